# Optimizing an MI355X kernel written in HIP

```python
import jax
import jax.numpy as jnp
from jax import lax
import numpy as np

D_MODEL = 1024
BATCH = 2
SEQ = 8192
DEPTH = 2

GRID_W = 64
CTX_LEN = 256
CHUNK = 64
LN_EPS = 1e-5

GLA_WIDTH = D_MODEL // 2
GLA_HEADS = 4
GLA_DV = GLA_WIDTH // GLA_HEADS
GLA_DK = GLA_DV // 2
GLA_GATE_RANK = 16
GLA_GATE_NORM = 16.0
GLA_SIZES = (GLA_HEADS * GLA_DK, GLA_HEADS * GLA_DK, GLA_WIDTH, GLA_WIDTH, GLA_GATE_RANK, GLA_GATE_RANK)
GLA_COLS = sum(GLA_SIZES)

RWKV_WIDTH = D_MODEL // 2
RWKV_HEAD_DIM = 64
RWKV_HEADS = RWKV_WIDTH // RWKV_HEAD_DIM
RWKV_DECAY_RANK = 64
RWKV_ICLR_RANK = 64
RWKV_DECAY_SCALE = 0.6065306597
RWKV_GN_EPS = 64e-5
RWKV_SIZES = (RWKV_WIDTH, RWKV_WIDTH, RWKV_WIDTH, RWKV_WIDTH, RWKV_DECAY_RANK, RWKV_DECAY_RANK, RWKV_ICLR_RANK, RWKV_ICLR_RANK)
RWKV_COLS = sum(RWKV_SIZES)
EVEN_IN = GLA_COLS + RWKV_COLS
EVEN_OUT = GLA_WIDTH + RWKV_WIDTH

MLSTM_INNER = 2 * D_MODEL
MLSTM_HEADS = 4
MLSTM_DH = MLSTM_INNER // MLSTM_HEADS
QKV_BLOCK = 4
CONV_K = 3

kernel_name = 'hybrid_gla_rwkv7_mlstm_prefix_flow_block'


def split_cols(p, sizes):
    idx = np.cumsum(sizes)[:-1].tolist()
    return jnp.split(p, idx, axis=-1)


def to_heads(t, n_heads):
    b, n, w = t.shape
    return t.reshape(b, n, n_heads, w // n_heads).transpose(0, 2, 1, 3)


def from_heads(t):
    b, h, n, d = t.shape
    return t.transpose(0, 2, 1, 3).reshape(b, n, h * d)


def layer_norm(x, g, b):
    xf = x.astype(jnp.float32)
    mu = jnp.mean(xf, -1, keepdims=True)
    var = jnp.mean(jnp.square(xf - mu), -1, keepdims=True)
    return ((xf - mu) * lax.rsqrt(var + LN_EPS) * g + b).astype(x.dtype)


def head_norm(y, eps, center):
    yf = y.astype(jnp.float32)
    if center:
        yf = yf - jnp.mean(yf, -1, keepdims=True)
    return yf * lax.rsqrt(jnp.mean(jnp.square(yf), -1, keepdims=True) + eps)


def quad_shift(p, rows, width):
    b, n, ch = p.shape
    g = p.reshape(b, rows, width, ch // 4, 4)
    left = jnp.pad(g[:, :, :-1, :, 0], ((0, 0), (0, 0), (1, 0), (0, 0)))
    right = jnp.pad(g[:, :, 1:, :, 1], ((0, 0), (0, 0), (0, 1), (0, 0)))
    up = jnp.pad(g[:, :-1, :, :, 2], ((0, 0), (1, 0), (0, 0), (0, 0)))
    down = jnp.pad(g[:, 1:, :, :, 3], ((0, 0), (0, 1), (0, 0), (0, 0)))
    return jnp.stack([left, right, up, down], axis=-1).reshape(b, n, ch)


def depthwise_conv_grid(x, w, bias, rows, width):
    b, n, ch = x.shape
    y = lax.conv_general_dilated(x.reshape(b, rows, width, ch), w, window_strides=(1, 1), padding='SAME',
                                 dimension_numbers=('NHWC', 'HWIO', 'NHWC'), feature_group_count=ch)
    return y.reshape(b, n, ch) + bias


def headwise(x, w):
    b, n, ch = x.shape
    nb, blk, _ = w.shape
    return jnp.einsum('bnjc,jcd->bnjd', x.reshape(b, n, nb, blk), w).reshape(b, n, ch)


def _chunks(t):
    b, h, n = t.shape[:3]
    t = t.reshape((b, h, n // CHUNK, CHUNK) + t.shape[3:])
    return jnp.moveaxis(t, 2, 0)


def _unchunks(t):
    t = jnp.moveaxis(t, 0, 2)
    b, h, nc, l = t.shape[:4]
    return t.reshape((b, h, nc * l) + t.shape[4:])


def gla_chunked(q, k, v, log_a, state):
    f32 = jnp.float32
    mask = jnp.tril(jnp.ones((CHUNK, CHUNK), bool))[:, :, None]

    def step(s, inp):
        qc, kc, vc, ac = inp
        bcum = jnp.cumsum(ac, axis=-2)
        inter = jnp.einsum('bhtk,bhkv->bhtv', qc * jnp.exp(bcum), s)
        diff = bcum[:, :, :, None, :] - bcum[:, :, None, :, :]
        decay = jnp.exp(jnp.where(mask, diff, -jnp.inf))
        scores = jnp.einsum('bhtk,bhsk,bhtsk->bhts', qc, kc, decay)
        intra = jnp.einsum('bhts,bhsv->bhtv', scores, vc)
        total = bcum[:, :, -1, :]
        kdec = kc * jnp.exp(total[:, :, None, :] - bcum)
        s_new = s * jnp.exp(total)[..., None] + jnp.einsum('bhsk,bhsv->bhkv', kdec, vc)
        return s_new, inter + intra

    xs = tuple(_chunks(t.astype(f32)) for t in (q, k, v, log_a))
    s_fin, out = lax.scan(step, state, xs)
    return _unchunks(out), s_fin


def rwkv7_scan(r, w, k, v, a, bvec, state):
    xs = tuple(jnp.moveaxis(t.astype(jnp.float32), 2, 0) for t in (r, w, k, v, a, bvec))

    def step(s, inp):
        r_t, w_t, k_t, v_t, a_t, b_t = inp
        sa = jnp.einsum('bhvk,bhk->bhv', s, a_t)
        s = s * w_t[:, :, None, :] + sa[..., None] * b_t[:, :, None, :] + v_t[..., None] * k_t[:, :, None, :]
        return s, jnp.einsum('bhvk,bhk->bhv', s, r_t)

    s_fin, y = lax.scan(step, state, xs)
    return jnp.moveaxis(y, 0, 2), s_fin


def mlstm_chunked(q, k, v, i_pre, log_f, state):
    f32 = jnp.float32
    mask = jnp.tril(jnp.ones((CHUNK, CHUNK), bool))

    def step(carry, inp):
        c0, n0, m0 = carry
        qc, kc, vc, ic, fc = inp
        bcum = jnp.cumsum(fc, axis=-1)
        log_d = jnp.where(mask, bcum[..., :, None] - bcum[..., None, :] + ic[..., None, :], -jnp.inf)
        log_inter = bcum + m0[..., None]
        m_t = jnp.maximum(jnp.max(log_d, axis=-1), log_inter)
        dmat = jnp.exp(log_d - m_t[..., None])
        g_inter = jnp.exp(log_inter - m_t)
        s = jnp.einsum('bhtd,bhsd->bhts', qc, kc) * dmat
        num = jnp.einsum('bhts,bhsv->bhtv', s, vc) + g_inter[..., None] * jnp.einsum('bhvk,bhtk->bhtv', c0, qc)
        den = jnp.sum(s, -1) + g_inter * jnp.einsum('bhk,bhtk->bht', n0, qc)
        h = num / jnp.maximum(jnp.abs(den), jnp.exp(-m_t))[..., None]
        tot = bcum[..., -1]
        log_w = tot[..., None] - bcum + ic
        m_new = jnp.maximum(tot + m0, jnp.max(log_w, axis=-1))
        wts = jnp.exp(log_w - m_new[..., None])
        decay0 = jnp.exp(tot + m0 - m_new)
        c_new = decay0[..., None, None] * c0 + jnp.einsum('bhsv,bhsk->bhvk', wts[..., None] * vc, kc)
        n_new = decay0[..., None] * n0 + jnp.einsum('bhs,bhsk->bhk', wts, kc)
        return (c_new, n_new, m_new), h

    xs = tuple(_chunks(t.astype(f32)) for t in (q, k, v, i_pre, log_f))
    st, out = lax.scan(step, state, xs)
    return _unchunks(out), st


def bidirectional(scan_fn, ctx_f, ctx_b, lat_f, lat_b, init):
    rev = lambda args: tuple(jnp.flip(a, axis=2) for a in args)
    yc_f, st_f = scan_fn(*ctx_f, init)
    yc_b, st_b = scan_fn(*rev(ctx_b), init)
    yl_f, _ = scan_fn(*lat_f, st_f)
    yl_b, _ = scan_fn(*rev(lat_b), st_b)
    return yc_f + jnp.flip(yc_b, axis=2), yl_f + jnp.flip(yl_b, axis=2)


def gla_branch(p_ctx, p_lat, need_ctx, wa2_f, ba_f, wa2_b, ba_b, norm_g):
    def prep(p):
        q, k, v, g, lr_f, lr_b = split_cols(p, GLA_SIZES)
        q = to_heads(q, GLA_HEADS) * (GLA_DK ** -0.5)
        k = to_heads(k, GLA_HEADS)
        v = to_heads(v, GLA_HEADS)
        la_f = to_heads(jax.nn.log_sigmoid((lr_f @ wa2_f + ba_f).astype(jnp.float32)) / GLA_GATE_NORM, GLA_HEADS)
        la_b = to_heads(jax.nn.log_sigmoid((lr_b @ wa2_b + ba_b).astype(jnp.float32)) / GLA_GATE_NORM, GLA_HEADS)
        return (q, k, v, la_f), (q, k, v, la_b), g

    cf, cb, gc = prep(p_ctx)
    lf, lb, gl = prep(p_lat)
    s0 = jnp.zeros((p_lat.shape[0], GLA_HEADS, GLA_DK, GLA_DV), jnp.float32)
    oc, ol = bidirectional(gla_chunked, cf, cb, lf, lb, s0)

    def finish(o, g):
        y = from_heads(head_norm(o, LN_EPS, False) * norm_g)
        return (y * jax.nn.silu(g.astype(jnp.float32))).astype(g.dtype)

    return (finish(oc, gc) if need_ctx else None), finish(ol, gl)


def rwkv_branch(p_ctx, p_lat, ctx_grid, lat_grid, need_ctx, mu, w0_f, ww2_f, w0_b, ww2_b,
                a0_f, wa2_f, a0_b, wa2_b, k_k, k_a, r_k, gn_g, gn_b):
    rk = r_k.reshape(RWKV_HEADS, 1, RWKV_HEAD_DIM)

    def prep(p, grid):
        p = p + (quad_shift(p, grid[0], grid[1]) - p) * mu
        r, k, v, g, wl_f, wl_b, al_f, al_b = split_cols(p, RWKV_SIZES)
        rh, vh = to_heads(r, RWKV_HEADS), to_heads(v, RWKV_HEADS)
        kk = to_heads(k * k_k, RWKV_HEADS).astype(jnp.float32)
        kk = kk * lax.rsqrt(jnp.maximum(jnp.sum(jnp.square(kk), -1, keepdims=True), 1e-24))

        def direction(w_lr, w0, ww2, a_lr, a0, wa2):
            w = jnp.exp(-RWKV_DECAY_SCALE * jax.nn.sigmoid((w0 + jnp.tanh(w_lr) @ ww2).astype(jnp.float32)))
            a = jax.nn.sigmoid(a0 + a_lr @ wa2)
            kh = to_heads(k * (1.0 + (a - 1.0) * k_a), RWKV_HEADS)
            ah = to_heads(a, RWKV_HEADS).astype(jnp.float32)
            bonus = jnp.sum(rh * kh * rk, -1, keepdims=True) * vh
            return (rh, to_heads(w, RWKV_HEADS), kh, vh, -kk, kk * ah), bonus

        fwd, bonus_f = direction(wl_f, w0_f, ww2_f, al_f, a0_f, wa2_f)
        bwd, bonus_b = direction(wl_b, w0_b, ww2_b, al_b, a0_b, wa2_b)
        return fwd, bwd, bonus_f + bonus_b, g

    cf, cb, bon_c, gc = prep(p_ctx, ctx_grid)
    lf, lb, bon_l, gl = prep(p_lat, lat_grid)
    s0 = jnp.zeros((p_lat.shape[0], RWKV_HEADS, RWKV_HEAD_DIM, RWKV_HEAD_DIM), jnp.float32)
    yc, yl = bidirectional(rwkv7_scan, cf, cb, lf, lb, s0)

    def finish(y, bonus, g):
        y = from_heads(head_norm(y, RWKV_GN_EPS, True)) * gn_g + gn_b + from_heads(bonus)
        return (y * jax.nn.silu(g.astype(jnp.float32))).astype(g.dtype)

    return (finish(yc, bon_c, gc) if need_ctx else None), finish(yl, bon_l, gl)


def mlstm_branch(p_ctx, p_lat, ctx_grid, lat_grid, need_ctx, conv_w, conv_b, wq, wk, wv,
                 wi_f, bi_f, wf_f, bf_f, wi_b, bi_b, wf_b, bf_b, norm_g, skip):
    def prep(p, grid):
        xm, z = split_cols(p, (MLSTM_INNER, MLSTM_INNER))
        xc = jax.nn.silu(depthwise_conv_grid(xm, conv_w, conv_b, grid[0], grid[1]))
        q, k, v = headwise(xc, wq), headwise(xc, wk), headwise(xm, wv)
        qkv = jnp.concatenate([q, k, v], axis=-1)
        qh = to_heads(q, MLSTM_HEADS)
        kh = to_heads(k, MLSTM_HEADS) * (MLSTM_DH ** -0.5)
        vh = to_heads(v, MLSTM_HEADS)

        def gates(wi, bi, wf, bf):
            i_pre = jnp.swapaxes((qkv @ wi + bi).astype(jnp.float32), 1, 2)
            log_f = jnp.swapaxes(jax.nn.log_sigmoid((qkv @ wf + bf).astype(jnp.float32)), 1, 2)
            return (qh, kh, vh, i_pre, log_f)

        return gates(wi_f, bi_f, wf_f, bf_f), gates(wi_b, bi_b, wf_b, bf_b), xc, z

    cf, cb, xc_c, z_c = prep(p_ctx, ctx_grid)
    lf, lb, xc_l, z_l = prep(p_lat, lat_grid)
    b = p_lat.shape[0]
    st0 = (jnp.zeros((b, MLSTM_HEADS, MLSTM_DH, MLSTM_DH), jnp.float32),
           jnp.zeros((b, MLSTM_HEADS, MLSTM_DH), jnp.float32),
           jnp.full((b, MLSTM_HEADS), -jnp.inf, jnp.float32))
    hc, hl = bidirectional(mlstm_chunked, cf, cb, lf, lb, st0)

    def finish(h, xc, z):
        y = from_heads(head_norm(h, LN_EPS, True)) * norm_g + skip * xc
        return (y * jax.nn.silu(z.astype(jnp.float32))).astype(z.dtype)

    return (finish(hc, xc_c, z_c) if need_ctx else None), finish(hl, xc_l, z_l)


def setup_inputs(seed: int = 0) -> dict:
    key = jax.random.key(seed)
    ks = iter(jax.random.split(key, 96))
    f32 = jnp.float32
    nrm = lambda shape, scale: jax.random.normal(next(ks), shape, f32) * scale
    uni = lambda shape, lo, hi: jax.random.uniform(next(ks), shape, f32, lo, hi)
    D = D_MODEL
    E = (DEPTH + 1) // 2
    O = DEPTH // 2
    beta = (8.0 * DEPTH) ** -0.25
    return {
        'x': nrm((BATCH, SEQ, D), 1.0),
        'c': nrm((BATCH, D), 1.0),
        'ctx': nrm((BATCH, CTX_LEN, D), 1.0),
        'c_ctx': nrm((D,), 1.0),
        'mod_w': nrm((DEPTH, D, 3 * D), D ** -0.5),
        'mod_b': nrm((DEPTH, 3 * D), 0.02),
        'ln_g': 1.0 + nrm((DEPTH, D), 0.02),
        'ln_b': nrm((DEPTH, D), 0.02),
        'e_w_in': nrm((E, D, EVEN_IN), D ** -0.5),
        'e_w_out': nrm((E, EVEN_OUT, D), beta * EVEN_OUT ** -0.5),
        'gla_wa2_f': nrm((E, GLA_GATE_RANK, GLA_HEADS * GLA_DK), GLA_GATE_RANK ** -0.5),
        'gla_ba_f': nrm((E, GLA_HEADS * GLA_DK), 0.1),
        'gla_wa2_b': nrm((E, GLA_GATE_RANK, GLA_HEADS * GLA_DK), GLA_GATE_RANK ** -0.5),
        'gla_ba_b': nrm((E, GLA_HEADS * GLA_DK), 0.1),
        'gla_norm_g': 1.0 + nrm((E, GLA_DV), 0.02),
        'rwkv_mu': uni((E, RWKV_COLS), 0.0, 1.0),
        'rwkv_w0_f': uni((E, RWKV_WIDTH), -6.0, 0.0),
        'rwkv_ww2_f': nrm((E, RWKV_DECAY_RANK, RWKV_WIDTH), 0.1 * RWKV_DECAY_RANK ** -0.5),
        'rwkv_w0_b': uni((E, RWKV_WIDTH), -6.0, 0.0),
        'rwkv_ww2_b': nrm((E, RWKV_DECAY_RANK, RWKV_WIDTH), 0.1 * RWKV_DECAY_RANK ** -0.5),
        'rwkv_a0_f': nrm((E, RWKV_WIDTH), 0.1),
        'rwkv_wa2_f': nrm((E, RWKV_ICLR_RANK, RWKV_WIDTH), 0.1 * RWKV_ICLR_RANK ** -0.5),
        'rwkv_a0_b': nrm((E, RWKV_WIDTH), 0.1),
        'rwkv_wa2_b': nrm((E, RWKV_ICLR_RANK, RWKV_WIDTH), 0.1 * RWKV_ICLR_RANK ** -0.5),
        'rwkv_k_k': 0.85 + nrm((E, RWKV_WIDTH), 0.02),
        'rwkv_k_a': 1.0 + nrm((E, RWKV_WIDTH), 0.02),
        'rwkv_r_k': nrm((E, RWKV_WIDTH), 0.1),
        'rwkv_gn_g': 1.0 + nrm((E, RWKV_WIDTH), 0.02),
        'rwkv_gn_b': nrm((E, RWKV_WIDTH), 0.02),
        'o_w_in': nrm((O, D, 2 * MLSTM_INNER), D ** -0.5),
        'o_w_out': nrm((O, MLSTM_INNER, D), beta * MLSTM_INNER ** -0.5),
        'ml_conv_w': nrm((O, CONV_K, CONV_K, 1, MLSTM_INNER), 1.0 / CONV_K),
        'ml_conv_b': nrm((O, MLSTM_INNER), 0.02),
        'ml_wq': nrm((O, MLSTM_INNER // QKV_BLOCK, QKV_BLOCK, QKV_BLOCK), QKV_BLOCK ** -0.5),
        'ml_wk': nrm((O, MLSTM_INNER // QKV_BLOCK, QKV_BLOCK, QKV_BLOCK), QKV_BLOCK ** -0.5),
        'ml_wv': nrm((O, MLSTM_INNER // QKV_BLOCK, QKV_BLOCK, QKV_BLOCK), QKV_BLOCK ** -0.5),
        'ml_wi_f': nrm((O, 3 * MLSTM_INNER, MLSTM_HEADS), (3 * MLSTM_INNER) ** -0.5),
        'ml_bi_f': nrm((O, MLSTM_HEADS), 0.1),
        'ml_wf_f': nrm((O, 3 * MLSTM_INNER, MLSTM_HEADS), (3 * MLSTM_INNER) ** -0.5),
        'ml_bf_f': jnp.linspace(3.0, 6.0, MLSTM_HEADS, dtype=f32) + nrm((O, MLSTM_HEADS), 0.1),
        'ml_wi_b': nrm((O, 3 * MLSTM_INNER, MLSTM_HEADS), (3 * MLSTM_INNER) ** -0.5),
        'ml_bi_b': nrm((O, MLSTM_HEADS), 0.1),
        'ml_wf_b': nrm((O, 3 * MLSTM_INNER, MLSTM_HEADS), (3 * MLSTM_INNER) ** -0.5),
        'ml_bf_b': jnp.linspace(3.0, 6.0, MLSTM_HEADS, dtype=f32) + nrm((O, MLSTM_HEADS), 0.1),
        'ml_norm_g': 1.0 + nrm((O, MLSTM_INNER), 0.02),
        'ml_skip': 1.0 + nrm((O, MLSTM_INNER), 0.02),
    }


def reference(x, c, ctx, c_ctx, mod_w, mod_b, ln_g, ln_b, e_w_in, e_w_out,
              gla_wa2_f, gla_ba_f, gla_wa2_b, gla_ba_b, gla_norm_g,
              rwkv_mu, rwkv_w0_f, rwkv_ww2_f, rwkv_w0_b, rwkv_ww2_b, rwkv_a0_f, rwkv_wa2_f,
              rwkv_a0_b, rwkv_wa2_b, rwkv_k_k, rwkv_k_a, rwkv_r_k, rwkv_gn_g, rwkv_gn_b,
              o_w_in, o_w_out, ml_conv_w, ml_conv_b, ml_wq, ml_wk, ml_wv,
              ml_wi_f, ml_bi_f, ml_wf_f, ml_bf_f, ml_wi_b, ml_bi_b, ml_wf_b, ml_bf_b,
              ml_norm_g, ml_skip):
    rows = x.shape[1] // GRID_W
    lat_grid = (rows, GRID_W)
    ctx_grid = (1, ctx.shape[1])
    alpha = (2.0 * DEPTH) ** 0.25
    xl, xc = x, ctx
    sc = jax.nn.silu(c)
    scc = jax.nn.silu(c_ctx)
    for layer in range(DEPTH):
        need_ctx = layer < DEPTH - 1
        mod_l = (sc @ mod_w[layer] + mod_b[layer])[:, None, :]
        mod_c = scc @ mod_w[layer] + mod_b[layer]
        shift_l, scale_l, gate_l = jnp.split(mod_l, 3, axis=-1)
        shift_c, scale_c, gate_c = jnp.split(mod_c, 3, axis=-1)
        hl = xl * (1.0 + scale_l) + shift_l
        hc = xc * (1.0 + scale_c) + shift_c
        j = layer // 2
        if layer % 2 == 0:
            pl = hl @ e_w_in[j]
            pc = hc @ e_w_in[j]
            gc_, gl_ = gla_branch(pc[..., :GLA_COLS], pl[..., :GLA_COLS], need_ctx,
                                  gla_wa2_f[j], gla_ba_f[j], gla_wa2_b[j], gla_ba_b[j], gla_norm_g[j])
            rc_, rl_ = rwkv_branch(pc[..., GLA_COLS:], pl[..., GLA_COLS:], ctx_grid, lat_grid, need_ctx,
                                   rwkv_mu[j], rwkv_w0_f[j], rwkv_ww2_f[j], rwkv_w0_b[j], rwkv_ww2_b[j],
                                   rwkv_a0_f[j], rwkv_wa2_f[j], rwkv_a0_b[j], rwkv_wa2_b[j],
                                   rwkv_k_k[j], rwkv_k_a[j], rwkv_r_k[j], rwkv_gn_g[j], rwkv_gn_b[j])
            out_l = jnp.concatenate([gl_, rl_], axis=-1) @ e_w_out[j]
            out_c = jnp.concatenate([gc_, rc_], axis=-1) @ e_w_out[j] if need_ctx else None
        else:
            pl = hl @ o_w_in[j]
            pc = hc @ o_w_in[j]
            mc_, ml_ = mlstm_branch(pc, pl, ctx_grid, lat_grid, need_ctx, ml_conv_w[j], ml_conv_b[j],
                                    ml_wq[j], ml_wk[j], ml_wv[j],
                                    ml_wi_f[j], ml_bi_f[j], ml_wf_f[j], ml_bf_f[j],
                                    ml_wi_b[j], ml_bi_b[j], ml_wf_b[j], ml_bf_b[j],
                                    ml_norm_g[j], ml_skip[j])
            out_l = ml_ @ o_w_out[j]
            out_c = mc_ @ o_w_out[j] if need_ctx else None
        xl = layer_norm(alpha * xl + gate_l * out_l, ln_g[layer], ln_b[layer])
        if need_ctx:
            xc = layer_norm(alpha * xc + gate_c * out_c, ln_g[layer], ln_b[layer])
    return xl
```

```cpp
#include <hip/hip_runtime.h>
#include <hip/hip_cooperative_groups.h>
#include <cstdio>
#include <cmath>
namespace cg = cooperative_groups;

#define DEV __device__ __forceinline__

constexpr int NB = 2, NL = 8192, DM = 1024, NCX = 256, TB = NCX + NL;
constexpr int EIN = 3872, RW0 = 1568;
constexpr int NTHR = 256;
constexpr float ALPHA = 1.41421356237f;

constexpr size_t OFF_MODV = 0;
constexpr size_t OFF_X1C  = 131072;
constexpr size_t OFF_BON  = 2359296;
constexpr size_t OFF_G16  = 2752512;
constexpr size_t OFF_BIG  = 4194304;
constexpr size_t OFF_P0   = OFF_BIG;
constexpr size_t OFF_YS   = OFF_BIG + (size_t)TB * EIN * 4;
constexpr size_t OFF_XM   = OFF_BIG;
constexpr size_t OFF_XC   = OFF_XM + (size_t)TB * 2048 * 4;
constexpr size_t OFF_H    = OFF_XC + (size_t)TB * 2048 * 4;
constexpr size_t WS_NEED  = OFF_H + (size_t)NL * 2048 * 4;

constexpr int LDS_BYTES = 135168;

struct Params { const float* in[46]; float* out; char* ws; };

DEV float wave_sum(float v) {
#pragma unroll
    for (int o = 32; o > 0; o >>= 1) v += __shfl_xor(v, o, 64);
    return v;
}
DEV float sigmoid_f(float x) { return 1.f / (1.f + expf(-x)); }
DEV float silu_f(float x) { return x / (1.f + expf(-x)); }
DEV float logsig_f(float x) { return fminf(x, 0.f) - log1pf(expf(-fabsf(x))); }
DEV void lds_fence() { asm volatile("" ::: "memory"); }
DEV int scan_s(int dir, int u) { return dir == 0 ? u : (u < NCX ? (NCX - 1 - u) : (TB - 1 + NCX - u)); }
DEV float4 ld4(const float* p) { return *(const float4*)p; }
DEV void st4(float* p, float4 v) { *(float4*)p = v; }

template <class AL, class EP>
DEV void gemm_plain(int M, int N, int K, const float* __restrict__ W, int ldw, AL al, EP ep, float* sm) {
    float (*As)[68] = (float (*)[68])sm;
    float (*Bs)[68] = (float (*)[68])(sm + 16 * 68);
    const int tid = threadIdx.x, tx = tid & 15, ty = tid >> 4;
    const int mt = M / 64, nt = (N + 63) / 64;
    for (int tile = blockIdx.x; tile < mt * nt; tile += gridDim.x) {
        const int tm = tile / nt, tn = tile % nt;
        const int m0 = tm * 64, n0 = tn * 64;
        float acc[4][4];
#pragma unroll
        for (int i = 0; i < 4; ++i)
#pragma unroll
            for (int j = 0; j < 4; ++j) acc[i][j] = 0.f;
        for (int k0 = 0; k0 < K; k0 += 16) {
            {
                const int r = tid >> 2, kq = (tid & 3) * 4;
                float4 a = al(m0 + r, k0 + kq);
                As[kq + 0][r] = a.x; As[kq + 1][r] = a.y; As[kq + 2][r] = a.z; As[kq + 3][r] = a.w;
            }
            {
                const int kk = tid >> 4, c4 = (tid & 15) * 4;
                float4 bq = make_float4(0.f, 0.f, 0.f, 0.f);
                if (n0 + c4 < N) bq = ld4(W + (size_t)(k0 + kk) * ldw + n0 + c4);
                st4(&Bs[kk][c4], bq);
            }
            __syncthreads();
#pragma unroll
            for (int kk = 0; kk < 16; ++kk) {
                float4 a = ld4(&As[kk][ty * 4]);
                float4 bq = ld4(&Bs[kk][tx * 4]);
                float av[4] = {a.x, a.y, a.z, a.w}, bv[4] = {bq.x, bq.y, bq.z, bq.w};
#pragma unroll
                for (int i = 0; i < 4; ++i)
#pragma unroll
                    for (int j = 0; j < 4; ++j) acc[i][j] += av[i] * bv[j];
            }
            __syncthreads();
        }
        if (n0 + tx * 4 < N) {
#pragma unroll
            for (int i = 0; i < 4; ++i) ep(m0 + ty * 4 + i, n0 + tx * 4, make_float4(acc[i][0], acc[i][1], acc[i][2], acc[i][3]));
        }
    }
}

struct ALmod {
    const float* lat; const float* cx; const float* mv; int b; int s0;
    DEV float4 operator()(int r, int k) const {
        const int s = r + s0;
        const float* src; int j;
        if (s < NCX) { src = cx + ((size_t)(b * NCX + s)) * DM + k; j = 2; }
        else { src = lat + ((size_t)(b * NL + s - NCX)) * DM + k; j = b; }
        float4 a = ld4(src);
        const float* m = mv + j * 3072;
        float4 sh = ld4(m + k), sc = ld4(m + 1024 + k);
        return make_float4(a.x * (1.f + sc.x) + sh.x, a.y * (1.f + sc.y) + sh.y, a.z * (1.f + sc.z) + sh.z, a.w * (1.f + sc.w) + sh.w);
    }
};
struct ALplain { const float* A; int lda; DEV float4 operator()(int r, int k) const { return ld4(A + (size_t)r * lda + k); } };
struct EPstore { float* C; int ldc; DEV void operator()(int r, int c, float4 v) const { st4(C + (size_t)r * ldc + c, v); } };
struct EPres {
    float* C; int ldc; const float* lat; const float* cx; const float* mv; int b; int s0;
    DEV void operator()(int r, int c, float4 v) const {
        const int s = r + s0;
        const float* src; int j;
        if (s < NCX) { src = cx + ((size_t)(b * NCX + s)) * DM + c; j = 2; }
        else { src = lat + ((size_t)(b * NL + s - NCX)) * DM + c; j = b; }
        float4 x = ld4(src);
        float4 g = ld4(mv + j * 3072 + 2048 + c);
        st4(C + (size_t)r * ldc + c, make_float4(ALPHA * x.x + g.x * v.x, ALPHA * x.y + g.y * v.y, ALPHA * x.z + g.z * v.z, ALPHA * x.w + g.w * v.w));
    }
};

DEV void phase_mod(const Params& p, float* sm) {
    const float* c = p.in[1]; const float* cctx = p.in[3];
    const float* mod_w = p.in[4]; const float* mod_b = p.in[5];
    float* modv = (float*)(p.ws + OFF_MODV);
    float* sil = sm; float* red = sm + 3072;
    const int tid = threadIdx.x;
    for (int i = tid; i < 3072; i += NTHR) {
        const int j = i >> 10, k = i & 1023;
        const float v = (j < 2) ? c[j * 1024 + k] : cctx[k];
        sil[i] = silu_f(v);
    }
    __syncthreads();
    for (int unit = blockIdx.x; unit < 192; unit += gridDim.x) {
        const int l = unit / 96, cb = unit % 96;
        const int kg = tid >> 5, col = tid & 31, n = cb * 32 + col;
        const float* w = mod_w + (size_t)l * 1024 * 3072 + n;
        float a0 = 0.f, a1 = 0.f, a2 = 0.f;
        for (int k = kg * 128; k < kg * 128 + 128; ++k) {
            const float wv = w[(size_t)k * 3072];
            a0 += sil[k] * wv; a1 += sil[1024 + k] * wv; a2 += sil[2048 + k] * wv;
        }
        red[(kg * 3 + 0) * 32 + col] = a0; red[(kg * 3 + 1) * 32 + col] = a1; red[(kg * 3 + 2) * 32 + col] = a2;
        __syncthreads();
        if (tid < 96) {
            const int j = tid >> 5, cc = tid & 31, nn = cb * 32 + cc;
            float s = mod_b[l * 3072 + nn];
            for (int g = 0; g < 8; ++g) s += red[(g * 3 + j) * 32 + cc];
            modv[(l * 3 + j) * 3072 + nn] = s;
        }
        __syncthreads();
    }
}

DEV float rw_mix(const float* P0, int s, int c, const float* __restrict__ mu) {
    const float own = P0[(size_t)s * EIN + RW0 + c];
    const int d = c & 3;
    int ns = -1;
    if (s < NCX) {
        if (d == 0) ns = (s > 0) ? s - 1 : -1;
        else if (d == 1) ns = (s < NCX - 1) ? s + 1 : -1;
    } else {
        const int n = s - NCX, rr = n >> 6, cc = n & 63;
        if (d == 0) ns = (cc > 0) ? s - 1 : -1;
        else if (d == 1) ns = (cc < 63) ? s + 1 : -1;
        else if (d == 2) ns = (rr > 0) ? s - 64 : -1;
        else ns = (rr < 127) ? s + 64 : -1;
    }
    const float nb = (ns >= 0) ? P0[(size_t)ns * EIN + RW0 + c] : 0.f;
    return own + (nb - own) * mu[c];
}

DEV void rwkv_unit(const Params& p, int h, int dir, float* sm, int lane) {
    const float* P0 = (const float*)(p.ws + OFF_P0);
    float* YS = (float*)(p.ws + OFF_YS);
    float* BON = (float*)(p.ws + OFF_BON);
    const float* mu = p.in[15];
    const float* w0 = p.in[dir ? 18 : 16]; const float* ww2 = p.in[dir ? 19 : 17];
    const float* a0 = p.in[dir ? 22 : 20]; const float* wa2 = p.in[dir ? 23 : 21];
    const float* k_k = p.in[24]; const float* k_a = p.in[25]; const float* r_k = p.in[26];
    float* sR = sm; float* sW = sm + 4096; float* sK = sm + 8192; float* sA = sm + 12288; float* sB = sm + 16384; float* sV = sm + 20480;
    const int hc = h * 64 + lane;
    const float w0j = w0[hc], a0j = a0[hc], kkj = k_k[hc], kaj = k_a[hc], rkj = r_k[hc];
    float S[64];
#pragma unroll
    for (int k = 0; k < 64; ++k) S[k] = 0.f;
    const int cwl = 2048 + dir * 64, cal = 2176 + dir * 64;
#pragma unroll 1
    for (int cu = 0; cu < TB / 64; ++cu) {
        lds_fence();
#pragma unroll 1
        for (int t = 0; t < 64; ++t) {
            const int s = scan_s(dir, cu * 64 + t);
            sR[t * 64 + lane] = rw_mix(P0, s, h * 64 + lane, mu);
            sK[t * 64 + lane] = rw_mix(P0, s, 512 + h * 64 + lane, mu);
            sV[t * 64 + lane] = rw_mix(P0, s, 1024 + h * 64 + lane, mu);
            sA[t * 64 + lane] = tanhf(rw_mix(P0, s, cwl + lane, mu));
            sB[t * 64 + lane] = rw_mix(P0, s, cal + lane, mu);
        }
        lds_fence();
        {
            const float* pw2 = ww2 + hc; asm volatile("" : "+v"(pw2));
            float wc[64];
#pragma unroll
            for (int i = 0; i < 64; ++i) wc[i] = pw2[i * 512];
#pragma unroll 1
            for (int t = 0; t < 64; ++t) {
                float accw = w0j;
#pragma unroll
                for (int i4 = 0; i4 < 16; ++i4) {
                    const float4 x = ld4(&sA[t * 64 + i4 * 4]);
                    accw += x.x * wc[i4 * 4] + x.y * wc[i4 * 4 + 1] + x.z * wc[i4 * 4 + 2] + x.w * wc[i4 * 4 + 3];
                }
                sW[t * 64 + lane] = expf(-0.6065306597f * sigmoid_f(accw));
            }
        }
        lds_fence();
        {
            const float* pa2 = wa2 + hc; asm volatile("" : "+v"(pa2));
            float ac[64];
#pragma unroll
            for (int i = 0; i < 64; ++i) ac[i] = pa2[i * 512];
#pragma unroll 1
            for (int t = 0; t < 64; ++t) {
                float acca = a0j;
#pragma unroll
                for (int i4 = 0; i4 < 16; ++i4) {
                    const float4 y = ld4(&sB[t * 64 + i4 * 4]);
                    acca += y.x * ac[i4 * 4] + y.y * ac[i4 * 4 + 1] + y.z * ac[i4 * 4 + 2] + y.w * ac[i4 * 4 + 3];
                }
                const float av = sigmoid_f(acca);
                const float kraw = sK[t * 64 + lane];
                const float kkv = kraw * kkj;
                const float ss = wave_sum(kkv * kkv);
                const float kk = kkv * rsqrtf(fmaxf(ss, 1e-24f));
                const float kh = kraw * (1.f + (av - 1.f) * kaj);
                const float r = sR[t * 64 + lane];
                const float bon = wave_sum(r * kh * rkj);
                lds_fence();
                sK[t * 64 + lane] = kh; sA[t * 64 + lane] = -kk; sB[t * 64 + lane] = kk * av;
                if (lane == 0) { const int s = scan_s(dir, cu * 64 + t); atomicAdd(&BON[s * 8 + h], bon); }
            }
        }
        lds_fence();
#pragma unroll 1
        for (int t = 0; t < 64; ++t) {
            const float vi = sV[t * 64 + lane];
            float sa = 0.f;
#pragma unroll
            for (int k4 = 0; k4 < 16; ++k4) {
                const float4 a4 = ld4(&sA[t * 64 + k4 * 4]);
                sa += S[k4 * 4] * a4.x + S[k4 * 4 + 1] * a4.y + S[k4 * 4 + 2] * a4.z + S[k4 * 4 + 3] * a4.w;
            }
            __builtin_amdgcn_sched_barrier(0);
            float y = 0.f;
#pragma unroll
            for (int k4 = 0; k4 < 16; ++k4) {
                const float4 w4 = ld4(&sW[t * 64 + k4 * 4]);
                const float4 b4 = ld4(&sB[t * 64 + k4 * 4]);
                const float4 h4 = ld4(&sK[t * 64 + k4 * 4]);
                const float4 r4 = ld4(&sR[t * 64 + k4 * 4]);
                S[k4 * 4 + 0] = S[k4 * 4 + 0] * w4.x + sa * b4.x + vi * h4.x;
                S[k4 * 4 + 1] = S[k4 * 4 + 1] * w4.y + sa * b4.y + vi * h4.y;
                S[k4 * 4 + 2] = S[k4 * 4 + 2] * w4.z + sa * b4.z + vi * h4.z;
                S[k4 * 4 + 3] = S[k4 * 4 + 3] * w4.w + sa * b4.w + vi * h4.w;
                y += S[k4 * 4] * r4.x + S[k4 * 4 + 1] * r4.y + S[k4 * 4 + 2] * r4.z + S[k4 * 4 + 3] * r4.w;
                if ((k4 & 3) == 3) __builtin_amdgcn_sched_barrier(0);
            }
            const int s = scan_s(dir, cu * 64 + t);
            atomicAdd(&YS[(size_t)s * 1024 + 512 + h * 64 + lane], y);
        }
    }
}

DEV void gla_unit(const Params& p, int h, int dir, int half, float* sm, int lane) {
    const float* P0 = (const float*)(p.ws + OFF_P0);
    float* YS = (float*)(p.ws + OFF_YS);
    const float* wa2 = p.in[dir ? 12 : 10]; const float* ba = p.in[dir ? 13 : 11];
    float* sQ = sm; float* sKg = sm + 4096; float* sAg = sm + 8192; float* sVg = sm + 12288; float* sLR = sm + 16384;
    const int hc = h * 64 + lane;
    float wcol[16];
#pragma unroll
    for (int i = 0; i < 16; ++i) wcol[i] = wa2[i * 256 + hc];
    const float baj = ba[hc];
    float S[64];
#pragma unroll
    for (int k = 0; k < 64; ++k) S[k] = 0.f;
#pragma unroll 1
    for (int cu = 0; cu < TB / 64; ++cu) {
        lds_fence();
#pragma unroll 1
        for (int t = 0; t < 64; ++t) {
            const int s = scan_s(dir, cu * 64 + t);
            const float* row = P0 + (size_t)s * EIN;
            sQ[t * 64 + lane] = row[h * 64 + lane] * 0.125f;
            sKg[t * 64 + lane] = row[256 + h * 64 + lane];
            sVg[t * 64 + lane] = row[512 + h * 128 + half * 64 + lane];
            if (lane < 16) sLR[t * 16 + lane] = row[1536 + dir * 16 + lane];
        }
        lds_fence();
#pragma unroll 1
        for (int t = 0; t < 64; ++t) {
            float x = baj;
#pragma unroll
            for (int i4 = 0; i4 < 4; ++i4) {
                const float4 l4 = ld4(&sLR[t * 16 + i4 * 4]);
                x += l4.x * wcol[i4 * 4] + l4.y * wcol[i4 * 4 + 1] + l4.z * wcol[i4 * 4 + 2] + l4.w * wcol[i4 * 4 + 3];
            }
            sAg[t * 64 + lane] = expf(logsig_f(x) * 0.0625f);
        }
        lds_fence();
#pragma unroll 1
        for (int t = 0; t < 64; ++t) {
            const float vv = sVg[t * 64 + lane];
            float o = 0.f;
#pragma unroll
            for (int k4 = 0; k4 < 16; ++k4) {
                const float4 a4 = ld4(&sAg[t * 64 + k4 * 4]);
                const float4 kk4 = ld4(&sKg[t * 64 + k4 * 4]);
                const float4 q4 = ld4(&sQ[t * 64 + k4 * 4]);
                S[k4 * 4 + 0] = a4.x * S[k4 * 4 + 0] + kk4.x * vv;
                S[k4 * 4 + 1] = a4.y * S[k4 * 4 + 1] + kk4.y * vv;
                S[k4 * 4 + 2] = a4.z * S[k4 * 4 + 2] + kk4.z * vv;
                S[k4 * 4 + 3] = a4.w * S[k4 * 4 + 3] + kk4.w * vv;
                o += q4.x * S[k4 * 4] + q4.y * S[k4 * 4 + 1] + q4.z * S[k4 * 4 + 2] + q4.w * S[k4 * 4 + 3];
            }
            const int s = scan_s(dir, cu * 64 + t);
            atomicAdd(&YS[(size_t)s * 1024 + h * 128 + half * 64 + lane], o);
        }
    }
}

DEV void phase_finish0(const Params& p) {
    const float* P0 = (const float*)(p.ws + OFF_P0);
    float* YS = (float*)(p.ws + OFF_YS);
    const float* BON = (const float*)(p.ws + OFF_BON);
    const float* mu = p.in[15];
    const float* gla_ng = p.in[14]; const float* gn_g = p.in[27]; const float* gn_b = p.in[28];
    const int lane = threadIdx.x & 63, gw = blockIdx.x * 4 + (threadIdx.x >> 6), ngw = gridDim.x * 4;
    for (int s = gw; s < TB; s += ngw) {
        float* ys = YS + (size_t)s * 1024;
        const float* row = P0 + (size_t)s * EIN;
#pragma unroll 1
        for (int h = 0; h < 4; ++h) {
            const float o0 = ys[h * 128 + lane], o1 = ys[h * 128 + 64 + lane];
            const float ss = wave_sum(o0 * o0 + o1 * o1);
            const float rms = rsqrtf(ss * (1.f / 128.f) + 1e-5f);
            const float g0 = row[1024 + h * 128 + lane], g1 = row[1024 + h * 128 + 64 + lane];
            ys[h * 128 + lane] = o0 * rms * gla_ng[lane] * silu_f(g0);
            ys[h * 128 + 64 + lane] = o1 * rms * gla_ng[64 + lane] * silu_f(g1);
        }
#pragma unroll 1
        for (int h = 0; h < 8; ++h) {
            const float yv = ys[512 + h * 64 + lane];
            const float mean = wave_sum(yv) * (1.f / 64.f);
            const float d = yv - mean;
            const float var = wave_sum(d * d) * (1.f / 64.f);
            const float yn = d * rsqrtf(var + 64e-5f);
            const float vmix = rw_mix(P0, s, 1024 + h * 64 + lane, mu);
            const float gmix = rw_mix(P0, s, 1536 + h * 64 + lane, mu);
            const float o = yn * gn_g[h * 64 + lane] + gn_b[h * 64 + lane] + BON[s * 8 + h] * vmix;
            ys[512 + h * 64 + lane] = o * silu_f(gmix);
        }
    }
}

DEV void ln_rows(const float* src, int nrows, const float* __restrict__ g, const float* __restrict__ bt, float* dst_lat, float* dst_cx, int s0) {
    const int lane = threadIdx.x & 63, gw = blockIdx.x * 4 + (threadIdx.x >> 6), ngw = gridDim.x * 4;
    for (int r = gw; r < nrows; r += ngw) {
        const float* x = src + (size_t)r * 1024;
        float4 v[4];
        float sum = 0.f;
#pragma unroll
        for (int i = 0; i < 4; ++i) { v[i] = ld4(x + i * 256 + lane * 4); sum += v[i].x + v[i].y + v[i].z + v[i].w; }
        const float mean = wave_sum(sum) * (1.f / 1024.f);
        float sq = 0.f;
#pragma unroll
        for (int i = 0; i < 4; ++i) {
            v[i].x -= mean; v[i].y -= mean; v[i].z -= mean; v[i].w -= mean;
            sq += v[i].x * v[i].x + v[i].y * v[i].y + v[i].z * v[i].z + v[i].w * v[i].w;
        }
        const float rstd = rsqrtf(wave_sum(sq) * (1.f / 1024.f) + 1e-5f);
        const int s = r + s0;
        float* d = (s < NCX) ? (dst_cx + (size_t)s * 1024) : (dst_lat + (size_t)(s - NCX) * 1024);
#pragma unroll
        for (int i = 0; i < 4; ++i) {
            const int c = i * 256 + lane * 4;
            const float4 gg = ld4(g + c), bb = ld4(bt + c);
            st4(d + c, make_float4(v[i].x * rstd * gg.x + bb.x, v[i].y * rstd * gg.y + bb.y, v[i].z * rstd * gg.z + bb.z, v[i].w * rstd * gg.w + bb.w));
        }
    }
}

DEV void phase_conv1(const Params& p) {
    const float* XM = (const float*)(p.ws + OFF_XM);
    float* XC = (float*)(p.ws + OFF_XC);
    float* G16 = (float*)(p.ws + OFF_G16);
    const float* cw = p.in[31]; const float* cbias = p.in[32];
    const float* wq = p.in[33]; const float* wk = p.in[34]; const float* wv = p.in[35];
    const float* gw4[4] = {p.in[36], p.in[38], p.in[40], p.in[42]};
    const float* gb4[4] = {p.in[37], p.in[39], p.in[41], p.in[43]};
    const int lane = threadIdx.x & 63, gwv = blockIdx.x * 4 + (threadIdx.x >> 6), ngw = gridDim.x * 4;
    for (int s = gwv; s < TB; s += ngw) {
        int nrow[9];
#pragma unroll
        for (int i = 0; i < 3; ++i)
#pragma unroll
            for (int j = 0; j < 3; ++j) {
                int ns = -1;
                if (s < NCX) { const int w2 = s + j - 1; if (i == 1 && w2 >= 0 && w2 < NCX) ns = w2; }
                else { const int n = s - NCX, rr = (n >> 6) + i - 1, w2 = (n & 63) + j - 1; if (rr >= 0 && rr < 128 && w2 >= 0 && w2 < 64) ns = NCX + rr * 64 + w2; }
                nrow[i * 3 + j] = ns;
            }
        float acc[16];
#pragma unroll
        for (int g = 0; g < 16; ++g) acc[g] = 0.f;
#pragma unroll 1
        for (int m = 0; m < 8; ++m) {
            const int blk = lane + 64 * m, c0 = blk * 4;
            float4 a = ld4(cbias + c0);
            float4 xmc = make_float4(0.f, 0.f, 0.f, 0.f);
#pragma unroll
            for (int tap = 0; tap < 9; ++tap) {
                if (nrow[tap] >= 0) {
                    const float4 xv = ld4(XM + (size_t)nrow[tap] * 2048 + c0);
                    const float4 w4 = ld4(cw + tap * 2048 + c0);
                    a.x += xv.x * w4.x; a.y += xv.y * w4.y; a.z += xv.z * w4.z; a.w += xv.w * w4.w;
                    if (tap == 4) xmc = xv;
                }
            }
            const float xc[4] = {silu_f(a.x), silu_f(a.y), silu_f(a.z), silu_f(a.w)};
            st4(XC + (size_t)s * 2048 + c0, make_float4(xc[0], xc[1], xc[2], xc[3]));
            const float xm[4] = {xmc.x, xmc.y, xmc.z, xmc.w};
            float q[4], k[4], v[4];
#pragma unroll
            for (int d = 0; d < 4; ++d) {
                float qa = 0.f, ka = 0.f, va = 0.f;
#pragma unroll
                for (int c = 0; c < 4; ++c) {
                    qa += xc[c] * wq[blk * 16 + c * 4 + d];
                    ka += xc[c] * wk[blk * 16 + c * 4 + d];
                    va += xm[c] * wv[blk * 16 + c * 4 + d];
                }
                q[d] = qa; k[d] = ka; v[d] = va;
            }
#pragma unroll
            for (int d = 0; d < 4; ++d) {
                const int ch = c0 + d;
#pragma unroll
                for (int gm = 0; gm < 4; ++gm) {
                    const float4 wq4 = ld4(gw4[gm] + (size_t)ch * 4);
                    const float4 wk4 = ld4(gw4[gm] + (size_t)(2048 + ch) * 4);
                    const float4 wv4 = ld4(gw4[gm] + (size_t)(4096 + ch) * 4);
                    acc[gm * 4 + 0] += q[d] * wq4.x + k[d] * wk4.x + v[d] * wv4.x;
                    acc[gm * 4 + 1] += q[d] * wq4.y + k[d] * wk4.y + v[d] * wv4.y;
                    acc[gm * 4 + 2] += q[d] * wq4.z + k[d] * wk4.z + v[d] * wv4.z;
                    acc[gm * 4 + 3] += q[d] * wq4.w + k[d] * wk4.w + v[d] * wv4.w;
                }
            }
        }
#pragma unroll
        for (int g = 0; g < 16; ++g) acc[g] = wave_sum(acc[g]);
        if (lane == 0) {
#pragma unroll
            for (int gm = 0; gm < 4; ++gm)
#pragma unroll
                for (int hh = 0; hh < 4; ++hh) {
                    float val = acc[gm * 4 + hh] + gb4[gm][hh];
                    if (gm & 1) val = logsig_f(val);
                    G16[(size_t)s * 16 + gm * 4 + hh] = val;
                }
        }
    }
}

DEV void mlstm_unit(const Params& p, int h, int dir, int rb, float* sm, int lane) {
    const float* XM = (const float*)(p.ws + OFF_XM);
    const float* XC = (const float*)(p.ws + OFF_XC);
    const float* G16 = (const float*)(p.ws + OFF_G16);
    float* H = (float*)(p.ws + OFF_H);
    const float* wq = p.in[33]; const float* wk = p.in[34]; const float* wv = p.in[35];
    float4* C = (float4*)sm;
    float* sq = sm + 32768; float* sk = sq + 512;
#pragma unroll 1
    for (int k4 = 0; k4 < 128; ++k4) C[k4 * 64 + lane] = make_float4(0.f, 0.f, 0.f, 0.f);
    float nst[8];
#pragma unroll
    for (int j = 0; j < 8; ++j) nst[j] = 0.f;
    float m = -INFINITY;
    const int ch = h * 512 + rb * 64 + lane;
    const int vb = ch >> 2, vd = ch & 3;
    float wvr[4];
#pragma unroll
    for (int c = 0; c < 4; ++c) wvr[c] = wv[vb * 16 + c * 4 + vd];
    const int qb0 = h * 128 + lane * 2;
    float wqr[32], wkr[32];
#pragma unroll
    for (int i = 0; i < 32; ++i) { wqr[i] = wq[qb0 * 16 + i]; wkr[i] = wk[qb0 * 16 + i]; }
    float4 x0, x1, xm4; float gi, lf;
    {
        const int s = scan_s(dir, 0);
        x0 = ld4(XC + (size_t)s * 2048 + h * 512 + lane * 8); x1 = ld4(XC + (size_t)s * 2048 + h * 512 + lane * 8 + 4);
        xm4 = ld4(XM + (size_t)s * 2048 + vb * 4);
        gi = G16[(size_t)s * 16 + dir * 8 + h]; lf = G16[(size_t)s * 16 + dir * 8 + 4 + h];
    }
#pragma unroll 1
    for (int u = 0; u < TB; ++u) {
        const int s = scan_s(dir, u);
        const float4 cx0 = x0, cx1 = x1, cxm = xm4; const float cgi = gi, clf = lf;
        if (u + 1 < TB) {
            const int s2 = scan_s(dir, u + 1);
            x0 = ld4(XC + (size_t)s2 * 2048 + h * 512 + lane * 8); x1 = ld4(XC + (size_t)s2 * 2048 + h * 512 + lane * 8 + 4);
            xm4 = ld4(XM + (size_t)s2 * 2048 + vb * 4);
            gi = G16[(size_t)s2 * 16 + dir * 8 + h]; lf = G16[(size_t)s2 * 16 + dir * 8 + 4 + h];
        }
        const float xa[8] = {cx0.x, cx0.y, cx0.z, cx0.w, cx1.x, cx1.y, cx1.z, cx1.w};
        float q[8], k[8];
#pragma unroll
        for (int bb = 0; bb < 2; ++bb)
#pragma unroll
            for (int d = 0; d < 4; ++d) {
                float qa = 0.f, ka = 0.f;
#pragma unroll
                for (int c = 0; c < 4; ++c) { qa += xa[bb * 4 + c] * wqr[bb * 16 + c * 4 + d]; ka += xa[bb * 4 + c] * wkr[bb * 16 + c * 4 + d]; }
                q[bb * 4 + d] = qa; k[bb * 4 + d] = ka * 0.04419417382f;
            }
        lds_fence();
        st4(sq + lane * 8, make_float4(q[0], q[1], q[2], q[3])); st4(sq + lane * 8 + 4, make_float4(q[4], q[5], q[6], q[7]));
        st4(sk + lane * 8, make_float4(k[0], k[1], k[2], k[3])); st4(sk + lane * 8 + 4, make_float4(k[4], k[5], k[6], k[7]));
        lds_fence();
        const float v = cxm.x * wvr[0] + cxm.y * wvr[1] + cxm.z * wvr[2] + cxm.w * wvr[3];
        const float mn = fmaxf(clf + m, cgi);
        const float fp = expf(clf + m - mn), ip = expf(cgi - mn);
        m = mn;
        float dl = 0.f;
#pragma unroll
        for (int j = 0; j < 8; ++j) { nst[j] = fp * nst[j] + ip * k[j]; dl += nst[j] * q[j]; }
        const float den = wave_sum(dl);
        const float ipv = ip * v;
        float num = 0.f;
#pragma unroll 4
        for (int k4 = 0; k4 < 128; ++k4) {
            float4 c4 = C[k4 * 64 + lane];
            const float4 kq = ld4(sk + k4 * 4), qq = ld4(sq + k4 * 4);
            c4.x = fp * c4.x + ipv * kq.x; c4.y = fp * c4.y + ipv * kq.y; c4.z = fp * c4.z + ipv * kq.z; c4.w = fp * c4.w + ipv * kq.w;
            num += c4.x * qq.x + c4.y * qq.y + c4.z * qq.z + c4.w * qq.w;
            C[k4 * 64 + lane] = c4;
        }
        const float hval = num / fmaxf(fabsf(den), expf(-m));
        if (s >= NCX) atomicAdd(&H[(size_t)(s - NCX) * 2048 + ch], hval);
    }
}

DEV void phase_finish1(const Params& p) {
    float* H = (float*)(p.ws + OFF_H);
    const float* XC = (const float*)(p.ws + OFF_XC);
    const float* Z = (const float*)(p.ws + OFF_XM);
    const float* ng = p.in[44]; const float* skip = p.in[45];
    const int lane = threadIdx.x & 63, gw = blockIdx.x * 4 + (threadIdx.x >> 6), ngw = gridDim.x * 4;
    for (int it = gw; it < NL * 4; it += ngw) {
        const int n = it >> 2, h = it & 3;
        float* hp = H + (size_t)n * 2048 + h * 512 + lane * 8;
        float4 a = ld4(hp), b2 = ld4(hp + 4);
        float v[8] = {a.x, a.y, a.z, a.w, b2.x, b2.y, b2.z, b2.w};
        float sum = 0.f;
#pragma unroll
        for (int j = 0; j < 8; ++j) sum += v[j];
        const float mean = wave_sum(sum) * (1.f / 512.f);
        float sq = 0.f;
#pragma unroll
        for (int j = 0; j < 8; ++j) { v[j] -= mean; sq += v[j] * v[j]; }
        const float rstd = rsqrtf(wave_sum(sq) * (1.f / 512.f) + 1e-5f);
        const int c0 = h * 512 + lane * 8;
        const float* xc = XC + (size_t)(NCX + n) * 2048 + c0;
        const float* z = Z + (size_t)n * 2048 + c0;
        float o[8];
#pragma unroll
        for (int j = 0; j < 8; ++j) o[j] = (v[j] * rstd * ng[c0 + j] + skip[c0 + j] * xc[j]) * silu_f(z[j]);
        st4(hp, make_float4(o[0], o[1], o[2], o[3])); st4(hp + 4, make_float4(o[4], o[5], o[6], o[7]));
    }
}

DEV void zero_f4(float* ptr, size_t nfloat) {
    const size_t n4 = nfloat / 4;
    for (size_t i = (size_t)blockIdx.x * NTHR + threadIdx.x; i < n4; i += (size_t)gridDim.x * NTHR) ((float4*)ptr)[i] = make_float4(0.f, 0.f, 0.f, 0.f);
}

__global__ void __launch_bounds__(NTHR) fwd_kernel(Params p) {
    extern __shared__ __attribute__((aligned(16))) float sm[];
    cg::grid_group grid = cg::this_grid();
    const int tid = threadIdx.x, lane = tid & 63, wave = tid >> 6;
    float* modv = (float*)(p.ws + OFF_MODV);
    float* X1C = (float*)(p.ws + OFF_X1C);

    phase_mod(p, sm);
    grid.sync();

#pragma unroll 1
    for (int b = 0; b < NB; ++b) {
        {
            ALmod al{p.in[0], p.in[2], modv, b, 0};
            EPstore ep{(float*)(p.ws + OFF_P0), EIN};
            gemm_plain(TB, EIN, DM, p.in[8], EIN, al, ep, sm);
            zero_f4((float*)(p.ws + OFF_YS), (size_t)TB * 1024);
            zero_f4((float*)(p.ws + OFF_BON), (size_t)TB * 8);
        }
        grid.sync();
        if (wave == 0) {
            const int u = blockIdx.x;
            #ifndef NO_RWKV
            if (u < 16) rwkv_unit(p, u >> 1, u & 1, sm, lane);
#endif
            #ifndef NO_GLA
            if (u >= 16 && u < 32) { const int v = u - 16; gla_unit(p, v >> 2, (v >> 1) & 1, v & 1, sm, lane); }
#endif
        }
        grid.sync();
        phase_finish0(p);
        grid.sync();
        {
            ALplain al{(const float*)(p.ws + OFF_YS), 1024};
            EPres ep{(float*)(p.ws + OFF_P0), 1024, p.in[0], p.in[2], modv, b, 0};
            gemm_plain(TB, DM, DM, p.in[9], DM, al, ep, sm);
        }
        grid.sync();
        ln_rows((const float*)(p.ws + OFF_P0), TB, p.in[6], p.in[7], p.out + (size_t)b * NL * DM, X1C + (size_t)b * NCX * DM, 0);
        grid.sync();
        {
            ALmod al{p.out, X1C, modv + 3 * 3072, b, 0};
            EPstore ep{(float*)(p.ws + OFF_XM), 2048};
            gemm_plain(TB, 2048, DM, p.in[29], 4096, al, ep, sm);
            zero_f4((float*)(p.ws + OFF_H), (size_t)NL * 2048);
        }
        grid.sync();
#ifndef NO_CONV
        phase_conv1(p);
#endif
        grid.sync();
        if (wave == 0) {
            const int u = blockIdx.x;
            #ifndef NO_MLSTM
            if (u < 64) mlstm_unit(p, u >> 4, (u >> 3) & 1, u & 7, sm, lane);
#endif
        }
        grid.sync();
        {
            ALmod al{p.out, X1C, modv + 3 * 3072, b, NCX};
            EPstore ep{(float*)(p.ws + OFF_XM), 2048};
            gemm_plain(NL, 2048, DM, p.in[29] + 2048, 4096, al, ep, sm);
        }
        grid.sync();
        phase_finish1(p);
        grid.sync();
        {
            ALplain al{(const float*)(p.ws + OFF_H), 2048};
            EPres ep{(float*)(p.ws + OFF_XC), 1024, p.out, X1C, modv + 3 * 3072, b, NCX};
            gemm_plain(NL, DM, 2048, p.in[30], DM, al, ep, sm);
        }
        grid.sync();
        ln_rows((const float*)(p.ws + OFF_XC), NL, p.in[6] + 1024, p.in[7] + 1024, p.out + (size_t)b * NL * DM, nullptr, NCX);
        grid.sync();
    }
}

extern "C" void kernel_launch(void* const* d_in, const int* in_sizes, int n_in, void* d_out, int out_size, void* d_ws, size_t ws_size, hipStream_t stream) {
    static int grid_blocks = 0;
    if (grid_blocks == 0) {
        if (ws_size < WS_NEED || n_in != 46) { fprintf(stderr, "kernel_launch: bad ws_size %zu (need %zu) or n_in %d\n", ws_size, (size_t)WS_NEED, n_in); grid_blocks = -1; return; }
        int dev = 0, cus = 0, per_cu = 0;
        hipGetDevice(&dev);
        hipDeviceGetAttribute(&cus, hipDeviceAttributeMultiprocessorCount, dev);
        hipFuncSetAttribute((const void*)fwd_kernel, hipFuncAttributeMaxDynamicSharedMemorySize, LDS_BYTES);
        hipOccupancyMaxActiveBlocksPerMultiprocessor(&per_cu, (const void*)fwd_kernel, NTHR, LDS_BYTES);
        if (per_cu < 1) { fprintf(stderr, "kernel_launch: occupancy query says %d blocks/CU\n", per_cu); grid_blocks = -1; return; }
        grid_blocks = cus;
    }
    if (grid_blocks < 0) return;
    Params p{};
    for (int i = 0; i < 46; ++i) p.in[i] = (const float*)d_in[i];
    p.out = (float*)d_out; p.ws = (char*)d_ws;
    void* args[] = {&p};
    hipError_t e = hipLaunchCooperativeKernel((const void*)fwd_kernel, dim3(grid_blocks), dim3(NTHR), args, LDS_BYTES, stream);
    if (e != hipSuccess) fprintf(stderr, "cooperative launch failed: %s (grid %d)\n", hipGetErrorString(e), grid_blocks);
}
```

```cpp
#include <hip/hip_runtime.h>
#include <hip/hip_cooperative_groups.h>
#include <cstdio>
#include <cmath>
namespace cg = cooperative_groups;

#define DEV __device__ __forceinline__

constexpr int NB = 2, NL = 8192, DM = 1024, NCX = 256, TB = NCX + NL;
constexpr int EIN = 3872, RW0 = 1568;
constexpr int NTHR = 256;
constexpr float ALPHA = 1.41421356237f;

constexpr size_t OFF_MODV = 0;
constexpr size_t OFF_X1C  = 131072;
constexpr size_t OFF_BON  = 2359296;
constexpr size_t OFF_G16  = 2752512;
constexpr size_t OFF_BIG  = 4194304;
constexpr size_t OFF_P0   = OFF_BIG;
constexpr size_t OFF_YS   = OFF_BIG + (size_t)TB * EIN * 4;
constexpr size_t OFF_XM   = OFF_BIG;
constexpr size_t OFF_XC   = OFF_XM + (size_t)TB * 2048 * 4;
constexpr size_t OFF_H    = OFF_XC + (size_t)TB * 2048 * 4;
constexpr size_t OFF_WT0  = OFF_H + (size_t)NL * 2048 * 4;
constexpr size_t OFF_WT1  = OFF_WT0 + (size_t)3968 * 1024 * 2;
constexpr size_t OFF_WT2  = OFF_WT1 + (size_t)4096 * 1024 * 2;
constexpr size_t OFF_WT3  = OFF_WT2 + (size_t)1024 * 1024 * 2;
constexpr size_t WS_NEED  = OFF_WT3 + (size_t)1024 * 2048 * 2;

constexpr int LDS_BYTES = 135168;

struct Params { const float* in[46]; float* out; char* ws; };
typedef unsigned short bf16_t;
typedef __attribute__((ext_vector_type(8))) short bf16x8;
typedef __attribute__((ext_vector_type(4))) float f32x4;
DEV bf16_t f2bf(float f) { unsigned u = __float_as_uint(f); u += 0x7fffu + ((u >> 16) & 1u); return (bf16_t)(u >> 16); }
DEV unsigned pack2bf(float lo, float hi) { return (unsigned)f2bf(lo) | ((unsigned)f2bf(hi) << 16); }
DEV float bf2f(bf16_t v) { return __uint_as_float(((unsigned)v) << 16); }

DEV float wave_sum(float v) {
#pragma unroll
    for (int o = 32; o > 0; o >>= 1) v += __shfl_xor(v, o, 64);
    return v;
}
DEV float sigmoid_f(float x) { return 1.f / (1.f + expf(-x)); }
DEV float silu_f(float x) { return x / (1.f + expf(-x)); }
DEV float logsig_f(float x) { return fminf(x, 0.f) - log1pf(expf(-fabsf(x))); }
DEV void lds_fence() { asm volatile("" ::: "memory"); }
DEV int scan_s(int dir, int u) { return dir == 0 ? u : (u < NCX ? (NCX - 1 - u) : (TB - 1 + NCX - u)); }
DEV float4 ld4(const float* p) { return *(const float4*)p; }
DEV void st4(float* p, float4 v) { *(float4*)p = v; }

template <class AL, class EP>
DEV void gemm_plain(int M, int N, int K, const float* __restrict__ W, int ldw, AL al, EP ep, float* sm) {
    float (*As)[68] = (float (*)[68])sm;
    float (*Bs)[68] = (float (*)[68])(sm + 16 * 68);
    const int tid = threadIdx.x, tx = tid & 15, ty = tid >> 4;
    const int mt = M / 64, nt = (N + 63) / 64;
    for (int tile = blockIdx.x; tile < mt * nt; tile += gridDim.x) {
        const int tm = tile / nt, tn = tile % nt;
        const int m0 = tm * 64, n0 = tn * 64;
        float acc[4][4];
#pragma unroll
        for (int i = 0; i < 4; ++i)
#pragma unroll
            for (int j = 0; j < 4; ++j) acc[i][j] = 0.f;
        for (int k0 = 0; k0 < K; k0 += 16) {
            {
                const int r = tid >> 2, kq = (tid & 3) * 4;
                float4 a = al(m0 + r, k0 + kq);
                As[kq + 0][r] = a.x; As[kq + 1][r] = a.y; As[kq + 2][r] = a.z; As[kq + 3][r] = a.w;
            }
            {
                const int kk = tid >> 4, c4 = (tid & 15) * 4;
                float4 bq = make_float4(0.f, 0.f, 0.f, 0.f);
                if (n0 + c4 < N) bq = ld4(W + (size_t)(k0 + kk) * ldw + n0 + c4);
                st4(&Bs[kk][c4], bq);
            }
            __syncthreads();
#pragma unroll
            for (int kk = 0; kk < 16; ++kk) {
                float4 a = ld4(&As[kk][ty * 4]);
                float4 bq = ld4(&Bs[kk][tx * 4]);
                float av[4] = {a.x, a.y, a.z, a.w}, bv[4] = {bq.x, bq.y, bq.z, bq.w};
#pragma unroll
                for (int i = 0; i < 4; ++i)
#pragma unroll
                    for (int j = 0; j < 4; ++j) acc[i][j] += av[i] * bv[j];
            }
            __syncthreads();
        }
        if (n0 + tx * 4 < N) {
#pragma unroll
            for (int i = 0; i < 4; ++i) ep(m0 + ty * 4 + i, n0 + tx * 4, make_float4(acc[i][0], acc[i][1], acc[i][2], acc[i][3]));
        }
    }
}


template <class AL, class EP>
DEV void gemm_mfma(int M, int N, int Npad, int K, const bf16_t* Wt, AL al, EP ep, float* smf) {
    constexpr int LDT = 40;
    bf16_t* As = (bf16_t*)smf;
    bf16_t* Bs = As + 2 * 128 * LDT;
    const int tid = threadIdx.x, lane = tid & 63, wave = tid >> 6, wm = wave & 1, wn = wave >> 1;
    const int mt = M / 128, nt = Npad / 128, nks = K / 32;
    const int lr = tid >> 1, lk = (tid & 1) * 16;
    for (int tile = blockIdx.x; tile < mt * nt; tile += gridDim.x) {
        const int tm = tile / nt, tn = tile % nt, m0 = tm * 128, n0 = tn * 128;
        f32x4 acc[4][4];
#pragma unroll
        for (int i = 0; i < 4; ++i)
#pragma unroll
            for (int j = 0; j < 4; ++j) acc[i][j] = (f32x4){0.f, 0.f, 0.f, 0.f};
        float4 ra[4]; uint4 rb0, rb1;
        const bf16_t* wrow = Wt + (size_t)(n0 + lr) * K + lk;
#pragma unroll
        for (int i = 0; i < 4; ++i) ra[i] = al(m0 + lr, lk + i * 4);
        rb0 = *(const uint4*)(wrow); rb1 = *(const uint4*)(wrow + 8);
        __syncthreads();
        {
            uint4 w0 = make_uint4(pack2bf(ra[0].x, ra[0].y), pack2bf(ra[0].z, ra[0].w), pack2bf(ra[1].x, ra[1].y), pack2bf(ra[1].z, ra[1].w));
            uint4 w1 = make_uint4(pack2bf(ra[2].x, ra[2].y), pack2bf(ra[2].z, ra[2].w), pack2bf(ra[3].x, ra[3].y), pack2bf(ra[3].z, ra[3].w));
            *(uint4*)(As + lr * LDT + lk) = w0; *(uint4*)(As + lr * LDT + lk + 8) = w1;
            *(uint4*)(Bs + lr * LDT + lk) = rb0; *(uint4*)(Bs + lr * LDT + lk + 8) = rb1;
        }
        __syncthreads();
#pragma unroll 1
        for (int ks = 0; ks < nks; ++ks) {
            const int buf = ks & 1;
            if (ks + 1 < nks) {
                const int k1 = (ks + 1) * 32;
#pragma unroll
                for (int i = 0; i < 4; ++i) ra[i] = al(m0 + lr, k1 + lk + i * 4);
                rb0 = *(const uint4*)(wrow + k1); rb1 = *(const uint4*)(wrow + k1 + 8);
            }
            const bf16_t* Ab = As + buf * 128 * LDT; const bf16_t* Bb = Bs + buf * 128 * LDT;
            bf16x8 wf[4], af[4];
#pragma unroll
            for (int i = 0; i < 4; ++i) wf[i] = *(const bf16x8*)(Bb + (wn * 64 + i * 16 + (lane & 15)) * LDT + (lane >> 4) * 8);
#pragma unroll
            for (int j = 0; j < 4; ++j) af[j] = *(const bf16x8*)(Ab + (wm * 64 + j * 16 + (lane & 15)) * LDT + (lane >> 4) * 8);
#pragma unroll
            for (int i = 0; i < 4; ++i)
#pragma unroll
                for (int j = 0; j < 4; ++j) acc[i][j] = __builtin_amdgcn_mfma_f32_16x16x32_bf16(wf[i], af[j], acc[i][j], 0, 0, 0);
            if (ks + 1 < nks) {
                bf16_t* An = As + (buf ^ 1) * 128 * LDT; bf16_t* Bn = Bs + (buf ^ 1) * 128 * LDT;
                uint4 w0 = make_uint4(pack2bf(ra[0].x, ra[0].y), pack2bf(ra[0].z, ra[0].w), pack2bf(ra[1].x, ra[1].y), pack2bf(ra[1].z, ra[1].w));
                uint4 w1 = make_uint4(pack2bf(ra[2].x, ra[2].y), pack2bf(ra[2].z, ra[2].w), pack2bf(ra[3].x, ra[3].y), pack2bf(ra[3].z, ra[3].w));
                *(uint4*)(An + lr * LDT + lk) = w0; *(uint4*)(An + lr * LDT + lk + 8) = w1;
                *(uint4*)(Bn + lr * LDT + lk) = rb0; *(uint4*)(Bn + lr * LDT + lk + 8) = rb1;
            }
            __syncthreads();
        }
#pragma unroll
        for (int i = 0; i < 4; ++i) {
            const int n = n0 + wn * 64 + i * 16 + (lane >> 4) * 4;
            if (n < N) {
#pragma unroll
                for (int j = 0; j < 4; ++j) {
                    const int m = m0 + wm * 64 + j * 16 + (lane & 15);
                    ep(m, n, make_float4(acc[i][j][0], acc[i][j][1], acc[i][j][2], acc[i][j][3]));
                }
            }
        }
    }
}

DEV void transpose_convert(const float* __restrict__ W, int K, int N, int Npad, bf16_t* Wt, float* sm) {
    float (*T)[65] = (float (*)[65])sm;
    const int tid = threadIdx.x;
    const int kt = K / 64, ntl = Npad / 64;
    for (int tile = blockIdx.x; tile < kt * ntl; tile += gridDim.x) {
        const int k0 = (tile / ntl) * 64, n0 = (tile % ntl) * 64;
        __syncthreads();
#pragma unroll
        for (int i = 0; i < 4; ++i) {
            const int k = (tid >> 4) + 16 * i, n4 = (tid & 15) * 4;
            float4 v = make_float4(0.f, 0.f, 0.f, 0.f);
            if (n0 + n4 < N) v = ld4(W + (size_t)(k0 + k) * N + n0 + n4);
            T[k][n4] = v.x; T[k][n4 + 1] = v.y; T[k][n4 + 2] = v.z; T[k][n4 + 3] = v.w;
        }
        __syncthreads();
        const int n = tid >> 2, kq = (tid & 3) * 16;
        unsigned o[8];
#pragma unroll
        for (int j = 0; j < 8; ++j) o[j] = pack2bf(T[kq + 2 * j][n], T[kq + 2 * j + 1][n]);
        bf16_t* dst = Wt + (size_t)(n0 + n) * K + k0 + kq;
        *(uint4*)dst = make_uint4(o[0], o[1], o[2], o[3]); *(uint4*)(dst + 8) = make_uint4(o[4], o[5], o[6], o[7]);
    }
}

struct ALmod {
    const float* lat; const float* cx; const float* mv; int b; int s0;
    DEV float4 operator()(int r, int k) const {
        const int s = r + s0;
        const float* src; int j;
        if (s < NCX) { src = cx + ((size_t)(b * NCX + s)) * DM + k; j = 2; }
        else { src = lat + ((size_t)(b * NL + s - NCX)) * DM + k; j = b; }
        float4 a = ld4(src);
        const float* m = mv + j * 3072;
        float4 sh = ld4(m + k), sc = ld4(m + 1024 + k);
        return make_float4(a.x * (1.f + sc.x) + sh.x, a.y * (1.f + sc.y) + sh.y, a.z * (1.f + sc.z) + sh.z, a.w * (1.f + sc.w) + sh.w);
    }
};
struct ALplain { const float* A; int lda; DEV float4 operator()(int r, int k) const { return ld4(A + (size_t)r * lda + k); } };
struct EPstore { float* C; int ldc; DEV void operator()(int r, int c, float4 v) const { st4(C + (size_t)r * ldc + c, v); } };
struct EPres {
    float* C; int ldc; const float* lat; const float* cx; const float* mv; int b; int s0;
    DEV void operator()(int r, int c, float4 v) const {
        const int s = r + s0;
        const float* src; int j;
        if (s < NCX) { src = cx + ((size_t)(b * NCX + s)) * DM + c; j = 2; }
        else { src = lat + ((size_t)(b * NL + s - NCX)) * DM + c; j = b; }
        float4 x = ld4(src);
        float4 g = ld4(mv + j * 3072 + 2048 + c);
        st4(C + (size_t)r * ldc + c, make_float4(ALPHA * x.x + g.x * v.x, ALPHA * x.y + g.y * v.y, ALPHA * x.z + g.z * v.z, ALPHA * x.w + g.w * v.w));
    }
};

DEV void phase_mod(const Params& p, float* sm) {
    const float* c = p.in[1]; const float* cctx = p.in[3];
    const float* mod_w = p.in[4]; const float* mod_b = p.in[5];
    float* modv = (float*)(p.ws + OFF_MODV);
    float* sil = sm; float* red = sm + 3072;
    const int tid = threadIdx.x;
    for (int i = tid; i < 3072; i += NTHR) {
        const int j = i >> 10, k = i & 1023;
        const float v = (j < 2) ? c[j * 1024 + k] : cctx[k];
        sil[i] = silu_f(v);
    }
    __syncthreads();
    for (int unit = blockIdx.x; unit < 192; unit += gridDim.x) {
        const int l = unit / 96, cb = unit % 96;
        const int kg = tid >> 5, col = tid & 31, n = cb * 32 + col;
        const float* w = mod_w + (size_t)l * 1024 * 3072 + n;
        float a0 = 0.f, a1 = 0.f, a2 = 0.f;
        for (int k = kg * 128; k < kg * 128 + 128; ++k) {
            const float wv = w[(size_t)k * 3072];
            a0 += sil[k] * wv; a1 += sil[1024 + k] * wv; a2 += sil[2048 + k] * wv;
        }
        red[(kg * 3 + 0) * 32 + col] = a0; red[(kg * 3 + 1) * 32 + col] = a1; red[(kg * 3 + 2) * 32 + col] = a2;
        __syncthreads();
        if (tid < 96) {
            const int j = tid >> 5, cc = tid & 31, nn = cb * 32 + cc;
            float s = mod_b[l * 3072 + nn];
            for (int g = 0; g < 8; ++g) s += red[(g * 3 + j) * 32 + cc];
            modv[(l * 3 + j) * 3072 + nn] = s;
        }
        __syncthreads();
    }
}

DEV float rw_mix(const float* P0, int s, int c, const float* __restrict__ mu) {
    const float own = P0[(size_t)s * EIN + RW0 + c];
    const int d = c & 3;
    int ns = -1;
    if (s < NCX) {
        if (d == 0) ns = (s > 0) ? s - 1 : -1;
        else if (d == 1) ns = (s < NCX - 1) ? s + 1 : -1;
    } else {
        const int n = s - NCX, rr = n >> 6, cc = n & 63;
        if (d == 0) ns = (cc > 0) ? s - 1 : -1;
        else if (d == 1) ns = (cc < 63) ? s + 1 : -1;
        else if (d == 2) ns = (rr > 0) ? s - 64 : -1;
        else ns = (rr < 127) ? s + 64 : -1;
    }
    const float nb = (ns >= 0) ? P0[(size_t)ns * EIN + RW0 + c] : 0.f;
    return own + (nb - own) * mu[c];
}

DEV void rwkv_unit(const Params& p, int h, int dir, float* sm, int lane) {
    const float* P0 = (const float*)(p.ws + OFF_P0);
    float* YS = (float*)(p.ws + OFF_YS);
    float* BON = (float*)(p.ws + OFF_BON);
    const float* mu = p.in[15];
    const float* w0 = p.in[dir ? 18 : 16]; const float* ww2 = p.in[dir ? 19 : 17];
    const float* a0 = p.in[dir ? 22 : 20]; const float* wa2 = p.in[dir ? 23 : 21];
    const float* k_k = p.in[24]; const float* k_a = p.in[25]; const float* r_k = p.in[26];
    float* sR = sm; float* sW = sm + 4096; float* sK = sm + 8192; float* sA = sm + 12288; float* sB = sm + 16384; float* sV = sm + 20480;
    const int hc = h * 64 + lane;
    const float w0j = w0[hc], a0j = a0[hc], kkj = k_k[hc], kaj = k_a[hc], rkj = r_k[hc];
    float S[64];
#pragma unroll
    for (int k = 0; k < 64; ++k) S[k] = 0.f;
    const int cwl = 2048 + dir * 64, cal = 2176 + dir * 64;
#pragma unroll 1
    for (int cu = 0; cu < TB / 64; ++cu) {
        lds_fence();
#pragma unroll 1
        for (int t = 0; t < 64; ++t) {
            const int s = scan_s(dir, cu * 64 + t);
            sR[t * 64 + lane] = rw_mix(P0, s, h * 64 + lane, mu);
            sK[t * 64 + lane] = rw_mix(P0, s, 512 + h * 64 + lane, mu);
            sV[t * 64 + lane] = rw_mix(P0, s, 1024 + h * 64 + lane, mu);
            sA[t * 64 + lane] = tanhf(rw_mix(P0, s, cwl + lane, mu));
            sB[t * 64 + lane] = rw_mix(P0, s, cal + lane, mu);
        }
        lds_fence();
        {
            const float* pw2 = ww2 + hc; asm volatile("" : "+v"(pw2));
            float wc[64];
#pragma unroll
            for (int i = 0; i < 64; ++i) wc[i] = pw2[i * 512];
#pragma unroll 1
            for (int t = 0; t < 64; ++t) {
                float accw = w0j;
#pragma unroll
                for (int i4 = 0; i4 < 16; ++i4) {
                    const float4 x = ld4(&sA[t * 64 + i4 * 4]);
                    accw += x.x * wc[i4 * 4] + x.y * wc[i4 * 4 + 1] + x.z * wc[i4 * 4 + 2] + x.w * wc[i4 * 4 + 3];
                }
                sW[t * 64 + lane] = expf(-0.6065306597f * sigmoid_f(accw));
            }
        }
        lds_fence();
        {
            const float* pa2 = wa2 + hc; asm volatile("" : "+v"(pa2));
            float ac[64];
#pragma unroll
            for (int i = 0; i < 64; ++i) ac[i] = pa2[i * 512];
#pragma unroll 1
            for (int t = 0; t < 64; ++t) {
                float acca = a0j;
#pragma unroll
                for (int i4 = 0; i4 < 16; ++i4) {
                    const float4 y = ld4(&sB[t * 64 + i4 * 4]);
                    acca += y.x * ac[i4 * 4] + y.y * ac[i4 * 4 + 1] + y.z * ac[i4 * 4 + 2] + y.w * ac[i4 * 4 + 3];
                }
                const float av = sigmoid_f(acca);
                const float kraw = sK[t * 64 + lane];
                const float kkv = kraw * kkj;
                const float ss = wave_sum(kkv * kkv);
                const float kk = kkv * rsqrtf(fmaxf(ss, 1e-24f));
                const float kh = kraw * (1.f + (av - 1.f) * kaj);
                const float r = sR[t * 64 + lane];
                const float bon = wave_sum(r * kh * rkj);
                lds_fence();
                sK[t * 64 + lane] = kh; sA[t * 64 + lane] = -kk; sB[t * 64 + lane] = kk * av;
                if (lane == 0) { const int s = scan_s(dir, cu * 64 + t); atomicAdd(&BON[s * 8 + h], bon); }
            }
        }
        lds_fence();
#pragma unroll 1
        for (int t = 0; t < 64; ++t) {
            const float vi = sV[t * 64 + lane];
            float sa = 0.f;
#pragma unroll
            for (int k4 = 0; k4 < 16; ++k4) {
                const float4 a4 = ld4(&sA[t * 64 + k4 * 4]);
                sa += S[k4 * 4] * a4.x + S[k4 * 4 + 1] * a4.y + S[k4 * 4 + 2] * a4.z + S[k4 * 4 + 3] * a4.w;
            }
            __builtin_amdgcn_sched_barrier(0);
            float y = 0.f;
#pragma unroll
            for (int k4 = 0; k4 < 16; ++k4) {
                const float4 w4 = ld4(&sW[t * 64 + k4 * 4]);
                const float4 b4 = ld4(&sB[t * 64 + k4 * 4]);
                const float4 h4 = ld4(&sK[t * 64 + k4 * 4]);
                const float4 r4 = ld4(&sR[t * 64 + k4 * 4]);
                S[k4 * 4 + 0] = S[k4 * 4 + 0] * w4.x + sa * b4.x + vi * h4.x;
                S[k4 * 4 + 1] = S[k4 * 4 + 1] * w4.y + sa * b4.y + vi * h4.y;
                S[k4 * 4 + 2] = S[k4 * 4 + 2] * w4.z + sa * b4.z + vi * h4.z;
                S[k4 * 4 + 3] = S[k4 * 4 + 3] * w4.w + sa * b4.w + vi * h4.w;
                y += S[k4 * 4] * r4.x + S[k4 * 4 + 1] * r4.y + S[k4 * 4 + 2] * r4.z + S[k4 * 4 + 3] * r4.w;
                if ((k4 & 3) == 3) __builtin_amdgcn_sched_barrier(0);
            }
            const int s = scan_s(dir, cu * 64 + t);
            atomicAdd(&YS[(size_t)s * 1024 + 512 + h * 64 + lane], y);
        }
    }
}

DEV void gla_unit(const Params& p, int h, int dir, int half, float* sm, int lane) {
    const float* P0 = (const float*)(p.ws + OFF_P0);
    float* YS = (float*)(p.ws + OFF_YS);
    const float* wa2 = p.in[dir ? 12 : 10]; const float* ba = p.in[dir ? 13 : 11];
    float* sQ = sm; float* sKg = sm + 4096; float* sAg = sm + 8192; float* sVg = sm + 12288; float* sLR = sm + 16384;
    const int hc = h * 64 + lane;
    float wcol[16];
#pragma unroll
    for (int i = 0; i < 16; ++i) wcol[i] = wa2[i * 256 + hc];
    const float baj = ba[hc];
    float S[64];
#pragma unroll
    for (int k = 0; k < 64; ++k) S[k] = 0.f;
#pragma unroll 1
    for (int cu = 0; cu < TB / 64; ++cu) {
        lds_fence();
#pragma unroll 1
        for (int t = 0; t < 64; ++t) {
            const int s = scan_s(dir, cu * 64 + t);
            const float* row = P0 + (size_t)s * EIN;
            sQ[t * 64 + lane] = row[h * 64 + lane] * 0.125f;
            sKg[t * 64 + lane] = row[256 + h * 64 + lane];
            sVg[t * 64 + lane] = row[512 + h * 128 + half * 64 + lane];
            if (lane < 16) sLR[t * 16 + lane] = row[1536 + dir * 16 + lane];
        }
        lds_fence();
#pragma unroll 1
        for (int t = 0; t < 64; ++t) {
            float x = baj;
#pragma unroll
            for (int i4 = 0; i4 < 4; ++i4) {
                const float4 l4 = ld4(&sLR[t * 16 + i4 * 4]);
                x += l4.x * wcol[i4 * 4] + l4.y * wcol[i4 * 4 + 1] + l4.z * wcol[i4 * 4 + 2] + l4.w * wcol[i4 * 4 + 3];
            }
            sAg[t * 64 + lane] = expf(logsig_f(x) * 0.0625f);
        }
        lds_fence();
#pragma unroll 1
        for (int t = 0; t < 64; ++t) {
            const float vv = sVg[t * 64 + lane];
            float o = 0.f;
#pragma unroll
            for (int k4 = 0; k4 < 16; ++k4) {
                const float4 a4 = ld4(&sAg[t * 64 + k4 * 4]);
                const float4 kk4 = ld4(&sKg[t * 64 + k4 * 4]);
                const float4 q4 = ld4(&sQ[t * 64 + k4 * 4]);
                S[k4 * 4 + 0] = a4.x * S[k4 * 4 + 0] + kk4.x * vv;
                S[k4 * 4 + 1] = a4.y * S[k4 * 4 + 1] + kk4.y * vv;
                S[k4 * 4 + 2] = a4.z * S[k4 * 4 + 2] + kk4.z * vv;
                S[k4 * 4 + 3] = a4.w * S[k4 * 4 + 3] + kk4.w * vv;
                o += q4.x * S[k4 * 4] + q4.y * S[k4 * 4 + 1] + q4.z * S[k4 * 4 + 2] + q4.w * S[k4 * 4 + 3];
            }
            const int s = scan_s(dir, cu * 64 + t);
            atomicAdd(&YS[(size_t)s * 1024 + h * 128 + half * 64 + lane], o);
        }
    }
}

DEV void phase_finish0(const Params& p) {
    const float* P0 = (const float*)(p.ws + OFF_P0);
    float* YS = (float*)(p.ws + OFF_YS);
    const float* BON = (const float*)(p.ws + OFF_BON);
    const float* mu = p.in[15];
    const float* gla_ng = p.in[14]; const float* gn_g = p.in[27]; const float* gn_b = p.in[28];
    const int lane = threadIdx.x & 63, gw = blockIdx.x * 4 + (threadIdx.x >> 6), ngw = gridDim.x * 4;
    for (int s = gw; s < TB; s += ngw) {
        float* ys = YS + (size_t)s * 1024;
        const float* row = P0 + (size_t)s * EIN;
#pragma unroll 1
        for (int h = 0; h < 4; ++h) {
            const float o0 = ys[h * 128 + lane], o1 = ys[h * 128 + 64 + lane];
            const float ss = wave_sum(o0 * o0 + o1 * o1);
            const float rms = rsqrtf(ss * (1.f / 128.f) + 1e-5f);
            const float g0 = row[1024 + h * 128 + lane], g1 = row[1024 + h * 128 + 64 + lane];
            ys[h * 128 + lane] = o0 * rms * gla_ng[lane] * silu_f(g0);
            ys[h * 128 + 64 + lane] = o1 * rms * gla_ng[64 + lane] * silu_f(g1);
        }
#pragma unroll 1
        for (int h = 0; h < 8; ++h) {
            const float yv = ys[512 + h * 64 + lane];
            const float mean = wave_sum(yv) * (1.f / 64.f);
            const float d = yv - mean;
            const float var = wave_sum(d * d) * (1.f / 64.f);
            const float yn = d * rsqrtf(var + 64e-5f);
            const float vmix = rw_mix(P0, s, 1024 + h * 64 + lane, mu);
            const float gmix = rw_mix(P0, s, 1536 + h * 64 + lane, mu);
            const float o = yn * gn_g[h * 64 + lane] + gn_b[h * 64 + lane] + BON[s * 8 + h] * vmix;
            ys[512 + h * 64 + lane] = o * silu_f(gmix);
        }
    }
}

DEV void ln_rows(const float* src, int nrows, const float* __restrict__ g, const float* __restrict__ bt, float* dst_lat, float* dst_cx, int s0) {
    const int lane = threadIdx.x & 63, gw = blockIdx.x * 4 + (threadIdx.x >> 6), ngw = gridDim.x * 4;
    for (int r = gw; r < nrows; r += ngw) {
        const float* x = src + (size_t)r * 1024;
        float4 v[4];
        float sum = 0.f;
#pragma unroll
        for (int i = 0; i < 4; ++i) { v[i] = ld4(x + i * 256 + lane * 4); sum += v[i].x + v[i].y + v[i].z + v[i].w; }
        const float mean = wave_sum(sum) * (1.f / 1024.f);
        float sq = 0.f;
#pragma unroll
        for (int i = 0; i < 4; ++i) {
            v[i].x -= mean; v[i].y -= mean; v[i].z -= mean; v[i].w -= mean;
            sq += v[i].x * v[i].x + v[i].y * v[i].y + v[i].z * v[i].z + v[i].w * v[i].w;
        }
        const float rstd = rsqrtf(wave_sum(sq) * (1.f / 1024.f) + 1e-5f);
        const int s = r + s0;
        float* d = (s < NCX) ? (dst_cx + (size_t)s * 1024) : (dst_lat + (size_t)(s - NCX) * 1024);
#pragma unroll
        for (int i = 0; i < 4; ++i) {
            const int c = i * 256 + lane * 4;
            const float4 gg = ld4(g + c), bb = ld4(bt + c);
            st4(d + c, make_float4(v[i].x * rstd * gg.x + bb.x, v[i].y * rstd * gg.y + bb.y, v[i].z * rstd * gg.z + bb.z, v[i].w * rstd * gg.w + bb.w));
        }
    }
}

DEV void phase_conv1(const Params& p) {
    const float* XM = (const float*)(p.ws + OFF_XM);
    float* XC = (float*)(p.ws + OFF_XC);
    float* G16 = (float*)(p.ws + OFF_G16);
    const float* cw = p.in[31]; const float* cbias = p.in[32];
    const float* wq = p.in[33]; const float* wk = p.in[34]; const float* wv = p.in[35];
    const float* gw4[4] = {p.in[36], p.in[38], p.in[40], p.in[42]};
    const float* gb4[4] = {p.in[37], p.in[39], p.in[41], p.in[43]};
    const int lane = threadIdx.x & 63, gwv = blockIdx.x * 4 + (threadIdx.x >> 6), ngw = gridDim.x * 4;
    for (int s = gwv; s < TB; s += ngw) {
        int nrow[9];
#pragma unroll
        for (int i = 0; i < 3; ++i)
#pragma unroll
            for (int j = 0; j < 3; ++j) {
                int ns = -1;
                if (s < NCX) { const int w2 = s + j - 1; if (i == 1 && w2 >= 0 && w2 < NCX) ns = w2; }
                else { const int n = s - NCX, rr = (n >> 6) + i - 1, w2 = (n & 63) + j - 1; if (rr >= 0 && rr < 128 && w2 >= 0 && w2 < 64) ns = NCX + rr * 64 + w2; }
                nrow[i * 3 + j] = ns;
            }
        float acc[16];
#pragma unroll
        for (int g = 0; g < 16; ++g) acc[g] = 0.f;
#pragma unroll 1
        for (int m = 0; m < 8; ++m) {
            const int blk = lane + 64 * m, c0 = blk * 4;
            float4 a = ld4(cbias + c0);
            float4 xmc = make_float4(0.f, 0.f, 0.f, 0.f);
#pragma unroll
            for (int tap = 0; tap < 9; ++tap) {
                if (nrow[tap] >= 0) {
                    const float4 xv = ld4(XM + (size_t)nrow[tap] * 2048 + c0);
                    const float4 w4 = ld4(cw + tap * 2048 + c0);
                    a.x += xv.x * w4.x; a.y += xv.y * w4.y; a.z += xv.z * w4.z; a.w += xv.w * w4.w;
                    if (tap == 4) xmc = xv;
                }
            }
            const float xc[4] = {silu_f(a.x), silu_f(a.y), silu_f(a.z), silu_f(a.w)};
            st4(XC + (size_t)s * 2048 + c0, make_float4(xc[0], xc[1], xc[2], xc[3]));
            const float xm[4] = {xmc.x, xmc.y, xmc.z, xmc.w};
            float q[4], k[4], v[4];
#pragma unroll
            for (int d = 0; d < 4; ++d) {
                float qa = 0.f, ka = 0.f, va = 0.f;
#pragma unroll
                for (int c = 0; c < 4; ++c) {
                    qa += xc[c] * wq[blk * 16 + c * 4 + d];
                    ka += xc[c] * wk[blk * 16 + c * 4 + d];
                    va += xm[c] * wv[blk * 16 + c * 4 + d];
                }
                q[d] = qa; k[d] = ka; v[d] = va;
            }
#pragma unroll
            for (int d = 0; d < 4; ++d) {
                const int ch = c0 + d;
#pragma unroll
                for (int gm = 0; gm < 4; ++gm) {
                    const float4 wq4 = ld4(gw4[gm] + (size_t)ch * 4);
                    const float4 wk4 = ld4(gw4[gm] + (size_t)(2048 + ch) * 4);
                    const float4 wv4 = ld4(gw4[gm] + (size_t)(4096 + ch) * 4);
                    acc[gm * 4 + 0] += q[d] * wq4.x + k[d] * wk4.x + v[d] * wv4.x;
                    acc[gm * 4 + 1] += q[d] * wq4.y + k[d] * wk4.y + v[d] * wv4.y;
                    acc[gm * 4 + 2] += q[d] * wq4.z + k[d] * wk4.z + v[d] * wv4.z;
                    acc[gm * 4 + 3] += q[d] * wq4.w + k[d] * wk4.w + v[d] * wv4.w;
                }
            }
        }
#pragma unroll
        for (int g = 0; g < 16; ++g) acc[g] = wave_sum(acc[g]);
        if (lane == 0) {
#pragma unroll
            for (int gm = 0; gm < 4; ++gm)
#pragma unroll
                for (int hh = 0; hh < 4; ++hh) {
                    float val = acc[gm * 4 + hh] + gb4[gm][hh];
                    if (gm & 1) val = logsig_f(val);
                    G16[(size_t)s * 16 + gm * 4 + hh] = val;
                }
        }
    }
}

DEV void mlstm_unit(const Params& p, int h, int dir, int rb, float* sm, int lane) {
    const float* XM = (const float*)(p.ws + OFF_XM);
    const float* XC = (const float*)(p.ws + OFF_XC);
    const float* G16 = (const float*)(p.ws + OFF_G16);
    float* H = (float*)(p.ws + OFF_H);
    const float* wq = p.in[33]; const float* wk = p.in[34]; const float* wv = p.in[35];
    float4* C = (float4*)sm;
    float* sq = sm + 32768; float* sk = sq + 512;
#pragma unroll 1
    for (int k4 = 0; k4 < 128; ++k4) C[k4 * 64 + lane] = make_float4(0.f, 0.f, 0.f, 0.f);
    float nst[8];
#pragma unroll
    for (int j = 0; j < 8; ++j) nst[j] = 0.f;
    float m = -INFINITY;
    const int ch = h * 512 + rb * 64 + lane;
    const int vb = ch >> 2, vd = ch & 3;
    float wvr[4];
#pragma unroll
    for (int c = 0; c < 4; ++c) wvr[c] = wv[vb * 16 + c * 4 + vd];
    const int qb0 = h * 128 + lane * 2;
    float wqr[32], wkr[32];
#pragma unroll
    for (int i = 0; i < 32; ++i) { wqr[i] = wq[qb0 * 16 + i]; wkr[i] = wk[qb0 * 16 + i]; }
    float4 x0, x1, xm4; float gi, lf;
    {
        const int s = scan_s(dir, 0);
        x0 = ld4(XC + (size_t)s * 2048 + h * 512 + lane * 8); x1 = ld4(XC + (size_t)s * 2048 + h * 512 + lane * 8 + 4);
        xm4 = ld4(XM + (size_t)s * 2048 + vb * 4);
        gi = G16[(size_t)s * 16 + dir * 8 + h]; lf = G16[(size_t)s * 16 + dir * 8 + 4 + h];
    }
#pragma unroll 1
    for (int u = 0; u < TB; ++u) {
        const int s = scan_s(dir, u);
        const float4 cx0 = x0, cx1 = x1, cxm = xm4; const float cgi = gi, clf = lf;
        if (u + 1 < TB) {
            const int s2 = scan_s(dir, u + 1);
            x0 = ld4(XC + (size_t)s2 * 2048 + h * 512 + lane * 8); x1 = ld4(XC + (size_t)s2 * 2048 + h * 512 + lane * 8 + 4);
            xm4 = ld4(XM + (size_t)s2 * 2048 + vb * 4);
            gi = G16[(size_t)s2 * 16 + dir * 8 + h]; lf = G16[(size_t)s2 * 16 + dir * 8 + 4 + h];
        }
        const float xa[8] = {cx0.x, cx0.y, cx0.z, cx0.w, cx1.x, cx1.y, cx1.z, cx1.w};
        float q[8], k[8];
#pragma unroll
        for (int bb = 0; bb < 2; ++bb)
#pragma unroll
            for (int d = 0; d < 4; ++d) {
                float qa = 0.f, ka = 0.f;
#pragma unroll
                for (int c = 0; c < 4; ++c) { qa += xa[bb * 4 + c] * wqr[bb * 16 + c * 4 + d]; ka += xa[bb * 4 + c] * wkr[bb * 16 + c * 4 + d]; }
                q[bb * 4 + d] = qa; k[bb * 4 + d] = ka * 0.04419417382f;
            }
        lds_fence();
        st4(sq + lane * 8, make_float4(q[0], q[1], q[2], q[3])); st4(sq + lane * 8 + 4, make_float4(q[4], q[5], q[6], q[7]));
        st4(sk + lane * 8, make_float4(k[0], k[1], k[2], k[3])); st4(sk + lane * 8 + 4, make_float4(k[4], k[5], k[6], k[7]));
        lds_fence();
        const float v = cxm.x * wvr[0] + cxm.y * wvr[1] + cxm.z * wvr[2] + cxm.w * wvr[3];
        const float mn = fmaxf(clf + m, cgi);
        const float fp = expf(clf + m - mn), ip = expf(cgi - mn);
        m = mn;
        float dl = 0.f;
#pragma unroll
        for (int j = 0; j < 8; ++j) { nst[j] = fp * nst[j] + ip * k[j]; dl += nst[j] * q[j]; }
        const float den = wave_sum(dl);
        const float ipv = ip * v;
        float num = 0.f;
#pragma unroll 4
        for (int k4 = 0; k4 < 128; ++k4) {
            float4 c4 = C[k4 * 64 + lane];
            const float4 kq = ld4(sk + k4 * 4), qq = ld4(sq + k4 * 4);
            c4.x = fp * c4.x + ipv * kq.x; c4.y = fp * c4.y + ipv * kq.y; c4.z = fp * c4.z + ipv * kq.z; c4.w = fp * c4.w + ipv * kq.w;
            num += c4.x * qq.x + c4.y * qq.y + c4.z * qq.z + c4.w * qq.w;
            C[k4 * 64 + lane] = c4;
        }
        const float hval = num / fmaxf(fabsf(den), expf(-m));
        if (s >= NCX) atomicAdd(&H[(size_t)(s - NCX) * 2048 + ch], hval);
    }
}

DEV void phase_finish1(const Params& p) {
    float* H = (float*)(p.ws + OFF_H);
    const float* XC = (const float*)(p.ws + OFF_XC);
    const float* Z = (const float*)(p.ws + OFF_XM);
    const float* ng = p.in[44]; const float* skip = p.in[45];
    const int lane = threadIdx.x & 63, gw = blockIdx.x * 4 + (threadIdx.x >> 6), ngw = gridDim.x * 4;
    for (int it = gw; it < NL * 4; it += ngw) {
        const int n = it >> 2, h = it & 3;
        float* hp = H + (size_t)n * 2048 + h * 512 + lane * 8;
        float4 a = ld4(hp), b2 = ld4(hp + 4);
        float v[8] = {a.x, a.y, a.z, a.w, b2.x, b2.y, b2.z, b2.w};
        float sum = 0.f;
#pragma unroll
        for (int j = 0; j < 8; ++j) sum += v[j];
        const float mean = wave_sum(sum) * (1.f / 512.f);
        float sq = 0.f;
#pragma unroll
        for (int j = 0; j < 8; ++j) { v[j] -= mean; sq += v[j] * v[j]; }
        const float rstd = rsqrtf(wave_sum(sq) * (1.f / 512.f) + 1e-5f);
        const int c0 = h * 512 + lane * 8;
        const float* xc = XC + (size_t)(NCX + n) * 2048 + c0;
        const float* z = Z + (size_t)n * 2048 + c0;
        float o[8];
#pragma unroll
        for (int j = 0; j < 8; ++j) o[j] = (v[j] * rstd * ng[c0 + j] + skip[c0 + j] * xc[j]) * silu_f(z[j]);
        st4(hp, make_float4(o[0], o[1], o[2], o[3])); st4(hp + 4, make_float4(o[4], o[5], o[6], o[7]));
    }
}

DEV void zero_f4(float* ptr, size_t nfloat) {
    const size_t n4 = nfloat / 4;
    for (size_t i = (size_t)blockIdx.x * NTHR + threadIdx.x; i < n4; i += (size_t)gridDim.x * NTHR) ((float4*)ptr)[i] = make_float4(0.f, 0.f, 0.f, 0.f);
}

__global__ void __launch_bounds__(NTHR) fwd_kernel(Params p) {
    extern __shared__ __attribute__((aligned(16))) float sm[];
    cg::grid_group grid = cg::this_grid();
    const int tid = threadIdx.x, lane = tid & 63, wave = tid >> 6;
    float* modv = (float*)(p.ws + OFF_MODV);
    float* X1C = (float*)(p.ws + OFF_X1C);

    phase_mod(p, sm);
    transpose_convert(p.in[8], 1024, EIN, 3968, (bf16_t*)(p.ws + OFF_WT0), sm);
    transpose_convert(p.in[29], 1024, 4096, 4096, (bf16_t*)(p.ws + OFF_WT1), sm);
    transpose_convert(p.in[9], 1024, 1024, 1024, (bf16_t*)(p.ws + OFF_WT2), sm);
    transpose_convert(p.in[30], 2048, 1024, 1024, (bf16_t*)(p.ws + OFF_WT3), sm);
    grid.sync();

#pragma unroll 1
    for (int b = 0; b < NB; ++b) {
        {
            ALmod al{p.in[0], p.in[2], modv, b, 0};
            EPstore ep{(float*)(p.ws + OFF_P0), EIN};
            gemm_mfma(TB, EIN, 3968, DM, (const bf16_t*)(p.ws + OFF_WT0), al, ep, sm);
            zero_f4((float*)(p.ws + OFF_YS), (size_t)TB * 1024);
            zero_f4((float*)(p.ws + OFF_BON), (size_t)TB * 8);
        }
        grid.sync();
        if (wave == 0) {
            const int u = blockIdx.x;
            #ifndef NO_RWKV
            if (u < 16) rwkv_unit(p, u >> 1, u & 1, sm, lane);
#endif
            #ifndef NO_GLA
            if (u >= 16 && u < 32) { const int v = u - 16; gla_unit(p, v >> 2, (v >> 1) & 1, v & 1, sm, lane); }
#endif
        }
        grid.sync();
        phase_finish0(p);
        grid.sync();
        {
            ALplain al{(const float*)(p.ws + OFF_YS), 1024};
            EPres ep{(float*)(p.ws + OFF_P0), 1024, p.in[0], p.in[2], modv, b, 0};
            gemm_mfma(TB, DM, DM, DM, (const bf16_t*)(p.ws + OFF_WT2), al, ep, sm);
        }
        grid.sync();
        ln_rows((const float*)(p.ws + OFF_P0), TB, p.in[6], p.in[7], p.out + (size_t)b * NL * DM, X1C + (size_t)b * NCX * DM, 0);
        grid.sync();
        {
            ALmod al{p.out, X1C, modv + 3 * 3072, b, 0};
            EPstore ep{(float*)(p.ws + OFF_XM), 2048};
            gemm_mfma(TB, 2048, 2048, DM, (const bf16_t*)(p.ws + OFF_WT1), al, ep, sm);
            zero_f4((float*)(p.ws + OFF_H), (size_t)NL * 2048);
        }
        grid.sync();
#ifndef NO_CONV
        phase_conv1(p);
#endif
        grid.sync();
        if (wave == 0) {
            const int u = blockIdx.x;
            #ifndef NO_MLSTM
            if (u < 64) mlstm_unit(p, u >> 4, (u >> 3) & 1, u & 7, sm, lane);
#endif
        }
        grid.sync();
        {
            ALmod al{p.out, X1C, modv + 3 * 3072, b, NCX};
            EPstore ep{(float*)(p.ws + OFF_XM), 2048};
            gemm_mfma(NL, 2048, 2048, DM, (const bf16_t*)(p.ws + OFF_WT1) + (size_t)2048 * 1024, al, ep, sm);
        }
        grid.sync();
        phase_finish1(p);
        grid.sync();
        {
            ALplain al{(const float*)(p.ws + OFF_H), 2048};
            EPres ep{(float*)(p.ws + OFF_XC), 1024, p.out, X1C, modv + 3 * 3072, b, NCX};
            gemm_mfma(NL, DM, DM, 2048, (const bf16_t*)(p.ws + OFF_WT3), al, ep, sm);
        }
        grid.sync();
        ln_rows((const float*)(p.ws + OFF_XC), NL, p.in[6] + 1024, p.in[7] + 1024, p.out + (size_t)b * NL * DM, nullptr, NCX);
        grid.sync();
    }
}

extern "C" void kernel_launch(void* const* d_in, const int* in_sizes, int n_in, void* d_out, int out_size, void* d_ws, size_t ws_size, hipStream_t stream) {
    static int grid_blocks = 0;
    if (grid_blocks == 0) {
        if (ws_size < WS_NEED || n_in != 46) { fprintf(stderr, "kernel_launch: bad ws_size %zu (need %zu) or n_in %d\n", ws_size, (size_t)WS_NEED, n_in); grid_blocks = -1; return; }
        int dev = 0, cus = 0, per_cu = 0;
        hipGetDevice(&dev);
        hipDeviceGetAttribute(&cus, hipDeviceAttributeMultiprocessorCount, dev);
        hipFuncSetAttribute((const void*)fwd_kernel, hipFuncAttributeMaxDynamicSharedMemorySize, LDS_BYTES);
        hipOccupancyMaxActiveBlocksPerMultiprocessor(&per_cu, (const void*)fwd_kernel, NTHR, LDS_BYTES);
        if (per_cu < 1) { fprintf(stderr, "kernel_launch: occupancy query says %d blocks/CU\n", per_cu); grid_blocks = -1; return; }
        grid_blocks = cus;
    }
    if (grid_blocks < 0) return;
    Params p{};
    for (int i = 0; i < 46; ++i) p.in[i] = (const float*)d_in[i];
    p.out = (float*)d_out; p.ws = (char*)d_ws;
    void* args[] = {&p};
    hipError_t e = hipLaunchCooperativeKernel((const void*)fwd_kernel, dim3(grid_blocks), dim3(NTHR), args, LDS_BYTES, stream);
    if (e != hipSuccess) fprintf(stderr, "cooperative launch failed: %s (grid %d)\n", hipGetErrorString(e), grid_blocks);
}
```

```cpp
#include <hip/hip_runtime.h>
#include <hip/hip_cooperative_groups.h>
#include <cstdio>
#include <cmath>
namespace cg = cooperative_groups;

#define DEV __device__ __forceinline__

constexpr int NB = 2, NL = 8192, DM = 1024, NCX = 256, TB = NCX + NL;
constexpr int RT = NB * TB;
constexpr int NCH = TB / 64;
constexpr int EIN = 3872, RW0 = 1568;
constexpr int NTHR = 512, NWV = 8;
constexpr float ALPHA = 1.41421356237f;
constexpr float KSCALE = 0.04419417382f;

constexpr size_t OFF_MODV = 0;
constexpr size_t OFF_X1C  = 131072;
constexpr size_t OFF_BON  = 2359296;
constexpr size_t OFF_BIG  = 4194304;
constexpr size_t OFF_P0   = OFF_BIG;
constexpr size_t OFF_YS   = OFF_BIG + (size_t)TB * EIN * 4;
constexpr size_t OFF_XM   = OFF_BIG;
constexpr size_t OFF_XC   = OFF_XM + (size_t)RT * 2048 * 2;
constexpr size_t OFF_H    = OFF_XC + (size_t)RT * 2048 * 2;
constexpr size_t OFF_WT0  = OFF_H + (size_t)NB * NL * 2048 * 2;
constexpr size_t OFF_WT1  = OFF_WT0 + (size_t)3968 * 1024 * 2;
constexpr size_t OFF_WT2  = OFF_WT1 + (size_t)4096 * 1024 * 2;
constexpr size_t OFF_WT3  = OFF_WT2 + (size_t)1024 * 1024 * 2;
constexpr size_t OFF_G16  = OFF_WT3 + (size_t)1024 * 2048 * 2;
constexpr size_t OFF_SMAT = OFF_G16 + (size_t)RT * 16 * 4;
constexpr size_t OFF_GSC  = OFF_SMAT + (size_t)NB * 4 * NCH * 4096 * 2;
constexpr size_t OFF_CSC  = OFF_GSC + (size_t)16 * TB * 4 * 4;
constexpr size_t OFF_NBUF = OFF_CSC + (size_t)16 * NCH * 2 * 4;
constexpr size_t OFF_GTAB = OFF_NBUF + (size_t)16 * NCH * 512 * 4;
constexpr size_t OFF_WFOLD = OFF_GTAB + (size_t)4 * 128 * 16 * 4;
constexpr size_t WS_NEED  = OFF_WFOLD + (size_t)4096 * 16 * 4;

constexpr int LDS_BYTES = 139264;

struct Params { const float* in[46]; float* out; char* ws; };
typedef unsigned short bf16_t;
typedef __attribute__((ext_vector_type(8))) short bf16x8;
typedef __attribute__((ext_vector_type(4))) short s16x4;
typedef __attribute__((ext_vector_type(2))) short s16x2;
typedef __attribute__((ext_vector_type(4))) float f32x4;
typedef __attribute__((ext_vector_type(2))) __bf16 bf2_t;
DEV unsigned pack2bf(float lo, float hi) { bf2_t v; v[0] = (__bf16)lo; v[1] = (__bf16)hi; return __builtin_bit_cast(unsigned, v); }
DEV float bflo(unsigned u) { return __uint_as_float(u << 16); }
DEV float bfhi(unsigned u) { return __uint_as_float(u & 0xffff0000u); }
DEV float bf2f(bf16_t v) { return __uint_as_float(((unsigned)v) << 16); }
DEV void unpack8(uint4 u, float* f) { f[0] = bflo(u.x); f[1] = bfhi(u.x); f[2] = bflo(u.y); f[3] = bfhi(u.y); f[4] = bflo(u.z); f[5] = bfhi(u.z); f[6] = bflo(u.w); f[7] = bfhi(u.w); }

DEV float wave_sum(float v) {
#pragma unroll
    for (int o = 32; o > 0; o >>= 1) v += __shfl_xor(v, o, 64);
    return v;
}
DEV float wave_max(float v) {
#pragma unroll
    for (int o = 32; o > 0; o >>= 1) v = fmaxf(v, __shfl_xor(v, o, 64));
    return v;
}
DEV float sigmoid_f(float x) { return 1.f / (1.f + expf(-x)); }
DEV float silu_f(float x) { return x / (1.f + expf(-x)); }
DEV float logsig_f(float x) { return fminf(x, 0.f) - log1pf(expf(-fabsf(x))); }
DEV void lds_fence() { asm volatile("" ::: "memory"); }
DEV int opaque_tid() { int t = threadIdx.x; asm volatile("" : "+v"(t)); return t; }
DEV int scan_s(int dir, int u) { return dir == 0 ? u : (u < NCX ? (NCX - 1 - u) : (TB - 1 + NCX - u)); }
DEV int chunk_at(int dir, int step) { return dir == 0 ? step : (step < 4 ? 3 - step : (NCH + 3 - step)); }
DEV float4 ld4(const float* p) { return *(const float4*)p; }
DEV void st4(float* p, float4 v) { *(float4*)p = v; }

template <class AL, class EP>
DEV void gemm_mfma(int M, int N, int Npad, int K, const bf16_t* Wt, AL al, EP ep, float* smf) {
    constexpr int LDT = 40;
    bf16_t* As = (bf16_t*)smf;
    bf16_t* Bs = As + 2 * 256 * LDT;
    const int tid = opaque_tid(), lane = tid & 63, wave = tid >> 6, wm = wave & 3, wn = wave >> 2;
    const int mt = M / 256, nt = Npad / 128, nks = K / 32;
    const int lr = tid >> 1, lk = (tid & 1) * 16;
    const int br = tid >> 2, bk = (tid & 3) * 8;
    for (int tile = blockIdx.x; tile < mt * nt; tile += gridDim.x) {
        const int tm = tile / nt, tn = tile % nt, m0 = tm * 256, n0 = tn * 128;
        f32x4 acc[4][4];
#pragma unroll
        for (int i = 0; i < 4; ++i)
#pragma unroll
            for (int j = 0; j < 4; ++j) acc[i][j] = (f32x4){0.f, 0.f, 0.f, 0.f};
        float4 ra[4]; uint4 rb0;
        const bf16_t* wrow = Wt + (size_t)(n0 + br) * K + bk;
#pragma unroll
        for (int i = 0; i < 4; ++i) ra[i] = al(m0 + lr, lk + i * 4);
        rb0 = *(const uint4*)(wrow);
        __syncthreads();
        {
            uint4 w0 = make_uint4(pack2bf(ra[0].x, ra[0].y), pack2bf(ra[0].z, ra[0].w), pack2bf(ra[1].x, ra[1].y), pack2bf(ra[1].z, ra[1].w));
            uint4 w1 = make_uint4(pack2bf(ra[2].x, ra[2].y), pack2bf(ra[2].z, ra[2].w), pack2bf(ra[3].x, ra[3].y), pack2bf(ra[3].z, ra[3].w));
            *(uint4*)(As + lr * LDT + lk) = w0; *(uint4*)(As + lr * LDT + lk + 8) = w1;
            *(uint4*)(Bs + br * LDT + bk) = rb0;
        }
        __syncthreads();
#pragma unroll 1
        for (int ks = 0; ks < nks; ++ks) {
            const int buf = ks & 1;
            if (ks + 1 < nks) {
                const int k1 = (ks + 1) * 32;
#pragma unroll
                for (int i = 0; i < 4; ++i) ra[i] = al(m0 + lr, k1 + lk + i * 4);
                rb0 = *(const uint4*)(wrow + k1);
            }
            const bf16_t* Ab = As + buf * 256 * LDT; const bf16_t* Bb = Bs + buf * 128 * LDT;
            bf16x8 wf[4], af[4];
#pragma unroll
            for (int i = 0; i < 4; ++i) wf[i] = *(const bf16x8*)(Bb + (wn * 64 + i * 16 + (lane & 15)) * LDT + (lane >> 4) * 8);
#pragma unroll
            for (int j = 0; j < 4; ++j) af[j] = *(const bf16x8*)(Ab + (wm * 64 + j * 16 + (lane & 15)) * LDT + (lane >> 4) * 8);
#pragma unroll
            for (int i = 0; i < 4; ++i)
#pragma unroll
                for (int j = 0; j < 4; ++j) acc[i][j] = __builtin_amdgcn_mfma_f32_16x16x32_bf16(wf[i], af[j], acc[i][j], 0, 0, 0);
            if (ks + 1 < nks) {
                bf16_t* An = As + (buf ^ 1) * 256 * LDT; bf16_t* Bn = Bs + (buf ^ 1) * 128 * LDT;
                uint4 w0 = make_uint4(pack2bf(ra[0].x, ra[0].y), pack2bf(ra[0].z, ra[0].w), pack2bf(ra[1].x, ra[1].y), pack2bf(ra[1].z, ra[1].w));
                uint4 w1 = make_uint4(pack2bf(ra[2].x, ra[2].y), pack2bf(ra[2].z, ra[2].w), pack2bf(ra[3].x, ra[3].y), pack2bf(ra[3].z, ra[3].w));
                *(uint4*)(An + lr * LDT + lk) = w0; *(uint4*)(An + lr * LDT + lk + 8) = w1;
                *(uint4*)(Bn + br * LDT + bk) = rb0;
            }
            __syncthreads();
        }
#pragma unroll
        for (int i = 0; i < 4; ++i) {
            const int n = n0 + wn * 64 + i * 16 + (lane >> 4) * 4;
            if (n < N) {
#pragma unroll
                for (int j = 0; j < 4; ++j) {
                    const int m = m0 + wm * 64 + j * 16 + (lane & 15);
                    ep(m, n, make_float4(acc[i][j][0], acc[i][j][1], acc[i][j][2], acc[i][j][3]));
                }
            }
        }
    }
}

DEV void transpose_convert(const float* __restrict__ W, int K, int N, int Npad, bf16_t* Wt, float* sm) {
    float (*T)[65] = (float (*)[65])sm;
    const int tid = opaque_tid();
    const int kt = K / 64, ntl = Npad / 64;
    for (int tile = blockIdx.x; tile < kt * ntl; tile += gridDim.x) {
        const int k0 = (tile / ntl) * 64, n0 = (tile % ntl) * 64;
        __syncthreads();
#pragma unroll
        for (int i = 0; i < 2; ++i) {
            const int k = (tid >> 4) + 32 * i, n4 = (tid & 15) * 4;
            float4 v = make_float4(0.f, 0.f, 0.f, 0.f);
            if (n0 + n4 < N) v = ld4(W + (size_t)(k0 + k) * N + n0 + n4);
            T[k][n4] = v.x; T[k][n4 + 1] = v.y; T[k][n4 + 2] = v.z; T[k][n4 + 3] = v.w;
        }
        __syncthreads();
        const int n = tid >> 3, kq = (tid & 7) * 8;
        unsigned o[4];
#pragma unroll
        for (int j = 0; j < 4; ++j) o[j] = pack2bf(T[kq + 2 * j][n], T[kq + 2 * j + 1][n]);
        bf16_t* dst = Wt + (size_t)(n0 + n) * K + k0 + kq;
        *(uint4*)dst = make_uint4(o[0], o[1], o[2], o[3]);
    }
}

struct ALmod {
    const float* lat; const float* cx; const float* mv; int b; int s0;
    DEV float4 operator()(int r, int k) const {
        const int s = r + s0;
        const float* src; int j;
        if (s < NCX) { src = cx + ((size_t)(b * NCX + s)) * DM + k; j = 2; }
        else { src = lat + ((size_t)(b * NL + s - NCX)) * DM + k; j = b; }
        float4 a = ld4(src);
        const float* m = mv + j * 3072;
        float4 sh = ld4(m + k), sc = ld4(m + 1024 + k);
        return make_float4(a.x * (1.f + sc.x) + sh.x, a.y * (1.f + sc.y) + sh.y, a.z * (1.f + sc.z) + sh.z, a.w * (1.f + sc.w) + sh.w);
    }
};
struct ALmodAll {
    const float* lat; const float* cx; const float* mv;
    DEV float4 operator()(int rr, int k) const {
        const int b = rr >= TB ? 1 : 0, s = rr - b * TB;
        const float* src; int j;
        if (s < NCX) { src = cx + ((size_t)(b * NCX + s)) * DM + k; j = 2; }
        else { src = lat + ((size_t)(b * NL + s - NCX)) * DM + k; j = b; }
        float4 a = ld4(src);
        const float* m = mv + j * 3072;
        float4 sh = ld4(m + k), sc = ld4(m + 1024 + k);
        return make_float4(a.x * (1.f + sc.x) + sh.x, a.y * (1.f + sc.y) + sh.y, a.z * (1.f + sc.z) + sh.z, a.w * (1.f + sc.w) + sh.w);
    }
};
struct ALmodLat {
    const float* lat; const float* mv;
    DEV float4 operator()(int r, int k) const {
        const int b = r >= NL ? 1 : 0;
        float4 a = ld4(lat + (size_t)r * DM + k);
        const float* m = mv + b * 3072;
        float4 sh = ld4(m + k), sc = ld4(m + 1024 + k);
        return make_float4(a.x * (1.f + sc.x) + sh.x, a.y * (1.f + sc.y) + sh.y, a.z * (1.f + sc.z) + sh.z, a.w * (1.f + sc.w) + sh.w);
    }
};
struct ALplain { const float* A; int lda; DEV float4 operator()(int r, int k) const { return ld4(A + (size_t)r * lda + k); } };
struct ALbf { const bf16_t* A; int lda; DEV float4 operator()(int r, int k) const { const uint2 u = *(const uint2*)(A + (size_t)r * lda + k); return make_float4(bflo(u.x), bfhi(u.x), bflo(u.y), bfhi(u.y)); } };
struct EPstore { float* C; int ldc; DEV void operator()(int r, int c, float4 v) const { st4(C + (size_t)r * ldc + c, v); } };
struct EPstoreBf { bf16_t* C; int ldc; DEV void operator()(int r, int c, float4 v) const { *(uint2*)(C + (size_t)r * ldc + c) = make_uint2(pack2bf(v.x, v.y), pack2bf(v.z, v.w)); } };
struct EPres {
    float* C; int ldc; const float* lat; const float* cx; const float* mv; int b; int s0;
    DEV void operator()(int r, int c, float4 v) const {
        const int s = r + s0;
        const float* src; int j;
        if (s < NCX) { src = cx + ((size_t)(b * NCX + s)) * DM + c; j = 2; }
        else { src = lat + ((size_t)(b * NL + s - NCX)) * DM + c; j = b; }
        float4 x = ld4(src);
        float4 g = ld4(mv + j * 3072 + 2048 + c);
        st4(C + (size_t)r * ldc + c, make_float4(ALPHA * x.x + g.x * v.x, ALPHA * x.y + g.y * v.y, ALPHA * x.z + g.z * v.z, ALPHA * x.w + g.w * v.w));
    }
};
struct EPresLat {
    float* C; const float* lat; const float* mv;
    DEV void operator()(int r, int c, float4 v) const {
        const int b = r >= NL ? 1 : 0;
        float4 x = ld4(lat + (size_t)r * DM + c);
        float4 g = ld4(mv + b * 3072 + 2048 + c);
        st4(C + (size_t)r * DM + c, make_float4(ALPHA * x.x + g.x * v.x, ALPHA * x.y + g.y * v.y, ALPHA * x.z + g.z * v.z, ALPHA * x.w + g.w * v.w));
    }
};

DEV void phase_mod(const Params& p, float* sm) {
    const float* c = p.in[1]; const float* cctx = p.in[3];
    const float* mod_w = p.in[4]; const float* mod_b = p.in[5];
    float* modv = (float*)(p.ws + OFF_MODV);
    float* sil = sm; float* red = sm + 3072;
    const int tid = opaque_tid();
    for (int i = tid; i < 3072; i += NTHR) {
        const int j = i >> 10, k = i & 1023;
        const float v = (j < 2) ? c[j * 1024 + k] : cctx[k];
        sil[i] = silu_f(v);
    }
    __syncthreads();
    for (int unit = blockIdx.x; unit < 192; unit += gridDim.x) {
        const int l = unit / 96, cb = unit % 96;
        const int kg = tid >> 5, col = tid & 31, n = cb * 32 + col;
        const float* w = mod_w + (size_t)l * 1024 * 3072 + n;
        float a0 = 0.f, a1 = 0.f, a2 = 0.f;
        for (int k = kg * 64; k < kg * 64 + 64; ++k) {
            const float wv = w[(size_t)k * 3072];
            a0 += sil[k] * wv; a1 += sil[1024 + k] * wv; a2 += sil[2048 + k] * wv;
        }
        red[(kg * 3 + 0) * 32 + col] = a0; red[(kg * 3 + 1) * 32 + col] = a1; red[(kg * 3 + 2) * 32 + col] = a2;
        __syncthreads();
        if (tid < 96) {
            const int j = tid >> 5, cc = tid & 31, nn = cb * 32 + cc;
            float s = mod_b[l * 3072 + nn];
            for (int g = 0; g < 16; ++g) s += red[(g * 3 + j) * 32 + cc];
            modv[(l * 3 + j) * 3072 + nn] = s;
        }
        __syncthreads();
    }
}

DEV void phase_tables(const Params& p) {
    const float* wq = p.in[33]; const float* wk = p.in[34]; const float* wv = p.in[35];
    const float* gw0 = p.in[36]; const float* gw1 = p.in[38]; const float* gw2 = p.in[40]; const float* gw3 = p.in[42];
    float* gtab = (float*)(p.ws + OFF_GTAB); float* wfold = (float*)(p.ws + OFF_WFOLD);
    const int gt = blockIdx.x * NTHR + opaque_tid(), gn = gridDim.x * NTHR;
    for (int i = gt; i < 512 * 16; i += gn) {
        const int gb = i >> 4, cp = (i >> 2) & 3, c = i & 3;
        float s = 0.f;
#pragma unroll
        for (int d = 0; d < 4; ++d) s += wq[gb * 16 + cp * 4 + d] * wk[gb * 16 + c * 4 + d];
        gtab[i] = s * KSCALE;
    }
    for (int i = gt; i < 4096 * 16; i += gn) {
        const int k = i >> 4, g = i & 15, gm = g >> 2, hd = g & 3;
        const float* wg = gm == 0 ? gw0 : (gm == 1 ? gw1 : (gm == 2 ? gw2 : gw3));
        float s = 0.f;
        if (k < 2048) {
            const int blk = k >> 2, cc = k & 3;
#pragma unroll
            for (int d = 0; d < 4; ++d) s += wq[blk * 16 + cc * 4 + d] * wg[(size_t)(4 * blk + d) * 4 + hd] + wk[blk * 16 + cc * 4 + d] * wg[(size_t)(2048 + 4 * blk + d) * 4 + hd];
        } else {
            const int kk = k - 2048, blk = kk >> 2, cc = kk & 3;
#pragma unroll
            for (int d = 0; d < 4; ++d) s += wv[blk * 16 + cc * 4 + d] * wg[(size_t)(4096 + 4 * blk + d) * 4 + hd];
        }
        wfold[i] = s;
    }
}

DEV float rw_mix(const float* P0, int s, int c, const float* __restrict__ mu) {
    const float own = P0[(size_t)s * EIN + RW0 + c];
    const int d = c & 3;
    int ns = -1;
    if (s < NCX) {
        if (d == 0) ns = (s > 0) ? s - 1 : -1;
        else if (d == 1) ns = (s < NCX - 1) ? s + 1 : -1;
    } else {
        const int n = s - NCX, rr = n >> 6, cc = n & 63;
        if (d == 0) ns = (cc > 0) ? s - 1 : -1;
        else if (d == 1) ns = (cc < 63) ? s + 1 : -1;
        else if (d == 2) ns = (rr > 0) ? s - 64 : -1;
        else ns = (rr < 127) ? s + 64 : -1;
    }
    const float nb = (ns >= 0) ? P0[(size_t)ns * EIN + RW0 + c] : 0.f;
    return own + (nb - own) * mu[c];
}

DEV void rwkv_unit(const Params& p, int h, int dir, int rh, float* sm, int lane) {
    asm volatile("" : "+v"(lane));
    const float* P0 = (const float*)(p.ws + OFF_P0);
    float* YS = (float*)(p.ws + OFF_YS);
    float* BON = (float*)(p.ws + OFF_BON);
    const float* mu = p.in[15];
    const float* w0 = p.in[dir ? 18 : 16]; const float* ww2 = p.in[dir ? 19 : 17];
    const float* a0 = p.in[dir ? 22 : 20]; const float* wa2 = p.in[dir ? 23 : 21];
    const float* k_k = p.in[24]; const float* k_a = p.in[25]; const float* r_k = p.in[26];
    float* sR = sm; float* sW = sm + 4096; float* sK = sm + 8192; float* sA = sm + 12288; float* sB = sm + 16384; float* sV = sm + 20480;
    const int hc = h * 64 + lane;
    const float w0j = w0[hc], a0j = a0[hc], kkj = k_k[hc], kaj = k_a[hc], rkj = r_k[hc];
    const int row = rh * 32 + (lane & 31), kh0 = (lane >> 5) * 32;
    float* sWW = sm + 24576; float* sWA = sm + 28672;
#pragma unroll 4
    for (int i = 0; i < 64; ++i) { sWW[i * 64 + lane] = ww2[i * 512 + hc]; sWA[i * 64 + lane] = wa2[i * 512 + hc]; }
    float S[32];
#pragma unroll
    for (int k = 0; k < 32; ++k) S[k] = 0.f;
    const int cwl = 2048 + dir * 64, cal = 2176 + dir * 64;
#pragma unroll 1
    for (int cu = 0; cu < TB / 64; ++cu) {
        lds_fence();
#pragma unroll 1
        for (int t = 0; t < 64; ++t) {
            const int s = scan_s(dir, cu * 64 + t);
            sR[t * 64 + lane] = rw_mix(P0, s, h * 64 + lane, mu);
            sK[t * 64 + lane] = rw_mix(P0, s, 512 + h * 64 + lane, mu);
            sV[t * 64 + lane] = rw_mix(P0, s, 1024 + h * 64 + lane, mu);
            sA[t * 64 + lane] = tanhf(rw_mix(P0, s, cwl + lane, mu));
            sB[t * 64 + lane] = rw_mix(P0, s, cal + lane, mu);
        }
        lds_fence();
        {
            const float* wr = sWW + lane; asm volatile("" : "+v"(wr));
            float wc[64];
#pragma unroll
            for (int i = 0; i < 64; ++i) wc[i] = wr[i * 64];
#pragma unroll 1
            for (int t = 0; t < 64; ++t) {
                float accw = w0j;
#pragma unroll
                for (int i4 = 0; i4 < 16; ++i4) {
                    const float4 x = ld4(&sA[t * 64 + i4 * 4]);
                    accw += x.x * wc[i4 * 4] + x.y * wc[i4 * 4 + 1] + x.z * wc[i4 * 4 + 2] + x.w * wc[i4 * 4 + 3];
                }
                sW[t * 64 + lane] = expf(-0.6065306597f * sigmoid_f(accw));
            }
        }
        lds_fence();
        {
            const float* ar = sWA + lane; asm volatile("" : "+v"(ar));
            float ac[64];
#pragma unroll
            for (int i = 0; i < 64; ++i) ac[i] = ar[i * 64];
#pragma unroll 1
            for (int t = 0; t < 64; ++t) {
                float acca = a0j;
#pragma unroll
                for (int i4 = 0; i4 < 16; ++i4) {
                    const float4 y = ld4(&sB[t * 64 + i4 * 4]);
                    acca += y.x * ac[i4 * 4] + y.y * ac[i4 * 4 + 1] + y.z * ac[i4 * 4 + 2] + y.w * ac[i4 * 4 + 3];
                }
                const float av = sigmoid_f(acca);
                const float kraw = sK[t * 64 + lane];
                const float kkv = kraw * kkj;
                const float ss = wave_sum(kkv * kkv);
                const float kk = kkv * rsqrtf(fmaxf(ss, 1e-24f));
                const float kh = kraw * (1.f + (av - 1.f) * kaj);
                const float r = sR[t * 64 + lane];
                const float bon = wave_sum(r * kh * rkj);
                lds_fence();
                sK[t * 64 + lane] = kh; sA[t * 64 + lane] = -kk; sB[t * 64 + lane] = kk * av;
                if (lane == 0 && rh == 0) { const int s = scan_s(dir, cu * 64 + t); atomicAdd(&BON[s * 8 + h], bon); }
            }
        }
        lds_fence();
#pragma unroll 1
        for (int t = 0; t < 64; ++t) {
            const float vi = sV[t * 64 + row];
            float sa = 0.f;
#pragma unroll
            for (int k4 = 0; k4 < 8; ++k4) {
                const float4 a4 = ld4(&sA[t * 64 + kh0 + k4 * 4]);
                sa += S[k4 * 4] * a4.x + S[k4 * 4 + 1] * a4.y + S[k4 * 4 + 2] * a4.z + S[k4 * 4 + 3] * a4.w;
            }
            sa += __shfl_xor(sa, 32, 64);
            float y = 0.f;
#pragma unroll
            for (int k4 = 0; k4 < 8; ++k4) {
                const float4 w4 = ld4(&sW[t * 64 + kh0 + k4 * 4]);
                const float4 b4 = ld4(&sB[t * 64 + kh0 + k4 * 4]);
                const float4 h4 = ld4(&sK[t * 64 + kh0 + k4 * 4]);
                const float4 r4 = ld4(&sR[t * 64 + kh0 + k4 * 4]);
                S[k4 * 4 + 0] = S[k4 * 4 + 0] * w4.x + sa * b4.x + vi * h4.x;
                S[k4 * 4 + 1] = S[k4 * 4 + 1] * w4.y + sa * b4.y + vi * h4.y;
                S[k4 * 4 + 2] = S[k4 * 4 + 2] * w4.z + sa * b4.z + vi * h4.z;
                S[k4 * 4 + 3] = S[k4 * 4 + 3] * w4.w + sa * b4.w + vi * h4.w;
                y += S[k4 * 4] * r4.x + S[k4 * 4 + 1] * r4.y + S[k4 * 4 + 2] * r4.z + S[k4 * 4 + 3] * r4.w;
            }
            y += __shfl_xor(y, 32, 64);
            if (lane < 32) { const int s = scan_s(dir, cu * 64 + t); atomicAdd(&YS[(size_t)s * 1024 + 512 + h * 64 + row], y); }
        }
    }
}

DEV void gla_unit(const Params& p, int h, int dir, int vq, float* sm, int lane) {
    asm volatile("" : "+v"(lane));
    const float* P0 = (const float*)(p.ws + OFF_P0);
    float* YS = (float*)(p.ws + OFF_YS);
    const float* wa2 = p.in[dir ? 12 : 10]; const float* ba = p.in[dir ? 13 : 11];
    float* sQ = sm; float* sKg = sm + 4096; float* sAg = sm + 8192; float* sVg = sm + 12288; float* sLR = sm + 16384;
    const int hc = h * 64 + lane;
    float wcol[16];
#pragma unroll
    for (int i = 0; i < 16; ++i) wcol[i] = wa2[i * 256 + hc];
    const float baj = ba[hc];
    const int vl = lane & 31, kh0 = (lane >> 5) * 32;
    float S[32];
#pragma unroll
    for (int k = 0; k < 32; ++k) S[k] = 0.f;
#pragma unroll 1
    for (int cu = 0; cu < TB / 64; ++cu) {
        lds_fence();
#pragma unroll 1
        for (int t = 0; t < 64; ++t) {
            const int s = scan_s(dir, cu * 64 + t);
            const float* rowp = P0 + (size_t)s * EIN;
            sQ[t * 64 + lane] = rowp[h * 64 + lane] * 0.125f;
            sKg[t * 64 + lane] = rowp[256 + h * 64 + lane];
            if (lane < 32) sVg[t * 32 + lane] = rowp[512 + h * 128 + vq * 32 + lane];
            if (lane < 16) sLR[t * 16 + lane] = rowp[1536 + dir * 16 + lane];
        }
        lds_fence();
#pragma unroll 1
        for (int t = 0; t < 64; ++t) {
            float x = baj;
#pragma unroll
            for (int i4 = 0; i4 < 4; ++i4) {
                const float4 l4 = ld4(&sLR[t * 16 + i4 * 4]);
                x += l4.x * wcol[i4 * 4] + l4.y * wcol[i4 * 4 + 1] + l4.z * wcol[i4 * 4 + 2] + l4.w * wcol[i4 * 4 + 3];
            }
            sAg[t * 64 + lane] = expf(logsig_f(x) * 0.0625f);
        }
        lds_fence();
#pragma unroll 1
        for (int t = 0; t < 64; ++t) {
            const float vv = sVg[t * 32 + vl];
            float o = 0.f;
#pragma unroll
            for (int k4 = 0; k4 < 8; ++k4) {
                const float4 a4 = ld4(&sAg[t * 64 + kh0 + k4 * 4]);
                const float4 kk4 = ld4(&sKg[t * 64 + kh0 + k4 * 4]);
                const float4 q4 = ld4(&sQ[t * 64 + kh0 + k4 * 4]);
                S[k4 * 4 + 0] = a4.x * S[k4 * 4 + 0] + kk4.x * vv;
                S[k4 * 4 + 1] = a4.y * S[k4 * 4 + 1] + kk4.y * vv;
                S[k4 * 4 + 2] = a4.z * S[k4 * 4 + 2] + kk4.z * vv;
                S[k4 * 4 + 3] = a4.w * S[k4 * 4 + 3] + kk4.w * vv;
                o += q4.x * S[k4 * 4] + q4.y * S[k4 * 4 + 1] + q4.z * S[k4 * 4 + 2] + q4.w * S[k4 * 4 + 3];
            }
            o += __shfl_xor(o, 32, 64);
            if (lane < 32) { const int s = scan_s(dir, cu * 64 + t); atomicAdd(&YS[(size_t)s * 1024 + h * 128 + vq * 32 + vl], o); }
        }
    }
}

DEV void phase_finish0(const Params& p) {
    const float* P0 = (const float*)(p.ws + OFF_P0);
    float* YS = (float*)(p.ws + OFF_YS);
    const float* BON = (const float*)(p.ws + OFF_BON);
    const float* mu = p.in[15];
    const float* gla_ng = p.in[14]; const float* gn_g = p.in[27]; const float* gn_b = p.in[28];
    const int tid_ = opaque_tid(); const int lane = tid_ & 63, gw = blockIdx.x * NWV + (tid_ >> 6), ngw = gridDim.x * NWV;
    for (int s = gw; s < TB; s += ngw) {
        float* ys = YS + (size_t)s * 1024;
        const float* row = P0 + (size_t)s * EIN;
#pragma unroll 1
        for (int h = 0; h < 4; ++h) {
            const float o0 = ys[h * 128 + lane], o1 = ys[h * 128 + 64 + lane];
            const float ss = wave_sum(o0 * o0 + o1 * o1);
            const float rms = rsqrtf(ss * (1.f / 128.f) + 1e-5f);
            const float g0 = row[1024 + h * 128 + lane], g1 = row[1024 + h * 128 + 64 + lane];
            ys[h * 128 + lane] = o0 * rms * gla_ng[lane] * silu_f(g0);
            ys[h * 128 + 64 + lane] = o1 * rms * gla_ng[64 + lane] * silu_f(g1);
        }
#pragma unroll 1
        for (int h = 0; h < 8; ++h) {
            const float yv = ys[512 + h * 64 + lane];
            const float mean = wave_sum(yv) * (1.f / 64.f);
            const float d = yv - mean;
            const float var = wave_sum(d * d) * (1.f / 64.f);
            const float yn = d * rsqrtf(var + 64e-5f);
            const float vmix = rw_mix(P0, s, 1024 + h * 64 + lane, mu);
            const float gmix = rw_mix(P0, s, 1536 + h * 64 + lane, mu);
            const float o = yn * gn_g[h * 64 + lane] + gn_b[h * 64 + lane] + BON[s * 8 + h] * vmix;
            ys[512 + h * 64 + lane] = o * silu_f(gmix);
        }
    }
}

DEV void ln_rows(const float* src, int nrows, const float* __restrict__ g, const float* __restrict__ bt, float* dst_lat, float* dst_cx, int ncx) {
    const int tid_ = opaque_tid(); const int lane = tid_ & 63, gw = blockIdx.x * NWV + (tid_ >> 6), ngw = gridDim.x * NWV;
    for (int r = gw; r < nrows; r += ngw) {
        const float* x = src + (size_t)r * 1024;
        float4 v[4];
        float sum = 0.f;
#pragma unroll
        for (int i = 0; i < 4; ++i) { v[i] = ld4(x + i * 256 + lane * 4); sum += v[i].x + v[i].y + v[i].z + v[i].w; }
        const float mean = wave_sum(sum) * (1.f / 1024.f);
        float sq = 0.f;
#pragma unroll
        for (int i = 0; i < 4; ++i) {
            v[i].x -= mean; v[i].y -= mean; v[i].z -= mean; v[i].w -= mean;
            sq += v[i].x * v[i].x + v[i].y * v[i].y + v[i].z * v[i].z + v[i].w * v[i].w;
        }
        const float rstd = rsqrtf(wave_sum(sq) * (1.f / 1024.f) + 1e-5f);
        float* d = (r < ncx) ? (dst_cx + (size_t)r * 1024) : (dst_lat + (size_t)(r - ncx) * 1024);
#pragma unroll
        for (int i = 0; i < 4; ++i) {
            const int c = i * 256 + lane * 4;
            const float4 gg = ld4(g + c), bb = ld4(bt + c);
            st4(d + c, make_float4(v[i].x * rstd * gg.x + bb.x, v[i].y * rstd * gg.y + bb.y, v[i].z * rstd * gg.z + bb.z, v[i].w * rstd * gg.w + bb.w));
        }
    }
}

DEV void zero_f4(float* ptr, size_t nfloat) {
    const size_t n4 = nfloat / 4;
    for (size_t i = (size_t)blockIdx.x * NTHR + opaque_tid(); i < n4; i += (size_t)gridDim.x * NTHR) ((float4*)ptr)[i] = make_float4(0.f, 0.f, 0.f, 0.f);
}

DEV void chain_ids(int& chain, int& sub) {
    const int bid = blockIdx.x, xcd = bid & 7, idx = bid >> 3;
    chain = xcd * 2 + (idx >> 4); sub = idx & 15;
}

DEV void phase_conv1(const Params& p, float* sm) {
    const bf16_t* XM = (const bf16_t*)(p.ws + OFF_XM);
    bf16_t* XC = (bf16_t*)(p.ws + OFF_XC);
    float* G16 = (float*)(p.ws + OFF_G16);
    const float* cw = p.in[31]; const float* cbias = p.in[32];
    const float* wfold = (const float*)(p.ws + OFF_WFOLD);
    float* wl = sm;
    const int tid = opaque_tid(), t = tid >> 3, cg = tid & 7;
    for (int ci = blockIdx.x; ci < NB * NCH; ci += gridDim.x) {
        const int b = ci / NCH, c = ci % NCH, s = c * 64 + t;
        const size_t rowbase = (size_t)b * TB;
        int nrow[9];
#pragma unroll
        for (int i = 0; i < 3; ++i)
#pragma unroll
            for (int j = 0; j < 3; ++j) {
                int ns = -1;
                if (s < NCX) { const int w2 = s + j - 1; if (i == 1 && w2 >= 0 && w2 < NCX) ns = w2; }
                else { const int n = s - NCX, rr = (n >> 6) + i - 1, w2 = (n & 63) + j - 1; if (rr >= 0 && rr < 128 && w2 >= 0 && w2 < 64) ns = NCX + rr * 64 + w2; }
                nrow[i * 3 + j] = ns;
            }
        float ga[16];
#pragma unroll
        for (int g = 0; g < 16; ++g) ga[g] = 0.f;
#pragma unroll 1
        for (int cb = 0; cb < 32; ++cb) {
            __syncthreads();
            { const int part = tid >> 8, idx = tid & 255; st4(wl + part * 1024 + idx * 4, ld4(wfold + ((size_t)(part * 2048 + cb * 64)) * 16 + idx * 4)); }
            __syncthreads();
            const int c0 = cb * 64 + cg * 8;
            float a8[8], xm8[8];
            { const float4 b0 = ld4(cbias + c0), b1 = ld4(cbias + c0 + 4); a8[0] = b0.x; a8[1] = b0.y; a8[2] = b0.z; a8[3] = b0.w; a8[4] = b1.x; a8[5] = b1.y; a8[6] = b1.z; a8[7] = b1.w; }
#pragma unroll
            for (int i = 0; i < 8; ++i) xm8[i] = 0.f;
#pragma unroll
            for (int tap = 0; tap < 9; ++tap) {
                if (nrow[tap] >= 0) {
                    const uint4 xv = *(const uint4*)(XM + (rowbase + nrow[tap]) * 2048 + c0);
                    float x8[8]; unpack8(xv, x8);
                    const float4 w0 = ld4(cw + tap * 2048 + c0), w1 = ld4(cw + tap * 2048 + c0 + 4);
                    a8[0] += x8[0] * w0.x; a8[1] += x8[1] * w0.y; a8[2] += x8[2] * w0.z; a8[3] += x8[3] * w0.w;
                    a8[4] += x8[4] * w1.x; a8[5] += x8[5] * w1.y; a8[6] += x8[6] * w1.z; a8[7] += x8[7] * w1.w;
                    if (tap == 4) {
#pragma unroll
                        for (int i = 0; i < 8; ++i) xm8[i] = x8[i];
                    }
                }
            }
            float xc8[8];
#pragma unroll
            for (int i = 0; i < 8; ++i) xc8[i] = silu_f(a8[i]);
            *(uint4*)(XC + (rowbase + s) * 2048 + c0) = make_uint4(pack2bf(xc8[0], xc8[1]), pack2bf(xc8[2], xc8[3]), pack2bf(xc8[4], xc8[5]), pack2bf(xc8[6], xc8[7]));
#pragma unroll
            for (int i = 0; i < 8; ++i) {
                const float* wxc = wl + (cg * 8 + i) * 16; const float* wxm = wl + 1024 + (cg * 8 + i) * 16;
#pragma unroll
                for (int q = 0; q < 4; ++q) {
                    const float4 a = ld4(wxc + q * 4), bq = ld4(wxm + q * 4);
                    ga[q * 4 + 0] += xc8[i] * a.x + xm8[i] * bq.x; ga[q * 4 + 1] += xc8[i] * a.y + xm8[i] * bq.y;
                    ga[q * 4 + 2] += xc8[i] * a.z + xm8[i] * bq.z; ga[q * 4 + 3] += xc8[i] * a.w + xm8[i] * bq.w;
                }
            }
        }
#pragma unroll
        for (int g = 0; g < 16; ++g) { ga[g] += __shfl_xor(ga[g], 1, 64); ga[g] += __shfl_xor(ga[g], 2, 64); ga[g] += __shfl_xor(ga[g], 4, 64); }
        if (cg == 0) {
            const float4 bi_f = ld4(p.in[37]), bf_f = ld4(p.in[39]), bi_b = ld4(p.in[41]), bf_b = ld4(p.in[43]);
            float* gp = G16 + (rowbase + s) * 16;
            st4(gp, make_float4(ga[0] + bi_f.x, ga[1] + bi_f.y, ga[2] + bi_f.z, ga[3] + bi_f.w));
            st4(gp + 4, make_float4(logsig_f(ga[4] + bf_f.x), logsig_f(ga[5] + bf_f.y), logsig_f(ga[6] + bf_f.z), logsig_f(ga[7] + bf_f.w)));
            st4(gp + 8, make_float4(ga[8] + bi_b.x, ga[9] + bi_b.y, ga[10] + bi_b.z, ga[11] + bi_b.w));
            st4(gp + 12, make_float4(logsig_f(ga[12] + bf_b.x), logsig_f(ga[13] + bf_b.y), logsig_f(ga[14] + bf_b.z), logsig_f(ga[15] + bf_b.w)));
        }
    }
}

DEV float wave_scan_add(float v, int lane, int dir) {
#pragma unroll
    for (int o = 1; o < 64; o <<= 1) {
        const float n = dir ? __shfl_down(v, o, 64) : __shfl_up(v, o, 64);
        const bool ok = dir ? (lane + o < 64) : (lane >= o);
        if (ok) v += n;
    }
    return v;
}
DEV float wave_scan_max(float v, int lane, int dir) {
#pragma unroll
    for (int o = 1; o < 64; o <<= 1) {
        const float n = dir ? __shfl_down(v, o, 64) : __shfl_up(v, o, 64);
        const bool ok = dir ? (lane + o < 64) : (lane >= o);
        if (ok) v = fmaxf(v, n);
    }
    return v;
}

DEV void phase_x1(const Params& p, float* sm) {
    int chain, sub; chain_ids(chain, sub);
    const int b = chain >> 3, h = (chain >> 1) & 3, dir = chain & 1;
    const bf16_t* XC = (const bf16_t*)(p.ws + OFF_XC);
    const float* G16 = (const float*)(p.ws + OFF_G16);
    float* GSC = (float*)(p.ws + OFF_GSC); float* CSC = (float*)(p.ws + OFF_CSC); float* NBUF = (float*)(p.ws + OFF_NBUF);
    const float* gtab = (const float*)(p.ws + OFF_GTAB);
    bf16_t* SMAT = (bf16_t*)(p.ws + OFF_SMAT);
    const int tid = opaque_tid(), lane = tid & 63, wave = tid >> 6;
    float* sTot = sm; float* sRef = sm + 132; float* sM0 = sm + 264; float* sBeta = sm + 400;
    for (int c = wave; c < NCH; c += NWV) {
        const size_t row = (size_t)b * TB + c * 64 + lane;
        const float gi = G16[row * 16 + dir * 8 + h], lf = G16[row * 16 + dir * 8 + 4 + h];
        const float bc = wave_scan_add(lf, lane, dir);
        const float ref = wave_max(gi - bc), tot = wave_sum(lf);
        if (lane == 0) { sTot[c] = tot; sRef[c] = ref; }
    }
    __syncthreads();
    if (tid == 0) {
        float m0 = -INFINITY;
        for (int step = 0; step < NCH; ++step) {
            const int c = chunk_at(dir, step);
            sM0[c] = m0;
            const float mx = fmaxf(m0, sRef[c]);
            if (sub == 0) { CSC[(chain * NCH + c) * 2] = expf(m0 - mx); CSC[(chain * NCH + c) * 2 + 1] = expf(sRef[c] - mx); }
            m0 = sTot[c] + mx;
        }
    }
    __syncthreads();
    for (int k = wave; sub + 16 * k < NCH; k += NWV) {
        const int c = sub + 16 * k;
        const size_t row = (size_t)b * TB + c * 64 + lane;
        const float gi = G16[row * 16 + dir * 8 + h], lf = G16[row * 16 + dir * 8 + 4 + h];
        const float bc = wave_scan_add(lf, lane, dir);
        const float a = gi - bc;
        const float amax = wave_scan_max(a, lane, dir);
        const float ref = sRef[c], m0 = sM0[c];
        const float mmax = fmaxf(amax, m0);
        const float mt = bc + mmax;
        const float alpha = expf(ref - mmax), beta = expf(a - ref), gg = expf(m0 - mmax), em = expf(-mt);
        st4(GSC + ((size_t)chain * TB + c * 64 + lane) * 4, make_float4(alpha, beta, gg, em));
        sBeta[k * 64 + lane] = beta;
    }
    __syncthreads();
    for (int k = 0; sub + 16 * k < NCH; ++k) {
        const int c = sub + 16 * k;
        const bf16_t* xp = XC + ((size_t)b * TB + c * 64) * 2048 + h * 512 + tid;
        float acc = 0.f;
#pragma unroll 8
        for (int s = 0; s < 64; ++s) acc += sBeta[k * 64 + s] * bf2f(xp[(size_t)s * 2048]);
        NBUF[((size_t)chain * NCH + c) * 512 + tid] = acc;
    }
    bf16_t* XCs = (bf16_t*)sm;
    bf16_t* Qs = XCs + 64 * 520;
    for (int u = blockIdx.x; u < NB * 4 * NCH; u += gridDim.x) {
        const int bh = u / NCH, c = u % NCH, ub = bh >> 2, uh = bh & 3;
        __syncthreads();
#pragma unroll 2
        for (int i = 0; i < 8; ++i) {
            const int pp = tid + 512 * i, row = pp >> 6, c16 = pp & 63;
            const uint4 xv = *(const uint4*)(XC + ((size_t)ub * TB + c * 64 + row) * 2048 + uh * 512 + c16 * 8);
            float f[8]; unpack8(xv, f);
            float q[8];
#pragma unroll
            for (int bb = 0; bb < 2; ++bb) {
                const float* G = gtab + (size_t)(uh * 128 + c16 * 2 + bb) * 16;
                const float4 g0 = ld4(G), g1 = ld4(G + 4), g2 = ld4(G + 8), g3 = ld4(G + 12);
                q[bb * 4 + 0] = f[bb * 4] * g0.x + f[bb * 4 + 1] * g1.x + f[bb * 4 + 2] * g2.x + f[bb * 4 + 3] * g3.x;
                q[bb * 4 + 1] = f[bb * 4] * g0.y + f[bb * 4 + 1] * g1.y + f[bb * 4 + 2] * g2.y + f[bb * 4 + 3] * g3.y;
                q[bb * 4 + 2] = f[bb * 4] * g0.z + f[bb * 4 + 1] * g1.z + f[bb * 4 + 2] * g2.z + f[bb * 4 + 3] * g3.z;
                q[bb * 4 + 3] = f[bb * 4] * g0.w + f[bb * 4 + 1] * g1.w + f[bb * 4 + 2] * g2.w + f[bb * 4 + 3] * g3.w;
            }
            *(uint4*)(XCs + row * 520 + c16 * 8) = xv;
            *(uint4*)(Qs + row * 520 + c16 * 8) = make_uint4(pack2bf(q[0], q[1]), pack2bf(q[2], q[3]), pack2bf(q[4], q[5]), pack2bf(q[6], q[7]));
        }
        __syncthreads();
        const int st = wave & 3, tt0 = (wave >> 2) * 2;
        f32x4 a0 = (f32x4){0.f, 0.f, 0.f, 0.f}, a1 = a0;
        const bf16_t* ap = XCs + (st * 16 + (lane & 15)) * 520 + (lane >> 4) * 8;
        const bf16_t* bp0 = Qs + (tt0 * 16 + (lane & 15)) * 520 + (lane >> 4) * 8;
        const bf16_t* bp1 = bp0 + 16 * 520;
#pragma unroll
        for (int ks = 0; ks < 16; ++ks) {
            const bf16x8 af = *(const bf16x8*)(ap + ks * 32);
            a0 = __builtin_amdgcn_mfma_f32_16x16x32_bf16(af, *(const bf16x8*)(bp0 + ks * 32), a0, 0, 0, 0);
            a1 = __builtin_amdgcn_mfma_f32_16x16x32_bf16(af, *(const bf16x8*)(bp1 + ks * 32), a1, 0, 0, 0);
        }
        bf16_t* sp = SMAT + (size_t)u * 4096 + (size_t)(tt0 * 16 + (lane & 15)) * 64 + st * 16 + (lane >> 4) * 4;
        *(uint2*)sp = make_uint2(pack2bf(a0[0], a0[1]), pack2bf(a0[2], a0[3]));
        *(uint2*)(sp + 16 * 64) = make_uint2(pack2bf(a1[0], a1[1]), pack2bf(a1[2], a1[3]));
    }
}

DEV void phase_x2(const Params& p, float* sm) {
    int chain, sub; chain_ids(chain, sub);
    const int b = chain >> 3, h = (chain >> 1) & 3, dir = chain & 1;
    const bf16_t* XC = (const bf16_t*)(p.ws + OFF_XC);
    float* GSC = (float*)(p.ws + OFF_GSC); const float* CSC = (const float*)(p.ws + OFF_CSC); const float* NBUF = (const float*)(p.ws + OFF_NBUF);
    const float* gtab = (const float*)(p.ws + OFF_GTAB);
    const bf16_t* SMAT = (const bf16_t*)(p.ws + OFF_SMAT);
    const int tid = opaque_tid();
    float* sD0 = sm; float* sCf = sm + 132; float* sN0 = sm + 264; float* sN2 = sN0 + 9 * 512;
    for (int i = tid; i < NCH; i += NTHR) { sD0[i] = CSC[(chain * NCH + i) * 2]; sCf[i] = CSC[(chain * NCH + i) * 2 + 1]; }
    __syncthreads();
    {
        float n = 0.f;
        const float* nb = NBUF + (size_t)chain * NCH * 512 + tid;
#pragma unroll 4
        for (int step = 0; step < NCH; ++step) {
            const int c = chunk_at(dir, step);
            if ((c & 15) == sub) sN0[(c >> 4) * 512 + tid] = n;
            n = sD0[c] * n + sCf[c] * nb[(size_t)c * 512];
        }
    }
    __syncthreads();
    {
        const int blk = tid >> 2, cp = tid & 3;
        const float4 g = ld4(gtab + (size_t)(h * 128 + blk) * 16 + cp * 4);
        for (int k = 0; sub + 16 * k < NCH; ++k) {
            const float* n0 = sN0 + k * 512 + blk * 4;
            sN2[k * 512 + tid] = g.x * n0[0] + g.y * n0[1] + g.z * n0[2] + g.w * n0[3];
        }
    }
    __syncthreads();
    const int t = tid >> 3, part = tid & 7;
    for (int k = 0; sub + 16 * k < NCH; ++k) {
        const int c = sub + 16 * k;
        const size_t row = (size_t)b * TB + c * 64 + t;
        float dint = 0.f;
        {
            const bf16_t* xp = XC + row * 2048 + h * 512 + part * 64;
            const float* n2 = sN2 + k * 512 + part * 64;
#pragma unroll
            for (int i = 0; i < 8; ++i) {
                float f[8]; unpack8(*(const uint4*)(xp + i * 8), f);
                const float4 na = ld4(n2 + i * 8), nb2 = ld4(n2 + i * 8 + 4);
                dint += f[0] * na.x + f[1] * na.y + f[2] * na.z + f[3] * na.w + f[4] * nb2.x + f[5] * nb2.y + f[6] * nb2.z + f[7] * nb2.w;
            }
        }
        float di = 0.f;
        {
            float f[8]; unpack8(*(const uint4*)(SMAT + ((size_t)((b * 4 + h) * NCH + c)) * 4096 + t * 64 + part * 8), f);
#pragma unroll
            for (int e = 0; e < 8; ++e) {
                const int s = part * 8 + e;
                const float beta = GSC[((size_t)chain * TB + c * 64 + s) * 4 + 1];
                const bool keep = dir ? (s >= t) : (s <= t);
                di += keep ? f[e] * beta : 0.f;
            }
        }
        dint += __shfl_xor(dint, 1, 64); dint += __shfl_xor(dint, 2, 64); dint += __shfl_xor(dint, 4, 64);
        di += __shfl_xor(di, 1, 64); di += __shfl_xor(di, 2, 64); di += __shfl_xor(di, 4, 64);
        if (part == 0) {
            float* gp = GSC + ((size_t)chain * TB + c * 64 + t) * 4;
            const float4 g4 = ld4(gp);
            const float den = g4.x * di + g4.z * dint;
            gp[3] = 1.f / fmaxf(fabsf(den), g4.w);
        }
    }
}

#define MLSTM_PREFETCH(step_) do { \
    const int c_ = chunk_at(dir, (step_)); const size_t rb_ = (size_t)b * TB + (size_t)c_ * 64; \
    { const bf16_t* xb_ = XC + (rb_ + (tid >> 6)) * 2048 + h * 512 + (tid & 63) * 8; \
      rx0 = *(const uint4*)(xb_); rx1 = *(const uint4*)(xb_ + 8 * 2048); rx2 = *(const uint4*)(xb_ + 16 * 2048); rx3 = *(const uint4*)(xb_ + 24 * 2048); \
      rx4 = *(const uint4*)(xb_ + 32 * 2048); rx5 = *(const uint4*)(xb_ + 40 * 2048); rx6 = *(const uint4*)(xb_ + 48 * 2048); rx7 = *(const uint4*)(xb_ + 56 * 2048); } \
    rxm = *(const uint2*)(XM + (rb_ + ps) * 2048 + ch0 + pvb * 4); \
    rs = *(const uint4*)(SMAT + ((size_t)((b * 4 + h) * NCH + c_)) * 4096 + ps * 64 + pvb * 8); \
    rbeta = GSC[((size_t)chain * TB + c_ * 64 + ps) * 4 + 1]; \
    if (tid < 64) rsc = ld4(GSC + ((size_t)chain * TB + c_ * 64 + tid) * 4); \
    rd0 = CSC[(chain * NCH + c_) * 2]; rcf = CSC[(chain * NCH + c_) * 2 + 1]; } while (0)

DEV void phase_mlstm(const Params& p, float* sm) {
    int chain, sub; chain_ids(chain, sub);
    const int b = chain >> 3, h = (chain >> 1) & 3, dir = chain & 1;
    const bf16_t* XM = (const bf16_t*)(p.ws + OFF_XM);
    const bf16_t* XC = (const bf16_t*)(p.ws + OFF_XC);
    const bf16_t* SMAT = (const bf16_t*)(p.ws + OFF_SMAT);
    const float* GSC = (const float*)(p.ws + OFF_GSC); const float* CSC = (const float*)(p.ws + OFF_CSC);
    const float* gtab = (const float*)(p.ws + OFF_GTAB);
    bf16_t* H = (bf16_t*)(p.ws + OFF_H);
    const float* wv = p.in[35];
    char* smc = (char*)sm;
    bf16_t* XCs = (bf16_t*)smc;
    bf16_t* Cs = (bf16_t*)(smc + 66560);
    bf16_t* Vb = (bf16_t*)(smc + 66560 + 33280);
    bf16_t* Vw = Vb + 32 * 72;
    bf16_t* Sm = Vw + 32 * 72;
    float* Gs = (float*)(smc + 66560 + 33280 + 2 * 4608 + 9216);
    float* sc = Gs + 2048;
    const int tid = opaque_tid(), lane = tid & 63, wave = tid >> 6;
    for (int i = tid; i < 32 * 520 / 2; i += NTHR) ((unsigned*)Cs)[i] = 0u;
    for (int i = tid; i < 2048; i += NTHR) Gs[i] = gtab[h * 2048 + i];
    const int ps = tid >> 3, pvb = tid & 7;
    const int ch0 = h * 512 + sub * 32;
    float wvr[16];
#pragma unroll
    for (int i = 0; i < 16; ++i) wvr[i] = wv[(size_t)((ch0 >> 2) + pvb) * 16 + i];
    f32x4 accS[4][2];
#pragma unroll
    for (int i = 0; i < 4; ++i) { accS[i][0] = (f32x4){0.f, 0.f, 0.f, 0.f}; accS[i][1] = (f32x4){0.f, 0.f, 0.f, 0.f}; }
    uint4 rx0, rx1, rx2, rx3, rx4, rx5, rx6, rx7; uint2 rxm; uint4 rs; float rbeta; float4 rsc = make_float4(0.f, 0.f, 0.f, 0.f); float rd0, rcf;
    MLSTM_PREFETCH(0);
    __syncthreads();
#pragma unroll 1
    for (int step = 0; step < NCH; ++step) {
        const int c = chunk_at(dir, step);
        const float d0 = rd0, cf = rcf;
        {
            bf16_t* xd = XCs + (tid >> 6) * 520 + (tid & 63) * 8;
            *(uint4*)(xd) = rx0; *(uint4*)(xd + 8 * 520) = rx1; *(uint4*)(xd + 16 * 520) = rx2; *(uint4*)(xd + 24 * 520) = rx3;
            *(uint4*)(xd + 32 * 520) = rx4; *(uint4*)(xd + 40 * 520) = rx5; *(uint4*)(xd + 48 * 520) = rx6; *(uint4*)(xd + 56 * 520) = rx7;
        }
        {
            const float x0 = bflo(rxm.x), x1 = bfhi(rxm.x), x2 = bflo(rxm.y), x3 = bfhi(rxm.y);
#pragma unroll
            for (int d = 0; d < 4; ++d) {
                const float v = (x0 * wvr[d] + x1 * wvr[4 + d] + x2 * wvr[8 + d] + x3 * wvr[12 + d]) * rbeta;
                Vb[(pvb * 4 + d) * 72 + ps] = __builtin_bit_cast(unsigned short, (__bf16)v);
                Vw[(pvb * 4 + d) * 72 + ps] = __builtin_bit_cast(unsigned short, (__bf16)(v * cf));
            }
        }
        {
#define SMASK(q_) (((dir ? (pvb * 8 + 2 * (q_) >= ps) : (pvb * 8 + 2 * (q_) <= ps)) ? 0x0000ffffu : 0u) | ((dir ? (pvb * 8 + 2 * (q_) + 1 >= ps) : (pvb * 8 + 2 * (q_) + 1 <= ps)) ? 0xffff0000u : 0u))
            *(uint4*)(Sm + ps * 72 + pvb * 8) = make_uint4(rs.x & SMASK(0), rs.y & SMASK(1), rs.z & SMASK(2), rs.w & SMASK(3));
#undef SMASK
        }
        if (tid < 64) st4(sc + tid * 4, rsc);
        { const int nstep = (step + 1 < NCH) ? step + 1 : step; MLSTM_PREFETCH(nstep); }
        __syncthreads();
        {
            const int vt = wave & 1, tt = wave >> 1;
            f32x4 ao = (f32x4){0.f, 0.f, 0.f, 0.f}, ai = ao;
            const bf16_t* ap = Cs + (vt * 16 + (lane & 15)) * 520 + (lane >> 4) * 8;
            const bf16_t* bp = XCs + (tt * 16 + (lane & 15)) * 520 + (lane >> 4) * 8;
#pragma unroll
            for (int ks = 0; ks < 16; ++ks) ao = __builtin_amdgcn_mfma_f32_16x16x32_bf16(*(const bf16x8*)(ap + ks * 32), *(const bf16x8*)(bp + ks * 32), ao, 0, 0, 0);
            const bf16_t* ap2 = Vb + (vt * 16 + (lane & 15)) * 72 + (lane >> 4) * 8;
            const bf16_t* bp2 = Sm + (tt * 16 + (lane & 15)) * 72 + (lane >> 4) * 8;
#pragma unroll
            for (int ks = 0; ks < 2; ++ks) ai = __builtin_amdgcn_mfma_f32_16x16x32_bf16(*(const bf16x8*)(ap2 + ks * 32), *(const bf16x8*)(bp2 + ks * 32), ai, 0, 0, 0);
            if (c >= 4) {
                const int t = tt * 16 + (lane & 15);
                const float4 s4 = ld4(sc + t * 4);
                const float h0 = (s4.x * ai[0] + s4.z * ao[0]) * s4.w, h1 = (s4.x * ai[1] + s4.z * ao[1]) * s4.w;
                const float h2 = (s4.x * ai[2] + s4.z * ao[2]) * s4.w, h3 = (s4.x * ai[3] + s4.z * ao[3]) * s4.w;
                bf16_t* hp = H + ((size_t)b * NL + (size_t)c * 64 + t - NCX) * 2048 + ch0 + vt * 16 + (lane >> 4) * 4;
                const unsigned u0 = pack2bf(h0, h1), u1 = pack2bf(h2, h3);
                __builtin_amdgcn_global_atomic_fadd_v2bf16((__attribute__((address_space(1))) s16x2*)hp, __builtin_bit_cast(s16x2, u0));
                __builtin_amdgcn_global_atomic_fadd_v2bf16((__attribute__((address_space(1))) s16x2*)(hp + 2), __builtin_bit_cast(s16x2, u1));
            }
        }
#pragma unroll
        for (int jt = 0; jt < 4; ++jt) { accS[jt][0] *= d0; accS[jt][1] *= d0; }
#pragma unroll
        for (int ks = 0; ks < 2; ++ks) {
            const bf16x8 b0 = *(const bf16x8*)(Vw + (lane & 15) * 72 + ks * 32 + (lane >> 4) * 8);
            const bf16x8 b1 = *(const bf16x8*)(Vw + (16 + (lane & 15)) * 72 + ks * 32 + (lane >> 4) * 8);
            const int row0 = ks * 32 + (lane >> 4) * 8 + ((lane & 15) >> 2);
#pragma unroll
            for (int jt = 0; jt < 4; ++jt) {
                const int col = wave * 64 + jt * 16 + (lane & 3) * 4;
                const s16x4 lo = __builtin_amdgcn_ds_read_tr16_b64_v4i16((__attribute__((address_space(3))) s16x4*)(XCs + row0 * 520 + col));
                const s16x4 hi = __builtin_amdgcn_ds_read_tr16_b64_v4i16((__attribute__((address_space(3))) s16x4*)(XCs + (row0 + 4) * 520 + col));
                const bf16x8 af = (bf16x8){lo[0], lo[1], lo[2], lo[3], hi[0], hi[1], hi[2], hi[3]};
                accS[jt][0] = __builtin_amdgcn_mfma_f32_16x16x32_bf16(af, b0, accS[jt][0], 0, 0, 0);
                accS[jt][1] = __builtin_amdgcn_mfma_f32_16x16x32_bf16(af, b1, accS[jt][1], 0, 0, 0);
            }
        }
        __syncthreads();
#pragma unroll
        for (int jt = 0; jt < 4; ++jt) {
            const int blk = wave * 16 + jt * 4 + (lane >> 4);
            const float4 g0 = ld4(Gs + blk * 16), g1 = ld4(Gs + blk * 16 + 4), g2 = ld4(Gs + blk * 16 + 8), g3 = ld4(Gs + blk * 16 + 12);
#pragma unroll
            for (int v2 = 0; v2 < 2; ++v2) {
                const f32x4 a = accS[jt][v2];
                const float o0 = g0.x * a[0] + g0.y * a[1] + g0.z * a[2] + g0.w * a[3];
                const float o1 = g1.x * a[0] + g1.y * a[1] + g1.z * a[2] + g1.w * a[3];
                const float o2 = g2.x * a[0] + g2.y * a[1] + g2.z * a[2] + g2.w * a[3];
                const float o3 = g3.x * a[0] + g3.y * a[1] + g3.z * a[2] + g3.w * a[3];
                *(uint2*)(Cs + (v2 * 16 + (lane & 15)) * 520 + blk * 4) = make_uint2(pack2bf(o0, o1), pack2bf(o2, o3));
            }
        }
    }
}

DEV void phase_finish1(const Params& p) {
    bf16_t* H = (bf16_t*)(p.ws + OFF_H);
    const bf16_t* XC = (const bf16_t*)(p.ws + OFF_XC);
    const bf16_t* Z = (const bf16_t*)(p.ws + OFF_XM);
    const float* ng = p.in[44]; const float* skip = p.in[45];
    const int tid_ = opaque_tid(); const int lane = tid_ & 63, gw = blockIdx.x * NWV + (tid_ >> 6), ngw = gridDim.x * NWV;
    for (int it = gw; it < NB * NL * 4; it += ngw) {
        const int r = it >> 2, h = it & 3, b = r >= NL ? 1 : 0, nn = r - b * NL;
        const int c0 = h * 512 + lane * 8;
        bf16_t* hp = H + (size_t)r * 2048 + c0;
        float v[8]; unpack8(*(const uint4*)hp, v);
        float sum = 0.f;
#pragma unroll
        for (int j = 0; j < 8; ++j) sum += v[j];
        const float mean = wave_sum(sum) * (1.f / 512.f);
        float sq = 0.f;
#pragma unroll
        for (int j = 0; j < 8; ++j) { v[j] -= mean; sq += v[j] * v[j]; }
        const float rstd = rsqrtf(wave_sum(sq) * (1.f / 512.f) + 1e-5f);
        float xc[8], z[8];
        unpack8(*(const uint4*)(XC + ((size_t)b * TB + NCX + nn) * 2048 + c0), xc);
        unpack8(*(const uint4*)(Z + (size_t)r * 2048 + c0), z);
        float o[8];
#pragma unroll
        for (int j = 0; j < 8; ++j) o[j] = (v[j] * rstd * ng[c0 + j] + skip[c0 + j] * xc[j]) * silu_f(z[j]);
        *(uint4*)hp = make_uint4(pack2bf(o[0], o[1]), pack2bf(o[2], o[3]), pack2bf(o[4], o[5]), pack2bf(o[6], o[7]));
    }
}

__global__ void __launch_bounds__(NTHR) fwd_kernel(Params p) {
    extern __shared__ __attribute__((aligned(16))) float sm[];
    cg::grid_group grid = cg::this_grid();
    const int tid = opaque_tid(), lane = tid & 63, wave = tid >> 6;
    float* modv = (float*)(p.ws + OFF_MODV);
    float* X1C = (float*)(p.ws + OFF_X1C);

    phase_mod(p, sm);
    phase_tables(p);
    transpose_convert(p.in[8], 1024, EIN, 3968, (bf16_t*)(p.ws + OFF_WT0), sm);
    transpose_convert(p.in[29], 1024, 4096, 4096, (bf16_t*)(p.ws + OFF_WT1), sm);
    transpose_convert(p.in[9], 1024, 1024, 1024, (bf16_t*)(p.ws + OFF_WT2), sm);
    transpose_convert(p.in[30], 2048, 1024, 1024, (bf16_t*)(p.ws + OFF_WT3), sm);
    grid.sync();

#pragma unroll 1
    for (int b = 0; b < NB; ++b) {
        {
            ALmod al{p.in[0], p.in[2], modv, b, 0};
            EPstore ep{(float*)(p.ws + OFF_P0), EIN};
            gemm_mfma(TB, EIN, 3968, DM, (const bf16_t*)(p.ws + OFF_WT0), al, ep, sm);
            zero_f4((float*)(p.ws + OFF_YS), (size_t)TB * 1024);
            zero_f4((float*)(p.ws + OFF_BON), (size_t)TB * 8);
        }
        grid.sync();
        if (wave == 0) {
            const int u = blockIdx.x;
            if (u < 32) rwkv_unit(p, u >> 2, (u >> 1) & 1, u & 1, sm, lane);
            if (u >= 32 && u < 64) { const int v = u - 32; gla_unit(p, v >> 3, (v >> 2) & 1, v & 3, sm, lane); }
        }
        grid.sync();
        phase_finish0(p);
        grid.sync();
        {
            ALplain al{(const float*)(p.ws + OFF_YS), 1024};
            EPres ep{(float*)(p.ws + OFF_P0), 1024, p.in[0], p.in[2], modv, b, 0};
            gemm_mfma(TB, DM, DM, DM, (const bf16_t*)(p.ws + OFF_WT2), al, ep, sm);
        }
        grid.sync();
        ln_rows((const float*)(p.ws + OFF_P0), TB, p.in[6], p.in[7], p.out + (size_t)b * NL * DM, X1C + (size_t)b * NCX * DM, NCX);
        grid.sync();
    }

    {
        ALmodAll al{p.out, X1C, modv + 3 * 3072};
        EPstoreBf ep{(bf16_t*)(p.ws + OFF_XM), 2048};
        gemm_mfma(RT, 2048, 2048, DM, (const bf16_t*)(p.ws + OFF_WT1), al, ep, sm);
        zero_f4((float*)(p.ws + OFF_H), (size_t)NB * NL * 1024);
    }
    grid.sync();
    phase_conv1(p, sm);
    grid.sync();
    phase_x1(p, sm);
    grid.sync();
    phase_x2(p, sm);
    grid.sync();
    phase_mlstm(p, sm);
    grid.sync();
    {
        ALmodLat al{p.out, modv + 3 * 3072};
        EPstoreBf ep{(bf16_t*)(p.ws + OFF_XM), 2048};
        gemm_mfma(NB * NL, 2048, 2048, DM, (const bf16_t*)(p.ws + OFF_WT1) + (size_t)2048 * 1024, al, ep, sm);
    }
    grid.sync();
    phase_finish1(p);
    grid.sync();
    {
        ALbf al{(const bf16_t*)(p.ws + OFF_H), 2048};
        EPresLat ep{(float*)(p.ws + OFF_XC), p.out, modv + 3 * 3072};
        gemm_mfma(NB * NL, DM, DM, 2048, (const bf16_t*)(p.ws + OFF_WT3), al, ep, sm);
    }
    grid.sync();
    ln_rows((const float*)(p.ws + OFF_XC), NB * NL, p.in[6] + 1024, p.in[7] + 1024, p.out, p.out, 0);
}

extern "C" void kernel_launch(void* const* d_in, const int* in_sizes, int n_in, void* d_out, int out_size, void* d_ws, size_t ws_size, hipStream_t stream) {
    static int grid_blocks = 0;
    if (grid_blocks == 0) {
        if (ws_size < WS_NEED || n_in != 46) { fprintf(stderr, "kernel_launch: bad ws_size %zu (need %zu) or n_in %d\n", ws_size, (size_t)WS_NEED, n_in); grid_blocks = -1; return; }
        int dev = 0, cus = 0, per_cu = 0;
        (void)hipGetDevice(&dev);
        (void)hipDeviceGetAttribute(&cus, hipDeviceAttributeMultiprocessorCount, dev);
        (void)hipFuncSetAttribute((const void*)fwd_kernel, hipFuncAttributeMaxDynamicSharedMemorySize, LDS_BYTES);
        (void)hipOccupancyMaxActiveBlocksPerMultiprocessor(&per_cu, (const void*)fwd_kernel, NTHR, LDS_BYTES);
        if (per_cu < 1 || cus < 256) { fprintf(stderr, "kernel_launch: occupancy query says %d blocks/CU on %d CUs; this kernel needs 256 resident workgroups\n", per_cu, cus); grid_blocks = -1; return; }
        grid_blocks = 256;
    }
    if (grid_blocks < 0) return;
    Params p{};
    for (int i = 0; i < 46; ++i) p.in[i] = (const float*)d_in[i];
    p.out = (float*)d_out; p.ws = (char*)d_ws;
    void* args[] = {&p};
    hipError_t e = hipLaunchCooperativeKernel((const void*)fwd_kernel, dim3(grid_blocks), dim3(NTHR), args, LDS_BYTES, stream);
    if (e != hipSuccess) fprintf(stderr, "cooperative launch failed: %s (grid %d)\n", hipGetErrorString(e), grid_blocks);
}
```

```cpp
#include <hip/hip_runtime.h>
#include <hip/hip_cooperative_groups.h>
#include <cstdio>
#include <cmath>
namespace cg = cooperative_groups;

#define DEV __device__ __forceinline__

constexpr int NB = 2, NL = 8192, DM = 1024, NCX = 256, TB = NCX + NL;
constexpr int RT = NB * TB;
constexpr int NCH = TB / 64;
constexpr int EIN = 3872, RW0 = 1568;
constexpr int NTHR = 512, NWV = 8;
constexpr float ALPHA = 1.41421356237f;
constexpr float KSCALE = 0.04419417382f;

constexpr size_t OFF_MODV = 0;
constexpr size_t OFF_X1C  = 131072;
constexpr size_t OFF_BON  = 2359296;
constexpr size_t OFF_BIG  = 4194304;
constexpr size_t OFF_P0   = OFF_BIG;
constexpr size_t OFF_YS   = OFF_BIG + (size_t)TB * EIN * 2;
constexpr size_t OFF_YC   = OFF_YS + (size_t)TB * 1024 * 4;
constexpr size_t OFF_GDS  = OFF_YC + (size_t)TB * 1024 * 2;
constexpr size_t OFF_GDEC = OFF_GDS + (size_t)8 * NCH * 8192 * 4;
constexpr size_t OFF_XM   = OFF_BIG;
constexpr size_t OFF_XC   = OFF_XM + (size_t)RT * 2048 * 2;
constexpr size_t OFF_H    = OFF_XC + (size_t)RT * 2048 * 2;
constexpr size_t OFF_WT0  = OFF_H + (size_t)NB * NL * 2048 * 2;
constexpr size_t OFF_WT1  = OFF_WT0 + (size_t)3968 * 1024 * 2;
constexpr size_t OFF_WT2  = OFF_WT1 + (size_t)4096 * 1024 * 2;
constexpr size_t OFF_WT3  = OFF_WT2 + (size_t)1024 * 1024 * 2;
constexpr size_t OFF_G16  = OFF_WT3 + (size_t)1024 * 2048 * 2;
constexpr size_t OFF_SMAT = OFF_G16 + (size_t)RT * 16 * 4;
constexpr size_t OFF_GSC  = OFF_SMAT + (size_t)NB * 4 * NCH * 4096 * 2;
constexpr size_t OFF_CSC  = OFF_GSC + (size_t)16 * TB * 4 * 4;
constexpr size_t OFF_NBUF = OFF_CSC + (size_t)16 * NCH * 2 * 4;
constexpr size_t OFF_GTAB = OFF_NBUF + (size_t)16 * NCH * 512 * 4;
constexpr size_t OFF_WFOLD = OFF_GTAB + (size_t)4 * 128 * 16 * 4;
constexpr size_t WS_NEED  = OFF_WFOLD + (size_t)4096 * 16 * 4;

constexpr int LDS_BYTES = 139264;

struct Params { const float* in[46]; float* out; char* ws; };
typedef unsigned short bf16_t;
typedef __attribute__((ext_vector_type(8))) short bf16x8;
typedef __attribute__((ext_vector_type(4))) short s16x4;
typedef __attribute__((ext_vector_type(2))) short s16x2;
typedef __attribute__((ext_vector_type(4))) float f32x4;
typedef __attribute__((ext_vector_type(2))) __bf16 bf2_t;
DEV unsigned pack2bf(float lo, float hi) { bf2_t v; v[0] = (__bf16)lo; v[1] = (__bf16)hi; return __builtin_bit_cast(unsigned, v); }
DEV float bflo(unsigned u) { return __uint_as_float(u << 16); }
DEV float bfhi(unsigned u) { return __uint_as_float(u & 0xffff0000u); }
DEV float bf2f(bf16_t v) { return __uint_as_float(((unsigned)v) << 16); }
DEV void unpack8(uint4 u, float* f) { f[0] = bflo(u.x); f[1] = bfhi(u.x); f[2] = bflo(u.y); f[3] = bfhi(u.y); f[4] = bflo(u.z); f[5] = bfhi(u.z); f[6] = bflo(u.w); f[7] = bfhi(u.w); }

DEV float wave_sum(float v) {
#pragma unroll
    for (int o = 32; o > 0; o >>= 1) v += __shfl_xor(v, o, 64);
    return v;
}
DEV float wave_max(float v) {
#pragma unroll
    for (int o = 32; o > 0; o >>= 1) v = fmaxf(v, __shfl_xor(v, o, 64));
    return v;
}
DEV float sigmoid_f(float x) { return 1.f / (1.f + expf(-x)); }
DEV float silu_f(float x) { return x / (1.f + expf(-x)); }
DEV float logsig_f(float x) { return fminf(x, 0.f) - log1pf(expf(-fabsf(x))); }
DEV void lds_fence() { asm volatile("" ::: "memory"); }
DEV int opaque_tid() { int t = threadIdx.x; asm volatile("" : "+v"(t)); return t; }
DEV int scan_s(int dir, int u) { return dir == 0 ? u : (u < NCX ? (NCX - 1 - u) : (TB - 1 + NCX - u)); }
DEV int chunk_at(int dir, int step) { return dir == 0 ? step : (step < 4 ? 3 - step : (NCH + 3 - step)); }
DEV float4 ld4(const float* p) { return *(const float4*)p; }
DEV void st4(float* p, float4 v) { *(float4*)p = v; }

template <class AL, class EP>
DEV void gemm_mfma(int M, int N, int Npad, int K, const bf16_t* Wt, AL al, EP ep, float* smf) {
    constexpr int LDT = 40;
    bf16_t* As = (bf16_t*)smf;
    bf16_t* Bs = As + 2 * 256 * LDT;
    const int tid = opaque_tid(), lane = tid & 63, wave = tid >> 6, wm = wave & 3, wn = wave >> 2;
    const int mt = M / 256, nt = Npad / 128, nks = K / 32;
    const int lr = tid >> 1, lk = (tid & 1) * 16;
    const int br = tid >> 2, bk = (tid & 3) * 8;
    for (int tile = blockIdx.x; tile < mt * nt; tile += gridDim.x) {
        const int tm = tile / nt, tn = tile % nt, m0 = tm * 256, n0 = tn * 128;
        f32x4 acc[4][4];
#pragma unroll
        for (int i = 0; i < 4; ++i)
#pragma unroll
            for (int j = 0; j < 4; ++j) acc[i][j] = (f32x4){0.f, 0.f, 0.f, 0.f};
        float4 ra[4]; uint4 rb0;
        const bf16_t* wrow = Wt + (size_t)(n0 + br) * K + bk;
#pragma unroll
        for (int i = 0; i < 4; ++i) ra[i] = al(m0 + lr, lk + i * 4);
        rb0 = *(const uint4*)(wrow);
        __syncthreads();
        {
            uint4 w0 = make_uint4(pack2bf(ra[0].x, ra[0].y), pack2bf(ra[0].z, ra[0].w), pack2bf(ra[1].x, ra[1].y), pack2bf(ra[1].z, ra[1].w));
            uint4 w1 = make_uint4(pack2bf(ra[2].x, ra[2].y), pack2bf(ra[2].z, ra[2].w), pack2bf(ra[3].x, ra[3].y), pack2bf(ra[3].z, ra[3].w));
            *(uint4*)(As + lr * LDT + lk) = w0; *(uint4*)(As + lr * LDT + lk + 8) = w1;
            *(uint4*)(Bs + br * LDT + bk) = rb0;
        }
        __syncthreads();
#pragma unroll 1
        for (int ks = 0; ks < nks; ++ks) {
            const int buf = ks & 1;
            if (ks + 1 < nks) {
                const int k1 = (ks + 1) * 32;
#pragma unroll
                for (int i = 0; i < 4; ++i) ra[i] = al(m0 + lr, k1 + lk + i * 4);
                rb0 = *(const uint4*)(wrow + k1);
            }
            const bf16_t* Ab = As + buf * 256 * LDT; const bf16_t* Bb = Bs + buf * 128 * LDT;
            bf16x8 wf[4], af[4];
#pragma unroll
            for (int i = 0; i < 4; ++i) wf[i] = *(const bf16x8*)(Bb + (wn * 64 + i * 16 + (lane & 15)) * LDT + (lane >> 4) * 8);
#pragma unroll
            for (int j = 0; j < 4; ++j) af[j] = *(const bf16x8*)(Ab + (wm * 64 + j * 16 + (lane & 15)) * LDT + (lane >> 4) * 8);
#pragma unroll
            for (int i = 0; i < 4; ++i)
#pragma unroll
                for (int j = 0; j < 4; ++j) acc[i][j] = __builtin_amdgcn_mfma_f32_16x16x32_bf16(wf[i], af[j], acc[i][j], 0, 0, 0);
            if (ks + 1 < nks) {
                bf16_t* An = As + (buf ^ 1) * 256 * LDT; bf16_t* Bn = Bs + (buf ^ 1) * 128 * LDT;
                uint4 w0 = make_uint4(pack2bf(ra[0].x, ra[0].y), pack2bf(ra[0].z, ra[0].w), pack2bf(ra[1].x, ra[1].y), pack2bf(ra[1].z, ra[1].w));
                uint4 w1 = make_uint4(pack2bf(ra[2].x, ra[2].y), pack2bf(ra[2].z, ra[2].w), pack2bf(ra[3].x, ra[3].y), pack2bf(ra[3].z, ra[3].w));
                *(uint4*)(An + lr * LDT + lk) = w0; *(uint4*)(An + lr * LDT + lk + 8) = w1;
                *(uint4*)(Bn + br * LDT + bk) = rb0;
            }
            __syncthreads();
        }
#pragma unroll
        for (int i = 0; i < 4; ++i) {
            const int n = n0 + wn * 64 + i * 16 + (lane >> 4) * 4;
            if (n < N) {
#pragma unroll
                for (int j = 0; j < 4; ++j) {
                    const int m = m0 + wm * 64 + j * 16 + (lane & 15);
                    ep(m, n, make_float4(acc[i][j][0], acc[i][j][1], acc[i][j][2], acc[i][j][3]));
                }
            }
        }
    }
}

DEV void transpose_convert(const float* __restrict__ W, int K, int N, int Npad, bf16_t* Wt, float* sm) {
    float (*T)[65] = (float (*)[65])sm;
    const int tid = opaque_tid();
    const int kt = K / 64, ntl = Npad / 64;
    for (int tile = blockIdx.x; tile < kt * ntl; tile += gridDim.x) {
        const int k0 = (tile / ntl) * 64, n0 = (tile % ntl) * 64;
        __syncthreads();
#pragma unroll
        for (int i = 0; i < 2; ++i) {
            const int k = (tid >> 4) + 32 * i, n4 = (tid & 15) * 4;
            float4 v = make_float4(0.f, 0.f, 0.f, 0.f);
            if (n0 + n4 < N) v = ld4(W + (size_t)(k0 + k) * N + n0 + n4);
            T[k][n4] = v.x; T[k][n4 + 1] = v.y; T[k][n4 + 2] = v.z; T[k][n4 + 3] = v.w;
        }
        __syncthreads();
        const int n = tid >> 3, kq = (tid & 7) * 8;
        unsigned o[4];
#pragma unroll
        for (int j = 0; j < 4; ++j) o[j] = pack2bf(T[kq + 2 * j][n], T[kq + 2 * j + 1][n]);
        bf16_t* dst = Wt + (size_t)(n0 + n) * K + k0 + kq;
        *(uint4*)dst = make_uint4(o[0], o[1], o[2], o[3]);
    }
}

struct ALmod {
    const float* lat; const float* cx; const float* mv; int b; int s0;
    DEV float4 operator()(int r, int k) const {
        const int s = r + s0;
        const float* src; int j;
        if (s < NCX) { src = cx + ((size_t)(b * NCX + s)) * DM + k; j = 2; }
        else { src = lat + ((size_t)(b * NL + s - NCX)) * DM + k; j = b; }
        float4 a = ld4(src);
        const float* m = mv + j * 3072;
        float4 sh = ld4(m + k), sc = ld4(m + 1024 + k);
        return make_float4(a.x * (1.f + sc.x) + sh.x, a.y * (1.f + sc.y) + sh.y, a.z * (1.f + sc.z) + sh.z, a.w * (1.f + sc.w) + sh.w);
    }
};
struct ALmodAll {
    const float* lat; const float* cx; const float* mv;
    DEV float4 operator()(int rr, int k) const {
        const int b = rr >= TB ? 1 : 0, s = rr - b * TB;
        const float* src; int j;
        if (s < NCX) { src = cx + ((size_t)(b * NCX + s)) * DM + k; j = 2; }
        else { src = lat + ((size_t)(b * NL + s - NCX)) * DM + k; j = b; }
        float4 a = ld4(src);
        const float* m = mv + j * 3072;
        float4 sh = ld4(m + k), sc = ld4(m + 1024 + k);
        return make_float4(a.x * (1.f + sc.x) + sh.x, a.y * (1.f + sc.y) + sh.y, a.z * (1.f + sc.z) + sh.z, a.w * (1.f + sc.w) + sh.w);
    }
};
struct ALmodLat {
    const float* lat; const float* mv;
    DEV float4 operator()(int r, int k) const {
        const int b = r >= NL ? 1 : 0;
        float4 a = ld4(lat + (size_t)r * DM + k);
        const float* m = mv + b * 3072;
        float4 sh = ld4(m + k), sc = ld4(m + 1024 + k);
        return make_float4(a.x * (1.f + sc.x) + sh.x, a.y * (1.f + sc.y) + sh.y, a.z * (1.f + sc.z) + sh.z, a.w * (1.f + sc.w) + sh.w);
    }
};
struct ALplain { const float* A; int lda; DEV float4 operator()(int r, int k) const { return ld4(A + (size_t)r * lda + k); } };
struct ALbf { const bf16_t* A; int lda; DEV float4 operator()(int r, int k) const { const uint2 u = *(const uint2*)(A + (size_t)r * lda + k); return make_float4(bflo(u.x), bfhi(u.x), bflo(u.y), bfhi(u.y)); } };
struct EPstore { float* C; int ldc; DEV void operator()(int r, int c, float4 v) const { st4(C + (size_t)r * ldc + c, v); } };
struct EPstoreBf { bf16_t* C; int ldc; DEV void operator()(int r, int c, float4 v) const { *(uint2*)(C + (size_t)r * ldc + c) = make_uint2(pack2bf(v.x, v.y), pack2bf(v.z, v.w)); } };
struct EPres {
    float* C; int ldc; const float* lat; const float* cx; const float* mv; int b; int s0;
    DEV void operator()(int r, int c, float4 v) const {
        const int s = r + s0;
        const float* src; int j;
        if (s < NCX) { src = cx + ((size_t)(b * NCX + s)) * DM + c; j = 2; }
        else { src = lat + ((size_t)(b * NL + s - NCX)) * DM + c; j = b; }
        float4 x = ld4(src);
        float4 g = ld4(mv + j * 3072 + 2048 + c);
        st4(C + (size_t)r * ldc + c, make_float4(ALPHA * x.x + g.x * v.x, ALPHA * x.y + g.y * v.y, ALPHA * x.z + g.z * v.z, ALPHA * x.w + g.w * v.w));
    }
};
struct EPresLat {
    float* C; const float* lat; const float* mv;
    DEV void operator()(int r, int c, float4 v) const {
        const int b = r >= NL ? 1 : 0;
        float4 x = ld4(lat + (size_t)r * DM + c);
        float4 g = ld4(mv + b * 3072 + 2048 + c);
        st4(C + (size_t)r * DM + c, make_float4(ALPHA * x.x + g.x * v.x, ALPHA * x.y + g.y * v.y, ALPHA * x.z + g.z * v.z, ALPHA * x.w + g.w * v.w));
    }
};

DEV void phase_mod(const Params& p, float* sm) {
    const float* c = p.in[1]; const float* cctx = p.in[3];
    const float* mod_w = p.in[4]; const float* mod_b = p.in[5];
    float* modv = (float*)(p.ws + OFF_MODV);
    float* sil = sm; float* red = sm + 3072;
    const int tid = opaque_tid();
    for (int i = tid; i < 3072; i += NTHR) {
        const int j = i >> 10, k = i & 1023;
        const float v = (j < 2) ? c[j * 1024 + k] : cctx[k];
        sil[i] = silu_f(v);
    }
    __syncthreads();
    for (int unit = blockIdx.x; unit < 192; unit += gridDim.x) {
        const int l = unit / 96, cb = unit % 96;
        const int kg = tid >> 5, col = tid & 31, n = cb * 32 + col;
        const float* w = mod_w + (size_t)l * 1024 * 3072 + n;
        float a0 = 0.f, a1 = 0.f, a2 = 0.f;
        for (int k = kg * 64; k < kg * 64 + 64; ++k) {
            const float wv = w[(size_t)k * 3072];
            a0 += sil[k] * wv; a1 += sil[1024 + k] * wv; a2 += sil[2048 + k] * wv;
        }
        red[(kg * 3 + 0) * 32 + col] = a0; red[(kg * 3 + 1) * 32 + col] = a1; red[(kg * 3 + 2) * 32 + col] = a2;
        __syncthreads();
        if (tid < 96) {
            const int j = tid >> 5, cc = tid & 31, nn = cb * 32 + cc;
            float s = mod_b[l * 3072 + nn];
            for (int g = 0; g < 16; ++g) s += red[(g * 3 + j) * 32 + cc];
            modv[(l * 3 + j) * 3072 + nn] = s;
        }
        __syncthreads();
    }
}

DEV void phase_tables(const Params& p) {
    const float* wq = p.in[33]; const float* wk = p.in[34]; const float* wv = p.in[35];
    const float* gw0 = p.in[36]; const float* gw1 = p.in[38]; const float* gw2 = p.in[40]; const float* gw3 = p.in[42];
    float* gtab = (float*)(p.ws + OFF_GTAB); float* wfold = (float*)(p.ws + OFF_WFOLD);
    const int gt = blockIdx.x * NTHR + opaque_tid(), gn = gridDim.x * NTHR;
    for (int i = gt; i < 512 * 16; i += gn) {
        const int gb = i >> 4, cp = (i >> 2) & 3, c = i & 3;
        float s = 0.f;
#pragma unroll
        for (int d = 0; d < 4; ++d) s += wq[gb * 16 + cp * 4 + d] * wk[gb * 16 + c * 4 + d];
        gtab[i] = s * KSCALE;
    }
    for (int i = gt; i < 4096 * 16; i += gn) {
        const int k = i >> 4, g = i & 15, gm = g >> 2, hd = g & 3;
        const float* wg = gm == 0 ? gw0 : (gm == 1 ? gw1 : (gm == 2 ? gw2 : gw3));
        float s = 0.f;
        if (k < 2048) {
            const int blk = k >> 2, cc = k & 3;
#pragma unroll
            for (int d = 0; d < 4; ++d) s += wq[blk * 16 + cc * 4 + d] * wg[(size_t)(4 * blk + d) * 4 + hd] + wk[blk * 16 + cc * 4 + d] * wg[(size_t)(2048 + 4 * blk + d) * 4 + hd];
        } else {
            const int kk = k - 2048, blk = kk >> 2, cc = kk & 3;
#pragma unroll
            for (int d = 0; d < 4; ++d) s += wv[blk * 16 + cc * 4 + d] * wg[(size_t)(4096 + 4 * blk + d) * 4 + hd];
        }
        wfold[i] = s;
    }
}

DEV float rw_mix(const bf16_t* P0, int s, int c, const float* __restrict__ mu) {
    const float own = bf2f(P0[(size_t)s * EIN + RW0 + c]);
    const int d = c & 3;
    int ns = -1;
    if (s < NCX) {
        if (d == 0) ns = (s > 0) ? s - 1 : -1;
        else if (d == 1) ns = (s < NCX - 1) ? s + 1 : -1;
    } else {
        const int n = s - NCX, rr = n >> 6, cc = n & 63;
        if (d == 0) ns = (cc > 0) ? s - 1 : -1;
        else if (d == 1) ns = (cc < 63) ? s + 1 : -1;
        else if (d == 2) ns = (rr > 0) ? s - 64 : -1;
        else ns = (rr < 127) ? s + 64 : -1;
    }
    const float nb = (ns >= 0) ? bf2f(P0[(size_t)ns * EIN + RW0 + c]) : 0.f;
    return own + (nb - own) * mu[c];
}

DEV void rwkv_unit(const Params& p, int h, int dir, int rh, float* sm, int lane) {
    asm volatile("" : "+v"(lane));
    const bf16_t* P0 = (const bf16_t*)(p.ws + OFF_P0);
    float* YS = (float*)(p.ws + OFF_YS);
    float* BON = (float*)(p.ws + OFF_BON);
    const float* mu = p.in[15];
    const float* w0 = p.in[dir ? 18 : 16]; const float* ww2 = p.in[dir ? 19 : 17];
    const float* a0 = p.in[dir ? 22 : 20]; const float* wa2 = p.in[dir ? 23 : 21];
    const float* k_k = p.in[24]; const float* k_a = p.in[25]; const float* r_k = p.in[26];
    float* sR = sm; float* sW = sm + 4096; float* sK = sm + 8192; float* sA = sm + 12288; float* sB = sm + 16384; float* sV = sm + 20480;
    const int hc = h * 64 + lane;
    const float w0j = w0[hc], a0j = a0[hc], kkj = k_k[hc], kaj = k_a[hc], rkj = r_k[hc];
    const int row = rh * 32 + (lane & 31), kh0 = (lane >> 5) * 32;
    float* sWW = sm + 24576; float* sWA = sm + 28672;
#pragma unroll 4
    for (int i = 0; i < 64; ++i) { sWW[i * 64 + lane] = ww2[i * 512 + hc]; sWA[i * 64 + lane] = wa2[i * 512 + hc]; }
    float S[32];
#pragma unroll
    for (int k = 0; k < 32; ++k) S[k] = 0.f;
    const int cwl = 2048 + dir * 64, cal = 2176 + dir * 64;
#pragma unroll 1
    for (int cu = 0; cu < TB / 64; ++cu) {
        lds_fence();
#pragma unroll 1
        for (int t = 0; t < 64; ++t) {
            const int s = scan_s(dir, cu * 64 + t);
            sR[t * 64 + lane] = rw_mix(P0, s, h * 64 + lane, mu);
            sK[t * 64 + lane] = rw_mix(P0, s, 512 + h * 64 + lane, mu);
            sV[t * 64 + lane] = rw_mix(P0, s, 1024 + h * 64 + lane, mu);
            sA[t * 64 + lane] = tanhf(rw_mix(P0, s, cwl + lane, mu));
            sB[t * 64 + lane] = rw_mix(P0, s, cal + lane, mu);
        }
        lds_fence();
        {
            const float* wr = sWW + lane; asm volatile("" : "+v"(wr));
            float wc[64];
#pragma unroll
            for (int i = 0; i < 64; ++i) wc[i] = wr[i * 64];
#pragma unroll 1
            for (int t = 0; t < 64; ++t) {
                float accw = w0j;
#pragma unroll
                for (int i4 = 0; i4 < 16; ++i4) {
                    const float4 x = ld4(&sA[t * 64 + i4 * 4]);
                    accw += x.x * wc[i4 * 4] + x.y * wc[i4 * 4 + 1] + x.z * wc[i4 * 4 + 2] + x.w * wc[i4 * 4 + 3];
                }
                sW[t * 64 + lane] = expf(-0.6065306597f * sigmoid_f(accw));
            }
        }
        lds_fence();
        {
            const float* ar = sWA + lane; asm volatile("" : "+v"(ar));
            float ac[64];
#pragma unroll
            for (int i = 0; i < 64; ++i) ac[i] = ar[i * 64];
#pragma unroll 1
            for (int t = 0; t < 64; ++t) {
                float acca = a0j;
#pragma unroll
                for (int i4 = 0; i4 < 16; ++i4) {
                    const float4 y = ld4(&sB[t * 64 + i4 * 4]);
                    acca += y.x * ac[i4 * 4] + y.y * ac[i4 * 4 + 1] + y.z * ac[i4 * 4 + 2] + y.w * ac[i4 * 4 + 3];
                }
                const float av = sigmoid_f(acca);
                const float kraw = sK[t * 64 + lane];
                const float kkv = kraw * kkj;
                const float ss = wave_sum(kkv * kkv);
                const float kk = kkv * rsqrtf(fmaxf(ss, 1e-24f));
                const float kh = kraw * (1.f + (av - 1.f) * kaj);
                const float r = sR[t * 64 + lane];
                const float bon = wave_sum(r * kh * rkj);
                lds_fence();
                sK[t * 64 + lane] = kh; sA[t * 64 + lane] = -kk; sB[t * 64 + lane] = kk * av;
                if (lane == 0 && rh == 0) { const int s = scan_s(dir, cu * 64 + t); atomicAdd(&BON[s * 8 + h], bon); }
            }
        }
        lds_fence();
#pragma unroll 1
        for (int t = 0; t < 64; ++t) {
            const float vi = sV[t * 64 + row];
            float sa = 0.f;
#pragma unroll
            for (int k4 = 0; k4 < 8; ++k4) {
                const float4 a4 = ld4(&sA[t * 64 + kh0 + k4 * 4]);
                sa += S[k4 * 4] * a4.x + S[k4 * 4 + 1] * a4.y + S[k4 * 4 + 2] * a4.z + S[k4 * 4 + 3] * a4.w;
            }
            sa += __shfl_xor(sa, 32, 64);
            float y = 0.f;
#pragma unroll
            for (int k4 = 0; k4 < 8; ++k4) {
                const float4 w4 = ld4(&sW[t * 64 + kh0 + k4 * 4]);
                const float4 b4 = ld4(&sB[t * 64 + kh0 + k4 * 4]);
                const float4 h4 = ld4(&sK[t * 64 + kh0 + k4 * 4]);
                const float4 r4 = ld4(&sR[t * 64 + kh0 + k4 * 4]);
                S[k4 * 4 + 0] = S[k4 * 4 + 0] * w4.x + sa * b4.x + vi * h4.x;
                S[k4 * 4 + 1] = S[k4 * 4 + 1] * w4.y + sa * b4.y + vi * h4.y;
                S[k4 * 4 + 2] = S[k4 * 4 + 2] * w4.z + sa * b4.z + vi * h4.z;
                S[k4 * 4 + 3] = S[k4 * 4 + 3] * w4.w + sa * b4.w + vi * h4.w;
                y += S[k4 * 4] * r4.x + S[k4 * 4 + 1] * r4.y + S[k4 * 4 + 2] * r4.z + S[k4 * 4 + 3] * r4.w;
            }
            y += __shfl_xor(y, 32, 64);
            if (lane < 32) { const int s = scan_s(dir, cu * 64 + t); atomicAdd(&YS[(size_t)s * 1024 + 512 + h * 64 + row], y); }
        }
    }
}

DEV void gla_decay(const bf16_t* P0, int c, int h, int dir, const float* __restrict__ wa2, const float* __restrict__ ba,
                   float* sLR, float* sWA, float* sBC, float* sTot, int tid) {
    for (int i = tid; i < 1024; i += NTHR) { const int t = i >> 4, j = i & 15; sLR[i] = bf2f(P0[(size_t)(c * 64 + t) * EIN + 1536 + dir * 16 + j]); }
    for (int i = tid; i < 1024; i += NTHR) { const int ii = i >> 6, k = i & 63; sWA[i] = wa2[ii * 256 + h * 64 + k]; }
    __syncthreads();
    {
        const int t = tid >> 3, k0 = (tid & 7) * 8;
        float acc[8];
#pragma unroll
        for (int j = 0; j < 8; ++j) acc[j] = ba[h * 64 + k0 + j];
#pragma unroll
        for (int ii = 0; ii < 16; ++ii) {
            const float l = sLR[t * 16 + ii];
#pragma unroll
            for (int j = 0; j < 8; ++j) acc[j] += l * sWA[ii * 64 + k0 + j];
        }
#pragma unroll
        for (int j = 0; j < 8; ++j) sBC[t * 65 + k0 + j] = logsig_f(acc[j]) * 0.0625f;
    }
    __syncthreads();
    if (tid < 64) {
        float run = 0.f;
        for (int step = 0; step < 64; ++step) { const int t = dir ? 63 - step : step; run += sBC[t * 65 + tid]; sBC[t * 65 + tid] = run; }
        sTot[tid] = run;
    }
    __syncthreads();
}
DEV bf16x8 tr_frag(const bf16_t* base, int ld, int row0, int col0, int lane) {
    const bf16_t* ptr = base + (row0 + (lane >> 4) * 8 + ((lane & 15) >> 2)) * ld + col0 + (lane & 3) * 4;
    const s16x4 lo = __builtin_amdgcn_ds_read_tr16_b64_v4i16((__attribute__((address_space(3))) s16x4*)ptr);
    const s16x4 hi = __builtin_amdgcn_ds_read_tr16_b64_v4i16((__attribute__((address_space(3))) s16x4*)(ptr + 4 * ld));
    return (bf16x8){lo[0], lo[1], lo[2], lo[3], hi[0], hi[1], hi[2], hi[3]};
}
DEV bf16x8 row_frag(const bf16_t* base, int ld, int idx0, int k0, int lane) {
    return *(const bf16x8*)(base + (idx0 + (lane & 15)) * ld + k0 + (lane >> 4) * 8);
}

DEV void gla1_unit(const Params& p, int h, int dir, int c, float* sm) {
    const int tid = opaque_tid(), lane = tid & 63, wave = tid >> 6;
    const bf16_t* P0 = (const bf16_t*)(p.ws + OFF_P0);
    float* GDS = (float*)(p.ws + OFF_GDS); float* GDEC = (float*)(p.ws + OFF_GDEC);
    const float* wa2 = p.in[dir ? 12 : 10]; const float* ba = p.in[dir ? 13 : 11];
    float* sLR = sm; float* sWA = sm + 1024; float* sBC = sm + 2048; float* sTot = sm + 6208;
    bf16_t* kT = (bf16_t*)(sm + 6272);
    bf16_t* Vs = (bf16_t*)(sm + 8576);
    const int ch = h * 2 + dir;
    __syncthreads();
    gla_decay(P0, c, h, dir, wa2, ba, sLR, sWA, sBC, sTot, tid);
    {
        const int t = tid >> 3, k0 = (tid & 7) * 8;
        float kv[8]; unpack8(*(const uint4*)(P0 + (size_t)(c * 64 + t) * EIN + 256 + h * 64 + k0), kv);
#pragma unroll
        for (int j = 0; j < 8; ++j) kT[(k0 + j) * 72 + t] = __builtin_bit_cast(unsigned short, (__bf16)(kv[j] * expf(sTot[k0 + j] - sBC[t * 65 + k0 + j])));
#pragma unroll
        for (int u = 0; u < 2; ++u) { const int i = tid + 512 * u, row = i >> 4, c16 = i & 15; *(uint4*)(Vs + row * 136 + c16 * 8) = *(const uint4*)(P0 + (size_t)(c * 64 + row) * EIN + 512 + h * 128 + c16 * 8); }
    }
    __syncthreads();
    {
        f32x4 acc[4];
#pragma unroll
        for (int kt = 0; kt < 4; ++kt) acc[kt] = (f32x4){0.f, 0.f, 0.f, 0.f};
#pragma unroll
        for (int ks = 0; ks < 2; ++ks) {
            const bf16x8 af = tr_frag(Vs, 136, ks * 32, wave * 16, lane);
#pragma unroll
            for (int kt = 0; kt < 4; ++kt) acc[kt] = __builtin_amdgcn_mfma_f32_16x16x32_bf16(af, row_frag(kT, 72, kt * 16, ks * 32, lane), acc[kt], 0, 0, 0);
        }
#pragma unroll
        for (int kt = 0; kt < 4; ++kt) {
            const int k = kt * 16 + (lane & 15), v = wave * 16 + (lane >> 4) * 4;
            st4(GDS + ((size_t)(ch * NCH + c) * 64 + k) * 128 + v, make_float4(acc[kt][0], acc[kt][1], acc[kt][2], acc[kt][3]));
        }
    }
    if (tid < 64) GDEC[(size_t)(ch * NCH + c) * 64 + tid] = expf(sTot[tid]);
}

DEV void gla2_unit(const Params& p, int unit) {
    const int tid = opaque_tid();
    float* GDS = (float*)(p.ws + OFF_GDS); const float* GDEC = (const float*)(p.ws + OFF_GDEC);
    const int ch = unit >> 4, e = (unit & 15) * 512 + tid, k = e >> 7, dir = ch & 1;
    float S = 0.f;
#pragma unroll 4
    for (int step = 0; step < NCH; ++step) {
        const int c = chunk_at(dir, step);
        float* gp = GDS + (size_t)(ch * NCH + c) * 8192 + e;
        const float d = GDEC[(size_t)(ch * NCH + c) * 64 + k], inc = *gp;
        *gp = S;
        S = d * S + inc;
    }
}

DEV void gla3_unit(const Params& p, int h, int c, float* sm) {
    const int tid = opaque_tid(), lane = tid & 63, wave = tid >> 6;
    const bf16_t* P0 = (const bf16_t*)(p.ws + OFF_P0);
    const float* GDS = (const float*)(p.ws + OFF_GDS);
    bf16_t* YC = (bf16_t*)(p.ws + OFF_YC);
    const float* ng = p.in[14];
    float* sLR = sm; float* sWA = sm + 1024; float* sBC = sm + 2048; float* sTot = sm + 6208;
    bf16_t* qt = (bf16_t*)(sm + 6272);
    bf16_t* kt = (bf16_t*)(sm + 8576);
    bf16_t* Sm = (bf16_t*)(sm + 10880);
    bf16_t* S0s = (bf16_t*)(sm + 13184);
    bf16_t* Vs = (bf16_t*)(sm + 17536);
    float* O = sm + 21888;
    const int ti = wave & 3, vt0 = (wave >> 2) * 4;
    f32x4 acc[4];
#pragma unroll
    for (int j = 0; j < 4; ++j) acc[j] = (f32x4){0.f, 0.f, 0.f, 0.f};
    __syncthreads();
#pragma unroll
    for (int u = 0; u < 2; ++u) { const int i = tid + 512 * u, row = i >> 4, c16 = i & 15; *(uint4*)(Vs + row * 136 + c16 * 8) = *(const uint4*)(P0 + (size_t)(c * 64 + row) * EIN + 512 + h * 128 + c16 * 8); }
#pragma unroll 1
    for (int dir = 0; dir < 2; ++dir) {
        const float* wa2 = p.in[dir ? 12 : 10]; const float* ba = p.in[dir ? 13 : 11];
        const int ch = h * 2 + dir;
        __syncthreads();
        gla_decay(P0, c, h, dir, wa2, ba, sLR, sWA, sBC, sTot, tid);
        {
            const int t = tid >> 3, k0 = (tid & 7) * 8;
            float qv[8], kv[8];
            unpack8(*(const uint4*)(P0 + (size_t)(c * 64 + t) * EIN + h * 64 + k0), qv);
            unpack8(*(const uint4*)(P0 + (size_t)(c * 64 + t) * EIN + 256 + h * 64 + k0), kv);
#pragma unroll
            for (int j = 0; j < 8; ++j) { const float bc = sBC[t * 65 + k0 + j]; qv[j] *= 0.125f * expf(bc); kv[j] *= expf(-bc); }
            *(uint4*)(qt + t * 72 + k0) = make_uint4(pack2bf(qv[0], qv[1]), pack2bf(qv[2], qv[3]), pack2bf(qv[4], qv[5]), pack2bf(qv[6], qv[7]));
            *(uint4*)(kt + t * 72 + k0) = make_uint4(pack2bf(kv[0], kv[1]), pack2bf(kv[2], kv[3]), pack2bf(kv[4], kv[5]), pack2bf(kv[6], kv[7]));
#pragma unroll
            for (int u = 0; u < 4; ++u) {
                const int i = tid + 512 * u, k = i >> 5, v4 = (i & 31) * 4;
                const float4 s4 = ld4(GDS + (size_t)(ch * NCH + c) * 8192 + k * 128 + v4);
                *(uint2*)(S0s + k * 136 + v4) = make_uint2(pack2bf(s4.x, s4.y), pack2bf(s4.z, s4.w));
            }
        }
        __syncthreads();
        {
            const int si = wave & 3;
#pragma unroll
            for (int jj = 0; jj < 2; ++jj) {
                const int t2 = (wave >> 2) * 2 + jj;
                f32x4 a = (f32x4){0.f, 0.f, 0.f, 0.f};
#pragma unroll
                for (int ks = 0; ks < 2; ++ks) a = __builtin_amdgcn_mfma_f32_16x16x32_bf16(row_frag(kt, 72, si * 16, ks * 32, lane), row_frag(qt, 72, t2 * 16, ks * 32, lane), a, 0, 0, 0);
                const int t = t2 * 16 + (lane & 15), s0 = si * 16 + (lane >> 4) * 4;
                float m[4];
#pragma unroll
                for (int r = 0; r < 4; ++r) { const bool keep = dir ? (s0 + r >= t) : (s0 + r <= t); m[r] = keep ? a[r] : 0.f; }
                *(uint2*)(Sm + t * 72 + s0) = make_uint2(pack2bf(m[0], m[1]), pack2bf(m[2], m[3]));
            }
        }
        __syncthreads();
#pragma unroll
        for (int ks = 0; ks < 2; ++ks) {
            const bf16x8 a1 = row_frag(qt, 72, ti * 16, ks * 32, lane), a2 = row_frag(Sm, 72, ti * 16, ks * 32, lane);
#pragma unroll
            for (int j = 0; j < 4; ++j) {
                acc[j] = __builtin_amdgcn_mfma_f32_16x16x32_bf16(a1, tr_frag(S0s, 136, ks * 32, (vt0 + j) * 16, lane), acc[j], 0, 0, 0);
                acc[j] = __builtin_amdgcn_mfma_f32_16x16x32_bf16(a2, tr_frag(Vs, 136, ks * 32, (vt0 + j) * 16, lane), acc[j], 0, 0, 0);
            }
        }
    }
#pragma unroll
    for (int j = 0; j < 4; ++j)
#pragma unroll
        for (int r = 0; r < 4; ++r) O[(ti * 16 + (lane >> 4) * 4 + r) * 132 + (vt0 + j) * 16 + (lane & 15)] = acc[j][r];
    __syncthreads();
    {
        const int t = tid >> 3, v0 = (tid & 7) * 16;
        float o[16];
        float ss = 0.f;
#pragma unroll
        for (int i = 0; i < 16; ++i) { o[i] = O[t * 132 + v0 + i]; ss += o[i] * o[i]; }
        ss += __shfl_xor(ss, 1, 64); ss += __shfl_xor(ss, 2, 64); ss += __shfl_xor(ss, 4, 64);
        const float rms = rsqrtf(ss * (1.f / 128.f) + 1e-5f);
        float g[16];
        const bf16_t* gp = P0 + (size_t)(c * 64 + t) * EIN + 1024 + h * 128 + v0;
        unpack8(*(const uint4*)gp, g); unpack8(*(const uint4*)(gp + 8), g + 8);
        float y[16];
#pragma unroll
        for (int i = 0; i < 16; ++i) y[i] = o[i] * rms * ng[v0 + i] * silu_f(g[i]);
        bf16_t* yp = YC + (size_t)(c * 64 + t) * 1024 + h * 128 + v0;
        *(uint4*)yp = make_uint4(pack2bf(y[0], y[1]), pack2bf(y[2], y[3]), pack2bf(y[4], y[5]), pack2bf(y[6], y[7]));
        *(uint4*)(yp + 8) = make_uint4(pack2bf(y[8], y[9]), pack2bf(y[10], y[11]), pack2bf(y[12], y[13]), pack2bf(y[14], y[15]));
    }
}

DEV void phase_finish0r(const Params& p) {
    const bf16_t* P0 = (const bf16_t*)(p.ws + OFF_P0);
    const float* YS = (const float*)(p.ws + OFF_YS);
    const float* BON = (const float*)(p.ws + OFF_BON);
    bf16_t* YC = (bf16_t*)(p.ws + OFF_YC);
    const float* mu = p.in[15];
    const float* gn_g = p.in[27]; const float* gn_b = p.in[28];
    const int tid_ = opaque_tid(); const int lane = tid_ & 63, gw = blockIdx.x * NWV + (tid_ >> 6), ngw = gridDim.x * NWV;
    for (int s = gw; s < TB; s += ngw) {
        const float* ys = YS + (size_t)s * 1024;
#pragma unroll 1
        for (int h = 0; h < 8; ++h) {
            const float yv = ys[512 + h * 64 + lane];
            const float mean = wave_sum(yv) * (1.f / 64.f);
            const float d = yv - mean;
            const float var = wave_sum(d * d) * (1.f / 64.f);
            const float yn = d * rsqrtf(var + 64e-5f);
            const float vmix = rw_mix(P0, s, 1024 + h * 64 + lane, mu);
            const float gmix = rw_mix(P0, s, 1536 + h * 64 + lane, mu);
            const float o = yn * gn_g[h * 64 + lane] + gn_b[h * 64 + lane] + BON[s * 8 + h] * vmix;
            YC[(size_t)s * 1024 + 512 + h * 64 + lane] = __builtin_bit_cast(unsigned short, (__bf16)(o * silu_f(gmix)));
        }
    }
}

DEV void ln_rows(const float* src, int nrows, const float* __restrict__ g, const float* __restrict__ bt, float* dst_lat, float* dst_cx, int ncx) {
    const int tid_ = opaque_tid(); const int lane = tid_ & 63, gw = blockIdx.x * NWV + (tid_ >> 6), ngw = gridDim.x * NWV;
    for (int r = gw; r < nrows; r += ngw) {
        const float* x = src + (size_t)r * 1024;
        float4 v[4];
        float sum = 0.f;
#pragma unroll
        for (int i = 0; i < 4; ++i) { v[i] = ld4(x + i * 256 + lane * 4); sum += v[i].x + v[i].y + v[i].z + v[i].w; }
        const float mean = wave_sum(sum) * (1.f / 1024.f);
        float sq = 0.f;
#pragma unroll
        for (int i = 0; i < 4; ++i) {
            v[i].x -= mean; v[i].y -= mean; v[i].z -= mean; v[i].w -= mean;
            sq += v[i].x * v[i].x + v[i].y * v[i].y + v[i].z * v[i].z + v[i].w * v[i].w;
        }
        const float rstd = rsqrtf(wave_sum(sq) * (1.f / 1024.f) + 1e-5f);
        float* d = (r < ncx) ? (dst_cx + (size_t)r * 1024) : (dst_lat + (size_t)(r - ncx) * 1024);
#pragma unroll
        for (int i = 0; i < 4; ++i) {
            const int c = i * 256 + lane * 4;
            const float4 gg = ld4(g + c), bb = ld4(bt + c);
            st4(d + c, make_float4(v[i].x * rstd * gg.x + bb.x, v[i].y * rstd * gg.y + bb.y, v[i].z * rstd * gg.z + bb.z, v[i].w * rstd * gg.w + bb.w));
        }
    }
}

DEV void zero_f4(float* ptr, size_t nfloat) {
    const size_t n4 = nfloat / 4;
    for (size_t i = (size_t)blockIdx.x * NTHR + opaque_tid(); i < n4; i += (size_t)gridDim.x * NTHR) ((float4*)ptr)[i] = make_float4(0.f, 0.f, 0.f, 0.f);
}

DEV void chain_ids(int& chain, int& sub) {
    const int bid = blockIdx.x, xcd = bid & 7, idx = bid >> 3;
    chain = xcd * 2 + (idx >> 4); sub = idx & 15;
}

DEV void phase_conv1(const Params& p, float* sm) {
    const bf16_t* XM = (const bf16_t*)(p.ws + OFF_XM);
    bf16_t* XC = (bf16_t*)(p.ws + OFF_XC);
    float* G16 = (float*)(p.ws + OFF_G16);
    const float* cw = p.in[31]; const float* cbias = p.in[32];
    const float* wfold = (const float*)(p.ws + OFF_WFOLD);
    float* wl = sm;
    const int tid = opaque_tid(), t = tid >> 3, cg = tid & 7;
    for (int ci = blockIdx.x; ci < NB * NCH; ci += gridDim.x) {
        const int b = ci / NCH, c = ci % NCH, s = c * 64 + t;
        const size_t rowbase = (size_t)b * TB;
        int nrow[9];
#pragma unroll
        for (int i = 0; i < 3; ++i)
#pragma unroll
            for (int j = 0; j < 3; ++j) {
                int ns = -1;
                if (s < NCX) { const int w2 = s + j - 1; if (i == 1 && w2 >= 0 && w2 < NCX) ns = w2; }
                else { const int n = s - NCX, rr = (n >> 6) + i - 1, w2 = (n & 63) + j - 1; if (rr >= 0 && rr < 128 && w2 >= 0 && w2 < 64) ns = NCX + rr * 64 + w2; }
                nrow[i * 3 + j] = ns;
            }
        float ga[16];
#pragma unroll
        for (int g = 0; g < 16; ++g) ga[g] = 0.f;
#pragma unroll 1
        for (int cb = 0; cb < 32; ++cb) {
            __syncthreads();
            { const int part = tid >> 8, idx = tid & 255; st4(wl + part * 1024 + idx * 4, ld4(wfold + ((size_t)(part * 2048 + cb * 64)) * 16 + idx * 4)); }
            __syncthreads();
            const int c0 = cb * 64 + cg * 8;
            float a8[8], xm8[8];
            { const float4 b0 = ld4(cbias + c0), b1 = ld4(cbias + c0 + 4); a8[0] = b0.x; a8[1] = b0.y; a8[2] = b0.z; a8[3] = b0.w; a8[4] = b1.x; a8[5] = b1.y; a8[6] = b1.z; a8[7] = b1.w; }
#pragma unroll
            for (int i = 0; i < 8; ++i) xm8[i] = 0.f;
#pragma unroll
            for (int tap = 0; tap < 9; ++tap) {
                if (nrow[tap] >= 0) {
                    const uint4 xv = *(const uint4*)(XM + (rowbase + nrow[tap]) * 2048 + c0);
                    float x8[8]; unpack8(xv, x8);
                    const float4 w0 = ld4(cw + tap * 2048 + c0), w1 = ld4(cw + tap * 2048 + c0 + 4);
                    a8[0] += x8[0] * w0.x; a8[1] += x8[1] * w0.y; a8[2] += x8[2] * w0.z; a8[3] += x8[3] * w0.w;
                    a8[4] += x8[4] * w1.x; a8[5] += x8[5] * w1.y; a8[6] += x8[6] * w1.z; a8[7] += x8[7] * w1.w;
                    if (tap == 4) {
#pragma unroll
                        for (int i = 0; i < 8; ++i) xm8[i] = x8[i];
                    }
                }
            }
            float xc8[8];
#pragma unroll
            for (int i = 0; i < 8; ++i) xc8[i] = silu_f(a8[i]);
            *(uint4*)(XC + (rowbase + s) * 2048 + c0) = make_uint4(pack2bf(xc8[0], xc8[1]), pack2bf(xc8[2], xc8[3]), pack2bf(xc8[4], xc8[5]), pack2bf(xc8[6], xc8[7]));
#pragma unroll
            for (int i = 0; i < 8; ++i) {
                const float* wxc = wl + (cg * 8 + i) * 16; const float* wxm = wl + 1024 + (cg * 8 + i) * 16;
#pragma unroll
                for (int q = 0; q < 4; ++q) {
                    const float4 a = ld4(wxc + q * 4), bq = ld4(wxm + q * 4);
                    ga[q * 4 + 0] += xc8[i] * a.x + xm8[i] * bq.x; ga[q * 4 + 1] += xc8[i] * a.y + xm8[i] * bq.y;
                    ga[q * 4 + 2] += xc8[i] * a.z + xm8[i] * bq.z; ga[q * 4 + 3] += xc8[i] * a.w + xm8[i] * bq.w;
                }
            }
        }
#pragma unroll
        for (int g = 0; g < 16; ++g) { ga[g] += __shfl_xor(ga[g], 1, 64); ga[g] += __shfl_xor(ga[g], 2, 64); ga[g] += __shfl_xor(ga[g], 4, 64); }
        if (cg == 0) {
            const float4 bi_f = ld4(p.in[37]), bf_f = ld4(p.in[39]), bi_b = ld4(p.in[41]), bf_b = ld4(p.in[43]);
            float* gp = G16 + (rowbase + s) * 16;
            st4(gp, make_float4(ga[0] + bi_f.x, ga[1] + bi_f.y, ga[2] + bi_f.z, ga[3] + bi_f.w));
            st4(gp + 4, make_float4(logsig_f(ga[4] + bf_f.x), logsig_f(ga[5] + bf_f.y), logsig_f(ga[6] + bf_f.z), logsig_f(ga[7] + bf_f.w)));
            st4(gp + 8, make_float4(ga[8] + bi_b.x, ga[9] + bi_b.y, ga[10] + bi_b.z, ga[11] + bi_b.w));
            st4(gp + 12, make_float4(logsig_f(ga[12] + bf_b.x), logsig_f(ga[13] + bf_b.y), logsig_f(ga[14] + bf_b.z), logsig_f(ga[15] + bf_b.w)));
        }
    }
}

DEV float wave_scan_add(float v, int lane, int dir) {
#pragma unroll
    for (int o = 1; o < 64; o <<= 1) {
        const float n = dir ? __shfl_down(v, o, 64) : __shfl_up(v, o, 64);
        const bool ok = dir ? (lane + o < 64) : (lane >= o);
        if (ok) v += n;
    }
    return v;
}
DEV float wave_scan_max(float v, int lane, int dir) {
#pragma unroll
    for (int o = 1; o < 64; o <<= 1) {
        const float n = dir ? __shfl_down(v, o, 64) : __shfl_up(v, o, 64);
        const bool ok = dir ? (lane + o < 64) : (lane >= o);
        if (ok) v = fmaxf(v, n);
    }
    return v;
}

DEV void phase_x1(const Params& p, float* sm) {
    int chain, sub; chain_ids(chain, sub);
    const int b = chain >> 3, h = (chain >> 1) & 3, dir = chain & 1;
    const bf16_t* XC = (const bf16_t*)(p.ws + OFF_XC);
    const float* G16 = (const float*)(p.ws + OFF_G16);
    float* GSC = (float*)(p.ws + OFF_GSC); float* CSC = (float*)(p.ws + OFF_CSC); float* NBUF = (float*)(p.ws + OFF_NBUF);
    const float* gtab = (const float*)(p.ws + OFF_GTAB);
    bf16_t* SMAT = (bf16_t*)(p.ws + OFF_SMAT);
    const int tid = opaque_tid(), lane = tid & 63, wave = tid >> 6;
    float* sTot = sm; float* sRef = sm + 132; float* sM0 = sm + 264; float* sBeta = sm + 400;
    for (int c = wave; c < NCH; c += NWV) {
        const size_t row = (size_t)b * TB + c * 64 + lane;
        const float gi = G16[row * 16 + dir * 8 + h], lf = G16[row * 16 + dir * 8 + 4 + h];
        const float bc = wave_scan_add(lf, lane, dir);
        const float ref = wave_max(gi - bc), tot = wave_sum(lf);
        if (lane == 0) { sTot[c] = tot; sRef[c] = ref; }
    }
    __syncthreads();
    if (tid == 0) {
        float m0 = -INFINITY;
        for (int step = 0; step < NCH; ++step) {
            const int c = chunk_at(dir, step);
            sM0[c] = m0;
            const float mx = fmaxf(m0, sRef[c]);
            if (sub == 0) { CSC[(chain * NCH + c) * 2] = expf(m0 - mx); CSC[(chain * NCH + c) * 2 + 1] = expf(sRef[c] - mx); }
            m0 = sTot[c] + mx;
        }
    }
    __syncthreads();
    for (int k = wave; sub + 16 * k < NCH; k += NWV) {
        const int c = sub + 16 * k;
        const size_t row = (size_t)b * TB + c * 64 + lane;
        const float gi = G16[row * 16 + dir * 8 + h], lf = G16[row * 16 + dir * 8 + 4 + h];
        const float bc = wave_scan_add(lf, lane, dir);
        const float a = gi - bc;
        const float amax = wave_scan_max(a, lane, dir);
        const float ref = sRef[c], m0 = sM0[c];
        const float mmax = fmaxf(amax, m0);
        const float mt = bc + mmax;
        const float alpha = expf(ref - mmax), beta = expf(a - ref), gg = expf(m0 - mmax), em = expf(-mt);
        st4(GSC + ((size_t)chain * TB + c * 64 + lane) * 4, make_float4(alpha, beta, gg, em));
        sBeta[k * 64 + lane] = beta;
    }
    __syncthreads();
    for (int k = 0; sub + 16 * k < NCH; ++k) {
        const int c = sub + 16 * k;
        const bf16_t* xp = XC + ((size_t)b * TB + c * 64) * 2048 + h * 512 + tid;
        float acc = 0.f;
#pragma unroll 8
        for (int s = 0; s < 64; ++s) acc += sBeta[k * 64 + s] * bf2f(xp[(size_t)s * 2048]);
        NBUF[((size_t)chain * NCH + c) * 512 + tid] = acc;
    }
    bf16_t* XCs = (bf16_t*)sm;
    bf16_t* Qs = XCs + 64 * 520;
    for (int u = blockIdx.x; u < NB * 4 * NCH; u += gridDim.x) {
        const int bh = u / NCH, c = u % NCH, ub = bh >> 2, uh = bh & 3;
        __syncthreads();
#pragma unroll 2
        for (int i = 0; i < 8; ++i) {
            const int pp = tid + 512 * i, row = pp >> 6, c16 = pp & 63;
            const uint4 xv = *(const uint4*)(XC + ((size_t)ub * TB + c * 64 + row) * 2048 + uh * 512 + c16 * 8);
            float f[8]; unpack8(xv, f);
            float q[8];
#pragma unroll
            for (int bb = 0; bb < 2; ++bb) {
                const float* G = gtab + (size_t)(uh * 128 + c16 * 2 + bb) * 16;
                const float4 g0 = ld4(G), g1 = ld4(G + 4), g2 = ld4(G + 8), g3 = ld4(G + 12);
                q[bb * 4 + 0] = f[bb * 4] * g0.x + f[bb * 4 + 1] * g1.x + f[bb * 4 + 2] * g2.x + f[bb * 4 + 3] * g3.x;
                q[bb * 4 + 1] = f[bb * 4] * g0.y + f[bb * 4 + 1] * g1.y + f[bb * 4 + 2] * g2.y + f[bb * 4 + 3] * g3.y;
                q[bb * 4 + 2] = f[bb * 4] * g0.z + f[bb * 4 + 1] * g1.z + f[bb * 4 + 2] * g2.z + f[bb * 4 + 3] * g3.z;
                q[bb * 4 + 3] = f[bb * 4] * g0.w + f[bb * 4 + 1] * g1.w + f[bb * 4 + 2] * g2.w + f[bb * 4 + 3] * g3.w;
            }
            *(uint4*)(XCs + row * 520 + c16 * 8) = xv;
            *(uint4*)(Qs + row * 520 + c16 * 8) = make_uint4(pack2bf(q[0], q[1]), pack2bf(q[2], q[3]), pack2bf(q[4], q[5]), pack2bf(q[6], q[7]));
        }
        __syncthreads();
        const int st = wave & 3, tt0 = (wave >> 2) * 2;
        f32x4 a0 = (f32x4){0.f, 0.f, 0.f, 0.f}, a1 = a0;
        const bf16_t* ap = XCs + (st * 16 + (lane & 15)) * 520 + (lane >> 4) * 8;
        const bf16_t* bp0 = Qs + (tt0 * 16 + (lane & 15)) * 520 + (lane >> 4) * 8;
        const bf16_t* bp1 = bp0 + 16 * 520;
#pragma unroll
        for (int ks = 0; ks < 16; ++ks) {
            const bf16x8 af = *(const bf16x8*)(ap + ks * 32);
            a0 = __builtin_amdgcn_mfma_f32_16x16x32_bf16(af, *(const bf16x8*)(bp0 + ks * 32), a0, 0, 0, 0);
            a1 = __builtin_amdgcn_mfma_f32_16x16x32_bf16(af, *(const bf16x8*)(bp1 + ks * 32), a1, 0, 0, 0);
        }
        bf16_t* sp = SMAT + (size_t)u * 4096 + (size_t)(tt0 * 16 + (lane & 15)) * 64 + st * 16 + (lane >> 4) * 4;
        *(uint2*)sp = make_uint2(pack2bf(a0[0], a0[1]), pack2bf(a0[2], a0[3]));
        *(uint2*)(sp + 16 * 64) = make_uint2(pack2bf(a1[0], a1[1]), pack2bf(a1[2], a1[3]));
    }
}

DEV void phase_x2(const Params& p, float* sm) {
    int chain, sub; chain_ids(chain, sub);
    const int b = chain >> 3, h = (chain >> 1) & 3, dir = chain & 1;
    const bf16_t* XC = (const bf16_t*)(p.ws + OFF_XC);
    float* GSC = (float*)(p.ws + OFF_GSC); const float* CSC = (const float*)(p.ws + OFF_CSC); const float* NBUF = (const float*)(p.ws + OFF_NBUF);
    const float* gtab = (const float*)(p.ws + OFF_GTAB);
    const bf16_t* SMAT = (const bf16_t*)(p.ws + OFF_SMAT);
    const int tid = opaque_tid();
    float* sD0 = sm; float* sCf = sm + 132; float* sN0 = sm + 264; float* sN2 = sN0 + 9 * 512;
    for (int i = tid; i < NCH; i += NTHR) { sD0[i] = CSC[(chain * NCH + i) * 2]; sCf[i] = CSC[(chain * NCH + i) * 2 + 1]; }
    __syncthreads();
    {
        float n = 0.f;
        const float* nb = NBUF + (size_t)chain * NCH * 512 + tid;
#pragma unroll 4
        for (int step = 0; step < NCH; ++step) {
            const int c = chunk_at(dir, step);
            if ((c & 15) == sub) sN0[(c >> 4) * 512 + tid] = n;
            n = sD0[c] * n + sCf[c] * nb[(size_t)c * 512];
        }
    }
    __syncthreads();
    {
        const int blk = tid >> 2, cp = tid & 3;
        const float4 g = ld4(gtab + (size_t)(h * 128 + blk) * 16 + cp * 4);
        for (int k = 0; sub + 16 * k < NCH; ++k) {
            const float* n0 = sN0 + k * 512 + blk * 4;
            sN2[k * 512 + tid] = g.x * n0[0] + g.y * n0[1] + g.z * n0[2] + g.w * n0[3];
        }
    }
    __syncthreads();
    const int t = tid >> 3, part = tid & 7;
    for (int k = 0; sub + 16 * k < NCH; ++k) {
        const int c = sub + 16 * k;
        const size_t row = (size_t)b * TB + c * 64 + t;
        float dint = 0.f;
        {
            const bf16_t* xp = XC + row * 2048 + h * 512 + part * 64;
            const float* n2 = sN2 + k * 512 + part * 64;
#pragma unroll
            for (int i = 0; i < 8; ++i) {
                float f[8]; unpack8(*(const uint4*)(xp + i * 8), f);
                const float4 na = ld4(n2 + i * 8), nb2 = ld4(n2 + i * 8 + 4);
                dint += f[0] * na.x + f[1] * na.y + f[2] * na.z + f[3] * na.w + f[4] * nb2.x + f[5] * nb2.y + f[6] * nb2.z + f[7] * nb2.w;
            }
        }
        float di = 0.f;
        {
            float f[8]; unpack8(*(const uint4*)(SMAT + ((size_t)((b * 4 + h) * NCH + c)) * 4096 + t * 64 + part * 8), f);
#pragma unroll
            for (int e = 0; e < 8; ++e) {
                const int s = part * 8 + e;
                const float beta = GSC[((size_t)chain * TB + c * 64 + s) * 4 + 1];
                const bool keep = dir ? (s >= t) : (s <= t);
                di += keep ? f[e] * beta : 0.f;
            }
        }
        dint += __shfl_xor(dint, 1, 64); dint += __shfl_xor(dint, 2, 64); dint += __shfl_xor(dint, 4, 64);
        di += __shfl_xor(di, 1, 64); di += __shfl_xor(di, 2, 64); di += __shfl_xor(di, 4, 64);
        if (part == 0) {
            float* gp = GSC + ((size_t)chain * TB + c * 64 + t) * 4;
            const float4 g4 = ld4(gp);
            const float den = g4.x * di + g4.z * dint;
            gp[3] = 1.f / fmaxf(fabsf(den), g4.w);
        }
    }
}

#define MLSTM_PREFETCH(step_) do { \
    const int c_ = chunk_at(dir, (step_)); const size_t rb_ = (size_t)b * TB + (size_t)c_ * 64; \
    { const bf16_t* xb_ = XC + (rb_ + (tid >> 6)) * 2048 + h * 512 + (tid & 63) * 8; \
      rx0 = *(const uint4*)(xb_); rx1 = *(const uint4*)(xb_ + 8 * 2048); rx2 = *(const uint4*)(xb_ + 16 * 2048); rx3 = *(const uint4*)(xb_ + 24 * 2048); \
      rx4 = *(const uint4*)(xb_ + 32 * 2048); rx5 = *(const uint4*)(xb_ + 40 * 2048); rx6 = *(const uint4*)(xb_ + 48 * 2048); rx7 = *(const uint4*)(xb_ + 56 * 2048); } \
    rxm = *(const uint2*)(XM + (rb_ + ps) * 2048 + ch0 + pvb * 4); \
    rs = *(const uint4*)(SMAT + ((size_t)((b * 4 + h) * NCH + c_)) * 4096 + ps * 64 + pvb * 8); \
    rbeta = GSC[((size_t)chain * TB + c_ * 64 + ps) * 4 + 1]; \
    if (tid < 64) rsc = ld4(GSC + ((size_t)chain * TB + c_ * 64 + tid) * 4); \
    rd0 = CSC[(chain * NCH + c_) * 2]; rcf = CSC[(chain * NCH + c_) * 2 + 1]; } while (0)

DEV void phase_mlstm(const Params& p, float* sm) {
    int chain, sub; chain_ids(chain, sub);
    const int b = chain >> 3, h = (chain >> 1) & 3, dir = chain & 1;
    const bf16_t* XM = (const bf16_t*)(p.ws + OFF_XM);
    const bf16_t* XC = (const bf16_t*)(p.ws + OFF_XC);
    const bf16_t* SMAT = (const bf16_t*)(p.ws + OFF_SMAT);
    const float* GSC = (const float*)(p.ws + OFF_GSC); const float* CSC = (const float*)(p.ws + OFF_CSC);
    const float* gtab = (const float*)(p.ws + OFF_GTAB);
    bf16_t* H = (bf16_t*)(p.ws + OFF_H);
    const float* wv = p.in[35];
    char* smc = (char*)sm;
    bf16_t* XCs = (bf16_t*)smc;
    bf16_t* Cs = (bf16_t*)(smc + 66560);
    bf16_t* Vb = (bf16_t*)(smc + 66560 + 33280);
    bf16_t* Vw = Vb + 32 * 72;
    bf16_t* Sm = Vw + 32 * 72;
    float* Gs = (float*)(smc + 66560 + 33280 + 2 * 4608 + 9216);
    float* sc = Gs + 2048;
    const int tid = opaque_tid(), lane = tid & 63, wave = tid >> 6;
    for (int i = tid; i < 32 * 520 / 2; i += NTHR) ((unsigned*)Cs)[i] = 0u;
    for (int i = tid; i < 2048; i += NTHR) Gs[i] = gtab[h * 2048 + i];
    const int ps = tid >> 3, pvb = tid & 7;
    const int ch0 = h * 512 + sub * 32;
    float wvr[16];
#pragma unroll
    for (int i = 0; i < 16; ++i) wvr[i] = wv[(size_t)((ch0 >> 2) + pvb) * 16 + i];
    f32x4 accS[4][2];
#pragma unroll
    for (int i = 0; i < 4; ++i) { accS[i][0] = (f32x4){0.f, 0.f, 0.f, 0.f}; accS[i][1] = (f32x4){0.f, 0.f, 0.f, 0.f}; }
    uint4 rx0, rx1, rx2, rx3, rx4, rx5, rx6, rx7; uint2 rxm; uint4 rs; float rbeta; float4 rsc = make_float4(0.f, 0.f, 0.f, 0.f); float rd0, rcf;
    MLSTM_PREFETCH(0);
    __syncthreads();
#pragma unroll 1
    for (int step = 0; step < NCH; ++step) {
        const int c = chunk_at(dir, step);
        const float d0 = rd0, cf = rcf;
        {
            bf16_t* xd = XCs + (tid >> 6) * 520 + (tid & 63) * 8;
            *(uint4*)(xd) = rx0; *(uint4*)(xd + 8 * 520) = rx1; *(uint4*)(xd + 16 * 520) = rx2; *(uint4*)(xd + 24 * 520) = rx3;
            *(uint4*)(xd + 32 * 520) = rx4; *(uint4*)(xd + 40 * 520) = rx5; *(uint4*)(xd + 48 * 520) = rx6; *(uint4*)(xd + 56 * 520) = rx7;
        }
        {
            const float x0 = bflo(rxm.x), x1 = bfhi(rxm.x), x2 = bflo(rxm.y), x3 = bfhi(rxm.y);
#pragma unroll
            for (int d = 0; d < 4; ++d) {
                const float v = (x0 * wvr[d] + x1 * wvr[4 + d] + x2 * wvr[8 + d] + x3 * wvr[12 + d]) * rbeta;
                Vb[(pvb * 4 + d) * 72 + ps] = __builtin_bit_cast(unsigned short, (__bf16)v);
                Vw[(pvb * 4 + d) * 72 + ps] = __builtin_bit_cast(unsigned short, (__bf16)(v * cf));
            }
        }
        {
#define SMASK(q_) (((dir ? (pvb * 8 + 2 * (q_) >= ps) : (pvb * 8 + 2 * (q_) <= ps)) ? 0x0000ffffu : 0u) | ((dir ? (pvb * 8 + 2 * (q_) + 1 >= ps) : (pvb * 8 + 2 * (q_) + 1 <= ps)) ? 0xffff0000u : 0u))
            *(uint4*)(Sm + ps * 72 + pvb * 8) = make_uint4(rs.x & SMASK(0), rs.y & SMASK(1), rs.z & SMASK(2), rs.w & SMASK(3));
#undef SMASK
        }
        if (tid < 64) st4(sc + tid * 4, rsc);
        { const int nstep = (step + 1 < NCH) ? step + 1 : step; MLSTM_PREFETCH(nstep); }
        __syncthreads();
        {
            const int vt = wave & 1, tt = wave >> 1;
            f32x4 ao = (f32x4){0.f, 0.f, 0.f, 0.f}, ai = ao;
            const bf16_t* ap = Cs + (vt * 16 + (lane & 15)) * 520 + (lane >> 4) * 8;
            const bf16_t* bp = XCs + (tt * 16 + (lane & 15)) * 520 + (lane >> 4) * 8;
#pragma unroll
            for (int ks = 0; ks < 16; ++ks) ao = __builtin_amdgcn_mfma_f32_16x16x32_bf16(*(const bf16x8*)(ap + ks * 32), *(const bf16x8*)(bp + ks * 32), ao, 0, 0, 0);
            const bf16_t* ap2 = Vb + (vt * 16 + (lane & 15)) * 72 + (lane >> 4) * 8;
            const bf16_t* bp2 = Sm + (tt * 16 + (lane & 15)) * 72 + (lane >> 4) * 8;
#pragma unroll
            for (int ks = 0; ks < 2; ++ks) ai = __builtin_amdgcn_mfma_f32_16x16x32_bf16(*(const bf16x8*)(ap2 + ks * 32), *(const bf16x8*)(bp2 + ks * 32), ai, 0, 0, 0);
            if (c >= 4) {
                const int t = tt * 16 + (lane & 15);
                const float4 s4 = ld4(sc + t * 4);
                const float h0 = (s4.x * ai[0] + s4.z * ao[0]) * s4.w, h1 = (s4.x * ai[1] + s4.z * ao[1]) * s4.w;
                const float h2 = (s4.x * ai[2] + s4.z * ao[2]) * s4.w, h3 = (s4.x * ai[3] + s4.z * ao[3]) * s4.w;
                bf16_t* hp = H + ((size_t)b * NL + (size_t)c * 64 + t - NCX) * 2048 + ch0 + vt * 16 + (lane >> 4) * 4;
                const unsigned u0 = pack2bf(h0, h1), u1 = pack2bf(h2, h3);
                __builtin_amdgcn_global_atomic_fadd_v2bf16((__attribute__((address_space(1))) s16x2*)hp, __builtin_bit_cast(s16x2, u0));
                __builtin_amdgcn_global_atomic_fadd_v2bf16((__attribute__((address_space(1))) s16x2*)(hp + 2), __builtin_bit_cast(s16x2, u1));
            }
        }
#pragma unroll
        for (int jt = 0; jt < 4; ++jt) { accS[jt][0] *= d0; accS[jt][1] *= d0; }
#pragma unroll
        for (int ks = 0; ks < 2; ++ks) {
            const bf16x8 b0 = *(const bf16x8*)(Vw + (lane & 15) * 72 + ks * 32 + (lane >> 4) * 8);
            const bf16x8 b1 = *(const bf16x8*)(Vw + (16 + (lane & 15)) * 72 + ks * 32 + (lane >> 4) * 8);
            const int row0 = ks * 32 + (lane >> 4) * 8 + ((lane & 15) >> 2);
#pragma unroll
            for (int jt = 0; jt < 4; ++jt) {
                const int col = wave * 64 + jt * 16 + (lane & 3) * 4;
                const s16x4 lo = __builtin_amdgcn_ds_read_tr16_b64_v4i16((__attribute__((address_space(3))) s16x4*)(XCs + row0 * 520 + col));
                const s16x4 hi = __builtin_amdgcn_ds_read_tr16_b64_v4i16((__attribute__((address_space(3))) s16x4*)(XCs + (row0 + 4) * 520 + col));
                const bf16x8 af = (bf16x8){lo[0], lo[1], lo[2], lo[3], hi[0], hi[1], hi[2], hi[3]};
                accS[jt][0] = __builtin_amdgcn_mfma_f32_16x16x32_bf16(af, b0, accS[jt][0], 0, 0, 0);
                accS[jt][1] = __builtin_amdgcn_mfma_f32_16x16x32_bf16(af, b1, accS[jt][1], 0, 0, 0);
            }
        }
        __syncthreads();
#pragma unroll
        for (int jt = 0; jt < 4; ++jt) {
            const int blk = wave * 16 + jt * 4 + (lane >> 4);
            const float4 g0 = ld4(Gs + blk * 16), g1 = ld4(Gs + blk * 16 + 4), g2 = ld4(Gs + blk * 16 + 8), g3 = ld4(Gs + blk * 16 + 12);
#pragma unroll
            for (int v2 = 0; v2 < 2; ++v2) {
                const f32x4 a = accS[jt][v2];
                const float o0 = g0.x * a[0] + g0.y * a[1] + g0.z * a[2] + g0.w * a[3];
                const float o1 = g1.x * a[0] + g1.y * a[1] + g1.z * a[2] + g1.w * a[3];
                const float o2 = g2.x * a[0] + g2.y * a[1] + g2.z * a[2] + g2.w * a[3];
                const float o3 = g3.x * a[0] + g3.y * a[1] + g3.z * a[2] + g3.w * a[3];
                *(uint2*)(Cs + (v2 * 16 + (lane & 15)) * 520 + blk * 4) = make_uint2(pack2bf(o0, o1), pack2bf(o2, o3));
            }
        }
    }
}

DEV void phase_finish1(const Params& p) {
    bf16_t* H = (bf16_t*)(p.ws + OFF_H);
    const bf16_t* XC = (const bf16_t*)(p.ws + OFF_XC);
    const bf16_t* Z = (const bf16_t*)(p.ws + OFF_XM);
    const float* ng = p.in[44]; const float* skip = p.in[45];
    const int tid_ = opaque_tid(); const int lane = tid_ & 63, gw = blockIdx.x * NWV + (tid_ >> 6), ngw = gridDim.x * NWV;
    for (int it = gw; it < NB * NL * 4; it += ngw) {
        const int r = it >> 2, h = it & 3, b = r >= NL ? 1 : 0, nn = r - b * NL;
        const int c0 = h * 512 + lane * 8;
        bf16_t* hp = H + (size_t)r * 2048 + c0;
        float v[8]; unpack8(*(const uint4*)hp, v);
        float sum = 0.f;
#pragma unroll
        for (int j = 0; j < 8; ++j) sum += v[j];
        const float mean = wave_sum(sum) * (1.f / 512.f);
        float sq = 0.f;
#pragma unroll
        for (int j = 0; j < 8; ++j) { v[j] -= mean; sq += v[j] * v[j]; }
        const float rstd = rsqrtf(wave_sum(sq) * (1.f / 512.f) + 1e-5f);
        float xc[8], z[8];
        unpack8(*(const uint4*)(XC + ((size_t)b * TB + NCX + nn) * 2048 + c0), xc);
        unpack8(*(const uint4*)(Z + (size_t)r * 2048 + c0), z);
        float o[8];
#pragma unroll
        for (int j = 0; j < 8; ++j) o[j] = (v[j] * rstd * ng[c0 + j] + skip[c0 + j] * xc[j]) * silu_f(z[j]);
        *(uint4*)hp = make_uint4(pack2bf(o[0], o[1]), pack2bf(o[2], o[3]), pack2bf(o[4], o[5]), pack2bf(o[6], o[7]));
    }
}

__global__ void __launch_bounds__(NTHR) fwd_kernel(Params p) {
    extern __shared__ __attribute__((aligned(16))) float sm[];
    cg::grid_group grid = cg::this_grid();
    const int tid = opaque_tid(), lane = tid & 63, wave = tid >> 6;
    float* modv = (float*)(p.ws + OFF_MODV);
    float* X1C = (float*)(p.ws + OFF_X1C);

    phase_mod(p, sm);
    phase_tables(p);
    transpose_convert(p.in[8], 1024, EIN, 3968, (bf16_t*)(p.ws + OFF_WT0), sm);
    transpose_convert(p.in[29], 1024, 4096, 4096, (bf16_t*)(p.ws + OFF_WT1), sm);
    transpose_convert(p.in[9], 1024, 1024, 1024, (bf16_t*)(p.ws + OFF_WT2), sm);
    transpose_convert(p.in[30], 2048, 1024, 1024, (bf16_t*)(p.ws + OFF_WT3), sm);
    grid.sync();

#pragma unroll 1
    for (int b = 0; b < NB; ++b) {
        {
            ALmod al{p.in[0], p.in[2], modv, b, 0};
            EPstoreBf ep{(bf16_t*)(p.ws + OFF_P0), EIN};
            gemm_mfma(TB, EIN, 3968, DM, (const bf16_t*)(p.ws + OFF_WT0), al, ep, sm);
            zero_f4((float*)(p.ws + OFF_YS), (size_t)TB * 1024);
            zero_f4((float*)(p.ws + OFF_BON), (size_t)TB * 8);
        }
        grid.sync();
        if (blockIdx.x < 32) {
            if (wave == 0) { const int u = blockIdx.x; rwkv_unit(p, u >> 2, (u >> 1) & 1, u & 1, sm, lane); }
        } else {
            for (int u = blockIdx.x - 32; u < 8 * NCH; u += gridDim.x - 32) gla1_unit(p, (u / NCH) >> 1, (u / NCH) & 1, u % NCH, sm);
        }
        grid.sync();
        if (blockIdx.x < 128) gla2_unit(p, blockIdx.x);
        grid.sync();
        for (int u = blockIdx.x; u < 4 * NCH; u += gridDim.x) gla3_unit(p, u / NCH, u % NCH, sm);
        phase_finish0r(p);
        grid.sync();
        {
            ALbf al{(const bf16_t*)(p.ws + OFF_YC), 1024};
            EPres ep{(float*)(p.ws + OFF_P0), 1024, p.in[0], p.in[2], modv, b, 0};
            gemm_mfma(TB, DM, DM, DM, (const bf16_t*)(p.ws + OFF_WT2), al, ep, sm);
        }
        grid.sync();
        ln_rows((const float*)(p.ws + OFF_P0), TB, p.in[6], p.in[7], p.out + (size_t)b * NL * DM, X1C + (size_t)b * NCX * DM, NCX);
        grid.sync();
    }

    {
        ALmodAll al{p.out, X1C, modv + 3 * 3072};
        EPstoreBf ep{(bf16_t*)(p.ws + OFF_XM), 2048};
        gemm_mfma(RT, 2048, 2048, DM, (const bf16_t*)(p.ws + OFF_WT1), al, ep, sm);
        zero_f4((float*)(p.ws + OFF_H), (size_t)NB * NL * 1024);
    }
    grid.sync();
    phase_conv1(p, sm);
    grid.sync();
    phase_x1(p, sm);
    grid.sync();
    phase_x2(p, sm);
    grid.sync();
    phase_mlstm(p, sm);
    grid.sync();
    {
        ALmodLat al{p.out, modv + 3 * 3072};
        EPstoreBf ep{(bf16_t*)(p.ws + OFF_XM), 2048};
        gemm_mfma(NB * NL, 2048, 2048, DM, (const bf16_t*)(p.ws + OFF_WT1) + (size_t)2048 * 1024, al, ep, sm);
    }
    grid.sync();
    phase_finish1(p);
    grid.sync();
    {
        ALbf al{(const bf16_t*)(p.ws + OFF_H), 2048};
        EPresLat ep{(float*)(p.ws + OFF_XC), p.out, modv + 3 * 3072};
        gemm_mfma(NB * NL, DM, DM, 2048, (const bf16_t*)(p.ws + OFF_WT3), al, ep, sm);
    }
    grid.sync();
    ln_rows((const float*)(p.ws + OFF_XC), NB * NL, p.in[6] + 1024, p.in[7] + 1024, p.out, p.out, 0);
}

extern "C" void kernel_launch(void* const* d_in, const int* in_sizes, int n_in, void* d_out, int out_size, void* d_ws, size_t ws_size, hipStream_t stream) {
    static int grid_blocks = 0;
    if (grid_blocks == 0) {
        if (ws_size < WS_NEED || n_in != 46) { fprintf(stderr, "kernel_launch: bad ws_size %zu (need %zu) or n_in %d\n", ws_size, (size_t)WS_NEED, n_in); grid_blocks = -1; return; }
        int dev = 0, cus = 0, per_cu = 0;
        (void)hipGetDevice(&dev);
        (void)hipDeviceGetAttribute(&cus, hipDeviceAttributeMultiprocessorCount, dev);
        (void)hipFuncSetAttribute((const void*)fwd_kernel, hipFuncAttributeMaxDynamicSharedMemorySize, LDS_BYTES);
        (void)hipOccupancyMaxActiveBlocksPerMultiprocessor(&per_cu, (const void*)fwd_kernel, NTHR, LDS_BYTES);
        if (per_cu < 1 || cus < 256) { fprintf(stderr, "kernel_launch: occupancy query says %d blocks/CU on %d CUs; this kernel needs 256 resident workgroups\n", per_cu, cus); grid_blocks = -1; return; }
        grid_blocks = 256;
    }
    if (grid_blocks < 0) return;
    Params p{};
    for (int i = 0; i < 46; ++i) p.in[i] = (const float*)d_in[i];
    p.out = (float*)d_out; p.ws = (char*)d_ws;
    void* args[] = {&p};
    hipError_t e = hipLaunchCooperativeKernel((const void*)fwd_kernel, dim3(grid_blocks), dim3(NTHR), args, LDS_BYTES, stream);
    if (e != hipSuccess) fprintf(stderr, "cooperative launch failed: %s (grid %d)\n", hipGetErrorString(e), grid_blocks);
}
```

```cpp
#include <hip/hip_runtime.h>
#include <hip/hip_cooperative_groups.h>
#include <cstdio>
#include <cmath>
namespace cg = cooperative_groups;

#define DEV __device__ __forceinline__
#define DBG_DIRMASK 3
#define DBG_CMIN 0
#define DBG_CMAX 132
#define DBG_TITERS 5
#define DBG_TSLOT 2
#define DBG_SELFTEST 0
#define DBG_MODE 1

constexpr int NB = 2, NL = 8192, DM = 1024, NCX = 256, TB = NCX + NL;
constexpr int RT = NB * TB;
constexpr int NCH = TB / 64;
constexpr int EIN = 3872, RW0 = 1568;
constexpr int NTHR = 512, NWV = 8;
constexpr float ALPHA = 1.41421356237f;
constexpr float KSCALE = 0.04419417382f;

constexpr size_t OFF_MODV = 0;
constexpr size_t OFF_X1C  = 131072;
constexpr size_t OFF_BIG  = 4194304;
constexpr size_t OFF_P0   = OFF_BIG;
constexpr size_t OFF_YC   = OFF_BIG + (size_t)TB * EIN * 2;
constexpr size_t OFF_GDS  = OFF_YC + (size_t)TB * 1024 * 2;
constexpr size_t OFF_GDEC = OFF_GDS + (size_t)8 * NCH * 8192 * 4;
constexpr size_t OFF_RU   = OFF_GDEC + (size_t)8 * NCH * 64 * 4;
constexpr size_t OFF_RS0  = OFF_RU + (size_t)16 * NCH * 16384 * 2;
constexpr size_t OFF_BONS = OFF_RS0 + (size_t)16 * NCH * 4096 * 2;
constexpr size_t L0_END   = OFF_BONS + (size_t)2 * TB * 8 * 4;
constexpr size_t OFF_XM   = OFF_BIG;
constexpr size_t OFF_XC   = OFF_XM + (size_t)RT * 2048 * 2;
constexpr size_t OFF_H    = OFF_XC + (size_t)RT * 2048 * 2;
constexpr size_t OFF_WT0  = OFF_H + (size_t)NB * NL * 2048 * 2;
constexpr size_t OFF_WT1  = OFF_WT0 + (size_t)3968 * 1024 * 2;
constexpr size_t OFF_WT2  = OFF_WT1 + (size_t)4096 * 1024 * 2;
constexpr size_t OFF_WT3  = OFF_WT2 + (size_t)1024 * 1024 * 2;
constexpr size_t OFF_G16  = OFF_WT3 + (size_t)1024 * 2048 * 2;
constexpr size_t OFF_SMAT = OFF_G16 + (size_t)RT * 16 * 4;
constexpr size_t OFF_GSC  = OFF_SMAT + (size_t)NB * 4 * NCH * 4096 * 2;
constexpr size_t OFF_CSC  = OFF_GSC + (size_t)16 * TB * 4 * 4;
constexpr size_t OFF_NBUF = OFF_CSC + (size_t)16 * NCH * 2 * 4;
constexpr size_t OFF_GTAB = OFF_NBUF + (size_t)16 * NCH * 512 * 4;
constexpr size_t OFF_WFOLD = OFF_GTAB + (size_t)4 * 128 * 16 * 4;
constexpr size_t WS_NEED  = OFF_WFOLD + (size_t)4096 * 16 * 4;

static_assert(L0_END <= OFF_WT0, "layer-0 buffers overlap the weight copies");
constexpr int LDS_BYTES = 139264;

struct Params { const float* in[46]; float* out; char* ws; };
typedef unsigned short bf16_t;
typedef __attribute__((ext_vector_type(8))) short bf16x8;
typedef __attribute__((ext_vector_type(4))) short s16x4;
typedef __attribute__((ext_vector_type(2))) short s16x2;
typedef __attribute__((ext_vector_type(4))) float f32x4;
typedef __attribute__((ext_vector_type(2))) __bf16 bf2_t;
DEV unsigned pack2bf(float lo, float hi) { bf2_t v; v[0] = (__bf16)lo; v[1] = (__bf16)hi; return __builtin_bit_cast(unsigned, v); }
DEV float bflo(unsigned u) { return __uint_as_float(u << 16); }
DEV float bfhi(unsigned u) { return __uint_as_float(u & 0xffff0000u); }
DEV float bf2f(bf16_t v) { return __uint_as_float(((unsigned)v) << 16); }
DEV void unpack8(uint4 u, float* f) { f[0] = bflo(u.x); f[1] = bfhi(u.x); f[2] = bflo(u.y); f[3] = bfhi(u.y); f[4] = bflo(u.z); f[5] = bfhi(u.z); f[6] = bflo(u.w); f[7] = bfhi(u.w); }

DEV float wave_sum(float v) {
#pragma unroll
    for (int o = 32; o > 0; o >>= 1) v += __shfl_xor(v, o, 64);
    return v;
}
DEV float wave_max(float v) {
#pragma unroll
    for (int o = 32; o > 0; o >>= 1) v = fmaxf(v, __shfl_xor(v, o, 64));
    return v;
}
DEV float sigmoid_f(float x) { return 1.f / (1.f + expf(-x)); }
DEV float silu_f(float x) { return x / (1.f + expf(-x)); }
DEV float logsig_f(float x) { return fminf(x, 0.f) - log1pf(expf(-fabsf(x))); }
DEV void lds_fence() { asm volatile("" ::: "memory"); }
DEV int opaque_tid() { int t = threadIdx.x; asm volatile("" : "+v"(t)); return t; }
DEV int scan_s(int dir, int u) { return dir == 0 ? u : (u < NCX ? (NCX - 1 - u) : (TB - 1 + NCX - u)); }
DEV int chunk_at(int dir, int step) { return dir == 0 ? step : (step < 4 ? 3 - step : (NCH + 3 - step)); }
DEV float4 ld4(const float* p) { return *(const float4*)p; }
DEV void st4(float* p, float4 v) { *(float4*)p = v; }

template <class AL, class EP>
DEV void gemm_mfma(int M, int N, int Npad, int K, const bf16_t* Wt, AL al, EP ep, float* smf) {
    constexpr int LDT = 40;
    bf16_t* As = (bf16_t*)smf;
    bf16_t* Bs = As + 2 * 256 * LDT;
    const int tid = opaque_tid(), lane = tid & 63, wave = tid >> 6, wm = wave & 3, wn = wave >> 2;
    const int mt = M / 256, nt = Npad / 128, nks = K / 32;
    const int lr = tid >> 1, lk = (tid & 1) * 16;
    const int br = tid >> 2, bk = (tid & 3) * 8;
    for (int tile = blockIdx.x; tile < mt * nt; tile += gridDim.x) {
        const int tm = tile / nt, tn = tile % nt, m0 = tm * 256, n0 = tn * 128;
        f32x4 acc[4][4];
#pragma unroll
        for (int i = 0; i < 4; ++i)
#pragma unroll
            for (int j = 0; j < 4; ++j) acc[i][j] = (f32x4){0.f, 0.f, 0.f, 0.f};
        float4 ra[4]; uint4 rb0;
        const bf16_t* wrow = Wt + (size_t)(n0 + br) * K + bk;
#pragma unroll
        for (int i = 0; i < 4; ++i) ra[i] = al(m0 + lr, lk + i * 4);
        rb0 = *(const uint4*)(wrow);
        __syncthreads();
        {
            uint4 w0 = make_uint4(pack2bf(ra[0].x, ra[0].y), pack2bf(ra[0].z, ra[0].w), pack2bf(ra[1].x, ra[1].y), pack2bf(ra[1].z, ra[1].w));
            uint4 w1 = make_uint4(pack2bf(ra[2].x, ra[2].y), pack2bf(ra[2].z, ra[2].w), pack2bf(ra[3].x, ra[3].y), pack2bf(ra[3].z, ra[3].w));
            *(uint4*)(As + lr * LDT + lk) = w0; *(uint4*)(As + lr * LDT + lk + 8) = w1;
            *(uint4*)(Bs + br * LDT + bk) = rb0;
        }
        __syncthreads();
#pragma unroll 1
        for (int ks = 0; ks < nks; ++ks) {
            const int buf = ks & 1;
            if (ks + 1 < nks) {
                const int k1 = (ks + 1) * 32;
#pragma unroll
                for (int i = 0; i < 4; ++i) ra[i] = al(m0 + lr, k1 + lk + i * 4);
                rb0 = *(const uint4*)(wrow + k1);
            }
            const bf16_t* Ab = As + buf * 256 * LDT; const bf16_t* Bb = Bs + buf * 128 * LDT;
            bf16x8 wf[4], af[4];
#pragma unroll
            for (int i = 0; i < 4; ++i) wf[i] = *(const bf16x8*)(Bb + (wn * 64 + i * 16 + (lane & 15)) * LDT + (lane >> 4) * 8);
#pragma unroll
            for (int j = 0; j < 4; ++j) af[j] = *(const bf16x8*)(Ab + (wm * 64 + j * 16 + (lane & 15)) * LDT + (lane >> 4) * 8);
#pragma unroll
            for (int i = 0; i < 4; ++i)
#pragma unroll
                for (int j = 0; j < 4; ++j) acc[i][j] = __builtin_amdgcn_mfma_f32_16x16x32_bf16(wf[i], af[j], acc[i][j], 0, 0, 0);
            if (ks + 1 < nks) {
                bf16_t* An = As + (buf ^ 1) * 256 * LDT; bf16_t* Bn = Bs + (buf ^ 1) * 128 * LDT;
                uint4 w0 = make_uint4(pack2bf(ra[0].x, ra[0].y), pack2bf(ra[0].z, ra[0].w), pack2bf(ra[1].x, ra[1].y), pack2bf(ra[1].z, ra[1].w));
                uint4 w1 = make_uint4(pack2bf(ra[2].x, ra[2].y), pack2bf(ra[2].z, ra[2].w), pack2bf(ra[3].x, ra[3].y), pack2bf(ra[3].z, ra[3].w));
                *(uint4*)(An + lr * LDT + lk) = w0; *(uint4*)(An + lr * LDT + lk + 8) = w1;
                *(uint4*)(Bn + br * LDT + bk) = rb0;
            }
            __syncthreads();
        }
#pragma unroll
        for (int i = 0; i < 4; ++i) {
            const int n = n0 + wn * 64 + i * 16 + (lane >> 4) * 4;
            if (n < N) {
#pragma unroll
                for (int j = 0; j < 4; ++j) {
                    const int m = m0 + wm * 64 + j * 16 + (lane & 15);
                    ep(m, n, make_float4(acc[i][j][0], acc[i][j][1], acc[i][j][2], acc[i][j][3]));
                }
            }
        }
    }
}

DEV void transpose_convert(const float* __restrict__ W, int K, int N, int Npad, bf16_t* Wt, float* sm) {
    float (*T)[65] = (float (*)[65])sm;
    const int tid = opaque_tid();
    const int kt = K / 64, ntl = Npad / 64;
    for (int tile = blockIdx.x; tile < kt * ntl; tile += gridDim.x) {
        const int k0 = (tile / ntl) * 64, n0 = (tile % ntl) * 64;
        __syncthreads();
#pragma unroll
        for (int i = 0; i < 2; ++i) {
            const int k = (tid >> 4) + 32 * i, n4 = (tid & 15) * 4;
            float4 v = make_float4(0.f, 0.f, 0.f, 0.f);
            if (n0 + n4 < N) v = ld4(W + (size_t)(k0 + k) * N + n0 + n4);
            T[k][n4] = v.x; T[k][n4 + 1] = v.y; T[k][n4 + 2] = v.z; T[k][n4 + 3] = v.w;
        }
        __syncthreads();
        const int n = tid >> 3, kq = (tid & 7) * 8;
        unsigned o[4];
#pragma unroll
        for (int j = 0; j < 4; ++j) o[j] = pack2bf(T[kq + 2 * j][n], T[kq + 2 * j + 1][n]);
        bf16_t* dst = Wt + (size_t)(n0 + n) * K + k0 + kq;
        *(uint4*)dst = make_uint4(o[0], o[1], o[2], o[3]);
    }
}

struct ALmod {
    const float* lat; const float* cx; const float* mv; int b; int s0;
    DEV float4 operator()(int r, int k) const {
        const int s = r + s0;
        const float* src; int j;
        if (s < NCX) { src = cx + ((size_t)(b * NCX + s)) * DM + k; j = 2; }
        else { src = lat + ((size_t)(b * NL + s - NCX)) * DM + k; j = b; }
        float4 a = ld4(src);
        const float* m = mv + j * 3072;
        float4 sh = ld4(m + k), sc = ld4(m + 1024 + k);
        return make_float4(a.x * (1.f + sc.x) + sh.x, a.y * (1.f + sc.y) + sh.y, a.z * (1.f + sc.z) + sh.z, a.w * (1.f + sc.w) + sh.w);
    }
};
struct ALmodAll {
    const float* lat; const float* cx; const float* mv;
    DEV float4 operator()(int rr, int k) const {
        const int b = rr >= TB ? 1 : 0, s = rr - b * TB;
        const float* src; int j;
        if (s < NCX) { src = cx + ((size_t)(b * NCX + s)) * DM + k; j = 2; }
        else { src = lat + ((size_t)(b * NL + s - NCX)) * DM + k; j = b; }
        float4 a = ld4(src);
        const float* m = mv + j * 3072;
        float4 sh = ld4(m + k), sc = ld4(m + 1024 + k);
        return make_float4(a.x * (1.f + sc.x) + sh.x, a.y * (1.f + sc.y) + sh.y, a.z * (1.f + sc.z) + sh.z, a.w * (1.f + sc.w) + sh.w);
    }
};
struct ALmodLat {
    const float* lat; const float* mv;
    DEV float4 operator()(int r, int k) const {
        const int b = r >= NL ? 1 : 0;
        float4 a = ld4(lat + (size_t)r * DM + k);
        const float* m = mv + b * 3072;
        float4 sh = ld4(m + k), sc = ld4(m + 1024 + k);
        return make_float4(a.x * (1.f + sc.x) + sh.x, a.y * (1.f + sc.y) + sh.y, a.z * (1.f + sc.z) + sh.z, a.w * (1.f + sc.w) + sh.w);
    }
};
struct ALplain { const float* A; int lda; DEV float4 operator()(int r, int k) const { return ld4(A + (size_t)r * lda + k); } };
struct ALbf { const bf16_t* A; int lda; DEV float4 operator()(int r, int k) const { const uint2 u = *(const uint2*)(A + (size_t)r * lda + k); return make_float4(bflo(u.x), bfhi(u.x), bflo(u.y), bfhi(u.y)); } };
struct EPstore { float* C; int ldc; DEV void operator()(int r, int c, float4 v) const { st4(C + (size_t)r * ldc + c, v); } };
struct EPstoreBf { bf16_t* C; int ldc; DEV void operator()(int r, int c, float4 v) const { *(uint2*)(C + (size_t)r * ldc + c) = make_uint2(pack2bf(v.x, v.y), pack2bf(v.z, v.w)); } };
struct EPres {
    float* C; int ldc; const float* lat; const float* cx; const float* mv; int b; int s0;
    DEV void operator()(int r, int c, float4 v) const {
        const int s = r + s0;
        const float* src; int j;
        if (s < NCX) { src = cx + ((size_t)(b * NCX + s)) * DM + c; j = 2; }
        else { src = lat + ((size_t)(b * NL + s - NCX)) * DM + c; j = b; }
        float4 x = ld4(src);
        float4 g = ld4(mv + j * 3072 + 2048 + c);
        st4(C + (size_t)r * ldc + c, make_float4(ALPHA * x.x + g.x * v.x, ALPHA * x.y + g.y * v.y, ALPHA * x.z + g.z * v.z, ALPHA * x.w + g.w * v.w));
    }
};
struct EPresLat {
    float* C; const float* lat; const float* mv;
    DEV void operator()(int r, int c, float4 v) const {
        const int b = r >= NL ? 1 : 0;
        float4 x = ld4(lat + (size_t)r * DM + c);
        float4 g = ld4(mv + b * 3072 + 2048 + c);
        st4(C + (size_t)r * DM + c, make_float4(ALPHA * x.x + g.x * v.x, ALPHA * x.y + g.y * v.y, ALPHA * x.z + g.z * v.z, ALPHA * x.w + g.w * v.w));
    }
};

DEV void phase_mod(const Params& p, float* sm) {
    const float* c = p.in[1]; const float* cctx = p.in[3];
    const float* mod_w = p.in[4]; const float* mod_b = p.in[5];
    float* modv = (float*)(p.ws + OFF_MODV);
    float* sil = sm; float* red = sm + 3072;
    const int tid = opaque_tid();
    for (int i = tid; i < 3072; i += NTHR) {
        const int j = i >> 10, k = i & 1023;
        const float v = (j < 2) ? c[j * 1024 + k] : cctx[k];
        sil[i] = silu_f(v);
    }
    __syncthreads();
    for (int unit = blockIdx.x; unit < 192; unit += gridDim.x) {
        const int l = unit / 96, cb = unit % 96;
        const int kg = tid >> 5, col = tid & 31, n = cb * 32 + col;
        const float* w = mod_w + (size_t)l * 1024 * 3072 + n;
        float a0 = 0.f, a1 = 0.f, a2 = 0.f;
        for (int k = kg * 64; k < kg * 64 + 64; ++k) {
            const float wv = w[(size_t)k * 3072];
            a0 += sil[k] * wv; a1 += sil[1024 + k] * wv; a2 += sil[2048 + k] * wv;
        }
        red[(kg * 3 + 0) * 32 + col] = a0; red[(kg * 3 + 1) * 32 + col] = a1; red[(kg * 3 + 2) * 32 + col] = a2;
        __syncthreads();
        if (tid < 96) {
            const int j = tid >> 5, cc = tid & 31, nn = cb * 32 + cc;
            float s = mod_b[l * 3072 + nn];
            for (int g = 0; g < 16; ++g) s += red[(g * 3 + j) * 32 + cc];
            modv[(l * 3 + j) * 3072 + nn] = s;
        }
        __syncthreads();
    }
}

DEV void phase_tables(const Params& p) {
    const float* wq = p.in[33]; const float* wk = p.in[34]; const float* wv = p.in[35];
    const float* gw0 = p.in[36]; const float* gw1 = p.in[38]; const float* gw2 = p.in[40]; const float* gw3 = p.in[42];
    float* gtab = (float*)(p.ws + OFF_GTAB); float* wfold = (float*)(p.ws + OFF_WFOLD);
    const int gt = blockIdx.x * NTHR + opaque_tid(), gn = gridDim.x * NTHR;
    for (int i = gt; i < 512 * 16; i += gn) {
        const int gb = i >> 4, cp = (i >> 2) & 3, c = i & 3;
        float s = 0.f;
#pragma unroll
        for (int d = 0; d < 4; ++d) s += wq[gb * 16 + cp * 4 + d] * wk[gb * 16 + c * 4 + d];
        gtab[i] = s * KSCALE;
    }
    for (int i = gt; i < 4096 * 16; i += gn) {
        const int k = i >> 4, g = i & 15, gm = g >> 2, hd = g & 3;
        const float* wg = gm == 0 ? gw0 : (gm == 1 ? gw1 : (gm == 2 ? gw2 : gw3));
        float s = 0.f;
        if (k < 2048) {
            const int blk = k >> 2, cc = k & 3;
#pragma unroll
            for (int d = 0; d < 4; ++d) s += wq[blk * 16 + cc * 4 + d] * wg[(size_t)(4 * blk + d) * 4 + hd] + wk[blk * 16 + cc * 4 + d] * wg[(size_t)(2048 + 4 * blk + d) * 4 + hd];
        } else {
            const int kk = k - 2048, blk = kk >> 2, cc = kk & 3;
#pragma unroll
            for (int d = 0; d < 4; ++d) s += wv[blk * 16 + cc * 4 + d] * wg[(size_t)(4096 + 4 * blk + d) * 4 + hd];
        }
        wfold[i] = s;
    }
}

#ifdef RWKV_DEBUG
DEV float rw_mix(const bf16_t* P0, int s, int c, const float* __restrict__ mu) {
    const float own = bf2f(P0[(size_t)s * EIN + RW0 + c]);
    const int d = c & 3;
    int ns = -1;
    if (s < NCX) {
        if (d == 0) ns = (s > 0) ? s - 1 : -1;
        else if (d == 1) ns = (s < NCX - 1) ? s + 1 : -1;
    } else {
        const int n = s - NCX, rr = n >> 6, cc = n & 63;
        if (d == 0) ns = (cc > 0) ? s - 1 : -1;
        else if (d == 1) ns = (cc < 63) ? s + 1 : -1;
        else if (d == 2) ns = (rr > 0) ? s - 64 : -1;
        else ns = (rr < 127) ? s + 64 : -1;
    }
    const float nb = (ns >= 0) ? bf2f(P0[(size_t)ns * EIN + RW0 + c]) : 0.f;
    return own + (nb - own) * mu[c];
}

DEV void rwkv_unit(const Params& p, int h, int dir, int rh, float* sm, int lane) {
    asm volatile("" : "+v"(lane));
    const bf16_t* P0 = (const bf16_t*)(p.ws + OFF_P0);
    float* YS = p.out;
    float* BON = (float*)(p.ws + OFF_X1C);
    const float* mu = p.in[15];
    const float* w0 = p.in[dir ? 18 : 16]; const float* ww2 = p.in[dir ? 19 : 17];
    const float* a0 = p.in[dir ? 22 : 20]; const float* wa2 = p.in[dir ? 23 : 21];
    const float* k_k = p.in[24]; const float* k_a = p.in[25]; const float* r_k = p.in[26];
    float* sR = sm; float* sW = sm + 4096; float* sK = sm + 8192; float* sA = sm + 12288; float* sB = sm + 16384; float* sV = sm + 20480;
    const int hc = h * 64 + lane;
    const float w0j = w0[hc], a0j = a0[hc], kkj = k_k[hc], kaj = k_a[hc], rkj = r_k[hc];
    const int row = rh * 32 + (lane & 31), kh0 = (lane >> 5) * 32;
    float* sWW = sm + 24576; float* sWA = sm + 28672;
#pragma unroll 4
    for (int i = 0; i < 64; ++i) { sWW[i * 64 + lane] = ww2[i * 512 + hc]; sWA[i * 64 + lane] = wa2[i * 512 + hc]; }
    float S[32];
#pragma unroll
    for (int k = 0; k < 32; ++k) S[k] = 0.f;
    const int cwl = 2048 + dir * 64, cal = 2176 + dir * 64;
#pragma unroll 1
    for (int cu = 0; cu < TB / 64; ++cu) {
        lds_fence();
#pragma unroll 1
        for (int t = 0; t < 64; ++t) {
            const int s = scan_s(dir, cu * 64 + t);
            sR[t * 64 + lane] = rw_mix(P0, s, h * 64 + lane, mu);
            sK[t * 64 + lane] = rw_mix(P0, s, 512 + h * 64 + lane, mu);
            sV[t * 64 + lane] = rw_mix(P0, s, 1024 + h * 64 + lane, mu);
            sA[t * 64 + lane] = tanhf(rw_mix(P0, s, cwl + lane, mu));
            sB[t * 64 + lane] = rw_mix(P0, s, cal + lane, mu);
        }
        lds_fence();
        {
            const float* wr = sWW + lane; asm volatile("" : "+v"(wr));
            float wc[64];
#pragma unroll
            for (int i = 0; i < 64; ++i) wc[i] = wr[i * 64];
#pragma unroll 1
            for (int t = 0; t < 64; ++t) {
                float accw = w0j;
#pragma unroll
                for (int i4 = 0; i4 < 16; ++i4) {
                    const float4 x = ld4(&sA[t * 64 + i4 * 4]);
                    accw += x.x * wc[i4 * 4] + x.y * wc[i4 * 4 + 1] + x.z * wc[i4 * 4 + 2] + x.w * wc[i4 * 4 + 3];
                }
                sW[t * 64 + lane] = expf(-0.6065306597f * sigmoid_f(accw));
            }
        }
        lds_fence();
        {
            const float* ar = sWA + lane; asm volatile("" : "+v"(ar));
            float ac[64];
#pragma unroll
            for (int i = 0; i < 64; ++i) ac[i] = ar[i * 64];
#pragma unroll 1
            for (int t = 0; t < 64; ++t) {
                float acca = a0j;
#pragma unroll
                for (int i4 = 0; i4 < 16; ++i4) {
                    const float4 y = ld4(&sB[t * 64 + i4 * 4]);
                    acca += y.x * ac[i4 * 4] + y.y * ac[i4 * 4 + 1] + y.z * ac[i4 * 4 + 2] + y.w * ac[i4 * 4 + 3];
                }
                const float av = sigmoid_f(acca);
                const float kraw = sK[t * 64 + lane];
                const float kkv = kraw * kkj;
                const float ss = wave_sum(kkv * kkv);
                const float kk = kkv * rsqrtf(fmaxf(ss, 1e-24f));
                const float kh = kraw * (1.f + (av - 1.f) * kaj);
                const float r = sR[t * 64 + lane];
                const float bon = wave_sum(r * kh * rkj);
                lds_fence();
                sK[t * 64 + lane] = kh; sA[t * 64 + lane] = -kk; sB[t * 64 + lane] = kk * av;
                if (lane == 0 && rh == 0) { const int s = scan_s(dir, cu * 64 + t); atomicAdd(&BON[s * 8 + h], bon); }
            }
        }
        lds_fence();
        if (cu == 0 && dir == 0 && rh == 0) {
            float* DBO = p.out + 9000000;
            for (int t = 0; t < 64; ++t) { float* d = DBO + ((size_t)(h * 64 + t) * 64 + lane) * 6; d[0] = sW[t * 64 + lane]; d[1] = sK[t * 64 + lane]; d[2] = sA[t * 64 + lane]; d[3] = sB[t * 64 + lane]; d[4] = sR[t * 64 + lane]; d[5] = sV[t * 64 + lane]; }
        }
#pragma unroll 1
        for (int t = 0; t < 64; ++t) {
            const float vi = sV[t * 64 + row];
            float sa = 0.f;
#pragma unroll
            for (int k4 = 0; k4 < 8; ++k4) {
                const float4 a4 = ld4(&sA[t * 64 + kh0 + k4 * 4]);
                sa += S[k4 * 4] * a4.x + S[k4 * 4 + 1] * a4.y + S[k4 * 4 + 2] * a4.z + S[k4 * 4 + 3] * a4.w;
            }
            sa += __shfl_xor(sa, 32, 64);
            float y = 0.f;
#pragma unroll
            for (int k4 = 0; k4 < 8; ++k4) {
                const float4 w4 = ld4(&sW[t * 64 + kh0 + k4 * 4]);
                const float4 b4 = ld4(&sB[t * 64 + kh0 + k4 * 4]);
                const float4 h4 = ld4(&sK[t * 64 + kh0 + k4 * 4]);
                const float4 r4 = ld4(&sR[t * 64 + kh0 + k4 * 4]);
                S[k4 * 4 + 0] = S[k4 * 4 + 0] * w4.x + sa * b4.x + vi * h4.x;
                S[k4 * 4 + 1] = S[k4 * 4 + 1] * w4.y + sa * b4.y + vi * h4.y;
                S[k4 * 4 + 2] = S[k4 * 4 + 2] * w4.z + sa * b4.z + vi * h4.z;
                S[k4 * 4 + 3] = S[k4 * 4 + 3] * w4.w + sa * b4.w + vi * h4.w;
                y += S[k4 * 4] * r4.x + S[k4 * 4 + 1] * r4.y + S[k4 * 4 + 2] * r4.z + S[k4 * 4 + 3] * r4.w;
            }
            y += __shfl_xor(y, 32, 64);
            if (lane < 32) { const int s = scan_s(dir, cu * 64 + t); atomicAdd(&YS[(size_t)s * 1024 + 512 + h * 64 + row], y); }
        }
    }
}

#endif
DEV void gla_decay(const bf16_t* P0, int c, int h, int dir, const float* __restrict__ wa2, const float* __restrict__ ba,
                   float* sLR, float* sWA, float* sBC, float* sTot, int tid) {
    for (int i = tid; i < 1024; i += NTHR) { const int t = i >> 4, j = i & 15; sLR[i] = bf2f(P0[(size_t)(c * 64 + t) * EIN + 1536 + dir * 16 + j]); }
    for (int i = tid; i < 1024; i += NTHR) { const int ii = i >> 6, k = i & 63; sWA[i] = wa2[ii * 256 + h * 64 + k]; }
    __syncthreads();
    {
        const int t = tid >> 3, k0 = (tid & 7) * 8;
        float acc[8];
#pragma unroll
        for (int j = 0; j < 8; ++j) acc[j] = ba[h * 64 + k0 + j];
#pragma unroll
        for (int ii = 0; ii < 16; ++ii) {
            const float l = sLR[t * 16 + ii];
#pragma unroll
            for (int j = 0; j < 8; ++j) acc[j] += l * sWA[ii * 64 + k0 + j];
        }
#pragma unroll
        for (int j = 0; j < 8; ++j) sBC[t * 65 + k0 + j] = logsig_f(acc[j]) * 0.0625f;
    }
    __syncthreads();
    if (tid < 64) {
        float run = 0.f;
        for (int step = 0; step < 64; ++step) { const int t = dir ? 63 - step : step; run += sBC[t * 65 + tid]; sBC[t * 65 + tid] = run; }
        sTot[tid] = run;
    }
    __syncthreads();
}
DEV bf16x8 tr_frag(const bf16_t* base, int ld, int row0, int col0, int lane) {
    const bf16_t* ptr = base + (row0 + (lane >> 4) * 8 + ((lane & 15) >> 2)) * ld + col0 + (lane & 3) * 4;
    const s16x4 lo = __builtin_amdgcn_ds_read_tr16_b64_v4i16((__attribute__((address_space(3))) s16x4*)ptr);
    const s16x4 hi = __builtin_amdgcn_ds_read_tr16_b64_v4i16((__attribute__((address_space(3))) s16x4*)(ptr + 4 * ld));
    return (bf16x8){lo[0], lo[1], lo[2], lo[3], hi[0], hi[1], hi[2], hi[3]};
}
DEV bf16x8 row_frag(const bf16_t* base, int ld, int idx0, int k0, int lane) {
    return *(const bf16x8*)(base + (idx0 + (lane & 15)) * ld + k0 + (lane >> 4) * 8);
}

DEV void gla1_unit(const Params& p, int h, int dir, int c, float* sm) {
    const int tid = opaque_tid(), lane = tid & 63, wave = tid >> 6;
    const bf16_t* P0 = (const bf16_t*)(p.ws + OFF_P0);
    float* GDS = (float*)(p.ws + OFF_GDS); float* GDEC = (float*)(p.ws + OFF_GDEC);
    const float* wa2 = p.in[dir ? 12 : 10]; const float* ba = p.in[dir ? 13 : 11];
    float* sLR = sm; float* sWA = sm + 1024; float* sBC = sm + 2048; float* sTot = sm + 6208;
    bf16_t* kT = (bf16_t*)(sm + 6272);
    bf16_t* Vs = (bf16_t*)(sm + 8576);
    const int ch = h * 2 + dir;
    __syncthreads();
    gla_decay(P0, c, h, dir, wa2, ba, sLR, sWA, sBC, sTot, tid);
    {
        const int t = tid >> 3, k0 = (tid & 7) * 8;
        float kv[8]; unpack8(*(const uint4*)(P0 + (size_t)(c * 64 + t) * EIN + 256 + h * 64 + k0), kv);
#pragma unroll
        for (int j = 0; j < 8; ++j) kT[(k0 + j) * 72 + t] = __builtin_bit_cast(unsigned short, (__bf16)(kv[j] * expf(sTot[k0 + j] - sBC[t * 65 + k0 + j])));
#pragma unroll
        for (int u = 0; u < 2; ++u) { const int i = tid + 512 * u, row = i >> 4, c16 = i & 15; *(uint4*)(Vs + row * 136 + c16 * 8) = *(const uint4*)(P0 + (size_t)(c * 64 + row) * EIN + 512 + h * 128 + c16 * 8); }
    }
    __syncthreads();
    {
        f32x4 acc[4];
#pragma unroll
        for (int kt = 0; kt < 4; ++kt) acc[kt] = (f32x4){0.f, 0.f, 0.f, 0.f};
#pragma unroll
        for (int ks = 0; ks < 2; ++ks) {
            const bf16x8 af = tr_frag(Vs, 136, ks * 32, wave * 16, lane);
#pragma unroll
            for (int kt = 0; kt < 4; ++kt) acc[kt] = __builtin_amdgcn_mfma_f32_16x16x32_bf16(af, row_frag(kT, 72, kt * 16, ks * 32, lane), acc[kt], 0, 0, 0);
        }
#pragma unroll
        for (int kt = 0; kt < 4; ++kt) {
            const int k = kt * 16 + (lane & 15), v = wave * 16 + (lane >> 4) * 4;
            st4(GDS + ((size_t)(ch * NCH + c) * 64 + k) * 128 + v, make_float4(acc[kt][0], acc[kt][1], acc[kt][2], acc[kt][3]));
        }
    }
    if (tid < 64) GDEC[(size_t)(ch * NCH + c) * 64 + tid] = expf(sTot[tid]);
}

DEV void gla2_unit(const Params& p, int unit) {
    const int tid = opaque_tid();
    float* GDS = (float*)(p.ws + OFF_GDS); const float* GDEC = (const float*)(p.ws + OFF_GDEC);
    const int ch = unit >> 4, e = (unit & 15) * 512 + tid, k = e >> 7, dir = ch & 1;
    float S = 0.f;
#pragma unroll 4
    for (int step = 0; step < NCH; ++step) {
        const int c = chunk_at(dir, step);
        float* gp = GDS + (size_t)(ch * NCH + c) * 8192 + e;
        const float d = GDEC[(size_t)(ch * NCH + c) * 64 + k], inc = *gp;
        *gp = S;
        S = d * S + inc;
    }
}

DEV void gla3_unit(const Params& p, int h, int c, float* sm) {
    const int tid = opaque_tid(), lane = tid & 63, wave = tid >> 6;
    const bf16_t* P0 = (const bf16_t*)(p.ws + OFF_P0);
    const float* GDS = (const float*)(p.ws + OFF_GDS);
    bf16_t* YC = (bf16_t*)(p.ws + OFF_YC);
    const float* ng = p.in[14];
    float* sLR = sm; float* sWA = sm + 1024; float* sBC = sm + 2048; float* sTot = sm + 6208;
    bf16_t* qt = (bf16_t*)(sm + 6272);
    bf16_t* kt = (bf16_t*)(sm + 8576);
    bf16_t* Sm = (bf16_t*)(sm + 10880);
    bf16_t* S0s = (bf16_t*)(sm + 13184);
    bf16_t* Vs = (bf16_t*)(sm + 17536);
    float* O = sm + 21888;
    const int ti = wave & 3, vt0 = (wave >> 2) * 4;
    f32x4 acc[4];
#pragma unroll
    for (int j = 0; j < 4; ++j) acc[j] = (f32x4){0.f, 0.f, 0.f, 0.f};
    __syncthreads();
#pragma unroll
    for (int u = 0; u < 2; ++u) { const int i = tid + 512 * u, row = i >> 4, c16 = i & 15; *(uint4*)(Vs + row * 136 + c16 * 8) = *(const uint4*)(P0 + (size_t)(c * 64 + row) * EIN + 512 + h * 128 + c16 * 8); }
#pragma unroll 1
    for (int dir = 0; dir < 2; ++dir) {
        const float* wa2 = p.in[dir ? 12 : 10]; const float* ba = p.in[dir ? 13 : 11];
        const int ch = h * 2 + dir;
        __syncthreads();
        gla_decay(P0, c, h, dir, wa2, ba, sLR, sWA, sBC, sTot, tid);
        {
            const int t = tid >> 3, k0 = (tid & 7) * 8;
            float qv[8], kv[8];
            unpack8(*(const uint4*)(P0 + (size_t)(c * 64 + t) * EIN + h * 64 + k0), qv);
            unpack8(*(const uint4*)(P0 + (size_t)(c * 64 + t) * EIN + 256 + h * 64 + k0), kv);
#pragma unroll
            for (int j = 0; j < 8; ++j) { const float bc = sBC[t * 65 + k0 + j]; qv[j] *= 0.125f * expf(bc); kv[j] *= expf(-bc); }
            *(uint4*)(qt + t * 72 + k0) = make_uint4(pack2bf(qv[0], qv[1]), pack2bf(qv[2], qv[3]), pack2bf(qv[4], qv[5]), pack2bf(qv[6], qv[7]));
            *(uint4*)(kt + t * 72 + k0) = make_uint4(pack2bf(kv[0], kv[1]), pack2bf(kv[2], kv[3]), pack2bf(kv[4], kv[5]), pack2bf(kv[6], kv[7]));
#pragma unroll
            for (int u = 0; u < 4; ++u) {
                const int i = tid + 512 * u, k = i >> 5, v4 = (i & 31) * 4;
                const float4 s4 = ld4(GDS + (size_t)(ch * NCH + c) * 8192 + k * 128 + v4);
                *(uint2*)(S0s + k * 136 + v4) = make_uint2(pack2bf(s4.x, s4.y), pack2bf(s4.z, s4.w));
            }
        }
        __syncthreads();
        {
            const int si = wave & 3;
#pragma unroll
            for (int jj = 0; jj < 2; ++jj) {
                const int t2 = (wave >> 2) * 2 + jj;
                f32x4 a = (f32x4){0.f, 0.f, 0.f, 0.f};
#pragma unroll
                for (int ks = 0; ks < 2; ++ks) a = __builtin_amdgcn_mfma_f32_16x16x32_bf16(row_frag(kt, 72, si * 16, ks * 32, lane), row_frag(qt, 72, t2 * 16, ks * 32, lane), a, 0, 0, 0);
                const int t = t2 * 16 + (lane & 15), s0 = si * 16 + (lane >> 4) * 4;
                float m[4];
#pragma unroll
                for (int r = 0; r < 4; ++r) { const bool keep = dir ? (s0 + r >= t) : (s0 + r <= t); m[r] = keep ? a[r] : 0.f; }
                *(uint2*)(Sm + t * 72 + s0) = make_uint2(pack2bf(m[0], m[1]), pack2bf(m[2], m[3]));
            }
        }
        __syncthreads();
#pragma unroll
        for (int ks = 0; ks < 2; ++ks) {
            const bf16x8 a1 = row_frag(qt, 72, ti * 16, ks * 32, lane), a2 = row_frag(Sm, 72, ti * 16, ks * 32, lane);
#pragma unroll
            for (int j = 0; j < 4; ++j) {
                acc[j] = __builtin_amdgcn_mfma_f32_16x16x32_bf16(a1, tr_frag(S0s, 136, ks * 32, (vt0 + j) * 16, lane), acc[j], 0, 0, 0);
                acc[j] = __builtin_amdgcn_mfma_f32_16x16x32_bf16(a2, tr_frag(Vs, 136, ks * 32, (vt0 + j) * 16, lane), acc[j], 0, 0, 0);
            }
        }
    }
#pragma unroll
    for (int j = 0; j < 4; ++j)
#pragma unroll
        for (int r = 0; r < 4; ++r) O[(ti * 16 + (lane >> 4) * 4 + r) * 132 + (vt0 + j) * 16 + (lane & 15)] = acc[j][r];
    __syncthreads();
    {
        const int t = tid >> 3, v0 = (tid & 7) * 16;
        float o[16];
        float ss = 0.f;
#pragma unroll
        for (int i = 0; i < 16; ++i) { o[i] = O[t * 132 + v0 + i]; ss += o[i] * o[i]; }
        ss += __shfl_xor(ss, 1, 64); ss += __shfl_xor(ss, 2, 64); ss += __shfl_xor(ss, 4, 64);
        const float rms = rsqrtf(ss * (1.f / 128.f) + 1e-5f);
        float g[16];
        const bf16_t* gp = P0 + (size_t)(c * 64 + t) * EIN + 1024 + h * 128 + v0;
        unpack8(*(const uint4*)gp, g); unpack8(*(const uint4*)(gp + 8), g + 8);
        float y[16];
#pragma unroll
        for (int i = 0; i < 16; ++i) y[i] = o[i] * rms * ng[v0 + i] * silu_f(g[i]);
        bf16_t* yp = YC + (size_t)(c * 64 + t) * 1024 + h * 128 + v0;
        *(uint4*)yp = make_uint4(pack2bf(y[0], y[1]), pack2bf(y[2], y[3]), pack2bf(y[4], y[5]), pack2bf(y[6], y[7]));
        *(uint4*)(yp + 8) = make_uint4(pack2bf(y[8], y[9]), pack2bf(y[10], y[11]), pack2bf(y[12], y[13]), pack2bf(y[14], y[15]));
    }
}

DEV void load8bf(const bf16_t* ptr, float* f) { unpack8(*(const uint4*)ptr, f); }
DEV void rw_mix8(const bf16_t* P0, int s, int cb, const float* __restrict__ mu, float* out) {
    float own[8]; load8bf(P0 + (size_t)s * EIN + RW0 + cb, own);
    int nL = -1, nR = -1, nU = -1, nD = -1;
    if (s < NCX) { if (s > 0) nL = s - 1; if (s < NCX - 1) nR = s + 1; }
    else { const int n = s - NCX, rr = n >> 6, cc = n & 63; if (cc > 0) nL = s - 1; if (cc < 63) nR = s + 1; if (rr > 0) nU = s - 64; if (rr < 127) nD = s + 64; }
    float fL[8], fR[8], fU[8], fD[8];
#pragma unroll
    for (int i = 0; i < 8; ++i) { fL[i] = 0.f; fR[i] = 0.f; fU[i] = 0.f; fD[i] = 0.f; }
    if (nL >= 0) load8bf(P0 + (size_t)nL * EIN + RW0 + cb, fL);
    if (nR >= 0) load8bf(P0 + (size_t)nR * EIN + RW0 + cb, fR);
    if (nU >= 0) load8bf(P0 + (size_t)nU * EIN + RW0 + cb, fU);
    if (nD >= 0) load8bf(P0 + (size_t)nD * EIN + RW0 + cb, fD);
    const float4 m0 = ld4(mu + cb), m1 = ld4(mu + cb + 4);
    const float m[8] = {m0.x, m0.y, m0.z, m0.w, m1.x, m1.y, m1.z, m1.w};
#pragma unroll
    for (int i = 0; i < 8; ++i) { const float nb = (i & 3) == 0 ? fL[i] : ((i & 3) == 1 ? fR[i] : ((i & 3) == 2 ? fU[i] : fD[i])); out[i] = own[i] + (nb - own[i]) * m[i]; }
}
DEV uint4 pack8(const float* f) { return make_uint4(pack2bf(f[0], f[1]), pack2bf(f[2], f[3]), pack2bf(f[4], f[5]), pack2bf(f[6], f[7])); }

template <int XM, int YM, class F>
DEV void mm64(const bf16_t* X, const bf16_t* Y, F f, int lane, int wave) {
#pragma unroll
    for (int q = 0; q < 2; ++q) {
        const int idx = wave * 2 + q, ti = idx >> 2, tj = idx & 3;
        f32x4 acc = (f32x4){0.f, 0.f, 0.f, 0.f};
#pragma unroll
        for (int ks = 0; ks < 2; ++ks) {
            const bf16x8 a = XM == 0 ? row_frag(X, 72, ti * 16, ks * 32, lane) : tr_frag(X, 72, ks * 32, ti * 16, lane);
            const bf16x8 bq = YM == 0 ? row_frag(Y, 72, tj * 16, ks * 32, lane) : tr_frag(Y, 72, ks * 32, tj * 16, lane);
            acc = __builtin_amdgcn_mfma_f32_16x16x32_bf16(a, bq, acc, 0, 0, 0);
        }
        f(ti * 16 + (lane >> 4) * 4, tj * 16 + (lane & 15), acc);
    }
}
template <int XM, int YM, class F>
DEV void mm64x2(const bf16_t* X1, const bf16_t* Y1, const bf16_t* X2, const bf16_t* Y2, F f, int lane, int wave) {
#pragma unroll
    for (int q = 0; q < 2; ++q) {
        const int idx = wave * 2 + q, ti = idx >> 2, tj = idx & 3;
        f32x4 acc = (f32x4){0.f, 0.f, 0.f, 0.f};
#pragma unroll
        for (int ks = 0; ks < 2; ++ks) {
            const bf16x8 a = XM == 0 ? row_frag(X1, 72, ti * 16, ks * 32, lane) : tr_frag(X1, 72, ks * 32, ti * 16, lane);
            const bf16x8 bq = YM == 0 ? row_frag(Y1, 72, tj * 16, ks * 32, lane) : tr_frag(Y1, 72, ks * 32, tj * 16, lane);
            acc = __builtin_amdgcn_mfma_f32_16x16x32_bf16(a, bq, acc, 0, 0, 0);
            const bf16x8 a2 = XM == 0 ? row_frag(X2, 72, ti * 16, ks * 32, lane) : tr_frag(X2, 72, ks * 32, ti * 16, lane);
            const bf16x8 b2 = YM == 0 ? row_frag(Y2, 72, tj * 16, ks * 32, lane) : tr_frag(Y2, 72, ks * 32, tj * 16, lane);
            acc = __builtin_amdgcn_mfma_f32_16x16x32_bf16(a2, b2, acc, 0, 0, 0);
        }
        f(ti * 16 + (lane >> 4) * 4, tj * 16 + (lane & 15), acc);
    }
}
DEV void st_img(bf16_t* P, int i0, int j, float a0, float a1, float a2, float a3) {
    P[(i0 + 0) * 72 + j] = __builtin_bit_cast(unsigned short, (__bf16)a0); P[(i0 + 1) * 72 + j] = __builtin_bit_cast(unsigned short, (__bf16)a1);
    P[(i0 + 2) * 72 + j] = __builtin_bit_cast(unsigned short, (__bf16)a2); P[(i0 + 3) * 72 + j] = __builtin_bit_cast(unsigned short, (__bf16)a3);
}

DEV void rwkv1_unit(const Params& p, int h, int dir, int c, float* sm) {
    const int tid = opaque_tid(), lane = tid & 63, wave = tid >> 6;
    const bf16_t* P0 = (const bf16_t*)(p.ws + OFF_P0);
    bf16_t* RU = (bf16_t*)(p.ws + OFF_RU) + (size_t)((h * 2 + dir) * NCH + c) * 16384;
    float* BONS = (float*)(p.ws + OFF_BONS);
    const float* mu = p.in[15];
    const float* w0 = p.in[dir ? 18 : 16]; const float* ww2 = p.in[dir ? 19 : 17];
    const float* a0 = p.in[dir ? 22 : 20]; const float* wa2 = p.in[dir ? 23 : 21];
    bf16_t* img = (bf16_t*)sm;
#define SLOT(i_) (img + (i_) * 4608)
    float* fLW = (float*)SLOT(10);
    float* fAS = (float*)SLOT(12);
    float* sv = (float*)SLOT(14);
    const int t = tid >> 3, j0 = (tid & 7) * 8, s = c * 64 + t;
    __syncthreads();
    if (tid < 64) { const int hc = h * 64 + tid; sv[64 + tid] = w0[hc]; sv[128 + tid] = a0[hc]; sv[192 + tid] = p.in[24][hc]; sv[256 + tid] = p.in[25][hc]; sv[320 + tid] = p.in[26][hc]; }
    float r8[8], k8[8], v8[8];
    {
        float x8[8];
        rw_mix8(P0, s, h * 64 + j0, mu, r8);
        rw_mix8(P0, s, 512 + h * 64 + j0, mu, k8);
        rw_mix8(P0, s, 1024 + h * 64 + j0, mu, v8);
        rw_mix8(P0, s, 2048 + dir * 64 + j0, mu, x8);
#pragma unroll
        for (int i = 0; i < 8; ++i) x8[i] = tanhf(x8[i]);
        *(uint4*)(SLOT(6) + t * 72 + j0) = pack8(x8);
        rw_mix8(P0, s, 2176 + dir * 64 + j0, mu, x8);
        *(uint4*)(SLOT(7) + t * 72 + j0) = pack8(x8);
        float wq[8];
        { const float4 q0 = ld4(ww2 + (size_t)t * 512 + h * 64 + j0), q1 = ld4(ww2 + (size_t)t * 512 + h * 64 + j0 + 4); wq[0] = q0.x; wq[1] = q0.y; wq[2] = q0.z; wq[3] = q0.w; wq[4] = q1.x; wq[5] = q1.y; wq[6] = q1.z; wq[7] = q1.w; }
        *(uint4*)(SLOT(8) + t * 72 + j0) = pack8(wq);
        { const float4 q0 = ld4(wa2 + (size_t)t * 512 + h * 64 + j0), q1 = ld4(wa2 + (size_t)t * 512 + h * 64 + j0 + 4); wq[0] = q0.x; wq[1] = q0.y; wq[2] = q0.z; wq[3] = q0.w; wq[4] = q1.x; wq[5] = q1.y; wq[6] = q1.z; wq[7] = q1.w; }
        *(uint4*)(SLOT(9) + t * 72 + j0) = pack8(wq);
    }
    __syncthreads();
    mm64<0, 1>(SLOT(6), SLOT(8), [=](int i0, int j, f32x4 a) {
#pragma unroll
        for (int r = 0; r < 4; ++r) fLW[(i0 + r) * 65 + j] = -0.6065306597f * sigmoid_f(sv[64 + j] + a[r]); }, lane, wave);
    mm64<0, 1>(SLOT(7), SLOT(9), [=](int i0, int j, f32x4 a) {
#pragma unroll
        for (int r = 0; r < 4; ++r) fAS[(i0 + r) * 65 + j] = sigmoid_f(sv[128 + j] + a[r]); }, lane, wave);
    __syncthreads();
    if (tid < 64) {
        float run = 0.f;
        for (int step = 0; step < 64; ++step) { const int tt = dir ? 63 - step : step; run += fLW[tt * 65 + tid]; fLW[tt * 65 + tid] = run; }
        sv[tid] = run;
    }
    __syncthreads();
    {
        float kkv[8], ss = 0.f;
#pragma unroll
        for (int i = 0; i < 8; ++i) { kkv[i] = k8[i] * sv[192 + j0 + i]; ss += kkv[i] * kkv[i]; }
        ss += __shfl_xor(ss, 1, 64); ss += __shfl_xor(ss, 2, 64); ss += __shfl_xor(ss, 4, 64);
        const float rn = rsqrtf(fmaxf(ss, 1e-24f));
        float fa[8], fb[8], fk[8], fr[8], fbp[8], fkp[8], bon = 0.f;
        const int tp = dir ? t + 1 : t - 1;
        const bool hasp = dir ? (t < 63) : (t > 0);
#pragma unroll
        for (int i = 0; i < 8; ++i) {
            const int k = j0 + i;
            const float Bt = fLW[t * 65 + k], Bx = hasp ? fLW[tp * 65 + k] : 0.f, asg = fAS[t * 65 + k];
            const float kk = kkv[i] * rn, kh = k8[i] * (1.f + (asg - 1.f) * sv[256 + k]);
            bon += r8[i] * kh * sv[320 + k];
            const float enB = expf(-Bt), eLB = expf(sv[k] - Bt), bv = kk * asg;
            fa[i] = -kk * expf(Bx); fb[i] = bv * enB; fk[i] = kh * enB; fr[i] = r8[i] * expf(Bt); fbp[i] = bv * eLB; fkp[i] = kh * eLB;
        }
#ifdef RWKV_DEBUG
        if (c == 0 && dir == 0) {
            float* DBN = p.out + 9000000 + 8 * 64 * 64 * 6;
#pragma unroll
            for (int i = 0; i < 8; ++i) {
                const int k = j0 + i;
                const float Bt = fLW[t * 65 + k], Bx = hasp ? fLW[tp * 65 + k] : 0.f, asg = fAS[t * 65 + k];
                const float kk = kkv[i] * rn, kh = k8[i] * (1.f + (asg - 1.f) * sv[256 + k]);
                float* d = DBN + ((size_t)(h * 64 + t) * 64 + k) * 6;
                d[0] = expf(Bt - Bx); d[1] = kh; d[2] = -kk; d[3] = kk * asg; d[4] = r8[i]; d[5] = v8[i];
            }
        }
#endif
        bon += __shfl_xor(bon, 1, 64); bon += __shfl_xor(bon, 2, 64); bon += __shfl_xor(bon, 4, 64);
        if ((tid & 7) == 0) BONS[((size_t)dir * TB + s) * 8 + h] = bon;
        *(uint4*)(SLOT(0) + t * 72 + j0) = pack8(fa); *(uint4*)(SLOT(1) + t * 72 + j0) = pack8(fb); *(uint4*)(SLOT(2) + t * 72 + j0) = pack8(fk);
        *(uint4*)(SLOT(3) + t * 72 + j0) = pack8(fr); *(uint4*)(SLOT(4) + t * 72 + j0) = pack8(fbp); *(uint4*)(SLOT(5) + t * 72 + j0) = pack8(fkp);
    }
    __syncthreads();
    *(uint4*)(SLOT(6) + t * 72 + j0) = pack8(v8);
    __syncthreads();
    mm64<0, 0>(SLOT(0), SLOT(1), [=](int i0, int j, f32x4 a) {
        float m[4];
#pragma unroll
        for (int r = 0; r < 4; ++r) { const bool keep = dir ? (j > i0 + r) : (j < i0 + r); m[r] = keep ? a[r] : 0.f; }
        const bool dg = (i0 >> 4) == (j >> 4);
        st_img(SLOT(7), i0, j, dg ? m[0] : 0.f, dg ? m[1] : 0.f, dg ? m[2] : 0.f, dg ? m[3] : 0.f);
        st_img(SLOT(8), i0, j, (dg ? m[0] : 0.f) + (j == i0 ? 1.f : 0.f), (dg ? m[1] : 0.f) + (j == i0 + 1 ? 1.f : 0.f), (dg ? m[2] : 0.f) + (j == i0 + 2 ? 1.f : 0.f), (dg ? m[3] : 0.f) + (j == i0 + 3 ? 1.f : 0.f));
        st_img(SLOT(12), i0, j, dg ? 0.f : m[0], dg ? 0.f : m[1], dg ? 0.f : m[2], dg ? 0.f : m[3]); }, lane, wave);
    mm64<0, 0>(SLOT(0), SLOT(2), [=](int i0, int j, f32x4 a) {
        float m[4];
#pragma unroll
        for (int r = 0; r < 4; ++r) { const bool keep = dir ? (j > i0 + r) : (j < i0 + r); m[r] = keep ? a[r] : 0.f; }
        st_img(SLOT(9), i0, j, m[0], m[1], m[2], m[3]); }, lane, wave);
    mm64<0, 0>(SLOT(3), SLOT(1), [=](int i0, int j, f32x4 a) {
        float m[4];
#pragma unroll
        for (int r = 0; r < 4; ++r) { const bool keep = dir ? (j >= i0 + r) : (j <= i0 + r); m[r] = keep ? a[r] : 0.f; }
        st_img(SLOT(10), i0, j, m[0], m[1], m[2], m[3]); }, lane, wave);
    mm64<0, 0>(SLOT(3), SLOT(2), [=](int i0, int j, f32x4 a) {
        float m[4];
#pragma unroll
        for (int r = 0; r < 4; ++r) { const bool keep = dir ? (j >= i0 + r) : (j <= i0 + r); m[r] = keep ? a[r] : 0.f; }
        st_img(SLOT(11), i0, j, m[0], m[1], m[2], m[3]); }, lane, wave);
    __syncthreads();
    {
        bf16_t* Pc = SLOT(7); bf16_t* Pn = SLOT(1); bf16_t* Tc = SLOT(8); bf16_t* Tn = SLOT(2);
#pragma unroll 1
        for (int it = 0; it < 3; ++it) {
            mm64<0, 1>(Pc, Pc, [=](int i0, int j, f32x4 a) { st_img(Pn, i0, j, a[0], a[1], a[2], a[3]); }, lane, wave);
            __syncthreads();
            mm64<0, 1>(Tc, Pn, [=](int i0, int j, f32x4 a) {
                st_img(Tn, i0, j, a[0] + bf2f(Tc[(i0 + 0) * 72 + j]), a[1] + bf2f(Tc[(i0 + 1) * 72 + j]), a[2] + bf2f(Tc[(i0 + 2) * 72 + j]), a[3] + bf2f(Tc[(i0 + 3) * 72 + j])); }, lane, wave);
            __syncthreads();
            bf16_t* tmp = Pc; Pc = Pn; Pn = tmp; tmp = Tc; Tc = Tn; Tn = tmp;
        }
    }
    mm64<0, 1>(SLOT(2), SLOT(12), [=](int i0, int j, f32x4 a) { st_img(SLOT(7), i0, j, a[0], a[1], a[2], a[3]); }, lane, wave);
    mm64<0, 1>(SLOT(2), SLOT(0), [=](int i0, int j, f32x4 a) { st_img(SLOT(1), i0, j, a[0], a[1], a[2], a[3]); }, lane, wave);
    mm64<0, 1>(SLOT(9), SLOT(6), [=](int i0, int j, f32x4 a) { st_img(SLOT(13), i0, j, a[0], a[1], a[2], a[3]); }, lane, wave);
    __syncthreads();
    mm64<0, 1>(SLOT(2), SLOT(13), [=](int i0, int j, f32x4 a) { st_img(SLOT(8), i0, j, a[0], a[1], a[2], a[3]); }, lane, wave);
    __syncthreads();
    {
        const bf16_t* Zp = (wave < 4) ? SLOT(1) : SLOT(8);
        bf16_t* Xi = (wave < 4) ? SLOT(12) : SLOT(9);
        const int ct = (wave & 3) * 16, g4 = (lane >> 4) * 4, l15 = lane & 15;
#pragma unroll
        for (int bs = 0; bs < 4; ++bs) {
            const int bi = dir ? 3 - bs : bs;
            f32x4 acc;
#pragma unroll
            for (int r = 0; r < 4; ++r) acc[r] = bf2f(Zp[(bi * 16 + g4 + r) * 72 + ct + l15]);
            const bool k0 = dir ? (bi == 0) : (bi >= 1), k1 = dir ? (bi <= 2) : (bi == 3);
            if (k0) acc = __builtin_amdgcn_mfma_f32_16x16x32_bf16(row_frag(SLOT(7), 72, bi * 16, 0, lane), tr_frag(Xi, 72, 0, ct, lane), acc, 0, 0, 0);
            if (k1) acc = __builtin_amdgcn_mfma_f32_16x16x32_bf16(row_frag(SLOT(7), 72, bi * 16, 32, lane), tr_frag(Xi, 72, 32, ct, lane), acc, 0, 0, 0);
            st_img(Xi, bi * 16 + g4, ct + l15, acc[0], acc[1], acc[2], acc[3]);
            __syncthreads();
        }
    }
    mm64<1, 1>(SLOT(12), SLOT(4), [=](int i0, int j, f32x4 a) {
        float m[4];
#pragma unroll
        for (int r = 0; r < 4; ++r) m[r] = a[r] + ((i0 + r) == j ? expf(sv[j]) : 0.f);
        *(uint2*)(RU + j * 64 + i0) = make_uint2(pack2bf(m[0], m[1]), pack2bf(m[2], m[3])); }, lane, wave);
    mm64x2<1, 1>(SLOT(4), SLOT(9), SLOT(5), SLOT(6), [=](int i0, int j, f32x4 a) {
        *(uint2*)(RU + 4096 + j * 64 + i0) = make_uint2(pack2bf(a[0], a[1]), pack2bf(a[2], a[3])); }, lane, wave);
    mm64<1, 0>(SLOT(12), SLOT(10), [=](int i0, int j, f32x4 a) {
        const uint2 rr = *(const uint2*)(SLOT(3) + j * 72 + i0);
        *(uint2*)(RU + 8192 + j * 64 + i0) = make_uint2(pack2bf(a[0] + bflo(rr.x), a[1] + bfhi(rr.x)), pack2bf(a[2] + bflo(rr.y), a[3] + bfhi(rr.y))); }, lane, wave);
    mm64x2<0, 1>(SLOT(10), SLOT(9), SLOT(11), SLOT(6), [=](int i0, int j, f32x4 a) {
        *(uint2*)(RU + 12288 + j * 64 + i0) = make_uint2(pack2bf(a[0], a[1]), pack2bf(a[2], a[3])); }, lane, wave);
#undef SLOT
}

DEV void rwkv2_unit(const Params& p, int chain, int vblk, int lane) {
    asm volatile("" : "+v"(lane));
    const bf16_t* RU = (const bf16_t*)(p.ws + OFF_RU);
    bf16_t* S0G = (bf16_t*)(p.ws + OFF_RS0);
    const int dir = chain & 1, g = lane >> 4, l15 = lane & 15;
    f32x4 st[4];
#pragma unroll
    for (int i = 0; i < 4; ++i) st[i] = (f32x4){0.f, 0.f, 0.f, 0.f};
    uint2 na[4][2][2], nc[4];
    {
        const bf16_t* U = RU + (size_t)(chain * NCH + chunk_at(dir, 0)) * 16384;
#pragma unroll
        for (int i = 0; i < 4; ++i) {
            nc[i] = *(const uint2*)(U + 4096 + (vblk * 16 + l15) * 64 + i * 16 + g * 4);
#pragma unroll
            for (int ks = 0; ks < 2; ++ks) { na[i][ks][0] = *(const uint2*)(U + (i * 16 + l15) * 64 + ks * 32 + g * 4); na[i][ks][1] = *(const uint2*)(U + (i * 16 + l15) * 64 + ks * 32 + 16 + g * 4); }
        }
    }
#pragma unroll 1
    for (int step = 0; step < NCH; ++step) {
        const int c = chunk_at(dir, step);
        uint2 ca[4][2][2], cc[4];
#pragma unroll
        for (int i = 0; i < 4; ++i) { cc[i] = nc[i]; ca[i][0][0] = na[i][0][0]; ca[i][0][1] = na[i][0][1]; ca[i][1][0] = na[i][1][0]; ca[i][1][1] = na[i][1][1]; }
        {
            const int cn = chunk_at(dir, step + 1 < NCH ? step + 1 : step);
            const bf16_t* U = RU + (size_t)(chain * NCH + cn) * 16384;
#pragma unroll
            for (int i = 0; i < 4; ++i) {
                nc[i] = *(const uint2*)(U + 4096 + (vblk * 16 + l15) * 64 + i * 16 + g * 4);
#pragma unroll
                for (int ks = 0; ks < 2; ++ks) { na[i][ks][0] = *(const uint2*)(U + (i * 16 + l15) * 64 + ks * 32 + g * 4); na[i][ks][1] = *(const uint2*)(U + (i * 16 + l15) * 64 + ks * 32 + 16 + g * 4); }
            }
        }
        unsigned pk[4][2];
#pragma unroll
        for (int i = 0; i < 4; ++i) { pk[i][0] = pack2bf(st[i][0], st[i][1]); pk[i][1] = pack2bf(st[i][2], st[i][3]); }
        bf16_t* sp = S0G + ((size_t)(chain * NCH + c) * 64 + vblk * 16 + l15) * 64 + g * 4;
#pragma unroll
        for (int i = 0; i < 4; ++i) *(uint2*)(sp + i * 16) = make_uint2(pk[i][0], pk[i][1]);
        bf16x8 bfr[2];
#pragma unroll
        for (int ks = 0; ks < 2; ++ks) { const uint4 u = make_uint4(pk[2 * ks][0], pk[2 * ks][1], pk[2 * ks + 1][0], pk[2 * ks + 1][1]); bfr[ks] = __builtin_bit_cast(bf16x8, u); }
#pragma unroll
        for (int i = 0; i < 4; ++i) {
            f32x4 acc = (f32x4){bflo(cc[i].x), bfhi(cc[i].x), bflo(cc[i].y), bfhi(cc[i].y)};
#pragma unroll
            for (int ks = 0; ks < 2; ++ks) {
                const uint4 u = make_uint4(ca[i][ks][0].x, ca[i][ks][0].y, ca[i][ks][1].x, ca[i][ks][1].y);
                acc = __builtin_amdgcn_mfma_f32_16x16x32_bf16(__builtin_bit_cast(bf16x8, u), bfr[ks], acc, 0, 0, 0);
            }
            st[i] = acc;
        }
    }
}

DEV void rwkv3_unit(const Params& p, int h, int c, float* sm, bool dbg_on = false) {
    const int tid = opaque_tid(), lane = tid & 63, wave = tid >> 6;
    const bf16_t* P0 = (const bf16_t*)(p.ws + OFF_P0);
    const bf16_t* RUb = (const bf16_t*)(p.ws + OFF_RU);
    const bf16_t* S0G = (const bf16_t*)(p.ws + OFF_RS0);
    const float* BONS = (const float*)(p.ws + OFF_BONS);
    bf16_t* YC = (bf16_t*)(p.ws + OFF_YC);
    const float* mu = p.in[15]; const float* gn_g = p.in[27]; const float* gn_b = p.in[28];
    bf16_t* img = (bf16_t*)sm;
    float* O = sm + 4 * 2304;
#ifdef RWKV_DEBUG
    float* Od = O + 64 * 68;
#endif
    __syncthreads();
    {
        const int row = tid >> 3, c8 = (tid & 7) * 8;
#pragma unroll
        for (int dir = 0; dir < 2; ++dir) {
            const size_t u = (size_t)((h * 2 + dir) * NCH + c);
            *(uint4*)(img + dir * 4608 + row * 72 + c8) = *(const uint4*)(RUb + u * 16384 + 8192 + row * 64 + c8);
            *(uint4*)(img + (2 + dir) * 4608 + row * 72 + c8) = *(const uint4*)(S0G + u * 4096 + row * 64 + c8);
        }
    }
    __syncthreads();
#pragma unroll
    for (int q = 0; q < 2; ++q) {
        const int idx = wave * 2 + q, ti = idx >> 2, tj = idx & 3;
        f32x4 accd[2];
#pragma unroll
        for (int dir = 0; dir < 2; ++dir) {
            f32x4 acc = (f32x4){0.f, 0.f, 0.f, 0.f};
#pragma unroll
            for (int ks = 0; ks < 2; ++ks) acc = __builtin_amdgcn_mfma_f32_16x16x32_bf16(row_frag(img + dir * 4608, 72, ti * 16, ks * 32, lane), row_frag(img + (2 + dir) * 4608, 72, tj * 16, ks * 32, lane), acc, 0, 0, 0);
            const uint2 yl = *(const uint2*)(RUb + (size_t)((h * 2 + dir) * NCH + c) * 16384 + 12288 + (tj * 16 + (lane & 15)) * 64 + ti * 16 + (lane >> 4) * 4);
            acc[0] += bflo(yl.x); acc[1] += bfhi(yl.x); acc[2] += bflo(yl.y); acc[3] += bfhi(yl.y);
            accd[dir] = acc;
        }
#pragma unroll
        for (int r = 0; r < 4; ++r) {
            const int oi = (ti * 16 + (lane >> 4) * 4 + r) * 68 + tj * 16 + (lane & 15);
            O[oi] = accd[0][r] + accd[1][r];
#ifdef RWKV_DEBUG
            Od[oi] = ((DBG_DIRMASK & 1) ? accd[0][r] : 0.f) + ((DBG_DIRMASK & 2) ? accd[1][r] : 0.f);
#endif
        }
    }
    __syncthreads();
    {
        const int t = tid >> 3, v0 = (tid & 7) * 8, s = c * 64 + t;
        float y[8], sum = 0.f;
#pragma unroll
        for (int i = 0; i < 8; ++i) { y[i] = O[t * 68 + v0 + i]; sum += y[i]; }
#ifdef RWKV_DEBUG
        if (dbg_on && c >= DBG_CMIN && c < DBG_CMAX) {
            float num = 0.f, den = 0.f;
#pragma unroll
            for (int i = 0; i < 8; ++i) {
                if (DBG_MODE == 1) { const float o = p.out[(size_t)s * 1024 + 512 + h * 64 + v0 + i]; const float yd = DBG_SELFTEST ? 1.05f * o : Od[t * 68 + v0 + i]; num += (yd - o) * (yd - o); den += o * o; }
                else { const float* dold = p.out + 9000000 + ((size_t)(h * 64 + t) * 64 + v0 + i) * 6; const float* dn = dold + 8 * 64 * 64 * 6;
                       for (int q = 1; q < 6; ++q) { const float o = dold[q], n = dn[q]; num += (n - o) * (n - o); den += o * o; } }
            }
            num = wave_sum(num); den = wave_sum(den);
            if (lane == 0) { atomicAdd((unsigned long long*)(p.ws + OFF_X1C + 2200000), (unsigned long long)(fminf(num, 1e12f) * 1048576.f)); atomicAdd((unsigned long long*)(p.ws + OFF_X1C + 2200008), (unsigned long long)(fminf(den, 1e12f) * 1048576.f)); }
        }
#endif
        sum += __shfl_xor(sum, 1, 64); sum += __shfl_xor(sum, 2, 64); sum += __shfl_xor(sum, 4, 64);
        const float mean = sum * (1.f / 64.f);
        float sq = 0.f;
#pragma unroll
        for (int i = 0; i < 8; ++i) { y[i] -= mean; sq += y[i] * y[i]; }
        sq += __shfl_xor(sq, 1, 64); sq += __shfl_xor(sq, 2, 64); sq += __shfl_xor(sq, 4, 64);
        const float rstd = rsqrtf(sq * (1.f / 64.f) + 64e-5f);
        float vm[8], gm[8];
        rw_mix8(P0, s, 1024 + h * 64 + v0, mu, vm);
        rw_mix8(P0, s, 1536 + h * 64 + v0, mu, gm);
        const float bon = BONS[(size_t)s * 8 + h] + BONS[((size_t)TB + s) * 8 + h];
        float o[8];
#pragma unroll
        for (int i = 0; i < 8; ++i) o[i] = (y[i] * rstd * gn_g[h * 64 + v0 + i] + gn_b[h * 64 + v0 + i] + bon * vm[i]) * silu_f(gm[i]);
        *(uint4*)(YC + (size_t)s * 1024 + 512 + h * 64 + v0) = pack8(o);
    }
}

DEV void ln_rows(const float* src, int nrows, const float* __restrict__ g, const float* __restrict__ bt, float* dst_lat, float* dst_cx, int ncx) {
    const int tid_ = opaque_tid(); const int lane = tid_ & 63, gw = blockIdx.x * NWV + (tid_ >> 6), ngw = gridDim.x * NWV;
    for (int r = gw; r < nrows; r += ngw) {
        const float* x = src + (size_t)r * 1024;
        float4 v[4];
        float sum = 0.f;
#pragma unroll
        for (int i = 0; i < 4; ++i) { v[i] = ld4(x + i * 256 + lane * 4); sum += v[i].x + v[i].y + v[i].z + v[i].w; }
        const float mean = wave_sum(sum) * (1.f / 1024.f);
        float sq = 0.f;
#pragma unroll
        for (int i = 0; i < 4; ++i) {
            v[i].x -= mean; v[i].y -= mean; v[i].z -= mean; v[i].w -= mean;
            sq += v[i].x * v[i].x + v[i].y * v[i].y + v[i].z * v[i].z + v[i].w * v[i].w;
        }
        const float rstd = rsqrtf(wave_sum(sq) * (1.f / 1024.f) + 1e-5f);
        float* d = (r < ncx) ? (dst_cx + (size_t)r * 1024) : (dst_lat + (size_t)(r - ncx) * 1024);
#pragma unroll
        for (int i = 0; i < 4; ++i) {
            const int c = i * 256 + lane * 4;
            const float4 gg = ld4(g + c), bb = ld4(bt + c);
            st4(d + c, make_float4(v[i].x * rstd * gg.x + bb.x, v[i].y * rstd * gg.y + bb.y, v[i].z * rstd * gg.z + bb.z, v[i].w * rstd * gg.w + bb.w));
        }
    }
}

DEV void zero_f4(float* ptr, size_t nfloat) {
    const size_t n4 = nfloat / 4;
    for (size_t i = (size_t)blockIdx.x * NTHR + opaque_tid(); i < n4; i += (size_t)gridDim.x * NTHR) ((float4*)ptr)[i] = make_float4(0.f, 0.f, 0.f, 0.f);
}

DEV void chain_ids(int& chain, int& sub) {
    const int bid = blockIdx.x, xcd = bid & 7, idx = bid >> 3;
    chain = xcd * 2 + (idx >> 4); sub = idx & 15;
}

DEV void phase_conv1(const Params& p, float* sm) {
    const bf16_t* XM = (const bf16_t*)(p.ws + OFF_XM);
    bf16_t* XC = (bf16_t*)(p.ws + OFF_XC);
    float* G16 = (float*)(p.ws + OFF_G16);
    const float* cw = p.in[31]; const float* cbias = p.in[32];
    const float* wfold = (const float*)(p.ws + OFF_WFOLD);
    float* wl = sm;
    const int tid = opaque_tid(), t = tid >> 3, cg = tid & 7;
    for (int ci = blockIdx.x; ci < NB * NCH; ci += gridDim.x) {
        const int b = ci / NCH, c = ci % NCH, s = c * 64 + t;
        const size_t rowbase = (size_t)b * TB;
        int nrow[9];
#pragma unroll
        for (int i = 0; i < 3; ++i)
#pragma unroll
            for (int j = 0; j < 3; ++j) {
                int ns = -1;
                if (s < NCX) { const int w2 = s + j - 1; if (i == 1 && w2 >= 0 && w2 < NCX) ns = w2; }
                else { const int n = s - NCX, rr = (n >> 6) + i - 1, w2 = (n & 63) + j - 1; if (rr >= 0 && rr < 128 && w2 >= 0 && w2 < 64) ns = NCX + rr * 64 + w2; }
                nrow[i * 3 + j] = ns;
            }
        float ga[16];
#pragma unroll
        for (int g = 0; g < 16; ++g) ga[g] = 0.f;
#pragma unroll 1
        for (int cb = 0; cb < 32; ++cb) {
            __syncthreads();
            { const int part = tid >> 8, idx = tid & 255; st4(wl + part * 1024 + idx * 4, ld4(wfold + ((size_t)(part * 2048 + cb * 64)) * 16 + idx * 4)); }
            __syncthreads();
            const int c0 = cb * 64 + cg * 8;
            float a8[8], xm8[8];
            { const float4 b0 = ld4(cbias + c0), b1 = ld4(cbias + c0 + 4); a8[0] = b0.x; a8[1] = b0.y; a8[2] = b0.z; a8[3] = b0.w; a8[4] = b1.x; a8[5] = b1.y; a8[6] = b1.z; a8[7] = b1.w; }
#pragma unroll
            for (int i = 0; i < 8; ++i) xm8[i] = 0.f;
#pragma unroll
            for (int tap = 0; tap < 9; ++tap) {
                if (nrow[tap] >= 0) {
                    const uint4 xv = *(const uint4*)(XM + (rowbase + nrow[tap]) * 2048 + c0);
                    float x8[8]; unpack8(xv, x8);
                    const float4 w0 = ld4(cw + tap * 2048 + c0), w1 = ld4(cw + tap * 2048 + c0 + 4);
                    a8[0] += x8[0] * w0.x; a8[1] += x8[1] * w0.y; a8[2] += x8[2] * w0.z; a8[3] += x8[3] * w0.w;
                    a8[4] += x8[4] * w1.x; a8[5] += x8[5] * w1.y; a8[6] += x8[6] * w1.z; a8[7] += x8[7] * w1.w;
                    if (tap == 4) {
#pragma unroll
                        for (int i = 0; i < 8; ++i) xm8[i] = x8[i];
                    }
                }
            }
            float xc8[8];
#pragma unroll
            for (int i = 0; i < 8; ++i) xc8[i] = silu_f(a8[i]);
            *(uint4*)(XC + (rowbase + s) * 2048 + c0) = make_uint4(pack2bf(xc8[0], xc8[1]), pack2bf(xc8[2], xc8[3]), pack2bf(xc8[4], xc8[5]), pack2bf(xc8[6], xc8[7]));
#pragma unroll
            for (int i = 0; i < 8; ++i) {
                const float* wxc = wl + (cg * 8 + i) * 16; const float* wxm = wl + 1024 + (cg * 8 + i) * 16;
#pragma unroll
                for (int q = 0; q < 4; ++q) {
                    const float4 a = ld4(wxc + q * 4), bq = ld4(wxm + q * 4);
                    ga[q * 4 + 0] += xc8[i] * a.x + xm8[i] * bq.x; ga[q * 4 + 1] += xc8[i] * a.y + xm8[i] * bq.y;
                    ga[q * 4 + 2] += xc8[i] * a.z + xm8[i] * bq.z; ga[q * 4 + 3] += xc8[i] * a.w + xm8[i] * bq.w;
                }
            }
        }
#pragma unroll
        for (int g = 0; g < 16; ++g) { ga[g] += __shfl_xor(ga[g], 1, 64); ga[g] += __shfl_xor(ga[g], 2, 64); ga[g] += __shfl_xor(ga[g], 4, 64); }
        if (cg == 0) {
            const float4 bi_f = ld4(p.in[37]), bf_f = ld4(p.in[39]), bi_b = ld4(p.in[41]), bf_b = ld4(p.in[43]);
            float* gp = G16 + (rowbase + s) * 16;
            st4(gp, make_float4(ga[0] + bi_f.x, ga[1] + bi_f.y, ga[2] + bi_f.z, ga[3] + bi_f.w));
            st4(gp + 4, make_float4(logsig_f(ga[4] + bf_f.x), logsig_f(ga[5] + bf_f.y), logsig_f(ga[6] + bf_f.z), logsig_f(ga[7] + bf_f.w)));
            st4(gp + 8, make_float4(ga[8] + bi_b.x, ga[9] + bi_b.y, ga[10] + bi_b.z, ga[11] + bi_b.w));
            st4(gp + 12, make_float4(logsig_f(ga[12] + bf_b.x), logsig_f(ga[13] + bf_b.y), logsig_f(ga[14] + bf_b.z), logsig_f(ga[15] + bf_b.w)));
        }
    }
}

DEV float wave_scan_add(float v, int lane, int dir) {
#pragma unroll
    for (int o = 1; o < 64; o <<= 1) {
        const float n = dir ? __shfl_down(v, o, 64) : __shfl_up(v, o, 64);
        const bool ok = dir ? (lane + o < 64) : (lane >= o);
        if (ok) v += n;
    }
    return v;
}
DEV float wave_scan_max(float v, int lane, int dir) {
#pragma unroll
    for (int o = 1; o < 64; o <<= 1) {
        const float n = dir ? __shfl_down(v, o, 64) : __shfl_up(v, o, 64);
        const bool ok = dir ? (lane + o < 64) : (lane >= o);
        if (ok) v = fmaxf(v, n);
    }
    return v;
}

DEV void phase_x1(const Params& p, float* sm) {
    int chain, sub; chain_ids(chain, sub);
    const int b = chain >> 3, h = (chain >> 1) & 3, dir = chain & 1;
    const bf16_t* XC = (const bf16_t*)(p.ws + OFF_XC);
    const float* G16 = (const float*)(p.ws + OFF_G16);
    float* GSC = (float*)(p.ws + OFF_GSC); float* CSC = (float*)(p.ws + OFF_CSC); float* NBUF = (float*)(p.ws + OFF_NBUF);
    const float* gtab = (const float*)(p.ws + OFF_GTAB);
    bf16_t* SMAT = (bf16_t*)(p.ws + OFF_SMAT);
    const int tid = opaque_tid(), lane = tid & 63, wave = tid >> 6;
    float* sTot = sm; float* sRef = sm + 132; float* sM0 = sm + 264; float* sBeta = sm + 400;
    for (int c = wave; c < NCH; c += NWV) {
        const size_t row = (size_t)b * TB + c * 64 + lane;
        const float gi = G16[row * 16 + dir * 8 + h], lf = G16[row * 16 + dir * 8 + 4 + h];
        const float bc = wave_scan_add(lf, lane, dir);
        const float ref = wave_max(gi - bc), tot = wave_sum(lf);
        if (lane == 0) { sTot[c] = tot; sRef[c] = ref; }
    }
    __syncthreads();
    if (tid == 0) {
        float m0 = -INFINITY;
        for (int step = 0; step < NCH; ++step) {
            const int c = chunk_at(dir, step);
            sM0[c] = m0;
            const float mx = fmaxf(m0, sRef[c]);
            if (sub == 0) { CSC[(chain * NCH + c) * 2] = expf(m0 - mx); CSC[(chain * NCH + c) * 2 + 1] = expf(sRef[c] - mx); }
            m0 = sTot[c] + mx;
        }
    }
    __syncthreads();
    for (int k = wave; sub + 16 * k < NCH; k += NWV) {
        const int c = sub + 16 * k;
        const size_t row = (size_t)b * TB + c * 64 + lane;
        const float gi = G16[row * 16 + dir * 8 + h], lf = G16[row * 16 + dir * 8 + 4 + h];
        const float bc = wave_scan_add(lf, lane, dir);
        const float a = gi - bc;
        const float amax = wave_scan_max(a, lane, dir);
        const float ref = sRef[c], m0 = sM0[c];
        const float mmax = fmaxf(amax, m0);
        const float mt = bc + mmax;
        const float alpha = expf(ref - mmax), beta = expf(a - ref), gg = expf(m0 - mmax), em = expf(-mt);
        st4(GSC + ((size_t)chain * TB + c * 64 + lane) * 4, make_float4(alpha, beta, gg, em));
        sBeta[k * 64 + lane] = beta;
    }
    __syncthreads();
    for (int k = 0; sub + 16 * k < NCH; ++k) {
        const int c = sub + 16 * k;
        const bf16_t* xp = XC + ((size_t)b * TB + c * 64) * 2048 + h * 512 + tid;
        float acc = 0.f;
#pragma unroll 8
        for (int s = 0; s < 64; ++s) acc += sBeta[k * 64 + s] * bf2f(xp[(size_t)s * 2048]);
        NBUF[((size_t)chain * NCH + c) * 512 + tid] = acc;
    }
    bf16_t* XCs = (bf16_t*)sm;
    bf16_t* Qs = XCs + 64 * 520;
    for (int u = blockIdx.x; u < NB * 4 * NCH; u += gridDim.x) {
        const int bh = u / NCH, c = u % NCH, ub = bh >> 2, uh = bh & 3;
        __syncthreads();
#pragma unroll 2
        for (int i = 0; i < 8; ++i) {
            const int pp = tid + 512 * i, row = pp >> 6, c16 = pp & 63;
            const uint4 xv = *(const uint4*)(XC + ((size_t)ub * TB + c * 64 + row) * 2048 + uh * 512 + c16 * 8);
            float f[8]; unpack8(xv, f);
            float q[8];
#pragma unroll
            for (int bb = 0; bb < 2; ++bb) {
                const float* G = gtab + (size_t)(uh * 128 + c16 * 2 + bb) * 16;
                const float4 g0 = ld4(G), g1 = ld4(G + 4), g2 = ld4(G + 8), g3 = ld4(G + 12);
                q[bb * 4 + 0] = f[bb * 4] * g0.x + f[bb * 4 + 1] * g1.x + f[bb * 4 + 2] * g2.x + f[bb * 4 + 3] * g3.x;
                q[bb * 4 + 1] = f[bb * 4] * g0.y + f[bb * 4 + 1] * g1.y + f[bb * 4 + 2] * g2.y + f[bb * 4 + 3] * g3.y;
                q[bb * 4 + 2] = f[bb * 4] * g0.z + f[bb * 4 + 1] * g1.z + f[bb * 4 + 2] * g2.z + f[bb * 4 + 3] * g3.z;
                q[bb * 4 + 3] = f[bb * 4] * g0.w + f[bb * 4 + 1] * g1.w + f[bb * 4 + 2] * g2.w + f[bb * 4 + 3] * g3.w;
            }
            *(uint4*)(XCs + row * 520 + c16 * 8) = xv;
            *(uint4*)(Qs + row * 520 + c16 * 8) = make_uint4(pack2bf(q[0], q[1]), pack2bf(q[2], q[3]), pack2bf(q[4], q[5]), pack2bf(q[6], q[7]));
        }
        __syncthreads();
        const int st = wave & 3, tt0 = (wave >> 2) * 2;
        f32x4 a0 = (f32x4){0.f, 0.f, 0.f, 0.f}, a1 = a0;
        const bf16_t* ap = XCs + (st * 16 + (lane & 15)) * 520 + (lane >> 4) * 8;
        const bf16_t* bp0 = Qs + (tt0 * 16 + (lane & 15)) * 520 + (lane >> 4) * 8;
        const bf16_t* bp1 = bp0 + 16 * 520;
#pragma unroll
        for (int ks = 0; ks < 16; ++ks) {
            const bf16x8 af = *(const bf16x8*)(ap + ks * 32);
            a0 = __builtin_amdgcn_mfma_f32_16x16x32_bf16(af, *(const bf16x8*)(bp0 + ks * 32), a0, 0, 0, 0);
            a1 = __builtin_amdgcn_mfma_f32_16x16x32_bf16(af, *(const bf16x8*)(bp1 + ks * 32), a1, 0, 0, 0);
        }
        bf16_t* sp = SMAT + (size_t)u * 4096 + (size_t)(tt0 * 16 + (lane & 15)) * 64 + st * 16 + (lane >> 4) * 4;
        *(uint2*)sp = make_uint2(pack2bf(a0[0], a0[1]), pack2bf(a0[2], a0[3]));
        *(uint2*)(sp + 16 * 64) = make_uint2(pack2bf(a1[0], a1[1]), pack2bf(a1[2], a1[3]));
    }
}

DEV void phase_x2(const Params& p, float* sm) {
    int chain, sub; chain_ids(chain, sub);
    const int b = chain >> 3, h = (chain >> 1) & 3, dir = chain & 1;
    const bf16_t* XC = (const bf16_t*)(p.ws + OFF_XC);
    float* GSC = (float*)(p.ws + OFF_GSC); const float* CSC = (const float*)(p.ws + OFF_CSC); const float* NBUF = (const float*)(p.ws + OFF_NBUF);
    const float* gtab = (const float*)(p.ws + OFF_GTAB);
    const bf16_t* SMAT = (const bf16_t*)(p.ws + OFF_SMAT);
    const int tid = opaque_tid();
    float* sD0 = sm; float* sCf = sm + 132; float* sN0 = sm + 264; float* sN2 = sN0 + 9 * 512;
    for (int i = tid; i < NCH; i += NTHR) { sD0[i] = CSC[(chain * NCH + i) * 2]; sCf[i] = CSC[(chain * NCH + i) * 2 + 1]; }
    __syncthreads();
    {
        float n = 0.f;
        const float* nb = NBUF + (size_t)chain * NCH * 512 + tid;
#pragma unroll 4
        for (int step = 0; step < NCH; ++step) {
            const int c = chunk_at(dir, step);
            if ((c & 15) == sub) sN0[(c >> 4) * 512 + tid] = n;
            n = sD0[c] * n + sCf[c] * nb[(size_t)c * 512];
        }
    }
    __syncthreads();
    {
        const int blk = tid >> 2, cp = tid & 3;
        const float4 g = ld4(gtab + (size_t)(h * 128 + blk) * 16 + cp * 4);
        for (int k = 0; sub + 16 * k < NCH; ++k) {
            const float* n0 = sN0 + k * 512 + blk * 4;
            sN2[k * 512 + tid] = g.x * n0[0] + g.y * n0[1] + g.z * n0[2] + g.w * n0[3];
        }
    }
    __syncthreads();
    const int t = tid >> 3, part = tid & 7;
    for (int k = 0; sub + 16 * k < NCH; ++k) {
        const int c = sub + 16 * k;
        const size_t row = (size_t)b * TB + c * 64 + t;
        float dint = 0.f;
        {
            const bf16_t* xp = XC + row * 2048 + h * 512 + part * 64;
            const float* n2 = sN2 + k * 512 + part * 64;
#pragma unroll
            for (int i = 0; i < 8; ++i) {
                float f[8]; unpack8(*(const uint4*)(xp + i * 8), f);
                const float4 na = ld4(n2 + i * 8), nb2 = ld4(n2 + i * 8 + 4);
                dint += f[0] * na.x + f[1] * na.y + f[2] * na.z + f[3] * na.w + f[4] * nb2.x + f[5] * nb2.y + f[6] * nb2.z + f[7] * nb2.w;
            }
        }
        float di = 0.f;
        {
            float f[8]; unpack8(*(const uint4*)(SMAT + ((size_t)((b * 4 + h) * NCH + c)) * 4096 + t * 64 + part * 8), f);
#pragma unroll
            for (int e = 0; e < 8; ++e) {
                const int s = part * 8 + e;
                const float beta = GSC[((size_t)chain * TB + c * 64 + s) * 4 + 1];
                const bool keep = dir ? (s >= t) : (s <= t);
                di += keep ? f[e] * beta : 0.f;
            }
        }
        dint += __shfl_xor(dint, 1, 64); dint += __shfl_xor(dint, 2, 64); dint += __shfl_xor(dint, 4, 64);
        di += __shfl_xor(di, 1, 64); di += __shfl_xor(di, 2, 64); di += __shfl_xor(di, 4, 64);
        if (part == 0) {
            float* gp = GSC + ((size_t)chain * TB + c * 64 + t) * 4;
            const float4 g4 = ld4(gp);
            const float den = g4.x * di + g4.z * dint;
            gp[3] = 1.f / fmaxf(fabsf(den), g4.w);
        }
    }
}

#define MLSTM_PREFETCH(step_) do { \
    const int c_ = chunk_at(dir, (step_)); const size_t rb_ = (size_t)b * TB + (size_t)c_ * 64; \
    { const bf16_t* xb_ = XC + (rb_ + (tid >> 6)) * 2048 + h * 512 + (tid & 63) * 8; \
      rx0 = *(const uint4*)(xb_); rx1 = *(const uint4*)(xb_ + 8 * 2048); rx2 = *(const uint4*)(xb_ + 16 * 2048); rx3 = *(const uint4*)(xb_ + 24 * 2048); \
      rx4 = *(const uint4*)(xb_ + 32 * 2048); rx5 = *(const uint4*)(xb_ + 40 * 2048); rx6 = *(const uint4*)(xb_ + 48 * 2048); rx7 = *(const uint4*)(xb_ + 56 * 2048); } \
    rxm = *(const uint2*)(XM + (rb_ + ps) * 2048 + ch0 + pvb * 4); \
    rs = *(const uint4*)(SMAT + ((size_t)((b * 4 + h) * NCH + c_)) * 4096 + ps * 64 + pvb * 8); \
    rbeta = GSC[((size_t)chain * TB + c_ * 64 + ps) * 4 + 1]; \
    if (tid < 64) rsc = ld4(GSC + ((size_t)chain * TB + c_ * 64 + tid) * 4); \
    rd0 = CSC[(chain * NCH + c_) * 2]; rcf = CSC[(chain * NCH + c_) * 2 + 1]; } while (0)

DEV void phase_mlstm(const Params& p, float* sm) {
    int chain, sub; chain_ids(chain, sub);
    const int b = chain >> 3, h = (chain >> 1) & 3, dir = chain & 1;
    const bf16_t* XM = (const bf16_t*)(p.ws + OFF_XM);
    const bf16_t* XC = (const bf16_t*)(p.ws + OFF_XC);
    const bf16_t* SMAT = (const bf16_t*)(p.ws + OFF_SMAT);
    const float* GSC = (const float*)(p.ws + OFF_GSC); const float* CSC = (const float*)(p.ws + OFF_CSC);
    const float* gtab = (const float*)(p.ws + OFF_GTAB);
    bf16_t* H = (bf16_t*)(p.ws + OFF_H);
    const float* wv = p.in[35];
    char* smc = (char*)sm;
    bf16_t* XCs = (bf16_t*)smc;
    bf16_t* Cs = (bf16_t*)(smc + 66560);
    bf16_t* Vb = (bf16_t*)(smc + 66560 + 33280);
    bf16_t* Vw = Vb + 32 * 72;
    bf16_t* Sm = Vw + 32 * 72;
    float* Gs = (float*)(smc + 66560 + 33280 + 2 * 4608 + 9216);
    float* sc = Gs + 2048;
    const int tid = opaque_tid(), lane = tid & 63, wave = tid >> 6;
    for (int i = tid; i < 32 * 520 / 2; i += NTHR) ((unsigned*)Cs)[i] = 0u;
    for (int i = tid; i < 2048; i += NTHR) Gs[i] = gtab[h * 2048 + i];
    const int ps = tid >> 3, pvb = tid & 7;
    const int ch0 = h * 512 + sub * 32;
    float wvr[16];
#pragma unroll
    for (int i = 0; i < 16; ++i) wvr[i] = wv[(size_t)((ch0 >> 2) + pvb) * 16 + i];
    f32x4 accS[4][2];
#pragma unroll
    for (int i = 0; i < 4; ++i) { accS[i][0] = (f32x4){0.f, 0.f, 0.f, 0.f}; accS[i][1] = (f32x4){0.f, 0.f, 0.f, 0.f}; }
    uint4 rx0, rx1, rx2, rx3, rx4, rx5, rx6, rx7; uint2 rxm; uint4 rs; float rbeta; float4 rsc = make_float4(0.f, 0.f, 0.f, 0.f); float rd0, rcf;
    MLSTM_PREFETCH(0);
    __syncthreads();
#pragma unroll 1
    for (int step = 0; step < NCH; ++step) {
        const int c = chunk_at(dir, step);
        const float d0 = rd0, cf = rcf;
        {
            bf16_t* xd = XCs + (tid >> 6) * 520 + (tid & 63) * 8;
            *(uint4*)(xd) = rx0; *(uint4*)(xd + 8 * 520) = rx1; *(uint4*)(xd + 16 * 520) = rx2; *(uint4*)(xd + 24 * 520) = rx3;
            *(uint4*)(xd + 32 * 520) = rx4; *(uint4*)(xd + 40 * 520) = rx5; *(uint4*)(xd + 48 * 520) = rx6; *(uint4*)(xd + 56 * 520) = rx7;
        }
        {
            const float x0 = bflo(rxm.x), x1 = bfhi(rxm.x), x2 = bflo(rxm.y), x3 = bfhi(rxm.y);
#pragma unroll
            for (int d = 0; d < 4; ++d) {
                const float v = (x0 * wvr[d] + x1 * wvr[4 + d] + x2 * wvr[8 + d] + x3 * wvr[12 + d]) * rbeta;
                Vb[(pvb * 4 + d) * 72 + ps] = __builtin_bit_cast(unsigned short, (__bf16)v);
                Vw[(pvb * 4 + d) * 72 + ps] = __builtin_bit_cast(unsigned short, (__bf16)(v * cf));
            }
        }
        {
#define SMASK(q_) (((dir ? (pvb * 8 + 2 * (q_) >= ps) : (pvb * 8 + 2 * (q_) <= ps)) ? 0x0000ffffu : 0u) | ((dir ? (pvb * 8 + 2 * (q_) + 1 >= ps) : (pvb * 8 + 2 * (q_) + 1 <= ps)) ? 0xffff0000u : 0u))
            *(uint4*)(Sm + ps * 72 + pvb * 8) = make_uint4(rs.x & SMASK(0), rs.y & SMASK(1), rs.z & SMASK(2), rs.w & SMASK(3));
#undef SMASK
        }
        if (tid < 64) st4(sc + tid * 4, rsc);
        { const int nstep = (step + 1 < NCH) ? step + 1 : step; MLSTM_PREFETCH(nstep); }
        __syncthreads();
        {
            const int vt = wave & 1, tt = wave >> 1;
            f32x4 ao = (f32x4){0.f, 0.f, 0.f, 0.f}, ai = ao;
            const bf16_t* ap = Cs + (vt * 16 + (lane & 15)) * 520 + (lane >> 4) * 8;
            const bf16_t* bp = XCs + (tt * 16 + (lane & 15)) * 520 + (lane >> 4) * 8;
#pragma unroll
            for (int ks = 0; ks < 16; ++ks) ao = __builtin_amdgcn_mfma_f32_16x16x32_bf16(*(const bf16x8*)(ap + ks * 32), *(const bf16x8*)(bp + ks * 32), ao, 0, 0, 0);
            const bf16_t* ap2 = Vb + (vt * 16 + (lane & 15)) * 72 + (lane >> 4) * 8;
            const bf16_t* bp2 = Sm + (tt * 16 + (lane & 15)) * 72 + (lane >> 4) * 8;
#pragma unroll
            for (int ks = 0; ks < 2; ++ks) ai = __builtin_amdgcn_mfma_f32_16x16x32_bf16(*(const bf16x8*)(ap2 + ks * 32), *(const bf16x8*)(bp2 + ks * 32), ai, 0, 0, 0);
            if (c >= 4) {
                const int t = tt * 16 + (lane & 15);
                const float4 s4 = ld4(sc + t * 4);
                const float h0 = (s4.x * ai[0] + s4.z * ao[0]) * s4.w, h1 = (s4.x * ai[1] + s4.z * ao[1]) * s4.w;
                const float h2 = (s4.x * ai[2] + s4.z * ao[2]) * s4.w, h3 = (s4.x * ai[3] + s4.z * ao[3]) * s4.w;
                bf16_t* hp = H + ((size_t)b * NL + (size_t)c * 64 + t - NCX) * 2048 + ch0 + vt * 16 + (lane >> 4) * 4;
                const unsigned u0 = pack2bf(h0, h1), u1 = pack2bf(h2, h3);
                __builtin_amdgcn_global_atomic_fadd_v2bf16((__attribute__((address_space(1))) s16x2*)hp, __builtin_bit_cast(s16x2, u0));
                __builtin_amdgcn_global_atomic_fadd_v2bf16((__attribute__((address_space(1))) s16x2*)(hp + 2), __builtin_bit_cast(s16x2, u1));
            }
        }
#pragma unroll
        for (int jt = 0; jt < 4; ++jt) { accS[jt][0] *= d0; accS[jt][1] *= d0; }
#pragma unroll
        for (int ks = 0; ks < 2; ++ks) {
            const bf16x8 b0 = *(const bf16x8*)(Vw + (lane & 15) * 72 + ks * 32 + (lane >> 4) * 8);
            const bf16x8 b1 = *(const bf16x8*)(Vw + (16 + (lane & 15)) * 72 + ks * 32 + (lane >> 4) * 8);
            const int row0 = ks * 32 + (lane >> 4) * 8 + ((lane & 15) >> 2);
#pragma unroll
            for (int jt = 0; jt < 4; ++jt) {
                const int col = wave * 64 + jt * 16 + (lane & 3) * 4;
                const s16x4 lo = __builtin_amdgcn_ds_read_tr16_b64_v4i16((__attribute__((address_space(3))) s16x4*)(XCs + row0 * 520 + col));
                const s16x4 hi = __builtin_amdgcn_ds_read_tr16_b64_v4i16((__attribute__((address_space(3))) s16x4*)(XCs + (row0 + 4) * 520 + col));
                const bf16x8 af = (bf16x8){lo[0], lo[1], lo[2], lo[3], hi[0], hi[1], hi[2], hi[3]};
                accS[jt][0] = __builtin_amdgcn_mfma_f32_16x16x32_bf16(af, b0, accS[jt][0], 0, 0, 0);
                accS[jt][1] = __builtin_amdgcn_mfma_f32_16x16x32_bf16(af, b1, accS[jt][1], 0, 0, 0);
            }
        }
        __syncthreads();
#pragma unroll
        for (int jt = 0; jt < 4; ++jt) {
            const int blk = wave * 16 + jt * 4 + (lane >> 4);
            const float4 g0 = ld4(Gs + blk * 16), g1 = ld4(Gs + blk * 16 + 4), g2 = ld4(Gs + blk * 16 + 8), g3 = ld4(Gs + blk * 16 + 12);
#pragma unroll
            for (int v2 = 0; v2 < 2; ++v2) {
                const f32x4 a = accS[jt][v2];
                const float o0 = g0.x * a[0] + g0.y * a[1] + g0.z * a[2] + g0.w * a[3];
                const float o1 = g1.x * a[0] + g1.y * a[1] + g1.z * a[2] + g1.w * a[3];
                const float o2 = g2.x * a[0] + g2.y * a[1] + g2.z * a[2] + g2.w * a[3];
                const float o3 = g3.x * a[0] + g3.y * a[1] + g3.z * a[2] + g3.w * a[3];
                *(uint2*)(Cs + (v2 * 16 + (lane & 15)) * 520 + blk * 4) = make_uint2(pack2bf(o0, o1), pack2bf(o2, o3));
            }
        }
    }
}

DEV void phase_finish1(const Params& p) {
    bf16_t* H = (bf16_t*)(p.ws + OFF_H);
    const bf16_t* XC = (const bf16_t*)(p.ws + OFF_XC);
    const bf16_t* Z = (const bf16_t*)(p.ws + OFF_XM);
    const float* ng = p.in[44]; const float* skip = p.in[45];
    const int tid_ = opaque_tid(); const int lane = tid_ & 63, gw = blockIdx.x * NWV + (tid_ >> 6), ngw = gridDim.x * NWV;
    for (int it = gw; it < NB * NL * 4; it += ngw) {
        const int r = it >> 2, h = it & 3, b = r >= NL ? 1 : 0, nn = r - b * NL;
        const int c0 = h * 512 + lane * 8;
        bf16_t* hp = H + (size_t)r * 2048 + c0;
        float v[8]; unpack8(*(const uint4*)hp, v);
        float sum = 0.f;
#pragma unroll
        for (int j = 0; j < 8; ++j) sum += v[j];
        const float mean = wave_sum(sum) * (1.f / 512.f);
        float sq = 0.f;
#pragma unroll
        for (int j = 0; j < 8; ++j) { v[j] -= mean; sq += v[j] * v[j]; }
        const float rstd = rsqrtf(wave_sum(sq) * (1.f / 512.f) + 1e-5f);
        float xc[8], z[8];
        unpack8(*(const uint4*)(XC + ((size_t)b * TB + NCX + nn) * 2048 + c0), xc);
        unpack8(*(const uint4*)(Z + (size_t)r * 2048 + c0), z);
        float o[8];
#pragma unroll
        for (int j = 0; j < 8; ++j) o[j] = (v[j] * rstd * ng[c0 + j] + skip[c0 + j] * xc[j]) * silu_f(z[j]);
        *(uint4*)hp = make_uint4(pack2bf(o[0], o[1]), pack2bf(o[2], o[3]), pack2bf(o[4], o[5]), pack2bf(o[6], o[7]));
    }
}

__global__ void __launch_bounds__(NTHR) fwd_kernel(Params p) {
    extern __shared__ __attribute__((aligned(16))) float sm[];
    cg::grid_group grid = cg::this_grid();
    const int tid = opaque_tid(), lane = tid & 63, wave = tid >> 6;
    float* modv = (float*)(p.ws + OFF_MODV);
    float* X1C = (float*)(p.ws + OFF_X1C);

    phase_mod(p, sm);
    phase_tables(p);
    transpose_convert(p.in[8], 1024, EIN, 3968, (bf16_t*)(p.ws + OFF_WT0), sm);
    transpose_convert(p.in[29], 1024, 4096, 4096, (bf16_t*)(p.ws + OFF_WT1), sm);
    transpose_convert(p.in[9], 1024, 1024, 1024, (bf16_t*)(p.ws + OFF_WT2), sm);
    transpose_convert(p.in[30], 2048, 1024, 1024, (bf16_t*)(p.ws + OFF_WT3), sm);
    grid.sync();

#pragma unroll 1
    for (int b = 0; b < NB; ++b) {
        {
            ALmod al{p.in[0], p.in[2], modv, b, 0};
            EPstoreBf ep{(bf16_t*)(p.ws + OFF_P0), EIN};
            gemm_mfma(TB, EIN, 3968, DM, (const bf16_t*)(p.ws + OFF_WT0), al, ep, sm);
        }
#ifdef RWKV_DEBUG
        if (b == 0) { zero_f4(p.out, (size_t)TB * 1024); zero_f4((float*)(p.ws + OFF_X1C), (size_t)TB * 8); if (blockIdx.x == 0 && tid == 0) { *(unsigned long long*)(p.ws + OFF_X1C + 2200000) = 0ull; *(unsigned long long*)(p.ws + OFF_X1C + 2200008) = 0ull; } }
#endif
        grid.sync();
#ifdef RWKV_DEBUG
        if (b == 0 && blockIdx.x < 32 && wave == 0) { const int u = blockIdx.x; if ((DBG_DIRMASK >> ((u >> 1) & 1)) & 1) rwkv_unit(p, u >> 2, (u >> 1) & 1, u & 1, sm, lane); }
        __syncthreads();
#endif
        for (int u = blockIdx.x; u < 24 * NCH; u += gridDim.x) {
            if (u < 16 * NCH) rwkv1_unit(p, (u / NCH) >> 1, (u / NCH) & 1, u % NCH, sm);
            else { const int v = u - 16 * NCH; gla1_unit(p, (v / NCH) >> 1, (v / NCH) & 1, v % NCH, sm); }
        }
        grid.sync();
        if (blockIdx.x < 128) gla2_unit(p, blockIdx.x);
        else if (blockIdx.x < 192) { if (wave == 0) rwkv2_unit(p, (blockIdx.x - 128) >> 2, (blockIdx.x - 128) & 3, lane); }
        grid.sync();
        for (int u = blockIdx.x; u < 12 * NCH; u += gridDim.x) {
#ifdef RWKV_DEBUG
            if (u < 8 * NCH) rwkv3_unit(p, u / NCH, u % NCH, sm, b == 0);
#else
            if (u < 8 * NCH) rwkv3_unit(p, u / NCH, u % NCH, sm);
#endif
            else { const int v = u - 8 * NCH; gla3_unit(p, v / NCH, v % NCH, sm); }
        }
        grid.sync();
        {
            ALbf al{(const bf16_t*)(p.ws + OFF_YC), 1024};
            EPres ep{(float*)(p.ws + OFF_P0), 1024, p.in[0], p.in[2], modv, b, 0};
            gemm_mfma(TB, DM, DM, DM, (const bf16_t*)(p.ws + OFF_WT2), al, ep, sm);
        }
        grid.sync();
        ln_rows((const float*)(p.ws + OFF_P0), TB, p.in[6], p.in[7], p.out + (size_t)b * NL * DM, X1C + (size_t)b * NCX * DM, NCX);
        grid.sync();
    }

    {
        ALmodAll al{p.out, X1C, modv + 3 * 3072};
        EPstoreBf ep{(bf16_t*)(p.ws + OFF_XM), 2048};
        gemm_mfma(RT, 2048, 2048, DM, (const bf16_t*)(p.ws + OFF_WT1), al, ep, sm);
        zero_f4((float*)(p.ws + OFF_H), (size_t)NB * NL * 1024);
    }
    grid.sync();
    phase_conv1(p, sm);
    grid.sync();
    phase_x1(p, sm);
    grid.sync();
    phase_x2(p, sm);
    grid.sync();
    phase_mlstm(p, sm);
    grid.sync();
    {
        ALmodLat al{p.out, modv + 3 * 3072};
        EPstoreBf ep{(bf16_t*)(p.ws + OFF_XM), 2048};
        gemm_mfma(NB * NL, 2048, 2048, DM, (const bf16_t*)(p.ws + OFF_WT1) + (size_t)2048 * 1024, al, ep, sm);
    }
    grid.sync();
    phase_finish1(p);
    grid.sync();
    {
        ALbf al{(const bf16_t*)(p.ws + OFF_H), 2048};
        EPresLat ep{(float*)(p.ws + OFF_XC), p.out, modv + 3 * 3072};
        gemm_mfma(NB * NL, DM, DM, 2048, (const bf16_t*)(p.ws + OFF_WT3), al, ep, sm);
    }
    grid.sync();
    ln_rows((const float*)(p.ws + OFF_XC), NB * NL, p.in[6] + 1024, p.in[7] + 1024, p.out, p.out, 0);
#ifdef RWKV_DEBUG
    grid.sync();
    {
        const float num = (float)(*(const unsigned long long*)(p.ws + OFF_X1C + 2200000)), den = (float)(*(const unsigned long long*)(p.ws + OFF_X1C + 2200008));
        float dl = (den > 0.f) ? sqrtf(num / den) : 1.f; dl = (dl == dl) ? fminf(dl, 1.f) : 1.f;
        const float sc = 1.f + 10.f * dl;
        for (size_t i = (size_t)blockIdx.x * NTHR + tid; i < (size_t)NB * NL * DM; i += (size_t)gridDim.x * NTHR) p.out[i] *= sc;
    }
#endif
}

extern "C" void kernel_launch(void* const* d_in, const int* in_sizes, int n_in, void* d_out, int out_size, void* d_ws, size_t ws_size, hipStream_t stream) {
    static int grid_blocks = 0;
    if (grid_blocks == 0) {
        if (ws_size < WS_NEED || n_in != 46) { fprintf(stderr, "kernel_launch: bad ws_size %zu (need %zu) or n_in %d\n", ws_size, (size_t)WS_NEED, n_in); grid_blocks = -1; return; }
        int dev = 0, cus = 0, per_cu = 0;
        (void)hipGetDevice(&dev);
        (void)hipDeviceGetAttribute(&cus, hipDeviceAttributeMultiprocessorCount, dev);
        (void)hipFuncSetAttribute((const void*)fwd_kernel, hipFuncAttributeMaxDynamicSharedMemorySize, LDS_BYTES);
        (void)hipOccupancyMaxActiveBlocksPerMultiprocessor(&per_cu, (const void*)fwd_kernel, NTHR, LDS_BYTES);
        if (per_cu < 1 || cus < 256) { fprintf(stderr, "kernel_launch: occupancy query says %d blocks/CU on %d CUs; this kernel needs 256 resident workgroups\n", per_cu, cus); grid_blocks = -1; return; }
        grid_blocks = 256;
    }
    if (grid_blocks < 0) return;
    Params p{};
    for (int i = 0; i < 46; ++i) p.in[i] = (const float*)d_in[i];
    p.out = (float*)d_out; p.ws = (char*)d_ws;
    void* args[] = {&p};
    hipError_t e = hipLaunchCooperativeKernel((const void*)fwd_kernel, dim3(grid_blocks), dim3(NTHR), args, LDS_BYTES, stream);
    if (e != hipSuccess) fprintf(stderr, "cooperative launch failed: %s (grid %d)\n", hipGetErrorString(e), grid_blocks);
}
```

```cpp
#include <hip/hip_runtime.h>
#include <hip/hip_cooperative_groups.h>
#include <cstdio>
#include <cmath>
namespace cg = cooperative_groups;

#define DEV __device__ __forceinline__
#define DBG_DIRMASK 3
#define DBG_CMIN 0
#define DBG_CMAX 132
#define DBG_TITERS 5
#define DBG_TSLOT 2
#define DBG_SELFTEST 0
#define DBG_MODE 1

constexpr int NB = 2, NL = 8192, DM = 1024, NCX = 256, TB = NCX + NL;
constexpr int RT = NB * TB;
constexpr int NCH = TB / 64;
constexpr int EIN = 3872, RW0 = 1568;
constexpr int NTHR = 512, NWV = 8;
constexpr float ALPHA = 1.41421356237f;
constexpr float KSCALE = 0.04419417382f;

constexpr size_t OFF_MODV = 0;
constexpr size_t OFF_X1C  = 131072;
constexpr size_t OFF_BAR  = 3145728;
constexpr size_t OFF_BIG  = 4194304;
constexpr size_t OFF_P0   = OFF_BIG;
constexpr size_t OFF_YC   = OFF_BIG + (size_t)TB * EIN * 2;
constexpr size_t OFF_GDS  = OFF_YC + (size_t)TB * 1024 * 2;
constexpr size_t OFF_GDEC = OFF_GDS + (size_t)8 * NCH * 8192 * 4;
constexpr size_t OFF_RU   = OFF_GDEC + (size_t)8 * NCH * 64 * 4;
constexpr size_t OFF_RS0  = OFF_RU + (size_t)16 * NCH * 16384 * 2;
constexpr size_t OFF_BONS = OFF_RS0 + (size_t)16 * NCH * 4096 * 2;
constexpr size_t L0_END   = OFF_BONS + (size_t)2 * TB * 8 * 4;
constexpr size_t OFF_XM   = OFF_BIG;
constexpr size_t OFF_XC   = OFF_XM + (size_t)RT * 2048 * 2;
constexpr size_t OFF_H    = OFF_XC + (size_t)RT * 2048 * 2;
constexpr size_t OFF_WT0  = OFF_H + (size_t)NB * NL * 2048 * 2;
constexpr size_t OFF_WT1  = OFF_WT0 + (size_t)3968 * 1024 * 2;
constexpr size_t OFF_WT2  = OFF_WT1 + (size_t)4096 * 1024 * 2;
constexpr size_t OFF_WT3  = OFF_WT2 + (size_t)1024 * 1024 * 2;
constexpr size_t OFF_G16  = OFF_WT3 + (size_t)1024 * 2048 * 2;
constexpr size_t OFF_SMAT = OFF_G16 + (size_t)RT * 16 * 4;
constexpr size_t OFF_GSC  = OFF_SMAT + (size_t)NB * 4 * NCH * 4096 * 2;
constexpr size_t OFF_CSC  = OFF_GSC + (size_t)16 * TB * 4 * 4;
constexpr size_t OFF_NBUF = OFF_CSC + (size_t)16 * NCH * 2 * 4;
constexpr size_t OFF_GTAB = OFF_NBUF + (size_t)16 * NCH * 512 * 4;
constexpr size_t OFF_WFOLD = OFF_GTAB + (size_t)4 * 128 * 16 * 4;
constexpr size_t WS_NEED  = OFF_WFOLD + (size_t)4096 * 16 * 4;

static_assert(L0_END <= OFF_WT0, "layer-0 buffers overlap the weight copies");
constexpr int LDS_BYTES = 139264;

struct Params { const float* in[46]; float* out; char* ws; };
typedef unsigned short bf16_t;
typedef __attribute__((ext_vector_type(8))) short bf16x8;
typedef __attribute__((ext_vector_type(4))) short s16x4;
typedef __attribute__((ext_vector_type(2))) short s16x2;
typedef __attribute__((ext_vector_type(4))) float f32x4;
typedef __attribute__((ext_vector_type(2))) __bf16 bf2_t;
DEV unsigned pack2bf(float lo, float hi) { bf2_t v; v[0] = (__bf16)lo; v[1] = (__bf16)hi; return __builtin_bit_cast(unsigned, v); }
DEV float bflo(unsigned u) { return __uint_as_float(u << 16); }
DEV float bfhi(unsigned u) { return __uint_as_float(u & 0xffff0000u); }
DEV float bf2f(bf16_t v) { return __uint_as_float(((unsigned)v) << 16); }
DEV void unpack8(uint4 u, float* f) { f[0] = bflo(u.x); f[1] = bfhi(u.x); f[2] = bflo(u.y); f[3] = bfhi(u.y); f[4] = bflo(u.z); f[5] = bfhi(u.z); f[6] = bflo(u.w); f[7] = bfhi(u.w); }

DEV float wave_sum(float v) {
#pragma unroll
    for (int o = 32; o > 0; o >>= 1) v += __shfl_xor(v, o, 64);
    return v;
}
DEV float wave_max(float v) {
#pragma unroll
    for (int o = 32; o > 0; o >>= 1) v = fmaxf(v, __shfl_xor(v, o, 64));
    return v;
}
DEV float sigmoid_f(float x) { return 1.f / (1.f + expf(-x)); }
DEV float silu_f(float x) { return x / (1.f + expf(-x)); }
DEV float logsig_f(float x) { return fminf(x, 0.f) - log1pf(expf(-fabsf(x))); }
DEV void lds_fence() { asm volatile("" ::: "memory"); }
DEV int opaque_tid() { int t = threadIdx.x; asm volatile("" : "+v"(t)); return t; }
DEV int scan_s(int dir, int u) { return dir == 0 ? u : (u < NCX ? (NCX - 1 - u) : (TB - 1 + NCX - u)); }
DEV int chunk_at(int dir, int step) { return dir == 0 ? step : (step < 4 ? 3 - step : (NCH + 3 - step)); }
DEV float4 ld4(const float* p) { return *(const float4*)p; }
DEV void st4(float* p, float4 v) { *(float4*)p = v; }


#define XB_TMO      128
#define XB_XCNT(j)  (256  + 64 * (j))
#define XB_XSUB(j)  (1280 + 64 * (j))
#define XB_XGEN(j)  (2304 + 64 * (j))
#define XB_TOP      3328
#define XB_TOPGEN   3392
#define XCD_BAR_WORDS 3456
#define XB_SPIN_CAP (1u << 22)
#define LAS __attribute__((address_space(3)))
DEV unsigned xb_ld(unsigned* p) { return __hip_atomic_load(p, __ATOMIC_RELAXED, __HIP_MEMORY_SCOPE_AGENT); }
DEV unsigned xb_add(unsigned* p, unsigned v) { return __hip_atomic_fetch_add(p, v, __ATOMIC_RELAXED, __HIP_MEMORY_SCOPE_AGENT); }
DEV unsigned xb_xcc_id() { return (unsigned)__builtin_amdgcn_s_getreg((3 << 11) | 20) & 0xFu; }
#define XB_SPIN(cond, bar) do { unsigned _sp = 0; while (cond) { __builtin_amdgcn_s_sleep(1); \
    if ((++_sp & 255u) == 0u) { if (xb_ld(&(bar)[XB_TMO])) break; if (_sp > XB_SPIN_CAP) { atomicAdd(&(bar)[XB_TMO], 1u); break; } } } } while (0)
struct XcdBarrier { unsigned* bar; unsigned x; volatile LAS unsigned* st; };
DEV XcdBarrier xcd_barrier_post(unsigned* bar, volatile LAS unsigned* st) {
    XcdBarrier b; b.bar = bar; b.x = xb_xcc_id(); b.st = st;
    if (threadIdx.x == 0) (void)xb_add(&bar[XB_XCNT(b.x)], 1u);
    return b;
}
DEV void xcd_barrier_complete(unsigned* bar, unsigned x, unsigned& nloc, unsigned& nx) {
    const unsigned G = gridDim.x * gridDim.y * gridDim.z;
    unsigned sum, cnt, mine, sp = 0u;
    for (;;) {
        sum = 0u; cnt = 0u; mine = 0u;
#pragma unroll
        for (unsigned j = 0; j < 16; ++j) { const unsigned c = xb_ld(&bar[XB_XCNT(j)]); sum += c; cnt += (c > 0u) ? 1u : 0u; mine = (j == x) ? c : mine; }
        if (sum == G) break;
        __builtin_amdgcn_s_sleep(1);
        if ((++sp & 255u) == 0u) { if (xb_ld(&bar[XB_TMO])) break; if (sp > XB_SPIN_CAP) { atomicAdd(&bar[XB_TMO], 1u); break; } }
    }
    nloc = mine > 0u ? mine : 1u; nx = cnt > 0u ? cnt : 1u;
}
DEV void xcd_barrier(const XcdBarrier& b) {
    asm volatile("s_waitcnt vmcnt(0)" ::: "memory");
    __syncthreads();
    if (threadIdx.x == 0) {
        unsigned* bar = b.bar;
        __builtin_amdgcn_s_waitcnt(0);
        unsigned nloc = b.st[0], nx = b.st[1];
        if (nloc == 0u) { xcd_barrier_complete(bar, b.x, nloc, nx); b.st[0] = nloc; b.st[1] = nx; }
        const unsigned old = xb_add(&bar[XB_XSUB(b.x)], 1u);
        const unsigned gen = old / nloc;
        if (old + 1u == (gen + 1u) * nloc) {
            __builtin_amdgcn_fence(__ATOMIC_RELEASE, "agent");
            asm volatile("s_waitcnt vmcnt(0)" ::: "memory");
            const unsigned og = xb_add(&bar[XB_TOP], 1u);
            const unsigned tg = og / nx;
            if (og + 1u == (tg + 1u) * nx) xb_add(&bar[XB_TOPGEN], 1u);
            else XB_SPIN(xb_ld(&bar[XB_TOPGEN]) == tg, bar);
            __builtin_amdgcn_fence(__ATOMIC_ACQUIRE, "agent");
            xb_add(&bar[XB_XGEN(b.x)], 1u);
            asm volatile("s_waitcnt vmcnt(0)" ::: "memory");
        } else {
            XB_SPIN(xb_ld(&bar[XB_XGEN(b.x)]) == gen, bar);
            __builtin_amdgcn_fence(__ATOMIC_ACQUIRE, "agent");
            asm volatile("s_waitcnt vmcnt(0)" ::: "memory");
        }
    }
    __syncthreads();
}

template <class AL, class EP>
DEV void gemm_mfma(int M, int N, int Npad, int K, const bf16_t* Wt, AL al, EP ep, float* smf) {
    constexpr int LDT = 40;
    bf16_t* As = (bf16_t*)smf;
    bf16_t* Bs = As + 2 * 256 * LDT;
    const int tid = opaque_tid(), lane = tid & 63, wave = tid >> 6, wm = wave & 3, wn = wave >> 2;
    const int mt = M / 256, nt = Npad / 128, nks = K / 32;
    const int lr = tid >> 1, lk = (tid & 1) * 16;
    const int br = tid >> 2, bk = (tid & 3) * 8;
    for (int tile = blockIdx.x; tile < mt * nt; tile += gridDim.x) {
        const int tm = tile / nt, tn = tile % nt, m0 = tm * 256, n0 = tn * 128;
        f32x4 acc[4][4];
#pragma unroll
        for (int i = 0; i < 4; ++i)
#pragma unroll
            for (int j = 0; j < 4; ++j) acc[i][j] = (f32x4){0.f, 0.f, 0.f, 0.f};
        float4 ra[4]; uint4 rb0;
        const bf16_t* wrow = Wt + (size_t)(n0 + br) * K + bk;
#pragma unroll
        for (int i = 0; i < 4; ++i) ra[i] = al(m0 + lr, lk + i * 4);
        rb0 = *(const uint4*)(wrow);
        __syncthreads();
        {
            uint4 w0 = make_uint4(pack2bf(ra[0].x, ra[0].y), pack2bf(ra[0].z, ra[0].w), pack2bf(ra[1].x, ra[1].y), pack2bf(ra[1].z, ra[1].w));
            uint4 w1 = make_uint4(pack2bf(ra[2].x, ra[2].y), pack2bf(ra[2].z, ra[2].w), pack2bf(ra[3].x, ra[3].y), pack2bf(ra[3].z, ra[3].w));
            *(uint4*)(As + lr * LDT + lk) = w0; *(uint4*)(As + lr * LDT + lk + 8) = w1;
            *(uint4*)(Bs + br * LDT + bk) = rb0;
        }
        __syncthreads();
#pragma unroll 1
        for (int ks = 0; ks < nks; ++ks) {
            const int buf = ks & 1;
            if (ks + 1 < nks) {
                const int k1 = (ks + 1) * 32;
#pragma unroll
                for (int i = 0; i < 4; ++i) ra[i] = al(m0 + lr, k1 + lk + i * 4);
                rb0 = *(const uint4*)(wrow + k1);
            }
            const bf16_t* Ab = As + buf * 256 * LDT; const bf16_t* Bb = Bs + buf * 128 * LDT;
            bf16x8 wf[4], af[4];
#pragma unroll
            for (int i = 0; i < 4; ++i) wf[i] = *(const bf16x8*)(Bb + (wn * 64 + i * 16 + (lane & 15)) * LDT + (lane >> 4) * 8);
#pragma unroll
            for (int j = 0; j < 4; ++j) af[j] = *(const bf16x8*)(Ab + (wm * 64 + j * 16 + (lane & 15)) * LDT + (lane >> 4) * 8);
#pragma unroll
            for (int i = 0; i < 4; ++i)
#pragma unroll
                for (int j = 0; j < 4; ++j) acc[i][j] = __builtin_amdgcn_mfma_f32_16x16x32_bf16(wf[i], af[j], acc[i][j], 0, 0, 0);
            if (ks + 1 < nks) {
                bf16_t* An = As + (buf ^ 1) * 256 * LDT; bf16_t* Bn = Bs + (buf ^ 1) * 128 * LDT;
                uint4 w0 = make_uint4(pack2bf(ra[0].x, ra[0].y), pack2bf(ra[0].z, ra[0].w), pack2bf(ra[1].x, ra[1].y), pack2bf(ra[1].z, ra[1].w));
                uint4 w1 = make_uint4(pack2bf(ra[2].x, ra[2].y), pack2bf(ra[2].z, ra[2].w), pack2bf(ra[3].x, ra[3].y), pack2bf(ra[3].z, ra[3].w));
                *(uint4*)(An + lr * LDT + lk) = w0; *(uint4*)(An + lr * LDT + lk + 8) = w1;
                *(uint4*)(Bn + br * LDT + bk) = rb0;
            }
            __syncthreads();
        }
#pragma unroll
        for (int i = 0; i < 4; ++i) {
            const int n = n0 + wn * 64 + i * 16 + (lane >> 4) * 4;
            if (n < N) {
#pragma unroll
                for (int j = 0; j < 4; ++j) {
                    const int m = m0 + wm * 64 + j * 16 + (lane & 15);
                    ep(m, n, make_float4(acc[i][j][0], acc[i][j][1], acc[i][j][2], acc[i][j][3]));
                }
            }
        }
    }
}

DEV void transpose_convert(const float* __restrict__ W, int K, int N, int Npad, bf16_t* Wt, float* sm) {
    float (*T)[65] = (float (*)[65])sm;
    const int tid = opaque_tid();
    const int kt = K / 64, ntl = Npad / 64;
    for (int tile = blockIdx.x; tile < kt * ntl; tile += gridDim.x) {
        const int k0 = (tile / ntl) * 64, n0 = (tile % ntl) * 64;
        __syncthreads();
#pragma unroll
        for (int i = 0; i < 2; ++i) {
            const int k = (tid >> 4) + 32 * i, n4 = (tid & 15) * 4;
            float4 v = make_float4(0.f, 0.f, 0.f, 0.f);
            if (n0 + n4 < N) v = ld4(W + (size_t)(k0 + k) * N + n0 + n4);
            T[k][n4] = v.x; T[k][n4 + 1] = v.y; T[k][n4 + 2] = v.z; T[k][n4 + 3] = v.w;
        }
        __syncthreads();
        const int n = tid >> 3, kq = (tid & 7) * 8;
        unsigned o[4];
#pragma unroll
        for (int j = 0; j < 4; ++j) o[j] = pack2bf(T[kq + 2 * j][n], T[kq + 2 * j + 1][n]);
        bf16_t* dst = Wt + (size_t)(n0 + n) * K + k0 + kq;
        *(uint4*)dst = make_uint4(o[0], o[1], o[2], o[3]);
    }
}

struct ALmod {
    const float* lat; const float* cx; const float* mv; int b; int s0;
    DEV float4 operator()(int r, int k) const {
        const int s = r + s0;
        const float* src; int j;
        if (s < NCX) { src = cx + ((size_t)(b * NCX + s)) * DM + k; j = 2; }
        else { src = lat + ((size_t)(b * NL + s - NCX)) * DM + k; j = b; }
        float4 a = ld4(src);
        const float* m = mv + j * 3072;
        float4 sh = ld4(m + k), sc = ld4(m + 1024 + k);
        return make_float4(a.x * (1.f + sc.x) + sh.x, a.y * (1.f + sc.y) + sh.y, a.z * (1.f + sc.z) + sh.z, a.w * (1.f + sc.w) + sh.w);
    }
};
struct ALmodAll {
    const float* lat; const float* cx; const float* mv;
    DEV float4 operator()(int rr, int k) const {
        const int b = rr >= TB ? 1 : 0, s = rr - b * TB;
        const float* src; int j;
        if (s < NCX) { src = cx + ((size_t)(b * NCX + s)) * DM + k; j = 2; }
        else { src = lat + ((size_t)(b * NL + s - NCX)) * DM + k; j = b; }
        float4 a = ld4(src);
        const float* m = mv + j * 3072;
        float4 sh = ld4(m + k), sc = ld4(m + 1024 + k);
        return make_float4(a.x * (1.f + sc.x) + sh.x, a.y * (1.f + sc.y) + sh.y, a.z * (1.f + sc.z) + sh.z, a.w * (1.f + sc.w) + sh.w);
    }
};
struct ALmodLat {
    const float* lat; const float* mv;
    DEV float4 operator()(int r, int k) const {
        const int b = r >= NL ? 1 : 0;
        float4 a = ld4(lat + (size_t)r * DM + k);
        const float* m = mv + b * 3072;
        float4 sh = ld4(m + k), sc = ld4(m + 1024 + k);
        return make_float4(a.x * (1.f + sc.x) + sh.x, a.y * (1.f + sc.y) + sh.y, a.z * (1.f + sc.z) + sh.z, a.w * (1.f + sc.w) + sh.w);
    }
};
struct ALplain { const float* A; int lda; DEV float4 operator()(int r, int k) const { return ld4(A + (size_t)r * lda + k); } };
struct ALbf { const bf16_t* A; int lda; DEV float4 operator()(int r, int k) const { const uint2 u = *(const uint2*)(A + (size_t)r * lda + k); return make_float4(bflo(u.x), bfhi(u.x), bflo(u.y), bfhi(u.y)); } };
struct EPstore { float* C; int ldc; DEV void operator()(int r, int c, float4 v) const { st4(C + (size_t)r * ldc + c, v); } };
struct EPstoreBf { bf16_t* C; int ldc; DEV void operator()(int r, int c, float4 v) const { *(uint2*)(C + (size_t)r * ldc + c) = make_uint2(pack2bf(v.x, v.y), pack2bf(v.z, v.w)); } };
struct EPres {
    float* C; int ldc; const float* lat; const float* cx; const float* mv; int b; int s0;
    DEV void operator()(int r, int c, float4 v) const {
        const int s = r + s0;
        const float* src; int j;
        if (s < NCX) { src = cx + ((size_t)(b * NCX + s)) * DM + c; j = 2; }
        else { src = lat + ((size_t)(b * NL + s - NCX)) * DM + c; j = b; }
        float4 x = ld4(src);
        float4 g = ld4(mv + j * 3072 + 2048 + c);
        st4(C + (size_t)r * ldc + c, make_float4(ALPHA * x.x + g.x * v.x, ALPHA * x.y + g.y * v.y, ALPHA * x.z + g.z * v.z, ALPHA * x.w + g.w * v.w));
    }
};
struct EPresLat {
    float* C; const float* lat; const float* mv;
    DEV void operator()(int r, int c, float4 v) const {
        const int b = r >= NL ? 1 : 0;
        float4 x = ld4(lat + (size_t)r * DM + c);
        float4 g = ld4(mv + b * 3072 + 2048 + c);
        st4(C + (size_t)r * DM + c, make_float4(ALPHA * x.x + g.x * v.x, ALPHA * x.y + g.y * v.y, ALPHA * x.z + g.z * v.z, ALPHA * x.w + g.w * v.w));
    }
};

DEV void phase_mod(const Params& p, float* sm) {
    const float* c = p.in[1]; const float* cctx = p.in[3];
    const float* mod_w = p.in[4]; const float* mod_b = p.in[5];
    float* modv = (float*)(p.ws + OFF_MODV);
    float* sil = sm; float* red = sm + 3072;
    const int tid = opaque_tid();
    for (int i = tid; i < 3072; i += NTHR) {
        const int j = i >> 10, k = i & 1023;
        const float v = (j < 2) ? c[j * 1024 + k] : cctx[k];
        sil[i] = silu_f(v);
    }
    __syncthreads();
    for (int unit = blockIdx.x; unit < 192; unit += gridDim.x) {
        const int l = unit / 96, cb = unit % 96;
        const int kg = tid >> 5, col = tid & 31, n = cb * 32 + col;
        const float* w = mod_w + (size_t)l * 1024 * 3072 + n;
        float a0 = 0.f, a1 = 0.f, a2 = 0.f;
        for (int k = kg * 64; k < kg * 64 + 64; ++k) {
            const float wv = w[(size_t)k * 3072];
            a0 += sil[k] * wv; a1 += sil[1024 + k] * wv; a2 += sil[2048 + k] * wv;
        }
        red[(kg * 3 + 0) * 32 + col] = a0; red[(kg * 3 + 1) * 32 + col] = a1; red[(kg * 3 + 2) * 32 + col] = a2;
        __syncthreads();
        if (tid < 96) {
            const int j = tid >> 5, cc = tid & 31, nn = cb * 32 + cc;
            float s = mod_b[l * 3072 + nn];
            for (int g = 0; g < 16; ++g) s += red[(g * 3 + j) * 32 + cc];
            modv[(l * 3 + j) * 3072 + nn] = s;
        }
        __syncthreads();
    }
}

DEV void phase_tables(const Params& p) {
    const float* wq = p.in[33]; const float* wk = p.in[34]; const float* wv = p.in[35];
    const float* gw0 = p.in[36]; const float* gw1 = p.in[38]; const float* gw2 = p.in[40]; const float* gw3 = p.in[42];
    float* gtab = (float*)(p.ws + OFF_GTAB); float* wfold = (float*)(p.ws + OFF_WFOLD);
    const int gt = blockIdx.x * NTHR + opaque_tid(), gn = gridDim.x * NTHR;
    for (int i = gt; i < 512 * 16; i += gn) {
        const int gb = i >> 4, cp = (i >> 2) & 3, c = i & 3;
        float s = 0.f;
#pragma unroll
        for (int d = 0; d < 4; ++d) s += wq[gb * 16 + cp * 4 + d] * wk[gb * 16 + c * 4 + d];
        gtab[i] = s * KSCALE;
    }
    for (int i = gt; i < 4096 * 16; i += gn) {
        const int k = i >> 4, g = i & 15, gm = g >> 2, hd = g & 3;
        const float* wg = gm == 0 ? gw0 : (gm == 1 ? gw1 : (gm == 2 ? gw2 : gw3));
        float s = 0.f;
        if (k < 2048) {
            const int blk = k >> 2, cc = k & 3;
#pragma unroll
            for (int d = 0; d < 4; ++d) s += wq[blk * 16 + cc * 4 + d] * wg[(size_t)(4 * blk + d) * 4 + hd] + wk[blk * 16 + cc * 4 + d] * wg[(size_t)(2048 + 4 * blk + d) * 4 + hd];
        } else {
            const int kk = k - 2048, blk = kk >> 2, cc = kk & 3;
#pragma unroll
            for (int d = 0; d < 4; ++d) s += wv[blk * 16 + cc * 4 + d] * wg[(size_t)(4096 + 4 * blk + d) * 4 + hd];
        }
        wfold[i] = s;
    }
}

#ifdef RWKV_DEBUG
DEV float rw_mix(const bf16_t* P0, int s, int c, const float* __restrict__ mu) {
    const float own = bf2f(P0[(size_t)s * EIN + RW0 + c]);
    const int d = c & 3;
    int ns = -1;
    if (s < NCX) {
        if (d == 0) ns = (s > 0) ? s - 1 : -1;
        else if (d == 1) ns = (s < NCX - 1) ? s + 1 : -1;
    } else {
        const int n = s - NCX, rr = n >> 6, cc = n & 63;
        if (d == 0) ns = (cc > 0) ? s - 1 : -1;
        else if (d == 1) ns = (cc < 63) ? s + 1 : -1;
        else if (d == 2) ns = (rr > 0) ? s - 64 : -1;
        else ns = (rr < 127) ? s + 64 : -1;
    }
    const float nb = (ns >= 0) ? bf2f(P0[(size_t)ns * EIN + RW0 + c]) : 0.f;
    return own + (nb - own) * mu[c];
}

DEV void rwkv_unit(const Params& p, int h, int dir, int rh, float* sm, int lane) {
    asm volatile("" : "+v"(lane));
    const bf16_t* P0 = (const bf16_t*)(p.ws + OFF_P0);
    float* YS = p.out;
    float* BON = (float*)(p.ws + OFF_X1C);
    const float* mu = p.in[15];
    const float* w0 = p.in[dir ? 18 : 16]; const float* ww2 = p.in[dir ? 19 : 17];
    const float* a0 = p.in[dir ? 22 : 20]; const float* wa2 = p.in[dir ? 23 : 21];
    const float* k_k = p.in[24]; const float* k_a = p.in[25]; const float* r_k = p.in[26];
    float* sR = sm; float* sW = sm + 4096; float* sK = sm + 8192; float* sA = sm + 12288; float* sB = sm + 16384; float* sV = sm + 20480;
    const int hc = h * 64 + lane;
    const float w0j = w0[hc], a0j = a0[hc], kkj = k_k[hc], kaj = k_a[hc], rkj = r_k[hc];
    const int row = rh * 32 + (lane & 31), kh0 = (lane >> 5) * 32;
    float* sWW = sm + 24576; float* sWA = sm + 28672;
#pragma unroll 4
    for (int i = 0; i < 64; ++i) { sWW[i * 64 + lane] = ww2[i * 512 + hc]; sWA[i * 64 + lane] = wa2[i * 512 + hc]; }
    float S[32];
#pragma unroll
    for (int k = 0; k < 32; ++k) S[k] = 0.f;
    const int cwl = 2048 + dir * 64, cal = 2176 + dir * 64;
#pragma unroll 1
    for (int cu = 0; cu < TB / 64; ++cu) {
        lds_fence();
#pragma unroll 1
        for (int t = 0; t < 64; ++t) {
            const int s = scan_s(dir, cu * 64 + t);
            sR[t * 64 + lane] = rw_mix(P0, s, h * 64 + lane, mu);
            sK[t * 64 + lane] = rw_mix(P0, s, 512 + h * 64 + lane, mu);
            sV[t * 64 + lane] = rw_mix(P0, s, 1024 + h * 64 + lane, mu);
            sA[t * 64 + lane] = tanhf(rw_mix(P0, s, cwl + lane, mu));
            sB[t * 64 + lane] = rw_mix(P0, s, cal + lane, mu);
        }
        lds_fence();
        {
            const float* wr = sWW + lane; asm volatile("" : "+v"(wr));
            float wc[64];
#pragma unroll
            for (int i = 0; i < 64; ++i) wc[i] = wr[i * 64];
#pragma unroll 1
            for (int t = 0; t < 64; ++t) {
                float accw = w0j;
#pragma unroll
                for (int i4 = 0; i4 < 16; ++i4) {
                    const float4 x = ld4(&sA[t * 64 + i4 * 4]);
                    accw += x.x * wc[i4 * 4] + x.y * wc[i4 * 4 + 1] + x.z * wc[i4 * 4 + 2] + x.w * wc[i4 * 4 + 3];
                }
                sW[t * 64 + lane] = expf(-0.6065306597f * sigmoid_f(accw));
            }
        }
        lds_fence();
        {
            const float* ar = sWA + lane; asm volatile("" : "+v"(ar));
            float ac[64];
#pragma unroll
            for (int i = 0; i < 64; ++i) ac[i] = ar[i * 64];
#pragma unroll 1
            for (int t = 0; t < 64; ++t) {
                float acca = a0j;
#pragma unroll
                for (int i4 = 0; i4 < 16; ++i4) {
                    const float4 y = ld4(&sB[t * 64 + i4 * 4]);
                    acca += y.x * ac[i4 * 4] + y.y * ac[i4 * 4 + 1] + y.z * ac[i4 * 4 + 2] + y.w * ac[i4 * 4 + 3];
                }
                const float av = sigmoid_f(acca);
                const float kraw = sK[t * 64 + lane];
                const float kkv = kraw * kkj;
                const float ss = wave_sum(kkv * kkv);
                const float kk = kkv * rsqrtf(fmaxf(ss, 1e-24f));
                const float kh = kraw * (1.f + (av - 1.f) * kaj);
                const float r = sR[t * 64 + lane];
                const float bon = wave_sum(r * kh * rkj);
                lds_fence();
                sK[t * 64 + lane] = kh; sA[t * 64 + lane] = -kk; sB[t * 64 + lane] = kk * av;
                if (lane == 0 && rh == 0) { const int s = scan_s(dir, cu * 64 + t); atomicAdd(&BON[s * 8 + h], bon); }
            }
        }
        lds_fence();
        if (cu == 0 && dir == 0 && rh == 0) {
            float* DBO = p.out + 9000000;
            for (int t = 0; t < 64; ++t) { float* d = DBO + ((size_t)(h * 64 + t) * 64 + lane) * 6; d[0] = sW[t * 64 + lane]; d[1] = sK[t * 64 + lane]; d[2] = sA[t * 64 + lane]; d[3] = sB[t * 64 + lane]; d[4] = sR[t * 64 + lane]; d[5] = sV[t * 64 + lane]; }
        }
#pragma unroll 1
        for (int t = 0; t < 64; ++t) {
            const float vi = sV[t * 64 + row];
            float sa = 0.f;
#pragma unroll
            for (int k4 = 0; k4 < 8; ++k4) {
                const float4 a4 = ld4(&sA[t * 64 + kh0 + k4 * 4]);
                sa += S[k4 * 4] * a4.x + S[k4 * 4 + 1] * a4.y + S[k4 * 4 + 2] * a4.z + S[k4 * 4 + 3] * a4.w;
            }
            sa += __shfl_xor(sa, 32, 64);
            float y = 0.f;
#pragma unroll
            for (int k4 = 0; k4 < 8; ++k4) {
                const float4 w4 = ld4(&sW[t * 64 + kh0 + k4 * 4]);
                const float4 b4 = ld4(&sB[t * 64 + kh0 + k4 * 4]);
                const float4 h4 = ld4(&sK[t * 64 + kh0 + k4 * 4]);
                const float4 r4 = ld4(&sR[t * 64 + kh0 + k4 * 4]);
                S[k4 * 4 + 0] = S[k4 * 4 + 0] * w4.x + sa * b4.x + vi * h4.x;
                S[k4 * 4 + 1] = S[k4 * 4 + 1] * w4.y + sa * b4.y + vi * h4.y;
                S[k4 * 4 + 2] = S[k4 * 4 + 2] * w4.z + sa * b4.z + vi * h4.z;
                S[k4 * 4 + 3] = S[k4 * 4 + 3] * w4.w + sa * b4.w + vi * h4.w;
                y += S[k4 * 4] * r4.x + S[k4 * 4 + 1] * r4.y + S[k4 * 4 + 2] * r4.z + S[k4 * 4 + 3] * r4.w;
            }
            y += __shfl_xor(y, 32, 64);
            if (lane < 32) { const int s = scan_s(dir, cu * 64 + t); atomicAdd(&YS[(size_t)s * 1024 + 512 + h * 64 + row], y); }
        }
    }
}

#endif
DEV void gla_decay(const bf16_t* P0, int c, int h, int dir, const float* __restrict__ wa2, const float* __restrict__ ba,
                   float* sLR, float* sWA, float* sBC, float* sTot, int tid) {
    for (int i = tid; i < 1024; i += NTHR) { const int t = i >> 4, j = i & 15; sLR[i] = bf2f(P0[(size_t)(c * 64 + t) * EIN + 1536 + dir * 16 + j]); }
    for (int i = tid; i < 1024; i += NTHR) { const int ii = i >> 6, k = i & 63; sWA[i] = wa2[ii * 256 + h * 64 + k]; }
    __syncthreads();
    {
        const int t = tid >> 3, k0 = (tid & 7) * 8;
        float acc[8];
#pragma unroll
        for (int j = 0; j < 8; ++j) acc[j] = ba[h * 64 + k0 + j];
#pragma unroll
        for (int ii = 0; ii < 16; ++ii) {
            const float l = sLR[t * 16 + ii];
#pragma unroll
            for (int j = 0; j < 8; ++j) acc[j] += l * sWA[ii * 64 + k0 + j];
        }
#pragma unroll
        for (int j = 0; j < 8; ++j) sBC[t * 65 + k0 + j] = logsig_f(acc[j]) * 0.0625f;
    }
    __syncthreads();
    if (tid < 64) {
        float run = 0.f;
        for (int step = 0; step < 64; ++step) { const int t = dir ? 63 - step : step; run += sBC[t * 65 + tid]; sBC[t * 65 + tid] = run; }
        sTot[tid] = run;
    }
    __syncthreads();
}
DEV bf16x8 tr_frag(const bf16_t* base, int ld, int row0, int col0, int lane) {
    const bf16_t* ptr = base + (row0 + (lane >> 4) * 8 + ((lane & 15) >> 2)) * ld + col0 + (lane & 3) * 4;
    const s16x4 lo = __builtin_amdgcn_ds_read_tr16_b64_v4i16((__attribute__((address_space(3))) s16x4*)ptr);
    const s16x4 hi = __builtin_amdgcn_ds_read_tr16_b64_v4i16((__attribute__((address_space(3))) s16x4*)(ptr + 4 * ld));
    return (bf16x8){lo[0], lo[1], lo[2], lo[3], hi[0], hi[1], hi[2], hi[3]};
}
DEV bf16x8 row_frag(const bf16_t* base, int ld, int idx0, int k0, int lane) {
    return *(const bf16x8*)(base + (idx0 + (lane & 15)) * ld + k0 + (lane >> 4) * 8);
}

DEV void gla1_unit(const Params& p, int h, int dir, int c, float* sm) {
    const int tid = opaque_tid(), lane = tid & 63, wave = tid >> 6;
    const bf16_t* P0 = (const bf16_t*)(p.ws + OFF_P0);
    float* GDS = (float*)(p.ws + OFF_GDS); float* GDEC = (float*)(p.ws + OFF_GDEC);
    const float* wa2 = p.in[dir ? 12 : 10]; const float* ba = p.in[dir ? 13 : 11];
    float* sLR = sm; float* sWA = sm + 1024; float* sBC = sm + 2048; float* sTot = sm + 6208;
    bf16_t* kT = (bf16_t*)(sm + 6272);
    bf16_t* Vs = (bf16_t*)(sm + 8576);
    const int ch = h * 2 + dir;
    __syncthreads();
    gla_decay(P0, c, h, dir, wa2, ba, sLR, sWA, sBC, sTot, tid);
    {
        const int t = tid >> 3, k0 = (tid & 7) * 8;
        float kv[8]; unpack8(*(const uint4*)(P0 + (size_t)(c * 64 + t) * EIN + 256 + h * 64 + k0), kv);
#pragma unroll
        for (int j = 0; j < 8; ++j) kT[(k0 + j) * 72 + t] = __builtin_bit_cast(unsigned short, (__bf16)(kv[j] * expf(sTot[k0 + j] - sBC[t * 65 + k0 + j])));
#pragma unroll
        for (int u = 0; u < 2; ++u) { const int i = tid + 512 * u, row = i >> 4, c16 = i & 15; *(uint4*)(Vs + row * 136 + c16 * 8) = *(const uint4*)(P0 + (size_t)(c * 64 + row) * EIN + 512 + h * 128 + c16 * 8); }
    }
    __syncthreads();
    {
        f32x4 acc[4];
#pragma unroll
        for (int kt = 0; kt < 4; ++kt) acc[kt] = (f32x4){0.f, 0.f, 0.f, 0.f};
#pragma unroll
        for (int ks = 0; ks < 2; ++ks) {
            const bf16x8 af = tr_frag(Vs, 136, ks * 32, wave * 16, lane);
#pragma unroll
            for (int kt = 0; kt < 4; ++kt) acc[kt] = __builtin_amdgcn_mfma_f32_16x16x32_bf16(af, row_frag(kT, 72, kt * 16, ks * 32, lane), acc[kt], 0, 0, 0);
        }
#pragma unroll
        for (int kt = 0; kt < 4; ++kt) {
            const int k = kt * 16 + (lane & 15), v = wave * 16 + (lane >> 4) * 4;
            st4(GDS + ((size_t)(ch * NCH + c) * 64 + k) * 128 + v, make_float4(acc[kt][0], acc[kt][1], acc[kt][2], acc[kt][3]));
        }
    }
    if (tid < 64) GDEC[(size_t)(ch * NCH + c) * 64 + tid] = expf(sTot[tid]);
}

DEV void gla2_unit(const Params& p, int unit) {
    const int tid = opaque_tid();
    float* GDS = (float*)(p.ws + OFF_GDS); const float* GDEC = (const float*)(p.ws + OFF_GDEC);
    const int ch = unit >> 4, e = (unit & 15) * 512 + tid, k = e >> 7, dir = ch & 1;
    float S = 0.f;
#pragma unroll 4
    for (int step = 0; step < NCH; ++step) {
        const int c = chunk_at(dir, step);
        float* gp = GDS + (size_t)(ch * NCH + c) * 8192 + e;
        const float d = GDEC[(size_t)(ch * NCH + c) * 64 + k], inc = *gp;
        *gp = S;
        S = d * S + inc;
    }
}

DEV void gla3_unit(const Params& p, int h, int c, float* sm) {
    const int tid = opaque_tid(), lane = tid & 63, wave = tid >> 6;
    const bf16_t* P0 = (const bf16_t*)(p.ws + OFF_P0);
    const float* GDS = (const float*)(p.ws + OFF_GDS);
    bf16_t* YC = (bf16_t*)(p.ws + OFF_YC);
    const float* ng = p.in[14];
    float* sLR = sm; float* sWA = sm + 1024; float* sBC = sm + 2048; float* sTot = sm + 6208;
    bf16_t* qt = (bf16_t*)(sm + 6272);
    bf16_t* kt = (bf16_t*)(sm + 8576);
    bf16_t* Sm = (bf16_t*)(sm + 10880);
    bf16_t* S0s = (bf16_t*)(sm + 13184);
    bf16_t* Vs = (bf16_t*)(sm + 17536);
    float* O = sm + 21888;
    const int ti = wave & 3, vt0 = (wave >> 2) * 4;
    f32x4 acc[4];
#pragma unroll
    for (int j = 0; j < 4; ++j) acc[j] = (f32x4){0.f, 0.f, 0.f, 0.f};
    __syncthreads();
#pragma unroll
    for (int u = 0; u < 2; ++u) { const int i = tid + 512 * u, row = i >> 4, c16 = i & 15; *(uint4*)(Vs + row * 136 + c16 * 8) = *(const uint4*)(P0 + (size_t)(c * 64 + row) * EIN + 512 + h * 128 + c16 * 8); }
#pragma unroll 1
    for (int dir = 0; dir < 2; ++dir) {
        const float* wa2 = p.in[dir ? 12 : 10]; const float* ba = p.in[dir ? 13 : 11];
        const int ch = h * 2 + dir;
        __syncthreads();
        gla_decay(P0, c, h, dir, wa2, ba, sLR, sWA, sBC, sTot, tid);
        {
            const int t = tid >> 3, k0 = (tid & 7) * 8;
            float qv[8], kv[8];
            unpack8(*(const uint4*)(P0 + (size_t)(c * 64 + t) * EIN + h * 64 + k0), qv);
            unpack8(*(const uint4*)(P0 + (size_t)(c * 64 + t) * EIN + 256 + h * 64 + k0), kv);
#pragma unroll
            for (int j = 0; j < 8; ++j) { const float bc = sBC[t * 65 + k0 + j]; qv[j] *= 0.125f * expf(bc); kv[j] *= expf(-bc); }
            *(uint4*)(qt + t * 72 + k0) = make_uint4(pack2bf(qv[0], qv[1]), pack2bf(qv[2], qv[3]), pack2bf(qv[4], qv[5]), pack2bf(qv[6], qv[7]));
            *(uint4*)(kt + t * 72 + k0) = make_uint4(pack2bf(kv[0], kv[1]), pack2bf(kv[2], kv[3]), pack2bf(kv[4], kv[5]), pack2bf(kv[6], kv[7]));
#pragma unroll
            for (int u = 0; u < 4; ++u) {
                const int i = tid + 512 * u, k = i >> 5, v4 = (i & 31) * 4;
                const float4 s4 = ld4(GDS + (size_t)(ch * NCH + c) * 8192 + k * 128 + v4);
                *(uint2*)(S0s + k * 136 + v4) = make_uint2(pack2bf(s4.x, s4.y), pack2bf(s4.z, s4.w));
            }
        }
        __syncthreads();
        {
            const int si = wave & 3;
#pragma unroll
            for (int jj = 0; jj < 2; ++jj) {
                const int t2 = (wave >> 2) * 2 + jj;
                f32x4 a = (f32x4){0.f, 0.f, 0.f, 0.f};
#pragma unroll
                for (int ks = 0; ks < 2; ++ks) a = __builtin_amdgcn_mfma_f32_16x16x32_bf16(row_frag(kt, 72, si * 16, ks * 32, lane), row_frag(qt, 72, t2 * 16, ks * 32, lane), a, 0, 0, 0);
                const int t = t2 * 16 + (lane & 15), s0 = si * 16 + (lane >> 4) * 4;
                float m[4];
#pragma unroll
                for (int r = 0; r < 4; ++r) { const bool keep = dir ? (s0 + r >= t) : (s0 + r <= t); m[r] = keep ? a[r] : 0.f; }
                *(uint2*)(Sm + t * 72 + s0) = make_uint2(pack2bf(m[0], m[1]), pack2bf(m[2], m[3]));
            }
        }
        __syncthreads();
#pragma unroll
        for (int ks = 0; ks < 2; ++ks) {
            const bf16x8 a1 = row_frag(qt, 72, ti * 16, ks * 32, lane), a2 = row_frag(Sm, 72, ti * 16, ks * 32, lane);
#pragma unroll
            for (int j = 0; j < 4; ++j) {
                acc[j] = __builtin_amdgcn_mfma_f32_16x16x32_bf16(a1, tr_frag(S0s, 136, ks * 32, (vt0 + j) * 16, lane), acc[j], 0, 0, 0);
                acc[j] = __builtin_amdgcn_mfma_f32_16x16x32_bf16(a2, tr_frag(Vs, 136, ks * 32, (vt0 + j) * 16, lane), acc[j], 0, 0, 0);
            }
        }
    }
#pragma unroll
    for (int j = 0; j < 4; ++j)
#pragma unroll
        for (int r = 0; r < 4; ++r) O[(ti * 16 + (lane >> 4) * 4 + r) * 132 + (vt0 + j) * 16 + (lane & 15)] = acc[j][r];
    __syncthreads();
    {
        const int t = tid >> 3, v0 = (tid & 7) * 16;
        float o[16];
        float ss = 0.f;
#pragma unroll
        for (int i = 0; i < 16; ++i) { o[i] = O[t * 132 + v0 + i]; ss += o[i] * o[i]; }
        ss += __shfl_xor(ss, 1, 64); ss += __shfl_xor(ss, 2, 64); ss += __shfl_xor(ss, 4, 64);
        const float rms = rsqrtf(ss * (1.f / 128.f) + 1e-5f);
        float g[16];
        const bf16_t* gp = P0 + (size_t)(c * 64 + t) * EIN + 1024 + h * 128 + v0;
        unpack8(*(const uint4*)gp, g); unpack8(*(const uint4*)(gp + 8), g + 8);
        float y[16];
#pragma unroll
        for (int i = 0; i < 16; ++i) y[i] = o[i] * rms * ng[v0 + i] * silu_f(g[i]);
        bf16_t* yp = YC + (size_t)(c * 64 + t) * 1024 + h * 128 + v0;
        *(uint4*)yp = make_uint4(pack2bf(y[0], y[1]), pack2bf(y[2], y[3]), pack2bf(y[4], y[5]), pack2bf(y[6], y[7]));
        *(uint4*)(yp + 8) = make_uint4(pack2bf(y[8], y[9]), pack2bf(y[10], y[11]), pack2bf(y[12], y[13]), pack2bf(y[14], y[15]));
    }
}

DEV void load8bf(const bf16_t* ptr, float* f) { unpack8(*(const uint4*)ptr, f); }
DEV void rw_mix8(const bf16_t* P0, int s, int cb, const float* __restrict__ mu, float* out) {
    float own[8]; load8bf(P0 + (size_t)s * EIN + RW0 + cb, own);
    int nL = -1, nR = -1, nU = -1, nD = -1;
    if (s < NCX) { if (s > 0) nL = s - 1; if (s < NCX - 1) nR = s + 1; }
    else { const int n = s - NCX, rr = n >> 6, cc = n & 63; if (cc > 0) nL = s - 1; if (cc < 63) nR = s + 1; if (rr > 0) nU = s - 64; if (rr < 127) nD = s + 64; }
    float fL[8], fR[8], fU[8], fD[8];
#pragma unroll
    for (int i = 0; i < 8; ++i) { fL[i] = 0.f; fR[i] = 0.f; fU[i] = 0.f; fD[i] = 0.f; }
    if (nL >= 0) load8bf(P0 + (size_t)nL * EIN + RW0 + cb, fL);
    if (nR >= 0) load8bf(P0 + (size_t)nR * EIN + RW0 + cb, fR);
    if (nU >= 0) load8bf(P0 + (size_t)nU * EIN + RW0 + cb, fU);
    if (nD >= 0) load8bf(P0 + (size_t)nD * EIN + RW0 + cb, fD);
    const float4 m0 = ld4(mu + cb), m1 = ld4(mu + cb + 4);
    const float m[8] = {m0.x, m0.y, m0.z, m0.w, m1.x, m1.y, m1.z, m1.w};
#pragma unroll
    for (int i = 0; i < 8; ++i) { const float nb = (i & 3) == 0 ? fL[i] : ((i & 3) == 1 ? fR[i] : ((i & 3) == 2 ? fU[i] : fD[i])); out[i] = own[i] + (nb - own[i]) * m[i]; }
}
DEV uint4 pack8(const float* f) { return make_uint4(pack2bf(f[0], f[1]), pack2bf(f[2], f[3]), pack2bf(f[4], f[5]), pack2bf(f[6], f[7])); }

template <int XM, int YM, class F>
DEV void mm64(const bf16_t* X, const bf16_t* Y, F f, int lane, int wave) {
#pragma unroll
    for (int q = 0; q < 2; ++q) {
        const int idx = wave * 2 + q, ti = idx >> 2, tj = idx & 3;
        f32x4 acc = (f32x4){0.f, 0.f, 0.f, 0.f};
#pragma unroll
        for (int ks = 0; ks < 2; ++ks) {
            const bf16x8 a = XM == 0 ? row_frag(X, 72, ti * 16, ks * 32, lane) : tr_frag(X, 72, ks * 32, ti * 16, lane);
            const bf16x8 bq = YM == 0 ? row_frag(Y, 72, tj * 16, ks * 32, lane) : tr_frag(Y, 72, ks * 32, tj * 16, lane);
            acc = __builtin_amdgcn_mfma_f32_16x16x32_bf16(a, bq, acc, 0, 0, 0);
        }
        f(ti * 16 + (lane >> 4) * 4, tj * 16 + (lane & 15), acc);
    }
}
template <int XM, int YM, class F>
DEV void mm64x2(const bf16_t* X1, const bf16_t* Y1, const bf16_t* X2, const bf16_t* Y2, F f, int lane, int wave) {
#pragma unroll
    for (int q = 0; q < 2; ++q) {
        const int idx = wave * 2 + q, ti = idx >> 2, tj = idx & 3;
        f32x4 acc = (f32x4){0.f, 0.f, 0.f, 0.f};
#pragma unroll
        for (int ks = 0; ks < 2; ++ks) {
            const bf16x8 a = XM == 0 ? row_frag(X1, 72, ti * 16, ks * 32, lane) : tr_frag(X1, 72, ks * 32, ti * 16, lane);
            const bf16x8 bq = YM == 0 ? row_frag(Y1, 72, tj * 16, ks * 32, lane) : tr_frag(Y1, 72, ks * 32, tj * 16, lane);
            acc = __builtin_amdgcn_mfma_f32_16x16x32_bf16(a, bq, acc, 0, 0, 0);
            const bf16x8 a2 = XM == 0 ? row_frag(X2, 72, ti * 16, ks * 32, lane) : tr_frag(X2, 72, ks * 32, ti * 16, lane);
            const bf16x8 b2 = YM == 0 ? row_frag(Y2, 72, tj * 16, ks * 32, lane) : tr_frag(Y2, 72, ks * 32, tj * 16, lane);
            acc = __builtin_amdgcn_mfma_f32_16x16x32_bf16(a2, b2, acc, 0, 0, 0);
        }
        f(ti * 16 + (lane >> 4) * 4, tj * 16 + (lane & 15), acc);
    }
}
DEV void st_img(bf16_t* P, int i0, int j, float a0, float a1, float a2, float a3) {
    P[(i0 + 0) * 72 + j] = __builtin_bit_cast(unsigned short, (__bf16)a0); P[(i0 + 1) * 72 + j] = __builtin_bit_cast(unsigned short, (__bf16)a1);
    P[(i0 + 2) * 72 + j] = __builtin_bit_cast(unsigned short, (__bf16)a2); P[(i0 + 3) * 72 + j] = __builtin_bit_cast(unsigned short, (__bf16)a3);
}

DEV void rwkv1_unit(const Params& p, int h, int dir, int c, float* sm) {
    const int tid = opaque_tid(), lane = tid & 63, wave = tid >> 6;
    const bf16_t* P0 = (const bf16_t*)(p.ws + OFF_P0);
    bf16_t* RU = (bf16_t*)(p.ws + OFF_RU) + (size_t)((h * 2 + dir) * NCH + c) * 16384;
    float* BONS = (float*)(p.ws + OFF_BONS);
    const float* mu = p.in[15];
    const float* w0 = p.in[dir ? 18 : 16]; const float* ww2 = p.in[dir ? 19 : 17];
    const float* a0 = p.in[dir ? 22 : 20]; const float* wa2 = p.in[dir ? 23 : 21];
    bf16_t* img = (bf16_t*)sm;
#define SLOT(i_) (img + (i_) * 4608)
    float* fLW = (float*)SLOT(10);
    float* fAS = (float*)SLOT(12);
    float* sv = (float*)SLOT(14);
    const int t = tid >> 3, j0 = (tid & 7) * 8, s = c * 64 + t;
    __syncthreads();
    if (tid < 64) { const int hc = h * 64 + tid; sv[64 + tid] = w0[hc]; sv[128 + tid] = a0[hc]; sv[192 + tid] = p.in[24][hc]; sv[256 + tid] = p.in[25][hc]; sv[320 + tid] = p.in[26][hc]; }
    float r8[8], k8[8], v8[8];
    {
        float x8[8];
        rw_mix8(P0, s, h * 64 + j0, mu, r8);
        rw_mix8(P0, s, 512 + h * 64 + j0, mu, k8);
        rw_mix8(P0, s, 1024 + h * 64 + j0, mu, v8);
        rw_mix8(P0, s, 2048 + dir * 64 + j0, mu, x8);
#pragma unroll
        for (int i = 0; i < 8; ++i) x8[i] = tanhf(x8[i]);
        *(uint4*)(SLOT(6) + t * 72 + j0) = pack8(x8);
        rw_mix8(P0, s, 2176 + dir * 64 + j0, mu, x8);
        *(uint4*)(SLOT(7) + t * 72 + j0) = pack8(x8);
        float wq[8];
        { const float4 q0 = ld4(ww2 + (size_t)t * 512 + h * 64 + j0), q1 = ld4(ww2 + (size_t)t * 512 + h * 64 + j0 + 4); wq[0] = q0.x; wq[1] = q0.y; wq[2] = q0.z; wq[3] = q0.w; wq[4] = q1.x; wq[5] = q1.y; wq[6] = q1.z; wq[7] = q1.w; }
        *(uint4*)(SLOT(8) + t * 72 + j0) = pack8(wq);
        { const float4 q0 = ld4(wa2 + (size_t)t * 512 + h * 64 + j0), q1 = ld4(wa2 + (size_t)t * 512 + h * 64 + j0 + 4); wq[0] = q0.x; wq[1] = q0.y; wq[2] = q0.z; wq[3] = q0.w; wq[4] = q1.x; wq[5] = q1.y; wq[6] = q1.z; wq[7] = q1.w; }
        *(uint4*)(SLOT(9) + t * 72 + j0) = pack8(wq);
    }
    __syncthreads();
    mm64<0, 1>(SLOT(6), SLOT(8), [=](int i0, int j, f32x4 a) {
#pragma unroll
        for (int r = 0; r < 4; ++r) fLW[(i0 + r) * 65 + j] = -0.6065306597f * sigmoid_f(sv[64 + j] + a[r]); }, lane, wave);
    mm64<0, 1>(SLOT(7), SLOT(9), [=](int i0, int j, f32x4 a) {
#pragma unroll
        for (int r = 0; r < 4; ++r) fAS[(i0 + r) * 65 + j] = sigmoid_f(sv[128 + j] + a[r]); }, lane, wave);
    __syncthreads();
    if (tid < 64) {
        float run = 0.f;
        for (int step = 0; step < 64; ++step) { const int tt = dir ? 63 - step : step; run += fLW[tt * 65 + tid]; fLW[tt * 65 + tid] = run; }
        sv[tid] = run;
    }
    __syncthreads();
    {
        float kkv[8], ss = 0.f;
#pragma unroll
        for (int i = 0; i < 8; ++i) { kkv[i] = k8[i] * sv[192 + j0 + i]; ss += kkv[i] * kkv[i]; }
        ss += __shfl_xor(ss, 1, 64); ss += __shfl_xor(ss, 2, 64); ss += __shfl_xor(ss, 4, 64);
        const float rn = rsqrtf(fmaxf(ss, 1e-24f));
        float fa[8], fb[8], fk[8], fr[8], fbp[8], fkp[8], bon = 0.f;
        const int tp = dir ? t + 1 : t - 1;
        const bool hasp = dir ? (t < 63) : (t > 0);
#pragma unroll
        for (int i = 0; i < 8; ++i) {
            const int k = j0 + i;
            const float Bt = fLW[t * 65 + k], Bx = hasp ? fLW[tp * 65 + k] : 0.f, asg = fAS[t * 65 + k];
            const float kk = kkv[i] * rn, kh = k8[i] * (1.f + (asg - 1.f) * sv[256 + k]);
            bon += r8[i] * kh * sv[320 + k];
            const float enB = expf(-Bt), eLB = expf(sv[k] - Bt), bv = kk * asg;
            fa[i] = -kk * expf(Bx); fb[i] = bv * enB; fk[i] = kh * enB; fr[i] = r8[i] * expf(Bt); fbp[i] = bv * eLB; fkp[i] = kh * eLB;
        }
#ifdef RWKV_DEBUG
        if (c == 0 && dir == 0) {
            float* DBN = p.out + 9000000 + 8 * 64 * 64 * 6;
#pragma unroll
            for (int i = 0; i < 8; ++i) {
                const int k = j0 + i;
                const float Bt = fLW[t * 65 + k], Bx = hasp ? fLW[tp * 65 + k] : 0.f, asg = fAS[t * 65 + k];
                const float kk = kkv[i] * rn, kh = k8[i] * (1.f + (asg - 1.f) * sv[256 + k]);
                float* d = DBN + ((size_t)(h * 64 + t) * 64 + k) * 6;
                d[0] = expf(Bt - Bx); d[1] = kh; d[2] = -kk; d[3] = kk * asg; d[4] = r8[i]; d[5] = v8[i];
            }
        }
#endif
        bon += __shfl_xor(bon, 1, 64); bon += __shfl_xor(bon, 2, 64); bon += __shfl_xor(bon, 4, 64);
        if ((tid & 7) == 0) BONS[((size_t)dir * TB + s) * 8 + h] = bon;
        *(uint4*)(SLOT(0) + t * 72 + j0) = pack8(fa); *(uint4*)(SLOT(1) + t * 72 + j0) = pack8(fb); *(uint4*)(SLOT(2) + t * 72 + j0) = pack8(fk);
        *(uint4*)(SLOT(3) + t * 72 + j0) = pack8(fr); *(uint4*)(SLOT(4) + t * 72 + j0) = pack8(fbp); *(uint4*)(SLOT(5) + t * 72 + j0) = pack8(fkp);
    }
    __syncthreads();
    *(uint4*)(SLOT(6) + t * 72 + j0) = pack8(v8);
    __syncthreads();
    mm64<0, 0>(SLOT(0), SLOT(1), [=](int i0, int j, f32x4 a) {
        float m[4];
#pragma unroll
        for (int r = 0; r < 4; ++r) { const bool keep = dir ? (j > i0 + r) : (j < i0 + r); m[r] = keep ? a[r] : 0.f; }
        const bool dg = (i0 >> 4) == (j >> 4);
        st_img(SLOT(7), i0, j, dg ? m[0] : 0.f, dg ? m[1] : 0.f, dg ? m[2] : 0.f, dg ? m[3] : 0.f);
        st_img(SLOT(8), i0, j, (dg ? m[0] : 0.f) + (j == i0 ? 1.f : 0.f), (dg ? m[1] : 0.f) + (j == i0 + 1 ? 1.f : 0.f), (dg ? m[2] : 0.f) + (j == i0 + 2 ? 1.f : 0.f), (dg ? m[3] : 0.f) + (j == i0 + 3 ? 1.f : 0.f));
        st_img(SLOT(12), i0, j, dg ? 0.f : m[0], dg ? 0.f : m[1], dg ? 0.f : m[2], dg ? 0.f : m[3]); }, lane, wave);
    mm64<0, 0>(SLOT(0), SLOT(2), [=](int i0, int j, f32x4 a) {
        float m[4];
#pragma unroll
        for (int r = 0; r < 4; ++r) { const bool keep = dir ? (j > i0 + r) : (j < i0 + r); m[r] = keep ? a[r] : 0.f; }
        st_img(SLOT(9), i0, j, m[0], m[1], m[2], m[3]); }, lane, wave);
    mm64<0, 0>(SLOT(3), SLOT(1), [=](int i0, int j, f32x4 a) {
        float m[4];
#pragma unroll
        for (int r = 0; r < 4; ++r) { const bool keep = dir ? (j >= i0 + r) : (j <= i0 + r); m[r] = keep ? a[r] : 0.f; }
        st_img(SLOT(10), i0, j, m[0], m[1], m[2], m[3]); }, lane, wave);
    mm64<0, 0>(SLOT(3), SLOT(2), [=](int i0, int j, f32x4 a) {
        float m[4];
#pragma unroll
        for (int r = 0; r < 4; ++r) { const bool keep = dir ? (j >= i0 + r) : (j <= i0 + r); m[r] = keep ? a[r] : 0.f; }
        st_img(SLOT(11), i0, j, m[0], m[1], m[2], m[3]); }, lane, wave);
    __syncthreads();
    {
        bf16_t* Pc = SLOT(7); bf16_t* Pn = SLOT(1); bf16_t* Tc = SLOT(8); bf16_t* Tn = SLOT(2);
#pragma unroll 1
        for (int it = 0; it < 3; ++it) {
            mm64<0, 1>(Pc, Pc, [=](int i0, int j, f32x4 a) { st_img(Pn, i0, j, a[0], a[1], a[2], a[3]); }, lane, wave);
            __syncthreads();
            mm64<0, 1>(Tc, Pn, [=](int i0, int j, f32x4 a) {
                st_img(Tn, i0, j, a[0] + bf2f(Tc[(i0 + 0) * 72 + j]), a[1] + bf2f(Tc[(i0 + 1) * 72 + j]), a[2] + bf2f(Tc[(i0 + 2) * 72 + j]), a[3] + bf2f(Tc[(i0 + 3) * 72 + j])); }, lane, wave);
            __syncthreads();
            bf16_t* tmp = Pc; Pc = Pn; Pn = tmp; tmp = Tc; Tc = Tn; Tn = tmp;
        }
    }
    mm64<0, 1>(SLOT(2), SLOT(12), [=](int i0, int j, f32x4 a) { st_img(SLOT(7), i0, j, a[0], a[1], a[2], a[3]); }, lane, wave);
    mm64<0, 1>(SLOT(2), SLOT(0), [=](int i0, int j, f32x4 a) { st_img(SLOT(1), i0, j, a[0], a[1], a[2], a[3]); }, lane, wave);
    mm64<0, 1>(SLOT(9), SLOT(6), [=](int i0, int j, f32x4 a) { st_img(SLOT(13), i0, j, a[0], a[1], a[2], a[3]); }, lane, wave);
    __syncthreads();
    mm64<0, 1>(SLOT(2), SLOT(13), [=](int i0, int j, f32x4 a) { st_img(SLOT(8), i0, j, a[0], a[1], a[2], a[3]); }, lane, wave);
    __syncthreads();
    {
        const bf16_t* Zp = (wave < 4) ? SLOT(1) : SLOT(8);
        bf16_t* Xi = (wave < 4) ? SLOT(12) : SLOT(9);
        const int ct = (wave & 3) * 16, g4 = (lane >> 4) * 4, l15 = lane & 15;
#pragma unroll
        for (int bs = 0; bs < 4; ++bs) {
            const int bi = dir ? 3 - bs : bs;
            f32x4 acc;
#pragma unroll
            for (int r = 0; r < 4; ++r) acc[r] = bf2f(Zp[(bi * 16 + g4 + r) * 72 + ct + l15]);
            const bool k0 = dir ? (bi == 0) : (bi >= 1), k1 = dir ? (bi <= 2) : (bi == 3);
            if (k0) acc = __builtin_amdgcn_mfma_f32_16x16x32_bf16(row_frag(SLOT(7), 72, bi * 16, 0, lane), tr_frag(Xi, 72, 0, ct, lane), acc, 0, 0, 0);
            if (k1) acc = __builtin_amdgcn_mfma_f32_16x16x32_bf16(row_frag(SLOT(7), 72, bi * 16, 32, lane), tr_frag(Xi, 72, 32, ct, lane), acc, 0, 0, 0);
            st_img(Xi, bi * 16 + g4, ct + l15, acc[0], acc[1], acc[2], acc[3]);
            __syncthreads();
        }
    }
    mm64<1, 1>(SLOT(12), SLOT(4), [=](int i0, int j, f32x4 a) {
        float m[4];
#pragma unroll
        for (int r = 0; r < 4; ++r) m[r] = a[r] + ((i0 + r) == j ? expf(sv[j]) : 0.f);
        *(uint2*)(RU + j * 64 + i0) = make_uint2(pack2bf(m[0], m[1]), pack2bf(m[2], m[3])); }, lane, wave);
    mm64x2<1, 1>(SLOT(4), SLOT(9), SLOT(5), SLOT(6), [=](int i0, int j, f32x4 a) {
        *(uint2*)(RU + 4096 + j * 64 + i0) = make_uint2(pack2bf(a[0], a[1]), pack2bf(a[2], a[3])); }, lane, wave);
    mm64<1, 0>(SLOT(12), SLOT(10), [=](int i0, int j, f32x4 a) {
        const uint2 rr = *(const uint2*)(SLOT(3) + j * 72 + i0);
        *(uint2*)(RU + 8192 + j * 64 + i0) = make_uint2(pack2bf(a[0] + bflo(rr.x), a[1] + bfhi(rr.x)), pack2bf(a[2] + bflo(rr.y), a[3] + bfhi(rr.y))); }, lane, wave);
    mm64x2<0, 1>(SLOT(10), SLOT(9), SLOT(11), SLOT(6), [=](int i0, int j, f32x4 a) {
        *(uint2*)(RU + 12288 + j * 64 + i0) = make_uint2(pack2bf(a[0], a[1]), pack2bf(a[2], a[3])); }, lane, wave);
#undef SLOT
}

DEV void rwkv2_unit(const Params& p, int chain, int vblk, int lane) {
    asm volatile("" : "+v"(lane));
    const bf16_t* RU = (const bf16_t*)(p.ws + OFF_RU);
    bf16_t* S0G = (bf16_t*)(p.ws + OFF_RS0);
    const int dir = chain & 1, g = lane >> 4, l15 = lane & 15;
    f32x4 st[4];
#pragma unroll
    for (int i = 0; i < 4; ++i) st[i] = (f32x4){0.f, 0.f, 0.f, 0.f};
    uint2 na[4][2][2], nc[4];
    {
        const bf16_t* U = RU + (size_t)(chain * NCH + chunk_at(dir, 0)) * 16384;
#pragma unroll
        for (int i = 0; i < 4; ++i) {
            nc[i] = *(const uint2*)(U + 4096 + (vblk * 16 + l15) * 64 + i * 16 + g * 4);
#pragma unroll
            for (int ks = 0; ks < 2; ++ks) { na[i][ks][0] = *(const uint2*)(U + (i * 16 + l15) * 64 + ks * 32 + g * 4); na[i][ks][1] = *(const uint2*)(U + (i * 16 + l15) * 64 + ks * 32 + 16 + g * 4); }
        }
    }
#pragma unroll 1
    for (int step = 0; step < NCH; ++step) {
        const int c = chunk_at(dir, step);
        uint2 ca[4][2][2], cc[4];
#pragma unroll
        for (int i = 0; i < 4; ++i) { cc[i] = nc[i]; ca[i][0][0] = na[i][0][0]; ca[i][0][1] = na[i][0][1]; ca[i][1][0] = na[i][1][0]; ca[i][1][1] = na[i][1][1]; }
        {
            const int cn = chunk_at(dir, step + 1 < NCH ? step + 1 : step);
            const bf16_t* U = RU + (size_t)(chain * NCH + cn) * 16384;
#pragma unroll
            for (int i = 0; i < 4; ++i) {
                nc[i] = *(const uint2*)(U + 4096 + (vblk * 16 + l15) * 64 + i * 16 + g * 4);
#pragma unroll
                for (int ks = 0; ks < 2; ++ks) { na[i][ks][0] = *(const uint2*)(U + (i * 16 + l15) * 64 + ks * 32 + g * 4); na[i][ks][1] = *(const uint2*)(U + (i * 16 + l15) * 64 + ks * 32 + 16 + g * 4); }
            }
        }
        unsigned pk[4][2];
#pragma unroll
        for (int i = 0; i < 4; ++i) { pk[i][0] = pack2bf(st[i][0], st[i][1]); pk[i][1] = pack2bf(st[i][2], st[i][3]); }
        bf16_t* sp = S0G + ((size_t)(chain * NCH + c) * 64 + vblk * 16 + l15) * 64 + g * 4;
#pragma unroll
        for (int i = 0; i < 4; ++i) *(uint2*)(sp + i * 16) = make_uint2(pk[i][0], pk[i][1]);
        bf16x8 bfr[2];
#pragma unroll
        for (int ks = 0; ks < 2; ++ks) { const uint4 u = make_uint4(pk[2 * ks][0], pk[2 * ks][1], pk[2 * ks + 1][0], pk[2 * ks + 1][1]); bfr[ks] = __builtin_bit_cast(bf16x8, u); }
#pragma unroll
        for (int i = 0; i < 4; ++i) {
            f32x4 acc = (f32x4){bflo(cc[i].x), bfhi(cc[i].x), bflo(cc[i].y), bfhi(cc[i].y)};
#pragma unroll
            for (int ks = 0; ks < 2; ++ks) {
                const uint4 u = make_uint4(ca[i][ks][0].x, ca[i][ks][0].y, ca[i][ks][1].x, ca[i][ks][1].y);
                acc = __builtin_amdgcn_mfma_f32_16x16x32_bf16(__builtin_bit_cast(bf16x8, u), bfr[ks], acc, 0, 0, 0);
            }
            st[i] = acc;
        }
    }
}

DEV void rwkv3_unit(const Params& p, int h, int c, float* sm, bool dbg_on = false) {
    const int tid = opaque_tid(), lane = tid & 63, wave = tid >> 6;
    const bf16_t* P0 = (const bf16_t*)(p.ws + OFF_P0);
    const bf16_t* RUb = (const bf16_t*)(p.ws + OFF_RU);
    const bf16_t* S0G = (const bf16_t*)(p.ws + OFF_RS0);
    const float* BONS = (const float*)(p.ws + OFF_BONS);
    bf16_t* YC = (bf16_t*)(p.ws + OFF_YC);
    const float* mu = p.in[15]; const float* gn_g = p.in[27]; const float* gn_b = p.in[28];
    bf16_t* img = (bf16_t*)sm;
    float* O = sm + 4 * 2304;
#ifdef RWKV_DEBUG
    float* Od = O + 64 * 68;
#endif
    __syncthreads();
    {
        const int row = tid >> 3, c8 = (tid & 7) * 8;
#pragma unroll
        for (int dir = 0; dir < 2; ++dir) {
            const size_t u = (size_t)((h * 2 + dir) * NCH + c);
            *(uint4*)(img + dir * 4608 + row * 72 + c8) = *(const uint4*)(RUb + u * 16384 + 8192 + row * 64 + c8);
            *(uint4*)(img + (2 + dir) * 4608 + row * 72 + c8) = *(const uint4*)(S0G + u * 4096 + row * 64 + c8);
        }
    }
    __syncthreads();
#pragma unroll
    for (int q = 0; q < 2; ++q) {
        const int idx = wave * 2 + q, ti = idx >> 2, tj = idx & 3;
        f32x4 accd[2];
#pragma unroll
        for (int dir = 0; dir < 2; ++dir) {
            f32x4 acc = (f32x4){0.f, 0.f, 0.f, 0.f};
#pragma unroll
            for (int ks = 0; ks < 2; ++ks) acc = __builtin_amdgcn_mfma_f32_16x16x32_bf16(row_frag(img + dir * 4608, 72, ti * 16, ks * 32, lane), row_frag(img + (2 + dir) * 4608, 72, tj * 16, ks * 32, lane), acc, 0, 0, 0);
            const uint2 yl = *(const uint2*)(RUb + (size_t)((h * 2 + dir) * NCH + c) * 16384 + 12288 + (tj * 16 + (lane & 15)) * 64 + ti * 16 + (lane >> 4) * 4);
            acc[0] += bflo(yl.x); acc[1] += bfhi(yl.x); acc[2] += bflo(yl.y); acc[3] += bfhi(yl.y);
            accd[dir] = acc;
        }
#pragma unroll
        for (int r = 0; r < 4; ++r) {
            const int oi = (ti * 16 + (lane >> 4) * 4 + r) * 68 + tj * 16 + (lane & 15);
            O[oi] = accd[0][r] + accd[1][r];
#ifdef RWKV_DEBUG
            Od[oi] = ((DBG_DIRMASK & 1) ? accd[0][r] : 0.f) + ((DBG_DIRMASK & 2) ? accd[1][r] : 0.f);
#endif
        }
    }
    __syncthreads();
    {
        const int t = tid >> 3, v0 = (tid & 7) * 8, s = c * 64 + t;
        float y[8], sum = 0.f;
#pragma unroll
        for (int i = 0; i < 8; ++i) { y[i] = O[t * 68 + v0 + i]; sum += y[i]; }
#ifdef RWKV_DEBUG
        if (dbg_on && c >= DBG_CMIN && c < DBG_CMAX) {
            float num = 0.f, den = 0.f;
#pragma unroll
            for (int i = 0; i < 8; ++i) {
                if (DBG_MODE == 1) { const float o = p.out[(size_t)s * 1024 + 512 + h * 64 + v0 + i]; const float yd = DBG_SELFTEST ? 1.05f * o : Od[t * 68 + v0 + i]; num += (yd - o) * (yd - o); den += o * o; }
                else { const float* dold = p.out + 9000000 + ((size_t)(h * 64 + t) * 64 + v0 + i) * 6; const float* dn = dold + 8 * 64 * 64 * 6;
                       for (int q = 1; q < 6; ++q) { const float o = dold[q], n = dn[q]; num += (n - o) * (n - o); den += o * o; } }
            }
            num = wave_sum(num); den = wave_sum(den);
            if (lane == 0) { atomicAdd((unsigned long long*)(p.ws + OFF_X1C + 2200000), (unsigned long long)(fminf(num, 1e12f) * 1048576.f)); atomicAdd((unsigned long long*)(p.ws + OFF_X1C + 2200008), (unsigned long long)(fminf(den, 1e12f) * 1048576.f)); }
        }
#endif
        sum += __shfl_xor(sum, 1, 64); sum += __shfl_xor(sum, 2, 64); sum += __shfl_xor(sum, 4, 64);
        const float mean = sum * (1.f / 64.f);
        float sq = 0.f;
#pragma unroll
        for (int i = 0; i < 8; ++i) { y[i] -= mean; sq += y[i] * y[i]; }
        sq += __shfl_xor(sq, 1, 64); sq += __shfl_xor(sq, 2, 64); sq += __shfl_xor(sq, 4, 64);
        const float rstd = rsqrtf(sq * (1.f / 64.f) + 64e-5f);
        float vm[8], gm[8];
        rw_mix8(P0, s, 1024 + h * 64 + v0, mu, vm);
        rw_mix8(P0, s, 1536 + h * 64 + v0, mu, gm);
        const float bon = BONS[(size_t)s * 8 + h] + BONS[((size_t)TB + s) * 8 + h];
        float o[8];
#pragma unroll
        for (int i = 0; i < 8; ++i) o[i] = (y[i] * rstd * gn_g[h * 64 + v0 + i] + gn_b[h * 64 + v0 + i] + bon * vm[i]) * silu_f(gm[i]);
        *(uint4*)(YC + (size_t)s * 1024 + 512 + h * 64 + v0) = pack8(o);
    }
}

DEV void ln_rows(const float* src, int nrows, const float* __restrict__ g, const float* __restrict__ bt, float* dst_lat, float* dst_cx, int ncx) {
    const int tid_ = opaque_tid(); const int lane = tid_ & 63, gw = blockIdx.x * NWV + (tid_ >> 6), ngw = gridDim.x * NWV;
    for (int r = gw; r < nrows; r += ngw) {
        const float* x = src + (size_t)r * 1024;
        float4 v[4];
        float sum = 0.f;
#pragma unroll
        for (int i = 0; i < 4; ++i) { v[i] = ld4(x + i * 256 + lane * 4); sum += v[i].x + v[i].y + v[i].z + v[i].w; }
        const float mean = wave_sum(sum) * (1.f / 1024.f);
        float sq = 0.f;
#pragma unroll
        for (int i = 0; i < 4; ++i) {
            v[i].x -= mean; v[i].y -= mean; v[i].z -= mean; v[i].w -= mean;
            sq += v[i].x * v[i].x + v[i].y * v[i].y + v[i].z * v[i].z + v[i].w * v[i].w;
        }
        const float rstd = rsqrtf(wave_sum(sq) * (1.f / 1024.f) + 1e-5f);
        float* d = (r < ncx) ? (dst_cx + (size_t)r * 1024) : (dst_lat + (size_t)(r - ncx) * 1024);
#pragma unroll
        for (int i = 0; i < 4; ++i) {
            const int c = i * 256 + lane * 4;
            const float4 gg = ld4(g + c), bb = ld4(bt + c);
            st4(d + c, make_float4(v[i].x * rstd * gg.x + bb.x, v[i].y * rstd * gg.y + bb.y, v[i].z * rstd * gg.z + bb.z, v[i].w * rstd * gg.w + bb.w));
        }
    }
}

DEV void zero_f4(float* ptr, size_t nfloat) {
    const size_t n4 = nfloat / 4;
    for (size_t i = (size_t)blockIdx.x * NTHR + opaque_tid(); i < n4; i += (size_t)gridDim.x * NTHR) ((float4*)ptr)[i] = make_float4(0.f, 0.f, 0.f, 0.f);
}

DEV void chain_ids(int& chain, int& sub) {
    const int bid = blockIdx.x, xcd = bid & 7, idx = bid >> 3;
    chain = xcd * 2 + (idx >> 4); sub = idx & 15;
}

DEV void phase_conv1(const Params& p, float* sm) {
    const bf16_t* XM = (const bf16_t*)(p.ws + OFF_XM);
    bf16_t* XC = (bf16_t*)(p.ws + OFF_XC);
    float* G16 = (float*)(p.ws + OFF_G16);
    const float* cw = p.in[31]; const float* cbias = p.in[32];
    const float* wfold = (const float*)(p.ws + OFF_WFOLD);
    float* wl = sm;
    const int tid = opaque_tid(), t = tid >> 3, cg = tid & 7;
    for (int ci = blockIdx.x; ci < NB * NCH; ci += gridDim.x) {
        const int b = ci / NCH, c = ci % NCH, s = c * 64 + t;
        const size_t rowbase = (size_t)b * TB;
        int nrow[9];
#pragma unroll
        for (int i = 0; i < 3; ++i)
#pragma unroll
            for (int j = 0; j < 3; ++j) {
                int ns = -1;
                if (s < NCX) { const int w2 = s + j - 1; if (i == 1 && w2 >= 0 && w2 < NCX) ns = w2; }
                else { const int n = s - NCX, rr = (n >> 6) + i - 1, w2 = (n & 63) + j - 1; if (rr >= 0 && rr < 128 && w2 >= 0 && w2 < 64) ns = NCX + rr * 64 + w2; }
                nrow[i * 3 + j] = ns;
            }
        float ga[16];
#pragma unroll
        for (int g = 0; g < 16; ++g) ga[g] = 0.f;
#pragma unroll 1
        for (int cb = 0; cb < 32; ++cb) {
            __syncthreads();
            { const int part = tid >> 8, idx = tid & 255; st4(wl + part * 1024 + idx * 4, ld4(wfold + ((size_t)(part * 2048 + cb * 64)) * 16 + idx * 4)); }
            __syncthreads();
            const int c0 = cb * 64 + cg * 8;
            float a8[8], xm8[8];
            { const float4 b0 = ld4(cbias + c0), b1 = ld4(cbias + c0 + 4); a8[0] = b0.x; a8[1] = b0.y; a8[2] = b0.z; a8[3] = b0.w; a8[4] = b1.x; a8[5] = b1.y; a8[6] = b1.z; a8[7] = b1.w; }
#pragma unroll
            for (int i = 0; i < 8; ++i) xm8[i] = 0.f;
#pragma unroll
            for (int tap = 0; tap < 9; ++tap) {
                if (nrow[tap] >= 0) {
                    const uint4 xv = *(const uint4*)(XM + (rowbase + nrow[tap]) * 2048 + c0);
                    float x8[8]; unpack8(xv, x8);
                    const float4 w0 = ld4(cw + tap * 2048 + c0), w1 = ld4(cw + tap * 2048 + c0 + 4);
                    a8[0] += x8[0] * w0.x; a8[1] += x8[1] * w0.y; a8[2] += x8[2] * w0.z; a8[3] += x8[3] * w0.w;
                    a8[4] += x8[4] * w1.x; a8[5] += x8[5] * w1.y; a8[6] += x8[6] * w1.z; a8[7] += x8[7] * w1.w;
                    if (tap == 4) {
#pragma unroll
                        for (int i = 0; i < 8; ++i) xm8[i] = x8[i];
                    }
                }
            }
            float xc8[8];
#pragma unroll
            for (int i = 0; i < 8; ++i) xc8[i] = silu_f(a8[i]);
            *(uint4*)(XC + (rowbase + s) * 2048 + c0) = make_uint4(pack2bf(xc8[0], xc8[1]), pack2bf(xc8[2], xc8[3]), pack2bf(xc8[4], xc8[5]), pack2bf(xc8[6], xc8[7]));
#pragma unroll
            for (int i = 0; i < 8; ++i) {
                const float* wxc = wl + (cg * 8 + i) * 16; const float* wxm = wl + 1024 + (cg * 8 + i) * 16;
#pragma unroll
                for (int q = 0; q < 4; ++q) {
                    const float4 a = ld4(wxc + q * 4), bq = ld4(wxm + q * 4);
                    ga[q * 4 + 0] += xc8[i] * a.x + xm8[i] * bq.x; ga[q * 4 + 1] += xc8[i] * a.y + xm8[i] * bq.y;
                    ga[q * 4 + 2] += xc8[i] * a.z + xm8[i] * bq.z; ga[q * 4 + 3] += xc8[i] * a.w + xm8[i] * bq.w;
                }
            }
        }
#pragma unroll
        for (int g = 0; g < 16; ++g) { ga[g] += __shfl_xor(ga[g], 1, 64); ga[g] += __shfl_xor(ga[g], 2, 64); ga[g] += __shfl_xor(ga[g], 4, 64); }
        if (cg == 0) {
            const float4 bi_f = ld4(p.in[37]), bf_f = ld4(p.in[39]), bi_b = ld4(p.in[41]), bf_b = ld4(p.in[43]);
            float* gp = G16 + (rowbase + s) * 16;
            st4(gp, make_float4(ga[0] + bi_f.x, ga[1] + bi_f.y, ga[2] + bi_f.z, ga[3] + bi_f.w));
            st4(gp + 4, make_float4(logsig_f(ga[4] + bf_f.x), logsig_f(ga[5] + bf_f.y), logsig_f(ga[6] + bf_f.z), logsig_f(ga[7] + bf_f.w)));
            st4(gp + 8, make_float4(ga[8] + bi_b.x, ga[9] + bi_b.y, ga[10] + bi_b.z, ga[11] + bi_b.w));
            st4(gp + 12, make_float4(logsig_f(ga[12] + bf_b.x), logsig_f(ga[13] + bf_b.y), logsig_f(ga[14] + bf_b.z), logsig_f(ga[15] + bf_b.w)));
        }
    }
}

DEV float wave_scan_add(float v, int lane, int dir) {
#pragma unroll
    for (int o = 1; o < 64; o <<= 1) {
        const float n = dir ? __shfl_down(v, o, 64) : __shfl_up(v, o, 64);
        const bool ok = dir ? (lane + o < 64) : (lane >= o);
        if (ok) v += n;
    }
    return v;
}
DEV float wave_scan_max(float v, int lane, int dir) {
#pragma unroll
    for (int o = 1; o < 64; o <<= 1) {
        const float n = dir ? __shfl_down(v, o, 64) : __shfl_up(v, o, 64);
        const bool ok = dir ? (lane + o < 64) : (lane >= o);
        if (ok) v = fmaxf(v, n);
    }
    return v;
}

DEV void phase_x1(const Params& p, float* sm) {
    int chain, sub; chain_ids(chain, sub);
    const int b = chain >> 3, h = (chain >> 1) & 3, dir = chain & 1;
    const bf16_t* XC = (const bf16_t*)(p.ws + OFF_XC);
    const float* G16 = (const float*)(p.ws + OFF_G16);
    float* GSC = (float*)(p.ws + OFF_GSC); float* CSC = (float*)(p.ws + OFF_CSC); float* NBUF = (float*)(p.ws + OFF_NBUF);
    const float* gtab = (const float*)(p.ws + OFF_GTAB);
    bf16_t* SMAT = (bf16_t*)(p.ws + OFF_SMAT);
    const int tid = opaque_tid(), lane = tid & 63, wave = tid >> 6;
    float* sTot = sm; float* sRef = sm + 132; float* sM0 = sm + 264; float* sBeta = sm + 400;
    for (int c = wave; c < NCH; c += NWV) {
        const size_t row = (size_t)b * TB + c * 64 + lane;
        const float gi = G16[row * 16 + dir * 8 + h], lf = G16[row * 16 + dir * 8 + 4 + h];
        const float bc = wave_scan_add(lf, lane, dir);
        const float ref = wave_max(gi - bc), tot = wave_sum(lf);
        if (lane == 0) { sTot[c] = tot; sRef[c] = ref; }
    }
    __syncthreads();
    if (tid == 0) {
        float m0 = -INFINITY;
        for (int step = 0; step < NCH; ++step) {
            const int c = chunk_at(dir, step);
            sM0[c] = m0;
            const float mx = fmaxf(m0, sRef[c]);
            if (sub == 0) { CSC[(chain * NCH + c) * 2] = expf(m0 - mx); CSC[(chain * NCH + c) * 2 + 1] = expf(sRef[c] - mx); }
            m0 = sTot[c] + mx;
        }
    }
    __syncthreads();
    for (int k = wave; sub + 16 * k < NCH; k += NWV) {
        const int c = sub + 16 * k;
        const size_t row = (size_t)b * TB + c * 64 + lane;
        const float gi = G16[row * 16 + dir * 8 + h], lf = G16[row * 16 + dir * 8 + 4 + h];
        const float bc = wave_scan_add(lf, lane, dir);
        const float a = gi - bc;
        const float amax = wave_scan_max(a, lane, dir);
        const float ref = sRef[c], m0 = sM0[c];
        const float mmax = fmaxf(amax, m0);
        const float mt = bc + mmax;
        const float alpha = expf(ref - mmax), beta = expf(a - ref), gg = expf(m0 - mmax), em = expf(-mt);
        st4(GSC + ((size_t)chain * TB + c * 64 + lane) * 4, make_float4(alpha, beta, gg, em));
        sBeta[k * 64 + lane] = beta;
    }
    __syncthreads();
    for (int k = 0; sub + 16 * k < NCH; ++k) {
        const int c = sub + 16 * k;
        const bf16_t* xp = XC + ((size_t)b * TB + c * 64) * 2048 + h * 512 + tid;
        float acc = 0.f;
#pragma unroll 8
        for (int s = 0; s < 64; ++s) acc += sBeta[k * 64 + s] * bf2f(xp[(size_t)s * 2048]);
        NBUF[((size_t)chain * NCH + c) * 512 + tid] = acc;
    }
    bf16_t* XCs = (bf16_t*)sm;
    bf16_t* Qs = XCs + 64 * 520;
    for (int u = blockIdx.x; u < NB * 4 * NCH; u += gridDim.x) {
        const int bh = u / NCH, c = u % NCH, ub = bh >> 2, uh = bh & 3;
        __syncthreads();
#pragma unroll 2
        for (int i = 0; i < 8; ++i) {
            const int pp = tid + 512 * i, row = pp >> 6, c16 = pp & 63;
            const uint4 xv = *(const uint4*)(XC + ((size_t)ub * TB + c * 64 + row) * 2048 + uh * 512 + c16 * 8);
            float f[8]; unpack8(xv, f);
            float q[8];
#pragma unroll
            for (int bb = 0; bb < 2; ++bb) {
                const float* G = gtab + (size_t)(uh * 128 + c16 * 2 + bb) * 16;
                const float4 g0 = ld4(G), g1 = ld4(G + 4), g2 = ld4(G + 8), g3 = ld4(G + 12);
                q[bb * 4 + 0] = f[bb * 4] * g0.x + f[bb * 4 + 1] * g1.x + f[bb * 4 + 2] * g2.x + f[bb * 4 + 3] * g3.x;
                q[bb * 4 + 1] = f[bb * 4] * g0.y + f[bb * 4 + 1] * g1.y + f[bb * 4 + 2] * g2.y + f[bb * 4 + 3] * g3.y;
                q[bb * 4 + 2] = f[bb * 4] * g0.z + f[bb * 4 + 1] * g1.z + f[bb * 4 + 2] * g2.z + f[bb * 4 + 3] * g3.z;
                q[bb * 4 + 3] = f[bb * 4] * g0.w + f[bb * 4 + 1] * g1.w + f[bb * 4 + 2] * g2.w + f[bb * 4 + 3] * g3.w;
            }
            *(uint4*)(XCs + row * 520 + c16 * 8) = xv;
            *(uint4*)(Qs + row * 520 + c16 * 8) = make_uint4(pack2bf(q[0], q[1]), pack2bf(q[2], q[3]), pack2bf(q[4], q[5]), pack2bf(q[6], q[7]));
        }
        __syncthreads();
        const int st = wave & 3, tt0 = (wave >> 2) * 2;
        f32x4 a0 = (f32x4){0.f, 0.f, 0.f, 0.f}, a1 = a0;
        const bf16_t* ap = XCs + (st * 16 + (lane & 15)) * 520 + (lane >> 4) * 8;
        const bf16_t* bp0 = Qs + (tt0 * 16 + (lane & 15)) * 520 + (lane >> 4) * 8;
        const bf16_t* bp1 = bp0 + 16 * 520;
#pragma unroll
        for (int ks = 0; ks < 16; ++ks) {
            const bf16x8 af = *(const bf16x8*)(ap + ks * 32);
            a0 = __builtin_amdgcn_mfma_f32_16x16x32_bf16(af, *(const bf16x8*)(bp0 + ks * 32), a0, 0, 0, 0);
            a1 = __builtin_amdgcn_mfma_f32_16x16x32_bf16(af, *(const bf16x8*)(bp1 + ks * 32), a1, 0, 0, 0);
        }
        bf16_t* sp = SMAT + (size_t)u * 4096 + (size_t)(tt0 * 16 + (lane & 15)) * 64 + st * 16 + (lane >> 4) * 4;
        *(uint2*)sp = make_uint2(pack2bf(a0[0], a0[1]), pack2bf(a0[2], a0[3]));
        *(uint2*)(sp + 16 * 64) = make_uint2(pack2bf(a1[0], a1[1]), pack2bf(a1[2], a1[3]));
    }
}

DEV void phase_x2(const Params& p, float* sm) {
    int chain, sub; chain_ids(chain, sub);
    const int b = chain >> 3, h = (chain >> 1) & 3, dir = chain & 1;
    const bf16_t* XC = (const bf16_t*)(p.ws + OFF_XC);
    float* GSC = (float*)(p.ws + OFF_GSC); const float* CSC = (const float*)(p.ws + OFF_CSC); const float* NBUF = (const float*)(p.ws + OFF_NBUF);
    const float* gtab = (const float*)(p.ws + OFF_GTAB);
    const bf16_t* SMAT = (const bf16_t*)(p.ws + OFF_SMAT);
    const int tid = opaque_tid();
    float* sD0 = sm; float* sCf = sm + 132; float* sN0 = sm + 264; float* sN2 = sN0 + 9 * 512;
    for (int i = tid; i < NCH; i += NTHR) { sD0[i] = CSC[(chain * NCH + i) * 2]; sCf[i] = CSC[(chain * NCH + i) * 2 + 1]; }
    __syncthreads();
    {
        float n = 0.f;
        const float* nb = NBUF + (size_t)chain * NCH * 512 + tid;
#pragma unroll 4
        for (int step = 0; step < NCH; ++step) {
            const int c = chunk_at(dir, step);
            if ((c & 15) == sub) sN0[(c >> 4) * 512 + tid] = n;
            n = sD0[c] * n + sCf[c] * nb[(size_t)c * 512];
        }
    }
    __syncthreads();
    {
        const int blk = tid >> 2, cp = tid & 3;
        const float4 g = ld4(gtab + (size_t)(h * 128 + blk) * 16 + cp * 4);
        for (int k = 0; sub + 16 * k < NCH; ++k) {
            const float* n0 = sN0 + k * 512 + blk * 4;
            sN2[k * 512 + tid] = g.x * n0[0] + g.y * n0[1] + g.z * n0[2] + g.w * n0[3];
        }
    }
    __syncthreads();
    const int t = tid >> 3, part = tid & 7;
    for (int k = 0; sub + 16 * k < NCH; ++k) {
        const int c = sub + 16 * k;
        const size_t row = (size_t)b * TB + c * 64 + t;
        float dint = 0.f;
        {
            const bf16_t* xp = XC + row * 2048 + h * 512 + part * 64;
            const float* n2 = sN2 + k * 512 + part * 64;
#pragma unroll
            for (int i = 0; i < 8; ++i) {
                float f[8]; unpack8(*(const uint4*)(xp + i * 8), f);
                const float4 na = ld4(n2 + i * 8), nb2 = ld4(n2 + i * 8 + 4);
                dint += f[0] * na.x + f[1] * na.y + f[2] * na.z + f[3] * na.w + f[4] * nb2.x + f[5] * nb2.y + f[6] * nb2.z + f[7] * nb2.w;
            }
        }
        float di = 0.f;
        {
            float f[8]; unpack8(*(const uint4*)(SMAT + ((size_t)((b * 4 + h) * NCH + c)) * 4096 + t * 64 + part * 8), f);
#pragma unroll
            for (int e = 0; e < 8; ++e) {
                const int s = part * 8 + e;
                const float beta = GSC[((size_t)chain * TB + c * 64 + s) * 4 + 1];
                const bool keep = dir ? (s >= t) : (s <= t);
                di += keep ? f[e] * beta : 0.f;
            }
        }
        dint += __shfl_xor(dint, 1, 64); dint += __shfl_xor(dint, 2, 64); dint += __shfl_xor(dint, 4, 64);
        di += __shfl_xor(di, 1, 64); di += __shfl_xor(di, 2, 64); di += __shfl_xor(di, 4, 64);
        if (part == 0) {
            float* gp = GSC + ((size_t)chain * TB + c * 64 + t) * 4;
            const float4 g4 = ld4(gp);
            const float den = g4.x * di + g4.z * dint;
            gp[3] = 1.f / fmaxf(fabsf(den), g4.w);
        }
    }
}

#define MLSTM_PREFETCH(step_) do { \
    const int c_ = chunk_at(dir, (step_)); const size_t rb_ = (size_t)b * TB + (size_t)c_ * 64; \
    { const bf16_t* xb_ = XC + (rb_ + (tid >> 6)) * 2048 + h * 512 + (tid & 63) * 8; \
      rx0 = *(const uint4*)(xb_); rx1 = *(const uint4*)(xb_ + 8 * 2048); rx2 = *(const uint4*)(xb_ + 16 * 2048); rx3 = *(const uint4*)(xb_ + 24 * 2048); \
      rx4 = *(const uint4*)(xb_ + 32 * 2048); rx5 = *(const uint4*)(xb_ + 40 * 2048); rx6 = *(const uint4*)(xb_ + 48 * 2048); rx7 = *(const uint4*)(xb_ + 56 * 2048); } \
    rxm = *(const uint2*)(XM + (rb_ + ps) * 2048 + ch0 + pvb * 4); \
    rs = *(const uint4*)(SMAT + ((size_t)((b * 4 + h) * NCH + c_)) * 4096 + ps * 64 + pvb * 8); \
    rbeta = GSC[((size_t)chain * TB + c_ * 64 + ps) * 4 + 1]; \
    if (tid < 64) rsc = ld4(GSC + ((size_t)chain * TB + c_ * 64 + tid) * 4); \
    rd0 = CSC[(chain * NCH + c_) * 2]; rcf = CSC[(chain * NCH + c_) * 2 + 1]; } while (0)

DEV void phase_mlstm(const Params& p, float* sm) {
    int chain, sub; chain_ids(chain, sub);
    const int b = chain >> 3, h = (chain >> 1) & 3, dir = chain & 1;
    const bf16_t* XM = (const bf16_t*)(p.ws + OFF_XM);
    const bf16_t* XC = (const bf16_t*)(p.ws + OFF_XC);
    const bf16_t* SMAT = (const bf16_t*)(p.ws + OFF_SMAT);
    const float* GSC = (const float*)(p.ws + OFF_GSC); const float* CSC = (const float*)(p.ws + OFF_CSC);
    const float* gtab = (const float*)(p.ws + OFF_GTAB);
    bf16_t* H = (bf16_t*)(p.ws + OFF_H);
    const float* wv = p.in[35];
    char* smc = (char*)sm;
    bf16_t* XCs = (bf16_t*)smc;
    bf16_t* Cs = (bf16_t*)(smc + 66560);
    bf16_t* Vb = (bf16_t*)(smc + 66560 + 33280);
    bf16_t* Vw = Vb + 32 * 72;
    bf16_t* Sm = Vw + 32 * 72;
    float* Gs = (float*)(smc + 66560 + 33280 + 2 * 4608 + 9216);
    float* sc = Gs + 2048;
    const int tid = opaque_tid(), lane = tid & 63, wave = tid >> 6;
    for (int i = tid; i < 32 * 520 / 2; i += NTHR) ((unsigned*)Cs)[i] = 0u;
    for (int i = tid; i < 2048; i += NTHR) Gs[i] = gtab[h * 2048 + i];
    const int ps = tid >> 3, pvb = tid & 7;
    const int ch0 = h * 512 + sub * 32;
    float wvr[16];
#pragma unroll
    for (int i = 0; i < 16; ++i) wvr[i] = wv[(size_t)((ch0 >> 2) + pvb) * 16 + i];
    f32x4 accS[4][2];
#pragma unroll
    for (int i = 0; i < 4; ++i) { accS[i][0] = (f32x4){0.f, 0.f, 0.f, 0.f}; accS[i][1] = (f32x4){0.f, 0.f, 0.f, 0.f}; }
    uint4 rx0, rx1, rx2, rx3, rx4, rx5, rx6, rx7; uint2 rxm; uint4 rs; float rbeta; float4 rsc = make_float4(0.f, 0.f, 0.f, 0.f); float rd0, rcf;
    MLSTM_PREFETCH(0);
    __syncthreads();
#pragma unroll 1
    for (int step = 0; step < NCH; ++step) {
        const int c = chunk_at(dir, step);
        const float d0 = rd0, cf = rcf;
        {
            bf16_t* xd = XCs + (tid >> 6) * 520 + (tid & 63) * 8;
            *(uint4*)(xd) = rx0; *(uint4*)(xd + 8 * 520) = rx1; *(uint4*)(xd + 16 * 520) = rx2; *(uint4*)(xd + 24 * 520) = rx3;
            *(uint4*)(xd + 32 * 520) = rx4; *(uint4*)(xd + 40 * 520) = rx5; *(uint4*)(xd + 48 * 520) = rx6; *(uint4*)(xd + 56 * 520) = rx7;
        }
        {
            const float x0 = bflo(rxm.x), x1 = bfhi(rxm.x), x2 = bflo(rxm.y), x3 = bfhi(rxm.y);
#pragma unroll
            for (int d = 0; d < 4; ++d) {
                const float v = (x0 * wvr[d] + x1 * wvr[4 + d] + x2 * wvr[8 + d] + x3 * wvr[12 + d]) * rbeta;
                Vb[(pvb * 4 + d) * 72 + ps] = __builtin_bit_cast(unsigned short, (__bf16)v);
                Vw[(pvb * 4 + d) * 72 + ps] = __builtin_bit_cast(unsigned short, (__bf16)(v * cf));
            }
        }
        {
#define SMASK(q_) (((dir ? (pvb * 8 + 2 * (q_) >= ps) : (pvb * 8 + 2 * (q_) <= ps)) ? 0x0000ffffu : 0u) | ((dir ? (pvb * 8 + 2 * (q_) + 1 >= ps) : (pvb * 8 + 2 * (q_) + 1 <= ps)) ? 0xffff0000u : 0u))
            *(uint4*)(Sm + ps * 72 + pvb * 8) = make_uint4(rs.x & SMASK(0), rs.y & SMASK(1), rs.z & SMASK(2), rs.w & SMASK(3));
#undef SMASK
        }
        if (tid < 64) st4(sc + tid * 4, rsc);
        { const int nstep = (step + 1 < NCH) ? step + 1 : step; MLSTM_PREFETCH(nstep); }
        __syncthreads();
        {
            const int vt = wave & 1, tt = wave >> 1;
            f32x4 ao = (f32x4){0.f, 0.f, 0.f, 0.f}, ai = ao;
            const bf16_t* ap = Cs + (vt * 16 + (lane & 15)) * 520 + (lane >> 4) * 8;
            const bf16_t* bp = XCs + (tt * 16 + (lane & 15)) * 520 + (lane >> 4) * 8;
#pragma unroll
            for (int ks = 0; ks < 16; ++ks) ao = __builtin_amdgcn_mfma_f32_16x16x32_bf16(*(const bf16x8*)(ap + ks * 32), *(const bf16x8*)(bp + ks * 32), ao, 0, 0, 0);
            const bf16_t* ap2 = Vb + (vt * 16 + (lane & 15)) * 72 + (lane >> 4) * 8;
            const bf16_t* bp2 = Sm + (tt * 16 + (lane & 15)) * 72 + (lane >> 4) * 8;
#pragma unroll
            for (int ks = 0; ks < 2; ++ks) ai = __builtin_amdgcn_mfma_f32_16x16x32_bf16(*(const bf16x8*)(ap2 + ks * 32), *(const bf16x8*)(bp2 + ks * 32), ai, 0, 0, 0);
            if (c >= 4) {
                const int t = tt * 16 + (lane & 15);
                const float4 s4 = ld4(sc + t * 4);
                const float h0 = (s4.x * ai[0] + s4.z * ao[0]) * s4.w, h1 = (s4.x * ai[1] + s4.z * ao[1]) * s4.w;
                const float h2 = (s4.x * ai[2] + s4.z * ao[2]) * s4.w, h3 = (s4.x * ai[3] + s4.z * ao[3]) * s4.w;
                bf16_t* hp = H + ((size_t)b * NL + (size_t)c * 64 + t - NCX) * 2048 + ch0 + vt * 16 + (lane >> 4) * 4;
                const unsigned u0 = pack2bf(h0, h1), u1 = pack2bf(h2, h3);
                __builtin_amdgcn_global_atomic_fadd_v2bf16((__attribute__((address_space(1))) s16x2*)hp, __builtin_bit_cast(s16x2, u0));
                __builtin_amdgcn_global_atomic_fadd_v2bf16((__attribute__((address_space(1))) s16x2*)(hp + 2), __builtin_bit_cast(s16x2, u1));
            }
        }
#pragma unroll
        for (int jt = 0; jt < 4; ++jt) { accS[jt][0] *= d0; accS[jt][1] *= d0; }
#pragma unroll
        for (int ks = 0; ks < 2; ++ks) {
            const bf16x8 b0 = *(const bf16x8*)(Vw + (lane & 15) * 72 + ks * 32 + (lane >> 4) * 8);
            const bf16x8 b1 = *(const bf16x8*)(Vw + (16 + (lane & 15)) * 72 + ks * 32 + (lane >> 4) * 8);
            const int row0 = ks * 32 + (lane >> 4) * 8 + ((lane & 15) >> 2);
#pragma unroll
            for (int jt = 0; jt < 4; ++jt) {
                const int col = wave * 64 + jt * 16 + (lane & 3) * 4;
                const s16x4 lo = __builtin_amdgcn_ds_read_tr16_b64_v4i16((__attribute__((address_space(3))) s16x4*)(XCs + row0 * 520 + col));
                const s16x4 hi = __builtin_amdgcn_ds_read_tr16_b64_v4i16((__attribute__((address_space(3))) s16x4*)(XCs + (row0 + 4) * 520 + col));
                const bf16x8 af = (bf16x8){lo[0], lo[1], lo[2], lo[3], hi[0], hi[1], hi[2], hi[3]};
                accS[jt][0] = __builtin_amdgcn_mfma_f32_16x16x32_bf16(af, b0, accS[jt][0], 0, 0, 0);
                accS[jt][1] = __builtin_amdgcn_mfma_f32_16x16x32_bf16(af, b1, accS[jt][1], 0, 0, 0);
            }
        }
        __syncthreads();
#pragma unroll
        for (int jt = 0; jt < 4; ++jt) {
            const int blk = wave * 16 + jt * 4 + (lane >> 4);
            const float4 g0 = ld4(Gs + blk * 16), g1 = ld4(Gs + blk * 16 + 4), g2 = ld4(Gs + blk * 16 + 8), g3 = ld4(Gs + blk * 16 + 12);
#pragma unroll
            for (int v2 = 0; v2 < 2; ++v2) {
                const f32x4 a = accS[jt][v2];
                const float o0 = g0.x * a[0] + g0.y * a[1] + g0.z * a[2] + g0.w * a[3];
                const float o1 = g1.x * a[0] + g1.y * a[1] + g1.z * a[2] + g1.w * a[3];
                const float o2 = g2.x * a[0] + g2.y * a[1] + g2.z * a[2] + g2.w * a[3];
                const float o3 = g3.x * a[0] + g3.y * a[1] + g3.z * a[2] + g3.w * a[3];
                *(uint2*)(Cs + (v2 * 16 + (lane & 15)) * 520 + blk * 4) = make_uint2(pack2bf(o0, o1), pack2bf(o2, o3));
            }
        }
    }
}

DEV void phase_finish1(const Params& p) {
    bf16_t* H = (bf16_t*)(p.ws + OFF_H);
    const bf16_t* XC = (const bf16_t*)(p.ws + OFF_XC);
    const bf16_t* Z = (const bf16_t*)(p.ws + OFF_XM);
    const float* ng = p.in[44]; const float* skip = p.in[45];
    const int tid_ = opaque_tid(); const int lane = tid_ & 63, gw = blockIdx.x * NWV + (tid_ >> 6), ngw = gridDim.x * NWV;
    for (int it = gw; it < NB * NL * 4; it += ngw) {
        const int r = it >> 2, h = it & 3, b = r >= NL ? 1 : 0, nn = r - b * NL;
        const int c0 = h * 512 + lane * 8;
        bf16_t* hp = H + (size_t)r * 2048 + c0;
        float v[8]; unpack8(*(const uint4*)hp, v);
        float sum = 0.f;
#pragma unroll
        for (int j = 0; j < 8; ++j) sum += v[j];
        const float mean = wave_sum(sum) * (1.f / 512.f);
        float sq = 0.f;
#pragma unroll
        for (int j = 0; j < 8; ++j) { v[j] -= mean; sq += v[j] * v[j]; }
        const float rstd = rsqrtf(wave_sum(sq) * (1.f / 512.f) + 1e-5f);
        float xc[8], z[8];
        unpack8(*(const uint4*)(XC + ((size_t)b * TB + NCX + nn) * 2048 + c0), xc);
        unpack8(*(const uint4*)(Z + (size_t)r * 2048 + c0), z);
        float o[8];
#pragma unroll
        for (int j = 0; j < 8; ++j) o[j] = (v[j] * rstd * ng[c0 + j] + skip[c0 + j] * xc[j]) * silu_f(z[j]);
        *(uint4*)hp = make_uint4(pack2bf(o[0], o[1]), pack2bf(o[2], o[3]), pack2bf(o[4], o[5]), pack2bf(o[6], o[7]));
    }
}

__global__ void __launch_bounds__(NTHR) fwd_kernel(Params p) {
    extern __shared__ __attribute__((aligned(16))) float sm[];
    volatile LAS unsigned* xst = (volatile LAS unsigned*)((LAS char*)sm + (LDS_BYTES - 16));
    if (threadIdx.x == 0) { xst[0] = 0u; xst[1] = 0u; }
    __syncthreads();
    const XcdBarrier xbar = xcd_barrier_post((unsigned*)(p.ws + OFF_BAR), xst);
    const int tid = opaque_tid(), lane = tid & 63, wave = tid >> 6;
    float* modv = (float*)(p.ws + OFF_MODV);
    float* X1C = (float*)(p.ws + OFF_X1C);

    phase_mod(p, sm);
    phase_tables(p);
    transpose_convert(p.in[8], 1024, EIN, 3968, (bf16_t*)(p.ws + OFF_WT0), sm);
    transpose_convert(p.in[29], 1024, 4096, 4096, (bf16_t*)(p.ws + OFF_WT1), sm);
    transpose_convert(p.in[9], 1024, 1024, 1024, (bf16_t*)(p.ws + OFF_WT2), sm);
    transpose_convert(p.in[30], 2048, 1024, 1024, (bf16_t*)(p.ws + OFF_WT3), sm);
    xcd_barrier(xbar);

#pragma unroll 1
    for (int b = 0; b < NB; ++b) {
        {
            ALmod al{p.in[0], p.in[2], modv, b, 0};
            EPstoreBf ep{(bf16_t*)(p.ws + OFF_P0), EIN};
            gemm_mfma(TB, EIN, 3968, DM, (const bf16_t*)(p.ws + OFF_WT0), al, ep, sm);
        }
#ifdef RWKV_DEBUG
        if (b == 0) { zero_f4(p.out, (size_t)TB * 1024); zero_f4((float*)(p.ws + OFF_X1C), (size_t)TB * 8); if (blockIdx.x == 0 && tid == 0) { *(unsigned long long*)(p.ws + OFF_X1C + 2200000) = 0ull; *(unsigned long long*)(p.ws + OFF_X1C + 2200008) = 0ull; } }
#endif
        xcd_barrier(xbar);
#ifdef RWKV_DEBUG
        if (b == 0 && blockIdx.x < 32 && wave == 0) { const int u = blockIdx.x; if ((DBG_DIRMASK >> ((u >> 1) & 1)) & 1) rwkv_unit(p, u >> 2, (u >> 1) & 1, u & 1, sm, lane); }
        __syncthreads();
#endif
        for (int u = blockIdx.x; u < 24 * NCH; u += gridDim.x) {
            if (u < 16 * NCH) rwkv1_unit(p, (u / NCH) >> 1, (u / NCH) & 1, u % NCH, sm);
            else { const int v = u - 16 * NCH; gla1_unit(p, (v / NCH) >> 1, (v / NCH) & 1, v % NCH, sm); }
        }
        xcd_barrier(xbar);
        if (blockIdx.x < 128) gla2_unit(p, blockIdx.x);
        else if (blockIdx.x < 192) { if (wave == 0) rwkv2_unit(p, (blockIdx.x - 128) >> 2, (blockIdx.x - 128) & 3, lane); }
        xcd_barrier(xbar);
        for (int u = blockIdx.x; u < 12 * NCH; u += gridDim.x) {
#ifdef RWKV_DEBUG
            if (u < 8 * NCH) rwkv3_unit(p, u / NCH, u % NCH, sm, b == 0);
#else
            if (u < 8 * NCH) rwkv3_unit(p, u / NCH, u % NCH, sm);
#endif
            else { const int v = u - 8 * NCH; gla3_unit(p, v / NCH, v % NCH, sm); }
        }
        xcd_barrier(xbar);
        {
            ALbf al{(const bf16_t*)(p.ws + OFF_YC), 1024};
            EPres ep{(float*)(p.ws + OFF_P0), 1024, p.in[0], p.in[2], modv, b, 0};
            gemm_mfma(TB, DM, DM, DM, (const bf16_t*)(p.ws + OFF_WT2), al, ep, sm);
        }
        xcd_barrier(xbar);
        ln_rows((const float*)(p.ws + OFF_P0), TB, p.in[6], p.in[7], p.out + (size_t)b * NL * DM, X1C + (size_t)b * NCX * DM, NCX);
        xcd_barrier(xbar);
    }

    {
        ALmodAll al{p.out, X1C, modv + 3 * 3072};
        EPstoreBf ep{(bf16_t*)(p.ws + OFF_XM), 2048};
        gemm_mfma(RT, 2048, 2048, DM, (const bf16_t*)(p.ws + OFF_WT1), al, ep, sm);
        zero_f4((float*)(p.ws + OFF_H), (size_t)NB * NL * 1024);
    }
    xcd_barrier(xbar);
    phase_conv1(p, sm);
    xcd_barrier(xbar);
    phase_x1(p, sm);
    xcd_barrier(xbar);
    phase_x2(p, sm);
    xcd_barrier(xbar);
    phase_mlstm(p, sm);
    xcd_barrier(xbar);
    {
        ALmodLat al{p.out, modv + 3 * 3072};
        EPstoreBf ep{(bf16_t*)(p.ws + OFF_XM), 2048};
        gemm_mfma(NB * NL, 2048, 2048, DM, (const bf16_t*)(p.ws + OFF_WT1) + (size_t)2048 * 1024, al, ep, sm);
    }
    xcd_barrier(xbar);
    phase_finish1(p);
    xcd_barrier(xbar);
    {
        ALbf al{(const bf16_t*)(p.ws + OFF_H), 2048};
        EPresLat ep{(float*)(p.ws + OFF_XC), p.out, modv + 3 * 3072};
        gemm_mfma(NB * NL, DM, DM, 2048, (const bf16_t*)(p.ws + OFF_WT3), al, ep, sm);
    }
    xcd_barrier(xbar);
    ln_rows((const float*)(p.ws + OFF_XC), NB * NL, p.in[6] + 1024, p.in[7] + 1024, p.out, p.out, 0);
#ifdef RWKV_DEBUG
    xcd_barrier(xbar);
    {
        const float num = (float)(*(const unsigned long long*)(p.ws + OFF_X1C + 2200000)), den = (float)(*(const unsigned long long*)(p.ws + OFF_X1C + 2200008));
        float dl = (den > 0.f) ? sqrtf(num / den) : 1.f; dl = (dl == dl) ? fminf(dl, 1.f) : 1.f;
        const float sc = 1.f + 10.f * dl;
        for (size_t i = (size_t)blockIdx.x * NTHR + tid; i < (size_t)NB * NL * DM; i += (size_t)gridDim.x * NTHR) p.out[i] *= sc;
    }
#endif
}

extern "C" void kernel_launch(void* const* d_in, const int* in_sizes, int n_in, void* d_out, int out_size, void* d_ws, size_t ws_size, hipStream_t stream) {
    static int grid_blocks = 0;
    if (grid_blocks == 0) {
        if (ws_size < WS_NEED || n_in != 46) { fprintf(stderr, "kernel_launch: bad ws_size %zu (need %zu) or n_in %d\n", ws_size, (size_t)WS_NEED, n_in); grid_blocks = -1; return; }
        int dev = 0, cus = 0, per_cu = 0;
        (void)hipGetDevice(&dev);
        (void)hipDeviceGetAttribute(&cus, hipDeviceAttributeMultiprocessorCount, dev);
        (void)hipFuncSetAttribute((const void*)fwd_kernel, hipFuncAttributeMaxDynamicSharedMemorySize, LDS_BYTES);
        (void)hipOccupancyMaxActiveBlocksPerMultiprocessor(&per_cu, (const void*)fwd_kernel, NTHR, LDS_BYTES);
        if (per_cu < 1 || cus < 256) { fprintf(stderr, "kernel_launch: occupancy query says %d blocks/CU on %d CUs; this kernel needs 256 resident workgroups\n", per_cu, cus); grid_blocks = -1; return; }
        grid_blocks = 256;
    }
    if (grid_blocks < 0) return;
    (void)hipMemsetAsync((char*)d_ws + OFF_BAR, 0, XCD_BAR_WORDS * 4, stream);
    Params p{};
    for (int i = 0; i < 46; ++i) p.in[i] = (const float*)d_in[i];
    p.out = (float*)d_out; p.ws = (char*)d_ws;
    void* args[] = {&p};
    hipError_t e = hipLaunchCooperativeKernel((const void*)fwd_kernel, dim3(grid_blocks), dim3(NTHR), args, LDS_BYTES, stream);
    if (e != hipSuccess) fprintf(stderr, "cooperative launch failed: %s (grid %d)\n", hipGetErrorString(e), grid_blocks);
}
```

```cpp
#include <hip/hip_runtime.h>
#include <hip/hip_cooperative_groups.h>
#include <cstdio>
#include <cmath>
namespace cg = cooperative_groups;

#define DEV __device__ __forceinline__
#define DBG_DIRMASK 3
#define DBG_CMIN 0
#define DBG_CMAX 132
#define DBG_TITERS 5
#define DBG_TSLOT 2
#define DBG_SELFTEST 0
#define DBG_MODE 1

constexpr int NB = 2, NL = 8192, DM = 1024, NCX = 256, TB = NCX + NL;
constexpr int RT = NB * TB;
constexpr int NCH = TB / 64;
constexpr int EIN = 3872, RW0 = 1568;
constexpr int NTHR = 512, NWV = 8;
constexpr float ALPHA = 1.41421356237f;
constexpr float KSCALE = 0.04419417382f;

constexpr size_t OFF_MODV = 0;
constexpr size_t OFF_X1C  = 131072;
constexpr size_t OFF_BAR  = 3145728;
constexpr size_t OFF_BIG  = 4194304;
constexpr size_t OFF_P0   = OFF_BIG;
constexpr size_t OFF_YC   = OFF_BIG + (size_t)TB * EIN * 2;
constexpr size_t OFF_GDS  = OFF_YC + (size_t)TB * 1024 * 2;
constexpr size_t OFF_GDEC = OFF_GDS + (size_t)8 * NCH * 8192 * 4;
constexpr size_t OFF_RU   = OFF_GDEC + (size_t)8 * NCH * 64 * 4;
constexpr size_t OFF_RS0  = OFF_RU + (size_t)16 * NCH * 16384 * 2;
constexpr size_t OFF_BONS = OFF_RS0 + (size_t)16 * NCH * 4096 * 2;
constexpr size_t L0_END   = OFF_BONS + (size_t)2 * TB * 8 * 4;
constexpr size_t OFF_XM   = OFF_BIG;
constexpr size_t OFF_XC   = OFF_XM + (size_t)RT * 2048 * 2;
constexpr size_t OFF_H    = OFF_XC + (size_t)RT * 2048 * 2;
constexpr size_t OFF_WT0  = OFF_H + (size_t)NB * NL * 2048 * 2;
constexpr size_t OFF_WT1  = OFF_WT0 + (size_t)3968 * 1024 * 2;
constexpr size_t OFF_WT2  = OFF_WT1 + (size_t)4096 * 1024 * 2;
constexpr size_t OFF_WT3  = OFF_WT2 + (size_t)1024 * 1024 * 2;
constexpr size_t OFF_G16  = OFF_WT3 + (size_t)1024 * 2048 * 2;
constexpr size_t OFF_SMAT = OFF_G16 + (size_t)RT * 16 * 4;
constexpr size_t OFF_GSC  = OFF_SMAT + (size_t)NB * 4 * NCH * 4096 * 2;
constexpr size_t OFF_CSC  = OFF_GSC + (size_t)16 * TB * 4 * 4;
constexpr size_t OFF_NBUF = OFF_CSC + (size_t)16 * NCH * 2 * 4;
constexpr size_t OFF_GTAB = OFF_NBUF + (size_t)16 * NCH * 512 * 4;
constexpr size_t OFF_WFT  = OFF_GTAB + (size_t)4 * 128 * 16 * 4;
constexpr size_t OFF_G16P = OFF_WFT + (size_t)16 * 4096 * 2;
constexpr size_t WS_NEED  = OFF_G16P + (size_t)4 * RT * 16 * 4;

static_assert(L0_END <= OFF_WT0, "layer-0 buffers overlap the weight copies");
constexpr int LDS_BYTES = 139264;

struct Params { const float* in[46]; float* out; char* ws; };
typedef unsigned short bf16_t;
typedef __attribute__((ext_vector_type(8))) short bf16x8;
typedef __attribute__((ext_vector_type(4))) short s16x4;
typedef __attribute__((ext_vector_type(2))) short s16x2;
typedef __attribute__((ext_vector_type(4))) float f32x4;
typedef __attribute__((ext_vector_type(2))) __bf16 bf2_t;
DEV unsigned pack2bf(float lo, float hi) { bf2_t v; v[0] = (__bf16)lo; v[1] = (__bf16)hi; return __builtin_bit_cast(unsigned, v); }
DEV float bflo(unsigned u) { return __uint_as_float(u << 16); }
DEV float bfhi(unsigned u) { return __uint_as_float(u & 0xffff0000u); }
DEV float bf2f(bf16_t v) { return __uint_as_float(((unsigned)v) << 16); }
DEV void unpack8(uint4 u, float* f) { f[0] = bflo(u.x); f[1] = bfhi(u.x); f[2] = bflo(u.y); f[3] = bfhi(u.y); f[4] = bflo(u.z); f[5] = bfhi(u.z); f[6] = bflo(u.w); f[7] = bfhi(u.w); }

DEV float wave_sum(float v) {
#pragma unroll
    for (int o = 32; o > 0; o >>= 1) v += __shfl_xor(v, o, 64);
    return v;
}
DEV float wave_max(float v) {
#pragma unroll
    for (int o = 32; o > 0; o >>= 1) v = fmaxf(v, __shfl_xor(v, o, 64));
    return v;
}
DEV float fexp(float x) { return __expf(x); }
DEV float frcp(float x) { return __builtin_amdgcn_rcpf(x); }
DEV float sigmoid_f(float x) { return frcp(1.f + fexp(-x)); }
DEV float silu_f(float x) { return x * frcp(1.f + fexp(-x)); }
DEV float logsig_f(float x) { return fminf(x, 0.f) - __logf(1.f + fexp(-fabsf(x))); }
DEV float tanh_f(float x) { const float e = fexp(2.f * x); return 1.f - 2.f * frcp(e + 1.f); }
DEV void lds_fence() { asm volatile("" ::: "memory"); }
DEV int opaque_tid() { int t = threadIdx.x; asm volatile("" : "+v"(t)); return t; }
DEV int scan_s(int dir, int u) { return dir == 0 ? u : (u < NCX ? (NCX - 1 - u) : (TB - 1 + NCX - u)); }
DEV int chunk_at(int dir, int step) { return dir == 0 ? step : (step < 4 ? 3 - step : (NCH + 3 - step)); }
DEV float4 ld4(const float* p) { return *(const float4*)p; }
DEV void st4(float* p, float4 v) { *(float4*)p = v; }


#define XB_TMO      128
#define XB_XCNT(j)  (256  + 64 * (j))
#define XB_XSUB(j)  (1280 + 64 * (j))
#define XB_XGEN(j)  (2304 + 64 * (j))
#define XB_TOP      3328
#define XB_TOPGEN   3392
#define XCD_BAR_WORDS 3456
#define XB_SPIN_CAP (1u << 22)
#define LAS __attribute__((address_space(3)))
DEV unsigned xb_ld(unsigned* p) { return __hip_atomic_load(p, __ATOMIC_RELAXED, __HIP_MEMORY_SCOPE_AGENT); }
DEV unsigned xb_add(unsigned* p, unsigned v) { return __hip_atomic_fetch_add(p, v, __ATOMIC_RELAXED, __HIP_MEMORY_SCOPE_AGENT); }
DEV unsigned xb_xcc_id() { return (unsigned)__builtin_amdgcn_s_getreg((3 << 11) | 20) & 0xFu; }
#define XB_SPIN(cond, bar) do { unsigned _sp = 0; while (cond) { __builtin_amdgcn_s_sleep(1); \
    if ((++_sp & 255u) == 0u) { if (xb_ld(&(bar)[XB_TMO])) break; if (_sp > XB_SPIN_CAP) { atomicAdd(&(bar)[XB_TMO], 1u); break; } } } } while (0)
struct XcdBarrier { unsigned* bar; unsigned x; volatile LAS unsigned* st; };
DEV XcdBarrier xcd_barrier_post(unsigned* bar, volatile LAS unsigned* st) {
    XcdBarrier b; b.bar = bar; b.x = xb_xcc_id(); b.st = st;
    if (threadIdx.x == 0) (void)xb_add(&bar[XB_XCNT(b.x)], 1u);
    return b;
}
DEV void xcd_barrier_complete(unsigned* bar, unsigned x, unsigned& nloc, unsigned& nx) {
    const unsigned G = gridDim.x * gridDim.y * gridDim.z;
    unsigned sum, cnt, mine, sp = 0u;
    for (;;) {
        sum = 0u; cnt = 0u; mine = 0u;
#pragma unroll
        for (unsigned j = 0; j < 16; ++j) { const unsigned c = xb_ld(&bar[XB_XCNT(j)]); sum += c; cnt += (c > 0u) ? 1u : 0u; mine = (j == x) ? c : mine; }
        if (sum == G) break;
        __builtin_amdgcn_s_sleep(1);
        if ((++sp & 255u) == 0u) { if (xb_ld(&bar[XB_TMO])) break; if (sp > XB_SPIN_CAP) { atomicAdd(&bar[XB_TMO], 1u); break; } }
    }
    nloc = mine > 0u ? mine : 1u; nx = cnt > 0u ? cnt : 1u;
}
DEV void xcd_barrier(const XcdBarrier& b) {
    asm volatile("s_waitcnt vmcnt(0)" ::: "memory");
    __syncthreads();
    if (threadIdx.x == 0) {
        unsigned* bar = b.bar;
        __builtin_amdgcn_s_waitcnt(0);
        unsigned nloc = b.st[0], nx = b.st[1];
        if (nloc == 0u) { xcd_barrier_complete(bar, b.x, nloc, nx); b.st[0] = nloc; b.st[1] = nx; }
        const unsigned old = xb_add(&bar[XB_XSUB(b.x)], 1u);
        const unsigned gen = old / nloc;
        if (old + 1u == (gen + 1u) * nloc) {
            __builtin_amdgcn_fence(__ATOMIC_RELEASE, "agent");
            asm volatile("s_waitcnt vmcnt(0)" ::: "memory");
            const unsigned og = xb_add(&bar[XB_TOP], 1u);
            const unsigned tg = og / nx;
            if (og + 1u == (tg + 1u) * nx) xb_add(&bar[XB_TOPGEN], 1u);
            else XB_SPIN(xb_ld(&bar[XB_TOPGEN]) == tg, bar);
            __builtin_amdgcn_fence(__ATOMIC_ACQUIRE, "agent");
            xb_add(&bar[XB_XGEN(b.x)], 1u);
            asm volatile("s_waitcnt vmcnt(0)" ::: "memory");
        } else {
            XB_SPIN(xb_ld(&bar[XB_XGEN(b.x)]) == gen, bar);
            __builtin_amdgcn_fence(__ATOMIC_ACQUIRE, "agent");
            asm volatile("s_waitcnt vmcnt(0)" ::: "memory");
        }
    }
    __syncthreads();
}

template <class AL, class EP>
DEV void gemm_mfma(int M, int N, int Npad, int K, const bf16_t* Wt, AL al, EP ep, float* smf) {
    constexpr int LDT = 40;
    bf16_t* As = (bf16_t*)smf;
    bf16_t* Bs = As + 2 * 256 * LDT;
    const int tid = opaque_tid(), lane = tid & 63, wave = tid >> 6, wm = wave & 3, wn = wave >> 2;
    const int mt = M / 256, nt = Npad / 128, nks = K / 32;
    const int lr = tid >> 1, lk = (tid & 1) * 16;
    const int br = tid >> 2, bk = (tid & 3) * 8;
    for (int tile = blockIdx.x; tile < mt * nt; tile += gridDim.x) {
        const int tm = tile / nt, tn = tile % nt, m0 = tm * 256, n0 = tn * 128;
        f32x4 acc[4][4];
#pragma unroll
        for (int i = 0; i < 4; ++i)
#pragma unroll
            for (int j = 0; j < 4; ++j) acc[i][j] = (f32x4){0.f, 0.f, 0.f, 0.f};
        float4 ra[4]; uint4 rb0;
        const bf16_t* wrow = Wt + (size_t)(n0 + br) * K + bk;
#pragma unroll
        for (int i = 0; i < 4; ++i) ra[i] = al(m0 + lr, lk + i * 4);
        rb0 = *(const uint4*)(wrow);
        __syncthreads();
        {
            uint4 w0 = make_uint4(pack2bf(ra[0].x, ra[0].y), pack2bf(ra[0].z, ra[0].w), pack2bf(ra[1].x, ra[1].y), pack2bf(ra[1].z, ra[1].w));
            uint4 w1 = make_uint4(pack2bf(ra[2].x, ra[2].y), pack2bf(ra[2].z, ra[2].w), pack2bf(ra[3].x, ra[3].y), pack2bf(ra[3].z, ra[3].w));
            *(uint4*)(As + lr * LDT + lk) = w0; *(uint4*)(As + lr * LDT + lk + 8) = w1;
            *(uint4*)(Bs + br * LDT + bk) = rb0;
        }
        __syncthreads();
#pragma unroll 1
        for (int ks = 0; ks < nks; ++ks) {
            const int buf = ks & 1;
            if (ks + 1 < nks) {
                const int k1 = (ks + 1) * 32;
#pragma unroll
                for (int i = 0; i < 4; ++i) ra[i] = al(m0 + lr, k1 + lk + i * 4);
                rb0 = *(const uint4*)(wrow + k1);
            }
            const bf16_t* Ab = As + buf * 256 * LDT; const bf16_t* Bb = Bs + buf * 128 * LDT;
            bf16x8 wf[4], af[4];
#pragma unroll
            for (int i = 0; i < 4; ++i) wf[i] = *(const bf16x8*)(Bb + (wn * 64 + i * 16 + (lane & 15)) * LDT + (lane >> 4) * 8);
#pragma unroll
            for (int j = 0; j < 4; ++j) af[j] = *(const bf16x8*)(Ab + (wm * 64 + j * 16 + (lane & 15)) * LDT + (lane >> 4) * 8);
#pragma unroll
            for (int i = 0; i < 4; ++i)
#pragma unroll
                for (int j = 0; j < 4; ++j) acc[i][j] = __builtin_amdgcn_mfma_f32_16x16x32_bf16(wf[i], af[j], acc[i][j], 0, 0, 0);
            if (ks + 1 < nks) {
                bf16_t* An = As + (buf ^ 1) * 256 * LDT; bf16_t* Bn = Bs + (buf ^ 1) * 128 * LDT;
                uint4 w0 = make_uint4(pack2bf(ra[0].x, ra[0].y), pack2bf(ra[0].z, ra[0].w), pack2bf(ra[1].x, ra[1].y), pack2bf(ra[1].z, ra[1].w));
                uint4 w1 = make_uint4(pack2bf(ra[2].x, ra[2].y), pack2bf(ra[2].z, ra[2].w), pack2bf(ra[3].x, ra[3].y), pack2bf(ra[3].z, ra[3].w));
                *(uint4*)(An + lr * LDT + lk) = w0; *(uint4*)(An + lr * LDT + lk + 8) = w1;
                *(uint4*)(Bn + br * LDT + bk) = rb0;
            }
            __syncthreads();
        }
#pragma unroll
        for (int i = 0; i < 4; ++i) {
            const int n = n0 + wn * 64 + i * 16 + (lane >> 4) * 4;
            if (n < N) {
#pragma unroll
                for (int j = 0; j < 4; ++j) {
                    const int m = m0 + wm * 64 + j * 16 + (lane & 15);
                    ep(m, n, make_float4(acc[i][j][0], acc[i][j][1], acc[i][j][2], acc[i][j][3]));
                }
            }
        }
    }
}

DEV void transpose_convert(const float* __restrict__ W, int K, int N, int Npad, bf16_t* Wt, float* sm) {
    float (*T)[65] = (float (*)[65])sm;
    const int tid = opaque_tid();
    const int kt = K / 64, ntl = Npad / 64;
    for (int tile = blockIdx.x; tile < kt * ntl; tile += gridDim.x) {
        const int k0 = (tile / ntl) * 64, n0 = (tile % ntl) * 64;
        __syncthreads();
#pragma unroll
        for (int i = 0; i < 2; ++i) {
            const int k = (tid >> 4) + 32 * i, n4 = (tid & 15) * 4;
            float4 v = make_float4(0.f, 0.f, 0.f, 0.f);
            if (n0 + n4 < N) v = ld4(W + (size_t)(k0 + k) * N + n0 + n4);
            T[k][n4] = v.x; T[k][n4 + 1] = v.y; T[k][n4 + 2] = v.z; T[k][n4 + 3] = v.w;
        }
        __syncthreads();
        const int n = tid >> 3, kq = (tid & 7) * 8;
        unsigned o[4];
#pragma unroll
        for (int j = 0; j < 4; ++j) o[j] = pack2bf(T[kq + 2 * j][n], T[kq + 2 * j + 1][n]);
        bf16_t* dst = Wt + (size_t)(n0 + n) * K + k0 + kq;
        *(uint4*)dst = make_uint4(o[0], o[1], o[2], o[3]);
    }
}

struct ALmod {
    const float* lat; const float* cx; const float* mv; int b; int s0;
    DEV float4 operator()(int r, int k) const {
        const int s = r + s0;
        const float* src; int j;
        if (s < NCX) { src = cx + ((size_t)(b * NCX + s)) * DM + k; j = 2; }
        else { src = lat + ((size_t)(b * NL + s - NCX)) * DM + k; j = b; }
        float4 a = ld4(src);
        const float* m = mv + j * 3072;
        float4 sh = ld4(m + k), sc = ld4(m + 1024 + k);
        return make_float4(a.x * (1.f + sc.x) + sh.x, a.y * (1.f + sc.y) + sh.y, a.z * (1.f + sc.z) + sh.z, a.w * (1.f + sc.w) + sh.w);
    }
};
struct ALmodAll {
    const float* lat; const float* cx; const float* mv;
    DEV float4 operator()(int rr, int k) const {
        const int b = rr >= TB ? 1 : 0, s = rr - b * TB;
        const float* src; int j;
        if (s < NCX) { src = cx + ((size_t)(b * NCX + s)) * DM + k; j = 2; }
        else { src = lat + ((size_t)(b * NL + s - NCX)) * DM + k; j = b; }
        float4 a = ld4(src);
        const float* m = mv + j * 3072;
        float4 sh = ld4(m + k), sc = ld4(m + 1024 + k);
        return make_float4(a.x * (1.f + sc.x) + sh.x, a.y * (1.f + sc.y) + sh.y, a.z * (1.f + sc.z) + sh.z, a.w * (1.f + sc.w) + sh.w);
    }
};
struct ALmodLat {
    const float* lat; const float* mv;
    DEV float4 operator()(int r, int k) const {
        const int b = r >= NL ? 1 : 0;
        float4 a = ld4(lat + (size_t)r * DM + k);
        const float* m = mv + b * 3072;
        float4 sh = ld4(m + k), sc = ld4(m + 1024 + k);
        return make_float4(a.x * (1.f + sc.x) + sh.x, a.y * (1.f + sc.y) + sh.y, a.z * (1.f + sc.z) + sh.z, a.w * (1.f + sc.w) + sh.w);
    }
};
struct ALplain { const float* A; int lda; DEV float4 operator()(int r, int k) const { return ld4(A + (size_t)r * lda + k); } };
struct ALbf { const bf16_t* A; int lda; DEV float4 operator()(int r, int k) const { const uint2 u = *(const uint2*)(A + (size_t)r * lda + k); return make_float4(bflo(u.x), bfhi(u.x), bflo(u.y), bfhi(u.y)); } };
struct EPstore { float* C; int ldc; DEV void operator()(int r, int c, float4 v) const { st4(C + (size_t)r * ldc + c, v); } };
struct EPstoreBf { bf16_t* C; int ldc; DEV void operator()(int r, int c, float4 v) const { *(uint2*)(C + (size_t)r * ldc + c) = make_uint2(pack2bf(v.x, v.y), pack2bf(v.z, v.w)); } };
struct EPres {
    float* C; int ldc; const float* lat; const float* cx; const float* mv; int b; int s0;
    DEV void operator()(int r, int c, float4 v) const {
        const int s = r + s0;
        const float* src; int j;
        if (s < NCX) { src = cx + ((size_t)(b * NCX + s)) * DM + c; j = 2; }
        else { src = lat + ((size_t)(b * NL + s - NCX)) * DM + c; j = b; }
        float4 x = ld4(src);
        float4 g = ld4(mv + j * 3072 + 2048 + c);
        st4(C + (size_t)r * ldc + c, make_float4(ALPHA * x.x + g.x * v.x, ALPHA * x.y + g.y * v.y, ALPHA * x.z + g.z * v.z, ALPHA * x.w + g.w * v.w));
    }
};
struct EPresLat {
    float* C; const float* lat; const float* mv;
    DEV void operator()(int r, int c, float4 v) const {
        const int b = r >= NL ? 1 : 0;
        float4 x = ld4(lat + (size_t)r * DM + c);
        float4 g = ld4(mv + b * 3072 + 2048 + c);
        st4(C + (size_t)r * DM + c, make_float4(ALPHA * x.x + g.x * v.x, ALPHA * x.y + g.y * v.y, ALPHA * x.z + g.z * v.z, ALPHA * x.w + g.w * v.w));
    }
};

DEV void phase_mod(const Params& p, float* sm) {
    const float* c = p.in[1]; const float* cctx = p.in[3];
    const float* mod_w = p.in[4]; const float* mod_b = p.in[5];
    float* modv = (float*)(p.ws + OFF_MODV);
    float* sil = sm; float* red = sm + 3072;
    const int tid = opaque_tid();
    for (int i = tid; i < 3072; i += NTHR) {
        const int j = i >> 10, k = i & 1023;
        const float v = (j < 2) ? c[j * 1024 + k] : cctx[k];
        sil[i] = silu_f(v);
    }
    __syncthreads();
    for (int unit = blockIdx.x; unit < 192; unit += gridDim.x) {
        const int l = unit / 96, cb = unit % 96;
        const int kg = tid >> 5, col = tid & 31, n = cb * 32 + col;
        const float* w = mod_w + (size_t)l * 1024 * 3072 + n;
        float a0 = 0.f, a1 = 0.f, a2 = 0.f;
        for (int k = kg * 64; k < kg * 64 + 64; ++k) {
            const float wv = w[(size_t)k * 3072];
            a0 += sil[k] * wv; a1 += sil[1024 + k] * wv; a2 += sil[2048 + k] * wv;
        }
        red[(kg * 3 + 0) * 32 + col] = a0; red[(kg * 3 + 1) * 32 + col] = a1; red[(kg * 3 + 2) * 32 + col] = a2;
        __syncthreads();
        if (tid < 96) {
            const int j = tid >> 5, cc = tid & 31, nn = cb * 32 + cc;
            float s = mod_b[l * 3072 + nn];
            for (int g = 0; g < 16; ++g) s += red[(g * 3 + j) * 32 + cc];
            modv[(l * 3 + j) * 3072 + nn] = s;
        }
        __syncthreads();
    }
}

DEV void phase_tables(const Params& p) {
    const float* wq = p.in[33]; const float* wk = p.in[34]; const float* wv = p.in[35];
    const float* gw0 = p.in[36]; const float* gw1 = p.in[38]; const float* gw2 = p.in[40]; const float* gw3 = p.in[42];
    float* gtab = (float*)(p.ws + OFF_GTAB); bf16_t* wft = (bf16_t*)(p.ws + OFF_WFT);
    const int gt = blockIdx.x * NTHR + opaque_tid(), gn = gridDim.x * NTHR;
    for (int i = gt; i < 512 * 16; i += gn) {
        const int gb = i >> 4, cp = (i >> 2) & 3, c = i & 3;
        float s = 0.f;
#pragma unroll
        for (int d = 0; d < 4; ++d) s += wq[gb * 16 + cp * 4 + d] * wk[gb * 16 + c * 4 + d];
        gtab[i] = s * KSCALE;
    }
    for (int i = gt; i < 4096 * 16; i += gn) {
        const int g = i >> 12, k = i & 4095, gm = g >> 2, hd = g & 3;
        const float* wg = gm == 0 ? gw0 : (gm == 1 ? gw1 : (gm == 2 ? gw2 : gw3));
        float s = 0.f;
        if (k < 2048) {
            const int blk = k >> 2, cc = k & 3;
#pragma unroll
            for (int d = 0; d < 4; ++d) s += wq[blk * 16 + cc * 4 + d] * wg[(size_t)(4 * blk + d) * 4 + hd] + wk[blk * 16 + cc * 4 + d] * wg[(size_t)(2048 + 4 * blk + d) * 4 + hd];
        } else {
            const int kk = k - 2048, blk = kk >> 2, cc = kk & 3;
#pragma unroll
            for (int d = 0; d < 4; ++d) s += wv[blk * 16 + cc * 4 + d] * wg[(size_t)(4096 + 4 * blk + d) * 4 + hd];
        }
        wft[i] = __builtin_bit_cast(unsigned short, (__bf16)s);
    }
}

#ifdef RWKV_DEBUG
DEV float rw_mix(const bf16_t* P0, int s, int c, const float* __restrict__ mu) {
    const float own = bf2f(P0[(size_t)s * EIN + RW0 + c]);
    const int d = c & 3;
    int ns = -1;
    if (s < NCX) {
        if (d == 0) ns = (s > 0) ? s - 1 : -1;
        else if (d == 1) ns = (s < NCX - 1) ? s + 1 : -1;
    } else {
        const int n = s - NCX, rr = n >> 6, cc = n & 63;
        if (d == 0) ns = (cc > 0) ? s - 1 : -1;
        else if (d == 1) ns = (cc < 63) ? s + 1 : -1;
        else if (d == 2) ns = (rr > 0) ? s - 64 : -1;
        else ns = (rr < 127) ? s + 64 : -1;
    }
    const float nb = (ns >= 0) ? bf2f(P0[(size_t)ns * EIN + RW0 + c]) : 0.f;
    return own + (nb - own) * mu[c];
}

DEV void rwkv_unit(const Params& p, int h, int dir, int rh, float* sm, int lane) {
    asm volatile("" : "+v"(lane));
    const bf16_t* P0 = (const bf16_t*)(p.ws + OFF_P0);
    float* YS = p.out;
    float* BON = (float*)(p.ws + OFF_X1C);
    const float* mu = p.in[15];
    const float* w0 = p.in[dir ? 18 : 16]; const float* ww2 = p.in[dir ? 19 : 17];
    const float* a0 = p.in[dir ? 22 : 20]; const float* wa2 = p.in[dir ? 23 : 21];
    const float* k_k = p.in[24]; const float* k_a = p.in[25]; const float* r_k = p.in[26];
    float* sR = sm; float* sW = sm + 4096; float* sK = sm + 8192; float* sA = sm + 12288; float* sB = sm + 16384; float* sV = sm + 20480;
    const int hc = h * 64 + lane;
    const float w0j = w0[hc], a0j = a0[hc], kkj = k_k[hc], kaj = k_a[hc], rkj = r_k[hc];
    const int row = rh * 32 + (lane & 31), kh0 = (lane >> 5) * 32;
    float* sWW = sm + 24576; float* sWA = sm + 28672;
#pragma unroll 4
    for (int i = 0; i < 64; ++i) { sWW[i * 64 + lane] = ww2[i * 512 + hc]; sWA[i * 64 + lane] = wa2[i * 512 + hc]; }
    float S[32];
#pragma unroll
    for (int k = 0; k < 32; ++k) S[k] = 0.f;
    const int cwl = 2048 + dir * 64, cal = 2176 + dir * 64;
#pragma unroll 1
    for (int cu = 0; cu < TB / 64; ++cu) {
        lds_fence();
#pragma unroll 1
        for (int t = 0; t < 64; ++t) {
            const int s = scan_s(dir, cu * 64 + t);
            sR[t * 64 + lane] = rw_mix(P0, s, h * 64 + lane, mu);
            sK[t * 64 + lane] = rw_mix(P0, s, 512 + h * 64 + lane, mu);
            sV[t * 64 + lane] = rw_mix(P0, s, 1024 + h * 64 + lane, mu);
            sA[t * 64 + lane] = tanh_f(rw_mix(P0, s, cwl + lane, mu));
            sB[t * 64 + lane] = rw_mix(P0, s, cal + lane, mu);
        }
        lds_fence();
        {
            const float* wr = sWW + lane; asm volatile("" : "+v"(wr));
            float wc[64];
#pragma unroll
            for (int i = 0; i < 64; ++i) wc[i] = wr[i * 64];
#pragma unroll 1
            for (int t = 0; t < 64; ++t) {
                float accw = w0j;
#pragma unroll
                for (int i4 = 0; i4 < 16; ++i4) {
                    const float4 x = ld4(&sA[t * 64 + i4 * 4]);
                    accw += x.x * wc[i4 * 4] + x.y * wc[i4 * 4 + 1] + x.z * wc[i4 * 4 + 2] + x.w * wc[i4 * 4 + 3];
                }
                sW[t * 64 + lane] = fexp(-0.6065306597f * sigmoid_f(accw));
            }
        }
        lds_fence();
        {
            const float* ar = sWA + lane; asm volatile("" : "+v"(ar));
            float ac[64];
#pragma unroll
            for (int i = 0; i < 64; ++i) ac[i] = ar[i * 64];
#pragma unroll 1
            for (int t = 0; t < 64; ++t) {
                float acca = a0j;
#pragma unroll
                for (int i4 = 0; i4 < 16; ++i4) {
                    const float4 y = ld4(&sB[t * 64 + i4 * 4]);
                    acca += y.x * ac[i4 * 4] + y.y * ac[i4 * 4 + 1] + y.z * ac[i4 * 4 + 2] + y.w * ac[i4 * 4 + 3];
                }
                const float av = sigmoid_f(acca);
                const float kraw = sK[t * 64 + lane];
                const float kkv = kraw * kkj;
                const float ss = wave_sum(kkv * kkv);
                const float kk = kkv * rsqrtf(fmaxf(ss, 1e-24f));
                const float kh = kraw * (1.f + (av - 1.f) * kaj);
                const float r = sR[t * 64 + lane];
                const float bon = wave_sum(r * kh * rkj);
                lds_fence();
                sK[t * 64 + lane] = kh; sA[t * 64 + lane] = -kk; sB[t * 64 + lane] = kk * av;
                if (lane == 0 && rh == 0) { const int s = scan_s(dir, cu * 64 + t); atomicAdd(&BON[s * 8 + h], bon); }
            }
        }
        lds_fence();
        if (cu == 0 && dir == 0 && rh == 0) {
            float* DBO = p.out + 9000000;
            for (int t = 0; t < 64; ++t) { float* d = DBO + ((size_t)(h * 64 + t) * 64 + lane) * 6; d[0] = sW[t * 64 + lane]; d[1] = sK[t * 64 + lane]; d[2] = sA[t * 64 + lane]; d[3] = sB[t * 64 + lane]; d[4] = sR[t * 64 + lane]; d[5] = sV[t * 64 + lane]; }
        }
#pragma unroll 1
        for (int t = 0; t < 64; ++t) {
            const float vi = sV[t * 64 + row];
            float sa = 0.f;
#pragma unroll
            for (int k4 = 0; k4 < 8; ++k4) {
                const float4 a4 = ld4(&sA[t * 64 + kh0 + k4 * 4]);
                sa += S[k4 * 4] * a4.x + S[k4 * 4 + 1] * a4.y + S[k4 * 4 + 2] * a4.z + S[k4 * 4 + 3] * a4.w;
            }
            sa += __shfl_xor(sa, 32, 64);
            float y = 0.f;
#pragma unroll
            for (int k4 = 0; k4 < 8; ++k4) {
                const float4 w4 = ld4(&sW[t * 64 + kh0 + k4 * 4]);
                const float4 b4 = ld4(&sB[t * 64 + kh0 + k4 * 4]);
                const float4 h4 = ld4(&sK[t * 64 + kh0 + k4 * 4]);
                const float4 r4 = ld4(&sR[t * 64 + kh0 + k4 * 4]);
                S[k4 * 4 + 0] = S[k4 * 4 + 0] * w4.x + sa * b4.x + vi * h4.x;
                S[k4 * 4 + 1] = S[k4 * 4 + 1] * w4.y + sa * b4.y + vi * h4.y;
                S[k4 * 4 + 2] = S[k4 * 4 + 2] * w4.z + sa * b4.z + vi * h4.z;
                S[k4 * 4 + 3] = S[k4 * 4 + 3] * w4.w + sa * b4.w + vi * h4.w;
                y += S[k4 * 4] * r4.x + S[k4 * 4 + 1] * r4.y + S[k4 * 4 + 2] * r4.z + S[k4 * 4 + 3] * r4.w;
            }
            y += __shfl_xor(y, 32, 64);
            if (lane < 32) { const int s = scan_s(dir, cu * 64 + t); atomicAdd(&YS[(size_t)s * 1024 + 512 + h * 64 + row], y); }
        }
    }
}

#endif
DEV float wave_scan_add(float v, int lane, int dir) {
#pragma unroll
    for (int o = 1; o < 64; o <<= 1) {
        const float n = dir ? __shfl_down(v, o, 64) : __shfl_up(v, o, 64);
        const bool ok = dir ? (lane + o < 64) : (lane >= o);
        if (ok) v += n;
    }
    return v;
}
DEV float wave_scan_max(float v, int lane, int dir) {
#pragma unroll
    for (int o = 1; o < 64; o <<= 1) {
        const float n = dir ? __shfl_down(v, o, 64) : __shfl_up(v, o, 64);
        const bool ok = dir ? (lane + o < 64) : (lane >= o);
        if (ok) v = fmaxf(v, n);
    }
    return v;
}

DEV void gla_decay(const bf16_t* P0, int c, int h, int dir, const float* __restrict__ wa2, const float* __restrict__ ba,
                   float* sLR, float* sWA, float* sBC, float* sTot, int tid) {
    for (int i = tid; i < 1024; i += NTHR) { const int t = i >> 4, j = i & 15; sLR[i] = bf2f(P0[(size_t)(c * 64 + t) * EIN + 1536 + dir * 16 + j]); }
    for (int i = tid; i < 1024; i += NTHR) { const int ii = i >> 6, k = i & 63; sWA[i] = wa2[ii * 256 + h * 64 + k]; }
    __syncthreads();
    {
        const int t = tid >> 3, k0 = (tid & 7) * 8;
        float acc[8];
#pragma unroll
        for (int j = 0; j < 8; ++j) acc[j] = ba[h * 64 + k0 + j];
#pragma unroll
        for (int ii = 0; ii < 16; ++ii) {
            const float l = sLR[t * 16 + ii];
#pragma unroll
            for (int j = 0; j < 8; ++j) acc[j] += l * sWA[ii * 64 + k0 + j];
        }
#pragma unroll
        for (int j = 0; j < 8; ++j) sBC[t * 65 + k0 + j] = logsig_f(acc[j]) * 0.0625f;
    }
    __syncthreads();
    {
        const int lane = tid & 63, wv = tid >> 6;
#pragma unroll
        for (int j = 0; j < 8; ++j) {
            const int k = wv * 8 + j;
            const float v = wave_scan_add(sBC[lane * 65 + k], lane, dir);
            sBC[lane * 65 + k] = v;
            if (lane == (dir ? 0 : 63)) sTot[k] = v;
        }
    }
    __syncthreads();
}
DEV bf16x8 tr_frag(const bf16_t* base, int ld, int row0, int col0, int lane) {
    const bf16_t* ptr = base + (row0 + (lane >> 4) * 8 + ((lane & 15) >> 2)) * ld + col0 + (lane & 3) * 4;
    const s16x4 lo = __builtin_amdgcn_ds_read_tr16_b64_v4i16((__attribute__((address_space(3))) s16x4*)ptr);
    const s16x4 hi = __builtin_amdgcn_ds_read_tr16_b64_v4i16((__attribute__((address_space(3))) s16x4*)(ptr + 4 * ld));
    return (bf16x8){lo[0], lo[1], lo[2], lo[3], hi[0], hi[1], hi[2], hi[3]};
}
DEV bf16x8 row_frag(const bf16_t* base, int ld, int idx0, int k0, int lane) {
    return *(const bf16x8*)(base + (idx0 + (lane & 15)) * ld + k0 + (lane >> 4) * 8);
}

DEV void gla1_unit(const Params& p, int h, int dir, int c, float* sm) {
    const int tid = opaque_tid(), lane = tid & 63, wave = tid >> 6;
    const bf16_t* P0 = (const bf16_t*)(p.ws + OFF_P0);
    float* GDS = (float*)(p.ws + OFF_GDS); float* GDEC = (float*)(p.ws + OFF_GDEC);
    const float* wa2 = p.in[dir ? 12 : 10]; const float* ba = p.in[dir ? 13 : 11];
    float* sLR = sm; float* sWA = sm + 1024; float* sBC = sm + 2048; float* sTot = sm + 6208;
    bf16_t* kT = (bf16_t*)(sm + 6272);
    bf16_t* Vs = (bf16_t*)(sm + 8576);
    const int ch = h * 2 + dir;
    __syncthreads();
    gla_decay(P0, c, h, dir, wa2, ba, sLR, sWA, sBC, sTot, tid);
    {
        const int t = tid >> 3, k0 = (tid & 7) * 8;
        float kv[8]; unpack8(*(const uint4*)(P0 + (size_t)(c * 64 + t) * EIN + 256 + h * 64 + k0), kv);
#pragma unroll
        for (int j = 0; j < 8; ++j) kT[(k0 + j) * 72 + t] = __builtin_bit_cast(unsigned short, (__bf16)(kv[j] * fexp(sTot[k0 + j] - sBC[t * 65 + k0 + j])));
#pragma unroll
        for (int u = 0; u < 2; ++u) { const int i = tid + 512 * u, row = i >> 4, c16 = i & 15; *(uint4*)(Vs + row * 136 + c16 * 8) = *(const uint4*)(P0 + (size_t)(c * 64 + row) * EIN + 512 + h * 128 + c16 * 8); }
    }
    __syncthreads();
    {
        f32x4 acc[4];
#pragma unroll
        for (int kt = 0; kt < 4; ++kt) acc[kt] = (f32x4){0.f, 0.f, 0.f, 0.f};
#pragma unroll
        for (int ks = 0; ks < 2; ++ks) {
            const bf16x8 af = tr_frag(Vs, 136, ks * 32, wave * 16, lane);
#pragma unroll
            for (int kt = 0; kt < 4; ++kt) acc[kt] = __builtin_amdgcn_mfma_f32_16x16x32_bf16(af, row_frag(kT, 72, kt * 16, ks * 32, lane), acc[kt], 0, 0, 0);
        }
#pragma unroll
        for (int kt = 0; kt < 4; ++kt) {
            const int k = kt * 16 + (lane & 15), v = wave * 16 + (lane >> 4) * 4;
            st4(GDS + ((size_t)(ch * NCH + c) * 64 + k) * 128 + v, make_float4(acc[kt][0], acc[kt][1], acc[kt][2], acc[kt][3]));
        }
    }
    if (tid < 64) GDEC[(size_t)(ch * NCH + c) * 64 + tid] = fexp(sTot[tid]);
}

DEV void gla2_unit(const Params& p, int unit) {
    const int tid = opaque_tid();
    float* GDS = (float*)(p.ws + OFF_GDS); const float* GDEC = (const float*)(p.ws + OFF_GDEC);
    const int ch = unit >> 4, e = (unit & 15) * 512 + tid, k = e >> 7, dir = ch & 1;
    float S = 0.f;
#pragma unroll 4
    for (int step = 0; step < NCH; ++step) {
        const int c = chunk_at(dir, step);
        float* gp = GDS + (size_t)(ch * NCH + c) * 8192 + e;
        const float d = GDEC[(size_t)(ch * NCH + c) * 64 + k], inc = *gp;
        *gp = S;
        S = d * S + inc;
    }
}

DEV void gla3_unit(const Params& p, int h, int c, float* sm) {
    const int tid = opaque_tid(), lane = tid & 63, wave = tid >> 6;
    const bf16_t* P0 = (const bf16_t*)(p.ws + OFF_P0);
    const float* GDS = (const float*)(p.ws + OFF_GDS);
    bf16_t* YC = (bf16_t*)(p.ws + OFF_YC);
    const float* ng = p.in[14];
    float* sLR = sm; float* sWA = sm + 1024; float* sBC = sm + 2048; float* sTot = sm + 6208;
    bf16_t* qt = (bf16_t*)(sm + 6272);
    bf16_t* kt = (bf16_t*)(sm + 8576);
    bf16_t* Sm = (bf16_t*)(sm + 10880);
    bf16_t* S0s = (bf16_t*)(sm + 13184);
    bf16_t* Vs = (bf16_t*)(sm + 17536);
    float* O = sm + 21888;
    const int ti = wave & 3, vt0 = (wave >> 2) * 4;
    f32x4 acc[4];
#pragma unroll
    for (int j = 0; j < 4; ++j) acc[j] = (f32x4){0.f, 0.f, 0.f, 0.f};
    __syncthreads();
#pragma unroll
    for (int u = 0; u < 2; ++u) { const int i = tid + 512 * u, row = i >> 4, c16 = i & 15; *(uint4*)(Vs + row * 136 + c16 * 8) = *(const uint4*)(P0 + (size_t)(c * 64 + row) * EIN + 512 + h * 128 + c16 * 8); }
#pragma unroll 1
    for (int dir = 0; dir < 2; ++dir) {
        const float* wa2 = p.in[dir ? 12 : 10]; const float* ba = p.in[dir ? 13 : 11];
        const int ch = h * 2 + dir;
        __syncthreads();
        gla_decay(P0, c, h, dir, wa2, ba, sLR, sWA, sBC, sTot, tid);
        {
            const int t = tid >> 3, k0 = (tid & 7) * 8;
            float qv[8], kv[8];
            unpack8(*(const uint4*)(P0 + (size_t)(c * 64 + t) * EIN + h * 64 + k0), qv);
            unpack8(*(const uint4*)(P0 + (size_t)(c * 64 + t) * EIN + 256 + h * 64 + k0), kv);
#pragma unroll
            for (int j = 0; j < 8; ++j) { const float bc = sBC[t * 65 + k0 + j]; qv[j] *= 0.125f * fexp(bc); kv[j] *= fexp(-bc); }
            *(uint4*)(qt + t * 72 + k0) = make_uint4(pack2bf(qv[0], qv[1]), pack2bf(qv[2], qv[3]), pack2bf(qv[4], qv[5]), pack2bf(qv[6], qv[7]));
            *(uint4*)(kt + t * 72 + k0) = make_uint4(pack2bf(kv[0], kv[1]), pack2bf(kv[2], kv[3]), pack2bf(kv[4], kv[5]), pack2bf(kv[6], kv[7]));
#pragma unroll
            for (int u = 0; u < 4; ++u) {
                const int i = tid + 512 * u, k = i >> 5, v4 = (i & 31) * 4;
                const float4 s4 = ld4(GDS + (size_t)(ch * NCH + c) * 8192 + k * 128 + v4);
                *(uint2*)(S0s + k * 136 + v4) = make_uint2(pack2bf(s4.x, s4.y), pack2bf(s4.z, s4.w));
            }
        }
        __syncthreads();
        {
            const int si = wave & 3;
#pragma unroll
            for (int jj = 0; jj < 2; ++jj) {
                const int t2 = (wave >> 2) * 2 + jj;
                f32x4 a = (f32x4){0.f, 0.f, 0.f, 0.f};
#pragma unroll
                for (int ks = 0; ks < 2; ++ks) a = __builtin_amdgcn_mfma_f32_16x16x32_bf16(row_frag(kt, 72, si * 16, ks * 32, lane), row_frag(qt, 72, t2 * 16, ks * 32, lane), a, 0, 0, 0);
                const int t = t2 * 16 + (lane & 15), s0 = si * 16 + (lane >> 4) * 4;
                float m[4];
#pragma unroll
                for (int r = 0; r < 4; ++r) { const bool keep = dir ? (s0 + r >= t) : (s0 + r <= t); m[r] = keep ? a[r] : 0.f; }
                *(uint2*)(Sm + t * 72 + s0) = make_uint2(pack2bf(m[0], m[1]), pack2bf(m[2], m[3]));
            }
        }
        __syncthreads();
#pragma unroll
        for (int ks = 0; ks < 2; ++ks) {
            const bf16x8 a1 = row_frag(qt, 72, ti * 16, ks * 32, lane), a2 = row_frag(Sm, 72, ti * 16, ks * 32, lane);
#pragma unroll
            for (int j = 0; j < 4; ++j) {
                acc[j] = __builtin_amdgcn_mfma_f32_16x16x32_bf16(a1, tr_frag(S0s, 136, ks * 32, (vt0 + j) * 16, lane), acc[j], 0, 0, 0);
                acc[j] = __builtin_amdgcn_mfma_f32_16x16x32_bf16(a2, tr_frag(Vs, 136, ks * 32, (vt0 + j) * 16, lane), acc[j], 0, 0, 0);
            }
        }
    }
#pragma unroll
    for (int j = 0; j < 4; ++j)
#pragma unroll
        for (int r = 0; r < 4; ++r) O[(ti * 16 + (lane >> 4) * 4 + r) * 132 + (vt0 + j) * 16 + (lane & 15)] = acc[j][r];
    __syncthreads();
    {
        const int t = tid >> 3, v0 = (tid & 7) * 16;
        float o[16];
        float ss = 0.f;
#pragma unroll
        for (int i = 0; i < 16; ++i) { o[i] = O[t * 132 + v0 + i]; ss += o[i] * o[i]; }
        ss += __shfl_xor(ss, 1, 64); ss += __shfl_xor(ss, 2, 64); ss += __shfl_xor(ss, 4, 64);
        const float rms = rsqrtf(ss * (1.f / 128.f) + 1e-5f);
        float g[16];
        const bf16_t* gp = P0 + (size_t)(c * 64 + t) * EIN + 1024 + h * 128 + v0;
        unpack8(*(const uint4*)gp, g); unpack8(*(const uint4*)(gp + 8), g + 8);
        float y[16];
#pragma unroll
        for (int i = 0; i < 16; ++i) y[i] = o[i] * rms * ng[v0 + i] * silu_f(g[i]);
        bf16_t* yp = YC + (size_t)(c * 64 + t) * 1024 + h * 128 + v0;
        *(uint4*)yp = make_uint4(pack2bf(y[0], y[1]), pack2bf(y[2], y[3]), pack2bf(y[4], y[5]), pack2bf(y[6], y[7]));
        *(uint4*)(yp + 8) = make_uint4(pack2bf(y[8], y[9]), pack2bf(y[10], y[11]), pack2bf(y[12], y[13]), pack2bf(y[14], y[15]));
    }
}

DEV void load8bf(const bf16_t* ptr, float* f) { unpack8(*(const uint4*)ptr, f); }
DEV void rw_mix8(const bf16_t* P0, int s, int cb, const float* __restrict__ mu, float* out) {
    float own[8]; load8bf(P0 + (size_t)s * EIN + RW0 + cb, own);
    int nL = -1, nR = -1, nU = -1, nD = -1;
    if (s < NCX) { if (s > 0) nL = s - 1; if (s < NCX - 1) nR = s + 1; }
    else { const int n = s - NCX, rr = n >> 6, cc = n & 63; if (cc > 0) nL = s - 1; if (cc < 63) nR = s + 1; if (rr > 0) nU = s - 64; if (rr < 127) nD = s + 64; }
    float fL[8], fR[8], fU[8], fD[8];
#pragma unroll
    for (int i = 0; i < 8; ++i) { fL[i] = 0.f; fR[i] = 0.f; fU[i] = 0.f; fD[i] = 0.f; }
    if (nL >= 0) load8bf(P0 + (size_t)nL * EIN + RW0 + cb, fL);
    if (nR >= 0) load8bf(P0 + (size_t)nR * EIN + RW0 + cb, fR);
    if (nU >= 0) load8bf(P0 + (size_t)nU * EIN + RW0 + cb, fU);
    if (nD >= 0) load8bf(P0 + (size_t)nD * EIN + RW0 + cb, fD);
    const float4 m0 = ld4(mu + cb), m1 = ld4(mu + cb + 4);
    const float m[8] = {m0.x, m0.y, m0.z, m0.w, m1.x, m1.y, m1.z, m1.w};
#pragma unroll
    for (int i = 0; i < 8; ++i) { const float nb = (i & 3) == 0 ? fL[i] : ((i & 3) == 1 ? fR[i] : ((i & 3) == 2 ? fU[i] : fD[i])); out[i] = own[i] + (nb - own[i]) * m[i]; }
}
DEV uint4 pack8(const float* f) { return make_uint4(pack2bf(f[0], f[1]), pack2bf(f[2], f[3]), pack2bf(f[4], f[5]), pack2bf(f[6], f[7])); }

template <int XM, int YM, class F>
DEV void mm64(const bf16_t* X, const bf16_t* Y, F f, int lane, int wave) {
#pragma unroll
    for (int q = 0; q < 2; ++q) {
        const int idx = wave * 2 + q, ti = idx >> 2, tj = idx & 3;
        f32x4 acc = (f32x4){0.f, 0.f, 0.f, 0.f};
#pragma unroll
        for (int ks = 0; ks < 2; ++ks) {
            const bf16x8 a = XM == 0 ? row_frag(X, 72, ti * 16, ks * 32, lane) : tr_frag(X, 72, ks * 32, ti * 16, lane);
            const bf16x8 bq = YM == 0 ? row_frag(Y, 72, tj * 16, ks * 32, lane) : tr_frag(Y, 72, ks * 32, tj * 16, lane);
            acc = __builtin_amdgcn_mfma_f32_16x16x32_bf16(a, bq, acc, 0, 0, 0);
        }
        f(ti * 16 + (lane >> 4) * 4, tj * 16 + (lane & 15), acc);
    }
}
template <int XM, int YM, class F>
DEV void mm64x2(const bf16_t* X1, const bf16_t* Y1, const bf16_t* X2, const bf16_t* Y2, F f, int lane, int wave) {
#pragma unroll
    for (int q = 0; q < 2; ++q) {
        const int idx = wave * 2 + q, ti = idx >> 2, tj = idx & 3;
        f32x4 acc = (f32x4){0.f, 0.f, 0.f, 0.f};
#pragma unroll
        for (int ks = 0; ks < 2; ++ks) {
            const bf16x8 a = XM == 0 ? row_frag(X1, 72, ti * 16, ks * 32, lane) : tr_frag(X1, 72, ks * 32, ti * 16, lane);
            const bf16x8 bq = YM == 0 ? row_frag(Y1, 72, tj * 16, ks * 32, lane) : tr_frag(Y1, 72, ks * 32, tj * 16, lane);
            acc = __builtin_amdgcn_mfma_f32_16x16x32_bf16(a, bq, acc, 0, 0, 0);
            const bf16x8 a2 = XM == 0 ? row_frag(X2, 72, ti * 16, ks * 32, lane) : tr_frag(X2, 72, ks * 32, ti * 16, lane);
            const bf16x8 b2 = YM == 0 ? row_frag(Y2, 72, tj * 16, ks * 32, lane) : tr_frag(Y2, 72, ks * 32, tj * 16, lane);
            acc = __builtin_amdgcn_mfma_f32_16x16x32_bf16(a2, b2, acc, 0, 0, 0);
        }
        f(ti * 16 + (lane >> 4) * 4, tj * 16 + (lane & 15), acc);
    }
}
DEV void st_img(bf16_t* P, int i0, int j, float a0, float a1, float a2, float a3) {
    P[(i0 + 0) * 72 + j] = __builtin_bit_cast(unsigned short, (__bf16)a0); P[(i0 + 1) * 72 + j] = __builtin_bit_cast(unsigned short, (__bf16)a1);
    P[(i0 + 2) * 72 + j] = __builtin_bit_cast(unsigned short, (__bf16)a2); P[(i0 + 3) * 72 + j] = __builtin_bit_cast(unsigned short, (__bf16)a3);
}

DEV void rwkv1_unit(const Params& p, int h, int dir, int c, float* sm) {
    const int tid = opaque_tid(), lane = tid & 63, wave = tid >> 6;
    const bf16_t* P0 = (const bf16_t*)(p.ws + OFF_P0);
    bf16_t* RU = (bf16_t*)(p.ws + OFF_RU) + (size_t)((h * 2 + dir) * NCH + c) * 16384;
    float* BONS = (float*)(p.ws + OFF_BONS);
    const float* mu = p.in[15];
    const float* w0 = p.in[dir ? 18 : 16]; const float* ww2 = p.in[dir ? 19 : 17];
    const float* a0 = p.in[dir ? 22 : 20]; const float* wa2 = p.in[dir ? 23 : 21];
    bf16_t* img = (bf16_t*)sm;
#define SLOT(i_) (img + (i_) * 4608)
    float* fLW = (float*)SLOT(10);
    float* fAS = (float*)SLOT(12);
    float* sv = (float*)SLOT(14);
    const int t = tid >> 3, j0 = (tid & 7) * 8, s = c * 64 + t;
    __syncthreads();
    if (tid < 64) { const int hc = h * 64 + tid; sv[64 + tid] = w0[hc]; sv[128 + tid] = a0[hc]; sv[192 + tid] = p.in[24][hc]; sv[256 + tid] = p.in[25][hc]; sv[320 + tid] = p.in[26][hc]; }
    float r8[8], k8[8], v8[8];
    {
        float x8[8];
        rw_mix8(P0, s, h * 64 + j0, mu, r8);
        rw_mix8(P0, s, 512 + h * 64 + j0, mu, k8);
        rw_mix8(P0, s, 1024 + h * 64 + j0, mu, v8);
        rw_mix8(P0, s, 2048 + dir * 64 + j0, mu, x8);
#pragma unroll
        for (int i = 0; i < 8; ++i) x8[i] = tanh_f(x8[i]);
        *(uint4*)(SLOT(6) + t * 72 + j0) = pack8(x8);
        rw_mix8(P0, s, 2176 + dir * 64 + j0, mu, x8);
        *(uint4*)(SLOT(7) + t * 72 + j0) = pack8(x8);
        float wq[8];
        { const float4 q0 = ld4(ww2 + (size_t)t * 512 + h * 64 + j0), q1 = ld4(ww2 + (size_t)t * 512 + h * 64 + j0 + 4); wq[0] = q0.x; wq[1] = q0.y; wq[2] = q0.z; wq[3] = q0.w; wq[4] = q1.x; wq[5] = q1.y; wq[6] = q1.z; wq[7] = q1.w; }
        *(uint4*)(SLOT(8) + t * 72 + j0) = pack8(wq);
        { const float4 q0 = ld4(wa2 + (size_t)t * 512 + h * 64 + j0), q1 = ld4(wa2 + (size_t)t * 512 + h * 64 + j0 + 4); wq[0] = q0.x; wq[1] = q0.y; wq[2] = q0.z; wq[3] = q0.w; wq[4] = q1.x; wq[5] = q1.y; wq[6] = q1.z; wq[7] = q1.w; }
        *(uint4*)(SLOT(9) + t * 72 + j0) = pack8(wq);
    }
    __syncthreads();
    mm64<0, 1>(SLOT(6), SLOT(8), [=](int i0, int j, f32x4 a) {
#pragma unroll
        for (int r = 0; r < 4; ++r) fLW[(i0 + r) * 65 + j] = -0.6065306597f * sigmoid_f(sv[64 + j] + a[r]); }, lane, wave);
    mm64<0, 1>(SLOT(7), SLOT(9), [=](int i0, int j, f32x4 a) {
#pragma unroll
        for (int r = 0; r < 4; ++r) fAS[(i0 + r) * 65 + j] = sigmoid_f(sv[128 + j] + a[r]); }, lane, wave);
    __syncthreads();
#pragma unroll
    for (int j = 0; j < 8; ++j) {
        const int k = wave * 8 + j;
        const float v = wave_scan_add(fLW[lane * 65 + k], lane, dir);
        fLW[lane * 65 + k] = v;
        if (lane == (dir ? 0 : 63)) sv[k] = v;
    }
    __syncthreads();
    {
        float kkv[8], ss = 0.f;
#pragma unroll
        for (int i = 0; i < 8; ++i) { kkv[i] = k8[i] * sv[192 + j0 + i]; ss += kkv[i] * kkv[i]; }
        ss += __shfl_xor(ss, 1, 64); ss += __shfl_xor(ss, 2, 64); ss += __shfl_xor(ss, 4, 64);
        const float rn = rsqrtf(fmaxf(ss, 1e-24f));
        float fa[8], fb[8], fk[8], fr[8], fbp[8], fkp[8], bon = 0.f;
        const int tp = dir ? t + 1 : t - 1;
        const bool hasp = dir ? (t < 63) : (t > 0);
#pragma unroll
        for (int i = 0; i < 8; ++i) {
            const int k = j0 + i;
            const float Bt = fLW[t * 65 + k], Bx = hasp ? fLW[tp * 65 + k] : 0.f, asg = fAS[t * 65 + k];
            const float kk = kkv[i] * rn, kh = k8[i] * (1.f + (asg - 1.f) * sv[256 + k]);
            bon += r8[i] * kh * sv[320 + k];
            const float enB = fexp(-Bt), eLB = fexp(sv[k] - Bt), bv = kk * asg;
            fa[i] = -kk * fexp(Bx); fb[i] = bv * enB; fk[i] = kh * enB; fr[i] = r8[i] * fexp(Bt); fbp[i] = bv * eLB; fkp[i] = kh * eLB;
        }
#ifdef RWKV_DEBUG
        if (c == 0 && dir == 0) {
            float* DBN = p.out + 9000000 + 8 * 64 * 64 * 6;
#pragma unroll
            for (int i = 0; i < 8; ++i) {
                const int k = j0 + i;
                const float Bt = fLW[t * 65 + k], Bx = hasp ? fLW[tp * 65 + k] : 0.f, asg = fAS[t * 65 + k];
                const float kk = kkv[i] * rn, kh = k8[i] * (1.f + (asg - 1.f) * sv[256 + k]);
                float* d = DBN + ((size_t)(h * 64 + t) * 64 + k) * 6;
                d[0] = fexp(Bt - Bx); d[1] = kh; d[2] = -kk; d[3] = kk * asg; d[4] = r8[i]; d[5] = v8[i];
            }
        }
#endif
        bon += __shfl_xor(bon, 1, 64); bon += __shfl_xor(bon, 2, 64); bon += __shfl_xor(bon, 4, 64);
        if ((tid & 7) == 0) BONS[((size_t)dir * TB + s) * 8 + h] = bon;
        *(uint4*)(SLOT(0) + t * 72 + j0) = pack8(fa); *(uint4*)(SLOT(1) + t * 72 + j0) = pack8(fb); *(uint4*)(SLOT(2) + t * 72 + j0) = pack8(fk);
        *(uint4*)(SLOT(3) + t * 72 + j0) = pack8(fr); *(uint4*)(SLOT(4) + t * 72 + j0) = pack8(fbp); *(uint4*)(SLOT(5) + t * 72 + j0) = pack8(fkp);
    }
    __syncthreads();
    *(uint4*)(SLOT(6) + t * 72 + j0) = pack8(v8);
    __syncthreads();
    mm64<0, 0>(SLOT(0), SLOT(1), [=](int i0, int j, f32x4 a) {
        float m[4];
#pragma unroll
        for (int r = 0; r < 4; ++r) { const bool keep = dir ? (j > i0 + r) : (j < i0 + r); m[r] = keep ? a[r] : 0.f; }
        const bool dg = (i0 >> 4) == (j >> 4);
        st_img(SLOT(7), i0, j, dg ? m[0] : 0.f, dg ? m[1] : 0.f, dg ? m[2] : 0.f, dg ? m[3] : 0.f);
        st_img(SLOT(8), i0, j, (dg ? m[0] : 0.f) + (j == i0 ? 1.f : 0.f), (dg ? m[1] : 0.f) + (j == i0 + 1 ? 1.f : 0.f), (dg ? m[2] : 0.f) + (j == i0 + 2 ? 1.f : 0.f), (dg ? m[3] : 0.f) + (j == i0 + 3 ? 1.f : 0.f));
        st_img(SLOT(12), i0, j, dg ? 0.f : m[0], dg ? 0.f : m[1], dg ? 0.f : m[2], dg ? 0.f : m[3]); }, lane, wave);
    mm64<0, 0>(SLOT(0), SLOT(2), [=](int i0, int j, f32x4 a) {
        float m[4];
#pragma unroll
        for (int r = 0; r < 4; ++r) { const bool keep = dir ? (j > i0 + r) : (j < i0 + r); m[r] = keep ? a[r] : 0.f; }
        st_img(SLOT(9), i0, j, m[0], m[1], m[2], m[3]); }, lane, wave);
    mm64<0, 0>(SLOT(3), SLOT(1), [=](int i0, int j, f32x4 a) {
        float m[4];
#pragma unroll
        for (int r = 0; r < 4; ++r) { const bool keep = dir ? (j >= i0 + r) : (j <= i0 + r); m[r] = keep ? a[r] : 0.f; }
        st_img(SLOT(10), i0, j, m[0], m[1], m[2], m[3]); }, lane, wave);
    mm64<0, 0>(SLOT(3), SLOT(2), [=](int i0, int j, f32x4 a) {
        float m[4];
#pragma unroll
        for (int r = 0; r < 4; ++r) { const bool keep = dir ? (j >= i0 + r) : (j <= i0 + r); m[r] = keep ? a[r] : 0.f; }
        st_img(SLOT(11), i0, j, m[0], m[1], m[2], m[3]); }, lane, wave);
    __syncthreads();
    {
        bf16_t* Pc = SLOT(7); bf16_t* Pn = SLOT(1); bf16_t* Tc = SLOT(8); bf16_t* Tn = SLOT(2);
#pragma unroll 1
        for (int it = 0; it < 3; ++it) {
            mm64<0, 1>(Pc, Pc, [=](int i0, int j, f32x4 a) { st_img(Pn, i0, j, a[0], a[1], a[2], a[3]); }, lane, wave);
            __syncthreads();
            mm64<0, 1>(Tc, Pn, [=](int i0, int j, f32x4 a) {
                st_img(Tn, i0, j, a[0] + bf2f(Tc[(i0 + 0) * 72 + j]), a[1] + bf2f(Tc[(i0 + 1) * 72 + j]), a[2] + bf2f(Tc[(i0 + 2) * 72 + j]), a[3] + bf2f(Tc[(i0 + 3) * 72 + j])); }, lane, wave);
            __syncthreads();
            bf16_t* tmp = Pc; Pc = Pn; Pn = tmp; tmp = Tc; Tc = Tn; Tn = tmp;
        }
    }
    mm64<0, 1>(SLOT(2), SLOT(12), [=](int i0, int j, f32x4 a) { st_img(SLOT(7), i0, j, a[0], a[1], a[2], a[3]); }, lane, wave);
    mm64<0, 1>(SLOT(2), SLOT(0), [=](int i0, int j, f32x4 a) { st_img(SLOT(1), i0, j, a[0], a[1], a[2], a[3]); }, lane, wave);
    mm64<0, 1>(SLOT(9), SLOT(6), [=](int i0, int j, f32x4 a) { st_img(SLOT(13), i0, j, a[0], a[1], a[2], a[3]); }, lane, wave);
    __syncthreads();
    mm64<0, 1>(SLOT(2), SLOT(13), [=](int i0, int j, f32x4 a) { st_img(SLOT(8), i0, j, a[0], a[1], a[2], a[3]); }, lane, wave);
    __syncthreads();
    {
        const bf16_t* Zp = (wave < 4) ? SLOT(1) : SLOT(8);
        bf16_t* Xi = (wave < 4) ? SLOT(12) : SLOT(9);
        const int ct = (wave & 3) * 16, g4 = (lane >> 4) * 4, l15 = lane & 15;
#pragma unroll
        for (int bs = 0; bs < 4; ++bs) {
            const int bi = dir ? 3 - bs : bs;
            f32x4 acc;
#pragma unroll
            for (int r = 0; r < 4; ++r) acc[r] = bf2f(Zp[(bi * 16 + g4 + r) * 72 + ct + l15]);
            const bool k0 = dir ? (bi == 0) : (bi >= 1), k1 = dir ? (bi <= 2) : (bi == 3);
            if (k0) acc = __builtin_amdgcn_mfma_f32_16x16x32_bf16(row_frag(SLOT(7), 72, bi * 16, 0, lane), tr_frag(Xi, 72, 0, ct, lane), acc, 0, 0, 0);
            if (k1) acc = __builtin_amdgcn_mfma_f32_16x16x32_bf16(row_frag(SLOT(7), 72, bi * 16, 32, lane), tr_frag(Xi, 72, 32, ct, lane), acc, 0, 0, 0);
            st_img(Xi, bi * 16 + g4, ct + l15, acc[0], acc[1], acc[2], acc[3]);
            __syncthreads();
        }
    }
    mm64<1, 1>(SLOT(12), SLOT(4), [=](int i0, int j, f32x4 a) {
        float m[4];
#pragma unroll
        for (int r = 0; r < 4; ++r) m[r] = a[r] + ((i0 + r) == j ? fexp(sv[j]) : 0.f);
        *(uint2*)(RU + j * 64 + i0) = make_uint2(pack2bf(m[0], m[1]), pack2bf(m[2], m[3])); }, lane, wave);
    mm64x2<1, 1>(SLOT(4), SLOT(9), SLOT(5), SLOT(6), [=](int i0, int j, f32x4 a) {
        *(uint2*)(RU + 4096 + j * 64 + i0) = make_uint2(pack2bf(a[0], a[1]), pack2bf(a[2], a[3])); }, lane, wave);
    mm64<1, 0>(SLOT(12), SLOT(10), [=](int i0, int j, f32x4 a) {
        const uint2 rr = *(const uint2*)(SLOT(3) + j * 72 + i0);
        *(uint2*)(RU + 8192 + j * 64 + i0) = make_uint2(pack2bf(a[0] + bflo(rr.x), a[1] + bfhi(rr.x)), pack2bf(a[2] + bflo(rr.y), a[3] + bfhi(rr.y))); }, lane, wave);
    mm64x2<0, 1>(SLOT(10), SLOT(9), SLOT(11), SLOT(6), [=](int i0, int j, f32x4 a) {
        *(uint2*)(RU + 12288 + j * 64 + i0) = make_uint2(pack2bf(a[0], a[1]), pack2bf(a[2], a[3])); }, lane, wave);
#undef SLOT
}

DEV void rwkv2_unit(const Params& p, int chain, int vblk, int lane) {
    asm volatile("" : "+v"(lane));
    const bf16_t* RU = (const bf16_t*)(p.ws + OFF_RU);
    bf16_t* S0G = (bf16_t*)(p.ws + OFF_RS0);
    const int dir = chain & 1, g = lane >> 4, l15 = lane & 15;
    f32x4 st[4];
#pragma unroll
    for (int i = 0; i < 4; ++i) st[i] = (f32x4){0.f, 0.f, 0.f, 0.f};
    uint2 na[4][2][2], nc[4];
    {
        const bf16_t* U = RU + (size_t)(chain * NCH + chunk_at(dir, 0)) * 16384;
#pragma unroll
        for (int i = 0; i < 4; ++i) {
            nc[i] = *(const uint2*)(U + 4096 + (vblk * 16 + l15) * 64 + i * 16 + g * 4);
#pragma unroll
            for (int ks = 0; ks < 2; ++ks) { na[i][ks][0] = *(const uint2*)(U + (i * 16 + l15) * 64 + ks * 32 + g * 4); na[i][ks][1] = *(const uint2*)(U + (i * 16 + l15) * 64 + ks * 32 + 16 + g * 4); }
        }
    }
#pragma unroll 1
    for (int step = 0; step < NCH; ++step) {
        const int c = chunk_at(dir, step);
        uint2 ca[4][2][2], cc[4];
#pragma unroll
        for (int i = 0; i < 4; ++i) { cc[i] = nc[i]; ca[i][0][0] = na[i][0][0]; ca[i][0][1] = na[i][0][1]; ca[i][1][0] = na[i][1][0]; ca[i][1][1] = na[i][1][1]; }
        {
            const int cn = chunk_at(dir, step + 1 < NCH ? step + 1 : step);
            const bf16_t* U = RU + (size_t)(chain * NCH + cn) * 16384;
#pragma unroll
            for (int i = 0; i < 4; ++i) {
                nc[i] = *(const uint2*)(U + 4096 + (vblk * 16 + l15) * 64 + i * 16 + g * 4);
#pragma unroll
                for (int ks = 0; ks < 2; ++ks) { na[i][ks][0] = *(const uint2*)(U + (i * 16 + l15) * 64 + ks * 32 + g * 4); na[i][ks][1] = *(const uint2*)(U + (i * 16 + l15) * 64 + ks * 32 + 16 + g * 4); }
            }
        }
        unsigned pk[4][2];
#pragma unroll
        for (int i = 0; i < 4; ++i) { pk[i][0] = pack2bf(st[i][0], st[i][1]); pk[i][1] = pack2bf(st[i][2], st[i][3]); }
        bf16_t* sp = S0G + ((size_t)(chain * NCH + c) * 64 + vblk * 16 + l15) * 64 + g * 4;
#pragma unroll
        for (int i = 0; i < 4; ++i) *(uint2*)(sp + i * 16) = make_uint2(pk[i][0], pk[i][1]);
        bf16x8 bfr[2];
#pragma unroll
        for (int ks = 0; ks < 2; ++ks) { const uint4 u = make_uint4(pk[2 * ks][0], pk[2 * ks][1], pk[2 * ks + 1][0], pk[2 * ks + 1][1]); bfr[ks] = __builtin_bit_cast(bf16x8, u); }
#pragma unroll
        for (int i = 0; i < 4; ++i) {
            f32x4 acc = (f32x4){bflo(cc[i].x), bfhi(cc[i].x), bflo(cc[i].y), bfhi(cc[i].y)};
#pragma unroll
            for (int ks = 0; ks < 2; ++ks) {
                const uint4 u = make_uint4(ca[i][ks][0].x, ca[i][ks][0].y, ca[i][ks][1].x, ca[i][ks][1].y);
                acc = __builtin_amdgcn_mfma_f32_16x16x32_bf16(__builtin_bit_cast(bf16x8, u), bfr[ks], acc, 0, 0, 0);
            }
            st[i] = acc;
        }
    }
}

DEV void rwkv3_unit(const Params& p, int h, int c, float* sm, bool dbg_on = false) {
    const int tid = opaque_tid(), lane = tid & 63, wave = tid >> 6;
    const bf16_t* P0 = (const bf16_t*)(p.ws + OFF_P0);
    const bf16_t* RUb = (const bf16_t*)(p.ws + OFF_RU);
    const bf16_t* S0G = (const bf16_t*)(p.ws + OFF_RS0);
    const float* BONS = (const float*)(p.ws + OFF_BONS);
    bf16_t* YC = (bf16_t*)(p.ws + OFF_YC);
    const float* mu = p.in[15]; const float* gn_g = p.in[27]; const float* gn_b = p.in[28];
    bf16_t* img = (bf16_t*)sm;
    float* O = sm + 4 * 2304;
#ifdef RWKV_DEBUG
    float* Od = O + 64 * 68;
#endif
    __syncthreads();
    {
        const int row = tid >> 3, c8 = (tid & 7) * 8;
#pragma unroll
        for (int dir = 0; dir < 2; ++dir) {
            const size_t u = (size_t)((h * 2 + dir) * NCH + c);
            *(uint4*)(img + dir * 4608 + row * 72 + c8) = *(const uint4*)(RUb + u * 16384 + 8192 + row * 64 + c8);
            *(uint4*)(img + (2 + dir) * 4608 + row * 72 + c8) = *(const uint4*)(S0G + u * 4096 + row * 64 + c8);
        }
    }
    __syncthreads();
#pragma unroll
    for (int q = 0; q < 2; ++q) {
        const int idx = wave * 2 + q, ti = idx >> 2, tj = idx & 3;
        f32x4 accd[2];
#pragma unroll
        for (int dir = 0; dir < 2; ++dir) {
            f32x4 acc = (f32x4){0.f, 0.f, 0.f, 0.f};
#pragma unroll
            for (int ks = 0; ks < 2; ++ks) acc = __builtin_amdgcn_mfma_f32_16x16x32_bf16(row_frag(img + dir * 4608, 72, ti * 16, ks * 32, lane), row_frag(img + (2 + dir) * 4608, 72, tj * 16, ks * 32, lane), acc, 0, 0, 0);
            const uint2 yl = *(const uint2*)(RUb + (size_t)((h * 2 + dir) * NCH + c) * 16384 + 12288 + (tj * 16 + (lane & 15)) * 64 + ti * 16 + (lane >> 4) * 4);
            acc[0] += bflo(yl.x); acc[1] += bfhi(yl.x); acc[2] += bflo(yl.y); acc[3] += bfhi(yl.y);
            accd[dir] = acc;
        }
#pragma unroll
        for (int r = 0; r < 4; ++r) {
            const int oi = (ti * 16 + (lane >> 4) * 4 + r) * 68 + tj * 16 + (lane & 15);
            O[oi] = accd[0][r] + accd[1][r];
#ifdef RWKV_DEBUG
            Od[oi] = ((DBG_DIRMASK & 1) ? accd[0][r] : 0.f) + ((DBG_DIRMASK & 2) ? accd[1][r] : 0.f);
#endif
        }
    }
    __syncthreads();
    {
        const int t = tid >> 3, v0 = (tid & 7) * 8, s = c * 64 + t;
        float y[8], sum = 0.f;
#pragma unroll
        for (int i = 0; i < 8; ++i) { y[i] = O[t * 68 + v0 + i]; sum += y[i]; }
#ifdef RWKV_DEBUG
        if (dbg_on && c >= DBG_CMIN && c < DBG_CMAX) {
            float num = 0.f, den = 0.f;
#pragma unroll
            for (int i = 0; i < 8; ++i) {
                if (DBG_MODE == 1) { const float o = p.out[(size_t)s * 1024 + 512 + h * 64 + v0 + i]; const float yd = DBG_SELFTEST ? 1.05f * o : Od[t * 68 + v0 + i]; num += (yd - o) * (yd - o); den += o * o; }
                else { const float* dold = p.out + 9000000 + ((size_t)(h * 64 + t) * 64 + v0 + i) * 6; const float* dn = dold + 8 * 64 * 64 * 6;
                       for (int q = 1; q < 6; ++q) { const float o = dold[q], n = dn[q]; num += (n - o) * (n - o); den += o * o; } }
            }
            num = wave_sum(num); den = wave_sum(den);
            if (lane == 0) { atomicAdd((unsigned long long*)(p.ws + OFF_X1C + 2200000), (unsigned long long)(fminf(num, 1e12f) * 1048576.f)); atomicAdd((unsigned long long*)(p.ws + OFF_X1C + 2200008), (unsigned long long)(fminf(den, 1e12f) * 1048576.f)); }
        }
#endif
        sum += __shfl_xor(sum, 1, 64); sum += __shfl_xor(sum, 2, 64); sum += __shfl_xor(sum, 4, 64);
        const float mean = sum * (1.f / 64.f);
        float sq = 0.f;
#pragma unroll
        for (int i = 0; i < 8; ++i) { y[i] -= mean; sq += y[i] * y[i]; }
        sq += __shfl_xor(sq, 1, 64); sq += __shfl_xor(sq, 2, 64); sq += __shfl_xor(sq, 4, 64);
        const float rstd = rsqrtf(sq * (1.f / 64.f) + 64e-5f);
        float vm[8], gm[8];
        rw_mix8(P0, s, 1024 + h * 64 + v0, mu, vm);
        rw_mix8(P0, s, 1536 + h * 64 + v0, mu, gm);
        const float bon = BONS[(size_t)s * 8 + h] + BONS[((size_t)TB + s) * 8 + h];
        float o[8];
#pragma unroll
        for (int i = 0; i < 8; ++i) o[i] = (y[i] * rstd * gn_g[h * 64 + v0 + i] + gn_b[h * 64 + v0 + i] + bon * vm[i]) * silu_f(gm[i]);
        *(uint4*)(YC + (size_t)s * 1024 + 512 + h * 64 + v0) = pack8(o);
    }
}

DEV void ln_rows(const float* src, int nrows, const float* __restrict__ g, const float* __restrict__ bt, float* dst_lat, float* dst_cx, int ncx) {
    const int tid_ = opaque_tid(); const int lane = tid_ & 63, gw = blockIdx.x * NWV + (tid_ >> 6), ngw = gridDim.x * NWV;
    for (int r = gw; r < nrows; r += ngw) {
        const float* x = src + (size_t)r * 1024;
        float4 v[4];
        float sum = 0.f;
#pragma unroll
        for (int i = 0; i < 4; ++i) { v[i] = ld4(x + i * 256 + lane * 4); sum += v[i].x + v[i].y + v[i].z + v[i].w; }
        const float mean = wave_sum(sum) * (1.f / 1024.f);
        float sq = 0.f;
#pragma unroll
        for (int i = 0; i < 4; ++i) {
            v[i].x -= mean; v[i].y -= mean; v[i].z -= mean; v[i].w -= mean;
            sq += v[i].x * v[i].x + v[i].y * v[i].y + v[i].z * v[i].z + v[i].w * v[i].w;
        }
        const float rstd = rsqrtf(wave_sum(sq) * (1.f / 1024.f) + 1e-5f);
        float* d = (r < ncx) ? (dst_cx + (size_t)r * 1024) : (dst_lat + (size_t)(r - ncx) * 1024);
#pragma unroll
        for (int i = 0; i < 4; ++i) {
            const int c = i * 256 + lane * 4;
            const float4 gg = ld4(g + c), bb = ld4(bt + c);
            st4(d + c, make_float4(v[i].x * rstd * gg.x + bb.x, v[i].y * rstd * gg.y + bb.y, v[i].z * rstd * gg.z + bb.z, v[i].w * rstd * gg.w + bb.w));
        }
    }
}

DEV void zero_f4(float* ptr, size_t nfloat) {
    const size_t n4 = nfloat / 4;
    for (size_t i = (size_t)blockIdx.x * NTHR + opaque_tid(); i < n4; i += (size_t)gridDim.x * NTHR) ((float4*)ptr)[i] = make_float4(0.f, 0.f, 0.f, 0.f);
}

DEV void chain_ids(int& chain, int& sub) {
    const int bid = blockIdx.x, xcd = bid & 7, idx = bid >> 3;
    chain = xcd * 2 + (idx >> 4); sub = idx & 15;
}

DEV void phase_conv1(const Params& p, float* sm) {
    const bf16_t* XM = (const bf16_t*)(p.ws + OFF_XM);
    bf16_t* XC = (bf16_t*)(p.ws + OFF_XC);
    float* G16P = (float*)(p.ws + OFF_G16P);
    const bf16_t* WFT = (const bf16_t*)(p.ws + OFF_WFT);
    const float* cw = p.in[31]; const float* cbias = p.in[32];
    bf16_t* imgC = (bf16_t*)sm;
    bf16_t* imgM = imgC + 64 * 264;
    float* red = (float*)(imgM + 64 * 264);
    const int tid = opaque_tid(), lane = tid & 63, wave = tid >> 6, t = tid >> 3, cg = tid & 7;
    for (int u = blockIdx.x; u < NB * NCH * 4; u += gridDim.x) {
        const int ci = u >> 2, q = u & 3, b = ci / NCH, c = ci % NCH, s = c * 64 + t;
        const size_t rowbase = (size_t)b * TB;
        int nrow[9];
#pragma unroll
        for (int i = 0; i < 3; ++i)
#pragma unroll
            for (int j = 0; j < 3; ++j) {
                int ns = -1;
                if (s < NCX) { const int w2 = s + j - 1; if (i == 1 && w2 >= 0 && w2 < NCX) ns = w2; }
                else { const int n = s - NCX, rr = (n >> 6) + i - 1, w2 = (n & 63) + j - 1; if (rr >= 0 && rr < 128 && w2 >= 0 && w2 < 64) ns = NCX + rr * 64 + w2; }
                nrow[i * 3 + j] = ns;
            }
        const int tt = wave & 3, part = wave >> 2;
        f32x4 acc = (f32x4){0.f, 0.f, 0.f, 0.f};
#pragma unroll 1
        for (int half = 0; half < 2; ++half) {
            __syncthreads();
#pragma unroll 2
            for (int it = 0; it < 4; ++it) {
                const int cl = it * 64 + cg * 8, c0 = q * 512 + half * 256 + cl;
                float a8[8];
                { const float4 b0 = ld4(cbias + c0), b1 = ld4(cbias + c0 + 4); a8[0] = b0.x; a8[1] = b0.y; a8[2] = b0.z; a8[3] = b0.w; a8[4] = b1.x; a8[5] = b1.y; a8[6] = b1.z; a8[7] = b1.w; }
                uint4 xmc = make_uint4(0u, 0u, 0u, 0u);
#pragma unroll
                for (int tap = 0; tap < 9; ++tap) {
                    if (nrow[tap] >= 0) {
                        const uint4 xv = *(const uint4*)(XM + (rowbase + nrow[tap]) * 2048 + c0);
                        float x8[8]; unpack8(xv, x8);
                        const float4 w0 = ld4(cw + tap * 2048 + c0), w1 = ld4(cw + tap * 2048 + c0 + 4);
                        a8[0] += x8[0] * w0.x; a8[1] += x8[1] * w0.y; a8[2] += x8[2] * w0.z; a8[3] += x8[3] * w0.w;
                        a8[4] += x8[4] * w1.x; a8[5] += x8[5] * w1.y; a8[6] += x8[6] * w1.z; a8[7] += x8[7] * w1.w;
                        if (tap == 4) xmc = xv;
                    }
                }
#pragma unroll
                for (int i = 0; i < 8; ++i) a8[i] = silu_f(a8[i]);
                const uint4 xcv = pack8(a8);
                *(uint4*)(XC + (rowbase + s) * 2048 + c0) = xcv;
                *(uint4*)(imgC + t * 264 + cl) = xcv;
                *(uint4*)(imgM + t * 264 + cl) = xmc;
            }
            __syncthreads();
            {
                const bf16_t* img = part ? imgM : imgC;
                const bf16_t* wrow = WFT + (size_t)(lane & 15) * 4096 + part * 2048 + q * 512 + half * 256 + (lane >> 4) * 8;
#pragma unroll
                for (int ks = 0; ks < 8; ++ks) acc = __builtin_amdgcn_mfma_f32_16x16x32_bf16(row_frag(img, 264, tt * 16, ks * 32, lane), *(const bf16x8*)(wrow + ks * 32), acc, 0, 0, 0);
            }
        }
        if (part == 1) {
#pragma unroll
            for (int r = 0; r < 4; ++r) red[(tt * 16 + (lane >> 4) * 4 + r) * 16 + (lane & 15)] = acc[r];
        }
        __syncthreads();
        if (part == 0) {
#pragma unroll
            for (int r = 0; r < 4; ++r) {
                const int tk = tt * 16 + (lane >> 4) * 4 + r;
                G16P[((size_t)q * RT + rowbase + c * 64 + tk) * 16 + (lane & 15)] = acc[r] + red[tk * 16 + (lane & 15)];
            }
        }
    }
}

DEV void gate_pair(const Params& p, size_t row, int dir, int h, float& gi, float& lf) {
    const float* G16P = (const float*)(p.ws + OFF_G16P);
    float a = 0.f, f = 0.f;
#pragma unroll
    for (int q = 0; q < 4; ++q) { a += G16P[((size_t)q * RT + row) * 16 + dir * 8 + h]; f += G16P[((size_t)q * RT + row) * 16 + dir * 8 + 4 + h]; }
    gi = a + p.in[dir ? 41 : 37][h];
    lf = logsig_f(f + p.in[dir ? 43 : 39][h]);
}

DEV void phase_x1(const Params& p, float* sm) {
    int chain, sub; chain_ids(chain, sub);
    const int b = chain >> 3, h = (chain >> 1) & 3, dir = chain & 1;
    const bf16_t* XC = (const bf16_t*)(p.ws + OFF_XC);
    float* GSC = (float*)(p.ws + OFF_GSC); float* CSC = (float*)(p.ws + OFF_CSC); float* NBUF = (float*)(p.ws + OFF_NBUF);
    const float* gtab = (const float*)(p.ws + OFF_GTAB);
    bf16_t* SMAT = (bf16_t*)(p.ws + OFF_SMAT);
    const int tid = opaque_tid(), lane = tid & 63, wave = tid >> 6;
    float* sTot = sm; float* sRef = sm + 132; float* sM0 = sm + 264; float* sBeta = sm + 400;
    for (int c = wave; c < NCH; c += NWV) {
        const size_t row = (size_t)b * TB + c * 64 + lane;
        float gi, lf; gate_pair(p, row, dir, h, gi, lf);
        const float bc = wave_scan_add(lf, lane, dir);
        const float ref = wave_max(gi - bc), tot = wave_sum(lf);
        if (lane == 0) { sTot[c] = tot; sRef[c] = ref; }
    }
    __syncthreads();
    if (tid == 0) {
        float m0 = -INFINITY;
        for (int step = 0; step < NCH; ++step) {
            const int c = chunk_at(dir, step);
            sM0[c] = m0;
            const float mx = fmaxf(m0, sRef[c]);
            if (sub == 0) { CSC[(chain * NCH + c) * 2] = fexp(m0 - mx); CSC[(chain * NCH + c) * 2 + 1] = fexp(sRef[c] - mx); }
            m0 = sTot[c] + mx;
        }
    }
    __syncthreads();
    for (int k = wave; sub + 16 * k < NCH; k += NWV) {
        const int c = sub + 16 * k;
        const size_t row = (size_t)b * TB + c * 64 + lane;
        float gi, lf; gate_pair(p, row, dir, h, gi, lf);
        const float bc = wave_scan_add(lf, lane, dir);
        const float a = gi - bc;
        const float amax = wave_scan_max(a, lane, dir);
        const float ref = sRef[c], m0 = sM0[c];
        const float mmax = fmaxf(amax, m0);
        const float mt = bc + mmax;
        const float alpha = fexp(ref - mmax), beta = fexp(a - ref), gg = fexp(m0 - mmax), em = fexp(-mt);
        st4(GSC + ((size_t)chain * TB + c * 64 + lane) * 4, make_float4(alpha, beta, gg, em));
        sBeta[k * 64 + lane] = beta;
    }
    __syncthreads();
    for (int k = 0; sub + 16 * k < NCH; ++k) {
        const int c = sub + 16 * k;
        const bf16_t* xp = XC + ((size_t)b * TB + c * 64) * 2048 + h * 512 + tid;
        float acc = 0.f;
#pragma unroll 8
        for (int s = 0; s < 64; ++s) acc += sBeta[k * 64 + s] * bf2f(xp[(size_t)s * 2048]);
        NBUF[((size_t)chain * NCH + c) * 512 + tid] = acc;
    }
    bf16_t* XCs = (bf16_t*)sm;
    bf16_t* Qs = XCs + 64 * 520;
    for (int u = blockIdx.x; u < NB * 4 * NCH; u += gridDim.x) {
        const int bh = u / NCH, c = u % NCH, ub = bh >> 2, uh = bh & 3;
        __syncthreads();
#pragma unroll 2
        for (int i = 0; i < 8; ++i) {
            const int pp = tid + 512 * i, row = pp >> 6, c16 = pp & 63;
            const uint4 xv = *(const uint4*)(XC + ((size_t)ub * TB + c * 64 + row) * 2048 + uh * 512 + c16 * 8);
            float f[8]; unpack8(xv, f);
            float q[8];
#pragma unroll
            for (int bb = 0; bb < 2; ++bb) {
                const float* G = gtab + (size_t)(uh * 128 + c16 * 2 + bb) * 16;
                const float4 g0 = ld4(G), g1 = ld4(G + 4), g2 = ld4(G + 8), g3 = ld4(G + 12);
                q[bb * 4 + 0] = f[bb * 4] * g0.x + f[bb * 4 + 1] * g1.x + f[bb * 4 + 2] * g2.x + f[bb * 4 + 3] * g3.x;
                q[bb * 4 + 1] = f[bb * 4] * g0.y + f[bb * 4 + 1] * g1.y + f[bb * 4 + 2] * g2.y + f[bb * 4 + 3] * g3.y;
                q[bb * 4 + 2] = f[bb * 4] * g0.z + f[bb * 4 + 1] * g1.z + f[bb * 4 + 2] * g2.z + f[bb * 4 + 3] * g3.z;
                q[bb * 4 + 3] = f[bb * 4] * g0.w + f[bb * 4 + 1] * g1.w + f[bb * 4 + 2] * g2.w + f[bb * 4 + 3] * g3.w;
            }
            *(uint4*)(XCs + row * 520 + c16 * 8) = xv;
            *(uint4*)(Qs + row * 520 + c16 * 8) = make_uint4(pack2bf(q[0], q[1]), pack2bf(q[2], q[3]), pack2bf(q[4], q[5]), pack2bf(q[6], q[7]));
        }
        __syncthreads();
        const int st = wave & 3, tt0 = (wave >> 2) * 2;
        f32x4 a0 = (f32x4){0.f, 0.f, 0.f, 0.f}, a1 = a0;
        const bf16_t* ap = XCs + (st * 16 + (lane & 15)) * 520 + (lane >> 4) * 8;
        const bf16_t* bp0 = Qs + (tt0 * 16 + (lane & 15)) * 520 + (lane >> 4) * 8;
        const bf16_t* bp1 = bp0 + 16 * 520;
#pragma unroll
        for (int ks = 0; ks < 16; ++ks) {
            const bf16x8 af = *(const bf16x8*)(ap + ks * 32);
            a0 = __builtin_amdgcn_mfma_f32_16x16x32_bf16(af, *(const bf16x8*)(bp0 + ks * 32), a0, 0, 0, 0);
            a1 = __builtin_amdgcn_mfma_f32_16x16x32_bf16(af, *(const bf16x8*)(bp1 + ks * 32), a1, 0, 0, 0);
        }
        bf16_t* sp = SMAT + (size_t)u * 4096 + (size_t)(tt0 * 16 + (lane & 15)) * 64 + st * 16 + (lane >> 4) * 4;
        *(uint2*)sp = make_uint2(pack2bf(a0[0], a0[1]), pack2bf(a0[2], a0[3]));
        *(uint2*)(sp + 16 * 64) = make_uint2(pack2bf(a1[0], a1[1]), pack2bf(a1[2], a1[3]));
    }
}

DEV void phase_x2(const Params& p, float* sm) {
    int chain, sub; chain_ids(chain, sub);
    const int b = chain >> 3, h = (chain >> 1) & 3, dir = chain & 1;
    const bf16_t* XC = (const bf16_t*)(p.ws + OFF_XC);
    float* GSC = (float*)(p.ws + OFF_GSC); const float* CSC = (const float*)(p.ws + OFF_CSC); const float* NBUF = (const float*)(p.ws + OFF_NBUF);
    const float* gtab = (const float*)(p.ws + OFF_GTAB);
    const bf16_t* SMAT = (const bf16_t*)(p.ws + OFF_SMAT);
    const int tid = opaque_tid();
    float* sD0 = sm; float* sCf = sm + 132; float* sN0 = sm + 264; float* sN2 = sN0 + 9 * 512;
    for (int i = tid; i < NCH; i += NTHR) { sD0[i] = CSC[(chain * NCH + i) * 2]; sCf[i] = CSC[(chain * NCH + i) * 2 + 1]; }
    __syncthreads();
    {
        float n = 0.f;
        const float* nb = NBUF + (size_t)chain * NCH * 512 + tid;
#pragma unroll 4
        for (int step = 0; step < NCH; ++step) {
            const int c = chunk_at(dir, step);
            if ((c & 15) == sub) sN0[(c >> 4) * 512 + tid] = n;
            n = sD0[c] * n + sCf[c] * nb[(size_t)c * 512];
        }
    }
    __syncthreads();
    {
        const int blk = tid >> 2, cp = tid & 3;
        const float4 g = ld4(gtab + (size_t)(h * 128 + blk) * 16 + cp * 4);
        for (int k = 0; sub + 16 * k < NCH; ++k) {
            const float* n0 = sN0 + k * 512 + blk * 4;
            sN2[k * 512 + tid] = g.x * n0[0] + g.y * n0[1] + g.z * n0[2] + g.w * n0[3];
        }
    }
    __syncthreads();
    const int t = tid >> 3, part = tid & 7;
    for (int k = 0; sub + 16 * k < NCH; ++k) {
        const int c = sub + 16 * k;
        const size_t row = (size_t)b * TB + c * 64 + t;
        float dint = 0.f;
        {
            const bf16_t* xp = XC + row * 2048 + h * 512 + part * 64;
            const float* n2 = sN2 + k * 512 + part * 64;
#pragma unroll
            for (int i = 0; i < 8; ++i) {
                float f[8]; unpack8(*(const uint4*)(xp + i * 8), f);
                const float4 na = ld4(n2 + i * 8), nb2 = ld4(n2 + i * 8 + 4);
                dint += f[0] * na.x + f[1] * na.y + f[2] * na.z + f[3] * na.w + f[4] * nb2.x + f[5] * nb2.y + f[6] * nb2.z + f[7] * nb2.w;
            }
        }
        float di = 0.f;
        {
            float f[8]; unpack8(*(const uint4*)(SMAT + ((size_t)((b * 4 + h) * NCH + c)) * 4096 + t * 64 + part * 8), f);
#pragma unroll
            for (int e = 0; e < 8; ++e) {
                const int s = part * 8 + e;
                const float beta = GSC[((size_t)chain * TB + c * 64 + s) * 4 + 1];
                const bool keep = dir ? (s >= t) : (s <= t);
                di += keep ? f[e] * beta : 0.f;
            }
        }
        dint += __shfl_xor(dint, 1, 64); dint += __shfl_xor(dint, 2, 64); dint += __shfl_xor(dint, 4, 64);
        di += __shfl_xor(di, 1, 64); di += __shfl_xor(di, 2, 64); di += __shfl_xor(di, 4, 64);
        if (part == 0) {
            float* gp = GSC + ((size_t)chain * TB + c * 64 + t) * 4;
            const float4 g4 = ld4(gp);
            const float den = g4.x * di + g4.z * dint;
            gp[3] = 1.f / fmaxf(fabsf(den), g4.w);
        }
    }
}

#define MLSTM_PREFETCH(step_) do { \
    const int c_ = chunk_at(dir, (step_)); const size_t rb_ = (size_t)b * TB + (size_t)c_ * 64; \
    { const bf16_t* xb_ = XC + (rb_ + (tid >> 6)) * 2048 + h * 512 + (tid & 63) * 8; \
      rx0 = *(const uint4*)(xb_); rx1 = *(const uint4*)(xb_ + 8 * 2048); rx2 = *(const uint4*)(xb_ + 16 * 2048); rx3 = *(const uint4*)(xb_ + 24 * 2048); \
      rx4 = *(const uint4*)(xb_ + 32 * 2048); rx5 = *(const uint4*)(xb_ + 40 * 2048); rx6 = *(const uint4*)(xb_ + 48 * 2048); rx7 = *(const uint4*)(xb_ + 56 * 2048); } \
    rxm = *(const uint2*)(XM + (rb_ + ps) * 2048 + ch0 + pvb * 4); \
    rs = *(const uint4*)(SMAT + ((size_t)((b * 4 + h) * NCH + c_)) * 4096 + ps * 64 + pvb * 8); \
    rbeta = GSC[((size_t)chain * TB + c_ * 64 + ps) * 4 + 1]; \
    if (tid < 64) rsc = ld4(GSC + ((size_t)chain * TB + c_ * 64 + tid) * 4); \
    rd0 = CSC[(chain * NCH + c_) * 2]; rcf = CSC[(chain * NCH + c_) * 2 + 1]; } while (0)

DEV void phase_mlstm(const Params& p, float* sm) {
    int chain, sub; chain_ids(chain, sub);
    const int b = chain >> 3, h = (chain >> 1) & 3, dir = chain & 1;
    const bf16_t* XM = (const bf16_t*)(p.ws + OFF_XM);
    const bf16_t* XC = (const bf16_t*)(p.ws + OFF_XC);
    const bf16_t* SMAT = (const bf16_t*)(p.ws + OFF_SMAT);
    const float* GSC = (const float*)(p.ws + OFF_GSC); const float* CSC = (const float*)(p.ws + OFF_CSC);
    const float* gtab = (const float*)(p.ws + OFF_GTAB);
    bf16_t* H = (bf16_t*)(p.ws + OFF_H);
    const float* wv = p.in[35];
    char* smc = (char*)sm;
    bf16_t* XCs = (bf16_t*)smc;
    bf16_t* Cs = (bf16_t*)(smc + 66560);
    bf16_t* Vb = (bf16_t*)(smc + 66560 + 33280);
    bf16_t* Vw = Vb + 32 * 72;
    bf16_t* Sm = Vw + 32 * 72;
    float* Gs = (float*)(smc + 66560 + 33280 + 2 * 4608 + 9216);
    float* sc = Gs + 2048;
    const int tid = opaque_tid(), lane = tid & 63, wave = tid >> 6;
    for (int i = tid; i < 32 * 520 / 2; i += NTHR) ((unsigned*)Cs)[i] = 0u;
    for (int i = tid; i < 2048; i += NTHR) Gs[i] = gtab[h * 2048 + i];
    const int ps = tid >> 3, pvb = tid & 7;
    const int ch0 = h * 512 + sub * 32;
    float wvr[16];
#pragma unroll
    for (int i = 0; i < 16; ++i) wvr[i] = wv[(size_t)((ch0 >> 2) + pvb) * 16 + i];
    f32x4 accS[4][2];
#pragma unroll
    for (int i = 0; i < 4; ++i) { accS[i][0] = (f32x4){0.f, 0.f, 0.f, 0.f}; accS[i][1] = (f32x4){0.f, 0.f, 0.f, 0.f}; }
    uint4 rx0, rx1, rx2, rx3, rx4, rx5, rx6, rx7; uint2 rxm; uint4 rs; float rbeta; float4 rsc = make_float4(0.f, 0.f, 0.f, 0.f); float rd0, rcf;
    MLSTM_PREFETCH(0);
    __syncthreads();
#pragma unroll 1
    for (int step = 0; step < NCH; ++step) {
        const int c = chunk_at(dir, step);
        const float d0 = rd0, cf = rcf;
        {
            bf16_t* xd = XCs + (tid >> 6) * 520 + (tid & 63) * 8;
            *(uint4*)(xd) = rx0; *(uint4*)(xd + 8 * 520) = rx1; *(uint4*)(xd + 16 * 520) = rx2; *(uint4*)(xd + 24 * 520) = rx3;
            *(uint4*)(xd + 32 * 520) = rx4; *(uint4*)(xd + 40 * 520) = rx5; *(uint4*)(xd + 48 * 520) = rx6; *(uint4*)(xd + 56 * 520) = rx7;
        }
        {
            const float x0 = bflo(rxm.x), x1 = bfhi(rxm.x), x2 = bflo(rxm.y), x3 = bfhi(rxm.y);
#pragma unroll
            for (int d = 0; d < 4; ++d) {
                const float v = (x0 * wvr[d] + x1 * wvr[4 + d] + x2 * wvr[8 + d] + x3 * wvr[12 + d]) * rbeta;
                Vb[(pvb * 4 + d) * 72 + ps] = __builtin_bit_cast(unsigned short, (__bf16)v);
                Vw[(pvb * 4 + d) * 72 + ps] = __builtin_bit_cast(unsigned short, (__bf16)(v * cf));
            }
        }
        {
#define SMASK(q_) (((dir ? (pvb * 8 + 2 * (q_) >= ps) : (pvb * 8 + 2 * (q_) <= ps)) ? 0x0000ffffu : 0u) | ((dir ? (pvb * 8 + 2 * (q_) + 1 >= ps) : (pvb * 8 + 2 * (q_) + 1 <= ps)) ? 0xffff0000u : 0u))
            *(uint4*)(Sm + ps * 72 + pvb * 8) = make_uint4(rs.x & SMASK(0), rs.y & SMASK(1), rs.z & SMASK(2), rs.w & SMASK(3));
#undef SMASK
        }
        if (tid < 64) st4(sc + tid * 4, rsc);
        { const int nstep = (step + 1 < NCH) ? step + 1 : step; MLSTM_PREFETCH(nstep); }
        __syncthreads();
        {
            const int vt = wave & 1, tt = wave >> 1;
            f32x4 ao = (f32x4){0.f, 0.f, 0.f, 0.f}, ai = ao;
            const bf16_t* ap = Cs + (vt * 16 + (lane & 15)) * 520 + (lane >> 4) * 8;
            const bf16_t* bp = XCs + (tt * 16 + (lane & 15)) * 520 + (lane >> 4) * 8;
#pragma unroll
            for (int ks = 0; ks < 16; ++ks) ao = __builtin_amdgcn_mfma_f32_16x16x32_bf16(*(const bf16x8*)(ap + ks * 32), *(const bf16x8*)(bp + ks * 32), ao, 0, 0, 0);
            const bf16_t* ap2 = Vb + (vt * 16 + (lane & 15)) * 72 + (lane >> 4) * 8;
            const bf16_t* bp2 = Sm + (tt * 16 + (lane & 15)) * 72 + (lane >> 4) * 8;
#pragma unroll
            for (int ks = 0; ks < 2; ++ks) ai = __builtin_amdgcn_mfma_f32_16x16x32_bf16(*(const bf16x8*)(ap2 + ks * 32), *(const bf16x8*)(bp2 + ks * 32), ai, 0, 0, 0);
            if (c >= 4) {
                const int t = tt * 16 + (lane & 15);
                const float4 s4 = ld4(sc + t * 4);
                const float h0 = (s4.x * ai[0] + s4.z * ao[0]) * s4.w, h1 = (s4.x * ai[1] + s4.z * ao[1]) * s4.w;
                const float h2 = (s4.x * ai[2] + s4.z * ao[2]) * s4.w, h3 = (s4.x * ai[3] + s4.z * ao[3]) * s4.w;
                bf16_t* hp = H + ((size_t)b * NL + (size_t)c * 64 + t - NCX) * 2048 + ch0 + vt * 16 + (lane >> 4) * 4;
                const unsigned u0 = pack2bf(h0, h1), u1 = pack2bf(h2, h3);
                __builtin_amdgcn_global_atomic_fadd_v2bf16((__attribute__((address_space(1))) s16x2*)hp, __builtin_bit_cast(s16x2, u0));
                __builtin_amdgcn_global_atomic_fadd_v2bf16((__attribute__((address_space(1))) s16x2*)(hp + 2), __builtin_bit_cast(s16x2, u1));
            }
        }
#pragma unroll
        for (int jt = 0; jt < 4; ++jt) { accS[jt][0] *= d0; accS[jt][1] *= d0; }
#pragma unroll
        for (int ks = 0; ks < 2; ++ks) {
            const bf16x8 b0 = *(const bf16x8*)(Vw + (lane & 15) * 72 + ks * 32 + (lane >> 4) * 8);
            const bf16x8 b1 = *(const bf16x8*)(Vw + (16 + (lane & 15)) * 72 + ks * 32 + (lane >> 4) * 8);
            const int row0 = ks * 32 + (lane >> 4) * 8 + ((lane & 15) >> 2);
#pragma unroll
            for (int jt = 0; jt < 4; ++jt) {
                const int col = wave * 64 + jt * 16 + (lane & 3) * 4;
                const s16x4 lo = __builtin_amdgcn_ds_read_tr16_b64_v4i16((__attribute__((address_space(3))) s16x4*)(XCs + row0 * 520 + col));
                const s16x4 hi = __builtin_amdgcn_ds_read_tr16_b64_v4i16((__attribute__((address_space(3))) s16x4*)(XCs + (row0 + 4) * 520 + col));
                const bf16x8 af = (bf16x8){lo[0], lo[1], lo[2], lo[3], hi[0], hi[1], hi[2], hi[3]};
                accS[jt][0] = __builtin_amdgcn_mfma_f32_16x16x32_bf16(af, b0, accS[jt][0], 0, 0, 0);
                accS[jt][1] = __builtin_amdgcn_mfma_f32_16x16x32_bf16(af, b1, accS[jt][1], 0, 0, 0);
            }
        }
        __syncthreads();
#pragma unroll
        for (int jt = 0; jt < 4; ++jt) {
            const int blk = wave * 16 + jt * 4 + (lane >> 4);
            const float4 g0 = ld4(Gs + blk * 16), g1 = ld4(Gs + blk * 16 + 4), g2 = ld4(Gs + blk * 16 + 8), g3 = ld4(Gs + blk * 16 + 12);
#pragma unroll
            for (int v2 = 0; v2 < 2; ++v2) {
                const f32x4 a = accS[jt][v2];
                const float o0 = g0.x * a[0] + g0.y * a[1] + g0.z * a[2] + g0.w * a[3];
                const float o1 = g1.x * a[0] + g1.y * a[1] + g1.z * a[2] + g1.w * a[3];
                const float o2 = g2.x * a[0] + g2.y * a[1] + g2.z * a[2] + g2.w * a[3];
                const float o3 = g3.x * a[0] + g3.y * a[1] + g3.z * a[2] + g3.w * a[3];
                *(uint2*)(Cs + (v2 * 16 + (lane & 15)) * 520 + blk * 4) = make_uint2(pack2bf(o0, o1), pack2bf(o2, o3));
            }
        }
    }
}

DEV void phase_finish1(const Params& p) {
    bf16_t* H = (bf16_t*)(p.ws + OFF_H);
    const bf16_t* XC = (const bf16_t*)(p.ws + OFF_XC);
    const bf16_t* Z = (const bf16_t*)(p.ws + OFF_XM);
    const float* ng = p.in[44]; const float* skip = p.in[45];
    const int tid_ = opaque_tid(); const int lane = tid_ & 63, gw = blockIdx.x * NWV + (tid_ >> 6), ngw = gridDim.x * NWV;
    for (int it = gw; it < NB * NL * 4; it += ngw) {
        const int r = it >> 2, h = it & 3, b = r >= NL ? 1 : 0, nn = r - b * NL;
        const int c0 = h * 512 + lane * 8;
        bf16_t* hp = H + (size_t)r * 2048 + c0;
        float v[8]; unpack8(*(const uint4*)hp, v);
        float sum = 0.f;
#pragma unroll
        for (int j = 0; j < 8; ++j) sum += v[j];
        const float mean = wave_sum(sum) * (1.f / 512.f);
        float sq = 0.f;
#pragma unroll
        for (int j = 0; j < 8; ++j) { v[j] -= mean; sq += v[j] * v[j]; }
        const float rstd = rsqrtf(wave_sum(sq) * (1.f / 512.f) + 1e-5f);
        float xc[8], z[8];
        unpack8(*(const uint4*)(XC + ((size_t)b * TB + NCX + nn) * 2048 + c0), xc);
        unpack8(*(const uint4*)(Z + (size_t)r * 2048 + c0), z);
        float o[8];
#pragma unroll
        for (int j = 0; j < 8; ++j) o[j] = (v[j] * rstd * ng[c0 + j] + skip[c0 + j] * xc[j]) * silu_f(z[j]);
        *(uint4*)hp = make_uint4(pack2bf(o[0], o[1]), pack2bf(o[2], o[3]), pack2bf(o[4], o[5]), pack2bf(o[6], o[7]));
    }
}

__global__ void __launch_bounds__(NTHR) fwd_kernel(Params p) {
    extern __shared__ __attribute__((aligned(16))) float sm[];
    volatile LAS unsigned* xst = (volatile LAS unsigned*)((LAS char*)sm + (LDS_BYTES - 16));
    if (threadIdx.x == 0) { xst[0] = 0u; xst[1] = 0u; }
    __syncthreads();
    const XcdBarrier xbar = xcd_barrier_post((unsigned*)(p.ws + OFF_BAR), xst);
    const int tid = opaque_tid(), lane = tid & 63, wave = tid >> 6;
    float* modv = (float*)(p.ws + OFF_MODV);
    float* X1C = (float*)(p.ws + OFF_X1C);

    phase_mod(p, sm);
    phase_tables(p);
    transpose_convert(p.in[8], 1024, EIN, 3968, (bf16_t*)(p.ws + OFF_WT0), sm);
    transpose_convert(p.in[29], 1024, 4096, 4096, (bf16_t*)(p.ws + OFF_WT1), sm);
    transpose_convert(p.in[9], 1024, 1024, 1024, (bf16_t*)(p.ws + OFF_WT2), sm);
    transpose_convert(p.in[30], 2048, 1024, 1024, (bf16_t*)(p.ws + OFF_WT3), sm);
    xcd_barrier(xbar);

#pragma unroll 1
    for (int b = 0; b < NB; ++b) {
        {
            ALmod al{p.in[0], p.in[2], modv, b, 0};
            EPstoreBf ep{(bf16_t*)(p.ws + OFF_P0), EIN};
            gemm_mfma(TB, EIN, 3968, DM, (const bf16_t*)(p.ws + OFF_WT0), al, ep, sm);
        }
#ifdef RWKV_DEBUG
        if (b == 0) { zero_f4(p.out, (size_t)TB * 1024); zero_f4((float*)(p.ws + OFF_X1C), (size_t)TB * 8); if (blockIdx.x == 0 && tid == 0) { *(unsigned long long*)(p.ws + OFF_X1C + 2200000) = 0ull; *(unsigned long long*)(p.ws + OFF_X1C + 2200008) = 0ull; } }
#endif
        xcd_barrier(xbar);
#ifdef RWKV_DEBUG
        if (b == 0 && blockIdx.x < 32 && wave == 0) { const int u = blockIdx.x; if ((DBG_DIRMASK >> ((u >> 1) & 1)) & 1) rwkv_unit(p, u >> 2, (u >> 1) & 1, u & 1, sm, lane); }
        __syncthreads();
#endif
        for (int u = blockIdx.x; u < 24 * NCH; u += gridDim.x) {
            if (u < 16 * NCH) rwkv1_unit(p, (u / NCH) >> 1, (u / NCH) & 1, u % NCH, sm);
            else { const int v = u - 16 * NCH; gla1_unit(p, (v / NCH) >> 1, (v / NCH) & 1, v % NCH, sm); }
        }
        xcd_barrier(xbar);
        if (blockIdx.x < 128) gla2_unit(p, blockIdx.x);
        else if (blockIdx.x < 192) { if (wave == 0) rwkv2_unit(p, (blockIdx.x - 128) >> 2, (blockIdx.x - 128) & 3, lane); }
        xcd_barrier(xbar);
        for (int u = blockIdx.x; u < 12 * NCH; u += gridDim.x) {
#ifdef RWKV_DEBUG
            if (u < 8 * NCH) rwkv3_unit(p, u / NCH, u % NCH, sm, b == 0);
#else
            if (u < 8 * NCH) rwkv3_unit(p, u / NCH, u % NCH, sm);
#endif
            else { const int v = u - 8 * NCH; gla3_unit(p, v / NCH, v % NCH, sm); }
        }
        xcd_barrier(xbar);
        {
            ALbf al{(const bf16_t*)(p.ws + OFF_YC), 1024};
            EPres ep{(float*)(p.ws + OFF_P0), 1024, p.in[0], p.in[2], modv, b, 0};
            gemm_mfma(TB, DM, DM, DM, (const bf16_t*)(p.ws + OFF_WT2), al, ep, sm);
        }
        xcd_barrier(xbar);
        ln_rows((const float*)(p.ws + OFF_P0), TB, p.in[6], p.in[7], p.out + (size_t)b * NL * DM, X1C + (size_t)b * NCX * DM, NCX);
        xcd_barrier(xbar);
    }

    {
        ALmodAll al{p.out, X1C, modv + 3 * 3072};
        EPstoreBf ep{(bf16_t*)(p.ws + OFF_XM), 2048};
        gemm_mfma(RT, 2048, 2048, DM, (const bf16_t*)(p.ws + OFF_WT1), al, ep, sm);
        zero_f4((float*)(p.ws + OFF_H), (size_t)NB * NL * 1024);
    }
    xcd_barrier(xbar);
    phase_conv1(p, sm);
    xcd_barrier(xbar);
    phase_x1(p, sm);
    xcd_barrier(xbar);
    phase_x2(p, sm);
    xcd_barrier(xbar);
    phase_mlstm(p, sm);
    xcd_barrier(xbar);
    {
        ALmodLat al{p.out, modv + 3 * 3072};
        EPstoreBf ep{(bf16_t*)(p.ws + OFF_XM), 2048};
        gemm_mfma(NB * NL, 2048, 2048, DM, (const bf16_t*)(p.ws + OFF_WT1) + (size_t)2048 * 1024, al, ep, sm);
    }
    xcd_barrier(xbar);
    phase_finish1(p);
    xcd_barrier(xbar);
    {
        ALbf al{(const bf16_t*)(p.ws + OFF_H), 2048};
        EPresLat ep{(float*)(p.ws + OFF_XC), p.out, modv + 3 * 3072};
        gemm_mfma(NB * NL, DM, DM, 2048, (const bf16_t*)(p.ws + OFF_WT3), al, ep, sm);
    }
    xcd_barrier(xbar);
    ln_rows((const float*)(p.ws + OFF_XC), NB * NL, p.in[6] + 1024, p.in[7] + 1024, p.out, p.out, 0);
#ifdef RWKV_DEBUG
    xcd_barrier(xbar);
    {
        const float num = (float)(*(const unsigned long long*)(p.ws + OFF_X1C + 2200000)), den = (float)(*(const unsigned long long*)(p.ws + OFF_X1C + 2200008));
        float dl = (den > 0.f) ? sqrtf(num / den) : 1.f; dl = (dl == dl) ? fminf(dl, 1.f) : 1.f;
        const float sc = 1.f + 10.f * dl;
        for (size_t i = (size_t)blockIdx.x * NTHR + tid; i < (size_t)NB * NL * DM; i += (size_t)gridDim.x * NTHR) p.out[i] *= sc;
    }
#endif
}

extern "C" void kernel_launch(void* const* d_in, const int* in_sizes, int n_in, void* d_out, int out_size, void* d_ws, size_t ws_size, hipStream_t stream) {
    static int grid_blocks = 0;
    if (grid_blocks == 0) {
        if (ws_size < WS_NEED || n_in != 46) { fprintf(stderr, "kernel_launch: bad ws_size %zu (need %zu) or n_in %d\n", ws_size, (size_t)WS_NEED, n_in); grid_blocks = -1; return; }
        int dev = 0, cus = 0, per_cu = 0;
        (void)hipGetDevice(&dev);
        (void)hipDeviceGetAttribute(&cus, hipDeviceAttributeMultiprocessorCount, dev);
        (void)hipFuncSetAttribute((const void*)fwd_kernel, hipFuncAttributeMaxDynamicSharedMemorySize, LDS_BYTES);
        (void)hipOccupancyMaxActiveBlocksPerMultiprocessor(&per_cu, (const void*)fwd_kernel, NTHR, LDS_BYTES);
        if (per_cu < 1 || cus < 256) { fprintf(stderr, "kernel_launch: occupancy query says %d blocks/CU on %d CUs; this kernel needs 256 resident workgroups\n", per_cu, cus); grid_blocks = -1; return; }
        grid_blocks = 256;
    }
    if (grid_blocks < 0) return;
    (void)hipMemsetAsync((char*)d_ws + OFF_BAR, 0, XCD_BAR_WORDS * 4, stream);
    Params p{};
    for (int i = 0; i < 46; ++i) p.in[i] = (const float*)d_in[i];
    p.out = (float*)d_out; p.ws = (char*)d_ws;
    void* args[] = {&p};
    hipError_t e = hipLaunchCooperativeKernel((const void*)fwd_kernel, dim3(grid_blocks), dim3(NTHR), args, LDS_BYTES, stream);
    if (e != hipSuccess) fprintf(stderr, "cooperative launch failed: %s (grid %d)\n", hipGetErrorString(e), grid_blocks);
}
```

```cpp
#include <hip/hip_runtime.h>
#include <hip/hip_cooperative_groups.h>
#include <cstdio>
#include <cmath>
namespace cg = cooperative_groups;

#define DEV __device__ __forceinline__
#define DBG_DIRMASK 3
#define DBG_CMIN 0
#define DBG_CMAX 132
#define DBG_TITERS 5
#define DBG_TSLOT 2
#define DBG_SELFTEST 0
#define DBG_MODE 1

constexpr int NB = 2, NL = 8192, DM = 1024, NCX = 256, TB = NCX + NL;
constexpr int RT = NB * TB;
constexpr int NCH = TB / 64;
constexpr int EIN = 3872, RW0 = 1568;
constexpr int NTHR = 512, NWV = 8;
constexpr float ALPHA = 1.41421356237f;
constexpr float KSCALE = 0.04419417382f;

constexpr size_t OFF_MODV = 0;
constexpr size_t OFF_X1C  = 131072;
constexpr size_t OFF_BAR  = 3145728;
constexpr size_t OFF_BIG  = 4194304;
constexpr size_t OFF_P0   = OFF_BIG;
constexpr size_t OFF_YC   = OFF_BIG + (size_t)TB * EIN * 2;
constexpr size_t OFF_GDS  = OFF_YC + (size_t)TB * 1024 * 2;
constexpr size_t OFF_GDEC = OFF_GDS + (size_t)8 * NCH * 8192 * 4;
constexpr size_t OFF_RU   = OFF_GDEC + (size_t)8 * NCH * 64 * 4;
constexpr size_t OFF_RS0  = OFF_RU + (size_t)16 * NCH * 16384 * 2;
constexpr size_t OFF_BONS = OFF_RS0 + (size_t)16 * NCH * 4096 * 2;
constexpr size_t L0_END   = OFF_BONS + (size_t)2 * TB * 8 * 4;
constexpr size_t OFF_XM   = OFF_BIG;
constexpr size_t OFF_XC   = OFF_XM + (size_t)RT * 2048 * 2;
constexpr size_t OFF_H    = OFF_XC + (size_t)RT * 2048 * 2;
constexpr size_t OFF_WT0  = OFF_H + (size_t)NB * NL * 2048 * 2;
constexpr size_t OFF_WT1  = OFF_WT0 + (size_t)3968 * 1024 * 2;
constexpr size_t OFF_WT2  = OFF_WT1 + (size_t)4096 * 1024 * 2;
constexpr size_t OFF_WT3  = OFF_WT2 + (size_t)1024 * 1024 * 2;
constexpr size_t OFF_G16  = OFF_WT3 + (size_t)1024 * 2048 * 2;
constexpr size_t OFF_SMAT = OFF_G16 + (size_t)RT * 16 * 4;
constexpr size_t OFF_GSC  = OFF_SMAT + (size_t)NB * 4 * NCH * 4096 * 2;
constexpr size_t OFF_CSC  = OFF_GSC + (size_t)16 * TB * 4 * 4;
constexpr size_t OFF_NBUF = OFF_CSC + (size_t)16 * NCH * 2 * 4;
constexpr size_t OFF_GTAB = OFF_NBUF + (size_t)16 * NCH * 512 * 4;
constexpr size_t OFF_WFT  = OFF_GTAB + (size_t)4 * 128 * 16 * 4;
constexpr size_t OFF_G16P = OFF_WFT + (size_t)16 * 4096 * 2;
constexpr size_t WS_NEED  = OFF_G16P + (size_t)4 * RT * 16 * 4;

static_assert(L0_END <= OFF_WT0, "layer-0 buffers overlap the weight copies");
constexpr int LDS_BYTES = 139264;

struct Params { const float* in[46]; float* out; char* ws; };
typedef unsigned short bf16_t;
typedef __attribute__((ext_vector_type(8))) short bf16x8;
typedef __attribute__((ext_vector_type(4))) short s16x4;
typedef __attribute__((ext_vector_type(2))) short s16x2;
typedef __attribute__((ext_vector_type(4))) float f32x4;
typedef __attribute__((ext_vector_type(2))) __bf16 bf2_t;
DEV unsigned pack2bf(float lo, float hi) { bf2_t v; v[0] = (__bf16)lo; v[1] = (__bf16)hi; return __builtin_bit_cast(unsigned, v); }
DEV float bflo(unsigned u) { return __uint_as_float(u << 16); }
DEV float bfhi(unsigned u) { return __uint_as_float(u & 0xffff0000u); }
DEV float bf2f(bf16_t v) { return __uint_as_float(((unsigned)v) << 16); }
DEV void unpack8(uint4 u, float* f) { f[0] = bflo(u.x); f[1] = bfhi(u.x); f[2] = bflo(u.y); f[3] = bfhi(u.y); f[4] = bflo(u.z); f[5] = bfhi(u.z); f[6] = bflo(u.w); f[7] = bfhi(u.w); }

DEV float wave_sum(float v) {
#pragma unroll
    for (int o = 32; o > 0; o >>= 1) v += __shfl_xor(v, o, 64);
    return v;
}
DEV float wave_max(float v) {
#pragma unroll
    for (int o = 32; o > 0; o >>= 1) v = fmaxf(v, __shfl_xor(v, o, 64));
    return v;
}
DEV float fexp(float x) { return __expf(x); }
DEV float frcp(float x) { return __builtin_amdgcn_rcpf(x); }
DEV float sigmoid_f(float x) { return frcp(1.f + fexp(-x)); }
DEV float silu_f(float x) { return x * frcp(1.f + fexp(-x)); }
DEV float logsig_f(float x) { return fminf(x, 0.f) - __logf(1.f + fexp(-fabsf(x))); }
DEV float tanh_f(float x) { const float e = fexp(2.f * x); return 1.f - 2.f * frcp(e + 1.f); }
DEV void lds_fence() { asm volatile("" ::: "memory"); }
DEV int opaque_tid() { int t = threadIdx.x; asm volatile("" : "+v"(t)); return t; }
DEV int scan_s(int dir, int u) { return dir == 0 ? u : (u < NCX ? (NCX - 1 - u) : (TB - 1 + NCX - u)); }
DEV int chunk_at(int dir, int step) { return dir == 0 ? step : (step < 4 ? 3 - step : (NCH + 3 - step)); }
DEV float4 ld4(const float* p) { return *(const float4*)p; }
DEV void st4(float* p, float4 v) { *(float4*)p = v; }


#define XB_TMO      128
#define XB_XCNT(j)  (256  + 64 * (j))
#define XB_XSUB(j)  (1280 + 64 * (j))
#define XB_XGEN(j)  (2304 + 64 * (j))
#define XB_TOP      3328
#define XB_TOPGEN   3392
#define XCD_BAR_WORDS 3456
#define XB_SPIN_CAP (1u << 22)
#define LAS __attribute__((address_space(3)))
DEV unsigned xb_ld(unsigned* p) { return __hip_atomic_load(p, __ATOMIC_RELAXED, __HIP_MEMORY_SCOPE_AGENT); }
DEV unsigned xb_add(unsigned* p, unsigned v) { return __hip_atomic_fetch_add(p, v, __ATOMIC_RELAXED, __HIP_MEMORY_SCOPE_AGENT); }
DEV unsigned xb_xcc_id() { return (unsigned)__builtin_amdgcn_s_getreg((3 << 11) | 20) & 0xFu; }
#define XB_SPIN(cond, bar) do { unsigned _sp = 0; while (cond) { __builtin_amdgcn_s_sleep(1); \
    if ((++_sp & 255u) == 0u) { if (xb_ld(&(bar)[XB_TMO])) break; if (_sp > XB_SPIN_CAP) { atomicAdd(&(bar)[XB_TMO], 1u); break; } } } } while (0)
struct XcdBarrier { unsigned* bar; unsigned x; volatile LAS unsigned* st; };
DEV XcdBarrier xcd_barrier_post(unsigned* bar, volatile LAS unsigned* st) {
    XcdBarrier b; b.bar = bar; b.x = xb_xcc_id(); b.st = st;
    if (threadIdx.x == 0) (void)xb_add(&bar[XB_XCNT(b.x)], 1u);
    return b;
}
DEV void xcd_barrier_complete(unsigned* bar, unsigned x, unsigned& nloc, unsigned& nx) {
    const unsigned G = gridDim.x * gridDim.y * gridDim.z;
    unsigned sum, cnt, mine, sp = 0u;
    for (;;) {
        sum = 0u; cnt = 0u; mine = 0u;
#pragma unroll
        for (unsigned j = 0; j < 16; ++j) { const unsigned c = xb_ld(&bar[XB_XCNT(j)]); sum += c; cnt += (c > 0u) ? 1u : 0u; mine = (j == x) ? c : mine; }
        if (sum == G) break;
        __builtin_amdgcn_s_sleep(1);
        if ((++sp & 255u) == 0u) { if (xb_ld(&bar[XB_TMO])) break; if (sp > XB_SPIN_CAP) { atomicAdd(&bar[XB_TMO], 1u); break; } }
    }
    nloc = mine > 0u ? mine : 1u; nx = cnt > 0u ? cnt : 1u;
}
DEV void xcd_barrier(const XcdBarrier& b) {
    asm volatile("s_waitcnt vmcnt(0)" ::: "memory");
    __syncthreads();
    if (threadIdx.x == 0) {
        unsigned* bar = b.bar;
        __builtin_amdgcn_s_waitcnt(0);
        unsigned nloc = b.st[0], nx = b.st[1];
        if (nloc == 0u) { xcd_barrier_complete(bar, b.x, nloc, nx); b.st[0] = nloc; b.st[1] = nx; }
        const unsigned old = xb_add(&bar[XB_XSUB(b.x)], 1u);
        const unsigned gen = old / nloc;
        if (old + 1u == (gen + 1u) * nloc) {
            __builtin_amdgcn_fence(__ATOMIC_RELEASE, "agent");
            asm volatile("s_waitcnt vmcnt(0)" ::: "memory");
            const unsigned og = xb_add(&bar[XB_TOP], 1u);
            const unsigned tg = og / nx;
            if (og + 1u == (tg + 1u) * nx) xb_add(&bar[XB_TOPGEN], 1u);
            else XB_SPIN(xb_ld(&bar[XB_TOPGEN]) == tg, bar);
            __builtin_amdgcn_fence(__ATOMIC_ACQUIRE, "agent");
            xb_add(&bar[XB_XGEN(b.x)], 1u);
            asm volatile("s_waitcnt vmcnt(0)" ::: "memory");
        } else {
            XB_SPIN(xb_ld(&bar[XB_XGEN(b.x)]) == gen, bar);
            __builtin_amdgcn_fence(__ATOMIC_ACQUIRE, "agent");
            asm volatile("s_waitcnt vmcnt(0)" ::: "memory");
        }
    }
    __syncthreads();
}

template <class AL>
DEV void gemm_lda(const AL& al, int m0, int k0, int tid, uint4 (&r)[4]) {
    if constexpr (AL::BF) {
#pragma unroll
        for (int i = 0; i < 4; ++i) r[i] = al.ld8(m0 + (tid >> 3) + 64 * i, k0 + (tid & 7) * 8);
    } else {
        const int k = k0 + (tid & 15) * 4;
        const float* mv = al.mvptr(m0);
        const float4 sh = ld4(mv + k), sc = ld4(mv + 1024 + k);
#pragma unroll
        for (int i = 0; i < 4; ++i) {
            float4 x = ld4(al.rowptr(m0 + (tid >> 4) + 32 * (2 * i)) + k), y = ld4(al.rowptr(m0 + (tid >> 4) + 32 * (2 * i + 1)) + k);
            x.x = x.x * (1.f + sc.x) + sh.x; x.y = x.y * (1.f + sc.y) + sh.y; x.z = x.z * (1.f + sc.z) + sh.z; x.w = x.w * (1.f + sc.w) + sh.w;
            y.x = y.x * (1.f + sc.x) + sh.x; y.y = y.y * (1.f + sc.y) + sh.y; y.z = y.z * (1.f + sc.z) + sh.z; y.w = y.w * (1.f + sc.w) + sh.w;
            r[i] = make_uint4(pack2bf(x.x, x.y), pack2bf(x.z, x.w), pack2bf(y.x, y.y), pack2bf(y.z, y.w));
        }
    }
}
template <class AL>
DEV void gemm_sta(bf16_t* Ab, int tid, const uint4 (&r)[4]) {
    if constexpr (AL::BF) {
#pragma unroll
        for (int i = 0; i < 4; ++i) { const int row = (tid >> 3) + 64 * i; *(uint4*)(Ab + row * 64 + (((tid & 7) ^ (row & 7)) * 8)) = r[i]; }
    } else {
#pragma unroll
        for (int i = 0; i < 4; ++i) {
            const int r0 = (tid >> 4) + 32 * (2 * i), r1 = r0 + 32, c = (tid & 15) >> 1, hf = (tid & 1) * 4;
            *(uint2*)(Ab + r0 * 64 + ((c ^ (r0 & 7)) * 8) + hf) = make_uint2(r[i].x, r[i].y);
            *(uint2*)(Ab + r1 * 64 + ((c ^ (r1 & 7)) * 8) + hf) = make_uint2(r[i].z, r[i].w);
        }
    }
}
template <class AL, class EP>
DEV void gemm_mfma(int M, int N, int Npad, int K, const bf16_t* Wt, AL al, EP ep, float* smf) {
    constexpr int LDT = 64;
    bf16_t* As = (bf16_t*)smf;
    bf16_t* Bs = As + 2 * 256 * LDT;
    const int tid = opaque_tid(), lane = tid & 63, wave = tid >> 6, wm = wave & 3, wn = wave >> 2;
    const int mt = M / 256, nt = Npad / 128, nks = K / 64;
    const int br = tid >> 3, bc = tid & 7;
    const int ntile = mt * nt, fullg = mt >> 2, cut = fullg * 4 * nt, rl = mt - fullg * 4;
    for (int pos = ((int)(blockIdx.x & 7)) * 32 + (int)(blockIdx.x >> 3); pos < ntile; pos += 256) {
        int tm, tn;
        if (pos < cut) { const int grp = pos / (4 * nt), w = pos - grp * 4 * nt; tn = w >> 2; tm = grp * 4 + (w & 3); }
        else { const int p2 = pos - cut; tn = p2 / rl; tm = fullg * 4 + p2 - tn * rl; }
        const int m0 = tm * 256, n0 = tn * 128;
        f32x4 acc[4][4];
#pragma unroll
        for (int i = 0; i < 4; ++i)
#pragma unroll
            for (int j = 0; j < 4; ++j) acc[i][j] = (f32x4){0.f, 0.f, 0.f, 0.f};
        const bf16_t* wrow = Wt + (size_t)(n0 + br) * K + bc * 8;
        uint4 ra0[4], ra1[4], rb00, rb01, rb10, rb11;
        gemm_lda(al, m0, 0, tid, ra0); rb00 = *(const uint4*)(wrow); rb01 = *(const uint4*)(wrow + (size_t)64 * K);
        { const int k1 = (nks > 1) ? 64 : 0; gemm_lda(al, m0, k1, tid, ra1); rb10 = *(const uint4*)(wrow + k1); rb11 = *(const uint4*)(wrow + (size_t)64 * K + k1); }
#define GEMM_ST(buf_, ra_, rbx_, rby_) do { gemm_sta<AL>(As + (buf_) * 256 * LDT, tid, ra_); bf16_t* Bd_ = Bs + (buf_) * 128 * LDT; \
        *(uint4*)(Bd_ + br * LDT + ((bc ^ (br & 7)) * 8)) = rbx_; *(uint4*)(Bd_ + (br + 64) * LDT + ((bc ^ (br & 7)) * 8)) = rby_; } while (0)
#define GEMM_MM(buf_) do { const bf16_t* Ab_ = As + (buf_) * 256 * LDT; const bf16_t* Bb_ = Bs + (buf_) * 128 * LDT; \
        _Pragma("unroll") for (int kk_ = 0; kk_ < 2; ++kk_) { bf16x8 wf_[4], af_[4]; \
            _Pragma("unroll") for (int i_ = 0; i_ < 4; ++i_) wf_[i_] = *(const bf16x8*)(Bb_ + (wn * 64 + i_ * 16 + (lane & 15)) * LDT + ((kk_ * 4 + (lane >> 4)) ^ (lane & 7)) * 8); \
            _Pragma("unroll") for (int j_ = 0; j_ < 4; ++j_) af_[j_] = *(const bf16x8*)(Ab_ + (wm * 64 + j_ * 16 + (lane & 15)) * LDT + ((kk_ * 4 + (lane >> 4)) ^ (lane & 7)) * 8); \
            _Pragma("unroll") for (int i_ = 0; i_ < 4; ++i_) _Pragma("unroll") for (int j_ = 0; j_ < 4; ++j_) acc[i_][j_] = __builtin_amdgcn_mfma_f32_16x16x32_bf16(wf_[i_], af_[j_], acc[i_][j_], 0, 0, 0); } } while (0)
        GEMM_ST(0, ra0, rb00, rb01);
        __syncthreads();
#pragma unroll 1
        for (int ks = 0; ks < nks; ks += 2) {
            {
                const int k2 = ((ks + 2 < nks) ? ks + 2 : nks - 1) * 64;
                gemm_lda(al, m0, k2, tid, ra0); rb00 = *(const uint4*)(wrow + k2); rb01 = *(const uint4*)(wrow + (size_t)64 * K + k2);
                __builtin_amdgcn_sched_barrier(0);
                GEMM_MM(0);
                GEMM_ST(1, ra1, rb10, rb11);
                __syncthreads();
            }
            {
                const int k3 = ((ks + 3 < nks) ? ks + 3 : nks - 1) * 64;
                gemm_lda(al, m0, k3, tid, ra1); rb10 = *(const uint4*)(wrow + k3); rb11 = *(const uint4*)(wrow + (size_t)64 * K + k3);
                __builtin_amdgcn_sched_barrier(0);
                GEMM_MM(1);
                GEMM_ST(0, ra0, rb00, rb01);
                __syncthreads();
            }
        }
#undef GEMM_ST
#undef GEMM_MM
#pragma unroll
        for (int i = 0; i < 4; ++i) {
            const int n = n0 + wn * 64 + i * 16 + (lane >> 4) * 4;
            if (n < N) {
#pragma unroll
                for (int j = 0; j < 4; ++j) {
                    const int m = m0 + wm * 64 + j * 16 + (lane & 15);
                    ep(m, n, make_float4(acc[i][j][0], acc[i][j][1], acc[i][j][2], acc[i][j][3]));
                }
            }
        }
    }
}

DEV void transpose_convert(const float* __restrict__ W, int K, int N, int Npad, bf16_t* Wt, float* sm) {
    float (*T)[65] = (float (*)[65])sm;
    const int tid = opaque_tid();
    const int kt = K / 64, ntl = Npad / 64;
    for (int tile = blockIdx.x; tile < kt * ntl; tile += gridDim.x) {
        const int k0 = (tile / ntl) * 64, n0 = (tile % ntl) * 64;
        __syncthreads();
#pragma unroll
        for (int i = 0; i < 2; ++i) {
            const int k = (tid >> 4) + 32 * i, n4 = (tid & 15) * 4;
            float4 v = make_float4(0.f, 0.f, 0.f, 0.f);
            if (n0 + n4 < N) v = ld4(W + (size_t)(k0 + k) * N + n0 + n4);
            T[k][n4] = v.x; T[k][n4 + 1] = v.y; T[k][n4 + 2] = v.z; T[k][n4 + 3] = v.w;
        }
        __syncthreads();
        const int n = tid >> 3, kq = (tid & 7) * 8;
        unsigned o[4];
#pragma unroll
        for (int j = 0; j < 4; ++j) o[j] = pack2bf(T[kq + 2 * j][n], T[kq + 2 * j + 1][n]);
        bf16_t* dst = Wt + (size_t)(n0 + n) * K + k0 + kq;
        *(uint4*)dst = make_uint4(o[0], o[1], o[2], o[3]);
    }
}

struct ALmodAll {
    static constexpr bool BF = false;
    const float* lat; const float* cx; const float* mv;
    DEV const float* rowptr(int rr) const { const int b = rr >= TB ? 1 : 0, s = rr - b * TB; return (s < NCX) ? cx + ((size_t)(b * NCX + s)) * DM : lat + ((size_t)(b * NL + s - NCX)) * DM; }
    DEV const float* mvptr(int m0) const { const int b = m0 >= TB ? 1 : 0, s = m0 - b * TB; return mv + ((s < NCX) ? 2 : b) * 3072; }
};
struct ALmodLat {
    static constexpr bool BF = false;
    const float* lat; const float* mv;
    DEV const float* rowptr(int r) const { return lat + (size_t)r * DM; }
    DEV const float* mvptr(int m0) const { return mv + (m0 >= NL ? 1 : 0) * 3072; }
};
struct ALbf { static constexpr bool BF = true; const bf16_t* A; int lda; DEV uint4 ld8(int r, int k) const { return *(const uint4*)(A + (size_t)r * lda + k); } };
struct EPstore { float* C; int ldc; DEV void operator()(int r, int c, float4 v) const { st4(C + (size_t)r * ldc + c, v); } };
struct EPstoreBf { bf16_t* C; int ldc; DEV void operator()(int r, int c, float4 v) const { *(uint2*)(C + (size_t)r * ldc + c) = make_uint2(pack2bf(v.x, v.y), pack2bf(v.z, v.w)); } };
struct EPres {
    float* C; int ldc; const float* lat; const float* cx; const float* mv; int b; int s0;
    DEV void operator()(int r, int c, float4 v) const {
        const int s = r + s0;
        const float* src; int j;
        if (s < NCX) { src = cx + ((size_t)(b * NCX + s)) * DM + c; j = 2; }
        else { src = lat + ((size_t)(b * NL + s - NCX)) * DM + c; j = b; }
        float4 x = ld4(src);
        float4 g = ld4(mv + j * 3072 + 2048 + c);
        st4(C + (size_t)r * ldc + c, make_float4(ALPHA * x.x + g.x * v.x, ALPHA * x.y + g.y * v.y, ALPHA * x.z + g.z * v.z, ALPHA * x.w + g.w * v.w));
    }
};
struct EPresLat {
    float* C; const float* lat; const float* mv;
    DEV void operator()(int r, int c, float4 v) const {
        const int b = r >= NL ? 1 : 0;
        float4 x = ld4(lat + (size_t)r * DM + c);
        float4 g = ld4(mv + b * 3072 + 2048 + c);
        st4(C + (size_t)r * DM + c, make_float4(ALPHA * x.x + g.x * v.x, ALPHA * x.y + g.y * v.y, ALPHA * x.z + g.z * v.z, ALPHA * x.w + g.w * v.w));
    }
};


DEV void phase_h0(const Params& p, int b) {
    const float* modv = (const float*)(p.ws + OFF_MODV);
    bf16_t* H0 = (bf16_t*)(p.ws + OFF_YC);
    const int gt = blockIdx.x * NTHR + opaque_tid(), gn = gridDim.x * NTHR;
    for (int i = gt; i < TB * 128; i += gn) {
        const int s = i >> 7, k = (i & 127) * 8;
        const float* src; int j;
        if (s < NCX) { src = p.in[2] + ((size_t)(b * NCX + s)) * DM + k; j = 2; }
        else { src = p.in[0] + ((size_t)(b * NL + s - NCX)) * DM + k; j = b; }
        const float4 x0 = ld4(src), x1 = ld4(src + 4);
        const float* m = modv + j * 3072;
        const float4 s0 = ld4(m + k), s1 = ld4(m + k + 4), c0 = ld4(m + 1024 + k), c1 = ld4(m + 1024 + k + 4);
        *(uint4*)(H0 + (size_t)s * DM + k) = make_uint4(pack2bf(x0.x * (1.f + c0.x) + s0.x, x0.y * (1.f + c0.y) + s0.y), pack2bf(x0.z * (1.f + c0.z) + s0.z, x0.w * (1.f + c0.w) + s0.w),
                                                      pack2bf(x1.x * (1.f + c1.x) + s1.x, x1.y * (1.f + c1.y) + s1.y), pack2bf(x1.z * (1.f + c1.z) + s1.z, x1.w * (1.f + c1.w) + s1.w));
    }
}

DEV void phase_mod(const Params& p, float* sm) {
    const float* c = p.in[1]; const float* cctx = p.in[3];
    const float* mod_w = p.in[4]; const float* mod_b = p.in[5];
    float* modv = (float*)(p.ws + OFF_MODV);
    float* sil = sm; float* red = sm + 3072;
    const int tid = opaque_tid();
    for (int i = tid; i < 3072; i += NTHR) {
        const int j = i >> 10, k = i & 1023;
        const float v = (j < 2) ? c[j * 1024 + k] : cctx[k];
        sil[i] = silu_f(v);
    }
    __syncthreads();
    for (int unit = blockIdx.x; unit < 192; unit += gridDim.x) {
        const int l = unit / 96, cb = unit % 96;
        const int kg = tid >> 5, col = tid & 31, n = cb * 32 + col;
        const float* w = mod_w + (size_t)l * 1024 * 3072 + n;
        float a0 = 0.f, a1 = 0.f, a2 = 0.f;
        for (int k = kg * 64; k < kg * 64 + 64; ++k) {
            const float wv = w[(size_t)k * 3072];
            a0 += sil[k] * wv; a1 += sil[1024 + k] * wv; a2 += sil[2048 + k] * wv;
        }
        red[(kg * 3 + 0) * 32 + col] = a0; red[(kg * 3 + 1) * 32 + col] = a1; red[(kg * 3 + 2) * 32 + col] = a2;
        __syncthreads();
        if (tid < 96) {
            const int j = tid >> 5, cc = tid & 31, nn = cb * 32 + cc;
            float s = mod_b[l * 3072 + nn];
            for (int g = 0; g < 16; ++g) s += red[(g * 3 + j) * 32 + cc];
            modv[(l * 3 + j) * 3072 + nn] = s;
        }
        __syncthreads();
    }
}

DEV void phase_tables(const Params& p) {
    const float* wq = p.in[33]; const float* wk = p.in[34]; const float* wv = p.in[35];
    const float* gw0 = p.in[36]; const float* gw1 = p.in[38]; const float* gw2 = p.in[40]; const float* gw3 = p.in[42];
    float* gtab = (float*)(p.ws + OFF_GTAB); bf16_t* wft = (bf16_t*)(p.ws + OFF_WFT);
    const int gt = blockIdx.x * NTHR + opaque_tid(), gn = gridDim.x * NTHR;
    for (int i = gt; i < 512 * 16; i += gn) {
        const int gb = i >> 4, cp = (i >> 2) & 3, c = i & 3;
        float s = 0.f;
#pragma unroll
        for (int d = 0; d < 4; ++d) s += wq[gb * 16 + cp * 4 + d] * wk[gb * 16 + c * 4 + d];
        gtab[i] = s * KSCALE;
    }
    for (int i = gt; i < 4096 * 16; i += gn) {
        const int g = i >> 12, k = i & 4095, gm = g >> 2, hd = g & 3;
        const float* wg = gm == 0 ? gw0 : (gm == 1 ? gw1 : (gm == 2 ? gw2 : gw3));
        float s = 0.f;
        if (k < 2048) {
            const int blk = k >> 2, cc = k & 3;
#pragma unroll
            for (int d = 0; d < 4; ++d) s += wq[blk * 16 + cc * 4 + d] * wg[(size_t)(4 * blk + d) * 4 + hd] + wk[blk * 16 + cc * 4 + d] * wg[(size_t)(2048 + 4 * blk + d) * 4 + hd];
        } else {
            const int kk = k - 2048, blk = kk >> 2, cc = kk & 3;
#pragma unroll
            for (int d = 0; d < 4; ++d) s += wv[blk * 16 + cc * 4 + d] * wg[(size_t)(4096 + 4 * blk + d) * 4 + hd];
        }
        wft[i] = __builtin_bit_cast(unsigned short, (__bf16)s);
    }
}

#ifdef RWKV_DEBUG
DEV float rw_mix(const bf16_t* P0, int s, int c, const float* __restrict__ mu) {
    const float own = bf2f(P0[(size_t)s * EIN + RW0 + c]);
    const int d = c & 3;
    int ns = -1;
    if (s < NCX) {
        if (d == 0) ns = (s > 0) ? s - 1 : -1;
        else if (d == 1) ns = (s < NCX - 1) ? s + 1 : -1;
    } else {
        const int n = s - NCX, rr = n >> 6, cc = n & 63;
        if (d == 0) ns = (cc > 0) ? s - 1 : -1;
        else if (d == 1) ns = (cc < 63) ? s + 1 : -1;
        else if (d == 2) ns = (rr > 0) ? s - 64 : -1;
        else ns = (rr < 127) ? s + 64 : -1;
    }
    const float nb = (ns >= 0) ? bf2f(P0[(size_t)ns * EIN + RW0 + c]) : 0.f;
    return own + (nb - own) * mu[c];
}

DEV void rwkv_unit(const Params& p, int h, int dir, int rh, float* sm, int lane) {
    asm volatile("" : "+v"(lane));
    const bf16_t* P0 = (const bf16_t*)(p.ws + OFF_P0);
    float* YS = p.out;
    float* BON = (float*)(p.ws + OFF_X1C);
    const float* mu = p.in[15];
    const float* w0 = p.in[dir ? 18 : 16]; const float* ww2 = p.in[dir ? 19 : 17];
    const float* a0 = p.in[dir ? 22 : 20]; const float* wa2 = p.in[dir ? 23 : 21];
    const float* k_k = p.in[24]; const float* k_a = p.in[25]; const float* r_k = p.in[26];
    float* sR = sm; float* sW = sm + 4096; float* sK = sm + 8192; float* sA = sm + 12288; float* sB = sm + 16384; float* sV = sm + 20480;
    const int hc = h * 64 + lane;
    const float w0j = w0[hc], a0j = a0[hc], kkj = k_k[hc], kaj = k_a[hc], rkj = r_k[hc];
    const int row = rh * 32 + (lane & 31), kh0 = (lane >> 5) * 32;
    float* sWW = sm + 24576; float* sWA = sm + 28672;
#pragma unroll 4
    for (int i = 0; i < 64; ++i) { sWW[i * 64 + lane] = ww2[i * 512 + hc]; sWA[i * 64 + lane] = wa2[i * 512 + hc]; }
    float S[32];
#pragma unroll
    for (int k = 0; k < 32; ++k) S[k] = 0.f;
    const int cwl = 2048 + dir * 64, cal = 2176 + dir * 64;
#pragma unroll 1
    for (int cu = 0; cu < TB / 64; ++cu) {
        lds_fence();
#pragma unroll 1
        for (int t = 0; t < 64; ++t) {
            const int s = scan_s(dir, cu * 64 + t);
            sR[t * 64 + lane] = rw_mix(P0, s, h * 64 + lane, mu);
            sK[t * 64 + lane] = rw_mix(P0, s, 512 + h * 64 + lane, mu);
            sV[t * 64 + lane] = rw_mix(P0, s, 1024 + h * 64 + lane, mu);
            sA[t * 64 + lane] = tanh_f(rw_mix(P0, s, cwl + lane, mu));
            sB[t * 64 + lane] = rw_mix(P0, s, cal + lane, mu);
        }
        lds_fence();
        {
            const float* wr = sWW + lane; asm volatile("" : "+v"(wr));
            float wc[64];
#pragma unroll
            for (int i = 0; i < 64; ++i) wc[i] = wr[i * 64];
#pragma unroll 1
            for (int t = 0; t < 64; ++t) {
                float accw = w0j;
#pragma unroll
                for (int i4 = 0; i4 < 16; ++i4) {
                    const float4 x = ld4(&sA[t * 64 + i4 * 4]);
                    accw += x.x * wc[i4 * 4] + x.y * wc[i4 * 4 + 1] + x.z * wc[i4 * 4 + 2] + x.w * wc[i4 * 4 + 3];
                }
                sW[t * 64 + lane] = fexp(-0.6065306597f * sigmoid_f(accw));
            }
        }
        lds_fence();
        {
            const float* ar = sWA + lane; asm volatile("" : "+v"(ar));
            float ac[64];
#pragma unroll
            for (int i = 0; i < 64; ++i) ac[i] = ar[i * 64];
#pragma unroll 1
            for (int t = 0; t < 64; ++t) {
                float acca = a0j;
#pragma unroll
                for (int i4 = 0; i4 < 16; ++i4) {
                    const float4 y = ld4(&sB[t * 64 + i4 * 4]);
                    acca += y.x * ac[i4 * 4] + y.y * ac[i4 * 4 + 1] + y.z * ac[i4 * 4 + 2] + y.w * ac[i4 * 4 + 3];
                }
                const float av = sigmoid_f(acca);
                const float kraw = sK[t * 64 + lane];
                const float kkv = kraw * kkj;
                const float ss = wave_sum(kkv * kkv);
                const float kk = kkv * rsqrtf(fmaxf(ss, 1e-24f));
                const float kh = kraw * (1.f + (av - 1.f) * kaj);
                const float r = sR[t * 64 + lane];
                const float bon = wave_sum(r * kh * rkj);
                lds_fence();
                sK[t * 64 + lane] = kh; sA[t * 64 + lane] = -kk; sB[t * 64 + lane] = kk * av;
                if (lane == 0 && rh == 0) { const int s = scan_s(dir, cu * 64 + t); atomicAdd(&BON[s * 8 + h], bon); }
            }
        }
        lds_fence();
        if (cu == 0 && dir == 0 && rh == 0) {
            float* DBO = p.out + 9000000;
            for (int t = 0; t < 64; ++t) { float* d = DBO + ((size_t)(h * 64 + t) * 64 + lane) * 6; d[0] = sW[t * 64 + lane]; d[1] = sK[t * 64 + lane]; d[2] = sA[t * 64 + lane]; d[3] = sB[t * 64 + lane]; d[4] = sR[t * 64 + lane]; d[5] = sV[t * 64 + lane]; }
        }
#pragma unroll 1
        for (int t = 0; t < 64; ++t) {
            const float vi = sV[t * 64 + row];
            float sa = 0.f;
#pragma unroll
            for (int k4 = 0; k4 < 8; ++k4) {
                const float4 a4 = ld4(&sA[t * 64 + kh0 + k4 * 4]);
                sa += S[k4 * 4] * a4.x + S[k4 * 4 + 1] * a4.y + S[k4 * 4 + 2] * a4.z + S[k4 * 4 + 3] * a4.w;
            }
            sa += __shfl_xor(sa, 32, 64);
            float y = 0.f;
#pragma unroll
            for (int k4 = 0; k4 < 8; ++k4) {
                const float4 w4 = ld4(&sW[t * 64 + kh0 + k4 * 4]);
                const float4 b4 = ld4(&sB[t * 64 + kh0 + k4 * 4]);
                const float4 h4 = ld4(&sK[t * 64 + kh0 + k4 * 4]);
                const float4 r4 = ld4(&sR[t * 64 + kh0 + k4 * 4]);
                S[k4 * 4 + 0] = S[k4 * 4 + 0] * w4.x + sa * b4.x + vi * h4.x;
                S[k4 * 4 + 1] = S[k4 * 4 + 1] * w4.y + sa * b4.y + vi * h4.y;
                S[k4 * 4 + 2] = S[k4 * 4 + 2] * w4.z + sa * b4.z + vi * h4.z;
                S[k4 * 4 + 3] = S[k4 * 4 + 3] * w4.w + sa * b4.w + vi * h4.w;
                y += S[k4 * 4] * r4.x + S[k4 * 4 + 1] * r4.y + S[k4 * 4 + 2] * r4.z + S[k4 * 4 + 3] * r4.w;
            }
            y += __shfl_xor(y, 32, 64);
            if (lane < 32) { const int s = scan_s(dir, cu * 64 + t); atomicAdd(&YS[(size_t)s * 1024 + 512 + h * 64 + row], y); }
        }
    }
}

#endif
DEV float wave_scan_add(float v, int lane, int dir) {
#pragma unroll
    for (int o = 1; o < 64; o <<= 1) {
        const float n = dir ? __shfl_down(v, o, 64) : __shfl_up(v, o, 64);
        const bool ok = dir ? (lane + o < 64) : (lane >= o);
        if (ok) v += n;
    }
    return v;
}
DEV float wave_scan_max(float v, int lane, int dir) {
#pragma unroll
    for (int o = 1; o < 64; o <<= 1) {
        const float n = dir ? __shfl_down(v, o, 64) : __shfl_up(v, o, 64);
        const bool ok = dir ? (lane + o < 64) : (lane >= o);
        if (ok) v = fmaxf(v, n);
    }
    return v;
}

DEV void gla_decay(const bf16_t* P0, int c, int h, int dir, const float* __restrict__ wa2, const float* __restrict__ ba,
                   float* sLR, float* sWA, float* sBC, float* sTot, int tid) {
    for (int i = tid; i < 1024; i += NTHR) { const int t = i >> 4, j = i & 15; sLR[i] = bf2f(P0[(size_t)(c * 64 + t) * EIN + 1536 + dir * 16 + j]); }
    for (int i = tid; i < 1024; i += NTHR) { const int ii = i >> 6, k = i & 63; sWA[i] = wa2[ii * 256 + h * 64 + k]; }
    __syncthreads();
    {
        const int t = tid >> 3, k0 = (tid & 7) * 8;
        float acc[8];
#pragma unroll
        for (int j = 0; j < 8; ++j) acc[j] = ba[h * 64 + k0 + j];
#pragma unroll
        for (int ii = 0; ii < 16; ++ii) {
            const float l = sLR[t * 16 + ii];
#pragma unroll
            for (int j = 0; j < 8; ++j) acc[j] += l * sWA[ii * 64 + k0 + j];
        }
#pragma unroll
        for (int j = 0; j < 8; ++j) sBC[t * 65 + k0 + j] = logsig_f(acc[j]) * 0.0625f;
    }
    __syncthreads();
    {
        const int lane = tid & 63, wv = tid >> 6;
#pragma unroll
        for (int j = 0; j < 8; ++j) {
            const int k = wv * 8 + j;
            const float v = wave_scan_add(sBC[lane * 65 + k], lane, dir);
            sBC[lane * 65 + k] = v;
            if (lane == (dir ? 0 : 63)) sTot[k] = v;
        }
    }
    __syncthreads();
}
DEV bf16x8 tr_frag(const bf16_t* base, int ld, int row0, int col0, int lane) {
    const bf16_t* ptr = base + (row0 + (lane >> 4) * 8 + ((lane & 15) >> 2)) * ld + col0 + (lane & 3) * 4;
    const s16x4 lo = __builtin_amdgcn_ds_read_tr16_b64_v4i16((__attribute__((address_space(3))) s16x4*)ptr);
    const s16x4 hi = __builtin_amdgcn_ds_read_tr16_b64_v4i16((__attribute__((address_space(3))) s16x4*)(ptr + 4 * ld));
    return (bf16x8){lo[0], lo[1], lo[2], lo[3], hi[0], hi[1], hi[2], hi[3]};
}
DEV bf16x8 row_frag(const bf16_t* base, int ld, int idx0, int k0, int lane) {
    return *(const bf16x8*)(base + (idx0 + (lane & 15)) * ld + k0 + (lane >> 4) * 8);
}

DEV void gla1_unit(const Params& p, int h, int dir, int c, float* sm) {
    const int tid = opaque_tid(), lane = tid & 63, wave = tid >> 6;
    const bf16_t* P0 = (const bf16_t*)(p.ws + OFF_P0);
    float* GDS = (float*)(p.ws + OFF_GDS); float* GDEC = (float*)(p.ws + OFF_GDEC);
    const float* wa2 = p.in[dir ? 12 : 10]; const float* ba = p.in[dir ? 13 : 11];
    float* sLR = sm; float* sWA = sm + 1024; float* sBC = sm + 2048; float* sTot = sm + 6208;
    bf16_t* kT = (bf16_t*)(sm + 6272);
    bf16_t* Vs = (bf16_t*)(sm + 8576);
    const int ch = h * 2 + dir;
    __syncthreads();
    gla_decay(P0, c, h, dir, wa2, ba, sLR, sWA, sBC, sTot, tid);
    {
        const int t = tid >> 3, k0 = (tid & 7) * 8;
        float kv[8]; unpack8(*(const uint4*)(P0 + (size_t)(c * 64 + t) * EIN + 256 + h * 64 + k0), kv);
#pragma unroll
        for (int j = 0; j < 8; ++j) kT[(k0 + j) * 72 + t] = __builtin_bit_cast(unsigned short, (__bf16)(kv[j] * fexp(sTot[k0 + j] - sBC[t * 65 + k0 + j])));
#pragma unroll
        for (int u = 0; u < 2; ++u) { const int i = tid + 512 * u, row = i >> 4, c16 = i & 15; *(uint4*)(Vs + row * 136 + c16 * 8) = *(const uint4*)(P0 + (size_t)(c * 64 + row) * EIN + 512 + h * 128 + c16 * 8); }
    }
    __syncthreads();
    {
        f32x4 acc[4];
#pragma unroll
        for (int kt = 0; kt < 4; ++kt) acc[kt] = (f32x4){0.f, 0.f, 0.f, 0.f};
#pragma unroll
        for (int ks = 0; ks < 2; ++ks) {
            const bf16x8 af = tr_frag(Vs, 136, ks * 32, wave * 16, lane);
#pragma unroll
            for (int kt = 0; kt < 4; ++kt) acc[kt] = __builtin_amdgcn_mfma_f32_16x16x32_bf16(af, row_frag(kT, 72, kt * 16, ks * 32, lane), acc[kt], 0, 0, 0);
        }
#pragma unroll
        for (int kt = 0; kt < 4; ++kt) {
            const int k = kt * 16 + (lane & 15), v = wave * 16 + (lane >> 4) * 4;
            st4(GDS + ((size_t)(ch * NCH + c) * 64 + k) * 128 + v, make_float4(acc[kt][0], acc[kt][1], acc[kt][2], acc[kt][3]));
        }
    }
    if (tid < 64) GDEC[(size_t)(ch * NCH + c) * 64 + tid] = fexp(sTot[tid]);
}

DEV void gla2_unit(const Params& p, int unit) {
    const int tid = opaque_tid();
    float* GDS = (float*)(p.ws + OFF_GDS); const float* GDEC = (const float*)(p.ws + OFF_GDEC);
    const int ch = unit >> 4, e = (unit & 15) * 512 + tid, k = e >> 7, dir = ch & 1;
    float S = 0.f;
#pragma unroll 4
    for (int step = 0; step < NCH; ++step) {
        const int c = chunk_at(dir, step);
        float* gp = GDS + (size_t)(ch * NCH + c) * 8192 + e;
        const float d = GDEC[(size_t)(ch * NCH + c) * 64 + k], inc = *gp;
        *gp = S;
        S = d * S + inc;
    }
}

DEV void gla3_unit(const Params& p, int h, int c, float* sm) {
    const int tid = opaque_tid(), lane = tid & 63, wave = tid >> 6;
    const bf16_t* P0 = (const bf16_t*)(p.ws + OFF_P0);
    const float* GDS = (const float*)(p.ws + OFF_GDS);
    bf16_t* YC = (bf16_t*)(p.ws + OFF_YC);
    const float* ng = p.in[14];
    float* sLR = sm; float* sWA = sm + 1024; float* sBC = sm + 2048; float* sTot = sm + 6208;
    bf16_t* qt = (bf16_t*)(sm + 6272);
    bf16_t* kt = (bf16_t*)(sm + 8576);
    bf16_t* Sm = (bf16_t*)(sm + 10880);
    bf16_t* S0s = (bf16_t*)(sm + 13184);
    bf16_t* Vs = (bf16_t*)(sm + 17536);
    float* O = sm + 21888;
    const int ti = wave & 3, vt0 = (wave >> 2) * 4;
    f32x4 acc[4];
#pragma unroll
    for (int j = 0; j < 4; ++j) acc[j] = (f32x4){0.f, 0.f, 0.f, 0.f};
    __syncthreads();
#pragma unroll
    for (int u = 0; u < 2; ++u) { const int i = tid + 512 * u, row = i >> 4, c16 = i & 15; *(uint4*)(Vs + row * 136 + c16 * 8) = *(const uint4*)(P0 + (size_t)(c * 64 + row) * EIN + 512 + h * 128 + c16 * 8); }
#pragma unroll 1
    for (int dir = 0; dir < 2; ++dir) {
        const float* wa2 = p.in[dir ? 12 : 10]; const float* ba = p.in[dir ? 13 : 11];
        const int ch = h * 2 + dir;
        __syncthreads();
        gla_decay(P0, c, h, dir, wa2, ba, sLR, sWA, sBC, sTot, tid);
        {
            const int t = tid >> 3, k0 = (tid & 7) * 8;
            float qv[8], kv[8];
            unpack8(*(const uint4*)(P0 + (size_t)(c * 64 + t) * EIN + h * 64 + k0), qv);
            unpack8(*(const uint4*)(P0 + (size_t)(c * 64 + t) * EIN + 256 + h * 64 + k0), kv);
#pragma unroll
            for (int j = 0; j < 8; ++j) { const float bc = sBC[t * 65 + k0 + j]; qv[j] *= 0.125f * fexp(bc); kv[j] *= fexp(-bc); }
            *(uint4*)(qt + t * 72 + k0) = make_uint4(pack2bf(qv[0], qv[1]), pack2bf(qv[2], qv[3]), pack2bf(qv[4], qv[5]), pack2bf(qv[6], qv[7]));
            *(uint4*)(kt + t * 72 + k0) = make_uint4(pack2bf(kv[0], kv[1]), pack2bf(kv[2], kv[3]), pack2bf(kv[4], kv[5]), pack2bf(kv[6], kv[7]));
#pragma unroll
            for (int u = 0; u < 4; ++u) {
                const int i = tid + 512 * u, k = i >> 5, v4 = (i & 31) * 4;
                const float4 s4 = ld4(GDS + (size_t)(ch * NCH + c) * 8192 + k * 128 + v4);
                *(uint2*)(S0s + k * 136 + v4) = make_uint2(pack2bf(s4.x, s4.y), pack2bf(s4.z, s4.w));
            }
        }
        __syncthreads();
        {
            const int si = wave & 3;
#pragma unroll
            for (int jj = 0; jj < 2; ++jj) {
                const int t2 = (wave >> 2) * 2 + jj;
                f32x4 a = (f32x4){0.f, 0.f, 0.f, 0.f};
#pragma unroll
                for (int ks = 0; ks < 2; ++ks) a = __builtin_amdgcn_mfma_f32_16x16x32_bf16(row_frag(kt, 72, si * 16, ks * 32, lane), row_frag(qt, 72, t2 * 16, ks * 32, lane), a, 0, 0, 0);
                const int t = t2 * 16 + (lane & 15), s0 = si * 16 + (lane >> 4) * 4;
                float m[4];
#pragma unroll
                for (int r = 0; r < 4; ++r) { const bool keep = dir ? (s0 + r >= t) : (s0 + r <= t); m[r] = keep ? a[r] : 0.f; }
                *(uint2*)(Sm + t * 72 + s0) = make_uint2(pack2bf(m[0], m[1]), pack2bf(m[2], m[3]));
            }
        }
        __syncthreads();
#pragma unroll
        for (int ks = 0; ks < 2; ++ks) {
            const bf16x8 a1 = row_frag(qt, 72, ti * 16, ks * 32, lane), a2 = row_frag(Sm, 72, ti * 16, ks * 32, lane);
#pragma unroll
            for (int j = 0; j < 4; ++j) {
                acc[j] = __builtin_amdgcn_mfma_f32_16x16x32_bf16(a1, tr_frag(S0s, 136, ks * 32, (vt0 + j) * 16, lane), acc[j], 0, 0, 0);
                acc[j] = __builtin_amdgcn_mfma_f32_16x16x32_bf16(a2, tr_frag(Vs, 136, ks * 32, (vt0 + j) * 16, lane), acc[j], 0, 0, 0);
            }
        }
    }
#pragma unroll
    for (int j = 0; j < 4; ++j)
#pragma unroll
        for (int r = 0; r < 4; ++r) O[(ti * 16 + (lane >> 4) * 4 + r) * 132 + (vt0 + j) * 16 + (lane & 15)] = acc[j][r];
    __syncthreads();
    {
        const int t = tid >> 3, v0 = (tid & 7) * 16;
        float o[16];
        float ss = 0.f;
#pragma unroll
        for (int i = 0; i < 16; ++i) { o[i] = O[t * 132 + v0 + i]; ss += o[i] * o[i]; }
        ss += __shfl_xor(ss, 1, 64); ss += __shfl_xor(ss, 2, 64); ss += __shfl_xor(ss, 4, 64);
        const float rms = rsqrtf(ss * (1.f / 128.f) + 1e-5f);
        float g[16];
        const bf16_t* gp = P0 + (size_t)(c * 64 + t) * EIN + 1024 + h * 128 + v0;
        unpack8(*(const uint4*)gp, g); unpack8(*(const uint4*)(gp + 8), g + 8);
        float y[16];
#pragma unroll
        for (int i = 0; i < 16; ++i) y[i] = o[i] * rms * ng[v0 + i] * silu_f(g[i]);
        bf16_t* yp = YC + (size_t)(c * 64 + t) * 1024 + h * 128 + v0;
        *(uint4*)yp = make_uint4(pack2bf(y[0], y[1]), pack2bf(y[2], y[3]), pack2bf(y[4], y[5]), pack2bf(y[6], y[7]));
        *(uint4*)(yp + 8) = make_uint4(pack2bf(y[8], y[9]), pack2bf(y[10], y[11]), pack2bf(y[12], y[13]), pack2bf(y[14], y[15]));
    }
}

DEV void load8bf(const bf16_t* ptr, float* f) { unpack8(*(const uint4*)ptr, f); }
DEV void rw_mix8(const bf16_t* P0, int s, int cb, const float* __restrict__ mu, float* out) {
    float own[8]; load8bf(P0 + (size_t)s * EIN + RW0 + cb, own);
    int nL = -1, nR = -1, nU = -1, nD = -1;
    if (s < NCX) { if (s > 0) nL = s - 1; if (s < NCX - 1) nR = s + 1; }
    else { const int n = s - NCX, rr = n >> 6, cc = n & 63; if (cc > 0) nL = s - 1; if (cc < 63) nR = s + 1; if (rr > 0) nU = s - 64; if (rr < 127) nD = s + 64; }
    float fL[8], fR[8], fU[8], fD[8];
#pragma unroll
    for (int i = 0; i < 8; ++i) { fL[i] = 0.f; fR[i] = 0.f; fU[i] = 0.f; fD[i] = 0.f; }
    if (nL >= 0) load8bf(P0 + (size_t)nL * EIN + RW0 + cb, fL);
    if (nR >= 0) load8bf(P0 + (size_t)nR * EIN + RW0 + cb, fR);
    if (nU >= 0) load8bf(P0 + (size_t)nU * EIN + RW0 + cb, fU);
    if (nD >= 0) load8bf(P0 + (size_t)nD * EIN + RW0 + cb, fD);
    const float4 m0 = ld4(mu + cb), m1 = ld4(mu + cb + 4);
    const float m[8] = {m0.x, m0.y, m0.z, m0.w, m1.x, m1.y, m1.z, m1.w};
#pragma unroll
    for (int i = 0; i < 8; ++i) { const float nb = (i & 3) == 0 ? fL[i] : ((i & 3) == 1 ? fR[i] : ((i & 3) == 2 ? fU[i] : fD[i])); out[i] = own[i] + (nb - own[i]) * m[i]; }
}
DEV uint4 pack8(const float* f) { return make_uint4(pack2bf(f[0], f[1]), pack2bf(f[2], f[3]), pack2bf(f[4], f[5]), pack2bf(f[6], f[7])); }

template <int XM, int YM, class F>
DEV void mm64(const bf16_t* X, const bf16_t* Y, F f, int lane, int wave) {
#pragma unroll
    for (int q = 0; q < 2; ++q) {
        const int idx = wave * 2 + q, ti = idx >> 2, tj = idx & 3;
        f32x4 acc = (f32x4){0.f, 0.f, 0.f, 0.f};
#pragma unroll
        for (int ks = 0; ks < 2; ++ks) {
            const bf16x8 a = XM == 0 ? row_frag(X, 72, ti * 16, ks * 32, lane) : tr_frag(X, 72, ks * 32, ti * 16, lane);
            const bf16x8 bq = YM == 0 ? row_frag(Y, 72, tj * 16, ks * 32, lane) : tr_frag(Y, 72, ks * 32, tj * 16, lane);
            acc = __builtin_amdgcn_mfma_f32_16x16x32_bf16(a, bq, acc, 0, 0, 0);
        }
        f(ti * 16 + (lane >> 4) * 4, tj * 16 + (lane & 15), acc);
    }
}
template <int XM, int YM, class F>
DEV void mm64x2(const bf16_t* X1, const bf16_t* Y1, const bf16_t* X2, const bf16_t* Y2, F f, int lane, int wave) {
#pragma unroll
    for (int q = 0; q < 2; ++q) {
        const int idx = wave * 2 + q, ti = idx >> 2, tj = idx & 3;
        f32x4 acc = (f32x4){0.f, 0.f, 0.f, 0.f};
#pragma unroll
        for (int ks = 0; ks < 2; ++ks) {
            const bf16x8 a = XM == 0 ? row_frag(X1, 72, ti * 16, ks * 32, lane) : tr_frag(X1, 72, ks * 32, ti * 16, lane);
            const bf16x8 bq = YM == 0 ? row_frag(Y1, 72, tj * 16, ks * 32, lane) : tr_frag(Y1, 72, ks * 32, tj * 16, lane);
            acc = __builtin_amdgcn_mfma_f32_16x16x32_bf16(a, bq, acc, 0, 0, 0);
            const bf16x8 a2 = XM == 0 ? row_frag(X2, 72, ti * 16, ks * 32, lane) : tr_frag(X2, 72, ks * 32, ti * 16, lane);
            const bf16x8 b2 = YM == 0 ? row_frag(Y2, 72, tj * 16, ks * 32, lane) : tr_frag(Y2, 72, ks * 32, tj * 16, lane);
            acc = __builtin_amdgcn_mfma_f32_16x16x32_bf16(a2, b2, acc, 0, 0, 0);
        }
        f(ti * 16 + (lane >> 4) * 4, tj * 16 + (lane & 15), acc);
    }
}
DEV void st_img(bf16_t* P, int i0, int j, float a0, float a1, float a2, float a3) {
    P[(i0 + 0) * 72 + j] = __builtin_bit_cast(unsigned short, (__bf16)a0); P[(i0 + 1) * 72 + j] = __builtin_bit_cast(unsigned short, (__bf16)a1);
    P[(i0 + 2) * 72 + j] = __builtin_bit_cast(unsigned short, (__bf16)a2); P[(i0 + 3) * 72 + j] = __builtin_bit_cast(unsigned short, (__bf16)a3);
}

DEV void rwkv1_unit(const Params& p, int h, int dir, int c, float* sm) {
    const int tid = opaque_tid(), lane = tid & 63, wave = tid >> 6;
    const bf16_t* P0 = (const bf16_t*)(p.ws + OFF_P0);
    bf16_t* RU = (bf16_t*)(p.ws + OFF_RU) + (size_t)((h * 2 + dir) * NCH + c) * 16384;
    float* BONS = (float*)(p.ws + OFF_BONS);
    const float* mu = p.in[15];
    const float* w0 = p.in[dir ? 18 : 16]; const float* ww2 = p.in[dir ? 19 : 17];
    const float* a0 = p.in[dir ? 22 : 20]; const float* wa2 = p.in[dir ? 23 : 21];
    bf16_t* img = (bf16_t*)sm;
#define SLOT(i_) (img + (i_) * 4608)
    float* fLW = (float*)SLOT(10);
    float* fAS = (float*)SLOT(12);
    float* sv = (float*)SLOT(14);
    const int t = tid >> 3, j0 = (tid & 7) * 8, s = c * 64 + t;
    __syncthreads();
    if (tid < 64) { const int hc = h * 64 + tid; sv[64 + tid] = w0[hc]; sv[128 + tid] = a0[hc]; sv[192 + tid] = p.in[24][hc]; sv[256 + tid] = p.in[25][hc]; sv[320 + tid] = p.in[26][hc]; }
    float r8[8], k8[8], v8[8];
    {
        float x8[8];
        rw_mix8(P0, s, h * 64 + j0, mu, r8);
        rw_mix8(P0, s, 512 + h * 64 + j0, mu, k8);
        rw_mix8(P0, s, 1024 + h * 64 + j0, mu, v8);
        rw_mix8(P0, s, 2048 + dir * 64 + j0, mu, x8);
#pragma unroll
        for (int i = 0; i < 8; ++i) x8[i] = tanh_f(x8[i]);
        *(uint4*)(SLOT(6) + t * 72 + j0) = pack8(x8);
        rw_mix8(P0, s, 2176 + dir * 64 + j0, mu, x8);
        *(uint4*)(SLOT(7) + t * 72 + j0) = pack8(x8);
        float wq[8];
        { const float4 q0 = ld4(ww2 + (size_t)t * 512 + h * 64 + j0), q1 = ld4(ww2 + (size_t)t * 512 + h * 64 + j0 + 4); wq[0] = q0.x; wq[1] = q0.y; wq[2] = q0.z; wq[3] = q0.w; wq[4] = q1.x; wq[5] = q1.y; wq[6] = q1.z; wq[7] = q1.w; }
        *(uint4*)(SLOT(8) + t * 72 + j0) = pack8(wq);
        { const float4 q0 = ld4(wa2 + (size_t)t * 512 + h * 64 + j0), q1 = ld4(wa2 + (size_t)t * 512 + h * 64 + j0 + 4); wq[0] = q0.x; wq[1] = q0.y; wq[2] = q0.z; wq[3] = q0.w; wq[4] = q1.x; wq[5] = q1.y; wq[6] = q1.z; wq[7] = q1.w; }
        *(uint4*)(SLOT(9) + t * 72 + j0) = pack8(wq);
    }
    __syncthreads();
    mm64<0, 1>(SLOT(6), SLOT(8), [=](int i0, int j, f32x4 a) {
#pragma unroll
        for (int r = 0; r < 4; ++r) fLW[(i0 + r) * 65 + j] = -0.6065306597f * sigmoid_f(sv[64 + j] + a[r]); }, lane, wave);
    mm64<0, 1>(SLOT(7), SLOT(9), [=](int i0, int j, f32x4 a) {
#pragma unroll
        for (int r = 0; r < 4; ++r) fAS[(i0 + r) * 65 + j] = sigmoid_f(sv[128 + j] + a[r]); }, lane, wave);
    __syncthreads();
#pragma unroll
    for (int j = 0; j < 8; ++j) {
        const int k = wave * 8 + j;
        const float v = wave_scan_add(fLW[lane * 65 + k], lane, dir);
        fLW[lane * 65 + k] = v;
        if (lane == (dir ? 0 : 63)) sv[k] = v;
    }
    __syncthreads();
    {
        float kkv[8], ss = 0.f;
#pragma unroll
        for (int i = 0; i < 8; ++i) { kkv[i] = k8[i] * sv[192 + j0 + i]; ss += kkv[i] * kkv[i]; }
        ss += __shfl_xor(ss, 1, 64); ss += __shfl_xor(ss, 2, 64); ss += __shfl_xor(ss, 4, 64);
        const float rn = rsqrtf(fmaxf(ss, 1e-24f));
        float fa[8], fb[8], fk[8], fr[8], fbp[8], fkp[8], bon = 0.f;
        const int tp = dir ? t + 1 : t - 1;
        const bool hasp = dir ? (t < 63) : (t > 0);
#pragma unroll
        for (int i = 0; i < 8; ++i) {
            const int k = j0 + i;
            const float Bt = fLW[t * 65 + k], Bx = hasp ? fLW[tp * 65 + k] : 0.f, asg = fAS[t * 65 + k];
            const float kk = kkv[i] * rn, kh = k8[i] * (1.f + (asg - 1.f) * sv[256 + k]);
            bon += r8[i] * kh * sv[320 + k];
            const float enB = fexp(-Bt), eLB = fexp(sv[k] - Bt), bv = kk * asg;
            fa[i] = -kk * fexp(Bx); fb[i] = bv * enB; fk[i] = kh * enB; fr[i] = r8[i] * fexp(Bt); fbp[i] = bv * eLB; fkp[i] = kh * eLB;
        }
#ifdef RWKV_DEBUG
        if (c == 0 && dir == 0) {
            float* DBN = p.out + 9000000 + 8 * 64 * 64 * 6;
#pragma unroll
            for (int i = 0; i < 8; ++i) {
                const int k = j0 + i;
                const float Bt = fLW[t * 65 + k], Bx = hasp ? fLW[tp * 65 + k] : 0.f, asg = fAS[t * 65 + k];
                const float kk = kkv[i] * rn, kh = k8[i] * (1.f + (asg - 1.f) * sv[256 + k]);
                float* d = DBN + ((size_t)(h * 64 + t) * 64 + k) * 6;
                d[0] = fexp(Bt - Bx); d[1] = kh; d[2] = -kk; d[3] = kk * asg; d[4] = r8[i]; d[5] = v8[i];
            }
        }
#endif
        bon += __shfl_xor(bon, 1, 64); bon += __shfl_xor(bon, 2, 64); bon += __shfl_xor(bon, 4, 64);
        if ((tid & 7) == 0) BONS[((size_t)dir * TB + s) * 8 + h] = bon;
        *(uint4*)(SLOT(0) + t * 72 + j0) = pack8(fa); *(uint4*)(SLOT(1) + t * 72 + j0) = pack8(fb); *(uint4*)(SLOT(2) + t * 72 + j0) = pack8(fk);
        *(uint4*)(SLOT(3) + t * 72 + j0) = pack8(fr); *(uint4*)(SLOT(4) + t * 72 + j0) = pack8(fbp); *(uint4*)(SLOT(5) + t * 72 + j0) = pack8(fkp);
    }
    __syncthreads();
    *(uint4*)(SLOT(6) + t * 72 + j0) = pack8(v8);
    __syncthreads();
    mm64<0, 0>(SLOT(0), SLOT(1), [=](int i0, int j, f32x4 a) {
        float m[4];
#pragma unroll
        for (int r = 0; r < 4; ++r) { const bool keep = dir ? (j > i0 + r) : (j < i0 + r); m[r] = keep ? a[r] : 0.f; }
        const bool dg = (i0 >> 4) == (j >> 4);
        st_img(SLOT(7), i0, j, dg ? m[0] : 0.f, dg ? m[1] : 0.f, dg ? m[2] : 0.f, dg ? m[3] : 0.f);
        st_img(SLOT(8), i0, j, (dg ? m[0] : 0.f) + (j == i0 ? 1.f : 0.f), (dg ? m[1] : 0.f) + (j == i0 + 1 ? 1.f : 0.f), (dg ? m[2] : 0.f) + (j == i0 + 2 ? 1.f : 0.f), (dg ? m[3] : 0.f) + (j == i0 + 3 ? 1.f : 0.f));
        st_img(SLOT(12), i0, j, dg ? 0.f : m[0], dg ? 0.f : m[1], dg ? 0.f : m[2], dg ? 0.f : m[3]); }, lane, wave);
    mm64<0, 0>(SLOT(0), SLOT(2), [=](int i0, int j, f32x4 a) {
        float m[4];
#pragma unroll
        for (int r = 0; r < 4; ++r) { const bool keep = dir ? (j > i0 + r) : (j < i0 + r); m[r] = keep ? a[r] : 0.f; }
        st_img(SLOT(9), i0, j, m[0], m[1], m[2], m[3]); }, lane, wave);
    mm64<0, 0>(SLOT(3), SLOT(1), [=](int i0, int j, f32x4 a) {
        float m[4];
#pragma unroll
        for (int r = 0; r < 4; ++r) { const bool keep = dir ? (j >= i0 + r) : (j <= i0 + r); m[r] = keep ? a[r] : 0.f; }
        st_img(SLOT(10), i0, j, m[0], m[1], m[2], m[3]); }, lane, wave);
    mm64<0, 0>(SLOT(3), SLOT(2), [=](int i0, int j, f32x4 a) {
        float m[4];
#pragma unroll
        for (int r = 0; r < 4; ++r) { const bool keep = dir ? (j >= i0 + r) : (j <= i0 + r); m[r] = keep ? a[r] : 0.f; }
        st_img(SLOT(11), i0, j, m[0], m[1], m[2], m[3]); }, lane, wave);
    __syncthreads();
    {
        bf16_t* Pc = SLOT(7); bf16_t* Pn = SLOT(1); bf16_t* Tc = SLOT(8); bf16_t* Tn = SLOT(2);
#pragma unroll 1
        for (int it = 0; it < 3; ++it) {
            mm64<0, 1>(Pc, Pc, [=](int i0, int j, f32x4 a) { st_img(Pn, i0, j, a[0], a[1], a[2], a[3]); }, lane, wave);
            __syncthreads();
            mm64<0, 1>(Tc, Pn, [=](int i0, int j, f32x4 a) {
                st_img(Tn, i0, j, a[0] + bf2f(Tc[(i0 + 0) * 72 + j]), a[1] + bf2f(Tc[(i0 + 1) * 72 + j]), a[2] + bf2f(Tc[(i0 + 2) * 72 + j]), a[3] + bf2f(Tc[(i0 + 3) * 72 + j])); }, lane, wave);
            __syncthreads();
            bf16_t* tmp = Pc; Pc = Pn; Pn = tmp; tmp = Tc; Tc = Tn; Tn = tmp;
        }
    }
    mm64<0, 1>(SLOT(2), SLOT(12), [=](int i0, int j, f32x4 a) { st_img(SLOT(7), i0, j, a[0], a[1], a[2], a[3]); }, lane, wave);
    mm64<0, 1>(SLOT(2), SLOT(0), [=](int i0, int j, f32x4 a) { st_img(SLOT(1), i0, j, a[0], a[1], a[2], a[3]); }, lane, wave);
    mm64<0, 1>(SLOT(9), SLOT(6), [=](int i0, int j, f32x4 a) { st_img(SLOT(13), i0, j, a[0], a[1], a[2], a[3]); }, lane, wave);
    __syncthreads();
    mm64<0, 1>(SLOT(2), SLOT(13), [=](int i0, int j, f32x4 a) { st_img(SLOT(8), i0, j, a[0], a[1], a[2], a[3]); }, lane, wave);
    __syncthreads();
    {
        const bf16_t* Zp = (wave < 4) ? SLOT(1) : SLOT(8);
        bf16_t* Xi = (wave < 4) ? SLOT(12) : SLOT(9);
        const int ct = (wave & 3) * 16, g4 = (lane >> 4) * 4, l15 = lane & 15;
#pragma unroll
        for (int bs = 0; bs < 4; ++bs) {
            const int bi = dir ? 3 - bs : bs;
            f32x4 acc;
#pragma unroll
            for (int r = 0; r < 4; ++r) acc[r] = bf2f(Zp[(bi * 16 + g4 + r) * 72 + ct + l15]);
            const bool k0 = dir ? (bi == 0) : (bi >= 1), k1 = dir ? (bi <= 2) : (bi == 3);
            if (k0) acc = __builtin_amdgcn_mfma_f32_16x16x32_bf16(row_frag(SLOT(7), 72, bi * 16, 0, lane), tr_frag(Xi, 72, 0, ct, lane), acc, 0, 0, 0);
            if (k1) acc = __builtin_amdgcn_mfma_f32_16x16x32_bf16(row_frag(SLOT(7), 72, bi * 16, 32, lane), tr_frag(Xi, 72, 32, ct, lane), acc, 0, 0, 0);
            st_img(Xi, bi * 16 + g4, ct + l15, acc[0], acc[1], acc[2], acc[3]);
            __syncthreads();
        }
    }
    mm64<1, 1>(SLOT(12), SLOT(4), [=](int i0, int j, f32x4 a) {
        float m[4];
#pragma unroll
        for (int r = 0; r < 4; ++r) m[r] = a[r] + ((i0 + r) == j ? fexp(sv[j]) : 0.f);
        *(uint2*)(RU + j * 64 + i0) = make_uint2(pack2bf(m[0], m[1]), pack2bf(m[2], m[3])); }, lane, wave);
    mm64x2<1, 1>(SLOT(4), SLOT(9), SLOT(5), SLOT(6), [=](int i0, int j, f32x4 a) {
        *(uint2*)(RU + 4096 + j * 64 + i0) = make_uint2(pack2bf(a[0], a[1]), pack2bf(a[2], a[3])); }, lane, wave);
    mm64<1, 0>(SLOT(12), SLOT(10), [=](int i0, int j, f32x4 a) {
        const uint2 rr = *(const uint2*)(SLOT(3) + j * 72 + i0);
        *(uint2*)(RU + 8192 + j * 64 + i0) = make_uint2(pack2bf(a[0] + bflo(rr.x), a[1] + bfhi(rr.x)), pack2bf(a[2] + bflo(rr.y), a[3] + bfhi(rr.y))); }, lane, wave);
    mm64x2<0, 1>(SLOT(10), SLOT(9), SLOT(11), SLOT(6), [=](int i0, int j, f32x4 a) {
        *(uint2*)(RU + 12288 + j * 64 + i0) = make_uint2(pack2bf(a[0], a[1]), pack2bf(a[2], a[3])); }, lane, wave);
#undef SLOT
}

DEV void rwkv2_unit(const Params& p, int chain, int vblk, int lane) {
    asm volatile("" : "+v"(lane));
    const bf16_t* RU = (const bf16_t*)(p.ws + OFF_RU);
    bf16_t* S0G = (bf16_t*)(p.ws + OFF_RS0);
    const int dir = chain & 1, g = lane >> 4, l15 = lane & 15;
    f32x4 st[4];
#pragma unroll
    for (int i = 0; i < 4; ++i) st[i] = (f32x4){0.f, 0.f, 0.f, 0.f};
    uint2 na[4][2][2], nc[4];
    {
        const bf16_t* U = RU + (size_t)(chain * NCH + chunk_at(dir, 0)) * 16384;
#pragma unroll
        for (int i = 0; i < 4; ++i) {
            nc[i] = *(const uint2*)(U + 4096 + (vblk * 16 + l15) * 64 + i * 16 + g * 4);
#pragma unroll
            for (int ks = 0; ks < 2; ++ks) { na[i][ks][0] = *(const uint2*)(U + (i * 16 + l15) * 64 + ks * 32 + g * 4); na[i][ks][1] = *(const uint2*)(U + (i * 16 + l15) * 64 + ks * 32 + 16 + g * 4); }
        }
    }
#pragma unroll 1
    for (int step = 0; step < NCH; ++step) {
        const int c = chunk_at(dir, step);
        uint2 ca[4][2][2], cc[4];
#pragma unroll
        for (int i = 0; i < 4; ++i) { cc[i] = nc[i]; ca[i][0][0] = na[i][0][0]; ca[i][0][1] = na[i][0][1]; ca[i][1][0] = na[i][1][0]; ca[i][1][1] = na[i][1][1]; }
        {
            const int cn = chunk_at(dir, step + 1 < NCH ? step + 1 : step);
            const bf16_t* U = RU + (size_t)(chain * NCH + cn) * 16384;
#pragma unroll
            for (int i = 0; i < 4; ++i) {
                nc[i] = *(const uint2*)(U + 4096 + (vblk * 16 + l15) * 64 + i * 16 + g * 4);
#pragma unroll
                for (int ks = 0; ks < 2; ++ks) { na[i][ks][0] = *(const uint2*)(U + (i * 16 + l15) * 64 + ks * 32 + g * 4); na[i][ks][1] = *(const uint2*)(U + (i * 16 + l15) * 64 + ks * 32 + 16 + g * 4); }
            }
        }
        unsigned pk[4][2];
#pragma unroll
        for (int i = 0; i < 4; ++i) { pk[i][0] = pack2bf(st[i][0], st[i][1]); pk[i][1] = pack2bf(st[i][2], st[i][3]); }
        bf16_t* sp = S0G + ((size_t)(chain * NCH + c) * 64 + vblk * 16 + l15) * 64 + g * 4;
#pragma unroll
        for (int i = 0; i < 4; ++i) *(uint2*)(sp + i * 16) = make_uint2(pk[i][0], pk[i][1]);
        bf16x8 bfr[2];
#pragma unroll
        for (int ks = 0; ks < 2; ++ks) { const uint4 u = make_uint4(pk[2 * ks][0], pk[2 * ks][1], pk[2 * ks + 1][0], pk[2 * ks + 1][1]); bfr[ks] = __builtin_bit_cast(bf16x8, u); }
#pragma unroll
        for (int i = 0; i < 4; ++i) {
            f32x4 acc = (f32x4){bflo(cc[i].x), bfhi(cc[i].x), bflo(cc[i].y), bfhi(cc[i].y)};
#pragma unroll
            for (int ks = 0; ks < 2; ++ks) {
                const uint4 u = make_uint4(ca[i][ks][0].x, ca[i][ks][0].y, ca[i][ks][1].x, ca[i][ks][1].y);
                acc = __builtin_amdgcn_mfma_f32_16x16x32_bf16(__builtin_bit_cast(bf16x8, u), bfr[ks], acc, 0, 0, 0);
            }
            st[i] = acc;
        }
    }
}

DEV void rwkv3_unit(const Params& p, int h, int c, float* sm, bool dbg_on = false) {
    const int tid = opaque_tid(), lane = tid & 63, wave = tid >> 6;
    const bf16_t* P0 = (const bf16_t*)(p.ws + OFF_P0);
    const bf16_t* RUb = (const bf16_t*)(p.ws + OFF_RU);
    const bf16_t* S0G = (const bf16_t*)(p.ws + OFF_RS0);
    const float* BONS = (const float*)(p.ws + OFF_BONS);
    bf16_t* YC = (bf16_t*)(p.ws + OFF_YC);
    const float* mu = p.in[15]; const float* gn_g = p.in[27]; const float* gn_b = p.in[28];
    bf16_t* img = (bf16_t*)sm;
    float* O = sm + 4 * 2304;
#ifdef RWKV_DEBUG
    float* Od = O + 64 * 68;
#endif
    __syncthreads();
    {
        const int row = tid >> 3, c8 = (tid & 7) * 8;
#pragma unroll
        for (int dir = 0; dir < 2; ++dir) {
            const size_t u = (size_t)((h * 2 + dir) * NCH + c);
            *(uint4*)(img + dir * 4608 + row * 72 + c8) = *(const uint4*)(RUb + u * 16384 + 8192 + row * 64 + c8);
            *(uint4*)(img + (2 + dir) * 4608 + row * 72 + c8) = *(const uint4*)(S0G + u * 4096 + row * 64 + c8);
        }
    }
    __syncthreads();
#pragma unroll
    for (int q = 0; q < 2; ++q) {
        const int idx = wave * 2 + q, ti = idx >> 2, tj = idx & 3;
        f32x4 accd[2];
#pragma unroll
        for (int dir = 0; dir < 2; ++dir) {
            f32x4 acc = (f32x4){0.f, 0.f, 0.f, 0.f};
#pragma unroll
            for (int ks = 0; ks < 2; ++ks) acc = __builtin_amdgcn_mfma_f32_16x16x32_bf16(row_frag(img + dir * 4608, 72, ti * 16, ks * 32, lane), row_frag(img + (2 + dir) * 4608, 72, tj * 16, ks * 32, lane), acc, 0, 0, 0);
            const uint2 yl = *(const uint2*)(RUb + (size_t)((h * 2 + dir) * NCH + c) * 16384 + 12288 + (tj * 16 + (lane & 15)) * 64 + ti * 16 + (lane >> 4) * 4);
            acc[0] += bflo(yl.x); acc[1] += bfhi(yl.x); acc[2] += bflo(yl.y); acc[3] += bfhi(yl.y);
            accd[dir] = acc;
        }
#pragma unroll
        for (int r = 0; r < 4; ++r) {
            const int oi = (ti * 16 + (lane >> 4) * 4 + r) * 68 + tj * 16 + (lane & 15);
            O[oi] = accd[0][r] + accd[1][r];
#ifdef RWKV_DEBUG
            Od[oi] = ((DBG_DIRMASK & 1) ? accd[0][r] : 0.f) + ((DBG_DIRMASK & 2) ? accd[1][r] : 0.f);
#endif
        }
    }
    __syncthreads();
    {
        const int t = tid >> 3, v0 = (tid & 7) * 8, s = c * 64 + t;
        float y[8], sum = 0.f;
#pragma unroll
        for (int i = 0; i < 8; ++i) { y[i] = O[t * 68 + v0 + i]; sum += y[i]; }
#ifdef RWKV_DEBUG
        if (dbg_on && c >= DBG_CMIN && c < DBG_CMAX) {
            float num = 0.f, den = 0.f;
#pragma unroll
            for (int i = 0; i < 8; ++i) {
                if (DBG_MODE == 1) { const float o = p.out[(size_t)s * 1024 + 512 + h * 64 + v0 + i]; const float yd = DBG_SELFTEST ? 1.05f * o : Od[t * 68 + v0 + i]; num += (yd - o) * (yd - o); den += o * o; }
                else { const float* dold = p.out + 9000000 + ((size_t)(h * 64 + t) * 64 + v0 + i) * 6; const float* dn = dold + 8 * 64 * 64 * 6;
                       for (int q = 1; q < 6; ++q) { const float o = dold[q], n = dn[q]; num += (n - o) * (n - o); den += o * o; } }
            }
            num = wave_sum(num); den = wave_sum(den);
            if (lane == 0) { atomicAdd((unsigned long long*)(p.ws + OFF_X1C + 2200000), (unsigned long long)(fminf(num, 1e12f) * 1048576.f)); atomicAdd((unsigned long long*)(p.ws + OFF_X1C + 2200008), (unsigned long long)(fminf(den, 1e12f) * 1048576.f)); }
        }
#endif
        sum += __shfl_xor(sum, 1, 64); sum += __shfl_xor(sum, 2, 64); sum += __shfl_xor(sum, 4, 64);
        const float mean = sum * (1.f / 64.f);
        float sq = 0.f;
#pragma unroll
        for (int i = 0; i < 8; ++i) { y[i] -= mean; sq += y[i] * y[i]; }
        sq += __shfl_xor(sq, 1, 64); sq += __shfl_xor(sq, 2, 64); sq += __shfl_xor(sq, 4, 64);
        const float rstd = rsqrtf(sq * (1.f / 64.f) + 64e-5f);
        float vm[8], gm[8];
        rw_mix8(P0, s, 1024 + h * 64 + v0, mu, vm);
        rw_mix8(P0, s, 1536 + h * 64 + v0, mu, gm);
        const float bon = BONS[(size_t)s * 8 + h] + BONS[((size_t)TB + s) * 8 + h];
        float o[8];
#pragma unroll
        for (int i = 0; i < 8; ++i) o[i] = (y[i] * rstd * gn_g[h * 64 + v0 + i] + gn_b[h * 64 + v0 + i] + bon * vm[i]) * silu_f(gm[i]);
        *(uint4*)(YC + (size_t)s * 1024 + 512 + h * 64 + v0) = pack8(o);
    }
}

DEV void ln_rows(const float* src, int nrows, const float* __restrict__ g, const float* __restrict__ bt, float* dst_lat, float* dst_cx, int ncx) {
    const int tid_ = opaque_tid(); const int lane = tid_ & 63, gw = blockIdx.x * NWV + (tid_ >> 6), ngw = gridDim.x * NWV;
    for (int r = gw; r < nrows; r += ngw) {
        const float* x = src + (size_t)r * 1024;
        float4 v[4];
        float sum = 0.f;
#pragma unroll
        for (int i = 0; i < 4; ++i) { v[i] = ld4(x + i * 256 + lane * 4); sum += v[i].x + v[i].y + v[i].z + v[i].w; }
        const float mean = wave_sum(sum) * (1.f / 1024.f);
        float sq = 0.f;
#pragma unroll
        for (int i = 0; i < 4; ++i) {
            v[i].x -= mean; v[i].y -= mean; v[i].z -= mean; v[i].w -= mean;
            sq += v[i].x * v[i].x + v[i].y * v[i].y + v[i].z * v[i].z + v[i].w * v[i].w;
        }
        const float rstd = rsqrtf(wave_sum(sq) * (1.f / 1024.f) + 1e-5f);
        float* d = (r < ncx) ? (dst_cx + (size_t)r * 1024) : (dst_lat + (size_t)(r - ncx) * 1024);
#pragma unroll
        for (int i = 0; i < 4; ++i) {
            const int c = i * 256 + lane * 4;
            const float4 gg = ld4(g + c), bb = ld4(bt + c);
            st4(d + c, make_float4(v[i].x * rstd * gg.x + bb.x, v[i].y * rstd * gg.y + bb.y, v[i].z * rstd * gg.z + bb.z, v[i].w * rstd * gg.w + bb.w));
        }
    }
}

DEV void zero_f4(float* ptr, size_t nfloat) {
    const size_t n4 = nfloat / 4;
    for (size_t i = (size_t)blockIdx.x * NTHR + opaque_tid(); i < n4; i += (size_t)gridDim.x * NTHR) ((float4*)ptr)[i] = make_float4(0.f, 0.f, 0.f, 0.f);
}

DEV void chain_ids(int& chain, int& sub) {
    const int bid = blockIdx.x, xcd = bid & 7, idx = bid >> 3;
    chain = xcd * 2 + (idx >> 4); sub = idx & 15;
}

DEV void phase_conv1(const Params& p, float* sm) {
    const bf16_t* XM = (const bf16_t*)(p.ws + OFF_XM);
    bf16_t* XC = (bf16_t*)(p.ws + OFF_XC);
    float* G16P = (float*)(p.ws + OFF_G16P);
    const bf16_t* WFT = (const bf16_t*)(p.ws + OFF_WFT);
    const float* cw = p.in[31]; const float* cbias = p.in[32];
    bf16_t* imgC = (bf16_t*)sm;
    bf16_t* imgM = imgC + 64 * 264;
    float* red = (float*)(imgM + 64 * 264);
    const int tid = opaque_tid(), lane = tid & 63, wave = tid >> 6, t = tid >> 3, cg = tid & 7;
    for (int u = blockIdx.x; u < NB * NCH * 4; u += gridDim.x) {
        const int ci = u >> 2, q = u & 3, b = ci / NCH, c = ci % NCH, s = c * 64 + t;
        const size_t rowbase = (size_t)b * TB;
        int nrow[9];
#pragma unroll
        for (int i = 0; i < 3; ++i)
#pragma unroll
            for (int j = 0; j < 3; ++j) {
                int ns = -1;
                if (s < NCX) { const int w2 = s + j - 1; if (i == 1 && w2 >= 0 && w2 < NCX) ns = w2; }
                else { const int n = s - NCX, rr = (n >> 6) + i - 1, w2 = (n & 63) + j - 1; if (rr >= 0 && rr < 128 && w2 >= 0 && w2 < 64) ns = NCX + rr * 64 + w2; }
                nrow[i * 3 + j] = ns;
            }
        const int tt = wave & 3, part = wave >> 2;
        f32x4 acc = (f32x4){0.f, 0.f, 0.f, 0.f};
#pragma unroll 1
        for (int half = 0; half < 2; ++half) {
            __syncthreads();
#pragma unroll 2
            for (int it = 0; it < 4; ++it) {
                const int cl = it * 64 + cg * 8, c0 = q * 512 + half * 256 + cl;
                float a8[8];
                { const float4 b0 = ld4(cbias + c0), b1 = ld4(cbias + c0 + 4); a8[0] = b0.x; a8[1] = b0.y; a8[2] = b0.z; a8[3] = b0.w; a8[4] = b1.x; a8[5] = b1.y; a8[6] = b1.z; a8[7] = b1.w; }
                uint4 xmc = make_uint4(0u, 0u, 0u, 0u);
#pragma unroll
                for (int tap = 0; tap < 9; ++tap) {
                    if (nrow[tap] >= 0) {
                        const uint4 xv = *(const uint4*)(XM + (rowbase + nrow[tap]) * 2048 + c0);
                        float x8[8]; unpack8(xv, x8);
                        const float4 w0 = ld4(cw + tap * 2048 + c0), w1 = ld4(cw + tap * 2048 + c0 + 4);
                        a8[0] += x8[0] * w0.x; a8[1] += x8[1] * w0.y; a8[2] += x8[2] * w0.z; a8[3] += x8[3] * w0.w;
                        a8[4] += x8[4] * w1.x; a8[5] += x8[5] * w1.y; a8[6] += x8[6] * w1.z; a8[7] += x8[7] * w1.w;
                        if (tap == 4) xmc = xv;
                    }
                }
#pragma unroll
                for (int i = 0; i < 8; ++i) a8[i] = silu_f(a8[i]);
                const uint4 xcv = pack8(a8);
                *(uint4*)(XC + (rowbase + s) * 2048 + c0) = xcv;
                *(uint4*)(imgC + t * 264 + cl) = xcv;
                *(uint4*)(imgM + t * 264 + cl) = xmc;
            }
            __syncthreads();
            {
                const bf16_t* img = part ? imgM : imgC;
                const bf16_t* wrow = WFT + (size_t)(lane & 15) * 4096 + part * 2048 + q * 512 + half * 256 + (lane >> 4) * 8;
#pragma unroll
                for (int ks = 0; ks < 8; ++ks) acc = __builtin_amdgcn_mfma_f32_16x16x32_bf16(row_frag(img, 264, tt * 16, ks * 32, lane), *(const bf16x8*)(wrow + ks * 32), acc, 0, 0, 0);
            }
        }
        if (part == 1) {
#pragma unroll
            for (int r = 0; r < 4; ++r) red[(tt * 16 + (lane >> 4) * 4 + r) * 16 + (lane & 15)] = acc[r];
        }
        __syncthreads();
        if (part == 0) {
#pragma unroll
            for (int r = 0; r < 4; ++r) {
                const int tk = tt * 16 + (lane >> 4) * 4 + r;
                G16P[((size_t)q * RT + rowbase + c * 64 + tk) * 16 + (lane & 15)] = acc[r] + red[tk * 16 + (lane & 15)];
            }
        }
    }
}

DEV void gate_pair(const Params& p, size_t row, int dir, int h, float& gi, float& lf) {
    const float* G16P = (const float*)(p.ws + OFF_G16P);
    float a = 0.f, f = 0.f;
#pragma unroll
    for (int q = 0; q < 4; ++q) { a += G16P[((size_t)q * RT + row) * 16 + dir * 8 + h]; f += G16P[((size_t)q * RT + row) * 16 + dir * 8 + 4 + h]; }
    gi = a + p.in[dir ? 41 : 37][h];
    lf = logsig_f(f + p.in[dir ? 43 : 39][h]);
}

DEV void phase_x1(const Params& p, float* sm) {
    int chain, sub; chain_ids(chain, sub);
    const int b = chain >> 3, h = (chain >> 1) & 3, dir = chain & 1;
    const bf16_t* XC = (const bf16_t*)(p.ws + OFF_XC);
    float* GSC = (float*)(p.ws + OFF_GSC); float* CSC = (float*)(p.ws + OFF_CSC); float* NBUF = (float*)(p.ws + OFF_NBUF);
    const float* gtab = (const float*)(p.ws + OFF_GTAB);
    bf16_t* SMAT = (bf16_t*)(p.ws + OFF_SMAT);
    const int tid = opaque_tid(), lane = tid & 63, wave = tid >> 6;
    float* sTot = sm; float* sRef = sm + 132; float* sM0 = sm + 264; float* sBeta = sm + 400;
    for (int c = wave; c < NCH; c += NWV) {
        const size_t row = (size_t)b * TB + c * 64 + lane;
        float gi, lf; gate_pair(p, row, dir, h, gi, lf);
        const float bc = wave_scan_add(lf, lane, dir);
        const float ref = wave_max(gi - bc), tot = wave_sum(lf);
        if (lane == 0) { sTot[c] = tot; sRef[c] = ref; }
    }
    __syncthreads();
    if (tid == 0) {
        float m0 = -INFINITY;
        for (int step = 0; step < NCH; ++step) {
            const int c = chunk_at(dir, step);
            sM0[c] = m0;
            const float mx = fmaxf(m0, sRef[c]);
            if (sub == 0) { CSC[(chain * NCH + c) * 2] = fexp(m0 - mx); CSC[(chain * NCH + c) * 2 + 1] = fexp(sRef[c] - mx); }
            m0 = sTot[c] + mx;
        }
    }
    __syncthreads();
    for (int k = wave; sub + 16 * k < NCH; k += NWV) {
        const int c = sub + 16 * k;
        const size_t row = (size_t)b * TB + c * 64 + lane;
        float gi, lf; gate_pair(p, row, dir, h, gi, lf);
        const float bc = wave_scan_add(lf, lane, dir);
        const float a = gi - bc;
        const float amax = wave_scan_max(a, lane, dir);
        const float ref = sRef[c], m0 = sM0[c];
        const float mmax = fmaxf(amax, m0);
        const float mt = bc + mmax;
        const float alpha = fexp(ref - mmax), beta = fexp(a - ref), gg = fexp(m0 - mmax), em = fexp(-mt);
        st4(GSC + ((size_t)chain * TB + c * 64 + lane) * 4, make_float4(alpha, beta, gg, em));
        sBeta[k * 64 + lane] = beta;
    }
    __syncthreads();
    for (int k = 0; sub + 16 * k < NCH; ++k) {
        const int c = sub + 16 * k;
        const bf16_t* xp = XC + ((size_t)b * TB + c * 64) * 2048 + h * 512 + tid;
        float acc = 0.f;
#pragma unroll 8
        for (int s = 0; s < 64; ++s) acc += sBeta[k * 64 + s] * bf2f(xp[(size_t)s * 2048]);
        NBUF[((size_t)chain * NCH + c) * 512 + tid] = acc;
    }
    bf16_t* XCs = (bf16_t*)sm;
    bf16_t* Qs = XCs + 64 * 520;
    for (int u = blockIdx.x; u < NB * 4 * NCH; u += gridDim.x) {
        const int bh = u / NCH, c = u % NCH, ub = bh >> 2, uh = bh & 3;
        __syncthreads();
#pragma unroll 2
        for (int i = 0; i < 8; ++i) {
            const int pp = tid + 512 * i, row = pp >> 6, c16 = pp & 63;
            const uint4 xv = *(const uint4*)(XC + ((size_t)ub * TB + c * 64 + row) * 2048 + uh * 512 + c16 * 8);
            float f[8]; unpack8(xv, f);
            float q[8];
#pragma unroll
            for (int bb = 0; bb < 2; ++bb) {
                const float* G = gtab + (size_t)(uh * 128 + c16 * 2 + bb) * 16;
                const float4 g0 = ld4(G), g1 = ld4(G + 4), g2 = ld4(G + 8), g3 = ld4(G + 12);
                q[bb * 4 + 0] = f[bb * 4] * g0.x + f[bb * 4 + 1] * g1.x + f[bb * 4 + 2] * g2.x + f[bb * 4 + 3] * g3.x;
                q[bb * 4 + 1] = f[bb * 4] * g0.y + f[bb * 4 + 1] * g1.y + f[bb * 4 + 2] * g2.y + f[bb * 4 + 3] * g3.y;
                q[bb * 4 + 2] = f[bb * 4] * g0.z + f[bb * 4 + 1] * g1.z + f[bb * 4 + 2] * g2.z + f[bb * 4 + 3] * g3.z;
                q[bb * 4 + 3] = f[bb * 4] * g0.w + f[bb * 4 + 1] * g1.w + f[bb * 4 + 2] * g2.w + f[bb * 4 + 3] * g3.w;
            }
            *(uint4*)(XCs + row * 520 + c16 * 8) = xv;
            *(uint4*)(Qs + row * 520 + c16 * 8) = make_uint4(pack2bf(q[0], q[1]), pack2bf(q[2], q[3]), pack2bf(q[4], q[5]), pack2bf(q[6], q[7]));
        }
        __syncthreads();
        const int st = wave & 3, tt0 = (wave >> 2) * 2;
        f32x4 a0 = (f32x4){0.f, 0.f, 0.f, 0.f}, a1 = a0;
        const bf16_t* ap = XCs + (st * 16 + (lane & 15)) * 520 + (lane >> 4) * 8;
        const bf16_t* bp0 = Qs + (tt0 * 16 + (lane & 15)) * 520 + (lane >> 4) * 8;
        const bf16_t* bp1 = bp0 + 16 * 520;
#pragma unroll
        for (int ks = 0; ks < 16; ++ks) {
            const bf16x8 af = *(const bf16x8*)(ap + ks * 32);
            a0 = __builtin_amdgcn_mfma_f32_16x16x32_bf16(af, *(const bf16x8*)(bp0 + ks * 32), a0, 0, 0, 0);
            a1 = __builtin_amdgcn_mfma_f32_16x16x32_bf16(af, *(const bf16x8*)(bp1 + ks * 32), a1, 0, 0, 0);
        }
        bf16_t* sp = SMAT + (size_t)u * 4096 + (size_t)(tt0 * 16 + (lane & 15)) * 64 + st * 16 + (lane >> 4) * 4;
        *(uint2*)sp = make_uint2(pack2bf(a0[0], a0[1]), pack2bf(a0[2], a0[3]));
        *(uint2*)(sp + 16 * 64) = make_uint2(pack2bf(a1[0], a1[1]), pack2bf(a1[2], a1[3]));
    }
}

DEV void phase_x2(const Params& p, float* sm) {
    int chain, sub; chain_ids(chain, sub);
    const int b = chain >> 3, h = (chain >> 1) & 3, dir = chain & 1;
    const bf16_t* XC = (const bf16_t*)(p.ws + OFF_XC);
    float* GSC = (float*)(p.ws + OFF_GSC); const float* CSC = (const float*)(p.ws + OFF_CSC); const float* NBUF = (const float*)(p.ws + OFF_NBUF);
    const float* gtab = (const float*)(p.ws + OFF_GTAB);
    const bf16_t* SMAT = (const bf16_t*)(p.ws + OFF_SMAT);
    const int tid = opaque_tid();
    float* sD0 = sm; float* sCf = sm + 132; float* sN0 = sm + 264; float* sN2 = sN0 + 9 * 512;
    for (int i = tid; i < NCH; i += NTHR) { sD0[i] = CSC[(chain * NCH + i) * 2]; sCf[i] = CSC[(chain * NCH + i) * 2 + 1]; }
    __syncthreads();
    {
        float n = 0.f;
        const float* nb = NBUF + (size_t)chain * NCH * 512 + tid;
#pragma unroll 4
        for (int step = 0; step < NCH; ++step) {
            const int c = chunk_at(dir, step);
            if ((c & 15) == sub) sN0[(c >> 4) * 512 + tid] = n;
            n = sD0[c] * n + sCf[c] * nb[(size_t)c * 512];
        }
    }
    __syncthreads();
    {
        const int blk = tid >> 2, cp = tid & 3;
        const float4 g = ld4(gtab + (size_t)(h * 128 + blk) * 16 + cp * 4);
        for (int k = 0; sub + 16 * k < NCH; ++k) {
            const float* n0 = sN0 + k * 512 + blk * 4;
            sN2[k * 512 + tid] = g.x * n0[0] + g.y * n0[1] + g.z * n0[2] + g.w * n0[3];
        }
    }
    __syncthreads();
    const int t = tid >> 3, part = tid & 7;
    for (int k = 0; sub + 16 * k < NCH; ++k) {
        const int c = sub + 16 * k;
        const size_t row = (size_t)b * TB + c * 64 + t;
        float dint = 0.f;
        {
            const bf16_t* xp = XC + row * 2048 + h * 512 + part * 64;
            const float* n2 = sN2 + k * 512 + part * 64;
#pragma unroll
            for (int i = 0; i < 8; ++i) {
                float f[8]; unpack8(*(const uint4*)(xp + i * 8), f);
                const float4 na = ld4(n2 + i * 8), nb2 = ld4(n2 + i * 8 + 4);
                dint += f[0] * na.x + f[1] * na.y + f[2] * na.z + f[3] * na.w + f[4] * nb2.x + f[5] * nb2.y + f[6] * nb2.z + f[7] * nb2.w;
            }
        }
        float di = 0.f;
        {
            float f[8]; unpack8(*(const uint4*)(SMAT + ((size_t)((b * 4 + h) * NCH + c)) * 4096 + t * 64 + part * 8), f);
#pragma unroll
            for (int e = 0; e < 8; ++e) {
                const int s = part * 8 + e;
                const float beta = GSC[((size_t)chain * TB + c * 64 + s) * 4 + 1];
                const bool keep = dir ? (s >= t) : (s <= t);
                di += keep ? f[e] * beta : 0.f;
            }
        }
        dint += __shfl_xor(dint, 1, 64); dint += __shfl_xor(dint, 2, 64); dint += __shfl_xor(dint, 4, 64);
        di += __shfl_xor(di, 1, 64); di += __shfl_xor(di, 2, 64); di += __shfl_xor(di, 4, 64);
        if (part == 0) {
            float* gp = GSC + ((size_t)chain * TB + c * 64 + t) * 4;
            const float4 g4 = ld4(gp);
            const float den = g4.x * di + g4.z * dint;
            gp[3] = 1.f / fmaxf(fabsf(den), g4.w);
        }
    }
}

#define MLSTM_PREFETCH(step_) do { \
    const int c_ = chunk_at(dir, (step_)); const size_t rb_ = (size_t)b * TB + (size_t)c_ * 64; \
    { const bf16_t* xb_ = XC + (rb_ + (tid >> 6)) * 2048 + h * 512 + (tid & 63) * 8; \
      rx0 = *(const uint4*)(xb_); rx1 = *(const uint4*)(xb_ + 8 * 2048); rx2 = *(const uint4*)(xb_ + 16 * 2048); rx3 = *(const uint4*)(xb_ + 24 * 2048); \
      rx4 = *(const uint4*)(xb_ + 32 * 2048); rx5 = *(const uint4*)(xb_ + 40 * 2048); rx6 = *(const uint4*)(xb_ + 48 * 2048); rx7 = *(const uint4*)(xb_ + 56 * 2048); } \
    rxm = *(const uint2*)(XM + (rb_ + ps) * 2048 + ch0 + pvb * 4); \
    rs = *(const uint4*)(SMAT + ((size_t)((b * 4 + h) * NCH + c_)) * 4096 + ps * 64 + pvb * 8); \
    rbeta = GSC[((size_t)chain * TB + c_ * 64 + ps) * 4 + 1]; \
    if (tid < 64) rsc = ld4(GSC + ((size_t)chain * TB + c_ * 64 + tid) * 4); \
    rd0 = CSC[(chain * NCH + c_) * 2]; rcf = CSC[(chain * NCH + c_) * 2 + 1]; } while (0)

DEV void phase_mlstm(const Params& p, float* sm) {
    int chain, sub; chain_ids(chain, sub);
    const int b = chain >> 3, h = (chain >> 1) & 3, dir = chain & 1;
    const bf16_t* XM = (const bf16_t*)(p.ws + OFF_XM);
    const bf16_t* XC = (const bf16_t*)(p.ws + OFF_XC);
    const bf16_t* SMAT = (const bf16_t*)(p.ws + OFF_SMAT);
    const float* GSC = (const float*)(p.ws + OFF_GSC); const float* CSC = (const float*)(p.ws + OFF_CSC);
    const float* gtab = (const float*)(p.ws + OFF_GTAB);
    bf16_t* H = (bf16_t*)(p.ws + OFF_H);
    const float* wv = p.in[35];
    char* smc = (char*)sm;
    bf16_t* XCs = (bf16_t*)smc;
    bf16_t* Cs = (bf16_t*)(smc + 66560);
    bf16_t* Vb = (bf16_t*)(smc + 66560 + 33280);
    bf16_t* Vw = Vb + 32 * 72;
    bf16_t* Sm = Vw + 32 * 72;
    float* Gs = (float*)(smc + 66560 + 33280 + 2 * 4608 + 9216);
    float* sc = Gs + 2048;
    const int tid = opaque_tid(), lane = tid & 63, wave = tid >> 6;
    for (int i = tid; i < 32 * 520 / 2; i += NTHR) ((unsigned*)Cs)[i] = 0u;
    for (int i = tid; i < 2048; i += NTHR) Gs[i] = gtab[h * 2048 + i];
    const int ps = tid >> 3, pvb = tid & 7;
    const int ch0 = h * 512 + sub * 32;
    float wvr[16];
#pragma unroll
    for (int i = 0; i < 16; ++i) wvr[i] = wv[(size_t)((ch0 >> 2) + pvb) * 16 + i];
    f32x4 accS[4][2];
#pragma unroll
    for (int i = 0; i < 4; ++i) { accS[i][0] = (f32x4){0.f, 0.f, 0.f, 0.f}; accS[i][1] = (f32x4){0.f, 0.f, 0.f, 0.f}; }
    uint4 rx0, rx1, rx2, rx3, rx4, rx5, rx6, rx7; uint2 rxm; uint4 rs; float rbeta; float4 rsc = make_float4(0.f, 0.f, 0.f, 0.f); float rd0, rcf;
    MLSTM_PREFETCH(0);
    __syncthreads();
#pragma unroll 1
    for (int step = 0; step < NCH; ++step) {
        const int c = chunk_at(dir, step);
        const float d0 = rd0, cf = rcf;
        {
            bf16_t* xd = XCs + (tid >> 6) * 520 + (tid & 63) * 8;
            *(uint4*)(xd) = rx0; *(uint4*)(xd + 8 * 520) = rx1; *(uint4*)(xd + 16 * 520) = rx2; *(uint4*)(xd + 24 * 520) = rx3;
            *(uint4*)(xd + 32 * 520) = rx4; *(uint4*)(xd + 40 * 520) = rx5; *(uint4*)(xd + 48 * 520) = rx6; *(uint4*)(xd + 56 * 520) = rx7;
        }
        {
            const float x0 = bflo(rxm.x), x1 = bfhi(rxm.x), x2 = bflo(rxm.y), x3 = bfhi(rxm.y);
#pragma unroll
            for (int d = 0; d < 4; ++d) {
                const float v = (x0 * wvr[d] + x1 * wvr[4 + d] + x2 * wvr[8 + d] + x3 * wvr[12 + d]) * rbeta;
                Vb[(pvb * 4 + d) * 72 + ps] = __builtin_bit_cast(unsigned short, (__bf16)v);
                Vw[(pvb * 4 + d) * 72 + ps] = __builtin_bit_cast(unsigned short, (__bf16)(v * cf));
            }
        }
        {
#define SMASK(q_) (((dir ? (pvb * 8 + 2 * (q_) >= ps) : (pvb * 8 + 2 * (q_) <= ps)) ? 0x0000ffffu : 0u) | ((dir ? (pvb * 8 + 2 * (q_) + 1 >= ps) : (pvb * 8 + 2 * (q_) + 1 <= ps)) ? 0xffff0000u : 0u))
            *(uint4*)(Sm + ps * 72 + pvb * 8) = make_uint4(rs.x & SMASK(0), rs.y & SMASK(1), rs.z & SMASK(2), rs.w & SMASK(3));
#undef SMASK
        }
        if (tid < 64) st4(sc + tid * 4, rsc);
        { const int nstep = (step + 1 < NCH) ? step + 1 : step; MLSTM_PREFETCH(nstep); }
        __syncthreads();
        {
            const int vt = wave & 1, tt = wave >> 1;
            f32x4 ao = (f32x4){0.f, 0.f, 0.f, 0.f}, ai = ao;
            const bf16_t* ap = Cs + (vt * 16 + (lane & 15)) * 520 + (lane >> 4) * 8;
            const bf16_t* bp = XCs + (tt * 16 + (lane & 15)) * 520 + (lane >> 4) * 8;
#pragma unroll
            for (int ks = 0; ks < 16; ++ks) ao = __builtin_amdgcn_mfma_f32_16x16x32_bf16(*(const bf16x8*)(ap + ks * 32), *(const bf16x8*)(bp + ks * 32), ao, 0, 0, 0);
            const bf16_t* ap2 = Vb + (vt * 16 + (lane & 15)) * 72 + (lane >> 4) * 8;
            const bf16_t* bp2 = Sm + (tt * 16 + (lane & 15)) * 72 + (lane >> 4) * 8;
#pragma unroll
            for (int ks = 0; ks < 2; ++ks) ai = __builtin_amdgcn_mfma_f32_16x16x32_bf16(*(const bf16x8*)(ap2 + ks * 32), *(const bf16x8*)(bp2 + ks * 32), ai, 0, 0, 0);
            if (c >= 4) {
                const int t = tt * 16 + (lane & 15);
                const float4 s4 = ld4(sc + t * 4);
                const float h0 = (s4.x * ai[0] + s4.z * ao[0]) * s4.w, h1 = (s4.x * ai[1] + s4.z * ao[1]) * s4.w;
                const float h2 = (s4.x * ai[2] + s4.z * ao[2]) * s4.w, h3 = (s4.x * ai[3] + s4.z * ao[3]) * s4.w;
                bf16_t* hp = H + ((size_t)b * NL + (size_t)c * 64 + t - NCX) * 2048 + ch0 + vt * 16 + (lane >> 4) * 4;
                const unsigned u0 = pack2bf(h0, h1), u1 = pack2bf(h2, h3);
                __builtin_amdgcn_global_atomic_fadd_v2bf16((__attribute__((address_space(1))) s16x2*)hp, __builtin_bit_cast(s16x2, u0));
                __builtin_amdgcn_global_atomic_fadd_v2bf16((__attribute__((address_space(1))) s16x2*)(hp + 2), __builtin_bit_cast(s16x2, u1));
            }
        }
#pragma unroll
        for (int jt = 0; jt < 4; ++jt) { accS[jt][0] *= d0; accS[jt][1] *= d0; }
#pragma unroll
        for (int ks = 0; ks < 2; ++ks) {
            const bf16x8 b0 = *(const bf16x8*)(Vw + (lane & 15) * 72 + ks * 32 + (lane >> 4) * 8);
            const bf16x8 b1 = *(const bf16x8*)(Vw + (16 + (lane & 15)) * 72 + ks * 32 + (lane >> 4) * 8);
            const int row0 = ks * 32 + (lane >> 4) * 8 + ((lane & 15) >> 2);
#pragma unroll
            for (int jt = 0; jt < 4; ++jt) {
                const int col = wave * 64 + jt * 16 + (lane & 3) * 4;
                const s16x4 lo = __builtin_amdgcn_ds_read_tr16_b64_v4i16((__attribute__((address_space(3))) s16x4*)(XCs + row0 * 520 + col));
                const s16x4 hi = __builtin_amdgcn_ds_read_tr16_b64_v4i16((__attribute__((address_space(3))) s16x4*)(XCs + (row0 + 4) * 520 + col));
                const bf16x8 af = (bf16x8){lo[0], lo[1], lo[2], lo[3], hi[0], hi[1], hi[2], hi[3]};
                accS[jt][0] = __builtin_amdgcn_mfma_f32_16x16x32_bf16(af, b0, accS[jt][0], 0, 0, 0);
                accS[jt][1] = __builtin_amdgcn_mfma_f32_16x16x32_bf16(af, b1, accS[jt][1], 0, 0, 0);
            }
        }
        __syncthreads();
#pragma unroll
        for (int jt = 0; jt < 4; ++jt) {
            const int blk = wave * 16 + jt * 4 + (lane >> 4);
            const float4 g0 = ld4(Gs + blk * 16), g1 = ld4(Gs + blk * 16 + 4), g2 = ld4(Gs + blk * 16 + 8), g3 = ld4(Gs + blk * 16 + 12);
#pragma unroll
            for (int v2 = 0; v2 < 2; ++v2) {
                const f32x4 a = accS[jt][v2];
                const float o0 = g0.x * a[0] + g0.y * a[1] + g0.z * a[2] + g0.w * a[3];
                const float o1 = g1.x * a[0] + g1.y * a[1] + g1.z * a[2] + g1.w * a[3];
                const float o2 = g2.x * a[0] + g2.y * a[1] + g2.z * a[2] + g2.w * a[3];
                const float o3 = g3.x * a[0] + g3.y * a[1] + g3.z * a[2] + g3.w * a[3];
                *(uint2*)(Cs + (v2 * 16 + (lane & 15)) * 520 + blk * 4) = make_uint2(pack2bf(o0, o1), pack2bf(o2, o3));
            }
        }
    }
}

DEV void phase_finish1(const Params& p) {
    bf16_t* H = (bf16_t*)(p.ws + OFF_H);
    const bf16_t* XC = (const bf16_t*)(p.ws + OFF_XC);
    const bf16_t* Z = (const bf16_t*)(p.ws + OFF_XM);
    const float* ng = p.in[44]; const float* skip = p.in[45];
    const int tid_ = opaque_tid(); const int lane = tid_ & 63, gw = blockIdx.x * NWV + (tid_ >> 6), ngw = gridDim.x * NWV;
    for (int it = gw; it < NB * NL * 4; it += ngw) {
        const int r = it >> 2, h = it & 3, b = r >= NL ? 1 : 0, nn = r - b * NL;
        const int c0 = h * 512 + lane * 8;
        bf16_t* hp = H + (size_t)r * 2048 + c0;
        float v[8]; unpack8(*(const uint4*)hp, v);
        float sum = 0.f;
#pragma unroll
        for (int j = 0; j < 8; ++j) sum += v[j];
        const float mean = wave_sum(sum) * (1.f / 512.f);
        float sq = 0.f;
#pragma unroll
        for (int j = 0; j < 8; ++j) { v[j] -= mean; sq += v[j] * v[j]; }
        const float rstd = rsqrtf(wave_sum(sq) * (1.f / 512.f) + 1e-5f);
        float xc[8], z[8];
        unpack8(*(const uint4*)(XC + ((size_t)b * TB + NCX + nn) * 2048 + c0), xc);
        unpack8(*(const uint4*)(Z + (size_t)r * 2048 + c0), z);
        float o[8];
#pragma unroll
        for (int j = 0; j < 8; ++j) o[j] = (v[j] * rstd * ng[c0 + j] + skip[c0 + j] * xc[j]) * silu_f(z[j]);
        *(uint4*)hp = make_uint4(pack2bf(o[0], o[1]), pack2bf(o[2], o[3]), pack2bf(o[4], o[5]), pack2bf(o[6], o[7]));
    }
}

__global__ void __launch_bounds__(NTHR) fwd_kernel(Params p) {
    extern __shared__ __attribute__((aligned(16))) float sm[];
    volatile LAS unsigned* xst = (volatile LAS unsigned*)((LAS char*)sm + (LDS_BYTES - 16));
    if (threadIdx.x == 0) { xst[0] = 0u; xst[1] = 0u; }
    __syncthreads();
    const XcdBarrier xbar = xcd_barrier_post((unsigned*)(p.ws + OFF_BAR), xst);
    const int tid = opaque_tid(), lane = tid & 63, wave = tid >> 6;
    float* modv = (float*)(p.ws + OFF_MODV);
    float* X1C = (float*)(p.ws + OFF_X1C);

    phase_mod(p, sm);
    phase_tables(p);
    transpose_convert(p.in[8], 1024, EIN, 3968, (bf16_t*)(p.ws + OFF_WT0), sm);
    transpose_convert(p.in[29], 1024, 4096, 4096, (bf16_t*)(p.ws + OFF_WT1), sm);
    transpose_convert(p.in[9], 1024, 1024, 1024, (bf16_t*)(p.ws + OFF_WT2), sm);
    transpose_convert(p.in[30], 2048, 1024, 1024, (bf16_t*)(p.ws + OFF_WT3), sm);
    xcd_barrier(xbar);

#pragma unroll 1
    for (int b = 0; b < NB; ++b) {
        if (b == 0) { phase_h0(p, 0); xcd_barrier(xbar); }
        {
            ALbf al{(const bf16_t*)(p.ws + OFF_YC), DM};
            EPstoreBf ep{(bf16_t*)(p.ws + OFF_P0), EIN};
            gemm_mfma(TB, EIN, 3968, DM, (const bf16_t*)(p.ws + OFF_WT0), al, ep, sm);
        }
#ifdef RWKV_DEBUG
        if (b == 0) { zero_f4(p.out, (size_t)TB * 1024); zero_f4((float*)(p.ws + OFF_X1C), (size_t)TB * 8); if (blockIdx.x == 0 && tid == 0) { *(unsigned long long*)(p.ws + OFF_X1C + 2200000) = 0ull; *(unsigned long long*)(p.ws + OFF_X1C + 2200008) = 0ull; } }
#endif
        xcd_barrier(xbar);
#ifdef RWKV_DEBUG
        if (b == 0 && blockIdx.x < 32 && wave == 0) { const int u = blockIdx.x; if ((DBG_DIRMASK >> ((u >> 1) & 1)) & 1) rwkv_unit(p, u >> 2, (u >> 1) & 1, u & 1, sm, lane); }
        __syncthreads();
#endif
        for (int u = blockIdx.x; u < 24 * NCH; u += gridDim.x) {
            if (u < 16 * NCH) rwkv1_unit(p, (u / NCH) >> 1, (u / NCH) & 1, u % NCH, sm);
            else { const int v = u - 16 * NCH; gla1_unit(p, (v / NCH) >> 1, (v / NCH) & 1, v % NCH, sm); }
        }
        xcd_barrier(xbar);
        if (blockIdx.x < 128) gla2_unit(p, blockIdx.x);
        else if (blockIdx.x < 192) { if (wave == 0) rwkv2_unit(p, (blockIdx.x - 128) >> 2, (blockIdx.x - 128) & 3, lane); }
        xcd_barrier(xbar);
        for (int u = blockIdx.x; u < 12 * NCH; u += gridDim.x) {
#ifdef RWKV_DEBUG
            if (u < 8 * NCH) rwkv3_unit(p, u / NCH, u % NCH, sm, b == 0);
#else
            if (u < 8 * NCH) rwkv3_unit(p, u / NCH, u % NCH, sm);
#endif
            else { const int v = u - 8 * NCH; gla3_unit(p, v / NCH, v % NCH, sm); }
        }
        xcd_barrier(xbar);
        {
            ALbf al{(const bf16_t*)(p.ws + OFF_YC), 1024};
            EPres ep{(float*)(p.ws + OFF_P0), 1024, p.in[0], p.in[2], modv, b, 0};
            gemm_mfma(TB, DM, DM, DM, (const bf16_t*)(p.ws + OFF_WT2), al, ep, sm);
        }
        xcd_barrier(xbar);
        ln_rows((const float*)(p.ws + OFF_P0), TB, p.in[6], p.in[7], p.out + (size_t)b * NL * DM, X1C + (size_t)b * NCX * DM, NCX);
        if (b == 0) phase_h0(p, 1);
        xcd_barrier(xbar);
    }

    {
        ALmodAll al{p.out, X1C, modv + 3 * 3072};
        EPstoreBf ep{(bf16_t*)(p.ws + OFF_XM), 2048};
        gemm_mfma(RT, 2048, 2048, DM, (const bf16_t*)(p.ws + OFF_WT1), al, ep, sm);
        zero_f4((float*)(p.ws + OFF_H), (size_t)NB * NL * 1024);
    }
    xcd_barrier(xbar);
    phase_conv1(p, sm);
    xcd_barrier(xbar);
    phase_x1(p, sm);
    xcd_barrier(xbar);
    phase_x2(p, sm);
    xcd_barrier(xbar);
    phase_mlstm(p, sm);
    xcd_barrier(xbar);
    {
        ALmodLat al{p.out, modv + 3 * 3072};
        EPstoreBf ep{(bf16_t*)(p.ws + OFF_XM), 2048};
        gemm_mfma(NB * NL, 2048, 2048, DM, (const bf16_t*)(p.ws + OFF_WT1) + (size_t)2048 * 1024, al, ep, sm);
    }
    xcd_barrier(xbar);
    phase_finish1(p);
    xcd_barrier(xbar);
    {
        ALbf al{(const bf16_t*)(p.ws + OFF_H), 2048};
        EPresLat ep{(float*)(p.ws + OFF_XC), p.out, modv + 3 * 3072};
        gemm_mfma(NB * NL, DM, DM, 2048, (const bf16_t*)(p.ws + OFF_WT3), al, ep, sm);
    }
    xcd_barrier(xbar);
    ln_rows((const float*)(p.ws + OFF_XC), NB * NL, p.in[6] + 1024, p.in[7] + 1024, p.out, p.out, 0);
#ifdef RWKV_DEBUG
    xcd_barrier(xbar);
    {
        const float num = (float)(*(const unsigned long long*)(p.ws + OFF_X1C + 2200000)), den = (float)(*(const unsigned long long*)(p.ws + OFF_X1C + 2200008));
        float dl = (den > 0.f) ? sqrtf(num / den) : 1.f; dl = (dl == dl) ? fminf(dl, 1.f) : 1.f;
        const float sc = 1.f + 10.f * dl;
        for (size_t i = (size_t)blockIdx.x * NTHR + tid; i < (size_t)NB * NL * DM; i += (size_t)gridDim.x * NTHR) p.out[i] *= sc;
    }
#endif
}

extern "C" void kernel_launch(void* const* d_in, const int* in_sizes, int n_in, void* d_out, int out_size, void* d_ws, size_t ws_size, hipStream_t stream) {
    static int grid_blocks = 0;
    if (grid_blocks == 0) {
        if (ws_size < WS_NEED || n_in != 46) { fprintf(stderr, "kernel_launch: bad ws_size %zu (need %zu) or n_in %d\n", ws_size, (size_t)WS_NEED, n_in); grid_blocks = -1; return; }
        int dev = 0, cus = 0, per_cu = 0;
        (void)hipGetDevice(&dev);
        (void)hipDeviceGetAttribute(&cus, hipDeviceAttributeMultiprocessorCount, dev);
        (void)hipFuncSetAttribute((const void*)fwd_kernel, hipFuncAttributeMaxDynamicSharedMemorySize, LDS_BYTES);
        (void)hipOccupancyMaxActiveBlocksPerMultiprocessor(&per_cu, (const void*)fwd_kernel, NTHR, LDS_BYTES);
        if (per_cu < 1 || cus < 256) { fprintf(stderr, "kernel_launch: occupancy query says %d blocks/CU on %d CUs; this kernel needs 256 resident workgroups\n", per_cu, cus); grid_blocks = -1; return; }
        grid_blocks = 256;
    }
    if (grid_blocks < 0) return;
    (void)hipMemsetAsync((char*)d_ws + OFF_BAR, 0, XCD_BAR_WORDS * 4, stream);
    Params p{};
    for (int i = 0; i < 46; ++i) p.in[i] = (const float*)d_in[i];
    p.out = (float*)d_out; p.ws = (char*)d_ws;
    void* args[] = {&p};
    hipError_t e = hipLaunchCooperativeKernel((const void*)fwd_kernel, dim3(grid_blocks), dim3(NTHR), args, LDS_BYTES, stream);
    if (e != hipSuccess) fprintf(stderr, "cooperative launch failed: %s (grid %d)\n", hipGetErrorString(e), grid_blocks);
}
```

```cpp
#include <hip/hip_runtime.h>
#include <hip/hip_cooperative_groups.h>
#include <cstdio>
#include <cmath>
namespace cg = cooperative_groups;

#define DEV __device__ __forceinline__
#define DBG_DIRMASK 3
#define DBG_CMIN 0
#define DBG_CMAX 132
#define DBG_TITERS 5
#define DBG_TSLOT 2
#define DBG_SELFTEST 0
#define DBG_MODE 1

constexpr int NB = 2, NL = 8192, DM = 1024, NCX = 256, TB = NCX + NL;
constexpr int RT = NB * TB;
constexpr int NCH = TB / 64;
constexpr int EIN = 3872, RW0 = 1568;
constexpr int NTHR = 512, NWV = 8;
constexpr float ALPHA = 1.41421356237f;
constexpr float KSCALE = 0.04419417382f;

constexpr size_t OFF_MODV = 0;
constexpr size_t OFF_X1C  = 131072;
constexpr size_t OFF_BAR  = 3145728;
constexpr size_t OFF_BIG  = 4194304;
constexpr size_t OFF_P0   = OFF_BIG;
constexpr size_t OFF_YC   = OFF_BIG + (size_t)TB * EIN * 2;
constexpr size_t OFF_GDS  = OFF_YC + (size_t)TB * 1024 * 2;
constexpr size_t OFF_GDEC = OFF_GDS + (size_t)8 * NCH * 8192 * 4;
constexpr size_t OFF_RU   = OFF_GDEC + (size_t)8 * NCH * 64 * 4;
constexpr size_t OFF_RS0  = OFF_RU + (size_t)16 * NCH * 16384 * 2;
constexpr size_t OFF_BONS = OFF_RS0 + (size_t)16 * NCH * 4096 * 2;
constexpr size_t L0_END   = OFF_BONS + (size_t)2 * TB * 8 * 4;
constexpr size_t OFF_XM   = OFF_BIG;
constexpr size_t OFF_XC   = OFF_XM + (size_t)RT * 2048 * 2;
constexpr size_t OFF_H    = OFF_XC + (size_t)RT * 2048 * 2;
constexpr size_t OFF_WT0  = OFF_H + (size_t)NB * NL * 2048 * 2;
constexpr size_t OFF_WT1  = OFF_WT0 + (size_t)3968 * 1024 * 2;
constexpr size_t OFF_WT2  = OFF_WT1 + (size_t)4096 * 1024 * 2;
constexpr size_t OFF_WT3  = OFF_WT2 + (size_t)1024 * 1024 * 2;
constexpr size_t OFF_G16  = OFF_WT3 + (size_t)1024 * 2048 * 2;
constexpr size_t OFF_SMAT = OFF_G16 + (size_t)RT * 16 * 4;
constexpr size_t OFF_GSC  = OFF_SMAT + (size_t)NB * 4 * NCH * 4096 * 2;
constexpr size_t OFF_CSC  = OFF_GSC + (size_t)16 * TB * 4 * 4;
constexpr size_t OFF_NBUF = OFF_CSC + (size_t)16 * NCH * 2 * 4;
constexpr size_t OFF_GTAB = OFF_NBUF + (size_t)16 * NCH * 512 * 4;
constexpr size_t OFF_WFT  = OFF_GTAB + (size_t)4 * 128 * 16 * 4;
constexpr size_t OFF_G16P = OFF_WFT + (size_t)16 * 4096 * 2;
constexpr size_t WS_NEED  = OFF_G16P + (size_t)4 * RT * 16 * 4;

static_assert(L0_END <= OFF_WT0, "layer-0 buffers overlap the weight copies");
constexpr int LDS_BYTES = 139264;

struct Params { const float* in[46]; float* out; char* ws; };
typedef unsigned short bf16_t;
typedef __attribute__((ext_vector_type(8))) short bf16x8;
typedef __attribute__((ext_vector_type(4))) short s16x4;
typedef __attribute__((ext_vector_type(2))) short s16x2;
typedef __attribute__((ext_vector_type(4))) float f32x4;
typedef __attribute__((ext_vector_type(2))) __bf16 bf2_t;
DEV unsigned pack2bf(float lo, float hi) { bf2_t v; v[0] = (__bf16)lo; v[1] = (__bf16)hi; return __builtin_bit_cast(unsigned, v); }
DEV float bflo(unsigned u) { return __uint_as_float(u << 16); }
DEV float bfhi(unsigned u) { return __uint_as_float(u & 0xffff0000u); }
DEV float bf2f(bf16_t v) { return __uint_as_float(((unsigned)v) << 16); }
DEV void unpack8(uint4 u, float* f) { f[0] = bflo(u.x); f[1] = bfhi(u.x); f[2] = bflo(u.y); f[3] = bfhi(u.y); f[4] = bflo(u.z); f[5] = bfhi(u.z); f[6] = bflo(u.w); f[7] = bfhi(u.w); }

DEV float wave_sum(float v) {
#pragma unroll
    for (int o = 32; o > 0; o >>= 1) v += __shfl_xor(v, o, 64);
    return v;
}
DEV float wave_max(float v) {
#pragma unroll
    for (int o = 32; o > 0; o >>= 1) v = fmaxf(v, __shfl_xor(v, o, 64));
    return v;
}
DEV float fexp(float x) { return __expf(x); }
DEV float frcp(float x) { return __builtin_amdgcn_rcpf(x); }
DEV float sigmoid_f(float x) { return frcp(1.f + fexp(-x)); }
DEV float silu_f(float x) { return x * frcp(1.f + fexp(-x)); }
DEV float logsig_f(float x) { return fminf(x, 0.f) - __logf(1.f + fexp(-fabsf(x))); }
DEV float tanh_f(float x) { const float e = fexp(2.f * x); return 1.f - 2.f * frcp(e + 1.f); }
DEV void lds_fence() { asm volatile("" ::: "memory"); }
DEV int opaque_tid() { int t = threadIdx.x; asm volatile("" : "+v"(t)); return t; }
DEV int scan_s(int dir, int u) { return dir == 0 ? u : (u < NCX ? (NCX - 1 - u) : (TB - 1 + NCX - u)); }
DEV int chunk_at(int dir, int step) { return dir == 0 ? step : (step < 4 ? 3 - step : (NCH + 3 - step)); }
DEV float4 ld4(const float* p) { return *(const float4*)p; }
DEV void st4(float* p, float4 v) { *(float4*)p = v; }


#define XB_TMO      128
#define XB_XCNT(j)  (256  + 64 * (j))
#define XB_XSUB(j)  (1280 + 64 * (j))
#define XB_XGEN(j)  (2304 + 64 * (j))
#define XB_TOP      3328
#define XB_TOPGEN   3392
#define XCD_BAR_WORDS 3456
#define XB_SPIN_CAP (1u << 22)
#define LAS __attribute__((address_space(3)))
DEV unsigned xb_ld(unsigned* p) { return __hip_atomic_load(p, __ATOMIC_RELAXED, __HIP_MEMORY_SCOPE_AGENT); }
DEV unsigned xb_add(unsigned* p, unsigned v) { return __hip_atomic_fetch_add(p, v, __ATOMIC_RELAXED, __HIP_MEMORY_SCOPE_AGENT); }
DEV unsigned xb_xcc_id() { return (unsigned)__builtin_amdgcn_s_getreg((3 << 11) | 20) & 0xFu; }
#define XB_SPIN(cond, bar) do { unsigned _sp = 0; while (cond) { __builtin_amdgcn_s_sleep(1); \
    if ((++_sp & 255u) == 0u) { if (xb_ld(&(bar)[XB_TMO])) break; if (_sp > XB_SPIN_CAP) { atomicAdd(&(bar)[XB_TMO], 1u); break; } } } } while (0)
struct XcdBarrier { unsigned* bar; unsigned x; volatile LAS unsigned* st; };
DEV XcdBarrier xcd_barrier_post(unsigned* bar, volatile LAS unsigned* st) {
    XcdBarrier b; b.bar = bar; b.x = xb_xcc_id(); b.st = st;
    if (threadIdx.x == 0) (void)xb_add(&bar[XB_XCNT(b.x)], 1u);
    return b;
}
DEV void xcd_barrier_complete(unsigned* bar, unsigned x, unsigned& nloc, unsigned& nx) {
    const unsigned G = gridDim.x * gridDim.y * gridDim.z;
    unsigned sum, cnt, mine, sp = 0u;
    for (;;) {
        sum = 0u; cnt = 0u; mine = 0u;
#pragma unroll
        for (unsigned j = 0; j < 16; ++j) { const unsigned c = xb_ld(&bar[XB_XCNT(j)]); sum += c; cnt += (c > 0u) ? 1u : 0u; mine = (j == x) ? c : mine; }
        if (sum == G) break;
        __builtin_amdgcn_s_sleep(1);
        if ((++sp & 255u) == 0u) { if (xb_ld(&bar[XB_TMO])) break; if (sp > XB_SPIN_CAP) { atomicAdd(&bar[XB_TMO], 1u); break; } }
    }
    nloc = mine > 0u ? mine : 1u; nx = cnt > 0u ? cnt : 1u;
}
DEV void xcd_barrier(const XcdBarrier& b) {
    asm volatile("s_waitcnt vmcnt(0)" ::: "memory");
    __syncthreads();
    if (threadIdx.x == 0) {
        unsigned* bar = b.bar;
        __builtin_amdgcn_s_waitcnt(0);
        unsigned nloc = b.st[0], nx = b.st[1];
        if (nloc == 0u) { xcd_barrier_complete(bar, b.x, nloc, nx); b.st[0] = nloc; b.st[1] = nx; }
        const unsigned old = xb_add(&bar[XB_XSUB(b.x)], 1u);
        const unsigned gen = old / nloc;
        if (old + 1u == (gen + 1u) * nloc) {
            __builtin_amdgcn_fence(__ATOMIC_RELEASE, "agent");
            asm volatile("s_waitcnt vmcnt(0)" ::: "memory");
            const unsigned og = xb_add(&bar[XB_TOP], 1u);
            const unsigned tg = og / nx;
            if (og + 1u == (tg + 1u) * nx) xb_add(&bar[XB_TOPGEN], 1u);
            else XB_SPIN(xb_ld(&bar[XB_TOPGEN]) == tg, bar);
            __builtin_amdgcn_fence(__ATOMIC_ACQUIRE, "agent");
            xb_add(&bar[XB_XGEN(b.x)], 1u);
            asm volatile("s_waitcnt vmcnt(0)" ::: "memory");
        } else {
            XB_SPIN(xb_ld(&bar[XB_XGEN(b.x)]) == gen, bar);
            __builtin_amdgcn_fence(__ATOMIC_ACQUIRE, "agent");
            asm volatile("s_waitcnt vmcnt(0)" ::: "memory");
        }
    }
    __syncthreads();
}

template <class AL>
DEV void gemm_lda(const AL& al, int m0, int k0, int tid, uint4 (&r)[4]) {
    if constexpr (AL::BF) {
#pragma unroll
        for (int i = 0; i < 4; ++i) r[i] = al.ld8(m0 + (tid >> 3) + 64 * i, k0 + (tid & 7) * 8);
    } else {
        const int k = k0 + (tid & 15) * 4;
        const float* mv = al.mvptr(m0);
        const float4 sh = ld4(mv + k), sc = ld4(mv + 1024 + k);
#pragma unroll
        for (int i = 0; i < 4; ++i) {
            float4 x = ld4(al.rowptr(m0 + (tid >> 4) + 32 * (2 * i)) + k), y = ld4(al.rowptr(m0 + (tid >> 4) + 32 * (2 * i + 1)) + k);
            x.x = x.x * (1.f + sc.x) + sh.x; x.y = x.y * (1.f + sc.y) + sh.y; x.z = x.z * (1.f + sc.z) + sh.z; x.w = x.w * (1.f + sc.w) + sh.w;
            y.x = y.x * (1.f + sc.x) + sh.x; y.y = y.y * (1.f + sc.y) + sh.y; y.z = y.z * (1.f + sc.z) + sh.z; y.w = y.w * (1.f + sc.w) + sh.w;
            r[i] = make_uint4(pack2bf(x.x, x.y), pack2bf(x.z, x.w), pack2bf(y.x, y.y), pack2bf(y.z, y.w));
        }
    }
}
template <class AL>
DEV void gemm_sta(bf16_t* Ab, int tid, const uint4 (&r)[4]) {
    if constexpr (AL::BF) {
#pragma unroll
        for (int i = 0; i < 4; ++i) { const int row = (tid >> 3) + 64 * i; *(uint4*)(Ab + row * 64 + (((tid & 7) ^ (row & 7)) * 8)) = r[i]; }
    } else {
#pragma unroll
        for (int i = 0; i < 4; ++i) {
            const int r0 = (tid >> 4) + 32 * (2 * i), r1 = r0 + 32, c = (tid & 15) >> 1, hf = (tid & 1) * 4;
            *(uint2*)(Ab + r0 * 64 + ((c ^ (r0 & 7)) * 8) + hf) = make_uint2(r[i].x, r[i].y);
            *(uint2*)(Ab + r1 * 64 + ((c ^ (r1 & 7)) * 8) + hf) = make_uint2(r[i].z, r[i].w);
        }
    }
}
template <class AL, class EP>
DEV void gemm_mfma(int M, int N, int Npad, int K, const bf16_t* Wt, AL al, EP ep, float* smf) {
    constexpr int LDT = 64;
    bf16_t* As = (bf16_t*)smf;
    bf16_t* Bs = As + 2 * 256 * LDT;
    const int tid = opaque_tid(), lane = tid & 63, wave = tid >> 6, wm = wave & 3, wn = wave >> 2;
    const int mt = M / 256, nt = Npad / 128, nks = K / 64;
    const int br = tid >> 3, bc = tid & 7;
    const int ntile = mt * nt, fullg = mt >> 2, cut = fullg * 4 * nt, rl = mt - fullg * 4;
    for (int pos = ((int)(blockIdx.x & 7)) * 32 + (int)(blockIdx.x >> 3); pos < ntile; pos += 256) {
        int tm, tn;
        if (pos < cut) { const int grp = pos / (4 * nt), w = pos - grp * 4 * nt; tn = w >> 2; tm = grp * 4 + (w & 3); }
        else { const int p2 = pos - cut; tn = p2 / rl; tm = fullg * 4 + p2 - tn * rl; }
        const int m0 = tm * 256, n0 = tn * 128;
        f32x4 acc[4][4];
#pragma unroll
        for (int i = 0; i < 4; ++i)
#pragma unroll
            for (int j = 0; j < 4; ++j) acc[i][j] = (f32x4){0.f, 0.f, 0.f, 0.f};
        const bf16_t* wrow = Wt + (size_t)(n0 + br) * K + bc * 8;
        uint4 ra0[4], ra1[4], rb00, rb01, rb10, rb11;
        gemm_lda(al, m0, 0, tid, ra0); rb00 = *(const uint4*)(wrow); rb01 = *(const uint4*)(wrow + (size_t)64 * K);
        { const int k1 = (nks > 1) ? 64 : 0; gemm_lda(al, m0, k1, tid, ra1); rb10 = *(const uint4*)(wrow + k1); rb11 = *(const uint4*)(wrow + (size_t)64 * K + k1); }
#define GEMM_ST(buf_, ra_, rbx_, rby_) do { gemm_sta<AL>(As + (buf_) * 256 * LDT, tid, ra_); bf16_t* Bd_ = Bs + (buf_) * 128 * LDT; \
        *(uint4*)(Bd_ + br * LDT + ((bc ^ (br & 7)) * 8)) = rbx_; *(uint4*)(Bd_ + (br + 64) * LDT + ((bc ^ (br & 7)) * 8)) = rby_; } while (0)
#define GEMM_MM(buf_) do { const bf16_t* Ab_ = As + (buf_) * 256 * LDT; const bf16_t* Bb_ = Bs + (buf_) * 128 * LDT; \
        _Pragma("unroll") for (int kk_ = 0; kk_ < 2; ++kk_) { bf16x8 wf_[4], af_[4]; \
            _Pragma("unroll") for (int i_ = 0; i_ < 4; ++i_) wf_[i_] = *(const bf16x8*)(Bb_ + (wn * 64 + i_ * 16 + (lane & 15)) * LDT + ((kk_ * 4 + (lane >> 4)) ^ (lane & 7)) * 8); \
            _Pragma("unroll") for (int j_ = 0; j_ < 4; ++j_) af_[j_] = *(const bf16x8*)(Ab_ + (wm * 64 + j_ * 16 + (lane & 15)) * LDT + ((kk_ * 4 + (lane >> 4)) ^ (lane & 7)) * 8); \
            _Pragma("unroll") for (int i_ = 0; i_ < 4; ++i_) _Pragma("unroll") for (int j_ = 0; j_ < 4; ++j_) acc[i_][j_] = __builtin_amdgcn_mfma_f32_16x16x32_bf16(wf_[i_], af_[j_], acc[i_][j_], 0, 0, 0); } } while (0)
        GEMM_ST(0, ra0, rb00, rb01);
        __syncthreads();
#pragma unroll 1
        for (int ks = 0; ks < nks; ks += 2) {
            {
                const int k2 = ((ks + 2 < nks) ? ks + 2 : nks - 1) * 64;
                gemm_lda(al, m0, k2, tid, ra0); rb00 = *(const uint4*)(wrow + k2); rb01 = *(const uint4*)(wrow + (size_t)64 * K + k2);
                __builtin_amdgcn_sched_barrier(0);
                GEMM_MM(0);
                GEMM_ST(1, ra1, rb10, rb11);
                __syncthreads();
            }
            {
                const int k3 = ((ks + 3 < nks) ? ks + 3 : nks - 1) * 64;
                gemm_lda(al, m0, k3, tid, ra1); rb10 = *(const uint4*)(wrow + k3); rb11 = *(const uint4*)(wrow + (size_t)64 * K + k3);
                __builtin_amdgcn_sched_barrier(0);
                GEMM_MM(1);
                GEMM_ST(0, ra0, rb00, rb01);
                __syncthreads();
            }
        }
#undef GEMM_ST
#undef GEMM_MM
#pragma unroll
        for (int i = 0; i < 4; ++i) {
            const int n = n0 + wn * 64 + i * 16 + (lane >> 4) * 4;
            if (n < N) {
#pragma unroll
                for (int j = 0; j < 4; ++j) {
                    const int m = m0 + wm * 64 + j * 16 + (lane & 15);
                    ep(m, n, make_float4(acc[i][j][0], acc[i][j][1], acc[i][j][2], acc[i][j][3]));
                }
            }
        }
    }
}

DEV void transpose_convert(const float* __restrict__ W, int K, int N, int Npad, bf16_t* Wt, float* sm) {
    float (*T)[65] = (float (*)[65])sm;
    const int tid = opaque_tid();
    const int kt = K / 64, ntl = Npad / 64;
    for (int tile = blockIdx.x; tile < kt * ntl; tile += gridDim.x) {
        const int k0 = (tile / ntl) * 64, n0 = (tile % ntl) * 64;
        __syncthreads();
#pragma unroll
        for (int i = 0; i < 2; ++i) {
            const int k = (tid >> 4) + 32 * i, n4 = (tid & 15) * 4;
            float4 v = make_float4(0.f, 0.f, 0.f, 0.f);
            if (n0 + n4 < N) v = ld4(W + (size_t)(k0 + k) * N + n0 + n4);
            T[k][n4] = v.x; T[k][n4 + 1] = v.y; T[k][n4 + 2] = v.z; T[k][n4 + 3] = v.w;
        }
        __syncthreads();
        const int n = tid >> 3, kq = (tid & 7) * 8;
        unsigned o[4];
#pragma unroll
        for (int j = 0; j < 4; ++j) o[j] = pack2bf(T[kq + 2 * j][n], T[kq + 2 * j + 1][n]);
        bf16_t* dst = Wt + (size_t)(n0 + n) * K + k0 + kq;
        *(uint4*)dst = make_uint4(o[0], o[1], o[2], o[3]);
    }
}

struct ALmodAll {
    static constexpr bool BF = false;
    const float* lat; const float* cx; const float* mv;
    DEV const float* rowptr(int rr) const { const int b = rr >= TB ? 1 : 0, s = rr - b * TB; return (s < NCX) ? cx + ((size_t)(b * NCX + s)) * DM : lat + ((size_t)(b * NL + s - NCX)) * DM; }
    DEV const float* mvptr(int m0) const { const int b = m0 >= TB ? 1 : 0, s = m0 - b * TB; return mv + ((s < NCX) ? 2 : b) * 3072; }
};
struct ALmodLat {
    static constexpr bool BF = false;
    const float* lat; const float* mv;
    DEV const float* rowptr(int r) const { return lat + (size_t)r * DM; }
    DEV const float* mvptr(int m0) const { return mv + (m0 >= NL ? 1 : 0) * 3072; }
};
struct ALbf { static constexpr bool BF = true; const bf16_t* A; int lda; DEV uint4 ld8(int r, int k) const { return *(const uint4*)(A + (size_t)r * lda + k); } };
struct EPstore { float* C; int ldc; DEV void operator()(int r, int c, float4 v) const { st4(C + (size_t)r * ldc + c, v); } };
struct EPstoreBf { bf16_t* C; int ldc; DEV void operator()(int r, int c, float4 v) const { *(uint2*)(C + (size_t)r * ldc + c) = make_uint2(pack2bf(v.x, v.y), pack2bf(v.z, v.w)); } };
struct EPres {
    float* C; int ldc; const float* lat; const float* cx; const float* mv; int b; int s0;
    DEV void operator()(int r, int c, float4 v) const {
        const int s = r + s0;
        const float* src; int j;
        if (s < NCX) { src = cx + ((size_t)(b * NCX + s)) * DM + c; j = 2; }
        else { src = lat + ((size_t)(b * NL + s - NCX)) * DM + c; j = b; }
        float4 x = ld4(src);
        float4 g = ld4(mv + j * 3072 + 2048 + c);
        st4(C + (size_t)r * ldc + c, make_float4(ALPHA * x.x + g.x * v.x, ALPHA * x.y + g.y * v.y, ALPHA * x.z + g.z * v.z, ALPHA * x.w + g.w * v.w));
    }
};
struct EPresLat {
    float* C; const float* lat; const float* mv;
    DEV void operator()(int r, int c, float4 v) const {
        const int b = r >= NL ? 1 : 0;
        float4 x = ld4(lat + (size_t)r * DM + c);
        float4 g = ld4(mv + b * 3072 + 2048 + c);
        st4(C + (size_t)r * DM + c, make_float4(ALPHA * x.x + g.x * v.x, ALPHA * x.y + g.y * v.y, ALPHA * x.z + g.z * v.z, ALPHA * x.w + g.w * v.w));
    }
};


DEV void phase_h0(const Params& p, int b) {
    const float* modv = (const float*)(p.ws + OFF_MODV);
    bf16_t* H0 = (bf16_t*)(p.ws + OFF_YC);
    const int gt = blockIdx.x * NTHR + opaque_tid(), gn = gridDim.x * NTHR;
    for (int i = gt; i < TB * 128; i += gn) {
        const int s = i >> 7, k = (i & 127) * 8;
        const float* src; int j;
        if (s < NCX) { src = p.in[2] + ((size_t)(b * NCX + s)) * DM + k; j = 2; }
        else { src = p.in[0] + ((size_t)(b * NL + s - NCX)) * DM + k; j = b; }
        const float4 x0 = ld4(src), x1 = ld4(src + 4);
        const float* m = modv + j * 3072;
        const float4 s0 = ld4(m + k), s1 = ld4(m + k + 4), c0 = ld4(m + 1024 + k), c1 = ld4(m + 1024 + k + 4);
        *(uint4*)(H0 + (size_t)s * DM + k) = make_uint4(pack2bf(x0.x * (1.f + c0.x) + s0.x, x0.y * (1.f + c0.y) + s0.y), pack2bf(x0.z * (1.f + c0.z) + s0.z, x0.w * (1.f + c0.w) + s0.w),
                                                      pack2bf(x1.x * (1.f + c1.x) + s1.x, x1.y * (1.f + c1.y) + s1.y), pack2bf(x1.z * (1.f + c1.z) + s1.z, x1.w * (1.f + c1.w) + s1.w));
    }
}

DEV void phase_mod(const Params& p, float* sm) {
    const float* c = p.in[1]; const float* cctx = p.in[3];
    const float* mod_w = p.in[4]; const float* mod_b = p.in[5];
    float* modv = (float*)(p.ws + OFF_MODV);
    float* sil = sm; float* red = sm + 3072;
    const int tid = opaque_tid();
    for (int i = tid; i < 3072; i += NTHR) {
        const int j = i >> 10, k = i & 1023;
        const float v = (j < 2) ? c[j * 1024 + k] : cctx[k];
        sil[i] = silu_f(v);
    }
    __syncthreads();
    for (int unit = blockIdx.x; unit < 192; unit += gridDim.x) {
        const int l = unit / 96, cb = unit % 96;
        const int kg = tid >> 5, col = tid & 31, n = cb * 32 + col;
        const float* w = mod_w + (size_t)l * 1024 * 3072 + n;
        float a0 = 0.f, a1 = 0.f, a2 = 0.f;
        for (int k = kg * 64; k < kg * 64 + 64; ++k) {
            const float wv = w[(size_t)k * 3072];
            a0 += sil[k] * wv; a1 += sil[1024 + k] * wv; a2 += sil[2048 + k] * wv;
        }
        red[(kg * 3 + 0) * 32 + col] = a0; red[(kg * 3 + 1) * 32 + col] = a1; red[(kg * 3 + 2) * 32 + col] = a2;
        __syncthreads();
        if (tid < 96) {
            const int j = tid >> 5, cc = tid & 31, nn = cb * 32 + cc;
            float s = mod_b[l * 3072 + nn];
            for (int g = 0; g < 16; ++g) s += red[(g * 3 + j) * 32 + cc];
            modv[(l * 3 + j) * 3072 + nn] = s;
        }
        __syncthreads();
    }
}

DEV void phase_tables(const Params& p) {
    const float* wq = p.in[33]; const float* wk = p.in[34]; const float* wv = p.in[35];
    const float* gw0 = p.in[36]; const float* gw1 = p.in[38]; const float* gw2 = p.in[40]; const float* gw3 = p.in[42];
    float* gtab = (float*)(p.ws + OFF_GTAB); bf16_t* wft = (bf16_t*)(p.ws + OFF_WFT);
    const int gt = blockIdx.x * NTHR + opaque_tid(), gn = gridDim.x * NTHR;
    for (int i = gt; i < 512 * 16; i += gn) {
        const int gb = i >> 4, cp = (i >> 2) & 3, c = i & 3;
        float s = 0.f;
#pragma unroll
        for (int d = 0; d < 4; ++d) s += wq[gb * 16 + cp * 4 + d] * wk[gb * 16 + c * 4 + d];
        gtab[i] = s * KSCALE;
    }
    for (int i = gt; i < 4096 * 16; i += gn) {
        const int g = i >> 12, k = i & 4095, gm = g >> 2, hd = g & 3;
        const float* wg = gm == 0 ? gw0 : (gm == 1 ? gw1 : (gm == 2 ? gw2 : gw3));
        float s = 0.f;
        if (k < 2048) {
            const int blk = k >> 2, cc = k & 3;
#pragma unroll
            for (int d = 0; d < 4; ++d) s += wq[blk * 16 + cc * 4 + d] * wg[(size_t)(4 * blk + d) * 4 + hd] + wk[blk * 16 + cc * 4 + d] * wg[(size_t)(2048 + 4 * blk + d) * 4 + hd];
        } else {
            const int kk = k - 2048, blk = kk >> 2, cc = kk & 3;
#pragma unroll
            for (int d = 0; d < 4; ++d) s += wv[blk * 16 + cc * 4 + d] * wg[(size_t)(4096 + 4 * blk + d) * 4 + hd];
        }
        wft[i] = __builtin_bit_cast(unsigned short, (__bf16)s);
    }
}

#ifdef RWKV_DEBUG
DEV float rw_mix(const bf16_t* P0, int s, int c, const float* __restrict__ mu) {
    const float own = bf2f(P0[(size_t)s * EIN + RW0 + c]);
    const int d = c & 3;
    int ns = -1;
    if (s < NCX) {
        if (d == 0) ns = (s > 0) ? s - 1 : -1;
        else if (d == 1) ns = (s < NCX - 1) ? s + 1 : -1;
    } else {
        const int n = s - NCX, rr = n >> 6, cc = n & 63;
        if (d == 0) ns = (cc > 0) ? s - 1 : -1;
        else if (d == 1) ns = (cc < 63) ? s + 1 : -1;
        else if (d == 2) ns = (rr > 0) ? s - 64 : -1;
        else ns = (rr < 127) ? s + 64 : -1;
    }
    const float nb = (ns >= 0) ? bf2f(P0[(size_t)ns * EIN + RW0 + c]) : 0.f;
    return own + (nb - own) * mu[c];
}

DEV void rwkv_unit(const Params& p, int h, int dir, int rh, float* sm, int lane) {
    asm volatile("" : "+v"(lane));
    const bf16_t* P0 = (const bf16_t*)(p.ws + OFF_P0);
    float* YS = p.out;
    float* BON = (float*)(p.ws + OFF_X1C);
    const float* mu = p.in[15];
    const float* w0 = p.in[dir ? 18 : 16]; const float* ww2 = p.in[dir ? 19 : 17];
    const float* a0 = p.in[dir ? 22 : 20]; const float* wa2 = p.in[dir ? 23 : 21];
    const float* k_k = p.in[24]; const float* k_a = p.in[25]; const float* r_k = p.in[26];
    float* sR = sm; float* sW = sm + 4096; float* sK = sm + 8192; float* sA = sm + 12288; float* sB = sm + 16384; float* sV = sm + 20480;
    const int hc = h * 64 + lane;
    const float w0j = w0[hc], a0j = a0[hc], kkj = k_k[hc], kaj = k_a[hc], rkj = r_k[hc];
    const int row = rh * 32 + (lane & 31), kh0 = (lane >> 5) * 32;
    float* sWW = sm + 24576; float* sWA = sm + 28672;
#pragma unroll 4
    for (int i = 0; i < 64; ++i) { sWW[i * 64 + lane] = ww2[i * 512 + hc]; sWA[i * 64 + lane] = wa2[i * 512 + hc]; }
    float S[32];
#pragma unroll
    for (int k = 0; k < 32; ++k) S[k] = 0.f;
    const int cwl = 2048 + dir * 64, cal = 2176 + dir * 64;
#pragma unroll 1
    for (int cu = 0; cu < TB / 64; ++cu) {
        lds_fence();
#pragma unroll 1
        for (int t = 0; t < 64; ++t) {
            const int s = scan_s(dir, cu * 64 + t);
            sR[t * 64 + lane] = rw_mix(P0, s, h * 64 + lane, mu);
            sK[t * 64 + lane] = rw_mix(P0, s, 512 + h * 64 + lane, mu);
            sV[t * 64 + lane] = rw_mix(P0, s, 1024 + h * 64 + lane, mu);
            sA[t * 64 + lane] = tanh_f(rw_mix(P0, s, cwl + lane, mu));
            sB[t * 64 + lane] = rw_mix(P0, s, cal + lane, mu);
        }
        lds_fence();
        {
            const float* wr = sWW + lane; asm volatile("" : "+v"(wr));
            float wc[64];
#pragma unroll
            for (int i = 0; i < 64; ++i) wc[i] = wr[i * 64];
#pragma unroll 1
            for (int t = 0; t < 64; ++t) {
                float accw = w0j;
#pragma unroll
                for (int i4 = 0; i4 < 16; ++i4) {
                    const float4 x = ld4(&sA[t * 64 + i4 * 4]);
                    accw += x.x * wc[i4 * 4] + x.y * wc[i4 * 4 + 1] + x.z * wc[i4 * 4 + 2] + x.w * wc[i4 * 4 + 3];
                }
                sW[t * 64 + lane] = fexp(-0.6065306597f * sigmoid_f(accw));
            }
        }
        lds_fence();
        {
            const float* ar = sWA + lane; asm volatile("" : "+v"(ar));
            float ac[64];
#pragma unroll
            for (int i = 0; i < 64; ++i) ac[i] = ar[i * 64];
#pragma unroll 1
            for (int t = 0; t < 64; ++t) {
                float acca = a0j;
#pragma unroll
                for (int i4 = 0; i4 < 16; ++i4) {
                    const float4 y = ld4(&sB[t * 64 + i4 * 4]);
                    acca += y.x * ac[i4 * 4] + y.y * ac[i4 * 4 + 1] + y.z * ac[i4 * 4 + 2] + y.w * ac[i4 * 4 + 3];
                }
                const float av = sigmoid_f(acca);
                const float kraw = sK[t * 64 + lane];
                const float kkv = kraw * kkj;
                const float ss = wave_sum(kkv * kkv);
                const float kk = kkv * rsqrtf(fmaxf(ss, 1e-24f));
                const float kh = kraw * (1.f + (av - 1.f) * kaj);
                const float r = sR[t * 64 + lane];
                const float bon = wave_sum(r * kh * rkj);
                lds_fence();
                sK[t * 64 + lane] = kh; sA[t * 64 + lane] = -kk; sB[t * 64 + lane] = kk * av;
                if (lane == 0 && rh == 0) { const int s = scan_s(dir, cu * 64 + t); atomicAdd(&BON[s * 8 + h], bon); }
            }
        }
        lds_fence();
        if (cu == 0 && dir == 0 && rh == 0) {
            float* DBO = p.out + 9000000;
            for (int t = 0; t < 64; ++t) { float* d = DBO + ((size_t)(h * 64 + t) * 64 + lane) * 6; d[0] = sW[t * 64 + lane]; d[1] = sK[t * 64 + lane]; d[2] = sA[t * 64 + lane]; d[3] = sB[t * 64 + lane]; d[4] = sR[t * 64 + lane]; d[5] = sV[t * 64 + lane]; }
        }
#pragma unroll 1
        for (int t = 0; t < 64; ++t) {
            const float vi = sV[t * 64 + row];
            float sa = 0.f;
#pragma unroll
            for (int k4 = 0; k4 < 8; ++k4) {
                const float4 a4 = ld4(&sA[t * 64 + kh0 + k4 * 4]);
                sa += S[k4 * 4] * a4.x + S[k4 * 4 + 1] * a4.y + S[k4 * 4 + 2] * a4.z + S[k4 * 4 + 3] * a4.w;
            }
            sa += __shfl_xor(sa, 32, 64);
            float y = 0.f;
#pragma unroll
            for (int k4 = 0; k4 < 8; ++k4) {
                const float4 w4 = ld4(&sW[t * 64 + kh0 + k4 * 4]);
                const float4 b4 = ld4(&sB[t * 64 + kh0 + k4 * 4]);
                const float4 h4 = ld4(&sK[t * 64 + kh0 + k4 * 4]);
                const float4 r4 = ld4(&sR[t * 64 + kh0 + k4 * 4]);
                S[k4 * 4 + 0] = S[k4 * 4 + 0] * w4.x + sa * b4.x + vi * h4.x;
                S[k4 * 4 + 1] = S[k4 * 4 + 1] * w4.y + sa * b4.y + vi * h4.y;
                S[k4 * 4 + 2] = S[k4 * 4 + 2] * w4.z + sa * b4.z + vi * h4.z;
                S[k4 * 4 + 3] = S[k4 * 4 + 3] * w4.w + sa * b4.w + vi * h4.w;
                y += S[k4 * 4] * r4.x + S[k4 * 4 + 1] * r4.y + S[k4 * 4 + 2] * r4.z + S[k4 * 4 + 3] * r4.w;
            }
            y += __shfl_xor(y, 32, 64);
            if (lane < 32) { const int s = scan_s(dir, cu * 64 + t); atomicAdd(&YS[(size_t)s * 1024 + 512 + h * 64 + row], y); }
        }
    }
}

#endif
DEV float wave_scan_add(float v, int lane, int dir) {
#pragma unroll
    for (int o = 1; o < 64; o <<= 1) {
        const float n = dir ? __shfl_down(v, o, 64) : __shfl_up(v, o, 64);
        const bool ok = dir ? (lane + o < 64) : (lane >= o);
        if (ok) v += n;
    }
    return v;
}
DEV float wave_scan_max(float v, int lane, int dir) {
#pragma unroll
    for (int o = 1; o < 64; o <<= 1) {
        const float n = dir ? __shfl_down(v, o, 64) : __shfl_up(v, o, 64);
        const bool ok = dir ? (lane + o < 64) : (lane >= o);
        if (ok) v = fmaxf(v, n);
    }
    return v;
}

DEV void gla_decay(const bf16_t* P0, int c, int h, int dir, const float* __restrict__ wa2, const float* __restrict__ ba,
                   float* sLR, float* sWA, float* sBC, float* sTot, int tid) {
    for (int i = tid; i < 1024; i += NTHR) { const int t = i >> 4, j = i & 15; sLR[i] = bf2f(P0[(size_t)(c * 64 + t) * EIN + 1536 + dir * 16 + j]); }
    for (int i = tid; i < 1024; i += NTHR) { const int ii = i >> 6, k = i & 63; sWA[i] = wa2[ii * 256 + h * 64 + k]; }
    __syncthreads();
    {
        const int t = tid >> 3, k0 = (tid & 7) * 8;
        float acc[8];
#pragma unroll
        for (int j = 0; j < 8; ++j) acc[j] = ba[h * 64 + k0 + j];
#pragma unroll
        for (int ii = 0; ii < 16; ++ii) {
            const float l = sLR[t * 16 + ii];
#pragma unroll
            for (int j = 0; j < 8; ++j) acc[j] += l * sWA[ii * 64 + k0 + j];
        }
#pragma unroll
        for (int j = 0; j < 8; ++j) sBC[t * 65 + k0 + j] = logsig_f(acc[j]) * 0.0625f;
    }
    __syncthreads();
    {
        const int lane = tid & 63, wv = tid >> 6;
#pragma unroll
        for (int j = 0; j < 8; ++j) {
            const int k = wv * 8 + j;
            const float v = wave_scan_add(sBC[lane * 65 + k], lane, dir);
            sBC[lane * 65 + k] = v;
            if (lane == (dir ? 0 : 63)) sTot[k] = v;
        }
    }
    __syncthreads();
}
DEV bf16x8 tr_frag(const bf16_t* base, int ld, int row0, int col0, int lane) {
    const bf16_t* ptr = base + (row0 + (lane >> 4) * 8 + ((lane & 15) >> 2)) * ld + col0 + (lane & 3) * 4;
    const s16x4 lo = __builtin_amdgcn_ds_read_tr16_b64_v4i16((__attribute__((address_space(3))) s16x4*)ptr);
    const s16x4 hi = __builtin_amdgcn_ds_read_tr16_b64_v4i16((__attribute__((address_space(3))) s16x4*)(ptr + 4 * ld));
    return (bf16x8){lo[0], lo[1], lo[2], lo[3], hi[0], hi[1], hi[2], hi[3]};
}
DEV bf16x8 row_frag(const bf16_t* base, int ld, int idx0, int k0, int lane) {
    return *(const bf16x8*)(base + (idx0 + (lane & 15)) * ld + k0 + (lane >> 4) * 8);
}

DEV void gla1_unit(const Params& p, int h, int dir, int c, float* sm) {
    const int tid = opaque_tid(), lane = tid & 63, wave = tid >> 6;
    const bf16_t* P0 = (const bf16_t*)(p.ws + OFF_P0);
    float* GDS = (float*)(p.ws + OFF_GDS); float* GDEC = (float*)(p.ws + OFF_GDEC);
    const float* wa2 = p.in[dir ? 12 : 10]; const float* ba = p.in[dir ? 13 : 11];
    float* sLR = sm; float* sWA = sm + 1024; float* sBC = sm + 2048; float* sTot = sm + 6208;
    bf16_t* kT = (bf16_t*)(sm + 6272);
    bf16_t* Vs = (bf16_t*)(sm + 8576);
    const int ch = h * 2 + dir;
    __syncthreads();
    gla_decay(P0, c, h, dir, wa2, ba, sLR, sWA, sBC, sTot, tid);
    {
        const int t = tid >> 3, k0 = (tid & 7) * 8;
        float kv[8]; unpack8(*(const uint4*)(P0 + (size_t)(c * 64 + t) * EIN + 256 + h * 64 + k0), kv);
#pragma unroll
        for (int j = 0; j < 8; ++j) kT[(k0 + j) * 72 + t] = __builtin_bit_cast(unsigned short, (__bf16)(kv[j] * fexp(sTot[k0 + j] - sBC[t * 65 + k0 + j])));
#pragma unroll
        for (int u = 0; u < 2; ++u) { const int i = tid + 512 * u, row = i >> 4, c16 = i & 15; *(uint4*)(Vs + row * 136 + c16 * 8) = *(const uint4*)(P0 + (size_t)(c * 64 + row) * EIN + 512 + h * 128 + c16 * 8); }
    }
    __syncthreads();
    {
        f32x4 acc[4];
#pragma unroll
        for (int kt = 0; kt < 4; ++kt) acc[kt] = (f32x4){0.f, 0.f, 0.f, 0.f};
#pragma unroll
        for (int ks = 0; ks < 2; ++ks) {
            const bf16x8 af = tr_frag(Vs, 136, ks * 32, wave * 16, lane);
#pragma unroll
            for (int kt = 0; kt < 4; ++kt) acc[kt] = __builtin_amdgcn_mfma_f32_16x16x32_bf16(af, row_frag(kT, 72, kt * 16, ks * 32, lane), acc[kt], 0, 0, 0);
        }
#pragma unroll
        for (int kt = 0; kt < 4; ++kt) {
            const int k = kt * 16 + (lane & 15), v = wave * 16 + (lane >> 4) * 4;
            st4(GDS + ((size_t)(ch * NCH + c) * 64 + k) * 128 + v, make_float4(acc[kt][0], acc[kt][1], acc[kt][2], acc[kt][3]));
        }
    }
    if (tid < 64) GDEC[(size_t)(ch * NCH + c) * 64 + tid] = fexp(sTot[tid]);
}

DEV void gla2_unit(const Params& p, int unit) {
    const int tid = opaque_tid();
    float* GDS = (float*)(p.ws + OFF_GDS); const float* GDEC = (const float*)(p.ws + OFF_GDEC);
    const int ch = unit >> 4, e = (unit & 15) * 512 + tid, k = e >> 7, dir = ch & 1;
    float S = 0.f;
#pragma unroll 12
    for (int step = 0; step < NCH; ++step) {
        const int c = chunk_at(dir, step);
        float* gp = GDS + (size_t)(ch * NCH + c) * 8192 + e;
        const float d = GDEC[(size_t)(ch * NCH + c) * 64 + k], inc = *gp;
        *gp = S;
        S = d * S + inc;
    }
}

DEV void gla3_unit(const Params& p, int h, int c, float* sm) {
    const int tid = opaque_tid(), lane = tid & 63, wave = tid >> 6;
    const bf16_t* P0 = (const bf16_t*)(p.ws + OFF_P0);
    const float* GDS = (const float*)(p.ws + OFF_GDS);
    bf16_t* YC = (bf16_t*)(p.ws + OFF_YC);
    const float* ng = p.in[14];
    float* sLR = sm; float* sWA = sm + 1024; float* sBC = sm + 2048; float* sTot = sm + 6208;
    bf16_t* qt = (bf16_t*)(sm + 6272);
    bf16_t* kt = (bf16_t*)(sm + 8576);
    bf16_t* Sm = (bf16_t*)(sm + 10880);
    bf16_t* S0s = (bf16_t*)(sm + 13184);
    bf16_t* Vs = (bf16_t*)(sm + 17536);
    float* O = sm + 21888;
    const int ti = wave & 3, vt0 = (wave >> 2) * 4;
    f32x4 acc[4];
#pragma unroll
    for (int j = 0; j < 4; ++j) acc[j] = (f32x4){0.f, 0.f, 0.f, 0.f};
    __syncthreads();
#pragma unroll
    for (int u = 0; u < 2; ++u) { const int i = tid + 512 * u, row = i >> 4, c16 = i & 15; *(uint4*)(Vs + row * 136 + c16 * 8) = *(const uint4*)(P0 + (size_t)(c * 64 + row) * EIN + 512 + h * 128 + c16 * 8); }
#pragma unroll 1
    for (int dir = 0; dir < 2; ++dir) {
        const float* wa2 = p.in[dir ? 12 : 10]; const float* ba = p.in[dir ? 13 : 11];
        const int ch = h * 2 + dir;
        __syncthreads();
        gla_decay(P0, c, h, dir, wa2, ba, sLR, sWA, sBC, sTot, tid);
        {
            const int t = tid >> 3, k0 = (tid & 7) * 8;
            float qv[8], kv[8];
            unpack8(*(const uint4*)(P0 + (size_t)(c * 64 + t) * EIN + h * 64 + k0), qv);
            unpack8(*(const uint4*)(P0 + (size_t)(c * 64 + t) * EIN + 256 + h * 64 + k0), kv);
#pragma unroll
            for (int j = 0; j < 8; ++j) { const float bc = sBC[t * 65 + k0 + j]; qv[j] *= 0.125f * fexp(bc); kv[j] *= fexp(-bc); }
            *(uint4*)(qt + t * 72 + k0) = make_uint4(pack2bf(qv[0], qv[1]), pack2bf(qv[2], qv[3]), pack2bf(qv[4], qv[5]), pack2bf(qv[6], qv[7]));
            *(uint4*)(kt + t * 72 + k0) = make_uint4(pack2bf(kv[0], kv[1]), pack2bf(kv[2], kv[3]), pack2bf(kv[4], kv[5]), pack2bf(kv[6], kv[7]));
#pragma unroll
            for (int u = 0; u < 4; ++u) {
                const int i = tid + 512 * u, k = i >> 5, v4 = (i & 31) * 4;
                const float4 s4 = ld4(GDS + (size_t)(ch * NCH + c) * 8192 + k * 128 + v4);
                *(uint2*)(S0s + k * 136 + v4) = make_uint2(pack2bf(s4.x, s4.y), pack2bf(s4.z, s4.w));
            }
        }
        __syncthreads();
        {
            const int si = wave & 3;
#pragma unroll
            for (int jj = 0; jj < 2; ++jj) {
                const int t2 = (wave >> 2) * 2 + jj;
                f32x4 a = (f32x4){0.f, 0.f, 0.f, 0.f};
#pragma unroll
                for (int ks = 0; ks < 2; ++ks) a = __builtin_amdgcn_mfma_f32_16x16x32_bf16(row_frag(kt, 72, si * 16, ks * 32, lane), row_frag(qt, 72, t2 * 16, ks * 32, lane), a, 0, 0, 0);
                const int t = t2 * 16 + (lane & 15), s0 = si * 16 + (lane >> 4) * 4;
                float m[4];
#pragma unroll
                for (int r = 0; r < 4; ++r) { const bool keep = dir ? (s0 + r >= t) : (s0 + r <= t); m[r] = keep ? a[r] : 0.f; }
                *(uint2*)(Sm + t * 72 + s0) = make_uint2(pack2bf(m[0], m[1]), pack2bf(m[2], m[3]));
            }
        }
        __syncthreads();
#pragma unroll
        for (int ks = 0; ks < 2; ++ks) {
            const bf16x8 a1 = row_frag(qt, 72, ti * 16, ks * 32, lane), a2 = row_frag(Sm, 72, ti * 16, ks * 32, lane);
#pragma unroll
            for (int j = 0; j < 4; ++j) {
                acc[j] = __builtin_amdgcn_mfma_f32_16x16x32_bf16(a1, tr_frag(S0s, 136, ks * 32, (vt0 + j) * 16, lane), acc[j], 0, 0, 0);
                acc[j] = __builtin_amdgcn_mfma_f32_16x16x32_bf16(a2, tr_frag(Vs, 136, ks * 32, (vt0 + j) * 16, lane), acc[j], 0, 0, 0);
            }
        }
    }
#pragma unroll
    for (int j = 0; j < 4; ++j)
#pragma unroll
        for (int r = 0; r < 4; ++r) O[(ti * 16 + (lane >> 4) * 4 + r) * 132 + (vt0 + j) * 16 + (lane & 15)] = acc[j][r];
    __syncthreads();
    {
        const int t = tid >> 3, v0 = (tid & 7) * 16;
        float o[16];
        float ss = 0.f;
#pragma unroll
        for (int i = 0; i < 16; ++i) { o[i] = O[t * 132 + v0 + i]; ss += o[i] * o[i]; }
        ss += __shfl_xor(ss, 1, 64); ss += __shfl_xor(ss, 2, 64); ss += __shfl_xor(ss, 4, 64);
        const float rms = rsqrtf(ss * (1.f / 128.f) + 1e-5f);
        float g[16];
        const bf16_t* gp = P0 + (size_t)(c * 64 + t) * EIN + 1024 + h * 128 + v0;
        unpack8(*(const uint4*)gp, g); unpack8(*(const uint4*)(gp + 8), g + 8);
        float y[16];
#pragma unroll
        for (int i = 0; i < 16; ++i) y[i] = o[i] * rms * ng[v0 + i] * silu_f(g[i]);
        bf16_t* yp = YC + (size_t)(c * 64 + t) * 1024 + h * 128 + v0;
        *(uint4*)yp = make_uint4(pack2bf(y[0], y[1]), pack2bf(y[2], y[3]), pack2bf(y[4], y[5]), pack2bf(y[6], y[7]));
        *(uint4*)(yp + 8) = make_uint4(pack2bf(y[8], y[9]), pack2bf(y[10], y[11]), pack2bf(y[12], y[13]), pack2bf(y[14], y[15]));
    }
}

DEV void load8bf(const bf16_t* ptr, float* f) { unpack8(*(const uint4*)ptr, f); }
DEV void rw_mix8(const bf16_t* P0, int s, int cb, const float* __restrict__ mu, float* out) {
    float own[8]; load8bf(P0 + (size_t)s * EIN + RW0 + cb, own);
    int nL = -1, nR = -1, nU = -1, nD = -1;
    if (s < NCX) { if (s > 0) nL = s - 1; if (s < NCX - 1) nR = s + 1; }
    else { const int n = s - NCX, rr = n >> 6, cc = n & 63; if (cc > 0) nL = s - 1; if (cc < 63) nR = s + 1; if (rr > 0) nU = s - 64; if (rr < 127) nD = s + 64; }
    float fL[8], fR[8], fU[8], fD[8];
#pragma unroll
    for (int i = 0; i < 8; ++i) { fL[i] = 0.f; fR[i] = 0.f; fU[i] = 0.f; fD[i] = 0.f; }
    if (nL >= 0) load8bf(P0 + (size_t)nL * EIN + RW0 + cb, fL);
    if (nR >= 0) load8bf(P0 + (size_t)nR * EIN + RW0 + cb, fR);
    if (nU >= 0) load8bf(P0 + (size_t)nU * EIN + RW0 + cb, fU);
    if (nD >= 0) load8bf(P0 + (size_t)nD * EIN + RW0 + cb, fD);
    const float4 m0 = ld4(mu + cb), m1 = ld4(mu + cb + 4);
    const float m[8] = {m0.x, m0.y, m0.z, m0.w, m1.x, m1.y, m1.z, m1.w};
#pragma unroll
    for (int i = 0; i < 8; ++i) { const float nb = (i & 3) == 0 ? fL[i] : ((i & 3) == 1 ? fR[i] : ((i & 3) == 2 ? fU[i] : fD[i])); out[i] = own[i] + (nb - own[i]) * m[i]; }
}
DEV uint4 pack8(const float* f) { return make_uint4(pack2bf(f[0], f[1]), pack2bf(f[2], f[3]), pack2bf(f[4], f[5]), pack2bf(f[6], f[7])); }

template <int XM, int YM, class F>
DEV void mm64(const bf16_t* X, const bf16_t* Y, F f, int lane, int wave) {
#pragma unroll
    for (int q = 0; q < 2; ++q) {
        const int idx = wave * 2 + q, ti = idx >> 2, tj = idx & 3;
        f32x4 acc = (f32x4){0.f, 0.f, 0.f, 0.f};
#pragma unroll
        for (int ks = 0; ks < 2; ++ks) {
            const bf16x8 a = XM == 0 ? row_frag(X, 72, ti * 16, ks * 32, lane) : tr_frag(X, 72, ks * 32, ti * 16, lane);
            const bf16x8 bq = YM == 0 ? row_frag(Y, 72, tj * 16, ks * 32, lane) : tr_frag(Y, 72, ks * 32, tj * 16, lane);
            acc = __builtin_amdgcn_mfma_f32_16x16x32_bf16(a, bq, acc, 0, 0, 0);
        }
        f(ti * 16 + (lane >> 4) * 4, tj * 16 + (lane & 15), acc);
    }
}
template <int XM, int YM, class F>
DEV void mm64x2(const bf16_t* X1, const bf16_t* Y1, const bf16_t* X2, const bf16_t* Y2, F f, int lane, int wave) {
#pragma unroll
    for (int q = 0; q < 2; ++q) {
        const int idx = wave * 2 + q, ti = idx >> 2, tj = idx & 3;
        f32x4 acc = (f32x4){0.f, 0.f, 0.f, 0.f};
#pragma unroll
        for (int ks = 0; ks < 2; ++ks) {
            const bf16x8 a = XM == 0 ? row_frag(X1, 72, ti * 16, ks * 32, lane) : tr_frag(X1, 72, ks * 32, ti * 16, lane);
            const bf16x8 bq = YM == 0 ? row_frag(Y1, 72, tj * 16, ks * 32, lane) : tr_frag(Y1, 72, ks * 32, tj * 16, lane);
            acc = __builtin_amdgcn_mfma_f32_16x16x32_bf16(a, bq, acc, 0, 0, 0);
            const bf16x8 a2 = XM == 0 ? row_frag(X2, 72, ti * 16, ks * 32, lane) : tr_frag(X2, 72, ks * 32, ti * 16, lane);
            const bf16x8 b2 = YM == 0 ? row_frag(Y2, 72, tj * 16, ks * 32, lane) : tr_frag(Y2, 72, ks * 32, tj * 16, lane);
            acc = __builtin_amdgcn_mfma_f32_16x16x32_bf16(a2, b2, acc, 0, 0, 0);
        }
        f(ti * 16 + (lane >> 4) * 4, tj * 16 + (lane & 15), acc);
    }
}
DEV void st_img(bf16_t* P, int i0, int j, float a0, float a1, float a2, float a3) {
    P[(i0 + 0) * 72 + j] = __builtin_bit_cast(unsigned short, (__bf16)a0); P[(i0 + 1) * 72 + j] = __builtin_bit_cast(unsigned short, (__bf16)a1);
    P[(i0 + 2) * 72 + j] = __builtin_bit_cast(unsigned short, (__bf16)a2); P[(i0 + 3) * 72 + j] = __builtin_bit_cast(unsigned short, (__bf16)a3);
}

DEV void rwkv1_unit(const Params& p, int h, int dir, int c, float* sm) {
    const int tid = opaque_tid(), lane = tid & 63, wave = tid >> 6;
    const bf16_t* P0 = (const bf16_t*)(p.ws + OFF_P0);
    bf16_t* RU = (bf16_t*)(p.ws + OFF_RU) + (size_t)((h * 2 + dir) * NCH + c) * 16384;
    float* BONS = (float*)(p.ws + OFF_BONS);
    const float* mu = p.in[15];
    const float* w0 = p.in[dir ? 18 : 16]; const float* ww2 = p.in[dir ? 19 : 17];
    const float* a0 = p.in[dir ? 22 : 20]; const float* wa2 = p.in[dir ? 23 : 21];
    bf16_t* img = (bf16_t*)sm;
#define SLOT(i_) (img + (i_) * 4608)
    float* fLW = (float*)SLOT(10);
    float* fAS = (float*)SLOT(12);
    float* sv = (float*)SLOT(14);
    const int t = tid >> 3, j0 = (tid & 7) * 8, s = c * 64 + t;
    __syncthreads();
    if (tid < 64) { const int hc = h * 64 + tid; sv[64 + tid] = w0[hc]; sv[128 + tid] = a0[hc]; sv[192 + tid] = p.in[24][hc]; sv[256 + tid] = p.in[25][hc]; sv[320 + tid] = p.in[26][hc]; }
    float r8[8], k8[8], v8[8];
    {
        float x8[8];
        rw_mix8(P0, s, h * 64 + j0, mu, r8);
        rw_mix8(P0, s, 512 + h * 64 + j0, mu, k8);
        rw_mix8(P0, s, 1024 + h * 64 + j0, mu, v8);
        rw_mix8(P0, s, 2048 + dir * 64 + j0, mu, x8);
#pragma unroll
        for (int i = 0; i < 8; ++i) x8[i] = tanh_f(x8[i]);
        *(uint4*)(SLOT(6) + t * 72 + j0) = pack8(x8);
        rw_mix8(P0, s, 2176 + dir * 64 + j0, mu, x8);
        *(uint4*)(SLOT(7) + t * 72 + j0) = pack8(x8);
        float wq[8];
        { const float4 q0 = ld4(ww2 + (size_t)t * 512 + h * 64 + j0), q1 = ld4(ww2 + (size_t)t * 512 + h * 64 + j0 + 4); wq[0] = q0.x; wq[1] = q0.y; wq[2] = q0.z; wq[3] = q0.w; wq[4] = q1.x; wq[5] = q1.y; wq[6] = q1.z; wq[7] = q1.w; }
        *(uint4*)(SLOT(8) + t * 72 + j0) = pack8(wq);
        { const float4 q0 = ld4(wa2 + (size_t)t * 512 + h * 64 + j0), q1 = ld4(wa2 + (size_t)t * 512 + h * 64 + j0 + 4); wq[0] = q0.x; wq[1] = q0.y; wq[2] = q0.z; wq[3] = q0.w; wq[4] = q1.x; wq[5] = q1.y; wq[6] = q1.z; wq[7] = q1.w; }
        *(uint4*)(SLOT(9) + t * 72 + j0) = pack8(wq);
    }
    __syncthreads();
    mm64<0, 1>(SLOT(6), SLOT(8), [=](int i0, int j, f32x4 a) {
#pragma unroll
        for (int r = 0; r < 4; ++r) fLW[(i0 + r) * 65 + j] = -0.6065306597f * sigmoid_f(sv[64 + j] + a[r]); }, lane, wave);
    mm64<0, 1>(SLOT(7), SLOT(9), [=](int i0, int j, f32x4 a) {
#pragma unroll
        for (int r = 0; r < 4; ++r) fAS[(i0 + r) * 65 + j] = sigmoid_f(sv[128 + j] + a[r]); }, lane, wave);
    __syncthreads();
#pragma unroll
    for (int j = 0; j < 8; ++j) {
        const int k = wave * 8 + j;
        const float v = wave_scan_add(fLW[lane * 65 + k], lane, dir);
        fLW[lane * 65 + k] = v;
        if (lane == (dir ? 0 : 63)) sv[k] = v;
    }
    __syncthreads();
    {
        float kkv[8], ss = 0.f;
#pragma unroll
        for (int i = 0; i < 8; ++i) { kkv[i] = k8[i] * sv[192 + j0 + i]; ss += kkv[i] * kkv[i]; }
        ss += __shfl_xor(ss, 1, 64); ss += __shfl_xor(ss, 2, 64); ss += __shfl_xor(ss, 4, 64);
        const float rn = rsqrtf(fmaxf(ss, 1e-24f));
        float fa[8], fb[8], fk[8], fr[8], fbp[8], fkp[8], bon = 0.f;
        const int tp = dir ? t + 1 : t - 1;
        const bool hasp = dir ? (t < 63) : (t > 0);
#pragma unroll
        for (int i = 0; i < 8; ++i) {
            const int k = j0 + i;
            const float Bt = fLW[t * 65 + k], Bx = hasp ? fLW[tp * 65 + k] : 0.f, asg = fAS[t * 65 + k];
            const float kk = kkv[i] * rn, kh = k8[i] * (1.f + (asg - 1.f) * sv[256 + k]);
            bon += r8[i] * kh * sv[320 + k];
            const float enB = fexp(-Bt), eLB = fexp(sv[k] - Bt), bv = kk * asg;
            fa[i] = -kk * fexp(Bx); fb[i] = bv * enB; fk[i] = kh * enB; fr[i] = r8[i] * fexp(Bt); fbp[i] = bv * eLB; fkp[i] = kh * eLB;
        }
#ifdef RWKV_DEBUG
        if (c == 0 && dir == 0) {
            float* DBN = p.out + 9000000 + 8 * 64 * 64 * 6;
#pragma unroll
            for (int i = 0; i < 8; ++i) {
                const int k = j0 + i;
                const float Bt = fLW[t * 65 + k], Bx = hasp ? fLW[tp * 65 + k] : 0.f, asg = fAS[t * 65 + k];
                const float kk = kkv[i] * rn, kh = k8[i] * (1.f + (asg - 1.f) * sv[256 + k]);
                float* d = DBN + ((size_t)(h * 64 + t) * 64 + k) * 6;
                d[0] = fexp(Bt - Bx); d[1] = kh; d[2] = -kk; d[3] = kk * asg; d[4] = r8[i]; d[5] = v8[i];
            }
        }
#endif
        bon += __shfl_xor(bon, 1, 64); bon += __shfl_xor(bon, 2, 64); bon += __shfl_xor(bon, 4, 64);
        if ((tid & 7) == 0) BONS[((size_t)dir * TB + s) * 8 + h] = bon;
        *(uint4*)(SLOT(0) + t * 72 + j0) = pack8(fa); *(uint4*)(SLOT(1) + t * 72 + j0) = pack8(fb); *(uint4*)(SLOT(2) + t * 72 + j0) = pack8(fk);
        *(uint4*)(SLOT(3) + t * 72 + j0) = pack8(fr); *(uint4*)(SLOT(4) + t * 72 + j0) = pack8(fbp); *(uint4*)(SLOT(5) + t * 72 + j0) = pack8(fkp);
    }
    __syncthreads();
    *(uint4*)(SLOT(6) + t * 72 + j0) = pack8(v8);
    __syncthreads();
    mm64<0, 0>(SLOT(0), SLOT(1), [=](int i0, int j, f32x4 a) {
        float m[4];
#pragma unroll
        for (int r = 0; r < 4; ++r) { const bool keep = dir ? (j > i0 + r) : (j < i0 + r); m[r] = keep ? a[r] : 0.f; }
        const bool dg = (i0 >> 4) == (j >> 4);
        st_img(SLOT(7), i0, j, dg ? m[0] : 0.f, dg ? m[1] : 0.f, dg ? m[2] : 0.f, dg ? m[3] : 0.f);
        st_img(SLOT(8), i0, j, (dg ? m[0] : 0.f) + (j == i0 ? 1.f : 0.f), (dg ? m[1] : 0.f) + (j == i0 + 1 ? 1.f : 0.f), (dg ? m[2] : 0.f) + (j == i0 + 2 ? 1.f : 0.f), (dg ? m[3] : 0.f) + (j == i0 + 3 ? 1.f : 0.f));
        st_img(SLOT(12), i0, j, dg ? 0.f : m[0], dg ? 0.f : m[1], dg ? 0.f : m[2], dg ? 0.f : m[3]); }, lane, wave);
    mm64<0, 0>(SLOT(0), SLOT(2), [=](int i0, int j, f32x4 a) {
        float m[4];
#pragma unroll
        for (int r = 0; r < 4; ++r) { const bool keep = dir ? (j > i0 + r) : (j < i0 + r); m[r] = keep ? a[r] : 0.f; }
        st_img(SLOT(9), i0, j, m[0], m[1], m[2], m[3]); }, lane, wave);
    mm64<0, 0>(SLOT(3), SLOT(1), [=](int i0, int j, f32x4 a) {
        float m[4];
#pragma unroll
        for (int r = 0; r < 4; ++r) { const bool keep = dir ? (j >= i0 + r) : (j <= i0 + r); m[r] = keep ? a[r] : 0.f; }
        st_img(SLOT(10), i0, j, m[0], m[1], m[2], m[3]); }, lane, wave);
    mm64<0, 0>(SLOT(3), SLOT(2), [=](int i0, int j, f32x4 a) {
        float m[4];
#pragma unroll
        for (int r = 0; r < 4; ++r) { const bool keep = dir ? (j >= i0 + r) : (j <= i0 + r); m[r] = keep ? a[r] : 0.f; }
        st_img(SLOT(11), i0, j, m[0], m[1], m[2], m[3]); }, lane, wave);
    __syncthreads();
    {
        bf16_t* Pc = SLOT(7); bf16_t* Pn = SLOT(1); bf16_t* Tc = SLOT(8); bf16_t* Tn = SLOT(2);
#pragma unroll 1
        for (int it = 0; it < 3; ++it) {
            mm64<0, 1>(Pc, Pc, [=](int i0, int j, f32x4 a) { st_img(Pn, i0, j, a[0], a[1], a[2], a[3]); }, lane, wave);
            __syncthreads();
            mm64<0, 1>(Tc, Pn, [=](int i0, int j, f32x4 a) {
                st_img(Tn, i0, j, a[0] + bf2f(Tc[(i0 + 0) * 72 + j]), a[1] + bf2f(Tc[(i0 + 1) * 72 + j]), a[2] + bf2f(Tc[(i0 + 2) * 72 + j]), a[3] + bf2f(Tc[(i0 + 3) * 72 + j])); }, lane, wave);
            __syncthreads();
            bf16_t* tmp = Pc; Pc = Pn; Pn = tmp; tmp = Tc; Tc = Tn; Tn = tmp;
        }
    }
    mm64<0, 1>(SLOT(2), SLOT(12), [=](int i0, int j, f32x4 a) { st_img(SLOT(7), i0, j, a[0], a[1], a[2], a[3]); }, lane, wave);
    mm64<0, 1>(SLOT(2), SLOT(0), [=](int i0, int j, f32x4 a) { st_img(SLOT(1), i0, j, a[0], a[1], a[2], a[3]); }, lane, wave);
    mm64<0, 1>(SLOT(9), SLOT(6), [=](int i0, int j, f32x4 a) { st_img(SLOT(13), i0, j, a[0], a[1], a[2], a[3]); }, lane, wave);
    __syncthreads();
    mm64<0, 1>(SLOT(2), SLOT(13), [=](int i0, int j, f32x4 a) { st_img(SLOT(8), i0, j, a[0], a[1], a[2], a[3]); }, lane, wave);
    __syncthreads();
    {
        const bf16_t* Zp = (wave < 4) ? SLOT(1) : SLOT(8);
        bf16_t* Xi = (wave < 4) ? SLOT(12) : SLOT(9);
        const int ct = (wave & 3) * 16, g4 = (lane >> 4) * 4, l15 = lane & 15;
#pragma unroll
        for (int bs = 0; bs < 4; ++bs) {
            const int bi = dir ? 3 - bs : bs;
            f32x4 acc;
#pragma unroll
            for (int r = 0; r < 4; ++r) acc[r] = bf2f(Zp[(bi * 16 + g4 + r) * 72 + ct + l15]);
            const bool k0 = dir ? (bi == 0) : (bi >= 1), k1 = dir ? (bi <= 2) : (bi == 3);
            if (k0) acc = __builtin_amdgcn_mfma_f32_16x16x32_bf16(row_frag(SLOT(7), 72, bi * 16, 0, lane), tr_frag(Xi, 72, 0, ct, lane), acc, 0, 0, 0);
            if (k1) acc = __builtin_amdgcn_mfma_f32_16x16x32_bf16(row_frag(SLOT(7), 72, bi * 16, 32, lane), tr_frag(Xi, 72, 32, ct, lane), acc, 0, 0, 0);
            st_img(Xi, bi * 16 + g4, ct + l15, acc[0], acc[1], acc[2], acc[3]);
            __syncthreads();
        }
    }
    mm64<1, 1>(SLOT(12), SLOT(4), [=](int i0, int j, f32x4 a) {
        float m[4];
#pragma unroll
        for (int r = 0; r < 4; ++r) m[r] = a[r] + ((i0 + r) == j ? fexp(sv[j]) : 0.f);
        *(uint2*)(RU + j * 64 + i0) = make_uint2(pack2bf(m[0], m[1]), pack2bf(m[2], m[3])); }, lane, wave);
    mm64x2<1, 1>(SLOT(4), SLOT(9), SLOT(5), SLOT(6), [=](int i0, int j, f32x4 a) {
        *(uint2*)(RU + 4096 + j * 64 + i0) = make_uint2(pack2bf(a[0], a[1]), pack2bf(a[2], a[3])); }, lane, wave);
    mm64<1, 0>(SLOT(12), SLOT(10), [=](int i0, int j, f32x4 a) {
        const uint2 rr = *(const uint2*)(SLOT(3) + j * 72 + i0);
        *(uint2*)(RU + 8192 + j * 64 + i0) = make_uint2(pack2bf(a[0] + bflo(rr.x), a[1] + bfhi(rr.x)), pack2bf(a[2] + bflo(rr.y), a[3] + bfhi(rr.y))); }, lane, wave);
    mm64x2<0, 1>(SLOT(10), SLOT(9), SLOT(11), SLOT(6), [=](int i0, int j, f32x4 a) {
        *(uint2*)(RU + 12288 + j * 64 + i0) = make_uint2(pack2bf(a[0], a[1]), pack2bf(a[2], a[3])); }, lane, wave);
#undef SLOT
}

#define R2_LOAD(slot_, stp_) do { const int cn_ = chunk_at(dir, ((stp_) < NCH) ? (stp_) : NCH - 1); const bf16_t* U_ = RU + (size_t)(chain * NCH + cn_) * 16384; \
    _Pragma("unroll") for (int i_ = 0; i_ < 4; ++i_) { rc[slot_][i_] = *(const uint2*)(U_ + 4096 + (vblk * 16 + l15) * 64 + i_ * 16 + g * 4); \
        _Pragma("unroll") for (int ks_ = 0; ks_ < 2; ++ks_) { ra[slot_][i_][ks_][0] = *(const uint2*)(U_ + (i_ * 16 + l15) * 64 + ks_ * 32 + g * 4); ra[slot_][i_][ks_][1] = *(const uint2*)(U_ + (i_ * 16 + l15) * 64 + ks_ * 32 + 16 + g * 4); } } } while (0)
DEV void rwkv2_unit(const Params& p, int chain, int vblk, int lane) {
    asm volatile("" : "+v"(lane));
    const bf16_t* RU = (const bf16_t*)(p.ws + OFF_RU);
    bf16_t* S0G = (bf16_t*)(p.ws + OFF_RS0);
    const int dir = chain & 1, g = lane >> 4, l15 = lane & 15;
    f32x4 st[4];
#pragma unroll
    for (int i = 0; i < 4; ++i) st[i] = (f32x4){0.f, 0.f, 0.f, 0.f};
    uint2 ra[3][4][2][2], rc[3][4];
    R2_LOAD(0, 0); R2_LOAD(1, 1); R2_LOAD(2, 2);
#pragma unroll 1
    for (int step0 = 0; step0 < NCH; step0 += 3) {
#pragma unroll
        for (int q = 0; q < 3; ++q) {
            const int step = step0 + q, c = chunk_at(dir, step);
            uint2 ca[4][2][2], cc[4];
#pragma unroll
            for (int i = 0; i < 4; ++i) { cc[i] = rc[q][i]; ca[i][0][0] = ra[q][i][0][0]; ca[i][0][1] = ra[q][i][0][1]; ca[i][1][0] = ra[q][i][1][0]; ca[i][1][1] = ra[q][i][1][1]; }
            R2_LOAD(q, step + 3);
            __builtin_amdgcn_sched_barrier(0);
            unsigned pk[4][2];
#pragma unroll
            for (int i = 0; i < 4; ++i) { pk[i][0] = pack2bf(st[i][0], st[i][1]); pk[i][1] = pack2bf(st[i][2], st[i][3]); }
            bf16_t* sp = S0G + ((size_t)(chain * NCH + c) * 64 + vblk * 16 + l15) * 64 + g * 4;
#pragma unroll
            for (int i = 0; i < 4; ++i) *(uint2*)(sp + i * 16) = make_uint2(pk[i][0], pk[i][1]);
            bf16x8 bfr[2];
#pragma unroll
            for (int ks = 0; ks < 2; ++ks) { const uint4 u = make_uint4(pk[2 * ks][0], pk[2 * ks][1], pk[2 * ks + 1][0], pk[2 * ks + 1][1]); bfr[ks] = __builtin_bit_cast(bf16x8, u); }
#pragma unroll
            for (int i = 0; i < 4; ++i) {
                f32x4 acc = (f32x4){bflo(cc[i].x), bfhi(cc[i].x), bflo(cc[i].y), bfhi(cc[i].y)};
#pragma unroll
                for (int ks = 0; ks < 2; ++ks) {
                    const uint4 u = make_uint4(ca[i][ks][0].x, ca[i][ks][0].y, ca[i][ks][1].x, ca[i][ks][1].y);
                    acc = __builtin_amdgcn_mfma_f32_16x16x32_bf16(__builtin_bit_cast(bf16x8, u), bfr[ks], acc, 0, 0, 0);
                }
                st[i] = acc;
            }
        }
    }
}
#undef R2_LOAD

DEV void rwkv3_unit(const Params& p, int h, int c, float* sm, bool dbg_on = false) {
    const int tid = opaque_tid(), lane = tid & 63, wave = tid >> 6;
    const bf16_t* P0 = (const bf16_t*)(p.ws + OFF_P0);
    const bf16_t* RUb = (const bf16_t*)(p.ws + OFF_RU);
    const bf16_t* S0G = (const bf16_t*)(p.ws + OFF_RS0);
    const float* BONS = (const float*)(p.ws + OFF_BONS);
    bf16_t* YC = (bf16_t*)(p.ws + OFF_YC);
    const float* mu = p.in[15]; const float* gn_g = p.in[27]; const float* gn_b = p.in[28];
    bf16_t* img = (bf16_t*)sm;
    float* O = sm + 4 * 2304;
#ifdef RWKV_DEBUG
    float* Od = O + 64 * 68;
#endif
    __syncthreads();
    {
        const int row = tid >> 3, c8 = (tid & 7) * 8;
#pragma unroll
        for (int dir = 0; dir < 2; ++dir) {
            const size_t u = (size_t)((h * 2 + dir) * NCH + c);
            *(uint4*)(img + dir * 4608 + row * 72 + c8) = *(const uint4*)(RUb + u * 16384 + 8192 + row * 64 + c8);
            *(uint4*)(img + (2 + dir) * 4608 + row * 72 + c8) = *(const uint4*)(S0G + u * 4096 + row * 64 + c8);
        }
    }
    __syncthreads();
#pragma unroll
    for (int q = 0; q < 2; ++q) {
        const int idx = wave * 2 + q, ti = idx >> 2, tj = idx & 3;
        f32x4 accd[2];
#pragma unroll
        for (int dir = 0; dir < 2; ++dir) {
            f32x4 acc = (f32x4){0.f, 0.f, 0.f, 0.f};
#pragma unroll
            for (int ks = 0; ks < 2; ++ks) acc = __builtin_amdgcn_mfma_f32_16x16x32_bf16(row_frag(img + dir * 4608, 72, ti * 16, ks * 32, lane), row_frag(img + (2 + dir) * 4608, 72, tj * 16, ks * 32, lane), acc, 0, 0, 0);
            const uint2 yl = *(const uint2*)(RUb + (size_t)((h * 2 + dir) * NCH + c) * 16384 + 12288 + (tj * 16 + (lane & 15)) * 64 + ti * 16 + (lane >> 4) * 4);
            acc[0] += bflo(yl.x); acc[1] += bfhi(yl.x); acc[2] += bflo(yl.y); acc[3] += bfhi(yl.y);
            accd[dir] = acc;
        }
#pragma unroll
        for (int r = 0; r < 4; ++r) {
            const int oi = (ti * 16 + (lane >> 4) * 4 + r) * 68 + tj * 16 + (lane & 15);
            O[oi] = accd[0][r] + accd[1][r];
#ifdef RWKV_DEBUG
            Od[oi] = ((DBG_DIRMASK & 1) ? accd[0][r] : 0.f) + ((DBG_DIRMASK & 2) ? accd[1][r] : 0.f);
#endif
        }
    }
    __syncthreads();
    {
        const int t = tid >> 3, v0 = (tid & 7) * 8, s = c * 64 + t;
        float y[8], sum = 0.f;
#pragma unroll
        for (int i = 0; i < 8; ++i) { y[i] = O[t * 68 + v0 + i]; sum += y[i]; }
#ifdef RWKV_DEBUG
        if (dbg_on && c >= DBG_CMIN && c < DBG_CMAX) {
            float num = 0.f, den = 0.f;
#pragma unroll
            for (int i = 0; i < 8; ++i) {
                if (DBG_MODE == 1) { const float o = p.out[(size_t)s * 1024 + 512 + h * 64 + v0 + i]; const float yd = DBG_SELFTEST ? 1.05f * o : Od[t * 68 + v0 + i]; num += (yd - o) * (yd - o); den += o * o; }
                else { const float* dold = p.out + 9000000 + ((size_t)(h * 64 + t) * 64 + v0 + i) * 6; const float* dn = dold + 8 * 64 * 64 * 6;
                       for (int q = 1; q < 6; ++q) { const float o = dold[q], n = dn[q]; num += (n - o) * (n - o); den += o * o; } }
            }
            num = wave_sum(num); den = wave_sum(den);
            if (lane == 0) { atomicAdd((unsigned long long*)(p.ws + OFF_X1C + 2200000), (unsigned long long)(fminf(num, 1e12f) * 1048576.f)); atomicAdd((unsigned long long*)(p.ws + OFF_X1C + 2200008), (unsigned long long)(fminf(den, 1e12f) * 1048576.f)); }
        }
#endif
        sum += __shfl_xor(sum, 1, 64); sum += __shfl_xor(sum, 2, 64); sum += __shfl_xor(sum, 4, 64);
        const float mean = sum * (1.f / 64.f);
        float sq = 0.f;
#pragma unroll
        for (int i = 0; i < 8; ++i) { y[i] -= mean; sq += y[i] * y[i]; }
        sq += __shfl_xor(sq, 1, 64); sq += __shfl_xor(sq, 2, 64); sq += __shfl_xor(sq, 4, 64);
        const float rstd = rsqrtf(sq * (1.f / 64.f) + 64e-5f);
        float vm[8], gm[8];
        rw_mix8(P0, s, 1024 + h * 64 + v0, mu, vm);
        rw_mix8(P0, s, 1536 + h * 64 + v0, mu, gm);
        const float bon = BONS[(size_t)s * 8 + h] + BONS[((size_t)TB + s) * 8 + h];
        float o[8];
#pragma unroll
        for (int i = 0; i < 8; ++i) o[i] = (y[i] * rstd * gn_g[h * 64 + v0 + i] + gn_b[h * 64 + v0 + i] + bon * vm[i]) * silu_f(gm[i]);
        *(uint4*)(YC + (size_t)s * 1024 + 512 + h * 64 + v0) = pack8(o);
    }
}

DEV void ln_rows(const float* src, int nrows, const float* __restrict__ g, const float* __restrict__ bt, float* dst_lat, float* dst_cx, int ncx) {
    const int tid_ = opaque_tid(); const int lane = tid_ & 63, gw = blockIdx.x * NWV + (tid_ >> 6), ngw = gridDim.x * NWV;
    for (int r = gw; r < nrows; r += ngw) {
        const float* x = src + (size_t)r * 1024;
        float4 v[4];
        float sum = 0.f;
#pragma unroll
        for (int i = 0; i < 4; ++i) { v[i] = ld4(x + i * 256 + lane * 4); sum += v[i].x + v[i].y + v[i].z + v[i].w; }
        const float mean = wave_sum(sum) * (1.f / 1024.f);
        float sq = 0.f;
#pragma unroll
        for (int i = 0; i < 4; ++i) {
            v[i].x -= mean; v[i].y -= mean; v[i].z -= mean; v[i].w -= mean;
            sq += v[i].x * v[i].x + v[i].y * v[i].y + v[i].z * v[i].z + v[i].w * v[i].w;
        }
        const float rstd = rsqrtf(wave_sum(sq) * (1.f / 1024.f) + 1e-5f);
        float* d = (r < ncx) ? (dst_cx + (size_t)r * 1024) : (dst_lat + (size_t)(r - ncx) * 1024);
#pragma unroll
        for (int i = 0; i < 4; ++i) {
            const int c = i * 256 + lane * 4;
            const float4 gg = ld4(g + c), bb = ld4(bt + c);
            st4(d + c, make_float4(v[i].x * rstd * gg.x + bb.x, v[i].y * rstd * gg.y + bb.y, v[i].z * rstd * gg.z + bb.z, v[i].w * rstd * gg.w + bb.w));
        }
    }
}

DEV void zero_f4(float* ptr, size_t nfloat) {
    const size_t n4 = nfloat / 4;
    for (size_t i = (size_t)blockIdx.x * NTHR + opaque_tid(); i < n4; i += (size_t)gridDim.x * NTHR) ((float4*)ptr)[i] = make_float4(0.f, 0.f, 0.f, 0.f);
}

DEV void chain_ids(int& chain, int& sub) {
    const int bid = blockIdx.x, xcd = bid & 7, idx = bid >> 3;
    chain = xcd * 2 + (idx >> 4); sub = idx & 15;
}

DEV void phase_conv1(const Params& p, float* sm) {
    const bf16_t* XM = (const bf16_t*)(p.ws + OFF_XM);
    bf16_t* XC = (bf16_t*)(p.ws + OFF_XC);
    float* G16P = (float*)(p.ws + OFF_G16P);
    const bf16_t* WFT = (const bf16_t*)(p.ws + OFF_WFT);
    const float* cw = p.in[31]; const float* cbias = p.in[32];
    bf16_t* imgC = (bf16_t*)sm;
    bf16_t* imgM = imgC + 64 * 264;
    float* red = (float*)(imgM + 64 * 264);
    const int tid = opaque_tid(), lane = tid & 63, wave = tid >> 6, t = tid >> 3, cg = tid & 7;
    for (int u = blockIdx.x; u < NB * NCH * 4; u += gridDim.x) {
        const int ci = u >> 2, q = u & 3, b = ci / NCH, c = ci % NCH, s = c * 64 + t;
        const size_t rowbase = (size_t)b * TB;
        int nrow[9];
#pragma unroll
        for (int i = 0; i < 3; ++i)
#pragma unroll
            for (int j = 0; j < 3; ++j) {
                int ns = -1;
                if (s < NCX) { const int w2 = s + j - 1; if (i == 1 && w2 >= 0 && w2 < NCX) ns = w2; }
                else { const int n = s - NCX, rr = (n >> 6) + i - 1, w2 = (n & 63) + j - 1; if (rr >= 0 && rr < 128 && w2 >= 0 && w2 < 64) ns = NCX + rr * 64 + w2; }
                nrow[i * 3 + j] = ns;
            }
        const int tt = wave & 3, part = wave >> 2;
        f32x4 acc = (f32x4){0.f, 0.f, 0.f, 0.f};
#pragma unroll 1
        for (int half = 0; half < 2; ++half) {
            __syncthreads();
#pragma unroll 2
            for (int it = 0; it < 4; ++it) {
                const int cl = it * 64 + cg * 8, c0 = q * 512 + half * 256 + cl;
                float a8[8];
                { const float4 b0 = ld4(cbias + c0), b1 = ld4(cbias + c0 + 4); a8[0] = b0.x; a8[1] = b0.y; a8[2] = b0.z; a8[3] = b0.w; a8[4] = b1.x; a8[5] = b1.y; a8[6] = b1.z; a8[7] = b1.w; }
                uint4 xmc = make_uint4(0u, 0u, 0u, 0u);
#pragma unroll
                for (int tap = 0; tap < 9; ++tap) {
                    if (nrow[tap] >= 0) {
                        const uint4 xv = *(const uint4*)(XM + (rowbase + nrow[tap]) * 2048 + c0);
                        float x8[8]; unpack8(xv, x8);
                        const float4 w0 = ld4(cw + tap * 2048 + c0), w1 = ld4(cw + tap * 2048 + c0 + 4);
                        a8[0] += x8[0] * w0.x; a8[1] += x8[1] * w0.y; a8[2] += x8[2] * w0.z; a8[3] += x8[3] * w0.w;
                        a8[4] += x8[4] * w1.x; a8[5] += x8[5] * w1.y; a8[6] += x8[6] * w1.z; a8[7] += x8[7] * w1.w;
                        if (tap == 4) xmc = xv;
                    }
                }
#pragma unroll
                for (int i = 0; i < 8; ++i) a8[i] = silu_f(a8[i]);
                const uint4 xcv = pack8(a8);
                *(uint4*)(XC + (rowbase + s) * 2048 + c0) = xcv;
                *(uint4*)(imgC + t * 264 + cl) = xcv;
                *(uint4*)(imgM + t * 264 + cl) = xmc;
            }
            __syncthreads();
            {
                const bf16_t* img = part ? imgM : imgC;
                const bf16_t* wrow = WFT + (size_t)(lane & 15) * 4096 + part * 2048 + q * 512 + half * 256 + (lane >> 4) * 8;
#pragma unroll
                for (int ks = 0; ks < 8; ++ks) acc = __builtin_amdgcn_mfma_f32_16x16x32_bf16(row_frag(img, 264, tt * 16, ks * 32, lane), *(const bf16x8*)(wrow + ks * 32), acc, 0, 0, 0);
            }
        }
        if (part == 1) {
#pragma unroll
            for (int r = 0; r < 4; ++r) red[(tt * 16 + (lane >> 4) * 4 + r) * 16 + (lane & 15)] = acc[r];
        }
        __syncthreads();
        if (part == 0) {
#pragma unroll
            for (int r = 0; r < 4; ++r) {
                const int tk = tt * 16 + (lane >> 4) * 4 + r;
                G16P[((size_t)q * RT + rowbase + c * 64 + tk) * 16 + (lane & 15)] = acc[r] + red[tk * 16 + (lane & 15)];
            }
        }
    }
}

DEV void gate_pair(const Params& p, size_t row, int dir, int h, float& gi, float& lf) {
    const float* G16P = (const float*)(p.ws + OFF_G16P);
    float a = 0.f, f = 0.f;
#pragma unroll
    for (int q = 0; q < 4; ++q) { a += G16P[((size_t)q * RT + row) * 16 + dir * 8 + h]; f += G16P[((size_t)q * RT + row) * 16 + dir * 8 + 4 + h]; }
    gi = a + p.in[dir ? 41 : 37][h];
    lf = logsig_f(f + p.in[dir ? 43 : 39][h]);
}

DEV void phase_x1(const Params& p, float* sm) {
    int chain, sub; chain_ids(chain, sub);
    const int b = chain >> 3, h = (chain >> 1) & 3, dir = chain & 1;
    const bf16_t* XC = (const bf16_t*)(p.ws + OFF_XC);
    float* GSC = (float*)(p.ws + OFF_GSC); float* CSC = (float*)(p.ws + OFF_CSC); float* NBUF = (float*)(p.ws + OFF_NBUF);
    const float* gtab = (const float*)(p.ws + OFF_GTAB);
    bf16_t* SMAT = (bf16_t*)(p.ws + OFF_SMAT);
    const int tid = opaque_tid(), lane = tid & 63, wave = tid >> 6;
    float* sTot = sm; float* sRef = sm + 132; float* sM0 = sm + 264; float* sBeta = sm + 400;
    for (int c = wave; c < NCH; c += NWV) {
        const size_t row = (size_t)b * TB + c * 64 + lane;
        float gi, lf; gate_pair(p, row, dir, h, gi, lf);
        const float bc = wave_scan_add(lf, lane, dir);
        const float ref = wave_max(gi - bc), tot = wave_sum(lf);
        if (lane == 0) { sTot[c] = tot; sRef[c] = ref; }
    }
    __syncthreads();
    if (tid == 0) {
        float m0 = -INFINITY;
        for (int step = 0; step < NCH; ++step) {
            const int c = chunk_at(dir, step);
            sM0[c] = m0;
            const float mx = fmaxf(m0, sRef[c]);
            if (sub == 0) { CSC[(chain * NCH + c) * 2] = fexp(m0 - mx); CSC[(chain * NCH + c) * 2 + 1] = fexp(sRef[c] - mx); }
            m0 = sTot[c] + mx;
        }
    }
    __syncthreads();
    for (int k = wave; sub + 16 * k < NCH; k += NWV) {
        const int c = sub + 16 * k;
        const size_t row = (size_t)b * TB + c * 64 + lane;
        float gi, lf; gate_pair(p, row, dir, h, gi, lf);
        const float bc = wave_scan_add(lf, lane, dir);
        const float a = gi - bc;
        const float amax = wave_scan_max(a, lane, dir);
        const float ref = sRef[c], m0 = sM0[c];
        const float mmax = fmaxf(amax, m0);
        const float mt = bc + mmax;
        const float alpha = fexp(ref - mmax), beta = fexp(a - ref), gg = fexp(m0 - mmax), em = fexp(-mt);
        st4(GSC + ((size_t)chain * TB + c * 64 + lane) * 4, make_float4(alpha, beta, gg, em));
        sBeta[k * 64 + lane] = beta;
    }
    __syncthreads();
    {
        float* part = sm + 1024;
        const int sg = tid >> 6, j8 = (tid & 63) * 8;
        for (int k = 0; sub + 16 * k < NCH; ++k) {
            const int c = sub + 16 * k;
            const bf16_t* xp = XC + ((size_t)b * TB + c * 64 + sg * 8) * 2048 + h * 512 + j8;
            float acc[8];
#pragma unroll
            for (int i = 0; i < 8; ++i) acc[i] = 0.f;
#pragma unroll
            for (int s = 0; s < 8; ++s) {
                float f[8]; unpack8(*(const uint4*)(xp + (size_t)s * 2048), f);
                const float be = sBeta[k * 64 + sg * 8 + s];
#pragma unroll
                for (int i = 0; i < 8; ++i) acc[i] += be * f[i];
            }
            __syncthreads();
            st4(part + sg * 512 + j8, make_float4(acc[0], acc[1], acc[2], acc[3])); st4(part + sg * 512 + j8 + 4, make_float4(acc[4], acc[5], acc[6], acc[7]));
            __syncthreads();
            float tot = 0.f;
#pragma unroll
            for (int q = 0; q < 8; ++q) tot += part[q * 512 + tid];
            NBUF[((size_t)chain * NCH + c) * 512 + tid] = tot;
        }
    }
    bf16_t* XCs = (bf16_t*)sm;
    bf16_t* Qs = XCs + 64 * 520;
    for (int u = blockIdx.x; u < NB * 4 * NCH; u += gridDim.x) {
        const int bh = u / NCH, c = u % NCH, ub = bh >> 2, uh = bh & 3;
        __syncthreads();
#pragma unroll 2
        for (int i = 0; i < 8; ++i) {
            const int pp = tid + 512 * i, row = pp >> 6, c16 = pp & 63;
            const uint4 xv = *(const uint4*)(XC + ((size_t)ub * TB + c * 64 + row) * 2048 + uh * 512 + c16 * 8);
            float f[8]; unpack8(xv, f);
            float q[8];
#pragma unroll
            for (int bb = 0; bb < 2; ++bb) {
                const float* G = gtab + (size_t)(uh * 128 + c16 * 2 + bb) * 16;
                const float4 g0 = ld4(G), g1 = ld4(G + 4), g2 = ld4(G + 8), g3 = ld4(G + 12);
                q[bb * 4 + 0] = f[bb * 4] * g0.x + f[bb * 4 + 1] * g1.x + f[bb * 4 + 2] * g2.x + f[bb * 4 + 3] * g3.x;
                q[bb * 4 + 1] = f[bb * 4] * g0.y + f[bb * 4 + 1] * g1.y + f[bb * 4 + 2] * g2.y + f[bb * 4 + 3] * g3.y;
                q[bb * 4 + 2] = f[bb * 4] * g0.z + f[bb * 4 + 1] * g1.z + f[bb * 4 + 2] * g2.z + f[bb * 4 + 3] * g3.z;
                q[bb * 4 + 3] = f[bb * 4] * g0.w + f[bb * 4 + 1] * g1.w + f[bb * 4 + 2] * g2.w + f[bb * 4 + 3] * g3.w;
            }
            *(uint4*)(XCs + row * 520 + c16 * 8) = xv;
            *(uint4*)(Qs + row * 520 + c16 * 8) = make_uint4(pack2bf(q[0], q[1]), pack2bf(q[2], q[3]), pack2bf(q[4], q[5]), pack2bf(q[6], q[7]));
        }
        __syncthreads();
        const int st = wave & 3, tt0 = (wave >> 2) * 2;
        f32x4 a0 = (f32x4){0.f, 0.f, 0.f, 0.f}, a1 = a0;
        const bf16_t* ap = XCs + (st * 16 + (lane & 15)) * 520 + (lane >> 4) * 8;
        const bf16_t* bp0 = Qs + (tt0 * 16 + (lane & 15)) * 520 + (lane >> 4) * 8;
        const bf16_t* bp1 = bp0 + 16 * 520;
#pragma unroll
        for (int ks = 0; ks < 16; ++ks) {
            const bf16x8 af = *(const bf16x8*)(ap + ks * 32);
            a0 = __builtin_amdgcn_mfma_f32_16x16x32_bf16(af, *(const bf16x8*)(bp0 + ks * 32), a0, 0, 0, 0);
            a1 = __builtin_amdgcn_mfma_f32_16x16x32_bf16(af, *(const bf16x8*)(bp1 + ks * 32), a1, 0, 0, 0);
        }
        bf16_t* sp = SMAT + (size_t)u * 4096 + (size_t)(tt0 * 16 + (lane & 15)) * 64 + st * 16 + (lane >> 4) * 4;
        *(uint2*)sp = make_uint2(pack2bf(a0[0], a0[1]), pack2bf(a0[2], a0[3]));
        *(uint2*)(sp + 16 * 64) = make_uint2(pack2bf(a1[0], a1[1]), pack2bf(a1[2], a1[3]));
    }
}

DEV void phase_x2(const Params& p, float* sm) {
    int chain, sub; chain_ids(chain, sub);
    const int b = chain >> 3, h = (chain >> 1) & 3, dir = chain & 1;
    const bf16_t* XC = (const bf16_t*)(p.ws + OFF_XC);
    float* GSC = (float*)(p.ws + OFF_GSC); const float* CSC = (const float*)(p.ws + OFF_CSC); const float* NBUF = (const float*)(p.ws + OFF_NBUF);
    const float* gtab = (const float*)(p.ws + OFF_GTAB);
    const bf16_t* SMAT = (const bf16_t*)(p.ws + OFF_SMAT);
    const int tid = opaque_tid();
    float* sD0 = sm; float* sCf = sm + 132; float* sN0 = sm + 264; float* sN2 = sN0 + 9 * 512;
    for (int i = tid; i < NCH; i += NTHR) { sD0[i] = CSC[(chain * NCH + i) * 2]; sCf[i] = CSC[(chain * NCH + i) * 2 + 1]; }
    __syncthreads();
    {
        float n = 0.f;
        const float* nb = NBUF + (size_t)chain * NCH * 512 + tid;
#pragma unroll 4
        for (int step = 0; step < NCH; ++step) {
            const int c = chunk_at(dir, step);
            if ((c & 15) == sub) sN0[(c >> 4) * 512 + tid] = n;
            n = sD0[c] * n + sCf[c] * nb[(size_t)c * 512];
        }
    }
    __syncthreads();
    {
        const int blk = tid >> 2, cp = tid & 3;
        const float4 g = ld4(gtab + (size_t)(h * 128 + blk) * 16 + cp * 4);
        for (int k = 0; sub + 16 * k < NCH; ++k) {
            const float* n0 = sN0 + k * 512 + blk * 4;
            sN2[k * 512 + tid] = g.x * n0[0] + g.y * n0[1] + g.z * n0[2] + g.w * n0[3];
        }
    }
    __syncthreads();
    const int t = tid >> 3, part = tid & 7;
    for (int k = 0; sub + 16 * k < NCH; ++k) {
        const int c = sub + 16 * k;
        const size_t row = (size_t)b * TB + c * 64 + t;
        float dint = 0.f;
        {
            const bf16_t* xp = XC + row * 2048 + h * 512 + part * 64;
            const float* n2 = sN2 + k * 512 + part * 64;
#pragma unroll
            for (int i = 0; i < 8; ++i) {
                float f[8]; unpack8(*(const uint4*)(xp + i * 8), f);
                const float4 na = ld4(n2 + i * 8), nb2 = ld4(n2 + i * 8 + 4);
                dint += f[0] * na.x + f[1] * na.y + f[2] * na.z + f[3] * na.w + f[4] * nb2.x + f[5] * nb2.y + f[6] * nb2.z + f[7] * nb2.w;
            }
        }
        float di = 0.f;
        {
            float f[8]; unpack8(*(const uint4*)(SMAT + ((size_t)((b * 4 + h) * NCH + c)) * 4096 + t * 64 + part * 8), f);
#pragma unroll
            for (int e = 0; e < 8; ++e) {
                const int s = part * 8 + e;
                const float beta = GSC[((size_t)chain * TB + c * 64 + s) * 4 + 1];
                const bool keep = dir ? (s >= t) : (s <= t);
                di += keep ? f[e] * beta : 0.f;
            }
        }
        dint += __shfl_xor(dint, 1, 64); dint += __shfl_xor(dint, 2, 64); dint += __shfl_xor(dint, 4, 64);
        di += __shfl_xor(di, 1, 64); di += __shfl_xor(di, 2, 64); di += __shfl_xor(di, 4, 64);
        if (part == 0) {
            float* gp = GSC + ((size_t)chain * TB + c * 64 + t) * 4;
            const float4 g4 = ld4(gp);
            const float den = g4.x * di + g4.z * dint;
            gp[3] = 1.f / fmaxf(fabsf(den), g4.w);
        }
    }
}

#define MLSTM_PREFETCH(step_) do { \
    const int c_ = chunk_at(dir, (step_)); const size_t rb_ = (size_t)b * TB + (size_t)c_ * 64; \
    { const bf16_t* xb_ = XC + (rb_ + (tid >> 6)) * 2048 + h * 512 + (tid & 63) * 8; \
      rx0 = *(const uint4*)(xb_); rx1 = *(const uint4*)(xb_ + 8 * 2048); rx2 = *(const uint4*)(xb_ + 16 * 2048); rx3 = *(const uint4*)(xb_ + 24 * 2048); \
      rx4 = *(const uint4*)(xb_ + 32 * 2048); rx5 = *(const uint4*)(xb_ + 40 * 2048); rx6 = *(const uint4*)(xb_ + 48 * 2048); rx7 = *(const uint4*)(xb_ + 56 * 2048); } \
    rxm = *(const uint2*)(XM + (rb_ + ps) * 2048 + ch0 + pvb * 4); \
    rs = *(const uint4*)(SMAT + ((size_t)((b * 4 + h) * NCH + c_)) * 4096 + ps * 64 + pvb * 8); \
    rbeta = GSC[((size_t)chain * TB + c_ * 64 + ps) * 4 + 1]; \
    if (tid < 64) rsc = ld4(GSC + ((size_t)chain * TB + c_ * 64 + tid) * 4); \
    rd0 = CSC[(chain * NCH + c_) * 2]; rcf = CSC[(chain * NCH + c_) * 2 + 1]; } while (0)

DEV void phase_mlstm(const Params& p, float* sm) {
    int chain, sub; chain_ids(chain, sub);
    const int b = chain >> 3, h = (chain >> 1) & 3, dir = chain & 1;
    const bf16_t* XM = (const bf16_t*)(p.ws + OFF_XM);
    const bf16_t* XC = (const bf16_t*)(p.ws + OFF_XC);
    const bf16_t* SMAT = (const bf16_t*)(p.ws + OFF_SMAT);
    const float* GSC = (const float*)(p.ws + OFF_GSC); const float* CSC = (const float*)(p.ws + OFF_CSC);
    const float* gtab = (const float*)(p.ws + OFF_GTAB);
    bf16_t* H = (bf16_t*)(p.ws + OFF_H);
    const float* wv = p.in[35];
    char* smc = (char*)sm;
    bf16_t* XCs = (bf16_t*)smc;
    bf16_t* Cs = (bf16_t*)(smc + 66560);
    bf16_t* Vb = (bf16_t*)(smc + 66560 + 33280);
    bf16_t* Vw = Vb + 32 * 72;
    bf16_t* Sm = Vw + 32 * 72;
    float* Gs = (float*)(smc + 66560 + 33280 + 2 * 4608 + 9216);
    float* sc = Gs + 2048;
    const int tid = opaque_tid(), lane = tid & 63, wave = tid >> 6;
    for (int i = tid; i < 32 * 520 / 2; i += NTHR) ((unsigned*)Cs)[i] = 0u;
    for (int i = tid; i < 2048; i += NTHR) Gs[i] = gtab[h * 2048 + i];
    const int ps = tid >> 3, pvb = tid & 7;
    const int ch0 = h * 512 + sub * 32;
    float wvr[16];
#pragma unroll
    for (int i = 0; i < 16; ++i) wvr[i] = wv[(size_t)((ch0 >> 2) + pvb) * 16 + i];
    f32x4 accS[4][2];
#pragma unroll
    for (int i = 0; i < 4; ++i) { accS[i][0] = (f32x4){0.f, 0.f, 0.f, 0.f}; accS[i][1] = (f32x4){0.f, 0.f, 0.f, 0.f}; }
    uint4 rx0, rx1, rx2, rx3, rx4, rx5, rx6, rx7; uint2 rxm; uint4 rs; float rbeta; float4 rsc = make_float4(0.f, 0.f, 0.f, 0.f); float rd0, rcf;
    MLSTM_PREFETCH(0);
    __syncthreads();
#pragma unroll 1
    for (int step = 0; step < NCH; ++step) {
        const int c = chunk_at(dir, step);
        const float d0 = rd0, cf = rcf;
        {
            bf16_t* xd = XCs + (tid >> 6) * 520 + (tid & 63) * 8;
            *(uint4*)(xd) = rx0; *(uint4*)(xd + 8 * 520) = rx1; *(uint4*)(xd + 16 * 520) = rx2; *(uint4*)(xd + 24 * 520) = rx3;
            *(uint4*)(xd + 32 * 520) = rx4; *(uint4*)(xd + 40 * 520) = rx5; *(uint4*)(xd + 48 * 520) = rx6; *(uint4*)(xd + 56 * 520) = rx7;
        }
        {
            const float x0 = bflo(rxm.x), x1 = bfhi(rxm.x), x2 = bflo(rxm.y), x3 = bfhi(rxm.y);
#pragma unroll
            for (int d = 0; d < 4; ++d) {
                const float v = (x0 * wvr[d] + x1 * wvr[4 + d] + x2 * wvr[8 + d] + x3 * wvr[12 + d]) * rbeta;
                Vb[(pvb * 4 + d) * 72 + ps] = __builtin_bit_cast(unsigned short, (__bf16)v);
                Vw[(pvb * 4 + d) * 72 + ps] = __builtin_bit_cast(unsigned short, (__bf16)(v * cf));
            }
        }
        {
#define SMASK(q_) (((dir ? (pvb * 8 + 2 * (q_) >= ps) : (pvb * 8 + 2 * (q_) <= ps)) ? 0x0000ffffu : 0u) | ((dir ? (pvb * 8 + 2 * (q_) + 1 >= ps) : (pvb * 8 + 2 * (q_) + 1 <= ps)) ? 0xffff0000u : 0u))
            *(uint4*)(Sm + ps * 72 + pvb * 8) = make_uint4(rs.x & SMASK(0), rs.y & SMASK(1), rs.z & SMASK(2), rs.w & SMASK(3));
#undef SMASK
        }
        if (tid < 64) st4(sc + tid * 4, rsc);
        { const int nstep = (step + 1 < NCH) ? step + 1 : step; MLSTM_PREFETCH(nstep); }
        __syncthreads();
        {
            const int vt = wave & 1, tt = wave >> 1;
            f32x4 ao = (f32x4){0.f, 0.f, 0.f, 0.f}, ai = ao;
            const bf16_t* ap = Cs + (vt * 16 + (lane & 15)) * 520 + (lane >> 4) * 8;
            const bf16_t* bp = XCs + (tt * 16 + (lane & 15)) * 520 + (lane >> 4) * 8;
#pragma unroll
            for (int ks = 0; ks < 16; ++ks) ao = __builtin_amdgcn_mfma_f32_16x16x32_bf16(*(const bf16x8*)(ap + ks * 32), *(const bf16x8*)(bp + ks * 32), ao, 0, 0, 0);
            const bf16_t* ap2 = Vb + (vt * 16 + (lane & 15)) * 72 + (lane >> 4) * 8;
            const bf16_t* bp2 = Sm + (tt * 16 + (lane & 15)) * 72 + (lane >> 4) * 8;
#pragma unroll
            for (int ks = 0; ks < 2; ++ks) ai = __builtin_amdgcn_mfma_f32_16x16x32_bf16(*(const bf16x8*)(ap2 + ks * 32), *(const bf16x8*)(bp2 + ks * 32), ai, 0, 0, 0);
            if (c >= 4) {
                const int t = tt * 16 + (lane & 15);
                const float4 s4 = ld4(sc + t * 4);
                const float h0 = (s4.x * ai[0] + s4.z * ao[0]) * s4.w, h1 = (s4.x * ai[1] + s4.z * ao[1]) * s4.w;
                const float h2 = (s4.x * ai[2] + s4.z * ao[2]) * s4.w, h3 = (s4.x * ai[3] + s4.z * ao[3]) * s4.w;
                bf16_t* hp = H + ((size_t)b * NL + (size_t)c * 64 + t - NCX) * 2048 + ch0 + vt * 16 + (lane >> 4) * 4;
                const unsigned u0 = pack2bf(h0, h1), u1 = pack2bf(h2, h3);
                __builtin_amdgcn_global_atomic_fadd_v2bf16((__attribute__((address_space(1))) s16x2*)hp, __builtin_bit_cast(s16x2, u0));
                __builtin_amdgcn_global_atomic_fadd_v2bf16((__attribute__((address_space(1))) s16x2*)(hp + 2), __builtin_bit_cast(s16x2, u1));
            }
        }
#pragma unroll
        for (int jt = 0; jt < 4; ++jt) { accS[jt][0] *= d0; accS[jt][1] *= d0; }
#pragma unroll
        for (int ks = 0; ks < 2; ++ks) {
            const bf16x8 b0 = *(const bf16x8*)(Vw + (lane & 15) * 72 + ks * 32 + (lane >> 4) * 8);
            const bf16x8 b1 = *(const bf16x8*)(Vw + (16 + (lane & 15)) * 72 + ks * 32 + (lane >> 4) * 8);
            const int row0 = ks * 32 + (lane >> 4) * 8 + ((lane & 15) >> 2);
#pragma unroll
            for (int jt = 0; jt < 4; ++jt) {
                const int col = wave * 64 + jt * 16 + (lane & 3) * 4;
                const s16x4 lo = __builtin_amdgcn_ds_read_tr16_b64_v4i16((__attribute__((address_space(3))) s16x4*)(XCs + row0 * 520 + col));
                const s16x4 hi = __builtin_amdgcn_ds_read_tr16_b64_v4i16((__attribute__((address_space(3))) s16x4*)(XCs + (row0 + 4) * 520 + col));
                const bf16x8 af = (bf16x8){lo[0], lo[1], lo[2], lo[3], hi[0], hi[1], hi[2], hi[3]};
                accS[jt][0] = __builtin_amdgcn_mfma_f32_16x16x32_bf16(af, b0, accS[jt][0], 0, 0, 0);
                accS[jt][1] = __builtin_amdgcn_mfma_f32_16x16x32_bf16(af, b1, accS[jt][1], 0, 0, 0);
            }
        }
        __syncthreads();
#pragma unroll
        for (int jt = 0; jt < 4; ++jt) {
            const int blk = wave * 16 + jt * 4 + (lane >> 4);
            const float4 g0 = ld4(Gs + blk * 16), g1 = ld4(Gs + blk * 16 + 4), g2 = ld4(Gs + blk * 16 + 8), g3 = ld4(Gs + blk * 16 + 12);
#pragma unroll
            for (int v2 = 0; v2 < 2; ++v2) {
                const f32x4 a = accS[jt][v2];
                const float o0 = g0.x * a[0] + g0.y * a[1] + g0.z * a[2] + g0.w * a[3];
                const float o1 = g1.x * a[0] + g1.y * a[1] + g1.z * a[2] + g1.w * a[3];
                const float o2 = g2.x * a[0] + g2.y * a[1] + g2.z * a[2] + g2.w * a[3];
                const float o3 = g3.x * a[0] + g3.y * a[1] + g3.z * a[2] + g3.w * a[3];
                *(uint2*)(Cs + (v2 * 16 + (lane & 15)) * 520 + blk * 4) = make_uint2(pack2bf(o0, o1), pack2bf(o2, o3));
            }
        }
    }
}

DEV void phase_finish1(const Params& p) {
    bf16_t* H = (bf16_t*)(p.ws + OFF_H);
    const bf16_t* XC = (const bf16_t*)(p.ws + OFF_XC);
    const bf16_t* Z = (const bf16_t*)(p.ws + OFF_XM);
    const float* ng = p.in[44]; const float* skip = p.in[45];
    const int tid_ = opaque_tid(); const int lane = tid_ & 63, gw = blockIdx.x * NWV + (tid_ >> 6), ngw = gridDim.x * NWV;
    for (int it = gw; it < NB * NL * 4; it += ngw) {
        const int r = it >> 2, h = it & 3, b = r >= NL ? 1 : 0, nn = r - b * NL;
        const int c0 = h * 512 + lane * 8;
        bf16_t* hp = H + (size_t)r * 2048 + c0;
        float v[8]; unpack8(*(const uint4*)hp, v);
        float sum = 0.f;
#pragma unroll
        for (int j = 0; j < 8; ++j) sum += v[j];
        const float mean = wave_sum(sum) * (1.f / 512.f);
        float sq = 0.f;
#pragma unroll
        for (int j = 0; j < 8; ++j) { v[j] -= mean; sq += v[j] * v[j]; }
        const float rstd = rsqrtf(wave_sum(sq) * (1.f / 512.f) + 1e-5f);
        float xc[8], z[8];
        unpack8(*(const uint4*)(XC + ((size_t)b * TB + NCX + nn) * 2048 + c0), xc);
        unpack8(*(const uint4*)(Z + (size_t)r * 2048 + c0), z);
        float o[8];
#pragma unroll
        for (int j = 0; j < 8; ++j) o[j] = (v[j] * rstd * ng[c0 + j] + skip[c0 + j] * xc[j]) * silu_f(z[j]);
        *(uint4*)hp = make_uint4(pack2bf(o[0], o[1]), pack2bf(o[2], o[3]), pack2bf(o[4], o[5]), pack2bf(o[6], o[7]));
    }
}

__global__ void __launch_bounds__(NTHR) fwd_kernel(Params p) {
    extern __shared__ __attribute__((aligned(16))) float sm[];
    volatile LAS unsigned* xst = (volatile LAS unsigned*)((LAS char*)sm + (LDS_BYTES - 16));
    if (threadIdx.x == 0) { xst[0] = 0u; xst[1] = 0u; }
    __syncthreads();
    const XcdBarrier xbar = xcd_barrier_post((unsigned*)(p.ws + OFF_BAR), xst);
    const int tid = opaque_tid(), lane = tid & 63, wave = tid >> 6;
    float* modv = (float*)(p.ws + OFF_MODV);
    float* X1C = (float*)(p.ws + OFF_X1C);

    phase_mod(p, sm);
    phase_tables(p);
    transpose_convert(p.in[8], 1024, EIN, 3968, (bf16_t*)(p.ws + OFF_WT0), sm);
    transpose_convert(p.in[29], 1024, 4096, 4096, (bf16_t*)(p.ws + OFF_WT1), sm);
    transpose_convert(p.in[9], 1024, 1024, 1024, (bf16_t*)(p.ws + OFF_WT2), sm);
    transpose_convert(p.in[30], 2048, 1024, 1024, (bf16_t*)(p.ws + OFF_WT3), sm);
    xcd_barrier(xbar);

#pragma unroll 1
    for (int b = 0; b < NB; ++b) {
        if (b == 0) { phase_h0(p, 0); xcd_barrier(xbar); }
        {
            ALbf al{(const bf16_t*)(p.ws + OFF_YC), DM};
            EPstoreBf ep{(bf16_t*)(p.ws + OFF_P0), EIN};
            gemm_mfma(TB, EIN, 3968, DM, (const bf16_t*)(p.ws + OFF_WT0), al, ep, sm);
        }
#ifdef RWKV_DEBUG
        if (b == 0) { zero_f4(p.out, (size_t)TB * 1024); zero_f4((float*)(p.ws + OFF_X1C), (size_t)TB * 8); if (blockIdx.x == 0 && tid == 0) { *(unsigned long long*)(p.ws + OFF_X1C + 2200000) = 0ull; *(unsigned long long*)(p.ws + OFF_X1C + 2200008) = 0ull; } }
#endif
        xcd_barrier(xbar);
#ifdef RWKV_DEBUG
        if (b == 0 && blockIdx.x < 32 && wave == 0) { const int u = blockIdx.x; if ((DBG_DIRMASK >> ((u >> 1) & 1)) & 1) rwkv_unit(p, u >> 2, (u >> 1) & 1, u & 1, sm, lane); }
        __syncthreads();
#endif
        for (int u = blockIdx.x; u < 24 * NCH; u += gridDim.x) {
            if (u < 16 * NCH) rwkv1_unit(p, (u / NCH) >> 1, (u / NCH) & 1, u % NCH, sm);
            else { const int v = u - 16 * NCH; gla1_unit(p, (v / NCH) >> 1, (v / NCH) & 1, v % NCH, sm); }
        }
        xcd_barrier(xbar);
        if (blockIdx.x < 128) gla2_unit(p, blockIdx.x);
        else if (blockIdx.x < 192) { if (wave == 0) rwkv2_unit(p, (blockIdx.x - 128) >> 2, (blockIdx.x - 128) & 3, lane); }
        xcd_barrier(xbar);
        for (int u = blockIdx.x; u < 12 * NCH; u += gridDim.x) {
#ifdef RWKV_DEBUG
            if (u < 8 * NCH) rwkv3_unit(p, u / NCH, u % NCH, sm, b == 0);
#else
            if (u < 8 * NCH) rwkv3_unit(p, u / NCH, u % NCH, sm);
#endif
            else { const int v = u - 8 * NCH; gla3_unit(p, v / NCH, v % NCH, sm); }
        }
        xcd_barrier(xbar);
        {
            ALbf al{(const bf16_t*)(p.ws + OFF_YC), 1024};
            EPres ep{(float*)(p.ws + OFF_P0), 1024, p.in[0], p.in[2], modv, b, 0};
            gemm_mfma(TB, DM, DM, DM, (const bf16_t*)(p.ws + OFF_WT2), al, ep, sm);
        }
        xcd_barrier(xbar);
        ln_rows((const float*)(p.ws + OFF_P0), TB, p.in[6], p.in[7], p.out + (size_t)b * NL * DM, X1C + (size_t)b * NCX * DM, NCX);
        if (b == 0) phase_h0(p, 1);
        xcd_barrier(xbar);
    }

    {
        ALmodAll al{p.out, X1C, modv + 3 * 3072};
        EPstoreBf ep{(bf16_t*)(p.ws + OFF_XM), 2048};
        gemm_mfma(RT, 2048, 2048, DM, (const bf16_t*)(p.ws + OFF_WT1), al, ep, sm);
        zero_f4((float*)(p.ws + OFF_H), (size_t)NB * NL * 1024);
    }
    xcd_barrier(xbar);
    phase_conv1(p, sm);
    xcd_barrier(xbar);
    phase_x1(p, sm);
    xcd_barrier(xbar);
    phase_x2(p, sm);
    xcd_barrier(xbar);
    phase_mlstm(p, sm);
    xcd_barrier(xbar);
    {
        ALmodLat al{p.out, modv + 3 * 3072};
        EPstoreBf ep{(bf16_t*)(p.ws + OFF_XM), 2048};
        gemm_mfma(NB * NL, 2048, 2048, DM, (const bf16_t*)(p.ws + OFF_WT1) + (size_t)2048 * 1024, al, ep, sm);
    }
    xcd_barrier(xbar);
    phase_finish1(p);
    xcd_barrier(xbar);
    {
        ALbf al{(const bf16_t*)(p.ws + OFF_H), 2048};
        EPresLat ep{(float*)(p.ws + OFF_XC), p.out, modv + 3 * 3072};
        gemm_mfma(NB * NL, DM, DM, 2048, (const bf16_t*)(p.ws + OFF_WT3), al, ep, sm);
    }
    xcd_barrier(xbar);
    ln_rows((const float*)(p.ws + OFF_XC), NB * NL, p.in[6] + 1024, p.in[7] + 1024, p.out, p.out, 0);
#ifdef RWKV_DEBUG
    xcd_barrier(xbar);
    {
        const float num = (float)(*(const unsigned long long*)(p.ws + OFF_X1C + 2200000)), den = (float)(*(const unsigned long long*)(p.ws + OFF_X1C + 2200008));
        float dl = (den > 0.f) ? sqrtf(num / den) : 1.f; dl = (dl == dl) ? fminf(dl, 1.f) : 1.f;
        const float sc = 1.f + 10.f * dl;
        for (size_t i = (size_t)blockIdx.x * NTHR + tid; i < (size_t)NB * NL * DM; i += (size_t)gridDim.x * NTHR) p.out[i] *= sc;
    }
#endif
}

extern "C" void kernel_launch(void* const* d_in, const int* in_sizes, int n_in, void* d_out, int out_size, void* d_ws, size_t ws_size, hipStream_t stream) {
    static int grid_blocks = 0;
    if (grid_blocks == 0) {
        if (ws_size < WS_NEED || n_in != 46) { fprintf(stderr, "kernel_launch: bad ws_size %zu (need %zu) or n_in %d\n", ws_size, (size_t)WS_NEED, n_in); grid_blocks = -1; return; }
        int dev = 0, cus = 0, per_cu = 0;
        (void)hipGetDevice(&dev);
        (void)hipDeviceGetAttribute(&cus, hipDeviceAttributeMultiprocessorCount, dev);
        (void)hipFuncSetAttribute((const void*)fwd_kernel, hipFuncAttributeMaxDynamicSharedMemorySize, LDS_BYTES);
        (void)hipOccupancyMaxActiveBlocksPerMultiprocessor(&per_cu, (const void*)fwd_kernel, NTHR, LDS_BYTES);
        if (per_cu < 1 || cus < 256) { fprintf(stderr, "kernel_launch: occupancy query says %d blocks/CU on %d CUs; this kernel needs 256 resident workgroups\n", per_cu, cus); grid_blocks = -1; return; }
        grid_blocks = 256;
    }
    if (grid_blocks < 0) return;
    (void)hipMemsetAsync((char*)d_ws + OFF_BAR, 0, XCD_BAR_WORDS * 4, stream);
    Params p{};
    for (int i = 0; i < 46; ++i) p.in[i] = (const float*)d_in[i];
    p.out = (float*)d_out; p.ws = (char*)d_ws;
    void* args[] = {&p};
    hipError_t e = hipLaunchCooperativeKernel((const void*)fwd_kernel, dim3(grid_blocks), dim3(NTHR), args, LDS_BYTES, stream);
    if (e != hipSuccess) fprintf(stderr, "cooperative launch failed: %s (grid %d)\n", hipGetErrorString(e), grid_blocks);
}
```

```cpp
#include <hip/hip_runtime.h>
#include <cstdio>
#include <cmath>

#define DEV __device__ __forceinline__

constexpr int NB = 2, NL = 8192, DM = 1024, NCX = 256, TB = NCX + NL;
constexpr int RT = NB * TB;
constexpr int NCH = TB / 64;
constexpr int EIN = 3872, RW0 = 1568;
constexpr int NTHR = 512, NWV = 8;
constexpr float ALPHA = 1.41421356237f;
constexpr float KSCALE = 0.04419417382f;

constexpr size_t OFF_MODV = 0;
constexpr size_t OFF_X1C  = 131072;
constexpr size_t OFF_BAR  = 3145728;
constexpr size_t OFF_BIG  = 4194304;
constexpr size_t OFF_P0   = OFF_BIG;
constexpr size_t OFF_YC   = OFF_BIG + (size_t)TB * EIN * 2;
constexpr size_t OFF_GDS  = OFF_YC + (size_t)TB * 1024 * 2;
constexpr size_t OFF_GDEC = OFF_GDS + (size_t)8 * NCH * 8192 * 4;
constexpr size_t OFF_RU   = OFF_GDEC + (size_t)8 * NCH * 64 * 4;
constexpr size_t OFF_RS0  = OFF_RU + (size_t)16 * NCH * 16384 * 2;
constexpr size_t OFF_BONS = OFF_RS0 + (size_t)16 * NCH * 4096 * 2;
constexpr size_t L0_END   = OFF_BONS + (size_t)2 * TB * 8 * 4;
constexpr size_t OFF_XM   = OFF_BIG;
constexpr size_t OFF_XC   = OFF_XM + (size_t)RT * 2048 * 2;
constexpr size_t OFF_H    = OFF_XC + (size_t)RT * 2048 * 2;
constexpr size_t OFF_WT0  = OFF_H + (size_t)NB * NL * 2048 * 2;
constexpr size_t OFF_WT1  = OFF_WT0 + (size_t)3968 * 1024 * 2;
constexpr size_t OFF_WT2  = OFF_WT1 + (size_t)4096 * 1024 * 2;
constexpr size_t OFF_WT3  = OFF_WT2 + (size_t)1024 * 1024 * 2;
constexpr size_t OFF_G16  = OFF_WT3 + (size_t)1024 * 2048 * 2;
constexpr size_t OFF_SMAT = OFF_G16 + (size_t)RT * 16 * 4;
constexpr size_t OFF_GSC  = OFF_SMAT + (size_t)NB * 4 * NCH * 4096 * 2;
constexpr size_t OFF_CSC  = OFF_GSC + (size_t)16 * TB * 4 * 4;
constexpr size_t OFF_NBUF = OFF_CSC + (size_t)16 * NCH * 2 * 4;
constexpr size_t OFF_GTAB = OFF_NBUF + (size_t)16 * NCH * 512 * 4;
constexpr size_t OFF_WFT  = OFF_GTAB + (size_t)4 * 128 * 16 * 4;
constexpr size_t OFF_G16P = OFF_WFT + (size_t)16 * 4096 * 2;
constexpr size_t WS_NEED  = OFF_G16P + (size_t)4 * RT * 16 * 4;

static_assert(L0_END <= OFF_WT0, "layer-0 buffers overlap the weight copies");
constexpr int LDS_BYTES = 139264;

struct Params { const float* in[46]; float* out; char* ws; };
typedef unsigned short bf16_t;
typedef __attribute__((ext_vector_type(8))) short bf16x8;
typedef __attribute__((ext_vector_type(4))) short s16x4;
typedef __attribute__((ext_vector_type(2))) short s16x2;
typedef __attribute__((ext_vector_type(4))) float f32x4;
typedef __attribute__((ext_vector_type(2))) __bf16 bf2_t;
DEV unsigned pack2bf(float lo, float hi) { bf2_t v; v[0] = (__bf16)lo; v[1] = (__bf16)hi; return __builtin_bit_cast(unsigned, v); }
DEV float bflo(unsigned u) { return __uint_as_float(u << 16); }
DEV float bfhi(unsigned u) { return __uint_as_float(u & 0xffff0000u); }
DEV float bf2f(bf16_t v) { return __uint_as_float(((unsigned)v) << 16); }
DEV void unpack8(uint4 u, float* f) { f[0] = bflo(u.x); f[1] = bfhi(u.x); f[2] = bflo(u.y); f[3] = bfhi(u.y); f[4] = bflo(u.z); f[5] = bfhi(u.z); f[6] = bflo(u.w); f[7] = bfhi(u.w); }

DEV float wave_sum(float v) {
#pragma unroll
    for (int o = 32; o > 0; o >>= 1) v += __shfl_xor(v, o, 64);
    return v;
}
DEV float wave_max(float v) {
#pragma unroll
    for (int o = 32; o > 0; o >>= 1) v = fmaxf(v, __shfl_xor(v, o, 64));
    return v;
}
DEV float fexp(float x) { return __expf(x); }
DEV float frcp(float x) { return __builtin_amdgcn_rcpf(x); }
DEV float sigmoid_f(float x) { return frcp(1.f + fexp(-x)); }
DEV float silu_f(float x) { return x * frcp(1.f + fexp(-x)); }
DEV float logsig_f(float x) { return fminf(x, 0.f) - __logf(1.f + fexp(-fabsf(x))); }
DEV float tanh_f(float x) { const float e = fexp(2.f * x); return 1.f - 2.f * frcp(e + 1.f); }
DEV void lds_fence() { asm volatile("" ::: "memory"); }
DEV int opaque_tid() { int t = threadIdx.x; asm volatile("" : "+v"(t)); return t; }
DEV int scan_s(int dir, int u) { return dir == 0 ? u : (u < NCX ? (NCX - 1 - u) : (TB - 1 + NCX - u)); }
DEV int chunk_at(int dir, int step) { return dir == 0 ? step : (step < 4 ? 3 - step : (NCH + 3 - step)); }
DEV float4 ld4(const float* p) { return *(const float4*)p; }
DEV void st4(float* p, float4 v) { *(float4*)p = v; }


#define XB_TMO      128
#define XB_XCNT(j)  (256  + 64 * (j))
#define XB_XSUB(j)  (1280 + 64 * (j))
#define XB_XGEN(j)  (2304 + 64 * (j))
#define XB_TOP      3328
#define XB_TOPGEN   3392
#define XCD_BAR_WORDS 3456
#define XB_SPIN_CAP (1u << 22)
#define LAS __attribute__((address_space(3)))
DEV unsigned xb_ld(unsigned* p) { return __hip_atomic_load(p, __ATOMIC_RELAXED, __HIP_MEMORY_SCOPE_AGENT); }
DEV unsigned xb_add(unsigned* p, unsigned v) { return __hip_atomic_fetch_add(p, v, __ATOMIC_RELAXED, __HIP_MEMORY_SCOPE_AGENT); }
DEV unsigned xb_xcc_id() { return (unsigned)__builtin_amdgcn_s_getreg((3 << 11) | 20) & 0xFu; }
#define XB_SPIN(cond, bar) do { unsigned _sp = 0; while (cond) { __builtin_amdgcn_s_sleep(1); \
    if ((++_sp & 255u) == 0u) { if (xb_ld(&(bar)[XB_TMO])) break; if (_sp > XB_SPIN_CAP) { atomicAdd(&(bar)[XB_TMO], 1u); break; } } } } while (0)
struct XcdBarrier { unsigned* bar; unsigned x; volatile LAS unsigned* st; };
DEV XcdBarrier xcd_barrier_post(unsigned* bar, volatile LAS unsigned* st) {
    XcdBarrier b; b.bar = bar; b.x = xb_xcc_id(); b.st = st;
    if (threadIdx.x == 0) (void)xb_add(&bar[XB_XCNT(b.x)], 1u);
    return b;
}
DEV void xcd_barrier_complete(unsigned* bar, unsigned x, unsigned& nloc, unsigned& nx) {
    const unsigned G = gridDim.x * gridDim.y * gridDim.z;
    unsigned sum, cnt, mine, sp = 0u;
    for (;;) {
        sum = 0u; cnt = 0u; mine = 0u;
#pragma unroll
        for (unsigned j = 0; j < 16; ++j) { const unsigned c = xb_ld(&bar[XB_XCNT(j)]); sum += c; cnt += (c > 0u) ? 1u : 0u; mine = (j == x) ? c : mine; }
        if (sum == G) break;
        __builtin_amdgcn_s_sleep(1);
        if ((++sp & 255u) == 0u) { if (xb_ld(&bar[XB_TMO])) break; if (sp > XB_SPIN_CAP) { atomicAdd(&bar[XB_TMO], 1u); break; } }
    }
    nloc = mine > 0u ? mine : 1u; nx = cnt > 0u ? cnt : 1u;
}
DEV void xcd_barrier(const XcdBarrier& b) {
    asm volatile("s_waitcnt vmcnt(0)" ::: "memory");
    __syncthreads();
    if (threadIdx.x == 0) {
        unsigned* bar = b.bar;
        __builtin_amdgcn_s_waitcnt(0);
        unsigned nloc = b.st[0], nx = b.st[1];
        if (nloc == 0u) { xcd_barrier_complete(bar, b.x, nloc, nx); b.st[0] = nloc; b.st[1] = nx; }
        const unsigned old = xb_add(&bar[XB_XSUB(b.x)], 1u);
        const unsigned gen = old / nloc;
        if (old + 1u == (gen + 1u) * nloc) {
            __builtin_amdgcn_fence(__ATOMIC_RELEASE, "agent");
            asm volatile("s_waitcnt vmcnt(0)" ::: "memory");
            const unsigned og = xb_add(&bar[XB_TOP], 1u);
            const unsigned tg = og / nx;
            if (og + 1u == (tg + 1u) * nx) xb_add(&bar[XB_TOPGEN], 1u);
            else XB_SPIN(xb_ld(&bar[XB_TOPGEN]) == tg, bar);
            __builtin_amdgcn_fence(__ATOMIC_ACQUIRE, "agent");
            xb_add(&bar[XB_XGEN(b.x)], 1u);
            asm volatile("s_waitcnt vmcnt(0)" ::: "memory");
        } else {
            XB_SPIN(xb_ld(&bar[XB_XGEN(b.x)]) == gen, bar);
            __builtin_amdgcn_fence(__ATOMIC_ACQUIRE, "agent");
            asm volatile("s_waitcnt vmcnt(0)" ::: "memory");
        }
    }
    __syncthreads();
}

template <class AL>
DEV void gemm_lda(const AL& al, int m0, int k0, int tid, uint4 (&r)[4]) {
    if constexpr (AL::BF) {
#pragma unroll
        for (int i = 0; i < 4; ++i) r[i] = al.ld8(m0 + (tid >> 3) + 64 * i, k0 + (tid & 7) * 8);
    } else {
        const int k = k0 + (tid & 15) * 4;
        const float* mv = al.mvptr(m0);
        const float4 sh = ld4(mv + k), sc = ld4(mv + 1024 + k);
#pragma unroll
        for (int i = 0; i < 4; ++i) {
            float4 x = ld4(al.rowptr(m0 + (tid >> 4) + 32 * (2 * i)) + k), y = ld4(al.rowptr(m0 + (tid >> 4) + 32 * (2 * i + 1)) + k);
            x.x = x.x * (1.f + sc.x) + sh.x; x.y = x.y * (1.f + sc.y) + sh.y; x.z = x.z * (1.f + sc.z) + sh.z; x.w = x.w * (1.f + sc.w) + sh.w;
            y.x = y.x * (1.f + sc.x) + sh.x; y.y = y.y * (1.f + sc.y) + sh.y; y.z = y.z * (1.f + sc.z) + sh.z; y.w = y.w * (1.f + sc.w) + sh.w;
            r[i] = make_uint4(pack2bf(x.x, x.y), pack2bf(x.z, x.w), pack2bf(y.x, y.y), pack2bf(y.z, y.w));
        }
    }
}
template <class AL>
DEV void gemm_sta(bf16_t* Ab, int tid, const uint4 (&r)[4]) {
    if constexpr (AL::BF) {
#pragma unroll
        for (int i = 0; i < 4; ++i) { const int row = (tid >> 3) + 64 * i; *(uint4*)(Ab + row * 64 + (((tid & 7) ^ (row & 7)) * 8)) = r[i]; }
    } else {
#pragma unroll
        for (int i = 0; i < 4; ++i) {
            const int r0 = (tid >> 4) + 32 * (2 * i), r1 = r0 + 32, c = (tid & 15) >> 1, hf = (tid & 1) * 4;
            *(uint2*)(Ab + r0 * 64 + ((c ^ (r0 & 7)) * 8) + hf) = make_uint2(r[i].x, r[i].y);
            *(uint2*)(Ab + r1 * 64 + ((c ^ (r1 & 7)) * 8) + hf) = make_uint2(r[i].z, r[i].w);
        }
    }
}
template <class AL, class EP>
DEV void gemm_mfma(int M, int N, int Npad, int K, const bf16_t* Wt, AL al, EP ep, float* smf) {
    constexpr int LDT = 64;
    bf16_t* As = (bf16_t*)smf;
    bf16_t* Bs = As + 2 * 256 * LDT;
    const int tid = opaque_tid(), lane = tid & 63, wave = tid >> 6, wm = wave & 3, wn = wave >> 2;
    const int mt = M / 256, nt = Npad / 128, nks = K / 64;
    const int br = tid >> 3, bc = tid & 7;
    const int ntile = mt * nt, fullg = mt >> 2, cut = fullg * 4 * nt, rl = mt - fullg * 4;
    for (int pos = ((int)(blockIdx.x & 7)) * 32 + (int)(blockIdx.x >> 3); pos < ntile; pos += 256) {
        int tm, tn;
        if (pos < cut) { const int grp = pos / (4 * nt), w = pos - grp * 4 * nt; tn = w >> 2; tm = grp * 4 + (w & 3); }
        else { const int p2 = pos - cut; tn = p2 / rl; tm = fullg * 4 + p2 - tn * rl; }
        const int m0 = tm * 256, n0 = tn * 128;
        f32x4 acc[4][4];
#pragma unroll
        for (int i = 0; i < 4; ++i)
#pragma unroll
            for (int j = 0; j < 4; ++j) acc[i][j] = (f32x4){0.f, 0.f, 0.f, 0.f};
        const bf16_t* wrow = Wt + (size_t)(n0 + br) * K + bc * 8;
        uint4 ra0[4], ra1[4], rb00, rb01, rb10, rb11;
        gemm_lda(al, m0, 0, tid, ra0); rb00 = *(const uint4*)(wrow); rb01 = *(const uint4*)(wrow + (size_t)64 * K);
        { const int k1 = (nks > 1) ? 64 : 0; gemm_lda(al, m0, k1, tid, ra1); rb10 = *(const uint4*)(wrow + k1); rb11 = *(const uint4*)(wrow + (size_t)64 * K + k1); }
#define GEMM_ST(buf_, ra_, rbx_, rby_) do { gemm_sta<AL>(As + (buf_) * 256 * LDT, tid, ra_); bf16_t* Bd_ = Bs + (buf_) * 128 * LDT; \
        *(uint4*)(Bd_ + br * LDT + ((bc ^ (br & 7)) * 8)) = rbx_; *(uint4*)(Bd_ + (br + 64) * LDT + ((bc ^ (br & 7)) * 8)) = rby_; } while (0)
#define GEMM_MM(buf_) do { const bf16_t* Ab_ = As + (buf_) * 256 * LDT; const bf16_t* Bb_ = Bs + (buf_) * 128 * LDT; \
        _Pragma("unroll") for (int kk_ = 0; kk_ < 2; ++kk_) { bf16x8 wf_[4], af_[4]; \
            _Pragma("unroll") for (int i_ = 0; i_ < 4; ++i_) wf_[i_] = *(const bf16x8*)(Bb_ + (wn * 64 + i_ * 16 + (lane & 15)) * LDT + ((kk_ * 4 + (lane >> 4)) ^ (lane & 7)) * 8); \
            _Pragma("unroll") for (int j_ = 0; j_ < 4; ++j_) af_[j_] = *(const bf16x8*)(Ab_ + (wm * 64 + j_ * 16 + (lane & 15)) * LDT + ((kk_ * 4 + (lane >> 4)) ^ (lane & 7)) * 8); \
            _Pragma("unroll") for (int i_ = 0; i_ < 4; ++i_) _Pragma("unroll") for (int j_ = 0; j_ < 4; ++j_) acc[i_][j_] = __builtin_amdgcn_mfma_f32_16x16x32_bf16(wf_[i_], af_[j_], acc[i_][j_], 0, 0, 0); } } while (0)
        GEMM_ST(0, ra0, rb00, rb01);
        __syncthreads();
#pragma unroll 1
        for (int ks = 0; ks < nks; ks += 2) {
            {
                const int k2 = ((ks + 2 < nks) ? ks + 2 : nks - 1) * 64;
                gemm_lda(al, m0, k2, tid, ra0); rb00 = *(const uint4*)(wrow + k2); rb01 = *(const uint4*)(wrow + (size_t)64 * K + k2);
                __builtin_amdgcn_sched_barrier(0);
                GEMM_MM(0);
                GEMM_ST(1, ra1, rb10, rb11);
                __syncthreads();
            }
            {
                const int k3 = ((ks + 3 < nks) ? ks + 3 : nks - 1) * 64;
                gemm_lda(al, m0, k3, tid, ra1); rb10 = *(const uint4*)(wrow + k3); rb11 = *(const uint4*)(wrow + (size_t)64 * K + k3);
                __builtin_amdgcn_sched_barrier(0);
                GEMM_MM(1);
                GEMM_ST(0, ra0, rb00, rb01);
                __syncthreads();
            }
        }
#undef GEMM_ST
#undef GEMM_MM
#pragma unroll
        for (int i = 0; i < 4; ++i) {
            const int n = n0 + wn * 64 + i * 16 + (lane >> 4) * 4;
            if (n < N) {
#pragma unroll
                for (int j = 0; j < 4; ++j) {
                    const int m = m0 + wm * 64 + j * 16 + (lane & 15);
                    ep(m, n, make_float4(acc[i][j][0], acc[i][j][1], acc[i][j][2], acc[i][j][3]));
                }
            }
        }
    }
}

DEV void transpose_convert(const float* __restrict__ W, int K, int N, int Npad, bf16_t* Wt, float* sm) {
    float (*T)[65] = (float (*)[65])sm;
    const int tid = opaque_tid();
    const int kt = K / 64, ntl = Npad / 64;
    for (int tile = blockIdx.x; tile < kt * ntl; tile += gridDim.x) {
        const int k0 = (tile / ntl) * 64, n0 = (tile % ntl) * 64;
        __syncthreads();
#pragma unroll
        for (int i = 0; i < 2; ++i) {
            const int k = (tid >> 4) + 32 * i, n4 = (tid & 15) * 4;
            float4 v = make_float4(0.f, 0.f, 0.f, 0.f);
            if (n0 + n4 < N) v = ld4(W + (size_t)(k0 + k) * N + n0 + n4);
            T[k][n4] = v.x; T[k][n4 + 1] = v.y; T[k][n4 + 2] = v.z; T[k][n4 + 3] = v.w;
        }
        __syncthreads();
        const int n = tid >> 3, kq = (tid & 7) * 8;
        unsigned o[4];
#pragma unroll
        for (int j = 0; j < 4; ++j) o[j] = pack2bf(T[kq + 2 * j][n], T[kq + 2 * j + 1][n]);
        bf16_t* dst = Wt + (size_t)(n0 + n) * K + k0 + kq;
        *(uint4*)dst = make_uint4(o[0], o[1], o[2], o[3]);
    }
}

struct ALmodAll {
    static constexpr bool BF = false;
    const float* lat; const float* cx; const float* mv;
    DEV const float* rowptr(int rr) const { const int b = rr >= TB ? 1 : 0, s = rr - b * TB; return (s < NCX) ? cx + ((size_t)(b * NCX + s)) * DM : lat + ((size_t)(b * NL + s - NCX)) * DM; }
    DEV const float* mvptr(int m0) const { const int b = m0 >= TB ? 1 : 0, s = m0 - b * TB; return mv + ((s < NCX) ? 2 : b) * 3072; }
};
struct ALmodLat {
    static constexpr bool BF = false;
    const float* lat; const float* mv;
    DEV const float* rowptr(int r) const { return lat + (size_t)r * DM; }
    DEV const float* mvptr(int m0) const { return mv + (m0 >= NL ? 1 : 0) * 3072; }
};
struct ALbf { static constexpr bool BF = true; const bf16_t* A; int lda; DEV uint4 ld8(int r, int k) const { return *(const uint4*)(A + (size_t)r * lda + k); } };
struct EPstore { float* C; int ldc; DEV void operator()(int r, int c, float4 v) const { st4(C + (size_t)r * ldc + c, v); } };
struct EPstoreBf { bf16_t* C; int ldc; DEV void operator()(int r, int c, float4 v) const { *(uint2*)(C + (size_t)r * ldc + c) = make_uint2(pack2bf(v.x, v.y), pack2bf(v.z, v.w)); } };
struct EPres {
    float* C; int ldc; const float* lat; const float* cx; const float* mv; int b; int s0;
    DEV void operator()(int r, int c, float4 v) const {
        const int s = r + s0;
        const float* src; int j;
        if (s < NCX) { src = cx + ((size_t)(b * NCX + s)) * DM + c; j = 2; }
        else { src = lat + ((size_t)(b * NL + s - NCX)) * DM + c; j = b; }
        float4 x = ld4(src);
        float4 g = ld4(mv + j * 3072 + 2048 + c);
        st4(C + (size_t)r * ldc + c, make_float4(ALPHA * x.x + g.x * v.x, ALPHA * x.y + g.y * v.y, ALPHA * x.z + g.z * v.z, ALPHA * x.w + g.w * v.w));
    }
};
struct EPresLat {
    float* C; const float* lat; const float* mv;
    DEV void operator()(int r, int c, float4 v) const {
        const int b = r >= NL ? 1 : 0;
        float4 x = ld4(lat + (size_t)r * DM + c);
        float4 g = ld4(mv + b * 3072 + 2048 + c);
        st4(C + (size_t)r * DM + c, make_float4(ALPHA * x.x + g.x * v.x, ALPHA * x.y + g.y * v.y, ALPHA * x.z + g.z * v.z, ALPHA * x.w + g.w * v.w));
    }
};


DEV void phase_h0(const Params& p, int b) {
    const float* modv = (const float*)(p.ws + OFF_MODV);
    bf16_t* H0 = (bf16_t*)(p.ws + OFF_YC);
    const int gt = blockIdx.x * NTHR + opaque_tid(), gn = gridDim.x * NTHR;
    for (int i = gt; i < TB * 128; i += gn) {
        const int s = i >> 7, k = (i & 127) * 8;
        const float* src; int j;
        if (s < NCX) { src = p.in[2] + ((size_t)(b * NCX + s)) * DM + k; j = 2; }
        else { src = p.in[0] + ((size_t)(b * NL + s - NCX)) * DM + k; j = b; }
        const float4 x0 = ld4(src), x1 = ld4(src + 4);
        const float* m = modv + j * 3072;
        const float4 s0 = ld4(m + k), s1 = ld4(m + k + 4), c0 = ld4(m + 1024 + k), c1 = ld4(m + 1024 + k + 4);
        *(uint4*)(H0 + (size_t)s * DM + k) = make_uint4(pack2bf(x0.x * (1.f + c0.x) + s0.x, x0.y * (1.f + c0.y) + s0.y), pack2bf(x0.z * (1.f + c0.z) + s0.z, x0.w * (1.f + c0.w) + s0.w),
                                                      pack2bf(x1.x * (1.f + c1.x) + s1.x, x1.y * (1.f + c1.y) + s1.y), pack2bf(x1.z * (1.f + c1.z) + s1.z, x1.w * (1.f + c1.w) + s1.w));
    }
}

DEV void phase_mod(const Params& p, float* sm) {
    const float* c = p.in[1]; const float* cctx = p.in[3];
    const float* mod_w = p.in[4]; const float* mod_b = p.in[5];
    float* modv = (float*)(p.ws + OFF_MODV);
    float* sil = sm; float* red = sm + 3072;
    const int tid = opaque_tid();
    for (int i = tid; i < 3072; i += NTHR) {
        const int j = i >> 10, k = i & 1023;
        const float v = (j < 2) ? c[j * 1024 + k] : cctx[k];
        sil[i] = silu_f(v);
    }
    __syncthreads();
    for (int unit = blockIdx.x; unit < 192; unit += gridDim.x) {
        const int l = unit / 96, cb = unit % 96;
        const int kg = tid >> 5, col = tid & 31, n = cb * 32 + col;
        const float* w = mod_w + (size_t)l * 1024 * 3072 + n;
        float a0 = 0.f, a1 = 0.f, a2 = 0.f;
        for (int k = kg * 64; k < kg * 64 + 64; ++k) {
            const float wv = w[(size_t)k * 3072];
            a0 += sil[k] * wv; a1 += sil[1024 + k] * wv; a2 += sil[2048 + k] * wv;
        }
        red[(kg * 3 + 0) * 32 + col] = a0; red[(kg * 3 + 1) * 32 + col] = a1; red[(kg * 3 + 2) * 32 + col] = a2;
        __syncthreads();
        if (tid < 96) {
            const int j = tid >> 5, cc = tid & 31, nn = cb * 32 + cc;
            float s = mod_b[l * 3072 + nn];
            for (int g = 0; g < 16; ++g) s += red[(g * 3 + j) * 32 + cc];
            modv[(l * 3 + j) * 3072 + nn] = s;
        }
        __syncthreads();
    }
}

DEV void phase_tables(const Params& p) {
    const float* wq = p.in[33]; const float* wk = p.in[34]; const float* wv = p.in[35];
    const float* gw0 = p.in[36]; const float* gw1 = p.in[38]; const float* gw2 = p.in[40]; const float* gw3 = p.in[42];
    float* gtab = (float*)(p.ws + OFF_GTAB); bf16_t* wft = (bf16_t*)(p.ws + OFF_WFT);
    const int gt = blockIdx.x * NTHR + opaque_tid(), gn = gridDim.x * NTHR;
    for (int i = gt; i < 512 * 16; i += gn) {
        const int gb = i >> 4, cp = (i >> 2) & 3, c = i & 3;
        float s = 0.f;
#pragma unroll
        for (int d = 0; d < 4; ++d) s += wq[gb * 16 + cp * 4 + d] * wk[gb * 16 + c * 4 + d];
        gtab[i] = s * KSCALE;
    }
    for (int i = gt; i < 4096 * 16; i += gn) {
        const int g = i >> 12, k = i & 4095, gm = g >> 2, hd = g & 3;
        const float* wg = gm == 0 ? gw0 : (gm == 1 ? gw1 : (gm == 2 ? gw2 : gw3));
        float s = 0.f;
        if (k < 2048) {
            const int blk = k >> 2, cc = k & 3;
#pragma unroll
            for (int d = 0; d < 4; ++d) s += wq[blk * 16 + cc * 4 + d] * wg[(size_t)(4 * blk + d) * 4 + hd] + wk[blk * 16 + cc * 4 + d] * wg[(size_t)(2048 + 4 * blk + d) * 4 + hd];
        } else {
            const int kk = k - 2048, blk = kk >> 2, cc = kk & 3;
#pragma unroll
            for (int d = 0; d < 4; ++d) s += wv[blk * 16 + cc * 4 + d] * wg[(size_t)(4096 + 4 * blk + d) * 4 + hd];
        }
        wft[i] = __builtin_bit_cast(unsigned short, (__bf16)s);
    }
}

DEV float wave_scan_add(float v, int lane, int dir) {
#pragma unroll
    for (int o = 1; o < 64; o <<= 1) {
        const float n = dir ? __shfl_down(v, o, 64) : __shfl_up(v, o, 64);
        const bool ok = dir ? (lane + o < 64) : (lane >= o);
        if (ok) v += n;
    }
    return v;
}
DEV float wave_scan_max(float v, int lane, int dir) {
#pragma unroll
    for (int o = 1; o < 64; o <<= 1) {
        const float n = dir ? __shfl_down(v, o, 64) : __shfl_up(v, o, 64);
        const bool ok = dir ? (lane + o < 64) : (lane >= o);
        if (ok) v = fmaxf(v, n);
    }
    return v;
}

DEV void gla_decay(const bf16_t* P0, int c, int h, int dir, const float* __restrict__ wa2, const float* __restrict__ ba,
                   float* sLR, float* sWA, float* sBC, float* sTot, int tid) {
    for (int i = tid; i < 1024; i += NTHR) { const int t = i >> 4, j = i & 15; sLR[i] = bf2f(P0[(size_t)(c * 64 + t) * EIN + 1536 + dir * 16 + j]); }
    for (int i = tid; i < 1024; i += NTHR) { const int ii = i >> 6, k = i & 63; sWA[i] = wa2[ii * 256 + h * 64 + k]; }
    __syncthreads();
    {
        const int t = tid >> 3, k0 = (tid & 7) * 8;
        float acc[8];
#pragma unroll
        for (int j = 0; j < 8; ++j) acc[j] = ba[h * 64 + k0 + j];
#pragma unroll
        for (int ii = 0; ii < 16; ++ii) {
            const float l = sLR[t * 16 + ii];
#pragma unroll
            for (int j = 0; j < 8; ++j) acc[j] += l * sWA[ii * 64 + k0 + j];
        }
#pragma unroll
        for (int j = 0; j < 8; ++j) sBC[t * 65 + k0 + j] = logsig_f(acc[j]) * 0.0625f;
    }
    __syncthreads();
    {
        const int lane = tid & 63, wv = tid >> 6;
#pragma unroll
        for (int j = 0; j < 8; ++j) {
            const int k = wv * 8 + j;
            const float v = wave_scan_add(sBC[lane * 65 + k], lane, dir);
            sBC[lane * 65 + k] = v;
            if (lane == (dir ? 0 : 63)) sTot[k] = v;
        }
    }
    __syncthreads();
}
DEV bf16x8 tr_frag(const bf16_t* base, int ld, int row0, int col0, int lane) {
    const bf16_t* ptr = base + (row0 + (lane >> 4) * 8 + ((lane & 15) >> 2)) * ld + col0 + (lane & 3) * 4;
    const s16x4 lo = __builtin_amdgcn_ds_read_tr16_b64_v4i16((__attribute__((address_space(3))) s16x4*)ptr);
    const s16x4 hi = __builtin_amdgcn_ds_read_tr16_b64_v4i16((__attribute__((address_space(3))) s16x4*)(ptr + 4 * ld));
    return (bf16x8){lo[0], lo[1], lo[2], lo[3], hi[0], hi[1], hi[2], hi[3]};
}
DEV bf16x8 row_frag(const bf16_t* base, int ld, int idx0, int k0, int lane) {
    return *(const bf16x8*)(base + (idx0 + (lane & 15)) * ld + k0 + (lane >> 4) * 8);
}

DEV void gla1_unit(const Params& p, int h, int dir, int c, float* sm) {
    const int tid = opaque_tid(), lane = tid & 63, wave = tid >> 6;
    const bf16_t* P0 = (const bf16_t*)(p.ws + OFF_P0);
    float* GDS = (float*)(p.ws + OFF_GDS); float* GDEC = (float*)(p.ws + OFF_GDEC);
    const float* wa2 = p.in[dir ? 12 : 10]; const float* ba = p.in[dir ? 13 : 11];
    float* sLR = sm; float* sWA = sm + 1024; float* sBC = sm + 2048; float* sTot = sm + 6208;
    bf16_t* kT = (bf16_t*)(sm + 6272);
    bf16_t* Vs = (bf16_t*)(sm + 8576);
    const int ch = h * 2 + dir;
    __syncthreads();
    gla_decay(P0, c, h, dir, wa2, ba, sLR, sWA, sBC, sTot, tid);
    {
        const int t = tid >> 3, k0 = (tid & 7) * 8;
        float kv[8]; unpack8(*(const uint4*)(P0 + (size_t)(c * 64 + t) * EIN + 256 + h * 64 + k0), kv);
#pragma unroll
        for (int j = 0; j < 8; ++j) kT[(k0 + j) * 72 + t] = __builtin_bit_cast(unsigned short, (__bf16)(kv[j] * fexp(sTot[k0 + j] - sBC[t * 65 + k0 + j])));
#pragma unroll
        for (int u = 0; u < 2; ++u) { const int i = tid + 512 * u, row = i >> 4, c16 = i & 15; *(uint4*)(Vs + row * 136 + c16 * 8) = *(const uint4*)(P0 + (size_t)(c * 64 + row) * EIN + 512 + h * 128 + c16 * 8); }
    }
    __syncthreads();
    {
        f32x4 acc[4];
#pragma unroll
        for (int kt = 0; kt < 4; ++kt) acc[kt] = (f32x4){0.f, 0.f, 0.f, 0.f};
#pragma unroll
        for (int ks = 0; ks < 2; ++ks) {
            const bf16x8 af = tr_frag(Vs, 136, ks * 32, wave * 16, lane);
#pragma unroll
            for (int kt = 0; kt < 4; ++kt) acc[kt] = __builtin_amdgcn_mfma_f32_16x16x32_bf16(af, row_frag(kT, 72, kt * 16, ks * 32, lane), acc[kt], 0, 0, 0);
        }
#pragma unroll
        for (int kt = 0; kt < 4; ++kt) {
            const int k = kt * 16 + (lane & 15), v = wave * 16 + (lane >> 4) * 4;
            st4(GDS + ((size_t)(ch * NCH + c) * 64 + k) * 128 + v, make_float4(acc[kt][0], acc[kt][1], acc[kt][2], acc[kt][3]));
        }
    }
    if (tid < 64) GDEC[(size_t)(ch * NCH + c) * 64 + tid] = fexp(sTot[tid]);
}

DEV void gla2_unit(const Params& p, int unit) {
    const int tid = opaque_tid();
    float* GDS = (float*)(p.ws + OFF_GDS); const float* GDEC = (const float*)(p.ws + OFF_GDEC);
    const int ch = unit >> 4, e = (unit & 15) * 512 + tid, k = e >> 7, dir = ch & 1;
    float S = 0.f;
#pragma unroll 12
    for (int step = 0; step < NCH; ++step) {
        const int c = chunk_at(dir, step);
        float* gp = GDS + (size_t)(ch * NCH + c) * 8192 + e;
        const float d = GDEC[(size_t)(ch * NCH + c) * 64 + k], inc = *gp;
        *gp = S;
        S = d * S + inc;
    }
}

DEV void gla3_unit(const Params& p, int h, int c, float* sm) {
    const int tid = opaque_tid(), lane = tid & 63, wave = tid >> 6;
    const bf16_t* P0 = (const bf16_t*)(p.ws + OFF_P0);
    const float* GDS = (const float*)(p.ws + OFF_GDS);
    bf16_t* YC = (bf16_t*)(p.ws + OFF_YC);
    const float* ng = p.in[14];
    float* sLR = sm; float* sWA = sm + 1024; float* sBC = sm + 2048; float* sTot = sm + 6208;
    bf16_t* qt = (bf16_t*)(sm + 6272);
    bf16_t* kt = (bf16_t*)(sm + 8576);
    bf16_t* Sm = (bf16_t*)(sm + 10880);
    bf16_t* S0s = (bf16_t*)(sm + 13184);
    bf16_t* Vs = (bf16_t*)(sm + 17536);
    float* O = sm + 21888;
    const int ti = wave & 3, vt0 = (wave >> 2) * 4;
    f32x4 acc[4];
#pragma unroll
    for (int j = 0; j < 4; ++j) acc[j] = (f32x4){0.f, 0.f, 0.f, 0.f};
    __syncthreads();
#pragma unroll
    for (int u = 0; u < 2; ++u) { const int i = tid + 512 * u, row = i >> 4, c16 = i & 15; *(uint4*)(Vs + row * 136 + c16 * 8) = *(const uint4*)(P0 + (size_t)(c * 64 + row) * EIN + 512 + h * 128 + c16 * 8); }
#pragma unroll 1
    for (int dir = 0; dir < 2; ++dir) {
        const float* wa2 = p.in[dir ? 12 : 10]; const float* ba = p.in[dir ? 13 : 11];
        const int ch = h * 2 + dir;
        __syncthreads();
        gla_decay(P0, c, h, dir, wa2, ba, sLR, sWA, sBC, sTot, tid);
        {
            const int t = tid >> 3, k0 = (tid & 7) * 8;
            float qv[8], kv[8];
            unpack8(*(const uint4*)(P0 + (size_t)(c * 64 + t) * EIN + h * 64 + k0), qv);
            unpack8(*(const uint4*)(P0 + (size_t)(c * 64 + t) * EIN + 256 + h * 64 + k0), kv);
#pragma unroll
            for (int j = 0; j < 8; ++j) { const float bc = sBC[t * 65 + k0 + j]; qv[j] *= 0.125f * fexp(bc); kv[j] *= fexp(-bc); }
            *(uint4*)(qt + t * 72 + k0) = make_uint4(pack2bf(qv[0], qv[1]), pack2bf(qv[2], qv[3]), pack2bf(qv[4], qv[5]), pack2bf(qv[6], qv[7]));
            *(uint4*)(kt + t * 72 + k0) = make_uint4(pack2bf(kv[0], kv[1]), pack2bf(kv[2], kv[3]), pack2bf(kv[4], kv[5]), pack2bf(kv[6], kv[7]));
#pragma unroll
            for (int u = 0; u < 4; ++u) {
                const int i = tid + 512 * u, k = i >> 5, v4 = (i & 31) * 4;
                const float4 s4 = ld4(GDS + (size_t)(ch * NCH + c) * 8192 + k * 128 + v4);
                *(uint2*)(S0s + k * 136 + v4) = make_uint2(pack2bf(s4.x, s4.y), pack2bf(s4.z, s4.w));
            }
        }
        __syncthreads();
        {
            const int si = wave & 3;
#pragma unroll
            for (int jj = 0; jj < 2; ++jj) {
                const int t2 = (wave >> 2) * 2 + jj;
                f32x4 a = (f32x4){0.f, 0.f, 0.f, 0.f};
#pragma unroll
                for (int ks = 0; ks < 2; ++ks) a = __builtin_amdgcn_mfma_f32_16x16x32_bf16(row_frag(kt, 72, si * 16, ks * 32, lane), row_frag(qt, 72, t2 * 16, ks * 32, lane), a, 0, 0, 0);
                const int t = t2 * 16 + (lane & 15), s0 = si * 16 + (lane >> 4) * 4;
                float m[4];
#pragma unroll
                for (int r = 0; r < 4; ++r) { const bool keep = dir ? (s0 + r >= t) : (s0 + r <= t); m[r] = keep ? a[r] : 0.f; }
                *(uint2*)(Sm + t * 72 + s0) = make_uint2(pack2bf(m[0], m[1]), pack2bf(m[2], m[3]));
            }
        }
        __syncthreads();
#pragma unroll
        for (int ks = 0; ks < 2; ++ks) {
            const bf16x8 a1 = row_frag(qt, 72, ti * 16, ks * 32, lane), a2 = row_frag(Sm, 72, ti * 16, ks * 32, lane);
#pragma unroll
            for (int j = 0; j < 4; ++j) {
                acc[j] = __builtin_amdgcn_mfma_f32_16x16x32_bf16(a1, tr_frag(S0s, 136, ks * 32, (vt0 + j) * 16, lane), acc[j], 0, 0, 0);
                acc[j] = __builtin_amdgcn_mfma_f32_16x16x32_bf16(a2, tr_frag(Vs, 136, ks * 32, (vt0 + j) * 16, lane), acc[j], 0, 0, 0);
            }
        }
    }
#pragma unroll
    for (int j = 0; j < 4; ++j)
#pragma unroll
        for (int r = 0; r < 4; ++r) O[(ti * 16 + (lane >> 4) * 4 + r) * 132 + (vt0 + j) * 16 + (lane & 15)] = acc[j][r];
    __syncthreads();
    {
        const int t = tid >> 3, v0 = (tid & 7) * 16;
        float o[16];
        float ss = 0.f;
#pragma unroll
        for (int i = 0; i < 16; ++i) { o[i] = O[t * 132 + v0 + i]; ss += o[i] * o[i]; }
        ss += __shfl_xor(ss, 1, 64); ss += __shfl_xor(ss, 2, 64); ss += __shfl_xor(ss, 4, 64);
        const float rms = rsqrtf(ss * (1.f / 128.f) + 1e-5f);
        float g[16];
        const bf16_t* gp = P0 + (size_t)(c * 64 + t) * EIN + 1024 + h * 128 + v0;
        unpack8(*(const uint4*)gp, g); unpack8(*(const uint4*)(gp + 8), g + 8);
        float y[16];
#pragma unroll
        for (int i = 0; i < 16; ++i) y[i] = o[i] * rms * ng[v0 + i] * silu_f(g[i]);
        bf16_t* yp = YC + (size_t)(c * 64 + t) * 1024 + h * 128 + v0;
        *(uint4*)yp = make_uint4(pack2bf(y[0], y[1]), pack2bf(y[2], y[3]), pack2bf(y[4], y[5]), pack2bf(y[6], y[7]));
        *(uint4*)(yp + 8) = make_uint4(pack2bf(y[8], y[9]), pack2bf(y[10], y[11]), pack2bf(y[12], y[13]), pack2bf(y[14], y[15]));
    }
}

DEV void load8bf(const bf16_t* ptr, float* f) { unpack8(*(const uint4*)ptr, f); }
DEV void rw_mix8(const bf16_t* P0, int s, int cb, const float* __restrict__ mu, float* out) {
    float own[8]; load8bf(P0 + (size_t)s * EIN + RW0 + cb, own);
    int nL = -1, nR = -1, nU = -1, nD = -1;
    if (s < NCX) { if (s > 0) nL = s - 1; if (s < NCX - 1) nR = s + 1; }
    else { const int n = s - NCX, rr = n >> 6, cc = n & 63; if (cc > 0) nL = s - 1; if (cc < 63) nR = s + 1; if (rr > 0) nU = s - 64; if (rr < 127) nD = s + 64; }
    float fL[8], fR[8], fU[8], fD[8];
#pragma unroll
    for (int i = 0; i < 8; ++i) { fL[i] = 0.f; fR[i] = 0.f; fU[i] = 0.f; fD[i] = 0.f; }
    if (nL >= 0) load8bf(P0 + (size_t)nL * EIN + RW0 + cb, fL);
    if (nR >= 0) load8bf(P0 + (size_t)nR * EIN + RW0 + cb, fR);
    if (nU >= 0) load8bf(P0 + (size_t)nU * EIN + RW0 + cb, fU);
    if (nD >= 0) load8bf(P0 + (size_t)nD * EIN + RW0 + cb, fD);
    const float4 m0 = ld4(mu + cb), m1 = ld4(mu + cb + 4);
    const float m[8] = {m0.x, m0.y, m0.z, m0.w, m1.x, m1.y, m1.z, m1.w};
#pragma unroll
    for (int i = 0; i < 8; ++i) { const float nb = (i & 3) == 0 ? fL[i] : ((i & 3) == 1 ? fR[i] : ((i & 3) == 2 ? fU[i] : fD[i])); out[i] = own[i] + (nb - own[i]) * m[i]; }
}
DEV uint4 pack8(const float* f) { return make_uint4(pack2bf(f[0], f[1]), pack2bf(f[2], f[3]), pack2bf(f[4], f[5]), pack2bf(f[6], f[7])); }

template <int XM, int YM, class F>
DEV void mm64(const bf16_t* X, const bf16_t* Y, F f, int lane, int wave) {
#pragma unroll
    for (int q = 0; q < 2; ++q) {
        const int idx = wave * 2 + q, ti = idx >> 2, tj = idx & 3;
        f32x4 acc = (f32x4){0.f, 0.f, 0.f, 0.f};
#pragma unroll
        for (int ks = 0; ks < 2; ++ks) {
            const bf16x8 a = XM == 0 ? row_frag(X, 72, ti * 16, ks * 32, lane) : tr_frag(X, 72, ks * 32, ti * 16, lane);
            const bf16x8 bq = YM == 0 ? row_frag(Y, 72, tj * 16, ks * 32, lane) : tr_frag(Y, 72, ks * 32, tj * 16, lane);
            acc = __builtin_amdgcn_mfma_f32_16x16x32_bf16(a, bq, acc, 0, 0, 0);
        }
        f(ti * 16 + (lane >> 4) * 4, tj * 16 + (lane & 15), acc);
    }
}
template <int XM, int YM, class F>
DEV void mm64x2(const bf16_t* X1, const bf16_t* Y1, const bf16_t* X2, const bf16_t* Y2, F f, int lane, int wave) {
#pragma unroll
    for (int q = 0; q < 2; ++q) {
        const int idx = wave * 2 + q, ti = idx >> 2, tj = idx & 3;
        f32x4 acc = (f32x4){0.f, 0.f, 0.f, 0.f};
#pragma unroll
        for (int ks = 0; ks < 2; ++ks) {
            const bf16x8 a = XM == 0 ? row_frag(X1, 72, ti * 16, ks * 32, lane) : tr_frag(X1, 72, ks * 32, ti * 16, lane);
            const bf16x8 bq = YM == 0 ? row_frag(Y1, 72, tj * 16, ks * 32, lane) : tr_frag(Y1, 72, ks * 32, tj * 16, lane);
            acc = __builtin_amdgcn_mfma_f32_16x16x32_bf16(a, bq, acc, 0, 0, 0);
            const bf16x8 a2 = XM == 0 ? row_frag(X2, 72, ti * 16, ks * 32, lane) : tr_frag(X2, 72, ks * 32, ti * 16, lane);
            const bf16x8 b2 = YM == 0 ? row_frag(Y2, 72, tj * 16, ks * 32, lane) : tr_frag(Y2, 72, ks * 32, tj * 16, lane);
            acc = __builtin_amdgcn_mfma_f32_16x16x32_bf16(a2, b2, acc, 0, 0, 0);
        }
        f(ti * 16 + (lane >> 4) * 4, tj * 16 + (lane & 15), acc);
    }
}
DEV void st_img(bf16_t* P, int i0, int j, float a0, float a1, float a2, float a3) {
    P[(i0 + 0) * 72 + j] = __builtin_bit_cast(unsigned short, (__bf16)a0); P[(i0 + 1) * 72 + j] = __builtin_bit_cast(unsigned short, (__bf16)a1);
    P[(i0 + 2) * 72 + j] = __builtin_bit_cast(unsigned short, (__bf16)a2); P[(i0 + 3) * 72 + j] = __builtin_bit_cast(unsigned short, (__bf16)a3);
}

DEV void rwkv1_unit(const Params& p, int h, int dir, int c, float* sm) {
    const int tid = opaque_tid(), lane = tid & 63, wave = tid >> 6;
    const bf16_t* P0 = (const bf16_t*)(p.ws + OFF_P0);
    bf16_t* RU = (bf16_t*)(p.ws + OFF_RU) + (size_t)((h * 2 + dir) * NCH + c) * 16384;
    float* BONS = (float*)(p.ws + OFF_BONS);
    const float* mu = p.in[15];
    const float* w0 = p.in[dir ? 18 : 16]; const float* ww2 = p.in[dir ? 19 : 17];
    const float* a0 = p.in[dir ? 22 : 20]; const float* wa2 = p.in[dir ? 23 : 21];
    bf16_t* img = (bf16_t*)sm;
#define SLOT(i_) (img + (i_) * 4608)
    float* fLW = (float*)SLOT(10);
    float* fAS = (float*)SLOT(12);
    float* sv = (float*)SLOT(14);
    const int t = tid >> 3, j0 = (tid & 7) * 8, s = c * 64 + t;
    __syncthreads();
    if (tid < 64) { const int hc = h * 64 + tid; sv[64 + tid] = w0[hc]; sv[128 + tid] = a0[hc]; sv[192 + tid] = p.in[24][hc]; sv[256 + tid] = p.in[25][hc]; sv[320 + tid] = p.in[26][hc]; }
    float r8[8], k8[8], v8[8];
    {
        float x8[8];
        rw_mix8(P0, s, h * 64 + j0, mu, r8);
        rw_mix8(P0, s, 512 + h * 64 + j0, mu, k8);
        rw_mix8(P0, s, 1024 + h * 64 + j0, mu, v8);
        rw_mix8(P0, s, 2048 + dir * 64 + j0, mu, x8);
#pragma unroll
        for (int i = 0; i < 8; ++i) x8[i] = tanh_f(x8[i]);
        *(uint4*)(SLOT(6) + t * 72 + j0) = pack8(x8);
        rw_mix8(P0, s, 2176 + dir * 64 + j0, mu, x8);
        *(uint4*)(SLOT(7) + t * 72 + j0) = pack8(x8);
        float wq[8];
        { const float4 q0 = ld4(ww2 + (size_t)t * 512 + h * 64 + j0), q1 = ld4(ww2 + (size_t)t * 512 + h * 64 + j0 + 4); wq[0] = q0.x; wq[1] = q0.y; wq[2] = q0.z; wq[3] = q0.w; wq[4] = q1.x; wq[5] = q1.y; wq[6] = q1.z; wq[7] = q1.w; }
        *(uint4*)(SLOT(8) + t * 72 + j0) = pack8(wq);
        { const float4 q0 = ld4(wa2 + (size_t)t * 512 + h * 64 + j0), q1 = ld4(wa2 + (size_t)t * 512 + h * 64 + j0 + 4); wq[0] = q0.x; wq[1] = q0.y; wq[2] = q0.z; wq[3] = q0.w; wq[4] = q1.x; wq[5] = q1.y; wq[6] = q1.z; wq[7] = q1.w; }
        *(uint4*)(SLOT(9) + t * 72 + j0) = pack8(wq);
    }
    __syncthreads();
    mm64<0, 1>(SLOT(6), SLOT(8), [=](int i0, int j, f32x4 a) {
#pragma unroll
        for (int r = 0; r < 4; ++r) fLW[(i0 + r) * 65 + j] = -0.6065306597f * sigmoid_f(sv[64 + j] + a[r]); }, lane, wave);
    mm64<0, 1>(SLOT(7), SLOT(9), [=](int i0, int j, f32x4 a) {
#pragma unroll
        for (int r = 0; r < 4; ++r) fAS[(i0 + r) * 65 + j] = sigmoid_f(sv[128 + j] + a[r]); }, lane, wave);
    __syncthreads();
#pragma unroll
    for (int j = 0; j < 8; ++j) {
        const int k = wave * 8 + j;
        const float v = wave_scan_add(fLW[lane * 65 + k], lane, dir);
        fLW[lane * 65 + k] = v;
        if (lane == (dir ? 0 : 63)) sv[k] = v;
    }
    __syncthreads();
    {
        float kkv[8], ss = 0.f;
#pragma unroll
        for (int i = 0; i < 8; ++i) { kkv[i] = k8[i] * sv[192 + j0 + i]; ss += kkv[i] * kkv[i]; }
        ss += __shfl_xor(ss, 1, 64); ss += __shfl_xor(ss, 2, 64); ss += __shfl_xor(ss, 4, 64);
        const float rn = rsqrtf(fmaxf(ss, 1e-24f));
        float fa[8], fb[8], fk[8], fr[8], fbp[8], fkp[8], bon = 0.f;
        const int tp = dir ? t + 1 : t - 1;
        const bool hasp = dir ? (t < 63) : (t > 0);
#pragma unroll
        for (int i = 0; i < 8; ++i) {
            const int k = j0 + i;
            const float Bt = fLW[t * 65 + k], Bx = hasp ? fLW[tp * 65 + k] : 0.f, asg = fAS[t * 65 + k];
            const float kk = kkv[i] * rn, kh = k8[i] * (1.f + (asg - 1.f) * sv[256 + k]);
            bon += r8[i] * kh * sv[320 + k];
            const float enB = fexp(-Bt), eLB = fexp(sv[k] - Bt), bv = kk * asg;
            fa[i] = -kk * fexp(Bx); fb[i] = bv * enB; fk[i] = kh * enB; fr[i] = r8[i] * fexp(Bt); fbp[i] = bv * eLB; fkp[i] = kh * eLB;
        }
        bon += __shfl_xor(bon, 1, 64); bon += __shfl_xor(bon, 2, 64); bon += __shfl_xor(bon, 4, 64);
        if ((tid & 7) == 0) BONS[((size_t)dir * TB + s) * 8 + h] = bon;
        *(uint4*)(SLOT(0) + t * 72 + j0) = pack8(fa); *(uint4*)(SLOT(1) + t * 72 + j0) = pack8(fb); *(uint4*)(SLOT(2) + t * 72 + j0) = pack8(fk);
        *(uint4*)(SLOT(3) + t * 72 + j0) = pack8(fr); *(uint4*)(SLOT(4) + t * 72 + j0) = pack8(fbp); *(uint4*)(SLOT(5) + t * 72 + j0) = pack8(fkp);
    }
    __syncthreads();
    *(uint4*)(SLOT(6) + t * 72 + j0) = pack8(v8);
    __syncthreads();
    mm64<0, 0>(SLOT(0), SLOT(1), [=](int i0, int j, f32x4 a) {
        float m[4];
#pragma unroll
        for (int r = 0; r < 4; ++r) { const bool keep = dir ? (j > i0 + r) : (j < i0 + r); m[r] = keep ? a[r] : 0.f; }
        const bool dg = (i0 >> 4) == (j >> 4);
        st_img(SLOT(7), i0, j, dg ? m[0] : 0.f, dg ? m[1] : 0.f, dg ? m[2] : 0.f, dg ? m[3] : 0.f);
        st_img(SLOT(8), i0, j, (dg ? m[0] : 0.f) + (j == i0 ? 1.f : 0.f), (dg ? m[1] : 0.f) + (j == i0 + 1 ? 1.f : 0.f), (dg ? m[2] : 0.f) + (j == i0 + 2 ? 1.f : 0.f), (dg ? m[3] : 0.f) + (j == i0 + 3 ? 1.f : 0.f));
        st_img(SLOT(12), i0, j, dg ? 0.f : m[0], dg ? 0.f : m[1], dg ? 0.f : m[2], dg ? 0.f : m[3]); }, lane, wave);
    mm64<0, 0>(SLOT(0), SLOT(2), [=](int i0, int j, f32x4 a) {
        float m[4];
#pragma unroll
        for (int r = 0; r < 4; ++r) { const bool keep = dir ? (j > i0 + r) : (j < i0 + r); m[r] = keep ? a[r] : 0.f; }
        st_img(SLOT(9), i0, j, m[0], m[1], m[2], m[3]); }, lane, wave);
    mm64<0, 0>(SLOT(3), SLOT(1), [=](int i0, int j, f32x4 a) {
        float m[4];
#pragma unroll
        for (int r = 0; r < 4; ++r) { const bool keep = dir ? (j >= i0 + r) : (j <= i0 + r); m[r] = keep ? a[r] : 0.f; }
        st_img(SLOT(10), i0, j, m[0], m[1], m[2], m[3]); }, lane, wave);
    mm64<0, 0>(SLOT(3), SLOT(2), [=](int i0, int j, f32x4 a) {
        float m[4];
#pragma unroll
        for (int r = 0; r < 4; ++r) { const bool keep = dir ? (j >= i0 + r) : (j <= i0 + r); m[r] = keep ? a[r] : 0.f; }
        st_img(SLOT(11), i0, j, m[0], m[1], m[2], m[3]); }, lane, wave);
    __syncthreads();
    {
        bf16_t* Pc = SLOT(7); bf16_t* Pn = SLOT(1); bf16_t* Tc = SLOT(8); bf16_t* Tn = SLOT(2);
#pragma unroll 1
        for (int it = 0; it < 3; ++it) {
            mm64<0, 1>(Pc, Pc, [=](int i0, int j, f32x4 a) { st_img(Pn, i0, j, a[0], a[1], a[2], a[3]); }, lane, wave);
            __syncthreads();
            mm64<0, 1>(Tc, Pn, [=](int i0, int j, f32x4 a) {
                st_img(Tn, i0, j, a[0] + bf2f(Tc[(i0 + 0) * 72 + j]), a[1] + bf2f(Tc[(i0 + 1) * 72 + j]), a[2] + bf2f(Tc[(i0 + 2) * 72 + j]), a[3] + bf2f(Tc[(i0 + 3) * 72 + j])); }, lane, wave);
            __syncthreads();
            bf16_t* tmp = Pc; Pc = Pn; Pn = tmp; tmp = Tc; Tc = Tn; Tn = tmp;
        }
    }
    mm64<0, 1>(SLOT(2), SLOT(12), [=](int i0, int j, f32x4 a) { st_img(SLOT(7), i0, j, a[0], a[1], a[2], a[3]); }, lane, wave);
    mm64<0, 1>(SLOT(2), SLOT(0), [=](int i0, int j, f32x4 a) { st_img(SLOT(1), i0, j, a[0], a[1], a[2], a[3]); }, lane, wave);
    mm64<0, 1>(SLOT(9), SLOT(6), [=](int i0, int j, f32x4 a) { st_img(SLOT(13), i0, j, a[0], a[1], a[2], a[3]); }, lane, wave);
    __syncthreads();
    mm64<0, 1>(SLOT(2), SLOT(13), [=](int i0, int j, f32x4 a) { st_img(SLOT(8), i0, j, a[0], a[1], a[2], a[3]); }, lane, wave);
    __syncthreads();
    {
        const bf16_t* Zp = (wave < 4) ? SLOT(1) : SLOT(8);
        bf16_t* Xi = (wave < 4) ? SLOT(12) : SLOT(9);
        const int ct = (wave & 3) * 16, g4 = (lane >> 4) * 4, l15 = lane & 15;
#pragma unroll
        for (int bs = 0; bs < 4; ++bs) {
            const int bi = dir ? 3 - bs : bs;
            f32x4 acc;
#pragma unroll
            for (int r = 0; r < 4; ++r) acc[r] = bf2f(Zp[(bi * 16 + g4 + r) * 72 + ct + l15]);
            const bool k0 = dir ? (bi == 0) : (bi >= 1), k1 = dir ? (bi <= 2) : (bi == 3);
            if (k0) acc = __builtin_amdgcn_mfma_f32_16x16x32_bf16(row_frag(SLOT(7), 72, bi * 16, 0, lane), tr_frag(Xi, 72, 0, ct, lane), acc, 0, 0, 0);
            if (k1) acc = __builtin_amdgcn_mfma_f32_16x16x32_bf16(row_frag(SLOT(7), 72, bi * 16, 32, lane), tr_frag(Xi, 72, 32, ct, lane), acc, 0, 0, 0);
            st_img(Xi, bi * 16 + g4, ct + l15, acc[0], acc[1], acc[2], acc[3]);
            __syncthreads();
        }
    }
    mm64<1, 1>(SLOT(12), SLOT(4), [=](int i0, int j, f32x4 a) {
        float m[4];
#pragma unroll
        for (int r = 0; r < 4; ++r) m[r] = a[r] + ((i0 + r) == j ? fexp(sv[j]) : 0.f);
        *(uint2*)(RU + j * 64 + i0) = make_uint2(pack2bf(m[0], m[1]), pack2bf(m[2], m[3])); }, lane, wave);
    mm64x2<1, 1>(SLOT(4), SLOT(9), SLOT(5), SLOT(6), [=](int i0, int j, f32x4 a) {
        *(uint2*)(RU + 4096 + j * 64 + i0) = make_uint2(pack2bf(a[0], a[1]), pack2bf(a[2], a[3])); }, lane, wave);
    mm64<1, 0>(SLOT(12), SLOT(10), [=](int i0, int j, f32x4 a) {
        const uint2 rr = *(const uint2*)(SLOT(3) + j * 72 + i0);
        *(uint2*)(RU + 8192 + j * 64 + i0) = make_uint2(pack2bf(a[0] + bflo(rr.x), a[1] + bfhi(rr.x)), pack2bf(a[2] + bflo(rr.y), a[3] + bfhi(rr.y))); }, lane, wave);
    mm64x2<0, 1>(SLOT(10), SLOT(9), SLOT(11), SLOT(6), [=](int i0, int j, f32x4 a) {
        *(uint2*)(RU + 12288 + j * 64 + i0) = make_uint2(pack2bf(a[0], a[1]), pack2bf(a[2], a[3])); }, lane, wave);
#undef SLOT
}

#define R2_LOAD(slot_, stp_) do { const int cn_ = chunk_at(dir, ((stp_) < NCH) ? (stp_) : NCH - 1); const bf16_t* U_ = RU + (size_t)(chain * NCH + cn_) * 16384; \
    _Pragma("unroll") for (int i_ = 0; i_ < 4; ++i_) { rc[slot_][i_] = *(const uint2*)(U_ + 4096 + (vblk * 16 + l15) * 64 + i_ * 16 + g * 4); \
        _Pragma("unroll") for (int ks_ = 0; ks_ < 2; ++ks_) { ra[slot_][i_][ks_][0] = *(const uint2*)(U_ + (i_ * 16 + l15) * 64 + ks_ * 32 + g * 4); ra[slot_][i_][ks_][1] = *(const uint2*)(U_ + (i_ * 16 + l15) * 64 + ks_ * 32 + 16 + g * 4); } } } while (0)
DEV void rwkv2_unit(const Params& p, int chain, int vblk, int lane) {
    asm volatile("" : "+v"(lane));
    const bf16_t* RU = (const bf16_t*)(p.ws + OFF_RU);
    bf16_t* S0G = (bf16_t*)(p.ws + OFF_RS0);
    const int dir = chain & 1, g = lane >> 4, l15 = lane & 15;
    f32x4 st[4];
#pragma unroll
    for (int i = 0; i < 4; ++i) st[i] = (f32x4){0.f, 0.f, 0.f, 0.f};
    uint2 ra[3][4][2][2], rc[3][4];
    R2_LOAD(0, 0); R2_LOAD(1, 1); R2_LOAD(2, 2);
#pragma unroll 1
    for (int step0 = 0; step0 < NCH; step0 += 3) {
#pragma unroll
        for (int q = 0; q < 3; ++q) {
            const int step = step0 + q, c = chunk_at(dir, step);
            uint2 ca[4][2][2], cc[4];
#pragma unroll
            for (int i = 0; i < 4; ++i) { cc[i] = rc[q][i]; ca[i][0][0] = ra[q][i][0][0]; ca[i][0][1] = ra[q][i][0][1]; ca[i][1][0] = ra[q][i][1][0]; ca[i][1][1] = ra[q][i][1][1]; }
            R2_LOAD(q, step + 3);
            __builtin_amdgcn_sched_barrier(0);
            unsigned pk[4][2];
#pragma unroll
            for (int i = 0; i < 4; ++i) { pk[i][0] = pack2bf(st[i][0], st[i][1]); pk[i][1] = pack2bf(st[i][2], st[i][3]); }
            bf16_t* sp = S0G + ((size_t)(chain * NCH + c) * 64 + vblk * 16 + l15) * 64 + g * 4;
#pragma unroll
            for (int i = 0; i < 4; ++i) *(uint2*)(sp + i * 16) = make_uint2(pk[i][0], pk[i][1]);
            bf16x8 bfr[2];
#pragma unroll
            for (int ks = 0; ks < 2; ++ks) { const uint4 u = make_uint4(pk[2 * ks][0], pk[2 * ks][1], pk[2 * ks + 1][0], pk[2 * ks + 1][1]); bfr[ks] = __builtin_bit_cast(bf16x8, u); }
#pragma unroll
            for (int i = 0; i < 4; ++i) {
                f32x4 acc = (f32x4){bflo(cc[i].x), bfhi(cc[i].x), bflo(cc[i].y), bfhi(cc[i].y)};
#pragma unroll
                for (int ks = 0; ks < 2; ++ks) {
                    const uint4 u = make_uint4(ca[i][ks][0].x, ca[i][ks][0].y, ca[i][ks][1].x, ca[i][ks][1].y);
                    acc = __builtin_amdgcn_mfma_f32_16x16x32_bf16(__builtin_bit_cast(bf16x8, u), bfr[ks], acc, 0, 0, 0);
                }
                st[i] = acc;
            }
        }
    }
}
#undef R2_LOAD

DEV void rwkv3_unit(const Params& p, int h, int c, float* sm) {
    const int tid = opaque_tid(), lane = tid & 63, wave = tid >> 6;
    const bf16_t* P0 = (const bf16_t*)(p.ws + OFF_P0);
    const bf16_t* RUb = (const bf16_t*)(p.ws + OFF_RU);
    const bf16_t* S0G = (const bf16_t*)(p.ws + OFF_RS0);
    const float* BONS = (const float*)(p.ws + OFF_BONS);
    bf16_t* YC = (bf16_t*)(p.ws + OFF_YC);
    const float* mu = p.in[15]; const float* gn_g = p.in[27]; const float* gn_b = p.in[28];
    bf16_t* img = (bf16_t*)sm;
    float* O = sm + 4 * 2304;
    __syncthreads();
    {
        const int row = tid >> 3, c8 = (tid & 7) * 8;
#pragma unroll
        for (int dir = 0; dir < 2; ++dir) {
            const size_t u = (size_t)((h * 2 + dir) * NCH + c);
            *(uint4*)(img + dir * 4608 + row * 72 + c8) = *(const uint4*)(RUb + u * 16384 + 8192 + row * 64 + c8);
            *(uint4*)(img + (2 + dir) * 4608 + row * 72 + c8) = *(const uint4*)(S0G + u * 4096 + row * 64 + c8);
        }
    }
    __syncthreads();
#pragma unroll
    for (int q = 0; q < 2; ++q) {
        const int idx = wave * 2 + q, ti = idx >> 2, tj = idx & 3;
        f32x4 accd[2];
#pragma unroll
        for (int dir = 0; dir < 2; ++dir) {
            f32x4 acc = (f32x4){0.f, 0.f, 0.f, 0.f};
#pragma unroll
            for (int ks = 0; ks < 2; ++ks) acc = __builtin_amdgcn_mfma_f32_16x16x32_bf16(row_frag(img + dir * 4608, 72, ti * 16, ks * 32, lane), row_frag(img + (2 + dir) * 4608, 72, tj * 16, ks * 32, lane), acc, 0, 0, 0);
            const uint2 yl = *(const uint2*)(RUb + (size_t)((h * 2 + dir) * NCH + c) * 16384 + 12288 + (tj * 16 + (lane & 15)) * 64 + ti * 16 + (lane >> 4) * 4);
            acc[0] += bflo(yl.x); acc[1] += bfhi(yl.x); acc[2] += bflo(yl.y); acc[3] += bfhi(yl.y);
            accd[dir] = acc;
        }
#pragma unroll
        for (int r = 0; r < 4; ++r) {
            const int oi = (ti * 16 + (lane >> 4) * 4 + r) * 68 + tj * 16 + (lane & 15);
            O[oi] = accd[0][r] + accd[1][r];
        }
    }
    __syncthreads();
    {
        const int t = tid >> 3, v0 = (tid & 7) * 8, s = c * 64 + t;
        float y[8], sum = 0.f;
#pragma unroll
        for (int i = 0; i < 8; ++i) { y[i] = O[t * 68 + v0 + i]; sum += y[i]; }
        sum += __shfl_xor(sum, 1, 64); sum += __shfl_xor(sum, 2, 64); sum += __shfl_xor(sum, 4, 64);
        const float mean = sum * (1.f / 64.f);
        float sq = 0.f;
#pragma unroll
        for (int i = 0; i < 8; ++i) { y[i] -= mean; sq += y[i] * y[i]; }
        sq += __shfl_xor(sq, 1, 64); sq += __shfl_xor(sq, 2, 64); sq += __shfl_xor(sq, 4, 64);
        const float rstd = rsqrtf(sq * (1.f / 64.f) + 64e-5f);
        float vm[8], gm[8];
        rw_mix8(P0, s, 1024 + h * 64 + v0, mu, vm);
        rw_mix8(P0, s, 1536 + h * 64 + v0, mu, gm);
        const float bon = BONS[(size_t)s * 8 + h] + BONS[((size_t)TB + s) * 8 + h];
        float o[8];
#pragma unroll
        for (int i = 0; i < 8; ++i) o[i] = (y[i] * rstd * gn_g[h * 64 + v0 + i] + gn_b[h * 64 + v0 + i] + bon * vm[i]) * silu_f(gm[i]);
        *(uint4*)(YC + (size_t)s * 1024 + 512 + h * 64 + v0) = pack8(o);
    }
}

DEV void ln_rows(const float* src, int nrows, const float* __restrict__ g, const float* __restrict__ bt, float* dst_lat, float* dst_cx, int ncx) {
    const int tid_ = opaque_tid(); const int lane = tid_ & 63, gw = blockIdx.x * NWV + (tid_ >> 6), ngw = gridDim.x * NWV;
    for (int r = gw; r < nrows; r += ngw) {
        const float* x = src + (size_t)r * 1024;
        float4 v[4];
        float sum = 0.f;
#pragma unroll
        for (int i = 0; i < 4; ++i) { v[i] = ld4(x + i * 256 + lane * 4); sum += v[i].x + v[i].y + v[i].z + v[i].w; }
        const float mean = wave_sum(sum) * (1.f / 1024.f);
        float sq = 0.f;
#pragma unroll
        for (int i = 0; i < 4; ++i) {
            v[i].x -= mean; v[i].y -= mean; v[i].z -= mean; v[i].w -= mean;
            sq += v[i].x * v[i].x + v[i].y * v[i].y + v[i].z * v[i].z + v[i].w * v[i].w;
        }
        const float rstd = rsqrtf(wave_sum(sq) * (1.f / 1024.f) + 1e-5f);
        float* d = (r < ncx) ? (dst_cx + (size_t)r * 1024) : (dst_lat + (size_t)(r - ncx) * 1024);
#pragma unroll
        for (int i = 0; i < 4; ++i) {
            const int c = i * 256 + lane * 4;
            const float4 gg = ld4(g + c), bb = ld4(bt + c);
            st4(d + c, make_float4(v[i].x * rstd * gg.x + bb.x, v[i].y * rstd * gg.y + bb.y, v[i].z * rstd * gg.z + bb.z, v[i].w * rstd * gg.w + bb.w));
        }
    }
}

DEV void zero_f4(float* ptr, size_t nfloat) {
    const size_t n4 = nfloat / 4;
    for (size_t i = (size_t)blockIdx.x * NTHR + opaque_tid(); i < n4; i += (size_t)gridDim.x * NTHR) ((float4*)ptr)[i] = make_float4(0.f, 0.f, 0.f, 0.f);
}

DEV void chain_ids(int& chain, int& sub) {
    const int bid = blockIdx.x, xcd = bid & 7, idx = bid >> 3;
    chain = xcd * 2 + (idx >> 4); sub = idx & 15;
}

DEV void phase_conv1(const Params& p, float* sm) {
    const bf16_t* XM = (const bf16_t*)(p.ws + OFF_XM);
    bf16_t* XC = (bf16_t*)(p.ws + OFF_XC);
    float* G16P = (float*)(p.ws + OFF_G16P);
    const bf16_t* WFT = (const bf16_t*)(p.ws + OFF_WFT);
    const float* cw = p.in[31]; const float* cbias = p.in[32];
    bf16_t* imgC = (bf16_t*)sm;
    bf16_t* imgM = imgC + 64 * 264;
    float* red = (float*)(imgM + 64 * 264);
    const int tid = opaque_tid(), lane = tid & 63, wave = tid >> 6, t = tid >> 3, cg = tid & 7;
    for (int u = blockIdx.x; u < NB * NCH * 4; u += gridDim.x) {
        const int ci = u >> 2, q = u & 3, b = ci / NCH, c = ci % NCH, s = c * 64 + t;
        const size_t rowbase = (size_t)b * TB;
        int nrow[9];
#pragma unroll
        for (int i = 0; i < 3; ++i)
#pragma unroll
            for (int j = 0; j < 3; ++j) {
                int ns = -1;
                if (s < NCX) { const int w2 = s + j - 1; if (i == 1 && w2 >= 0 && w2 < NCX) ns = w2; }
                else { const int n = s - NCX, rr = (n >> 6) + i - 1, w2 = (n & 63) + j - 1; if (rr >= 0 && rr < 128 && w2 >= 0 && w2 < 64) ns = NCX + rr * 64 + w2; }
                nrow[i * 3 + j] = ns;
            }
        const int tt = wave & 3, part = wave >> 2;
        f32x4 acc = (f32x4){0.f, 0.f, 0.f, 0.f};
#pragma unroll 1
        for (int half = 0; half < 2; ++half) {
            __syncthreads();
#pragma unroll 2
            for (int it = 0; it < 4; ++it) {
                const int cl = it * 64 + cg * 8, c0 = q * 512 + half * 256 + cl;
                float a8[8];
                { const float4 b0 = ld4(cbias + c0), b1 = ld4(cbias + c0 + 4); a8[0] = b0.x; a8[1] = b0.y; a8[2] = b0.z; a8[3] = b0.w; a8[4] = b1.x; a8[5] = b1.y; a8[6] = b1.z; a8[7] = b1.w; }
                uint4 xmc = make_uint4(0u, 0u, 0u, 0u);
#pragma unroll
                for (int tap = 0; tap < 9; ++tap) {
                    if (nrow[tap] >= 0) {
                        const uint4 xv = *(const uint4*)(XM + (rowbase + nrow[tap]) * 2048 + c0);
                        float x8[8]; unpack8(xv, x8);
                        const float4 w0 = ld4(cw + tap * 2048 + c0), w1 = ld4(cw + tap * 2048 + c0 + 4);
                        a8[0] += x8[0] * w0.x; a8[1] += x8[1] * w0.y; a8[2] += x8[2] * w0.z; a8[3] += x8[3] * w0.w;
                        a8[4] += x8[4] * w1.x; a8[5] += x8[5] * w1.y; a8[6] += x8[6] * w1.z; a8[7] += x8[7] * w1.w;
                        if (tap == 4) xmc = xv;
                    }
                }
#pragma unroll
                for (int i = 0; i < 8; ++i) a8[i] = silu_f(a8[i]);
                const uint4 xcv = pack8(a8);
                *(uint4*)(XC + (rowbase + s) * 2048 + c0) = xcv;
                *(uint4*)(imgC + t * 264 + cl) = xcv;
                *(uint4*)(imgM + t * 264 + cl) = xmc;
            }
            __syncthreads();
            {
                const bf16_t* img = part ? imgM : imgC;
                const bf16_t* wrow = WFT + (size_t)(lane & 15) * 4096 + part * 2048 + q * 512 + half * 256 + (lane >> 4) * 8;
#pragma unroll
                for (int ks = 0; ks < 8; ++ks) acc = __builtin_amdgcn_mfma_f32_16x16x32_bf16(row_frag(img, 264, tt * 16, ks * 32, lane), *(const bf16x8*)(wrow + ks * 32), acc, 0, 0, 0);
            }
        }
        if (part == 1) {
#pragma unroll
            for (int r = 0; r < 4; ++r) red[(tt * 16 + (lane >> 4) * 4 + r) * 16 + (lane & 15)] = acc[r];
        }
        __syncthreads();
        if (part == 0) {
#pragma unroll
            for (int r = 0; r < 4; ++r) {
                const int tk = tt * 16 + (lane >> 4) * 4 + r;
                G16P[((size_t)q * RT + rowbase + c * 64 + tk) * 16 + (lane & 15)] = acc[r] + red[tk * 16 + (lane & 15)];
            }
        }
    }
}

DEV void gate_pair(const Params& p, size_t row, int dir, int h, float& gi, float& lf) {
    const float* G16P = (const float*)(p.ws + OFF_G16P);
    float a = 0.f, f = 0.f;
#pragma unroll
    for (int q = 0; q < 4; ++q) { a += G16P[((size_t)q * RT + row) * 16 + dir * 8 + h]; f += G16P[((size_t)q * RT + row) * 16 + dir * 8 + 4 + h]; }
    gi = a + p.in[dir ? 41 : 37][h];
    lf = logsig_f(f + p.in[dir ? 43 : 39][h]);
}

DEV void phase_x1(const Params& p, float* sm) {
    int chain, sub; chain_ids(chain, sub);
    const int b = chain >> 3, h = (chain >> 1) & 3, dir = chain & 1;
    const bf16_t* XC = (const bf16_t*)(p.ws + OFF_XC);
    float* GSC = (float*)(p.ws + OFF_GSC); float* CSC = (float*)(p.ws + OFF_CSC); float* NBUF = (float*)(p.ws + OFF_NBUF);
    const float* gtab = (const float*)(p.ws + OFF_GTAB);
    bf16_t* SMAT = (bf16_t*)(p.ws + OFF_SMAT);
    const int tid = opaque_tid(), lane = tid & 63, wave = tid >> 6;
    float* sTot = sm; float* sRef = sm + 132; float* sM0 = sm + 264; float* sBeta = sm + 400;
    for (int c = wave; c < NCH; c += NWV) {
        const size_t row = (size_t)b * TB + c * 64 + lane;
        float gi, lf; gate_pair(p, row, dir, h, gi, lf);
        const float bc = wave_scan_add(lf, lane, dir);
        const float ref = wave_max(gi - bc), tot = wave_sum(lf);
        if (lane == 0) { sTot[c] = tot; sRef[c] = ref; }
    }
    __syncthreads();
    if (tid == 0) {
        float m0 = -INFINITY;
        for (int step = 0; step < NCH; ++step) {
            const int c = chunk_at(dir, step);
            sM0[c] = m0;
            const float mx = fmaxf(m0, sRef[c]);
            if (sub == 0) { CSC[(chain * NCH + c) * 2] = fexp(m0 - mx); CSC[(chain * NCH + c) * 2 + 1] = fexp(sRef[c] - mx); }
            m0 = sTot[c] + mx;
        }
    }
    __syncthreads();
    for (int k = wave; sub + 16 * k < NCH; k += NWV) {
        const int c = sub + 16 * k;
        const size_t row = (size_t)b * TB + c * 64 + lane;
        float gi, lf; gate_pair(p, row, dir, h, gi, lf);
        const float bc = wave_scan_add(lf, lane, dir);
        const float a = gi - bc;
        const float amax = wave_scan_max(a, lane, dir);
        const float ref = sRef[c], m0 = sM0[c];
        const float mmax = fmaxf(amax, m0);
        const float mt = bc + mmax;
        const float alpha = fexp(ref - mmax), beta = fexp(a - ref), gg = fexp(m0 - mmax), em = fexp(-mt);
        st4(GSC + ((size_t)chain * TB + c * 64 + lane) * 4, make_float4(alpha, beta, gg, em));
        sBeta[k * 64 + lane] = beta;
    }
    __syncthreads();
    {
        float* part = sm + 1024;
        const int sg = tid >> 6, j8 = (tid & 63) * 8;
        for (int k = 0; sub + 16 * k < NCH; ++k) {
            const int c = sub + 16 * k;
            const bf16_t* xp = XC + ((size_t)b * TB + c * 64 + sg * 8) * 2048 + h * 512 + j8;
            float acc[8];
#pragma unroll
            for (int i = 0; i < 8; ++i) acc[i] = 0.f;
#pragma unroll
            for (int s = 0; s < 8; ++s) {
                float f[8]; unpack8(*(const uint4*)(xp + (size_t)s * 2048), f);
                const float be = sBeta[k * 64 + sg * 8 + s];
#pragma unroll
                for (int i = 0; i < 8; ++i) acc[i] += be * f[i];
            }
            __syncthreads();
            st4(part + sg * 512 + j8, make_float4(acc[0], acc[1], acc[2], acc[3])); st4(part + sg * 512 + j8 + 4, make_float4(acc[4], acc[5], acc[6], acc[7]));
            __syncthreads();
            float tot = 0.f;
#pragma unroll
            for (int q = 0; q < 8; ++q) tot += part[q * 512 + tid];
            NBUF[((size_t)chain * NCH + c) * 512 + tid] = tot;
        }
    }
    bf16_t* XCs = (bf16_t*)sm;
    bf16_t* Qs = XCs + 64 * 520;
    for (int u = blockIdx.x; u < NB * 4 * NCH; u += gridDim.x) {
        const int bh = u / NCH, c = u % NCH, ub = bh >> 2, uh = bh & 3;
        __syncthreads();
#pragma unroll 2
        for (int i = 0; i < 8; ++i) {
            const int pp = tid + 512 * i, row = pp >> 6, c16 = pp & 63;
            const uint4 xv = *(const uint4*)(XC + ((size_t)ub * TB + c * 64 + row) * 2048 + uh * 512 + c16 * 8);
            float f[8]; unpack8(xv, f);
            float q[8];
#pragma unroll
            for (int bb = 0; bb < 2; ++bb) {
                const float* G = gtab + (size_t)(uh * 128 + c16 * 2 + bb) * 16;
                const float4 g0 = ld4(G), g1 = ld4(G + 4), g2 = ld4(G + 8), g3 = ld4(G + 12);
                q[bb * 4 + 0] = f[bb * 4] * g0.x + f[bb * 4 + 1] * g1.x + f[bb * 4 + 2] * g2.x + f[bb * 4 + 3] * g3.x;
                q[bb * 4 + 1] = f[bb * 4] * g0.y + f[bb * 4 + 1] * g1.y + f[bb * 4 + 2] * g2.y + f[bb * 4 + 3] * g3.y;
                q[bb * 4 + 2] = f[bb * 4] * g0.z + f[bb * 4 + 1] * g1.z + f[bb * 4 + 2] * g2.z + f[bb * 4 + 3] * g3.z;
                q[bb * 4 + 3] = f[bb * 4] * g0.w + f[bb * 4 + 1] * g1.w + f[bb * 4 + 2] * g2.w + f[bb * 4 + 3] * g3.w;
            }
            *(uint4*)(XCs + row * 520 + c16 * 8) = xv;
            *(uint4*)(Qs + row * 520 + c16 * 8) = make_uint4(pack2bf(q[0], q[1]), pack2bf(q[2], q[3]), pack2bf(q[4], q[5]), pack2bf(q[6], q[7]));
        }
        __syncthreads();
        const int st = wave & 3, tt0 = (wave >> 2) * 2;
        f32x4 a0 = (f32x4){0.f, 0.f, 0.f, 0.f}, a1 = a0;
        const bf16_t* ap = XCs + (st * 16 + (lane & 15)) * 520 + (lane >> 4) * 8;
        const bf16_t* bp0 = Qs + (tt0 * 16 + (lane & 15)) * 520 + (lane >> 4) * 8;
        const bf16_t* bp1 = bp0 + 16 * 520;
#pragma unroll
        for (int ks = 0; ks < 16; ++ks) {
            const bf16x8 af = *(const bf16x8*)(ap + ks * 32);
            a0 = __builtin_amdgcn_mfma_f32_16x16x32_bf16(af, *(const bf16x8*)(bp0 + ks * 32), a0, 0, 0, 0);
            a1 = __builtin_amdgcn_mfma_f32_16x16x32_bf16(af, *(const bf16x8*)(bp1 + ks * 32), a1, 0, 0, 0);
        }
        bf16_t* sp = SMAT + (size_t)u * 4096 + (size_t)(tt0 * 16 + (lane & 15)) * 64 + st * 16 + (lane >> 4) * 4;
        *(uint2*)sp = make_uint2(pack2bf(a0[0], a0[1]), pack2bf(a0[2], a0[3]));
        *(uint2*)(sp + 16 * 64) = make_uint2(pack2bf(a1[0], a1[1]), pack2bf(a1[2], a1[3]));
    }
}

DEV void phase_x2(const Params& p, float* sm) {
    int chain, sub; chain_ids(chain, sub);
    const int b = chain >> 3, h = (chain >> 1) & 3, dir = chain & 1;
    const bf16_t* XC = (const bf16_t*)(p.ws + OFF_XC);
    float* GSC = (float*)(p.ws + OFF_GSC); const float* CSC = (const float*)(p.ws + OFF_CSC); const float* NBUF = (const float*)(p.ws + OFF_NBUF);
    const float* gtab = (const float*)(p.ws + OFF_GTAB);
    const bf16_t* SMAT = (const bf16_t*)(p.ws + OFF_SMAT);
    const int tid = opaque_tid();
    float* sD0 = sm; float* sCf = sm + 132; float* sN0 = sm + 264; float* sN2 = sN0 + 9 * 512;
    for (int i = tid; i < NCH; i += NTHR) { sD0[i] = CSC[(chain * NCH + i) * 2]; sCf[i] = CSC[(chain * NCH + i) * 2 + 1]; }
    __syncthreads();
    {
        float n = 0.f;
        const float* nb = NBUF + (size_t)chain * NCH * 512 + tid;
#pragma unroll 4
        for (int step = 0; step < NCH; ++step) {
            const int c = chunk_at(dir, step);
            if ((c & 15) == sub) sN0[(c >> 4) * 512 + tid] = n;
            n = sD0[c] * n + sCf[c] * nb[(size_t)c * 512];
        }
    }
    __syncthreads();
    {
        const int blk = tid >> 2, cp = tid & 3;
        const float4 g = ld4(gtab + (size_t)(h * 128 + blk) * 16 + cp * 4);
        for (int k = 0; sub + 16 * k < NCH; ++k) {
            const float* n0 = sN0 + k * 512 + blk * 4;
            sN2[k * 512 + tid] = g.x * n0[0] + g.y * n0[1] + g.z * n0[2] + g.w * n0[3];
        }
    }
    __syncthreads();
    const int t = tid >> 3, part = tid & 7;
    for (int k = 0; sub + 16 * k < NCH; ++k) {
        const int c = sub + 16 * k;
        const size_t row = (size_t)b * TB + c * 64 + t;
        float dint = 0.f;
        {
            const bf16_t* xp = XC + row * 2048 + h * 512 + part * 64;
            const float* n2 = sN2 + k * 512 + part * 64;
#pragma unroll
            for (int i = 0; i < 8; ++i) {
                float f[8]; unpack8(*(const uint4*)(xp + i * 8), f);
                const float4 na = ld4(n2 + i * 8), nb2 = ld4(n2 + i * 8 + 4);
                dint += f[0] * na.x + f[1] * na.y + f[2] * na.z + f[3] * na.w + f[4] * nb2.x + f[5] * nb2.y + f[6] * nb2.z + f[7] * nb2.w;
            }
        }
        float di = 0.f;
        {
            float f[8]; unpack8(*(const uint4*)(SMAT + ((size_t)((b * 4 + h) * NCH + c)) * 4096 + t * 64 + part * 8), f);
#pragma unroll
            for (int e = 0; e < 8; ++e) {
                const int s = part * 8 + e;
                const float beta = GSC[((size_t)chain * TB + c * 64 + s) * 4 + 1];
                const bool keep = dir ? (s >= t) : (s <= t);
                di += keep ? f[e] * beta : 0.f;
            }
        }
        dint += __shfl_xor(dint, 1, 64); dint += __shfl_xor(dint, 2, 64); dint += __shfl_xor(dint, 4, 64);
        di += __shfl_xor(di, 1, 64); di += __shfl_xor(di, 2, 64); di += __shfl_xor(di, 4, 64);
        if (part == 0) {
            float* gp = GSC + ((size_t)chain * TB + c * 64 + t) * 4;
            const float4 g4 = ld4(gp);
            const float den = g4.x * di + g4.z * dint;
            gp[3] = 1.f / fmaxf(fabsf(den), g4.w);
        }
    }
}

#define MLSTM_PREFETCH(step_) do { \
    const int c_ = chunk_at(dir, (step_)); const size_t rb_ = (size_t)b * TB + (size_t)c_ * 64; \
    { const bf16_t* xb_ = XC + (rb_ + (tid >> 6)) * 2048 + h * 512 + (tid & 63) * 8; \
      rx0 = *(const uint4*)(xb_); rx1 = *(const uint4*)(xb_ + 8 * 2048); rx2 = *(const uint4*)(xb_ + 16 * 2048); rx3 = *(const uint4*)(xb_ + 24 * 2048); \
      rx4 = *(const uint4*)(xb_ + 32 * 2048); rx5 = *(const uint4*)(xb_ + 40 * 2048); rx6 = *(const uint4*)(xb_ + 48 * 2048); rx7 = *(const uint4*)(xb_ + 56 * 2048); } \
    rxm = *(const uint2*)(XM + (rb_ + ps) * 2048 + ch0 + pvb * 4); \
    rs = *(const uint4*)(SMAT + ((size_t)((b * 4 + h) * NCH + c_)) * 4096 + ps * 64 + pvb * 8); \
    rbeta = GSC[((size_t)chain * TB + c_ * 64 + ps) * 4 + 1]; \
    if (tid < 64) rsc = ld4(GSC + ((size_t)chain * TB + c_ * 64 + tid) * 4); \
    rd0 = CSC[(chain * NCH + c_) * 2]; rcf = CSC[(chain * NCH + c_) * 2 + 1]; } while (0)

DEV void phase_mlstm(const Params& p, float* sm) {
    int chain, sub; chain_ids(chain, sub);
    const int b = chain >> 3, h = (chain >> 1) & 3, dir = chain & 1;
    const bf16_t* XM = (const bf16_t*)(p.ws + OFF_XM);
    const bf16_t* XC = (const bf16_t*)(p.ws + OFF_XC);
    const bf16_t* SMAT = (const bf16_t*)(p.ws + OFF_SMAT);
    const float* GSC = (const float*)(p.ws + OFF_GSC); const float* CSC = (const float*)(p.ws + OFF_CSC);
    const float* gtab = (const float*)(p.ws + OFF_GTAB);
    bf16_t* H = (bf16_t*)(p.ws + OFF_H);
    const float* wv = p.in[35];
    char* smc = (char*)sm;
    bf16_t* XCs = (bf16_t*)smc;
    bf16_t* Cs = (bf16_t*)(smc + 66560);
    bf16_t* Vb = (bf16_t*)(smc + 66560 + 33280);
    bf16_t* Vw = Vb + 32 * 72;
    bf16_t* Sm = Vw + 32 * 72;
    float* Gs = (float*)(smc + 66560 + 33280 + 2 * 4608 + 9216);
    float* sc = Gs + 2048;
    const int tid = opaque_tid(), lane = tid & 63, wave = tid >> 6;
    for (int i = tid; i < 32 * 520 / 2; i += NTHR) ((unsigned*)Cs)[i] = 0u;
    for (int i = tid; i < 2048; i += NTHR) Gs[i] = gtab[h * 2048 + i];
    const int ps = tid >> 3, pvb = tid & 7;
    const int ch0 = h * 512 + sub * 32;
    float wvr[16];
#pragma unroll
    for (int i = 0; i < 16; ++i) wvr[i] = wv[(size_t)((ch0 >> 2) + pvb) * 16 + i];
    f32x4 accS[4][2];
#pragma unroll
    for (int i = 0; i < 4; ++i) { accS[i][0] = (f32x4){0.f, 0.f, 0.f, 0.f}; accS[i][1] = (f32x4){0.f, 0.f, 0.f, 0.f}; }
    uint4 rx0, rx1, rx2, rx3, rx4, rx5, rx6, rx7; uint2 rxm; uint4 rs; float rbeta; float4 rsc = make_float4(0.f, 0.f, 0.f, 0.f); float rd0, rcf;
    MLSTM_PREFETCH(0);
    __syncthreads();
#pragma unroll 1
    for (int step = 0; step < NCH; ++step) {
        const int c = chunk_at(dir, step);
        const float d0 = rd0, cf = rcf;
        {
            bf16_t* xd = XCs + (tid >> 6) * 520 + (tid & 63) * 8;
            *(uint4*)(xd) = rx0; *(uint4*)(xd + 8 * 520) = rx1; *(uint4*)(xd + 16 * 520) = rx2; *(uint4*)(xd + 24 * 520) = rx3;
            *(uint4*)(xd + 32 * 520) = rx4; *(uint4*)(xd + 40 * 520) = rx5; *(uint4*)(xd + 48 * 520) = rx6; *(uint4*)(xd + 56 * 520) = rx7;
        }
        {
            const float x0 = bflo(rxm.x), x1 = bfhi(rxm.x), x2 = bflo(rxm.y), x3 = bfhi(rxm.y);
#pragma unroll
            for (int d = 0; d < 4; ++d) {
                const float v = (x0 * wvr[d] + x1 * wvr[4 + d] + x2 * wvr[8 + d] + x3 * wvr[12 + d]) * rbeta;
                Vb[(pvb * 4 + d) * 72 + ps] = __builtin_bit_cast(unsigned short, (__bf16)v);
                Vw[(pvb * 4 + d) * 72 + ps] = __builtin_bit_cast(unsigned short, (__bf16)(v * cf));
            }
        }
        {
#define SMASK(q_) (((dir ? (pvb * 8 + 2 * (q_) >= ps) : (pvb * 8 + 2 * (q_) <= ps)) ? 0x0000ffffu : 0u) | ((dir ? (pvb * 8 + 2 * (q_) + 1 >= ps) : (pvb * 8 + 2 * (q_) + 1 <= ps)) ? 0xffff0000u : 0u))
            *(uint4*)(Sm + ps * 72 + pvb * 8) = make_uint4(rs.x & SMASK(0), rs.y & SMASK(1), rs.z & SMASK(2), rs.w & SMASK(3));
#undef SMASK
        }
        if (tid < 64) st4(sc + tid * 4, rsc);
        { const int nstep = (step + 1 < NCH) ? step + 1 : step; MLSTM_PREFETCH(nstep); }
        __syncthreads();
        {
            const int vt = wave & 1, tt = wave >> 1;
            f32x4 ao = (f32x4){0.f, 0.f, 0.f, 0.f}, ai = ao;
            const bf16_t* ap = Cs + (vt * 16 + (lane & 15)) * 520 + (lane >> 4) * 8;
            const bf16_t* bp = XCs + (tt * 16 + (lane & 15)) * 520 + (lane >> 4) * 8;
#pragma unroll
            for (int ks = 0; ks < 16; ++ks) ao = __builtin_amdgcn_mfma_f32_16x16x32_bf16(*(const bf16x8*)(ap + ks * 32), *(const bf16x8*)(bp + ks * 32), ao, 0, 0, 0);
            const bf16_t* ap2 = Vb + (vt * 16 + (lane & 15)) * 72 + (lane >> 4) * 8;
            const bf16_t* bp2 = Sm + (tt * 16 + (lane & 15)) * 72 + (lane >> 4) * 8;
#pragma unroll
            for (int ks = 0; ks < 2; ++ks) ai = __builtin_amdgcn_mfma_f32_16x16x32_bf16(*(const bf16x8*)(ap2 + ks * 32), *(const bf16x8*)(bp2 + ks * 32), ai, 0, 0, 0);
            if (c >= 4) {
                const int t = tt * 16 + (lane & 15);
                const float4 s4 = ld4(sc + t * 4);
                const float h0 = (s4.x * ai[0] + s4.z * ao[0]) * s4.w, h1 = (s4.x * ai[1] + s4.z * ao[1]) * s4.w;
                const float h2 = (s4.x * ai[2] + s4.z * ao[2]) * s4.w, h3 = (s4.x * ai[3] + s4.z * ao[3]) * s4.w;
                bf16_t* hp = H + ((size_t)b * NL + (size_t)c * 64 + t - NCX) * 2048 + ch0 + vt * 16 + (lane >> 4) * 4;
                const unsigned u0 = pack2bf(h0, h1), u1 = pack2bf(h2, h3);
                __builtin_amdgcn_global_atomic_fadd_v2bf16((__attribute__((address_space(1))) s16x2*)hp, __builtin_bit_cast(s16x2, u0));
                __builtin_amdgcn_global_atomic_fadd_v2bf16((__attribute__((address_space(1))) s16x2*)(hp + 2), __builtin_bit_cast(s16x2, u1));
            }
        }
#pragma unroll
        for (int jt = 0; jt < 4; ++jt) { accS[jt][0] *= d0; accS[jt][1] *= d0; }
#pragma unroll
        for (int ks = 0; ks < 2; ++ks) {
            const bf16x8 b0 = *(const bf16x8*)(Vw + (lane & 15) * 72 + ks * 32 + (lane >> 4) * 8);
            const bf16x8 b1 = *(const bf16x8*)(Vw + (16 + (lane & 15)) * 72 + ks * 32 + (lane >> 4) * 8);
            const int row0 = ks * 32 + (lane >> 4) * 8 + ((lane & 15) >> 2);
#pragma unroll
            for (int jt = 0; jt < 4; ++jt) {
                const int col = wave * 64 + jt * 16 + (lane & 3) * 4;
                const s16x4 lo = __builtin_amdgcn_ds_read_tr16_b64_v4i16((__attribute__((address_space(3))) s16x4*)(XCs + row0 * 520 + col));
                const s16x4 hi = __builtin_amdgcn_ds_read_tr16_b64_v4i16((__attribute__((address_space(3))) s16x4*)(XCs + (row0 + 4) * 520 + col));
                const bf16x8 af = (bf16x8){lo[0], lo[1], lo[2], lo[3], hi[0], hi[1], hi[2], hi[3]};
                accS[jt][0] = __builtin_amdgcn_mfma_f32_16x16x32_bf16(af, b0, accS[jt][0], 0, 0, 0);
                accS[jt][1] = __builtin_amdgcn_mfma_f32_16x16x32_bf16(af, b1, accS[jt][1], 0, 0, 0);
            }
        }
        __syncthreads();
#pragma unroll
        for (int jt = 0; jt < 4; ++jt) {
            const int blk = wave * 16 + jt * 4 + (lane >> 4);
            const float4 g0 = ld4(Gs + blk * 16), g1 = ld4(Gs + blk * 16 + 4), g2 = ld4(Gs + blk * 16 + 8), g3 = ld4(Gs + blk * 16 + 12);
#pragma unroll
            for (int v2 = 0; v2 < 2; ++v2) {
                const f32x4 a = accS[jt][v2];
                const float o0 = g0.x * a[0] + g0.y * a[1] + g0.z * a[2] + g0.w * a[3];
                const float o1 = g1.x * a[0] + g1.y * a[1] + g1.z * a[2] + g1.w * a[3];
                const float o2 = g2.x * a[0] + g2.y * a[1] + g2.z * a[2] + g2.w * a[3];
                const float o3 = g3.x * a[0] + g3.y * a[1] + g3.z * a[2] + g3.w * a[3];
                *(uint2*)(Cs + (v2 * 16 + (lane & 15)) * 520 + blk * 4) = make_uint2(pack2bf(o0, o1), pack2bf(o2, o3));
            }
        }
    }
}

DEV void phase_finish1(const Params& p) {
    bf16_t* H = (bf16_t*)(p.ws + OFF_H);
    const bf16_t* XC = (const bf16_t*)(p.ws + OFF_XC);
    const bf16_t* Z = (const bf16_t*)(p.ws + OFF_XM);
    const float* ng = p.in[44]; const float* skip = p.in[45];
    const int tid_ = opaque_tid(); const int lane = tid_ & 63, gw = blockIdx.x * NWV + (tid_ >> 6), ngw = gridDim.x * NWV;
    for (int it = gw; it < NB * NL * 4; it += ngw) {
        const int r = it >> 2, h = it & 3, b = r >= NL ? 1 : 0, nn = r - b * NL;
        const int c0 = h * 512 + lane * 8;
        bf16_t* hp = H + (size_t)r * 2048 + c0;
        float v[8]; unpack8(*(const uint4*)hp, v);
        float sum = 0.f;
#pragma unroll
        for (int j = 0; j < 8; ++j) sum += v[j];
        const float mean = wave_sum(sum) * (1.f / 512.f);
        float sq = 0.f;
#pragma unroll
        for (int j = 0; j < 8; ++j) { v[j] -= mean; sq += v[j] * v[j]; }
        const float rstd = rsqrtf(wave_sum(sq) * (1.f / 512.f) + 1e-5f);
        float xc[8], z[8];
        unpack8(*(const uint4*)(XC + ((size_t)b * TB + NCX + nn) * 2048 + c0), xc);
        unpack8(*(const uint4*)(Z + (size_t)r * 2048 + c0), z);
        float o[8];
#pragma unroll
        for (int j = 0; j < 8; ++j) o[j] = (v[j] * rstd * ng[c0 + j] + skip[c0 + j] * xc[j]) * silu_f(z[j]);
        *(uint4*)hp = make_uint4(pack2bf(o[0], o[1]), pack2bf(o[2], o[3]), pack2bf(o[4], o[5]), pack2bf(o[6], o[7]));
    }
}

__global__ void __launch_bounds__(NTHR) fwd_kernel(Params p) {
    extern __shared__ __attribute__((aligned(16))) float sm[];
    volatile LAS unsigned* xst = (volatile LAS unsigned*)((LAS char*)sm + (LDS_BYTES - 16));
    if (threadIdx.x == 0) { xst[0] = 0u; xst[1] = 0u; }
    __syncthreads();
    const XcdBarrier xbar = xcd_barrier_post((unsigned*)(p.ws + OFF_BAR), xst);
    const int tid = opaque_tid(), lane = tid & 63, wave = tid >> 6;
    float* modv = (float*)(p.ws + OFF_MODV);
    float* X1C = (float*)(p.ws + OFF_X1C);

    phase_mod(p, sm);
    phase_tables(p);
    transpose_convert(p.in[8], 1024, EIN, 3968, (bf16_t*)(p.ws + OFF_WT0), sm);
    transpose_convert(p.in[29], 1024, 4096, 4096, (bf16_t*)(p.ws + OFF_WT1), sm);
    transpose_convert(p.in[9], 1024, 1024, 1024, (bf16_t*)(p.ws + OFF_WT2), sm);
    transpose_convert(p.in[30], 2048, 1024, 1024, (bf16_t*)(p.ws + OFF_WT3), sm);
    xcd_barrier(xbar);

#pragma unroll 1
    for (int b = 0; b < NB; ++b) {
        if (b == 0) { phase_h0(p, 0); xcd_barrier(xbar); }
        {
            ALbf al{(const bf16_t*)(p.ws + OFF_YC), DM};
            EPstoreBf ep{(bf16_t*)(p.ws + OFF_P0), EIN};
            gemm_mfma(TB, EIN, 3968, DM, (const bf16_t*)(p.ws + OFF_WT0), al, ep, sm);
        }
        xcd_barrier(xbar);
        for (int u = blockIdx.x; u < 24 * NCH; u += gridDim.x) {
            if (u < 16 * NCH) rwkv1_unit(p, (u / NCH) >> 1, (u / NCH) & 1, u % NCH, sm);
            else { const int v = u - 16 * NCH; gla1_unit(p, (v / NCH) >> 1, (v / NCH) & 1, v % NCH, sm); }
        }
        xcd_barrier(xbar);
        if (blockIdx.x < 128) gla2_unit(p, blockIdx.x);
        else if (blockIdx.x < 192) { if (wave == 0) rwkv2_unit(p, (blockIdx.x - 128) >> 2, (blockIdx.x - 128) & 3, lane); }
        xcd_barrier(xbar);
        for (int u = blockIdx.x; u < 12 * NCH; u += gridDim.x) {
            if (u < 8 * NCH) rwkv3_unit(p, u / NCH, u % NCH, sm);
            else { const int v = u - 8 * NCH; gla3_unit(p, v / NCH, v % NCH, sm); }
        }
        xcd_barrier(xbar);
        {
            ALbf al{(const bf16_t*)(p.ws + OFF_YC), 1024};
            EPres ep{(float*)(p.ws + OFF_P0), 1024, p.in[0], p.in[2], modv, b, 0};
            gemm_mfma(TB, DM, DM, DM, (const bf16_t*)(p.ws + OFF_WT2), al, ep, sm);
        }
        xcd_barrier(xbar);
        ln_rows((const float*)(p.ws + OFF_P0), TB, p.in[6], p.in[7], p.out + (size_t)b * NL * DM, X1C + (size_t)b * NCX * DM, NCX);
        if (b == 0) phase_h0(p, 1);
        xcd_barrier(xbar);
    }

    {
        ALmodAll al{p.out, X1C, modv + 3 * 3072};
        EPstoreBf ep{(bf16_t*)(p.ws + OFF_XM), 2048};
        gemm_mfma(RT, 2048, 2048, DM, (const bf16_t*)(p.ws + OFF_WT1), al, ep, sm);
        zero_f4((float*)(p.ws + OFF_H), (size_t)NB * NL * 1024);
    }
    xcd_barrier(xbar);
    phase_conv1(p, sm);
    xcd_barrier(xbar);
    phase_x1(p, sm);
    xcd_barrier(xbar);
    phase_x2(p, sm);
    xcd_barrier(xbar);
    phase_mlstm(p, sm);
    xcd_barrier(xbar);
    {
        ALmodLat al{p.out, modv + 3 * 3072};
        EPstoreBf ep{(bf16_t*)(p.ws + OFF_XM), 2048};
        gemm_mfma(NB * NL, 2048, 2048, DM, (const bf16_t*)(p.ws + OFF_WT1) + (size_t)2048 * 1024, al, ep, sm);
    }
    xcd_barrier(xbar);
    phase_finish1(p);
    xcd_barrier(xbar);
    {
        ALbf al{(const bf16_t*)(p.ws + OFF_H), 2048};
        EPresLat ep{(float*)(p.ws + OFF_XC), p.out, modv + 3 * 3072};
        gemm_mfma(NB * NL, DM, DM, 2048, (const bf16_t*)(p.ws + OFF_WT3), al, ep, sm);
    }
    xcd_barrier(xbar);
    ln_rows((const float*)(p.ws + OFF_XC), NB * NL, p.in[6] + 1024, p.in[7] + 1024, p.out, p.out, 0);
}

extern "C" void kernel_launch(void* const* d_in, const int* in_sizes, int n_in, void* d_out, int out_size, void* d_ws, size_t ws_size, hipStream_t stream) {
    static int grid_blocks = 0;
    if (grid_blocks == 0) {
        if (ws_size < WS_NEED || n_in != 46) { fprintf(stderr, "kernel_launch: bad ws_size %zu (need %zu) or n_in %d\n", ws_size, (size_t)WS_NEED, n_in); grid_blocks = -1; return; }
        int dev = 0, cus = 0, per_cu = 0;
        (void)hipGetDevice(&dev);
        (void)hipDeviceGetAttribute(&cus, hipDeviceAttributeMultiprocessorCount, dev);
        (void)hipFuncSetAttribute((const void*)fwd_kernel, hipFuncAttributeMaxDynamicSharedMemorySize, LDS_BYTES);
        (void)hipOccupancyMaxActiveBlocksPerMultiprocessor(&per_cu, (const void*)fwd_kernel, NTHR, LDS_BYTES);
        if (per_cu < 1 || cus < 256) { fprintf(stderr, "kernel_launch: occupancy query says %d blocks/CU on %d CUs; this kernel needs 256 resident workgroups\n", per_cu, cus); grid_blocks = -1; return; }
        grid_blocks = 256;
    }
    if (grid_blocks < 0) return;
    (void)hipMemsetAsync((char*)d_ws + OFF_BAR, 0, XCD_BAR_WORDS * 4, stream);
    Params p{};
    for (int i = 0; i < 46; ++i) p.in[i] = (const float*)d_in[i];
    p.out = (float*)d_out; p.ws = (char*)d_ws;
    void* args[] = {&p};
    hipError_t e = hipLaunchCooperativeKernel((const void*)fwd_kernel, dim3(grid_blocks), dim3(NTHR), args, LDS_BYTES, stream);
    if (e != hipSuccess) fprintf(stderr, "cooperative launch failed: %s (grid %d)\n", hipGetErrorString(e), grid_blocks);
}
```

```cpp
#include <hip/hip_runtime.h>
#include <cstdio>
#include <cmath>

#define DEV __device__ __forceinline__

constexpr int NB = 2, NL = 8192, DM = 1024, NCX = 256, TB = NCX + NL;
constexpr int RT = NB * TB;
constexpr int NCH = TB / 64;
constexpr int EIN = 3872, RW0 = 1568;
constexpr int NTHR = 512, NWV = 8;
constexpr float ALPHA = 1.41421356237f;
constexpr float KSCALE = 0.04419417382f;

constexpr size_t OFF_MODV = 0;
constexpr size_t OFF_X1C  = 131072;
constexpr size_t OFF_BAR  = 3145728;
constexpr size_t OFF_BIG  = 4194304;
constexpr size_t OFF_P0   = OFF_BIG;
constexpr size_t OFF_YC   = OFF_BIG + (size_t)TB * EIN * 2;
constexpr size_t OFF_GDS  = OFF_YC + (size_t)TB * 1024 * 2;
constexpr size_t OFF_GDEC = OFF_GDS + (size_t)8 * NCH * 8192 * 4;
constexpr size_t OFF_RU   = OFF_GDEC + (size_t)8 * NCH * 64 * 4;
constexpr size_t OFF_RS0  = OFF_RU + (size_t)16 * NCH * 16384 * 2;
constexpr size_t OFF_BONS = OFF_RS0 + (size_t)16 * NCH * 4096 * 2;
constexpr size_t L0_END   = OFF_BONS + (size_t)2 * TB * 8 * 4;
constexpr size_t OFF_XM   = OFF_BIG;
constexpr size_t OFF_XC   = OFF_XM + (size_t)RT * 2048 * 2;
constexpr size_t OFF_H    = OFF_XC + (size_t)RT * 2048 * 2;
constexpr size_t OFF_WT0  = OFF_H + (size_t)NB * NL * 2048 * 2;
constexpr size_t OFF_WT1  = OFF_WT0 + (size_t)4096 * 1024 * 2;
constexpr size_t OFF_WT2  = OFF_WT1 + (size_t)4096 * 1024 * 2;
constexpr size_t OFF_WT3  = OFF_WT2 + (size_t)1024 * 1024 * 2;
constexpr size_t OFF_G16  = OFF_WT3 + (size_t)1024 * 2048 * 2;
constexpr size_t OFF_SMAT = OFF_G16 + (size_t)RT * 16 * 4;
constexpr size_t OFF_GSC  = OFF_SMAT + (size_t)NB * 4 * NCH * 4096 * 2;
constexpr size_t OFF_CSC  = OFF_GSC + (size_t)16 * TB * 4 * 4;
constexpr size_t OFF_NBUF = OFF_CSC + (size_t)16 * NCH * 2 * 4;
constexpr size_t OFF_GTAB = 3407872;
constexpr size_t OFF_WFT  = OFF_GTAB + (size_t)4 * 128 * 16 * 4;
static_assert(OFF_WFT + (size_t)16 * 4096 * 2 <= OFF_BIG, "low-region tables overflow");
constexpr size_t OFF_G16P = OFF_NBUF + (size_t)16 * NCH * 512 * 4;
constexpr size_t OFF_H1B  = OFF_G16;
constexpr size_t WS_NEED  = (OFF_G16P + (size_t)4 * RT * 16 * 4 > OFF_H1B + (size_t)RT * 1024 * 2) ? OFF_G16P + (size_t)4 * RT * 16 * 4 : OFF_H1B + (size_t)RT * 1024 * 2;
static_assert(WS_NEED <= (size_t)256 * 1024 * 1024, "workspace exceeds the guaranteed 256 MiB");

static_assert(L0_END <= OFF_WT0, "layer-0 buffers overlap the weight copies");
constexpr int LDS_BYTES = 139264;

struct Params { const float* in[46]; float* out; char* ws; };
typedef unsigned short bf16_t;
typedef __attribute__((ext_vector_type(8))) short bf16x8;
typedef __attribute__((ext_vector_type(4))) short s16x4;
typedef __attribute__((ext_vector_type(2))) short s16x2;
typedef __attribute__((ext_vector_type(4))) float f32x4;
typedef __attribute__((ext_vector_type(2))) __bf16 bf2_t;
DEV unsigned pack2bf(float lo, float hi) { bf2_t v; v[0] = (__bf16)lo; v[1] = (__bf16)hi; return __builtin_bit_cast(unsigned, v); }
DEV float bflo(unsigned u) { return __uint_as_float(u << 16); }
DEV float bfhi(unsigned u) { return __uint_as_float(u & 0xffff0000u); }
DEV float bf2f(bf16_t v) { return __uint_as_float(((unsigned)v) << 16); }
DEV void unpack8(uint4 u, float* f) { f[0] = bflo(u.x); f[1] = bfhi(u.x); f[2] = bflo(u.y); f[3] = bfhi(u.y); f[4] = bflo(u.z); f[5] = bfhi(u.z); f[6] = bflo(u.w); f[7] = bfhi(u.w); }

DEV float wave_sum(float v) {
#pragma unroll
    for (int o = 32; o > 0; o >>= 1) v += __shfl_xor(v, o, 64);
    return v;
}
DEV float wave_max(float v) {
#pragma unroll
    for (int o = 32; o > 0; o >>= 1) v = fmaxf(v, __shfl_xor(v, o, 64));
    return v;
}
DEV float fexp(float x) { return __expf(x); }
DEV float frcp(float x) { return __builtin_amdgcn_rcpf(x); }
DEV float sigmoid_f(float x) { return frcp(1.f + fexp(-x)); }
DEV float silu_f(float x) { return x * frcp(1.f + fexp(-x)); }
DEV float logsig_f(float x) { return fminf(x, 0.f) - __logf(1.f + fexp(-fabsf(x))); }
DEV float tanh_f(float x) { const float e = fexp(2.f * x); return 1.f - 2.f * frcp(e + 1.f); }
DEV void lds_fence() { asm volatile("" ::: "memory"); }
DEV int opaque_tid() { int t = threadIdx.x; asm volatile("" : "+v"(t)); return t; }
DEV int scan_s(int dir, int u) { return dir == 0 ? u : (u < NCX ? (NCX - 1 - u) : (TB - 1 + NCX - u)); }
DEV int chunk_at(int dir, int step) { return dir == 0 ? step : (step < 4 ? 3 - step : (NCH + 3 - step)); }
DEV float4 ld4(const float* p) { return *(const float4*)p; }
DEV void st4(float* p, float4 v) { *(float4*)p = v; }


#define XB_TMO      128
#define XB_XCNT(j)  (256  + 64 * (j))
#define XB_XSUB(j)  (1280 + 64 * (j))
#define XB_XGEN(j)  (2304 + 64 * (j))
#define XB_TOP      3328
#define XB_TOPGEN   3392
#define XCD_BAR_WORDS 3456
#define XB_SPIN_CAP (1u << 22)
#define LAS __attribute__((address_space(3)))
DEV unsigned xb_ld(unsigned* p) { return __hip_atomic_load(p, __ATOMIC_RELAXED, __HIP_MEMORY_SCOPE_AGENT); }
DEV unsigned xb_add(unsigned* p, unsigned v) { return __hip_atomic_fetch_add(p, v, __ATOMIC_RELAXED, __HIP_MEMORY_SCOPE_AGENT); }
DEV unsigned xb_xcc_id() { return (unsigned)__builtin_amdgcn_s_getreg((3 << 11) | 20) & 0xFu; }
#define XB_SPIN(cond, bar) do { unsigned _sp = 0; while (cond) { __builtin_amdgcn_s_sleep(1); \
    if ((++_sp & 255u) == 0u) { if (xb_ld(&(bar)[XB_TMO])) break; if (_sp > XB_SPIN_CAP) { atomicAdd(&(bar)[XB_TMO], 1u); break; } } } } while (0)
struct XcdBarrier { unsigned* bar; unsigned x; volatile LAS unsigned* st; };
DEV XcdBarrier xcd_barrier_post(unsigned* bar, volatile LAS unsigned* st) {
    XcdBarrier b; b.bar = bar; b.x = xb_xcc_id(); b.st = st;
    if (threadIdx.x == 0) (void)xb_add(&bar[XB_XCNT(b.x)], 1u);
    return b;
}
DEV void xcd_barrier_complete(unsigned* bar, unsigned x, unsigned& nloc, unsigned& nx) {
    const unsigned G = gridDim.x * gridDim.y * gridDim.z;
    unsigned sum, cnt, mine, sp = 0u;
    for (;;) {
        sum = 0u; cnt = 0u; mine = 0u;
#pragma unroll
        for (unsigned j = 0; j < 16; ++j) { const unsigned c = xb_ld(&bar[XB_XCNT(j)]); sum += c; cnt += (c > 0u) ? 1u : 0u; mine = (j == x) ? c : mine; }
        if (sum == G) break;
        __builtin_amdgcn_s_sleep(1);
        if ((++sp & 255u) == 0u) { if (xb_ld(&bar[XB_TMO])) break; if (sp > XB_SPIN_CAP) { atomicAdd(&bar[XB_TMO], 1u); break; } }
    }
    nloc = mine > 0u ? mine : 1u; nx = cnt > 0u ? cnt : 1u;
}
DEV void xcd_barrier(const XcdBarrier& b) {
    asm volatile("s_waitcnt vmcnt(0)" ::: "memory");
    __syncthreads();
    if (threadIdx.x == 0) {
        unsigned* bar = b.bar;
        __builtin_amdgcn_s_waitcnt(0);
        unsigned nloc = b.st[0], nx = b.st[1];
        if (nloc == 0u) { xcd_barrier_complete(bar, b.x, nloc, nx); b.st[0] = nloc; b.st[1] = nx; }
        const unsigned old = xb_add(&bar[XB_XSUB(b.x)], 1u);
        const unsigned gen = old / nloc;
        if (old + 1u == (gen + 1u) * nloc) {
            __builtin_amdgcn_fence(__ATOMIC_RELEASE, "agent");
            asm volatile("s_waitcnt vmcnt(0)" ::: "memory");
            const unsigned og = xb_add(&bar[XB_TOP], 1u);
            const unsigned tg = og / nx;
            if (og + 1u == (tg + 1u) * nx) xb_add(&bar[XB_TOPGEN], 1u);
            else XB_SPIN(xb_ld(&bar[XB_TOPGEN]) == tg, bar);
            __builtin_amdgcn_fence(__ATOMIC_ACQUIRE, "agent");
            xb_add(&bar[XB_XGEN(b.x)], 1u);
            asm volatile("s_waitcnt vmcnt(0)" ::: "memory");
        } else {
            XB_SPIN(xb_ld(&bar[XB_XGEN(b.x)]) == gen, bar);
            __builtin_amdgcn_fence(__ATOMIC_ACQUIRE, "agent");
            asm volatile("s_waitcnt vmcnt(0)" ::: "memory");
        }
    }
    __syncthreads();
}

namespace pg8 {
#define PG8_LAS __attribute__((address_space(3)))
typedef unsigned short bf16_t;
typedef short bf16x8 __attribute__((ext_vector_type(8)));
typedef float f32x4 __attribute__((ext_vector_type(4)));
typedef unsigned u32x4 __attribute__((ext_vector_type(4)));
constexpr int BM = 256, BK = 64, HALF = 128, HTB = HALF * BK * 2  , STAGE_BYTES = 8 * HTB, NXCD = 8, WGM = 8;

__host__ __device__ __forceinline__ int lds_byte(int r, int c) { const int st = (r >> 4) * 2 + (c >> 5), rr = r & 15, cc = c & 31, ob = rr * 64 + cc * 2; return st * 1024 + (ob ^ (((ob >> 9) & 1) << 5)); }
__host__ __device__ __forceinline__ void stage_rc(int b, int& R, int& C) { const int st = b / 1024, sb = b % 1024, swz = sb ^ (((sb >> 9) & 1) << 5); R = (st >> 1) * 16 + swz / 64; C = (st & 1) * 32 + (swz % 64) / 2; }
__host__ __device__ __forceinline__ int perm32(int rho) { const int n = rho >> 4, i = rho & 15; return 8 * (i >> 2) + 4 * n + (i & 3); }

struct Unit { int pm, pn; };
struct Gemm { const bf16_t* A; const bf16_t* Bt; int M, N, K; };

struct StaticOrder {
    int nM, nN, nwg, G, c;
    __host__ __device__ void init(int M, int N, int G_, int c_) { nM = M / BM; nN = N / BM; nwg = nM * nN; G = G_; c = c_; }
    __host__ __device__ bool next(int i, Unit& u) const {
        const long L = (long)i * G + c; if (L >= nwg) return false;
        int wgid = (int)L; { const int q = nwg / NXCD, r = nwg % NXCD, xcd = wgid % NXCD, off = wgid / NXCD; wgid = (xcd < r ? xcd * (q + 1) : r * (q + 1) + (xcd - r) * q) + off; }
        const int nig = WGM * nN, gid = wgid / nig, fm = gid * WGM, gsz = (nM - fm) < WGM ? (nM - fm) : WGM;
        u.pm = fm + ((wgid % nig) % gsz); u.pn = (wgid % nig) / gsz; return true;
    }
    __device__ __forceinline__ void a_ready(const Unit&) const {}
    __device__ __forceinline__ void done(const Unit&) const {}
};

template <class Epi, class Sched, bool STAMP = false>
__device__ __forceinline__ void gemm_phase(PG8_LAS unsigned char* lds, const Gemm g, const Sched& S, const Epi& E, unsigned long long* stamps) {
    int tid = threadIdx.x; asm volatile("" : "+v"(tid));
    const int wid = __builtin_amdgcn_readfirstlane(tid >> 6), lane = tid & 63, wr = wid >> 2, wc = wid & 3, fr = lane & 15, fq = lane >> 4;
    const int K = g.K, nt = K / BK;
#define PG8_STAMP() do { } while (0)
    PG8_STAMP();
    unsigned voffA[2], voffB[2];
#pragma unroll
    for (int i = 0; i < 2; ++i) { int R, C; stage_rc(tid * 16 + i * 8192, R, C); const int Rb = Epi::PERM ? ((R & ~31) + perm32(R & 31)) : R;
        voffA[i] = (unsigned)(R * K + C) * 2u; voffB[i] = (unsigned)(Rb * K + C) * 2u; }
    const size_t kstep = (size_t)(BK * 2);
    const size_t hstep = (size_t)HALF * K * 2;
    const size_t tstep = 2 * hstep;
    const unsigned ldsw = (unsigned)wid * 1024u;
    const int aoff = lds_byte(wr * 64 + fr, fq * 8), boff = lds_byte(wc * 32 + fr, fq * 8);
#define PG8_SA(b, h) (((b) * 2 + (h)) * HTB)
#define PG8_SB(b, h) ((4 + (b) * 2 + (h)) * HTB)
#define PG8_STAGE(bufoff, gbase, voff) do { _Pragma("unroll") for (int _i = 0; _i < 2; ++_i) \
        __builtin_amdgcn_global_load_lds((const unsigned*)((const char*)(gbase) + (voff)[_i]), (PG8_LAS unsigned*)(lds + (bufoff) + ldsw + _i * 8192), 16, 0, 0); } while (0)
#define PG8_LDA(dst, b, h) do { _Pragma("unroll") for (int m = 0; m < 4; ++m) _Pragma("unroll") for (int k = 0; k < 2; ++k) dst[m][k] = *(const PG8_LAS bf16x8*)(lds + PG8_SA(b, h) + aoff + m * 2048 + k * 1024); } while (0)
#define PG8_LDB(dst, b, h) do { _Pragma("unroll") for (int n = 0; n < 2; ++n) _Pragma("unroll") for (int k = 0; k < 2; ++k) dst[n][k] = *(const PG8_LAS bf16x8*)(lds + PG8_SB(b, h) + boff + n * 2048 + k * 1024); } while (0)
#define PG8_MMA(ai, bj, At, Bt) do { __builtin_amdgcn_s_setprio(1); _Pragma("unroll") for (int m = 0; m < 4; ++m) _Pragma("unroll") for (int n = 0; n < 2; ++n) _Pragma("unroll") for (int k = 0; k < 2; ++k) \
        acc[ai][bj][m][n] = __builtin_amdgcn_mfma_f32_16x16x32_bf16(Bt[n][k], At[m][k], acc[ai][bj][m][n], 0, 0, 0); __builtin_amdgcn_s_setprio(0); } while (0)
#define PG8_WAIT_V(n) asm volatile("s_waitcnt vmcnt(" #n ")" ::: "memory")
#define PG8_WAIT_L(n) asm volatile("s_waitcnt lgkmcnt(" #n ")" ::: "memory")
#define PG8_BAR __builtin_amdgcn_s_barrier()
#define PG8_SCHED __builtin_amdgcn_sched_barrier(0)
    Unit cur, nxt; int ui = 0;
    if (!S.next(0, cur)) return;
    f32x4 acc[2][2][4][2];
#pragma unroll
    for (int a = 0; a < 2; ++a)
#pragma unroll
        for (int b = 0; b < 2; ++b)
#pragma unroll
            for (int m = 0; m < 4; ++m)
#pragma unroll
                for (int n = 0; n < 2; ++n) acc[a][b][m][n] = (f32x4){0.f, 0.f, 0.f, 0.f};
    bf16x8 At[4][2], B0[2][2], B1[2][2];
    const char* cA = (const char*)g.A + (size_t)cur.pm * tstep; const char* cB = (const char*)g.Bt + (size_t)cur.pn * tstep;
    S.a_ready(cur);
    PG8_STAGE(PG8_SB(0, 0), cB, voffB); PG8_STAGE(PG8_SA(0, 0), cA, voffA); PG8_STAGE(PG8_SB(0, 1), cB + hstep, voffB); PG8_STAGE(PG8_SA(0, 1), cA + hstep, voffA);
    if (wr == 1) PG8_BAR;
    PG8_WAIT_V(4); PG8_BAR;
    PG8_STAGE(PG8_SB(1, 0), cB + kstep, voffB); PG8_STAGE(PG8_SA(1, 0), cA + kstep, voffA); PG8_STAGE(PG8_SB(1, 1), cB + hstep + kstep, voffB);
    PG8_WAIT_V(6); PG8_BAR;
    PG8_STAMP();
    for (;;) {
        const bool has_next = S.next(ui + 1, nxt);
        const char* nA = has_next ? (const char*)g.A + (size_t)nxt.pm * tstep : cA; const char* nB = has_next ? (const char*)g.Bt + (size_t)nxt.pn * tstep : cB;
        for (int t = 0; t < nt; t += 2) {
            const bool last = (t == nt - 2);
            const char* a1 = cA + (size_t)(t + 1) * kstep;
            const char* a2 = last ? nA : cA + (size_t)(t + 2) * kstep; const char* b2 = last ? nB : cB + (size_t)(t + 2) * kstep;
            const char* a3 = a2 + kstep; const char* b3 = b2 + kstep;
            if (last && has_next) S.a_ready(nxt);
            PG8_LDB(B0, 0, 0); PG8_SCHED; PG8_LDA(At, 0, 0); PG8_STAGE(PG8_SA(1, 1), a1 + hstep, voffA);
            PG8_WAIT_L(8); PG8_BAR; PG8_WAIT_L(0); PG8_MMA(0, 0, At, B0); PG8_BAR; PG8_SCHED;
            PG8_LDB(B1, 0, 1); PG8_STAGE(PG8_SB(0, 0), b2, voffB);
            PG8_BAR; PG8_WAIT_L(0); PG8_MMA(0, 1, At, B1); PG8_BAR;
            PG8_LDA(At, 0, 1); PG8_STAGE(PG8_SA(0, 0), a2, voffA);
            PG8_BAR; PG8_WAIT_L(0); PG8_MMA(1, 0, At, B0); PG8_BAR; PG8_SCHED;
            PG8_STAGE(PG8_SB(0, 1), b2 + hstep, voffB);
            PG8_WAIT_V(6); PG8_BAR; PG8_MMA(1, 1, At, B1); PG8_BAR;
            PG8_LDB(B0, 1, 0); PG8_SCHED; PG8_LDA(At, 1, 0); PG8_STAGE(PG8_SA(0, 1), a2 + hstep, voffA);
            PG8_WAIT_L(8); PG8_BAR; PG8_WAIT_L(0); PG8_MMA(0, 0, At, B0); PG8_BAR; PG8_SCHED;
            PG8_LDB(B1, 1, 1); PG8_STAGE(PG8_SB(1, 0), b3, voffB);
            PG8_BAR; PG8_WAIT_L(0); PG8_MMA(0, 1, At, B1); PG8_BAR;
            PG8_LDA(At, 1, 1); PG8_STAGE(PG8_SA(1, 0), a3, voffA);
            PG8_BAR; PG8_WAIT_L(0); PG8_MMA(1, 0, At, B0); PG8_BAR; PG8_SCHED;
            PG8_STAGE(PG8_SB(1, 1), b3 + hstep, voffB);
            PG8_WAIT_V(6); PG8_BAR; PG8_MMA(1, 1, At, B1); PG8_BAR;
        }
        PG8_STAMP();
        if constexpr (!Epi::AFTER_DRAIN) { E(acc, cur, wr, wc, fr, fq); S.done(cur); }
        PG8_STAMP();
        if (!has_next) break;
#pragma unroll
        for (int a = 0; a < 2; ++a)
#pragma unroll
            for (int b = 0; b < 2; ++b)
#pragma unroll
                for (int m = 0; m < 4; ++m)
#pragma unroll
                    for (int n = 0; n < 2; ++n) acc[a][b][m][n] = (f32x4){0.f, 0.f, 0.f, 0.f};
        cur = nxt; cA = nA; cB = nB; ++ui;
    }
    PG8_WAIT_V(0);
    if (wr == 0) PG8_BAR;
    PG8_BAR;
    if constexpr (Epi::AFTER_DRAIN) { E.fused(acc, cur, wr, wc, fr, fq, lds, wid, lane); S.done(cur); }
    PG8_STAMP();
#undef PG8_STAMP
#undef PG8_SA
#undef PG8_SB
#undef PG8_STAGE
#undef PG8_LDA
#undef PG8_LDB
#undef PG8_MMA
#undef PG8_WAIT_V
#undef PG8_WAIT_L
#undef PG8_BAR
#undef PG8_SCHED
}
}

DEV void transpose_convert(const float* __restrict__ W, int K, int N, int Npad, bf16_t* Wt, float* sm) {
    float (*T)[65] = (float (*)[65])sm;
    const int tid = opaque_tid();
    const int kt = K / 64, ntl = Npad / 64;
    for (int tile = blockIdx.x; tile < kt * ntl; tile += gridDim.x) {
        const int k0 = (tile / ntl) * 64, n0 = (tile % ntl) * 64;
        __syncthreads();
#pragma unroll
        for (int i = 0; i < 2; ++i) {
            const int k = (tid >> 4) + 32 * i, n4 = (tid & 15) * 4;
            float4 v = make_float4(0.f, 0.f, 0.f, 0.f);
            if (n0 + n4 < N) v = ld4(W + (size_t)(k0 + k) * N + n0 + n4);
            T[k][n4] = v.x; T[k][n4 + 1] = v.y; T[k][n4 + 2] = v.z; T[k][n4 + 3] = v.w;
        }
        __syncthreads();
        const int n = tid >> 3, kq = (tid & 7) * 8;
        unsigned o[4];
#pragma unroll
        for (int j = 0; j < 4; ++j) o[j] = pack2bf(T[kq + 2 * j][n], T[kq + 2 * j + 1][n]);
        bf16_t* dst = Wt + (size_t)(n0 + n) * K + k0 + kq;
        *(uint4*)dst = make_uint4(o[0], o[1], o[2], o[3]);
    }
}

struct EpBf16 {
    static constexpr bool PERM = true, AFTER_DRAIN = false;
    bf16_t* O; int ldc; int ncols;
    DEV void operator()(const pg8::f32x4 (&acc)[2][2][4][2], const pg8::Unit& u, int wr, int wc, int fr, int fq) const {
        const int row0 = u.pm * 256 + wr * 64 + fr, col0 = u.pn * 256 + wc * 32 + 8 * fq;
#pragma unroll
        for (int ai = 0; ai < 2; ++ai)
#pragma unroll
            for (int m = 0; m < 4; ++m) {
                bf16_t* rowp = O + (size_t)(row0 + ai * 128 + m * 16) * ldc + col0;
#pragma unroll
                for (int bj = 0; bj < 2; ++bj) {
                    if (col0 + bj * 128 < ncols) {
                        const pg8::f32x4 v0 = acc[ai][bj][m][0], v1 = acc[ai][bj][m][1];
                        *(uint4*)(rowp + bj * 128) = make_uint4(pack2bf(v0[0], v0[1]), pack2bf(v0[2], v0[3]), pack2bf(v1[0], v1[1]), pack2bf(v1[2], v1[3]));
                    }
                }
            }
    }
};
struct EpRes0 {
    static constexpr bool PERM = false, AFTER_DRAIN = false;
    float* C; const float* lat; const float* cx; const float* mv; int b;
    DEV void operator()(const pg8::f32x4 (&acc)[2][2][4][2], const pg8::Unit& u, int wr, int wc, int fr, int fq) const {
        const bool isc = (u.pm * 256 < NCX);
        const float* base = isc ? cx + (size_t)b * NCX * DM : lat + ((size_t)b * NL - NCX) * DM;
        const float* gp = mv + (isc ? 2 : b) * 3072 + 2048;
        const int row0 = u.pm * 256 + wr * 64 + fr, col0 = u.pn * 256 + wc * 32 + 4 * fq;
#pragma unroll
        for (int ai = 0; ai < 2; ++ai)
#pragma unroll
            for (int m = 0; m < 4; ++m) {
                const size_t ro = (size_t)(row0 + ai * 128 + m * 16) * DM + col0;
#pragma unroll
                for (int bj = 0; bj < 2; ++bj)
#pragma unroll
                    for (int n = 0; n < 2; ++n) {
                        const int co = bj * 128 + n * 16;
                        const float4 x = ld4(base + ro + co), g = ld4(gp + col0 + co); const pg8::f32x4 v = acc[ai][bj][m][n];
                        st4(C + ro + co, make_float4(ALPHA * x.x + g.x * v[0], ALPHA * x.y + g.y * v[1], ALPHA * x.z + g.z * v[2], ALPHA * x.w + g.w * v[3]));
                    }
            }
    }
};
struct EpRes1 {
    static constexpr bool PERM = false, AFTER_DRAIN = false;
    float* C; const float* lat; const float* mv;
    DEV void operator()(const pg8::f32x4 (&acc)[2][2][4][2], const pg8::Unit& u, int wr, int wc, int fr, int fq) const {
        const float* gp = mv + (u.pm * 256 >= NL ? 1 : 0) * 3072 + 2048;
        const int row0 = u.pm * 256 + wr * 64 + fr, col0 = u.pn * 256 + wc * 32 + 4 * fq;
#pragma unroll
        for (int ai = 0; ai < 2; ++ai)
#pragma unroll
            for (int m = 0; m < 4; ++m) {
                const size_t ro = (size_t)(row0 + ai * 128 + m * 16) * DM + col0;
#pragma unroll
                for (int bj = 0; bj < 2; ++bj)
#pragma unroll
                    for (int n = 0; n < 2; ++n) {
                        const int co = bj * 128 + n * 16;
                        const float4 x = ld4(lat + ro + co), g = ld4(gp + col0 + co); const pg8::f32x4 v = acc[ai][bj][m][n];
                        st4(C + ro + co, make_float4(ALPHA * x.x + g.x * v[0], ALPHA * x.y + g.y * v[1], ALPHA * x.z + g.z * v[2], ALPHA * x.w + g.w * v[3]));
                    }
            }
    }
};
template <class EP>
DEV void run_gemm(const bf16_t* A, const bf16_t* Bt, int M, int N, int K, const EP& ep, float* sm) {
    pg8::Gemm g{A, Bt, M, N, K}; pg8::StaticOrder S; S.init(M, N, (int)gridDim.x, (int)blockIdx.x);
    pg8::gemm_phase<EP, pg8::StaticOrder, false>((PG8_LAS unsigned char*)sm, g, S, ep, nullptr);
}

DEV void phase_h0(const Params& p, int b) {
    const float* modv = (const float*)(p.ws + OFF_MODV);
    bf16_t* H0 = (bf16_t*)(p.ws + OFF_YC);
    const int gt = blockIdx.x * NTHR + opaque_tid(), gn = gridDim.x * NTHR;
    for (int i = gt; i < TB * 128; i += gn) {
        const int s = i >> 7, k = (i & 127) * 8;
        const float* src; int j;
        if (s < NCX) { src = p.in[2] + ((size_t)(b * NCX + s)) * DM + k; j = 2; }
        else { src = p.in[0] + ((size_t)(b * NL + s - NCX)) * DM + k; j = b; }
        const float4 x0 = ld4(src), x1 = ld4(src + 4);
        const float* m = modv + j * 3072;
        const float4 s0 = ld4(m + k), s1 = ld4(m + k + 4), c0 = ld4(m + 1024 + k), c1 = ld4(m + 1024 + k + 4);
        *(uint4*)(H0 + (size_t)s * DM + k) = make_uint4(pack2bf(x0.x * (1.f + c0.x) + s0.x, x0.y * (1.f + c0.y) + s0.y), pack2bf(x0.z * (1.f + c0.z) + s0.z, x0.w * (1.f + c0.w) + s0.w),
                                                      pack2bf(x1.x * (1.f + c1.x) + s1.x, x1.y * (1.f + c1.y) + s1.y), pack2bf(x1.z * (1.f + c1.z) + s1.z, x1.w * (1.f + c1.w) + s1.w));
    }
}

DEV void phase_mod(const Params& p, float* sm) {
    const float* c = p.in[1]; const float* cctx = p.in[3];
    const float* mod_w = p.in[4]; const float* mod_b = p.in[5];
    float* modv = (float*)(p.ws + OFF_MODV);
    float* sil = sm; float* red = sm + 3072;
    const int tid = opaque_tid();
    for (int i = tid; i < 3072; i += NTHR) {
        const int j = i >> 10, k = i & 1023;
        const float v = (j < 2) ? c[j * 1024 + k] : cctx[k];
        sil[i] = silu_f(v);
    }
    __syncthreads();
    for (int unit = blockIdx.x; unit < 192; unit += gridDim.x) {
        const int l = unit / 96, cb = unit % 96;
        const int kg = tid >> 5, col = tid & 31, n = cb * 32 + col;
        const float* w = mod_w + (size_t)l * 1024 * 3072 + n;
        float a0 = 0.f, a1 = 0.f, a2 = 0.f;
        for (int k = kg * 64; k < kg * 64 + 64; ++k) {
            const float wv = w[(size_t)k * 3072];
            a0 += sil[k] * wv; a1 += sil[1024 + k] * wv; a2 += sil[2048 + k] * wv;
        }
        red[(kg * 3 + 0) * 32 + col] = a0; red[(kg * 3 + 1) * 32 + col] = a1; red[(kg * 3 + 2) * 32 + col] = a2;
        __syncthreads();
        if (tid < 96) {
            const int j = tid >> 5, cc = tid & 31, nn = cb * 32 + cc;
            float s = mod_b[l * 3072 + nn];
            for (int g = 0; g < 16; ++g) s += red[(g * 3 + j) * 32 + cc];
            modv[(l * 3 + j) * 3072 + nn] = s;
        }
        __syncthreads();
    }
}

DEV void phase_tables(const Params& p) {
    const float* wq = p.in[33]; const float* wk = p.in[34]; const float* wv = p.in[35];
    const float* gw0 = p.in[36]; const float* gw1 = p.in[38]; const float* gw2 = p.in[40]; const float* gw3 = p.in[42];
    float* gtab = (float*)(p.ws + OFF_GTAB); bf16_t* wft = (bf16_t*)(p.ws + OFF_WFT);
    const int gt = blockIdx.x * NTHR + opaque_tid(), gn = gridDim.x * NTHR;
    for (int i = gt; i < 512 * 16; i += gn) {
        const int gb = i >> 4, cp = (i >> 2) & 3, c = i & 3;
        float s = 0.f;
#pragma unroll
        for (int d = 0; d < 4; ++d) s += wq[gb * 16 + cp * 4 + d] * wk[gb * 16 + c * 4 + d];
        gtab[i] = s * KSCALE;
    }
    for (int i = gt; i < 4096 * 16; i += gn) {
        const int g = i >> 12, k = i & 4095, gm = g >> 2, hd = g & 3;
        const float* wg = gm == 0 ? gw0 : (gm == 1 ? gw1 : (gm == 2 ? gw2 : gw3));
        float s = 0.f;
        if (k < 2048) {
            const int blk = k >> 2, cc = k & 3;
#pragma unroll
            for (int d = 0; d < 4; ++d) s += wq[blk * 16 + cc * 4 + d] * wg[(size_t)(4 * blk + d) * 4 + hd] + wk[blk * 16 + cc * 4 + d] * wg[(size_t)(2048 + 4 * blk + d) * 4 + hd];
        } else {
            const int kk = k - 2048, blk = kk >> 2, cc = kk & 3;
#pragma unroll
            for (int d = 0; d < 4; ++d) s += wv[blk * 16 + cc * 4 + d] * wg[(size_t)(4096 + 4 * blk + d) * 4 + hd];
        }
        wft[i] = __builtin_bit_cast(unsigned short, (__bf16)s);
    }
}

DEV float wave_scan_add(float v, int lane, int dir) {
#pragma unroll
    for (int o = 1; o < 64; o <<= 1) {
        const float n = dir ? __shfl_down(v, o, 64) : __shfl_up(v, o, 64);
        const bool ok = dir ? (lane + o < 64) : (lane >= o);
        if (ok) v += n;
    }
    return v;
}
DEV float wave_scan_max(float v, int lane, int dir) {
#pragma unroll
    for (int o = 1; o < 64; o <<= 1) {
        const float n = dir ? __shfl_down(v, o, 64) : __shfl_up(v, o, 64);
        const bool ok = dir ? (lane + o < 64) : (lane >= o);
        if (ok) v = fmaxf(v, n);
    }
    return v;
}

DEV void gla_decay(const bf16_t* P0, int c, int h, int dir, const float* __restrict__ wa2, const float* __restrict__ ba,
                   float* sLR, float* sWA, float* sBC, float* sTot, int tid) {
    for (int i = tid; i < 1024; i += NTHR) { const int t = i >> 4, j = i & 15; sLR[i] = bf2f(P0[(size_t)(c * 64 + t) * EIN + 1536 + dir * 16 + j]); }
    for (int i = tid; i < 1024; i += NTHR) { const int ii = i >> 6, k = i & 63; sWA[i] = wa2[ii * 256 + h * 64 + k]; }
    __syncthreads();
    {
        const int t = tid >> 3, k0 = (tid & 7) * 8;
        float acc[8];
#pragma unroll
        for (int j = 0; j < 8; ++j) acc[j] = ba[h * 64 + k0 + j];
#pragma unroll
        for (int ii = 0; ii < 16; ++ii) {
            const float l = sLR[t * 16 + ii];
#pragma unroll
            for (int j = 0; j < 8; ++j) acc[j] += l * sWA[ii * 64 + k0 + j];
        }
#pragma unroll
        for (int j = 0; j < 8; ++j) sBC[t * 65 + k0 + j] = logsig_f(acc[j]) * 0.0625f;
    }
    __syncthreads();
    {
        const int lane = tid & 63, wv = tid >> 6;
#pragma unroll
        for (int j = 0; j < 8; ++j) {
            const int k = wv * 8 + j;
            const float v = wave_scan_add(sBC[lane * 65 + k], lane, dir);
            sBC[lane * 65 + k] = v;
            if (lane == (dir ? 0 : 63)) sTot[k] = v;
        }
    }
    __syncthreads();
}
DEV bf16x8 tr_frag(const bf16_t* base, int ld, int row0, int col0, int lane) {
    const bf16_t* ptr = base + (row0 + (lane >> 4) * 8 + ((lane & 15) >> 2)) * ld + col0 + (lane & 3) * 4;
    const s16x4 lo = __builtin_amdgcn_ds_read_tr16_b64_v4i16((__attribute__((address_space(3))) s16x4*)ptr);
    const s16x4 hi = __builtin_amdgcn_ds_read_tr16_b64_v4i16((__attribute__((address_space(3))) s16x4*)(ptr + 4 * ld));
    return (bf16x8){lo[0], lo[1], lo[2], lo[3], hi[0], hi[1], hi[2], hi[3]};
}
DEV bf16x8 row_frag(const bf16_t* base, int ld, int idx0, int k0, int lane) {
    return *(const bf16x8*)(base + (idx0 + (lane & 15)) * ld + k0 + (lane >> 4) * 8);
}

DEV void gla1_unit(const Params& p, int h, int dir, int c, float* sm) {
    const int tid = opaque_tid(), lane = tid & 63, wave = tid >> 6;
    const bf16_t* P0 = (const bf16_t*)(p.ws + OFF_P0);
    float* GDS = (float*)(p.ws + OFF_GDS); float* GDEC = (float*)(p.ws + OFF_GDEC);
    const float* wa2 = p.in[dir ? 12 : 10]; const float* ba = p.in[dir ? 13 : 11];
    float* sLR = sm; float* sWA = sm + 1024; float* sBC = sm + 2048; float* sTot = sm + 6208;
    bf16_t* kT = (bf16_t*)(sm + 6272);
    bf16_t* Vs = (bf16_t*)(sm + 8576);
    const int ch = h * 2 + dir;
    __syncthreads();
    gla_decay(P0, c, h, dir, wa2, ba, sLR, sWA, sBC, sTot, tid);
    {
        const int t = tid >> 3, k0 = (tid & 7) * 8;
        float kv[8]; unpack8(*(const uint4*)(P0 + (size_t)(c * 64 + t) * EIN + 256 + h * 64 + k0), kv);
#pragma unroll
        for (int j = 0; j < 8; ++j) kT[(k0 + j) * 72 + t] = __builtin_bit_cast(unsigned short, (__bf16)(kv[j] * fexp(sTot[k0 + j] - sBC[t * 65 + k0 + j])));
#pragma unroll
        for (int u = 0; u < 2; ++u) { const int i = tid + 512 * u, row = i >> 4, c16 = i & 15; *(uint4*)(Vs + row * 136 + c16 * 8) = *(const uint4*)(P0 + (size_t)(c * 64 + row) * EIN + 512 + h * 128 + c16 * 8); }
    }
    __syncthreads();
    {
        f32x4 acc[4];
#pragma unroll
        for (int kt = 0; kt < 4; ++kt) acc[kt] = (f32x4){0.f, 0.f, 0.f, 0.f};
#pragma unroll
        for (int ks = 0; ks < 2; ++ks) {
            const bf16x8 af = tr_frag(Vs, 136, ks * 32, wave * 16, lane);
#pragma unroll
            for (int kt = 0; kt < 4; ++kt) acc[kt] = __builtin_amdgcn_mfma_f32_16x16x32_bf16(af, row_frag(kT, 72, kt * 16, ks * 32, lane), acc[kt], 0, 0, 0);
        }
#pragma unroll
        for (int kt = 0; kt < 4; ++kt) {
            const int k = kt * 16 + (lane & 15), v = wave * 16 + (lane >> 4) * 4;
            st4(GDS + ((size_t)(ch * NCH + c) * 64 + k) * 128 + v, make_float4(acc[kt][0], acc[kt][1], acc[kt][2], acc[kt][3]));
        }
    }
    if (tid < 64) GDEC[(size_t)(ch * NCH + c) * 64 + tid] = fexp(sTot[tid]);
}

DEV void gla2_unit(const Params& p, int unit) {
    const int tid = opaque_tid();
    float* GDS = (float*)(p.ws + OFF_GDS); const float* GDEC = (const float*)(p.ws + OFF_GDEC);
    const int ch = unit >> 4, e = (unit & 15) * 512 + tid, k = e >> 7, dir = ch & 1;
    float S = 0.f;
#pragma unroll 12
    for (int step = 0; step < NCH; ++step) {
        const int c = chunk_at(dir, step);
        float* gp = GDS + (size_t)(ch * NCH + c) * 8192 + e;
        const float d = GDEC[(size_t)(ch * NCH + c) * 64 + k], inc = *gp;
        *gp = S;
        S = d * S + inc;
    }
}

DEV void gla3_unit(const Params& p, int h, int c, float* sm) {
    const int tid = opaque_tid(), lane = tid & 63, wave = tid >> 6;
    const bf16_t* P0 = (const bf16_t*)(p.ws + OFF_P0);
    const float* GDS = (const float*)(p.ws + OFF_GDS);
    bf16_t* YC = (bf16_t*)(p.ws + OFF_YC);
    const float* ng = p.in[14];
    float* sLR = sm; float* sWA = sm + 1024; float* sBC = sm + 2048; float* sTot = sm + 6208;
    bf16_t* qt = (bf16_t*)(sm + 6272);
    bf16_t* kt = (bf16_t*)(sm + 8576);
    bf16_t* Sm = (bf16_t*)(sm + 10880);
    bf16_t* S0s = (bf16_t*)(sm + 13184);
    bf16_t* Vs = (bf16_t*)(sm + 17536);
    float* O = sm + 21888;
    const int ti = wave & 3, vt0 = (wave >> 2) * 4;
    f32x4 acc[4];
#pragma unroll
    for (int j = 0; j < 4; ++j) acc[j] = (f32x4){0.f, 0.f, 0.f, 0.f};
    __syncthreads();
#pragma unroll
    for (int u = 0; u < 2; ++u) { const int i = tid + 512 * u, row = i >> 4, c16 = i & 15; *(uint4*)(Vs + row * 136 + c16 * 8) = *(const uint4*)(P0 + (size_t)(c * 64 + row) * EIN + 512 + h * 128 + c16 * 8); }
#pragma unroll 1
    for (int dir = 0; dir < 2; ++dir) {
        const float* wa2 = p.in[dir ? 12 : 10]; const float* ba = p.in[dir ? 13 : 11];
        const int ch = h * 2 + dir;
        __syncthreads();
        gla_decay(P0, c, h, dir, wa2, ba, sLR, sWA, sBC, sTot, tid);
        {
            const int t = tid >> 3, k0 = (tid & 7) * 8;
            float qv[8], kv[8];
            unpack8(*(const uint4*)(P0 + (size_t)(c * 64 + t) * EIN + h * 64 + k0), qv);
            unpack8(*(const uint4*)(P0 + (size_t)(c * 64 + t) * EIN + 256 + h * 64 + k0), kv);
#pragma unroll
            for (int j = 0; j < 8; ++j) { const float bc = sBC[t * 65 + k0 + j]; qv[j] *= 0.125f * fexp(bc); kv[j] *= fexp(-bc); }
            *(uint4*)(qt + t * 72 + k0) = make_uint4(pack2bf(qv[0], qv[1]), pack2bf(qv[2], qv[3]), pack2bf(qv[4], qv[5]), pack2bf(qv[6], qv[7]));
            *(uint4*)(kt + t * 72 + k0) = make_uint4(pack2bf(kv[0], kv[1]), pack2bf(kv[2], kv[3]), pack2bf(kv[4], kv[5]), pack2bf(kv[6], kv[7]));
#pragma unroll
            for (int u = 0; u < 4; ++u) {
                const int i = tid + 512 * u, k = i >> 5, v4 = (i & 31) * 4;
                const float4 s4 = ld4(GDS + (size_t)(ch * NCH + c) * 8192 + k * 128 + v4);
                *(uint2*)(S0s + k * 136 + v4) = make_uint2(pack2bf(s4.x, s4.y), pack2bf(s4.z, s4.w));
            }
        }
        __syncthreads();
        {
            const int si = wave & 3;
#pragma unroll
            for (int jj = 0; jj < 2; ++jj) {
                const int t2 = (wave >> 2) * 2 + jj;
                f32x4 a = (f32x4){0.f, 0.f, 0.f, 0.f};
#pragma unroll
                for (int ks = 0; ks < 2; ++ks) a = __builtin_amdgcn_mfma_f32_16x16x32_bf16(row_frag(kt, 72, si * 16, ks * 32, lane), row_frag(qt, 72, t2 * 16, ks * 32, lane), a, 0, 0, 0);
                const int t = t2 * 16 + (lane & 15), s0 = si * 16 + (lane >> 4) * 4;
                float m[4];
#pragma unroll
                for (int r = 0; r < 4; ++r) { const bool keep = dir ? (s0 + r >= t) : (s0 + r <= t); m[r] = keep ? a[r] : 0.f; }
                *(uint2*)(Sm + t * 72 + s0) = make_uint2(pack2bf(m[0], m[1]), pack2bf(m[2], m[3]));
            }
        }
        __syncthreads();
#pragma unroll
        for (int ks = 0; ks < 2; ++ks) {
            const bf16x8 a1 = row_frag(qt, 72, ti * 16, ks * 32, lane), a2 = row_frag(Sm, 72, ti * 16, ks * 32, lane);
#pragma unroll
            for (int j = 0; j < 4; ++j) {
                acc[j] = __builtin_amdgcn_mfma_f32_16x16x32_bf16(a1, tr_frag(S0s, 136, ks * 32, (vt0 + j) * 16, lane), acc[j], 0, 0, 0);
                acc[j] = __builtin_amdgcn_mfma_f32_16x16x32_bf16(a2, tr_frag(Vs, 136, ks * 32, (vt0 + j) * 16, lane), acc[j], 0, 0, 0);
            }
        }
    }
#pragma unroll
    for (int j = 0; j < 4; ++j)
#pragma unroll
        for (int r = 0; r < 4; ++r) O[(ti * 16 + (lane >> 4) * 4 + r) * 132 + (vt0 + j) * 16 + (lane & 15)] = acc[j][r];
    __syncthreads();
    {
        const int t = tid >> 3, v0 = (tid & 7) * 16;
        float o[16];
        float ss = 0.f;
#pragma unroll
        for (int i = 0; i < 16; ++i) { o[i] = O[t * 132 + v0 + i]; ss += o[i] * o[i]; }
        ss += __shfl_xor(ss, 1, 64); ss += __shfl_xor(ss, 2, 64); ss += __shfl_xor(ss, 4, 64);
        const float rms = rsqrtf(ss * (1.f / 128.f) + 1e-5f);
        float g[16];
        const bf16_t* gp = P0 + (size_t)(c * 64 + t) * EIN + 1024 + h * 128 + v0;
        unpack8(*(const uint4*)gp, g); unpack8(*(const uint4*)(gp + 8), g + 8);
        float y[16];
#pragma unroll
        for (int i = 0; i < 16; ++i) y[i] = o[i] * rms * ng[v0 + i] * silu_f(g[i]);
        bf16_t* yp = YC + (size_t)(c * 64 + t) * 1024 + h * 128 + v0;
        *(uint4*)yp = make_uint4(pack2bf(y[0], y[1]), pack2bf(y[2], y[3]), pack2bf(y[4], y[5]), pack2bf(y[6], y[7]));
        *(uint4*)(yp + 8) = make_uint4(pack2bf(y[8], y[9]), pack2bf(y[10], y[11]), pack2bf(y[12], y[13]), pack2bf(y[14], y[15]));
    }
}

DEV void load8bf(const bf16_t* ptr, float* f) { unpack8(*(const uint4*)ptr, f); }
DEV void rw_mix8(const bf16_t* P0, int s, int cb, const float* __restrict__ mu, float* out) {
    float own[8]; load8bf(P0 + (size_t)s * EIN + RW0 + cb, own);
    int nL = -1, nR = -1, nU = -1, nD = -1;
    if (s < NCX) { if (s > 0) nL = s - 1; if (s < NCX - 1) nR = s + 1; }
    else { const int n = s - NCX, rr = n >> 6, cc = n & 63; if (cc > 0) nL = s - 1; if (cc < 63) nR = s + 1; if (rr > 0) nU = s - 64; if (rr < 127) nD = s + 64; }
    float fL[8], fR[8], fU[8], fD[8];
#pragma unroll
    for (int i = 0; i < 8; ++i) { fL[i] = 0.f; fR[i] = 0.f; fU[i] = 0.f; fD[i] = 0.f; }
    if (nL >= 0) load8bf(P0 + (size_t)nL * EIN + RW0 + cb, fL);
    if (nR >= 0) load8bf(P0 + (size_t)nR * EIN + RW0 + cb, fR);
    if (nU >= 0) load8bf(P0 + (size_t)nU * EIN + RW0 + cb, fU);
    if (nD >= 0) load8bf(P0 + (size_t)nD * EIN + RW0 + cb, fD);
    const float4 m0 = ld4(mu + cb), m1 = ld4(mu + cb + 4);
    const float m[8] = {m0.x, m0.y, m0.z, m0.w, m1.x, m1.y, m1.z, m1.w};
#pragma unroll
    for (int i = 0; i < 8; ++i) { const float nb = (i & 3) == 0 ? fL[i] : ((i & 3) == 1 ? fR[i] : ((i & 3) == 2 ? fU[i] : fD[i])); out[i] = own[i] + (nb - own[i]) * m[i]; }
}
DEV uint4 pack8(const float* f) { return make_uint4(pack2bf(f[0], f[1]), pack2bf(f[2], f[3]), pack2bf(f[4], f[5]), pack2bf(f[6], f[7])); }

template <int XM, int YM, class F>
DEV void mm64(const bf16_t* X, const bf16_t* Y, F f, int lane, int wave) {
#pragma unroll
    for (int q = 0; q < 2; ++q) {
        const int idx = wave * 2 + q, ti = idx >> 2, tj = idx & 3;
        f32x4 acc = (f32x4){0.f, 0.f, 0.f, 0.f};
#pragma unroll
        for (int ks = 0; ks < 2; ++ks) {
            const bf16x8 a = XM == 0 ? row_frag(X, 72, ti * 16, ks * 32, lane) : tr_frag(X, 72, ks * 32, ti * 16, lane);
            const bf16x8 bq = YM == 0 ? row_frag(Y, 72, tj * 16, ks * 32, lane) : tr_frag(Y, 72, ks * 32, tj * 16, lane);
            acc = __builtin_amdgcn_mfma_f32_16x16x32_bf16(a, bq, acc, 0, 0, 0);
        }
        f(ti * 16 + (lane >> 4) * 4, tj * 16 + (lane & 15), acc);
    }
}
template <int XM, int YM, class F>
DEV void mm64x2(const bf16_t* X1, const bf16_t* Y1, const bf16_t* X2, const bf16_t* Y2, F f, int lane, int wave) {
#pragma unroll
    for (int q = 0; q < 2; ++q) {
        const int idx = wave * 2 + q, ti = idx >> 2, tj = idx & 3;
        f32x4 acc = (f32x4){0.f, 0.f, 0.f, 0.f};
#pragma unroll
        for (int ks = 0; ks < 2; ++ks) {
            const bf16x8 a = XM == 0 ? row_frag(X1, 72, ti * 16, ks * 32, lane) : tr_frag(X1, 72, ks * 32, ti * 16, lane);
            const bf16x8 bq = YM == 0 ? row_frag(Y1, 72, tj * 16, ks * 32, lane) : tr_frag(Y1, 72, ks * 32, tj * 16, lane);
            acc = __builtin_amdgcn_mfma_f32_16x16x32_bf16(a, bq, acc, 0, 0, 0);
            const bf16x8 a2 = XM == 0 ? row_frag(X2, 72, ti * 16, ks * 32, lane) : tr_frag(X2, 72, ks * 32, ti * 16, lane);
            const bf16x8 b2 = YM == 0 ? row_frag(Y2, 72, tj * 16, ks * 32, lane) : tr_frag(Y2, 72, ks * 32, tj * 16, lane);
            acc = __builtin_amdgcn_mfma_f32_16x16x32_bf16(a2, b2, acc, 0, 0, 0);
        }
        f(ti * 16 + (lane >> 4) * 4, tj * 16 + (lane & 15), acc);
    }
}
DEV void st_img(bf16_t* P, int i0, int j, float a0, float a1, float a2, float a3) {
    P[(i0 + 0) * 72 + j] = __builtin_bit_cast(unsigned short, (__bf16)a0); P[(i0 + 1) * 72 + j] = __builtin_bit_cast(unsigned short, (__bf16)a1);
    P[(i0 + 2) * 72 + j] = __builtin_bit_cast(unsigned short, (__bf16)a2); P[(i0 + 3) * 72 + j] = __builtin_bit_cast(unsigned short, (__bf16)a3);
}

DEV void rwkv1_unit(const Params& p, int h, int dir, int c, float* sm) {
    const int tid = opaque_tid(), lane = tid & 63, wave = tid >> 6;
    const bf16_t* P0 = (const bf16_t*)(p.ws + OFF_P0);
    bf16_t* RU = (bf16_t*)(p.ws + OFF_RU) + (size_t)((h * 2 + dir) * NCH + c) * 16384;
    float* BONS = (float*)(p.ws + OFF_BONS);
    const float* mu = p.in[15];
    const float* w0 = p.in[dir ? 18 : 16]; const float* ww2 = p.in[dir ? 19 : 17];
    const float* a0 = p.in[dir ? 22 : 20]; const float* wa2 = p.in[dir ? 23 : 21];
    bf16_t* img = (bf16_t*)sm;
#define SLOT(i_) (img + (i_) * 4608)
    float* fLW = (float*)SLOT(10);
    float* fAS = (float*)SLOT(12);
    float* sv = (float*)SLOT(14);
    const int t = tid >> 3, j0 = (tid & 7) * 8, s = c * 64 + t;
    __syncthreads();
    if (tid < 64) { const int hc = h * 64 + tid; sv[64 + tid] = w0[hc]; sv[128 + tid] = a0[hc]; sv[192 + tid] = p.in[24][hc]; sv[256 + tid] = p.in[25][hc]; sv[320 + tid] = p.in[26][hc]; }
    float r8[8], k8[8], v8[8];
    {
        float x8[8];
        rw_mix8(P0, s, h * 64 + j0, mu, r8);
        rw_mix8(P0, s, 512 + h * 64 + j0, mu, k8);
        rw_mix8(P0, s, 1024 + h * 64 + j0, mu, v8);
        rw_mix8(P0, s, 2048 + dir * 64 + j0, mu, x8);
#pragma unroll
        for (int i = 0; i < 8; ++i) x8[i] = tanh_f(x8[i]);
        *(uint4*)(SLOT(6) + t * 72 + j0) = pack8(x8);
        rw_mix8(P0, s, 2176 + dir * 64 + j0, mu, x8);
        *(uint4*)(SLOT(7) + t * 72 + j0) = pack8(x8);
        float wq[8];
        { const float4 q0 = ld4(ww2 + (size_t)t * 512 + h * 64 + j0), q1 = ld4(ww2 + (size_t)t * 512 + h * 64 + j0 + 4); wq[0] = q0.x; wq[1] = q0.y; wq[2] = q0.z; wq[3] = q0.w; wq[4] = q1.x; wq[5] = q1.y; wq[6] = q1.z; wq[7] = q1.w; }
        *(uint4*)(SLOT(8) + t * 72 + j0) = pack8(wq);
        { const float4 q0 = ld4(wa2 + (size_t)t * 512 + h * 64 + j0), q1 = ld4(wa2 + (size_t)t * 512 + h * 64 + j0 + 4); wq[0] = q0.x; wq[1] = q0.y; wq[2] = q0.z; wq[3] = q0.w; wq[4] = q1.x; wq[5] = q1.y; wq[6] = q1.z; wq[7] = q1.w; }
        *(uint4*)(SLOT(9) + t * 72 + j0) = pack8(wq);
    }
    __syncthreads();
    mm64<0, 1>(SLOT(6), SLOT(8), [=](int i0, int j, f32x4 a) {
#pragma unroll
        for (int r = 0; r < 4; ++r) fLW[(i0 + r) * 65 + j] = -0.6065306597f * sigmoid_f(sv[64 + j] + a[r]); }, lane, wave);
    mm64<0, 1>(SLOT(7), SLOT(9), [=](int i0, int j, f32x4 a) {
#pragma unroll
        for (int r = 0; r < 4; ++r) fAS[(i0 + r) * 65 + j] = sigmoid_f(sv[128 + j] + a[r]); }, lane, wave);
    __syncthreads();
#pragma unroll
    for (int j = 0; j < 8; ++j) {
        const int k = wave * 8 + j;
        const float v = wave_scan_add(fLW[lane * 65 + k], lane, dir);
        fLW[lane * 65 + k] = v;
        if (lane == (dir ? 0 : 63)) sv[k] = v;
    }
    __syncthreads();
    {
        float kkv[8], ss = 0.f;
#pragma unroll
        for (int i = 0; i < 8; ++i) { kkv[i] = k8[i] * sv[192 + j0 + i]; ss += kkv[i] * kkv[i]; }
        ss += __shfl_xor(ss, 1, 64); ss += __shfl_xor(ss, 2, 64); ss += __shfl_xor(ss, 4, 64);
        const float rn = rsqrtf(fmaxf(ss, 1e-24f));
        float fa[8], fb[8], fk[8], fr[8], fbp[8], fkp[8], bon = 0.f;
        const int tp = dir ? t + 1 : t - 1;
        const bool hasp = dir ? (t < 63) : (t > 0);
#pragma unroll
        for (int i = 0; i < 8; ++i) {
            const int k = j0 + i;
            const float Bt = fLW[t * 65 + k], Bx = hasp ? fLW[tp * 65 + k] : 0.f, asg = fAS[t * 65 + k];
            const float kk = kkv[i] * rn, kh = k8[i] * (1.f + (asg - 1.f) * sv[256 + k]);
            bon += r8[i] * kh * sv[320 + k];
            const float enB = fexp(-Bt), eLB = fexp(sv[k] - Bt), bv = kk * asg;
            fa[i] = -kk * fexp(Bx); fb[i] = bv * enB; fk[i] = kh * enB; fr[i] = r8[i] * fexp(Bt); fbp[i] = bv * eLB; fkp[i] = kh * eLB;
        }
        bon += __shfl_xor(bon, 1, 64); bon += __shfl_xor(bon, 2, 64); bon += __shfl_xor(bon, 4, 64);
        if ((tid & 7) == 0) BONS[((size_t)dir * TB + s) * 8 + h] = bon;
        *(uint4*)(SLOT(0) + t * 72 + j0) = pack8(fa); *(uint4*)(SLOT(1) + t * 72 + j0) = pack8(fb); *(uint4*)(SLOT(2) + t * 72 + j0) = pack8(fk);
        *(uint4*)(SLOT(3) + t * 72 + j0) = pack8(fr); *(uint4*)(SLOT(4) + t * 72 + j0) = pack8(fbp); *(uint4*)(SLOT(5) + t * 72 + j0) = pack8(fkp);
    }
    __syncthreads();
    *(uint4*)(SLOT(6) + t * 72 + j0) = pack8(v8);
    __syncthreads();
    mm64<0, 0>(SLOT(0), SLOT(1), [=](int i0, int j, f32x4 a) {
        float m[4];
#pragma unroll
        for (int r = 0; r < 4; ++r) { const bool keep = dir ? (j > i0 + r) : (j < i0 + r); m[r] = keep ? a[r] : 0.f; }
        const bool dg = (i0 >> 4) == (j >> 4);
        st_img(SLOT(7), i0, j, dg ? m[0] : 0.f, dg ? m[1] : 0.f, dg ? m[2] : 0.f, dg ? m[3] : 0.f);
        st_img(SLOT(8), i0, j, (dg ? m[0] : 0.f) + (j == i0 ? 1.f : 0.f), (dg ? m[1] : 0.f) + (j == i0 + 1 ? 1.f : 0.f), (dg ? m[2] : 0.f) + (j == i0 + 2 ? 1.f : 0.f), (dg ? m[3] : 0.f) + (j == i0 + 3 ? 1.f : 0.f));
        st_img(SLOT(12), i0, j, dg ? 0.f : m[0], dg ? 0.f : m[1], dg ? 0.f : m[2], dg ? 0.f : m[3]); }, lane, wave);
    mm64<0, 0>(SLOT(0), SLOT(2), [=](int i0, int j, f32x4 a) {
        float m[4];
#pragma unroll
        for (int r = 0; r < 4; ++r) { const bool keep = dir ? (j > i0 + r) : (j < i0 + r); m[r] = keep ? a[r] : 0.f; }
        st_img(SLOT(9), i0, j, m[0], m[1], m[2], m[3]); }, lane, wave);
    mm64<0, 0>(SLOT(3), SLOT(1), [=](int i0, int j, f32x4 a) {
        float m[4];
#pragma unroll
        for (int r = 0; r < 4; ++r) { const bool keep = dir ? (j >= i0 + r) : (j <= i0 + r); m[r] = keep ? a[r] : 0.f; }
        st_img(SLOT(10), i0, j, m[0], m[1], m[2], m[3]); }, lane, wave);
    mm64<0, 0>(SLOT(3), SLOT(2), [=](int i0, int j, f32x4 a) {
        float m[4];
#pragma unroll
        for (int r = 0; r < 4; ++r) { const bool keep = dir ? (j >= i0 + r) : (j <= i0 + r); m[r] = keep ? a[r] : 0.f; }
        st_img(SLOT(11), i0, j, m[0], m[1], m[2], m[3]); }, lane, wave);
    __syncthreads();
    {
        bf16_t* Pc = SLOT(7); bf16_t* Pn = SLOT(1); bf16_t* Tc = SLOT(8); bf16_t* Tn = SLOT(2);
#pragma unroll 1
        for (int it = 0; it < 3; ++it) {
            mm64<0, 1>(Pc, Pc, [=](int i0, int j, f32x4 a) { st_img(Pn, i0, j, a[0], a[1], a[2], a[3]); }, lane, wave);
            __syncthreads();
            mm64<0, 1>(Tc, Pn, [=](int i0, int j, f32x4 a) {
                st_img(Tn, i0, j, a[0] + bf2f(Tc[(i0 + 0) * 72 + j]), a[1] + bf2f(Tc[(i0 + 1) * 72 + j]), a[2] + bf2f(Tc[(i0 + 2) * 72 + j]), a[3] + bf2f(Tc[(i0 + 3) * 72 + j])); }, lane, wave);
            __syncthreads();
            bf16_t* tmp = Pc; Pc = Pn; Pn = tmp; tmp = Tc; Tc = Tn; Tn = tmp;
        }
    }
    mm64<0, 1>(SLOT(2), SLOT(12), [=](int i0, int j, f32x4 a) { st_img(SLOT(7), i0, j, a[0], a[1], a[2], a[3]); }, lane, wave);
    mm64<0, 1>(SLOT(2), SLOT(0), [=](int i0, int j, f32x4 a) { st_img(SLOT(1), i0, j, a[0], a[1], a[2], a[3]); }, lane, wave);
    mm64<0, 1>(SLOT(9), SLOT(6), [=](int i0, int j, f32x4 a) { st_img(SLOT(13), i0, j, a[0], a[1], a[2], a[3]); }, lane, wave);
    __syncthreads();
    mm64<0, 1>(SLOT(2), SLOT(13), [=](int i0, int j, f32x4 a) { st_img(SLOT(8), i0, j, a[0], a[1], a[2], a[3]); }, lane, wave);
    __syncthreads();
    {
        const bf16_t* Zp = (wave < 4) ? SLOT(1) : SLOT(8);
        bf16_t* Xi = (wave < 4) ? SLOT(12) : SLOT(9);
        const int ct = (wave & 3) * 16, g4 = (lane >> 4) * 4, l15 = lane & 15;
#pragma unroll
        for (int bs = 0; bs < 4; ++bs) {
            const int bi = dir ? 3 - bs : bs;
            f32x4 acc;
#pragma unroll
            for (int r = 0; r < 4; ++r) acc[r] = bf2f(Zp[(bi * 16 + g4 + r) * 72 + ct + l15]);
            const bool k0 = dir ? (bi == 0) : (bi >= 1), k1 = dir ? (bi <= 2) : (bi == 3);
            if (k0) acc = __builtin_amdgcn_mfma_f32_16x16x32_bf16(row_frag(SLOT(7), 72, bi * 16, 0, lane), tr_frag(Xi, 72, 0, ct, lane), acc, 0, 0, 0);
            if (k1) acc = __builtin_amdgcn_mfma_f32_16x16x32_bf16(row_frag(SLOT(7), 72, bi * 16, 32, lane), tr_frag(Xi, 72, 32, ct, lane), acc, 0, 0, 0);
            st_img(Xi, bi * 16 + g4, ct + l15, acc[0], acc[1], acc[2], acc[3]);
            __syncthreads();
        }
    }
    mm64<1, 1>(SLOT(12), SLOT(4), [=](int i0, int j, f32x4 a) {
        float m[4];
#pragma unroll
        for (int r = 0; r < 4; ++r) m[r] = a[r] + ((i0 + r) == j ? fexp(sv[j]) : 0.f);
        *(uint2*)(RU + j * 64 + i0) = make_uint2(pack2bf(m[0], m[1]), pack2bf(m[2], m[3])); }, lane, wave);
    mm64x2<1, 1>(SLOT(4), SLOT(9), SLOT(5), SLOT(6), [=](int i0, int j, f32x4 a) {
        *(uint2*)(RU + 4096 + j * 64 + i0) = make_uint2(pack2bf(a[0], a[1]), pack2bf(a[2], a[3])); }, lane, wave);
    mm64<1, 0>(SLOT(12), SLOT(10), [=](int i0, int j, f32x4 a) {
        const uint2 rr = *(const uint2*)(SLOT(3) + j * 72 + i0);
        *(uint2*)(RU + 8192 + j * 64 + i0) = make_uint2(pack2bf(a[0] + bflo(rr.x), a[1] + bfhi(rr.x)), pack2bf(a[2] + bflo(rr.y), a[3] + bfhi(rr.y))); }, lane, wave);
    mm64x2<0, 1>(SLOT(10), SLOT(9), SLOT(11), SLOT(6), [=](int i0, int j, f32x4 a) {
        *(uint2*)(RU + 12288 + j * 64 + i0) = make_uint2(pack2bf(a[0], a[1]), pack2bf(a[2], a[3])); }, lane, wave);
#undef SLOT
}

#define R2_LOAD(slot_, stp_) do { const int cn_ = chunk_at(dir, ((stp_) < NCH) ? (stp_) : NCH - 1); const bf16_t* U_ = RU + (size_t)(chain * NCH + cn_) * 16384; \
    _Pragma("unroll") for (int i_ = 0; i_ < 4; ++i_) { rc[slot_][i_] = *(const uint2*)(U_ + 4096 + (vblk * 16 + l15) * 64 + i_ * 16 + g * 4); \
        _Pragma("unroll") for (int ks_ = 0; ks_ < 2; ++ks_) { ra[slot_][i_][ks_][0] = *(const uint2*)(U_ + (i_ * 16 + l15) * 64 + ks_ * 32 + g * 4); ra[slot_][i_][ks_][1] = *(const uint2*)(U_ + (i_ * 16 + l15) * 64 + ks_ * 32 + 16 + g * 4); } } } while (0)
DEV void rwkv2_unit(const Params& p, int chain, int vblk, int lane) {
    asm volatile("" : "+v"(lane));
    const bf16_t* RU = (const bf16_t*)(p.ws + OFF_RU);
    bf16_t* S0G = (bf16_t*)(p.ws + OFF_RS0);
    const int dir = chain & 1, g = lane >> 4, l15 = lane & 15;
    f32x4 st[4];
#pragma unroll
    for (int i = 0; i < 4; ++i) st[i] = (f32x4){0.f, 0.f, 0.f, 0.f};
    uint2 ra[3][4][2][2], rc[3][4];
    R2_LOAD(0, 0); R2_LOAD(1, 1); R2_LOAD(2, 2);
#pragma unroll 1
    for (int step0 = 0; step0 < NCH; step0 += 3) {
#pragma unroll
        for (int q = 0; q < 3; ++q) {
            const int step = step0 + q, c = chunk_at(dir, step);
            uint2 ca[4][2][2], cc[4];
#pragma unroll
            for (int i = 0; i < 4; ++i) { cc[i] = rc[q][i]; ca[i][0][0] = ra[q][i][0][0]; ca[i][0][1] = ra[q][i][0][1]; ca[i][1][0] = ra[q][i][1][0]; ca[i][1][1] = ra[q][i][1][1]; }
            R2_LOAD(q, step + 3);
            __builtin_amdgcn_sched_barrier(0);
            unsigned pk[4][2];
#pragma unroll
            for (int i = 0; i < 4; ++i) { pk[i][0] = pack2bf(st[i][0], st[i][1]); pk[i][1] = pack2bf(st[i][2], st[i][3]); }
            bf16_t* sp = S0G + ((size_t)(chain * NCH + c) * 64 + vblk * 16 + l15) * 64 + g * 4;
#pragma unroll
            for (int i = 0; i < 4; ++i) *(uint2*)(sp + i * 16) = make_uint2(pk[i][0], pk[i][1]);
            bf16x8 bfr[2];
#pragma unroll
            for (int ks = 0; ks < 2; ++ks) { const uint4 u = make_uint4(pk[2 * ks][0], pk[2 * ks][1], pk[2 * ks + 1][0], pk[2 * ks + 1][1]); bfr[ks] = __builtin_bit_cast(bf16x8, u); }
#pragma unroll
            for (int i = 0; i < 4; ++i) {
                f32x4 acc = (f32x4){bflo(cc[i].x), bfhi(cc[i].x), bflo(cc[i].y), bfhi(cc[i].y)};
#pragma unroll
                for (int ks = 0; ks < 2; ++ks) {
                    const uint4 u = make_uint4(ca[i][ks][0].x, ca[i][ks][0].y, ca[i][ks][1].x, ca[i][ks][1].y);
                    acc = __builtin_amdgcn_mfma_f32_16x16x32_bf16(__builtin_bit_cast(bf16x8, u), bfr[ks], acc, 0, 0, 0);
                }
                st[i] = acc;
            }
        }
    }
}
#undef R2_LOAD

DEV void rwkv3_unit(const Params& p, int h, int c, float* sm) {
    const int tid = opaque_tid(), lane = tid & 63, wave = tid >> 6;
    const bf16_t* P0 = (const bf16_t*)(p.ws + OFF_P0);
    const bf16_t* RUb = (const bf16_t*)(p.ws + OFF_RU);
    const bf16_t* S0G = (const bf16_t*)(p.ws + OFF_RS0);
    const float* BONS = (const float*)(p.ws + OFF_BONS);
    bf16_t* YC = (bf16_t*)(p.ws + OFF_YC);
    const float* mu = p.in[15]; const float* gn_g = p.in[27]; const float* gn_b = p.in[28];
    bf16_t* img = (bf16_t*)sm;
    float* O = sm + 4 * 2304;
    __syncthreads();
    {
        const int row = tid >> 3, c8 = (tid & 7) * 8;
#pragma unroll
        for (int dir = 0; dir < 2; ++dir) {
            const size_t u = (size_t)((h * 2 + dir) * NCH + c);
            *(uint4*)(img + dir * 4608 + row * 72 + c8) = *(const uint4*)(RUb + u * 16384 + 8192 + row * 64 + c8);
            *(uint4*)(img + (2 + dir) * 4608 + row * 72 + c8) = *(const uint4*)(S0G + u * 4096 + row * 64 + c8);
        }
    }
    __syncthreads();
#pragma unroll
    for (int q = 0; q < 2; ++q) {
        const int idx = wave * 2 + q, ti = idx >> 2, tj = idx & 3;
        f32x4 accd[2];
#pragma unroll
        for (int dir = 0; dir < 2; ++dir) {
            f32x4 acc = (f32x4){0.f, 0.f, 0.f, 0.f};
#pragma unroll
            for (int ks = 0; ks < 2; ++ks) acc = __builtin_amdgcn_mfma_f32_16x16x32_bf16(row_frag(img + dir * 4608, 72, ti * 16, ks * 32, lane), row_frag(img + (2 + dir) * 4608, 72, tj * 16, ks * 32, lane), acc, 0, 0, 0);
            const uint2 yl = *(const uint2*)(RUb + (size_t)((h * 2 + dir) * NCH + c) * 16384 + 12288 + (tj * 16 + (lane & 15)) * 64 + ti * 16 + (lane >> 4) * 4);
            acc[0] += bflo(yl.x); acc[1] += bfhi(yl.x); acc[2] += bflo(yl.y); acc[3] += bfhi(yl.y);
            accd[dir] = acc;
        }
#pragma unroll
        for (int r = 0; r < 4; ++r) {
            const int oi = (ti * 16 + (lane >> 4) * 4 + r) * 68 + tj * 16 + (lane & 15);
            O[oi] = accd[0][r] + accd[1][r];
        }
    }
    __syncthreads();
    {
        const int t = tid >> 3, v0 = (tid & 7) * 8, s = c * 64 + t;
        float y[8], sum = 0.f;
#pragma unroll
        for (int i = 0; i < 8; ++i) { y[i] = O[t * 68 + v0 + i]; sum += y[i]; }
        sum += __shfl_xor(sum, 1, 64); sum += __shfl_xor(sum, 2, 64); sum += __shfl_xor(sum, 4, 64);
        const float mean = sum * (1.f / 64.f);
        float sq = 0.f;
#pragma unroll
        for (int i = 0; i < 8; ++i) { y[i] -= mean; sq += y[i] * y[i]; }
        sq += __shfl_xor(sq, 1, 64); sq += __shfl_xor(sq, 2, 64); sq += __shfl_xor(sq, 4, 64);
        const float rstd = rsqrtf(sq * (1.f / 64.f) + 64e-5f);
        float vm[8], gm[8];
        rw_mix8(P0, s, 1024 + h * 64 + v0, mu, vm);
        rw_mix8(P0, s, 1536 + h * 64 + v0, mu, gm);
        const float bon = BONS[(size_t)s * 8 + h] + BONS[((size_t)TB + s) * 8 + h];
        float o[8];
#pragma unroll
        for (int i = 0; i < 8; ++i) o[i] = (y[i] * rstd * gn_g[h * 64 + v0 + i] + gn_b[h * 64 + v0 + i] + bon * vm[i]) * silu_f(gm[i]);
        *(uint4*)(YC + (size_t)s * 1024 + 512 + h * 64 + v0) = pack8(o);
    }
}

DEV void ln_rows(const float* src, int nrows, const float* __restrict__ g, const float* __restrict__ bt, float* dst_lat, float* dst_cx, int ncx,
                 bf16_t* hb = nullptr, const float* mvc = nullptr, const float* mvl = nullptr) {
    const int tid_ = opaque_tid(); const int lane = tid_ & 63, gw = blockIdx.x * NWV + (tid_ >> 6), ngw = gridDim.x * NWV;
    for (int r = gw; r < nrows; r += ngw) {
        const float* x = src + (size_t)r * 1024;
        float4 v[4];
        float sum = 0.f;
#pragma unroll
        for (int i = 0; i < 4; ++i) { v[i] = ld4(x + i * 256 + lane * 4); sum += v[i].x + v[i].y + v[i].z + v[i].w; }
        const float mean = wave_sum(sum) * (1.f / 1024.f);
        float sq = 0.f;
#pragma unroll
        for (int i = 0; i < 4; ++i) {
            v[i].x -= mean; v[i].y -= mean; v[i].z -= mean; v[i].w -= mean;
            sq += v[i].x * v[i].x + v[i].y * v[i].y + v[i].z * v[i].z + v[i].w * v[i].w;
        }
        const float rstd = rsqrtf(wave_sum(sq) * (1.f / 1024.f) + 1e-5f);
        float* d = (r < ncx) ? (dst_cx + (size_t)r * 1024) : (dst_lat + (size_t)(r - ncx) * 1024);
#pragma unroll
        for (int i = 0; i < 4; ++i) {
            const int c = i * 256 + lane * 4;
            const float4 gg = ld4(g + c), bb = ld4(bt + c);
            const float4 y = make_float4(v[i].x * rstd * gg.x + bb.x, v[i].y * rstd * gg.y + bb.y, v[i].z * rstd * gg.z + bb.z, v[i].w * rstd * gg.w + bb.w);
            st4(d + c, y);
            if (hb != nullptr) {
                const float* m = (r < ncx) ? mvc : mvl;
                const float4 sh = ld4(m + c), sc = ld4(m + 1024 + c);
                *(uint2*)(hb + (size_t)r * 1024 + c) = make_uint2(pack2bf(y.x * (1.f + sc.x) + sh.x, y.y * (1.f + sc.y) + sh.y), pack2bf(y.z * (1.f + sc.z) + sh.z, y.w * (1.f + sc.w) + sh.w));
            }
        }
    }
}
DEV void phase_h1l(const Params& p) {
    const float* modv1 = (const float*)(p.ws + OFF_MODV) + 3 * 3072;
    bf16_t* H1 = (bf16_t*)(p.ws + OFF_H1B);
    const size_t gt = (size_t)blockIdx.x * NTHR + opaque_tid(), gn = (size_t)gridDim.x * NTHR;
    for (size_t i = gt; i < (size_t)NB * NL * 128; i += gn) {
        const size_t r = i >> 7; const int k = (int)(i & 127) * 8;
        const float* m = modv1 + (r >= (size_t)NL ? 1 : 0) * 3072;
        const float4 x0 = ld4(p.out + r * DM + k), x1 = ld4(p.out + r * DM + k + 4);
        const float4 s0 = ld4(m + k), s1 = ld4(m + k + 4), c0 = ld4(m + 1024 + k), c1 = ld4(m + 1024 + k + 4);
        *(uint4*)(H1 + r * DM + k) = make_uint4(pack2bf(x0.x * (1.f + c0.x) + s0.x, x0.y * (1.f + c0.y) + s0.y), pack2bf(x0.z * (1.f + c0.z) + s0.z, x0.w * (1.f + c0.w) + s0.w),
                                                pack2bf(x1.x * (1.f + c1.x) + s1.x, x1.y * (1.f + c1.y) + s1.y), pack2bf(x1.z * (1.f + c1.z) + s1.z, x1.w * (1.f + c1.w) + s1.w));
    }
}

DEV void zero_f4(float* ptr, size_t nfloat) {
    const size_t n4 = nfloat / 4;
    for (size_t i = (size_t)blockIdx.x * NTHR + opaque_tid(); i < n4; i += (size_t)gridDim.x * NTHR) ((float4*)ptr)[i] = make_float4(0.f, 0.f, 0.f, 0.f);
}

DEV void chain_ids(int& chain, int& sub) {
    const int bid = blockIdx.x, xcd = bid & 7, idx = bid >> 3;
    chain = xcd * 2 + (idx >> 4); sub = idx & 15;
}

DEV void phase_conv1(const Params& p, float* sm) {
    const bf16_t* XM = (const bf16_t*)(p.ws + OFF_XM);
    bf16_t* XC = (bf16_t*)(p.ws + OFF_XC);
    float* G16P = (float*)(p.ws + OFF_G16P);
    const bf16_t* WFT = (const bf16_t*)(p.ws + OFF_WFT);
    const float* cw = p.in[31]; const float* cbias = p.in[32];
    bf16_t* imgC = (bf16_t*)sm;
    bf16_t* imgM = imgC + 64 * 264;
    float* red = (float*)(imgM + 64 * 264);
    const int tid = opaque_tid(), lane = tid & 63, wave = tid >> 6, t = tid >> 3, cg = tid & 7;
    for (int u = blockIdx.x; u < NB * NCH * 4; u += gridDim.x) {
        const int ci = u >> 2, q = u & 3, b = ci / NCH, c = ci % NCH, s = c * 64 + t;
        const size_t rowbase = (size_t)b * TB;
        int nrow[9];
#pragma unroll
        for (int i = 0; i < 3; ++i)
#pragma unroll
            for (int j = 0; j < 3; ++j) {
                int ns = -1;
                if (s < NCX) { const int w2 = s + j - 1; if (i == 1 && w2 >= 0 && w2 < NCX) ns = w2; }
                else { const int n = s - NCX, rr = (n >> 6) + i - 1, w2 = (n & 63) + j - 1; if (rr >= 0 && rr < 128 && w2 >= 0 && w2 < 64) ns = NCX + rr * 64 + w2; }
                nrow[i * 3 + j] = ns;
            }
        const int tt = wave & 3, part = wave >> 2;
        f32x4 acc = (f32x4){0.f, 0.f, 0.f, 0.f};
#pragma unroll 1
        for (int half = 0; half < 2; ++half) {
            __syncthreads();
#pragma unroll 2
            for (int it = 0; it < 4; ++it) {
                const int cl = it * 64 + cg * 8, c0 = q * 512 + half * 256 + cl;
                float a8[8];
                { const float4 b0 = ld4(cbias + c0), b1 = ld4(cbias + c0 + 4); a8[0] = b0.x; a8[1] = b0.y; a8[2] = b0.z; a8[3] = b0.w; a8[4] = b1.x; a8[5] = b1.y; a8[6] = b1.z; a8[7] = b1.w; }
                uint4 xmc = make_uint4(0u, 0u, 0u, 0u);
#pragma unroll
                for (int tap = 0; tap < 9; ++tap) {
                    if (nrow[tap] >= 0) {
                        const uint4 xv = *(const uint4*)(XM + (rowbase + nrow[tap]) * 2048 + c0);
                        float x8[8]; unpack8(xv, x8);
                        const float4 w0 = ld4(cw + tap * 2048 + c0), w1 = ld4(cw + tap * 2048 + c0 + 4);
                        a8[0] += x8[0] * w0.x; a8[1] += x8[1] * w0.y; a8[2] += x8[2] * w0.z; a8[3] += x8[3] * w0.w;
                        a8[4] += x8[4] * w1.x; a8[5] += x8[5] * w1.y; a8[6] += x8[6] * w1.z; a8[7] += x8[7] * w1.w;
                        if (tap == 4) xmc = xv;
                    }
                }
#pragma unroll
                for (int i = 0; i < 8; ++i) a8[i] = silu_f(a8[i]);
                const uint4 xcv = pack8(a8);
                *(uint4*)(XC + (rowbase + s) * 2048 + c0) = xcv;
                *(uint4*)(imgC + t * 264 + cl) = xcv;
                *(uint4*)(imgM + t * 264 + cl) = xmc;
            }
            __syncthreads();
            {
                const bf16_t* img = part ? imgM : imgC;
                const bf16_t* wrow = WFT + (size_t)(lane & 15) * 4096 + part * 2048 + q * 512 + half * 256 + (lane >> 4) * 8;
#pragma unroll
                for (int ks = 0; ks < 8; ++ks) acc = __builtin_amdgcn_mfma_f32_16x16x32_bf16(row_frag(img, 264, tt * 16, ks * 32, lane), *(const bf16x8*)(wrow + ks * 32), acc, 0, 0, 0);
            }
        }
        if (part == 1) {
#pragma unroll
            for (int r = 0; r < 4; ++r) red[(tt * 16 + (lane >> 4) * 4 + r) * 16 + (lane & 15)] = acc[r];
        }
        __syncthreads();
        if (part == 0) {
#pragma unroll
            for (int r = 0; r < 4; ++r) {
                const int tk = tt * 16 + (lane >> 4) * 4 + r;
                G16P[((size_t)q * RT + rowbase + c * 64 + tk) * 16 + (lane & 15)] = acc[r] + red[tk * 16 + (lane & 15)];
            }
        }
    }
}

DEV void gate_pair(const Params& p, size_t row, int dir, int h, float& gi, float& lf) {
    const float* G16P = (const float*)(p.ws + OFF_G16P);
    float a = 0.f, f = 0.f;
#pragma unroll
    for (int q = 0; q < 4; ++q) { a += G16P[((size_t)q * RT + row) * 16 + dir * 8 + h]; f += G16P[((size_t)q * RT + row) * 16 + dir * 8 + 4 + h]; }
    gi = a + p.in[dir ? 41 : 37][h];
    lf = logsig_f(f + p.in[dir ? 43 : 39][h]);
}

DEV void phase_x1(const Params& p, float* sm) {
    int chain, sub; chain_ids(chain, sub);
    const int b = chain >> 3, h = (chain >> 1) & 3, dir = chain & 1;
    const bf16_t* XC = (const bf16_t*)(p.ws + OFF_XC);
    float* GSC = (float*)(p.ws + OFF_GSC); float* CSC = (float*)(p.ws + OFF_CSC); float* NBUF = (float*)(p.ws + OFF_NBUF);
    const float* gtab = (const float*)(p.ws + OFF_GTAB);
    bf16_t* SMAT = (bf16_t*)(p.ws + OFF_SMAT);
    const int tid = opaque_tid(), lane = tid & 63, wave = tid >> 6;
    float* sTot = sm; float* sRef = sm + 132; float* sM0 = sm + 264; float* sBeta = sm + 400;
    for (int c = wave; c < NCH; c += NWV) {
        const size_t row = (size_t)b * TB + c * 64 + lane;
        float gi, lf; gate_pair(p, row, dir, h, gi, lf);
        const float bc = wave_scan_add(lf, lane, dir);
        const float ref = wave_max(gi - bc), tot = wave_sum(lf);
        if (lane == 0) { sTot[c] = tot; sRef[c] = ref; }
    }
    __syncthreads();
    if (tid == 0) {
        float m0 = -INFINITY;
        for (int step = 0; step < NCH; ++step) {
            const int c = chunk_at(dir, step);
            sM0[c] = m0;
            const float mx = fmaxf(m0, sRef[c]);
            if (sub == 0) { CSC[(chain * NCH + c) * 2] = fexp(m0 - mx); CSC[(chain * NCH + c) * 2 + 1] = fexp(sRef[c] - mx); }
            m0 = sTot[c] + mx;
        }
    }
    __syncthreads();
    for (int k = wave; sub + 16 * k < NCH; k += NWV) {
        const int c = sub + 16 * k;
        const size_t row = (size_t)b * TB + c * 64 + lane;
        float gi, lf; gate_pair(p, row, dir, h, gi, lf);
        const float bc = wave_scan_add(lf, lane, dir);
        const float a = gi - bc;
        const float amax = wave_scan_max(a, lane, dir);
        const float ref = sRef[c], m0 = sM0[c];
        const float mmax = fmaxf(amax, m0);
        const float mt = bc + mmax;
        const float alpha = fexp(ref - mmax), beta = fexp(a - ref), gg = fexp(m0 - mmax), em = fexp(-mt);
        st4(GSC + ((size_t)chain * TB + c * 64 + lane) * 4, make_float4(alpha, beta, gg, em));
        sBeta[k * 64 + lane] = beta;
    }
    __syncthreads();
    {
        float* part = sm + 1024;
        const int sg = tid >> 6, j8 = (tid & 63) * 8;
        for (int k = 0; sub + 16 * k < NCH; ++k) {
            const int c = sub + 16 * k;
            const bf16_t* xp = XC + ((size_t)b * TB + c * 64 + sg * 8) * 2048 + h * 512 + j8;
            float acc[8];
#pragma unroll
            for (int i = 0; i < 8; ++i) acc[i] = 0.f;
#pragma unroll
            for (int s = 0; s < 8; ++s) {
                float f[8]; unpack8(*(const uint4*)(xp + (size_t)s * 2048), f);
                const float be = sBeta[k * 64 + sg * 8 + s];
#pragma unroll
                for (int i = 0; i < 8; ++i) acc[i] += be * f[i];
            }
            __syncthreads();
            st4(part + sg * 512 + j8, make_float4(acc[0], acc[1], acc[2], acc[3])); st4(part + sg * 512 + j8 + 4, make_float4(acc[4], acc[5], acc[6], acc[7]));
            __syncthreads();
            float tot = 0.f;
#pragma unroll
            for (int q = 0; q < 8; ++q) tot += part[q * 512 + tid];
            NBUF[((size_t)chain * NCH + c) * 512 + tid] = tot;
        }
    }
    bf16_t* XCs = (bf16_t*)sm;
    bf16_t* Qs = XCs + 64 * 520;
    for (int u = blockIdx.x; u < NB * 4 * NCH; u += gridDim.x) {
        const int bh = u / NCH, c = u % NCH, ub = bh >> 2, uh = bh & 3;
        __syncthreads();
#pragma unroll 2
        for (int i = 0; i < 8; ++i) {
            const int pp = tid + 512 * i, row = pp >> 6, c16 = pp & 63;
            const uint4 xv = *(const uint4*)(XC + ((size_t)ub * TB + c * 64 + row) * 2048 + uh * 512 + c16 * 8);
            float f[8]; unpack8(xv, f);
            float q[8];
#pragma unroll
            for (int bb = 0; bb < 2; ++bb) {
                const float* G = gtab + (size_t)(uh * 128 + c16 * 2 + bb) * 16;
                const float4 g0 = ld4(G), g1 = ld4(G + 4), g2 = ld4(G + 8), g3 = ld4(G + 12);
                q[bb * 4 + 0] = f[bb * 4] * g0.x + f[bb * 4 + 1] * g1.x + f[bb * 4 + 2] * g2.x + f[bb * 4 + 3] * g3.x;
                q[bb * 4 + 1] = f[bb * 4] * g0.y + f[bb * 4 + 1] * g1.y + f[bb * 4 + 2] * g2.y + f[bb * 4 + 3] * g3.y;
                q[bb * 4 + 2] = f[bb * 4] * g0.z + f[bb * 4 + 1] * g1.z + f[bb * 4 + 2] * g2.z + f[bb * 4 + 3] * g3.z;
                q[bb * 4 + 3] = f[bb * 4] * g0.w + f[bb * 4 + 1] * g1.w + f[bb * 4 + 2] * g2.w + f[bb * 4 + 3] * g3.w;
            }
            *(uint4*)(XCs + row * 520 + c16 * 8) = xv;
            *(uint4*)(Qs + row * 520 + c16 * 8) = make_uint4(pack2bf(q[0], q[1]), pack2bf(q[2], q[3]), pack2bf(q[4], q[5]), pack2bf(q[6], q[7]));
        }
        __syncthreads();
        const int st = wave & 3, tt0 = (wave >> 2) * 2;
        f32x4 a0 = (f32x4){0.f, 0.f, 0.f, 0.f}, a1 = a0;
        const bf16_t* ap = XCs + (st * 16 + (lane & 15)) * 520 + (lane >> 4) * 8;
        const bf16_t* bp0 = Qs + (tt0 * 16 + (lane & 15)) * 520 + (lane >> 4) * 8;
        const bf16_t* bp1 = bp0 + 16 * 520;
#pragma unroll
        for (int ks = 0; ks < 16; ++ks) {
            const bf16x8 af = *(const bf16x8*)(ap + ks * 32);
            a0 = __builtin_amdgcn_mfma_f32_16x16x32_bf16(af, *(const bf16x8*)(bp0 + ks * 32), a0, 0, 0, 0);
            a1 = __builtin_amdgcn_mfma_f32_16x16x32_bf16(af, *(const bf16x8*)(bp1 + ks * 32), a1, 0, 0, 0);
        }
        bf16_t* sp = SMAT + (size_t)u * 4096 + (size_t)(tt0 * 16 + (lane & 15)) * 64 + st * 16 + (lane >> 4) * 4;
        *(uint2*)sp = make_uint2(pack2bf(a0[0], a0[1]), pack2bf(a0[2], a0[3]));
        *(uint2*)(sp + 16 * 64) = make_uint2(pack2bf(a1[0], a1[1]), pack2bf(a1[2], a1[3]));
    }
}

DEV void phase_x2(const Params& p, float* sm) {
    int chain, sub; chain_ids(chain, sub);
    const int b = chain >> 3, h = (chain >> 1) & 3, dir = chain & 1;
    const bf16_t* XC = (const bf16_t*)(p.ws + OFF_XC);
    float* GSC = (float*)(p.ws + OFF_GSC); const float* CSC = (const float*)(p.ws + OFF_CSC); const float* NBUF = (const float*)(p.ws + OFF_NBUF);
    const float* gtab = (const float*)(p.ws + OFF_GTAB);
    const bf16_t* SMAT = (const bf16_t*)(p.ws + OFF_SMAT);
    const int tid = opaque_tid();
    float* sD0 = sm; float* sCf = sm + 132; float* sN0 = sm + 264; float* sN2 = sN0 + 9 * 512;
    for (int i = tid; i < NCH; i += NTHR) { sD0[i] = CSC[(chain * NCH + i) * 2]; sCf[i] = CSC[(chain * NCH + i) * 2 + 1]; }
    __syncthreads();
    {
        float n = 0.f;
        const float* nb = NBUF + (size_t)chain * NCH * 512 + tid;
#pragma unroll 4
        for (int step = 0; step < NCH; ++step) {
            const int c = chunk_at(dir, step);
            if ((c & 15) == sub) sN0[(c >> 4) * 512 + tid] = n;
            n = sD0[c] * n + sCf[c] * nb[(size_t)c * 512];
        }
    }
    __syncthreads();
    {
        const int blk = tid >> 2, cp = tid & 3;
        const float4 g = ld4(gtab + (size_t)(h * 128 + blk) * 16 + cp * 4);
        for (int k = 0; sub + 16 * k < NCH; ++k) {
            const float* n0 = sN0 + k * 512 + blk * 4;
            sN2[k * 512 + tid] = g.x * n0[0] + g.y * n0[1] + g.z * n0[2] + g.w * n0[3];
        }
    }
    __syncthreads();
    const int t = tid >> 3, part = tid & 7;
    for (int k = 0; sub + 16 * k < NCH; ++k) {
        const int c = sub + 16 * k;
        const size_t row = (size_t)b * TB + c * 64 + t;
        float dint = 0.f;
        {
            const bf16_t* xp = XC + row * 2048 + h * 512 + part * 64;
            const float* n2 = sN2 + k * 512 + part * 64;
#pragma unroll
            for (int i = 0; i < 8; ++i) {
                float f[8]; unpack8(*(const uint4*)(xp + i * 8), f);
                const float4 na = ld4(n2 + i * 8), nb2 = ld4(n2 + i * 8 + 4);
                dint += f[0] * na.x + f[1] * na.y + f[2] * na.z + f[3] * na.w + f[4] * nb2.x + f[5] * nb2.y + f[6] * nb2.z + f[7] * nb2.w;
            }
        }
        float di = 0.f;
        {
            float f[8]; unpack8(*(const uint4*)(SMAT + ((size_t)((b * 4 + h) * NCH + c)) * 4096 + t * 64 + part * 8), f);
#pragma unroll
            for (int e = 0; e < 8; ++e) {
                const int s = part * 8 + e;
                const float beta = GSC[((size_t)chain * TB + c * 64 + s) * 4 + 1];
                const bool keep = dir ? (s >= t) : (s <= t);
                di += keep ? f[e] * beta : 0.f;
            }
        }
        dint += __shfl_xor(dint, 1, 64); dint += __shfl_xor(dint, 2, 64); dint += __shfl_xor(dint, 4, 64);
        di += __shfl_xor(di, 1, 64); di += __shfl_xor(di, 2, 64); di += __shfl_xor(di, 4, 64);
        if (part == 0) {
            float* gp = GSC + ((size_t)chain * TB + c * 64 + t) * 4;
            const float4 g4 = ld4(gp);
            const float den = g4.x * di + g4.z * dint;
            gp[3] = 1.f / fmaxf(fabsf(den), g4.w);
        }
    }
}

#define MLSTM_PREFETCH(step_) do { \
    const int c_ = chunk_at(dir, (step_)); const size_t rb_ = (size_t)b * TB + (size_t)c_ * 64; \
    { const bf16_t* xb_ = XC + (rb_ + (tid >> 6)) * 2048 + h * 512 + (tid & 63) * 8; \
      rx0 = *(const uint4*)(xb_); rx1 = *(const uint4*)(xb_ + 8 * 2048); rx2 = *(const uint4*)(xb_ + 16 * 2048); rx3 = *(const uint4*)(xb_ + 24 * 2048); \
      rx4 = *(const uint4*)(xb_ + 32 * 2048); rx5 = *(const uint4*)(xb_ + 40 * 2048); rx6 = *(const uint4*)(xb_ + 48 * 2048); rx7 = *(const uint4*)(xb_ + 56 * 2048); } \
    rxm = *(const uint2*)(XM + (rb_ + ps) * 2048 + ch0 + pvb * 4); \
    rs = *(const uint4*)(SMAT + ((size_t)((b * 4 + h) * NCH + c_)) * 4096 + ps * 64 + pvb * 8); \
    rbeta = GSC[((size_t)chain * TB + c_ * 64 + ps) * 4 + 1]; \
    if (tid < 64) rsc = ld4(GSC + ((size_t)chain * TB + c_ * 64 + tid) * 4); \
    rd0 = CSC[(chain * NCH + c_) * 2]; rcf = CSC[(chain * NCH + c_) * 2 + 1]; } while (0)

DEV void phase_mlstm(const Params& p, float* sm) {
    int chain, sub; chain_ids(chain, sub);
    const int b = chain >> 3, h = (chain >> 1) & 3, dir = chain & 1;
    const bf16_t* XM = (const bf16_t*)(p.ws + OFF_XM);
    const bf16_t* XC = (const bf16_t*)(p.ws + OFF_XC);
    const bf16_t* SMAT = (const bf16_t*)(p.ws + OFF_SMAT);
    const float* GSC = (const float*)(p.ws + OFF_GSC); const float* CSC = (const float*)(p.ws + OFF_CSC);
    const float* gtab = (const float*)(p.ws + OFF_GTAB);
    bf16_t* H = (bf16_t*)(p.ws + OFF_H);
    const float* wv = p.in[35];
    char* smc = (char*)sm;
    bf16_t* XCs = (bf16_t*)smc;
    bf16_t* Cs = (bf16_t*)(smc + 66560);
    bf16_t* Vb = (bf16_t*)(smc + 66560 + 33280);
    bf16_t* Vw = Vb + 32 * 72;
    bf16_t* Sm = Vw + 32 * 72;
    float* Gs = (float*)(smc + 66560 + 33280 + 2 * 4608 + 9216);
    float* sc = Gs + 2048;
    const int tid = opaque_tid(), lane = tid & 63, wave = tid >> 6;
    for (int i = tid; i < 32 * 520 / 2; i += NTHR) ((unsigned*)Cs)[i] = 0u;
    for (int i = tid; i < 2048; i += NTHR) Gs[i] = gtab[h * 2048 + i];
    const int ps = tid >> 3, pvb = tid & 7;
    const int ch0 = h * 512 + sub * 32;
    float wvr[16];
#pragma unroll
    for (int i = 0; i < 16; ++i) wvr[i] = wv[(size_t)((ch0 >> 2) + pvb) * 16 + i];
    f32x4 accS[4][2];
#pragma unroll
    for (int i = 0; i < 4; ++i) { accS[i][0] = (f32x4){0.f, 0.f, 0.f, 0.f}; accS[i][1] = (f32x4){0.f, 0.f, 0.f, 0.f}; }
    uint4 rx0, rx1, rx2, rx3, rx4, rx5, rx6, rx7; uint2 rxm; uint4 rs; float rbeta; float4 rsc = make_float4(0.f, 0.f, 0.f, 0.f); float rd0, rcf;
    MLSTM_PREFETCH(0);
    __syncthreads();
#pragma unroll 1
    for (int step = 0; step < NCH; ++step) {
        const int c = chunk_at(dir, step);
        const float d0 = rd0, cf = rcf;
        {
            bf16_t* xd = XCs + (tid >> 6) * 520 + (tid & 63) * 8;
            *(uint4*)(xd) = rx0; *(uint4*)(xd + 8 * 520) = rx1; *(uint4*)(xd + 16 * 520) = rx2; *(uint4*)(xd + 24 * 520) = rx3;
            *(uint4*)(xd + 32 * 520) = rx4; *(uint4*)(xd + 40 * 520) = rx5; *(uint4*)(xd + 48 * 520) = rx6; *(uint4*)(xd + 56 * 520) = rx7;
        }
        {
            const float x0 = bflo(rxm.x), x1 = bfhi(rxm.x), x2 = bflo(rxm.y), x3 = bfhi(rxm.y);
#pragma unroll
            for (int d = 0; d < 4; ++d) {
                const float v = (x0 * wvr[d] + x1 * wvr[4 + d] + x2 * wvr[8 + d] + x3 * wvr[12 + d]) * rbeta;
                Vb[(pvb * 4 + d) * 72 + ps] = __builtin_bit_cast(unsigned short, (__bf16)v);
                Vw[(pvb * 4 + d) * 72 + ps] = __builtin_bit_cast(unsigned short, (__bf16)(v * cf));
            }
        }
        {
#define SMASK(q_) (((dir ? (pvb * 8 + 2 * (q_) >= ps) : (pvb * 8 + 2 * (q_) <= ps)) ? 0x0000ffffu : 0u) | ((dir ? (pvb * 8 + 2 * (q_) + 1 >= ps) : (pvb * 8 + 2 * (q_) + 1 <= ps)) ? 0xffff0000u : 0u))
            *(uint4*)(Sm + ps * 72 + pvb * 8) = make_uint4(rs.x & SMASK(0), rs.y & SMASK(1), rs.z & SMASK(2), rs.w & SMASK(3));
#undef SMASK
        }
        if (tid < 64) st4(sc + tid * 4, rsc);
        { const int nstep = (step + 1 < NCH) ? step + 1 : step; MLSTM_PREFETCH(nstep); }
        __syncthreads();
        {
            const int vt = wave & 1, tt = wave >> 1;
            f32x4 ao = (f32x4){0.f, 0.f, 0.f, 0.f}, ai = ao;
            const bf16_t* ap = Cs + (vt * 16 + (lane & 15)) * 520 + (lane >> 4) * 8;
            const bf16_t* bp = XCs + (tt * 16 + (lane & 15)) * 520 + (lane >> 4) * 8;
#pragma unroll
            for (int ks = 0; ks < 16; ++ks) ao = __builtin_amdgcn_mfma_f32_16x16x32_bf16(*(const bf16x8*)(ap + ks * 32), *(const bf16x8*)(bp + ks * 32), ao, 0, 0, 0);
            const bf16_t* ap2 = Vb + (vt * 16 + (lane & 15)) * 72 + (lane >> 4) * 8;
            const bf16_t* bp2 = Sm + (tt * 16 + (lane & 15)) * 72 + (lane >> 4) * 8;
#pragma unroll
            for (int ks = 0; ks < 2; ++ks) ai = __builtin_amdgcn_mfma_f32_16x16x32_bf16(*(const bf16x8*)(ap2 + ks * 32), *(const bf16x8*)(bp2 + ks * 32), ai, 0, 0, 0);
            if (c >= 4) {
                const int t = tt * 16 + (lane & 15);
                const float4 s4 = ld4(sc + t * 4);
                const float h0 = (s4.x * ai[0] + s4.z * ao[0]) * s4.w, h1 = (s4.x * ai[1] + s4.z * ao[1]) * s4.w;
                const float h2 = (s4.x * ai[2] + s4.z * ao[2]) * s4.w, h3 = (s4.x * ai[3] + s4.z * ao[3]) * s4.w;
                bf16_t* hp = H + ((size_t)b * NL + (size_t)c * 64 + t - NCX) * 2048 + ch0 + vt * 16 + (lane >> 4) * 4;
                const unsigned u0 = pack2bf(h0, h1), u1 = pack2bf(h2, h3);
                __builtin_amdgcn_global_atomic_fadd_v2bf16((__attribute__((address_space(1))) s16x2*)hp, __builtin_bit_cast(s16x2, u0));
                __builtin_amdgcn_global_atomic_fadd_v2bf16((__attribute__((address_space(1))) s16x2*)(hp + 2), __builtin_bit_cast(s16x2, u1));
            }
        }
#pragma unroll
        for (int jt = 0; jt < 4; ++jt) { accS[jt][0] *= d0; accS[jt][1] *= d0; }
#pragma unroll
        for (int ks = 0; ks < 2; ++ks) {
            const bf16x8 b0 = *(const bf16x8*)(Vw + (lane & 15) * 72 + ks * 32 + (lane >> 4) * 8);
            const bf16x8 b1 = *(const bf16x8*)(Vw + (16 + (lane & 15)) * 72 + ks * 32 + (lane >> 4) * 8);
            const int row0 = ks * 32 + (lane >> 4) * 8 + ((lane & 15) >> 2);
#pragma unroll
            for (int jt = 0; jt < 4; ++jt) {
                const int col = wave * 64 + jt * 16 + (lane & 3) * 4;
                const s16x4 lo = __builtin_amdgcn_ds_read_tr16_b64_v4i16((__attribute__((address_space(3))) s16x4*)(XCs + row0 * 520 + col));
                const s16x4 hi = __builtin_amdgcn_ds_read_tr16_b64_v4i16((__attribute__((address_space(3))) s16x4*)(XCs + (row0 + 4) * 520 + col));
                const bf16x8 af = (bf16x8){lo[0], lo[1], lo[2], lo[3], hi[0], hi[1], hi[2], hi[3]};
                accS[jt][0] = __builtin_amdgcn_mfma_f32_16x16x32_bf16(af, b0, accS[jt][0], 0, 0, 0);
                accS[jt][1] = __builtin_amdgcn_mfma_f32_16x16x32_bf16(af, b1, accS[jt][1], 0, 0, 0);
            }
        }
        __syncthreads();
#pragma unroll
        for (int jt = 0; jt < 4; ++jt) {
            const int blk = wave * 16 + jt * 4 + (lane >> 4);
            const float4 g0 = ld4(Gs + blk * 16), g1 = ld4(Gs + blk * 16 + 4), g2 = ld4(Gs + blk * 16 + 8), g3 = ld4(Gs + blk * 16 + 12);
#pragma unroll
            for (int v2 = 0; v2 < 2; ++v2) {
                const f32x4 a = accS[jt][v2];
                const float o0 = g0.x * a[0] + g0.y * a[1] + g0.z * a[2] + g0.w * a[3];
                const float o1 = g1.x * a[0] + g1.y * a[1] + g1.z * a[2] + g1.w * a[3];
                const float o2 = g2.x * a[0] + g2.y * a[1] + g2.z * a[2] + g2.w * a[3];
                const float o3 = g3.x * a[0] + g3.y * a[1] + g3.z * a[2] + g3.w * a[3];
                *(uint2*)(Cs + (v2 * 16 + (lane & 15)) * 520 + blk * 4) = make_uint2(pack2bf(o0, o1), pack2bf(o2, o3));
            }
        }
    }
}

DEV void phase_finish1(const Params& p) {
    bf16_t* H = (bf16_t*)(p.ws + OFF_H);
    const bf16_t* XC = (const bf16_t*)(p.ws + OFF_XC);
    const bf16_t* Z = (const bf16_t*)(p.ws + OFF_XM);
    const float* ng = p.in[44]; const float* skip = p.in[45];
    const int tid_ = opaque_tid(); const int lane = tid_ & 63, gw = blockIdx.x * NWV + (tid_ >> 6), ngw = gridDim.x * NWV;
    for (int it = gw; it < NB * NL * 4; it += ngw) {
        const int r = it >> 2, h = it & 3, b = r >= NL ? 1 : 0, nn = r - b * NL;
        const int c0 = h * 512 + lane * 8;
        bf16_t* hp = H + (size_t)r * 2048 + c0;
        float v[8]; unpack8(*(const uint4*)hp, v);
        float sum = 0.f;
#pragma unroll
        for (int j = 0; j < 8; ++j) sum += v[j];
        const float mean = wave_sum(sum) * (1.f / 512.f);
        float sq = 0.f;
#pragma unroll
        for (int j = 0; j < 8; ++j) { v[j] -= mean; sq += v[j] * v[j]; }
        const float rstd = rsqrtf(wave_sum(sq) * (1.f / 512.f) + 1e-5f);
        float xc[8], z[8];
        unpack8(*(const uint4*)(XC + ((size_t)b * TB + NCX + nn) * 2048 + c0), xc);
        unpack8(*(const uint4*)(Z + (size_t)r * 2048 + c0), z);
        float o[8];
#pragma unroll
        for (int j = 0; j < 8; ++j) o[j] = (v[j] * rstd * ng[c0 + j] + skip[c0 + j] * xc[j]) * silu_f(z[j]);
        *(uint4*)hp = make_uint4(pack2bf(o[0], o[1]), pack2bf(o[2], o[3]), pack2bf(o[4], o[5]), pack2bf(o[6], o[7]));
    }
}

__global__ void __launch_bounds__(NTHR) fwd_kernel(Params p) {
    extern __shared__ __attribute__((aligned(16))) float sm[];
    volatile LAS unsigned* xst = (volatile LAS unsigned*)((LAS char*)sm + (LDS_BYTES - 16));
    if (threadIdx.x == 0) { xst[0] = 0u; xst[1] = 0u; }
    __syncthreads();
    const XcdBarrier xbar = xcd_barrier_post((unsigned*)(p.ws + OFF_BAR), xst);
    const int tid = opaque_tid(), lane = tid & 63, wave = tid >> 6;
    float* modv = (float*)(p.ws + OFF_MODV);
    float* X1C = (float*)(p.ws + OFF_X1C);

    phase_mod(p, sm);
    phase_tables(p);
    transpose_convert(p.in[8], 1024, EIN, 4096, (bf16_t*)(p.ws + OFF_WT0), sm);
    transpose_convert(p.in[29], 1024, 4096, 4096, (bf16_t*)(p.ws + OFF_WT1), sm);
    transpose_convert(p.in[9], 1024, 1024, 1024, (bf16_t*)(p.ws + OFF_WT2), sm);
    transpose_convert(p.in[30], 2048, 1024, 1024, (bf16_t*)(p.ws + OFF_WT3), sm);
    xcd_barrier(xbar);

#pragma unroll 1
    for (int b = 0; b < NB; ++b) {
        if (b == 0) { phase_h0(p, 0); xcd_barrier(xbar); }
        run_gemm((const bf16_t*)(p.ws + OFF_YC), (const bf16_t*)(p.ws + OFF_WT0), TB, 4096, DM, EpBf16{(bf16_t*)(p.ws + OFF_P0), EIN, EIN}, sm);
        xcd_barrier(xbar);
        for (int u = blockIdx.x; u < 24 * NCH; u += gridDim.x) {
            if (u < 16 * NCH) rwkv1_unit(p, (u / NCH) >> 1, (u / NCH) & 1, u % NCH, sm);
            else { const int v = u - 16 * NCH; gla1_unit(p, (v / NCH) >> 1, (v / NCH) & 1, v % NCH, sm); }
        }
        xcd_barrier(xbar);
        if (blockIdx.x < 128) gla2_unit(p, blockIdx.x);
        else if (blockIdx.x < 192) { if (wave == 0) rwkv2_unit(p, (blockIdx.x - 128) >> 2, (blockIdx.x - 128) & 3, lane); }
        xcd_barrier(xbar);
        for (int u = blockIdx.x; u < 12 * NCH; u += gridDim.x) {
            if (u < 8 * NCH) rwkv3_unit(p, u / NCH, u % NCH, sm);
            else { const int v = u - 8 * NCH; gla3_unit(p, v / NCH, v % NCH, sm); }
        }
        xcd_barrier(xbar);
        run_gemm((const bf16_t*)(p.ws + OFF_YC), (const bf16_t*)(p.ws + OFF_WT2), TB, DM, DM, EpRes0{(float*)(p.ws + OFF_P0), p.in[0], p.in[2], modv, b}, sm);
        xcd_barrier(xbar);
        ln_rows((const float*)(p.ws + OFF_P0), TB, p.in[6], p.in[7], p.out + (size_t)b * NL * DM, X1C + (size_t)b * NCX * DM, NCX,
                (bf16_t*)(p.ws + OFF_H1B) + (size_t)b * TB * DM, modv + (3 + 2) * 3072, modv + (3 + b) * 3072);
        if (b == 0) phase_h0(p, 1);
        xcd_barrier(xbar);
    }

    run_gemm((const bf16_t*)(p.ws + OFF_H1B), (const bf16_t*)(p.ws + OFF_WT1), RT, 2048, DM, EpBf16{(bf16_t*)(p.ws + OFF_XM), 2048, 2048}, sm);
    zero_f4((float*)(p.ws + OFF_H), (size_t)NB * NL * 1024);
    xcd_barrier(xbar);
    phase_conv1(p, sm);
    xcd_barrier(xbar);
    phase_x1(p, sm);
    xcd_barrier(xbar);
    phase_x2(p, sm);
    xcd_barrier(xbar);
    phase_mlstm(p, sm);
    xcd_barrier(xbar);
    phase_h1l(p);
    xcd_barrier(xbar);
    run_gemm((const bf16_t*)(p.ws + OFF_H1B), (const bf16_t*)(p.ws + OFF_WT1) + (size_t)2048 * 1024, NB * NL, 2048, DM, EpBf16{(bf16_t*)(p.ws + OFF_XM), 2048, 2048}, sm);
    xcd_barrier(xbar);
    phase_finish1(p);
    xcd_barrier(xbar);
    run_gemm((const bf16_t*)(p.ws + OFF_H), (const bf16_t*)(p.ws + OFF_WT3), NB * NL, DM, 2048, EpRes1{(float*)(p.ws + OFF_XC), p.out, modv + 3 * 3072}, sm);
    xcd_barrier(xbar);
    ln_rows((const float*)(p.ws + OFF_XC), NB * NL, p.in[6] + 1024, p.in[7] + 1024, p.out, p.out, 0);
}

extern "C" void kernel_launch(void* const* d_in, const int* in_sizes, int n_in, void* d_out, int out_size, void* d_ws, size_t ws_size, hipStream_t stream) {
    static int grid_blocks = 0;
    if (grid_blocks == 0) {
        if (ws_size < WS_NEED || n_in != 46) { fprintf(stderr, "kernel_launch: bad ws_size %zu (need %zu) or n_in %d\n", ws_size, (size_t)WS_NEED, n_in); grid_blocks = -1; return; }
        int dev = 0, cus = 0, per_cu = 0;
        (void)hipGetDevice(&dev);
        (void)hipDeviceGetAttribute(&cus, hipDeviceAttributeMultiprocessorCount, dev);
        (void)hipFuncSetAttribute((const void*)fwd_kernel, hipFuncAttributeMaxDynamicSharedMemorySize, LDS_BYTES);
        (void)hipOccupancyMaxActiveBlocksPerMultiprocessor(&per_cu, (const void*)fwd_kernel, NTHR, LDS_BYTES);
        if (per_cu < 1 || cus < 256) { fprintf(stderr, "kernel_launch: occupancy query says %d blocks/CU on %d CUs; this kernel needs 256 resident workgroups\n", per_cu, cus); grid_blocks = -1; return; }
        grid_blocks = 256;
    }
    if (grid_blocks < 0) return;
    (void)hipMemsetAsync((char*)d_ws + OFF_BAR, 0, XCD_BAR_WORDS * 4, stream);
    Params p{};
    for (int i = 0; i < 46; ++i) p.in[i] = (const float*)d_in[i];
    p.out = (float*)d_out; p.ws = (char*)d_ws;
    void* args[] = {&p};
    hipError_t e = hipLaunchCooperativeKernel((const void*)fwd_kernel, dim3(grid_blocks), dim3(NTHR), args, LDS_BYTES, stream);
    if (e != hipSuccess) fprintf(stderr, "cooperative launch failed: %s (grid %d)\n", hipGetErrorString(e), grid_blocks);
}
```

```cpp
#include <hip/hip_runtime.h>
#include <cstdio>
#include <cmath>

#define DEV __device__ __forceinline__

constexpr int NB = 2, NL = 8192, DM = 1024, NCX = 256, TB = NCX + NL;
constexpr int RT = NB * TB;
constexpr int NCH = TB / 64;
constexpr int EIN = 3872, RW0 = 1568;
constexpr int NTHR = 512, NWV = 8;
constexpr float ALPHA = 1.41421356237f;
constexpr float KSCALE = 0.04419417382f;

constexpr size_t OFF_MODV = 0;
constexpr size_t OFF_X1C  = 131072;
constexpr size_t OFF_BAR  = 3145728;
constexpr size_t OFF_BIG  = 4194304;
constexpr size_t OFF_P0   = OFF_BIG;
constexpr size_t OFF_YC   = OFF_BIG + (size_t)TB * EIN * 2;
constexpr size_t OFF_GDS  = OFF_YC + (size_t)TB * 1024 * 2;
constexpr size_t OFF_GDEC = OFF_GDS + (size_t)8 * NCH * 8192 * 4;
constexpr size_t OFF_RU   = OFF_GDEC + (size_t)8 * NCH * 64 * 4;
constexpr size_t OFF_RS0  = OFF_RU + (size_t)16 * NCH * 16384 * 2;
constexpr size_t OFF_BONS = OFF_RS0 + (size_t)16 * NCH * 4096 * 2;
constexpr size_t L0_END   = OFF_BONS + (size_t)2 * TB * 8 * 4;
constexpr size_t OFF_XM   = OFF_BIG;
constexpr size_t OFF_XC   = OFF_XM + (size_t)RT * 2048 * 2;
constexpr size_t OFF_H    = OFF_XC + (size_t)RT * 2048 * 2;
constexpr size_t OFF_WT0  = OFF_H + (size_t)NB * NL * 2048 * 2;
constexpr size_t OFF_WT1  = OFF_WT0 + (size_t)4096 * 1024 * 2;
constexpr size_t OFF_WT2  = OFF_WT1 + (size_t)4096 * 1024 * 2;
constexpr size_t OFF_WT3  = OFF_WT2 + (size_t)1024 * 1024 * 2;
constexpr size_t OFF_G16  = OFF_WT3 + (size_t)1024 * 2048 * 2;
constexpr size_t OFF_SMAT = OFF_G16 + (size_t)RT * 16 * 4;
constexpr size_t OFF_GSC  = OFF_SMAT + (size_t)NB * 4 * NCH * 4096 * 2;
constexpr size_t OFF_CSC  = OFF_GSC + (size_t)16 * TB * 4 * 4;
constexpr size_t OFF_NBUF = OFF_CSC + (size_t)16 * NCH * 2 * 4;
constexpr size_t OFF_GTAB = 3407872;
constexpr size_t OFF_WFT  = OFF_GTAB + (size_t)4 * 128 * 16 * 4;
static_assert(OFF_WFT + (size_t)16 * 4096 * 2 <= OFF_BIG, "low-region tables overflow");
constexpr size_t OFF_G16P = OFF_NBUF + (size_t)16 * NCH * 512 * 4;
constexpr size_t OFF_H1B  = OFF_G16;
constexpr size_t WS_NEED  = (OFF_G16P + (size_t)4 * RT * 16 * 4 > OFF_H1B + (size_t)RT * 1024 * 2) ? OFF_G16P + (size_t)4 * RT * 16 * 4 : OFF_H1B + (size_t)RT * 1024 * 2;
static_assert(WS_NEED <= (size_t)256 * 1024 * 1024, "workspace exceeds the guaranteed 256 MiB");

static_assert(L0_END <= OFF_WT0, "layer-0 buffers overlap the weight copies");
constexpr int LDS_BYTES = 139264;

struct Params { const float* in[46]; float* out; char* ws; };
typedef unsigned short bf16_t;
typedef __attribute__((ext_vector_type(8))) short bf16x8;
typedef __attribute__((ext_vector_type(4))) short s16x4;
typedef __attribute__((ext_vector_type(2))) short s16x2;
typedef __attribute__((ext_vector_type(4))) float f32x4;
typedef __attribute__((ext_vector_type(2))) __bf16 bf2_t;
DEV unsigned pack2bf(float lo, float hi) { bf2_t v; v[0] = (__bf16)lo; v[1] = (__bf16)hi; return __builtin_bit_cast(unsigned, v); }
DEV float bflo(unsigned u) { return __uint_as_float(u << 16); }
DEV float bfhi(unsigned u) { return __uint_as_float(u & 0xffff0000u); }
DEV float bf2f(bf16_t v) { return __uint_as_float(((unsigned)v) << 16); }
DEV void unpack8(uint4 u, float* f) { f[0] = bflo(u.x); f[1] = bfhi(u.x); f[2] = bflo(u.y); f[3] = bfhi(u.y); f[4] = bflo(u.z); f[5] = bfhi(u.z); f[6] = bflo(u.w); f[7] = bfhi(u.w); }

DEV float wave_sum(float v) {
#pragma unroll
    for (int o = 32; o > 0; o >>= 1) v += __shfl_xor(v, o, 64);
    return v;
}
DEV float wave_max(float v) {
#pragma unroll
    for (int o = 32; o > 0; o >>= 1) v = fmaxf(v, __shfl_xor(v, o, 64));
    return v;
}
DEV float fexp(float x) { return __expf(x); }
DEV float frcp(float x) { return __builtin_amdgcn_rcpf(x); }
DEV float sigmoid_f(float x) { return frcp(1.f + fexp(-x)); }
DEV float silu_f(float x) { return x * frcp(1.f + fexp(-x)); }
DEV float logsig_f(float x) { return fminf(x, 0.f) - __logf(1.f + fexp(-fabsf(x))); }
DEV float tanh_f(float x) { const float e = fexp(2.f * x); return 1.f - 2.f * frcp(e + 1.f); }
DEV void lds_fence() { asm volatile("" ::: "memory"); }
DEV int opaque_tid() { int t = threadIdx.x; asm volatile("" : "+v"(t)); return t; }
DEV int scan_s(int dir, int u) { return dir == 0 ? u : (u < NCX ? (NCX - 1 - u) : (TB - 1 + NCX - u)); }
DEV int chunk_at(int dir, int step) { return dir == 0 ? step : (step < 4 ? 3 - step : (NCH + 3 - step)); }
DEV float4 ld4(const float* p) { return *(const float4*)p; }
DEV void st4(float* p, float4 v) { *(float4*)p = v; }


#define XB_TMO      128
#define XB_XCNT(j)  (256  + 64 * (j))
#define XB_XSUB(j)  (1280 + 64 * (j))
#define XB_XGEN(j)  (2304 + 64 * (j))
#define XB_TOP      3328
#define XB_TOPGEN   3392
#define XCD_BAR_WORDS 3456
#define XB_SPIN_CAP (1u << 22)
#define LAS __attribute__((address_space(3)))
DEV unsigned xb_ld(unsigned* p) { return __hip_atomic_load(p, __ATOMIC_RELAXED, __HIP_MEMORY_SCOPE_AGENT); }
DEV unsigned xb_add(unsigned* p, unsigned v) { return __hip_atomic_fetch_add(p, v, __ATOMIC_RELAXED, __HIP_MEMORY_SCOPE_AGENT); }
DEV unsigned xb_xcc_id() { return (unsigned)__builtin_amdgcn_s_getreg((3 << 11) | 20) & 0xFu; }
#define XB_SPIN(cond, bar) do { unsigned _sp = 0; while (cond) { __builtin_amdgcn_s_sleep(1); \
    if ((++_sp & 255u) == 0u) { if (xb_ld(&(bar)[XB_TMO])) break; if (_sp > XB_SPIN_CAP) { atomicAdd(&(bar)[XB_TMO], 1u); break; } } } } while (0)
struct XcdBarrier { unsigned* bar; unsigned x; volatile LAS unsigned* st; };
DEV XcdBarrier xcd_barrier_post(unsigned* bar, volatile LAS unsigned* st) {
    XcdBarrier b; b.bar = bar; b.x = xb_xcc_id(); b.st = st;
    if (threadIdx.x == 0) (void)xb_add(&bar[XB_XCNT(b.x)], 1u);
    return b;
}
DEV void xcd_barrier_complete(unsigned* bar, unsigned x, unsigned& nloc, unsigned& nx) {
    const unsigned G = gridDim.x * gridDim.y * gridDim.z;
    unsigned sum, cnt, mine, sp = 0u;
    for (;;) {
        sum = 0u; cnt = 0u; mine = 0u;
#pragma unroll
        for (unsigned j = 0; j < 16; ++j) { const unsigned c = xb_ld(&bar[XB_XCNT(j)]); sum += c; cnt += (c > 0u) ? 1u : 0u; mine = (j == x) ? c : mine; }
        if (sum == G) break;
        __builtin_amdgcn_s_sleep(1);
        if ((++sp & 255u) == 0u) { if (xb_ld(&bar[XB_TMO])) break; if (sp > XB_SPIN_CAP) { atomicAdd(&bar[XB_TMO], 1u); break; } }
    }
    nloc = mine > 0u ? mine : 1u; nx = cnt > 0u ? cnt : 1u;
}
DEV void xcd_barrier(const XcdBarrier& b) {
    asm volatile("s_waitcnt vmcnt(0)" ::: "memory");
    __syncthreads();
    if (threadIdx.x == 0) {
        unsigned* bar = b.bar;
        __builtin_amdgcn_s_waitcnt(0);
        unsigned nloc = b.st[0], nx = b.st[1];
        if (nloc == 0u) { xcd_barrier_complete(bar, b.x, nloc, nx); b.st[0] = nloc; b.st[1] = nx; }
        const unsigned old = xb_add(&bar[XB_XSUB(b.x)], 1u);
        const unsigned gen = old / nloc;
        if (old + 1u == (gen + 1u) * nloc) {
            __builtin_amdgcn_fence(__ATOMIC_RELEASE, "agent");
            asm volatile("s_waitcnt vmcnt(0)" ::: "memory");
            const unsigned og = xb_add(&bar[XB_TOP], 1u);
            const unsigned tg = og / nx;
            if (og + 1u == (tg + 1u) * nx) xb_add(&bar[XB_TOPGEN], 1u);
            else XB_SPIN(xb_ld(&bar[XB_TOPGEN]) == tg, bar);
            __builtin_amdgcn_fence(__ATOMIC_ACQUIRE, "agent");
            xb_add(&bar[XB_XGEN(b.x)], 1u);
            asm volatile("s_waitcnt vmcnt(0)" ::: "memory");
        } else {
            XB_SPIN(xb_ld(&bar[XB_XGEN(b.x)]) == gen, bar);
            __builtin_amdgcn_fence(__ATOMIC_ACQUIRE, "agent");
            asm volatile("s_waitcnt vmcnt(0)" ::: "memory");
        }
    }
    __syncthreads();
}

namespace pg8 {
#define PG8_LAS __attribute__((address_space(3)))
typedef unsigned short bf16_t;
typedef short bf16x8 __attribute__((ext_vector_type(8)));
typedef float f32x4 __attribute__((ext_vector_type(4)));
typedef unsigned u32x4 __attribute__((ext_vector_type(4)));
constexpr int BM = 256, BK = 64, HALF = 128, HTB = HALF * BK * 2  , STAGE_BYTES = 8 * HTB, NXCD = 8, WGM = 8;

__host__ __device__ __forceinline__ int lds_byte(int r, int c) { const int st = (r >> 4) * 2 + (c >> 5), rr = r & 15, cc = c & 31, ob = rr * 64 + cc * 2; return st * 1024 + (ob ^ (((ob >> 9) & 1) << 5)); }
__host__ __device__ __forceinline__ void stage_rc(int b, int& R, int& C) { const int st = b / 1024, sb = b % 1024, swz = sb ^ (((sb >> 9) & 1) << 5); R = (st >> 1) * 16 + swz / 64; C = (st & 1) * 32 + (swz % 64) / 2; }
__host__ __device__ __forceinline__ int perm32(int rho) { const int n = rho >> 4, i = rho & 15; return 8 * (i >> 2) + 4 * n + (i & 3); }

struct Unit { int pm, pn; };
struct Gemm { const bf16_t* A; const bf16_t* Bt; int M, N, K; };

struct StaticOrder {
    int nM, nN, nwg, G, c;
    __host__ __device__ void init(int M, int N, int G_, int c_) { nM = M / BM; nN = N / BM; nwg = nM * nN; G = G_; c = c_; }
    __host__ __device__ bool next(int i, Unit& u) const {
        const long L = (long)i * G + c; if (L >= nwg) return false;
        int wgid = (int)L; { const int q = nwg / NXCD, r = nwg % NXCD, xcd = wgid % NXCD, off = wgid / NXCD; wgid = (xcd < r ? xcd * (q + 1) : r * (q + 1) + (xcd - r) * q) + off; }
        const int nig = WGM * nN, gid = wgid / nig, fm = gid * WGM, gsz = (nM - fm) < WGM ? (nM - fm) : WGM;
        u.pm = fm + ((wgid % nig) % gsz); u.pn = (wgid % nig) / gsz; return true;
    }
    __device__ __forceinline__ void a_ready(const Unit&) const {}
    __device__ __forceinline__ void done(const Unit&) const {}
};

template <class Epi, class Sched, bool STAMP = false>
__device__ __forceinline__ void gemm_phase(PG8_LAS unsigned char* lds, const Gemm g, const Sched& S, const Epi& E, unsigned long long* stamps) {
    int tid = threadIdx.x; asm volatile("" : "+v"(tid));
    const int wid = __builtin_amdgcn_readfirstlane(tid >> 6), lane = tid & 63, wr = wid >> 2, wc = wid & 3, fr = lane & 15, fq = lane >> 4;
    const int K = g.K, nt = K / BK;
#define PG8_STAMP() do { } while (0)
    PG8_STAMP();
    unsigned voffA[2], voffB[2];
#pragma unroll
    for (int i = 0; i < 2; ++i) { int R, C; stage_rc(tid * 16 + i * 8192, R, C); const int Rb = Epi::PERM ? ((R & ~31) + perm32(R & 31)) : R;
        voffA[i] = (unsigned)(R * K + C) * 2u; voffB[i] = (unsigned)(Rb * K + C) * 2u; }
    const size_t kstep = (size_t)(BK * 2);
    const size_t hstep = (size_t)HALF * K * 2;
    const size_t tstep = 2 * hstep;
    const unsigned ldsw = (unsigned)wid * 1024u;
    const int aoff = lds_byte(wr * 64 + fr, fq * 8), boff = lds_byte(wc * 32 + fr, fq * 8);
#define PG8_SA(b, h) (((b) * 2 + (h)) * HTB)
#define PG8_SB(b, h) ((4 + (b) * 2 + (h)) * HTB)
#define PG8_STAGE(bufoff, gbase, voff) do { _Pragma("unroll") for (int _i = 0; _i < 2; ++_i) \
        __builtin_amdgcn_global_load_lds((const unsigned*)((const char*)(gbase) + (voff)[_i]), (PG8_LAS unsigned*)(lds + (bufoff) + ldsw + _i * 8192), 16, 0, 0); } while (0)
#define PG8_LDA(dst, b, h) do { _Pragma("unroll") for (int m = 0; m < 4; ++m) _Pragma("unroll") for (int k = 0; k < 2; ++k) dst[m][k] = *(const PG8_LAS bf16x8*)(lds + PG8_SA(b, h) + aoff + m * 2048 + k * 1024); } while (0)
#define PG8_LDB(dst, b, h) do { _Pragma("unroll") for (int n = 0; n < 2; ++n) _Pragma("unroll") for (int k = 0; k < 2; ++k) dst[n][k] = *(const PG8_LAS bf16x8*)(lds + PG8_SB(b, h) + boff + n * 2048 + k * 1024); } while (0)
#define PG8_MMA(ai, bj, At, Bt) do { __builtin_amdgcn_s_setprio(1); _Pragma("unroll") for (int m = 0; m < 4; ++m) _Pragma("unroll") for (int n = 0; n < 2; ++n) _Pragma("unroll") for (int k = 0; k < 2; ++k) \
        acc[ai][bj][m][n] = __builtin_amdgcn_mfma_f32_16x16x32_bf16(Bt[n][k], At[m][k], acc[ai][bj][m][n], 0, 0, 0); __builtin_amdgcn_s_setprio(0); } while (0)
#define PG8_WAIT_V(n) asm volatile("s_waitcnt vmcnt(" #n ")" ::: "memory")
#define PG8_WAIT_L(n) asm volatile("s_waitcnt lgkmcnt(" #n ")" ::: "memory")
#define PG8_BAR __builtin_amdgcn_s_barrier()
#define PG8_SCHED __builtin_amdgcn_sched_barrier(0)
    Unit cur, nxt; int ui = 0;
    if (!S.next(0, cur)) return;
    f32x4 acc[2][2][4][2];
#pragma unroll
    for (int a = 0; a < 2; ++a)
#pragma unroll
        for (int b = 0; b < 2; ++b)
#pragma unroll
            for (int m = 0; m < 4; ++m)
#pragma unroll
                for (int n = 0; n < 2; ++n) acc[a][b][m][n] = (f32x4){0.f, 0.f, 0.f, 0.f};
    bf16x8 At[4][2], B0[2][2], B1[2][2];
    const char* cA = (const char*)g.A + (size_t)cur.pm * tstep; const char* cB = (const char*)g.Bt + (size_t)cur.pn * tstep;
    S.a_ready(cur);
    PG8_STAGE(PG8_SB(0, 0), cB, voffB); PG8_STAGE(PG8_SA(0, 0), cA, voffA); PG8_STAGE(PG8_SB(0, 1), cB + hstep, voffB); PG8_STAGE(PG8_SA(0, 1), cA + hstep, voffA);
    if (wr == 1) PG8_BAR;
    PG8_WAIT_V(4); PG8_BAR;
    PG8_STAGE(PG8_SB(1, 0), cB + kstep, voffB); PG8_STAGE(PG8_SA(1, 0), cA + kstep, voffA); PG8_STAGE(PG8_SB(1, 1), cB + hstep + kstep, voffB);
    PG8_WAIT_V(6); PG8_BAR;
    PG8_STAMP();
    for (;;) {
        const bool has_next = S.next(ui + 1, nxt);
        const char* nA = has_next ? (const char*)g.A + (size_t)nxt.pm * tstep : cA; const char* nB = has_next ? (const char*)g.Bt + (size_t)nxt.pn * tstep : cB;
        for (int t = 0; t < nt; t += 2) {
            const bool last = (t == nt - 2);
            const char* a1 = cA + (size_t)(t + 1) * kstep;
            const char* a2 = last ? nA : cA + (size_t)(t + 2) * kstep; const char* b2 = last ? nB : cB + (size_t)(t + 2) * kstep;
            const char* a3 = a2 + kstep; const char* b3 = b2 + kstep;
            if (last && has_next) S.a_ready(nxt);
            PG8_LDB(B0, 0, 0); PG8_SCHED; PG8_LDA(At, 0, 0); PG8_STAGE(PG8_SA(1, 1), a1 + hstep, voffA);
            PG8_WAIT_L(8); PG8_BAR; PG8_WAIT_L(0); PG8_MMA(0, 0, At, B0); PG8_BAR; PG8_SCHED;
            PG8_LDB(B1, 0, 1); PG8_STAGE(PG8_SB(0, 0), b2, voffB);
            PG8_BAR; PG8_WAIT_L(0); PG8_MMA(0, 1, At, B1); PG8_BAR;
            PG8_LDA(At, 0, 1); PG8_STAGE(PG8_SA(0, 0), a2, voffA);
            PG8_BAR; PG8_WAIT_L(0); PG8_MMA(1, 0, At, B0); PG8_BAR; PG8_SCHED;
            PG8_STAGE(PG8_SB(0, 1), b2 + hstep, voffB);
            PG8_WAIT_V(6); PG8_BAR; PG8_MMA(1, 1, At, B1); PG8_BAR;
            PG8_LDB(B0, 1, 0); PG8_SCHED; PG8_LDA(At, 1, 0); PG8_STAGE(PG8_SA(0, 1), a2 + hstep, voffA);
            PG8_WAIT_L(8); PG8_BAR; PG8_WAIT_L(0); PG8_MMA(0, 0, At, B0); PG8_BAR; PG8_SCHED;
            PG8_LDB(B1, 1, 1); PG8_STAGE(PG8_SB(1, 0), b3, voffB);
            PG8_BAR; PG8_WAIT_L(0); PG8_MMA(0, 1, At, B1); PG8_BAR;
            PG8_LDA(At, 1, 1); PG8_STAGE(PG8_SA(1, 0), a3, voffA);
            PG8_BAR; PG8_WAIT_L(0); PG8_MMA(1, 0, At, B0); PG8_BAR; PG8_SCHED;
            PG8_STAGE(PG8_SB(1, 1), b3 + hstep, voffB);
            PG8_WAIT_V(6); PG8_BAR; PG8_MMA(1, 1, At, B1); PG8_BAR;
        }
        PG8_STAMP();
        if constexpr (!Epi::AFTER_DRAIN) { E(acc, cur, wr, wc, fr, fq); S.done(cur); }
        PG8_STAMP();
        if (!has_next) break;
#pragma unroll
        for (int a = 0; a < 2; ++a)
#pragma unroll
            for (int b = 0; b < 2; ++b)
#pragma unroll
                for (int m = 0; m < 4; ++m)
#pragma unroll
                    for (int n = 0; n < 2; ++n) acc[a][b][m][n] = (f32x4){0.f, 0.f, 0.f, 0.f};
        cur = nxt; cA = nA; cB = nB; ++ui;
    }
    PG8_WAIT_V(0);
    if (wr == 0) PG8_BAR;
    PG8_BAR;
    if constexpr (Epi::AFTER_DRAIN) { E.fused(acc, cur, wr, wc, fr, fq, lds, wid, lane); S.done(cur); }
    PG8_STAMP();
#undef PG8_STAMP
#undef PG8_SA
#undef PG8_SB
#undef PG8_STAGE
#undef PG8_LDA
#undef PG8_LDB
#undef PG8_MMA
#undef PG8_WAIT_V
#undef PG8_WAIT_L
#undef PG8_BAR
#undef PG8_SCHED
}
}

DEV void transpose_convert(const float* __restrict__ W, int K, int N, int Npad, bf16_t* Wt, float* sm) {
    float (*T)[65] = (float (*)[65])sm;
    const int tid = opaque_tid();
    const int kt = K / 64, ntl = Npad / 64;
    for (int tile = blockIdx.x; tile < kt * ntl; tile += gridDim.x) {
        const int k0 = (tile / ntl) * 64, n0 = (tile % ntl) * 64;
        __syncthreads();
#pragma unroll
        for (int i = 0; i < 2; ++i) {
            const int k = (tid >> 4) + 32 * i, n4 = (tid & 15) * 4;
            float4 v = make_float4(0.f, 0.f, 0.f, 0.f);
            if (n0 + n4 < N) v = ld4(W + (size_t)(k0 + k) * N + n0 + n4);
            T[k][n4] = v.x; T[k][n4 + 1] = v.y; T[k][n4 + 2] = v.z; T[k][n4 + 3] = v.w;
        }
        __syncthreads();
        const int n = tid >> 3, kq = (tid & 7) * 8;
        unsigned o[4];
#pragma unroll
        for (int j = 0; j < 4; ++j) o[j] = pack2bf(T[kq + 2 * j][n], T[kq + 2 * j + 1][n]);
        bf16_t* dst = Wt + (size_t)(n0 + n) * K + k0 + kq;
        *(uint4*)dst = make_uint4(o[0], o[1], o[2], o[3]);
    }
}

struct EpBf16 {
    static constexpr bool PERM = true, AFTER_DRAIN = false;
    bf16_t* O; int ldc; int ncols;
    DEV void operator()(const pg8::f32x4 (&acc)[2][2][4][2], const pg8::Unit& u, int wr, int wc, int fr, int fq) const {
        const int row0 = u.pm * 256 + wr * 64 + fr, col0 = u.pn * 256 + wc * 32 + 8 * fq;
#pragma unroll
        for (int ai = 0; ai < 2; ++ai)
#pragma unroll
            for (int m = 0; m < 4; ++m) {
                bf16_t* rowp = O + (size_t)(row0 + ai * 128 + m * 16) * ldc + col0;
#pragma unroll
                for (int bj = 0; bj < 2; ++bj) {
                    if (col0 + bj * 128 < ncols) {
                        const pg8::f32x4 v0 = acc[ai][bj][m][0], v1 = acc[ai][bj][m][1];
                        *(uint4*)(rowp + bj * 128) = make_uint4(pack2bf(v0[0], v0[1]), pack2bf(v0[2], v0[3]), pack2bf(v1[0], v1[1]), pack2bf(v1[2], v1[3]));
                    }
                }
            }
    }
};
struct EpRes0 {
    static constexpr bool PERM = false, AFTER_DRAIN = false;
    float* C; const float* lat; const float* cx; const float* mv; int b;
    DEV void operator()(const pg8::f32x4 (&acc)[2][2][4][2], const pg8::Unit& u, int wr, int wc, int fr, int fq) const {
        const bool isc = (u.pm * 256 < NCX);
        const float* base = isc ? cx + (size_t)b * NCX * DM : lat + ((size_t)b * NL - NCX) * DM;
        const float* gp = mv + (isc ? 2 : b) * 3072 + 2048;
        const int row0 = u.pm * 256 + wr * 64 + fr, col0 = u.pn * 256 + wc * 32 + 4 * fq;
#pragma unroll
        for (int ai = 0; ai < 2; ++ai)
#pragma unroll
            for (int m = 0; m < 4; ++m) {
                const size_t ro = (size_t)(row0 + ai * 128 + m * 16) * DM + col0;
#pragma unroll
                for (int bj = 0; bj < 2; ++bj)
#pragma unroll
                    for (int n = 0; n < 2; ++n) {
                        const int co = bj * 128 + n * 16;
                        const float4 x = ld4(base + ro + co), g = ld4(gp + col0 + co); const pg8::f32x4 v = acc[ai][bj][m][n];
                        st4(C + ro + co, make_float4(ALPHA * x.x + g.x * v[0], ALPHA * x.y + g.y * v[1], ALPHA * x.z + g.z * v[2], ALPHA * x.w + g.w * v[3]));
                    }
            }
    }
};
struct EpRes1 {
    static constexpr bool PERM = false, AFTER_DRAIN = false;
    float* C; const float* lat; const float* mv;
    DEV void operator()(const pg8::f32x4 (&acc)[2][2][4][2], const pg8::Unit& u, int wr, int wc, int fr, int fq) const {
        const float* gp = mv + (u.pm * 256 >= NL ? 1 : 0) * 3072 + 2048;
        const int row0 = u.pm * 256 + wr * 64 + fr, col0 = u.pn * 256 + wc * 32 + 4 * fq;
#pragma unroll
        for (int ai = 0; ai < 2; ++ai)
#pragma unroll
            for (int m = 0; m < 4; ++m) {
                const size_t ro = (size_t)(row0 + ai * 128 + m * 16) * DM + col0;
#pragma unroll
                for (int bj = 0; bj < 2; ++bj)
#pragma unroll
                    for (int n = 0; n < 2; ++n) {
                        const int co = bj * 128 + n * 16;
                        const float4 x = ld4(lat + ro + co), g = ld4(gp + col0 + co); const pg8::f32x4 v = acc[ai][bj][m][n];
                        st4(C + ro + co, make_float4(ALPHA * x.x + g.x * v[0], ALPHA * x.y + g.y * v[1], ALPHA * x.z + g.z * v[2], ALPHA * x.w + g.w * v[3]));
                    }
            }
    }
};
template <class EP>
DEV void run_gemm(const bf16_t* A, const bf16_t* Bt, int M, int N, int K, const EP& ep, float* sm) {
    pg8::Gemm g{A, Bt, M, N, K}; pg8::StaticOrder S; S.init(M, N, (int)gridDim.x, (int)blockIdx.x);
    pg8::gemm_phase<EP, pg8::StaticOrder, false>((PG8_LAS unsigned char*)sm, g, S, ep, nullptr);
}

DEV void phase_h0(const Params& p, int b) {
    const float* modv = (const float*)(p.ws + OFF_MODV);
    bf16_t* H0 = (bf16_t*)(p.ws + OFF_YC);
    const int gt = blockIdx.x * NTHR + opaque_tid(), gn = gridDim.x * NTHR;
    for (int i = gt; i < TB * 128; i += gn) {
        const int s = i >> 7, k = (i & 127) * 8;
        const float* src; int j;
        if (s < NCX) { src = p.in[2] + ((size_t)(b * NCX + s)) * DM + k; j = 2; }
        else { src = p.in[0] + ((size_t)(b * NL + s - NCX)) * DM + k; j = b; }
        const float4 x0 = ld4(src), x1 = ld4(src + 4);
        const float* m = modv + j * 3072;
        const float4 s0 = ld4(m + k), s1 = ld4(m + k + 4), c0 = ld4(m + 1024 + k), c1 = ld4(m + 1024 + k + 4);
        *(uint4*)(H0 + (size_t)s * DM + k) = make_uint4(pack2bf(x0.x * (1.f + c0.x) + s0.x, x0.y * (1.f + c0.y) + s0.y), pack2bf(x0.z * (1.f + c0.z) + s0.z, x0.w * (1.f + c0.w) + s0.w),
                                                      pack2bf(x1.x * (1.f + c1.x) + s1.x, x1.y * (1.f + c1.y) + s1.y), pack2bf(x1.z * (1.f + c1.z) + s1.z, x1.w * (1.f + c1.w) + s1.w));
    }
}

DEV void phase_mod(const Params& p, float* sm) {
    const float* c = p.in[1]; const float* cctx = p.in[3];
    const float* mod_w = p.in[4]; const float* mod_b = p.in[5];
    float* modv = (float*)(p.ws + OFF_MODV);
    float* sil = sm; float* red = sm + 3072;
    const int tid = opaque_tid();
    for (int i = tid; i < 3072; i += NTHR) {
        const int j = i >> 10, k = i & 1023;
        const float v = (j < 2) ? c[j * 1024 + k] : cctx[k];
        sil[i] = silu_f(v);
    }
    __syncthreads();
    for (int unit = blockIdx.x; unit < 192; unit += gridDim.x) {
        const int l = unit / 96, cb = unit % 96;
        const int kg = tid >> 5, col = tid & 31, n = cb * 32 + col;
        const float* w = mod_w + (size_t)l * 1024 * 3072 + n;
        float a0 = 0.f, a1 = 0.f, a2 = 0.f;
        for (int k = kg * 64; k < kg * 64 + 64; ++k) {
            const float wv = w[(size_t)k * 3072];
            a0 += sil[k] * wv; a1 += sil[1024 + k] * wv; a2 += sil[2048 + k] * wv;
        }
        red[(kg * 3 + 0) * 32 + col] = a0; red[(kg * 3 + 1) * 32 + col] = a1; red[(kg * 3 + 2) * 32 + col] = a2;
        __syncthreads();
        if (tid < 96) {
            const int j = tid >> 5, cc = tid & 31, nn = cb * 32 + cc;
            float s = mod_b[l * 3072 + nn];
            for (int g = 0; g < 16; ++g) s += red[(g * 3 + j) * 32 + cc];
            modv[(l * 3 + j) * 3072 + nn] = s;
        }
        __syncthreads();
    }
}

DEV void phase_tables(const Params& p) {
    const float* wq = p.in[33]; const float* wk = p.in[34]; const float* wv = p.in[35];
    const float* gw0 = p.in[36]; const float* gw1 = p.in[38]; const float* gw2 = p.in[40]; const float* gw3 = p.in[42];
    float* gtab = (float*)(p.ws + OFF_GTAB); bf16_t* wft = (bf16_t*)(p.ws + OFF_WFT);
    const int gt = blockIdx.x * NTHR + opaque_tid(), gn = gridDim.x * NTHR;
    for (int i = gt; i < 512 * 16; i += gn) {
        const int gb = i >> 4, cp = (i >> 2) & 3, c = i & 3;
        float s = 0.f;
#pragma unroll
        for (int d = 0; d < 4; ++d) s += wq[gb * 16 + cp * 4 + d] * wk[gb * 16 + c * 4 + d];
        gtab[i] = s * KSCALE;
    }
    for (int i = gt; i < 4096 * 16; i += gn) {
        const int g = i >> 12, k = i & 4095, gm = g >> 2, hd = g & 3;
        const float* wg = gm == 0 ? gw0 : (gm == 1 ? gw1 : (gm == 2 ? gw2 : gw3));
        float s = 0.f;
        if (k < 2048) {
            const int blk = k >> 2, cc = k & 3;
#pragma unroll
            for (int d = 0; d < 4; ++d) s += wq[blk * 16 + cc * 4 + d] * wg[(size_t)(4 * blk + d) * 4 + hd] + wk[blk * 16 + cc * 4 + d] * wg[(size_t)(2048 + 4 * blk + d) * 4 + hd];
        } else {
            const int kk = k - 2048, blk = kk >> 2, cc = kk & 3;
#pragma unroll
            for (int d = 0; d < 4; ++d) s += wv[blk * 16 + cc * 4 + d] * wg[(size_t)(4096 + 4 * blk + d) * 4 + hd];
        }
        wft[i] = __builtin_bit_cast(unsigned short, (__bf16)s);
    }
}

DEV float wave_scan_add(float v, int lane, int dir) {
#pragma unroll
    for (int o = 1; o < 64; o <<= 1) {
        const float n = dir ? __shfl_down(v, o, 64) : __shfl_up(v, o, 64);
        const bool ok = dir ? (lane + o < 64) : (lane >= o);
        if (ok) v += n;
    }
    return v;
}
DEV float wave_scan_max(float v, int lane, int dir) {
#pragma unroll
    for (int o = 1; o < 64; o <<= 1) {
        const float n = dir ? __shfl_down(v, o, 64) : __shfl_up(v, o, 64);
        const bool ok = dir ? (lane + o < 64) : (lane >= o);
        if (ok) v = fmaxf(v, n);
    }
    return v;
}

DEV void gla_decay(const bf16_t* P0, int c, int h, int dir, const float* __restrict__ wa2, const float* __restrict__ ba,
                   float* sLR, float* sWA, float* sBC, float* sTot, int tid) {
    for (int i = tid; i < 1024; i += NTHR) { const int t = i >> 4, j = i & 15; sLR[i] = bf2f(P0[(size_t)(c * 64 + t) * EIN + 1536 + dir * 16 + j]); }
    for (int i = tid; i < 1024; i += NTHR) { const int ii = i >> 6, k = i & 63; sWA[i] = wa2[ii * 256 + h * 64 + k]; }
    __syncthreads();
    {
        const int t = tid >> 3, k0 = (tid & 7) * 8;
        float acc[8];
#pragma unroll
        for (int j = 0; j < 8; ++j) acc[j] = ba[h * 64 + k0 + j];
#pragma unroll
        for (int ii = 0; ii < 16; ++ii) {
            const float l = sLR[t * 16 + ii];
#pragma unroll
            for (int j = 0; j < 8; ++j) acc[j] += l * sWA[ii * 64 + k0 + j];
        }
#pragma unroll
        for (int j = 0; j < 8; ++j) sBC[t * 65 + k0 + j] = logsig_f(acc[j]) * 0.0625f;
    }
    __syncthreads();
    {
        const int lane = tid & 63, wv = tid >> 6;
#pragma unroll
        for (int j = 0; j < 8; ++j) {
            const int k = wv * 8 + j;
            const float v = wave_scan_add(sBC[lane * 65 + k], lane, dir);
            sBC[lane * 65 + k] = v;
            if (lane == (dir ? 0 : 63)) sTot[k] = v;
        }
    }
    __syncthreads();
}
DEV bf16x8 tr_frag(const bf16_t* base, int ld, int row0, int col0, int lane) {
    const bf16_t* ptr = base + (row0 + (lane >> 4) * 8 + ((lane & 15) >> 2)) * ld + col0 + (lane & 3) * 4;
    const s16x4 lo = __builtin_amdgcn_ds_read_tr16_b64_v4i16((__attribute__((address_space(3))) s16x4*)ptr);
    const s16x4 hi = __builtin_amdgcn_ds_read_tr16_b64_v4i16((__attribute__((address_space(3))) s16x4*)(ptr + 4 * ld));
    return (bf16x8){lo[0], lo[1], lo[2], lo[3], hi[0], hi[1], hi[2], hi[3]};
}
DEV bf16x8 row_frag(const bf16_t* base, int ld, int idx0, int k0, int lane) {
    return *(const bf16x8*)(base + (idx0 + (lane & 15)) * ld + k0 + (lane >> 4) * 8);
}

DEV void gla1_unit(const Params& p, int h, int dir, int c, float* sm) {
    const int tid = opaque_tid(), lane = tid & 63, wave = tid >> 6;
    const bf16_t* P0 = (const bf16_t*)(p.ws + OFF_P0);
    float* GDS = (float*)(p.ws + OFF_GDS); float* GDEC = (float*)(p.ws + OFF_GDEC);
    const float* wa2 = p.in[dir ? 12 : 10]; const float* ba = p.in[dir ? 13 : 11];
    float* sLR = sm; float* sWA = sm + 1024; float* sBC = sm + 2048; float* sTot = sm + 6208;
    bf16_t* kT = (bf16_t*)(sm + 6272);
    bf16_t* Vs = (bf16_t*)(sm + 8576);
    const int ch = h * 2 + dir;
    __syncthreads();
    gla_decay(P0, c, h, dir, wa2, ba, sLR, sWA, sBC, sTot, tid);
    {
        const int t = tid >> 3, k0 = (tid & 7) * 8;
        float kv[8]; unpack8(*(const uint4*)(P0 + (size_t)(c * 64 + t) * EIN + 256 + h * 64 + k0), kv);
#pragma unroll
        for (int j = 0; j < 8; ++j) kT[(k0 + j) * 72 + t] = __builtin_bit_cast(unsigned short, (__bf16)(kv[j] * fexp(sTot[k0 + j] - sBC[t * 65 + k0 + j])));
#pragma unroll
        for (int u = 0; u < 2; ++u) { const int i = tid + 512 * u, row = i >> 4, c16 = i & 15; *(uint4*)(Vs + row * 136 + c16 * 8) = *(const uint4*)(P0 + (size_t)(c * 64 + row) * EIN + 512 + h * 128 + c16 * 8); }
    }
    __syncthreads();
    {
        f32x4 acc[4];
#pragma unroll
        for (int kt = 0; kt < 4; ++kt) acc[kt] = (f32x4){0.f, 0.f, 0.f, 0.f};
#pragma unroll
        for (int ks = 0; ks < 2; ++ks) {
            const bf16x8 af = tr_frag(Vs, 136, ks * 32, wave * 16, lane);
#pragma unroll
            for (int kt = 0; kt < 4; ++kt) acc[kt] = __builtin_amdgcn_mfma_f32_16x16x32_bf16(af, row_frag(kT, 72, kt * 16, ks * 32, lane), acc[kt], 0, 0, 0);
        }
#pragma unroll
        for (int kt = 0; kt < 4; ++kt) {
            const int k = kt * 16 + (lane & 15), v = wave * 16 + (lane >> 4) * 4;
            st4(GDS + ((size_t)(ch * NCH + c) * 64 + k) * 128 + v, make_float4(acc[kt][0], acc[kt][1], acc[kt][2], acc[kt][3]));
        }
    }
    if (tid < 64) GDEC[(size_t)(ch * NCH + c) * 64 + tid] = fexp(sTot[tid]);
}

DEV void gla2_unit(const Params& p, int unit) {
    const int tid = opaque_tid();
    float* GDS = (float*)(p.ws + OFF_GDS); const float* GDEC = (const float*)(p.ws + OFF_GDEC);
    const int ch = unit >> 4, e = (unit & 15) * 512 + tid, k = e >> 7, dir = ch & 1;
    float S = 0.f;
#pragma unroll 12
    for (int step = 0; step < NCH; ++step) {
        const int c = chunk_at(dir, step);
        float* gp = GDS + (size_t)(ch * NCH + c) * 8192 + e;
        const float d = GDEC[(size_t)(ch * NCH + c) * 64 + k], inc = *gp;
        *gp = S;
        S = d * S + inc;
    }
}

DEV void gla3_unit(const Params& p, int h, int c, float* sm) {
    const int tid = opaque_tid(), lane = tid & 63, wave = tid >> 6;
    const bf16_t* P0 = (const bf16_t*)(p.ws + OFF_P0);
    const float* GDS = (const float*)(p.ws + OFF_GDS);
    bf16_t* YC = (bf16_t*)(p.ws + OFF_YC);
    const float* ng = p.in[14];
    float* sLR = sm; float* sWA = sm + 1024; float* sBC = sm + 2048; float* sTot = sm + 6208;
    bf16_t* qt = (bf16_t*)(sm + 6272);
    bf16_t* kt = (bf16_t*)(sm + 8576);
    bf16_t* Sm = (bf16_t*)(sm + 10880);
    bf16_t* S0s = (bf16_t*)(sm + 13184);
    bf16_t* Vs = (bf16_t*)(sm + 17536);
    float* O = sm + 21888;
    const int ti = wave & 3, vt0 = (wave >> 2) * 4;
    f32x4 acc[4];
#pragma unroll
    for (int j = 0; j < 4; ++j) acc[j] = (f32x4){0.f, 0.f, 0.f, 0.f};
    __syncthreads();
#pragma unroll
    for (int u = 0; u < 2; ++u) { const int i = tid + 512 * u, row = i >> 4, c16 = i & 15; *(uint4*)(Vs + row * 136 + c16 * 8) = *(const uint4*)(P0 + (size_t)(c * 64 + row) * EIN + 512 + h * 128 + c16 * 8); }
#pragma unroll 1
    for (int dir = 0; dir < 2; ++dir) {
        const float* wa2 = p.in[dir ? 12 : 10]; const float* ba = p.in[dir ? 13 : 11];
        const int ch = h * 2 + dir;
        __syncthreads();
        gla_decay(P0, c, h, dir, wa2, ba, sLR, sWA, sBC, sTot, tid);
        {
            const int t = tid >> 3, k0 = (tid & 7) * 8;
            float qv[8], kv[8];
            unpack8(*(const uint4*)(P0 + (size_t)(c * 64 + t) * EIN + h * 64 + k0), qv);
            unpack8(*(const uint4*)(P0 + (size_t)(c * 64 + t) * EIN + 256 + h * 64 + k0), kv);
#pragma unroll
            for (int j = 0; j < 8; ++j) { const float bc = sBC[t * 65 + k0 + j]; qv[j] *= 0.125f * fexp(bc); kv[j] *= fexp(-bc); }
            *(uint4*)(qt + t * 72 + k0) = make_uint4(pack2bf(qv[0], qv[1]), pack2bf(qv[2], qv[3]), pack2bf(qv[4], qv[5]), pack2bf(qv[6], qv[7]));
            *(uint4*)(kt + t * 72 + k0) = make_uint4(pack2bf(kv[0], kv[1]), pack2bf(kv[2], kv[3]), pack2bf(kv[4], kv[5]), pack2bf(kv[6], kv[7]));
#pragma unroll
            for (int u = 0; u < 4; ++u) {
                const int i = tid + 512 * u, k = i >> 5, v4 = (i & 31) * 4;
                const float4 s4 = ld4(GDS + (size_t)(ch * NCH + c) * 8192 + k * 128 + v4);
                *(uint2*)(S0s + k * 136 + v4) = make_uint2(pack2bf(s4.x, s4.y), pack2bf(s4.z, s4.w));
            }
        }
        __syncthreads();
        {
            const int si = wave & 3;
#pragma unroll
            for (int jj = 0; jj < 2; ++jj) {
                const int t2 = (wave >> 2) * 2 + jj;
                f32x4 a = (f32x4){0.f, 0.f, 0.f, 0.f};
#pragma unroll
                for (int ks = 0; ks < 2; ++ks) a = __builtin_amdgcn_mfma_f32_16x16x32_bf16(row_frag(kt, 72, si * 16, ks * 32, lane), row_frag(qt, 72, t2 * 16, ks * 32, lane), a, 0, 0, 0);
                const int t = t2 * 16 + (lane & 15), s0 = si * 16 + (lane >> 4) * 4;
                float m[4];
#pragma unroll
                for (int r = 0; r < 4; ++r) { const bool keep = dir ? (s0 + r >= t) : (s0 + r <= t); m[r] = keep ? a[r] : 0.f; }
                *(uint2*)(Sm + t * 72 + s0) = make_uint2(pack2bf(m[0], m[1]), pack2bf(m[2], m[3]));
            }
        }
        __syncthreads();
#pragma unroll
        for (int ks = 0; ks < 2; ++ks) {
            const bf16x8 a1 = row_frag(qt, 72, ti * 16, ks * 32, lane), a2 = row_frag(Sm, 72, ti * 16, ks * 32, lane);
#pragma unroll
            for (int j = 0; j < 4; ++j) {
                acc[j] = __builtin_amdgcn_mfma_f32_16x16x32_bf16(a1, tr_frag(S0s, 136, ks * 32, (vt0 + j) * 16, lane), acc[j], 0, 0, 0);
                acc[j] = __builtin_amdgcn_mfma_f32_16x16x32_bf16(a2, tr_frag(Vs, 136, ks * 32, (vt0 + j) * 16, lane), acc[j], 0, 0, 0);
            }
        }
    }
#pragma unroll
    for (int j = 0; j < 4; ++j)
#pragma unroll
        for (int r = 0; r < 4; ++r) O[(ti * 16 + (lane >> 4) * 4 + r) * 132 + (vt0 + j) * 16 + (lane & 15)] = acc[j][r];
    __syncthreads();
    {
        const int t = tid >> 3, v0 = (tid & 7) * 16;
        float o[16];
        float ss = 0.f;
#pragma unroll
        for (int i = 0; i < 16; ++i) { o[i] = O[t * 132 + v0 + i]; ss += o[i] * o[i]; }
        ss += __shfl_xor(ss, 1, 64); ss += __shfl_xor(ss, 2, 64); ss += __shfl_xor(ss, 4, 64);
        const float rms = rsqrtf(ss * (1.f / 128.f) + 1e-5f);
        float g[16];
        const bf16_t* gp = P0 + (size_t)(c * 64 + t) * EIN + 1024 + h * 128 + v0;
        unpack8(*(const uint4*)gp, g); unpack8(*(const uint4*)(gp + 8), g + 8);
        float y[16];
#pragma unroll
        for (int i = 0; i < 16; ++i) y[i] = o[i] * rms * ng[v0 + i] * silu_f(g[i]);
        bf16_t* yp = YC + (size_t)(c * 64 + t) * 1024 + h * 128 + v0;
        *(uint4*)yp = make_uint4(pack2bf(y[0], y[1]), pack2bf(y[2], y[3]), pack2bf(y[4], y[5]), pack2bf(y[6], y[7]));
        *(uint4*)(yp + 8) = make_uint4(pack2bf(y[8], y[9]), pack2bf(y[10], y[11]), pack2bf(y[12], y[13]), pack2bf(y[14], y[15]));
    }
}

DEV void load8bf(const bf16_t* ptr, float* f) { unpack8(*(const uint4*)ptr, f); }
DEV void rw_mix8(const bf16_t* P0, int s, int cb, const float* __restrict__ mu, float* out) {
    float own[8]; load8bf(P0 + (size_t)s * EIN + RW0 + cb, own);
    int nL = -1, nR = -1, nU = -1, nD = -1;
    if (s < NCX) { if (s > 0) nL = s - 1; if (s < NCX - 1) nR = s + 1; }
    else { const int n = s - NCX, rr = n >> 6, cc = n & 63; if (cc > 0) nL = s - 1; if (cc < 63) nR = s + 1; if (rr > 0) nU = s - 64; if (rr < 127) nD = s + 64; }
    float fL[8], fR[8], fU[8], fD[8];
#pragma unroll
    for (int i = 0; i < 8; ++i) { fL[i] = 0.f; fR[i] = 0.f; fU[i] = 0.f; fD[i] = 0.f; }
    if (nL >= 0) load8bf(P0 + (size_t)nL * EIN + RW0 + cb, fL);
    if (nR >= 0) load8bf(P0 + (size_t)nR * EIN + RW0 + cb, fR);
    if (nU >= 0) load8bf(P0 + (size_t)nU * EIN + RW0 + cb, fU);
    if (nD >= 0) load8bf(P0 + (size_t)nD * EIN + RW0 + cb, fD);
    const float4 m0 = ld4(mu + cb), m1 = ld4(mu + cb + 4);
    const float m[8] = {m0.x, m0.y, m0.z, m0.w, m1.x, m1.y, m1.z, m1.w};
#pragma unroll
    for (int i = 0; i < 8; ++i) { const float nb = (i & 3) == 0 ? fL[i] : ((i & 3) == 1 ? fR[i] : ((i & 3) == 2 ? fU[i] : fD[i])); out[i] = own[i] + (nb - own[i]) * m[i]; }
}
DEV uint4 pack8(const float* f) { return make_uint4(pack2bf(f[0], f[1]), pack2bf(f[2], f[3]), pack2bf(f[4], f[5]), pack2bf(f[6], f[7])); }

template <int XM, int YM, class F>
DEV void mm64(const bf16_t* X, const bf16_t* Y, F f, int lane, int wave) {
#pragma unroll
    for (int q = 0; q < 2; ++q) {
        const int idx = wave * 2 + q, ti = idx >> 2, tj = idx & 3;
        f32x4 acc = (f32x4){0.f, 0.f, 0.f, 0.f};
#pragma unroll
        for (int ks = 0; ks < 2; ++ks) {
            const bf16x8 a = XM == 0 ? row_frag(X, 72, ti * 16, ks * 32, lane) : tr_frag(X, 72, ks * 32, ti * 16, lane);
            const bf16x8 bq = YM == 0 ? row_frag(Y, 72, tj * 16, ks * 32, lane) : tr_frag(Y, 72, ks * 32, tj * 16, lane);
            acc = __builtin_amdgcn_mfma_f32_16x16x32_bf16(a, bq, acc, 0, 0, 0);
        }
        f(ti * 16 + (lane >> 4) * 4, tj * 16 + (lane & 15), acc);
    }
}
template <int XM, int YM, class F>
DEV void mm64x2(const bf16_t* X1, const bf16_t* Y1, const bf16_t* X2, const bf16_t* Y2, F f, int lane, int wave) {
#pragma unroll
    for (int q = 0; q < 2; ++q) {
        const int idx = wave * 2 + q, ti = idx >> 2, tj = idx & 3;
        f32x4 acc = (f32x4){0.f, 0.f, 0.f, 0.f};
#pragma unroll
        for (int ks = 0; ks < 2; ++ks) {
            const bf16x8 a = XM == 0 ? row_frag(X1, 72, ti * 16, ks * 32, lane) : tr_frag(X1, 72, ks * 32, ti * 16, lane);
            const bf16x8 bq = YM == 0 ? row_frag(Y1, 72, tj * 16, ks * 32, lane) : tr_frag(Y1, 72, ks * 32, tj * 16, lane);
            acc = __builtin_amdgcn_mfma_f32_16x16x32_bf16(a, bq, acc, 0, 0, 0);
            const bf16x8 a2 = XM == 0 ? row_frag(X2, 72, ti * 16, ks * 32, lane) : tr_frag(X2, 72, ks * 32, ti * 16, lane);
            const bf16x8 b2 = YM == 0 ? row_frag(Y2, 72, tj * 16, ks * 32, lane) : tr_frag(Y2, 72, ks * 32, tj * 16, lane);
            acc = __builtin_amdgcn_mfma_f32_16x16x32_bf16(a2, b2, acc, 0, 0, 0);
        }
        f(ti * 16 + (lane >> 4) * 4, tj * 16 + (lane & 15), acc);
    }
}
DEV void st_img(bf16_t* P, int i0, int j, float a0, float a1, float a2, float a3) {
    P[(i0 + 0) * 72 + j] = __builtin_bit_cast(unsigned short, (__bf16)a0); P[(i0 + 1) * 72 + j] = __builtin_bit_cast(unsigned short, (__bf16)a1);
    P[(i0 + 2) * 72 + j] = __builtin_bit_cast(unsigned short, (__bf16)a2); P[(i0 + 3) * 72 + j] = __builtin_bit_cast(unsigned short, (__bf16)a3);
}

DEV void rwkv1_unit(const Params& p, int h, int dir, int c, float* sm) {
    const int tid = opaque_tid(), lane = tid & 63, wave = tid >> 6;
    const bf16_t* P0 = (const bf16_t*)(p.ws + OFF_P0);
    bf16_t* RU = (bf16_t*)(p.ws + OFF_RU) + (size_t)((h * 2 + dir) * NCH + c) * 16384;
    float* BONS = (float*)(p.ws + OFF_BONS);
    const float* mu = p.in[15];
    const float* w0 = p.in[dir ? 18 : 16]; const float* ww2 = p.in[dir ? 19 : 17];
    const float* a0 = p.in[dir ? 22 : 20]; const float* wa2 = p.in[dir ? 23 : 21];
    bf16_t* img = (bf16_t*)sm;
#define SLOT(i_) (img + (i_) * 4608)
    float* fLW = (float*)SLOT(10);
    float* fAS = (float*)SLOT(12);
    float* sv = (float*)SLOT(14);
    const int t = tid >> 3, j0 = (tid & 7) * 8, s = c * 64 + t;
    __syncthreads();
    if (tid < 64) { const int hc = h * 64 + tid; sv[64 + tid] = w0[hc]; sv[128 + tid] = a0[hc]; sv[192 + tid] = p.in[24][hc]; sv[256 + tid] = p.in[25][hc]; sv[320 + tid] = p.in[26][hc]; }
    float r8[8], k8[8], v8[8];
    {
        float x8[8];
        rw_mix8(P0, s, h * 64 + j0, mu, r8);
        rw_mix8(P0, s, 512 + h * 64 + j0, mu, k8);
        rw_mix8(P0, s, 1024 + h * 64 + j0, mu, v8);
        rw_mix8(P0, s, 2048 + dir * 64 + j0, mu, x8);
#pragma unroll
        for (int i = 0; i < 8; ++i) x8[i] = tanh_f(x8[i]);
        *(uint4*)(SLOT(6) + t * 72 + j0) = pack8(x8);
        rw_mix8(P0, s, 2176 + dir * 64 + j0, mu, x8);
        *(uint4*)(SLOT(7) + t * 72 + j0) = pack8(x8);
        float wq[8];
        { const float4 q0 = ld4(ww2 + (size_t)t * 512 + h * 64 + j0), q1 = ld4(ww2 + (size_t)t * 512 + h * 64 + j0 + 4); wq[0] = q0.x; wq[1] = q0.y; wq[2] = q0.z; wq[3] = q0.w; wq[4] = q1.x; wq[5] = q1.y; wq[6] = q1.z; wq[7] = q1.w; }
        *(uint4*)(SLOT(8) + t * 72 + j0) = pack8(wq);
        { const float4 q0 = ld4(wa2 + (size_t)t * 512 + h * 64 + j0), q1 = ld4(wa2 + (size_t)t * 512 + h * 64 + j0 + 4); wq[0] = q0.x; wq[1] = q0.y; wq[2] = q0.z; wq[3] = q0.w; wq[4] = q1.x; wq[5] = q1.y; wq[6] = q1.z; wq[7] = q1.w; }
        *(uint4*)(SLOT(9) + t * 72 + j0) = pack8(wq);
    }
    __syncthreads();
    mm64<0, 1>(SLOT(6), SLOT(8), [=](int i0, int j, f32x4 a) {
#pragma unroll
        for (int r = 0; r < 4; ++r) fLW[(i0 + r) * 65 + j] = -0.6065306597f * sigmoid_f(sv[64 + j] + a[r]); }, lane, wave);
    mm64<0, 1>(SLOT(7), SLOT(9), [=](int i0, int j, f32x4 a) {
#pragma unroll
        for (int r = 0; r < 4; ++r) fAS[(i0 + r) * 65 + j] = sigmoid_f(sv[128 + j] + a[r]); }, lane, wave);
    __syncthreads();
#pragma unroll
    for (int j = 0; j < 8; ++j) {
        const int k = wave * 8 + j;
        const float v = wave_scan_add(fLW[lane * 65 + k], lane, dir);
        fLW[lane * 65 + k] = v;
        if (lane == (dir ? 0 : 63)) sv[k] = v;
    }
    __syncthreads();
    {
        float kkv[8], ss = 0.f;
#pragma unroll
        for (int i = 0; i < 8; ++i) { kkv[i] = k8[i] * sv[192 + j0 + i]; ss += kkv[i] * kkv[i]; }
        ss += __shfl_xor(ss, 1, 64); ss += __shfl_xor(ss, 2, 64); ss += __shfl_xor(ss, 4, 64);
        const float rn = rsqrtf(fmaxf(ss, 1e-24f));
        float fa[8], fb[8], fk[8], fr[8], fbp[8], fkp[8], bon = 0.f;
        const int tp = dir ? t + 1 : t - 1;
        const bool hasp = dir ? (t < 63) : (t > 0);
#pragma unroll
        for (int i = 0; i < 8; ++i) {
            const int k = j0 + i;
            const float Bt = fLW[t * 65 + k], Bx = hasp ? fLW[tp * 65 + k] : 0.f, asg = fAS[t * 65 + k];
            const float kk = kkv[i] * rn, kh = k8[i] * (1.f + (asg - 1.f) * sv[256 + k]);
            bon += r8[i] * kh * sv[320 + k];
            const float enB = fexp(-Bt), eLB = fexp(sv[k] - Bt), bv = kk * asg;
            fa[i] = -kk * fexp(Bx); fb[i] = bv * enB; fk[i] = kh * enB; fr[i] = r8[i] * fexp(Bt); fbp[i] = bv * eLB; fkp[i] = kh * eLB;
        }
        bon += __shfl_xor(bon, 1, 64); bon += __shfl_xor(bon, 2, 64); bon += __shfl_xor(bon, 4, 64);
        if ((tid & 7) == 0) BONS[((size_t)dir * TB + s) * 8 + h] = bon;
        *(uint4*)(SLOT(0) + t * 72 + j0) = pack8(fa); *(uint4*)(SLOT(1) + t * 72 + j0) = pack8(fb); *(uint4*)(SLOT(2) + t * 72 + j0) = pack8(fk);
        *(uint4*)(SLOT(3) + t * 72 + j0) = pack8(fr); *(uint4*)(SLOT(4) + t * 72 + j0) = pack8(fbp); *(uint4*)(SLOT(5) + t * 72 + j0) = pack8(fkp);
    }
    __syncthreads();
    *(uint4*)(SLOT(6) + t * 72 + j0) = pack8(v8);
    __syncthreads();
    mm64<0, 0>(SLOT(0), SLOT(1), [=](int i0, int j, f32x4 a) {
        float m[4];
#pragma unroll
        for (int r = 0; r < 4; ++r) { const bool keep = dir ? (j > i0 + r) : (j < i0 + r); m[r] = keep ? a[r] : 0.f; }
        const bool dg = (i0 >> 4) == (j >> 4);
        st_img(SLOT(7), i0, j, dg ? m[0] : 0.f, dg ? m[1] : 0.f, dg ? m[2] : 0.f, dg ? m[3] : 0.f);
        st_img(SLOT(8), i0, j, (dg ? m[0] : 0.f) + (j == i0 ? 1.f : 0.f), (dg ? m[1] : 0.f) + (j == i0 + 1 ? 1.f : 0.f), (dg ? m[2] : 0.f) + (j == i0 + 2 ? 1.f : 0.f), (dg ? m[3] : 0.f) + (j == i0 + 3 ? 1.f : 0.f));
        st_img(SLOT(12), i0, j, dg ? 0.f : m[0], dg ? 0.f : m[1], dg ? 0.f : m[2], dg ? 0.f : m[3]); }, lane, wave);
    mm64<0, 0>(SLOT(0), SLOT(2), [=](int i0, int j, f32x4 a) {
        float m[4];
#pragma unroll
        for (int r = 0; r < 4; ++r) { const bool keep = dir ? (j > i0 + r) : (j < i0 + r); m[r] = keep ? a[r] : 0.f; }
        st_img(SLOT(9), i0, j, m[0], m[1], m[2], m[3]); }, lane, wave);
    mm64<0, 0>(SLOT(3), SLOT(1), [=](int i0, int j, f32x4 a) {
        float m[4];
#pragma unroll
        for (int r = 0; r < 4; ++r) { const bool keep = dir ? (j >= i0 + r) : (j <= i0 + r); m[r] = keep ? a[r] : 0.f; }
        st_img(SLOT(10), i0, j, m[0], m[1], m[2], m[3]); }, lane, wave);
    mm64<0, 0>(SLOT(3), SLOT(2), [=](int i0, int j, f32x4 a) {
        float m[4];
#pragma unroll
        for (int r = 0; r < 4; ++r) { const bool keep = dir ? (j >= i0 + r) : (j <= i0 + r); m[r] = keep ? a[r] : 0.f; }
        st_img(SLOT(11), i0, j, m[0], m[1], m[2], m[3]); }, lane, wave);
    __syncthreads();
    {
        bf16_t* Pc = SLOT(7); bf16_t* Pn = SLOT(1); bf16_t* Tc = SLOT(8); bf16_t* Tn = SLOT(2);
#pragma unroll 1
        for (int it = 0; it < 3; ++it) {
            mm64<0, 1>(Pc, Pc, [=](int i0, int j, f32x4 a) { st_img(Pn, i0, j, a[0], a[1], a[2], a[3]); }, lane, wave);
            __syncthreads();
            mm64<0, 1>(Tc, Pn, [=](int i0, int j, f32x4 a) {
                st_img(Tn, i0, j, a[0] + bf2f(Tc[(i0 + 0) * 72 + j]), a[1] + bf2f(Tc[(i0 + 1) * 72 + j]), a[2] + bf2f(Tc[(i0 + 2) * 72 + j]), a[3] + bf2f(Tc[(i0 + 3) * 72 + j])); }, lane, wave);
            __syncthreads();
            bf16_t* tmp = Pc; Pc = Pn; Pn = tmp; tmp = Tc; Tc = Tn; Tn = tmp;
        }
    }
    mm64<0, 1>(SLOT(2), SLOT(12), [=](int i0, int j, f32x4 a) { st_img(SLOT(7), i0, j, a[0], a[1], a[2], a[3]); }, lane, wave);
    mm64<0, 1>(SLOT(2), SLOT(0), [=](int i0, int j, f32x4 a) { st_img(SLOT(1), i0, j, a[0], a[1], a[2], a[3]); }, lane, wave);
    mm64<0, 1>(SLOT(9), SLOT(6), [=](int i0, int j, f32x4 a) { st_img(SLOT(13), i0, j, a[0], a[1], a[2], a[3]); }, lane, wave);
    __syncthreads();
    mm64<0, 1>(SLOT(2), SLOT(13), [=](int i0, int j, f32x4 a) { st_img(SLOT(8), i0, j, a[0], a[1], a[2], a[3]); }, lane, wave);
    __syncthreads();
    {
        const bf16_t* Zp = (wave < 4) ? SLOT(1) : SLOT(8);
        bf16_t* Xi = (wave < 4) ? SLOT(12) : SLOT(9);
        const int ct = (wave & 3) * 16, g4 = (lane >> 4) * 4, l15 = lane & 15;
#pragma unroll
        for (int bs = 0; bs < 4; ++bs) {
            const int bi = dir ? 3 - bs : bs;
            f32x4 acc;
#pragma unroll
            for (int r = 0; r < 4; ++r) acc[r] = bf2f(Zp[(bi * 16 + g4 + r) * 72 + ct + l15]);
            const bool k0 = dir ? (bi == 0) : (bi >= 1), k1 = dir ? (bi <= 2) : (bi == 3);
            if (k0) acc = __builtin_amdgcn_mfma_f32_16x16x32_bf16(row_frag(SLOT(7), 72, bi * 16, 0, lane), tr_frag(Xi, 72, 0, ct, lane), acc, 0, 0, 0);
            if (k1) acc = __builtin_amdgcn_mfma_f32_16x16x32_bf16(row_frag(SLOT(7), 72, bi * 16, 32, lane), tr_frag(Xi, 72, 32, ct, lane), acc, 0, 0, 0);
            st_img(Xi, bi * 16 + g4, ct + l15, acc[0], acc[1], acc[2], acc[3]);
            __syncthreads();
        }
    }
    mm64<1, 1>(SLOT(12), SLOT(4), [=](int i0, int j, f32x4 a) {
        float m[4];
#pragma unroll
        for (int r = 0; r < 4; ++r) m[r] = a[r] + ((i0 + r) == j ? fexp(sv[j]) : 0.f);
        *(uint2*)(RU + j * 64 + i0) = make_uint2(pack2bf(m[0], m[1]), pack2bf(m[2], m[3])); }, lane, wave);
    mm64x2<1, 1>(SLOT(4), SLOT(9), SLOT(5), SLOT(6), [=](int i0, int j, f32x4 a) {
        *(uint2*)(RU + 4096 + j * 64 + i0) = make_uint2(pack2bf(a[0], a[1]), pack2bf(a[2], a[3])); }, lane, wave);
    mm64<1, 0>(SLOT(12), SLOT(10), [=](int i0, int j, f32x4 a) {
        const uint2 rr = *(const uint2*)(SLOT(3) + j * 72 + i0);
        *(uint2*)(RU + 8192 + j * 64 + i0) = make_uint2(pack2bf(a[0] + bflo(rr.x), a[1] + bfhi(rr.x)), pack2bf(a[2] + bflo(rr.y), a[3] + bfhi(rr.y))); }, lane, wave);
    mm64x2<0, 1>(SLOT(10), SLOT(9), SLOT(11), SLOT(6), [=](int i0, int j, f32x4 a) {
        *(uint2*)(RU + 12288 + j * 64 + i0) = make_uint2(pack2bf(a[0], a[1]), pack2bf(a[2], a[3])); }, lane, wave);
#undef SLOT
}

#define R2_LOAD(slot_, stp_) do { const int cn_ = chunk_at(dir, ((stp_) < NCH) ? (stp_) : NCH - 1); const bf16_t* U_ = RU + (size_t)(chain * NCH + cn_) * 16384; \
    _Pragma("unroll") for (int i_ = 0; i_ < 4; ++i_) { rc[slot_][i_] = *(const uint2*)(U_ + 4096 + (vblk * 16 + l15) * 64 + i_ * 16 + g * 4); \
        _Pragma("unroll") for (int ks_ = 0; ks_ < 2; ++ks_) { ra[slot_][i_][ks_][0] = *(const uint2*)(U_ + (i_ * 16 + l15) * 64 + ks_ * 32 + g * 4); ra[slot_][i_][ks_][1] = *(const uint2*)(U_ + (i_ * 16 + l15) * 64 + ks_ * 32 + 16 + g * 4); } } } while (0)
DEV void rwkv2_unit(const Params& p, int chain, int vblk, int lane) {
    asm volatile("" : "+v"(lane));
    const bf16_t* RU = (const bf16_t*)(p.ws + OFF_RU);
    bf16_t* S0G = (bf16_t*)(p.ws + OFF_RS0);
    const int dir = chain & 1, g = lane >> 4, l15 = lane & 15;
    f32x4 st[4];
#pragma unroll
    for (int i = 0; i < 4; ++i) st[i] = (f32x4){0.f, 0.f, 0.f, 0.f};
    uint2 ra[3][4][2][2], rc[3][4];
    R2_LOAD(0, 0); R2_LOAD(1, 1); R2_LOAD(2, 2);
#pragma unroll 1
    for (int step0 = 0; step0 < NCH; step0 += 3) {
#pragma unroll
        for (int q = 0; q < 3; ++q) {
            const int step = step0 + q, c = chunk_at(dir, step);
            uint2 ca[4][2][2], cc[4];
#pragma unroll
            for (int i = 0; i < 4; ++i) { cc[i] = rc[q][i]; ca[i][0][0] = ra[q][i][0][0]; ca[i][0][1] = ra[q][i][0][1]; ca[i][1][0] = ra[q][i][1][0]; ca[i][1][1] = ra[q][i][1][1]; }
            R2_LOAD(q, step + 3);
            __builtin_amdgcn_sched_barrier(0);
            unsigned pk[4][2];
#pragma unroll
            for (int i = 0; i < 4; ++i) { pk[i][0] = pack2bf(st[i][0], st[i][1]); pk[i][1] = pack2bf(st[i][2], st[i][3]); }
            bf16_t* sp = S0G + ((size_t)(chain * NCH + c) * 64 + vblk * 16 + l15) * 64 + g * 4;
#pragma unroll
            for (int i = 0; i < 4; ++i) *(uint2*)(sp + i * 16) = make_uint2(pk[i][0], pk[i][1]);
            bf16x8 bfr[2];
#pragma unroll
            for (int ks = 0; ks < 2; ++ks) { const uint4 u = make_uint4(pk[2 * ks][0], pk[2 * ks][1], pk[2 * ks + 1][0], pk[2 * ks + 1][1]); bfr[ks] = __builtin_bit_cast(bf16x8, u); }
#pragma unroll
            for (int i = 0; i < 4; ++i) {
                f32x4 acc = (f32x4){bflo(cc[i].x), bfhi(cc[i].x), bflo(cc[i].y), bfhi(cc[i].y)};
#pragma unroll
                for (int ks = 0; ks < 2; ++ks) {
                    const uint4 u = make_uint4(ca[i][ks][0].x, ca[i][ks][0].y, ca[i][ks][1].x, ca[i][ks][1].y);
                    acc = __builtin_amdgcn_mfma_f32_16x16x32_bf16(__builtin_bit_cast(bf16x8, u), bfr[ks], acc, 0, 0, 0);
                }
                st[i] = acc;
            }
        }
    }
}
#undef R2_LOAD

DEV void rwkv3_unit(const Params& p, int h, int c, float* sm) {
    const int tid = opaque_tid(), lane = tid & 63, wave = tid >> 6;
    const bf16_t* P0 = (const bf16_t*)(p.ws + OFF_P0);
    const bf16_t* RUb = (const bf16_t*)(p.ws + OFF_RU);
    const bf16_t* S0G = (const bf16_t*)(p.ws + OFF_RS0);
    const float* BONS = (const float*)(p.ws + OFF_BONS);
    bf16_t* YC = (bf16_t*)(p.ws + OFF_YC);
    const float* mu = p.in[15]; const float* gn_g = p.in[27]; const float* gn_b = p.in[28];
    bf16_t* img = (bf16_t*)sm;
    float* O = sm + 4 * 2304;
    __syncthreads();
    {
        const int row = tid >> 3, c8 = (tid & 7) * 8;
#pragma unroll
        for (int dir = 0; dir < 2; ++dir) {
            const size_t u = (size_t)((h * 2 + dir) * NCH + c);
            *(uint4*)(img + dir * 4608 + row * 72 + c8) = *(const uint4*)(RUb + u * 16384 + 8192 + row * 64 + c8);
            *(uint4*)(img + (2 + dir) * 4608 + row * 72 + c8) = *(const uint4*)(S0G + u * 4096 + row * 64 + c8);
        }
    }
    __syncthreads();
#pragma unroll
    for (int q = 0; q < 2; ++q) {
        const int idx = wave * 2 + q, ti = idx >> 2, tj = idx & 3;
        f32x4 accd[2];
#pragma unroll
        for (int dir = 0; dir < 2; ++dir) {
            f32x4 acc = (f32x4){0.f, 0.f, 0.f, 0.f};
#pragma unroll
            for (int ks = 0; ks < 2; ++ks) acc = __builtin_amdgcn_mfma_f32_16x16x32_bf16(row_frag(img + dir * 4608, 72, ti * 16, ks * 32, lane), row_frag(img + (2 + dir) * 4608, 72, tj * 16, ks * 32, lane), acc, 0, 0, 0);
            const uint2 yl = *(const uint2*)(RUb + (size_t)((h * 2 + dir) * NCH + c) * 16384 + 12288 + (tj * 16 + (lane & 15)) * 64 + ti * 16 + (lane >> 4) * 4);
            acc[0] += bflo(yl.x); acc[1] += bfhi(yl.x); acc[2] += bflo(yl.y); acc[3] += bfhi(yl.y);
            accd[dir] = acc;
        }
#pragma unroll
        for (int r = 0; r < 4; ++r) {
            const int oi = (ti * 16 + (lane >> 4) * 4 + r) * 68 + tj * 16 + (lane & 15);
            O[oi] = accd[0][r] + accd[1][r];
        }
    }
    __syncthreads();
    {
        const int t = tid >> 3, v0 = (tid & 7) * 8, s = c * 64 + t;
        float y[8], sum = 0.f;
#pragma unroll
        for (int i = 0; i < 8; ++i) { y[i] = O[t * 68 + v0 + i]; sum += y[i]; }
        sum += __shfl_xor(sum, 1, 64); sum += __shfl_xor(sum, 2, 64); sum += __shfl_xor(sum, 4, 64);
        const float mean = sum * (1.f / 64.f);
        float sq = 0.f;
#pragma unroll
        for (int i = 0; i < 8; ++i) { y[i] -= mean; sq += y[i] * y[i]; }
        sq += __shfl_xor(sq, 1, 64); sq += __shfl_xor(sq, 2, 64); sq += __shfl_xor(sq, 4, 64);
        const float rstd = rsqrtf(sq * (1.f / 64.f) + 64e-5f);
        float vm[8], gm[8];
        rw_mix8(P0, s, 1024 + h * 64 + v0, mu, vm);
        rw_mix8(P0, s, 1536 + h * 64 + v0, mu, gm);
        const float bon = BONS[(size_t)s * 8 + h] + BONS[((size_t)TB + s) * 8 + h];
        float o[8];
#pragma unroll
        for (int i = 0; i < 8; ++i) o[i] = (y[i] * rstd * gn_g[h * 64 + v0 + i] + gn_b[h * 64 + v0 + i] + bon * vm[i]) * silu_f(gm[i]);
        *(uint4*)(YC + (size_t)s * 1024 + 512 + h * 64 + v0) = pack8(o);
    }
}

DEV void ln_rows(const float* src, int nrows, const float* __restrict__ g, const float* __restrict__ bt, float* dst_lat, float* dst_cx, int ncx,
                 bf16_t* hb = nullptr, const float* mvc = nullptr, const float* mvl = nullptr) {
    const int tid_ = opaque_tid(); const int lane = tid_ & 63, gw = blockIdx.x * NWV + (tid_ >> 6), ngw = gridDim.x * NWV;
    for (int r = gw; r < nrows; r += ngw) {
        const float* x = src + (size_t)r * 1024;
        float4 v[4];
        float sum = 0.f;
#pragma unroll
        for (int i = 0; i < 4; ++i) { v[i] = ld4(x + i * 256 + lane * 4); sum += v[i].x + v[i].y + v[i].z + v[i].w; }
        const float mean = wave_sum(sum) * (1.f / 1024.f);
        float sq = 0.f;
#pragma unroll
        for (int i = 0; i < 4; ++i) {
            v[i].x -= mean; v[i].y -= mean; v[i].z -= mean; v[i].w -= mean;
            sq += v[i].x * v[i].x + v[i].y * v[i].y + v[i].z * v[i].z + v[i].w * v[i].w;
        }
        const float rstd = rsqrtf(wave_sum(sq) * (1.f / 1024.f) + 1e-5f);
        float* d = (r < ncx) ? (dst_cx + (size_t)r * 1024) : (dst_lat + (size_t)(r - ncx) * 1024);
#pragma unroll
        for (int i = 0; i < 4; ++i) {
            const int c = i * 256 + lane * 4;
            const float4 gg = ld4(g + c), bb = ld4(bt + c);
            const float4 y = make_float4(v[i].x * rstd * gg.x + bb.x, v[i].y * rstd * gg.y + bb.y, v[i].z * rstd * gg.z + bb.z, v[i].w * rstd * gg.w + bb.w);
            st4(d + c, y);
            if (hb != nullptr) {
                const float* m = (r < ncx) ? mvc : mvl;
                const float4 sh = ld4(m + c), sc = ld4(m + 1024 + c);
                *(uint2*)(hb + (size_t)r * 1024 + c) = make_uint2(pack2bf(y.x * (1.f + sc.x) + sh.x, y.y * (1.f + sc.y) + sh.y), pack2bf(y.z * (1.f + sc.z) + sh.z, y.w * (1.f + sc.w) + sh.w));
            }
        }
    }
}
DEV void phase_h1l(const Params& p) {
    const float* modv1 = (const float*)(p.ws + OFF_MODV) + 3 * 3072;
    bf16_t* H1 = (bf16_t*)(p.ws + OFF_H1B);
    const size_t gt = (size_t)blockIdx.x * NTHR + opaque_tid(), gn = (size_t)gridDim.x * NTHR;
    for (size_t i = gt; i < (size_t)NB * NL * 128; i += gn) {
        const size_t r = i >> 7; const int k = (int)(i & 127) * 8;
        const float* m = modv1 + (r >= (size_t)NL ? 1 : 0) * 3072;
        const float4 x0 = ld4(p.out + r * DM + k), x1 = ld4(p.out + r * DM + k + 4);
        const float4 s0 = ld4(m + k), s1 = ld4(m + k + 4), c0 = ld4(m + 1024 + k), c1 = ld4(m + 1024 + k + 4);
        *(uint4*)(H1 + r * DM + k) = make_uint4(pack2bf(x0.x * (1.f + c0.x) + s0.x, x0.y * (1.f + c0.y) + s0.y), pack2bf(x0.z * (1.f + c0.z) + s0.z, x0.w * (1.f + c0.w) + s0.w),
                                                pack2bf(x1.x * (1.f + c1.x) + s1.x, x1.y * (1.f + c1.y) + s1.y), pack2bf(x1.z * (1.f + c1.z) + s1.z, x1.w * (1.f + c1.w) + s1.w));
    }
}

DEV void zero_f4(float* ptr, size_t nfloat) {
    const size_t n4 = nfloat / 4;
    for (size_t i = (size_t)blockIdx.x * NTHR + opaque_tid(); i < n4; i += (size_t)gridDim.x * NTHR) ((float4*)ptr)[i] = make_float4(0.f, 0.f, 0.f, 0.f);
}

DEV void chain_ids(int& chain, int& sub) {
    const int bid = blockIdx.x, xcd = bid & 7, idx = bid >> 3;
    chain = xcd * 2 + (idx >> 4); sub = idx & 15;
}

DEV void phase_conv1(const Params& p, float* sm) {
    const bf16_t* XM = (const bf16_t*)(p.ws + OFF_XM);
    bf16_t* XC = (bf16_t*)(p.ws + OFF_XC);
    float* G16P = (float*)(p.ws + OFF_G16P);
    const bf16_t* WFT = (const bf16_t*)(p.ws + OFF_WFT);
    const float* cw = p.in[31]; const float* cbias = p.in[32];
    bf16_t* imgC = (bf16_t*)sm;
    bf16_t* imgM = imgC + 64 * 264;
    float* red = (float*)(imgM + 64 * 264);
    float* cwl = red + 1024;
    const int tid = opaque_tid(), lane = tid & 63, wave = tid >> 6, t = tid >> 3, cg = tid & 7;
    for (int u = blockIdx.x; u < NB * NCH * 4; u += gridDim.x) {
        const int ci = u >> 2, q = u & 3, b = ci / NCH, c = ci % NCH, s = c * 64 + t;
        const size_t rowbase = (size_t)b * TB;
        int nrow[9];
#pragma unroll
        for (int i = 0; i < 3; ++i)
#pragma unroll
            for (int j = 0; j < 3; ++j) {
                int ns = -1;
                if (s < NCX) { const int w2 = s + j - 1; if (i == 1 && w2 >= 0 && w2 < NCX) ns = w2; }
                else { const int n = s - NCX, rr = (n >> 6) + i - 1, w2 = (n & 63) + j - 1; if (rr >= 0 && rr < 128 && w2 >= 0 && w2 < 64) ns = NCX + rr * 64 + w2; }
                nrow[i * 3 + j] = ns;
            }
        const int tt = wave & 3, part = wave >> 2;
        f32x4 acc = (f32x4){0.f, 0.f, 0.f, 0.f};
#pragma unroll 1
        for (int half = 0; half < 2; ++half) {
            __syncthreads();
            for (int i = tid; i < 640; i += NTHR) { const int tp = i >> 6, c4 = (i & 63) * 4; st4(cwl + tp * 256 + c4, ld4((tp < 9 ? cw + tp * 2048 : cbias) + q * 512 + half * 256 + c4)); }
            __syncthreads();
#pragma unroll 2
            for (int it = 0; it < 4; ++it) {
                const int cl = it * 64 + cg * 8, c0 = q * 512 + half * 256 + cl;
                float a8[8];
                { const float4 b0 = ld4(cwl + 9 * 256 + cl), b1 = ld4(cwl + 9 * 256 + cl + 4); a8[0] = b0.x; a8[1] = b0.y; a8[2] = b0.z; a8[3] = b0.w; a8[4] = b1.x; a8[5] = b1.y; a8[6] = b1.z; a8[7] = b1.w; }
                uint4 xmc = make_uint4(0u, 0u, 0u, 0u);
#pragma unroll
                for (int tap = 0; tap < 9; ++tap) {
                    if (nrow[tap] >= 0) {
                        const uint4 xv = *(const uint4*)(XM + (rowbase + nrow[tap]) * 2048 + c0);
                        float x8[8]; unpack8(xv, x8);
                        const float4 w0 = ld4(cwl + tap * 256 + cl), w1 = ld4(cwl + tap * 256 + cl + 4);
                        a8[0] += x8[0] * w0.x; a8[1] += x8[1] * w0.y; a8[2] += x8[2] * w0.z; a8[3] += x8[3] * w0.w;
                        a8[4] += x8[4] * w1.x; a8[5] += x8[5] * w1.y; a8[6] += x8[6] * w1.z; a8[7] += x8[7] * w1.w;
                        if (tap == 4) xmc = xv;
                    }
                }
#pragma unroll
                for (int i = 0; i < 8; ++i) a8[i] = silu_f(a8[i]);
                const uint4 xcv = pack8(a8);
                *(uint4*)(XC + (rowbase + s) * 2048 + c0) = xcv;
                *(uint4*)(imgC + t * 264 + cl) = xcv;
                *(uint4*)(imgM + t * 264 + cl) = xmc;
            }
            __syncthreads();
            {
                const bf16_t* img = part ? imgM : imgC;
                const bf16_t* wrow = WFT + (size_t)(lane & 15) * 4096 + part * 2048 + q * 512 + half * 256 + (lane >> 4) * 8;
#pragma unroll
                for (int ks = 0; ks < 8; ++ks) acc = __builtin_amdgcn_mfma_f32_16x16x32_bf16(row_frag(img, 264, tt * 16, ks * 32, lane), *(const bf16x8*)(wrow + ks * 32), acc, 0, 0, 0);
            }
        }
        if (part == 1) {
#pragma unroll
            for (int r = 0; r < 4; ++r) red[(tt * 16 + (lane >> 4) * 4 + r) * 16 + (lane & 15)] = acc[r];
        }
        __syncthreads();
        if (part == 0) {
#pragma unroll
            for (int r = 0; r < 4; ++r) {
                const int tk = tt * 16 + (lane >> 4) * 4 + r;
                G16P[((size_t)q * RT + rowbase + c * 64 + tk) * 16 + (lane & 15)] = acc[r] + red[tk * 16 + (lane & 15)];
            }
        }
    }
}

DEV void gate_pair(const Params& p, size_t row, int dir, int h, float& gi, float& lf) {
    const float* G16P = (const float*)(p.ws + OFF_G16P);
    float a = 0.f, f = 0.f;
#pragma unroll
    for (int q = 0; q < 4; ++q) { a += G16P[((size_t)q * RT + row) * 16 + dir * 8 + h]; f += G16P[((size_t)q * RT + row) * 16 + dir * 8 + 4 + h]; }
    gi = a + p.in[dir ? 41 : 37][h];
    lf = logsig_f(f + p.in[dir ? 43 : 39][h]);
}

DEV void phase_x1(const Params& p, float* sm) {
    int chain, sub; chain_ids(chain, sub);
    const int b = chain >> 3, h = (chain >> 1) & 3, dir = chain & 1;
    const bf16_t* XC = (const bf16_t*)(p.ws + OFF_XC);
    float* GSC = (float*)(p.ws + OFF_GSC); float* CSC = (float*)(p.ws + OFF_CSC); float* NBUF = (float*)(p.ws + OFF_NBUF);
    const float* gtab = (const float*)(p.ws + OFF_GTAB);
    bf16_t* SMAT = (bf16_t*)(p.ws + OFF_SMAT);
    const int tid = opaque_tid(), lane = tid & 63, wave = tid >> 6;
    float* sTot = sm; float* sRef = sm + 132; float* sM0 = sm + 264; float* sBeta = sm + 400;
    for (int c = wave; c < NCH; c += NWV) {
        const size_t row = (size_t)b * TB + c * 64 + lane;
        float gi, lf; gate_pair(p, row, dir, h, gi, lf);
        const float bc = wave_scan_add(lf, lane, dir);
        const float ref = wave_max(gi - bc), tot = wave_sum(lf);
        if (lane == 0) { sTot[c] = tot; sRef[c] = ref; }
    }
    __syncthreads();
    if (tid == 0) {
        float m0 = -INFINITY;
        for (int step = 0; step < NCH; ++step) {
            const int c = chunk_at(dir, step);
            sM0[c] = m0;
            const float mx = fmaxf(m0, sRef[c]);
            if (sub == 0) { CSC[(chain * NCH + c) * 2] = fexp(m0 - mx); CSC[(chain * NCH + c) * 2 + 1] = fexp(sRef[c] - mx); }
            m0 = sTot[c] + mx;
        }
    }
    __syncthreads();
    for (int k = wave; sub + 16 * k < NCH; k += NWV) {
        const int c = sub + 16 * k;
        const size_t row = (size_t)b * TB + c * 64 + lane;
        float gi, lf; gate_pair(p, row, dir, h, gi, lf);
        const float bc = wave_scan_add(lf, lane, dir);
        const float a = gi - bc;
        const float amax = wave_scan_max(a, lane, dir);
        const float ref = sRef[c], m0 = sM0[c];
        const float mmax = fmaxf(amax, m0);
        const float mt = bc + mmax;
        const float alpha = fexp(ref - mmax), beta = fexp(a - ref), gg = fexp(m0 - mmax), em = fexp(-mt);
        st4(GSC + ((size_t)chain * TB + c * 64 + lane) * 4, make_float4(alpha, beta, gg, em));
        sBeta[k * 64 + lane] = beta;
    }
    __syncthreads();
    {
        float* part = sm + 1024;
        const int sg = tid >> 6, j8 = (tid & 63) * 8;
        for (int k = 0; sub + 16 * k < NCH; ++k) {
            const int c = sub + 16 * k;
            const bf16_t* xp = XC + ((size_t)b * TB + c * 64 + sg * 8) * 2048 + h * 512 + j8;
            float acc[8];
#pragma unroll
            for (int i = 0; i < 8; ++i) acc[i] = 0.f;
#pragma unroll
            for (int s = 0; s < 8; ++s) {
                float f[8]; unpack8(*(const uint4*)(xp + (size_t)s * 2048), f);
                const float be = sBeta[k * 64 + sg * 8 + s];
#pragma unroll
                for (int i = 0; i < 8; ++i) acc[i] += be * f[i];
            }
            __syncthreads();
            st4(part + sg * 512 + j8, make_float4(acc[0], acc[1], acc[2], acc[3])); st4(part + sg * 512 + j8 + 4, make_float4(acc[4], acc[5], acc[6], acc[7]));
            __syncthreads();
            float tot = 0.f;
#pragma unroll
            for (int q = 0; q < 8; ++q) tot += part[q * 512 + tid];
            NBUF[((size_t)chain * NCH + c) * 512 + tid] = tot;
        }
    }
    bf16_t* XCs = (bf16_t*)sm;
    bf16_t* Qs = XCs + 64 * 520;
    for (int u = blockIdx.x; u < NB * 4 * NCH; u += gridDim.x) {
        const int bh = u / NCH, c = u % NCH, ub = bh >> 2, uh = bh & 3;
        __syncthreads();
#pragma unroll 2
        for (int i = 0; i < 8; ++i) {
            const int pp = tid + 512 * i, row = pp >> 6, c16 = pp & 63;
            const uint4 xv = *(const uint4*)(XC + ((size_t)ub * TB + c * 64 + row) * 2048 + uh * 512 + c16 * 8);
            float f[8]; unpack8(xv, f);
            float q[8];
#pragma unroll
            for (int bb = 0; bb < 2; ++bb) {
                const float* G = gtab + (size_t)(uh * 128 + c16 * 2 + bb) * 16;
                const float4 g0 = ld4(G), g1 = ld4(G + 4), g2 = ld4(G + 8), g3 = ld4(G + 12);
                q[bb * 4 + 0] = f[bb * 4] * g0.x + f[bb * 4 + 1] * g1.x + f[bb * 4 + 2] * g2.x + f[bb * 4 + 3] * g3.x;
                q[bb * 4 + 1] = f[bb * 4] * g0.y + f[bb * 4 + 1] * g1.y + f[bb * 4 + 2] * g2.y + f[bb * 4 + 3] * g3.y;
                q[bb * 4 + 2] = f[bb * 4] * g0.z + f[bb * 4 + 1] * g1.z + f[bb * 4 + 2] * g2.z + f[bb * 4 + 3] * g3.z;
                q[bb * 4 + 3] = f[bb * 4] * g0.w + f[bb * 4 + 1] * g1.w + f[bb * 4 + 2] * g2.w + f[bb * 4 + 3] * g3.w;
            }
            *(uint4*)(XCs + row * 520 + c16 * 8) = xv;
            *(uint4*)(Qs + row * 520 + c16 * 8) = make_uint4(pack2bf(q[0], q[1]), pack2bf(q[2], q[3]), pack2bf(q[4], q[5]), pack2bf(q[6], q[7]));
        }
        __syncthreads();
        const int st = wave & 3, tt0 = (wave >> 2) * 2;
        f32x4 a0 = (f32x4){0.f, 0.f, 0.f, 0.f}, a1 = a0;
        const bf16_t* ap = XCs + (st * 16 + (lane & 15)) * 520 + (lane >> 4) * 8;
        const bf16_t* bp0 = Qs + (tt0 * 16 + (lane & 15)) * 520 + (lane >> 4) * 8;
        const bf16_t* bp1 = bp0 + 16 * 520;
#pragma unroll
        for (int ks = 0; ks < 16; ++ks) {
            const bf16x8 af = *(const bf16x8*)(ap + ks * 32);
            a0 = __builtin_amdgcn_mfma_f32_16x16x32_bf16(af, *(const bf16x8*)(bp0 + ks * 32), a0, 0, 0, 0);
            a1 = __builtin_amdgcn_mfma_f32_16x16x32_bf16(af, *(const bf16x8*)(bp1 + ks * 32), a1, 0, 0, 0);
        }
        bf16_t* sp = SMAT + (size_t)u * 4096 + (size_t)(tt0 * 16 + (lane & 15)) * 64 + st * 16 + (lane >> 4) * 4;
        *(uint2*)sp = make_uint2(pack2bf(a0[0], a0[1]), pack2bf(a0[2], a0[3]));
        *(uint2*)(sp + 16 * 64) = make_uint2(pack2bf(a1[0], a1[1]), pack2bf(a1[2], a1[3]));
    }
}

DEV void phase_x2(const Params& p, float* sm) {
    int chain, sub; chain_ids(chain, sub);
    const int b = chain >> 3, h = (chain >> 1) & 3, dir = chain & 1;
    const bf16_t* XC = (const bf16_t*)(p.ws + OFF_XC);
    float* GSC = (float*)(p.ws + OFF_GSC); const float* CSC = (const float*)(p.ws + OFF_CSC); const float* NBUF = (const float*)(p.ws + OFF_NBUF);
    const float* gtab = (const float*)(p.ws + OFF_GTAB);
    const bf16_t* SMAT = (const bf16_t*)(p.ws + OFF_SMAT);
    const int tid = opaque_tid();
    float* sD0 = sm; float* sCf = sm + 132; float* sN0 = sm + 264; float* sN2 = sN0 + 9 * 512;
    for (int i = tid; i < NCH; i += NTHR) { sD0[i] = CSC[(chain * NCH + i) * 2]; sCf[i] = CSC[(chain * NCH + i) * 2 + 1]; }
    __syncthreads();
    {
        float n = 0.f;
        const float* nb = NBUF + (size_t)chain * NCH * 512 + tid;
#pragma unroll 4
        for (int step = 0; step < NCH; ++step) {
            const int c = chunk_at(dir, step);
            if ((c & 15) == sub) sN0[(c >> 4) * 512 + tid] = n;
            n = sD0[c] * n + sCf[c] * nb[(size_t)c * 512];
        }
    }
    __syncthreads();
    {
        const int blk = tid >> 2, cp = tid & 3;
        const float4 g = ld4(gtab + (size_t)(h * 128 + blk) * 16 + cp * 4);
        for (int k = 0; sub + 16 * k < NCH; ++k) {
            const float* n0 = sN0 + k * 512 + blk * 4;
            sN2[k * 512 + tid] = g.x * n0[0] + g.y * n0[1] + g.z * n0[2] + g.w * n0[3];
        }
    }
    __syncthreads();
    const int t = tid >> 3, part = tid & 7;
    for (int k = 0; sub + 16 * k < NCH; ++k) {
        const int c = sub + 16 * k;
        const size_t row = (size_t)b * TB + c * 64 + t;
        float dint = 0.f;
        {
            const bf16_t* xp = XC + row * 2048 + h * 512 + part * 64;
            const float* n2 = sN2 + k * 512 + part * 64;
#pragma unroll
            for (int i = 0; i < 8; ++i) {
                float f[8]; unpack8(*(const uint4*)(xp + i * 8), f);
                const float4 na = ld4(n2 + i * 8), nb2 = ld4(n2 + i * 8 + 4);
                dint += f[0] * na.x + f[1] * na.y + f[2] * na.z + f[3] * na.w + f[4] * nb2.x + f[5] * nb2.y + f[6] * nb2.z + f[7] * nb2.w;
            }
        }
        float di = 0.f;
        {
            float f[8]; unpack8(*(const uint4*)(SMAT + ((size_t)((b * 4 + h) * NCH + c)) * 4096 + t * 64 + part * 8), f);
#pragma unroll
            for (int e = 0; e < 8; ++e) {
                const int s = part * 8 + e;
                const float beta = GSC[((size_t)chain * TB + c * 64 + s) * 4 + 1];
                const bool keep = dir ? (s >= t) : (s <= t);
                di += keep ? f[e] * beta : 0.f;
            }
        }
        dint += __shfl_xor(dint, 1, 64); dint += __shfl_xor(dint, 2, 64); dint += __shfl_xor(dint, 4, 64);
        di += __shfl_xor(di, 1, 64); di += __shfl_xor(di, 2, 64); di += __shfl_xor(di, 4, 64);
        if (part == 0) {
            float* gp = GSC + ((size_t)chain * TB + c * 64 + t) * 4;
            const float4 g4 = ld4(gp);
            const float den = g4.x * di + g4.z * dint;
            gp[3] = 1.f / fmaxf(fabsf(den), g4.w);
        }
    }
}

#define MLSTM_PREFETCH(step_) do { \
    const int c_ = chunk_at(dir, (step_)); const size_t rb_ = (size_t)b * TB + (size_t)c_ * 64; \
    { const bf16_t* xb_ = XC + (rb_ + (tid >> 6)) * 2048 + h * 512 + (tid & 63) * 8; \
      rx0 = *(const uint4*)(xb_); rx1 = *(const uint4*)(xb_ + 8 * 2048); rx2 = *(const uint4*)(xb_ + 16 * 2048); rx3 = *(const uint4*)(xb_ + 24 * 2048); \
      rx4 = *(const uint4*)(xb_ + 32 * 2048); rx5 = *(const uint4*)(xb_ + 40 * 2048); rx6 = *(const uint4*)(xb_ + 48 * 2048); rx7 = *(const uint4*)(xb_ + 56 * 2048); } \
    rxm = *(const uint2*)(XM + (rb_ + ps) * 2048 + ch0 + pvb * 4); \
    rs = *(const uint4*)(SMAT + ((size_t)((b * 4 + h) * NCH + c_)) * 4096 + ps * 64 + pvb * 8); \
    rbeta = GSC[((size_t)chain * TB + c_ * 64 + ps) * 4 + 1]; \
    if (tid < 64) rsc = ld4(GSC + ((size_t)chain * TB + c_ * 64 + tid) * 4); \
    rd0 = CSC[(chain * NCH + c_) * 2]; rcf = CSC[(chain * NCH + c_) * 2 + 1]; } while (0)

DEV void phase_mlstm(const Params& p, float* sm) {
    int chain, sub; chain_ids(chain, sub);
    const int b = chain >> 3, h = (chain >> 1) & 3, dir = chain & 1;
    const bf16_t* XM = (const bf16_t*)(p.ws + OFF_XM);
    const bf16_t* XC = (const bf16_t*)(p.ws + OFF_XC);
    const bf16_t* SMAT = (const bf16_t*)(p.ws + OFF_SMAT);
    const float* GSC = (const float*)(p.ws + OFF_GSC); const float* CSC = (const float*)(p.ws + OFF_CSC);
    const float* gtab = (const float*)(p.ws + OFF_GTAB);
    bf16_t* H = (bf16_t*)(p.ws + OFF_H);
    const float* wv = p.in[35];
    char* smc = (char*)sm;
    bf16_t* XCs = (bf16_t*)smc;
    bf16_t* Cs = (bf16_t*)(smc + 66560);
    bf16_t* Vb = (bf16_t*)(smc + 66560 + 33280);
    bf16_t* Vw = Vb + 32 * 72;
    bf16_t* Sm = Vw + 32 * 72;
    float* Gs = (float*)(smc + 66560 + 33280 + 2 * 4608 + 9216);
    float* sc = Gs + 2048;
    const int tid = opaque_tid(), lane = tid & 63, wave = tid >> 6;
    for (int i = tid; i < 32 * 520 / 2; i += NTHR) ((unsigned*)Cs)[i] = 0u;
    for (int i = tid; i < 2048; i += NTHR) Gs[i] = gtab[h * 2048 + i];
    const int ps = tid >> 3, pvb = tid & 7;
    const int ch0 = h * 512 + sub * 32;
    float wvr[16];
#pragma unroll
    for (int i = 0; i < 16; ++i) wvr[i] = wv[(size_t)((ch0 >> 2) + pvb) * 16 + i];
    f32x4 accS[4][2];
#pragma unroll
    for (int i = 0; i < 4; ++i) { accS[i][0] = (f32x4){0.f, 0.f, 0.f, 0.f}; accS[i][1] = (f32x4){0.f, 0.f, 0.f, 0.f}; }
    uint4 rx0, rx1, rx2, rx3, rx4, rx5, rx6, rx7; uint2 rxm; uint4 rs; float rbeta; float4 rsc = make_float4(0.f, 0.f, 0.f, 0.f); float rd0, rcf;
    MLSTM_PREFETCH(0);
    __syncthreads();
#pragma unroll 1
    for (int step = 0; step < NCH; ++step) {
        const int c = chunk_at(dir, step);
        const float d0 = rd0, cf = rcf;
        {
            bf16_t* xd = XCs + (tid >> 6) * 520 + (tid & 63) * 8;
            *(uint4*)(xd) = rx0; *(uint4*)(xd + 8 * 520) = rx1; *(uint4*)(xd + 16 * 520) = rx2; *(uint4*)(xd + 24 * 520) = rx3;
            *(uint4*)(xd + 32 * 520) = rx4; *(uint4*)(xd + 40 * 520) = rx5; *(uint4*)(xd + 48 * 520) = rx6; *(uint4*)(xd + 56 * 520) = rx7;
        }
        {
            const float x0 = bflo(rxm.x), x1 = bfhi(rxm.x), x2 = bflo(rxm.y), x3 = bfhi(rxm.y);
#pragma unroll
            for (int d = 0; d < 4; ++d) {
                const float v = (x0 * wvr[d] + x1 * wvr[4 + d] + x2 * wvr[8 + d] + x3 * wvr[12 + d]) * rbeta;
                Vb[(pvb * 4 + d) * 72 + ps] = __builtin_bit_cast(unsigned short, (__bf16)v);
                Vw[(pvb * 4 + d) * 72 + ps] = __builtin_bit_cast(unsigned short, (__bf16)(v * cf));
            }
        }
        {
#define SMASK(q_) (((dir ? (pvb * 8 + 2 * (q_) >= ps) : (pvb * 8 + 2 * (q_) <= ps)) ? 0x0000ffffu : 0u) | ((dir ? (pvb * 8 + 2 * (q_) + 1 >= ps) : (pvb * 8 + 2 * (q_) + 1 <= ps)) ? 0xffff0000u : 0u))
            *(uint4*)(Sm + ps * 72 + pvb * 8) = make_uint4(rs.x & SMASK(0), rs.y & SMASK(1), rs.z & SMASK(2), rs.w & SMASK(3));
#undef SMASK
        }
        if (tid < 64) st4(sc + tid * 4, rsc);
        { const int nstep = (step + 1 < NCH) ? step + 1 : step; MLSTM_PREFETCH(nstep); }
        __syncthreads();
        {
            const int vt = wave & 1, tt = wave >> 1;
            f32x4 ao = (f32x4){0.f, 0.f, 0.f, 0.f}, ai = ao, ao1 = ao, ao2 = ao, ao3 = ao;
            const bf16_t* ap = Cs + (vt * 16 + (lane & 15)) * 520 + (lane >> 4) * 8;
            const bf16_t* bp = XCs + (tt * 16 + (lane & 15)) * 520 + (lane >> 4) * 8;
#pragma unroll
            for (int ks = 0; ks < 16; ks += 4) {
                ao = __builtin_amdgcn_mfma_f32_16x16x32_bf16(*(const bf16x8*)(ap + ks * 32), *(const bf16x8*)(bp + ks * 32), ao, 0, 0, 0);
                ao1 = __builtin_amdgcn_mfma_f32_16x16x32_bf16(*(const bf16x8*)(ap + (ks + 1) * 32), *(const bf16x8*)(bp + (ks + 1) * 32), ao1, 0, 0, 0);
                ao2 = __builtin_amdgcn_mfma_f32_16x16x32_bf16(*(const bf16x8*)(ap + (ks + 2) * 32), *(const bf16x8*)(bp + (ks + 2) * 32), ao2, 0, 0, 0);
                ao3 = __builtin_amdgcn_mfma_f32_16x16x32_bf16(*(const bf16x8*)(ap + (ks + 3) * 32), *(const bf16x8*)(bp + (ks + 3) * 32), ao3, 0, 0, 0);
            }
            ao = (ao + ao1) + (ao2 + ao3);
            const bf16_t* ap2 = Vb + (vt * 16 + (lane & 15)) * 72 + (lane >> 4) * 8;
            const bf16_t* bp2 = Sm + (tt * 16 + (lane & 15)) * 72 + (lane >> 4) * 8;
#pragma unroll
            for (int ks = 0; ks < 2; ++ks) ai = __builtin_amdgcn_mfma_f32_16x16x32_bf16(*(const bf16x8*)(ap2 + ks * 32), *(const bf16x8*)(bp2 + ks * 32), ai, 0, 0, 0);
            if (c >= 4) {
                const int t = tt * 16 + (lane & 15);
                const float4 s4 = ld4(sc + t * 4);
                const float h0 = (s4.x * ai[0] + s4.z * ao[0]) * s4.w, h1 = (s4.x * ai[1] + s4.z * ao[1]) * s4.w;
                const float h2 = (s4.x * ai[2] + s4.z * ao[2]) * s4.w, h3 = (s4.x * ai[3] + s4.z * ao[3]) * s4.w;
                bf16_t* hp = H + ((size_t)b * NL + (size_t)c * 64 + t - NCX) * 2048 + ch0 + vt * 16 + (lane >> 4) * 4;
                const unsigned u0 = pack2bf(h0, h1), u1 = pack2bf(h2, h3);
                __builtin_amdgcn_global_atomic_fadd_v2bf16((__attribute__((address_space(1))) s16x2*)hp, __builtin_bit_cast(s16x2, u0));
                __builtin_amdgcn_global_atomic_fadd_v2bf16((__attribute__((address_space(1))) s16x2*)(hp + 2), __builtin_bit_cast(s16x2, u1));
            }
        }
#pragma unroll
        for (int jt = 0; jt < 4; ++jt) { accS[jt][0] *= d0; accS[jt][1] *= d0; }
#pragma unroll
        for (int ks = 0; ks < 2; ++ks) {
            const bf16x8 b0 = *(const bf16x8*)(Vw + (lane & 15) * 72 + ks * 32 + (lane >> 4) * 8);
            const bf16x8 b1 = *(const bf16x8*)(Vw + (16 + (lane & 15)) * 72 + ks * 32 + (lane >> 4) * 8);
            const int row0 = ks * 32 + (lane >> 4) * 8 + ((lane & 15) >> 2);
#pragma unroll
            for (int jt = 0; jt < 4; ++jt) {
                const int col = wave * 64 + jt * 16 + (lane & 3) * 4;
                const s16x4 lo = __builtin_amdgcn_ds_read_tr16_b64_v4i16((__attribute__((address_space(3))) s16x4*)(XCs + row0 * 520 + col));
                const s16x4 hi = __builtin_amdgcn_ds_read_tr16_b64_v4i16((__attribute__((address_space(3))) s16x4*)(XCs + (row0 + 4) * 520 + col));
                const bf16x8 af = (bf16x8){lo[0], lo[1], lo[2], lo[3], hi[0], hi[1], hi[2], hi[3]};
                accS[jt][0] = __builtin_amdgcn_mfma_f32_16x16x32_bf16(af, b0, accS[jt][0], 0, 0, 0);
                accS[jt][1] = __builtin_amdgcn_mfma_f32_16x16x32_bf16(af, b1, accS[jt][1], 0, 0, 0);
            }
        }
        __syncthreads();
#pragma unroll
        for (int jt = 0; jt < 4; ++jt) {
            const int blk = wave * 16 + jt * 4 + (lane >> 4);
            const float4 g0 = ld4(Gs + blk * 16), g1 = ld4(Gs + blk * 16 + 4), g2 = ld4(Gs + blk * 16 + 8), g3 = ld4(Gs + blk * 16 + 12);
#pragma unroll
            for (int v2 = 0; v2 < 2; ++v2) {
                const f32x4 a = accS[jt][v2];
                const float o0 = g0.x * a[0] + g0.y * a[1] + g0.z * a[2] + g0.w * a[3];
                const float o1 = g1.x * a[0] + g1.y * a[1] + g1.z * a[2] + g1.w * a[3];
                const float o2 = g2.x * a[0] + g2.y * a[1] + g2.z * a[2] + g2.w * a[3];
                const float o3 = g3.x * a[0] + g3.y * a[1] + g3.z * a[2] + g3.w * a[3];
                *(uint2*)(Cs + (v2 * 16 + (lane & 15)) * 520 + blk * 4) = make_uint2(pack2bf(o0, o1), pack2bf(o2, o3));
            }
        }
    }
}

DEV void phase_finish1(const Params& p) {
    bf16_t* H = (bf16_t*)(p.ws + OFF_H);
    const bf16_t* XC = (const bf16_t*)(p.ws + OFF_XC);
    const bf16_t* Z = (const bf16_t*)(p.ws + OFF_XM);
    const float* ng = p.in[44]; const float* skip = p.in[45];
    const int tid_ = opaque_tid(); const int lane = tid_ & 63, gw = blockIdx.x * NWV + (tid_ >> 6), ngw = gridDim.x * NWV;
    for (int it = gw; it < NB * NL * 4; it += ngw) {
        const int r = it >> 2, h = it & 3, b = r >= NL ? 1 : 0, nn = r - b * NL;
        const int c0 = h * 512 + lane * 8;
        bf16_t* hp = H + (size_t)r * 2048 + c0;
        float v[8]; unpack8(*(const uint4*)hp, v);
        float sum = 0.f;
#pragma unroll
        for (int j = 0; j < 8; ++j) sum += v[j];
        const float mean = wave_sum(sum) * (1.f / 512.f);
        float sq = 0.f;
#pragma unroll
        for (int j = 0; j < 8; ++j) { v[j] -= mean; sq += v[j] * v[j]; }
        const float rstd = rsqrtf(wave_sum(sq) * (1.f / 512.f) + 1e-5f);
        float xc[8], z[8];
        unpack8(*(const uint4*)(XC + ((size_t)b * TB + NCX + nn) * 2048 + c0), xc);
        unpack8(*(const uint4*)(Z + (size_t)r * 2048 + c0), z);
        float o[8];
#pragma unroll
        for (int j = 0; j < 8; ++j) o[j] = (v[j] * rstd * ng[c0 + j] + skip[c0 + j] * xc[j]) * silu_f(z[j]);
        *(uint4*)hp = make_uint4(pack2bf(o[0], o[1]), pack2bf(o[2], o[3]), pack2bf(o[4], o[5]), pack2bf(o[6], o[7]));
    }
}

__global__ void __launch_bounds__(NTHR) fwd_kernel(Params p) {
    extern __shared__ __attribute__((aligned(16))) float sm[];
    volatile LAS unsigned* xst = (volatile LAS unsigned*)((LAS char*)sm + (LDS_BYTES - 16));
    if (threadIdx.x == 0) { xst[0] = 0u; xst[1] = 0u; }
    __syncthreads();
    const XcdBarrier xbar = xcd_barrier_post((unsigned*)(p.ws + OFF_BAR), xst);
    const int tid = opaque_tid(), lane = tid & 63, wave = tid >> 6;
    float* modv = (float*)(p.ws + OFF_MODV);
    float* X1C = (float*)(p.ws + OFF_X1C);

    phase_mod(p, sm);
    phase_tables(p);
    transpose_convert(p.in[8], 1024, EIN, 4096, (bf16_t*)(p.ws + OFF_WT0), sm);
    transpose_convert(p.in[29], 1024, 4096, 4096, (bf16_t*)(p.ws + OFF_WT1), sm);
    transpose_convert(p.in[9], 1024, 1024, 1024, (bf16_t*)(p.ws + OFF_WT2), sm);
    transpose_convert(p.in[30], 2048, 1024, 1024, (bf16_t*)(p.ws + OFF_WT3), sm);
    xcd_barrier(xbar);

#pragma unroll 1
    for (int b = 0; b < NB; ++b) {
        if (b == 0) { phase_h0(p, 0); xcd_barrier(xbar); }
        run_gemm((const bf16_t*)(p.ws + OFF_YC), (const bf16_t*)(p.ws + OFF_WT0), TB, 4096, DM, EpBf16{(bf16_t*)(p.ws + OFF_P0), EIN, EIN}, sm);
        xcd_barrier(xbar);
        for (int u = blockIdx.x; u < 24 * NCH; u += gridDim.x) {
            if (u < 16 * NCH) rwkv1_unit(p, (u / NCH) >> 1, (u / NCH) & 1, u % NCH, sm);
            else { const int v = u - 16 * NCH; gla1_unit(p, (v / NCH) >> 1, (v / NCH) & 1, v % NCH, sm); }
        }
        xcd_barrier(xbar);
        if (blockIdx.x < 128) gla2_unit(p, blockIdx.x);
        else if (blockIdx.x < 192) { if (wave == 0) rwkv2_unit(p, (blockIdx.x - 128) >> 2, (blockIdx.x - 128) & 3, lane); }
        xcd_barrier(xbar);
        for (int u = blockIdx.x; u < 12 * NCH; u += gridDim.x) {
            if (u < 8 * NCH) rwkv3_unit(p, u / NCH, u % NCH, sm);
            else { const int v = u - 8 * NCH; gla3_unit(p, v / NCH, v % NCH, sm); }
        }
        xcd_barrier(xbar);
        run_gemm((const bf16_t*)(p.ws + OFF_YC), (const bf16_t*)(p.ws + OFF_WT2), TB, DM, DM, EpRes0{(float*)(p.ws + OFF_P0), p.in[0], p.in[2], modv, b}, sm);
        xcd_barrier(xbar);
        ln_rows((const float*)(p.ws + OFF_P0), TB, p.in[6], p.in[7], p.out + (size_t)b * NL * DM, X1C + (size_t)b * NCX * DM, NCX,
                (bf16_t*)(p.ws + OFF_H1B) + (size_t)b * TB * DM, modv + (3 + 2) * 3072, modv + (3 + b) * 3072);
        if (b == 0) phase_h0(p, 1);
        xcd_barrier(xbar);
    }

    run_gemm((const bf16_t*)(p.ws + OFF_H1B), (const bf16_t*)(p.ws + OFF_WT1), RT, 2048, DM, EpBf16{(bf16_t*)(p.ws + OFF_XM), 2048, 2048}, sm);
    zero_f4((float*)(p.ws + OFF_H), (size_t)NB * NL * 1024);
    xcd_barrier(xbar);
    phase_conv1(p, sm);
    xcd_barrier(xbar);
    phase_x1(p, sm);
    xcd_barrier(xbar);
    phase_x2(p, sm);
    xcd_barrier(xbar);
    phase_mlstm(p, sm);
    xcd_barrier(xbar);
    phase_h1l(p);
    xcd_barrier(xbar);
    run_gemm((const bf16_t*)(p.ws + OFF_H1B), (const bf16_t*)(p.ws + OFF_WT1) + (size_t)2048 * 1024, NB * NL, 2048, DM, EpBf16{(bf16_t*)(p.ws + OFF_XM), 2048, 2048}, sm);
    xcd_barrier(xbar);
    phase_finish1(p);
    xcd_barrier(xbar);
    run_gemm((const bf16_t*)(p.ws + OFF_H), (const bf16_t*)(p.ws + OFF_WT3), NB * NL, DM, 2048, EpRes1{(float*)(p.ws + OFF_XC), p.out, modv + 3 * 3072}, sm);
    xcd_barrier(xbar);
    ln_rows((const float*)(p.ws + OFF_XC), NB * NL, p.in[6] + 1024, p.in[7] + 1024, p.out, p.out, 0);
}

extern "C" void kernel_launch(void* const* d_in, const int* in_sizes, int n_in, void* d_out, int out_size, void* d_ws, size_t ws_size, hipStream_t stream) {
    static int grid_blocks = 0;
    if (grid_blocks == 0) {
        if (ws_size < WS_NEED || n_in != 46) { fprintf(stderr, "kernel_launch: bad ws_size %zu (need %zu) or n_in %d\n", ws_size, (size_t)WS_NEED, n_in); grid_blocks = -1; return; }
        int dev = 0, cus = 0, per_cu = 0;
        (void)hipGetDevice(&dev);
        (void)hipDeviceGetAttribute(&cus, hipDeviceAttributeMultiprocessorCount, dev);
        (void)hipFuncSetAttribute((const void*)fwd_kernel, hipFuncAttributeMaxDynamicSharedMemorySize, LDS_BYTES);
        (void)hipOccupancyMaxActiveBlocksPerMultiprocessor(&per_cu, (const void*)fwd_kernel, NTHR, LDS_BYTES);
        if (per_cu < 1 || cus < 256) { fprintf(stderr, "kernel_launch: occupancy query says %d blocks/CU on %d CUs; this kernel needs 256 resident workgroups\n", per_cu, cus); grid_blocks = -1; return; }
        grid_blocks = 256;
    }
    if (grid_blocks < 0) return;
    (void)hipMemsetAsync((char*)d_ws + OFF_BAR, 0, XCD_BAR_WORDS * 4, stream);
    Params p{};
    for (int i = 0; i < 46; ++i) p.in[i] = (const float*)d_in[i];
    p.out = (float*)d_out; p.ws = (char*)d_ws;
    void* args[] = {&p};
    hipError_t e = hipLaunchCooperativeKernel((const void*)fwd_kernel, dim3(grid_blocks), dim3(NTHR), args, LDS_BYTES, stream);
    if (e != hipSuccess) fprintf(stderr, "cooperative launch failed: %s (grid %d)\n", hipGetErrorString(e), grid_blocks);
}
```

```cpp
#include <hip/hip_runtime.h>
#include <cstdio>
#include <cmath>

#define DEV __device__ __forceinline__

constexpr int NB = 2, NL = 8192, DM = 1024, NCX = 256, TB = NCX + NL;
constexpr int RT = NB * TB;
constexpr int NCH = TB / 64;
constexpr int EIN = 3872, RW0 = 1568;
constexpr int NTHR = 512, NWV = 8;
constexpr float ALPHA = 1.41421356237f;
constexpr float KSCALE = 0.04419417382f;

constexpr size_t OFF_MODV = 0;
constexpr size_t OFF_X1C  = 131072;
constexpr size_t OFF_BAR  = 3145728;
constexpr size_t OFF_BIG  = 4194304;
constexpr size_t OFF_P0   = OFF_BIG;
constexpr size_t OFF_YC   = OFF_BIG + (size_t)TB * EIN * 2;
constexpr size_t OFF_GDS  = OFF_YC + (size_t)TB * 1024 * 2;
constexpr size_t OFF_GDEC = OFF_GDS + (size_t)8 * NCH * 8192 * 4;
constexpr size_t OFF_RU   = OFF_GDEC + (size_t)8 * NCH * 64 * 4;
constexpr size_t OFF_RS0  = OFF_RU + (size_t)16 * NCH * 16384 * 2;
constexpr size_t OFF_BONS = OFF_RS0 + (size_t)16 * NCH * 4096 * 2;
constexpr size_t L0_END   = OFF_BONS + (size_t)2 * TB * 8 * 4;
constexpr size_t OFF_XM   = OFF_BIG;
constexpr size_t OFF_XC   = OFF_XM + (size_t)RT * 2048 * 2;
constexpr size_t OFF_H    = OFF_XC + (size_t)RT * 2048 * 2;
constexpr size_t OFF_WT0  = OFF_H + (size_t)NB * NL * 2048 * 2;
constexpr size_t OFF_WT1  = OFF_WT0 + (size_t)4096 * 1024 * 2;
constexpr size_t OFF_WT2  = OFF_WT1 + (size_t)4096 * 1024 * 2;
constexpr size_t OFF_WT3  = OFF_WT2 + (size_t)1024 * 1024 * 2;
constexpr size_t OFF_G16  = OFF_WT3 + (size_t)1024 * 2048 * 2;
constexpr size_t OFF_SMAT = OFF_G16 + (size_t)RT * 16 * 4;
constexpr size_t OFF_GSC  = OFF_SMAT + (size_t)NB * 4 * NCH * 4096 * 2;
constexpr size_t OFF_CSC  = OFF_GSC + (size_t)16 * TB * 4 * 4;
constexpr size_t OFF_NBUF = OFF_CSC + (size_t)16 * NCH * 2 * 4;
constexpr size_t OFF_GTAB = 3407872;
constexpr size_t OFF_WFT  = OFF_GTAB + (size_t)4 * 128 * 16 * 4;
static_assert(OFF_WFT + (size_t)16 * 4096 * 2 <= OFF_BIG, "low-region tables overflow");
constexpr size_t OFF_G16P = OFF_NBUF + (size_t)16 * NCH * 512 * 4;
constexpr size_t OFF_H1B  = OFF_G16;
constexpr size_t WS_NEED  = (OFF_G16P + (size_t)4 * RT * 16 * 4 > OFF_H1B + (size_t)RT * 1024 * 2) ? OFF_G16P + (size_t)4 * RT * 16 * 4 : OFF_H1B + (size_t)RT * 1024 * 2;
static_assert(WS_NEED <= (size_t)256 * 1024 * 1024, "workspace exceeds the guaranteed 256 MiB");

static_assert(L0_END <= OFF_WT0, "layer-0 buffers overlap the weight copies");
constexpr int LDS_BYTES = 139264;

struct Params { const float* in[46]; float* out; char* ws; };
typedef unsigned short bf16_t;
typedef __attribute__((ext_vector_type(8))) short bf16x8;
typedef __attribute__((ext_vector_type(4))) short s16x4;
typedef __attribute__((ext_vector_type(2))) short s16x2;
typedef __attribute__((ext_vector_type(4))) float f32x4;
typedef __attribute__((ext_vector_type(2))) __bf16 bf2_t;
DEV unsigned pack2bf(float lo, float hi) { bf2_t v; v[0] = (__bf16)lo; v[1] = (__bf16)hi; return __builtin_bit_cast(unsigned, v); }
DEV float bflo(unsigned u) { return __uint_as_float(u << 16); }
DEV float bfhi(unsigned u) { return __uint_as_float(u & 0xffff0000u); }
DEV float bf2f(bf16_t v) { return __uint_as_float(((unsigned)v) << 16); }
DEV void unpack8(uint4 u, float* f) { f[0] = bflo(u.x); f[1] = bfhi(u.x); f[2] = bflo(u.y); f[3] = bfhi(u.y); f[4] = bflo(u.z); f[5] = bfhi(u.z); f[6] = bflo(u.w); f[7] = bfhi(u.w); }

DEV float wave_sum(float v) {
#pragma unroll
    for (int o = 32; o > 0; o >>= 1) v += __shfl_xor(v, o, 64);
    return v;
}
DEV float wave_max(float v) {
#pragma unroll
    for (int o = 32; o > 0; o >>= 1) v = fmaxf(v, __shfl_xor(v, o, 64));
    return v;
}
DEV float fexp(float x) { return __expf(x); }
DEV float frcp(float x) { return __builtin_amdgcn_rcpf(x); }
DEV float sigmoid_f(float x) { return frcp(1.f + fexp(-x)); }
DEV float silu_f(float x) { return x * frcp(1.f + fexp(-x)); }
DEV float logsig_f(float x) { return fminf(x, 0.f) - __logf(1.f + fexp(-fabsf(x))); }
DEV float tanh_f(float x) { const float e = fexp(2.f * x); return 1.f - 2.f * frcp(e + 1.f); }
DEV void lds_fence() { asm volatile("" ::: "memory"); }
DEV int opaque_tid() { int t = threadIdx.x; asm volatile("" : "+v"(t)); return t; }
DEV int scan_s(int dir, int u) { return dir == 0 ? u : (u < NCX ? (NCX - 1 - u) : (TB - 1 + NCX - u)); }
DEV int chunk_at(int dir, int step) { return dir == 0 ? step : (step < 4 ? 3 - step : (NCH + 3 - step)); }
DEV float4 ld4(const float* p) { return *(const float4*)p; }
DEV void st4(float* p, float4 v) { *(float4*)p = v; }


#define XB_TMO      128
#define XB_XCNT(j)  (256  + 64 * (j))
#define XB_XSUB(j)  (1280 + 64 * (j))
#define XB_XGEN(j)  (2304 + 64 * (j))
#define XB_TOP      3328
#define XB_TOPGEN   3392
#define XCD_BAR_WORDS 3456
#define XB_SPIN_CAP (1u << 22)
#define LAS __attribute__((address_space(3)))
DEV unsigned xb_ld(unsigned* p) { return __hip_atomic_load(p, __ATOMIC_RELAXED, __HIP_MEMORY_SCOPE_AGENT); }
DEV unsigned xb_add(unsigned* p, unsigned v) { return __hip_atomic_fetch_add(p, v, __ATOMIC_RELAXED, __HIP_MEMORY_SCOPE_AGENT); }
DEV unsigned xb_xcc_id() { return (unsigned)__builtin_amdgcn_s_getreg((3 << 11) | 20) & 0xFu; }
#define XB_SPIN(cond, bar) do { unsigned _sp = 0; while (cond) { __builtin_amdgcn_s_sleep(1); \
    if ((++_sp & 255u) == 0u) { if (xb_ld(&(bar)[XB_TMO])) break; if (_sp > XB_SPIN_CAP) { atomicAdd(&(bar)[XB_TMO], 1u); break; } } } } while (0)
struct XcdBarrier { unsigned* bar; unsigned x; volatile LAS unsigned* st; };
DEV XcdBarrier xcd_barrier_post(unsigned* bar, volatile LAS unsigned* st) {
    XcdBarrier b; b.bar = bar; b.x = xb_xcc_id(); b.st = st;
    if (threadIdx.x == 0) (void)xb_add(&bar[XB_XCNT(b.x)], 1u);
    return b;
}
DEV void xcd_barrier_complete(unsigned* bar, unsigned x, unsigned& nloc, unsigned& nx) {
    const unsigned G = gridDim.x * gridDim.y * gridDim.z;
    unsigned sum, cnt, mine, sp = 0u;
    for (;;) {
        sum = 0u; cnt = 0u; mine = 0u;
#pragma unroll
        for (unsigned j = 0; j < 16; ++j) { const unsigned c = xb_ld(&bar[XB_XCNT(j)]); sum += c; cnt += (c > 0u) ? 1u : 0u; mine = (j == x) ? c : mine; }
        if (sum == G) break;
        __builtin_amdgcn_s_sleep(1);
        if ((++sp & 255u) == 0u) { if (xb_ld(&bar[XB_TMO])) break; if (sp > XB_SPIN_CAP) { atomicAdd(&bar[XB_TMO], 1u); break; } }
    }
    nloc = mine > 0u ? mine : 1u; nx = cnt > 0u ? cnt : 1u;
}
DEV void xcd_barrier(const XcdBarrier& b) {
    asm volatile("s_waitcnt vmcnt(0)" ::: "memory");
    __syncthreads();
    if (threadIdx.x == 0) {
        unsigned* bar = b.bar;
        __builtin_amdgcn_s_waitcnt(0);
        unsigned nloc = b.st[0], nx = b.st[1];
        if (nloc == 0u) { xcd_barrier_complete(bar, b.x, nloc, nx); b.st[0] = nloc; b.st[1] = nx; }
        const unsigned old = xb_add(&bar[XB_XSUB(b.x)], 1u);
        const unsigned gen = old / nloc;
        if (old + 1u == (gen + 1u) * nloc) {
            __builtin_amdgcn_fence(__ATOMIC_RELEASE, "agent");
            asm volatile("s_waitcnt vmcnt(0)" ::: "memory");
            const unsigned og = xb_add(&bar[XB_TOP], 1u);
            const unsigned tg = og / nx;
            if (og + 1u == (tg + 1u) * nx) xb_add(&bar[XB_TOPGEN], 1u);
            else XB_SPIN(xb_ld(&bar[XB_TOPGEN]) == tg, bar);
            __builtin_amdgcn_fence(__ATOMIC_ACQUIRE, "agent");
            xb_add(&bar[XB_XGEN(b.x)], 1u);
            asm volatile("s_waitcnt vmcnt(0)" ::: "memory");
        } else {
            XB_SPIN(xb_ld(&bar[XB_XGEN(b.x)]) == gen, bar);
            __builtin_amdgcn_fence(__ATOMIC_ACQUIRE, "agent");
            asm volatile("s_waitcnt vmcnt(0)" ::: "memory");
        }
    }
    __syncthreads();
}

namespace pg8 {
#define PG8_LAS __attribute__((address_space(3)))
typedef unsigned short bf16_t;
typedef short bf16x8 __attribute__((ext_vector_type(8)));
typedef float f32x4 __attribute__((ext_vector_type(4)));
typedef unsigned u32x4 __attribute__((ext_vector_type(4)));
constexpr int BM = 256, BK = 64, HALF = 128, HTB = HALF * BK * 2  , STAGE_BYTES = 8 * HTB, NXCD = 8, WGM = 8;

__host__ __device__ __forceinline__ int lds_byte(int r, int c) { const int st = (r >> 4) * 2 + (c >> 5), rr = r & 15, cc = c & 31, ob = rr * 64 + cc * 2; return st * 1024 + (ob ^ (((ob >> 9) & 1) << 5)); }
__host__ __device__ __forceinline__ void stage_rc(int b, int& R, int& C) { const int st = b / 1024, sb = b % 1024, swz = sb ^ (((sb >> 9) & 1) << 5); R = (st >> 1) * 16 + swz / 64; C = (st & 1) * 32 + (swz % 64) / 2; }
__host__ __device__ __forceinline__ int perm32(int rho) { const int n = rho >> 4, i = rho & 15; return 8 * (i >> 2) + 4 * n + (i & 3); }

struct Unit { int pm, pn; };
struct Gemm { const bf16_t* A; const bf16_t* Bt; int M, N, K; };

struct StaticOrder {
    int nM, nN, nwg, G, c;
    __host__ __device__ void init(int M, int N, int G_, int c_) { nM = M / BM; nN = N / BM; nwg = nM * nN; G = G_; c = c_; }
    __host__ __device__ bool next(int i, Unit& u) const {
        const long L = (long)i * G + c; if (L >= nwg) return false;
        int wgid = (int)L; { const int q = nwg / NXCD, r = nwg % NXCD, xcd = wgid % NXCD, off = wgid / NXCD; wgid = (xcd < r ? xcd * (q + 1) : r * (q + 1) + (xcd - r) * q) + off; }
        const int nig = WGM * nN, gid = wgid / nig, fm = gid * WGM, gsz = (nM - fm) < WGM ? (nM - fm) : WGM;
        u.pm = fm + ((wgid % nig) % gsz); u.pn = (wgid % nig) / gsz; return true;
    }
    __device__ __forceinline__ void a_ready(const Unit&) const {}
    __device__ __forceinline__ void done(const Unit&) const {}
};

template <class Epi, class Sched, bool STAMP = false>
__device__ __forceinline__ void gemm_phase(PG8_LAS unsigned char* lds, const Gemm g, const Sched& S, const Epi& E, unsigned long long* stamps) {
    int tid = threadIdx.x; asm volatile("" : "+v"(tid));
    const int wid = __builtin_amdgcn_readfirstlane(tid >> 6), lane = tid & 63, wr = wid >> 2, wc = wid & 3, fr = lane & 15, fq = lane >> 4;
    const int K = g.K, nt = K / BK;
#define PG8_STAMP() do { } while (0)
    PG8_STAMP();
    unsigned voffA[2], voffB[2];
#pragma unroll
    for (int i = 0; i < 2; ++i) { int R, C; stage_rc(tid * 16 + i * 8192, R, C); const int Rb = Epi::PERM ? ((R & ~31) + perm32(R & 31)) : R;
        voffA[i] = (unsigned)(R * K + C) * 2u; voffB[i] = (unsigned)(Rb * K + C) * 2u; }
    const size_t kstep = (size_t)(BK * 2);
    const size_t hstep = (size_t)HALF * K * 2;
    const size_t tstep = 2 * hstep;
    const unsigned ldsw = (unsigned)wid * 1024u;
    const int aoff = lds_byte(wr * 64 + fr, fq * 8), boff = lds_byte(wc * 32 + fr, fq * 8);
#define PG8_SA(b, h) (((b) * 2 + (h)) * HTB)
#define PG8_SB(b, h) ((4 + (b) * 2 + (h)) * HTB)
#define PG8_STAGE(bufoff, gbase, voff) do { _Pragma("unroll") for (int _i = 0; _i < 2; ++_i) \
        __builtin_amdgcn_global_load_lds((const unsigned*)((const char*)(gbase) + (voff)[_i]), (PG8_LAS unsigned*)(lds + (bufoff) + ldsw + _i * 8192), 16, 0, 0); } while (0)
#define PG8_LDA(dst, b, h) do { _Pragma("unroll") for (int m = 0; m < 4; ++m) _Pragma("unroll") for (int k = 0; k < 2; ++k) dst[m][k] = *(const PG8_LAS bf16x8*)(lds + PG8_SA(b, h) + aoff + m * 2048 + k * 1024); } while (0)
#define PG8_LDB(dst, b, h) do { _Pragma("unroll") for (int n = 0; n < 2; ++n) _Pragma("unroll") for (int k = 0; k < 2; ++k) dst[n][k] = *(const PG8_LAS bf16x8*)(lds + PG8_SB(b, h) + boff + n * 2048 + k * 1024); } while (0)
#define PG8_MMA(ai, bj, At, Bt) do { __builtin_amdgcn_s_setprio(1); _Pragma("unroll") for (int m = 0; m < 4; ++m) _Pragma("unroll") for (int n = 0; n < 2; ++n) _Pragma("unroll") for (int k = 0; k < 2; ++k) \
        acc[ai][bj][m][n] = __builtin_amdgcn_mfma_f32_16x16x32_bf16(Bt[n][k], At[m][k], acc[ai][bj][m][n], 0, 0, 0); __builtin_amdgcn_s_setprio(0); } while (0)
#define PG8_WAIT_V(n) asm volatile("s_waitcnt vmcnt(" #n ")" ::: "memory")
#define PG8_WAIT_L(n) asm volatile("s_waitcnt lgkmcnt(" #n ")" ::: "memory")
#define PG8_BAR __builtin_amdgcn_s_barrier()
#define PG8_SCHED __builtin_amdgcn_sched_barrier(0)
    Unit cur, nxt; int ui = 0;
    if (!S.next(0, cur)) return;
    f32x4 acc[2][2][4][2];
#pragma unroll
    for (int a = 0; a < 2; ++a)
#pragma unroll
        for (int b = 0; b < 2; ++b)
#pragma unroll
            for (int m = 0; m < 4; ++m)
#pragma unroll
                for (int n = 0; n < 2; ++n) acc[a][b][m][n] = (f32x4){0.f, 0.f, 0.f, 0.f};
    bf16x8 At[4][2], B0[2][2], B1[2][2];
    const char* cA = (const char*)g.A + (size_t)cur.pm * tstep; const char* cB = (const char*)g.Bt + (size_t)cur.pn * tstep;
    S.a_ready(cur);
    PG8_STAGE(PG8_SB(0, 0), cB, voffB); PG8_STAGE(PG8_SA(0, 0), cA, voffA); PG8_STAGE(PG8_SB(0, 1), cB + hstep, voffB); PG8_STAGE(PG8_SA(0, 1), cA + hstep, voffA);
    if (wr == 1) PG8_BAR;
    PG8_WAIT_V(4); PG8_BAR;
    PG8_STAGE(PG8_SB(1, 0), cB + kstep, voffB); PG8_STAGE(PG8_SA(1, 0), cA + kstep, voffA); PG8_STAGE(PG8_SB(1, 1), cB + hstep + kstep, voffB);
    PG8_WAIT_V(6); PG8_BAR;
    PG8_STAMP();
    for (;;) {
        const bool has_next = S.next(ui + 1, nxt);
        const char* nA = has_next ? (const char*)g.A + (size_t)nxt.pm * tstep : cA; const char* nB = has_next ? (const char*)g.Bt + (size_t)nxt.pn * tstep : cB;
        for (int t = 0; t < nt; t += 2) {
            const bool last = (t == nt - 2);
            const char* a1 = cA + (size_t)(t + 1) * kstep;
            const char* a2 = last ? nA : cA + (size_t)(t + 2) * kstep; const char* b2 = last ? nB : cB + (size_t)(t + 2) * kstep;
            const char* a3 = a2 + kstep; const char* b3 = b2 + kstep;
            if (last && has_next) S.a_ready(nxt);
            PG8_LDB(B0, 0, 0); PG8_SCHED; PG8_LDA(At, 0, 0); PG8_STAGE(PG8_SA(1, 1), a1 + hstep, voffA);
            PG8_WAIT_L(8); PG8_BAR; PG8_WAIT_L(0); PG8_MMA(0, 0, At, B0); PG8_BAR; PG8_SCHED;
            PG8_LDB(B1, 0, 1); PG8_STAGE(PG8_SB(0, 0), b2, voffB);
            PG8_BAR; PG8_WAIT_L(0); PG8_MMA(0, 1, At, B1); PG8_BAR;
            PG8_LDA(At, 0, 1); PG8_STAGE(PG8_SA(0, 0), a2, voffA);
            PG8_BAR; PG8_WAIT_L(0); PG8_MMA(1, 0, At, B0); PG8_BAR; PG8_SCHED;
            PG8_STAGE(PG8_SB(0, 1), b2 + hstep, voffB);
            PG8_WAIT_V(6); PG8_BAR; PG8_MMA(1, 1, At, B1); PG8_BAR;
            PG8_LDB(B0, 1, 0); PG8_SCHED; PG8_LDA(At, 1, 0); PG8_STAGE(PG8_SA(0, 1), a2 + hstep, voffA);
            PG8_WAIT_L(8); PG8_BAR; PG8_WAIT_L(0); PG8_MMA(0, 0, At, B0); PG8_BAR; PG8_SCHED;
            PG8_LDB(B1, 1, 1); PG8_STAGE(PG8_SB(1, 0), b3, voffB);
            PG8_BAR; PG8_WAIT_L(0); PG8_MMA(0, 1, At, B1); PG8_BAR;
            PG8_LDA(At, 1, 1); PG8_STAGE(PG8_SA(1, 0), a3, voffA);
            PG8_BAR; PG8_WAIT_L(0); PG8_MMA(1, 0, At, B0); PG8_BAR; PG8_SCHED;
            PG8_STAGE(PG8_SB(1, 1), b3 + hstep, voffB);
            PG8_WAIT_V(6); PG8_BAR; PG8_MMA(1, 1, At, B1); PG8_BAR;
        }
        PG8_STAMP();
        if constexpr (!Epi::AFTER_DRAIN) { E(acc, cur, wr, wc, fr, fq); S.done(cur); }
        PG8_STAMP();
        if (!has_next) break;
#pragma unroll
        for (int a = 0; a < 2; ++a)
#pragma unroll
            for (int b = 0; b < 2; ++b)
#pragma unroll
                for (int m = 0; m < 4; ++m)
#pragma unroll
                    for (int n = 0; n < 2; ++n) acc[a][b][m][n] = (f32x4){0.f, 0.f, 0.f, 0.f};
        cur = nxt; cA = nA; cB = nB; ++ui;
    }
    PG8_WAIT_V(0);
    if (wr == 0) PG8_BAR;
    PG8_BAR;
    if constexpr (Epi::AFTER_DRAIN) { E.fused(acc, cur, wr, wc, fr, fq, lds, wid, lane); S.done(cur); }
    PG8_STAMP();
#undef PG8_STAMP
#undef PG8_SA
#undef PG8_SB
#undef PG8_STAGE
#undef PG8_LDA
#undef PG8_LDB
#undef PG8_MMA
#undef PG8_WAIT_V
#undef PG8_WAIT_L
#undef PG8_BAR
#undef PG8_SCHED
}
}

DEV void transpose_convert(const float* __restrict__ W, int K, int N, int Npad, bf16_t* Wt, float* sm) {
    float (*T)[65] = (float (*)[65])sm;
    const int tid = opaque_tid();
    const int kt = K / 64, ntl = Npad / 64;
    for (int tile = blockIdx.x; tile < kt * ntl; tile += gridDim.x) {
        const int k0 = (tile / ntl) * 64, n0 = (tile % ntl) * 64;
        __syncthreads();
#pragma unroll
        for (int i = 0; i < 2; ++i) {
            const int k = (tid >> 4) + 32 * i, n4 = (tid & 15) * 4;
            float4 v = make_float4(0.f, 0.f, 0.f, 0.f);
            if (n0 + n4 < N) v = ld4(W + (size_t)(k0 + k) * N + n0 + n4);
            T[k][n4] = v.x; T[k][n4 + 1] = v.y; T[k][n4 + 2] = v.z; T[k][n4 + 3] = v.w;
        }
        __syncthreads();
        const int n = tid >> 3, kq = (tid & 7) * 8;
        unsigned o[4];
#pragma unroll
        for (int j = 0; j < 4; ++j) o[j] = pack2bf(T[kq + 2 * j][n], T[kq + 2 * j + 1][n]);
        bf16_t* dst = Wt + (size_t)(n0 + n) * K + k0 + kq;
        *(uint4*)dst = make_uint4(o[0], o[1], o[2], o[3]);
    }
}

struct EpBf16 {
    static constexpr bool PERM = true, AFTER_DRAIN = false;
    bf16_t* O; int ldc; int ncols;
    DEV void operator()(const pg8::f32x4 (&acc)[2][2][4][2], const pg8::Unit& u, int wr, int wc, int fr, int fq) const {
        const int row0 = u.pm * 256 + wr * 64 + fr, col0 = u.pn * 256 + wc * 32 + 8 * fq;
#pragma unroll
        for (int ai = 0; ai < 2; ++ai)
#pragma unroll
            for (int m = 0; m < 4; ++m) {
                bf16_t* rowp = O + (size_t)(row0 + ai * 128 + m * 16) * ldc + col0;
#pragma unroll
                for (int bj = 0; bj < 2; ++bj) {
                    if (col0 + bj * 128 < ncols) {
                        const pg8::f32x4 v0 = acc[ai][bj][m][0], v1 = acc[ai][bj][m][1];
                        *(uint4*)(rowp + bj * 128) = make_uint4(pack2bf(v0[0], v0[1]), pack2bf(v0[2], v0[3]), pack2bf(v1[0], v1[1]), pack2bf(v1[2], v1[3]));
                    }
                }
            }
    }
};
struct EpRes0 {
    static constexpr bool PERM = false, AFTER_DRAIN = false;
    float* C; const float* lat; const float* cx; const float* mv; int b;
    DEV void operator()(const pg8::f32x4 (&acc)[2][2][4][2], const pg8::Unit& u, int wr, int wc, int fr, int fq) const {
        const bool isc = (u.pm * 256 < NCX);
        const float* base = isc ? cx + (size_t)b * NCX * DM : lat + ((size_t)b * NL - NCX) * DM;
        const float* gp = mv + (isc ? 2 : b) * 3072 + 2048;
        const int row0 = u.pm * 256 + wr * 64 + fr, col0 = u.pn * 256 + wc * 32 + 4 * fq;
#pragma unroll
        for (int ai = 0; ai < 2; ++ai)
#pragma unroll
            for (int m = 0; m < 4; ++m) {
                const size_t ro = (size_t)(row0 + ai * 128 + m * 16) * DM + col0;
#pragma unroll
                for (int bj = 0; bj < 2; ++bj)
#pragma unroll
                    for (int n = 0; n < 2; ++n) {
                        const int co = bj * 128 + n * 16;
                        const float4 x = ld4(base + ro + co), g = ld4(gp + col0 + co); const pg8::f32x4 v = acc[ai][bj][m][n];
                        st4(C + ro + co, make_float4(ALPHA * x.x + g.x * v[0], ALPHA * x.y + g.y * v[1], ALPHA * x.z + g.z * v[2], ALPHA * x.w + g.w * v[3]));
                    }
            }
    }
};
struct EpRes1 {
    static constexpr bool PERM = false, AFTER_DRAIN = false;
    float* C; const float* lat; const float* mv;
    DEV void operator()(const pg8::f32x4 (&acc)[2][2][4][2], const pg8::Unit& u, int wr, int wc, int fr, int fq) const {
        const float* gp = mv + (u.pm * 256 >= NL ? 1 : 0) * 3072 + 2048;
        const int row0 = u.pm * 256 + wr * 64 + fr, col0 = u.pn * 256 + wc * 32 + 4 * fq;
#pragma unroll
        for (int ai = 0; ai < 2; ++ai)
#pragma unroll
            for (int m = 0; m < 4; ++m) {
                const size_t ro = (size_t)(row0 + ai * 128 + m * 16) * DM + col0;
#pragma unroll
                for (int bj = 0; bj < 2; ++bj)
#pragma unroll
                    for (int n = 0; n < 2; ++n) {
                        const int co = bj * 128 + n * 16;
                        const float4 x = ld4(lat + ro + co), g = ld4(gp + col0 + co); const pg8::f32x4 v = acc[ai][bj][m][n];
                        st4(C + ro + co, make_float4(ALPHA * x.x + g.x * v[0], ALPHA * x.y + g.y * v[1], ALPHA * x.z + g.z * v[2], ALPHA * x.w + g.w * v[3]));
                    }
            }
    }
};
template <class EP>
DEV void run_gemm(const bf16_t* A, const bf16_t* Bt, int M, int N, int K, const EP& ep, float* sm) {
    pg8::Gemm g{A, Bt, M, N, K}; pg8::StaticOrder S; S.init(M, N, (int)gridDim.x, (int)blockIdx.x);
    pg8::gemm_phase<EP, pg8::StaticOrder, false>((PG8_LAS unsigned char*)sm, g, S, ep, nullptr);
}

DEV void phase_h0(const Params& p, int b) {
    const float* modv = (const float*)(p.ws + OFF_MODV);
    bf16_t* H0 = (bf16_t*)(p.ws + OFF_YC);
    const int gt = blockIdx.x * NTHR + opaque_tid(), gn = gridDim.x * NTHR;
    for (int i = gt; i < TB * 128; i += gn) {
        const int s = i >> 7, k = (i & 127) * 8;
        const float* src; int j;
        if (s < NCX) { src = p.in[2] + ((size_t)(b * NCX + s)) * DM + k; j = 2; }
        else { src = p.in[0] + ((size_t)(b * NL + s - NCX)) * DM + k; j = b; }
        const float4 x0 = ld4(src), x1 = ld4(src + 4);
        const float* m = modv + j * 3072;
        const float4 s0 = ld4(m + k), s1 = ld4(m + k + 4), c0 = ld4(m + 1024 + k), c1 = ld4(m + 1024 + k + 4);
        *(uint4*)(H0 + (size_t)s * DM + k) = make_uint4(pack2bf(x0.x * (1.f + c0.x) + s0.x, x0.y * (1.f + c0.y) + s0.y), pack2bf(x0.z * (1.f + c0.z) + s0.z, x0.w * (1.f + c0.w) + s0.w),
                                                      pack2bf(x1.x * (1.f + c1.x) + s1.x, x1.y * (1.f + c1.y) + s1.y), pack2bf(x1.z * (1.f + c1.z) + s1.z, x1.w * (1.f + c1.w) + s1.w));
    }
}

DEV void phase_mod(const Params& p, float* sm) {
    const float* c = p.in[1]; const float* cctx = p.in[3];
    const float* mod_w = p.in[4]; const float* mod_b = p.in[5];
    float* modv = (float*)(p.ws + OFF_MODV);
    float* sil = sm; float* red = sm + 3072;
    const int tid = opaque_tid();
    for (int i = tid; i < 3072; i += NTHR) {
        const int j = i >> 10, k = i & 1023;
        const float v = (j < 2) ? c[j * 1024 + k] : cctx[k];
        sil[i] = silu_f(v);
    }
    __syncthreads();
    for (int unit = blockIdx.x; unit < 192; unit += gridDim.x) {
        const int l = unit / 96, cb = unit % 96;
        const int kg = tid >> 5, col = tid & 31, n = cb * 32 + col;
        const float* w = mod_w + (size_t)l * 1024 * 3072 + n;
        float a0 = 0.f, a1 = 0.f, a2 = 0.f;
        for (int k = kg * 64; k < kg * 64 + 64; ++k) {
            const float wv = w[(size_t)k * 3072];
            a0 += sil[k] * wv; a1 += sil[1024 + k] * wv; a2 += sil[2048 + k] * wv;
        }
        red[(kg * 3 + 0) * 32 + col] = a0; red[(kg * 3 + 1) * 32 + col] = a1; red[(kg * 3 + 2) * 32 + col] = a2;
        __syncthreads();
        if (tid < 96) {
            const int j = tid >> 5, cc = tid & 31, nn = cb * 32 + cc;
            float s = mod_b[l * 3072 + nn];
            for (int g = 0; g < 16; ++g) s += red[(g * 3 + j) * 32 + cc];
            modv[(l * 3 + j) * 3072 + nn] = s;
        }
        __syncthreads();
    }
}

DEV void phase_tables(const Params& p) {
    const float* wq = p.in[33]; const float* wk = p.in[34]; const float* wv = p.in[35];
    const float* gw0 = p.in[36]; const float* gw1 = p.in[38]; const float* gw2 = p.in[40]; const float* gw3 = p.in[42];
    float* gtab = (float*)(p.ws + OFF_GTAB); bf16_t* wft = (bf16_t*)(p.ws + OFF_WFT);
    const int gt = blockIdx.x * NTHR + opaque_tid(), gn = gridDim.x * NTHR;
    for (int i = gt; i < 512 * 16; i += gn) {
        const int gb = i >> 4, cp = (i >> 2) & 3, c = i & 3;
        float s = 0.f;
#pragma unroll
        for (int d = 0; d < 4; ++d) s += wq[gb * 16 + cp * 4 + d] * wk[gb * 16 + c * 4 + d];
        gtab[i] = s * KSCALE;
    }
    for (int i = gt; i < 4096 * 16; i += gn) {
        const int g = i >> 12, k = i & 4095, gm = g >> 2, hd = g & 3;
        const float* wg = gm == 0 ? gw0 : (gm == 1 ? gw1 : (gm == 2 ? gw2 : gw3));
        float s = 0.f;
        if (k < 2048) {
            const int blk = k >> 2, cc = k & 3;
#pragma unroll
            for (int d = 0; d < 4; ++d) s += wq[blk * 16 + cc * 4 + d] * wg[(size_t)(4 * blk + d) * 4 + hd] + wk[blk * 16 + cc * 4 + d] * wg[(size_t)(2048 + 4 * blk + d) * 4 + hd];
        } else {
            const int kk = k - 2048, blk = kk >> 2, cc = kk & 3;
#pragma unroll
            for (int d = 0; d < 4; ++d) s += wv[blk * 16 + cc * 4 + d] * wg[(size_t)(4096 + 4 * blk + d) * 4 + hd];
        }
        wft[i] = __builtin_bit_cast(unsigned short, (__bf16)s);
    }
}

DEV float wave_scan_add(float v, int lane, int dir) {
#pragma unroll
    for (int o = 1; o < 64; o <<= 1) {
        const float n = dir ? __shfl_down(v, o, 64) : __shfl_up(v, o, 64);
        const bool ok = dir ? (lane + o < 64) : (lane >= o);
        if (ok) v += n;
    }
    return v;
}
DEV float wave_scan_max(float v, int lane, int dir) {
#pragma unroll
    for (int o = 1; o < 64; o <<= 1) {
        const float n = dir ? __shfl_down(v, o, 64) : __shfl_up(v, o, 64);
        const bool ok = dir ? (lane + o < 64) : (lane >= o);
        if (ok) v = fmaxf(v, n);
    }
    return v;
}

DEV void gla_decay(const bf16_t* P0, int c, int h, int dir, const float* __restrict__ wa2, const float* __restrict__ ba,
                   float* sLR, float* sWA, float* sBC, float* sTot, int tid) {
    for (int i = tid; i < 1024; i += NTHR) { const int t = i >> 4, j = i & 15; sLR[i] = bf2f(P0[(size_t)(c * 64 + t) * EIN + 1536 + dir * 16 + j]); }
    for (int i = tid; i < 1024; i += NTHR) { const int ii = i >> 6, k = i & 63; sWA[i] = wa2[ii * 256 + h * 64 + k]; }
    __syncthreads();
    {
        const int t = tid >> 3, k0 = (tid & 7) * 8;
        float acc[8];
#pragma unroll
        for (int j = 0; j < 8; ++j) acc[j] = ba[h * 64 + k0 + j];
#pragma unroll
        for (int ii = 0; ii < 16; ++ii) {
            const float l = sLR[t * 16 + ii];
#pragma unroll
            for (int j = 0; j < 8; ++j) acc[j] += l * sWA[ii * 64 + k0 + j];
        }
#pragma unroll
        for (int j = 0; j < 8; ++j) sBC[t * 65 + k0 + j] = logsig_f(acc[j]) * 0.0625f;
    }
    __syncthreads();
    {
        const int lane = tid & 63, wv = tid >> 6;
#pragma unroll
        for (int j = 0; j < 8; ++j) {
            const int k = wv * 8 + j;
            const float v = wave_scan_add(sBC[lane * 65 + k], lane, dir);
            sBC[lane * 65 + k] = v;
            if (lane == (dir ? 0 : 63)) sTot[k] = v;
        }
    }
    __syncthreads();
}
DEV bf16x8 tr_frag(const bf16_t* base, int ld, int row0, int col0, int lane) {
    const bf16_t* ptr = base + (row0 + (lane >> 4) * 8 + ((lane & 15) >> 2)) * ld + col0 + (lane & 3) * 4;
    const s16x4 lo = __builtin_amdgcn_ds_read_tr16_b64_v4i16((__attribute__((address_space(3))) s16x4*)ptr);
    const s16x4 hi = __builtin_amdgcn_ds_read_tr16_b64_v4i16((__attribute__((address_space(3))) s16x4*)(ptr + 4 * ld));
    return (bf16x8){lo[0], lo[1], lo[2], lo[3], hi[0], hi[1], hi[2], hi[3]};
}
DEV bf16x8 row_frag(const bf16_t* base, int ld, int idx0, int k0, int lane) {
    return *(const bf16x8*)(base + (idx0 + (lane & 15)) * ld + k0 + (lane >> 4) * 8);
}

DEV void gla1_unit(const Params& p, int h, int dir, int c, float* sm) {
    const int tid = opaque_tid(), lane = tid & 63, wave = tid >> 6;
    const bf16_t* P0 = (const bf16_t*)(p.ws + OFF_P0);
    float* GDS = (float*)(p.ws + OFF_GDS); float* GDEC = (float*)(p.ws + OFF_GDEC);
    const float* wa2 = p.in[dir ? 12 : 10]; const float* ba = p.in[dir ? 13 : 11];
    float* sLR = sm; float* sWA = sm + 1024; float* sBC = sm + 2048; float* sTot = sm + 6208;
    bf16_t* kT = (bf16_t*)(sm + 6272);
    bf16_t* Vs = (bf16_t*)(sm + 8576);
    const int ch = h * 2 + dir;
    __syncthreads();
    gla_decay(P0, c, h, dir, wa2, ba, sLR, sWA, sBC, sTot, tid);
    {
        const int t = tid >> 3, k0 = (tid & 7) * 8;
        float kv[8]; unpack8(*(const uint4*)(P0 + (size_t)(c * 64 + t) * EIN + 256 + h * 64 + k0), kv);
#pragma unroll
        for (int j = 0; j < 8; ++j) kT[(k0 + j) * 72 + t] = __builtin_bit_cast(unsigned short, (__bf16)(kv[j] * fexp(sTot[k0 + j] - sBC[t * 65 + k0 + j])));
#pragma unroll
        for (int u = 0; u < 2; ++u) { const int i = tid + 512 * u, row = i >> 4, c16 = i & 15; *(uint4*)(Vs + row * 136 + c16 * 8) = *(const uint4*)(P0 + (size_t)(c * 64 + row) * EIN + 512 + h * 128 + c16 * 8); }
    }
    __syncthreads();
    {
        f32x4 acc[4];
#pragma unroll
        for (int kt = 0; kt < 4; ++kt) acc[kt] = (f32x4){0.f, 0.f, 0.f, 0.f};
#pragma unroll
        for (int ks = 0; ks < 2; ++ks) {
            const bf16x8 af = tr_frag(Vs, 136, ks * 32, wave * 16, lane);
#pragma unroll
            for (int kt = 0; kt < 4; ++kt) acc[kt] = __builtin_amdgcn_mfma_f32_16x16x32_bf16(af, row_frag(kT, 72, kt * 16, ks * 32, lane), acc[kt], 0, 0, 0);
        }
#pragma unroll
        for (int kt = 0; kt < 4; ++kt) {
            const int k = kt * 16 + (lane & 15), v = wave * 16 + (lane >> 4) * 4;
            st4(GDS + ((size_t)(ch * NCH + c) * 64 + k) * 128 + v, make_float4(acc[kt][0], acc[kt][1], acc[kt][2], acc[kt][3]));
        }
    }
    if (tid < 64) GDEC[(size_t)(ch * NCH + c) * 64 + tid] = fexp(sTot[tid]);
}

DEV void gla2_unit(const Params& p, int unit) {
    const int tid = opaque_tid();
    float* GDS = (float*)(p.ws + OFF_GDS); const float* GDEC = (const float*)(p.ws + OFF_GDEC);
    const int ch = unit >> 4, e = (unit & 15) * 512 + tid, k = e >> 7, dir = ch & 1;
    constexpr int GB = 12;
    float S = 0.f, ninc[GB], nd[GB];
#pragma unroll
    for (int j = 0; j < GB; ++j) { const int c = chunk_at(dir, j); ninc[j] = GDS[(size_t)(ch * NCH + c) * 8192 + e]; nd[j] = GDEC[(size_t)(ch * NCH + c) * 64 + k]; }
#pragma unroll 1
    for (int step0 = 0; step0 < NCH; step0 += GB) {
        float inc[GB], d[GB];
#pragma unroll
        for (int j = 0; j < GB; ++j) { inc[j] = ninc[j]; d[j] = nd[j]; }
#pragma unroll
        for (int j = 0; j < GB; ++j) { const int sn = step0 + GB + j, c = chunk_at(dir, sn < NCH ? sn : NCH - 1); ninc[j] = GDS[(size_t)(ch * NCH + c) * 8192 + e]; nd[j] = GDEC[(size_t)(ch * NCH + c) * 64 + k]; }
        __builtin_amdgcn_sched_barrier(0);
#pragma unroll
        for (int j = 0; j < GB; ++j) { const int c = chunk_at(dir, step0 + j); GDS[(size_t)(ch * NCH + c) * 8192 + e] = S; S = d[j] * S + inc[j]; }
    }
}

DEV void gla3_unit(const Params& p, int h, int c, float* sm) {
    const int tid = opaque_tid(), lane = tid & 63, wave = tid >> 6;
    const bf16_t* P0 = (const bf16_t*)(p.ws + OFF_P0);
    const float* GDS = (const float*)(p.ws + OFF_GDS);
    bf16_t* YC = (bf16_t*)(p.ws + OFF_YC);
    const float* ng = p.in[14];
    float* sLR = sm; float* sWA = sm + 1024; float* sBC = sm + 2048; float* sTot = sm + 6208;
    bf16_t* qt = (bf16_t*)(sm + 6272);
    bf16_t* kt = (bf16_t*)(sm + 8576);
    bf16_t* Sm = (bf16_t*)(sm + 10880);
    bf16_t* S0s = (bf16_t*)(sm + 13184);
    bf16_t* Vs = (bf16_t*)(sm + 17536);
    float* O = sm + 21888;
    const int ti = wave & 3, vt0 = (wave >> 2) * 4;
    f32x4 acc[4];
#pragma unroll
    for (int j = 0; j < 4; ++j) acc[j] = (f32x4){0.f, 0.f, 0.f, 0.f};
    __syncthreads();
#pragma unroll
    for (int u = 0; u < 2; ++u) { const int i = tid + 512 * u, row = i >> 4, c16 = i & 15; *(uint4*)(Vs + row * 136 + c16 * 8) = *(const uint4*)(P0 + (size_t)(c * 64 + row) * EIN + 512 + h * 128 + c16 * 8); }
#pragma unroll 1
    for (int dir = 0; dir < 2; ++dir) {
        const float* wa2 = p.in[dir ? 12 : 10]; const float* ba = p.in[dir ? 13 : 11];
        const int ch = h * 2 + dir;
        __syncthreads();
        gla_decay(P0, c, h, dir, wa2, ba, sLR, sWA, sBC, sTot, tid);
        {
            const int t = tid >> 3, k0 = (tid & 7) * 8;
            float qv[8], kv[8];
            unpack8(*(const uint4*)(P0 + (size_t)(c * 64 + t) * EIN + h * 64 + k0), qv);
            unpack8(*(const uint4*)(P0 + (size_t)(c * 64 + t) * EIN + 256 + h * 64 + k0), kv);
#pragma unroll
            for (int j = 0; j < 8; ++j) { const float bc = sBC[t * 65 + k0 + j]; qv[j] *= 0.125f * fexp(bc); kv[j] *= fexp(-bc); }
            *(uint4*)(qt + t * 72 + k0) = make_uint4(pack2bf(qv[0], qv[1]), pack2bf(qv[2], qv[3]), pack2bf(qv[4], qv[5]), pack2bf(qv[6], qv[7]));
            *(uint4*)(kt + t * 72 + k0) = make_uint4(pack2bf(kv[0], kv[1]), pack2bf(kv[2], kv[3]), pack2bf(kv[4], kv[5]), pack2bf(kv[6], kv[7]));
#pragma unroll
            for (int u = 0; u < 4; ++u) {
                const int i = tid + 512 * u, k = i >> 5, v4 = (i & 31) * 4;
                const float4 s4 = ld4(GDS + (size_t)(ch * NCH + c) * 8192 + k * 128 + v4);
                *(uint2*)(S0s + k * 136 + v4) = make_uint2(pack2bf(s4.x, s4.y), pack2bf(s4.z, s4.w));
            }
        }
        __syncthreads();
        {
            const int si = wave & 3;
#pragma unroll
            for (int jj = 0; jj < 2; ++jj) {
                const int t2 = (wave >> 2) * 2 + jj;
                f32x4 a = (f32x4){0.f, 0.f, 0.f, 0.f};
#pragma unroll
                for (int ks = 0; ks < 2; ++ks) a = __builtin_amdgcn_mfma_f32_16x16x32_bf16(row_frag(kt, 72, si * 16, ks * 32, lane), row_frag(qt, 72, t2 * 16, ks * 32, lane), a, 0, 0, 0);
                const int t = t2 * 16 + (lane & 15), s0 = si * 16 + (lane >> 4) * 4;
                float m[4];
#pragma unroll
                for (int r = 0; r < 4; ++r) { const bool keep = dir ? (s0 + r >= t) : (s0 + r <= t); m[r] = keep ? a[r] : 0.f; }
                *(uint2*)(Sm + t * 72 + s0) = make_uint2(pack2bf(m[0], m[1]), pack2bf(m[2], m[3]));
            }
        }
        __syncthreads();
#pragma unroll
        for (int ks = 0; ks < 2; ++ks) {
            const bf16x8 a1 = row_frag(qt, 72, ti * 16, ks * 32, lane), a2 = row_frag(Sm, 72, ti * 16, ks * 32, lane);
#pragma unroll
            for (int j = 0; j < 4; ++j) {
                acc[j] = __builtin_amdgcn_mfma_f32_16x16x32_bf16(a1, tr_frag(S0s, 136, ks * 32, (vt0 + j) * 16, lane), acc[j], 0, 0, 0);
                acc[j] = __builtin_amdgcn_mfma_f32_16x16x32_bf16(a2, tr_frag(Vs, 136, ks * 32, (vt0 + j) * 16, lane), acc[j], 0, 0, 0);
            }
        }
    }
#pragma unroll
    for (int j = 0; j < 4; ++j)
#pragma unroll
        for (int r = 0; r < 4; ++r) O[(ti * 16 + (lane >> 4) * 4 + r) * 132 + (vt0 + j) * 16 + (lane & 15)] = acc[j][r];
    __syncthreads();
    {
        const int t = tid >> 3, v0 = (tid & 7) * 16;
        float o[16];
        float ss = 0.f;
#pragma unroll
        for (int i = 0; i < 16; ++i) { o[i] = O[t * 132 + v0 + i]; ss += o[i] * o[i]; }
        ss += __shfl_xor(ss, 1, 64); ss += __shfl_xor(ss, 2, 64); ss += __shfl_xor(ss, 4, 64);
        const float rms = rsqrtf(ss * (1.f / 128.f) + 1e-5f);
        float g[16];
        const bf16_t* gp = P0 + (size_t)(c * 64 + t) * EIN + 1024 + h * 128 + v0;
        unpack8(*(const uint4*)gp, g); unpack8(*(const uint4*)(gp + 8), g + 8);
        float y[16];
#pragma unroll
        for (int i = 0; i < 16; ++i) y[i] = o[i] * rms * ng[v0 + i] * silu_f(g[i]);
        bf16_t* yp = YC + (size_t)(c * 64 + t) * 1024 + h * 128 + v0;
        *(uint4*)yp = make_uint4(pack2bf(y[0], y[1]), pack2bf(y[2], y[3]), pack2bf(y[4], y[5]), pack2bf(y[6], y[7]));
        *(uint4*)(yp + 8) = make_uint4(pack2bf(y[8], y[9]), pack2bf(y[10], y[11]), pack2bf(y[12], y[13]), pack2bf(y[14], y[15]));
    }
}

DEV void load8bf(const bf16_t* ptr, float* f) { unpack8(*(const uint4*)ptr, f); }
DEV void rw_mix8(const bf16_t* P0, int s, int cb, const float* __restrict__ mu, float* out) {
    float own[8]; load8bf(P0 + (size_t)s * EIN + RW0 + cb, own);
    int nL = -1, nR = -1, nU = -1, nD = -1;
    if (s < NCX) { if (s > 0) nL = s - 1; if (s < NCX - 1) nR = s + 1; }
    else { const int n = s - NCX, rr = n >> 6, cc = n & 63; if (cc > 0) nL = s - 1; if (cc < 63) nR = s + 1; if (rr > 0) nU = s - 64; if (rr < 127) nD = s + 64; }
    float fL[8], fR[8], fU[8], fD[8];
#pragma unroll
    for (int i = 0; i < 8; ++i) { fL[i] = 0.f; fR[i] = 0.f; fU[i] = 0.f; fD[i] = 0.f; }
    if (nL >= 0) load8bf(P0 + (size_t)nL * EIN + RW0 + cb, fL);
    if (nR >= 0) load8bf(P0 + (size_t)nR * EIN + RW0 + cb, fR);
    if (nU >= 0) load8bf(P0 + (size_t)nU * EIN + RW0 + cb, fU);
    if (nD >= 0) load8bf(P0 + (size_t)nD * EIN + RW0 + cb, fD);
    const float4 m0 = ld4(mu + cb), m1 = ld4(mu + cb + 4);
    const float m[8] = {m0.x, m0.y, m0.z, m0.w, m1.x, m1.y, m1.z, m1.w};
#pragma unroll
    for (int i = 0; i < 8; ++i) { const float nb = (i & 3) == 0 ? fL[i] : ((i & 3) == 1 ? fR[i] : ((i & 3) == 2 ? fU[i] : fD[i])); out[i] = own[i] + (nb - own[i]) * m[i]; }
}
DEV uint4 pack8(const float* f) { return make_uint4(pack2bf(f[0], f[1]), pack2bf(f[2], f[3]), pack2bf(f[4], f[5]), pack2bf(f[6], f[7])); }

template <int XM, int YM, class F>
DEV void mm64(const bf16_t* X, const bf16_t* Y, F f, int lane, int wave) {
#pragma unroll
    for (int q = 0; q < 2; ++q) {
        const int idx = wave * 2 + q, ti = idx >> 2, tj = idx & 3;
        f32x4 acc = (f32x4){0.f, 0.f, 0.f, 0.f};
#pragma unroll
        for (int ks = 0; ks < 2; ++ks) {
            const bf16x8 a = XM == 0 ? row_frag(X, 72, ti * 16, ks * 32, lane) : tr_frag(X, 72, ks * 32, ti * 16, lane);
            const bf16x8 bq = YM == 0 ? row_frag(Y, 72, tj * 16, ks * 32, lane) : tr_frag(Y, 72, ks * 32, tj * 16, lane);
            acc = __builtin_amdgcn_mfma_f32_16x16x32_bf16(a, bq, acc, 0, 0, 0);
        }
        f(ti * 16 + (lane >> 4) * 4, tj * 16 + (lane & 15), acc);
    }
}
template <int XM, int YM, class F>
DEV void mm64x2(const bf16_t* X1, const bf16_t* Y1, const bf16_t* X2, const bf16_t* Y2, F f, int lane, int wave) {
#pragma unroll
    for (int q = 0; q < 2; ++q) {
        const int idx = wave * 2 + q, ti = idx >> 2, tj = idx & 3;
        f32x4 acc = (f32x4){0.f, 0.f, 0.f, 0.f};
#pragma unroll
        for (int ks = 0; ks < 2; ++ks) {
            const bf16x8 a = XM == 0 ? row_frag(X1, 72, ti * 16, ks * 32, lane) : tr_frag(X1, 72, ks * 32, ti * 16, lane);
            const bf16x8 bq = YM == 0 ? row_frag(Y1, 72, tj * 16, ks * 32, lane) : tr_frag(Y1, 72, ks * 32, tj * 16, lane);
            acc = __builtin_amdgcn_mfma_f32_16x16x32_bf16(a, bq, acc, 0, 0, 0);
            const bf16x8 a2 = XM == 0 ? row_frag(X2, 72, ti * 16, ks * 32, lane) : tr_frag(X2, 72, ks * 32, ti * 16, lane);
            const bf16x8 b2 = YM == 0 ? row_frag(Y2, 72, tj * 16, ks * 32, lane) : tr_frag(Y2, 72, ks * 32, tj * 16, lane);
            acc = __builtin_amdgcn_mfma_f32_16x16x32_bf16(a2, b2, acc, 0, 0, 0);
        }
        f(ti * 16 + (lane >> 4) * 4, tj * 16 + (lane & 15), acc);
    }
}
DEV void st_img(bf16_t* P, int i0, int j, float a0, float a1, float a2, float a3) {
    P[(i0 + 0) * 72 + j] = __builtin_bit_cast(unsigned short, (__bf16)a0); P[(i0 + 1) * 72 + j] = __builtin_bit_cast(unsigned short, (__bf16)a1);
    P[(i0 + 2) * 72 + j] = __builtin_bit_cast(unsigned short, (__bf16)a2); P[(i0 + 3) * 72 + j] = __builtin_bit_cast(unsigned short, (__bf16)a3);
}

DEV void rwkv1_unit(const Params& p, int h, int dir, int c, float* sm) {
    const int tid = opaque_tid(), lane = tid & 63, wave = tid >> 6;
    const bf16_t* P0 = (const bf16_t*)(p.ws + OFF_P0);
    bf16_t* RU = (bf16_t*)(p.ws + OFF_RU) + (size_t)((h * 2 + dir) * NCH + c) * 16384;
    float* BONS = (float*)(p.ws + OFF_BONS);
    const float* mu = p.in[15];
    const float* w0 = p.in[dir ? 18 : 16]; const float* ww2 = p.in[dir ? 19 : 17];
    const float* a0 = p.in[dir ? 22 : 20]; const float* wa2 = p.in[dir ? 23 : 21];
    bf16_t* img = (bf16_t*)sm;
#define SLOT(i_) (img + (i_) * 4608)
    float* fLW = (float*)SLOT(10);
    float* fAS = (float*)SLOT(12);
    float* sv = (float*)SLOT(14);
    const int t = tid >> 3, j0 = (tid & 7) * 8, s = c * 64 + t;
    __syncthreads();
    if (tid < 64) { const int hc = h * 64 + tid; sv[64 + tid] = w0[hc]; sv[128 + tid] = a0[hc]; sv[192 + tid] = p.in[24][hc]; sv[256 + tid] = p.in[25][hc]; sv[320 + tid] = p.in[26][hc]; }
    float r8[8], k8[8], v8[8];
    {
        float x8[8];
        rw_mix8(P0, s, h * 64 + j0, mu, r8);
        rw_mix8(P0, s, 512 + h * 64 + j0, mu, k8);
        rw_mix8(P0, s, 1024 + h * 64 + j0, mu, v8);
        rw_mix8(P0, s, 2048 + dir * 64 + j0, mu, x8);
#pragma unroll
        for (int i = 0; i < 8; ++i) x8[i] = tanh_f(x8[i]);
        *(uint4*)(SLOT(6) + t * 72 + j0) = pack8(x8);
        rw_mix8(P0, s, 2176 + dir * 64 + j0, mu, x8);
        *(uint4*)(SLOT(7) + t * 72 + j0) = pack8(x8);
        float wq[8];
        { const float4 q0 = ld4(ww2 + (size_t)t * 512 + h * 64 + j0), q1 = ld4(ww2 + (size_t)t * 512 + h * 64 + j0 + 4); wq[0] = q0.x; wq[1] = q0.y; wq[2] = q0.z; wq[3] = q0.w; wq[4] = q1.x; wq[5] = q1.y; wq[6] = q1.z; wq[7] = q1.w; }
        *(uint4*)(SLOT(8) + t * 72 + j0) = pack8(wq);
        { const float4 q0 = ld4(wa2 + (size_t)t * 512 + h * 64 + j0), q1 = ld4(wa2 + (size_t)t * 512 + h * 64 + j0 + 4); wq[0] = q0.x; wq[1] = q0.y; wq[2] = q0.z; wq[3] = q0.w; wq[4] = q1.x; wq[5] = q1.y; wq[6] = q1.z; wq[7] = q1.w; }
        *(uint4*)(SLOT(9) + t * 72 + j0) = pack8(wq);
    }
    __syncthreads();
    mm64<0, 1>(SLOT(6), SLOT(8), [=](int i0, int j, f32x4 a) {
#pragma unroll
        for (int r = 0; r < 4; ++r) fLW[(i0 + r) * 65 + j] = -0.6065306597f * sigmoid_f(sv[64 + j] + a[r]); }, lane, wave);
    mm64<0, 1>(SLOT(7), SLOT(9), [=](int i0, int j, f32x4 a) {
#pragma unroll
        for (int r = 0; r < 4; ++r) fAS[(i0 + r) * 65 + j] = sigmoid_f(sv[128 + j] + a[r]); }, lane, wave);
    __syncthreads();
#pragma unroll
    for (int j = 0; j < 8; ++j) {
        const int k = wave * 8 + j;
        const float v = wave_scan_add(fLW[lane * 65 + k], lane, dir);
        fLW[lane * 65 + k] = v;
        if (lane == (dir ? 0 : 63)) sv[k] = v;
    }
    __syncthreads();
    {
        float kkv[8], ss = 0.f;
#pragma unroll
        for (int i = 0; i < 8; ++i) { kkv[i] = k8[i] * sv[192 + j0 + i]; ss += kkv[i] * kkv[i]; }
        ss += __shfl_xor(ss, 1, 64); ss += __shfl_xor(ss, 2, 64); ss += __shfl_xor(ss, 4, 64);
        const float rn = rsqrtf(fmaxf(ss, 1e-24f));
        float fa[8], fb[8], fk[8], fr[8], fbp[8], fkp[8], bon = 0.f;
        const int tp = dir ? t + 1 : t - 1;
        const bool hasp = dir ? (t < 63) : (t > 0);
#pragma unroll
        for (int i = 0; i < 8; ++i) {
            const int k = j0 + i;
            const float Bt = fLW[t * 65 + k], Bx = hasp ? fLW[tp * 65 + k] : 0.f, asg = fAS[t * 65 + k];
            const float kk = kkv[i] * rn, kh = k8[i] * (1.f + (asg - 1.f) * sv[256 + k]);
            bon += r8[i] * kh * sv[320 + k];
            const float enB = fexp(-Bt), eLB = fexp(sv[k] - Bt), bv = kk * asg;
            fa[i] = -kk * fexp(Bx); fb[i] = bv * enB; fk[i] = kh * enB; fr[i] = r8[i] * fexp(Bt); fbp[i] = bv * eLB; fkp[i] = kh * eLB;
        }
        bon += __shfl_xor(bon, 1, 64); bon += __shfl_xor(bon, 2, 64); bon += __shfl_xor(bon, 4, 64);
        if ((tid & 7) == 0) BONS[((size_t)dir * TB + s) * 8 + h] = bon;
        *(uint4*)(SLOT(0) + t * 72 + j0) = pack8(fa); *(uint4*)(SLOT(1) + t * 72 + j0) = pack8(fb); *(uint4*)(SLOT(2) + t * 72 + j0) = pack8(fk);
        *(uint4*)(SLOT(3) + t * 72 + j0) = pack8(fr); *(uint4*)(SLOT(4) + t * 72 + j0) = pack8(fbp); *(uint4*)(SLOT(5) + t * 72 + j0) = pack8(fkp);
    }
    __syncthreads();
    *(uint4*)(SLOT(6) + t * 72 + j0) = pack8(v8);
    __syncthreads();
    mm64<0, 0>(SLOT(0), SLOT(1), [=](int i0, int j, f32x4 a) {
        float m[4];
#pragma unroll
        for (int r = 0; r < 4; ++r) { const bool keep = dir ? (j > i0 + r) : (j < i0 + r); m[r] = keep ? a[r] : 0.f; }
        const bool dg = (i0 >> 4) == (j >> 4);
        st_img(SLOT(7), i0, j, dg ? m[0] : 0.f, dg ? m[1] : 0.f, dg ? m[2] : 0.f, dg ? m[3] : 0.f);
        st_img(SLOT(8), i0, j, (dg ? m[0] : 0.f) + (j == i0 ? 1.f : 0.f), (dg ? m[1] : 0.f) + (j == i0 + 1 ? 1.f : 0.f), (dg ? m[2] : 0.f) + (j == i0 + 2 ? 1.f : 0.f), (dg ? m[3] : 0.f) + (j == i0 + 3 ? 1.f : 0.f));
        st_img(SLOT(12), i0, j, dg ? 0.f : m[0], dg ? 0.f : m[1], dg ? 0.f : m[2], dg ? 0.f : m[3]); }, lane, wave);
    mm64<0, 0>(SLOT(0), SLOT(2), [=](int i0, int j, f32x4 a) {
        float m[4];
#pragma unroll
        for (int r = 0; r < 4; ++r) { const bool keep = dir ? (j > i0 + r) : (j < i0 + r); m[r] = keep ? a[r] : 0.f; }
        st_img(SLOT(9), i0, j, m[0], m[1], m[2], m[3]); }, lane, wave);
    mm64<0, 0>(SLOT(3), SLOT(1), [=](int i0, int j, f32x4 a) {
        float m[4];
#pragma unroll
        for (int r = 0; r < 4; ++r) { const bool keep = dir ? (j >= i0 + r) : (j <= i0 + r); m[r] = keep ? a[r] : 0.f; }
        st_img(SLOT(10), i0, j, m[0], m[1], m[2], m[3]); }, lane, wave);
    mm64<0, 0>(SLOT(3), SLOT(2), [=](int i0, int j, f32x4 a) {
        float m[4];
#pragma unroll
        for (int r = 0; r < 4; ++r) { const bool keep = dir ? (j >= i0 + r) : (j <= i0 + r); m[r] = keep ? a[r] : 0.f; }
        st_img(SLOT(11), i0, j, m[0], m[1], m[2], m[3]); }, lane, wave);
    __syncthreads();
    {
        bf16_t* Pc = SLOT(7); bf16_t* Pn = SLOT(1); bf16_t* Tc = SLOT(8); bf16_t* Tn = SLOT(2);
#pragma unroll 1
        for (int it = 0; it < 3; ++it) {
            mm64<0, 1>(Pc, Pc, [=](int i0, int j, f32x4 a) { st_img(Pn, i0, j, a[0], a[1], a[2], a[3]); }, lane, wave);
            __syncthreads();
            mm64<0, 1>(Tc, Pn, [=](int i0, int j, f32x4 a) {
                st_img(Tn, i0, j, a[0] + bf2f(Tc[(i0 + 0) * 72 + j]), a[1] + bf2f(Tc[(i0 + 1) * 72 + j]), a[2] + bf2f(Tc[(i0 + 2) * 72 + j]), a[3] + bf2f(Tc[(i0 + 3) * 72 + j])); }, lane, wave);
            __syncthreads();
            bf16_t* tmp = Pc; Pc = Pn; Pn = tmp; tmp = Tc; Tc = Tn; Tn = tmp;
        }
    }
    mm64<0, 1>(SLOT(2), SLOT(12), [=](int i0, int j, f32x4 a) { st_img(SLOT(7), i0, j, a[0], a[1], a[2], a[3]); }, lane, wave);
    mm64<0, 1>(SLOT(2), SLOT(0), [=](int i0, int j, f32x4 a) { st_img(SLOT(1), i0, j, a[0], a[1], a[2], a[3]); }, lane, wave);
    mm64<0, 1>(SLOT(9), SLOT(6), [=](int i0, int j, f32x4 a) { st_img(SLOT(13), i0, j, a[0], a[1], a[2], a[3]); }, lane, wave);
    __syncthreads();
    mm64<0, 1>(SLOT(2), SLOT(13), [=](int i0, int j, f32x4 a) { st_img(SLOT(8), i0, j, a[0], a[1], a[2], a[3]); }, lane, wave);
    __syncthreads();
    {
        const bf16_t* Zp = (wave < 4) ? SLOT(1) : SLOT(8);
        bf16_t* Xi = (wave < 4) ? SLOT(12) : SLOT(9);
        const int ct = (wave & 3) * 16, g4 = (lane >> 4) * 4, l15 = lane & 15;
#pragma unroll
        for (int bs = 0; bs < 4; ++bs) {
            const int bi = dir ? 3 - bs : bs;
            f32x4 acc;
#pragma unroll
            for (int r = 0; r < 4; ++r) acc[r] = bf2f(Zp[(bi * 16 + g4 + r) * 72 + ct + l15]);
            const bool k0 = dir ? (bi == 0) : (bi >= 1), k1 = dir ? (bi <= 2) : (bi == 3);
            if (k0) acc = __builtin_amdgcn_mfma_f32_16x16x32_bf16(row_frag(SLOT(7), 72, bi * 16, 0, lane), tr_frag(Xi, 72, 0, ct, lane), acc, 0, 0, 0);
            if (k1) acc = __builtin_amdgcn_mfma_f32_16x16x32_bf16(row_frag(SLOT(7), 72, bi * 16, 32, lane), tr_frag(Xi, 72, 32, ct, lane), acc, 0, 0, 0);
            st_img(Xi, bi * 16 + g4, ct + l15, acc[0], acc[1], acc[2], acc[3]);
            __syncthreads();
        }
    }
    mm64<1, 1>(SLOT(12), SLOT(4), [=](int i0, int j, f32x4 a) {
        float m[4];
#pragma unroll
        for (int r = 0; r < 4; ++r) m[r] = a[r] + ((i0 + r) == j ? fexp(sv[j]) : 0.f);
        *(uint2*)(RU + j * 64 + i0) = make_uint2(pack2bf(m[0], m[1]), pack2bf(m[2], m[3])); }, lane, wave);
    mm64x2<1, 1>(SLOT(4), SLOT(9), SLOT(5), SLOT(6), [=](int i0, int j, f32x4 a) {
        *(uint2*)(RU + 4096 + j * 64 + i0) = make_uint2(pack2bf(a[0], a[1]), pack2bf(a[2], a[3])); }, lane, wave);
    mm64<1, 0>(SLOT(12), SLOT(10), [=](int i0, int j, f32x4 a) {
        const uint2 rr = *(const uint2*)(SLOT(3) + j * 72 + i0);
        *(uint2*)(RU + 8192 + j * 64 + i0) = make_uint2(pack2bf(a[0] + bflo(rr.x), a[1] + bfhi(rr.x)), pack2bf(a[2] + bflo(rr.y), a[3] + bfhi(rr.y))); }, lane, wave);
    mm64x2<0, 1>(SLOT(10), SLOT(9), SLOT(11), SLOT(6), [=](int i0, int j, f32x4 a) {
        *(uint2*)(RU + 12288 + j * 64 + i0) = make_uint2(pack2bf(a[0], a[1]), pack2bf(a[2], a[3])); }, lane, wave);
#undef SLOT
}

#define R2_LOAD(M_, C_, rnd_) do { const int r0_ = ((rnd_) < R2_NR ? (rnd_) : R2_NR - 1) * R2_RS; \
    _Pragma("unroll") for (int s_ = 0; s_ < R2_RS; ++s_) M_[s_] = *(const uint4*)(RU + (size_t)(chain * NCH + chunk_at(dir, r0_ + s_)) * 16384 + tid * 8); \
    _Pragma("unroll") for (int j_ = 0; j_ < 3; ++j_) { const int cq_ = tid + 512 * j_; \
        C_[j_] = *(const uint4*)(RU + (size_t)(chain * NCH + chunk_at(dir, r0_ + (cq_ >> 7))) * 16384 + 4096 + (vblk * 16 + ((cq_ >> 3) & 15)) * 64 + (cq_ & 7) * 8); } } while (0)
#define R2_ROUND(M_, C_, rnd_) do { \
    { const int row_ = tid >> 3, c8_ = tid & 7, sw_ = (row_ >> 1) & 7, u0_ = (c8_ >> 2) * 4 + (c8_ & 1) * 2, eh_ = ((c8_ >> 1) & 1) * 8; \
      _Pragma("unroll") for (int s_ = 0; s_ < R2_RS; ++s_) { char* sl_ = ring + s_ * 10240 + row_ * 128 + eh_; \
          *(uint2*)(sl_ + ((u0_ ^ sw_) * 16)) = make_uint2(M_[s_].x, M_[s_].y); *(uint2*)(sl_ + (((u0_ + 1) ^ sw_) * 16)) = make_uint2(M_[s_].z, M_[s_].w); } \
      _Pragma("unroll") for (int j_ = 0; j_ < 3; ++j_) { const int cq_ = tid + 512 * j_, rw_ = (cq_ >> 3) & 15, q8_ = cq_ & 7, i_ = q8_ >> 1, g0_ = (q8_ & 1) * 2, sc_ = (rw_ >> 1) & 7; \
          char* sl_ = ring + (cq_ >> 7) * 10240 + 8192 + rw_ * 128 + (i_ & 1) * 8; \
          *(uint2*)(sl_ + (((g0_ * 2 + (i_ >> 1)) ^ sc_) * 16)) = make_uint2(C_[j_].x, C_[j_].y); *(uint2*)(sl_ + ((((g0_ + 1) * 2 + (i_ >> 1)) ^ sc_) * 16)) = make_uint2(C_[j_].z, C_[j_].w); } } \
    R2_LOAD(M_, C_, (rnd_) + 2); \
    __syncthreads(); \
    if (wave == 0) { \
        _Pragma("unroll 4") for (int s_ = 0; s_ < R2_RS; ++s_) { \
            const int c_ = chunk_at(dir, (rnd_) * R2_RS + s_); const char* sl_ = ring + s_ * 10240; \
            unsigned pk_[4][2]; \
            _Pragma("unroll") for (int i_ = 0; i_ < 4; ++i_) { pk_[i_][0] = pack2bf(st[i_][0], st[i_][1]); pk_[i_][1] = pack2bf(st[i_][2], st[i_][3]); } \
            bf16_t* sp_ = S0G + ((size_t)(chain * NCH + c_) * 64 + vblk * 16 + l15) * 64 + g * 4; \
            _Pragma("unroll") for (int i_ = 0; i_ < 4; ++i_) *(uint2*)(sp_ + i_ * 16) = make_uint2(pk_[i_][0], pk_[i_][1]); \
            bf16x8 bfr_[2]; \
            _Pragma("unroll") for (int ks_ = 0; ks_ < 2; ++ks_) { const uint4 u_ = make_uint4(pk_[2 * ks_][0], pk_[2 * ks_][1], pk_[2 * ks_ + 1][0], pk_[2 * ks_ + 1][1]); bfr_[ks_] = __builtin_bit_cast(bf16x8, u_); } \
            const uint4 c01_ = *(const uint4*)(sl_ + 8192 + l15 * 128 + (((g * 2) ^ ((l15 >> 1) & 7)) * 16)), c23_ = *(const uint4*)(sl_ + 8192 + l15 * 128 + (((g * 2 + 1) ^ ((l15 >> 1) & 7)) * 16)); \
            const unsigned cw_[8] = {c01_.x, c01_.y, c01_.z, c01_.w, c23_.x, c23_.y, c23_.z, c23_.w}; \
            _Pragma("unroll") for (int i_ = 0; i_ < 4; ++i_) { \
                f32x4 acc_ = (f32x4){bflo(cw_[2 * i_]), bfhi(cw_[2 * i_]), bflo(cw_[2 * i_ + 1]), bfhi(cw_[2 * i_ + 1])}; \
                _Pragma("unroll") for (int ks_ = 0; ks_ < 2; ++ks_) { \
                    const int row_ = i_ * 16 + l15; \
                    const bf16x8 af_ = *(const bf16x8*)(sl_ + row_ * 128 + (((ks_ * 4 + g) ^ ((row_ >> 1) & 7)) * 16)); \
                    acc_ = __builtin_amdgcn_mfma_f32_16x16x32_bf16(af_, bfr_[ks_], acc_, 0, 0, 0); } \
                st[i_] = acc_; } } } \
    __syncthreads(); } while (0)
DEV void rwkv2_unit(const Params& p, int chain, int vblk, float* sm) {
    constexpr int R2_RS = 12, R2_NR = NCH / R2_RS;
    static_assert(R2_NR * R2_RS == NCH && R2_RS * 10240 <= LDS_BYTES, "R2 ring");
    const int tid = opaque_tid(), lane = tid & 63, wave = tid >> 6;
    const bf16_t* RU = (const bf16_t*)(p.ws + OFF_RU);
    bf16_t* S0G = (bf16_t*)(p.ws + OFF_RS0);
    char* ring = (char*)sm;
    const int dir = chain & 1, g = lane >> 4, l15 = lane & 15;
    f32x4 st[4];
#pragma unroll
    for (int i = 0; i < 4; ++i) st[i] = (f32x4){0.f, 0.f, 0.f, 0.f};
    uint4 ma[R2_RS], ca[3], mb[R2_RS], cb[3];
    __syncthreads();
    R2_LOAD(ma, ca, 0); R2_LOAD(mb, cb, 1);
#pragma unroll 1
    for (int rnd = 0; rnd < R2_NR; rnd += 2) {
        R2_ROUND(ma, ca, rnd);
        if (rnd + 1 < R2_NR) R2_ROUND(mb, cb, rnd + 1);
    }
}
#undef R2_LOAD
#undef R2_ROUND

DEV void rwkv3_unit(const Params& p, int h, int c, float* sm) {
    const int tid = opaque_tid(), lane = tid & 63, wave = tid >> 6;
    const bf16_t* P0 = (const bf16_t*)(p.ws + OFF_P0);
    const bf16_t* RUb = (const bf16_t*)(p.ws + OFF_RU);
    const bf16_t* S0G = (const bf16_t*)(p.ws + OFF_RS0);
    const float* BONS = (const float*)(p.ws + OFF_BONS);
    bf16_t* YC = (bf16_t*)(p.ws + OFF_YC);
    const float* mu = p.in[15]; const float* gn_g = p.in[27]; const float* gn_b = p.in[28];
    bf16_t* img = (bf16_t*)sm;
    float* O = sm + 4 * 2304;
    __syncthreads();
    {
        const int row = tid >> 3, c8 = (tid & 7) * 8;
#pragma unroll
        for (int dir = 0; dir < 2; ++dir) {
            const size_t u = (size_t)((h * 2 + dir) * NCH + c);
            *(uint4*)(img + dir * 4608 + row * 72 + c8) = *(const uint4*)(RUb + u * 16384 + 8192 + row * 64 + c8);
            *(uint4*)(img + (2 + dir) * 4608 + row * 72 + c8) = *(const uint4*)(S0G + u * 4096 + row * 64 + c8);
        }
    }
    __syncthreads();
#pragma unroll
    for (int q = 0; q < 2; ++q) {
        const int idx = wave * 2 + q, ti = idx >> 2, tj = idx & 3;
        f32x4 accd[2];
#pragma unroll
        for (int dir = 0; dir < 2; ++dir) {
            f32x4 acc = (f32x4){0.f, 0.f, 0.f, 0.f};
#pragma unroll
            for (int ks = 0; ks < 2; ++ks) acc = __builtin_amdgcn_mfma_f32_16x16x32_bf16(row_frag(img + dir * 4608, 72, ti * 16, ks * 32, lane), row_frag(img + (2 + dir) * 4608, 72, tj * 16, ks * 32, lane), acc, 0, 0, 0);
            const uint2 yl = *(const uint2*)(RUb + (size_t)((h * 2 + dir) * NCH + c) * 16384 + 12288 + (tj * 16 + (lane & 15)) * 64 + ti * 16 + (lane >> 4) * 4);
            acc[0] += bflo(yl.x); acc[1] += bfhi(yl.x); acc[2] += bflo(yl.y); acc[3] += bfhi(yl.y);
            accd[dir] = acc;
        }
#pragma unroll
        for (int r = 0; r < 4; ++r) {
            const int oi = (ti * 16 + (lane >> 4) * 4 + r) * 68 + tj * 16 + (lane & 15);
            O[oi] = accd[0][r] + accd[1][r];
        }
    }
    __syncthreads();
    {
        const int t = tid >> 3, v0 = (tid & 7) * 8, s = c * 64 + t;
        float y[8], sum = 0.f;
#pragma unroll
        for (int i = 0; i < 8; ++i) { y[i] = O[t * 68 + v0 + i]; sum += y[i]; }
        sum += __shfl_xor(sum, 1, 64); sum += __shfl_xor(sum, 2, 64); sum += __shfl_xor(sum, 4, 64);
        const float mean = sum * (1.f / 64.f);
        float sq = 0.f;
#pragma unroll
        for (int i = 0; i < 8; ++i) { y[i] -= mean; sq += y[i] * y[i]; }
        sq += __shfl_xor(sq, 1, 64); sq += __shfl_xor(sq, 2, 64); sq += __shfl_xor(sq, 4, 64);
        const float rstd = rsqrtf(sq * (1.f / 64.f) + 64e-5f);
        float vm[8], gm[8];
        rw_mix8(P0, s, 1024 + h * 64 + v0, mu, vm);
        rw_mix8(P0, s, 1536 + h * 64 + v0, mu, gm);
        const float bon = BONS[(size_t)s * 8 + h] + BONS[((size_t)TB + s) * 8 + h];
        float o[8];
#pragma unroll
        for (int i = 0; i < 8; ++i) o[i] = (y[i] * rstd * gn_g[h * 64 + v0 + i] + gn_b[h * 64 + v0 + i] + bon * vm[i]) * silu_f(gm[i]);
        *(uint4*)(YC + (size_t)s * 1024 + 512 + h * 64 + v0) = pack8(o);
    }
}

DEV void ln_rows(const float* src, int nrows, const float* __restrict__ g, const float* __restrict__ bt, float* dst_lat, float* dst_cx, int ncx,
                 bf16_t* hb = nullptr, const float* mvc = nullptr, const float* mvl = nullptr) {
    const int tid_ = opaque_tid(); const int lane = tid_ & 63, gw = blockIdx.x * NWV + (tid_ >> 6), ngw = gridDim.x * NWV;
    for (int r = gw; r < nrows; r += ngw) {
        const float* x = src + (size_t)r * 1024;
        float4 v[4];
        float sum = 0.f;
#pragma unroll
        for (int i = 0; i < 4; ++i) { v[i] = ld4(x + i * 256 + lane * 4); sum += v[i].x + v[i].y + v[i].z + v[i].w; }
        const float mean = wave_sum(sum) * (1.f / 1024.f);
        float sq = 0.f;
#pragma unroll
        for (int i = 0; i < 4; ++i) {
            v[i].x -= mean; v[i].y -= mean; v[i].z -= mean; v[i].w -= mean;
            sq += v[i].x * v[i].x + v[i].y * v[i].y + v[i].z * v[i].z + v[i].w * v[i].w;
        }
        const float rstd = rsqrtf(wave_sum(sq) * (1.f / 1024.f) + 1e-5f);
        float* d = (r < ncx) ? (dst_cx + (size_t)r * 1024) : (dst_lat + (size_t)(r - ncx) * 1024);
#pragma unroll
        for (int i = 0; i < 4; ++i) {
            const int c = i * 256 + lane * 4;
            const float4 gg = ld4(g + c), bb = ld4(bt + c);
            const float4 y = make_float4(v[i].x * rstd * gg.x + bb.x, v[i].y * rstd * gg.y + bb.y, v[i].z * rstd * gg.z + bb.z, v[i].w * rstd * gg.w + bb.w);
            st4(d + c, y);
            if (hb != nullptr) {
                const float* m = (r < ncx) ? mvc : mvl;
                const float4 sh = ld4(m + c), sc = ld4(m + 1024 + c);
                *(uint2*)(hb + (size_t)r * 1024 + c) = make_uint2(pack2bf(y.x * (1.f + sc.x) + sh.x, y.y * (1.f + sc.y) + sh.y), pack2bf(y.z * (1.f + sc.z) + sh.z, y.w * (1.f + sc.w) + sh.w));
            }
        }
    }
}
DEV void phase_h1l(const Params& p) {
    const float* modv1 = (const float*)(p.ws + OFF_MODV) + 3 * 3072;
    bf16_t* H1 = (bf16_t*)(p.ws + OFF_H1B);
    const size_t gt = (size_t)blockIdx.x * NTHR + opaque_tid(), gn = (size_t)gridDim.x * NTHR;
    for (size_t i = gt; i < (size_t)NB * NL * 128; i += gn) {
        const size_t r = i >> 7; const int k = (int)(i & 127) * 8;
        const float* m = modv1 + (r >= (size_t)NL ? 1 : 0) * 3072;
        const float4 x0 = ld4(p.out + r * DM + k), x1 = ld4(p.out + r * DM + k + 4);
        const float4 s0 = ld4(m + k), s1 = ld4(m + k + 4), c0 = ld4(m + 1024 + k), c1 = ld4(m + 1024 + k + 4);
        *(uint4*)(H1 + r * DM + k) = make_uint4(pack2bf(x0.x * (1.f + c0.x) + s0.x, x0.y * (1.f + c0.y) + s0.y), pack2bf(x0.z * (1.f + c0.z) + s0.z, x0.w * (1.f + c0.w) + s0.w),
                                                pack2bf(x1.x * (1.f + c1.x) + s1.x, x1.y * (1.f + c1.y) + s1.y), pack2bf(x1.z * (1.f + c1.z) + s1.z, x1.w * (1.f + c1.w) + s1.w));
    }
}

DEV void zero_f4(float* ptr, size_t nfloat) {
    const size_t n4 = nfloat / 4;
    for (size_t i = (size_t)blockIdx.x * NTHR + opaque_tid(); i < n4; i += (size_t)gridDim.x * NTHR) ((float4*)ptr)[i] = make_float4(0.f, 0.f, 0.f, 0.f);
}

DEV void chain_ids(int& chain, int& sub) {
    const int bid = blockIdx.x, xcd = bid & 7, idx = bid >> 3;
    chain = xcd * 2 + (idx >> 4); sub = idx & 15;
}

DEV void phase_conv1(const Params& p, float* sm) {
    const bf16_t* XM = (const bf16_t*)(p.ws + OFF_XM);
    bf16_t* XC = (bf16_t*)(p.ws + OFF_XC);
    float* G16P = (float*)(p.ws + OFF_G16P);
    const bf16_t* WFT = (const bf16_t*)(p.ws + OFF_WFT);
    const float* cw = p.in[31]; const float* cbias = p.in[32];
    bf16_t* imgC = (bf16_t*)sm;
    bf16_t* imgM = imgC + 64 * 264;
    float* red = (float*)(imgM + 64 * 264);
    float* cwl = red + 1024;
    const int tid = opaque_tid(), lane = tid & 63, wave = tid >> 6, t = tid >> 3, cg = tid & 7;
    for (int u = blockIdx.x; u < NB * NCH * 4; u += gridDim.x) {
        const int ci = u >> 2, q = u & 3, b = ci / NCH, c = ci % NCH, s = c * 64 + t;
        const size_t rowbase = (size_t)b * TB;
        int nrow[9];
#pragma unroll
        for (int i = 0; i < 3; ++i)
#pragma unroll
            for (int j = 0; j < 3; ++j) {
                int ns = -1;
                if (s < NCX) { const int w2 = s + j - 1; if (i == 1 && w2 >= 0 && w2 < NCX) ns = w2; }
                else { const int n = s - NCX, rr = (n >> 6) + i - 1, w2 = (n & 63) + j - 1; if (rr >= 0 && rr < 128 && w2 >= 0 && w2 < 64) ns = NCX + rr * 64 + w2; }
                nrow[i * 3 + j] = ns;
            }
        const int tt = wave & 3, part = wave >> 2;
        f32x4 acc = (f32x4){0.f, 0.f, 0.f, 0.f};
#pragma unroll 1
        for (int half = 0; half < 2; ++half) {
            __syncthreads();
            for (int i = tid; i < 640; i += NTHR) { const int tp = i >> 6, c4 = (i & 63) * 4; st4(cwl + tp * 256 + c4, ld4((tp < 9 ? cw + tp * 2048 : cbias) + q * 512 + half * 256 + c4)); }
            __syncthreads();
#pragma unroll 2
            for (int it = 0; it < 4; ++it) {
                const int cl = it * 64 + cg * 8, c0 = q * 512 + half * 256 + cl;
                float a8[8];
                { const float4 b0 = ld4(cwl + 9 * 256 + cl), b1 = ld4(cwl + 9 * 256 + cl + 4); a8[0] = b0.x; a8[1] = b0.y; a8[2] = b0.z; a8[3] = b0.w; a8[4] = b1.x; a8[5] = b1.y; a8[6] = b1.z; a8[7] = b1.w; }
                uint4 xmc = make_uint4(0u, 0u, 0u, 0u);
#pragma unroll
                for (int tap = 0; tap < 9; ++tap) {
                    if (nrow[tap] >= 0) {
                        const uint4 xv = *(const uint4*)(XM + (rowbase + nrow[tap]) * 2048 + c0);
                        float x8[8]; unpack8(xv, x8);
                        const float4 w0 = ld4(cwl + tap * 256 + cl), w1 = ld4(cwl + tap * 256 + cl + 4);
                        a8[0] += x8[0] * w0.x; a8[1] += x8[1] * w0.y; a8[2] += x8[2] * w0.z; a8[3] += x8[3] * w0.w;
                        a8[4] += x8[4] * w1.x; a8[5] += x8[5] * w1.y; a8[6] += x8[6] * w1.z; a8[7] += x8[7] * w1.w;
                        if (tap == 4) xmc = xv;
                    }
                }
#pragma unroll
                for (int i = 0; i < 8; ++i) a8[i] = silu_f(a8[i]);
                const uint4 xcv = pack8(a8);
                *(uint4*)(XC + (rowbase + s) * 2048 + c0) = xcv;
                *(uint4*)(imgC + t * 264 + cl) = xcv;
                *(uint4*)(imgM + t * 264 + cl) = xmc;
            }
            __syncthreads();
            {
                const bf16_t* img = part ? imgM : imgC;
                const bf16_t* wrow = WFT + (size_t)(lane & 15) * 4096 + part * 2048 + q * 512 + half * 256 + (lane >> 4) * 8;
#pragma unroll
                for (int ks = 0; ks < 8; ++ks) acc = __builtin_amdgcn_mfma_f32_16x16x32_bf16(row_frag(img, 264, tt * 16, ks * 32, lane), *(const bf16x8*)(wrow + ks * 32), acc, 0, 0, 0);
            }
        }
        if (part == 1) {
#pragma unroll
            for (int r = 0; r < 4; ++r) red[(tt * 16 + (lane >> 4) * 4 + r) * 16 + (lane & 15)] = acc[r];
        }
        __syncthreads();
        if (part == 0) {
#pragma unroll
            for (int r = 0; r < 4; ++r) {
                const int tk = tt * 16 + (lane >> 4) * 4 + r;
                G16P[((size_t)q * RT + rowbase + c * 64 + tk) * 16 + (lane & 15)] = acc[r] + red[tk * 16 + (lane & 15)];
            }
        }
    }
}

DEV void gate_pair(const Params& p, size_t row, int dir, int h, float& gi, float& lf) {
    const float* G16P = (const float*)(p.ws + OFF_G16P);
    float a = 0.f, f = 0.f;
#pragma unroll
    for (int q = 0; q < 4; ++q) { a += G16P[((size_t)q * RT + row) * 16 + dir * 8 + h]; f += G16P[((size_t)q * RT + row) * 16 + dir * 8 + 4 + h]; }
    gi = a + p.in[dir ? 41 : 37][h];
    lf = logsig_f(f + p.in[dir ? 43 : 39][h]);
}

DEV void phase_x1(const Params& p, float* sm) {
    int chain, sub; chain_ids(chain, sub);
    const int b = chain >> 3, h = (chain >> 1) & 3, dir = chain & 1;
    const bf16_t* XC = (const bf16_t*)(p.ws + OFF_XC);
    float* GSC = (float*)(p.ws + OFF_GSC); float* CSC = (float*)(p.ws + OFF_CSC); float* NBUF = (float*)(p.ws + OFF_NBUF);
    const float* gtab = (const float*)(p.ws + OFF_GTAB);
    bf16_t* SMAT = (bf16_t*)(p.ws + OFF_SMAT);
    const int tid = opaque_tid(), lane = tid & 63, wave = tid >> 6;
    float* sTot = sm; float* sRef = sm + 132; float* sM0 = sm + 264; float* sBeta = sm + 400;
    for (int c = wave; c < NCH; c += NWV) {
        const size_t row = (size_t)b * TB + c * 64 + lane;
        float gi, lf; gate_pair(p, row, dir, h, gi, lf);
        const float bc = wave_scan_add(lf, lane, dir);
        const float ref = wave_max(gi - bc), tot = wave_sum(lf);
        if (lane == 0) { sTot[c] = tot; sRef[c] = ref; }
    }
    __syncthreads();
    if (tid == 0) {
        float m0 = -INFINITY;
        for (int step = 0; step < NCH; ++step) {
            const int c = chunk_at(dir, step);
            sM0[c] = m0;
            const float mx = fmaxf(m0, sRef[c]);
            if (sub == 0) { CSC[(chain * NCH + c) * 2] = fexp(m0 - mx); CSC[(chain * NCH + c) * 2 + 1] = fexp(sRef[c] - mx); }
            m0 = sTot[c] + mx;
        }
    }
    __syncthreads();
    for (int k = wave; sub + 16 * k < NCH; k += NWV) {
        const int c = sub + 16 * k;
        const size_t row = (size_t)b * TB + c * 64 + lane;
        float gi, lf; gate_pair(p, row, dir, h, gi, lf);
        const float bc = wave_scan_add(lf, lane, dir);
        const float a = gi - bc;
        const float amax = wave_scan_max(a, lane, dir);
        const float ref = sRef[c], m0 = sM0[c];
        const float mmax = fmaxf(amax, m0);
        const float mt = bc + mmax;
        const float alpha = fexp(ref - mmax), beta = fexp(a - ref), gg = fexp(m0 - mmax), em = fexp(-mt);
        st4(GSC + ((size_t)chain * TB + c * 64 + lane) * 4, make_float4(alpha, beta, gg, em));
        sBeta[k * 64 + lane] = beta;
    }
    __syncthreads();
    {
        float* part = sm + 1024;
        const int sg = tid >> 6, j8 = (tid & 63) * 8;
        for (int k = 0; sub + 16 * k < NCH; ++k) {
            const int c = sub + 16 * k;
            const bf16_t* xp = XC + ((size_t)b * TB + c * 64 + sg * 8) * 2048 + h * 512 + j8;
            float acc[8];
#pragma unroll
            for (int i = 0; i < 8; ++i) acc[i] = 0.f;
#pragma unroll
            for (int s = 0; s < 8; ++s) {
                float f[8]; unpack8(*(const uint4*)(xp + (size_t)s * 2048), f);
                const float be = sBeta[k * 64 + sg * 8 + s];
#pragma unroll
                for (int i = 0; i < 8; ++i) acc[i] += be * f[i];
            }
            __syncthreads();
            st4(part + sg * 512 + j8, make_float4(acc[0], acc[1], acc[2], acc[3])); st4(part + sg * 512 + j8 + 4, make_float4(acc[4], acc[5], acc[6], acc[7]));
            __syncthreads();
            float tot = 0.f;
#pragma unroll
            for (int q = 0; q < 8; ++q) tot += part[q * 512 + tid];
            NBUF[((size_t)chain * NCH + c) * 512 + tid] = tot;
        }
    }
    bf16_t* XCs = (bf16_t*)sm;
    bf16_t* Qs = XCs + 64 * 520;
    for (int u = blockIdx.x; u < NB * 4 * NCH; u += gridDim.x) {
        const int bh = u / NCH, c = u % NCH, ub = bh >> 2, uh = bh & 3;
        __syncthreads();
#pragma unroll 2
        for (int i = 0; i < 8; ++i) {
            const int pp = tid + 512 * i, row = pp >> 6, c16 = pp & 63;
            const uint4 xv = *(const uint4*)(XC + ((size_t)ub * TB + c * 64 + row) * 2048 + uh * 512 + c16 * 8);
            float f[8]; unpack8(xv, f);
            float q[8];
#pragma unroll
            for (int bb = 0; bb < 2; ++bb) {
                const float* G = gtab + (size_t)(uh * 128 + c16 * 2 + bb) * 16;
                const float4 g0 = ld4(G), g1 = ld4(G + 4), g2 = ld4(G + 8), g3 = ld4(G + 12);
                q[bb * 4 + 0] = f[bb * 4] * g0.x + f[bb * 4 + 1] * g1.x + f[bb * 4 + 2] * g2.x + f[bb * 4 + 3] * g3.x;
                q[bb * 4 + 1] = f[bb * 4] * g0.y + f[bb * 4 + 1] * g1.y + f[bb * 4 + 2] * g2.y + f[bb * 4 + 3] * g3.y;
                q[bb * 4 + 2] = f[bb * 4] * g0.z + f[bb * 4 + 1] * g1.z + f[bb * 4 + 2] * g2.z + f[bb * 4 + 3] * g3.z;
                q[bb * 4 + 3] = f[bb * 4] * g0.w + f[bb * 4 + 1] * g1.w + f[bb * 4 + 2] * g2.w + f[bb * 4 + 3] * g3.w;
            }
            *(uint4*)(XCs + row * 520 + c16 * 8) = xv;
            *(uint4*)(Qs + row * 520 + c16 * 8) = make_uint4(pack2bf(q[0], q[1]), pack2bf(q[2], q[3]), pack2bf(q[4], q[5]), pack2bf(q[6], q[7]));
        }
        __syncthreads();
        const int st = wave & 3, tt0 = (wave >> 2) * 2;
        f32x4 a0 = (f32x4){0.f, 0.f, 0.f, 0.f}, a1 = a0;
        const bf16_t* ap = XCs + (st * 16 + (lane & 15)) * 520 + (lane >> 4) * 8;
        const bf16_t* bp0 = Qs + (tt0 * 16 + (lane & 15)) * 520 + (lane >> 4) * 8;
        const bf16_t* bp1 = bp0 + 16 * 520;
#pragma unroll
        for (int ks = 0; ks < 16; ++ks) {
            const bf16x8 af = *(const bf16x8*)(ap + ks * 32);
            a0 = __builtin_amdgcn_mfma_f32_16x16x32_bf16(af, *(const bf16x8*)(bp0 + ks * 32), a0, 0, 0, 0);
            a1 = __builtin_amdgcn_mfma_f32_16x16x32_bf16(af, *(const bf16x8*)(bp1 + ks * 32), a1, 0, 0, 0);
        }
        bf16_t* sp = SMAT + (size_t)u * 4096 + (size_t)(tt0 * 16 + (lane & 15)) * 64 + st * 16 + (lane >> 4) * 4;
        *(uint2*)sp = make_uint2(pack2bf(a0[0], a0[1]), pack2bf(a0[2], a0[3]));
        *(uint2*)(sp + 16 * 64) = make_uint2(pack2bf(a1[0], a1[1]), pack2bf(a1[2], a1[3]));
    }
}

DEV void phase_x2(const Params& p, float* sm) {
    int chain, sub; chain_ids(chain, sub);
    const int b = chain >> 3, h = (chain >> 1) & 3, dir = chain & 1;
    const bf16_t* XC = (const bf16_t*)(p.ws + OFF_XC);
    float* GSC = (float*)(p.ws + OFF_GSC); const float* CSC = (const float*)(p.ws + OFF_CSC); const float* NBUF = (const float*)(p.ws + OFF_NBUF);
    const float* gtab = (const float*)(p.ws + OFF_GTAB);
    const bf16_t* SMAT = (const bf16_t*)(p.ws + OFF_SMAT);
    const int tid = opaque_tid();
    float* sD0 = sm; float* sCf = sm + 132; float* sN0 = sm + 264; float* sN2 = sN0 + 9 * 512;
    for (int i = tid; i < NCH; i += NTHR) { sD0[i] = CSC[(chain * NCH + i) * 2]; sCf[i] = CSC[(chain * NCH + i) * 2 + 1]; }
    __syncthreads();
    {
        float n = 0.f;
        const float* nb = NBUF + (size_t)chain * NCH * 512 + tid;
#pragma unroll 4
        for (int step = 0; step < NCH; ++step) {
            const int c = chunk_at(dir, step);
            if ((c & 15) == sub) sN0[(c >> 4) * 512 + tid] = n;
            n = sD0[c] * n + sCf[c] * nb[(size_t)c * 512];
        }
    }
    __syncthreads();
    {
        const int blk = tid >> 2, cp = tid & 3;
        const float4 g = ld4(gtab + (size_t)(h * 128 + blk) * 16 + cp * 4);
        for (int k = 0; sub + 16 * k < NCH; ++k) {
            const float* n0 = sN0 + k * 512 + blk * 4;
            sN2[k * 512 + tid] = g.x * n0[0] + g.y * n0[1] + g.z * n0[2] + g.w * n0[3];
        }
    }
    __syncthreads();
    const int t = tid >> 3, part = tid & 7;
    for (int k = 0; sub + 16 * k < NCH; ++k) {
        const int c = sub + 16 * k;
        const size_t row = (size_t)b * TB + c * 64 + t;
        float dint = 0.f;
        {
            const bf16_t* xp = XC + row * 2048 + h * 512 + part * 64;
            const float* n2 = sN2 + k * 512 + part * 64;
#pragma unroll
            for (int i = 0; i < 8; ++i) {
                float f[8]; unpack8(*(const uint4*)(xp + i * 8), f);
                const float4 na = ld4(n2 + i * 8), nb2 = ld4(n2 + i * 8 + 4);
                dint += f[0] * na.x + f[1] * na.y + f[2] * na.z + f[3] * na.w + f[4] * nb2.x + f[5] * nb2.y + f[6] * nb2.z + f[7] * nb2.w;
            }
        }
        float di = 0.f;
        {
            float f[8]; unpack8(*(const uint4*)(SMAT + ((size_t)((b * 4 + h) * NCH + c)) * 4096 + t * 64 + part * 8), f);
#pragma unroll
            for (int e = 0; e < 8; ++e) {
                const int s = part * 8 + e;
                const float beta = GSC[((size_t)chain * TB + c * 64 + s) * 4 + 1];
                const bool keep = dir ? (s >= t) : (s <= t);
                di += keep ? f[e] * beta : 0.f;
            }
        }
        dint += __shfl_xor(dint, 1, 64); dint += __shfl_xor(dint, 2, 64); dint += __shfl_xor(dint, 4, 64);
        di += __shfl_xor(di, 1, 64); di += __shfl_xor(di, 2, 64); di += __shfl_xor(di, 4, 64);
        if (part == 0) {
            float* gp = GSC + ((size_t)chain * TB + c * 64 + t) * 4;
            const float4 g4 = ld4(gp);
            const float den = g4.x * di + g4.z * dint;
            gp[3] = 1.f / fmaxf(fabsf(den), g4.w);
        }
    }
}

#define MLSTM_PREFETCH(step_) do { \
    const int c_ = chunk_at(dir, (step_)); const size_t rb_ = (size_t)b * TB + (size_t)c_ * 64; \
    { const bf16_t* xb_ = XC + (rb_ + (tid >> 6)) * 2048 + h * 512 + (tid & 63) * 8; \
      rx0 = *(const uint4*)(xb_); rx1 = *(const uint4*)(xb_ + 8 * 2048); rx2 = *(const uint4*)(xb_ + 16 * 2048); rx3 = *(const uint4*)(xb_ + 24 * 2048); \
      rx4 = *(const uint4*)(xb_ + 32 * 2048); rx5 = *(const uint4*)(xb_ + 40 * 2048); rx6 = *(const uint4*)(xb_ + 48 * 2048); rx7 = *(const uint4*)(xb_ + 56 * 2048); } \
    rxm = *(const uint2*)(XM + (rb_ + ps) * 2048 + ch0 + pvb * 4); \
    rs = *(const uint4*)(SMAT + ((size_t)((b * 4 + h) * NCH + c_)) * 4096 + ps * 64 + pvb * 8); \
    rbeta = GSC[((size_t)chain * TB + c_ * 64 + ps) * 4 + 1]; \
    if (tid < 64) rsc = ld4(GSC + ((size_t)chain * TB + c_ * 64 + tid) * 4); \
    rd0 = CSC[(chain * NCH + c_) * 2]; rcf = CSC[(chain * NCH + c_) * 2 + 1]; } while (0)

DEV void phase_mlstm(const Params& p, float* sm) {
    int chain, sub; chain_ids(chain, sub);
    const int b = chain >> 3, h = (chain >> 1) & 3, dir = chain & 1;
    const bf16_t* XM = (const bf16_t*)(p.ws + OFF_XM);
    const bf16_t* XC = (const bf16_t*)(p.ws + OFF_XC);
    const bf16_t* SMAT = (const bf16_t*)(p.ws + OFF_SMAT);
    const float* GSC = (const float*)(p.ws + OFF_GSC); const float* CSC = (const float*)(p.ws + OFF_CSC);
    const float* gtab = (const float*)(p.ws + OFF_GTAB);
    bf16_t* H = (bf16_t*)(p.ws + OFF_H);
    const float* wv = p.in[35];
    char* smc = (char*)sm;
    bf16_t* XCs = (bf16_t*)smc;
    bf16_t* Cs = (bf16_t*)(smc + 66560);
    bf16_t* Vb = (bf16_t*)(smc + 66560 + 33280);
    bf16_t* Vw = Vb + 32 * 72;
    bf16_t* Sm = Vw + 32 * 72;
    float* Gs = (float*)(smc + 66560 + 33280 + 2 * 4608 + 9216);
    float* sc = Gs + 2048;
    const int tid = opaque_tid(), lane = tid & 63, wave = tid >> 6;
    for (int i = tid; i < 32 * 520 / 2; i += NTHR) ((unsigned*)Cs)[i] = 0u;
    for (int i = tid; i < 2048; i += NTHR) Gs[i] = gtab[h * 2048 + i];
    const int ps = tid >> 3, pvb = tid & 7;
    const int ch0 = h * 512 + sub * 32;
    float wvr[16];
#pragma unroll
    for (int i = 0; i < 16; ++i) wvr[i] = wv[(size_t)((ch0 >> 2) + pvb) * 16 + i];
    f32x4 accS[4][2];
#pragma unroll
    for (int i = 0; i < 4; ++i) { accS[i][0] = (f32x4){0.f, 0.f, 0.f, 0.f}; accS[i][1] = (f32x4){0.f, 0.f, 0.f, 0.f}; }
    uint4 rx0, rx1, rx2, rx3, rx4, rx5, rx6, rx7; uint2 rxm; uint4 rs; float rbeta; float4 rsc = make_float4(0.f, 0.f, 0.f, 0.f); float rd0, rcf;
    MLSTM_PREFETCH(0);
    __syncthreads();
#pragma unroll 1
    for (int step = 0; step < NCH; ++step) {
        const int c = chunk_at(dir, step);
        const float d0 = rd0, cf = rcf;
        {
            bf16_t* xd = XCs + (tid >> 6) * 520 + (tid & 63) * 8;
            *(uint4*)(xd) = rx0; *(uint4*)(xd + 8 * 520) = rx1; *(uint4*)(xd + 16 * 520) = rx2; *(uint4*)(xd + 24 * 520) = rx3;
            *(uint4*)(xd + 32 * 520) = rx4; *(uint4*)(xd + 40 * 520) = rx5; *(uint4*)(xd + 48 * 520) = rx6; *(uint4*)(xd + 56 * 520) = rx7;
        }
        {
            const float x0 = bflo(rxm.x), x1 = bfhi(rxm.x), x2 = bflo(rxm.y), x3 = bfhi(rxm.y);
#pragma unroll
            for (int d = 0; d < 4; ++d) {
                const float v = (x0 * wvr[d] + x1 * wvr[4 + d] + x2 * wvr[8 + d] + x3 * wvr[12 + d]) * rbeta;
                Vb[(pvb * 4 + d) * 72 + ps] = __builtin_bit_cast(unsigned short, (__bf16)v);
                Vw[(pvb * 4 + d) * 72 + ps] = __builtin_bit_cast(unsigned short, (__bf16)(v * cf));
            }
        }
        {
#define SMASK(q_) (((dir ? (pvb * 8 + 2 * (q_) >= ps) : (pvb * 8 + 2 * (q_) <= ps)) ? 0x0000ffffu : 0u) | ((dir ? (pvb * 8 + 2 * (q_) + 1 >= ps) : (pvb * 8 + 2 * (q_) + 1 <= ps)) ? 0xffff0000u : 0u))
            *(uint4*)(Sm + ps * 72 + pvb * 8) = make_uint4(rs.x & SMASK(0), rs.y & SMASK(1), rs.z & SMASK(2), rs.w & SMASK(3));
#undef SMASK
        }
        if (tid < 64) st4(sc + tid * 4, rsc);
        { const int nstep = (step + 1 < NCH) ? step + 1 : step; MLSTM_PREFETCH(nstep); }
        __syncthreads();
        {
            const int vt = wave & 1, tt = wave >> 1;
            f32x4 ao = (f32x4){0.f, 0.f, 0.f, 0.f}, ai = ao, ao1 = ao, ao2 = ao, ao3 = ao;
            const bf16_t* ap = Cs + (vt * 16 + (lane & 15)) * 520 + (lane >> 4) * 8;
            const bf16_t* bp = XCs + (tt * 16 + (lane & 15)) * 520 + (lane >> 4) * 8;
#pragma unroll
            for (int ks = 0; ks < 16; ks += 4) {
                ao = __builtin_amdgcn_mfma_f32_16x16x32_bf16(*(const bf16x8*)(ap + ks * 32), *(const bf16x8*)(bp + ks * 32), ao, 0, 0, 0);
                ao1 = __builtin_amdgcn_mfma_f32_16x16x32_bf16(*(const bf16x8*)(ap + (ks + 1) * 32), *(const bf16x8*)(bp + (ks + 1) * 32), ao1, 0, 0, 0);
                ao2 = __builtin_amdgcn_mfma_f32_16x16x32_bf16(*(const bf16x8*)(ap + (ks + 2) * 32), *(const bf16x8*)(bp + (ks + 2) * 32), ao2, 0, 0, 0);
                ao3 = __builtin_amdgcn_mfma_f32_16x16x32_bf16(*(const bf16x8*)(ap + (ks + 3) * 32), *(const bf16x8*)(bp + (ks + 3) * 32), ao3, 0, 0, 0);
            }
            ao = (ao + ao1) + (ao2 + ao3);
            const bf16_t* ap2 = Vb + (vt * 16 + (lane & 15)) * 72 + (lane >> 4) * 8;
            const bf16_t* bp2 = Sm + (tt * 16 + (lane & 15)) * 72 + (lane >> 4) * 8;
#pragma unroll
            for (int ks = 0; ks < 2; ++ks) ai = __builtin_amdgcn_mfma_f32_16x16x32_bf16(*(const bf16x8*)(ap2 + ks * 32), *(const bf16x8*)(bp2 + ks * 32), ai, 0, 0, 0);
            if (c >= 4) {
                const int t = tt * 16 + (lane & 15);
                const float4 s4 = ld4(sc + t * 4);
                const float h0 = (s4.x * ai[0] + s4.z * ao[0]) * s4.w, h1 = (s4.x * ai[1] + s4.z * ao[1]) * s4.w;
                const float h2 = (s4.x * ai[2] + s4.z * ao[2]) * s4.w, h3 = (s4.x * ai[3] + s4.z * ao[3]) * s4.w;
                bf16_t* hp = H + ((size_t)b * NL + (size_t)c * 64 + t - NCX) * 2048 + ch0 + vt * 16 + (lane >> 4) * 4;
                const unsigned u0 = pack2bf(h0, h1), u1 = pack2bf(h2, h3);
                __builtin_amdgcn_global_atomic_fadd_v2bf16((__attribute__((address_space(1))) s16x2*)hp, __builtin_bit_cast(s16x2, u0));
                __builtin_amdgcn_global_atomic_fadd_v2bf16((__attribute__((address_space(1))) s16x2*)(hp + 2), __builtin_bit_cast(s16x2, u1));
            }
        }
#pragma unroll
        for (int jt = 0; jt < 4; ++jt) { accS[jt][0] *= d0; accS[jt][1] *= d0; }
#pragma unroll
        for (int ks = 0; ks < 2; ++ks) {
            const bf16x8 b0 = *(const bf16x8*)(Vw + (lane & 15) * 72 + ks * 32 + (lane >> 4) * 8);
            const bf16x8 b1 = *(const bf16x8*)(Vw + (16 + (lane & 15)) * 72 + ks * 32 + (lane >> 4) * 8);
            const int row0 = ks * 32 + (lane >> 4) * 8 + ((lane & 15) >> 2);
#pragma unroll
            for (int jt = 0; jt < 4; ++jt) {
                const int col = wave * 64 + jt * 16 + (lane & 3) * 4;
                const s16x4 lo = __builtin_amdgcn_ds_read_tr16_b64_v4i16((__attribute__((address_space(3))) s16x4*)(XCs + row0 * 520 + col));
                const s16x4 hi = __builtin_amdgcn_ds_read_tr16_b64_v4i16((__attribute__((address_space(3))) s16x4*)(XCs + (row0 + 4) * 520 + col));
                const bf16x8 af = (bf16x8){lo[0], lo[1], lo[2], lo[3], hi[0], hi[1], hi[2], hi[3]};
                accS[jt][0] = __builtin_amdgcn_mfma_f32_16x16x32_bf16(af, b0, accS[jt][0], 0, 0, 0);
                accS[jt][1] = __builtin_amdgcn_mfma_f32_16x16x32_bf16(af, b1, accS[jt][1], 0, 0, 0);
            }
        }
        __syncthreads();
#pragma unroll
        for (int jt = 0; jt < 4; ++jt) {
            const int blk = wave * 16 + jt * 4 + (lane >> 4);
            const float4 g0 = ld4(Gs + blk * 16), g1 = ld4(Gs + blk * 16 + 4), g2 = ld4(Gs + blk * 16 + 8), g3 = ld4(Gs + blk * 16 + 12);
#pragma unroll
            for (int v2 = 0; v2 < 2; ++v2) {
                const f32x4 a = accS[jt][v2];
                const float o0 = g0.x * a[0] + g0.y * a[1] + g0.z * a[2] + g0.w * a[3];
                const float o1 = g1.x * a[0] + g1.y * a[1] + g1.z * a[2] + g1.w * a[3];
                const float o2 = g2.x * a[0] + g2.y * a[1] + g2.z * a[2] + g2.w * a[3];
                const float o3 = g3.x * a[0] + g3.y * a[1] + g3.z * a[2] + g3.w * a[3];
                *(uint2*)(Cs + (v2 * 16 + (lane & 15)) * 520 + blk * 4) = make_uint2(pack2bf(o0, o1), pack2bf(o2, o3));
            }
        }
    }
}

DEV void phase_finish1(const Params& p) {
    bf16_t* H = (bf16_t*)(p.ws + OFF_H);
    const bf16_t* XC = (const bf16_t*)(p.ws + OFF_XC);
    const bf16_t* Z = (const bf16_t*)(p.ws + OFF_XM);
    const float* ng = p.in[44]; const float* skip = p.in[45];
    const int tid_ = opaque_tid(); const int lane = tid_ & 63, gw = blockIdx.x * NWV + (tid_ >> 6), ngw = gridDim.x * NWV;
    for (int it = gw; it < NB * NL * 4; it += ngw) {
        const int r = it >> 2, h = it & 3, b = r >= NL ? 1 : 0, nn = r - b * NL;
        const int c0 = h * 512 + lane * 8;
        bf16_t* hp = H + (size_t)r * 2048 + c0;
        float v[8]; unpack8(*(const uint4*)hp, v);
        float sum = 0.f;
#pragma unroll
        for (int j = 0; j < 8; ++j) sum += v[j];
        const float mean = wave_sum(sum) * (1.f / 512.f);
        float sq = 0.f;
#pragma unroll
        for (int j = 0; j < 8; ++j) { v[j] -= mean; sq += v[j] * v[j]; }
        const float rstd = rsqrtf(wave_sum(sq) * (1.f / 512.f) + 1e-5f);
        float xc[8], z[8];
        unpack8(*(const uint4*)(XC + ((size_t)b * TB + NCX + nn) * 2048 + c0), xc);
        unpack8(*(const uint4*)(Z + (size_t)r * 2048 + c0), z);
        float o[8];
#pragma unroll
        for (int j = 0; j < 8; ++j) o[j] = (v[j] * rstd * ng[c0 + j] + skip[c0 + j] * xc[j]) * silu_f(z[j]);
        *(uint4*)hp = make_uint4(pack2bf(o[0], o[1]), pack2bf(o[2], o[3]), pack2bf(o[4], o[5]), pack2bf(o[6], o[7]));
    }
}

__global__ void __launch_bounds__(NTHR) fwd_kernel(Params p) {
    extern __shared__ __attribute__((aligned(16))) float sm[];
    volatile LAS unsigned* xst = (volatile LAS unsigned*)((LAS char*)sm + (LDS_BYTES - 16));
    if (threadIdx.x == 0) { xst[0] = 0u; xst[1] = 0u; }
    __syncthreads();
    const XcdBarrier xbar = xcd_barrier_post((unsigned*)(p.ws + OFF_BAR), xst);
    const int tid = opaque_tid(), lane = tid & 63, wave = tid >> 6;
    float* modv = (float*)(p.ws + OFF_MODV);
    float* X1C = (float*)(p.ws + OFF_X1C);

    phase_mod(p, sm);
    phase_tables(p);
    transpose_convert(p.in[8], 1024, EIN, 4096, (bf16_t*)(p.ws + OFF_WT0), sm);
    transpose_convert(p.in[29], 1024, 4096, 4096, (bf16_t*)(p.ws + OFF_WT1), sm);
    transpose_convert(p.in[9], 1024, 1024, 1024, (bf16_t*)(p.ws + OFF_WT2), sm);
    transpose_convert(p.in[30], 2048, 1024, 1024, (bf16_t*)(p.ws + OFF_WT3), sm);
    xcd_barrier(xbar);

#pragma unroll 1
    for (int b = 0; b < NB; ++b) {
        if (b == 0) { phase_h0(p, 0); xcd_barrier(xbar); }
        run_gemm((const bf16_t*)(p.ws + OFF_YC), (const bf16_t*)(p.ws + OFF_WT0), TB, 4096, DM, EpBf16{(bf16_t*)(p.ws + OFF_P0), EIN, EIN}, sm);
        xcd_barrier(xbar);
        for (int u = blockIdx.x; u < 24 * NCH; u += gridDim.x) {
            if (u < 16 * NCH) rwkv1_unit(p, (u / NCH) >> 1, (u / NCH) & 1, u % NCH, sm);
            else { const int v = u - 16 * NCH; gla1_unit(p, (v / NCH) >> 1, (v / NCH) & 1, v % NCH, sm); }
        }
        xcd_barrier(xbar);
        if (blockIdx.x < 128) gla2_unit(p, blockIdx.x);
        else if (blockIdx.x < 192) rwkv2_unit(p, (blockIdx.x - 128) >> 2, (blockIdx.x - 128) & 3, sm);
        xcd_barrier(xbar);
        for (int u = blockIdx.x; u < 12 * NCH; u += gridDim.x) {
            if (u < 8 * NCH) rwkv3_unit(p, u / NCH, u % NCH, sm);
            else { const int v = u - 8 * NCH; gla3_unit(p, v / NCH, v % NCH, sm); }
        }
        xcd_barrier(xbar);
        run_gemm((const bf16_t*)(p.ws + OFF_YC), (const bf16_t*)(p.ws + OFF_WT2), TB, DM, DM, EpRes0{(float*)(p.ws + OFF_P0), p.in[0], p.in[2], modv, b}, sm);
        xcd_barrier(xbar);
        ln_rows((const float*)(p.ws + OFF_P0), TB, p.in[6], p.in[7], p.out + (size_t)b * NL * DM, X1C + (size_t)b * NCX * DM, NCX,
                (bf16_t*)(p.ws + OFF_H1B) + (size_t)b * TB * DM, modv + (3 + 2) * 3072, modv + (3 + b) * 3072);
        if (b == 0) phase_h0(p, 1);
        xcd_barrier(xbar);
    }

    run_gemm((const bf16_t*)(p.ws + OFF_H1B), (const bf16_t*)(p.ws + OFF_WT1), RT, 2048, DM, EpBf16{(bf16_t*)(p.ws + OFF_XM), 2048, 2048}, sm);
    zero_f4((float*)(p.ws + OFF_H), (size_t)NB * NL * 1024);
    xcd_barrier(xbar);
    phase_conv1(p, sm);
    xcd_barrier(xbar);
    phase_x1(p, sm);
    xcd_barrier(xbar);
    phase_x2(p, sm);
    xcd_barrier(xbar);
    phase_mlstm(p, sm);
    xcd_barrier(xbar);
    phase_h1l(p);
    xcd_barrier(xbar);
    run_gemm((const bf16_t*)(p.ws + OFF_H1B), (const bf16_t*)(p.ws + OFF_WT1) + (size_t)2048 * 1024, NB * NL, 2048, DM, EpBf16{(bf16_t*)(p.ws + OFF_XM), 2048, 2048}, sm);
    xcd_barrier(xbar);
    phase_finish1(p);
    xcd_barrier(xbar);
    run_gemm((const bf16_t*)(p.ws + OFF_H), (const bf16_t*)(p.ws + OFF_WT3), NB * NL, DM, 2048, EpRes1{(float*)(p.ws + OFF_XC), p.out, modv + 3 * 3072}, sm);
    xcd_barrier(xbar);
    ln_rows((const float*)(p.ws + OFF_XC), NB * NL, p.in[6] + 1024, p.in[7] + 1024, p.out, p.out, 0);
}

extern "C" void kernel_launch(void* const* d_in, const int* in_sizes, int n_in, void* d_out, int out_size, void* d_ws, size_t ws_size, hipStream_t stream) {
    static int grid_blocks = 0;
    if (grid_blocks == 0) {
        if (ws_size < WS_NEED || n_in != 46) { fprintf(stderr, "kernel_launch: bad ws_size %zu (need %zu) or n_in %d\n", ws_size, (size_t)WS_NEED, n_in); grid_blocks = -1; return; }
        int dev = 0, cus = 0, per_cu = 0;
        (void)hipGetDevice(&dev);
        (void)hipDeviceGetAttribute(&cus, hipDeviceAttributeMultiprocessorCount, dev);
        (void)hipFuncSetAttribute((const void*)fwd_kernel, hipFuncAttributeMaxDynamicSharedMemorySize, LDS_BYTES);
        (void)hipOccupancyMaxActiveBlocksPerMultiprocessor(&per_cu, (const void*)fwd_kernel, NTHR, LDS_BYTES);
        if (per_cu < 1 || cus < 256) { fprintf(stderr, "kernel_launch: occupancy query says %d blocks/CU on %d CUs; this kernel needs 256 resident workgroups\n", per_cu, cus); grid_blocks = -1; return; }
        grid_blocks = 256;
    }
    if (grid_blocks < 0) return;
    (void)hipMemsetAsync((char*)d_ws + OFF_BAR, 0, XCD_BAR_WORDS * 4, stream);
    Params p{};
    for (int i = 0; i < 46; ++i) p.in[i] = (const float*)d_in[i];
    p.out = (float*)d_out; p.ws = (char*)d_ws;
    void* args[] = {&p};
    hipError_t e = hipLaunchCooperativeKernel((const void*)fwd_kernel, dim3(grid_blocks), dim3(NTHR), args, LDS_BYTES, stream);
    if (e != hipSuccess) fprintf(stderr, "cooperative launch failed: %s (grid %d)\n", hipGetErrorString(e), grid_blocks);
}
```

```cpp
#include <hip/hip_runtime.h>
#include <cstdio>
#include <cmath>

#define DEV __device__ __forceinline__

constexpr int NB = 2, NL = 8192, DM = 1024, NCX = 256, TB = NCX + NL;
constexpr int RT = NB * TB;
constexpr int NCH = TB / 64;
constexpr int EIN = 3872, RW0 = 1568;
constexpr int NTHR = 512, NWV = 8;
constexpr float ALPHA = 1.41421356237f;
constexpr float KSCALE = 0.04419417382f;

constexpr size_t OFF_MODV = 0;
constexpr size_t OFF_X1C  = 131072;
constexpr size_t OFF_BAR  = 3145728;
constexpr size_t OFF_BIG  = 4194304;
constexpr size_t OFF_P0   = OFF_BIG;
constexpr size_t OFF_YC   = OFF_BIG + (size_t)TB * EIN * 2;
constexpr size_t OFF_GDS  = OFF_YC + (size_t)TB * 1024 * 2;
constexpr size_t OFF_GDEC = OFF_GDS + (size_t)8 * NCH * 8192 * 4;
constexpr size_t OFF_RU   = OFF_GDEC + (size_t)8 * NCH * 64 * 4;
constexpr size_t OFF_RS0  = OFF_RU + (size_t)16 * NCH * 16384 * 2;
constexpr size_t OFF_BONS = OFF_RS0 + (size_t)16 * NCH * 4096 * 2;
constexpr size_t L0_END   = OFF_BONS + (size_t)2 * TB * 8 * 4;
constexpr size_t OFF_XM   = OFF_BIG;
constexpr size_t OFF_XC   = OFF_XM + (size_t)RT * 2048 * 2;
constexpr size_t OFF_H    = OFF_XC + (size_t)RT * 2048 * 2;
constexpr size_t OFF_WT0  = OFF_H + (size_t)NB * NL * 2048 * 2;
constexpr size_t OFF_WT1  = OFF_WT0 + (size_t)4096 * 1024 * 2;
constexpr size_t OFF_WT2  = OFF_WT1 + (size_t)4096 * 1024 * 2;
constexpr size_t OFF_WT3  = OFF_WT2 + (size_t)1024 * 1024 * 2;
constexpr size_t OFF_G16  = OFF_WT3 + (size_t)1024 * 2048 * 2;
constexpr size_t OFF_SMAT = OFF_G16 + (size_t)RT * 16 * 4;
constexpr size_t OFF_GSC  = OFF_SMAT + (size_t)NB * 4 * NCH * 4096 * 2;
constexpr size_t OFF_CSC  = OFF_GSC + (size_t)16 * TB * 4 * 4;
constexpr size_t OFF_NBUF = OFF_CSC + (size_t)16 * NCH * 2 * 4;
constexpr size_t OFF_GTAB = 3407872;
constexpr size_t OFF_WFT  = OFF_GTAB + (size_t)4 * 128 * 16 * 4;
static_assert(OFF_WFT + (size_t)16 * 4096 * 2 <= OFF_BIG, "low-region tables overflow");
constexpr size_t OFF_G16P = OFF_NBUF + (size_t)16 * NCH * 512 * 4;
constexpr size_t OFF_H1B  = OFF_G16;
constexpr size_t WS_NEED  = (OFF_G16P + (size_t)4 * RT * 16 * 4 > OFF_H1B + (size_t)RT * 1024 * 2) ? OFF_G16P + (size_t)4 * RT * 16 * 4 : OFF_H1B + (size_t)RT * 1024 * 2;
static_assert(WS_NEED <= (size_t)256 * 1024 * 1024, "workspace exceeds the guaranteed 256 MiB");

static_assert(L0_END <= OFF_WT0, "layer-0 buffers overlap the weight copies");
constexpr int LDS_BYTES = 139264;

struct Params { const float* in[46]; float* out; char* ws; };
typedef unsigned short bf16_t;
typedef __attribute__((ext_vector_type(8))) short bf16x8;
typedef __attribute__((ext_vector_type(4))) short s16x4;
typedef __attribute__((ext_vector_type(2))) short s16x2;
typedef __attribute__((ext_vector_type(4))) float f32x4;
typedef __attribute__((ext_vector_type(2))) __bf16 bf2_t;
DEV unsigned pack2bf(float lo, float hi) { bf2_t v; v[0] = (__bf16)lo; v[1] = (__bf16)hi; return __builtin_bit_cast(unsigned, v); }
DEV float bflo(unsigned u) { return __uint_as_float(u << 16); }
DEV float bfhi(unsigned u) { return __uint_as_float(u & 0xffff0000u); }
DEV float bf2f(bf16_t v) { return __uint_as_float(((unsigned)v) << 16); }
DEV void unpack8(uint4 u, float* f) { f[0] = bflo(u.x); f[1] = bfhi(u.x); f[2] = bflo(u.y); f[3] = bfhi(u.y); f[4] = bflo(u.z); f[5] = bfhi(u.z); f[6] = bflo(u.w); f[7] = bfhi(u.w); }

DEV float wave_sum(float v) {
#pragma unroll
    for (int o = 32; o > 0; o >>= 1) v += __shfl_xor(v, o, 64);
    return v;
}
DEV float wave_max(float v) {
#pragma unroll
    for (int o = 32; o > 0; o >>= 1) v = fmaxf(v, __shfl_xor(v, o, 64));
    return v;
}
DEV float fexp(float x) { return __expf(x); }
DEV float frcp(float x) { return __builtin_amdgcn_rcpf(x); }
DEV float sigmoid_f(float x) { return frcp(1.f + fexp(-x)); }
DEV float silu_f(float x) { return x * frcp(1.f + fexp(-x)); }
DEV float logsig_f(float x) { return fminf(x, 0.f) - __logf(1.f + fexp(-fabsf(x))); }
DEV float tanh_f(float x) { const float e = fexp(2.f * x); return 1.f - 2.f * frcp(e + 1.f); }
DEV void lds_fence() { asm volatile("" ::: "memory"); }
DEV int opaque_tid() { int t = threadIdx.x; asm volatile("" : "+v"(t)); return t; }
DEV int scan_s(int dir, int u) { return dir == 0 ? u : (u < NCX ? (NCX - 1 - u) : (TB - 1 + NCX - u)); }
DEV int chunk_at(int dir, int step) { return dir == 0 ? step : (step < 4 ? 3 - step : (NCH + 3 - step)); }
DEV float4 ld4(const float* p) { return *(const float4*)p; }
DEV void st4(float* p, float4 v) { *(float4*)p = v; }


#define XB_TMO      128
#define XB_XCNT(j)  (256  + 64 * (j))
#define XB_XSUB(j)  (1280 + 64 * (j))
#define XB_XGEN(j)  (2304 + 64 * (j))
#define XB_TOP      3328
#define XB_TOPGEN   3392
#define XCD_BAR_WORDS 3456
#define XB_SPIN_CAP (1u << 22)
#define LAS __attribute__((address_space(3)))
DEV unsigned xb_ld(unsigned* p) { return __hip_atomic_load(p, __ATOMIC_RELAXED, __HIP_MEMORY_SCOPE_AGENT); }
DEV unsigned xb_add(unsigned* p, unsigned v) { return __hip_atomic_fetch_add(p, v, __ATOMIC_RELAXED, __HIP_MEMORY_SCOPE_AGENT); }
DEV unsigned xb_xcc_id() { return (unsigned)__builtin_amdgcn_s_getreg((3 << 11) | 20) & 0xFu; }
#define XB_SPIN(cond, bar) do { unsigned _sp = 0; while (cond) { __builtin_amdgcn_s_sleep(1); \
    if ((++_sp & 255u) == 0u) { if (xb_ld(&(bar)[XB_TMO])) break; if (_sp > XB_SPIN_CAP) { atomicAdd(&(bar)[XB_TMO], 1u); break; } } } } while (0)
struct XcdBarrier { unsigned* bar; unsigned x; volatile LAS unsigned* st; };
DEV XcdBarrier xcd_barrier_post(unsigned* bar, volatile LAS unsigned* st) {
    XcdBarrier b; b.bar = bar; b.x = xb_xcc_id(); b.st = st;
    if (threadIdx.x == 0) (void)xb_add(&bar[XB_XCNT(b.x)], 1u);
    return b;
}
DEV void xcd_barrier_complete(unsigned* bar, unsigned x, unsigned& nloc, unsigned& nx) {
    const unsigned G = gridDim.x * gridDim.y * gridDim.z;
    unsigned sum, cnt, mine, sp = 0u;
    for (;;) {
        sum = 0u; cnt = 0u; mine = 0u;
#pragma unroll
        for (unsigned j = 0; j < 16; ++j) { const unsigned c = xb_ld(&bar[XB_XCNT(j)]); sum += c; cnt += (c > 0u) ? 1u : 0u; mine = (j == x) ? c : mine; }
        if (sum == G) break;
        __builtin_amdgcn_s_sleep(1);
        if ((++sp & 255u) == 0u) { if (xb_ld(&bar[XB_TMO])) break; if (sp > XB_SPIN_CAP) { atomicAdd(&bar[XB_TMO], 1u); break; } }
    }
    nloc = mine > 0u ? mine : 1u; nx = cnt > 0u ? cnt : 1u;
}
DEV void xcd_barrier(const XcdBarrier& b) {
    asm volatile("s_waitcnt vmcnt(0)" ::: "memory");
    __syncthreads();
    if (threadIdx.x == 0) {
        unsigned* bar = b.bar;
        __builtin_amdgcn_s_waitcnt(0);
        unsigned nloc = b.st[0], nx = b.st[1];
        if (nloc == 0u) { xcd_barrier_complete(bar, b.x, nloc, nx); b.st[0] = nloc; b.st[1] = nx; }
        const unsigned old = xb_add(&bar[XB_XSUB(b.x)], 1u);
        const unsigned gen = old / nloc;
        if (old + 1u == (gen + 1u) * nloc) {
            __builtin_amdgcn_fence(__ATOMIC_RELEASE, "agent");
            asm volatile("s_waitcnt vmcnt(0)" ::: "memory");
            const unsigned og = xb_add(&bar[XB_TOP], 1u);
            const unsigned tg = og / nx;
            if (og + 1u == (tg + 1u) * nx) xb_add(&bar[XB_TOPGEN], 1u);
            else XB_SPIN(xb_ld(&bar[XB_TOPGEN]) == tg, bar);
            __builtin_amdgcn_fence(__ATOMIC_ACQUIRE, "agent");
            xb_add(&bar[XB_XGEN(b.x)], 1u);
            asm volatile("s_waitcnt vmcnt(0)" ::: "memory");
        } else {
            XB_SPIN(xb_ld(&bar[XB_XGEN(b.x)]) == gen, bar);
            __builtin_amdgcn_fence(__ATOMIC_ACQUIRE, "agent");
            asm volatile("s_waitcnt vmcnt(0)" ::: "memory");
        }
    }
    __syncthreads();
}

namespace pg8 {
#define PG8_LAS __attribute__((address_space(3)))
typedef unsigned short bf16_t;
typedef short bf16x8 __attribute__((ext_vector_type(8)));
typedef float f32x4 __attribute__((ext_vector_type(4)));
typedef unsigned u32x4 __attribute__((ext_vector_type(4)));
constexpr int BM = 256, BK = 64, HALF = 128, HTB = HALF * BK * 2  , STAGE_BYTES = 8 * HTB, NXCD = 8, WGM = 8;

__host__ __device__ __forceinline__ int lds_byte(int r, int c) { const int st = (r >> 4) * 2 + (c >> 5), rr = r & 15, cc = c & 31, ob = rr * 64 + cc * 2; return st * 1024 + (ob ^ (((ob >> 9) & 1) << 5)); }
__host__ __device__ __forceinline__ void stage_rc(int b, int& R, int& C) { const int st = b / 1024, sb = b % 1024, swz = sb ^ (((sb >> 9) & 1) << 5); R = (st >> 1) * 16 + swz / 64; C = (st & 1) * 32 + (swz % 64) / 2; }
__host__ __device__ __forceinline__ int perm32(int rho) { const int n = rho >> 4, i = rho & 15; return 8 * (i >> 2) + 4 * n + (i & 3); }

struct Unit { int pm, pn; };
struct Gemm { const bf16_t* A; const bf16_t* Bt; int M, N, K; };

struct StaticOrder {
    int nM, nN, nwg, G, c;
    __host__ __device__ void init(int M, int N, int G_, int c_) { nM = M / BM; nN = N / BM; nwg = nM * nN; G = G_; c = c_; }
    __host__ __device__ bool next(int i, Unit& u) const {
        const long L = (long)i * G + c; if (L >= nwg) return false;
        int wgid = (int)L; { const int q = nwg / NXCD, r = nwg % NXCD, xcd = wgid % NXCD, off = wgid / NXCD; wgid = (xcd < r ? xcd * (q + 1) : r * (q + 1) + (xcd - r) * q) + off; }
        const int nig = WGM * nN, gid = wgid / nig, fm = gid * WGM, gsz = (nM - fm) < WGM ? (nM - fm) : WGM;
        u.pm = fm + ((wgid % nig) % gsz); u.pn = (wgid % nig) / gsz; return true;
    }
    __device__ __forceinline__ void a_ready(const Unit&) const {}
    __device__ __forceinline__ void done(const Unit&) const {}
};

template <class Epi, class Sched, bool STAMP = false>
__device__ __forceinline__ void gemm_phase(PG8_LAS unsigned char* lds, const Gemm g, const Sched& S, const Epi& E, unsigned long long* stamps) {
    int tid = threadIdx.x; asm volatile("" : "+v"(tid));
    const int wid = __builtin_amdgcn_readfirstlane(tid >> 6), lane = tid & 63, wr = wid >> 2, wc = wid & 3, fr = lane & 15, fq = lane >> 4;
    const int K = g.K, nt = K / BK;
#define PG8_STAMP() do { } while (0)
    PG8_STAMP();
    unsigned voffA[2], voffB[2];
#pragma unroll
    for (int i = 0; i < 2; ++i) { int R, C; stage_rc(tid * 16 + i * 8192, R, C); const int Rb = Epi::PERM ? ((R & ~31) + perm32(R & 31)) : R;
        voffA[i] = (unsigned)(R * K + C) * 2u; voffB[i] = (unsigned)(Rb * K + C) * 2u; }
    const size_t kstep = (size_t)(BK * 2);
    const size_t hstep = (size_t)HALF * K * 2;
    const size_t tstep = 2 * hstep;
    const unsigned ldsw = (unsigned)wid * 1024u;
    const int aoff = lds_byte(wr * 64 + fr, fq * 8), boff = lds_byte(wc * 32 + fr, fq * 8);
#define PG8_SA(b, h) (((b) * 2 + (h)) * HTB)
#define PG8_SB(b, h) ((4 + (b) * 2 + (h)) * HTB)
#define PG8_STAGE(bufoff, gbase, voff) do { _Pragma("unroll") for (int _i = 0; _i < 2; ++_i) \
        __builtin_amdgcn_global_load_lds((const unsigned*)((const char*)(gbase) + (voff)[_i]), (PG8_LAS unsigned*)(lds + (bufoff) + ldsw + _i * 8192), 16, 0, 0); } while (0)
#define PG8_LDA(dst, b, h) do { _Pragma("unroll") for (int m = 0; m < 4; ++m) _Pragma("unroll") for (int k = 0; k < 2; ++k) dst[m][k] = *(const PG8_LAS bf16x8*)(lds + PG8_SA(b, h) + aoff + m * 2048 + k * 1024); } while (0)
#define PG8_LDB(dst, b, h) do { _Pragma("unroll") for (int n = 0; n < 2; ++n) _Pragma("unroll") for (int k = 0; k < 2; ++k) dst[n][k] = *(const PG8_LAS bf16x8*)(lds + PG8_SB(b, h) + boff + n * 2048 + k * 1024); } while (0)
#define PG8_MMA(ai, bj, At, Bt) do { __builtin_amdgcn_s_setprio(1); _Pragma("unroll") for (int m = 0; m < 4; ++m) _Pragma("unroll") for (int n = 0; n < 2; ++n) _Pragma("unroll") for (int k = 0; k < 2; ++k) \
        acc[ai][bj][m][n] = __builtin_amdgcn_mfma_f32_16x16x32_bf16(Bt[n][k], At[m][k], acc[ai][bj][m][n], 0, 0, 0); __builtin_amdgcn_s_setprio(0); } while (0)
#define PG8_WAIT_V(n) asm volatile("s_waitcnt vmcnt(" #n ")" ::: "memory")
#define PG8_WAIT_L(n) asm volatile("s_waitcnt lgkmcnt(" #n ")" ::: "memory")
#define PG8_BAR __builtin_amdgcn_s_barrier()
#define PG8_SCHED __builtin_amdgcn_sched_barrier(0)
    Unit cur, nxt; int ui = 0;
    if (!S.next(0, cur)) return;
    f32x4 acc[2][2][4][2];
#pragma unroll
    for (int a = 0; a < 2; ++a)
#pragma unroll
        for (int b = 0; b < 2; ++b)
#pragma unroll
            for (int m = 0; m < 4; ++m)
#pragma unroll
                for (int n = 0; n < 2; ++n) acc[a][b][m][n] = (f32x4){0.f, 0.f, 0.f, 0.f};
    bf16x8 At[4][2], B0[2][2], B1[2][2];
    const char* cA = (const char*)g.A + (size_t)cur.pm * tstep; const char* cB = (const char*)g.Bt + (size_t)cur.pn * tstep;
    S.a_ready(cur);
    PG8_STAGE(PG8_SB(0, 0), cB, voffB); PG8_STAGE(PG8_SA(0, 0), cA, voffA); PG8_STAGE(PG8_SB(0, 1), cB + hstep, voffB); PG8_STAGE(PG8_SA(0, 1), cA + hstep, voffA);
    if (wr == 1) PG8_BAR;
    PG8_WAIT_V(4); PG8_BAR;
    PG8_STAGE(PG8_SB(1, 0), cB + kstep, voffB); PG8_STAGE(PG8_SA(1, 0), cA + kstep, voffA); PG8_STAGE(PG8_SB(1, 1), cB + hstep + kstep, voffB);
    PG8_WAIT_V(6); PG8_BAR;
    PG8_STAMP();
    for (;;) {
        const bool has_next = S.next(ui + 1, nxt);
        const char* nA = has_next ? (const char*)g.A + (size_t)nxt.pm * tstep : cA; const char* nB = has_next ? (const char*)g.Bt + (size_t)nxt.pn * tstep : cB;
        for (int t = 0; t < nt; t += 2) {
            const bool last = (t == nt - 2);
            const char* a1 = cA + (size_t)(t + 1) * kstep;
            const char* a2 = last ? nA : cA + (size_t)(t + 2) * kstep; const char* b2 = last ? nB : cB + (size_t)(t + 2) * kstep;
            const char* a3 = a2 + kstep; const char* b3 = b2 + kstep;
            if (last && has_next) S.a_ready(nxt);
            PG8_LDB(B0, 0, 0); PG8_SCHED; PG8_LDA(At, 0, 0); PG8_STAGE(PG8_SA(1, 1), a1 + hstep, voffA);
            PG8_WAIT_L(8); PG8_BAR; PG8_WAIT_L(0); PG8_MMA(0, 0, At, B0); PG8_BAR; PG8_SCHED;
            PG8_LDB(B1, 0, 1); PG8_STAGE(PG8_SB(0, 0), b2, voffB);
            PG8_BAR; PG8_WAIT_L(0); PG8_MMA(0, 1, At, B1); PG8_BAR;
            PG8_LDA(At, 0, 1); PG8_STAGE(PG8_SA(0, 0), a2, voffA);
            PG8_BAR; PG8_WAIT_L(0); PG8_MMA(1, 0, At, B0); PG8_BAR; PG8_SCHED;
            PG8_STAGE(PG8_SB(0, 1), b2 + hstep, voffB);
            PG8_WAIT_V(6); PG8_BAR; PG8_MMA(1, 1, At, B1); PG8_BAR;
            PG8_LDB(B0, 1, 0); PG8_SCHED; PG8_LDA(At, 1, 0); PG8_STAGE(PG8_SA(0, 1), a2 + hstep, voffA);
            PG8_WAIT_L(8); PG8_BAR; PG8_WAIT_L(0); PG8_MMA(0, 0, At, B0); PG8_BAR; PG8_SCHED;
            PG8_LDB(B1, 1, 1); PG8_STAGE(PG8_SB(1, 0), b3, voffB);
            PG8_BAR; PG8_WAIT_L(0); PG8_MMA(0, 1, At, B1); PG8_BAR;
            PG8_LDA(At, 1, 1); PG8_STAGE(PG8_SA(1, 0), a3, voffA);
            PG8_BAR; PG8_WAIT_L(0); PG8_MMA(1, 0, At, B0); PG8_BAR; PG8_SCHED;
            PG8_STAGE(PG8_SB(1, 1), b3 + hstep, voffB);
            PG8_WAIT_V(6); PG8_BAR; PG8_MMA(1, 1, At, B1); PG8_BAR;
        }
        PG8_STAMP();
        if constexpr (!Epi::AFTER_DRAIN) { E(acc, cur, wr, wc, fr, fq); S.done(cur); }
        PG8_STAMP();
        if (!has_next) break;
#pragma unroll
        for (int a = 0; a < 2; ++a)
#pragma unroll
            for (int b = 0; b < 2; ++b)
#pragma unroll
                for (int m = 0; m < 4; ++m)
#pragma unroll
                    for (int n = 0; n < 2; ++n) acc[a][b][m][n] = (f32x4){0.f, 0.f, 0.f, 0.f};
        cur = nxt; cA = nA; cB = nB; ++ui;
    }
    PG8_WAIT_V(0);
    if (wr == 0) PG8_BAR;
    PG8_BAR;
    if constexpr (Epi::AFTER_DRAIN) { E.fused(acc, cur, wr, wc, fr, fq, lds, wid, lane); S.done(cur); }
    PG8_STAMP();
#undef PG8_STAMP
#undef PG8_SA
#undef PG8_SB
#undef PG8_STAGE
#undef PG8_LDA
#undef PG8_LDB
#undef PG8_MMA
#undef PG8_WAIT_V
#undef PG8_WAIT_L
#undef PG8_BAR
#undef PG8_SCHED
}
}

DEV void transpose_convert(const float* __restrict__ W, int K, int N, int Npad, bf16_t* Wt, float* sm) {
    float (*T)[65] = (float (*)[65])sm;
    const int tid = opaque_tid();
    const int kt = K / 64, ntl = Npad / 64;
    for (int tile = blockIdx.x; tile < kt * ntl; tile += gridDim.x) {
        const int k0 = (tile / ntl) * 64, n0 = (tile % ntl) * 64;
        __syncthreads();
#pragma unroll
        for (int i = 0; i < 2; ++i) {
            const int k = (tid >> 4) + 32 * i, n4 = (tid & 15) * 4;
            float4 v = make_float4(0.f, 0.f, 0.f, 0.f);
            if (n0 + n4 < N) v = ld4(W + (size_t)(k0 + k) * N + n0 + n4);
            T[k][n4] = v.x; T[k][n4 + 1] = v.y; T[k][n4 + 2] = v.z; T[k][n4 + 3] = v.w;
        }
        __syncthreads();
        const int n = tid >> 3, kq = (tid & 7) * 8;
        unsigned o[4];
#pragma unroll
        for (int j = 0; j < 4; ++j) o[j] = pack2bf(T[kq + 2 * j][n], T[kq + 2 * j + 1][n]);
        bf16_t* dst = Wt + (size_t)(n0 + n) * K + k0 + kq;
        *(uint4*)dst = make_uint4(o[0], o[1], o[2], o[3]);
    }
}

struct EpBf16 {
    static constexpr bool PERM = true, AFTER_DRAIN = false;
    bf16_t* O; int ldc; int ncols;
    DEV void operator()(const pg8::f32x4 (&acc)[2][2][4][2], const pg8::Unit& u, int wr, int wc, int fr, int fq) const {
        const int row0 = u.pm * 256 + wr * 64 + fr, col0 = u.pn * 256 + wc * 32 + 8 * fq;
#pragma unroll
        for (int ai = 0; ai < 2; ++ai)
#pragma unroll
            for (int m = 0; m < 4; ++m) {
                bf16_t* rowp = O + (size_t)(row0 + ai * 128 + m * 16) * ldc + col0;
#pragma unroll
                for (int bj = 0; bj < 2; ++bj) {
                    if (col0 + bj * 128 < ncols) {
                        const pg8::f32x4 v0 = acc[ai][bj][m][0], v1 = acc[ai][bj][m][1];
                        *(uint4*)(rowp + bj * 128) = make_uint4(pack2bf(v0[0], v0[1]), pack2bf(v0[2], v0[3]), pack2bf(v1[0], v1[1]), pack2bf(v1[2], v1[3]));
                    }
                }
            }
    }
};
struct EpRes0 {
    static constexpr bool PERM = false, AFTER_DRAIN = false;
    float* C; const float* mv; int b;
    DEV void operator()(const pg8::f32x4 (&acc)[2][2][4][2], const pg8::Unit& u, int wr, int wc, int fr, int fq) const {
        const bool isc = (u.pm * 256 < NCX);
        const float* gp = mv + (isc ? 2 : b) * 3072 + 2048;
        const int row0 = u.pm * 256 + wr * 64 + fr, col0 = u.pn * 256 + wc * 32 + 4 * fq;
#pragma unroll
        for (int ai = 0; ai < 2; ++ai)
#pragma unroll
            for (int m = 0; m < 4; ++m) {
                const size_t ro = (size_t)(row0 + ai * 128 + m * 16) * DM + col0;
#pragma unroll
                for (int bj = 0; bj < 2; ++bj)
#pragma unroll
                    for (int n = 0; n < 2; ++n) {
                        const int co = bj * 128 + n * 16;
                        const float4 g = ld4(gp + col0 + co); const pg8::f32x4 v = acc[ai][bj][m][n];
                        st4(C + ro + co, make_float4(g.x * v[0], g.y * v[1], g.z * v[2], g.w * v[3]));
                    }
            }
    }
};
struct EpRes1 {
    static constexpr bool PERM = false, AFTER_DRAIN = false;
    float* C; const float* mv;
    DEV void operator()(const pg8::f32x4 (&acc)[2][2][4][2], const pg8::Unit& u, int wr, int wc, int fr, int fq) const {
        const float* gp = mv + (u.pm * 256 >= NL ? 1 : 0) * 3072 + 2048;
        const int row0 = u.pm * 256 + wr * 64 + fr, col0 = u.pn * 256 + wc * 32 + 4 * fq;
#pragma unroll
        for (int ai = 0; ai < 2; ++ai)
#pragma unroll
            for (int m = 0; m < 4; ++m) {
                const size_t ro = (size_t)(row0 + ai * 128 + m * 16) * DM + col0;
#pragma unroll
                for (int bj = 0; bj < 2; ++bj)
#pragma unroll
                    for (int n = 0; n < 2; ++n) {
                        const int co = bj * 128 + n * 16;
                        const float4 g = ld4(gp + col0 + co); const pg8::f32x4 v = acc[ai][bj][m][n];
                        st4(C + ro + co, make_float4(g.x * v[0], g.y * v[1], g.z * v[2], g.w * v[3]));
                    }
            }
    }
};
template <class EP>
DEV void run_gemm(const bf16_t* A, const bf16_t* Bt, int M, int N, int K, const EP& ep, float* sm) {
    pg8::Gemm g{A, Bt, M, N, K}; pg8::StaticOrder S; S.init(M, N, (int)gridDim.x, (int)blockIdx.x);
    pg8::gemm_phase<EP, pg8::StaticOrder, false>((PG8_LAS unsigned char*)sm, g, S, ep, nullptr);
}

DEV void phase_h0(const Params& p, int b) {
    const float* modv = (const float*)(p.ws + OFF_MODV);
    bf16_t* H0 = (bf16_t*)(p.ws + OFF_YC);
    const int gt = blockIdx.x * NTHR + opaque_tid(), gn = gridDim.x * NTHR;
    for (int i = gt; i < TB * 128; i += gn) {
        const int s = i >> 7, k = (i & 127) * 8;
        const float* src; int j;
        if (s < NCX) { src = p.in[2] + ((size_t)(b * NCX + s)) * DM + k; j = 2; }
        else { src = p.in[0] + ((size_t)(b * NL + s - NCX)) * DM + k; j = b; }
        const float4 x0 = ld4(src), x1 = ld4(src + 4);
        const float* m = modv + j * 3072;
        const float4 s0 = ld4(m + k), s1 = ld4(m + k + 4), c0 = ld4(m + 1024 + k), c1 = ld4(m + 1024 + k + 4);
        *(uint4*)(H0 + (size_t)s * DM + k) = make_uint4(pack2bf(x0.x * (1.f + c0.x) + s0.x, x0.y * (1.f + c0.y) + s0.y), pack2bf(x0.z * (1.f + c0.z) + s0.z, x0.w * (1.f + c0.w) + s0.w),
                                                      pack2bf(x1.x * (1.f + c1.x) + s1.x, x1.y * (1.f + c1.y) + s1.y), pack2bf(x1.z * (1.f + c1.z) + s1.z, x1.w * (1.f + c1.w) + s1.w));
    }
}

DEV void phase_mod(const Params& p, float* sm) {
    const float* c = p.in[1]; const float* cctx = p.in[3];
    const float* mod_w = p.in[4]; const float* mod_b = p.in[5];
    float* modv = (float*)(p.ws + OFF_MODV);
    float* sil = sm; float* red = sm + 3072;
    const int tid = opaque_tid();
    for (int i = tid; i < 3072; i += NTHR) {
        const int j = i >> 10, k = i & 1023;
        const float v = (j < 2) ? c[j * 1024 + k] : cctx[k];
        sil[i] = silu_f(v);
    }
    __syncthreads();
    for (int unit = blockIdx.x; unit < 192; unit += gridDim.x) {
        const int l = unit / 96, cb = unit % 96;
        const int kg = tid >> 5, col = tid & 31, n = cb * 32 + col;
        const float* w = mod_w + (size_t)l * 1024 * 3072 + n;
        float a0 = 0.f, a1 = 0.f, a2 = 0.f;
        for (int k = kg * 64; k < kg * 64 + 64; ++k) {
            const float wv = w[(size_t)k * 3072];
            a0 += sil[k] * wv; a1 += sil[1024 + k] * wv; a2 += sil[2048 + k] * wv;
        }
        red[(kg * 3 + 0) * 32 + col] = a0; red[(kg * 3 + 1) * 32 + col] = a1; red[(kg * 3 + 2) * 32 + col] = a2;
        __syncthreads();
        if (tid < 96) {
            const int j = tid >> 5, cc = tid & 31, nn = cb * 32 + cc;
            float s = mod_b[l * 3072 + nn];
            for (int g = 0; g < 16; ++g) s += red[(g * 3 + j) * 32 + cc];
            modv[(l * 3 + j) * 3072 + nn] = s;
        }
        __syncthreads();
    }
}

DEV void phase_tables(const Params& p) {
    const float* wq = p.in[33]; const float* wk = p.in[34]; const float* wv = p.in[35];
    const float* gw0 = p.in[36]; const float* gw1 = p.in[38]; const float* gw2 = p.in[40]; const float* gw3 = p.in[42];
    float* gtab = (float*)(p.ws + OFF_GTAB); bf16_t* wft = (bf16_t*)(p.ws + OFF_WFT);
    const int gt = blockIdx.x * NTHR + opaque_tid(), gn = gridDim.x * NTHR;
    for (int i = gt; i < 512 * 16; i += gn) {
        const int gb = i >> 4, cp = (i >> 2) & 3, c = i & 3;
        float s = 0.f;
#pragma unroll
        for (int d = 0; d < 4; ++d) s += wq[gb * 16 + cp * 4 + d] * wk[gb * 16 + c * 4 + d];
        gtab[i] = s * KSCALE;
    }
    for (int i = gt; i < 4096 * 16; i += gn) {
        const int g = i >> 12, k = i & 4095, gm = g >> 2, hd = g & 3;
        const float* wg = gm == 0 ? gw0 : (gm == 1 ? gw1 : (gm == 2 ? gw2 : gw3));
        float s = 0.f;
        if (k < 2048) {
            const int blk = k >> 2, cc = k & 3;
#pragma unroll
            for (int d = 0; d < 4; ++d) s += wq[blk * 16 + cc * 4 + d] * wg[(size_t)(4 * blk + d) * 4 + hd] + wk[blk * 16 + cc * 4 + d] * wg[(size_t)(2048 + 4 * blk + d) * 4 + hd];
        } else {
            const int kk = k - 2048, blk = kk >> 2, cc = kk & 3;
#pragma unroll
            for (int d = 0; d < 4; ++d) s += wv[blk * 16 + cc * 4 + d] * wg[(size_t)(4096 + 4 * blk + d) * 4 + hd];
        }
        wft[i] = __builtin_bit_cast(unsigned short, (__bf16)s);
    }
}

DEV float wave_scan_add(float v, int lane, int dir) {
#pragma unroll
    for (int o = 1; o < 64; o <<= 1) {
        const float n = dir ? __shfl_down(v, o, 64) : __shfl_up(v, o, 64);
        const bool ok = dir ? (lane + o < 64) : (lane >= o);
        if (ok) v += n;
    }
    return v;
}
DEV float wave_scan_max(float v, int lane, int dir) {
#pragma unroll
    for (int o = 1; o < 64; o <<= 1) {
        const float n = dir ? __shfl_down(v, o, 64) : __shfl_up(v, o, 64);
        const bool ok = dir ? (lane + o < 64) : (lane >= o);
        if (ok) v = fmaxf(v, n);
    }
    return v;
}

DEV void gla_decay(const bf16_t* P0, int c, int h, int dir, const float* __restrict__ wa2, const float* __restrict__ ba,
                   float* sLR, float* sWA, float* sBC, float* sTot, int tid) {
    for (int i = tid; i < 1024; i += NTHR) { const int t = i >> 4, j = i & 15; sLR[i] = bf2f(P0[(size_t)(c * 64 + t) * EIN + 1536 + dir * 16 + j]); }
    for (int i = tid; i < 1024; i += NTHR) { const int ii = i >> 6, k = i & 63; sWA[i] = wa2[ii * 256 + h * 64 + k]; }
    __syncthreads();
    {
        const int t = tid >> 3, k0 = (tid & 7) * 8;
        float acc[8];
#pragma unroll
        for (int j = 0; j < 8; ++j) acc[j] = ba[h * 64 + k0 + j];
#pragma unroll
        for (int ii = 0; ii < 16; ++ii) {
            const float l = sLR[t * 16 + ii];
#pragma unroll
            for (int j = 0; j < 8; ++j) acc[j] += l * sWA[ii * 64 + k0 + j];
        }
#pragma unroll
        for (int j = 0; j < 8; ++j) sBC[t * 65 + k0 + j] = logsig_f(acc[j]) * 0.0625f;
    }
    __syncthreads();
    {
        const int lane = tid & 63, wv = tid >> 6;
#pragma unroll
        for (int j = 0; j < 8; ++j) {
            const int k = wv * 8 + j;
            const float v = wave_scan_add(sBC[lane * 65 + k], lane, dir);
            sBC[lane * 65 + k] = v;
            if (lane == (dir ? 0 : 63)) sTot[k] = v;
        }
    }
    __syncthreads();
}
DEV bf16x8 tr_frag(const bf16_t* base, int ld, int row0, int col0, int lane) {
    const bf16_t* ptr = base + (row0 + (lane >> 4) * 8 + ((lane & 15) >> 2)) * ld + col0 + (lane & 3) * 4;
    const s16x4 lo = __builtin_amdgcn_ds_read_tr16_b64_v4i16((__attribute__((address_space(3))) s16x4*)ptr);
    const s16x4 hi = __builtin_amdgcn_ds_read_tr16_b64_v4i16((__attribute__((address_space(3))) s16x4*)(ptr + 4 * ld));
    return (bf16x8){lo[0], lo[1], lo[2], lo[3], hi[0], hi[1], hi[2], hi[3]};
}
DEV bf16x8 row_frag(const bf16_t* base, int ld, int idx0, int k0, int lane) {
    return *(const bf16x8*)(base + (idx0 + (lane & 15)) * ld + k0 + (lane >> 4) * 8);
}

DEV void gla1_unit(const Params& p, int h, int dir, int c, float* sm) {
    const int tid = opaque_tid(), lane = tid & 63, wave = tid >> 6;
    const bf16_t* P0 = (const bf16_t*)(p.ws + OFF_P0);
    float* GDS = (float*)(p.ws + OFF_GDS); float* GDEC = (float*)(p.ws + OFF_GDEC);
    const float* wa2 = p.in[dir ? 12 : 10]; const float* ba = p.in[dir ? 13 : 11];
    float* sLR = sm; float* sWA = sm + 1024; float* sBC = sm + 2048; float* sTot = sm + 6208;
    bf16_t* kT = (bf16_t*)(sm + 6272);
    bf16_t* Vs = (bf16_t*)(sm + 8576);
    const int ch = h * 2 + dir;
    __syncthreads();
    gla_decay(P0, c, h, dir, wa2, ba, sLR, sWA, sBC, sTot, tid);
    {
        const int t = tid >> 3, k0 = (tid & 7) * 8;
        float kv[8]; unpack8(*(const uint4*)(P0 + (size_t)(c * 64 + t) * EIN + 256 + h * 64 + k0), kv);
#pragma unroll
        for (int j = 0; j < 8; ++j) kT[(k0 + j) * 72 + t] = __builtin_bit_cast(unsigned short, (__bf16)(kv[j] * fexp(sTot[k0 + j] - sBC[t * 65 + k0 + j])));
#pragma unroll
        for (int u = 0; u < 2; ++u) { const int i = tid + 512 * u, row = i >> 4, c16 = i & 15; *(uint4*)(Vs + row * 136 + c16 * 8) = *(const uint4*)(P0 + (size_t)(c * 64 + row) * EIN + 512 + h * 128 + c16 * 8); }
    }
    __syncthreads();
    {
        f32x4 acc[4];
#pragma unroll
        for (int kt = 0; kt < 4; ++kt) acc[kt] = (f32x4){0.f, 0.f, 0.f, 0.f};
#pragma unroll
        for (int ks = 0; ks < 2; ++ks) {
            const bf16x8 af = tr_frag(Vs, 136, ks * 32, wave * 16, lane);
#pragma unroll
            for (int kt = 0; kt < 4; ++kt) acc[kt] = __builtin_amdgcn_mfma_f32_16x16x32_bf16(af, row_frag(kT, 72, kt * 16, ks * 32, lane), acc[kt], 0, 0, 0);
        }
#pragma unroll
        for (int kt = 0; kt < 4; ++kt) {
            const int k = kt * 16 + (lane & 15), v = wave * 16 + (lane >> 4) * 4;
            st4(GDS + ((size_t)(ch * NCH + c) * 64 + k) * 128 + v, make_float4(acc[kt][0], acc[kt][1], acc[kt][2], acc[kt][3]));
        }
    }
    if (tid < 64) GDEC[(size_t)(ch * NCH + c) * 64 + tid] = fexp(sTot[tid]);
}

DEV void gla2_unit(const Params& p, int unit) {
    const int tid = opaque_tid();
    float* GDS = (float*)(p.ws + OFF_GDS); const float* GDEC = (const float*)(p.ws + OFF_GDEC);
    const int ch = unit >> 4, e = (unit & 15) * 512 + tid, k = e >> 7, dir = ch & 1;
    constexpr int GB = 12;
    float S = 0.f, ninc[GB], nd[GB];
#pragma unroll
    for (int j = 0; j < GB; ++j) { const int c = chunk_at(dir, j); ninc[j] = GDS[(size_t)(ch * NCH + c) * 8192 + e]; nd[j] = GDEC[(size_t)(ch * NCH + c) * 64 + k]; }
#pragma unroll 1
    for (int step0 = 0; step0 < NCH; step0 += GB) {
        float inc[GB], d[GB];
#pragma unroll
        for (int j = 0; j < GB; ++j) { inc[j] = ninc[j]; d[j] = nd[j]; }
#pragma unroll
        for (int j = 0; j < GB; ++j) { const int sn = step0 + GB + j, c = chunk_at(dir, sn < NCH ? sn : NCH - 1); ninc[j] = GDS[(size_t)(ch * NCH + c) * 8192 + e]; nd[j] = GDEC[(size_t)(ch * NCH + c) * 64 + k]; }
        __builtin_amdgcn_sched_barrier(0);
#pragma unroll
        for (int j = 0; j < GB; ++j) { const int c = chunk_at(dir, step0 + j); GDS[(size_t)(ch * NCH + c) * 8192 + e] = S; S = d[j] * S + inc[j]; }
    }
}

DEV void gla3_unit(const Params& p, int h, int c, float* sm) {
    const int tid = opaque_tid(), lane = tid & 63, wave = tid >> 6;
    const bf16_t* P0 = (const bf16_t*)(p.ws + OFF_P0);
    const float* GDS = (const float*)(p.ws + OFF_GDS);
    bf16_t* YC = (bf16_t*)(p.ws + OFF_YC);
    const float* ng = p.in[14];
    float* sLR = sm; float* sWA = sm + 1024; float* sBC = sm + 2048; float* sTot = sm + 6208;
    bf16_t* qt = (bf16_t*)(sm + 6272);
    bf16_t* kt = (bf16_t*)(sm + 8576);
    bf16_t* Sm = (bf16_t*)(sm + 10880);
    bf16_t* S0s = (bf16_t*)(sm + 13184);
    bf16_t* Vs = (bf16_t*)(sm + 17536);
    float* O = sm + 21888;
    const int ti = wave & 3, vt0 = (wave >> 2) * 4;
    f32x4 acc[4];
#pragma unroll
    for (int j = 0; j < 4; ++j) acc[j] = (f32x4){0.f, 0.f, 0.f, 0.f};
    __syncthreads();
#pragma unroll
    for (int u = 0; u < 2; ++u) { const int i = tid + 512 * u, row = i >> 4, c16 = i & 15; *(uint4*)(Vs + row * 136 + c16 * 8) = *(const uint4*)(P0 + (size_t)(c * 64 + row) * EIN + 512 + h * 128 + c16 * 8); }
#pragma unroll 1
    for (int dir = 0; dir < 2; ++dir) {
        const float* wa2 = p.in[dir ? 12 : 10]; const float* ba = p.in[dir ? 13 : 11];
        const int ch = h * 2 + dir;
        __syncthreads();
        gla_decay(P0, c, h, dir, wa2, ba, sLR, sWA, sBC, sTot, tid);
        {
            const int t = tid >> 3, k0 = (tid & 7) * 8;
            float qv[8], kv[8];
            unpack8(*(const uint4*)(P0 + (size_t)(c * 64 + t) * EIN + h * 64 + k0), qv);
            unpack8(*(const uint4*)(P0 + (size_t)(c * 64 + t) * EIN + 256 + h * 64 + k0), kv);
#pragma unroll
            for (int j = 0; j < 8; ++j) { const float bc = sBC[t * 65 + k0 + j]; qv[j] *= 0.125f * fexp(bc); kv[j] *= fexp(-bc); }
            *(uint4*)(qt + t * 72 + k0) = make_uint4(pack2bf(qv[0], qv[1]), pack2bf(qv[2], qv[3]), pack2bf(qv[4], qv[5]), pack2bf(qv[6], qv[7]));
            *(uint4*)(kt + t * 72 + k0) = make_uint4(pack2bf(kv[0], kv[1]), pack2bf(kv[2], kv[3]), pack2bf(kv[4], kv[5]), pack2bf(kv[6], kv[7]));
#pragma unroll
            for (int u = 0; u < 4; ++u) {
                const int i = tid + 512 * u, k = i >> 5, v4 = (i & 31) * 4;
                const float4 s4 = ld4(GDS + (size_t)(ch * NCH + c) * 8192 + k * 128 + v4);
                *(uint2*)(S0s + k * 136 + v4) = make_uint2(pack2bf(s4.x, s4.y), pack2bf(s4.z, s4.w));
            }
        }
        __syncthreads();
        {
            const int si = wave & 3;
#pragma unroll
            for (int jj = 0; jj < 2; ++jj) {
                const int t2 = (wave >> 2) * 2 + jj;
                f32x4 a = (f32x4){0.f, 0.f, 0.f, 0.f};
#pragma unroll
                for (int ks = 0; ks < 2; ++ks) a = __builtin_amdgcn_mfma_f32_16x16x32_bf16(row_frag(kt, 72, si * 16, ks * 32, lane), row_frag(qt, 72, t2 * 16, ks * 32, lane), a, 0, 0, 0);
                const int t = t2 * 16 + (lane & 15), s0 = si * 16 + (lane >> 4) * 4;
                float m[4];
#pragma unroll
                for (int r = 0; r < 4; ++r) { const bool keep = dir ? (s0 + r >= t) : (s0 + r <= t); m[r] = keep ? a[r] : 0.f; }
                *(uint2*)(Sm + t * 72 + s0) = make_uint2(pack2bf(m[0], m[1]), pack2bf(m[2], m[3]));
            }
        }
        __syncthreads();
#pragma unroll
        for (int ks = 0; ks < 2; ++ks) {
            const bf16x8 a1 = row_frag(qt, 72, ti * 16, ks * 32, lane), a2 = row_frag(Sm, 72, ti * 16, ks * 32, lane);
#pragma unroll
            for (int j = 0; j < 4; ++j) {
                acc[j] = __builtin_amdgcn_mfma_f32_16x16x32_bf16(a1, tr_frag(S0s, 136, ks * 32, (vt0 + j) * 16, lane), acc[j], 0, 0, 0);
                acc[j] = __builtin_amdgcn_mfma_f32_16x16x32_bf16(a2, tr_frag(Vs, 136, ks * 32, (vt0 + j) * 16, lane), acc[j], 0, 0, 0);
            }
        }
    }
#pragma unroll
    for (int j = 0; j < 4; ++j)
#pragma unroll
        for (int r = 0; r < 4; ++r) O[(ti * 16 + (lane >> 4) * 4 + r) * 132 + (vt0 + j) * 16 + (lane & 15)] = acc[j][r];
    __syncthreads();
    {
        const int t = tid >> 3, v0 = (tid & 7) * 16;
        float o[16];
        float ss = 0.f;
#pragma unroll
        for (int i = 0; i < 16; ++i) { o[i] = O[t * 132 + v0 + i]; ss += o[i] * o[i]; }
        ss += __shfl_xor(ss, 1, 64); ss += __shfl_xor(ss, 2, 64); ss += __shfl_xor(ss, 4, 64);
        const float rms = rsqrtf(ss * (1.f / 128.f) + 1e-5f);
        float g[16];
        const bf16_t* gp = P0 + (size_t)(c * 64 + t) * EIN + 1024 + h * 128 + v0;
        unpack8(*(const uint4*)gp, g); unpack8(*(const uint4*)(gp + 8), g + 8);
        float y[16];
#pragma unroll
        for (int i = 0; i < 16; ++i) y[i] = o[i] * rms * ng[v0 + i] * silu_f(g[i]);
        bf16_t* yp = YC + (size_t)(c * 64 + t) * 1024 + h * 128 + v0;
        *(uint4*)yp = make_uint4(pack2bf(y[0], y[1]), pack2bf(y[2], y[3]), pack2bf(y[4], y[5]), pack2bf(y[6], y[7]));
        *(uint4*)(yp + 8) = make_uint4(pack2bf(y[8], y[9]), pack2bf(y[10], y[11]), pack2bf(y[12], y[13]), pack2bf(y[14], y[15]));
    }
}

DEV void load8bf(const bf16_t* ptr, float* f) { unpack8(*(const uint4*)ptr, f); }
DEV void rw_mix8(const bf16_t* P0, int s, int cb, const float* __restrict__ mu, float* out) {
    float own[8]; load8bf(P0 + (size_t)s * EIN + RW0 + cb, own);
    int nL = -1, nR = -1, nU = -1, nD = -1;
    if (s < NCX) { if (s > 0) nL = s - 1; if (s < NCX - 1) nR = s + 1; }
    else { const int n = s - NCX, rr = n >> 6, cc = n & 63; if (cc > 0) nL = s - 1; if (cc < 63) nR = s + 1; if (rr > 0) nU = s - 64; if (rr < 127) nD = s + 64; }
    float fL[8], fR[8], fU[8], fD[8];
#pragma unroll
    for (int i = 0; i < 8; ++i) { fL[i] = 0.f; fR[i] = 0.f; fU[i] = 0.f; fD[i] = 0.f; }
    if (nL >= 0) load8bf(P0 + (size_t)nL * EIN + RW0 + cb, fL);
    if (nR >= 0) load8bf(P0 + (size_t)nR * EIN + RW0 + cb, fR);
    if (nU >= 0) load8bf(P0 + (size_t)nU * EIN + RW0 + cb, fU);
    if (nD >= 0) load8bf(P0 + (size_t)nD * EIN + RW0 + cb, fD);
    const float4 m0 = ld4(mu + cb), m1 = ld4(mu + cb + 4);
    const float m[8] = {m0.x, m0.y, m0.z, m0.w, m1.x, m1.y, m1.z, m1.w};
#pragma unroll
    for (int i = 0; i < 8; ++i) { const float nb = (i & 3) == 0 ? fL[i] : ((i & 3) == 1 ? fR[i] : ((i & 3) == 2 ? fU[i] : fD[i])); out[i] = own[i] + (nb - own[i]) * m[i]; }
}
DEV uint4 pack8(const float* f) { return make_uint4(pack2bf(f[0], f[1]), pack2bf(f[2], f[3]), pack2bf(f[4], f[5]), pack2bf(f[6], f[7])); }

template <int XM, int YM, class F>
DEV void mm64(const bf16_t* X, const bf16_t* Y, F f, int lane, int wave) {
#pragma unroll
    for (int q = 0; q < 2; ++q) {
        const int idx = wave * 2 + q, ti = idx >> 2, tj = idx & 3;
        f32x4 acc = (f32x4){0.f, 0.f, 0.f, 0.f};
#pragma unroll
        for (int ks = 0; ks < 2; ++ks) {
            const bf16x8 a = XM == 0 ? row_frag(X, 72, ti * 16, ks * 32, lane) : tr_frag(X, 72, ks * 32, ti * 16, lane);
            const bf16x8 bq = YM == 0 ? row_frag(Y, 72, tj * 16, ks * 32, lane) : tr_frag(Y, 72, ks * 32, tj * 16, lane);
            acc = __builtin_amdgcn_mfma_f32_16x16x32_bf16(a, bq, acc, 0, 0, 0);
        }
        f(ti * 16 + (lane >> 4) * 4, tj * 16 + (lane & 15), acc);
    }
}
template <int XM, int YM, class F>
DEV void mm64x2(const bf16_t* X1, const bf16_t* Y1, const bf16_t* X2, const bf16_t* Y2, F f, int lane, int wave) {
#pragma unroll
    for (int q = 0; q < 2; ++q) {
        const int idx = wave * 2 + q, ti = idx >> 2, tj = idx & 3;
        f32x4 acc = (f32x4){0.f, 0.f, 0.f, 0.f};
#pragma unroll
        for (int ks = 0; ks < 2; ++ks) {
            const bf16x8 a = XM == 0 ? row_frag(X1, 72, ti * 16, ks * 32, lane) : tr_frag(X1, 72, ks * 32, ti * 16, lane);
            const bf16x8 bq = YM == 0 ? row_frag(Y1, 72, tj * 16, ks * 32, lane) : tr_frag(Y1, 72, ks * 32, tj * 16, lane);
            acc = __builtin_amdgcn_mfma_f32_16x16x32_bf16(a, bq, acc, 0, 0, 0);
            const bf16x8 a2 = XM == 0 ? row_frag(X2, 72, ti * 16, ks * 32, lane) : tr_frag(X2, 72, ks * 32, ti * 16, lane);
            const bf16x8 b2 = YM == 0 ? row_frag(Y2, 72, tj * 16, ks * 32, lane) : tr_frag(Y2, 72, ks * 32, tj * 16, lane);
            acc = __builtin_amdgcn_mfma_f32_16x16x32_bf16(a2, b2, acc, 0, 0, 0);
        }
        f(ti * 16 + (lane >> 4) * 4, tj * 16 + (lane & 15), acc);
    }
}
DEV void st_img(bf16_t* P, int i0, int j, float a0, float a1, float a2, float a3) {
    P[(i0 + 0) * 72 + j] = __builtin_bit_cast(unsigned short, (__bf16)a0); P[(i0 + 1) * 72 + j] = __builtin_bit_cast(unsigned short, (__bf16)a1);
    P[(i0 + 2) * 72 + j] = __builtin_bit_cast(unsigned short, (__bf16)a2); P[(i0 + 3) * 72 + j] = __builtin_bit_cast(unsigned short, (__bf16)a3);
}

DEV void rwkv1_unit(const Params& p, int h, int dir, int c, float* sm) {
    const int tid = opaque_tid(), lane = tid & 63, wave = tid >> 6;
    const bf16_t* P0 = (const bf16_t*)(p.ws + OFF_P0);
    bf16_t* RU = (bf16_t*)(p.ws + OFF_RU) + (size_t)((h * 2 + dir) * NCH + c) * 16384;
    float* BONS = (float*)(p.ws + OFF_BONS);
    const float* mu = p.in[15];
    const float* w0 = p.in[dir ? 18 : 16]; const float* ww2 = p.in[dir ? 19 : 17];
    const float* a0 = p.in[dir ? 22 : 20]; const float* wa2 = p.in[dir ? 23 : 21];
    bf16_t* img = (bf16_t*)sm;
#define SLOT(i_) (img + (i_) * 4608)
    float* fLW = (float*)SLOT(10);
    float* fAS = (float*)SLOT(12);
    float* sv = (float*)SLOT(14);
    const int t = tid >> 3, j0 = (tid & 7) * 8, s = c * 64 + t;
    __syncthreads();
    if (tid < 64) { const int hc = h * 64 + tid; sv[64 + tid] = w0[hc]; sv[128 + tid] = a0[hc]; sv[192 + tid] = p.in[24][hc]; sv[256 + tid] = p.in[25][hc]; sv[320 + tid] = p.in[26][hc]; }
    float r8[8], k8[8], v8[8];
    {
        float x8[8];
        rw_mix8(P0, s, h * 64 + j0, mu, r8);
        rw_mix8(P0, s, 512 + h * 64 + j0, mu, k8);
        rw_mix8(P0, s, 1024 + h * 64 + j0, mu, v8);
        rw_mix8(P0, s, 2048 + dir * 64 + j0, mu, x8);
#pragma unroll
        for (int i = 0; i < 8; ++i) x8[i] = tanh_f(x8[i]);
        *(uint4*)(SLOT(6) + t * 72 + j0) = pack8(x8);
        rw_mix8(P0, s, 2176 + dir * 64 + j0, mu, x8);
        *(uint4*)(SLOT(7) + t * 72 + j0) = pack8(x8);
        float wq[8];
        { const float4 q0 = ld4(ww2 + (size_t)t * 512 + h * 64 + j0), q1 = ld4(ww2 + (size_t)t * 512 + h * 64 + j0 + 4); wq[0] = q0.x; wq[1] = q0.y; wq[2] = q0.z; wq[3] = q0.w; wq[4] = q1.x; wq[5] = q1.y; wq[6] = q1.z; wq[7] = q1.w; }
        *(uint4*)(SLOT(8) + t * 72 + j0) = pack8(wq);
        { const float4 q0 = ld4(wa2 + (size_t)t * 512 + h * 64 + j0), q1 = ld4(wa2 + (size_t)t * 512 + h * 64 + j0 + 4); wq[0] = q0.x; wq[1] = q0.y; wq[2] = q0.z; wq[3] = q0.w; wq[4] = q1.x; wq[5] = q1.y; wq[6] = q1.z; wq[7] = q1.w; }
        *(uint4*)(SLOT(9) + t * 72 + j0) = pack8(wq);
    }
    __syncthreads();
    mm64<0, 1>(SLOT(6), SLOT(8), [=](int i0, int j, f32x4 a) {
#pragma unroll
        for (int r = 0; r < 4; ++r) fLW[(i0 + r) * 65 + j] = -0.6065306597f * sigmoid_f(sv[64 + j] + a[r]); }, lane, wave);
    mm64<0, 1>(SLOT(7), SLOT(9), [=](int i0, int j, f32x4 a) {
#pragma unroll
        for (int r = 0; r < 4; ++r) fAS[(i0 + r) * 65 + j] = sigmoid_f(sv[128 + j] + a[r]); }, lane, wave);
    __syncthreads();
#pragma unroll
    for (int j = 0; j < 8; ++j) {
        const int k = wave * 8 + j;
        const float v = wave_scan_add(fLW[lane * 65 + k], lane, dir);
        fLW[lane * 65 + k] = v;
        if (lane == (dir ? 0 : 63)) sv[k] = v;
    }
    __syncthreads();
    {
        float kkv[8], ss = 0.f;
#pragma unroll
        for (int i = 0; i < 8; ++i) { kkv[i] = k8[i] * sv[192 + j0 + i]; ss += kkv[i] * kkv[i]; }
        ss += __shfl_xor(ss, 1, 64); ss += __shfl_xor(ss, 2, 64); ss += __shfl_xor(ss, 4, 64);
        const float rn = rsqrtf(fmaxf(ss, 1e-24f));
        float fa[8], fb[8], fk[8], fr[8], fbp[8], fkp[8], bon = 0.f;
        const int tp = dir ? t + 1 : t - 1;
        const bool hasp = dir ? (t < 63) : (t > 0);
#pragma unroll
        for (int i = 0; i < 8; ++i) {
            const int k = j0 + i;
            const float Bt = fLW[t * 65 + k], Bx = hasp ? fLW[tp * 65 + k] : 0.f, asg = fAS[t * 65 + k];
            const float kk = kkv[i] * rn, kh = k8[i] * (1.f + (asg - 1.f) * sv[256 + k]);
            bon += r8[i] * kh * sv[320 + k];
            const float enB = fexp(-Bt), eLB = fexp(sv[k] - Bt), bv = kk * asg;
            fa[i] = -kk * fexp(Bx); fb[i] = bv * enB; fk[i] = kh * enB; fr[i] = r8[i] * fexp(Bt); fbp[i] = bv * eLB; fkp[i] = kh * eLB;
        }
        bon += __shfl_xor(bon, 1, 64); bon += __shfl_xor(bon, 2, 64); bon += __shfl_xor(bon, 4, 64);
        if ((tid & 7) == 0) BONS[((size_t)dir * TB + s) * 8 + h] = bon;
        *(uint4*)(SLOT(0) + t * 72 + j0) = pack8(fa); *(uint4*)(SLOT(1) + t * 72 + j0) = pack8(fb); *(uint4*)(SLOT(2) + t * 72 + j0) = pack8(fk);
        *(uint4*)(SLOT(3) + t * 72 + j0) = pack8(fr); *(uint4*)(SLOT(4) + t * 72 + j0) = pack8(fbp); *(uint4*)(SLOT(5) + t * 72 + j0) = pack8(fkp);
    }
    __syncthreads();
    *(uint4*)(SLOT(6) + t * 72 + j0) = pack8(v8);
    __syncthreads();
    mm64<0, 0>(SLOT(0), SLOT(1), [=](int i0, int j, f32x4 a) {
        float m[4];
#pragma unroll
        for (int r = 0; r < 4; ++r) { const bool keep = dir ? (j > i0 + r) : (j < i0 + r); m[r] = keep ? a[r] : 0.f; }
        const bool dg = (i0 >> 4) == (j >> 4);
        st_img(SLOT(7), i0, j, dg ? m[0] : 0.f, dg ? m[1] : 0.f, dg ? m[2] : 0.f, dg ? m[3] : 0.f);
        st_img(SLOT(8), i0, j, (dg ? m[0] : 0.f) + (j == i0 ? 1.f : 0.f), (dg ? m[1] : 0.f) + (j == i0 + 1 ? 1.f : 0.f), (dg ? m[2] : 0.f) + (j == i0 + 2 ? 1.f : 0.f), (dg ? m[3] : 0.f) + (j == i0 + 3 ? 1.f : 0.f));
        st_img(SLOT(12), i0, j, dg ? 0.f : m[0], dg ? 0.f : m[1], dg ? 0.f : m[2], dg ? 0.f : m[3]); }, lane, wave);
    mm64<0, 0>(SLOT(0), SLOT(2), [=](int i0, int j, f32x4 a) {
        float m[4];
#pragma unroll
        for (int r = 0; r < 4; ++r) { const bool keep = dir ? (j > i0 + r) : (j < i0 + r); m[r] = keep ? a[r] : 0.f; }
        st_img(SLOT(9), i0, j, m[0], m[1], m[2], m[3]); }, lane, wave);
    mm64<0, 0>(SLOT(3), SLOT(1), [=](int i0, int j, f32x4 a) {
        float m[4];
#pragma unroll
        for (int r = 0; r < 4; ++r) { const bool keep = dir ? (j >= i0 + r) : (j <= i0 + r); m[r] = keep ? a[r] : 0.f; }
        st_img(SLOT(10), i0, j, m[0], m[1], m[2], m[3]); }, lane, wave);
    mm64<0, 0>(SLOT(3), SLOT(2), [=](int i0, int j, f32x4 a) {
        float m[4];
#pragma unroll
        for (int r = 0; r < 4; ++r) { const bool keep = dir ? (j >= i0 + r) : (j <= i0 + r); m[r] = keep ? a[r] : 0.f; }
        st_img(SLOT(11), i0, j, m[0], m[1], m[2], m[3]); }, lane, wave);
    __syncthreads();
    {
        bf16_t* Pc = SLOT(7); bf16_t* Pn = SLOT(1); bf16_t* Tc = SLOT(8); bf16_t* Tn = SLOT(2);
#pragma unroll 1
        for (int it = 0; it < 3; ++it) {
            mm64<0, 1>(Pc, Pc, [=](int i0, int j, f32x4 a) { st_img(Pn, i0, j, a[0], a[1], a[2], a[3]); }, lane, wave);
            __syncthreads();
            mm64<0, 1>(Tc, Pn, [=](int i0, int j, f32x4 a) {
                st_img(Tn, i0, j, a[0] + bf2f(Tc[(i0 + 0) * 72 + j]), a[1] + bf2f(Tc[(i0 + 1) * 72 + j]), a[2] + bf2f(Tc[(i0 + 2) * 72 + j]), a[3] + bf2f(Tc[(i0 + 3) * 72 + j])); }, lane, wave);
            __syncthreads();
            bf16_t* tmp = Pc; Pc = Pn; Pn = tmp; tmp = Tc; Tc = Tn; Tn = tmp;
        }
    }
    mm64<0, 1>(SLOT(2), SLOT(12), [=](int i0, int j, f32x4 a) { st_img(SLOT(7), i0, j, a[0], a[1], a[2], a[3]); }, lane, wave);
    mm64<0, 1>(SLOT(2), SLOT(0), [=](int i0, int j, f32x4 a) { st_img(SLOT(1), i0, j, a[0], a[1], a[2], a[3]); }, lane, wave);
    mm64<0, 1>(SLOT(9), SLOT(6), [=](int i0, int j, f32x4 a) { st_img(SLOT(13), i0, j, a[0], a[1], a[2], a[3]); }, lane, wave);
    __syncthreads();
    mm64<0, 1>(SLOT(2), SLOT(13), [=](int i0, int j, f32x4 a) { st_img(SLOT(8), i0, j, a[0], a[1], a[2], a[3]); }, lane, wave);
    __syncthreads();
    {
        const bf16_t* Zp = (wave < 4) ? SLOT(1) : SLOT(8);
        bf16_t* Xi = (wave < 4) ? SLOT(12) : SLOT(9);
        const int ct = (wave & 3) * 16, g4 = (lane >> 4) * 4, l15 = lane & 15;
#pragma unroll
        for (int bs = 0; bs < 4; ++bs) {
            const int bi = dir ? 3 - bs : bs;
            f32x4 acc;
#pragma unroll
            for (int r = 0; r < 4; ++r) acc[r] = bf2f(Zp[(bi * 16 + g4 + r) * 72 + ct + l15]);
            const bool k0 = dir ? (bi == 0) : (bi >= 1), k1 = dir ? (bi <= 2) : (bi == 3);
            if (k0) acc = __builtin_amdgcn_mfma_f32_16x16x32_bf16(row_frag(SLOT(7), 72, bi * 16, 0, lane), tr_frag(Xi, 72, 0, ct, lane), acc, 0, 0, 0);
            if (k1) acc = __builtin_amdgcn_mfma_f32_16x16x32_bf16(row_frag(SLOT(7), 72, bi * 16, 32, lane), tr_frag(Xi, 72, 32, ct, lane), acc, 0, 0, 0);
            st_img(Xi, bi * 16 + g4, ct + l15, acc[0], acc[1], acc[2], acc[3]);
            __syncthreads();
        }
    }
    mm64<1, 1>(SLOT(12), SLOT(4), [=](int i0, int j, f32x4 a) {
        float m[4];
#pragma unroll
        for (int r = 0; r < 4; ++r) m[r] = a[r] + ((i0 + r) == j ? fexp(sv[j]) : 0.f);
        *(uint2*)(RU + j * 64 + i0) = make_uint2(pack2bf(m[0], m[1]), pack2bf(m[2], m[3])); }, lane, wave);
    mm64x2<1, 1>(SLOT(4), SLOT(9), SLOT(5), SLOT(6), [=](int i0, int j, f32x4 a) {
        *(uint2*)(RU + 4096 + j * 64 + i0) = make_uint2(pack2bf(a[0], a[1]), pack2bf(a[2], a[3])); }, lane, wave);
    mm64<1, 0>(SLOT(12), SLOT(10), [=](int i0, int j, f32x4 a) {
        const uint2 rr = *(const uint2*)(SLOT(3) + j * 72 + i0);
        *(uint2*)(RU + 8192 + j * 64 + i0) = make_uint2(pack2bf(a[0] + bflo(rr.x), a[1] + bfhi(rr.x)), pack2bf(a[2] + bflo(rr.y), a[3] + bfhi(rr.y))); }, lane, wave);
    mm64x2<0, 1>(SLOT(10), SLOT(9), SLOT(11), SLOT(6), [=](int i0, int j, f32x4 a) {
        *(uint2*)(RU + 12288 + j * 64 + i0) = make_uint2(pack2bf(a[0], a[1]), pack2bf(a[2], a[3])); }, lane, wave);
#undef SLOT
}

#define R2_LOAD(M_, C_, rnd_) do { const int r0_ = ((rnd_) < R2_NR ? (rnd_) : R2_NR - 1) * R2_RS; \
    _Pragma("unroll") for (int s_ = 0; s_ < R2_RS; ++s_) M_[s_] = *(const uint4*)(RU + (size_t)(chain * NCH + chunk_at(dir, r0_ + s_)) * 16384 + tid * 8); \
    _Pragma("unroll") for (int j_ = 0; j_ < 3; ++j_) { const int cq_ = tid + 512 * j_; \
        C_[j_] = *(const uint4*)(RU + (size_t)(chain * NCH + chunk_at(dir, r0_ + (cq_ >> 7))) * 16384 + 4096 + (vblk * 16 + ((cq_ >> 3) & 15)) * 64 + (cq_ & 7) * 8); } } while (0)
#define R2_ROUND(M_, C_, rnd_) do { \
    { const int row_ = tid >> 3, c8_ = tid & 7, sw_ = (row_ >> 1) & 7, u0_ = (c8_ >> 2) * 4 + (c8_ & 1) * 2, eh_ = ((c8_ >> 1) & 1) * 8; \
      _Pragma("unroll") for (int s_ = 0; s_ < R2_RS; ++s_) { char* sl_ = ring + s_ * 10240 + row_ * 128 + eh_; \
          *(uint2*)(sl_ + ((u0_ ^ sw_) * 16)) = make_uint2(M_[s_].x, M_[s_].y); *(uint2*)(sl_ + (((u0_ + 1) ^ sw_) * 16)) = make_uint2(M_[s_].z, M_[s_].w); } \
      _Pragma("unroll") for (int j_ = 0; j_ < 3; ++j_) { const int cq_ = tid + 512 * j_, rw_ = (cq_ >> 3) & 15, q8_ = cq_ & 7, i_ = q8_ >> 1, g0_ = (q8_ & 1) * 2, sc_ = (rw_ >> 1) & 7; \
          char* sl_ = ring + (cq_ >> 7) * 10240 + 8192 + rw_ * 128 + (i_ & 1) * 8; \
          *(uint2*)(sl_ + (((g0_ * 2 + (i_ >> 1)) ^ sc_) * 16)) = make_uint2(C_[j_].x, C_[j_].y); *(uint2*)(sl_ + ((((g0_ + 1) * 2 + (i_ >> 1)) ^ sc_) * 16)) = make_uint2(C_[j_].z, C_[j_].w); } } \
    R2_LOAD(M_, C_, (rnd_) + 2); \
    __syncthreads(); \
    if (wave == 0) { \
        _Pragma("unroll 4") for (int s_ = 0; s_ < R2_RS; ++s_) { \
            const int c_ = chunk_at(dir, (rnd_) * R2_RS + s_); const char* sl_ = ring + s_ * 10240; \
            unsigned pk_[4][2]; \
            _Pragma("unroll") for (int i_ = 0; i_ < 4; ++i_) { pk_[i_][0] = pack2bf(st[i_][0], st[i_][1]); pk_[i_][1] = pack2bf(st[i_][2], st[i_][3]); } \
            bf16_t* sp_ = S0G + ((size_t)(chain * NCH + c_) * 64 + vblk * 16 + l15) * 64 + g * 4; \
            _Pragma("unroll") for (int i_ = 0; i_ < 4; ++i_) *(uint2*)(sp_ + i_ * 16) = make_uint2(pk_[i_][0], pk_[i_][1]); \
            bf16x8 bfr_[2]; \
            _Pragma("unroll") for (int ks_ = 0; ks_ < 2; ++ks_) { const uint4 u_ = make_uint4(pk_[2 * ks_][0], pk_[2 * ks_][1], pk_[2 * ks_ + 1][0], pk_[2 * ks_ + 1][1]); bfr_[ks_] = __builtin_bit_cast(bf16x8, u_); } \
            const uint4 c01_ = *(const uint4*)(sl_ + 8192 + l15 * 128 + (((g * 2) ^ ((l15 >> 1) & 7)) * 16)), c23_ = *(const uint4*)(sl_ + 8192 + l15 * 128 + (((g * 2 + 1) ^ ((l15 >> 1) & 7)) * 16)); \
            const unsigned cw_[8] = {c01_.x, c01_.y, c01_.z, c01_.w, c23_.x, c23_.y, c23_.z, c23_.w}; \
            _Pragma("unroll") for (int i_ = 0; i_ < 4; ++i_) { \
                f32x4 acc_ = (f32x4){bflo(cw_[2 * i_]), bfhi(cw_[2 * i_]), bflo(cw_[2 * i_ + 1]), bfhi(cw_[2 * i_ + 1])}; \
                _Pragma("unroll") for (int ks_ = 0; ks_ < 2; ++ks_) { \
                    const int row_ = i_ * 16 + l15; \
                    const bf16x8 af_ = *(const bf16x8*)(sl_ + row_ * 128 + (((ks_ * 4 + g) ^ ((row_ >> 1) & 7)) * 16)); \
                    acc_ = __builtin_amdgcn_mfma_f32_16x16x32_bf16(af_, bfr_[ks_], acc_, 0, 0, 0); } \
                st[i_] = acc_; } } } \
    __syncthreads(); } while (0)
DEV void rwkv2_unit(const Params& p, int chain, int vblk, float* sm) {
    constexpr int R2_RS = 12, R2_NR = NCH / R2_RS;
    static_assert(R2_NR * R2_RS == NCH && R2_RS * 10240 <= LDS_BYTES, "R2 ring");
    const int tid = opaque_tid(), lane = tid & 63, wave = tid >> 6;
    const bf16_t* RU = (const bf16_t*)(p.ws + OFF_RU);
    bf16_t* S0G = (bf16_t*)(p.ws + OFF_RS0);
    char* ring = (char*)sm;
    const int dir = chain & 1, g = lane >> 4, l15 = lane & 15;
    f32x4 st[4];
#pragma unroll
    for (int i = 0; i < 4; ++i) st[i] = (f32x4){0.f, 0.f, 0.f, 0.f};
    uint4 ma[R2_RS], ca[3], mb[R2_RS], cb[3];
    __syncthreads();
    R2_LOAD(ma, ca, 0); R2_LOAD(mb, cb, 1);
#pragma unroll 1
    for (int rnd = 0; rnd < R2_NR; rnd += 2) {
        R2_ROUND(ma, ca, rnd);
        if (rnd + 1 < R2_NR) R2_ROUND(mb, cb, rnd + 1);
    }
}
#undef R2_LOAD
#undef R2_ROUND

DEV void rwkv3_unit(const Params& p, int h, int c, float* sm) {
    const int tid = opaque_tid(), lane = tid & 63, wave = tid >> 6;
    const bf16_t* P0 = (const bf16_t*)(p.ws + OFF_P0);
    const bf16_t* RUb = (const bf16_t*)(p.ws + OFF_RU);
    const bf16_t* S0G = (const bf16_t*)(p.ws + OFF_RS0);
    const float* BONS = (const float*)(p.ws + OFF_BONS);
    bf16_t* YC = (bf16_t*)(p.ws + OFF_YC);
    const float* mu = p.in[15]; const float* gn_g = p.in[27]; const float* gn_b = p.in[28];
    bf16_t* img = (bf16_t*)sm;
    float* O = sm + 4 * 2304;
    __syncthreads();
    {
        const int row = tid >> 3, c8 = (tid & 7) * 8;
#pragma unroll
        for (int dir = 0; dir < 2; ++dir) {
            const size_t u = (size_t)((h * 2 + dir) * NCH + c);
            *(uint4*)(img + dir * 4608 + row * 72 + c8) = *(const uint4*)(RUb + u * 16384 + 8192 + row * 64 + c8);
            *(uint4*)(img + (2 + dir) * 4608 + row * 72 + c8) = *(const uint4*)(S0G + u * 4096 + row * 64 + c8);
        }
    }
    __syncthreads();
#pragma unroll
    for (int q = 0; q < 2; ++q) {
        const int idx = wave * 2 + q, ti = idx >> 2, tj = idx & 3;
        f32x4 accd[2];
#pragma unroll
        for (int dir = 0; dir < 2; ++dir) {
            f32x4 acc = (f32x4){0.f, 0.f, 0.f, 0.f};
#pragma unroll
            for (int ks = 0; ks < 2; ++ks) acc = __builtin_amdgcn_mfma_f32_16x16x32_bf16(row_frag(img + dir * 4608, 72, ti * 16, ks * 32, lane), row_frag(img + (2 + dir) * 4608, 72, tj * 16, ks * 32, lane), acc, 0, 0, 0);
            const uint2 yl = *(const uint2*)(RUb + (size_t)((h * 2 + dir) * NCH + c) * 16384 + 12288 + (tj * 16 + (lane & 15)) * 64 + ti * 16 + (lane >> 4) * 4);
            acc[0] += bflo(yl.x); acc[1] += bfhi(yl.x); acc[2] += bflo(yl.y); acc[3] += bfhi(yl.y);
            accd[dir] = acc;
        }
#pragma unroll
        for (int r = 0; r < 4; ++r) {
            const int oi = (ti * 16 + (lane >> 4) * 4 + r) * 68 + tj * 16 + (lane & 15);
            O[oi] = accd[0][r] + accd[1][r];
        }
    }
    __syncthreads();
    {
        const int t = tid >> 3, v0 = (tid & 7) * 8, s = c * 64 + t;
        float y[8], sum = 0.f;
#pragma unroll
        for (int i = 0; i < 8; ++i) { y[i] = O[t * 68 + v0 + i]; sum += y[i]; }
        sum += __shfl_xor(sum, 1, 64); sum += __shfl_xor(sum, 2, 64); sum += __shfl_xor(sum, 4, 64);
        const float mean = sum * (1.f / 64.f);
        float sq = 0.f;
#pragma unroll
        for (int i = 0; i < 8; ++i) { y[i] -= mean; sq += y[i] * y[i]; }
        sq += __shfl_xor(sq, 1, 64); sq += __shfl_xor(sq, 2, 64); sq += __shfl_xor(sq, 4, 64);
        const float rstd = rsqrtf(sq * (1.f / 64.f) + 64e-5f);
        float vm[8], gm[8];
        rw_mix8(P0, s, 1024 + h * 64 + v0, mu, vm);
        rw_mix8(P0, s, 1536 + h * 64 + v0, mu, gm);
        const float bon = BONS[(size_t)s * 8 + h] + BONS[((size_t)TB + s) * 8 + h];
        float o[8];
#pragma unroll
        for (int i = 0; i < 8; ++i) o[i] = (y[i] * rstd * gn_g[h * 64 + v0 + i] + gn_b[h * 64 + v0 + i] + bon * vm[i]) * silu_f(gm[i]);
        *(uint4*)(YC + (size_t)s * 1024 + 512 + h * 64 + v0) = pack8(o);
    }
}

DEV void ln_rows(const float* src, const float* res_lat, const float* res_cx, int nrows, const float* __restrict__ g, const float* __restrict__ bt, float* dst_lat, float* dst_cx, int ncx,
                 bf16_t* hb = nullptr, const float* mvc = nullptr, const float* mvl = nullptr) {
    const int tid_ = opaque_tid(); const int lane = tid_ & 63, gw = blockIdx.x * NWV + (tid_ >> 6), ngw = gridDim.x * NWV;
    for (int r = gw; r < nrows; r += ngw) {
        const float* x = src + (size_t)r * 1024;
        float4 v[4];
        float sum = 0.f;
        const float* xr = (r < ncx) ? (res_cx + (size_t)r * 1024) : (res_lat + (size_t)(r - ncx) * 1024);
#pragma unroll
        for (int i = 0; i < 4; ++i) { const float4 a = ld4(x + i * 256 + lane * 4), rr = ld4(xr + i * 256 + lane * 4);
            v[i] = make_float4(ALPHA * rr.x + a.x, ALPHA * rr.y + a.y, ALPHA * rr.z + a.z, ALPHA * rr.w + a.w); sum += v[i].x + v[i].y + v[i].z + v[i].w; }
        const float mean = wave_sum(sum) * (1.f / 1024.f);
        float sq = 0.f;
#pragma unroll
        for (int i = 0; i < 4; ++i) {
            v[i].x -= mean; v[i].y -= mean; v[i].z -= mean; v[i].w -= mean;
            sq += v[i].x * v[i].x + v[i].y * v[i].y + v[i].z * v[i].z + v[i].w * v[i].w;
        }
        const float rstd = rsqrtf(wave_sum(sq) * (1.f / 1024.f) + 1e-5f);
        float* d = (r < ncx) ? (dst_cx + (size_t)r * 1024) : (dst_lat + (size_t)(r - ncx) * 1024);
#pragma unroll
        for (int i = 0; i < 4; ++i) {
            const int c = i * 256 + lane * 4;
            const float4 gg = ld4(g + c), bb = ld4(bt + c);
            const float4 y = make_float4(v[i].x * rstd * gg.x + bb.x, v[i].y * rstd * gg.y + bb.y, v[i].z * rstd * gg.z + bb.z, v[i].w * rstd * gg.w + bb.w);
            st4(d + c, y);
            if (hb != nullptr) {
                const float* m = (r < ncx) ? mvc : mvl;
                const float4 sh = ld4(m + c), sc = ld4(m + 1024 + c);
                *(uint2*)(hb + (size_t)r * 1024 + c) = make_uint2(pack2bf(y.x * (1.f + sc.x) + sh.x, y.y * (1.f + sc.y) + sh.y), pack2bf(y.z * (1.f + sc.z) + sh.z, y.w * (1.f + sc.w) + sh.w));
            }
        }
    }
}
DEV void phase_h1l(const Params& p) {
    const float* modv1 = (const float*)(p.ws + OFF_MODV) + 3 * 3072;
    bf16_t* H1 = (bf16_t*)(p.ws + OFF_H1B);
    const size_t gt = (size_t)blockIdx.x * NTHR + opaque_tid(), gn = (size_t)gridDim.x * NTHR;
    for (size_t i = gt; i < (size_t)NB * NL * 128; i += gn) {
        const size_t r = i >> 7; const int k = (int)(i & 127) * 8;
        const float* m = modv1 + (r >= (size_t)NL ? 1 : 0) * 3072;
        const float4 x0 = ld4(p.out + r * DM + k), x1 = ld4(p.out + r * DM + k + 4);
        const float4 s0 = ld4(m + k), s1 = ld4(m + k + 4), c0 = ld4(m + 1024 + k), c1 = ld4(m + 1024 + k + 4);
        *(uint4*)(H1 + r * DM + k) = make_uint4(pack2bf(x0.x * (1.f + c0.x) + s0.x, x0.y * (1.f + c0.y) + s0.y), pack2bf(x0.z * (1.f + c0.z) + s0.z, x0.w * (1.f + c0.w) + s0.w),
                                                pack2bf(x1.x * (1.f + c1.x) + s1.x, x1.y * (1.f + c1.y) + s1.y), pack2bf(x1.z * (1.f + c1.z) + s1.z, x1.w * (1.f + c1.w) + s1.w));
    }
}

DEV void zero_f4(float* ptr, size_t nfloat) {
    const size_t n4 = nfloat / 4;
    for (size_t i = (size_t)blockIdx.x * NTHR + opaque_tid(); i < n4; i += (size_t)gridDim.x * NTHR) ((float4*)ptr)[i] = make_float4(0.f, 0.f, 0.f, 0.f);
}

DEV void chain_ids(int& chain, int& sub) {
    const int bid = blockIdx.x, xcd = bid & 7, idx = bid >> 3;
    chain = xcd * 2 + (idx >> 4); sub = idx & 15;
}

DEV void phase_conv1(const Params& p, float* sm) {
    const bf16_t* XM = (const bf16_t*)(p.ws + OFF_XM);
    bf16_t* XC = (bf16_t*)(p.ws + OFF_XC);
    float* G16P = (float*)(p.ws + OFF_G16P);
    const bf16_t* WFT = (const bf16_t*)(p.ws + OFF_WFT);
    const float* cw = p.in[31]; const float* cbias = p.in[32];
    bf16_t* imgC = (bf16_t*)sm;
    bf16_t* imgM = imgC + 64 * 264;
    float* red = (float*)(imgM + 64 * 264);
    float* cwl = red + 1024;
    const int tid = opaque_tid(), lane = tid & 63, wave = tid >> 6, t = tid >> 3, cg = tid & 7;
    for (int u = blockIdx.x; u < NB * NCH * 4; u += gridDim.x) {
        const int ci = u >> 2, q = u & 3, b = ci / NCH, c = ci % NCH, s = c * 64 + t;
        const size_t rowbase = (size_t)b * TB;
        int nrow[9];
#pragma unroll
        for (int i = 0; i < 3; ++i)
#pragma unroll
            for (int j = 0; j < 3; ++j) {
                int ns = -1;
                if (s < NCX) { const int w2 = s + j - 1; if (i == 1 && w2 >= 0 && w2 < NCX) ns = w2; }
                else { const int n = s - NCX, rr = (n >> 6) + i - 1, w2 = (n & 63) + j - 1; if (rr >= 0 && rr < 128 && w2 >= 0 && w2 < 64) ns = NCX + rr * 64 + w2; }
                nrow[i * 3 + j] = ns;
            }
        const int tt = wave & 3, part = wave >> 2;
        f32x4 acc = (f32x4){0.f, 0.f, 0.f, 0.f};
#pragma unroll 1
        for (int half = 0; half < 2; ++half) {
            __syncthreads();
            for (int i = tid; i < 640; i += NTHR) { const int tp = i >> 6, c4 = (i & 63) * 4; st4(cwl + tp * 256 + c4, ld4((tp < 9 ? cw + tp * 2048 : cbias) + q * 512 + half * 256 + c4)); }
            __syncthreads();
#pragma unroll 2
            for (int it = 0; it < 4; ++it) {
                const int cl = it * 64 + cg * 8, c0 = q * 512 + half * 256 + cl;
                float a8[8];
                { const float4 b0 = ld4(cwl + 9 * 256 + cl), b1 = ld4(cwl + 9 * 256 + cl + 4); a8[0] = b0.x; a8[1] = b0.y; a8[2] = b0.z; a8[3] = b0.w; a8[4] = b1.x; a8[5] = b1.y; a8[6] = b1.z; a8[7] = b1.w; }
                uint4 xmc = make_uint4(0u, 0u, 0u, 0u);
#pragma unroll
                for (int tap = 0; tap < 9; ++tap) {
                    if (nrow[tap] >= 0) {
                        const uint4 xv = *(const uint4*)(XM + (rowbase + nrow[tap]) * 2048 + c0);
                        float x8[8]; unpack8(xv, x8);
                        const float4 w0 = ld4(cwl + tap * 256 + cl), w1 = ld4(cwl + tap * 256 + cl + 4);
                        a8[0] += x8[0] * w0.x; a8[1] += x8[1] * w0.y; a8[2] += x8[2] * w0.z; a8[3] += x8[3] * w0.w;
                        a8[4] += x8[4] * w1.x; a8[5] += x8[5] * w1.y; a8[6] += x8[6] * w1.z; a8[7] += x8[7] * w1.w;
                        if (tap == 4) xmc = xv;
                    }
                }
#pragma unroll
                for (int i = 0; i < 8; ++i) a8[i] = silu_f(a8[i]);
                const uint4 xcv = pack8(a8);
                *(uint4*)(XC + (rowbase + s) * 2048 + c0) = xcv;
                *(uint4*)(imgC + t * 264 + cl) = xcv;
                *(uint4*)(imgM + t * 264 + cl) = xmc;
            }
            __syncthreads();
            {
                const bf16_t* img = part ? imgM : imgC;
                const bf16_t* wrow = WFT + (size_t)(lane & 15) * 4096 + part * 2048 + q * 512 + half * 256 + (lane >> 4) * 8;
#pragma unroll
                for (int ks = 0; ks < 8; ++ks) acc = __builtin_amdgcn_mfma_f32_16x16x32_bf16(row_frag(img, 264, tt * 16, ks * 32, lane), *(const bf16x8*)(wrow + ks * 32), acc, 0, 0, 0);
            }
        }
        if (part == 1) {
#pragma unroll
            for (int r = 0; r < 4; ++r) red[(tt * 16 + (lane >> 4) * 4 + r) * 16 + (lane & 15)] = acc[r];
        }
        __syncthreads();
        if (part == 0) {
#pragma unroll
            for (int r = 0; r < 4; ++r) {
                const int tk = tt * 16 + (lane >> 4) * 4 + r;
                G16P[((size_t)q * RT + rowbase + c * 64 + tk) * 16 + (lane & 15)] = acc[r] + red[tk * 16 + (lane & 15)];
            }
        }
    }
}

DEV void gate_pair(const Params& p, size_t row, int dir, int h, float& gi, float& lf) {
    const float* G16P = (const float*)(p.ws + OFF_G16P);
    float a = 0.f, f = 0.f;
#pragma unroll
    for (int q = 0; q < 4; ++q) { a += G16P[((size_t)q * RT + row) * 16 + dir * 8 + h]; f += G16P[((size_t)q * RT + row) * 16 + dir * 8 + 4 + h]; }
    gi = a + p.in[dir ? 41 : 37][h];
    lf = logsig_f(f + p.in[dir ? 43 : 39][h]);
}

DEV void phase_x1(const Params& p, float* sm) {
    int chain, sub; chain_ids(chain, sub);
    const int b = chain >> 3, h = (chain >> 1) & 3, dir = chain & 1;
    const bf16_t* XC = (const bf16_t*)(p.ws + OFF_XC);
    float* GSC = (float*)(p.ws + OFF_GSC); float* CSC = (float*)(p.ws + OFF_CSC); float* NBUF = (float*)(p.ws + OFF_NBUF);
    const float* gtab = (const float*)(p.ws + OFF_GTAB);
    bf16_t* SMAT = (bf16_t*)(p.ws + OFF_SMAT);
    const int tid = opaque_tid(), lane = tid & 63, wave = tid >> 6;
    float* sTot = sm; float* sRef = sm + 132; float* sM0 = sm + 264; float* sBeta = sm + 400;
    for (int c = wave; c < NCH; c += NWV) {
        const size_t row = (size_t)b * TB + c * 64 + lane;
        float gi, lf; gate_pair(p, row, dir, h, gi, lf);
        const float bc = wave_scan_add(lf, lane, dir);
        const float ref = wave_max(gi - bc), tot = wave_sum(lf);
        if (lane == 0) { sTot[c] = tot; sRef[c] = ref; }
    }
    __syncthreads();
    if (tid == 0) {
        float m0 = -INFINITY;
        for (int step = 0; step < NCH; ++step) {
            const int c = chunk_at(dir, step);
            sM0[c] = m0;
            const float mx = fmaxf(m0, sRef[c]);
            if (sub == 0) { CSC[(chain * NCH + c) * 2] = fexp(m0 - mx); CSC[(chain * NCH + c) * 2 + 1] = fexp(sRef[c] - mx); }
            m0 = sTot[c] + mx;
        }
    }
    __syncthreads();
    for (int k = wave; sub + 16 * k < NCH; k += NWV) {
        const int c = sub + 16 * k;
        const size_t row = (size_t)b * TB + c * 64 + lane;
        float gi, lf; gate_pair(p, row, dir, h, gi, lf);
        const float bc = wave_scan_add(lf, lane, dir);
        const float a = gi - bc;
        const float amax = wave_scan_max(a, lane, dir);
        const float ref = sRef[c], m0 = sM0[c];
        const float mmax = fmaxf(amax, m0);
        const float mt = bc + mmax;
        const float alpha = fexp(ref - mmax), beta = fexp(a - ref), gg = fexp(m0 - mmax), em = fexp(-mt);
        st4(GSC + ((size_t)chain * TB + c * 64 + lane) * 4, make_float4(alpha, beta, gg, em));
        sBeta[k * 64 + lane] = beta;
    }
    __syncthreads();
    {
        float* part = sm + 1024;
        const int sg = tid >> 6, j8 = (tid & 63) * 8;
        for (int k = 0; sub + 16 * k < NCH; ++k) {
            const int c = sub + 16 * k;
            const bf16_t* xp = XC + ((size_t)b * TB + c * 64 + sg * 8) * 2048 + h * 512 + j8;
            float acc[8];
#pragma unroll
            for (int i = 0; i < 8; ++i) acc[i] = 0.f;
#pragma unroll
            for (int s = 0; s < 8; ++s) {
                float f[8]; unpack8(*(const uint4*)(xp + (size_t)s * 2048), f);
                const float be = sBeta[k * 64 + sg * 8 + s];
#pragma unroll
                for (int i = 0; i < 8; ++i) acc[i] += be * f[i];
            }
            __syncthreads();
            st4(part + sg * 512 + j8, make_float4(acc[0], acc[1], acc[2], acc[3])); st4(part + sg * 512 + j8 + 4, make_float4(acc[4], acc[5], acc[6], acc[7]));
            __syncthreads();
            float tot = 0.f;
#pragma unroll
            for (int q = 0; q < 8; ++q) tot += part[q * 512 + tid];
            NBUF[((size_t)chain * NCH + c) * 512 + tid] = tot;
        }
    }
    bf16_t* XCs = (bf16_t*)sm;
    bf16_t* Qs = XCs + 64 * 520;
    for (int u = blockIdx.x; u < NB * 4 * NCH; u += gridDim.x) {
        const int bh = u / NCH, c = u % NCH, ub = bh >> 2, uh = bh & 3;
        __syncthreads();
#pragma unroll 2
        for (int i = 0; i < 8; ++i) {
            const int pp = tid + 512 * i, row = pp >> 6, c16 = pp & 63;
            const uint4 xv = *(const uint4*)(XC + ((size_t)ub * TB + c * 64 + row) * 2048 + uh * 512 + c16 * 8);
            float f[8]; unpack8(xv, f);
            float q[8];
#pragma unroll
            for (int bb = 0; bb < 2; ++bb) {
                const float* G = gtab + (size_t)(uh * 128 + c16 * 2 + bb) * 16;
                const float4 g0 = ld4(G), g1 = ld4(G + 4), g2 = ld4(G + 8), g3 = ld4(G + 12);
                q[bb * 4 + 0] = f[bb * 4] * g0.x + f[bb * 4 + 1] * g1.x + f[bb * 4 + 2] * g2.x + f[bb * 4 + 3] * g3.x;
                q[bb * 4 + 1] = f[bb * 4] * g0.y + f[bb * 4 + 1] * g1.y + f[bb * 4 + 2] * g2.y + f[bb * 4 + 3] * g3.y;
                q[bb * 4 + 2] = f[bb * 4] * g0.z + f[bb * 4 + 1] * g1.z + f[bb * 4 + 2] * g2.z + f[bb * 4 + 3] * g3.z;
                q[bb * 4 + 3] = f[bb * 4] * g0.w + f[bb * 4 + 1] * g1.w + f[bb * 4 + 2] * g2.w + f[bb * 4 + 3] * g3.w;
            }
            *(uint4*)(XCs + row * 520 + c16 * 8) = xv;
            *(uint4*)(Qs + row * 520 + c16 * 8) = make_uint4(pack2bf(q[0], q[1]), pack2bf(q[2], q[3]), pack2bf(q[4], q[5]), pack2bf(q[6], q[7]));
        }
        __syncthreads();
        const int st = wave & 3, tt0 = (wave >> 2) * 2;
        f32x4 a0 = (f32x4){0.f, 0.f, 0.f, 0.f}, a1 = a0;
        const bf16_t* ap = XCs + (st * 16 + (lane & 15)) * 520 + (lane >> 4) * 8;
        const bf16_t* bp0 = Qs + (tt0 * 16 + (lane & 15)) * 520 + (lane >> 4) * 8;
        const bf16_t* bp1 = bp0 + 16 * 520;
#pragma unroll
        for (int ks = 0; ks < 16; ++ks) {
            const bf16x8 af = *(const bf16x8*)(ap + ks * 32);
            a0 = __builtin_amdgcn_mfma_f32_16x16x32_bf16(af, *(const bf16x8*)(bp0 + ks * 32), a0, 0, 0, 0);
            a1 = __builtin_amdgcn_mfma_f32_16x16x32_bf16(af, *(const bf16x8*)(bp1 + ks * 32), a1, 0, 0, 0);
        }
        bf16_t* sp = SMAT + (size_t)u * 4096 + (size_t)(tt0 * 16 + (lane & 15)) * 64 + st * 16 + (lane >> 4) * 4;
        *(uint2*)sp = make_uint2(pack2bf(a0[0], a0[1]), pack2bf(a0[2], a0[3]));
        *(uint2*)(sp + 16 * 64) = make_uint2(pack2bf(a1[0], a1[1]), pack2bf(a1[2], a1[3]));
    }
}

DEV void phase_x2(const Params& p, float* sm) {
    int chain, sub; chain_ids(chain, sub);
    const int b = chain >> 3, h = (chain >> 1) & 3, dir = chain & 1;
    const bf16_t* XC = (const bf16_t*)(p.ws + OFF_XC);
    float* GSC = (float*)(p.ws + OFF_GSC); const float* CSC = (const float*)(p.ws + OFF_CSC); const float* NBUF = (const float*)(p.ws + OFF_NBUF);
    const float* gtab = (const float*)(p.ws + OFF_GTAB);
    const bf16_t* SMAT = (const bf16_t*)(p.ws + OFF_SMAT);
    const int tid = opaque_tid();
    float* sD0 = sm; float* sCf = sm + 132; float* sN0 = sm + 264; float* sN2 = sN0 + 9 * 512;
    for (int i = tid; i < NCH; i += NTHR) { sD0[i] = CSC[(chain * NCH + i) * 2]; sCf[i] = CSC[(chain * NCH + i) * 2 + 1]; }
    __syncthreads();
    {
        float n = 0.f;
        const float* nb = NBUF + (size_t)chain * NCH * 512 + tid;
#pragma unroll 4
        for (int step = 0; step < NCH; ++step) {
            const int c = chunk_at(dir, step);
            if ((c & 15) == sub) sN0[(c >> 4) * 512 + tid] = n;
            n = sD0[c] * n + sCf[c] * nb[(size_t)c * 512];
        }
    }
    __syncthreads();
    {
        const int blk = tid >> 2, cp = tid & 3;
        const float4 g = ld4(gtab + (size_t)(h * 128 + blk) * 16 + cp * 4);
        for (int k = 0; sub + 16 * k < NCH; ++k) {
            const float* n0 = sN0 + k * 512 + blk * 4;
            sN2[k * 512 + tid] = g.x * n0[0] + g.y * n0[1] + g.z * n0[2] + g.w * n0[3];
        }
    }
    __syncthreads();
    const int t = tid >> 3, part = tid & 7;
    for (int k = 0; sub + 16 * k < NCH; ++k) {
        const int c = sub + 16 * k;
        const size_t row = (size_t)b * TB + c * 64 + t;
        float dint = 0.f;
        {
            const bf16_t* xp = XC + row * 2048 + h * 512 + part * 64;
            const float* n2 = sN2 + k * 512 + part * 64;
#pragma unroll
            for (int i = 0; i < 8; ++i) {
                float f[8]; unpack8(*(const uint4*)(xp + i * 8), f);
                const float4 na = ld4(n2 + i * 8), nb2 = ld4(n2 + i * 8 + 4);
                dint += f[0] * na.x + f[1] * na.y + f[2] * na.z + f[3] * na.w + f[4] * nb2.x + f[5] * nb2.y + f[6] * nb2.z + f[7] * nb2.w;
            }
        }
        float di = 0.f;
        {
            float f[8]; unpack8(*(const uint4*)(SMAT + ((size_t)((b * 4 + h) * NCH + c)) * 4096 + t * 64 + part * 8), f);
#pragma unroll
            for (int e = 0; e < 8; ++e) {
                const int s = part * 8 + e;
                const float beta = GSC[((size_t)chain * TB + c * 64 + s) * 4 + 1];
                const bool keep = dir ? (s >= t) : (s <= t);
                di += keep ? f[e] * beta : 0.f;
            }
        }
        dint += __shfl_xor(dint, 1, 64); dint += __shfl_xor(dint, 2, 64); dint += __shfl_xor(dint, 4, 64);
        di += __shfl_xor(di, 1, 64); di += __shfl_xor(di, 2, 64); di += __shfl_xor(di, 4, 64);
        if (part == 0) {
            float* gp = GSC + ((size_t)chain * TB + c * 64 + t) * 4;
            const float4 g4 = ld4(gp);
            const float den = g4.x * di + g4.z * dint;
            gp[3] = 1.f / fmaxf(fabsf(den), g4.w);
        }
    }
}

#define MLSTM_PREFETCH(step_) do { \
    const int c_ = chunk_at(dir, (step_)); const size_t rb_ = (size_t)b * TB + (size_t)c_ * 64; \
    { const bf16_t* xb_ = XC + (rb_ + (tid >> 6)) * 2048 + h * 512 + (tid & 63) * 8; \
      rx0 = *(const uint4*)(xb_); rx1 = *(const uint4*)(xb_ + 8 * 2048); rx2 = *(const uint4*)(xb_ + 16 * 2048); rx3 = *(const uint4*)(xb_ + 24 * 2048); \
      rx4 = *(const uint4*)(xb_ + 32 * 2048); rx5 = *(const uint4*)(xb_ + 40 * 2048); rx6 = *(const uint4*)(xb_ + 48 * 2048); rx7 = *(const uint4*)(xb_ + 56 * 2048); } \
    rxm = *(const uint2*)(XM + (rb_ + ps) * 2048 + ch0 + pvb * 4); \
    rs = *(const uint4*)(SMAT + ((size_t)((b * 4 + h) * NCH + c_)) * 4096 + ps * 64 + pvb * 8); \
    rbeta = GSC[((size_t)chain * TB + c_ * 64 + ps) * 4 + 1]; \
    if (tid < 64) rsc = ld4(GSC + ((size_t)chain * TB + c_ * 64 + tid) * 4); \
    rd0 = CSC[(chain * NCH + c_) * 2]; rcf = CSC[(chain * NCH + c_) * 2 + 1]; } while (0)

DEV void phase_mlstm(const Params& p, float* sm) {
    int chain, sub; chain_ids(chain, sub);
    const int b = chain >> 3, h = (chain >> 1) & 3, dir = chain & 1;
    const bf16_t* XM = (const bf16_t*)(p.ws + OFF_XM);
    const bf16_t* XC = (const bf16_t*)(p.ws + OFF_XC);
    const bf16_t* SMAT = (const bf16_t*)(p.ws + OFF_SMAT);
    const float* GSC = (const float*)(p.ws + OFF_GSC); const float* CSC = (const float*)(p.ws + OFF_CSC);
    const float* gtab = (const float*)(p.ws + OFF_GTAB);
    bf16_t* H = (bf16_t*)(p.ws + OFF_H);
    const float* wv = p.in[35];
    char* smc = (char*)sm;
    bf16_t* XCs = (bf16_t*)smc;
    bf16_t* Cs = (bf16_t*)(smc + 66560);
    bf16_t* Vb = (bf16_t*)(smc + 66560 + 33280);
    bf16_t* Vw = Vb + 32 * 72;
    bf16_t* Sm = Vw + 32 * 72;
    float* Gs = (float*)(smc + 66560 + 33280 + 2 * 4608 + 9216);
    float* sc = Gs + 2048;
    const int tid = opaque_tid(), lane = tid & 63, wave = tid >> 6;
    for (int i = tid; i < 32 * 520 / 2; i += NTHR) ((unsigned*)Cs)[i] = 0u;
    for (int i = tid; i < 2048; i += NTHR) Gs[i] = gtab[h * 2048 + i];
    const int ps = tid >> 3, pvb = tid & 7;
    const int ch0 = h * 512 + sub * 32;
    float wvr[16];
#pragma unroll
    for (int i = 0; i < 16; ++i) wvr[i] = wv[(size_t)((ch0 >> 2) + pvb) * 16 + i];
    f32x4 accS[4][2];
#pragma unroll
    for (int i = 0; i < 4; ++i) { accS[i][0] = (f32x4){0.f, 0.f, 0.f, 0.f}; accS[i][1] = (f32x4){0.f, 0.f, 0.f, 0.f}; }
    uint4 rx0, rx1, rx2, rx3, rx4, rx5, rx6, rx7; uint2 rxm; uint4 rs; float rbeta; float4 rsc = make_float4(0.f, 0.f, 0.f, 0.f); float rd0, rcf;
    MLSTM_PREFETCH(0);
    __syncthreads();
#pragma unroll 1
    for (int step = 0; step < NCH; ++step) {
        const int c = chunk_at(dir, step);
        const float d0 = rd0, cf = rcf;
        {
            bf16_t* xd = XCs + (tid >> 6) * 520 + (tid & 63) * 8;
            *(uint4*)(xd) = rx0; *(uint4*)(xd + 8 * 520) = rx1; *(uint4*)(xd + 16 * 520) = rx2; *(uint4*)(xd + 24 * 520) = rx3;
            *(uint4*)(xd + 32 * 520) = rx4; *(uint4*)(xd + 40 * 520) = rx5; *(uint4*)(xd + 48 * 520) = rx6; *(uint4*)(xd + 56 * 520) = rx7;
        }
        {
            const float x0 = bflo(rxm.x), x1 = bfhi(rxm.x), x2 = bflo(rxm.y), x3 = bfhi(rxm.y);
#pragma unroll
            for (int d = 0; d < 4; ++d) {
                const float v = (x0 * wvr[d] + x1 * wvr[4 + d] + x2 * wvr[8 + d] + x3 * wvr[12 + d]) * rbeta;
                Vb[(pvb * 4 + d) * 72 + ps] = __builtin_bit_cast(unsigned short, (__bf16)v);
                Vw[(pvb * 4 + d) * 72 + ps] = __builtin_bit_cast(unsigned short, (__bf16)(v * cf));
            }
        }
        {
#define SMASK(q_) (((dir ? (pvb * 8 + 2 * (q_) >= ps) : (pvb * 8 + 2 * (q_) <= ps)) ? 0x0000ffffu : 0u) | ((dir ? (pvb * 8 + 2 * (q_) + 1 >= ps) : (pvb * 8 + 2 * (q_) + 1 <= ps)) ? 0xffff0000u : 0u))
            *(uint4*)(Sm + ps * 72 + pvb * 8) = make_uint4(rs.x & SMASK(0), rs.y & SMASK(1), rs.z & SMASK(2), rs.w & SMASK(3));
#undef SMASK
        }
        if (tid < 64) st4(sc + tid * 4, rsc);
        { const int nstep = (step + 1 < NCH) ? step + 1 : step; MLSTM_PREFETCH(nstep); }
        __syncthreads();
        {
            const int vt = wave & 1, tt = wave >> 1;
            f32x4 ao = (f32x4){0.f, 0.f, 0.f, 0.f}, ai = ao, ao1 = ao, ao2 = ao, ao3 = ao;
            const bf16_t* ap = Cs + (vt * 16 + (lane & 15)) * 520 + (lane >> 4) * 8;
            const bf16_t* bp = XCs + (tt * 16 + (lane & 15)) * 520 + (lane >> 4) * 8;
#pragma unroll
            for (int ks = 0; ks < 16; ks += 4) {
                ao = __builtin_amdgcn_mfma_f32_16x16x32_bf16(*(const bf16x8*)(ap + ks * 32), *(const bf16x8*)(bp + ks * 32), ao, 0, 0, 0);
                ao1 = __builtin_amdgcn_mfma_f32_16x16x32_bf16(*(const bf16x8*)(ap + (ks + 1) * 32), *(const bf16x8*)(bp + (ks + 1) * 32), ao1, 0, 0, 0);
                ao2 = __builtin_amdgcn_mfma_f32_16x16x32_bf16(*(const bf16x8*)(ap + (ks + 2) * 32), *(const bf16x8*)(bp + (ks + 2) * 32), ao2, 0, 0, 0);
                ao3 = __builtin_amdgcn_mfma_f32_16x16x32_bf16(*(const bf16x8*)(ap + (ks + 3) * 32), *(const bf16x8*)(bp + (ks + 3) * 32), ao3, 0, 0, 0);
            }
            ao = (ao + ao1) + (ao2 + ao3);
            const bf16_t* ap2 = Vb + (vt * 16 + (lane & 15)) * 72 + (lane >> 4) * 8;
            const bf16_t* bp2 = Sm + (tt * 16 + (lane & 15)) * 72 + (lane >> 4) * 8;
#pragma unroll
            for (int ks = 0; ks < 2; ++ks) ai = __builtin_amdgcn_mfma_f32_16x16x32_bf16(*(const bf16x8*)(ap2 + ks * 32), *(const bf16x8*)(bp2 + ks * 32), ai, 0, 0, 0);
            if (c >= 4) {
                const int t = tt * 16 + (lane & 15);
                const float4 s4 = ld4(sc + t * 4);
                const float h0 = (s4.x * ai[0] + s4.z * ao[0]) * s4.w, h1 = (s4.x * ai[1] + s4.z * ao[1]) * s4.w;
                const float h2 = (s4.x * ai[2] + s4.z * ao[2]) * s4.w, h3 = (s4.x * ai[3] + s4.z * ao[3]) * s4.w;
                bf16_t* hp = H + ((size_t)b * NL + (size_t)c * 64 + t - NCX) * 2048 + ch0 + vt * 16 + (lane >> 4) * 4;
                const unsigned u0 = pack2bf(h0, h1), u1 = pack2bf(h2, h3);
                __builtin_amdgcn_global_atomic_fadd_v2bf16((__attribute__((address_space(1))) s16x2*)hp, __builtin_bit_cast(s16x2, u0));
                __builtin_amdgcn_global_atomic_fadd_v2bf16((__attribute__((address_space(1))) s16x2*)(hp + 2), __builtin_bit_cast(s16x2, u1));
            }
        }
#pragma unroll
        for (int jt = 0; jt < 4; ++jt) { accS[jt][0] *= d0; accS[jt][1] *= d0; }
#pragma unroll
        for (int ks = 0; ks < 2; ++ks) {
            const bf16x8 b0 = *(const bf16x8*)(Vw + (lane & 15) * 72 + ks * 32 + (lane >> 4) * 8);
            const bf16x8 b1 = *(const bf16x8*)(Vw + (16 + (lane & 15)) * 72 + ks * 32 + (lane >> 4) * 8);
            const int row0 = ks * 32 + (lane >> 4) * 8 + ((lane & 15) >> 2);
#pragma unroll
            for (int jt = 0; jt < 4; ++jt) {
                const int col = wave * 64 + jt * 16 + (lane & 3) * 4;
                const s16x4 lo = __builtin_amdgcn_ds_read_tr16_b64_v4i16((__attribute__((address_space(3))) s16x4*)(XCs + row0 * 520 + col));
                const s16x4 hi = __builtin_amdgcn_ds_read_tr16_b64_v4i16((__attribute__((address_space(3))) s16x4*)(XCs + (row0 + 4) * 520 + col));
                const bf16x8 af = (bf16x8){lo[0], lo[1], lo[2], lo[3], hi[0], hi[1], hi[2], hi[3]};
                accS[jt][0] = __builtin_amdgcn_mfma_f32_16x16x32_bf16(af, b0, accS[jt][0], 0, 0, 0);
                accS[jt][1] = __builtin_amdgcn_mfma_f32_16x16x32_bf16(af, b1, accS[jt][1], 0, 0, 0);
            }
        }
        __syncthreads();
#pragma unroll
        for (int jt = 0; jt < 4; ++jt) {
            const int blk = wave * 16 + jt * 4 + (lane >> 4);
            const float4 g0 = ld4(Gs + blk * 16), g1 = ld4(Gs + blk * 16 + 4), g2 = ld4(Gs + blk * 16 + 8), g3 = ld4(Gs + blk * 16 + 12);
#pragma unroll
            for (int v2 = 0; v2 < 2; ++v2) {
                const f32x4 a = accS[jt][v2];
                const float o0 = g0.x * a[0] + g0.y * a[1] + g0.z * a[2] + g0.w * a[3];
                const float o1 = g1.x * a[0] + g1.y * a[1] + g1.z * a[2] + g1.w * a[3];
                const float o2 = g2.x * a[0] + g2.y * a[1] + g2.z * a[2] + g2.w * a[3];
                const float o3 = g3.x * a[0] + g3.y * a[1] + g3.z * a[2] + g3.w * a[3];
                *(uint2*)(Cs + (v2 * 16 + (lane & 15)) * 520 + blk * 4) = make_uint2(pack2bf(o0, o1), pack2bf(o2, o3));
            }
        }
    }
}

DEV void phase_finish1(const Params& p) {
    bf16_t* H = (bf16_t*)(p.ws + OFF_H);
    const bf16_t* XC = (const bf16_t*)(p.ws + OFF_XC);
    const bf16_t* Z = (const bf16_t*)(p.ws + OFF_XM);
    const float* ng = p.in[44]; const float* skip = p.in[45];
    const int tid_ = opaque_tid(); const int lane = tid_ & 63, gw = blockIdx.x * NWV + (tid_ >> 6), ngw = gridDim.x * NWV;
    for (int it = gw; it < NB * NL * 4; it += ngw) {
        const int r = it >> 2, h = it & 3, b = r >= NL ? 1 : 0, nn = r - b * NL;
        const int c0 = h * 512 + lane * 8;
        bf16_t* hp = H + (size_t)r * 2048 + c0;
        float v[8]; unpack8(*(const uint4*)hp, v);
        float sum = 0.f;
#pragma unroll
        for (int j = 0; j < 8; ++j) sum += v[j];
        const float mean = wave_sum(sum) * (1.f / 512.f);
        float sq = 0.f;
#pragma unroll
        for (int j = 0; j < 8; ++j) { v[j] -= mean; sq += v[j] * v[j]; }
        const float rstd = rsqrtf(wave_sum(sq) * (1.f / 512.f) + 1e-5f);
        float xc[8], z[8];
        unpack8(*(const uint4*)(XC + ((size_t)b * TB + NCX + nn) * 2048 + c0), xc);
        unpack8(*(const uint4*)(Z + (size_t)r * 2048 + c0), z);
        float o[8];
#pragma unroll
        for (int j = 0; j < 8; ++j) o[j] = (v[j] * rstd * ng[c0 + j] + skip[c0 + j] * xc[j]) * silu_f(z[j]);
        *(uint4*)hp = make_uint4(pack2bf(o[0], o[1]), pack2bf(o[2], o[3]), pack2bf(o[4], o[5]), pack2bf(o[6], o[7]));
    }
}

__global__ void __launch_bounds__(NTHR) fwd_kernel(Params p) {
    extern __shared__ __attribute__((aligned(16))) float sm[];
    volatile LAS unsigned* xst = (volatile LAS unsigned*)((LAS char*)sm + (LDS_BYTES - 16));
    if (threadIdx.x == 0) { xst[0] = 0u; xst[1] = 0u; }
    __syncthreads();
    const XcdBarrier xbar = xcd_barrier_post((unsigned*)(p.ws + OFF_BAR), xst);
    const int tid = opaque_tid(), lane = tid & 63, wave = tid >> 6;
    float* modv = (float*)(p.ws + OFF_MODV);
    float* X1C = (float*)(p.ws + OFF_X1C);

    phase_mod(p, sm);
    phase_tables(p);
    transpose_convert(p.in[8], 1024, EIN, 4096, (bf16_t*)(p.ws + OFF_WT0), sm);
    transpose_convert(p.in[29], 1024, 4096, 4096, (bf16_t*)(p.ws + OFF_WT1), sm);
    transpose_convert(p.in[9], 1024, 1024, 1024, (bf16_t*)(p.ws + OFF_WT2), sm);
    transpose_convert(p.in[30], 2048, 1024, 1024, (bf16_t*)(p.ws + OFF_WT3), sm);
    xcd_barrier(xbar);

#pragma unroll 1
    for (int b = 0; b < NB; ++b) {
        if (b == 0) { phase_h0(p, 0); xcd_barrier(xbar); }
        run_gemm((const bf16_t*)(p.ws + OFF_YC), (const bf16_t*)(p.ws + OFF_WT0), TB, 4096, DM, EpBf16{(bf16_t*)(p.ws + OFF_P0), EIN, EIN}, sm);
        xcd_barrier(xbar);
        for (int u = blockIdx.x; u < 24 * NCH; u += gridDim.x) {
            if (u < 16 * NCH) rwkv1_unit(p, (u / NCH) >> 1, (u / NCH) & 1, u % NCH, sm);
            else { const int v = u - 16 * NCH; gla1_unit(p, (v / NCH) >> 1, (v / NCH) & 1, v % NCH, sm); }
        }
        xcd_barrier(xbar);
        if (blockIdx.x < 128) gla2_unit(p, blockIdx.x);
        else if (blockIdx.x < 192) rwkv2_unit(p, (blockIdx.x - 128) >> 2, (blockIdx.x - 128) & 3, sm);
        xcd_barrier(xbar);
        for (int u = blockIdx.x; u < 12 * NCH; u += gridDim.x) {
            if (u < 8 * NCH) rwkv3_unit(p, u / NCH, u % NCH, sm);
            else { const int v = u - 8 * NCH; gla3_unit(p, v / NCH, v % NCH, sm); }
        }
        xcd_barrier(xbar);
        run_gemm((const bf16_t*)(p.ws + OFF_YC), (const bf16_t*)(p.ws + OFF_WT2), TB, DM, DM, EpRes0{(float*)(p.ws + OFF_P0), modv, b}, sm);
        xcd_barrier(xbar);
        ln_rows((const float*)(p.ws + OFF_P0), p.in[0] + (size_t)b * NL * DM, p.in[2] + (size_t)b * NCX * DM, TB, p.in[6], p.in[7], p.out + (size_t)b * NL * DM, X1C + (size_t)b * NCX * DM, NCX,
                (bf16_t*)(p.ws + OFF_H1B) + (size_t)b * TB * DM, modv + (3 + 2) * 3072, modv + (3 + b) * 3072);
        if (b == 0) phase_h0(p, 1);
        xcd_barrier(xbar);
    }

    run_gemm((const bf16_t*)(p.ws + OFF_H1B), (const bf16_t*)(p.ws + OFF_WT1), RT, 2048, DM, EpBf16{(bf16_t*)(p.ws + OFF_XM), 2048, 2048}, sm);
    zero_f4((float*)(p.ws + OFF_H), (size_t)NB * NL * 1024);
    xcd_barrier(xbar);
    phase_conv1(p, sm);
    xcd_barrier(xbar);
    phase_x1(p, sm);
    xcd_barrier(xbar);
    phase_x2(p, sm);
    xcd_barrier(xbar);
    phase_mlstm(p, sm);
    xcd_barrier(xbar);
    phase_h1l(p);
    xcd_barrier(xbar);
    run_gemm((const bf16_t*)(p.ws + OFF_H1B), (const bf16_t*)(p.ws + OFF_WT1) + (size_t)2048 * 1024, NB * NL, 2048, DM, EpBf16{(bf16_t*)(p.ws + OFF_XM), 2048, 2048}, sm);
    xcd_barrier(xbar);
    phase_finish1(p);
    xcd_barrier(xbar);
    run_gemm((const bf16_t*)(p.ws + OFF_H), (const bf16_t*)(p.ws + OFF_WT3), NB * NL, DM, 2048, EpRes1{(float*)(p.ws + OFF_XC), modv + 3 * 3072}, sm);
    xcd_barrier(xbar);
    ln_rows((const float*)(p.ws + OFF_XC), p.out, p.out, NB * NL, p.in[6] + 1024, p.in[7] + 1024, p.out, p.out, 0);
}

extern "C" void kernel_launch(void* const* d_in, const int* in_sizes, int n_in, void* d_out, int out_size, void* d_ws, size_t ws_size, hipStream_t stream) {
    static int grid_blocks = 0;
    if (grid_blocks == 0) {
        if (ws_size < WS_NEED || n_in != 46) { fprintf(stderr, "kernel_launch: bad ws_size %zu (need %zu) or n_in %d\n", ws_size, (size_t)WS_NEED, n_in); grid_blocks = -1; return; }
        int dev = 0, cus = 0, per_cu = 0;
        (void)hipGetDevice(&dev);
        (void)hipDeviceGetAttribute(&cus, hipDeviceAttributeMultiprocessorCount, dev);
        (void)hipFuncSetAttribute((const void*)fwd_kernel, hipFuncAttributeMaxDynamicSharedMemorySize, LDS_BYTES);
        (void)hipOccupancyMaxActiveBlocksPerMultiprocessor(&per_cu, (const void*)fwd_kernel, NTHR, LDS_BYTES);
        if (per_cu < 1 || cus < 256) { fprintf(stderr, "kernel_launch: occupancy query says %d blocks/CU on %d CUs; this kernel needs 256 resident workgroups\n", per_cu, cus); grid_blocks = -1; return; }
        grid_blocks = 256;
    }
    if (grid_blocks < 0) return;
    (void)hipMemsetAsync((char*)d_ws + OFF_BAR, 0, XCD_BAR_WORDS * 4, stream);
    Params p{};
    for (int i = 0; i < 46; ++i) p.in[i] = (const float*)d_in[i];
    p.out = (float*)d_out; p.ws = (char*)d_ws;
    void* args[] = {&p};
    hipError_t e = hipLaunchCooperativeKernel((const void*)fwd_kernel, dim3(grid_blocks), dim3(NTHR), args, LDS_BYTES, stream);
    if (e != hipSuccess) fprintf(stderr, "cooperative launch failed: %s (grid %d)\n", hipGetErrorString(e), grid_blocks);
}
```

```cpp
#include <hip/hip_runtime.h>
#include <cstdio>
#include <cmath>

#define DEV __device__ __forceinline__

constexpr int NB = 2, NL = 8192, DM = 1024, NCX = 256, TB = NCX + NL;
constexpr int RT = NB * TB;
constexpr int NCH = TB / 64;
constexpr int EIN = 3872, RW0 = 1568;
constexpr int NTHR = 512, NWV = 8;
constexpr float ALPHA = 1.41421356237f;
constexpr float KSCALE = 0.04419417382f;

constexpr size_t OFF_MODV = 0;
constexpr size_t OFF_X1C  = 131072;
constexpr size_t OFF_BAR  = 3145728;
constexpr size_t OFF_BIG  = 4194304;
constexpr size_t OFF_P0   = OFF_BIG;
constexpr size_t OFF_YC   = OFF_BIG + (size_t)TB * EIN * 2;
constexpr size_t OFF_GDS  = OFF_YC + (size_t)TB * 1024 * 2;
constexpr size_t OFF_GDEC = OFF_GDS + (size_t)8 * NCH * 8192 * 4;
constexpr size_t OFF_RU   = OFF_GDEC + (size_t)8 * NCH * 64 * 4;
constexpr size_t OFF_RS0  = OFF_RU + (size_t)16 * NCH * 16384 * 2;
constexpr size_t OFF_BONS = OFF_RS0 + (size_t)16 * NCH * 4096 * 2;
constexpr size_t L0_END   = OFF_BONS + (size_t)2 * TB * 8 * 4;
constexpr size_t OFF_XM   = OFF_BIG;
constexpr size_t OFF_XC   = OFF_XM + (size_t)RT * 2048 * 2;
constexpr size_t OFF_H    = OFF_XC + (size_t)RT * 2048 * 2;
constexpr size_t OFF_WT0  = OFF_H + (size_t)NB * NL * 2048 * 2;
constexpr size_t OFF_WT1  = OFF_WT0 + (size_t)4096 * 1024 * 2;
constexpr size_t OFF_WT2  = OFF_WT1 + (size_t)4096 * 1024 * 2;
constexpr size_t OFF_WT3  = OFF_WT2 + (size_t)1024 * 1024 * 2;
constexpr size_t OFF_G16  = OFF_WT3 + (size_t)1024 * 2048 * 2;
constexpr size_t OFF_SMAT = OFF_G16 + (size_t)RT * 16 * 4;
constexpr size_t OFF_GSC  = OFF_SMAT + (size_t)NB * 4 * NCH * 4096 * 2;
constexpr size_t OFF_CSC  = OFF_GSC + (size_t)16 * TB * 4 * 4;
constexpr size_t OFF_NBUF = OFF_CSC + (size_t)16 * NCH * 2 * 4;
constexpr size_t OFF_GTAB = 3407872;
constexpr size_t OFF_WFT  = OFF_GTAB + (size_t)4 * 128 * 16 * 4;
static_assert(OFF_WFT + (size_t)16 * 4096 * 2 <= OFF_BIG, "low-region tables overflow");
constexpr size_t OFF_G16P = OFF_NBUF + (size_t)16 * NCH * 512 * 4;
constexpr size_t OFF_H1B  = OFF_G16;
constexpr size_t WS_NEED  = (OFF_G16P + (size_t)4 * RT * 16 * 4 > OFF_H1B + (size_t)RT * 1024 * 2) ? OFF_G16P + (size_t)4 * RT * 16 * 4 : OFF_H1B + (size_t)RT * 1024 * 2;
static_assert(WS_NEED <= (size_t)256 * 1024 * 1024, "workspace exceeds the guaranteed 256 MiB");

static_assert(L0_END <= OFF_WT0, "layer-0 buffers overlap the weight copies");
constexpr int LDS_BYTES = 139264;

struct Params { const float* in[46]; float* out; char* ws; };
typedef unsigned short bf16_t;
typedef __attribute__((ext_vector_type(8))) short bf16x8;
typedef __attribute__((ext_vector_type(4))) short s16x4;
typedef __attribute__((ext_vector_type(2))) short s16x2;
typedef __attribute__((ext_vector_type(4))) float f32x4;
typedef __attribute__((ext_vector_type(2))) __bf16 bf2_t;
DEV unsigned pack2bf(float lo, float hi) { bf2_t v; v[0] = (__bf16)lo; v[1] = (__bf16)hi; return __builtin_bit_cast(unsigned, v); }
DEV float bflo(unsigned u) { return __uint_as_float(u << 16); }
DEV float bfhi(unsigned u) { return __uint_as_float(u & 0xffff0000u); }
DEV float bf2f(bf16_t v) { return __uint_as_float(((unsigned)v) << 16); }
DEV void unpack8(uint4 u, float* f) { f[0] = bflo(u.x); f[1] = bfhi(u.x); f[2] = bflo(u.y); f[3] = bfhi(u.y); f[4] = bflo(u.z); f[5] = bfhi(u.z); f[6] = bflo(u.w); f[7] = bfhi(u.w); }

DEV float wave_sum(float v) {
#pragma unroll
    for (int o = 32; o > 0; o >>= 1) v += __shfl_xor(v, o, 64);
    return v;
}
DEV float wave_max(float v) {
#pragma unroll
    for (int o = 32; o > 0; o >>= 1) v = fmaxf(v, __shfl_xor(v, o, 64));
    return v;
}
DEV float fexp(float x) { return __expf(x); }
DEV float frcp(float x) { return __builtin_amdgcn_rcpf(x); }
DEV float sigmoid_f(float x) { return frcp(1.f + fexp(-x)); }
DEV float silu_f(float x) { return x * frcp(1.f + fexp(-x)); }
DEV float logsig_f(float x) { return fminf(x, 0.f) - __logf(1.f + fexp(-fabsf(x))); }
DEV float tanh_f(float x) { const float e = fexp(2.f * x); return 1.f - 2.f * frcp(e + 1.f); }
DEV void lds_fence() { asm volatile("" ::: "memory"); }
DEV int opaque_tid() { int t = threadIdx.x; asm volatile("" : "+v"(t)); return t; }
DEV int scan_s(int dir, int u) { return dir == 0 ? u : (u < NCX ? (NCX - 1 - u) : (TB - 1 + NCX - u)); }
DEV int chunk_at(int dir, int step) { return dir == 0 ? step : (step < 4 ? 3 - step : (NCH + 3 - step)); }
DEV float4 ld4(const float* p) { return *(const float4*)p; }
DEV void st4(float* p, float4 v) { *(float4*)p = v; }


#define XB_TMO      128
#define XB_XCNT(j)  (256  + 64 * (j))
#define XB_XSUB(j)  (1280 + 64 * (j))
#define XB_XGEN(j)  (2304 + 64 * (j))
#define XB_TOP      3328
#define XB_TOPGEN   3392
#define XCD_BAR_WORDS 3456
#define XB_SPIN_CAP (1u << 22)
#define LAS __attribute__((address_space(3)))
DEV unsigned xb_ld(unsigned* p) { return __hip_atomic_load(p, __ATOMIC_RELAXED, __HIP_MEMORY_SCOPE_AGENT); }
DEV unsigned xb_add(unsigned* p, unsigned v) { return __hip_atomic_fetch_add(p, v, __ATOMIC_RELAXED, __HIP_MEMORY_SCOPE_AGENT); }
DEV unsigned xb_xcc_id() { return (unsigned)__builtin_amdgcn_s_getreg((3 << 11) | 20) & 0xFu; }
#define XB_SPIN(cond, bar) do { unsigned _sp = 0; while (cond) { __builtin_amdgcn_s_sleep(1); \
    if ((++_sp & 255u) == 0u) { if (xb_ld(&(bar)[XB_TMO])) break; if (_sp > XB_SPIN_CAP) { atomicAdd(&(bar)[XB_TMO], 1u); break; } } } } while (0)
struct XcdBarrier { unsigned* bar; unsigned x; volatile LAS unsigned* st; };
DEV XcdBarrier xcd_barrier_post(unsigned* bar, volatile LAS unsigned* st) {
    XcdBarrier b; b.bar = bar; b.x = xb_xcc_id(); b.st = st;
    if (threadIdx.x == 0) (void)xb_add(&bar[XB_XCNT(b.x)], 1u);
    return b;
}
DEV void xcd_barrier_complete(unsigned* bar, unsigned x, unsigned& nloc, unsigned& nx) {
    const unsigned G = gridDim.x * gridDim.y * gridDim.z;
    unsigned sum, cnt, mine, sp = 0u;
    for (;;) {
        sum = 0u; cnt = 0u; mine = 0u;
#pragma unroll
        for (unsigned j = 0; j < 16; ++j) { const unsigned c = xb_ld(&bar[XB_XCNT(j)]); sum += c; cnt += (c > 0u) ? 1u : 0u; mine = (j == x) ? c : mine; }
        if (sum == G) break;
        __builtin_amdgcn_s_sleep(1);
        if ((++sp & 255u) == 0u) { if (xb_ld(&bar[XB_TMO])) break; if (sp > XB_SPIN_CAP) { atomicAdd(&bar[XB_TMO], 1u); break; } }
    }
    nloc = mine > 0u ? mine : 1u; nx = cnt > 0u ? cnt : 1u;
}
DEV void xcd_barrier(const XcdBarrier& b) {
    asm volatile("s_waitcnt vmcnt(0)" ::: "memory");
    __syncthreads();
    if (threadIdx.x == 0) {
        unsigned* bar = b.bar;
        __builtin_amdgcn_s_waitcnt(0);
        unsigned nloc = b.st[0], nx = b.st[1];
        if (nloc == 0u) { xcd_barrier_complete(bar, b.x, nloc, nx); b.st[0] = nloc; b.st[1] = nx; }
        const unsigned old = xb_add(&bar[XB_XSUB(b.x)], 1u);
        const unsigned gen = old / nloc;
        if (old + 1u == (gen + 1u) * nloc) {
            __builtin_amdgcn_fence(__ATOMIC_RELEASE, "agent");
            asm volatile("s_waitcnt vmcnt(0)" ::: "memory");
            const unsigned og = xb_add(&bar[XB_TOP], 1u);
            const unsigned tg = og / nx;
            if (og + 1u == (tg + 1u) * nx) xb_add(&bar[XB_TOPGEN], 1u);
            else XB_SPIN(xb_ld(&bar[XB_TOPGEN]) == tg, bar);
            __builtin_amdgcn_fence(__ATOMIC_ACQUIRE, "agent");
            xb_add(&bar[XB_XGEN(b.x)], 1u);
            asm volatile("s_waitcnt vmcnt(0)" ::: "memory");
        } else {
            XB_SPIN(xb_ld(&bar[XB_XGEN(b.x)]) == gen, bar);
            __builtin_amdgcn_fence(__ATOMIC_ACQUIRE, "agent");
            asm volatile("s_waitcnt vmcnt(0)" ::: "memory");
        }
    }
    __syncthreads();
}

namespace pg8 {
#define PG8_LAS __attribute__((address_space(3)))
typedef unsigned short bf16_t;
typedef short bf16x8 __attribute__((ext_vector_type(8)));
typedef float f32x4 __attribute__((ext_vector_type(4)));
typedef unsigned u32x4 __attribute__((ext_vector_type(4)));
constexpr int BM = 256, BK = 64, HALF = 128, HTB = HALF * BK * 2  , STAGE_BYTES = 8 * HTB, NXCD = 8, WGM = 8;

__host__ __device__ __forceinline__ int lds_byte(int r, int c) { const int st = (r >> 4) * 2 + (c >> 5), rr = r & 15, cc = c & 31, ob = rr * 64 + cc * 2; return st * 1024 + (ob ^ (((ob >> 9) & 1) << 5)); }
__host__ __device__ __forceinline__ void stage_rc(int b, int& R, int& C) { const int st = b / 1024, sb = b % 1024, swz = sb ^ (((sb >> 9) & 1) << 5); R = (st >> 1) * 16 + swz / 64; C = (st & 1) * 32 + (swz % 64) / 2; }
__host__ __device__ __forceinline__ int perm32(int rho) { const int n = rho >> 4, i = rho & 15; return 8 * (i >> 2) + 4 * n + (i & 3); }

struct Unit { int pm, pn; };
struct Gemm { const bf16_t* A; const bf16_t* Bt; int M, N, K; };

struct StaticOrder {
    int nM, nN, nwg, G, c;
    __host__ __device__ void init(int M, int N, int G_, int c_) { nM = M / BM; nN = N / BM; nwg = nM * nN; G = G_; c = c_; }
    __host__ __device__ bool next(int i, Unit& u) const {
        const long L = (long)i * G + c; if (L >= nwg) return false;
        int wgid = (int)L; { const int q = nwg / NXCD, r = nwg % NXCD, xcd = wgid % NXCD, off = wgid / NXCD; wgid = (xcd < r ? xcd * (q + 1) : r * (q + 1) + (xcd - r) * q) + off; }
        const int nig = WGM * nN, gid = wgid / nig, fm = gid * WGM, gsz = (nM - fm) < WGM ? (nM - fm) : WGM;
        u.pm = fm + ((wgid % nig) % gsz); u.pn = (wgid % nig) / gsz; return true;
    }
    __device__ __forceinline__ void a_ready(const Unit&) const {}
    __device__ __forceinline__ void done(const Unit&) const {}
};

template <class Epi, class Sched, bool STAMP = false>
__device__ __forceinline__ void gemm_phase(PG8_LAS unsigned char* lds, const Gemm g, const Sched& S, const Epi& E, unsigned long long* stamps) {
    int tid = threadIdx.x; asm volatile("" : "+v"(tid));
    const int wid = __builtin_amdgcn_readfirstlane(tid >> 6), lane = tid & 63, wr = wid >> 2, wc = wid & 3, fr = lane & 15, fq = lane >> 4;
    const int K = g.K, nt = K / BK;
#define PG8_STAMP() do { } while (0)
    PG8_STAMP();
    unsigned voffA[2], voffB[2];
#pragma unroll
    for (int i = 0; i < 2; ++i) { int R, C; stage_rc(tid * 16 + i * 8192, R, C); const int Rb = Epi::PERM ? ((R & ~31) + perm32(R & 31)) : R;
        voffA[i] = (unsigned)(R * K + C) * 2u; voffB[i] = (unsigned)(Rb * K + C) * 2u; }
    const size_t kstep = (size_t)(BK * 2);
    const size_t hstep = (size_t)HALF * K * 2;
    const size_t tstep = 2 * hstep;
    const unsigned ldsw = (unsigned)wid * 1024u;
    const int aoff = lds_byte(wr * 64 + fr, fq * 8), boff = lds_byte(wc * 32 + fr, fq * 8);
#define PG8_SA(b, h) (((b) * 2 + (h)) * HTB)
#define PG8_SB(b, h) ((4 + (b) * 2 + (h)) * HTB)
#define PG8_STAGE(bufoff, gbase, voff) do { _Pragma("unroll") for (int _i = 0; _i < 2; ++_i) \
        __builtin_amdgcn_global_load_lds((const unsigned*)((const char*)(gbase) + (voff)[_i]), (PG8_LAS unsigned*)(lds + (bufoff) + ldsw + _i * 8192), 16, 0, 0); } while (0)
#define PG8_LDA(dst, b, h) do { _Pragma("unroll") for (int m = 0; m < 4; ++m) _Pragma("unroll") for (int k = 0; k < 2; ++k) dst[m][k] = *(const PG8_LAS bf16x8*)(lds + PG8_SA(b, h) + aoff + m * 2048 + k * 1024); } while (0)
#define PG8_LDB(dst, b, h) do { _Pragma("unroll") for (int n = 0; n < 2; ++n) _Pragma("unroll") for (int k = 0; k < 2; ++k) dst[n][k] = *(const PG8_LAS bf16x8*)(lds + PG8_SB(b, h) + boff + n * 2048 + k * 1024); } while (0)
#define PG8_MMA(ai, bj, At, Bt) do { __builtin_amdgcn_s_setprio(1); _Pragma("unroll") for (int m = 0; m < 4; ++m) _Pragma("unroll") for (int n = 0; n < 2; ++n) _Pragma("unroll") for (int k = 0; k < 2; ++k) \
        acc[ai][bj][m][n] = __builtin_amdgcn_mfma_f32_16x16x32_bf16(Bt[n][k], At[m][k], acc[ai][bj][m][n], 0, 0, 0); __builtin_amdgcn_s_setprio(0); } while (0)
#define PG8_WAIT_V(n) asm volatile("s_waitcnt vmcnt(" #n ")" ::: "memory")
#define PG8_WAIT_L(n) asm volatile("s_waitcnt lgkmcnt(" #n ")" ::: "memory")
#define PG8_BAR __builtin_amdgcn_s_barrier()
#define PG8_SCHED __builtin_amdgcn_sched_barrier(0)
    Unit cur, nxt; int ui = 0;
    if (!S.next(0, cur)) return;
    f32x4 acc[2][2][4][2];
#pragma unroll
    for (int a = 0; a < 2; ++a)
#pragma unroll
        for (int b = 0; b < 2; ++b)
#pragma unroll
            for (int m = 0; m < 4; ++m)
#pragma unroll
                for (int n = 0; n < 2; ++n) acc[a][b][m][n] = (f32x4){0.f, 0.f, 0.f, 0.f};
    bf16x8 At[4][2], B0[2][2], B1[2][2];
    const char* cA = (const char*)g.A + (size_t)cur.pm * tstep; const char* cB = (const char*)g.Bt + (size_t)cur.pn * tstep;
    S.a_ready(cur);
    PG8_STAGE(PG8_SB(0, 0), cB, voffB); PG8_STAGE(PG8_SA(0, 0), cA, voffA); PG8_STAGE(PG8_SB(0, 1), cB + hstep, voffB); PG8_STAGE(PG8_SA(0, 1), cA + hstep, voffA);
    if (wr == 1) PG8_BAR;
    PG8_WAIT_V(4); PG8_BAR;
    PG8_STAGE(PG8_SB(1, 0), cB + kstep, voffB); PG8_STAGE(PG8_SA(1, 0), cA + kstep, voffA); PG8_STAGE(PG8_SB(1, 1), cB + hstep + kstep, voffB);
    PG8_WAIT_V(6); PG8_BAR;
    PG8_STAMP();
    for (;;) {
        const bool has_next = S.next(ui + 1, nxt);
        const char* nA = has_next ? (const char*)g.A + (size_t)nxt.pm * tstep : cA; const char* nB = has_next ? (const char*)g.Bt + (size_t)nxt.pn * tstep : cB;
        for (int t = 0; t < nt; t += 2) {
            const bool last = (t == nt - 2);
            const char* a1 = cA + (size_t)(t + 1) * kstep;
            const char* a2 = last ? nA : cA + (size_t)(t + 2) * kstep; const char* b2 = last ? nB : cB + (size_t)(t + 2) * kstep;
            const char* a3 = a2 + kstep; const char* b3 = b2 + kstep;
            if (last && has_next) S.a_ready(nxt);
            PG8_LDB(B0, 0, 0); PG8_SCHED; PG8_LDA(At, 0, 0); PG8_STAGE(PG8_SA(1, 1), a1 + hstep, voffA);
            PG8_WAIT_L(8); PG8_BAR; PG8_WAIT_L(0); PG8_MMA(0, 0, At, B0); PG8_BAR; PG8_SCHED;
            PG8_LDB(B1, 0, 1); PG8_STAGE(PG8_SB(0, 0), b2, voffB);
            PG8_BAR; PG8_WAIT_L(0); PG8_MMA(0, 1, At, B1); PG8_BAR;
            PG8_LDA(At, 0, 1); PG8_STAGE(PG8_SA(0, 0), a2, voffA);
            PG8_BAR; PG8_WAIT_L(0); PG8_MMA(1, 0, At, B0); PG8_BAR; PG8_SCHED;
            PG8_STAGE(PG8_SB(0, 1), b2 + hstep, voffB);
            PG8_WAIT_V(6); PG8_BAR; PG8_MMA(1, 1, At, B1); PG8_BAR;
            PG8_LDB(B0, 1, 0); PG8_SCHED; PG8_LDA(At, 1, 0); PG8_STAGE(PG8_SA(0, 1), a2 + hstep, voffA);
            PG8_WAIT_L(8); PG8_BAR; PG8_WAIT_L(0); PG8_MMA(0, 0, At, B0); PG8_BAR; PG8_SCHED;
            PG8_LDB(B1, 1, 1); PG8_STAGE(PG8_SB(1, 0), b3, voffB);
            PG8_BAR; PG8_WAIT_L(0); PG8_MMA(0, 1, At, B1); PG8_BAR;
            PG8_LDA(At, 1, 1); PG8_STAGE(PG8_SA(1, 0), a3, voffA);
            PG8_BAR; PG8_WAIT_L(0); PG8_MMA(1, 0, At, B0); PG8_BAR; PG8_SCHED;
            PG8_STAGE(PG8_SB(1, 1), b3 + hstep, voffB);
            PG8_WAIT_V(6); PG8_BAR; PG8_MMA(1, 1, At, B1); PG8_BAR;
        }
        PG8_STAMP();
        if constexpr (!Epi::AFTER_DRAIN) { E(acc, cur, wr, wc, fr, fq); S.done(cur); }
        PG8_STAMP();
        if (!has_next) break;
#pragma unroll
        for (int a = 0; a < 2; ++a)
#pragma unroll
            for (int b = 0; b < 2; ++b)
#pragma unroll
                for (int m = 0; m < 4; ++m)
#pragma unroll
                    for (int n = 0; n < 2; ++n) acc[a][b][m][n] = (f32x4){0.f, 0.f, 0.f, 0.f};
        cur = nxt; cA = nA; cB = nB; ++ui;
    }
    PG8_WAIT_V(0);
    if (wr == 0) PG8_BAR;
    PG8_BAR;
    if constexpr (Epi::AFTER_DRAIN) { E.fused(acc, cur, wr, wc, fr, fq, lds, wid, lane); S.done(cur); }
    PG8_STAMP();
#undef PG8_STAMP
#undef PG8_SA
#undef PG8_SB
#undef PG8_STAGE
#undef PG8_LDA
#undef PG8_LDB
#undef PG8_MMA
#undef PG8_WAIT_V
#undef PG8_WAIT_L
#undef PG8_BAR
#undef PG8_SCHED
}
}

DEV void transpose_convert(const float* __restrict__ W, int K, int N, int Npad, bf16_t* Wt, float* sm) {
    float (*T)[65] = (float (*)[65])sm;
    const int tid = opaque_tid();
    const int kt = K / 64, ntl = Npad / 64;
    for (int tile = blockIdx.x; tile < kt * ntl; tile += gridDim.x) {
        const int k0 = (tile / ntl) * 64, n0 = (tile % ntl) * 64;
        __syncthreads();
#pragma unroll
        for (int i = 0; i < 2; ++i) {
            const int k = (tid >> 4) + 32 * i, n4 = (tid & 15) * 4;
            float4 v = make_float4(0.f, 0.f, 0.f, 0.f);
            if (n0 + n4 < N) v = ld4(W + (size_t)(k0 + k) * N + n0 + n4);
            T[k][n4] = v.x; T[k][n4 + 1] = v.y; T[k][n4 + 2] = v.z; T[k][n4 + 3] = v.w;
        }
        __syncthreads();
        const int n = tid >> 3, kq = (tid & 7) * 8;
        unsigned o[4];
#pragma unroll
        for (int j = 0; j < 4; ++j) o[j] = pack2bf(T[kq + 2 * j][n], T[kq + 2 * j + 1][n]);
        bf16_t* dst = Wt + (size_t)(n0 + n) * K + k0 + kq;
        *(uint4*)dst = make_uint4(o[0], o[1], o[2], o[3]);
    }
}

struct EpBf16 {
    static constexpr bool PERM = true, AFTER_DRAIN = false;
    bf16_t* O; int ldc; int ncols;
    DEV void operator()(const pg8::f32x4 (&acc)[2][2][4][2], const pg8::Unit& u, int wr, int wc, int fr, int fq) const {
        const int row0 = u.pm * 256 + wr * 64 + fr, col0 = u.pn * 256 + wc * 32 + 8 * fq;
#pragma unroll
        for (int ai = 0; ai < 2; ++ai)
#pragma unroll
            for (int m = 0; m < 4; ++m) {
                bf16_t* rowp = O + (size_t)(row0 + ai * 128 + m * 16) * ldc + col0;
#pragma unroll
                for (int bj = 0; bj < 2; ++bj) {
                    if (col0 + bj * 128 < ncols) {
                        const pg8::f32x4 v0 = acc[ai][bj][m][0], v1 = acc[ai][bj][m][1];
                        *(uint4*)(rowp + bj * 128) = make_uint4(pack2bf(v0[0], v0[1]), pack2bf(v0[2], v0[3]), pack2bf(v1[0], v1[1]), pack2bf(v1[2], v1[3]));
                    }
                }
            }
    }
};
struct EpRes0 {
    static constexpr bool PERM = false, AFTER_DRAIN = false;
    float* C; const float* mv; int b;
    DEV void operator()(const pg8::f32x4 (&acc)[2][2][4][2], const pg8::Unit& u, int wr, int wc, int fr, int fq) const {
        const bool isc = (u.pm * 256 < NCX);
        const float* gp = mv + (isc ? 2 : b) * 3072 + 2048;
        const int row0 = u.pm * 256 + wr * 64 + fr, col0 = u.pn * 256 + wc * 32 + 4 * fq;
#pragma unroll
        for (int ai = 0; ai < 2; ++ai)
#pragma unroll
            for (int m = 0; m < 4; ++m) {
                const size_t ro = (size_t)(row0 + ai * 128 + m * 16) * DM + col0;
#pragma unroll
                for (int bj = 0; bj < 2; ++bj)
#pragma unroll
                    for (int n = 0; n < 2; ++n) {
                        const int co = bj * 128 + n * 16;
                        const float4 g = ld4(gp + col0 + co); const pg8::f32x4 v = acc[ai][bj][m][n];
                        st4(C + ro + co, make_float4(g.x * v[0], g.y * v[1], g.z * v[2], g.w * v[3]));
                    }
            }
    }
};
struct EpRes1 {
    static constexpr bool PERM = false, AFTER_DRAIN = false;
    float* C; const float* mv;
    DEV void operator()(const pg8::f32x4 (&acc)[2][2][4][2], const pg8::Unit& u, int wr, int wc, int fr, int fq) const {
        const float* gp = mv + (u.pm * 256 >= NL ? 1 : 0) * 3072 + 2048;
        const int row0 = u.pm * 256 + wr * 64 + fr, col0 = u.pn * 256 + wc * 32 + 4 * fq;
#pragma unroll
        for (int ai = 0; ai < 2; ++ai)
#pragma unroll
            for (int m = 0; m < 4; ++m) {
                const size_t ro = (size_t)(row0 + ai * 128 + m * 16) * DM + col0;
#pragma unroll
                for (int bj = 0; bj < 2; ++bj)
#pragma unroll
                    for (int n = 0; n < 2; ++n) {
                        const int co = bj * 128 + n * 16;
                        const float4 g = ld4(gp + col0 + co); const pg8::f32x4 v = acc[ai][bj][m][n];
                        st4(C + ro + co, make_float4(g.x * v[0], g.y * v[1], g.z * v[2], g.w * v[3]));
                    }
            }
    }
};
template <class EP>
DEV void run_gemm(const bf16_t* A, const bf16_t* Bt, int M, int N, int K, const EP& ep, float* sm) {
    pg8::Gemm g{A, Bt, M, N, K}; pg8::StaticOrder S; S.init(M, N, (int)gridDim.x, (int)blockIdx.x);
    pg8::gemm_phase<EP, pg8::StaticOrder, false>((PG8_LAS unsigned char*)sm, g, S, ep, nullptr);
}

DEV void phase_h0(const Params& p, int b) {
    const float* modv = (const float*)(p.ws + OFF_MODV);
    bf16_t* H0 = (bf16_t*)(p.ws + OFF_YC);
    const int gt = blockIdx.x * NTHR + opaque_tid(), gn = gridDim.x * NTHR;
    for (int i = gt; i < TB * 128; i += gn) {
        const int s = i >> 7, k = (i & 127) * 8;
        const float* src; int j;
        if (s < NCX) { src = p.in[2] + ((size_t)(b * NCX + s)) * DM + k; j = 2; }
        else { src = p.in[0] + ((size_t)(b * NL + s - NCX)) * DM + k; j = b; }
        const float4 x0 = ld4(src), x1 = ld4(src + 4);
        const float* m = modv + j * 3072;
        const float4 s0 = ld4(m + k), s1 = ld4(m + k + 4), c0 = ld4(m + 1024 + k), c1 = ld4(m + 1024 + k + 4);
        *(uint4*)(H0 + (size_t)s * DM + k) = make_uint4(pack2bf(x0.x * (1.f + c0.x) + s0.x, x0.y * (1.f + c0.y) + s0.y), pack2bf(x0.z * (1.f + c0.z) + s0.z, x0.w * (1.f + c0.w) + s0.w),
                                                      pack2bf(x1.x * (1.f + c1.x) + s1.x, x1.y * (1.f + c1.y) + s1.y), pack2bf(x1.z * (1.f + c1.z) + s1.z, x1.w * (1.f + c1.w) + s1.w));
    }
}

DEV void phase_mod(const Params& p, float* sm) {
    const float* c = p.in[1]; const float* cctx = p.in[3];
    const float* mod_w = p.in[4]; const float* mod_b = p.in[5];
    float* modv = (float*)(p.ws + OFF_MODV);
    float* sil = sm; float* red = sm + 3072;
    const int tid = opaque_tid();
    for (int i = tid; i < 3072; i += NTHR) {
        const int j = i >> 10, k = i & 1023;
        const float v = (j < 2) ? c[j * 1024 + k] : cctx[k];
        sil[i] = silu_f(v);
    }
    __syncthreads();
    for (int unit = blockIdx.x; unit < 192; unit += gridDim.x) {
        const int l = unit / 96, cb = unit % 96;
        const int kg = tid >> 5, col = tid & 31, n = cb * 32 + col;
        const float* w = mod_w + (size_t)l * 1024 * 3072 + n;
        float a0 = 0.f, a1 = 0.f, a2 = 0.f;
        for (int k = kg * 64; k < kg * 64 + 64; ++k) {
            const float wv = w[(size_t)k * 3072];
            a0 += sil[k] * wv; a1 += sil[1024 + k] * wv; a2 += sil[2048 + k] * wv;
        }
        red[(kg * 3 + 0) * 32 + col] = a0; red[(kg * 3 + 1) * 32 + col] = a1; red[(kg * 3 + 2) * 32 + col] = a2;
        __syncthreads();
        if (tid < 96) {
            const int j = tid >> 5, cc = tid & 31, nn = cb * 32 + cc;
            float s = mod_b[l * 3072 + nn];
            for (int g = 0; g < 16; ++g) s += red[(g * 3 + j) * 32 + cc];
            modv[(l * 3 + j) * 3072 + nn] = s;
        }
        __syncthreads();
    }
}

DEV void phase_tables(const Params& p) {
    const float* wq = p.in[33]; const float* wk = p.in[34]; const float* wv = p.in[35];
    const float* gw0 = p.in[36]; const float* gw1 = p.in[38]; const float* gw2 = p.in[40]; const float* gw3 = p.in[42];
    float* gtab = (float*)(p.ws + OFF_GTAB); bf16_t* wft = (bf16_t*)(p.ws + OFF_WFT);
    const int gt = blockIdx.x * NTHR + opaque_tid(), gn = gridDim.x * NTHR;
    for (int i = gt; i < 512 * 16; i += gn) {
        const int gb = i >> 4, cp = (i >> 2) & 3, c = i & 3;
        float s = 0.f;
#pragma unroll
        for (int d = 0; d < 4; ++d) s += wq[gb * 16 + cp * 4 + d] * wk[gb * 16 + c * 4 + d];
        gtab[i] = s * KSCALE;
    }
    for (int i = gt; i < 4096 * 16; i += gn) {
        const int g = i >> 12, k = i & 4095, gm = g >> 2, hd = g & 3;
        const float* wg = gm == 0 ? gw0 : (gm == 1 ? gw1 : (gm == 2 ? gw2 : gw3));
        float s = 0.f;
        if (k < 2048) {
            const int blk = k >> 2, cc = k & 3;
#pragma unroll
            for (int d = 0; d < 4; ++d) s += wq[blk * 16 + cc * 4 + d] * wg[(size_t)(4 * blk + d) * 4 + hd] + wk[blk * 16 + cc * 4 + d] * wg[(size_t)(2048 + 4 * blk + d) * 4 + hd];
        } else {
            const int kk = k - 2048, blk = kk >> 2, cc = kk & 3;
#pragma unroll
            for (int d = 0; d < 4; ++d) s += wv[blk * 16 + cc * 4 + d] * wg[(size_t)(4096 + 4 * blk + d) * 4 + hd];
        }
        wft[i] = __builtin_bit_cast(unsigned short, (__bf16)s);
    }
}

DEV float wave_scan_add(float v, int lane, int dir) {
#pragma unroll
    for (int o = 1; o < 64; o <<= 1) {
        const float n = dir ? __shfl_down(v, o, 64) : __shfl_up(v, o, 64);
        const bool ok = dir ? (lane + o < 64) : (lane >= o);
        if (ok) v += n;
    }
    return v;
}
DEV float wave_scan_max(float v, int lane, int dir) {
#pragma unroll
    for (int o = 1; o < 64; o <<= 1) {
        const float n = dir ? __shfl_down(v, o, 64) : __shfl_up(v, o, 64);
        const bool ok = dir ? (lane + o < 64) : (lane >= o);
        if (ok) v = fmaxf(v, n);
    }
    return v;
}

DEV void gla_decay(const bf16_t* P0, int c, int h, int dir, const float* __restrict__ wa2, const float* __restrict__ ba,
                   float* sLR, float* sWA, float* sBC, float* sTot, int tid) {
    for (int i = tid; i < 1024; i += NTHR) { const int t = i >> 4, j = i & 15; sLR[i] = bf2f(P0[(size_t)(c * 64 + t) * EIN + 1536 + dir * 16 + j]); }
    for (int i = tid; i < 1024; i += NTHR) { const int ii = i >> 6, k = i & 63; sWA[i] = wa2[ii * 256 + h * 64 + k]; }
    __syncthreads();
    {
        const int t = tid >> 3, k0 = (tid & 7) * 8;
        float acc[8];
#pragma unroll
        for (int j = 0; j < 8; ++j) acc[j] = ba[h * 64 + k0 + j];
#pragma unroll
        for (int ii = 0; ii < 16; ++ii) {
            const float l = sLR[t * 16 + ii];
#pragma unroll
            for (int j = 0; j < 8; ++j) acc[j] += l * sWA[ii * 64 + k0 + j];
        }
#pragma unroll
        for (int j = 0; j < 8; ++j) sBC[t * 65 + k0 + j] = logsig_f(acc[j]) * 0.0625f;
    }
    __syncthreads();
    {
        const int lane = tid & 63, wv = tid >> 6;
#pragma unroll
        for (int j = 0; j < 8; ++j) {
            const int k = wv * 8 + j;
            const float v = wave_scan_add(sBC[lane * 65 + k], lane, dir);
            sBC[lane * 65 + k] = v;
            if (lane == (dir ? 0 : 63)) sTot[k] = v;
        }
    }
    __syncthreads();
}
DEV bf16x8 tr_frag(const bf16_t* base, int ld, int row0, int col0, int lane) {
    const bf16_t* ptr = base + (row0 + (lane >> 4) * 8 + ((lane & 15) >> 2)) * ld + col0 + (lane & 3) * 4;
    const s16x4 lo = __builtin_amdgcn_ds_read_tr16_b64_v4i16((__attribute__((address_space(3))) s16x4*)ptr);
    const s16x4 hi = __builtin_amdgcn_ds_read_tr16_b64_v4i16((__attribute__((address_space(3))) s16x4*)(ptr + 4 * ld));
    return (bf16x8){lo[0], lo[1], lo[2], lo[3], hi[0], hi[1], hi[2], hi[3]};
}
DEV bf16x8 row_frag(const bf16_t* base, int ld, int idx0, int k0, int lane) {
    return *(const bf16x8*)(base + (idx0 + (lane & 15)) * ld + k0 + (lane >> 4) * 8);
}

DEV void gla1_unit(const Params& p, int h, int dir, int c, float* sm) {
    const int tid = opaque_tid(), lane = tid & 63, wave = tid >> 6;
    const bf16_t* P0 = (const bf16_t*)(p.ws + OFF_P0);
    float* GDS = (float*)(p.ws + OFF_GDS); float* GDEC = (float*)(p.ws + OFF_GDEC);
    const float* wa2 = p.in[dir ? 12 : 10]; const float* ba = p.in[dir ? 13 : 11];
    float* sLR = sm; float* sWA = sm + 1024; float* sBC = sm + 2048; float* sTot = sm + 6208;
    bf16_t* kT = (bf16_t*)(sm + 6272);
    bf16_t* Vs = (bf16_t*)(sm + 8576);
    const int ch = h * 2 + dir;
    __syncthreads();
    gla_decay(P0, c, h, dir, wa2, ba, sLR, sWA, sBC, sTot, tid);
    {
        const int t = tid >> 3, k0 = (tid & 7) * 8;
        float kv[8]; unpack8(*(const uint4*)(P0 + (size_t)(c * 64 + t) * EIN + 256 + h * 64 + k0), kv);
#pragma unroll
        for (int j = 0; j < 8; ++j) kT[(k0 + j) * 72 + t] = __builtin_bit_cast(unsigned short, (__bf16)(kv[j] * fexp(sTot[k0 + j] - sBC[t * 65 + k0 + j])));
#pragma unroll
        for (int u = 0; u < 2; ++u) { const int i = tid + 512 * u, row = i >> 4, c16 = i & 15; *(uint4*)(Vs + row * 136 + c16 * 8) = *(const uint4*)(P0 + (size_t)(c * 64 + row) * EIN + 512 + h * 128 + c16 * 8); }
    }
    __syncthreads();
    {
        f32x4 acc[4];
#pragma unroll
        for (int kt = 0; kt < 4; ++kt) acc[kt] = (f32x4){0.f, 0.f, 0.f, 0.f};
#pragma unroll
        for (int ks = 0; ks < 2; ++ks) {
            const bf16x8 af = tr_frag(Vs, 136, ks * 32, wave * 16, lane);
#pragma unroll
            for (int kt = 0; kt < 4; ++kt) acc[kt] = __builtin_amdgcn_mfma_f32_16x16x32_bf16(af, row_frag(kT, 72, kt * 16, ks * 32, lane), acc[kt], 0, 0, 0);
        }
#pragma unroll
        for (int kt = 0; kt < 4; ++kt) {
            const int k = kt * 16 + (lane & 15), v = wave * 16 + (lane >> 4) * 4;
            st4(GDS + ((size_t)(ch * NCH + c) * 64 + k) * 128 + v, make_float4(acc[kt][0], acc[kt][1], acc[kt][2], acc[kt][3]));
        }
    }
    if (tid < 64) GDEC[(size_t)(ch * NCH + c) * 64 + tid] = fexp(sTot[tid]);
}

DEV void gla2_unit(const Params& p, int unit) {
    const int tid = opaque_tid();
    float* GDS = (float*)(p.ws + OFF_GDS); const float* GDEC = (const float*)(p.ws + OFF_GDEC);
    const int ch = unit >> 4, e = (unit & 15) * 512 + tid, k = e >> 7, dir = ch & 1;
    constexpr int GB = 12;
    float S = 0.f, ninc[GB], nd[GB];
#pragma unroll
    for (int j = 0; j < GB; ++j) { const int c = chunk_at(dir, j); ninc[j] = GDS[(size_t)(ch * NCH + c) * 8192 + e]; nd[j] = GDEC[(size_t)(ch * NCH + c) * 64 + k]; }
#pragma unroll 1
    for (int step0 = 0; step0 < NCH; step0 += GB) {
        float inc[GB], d[GB];
#pragma unroll
        for (int j = 0; j < GB; ++j) { inc[j] = ninc[j]; d[j] = nd[j]; }
#pragma unroll
        for (int j = 0; j < GB; ++j) { const int sn = step0 + GB + j, c = chunk_at(dir, sn < NCH ? sn : NCH - 1); ninc[j] = GDS[(size_t)(ch * NCH + c) * 8192 + e]; nd[j] = GDEC[(size_t)(ch * NCH + c) * 64 + k]; }
        __builtin_amdgcn_sched_barrier(0);
#pragma unroll
        for (int j = 0; j < GB; ++j) { const int c = chunk_at(dir, step0 + j); GDS[(size_t)(ch * NCH + c) * 8192 + e] = S; S = d[j] * S + inc[j]; }
    }
}

DEV void gla3_unit(const Params& p, int h, int c, float* sm) {
    const int tid = opaque_tid(), lane = tid & 63, wave = tid >> 6;
    const bf16_t* P0 = (const bf16_t*)(p.ws + OFF_P0);
    const float* GDS = (const float*)(p.ws + OFF_GDS);
    bf16_t* YC = (bf16_t*)(p.ws + OFF_YC);
    const float* ng = p.in[14];
    float* sLR = sm; float* sWA = sm + 1024; float* sBC = sm + 2048; float* sTot = sm + 6208;
    bf16_t* qt = (bf16_t*)(sm + 6272);
    bf16_t* kt = (bf16_t*)(sm + 8576);
    bf16_t* Sm = (bf16_t*)(sm + 10880);
    bf16_t* S0s = (bf16_t*)(sm + 13184);
    bf16_t* Vs = (bf16_t*)(sm + 17536);
    float* O = sm + 21888;
    const int ti = wave & 3, vt0 = (wave >> 2) * 4;
    f32x4 acc[4];
#pragma unroll
    for (int j = 0; j < 4; ++j) acc[j] = (f32x4){0.f, 0.f, 0.f, 0.f};
    __syncthreads();
#pragma unroll
    for (int u = 0; u < 2; ++u) { const int i = tid + 512 * u, row = i >> 4, c16 = i & 15; *(uint4*)(Vs + row * 136 + c16 * 8) = *(const uint4*)(P0 + (size_t)(c * 64 + row) * EIN + 512 + h * 128 + c16 * 8); }
#pragma unroll 1
    for (int dir = 0; dir < 2; ++dir) {
        const float* wa2 = p.in[dir ? 12 : 10]; const float* ba = p.in[dir ? 13 : 11];
        const int ch = h * 2 + dir;
        __syncthreads();
        gla_decay(P0, c, h, dir, wa2, ba, sLR, sWA, sBC, sTot, tid);
        {
            const int t = tid >> 3, k0 = (tid & 7) * 8;
            float qv[8], kv[8];
            unpack8(*(const uint4*)(P0 + (size_t)(c * 64 + t) * EIN + h * 64 + k0), qv);
            unpack8(*(const uint4*)(P0 + (size_t)(c * 64 + t) * EIN + 256 + h * 64 + k0), kv);
#pragma unroll
            for (int j = 0; j < 8; ++j) { const float bc = sBC[t * 65 + k0 + j]; qv[j] *= 0.125f * fexp(bc); kv[j] *= fexp(-bc); }
            *(uint4*)(qt + t * 72 + k0) = make_uint4(pack2bf(qv[0], qv[1]), pack2bf(qv[2], qv[3]), pack2bf(qv[4], qv[5]), pack2bf(qv[6], qv[7]));
            *(uint4*)(kt + t * 72 + k0) = make_uint4(pack2bf(kv[0], kv[1]), pack2bf(kv[2], kv[3]), pack2bf(kv[4], kv[5]), pack2bf(kv[6], kv[7]));
#pragma unroll
            for (int u = 0; u < 4; ++u) {
                const int i = tid + 512 * u, k = i >> 5, v4 = (i & 31) * 4;
                const float4 s4 = ld4(GDS + (size_t)(ch * NCH + c) * 8192 + k * 128 + v4);
                *(uint2*)(S0s + k * 136 + v4) = make_uint2(pack2bf(s4.x, s4.y), pack2bf(s4.z, s4.w));
            }
        }
        __syncthreads();
        {
            const int si = wave & 3;
#pragma unroll
            for (int jj = 0; jj < 2; ++jj) {
                const int t2 = (wave >> 2) * 2 + jj;
                f32x4 a = (f32x4){0.f, 0.f, 0.f, 0.f};
#pragma unroll
                for (int ks = 0; ks < 2; ++ks) a = __builtin_amdgcn_mfma_f32_16x16x32_bf16(row_frag(kt, 72, si * 16, ks * 32, lane), row_frag(qt, 72, t2 * 16, ks * 32, lane), a, 0, 0, 0);
                const int t = t2 * 16 + (lane & 15), s0 = si * 16 + (lane >> 4) * 4;
                float m[4];
#pragma unroll
                for (int r = 0; r < 4; ++r) { const bool keep = dir ? (s0 + r >= t) : (s0 + r <= t); m[r] = keep ? a[r] : 0.f; }
                *(uint2*)(Sm + t * 72 + s0) = make_uint2(pack2bf(m[0], m[1]), pack2bf(m[2], m[3]));
            }
        }
        __syncthreads();
#pragma unroll
        for (int ks = 0; ks < 2; ++ks) {
            const bf16x8 a1 = row_frag(qt, 72, ti * 16, ks * 32, lane), a2 = row_frag(Sm, 72, ti * 16, ks * 32, lane);
#pragma unroll
            for (int j = 0; j < 4; ++j) {
                acc[j] = __builtin_amdgcn_mfma_f32_16x16x32_bf16(a1, tr_frag(S0s, 136, ks * 32, (vt0 + j) * 16, lane), acc[j], 0, 0, 0);
                acc[j] = __builtin_amdgcn_mfma_f32_16x16x32_bf16(a2, tr_frag(Vs, 136, ks * 32, (vt0 + j) * 16, lane), acc[j], 0, 0, 0);
            }
        }
    }
#pragma unroll
    for (int j = 0; j < 4; ++j)
#pragma unroll
        for (int r = 0; r < 4; ++r) O[(ti * 16 + (lane >> 4) * 4 + r) * 132 + (vt0 + j) * 16 + (lane & 15)] = acc[j][r];
    __syncthreads();
    {
        const int t = tid >> 3, v0 = (tid & 7) * 16;
        float o[16];
        float ss = 0.f;
#pragma unroll
        for (int i = 0; i < 16; ++i) { o[i] = O[t * 132 + v0 + i]; ss += o[i] * o[i]; }
        ss += __shfl_xor(ss, 1, 64); ss += __shfl_xor(ss, 2, 64); ss += __shfl_xor(ss, 4, 64);
        const float rms = rsqrtf(ss * (1.f / 128.f) + 1e-5f);
        float g[16];
        const bf16_t* gp = P0 + (size_t)(c * 64 + t) * EIN + 1024 + h * 128 + v0;
        unpack8(*(const uint4*)gp, g); unpack8(*(const uint4*)(gp + 8), g + 8);
        float y[16];
#pragma unroll
        for (int i = 0; i < 16; ++i) y[i] = o[i] * rms * ng[v0 + i] * silu_f(g[i]);
        bf16_t* yp = YC + (size_t)(c * 64 + t) * 1024 + h * 128 + v0;
        *(uint4*)yp = make_uint4(pack2bf(y[0], y[1]), pack2bf(y[2], y[3]), pack2bf(y[4], y[5]), pack2bf(y[6], y[7]));
        *(uint4*)(yp + 8) = make_uint4(pack2bf(y[8], y[9]), pack2bf(y[10], y[11]), pack2bf(y[12], y[13]), pack2bf(y[14], y[15]));
    }
}

DEV void load8bf(const bf16_t* ptr, float* f) { unpack8(*(const uint4*)ptr, f); }
struct RwNb { int sL, sR, sU, sD; bool vL, vR, vU, vD; };
DEV RwNb rw_nb(int s) {
    RwNb q; q.vU = false; q.vD = false;
    if (s < NCX) { q.vL = s > 0; q.vR = s < NCX - 1; }
    else { const int n = s - NCX, rr = n >> 6, cc = n & 63; q.vL = cc > 0; q.vR = cc < 63; q.vU = rr > 0; q.vD = rr < 127; }
    q.sL = q.vL ? s - 1 : s; q.sR = q.vR ? s + 1 : s; q.sU = q.vU ? s - 64 : s; q.sD = q.vD ? s + 64 : s;
    return q;
}
struct RwRaw { uint4 o, l, r, u, d; };
DEV RwRaw rw_load(const bf16_t* P0, int s, const RwNb& q, int cb) {
    RwRaw w;
    w.o = *(const uint4*)(P0 + (size_t)s * EIN + RW0 + cb); w.l = *(const uint4*)(P0 + (size_t)q.sL * EIN + RW0 + cb); w.r = *(const uint4*)(P0 + (size_t)q.sR * EIN + RW0 + cb);
    w.u = *(const uint4*)(P0 + (size_t)q.sU * EIN + RW0 + cb); w.d = *(const uint4*)(P0 + (size_t)q.sD * EIN + RW0 + cb);
    return w;
}
DEV void rw_comb(const RwRaw& w, const RwNb& q, const float* __restrict__ mu, int cb, float* out) {
    float own[8]; unpack8(w.o, own);
    const float nb[8] = {q.vL ? bflo(w.l.x) : 0.f, q.vR ? bfhi(w.r.x) : 0.f, q.vU ? bflo(w.u.y) : 0.f, q.vD ? bfhi(w.d.y) : 0.f,
                         q.vL ? bflo(w.l.z) : 0.f, q.vR ? bfhi(w.r.z) : 0.f, q.vU ? bflo(w.u.w) : 0.f, q.vD ? bfhi(w.d.w) : 0.f};
    const float4 m0 = ld4(mu + cb), m1 = ld4(mu + cb + 4);
    const float m[8] = {m0.x, m0.y, m0.z, m0.w, m1.x, m1.y, m1.z, m1.w};
#pragma unroll
    for (int i = 0; i < 8; ++i) out[i] = own[i] + (nb[i] - own[i]) * m[i];
}
DEV uint4 pack8(const float* f) { return make_uint4(pack2bf(f[0], f[1]), pack2bf(f[2], f[3]), pack2bf(f[4], f[5]), pack2bf(f[6], f[7])); }

template <int XM, int YM, class F>
DEV void mm64(const bf16_t* X, const bf16_t* Y, F f, int lane, int wave) {
#pragma unroll
    for (int q = 0; q < 2; ++q) {
        const int idx = wave * 2 + q, ti = idx >> 2, tj = idx & 3;
        f32x4 acc = (f32x4){0.f, 0.f, 0.f, 0.f};
#pragma unroll
        for (int ks = 0; ks < 2; ++ks) {
            const bf16x8 a = XM == 0 ? row_frag(X, 72, ti * 16, ks * 32, lane) : tr_frag(X, 72, ks * 32, ti * 16, lane);
            const bf16x8 bq = YM == 0 ? row_frag(Y, 72, tj * 16, ks * 32, lane) : tr_frag(Y, 72, ks * 32, tj * 16, lane);
            acc = __builtin_amdgcn_mfma_f32_16x16x32_bf16(a, bq, acc, 0, 0, 0);
        }
        f(ti * 16 + (lane >> 4) * 4, tj * 16 + (lane & 15), acc);
    }
}
template <int XM, int YM, class F>
DEV void mm64x2(const bf16_t* X1, const bf16_t* Y1, const bf16_t* X2, const bf16_t* Y2, F f, int lane, int wave) {
#pragma unroll
    for (int q = 0; q < 2; ++q) {
        const int idx = wave * 2 + q, ti = idx >> 2, tj = idx & 3;
        f32x4 acc = (f32x4){0.f, 0.f, 0.f, 0.f};
#pragma unroll
        for (int ks = 0; ks < 2; ++ks) {
            const bf16x8 a = XM == 0 ? row_frag(X1, 72, ti * 16, ks * 32, lane) : tr_frag(X1, 72, ks * 32, ti * 16, lane);
            const bf16x8 bq = YM == 0 ? row_frag(Y1, 72, tj * 16, ks * 32, lane) : tr_frag(Y1, 72, ks * 32, tj * 16, lane);
            acc = __builtin_amdgcn_mfma_f32_16x16x32_bf16(a, bq, acc, 0, 0, 0);
            const bf16x8 a2 = XM == 0 ? row_frag(X2, 72, ti * 16, ks * 32, lane) : tr_frag(X2, 72, ks * 32, ti * 16, lane);
            const bf16x8 b2 = YM == 0 ? row_frag(Y2, 72, tj * 16, ks * 32, lane) : tr_frag(Y2, 72, ks * 32, tj * 16, lane);
            acc = __builtin_amdgcn_mfma_f32_16x16x32_bf16(a2, b2, acc, 0, 0, 0);
        }
        f(ti * 16 + (lane >> 4) * 4, tj * 16 + (lane & 15), acc);
    }
}
DEV void st_img(bf16_t* P, int i0, int j, float a0, float a1, float a2, float a3) {
    P[(i0 + 0) * 72 + j] = __builtin_bit_cast(unsigned short, (__bf16)a0); P[(i0 + 1) * 72 + j] = __builtin_bit_cast(unsigned short, (__bf16)a1);
    P[(i0 + 2) * 72 + j] = __builtin_bit_cast(unsigned short, (__bf16)a2); P[(i0 + 3) * 72 + j] = __builtin_bit_cast(unsigned short, (__bf16)a3);
}

DEV void rwkv1_unit(const Params& p, int h, int dir, int c, float* sm) {
    const int tid = opaque_tid(), lane = tid & 63, wave = tid >> 6;
    const bf16_t* P0 = (const bf16_t*)(p.ws + OFF_P0);
    bf16_t* RU = (bf16_t*)(p.ws + OFF_RU) + (size_t)((h * 2 + dir) * NCH + c) * 16384;
    float* BONS = (float*)(p.ws + OFF_BONS);
    const float* mu = p.in[15];
    const float* w0 = p.in[dir ? 18 : 16]; const float* ww2 = p.in[dir ? 19 : 17];
    const float* a0 = p.in[dir ? 22 : 20]; const float* wa2 = p.in[dir ? 23 : 21];
    bf16_t* img = (bf16_t*)sm;
#define SLOT(i_) (img + (i_) * 4608)
    float* fLW = (float*)SLOT(10);
    float* fAS = (float*)SLOT(12);
    float* sv = (float*)SLOT(14);
    const int t = tid >> 3, j0 = (tid & 7) * 8, s = c * 64 + t;
    __syncthreads();
    if (tid < 64) { const int hc = h * 64 + tid; sv[64 + tid] = w0[hc]; sv[128 + tid] = a0[hc]; sv[192 + tid] = p.in[24][hc]; sv[256 + tid] = p.in[25][hc]; sv[320 + tid] = p.in[26][hc]; }
    float r8[8], k8[8], v8[8];
    {
        float x8[8];
        const RwNb nbq = rw_nb(s);
        const RwRaw wr_ = rw_load(P0, s, nbq, h * 64 + j0), wk_ = rw_load(P0, s, nbq, 512 + h * 64 + j0), wv_ = rw_load(P0, s, nbq, 1024 + h * 64 + j0),
                    ww_ = rw_load(P0, s, nbq, 2048 + dir * 64 + j0), wa_ = rw_load(P0, s, nbq, 2176 + dir * 64 + j0);
        const float4 qw0 = ld4(ww2 + (size_t)t * 512 + h * 64 + j0), qw1 = ld4(ww2 + (size_t)t * 512 + h * 64 + j0 + 4);
        const float4 qa0 = ld4(wa2 + (size_t)t * 512 + h * 64 + j0), qa1 = ld4(wa2 + (size_t)t * 512 + h * 64 + j0 + 4);
        __builtin_amdgcn_sched_barrier(0);
        rw_comb(wr_, nbq, mu, h * 64 + j0, r8);
        rw_comb(wk_, nbq, mu, 512 + h * 64 + j0, k8);
        rw_comb(wv_, nbq, mu, 1024 + h * 64 + j0, v8);
        rw_comb(ww_, nbq, mu, 2048 + dir * 64 + j0, x8);
#pragma unroll
        for (int i = 0; i < 8; ++i) x8[i] = tanh_f(x8[i]);
        *(uint4*)(SLOT(6) + t * 72 + j0) = pack8(x8);
        rw_comb(wa_, nbq, mu, 2176 + dir * 64 + j0, x8);
        *(uint4*)(SLOT(7) + t * 72 + j0) = pack8(x8);
        { const float wq[8] = {qw0.x, qw0.y, qw0.z, qw0.w, qw1.x, qw1.y, qw1.z, qw1.w}; *(uint4*)(SLOT(8) + t * 72 + j0) = pack8(wq); }
        { const float wq[8] = {qa0.x, qa0.y, qa0.z, qa0.w, qa1.x, qa1.y, qa1.z, qa1.w}; *(uint4*)(SLOT(9) + t * 72 + j0) = pack8(wq); }
    }
    __syncthreads();
    mm64<0, 1>(SLOT(6), SLOT(8), [=](int i0, int j, f32x4 a) {
#pragma unroll
        for (int r = 0; r < 4; ++r) fLW[(i0 + r) * 65 + j] = -0.6065306597f * sigmoid_f(sv[64 + j] + a[r]); }, lane, wave);
    mm64<0, 1>(SLOT(7), SLOT(9), [=](int i0, int j, f32x4 a) {
#pragma unroll
        for (int r = 0; r < 4; ++r) fAS[(i0 + r) * 65 + j] = sigmoid_f(sv[128 + j] + a[r]); }, lane, wave);
    __syncthreads();
#pragma unroll
    for (int j = 0; j < 8; ++j) {
        const int k = wave * 8 + j;
        const float v = wave_scan_add(fLW[lane * 65 + k], lane, dir);
        fLW[lane * 65 + k] = v;
        if (lane == (dir ? 0 : 63)) sv[k] = v;
    }
    __syncthreads();
    {
        float kkv[8], ss = 0.f;
#pragma unroll
        for (int i = 0; i < 8; ++i) { kkv[i] = k8[i] * sv[192 + j0 + i]; ss += kkv[i] * kkv[i]; }
        ss += __shfl_xor(ss, 1, 64); ss += __shfl_xor(ss, 2, 64); ss += __shfl_xor(ss, 4, 64);
        const float rn = rsqrtf(fmaxf(ss, 1e-24f));
        float fa[8], fb[8], fk[8], fr[8], fbp[8], fkp[8], bon = 0.f;
        const int tp = dir ? t + 1 : t - 1;
        const bool hasp = dir ? (t < 63) : (t > 0);
#pragma unroll
        for (int i = 0; i < 8; ++i) {
            const int k = j0 + i;
            const float Bt = fLW[t * 65 + k], Bx = hasp ? fLW[tp * 65 + k] : 0.f, asg = fAS[t * 65 + k];
            const float kk = kkv[i] * rn, kh = k8[i] * (1.f + (asg - 1.f) * sv[256 + k]);
            bon += r8[i] * kh * sv[320 + k];
            const float enB = fexp(-Bt), eLB = fexp(sv[k] - Bt), bv = kk * asg;
            fa[i] = -kk * fexp(Bx); fb[i] = bv * enB; fk[i] = kh * enB; fr[i] = r8[i] * fexp(Bt); fbp[i] = bv * eLB; fkp[i] = kh * eLB;
        }
        bon += __shfl_xor(bon, 1, 64); bon += __shfl_xor(bon, 2, 64); bon += __shfl_xor(bon, 4, 64);
        if ((tid & 7) == 0) BONS[((size_t)dir * TB + s) * 8 + h] = bon;
        *(uint4*)(SLOT(0) + t * 72 + j0) = pack8(fa); *(uint4*)(SLOT(1) + t * 72 + j0) = pack8(fb); *(uint4*)(SLOT(2) + t * 72 + j0) = pack8(fk);
        *(uint4*)(SLOT(3) + t * 72 + j0) = pack8(fr); *(uint4*)(SLOT(4) + t * 72 + j0) = pack8(fbp); *(uint4*)(SLOT(5) + t * 72 + j0) = pack8(fkp);
    }
    __syncthreads();
    *(uint4*)(SLOT(6) + t * 72 + j0) = pack8(v8);
    __syncthreads();
    mm64<0, 0>(SLOT(0), SLOT(1), [=](int i0, int j, f32x4 a) {
        float m[4];
#pragma unroll
        for (int r = 0; r < 4; ++r) { const bool keep = dir ? (j > i0 + r) : (j < i0 + r); m[r] = keep ? a[r] : 0.f; }
        const bool dg = (i0 >> 4) == (j >> 4);
        st_img(SLOT(7), i0, j, dg ? m[0] : 0.f, dg ? m[1] : 0.f, dg ? m[2] : 0.f, dg ? m[3] : 0.f);
        st_img(SLOT(8), i0, j, (dg ? m[0] : 0.f) + (j == i0 ? 1.f : 0.f), (dg ? m[1] : 0.f) + (j == i0 + 1 ? 1.f : 0.f), (dg ? m[2] : 0.f) + (j == i0 + 2 ? 1.f : 0.f), (dg ? m[3] : 0.f) + (j == i0 + 3 ? 1.f : 0.f));
        st_img(SLOT(12), i0, j, dg ? 0.f : m[0], dg ? 0.f : m[1], dg ? 0.f : m[2], dg ? 0.f : m[3]); }, lane, wave);
    mm64<0, 0>(SLOT(0), SLOT(2), [=](int i0, int j, f32x4 a) {
        float m[4];
#pragma unroll
        for (int r = 0; r < 4; ++r) { const bool keep = dir ? (j > i0 + r) : (j < i0 + r); m[r] = keep ? a[r] : 0.f; }
        st_img(SLOT(9), i0, j, m[0], m[1], m[2], m[3]); }, lane, wave);
    mm64<0, 0>(SLOT(3), SLOT(1), [=](int i0, int j, f32x4 a) {
        float m[4];
#pragma unroll
        for (int r = 0; r < 4; ++r) { const bool keep = dir ? (j >= i0 + r) : (j <= i0 + r); m[r] = keep ? a[r] : 0.f; }
        st_img(SLOT(10), i0, j, m[0], m[1], m[2], m[3]); }, lane, wave);
    mm64<0, 0>(SLOT(3), SLOT(2), [=](int i0, int j, f32x4 a) {
        float m[4];
#pragma unroll
        for (int r = 0; r < 4; ++r) { const bool keep = dir ? (j >= i0 + r) : (j <= i0 + r); m[r] = keep ? a[r] : 0.f; }
        st_img(SLOT(11), i0, j, m[0], m[1], m[2], m[3]); }, lane, wave);
    __syncthreads();
    {
        bf16_t* Pc = SLOT(7); bf16_t* Pn = SLOT(1); bf16_t* Tc = SLOT(8); bf16_t* Tn = SLOT(2);
#pragma unroll 1
        for (int it = 0; it < 3; ++it) {
            mm64<0, 1>(Pc, Pc, [=](int i0, int j, f32x4 a) { st_img(Pn, i0, j, a[0], a[1], a[2], a[3]); }, lane, wave);
            __syncthreads();
            mm64<0, 1>(Tc, Pn, [=](int i0, int j, f32x4 a) {
                st_img(Tn, i0, j, a[0] + bf2f(Tc[(i0 + 0) * 72 + j]), a[1] + bf2f(Tc[(i0 + 1) * 72 + j]), a[2] + bf2f(Tc[(i0 + 2) * 72 + j]), a[3] + bf2f(Tc[(i0 + 3) * 72 + j])); }, lane, wave);
            __syncthreads();
            bf16_t* tmp = Pc; Pc = Pn; Pn = tmp; tmp = Tc; Tc = Tn; Tn = tmp;
        }
    }
    mm64<0, 1>(SLOT(2), SLOT(12), [=](int i0, int j, f32x4 a) { st_img(SLOT(7), i0, j, a[0], a[1], a[2], a[3]); }, lane, wave);
    mm64<0, 1>(SLOT(2), SLOT(0), [=](int i0, int j, f32x4 a) { st_img(SLOT(1), i0, j, a[0], a[1], a[2], a[3]); }, lane, wave);
    mm64<0, 1>(SLOT(9), SLOT(6), [=](int i0, int j, f32x4 a) { st_img(SLOT(13), i0, j, a[0], a[1], a[2], a[3]); }, lane, wave);
    __syncthreads();
    mm64<0, 1>(SLOT(2), SLOT(13), [=](int i0, int j, f32x4 a) { st_img(SLOT(8), i0, j, a[0], a[1], a[2], a[3]); }, lane, wave);
    __syncthreads();
    {
        const bf16_t* Zp = (wave < 4) ? SLOT(1) : SLOT(8);
        bf16_t* Xi = (wave < 4) ? SLOT(12) : SLOT(9);
        const int ct = (wave & 3) * 16, g4 = (lane >> 4) * 4, l15 = lane & 15;
#pragma unroll
        for (int bs = 0; bs < 4; ++bs) {
            const int bi = dir ? 3 - bs : bs;
            f32x4 acc;
#pragma unroll
            for (int r = 0; r < 4; ++r) acc[r] = bf2f(Zp[(bi * 16 + g4 + r) * 72 + ct + l15]);
            const bool k0 = dir ? (bi == 0) : (bi >= 1), k1 = dir ? (bi <= 2) : (bi == 3);
            if (k0) acc = __builtin_amdgcn_mfma_f32_16x16x32_bf16(row_frag(SLOT(7), 72, bi * 16, 0, lane), tr_frag(Xi, 72, 0, ct, lane), acc, 0, 0, 0);
            if (k1) acc = __builtin_amdgcn_mfma_f32_16x16x32_bf16(row_frag(SLOT(7), 72, bi * 16, 32, lane), tr_frag(Xi, 72, 32, ct, lane), acc, 0, 0, 0);
            st_img(Xi, bi * 16 + g4, ct + l15, acc[0], acc[1], acc[2], acc[3]);
            __syncthreads();
        }
    }
    mm64<1, 1>(SLOT(12), SLOT(4), [=](int i0, int j, f32x4 a) {
        float m[4];
#pragma unroll
        for (int r = 0; r < 4; ++r) m[r] = a[r] + ((i0 + r) == j ? fexp(sv[j]) : 0.f);
        *(uint2*)(RU + j * 64 + i0) = make_uint2(pack2bf(m[0], m[1]), pack2bf(m[2], m[3])); }, lane, wave);
    mm64x2<1, 1>(SLOT(4), SLOT(9), SLOT(5), SLOT(6), [=](int i0, int j, f32x4 a) {
        *(uint2*)(RU + 4096 + j * 64 + i0) = make_uint2(pack2bf(a[0], a[1]), pack2bf(a[2], a[3])); }, lane, wave);
    mm64<1, 0>(SLOT(12), SLOT(10), [=](int i0, int j, f32x4 a) {
        const uint2 rr = *(const uint2*)(SLOT(3) + j * 72 + i0);
        *(uint2*)(RU + 8192 + j * 64 + i0) = make_uint2(pack2bf(a[0] + bflo(rr.x), a[1] + bfhi(rr.x)), pack2bf(a[2] + bflo(rr.y), a[3] + bfhi(rr.y))); }, lane, wave);
    mm64x2<0, 1>(SLOT(10), SLOT(9), SLOT(11), SLOT(6), [=](int i0, int j, f32x4 a) {
        *(uint2*)(RU + 12288 + j * 64 + i0) = make_uint2(pack2bf(a[0], a[1]), pack2bf(a[2], a[3])); }, lane, wave);
#undef SLOT
}

#define R2_LOAD(M_, C_, rnd_) do { const int r0_ = ((rnd_) < R2_NR ? (rnd_) : R2_NR - 1) * R2_RS; \
    _Pragma("unroll") for (int s_ = 0; s_ < R2_RS; ++s_) M_[s_] = *(const uint4*)(RU + (size_t)(chain * NCH + chunk_at(dir, r0_ + s_)) * 16384 + tid * 8); \
    _Pragma("unroll") for (int j_ = 0; j_ < 3; ++j_) { const int cq_ = tid + 512 * j_; \
        C_[j_] = *(const uint4*)(RU + (size_t)(chain * NCH + chunk_at(dir, r0_ + (cq_ >> 7))) * 16384 + 4096 + (vblk * 16 + ((cq_ >> 3) & 15)) * 64 + (cq_ & 7) * 8); } } while (0)
#define R2_ROUND(M_, C_, rnd_) do { \
    { const int row_ = tid >> 3, c8_ = tid & 7, sw_ = (row_ >> 1) & 7, u0_ = (c8_ >> 2) * 4 + (c8_ & 1) * 2, eh_ = ((c8_ >> 1) & 1) * 8; \
      _Pragma("unroll") for (int s_ = 0; s_ < R2_RS; ++s_) { char* sl_ = ring + s_ * 10240 + row_ * 128 + eh_; \
          *(uint2*)(sl_ + ((u0_ ^ sw_) * 16)) = make_uint2(M_[s_].x, M_[s_].y); *(uint2*)(sl_ + (((u0_ + 1) ^ sw_) * 16)) = make_uint2(M_[s_].z, M_[s_].w); } \
      _Pragma("unroll") for (int j_ = 0; j_ < 3; ++j_) { const int cq_ = tid + 512 * j_, rw_ = (cq_ >> 3) & 15, q8_ = cq_ & 7, i_ = q8_ >> 1, g0_ = (q8_ & 1) * 2, sc_ = (rw_ >> 1) & 7; \
          char* sl_ = ring + (cq_ >> 7) * 10240 + 8192 + rw_ * 128 + (i_ & 1) * 8; \
          *(uint2*)(sl_ + (((g0_ * 2 + (i_ >> 1)) ^ sc_) * 16)) = make_uint2(C_[j_].x, C_[j_].y); *(uint2*)(sl_ + ((((g0_ + 1) * 2 + (i_ >> 1)) ^ sc_) * 16)) = make_uint2(C_[j_].z, C_[j_].w); } } \
    R2_LOAD(M_, C_, (rnd_) + 2); \
    __syncthreads(); \
    if (wave == 0) { \
        _Pragma("unroll 4") for (int s_ = 0; s_ < R2_RS; ++s_) { \
            const int c_ = chunk_at(dir, (rnd_) * R2_RS + s_); const char* sl_ = ring + s_ * 10240; \
            unsigned pk_[4][2]; \
            _Pragma("unroll") for (int i_ = 0; i_ < 4; ++i_) { pk_[i_][0] = pack2bf(st[i_][0], st[i_][1]); pk_[i_][1] = pack2bf(st[i_][2], st[i_][3]); } \
            bf16_t* sp_ = S0G + ((size_t)(chain * NCH + c_) * 64 + vblk * 16 + l15) * 64 + g * 4; \
            _Pragma("unroll") for (int i_ = 0; i_ < 4; ++i_) *(uint2*)(sp_ + i_ * 16) = make_uint2(pk_[i_][0], pk_[i_][1]); \
            bf16x8 bfr_[2]; \
            _Pragma("unroll") for (int ks_ = 0; ks_ < 2; ++ks_) { const uint4 u_ = make_uint4(pk_[2 * ks_][0], pk_[2 * ks_][1], pk_[2 * ks_ + 1][0], pk_[2 * ks_ + 1][1]); bfr_[ks_] = __builtin_bit_cast(bf16x8, u_); } \
            const uint4 c01_ = *(const uint4*)(sl_ + 8192 + l15 * 128 + (((g * 2) ^ ((l15 >> 1) & 7)) * 16)), c23_ = *(const uint4*)(sl_ + 8192 + l15 * 128 + (((g * 2 + 1) ^ ((l15 >> 1) & 7)) * 16)); \
            const unsigned cw_[8] = {c01_.x, c01_.y, c01_.z, c01_.w, c23_.x, c23_.y, c23_.z, c23_.w}; \
            _Pragma("unroll") for (int i_ = 0; i_ < 4; ++i_) { \
                f32x4 acc_ = (f32x4){bflo(cw_[2 * i_]), bfhi(cw_[2 * i_]), bflo(cw_[2 * i_ + 1]), bfhi(cw_[2 * i_ + 1])}; \
                _Pragma("unroll") for (int ks_ = 0; ks_ < 2; ++ks_) { \
                    const int row_ = i_ * 16 + l15; \
                    const bf16x8 af_ = *(const bf16x8*)(sl_ + row_ * 128 + (((ks_ * 4 + g) ^ ((row_ >> 1) & 7)) * 16)); \
                    acc_ = __builtin_amdgcn_mfma_f32_16x16x32_bf16(af_, bfr_[ks_], acc_, 0, 0, 0); } \
                st[i_] = acc_; } } } \
    __syncthreads(); } while (0)
DEV void rwkv2_unit(const Params& p, int chain, int vblk, float* sm) {
    constexpr int R2_RS = 12, R2_NR = NCH / R2_RS;
    static_assert(R2_NR * R2_RS == NCH && R2_RS * 10240 <= LDS_BYTES, "R2 ring");
    const int tid = opaque_tid(), lane = tid & 63, wave = tid >> 6;
    const bf16_t* RU = (const bf16_t*)(p.ws + OFF_RU);
    bf16_t* S0G = (bf16_t*)(p.ws + OFF_RS0);
    char* ring = (char*)sm;
    const int dir = chain & 1, g = lane >> 4, l15 = lane & 15;
    f32x4 st[4];
#pragma unroll
    for (int i = 0; i < 4; ++i) st[i] = (f32x4){0.f, 0.f, 0.f, 0.f};
    uint4 ma[R2_RS], ca[3], mb[R2_RS], cb[3];
    __syncthreads();
    R2_LOAD(ma, ca, 0); R2_LOAD(mb, cb, 1);
#pragma unroll 1
    for (int rnd = 0; rnd < R2_NR; rnd += 2) {
        R2_ROUND(ma, ca, rnd);
        if (rnd + 1 < R2_NR) R2_ROUND(mb, cb, rnd + 1);
    }
}
#undef R2_LOAD
#undef R2_ROUND

DEV void rwkv3_unit(const Params& p, int h, int c, float* sm) {
    const int tid = opaque_tid(), lane = tid & 63, wave = tid >> 6;
    const bf16_t* P0 = (const bf16_t*)(p.ws + OFF_P0);
    const bf16_t* RUb = (const bf16_t*)(p.ws + OFF_RU);
    const bf16_t* S0G = (const bf16_t*)(p.ws + OFF_RS0);
    const float* BONS = (const float*)(p.ws + OFF_BONS);
    bf16_t* YC = (bf16_t*)(p.ws + OFF_YC);
    const float* mu = p.in[15]; const float* gn_g = p.in[27]; const float* gn_b = p.in[28];
    bf16_t* img = (bf16_t*)sm;
    float* O = sm + 4 * 2304;
    const int t = tid >> 3, v0 = (tid & 7) * 8, s = c * 64 + t;
    const size_t u0 = (size_t)((h * 2 + 0) * NCH + c), u1 = (size_t)((h * 2 + 1) * NCH + c);
    const uint4 gr0 = *(const uint4*)(RUb + u0 * 16384 + 8192 + t * 64 + v0), gs0 = *(const uint4*)(S0G + u0 * 4096 + t * 64 + v0);
    const uint4 gr1 = *(const uint4*)(RUb + u1 * 16384 + 8192 + t * 64 + v0), gs1 = *(const uint4*)(S0G + u1 * 4096 + t * 64 + v0);
    uint2 yl[2][2];
#pragma unroll
    for (int q = 0; q < 2; ++q) { const int idx = wave * 2 + q, ti = idx >> 2, tj = idx & 3;
        yl[q][0] = *(const uint2*)(RUb + u0 * 16384 + 12288 + (tj * 16 + (lane & 15)) * 64 + ti * 16 + (lane >> 4) * 4);
        yl[q][1] = *(const uint2*)(RUb + u1 * 16384 + 12288 + (tj * 16 + (lane & 15)) * 64 + ti * 16 + (lane >> 4) * 4); }
    const RwNb nbq = rw_nb(s);
    const RwRaw wv_ = rw_load(P0, s, nbq, 1024 + h * 64 + v0), wg_ = rw_load(P0, s, nbq, 1536 + h * 64 + v0);
    const float bon = BONS[(size_t)s * 8 + h] + BONS[((size_t)TB + s) * 8 + h];
    __syncthreads();
    *(uint4*)(img + 0 * 4608 + t * 72 + v0) = gr0; *(uint4*)(img + 2 * 4608 + t * 72 + v0) = gs0;
    *(uint4*)(img + 1 * 4608 + t * 72 + v0) = gr1; *(uint4*)(img + 3 * 4608 + t * 72 + v0) = gs1;
    __syncthreads();
#pragma unroll
    for (int q = 0; q < 2; ++q) {
        const int idx = wave * 2 + q, ti = idx >> 2, tj = idx & 3;
        f32x4 accd[2];
#pragma unroll
        for (int dir = 0; dir < 2; ++dir) {
            f32x4 acc = (f32x4){bflo(yl[q][dir].x), bfhi(yl[q][dir].x), bflo(yl[q][dir].y), bfhi(yl[q][dir].y)};
#pragma unroll
            for (int ks = 0; ks < 2; ++ks) acc = __builtin_amdgcn_mfma_f32_16x16x32_bf16(row_frag(img + dir * 4608, 72, ti * 16, ks * 32, lane), row_frag(img + (2 + dir) * 4608, 72, tj * 16, ks * 32, lane), acc, 0, 0, 0);
            accd[dir] = acc;
        }
#pragma unroll
        for (int r = 0; r < 4; ++r) {
            const int oi = (ti * 16 + (lane >> 4) * 4 + r) * 68 + tj * 16 + (lane & 15);
            O[oi] = accd[0][r] + accd[1][r];
        }
    }
    __syncthreads();
    {
        float y[8], sum = 0.f;
#pragma unroll
        for (int i = 0; i < 8; ++i) { y[i] = O[t * 68 + v0 + i]; sum += y[i]; }
        sum += __shfl_xor(sum, 1, 64); sum += __shfl_xor(sum, 2, 64); sum += __shfl_xor(sum, 4, 64);
        const float mean = sum * (1.f / 64.f);
        float sq = 0.f;
#pragma unroll
        for (int i = 0; i < 8; ++i) { y[i] -= mean; sq += y[i] * y[i]; }
        sq += __shfl_xor(sq, 1, 64); sq += __shfl_xor(sq, 2, 64); sq += __shfl_xor(sq, 4, 64);
        const float rstd = rsqrtf(sq * (1.f / 64.f) + 64e-5f);
        float vm[8], gm[8];
        rw_comb(wv_, nbq, mu, 1024 + h * 64 + v0, vm);
        rw_comb(wg_, nbq, mu, 1536 + h * 64 + v0, gm);
        float o[8];
#pragma unroll
        for (int i = 0; i < 8; ++i) o[i] = (y[i] * rstd * gn_g[h * 64 + v0 + i] + gn_b[h * 64 + v0 + i] + bon * vm[i]) * silu_f(gm[i]);
        *(uint4*)(YC + (size_t)s * 1024 + 512 + h * 64 + v0) = pack8(o);
    }
}

DEV void ln_rows(const float* src, const float* res_lat, const float* res_cx, int nrows, const float* __restrict__ g, const float* __restrict__ bt, float* dst_lat, float* dst_cx, int ncx,
                 bf16_t* hb = nullptr, const float* mvc = nullptr, const float* mvl = nullptr) {
    const int tid_ = opaque_tid(); const int lane = tid_ & 63, gw = blockIdx.x * NWV + (tid_ >> 6), ngw = gridDim.x * NWV;
    for (int r = gw; r < nrows; r += ngw) {
        const float* x = src + (size_t)r * 1024;
        float4 v[4];
        float sum = 0.f;
        const float* xr = (r < ncx) ? (res_cx + (size_t)r * 1024) : (res_lat + (size_t)(r - ncx) * 1024);
#pragma unroll
        for (int i = 0; i < 4; ++i) { const float4 a = ld4(x + i * 256 + lane * 4), rr = ld4(xr + i * 256 + lane * 4);
            v[i] = make_float4(ALPHA * rr.x + a.x, ALPHA * rr.y + a.y, ALPHA * rr.z + a.z, ALPHA * rr.w + a.w); sum += v[i].x + v[i].y + v[i].z + v[i].w; }
        const float mean = wave_sum(sum) * (1.f / 1024.f);
        float sq = 0.f;
#pragma unroll
        for (int i = 0; i < 4; ++i) {
            v[i].x -= mean; v[i].y -= mean; v[i].z -= mean; v[i].w -= mean;
            sq += v[i].x * v[i].x + v[i].y * v[i].y + v[i].z * v[i].z + v[i].w * v[i].w;
        }
        const float rstd = rsqrtf(wave_sum(sq) * (1.f / 1024.f) + 1e-5f);
        float* d = (r < ncx) ? (dst_cx + (size_t)r * 1024) : (dst_lat + (size_t)(r - ncx) * 1024);
#pragma unroll
        for (int i = 0; i < 4; ++i) {
            const int c = i * 256 + lane * 4;
            const float4 gg = ld4(g + c), bb = ld4(bt + c);
            const float4 y = make_float4(v[i].x * rstd * gg.x + bb.x, v[i].y * rstd * gg.y + bb.y, v[i].z * rstd * gg.z + bb.z, v[i].w * rstd * gg.w + bb.w);
            st4(d + c, y);
            if (hb != nullptr) {
                const float* m = (r < ncx) ? mvc : mvl;
                const float4 sh = ld4(m + c), sc = ld4(m + 1024 + c);
                *(uint2*)(hb + (size_t)r * 1024 + c) = make_uint2(pack2bf(y.x * (1.f + sc.x) + sh.x, y.y * (1.f + sc.y) + sh.y), pack2bf(y.z * (1.f + sc.z) + sh.z, y.w * (1.f + sc.w) + sh.w));
            }
        }
    }
}
DEV void phase_h1l(const Params& p) {
    const float* modv1 = (const float*)(p.ws + OFF_MODV) + 3 * 3072;
    bf16_t* H1 = (bf16_t*)(p.ws + OFF_H1B);
    const size_t gt = (size_t)blockIdx.x * NTHR + opaque_tid(), gn = (size_t)gridDim.x * NTHR;
    for (size_t i = gt; i < (size_t)NB * NL * 128; i += gn) {
        const size_t r = i >> 7; const int k = (int)(i & 127) * 8;
        const float* m = modv1 + (r >= (size_t)NL ? 1 : 0) * 3072;
        const float4 x0 = ld4(p.out + r * DM + k), x1 = ld4(p.out + r * DM + k + 4);
        const float4 s0 = ld4(m + k), s1 = ld4(m + k + 4), c0 = ld4(m + 1024 + k), c1 = ld4(m + 1024 + k + 4);
        *(uint4*)(H1 + r * DM + k) = make_uint4(pack2bf(x0.x * (1.f + c0.x) + s0.x, x0.y * (1.f + c0.y) + s0.y), pack2bf(x0.z * (1.f + c0.z) + s0.z, x0.w * (1.f + c0.w) + s0.w),
                                                pack2bf(x1.x * (1.f + c1.x) + s1.x, x1.y * (1.f + c1.y) + s1.y), pack2bf(x1.z * (1.f + c1.z) + s1.z, x1.w * (1.f + c1.w) + s1.w));
    }
}

DEV void zero_f4(float* ptr, size_t nfloat) {
    const size_t n4 = nfloat / 4;
    for (size_t i = (size_t)blockIdx.x * NTHR + opaque_tid(); i < n4; i += (size_t)gridDim.x * NTHR) ((float4*)ptr)[i] = make_float4(0.f, 0.f, 0.f, 0.f);
}

DEV void chain_ids(int& chain, int& sub) {
    const int bid = blockIdx.x, xcd = bid & 7, idx = bid >> 3;
    chain = xcd * 2 + (idx >> 4); sub = idx & 15;
}

DEV void phase_conv1(const Params& p, float* sm) {
    const bf16_t* XM = (const bf16_t*)(p.ws + OFF_XM);
    bf16_t* XC = (bf16_t*)(p.ws + OFF_XC);
    float* G16P = (float*)(p.ws + OFF_G16P);
    const bf16_t* WFT = (const bf16_t*)(p.ws + OFF_WFT);
    const float* cw = p.in[31]; const float* cbias = p.in[32];
    bf16_t* imgC = (bf16_t*)sm;
    bf16_t* imgM = imgC + 64 * 264;
    float* red = (float*)(imgM + 64 * 264);
    float* cwl = red + 1024;
    const int tid = opaque_tid(), lane = tid & 63, wave = tid >> 6, t = tid >> 3, cg = tid & 7;
    for (int u = blockIdx.x; u < NB * NCH * 4; u += gridDim.x) {
        const int ci = u >> 2, q = u & 3, b = ci / NCH, c = ci % NCH, s = c * 64 + t;
        const size_t rowbase = (size_t)b * TB;
        int nrow[9];
#pragma unroll
        for (int i = 0; i < 3; ++i)
#pragma unroll
            for (int j = 0; j < 3; ++j) {
                int ns = -1;
                if (s < NCX) { const int w2 = s + j - 1; if (i == 1 && w2 >= 0 && w2 < NCX) ns = w2; }
                else { const int n = s - NCX, rr = (n >> 6) + i - 1, w2 = (n & 63) + j - 1; if (rr >= 0 && rr < 128 && w2 >= 0 && w2 < 64) ns = NCX + rr * 64 + w2; }
                nrow[i * 3 + j] = ns;
            }
        const int tt = wave & 3, part = wave >> 2;
        f32x4 acc = (f32x4){0.f, 0.f, 0.f, 0.f};
#pragma unroll 1
        for (int half = 0; half < 2; ++half) {
            __syncthreads();
            for (int i = tid; i < 640; i += NTHR) { const int tp = i >> 6, c4 = (i & 63) * 4; st4(cwl + tp * 256 + c4, ld4((tp < 9 ? cw + tp * 2048 : cbias) + q * 512 + half * 256 + c4)); }
            __syncthreads();
#pragma unroll 2
            for (int it = 0; it < 4; ++it) {
                const int cl = it * 64 + cg * 8, c0 = q * 512 + half * 256 + cl;
                float a8[8];
                { const float4 b0 = ld4(cwl + 9 * 256 + cl), b1 = ld4(cwl + 9 * 256 + cl + 4); a8[0] = b0.x; a8[1] = b0.y; a8[2] = b0.z; a8[3] = b0.w; a8[4] = b1.x; a8[5] = b1.y; a8[6] = b1.z; a8[7] = b1.w; }
                uint4 xmc = make_uint4(0u, 0u, 0u, 0u);
#pragma unroll
                for (int tap = 0; tap < 9; ++tap) {
                    if (nrow[tap] >= 0) {
                        const uint4 xv = *(const uint4*)(XM + (rowbase + nrow[tap]) * 2048 + c0);
                        float x8[8]; unpack8(xv, x8);
                        const float4 w0 = ld4(cwl + tap * 256 + cl), w1 = ld4(cwl + tap * 256 + cl + 4);
                        a8[0] += x8[0] * w0.x; a8[1] += x8[1] * w0.y; a8[2] += x8[2] * w0.z; a8[3] += x8[3] * w0.w;
                        a8[4] += x8[4] * w1.x; a8[5] += x8[5] * w1.y; a8[6] += x8[6] * w1.z; a8[7] += x8[7] * w1.w;
                        if (tap == 4) xmc = xv;
                    }
                }
#pragma unroll
                for (int i = 0; i < 8; ++i) a8[i] = silu_f(a8[i]);
                const uint4 xcv = pack8(a8);
                *(uint4*)(XC + (rowbase + s) * 2048 + c0) = xcv;
                *(uint4*)(imgC + t * 264 + cl) = xcv;
                *(uint4*)(imgM + t * 264 + cl) = xmc;
            }
            __syncthreads();
            {
                const bf16_t* img = part ? imgM : imgC;
                const bf16_t* wrow = WFT + (size_t)(lane & 15) * 4096 + part * 2048 + q * 512 + half * 256 + (lane >> 4) * 8;
#pragma unroll
                for (int ks = 0; ks < 8; ++ks) acc = __builtin_amdgcn_mfma_f32_16x16x32_bf16(row_frag(img, 264, tt * 16, ks * 32, lane), *(const bf16x8*)(wrow + ks * 32), acc, 0, 0, 0);
            }
        }
        if (part == 1) {
#pragma unroll
            for (int r = 0; r < 4; ++r) red[(tt * 16 + (lane >> 4) * 4 + r) * 16 + (lane & 15)] = acc[r];
        }
        __syncthreads();
        if (part == 0) {
#pragma unroll
            for (int r = 0; r < 4; ++r) {
                const int tk = tt * 16 + (lane >> 4) * 4 + r;
                G16P[((size_t)q * RT + rowbase + c * 64 + tk) * 16 + (lane & 15)] = acc[r] + red[tk * 16 + (lane & 15)];
            }
        }
    }
}

DEV void gate_pair(const Params& p, size_t row, int dir, int h, float& gi, float& lf) {
    const float* G16P = (const float*)(p.ws + OFF_G16P);
    float a = 0.f, f = 0.f;
#pragma unroll
    for (int q = 0; q < 4; ++q) { a += G16P[((size_t)q * RT + row) * 16 + dir * 8 + h]; f += G16P[((size_t)q * RT + row) * 16 + dir * 8 + 4 + h]; }
    gi = a + p.in[dir ? 41 : 37][h];
    lf = logsig_f(f + p.in[dir ? 43 : 39][h]);
}

DEV void phase_x1(const Params& p, float* sm) {
    int chain, sub; chain_ids(chain, sub);
    const int b = chain >> 3, h = (chain >> 1) & 3, dir = chain & 1;
    const bf16_t* XC = (const bf16_t*)(p.ws + OFF_XC);
    float* GSC = (float*)(p.ws + OFF_GSC); float* CSC = (float*)(p.ws + OFF_CSC); float* NBUF = (float*)(p.ws + OFF_NBUF);
    const float* gtab = (const float*)(p.ws + OFF_GTAB);
    bf16_t* SMAT = (bf16_t*)(p.ws + OFF_SMAT);
    const int tid = opaque_tid(), lane = tid & 63, wave = tid >> 6;
    float* sTot = sm; float* sRef = sm + 132; float* sM0 = sm + 264; float* sBeta = sm + 400;
    for (int c = wave; c < NCH; c += NWV) {
        const size_t row = (size_t)b * TB + c * 64 + lane;
        float gi, lf; gate_pair(p, row, dir, h, gi, lf);
        const float bc = wave_scan_add(lf, lane, dir);
        const float ref = wave_max(gi - bc), tot = wave_sum(lf);
        if (lane == 0) { sTot[c] = tot; sRef[c] = ref; }
    }
    __syncthreads();
    if (tid == 0) {
        float m0 = -INFINITY;
        for (int step = 0; step < NCH; ++step) {
            const int c = chunk_at(dir, step);
            sM0[c] = m0;
            const float mx = fmaxf(m0, sRef[c]);
            if (sub == 0) { CSC[(chain * NCH + c) * 2] = fexp(m0 - mx); CSC[(chain * NCH + c) * 2 + 1] = fexp(sRef[c] - mx); }
            m0 = sTot[c] + mx;
        }
    }
    __syncthreads();
    for (int k = wave; sub + 16 * k < NCH; k += NWV) {
        const int c = sub + 16 * k;
        const size_t row = (size_t)b * TB + c * 64 + lane;
        float gi, lf; gate_pair(p, row, dir, h, gi, lf);
        const float bc = wave_scan_add(lf, lane, dir);
        const float a = gi - bc;
        const float amax = wave_scan_max(a, lane, dir);
        const float ref = sRef[c], m0 = sM0[c];
        const float mmax = fmaxf(amax, m0);
        const float mt = bc + mmax;
        const float alpha = fexp(ref - mmax), beta = fexp(a - ref), gg = fexp(m0 - mmax), em = fexp(-mt);
        st4(GSC + ((size_t)chain * TB + c * 64 + lane) * 4, make_float4(alpha, beta, gg, em));
        sBeta[k * 64 + lane] = beta;
    }
    __syncthreads();
    {
        float* part = sm + 1024;
        const int sg = tid >> 6, j8 = (tid & 63) * 8;
        for (int k = 0; sub + 16 * k < NCH; ++k) {
            const int c = sub + 16 * k;
            const bf16_t* xp = XC + ((size_t)b * TB + c * 64 + sg * 8) * 2048 + h * 512 + j8;
            float acc[8];
#pragma unroll
            for (int i = 0; i < 8; ++i) acc[i] = 0.f;
#pragma unroll
            for (int s = 0; s < 8; ++s) {
                float f[8]; unpack8(*(const uint4*)(xp + (size_t)s * 2048), f);
                const float be = sBeta[k * 64 + sg * 8 + s];
#pragma unroll
                for (int i = 0; i < 8; ++i) acc[i] += be * f[i];
            }
            __syncthreads();
            st4(part + sg * 512 + j8, make_float4(acc[0], acc[1], acc[2], acc[3])); st4(part + sg * 512 + j8 + 4, make_float4(acc[4], acc[5], acc[6], acc[7]));
            __syncthreads();
            float tot = 0.f;
#pragma unroll
            for (int q = 0; q < 8; ++q) tot += part[q * 512 + tid];
            NBUF[((size_t)chain * NCH + c) * 512 + tid] = tot;
        }
    }
    bf16_t* XCs = (bf16_t*)sm;
    bf16_t* Qs = XCs + 64 * 520;
    for (int u = blockIdx.x; u < NB * 4 * NCH; u += gridDim.x) {
        const int bh = u / NCH, c = u % NCH, ub = bh >> 2, uh = bh & 3;
        __syncthreads();
#pragma unroll 2
        for (int i = 0; i < 8; ++i) {
            const int pp = tid + 512 * i, row = pp >> 6, c16 = pp & 63;
            const uint4 xv = *(const uint4*)(XC + ((size_t)ub * TB + c * 64 + row) * 2048 + uh * 512 + c16 * 8);
            float f[8]; unpack8(xv, f);
            float q[8];
#pragma unroll
            for (int bb = 0; bb < 2; ++bb) {
                const float* G = gtab + (size_t)(uh * 128 + c16 * 2 + bb) * 16;
                const float4 g0 = ld4(G), g1 = ld4(G + 4), g2 = ld4(G + 8), g3 = ld4(G + 12);
                q[bb * 4 + 0] = f[bb * 4] * g0.x + f[bb * 4 + 1] * g1.x + f[bb * 4 + 2] * g2.x + f[bb * 4 + 3] * g3.x;
                q[bb * 4 + 1] = f[bb * 4] * g0.y + f[bb * 4 + 1] * g1.y + f[bb * 4 + 2] * g2.y + f[bb * 4 + 3] * g3.y;
                q[bb * 4 + 2] = f[bb * 4] * g0.z + f[bb * 4 + 1] * g1.z + f[bb * 4 + 2] * g2.z + f[bb * 4 + 3] * g3.z;
                q[bb * 4 + 3] = f[bb * 4] * g0.w + f[bb * 4 + 1] * g1.w + f[bb * 4 + 2] * g2.w + f[bb * 4 + 3] * g3.w;
            }
            *(uint4*)(XCs + row * 520 + c16 * 8) = xv;
            *(uint4*)(Qs + row * 520 + c16 * 8) = make_uint4(pack2bf(q[0], q[1]), pack2bf(q[2], q[3]), pack2bf(q[4], q[5]), pack2bf(q[6], q[7]));
        }
        __syncthreads();
        const int st = wave & 3, tt0 = (wave >> 2) * 2;
        f32x4 a0 = (f32x4){0.f, 0.f, 0.f, 0.f}, a1 = a0;
        const bf16_t* ap = XCs + (st * 16 + (lane & 15)) * 520 + (lane >> 4) * 8;
        const bf16_t* bp0 = Qs + (tt0 * 16 + (lane & 15)) * 520 + (lane >> 4) * 8;
        const bf16_t* bp1 = bp0 + 16 * 520;
#pragma unroll
        for (int ks = 0; ks < 16; ++ks) {
            const bf16x8 af = *(const bf16x8*)(ap + ks * 32);
            a0 = __builtin_amdgcn_mfma_f32_16x16x32_bf16(af, *(const bf16x8*)(bp0 + ks * 32), a0, 0, 0, 0);
            a1 = __builtin_amdgcn_mfma_f32_16x16x32_bf16(af, *(const bf16x8*)(bp1 + ks * 32), a1, 0, 0, 0);
        }
        bf16_t* sp = SMAT + (size_t)u * 4096 + (size_t)(tt0 * 16 + (lane & 15)) * 64 + st * 16 + (lane >> 4) * 4;
        *(uint2*)sp = make_uint2(pack2bf(a0[0], a0[1]), pack2bf(a0[2], a0[3]));
        *(uint2*)(sp + 16 * 64) = make_uint2(pack2bf(a1[0], a1[1]), pack2bf(a1[2], a1[3]));
    }
}

DEV void phase_x2(const Params& p, float* sm) {
    int chain, sub; chain_ids(chain, sub);
    const int b = chain >> 3, h = (chain >> 1) & 3, dir = chain & 1;
    const bf16_t* XC = (const bf16_t*)(p.ws + OFF_XC);
    float* GSC = (float*)(p.ws + OFF_GSC); const float* CSC = (const float*)(p.ws + OFF_CSC); const float* NBUF = (const float*)(p.ws + OFF_NBUF);
    const float* gtab = (const float*)(p.ws + OFF_GTAB);
    const bf16_t* SMAT = (const bf16_t*)(p.ws + OFF_SMAT);
    const int tid = opaque_tid();
    float* sD0 = sm; float* sCf = sm + 132; float* sN0 = sm + 264; float* sN2 = sN0 + 9 * 512;
    for (int i = tid; i < NCH; i += NTHR) { sD0[i] = CSC[(chain * NCH + i) * 2]; sCf[i] = CSC[(chain * NCH + i) * 2 + 1]; }
    __syncthreads();
    {
        float n = 0.f;
        const float* nb = NBUF + (size_t)chain * NCH * 512 + tid;
#pragma unroll 4
        for (int step = 0; step < NCH; ++step) {
            const int c = chunk_at(dir, step);
            if ((c & 15) == sub) sN0[(c >> 4) * 512 + tid] = n;
            n = sD0[c] * n + sCf[c] * nb[(size_t)c * 512];
        }
    }
    __syncthreads();
    {
        const int blk = tid >> 2, cp = tid & 3;
        const float4 g = ld4(gtab + (size_t)(h * 128 + blk) * 16 + cp * 4);
        for (int k = 0; sub + 16 * k < NCH; ++k) {
            const float* n0 = sN0 + k * 512 + blk * 4;
            sN2[k * 512 + tid] = g.x * n0[0] + g.y * n0[1] + g.z * n0[2] + g.w * n0[3];
        }
    }
    __syncthreads();
    const int t = tid >> 3, part = tid & 7;
    for (int k = 0; sub + 16 * k < NCH; ++k) {
        const int c = sub + 16 * k;
        const size_t row = (size_t)b * TB + c * 64 + t;
        float dint = 0.f;
        {
            const bf16_t* xp = XC + row * 2048 + h * 512 + part * 64;
            const float* n2 = sN2 + k * 512 + part * 64;
#pragma unroll
            for (int i = 0; i < 8; ++i) {
                float f[8]; unpack8(*(const uint4*)(xp + i * 8), f);
                const float4 na = ld4(n2 + i * 8), nb2 = ld4(n2 + i * 8 + 4);
                dint += f[0] * na.x + f[1] * na.y + f[2] * na.z + f[3] * na.w + f[4] * nb2.x + f[5] * nb2.y + f[6] * nb2.z + f[7] * nb2.w;
            }
        }
        float di = 0.f;
        {
            float f[8]; unpack8(*(const uint4*)(SMAT + ((size_t)((b * 4 + h) * NCH + c)) * 4096 + t * 64 + part * 8), f);
#pragma unroll
            for (int e = 0; e < 8; ++e) {
                const int s = part * 8 + e;
                const float beta = GSC[((size_t)chain * TB + c * 64 + s) * 4 + 1];
                const bool keep = dir ? (s >= t) : (s <= t);
                di += keep ? f[e] * beta : 0.f;
            }
        }
        dint += __shfl_xor(dint, 1, 64); dint += __shfl_xor(dint, 2, 64); dint += __shfl_xor(dint, 4, 64);
        di += __shfl_xor(di, 1, 64); di += __shfl_xor(di, 2, 64); di += __shfl_xor(di, 4, 64);
        if (part == 0) {
            float* gp = GSC + ((size_t)chain * TB + c * 64 + t) * 4;
            const float4 g4 = ld4(gp);
            const float den = g4.x * di + g4.z * dint;
            gp[3] = 1.f / fmaxf(fabsf(den), g4.w);
        }
    }
}

#define MLSTM_PREFETCH(step_) do { \
    const int c_ = chunk_at(dir, (step_)); const size_t rb_ = (size_t)b * TB + (size_t)c_ * 64; \
    { const bf16_t* xb_ = XC + (rb_ + (tid >> 6)) * 2048 + h * 512 + (tid & 63) * 8; \
      rx0 = *(const uint4*)(xb_); rx1 = *(const uint4*)(xb_ + 8 * 2048); rx2 = *(const uint4*)(xb_ + 16 * 2048); rx3 = *(const uint4*)(xb_ + 24 * 2048); \
      rx4 = *(const uint4*)(xb_ + 32 * 2048); rx5 = *(const uint4*)(xb_ + 40 * 2048); rx6 = *(const uint4*)(xb_ + 48 * 2048); rx7 = *(const uint4*)(xb_ + 56 * 2048); } \
    rxm = *(const uint2*)(XM + (rb_ + ps) * 2048 + ch0 + pvb * 4); \
    rs = *(const uint4*)(SMAT + ((size_t)((b * 4 + h) * NCH + c_)) * 4096 + ps * 64 + pvb * 8); \
    rbeta = GSC[((size_t)chain * TB + c_ * 64 + ps) * 4 + 1]; \
    if (tid < 64) rsc = ld4(GSC + ((size_t)chain * TB + c_ * 64 + tid) * 4); \
    rd0 = CSC[(chain * NCH + c_) * 2]; rcf = CSC[(chain * NCH + c_) * 2 + 1]; } while (0)

DEV void phase_mlstm(const Params& p, float* sm) {
    int chain, sub; chain_ids(chain, sub);
    const int b = chain >> 3, h = (chain >> 1) & 3, dir = chain & 1;
    const bf16_t* XM = (const bf16_t*)(p.ws + OFF_XM);
    const bf16_t* XC = (const bf16_t*)(p.ws + OFF_XC);
    const bf16_t* SMAT = (const bf16_t*)(p.ws + OFF_SMAT);
    const float* GSC = (const float*)(p.ws + OFF_GSC); const float* CSC = (const float*)(p.ws + OFF_CSC);
    const float* gtab = (const float*)(p.ws + OFF_GTAB);
    bf16_t* H = (bf16_t*)(p.ws + OFF_H);
    const float* wv = p.in[35];
    char* smc = (char*)sm;
    bf16_t* XCs = (bf16_t*)smc;
    bf16_t* Cs = (bf16_t*)(smc + 66560);
    bf16_t* Vb = (bf16_t*)(smc + 66560 + 33280);
    bf16_t* Vw = Vb + 32 * 72;
    bf16_t* Sm = Vw + 32 * 72;
    float* Gs = (float*)(smc + 66560 + 33280 + 2 * 4608 + 9216);
    float* sc = Gs + 2048;
    const int tid = opaque_tid(), lane = tid & 63, wave = tid >> 6;
    for (int i = tid; i < 32 * 520 / 2; i += NTHR) ((unsigned*)Cs)[i] = 0u;
    for (int i = tid; i < 2048; i += NTHR) Gs[i] = gtab[h * 2048 + i];
    const int ps = tid >> 3, pvb = tid & 7;
    const int ch0 = h * 512 + sub * 32;
    float wvr[16];
#pragma unroll
    for (int i = 0; i < 16; ++i) wvr[i] = wv[(size_t)((ch0 >> 2) + pvb) * 16 + i];
    f32x4 accS[4][2];
#pragma unroll
    for (int i = 0; i < 4; ++i) { accS[i][0] = (f32x4){0.f, 0.f, 0.f, 0.f}; accS[i][1] = (f32x4){0.f, 0.f, 0.f, 0.f}; }
    uint4 rx0, rx1, rx2, rx3, rx4, rx5, rx6, rx7; uint2 rxm; uint4 rs; float rbeta; float4 rsc = make_float4(0.f, 0.f, 0.f, 0.f); float rd0, rcf;
    MLSTM_PREFETCH(0);
    __syncthreads();
#pragma unroll 1
    for (int step = 0; step < NCH; ++step) {
        const int c = chunk_at(dir, step);
        const float d0 = rd0, cf = rcf;
        {
            bf16_t* xd = XCs + (tid >> 6) * 520 + (tid & 63) * 8;
            *(uint4*)(xd) = rx0; *(uint4*)(xd + 8 * 520) = rx1; *(uint4*)(xd + 16 * 520) = rx2; *(uint4*)(xd + 24 * 520) = rx3;
            *(uint4*)(xd + 32 * 520) = rx4; *(uint4*)(xd + 40 * 520) = rx5; *(uint4*)(xd + 48 * 520) = rx6; *(uint4*)(xd + 56 * 520) = rx7;
        }
        {
            const float x0 = bflo(rxm.x), x1 = bfhi(rxm.x), x2 = bflo(rxm.y), x3 = bfhi(rxm.y);
#pragma unroll
            for (int d = 0; d < 4; ++d) {
                const float v = (x0 * wvr[d] + x1 * wvr[4 + d] + x2 * wvr[8 + d] + x3 * wvr[12 + d]) * rbeta;
                Vb[(pvb * 4 + d) * 72 + ps] = __builtin_bit_cast(unsigned short, (__bf16)v);
                Vw[(pvb * 4 + d) * 72 + ps] = __builtin_bit_cast(unsigned short, (__bf16)(v * cf));
            }
        }
        {
#define SMASK(q_) (((dir ? (pvb * 8 + 2 * (q_) >= ps) : (pvb * 8 + 2 * (q_) <= ps)) ? 0x0000ffffu : 0u) | ((dir ? (pvb * 8 + 2 * (q_) + 1 >= ps) : (pvb * 8 + 2 * (q_) + 1 <= ps)) ? 0xffff0000u : 0u))
            *(uint4*)(Sm + ps * 72 + pvb * 8) = make_uint4(rs.x & SMASK(0), rs.y & SMASK(1), rs.z & SMASK(2), rs.w & SMASK(3));
#undef SMASK
        }
        if (tid < 64) st4(sc + tid * 4, rsc);
        { const int nstep = (step + 1 < NCH) ? step + 1 : step; MLSTM_PREFETCH(nstep); }
        __syncthreads();
        {
            const int vt = wave & 1, tt = wave >> 1;
            f32x4 ao = (f32x4){0.f, 0.f, 0.f, 0.f}, ai = ao, ao1 = ao, ao2 = ao, ao3 = ao;
            const bf16_t* ap = Cs + (vt * 16 + (lane & 15)) * 520 + (lane >> 4) * 8;
            const bf16_t* bp = XCs + (tt * 16 + (lane & 15)) * 520 + (lane >> 4) * 8;
#pragma unroll
            for (int ks = 0; ks < 16; ks += 4) {
                ao = __builtin_amdgcn_mfma_f32_16x16x32_bf16(*(const bf16x8*)(ap + ks * 32), *(const bf16x8*)(bp + ks * 32), ao, 0, 0, 0);
                ao1 = __builtin_amdgcn_mfma_f32_16x16x32_bf16(*(const bf16x8*)(ap + (ks + 1) * 32), *(const bf16x8*)(bp + (ks + 1) * 32), ao1, 0, 0, 0);
                ao2 = __builtin_amdgcn_mfma_f32_16x16x32_bf16(*(const bf16x8*)(ap + (ks + 2) * 32), *(const bf16x8*)(bp + (ks + 2) * 32), ao2, 0, 0, 0);
                ao3 = __builtin_amdgcn_mfma_f32_16x16x32_bf16(*(const bf16x8*)(ap + (ks + 3) * 32), *(const bf16x8*)(bp + (ks + 3) * 32), ao3, 0, 0, 0);
            }
            ao = (ao + ao1) + (ao2 + ao3);
            const bf16_t* ap2 = Vb + (vt * 16 + (lane & 15)) * 72 + (lane >> 4) * 8;
            const bf16_t* bp2 = Sm + (tt * 16 + (lane & 15)) * 72 + (lane >> 4) * 8;
#pragma unroll
            for (int ks = 0; ks < 2; ++ks) ai = __builtin_amdgcn_mfma_f32_16x16x32_bf16(*(const bf16x8*)(ap2 + ks * 32), *(const bf16x8*)(bp2 + ks * 32), ai, 0, 0, 0);
            if (c >= 4) {
                const int t = tt * 16 + (lane & 15);
                const float4 s4 = ld4(sc + t * 4);
                const float h0 = (s4.x * ai[0] + s4.z * ao[0]) * s4.w, h1 = (s4.x * ai[1] + s4.z * ao[1]) * s4.w;
                const float h2 = (s4.x * ai[2] + s4.z * ao[2]) * s4.w, h3 = (s4.x * ai[3] + s4.z * ao[3]) * s4.w;
                bf16_t* hp = H + ((size_t)b * NL + (size_t)c * 64 + t - NCX) * 2048 + ch0 + vt * 16 + (lane >> 4) * 4;
                const unsigned u0 = pack2bf(h0, h1), u1 = pack2bf(h2, h3);
                __builtin_amdgcn_global_atomic_fadd_v2bf16((__attribute__((address_space(1))) s16x2*)hp, __builtin_bit_cast(s16x2, u0));
                __builtin_amdgcn_global_atomic_fadd_v2bf16((__attribute__((address_space(1))) s16x2*)(hp + 2), __builtin_bit_cast(s16x2, u1));
            }
        }
#pragma unroll
        for (int jt = 0; jt < 4; ++jt) { accS[jt][0] *= d0; accS[jt][1] *= d0; }
#pragma unroll
        for (int ks = 0; ks < 2; ++ks) {
            const bf16x8 b0 = *(const bf16x8*)(Vw + (lane & 15) * 72 + ks * 32 + (lane >> 4) * 8);
            const bf16x8 b1 = *(const bf16x8*)(Vw + (16 + (lane & 15)) * 72 + ks * 32 + (lane >> 4) * 8);
            const int row0 = ks * 32 + (lane >> 4) * 8 + ((lane & 15) >> 2);
#pragma unroll
            for (int jt = 0; jt < 4; ++jt) {
                const int col = wave * 64 + jt * 16 + (lane & 3) * 4;
                const s16x4 lo = __builtin_amdgcn_ds_read_tr16_b64_v4i16((__attribute__((address_space(3))) s16x4*)(XCs + row0 * 520 + col));
                const s16x4 hi = __builtin_amdgcn_ds_read_tr16_b64_v4i16((__attribute__((address_space(3))) s16x4*)(XCs + (row0 + 4) * 520 + col));
                const bf16x8 af = (bf16x8){lo[0], lo[1], lo[2], lo[3], hi[0], hi[1], hi[2], hi[3]};
                accS[jt][0] = __builtin_amdgcn_mfma_f32_16x16x32_bf16(af, b0, accS[jt][0], 0, 0, 0);
                accS[jt][1] = __builtin_amdgcn_mfma_f32_16x16x32_bf16(af, b1, accS[jt][1], 0, 0, 0);
            }
        }
        __syncthreads();
#pragma unroll
        for (int jt = 0; jt < 4; ++jt) {
            const int blk = wave * 16 + jt * 4 + (lane >> 4);
            const float4 g0 = ld4(Gs + blk * 16), g1 = ld4(Gs + blk * 16 + 4), g2 = ld4(Gs + blk * 16 + 8), g3 = ld4(Gs + blk * 16 + 12);
#pragma unroll
            for (int v2 = 0; v2 < 2; ++v2) {
                const f32x4 a = accS[jt][v2];
                const float o0 = g0.x * a[0] + g0.y * a[1] + g0.z * a[2] + g0.w * a[3];
                const float o1 = g1.x * a[0] + g1.y * a[1] + g1.z * a[2] + g1.w * a[3];
                const float o2 = g2.x * a[0] + g2.y * a[1] + g2.z * a[2] + g2.w * a[3];
                const float o3 = g3.x * a[0] + g3.y * a[1] + g3.z * a[2] + g3.w * a[3];
                *(uint2*)(Cs + (v2 * 16 + (lane & 15)) * 520 + blk * 4) = make_uint2(pack2bf(o0, o1), pack2bf(o2, o3));
            }
        }
    }
}

DEV void phase_finish1(const Params& p) {
    bf16_t* H = (bf16_t*)(p.ws + OFF_H);
    const bf16_t* XC = (const bf16_t*)(p.ws + OFF_XC);
    const bf16_t* Z = (const bf16_t*)(p.ws + OFF_XM);
    const float* ng = p.in[44]; const float* skip = p.in[45];
    const int tid_ = opaque_tid(); const int lane = tid_ & 63, gw = blockIdx.x * NWV + (tid_ >> 6), ngw = gridDim.x * NWV;
    for (int it = gw; it < NB * NL * 4; it += ngw) {
        const int r = it >> 2, h = it & 3, b = r >= NL ? 1 : 0, nn = r - b * NL;
        const int c0 = h * 512 + lane * 8;
        bf16_t* hp = H + (size_t)r * 2048 + c0;
        float v[8]; unpack8(*(const uint4*)hp, v);
        float sum = 0.f;
#pragma unroll
        for (int j = 0; j < 8; ++j) sum += v[j];
        const float mean = wave_sum(sum) * (1.f / 512.f);
        float sq = 0.f;
#pragma unroll
        for (int j = 0; j < 8; ++j) { v[j] -= mean; sq += v[j] * v[j]; }
        const float rstd = rsqrtf(wave_sum(sq) * (1.f / 512.f) + 1e-5f);
        float xc[8], z[8];
        unpack8(*(const uint4*)(XC + ((size_t)b * TB + NCX + nn) * 2048 + c0), xc);
        unpack8(*(const uint4*)(Z + (size_t)r * 2048 + c0), z);
        float o[8];
#pragma unroll
        for (int j = 0; j < 8; ++j) o[j] = (v[j] * rstd * ng[c0 + j] + skip[c0 + j] * xc[j]) * silu_f(z[j]);
        *(uint4*)hp = make_uint4(pack2bf(o[0], o[1]), pack2bf(o[2], o[3]), pack2bf(o[4], o[5]), pack2bf(o[6], o[7]));
    }
}

__global__ void __launch_bounds__(NTHR) fwd_kernel(Params p) {
    extern __shared__ __attribute__((aligned(16))) float sm[];
    volatile LAS unsigned* xst = (volatile LAS unsigned*)((LAS char*)sm + (LDS_BYTES - 16));
    if (threadIdx.x == 0) { xst[0] = 0u; xst[1] = 0u; }
    __syncthreads();
    const XcdBarrier xbar = xcd_barrier_post((unsigned*)(p.ws + OFF_BAR), xst);
    const int tid = opaque_tid(), lane = tid & 63, wave = tid >> 6;
    float* modv = (float*)(p.ws + OFF_MODV);
    float* X1C = (float*)(p.ws + OFF_X1C);

    phase_mod(p, sm);
    phase_tables(p);
    transpose_convert(p.in[8], 1024, EIN, 4096, (bf16_t*)(p.ws + OFF_WT0), sm);
    transpose_convert(p.in[29], 1024, 4096, 4096, (bf16_t*)(p.ws + OFF_WT1), sm);
    transpose_convert(p.in[9], 1024, 1024, 1024, (bf16_t*)(p.ws + OFF_WT2), sm);
    transpose_convert(p.in[30], 2048, 1024, 1024, (bf16_t*)(p.ws + OFF_WT3), sm);
    xcd_barrier(xbar);

#pragma unroll 1
    for (int b = 0; b < NB; ++b) {
        if (b == 0) { phase_h0(p, 0); xcd_barrier(xbar); }
        run_gemm((const bf16_t*)(p.ws + OFF_YC), (const bf16_t*)(p.ws + OFF_WT0), TB, 4096, DM, EpBf16{(bf16_t*)(p.ws + OFF_P0), EIN, EIN}, sm);
        xcd_barrier(xbar);
        for (int u = blockIdx.x; u < 24 * NCH; u += gridDim.x) {
            if (u < 16 * NCH) rwkv1_unit(p, (u / NCH) >> 1, (u / NCH) & 1, u % NCH, sm);
            else { const int v = u - 16 * NCH; gla1_unit(p, (v / NCH) >> 1, (v / NCH) & 1, v % NCH, sm); }
        }
        xcd_barrier(xbar);
        if (blockIdx.x < 128) gla2_unit(p, blockIdx.x);
        else if (blockIdx.x < 192) rwkv2_unit(p, (blockIdx.x - 128) >> 2, (blockIdx.x - 128) & 3, sm);
        xcd_barrier(xbar);
        for (int u = blockIdx.x; u < 12 * NCH; u += gridDim.x) {
            if (u < 8 * NCH) rwkv3_unit(p, u / NCH, u % NCH, sm);
            else { const int v = u - 8 * NCH; gla3_unit(p, v / NCH, v % NCH, sm); }
        }
        xcd_barrier(xbar);
        run_gemm((const bf16_t*)(p.ws + OFF_YC), (const bf16_t*)(p.ws + OFF_WT2), TB, DM, DM, EpRes0{(float*)(p.ws + OFF_P0), modv, b}, sm);
        xcd_barrier(xbar);
        ln_rows((const float*)(p.ws + OFF_P0), p.in[0] + (size_t)b * NL * DM, p.in[2] + (size_t)b * NCX * DM, TB, p.in[6], p.in[7], p.out + (size_t)b * NL * DM, X1C + (size_t)b * NCX * DM, NCX,
                (bf16_t*)(p.ws + OFF_H1B) + (size_t)b * TB * DM, modv + (3 + 2) * 3072, modv + (3 + b) * 3072);
        if (b == 0) phase_h0(p, 1);
        xcd_barrier(xbar);
    }

    run_gemm((const bf16_t*)(p.ws + OFF_H1B), (const bf16_t*)(p.ws + OFF_WT1), RT, 2048, DM, EpBf16{(bf16_t*)(p.ws + OFF_XM), 2048, 2048}, sm);
    zero_f4((float*)(p.ws + OFF_H), (size_t)NB * NL * 1024);
    xcd_barrier(xbar);
    phase_conv1(p, sm);
    xcd_barrier(xbar);
    phase_x1(p, sm);
    xcd_barrier(xbar);
    phase_x2(p, sm);
    xcd_barrier(xbar);
    phase_mlstm(p, sm);
    xcd_barrier(xbar);
    phase_h1l(p);
    xcd_barrier(xbar);
    run_gemm((const bf16_t*)(p.ws + OFF_H1B), (const bf16_t*)(p.ws + OFF_WT1) + (size_t)2048 * 1024, NB * NL, 2048, DM, EpBf16{(bf16_t*)(p.ws + OFF_XM), 2048, 2048}, sm);
    xcd_barrier(xbar);
    phase_finish1(p);
    xcd_barrier(xbar);
    run_gemm((const bf16_t*)(p.ws + OFF_H), (const bf16_t*)(p.ws + OFF_WT3), NB * NL, DM, 2048, EpRes1{(float*)(p.ws + OFF_XC), modv + 3 * 3072}, sm);
    xcd_barrier(xbar);
    ln_rows((const float*)(p.ws + OFF_XC), p.out, p.out, NB * NL, p.in[6] + 1024, p.in[7] + 1024, p.out, p.out, 0);
}

extern "C" void kernel_launch(void* const* d_in, const int* in_sizes, int n_in, void* d_out, int out_size, void* d_ws, size_t ws_size, hipStream_t stream) {
    static int grid_blocks = 0;
    if (grid_blocks == 0) {
        if (ws_size < WS_NEED || n_in != 46) { fprintf(stderr, "kernel_launch: bad ws_size %zu (need %zu) or n_in %d\n", ws_size, (size_t)WS_NEED, n_in); grid_blocks = -1; return; }
        int dev = 0, cus = 0, per_cu = 0;
        (void)hipGetDevice(&dev);
        (void)hipDeviceGetAttribute(&cus, hipDeviceAttributeMultiprocessorCount, dev);
        (void)hipFuncSetAttribute((const void*)fwd_kernel, hipFuncAttributeMaxDynamicSharedMemorySize, LDS_BYTES);
        (void)hipOccupancyMaxActiveBlocksPerMultiprocessor(&per_cu, (const void*)fwd_kernel, NTHR, LDS_BYTES);
        if (per_cu < 1 || cus < 256) { fprintf(stderr, "kernel_launch: occupancy query says %d blocks/CU on %d CUs; this kernel needs 256 resident workgroups\n", per_cu, cus); grid_blocks = -1; return; }
        grid_blocks = 256;
    }
    if (grid_blocks < 0) return;
    (void)hipMemsetAsync((char*)d_ws + OFF_BAR, 0, XCD_BAR_WORDS * 4, stream);
    Params p{};
    for (int i = 0; i < 46; ++i) p.in[i] = (const float*)d_in[i];
    p.out = (float*)d_out; p.ws = (char*)d_ws;
    void* args[] = {&p};
    hipError_t e = hipLaunchCooperativeKernel((const void*)fwd_kernel, dim3(grid_blocks), dim3(NTHR), args, LDS_BYTES, stream);
    if (e != hipSuccess) fprintf(stderr, "cooperative launch failed: %s (grid %d)\n", hipGetErrorString(e), grid_blocks);
}
```

```cpp
#include <hip/hip_runtime.h>
#include <cstdio>
#include <cmath>

#define DEV __device__ __forceinline__

constexpr int NB = 2, NL = 8192, DM = 1024, NCX = 256, TB = NCX + NL;
constexpr int RT = NB * TB;
constexpr int NCH = TB / 64;
constexpr int EIN = 3872, RW0 = 1568;
constexpr int NTHR = 512, NWV = 8;
constexpr float ALPHA = 1.41421356237f;
constexpr float KSCALE = 0.04419417382f;

constexpr size_t OFF_MODV = 0;
constexpr size_t OFF_X1C  = 131072;
constexpr size_t OFF_BAR  = 3145728;
constexpr size_t OFF_BIG  = 4194304;
constexpr size_t OFF_P0   = OFF_BIG;
constexpr size_t OFF_YC   = OFF_BIG + (size_t)TB * EIN * 2;
constexpr size_t OFF_GDS  = OFF_YC + (size_t)TB * 1024 * 2;
constexpr size_t OFF_GDEC = OFF_GDS + (size_t)8 * NCH * 8192 * 4;
constexpr size_t OFF_RU   = OFF_GDEC + (size_t)8 * NCH * 64 * 4;
constexpr size_t OFF_RS0  = OFF_RU + (size_t)16 * NCH * 16384 * 2;
constexpr size_t OFF_BONS = OFF_RS0 + (size_t)16 * NCH * 4096 * 2;
constexpr size_t L0_END   = OFF_BONS + (size_t)2 * TB * 8 * 4;
constexpr size_t OFF_XM   = OFF_BIG;
constexpr size_t OFF_XC   = OFF_XM + (size_t)RT * 2048 * 2;
constexpr size_t OFF_H    = OFF_XC + (size_t)RT * 2048 * 2;
constexpr size_t OFF_WT0  = OFF_H + (size_t)NB * NL * 2048 * 2;
constexpr size_t OFF_WT1  = OFF_WT0 + (size_t)4096 * 1024 * 2;
constexpr size_t OFF_WT2  = OFF_WT1 + (size_t)4096 * 1024 * 2;
constexpr size_t OFF_WT3  = OFF_WT2 + (size_t)1024 * 1024 * 2;
constexpr size_t OFF_G16  = OFF_WT3 + (size_t)1024 * 2048 * 2;
constexpr size_t OFF_SMAT = OFF_G16 + (size_t)RT * 16 * 4;
constexpr size_t OFF_GSC  = OFF_SMAT + (size_t)NB * 4 * NCH * 4096 * 2;
constexpr size_t OFF_CSC  = OFF_GSC + (size_t)16 * TB * 4 * 4;
constexpr size_t OFF_NBUF = OFF_CSC + (size_t)16 * NCH * 2 * 4;
constexpr size_t OFF_GTAB = 3407872;
constexpr size_t OFF_WFT  = OFF_GTAB + (size_t)4 * 128 * 16 * 4;
static_assert(OFF_WFT + (size_t)16 * 4096 * 2 <= OFF_BIG, "low-region tables overflow");
constexpr size_t OFF_G16P = OFF_NBUF + (size_t)16 * NCH * 512 * 4;
constexpr size_t OFF_H1B  = OFF_G16;
constexpr size_t WS_NEED  = (OFF_G16P + (size_t)4 * RT * 16 * 4 > OFF_H1B + (size_t)RT * 1024 * 2) ? OFF_G16P + (size_t)4 * RT * 16 * 4 : OFF_H1B + (size_t)RT * 1024 * 2;
static_assert(WS_NEED <= (size_t)256 * 1024 * 1024, "workspace exceeds the guaranteed 256 MiB");

static_assert(L0_END <= OFF_WT0, "layer-0 buffers overlap the weight copies");
constexpr int LDS_BYTES = 139264;

struct Params { const float* in[46]; float* out; char* ws; };
typedef unsigned short bf16_t;
typedef __attribute__((ext_vector_type(8))) short bf16x8;
typedef __attribute__((ext_vector_type(4))) short s16x4;
typedef __attribute__((ext_vector_type(2))) short s16x2;
typedef __attribute__((ext_vector_type(4))) float f32x4;
typedef __attribute__((ext_vector_type(2))) __bf16 bf2_t;
DEV unsigned pack2bf(float lo, float hi) { bf2_t v; v[0] = (__bf16)lo; v[1] = (__bf16)hi; return __builtin_bit_cast(unsigned, v); }
DEV float bflo(unsigned u) { return __uint_as_float(u << 16); }
DEV float bfhi(unsigned u) { return __uint_as_float(u & 0xffff0000u); }
DEV float bf2f(bf16_t v) { return __uint_as_float(((unsigned)v) << 16); }
DEV void unpack8(uint4 u, float* f) { f[0] = bflo(u.x); f[1] = bfhi(u.x); f[2] = bflo(u.y); f[3] = bfhi(u.y); f[4] = bflo(u.z); f[5] = bfhi(u.z); f[6] = bflo(u.w); f[7] = bfhi(u.w); }

DEV float wave_sum(float v) {
#pragma unroll
    for (int o = 32; o > 0; o >>= 1) v += __shfl_xor(v, o, 64);
    return v;
}
DEV float wave_max(float v) {
#pragma unroll
    for (int o = 32; o > 0; o >>= 1) v = fmaxf(v, __shfl_xor(v, o, 64));
    return v;
}
DEV float fexp(float x) { return __expf(x); }
DEV float frcp(float x) { return __builtin_amdgcn_rcpf(x); }
DEV float sigmoid_f(float x) { return frcp(1.f + fexp(-x)); }
DEV float silu_f(float x) { return x * frcp(1.f + fexp(-x)); }
DEV float logsig_f(float x) { return fminf(x, 0.f) - __logf(1.f + fexp(-fabsf(x))); }
DEV float tanh_f(float x) { const float e = fexp(2.f * x); return 1.f - 2.f * frcp(e + 1.f); }
DEV void lds_fence() { asm volatile("" ::: "memory"); }
DEV int opaque_tid() { int t = threadIdx.x; asm volatile("" : "+v"(t)); return t; }
DEV int scan_s(int dir, int u) { return dir == 0 ? u : (u < NCX ? (NCX - 1 - u) : (TB - 1 + NCX - u)); }
DEV int chunk_at(int dir, int step) { return dir == 0 ? step : (step < 4 ? 3 - step : (NCH + 3 - step)); }
DEV float4 ld4(const float* p) { return *(const float4*)p; }
DEV void st4(float* p, float4 v) { *(float4*)p = v; }


#define XB_TMO      128
#define XB_XCNT(j)  (256  + 64 * (j))
#define XB_XSUB(j)  (1280 + 64 * (j))
#define XB_XGEN(j)  (2304 + 64 * (j))
#define XB_TOP      3328
#define XB_TOPGEN   3392
#define XCD_BAR_WORDS 3456
#define XB_SPIN_CAP (1u << 22)
#define LAS __attribute__((address_space(3)))
DEV unsigned xb_ld(unsigned* p) { return __hip_atomic_load(p, __ATOMIC_RELAXED, __HIP_MEMORY_SCOPE_AGENT); }
DEV unsigned xb_add(unsigned* p, unsigned v) { return __hip_atomic_fetch_add(p, v, __ATOMIC_RELAXED, __HIP_MEMORY_SCOPE_AGENT); }
DEV unsigned xb_xcc_id() { return (unsigned)__builtin_amdgcn_s_getreg((3 << 11) | 20) & 0xFu; }
#define XB_SPIN(cond, bar) do { unsigned _sp = 0; while (cond) { __builtin_amdgcn_s_sleep(1); \
    if ((++_sp & 255u) == 0u) { if (xb_ld(&(bar)[XB_TMO])) break; if (_sp > XB_SPIN_CAP) { atomicAdd(&(bar)[XB_TMO], 1u); break; } } } } while (0)
struct XcdBarrier { unsigned* bar; unsigned x; volatile LAS unsigned* st; };
DEV XcdBarrier xcd_barrier_post(unsigned* bar, volatile LAS unsigned* st) {
    XcdBarrier b; b.bar = bar; b.x = xb_xcc_id(); b.st = st;
    if (threadIdx.x == 0) (void)xb_add(&bar[XB_XCNT(b.x)], 1u);
    return b;
}
DEV void xcd_barrier_complete(unsigned* bar, unsigned x, unsigned& nloc, unsigned& nx) {
    const unsigned G = gridDim.x * gridDim.y * gridDim.z;
    unsigned sum, cnt, mine, sp = 0u;
    for (;;) {
        sum = 0u; cnt = 0u; mine = 0u;
#pragma unroll
        for (unsigned j = 0; j < 16; ++j) { const unsigned c = xb_ld(&bar[XB_XCNT(j)]); sum += c; cnt += (c > 0u) ? 1u : 0u; mine = (j == x) ? c : mine; }
        if (sum == G) break;
        __builtin_amdgcn_s_sleep(1);
        if ((++sp & 255u) == 0u) { if (xb_ld(&bar[XB_TMO])) break; if (sp > XB_SPIN_CAP) { atomicAdd(&bar[XB_TMO], 1u); break; } }
    }
    nloc = mine > 0u ? mine : 1u; nx = cnt > 0u ? cnt : 1u;
}
DEV void xcd_barrier(const XcdBarrier& b) {
    asm volatile("s_waitcnt vmcnt(0)" ::: "memory");
    __syncthreads();
    if (threadIdx.x == 0) {
        unsigned* bar = b.bar;
        __builtin_amdgcn_s_waitcnt(0);
        unsigned nloc = b.st[0], nx = b.st[1];
        if (nloc == 0u) { xcd_barrier_complete(bar, b.x, nloc, nx); b.st[0] = nloc; b.st[1] = nx; }
        const unsigned old = xb_add(&bar[XB_XSUB(b.x)], 1u);
        const unsigned gen = old / nloc;
        if (old + 1u == (gen + 1u) * nloc) {
            __builtin_amdgcn_fence(__ATOMIC_RELEASE, "agent");
            asm volatile("s_waitcnt vmcnt(0)" ::: "memory");
            const unsigned og = xb_add(&bar[XB_TOP], 1u);
            const unsigned tg = og / nx;
            if (og + 1u == (tg + 1u) * nx) xb_add(&bar[XB_TOPGEN], 1u);
            else XB_SPIN(xb_ld(&bar[XB_TOPGEN]) == tg, bar);
            __builtin_amdgcn_fence(__ATOMIC_ACQUIRE, "agent");
            xb_add(&bar[XB_XGEN(b.x)], 1u);
            asm volatile("s_waitcnt vmcnt(0)" ::: "memory");
        } else {
            XB_SPIN(xb_ld(&bar[XB_XGEN(b.x)]) == gen, bar);
            __builtin_amdgcn_fence(__ATOMIC_ACQUIRE, "agent");
            asm volatile("s_waitcnt vmcnt(0)" ::: "memory");
        }
    }
    __syncthreads();
}

namespace pg8 {
#define PG8_LAS __attribute__((address_space(3)))
typedef unsigned short bf16_t;
typedef short bf16x8 __attribute__((ext_vector_type(8)));
typedef float f32x4 __attribute__((ext_vector_type(4)));
typedef unsigned u32x4 __attribute__((ext_vector_type(4)));
constexpr int BM = 256, BK = 64, HALF = 128, HTB = HALF * BK * 2  , STAGE_BYTES = 8 * HTB, NXCD = 8, WGM = 8;

__host__ __device__ __forceinline__ int lds_byte(int r, int c) { const int st = (r >> 4) * 2 + (c >> 5), rr = r & 15, cc = c & 31, ob = rr * 64 + cc * 2; return st * 1024 + (ob ^ (((ob >> 9) & 1) << 5)); }
__host__ __device__ __forceinline__ void stage_rc(int b, int& R, int& C) { const int st = b / 1024, sb = b % 1024, swz = sb ^ (((sb >> 9) & 1) << 5); R = (st >> 1) * 16 + swz / 64; C = (st & 1) * 32 + (swz % 64) / 2; }
__host__ __device__ __forceinline__ int perm32(int rho) { const int n = rho >> 4, i = rho & 15; return 8 * (i >> 2) + 4 * n + (i & 3); }

struct Unit { int pm, pn; };
struct Gemm { const bf16_t* A; const bf16_t* Bt; int M, N, K; };

struct StaticOrder {
    int nM, nN, nwg, G, c;
    __host__ __device__ void init(int M, int N, int G_, int c_) { nM = M / BM; nN = N / BM; nwg = nM * nN; G = G_; c = c_; }
    __host__ __device__ bool next(int i, Unit& u) const {
        const long L = (long)i * G + c; if (L >= nwg) return false;
        int wgid = (int)L; { const int q = nwg / NXCD, r = nwg % NXCD, xcd = wgid % NXCD, off = wgid / NXCD; wgid = (xcd < r ? xcd * (q + 1) : r * (q + 1) + (xcd - r) * q) + off; }
        const int nig = WGM * nN, gid = wgid / nig, fm = gid * WGM, gsz = (nM - fm) < WGM ? (nM - fm) : WGM;
        u.pm = fm + ((wgid % nig) % gsz); u.pn = (wgid % nig) / gsz; return true;
    }
    __device__ __forceinline__ void a_ready(const Unit&) const {}
    __device__ __forceinline__ void done(const Unit&) const {}
};

template <class Epi, class Sched, bool STAMP = false>
__device__ __forceinline__ void gemm_phase(PG8_LAS unsigned char* lds, const Gemm g, const Sched& S, const Epi& E, unsigned long long* stamps) {
    int tid = threadIdx.x; asm volatile("" : "+v"(tid));
    const int wid = __builtin_amdgcn_readfirstlane(tid >> 6), lane = tid & 63, wr = wid >> 2, wc = wid & 3, fr = lane & 15, fq = lane >> 4;
    const int K = g.K, nt = K / BK;
#define PG8_STAMP() do { } while (0)
    PG8_STAMP();
    unsigned voffA[2], voffB[2];
#pragma unroll
    for (int i = 0; i < 2; ++i) { int R, C; stage_rc(tid * 16 + i * 8192, R, C); const int Rb = Epi::PERM ? ((R & ~31) + perm32(R & 31)) : R;
        voffA[i] = (unsigned)(R * K + C) * 2u; voffB[i] = (unsigned)(Rb * K + C) * 2u; }
    const size_t kstep = (size_t)(BK * 2);
    const size_t hstep = (size_t)HALF * K * 2;
    const size_t tstep = 2 * hstep;
    const unsigned ldsw = (unsigned)wid * 1024u;
    const int aoff = lds_byte(wr * 64 + fr, fq * 8), boff = lds_byte(wc * 32 + fr, fq * 8);
#define PG8_SA(b, h) (((b) * 2 + (h)) * HTB)
#define PG8_SB(b, h) ((4 + (b) * 2 + (h)) * HTB)
#define PG8_STAGE(bufoff, gbase, voff) do { _Pragma("unroll") for (int _i = 0; _i < 2; ++_i) \
        __builtin_amdgcn_global_load_lds((const unsigned*)((const char*)(gbase) + (voff)[_i]), (PG8_LAS unsigned*)(lds + (bufoff) + ldsw + _i * 8192), 16, 0, 0); } while (0)
#define PG8_LDA(dst, b, h) do { _Pragma("unroll") for (int m = 0; m < 4; ++m) _Pragma("unroll") for (int k = 0; k < 2; ++k) dst[m][k] = *(const PG8_LAS bf16x8*)(lds + PG8_SA(b, h) + aoff + m * 2048 + k * 1024); } while (0)
#define PG8_LDB(dst, b, h) do { _Pragma("unroll") for (int n = 0; n < 2; ++n) _Pragma("unroll") for (int k = 0; k < 2; ++k) dst[n][k] = *(const PG8_LAS bf16x8*)(lds + PG8_SB(b, h) + boff + n * 2048 + k * 1024); } while (0)
#define PG8_MMA(ai, bj, At, Bt) do { __builtin_amdgcn_s_setprio(1); _Pragma("unroll") for (int m = 0; m < 4; ++m) _Pragma("unroll") for (int n = 0; n < 2; ++n) _Pragma("unroll") for (int k = 0; k < 2; ++k) \
        acc[ai][bj][m][n] = __builtin_amdgcn_mfma_f32_16x16x32_bf16(Bt[n][k], At[m][k], acc[ai][bj][m][n], 0, 0, 0); __builtin_amdgcn_s_setprio(0); } while (0)
#define PG8_WAIT_V(n) asm volatile("s_waitcnt vmcnt(" #n ")" ::: "memory")
#define PG8_WAIT_L(n) asm volatile("s_waitcnt lgkmcnt(" #n ")" ::: "memory")
#define PG8_BAR __builtin_amdgcn_s_barrier()
#define PG8_SCHED __builtin_amdgcn_sched_barrier(0)
    Unit cur, nxt; int ui = 0;
    if (!S.next(0, cur)) return;
    f32x4 acc[2][2][4][2];
#pragma unroll
    for (int a = 0; a < 2; ++a)
#pragma unroll
        for (int b = 0; b < 2; ++b)
#pragma unroll
            for (int m = 0; m < 4; ++m)
#pragma unroll
                for (int n = 0; n < 2; ++n) acc[a][b][m][n] = (f32x4){0.f, 0.f, 0.f, 0.f};
    bf16x8 At[4][2], B0[2][2], B1[2][2];
    const char* cA = (const char*)g.A + (size_t)cur.pm * tstep; const char* cB = (const char*)g.Bt + (size_t)cur.pn * tstep;
    S.a_ready(cur);
    PG8_STAGE(PG8_SB(0, 0), cB, voffB); PG8_STAGE(PG8_SA(0, 0), cA, voffA); PG8_STAGE(PG8_SB(0, 1), cB + hstep, voffB); PG8_STAGE(PG8_SA(0, 1), cA + hstep, voffA);
    if (wr == 1) PG8_BAR;
    PG8_WAIT_V(4); PG8_BAR;
    PG8_STAGE(PG8_SB(1, 0), cB + kstep, voffB); PG8_STAGE(PG8_SA(1, 0), cA + kstep, voffA); PG8_STAGE(PG8_SB(1, 1), cB + hstep + kstep, voffB);
    PG8_WAIT_V(6); PG8_BAR;
    PG8_STAMP();
    for (;;) {
        const bool has_next = S.next(ui + 1, nxt);
        const char* nA = has_next ? (const char*)g.A + (size_t)nxt.pm * tstep : cA; const char* nB = has_next ? (const char*)g.Bt + (size_t)nxt.pn * tstep : cB;
        for (int t = 0; t < nt; t += 2) {
            const bool last = (t == nt - 2);
            const char* a1 = cA + (size_t)(t + 1) * kstep;
            const char* a2 = last ? nA : cA + (size_t)(t + 2) * kstep; const char* b2 = last ? nB : cB + (size_t)(t + 2) * kstep;
            const char* a3 = a2 + kstep; const char* b3 = b2 + kstep;
            if (last && has_next) S.a_ready(nxt);
            PG8_LDB(B0, 0, 0); PG8_SCHED; PG8_LDA(At, 0, 0); PG8_STAGE(PG8_SA(1, 1), a1 + hstep, voffA);
            PG8_WAIT_L(8); PG8_BAR; PG8_WAIT_L(0); PG8_MMA(0, 0, At, B0); PG8_BAR; PG8_SCHED;
            PG8_LDB(B1, 0, 1); PG8_STAGE(PG8_SB(0, 0), b2, voffB);
            PG8_BAR; PG8_WAIT_L(0); PG8_MMA(0, 1, At, B1); PG8_BAR;
            PG8_LDA(At, 0, 1); PG8_STAGE(PG8_SA(0, 0), a2, voffA);
            PG8_BAR; PG8_WAIT_L(0); PG8_MMA(1, 0, At, B0); PG8_BAR; PG8_SCHED;
            PG8_STAGE(PG8_SB(0, 1), b2 + hstep, voffB);
            PG8_WAIT_V(6); PG8_BAR; PG8_MMA(1, 1, At, B1); PG8_BAR;
            PG8_LDB(B0, 1, 0); PG8_SCHED; PG8_LDA(At, 1, 0); PG8_STAGE(PG8_SA(0, 1), a2 + hstep, voffA);
            PG8_WAIT_L(8); PG8_BAR; PG8_WAIT_L(0); PG8_MMA(0, 0, At, B0); PG8_BAR; PG8_SCHED;
            PG8_LDB(B1, 1, 1); PG8_STAGE(PG8_SB(1, 0), b3, voffB);
            PG8_BAR; PG8_WAIT_L(0); PG8_MMA(0, 1, At, B1); PG8_BAR;
            PG8_LDA(At, 1, 1); PG8_STAGE(PG8_SA(1, 0), a3, voffA);
            PG8_BAR; PG8_WAIT_L(0); PG8_MMA(1, 0, At, B0); PG8_BAR; PG8_SCHED;
            PG8_STAGE(PG8_SB(1, 1), b3 + hstep, voffB);
            PG8_WAIT_V(6); PG8_BAR; PG8_MMA(1, 1, At, B1); PG8_BAR;
        }
        PG8_STAMP();
        if constexpr (!Epi::AFTER_DRAIN) { E(acc, cur, wr, wc, fr, fq); S.done(cur); }
        PG8_STAMP();
        if (!has_next) break;
#pragma unroll
        for (int a = 0; a < 2; ++a)
#pragma unroll
            for (int b = 0; b < 2; ++b)
#pragma unroll
                for (int m = 0; m < 4; ++m)
#pragma unroll
                    for (int n = 0; n < 2; ++n) acc[a][b][m][n] = (f32x4){0.f, 0.f, 0.f, 0.f};
        cur = nxt; cA = nA; cB = nB; ++ui;
    }
    PG8_WAIT_V(0);
    if (wr == 0) PG8_BAR;
    PG8_BAR;
    if constexpr (Epi::AFTER_DRAIN) { E.fused(acc, cur, wr, wc, fr, fq, lds, wid, lane); S.done(cur); }
    PG8_STAMP();
#undef PG8_STAMP
#undef PG8_SA
#undef PG8_SB
#undef PG8_STAGE
#undef PG8_LDA
#undef PG8_LDB
#undef PG8_MMA
#undef PG8_WAIT_V
#undef PG8_WAIT_L
#undef PG8_BAR
#undef PG8_SCHED
}
}

DEV void transpose_convert(const float* __restrict__ W, int K, int N, int Npad, bf16_t* Wt, float* sm) {
    float (*T)[65] = (float (*)[65])sm;
    const int tid = opaque_tid();
    const int kt = K / 64, ntl = Npad / 64;
    for (int tile = blockIdx.x; tile < kt * ntl; tile += gridDim.x) {
        const int k0 = (tile / ntl) * 64, n0 = (tile % ntl) * 64;
        __syncthreads();
#pragma unroll
        for (int i = 0; i < 2; ++i) {
            const int k = (tid >> 4) + 32 * i, n4 = (tid & 15) * 4;
            float4 v = make_float4(0.f, 0.f, 0.f, 0.f);
            if (n0 + n4 < N) v = ld4(W + (size_t)(k0 + k) * N + n0 + n4);
            T[k][n4] = v.x; T[k][n4 + 1] = v.y; T[k][n4 + 2] = v.z; T[k][n4 + 3] = v.w;
        }
        __syncthreads();
        const int n = tid >> 3, kq = (tid & 7) * 8;
        unsigned o[4];
#pragma unroll
        for (int j = 0; j < 4; ++j) o[j] = pack2bf(T[kq + 2 * j][n], T[kq + 2 * j + 1][n]);
        bf16_t* dst = Wt + (size_t)(n0 + n) * K + k0 + kq;
        *(uint4*)dst = make_uint4(o[0], o[1], o[2], o[3]);
    }
}

struct EpBf16 {
    static constexpr bool PERM = true, AFTER_DRAIN = false;
    bf16_t* O; int ldc; int ncols;
    DEV void operator()(const pg8::f32x4 (&acc)[2][2][4][2], const pg8::Unit& u, int wr, int wc, int fr, int fq) const {
        const int row0 = u.pm * 256 + wr * 64 + fr, col0 = u.pn * 256 + wc * 32 + 8 * fq;
#pragma unroll
        for (int ai = 0; ai < 2; ++ai)
#pragma unroll
            for (int m = 0; m < 4; ++m) {
                bf16_t* rowp = O + (size_t)(row0 + ai * 128 + m * 16) * ldc + col0;
#pragma unroll
                for (int bj = 0; bj < 2; ++bj) {
                    if (col0 + bj * 128 < ncols) {
                        const pg8::f32x4 v0 = acc[ai][bj][m][0], v1 = acc[ai][bj][m][1];
                        *(uint4*)(rowp + bj * 128) = make_uint4(pack2bf(v0[0], v0[1]), pack2bf(v0[2], v0[3]), pack2bf(v1[0], v1[1]), pack2bf(v1[2], v1[3]));
                    }
                }
            }
    }
};
struct EpRes0 {
    static constexpr bool PERM = false, AFTER_DRAIN = false;
    float* C; const float* mv; int b;
    DEV void operator()(const pg8::f32x4 (&acc)[2][2][4][2], const pg8::Unit& u, int wr, int wc, int fr, int fq) const {
        const bool isc = (u.pm * 256 < NCX);
        const float* gp = mv + (isc ? 2 : b) * 3072 + 2048;
        const int row0 = u.pm * 256 + wr * 64 + fr, col0 = u.pn * 256 + wc * 32 + 4 * fq;
#pragma unroll
        for (int ai = 0; ai < 2; ++ai)
#pragma unroll
            for (int m = 0; m < 4; ++m) {
                const size_t ro = (size_t)(row0 + ai * 128 + m * 16) * DM + col0;
#pragma unroll
                for (int bj = 0; bj < 2; ++bj)
#pragma unroll
                    for (int n = 0; n < 2; ++n) {
                        const int co = bj * 128 + n * 16;
                        const float4 g = ld4(gp + col0 + co); const pg8::f32x4 v = acc[ai][bj][m][n];
                        st4(C + ro + co, make_float4(g.x * v[0], g.y * v[1], g.z * v[2], g.w * v[3]));
                    }
            }
    }
};
struct EpRes1 {
    static constexpr bool PERM = false, AFTER_DRAIN = false;
    float* C; const float* mv;
    DEV void operator()(const pg8::f32x4 (&acc)[2][2][4][2], const pg8::Unit& u, int wr, int wc, int fr, int fq) const {
        const float* gp = mv + (u.pm * 256 >= NL ? 1 : 0) * 3072 + 2048;
        const int row0 = u.pm * 256 + wr * 64 + fr, col0 = u.pn * 256 + wc * 32 + 4 * fq;
#pragma unroll
        for (int ai = 0; ai < 2; ++ai)
#pragma unroll
            for (int m = 0; m < 4; ++m) {
                const size_t ro = (size_t)(row0 + ai * 128 + m * 16) * DM + col0;
#pragma unroll
                for (int bj = 0; bj < 2; ++bj)
#pragma unroll
                    for (int n = 0; n < 2; ++n) {
                        const int co = bj * 128 + n * 16;
                        const float4 g = ld4(gp + col0 + co); const pg8::f32x4 v = acc[ai][bj][m][n];
                        st4(C + ro + co, make_float4(g.x * v[0], g.y * v[1], g.z * v[2], g.w * v[3]));
                    }
            }
    }
};
template <class EP>
DEV void run_gemm(const bf16_t* A, const bf16_t* Bt, int M, int N, int K, const EP& ep, float* sm) {
    pg8::Gemm g{A, Bt, M, N, K}; pg8::StaticOrder S; S.init(M, N, (int)gridDim.x, (int)blockIdx.x);
    pg8::gemm_phase<EP, pg8::StaticOrder, false>((PG8_LAS unsigned char*)sm, g, S, ep, nullptr);
}

DEV void phase_h0(const Params& p, int b) {
    const float* modv = (const float*)(p.ws + OFF_MODV);
    bf16_t* H0 = (bf16_t*)(p.ws + OFF_YC);
    const int gt = blockIdx.x * NTHR + opaque_tid(), gn = gridDim.x * NTHR;
    for (int i = gt; i < TB * 128; i += gn) {
        const int s = i >> 7, k = (i & 127) * 8;
        const float* src; int j;
        if (s < NCX) { src = p.in[2] + ((size_t)(b * NCX + s)) * DM + k; j = 2; }
        else { src = p.in[0] + ((size_t)(b * NL + s - NCX)) * DM + k; j = b; }
        const float4 x0 = ld4(src), x1 = ld4(src + 4);
        const float* m = modv + j * 3072;
        const float4 s0 = ld4(m + k), s1 = ld4(m + k + 4), c0 = ld4(m + 1024 + k), c1 = ld4(m + 1024 + k + 4);
        *(uint4*)(H0 + (size_t)s * DM + k) = make_uint4(pack2bf(x0.x * (1.f + c0.x) + s0.x, x0.y * (1.f + c0.y) + s0.y), pack2bf(x0.z * (1.f + c0.z) + s0.z, x0.w * (1.f + c0.w) + s0.w),
                                                      pack2bf(x1.x * (1.f + c1.x) + s1.x, x1.y * (1.f + c1.y) + s1.y), pack2bf(x1.z * (1.f + c1.z) + s1.z, x1.w * (1.f + c1.w) + s1.w));
    }
}

DEV void phase_mod(const Params& p, float* sm) {
    const float* c = p.in[1]; const float* cctx = p.in[3];
    const float* mod_w = p.in[4]; const float* mod_b = p.in[5];
    float* modv = (float*)(p.ws + OFF_MODV);
    float* sil = sm; float* red = sm + 3072;
    const int tid = opaque_tid();
    for (int i = tid; i < 3072; i += NTHR) {
        const int j = i >> 10, k = i & 1023;
        const float v = (j < 2) ? c[j * 1024 + k] : cctx[k];
        sil[i] = silu_f(v);
    }
    __syncthreads();
    for (int unit = blockIdx.x; unit < 192; unit += gridDim.x) {
        const int l = unit / 96, cb = unit % 96;
        const int kg = tid >> 5, col = tid & 31, n = cb * 32 + col;
        const float* w = mod_w + (size_t)l * 1024 * 3072 + n;
        float a0 = 0.f, a1 = 0.f, a2 = 0.f;
        for (int k = kg * 64; k < kg * 64 + 64; ++k) {
            const float wv = w[(size_t)k * 3072];
            a0 += sil[k] * wv; a1 += sil[1024 + k] * wv; a2 += sil[2048 + k] * wv;
        }
        red[(kg * 3 + 0) * 32 + col] = a0; red[(kg * 3 + 1) * 32 + col] = a1; red[(kg * 3 + 2) * 32 + col] = a2;
        __syncthreads();
        if (tid < 96) {
            const int j = tid >> 5, cc = tid & 31, nn = cb * 32 + cc;
            float s = mod_b[l * 3072 + nn];
            for (int g = 0; g < 16; ++g) s += red[(g * 3 + j) * 32 + cc];
            modv[(l * 3 + j) * 3072 + nn] = s;
        }
        __syncthreads();
    }
}

DEV void phase_tables(const Params& p) {
    const float* wq = p.in[33]; const float* wk = p.in[34]; const float* wv = p.in[35];
    const float* gw0 = p.in[36]; const float* gw1 = p.in[38]; const float* gw2 = p.in[40]; const float* gw3 = p.in[42];
    float* gtab = (float*)(p.ws + OFF_GTAB); bf16_t* wft = (bf16_t*)(p.ws + OFF_WFT);
    const int gt = blockIdx.x * NTHR + opaque_tid(), gn = gridDim.x * NTHR;
    for (int i = gt; i < 512 * 16; i += gn) {
        const int gb = i >> 4, cp = (i >> 2) & 3, c = i & 3;
        float s = 0.f;
#pragma unroll
        for (int d = 0; d < 4; ++d) s += wq[gb * 16 + cp * 4 + d] * wk[gb * 16 + c * 4 + d];
        gtab[i] = s * KSCALE;
    }
    for (int i = gt; i < 4096 * 16; i += gn) {
        const int g = i >> 12, k = i & 4095, gm = g >> 2, hd = g & 3;
        const float* wg = gm == 0 ? gw0 : (gm == 1 ? gw1 : (gm == 2 ? gw2 : gw3));
        float s = 0.f;
        if (k < 2048) {
            const int blk = k >> 2, cc = k & 3;
#pragma unroll
            for (int d = 0; d < 4; ++d) s += wq[blk * 16 + cc * 4 + d] * wg[(size_t)(4 * blk + d) * 4 + hd] + wk[blk * 16 + cc * 4 + d] * wg[(size_t)(2048 + 4 * blk + d) * 4 + hd];
        } else {
            const int kk = k - 2048, blk = kk >> 2, cc = kk & 3;
#pragma unroll
            for (int d = 0; d < 4; ++d) s += wv[blk * 16 + cc * 4 + d] * wg[(size_t)(4096 + 4 * blk + d) * 4 + hd];
        }
        wft[i] = __builtin_bit_cast(unsigned short, (__bf16)s);
    }
}

DEV float wave_scan_add(float v, int lane, int dir) {
#pragma unroll
    for (int o = 1; o < 64; o <<= 1) {
        const float n = dir ? __shfl_down(v, o, 64) : __shfl_up(v, o, 64);
        const bool ok = dir ? (lane + o < 64) : (lane >= o);
        if (ok) v += n;
    }
    return v;
}
DEV float wave_scan_max(float v, int lane, int dir) {
#pragma unroll
    for (int o = 1; o < 64; o <<= 1) {
        const float n = dir ? __shfl_down(v, o, 64) : __shfl_up(v, o, 64);
        const bool ok = dir ? (lane + o < 64) : (lane >= o);
        if (ok) v = fmaxf(v, n);
    }
    return v;
}

DEV void gla_decay(const bf16_t* P0, int c, int h, int dir, const float* __restrict__ wa2, const float* __restrict__ ba,
                   float* sLR, float* sWA, float* sBC, float* sTot, int tid) {
    for (int i = tid; i < 1024; i += NTHR) { const int t = i >> 4, j = i & 15; sLR[i] = bf2f(P0[(size_t)(c * 64 + t) * EIN + 1536 + dir * 16 + j]); }
    for (int i = tid; i < 1024; i += NTHR) { const int ii = i >> 6, k = i & 63; sWA[i] = wa2[ii * 256 + h * 64 + k]; }
    __syncthreads();
    {
        const int t = tid >> 3, k0 = (tid & 7) * 8;
        float acc[8];
#pragma unroll
        for (int j = 0; j < 8; ++j) acc[j] = ba[h * 64 + k0 + j];
#pragma unroll
        for (int ii = 0; ii < 16; ++ii) {
            const float l = sLR[t * 16 + ii];
#pragma unroll
            for (int j = 0; j < 8; ++j) acc[j] += l * sWA[ii * 64 + k0 + j];
        }
#pragma unroll
        for (int j = 0; j < 8; ++j) sBC[t * 65 + k0 + j] = logsig_f(acc[j]) * 0.0625f;
    }
    __syncthreads();
    {
        const int lane = tid & 63, wv = tid >> 6;
#pragma unroll
        for (int j = 0; j < 8; ++j) {
            const int k = wv * 8 + j;
            const float v = wave_scan_add(sBC[lane * 65 + k], lane, dir);
            sBC[lane * 65 + k] = v;
            if (lane == (dir ? 0 : 63)) sTot[k] = v;
        }
    }
    __syncthreads();
}
DEV bf16x8 tr_frag(const bf16_t* base, int ld, int row0, int col0, int lane) {
    const bf16_t* ptr = base + (row0 + (lane >> 4) * 8 + ((lane & 15) >> 2)) * ld + col0 + (lane & 3) * 4;
    const s16x4 lo = __builtin_amdgcn_ds_read_tr16_b64_v4i16((__attribute__((address_space(3))) s16x4*)ptr);
    const s16x4 hi = __builtin_amdgcn_ds_read_tr16_b64_v4i16((__attribute__((address_space(3))) s16x4*)(ptr + 4 * ld));
    return (bf16x8){lo[0], lo[1], lo[2], lo[3], hi[0], hi[1], hi[2], hi[3]};
}
DEV bf16x8 row_frag(const bf16_t* base, int ld, int idx0, int k0, int lane) {
    return *(const bf16x8*)(base + (idx0 + (lane & 15)) * ld + k0 + (lane >> 4) * 8);
}

DEV void gla1_unit(const Params& p, int h, int dir, int c, float* sm) {
    const int tid = opaque_tid(), lane = tid & 63, wave = tid >> 6;
    const bf16_t* P0 = (const bf16_t*)(p.ws + OFF_P0);
    float* GDS = (float*)(p.ws + OFF_GDS); float* GDEC = (float*)(p.ws + OFF_GDEC);
    const float* wa2 = p.in[dir ? 12 : 10]; const float* ba = p.in[dir ? 13 : 11];
    float* sLR = sm; float* sWA = sm + 1024; float* sBC = sm + 2048; float* sTot = sm + 6208;
    bf16_t* kT = (bf16_t*)(sm + 6272);
    bf16_t* Vs = (bf16_t*)(sm + 8576);
    const int ch = h * 2 + dir;
    __syncthreads();
    gla_decay(P0, c, h, dir, wa2, ba, sLR, sWA, sBC, sTot, tid);
    {
        const int t = tid >> 3, k0 = (tid & 7) * 8;
        float kv[8]; unpack8(*(const uint4*)(P0 + (size_t)(c * 64 + t) * EIN + 256 + h * 64 + k0), kv);
#pragma unroll
        for (int j = 0; j < 8; ++j) kT[(k0 + j) * 72 + t] = __builtin_bit_cast(unsigned short, (__bf16)(kv[j] * fexp(sTot[k0 + j] - sBC[t * 65 + k0 + j])));
#pragma unroll
        for (int u = 0; u < 2; ++u) { const int i = tid + 512 * u, row = i >> 4, c16 = i & 15; *(uint4*)(Vs + row * 136 + c16 * 8) = *(const uint4*)(P0 + (size_t)(c * 64 + row) * EIN + 512 + h * 128 + c16 * 8); }
    }
    __syncthreads();
    {
        f32x4 acc[4];
#pragma unroll
        for (int kt = 0; kt < 4; ++kt) acc[kt] = (f32x4){0.f, 0.f, 0.f, 0.f};
#pragma unroll
        for (int ks = 0; ks < 2; ++ks) {
            const bf16x8 af = tr_frag(Vs, 136, ks * 32, wave * 16, lane);
#pragma unroll
            for (int kt = 0; kt < 4; ++kt) acc[kt] = __builtin_amdgcn_mfma_f32_16x16x32_bf16(af, row_frag(kT, 72, kt * 16, ks * 32, lane), acc[kt], 0, 0, 0);
        }
#pragma unroll
        for (int kt = 0; kt < 4; ++kt) {
            const int k = kt * 16 + (lane & 15), v = wave * 16 + (lane >> 4) * 4;
            st4(GDS + ((size_t)(ch * NCH + c) * 64 + k) * 128 + v, make_float4(acc[kt][0], acc[kt][1], acc[kt][2], acc[kt][3]));
        }
    }
    if (tid < 64) GDEC[(size_t)(ch * NCH + c) * 64 + tid] = fexp(sTot[tid]);
}

DEV void gla2_unit(const Params& p, int unit) {
    const int tid = opaque_tid();
    float* GDS = (float*)(p.ws + OFF_GDS); const float* GDEC = (const float*)(p.ws + OFF_GDEC);
    const int ch = unit >> 4, e = (unit & 15) * 512 + tid, k = e >> 7, dir = ch & 1;
    constexpr int GB = 12;
    float S = 0.f, ninc[GB], nd[GB];
#pragma unroll
    for (int j = 0; j < GB; ++j) { const int c = chunk_at(dir, j); ninc[j] = GDS[(size_t)(ch * NCH + c) * 8192 + e]; nd[j] = GDEC[(size_t)(ch * NCH + c) * 64 + k]; }
#pragma unroll 1
    for (int step0 = 0; step0 < NCH; step0 += GB) {
        float inc[GB], d[GB];
#pragma unroll
        for (int j = 0; j < GB; ++j) { inc[j] = ninc[j]; d[j] = nd[j]; }
#pragma unroll
        for (int j = 0; j < GB; ++j) { const int sn = step0 + GB + j, c = chunk_at(dir, sn < NCH ? sn : NCH - 1); ninc[j] = GDS[(size_t)(ch * NCH + c) * 8192 + e]; nd[j] = GDEC[(size_t)(ch * NCH + c) * 64 + k]; }
        __builtin_amdgcn_sched_barrier(0);
#pragma unroll
        for (int j = 0; j < GB; ++j) { const int c = chunk_at(dir, step0 + j); GDS[(size_t)(ch * NCH + c) * 8192 + e] = S; S = d[j] * S + inc[j]; }
    }
}

DEV void gla3_unit(const Params& p, int h, int c, float* sm) {
    const int tid = opaque_tid(), lane = tid & 63, wave = tid >> 6;
    const bf16_t* P0 = (const bf16_t*)(p.ws + OFF_P0);
    const float* GDS = (const float*)(p.ws + OFF_GDS);
    bf16_t* YC = (bf16_t*)(p.ws + OFF_YC);
    const float* ng = p.in[14];
    float* sLR = sm; float* sWA = sm + 1024; float* sBC = sm + 2048; float* sTot = sm + 6208;
    bf16_t* qt = (bf16_t*)(sm + 6272);
    bf16_t* kt = (bf16_t*)(sm + 8576);
    bf16_t* Sm = (bf16_t*)(sm + 10880);
    bf16_t* S0s = (bf16_t*)(sm + 13184);
    bf16_t* Vs = (bf16_t*)(sm + 17536);
    float* O = sm + 21888;
    const int ti = wave & 3, vt0 = (wave >> 2) * 4;
    f32x4 acc[4];
#pragma unroll
    for (int j = 0; j < 4; ++j) acc[j] = (f32x4){0.f, 0.f, 0.f, 0.f};
    __syncthreads();
#pragma unroll
    for (int u = 0; u < 2; ++u) { const int i = tid + 512 * u, row = i >> 4, c16 = i & 15; *(uint4*)(Vs + row * 136 + c16 * 8) = *(const uint4*)(P0 + (size_t)(c * 64 + row) * EIN + 512 + h * 128 + c16 * 8); }
#pragma unroll 1
    for (int dir = 0; dir < 2; ++dir) {
        const float* wa2 = p.in[dir ? 12 : 10]; const float* ba = p.in[dir ? 13 : 11];
        const int ch = h * 2 + dir;
        __syncthreads();
        gla_decay(P0, c, h, dir, wa2, ba, sLR, sWA, sBC, sTot, tid);
        {
            const int t = tid >> 3, k0 = (tid & 7) * 8;
            float qv[8], kv[8];
            unpack8(*(const uint4*)(P0 + (size_t)(c * 64 + t) * EIN + h * 64 + k0), qv);
            unpack8(*(const uint4*)(P0 + (size_t)(c * 64 + t) * EIN + 256 + h * 64 + k0), kv);
#pragma unroll
            for (int j = 0; j < 8; ++j) { const float bc = sBC[t * 65 + k0 + j]; qv[j] *= 0.125f * fexp(bc); kv[j] *= fexp(-bc); }
            *(uint4*)(qt + t * 72 + k0) = make_uint4(pack2bf(qv[0], qv[1]), pack2bf(qv[2], qv[3]), pack2bf(qv[4], qv[5]), pack2bf(qv[6], qv[7]));
            *(uint4*)(kt + t * 72 + k0) = make_uint4(pack2bf(kv[0], kv[1]), pack2bf(kv[2], kv[3]), pack2bf(kv[4], kv[5]), pack2bf(kv[6], kv[7]));
#pragma unroll
            for (int u = 0; u < 4; ++u) {
                const int i = tid + 512 * u, k = i >> 5, v4 = (i & 31) * 4;
                const float4 s4 = ld4(GDS + (size_t)(ch * NCH + c) * 8192 + k * 128 + v4);
                *(uint2*)(S0s + k * 136 + v4) = make_uint2(pack2bf(s4.x, s4.y), pack2bf(s4.z, s4.w));
            }
        }
        __syncthreads();
        {
            const int si = wave & 3;
#pragma unroll
            for (int jj = 0; jj < 2; ++jj) {
                const int t2 = (wave >> 2) * 2 + jj;
                f32x4 a = (f32x4){0.f, 0.f, 0.f, 0.f};
#pragma unroll
                for (int ks = 0; ks < 2; ++ks) a = __builtin_amdgcn_mfma_f32_16x16x32_bf16(row_frag(kt, 72, si * 16, ks * 32, lane), row_frag(qt, 72, t2 * 16, ks * 32, lane), a, 0, 0, 0);
                const int t = t2 * 16 + (lane & 15), s0 = si * 16 + (lane >> 4) * 4;
                float m[4];
#pragma unroll
                for (int r = 0; r < 4; ++r) { const bool keep = dir ? (s0 + r >= t) : (s0 + r <= t); m[r] = keep ? a[r] : 0.f; }
                *(uint2*)(Sm + t * 72 + s0) = make_uint2(pack2bf(m[0], m[1]), pack2bf(m[2], m[3]));
            }
        }
        __syncthreads();
#pragma unroll
        for (int ks = 0; ks < 2; ++ks) {
            const bf16x8 a1 = row_frag(qt, 72, ti * 16, ks * 32, lane), a2 = row_frag(Sm, 72, ti * 16, ks * 32, lane);
#pragma unroll
            for (int j = 0; j < 4; ++j) {
                acc[j] = __builtin_amdgcn_mfma_f32_16x16x32_bf16(a1, tr_frag(S0s, 136, ks * 32, (vt0 + j) * 16, lane), acc[j], 0, 0, 0);
                acc[j] = __builtin_amdgcn_mfma_f32_16x16x32_bf16(a2, tr_frag(Vs, 136, ks * 32, (vt0 + j) * 16, lane), acc[j], 0, 0, 0);
            }
        }
    }
#pragma unroll
    for (int j = 0; j < 4; ++j)
#pragma unroll
        for (int r = 0; r < 4; ++r) O[(ti * 16 + (lane >> 4) * 4 + r) * 132 + (vt0 + j) * 16 + (lane & 15)] = acc[j][r];
    __syncthreads();
    {
        const int t = tid >> 3, v0 = (tid & 7) * 16;
        float o[16];
        float ss = 0.f;
#pragma unroll
        for (int i = 0; i < 16; ++i) { o[i] = O[t * 132 + v0 + i]; ss += o[i] * o[i]; }
        ss += __shfl_xor(ss, 1, 64); ss += __shfl_xor(ss, 2, 64); ss += __shfl_xor(ss, 4, 64);
        const float rms = rsqrtf(ss * (1.f / 128.f) + 1e-5f);
        float g[16];
        const bf16_t* gp = P0 + (size_t)(c * 64 + t) * EIN + 1024 + h * 128 + v0;
        unpack8(*(const uint4*)gp, g); unpack8(*(const uint4*)(gp + 8), g + 8);
        float y[16];
#pragma unroll
        for (int i = 0; i < 16; ++i) y[i] = o[i] * rms * ng[v0 + i] * silu_f(g[i]);
        bf16_t* yp = YC + (size_t)(c * 64 + t) * 1024 + h * 128 + v0;
        *(uint4*)yp = make_uint4(pack2bf(y[0], y[1]), pack2bf(y[2], y[3]), pack2bf(y[4], y[5]), pack2bf(y[6], y[7]));
        *(uint4*)(yp + 8) = make_uint4(pack2bf(y[8], y[9]), pack2bf(y[10], y[11]), pack2bf(y[12], y[13]), pack2bf(y[14], y[15]));
    }
}

DEV void load8bf(const bf16_t* ptr, float* f) { unpack8(*(const uint4*)ptr, f); }
struct RwNb { int sL, sR, sU, sD; bool vL, vR, vU, vD; };
DEV RwNb rw_nb(int s) {
    RwNb q; q.vU = false; q.vD = false;
    if (s < NCX) { q.vL = s > 0; q.vR = s < NCX - 1; }
    else { const int n = s - NCX, rr = n >> 6, cc = n & 63; q.vL = cc > 0; q.vR = cc < 63; q.vU = rr > 0; q.vD = rr < 127; }
    q.sL = q.vL ? s - 1 : s; q.sR = q.vR ? s + 1 : s; q.sU = q.vU ? s - 64 : s; q.sD = q.vD ? s + 64 : s;
    return q;
}
struct RwRaw { uint4 o, l, r, u, d; };
DEV RwRaw rw_load(const bf16_t* P0, int s, const RwNb& q, int cb) {
    RwRaw w;
    w.o = *(const uint4*)(P0 + (size_t)s * EIN + RW0 + cb); w.l = *(const uint4*)(P0 + (size_t)q.sL * EIN + RW0 + cb); w.r = *(const uint4*)(P0 + (size_t)q.sR * EIN + RW0 + cb);
    w.u = *(const uint4*)(P0 + (size_t)q.sU * EIN + RW0 + cb); w.d = *(const uint4*)(P0 + (size_t)q.sD * EIN + RW0 + cb);
    return w;
}
DEV void rw_comb(const RwRaw& w, const RwNb& q, const float* __restrict__ mu, int cb, float* out) {
    float own[8]; unpack8(w.o, own);
    const float nb[8] = {q.vL ? bflo(w.l.x) : 0.f, q.vR ? bfhi(w.r.x) : 0.f, q.vU ? bflo(w.u.y) : 0.f, q.vD ? bfhi(w.d.y) : 0.f,
                         q.vL ? bflo(w.l.z) : 0.f, q.vR ? bfhi(w.r.z) : 0.f, q.vU ? bflo(w.u.w) : 0.f, q.vD ? bfhi(w.d.w) : 0.f};
    const float4 m0 = ld4(mu + cb), m1 = ld4(mu + cb + 4);
    const float m[8] = {m0.x, m0.y, m0.z, m0.w, m1.x, m1.y, m1.z, m1.w};
#pragma unroll
    for (int i = 0; i < 8; ++i) out[i] = own[i] + (nb[i] - own[i]) * m[i];
}
DEV uint4 pack8(const float* f) { return make_uint4(pack2bf(f[0], f[1]), pack2bf(f[2], f[3]), pack2bf(f[4], f[5]), pack2bf(f[6], f[7])); }

template <int XM, int YM, class F>
DEV void mm64(const bf16_t* X, const bf16_t* Y, F f, int lane, int wave) {
#pragma unroll
    for (int q = 0; q < 2; ++q) {
        const int idx = wave * 2 + q, ti = idx >> 2, tj = idx & 3;
        f32x4 acc = (f32x4){0.f, 0.f, 0.f, 0.f};
#pragma unroll
        for (int ks = 0; ks < 2; ++ks) {
            const bf16x8 a = XM == 0 ? row_frag(X, 72, ti * 16, ks * 32, lane) : tr_frag(X, 72, ks * 32, ti * 16, lane);
            const bf16x8 bq = YM == 0 ? row_frag(Y, 72, tj * 16, ks * 32, lane) : tr_frag(Y, 72, ks * 32, tj * 16, lane);
            acc = __builtin_amdgcn_mfma_f32_16x16x32_bf16(a, bq, acc, 0, 0, 0);
        }
        f(ti * 16 + (lane >> 4) * 4, tj * 16 + (lane & 15), acc);
    }
}
template <int XM, int YM, class F>
DEV void mm64x2(const bf16_t* X1, const bf16_t* Y1, const bf16_t* X2, const bf16_t* Y2, F f, int lane, int wave) {
#pragma unroll
    for (int q = 0; q < 2; ++q) {
        const int idx = wave * 2 + q, ti = idx >> 2, tj = idx & 3;
        f32x4 acc = (f32x4){0.f, 0.f, 0.f, 0.f};
#pragma unroll
        for (int ks = 0; ks < 2; ++ks) {
            const bf16x8 a = XM == 0 ? row_frag(X1, 72, ti * 16, ks * 32, lane) : tr_frag(X1, 72, ks * 32, ti * 16, lane);
            const bf16x8 bq = YM == 0 ? row_frag(Y1, 72, tj * 16, ks * 32, lane) : tr_frag(Y1, 72, ks * 32, tj * 16, lane);
            acc = __builtin_amdgcn_mfma_f32_16x16x32_bf16(a, bq, acc, 0, 0, 0);
            const bf16x8 a2 = XM == 0 ? row_frag(X2, 72, ti * 16, ks * 32, lane) : tr_frag(X2, 72, ks * 32, ti * 16, lane);
            const bf16x8 b2 = YM == 0 ? row_frag(Y2, 72, tj * 16, ks * 32, lane) : tr_frag(Y2, 72, ks * 32, tj * 16, lane);
            acc = __builtin_amdgcn_mfma_f32_16x16x32_bf16(a2, b2, acc, 0, 0, 0);
        }
        f(ti * 16 + (lane >> 4) * 4, tj * 16 + (lane & 15), acc);
    }
}
DEV void st_img(bf16_t* P, int i0, int j, float a0, float a1, float a2, float a3) {
    P[(i0 + 0) * 72 + j] = __builtin_bit_cast(unsigned short, (__bf16)a0); P[(i0 + 1) * 72 + j] = __builtin_bit_cast(unsigned short, (__bf16)a1);
    P[(i0 + 2) * 72 + j] = __builtin_bit_cast(unsigned short, (__bf16)a2); P[(i0 + 3) * 72 + j] = __builtin_bit_cast(unsigned short, (__bf16)a3);
}

DEV void rwkv1_unit(const Params& p, int h, int dir, int c, float* sm) {
    const int tid = opaque_tid(), lane = tid & 63, wave = tid >> 6;
    const bf16_t* P0 = (const bf16_t*)(p.ws + OFF_P0);
    bf16_t* RU = (bf16_t*)(p.ws + OFF_RU) + (size_t)((h * 2 + dir) * NCH + c) * 16384;
    float* BONS = (float*)(p.ws + OFF_BONS);
    const float* mu = p.in[15];
    const float* w0 = p.in[dir ? 18 : 16]; const float* ww2 = p.in[dir ? 19 : 17];
    const float* a0 = p.in[dir ? 22 : 20]; const float* wa2 = p.in[dir ? 23 : 21];
    bf16_t* img = (bf16_t*)sm;
#define SLOT(i_) (img + (i_) * 4608)
    float* fLW = (float*)SLOT(10);
    float* fAS = (float*)SLOT(12);
    float* sv = (float*)SLOT(14);
    const int t = tid >> 3, j0 = (tid & 7) * 8, s = c * 64 + t;
    __syncthreads();
    if (tid < 64) { const int hc = h * 64 + tid; sv[64 + tid] = w0[hc]; sv[128 + tid] = a0[hc]; sv[192 + tid] = p.in[24][hc]; sv[256 + tid] = p.in[25][hc]; sv[320 + tid] = p.in[26][hc]; }
    float r8[8], k8[8], v8[8];
    {
        float x8[8];
        const RwNb nbq = rw_nb(s);
        const RwRaw wr_ = rw_load(P0, s, nbq, h * 64 + j0), wk_ = rw_load(P0, s, nbq, 512 + h * 64 + j0), wv_ = rw_load(P0, s, nbq, 1024 + h * 64 + j0),
                    ww_ = rw_load(P0, s, nbq, 2048 + dir * 64 + j0), wa_ = rw_load(P0, s, nbq, 2176 + dir * 64 + j0);
        const float4 qw0 = ld4(ww2 + (size_t)t * 512 + h * 64 + j0), qw1 = ld4(ww2 + (size_t)t * 512 + h * 64 + j0 + 4);
        const float4 qa0 = ld4(wa2 + (size_t)t * 512 + h * 64 + j0), qa1 = ld4(wa2 + (size_t)t * 512 + h * 64 + j0 + 4);
        __builtin_amdgcn_sched_barrier(0);
        rw_comb(wr_, nbq, mu, h * 64 + j0, r8);
        rw_comb(wk_, nbq, mu, 512 + h * 64 + j0, k8);
        rw_comb(wv_, nbq, mu, 1024 + h * 64 + j0, v8);
        rw_comb(ww_, nbq, mu, 2048 + dir * 64 + j0, x8);
#pragma unroll
        for (int i = 0; i < 8; ++i) x8[i] = tanh_f(x8[i]);
        *(uint4*)(SLOT(6) + t * 72 + j0) = pack8(x8);
        rw_comb(wa_, nbq, mu, 2176 + dir * 64 + j0, x8);
        *(uint4*)(SLOT(7) + t * 72 + j0) = pack8(x8);
        { const float wq[8] = {qw0.x, qw0.y, qw0.z, qw0.w, qw1.x, qw1.y, qw1.z, qw1.w}; *(uint4*)(SLOT(8) + t * 72 + j0) = pack8(wq); }
        { const float wq[8] = {qa0.x, qa0.y, qa0.z, qa0.w, qa1.x, qa1.y, qa1.z, qa1.w}; *(uint4*)(SLOT(9) + t * 72 + j0) = pack8(wq); }
    }
    __syncthreads();
    mm64<0, 1>(SLOT(6), SLOT(8), [=](int i0, int j, f32x4 a) {
#pragma unroll
        for (int r = 0; r < 4; ++r) fLW[(i0 + r) * 65 + j] = -0.6065306597f * sigmoid_f(sv[64 + j] + a[r]); }, lane, wave);
    mm64<0, 1>(SLOT(7), SLOT(9), [=](int i0, int j, f32x4 a) {
#pragma unroll
        for (int r = 0; r < 4; ++r) fAS[(i0 + r) * 65 + j] = sigmoid_f(sv[128 + j] + a[r]); }, lane, wave);
    __syncthreads();
#pragma unroll
    for (int j = 0; j < 8; ++j) {
        const int k = wave * 8 + j;
        const float v = wave_scan_add(fLW[lane * 65 + k], lane, dir);
        fLW[lane * 65 + k] = v;
        if (lane == (dir ? 0 : 63)) sv[k] = v;
    }
    __syncthreads();
    {
        float kkv[8], ss = 0.f;
#pragma unroll
        for (int i = 0; i < 8; ++i) { kkv[i] = k8[i] * sv[192 + j0 + i]; ss += kkv[i] * kkv[i]; }
        ss += __shfl_xor(ss, 1, 64); ss += __shfl_xor(ss, 2, 64); ss += __shfl_xor(ss, 4, 64);
        const float rn = rsqrtf(fmaxf(ss, 1e-24f));
        float fa[8], fb[8], fk[8], fr[8], fbp[8], fkp[8], bon = 0.f;
        const int tp = dir ? t + 1 : t - 1;
        const bool hasp = dir ? (t < 63) : (t > 0);
#pragma unroll
        for (int i = 0; i < 8; ++i) {
            const int k = j0 + i;
            const float Bt = fLW[t * 65 + k], Bx = hasp ? fLW[tp * 65 + k] : 0.f, asg = fAS[t * 65 + k];
            const float kk = kkv[i] * rn, kh = k8[i] * (1.f + (asg - 1.f) * sv[256 + k]);
            bon += r8[i] * kh * sv[320 + k];
            const float enB = fexp(-Bt), eLB = fexp(sv[k] - Bt), bv = kk * asg;
            fa[i] = -kk * fexp(Bx); fb[i] = bv * enB; fk[i] = kh * enB; fr[i] = r8[i] * fexp(Bt); fbp[i] = bv * eLB; fkp[i] = kh * eLB;
        }
        bon += __shfl_xor(bon, 1, 64); bon += __shfl_xor(bon, 2, 64); bon += __shfl_xor(bon, 4, 64);
        if ((tid & 7) == 0) BONS[((size_t)dir * TB + s) * 8 + h] = bon;
        *(uint4*)(SLOT(0) + t * 72 + j0) = pack8(fa); *(uint4*)(SLOT(1) + t * 72 + j0) = pack8(fb); *(uint4*)(SLOT(2) + t * 72 + j0) = pack8(fk);
        *(uint4*)(SLOT(3) + t * 72 + j0) = pack8(fr); *(uint4*)(SLOT(4) + t * 72 + j0) = pack8(fbp); *(uint4*)(SLOT(5) + t * 72 + j0) = pack8(fkp);
    }
    __syncthreads();
    *(uint4*)(SLOT(6) + t * 72 + j0) = pack8(v8);
    __syncthreads();
    mm64<0, 0>(SLOT(0), SLOT(1), [=](int i0, int j, f32x4 a) {
        float m[4];
#pragma unroll
        for (int r = 0; r < 4; ++r) { const bool keep = dir ? (j > i0 + r) : (j < i0 + r); m[r] = keep ? a[r] : 0.f; }
        const bool dg = (i0 >> 4) == (j >> 4);
        st_img(SLOT(7), i0, j, dg ? m[0] : 0.f, dg ? m[1] : 0.f, dg ? m[2] : 0.f, dg ? m[3] : 0.f);
        st_img(SLOT(8), i0, j, (dg ? m[0] : 0.f) + (j == i0 ? 1.f : 0.f), (dg ? m[1] : 0.f) + (j == i0 + 1 ? 1.f : 0.f), (dg ? m[2] : 0.f) + (j == i0 + 2 ? 1.f : 0.f), (dg ? m[3] : 0.f) + (j == i0 + 3 ? 1.f : 0.f));
        st_img(SLOT(12), i0, j, dg ? 0.f : m[0], dg ? 0.f : m[1], dg ? 0.f : m[2], dg ? 0.f : m[3]); }, lane, wave);
    mm64<0, 0>(SLOT(0), SLOT(2), [=](int i0, int j, f32x4 a) {
        float m[4];
#pragma unroll
        for (int r = 0; r < 4; ++r) { const bool keep = dir ? (j > i0 + r) : (j < i0 + r); m[r] = keep ? a[r] : 0.f; }
        st_img(SLOT(9), i0, j, m[0], m[1], m[2], m[3]); }, lane, wave);
    mm64<0, 0>(SLOT(3), SLOT(1), [=](int i0, int j, f32x4 a) {
        float m[4];
#pragma unroll
        for (int r = 0; r < 4; ++r) { const bool keep = dir ? (j >= i0 + r) : (j <= i0 + r); m[r] = keep ? a[r] : 0.f; }
        st_img(SLOT(10), i0, j, m[0], m[1], m[2], m[3]); }, lane, wave);
    mm64<0, 0>(SLOT(3), SLOT(2), [=](int i0, int j, f32x4 a) {
        float m[4];
#pragma unroll
        for (int r = 0; r < 4; ++r) { const bool keep = dir ? (j >= i0 + r) : (j <= i0 + r); m[r] = keep ? a[r] : 0.f; }
        st_img(SLOT(11), i0, j, m[0], m[1], m[2], m[3]); }, lane, wave);
    __syncthreads();
    {
        bf16_t* Pc = SLOT(7); bf16_t* Pn = SLOT(1); bf16_t* Tc = SLOT(8); bf16_t* Tn = SLOT(2);
#pragma unroll 1
        for (int it = 0; it < 3; ++it) {
            mm64<0, 1>(Pc, Pc, [=](int i0, int j, f32x4 a) { st_img(Pn, i0, j, a[0], a[1], a[2], a[3]); }, lane, wave);
            __syncthreads();
            mm64<0, 1>(Tc, Pn, [=](int i0, int j, f32x4 a) {
                st_img(Tn, i0, j, a[0] + bf2f(Tc[(i0 + 0) * 72 + j]), a[1] + bf2f(Tc[(i0 + 1) * 72 + j]), a[2] + bf2f(Tc[(i0 + 2) * 72 + j]), a[3] + bf2f(Tc[(i0 + 3) * 72 + j])); }, lane, wave);
            __syncthreads();
            bf16_t* tmp = Pc; Pc = Pn; Pn = tmp; tmp = Tc; Tc = Tn; Tn = tmp;
        }
    }
    mm64<0, 1>(SLOT(2), SLOT(12), [=](int i0, int j, f32x4 a) { st_img(SLOT(7), i0, j, a[0], a[1], a[2], a[3]); }, lane, wave);
    mm64<0, 1>(SLOT(2), SLOT(0), [=](int i0, int j, f32x4 a) { st_img(SLOT(1), i0, j, a[0], a[1], a[2], a[3]); }, lane, wave);
    mm64<0, 1>(SLOT(9), SLOT(6), [=](int i0, int j, f32x4 a) { st_img(SLOT(13), i0, j, a[0], a[1], a[2], a[3]); }, lane, wave);
    __syncthreads();
    mm64<0, 1>(SLOT(2), SLOT(13), [=](int i0, int j, f32x4 a) { st_img(SLOT(8), i0, j, a[0], a[1], a[2], a[3]); }, lane, wave);
    __syncthreads();
    {
        const bf16_t* Zp = (wave < 4) ? SLOT(1) : SLOT(8);
        bf16_t* Xi = (wave < 4) ? SLOT(12) : SLOT(9);
        const int ct = (wave & 3) * 16, g4 = (lane >> 4) * 4, l15 = lane & 15;
#pragma unroll
        for (int bs = 0; bs < 4; ++bs) {
            const int bi = dir ? 3 - bs : bs;
            f32x4 acc;
#pragma unroll
            for (int r = 0; r < 4; ++r) acc[r] = bf2f(Zp[(bi * 16 + g4 + r) * 72 + ct + l15]);
            const bool k0 = dir ? (bi == 0) : (bi >= 1), k1 = dir ? (bi <= 2) : (bi == 3);
            if (k0) acc = __builtin_amdgcn_mfma_f32_16x16x32_bf16(row_frag(SLOT(7), 72, bi * 16, 0, lane), tr_frag(Xi, 72, 0, ct, lane), acc, 0, 0, 0);
            if (k1) acc = __builtin_amdgcn_mfma_f32_16x16x32_bf16(row_frag(SLOT(7), 72, bi * 16, 32, lane), tr_frag(Xi, 72, 32, ct, lane), acc, 0, 0, 0);
            st_img(Xi, bi * 16 + g4, ct + l15, acc[0], acc[1], acc[2], acc[3]);
            __syncthreads();
        }
    }
    mm64<1, 1>(SLOT(12), SLOT(4), [=](int i0, int j, f32x4 a) {
        float m[4];
#pragma unroll
        for (int r = 0; r < 4; ++r) m[r] = a[r] + ((i0 + r) == j ? fexp(sv[j]) : 0.f);
        *(uint2*)(RU + j * 64 + i0) = make_uint2(pack2bf(m[0], m[1]), pack2bf(m[2], m[3])); }, lane, wave);
    mm64x2<1, 1>(SLOT(4), SLOT(9), SLOT(5), SLOT(6), [=](int i0, int j, f32x4 a) {
        *(uint2*)(RU + 4096 + j * 64 + i0) = make_uint2(pack2bf(a[0], a[1]), pack2bf(a[2], a[3])); }, lane, wave);
    mm64<1, 0>(SLOT(12), SLOT(10), [=](int i0, int j, f32x4 a) {
        const uint2 rr = *(const uint2*)(SLOT(3) + j * 72 + i0);
        *(uint2*)(RU + 8192 + j * 64 + i0) = make_uint2(pack2bf(a[0] + bflo(rr.x), a[1] + bfhi(rr.x)), pack2bf(a[2] + bflo(rr.y), a[3] + bfhi(rr.y))); }, lane, wave);
    mm64x2<0, 1>(SLOT(10), SLOT(9), SLOT(11), SLOT(6), [=](int i0, int j, f32x4 a) {
        *(uint2*)(RU + 12288 + j * 64 + i0) = make_uint2(pack2bf(a[0], a[1]), pack2bf(a[2], a[3])); }, lane, wave);
#undef SLOT
}

#define R2_LOAD(M_, C_, rnd_) do { const int r0_ = ((rnd_) < R2_NR ? (rnd_) : R2_NR - 1) * R2_RS; \
    _Pragma("unroll") for (int s_ = 0; s_ < R2_RS; ++s_) M_[s_] = *(const uint4*)(RU + (size_t)(chain * NCH + chunk_at(dir, r0_ + s_)) * 16384 + tid * 8); \
    _Pragma("unroll") for (int j_ = 0; j_ < 3; ++j_) { const int cq_ = tid + 512 * j_; \
        C_[j_] = *(const uint4*)(RU + (size_t)(chain * NCH + chunk_at(dir, r0_ + (cq_ >> 7))) * 16384 + 4096 + (vblk * 16 + ((cq_ >> 3) & 15)) * 64 + (cq_ & 7) * 8); } } while (0)
#define R2_ROUND(M_, C_, rnd_) do { \
    { const int row_ = tid >> 3, c8_ = tid & 7, sw_ = (row_ >> 1) & 7, u0_ = (c8_ >> 2) * 4 + (c8_ & 1) * 2, eh_ = ((c8_ >> 1) & 1) * 8; \
      _Pragma("unroll") for (int s_ = 0; s_ < R2_RS; ++s_) { char* sl_ = ring + s_ * 10240 + row_ * 128 + eh_; \
          *(uint2*)(sl_ + ((u0_ ^ sw_) * 16)) = make_uint2(M_[s_].x, M_[s_].y); *(uint2*)(sl_ + (((u0_ + 1) ^ sw_) * 16)) = make_uint2(M_[s_].z, M_[s_].w); } \
      _Pragma("unroll") for (int j_ = 0; j_ < 3; ++j_) { const int cq_ = tid + 512 * j_, rw_ = (cq_ >> 3) & 15, q8_ = cq_ & 7, i_ = q8_ >> 1, g0_ = (q8_ & 1) * 2, sc_ = (rw_ >> 1) & 7; \
          char* sl_ = ring + (cq_ >> 7) * 10240 + 8192 + rw_ * 128 + (i_ & 1) * 8; \
          *(uint2*)(sl_ + (((g0_ * 2 + (i_ >> 1)) ^ sc_) * 16)) = make_uint2(C_[j_].x, C_[j_].y); *(uint2*)(sl_ + ((((g0_ + 1) * 2 + (i_ >> 1)) ^ sc_) * 16)) = make_uint2(C_[j_].z, C_[j_].w); } } \
    R2_LOAD(M_, C_, (rnd_) + 2); \
    __syncthreads(); \
    if (wave == 0) { \
        _Pragma("unroll 4") for (int s_ = 0; s_ < R2_RS; ++s_) { \
            const int c_ = chunk_at(dir, (rnd_) * R2_RS + s_); const char* sl_ = ring + s_ * 10240; \
            unsigned pk_[4][2]; \
            _Pragma("unroll") for (int i_ = 0; i_ < 4; ++i_) { pk_[i_][0] = pack2bf(st[i_][0], st[i_][1]); pk_[i_][1] = pack2bf(st[i_][2], st[i_][3]); } \
            bf16_t* sp_ = S0G + ((size_t)(chain * NCH + c_) * 64 + vblk * 16 + l15) * 64 + g * 4; \
            _Pragma("unroll") for (int i_ = 0; i_ < 4; ++i_) *(uint2*)(sp_ + i_ * 16) = make_uint2(pk_[i_][0], pk_[i_][1]); \
            bf16x8 bfr_[2]; \
            _Pragma("unroll") for (int ks_ = 0; ks_ < 2; ++ks_) { const uint4 u_ = make_uint4(pk_[2 * ks_][0], pk_[2 * ks_][1], pk_[2 * ks_ + 1][0], pk_[2 * ks_ + 1][1]); bfr_[ks_] = __builtin_bit_cast(bf16x8, u_); } \
            const uint4 c01_ = *(const uint4*)(sl_ + 8192 + l15 * 128 + (((g * 2) ^ ((l15 >> 1) & 7)) * 16)), c23_ = *(const uint4*)(sl_ + 8192 + l15 * 128 + (((g * 2 + 1) ^ ((l15 >> 1) & 7)) * 16)); \
            const unsigned cw_[8] = {c01_.x, c01_.y, c01_.z, c01_.w, c23_.x, c23_.y, c23_.z, c23_.w}; \
            _Pragma("unroll") for (int i_ = 0; i_ < 4; ++i_) { \
                f32x4 acc_ = (f32x4){bflo(cw_[2 * i_]), bfhi(cw_[2 * i_]), bflo(cw_[2 * i_ + 1]), bfhi(cw_[2 * i_ + 1])}; \
                _Pragma("unroll") for (int ks_ = 0; ks_ < 2; ++ks_) { \
                    const int row_ = i_ * 16 + l15; \
                    const bf16x8 af_ = *(const bf16x8*)(sl_ + row_ * 128 + (((ks_ * 4 + g) ^ ((row_ >> 1) & 7)) * 16)); \
                    acc_ = __builtin_amdgcn_mfma_f32_16x16x32_bf16(af_, bfr_[ks_], acc_, 0, 0, 0); } \
                st[i_] = acc_; } } } \
    __syncthreads(); } while (0)
DEV void rwkv2_unit(const Params& p, int chain, int vblk, float* sm) {
    constexpr int R2_RS = 12, R2_NR = NCH / R2_RS;
    static_assert(R2_NR * R2_RS == NCH && R2_RS * 10240 <= LDS_BYTES, "R2 ring");
    const int tid = opaque_tid(), lane = tid & 63, wave = tid >> 6;
    const bf16_t* RU = (const bf16_t*)(p.ws + OFF_RU);
    bf16_t* S0G = (bf16_t*)(p.ws + OFF_RS0);
    char* ring = (char*)sm;
    const int dir = chain & 1, g = lane >> 4, l15 = lane & 15;
    f32x4 st[4];
#pragma unroll
    for (int i = 0; i < 4; ++i) st[i] = (f32x4){0.f, 0.f, 0.f, 0.f};
    uint4 ma[R2_RS], ca[3], mb[R2_RS], cb[3];
    __syncthreads();
    R2_LOAD(ma, ca, 0); R2_LOAD(mb, cb, 1);
#pragma unroll 1
    for (int rnd = 0; rnd < R2_NR; rnd += 2) {
        R2_ROUND(ma, ca, rnd);
        if (rnd + 1 < R2_NR) R2_ROUND(mb, cb, rnd + 1);
    }
}
#undef R2_LOAD
#undef R2_ROUND

DEV void rwkv3_unit(const Params& p, int h, int c, float* sm) {
    const int tid = opaque_tid(), lane = tid & 63, wave = tid >> 6;
    const bf16_t* P0 = (const bf16_t*)(p.ws + OFF_P0);
    const bf16_t* RUb = (const bf16_t*)(p.ws + OFF_RU);
    const bf16_t* S0G = (const bf16_t*)(p.ws + OFF_RS0);
    const float* BONS = (const float*)(p.ws + OFF_BONS);
    bf16_t* YC = (bf16_t*)(p.ws + OFF_YC);
    const float* mu = p.in[15]; const float* gn_g = p.in[27]; const float* gn_b = p.in[28];
    bf16_t* img = (bf16_t*)sm;
    float* O = sm + 4 * 2304;
    const int t = tid >> 3, v0 = (tid & 7) * 8, s = c * 64 + t;
    const size_t u0 = (size_t)((h * 2 + 0) * NCH + c), u1 = (size_t)((h * 2 + 1) * NCH + c);
    const uint4 gr0 = *(const uint4*)(RUb + u0 * 16384 + 8192 + t * 64 + v0), gs0 = *(const uint4*)(S0G + u0 * 4096 + t * 64 + v0);
    const uint4 gr1 = *(const uint4*)(RUb + u1 * 16384 + 8192 + t * 64 + v0), gs1 = *(const uint4*)(S0G + u1 * 4096 + t * 64 + v0);
    uint2 yl[2][2];
#pragma unroll
    for (int q = 0; q < 2; ++q) { const int idx = wave * 2 + q, ti = idx >> 2, tj = idx & 3;
        yl[q][0] = *(const uint2*)(RUb + u0 * 16384 + 12288 + (tj * 16 + (lane & 15)) * 64 + ti * 16 + (lane >> 4) * 4);
        yl[q][1] = *(const uint2*)(RUb + u1 * 16384 + 12288 + (tj * 16 + (lane & 15)) * 64 + ti * 16 + (lane >> 4) * 4); }
    const RwNb nbq = rw_nb(s);
    const RwRaw wv_ = rw_load(P0, s, nbq, 1024 + h * 64 + v0), wg_ = rw_load(P0, s, nbq, 1536 + h * 64 + v0);
    const float bon = BONS[(size_t)s * 8 + h] + BONS[((size_t)TB + s) * 8 + h];
    __syncthreads();
    *(uint4*)(img + 0 * 4608 + t * 72 + v0) = gr0; *(uint4*)(img + 2 * 4608 + t * 72 + v0) = gs0;
    *(uint4*)(img + 1 * 4608 + t * 72 + v0) = gr1; *(uint4*)(img + 3 * 4608 + t * 72 + v0) = gs1;
    __syncthreads();
#pragma unroll
    for (int q = 0; q < 2; ++q) {
        const int idx = wave * 2 + q, ti = idx >> 2, tj = idx & 3;
        f32x4 accd[2];
#pragma unroll
        for (int dir = 0; dir < 2; ++dir) {
            f32x4 acc = (f32x4){bflo(yl[q][dir].x), bfhi(yl[q][dir].x), bflo(yl[q][dir].y), bfhi(yl[q][dir].y)};
#pragma unroll
            for (int ks = 0; ks < 2; ++ks) acc = __builtin_amdgcn_mfma_f32_16x16x32_bf16(row_frag(img + dir * 4608, 72, ti * 16, ks * 32, lane), row_frag(img + (2 + dir) * 4608, 72, tj * 16, ks * 32, lane), acc, 0, 0, 0);
            accd[dir] = acc;
        }
#pragma unroll
        for (int r = 0; r < 4; ++r) {
            const int oi = (ti * 16 + (lane >> 4) * 4 + r) * 68 + tj * 16 + (lane & 15);
            O[oi] = accd[0][r] + accd[1][r];
        }
    }
    __syncthreads();
    {
        float y[8], sum = 0.f;
#pragma unroll
        for (int i = 0; i < 8; ++i) { y[i] = O[t * 68 + v0 + i]; sum += y[i]; }
        sum += __shfl_xor(sum, 1, 64); sum += __shfl_xor(sum, 2, 64); sum += __shfl_xor(sum, 4, 64);
        const float mean = sum * (1.f / 64.f);
        float sq = 0.f;
#pragma unroll
        for (int i = 0; i < 8; ++i) { y[i] -= mean; sq += y[i] * y[i]; }
        sq += __shfl_xor(sq, 1, 64); sq += __shfl_xor(sq, 2, 64); sq += __shfl_xor(sq, 4, 64);
        const float rstd = rsqrtf(sq * (1.f / 64.f) + 64e-5f);
        float vm[8], gm[8];
        rw_comb(wv_, nbq, mu, 1024 + h * 64 + v0, vm);
        rw_comb(wg_, nbq, mu, 1536 + h * 64 + v0, gm);
        float o[8];
#pragma unroll
        for (int i = 0; i < 8; ++i) o[i] = (y[i] * rstd * gn_g[h * 64 + v0 + i] + gn_b[h * 64 + v0 + i] + bon * vm[i]) * silu_f(gm[i]);
        *(uint4*)(YC + (size_t)s * 1024 + 512 + h * 64 + v0) = pack8(o);
    }
}

DEV void ln_rows(const float* src, const float* res_lat, const float* res_cx, int nrows, const float* __restrict__ g, const float* __restrict__ bt, float* dst_lat, float* dst_cx, int ncx,
                 bf16_t* hb = nullptr, const float* mvc = nullptr, const float* mvl = nullptr) {
    const int tid_ = opaque_tid(); const int lane = tid_ & 63, gw = blockIdx.x * NWV + (tid_ >> 6), ngw = gridDim.x * NWV;
    for (int r = gw; r < nrows; r += ngw) {
        const float* x = src + (size_t)r * 1024;
        float4 v[4];
        float sum = 0.f;
        const float* xr = (r < ncx) ? (res_cx + (size_t)r * 1024) : (res_lat + (size_t)(r - ncx) * 1024);
#pragma unroll
        for (int i = 0; i < 4; ++i) { const float4 a = ld4(x + i * 256 + lane * 4), rr = ld4(xr + i * 256 + lane * 4);
            v[i] = make_float4(ALPHA * rr.x + a.x, ALPHA * rr.y + a.y, ALPHA * rr.z + a.z, ALPHA * rr.w + a.w); sum += v[i].x + v[i].y + v[i].z + v[i].w; }
        const float mean = wave_sum(sum) * (1.f / 1024.f);
        float sq = 0.f;
#pragma unroll
        for (int i = 0; i < 4; ++i) {
            v[i].x -= mean; v[i].y -= mean; v[i].z -= mean; v[i].w -= mean;
            sq += v[i].x * v[i].x + v[i].y * v[i].y + v[i].z * v[i].z + v[i].w * v[i].w;
        }
        const float rstd = rsqrtf(wave_sum(sq) * (1.f / 1024.f) + 1e-5f);
        float* d = (r < ncx) ? (dst_cx + (size_t)r * 1024) : (dst_lat + (size_t)(r - ncx) * 1024);
#pragma unroll
        for (int i = 0; i < 4; ++i) {
            const int c = i * 256 + lane * 4;
            const float4 gg = ld4(g + c), bb = ld4(bt + c);
            const float4 y = make_float4(v[i].x * rstd * gg.x + bb.x, v[i].y * rstd * gg.y + bb.y, v[i].z * rstd * gg.z + bb.z, v[i].w * rstd * gg.w + bb.w);
            st4(d + c, y);
            if (hb != nullptr) {
                const float* m = (r < ncx) ? mvc : mvl;
                const float4 sh = ld4(m + c), sc = ld4(m + 1024 + c);
                *(uint2*)(hb + (size_t)r * 1024 + c) = make_uint2(pack2bf(y.x * (1.f + sc.x) + sh.x, y.y * (1.f + sc.y) + sh.y), pack2bf(y.z * (1.f + sc.z) + sh.z, y.w * (1.f + sc.w) + sh.w));
            }
        }
    }
}
DEV void phase_h1l(const Params& p) {
    const float* modv1 = (const float*)(p.ws + OFF_MODV) + 3 * 3072;
    bf16_t* H1 = (bf16_t*)(p.ws + OFF_H1B);
    const size_t gt = (size_t)blockIdx.x * NTHR + opaque_tid(), gn = (size_t)gridDim.x * NTHR;
    for (size_t i = gt; i < (size_t)NB * NL * 128; i += gn) {
        const size_t r = i >> 7; const int k = (int)(i & 127) * 8;
        const float* m = modv1 + (r >= (size_t)NL ? 1 : 0) * 3072;
        const float4 x0 = ld4(p.out + r * DM + k), x1 = ld4(p.out + r * DM + k + 4);
        const float4 s0 = ld4(m + k), s1 = ld4(m + k + 4), c0 = ld4(m + 1024 + k), c1 = ld4(m + 1024 + k + 4);
        *(uint4*)(H1 + r * DM + k) = make_uint4(pack2bf(x0.x * (1.f + c0.x) + s0.x, x0.y * (1.f + c0.y) + s0.y), pack2bf(x0.z * (1.f + c0.z) + s0.z, x0.w * (1.f + c0.w) + s0.w),
                                                pack2bf(x1.x * (1.f + c1.x) + s1.x, x1.y * (1.f + c1.y) + s1.y), pack2bf(x1.z * (1.f + c1.z) + s1.z, x1.w * (1.f + c1.w) + s1.w));
    }
}

DEV void zero_f4(float* ptr, size_t nfloat) {
    const size_t n4 = nfloat / 4;
    for (size_t i = (size_t)blockIdx.x * NTHR + opaque_tid(); i < n4; i += (size_t)gridDim.x * NTHR) ((float4*)ptr)[i] = make_float4(0.f, 0.f, 0.f, 0.f);
}

DEV void chain_ids(int& chain, int& sub) {
    const int bid = blockIdx.x, xcd = bid & 7, idx = bid >> 3;
    chain = xcd * 2 + (idx >> 4); sub = idx & 15;
}

DEV void phase_conv1(const Params& p, float* sm) {
    const bf16_t* XM = (const bf16_t*)(p.ws + OFF_XM);
    bf16_t* XC = (bf16_t*)(p.ws + OFF_XC);
    float* G16P = (float*)(p.ws + OFF_G16P);
    const bf16_t* WFT = (const bf16_t*)(p.ws + OFF_WFT);
    const float* cw = p.in[31]; const float* cbias = p.in[32];
    bf16_t* imgC = (bf16_t*)sm;
    bf16_t* imgM = imgC + 64 * 264;
    float* red = (float*)(imgM + 64 * 264);
    float* cwl = red + 1024;
    const int tid = opaque_tid(), lane = tid & 63, wave = tid >> 6, t = tid >> 3, cg = tid & 7;
    for (int u = blockIdx.x; u < NB * NCH * 4; u += gridDim.x) {
        const int ci = u >> 2, q = u & 3, b = ci / NCH, c = ci % NCH, s = c * 64 + t;
        const size_t rowbase = (size_t)b * TB;
        int nrow[9];
#pragma unroll
        for (int i = 0; i < 3; ++i)
#pragma unroll
            for (int j = 0; j < 3; ++j) {
                int ns = -1;
                if (s < NCX) { const int w2 = s + j - 1; if (i == 1 && w2 >= 0 && w2 < NCX) ns = w2; }
                else { const int n = s - NCX, rr = (n >> 6) + i - 1, w2 = (n & 63) + j - 1; if (rr >= 0 && rr < 128 && w2 >= 0 && w2 < 64) ns = NCX + rr * 64 + w2; }
                nrow[i * 3 + j] = ns;
            }
        const int tt = wave & 3, part = wave >> 2;
        f32x4 acc = (f32x4){0.f, 0.f, 0.f, 0.f};
#pragma unroll 1
        for (int half = 0; half < 2; ++half) {
            __syncthreads();
            for (int i = tid; i < 640; i += NTHR) { const int tp = i >> 6, c4 = (i & 63) * 4; st4(cwl + tp * 256 + c4, ld4((tp < 9 ? cw + tp * 2048 : cbias) + q * 512 + half * 256 + c4)); }
            __syncthreads();
#pragma unroll 2
            for (int it = 0; it < 4; ++it) {
                const int cl = it * 64 + cg * 8, c0 = q * 512 + half * 256 + cl;
                float a8[8];
                { const float4 b0 = ld4(cwl + 9 * 256 + cl), b1 = ld4(cwl + 9 * 256 + cl + 4); a8[0] = b0.x; a8[1] = b0.y; a8[2] = b0.z; a8[3] = b0.w; a8[4] = b1.x; a8[5] = b1.y; a8[6] = b1.z; a8[7] = b1.w; }
                uint4 xmc = make_uint4(0u, 0u, 0u, 0u);
#pragma unroll
                for (int tap = 0; tap < 9; ++tap) {
                    if (nrow[tap] >= 0) {
                        const uint4 xv = *(const uint4*)(XM + (rowbase + nrow[tap]) * 2048 + c0);
                        float x8[8]; unpack8(xv, x8);
                        const float4 w0 = ld4(cwl + tap * 256 + cl), w1 = ld4(cwl + tap * 256 + cl + 4);
                        a8[0] += x8[0] * w0.x; a8[1] += x8[1] * w0.y; a8[2] += x8[2] * w0.z; a8[3] += x8[3] * w0.w;
                        a8[4] += x8[4] * w1.x; a8[5] += x8[5] * w1.y; a8[6] += x8[6] * w1.z; a8[7] += x8[7] * w1.w;
                        if (tap == 4) xmc = xv;
                    }
                }
#pragma unroll
                for (int i = 0; i < 8; ++i) a8[i] = silu_f(a8[i]);
                const uint4 xcv = pack8(a8);
                *(uint4*)(XC + (rowbase + s) * 2048 + c0) = xcv;
                *(uint4*)(imgC + t * 264 + cl) = xcv;
                *(uint4*)(imgM + t * 264 + cl) = xmc;
            }
            __syncthreads();
            {
                const bf16_t* img = part ? imgM : imgC;
                const bf16_t* wrow = WFT + (size_t)(lane & 15) * 4096 + part * 2048 + q * 512 + half * 256 + (lane >> 4) * 8;
#pragma unroll
                for (int ks = 0; ks < 8; ++ks) acc = __builtin_amdgcn_mfma_f32_16x16x32_bf16(row_frag(img, 264, tt * 16, ks * 32, lane), *(const bf16x8*)(wrow + ks * 32), acc, 0, 0, 0);
            }
        }
        if (part == 1) {
#pragma unroll
            for (int r = 0; r < 4; ++r) red[(tt * 16 + (lane >> 4) * 4 + r) * 16 + (lane & 15)] = acc[r];
        }
        __syncthreads();
        if (part == 0) {
#pragma unroll
            for (int r = 0; r < 4; ++r) {
                const int tk = tt * 16 + (lane >> 4) * 4 + r;
                G16P[((size_t)q * RT + rowbase + c * 64 + tk) * 16 + (lane & 15)] = acc[r] + red[tk * 16 + (lane & 15)];
            }
        }
    }
}

DEV void gate_pair(const Params& p, size_t row, int dir, int h, float& gi, float& lf) {
    const float* G16P = (const float*)(p.ws + OFF_G16P);
    float a = 0.f, f = 0.f;
#pragma unroll
    for (int q = 0; q < 4; ++q) { a += G16P[((size_t)q * RT + row) * 16 + dir * 8 + h]; f += G16P[((size_t)q * RT + row) * 16 + dir * 8 + 4 + h]; }
    gi = a + p.in[dir ? 41 : 37][h];
    lf = logsig_f(f + p.in[dir ? 43 : 39][h]);
}

DEV void phase_x1(const Params& p, float* sm) {
    int chain, sub; chain_ids(chain, sub);
    const int b = chain >> 3, h = (chain >> 1) & 3, dir = chain & 1;
    const bf16_t* XC = (const bf16_t*)(p.ws + OFF_XC);
    float* GSC = (float*)(p.ws + OFF_GSC); float* CSC = (float*)(p.ws + OFF_CSC); float* NBUF = (float*)(p.ws + OFF_NBUF);
    const float* gtab = (const float*)(p.ws + OFF_GTAB);
    bf16_t* SMAT = (bf16_t*)(p.ws + OFF_SMAT);
    const int tid = opaque_tid(), lane = tid & 63, wave = tid >> 6;
    float* sTot = sm; float* sRef = sm + 132; float* sM0 = sm + 264; float* sBeta = sm + 400;
    for (int c = wave; c < NCH; c += NWV) {
        const size_t row = (size_t)b * TB + c * 64 + lane;
        float gi, lf; gate_pair(p, row, dir, h, gi, lf);
        const float bc = wave_scan_add(lf, lane, dir);
        const float ref = wave_max(gi - bc), tot = wave_sum(lf);
        if (lane == 0) { sTot[c] = tot; sRef[c] = ref; }
    }
    __syncthreads();
    if (tid == 0) {
        float m0 = -INFINITY;
        for (int step = 0; step < NCH; ++step) {
            const int c = chunk_at(dir, step);
            sM0[c] = m0;
            const float mx = fmaxf(m0, sRef[c]);
            if (sub == 0) { CSC[(chain * NCH + c) * 2] = fexp(m0 - mx); CSC[(chain * NCH + c) * 2 + 1] = fexp(sRef[c] - mx); }
            m0 = sTot[c] + mx;
        }
    }
    __syncthreads();
    for (int k = wave; sub + 16 * k < NCH; k += NWV) {
        const int c = sub + 16 * k;
        const size_t row = (size_t)b * TB + c * 64 + lane;
        float gi, lf; gate_pair(p, row, dir, h, gi, lf);
        const float bc = wave_scan_add(lf, lane, dir);
        const float a = gi - bc;
        const float amax = wave_scan_max(a, lane, dir);
        const float ref = sRef[c], m0 = sM0[c];
        const float mmax = fmaxf(amax, m0);
        const float mt = bc + mmax;
        const float alpha = fexp(ref - mmax), beta = fexp(a - ref), gg = fexp(m0 - mmax), em = fexp(-mt);
        st4(GSC + ((size_t)chain * TB + c * 64 + lane) * 4, make_float4(alpha, beta, gg, em));
        sBeta[k * 64 + lane] = beta;
    }
    __syncthreads();
    {
        float* part = sm + 1024;
        const int sg = tid >> 6, j8 = (tid & 63) * 8;
        for (int k = 0; sub + 16 * k < NCH; ++k) {
            const int c = sub + 16 * k;
            const bf16_t* xp = XC + ((size_t)b * TB + c * 64 + sg * 8) * 2048 + h * 512 + j8;
            float acc[8];
#pragma unroll
            for (int i = 0; i < 8; ++i) acc[i] = 0.f;
#pragma unroll
            for (int s = 0; s < 8; ++s) {
                float f[8]; unpack8(*(const uint4*)(xp + (size_t)s * 2048), f);
                const float be = sBeta[k * 64 + sg * 8 + s];
#pragma unroll
                for (int i = 0; i < 8; ++i) acc[i] += be * f[i];
            }
            __syncthreads();
            st4(part + sg * 512 + j8, make_float4(acc[0], acc[1], acc[2], acc[3])); st4(part + sg * 512 + j8 + 4, make_float4(acc[4], acc[5], acc[6], acc[7]));
            __syncthreads();
            float tot = 0.f;
#pragma unroll
            for (int q = 0; q < 8; ++q) tot += part[q * 512 + tid];
            NBUF[((size_t)chain * NCH + c) * 512 + tid] = tot;
        }
    }
    bf16_t* XCs = (bf16_t*)sm;
    bf16_t* Qs = XCs + 64 * 520;
    for (int u = blockIdx.x; u < NB * 4 * NCH; u += gridDim.x) {
        const int bh = u / NCH, c = u % NCH, ub = bh >> 2, uh = bh & 3;
        __syncthreads();
#pragma unroll 2
        for (int i = 0; i < 8; ++i) {
            const int pp = tid + 512 * i, row = pp >> 6, c16 = pp & 63;
            const uint4 xv = *(const uint4*)(XC + ((size_t)ub * TB + c * 64 + row) * 2048 + uh * 512 + c16 * 8);
            float f[8]; unpack8(xv, f);
            float q[8];
#pragma unroll
            for (int bb = 0; bb < 2; ++bb) {
                const float* G = gtab + (size_t)(uh * 128 + c16 * 2 + bb) * 16;
                const float4 g0 = ld4(G), g1 = ld4(G + 4), g2 = ld4(G + 8), g3 = ld4(G + 12);
                q[bb * 4 + 0] = f[bb * 4] * g0.x + f[bb * 4 + 1] * g1.x + f[bb * 4 + 2] * g2.x + f[bb * 4 + 3] * g3.x;
                q[bb * 4 + 1] = f[bb * 4] * g0.y + f[bb * 4 + 1] * g1.y + f[bb * 4 + 2] * g2.y + f[bb * 4 + 3] * g3.y;
                q[bb * 4 + 2] = f[bb * 4] * g0.z + f[bb * 4 + 1] * g1.z + f[bb * 4 + 2] * g2.z + f[bb * 4 + 3] * g3.z;
                q[bb * 4 + 3] = f[bb * 4] * g0.w + f[bb * 4 + 1] * g1.w + f[bb * 4 + 2] * g2.w + f[bb * 4 + 3] * g3.w;
            }
            *(uint4*)(XCs + row * 520 + c16 * 8) = xv;
            *(uint4*)(Qs + row * 520 + c16 * 8) = make_uint4(pack2bf(q[0], q[1]), pack2bf(q[2], q[3]), pack2bf(q[4], q[5]), pack2bf(q[6], q[7]));
        }
        __syncthreads();
        const int st = wave & 3, tt0 = (wave >> 2) * 2;
        f32x4 a0 = (f32x4){0.f, 0.f, 0.f, 0.f}, a1 = a0;
        const bf16_t* ap = XCs + (st * 16 + (lane & 15)) * 520 + (lane >> 4) * 8;
        const bf16_t* bp0 = Qs + (tt0 * 16 + (lane & 15)) * 520 + (lane >> 4) * 8;
        const bf16_t* bp1 = bp0 + 16 * 520;
#pragma unroll
        for (int ks = 0; ks < 16; ++ks) {
            const bf16x8 af = *(const bf16x8*)(ap + ks * 32);
            a0 = __builtin_amdgcn_mfma_f32_16x16x32_bf16(af, *(const bf16x8*)(bp0 + ks * 32), a0, 0, 0, 0);
            a1 = __builtin_amdgcn_mfma_f32_16x16x32_bf16(af, *(const bf16x8*)(bp1 + ks * 32), a1, 0, 0, 0);
        }
        bf16_t* sp = SMAT + (size_t)u * 4096 + (size_t)(tt0 * 16 + (lane & 15)) * 64 + st * 16 + (lane >> 4) * 4;
        *(uint2*)sp = make_uint2(pack2bf(a0[0], a0[1]), pack2bf(a0[2], a0[3]));
        *(uint2*)(sp + 16 * 64) = make_uint2(pack2bf(a1[0], a1[1]), pack2bf(a1[2], a1[3]));
    }
}

DEV void phase_x2(const Params& p, float* sm) {
    int chain, sub; chain_ids(chain, sub);
    const int b = chain >> 3, h = (chain >> 1) & 3, dir = chain & 1;
    const bf16_t* XC = (const bf16_t*)(p.ws + OFF_XC);
    float* GSC = (float*)(p.ws + OFF_GSC); const float* CSC = (const float*)(p.ws + OFF_CSC); const float* NBUF = (const float*)(p.ws + OFF_NBUF);
    const float* gtab = (const float*)(p.ws + OFF_GTAB);
    const bf16_t* SMAT = (const bf16_t*)(p.ws + OFF_SMAT);
    const int tid = opaque_tid();
    float* sD0 = sm; float* sCf = sm + 132; float* sN0 = sm + 264; float* sN2 = sN0 + 9 * 512;
    for (int i = tid; i < NCH; i += NTHR) { sD0[i] = CSC[(chain * NCH + i) * 2]; sCf[i] = CSC[(chain * NCH + i) * 2 + 1]; }
    __syncthreads();
    {
        float n = 0.f;
        const float* nb = NBUF + (size_t)chain * NCH * 512 + tid;
#pragma unroll 4
        for (int step = 0; step < NCH; ++step) {
            const int c = chunk_at(dir, step);
            if ((c & 15) == sub) sN0[(c >> 4) * 512 + tid] = n;
            n = sD0[c] * n + sCf[c] * nb[(size_t)c * 512];
        }
    }
    __syncthreads();
    {
        const int blk = tid >> 2, cp = tid & 3;
        const float4 g = ld4(gtab + (size_t)(h * 128 + blk) * 16 + cp * 4);
        for (int k = 0; sub + 16 * k < NCH; ++k) {
            const float* n0 = sN0 + k * 512 + blk * 4;
            sN2[k * 512 + tid] = g.x * n0[0] + g.y * n0[1] + g.z * n0[2] + g.w * n0[3];
        }
    }
    __syncthreads();
    const int t = tid >> 3, part = tid & 7;
    for (int k = 0; sub + 16 * k < NCH; ++k) {
        const int c = sub + 16 * k;
        const size_t row = (size_t)b * TB + c * 64 + t;
        float dint = 0.f;
        {
            const bf16_t* xp = XC + row * 2048 + h * 512 + part * 64;
            const float* n2 = sN2 + k * 512 + part * 64;
#pragma unroll
            for (int i = 0; i < 8; ++i) {
                float f[8]; unpack8(*(const uint4*)(xp + i * 8), f);
                const float4 na = ld4(n2 + i * 8), nb2 = ld4(n2 + i * 8 + 4);
                dint += f[0] * na.x + f[1] * na.y + f[2] * na.z + f[3] * na.w + f[4] * nb2.x + f[5] * nb2.y + f[6] * nb2.z + f[7] * nb2.w;
            }
        }
        float di = 0.f;
        {
            float f[8]; unpack8(*(const uint4*)(SMAT + ((size_t)((b * 4 + h) * NCH + c)) * 4096 + t * 64 + part * 8), f);
#pragma unroll
            for (int e = 0; e < 8; ++e) {
                const int s = part * 8 + e;
                const float beta = GSC[((size_t)chain * TB + c * 64 + s) * 4 + 1];
                const bool keep = dir ? (s >= t) : (s <= t);
                di += keep ? f[e] * beta : 0.f;
            }
        }
        dint += __shfl_xor(dint, 1, 64); dint += __shfl_xor(dint, 2, 64); dint += __shfl_xor(dint, 4, 64);
        di += __shfl_xor(di, 1, 64); di += __shfl_xor(di, 2, 64); di += __shfl_xor(di, 4, 64);
        if (part == 0) {
            float* gp = GSC + ((size_t)chain * TB + c * 64 + t) * 4;
            const float4 g4 = ld4(gp);
            const float den = g4.x * di + g4.z * dint;
            gp[3] = 1.f / fmaxf(fabsf(den), g4.w);
        }
    }
}

#define MLSTM_PREFETCH(step_) do { \
    const int c_ = chunk_at(dir, (step_)); const size_t rb_ = (size_t)b * TB + (size_t)c_ * 64; \
    { const bf16_t* xb_ = XC + (rb_ + (tid >> 6)) * 2048 + h * 512 + (tid & 63) * 8; \
      rx0 = *(const uint4*)(xb_); rx1 = *(const uint4*)(xb_ + 8 * 2048); rx2 = *(const uint4*)(xb_ + 16 * 2048); rx3 = *(const uint4*)(xb_ + 24 * 2048); \
      rx4 = *(const uint4*)(xb_ + 32 * 2048); rx5 = *(const uint4*)(xb_ + 40 * 2048); rx6 = *(const uint4*)(xb_ + 48 * 2048); rx7 = *(const uint4*)(xb_ + 56 * 2048); } \
    rxm = *(const uint2*)(XM + (rb_ + ps) * 2048 + ch0 + pvb * 4); \
    rs = *(const uint4*)(SMAT + ((size_t)((b * 4 + h) * NCH + c_)) * 4096 + ps * 64 + pvb * 8); \
    rbeta = GSC[((size_t)chain * TB + c_ * 64 + ps) * 4 + 1]; \
    if (tid < 64) rsc = ld4(GSC + ((size_t)chain * TB + c_ * 64 + tid) * 4); \
    rd0 = CSC[(chain * NCH + c_) * 2]; rcf = CSC[(chain * NCH + c_) * 2 + 1]; } while (0)

DEV void phase_mlstm(const Params& p, float* sm) {
    int chain, sub; chain_ids(chain, sub);
    const int b = chain >> 3, h = (chain >> 1) & 3, dir = chain & 1;
    const bf16_t* XM = (const bf16_t*)(p.ws + OFF_XM);
    const bf16_t* XC = (const bf16_t*)(p.ws + OFF_XC);
    const bf16_t* SMAT = (const bf16_t*)(p.ws + OFF_SMAT);
    const float* GSC = (const float*)(p.ws + OFF_GSC); const float* CSC = (const float*)(p.ws + OFF_CSC);
    const float* gtab = (const float*)(p.ws + OFF_GTAB);
    bf16_t* H = (bf16_t*)(p.ws + OFF_H);
    const float* wv = p.in[35];
    char* smc = (char*)sm;
    bf16_t* XCs = (bf16_t*)smc;
    bf16_t* Cs = (bf16_t*)(smc + 66560);
    bf16_t* Vb = (bf16_t*)(smc + 66560 + 33280);
    bf16_t* Vw = Vb + 32 * 72;
    bf16_t* Sm = Vw + 32 * 72;
    float* Gs = (float*)(smc + 66560 + 33280 + 2 * 4608 + 9216);
    float* sc = Gs + 2048;
    const int tid = opaque_tid(), lane = tid & 63, wave = tid >> 6;
    for (int i = tid; i < 32 * 520 / 2; i += NTHR) ((unsigned*)Cs)[i] = 0u;
    for (int i = tid; i < 2048; i += NTHR) Gs[i] = gtab[h * 2048 + i];
    const int ps = tid >> 3, pvb = tid & 7;
    const int ch0 = h * 512 + sub * 32;
    float wvr[16];
#pragma unroll
    for (int i = 0; i < 16; ++i) wvr[i] = wv[(size_t)((ch0 >> 2) + pvb) * 16 + i];
    f32x4 accS[4][2];
#pragma unroll
    for (int i = 0; i < 4; ++i) { accS[i][0] = (f32x4){0.f, 0.f, 0.f, 0.f}; accS[i][1] = (f32x4){0.f, 0.f, 0.f, 0.f}; }
    uint4 rx0, rx1, rx2, rx3, rx4, rx5, rx6, rx7; uint2 rxm; uint4 rs; float rbeta; float4 rsc = make_float4(0.f, 0.f, 0.f, 0.f); float rd0, rcf;
    MLSTM_PREFETCH(0);
    __syncthreads();
#pragma unroll 1
    for (int step = 0; step < NCH; ++step) {
        const int c = chunk_at(dir, step);
        const float d0 = rd0, cf = rcf;
        {
            bf16_t* xd = XCs + (tid >> 6) * 520 + (tid & 63) * 8;
            *(uint4*)(xd) = rx0; *(uint4*)(xd + 8 * 520) = rx1; *(uint4*)(xd + 16 * 520) = rx2; *(uint4*)(xd + 24 * 520) = rx3;
            *(uint4*)(xd + 32 * 520) = rx4; *(uint4*)(xd + 40 * 520) = rx5; *(uint4*)(xd + 48 * 520) = rx6; *(uint4*)(xd + 56 * 520) = rx7;
        }
        {
            const float x0 = bflo(rxm.x), x1 = bfhi(rxm.x), x2 = bflo(rxm.y), x3 = bfhi(rxm.y);
#pragma unroll
            for (int d = 0; d < 4; ++d) {
                const float v = (x0 * wvr[d] + x1 * wvr[4 + d] + x2 * wvr[8 + d] + x3 * wvr[12 + d]) * rbeta;
                Vb[(pvb * 4 + d) * 72 + ps] = __builtin_bit_cast(unsigned short, (__bf16)v);
                Vw[(pvb * 4 + d) * 72 + ps] = __builtin_bit_cast(unsigned short, (__bf16)(v * cf));
            }
        }
        {
#define SMASK(q_) (((dir ? (pvb * 8 + 2 * (q_) >= ps) : (pvb * 8 + 2 * (q_) <= ps)) ? 0x0000ffffu : 0u) | ((dir ? (pvb * 8 + 2 * (q_) + 1 >= ps) : (pvb * 8 + 2 * (q_) + 1 <= ps)) ? 0xffff0000u : 0u))
            *(uint4*)(Sm + ps * 72 + pvb * 8) = make_uint4(rs.x & SMASK(0), rs.y & SMASK(1), rs.z & SMASK(2), rs.w & SMASK(3));
#undef SMASK
        }
        if (tid < 64) st4(sc + tid * 4, rsc);
        { const int nstep = (step + 1 < NCH) ? step + 1 : step; MLSTM_PREFETCH(nstep); }
        __syncthreads();
        {
            const int vt = wave & 1, tt = wave >> 1;
            f32x4 ao = (f32x4){0.f, 0.f, 0.f, 0.f}, ai = ao, ao1 = ao, ao2 = ao, ao3 = ao;
            const bf16_t* ap = Cs + (vt * 16 + (lane & 15)) * 520 + (lane >> 4) * 8;
            const bf16_t* bp = XCs + (tt * 16 + (lane & 15)) * 520 + (lane >> 4) * 8;
#pragma unroll
            for (int ks = 0; ks < 16; ks += 4) {
                ao = __builtin_amdgcn_mfma_f32_16x16x32_bf16(*(const bf16x8*)(ap + ks * 32), *(const bf16x8*)(bp + ks * 32), ao, 0, 0, 0);
                ao1 = __builtin_amdgcn_mfma_f32_16x16x32_bf16(*(const bf16x8*)(ap + (ks + 1) * 32), *(const bf16x8*)(bp + (ks + 1) * 32), ao1, 0, 0, 0);
                ao2 = __builtin_amdgcn_mfma_f32_16x16x32_bf16(*(const bf16x8*)(ap + (ks + 2) * 32), *(const bf16x8*)(bp + (ks + 2) * 32), ao2, 0, 0, 0);
                ao3 = __builtin_amdgcn_mfma_f32_16x16x32_bf16(*(const bf16x8*)(ap + (ks + 3) * 32), *(const bf16x8*)(bp + (ks + 3) * 32), ao3, 0, 0, 0);
            }
            ao = (ao + ao1) + (ao2 + ao3);
            const bf16_t* ap2 = Vb + (vt * 16 + (lane & 15)) * 72 + (lane >> 4) * 8;
            const bf16_t* bp2 = Sm + (tt * 16 + (lane & 15)) * 72 + (lane >> 4) * 8;
#pragma unroll
            for (int ks = 0; ks < 2; ++ks) ai = __builtin_amdgcn_mfma_f32_16x16x32_bf16(*(const bf16x8*)(ap2 + ks * 32), *(const bf16x8*)(bp2 + ks * 32), ai, 0, 0, 0);
            if (c >= 4) {
                const int t = tt * 16 + (lane & 15);
                const float4 s4 = ld4(sc + t * 4);
                const float h0 = (s4.x * ai[0] + s4.z * ao[0]) * s4.w, h1 = (s4.x * ai[1] + s4.z * ao[1]) * s4.w;
                const float h2 = (s4.x * ai[2] + s4.z * ao[2]) * s4.w, h3 = (s4.x * ai[3] + s4.z * ao[3]) * s4.w;
                bf16_t* hp = H + ((size_t)b * NL + (size_t)c * 64 + t - NCX) * 2048 + ch0 + vt * 16 + (lane >> 4) * 4;
                const unsigned u0 = pack2bf(h0, h1), u1 = pack2bf(h2, h3);
                __builtin_amdgcn_global_atomic_fadd_v2bf16((__attribute__((address_space(1))) s16x2*)hp, __builtin_bit_cast(s16x2, u0));
                __builtin_amdgcn_global_atomic_fadd_v2bf16((__attribute__((address_space(1))) s16x2*)(hp + 2), __builtin_bit_cast(s16x2, u1));
            }
        }
#pragma unroll
        for (int jt = 0; jt < 4; ++jt) { accS[jt][0] *= d0; accS[jt][1] *= d0; }
#pragma unroll
        for (int ks = 0; ks < 2; ++ks) {
            const bf16x8 b0 = *(const bf16x8*)(Vw + (lane & 15) * 72 + ks * 32 + (lane >> 4) * 8);
            const bf16x8 b1 = *(const bf16x8*)(Vw + (16 + (lane & 15)) * 72 + ks * 32 + (lane >> 4) * 8);
            const int row0 = ks * 32 + (lane >> 4) * 8 + ((lane & 15) >> 2);
#pragma unroll
            for (int jt = 0; jt < 4; ++jt) {
                const int col = wave * 64 + jt * 16 + (lane & 3) * 4;
                const s16x4 lo = __builtin_amdgcn_ds_read_tr16_b64_v4i16((__attribute__((address_space(3))) s16x4*)(XCs + row0 * 520 + col));
                const s16x4 hi = __builtin_amdgcn_ds_read_tr16_b64_v4i16((__attribute__((address_space(3))) s16x4*)(XCs + (row0 + 4) * 520 + col));
                const bf16x8 af = (bf16x8){lo[0], lo[1], lo[2], lo[3], hi[0], hi[1], hi[2], hi[3]};
                accS[jt][0] = __builtin_amdgcn_mfma_f32_16x16x32_bf16(af, b0, accS[jt][0], 0, 0, 0);
                accS[jt][1] = __builtin_amdgcn_mfma_f32_16x16x32_bf16(af, b1, accS[jt][1], 0, 0, 0);
            }
        }
        __syncthreads();
#pragma unroll
        for (int jt = 0; jt < 4; ++jt) {
            const int blk = wave * 16 + jt * 4 + (lane >> 4);
            const float4 g0 = ld4(Gs + blk * 16), g1 = ld4(Gs + blk * 16 + 4), g2 = ld4(Gs + blk * 16 + 8), g3 = ld4(Gs + blk * 16 + 12);
#pragma unroll
            for (int v2 = 0; v2 < 2; ++v2) {
                const f32x4 a = accS[jt][v2];
                const float o0 = g0.x * a[0] + g0.y * a[1] + g0.z * a[2] + g0.w * a[3];
                const float o1 = g1.x * a[0] + g1.y * a[1] + g1.z * a[2] + g1.w * a[3];
                const float o2 = g2.x * a[0] + g2.y * a[1] + g2.z * a[2] + g2.w * a[3];
                const float o3 = g3.x * a[0] + g3.y * a[1] + g3.z * a[2] + g3.w * a[3];
                *(uint2*)(Cs + (v2 * 16 + (lane & 15)) * 520 + blk * 4) = make_uint2(pack2bf(o0, o1), pack2bf(o2, o3));
            }
        }
    }
}

DEV void phase_finish1(const Params& p) {
    bf16_t* H = (bf16_t*)(p.ws + OFF_H);
    const bf16_t* XC = (const bf16_t*)(p.ws + OFF_XC);
    const bf16_t* Z = (const bf16_t*)(p.ws + OFF_XM);
    const float* ng = p.in[44]; const float* skip = p.in[45];
    const int tid_ = opaque_tid(); const int lane = tid_ & 63, gw = blockIdx.x * NWV + (tid_ >> 6), ngw = gridDim.x * NWV;
    for (int it = gw; it < NB * NL * 4; it += ngw) {
        const int r = it >> 2, h = it & 3, b = r >= NL ? 1 : 0, nn = r - b * NL;
        const int c0 = h * 512 + lane * 8;
        bf16_t* hp = H + (size_t)r * 2048 + c0;
        float v[8]; unpack8(*(const uint4*)hp, v);
        float sum = 0.f;
#pragma unroll
        for (int j = 0; j < 8; ++j) sum += v[j];
        const float mean = wave_sum(sum) * (1.f / 512.f);
        float sq = 0.f;
#pragma unroll
        for (int j = 0; j < 8; ++j) { v[j] -= mean; sq += v[j] * v[j]; }
        const float rstd = rsqrtf(wave_sum(sq) * (1.f / 512.f) + 1e-5f);
        float xc[8], z[8];
        unpack8(*(const uint4*)(XC + ((size_t)b * TB + NCX + nn) * 2048 + c0), xc);
        unpack8(*(const uint4*)(Z + (size_t)r * 2048 + c0), z);
        float o[8];
#pragma unroll
        for (int j = 0; j < 8; ++j) o[j] = (v[j] * rstd * ng[c0 + j] + skip[c0 + j] * xc[j]) * silu_f(z[j]);
        *(uint4*)hp = make_uint4(pack2bf(o[0], o[1]), pack2bf(o[2], o[3]), pack2bf(o[4], o[5]), pack2bf(o[6], o[7]));
    }
}

__global__ void __launch_bounds__(NTHR) fwd_kernel(Params p) {
    extern __shared__ __attribute__((aligned(16))) float sm[];
    volatile LAS unsigned* xst = (volatile LAS unsigned*)((LAS char*)sm + (LDS_BYTES - 16));
    if (threadIdx.x == 0) { xst[0] = 0u; xst[1] = 0u; }
    __syncthreads();
    const XcdBarrier xbar = xcd_barrier_post((unsigned*)(p.ws + OFF_BAR), xst);
    const int tid = opaque_tid(), lane = tid & 63, wave = tid >> 6;
    float* modv = (float*)(p.ws + OFF_MODV);
    float* X1C = (float*)(p.ws + OFF_X1C);

    phase_mod(p, sm);
    phase_tables(p);
    transpose_convert(p.in[8], 1024, EIN, 4096, (bf16_t*)(p.ws + OFF_WT0), sm);
    transpose_convert(p.in[29], 1024, 4096, 4096, (bf16_t*)(p.ws + OFF_WT1), sm);
    transpose_convert(p.in[9], 1024, 1024, 1024, (bf16_t*)(p.ws + OFF_WT2), sm);
    transpose_convert(p.in[30], 2048, 1024, 1024, (bf16_t*)(p.ws + OFF_WT3), sm);
    xcd_barrier(xbar);

#pragma unroll 1
    for (int b = 0; b < NB; ++b) {
        if (b == 0) { phase_h0(p, 0); xcd_barrier(xbar); }
        run_gemm((const bf16_t*)(p.ws + OFF_YC), (const bf16_t*)(p.ws + OFF_WT0), TB, 4096, DM, EpBf16{(bf16_t*)(p.ws + OFF_P0), EIN, EIN}, sm);
        xcd_barrier(xbar);
        for (int q = blockIdx.x >> 3; q < 3 * NCH; q += 32) {
            const int x = blockIdx.x & 7;
            if (q < 2 * NCH) rwkv1_unit(p, x, q & 1, q >> 1, sm);
            else { const int q2 = q - 2 * NCH; gla1_unit(p, x >> 1, q2 & 1, (NCH / 2) * (x & 1) + (q2 >> 1), sm); }
        }
        xcd_barrier(xbar);
        if (blockIdx.x < 128) gla2_unit(p, blockIdx.x);
        else if (blockIdx.x < 192) rwkv2_unit(p, (blockIdx.x - 128) >> 2, (blockIdx.x - 128) & 3, sm);
        xcd_barrier(xbar);
        for (int q = blockIdx.x >> 3; q < NCH + NCH / 2; q += 32) {
            const int x = blockIdx.x & 7;
            if (q < NCH) rwkv3_unit(p, x, q, sm);
            else gla3_unit(p, x >> 1, (NCH / 2) * (x & 1) + (q - NCH), sm);
        }
        xcd_barrier(xbar);
        run_gemm((const bf16_t*)(p.ws + OFF_YC), (const bf16_t*)(p.ws + OFF_WT2), TB, DM, DM, EpRes0{(float*)(p.ws + OFF_P0), modv, b}, sm);
        xcd_barrier(xbar);
        ln_rows((const float*)(p.ws + OFF_P0), p.in[0] + (size_t)b * NL * DM, p.in[2] + (size_t)b * NCX * DM, TB, p.in[6], p.in[7], p.out + (size_t)b * NL * DM, X1C + (size_t)b * NCX * DM, NCX,
                (bf16_t*)(p.ws + OFF_H1B) + (size_t)b * TB * DM, modv + (3 + 2) * 3072, modv + (3 + b) * 3072);
        if (b == 0) phase_h0(p, 1);
        xcd_barrier(xbar);
    }

    run_gemm((const bf16_t*)(p.ws + OFF_H1B), (const bf16_t*)(p.ws + OFF_WT1), RT, 2048, DM, EpBf16{(bf16_t*)(p.ws + OFF_XM), 2048, 2048}, sm);
    zero_f4((float*)(p.ws + OFF_H), (size_t)NB * NL * 1024);
    xcd_barrier(xbar);
    phase_conv1(p, sm);
    xcd_barrier(xbar);
    phase_x1(p, sm);
    xcd_barrier(xbar);
    phase_x2(p, sm);
    xcd_barrier(xbar);
    phase_mlstm(p, sm);
    xcd_barrier(xbar);
    phase_h1l(p);
    xcd_barrier(xbar);
    run_gemm((const bf16_t*)(p.ws + OFF_H1B), (const bf16_t*)(p.ws + OFF_WT1) + (size_t)2048 * 1024, NB * NL, 2048, DM, EpBf16{(bf16_t*)(p.ws + OFF_XM), 2048, 2048}, sm);
    xcd_barrier(xbar);
    phase_finish1(p);
    xcd_barrier(xbar);
    run_gemm((const bf16_t*)(p.ws + OFF_H), (const bf16_t*)(p.ws + OFF_WT3), NB * NL, DM, 2048, EpRes1{(float*)(p.ws + OFF_XC), modv + 3 * 3072}, sm);
    xcd_barrier(xbar);
    ln_rows((const float*)(p.ws + OFF_XC), p.out, p.out, NB * NL, p.in[6] + 1024, p.in[7] + 1024, p.out, p.out, 0);
}

extern "C" void kernel_launch(void* const* d_in, const int* in_sizes, int n_in, void* d_out, int out_size, void* d_ws, size_t ws_size, hipStream_t stream) {
    static int grid_blocks = 0;
    if (grid_blocks == 0) {
        if (ws_size < WS_NEED || n_in != 46) { fprintf(stderr, "kernel_launch: bad ws_size %zu (need %zu) or n_in %d\n", ws_size, (size_t)WS_NEED, n_in); grid_blocks = -1; return; }
        int dev = 0, cus = 0, per_cu = 0;
        (void)hipGetDevice(&dev);
        (void)hipDeviceGetAttribute(&cus, hipDeviceAttributeMultiprocessorCount, dev);
        (void)hipFuncSetAttribute((const void*)fwd_kernel, hipFuncAttributeMaxDynamicSharedMemorySize, LDS_BYTES);
        (void)hipOccupancyMaxActiveBlocksPerMultiprocessor(&per_cu, (const void*)fwd_kernel, NTHR, LDS_BYTES);
        if (per_cu < 1 || cus < 256) { fprintf(stderr, "kernel_launch: occupancy query says %d blocks/CU on %d CUs; this kernel needs 256 resident workgroups\n", per_cu, cus); grid_blocks = -1; return; }
        grid_blocks = 256;
    }
    if (grid_blocks < 0) return;
    (void)hipMemsetAsync((char*)d_ws + OFF_BAR, 0, XCD_BAR_WORDS * 4, stream);
    Params p{};
    for (int i = 0; i < 46; ++i) p.in[i] = (const float*)d_in[i];
    p.out = (float*)d_out; p.ws = (char*)d_ws;
    void* args[] = {&p};
    hipError_t e = hipLaunchCooperativeKernel((const void*)fwd_kernel, dim3(grid_blocks), dim3(NTHR), args, LDS_BYTES, stream);
    if (e != hipSuccess) fprintf(stderr, "cooperative launch failed: %s (grid %d)\n", hipGetErrorString(e), grid_blocks);
}
```

```cpp
#include <hip/hip_runtime.h>
#include <cstdio>
#include <cmath>

#define DEV __device__ __forceinline__

constexpr int NB = 2, NL = 8192, DM = 1024, NCX = 256, TB = NCX + NL;
constexpr int RT = NB * TB;
constexpr int NCH = TB / 64;
constexpr int EIN = 3872, RW0 = 1568;
constexpr int NTHR = 512, NWV = 8;
constexpr float ALPHA = 1.41421356237f;
constexpr float KSCALE = 0.04419417382f;

constexpr size_t OFF_MODV = 0;
constexpr size_t OFF_X1C  = 131072;
constexpr size_t OFF_BAR  = 3145728;
constexpr size_t OFF_BIG  = 4194304;
constexpr size_t OFF_P0   = OFF_BIG;
constexpr size_t OFF_YC   = OFF_BIG + (size_t)TB * EIN * 2;
constexpr size_t OFF_GDS  = OFF_YC + (size_t)TB * 1024 * 2;
constexpr size_t OFF_GDEC = OFF_GDS + (size_t)8 * NCH * 8192 * 4;
constexpr size_t OFF_RU   = OFF_GDEC + (size_t)8 * NCH * 64 * 4;
constexpr size_t OFF_RS0  = OFF_RU + (size_t)16 * NCH * 16384 * 2;
constexpr size_t OFF_BONS = OFF_RS0 + (size_t)16 * NCH * 4096 * 2;
constexpr size_t L0_END   = OFF_BONS + (size_t)2 * TB * 8 * 4;
constexpr size_t OFF_XM   = OFF_BIG;
constexpr size_t OFF_XC   = OFF_XM + (size_t)RT * 2048 * 2;
constexpr size_t OFF_H    = OFF_XC + (size_t)RT * 2048 * 2;
constexpr size_t OFF_WT0  = OFF_H + (size_t)NB * NL * 2048 * 2;
constexpr size_t OFF_WT1  = OFF_WT0 + (size_t)4096 * 1024 * 2;
constexpr size_t OFF_WT2  = OFF_WT1 + (size_t)4096 * 1024 * 2;
constexpr size_t OFF_WT3  = OFF_WT2 + (size_t)1024 * 1024 * 2;
constexpr size_t OFF_G16  = OFF_WT3 + (size_t)1024 * 2048 * 2;
constexpr size_t OFF_SMAT = OFF_G16 + (size_t)RT * 16 * 4;
constexpr size_t OFF_GSC  = OFF_SMAT + (size_t)NB * 4 * NCH * 4096 * 2;
constexpr size_t OFF_CSC  = OFF_GSC + (size_t)16 * TB * 4 * 4;
constexpr size_t OFF_NBUF = OFF_CSC + (size_t)16 * NCH * 2 * 4;
constexpr size_t OFF_GTAB = 3407872;
constexpr size_t OFF_WFT  = OFF_GTAB + (size_t)4 * 128 * 16 * 4;
static_assert(OFF_WFT + (size_t)16 * 4096 * 2 <= OFF_BIG, "low-region tables overflow");
constexpr size_t OFF_G16P = OFF_NBUF + (size_t)16 * NCH * 512 * 4;
constexpr size_t OFF_H1B  = OFF_G16;
constexpr size_t WS_NEED  = (OFF_G16P + (size_t)4 * RT * 16 * 4 > OFF_H1B + (size_t)RT * 1024 * 2) ? OFF_G16P + (size_t)4 * RT * 16 * 4 : OFF_H1B + (size_t)RT * 1024 * 2;
static_assert(WS_NEED <= (size_t)256 * 1024 * 1024, "workspace exceeds the guaranteed 256 MiB");

static_assert(L0_END <= OFF_WT0, "layer-0 buffers overlap the weight copies");
constexpr int LDS_BYTES = 139264;

struct Params { const float* in[46]; float* out; char* ws; };
typedef unsigned short bf16_t;
typedef __attribute__((ext_vector_type(8))) short bf16x8;
typedef __attribute__((ext_vector_type(4))) short s16x4;
typedef __attribute__((ext_vector_type(2))) short s16x2;
typedef __attribute__((ext_vector_type(4))) float f32x4;
typedef __attribute__((ext_vector_type(2))) __bf16 bf2_t;
DEV unsigned pack2bf(float lo, float hi) { bf2_t v; v[0] = (__bf16)lo; v[1] = (__bf16)hi; return __builtin_bit_cast(unsigned, v); }
DEV float bflo(unsigned u) { return __uint_as_float(u << 16); }
DEV float bfhi(unsigned u) { return __uint_as_float(u & 0xffff0000u); }
DEV float bf2f(bf16_t v) { return __uint_as_float(((unsigned)v) << 16); }
DEV void unpack8(uint4 u, float* f) { f[0] = bflo(u.x); f[1] = bfhi(u.x); f[2] = bflo(u.y); f[3] = bfhi(u.y); f[4] = bflo(u.z); f[5] = bfhi(u.z); f[6] = bflo(u.w); f[7] = bfhi(u.w); }

DEV float wave_sum(float v) {
#pragma unroll
    for (int o = 32; o > 0; o >>= 1) v += __shfl_xor(v, o, 64);
    return v;
}
DEV float wave_max(float v) {
#pragma unroll
    for (int o = 32; o > 0; o >>= 1) v = fmaxf(v, __shfl_xor(v, o, 64));
    return v;
}
DEV float fexp(float x) { return __expf(x); }
DEV float frcp(float x) { return __builtin_amdgcn_rcpf(x); }
DEV float sigmoid_f(float x) { return frcp(1.f + fexp(-x)); }
DEV float silu_f(float x) { return x * frcp(1.f + fexp(-x)); }
DEV float logsig_f(float x) { return fminf(x, 0.f) - __logf(1.f + fexp(-fabsf(x))); }
DEV float tanh_f(float x) { const float e = fexp(2.f * x); return 1.f - 2.f * frcp(e + 1.f); }
DEV void lds_fence() { asm volatile("" ::: "memory"); }
DEV int opaque_tid() { int t = threadIdx.x; asm volatile("" : "+v"(t)); return t; }
DEV int scan_s(int dir, int u) { return dir == 0 ? u : (u < NCX ? (NCX - 1 - u) : (TB - 1 + NCX - u)); }
DEV int chunk_at(int dir, int step) { return dir == 0 ? step : (step < 4 ? 3 - step : (NCH + 3 - step)); }
DEV float4 ld4(const float* p) { return *(const float4*)p; }
DEV void st4(float* p, float4 v) { *(float4*)p = v; }


#define XB_TMO      128
#define XB_XCNT(j)  (256  + 64 * (j))
#define XB_XSUB(j)  (1280 + 64 * (j))
#define XB_XGEN(j)  (2304 + 64 * (j))
#define XB_TOP      3328
#define XB_TOPGEN   3392
#define XCD_BAR_WORDS 3456
#define XB_SPIN_CAP (1u << 22)
#define LAS __attribute__((address_space(3)))
DEV unsigned xb_ld(unsigned* p) { return __hip_atomic_load(p, __ATOMIC_RELAXED, __HIP_MEMORY_SCOPE_AGENT); }
DEV unsigned xb_add(unsigned* p, unsigned v) { return __hip_atomic_fetch_add(p, v, __ATOMIC_RELAXED, __HIP_MEMORY_SCOPE_AGENT); }
DEV unsigned xb_xcc_id() { return (unsigned)__builtin_amdgcn_s_getreg((3 << 11) | 20) & 0xFu; }
#define XB_SPIN(cond, bar) do { unsigned _sp = 0; while (cond) { __builtin_amdgcn_s_sleep(1); \
    if ((++_sp & 255u) == 0u) { if (xb_ld(&(bar)[XB_TMO])) break; if (_sp > XB_SPIN_CAP) { atomicAdd(&(bar)[XB_TMO], 1u); break; } } } } while (0)
struct XcdBarrier { unsigned* bar; unsigned x; volatile LAS unsigned* st; };
DEV XcdBarrier xcd_barrier_post(unsigned* bar, volatile LAS unsigned* st) {
    XcdBarrier b; b.bar = bar; b.x = xb_xcc_id(); b.st = st;
    if (threadIdx.x == 0) (void)xb_add(&bar[XB_XCNT(b.x)], 1u);
    return b;
}
DEV void xcd_barrier_complete(unsigned* bar, unsigned x, unsigned& nloc, unsigned& nx) {
    const unsigned G = gridDim.x * gridDim.y * gridDim.z;
    unsigned sum, cnt, mine, sp = 0u;
    for (;;) {
        sum = 0u; cnt = 0u; mine = 0u;
#pragma unroll
        for (unsigned j = 0; j < 16; ++j) { const unsigned c = xb_ld(&bar[XB_XCNT(j)]); sum += c; cnt += (c > 0u) ? 1u : 0u; mine = (j == x) ? c : mine; }
        if (sum == G) break;
        __builtin_amdgcn_s_sleep(1);
        if ((++sp & 255u) == 0u) { if (xb_ld(&bar[XB_TMO])) break; if (sp > XB_SPIN_CAP) { atomicAdd(&bar[XB_TMO], 1u); break; } }
    }
    nloc = mine > 0u ? mine : 1u; nx = cnt > 0u ? cnt : 1u;
}
DEV void xcd_barrier(const XcdBarrier& b) {
    asm volatile("s_waitcnt vmcnt(0)" ::: "memory");
    __syncthreads();
    if (threadIdx.x == 0) {
        unsigned* bar = b.bar;
        __builtin_amdgcn_s_waitcnt(0);
        unsigned nloc = b.st[0], nx = b.st[1];
        if (nloc == 0u) { xcd_barrier_complete(bar, b.x, nloc, nx); b.st[0] = nloc; b.st[1] = nx; }
        const unsigned old = xb_add(&bar[XB_XSUB(b.x)], 1u);
        const unsigned gen = old / nloc;
        if (old + 1u == (gen + 1u) * nloc) {
            __builtin_amdgcn_fence(__ATOMIC_RELEASE, "agent");
            asm volatile("s_waitcnt vmcnt(0)" ::: "memory");
            const unsigned og = xb_add(&bar[XB_TOP], 1u);
            const unsigned tg = og / nx;
            if (og + 1u == (tg + 1u) * nx) xb_add(&bar[XB_TOPGEN], 1u);
            else XB_SPIN(xb_ld(&bar[XB_TOPGEN]) == tg, bar);
            __builtin_amdgcn_fence(__ATOMIC_ACQUIRE, "agent");
            xb_add(&bar[XB_XGEN(b.x)], 1u);
            asm volatile("s_waitcnt vmcnt(0)" ::: "memory");
        } else {
            XB_SPIN(xb_ld(&bar[XB_XGEN(b.x)]) == gen, bar);
            __builtin_amdgcn_fence(__ATOMIC_ACQUIRE, "agent");
            asm volatile("s_waitcnt vmcnt(0)" ::: "memory");
        }
    }
    __syncthreads();
}

namespace pg8 {
#define PG8_LAS __attribute__((address_space(3)))
typedef unsigned short bf16_t;
typedef short bf16x8 __attribute__((ext_vector_type(8)));
typedef float f32x4 __attribute__((ext_vector_type(4)));
typedef unsigned u32x4 __attribute__((ext_vector_type(4)));
constexpr int BM = 256, BK = 64, HALF = 128, HTB = HALF * BK * 2  , STAGE_BYTES = 8 * HTB, NXCD = 8, WGM = 8;

__host__ __device__ __forceinline__ int lds_byte(int r, int c) { const int st = (r >> 4) * 2 + (c >> 5), rr = r & 15, cc = c & 31, ob = rr * 64 + cc * 2; return st * 1024 + (ob ^ (((ob >> 9) & 1) << 5)); }
__host__ __device__ __forceinline__ void stage_rc(int b, int& R, int& C) { const int st = b / 1024, sb = b % 1024, swz = sb ^ (((sb >> 9) & 1) << 5); R = (st >> 1) * 16 + swz / 64; C = (st & 1) * 32 + (swz % 64) / 2; }
__host__ __device__ __forceinline__ int perm32(int rho) { const int n = rho >> 4, i = rho & 15; return 8 * (i >> 2) + 4 * n + (i & 3); }

struct Unit { int pm, pn; };
struct Gemm { const bf16_t* A; const bf16_t* Bt; int M, N, K; };

struct StaticOrder {
    int nM, nN, nwg, G, c;
    __host__ __device__ void init(int M, int N, int G_, int c_) { nM = M / BM; nN = N / BM; nwg = nM * nN; G = G_; c = c_; }
    __host__ __device__ bool next(int i, Unit& u) const {
        const long L = (long)i * G + c; if (L >= nwg) return false;
        int wgid = (int)L; { const int q = nwg / NXCD, r = nwg % NXCD, xcd = wgid % NXCD, off = wgid / NXCD; wgid = (xcd < r ? xcd * (q + 1) : r * (q + 1) + (xcd - r) * q) + off; }
        const int nig = WGM * nN, gid = wgid / nig, fm = gid * WGM, gsz = (nM - fm) < WGM ? (nM - fm) : WGM;
        u.pm = fm + ((wgid % nig) % gsz); u.pn = (wgid % nig) / gsz; return true;
    }
    __device__ __forceinline__ void a_ready(const Unit&) const {}
    __device__ __forceinline__ void done(const Unit&) const {}
};

template <class Epi, class Sched, bool STAMP = false>
__device__ __forceinline__ void gemm_phase(PG8_LAS unsigned char* lds, const Gemm g, const Sched& S, const Epi& E, unsigned long long* stamps) {
    int tid = threadIdx.x; asm volatile("" : "+v"(tid));
    const int wid = __builtin_amdgcn_readfirstlane(tid >> 6), lane = tid & 63, wr = wid >> 2, wc = wid & 3, fr = lane & 15, fq = lane >> 4;
    const int K = g.K, nt = K / BK;
#define PG8_STAMP() do { } while (0)
    PG8_STAMP();
    unsigned voffA[2], voffB[2];
#pragma unroll
    for (int i = 0; i < 2; ++i) { int R, C; stage_rc(tid * 16 + i * 8192, R, C); const int Rb = Epi::PERM ? ((R & ~31) + perm32(R & 31)) : R;
        voffA[i] = (unsigned)(R * K + C) * 2u; voffB[i] = (unsigned)(Rb * K + C) * 2u; }
    const size_t kstep = (size_t)(BK * 2);
    const size_t hstep = (size_t)HALF * K * 2;
    const size_t tstep = 2 * hstep;
    const unsigned ldsw = (unsigned)wid * 1024u;
    const int aoff = lds_byte(wr * 64 + fr, fq * 8), boff = lds_byte(wc * 32 + fr, fq * 8);
#define PG8_SA(b, h) (((b) * 2 + (h)) * HTB)
#define PG8_SB(b, h) ((4 + (b) * 2 + (h)) * HTB)
#define PG8_STAGE(bufoff, gbase, voff) do { _Pragma("unroll") for (int _i = 0; _i < 2; ++_i) \
        __builtin_amdgcn_global_load_lds((const unsigned*)((const char*)(gbase) + (voff)[_i]), (PG8_LAS unsigned*)(lds + (bufoff) + ldsw + _i * 8192), 16, 0, 0); } while (0)
#define PG8_LDA(dst, b, h) do { _Pragma("unroll") for (int m = 0; m < 4; ++m) _Pragma("unroll") for (int k = 0; k < 2; ++k) dst[m][k] = *(const PG8_LAS bf16x8*)(lds + PG8_SA(b, h) + aoff + m * 2048 + k * 1024); } while (0)
#define PG8_LDB(dst, b, h) do { _Pragma("unroll") for (int n = 0; n < 2; ++n) _Pragma("unroll") for (int k = 0; k < 2; ++k) dst[n][k] = *(const PG8_LAS bf16x8*)(lds + PG8_SB(b, h) + boff + n * 2048 + k * 1024); } while (0)
#define PG8_MMA(ai, bj, At, Bt) do { __builtin_amdgcn_s_setprio(1); _Pragma("unroll") for (int m = 0; m < 4; ++m) _Pragma("unroll") for (int n = 0; n < 2; ++n) _Pragma("unroll") for (int k = 0; k < 2; ++k) \
        acc[ai][bj][m][n] = __builtin_amdgcn_mfma_f32_16x16x32_bf16(Bt[n][k], At[m][k], acc[ai][bj][m][n], 0, 0, 0); __builtin_amdgcn_s_setprio(0); } while (0)
#define PG8_WAIT_V(n) asm volatile("s_waitcnt vmcnt(" #n ")" ::: "memory")
#define PG8_WAIT_L(n) asm volatile("s_waitcnt lgkmcnt(" #n ")" ::: "memory")
#define PG8_BAR __builtin_amdgcn_s_barrier()
#define PG8_SCHED __builtin_amdgcn_sched_barrier(0)
    Unit cur, nxt; int ui = 0;
    if (!S.next(0, cur)) return;
    f32x4 acc[2][2][4][2];
#pragma unroll
    for (int a = 0; a < 2; ++a)
#pragma unroll
        for (int b = 0; b < 2; ++b)
#pragma unroll
            for (int m = 0; m < 4; ++m)
#pragma unroll
                for (int n = 0; n < 2; ++n) acc[a][b][m][n] = (f32x4){0.f, 0.f, 0.f, 0.f};
    bf16x8 At[4][2], B0[2][2], B1[2][2];
    const char* cA = (const char*)g.A + (size_t)cur.pm * tstep; const char* cB = (const char*)g.Bt + (size_t)cur.pn * tstep;
    S.a_ready(cur);
    PG8_STAGE(PG8_SB(0, 0), cB, voffB); PG8_STAGE(PG8_SA(0, 0), cA, voffA); PG8_STAGE(PG8_SB(0, 1), cB + hstep, voffB); PG8_STAGE(PG8_SA(0, 1), cA + hstep, voffA);
    if (wr == 1) PG8_BAR;
    PG8_WAIT_V(4); PG8_BAR;
    PG8_STAGE(PG8_SB(1, 0), cB + kstep, voffB); PG8_STAGE(PG8_SA(1, 0), cA + kstep, voffA); PG8_STAGE(PG8_SB(1, 1), cB + hstep + kstep, voffB);
    PG8_WAIT_V(6); PG8_BAR;
    PG8_STAMP();
    for (;;) {
        const bool has_next = S.next(ui + 1, nxt);
        const char* nA = has_next ? (const char*)g.A + (size_t)nxt.pm * tstep : cA; const char* nB = has_next ? (const char*)g.Bt + (size_t)nxt.pn * tstep : cB;
        for (int t = 0; t < nt; t += 2) {
            const bool last = (t == nt - 2);
            const char* a1 = cA + (size_t)(t + 1) * kstep;
            const char* a2 = last ? nA : cA + (size_t)(t + 2) * kstep; const char* b2 = last ? nB : cB + (size_t)(t + 2) * kstep;
            const char* a3 = a2 + kstep; const char* b3 = b2 + kstep;
            if (last && has_next) S.a_ready(nxt);
            PG8_LDB(B0, 0, 0); PG8_SCHED; PG8_LDA(At, 0, 0); PG8_STAGE(PG8_SA(1, 1), a1 + hstep, voffA);
            PG8_WAIT_L(8); PG8_BAR; PG8_WAIT_L(0); PG8_MMA(0, 0, At, B0); PG8_BAR; PG8_SCHED;
            PG8_LDB(B1, 0, 1); PG8_STAGE(PG8_SB(0, 0), b2, voffB);
            PG8_BAR; PG8_WAIT_L(0); PG8_MMA(0, 1, At, B1); PG8_BAR;
            PG8_LDA(At, 0, 1); PG8_STAGE(PG8_SA(0, 0), a2, voffA);
            PG8_BAR; PG8_WAIT_L(0); PG8_MMA(1, 0, At, B0); PG8_BAR; PG8_SCHED;
            PG8_STAGE(PG8_SB(0, 1), b2 + hstep, voffB);
            PG8_WAIT_V(6); PG8_BAR; PG8_MMA(1, 1, At, B1); PG8_BAR;
            PG8_LDB(B0, 1, 0); PG8_SCHED; PG8_LDA(At, 1, 0); PG8_STAGE(PG8_SA(0, 1), a2 + hstep, voffA);
            PG8_WAIT_L(8); PG8_BAR; PG8_WAIT_L(0); PG8_MMA(0, 0, At, B0); PG8_BAR; PG8_SCHED;
            PG8_LDB(B1, 1, 1); PG8_STAGE(PG8_SB(1, 0), b3, voffB);
            PG8_BAR; PG8_WAIT_L(0); PG8_MMA(0, 1, At, B1); PG8_BAR;
            PG8_LDA(At, 1, 1); PG8_STAGE(PG8_SA(1, 0), a3, voffA);
            PG8_BAR; PG8_WAIT_L(0); PG8_MMA(1, 0, At, B0); PG8_BAR; PG8_SCHED;
            PG8_STAGE(PG8_SB(1, 1), b3 + hstep, voffB);
            PG8_WAIT_V(6); PG8_BAR; PG8_MMA(1, 1, At, B1); PG8_BAR;
        }
        PG8_STAMP();
        if constexpr (!Epi::AFTER_DRAIN) { E(acc, cur, wr, wc, fr, fq); S.done(cur); }
        PG8_STAMP();
        if (!has_next) break;
#pragma unroll
        for (int a = 0; a < 2; ++a)
#pragma unroll
            for (int b = 0; b < 2; ++b)
#pragma unroll
                for (int m = 0; m < 4; ++m)
#pragma unroll
                    for (int n = 0; n < 2; ++n) acc[a][b][m][n] = (f32x4){0.f, 0.f, 0.f, 0.f};
        cur = nxt; cA = nA; cB = nB; ++ui;
    }
    PG8_WAIT_V(0);
    if (wr == 0) PG8_BAR;
    PG8_BAR;
    if constexpr (Epi::AFTER_DRAIN) { E.fused(acc, cur, wr, wc, fr, fq, lds, wid, lane); S.done(cur); }
    PG8_STAMP();
#undef PG8_STAMP
#undef PG8_SA
#undef PG8_SB
#undef PG8_STAGE
#undef PG8_LDA
#undef PG8_LDB
#undef PG8_MMA
#undef PG8_WAIT_V
#undef PG8_WAIT_L
#undef PG8_BAR
#undef PG8_SCHED
}
}

DEV void transpose_convert(const float* __restrict__ W, int K, int N, int Npad, bf16_t* Wt, float* sm) {
    float (*T)[65] = (float (*)[65])sm;
    const int tid = opaque_tid();
    const int kt = K / 64, ntl = Npad / 64;
    for (int tile = blockIdx.x; tile < kt * ntl; tile += gridDim.x) {
        const int k0 = (tile / ntl) * 64, n0 = (tile % ntl) * 64;
        __syncthreads();
#pragma unroll
        for (int i = 0; i < 2; ++i) {
            const int k = (tid >> 4) + 32 * i, n4 = (tid & 15) * 4;
            float4 v = make_float4(0.f, 0.f, 0.f, 0.f);
            if (n0 + n4 < N) v = ld4(W + (size_t)(k0 + k) * N + n0 + n4);
            T[k][n4] = v.x; T[k][n4 + 1] = v.y; T[k][n4 + 2] = v.z; T[k][n4 + 3] = v.w;
        }
        __syncthreads();
        const int n = tid >> 3, kq = (tid & 7) * 8;
        unsigned o[4];
#pragma unroll
        for (int j = 0; j < 4; ++j) o[j] = pack2bf(T[kq + 2 * j][n], T[kq + 2 * j + 1][n]);
        bf16_t* dst = Wt + (size_t)(n0 + n) * K + k0 + kq;
        *(uint4*)dst = make_uint4(o[0], o[1], o[2], o[3]);
    }
}

struct EpBf16 {
    static constexpr bool PERM = true, AFTER_DRAIN = false;
    bf16_t* O; int ldc; int ncols;
    DEV void operator()(const pg8::f32x4 (&acc)[2][2][4][2], const pg8::Unit& u, int wr, int wc, int fr, int fq) const {
        const int row0 = u.pm * 256 + wr * 64 + fr, col0 = u.pn * 256 + wc * 32 + 8 * fq;
#pragma unroll
        for (int ai = 0; ai < 2; ++ai)
#pragma unroll
            for (int m = 0; m < 4; ++m) {
                bf16_t* rowp = O + (size_t)(row0 + ai * 128 + m * 16) * ldc + col0;
#pragma unroll
                for (int bj = 0; bj < 2; ++bj) {
                    if (col0 + bj * 128 < ncols) {
                        const pg8::f32x4 v0 = acc[ai][bj][m][0], v1 = acc[ai][bj][m][1];
                        *(uint4*)(rowp + bj * 128) = make_uint4(pack2bf(v0[0], v0[1]), pack2bf(v0[2], v0[3]), pack2bf(v1[0], v1[1]), pack2bf(v1[2], v1[3]));
                    }
                }
            }
    }
};
struct EpRes0 {
    static constexpr bool PERM = false, AFTER_DRAIN = false;
    float* C; const float* mv; int b;
    DEV void operator()(const pg8::f32x4 (&acc)[2][2][4][2], const pg8::Unit& u, int wr, int wc, int fr, int fq) const {
        const bool isc = (u.pm * 256 < NCX);
        const float* gp = mv + (isc ? 2 : b) * 3072 + 2048;
        const int row0 = u.pm * 256 + wr * 64 + fr, col0 = u.pn * 256 + wc * 32 + 4 * fq;
#pragma unroll
        for (int ai = 0; ai < 2; ++ai)
#pragma unroll
            for (int m = 0; m < 4; ++m) {
                const size_t ro = (size_t)(row0 + ai * 128 + m * 16) * DM + col0;
#pragma unroll
                for (int bj = 0; bj < 2; ++bj)
#pragma unroll
                    for (int n = 0; n < 2; ++n) {
                        const int co = bj * 128 + n * 16;
                        const float4 g = ld4(gp + col0 + co); const pg8::f32x4 v = acc[ai][bj][m][n];
                        st4(C + ro + co, make_float4(g.x * v[0], g.y * v[1], g.z * v[2], g.w * v[3]));
                    }
            }
    }
};
struct EpRes1 {
    static constexpr bool PERM = false, AFTER_DRAIN = false;
    float* C; const float* mv;
    DEV void operator()(const pg8::f32x4 (&acc)[2][2][4][2], const pg8::Unit& u, int wr, int wc, int fr, int fq) const {
        const float* gp = mv + (u.pm * 256 >= NL ? 1 : 0) * 3072 + 2048;
        const int row0 = u.pm * 256 + wr * 64 + fr, col0 = u.pn * 256 + wc * 32 + 4 * fq;
#pragma unroll
        for (int ai = 0; ai < 2; ++ai)
#pragma unroll
            for (int m = 0; m < 4; ++m) {
                const size_t ro = (size_t)(row0 + ai * 128 + m * 16) * DM + col0;
#pragma unroll
                for (int bj = 0; bj < 2; ++bj)
#pragma unroll
                    for (int n = 0; n < 2; ++n) {
                        const int co = bj * 128 + n * 16;
                        const float4 g = ld4(gp + col0 + co); const pg8::f32x4 v = acc[ai][bj][m][n];
                        st4(C + ro + co, make_float4(g.x * v[0], g.y * v[1], g.z * v[2], g.w * v[3]));
                    }
            }
    }
};
template <class EP>
DEV void run_gemm(const bf16_t* A, const bf16_t* Bt, int M, int N, int K, const EP& ep, float* sm) {
    pg8::Gemm g{A, Bt, M, N, K}; pg8::StaticOrder S; S.init(M, N, (int)gridDim.x, (int)blockIdx.x);
    pg8::gemm_phase<EP, pg8::StaticOrder, false>((PG8_LAS unsigned char*)sm, g, S, ep, nullptr);
}

DEV void phase_h0(const Params& p, int b) {
    const float* modv = (const float*)(p.ws + OFF_MODV);
    bf16_t* H0 = (bf16_t*)(p.ws + OFF_YC);
    const int gt = blockIdx.x * NTHR + opaque_tid(), gn = gridDim.x * NTHR;
    for (int i = gt; i < TB * 128; i += gn) {
        const int s = i >> 7, k = (i & 127) * 8;
        const float* src; int j;
        if (s < NCX) { src = p.in[2] + ((size_t)(b * NCX + s)) * DM + k; j = 2; }
        else { src = p.in[0] + ((size_t)(b * NL + s - NCX)) * DM + k; j = b; }
        const float4 x0 = ld4(src), x1 = ld4(src + 4);
        const float* m = modv + j * 3072;
        const float4 s0 = ld4(m + k), s1 = ld4(m + k + 4), c0 = ld4(m + 1024 + k), c1 = ld4(m + 1024 + k + 4);
        *(uint4*)(H0 + (size_t)s * DM + k) = make_uint4(pack2bf(x0.x * (1.f + c0.x) + s0.x, x0.y * (1.f + c0.y) + s0.y), pack2bf(x0.z * (1.f + c0.z) + s0.z, x0.w * (1.f + c0.w) + s0.w),
                                                      pack2bf(x1.x * (1.f + c1.x) + s1.x, x1.y * (1.f + c1.y) + s1.y), pack2bf(x1.z * (1.f + c1.z) + s1.z, x1.w * (1.f + c1.w) + s1.w));
    }
}

DEV void phase_mod(const Params& p, float* sm) {
    const float* c = p.in[1]; const float* cctx = p.in[3];
    const float* mod_w = p.in[4]; const float* mod_b = p.in[5];
    float* modv = (float*)(p.ws + OFF_MODV);
    float* sil = sm; float* red = sm + 3072;
    const int tid = opaque_tid();
    for (int i = tid; i < 3072; i += NTHR) {
        const int j = i >> 10, k = i & 1023;
        const float v = (j < 2) ? c[j * 1024 + k] : cctx[k];
        sil[i] = silu_f(v);
    }
    __syncthreads();
    for (int unit = blockIdx.x; unit < 192; unit += gridDim.x) {
        const int l = unit / 96, cb = unit % 96;
        const int kg = tid >> 5, col = tid & 31, n = cb * 32 + col;
        const float* w = mod_w + (size_t)l * 1024 * 3072 + n;
        float a0 = 0.f, a1 = 0.f, a2 = 0.f;
        for (int k = kg * 64; k < kg * 64 + 64; ++k) {
            const float wv = w[(size_t)k * 3072];
            a0 += sil[k] * wv; a1 += sil[1024 + k] * wv; a2 += sil[2048 + k] * wv;
        }
        red[(kg * 3 + 0) * 32 + col] = a0; red[(kg * 3 + 1) * 32 + col] = a1; red[(kg * 3 + 2) * 32 + col] = a2;
        __syncthreads();
        if (tid < 96) {
            const int j = tid >> 5, cc = tid & 31, nn = cb * 32 + cc;
            float s = mod_b[l * 3072 + nn];
            for (int g = 0; g < 16; ++g) s += red[(g * 3 + j) * 32 + cc];
            modv[(l * 3 + j) * 3072 + nn] = s;
        }
        __syncthreads();
    }
}

DEV void phase_tables(const Params& p) {
    const float* wq = p.in[33]; const float* wk = p.in[34]; const float* wv = p.in[35];
    const float* gw0 = p.in[36]; const float* gw1 = p.in[38]; const float* gw2 = p.in[40]; const float* gw3 = p.in[42];
    float* gtab = (float*)(p.ws + OFF_GTAB); bf16_t* wft = (bf16_t*)(p.ws + OFF_WFT);
    const int gt = blockIdx.x * NTHR + opaque_tid(), gn = gridDim.x * NTHR;
    for (int i = gt; i < 512 * 16; i += gn) {
        const int gb = i >> 4, cp = (i >> 2) & 3, c = i & 3;
        float s = 0.f;
#pragma unroll
        for (int d = 0; d < 4; ++d) s += wq[gb * 16 + cp * 4 + d] * wk[gb * 16 + c * 4 + d];
        gtab[i] = s * KSCALE;
    }
    for (int i = gt; i < 4096 * 16; i += gn) {
        const int g = i >> 12, k = i & 4095, gm = g >> 2, hd = g & 3;
        const float* wg = gm == 0 ? gw0 : (gm == 1 ? gw1 : (gm == 2 ? gw2 : gw3));
        float s = 0.f;
        if (k < 2048) {
            const int blk = k >> 2, cc = k & 3;
#pragma unroll
            for (int d = 0; d < 4; ++d) s += wq[blk * 16 + cc * 4 + d] * wg[(size_t)(4 * blk + d) * 4 + hd] + wk[blk * 16 + cc * 4 + d] * wg[(size_t)(2048 + 4 * blk + d) * 4 + hd];
        } else {
            const int kk = k - 2048, blk = kk >> 2, cc = kk & 3;
#pragma unroll
            for (int d = 0; d < 4; ++d) s += wv[blk * 16 + cc * 4 + d] * wg[(size_t)(4096 + 4 * blk + d) * 4 + hd];
        }
        wft[i] = __builtin_bit_cast(unsigned short, (__bf16)s);
    }
}

DEV float wave_scan_add(float v, int lane, int dir) {
#pragma unroll
    for (int o = 1; o < 64; o <<= 1) {
        const float n = dir ? __shfl_down(v, o, 64) : __shfl_up(v, o, 64);
        const bool ok = dir ? (lane + o < 64) : (lane >= o);
        if (ok) v += n;
    }
    return v;
}
DEV float wave_scan_max(float v, int lane, int dir) {
#pragma unroll
    for (int o = 1; o < 64; o <<= 1) {
        const float n = dir ? __shfl_down(v, o, 64) : __shfl_up(v, o, 64);
        const bool ok = dir ? (lane + o < 64) : (lane >= o);
        if (ok) v = fmaxf(v, n);
    }
    return v;
}

DEV void gla_decay(const bf16_t* P0, int c, int h, int dir, const float* __restrict__ wa2, const float* __restrict__ ba,
                   float* sLR, float* sWA, float* sBC, float* sTot, int tid) {
    for (int i = tid; i < 1024; i += NTHR) { const int t = i >> 4, j = i & 15; sLR[i] = bf2f(P0[(size_t)(c * 64 + t) * EIN + 1536 + dir * 16 + j]); }
    for (int i = tid; i < 1024; i += NTHR) { const int ii = i >> 6, k = i & 63; sWA[i] = wa2[ii * 256 + h * 64 + k]; }
    __syncthreads();
    {
        const int t = tid >> 3, k0 = (tid & 7) * 8;
        float acc[8];
#pragma unroll
        for (int j = 0; j < 8; ++j) acc[j] = ba[h * 64 + k0 + j];
#pragma unroll
        for (int ii = 0; ii < 16; ++ii) {
            const float l = sLR[t * 16 + ii];
#pragma unroll
            for (int j = 0; j < 8; ++j) acc[j] += l * sWA[ii * 64 + k0 + j];
        }
#pragma unroll
        for (int j = 0; j < 8; ++j) sBC[t * 65 + k0 + j] = logsig_f(acc[j]) * 0.0625f;
    }
    __syncthreads();
    {
        const int lane = tid & 63, wv = tid >> 6;
#pragma unroll
        for (int j = 0; j < 8; ++j) {
            const int k = wv * 8 + j;
            const float v = wave_scan_add(sBC[lane * 65 + k], lane, dir);
            sBC[lane * 65 + k] = v;
            if (lane == (dir ? 0 : 63)) sTot[k] = v;
        }
    }
    __syncthreads();
}
DEV bf16x8 tr_frag(const bf16_t* base, int ld, int row0, int col0, int lane) {
    const bf16_t* ptr = base + (row0 + (lane >> 4) * 8 + ((lane & 15) >> 2)) * ld + col0 + (lane & 3) * 4;
    const s16x4 lo = __builtin_amdgcn_ds_read_tr16_b64_v4i16((__attribute__((address_space(3))) s16x4*)ptr);
    const s16x4 hi = __builtin_amdgcn_ds_read_tr16_b64_v4i16((__attribute__((address_space(3))) s16x4*)(ptr + 4 * ld));
    return (bf16x8){lo[0], lo[1], lo[2], lo[3], hi[0], hi[1], hi[2], hi[3]};
}
DEV bf16x8 row_frag(const bf16_t* base, int ld, int idx0, int k0, int lane) {
    return *(const bf16x8*)(base + (idx0 + (lane & 15)) * ld + k0 + (lane >> 4) * 8);
}

DEV void gla1_unit(const Params& p, int h, int dir, int c, float* sm) {
    const int tid = opaque_tid(), lane = tid & 63, wave = tid >> 6;
    const bf16_t* P0 = (const bf16_t*)(p.ws + OFF_P0);
    float* GDS = (float*)(p.ws + OFF_GDS); float* GDEC = (float*)(p.ws + OFF_GDEC);
    const float* wa2 = p.in[dir ? 12 : 10]; const float* ba = p.in[dir ? 13 : 11];
    float* sLR = sm; float* sWA = sm + 1024; float* sBC = sm + 2048; float* sTot = sm + 6208;
    bf16_t* kT = (bf16_t*)(sm + 6272);
    bf16_t* Vs = (bf16_t*)(sm + 8576);
    const int ch = h * 2 + dir;
    __syncthreads();
    gla_decay(P0, c, h, dir, wa2, ba, sLR, sWA, sBC, sTot, tid);
    {
        const int t = tid >> 3, k0 = (tid & 7) * 8;
        float kv[8]; unpack8(*(const uint4*)(P0 + (size_t)(c * 64 + t) * EIN + 256 + h * 64 + k0), kv);
#pragma unroll
        for (int j = 0; j < 8; ++j) kT[(k0 + j) * 72 + t] = __builtin_bit_cast(unsigned short, (__bf16)(kv[j] * fexp(sTot[k0 + j] - sBC[t * 65 + k0 + j])));
#pragma unroll
        for (int u = 0; u < 2; ++u) { const int i = tid + 512 * u, row = i >> 4, c16 = i & 15; *(uint4*)(Vs + row * 136 + c16 * 8) = *(const uint4*)(P0 + (size_t)(c * 64 + row) * EIN + 512 + h * 128 + c16 * 8); }
    }
    __syncthreads();
    {
        f32x4 acc[4];
#pragma unroll
        for (int kt = 0; kt < 4; ++kt) acc[kt] = (f32x4){0.f, 0.f, 0.f, 0.f};
#pragma unroll
        for (int ks = 0; ks < 2; ++ks) {
            const bf16x8 af = tr_frag(Vs, 136, ks * 32, wave * 16, lane);
#pragma unroll
            for (int kt = 0; kt < 4; ++kt) acc[kt] = __builtin_amdgcn_mfma_f32_16x16x32_bf16(af, row_frag(kT, 72, kt * 16, ks * 32, lane), acc[kt], 0, 0, 0);
        }
#pragma unroll
        for (int kt = 0; kt < 4; ++kt) {
            const int k = kt * 16 + (lane & 15), v = wave * 16 + (lane >> 4) * 4;
            st4(GDS + ((size_t)(ch * NCH + c) * 64 + k) * 128 + v, make_float4(acc[kt][0], acc[kt][1], acc[kt][2], acc[kt][3]));
        }
    }
    if (tid < 64) GDEC[(size_t)(ch * NCH + c) * 64 + tid] = fexp(sTot[tid]);
}

DEV void gla2_unit(const Params& p, int unit) {
    const int tid = opaque_tid();
    float* GDS = (float*)(p.ws + OFF_GDS); const float* GDEC = (const float*)(p.ws + OFF_GDEC);
    const int ch = unit >> 4, e = (unit & 15) * 512 + tid, k = e >> 7, dir = ch & 1;
    constexpr int GB = 12;
    float S = 0.f, ninc[GB], nd[GB];
#pragma unroll
    for (int j = 0; j < GB; ++j) { const int c = chunk_at(dir, j); ninc[j] = GDS[(size_t)(ch * NCH + c) * 8192 + e]; nd[j] = GDEC[(size_t)(ch * NCH + c) * 64 + k]; }
#pragma unroll 1
    for (int step0 = 0; step0 < NCH; step0 += GB) {
        float inc[GB], d[GB];
#pragma unroll
        for (int j = 0; j < GB; ++j) { inc[j] = ninc[j]; d[j] = nd[j]; }
#pragma unroll
        for (int j = 0; j < GB; ++j) { const int sn = step0 + GB + j, c = chunk_at(dir, sn < NCH ? sn : NCH - 1); ninc[j] = GDS[(size_t)(ch * NCH + c) * 8192 + e]; nd[j] = GDEC[(size_t)(ch * NCH + c) * 64 + k]; }
        __builtin_amdgcn_sched_barrier(0);
#pragma unroll
        for (int j = 0; j < GB; ++j) { const int c = chunk_at(dir, step0 + j); GDS[(size_t)(ch * NCH + c) * 8192 + e] = S; S = d[j] * S + inc[j]; }
    }
}

DEV void gla3_unit(const Params& p, int h, int c, float* sm) {
    const int tid = opaque_tid(), lane = tid & 63, wave = tid >> 6;
    const bf16_t* P0 = (const bf16_t*)(p.ws + OFF_P0);
    const float* GDS = (const float*)(p.ws + OFF_GDS);
    bf16_t* YC = (bf16_t*)(p.ws + OFF_YC);
    const float* ng = p.in[14];
    float* sLR = sm; float* sWA = sm + 1024; float* sBC = sm + 2048; float* sTot = sm + 6208;
    bf16_t* qt = (bf16_t*)(sm + 6272);
    bf16_t* kt = (bf16_t*)(sm + 8576);
    bf16_t* Sm = (bf16_t*)(sm + 10880);
    bf16_t* S0s = (bf16_t*)(sm + 13184);
    bf16_t* Vs = (bf16_t*)(sm + 17536);
    float* O = sm + 21888;
    const int ti = wave & 3, vt0 = (wave >> 2) * 4;
    f32x4 acc[4];
#pragma unroll
    for (int j = 0; j < 4; ++j) acc[j] = (f32x4){0.f, 0.f, 0.f, 0.f};
    __syncthreads();
#pragma unroll
    for (int u = 0; u < 2; ++u) { const int i = tid + 512 * u, row = i >> 4, c16 = i & 15; *(uint4*)(Vs + row * 136 + c16 * 8) = *(const uint4*)(P0 + (size_t)(c * 64 + row) * EIN + 512 + h * 128 + c16 * 8); }
#pragma unroll 1
    for (int dir = 0; dir < 2; ++dir) {
        const float* wa2 = p.in[dir ? 12 : 10]; const float* ba = p.in[dir ? 13 : 11];
        const int ch = h * 2 + dir;
        __syncthreads();
        gla_decay(P0, c, h, dir, wa2, ba, sLR, sWA, sBC, sTot, tid);
        {
            const int t = tid >> 3, k0 = (tid & 7) * 8;
            float qv[8], kv[8];
            unpack8(*(const uint4*)(P0 + (size_t)(c * 64 + t) * EIN + h * 64 + k0), qv);
            unpack8(*(const uint4*)(P0 + (size_t)(c * 64 + t) * EIN + 256 + h * 64 + k0), kv);
#pragma unroll
            for (int j = 0; j < 8; ++j) { const float bc = sBC[t * 65 + k0 + j]; qv[j] *= 0.125f * fexp(bc); kv[j] *= fexp(-bc); }
            *(uint4*)(qt + t * 72 + k0) = make_uint4(pack2bf(qv[0], qv[1]), pack2bf(qv[2], qv[3]), pack2bf(qv[4], qv[5]), pack2bf(qv[6], qv[7]));
            *(uint4*)(kt + t * 72 + k0) = make_uint4(pack2bf(kv[0], kv[1]), pack2bf(kv[2], kv[3]), pack2bf(kv[4], kv[5]), pack2bf(kv[6], kv[7]));
#pragma unroll
            for (int u = 0; u < 4; ++u) {
                const int i = tid + 512 * u, k = i >> 5, v4 = (i & 31) * 4;
                const float4 s4 = ld4(GDS + (size_t)(ch * NCH + c) * 8192 + k * 128 + v4);
                *(uint2*)(S0s + k * 136 + v4) = make_uint2(pack2bf(s4.x, s4.y), pack2bf(s4.z, s4.w));
            }
        }
        __syncthreads();
        {
            const int si = wave & 3;
#pragma unroll
            for (int jj = 0; jj < 2; ++jj) {
                const int t2 = (wave >> 2) * 2 + jj;
                f32x4 a = (f32x4){0.f, 0.f, 0.f, 0.f};
#pragma unroll
                for (int ks = 0; ks < 2; ++ks) a = __builtin_amdgcn_mfma_f32_16x16x32_bf16(row_frag(kt, 72, si * 16, ks * 32, lane), row_frag(qt, 72, t2 * 16, ks * 32, lane), a, 0, 0, 0);
                const int t = t2 * 16 + (lane & 15), s0 = si * 16 + (lane >> 4) * 4;
                float m[4];
#pragma unroll
                for (int r = 0; r < 4; ++r) { const bool keep = dir ? (s0 + r >= t) : (s0 + r <= t); m[r] = keep ? a[r] : 0.f; }
                *(uint2*)(Sm + t * 72 + s0) = make_uint2(pack2bf(m[0], m[1]), pack2bf(m[2], m[3]));
            }
        }
        __syncthreads();
#pragma unroll
        for (int ks = 0; ks < 2; ++ks) {
            const bf16x8 a1 = row_frag(qt, 72, ti * 16, ks * 32, lane), a2 = row_frag(Sm, 72, ti * 16, ks * 32, lane);
#pragma unroll
            for (int j = 0; j < 4; ++j) {
                acc[j] = __builtin_amdgcn_mfma_f32_16x16x32_bf16(a1, tr_frag(S0s, 136, ks * 32, (vt0 + j) * 16, lane), acc[j], 0, 0, 0);
                acc[j] = __builtin_amdgcn_mfma_f32_16x16x32_bf16(a2, tr_frag(Vs, 136, ks * 32, (vt0 + j) * 16, lane), acc[j], 0, 0, 0);
            }
        }
    }
#pragma unroll
    for (int j = 0; j < 4; ++j)
#pragma unroll
        for (int r = 0; r < 4; ++r) O[(ti * 16 + (lane >> 4) * 4 + r) * 132 + (vt0 + j) * 16 + (lane & 15)] = acc[j][r];
    __syncthreads();
    {
        const int t = tid >> 3, v0 = (tid & 7) * 16;
        float o[16];
        float ss = 0.f;
#pragma unroll
        for (int i = 0; i < 16; ++i) { o[i] = O[t * 132 + v0 + i]; ss += o[i] * o[i]; }
        ss += __shfl_xor(ss, 1, 64); ss += __shfl_xor(ss, 2, 64); ss += __shfl_xor(ss, 4, 64);
        const float rms = rsqrtf(ss * (1.f / 128.f) + 1e-5f);
        float g[16];
        const bf16_t* gp = P0 + (size_t)(c * 64 + t) * EIN + 1024 + h * 128 + v0;
        unpack8(*(const uint4*)gp, g); unpack8(*(const uint4*)(gp + 8), g + 8);
        float y[16];
#pragma unroll
        for (int i = 0; i < 16; ++i) y[i] = o[i] * rms * ng[v0 + i] * silu_f(g[i]);
        bf16_t* yp = YC + (size_t)(c * 64 + t) * 1024 + h * 128 + v0;
        *(uint4*)yp = make_uint4(pack2bf(y[0], y[1]), pack2bf(y[2], y[3]), pack2bf(y[4], y[5]), pack2bf(y[6], y[7]));
        *(uint4*)(yp + 8) = make_uint4(pack2bf(y[8], y[9]), pack2bf(y[10], y[11]), pack2bf(y[12], y[13]), pack2bf(y[14], y[15]));
    }
}

DEV void load8bf(const bf16_t* ptr, float* f) { unpack8(*(const uint4*)ptr, f); }
struct RwNb { int sL, sR, sU, sD; bool vL, vR, vU, vD; };
DEV RwNb rw_nb(int s) {
    RwNb q; q.vU = false; q.vD = false;
    if (s < NCX) { q.vL = s > 0; q.vR = s < NCX - 1; }
    else { const int n = s - NCX, rr = n >> 6, cc = n & 63; q.vL = cc > 0; q.vR = cc < 63; q.vU = rr > 0; q.vD = rr < 127; }
    q.sL = q.vL ? s - 1 : s; q.sR = q.vR ? s + 1 : s; q.sU = q.vU ? s - 64 : s; q.sD = q.vD ? s + 64 : s;
    return q;
}
struct RwRaw { uint4 o, l, r, u, d; };
DEV RwRaw rw_load(const bf16_t* P0, int s, const RwNb& q, int cb) {
    RwRaw w;
    w.o = *(const uint4*)(P0 + (size_t)s * EIN + RW0 + cb); w.l = *(const uint4*)(P0 + (size_t)q.sL * EIN + RW0 + cb); w.r = *(const uint4*)(P0 + (size_t)q.sR * EIN + RW0 + cb);
    w.u = *(const uint4*)(P0 + (size_t)q.sU * EIN + RW0 + cb); w.d = *(const uint4*)(P0 + (size_t)q.sD * EIN + RW0 + cb);
    return w;
}
DEV void rw_comb_l(const RwRaw& w, const RwNb& q, const float* ml, float* out) {
    float own[8]; unpack8(w.o, own);
    const float nb[8] = {q.vL ? bflo(w.l.x) : 0.f, q.vR ? bfhi(w.r.x) : 0.f, q.vU ? bflo(w.u.y) : 0.f, q.vD ? bfhi(w.d.y) : 0.f,
                         q.vL ? bflo(w.l.z) : 0.f, q.vR ? bfhi(w.r.z) : 0.f, q.vU ? bflo(w.u.w) : 0.f, q.vD ? bfhi(w.d.w) : 0.f};
    const float4 m0 = *(const float4*)ml, m1 = *(const float4*)(ml + 4);
    const float m[8] = {m0.x, m0.y, m0.z, m0.w, m1.x, m1.y, m1.z, m1.w};
#pragma unroll
    for (int i = 0; i < 8; ++i) out[i] = own[i] + (nb[i] - own[i]) * m[i];
}
DEV void rw_comb(const RwRaw& w, const RwNb& q, const float* __restrict__ mu, int cb, float* out) {
    float own[8]; unpack8(w.o, own);
    const float nb[8] = {q.vL ? bflo(w.l.x) : 0.f, q.vR ? bfhi(w.r.x) : 0.f, q.vU ? bflo(w.u.y) : 0.f, q.vD ? bfhi(w.d.y) : 0.f,
                         q.vL ? bflo(w.l.z) : 0.f, q.vR ? bfhi(w.r.z) : 0.f, q.vU ? bflo(w.u.w) : 0.f, q.vD ? bfhi(w.d.w) : 0.f};
    const float4 m0 = ld4(mu + cb), m1 = ld4(mu + cb + 4);
    const float m[8] = {m0.x, m0.y, m0.z, m0.w, m1.x, m1.y, m1.z, m1.w};
#pragma unroll
    for (int i = 0; i < 8; ++i) out[i] = own[i] + (nb[i] - own[i]) * m[i];
}
DEV uint4 pack8(const float* f) { return make_uint4(pack2bf(f[0], f[1]), pack2bf(f[2], f[3]), pack2bf(f[4], f[5]), pack2bf(f[6], f[7])); }

template <int XM, int YM, class F>
DEV void mm64(const bf16_t* X, const bf16_t* Y, F f, int lane, int wave) {
#pragma unroll
    for (int q = 0; q < 2; ++q) {
        const int idx = wave * 2 + q, ti = idx >> 2, tj = idx & 3;
        f32x4 acc = (f32x4){0.f, 0.f, 0.f, 0.f};
#pragma unroll
        for (int ks = 0; ks < 2; ++ks) {
            const bf16x8 a = XM == 0 ? row_frag(X, 72, ti * 16, ks * 32, lane) : tr_frag(X, 72, ks * 32, ti * 16, lane);
            const bf16x8 bq = YM == 0 ? row_frag(Y, 72, tj * 16, ks * 32, lane) : tr_frag(Y, 72, ks * 32, tj * 16, lane);
            acc = __builtin_amdgcn_mfma_f32_16x16x32_bf16(a, bq, acc, 0, 0, 0);
        }
        f(ti * 16 + (lane >> 4) * 4, tj * 16 + (lane & 15), acc);
    }
}
template <int XM, int YM, class F>
DEV void mm64x2(const bf16_t* X1, const bf16_t* Y1, const bf16_t* X2, const bf16_t* Y2, F f, int lane, int wave) {
#pragma unroll
    for (int q = 0; q < 2; ++q) {
        const int idx = wave * 2 + q, ti = idx >> 2, tj = idx & 3;
        f32x4 acc = (f32x4){0.f, 0.f, 0.f, 0.f};
#pragma unroll
        for (int ks = 0; ks < 2; ++ks) {
            const bf16x8 a = XM == 0 ? row_frag(X1, 72, ti * 16, ks * 32, lane) : tr_frag(X1, 72, ks * 32, ti * 16, lane);
            const bf16x8 bq = YM == 0 ? row_frag(Y1, 72, tj * 16, ks * 32, lane) : tr_frag(Y1, 72, ks * 32, tj * 16, lane);
            acc = __builtin_amdgcn_mfma_f32_16x16x32_bf16(a, bq, acc, 0, 0, 0);
            const bf16x8 a2 = XM == 0 ? row_frag(X2, 72, ti * 16, ks * 32, lane) : tr_frag(X2, 72, ks * 32, ti * 16, lane);
            const bf16x8 b2 = YM == 0 ? row_frag(Y2, 72, tj * 16, ks * 32, lane) : tr_frag(Y2, 72, ks * 32, tj * 16, lane);
            acc = __builtin_amdgcn_mfma_f32_16x16x32_bf16(a2, b2, acc, 0, 0, 0);
        }
        f(ti * 16 + (lane >> 4) * 4, tj * 16 + (lane & 15), acc);
    }
}
DEV void st_img(bf16_t* P, int i0, int j, float a0, float a1, float a2, float a3) {
    P[(i0 + 0) * 72 + j] = __builtin_bit_cast(unsigned short, (__bf16)a0); P[(i0 + 1) * 72 + j] = __builtin_bit_cast(unsigned short, (__bf16)a1);
    P[(i0 + 2) * 72 + j] = __builtin_bit_cast(unsigned short, (__bf16)a2); P[(i0 + 3) * 72 + j] = __builtin_bit_cast(unsigned short, (__bf16)a3);
}

struct RwRaw3 { uint4 o, u, d; };
DEV RwRaw3 rw_load3(const bf16_t* P0, int s, const RwNb& q, int cb) {
    RwRaw3 w;
    w.o = *(const uint4*)(P0 + (size_t)s * EIN + RW0 + cb); w.u = *(const uint4*)(P0 + (size_t)q.sU * EIN + RW0 + cb); w.d = *(const uint4*)(P0 + (size_t)q.sD * EIN + RW0 + cb);
    return w;
}
DEV void rw_comb3(const RwRaw3& w, const RwNb& q, const bf16_t* tile, const bf16_t* P0, int s, int t, int cb, int j0, const float* ml, float* out) {
    asm volatile("" :: "v"(w.u.x), "v"(w.u.z), "v"(w.d.x), "v"(w.d.z));
    float own[8]; unpack8(w.o, own);
    float l0 = 0.f, l4 = 0.f, r1 = 0.f, r5 = 0.f;
    if (q.vL) { if (t > 0) { l0 = bf2f(tile[(t - 1) * 72 + j0]); l4 = bf2f(tile[(t - 1) * 72 + j0 + 4]); }
                else { const bf16_t* g = P0 + (size_t)(s - 1) * EIN + RW0 + cb; l0 = bf2f(g[0]); l4 = bf2f(g[4]); } }
    if (q.vR) { if (t < 63) { r1 = bf2f(tile[(t + 1) * 72 + j0 + 1]); r5 = bf2f(tile[(t + 1) * 72 + j0 + 5]); }
                else { const bf16_t* g = P0 + (size_t)(s + 1) * EIN + RW0 + cb; r1 = bf2f(g[1]); r5 = bf2f(g[5]); } }
    const float nb[8] = {l0, r1, q.vU ? bflo(w.u.y) : 0.f, q.vD ? bfhi(w.d.y) : 0.f, l4, r5, q.vU ? bflo(w.u.w) : 0.f, q.vD ? bfhi(w.d.w) : 0.f};
    const float4 m0 = *(const float4*)ml, m1 = *(const float4*)(ml + 4);
    const float m[8] = {m0.x, m0.y, m0.z, m0.w, m1.x, m1.y, m1.z, m1.w};
#pragma unroll
    for (int i = 0; i < 8; ++i) out[i] = own[i] + (nb[i] - own[i]) * m[i];
}
struct R1Raw { RwRaw3 r, k, v, w, a; float4 qw0, qw1, qa0, qa1; };
DEV void r1_consts(const Params& p, int h, int dir, float* sm) {
    const int tid = opaque_tid();
    float* sv = (float*)((bf16_t*)sm + 14 * 4608);
    __syncthreads();
    if (tid < 64) { const int hc = h * 64 + tid; sv[64 + tid] = p.in[dir ? 18 : 16][hc]; sv[128 + tid] = p.in[dir ? 22 : 20][hc]; sv[192 + tid] = p.in[24][hc]; sv[256 + tid] = p.in[25][hc]; sv[320 + tid] = p.in[26][hc]; }
    if (tid < 320) { const int tn = tid >> 6, col = tid & 63; const int cb = tn < 3 ? tn * 512 + h * 64 : (tn == 3 ? 2048 + dir * 64 : 2176 + dir * 64); sv[384 + tid] = p.in[15][cb + col]; }
}
DEV void r1_load(const Params& p, int h, int dir, int c, R1Raw& R) {
    const int tid = opaque_tid();
    const bf16_t* P0 = (const bf16_t*)(p.ws + OFF_P0);
    const float* ww2 = p.in[dir ? 19 : 17]; const float* wa2 = p.in[dir ? 23 : 21];
    const int t = tid >> 3, j0 = (tid & 7) * 8, s = c * 64 + t;
    const RwNb nbq = rw_nb(s);
    R.r = rw_load3(P0, s, nbq, h * 64 + j0); R.k = rw_load3(P0, s, nbq, 512 + h * 64 + j0); R.v = rw_load3(P0, s, nbq, 1024 + h * 64 + j0);
    R.w = rw_load3(P0, s, nbq, 2048 + dir * 64 + j0); R.a = rw_load3(P0, s, nbq, 2176 + dir * 64 + j0);
    R.qw0 = ld4(ww2 + (size_t)t * 512 + h * 64 + j0); R.qw1 = ld4(ww2 + (size_t)t * 512 + h * 64 + j0 + 4);
    R.qa0 = ld4(wa2 + (size_t)t * 512 + h * 64 + j0); R.qa1 = ld4(wa2 + (size_t)t * 512 + h * 64 + j0 + 4);
}
DEV void rwkv1_unit(const Params& p, int h, int dir, int c, float* sm, R1Raw& R, int cnext) {
    const int tid = opaque_tid(), lane = tid & 63, wave = tid >> 6;
    bf16_t* RU = (bf16_t*)(p.ws + OFF_RU) + (size_t)((h * 2 + dir) * NCH + c) * 16384;
    float* BONS = (float*)(p.ws + OFF_BONS);
    bf16_t* img = (bf16_t*)sm;
#define SLOT(i_) (img + (i_) * 4608)
    float* fLW = (float*)SLOT(10);
    float* fAS = (float*)SLOT(12);
    float* sv = (float*)SLOT(14);
    const int t = tid >> 3, j0 = (tid & 7) * 8, s = c * 64 + t;
    const bf16_t* P0 = (const bf16_t*)(p.ws + OFF_P0);
    __syncthreads();
    *(uint4*)(SLOT(0) + t * 72 + j0) = R.r.o; *(uint4*)(SLOT(1) + t * 72 + j0) = R.k.o; *(uint4*)(SLOT(2) + t * 72 + j0) = R.v.o;
    *(uint4*)(SLOT(3) + t * 72 + j0) = R.w.o; *(uint4*)(SLOT(4) + t * 72 + j0) = R.a.o;
    __syncthreads();
    float r8[8], k8[8], v8[8];
    {
        float x8[8];
        const RwNb nbq = rw_nb(s);
        rw_comb3(R.r, nbq, SLOT(0), P0, s, t, h * 64 + j0, j0, sv + 384 + j0, r8);
        rw_comb3(R.k, nbq, SLOT(1), P0, s, t, 512 + h * 64 + j0, j0, sv + 448 + j0, k8);
        rw_comb3(R.v, nbq, SLOT(2), P0, s, t, 1024 + h * 64 + j0, j0, sv + 512 + j0, v8);
        rw_comb3(R.w, nbq, SLOT(3), P0, s, t, 2048 + dir * 64 + j0, j0, sv + 576 + j0, x8);
#pragma unroll
        for (int i = 0; i < 8; ++i) x8[i] = tanh_f(x8[i]);
        *(uint4*)(SLOT(6) + t * 72 + j0) = pack8(x8);
        rw_comb3(R.a, nbq, SLOT(4), P0, s, t, 2176 + dir * 64 + j0, j0, sv + 640 + j0, x8);
        *(uint4*)(SLOT(7) + t * 72 + j0) = pack8(x8);
        { const float wq[8] = {R.qw0.x, R.qw0.y, R.qw0.z, R.qw0.w, R.qw1.x, R.qw1.y, R.qw1.z, R.qw1.w}; *(uint4*)(SLOT(8) + t * 72 + j0) = pack8(wq); }
        { const float wq[8] = {R.qa0.x, R.qa0.y, R.qa0.z, R.qa0.w, R.qa1.x, R.qa1.y, R.qa1.z, R.qa1.w}; *(uint4*)(SLOT(9) + t * 72 + j0) = pack8(wq); }
    }
    r1_load(p, h, dir, cnext >= 0 ? cnext : c, R);
    __syncthreads();
    mm64<0, 1>(SLOT(6), SLOT(8), [=](int i0, int j, f32x4 a) {
#pragma unroll
        for (int r = 0; r < 4; ++r) fLW[(i0 + r) * 65 + j] = -0.6065306597f * sigmoid_f(sv[64 + j] + a[r]); }, lane, wave);
    mm64<0, 1>(SLOT(7), SLOT(9), [=](int i0, int j, f32x4 a) {
#pragma unroll
        for (int r = 0; r < 4; ++r) fAS[(i0 + r) * 65 + j] = sigmoid_f(sv[128 + j] + a[r]); }, lane, wave);
    __syncthreads();
#pragma unroll
    for (int j = 0; j < 8; ++j) {
        const int k = wave * 8 + j;
        const float v = wave_scan_add(fLW[lane * 65 + k], lane, dir);
        fLW[lane * 65 + k] = v;
        if (lane == (dir ? 0 : 63)) sv[k] = v;
    }
    __syncthreads();
    {
        float kkv[8], ss = 0.f;
#pragma unroll
        for (int i = 0; i < 8; ++i) { kkv[i] = k8[i] * sv[192 + j0 + i]; ss += kkv[i] * kkv[i]; }
        ss += __shfl_xor(ss, 1, 64); ss += __shfl_xor(ss, 2, 64); ss += __shfl_xor(ss, 4, 64);
        const float rn = rsqrtf(fmaxf(ss, 1e-24f));
        float fa[8], fb[8], fk[8], fr[8], fbp[8], fkp[8], bon = 0.f;
        const int tp = dir ? t + 1 : t - 1;
        const bool hasp = dir ? (t < 63) : (t > 0);
#pragma unroll
        for (int i = 0; i < 8; ++i) {
            const int k = j0 + i;
            const float Bt = fLW[t * 65 + k], Bx = hasp ? fLW[tp * 65 + k] : 0.f, asg = fAS[t * 65 + k];
            const float kk = kkv[i] * rn, kh = k8[i] * (1.f + (asg - 1.f) * sv[256 + k]);
            bon += r8[i] * kh * sv[320 + k];
            const float enB = fexp(-Bt), eLB = fexp(sv[k] - Bt), bv = kk * asg;
            fa[i] = -kk * fexp(Bx); fb[i] = bv * enB; fk[i] = kh * enB; fr[i] = r8[i] * fexp(Bt); fbp[i] = bv * eLB; fkp[i] = kh * eLB;
        }
        bon += __shfl_xor(bon, 1, 64); bon += __shfl_xor(bon, 2, 64); bon += __shfl_xor(bon, 4, 64);
        if ((tid & 7) == 0) BONS[((size_t)dir * TB + s) * 8 + h] = bon;
        *(uint4*)(SLOT(0) + t * 72 + j0) = pack8(fa); *(uint4*)(SLOT(1) + t * 72 + j0) = pack8(fb); *(uint4*)(SLOT(2) + t * 72 + j0) = pack8(fk);
        *(uint4*)(SLOT(3) + t * 72 + j0) = pack8(fr); *(uint4*)(SLOT(4) + t * 72 + j0) = pack8(fbp); *(uint4*)(SLOT(5) + t * 72 + j0) = pack8(fkp);
    }
    __syncthreads();
    *(uint4*)(SLOT(6) + t * 72 + j0) = pack8(v8);
    __syncthreads();
    mm64<0, 0>(SLOT(0), SLOT(1), [=](int i0, int j, f32x4 a) {
        float m[4];
#pragma unroll
        for (int r = 0; r < 4; ++r) { const bool keep = dir ? (j > i0 + r) : (j < i0 + r); m[r] = keep ? a[r] : 0.f; }
        const bool dg = (i0 >> 4) == (j >> 4);
        st_img(SLOT(7), i0, j, dg ? m[0] : 0.f, dg ? m[1] : 0.f, dg ? m[2] : 0.f, dg ? m[3] : 0.f);
        st_img(SLOT(8), i0, j, (dg ? m[0] : 0.f) + (j == i0 ? 1.f : 0.f), (dg ? m[1] : 0.f) + (j == i0 + 1 ? 1.f : 0.f), (dg ? m[2] : 0.f) + (j == i0 + 2 ? 1.f : 0.f), (dg ? m[3] : 0.f) + (j == i0 + 3 ? 1.f : 0.f));
        st_img(SLOT(12), i0, j, dg ? 0.f : m[0], dg ? 0.f : m[1], dg ? 0.f : m[2], dg ? 0.f : m[3]); }, lane, wave);
    mm64<0, 0>(SLOT(0), SLOT(2), [=](int i0, int j, f32x4 a) {
        float m[4];
#pragma unroll
        for (int r = 0; r < 4; ++r) { const bool keep = dir ? (j > i0 + r) : (j < i0 + r); m[r] = keep ? a[r] : 0.f; }
        st_img(SLOT(9), i0, j, m[0], m[1], m[2], m[3]); }, lane, wave);
    mm64<0, 0>(SLOT(3), SLOT(1), [=](int i0, int j, f32x4 a) {
        float m[4];
#pragma unroll
        for (int r = 0; r < 4; ++r) { const bool keep = dir ? (j >= i0 + r) : (j <= i0 + r); m[r] = keep ? a[r] : 0.f; }
        st_img(SLOT(10), i0, j, m[0], m[1], m[2], m[3]); }, lane, wave);
    mm64<0, 0>(SLOT(3), SLOT(2), [=](int i0, int j, f32x4 a) {
        float m[4];
#pragma unroll
        for (int r = 0; r < 4; ++r) { const bool keep = dir ? (j >= i0 + r) : (j <= i0 + r); m[r] = keep ? a[r] : 0.f; }
        st_img(SLOT(11), i0, j, m[0], m[1], m[2], m[3]); }, lane, wave);
    __syncthreads();
    {
        bf16_t* Pc = SLOT(7); bf16_t* Pn = SLOT(1); bf16_t* Tc = SLOT(8); bf16_t* Tn = SLOT(2);
#pragma unroll 1
        for (int it = 0; it < 3; ++it) {
            mm64<0, 1>(Pc, Pc, [=](int i0, int j, f32x4 a) { st_img(Pn, i0, j, a[0], a[1], a[2], a[3]); }, lane, wave);
            __syncthreads();
            mm64<0, 1>(Tc, Pn, [=](int i0, int j, f32x4 a) {
                st_img(Tn, i0, j, a[0] + bf2f(Tc[(i0 + 0) * 72 + j]), a[1] + bf2f(Tc[(i0 + 1) * 72 + j]), a[2] + bf2f(Tc[(i0 + 2) * 72 + j]), a[3] + bf2f(Tc[(i0 + 3) * 72 + j])); }, lane, wave);
            __syncthreads();
            bf16_t* tmp = Pc; Pc = Pn; Pn = tmp; tmp = Tc; Tc = Tn; Tn = tmp;
        }
    }
    mm64<0, 1>(SLOT(2), SLOT(12), [=](int i0, int j, f32x4 a) { st_img(SLOT(7), i0, j, a[0], a[1], a[2], a[3]); }, lane, wave);
    mm64<0, 1>(SLOT(2), SLOT(0), [=](int i0, int j, f32x4 a) { st_img(SLOT(1), i0, j, a[0], a[1], a[2], a[3]); }, lane, wave);
    mm64<0, 1>(SLOT(9), SLOT(6), [=](int i0, int j, f32x4 a) { st_img(SLOT(13), i0, j, a[0], a[1], a[2], a[3]); }, lane, wave);
    __syncthreads();
    mm64<0, 1>(SLOT(2), SLOT(13), [=](int i0, int j, f32x4 a) { st_img(SLOT(8), i0, j, a[0], a[1], a[2], a[3]); }, lane, wave);
    __syncthreads();
    {
        const bf16_t* Zp = (wave < 4) ? SLOT(1) : SLOT(8);
        bf16_t* Xi = (wave < 4) ? SLOT(12) : SLOT(9);
        const int ct = (wave & 3) * 16, g4 = (lane >> 4) * 4, l15 = lane & 15;
#pragma unroll
        for (int bs = 0; bs < 4; ++bs) {
            const int bi = dir ? 3 - bs : bs;
            f32x4 acc;
#pragma unroll
            for (int r = 0; r < 4; ++r) acc[r] = bf2f(Zp[(bi * 16 + g4 + r) * 72 + ct + l15]);
            const bool k0 = dir ? (bi == 0) : (bi >= 1), k1 = dir ? (bi <= 2) : (bi == 3);
            if (k0) acc = __builtin_amdgcn_mfma_f32_16x16x32_bf16(row_frag(SLOT(7), 72, bi * 16, 0, lane), tr_frag(Xi, 72, 0, ct, lane), acc, 0, 0, 0);
            if (k1) acc = __builtin_amdgcn_mfma_f32_16x16x32_bf16(row_frag(SLOT(7), 72, bi * 16, 32, lane), tr_frag(Xi, 72, 32, ct, lane), acc, 0, 0, 0);
            st_img(Xi, bi * 16 + g4, ct + l15, acc[0], acc[1], acc[2], acc[3]);
            __syncthreads();
        }
    }
    mm64<1, 1>(SLOT(12), SLOT(4), [=](int i0, int j, f32x4 a) {
        float m[4];
#pragma unroll
        for (int r = 0; r < 4; ++r) m[r] = a[r] + ((i0 + r) == j ? fexp(sv[j]) : 0.f);
        *(uint2*)(RU + j * 64 + i0) = make_uint2(pack2bf(m[0], m[1]), pack2bf(m[2], m[3])); }, lane, wave);
    mm64x2<1, 1>(SLOT(4), SLOT(9), SLOT(5), SLOT(6), [=](int i0, int j, f32x4 a) {
        *(uint2*)(RU + 4096 + j * 64 + i0) = make_uint2(pack2bf(a[0], a[1]), pack2bf(a[2], a[3])); }, lane, wave);
    mm64<1, 0>(SLOT(12), SLOT(10), [=](int i0, int j, f32x4 a) {
        const uint2 rr = *(const uint2*)(SLOT(3) + j * 72 + i0);
        *(uint2*)(RU + 8192 + j * 64 + i0) = make_uint2(pack2bf(a[0] + bflo(rr.x), a[1] + bfhi(rr.x)), pack2bf(a[2] + bflo(rr.y), a[3] + bfhi(rr.y))); }, lane, wave);
    mm64x2<0, 1>(SLOT(10), SLOT(9), SLOT(11), SLOT(6), [=](int i0, int j, f32x4 a) {
        *(uint2*)(RU + 12288 + j * 64 + i0) = make_uint2(pack2bf(a[0], a[1]), pack2bf(a[2], a[3])); }, lane, wave);
#undef SLOT
}

#define R2_LOAD(M_, C_, rnd_) do { const int r0_ = ((rnd_) < R2_NR ? (rnd_) : R2_NR - 1) * R2_RS; \
    _Pragma("unroll") for (int s_ = 0; s_ < R2_RS; ++s_) M_[s_] = *(const uint4*)(RU + (size_t)(chain * NCH + chunk_at(dir, r0_ + s_)) * 16384 + tid * 8); \
    _Pragma("unroll") for (int j_ = 0; j_ < 3; ++j_) { const int cq_ = tid + 512 * j_; \
        C_[j_] = *(const uint4*)(RU + (size_t)(chain * NCH + chunk_at(dir, r0_ + (cq_ >> 7))) * 16384 + 4096 + (vblk * 16 + ((cq_ >> 3) & 15)) * 64 + (cq_ & 7) * 8); } } while (0)
#define R2_ROUND(M_, C_, rnd_) do { \
    { const int row_ = tid >> 3, c8_ = tid & 7, sw_ = (row_ >> 1) & 7, u0_ = (c8_ >> 2) * 4 + (c8_ & 1) * 2, eh_ = ((c8_ >> 1) & 1) * 8; \
      _Pragma("unroll") for (int s_ = 0; s_ < R2_RS; ++s_) { char* sl_ = ring + s_ * 10240 + row_ * 128 + eh_; \
          *(uint2*)(sl_ + ((u0_ ^ sw_) * 16)) = make_uint2(M_[s_].x, M_[s_].y); *(uint2*)(sl_ + (((u0_ + 1) ^ sw_) * 16)) = make_uint2(M_[s_].z, M_[s_].w); } \
      _Pragma("unroll") for (int j_ = 0; j_ < 3; ++j_) { const int cq_ = tid + 512 * j_, rw_ = (cq_ >> 3) & 15, q8_ = cq_ & 7, i_ = q8_ >> 1, g0_ = (q8_ & 1) * 2, sc_ = (rw_ >> 1) & 7; \
          char* sl_ = ring + (cq_ >> 7) * 10240 + 8192 + rw_ * 128 + (i_ & 1) * 8; \
          *(uint2*)(sl_ + (((g0_ * 2 + (i_ >> 1)) ^ sc_) * 16)) = make_uint2(C_[j_].x, C_[j_].y); *(uint2*)(sl_ + ((((g0_ + 1) * 2 + (i_ >> 1)) ^ sc_) * 16)) = make_uint2(C_[j_].z, C_[j_].w); } } \
    R2_LOAD(M_, C_, (rnd_) + 2); \
    __syncthreads(); \
    if (wave == 0) { \
        _Pragma("unroll 4") for (int s_ = 0; s_ < R2_RS; ++s_) { \
            const int c_ = chunk_at(dir, (rnd_) * R2_RS + s_); const char* sl_ = ring + s_ * 10240; \
            unsigned pk_[4][2]; \
            _Pragma("unroll") for (int i_ = 0; i_ < 4; ++i_) { pk_[i_][0] = pack2bf(st[i_][0], st[i_][1]); pk_[i_][1] = pack2bf(st[i_][2], st[i_][3]); } \
            bf16_t* sp_ = S0G + ((size_t)(chain * NCH + c_) * 64 + vblk * 16 + l15) * 64 + g * 4; \
            _Pragma("unroll") for (int i_ = 0; i_ < 4; ++i_) *(uint2*)(sp_ + i_ * 16) = make_uint2(pk_[i_][0], pk_[i_][1]); \
            bf16x8 bfr_[2]; \
            _Pragma("unroll") for (int ks_ = 0; ks_ < 2; ++ks_) { const uint4 u_ = make_uint4(pk_[2 * ks_][0], pk_[2 * ks_][1], pk_[2 * ks_ + 1][0], pk_[2 * ks_ + 1][1]); bfr_[ks_] = __builtin_bit_cast(bf16x8, u_); } \
            const uint4 c01_ = *(const uint4*)(sl_ + 8192 + l15 * 128 + (((g * 2) ^ ((l15 >> 1) & 7)) * 16)), c23_ = *(const uint4*)(sl_ + 8192 + l15 * 128 + (((g * 2 + 1) ^ ((l15 >> 1) & 7)) * 16)); \
            const unsigned cw_[8] = {c01_.x, c01_.y, c01_.z, c01_.w, c23_.x, c23_.y, c23_.z, c23_.w}; \
            _Pragma("unroll") for (int i_ = 0; i_ < 4; ++i_) { \
                f32x4 acc_ = (f32x4){bflo(cw_[2 * i_]), bfhi(cw_[2 * i_]), bflo(cw_[2 * i_ + 1]), bfhi(cw_[2 * i_ + 1])}; \
                _Pragma("unroll") for (int ks_ = 0; ks_ < 2; ++ks_) { \
                    const int row_ = i_ * 16 + l15; \
                    const bf16x8 af_ = *(const bf16x8*)(sl_ + row_ * 128 + (((ks_ * 4 + g) ^ ((row_ >> 1) & 7)) * 16)); \
                    acc_ = __builtin_amdgcn_mfma_f32_16x16x32_bf16(af_, bfr_[ks_], acc_, 0, 0, 0); } \
                st[i_] = acc_; } } } \
    __syncthreads(); } while (0)
DEV void rwkv2_unit(const Params& p, int chain, int vblk, float* sm) {
    constexpr int R2_RS = 12, R2_NR = NCH / R2_RS;
    static_assert(R2_NR * R2_RS == NCH && R2_RS * 10240 <= LDS_BYTES, "R2 ring");
    const int tid = opaque_tid(), lane = tid & 63, wave = tid >> 6;
    const bf16_t* RU = (const bf16_t*)(p.ws + OFF_RU);
    bf16_t* S0G = (bf16_t*)(p.ws + OFF_RS0);
    char* ring = (char*)sm;
    const int dir = chain & 1, g = lane >> 4, l15 = lane & 15;
    f32x4 st[4];
#pragma unroll
    for (int i = 0; i < 4; ++i) st[i] = (f32x4){0.f, 0.f, 0.f, 0.f};
    uint4 ma[R2_RS], ca[3], mb[R2_RS], cb[3];
    __syncthreads();
    R2_LOAD(ma, ca, 0); R2_LOAD(mb, cb, 1);
#pragma unroll 1
    for (int rnd = 0; rnd < R2_NR; rnd += 2) {
        R2_ROUND(ma, ca, rnd);
        if (rnd + 1 < R2_NR) R2_ROUND(mb, cb, rnd + 1);
    }
}
#undef R2_LOAD
#undef R2_ROUND

DEV void rwkv3_unit(const Params& p, int h, int c, float* sm) {
    const int tid = opaque_tid(), lane = tid & 63, wave = tid >> 6;
    const bf16_t* P0 = (const bf16_t*)(p.ws + OFF_P0);
    const bf16_t* RUb = (const bf16_t*)(p.ws + OFF_RU);
    const bf16_t* S0G = (const bf16_t*)(p.ws + OFF_RS0);
    const float* BONS = (const float*)(p.ws + OFF_BONS);
    bf16_t* YC = (bf16_t*)(p.ws + OFF_YC);
    const float* mu = p.in[15]; const float* gn_g = p.in[27]; const float* gn_b = p.in[28];
    bf16_t* img = (bf16_t*)sm;
    float* O = sm + 4 * 2304;
    const int t = tid >> 3, v0 = (tid & 7) * 8, s = c * 64 + t;
    const size_t u0 = (size_t)((h * 2 + 0) * NCH + c), u1 = (size_t)((h * 2 + 1) * NCH + c);
    const uint4 gr0 = *(const uint4*)(RUb + u0 * 16384 + 8192 + t * 64 + v0), gs0 = *(const uint4*)(S0G + u0 * 4096 + t * 64 + v0);
    const uint4 gr1 = *(const uint4*)(RUb + u1 * 16384 + 8192 + t * 64 + v0), gs1 = *(const uint4*)(S0G + u1 * 4096 + t * 64 + v0);
    uint2 yl[2][2];
#pragma unroll
    for (int q = 0; q < 2; ++q) { const int idx = wave * 2 + q, ti = idx >> 2, tj = idx & 3;
        yl[q][0] = *(const uint2*)(RUb + u0 * 16384 + 12288 + (tj * 16 + (lane & 15)) * 64 + ti * 16 + (lane >> 4) * 4);
        yl[q][1] = *(const uint2*)(RUb + u1 * 16384 + 12288 + (tj * 16 + (lane & 15)) * 64 + ti * 16 + (lane >> 4) * 4); }
    const RwNb nbq = rw_nb(s);
    const RwRaw wv_ = rw_load(P0, s, nbq, 1024 + h * 64 + v0), wg_ = rw_load(P0, s, nbq, 1536 + h * 64 + v0);
    const float bon = BONS[(size_t)s * 8 + h] + BONS[((size_t)TB + s) * 8 + h];
    __syncthreads();
    *(uint4*)(img + 0 * 4608 + t * 72 + v0) = gr0; *(uint4*)(img + 2 * 4608 + t * 72 + v0) = gs0;
    *(uint4*)(img + 1 * 4608 + t * 72 + v0) = gr1; *(uint4*)(img + 3 * 4608 + t * 72 + v0) = gs1;
    __syncthreads();
#pragma unroll
    for (int q = 0; q < 2; ++q) {
        const int idx = wave * 2 + q, ti = idx >> 2, tj = idx & 3;
        f32x4 accd[2];
#pragma unroll
        for (int dir = 0; dir < 2; ++dir) {
            f32x4 acc = (f32x4){bflo(yl[q][dir].x), bfhi(yl[q][dir].x), bflo(yl[q][dir].y), bfhi(yl[q][dir].y)};
#pragma unroll
            for (int ks = 0; ks < 2; ++ks) acc = __builtin_amdgcn_mfma_f32_16x16x32_bf16(row_frag(img + dir * 4608, 72, ti * 16, ks * 32, lane), row_frag(img + (2 + dir) * 4608, 72, tj * 16, ks * 32, lane), acc, 0, 0, 0);
            accd[dir] = acc;
        }
#pragma unroll
        for (int r = 0; r < 4; ++r) {
            const int oi = (ti * 16 + (lane >> 4) * 4 + r) * 68 + tj * 16 + (lane & 15);
            O[oi] = accd[0][r] + accd[1][r];
        }
    }
    __syncthreads();
    {
        float y[8], sum = 0.f;
#pragma unroll
        for (int i = 0; i < 8; ++i) { y[i] = O[t * 68 + v0 + i]; sum += y[i]; }
        sum += __shfl_xor(sum, 1, 64); sum += __shfl_xor(sum, 2, 64); sum += __shfl_xor(sum, 4, 64);
        const float mean = sum * (1.f / 64.f);
        float sq = 0.f;
#pragma unroll
        for (int i = 0; i < 8; ++i) { y[i] -= mean; sq += y[i] * y[i]; }
        sq += __shfl_xor(sq, 1, 64); sq += __shfl_xor(sq, 2, 64); sq += __shfl_xor(sq, 4, 64);
        const float rstd = rsqrtf(sq * (1.f / 64.f) + 64e-5f);
        float vm[8], gm[8];
        rw_comb(wv_, nbq, mu, 1024 + h * 64 + v0, vm);
        rw_comb(wg_, nbq, mu, 1536 + h * 64 + v0, gm);
        float o[8];
#pragma unroll
        for (int i = 0; i < 8; ++i) o[i] = (y[i] * rstd * gn_g[h * 64 + v0 + i] + gn_b[h * 64 + v0 + i] + bon * vm[i]) * silu_f(gm[i]);
        *(uint4*)(YC + (size_t)s * 1024 + 512 + h * 64 + v0) = pack8(o);
    }
}

DEV void ln_rows(const float* src, const float* res_lat, const float* res_cx, int nrows, const float* __restrict__ g, const float* __restrict__ bt, float* dst_lat, float* dst_cx, int ncx,
                 bf16_t* hb = nullptr, const float* mvc = nullptr, const float* mvl = nullptr) {
    const int tid_ = opaque_tid(); const int lane = tid_ & 63, gw = blockIdx.x * NWV + (tid_ >> 6), ngw = gridDim.x * NWV;
    for (int r = gw; r < nrows; r += ngw) {
        const float* x = src + (size_t)r * 1024;
        float4 v[4];
        float sum = 0.f;
        const float* xr = (r < ncx) ? (res_cx + (size_t)r * 1024) : (res_lat + (size_t)(r - ncx) * 1024);
#pragma unroll
        for (int i = 0; i < 4; ++i) { const float4 a = ld4(x + i * 256 + lane * 4), rr = ld4(xr + i * 256 + lane * 4);
            v[i] = make_float4(ALPHA * rr.x + a.x, ALPHA * rr.y + a.y, ALPHA * rr.z + a.z, ALPHA * rr.w + a.w); sum += v[i].x + v[i].y + v[i].z + v[i].w; }
        const float mean = wave_sum(sum) * (1.f / 1024.f);
        float sq = 0.f;
#pragma unroll
        for (int i = 0; i < 4; ++i) {
            v[i].x -= mean; v[i].y -= mean; v[i].z -= mean; v[i].w -= mean;
            sq += v[i].x * v[i].x + v[i].y * v[i].y + v[i].z * v[i].z + v[i].w * v[i].w;
        }
        const float rstd = rsqrtf(wave_sum(sq) * (1.f / 1024.f) + 1e-5f);
        float* d = (r < ncx) ? (dst_cx + (size_t)r * 1024) : (dst_lat + (size_t)(r - ncx) * 1024);
#pragma unroll
        for (int i = 0; i < 4; ++i) {
            const int c = i * 256 + lane * 4;
            const float4 gg = ld4(g + c), bb = ld4(bt + c);
            const float4 y = make_float4(v[i].x * rstd * gg.x + bb.x, v[i].y * rstd * gg.y + bb.y, v[i].z * rstd * gg.z + bb.z, v[i].w * rstd * gg.w + bb.w);
            st4(d + c, y);
            if (hb != nullptr) {
                const float* m = (r < ncx) ? mvc : mvl;
                const float4 sh = ld4(m + c), sc = ld4(m + 1024 + c);
                *(uint2*)(hb + (size_t)r * 1024 + c) = make_uint2(pack2bf(y.x * (1.f + sc.x) + sh.x, y.y * (1.f + sc.y) + sh.y), pack2bf(y.z * (1.f + sc.z) + sh.z, y.w * (1.f + sc.w) + sh.w));
            }
        }
    }
}
DEV void phase_h1l(const Params& p) {
    const float* modv1 = (const float*)(p.ws + OFF_MODV) + 3 * 3072;
    bf16_t* H1 = (bf16_t*)(p.ws + OFF_H1B);
    const size_t gt = (size_t)blockIdx.x * NTHR + opaque_tid(), gn = (size_t)gridDim.x * NTHR;
    for (size_t i = gt; i < (size_t)NB * NL * 128; i += gn) {
        const size_t r = i >> 7; const int k = (int)(i & 127) * 8;
        const float* m = modv1 + (r >= (size_t)NL ? 1 : 0) * 3072;
        const float4 x0 = ld4(p.out + r * DM + k), x1 = ld4(p.out + r * DM + k + 4);
        const float4 s0 = ld4(m + k), s1 = ld4(m + k + 4), c0 = ld4(m + 1024 + k), c1 = ld4(m + 1024 + k + 4);
        *(uint4*)(H1 + r * DM + k) = make_uint4(pack2bf(x0.x * (1.f + c0.x) + s0.x, x0.y * (1.f + c0.y) + s0.y), pack2bf(x0.z * (1.f + c0.z) + s0.z, x0.w * (1.f + c0.w) + s0.w),
                                                pack2bf(x1.x * (1.f + c1.x) + s1.x, x1.y * (1.f + c1.y) + s1.y), pack2bf(x1.z * (1.f + c1.z) + s1.z, x1.w * (1.f + c1.w) + s1.w));
    }
}

DEV void zero_f4(float* ptr, size_t nfloat) {
    const size_t n4 = nfloat / 4;
    for (size_t i = (size_t)blockIdx.x * NTHR + opaque_tid(); i < n4; i += (size_t)gridDim.x * NTHR) ((float4*)ptr)[i] = make_float4(0.f, 0.f, 0.f, 0.f);
}

DEV void chain_ids(int& chain, int& sub) {
    const int bid = blockIdx.x, xcd = bid & 7, idx = bid >> 3;
    chain = xcd * 2 + (idx >> 4); sub = idx & 15;
}

DEV void phase_conv1(const Params& p, float* sm) {
    const bf16_t* XM = (const bf16_t*)(p.ws + OFF_XM);
    bf16_t* XC = (bf16_t*)(p.ws + OFF_XC);
    float* G16P = (float*)(p.ws + OFF_G16P);
    const bf16_t* WFT = (const bf16_t*)(p.ws + OFF_WFT);
    const float* cw = p.in[31]; const float* cbias = p.in[32];
    bf16_t* imgC = (bf16_t*)sm;
    bf16_t* imgM = imgC + 64 * 264;
    float* red = (float*)(imgM + 64 * 264);
    float* cwl = red + 1024;
    const int tid = opaque_tid(), lane = tid & 63, wave = tid >> 6, t = tid >> 3, cg = tid & 7;
    for (int u = blockIdx.x; u < NB * NCH * 4; u += gridDim.x) {
        const int ci = u >> 2, q = u & 3, b = ci / NCH, c = ci % NCH, s = c * 64 + t;
        const size_t rowbase = (size_t)b * TB;
        int nrow[9];
#pragma unroll
        for (int i = 0; i < 3; ++i)
#pragma unroll
            for (int j = 0; j < 3; ++j) {
                int ns = -1;
                if (s < NCX) { const int w2 = s + j - 1; if (i == 1 && w2 >= 0 && w2 < NCX) ns = w2; }
                else { const int n = s - NCX, rr = (n >> 6) + i - 1, w2 = (n & 63) + j - 1; if (rr >= 0 && rr < 128 && w2 >= 0 && w2 < 64) ns = NCX + rr * 64 + w2; }
                nrow[i * 3 + j] = ns;
            }
        const int tt = wave & 3, part = wave >> 2;
        f32x4 acc = (f32x4){0.f, 0.f, 0.f, 0.f};
#pragma unroll 1
        for (int half = 0; half < 2; ++half) {
            __syncthreads();
            for (int i = tid; i < 640; i += NTHR) { const int tp = i >> 6, c4 = (i & 63) * 4; st4(cwl + tp * 256 + c4, ld4((tp < 9 ? cw + tp * 2048 : cbias) + q * 512 + half * 256 + c4)); }
            __syncthreads();
#pragma unroll 2
            for (int it = 0; it < 4; ++it) {
                const int cl = it * 64 + cg * 8, c0 = q * 512 + half * 256 + cl;
                float a8[8];
                { const float4 b0 = ld4(cwl + 9 * 256 + cl), b1 = ld4(cwl + 9 * 256 + cl + 4); a8[0] = b0.x; a8[1] = b0.y; a8[2] = b0.z; a8[3] = b0.w; a8[4] = b1.x; a8[5] = b1.y; a8[6] = b1.z; a8[7] = b1.w; }
                uint4 xmc = make_uint4(0u, 0u, 0u, 0u);
#pragma unroll
                for (int tap = 0; tap < 9; ++tap) {
                    if (nrow[tap] >= 0) {
                        const uint4 xv = *(const uint4*)(XM + (rowbase + nrow[tap]) * 2048 + c0);
                        float x8[8]; unpack8(xv, x8);
                        const float4 w0 = ld4(cwl + tap * 256 + cl), w1 = ld4(cwl + tap * 256 + cl + 4);
                        a8[0] += x8[0] * w0.x; a8[1] += x8[1] * w0.y; a8[2] += x8[2] * w0.z; a8[3] += x8[3] * w0.w;
                        a8[4] += x8[4] * w1.x; a8[5] += x8[5] * w1.y; a8[6] += x8[6] * w1.z; a8[7] += x8[7] * w1.w;
                        if (tap == 4) xmc = xv;
                    }
                }
#pragma unroll
                for (int i = 0; i < 8; ++i) a8[i] = silu_f(a8[i]);
                const uint4 xcv = pack8(a8);
                *(uint4*)(XC + (rowbase + s) * 2048 + c0) = xcv;
                *(uint4*)(imgC + t * 264 + cl) = xcv;
                *(uint4*)(imgM + t * 264 + cl) = xmc;
            }
            __syncthreads();
            {
                const bf16_t* img = part ? imgM : imgC;
                const bf16_t* wrow = WFT + (size_t)(lane & 15) * 4096 + part * 2048 + q * 512 + half * 256 + (lane >> 4) * 8;
#pragma unroll
                for (int ks = 0; ks < 8; ++ks) acc = __builtin_amdgcn_mfma_f32_16x16x32_bf16(row_frag(img, 264, tt * 16, ks * 32, lane), *(const bf16x8*)(wrow + ks * 32), acc, 0, 0, 0);
            }
        }
        if (part == 1) {
#pragma unroll
            for (int r = 0; r < 4; ++r) red[(tt * 16 + (lane >> 4) * 4 + r) * 16 + (lane & 15)] = acc[r];
        }
        __syncthreads();
        if (part == 0) {
#pragma unroll
            for (int r = 0; r < 4; ++r) {
                const int tk = tt * 16 + (lane >> 4) * 4 + r;
                G16P[((size_t)q * RT + rowbase + c * 64 + tk) * 16 + (lane & 15)] = acc[r] + red[tk * 16 + (lane & 15)];
            }
        }
    }
}

DEV void gate_pair(const Params& p, size_t row, int dir, int h, float& gi, float& lf) {
    const float* G16P = (const float*)(p.ws + OFF_G16P);
    float a = 0.f, f = 0.f;
#pragma unroll
    for (int q = 0; q < 4; ++q) { a += G16P[((size_t)q * RT + row) * 16 + dir * 8 + h]; f += G16P[((size_t)q * RT + row) * 16 + dir * 8 + 4 + h]; }
    gi = a + p.in[dir ? 41 : 37][h];
    lf = logsig_f(f + p.in[dir ? 43 : 39][h]);
}

DEV void phase_x1(const Params& p, float* sm) {
    int chain, sub; chain_ids(chain, sub);
    const int b = chain >> 3, h = (chain >> 1) & 3, dir = chain & 1;
    const bf16_t* XC = (const bf16_t*)(p.ws + OFF_XC);
    float* GSC = (float*)(p.ws + OFF_GSC); float* CSC = (float*)(p.ws + OFF_CSC); float* NBUF = (float*)(p.ws + OFF_NBUF);
    const float* gtab = (const float*)(p.ws + OFF_GTAB);
    bf16_t* SMAT = (bf16_t*)(p.ws + OFF_SMAT);
    const int tid = opaque_tid(), lane = tid & 63, wave = tid >> 6;
    float* sTot = sm; float* sRef = sm + 132; float* sM0 = sm + 264; float* sBeta = sm + 400;
    for (int c = wave; c < NCH; c += NWV) {
        const size_t row = (size_t)b * TB + c * 64 + lane;
        float gi, lf; gate_pair(p, row, dir, h, gi, lf);
        const float bc = wave_scan_add(lf, lane, dir);
        const float ref = wave_max(gi - bc), tot = wave_sum(lf);
        if (lane == 0) { sTot[c] = tot; sRef[c] = ref; }
    }
    __syncthreads();
    if (tid == 0) {
        float m0 = -INFINITY;
        for (int step = 0; step < NCH; ++step) {
            const int c = chunk_at(dir, step);
            sM0[c] = m0;
            const float mx = fmaxf(m0, sRef[c]);
            if (sub == 0) { CSC[(chain * NCH + c) * 2] = fexp(m0 - mx); CSC[(chain * NCH + c) * 2 + 1] = fexp(sRef[c] - mx); }
            m0 = sTot[c] + mx;
        }
    }
    __syncthreads();
    for (int k = wave; sub + 16 * k < NCH; k += NWV) {
        const int c = sub + 16 * k;
        const size_t row = (size_t)b * TB + c * 64 + lane;
        float gi, lf; gate_pair(p, row, dir, h, gi, lf);
        const float bc = wave_scan_add(lf, lane, dir);
        const float a = gi - bc;
        const float amax = wave_scan_max(a, lane, dir);
        const float ref = sRef[c], m0 = sM0[c];
        const float mmax = fmaxf(amax, m0);
        const float mt = bc + mmax;
        const float alpha = fexp(ref - mmax), beta = fexp(a - ref), gg = fexp(m0 - mmax), em = fexp(-mt);
        st4(GSC + ((size_t)chain * TB + c * 64 + lane) * 4, make_float4(alpha, beta, gg, em));
        sBeta[k * 64 + lane] = beta;
    }
    __syncthreads();
    {
        float* part = sm + 1024;
        const int sg = tid >> 6, j8 = (tid & 63) * 8;
        for (int k = 0; sub + 16 * k < NCH; ++k) {
            const int c = sub + 16 * k;
            const bf16_t* xp = XC + ((size_t)b * TB + c * 64 + sg * 8) * 2048 + h * 512 + j8;
            float acc[8];
#pragma unroll
            for (int i = 0; i < 8; ++i) acc[i] = 0.f;
#pragma unroll
            for (int s = 0; s < 8; ++s) {
                float f[8]; unpack8(*(const uint4*)(xp + (size_t)s * 2048), f);
                const float be = sBeta[k * 64 + sg * 8 + s];
#pragma unroll
                for (int i = 0; i < 8; ++i) acc[i] += be * f[i];
            }
            __syncthreads();
            st4(part + sg * 512 + j8, make_float4(acc[0], acc[1], acc[2], acc[3])); st4(part + sg * 512 + j8 + 4, make_float4(acc[4], acc[5], acc[6], acc[7]));
            __syncthreads();
            float tot = 0.f;
#pragma unroll
            for (int q = 0; q < 8; ++q) tot += part[q * 512 + tid];
            NBUF[((size_t)chain * NCH + c) * 512 + tid] = tot;
        }
    }
    bf16_t* XCs = (bf16_t*)sm;
    bf16_t* Qs = XCs + 64 * 520;
    for (int u = blockIdx.x; u < NB * 4 * NCH; u += gridDim.x) {
        const int bh = u / NCH, c = u % NCH, ub = bh >> 2, uh = bh & 3;
        __syncthreads();
#pragma unroll 2
        for (int i = 0; i < 8; ++i) {
            const int pp = tid + 512 * i, row = pp >> 6, c16 = pp & 63;
            const uint4 xv = *(const uint4*)(XC + ((size_t)ub * TB + c * 64 + row) * 2048 + uh * 512 + c16 * 8);
            float f[8]; unpack8(xv, f);
            float q[8];
#pragma unroll
            for (int bb = 0; bb < 2; ++bb) {
                const float* G = gtab + (size_t)(uh * 128 + c16 * 2 + bb) * 16;
                const float4 g0 = ld4(G), g1 = ld4(G + 4), g2 = ld4(G + 8), g3 = ld4(G + 12);
                q[bb * 4 + 0] = f[bb * 4] * g0.x + f[bb * 4 + 1] * g1.x + f[bb * 4 + 2] * g2.x + f[bb * 4 + 3] * g3.x;
                q[bb * 4 + 1] = f[bb * 4] * g0.y + f[bb * 4 + 1] * g1.y + f[bb * 4 + 2] * g2.y + f[bb * 4 + 3] * g3.y;
                q[bb * 4 + 2] = f[bb * 4] * g0.z + f[bb * 4 + 1] * g1.z + f[bb * 4 + 2] * g2.z + f[bb * 4 + 3] * g3.z;
                q[bb * 4 + 3] = f[bb * 4] * g0.w + f[bb * 4 + 1] * g1.w + f[bb * 4 + 2] * g2.w + f[bb * 4 + 3] * g3.w;
            }
            *(uint4*)(XCs + row * 520 + c16 * 8) = xv;
            *(uint4*)(Qs + row * 520 + c16 * 8) = make_uint4(pack2bf(q[0], q[1]), pack2bf(q[2], q[3]), pack2bf(q[4], q[5]), pack2bf(q[6], q[7]));
        }
        __syncthreads();
        const int st = wave & 3, tt0 = (wave >> 2) * 2;
        f32x4 a0 = (f32x4){0.f, 0.f, 0.f, 0.f}, a1 = a0;
        const bf16_t* ap = XCs + (st * 16 + (lane & 15)) * 520 + (lane >> 4) * 8;
        const bf16_t* bp0 = Qs + (tt0 * 16 + (lane & 15)) * 520 + (lane >> 4) * 8;
        const bf16_t* bp1 = bp0 + 16 * 520;
#pragma unroll
        for (int ks = 0; ks < 16; ++ks) {
            const bf16x8 af = *(const bf16x8*)(ap + ks * 32);
            a0 = __builtin_amdgcn_mfma_f32_16x16x32_bf16(af, *(const bf16x8*)(bp0 + ks * 32), a0, 0, 0, 0);
            a1 = __builtin_amdgcn_mfma_f32_16x16x32_bf16(af, *(const bf16x8*)(bp1 + ks * 32), a1, 0, 0, 0);
        }
        bf16_t* sp = SMAT + (size_t)u * 4096 + (size_t)(tt0 * 16 + (lane & 15)) * 64 + st * 16 + (lane >> 4) * 4;
        *(uint2*)sp = make_uint2(pack2bf(a0[0], a0[1]), pack2bf(a0[2], a0[3]));
        *(uint2*)(sp + 16 * 64) = make_uint2(pack2bf(a1[0], a1[1]), pack2bf(a1[2], a1[3]));
    }
}

DEV void phase_x2(const Params& p, float* sm) {
    int chain, sub; chain_ids(chain, sub);
    const int b = chain >> 3, h = (chain >> 1) & 3, dir = chain & 1;
    const bf16_t* XC = (const bf16_t*)(p.ws + OFF_XC);
    float* GSC = (float*)(p.ws + OFF_GSC); const float* CSC = (const float*)(p.ws + OFF_CSC); const float* NBUF = (const float*)(p.ws + OFF_NBUF);
    const float* gtab = (const float*)(p.ws + OFF_GTAB);
    const bf16_t* SMAT = (const bf16_t*)(p.ws + OFF_SMAT);
    const int tid = opaque_tid();
    float* sD0 = sm; float* sCf = sm + 132; float* sN0 = sm + 264; float* sN2 = sN0 + 9 * 512;
    for (int i = tid; i < NCH; i += NTHR) { sD0[i] = CSC[(chain * NCH + i) * 2]; sCf[i] = CSC[(chain * NCH + i) * 2 + 1]; }
    __syncthreads();
    {
        float n = 0.f;
        const float* nb = NBUF + (size_t)chain * NCH * 512 + tid;
#pragma unroll 4
        for (int step = 0; step < NCH; ++step) {
            const int c = chunk_at(dir, step);
            if ((c & 15) == sub) sN0[(c >> 4) * 512 + tid] = n;
            n = sD0[c] * n + sCf[c] * nb[(size_t)c * 512];
        }
    }
    __syncthreads();
    {
        const int blk = tid >> 2, cp = tid & 3;
        const float4 g = ld4(gtab + (size_t)(h * 128 + blk) * 16 + cp * 4);
        for (int k = 0; sub + 16 * k < NCH; ++k) {
            const float* n0 = sN0 + k * 512 + blk * 4;
            sN2[k * 512 + tid] = g.x * n0[0] + g.y * n0[1] + g.z * n0[2] + g.w * n0[3];
        }
    }
    __syncthreads();
    const int t = tid >> 3, part = tid & 7;
    for (int k = 0; sub + 16 * k < NCH; ++k) {
        const int c = sub + 16 * k;
        const size_t row = (size_t)b * TB + c * 64 + t;
        float dint = 0.f;
        {
            const bf16_t* xp = XC + row * 2048 + h * 512 + part * 64;
            const float* n2 = sN2 + k * 512 + part * 64;
#pragma unroll
            for (int i = 0; i < 8; ++i) {
                float f[8]; unpack8(*(const uint4*)(xp + i * 8), f);
                const float4 na = ld4(n2 + i * 8), nb2 = ld4(n2 + i * 8 + 4);
                dint += f[0] * na.x + f[1] * na.y + f[2] * na.z + f[3] * na.w + f[4] * nb2.x + f[5] * nb2.y + f[6] * nb2.z + f[7] * nb2.w;
            }
        }
        float di = 0.f;
        {
            float f[8]; unpack8(*(const uint4*)(SMAT + ((size_t)((b * 4 + h) * NCH + c)) * 4096 + t * 64 + part * 8), f);
#pragma unroll
            for (int e = 0; e < 8; ++e) {
                const int s = part * 8 + e;
                const float beta = GSC[((size_t)chain * TB + c * 64 + s) * 4 + 1];
                const bool keep = dir ? (s >= t) : (s <= t);
                di += keep ? f[e] * beta : 0.f;
            }
        }
        dint += __shfl_xor(dint, 1, 64); dint += __shfl_xor(dint, 2, 64); dint += __shfl_xor(dint, 4, 64);
        di += __shfl_xor(di, 1, 64); di += __shfl_xor(di, 2, 64); di += __shfl_xor(di, 4, 64);
        if (part == 0) {
            float* gp = GSC + ((size_t)chain * TB + c * 64 + t) * 4;
            const float4 g4 = ld4(gp);
            const float den = g4.x * di + g4.z * dint;
            gp[3] = 1.f / fmaxf(fabsf(den), g4.w);
        }
    }
}

#define MLSTM_PREFETCH(step_) do { \
    const int c_ = chunk_at(dir, (step_)); const size_t rb_ = (size_t)b * TB + (size_t)c_ * 64; \
    { const bf16_t* xb_ = XC + (rb_ + (tid >> 6)) * 2048 + h * 512 + (tid & 63) * 8; \
      rx0 = *(const uint4*)(xb_); rx1 = *(const uint4*)(xb_ + 8 * 2048); rx2 = *(const uint4*)(xb_ + 16 * 2048); rx3 = *(const uint4*)(xb_ + 24 * 2048); \
      rx4 = *(const uint4*)(xb_ + 32 * 2048); rx5 = *(const uint4*)(xb_ + 40 * 2048); rx6 = *(const uint4*)(xb_ + 48 * 2048); rx7 = *(const uint4*)(xb_ + 56 * 2048); } \
    rxm = *(const uint2*)(XM + (rb_ + ps) * 2048 + ch0 + pvb * 4); \
    rs = *(const uint4*)(SMAT + ((size_t)((b * 4 + h) * NCH + c_)) * 4096 + ps * 64 + pvb * 8); \
    rbeta = GSC[((size_t)chain * TB + c_ * 64 + ps) * 4 + 1]; \
    if (tid < 64) rsc = ld4(GSC + ((size_t)chain * TB + c_ * 64 + tid) * 4); \
    rd0 = CSC[(chain * NCH + c_) * 2]; rcf = CSC[(chain * NCH + c_) * 2 + 1]; } while (0)

DEV void phase_mlstm(const Params& p, float* sm) {
    int chain, sub; chain_ids(chain, sub);
    const int b = chain >> 3, h = (chain >> 1) & 3, dir = chain & 1;
    const bf16_t* XM = (const bf16_t*)(p.ws + OFF_XM);
    const bf16_t* XC = (const bf16_t*)(p.ws + OFF_XC);
    const bf16_t* SMAT = (const bf16_t*)(p.ws + OFF_SMAT);
    const float* GSC = (const float*)(p.ws + OFF_GSC); const float* CSC = (const float*)(p.ws + OFF_CSC);
    const float* gtab = (const float*)(p.ws + OFF_GTAB);
    bf16_t* H = (bf16_t*)(p.ws + OFF_H);
    const float* wv = p.in[35];
    char* smc = (char*)sm;
    bf16_t* XCs = (bf16_t*)smc;
    bf16_t* Cs = (bf16_t*)(smc + 66560);
    bf16_t* Vb = (bf16_t*)(smc + 66560 + 33280);
    bf16_t* Vw = Vb + 32 * 72;
    bf16_t* Sm = Vw + 32 * 72;
    float* Gs = (float*)(smc + 66560 + 33280 + 2 * 4608 + 9216);
    float* sc = Gs + 2048;
    const int tid = opaque_tid(), lane = tid & 63, wave = tid >> 6;
    for (int i = tid; i < 32 * 520 / 2; i += NTHR) ((unsigned*)Cs)[i] = 0u;
    for (int i = tid; i < 2048; i += NTHR) Gs[i] = gtab[h * 2048 + i];
    const int ps = tid >> 3, pvb = tid & 7;
    const int ch0 = h * 512 + sub * 32;
    float wvr[16];
#pragma unroll
    for (int i = 0; i < 16; ++i) wvr[i] = wv[(size_t)((ch0 >> 2) + pvb) * 16 + i];
    f32x4 accS[4][2];
#pragma unroll
    for (int i = 0; i < 4; ++i) { accS[i][0] = (f32x4){0.f, 0.f, 0.f, 0.f}; accS[i][1] = (f32x4){0.f, 0.f, 0.f, 0.f}; }
    uint4 rx0, rx1, rx2, rx3, rx4, rx5, rx6, rx7; uint2 rxm; uint4 rs; float rbeta; float4 rsc = make_float4(0.f, 0.f, 0.f, 0.f); float rd0, rcf;
    MLSTM_PREFETCH(0);
    __syncthreads();
#pragma unroll 1
    for (int step = 0; step < NCH; ++step) {
        const int c = chunk_at(dir, step);
        const float d0 = rd0, cf = rcf;
        {
            bf16_t* xd = XCs + (tid >> 6) * 520 + (tid & 63) * 8;
            *(uint4*)(xd) = rx0; *(uint4*)(xd + 8 * 520) = rx1; *(uint4*)(xd + 16 * 520) = rx2; *(uint4*)(xd + 24 * 520) = rx3;
            *(uint4*)(xd + 32 * 520) = rx4; *(uint4*)(xd + 40 * 520) = rx5; *(uint4*)(xd + 48 * 520) = rx6; *(uint4*)(xd + 56 * 520) = rx7;
        }
        {
            const float x0 = bflo(rxm.x), x1 = bfhi(rxm.x), x2 = bflo(rxm.y), x3 = bfhi(rxm.y);
#pragma unroll
            for (int d = 0; d < 4; ++d) {
                const float v = (x0 * wvr[d] + x1 * wvr[4 + d] + x2 * wvr[8 + d] + x3 * wvr[12 + d]) * rbeta;
                Vb[(pvb * 4 + d) * 72 + ps] = __builtin_bit_cast(unsigned short, (__bf16)v);
                Vw[(pvb * 4 + d) * 72 + ps] = __builtin_bit_cast(unsigned short, (__bf16)(v * cf));
            }
        }
        {
#define SMASK(q_) (((dir ? (pvb * 8 + 2 * (q_) >= ps) : (pvb * 8 + 2 * (q_) <= ps)) ? 0x0000ffffu : 0u) | ((dir ? (pvb * 8 + 2 * (q_) + 1 >= ps) : (pvb * 8 + 2 * (q_) + 1 <= ps)) ? 0xffff0000u : 0u))
            *(uint4*)(Sm + ps * 72 + pvb * 8) = make_uint4(rs.x & SMASK(0), rs.y & SMASK(1), rs.z & SMASK(2), rs.w & SMASK(3));
#undef SMASK
        }
        if (tid < 64) st4(sc + tid * 4, rsc);
        { const int nstep = (step + 1 < NCH) ? step + 1 : step; MLSTM_PREFETCH(nstep); }
        __syncthreads();
        {
            const int vt = wave & 1, tt = wave >> 1;
            f32x4 ao = (f32x4){0.f, 0.f, 0.f, 0.f}, ai = ao, ao1 = ao, ao2 = ao, ao3 = ao;
            const bf16_t* ap = Cs + (vt * 16 + (lane & 15)) * 520 + (lane >> 4) * 8;
            const bf16_t* bp = XCs + (tt * 16 + (lane & 15)) * 520 + (lane >> 4) * 8;
#pragma unroll
            for (int ks = 0; ks < 16; ks += 4) {
                ao = __builtin_amdgcn_mfma_f32_16x16x32_bf16(*(const bf16x8*)(ap + ks * 32), *(const bf16x8*)(bp + ks * 32), ao, 0, 0, 0);
                ao1 = __builtin_amdgcn_mfma_f32_16x16x32_bf16(*(const bf16x8*)(ap + (ks + 1) * 32), *(const bf16x8*)(bp + (ks + 1) * 32), ao1, 0, 0, 0);
                ao2 = __builtin_amdgcn_mfma_f32_16x16x32_bf16(*(const bf16x8*)(ap + (ks + 2) * 32), *(const bf16x8*)(bp + (ks + 2) * 32), ao2, 0, 0, 0);
                ao3 = __builtin_amdgcn_mfma_f32_16x16x32_bf16(*(const bf16x8*)(ap + (ks + 3) * 32), *(const bf16x8*)(bp + (ks + 3) * 32), ao3, 0, 0, 0);
            }
            ao = (ao + ao1) + (ao2 + ao3);
            const bf16_t* ap2 = Vb + (vt * 16 + (lane & 15)) * 72 + (lane >> 4) * 8;
            const bf16_t* bp2 = Sm + (tt * 16 + (lane & 15)) * 72 + (lane >> 4) * 8;
#pragma unroll
            for (int ks = 0; ks < 2; ++ks) ai = __builtin_amdgcn_mfma_f32_16x16x32_bf16(*(const bf16x8*)(ap2 + ks * 32), *(const bf16x8*)(bp2 + ks * 32), ai, 0, 0, 0);
            if (c >= 4) {
                const int t = tt * 16 + (lane & 15);
                const float4 s4 = ld4(sc + t * 4);
                const float h0 = (s4.x * ai[0] + s4.z * ao[0]) * s4.w, h1 = (s4.x * ai[1] + s4.z * ao[1]) * s4.w;
                const float h2 = (s4.x * ai[2] + s4.z * ao[2]) * s4.w, h3 = (s4.x * ai[3] + s4.z * ao[3]) * s4.w;
                bf16_t* hp = H + ((size_t)b * NL + (size_t)c * 64 + t - NCX) * 2048 + ch0 + vt * 16 + (lane >> 4) * 4;
                const unsigned u0 = pack2bf(h0, h1), u1 = pack2bf(h2, h3);
                __builtin_amdgcn_global_atomic_fadd_v2bf16((__attribute__((address_space(1))) s16x2*)hp, __builtin_bit_cast(s16x2, u0));
                __builtin_amdgcn_global_atomic_fadd_v2bf16((__attribute__((address_space(1))) s16x2*)(hp + 2), __builtin_bit_cast(s16x2, u1));
            }
        }
#pragma unroll
        for (int jt = 0; jt < 4; ++jt) { accS[jt][0] *= d0; accS[jt][1] *= d0; }
#pragma unroll
        for (int ks = 0; ks < 2; ++ks) {
            const bf16x8 b0 = *(const bf16x8*)(Vw + (lane & 15) * 72 + ks * 32 + (lane >> 4) * 8);
            const bf16x8 b1 = *(const bf16x8*)(Vw + (16 + (lane & 15)) * 72 + ks * 32 + (lane >> 4) * 8);
            const int row0 = ks * 32 + (lane >> 4) * 8 + ((lane & 15) >> 2);
#pragma unroll
            for (int jt = 0; jt < 4; ++jt) {
                const int col = wave * 64 + jt * 16 + (lane & 3) * 4;
                const s16x4 lo = __builtin_amdgcn_ds_read_tr16_b64_v4i16((__attribute__((address_space(3))) s16x4*)(XCs + row0 * 520 + col));
                const s16x4 hi = __builtin_amdgcn_ds_read_tr16_b64_v4i16((__attribute__((address_space(3))) s16x4*)(XCs + (row0 + 4) * 520 + col));
                const bf16x8 af = (bf16x8){lo[0], lo[1], lo[2], lo[3], hi[0], hi[1], hi[2], hi[3]};
                accS[jt][0] = __builtin_amdgcn_mfma_f32_16x16x32_bf16(af, b0, accS[jt][0], 0, 0, 0);
                accS[jt][1] = __builtin_amdgcn_mfma_f32_16x16x32_bf16(af, b1, accS[jt][1], 0, 0, 0);
            }
        }
        __syncthreads();
#pragma unroll
        for (int jt = 0; jt < 4; ++jt) {
            const int blk = wave * 16 + jt * 4 + (lane >> 4);
            const float4 g0 = ld4(Gs + blk * 16), g1 = ld4(Gs + blk * 16 + 4), g2 = ld4(Gs + blk * 16 + 8), g3 = ld4(Gs + blk * 16 + 12);
#pragma unroll
            for (int v2 = 0; v2 < 2; ++v2) {
                const f32x4 a = accS[jt][v2];
                const float o0 = g0.x * a[0] + g0.y * a[1] + g0.z * a[2] + g0.w * a[3];
                const float o1 = g1.x * a[0] + g1.y * a[1] + g1.z * a[2] + g1.w * a[3];
                const float o2 = g2.x * a[0] + g2.y * a[1] + g2.z * a[2] + g2.w * a[3];
                const float o3 = g3.x * a[0] + g3.y * a[1] + g3.z * a[2] + g3.w * a[3];
                *(uint2*)(Cs + (v2 * 16 + (lane & 15)) * 520 + blk * 4) = make_uint2(pack2bf(o0, o1), pack2bf(o2, o3));
            }
        }
    }
}

DEV void phase_finish1(const Params& p) {
    bf16_t* H = (bf16_t*)(p.ws + OFF_H);
    const bf16_t* XC = (const bf16_t*)(p.ws + OFF_XC);
    const bf16_t* Z = (const bf16_t*)(p.ws + OFF_XM);
    const float* ng = p.in[44]; const float* skip = p.in[45];
    const int tid_ = opaque_tid(); const int lane = tid_ & 63, gw = blockIdx.x * NWV + (tid_ >> 6), ngw = gridDim.x * NWV;
    for (int it = gw; it < NB * NL * 4; it += ngw) {
        const int r = it >> 2, h = it & 3, b = r >= NL ? 1 : 0, nn = r - b * NL;
        const int c0 = h * 512 + lane * 8;
        bf16_t* hp = H + (size_t)r * 2048 + c0;
        float v[8]; unpack8(*(const uint4*)hp, v);
        float sum = 0.f;
#pragma unroll
        for (int j = 0; j < 8; ++j) sum += v[j];
        const float mean = wave_sum(sum) * (1.f / 512.f);
        float sq = 0.f;
#pragma unroll
        for (int j = 0; j < 8; ++j) { v[j] -= mean; sq += v[j] * v[j]; }
        const float rstd = rsqrtf(wave_sum(sq) * (1.f / 512.f) + 1e-5f);
        float xc[8], z[8];
        unpack8(*(const uint4*)(XC + ((size_t)b * TB + NCX + nn) * 2048 + c0), xc);
        unpack8(*(const uint4*)(Z + (size_t)r * 2048 + c0), z);
        float o[8];
#pragma unroll
        for (int j = 0; j < 8; ++j) o[j] = (v[j] * rstd * ng[c0 + j] + skip[c0 + j] * xc[j]) * silu_f(z[j]);
        *(uint4*)hp = make_uint4(pack2bf(o[0], o[1]), pack2bf(o[2], o[3]), pack2bf(o[4], o[5]), pack2bf(o[6], o[7]));
    }
}

__global__ void __launch_bounds__(NTHR) fwd_kernel(Params p) {
    extern __shared__ __attribute__((aligned(16))) float sm[];
    volatile LAS unsigned* xst = (volatile LAS unsigned*)((LAS char*)sm + (LDS_BYTES - 16));
    if (threadIdx.x == 0) { xst[0] = 0u; xst[1] = 0u; }
    __syncthreads();
    const XcdBarrier xbar = xcd_barrier_post((unsigned*)(p.ws + OFF_BAR), xst);
    const int tid = opaque_tid(), lane = tid & 63, wave = tid >> 6;
    float* modv = (float*)(p.ws + OFF_MODV);
    float* X1C = (float*)(p.ws + OFF_X1C);

    phase_mod(p, sm);
    phase_tables(p);
    transpose_convert(p.in[8], 1024, EIN, 4096, (bf16_t*)(p.ws + OFF_WT0), sm);
    transpose_convert(p.in[29], 1024, 4096, 4096, (bf16_t*)(p.ws + OFF_WT1), sm);
    transpose_convert(p.in[9], 1024, 1024, 1024, (bf16_t*)(p.ws + OFF_WT2), sm);
    transpose_convert(p.in[30], 2048, 1024, 1024, (bf16_t*)(p.ws + OFF_WT3), sm);
    xcd_barrier(xbar);

#pragma unroll 1
    for (int b = 0; b < NB; ++b) {
        if (b == 0) { phase_h0(p, 0); xcd_barrier(xbar); }
        run_gemm((const bf16_t*)(p.ws + OFF_YC), (const bf16_t*)(p.ws + OFF_WT0), TB, 4096, DM, EpBf16{(bf16_t*)(p.ws + OFF_P0), EIN, EIN}, sm);
        xcd_barrier(xbar);
        {
            const int x = blockIdx.x & 7, q0 = blockIdx.x >> 3;
            R1Raw R;
            r1_consts(p, x, q0 & 1, sm);
            r1_load(p, x, q0 & 1, q0 >> 1, R);
            for (int q = q0; q < 3 * NCH; q += 32) {
                if (q < 2 * NCH) rwkv1_unit(p, x, q & 1, q >> 1, sm, R, (q + 32 < 2 * NCH) ? ((q + 32) >> 1) : -1);
                else { const int q2 = q - 2 * NCH; gla1_unit(p, x >> 1, q2 & 1, (NCH / 2) * (x & 1) + (q2 >> 1), sm); }
            }
        }
        xcd_barrier(xbar);
        if (blockIdx.x < 128) gla2_unit(p, blockIdx.x);
        else if (blockIdx.x < 192) rwkv2_unit(p, (blockIdx.x - 128) >> 2, (blockIdx.x - 128) & 3, sm);
        xcd_barrier(xbar);
        for (int q = blockIdx.x >> 3; q < NCH + NCH / 2; q += 32) {
            const int x = blockIdx.x & 7;
            if (q < NCH) rwkv3_unit(p, x, q, sm);
            else gla3_unit(p, x >> 1, (NCH / 2) * (x & 1) + (q - NCH), sm);
        }
        xcd_barrier(xbar);
        run_gemm((const bf16_t*)(p.ws + OFF_YC), (const bf16_t*)(p.ws + OFF_WT2), TB, DM, DM, EpRes0{(float*)(p.ws + OFF_P0), modv, b}, sm);
        xcd_barrier(xbar);
        ln_rows((const float*)(p.ws + OFF_P0), p.in[0] + (size_t)b * NL * DM, p.in[2] + (size_t)b * NCX * DM, TB, p.in[6], p.in[7], p.out + (size_t)b * NL * DM, X1C + (size_t)b * NCX * DM, NCX,
                (bf16_t*)(p.ws + OFF_H1B) + (size_t)b * TB * DM, modv + (3 + 2) * 3072, modv + (3 + b) * 3072);
        if (b == 0) phase_h0(p, 1);
        xcd_barrier(xbar);
    }

    run_gemm((const bf16_t*)(p.ws + OFF_H1B), (const bf16_t*)(p.ws + OFF_WT1), RT, 2048, DM, EpBf16{(bf16_t*)(p.ws + OFF_XM), 2048, 2048}, sm);
    zero_f4((float*)(p.ws + OFF_H), (size_t)NB * NL * 1024);
    xcd_barrier(xbar);
    phase_conv1(p, sm);
    xcd_barrier(xbar);
    phase_x1(p, sm);
    xcd_barrier(xbar);
    phase_x2(p, sm);
    xcd_barrier(xbar);
    phase_mlstm(p, sm);
    xcd_barrier(xbar);
    phase_h1l(p);
    xcd_barrier(xbar);
    run_gemm((const bf16_t*)(p.ws + OFF_H1B), (const bf16_t*)(p.ws + OFF_WT1) + (size_t)2048 * 1024, NB * NL, 2048, DM, EpBf16{(bf16_t*)(p.ws + OFF_XM), 2048, 2048}, sm);
    xcd_barrier(xbar);
    phase_finish1(p);
    xcd_barrier(xbar);
    run_gemm((const bf16_t*)(p.ws + OFF_H), (const bf16_t*)(p.ws + OFF_WT3), NB * NL, DM, 2048, EpRes1{(float*)(p.ws + OFF_XC), modv + 3 * 3072}, sm);
    xcd_barrier(xbar);
    ln_rows((const float*)(p.ws + OFF_XC), p.out, p.out, NB * NL, p.in[6] + 1024, p.in[7] + 1024, p.out, p.out, 0);
}

extern "C" void kernel_launch(void* const* d_in, const int* in_sizes, int n_in, void* d_out, int out_size, void* d_ws, size_t ws_size, hipStream_t stream) {
    static int grid_blocks = 0;
    if (grid_blocks == 0) {
        if (ws_size < WS_NEED || n_in != 46) { fprintf(stderr, "kernel_launch: bad ws_size %zu (need %zu) or n_in %d\n", ws_size, (size_t)WS_NEED, n_in); grid_blocks = -1; return; }
        int dev = 0, cus = 0, per_cu = 0;
        (void)hipGetDevice(&dev);
        (void)hipDeviceGetAttribute(&cus, hipDeviceAttributeMultiprocessorCount, dev);
        (void)hipFuncSetAttribute((const void*)fwd_kernel, hipFuncAttributeMaxDynamicSharedMemorySize, LDS_BYTES);
        (void)hipOccupancyMaxActiveBlocksPerMultiprocessor(&per_cu, (const void*)fwd_kernel, NTHR, LDS_BYTES);
        if (per_cu < 1 || cus < 256) { fprintf(stderr, "kernel_launch: occupancy query says %d blocks/CU on %d CUs; this kernel needs 256 resident workgroups\n", per_cu, cus); grid_blocks = -1; return; }
        grid_blocks = 256;
    }
    if (grid_blocks < 0) return;
    (void)hipMemsetAsync((char*)d_ws + OFF_BAR, 0, XCD_BAR_WORDS * 4, stream);
    Params p{};
    for (int i = 0; i < 46; ++i) p.in[i] = (const float*)d_in[i];
    p.out = (float*)d_out; p.ws = (char*)d_ws;
    void* args[] = {&p};
    hipError_t e = hipLaunchCooperativeKernel((const void*)fwd_kernel, dim3(grid_blocks), dim3(NTHR), args, LDS_BYTES, stream);
    if (e != hipSuccess) fprintf(stderr, "cooperative launch failed: %s (grid %d)\n", hipGetErrorString(e), grid_blocks);
}
```

```cpp
#include <hip/hip_runtime.h>
#include <cstdio>
#include <cmath>

#define DEV __device__ __forceinline__

constexpr int NB = 2, NL = 8192, DM = 1024, NCX = 256, TB = NCX + NL;
constexpr int RT = NB * TB;
constexpr int NCH = TB / 64;
constexpr int EIN = 3872, RW0 = 1568;
constexpr int NTHR = 512, NWV = 8;
constexpr float ALPHA = 1.41421356237f;
constexpr float KSCALE = 0.04419417382f;

constexpr size_t OFF_MODV = 0;
constexpr size_t OFF_X1C  = 131072;
constexpr size_t OFF_BAR  = 3145728;
constexpr size_t OFF_BIG  = 4194304;
constexpr size_t OFF_P0   = OFF_BIG;
constexpr size_t OFF_YC   = OFF_BIG + (size_t)TB * EIN * 2;
constexpr size_t OFF_GDS  = OFF_YC + (size_t)TB * 1024 * 2;
constexpr size_t OFF_GDEC = OFF_GDS + (size_t)8 * NCH * 8192 * 4;
constexpr size_t OFF_RU   = OFF_GDEC + (size_t)8 * NCH * 64 * 4;
constexpr size_t OFF_RS0  = OFF_RU + (size_t)16 * NCH * 16384 * 2;
constexpr size_t OFF_BONS = OFF_RS0 + (size_t)16 * NCH * 4096 * 2;
constexpr size_t L0_END   = OFF_BONS + (size_t)2 * TB * 8 * 4;
constexpr size_t OFF_XM   = OFF_BIG;
constexpr size_t OFF_XC   = OFF_XM + (size_t)RT * 2048 * 2;
constexpr size_t OFF_H    = OFF_XC + (size_t)RT * 2048 * 2;
constexpr size_t OFF_WT0  = OFF_H + (size_t)NB * NL * 2048 * 2;
constexpr size_t OFF_WT1  = OFF_WT0 + (size_t)4096 * 1024 * 2;
constexpr size_t OFF_WT2  = OFF_WT1 + (size_t)4096 * 1024 * 2;
constexpr size_t OFF_WT3  = OFF_WT2 + (size_t)1024 * 1024 * 2;
constexpr size_t OFF_G16  = OFF_WT3 + (size_t)1024 * 2048 * 2;
constexpr size_t OFF_SMAT = OFF_G16 + (size_t)RT * 16 * 4;
constexpr size_t OFF_GSC  = OFF_SMAT + (size_t)NB * 4 * NCH * 4096 * 2;
constexpr size_t OFF_CSC  = OFF_GSC + (size_t)16 * TB * 4 * 4;
constexpr size_t OFF_NBUF = OFF_CSC + (size_t)16 * NCH * 2 * 4;
constexpr size_t OFF_GTAB = 3407872;
constexpr size_t OFF_WFT  = OFF_GTAB + (size_t)4 * 128 * 16 * 4;
static_assert(OFF_WFT + (size_t)16 * 4096 * 2 <= OFF_BIG, "low-region tables overflow");
constexpr size_t OFF_G16P = OFF_NBUF + (size_t)16 * NCH * 512 * 4;
constexpr size_t OFF_H1B  = OFF_G16;
constexpr size_t WS_NEED  = (OFF_G16P + (size_t)4 * RT * 16 * 4 > OFF_H1B + (size_t)RT * 1024 * 2) ? OFF_G16P + (size_t)4 * RT * 16 * 4 : OFF_H1B + (size_t)RT * 1024 * 2;
static_assert(WS_NEED <= (size_t)256 * 1024 * 1024, "workspace exceeds the guaranteed 256 MiB");

static_assert(L0_END <= OFF_WT0, "layer-0 buffers overlap the weight copies");
constexpr int LDS_BYTES = 139264;

struct Params { const float* in[46]; float* out; char* ws; };
typedef unsigned short bf16_t;
typedef __attribute__((ext_vector_type(8))) short bf16x8;
typedef __attribute__((ext_vector_type(4))) short s16x4;
typedef __attribute__((ext_vector_type(2))) short s16x2;
typedef __attribute__((ext_vector_type(4))) float f32x4;
typedef __attribute__((ext_vector_type(2))) __bf16 bf2_t;
DEV unsigned pack2bf(float lo, float hi) { bf2_t v; v[0] = (__bf16)lo; v[1] = (__bf16)hi; return __builtin_bit_cast(unsigned, v); }
DEV float bflo(unsigned u) { return __uint_as_float(u << 16); }
DEV float bfhi(unsigned u) { return __uint_as_float(u & 0xffff0000u); }
DEV float bf2f(bf16_t v) { return __uint_as_float(((unsigned)v) << 16); }
DEV void unpack8(uint4 u, float* f) { f[0] = bflo(u.x); f[1] = bfhi(u.x); f[2] = bflo(u.y); f[3] = bfhi(u.y); f[4] = bflo(u.z); f[5] = bfhi(u.z); f[6] = bflo(u.w); f[7] = bfhi(u.w); }

DEV float wave_sum(float v) {
#pragma unroll
    for (int o = 32; o > 0; o >>= 1) v += __shfl_xor(v, o, 64);
    return v;
}
DEV float wave_max(float v) {
#pragma unroll
    for (int o = 32; o > 0; o >>= 1) v = fmaxf(v, __shfl_xor(v, o, 64));
    return v;
}
DEV float fexp(float x) { return __expf(x); }
DEV float frcp(float x) { return __builtin_amdgcn_rcpf(x); }
DEV float sigmoid_f(float x) { return frcp(1.f + fexp(-x)); }
DEV float silu_f(float x) { return x * frcp(1.f + fexp(-x)); }
DEV float logsig_f(float x) { return fminf(x, 0.f) - __logf(1.f + fexp(-fabsf(x))); }
DEV float tanh_f(float x) { const float e = fexp(2.f * x); return 1.f - 2.f * frcp(e + 1.f); }
DEV void lds_fence() { asm volatile("" ::: "memory"); }
DEV int opaque_tid() { int t = threadIdx.x; asm volatile("" : "+v"(t)); return t; }
DEV int scan_s(int dir, int u) { return dir == 0 ? u : (u < NCX ? (NCX - 1 - u) : (TB - 1 + NCX - u)); }
DEV int chunk_at(int dir, int step) { return dir == 0 ? step : (step < 4 ? 3 - step : (NCH + 3 - step)); }
DEV float4 ld4(const float* p) { return *(const float4*)p; }
DEV void st4(float* p, float4 v) { *(float4*)p = v; }


#define XB_TMO      128
#define XB_XCNT(j)  (256  + 64 * (j))
#define XB_XSUB(j)  (1280 + 64 * (j))
#define XB_XGEN(j)  (2304 + 64 * (j))
#define XB_TOP      3328
#define XB_TOPGEN   3392
#define XCD_BAR_WORDS 3456
#define XB_SPIN_CAP (1u << 22)
#define LAS __attribute__((address_space(3)))
DEV unsigned xb_ld(unsigned* p) { return __hip_atomic_load(p, __ATOMIC_RELAXED, __HIP_MEMORY_SCOPE_AGENT); }
DEV unsigned xb_add(unsigned* p, unsigned v) { return __hip_atomic_fetch_add(p, v, __ATOMIC_RELAXED, __HIP_MEMORY_SCOPE_AGENT); }
DEV unsigned xb_xcc_id() { return (unsigned)__builtin_amdgcn_s_getreg((3 << 11) | 20) & 0xFu; }
#define XB_SPIN(cond, bar) do { unsigned _sp = 0; while (cond) { __builtin_amdgcn_s_sleep(1); \
    if ((++_sp & 255u) == 0u) { if (xb_ld(&(bar)[XB_TMO])) break; if (_sp > XB_SPIN_CAP) { atomicAdd(&(bar)[XB_TMO], 1u); break; } } } } while (0)
struct XcdBarrier { unsigned* bar; unsigned x; volatile LAS unsigned* st; };
DEV XcdBarrier xcd_barrier_post(unsigned* bar, volatile LAS unsigned* st) {
    XcdBarrier b; b.bar = bar; b.x = xb_xcc_id(); b.st = st;
    if (threadIdx.x == 0) (void)xb_add(&bar[XB_XCNT(b.x)], 1u);
    return b;
}
DEV void xcd_barrier_complete(unsigned* bar, unsigned x, unsigned& nloc, unsigned& nx) {
    const unsigned G = gridDim.x * gridDim.y * gridDim.z;
    unsigned sum, cnt, mine, sp = 0u;
    for (;;) {
        sum = 0u; cnt = 0u; mine = 0u;
#pragma unroll
        for (unsigned j = 0; j < 16; ++j) { const unsigned c = xb_ld(&bar[XB_XCNT(j)]); sum += c; cnt += (c > 0u) ? 1u : 0u; mine = (j == x) ? c : mine; }
        if (sum == G) break;
        __builtin_amdgcn_s_sleep(1);
        if ((++sp & 255u) == 0u) { if (xb_ld(&bar[XB_TMO])) break; if (sp > XB_SPIN_CAP) { atomicAdd(&bar[XB_TMO], 1u); break; } }
    }
    nloc = mine > 0u ? mine : 1u; nx = cnt > 0u ? cnt : 1u;
}
DEV void xcd_barrier(const XcdBarrier& b) {
    asm volatile("s_waitcnt vmcnt(0)" ::: "memory");
    __syncthreads();
    if (threadIdx.x == 0) {
        unsigned* bar = b.bar;
        __builtin_amdgcn_s_waitcnt(0);
        unsigned nloc = b.st[0], nx = b.st[1];
        if (nloc == 0u) { xcd_barrier_complete(bar, b.x, nloc, nx); b.st[0] = nloc; b.st[1] = nx; }
        const unsigned old = xb_add(&bar[XB_XSUB(b.x)], 1u);
        const unsigned gen = old / nloc;
        if (old + 1u == (gen + 1u) * nloc) {
            __builtin_amdgcn_fence(__ATOMIC_RELEASE, "agent");
            asm volatile("s_waitcnt vmcnt(0)" ::: "memory");
            const unsigned og = xb_add(&bar[XB_TOP], 1u);
            const unsigned tg = og / nx;
            if (og + 1u == (tg + 1u) * nx) xb_add(&bar[XB_TOPGEN], 1u);
            else XB_SPIN(xb_ld(&bar[XB_TOPGEN]) == tg, bar);
            __builtin_amdgcn_fence(__ATOMIC_ACQUIRE, "agent");
            xb_add(&bar[XB_XGEN(b.x)], 1u);
            asm volatile("s_waitcnt vmcnt(0)" ::: "memory");
        } else {
            XB_SPIN(xb_ld(&bar[XB_XGEN(b.x)]) == gen, bar);
            __builtin_amdgcn_fence(__ATOMIC_ACQUIRE, "agent");
            asm volatile("s_waitcnt vmcnt(0)" ::: "memory");
        }
    }
    __syncthreads();
}

namespace pg8 {
#define PG8_LAS __attribute__((address_space(3)))
typedef unsigned short bf16_t;
typedef short bf16x8 __attribute__((ext_vector_type(8)));
typedef float f32x4 __attribute__((ext_vector_type(4)));
typedef unsigned u32x4 __attribute__((ext_vector_type(4)));
constexpr int BM = 256, BK = 64, HALF = 128, HTB = HALF * BK * 2  , STAGE_BYTES = 8 * HTB, NXCD = 8, WGM = 8;

__host__ __device__ __forceinline__ int lds_byte(int r, int c) { const int st = (r >> 4) * 2 + (c >> 5), rr = r & 15, cc = c & 31, ob = rr * 64 + cc * 2; return st * 1024 + (ob ^ (((ob >> 9) & 1) << 5)); }
__host__ __device__ __forceinline__ void stage_rc(int b, int& R, int& C) { const int st = b / 1024, sb = b % 1024, swz = sb ^ (((sb >> 9) & 1) << 5); R = (st >> 1) * 16 + swz / 64; C = (st & 1) * 32 + (swz % 64) / 2; }
__host__ __device__ __forceinline__ int perm32(int rho) { const int n = rho >> 4, i = rho & 15; return 8 * (i >> 2) + 4 * n + (i & 3); }

struct Unit { int pm, pn; };
struct Gemm { const bf16_t* A; const bf16_t* Bt; int M, N, K; };

struct StaticOrder {
    int nM, nN, nwg, G, c;
    __host__ __device__ void init(int M, int N, int G_, int c_) { nM = M / BM; nN = N / BM; nwg = nM * nN; G = G_; c = c_; }
    __host__ __device__ bool next(int i, Unit& u) const {
        const long L = (long)i * G + c; if (L >= nwg) return false;
        int wgid = (int)L; { const int q = nwg / NXCD, r = nwg % NXCD, xcd = wgid % NXCD, off = wgid / NXCD; wgid = (xcd < r ? xcd * (q + 1) : r * (q + 1) + (xcd - r) * q) + off; }
        const int nig = WGM * nN, gid = wgid / nig, fm = gid * WGM, gsz = (nM - fm) < WGM ? (nM - fm) : WGM;
        u.pm = fm + ((wgid % nig) % gsz); u.pn = (wgid % nig) / gsz; return true;
    }
    __device__ __forceinline__ void a_ready(const Unit&) const {}
    __device__ __forceinline__ void done(const Unit&) const {}
};

template <class Epi, class Sched, bool STAMP = false>
__device__ __forceinline__ void gemm_phase(PG8_LAS unsigned char* lds, const Gemm g, const Sched& S, const Epi& E, unsigned long long* stamps) {
    int tid = threadIdx.x; asm volatile("" : "+v"(tid));
    const int wid = __builtin_amdgcn_readfirstlane(tid >> 6), lane = tid & 63, wr = wid >> 2, wc = wid & 3, fr = lane & 15, fq = lane >> 4;
    const int K = g.K, nt = K / BK;
#define PG8_STAMP() do { } while (0)
    PG8_STAMP();
    unsigned voffA[2], voffB[2];
#pragma unroll
    for (int i = 0; i < 2; ++i) { int R, C; stage_rc(tid * 16 + i * 8192, R, C); const int Rb = Epi::PERM ? ((R & ~31) + perm32(R & 31)) : R;
        voffA[i] = (unsigned)(R * K + C) * 2u; voffB[i] = (unsigned)(Rb * K + C) * 2u; }
    const size_t kstep = (size_t)(BK * 2);
    const size_t hstep = (size_t)HALF * K * 2;
    const size_t tstep = 2 * hstep;
    const unsigned ldsw = (unsigned)wid * 1024u;
    const int aoff = lds_byte(wr * 64 + fr, fq * 8), boff = lds_byte(wc * 32 + fr, fq * 8);
#define PG8_SA(b, h) (((b) * 2 + (h)) * HTB)
#define PG8_SB(b, h) ((4 + (b) * 2 + (h)) * HTB)
#define PG8_STAGE(bufoff, gbase, voff) do { _Pragma("unroll") for (int _i = 0; _i < 2; ++_i) \
        __builtin_amdgcn_global_load_lds((const unsigned*)((const char*)(gbase) + (voff)[_i]), (PG8_LAS unsigned*)(lds + (bufoff) + ldsw + _i * 8192), 16, 0, 0); } while (0)
#define PG8_LDA(dst, b, h) do { _Pragma("unroll") for (int m = 0; m < 4; ++m) _Pragma("unroll") for (int k = 0; k < 2; ++k) dst[m][k] = *(const PG8_LAS bf16x8*)(lds + PG8_SA(b, h) + aoff + m * 2048 + k * 1024); } while (0)
#define PG8_LDB(dst, b, h) do { _Pragma("unroll") for (int n = 0; n < 2; ++n) _Pragma("unroll") for (int k = 0; k < 2; ++k) dst[n][k] = *(const PG8_LAS bf16x8*)(lds + PG8_SB(b, h) + boff + n * 2048 + k * 1024); } while (0)
#define PG8_MMA(ai, bj, At, Bt) do { __builtin_amdgcn_s_setprio(1); _Pragma("unroll") for (int m = 0; m < 4; ++m) _Pragma("unroll") for (int n = 0; n < 2; ++n) _Pragma("unroll") for (int k = 0; k < 2; ++k) \
        acc[ai][bj][m][n] = __builtin_amdgcn_mfma_f32_16x16x32_bf16(Bt[n][k], At[m][k], acc[ai][bj][m][n], 0, 0, 0); __builtin_amdgcn_s_setprio(0); } while (0)
#define PG8_WAIT_V(n) asm volatile("s_waitcnt vmcnt(" #n ")" ::: "memory")
#define PG8_WAIT_L(n) asm volatile("s_waitcnt lgkmcnt(" #n ")" ::: "memory")
#define PG8_BAR __builtin_amdgcn_s_barrier()
#define PG8_SCHED __builtin_amdgcn_sched_barrier(0)
    Unit cur, nxt; int ui = 0;
    if (!S.next(0, cur)) return;
    f32x4 acc[2][2][4][2];
#pragma unroll
    for (int a = 0; a < 2; ++a)
#pragma unroll
        for (int b = 0; b < 2; ++b)
#pragma unroll
            for (int m = 0; m < 4; ++m)
#pragma unroll
                for (int n = 0; n < 2; ++n) acc[a][b][m][n] = (f32x4){0.f, 0.f, 0.f, 0.f};
    bf16x8 At[4][2], B0[2][2], B1[2][2];
    const char* cA = (const char*)g.A + (size_t)cur.pm * tstep; const char* cB = (const char*)g.Bt + (size_t)cur.pn * tstep;
    S.a_ready(cur);
    PG8_STAGE(PG8_SB(0, 0), cB, voffB); PG8_STAGE(PG8_SA(0, 0), cA, voffA); PG8_STAGE(PG8_SB(0, 1), cB + hstep, voffB); PG8_STAGE(PG8_SA(0, 1), cA + hstep, voffA);
    if (wr == 1) PG8_BAR;
    PG8_WAIT_V(4); PG8_BAR;
    PG8_STAGE(PG8_SB(1, 0), cB + kstep, voffB); PG8_STAGE(PG8_SA(1, 0), cA + kstep, voffA); PG8_STAGE(PG8_SB(1, 1), cB + hstep + kstep, voffB);
    PG8_WAIT_V(6); PG8_BAR;
    PG8_STAMP();
    for (;;) {
        const bool has_next = S.next(ui + 1, nxt);
        const char* nA = has_next ? (const char*)g.A + (size_t)nxt.pm * tstep : cA; const char* nB = has_next ? (const char*)g.Bt + (size_t)nxt.pn * tstep : cB;
        for (int t = 0; t < nt; t += 2) {
            const bool last = (t == nt - 2);
            const char* a1 = cA + (size_t)(t + 1) * kstep;
            const char* a2 = last ? nA : cA + (size_t)(t + 2) * kstep; const char* b2 = last ? nB : cB + (size_t)(t + 2) * kstep;
            const char* a3 = a2 + kstep; const char* b3 = b2 + kstep;
            if (last && has_next) S.a_ready(nxt);
            PG8_LDB(B0, 0, 0); PG8_SCHED; PG8_LDA(At, 0, 0); PG8_STAGE(PG8_SA(1, 1), a1 + hstep, voffA);
            PG8_WAIT_L(8); PG8_BAR; PG8_WAIT_L(0); PG8_MMA(0, 0, At, B0); PG8_BAR; PG8_SCHED;
            PG8_LDB(B1, 0, 1); PG8_STAGE(PG8_SB(0, 0), b2, voffB);
            PG8_BAR; PG8_WAIT_L(0); PG8_MMA(0, 1, At, B1); PG8_BAR;
            PG8_LDA(At, 0, 1); PG8_STAGE(PG8_SA(0, 0), a2, voffA);
            PG8_BAR; PG8_WAIT_L(0); PG8_MMA(1, 0, At, B0); PG8_BAR; PG8_SCHED;
            PG8_STAGE(PG8_SB(0, 1), b2 + hstep, voffB);
            PG8_WAIT_V(6); PG8_BAR; PG8_MMA(1, 1, At, B1); PG8_BAR;
            PG8_LDB(B0, 1, 0); PG8_SCHED; PG8_LDA(At, 1, 0); PG8_STAGE(PG8_SA(0, 1), a2 + hstep, voffA);
            PG8_WAIT_L(8); PG8_BAR; PG8_WAIT_L(0); PG8_MMA(0, 0, At, B0); PG8_BAR; PG8_SCHED;
            PG8_LDB(B1, 1, 1); PG8_STAGE(PG8_SB(1, 0), b3, voffB);
            PG8_BAR; PG8_WAIT_L(0); PG8_MMA(0, 1, At, B1); PG8_BAR;
            PG8_LDA(At, 1, 1); PG8_STAGE(PG8_SA(1, 0), a3, voffA);
            PG8_BAR; PG8_WAIT_L(0); PG8_MMA(1, 0, At, B0); PG8_BAR; PG8_SCHED;
            PG8_STAGE(PG8_SB(1, 1), b3 + hstep, voffB);
            PG8_WAIT_V(6); PG8_BAR; PG8_MMA(1, 1, At, B1); PG8_BAR;
        }
        PG8_STAMP();
        if constexpr (!Epi::AFTER_DRAIN) { E(acc, cur, wr, wc, fr, fq); S.done(cur); }
        PG8_STAMP();
        if (!has_next) break;
#pragma unroll
        for (int a = 0; a < 2; ++a)
#pragma unroll
            for (int b = 0; b < 2; ++b)
#pragma unroll
                for (int m = 0; m < 4; ++m)
#pragma unroll
                    for (int n = 0; n < 2; ++n) acc[a][b][m][n] = (f32x4){0.f, 0.f, 0.f, 0.f};
        cur = nxt; cA = nA; cB = nB; ++ui;
    }
    PG8_WAIT_V(0);
    if (wr == 0) PG8_BAR;
    PG8_BAR;
    if constexpr (Epi::AFTER_DRAIN) { E.fused(acc, cur, wr, wc, fr, fq, lds, wid, lane); S.done(cur); }
    PG8_STAMP();
#undef PG8_STAMP
#undef PG8_SA
#undef PG8_SB
#undef PG8_STAGE
#undef PG8_LDA
#undef PG8_LDB
#undef PG8_MMA
#undef PG8_WAIT_V
#undef PG8_WAIT_L
#undef PG8_BAR
#undef PG8_SCHED
}
}

DEV void transpose_convert(const float* __restrict__ W, int K, int N, int Npad, bf16_t* Wt, float* sm) {
    float (*T)[65] = (float (*)[65])sm;
    const int tid = opaque_tid();
    const int kt = K / 64, ntl = Npad / 64;
    for (int tile = blockIdx.x; tile < kt * ntl; tile += gridDim.x) {
        const int k0 = (tile / ntl) * 64, n0 = (tile % ntl) * 64;
        __syncthreads();
#pragma unroll
        for (int i = 0; i < 2; ++i) {
            const int k = (tid >> 4) + 32 * i, n4 = (tid & 15) * 4;
            float4 v = make_float4(0.f, 0.f, 0.f, 0.f);
            if (n0 + n4 < N) v = ld4(W + (size_t)(k0 + k) * N + n0 + n4);
            T[k][n4] = v.x; T[k][n4 + 1] = v.y; T[k][n4 + 2] = v.z; T[k][n4 + 3] = v.w;
        }
        __syncthreads();
        const int n = tid >> 3, kq = (tid & 7) * 8;
        unsigned o[4];
#pragma unroll
        for (int j = 0; j < 4; ++j) o[j] = pack2bf(T[kq + 2 * j][n], T[kq + 2 * j + 1][n]);
        bf16_t* dst = Wt + (size_t)(n0 + n) * K + k0 + kq;
        *(uint4*)dst = make_uint4(o[0], o[1], o[2], o[3]);
    }
}

struct EpBf16 {
    static constexpr bool PERM = true, AFTER_DRAIN = false;
    bf16_t* O; int ldc; int ncols;
    DEV void operator()(const pg8::f32x4 (&acc)[2][2][4][2], const pg8::Unit& u, int wr, int wc, int fr, int fq) const {
        const int row0 = u.pm * 256 + wr * 64 + fr, col0 = u.pn * 256 + wc * 32 + 8 * fq;
#pragma unroll
        for (int ai = 0; ai < 2; ++ai)
#pragma unroll
            for (int m = 0; m < 4; ++m) {
                bf16_t* rowp = O + (size_t)(row0 + ai * 128 + m * 16) * ldc + col0;
#pragma unroll
                for (int bj = 0; bj < 2; ++bj) {
                    if (col0 + bj * 128 < ncols) {
                        const pg8::f32x4 v0 = acc[ai][bj][m][0], v1 = acc[ai][bj][m][1];
                        *(uint4*)(rowp + bj * 128) = make_uint4(pack2bf(v0[0], v0[1]), pack2bf(v0[2], v0[3]), pack2bf(v1[0], v1[1]), pack2bf(v1[2], v1[3]));
                    }
                }
            }
    }
};
struct EpRes0 {
    static constexpr bool PERM = false, AFTER_DRAIN = false;
    float* C; const float* mv; int b;
    DEV void operator()(const pg8::f32x4 (&acc)[2][2][4][2], const pg8::Unit& u, int wr, int wc, int fr, int fq) const {
        const bool isc = (u.pm * 256 < NCX);
        const float* gp = mv + (isc ? 2 : b) * 3072 + 2048;
        const int row0 = u.pm * 256 + wr * 64 + fr, col0 = u.pn * 256 + wc * 32 + 4 * fq;
#pragma unroll
        for (int ai = 0; ai < 2; ++ai)
#pragma unroll
            for (int m = 0; m < 4; ++m) {
                const size_t ro = (size_t)(row0 + ai * 128 + m * 16) * DM + col0;
#pragma unroll
                for (int bj = 0; bj < 2; ++bj)
#pragma unroll
                    for (int n = 0; n < 2; ++n) {
                        const int co = bj * 128 + n * 16;
                        const float4 g = ld4(gp + col0 + co); const pg8::f32x4 v = acc[ai][bj][m][n];
                        st4(C + ro + co, make_float4(g.x * v[0], g.y * v[1], g.z * v[2], g.w * v[3]));
                    }
            }
    }
};
struct EpRes1 {
    static constexpr bool PERM = false, AFTER_DRAIN = false;
    float* C; const float* mv;
    DEV void operator()(const pg8::f32x4 (&acc)[2][2][4][2], const pg8::Unit& u, int wr, int wc, int fr, int fq) const {
        const float* gp = mv + (u.pm * 256 >= NL ? 1 : 0) * 3072 + 2048;
        const int row0 = u.pm * 256 + wr * 64 + fr, col0 = u.pn * 256 + wc * 32 + 4 * fq;
#pragma unroll
        for (int ai = 0; ai < 2; ++ai)
#pragma unroll
            for (int m = 0; m < 4; ++m) {
                const size_t ro = (size_t)(row0 + ai * 128 + m * 16) * DM + col0;
#pragma unroll
                for (int bj = 0; bj < 2; ++bj)
#pragma unroll
                    for (int n = 0; n < 2; ++n) {
                        const int co = bj * 128 + n * 16;
                        const float4 g = ld4(gp + col0 + co); const pg8::f32x4 v = acc[ai][bj][m][n];
                        st4(C + ro + co, make_float4(g.x * v[0], g.y * v[1], g.z * v[2], g.w * v[3]));
                    }
            }
    }
};
template <class EP>
DEV void run_gemm(const bf16_t* A, const bf16_t* Bt, int M, int N, int K, const EP& ep, float* sm) {
    pg8::Gemm g{A, Bt, M, N, K}; pg8::StaticOrder S; S.init(M, N, (int)gridDim.x, (int)blockIdx.x);
    pg8::gemm_phase<EP, pg8::StaticOrder, false>((PG8_LAS unsigned char*)sm, g, S, ep, nullptr);
}

DEV void phase_h0(const Params& p, int b) {
    const float* modv = (const float*)(p.ws + OFF_MODV);
    bf16_t* H0 = (bf16_t*)(p.ws + OFF_YC);
    const int gt = blockIdx.x * NTHR + opaque_tid(), gn = gridDim.x * NTHR;
    for (int i = gt; i < TB * 128; i += gn) {
        const int s = i >> 7, k = (i & 127) * 8;
        const float* src; int j;
        if (s < NCX) { src = p.in[2] + ((size_t)(b * NCX + s)) * DM + k; j = 2; }
        else { src = p.in[0] + ((size_t)(b * NL + s - NCX)) * DM + k; j = b; }
        const float4 x0 = ld4(src), x1 = ld4(src + 4);
        const float* m = modv + j * 3072;
        const float4 s0 = ld4(m + k), s1 = ld4(m + k + 4), c0 = ld4(m + 1024 + k), c1 = ld4(m + 1024 + k + 4);
        *(uint4*)(H0 + (size_t)s * DM + k) = make_uint4(pack2bf(x0.x * (1.f + c0.x) + s0.x, x0.y * (1.f + c0.y) + s0.y), pack2bf(x0.z * (1.f + c0.z) + s0.z, x0.w * (1.f + c0.w) + s0.w),
                                                      pack2bf(x1.x * (1.f + c1.x) + s1.x, x1.y * (1.f + c1.y) + s1.y), pack2bf(x1.z * (1.f + c1.z) + s1.z, x1.w * (1.f + c1.w) + s1.w));
    }
}

DEV void phase_mod(const Params& p, float* sm) {
    const float* c = p.in[1]; const float* cctx = p.in[3];
    const float* mod_w = p.in[4]; const float* mod_b = p.in[5];
    float* modv = (float*)(p.ws + OFF_MODV);
    float* sil = sm; float* red = sm + 3072;
    const int tid = opaque_tid();
    for (int i = tid; i < 3072; i += NTHR) {
        const int j = i >> 10, k = i & 1023;
        const float v = (j < 2) ? c[j * 1024 + k] : cctx[k];
        sil[i] = silu_f(v);
    }
    __syncthreads();
    for (int unit = blockIdx.x; unit < 192; unit += gridDim.x) {
        const int l = unit / 96, cb = unit % 96;
        const int kg = tid >> 5, col = tid & 31, n = cb * 32 + col;
        const float* w = mod_w + (size_t)l * 1024 * 3072 + n;
        float a0 = 0.f, a1 = 0.f, a2 = 0.f;
        for (int k = kg * 64; k < kg * 64 + 64; ++k) {
            const float wv = w[(size_t)k * 3072];
            a0 += sil[k] * wv; a1 += sil[1024 + k] * wv; a2 += sil[2048 + k] * wv;
        }
        red[(kg * 3 + 0) * 32 + col] = a0; red[(kg * 3 + 1) * 32 + col] = a1; red[(kg * 3 + 2) * 32 + col] = a2;
        __syncthreads();
        if (tid < 96) {
            const int j = tid >> 5, cc = tid & 31, nn = cb * 32 + cc;
            float s = mod_b[l * 3072 + nn];
            for (int g = 0; g < 16; ++g) s += red[(g * 3 + j) * 32 + cc];
            modv[(l * 3 + j) * 3072 + nn] = s;
        }
        __syncthreads();
    }
}

DEV void phase_tables(const Params& p) {
    const float* wq = p.in[33]; const float* wk = p.in[34]; const float* wv = p.in[35];
    const float* gw0 = p.in[36]; const float* gw1 = p.in[38]; const float* gw2 = p.in[40]; const float* gw3 = p.in[42];
    float* gtab = (float*)(p.ws + OFF_GTAB); bf16_t* wft = (bf16_t*)(p.ws + OFF_WFT);
    const int gt = blockIdx.x * NTHR + opaque_tid(), gn = gridDim.x * NTHR;
    for (int i = gt; i < 512 * 16; i += gn) {
        const int gb = i >> 4, cp = (i >> 2) & 3, c = i & 3;
        float s = 0.f;
#pragma unroll
        for (int d = 0; d < 4; ++d) s += wq[gb * 16 + cp * 4 + d] * wk[gb * 16 + c * 4 + d];
        gtab[i] = s * KSCALE;
    }
    for (int i = gt; i < 4096 * 16; i += gn) {
        const int g = i >> 12, k = i & 4095, gm = g >> 2, hd = g & 3;
        const float* wg = gm == 0 ? gw0 : (gm == 1 ? gw1 : (gm == 2 ? gw2 : gw3));
        float s = 0.f;
        if (k < 2048) {
            const int blk = k >> 2, cc = k & 3;
#pragma unroll
            for (int d = 0; d < 4; ++d) s += wq[blk * 16 + cc * 4 + d] * wg[(size_t)(4 * blk + d) * 4 + hd] + wk[blk * 16 + cc * 4 + d] * wg[(size_t)(2048 + 4 * blk + d) * 4 + hd];
        } else {
            const int kk = k - 2048, blk = kk >> 2, cc = kk & 3;
#pragma unroll
            for (int d = 0; d < 4; ++d) s += wv[blk * 16 + cc * 4 + d] * wg[(size_t)(4096 + 4 * blk + d) * 4 + hd];
        }
        wft[i] = __builtin_bit_cast(unsigned short, (__bf16)s);
    }
}

DEV float wave_scan_add(float v, int lane, int dir) {
#pragma unroll
    for (int o = 1; o < 64; o <<= 1) {
        const float n = dir ? __shfl_down(v, o, 64) : __shfl_up(v, o, 64);
        const bool ok = dir ? (lane + o < 64) : (lane >= o);
        if (ok) v += n;
    }
    return v;
}
DEV float wave_scan_max(float v, int lane, int dir) {
#pragma unroll
    for (int o = 1; o < 64; o <<= 1) {
        const float n = dir ? __shfl_down(v, o, 64) : __shfl_up(v, o, 64);
        const bool ok = dir ? (lane + o < 64) : (lane >= o);
        if (ok) v = fmaxf(v, n);
    }
    return v;
}

DEV void gla_decay(const bf16_t* P0, int c, int h, int dir, const float* __restrict__ wa2, const float* __restrict__ ba,
                   float* sLR, float* sWA, float* sBC, float* sTot, int tid) {
    for (int i = tid; i < 1024; i += NTHR) { const int t = i >> 4, j = i & 15; sLR[i] = bf2f(P0[(size_t)(c * 64 + t) * EIN + 1536 + dir * 16 + j]); }
    for (int i = tid; i < 1024; i += NTHR) { const int ii = i >> 6, k = i & 63; sWA[i] = wa2[ii * 256 + h * 64 + k]; }
    __syncthreads();
    {
        const int t = tid >> 3, k0 = (tid & 7) * 8;
        float acc[8];
#pragma unroll
        for (int j = 0; j < 8; ++j) acc[j] = ba[h * 64 + k0 + j];
#pragma unroll
        for (int ii = 0; ii < 16; ++ii) {
            const float l = sLR[t * 16 + ii];
#pragma unroll
            for (int j = 0; j < 8; ++j) acc[j] += l * sWA[ii * 64 + k0 + j];
        }
#pragma unroll
        for (int j = 0; j < 8; ++j) sBC[t * 65 + k0 + j] = logsig_f(acc[j]) * 0.0625f;
    }
    __syncthreads();
    {
        const int lane = tid & 63, wv = tid >> 6;
#pragma unroll
        for (int j = 0; j < 8; ++j) {
            const int k = wv * 8 + j;
            const float v = wave_scan_add(sBC[lane * 65 + k], lane, dir);
            sBC[lane * 65 + k] = v;
            if (lane == (dir ? 0 : 63)) sTot[k] = v;
        }
    }
    __syncthreads();
}
DEV bf16x8 tr_frag(const bf16_t* base, int ld, int row0, int col0, int lane) {
    const bf16_t* ptr = base + (row0 + (lane >> 4) * 8 + ((lane & 15) >> 2)) * ld + col0 + (lane & 3) * 4;
    const s16x4 lo = __builtin_amdgcn_ds_read_tr16_b64_v4i16((__attribute__((address_space(3))) s16x4*)ptr);
    const s16x4 hi = __builtin_amdgcn_ds_read_tr16_b64_v4i16((__attribute__((address_space(3))) s16x4*)(ptr + 4 * ld));
    return (bf16x8){lo[0], lo[1], lo[2], lo[3], hi[0], hi[1], hi[2], hi[3]};
}
DEV bf16x8 row_frag(const bf16_t* base, int ld, int idx0, int k0, int lane) {
    return *(const bf16x8*)(base + (idx0 + (lane & 15)) * ld + k0 + (lane >> 4) * 8);
}

DEV void gla1_unit(const Params& p, int h, int dir, int c, float* sm) {
    const int tid = opaque_tid(), lane = tid & 63, wave = tid >> 6;
    const bf16_t* P0 = (const bf16_t*)(p.ws + OFF_P0);
    float* GDS = (float*)(p.ws + OFF_GDS); float* GDEC = (float*)(p.ws + OFF_GDEC);
    const float* wa2 = p.in[dir ? 12 : 10]; const float* ba = p.in[dir ? 13 : 11];
    float* sLR = sm; float* sWA = sm + 1024; float* sBC = sm + 2048; float* sTot = sm + 6208;
    bf16_t* kT = (bf16_t*)(sm + 6272);
    bf16_t* Vs = (bf16_t*)(sm + 8576);
    const int ch = h * 2 + dir;
    __syncthreads();
    gla_decay(P0, c, h, dir, wa2, ba, sLR, sWA, sBC, sTot, tid);
    {
        const int t = tid >> 3, k0 = (tid & 7) * 8;
        float kv[8]; unpack8(*(const uint4*)(P0 + (size_t)(c * 64 + t) * EIN + 256 + h * 64 + k0), kv);
#pragma unroll
        for (int j = 0; j < 8; ++j) kT[(k0 + j) * 72 + t] = __builtin_bit_cast(unsigned short, (__bf16)(kv[j] * fexp(sTot[k0 + j] - sBC[t * 65 + k0 + j])));
#pragma unroll
        for (int u = 0; u < 2; ++u) { const int i = tid + 512 * u, row = i >> 4, c16 = i & 15; *(uint4*)(Vs + row * 136 + c16 * 8) = *(const uint4*)(P0 + (size_t)(c * 64 + row) * EIN + 512 + h * 128 + c16 * 8); }
    }
    __syncthreads();
    {
        f32x4 acc[4];
#pragma unroll
        for (int kt = 0; kt < 4; ++kt) acc[kt] = (f32x4){0.f, 0.f, 0.f, 0.f};
#pragma unroll
        for (int ks = 0; ks < 2; ++ks) {
            const bf16x8 af = tr_frag(Vs, 136, ks * 32, wave * 16, lane);
#pragma unroll
            for (int kt = 0; kt < 4; ++kt) acc[kt] = __builtin_amdgcn_mfma_f32_16x16x32_bf16(af, row_frag(kT, 72, kt * 16, ks * 32, lane), acc[kt], 0, 0, 0);
        }
#pragma unroll
        for (int kt = 0; kt < 4; ++kt) {
            const int k = kt * 16 + (lane & 15), v = wave * 16 + (lane >> 4) * 4;
            st4(GDS + ((size_t)(ch * NCH + c) * 64 + k) * 128 + v, make_float4(acc[kt][0], acc[kt][1], acc[kt][2], acc[kt][3]));
        }
    }
    if (tid < 64) GDEC[(size_t)(ch * NCH + c) * 64 + tid] = fexp(sTot[tid]);
}

DEV void gla2_unit(const Params& p, int unit) {
    const int tid = opaque_tid();
    float* GDS = (float*)(p.ws + OFF_GDS); const float* GDEC = (const float*)(p.ws + OFF_GDEC);
    const int ch = unit >> 4, e = (unit & 15) * 512 + tid, k = e >> 7, dir = ch & 1;
    constexpr int GB = 12;
    float S = 0.f, ninc[GB], nd[GB];
#pragma unroll
    for (int j = 0; j < GB; ++j) { const int c = chunk_at(dir, j); ninc[j] = GDS[(size_t)(ch * NCH + c) * 8192 + e]; nd[j] = GDEC[(size_t)(ch * NCH + c) * 64 + k]; }
#pragma unroll 1
    for (int step0 = 0; step0 < NCH; step0 += GB) {
        float inc[GB], d[GB];
#pragma unroll
        for (int j = 0; j < GB; ++j) { inc[j] = ninc[j]; d[j] = nd[j]; }
#pragma unroll
        for (int j = 0; j < GB; ++j) { const int sn = step0 + GB + j, c = chunk_at(dir, sn < NCH ? sn : NCH - 1); ninc[j] = GDS[(size_t)(ch * NCH + c) * 8192 + e]; nd[j] = GDEC[(size_t)(ch * NCH + c) * 64 + k]; }
        __builtin_amdgcn_sched_barrier(0);
#pragma unroll
        for (int j = 0; j < GB; ++j) { const int c = chunk_at(dir, step0 + j); GDS[(size_t)(ch * NCH + c) * 8192 + e] = S; S = d[j] * S + inc[j]; }
    }
}

DEV void gla3_unit(const Params& p, int h, int c, float* sm) {
    const int tid = opaque_tid(), lane = tid & 63, wave = tid >> 6;
    const bf16_t* P0 = (const bf16_t*)(p.ws + OFF_P0);
    const float* GDS = (const float*)(p.ws + OFF_GDS);
    bf16_t* YC = (bf16_t*)(p.ws + OFF_YC);
    const float* ng = p.in[14];
    float* sLR = sm; float* sWA = sm + 1024; float* sBC = sm + 2048; float* sTot = sm + 6208;
    bf16_t* qt = (bf16_t*)(sm + 6272);
    bf16_t* kt = (bf16_t*)(sm + 8576);
    bf16_t* Sm = (bf16_t*)(sm + 10880);
    bf16_t* S0s = (bf16_t*)(sm + 13184);
    bf16_t* Vs = (bf16_t*)(sm + 17536);
    float* O = sm + 21888;
    const int ti = wave & 3, vt0 = (wave >> 2) * 4;
    f32x4 acc[4];
#pragma unroll
    for (int j = 0; j < 4; ++j) acc[j] = (f32x4){0.f, 0.f, 0.f, 0.f};
    __syncthreads();
#pragma unroll
    for (int u = 0; u < 2; ++u) { const int i = tid + 512 * u, row = i >> 4, c16 = i & 15; *(uint4*)(Vs + row * 136 + c16 * 8) = *(const uint4*)(P0 + (size_t)(c * 64 + row) * EIN + 512 + h * 128 + c16 * 8); }
#pragma unroll 1
    for (int dir = 0; dir < 2; ++dir) {
        const float* wa2 = p.in[dir ? 12 : 10]; const float* ba = p.in[dir ? 13 : 11];
        const int ch = h * 2 + dir;
        __syncthreads();
        gla_decay(P0, c, h, dir, wa2, ba, sLR, sWA, sBC, sTot, tid);
        {
            const int t = tid >> 3, k0 = (tid & 7) * 8;
            float qv[8], kv[8];
            unpack8(*(const uint4*)(P0 + (size_t)(c * 64 + t) * EIN + h * 64 + k0), qv);
            unpack8(*(const uint4*)(P0 + (size_t)(c * 64 + t) * EIN + 256 + h * 64 + k0), kv);
#pragma unroll
            for (int j = 0; j < 8; ++j) { const float bc = sBC[t * 65 + k0 + j]; qv[j] *= 0.125f * fexp(bc); kv[j] *= fexp(-bc); }
            *(uint4*)(qt + t * 72 + k0) = make_uint4(pack2bf(qv[0], qv[1]), pack2bf(qv[2], qv[3]), pack2bf(qv[4], qv[5]), pack2bf(qv[6], qv[7]));
            *(uint4*)(kt + t * 72 + k0) = make_uint4(pack2bf(kv[0], kv[1]), pack2bf(kv[2], kv[3]), pack2bf(kv[4], kv[5]), pack2bf(kv[6], kv[7]));
#pragma unroll
            for (int u = 0; u < 4; ++u) {
                const int i = tid + 512 * u, k = i >> 5, v4 = (i & 31) * 4;
                const float4 s4 = ld4(GDS + (size_t)(ch * NCH + c) * 8192 + k * 128 + v4);
                *(uint2*)(S0s + k * 136 + v4) = make_uint2(pack2bf(s4.x, s4.y), pack2bf(s4.z, s4.w));
            }
        }
        __syncthreads();
        {
            const int si = wave & 3;
#pragma unroll
            for (int jj = 0; jj < 2; ++jj) {
                const int t2 = (wave >> 2) * 2 + jj;
                f32x4 a = (f32x4){0.f, 0.f, 0.f, 0.f};
#pragma unroll
                for (int ks = 0; ks < 2; ++ks) a = __builtin_amdgcn_mfma_f32_16x16x32_bf16(row_frag(kt, 72, si * 16, ks * 32, lane), row_frag(qt, 72, t2 * 16, ks * 32, lane), a, 0, 0, 0);
                const int t = t2 * 16 + (lane & 15), s0 = si * 16 + (lane >> 4) * 4;
                float m[4];
#pragma unroll
                for (int r = 0; r < 4; ++r) { const bool keep = dir ? (s0 + r >= t) : (s0 + r <= t); m[r] = keep ? a[r] : 0.f; }
                *(uint2*)(Sm + t * 72 + s0) = make_uint2(pack2bf(m[0], m[1]), pack2bf(m[2], m[3]));
            }
        }
        __syncthreads();
#pragma unroll
        for (int ks = 0; ks < 2; ++ks) {
            const bf16x8 a1 = row_frag(qt, 72, ti * 16, ks * 32, lane), a2 = row_frag(Sm, 72, ti * 16, ks * 32, lane);
#pragma unroll
            for (int j = 0; j < 4; ++j) {
                acc[j] = __builtin_amdgcn_mfma_f32_16x16x32_bf16(a1, tr_frag(S0s, 136, ks * 32, (vt0 + j) * 16, lane), acc[j], 0, 0, 0);
                acc[j] = __builtin_amdgcn_mfma_f32_16x16x32_bf16(a2, tr_frag(Vs, 136, ks * 32, (vt0 + j) * 16, lane), acc[j], 0, 0, 0);
            }
        }
    }
#pragma unroll
    for (int j = 0; j < 4; ++j)
#pragma unroll
        for (int r = 0; r < 4; ++r) O[(ti * 16 + (lane >> 4) * 4 + r) * 132 + (vt0 + j) * 16 + (lane & 15)] = acc[j][r];
    __syncthreads();
    {
        const int t = tid >> 3, v0 = (tid & 7) * 16;
        float o[16];
        float ss = 0.f;
#pragma unroll
        for (int i = 0; i < 16; ++i) { o[i] = O[t * 132 + v0 + i]; ss += o[i] * o[i]; }
        ss += __shfl_xor(ss, 1, 64); ss += __shfl_xor(ss, 2, 64); ss += __shfl_xor(ss, 4, 64);
        const float rms = rsqrtf(ss * (1.f / 128.f) + 1e-5f);
        float g[16];
        const bf16_t* gp = P0 + (size_t)(c * 64 + t) * EIN + 1024 + h * 128 + v0;
        unpack8(*(const uint4*)gp, g); unpack8(*(const uint4*)(gp + 8), g + 8);
        float y[16];
#pragma unroll
        for (int i = 0; i < 16; ++i) y[i] = o[i] * rms * ng[v0 + i] * silu_f(g[i]);
        bf16_t* yp = YC + (size_t)(c * 64 + t) * 1024 + h * 128 + v0;
        *(uint4*)yp = make_uint4(pack2bf(y[0], y[1]), pack2bf(y[2], y[3]), pack2bf(y[4], y[5]), pack2bf(y[6], y[7]));
        *(uint4*)(yp + 8) = make_uint4(pack2bf(y[8], y[9]), pack2bf(y[10], y[11]), pack2bf(y[12], y[13]), pack2bf(y[14], y[15]));
    }
}

DEV void load8bf(const bf16_t* ptr, float* f) { unpack8(*(const uint4*)ptr, f); }
struct RwNb { int sL, sR, sU, sD; bool vL, vR, vU, vD; };
DEV RwNb rw_nb(int s) {
    RwNb q; q.vU = false; q.vD = false;
    if (s < NCX) { q.vL = s > 0; q.vR = s < NCX - 1; }
    else { const int n = s - NCX, rr = n >> 6, cc = n & 63; q.vL = cc > 0; q.vR = cc < 63; q.vU = rr > 0; q.vD = rr < 127; }
    q.sL = q.vL ? s - 1 : s; q.sR = q.vR ? s + 1 : s; q.sU = q.vU ? s - 64 : s; q.sD = q.vD ? s + 64 : s;
    return q;
}
struct RwRaw { uint4 o, l, r, u, d; };
DEV RwRaw rw_load(const bf16_t* P0, int s, const RwNb& q, int cb) {
    RwRaw w;
    w.o = *(const uint4*)(P0 + (size_t)s * EIN + RW0 + cb); w.l = *(const uint4*)(P0 + (size_t)q.sL * EIN + RW0 + cb); w.r = *(const uint4*)(P0 + (size_t)q.sR * EIN + RW0 + cb);
    w.u = *(const uint4*)(P0 + (size_t)q.sU * EIN + RW0 + cb); w.d = *(const uint4*)(P0 + (size_t)q.sD * EIN + RW0 + cb);
    return w;
}
DEV void rw_comb_l(const RwRaw& w, const RwNb& q, const float* ml, float* out) {
    float own[8]; unpack8(w.o, own);
    const float nb[8] = {q.vL ? bflo(w.l.x) : 0.f, q.vR ? bfhi(w.r.x) : 0.f, q.vU ? bflo(w.u.y) : 0.f, q.vD ? bfhi(w.d.y) : 0.f,
                         q.vL ? bflo(w.l.z) : 0.f, q.vR ? bfhi(w.r.z) : 0.f, q.vU ? bflo(w.u.w) : 0.f, q.vD ? bfhi(w.d.w) : 0.f};
    const float4 m0 = *(const float4*)ml, m1 = *(const float4*)(ml + 4);
    const float m[8] = {m0.x, m0.y, m0.z, m0.w, m1.x, m1.y, m1.z, m1.w};
#pragma unroll
    for (int i = 0; i < 8; ++i) out[i] = own[i] + (nb[i] - own[i]) * m[i];
}
DEV void rw_comb(const RwRaw& w, const RwNb& q, const float* __restrict__ mu, int cb, float* out) {
    float own[8]; unpack8(w.o, own);
    const float nb[8] = {q.vL ? bflo(w.l.x) : 0.f, q.vR ? bfhi(w.r.x) : 0.f, q.vU ? bflo(w.u.y) : 0.f, q.vD ? bfhi(w.d.y) : 0.f,
                         q.vL ? bflo(w.l.z) : 0.f, q.vR ? bfhi(w.r.z) : 0.f, q.vU ? bflo(w.u.w) : 0.f, q.vD ? bfhi(w.d.w) : 0.f};
    const float4 m0 = ld4(mu + cb), m1 = ld4(mu + cb + 4);
    const float m[8] = {m0.x, m0.y, m0.z, m0.w, m1.x, m1.y, m1.z, m1.w};
#pragma unroll
    for (int i = 0; i < 8; ++i) out[i] = own[i] + (nb[i] - own[i]) * m[i];
}
DEV uint4 pack8(const float* f) { return make_uint4(pack2bf(f[0], f[1]), pack2bf(f[2], f[3]), pack2bf(f[4], f[5]), pack2bf(f[6], f[7])); }

template <int XM, int YM, class F>
DEV void mm64(const bf16_t* X, const bf16_t* Y, F f, int lane, int wave) {
#pragma unroll
    for (int q = 0; q < 2; ++q) {
        const int idx = wave * 2 + q, ti = idx >> 2, tj = idx & 3;
        f32x4 acc = (f32x4){0.f, 0.f, 0.f, 0.f};
#pragma unroll
        for (int ks = 0; ks < 2; ++ks) {
            const bf16x8 a = XM == 0 ? row_frag(X, 72, ti * 16, ks * 32, lane) : tr_frag(X, 72, ks * 32, ti * 16, lane);
            const bf16x8 bq = YM == 0 ? row_frag(Y, 72, tj * 16, ks * 32, lane) : tr_frag(Y, 72, ks * 32, tj * 16, lane);
            acc = __builtin_amdgcn_mfma_f32_16x16x32_bf16(a, bq, acc, 0, 0, 0);
        }
        f(ti * 16 + (lane >> 4) * 4, tj * 16 + (lane & 15), acc);
    }
}
template <int XM, int YM, class F>
DEV void mm64x2(const bf16_t* X1, const bf16_t* Y1, const bf16_t* X2, const bf16_t* Y2, F f, int lane, int wave) {
#pragma unroll
    for (int q = 0; q < 2; ++q) {
        const int idx = wave * 2 + q, ti = idx >> 2, tj = idx & 3;
        f32x4 acc = (f32x4){0.f, 0.f, 0.f, 0.f};
#pragma unroll
        for (int ks = 0; ks < 2; ++ks) {
            const bf16x8 a = XM == 0 ? row_frag(X1, 72, ti * 16, ks * 32, lane) : tr_frag(X1, 72, ks * 32, ti * 16, lane);
            const bf16x8 bq = YM == 0 ? row_frag(Y1, 72, tj * 16, ks * 32, lane) : tr_frag(Y1, 72, ks * 32, tj * 16, lane);
            acc = __builtin_amdgcn_mfma_f32_16x16x32_bf16(a, bq, acc, 0, 0, 0);
            const bf16x8 a2 = XM == 0 ? row_frag(X2, 72, ti * 16, ks * 32, lane) : tr_frag(X2, 72, ks * 32, ti * 16, lane);
            const bf16x8 b2 = YM == 0 ? row_frag(Y2, 72, tj * 16, ks * 32, lane) : tr_frag(Y2, 72, ks * 32, tj * 16, lane);
            acc = __builtin_amdgcn_mfma_f32_16x16x32_bf16(a2, b2, acc, 0, 0, 0);
        }
        f(ti * 16 + (lane >> 4) * 4, tj * 16 + (lane & 15), acc);
    }
}
DEV void st_img(bf16_t* P, int i0, int j, float a0, float a1, float a2, float a3) {
    P[(i0 + 0) * 72 + j] = __builtin_bit_cast(unsigned short, (__bf16)a0); P[(i0 + 1) * 72 + j] = __builtin_bit_cast(unsigned short, (__bf16)a1);
    P[(i0 + 2) * 72 + j] = __builtin_bit_cast(unsigned short, (__bf16)a2); P[(i0 + 3) * 72 + j] = __builtin_bit_cast(unsigned short, (__bf16)a3);
}

struct RwRaw3 { uint4 o, u, d; };
DEV RwRaw3 rw_load3(const bf16_t* P0, int s, const RwNb& q, int cb) {
    RwRaw3 w;
    w.o = *(const uint4*)(P0 + (size_t)s * EIN + RW0 + cb); w.u = *(const uint4*)(P0 + (size_t)q.sU * EIN + RW0 + cb); w.d = *(const uint4*)(P0 + (size_t)q.sD * EIN + RW0 + cb);
    return w;
}
DEV void rw_comb3(const RwRaw3& w, const RwNb& q, const bf16_t* tile, const bf16_t* P0, int s, int t, int cb, int j0, const float* ml, float* out) {
    asm volatile("" :: "v"(w.u.x), "v"(w.u.z), "v"(w.d.x), "v"(w.d.z));
    float own[8]; unpack8(w.o, own);
    float l0 = 0.f, l4 = 0.f, r1 = 0.f, r5 = 0.f;
    if (q.vL) { if (t > 0) { l0 = bf2f(tile[(t - 1) * 72 + j0]); l4 = bf2f(tile[(t - 1) * 72 + j0 + 4]); }
                else { const bf16_t* g = P0 + (size_t)(s - 1) * EIN + RW0 + cb; l0 = bf2f(g[0]); l4 = bf2f(g[4]); } }
    if (q.vR) { if (t < 63) { r1 = bf2f(tile[(t + 1) * 72 + j0 + 1]); r5 = bf2f(tile[(t + 1) * 72 + j0 + 5]); }
                else { const bf16_t* g = P0 + (size_t)(s + 1) * EIN + RW0 + cb; r1 = bf2f(g[1]); r5 = bf2f(g[5]); } }
    const float nb[8] = {l0, r1, q.vU ? bflo(w.u.y) : 0.f, q.vD ? bfhi(w.d.y) : 0.f, l4, r5, q.vU ? bflo(w.u.w) : 0.f, q.vD ? bfhi(w.d.w) : 0.f};
    const float4 m0 = *(const float4*)ml, m1 = *(const float4*)(ml + 4);
    const float m[8] = {m0.x, m0.y, m0.z, m0.w, m1.x, m1.y, m1.z, m1.w};
#pragma unroll
    for (int i = 0; i < 8; ++i) out[i] = own[i] + (nb[i] - own[i]) * m[i];
}
struct R1Raw { RwRaw3 r, k, v, w, a; float4 qw0, qw1, qa0, qa1; };
DEV void r1_consts(const Params& p, int h, int dir, float* sm) {
    const int tid = opaque_tid();
    float* sv = (float*)((bf16_t*)sm + 14 * 4608);
    __syncthreads();
    if (tid < 64) { const int hc = h * 64 + tid; sv[64 + tid] = p.in[dir ? 18 : 16][hc]; sv[128 + tid] = p.in[dir ? 22 : 20][hc]; sv[192 + tid] = p.in[24][hc]; sv[256 + tid] = p.in[25][hc]; sv[320 + tid] = p.in[26][hc]; }
    if (tid < 320) { const int tn = tid >> 6, col = tid & 63; const int cb = tn < 3 ? tn * 512 + h * 64 : (tn == 3 ? 2048 + dir * 64 : 2176 + dir * 64); sv[384 + tid] = p.in[15][cb + col]; }
}
DEV void r1_load(const Params& p, int h, int dir, int c, R1Raw& R) {
    const int tid = opaque_tid();
    const bf16_t* P0 = (const bf16_t*)(p.ws + OFF_P0);
    const float* ww2 = p.in[dir ? 19 : 17]; const float* wa2 = p.in[dir ? 23 : 21];
    const int t = tid >> 3, j0 = (tid & 7) * 8, s = c * 64 + t;
    const RwNb nbq = rw_nb(s);
    R.r = rw_load3(P0, s, nbq, h * 64 + j0); R.k = rw_load3(P0, s, nbq, 512 + h * 64 + j0); R.v = rw_load3(P0, s, nbq, 1024 + h * 64 + j0);
    R.w = rw_load3(P0, s, nbq, 2048 + dir * 64 + j0); R.a = rw_load3(P0, s, nbq, 2176 + dir * 64 + j0);
    R.qw0 = ld4(ww2 + (size_t)t * 512 + h * 64 + j0); R.qw1 = ld4(ww2 + (size_t)t * 512 + h * 64 + j0 + 4);
    R.qa0 = ld4(wa2 + (size_t)t * 512 + h * 64 + j0); R.qa1 = ld4(wa2 + (size_t)t * 512 + h * 64 + j0 + 4);
}
DEV void rwkv1_unit(const Params& p, int h, int dir, int c, float* sm, R1Raw& R, int cnext) {
    const int tid = opaque_tid(), lane = tid & 63, wave = tid >> 6;
    bf16_t* RU = (bf16_t*)(p.ws + OFF_RU) + (size_t)((h * 2 + dir) * NCH + c) * 16384;
    float* BONS = (float*)(p.ws + OFF_BONS);
    bf16_t* img = (bf16_t*)sm;
#define SLOT(i_) (img + (i_) * 4608)
    float* fLW = (float*)SLOT(10);
    float* fAS = (float*)SLOT(12);
    float* sv = (float*)SLOT(14);
    const int t = tid >> 3, j0 = (tid & 7) * 8, s = c * 64 + t;
    const bf16_t* P0 = (const bf16_t*)(p.ws + OFF_P0);
    __syncthreads();
    *(uint4*)(SLOT(0) + t * 72 + j0) = R.r.o; *(uint4*)(SLOT(1) + t * 72 + j0) = R.k.o; *(uint4*)(SLOT(2) + t * 72 + j0) = R.v.o;
    *(uint4*)(SLOT(3) + t * 72 + j0) = R.w.o; *(uint4*)(SLOT(4) + t * 72 + j0) = R.a.o;
    __syncthreads();
    float r8[8], k8[8], v8[8];
    {
        float x8[8];
        const RwNb nbq = rw_nb(s);
        rw_comb3(R.r, nbq, SLOT(0), P0, s, t, h * 64 + j0, j0, sv + 384 + j0, r8);
        rw_comb3(R.k, nbq, SLOT(1), P0, s, t, 512 + h * 64 + j0, j0, sv + 448 + j0, k8);
        rw_comb3(R.v, nbq, SLOT(2), P0, s, t, 1024 + h * 64 + j0, j0, sv + 512 + j0, v8);
        rw_comb3(R.w, nbq, SLOT(3), P0, s, t, 2048 + dir * 64 + j0, j0, sv + 576 + j0, x8);
#pragma unroll
        for (int i = 0; i < 8; ++i) x8[i] = tanh_f(x8[i]);
        *(uint4*)(SLOT(6) + t * 72 + j0) = pack8(x8);
        rw_comb3(R.a, nbq, SLOT(4), P0, s, t, 2176 + dir * 64 + j0, j0, sv + 640 + j0, x8);
        *(uint4*)(SLOT(7) + t * 72 + j0) = pack8(x8);
        { const float wq[8] = {R.qw0.x, R.qw0.y, R.qw0.z, R.qw0.w, R.qw1.x, R.qw1.y, R.qw1.z, R.qw1.w}; *(uint4*)(SLOT(8) + t * 72 + j0) = pack8(wq); }
        { const float wq[8] = {R.qa0.x, R.qa0.y, R.qa0.z, R.qa0.w, R.qa1.x, R.qa1.y, R.qa1.z, R.qa1.w}; *(uint4*)(SLOT(9) + t * 72 + j0) = pack8(wq); }
    }
    r1_load(p, h, dir, cnext >= 0 ? cnext : c, R);
    __syncthreads();
    mm64<0, 1>(SLOT(6), SLOT(8), [=](int i0, int j, f32x4 a) {
#pragma unroll
        for (int r = 0; r < 4; ++r) fLW[(i0 + r) * 65 + j] = -0.6065306597f * sigmoid_f(sv[64 + j] + a[r]); }, lane, wave);
    mm64<0, 1>(SLOT(7), SLOT(9), [=](int i0, int j, f32x4 a) {
#pragma unroll
        for (int r = 0; r < 4; ++r) fAS[(i0 + r) * 65 + j] = sigmoid_f(sv[128 + j] + a[r]); }, lane, wave);
    __syncthreads();
#pragma unroll
    for (int j = 0; j < 8; ++j) {
        const int k = wave * 8 + j;
        const float v = wave_scan_add(fLW[lane * 65 + k], lane, dir);
        fLW[lane * 65 + k] = v;
        if (lane == (dir ? 0 : 63)) sv[k] = v;
    }
    __syncthreads();
    {
        float kkv[8], ss = 0.f;
#pragma unroll
        for (int i = 0; i < 8; ++i) { kkv[i] = k8[i] * sv[192 + j0 + i]; ss += kkv[i] * kkv[i]; }
        ss += __shfl_xor(ss, 1, 64); ss += __shfl_xor(ss, 2, 64); ss += __shfl_xor(ss, 4, 64);
        const float rn = rsqrtf(fmaxf(ss, 1e-24f));
        float fa[8], fb[8], fk[8], fr[8], fbp[8], fkp[8], bon = 0.f;
        const int tp = dir ? t + 1 : t - 1;
        const bool hasp = dir ? (t < 63) : (t > 0);
#pragma unroll
        for (int i = 0; i < 8; ++i) {
            const int k = j0 + i;
            const float Bt = fLW[t * 65 + k], Bx = hasp ? fLW[tp * 65 + k] : 0.f, asg = fAS[t * 65 + k];
            const float kk = kkv[i] * rn, kh = k8[i] * (1.f + (asg - 1.f) * sv[256 + k]);
            bon += r8[i] * kh * sv[320 + k];
            const float enB = fexp(-Bt), eLB = fexp(sv[k] - Bt), bv = kk * asg;
            fa[i] = -kk * fexp(Bx); fb[i] = bv * enB; fk[i] = kh * enB; fr[i] = r8[i] * fexp(Bt); fbp[i] = bv * eLB; fkp[i] = kh * eLB;
        }
        bon += __shfl_xor(bon, 1, 64); bon += __shfl_xor(bon, 2, 64); bon += __shfl_xor(bon, 4, 64);
        if ((tid & 7) == 0) BONS[((size_t)dir * TB + s) * 8 + h] = bon;
        *(uint4*)(SLOT(0) + t * 72 + j0) = pack8(fa); *(uint4*)(SLOT(1) + t * 72 + j0) = pack8(fb); *(uint4*)(SLOT(2) + t * 72 + j0) = pack8(fk);
        *(uint4*)(SLOT(3) + t * 72 + j0) = pack8(fr); *(uint4*)(SLOT(4) + t * 72 + j0) = pack8(fbp); *(uint4*)(SLOT(5) + t * 72 + j0) = pack8(fkp);
    }
    __syncthreads();
    *(uint4*)(SLOT(6) + t * 72 + j0) = pack8(v8);
    __syncthreads();
    mm64<0, 0>(SLOT(0), SLOT(1), [=](int i0, int j, f32x4 a) {
        float m[4];
#pragma unroll
        for (int r = 0; r < 4; ++r) { const bool keep = dir ? (j > i0 + r) : (j < i0 + r); m[r] = keep ? a[r] : 0.f; }
        const bool dg = (i0 >> 4) == (j >> 4);
        st_img(SLOT(7), i0, j, dg ? m[0] : 0.f, dg ? m[1] : 0.f, dg ? m[2] : 0.f, dg ? m[3] : 0.f);
        st_img(SLOT(8), i0, j, (dg ? m[0] : 0.f) + (j == i0 ? 1.f : 0.f), (dg ? m[1] : 0.f) + (j == i0 + 1 ? 1.f : 0.f), (dg ? m[2] : 0.f) + (j == i0 + 2 ? 1.f : 0.f), (dg ? m[3] : 0.f) + (j == i0 + 3 ? 1.f : 0.f));
        st_img(SLOT(12), i0, j, dg ? 0.f : m[0], dg ? 0.f : m[1], dg ? 0.f : m[2], dg ? 0.f : m[3]); }, lane, wave);
    mm64<0, 0>(SLOT(0), SLOT(2), [=](int i0, int j, f32x4 a) {
        float m[4];
#pragma unroll
        for (int r = 0; r < 4; ++r) { const bool keep = dir ? (j > i0 + r) : (j < i0 + r); m[r] = keep ? a[r] : 0.f; }
        st_img(SLOT(9), i0, j, m[0], m[1], m[2], m[3]); }, lane, wave);
    mm64<0, 0>(SLOT(3), SLOT(1), [=](int i0, int j, f32x4 a) {
        float m[4];
#pragma unroll
        for (int r = 0; r < 4; ++r) { const bool keep = dir ? (j >= i0 + r) : (j <= i0 + r); m[r] = keep ? a[r] : 0.f; }
        st_img(SLOT(10), i0, j, m[0], m[1], m[2], m[3]); }, lane, wave);
    mm64<0, 0>(SLOT(3), SLOT(2), [=](int i0, int j, f32x4 a) {
        float m[4];
#pragma unroll
        for (int r = 0; r < 4; ++r) { const bool keep = dir ? (j >= i0 + r) : (j <= i0 + r); m[r] = keep ? a[r] : 0.f; }
        st_img(SLOT(11), i0, j, m[0], m[1], m[2], m[3]); }, lane, wave);
    __syncthreads();
    {
        bf16_t* Pc = SLOT(7); bf16_t* Pn = SLOT(1); bf16_t* Tc = SLOT(8); bf16_t* Tn = SLOT(2);
#pragma unroll 1
        for (int it = 0; it < 3; ++it) {
            mm64<0, 1>(Pc, Pc, [=](int i0, int j, f32x4 a) { st_img(Pn, i0, j, a[0], a[1], a[2], a[3]); }, lane, wave);
            __syncthreads();
            mm64<0, 1>(Tc, Pn, [=](int i0, int j, f32x4 a) {
                st_img(Tn, i0, j, a[0] + bf2f(Tc[(i0 + 0) * 72 + j]), a[1] + bf2f(Tc[(i0 + 1) * 72 + j]), a[2] + bf2f(Tc[(i0 + 2) * 72 + j]), a[3] + bf2f(Tc[(i0 + 3) * 72 + j])); }, lane, wave);
            __syncthreads();
            bf16_t* tmp = Pc; Pc = Pn; Pn = tmp; tmp = Tc; Tc = Tn; Tn = tmp;
        }
    }
    mm64<0, 1>(SLOT(2), SLOT(12), [=](int i0, int j, f32x4 a) { st_img(SLOT(7), i0, j, a[0], a[1], a[2], a[3]); }, lane, wave);
    mm64<0, 1>(SLOT(2), SLOT(0), [=](int i0, int j, f32x4 a) { st_img(SLOT(1), i0, j, a[0], a[1], a[2], a[3]); }, lane, wave);
    mm64<0, 1>(SLOT(9), SLOT(6), [=](int i0, int j, f32x4 a) { st_img(SLOT(13), i0, j, a[0], a[1], a[2], a[3]); }, lane, wave);
    __syncthreads();
    mm64<0, 1>(SLOT(2), SLOT(13), [=](int i0, int j, f32x4 a) { st_img(SLOT(8), i0, j, a[0], a[1], a[2], a[3]); }, lane, wave);
    __syncthreads();
    {
        const bf16_t* Zp = (wave < 4) ? SLOT(1) : SLOT(8);
        bf16_t* Xi = (wave < 4) ? SLOT(12) : SLOT(9);
        const int ct = (wave & 3) * 16, g4 = (lane >> 4) * 4, l15 = lane & 15;
#pragma unroll
        for (int bs = 0; bs < 4; ++bs) {
            const int bi = dir ? 3 - bs : bs;
            f32x4 acc;
#pragma unroll
            for (int r = 0; r < 4; ++r) acc[r] = bf2f(Zp[(bi * 16 + g4 + r) * 72 + ct + l15]);
            const bool k0 = dir ? (bi == 0) : (bi >= 1), k1 = dir ? (bi <= 2) : (bi == 3);
            if (k0) acc = __builtin_amdgcn_mfma_f32_16x16x32_bf16(row_frag(SLOT(7), 72, bi * 16, 0, lane), tr_frag(Xi, 72, 0, ct, lane), acc, 0, 0, 0);
            if (k1) acc = __builtin_amdgcn_mfma_f32_16x16x32_bf16(row_frag(SLOT(7), 72, bi * 16, 32, lane), tr_frag(Xi, 72, 32, ct, lane), acc, 0, 0, 0);
            st_img(Xi, bi * 16 + g4, ct + l15, acc[0], acc[1], acc[2], acc[3]);
            __syncthreads();
        }
    }
    mm64<1, 1>(SLOT(12), SLOT(4), [=](int i0, int j, f32x4 a) {
        float m[4];
#pragma unroll
        for (int r = 0; r < 4; ++r) m[r] = a[r] + ((i0 + r) == j ? fexp(sv[j]) : 0.f);
        *(uint2*)(RU + j * 64 + i0) = make_uint2(pack2bf(m[0], m[1]), pack2bf(m[2], m[3])); }, lane, wave);
    mm64x2<1, 1>(SLOT(4), SLOT(9), SLOT(5), SLOT(6), [=](int i0, int j, f32x4 a) {
        *(uint2*)(RU + 4096 + j * 64 + i0) = make_uint2(pack2bf(a[0], a[1]), pack2bf(a[2], a[3])); }, lane, wave);
    mm64<1, 0>(SLOT(12), SLOT(10), [=](int i0, int j, f32x4 a) {
        const uint2 rr = *(const uint2*)(SLOT(3) + j * 72 + i0);
        *(uint2*)(RU + 8192 + j * 64 + i0) = make_uint2(pack2bf(a[0] + bflo(rr.x), a[1] + bfhi(rr.x)), pack2bf(a[2] + bflo(rr.y), a[3] + bfhi(rr.y))); }, lane, wave);
    mm64x2<0, 1>(SLOT(10), SLOT(9), SLOT(11), SLOT(6), [=](int i0, int j, f32x4 a) {
        *(uint2*)(RU + 12288 + j * 64 + i0) = make_uint2(pack2bf(a[0], a[1]), pack2bf(a[2], a[3])); }, lane, wave);
#undef SLOT
}

#define R2_LOAD(M_, C_, rnd_) do { const int r0_ = ((rnd_) < R2_NR ? (rnd_) : R2_NR - 1) * R2_RS; \
    _Pragma("unroll") for (int s_ = 0; s_ < R2_RS; ++s_) M_[s_] = *(const uint4*)(RU + (size_t)(chain * NCH + chunk_at(dir, r0_ + s_)) * 16384 + tid * 8); \
    _Pragma("unroll") for (int j_ = 0; j_ < 3; ++j_) { const int cq_ = tid + 512 * j_; \
        C_[j_] = *(const uint4*)(RU + (size_t)(chain * NCH + chunk_at(dir, r0_ + (cq_ >> 7))) * 16384 + 4096 + (vblk * 16 + ((cq_ >> 3) & 15)) * 64 + (cq_ & 7) * 8); } } while (0)
#define R2_ROUND(M_, C_, rnd_) do { \
    { const int row_ = tid >> 3, c8_ = tid & 7, sw_ = (row_ >> 1) & 7, u0_ = (c8_ >> 2) * 4 + (c8_ & 1) * 2, eh_ = ((c8_ >> 1) & 1) * 8; \
      _Pragma("unroll") for (int s_ = 0; s_ < R2_RS; ++s_) { char* sl_ = ring + s_ * 10240 + row_ * 128 + eh_; \
          *(uint2*)(sl_ + ((u0_ ^ sw_) * 16)) = make_uint2(M_[s_].x, M_[s_].y); *(uint2*)(sl_ + (((u0_ + 1) ^ sw_) * 16)) = make_uint2(M_[s_].z, M_[s_].w); } \
      _Pragma("unroll") for (int j_ = 0; j_ < 3; ++j_) { const int cq_ = tid + 512 * j_, rw_ = (cq_ >> 3) & 15, q8_ = cq_ & 7, i_ = q8_ >> 1, g0_ = (q8_ & 1) * 2, sc_ = (rw_ >> 1) & 7; \
          char* sl_ = ring + (cq_ >> 7) * 10240 + 8192 + rw_ * 128 + (i_ & 1) * 8; \
          *(uint2*)(sl_ + (((g0_ * 2 + (i_ >> 1)) ^ sc_) * 16)) = make_uint2(C_[j_].x, C_[j_].y); *(uint2*)(sl_ + ((((g0_ + 1) * 2 + (i_ >> 1)) ^ sc_) * 16)) = make_uint2(C_[j_].z, C_[j_].w); } } \
    R2_LOAD(M_, C_, (rnd_) + 2); \
    __syncthreads(); \
    if (wave == 0) { \
        _Pragma("unroll 4") for (int s_ = 0; s_ < R2_RS; ++s_) { \
            const int c_ = chunk_at(dir, (rnd_) * R2_RS + s_); const char* sl_ = ring + s_ * 10240; \
            unsigned pk_[4][2]; \
            _Pragma("unroll") for (int i_ = 0; i_ < 4; ++i_) { pk_[i_][0] = pack2bf(st[i_][0], st[i_][1]); pk_[i_][1] = pack2bf(st[i_][2], st[i_][3]); } \
            bf16_t* sp_ = S0G + ((size_t)(chain * NCH + c_) * 64 + vblk * 16 + l15) * 64 + g * 4; \
            _Pragma("unroll") for (int i_ = 0; i_ < 4; ++i_) *(uint2*)(sp_ + i_ * 16) = make_uint2(pk_[i_][0], pk_[i_][1]); \
            bf16x8 bfr_[2]; \
            _Pragma("unroll") for (int ks_ = 0; ks_ < 2; ++ks_) { const uint4 u_ = make_uint4(pk_[2 * ks_][0], pk_[2 * ks_][1], pk_[2 * ks_ + 1][0], pk_[2 * ks_ + 1][1]); bfr_[ks_] = __builtin_bit_cast(bf16x8, u_); } \
            const uint4 c01_ = *(const uint4*)(sl_ + 8192 + l15 * 128 + (((g * 2) ^ ((l15 >> 1) & 7)) * 16)), c23_ = *(const uint4*)(sl_ + 8192 + l15 * 128 + (((g * 2 + 1) ^ ((l15 >> 1) & 7)) * 16)); \
            const unsigned cw_[8] = {c01_.x, c01_.y, c01_.z, c01_.w, c23_.x, c23_.y, c23_.z, c23_.w}; \
            _Pragma("unroll") for (int i_ = 0; i_ < 4; ++i_) { \
                f32x4 acc_ = (f32x4){bflo(cw_[2 * i_]), bfhi(cw_[2 * i_]), bflo(cw_[2 * i_ + 1]), bfhi(cw_[2 * i_ + 1])}; \
                _Pragma("unroll") for (int ks_ = 0; ks_ < 2; ++ks_) { \
                    const int row_ = i_ * 16 + l15; \
                    const bf16x8 af_ = *(const bf16x8*)(sl_ + row_ * 128 + (((ks_ * 4 + g) ^ ((row_ >> 1) & 7)) * 16)); \
                    acc_ = __builtin_amdgcn_mfma_f32_16x16x32_bf16(af_, bfr_[ks_], acc_, 0, 0, 0); } \
                st[i_] = acc_; } } } \
    __syncthreads(); } while (0)
DEV void rwkv2_unit(const Params& p, int chain, int vblk, float* sm) {
    constexpr int R2_RS = 12, R2_NR = NCH / R2_RS;
    static_assert(R2_NR * R2_RS == NCH && R2_RS * 10240 <= LDS_BYTES, "R2 ring");
    const int tid = opaque_tid(), lane = tid & 63, wave = tid >> 6;
    const bf16_t* RU = (const bf16_t*)(p.ws + OFF_RU);
    bf16_t* S0G = (bf16_t*)(p.ws + OFF_RS0);
    char* ring = (char*)sm;
    const int dir = chain & 1, g = lane >> 4, l15 = lane & 15;
    f32x4 st[4];
#pragma unroll
    for (int i = 0; i < 4; ++i) st[i] = (f32x4){0.f, 0.f, 0.f, 0.f};
    uint4 ma[R2_RS], ca[3], mb[R2_RS], cb[3];
    __syncthreads();
    R2_LOAD(ma, ca, 0); R2_LOAD(mb, cb, 1);
#pragma unroll 1
    for (int rnd = 0; rnd < R2_NR; rnd += 2) {
        R2_ROUND(ma, ca, rnd);
        if (rnd + 1 < R2_NR) R2_ROUND(mb, cb, rnd + 1);
    }
}
#undef R2_LOAD
#undef R2_ROUND

DEV void rwkv3_unit(const Params& p, int h, int c, float* sm) {
    const int tid = opaque_tid(), lane = tid & 63, wave = tid >> 6;
    const bf16_t* P0 = (const bf16_t*)(p.ws + OFF_P0);
    const bf16_t* RUb = (const bf16_t*)(p.ws + OFF_RU);
    const bf16_t* S0G = (const bf16_t*)(p.ws + OFF_RS0);
    const float* BONS = (const float*)(p.ws + OFF_BONS);
    bf16_t* YC = (bf16_t*)(p.ws + OFF_YC);
    const float* mu = p.in[15]; const float* gn_g = p.in[27]; const float* gn_b = p.in[28];
    bf16_t* img = (bf16_t*)sm;
    float* O = sm + 4 * 2304;
    const int t = tid >> 3, v0 = (tid & 7) * 8, s = c * 64 + t;
    const size_t u0 = (size_t)((h * 2 + 0) * NCH + c), u1 = (size_t)((h * 2 + 1) * NCH + c);
    const uint4 gr0 = *(const uint4*)(RUb + u0 * 16384 + 8192 + t * 64 + v0), gs0 = *(const uint4*)(S0G + u0 * 4096 + t * 64 + v0);
    const uint4 gr1 = *(const uint4*)(RUb + u1 * 16384 + 8192 + t * 64 + v0), gs1 = *(const uint4*)(S0G + u1 * 4096 + t * 64 + v0);
    uint2 yl[2][2];
#pragma unroll
    for (int q = 0; q < 2; ++q) { const int idx = wave * 2 + q, ti = idx >> 2, tj = idx & 3;
        yl[q][0] = *(const uint2*)(RUb + u0 * 16384 + 12288 + (tj * 16 + (lane & 15)) * 64 + ti * 16 + (lane >> 4) * 4);
        yl[q][1] = *(const uint2*)(RUb + u1 * 16384 + 12288 + (tj * 16 + (lane & 15)) * 64 + ti * 16 + (lane >> 4) * 4); }
    const RwNb nbq = rw_nb(s);
    const RwRaw wv_ = rw_load(P0, s, nbq, 1024 + h * 64 + v0), wg_ = rw_load(P0, s, nbq, 1536 + h * 64 + v0);
    const float bon = BONS[(size_t)s * 8 + h] + BONS[((size_t)TB + s) * 8 + h];
    __syncthreads();
    *(uint4*)(img + 0 * 4608 + t * 72 + v0) = gr0; *(uint4*)(img + 2 * 4608 + t * 72 + v0) = gs0;
    *(uint4*)(img + 1 * 4608 + t * 72 + v0) = gr1; *(uint4*)(img + 3 * 4608 + t * 72 + v0) = gs1;
    __syncthreads();
#pragma unroll
    for (int q = 0; q < 2; ++q) {
        const int idx = wave * 2 + q, ti = idx >> 2, tj = idx & 3;
        f32x4 accd[2];
#pragma unroll
        for (int dir = 0; dir < 2; ++dir) {
            f32x4 acc = (f32x4){bflo(yl[q][dir].x), bfhi(yl[q][dir].x), bflo(yl[q][dir].y), bfhi(yl[q][dir].y)};
#pragma unroll
            for (int ks = 0; ks < 2; ++ks) acc = __builtin_amdgcn_mfma_f32_16x16x32_bf16(row_frag(img + dir * 4608, 72, ti * 16, ks * 32, lane), row_frag(img + (2 + dir) * 4608, 72, tj * 16, ks * 32, lane), acc, 0, 0, 0);
            accd[dir] = acc;
        }
#pragma unroll
        for (int r = 0; r < 4; ++r) {
            const int oi = (ti * 16 + (lane >> 4) * 4 + r) * 68 + tj * 16 + (lane & 15);
            O[oi] = accd[0][r] + accd[1][r];
        }
    }
    __syncthreads();
    {
        float y[8], sum = 0.f;
#pragma unroll
        for (int i = 0; i < 8; ++i) { y[i] = O[t * 68 + v0 + i]; sum += y[i]; }
        sum += __shfl_xor(sum, 1, 64); sum += __shfl_xor(sum, 2, 64); sum += __shfl_xor(sum, 4, 64);
        const float mean = sum * (1.f / 64.f);
        float sq = 0.f;
#pragma unroll
        for (int i = 0; i < 8; ++i) { y[i] -= mean; sq += y[i] * y[i]; }
        sq += __shfl_xor(sq, 1, 64); sq += __shfl_xor(sq, 2, 64); sq += __shfl_xor(sq, 4, 64);
        const float rstd = rsqrtf(sq * (1.f / 64.f) + 64e-5f);
        float vm[8], gm[8];
        rw_comb(wv_, nbq, mu, 1024 + h * 64 + v0, vm);
        rw_comb(wg_, nbq, mu, 1536 + h * 64 + v0, gm);
        float o[8];
#pragma unroll
        for (int i = 0; i < 8; ++i) o[i] = (y[i] * rstd * gn_g[h * 64 + v0 + i] + gn_b[h * 64 + v0 + i] + bon * vm[i]) * silu_f(gm[i]);
        *(uint4*)(YC + (size_t)s * 1024 + 512 + h * 64 + v0) = pack8(o);
    }
}

DEV void ln_rows(const float* src, const float* res_lat, const float* res_cx, int nrows, const float* __restrict__ g, const float* __restrict__ bt, float* dst_lat, float* dst_cx, int ncx,
                 bf16_t* hb = nullptr, const float* mvc = nullptr, const float* mvl = nullptr) {
    const int tid_ = opaque_tid(); const int lane = tid_ & 63, gw = blockIdx.x * NWV + (tid_ >> 6), ngw = gridDim.x * NWV;
    for (int r = gw; r < nrows; r += ngw) {
        const float* x = src + (size_t)r * 1024;
        float4 v[4];
        float sum = 0.f;
        const float* xr = (r < ncx) ? (res_cx + (size_t)r * 1024) : (res_lat + (size_t)(r - ncx) * 1024);
#pragma unroll
        for (int i = 0; i < 4; ++i) { const float4 a = ld4(x + i * 256 + lane * 4), rr = ld4(xr + i * 256 + lane * 4);
            v[i] = make_float4(ALPHA * rr.x + a.x, ALPHA * rr.y + a.y, ALPHA * rr.z + a.z, ALPHA * rr.w + a.w); sum += v[i].x + v[i].y + v[i].z + v[i].w; }
        const float mean = wave_sum(sum) * (1.f / 1024.f);
        float sq = 0.f;
#pragma unroll
        for (int i = 0; i < 4; ++i) {
            v[i].x -= mean; v[i].y -= mean; v[i].z -= mean; v[i].w -= mean;
            sq += v[i].x * v[i].x + v[i].y * v[i].y + v[i].z * v[i].z + v[i].w * v[i].w;
        }
        const float rstd = rsqrtf(wave_sum(sq) * (1.f / 1024.f) + 1e-5f);
        float* d = (r < ncx) ? (dst_cx + (size_t)r * 1024) : (dst_lat + (size_t)(r - ncx) * 1024);
#pragma unroll
        for (int i = 0; i < 4; ++i) {
            const int c = i * 256 + lane * 4;
            const float4 gg = ld4(g + c), bb = ld4(bt + c);
            const float4 y = make_float4(v[i].x * rstd * gg.x + bb.x, v[i].y * rstd * gg.y + bb.y, v[i].z * rstd * gg.z + bb.z, v[i].w * rstd * gg.w + bb.w);
            st4(d + c, y);
            if (hb != nullptr) {
                const float* m = (r < ncx) ? mvc : mvl;
                const float4 sh = ld4(m + c), sc = ld4(m + 1024 + c);
                *(uint2*)(hb + (size_t)r * 1024 + c) = make_uint2(pack2bf(y.x * (1.f + sc.x) + sh.x, y.y * (1.f + sc.y) + sh.y), pack2bf(y.z * (1.f + sc.z) + sh.z, y.w * (1.f + sc.w) + sh.w));
            }
        }
    }
}
DEV void phase_h1l(const Params& p) {
    const float* modv1 = (const float*)(p.ws + OFF_MODV) + 3 * 3072;
    bf16_t* H1 = (bf16_t*)(p.ws + OFF_H1B);
    const size_t gt = (size_t)blockIdx.x * NTHR + opaque_tid(), gn = (size_t)gridDim.x * NTHR;
    for (size_t i = gt; i < (size_t)NB * NL * 128; i += gn) {
        const size_t r = i >> 7; const int k = (int)(i & 127) * 8;
        const float* m = modv1 + (r >= (size_t)NL ? 1 : 0) * 3072;
        const float4 x0 = ld4(p.out + r * DM + k), x1 = ld4(p.out + r * DM + k + 4);
        const float4 s0 = ld4(m + k), s1 = ld4(m + k + 4), c0 = ld4(m + 1024 + k), c1 = ld4(m + 1024 + k + 4);
        *(uint4*)(H1 + r * DM + k) = make_uint4(pack2bf(x0.x * (1.f + c0.x) + s0.x, x0.y * (1.f + c0.y) + s0.y), pack2bf(x0.z * (1.f + c0.z) + s0.z, x0.w * (1.f + c0.w) + s0.w),
                                                pack2bf(x1.x * (1.f + c1.x) + s1.x, x1.y * (1.f + c1.y) + s1.y), pack2bf(x1.z * (1.f + c1.z) + s1.z, x1.w * (1.f + c1.w) + s1.w));
    }
}

DEV void zero_f4(float* ptr, size_t nfloat) {
    const size_t n4 = nfloat / 4;
    for (size_t i = (size_t)blockIdx.x * NTHR + opaque_tid(); i < n4; i += (size_t)gridDim.x * NTHR) ((float4*)ptr)[i] = make_float4(0.f, 0.f, 0.f, 0.f);
}

DEV void chain_ids(int& chain, int& sub) {
    const int bid = blockIdx.x, xcd = bid & 7, idx = bid >> 3;
    chain = xcd * 2 + (idx >> 4); sub = idx & 15;
}

DEV void phase_conv1(const Params& p, float* sm) {
    const bf16_t* XM = (const bf16_t*)(p.ws + OFF_XM);
    bf16_t* XC = (bf16_t*)(p.ws + OFF_XC);
    float* G16P = (float*)(p.ws + OFF_G16P);
    const bf16_t* WFT = (const bf16_t*)(p.ws + OFF_WFT);
    const float* cw = p.in[31]; const float* cbias = p.in[32];
    bf16_t* imgC = (bf16_t*)sm;
    bf16_t* imgM = imgC + 64 * 264;
    float* red = (float*)(imgM + 64 * 264);
    float* cwl = red + 1024;
    const int tid = opaque_tid(), lane = tid & 63, wave = tid >> 6, t = tid >> 3, cg = tid & 7;
    for (int u = blockIdx.x; u < NB * NCH * 4; u += gridDim.x) {
        const int ci = u >> 2, q = u & 3, b = ci / NCH, c = ci % NCH, s = c * 64 + t;
        const size_t rowbase = (size_t)b * TB;
        int nrow[9];
#pragma unroll
        for (int i = 0; i < 3; ++i)
#pragma unroll
            for (int j = 0; j < 3; ++j) {
                int ns = -1;
                if (s < NCX) { const int w2 = s + j - 1; if (i == 1 && w2 >= 0 && w2 < NCX) ns = w2; }
                else { const int n = s - NCX, rr = (n >> 6) + i - 1, w2 = (n & 63) + j - 1; if (rr >= 0 && rr < 128 && w2 >= 0 && w2 < 64) ns = NCX + rr * 64 + w2; }
                nrow[i * 3 + j] = ns;
            }
        const int tt = wave & 3, part = wave >> 2;
        f32x4 acc = (f32x4){0.f, 0.f, 0.f, 0.f};
#pragma unroll 1
        for (int half = 0; half < 2; ++half) {
            __syncthreads();
            for (int i = tid; i < 640; i += NTHR) { const int tp = i >> 6, c4 = (i & 63) * 4; st4(cwl + tp * 256 + c4, ld4((tp < 9 ? cw + tp * 2048 : cbias) + q * 512 + half * 256 + c4)); }
            __syncthreads();
#pragma unroll 2
            for (int it = 0; it < 4; ++it) {
                const int cl = it * 64 + cg * 8, c0 = q * 512 + half * 256 + cl;
                float a8[8];
                { const float4 b0 = ld4(cwl + 9 * 256 + cl), b1 = ld4(cwl + 9 * 256 + cl + 4); a8[0] = b0.x; a8[1] = b0.y; a8[2] = b0.z; a8[3] = b0.w; a8[4] = b1.x; a8[5] = b1.y; a8[6] = b1.z; a8[7] = b1.w; }
                uint4 xmc = make_uint4(0u, 0u, 0u, 0u);
#pragma unroll
                for (int tap = 0; tap < 9; ++tap) {
                    if (nrow[tap] >= 0) {
                        const uint4 xv = *(const uint4*)(XM + (rowbase + nrow[tap]) * 2048 + c0);
                        float x8[8]; unpack8(xv, x8);
                        const float4 w0 = ld4(cwl + tap * 256 + cl), w1 = ld4(cwl + tap * 256 + cl + 4);
                        a8[0] += x8[0] * w0.x; a8[1] += x8[1] * w0.y; a8[2] += x8[2] * w0.z; a8[3] += x8[3] * w0.w;
                        a8[4] += x8[4] * w1.x; a8[5] += x8[5] * w1.y; a8[6] += x8[6] * w1.z; a8[7] += x8[7] * w1.w;
                        if (tap == 4) xmc = xv;
                    }
                }
#pragma unroll
                for (int i = 0; i < 8; ++i) a8[i] = silu_f(a8[i]);
                const uint4 xcv = pack8(a8);
                *(uint4*)(XC + (rowbase + s) * 2048 + c0) = xcv;
                *(uint4*)(imgC + t * 264 + cl) = xcv;
                *(uint4*)(imgM + t * 264 + cl) = xmc;
            }
            __syncthreads();
            {
                const bf16_t* img = part ? imgM : imgC;
                const bf16_t* wrow = WFT + (size_t)(lane & 15) * 4096 + part * 2048 + q * 512 + half * 256 + (lane >> 4) * 8;
#pragma unroll
                for (int ks = 0; ks < 8; ++ks) acc = __builtin_amdgcn_mfma_f32_16x16x32_bf16(row_frag(img, 264, tt * 16, ks * 32, lane), *(const bf16x8*)(wrow + ks * 32), acc, 0, 0, 0);
            }
        }
        if (part == 1) {
#pragma unroll
            for (int r = 0; r < 4; ++r) red[(tt * 16 + (lane >> 4) * 4 + r) * 16 + (lane & 15)] = acc[r];
        }
        __syncthreads();
        if (part == 0) {
#pragma unroll
            for (int r = 0; r < 4; ++r) {
                const int tk = tt * 16 + (lane >> 4) * 4 + r;
                G16P[((size_t)q * RT + rowbase + c * 64 + tk) * 16 + (lane & 15)] = acc[r] + red[tk * 16 + (lane & 15)];
            }
        }
    }
}

DEV void gate_pair(const Params& p, size_t row, int dir, int h, float& gi, float& lf) {
    const float* G16P = (const float*)(p.ws + OFF_G16P);
    float a = 0.f, f = 0.f;
#pragma unroll
    for (int q = 0; q < 4; ++q) { a += G16P[((size_t)q * RT + row) * 16 + dir * 8 + h]; f += G16P[((size_t)q * RT + row) * 16 + dir * 8 + 4 + h]; }
    gi = a + p.in[dir ? 41 : 37][h];
    lf = logsig_f(f + p.in[dir ? 43 : 39][h]);
}

DEV void phase_x1(const Params& p, float* sm) {
    int chain, sub; chain_ids(chain, sub);
    const int b = chain >> 3, h = (chain >> 1) & 3, dir = chain & 1;
    const bf16_t* XC = (const bf16_t*)(p.ws + OFF_XC);
    float* GSC = (float*)(p.ws + OFF_GSC); float* CSC = (float*)(p.ws + OFF_CSC); float* NBUF = (float*)(p.ws + OFF_NBUF);
    const float* gtab = (const float*)(p.ws + OFF_GTAB);
    bf16_t* SMAT = (bf16_t*)(p.ws + OFF_SMAT);
    const int tid = opaque_tid(), lane = tid & 63, wave = tid >> 6;
    float* sTot = sm; float* sRef = sm + 132; float* sM0 = sm + 264; float* sBeta = sm + 400;
    for (int c = wave; c < NCH; c += NWV) {
        const size_t row = (size_t)b * TB + c * 64 + lane;
        float gi, lf; gate_pair(p, row, dir, h, gi, lf);
        const float bc = wave_scan_add(lf, lane, dir);
        const float ref = wave_max(gi - bc), tot = wave_sum(lf);
        if (lane == 0) { sTot[c] = tot; sRef[c] = ref; }
    }
    __syncthreads();
    if (tid == 0) {
        float m0 = -INFINITY;
        for (int step = 0; step < NCH; ++step) {
            const int c = chunk_at(dir, step);
            sM0[c] = m0;
            const float mx = fmaxf(m0, sRef[c]);
            if (sub == 0) { CSC[(chain * NCH + c) * 2] = fexp(m0 - mx); CSC[(chain * NCH + c) * 2 + 1] = fexp(sRef[c] - mx); }
            m0 = sTot[c] + mx;
        }
    }
    __syncthreads();
    for (int k = wave; sub + 16 * k < NCH; k += NWV) {
        const int c = sub + 16 * k;
        const size_t row = (size_t)b * TB + c * 64 + lane;
        float gi, lf; gate_pair(p, row, dir, h, gi, lf);
        const float bc = wave_scan_add(lf, lane, dir);
        const float a = gi - bc;
        const float amax = wave_scan_max(a, lane, dir);
        const float ref = sRef[c], m0 = sM0[c];
        const float mmax = fmaxf(amax, m0);
        const float mt = bc + mmax;
        const float alpha = fexp(ref - mmax), beta = fexp(a - ref), gg = fexp(m0 - mmax), em = fexp(-mt);
        st4(GSC + ((size_t)chain * TB + c * 64 + lane) * 4, make_float4(alpha, beta, gg, em));
        sBeta[k * 64 + lane] = beta;
    }
    __syncthreads();
    {
        float* part = sm + 1024;
        const int sg = tid >> 6, j8 = (tid & 63) * 8;
        for (int k = 0; sub + 16 * k < NCH; ++k) {
            const int c = sub + 16 * k;
            const bf16_t* xp = XC + ((size_t)b * TB + c * 64 + sg * 8) * 2048 + h * 512 + j8;
            float acc[8];
#pragma unroll
            for (int i = 0; i < 8; ++i) acc[i] = 0.f;
#pragma unroll
            for (int s = 0; s < 8; ++s) {
                float f[8]; unpack8(*(const uint4*)(xp + (size_t)s * 2048), f);
                const float be = sBeta[k * 64 + sg * 8 + s];
#pragma unroll
                for (int i = 0; i < 8; ++i) acc[i] += be * f[i];
            }
            __syncthreads();
            st4(part + sg * 512 + j8, make_float4(acc[0], acc[1], acc[2], acc[3])); st4(part + sg * 512 + j8 + 4, make_float4(acc[4], acc[5], acc[6], acc[7]));
            __syncthreads();
            float tot = 0.f;
#pragma unroll
            for (int q = 0; q < 8; ++q) tot += part[q * 512 + tid];
            NBUF[((size_t)chain * NCH + c) * 512 + tid] = tot;
        }
    }
    bf16_t* XCs = (bf16_t*)sm;
    bf16_t* Qs = XCs + 64 * 520;
    for (int u = blockIdx.x; u < NB * 4 * NCH; u += gridDim.x) {
        const int bh = u / NCH, c = u % NCH, ub = bh >> 2, uh = bh & 3;
        __syncthreads();
#pragma unroll 2
        for (int i = 0; i < 8; ++i) {
            const int pp = tid + 512 * i, row = pp >> 6, c16 = pp & 63;
            const uint4 xv = *(const uint4*)(XC + ((size_t)ub * TB + c * 64 + row) * 2048 + uh * 512 + c16 * 8);
            float f[8]; unpack8(xv, f);
            float q[8];
#pragma unroll
            for (int bb = 0; bb < 2; ++bb) {
                const float* G = gtab + (size_t)(uh * 128 + c16 * 2 + bb) * 16;
                const float4 g0 = ld4(G), g1 = ld4(G + 4), g2 = ld4(G + 8), g3 = ld4(G + 12);
                q[bb * 4 + 0] = f[bb * 4] * g0.x + f[bb * 4 + 1] * g1.x + f[bb * 4 + 2] * g2.x + f[bb * 4 + 3] * g3.x;
                q[bb * 4 + 1] = f[bb * 4] * g0.y + f[bb * 4 + 1] * g1.y + f[bb * 4 + 2] * g2.y + f[bb * 4 + 3] * g3.y;
                q[bb * 4 + 2] = f[bb * 4] * g0.z + f[bb * 4 + 1] * g1.z + f[bb * 4 + 2] * g2.z + f[bb * 4 + 3] * g3.z;
                q[bb * 4 + 3] = f[bb * 4] * g0.w + f[bb * 4 + 1] * g1.w + f[bb * 4 + 2] * g2.w + f[bb * 4 + 3] * g3.w;
            }
            *(uint4*)(XCs + row * 520 + c16 * 8) = xv;
            *(uint4*)(Qs + row * 520 + c16 * 8) = make_uint4(pack2bf(q[0], q[1]), pack2bf(q[2], q[3]), pack2bf(q[4], q[5]), pack2bf(q[6], q[7]));
        }
        __syncthreads();
        const int st = wave & 3, tt0 = (wave >> 2) * 2;
        f32x4 a0 = (f32x4){0.f, 0.f, 0.f, 0.f}, a1 = a0;
        const bf16_t* ap = XCs + (st * 16 + (lane & 15)) * 520 + (lane >> 4) * 8;
        const bf16_t* bp0 = Qs + (tt0 * 16 + (lane & 15)) * 520 + (lane >> 4) * 8;
        const bf16_t* bp1 = bp0 + 16 * 520;
#pragma unroll
        for (int ks = 0; ks < 16; ++ks) {
            const bf16x8 af = *(const bf16x8*)(ap + ks * 32);
            a0 = __builtin_amdgcn_mfma_f32_16x16x32_bf16(af, *(const bf16x8*)(bp0 + ks * 32), a0, 0, 0, 0);
            a1 = __builtin_amdgcn_mfma_f32_16x16x32_bf16(af, *(const bf16x8*)(bp1 + ks * 32), a1, 0, 0, 0);
        }
        bf16_t* sp = SMAT + (size_t)u * 4096 + (size_t)(tt0 * 16 + (lane & 15)) * 64 + st * 16 + (lane >> 4) * 4;
        *(uint2*)sp = make_uint2(pack2bf(a0[0], a0[1]), pack2bf(a0[2], a0[3]));
        *(uint2*)(sp + 16 * 64) = make_uint2(pack2bf(a1[0], a1[1]), pack2bf(a1[2], a1[3]));
    }
}

DEV void phase_x2(const Params& p, float* sm) {
    int chain, sub; chain_ids(chain, sub);
    const int b = chain >> 3, h = (chain >> 1) & 3, dir = chain & 1;
    const bf16_t* XC = (const bf16_t*)(p.ws + OFF_XC);
    float* GSC = (float*)(p.ws + OFF_GSC); const float* CSC = (const float*)(p.ws + OFF_CSC); const float* NBUF = (const float*)(p.ws + OFF_NBUF);
    const float* gtab = (const float*)(p.ws + OFF_GTAB);
    const bf16_t* SMAT = (const bf16_t*)(p.ws + OFF_SMAT);
    const int tid = opaque_tid();
    float* sD0 = sm; float* sCf = sm + 132; float* sN0 = sm + 264; float* sN2 = sN0 + 9 * 512;
    for (int i = tid; i < NCH; i += NTHR) { sD0[i] = CSC[(chain * NCH + i) * 2]; sCf[i] = CSC[(chain * NCH + i) * 2 + 1]; }
    __syncthreads();
    float* sBeta = sN2 + 9 * 512;
    for (int i = tid; i < 9 * 64; i += NTHR) { const int k = i >> 6, c = sub + 16 * k; if (c < NCH) sBeta[i] = GSC[((size_t)chain * TB + c * 64 + (i & 63)) * 4 + 1]; }
    if (tid < 128) {
        constexpr int NBT = 12;
        float4 n = make_float4(0.f, 0.f, 0.f, 0.f), nx[NBT];
        const float* nb = NBUF + (size_t)chain * NCH * 512 + tid * 4;
#pragma unroll
        for (int j = 0; j < NBT; ++j) nx[j] = ld4(nb + (size_t)chunk_at(dir, j) * 512);
#pragma unroll 1
        for (int step0 = 0; step0 < NCH; step0 += NBT) {
            float4 cu[NBT];
#pragma unroll
            for (int j = 0; j < NBT; ++j) cu[j] = nx[j];
#pragma unroll
            for (int j = 0; j < NBT; ++j) { const int sn = step0 + NBT + j; nx[j] = ld4(nb + (size_t)chunk_at(dir, sn < NCH ? sn : NCH - 1) * 512); }
            __builtin_amdgcn_sched_barrier(0);
#pragma unroll
            for (int j = 0; j < NBT; ++j) {
                const int c = chunk_at(dir, step0 + j);
                if ((c & 15) == sub) st4(sN0 + (c >> 4) * 512 + tid * 4, n);
                const float d = sD0[c], cf = sCf[c];
                n = make_float4(d * n.x + cf * cu[j].x, d * n.y + cf * cu[j].y, d * n.z + cf * cu[j].z, d * n.w + cf * cu[j].w);
            }
        }
    }
    __syncthreads();
    {
        const int blk = tid >> 2, cp = tid & 3;
        const float4 g = ld4(gtab + (size_t)(h * 128 + blk) * 16 + cp * 4);
        for (int k = 0; sub + 16 * k < NCH; ++k) {
            const float* n0 = sN0 + k * 512 + blk * 4;
            sN2[k * 512 + tid] = g.x * n0[0] + g.y * n0[1] + g.z * n0[2] + g.w * n0[3];
        }
    }
    __syncthreads();
    const int t = tid >> 3, part = tid & 7;
    for (int k = 0; sub + 16 * k < NCH; ++k) {
        const int c = sub + 16 * k;
        const size_t row = (size_t)b * TB + c * 64 + t;
        float dint = 0.f;
        {
            const bf16_t* xp = XC + row * 2048 + h * 512 + part * 64;
            const float* n2 = sN2 + k * 512 + part * 64;
#pragma unroll
            for (int i = 0; i < 8; ++i) {
                float f[8]; unpack8(*(const uint4*)(xp + i * 8), f);
                const float4 na = ld4(n2 + i * 8), nb2 = ld4(n2 + i * 8 + 4);
                dint += f[0] * na.x + f[1] * na.y + f[2] * na.z + f[3] * na.w + f[4] * nb2.x + f[5] * nb2.y + f[6] * nb2.z + f[7] * nb2.w;
            }
        }
        float di = 0.f;
        {
            float f[8]; unpack8(*(const uint4*)(SMAT + ((size_t)((b * 4 + h) * NCH + c)) * 4096 + t * 64 + part * 8), f);
#pragma unroll
            for (int e = 0; e < 8; ++e) {
                const int s = part * 8 + e;
                const float beta = sBeta[k * 64 + s];
                const bool keep = dir ? (s >= t) : (s <= t);
                di += keep ? f[e] * beta : 0.f;
            }
        }
        dint += __shfl_xor(dint, 1, 64); dint += __shfl_xor(dint, 2, 64); dint += __shfl_xor(dint, 4, 64);
        di += __shfl_xor(di, 1, 64); di += __shfl_xor(di, 2, 64); di += __shfl_xor(di, 4, 64);
        if (part == 0) {
            float* gp = GSC + ((size_t)chain * TB + c * 64 + t) * 4;
            const float4 g4 = ld4(gp);
            const float den = g4.x * di + g4.z * dint;
            gp[3] = 1.f / fmaxf(fabsf(den), g4.w);
        }
    }
}

#define MLSTM_PREFETCH(step_) do { \
    const int c_ = chunk_at(dir, (step_)); const size_t rb_ = (size_t)b * TB + (size_t)c_ * 64; \
    { const bf16_t* xb_ = XC + (rb_ + (tid >> 6)) * 2048 + h * 512 + (tid & 63) * 8; \
      rx0 = *(const uint4*)(xb_); rx1 = *(const uint4*)(xb_ + 8 * 2048); rx2 = *(const uint4*)(xb_ + 16 * 2048); rx3 = *(const uint4*)(xb_ + 24 * 2048); \
      rx4 = *(const uint4*)(xb_ + 32 * 2048); rx5 = *(const uint4*)(xb_ + 40 * 2048); rx6 = *(const uint4*)(xb_ + 48 * 2048); rx7 = *(const uint4*)(xb_ + 56 * 2048); } \
    rxm = *(const uint2*)(XM + (rb_ + ps) * 2048 + ch0 + pvb * 4); \
    rs = *(const uint4*)(SMAT + ((size_t)((b * 4 + h) * NCH + c_)) * 4096 + ps * 64 + pvb * 8); \
    rbeta = GSC[((size_t)chain * TB + c_ * 64 + ps) * 4 + 1]; \
    if (tid < 64) rsc = ld4(GSC + ((size_t)chain * TB + c_ * 64 + tid) * 4); \
    rd0 = CSC[(chain * NCH + c_) * 2]; rcf = CSC[(chain * NCH + c_) * 2 + 1]; } while (0)

DEV void phase_mlstm(const Params& p, float* sm) {
    int chain, sub; chain_ids(chain, sub);
    const int b = chain >> 3, h = (chain >> 1) & 3, dir = chain & 1;
    const bf16_t* XM = (const bf16_t*)(p.ws + OFF_XM);
    const bf16_t* XC = (const bf16_t*)(p.ws + OFF_XC);
    const bf16_t* SMAT = (const bf16_t*)(p.ws + OFF_SMAT);
    const float* GSC = (const float*)(p.ws + OFF_GSC); const float* CSC = (const float*)(p.ws + OFF_CSC);
    const float* gtab = (const float*)(p.ws + OFF_GTAB);
    bf16_t* H = (bf16_t*)(p.ws + OFF_H);
    const float* wv = p.in[35];
    char* smc = (char*)sm;
    bf16_t* XCs = (bf16_t*)smc;
    bf16_t* Cs = (bf16_t*)(smc + 66560);
    bf16_t* Vb = (bf16_t*)(smc + 66560 + 33280);
    bf16_t* Vw = Vb + 32 * 72;
    bf16_t* Sm = Vw + 32 * 72;
    float* Gs = (float*)(smc + 66560 + 33280 + 2 * 4608 + 9216);
    float* sc = Gs + 2048;
    const int tid = opaque_tid(), lane = tid & 63, wave = tid >> 6;
    for (int i = tid; i < 32 * 520 / 2; i += NTHR) ((unsigned*)Cs)[i] = 0u;
    for (int i = tid; i < 2048; i += NTHR) Gs[i] = gtab[h * 2048 + i];
    const int ps = tid >> 3, pvb = tid & 7;
    const int ch0 = h * 512 + sub * 32;
    float wvr[16];
#pragma unroll
    for (int i = 0; i < 16; ++i) wvr[i] = wv[(size_t)((ch0 >> 2) + pvb) * 16 + i];
    f32x4 accS[4][2];
#pragma unroll
    for (int i = 0; i < 4; ++i) { accS[i][0] = (f32x4){0.f, 0.f, 0.f, 0.f}; accS[i][1] = (f32x4){0.f, 0.f, 0.f, 0.f}; }
    uint4 rx0, rx1, rx2, rx3, rx4, rx5, rx6, rx7; uint2 rxm; uint4 rs; float rbeta; float4 rsc = make_float4(0.f, 0.f, 0.f, 0.f); float rd0, rcf;
    MLSTM_PREFETCH(0);
    __syncthreads();
#pragma unroll 1
    for (int step = 0; step < NCH; ++step) {
        const int c = chunk_at(dir, step);
        const float d0 = rd0, cf = rcf;
        {
            bf16_t* xd = XCs + (tid >> 6) * 520 + (tid & 63) * 8;
            *(uint4*)(xd) = rx0; *(uint4*)(xd + 8 * 520) = rx1; *(uint4*)(xd + 16 * 520) = rx2; *(uint4*)(xd + 24 * 520) = rx3;
            *(uint4*)(xd + 32 * 520) = rx4; *(uint4*)(xd + 40 * 520) = rx5; *(uint4*)(xd + 48 * 520) = rx6; *(uint4*)(xd + 56 * 520) = rx7;
        }
        {
            const float x0 = bflo(rxm.x), x1 = bfhi(rxm.x), x2 = bflo(rxm.y), x3 = bfhi(rxm.y);
#pragma unroll
            for (int d = 0; d < 4; ++d) {
                const float v = (x0 * wvr[d] + x1 * wvr[4 + d] + x2 * wvr[8 + d] + x3 * wvr[12 + d]) * rbeta;
                Vb[(pvb * 4 + d) * 72 + ps] = __builtin_bit_cast(unsigned short, (__bf16)v);
                Vw[(pvb * 4 + d) * 72 + ps] = __builtin_bit_cast(unsigned short, (__bf16)(v * cf));
            }
        }
        {
#define SMASK(q_) (((dir ? (pvb * 8 + 2 * (q_) >= ps) : (pvb * 8 + 2 * (q_) <= ps)) ? 0x0000ffffu : 0u) | ((dir ? (pvb * 8 + 2 * (q_) + 1 >= ps) : (pvb * 8 + 2 * (q_) + 1 <= ps)) ? 0xffff0000u : 0u))
            *(uint4*)(Sm + ps * 72 + pvb * 8) = make_uint4(rs.x & SMASK(0), rs.y & SMASK(1), rs.z & SMASK(2), rs.w & SMASK(3));
#undef SMASK
        }
        if (tid < 64) st4(sc + tid * 4, rsc);
        { const int nstep = (step + 1 < NCH) ? step + 1 : step; MLSTM_PREFETCH(nstep); }
        __syncthreads();
        {
            const int vt = wave & 1, tt = wave >> 1;
            f32x4 ao = (f32x4){0.f, 0.f, 0.f, 0.f}, ai = ao, ao1 = ao, ao2 = ao, ao3 = ao;
            const bf16_t* ap = Cs + (vt * 16 + (lane & 15)) * 520 + (lane >> 4) * 8;
            const bf16_t* bp = XCs + (tt * 16 + (lane & 15)) * 520 + (lane >> 4) * 8;
#pragma unroll
            for (int ks = 0; ks < 16; ks += 4) {
                ao = __builtin_amdgcn_mfma_f32_16x16x32_bf16(*(const bf16x8*)(ap + ks * 32), *(const bf16x8*)(bp + ks * 32), ao, 0, 0, 0);
                ao1 = __builtin_amdgcn_mfma_f32_16x16x32_bf16(*(const bf16x8*)(ap + (ks + 1) * 32), *(const bf16x8*)(bp + (ks + 1) * 32), ao1, 0, 0, 0);
                ao2 = __builtin_amdgcn_mfma_f32_16x16x32_bf16(*(const bf16x8*)(ap + (ks + 2) * 32), *(const bf16x8*)(bp + (ks + 2) * 32), ao2, 0, 0, 0);
                ao3 = __builtin_amdgcn_mfma_f32_16x16x32_bf16(*(const bf16x8*)(ap + (ks + 3) * 32), *(const bf16x8*)(bp + (ks + 3) * 32), ao3, 0, 0, 0);
            }
            ao = (ao + ao1) + (ao2 + ao3);
            const bf16_t* ap2 = Vb + (vt * 16 + (lane & 15)) * 72 + (lane >> 4) * 8;
            const bf16_t* bp2 = Sm + (tt * 16 + (lane & 15)) * 72 + (lane >> 4) * 8;
#pragma unroll
            for (int ks = 0; ks < 2; ++ks) ai = __builtin_amdgcn_mfma_f32_16x16x32_bf16(*(const bf16x8*)(ap2 + ks * 32), *(const bf16x8*)(bp2 + ks * 32), ai, 0, 0, 0);
            if (c >= 4) {
                const int t = tt * 16 + (lane & 15);
                const float4 s4 = ld4(sc + t * 4);
                const float h0 = (s4.x * ai[0] + s4.z * ao[0]) * s4.w, h1 = (s4.x * ai[1] + s4.z * ao[1]) * s4.w;
                const float h2 = (s4.x * ai[2] + s4.z * ao[2]) * s4.w, h3 = (s4.x * ai[3] + s4.z * ao[3]) * s4.w;
                bf16_t* hp = H + ((size_t)b * NL + (size_t)c * 64 + t - NCX) * 2048 + ch0 + vt * 16 + (lane >> 4) * 4;
                const unsigned u0 = pack2bf(h0, h1), u1 = pack2bf(h2, h3);
                __builtin_amdgcn_global_atomic_fadd_v2bf16((__attribute__((address_space(1))) s16x2*)hp, __builtin_bit_cast(s16x2, u0));
                __builtin_amdgcn_global_atomic_fadd_v2bf16((__attribute__((address_space(1))) s16x2*)(hp + 2), __builtin_bit_cast(s16x2, u1));
            }
        }
#pragma unroll
        for (int jt = 0; jt < 4; ++jt) { accS[jt][0] *= d0; accS[jt][1] *= d0; }
#pragma unroll
        for (int ks = 0; ks < 2; ++ks) {
            const bf16x8 b0 = *(const bf16x8*)(Vw + (lane & 15) * 72 + ks * 32 + (lane >> 4) * 8);
            const bf16x8 b1 = *(const bf16x8*)(Vw + (16 + (lane & 15)) * 72 + ks * 32 + (lane >> 4) * 8);
            const int row0 = ks * 32 + (lane >> 4) * 8 + ((lane & 15) >> 2);
#pragma unroll
            for (int jt = 0; jt < 4; ++jt) {
                const int col = wave * 64 + jt * 16 + (lane & 3) * 4;
                const s16x4 lo = __builtin_amdgcn_ds_read_tr16_b64_v4i16((__attribute__((address_space(3))) s16x4*)(XCs + row0 * 520 + col));
                const s16x4 hi = __builtin_amdgcn_ds_read_tr16_b64_v4i16((__attribute__((address_space(3))) s16x4*)(XCs + (row0 + 4) * 520 + col));
                const bf16x8 af = (bf16x8){lo[0], lo[1], lo[2], lo[3], hi[0], hi[1], hi[2], hi[3]};
                accS[jt][0] = __builtin_amdgcn_mfma_f32_16x16x32_bf16(af, b0, accS[jt][0], 0, 0, 0);
                accS[jt][1] = __builtin_amdgcn_mfma_f32_16x16x32_bf16(af, b1, accS[jt][1], 0, 0, 0);
            }
        }
        __syncthreads();
#pragma unroll
        for (int jt = 0; jt < 4; ++jt) {
            const int blk = wave * 16 + jt * 4 + (lane >> 4);
            const float4 g0 = ld4(Gs + blk * 16), g1 = ld4(Gs + blk * 16 + 4), g2 = ld4(Gs + blk * 16 + 8), g3 = ld4(Gs + blk * 16 + 12);
#pragma unroll
            for (int v2 = 0; v2 < 2; ++v2) {
                const f32x4 a = accS[jt][v2];
                const float o0 = g0.x * a[0] + g0.y * a[1] + g0.z * a[2] + g0.w * a[3];
                const float o1 = g1.x * a[0] + g1.y * a[1] + g1.z * a[2] + g1.w * a[3];
                const float o2 = g2.x * a[0] + g2.y * a[1] + g2.z * a[2] + g2.w * a[3];
                const float o3 = g3.x * a[0] + g3.y * a[1] + g3.z * a[2] + g3.w * a[3];
                *(uint2*)(Cs + (v2 * 16 + (lane & 15)) * 520 + blk * 4) = make_uint2(pack2bf(o0, o1), pack2bf(o2, o3));
            }
        }
    }
}

DEV void phase_finish1(const Params& p) {
    bf16_t* H = (bf16_t*)(p.ws + OFF_H);
    const bf16_t* XC = (const bf16_t*)(p.ws + OFF_XC);
    const bf16_t* Z = (const bf16_t*)(p.ws + OFF_XM);
    const float* ng = p.in[44]; const float* skip = p.in[45];
    const int tid_ = opaque_tid(); const int lane = tid_ & 63, gw = blockIdx.x * NWV + (tid_ >> 6), ngw = gridDim.x * NWV;
    for (int it = gw; it < NB * NL * 4; it += ngw) {
        const int r = it >> 2, h = it & 3, b = r >= NL ? 1 : 0, nn = r - b * NL;
        const int c0 = h * 512 + lane * 8;
        bf16_t* hp = H + (size_t)r * 2048 + c0;
        float v[8]; unpack8(*(const uint4*)hp, v);
        float sum = 0.f;
#pragma unroll
        for (int j = 0; j < 8; ++j) sum += v[j];
        const float mean = wave_sum(sum) * (1.f / 512.f);
        float sq = 0.f;
#pragma unroll
        for (int j = 0; j < 8; ++j) { v[j] -= mean; sq += v[j] * v[j]; }
        const float rstd = rsqrtf(wave_sum(sq) * (1.f / 512.f) + 1e-5f);
        float xc[8], z[8];
        unpack8(*(const uint4*)(XC + ((size_t)b * TB + NCX + nn) * 2048 + c0), xc);
        unpack8(*(const uint4*)(Z + (size_t)r * 2048 + c0), z);
        float o[8];
#pragma unroll
        for (int j = 0; j < 8; ++j) o[j] = (v[j] * rstd * ng[c0 + j] + skip[c0 + j] * xc[j]) * silu_f(z[j]);
        *(uint4*)hp = make_uint4(pack2bf(o[0], o[1]), pack2bf(o[2], o[3]), pack2bf(o[4], o[5]), pack2bf(o[6], o[7]));
    }
}

__global__ void __launch_bounds__(NTHR) fwd_kernel(Params p) {
    extern __shared__ __attribute__((aligned(16))) float sm[];
    volatile LAS unsigned* xst = (volatile LAS unsigned*)((LAS char*)sm + (LDS_BYTES - 16));
    if (threadIdx.x == 0) { xst[0] = 0u; xst[1] = 0u; }
    __syncthreads();
    const XcdBarrier xbar = xcd_barrier_post((unsigned*)(p.ws + OFF_BAR), xst);
    const int tid = opaque_tid(), lane = tid & 63, wave = tid >> 6;
    float* modv = (float*)(p.ws + OFF_MODV);
    float* X1C = (float*)(p.ws + OFF_X1C);

    phase_mod(p, sm);
    phase_tables(p);
    transpose_convert(p.in[8], 1024, EIN, 4096, (bf16_t*)(p.ws + OFF_WT0), sm);
    transpose_convert(p.in[29], 1024, 4096, 4096, (bf16_t*)(p.ws + OFF_WT1), sm);
    transpose_convert(p.in[9], 1024, 1024, 1024, (bf16_t*)(p.ws + OFF_WT2), sm);
    transpose_convert(p.in[30], 2048, 1024, 1024, (bf16_t*)(p.ws + OFF_WT3), sm);
    xcd_barrier(xbar);

#pragma unroll 1
    for (int b = 0; b < NB; ++b) {
        if (b == 0) { phase_h0(p, 0); xcd_barrier(xbar); }
        run_gemm((const bf16_t*)(p.ws + OFF_YC), (const bf16_t*)(p.ws + OFF_WT0), TB, 4096, DM, EpBf16{(bf16_t*)(p.ws + OFF_P0), EIN, EIN}, sm);
        xcd_barrier(xbar);
        {
            const int x = blockIdx.x & 7, q0 = blockIdx.x >> 3;
            R1Raw R;
            r1_consts(p, x, q0 & 1, sm);
            r1_load(p, x, q0 & 1, q0 >> 1, R);
            for (int q = q0; q < 3 * NCH; q += 32) {
                if (q < 2 * NCH) rwkv1_unit(p, x, q & 1, q >> 1, sm, R, (q + 32 < 2 * NCH) ? ((q + 32) >> 1) : -1);
                else { const int q2 = q - 2 * NCH; gla1_unit(p, x >> 1, q2 & 1, (NCH / 2) * (x & 1) + (q2 >> 1), sm); }
            }
        }
        xcd_barrier(xbar);
        if (blockIdx.x < 128) gla2_unit(p, blockIdx.x);
        else if (blockIdx.x < 192) rwkv2_unit(p, (blockIdx.x - 128) >> 2, (blockIdx.x - 128) & 3, sm);
        xcd_barrier(xbar);
        for (int q = blockIdx.x >> 3; q < NCH + NCH / 2; q += 32) {
            const int x = blockIdx.x & 7;
            if (q < NCH) rwkv3_unit(p, x, q, sm);
            else gla3_unit(p, x >> 1, (NCH / 2) * (x & 1) + (q - NCH), sm);
        }
        xcd_barrier(xbar);
        run_gemm((const bf16_t*)(p.ws + OFF_YC), (const bf16_t*)(p.ws + OFF_WT2), TB, DM, DM, EpRes0{(float*)(p.ws + OFF_P0), modv, b}, sm);
        xcd_barrier(xbar);
        ln_rows((const float*)(p.ws + OFF_P0), p.in[0] + (size_t)b * NL * DM, p.in[2] + (size_t)b * NCX * DM, TB, p.in[6], p.in[7], p.out + (size_t)b * NL * DM, X1C + (size_t)b * NCX * DM, NCX,
                (bf16_t*)(p.ws + OFF_H1B) + (size_t)b * TB * DM, modv + (3 + 2) * 3072, modv + (3 + b) * 3072);
        if (b == 0) phase_h0(p, 1);
        xcd_barrier(xbar);
    }

    run_gemm((const bf16_t*)(p.ws + OFF_H1B), (const bf16_t*)(p.ws + OFF_WT1), RT, 2048, DM, EpBf16{(bf16_t*)(p.ws + OFF_XM), 2048, 2048}, sm);
    zero_f4((float*)(p.ws + OFF_H), (size_t)NB * NL * 1024);
    xcd_barrier(xbar);
    phase_conv1(p, sm);
    xcd_barrier(xbar);
    phase_x1(p, sm);
    xcd_barrier(xbar);
    phase_x2(p, sm);
    xcd_barrier(xbar);
    phase_mlstm(p, sm);
    xcd_barrier(xbar);
    phase_h1l(p);
    xcd_barrier(xbar);
    run_gemm((const bf16_t*)(p.ws + OFF_H1B), (const bf16_t*)(p.ws + OFF_WT1) + (size_t)2048 * 1024, NB * NL, 2048, DM, EpBf16{(bf16_t*)(p.ws + OFF_XM), 2048, 2048}, sm);
    xcd_barrier(xbar);
    phase_finish1(p);
    xcd_barrier(xbar);
    run_gemm((const bf16_t*)(p.ws + OFF_H), (const bf16_t*)(p.ws + OFF_WT3), NB * NL, DM, 2048, EpRes1{(float*)(p.ws + OFF_XC), modv + 3 * 3072}, sm);
    xcd_barrier(xbar);
    ln_rows((const float*)(p.ws + OFF_XC), p.out, p.out, NB * NL, p.in[6] + 1024, p.in[7] + 1024, p.out, p.out, 0);
}

extern "C" void kernel_launch(void* const* d_in, const int* in_sizes, int n_in, void* d_out, int out_size, void* d_ws, size_t ws_size, hipStream_t stream) {
    static int grid_blocks = 0;
    if (grid_blocks == 0) {
        if (ws_size < WS_NEED || n_in != 46) { fprintf(stderr, "kernel_launch: bad ws_size %zu (need %zu) or n_in %d\n", ws_size, (size_t)WS_NEED, n_in); grid_blocks = -1; return; }
        int dev = 0, cus = 0, per_cu = 0;
        (void)hipGetDevice(&dev);
        (void)hipDeviceGetAttribute(&cus, hipDeviceAttributeMultiprocessorCount, dev);
        (void)hipFuncSetAttribute((const void*)fwd_kernel, hipFuncAttributeMaxDynamicSharedMemorySize, LDS_BYTES);
        (void)hipOccupancyMaxActiveBlocksPerMultiprocessor(&per_cu, (const void*)fwd_kernel, NTHR, LDS_BYTES);
        if (per_cu < 1 || cus < 256) { fprintf(stderr, "kernel_launch: occupancy query says %d blocks/CU on %d CUs; this kernel needs 256 resident workgroups\n", per_cu, cus); grid_blocks = -1; return; }
        grid_blocks = 256;
    }
    if (grid_blocks < 0) return;
    (void)hipMemsetAsync((char*)d_ws + OFF_BAR, 0, XCD_BAR_WORDS * 4, stream);
    Params p{};
    for (int i = 0; i < 46; ++i) p.in[i] = (const float*)d_in[i];
    p.out = (float*)d_out; p.ws = (char*)d_ws;
    void* args[] = {&p};
    hipError_t e = hipLaunchCooperativeKernel((const void*)fwd_kernel, dim3(grid_blocks), dim3(NTHR), args, LDS_BYTES, stream);
    if (e != hipSuccess) fprintf(stderr, "cooperative launch failed: %s (grid %d)\n", hipGetErrorString(e), grid_blocks);
}
```

```cpp
#include <hip/hip_runtime.h>
#include <cstdio>
#include <cmath>

#define DEV __device__ __forceinline__

constexpr int NB = 2, NL = 8192, DM = 1024, NCX = 256, TB = NCX + NL;
constexpr int RT = NB * TB;
constexpr int NCH = TB / 64;
constexpr int EIN = 3872, RW0 = 1568;
constexpr int NTHR = 512, NWV = 8;
constexpr float ALPHA = 1.41421356237f;
constexpr float KSCALE = 0.04419417382f;

constexpr size_t OFF_MODV = 0;
constexpr size_t OFF_X1C  = 131072;
constexpr size_t OFF_BAR  = 3145728;
constexpr size_t OFF_BIG  = 4194304;
constexpr size_t OFF_P0   = OFF_BIG;
constexpr size_t OFF_YC   = OFF_BIG + (size_t)TB * EIN * 2;
constexpr size_t OFF_GDS  = OFF_YC + (size_t)TB * 1024 * 2;
constexpr size_t OFF_GDEC = OFF_GDS + (size_t)8 * NCH * 8192 * 4;
constexpr size_t OFF_RU   = OFF_GDEC + (size_t)8 * NCH * 64 * 4;
constexpr size_t OFF_RS0  = OFF_RU + (size_t)16 * NCH * 16384 * 2;
constexpr size_t OFF_BONS = OFF_RS0 + (size_t)16 * NCH * 4096 * 2;
constexpr size_t L0_END   = OFF_BONS + (size_t)2 * TB * 8 * 4;
constexpr size_t OFF_XM   = OFF_BIG;
constexpr size_t OFF_XC   = OFF_XM + (size_t)RT * 2048 * 2;
constexpr size_t OFF_H    = OFF_XC + (size_t)RT * 2048 * 2;
constexpr size_t OFF_WT0  = OFF_H + (size_t)NB * NL * 2048 * 2;
constexpr size_t OFF_WT1  = OFF_WT0 + (size_t)4096 * 1024 * 2;
constexpr size_t OFF_WT2  = OFF_WT1 + (size_t)4096 * 1024 * 2;
constexpr size_t OFF_WT3  = OFF_WT2 + (size_t)1024 * 1024 * 2;
constexpr size_t OFF_G16  = OFF_WT3 + (size_t)1024 * 2048 * 2;
constexpr size_t OFF_SMAT = OFF_G16 + (size_t)RT * 16 * 4;
constexpr size_t OFF_GSC  = OFF_SMAT + (size_t)NB * 4 * NCH * 4096 * 2;
constexpr size_t OFF_CSC  = OFF_GSC + (size_t)16 * TB * 4 * 4;
constexpr size_t OFF_NBUF = OFF_CSC + (size_t)16 * NCH * 2 * 4;
constexpr size_t OFF_GTAB = 3407872;
constexpr size_t OFF_WFT  = OFF_GTAB + (size_t)4 * 128 * 16 * 4;
static_assert(OFF_WFT + (size_t)16 * 4096 * 2 <= OFF_BIG, "low-region tables overflow");
constexpr size_t OFF_G16P = OFF_NBUF + (size_t)16 * NCH * 512 * 4;
constexpr size_t OFF_H1B  = OFF_G16;
constexpr size_t WS_NEED  = (OFF_G16P + (size_t)4 * RT * 16 * 4 > OFF_H1B + (size_t)RT * 1024 * 2) ? OFF_G16P + (size_t)4 * RT * 16 * 4 : OFF_H1B + (size_t)RT * 1024 * 2;
static_assert(WS_NEED <= (size_t)256 * 1024 * 1024, "workspace exceeds the guaranteed 256 MiB");

static_assert(L0_END <= OFF_WT0, "layer-0 buffers overlap the weight copies");
constexpr int LDS_BYTES = 139264;

struct Params { const float* in[46]; float* out; char* ws; };
typedef unsigned short bf16_t;
typedef __attribute__((ext_vector_type(8))) short bf16x8;
typedef __attribute__((ext_vector_type(4))) short s16x4;
typedef __attribute__((ext_vector_type(2))) short s16x2;
typedef __attribute__((ext_vector_type(4))) float f32x4;
typedef __attribute__((ext_vector_type(2))) __bf16 bf2_t;
DEV unsigned pack2bf(float lo, float hi) { bf2_t v; v[0] = (__bf16)lo; v[1] = (__bf16)hi; return __builtin_bit_cast(unsigned, v); }
DEV float bflo(unsigned u) { return __uint_as_float(u << 16); }
DEV float bfhi(unsigned u) { return __uint_as_float(u & 0xffff0000u); }
DEV float bf2f(bf16_t v) { return __uint_as_float(((unsigned)v) << 16); }
DEV void unpack8(uint4 u, float* f) { f[0] = bflo(u.x); f[1] = bfhi(u.x); f[2] = bflo(u.y); f[3] = bfhi(u.y); f[4] = bflo(u.z); f[5] = bfhi(u.z); f[6] = bflo(u.w); f[7] = bfhi(u.w); }

DEV float wave_sum(float v) {
#pragma unroll
    for (int o = 32; o > 0; o >>= 1) v += __shfl_xor(v, o, 64);
    return v;
}
DEV float wave_max(float v) {
#pragma unroll
    for (int o = 32; o > 0; o >>= 1) v = fmaxf(v, __shfl_xor(v, o, 64));
    return v;
}
DEV float fexp(float x) { return __expf(x); }
DEV float frcp(float x) { return __builtin_amdgcn_rcpf(x); }
DEV float sigmoid_f(float x) { return frcp(1.f + fexp(-x)); }
DEV float silu_f(float x) { return x * frcp(1.f + fexp(-x)); }
DEV float logsig_f(float x) { return fminf(x, 0.f) - __logf(1.f + fexp(-fabsf(x))); }
DEV float tanh_f(float x) { const float e = fexp(2.f * x); return 1.f - 2.f * frcp(e + 1.f); }
DEV void lds_fence() { asm volatile("" ::: "memory"); }
DEV int opaque_tid() { int t = threadIdx.x; asm volatile("" : "+v"(t)); return t; }
DEV int scan_s(int dir, int u) { return dir == 0 ? u : (u < NCX ? (NCX - 1 - u) : (TB - 1 + NCX - u)); }
DEV int chunk_at(int dir, int step) { return dir == 0 ? step : (step < 4 ? 3 - step : (NCH + 3 - step)); }
DEV float4 ld4(const float* p) { return *(const float4*)p; }
DEV void st4(float* p, float4 v) { *(float4*)p = v; }


#define XB_TMO      128
#define XB_XCNT(j)  (256  + 64 * (j))
#define XB_XSUB(j)  (1280 + 64 * (j))
#define XB_XGEN(j)  (2304 + 64 * (j))
#define XB_TOP      3328
#define XB_TOPGEN   3392
#define XCD_BAR_WORDS 3456
#define XB_SPIN_CAP (1u << 22)
#define LAS __attribute__((address_space(3)))
DEV unsigned xb_ld(unsigned* p) { return __hip_atomic_load(p, __ATOMIC_RELAXED, __HIP_MEMORY_SCOPE_AGENT); }
DEV unsigned xb_add(unsigned* p, unsigned v) { return __hip_atomic_fetch_add(p, v, __ATOMIC_RELAXED, __HIP_MEMORY_SCOPE_AGENT); }
DEV unsigned xb_xcc_id() { return (unsigned)__builtin_amdgcn_s_getreg((3 << 11) | 20) & 0xFu; }
#define XB_SPIN(cond, bar) do { unsigned _sp = 0; while (cond) { __builtin_amdgcn_s_sleep(1); \
    if ((++_sp & 255u) == 0u) { if (xb_ld(&(bar)[XB_TMO])) break; if (_sp > XB_SPIN_CAP) { atomicAdd(&(bar)[XB_TMO], 1u); break; } } } } while (0)
struct XcdBarrier { unsigned* bar; unsigned x; volatile LAS unsigned* st; };
DEV XcdBarrier xcd_barrier_post(unsigned* bar, volatile LAS unsigned* st) {
    XcdBarrier b; b.bar = bar; b.x = xb_xcc_id(); b.st = st;
    if (threadIdx.x == 0) (void)xb_add(&bar[XB_XCNT(b.x)], 1u);
    return b;
}
DEV void xcd_barrier_complete(unsigned* bar, unsigned x, unsigned& nloc, unsigned& nx) {
    const unsigned G = gridDim.x * gridDim.y * gridDim.z;
    unsigned sum, cnt, mine, sp = 0u;
    for (;;) {
        sum = 0u; cnt = 0u; mine = 0u;
#pragma unroll
        for (unsigned j = 0; j < 16; ++j) { const unsigned c = xb_ld(&bar[XB_XCNT(j)]); sum += c; cnt += (c > 0u) ? 1u : 0u; mine = (j == x) ? c : mine; }
        if (sum == G) break;
        __builtin_amdgcn_s_sleep(1);
        if ((++sp & 255u) == 0u) { if (xb_ld(&bar[XB_TMO])) break; if (sp > XB_SPIN_CAP) { atomicAdd(&bar[XB_TMO], 1u); break; } }
    }
    nloc = mine > 0u ? mine : 1u; nx = cnt > 0u ? cnt : 1u;
}
DEV void xcd_barrier(const XcdBarrier& b) {
    asm volatile("s_waitcnt vmcnt(0)" ::: "memory");
    __syncthreads();
    if (threadIdx.x == 0) {
        unsigned* bar = b.bar;
        __builtin_amdgcn_s_waitcnt(0);
        unsigned nloc = b.st[0], nx = b.st[1];
        if (nloc == 0u) { xcd_barrier_complete(bar, b.x, nloc, nx); b.st[0] = nloc; b.st[1] = nx; }
        const unsigned old = xb_add(&bar[XB_XSUB(b.x)], 1u);
        const unsigned gen = old / nloc;
        if (old + 1u == (gen + 1u) * nloc) {
            __builtin_amdgcn_fence(__ATOMIC_RELEASE, "agent");
            asm volatile("s_waitcnt vmcnt(0)" ::: "memory");
            const unsigned og = xb_add(&bar[XB_TOP], 1u);
            const unsigned tg = og / nx;
            if (og + 1u == (tg + 1u) * nx) xb_add(&bar[XB_TOPGEN], 1u);
            else XB_SPIN(xb_ld(&bar[XB_TOPGEN]) == tg, bar);
            __builtin_amdgcn_fence(__ATOMIC_ACQUIRE, "agent");
            xb_add(&bar[XB_XGEN(b.x)], 1u);
            asm volatile("s_waitcnt vmcnt(0)" ::: "memory");
        } else {
            XB_SPIN(xb_ld(&bar[XB_XGEN(b.x)]) == gen, bar);
            __builtin_amdgcn_fence(__ATOMIC_ACQUIRE, "agent");
            asm volatile("s_waitcnt vmcnt(0)" ::: "memory");
        }
    }
    __syncthreads();
}

namespace pg8 {
#define PG8_LAS __attribute__((address_space(3)))
typedef unsigned short bf16_t;
typedef short bf16x8 __attribute__((ext_vector_type(8)));
typedef float f32x4 __attribute__((ext_vector_type(4)));
typedef unsigned u32x4 __attribute__((ext_vector_type(4)));
constexpr int BM = 256, BK = 64, HALF = 128, HTB = HALF * BK * 2  , STAGE_BYTES = 8 * HTB, NXCD = 8, WGM = 8;

__host__ __device__ __forceinline__ int lds_byte(int r, int c) { const int st = (r >> 4) * 2 + (c >> 5), rr = r & 15, cc = c & 31, ob = rr * 64 + cc * 2; return st * 1024 + (ob ^ (((ob >> 9) & 1) << 5)); }
__host__ __device__ __forceinline__ void stage_rc(int b, int& R, int& C) { const int st = b / 1024, sb = b % 1024, swz = sb ^ (((sb >> 9) & 1) << 5); R = (st >> 1) * 16 + swz / 64; C = (st & 1) * 32 + (swz % 64) / 2; }
__host__ __device__ __forceinline__ int perm32(int rho) { const int n = rho >> 4, i = rho & 15; return 8 * (i >> 2) + 4 * n + (i & 3); }

struct Unit { int pm, pn; };
struct Gemm { const bf16_t* A; const bf16_t* Bt; int M, N, K; };

struct StaticOrder {
    int nM, nN, nwg, G, c;
    __host__ __device__ void init(int M, int N, int G_, int c_) { nM = M / BM; nN = N / BM; nwg = nM * nN; G = G_; c = c_; }
    __host__ __device__ bool next(int i, Unit& u) const {
        const long L = (long)i * G + c; if (L >= nwg) return false;
        int wgid = (int)L; { const int q = nwg / NXCD, r = nwg % NXCD, xcd = wgid % NXCD, off = wgid / NXCD; wgid = (xcd < r ? xcd * (q + 1) : r * (q + 1) + (xcd - r) * q) + off; }
        const int nig = WGM * nN, gid = wgid / nig, fm = gid * WGM, gsz = (nM - fm) < WGM ? (nM - fm) : WGM;
        u.pm = fm + ((wgid % nig) % gsz); u.pn = (wgid % nig) / gsz; return true;
    }
    __device__ __forceinline__ void a_ready(const Unit&) const {}
    __device__ __forceinline__ void done(const Unit&) const {}
};

template <class Epi, class Sched, bool STAMP = false>
__device__ __forceinline__ void gemm_phase(PG8_LAS unsigned char* lds, const Gemm g, const Sched& S, const Epi& E, unsigned long long* stamps) {
    int tid = threadIdx.x; asm volatile("" : "+v"(tid));
    const int wid = __builtin_amdgcn_readfirstlane(tid >> 6), lane = tid & 63, wr = wid >> 2, wc = wid & 3, fr = lane & 15, fq = lane >> 4;
    const int K = g.K, nt = K / BK;
#define PG8_STAMP() do { } while (0)
    PG8_STAMP();
    unsigned voffA[2], voffB[2];
#pragma unroll
    for (int i = 0; i < 2; ++i) { int R, C; stage_rc(tid * 16 + i * 8192, R, C); const int Rb = Epi::PERM ? ((R & ~31) + perm32(R & 31)) : R;
        voffA[i] = (unsigned)(R * K + C) * 2u; voffB[i] = (unsigned)(Rb * K + C) * 2u; }
    const size_t kstep = (size_t)(BK * 2);
    const size_t hstep = (size_t)HALF * K * 2;
    const size_t tstep = 2 * hstep;
    const unsigned ldsw = (unsigned)wid * 1024u;
    const int aoff = lds_byte(wr * 64 + fr, fq * 8), boff = lds_byte(wc * 32 + fr, fq * 8);
#define PG8_SA(b, h) (((b) * 2 + (h)) * HTB)
#define PG8_SB(b, h) ((4 + (b) * 2 + (h)) * HTB)
#define PG8_STAGE(bufoff, gbase, voff) do { _Pragma("unroll") for (int _i = 0; _i < 2; ++_i) \
        __builtin_amdgcn_global_load_lds((const unsigned*)((const char*)(gbase) + (voff)[_i]), (PG8_LAS unsigned*)(lds + (bufoff) + ldsw + _i * 8192), 16, 0, 0); } while (0)
#define PG8_LDA(dst, b, h) do { _Pragma("unroll") for (int m = 0; m < 4; ++m) _Pragma("unroll") for (int k = 0; k < 2; ++k) dst[m][k] = *(const PG8_LAS bf16x8*)(lds + PG8_SA(b, h) + aoff + m * 2048 + k * 1024); } while (0)
#define PG8_LDB(dst, b, h) do { _Pragma("unroll") for (int n = 0; n < 2; ++n) _Pragma("unroll") for (int k = 0; k < 2; ++k) dst[n][k] = *(const PG8_LAS bf16x8*)(lds + PG8_SB(b, h) + boff + n * 2048 + k * 1024); } while (0)
#define PG8_MMA(ai, bj, At, Bt) do { __builtin_amdgcn_s_setprio(1); _Pragma("unroll") for (int m = 0; m < 4; ++m) _Pragma("unroll") for (int n = 0; n < 2; ++n) _Pragma("unroll") for (int k = 0; k < 2; ++k) \
        acc[ai][bj][m][n] = __builtin_amdgcn_mfma_f32_16x16x32_bf16(Bt[n][k], At[m][k], acc[ai][bj][m][n], 0, 0, 0); __builtin_amdgcn_s_setprio(0); } while (0)
#define PG8_WAIT_V(n) asm volatile("s_waitcnt vmcnt(" #n ")" ::: "memory")
#define PG8_WAIT_L(n) asm volatile("s_waitcnt lgkmcnt(" #n ")" ::: "memory")
#define PG8_BAR __builtin_amdgcn_s_barrier()
#define PG8_SCHED __builtin_amdgcn_sched_barrier(0)
    Unit cur, nxt; int ui = 0;
    if (!S.next(0, cur)) return;
    f32x4 acc[2][2][4][2];
#pragma unroll
    for (int a = 0; a < 2; ++a)
#pragma unroll
        for (int b = 0; b < 2; ++b)
#pragma unroll
            for (int m = 0; m < 4; ++m)
#pragma unroll
                for (int n = 0; n < 2; ++n) acc[a][b][m][n] = (f32x4){0.f, 0.f, 0.f, 0.f};
    bf16x8 At[4][2], B0[2][2], B1[2][2];
    const char* cA = (const char*)g.A + (size_t)cur.pm * tstep; const char* cB = (const char*)g.Bt + (size_t)cur.pn * tstep;
    S.a_ready(cur);
    PG8_STAGE(PG8_SB(0, 0), cB, voffB); PG8_STAGE(PG8_SA(0, 0), cA, voffA); PG8_STAGE(PG8_SB(0, 1), cB + hstep, voffB); PG8_STAGE(PG8_SA(0, 1), cA + hstep, voffA);
    if (wr == 1) PG8_BAR;
    PG8_WAIT_V(4); PG8_BAR;
    PG8_STAGE(PG8_SB(1, 0), cB + kstep, voffB); PG8_STAGE(PG8_SA(1, 0), cA + kstep, voffA); PG8_STAGE(PG8_SB(1, 1), cB + hstep + kstep, voffB);
    PG8_WAIT_V(6); PG8_BAR;
    PG8_STAMP();
    for (;;) {
        const bool has_next = S.next(ui + 1, nxt);
        const char* nA = has_next ? (const char*)g.A + (size_t)nxt.pm * tstep : cA; const char* nB = has_next ? (const char*)g.Bt + (size_t)nxt.pn * tstep : cB;
        for (int t = 0; t < nt; t += 2) {
            const bool last = (t == nt - 2);
            const char* a1 = cA + (size_t)(t + 1) * kstep;
            const char* a2 = last ? nA : cA + (size_t)(t + 2) * kstep; const char* b2 = last ? nB : cB + (size_t)(t + 2) * kstep;
            const char* a3 = a2 + kstep; const char* b3 = b2 + kstep;
            if (last && has_next) S.a_ready(nxt);
            PG8_LDB(B0, 0, 0); PG8_SCHED; PG8_LDA(At, 0, 0); PG8_STAGE(PG8_SA(1, 1), a1 + hstep, voffA);
            PG8_WAIT_L(8); PG8_BAR; PG8_WAIT_L(0); PG8_MMA(0, 0, At, B0); PG8_BAR; PG8_SCHED;
            PG8_LDB(B1, 0, 1); PG8_STAGE(PG8_SB(0, 0), b2, voffB);
            PG8_BAR; PG8_WAIT_L(0); PG8_MMA(0, 1, At, B1); PG8_BAR;
            PG8_LDA(At, 0, 1); PG8_STAGE(PG8_SA(0, 0), a2, voffA);
            PG8_BAR; PG8_WAIT_L(0); PG8_MMA(1, 0, At, B0); PG8_BAR; PG8_SCHED;
            PG8_STAGE(PG8_SB(0, 1), b2 + hstep, voffB);
            PG8_WAIT_V(6); PG8_BAR; PG8_MMA(1, 1, At, B1); PG8_BAR;
            PG8_LDB(B0, 1, 0); PG8_SCHED; PG8_LDA(At, 1, 0); PG8_STAGE(PG8_SA(0, 1), a2 + hstep, voffA);
            PG8_WAIT_L(8); PG8_BAR; PG8_WAIT_L(0); PG8_MMA(0, 0, At, B0); PG8_BAR; PG8_SCHED;
            PG8_LDB(B1, 1, 1); PG8_STAGE(PG8_SB(1, 0), b3, voffB);
            PG8_BAR; PG8_WAIT_L(0); PG8_MMA(0, 1, At, B1); PG8_BAR;
            PG8_LDA(At, 1, 1); PG8_STAGE(PG8_SA(1, 0), a3, voffA);
            PG8_BAR; PG8_WAIT_L(0); PG8_MMA(1, 0, At, B0); PG8_BAR; PG8_SCHED;
            PG8_STAGE(PG8_SB(1, 1), b3 + hstep, voffB);
            PG8_WAIT_V(6); PG8_BAR; PG8_MMA(1, 1, At, B1); PG8_BAR;
        }
        PG8_STAMP();
        if constexpr (!Epi::AFTER_DRAIN) { E(acc, cur, wr, wc, fr, fq); S.done(cur); }
        PG8_STAMP();
        if (!has_next) break;
#pragma unroll
        for (int a = 0; a < 2; ++a)
#pragma unroll
            for (int b = 0; b < 2; ++b)
#pragma unroll
                for (int m = 0; m < 4; ++m)
#pragma unroll
                    for (int n = 0; n < 2; ++n) acc[a][b][m][n] = (f32x4){0.f, 0.f, 0.f, 0.f};
        cur = nxt; cA = nA; cB = nB; ++ui;
    }
    PG8_WAIT_V(0);
    if (wr == 0) PG8_BAR;
    PG8_BAR;
    if constexpr (Epi::AFTER_DRAIN) { E.fused(acc, cur, wr, wc, fr, fq, lds, wid, lane); S.done(cur); }
    PG8_STAMP();
#undef PG8_STAMP
#undef PG8_SA
#undef PG8_SB
#undef PG8_STAGE
#undef PG8_LDA
#undef PG8_LDB
#undef PG8_MMA
#undef PG8_WAIT_V
#undef PG8_WAIT_L
#undef PG8_BAR
#undef PG8_SCHED
}
}

DEV void transpose_convert(const float* __restrict__ W, int K, int N, int Npad, bf16_t* Wt, float* sm) {
    float (*T)[65] = (float (*)[65])sm;
    const int tid = opaque_tid();
    const int kt = K / 64, ntl = Npad / 64;
    for (int tile = blockIdx.x; tile < kt * ntl; tile += gridDim.x) {
        const int k0 = (tile / ntl) * 64, n0 = (tile % ntl) * 64;
        __syncthreads();
#pragma unroll
        for (int i = 0; i < 2; ++i) {
            const int k = (tid >> 4) + 32 * i, n4 = (tid & 15) * 4;
            float4 v = make_float4(0.f, 0.f, 0.f, 0.f);
            if (n0 + n4 < N) v = ld4(W + (size_t)(k0 + k) * N + n0 + n4);
            T[k][n4] = v.x; T[k][n4 + 1] = v.y; T[k][n4 + 2] = v.z; T[k][n4 + 3] = v.w;
        }
        __syncthreads();
        const int n = tid >> 3, kq = (tid & 7) * 8;
        unsigned o[4];
#pragma unroll
        for (int j = 0; j < 4; ++j) o[j] = pack2bf(T[kq + 2 * j][n], T[kq + 2 * j + 1][n]);
        bf16_t* dst = Wt + (size_t)(n0 + n) * K + k0 + kq;
        *(uint4*)dst = make_uint4(o[0], o[1], o[2], o[3]);
    }
}

struct EpBf16 {
    static constexpr bool PERM = true, AFTER_DRAIN = false;
    bf16_t* O; int ldc; int ncols;
    DEV void operator()(const pg8::f32x4 (&acc)[2][2][4][2], const pg8::Unit& u, int wr, int wc, int fr, int fq) const {
        const int row0 = u.pm * 256 + wr * 64 + fr, col0 = u.pn * 256 + wc * 32 + 8 * fq;
#pragma unroll
        for (int ai = 0; ai < 2; ++ai)
#pragma unroll
            for (int m = 0; m < 4; ++m) {
                bf16_t* rowp = O + (size_t)(row0 + ai * 128 + m * 16) * ldc + col0;
#pragma unroll
                for (int bj = 0; bj < 2; ++bj) {
                    if (col0 + bj * 128 < ncols) {
                        const pg8::f32x4 v0 = acc[ai][bj][m][0], v1 = acc[ai][bj][m][1];
                        *(uint4*)(rowp + bj * 128) = make_uint4(pack2bf(v0[0], v0[1]), pack2bf(v0[2], v0[3]), pack2bf(v1[0], v1[1]), pack2bf(v1[2], v1[3]));
                    }
                }
            }
    }
};
struct EpRes0 {
    static constexpr bool PERM = false, AFTER_DRAIN = false;
    float* C; const float* mv; int b;
    DEV void operator()(const pg8::f32x4 (&acc)[2][2][4][2], const pg8::Unit& u, int wr, int wc, int fr, int fq) const {
        const bool isc = (u.pm * 256 < NCX);
        const float* gp = mv + (isc ? 2 : b) * 3072 + 2048;
        const int row0 = u.pm * 256 + wr * 64 + fr, col0 = u.pn * 256 + wc * 32 + 4 * fq;
#pragma unroll
        for (int ai = 0; ai < 2; ++ai)
#pragma unroll
            for (int m = 0; m < 4; ++m) {
                const size_t ro = (size_t)(row0 + ai * 128 + m * 16) * DM + col0;
#pragma unroll
                for (int bj = 0; bj < 2; ++bj)
#pragma unroll
                    for (int n = 0; n < 2; ++n) {
                        const int co = bj * 128 + n * 16;
                        const float4 g = ld4(gp + col0 + co); const pg8::f32x4 v = acc[ai][bj][m][n];
                        st4(C + ro + co, make_float4(g.x * v[0], g.y * v[1], g.z * v[2], g.w * v[3]));
                    }
            }
    }
};
struct EpRes1 {
    static constexpr bool PERM = false, AFTER_DRAIN = false;
    float* C; const float* mv;
    DEV void operator()(const pg8::f32x4 (&acc)[2][2][4][2], const pg8::Unit& u, int wr, int wc, int fr, int fq) const {
        const float* gp = mv + (u.pm * 256 >= NL ? 1 : 0) * 3072 + 2048;
        const int row0 = u.pm * 256 + wr * 64 + fr, col0 = u.pn * 256 + wc * 32 + 4 * fq;
#pragma unroll
        for (int ai = 0; ai < 2; ++ai)
#pragma unroll
            for (int m = 0; m < 4; ++m) {
                const size_t ro = (size_t)(row0 + ai * 128 + m * 16) * DM + col0;
#pragma unroll
                for (int bj = 0; bj < 2; ++bj)
#pragma unroll
                    for (int n = 0; n < 2; ++n) {
                        const int co = bj * 128 + n * 16;
                        const float4 g = ld4(gp + col0 + co); const pg8::f32x4 v = acc[ai][bj][m][n];
                        st4(C + ro + co, make_float4(g.x * v[0], g.y * v[1], g.z * v[2], g.w * v[3]));
                    }
            }
    }
};
template <class EP>
DEV void run_gemm(const bf16_t* A, const bf16_t* Bt, int M, int N, int K, const EP& ep, float* sm) {
    pg8::Gemm g{A, Bt, M, N, K}; pg8::StaticOrder S; S.init(M, N, (int)gridDim.x, (int)blockIdx.x);
    pg8::gemm_phase<EP, pg8::StaticOrder, false>((PG8_LAS unsigned char*)sm, g, S, ep, nullptr);
}

DEV void phase_h0(const Params& p, int b) {
    const float* modv = (const float*)(p.ws + OFF_MODV);
    bf16_t* H0 = (bf16_t*)(p.ws + OFF_YC);
    const int gt = blockIdx.x * NTHR + opaque_tid(), gn = gridDim.x * NTHR;
    for (int i = gt; i < TB * 128; i += gn) {
        const int s = i >> 7, k = (i & 127) * 8;
        const float* src; int j;
        if (s < NCX) { src = p.in[2] + ((size_t)(b * NCX + s)) * DM + k; j = 2; }
        else { src = p.in[0] + ((size_t)(b * NL + s - NCX)) * DM + k; j = b; }
        const float4 x0 = ld4(src), x1 = ld4(src + 4);
        const float* m = modv + j * 3072;
        const float4 s0 = ld4(m + k), s1 = ld4(m + k + 4), c0 = ld4(m + 1024 + k), c1 = ld4(m + 1024 + k + 4);
        *(uint4*)(H0 + (size_t)s * DM + k) = make_uint4(pack2bf(x0.x * (1.f + c0.x) + s0.x, x0.y * (1.f + c0.y) + s0.y), pack2bf(x0.z * (1.f + c0.z) + s0.z, x0.w * (1.f + c0.w) + s0.w),
                                                      pack2bf(x1.x * (1.f + c1.x) + s1.x, x1.y * (1.f + c1.y) + s1.y), pack2bf(x1.z * (1.f + c1.z) + s1.z, x1.w * (1.f + c1.w) + s1.w));
    }
}

DEV void phase_mod(const Params& p, float* sm) {
    const float* c = p.in[1]; const float* cctx = p.in[3];
    const float* mod_w = p.in[4]; const float* mod_b = p.in[5];
    float* modv = (float*)(p.ws + OFF_MODV);
    float* sil = sm; float* red = sm + 3072;
    const int tid = opaque_tid();
    for (int i = tid; i < 3072; i += NTHR) {
        const int j = i >> 10, k = i & 1023;
        const float v = (j < 2) ? c[j * 1024 + k] : cctx[k];
        sil[i] = silu_f(v);
    }
    __syncthreads();
    for (int unit = blockIdx.x; unit < 192; unit += gridDim.x) {
        const int l = unit / 96, cb = unit % 96;
        const int kg = tid >> 5, col = tid & 31, n = cb * 32 + col;
        const float* w = mod_w + (size_t)l * 1024 * 3072 + n;
        float a0 = 0.f, a1 = 0.f, a2 = 0.f;
        for (int k = kg * 64; k < kg * 64 + 64; ++k) {
            const float wv = w[(size_t)k * 3072];
            a0 += sil[k] * wv; a1 += sil[1024 + k] * wv; a2 += sil[2048 + k] * wv;
        }
        red[(kg * 3 + 0) * 32 + col] = a0; red[(kg * 3 + 1) * 32 + col] = a1; red[(kg * 3 + 2) * 32 + col] = a2;
        __syncthreads();
        if (tid < 96) {
            const int j = tid >> 5, cc = tid & 31, nn = cb * 32 + cc;
            float s = mod_b[l * 3072 + nn];
            for (int g = 0; g < 16; ++g) s += red[(g * 3 + j) * 32 + cc];
            modv[(l * 3 + j) * 3072 + nn] = s;
        }
        __syncthreads();
    }
}

DEV void phase_tables(const Params& p) {
    const float* wq = p.in[33]; const float* wk = p.in[34]; const float* wv = p.in[35];
    const float* gw0 = p.in[36]; const float* gw1 = p.in[38]; const float* gw2 = p.in[40]; const float* gw3 = p.in[42];
    float* gtab = (float*)(p.ws + OFF_GTAB); bf16_t* wft = (bf16_t*)(p.ws + OFF_WFT);
    const int gt = blockIdx.x * NTHR + opaque_tid(), gn = gridDim.x * NTHR;
    for (int i = gt; i < 512 * 16; i += gn) {
        const int gb = i >> 4, cp = (i >> 2) & 3, c = i & 3;
        float s = 0.f;
#pragma unroll
        for (int d = 0; d < 4; ++d) s += wq[gb * 16 + cp * 4 + d] * wk[gb * 16 + c * 4 + d];
        gtab[i] = s * KSCALE;
    }
    for (int i = gt; i < 4096 * 16; i += gn) {
        const int g = i >> 12, k = i & 4095, gm = g >> 2, hd = g & 3;
        const float* wg = gm == 0 ? gw0 : (gm == 1 ? gw1 : (gm == 2 ? gw2 : gw3));
        float s = 0.f;
        if (k < 2048) {
            const int blk = k >> 2, cc = k & 3;
#pragma unroll
            for (int d = 0; d < 4; ++d) s += wq[blk * 16 + cc * 4 + d] * wg[(size_t)(4 * blk + d) * 4 + hd] + wk[blk * 16 + cc * 4 + d] * wg[(size_t)(2048 + 4 * blk + d) * 4 + hd];
        } else {
            const int kk = k - 2048, blk = kk >> 2, cc = kk & 3;
#pragma unroll
            for (int d = 0; d < 4; ++d) s += wv[blk * 16 + cc * 4 + d] * wg[(size_t)(4096 + 4 * blk + d) * 4 + hd];
        }
        wft[i] = __builtin_bit_cast(unsigned short, (__bf16)s);
    }
}

DEV float wave_scan_add(float v, int lane, int dir) {
#pragma unroll
    for (int o = 1; o < 64; o <<= 1) {
        const float n = dir ? __shfl_down(v, o, 64) : __shfl_up(v, o, 64);
        const bool ok = dir ? (lane + o < 64) : (lane >= o);
        if (ok) v += n;
    }
    return v;
}
DEV float wave_scan_max(float v, int lane, int dir) {
#pragma unroll
    for (int o = 1; o < 64; o <<= 1) {
        const float n = dir ? __shfl_down(v, o, 64) : __shfl_up(v, o, 64);
        const bool ok = dir ? (lane + o < 64) : (lane >= o);
        if (ok) v = fmaxf(v, n);
    }
    return v;
}

DEV void gla_decay(const bf16_t* P0, int c, int h, int dir, const float* __restrict__ wa2, const float* __restrict__ ba,
                   float* sLR, float* sWA, float* sBC, float* sTot, int tid) {
    for (int i = tid; i < 1024; i += NTHR) { const int t = i >> 4, j = i & 15; sLR[i] = bf2f(P0[(size_t)(c * 64 + t) * EIN + 1536 + dir * 16 + j]); }
    for (int i = tid; i < 1024; i += NTHR) { const int ii = i >> 6, k = i & 63; sWA[i] = wa2[ii * 256 + h * 64 + k]; }
    __syncthreads();
    {
        const int t = tid >> 3, k0 = (tid & 7) * 8;
        float acc[8];
#pragma unroll
        for (int j = 0; j < 8; ++j) acc[j] = ba[h * 64 + k0 + j];
#pragma unroll
        for (int ii = 0; ii < 16; ++ii) {
            const float l = sLR[t * 16 + ii];
#pragma unroll
            for (int j = 0; j < 8; ++j) acc[j] += l * sWA[ii * 64 + k0 + j];
        }
#pragma unroll
        for (int j = 0; j < 8; ++j) sBC[t * 65 + k0 + j] = logsig_f(acc[j]) * 0.0625f;
    }
    __syncthreads();
    {
        const int lane = tid & 63, wv = tid >> 6;
#pragma unroll
        for (int j = 0; j < 8; ++j) {
            const int k = wv * 8 + j;
            const float v = wave_scan_add(sBC[lane * 65 + k], lane, dir);
            sBC[lane * 65 + k] = v;
            if (lane == (dir ? 0 : 63)) sTot[k] = v;
        }
    }
    __syncthreads();
}
DEV bf16x8 tr_frag(const bf16_t* base, int ld, int row0, int col0, int lane) {
    const bf16_t* ptr = base + (row0 + (lane >> 4) * 8 + ((lane & 15) >> 2)) * ld + col0 + (lane & 3) * 4;
    const s16x4 lo = __builtin_amdgcn_ds_read_tr16_b64_v4i16((__attribute__((address_space(3))) s16x4*)ptr);
    const s16x4 hi = __builtin_amdgcn_ds_read_tr16_b64_v4i16((__attribute__((address_space(3))) s16x4*)(ptr + 4 * ld));
    return (bf16x8){lo[0], lo[1], lo[2], lo[3], hi[0], hi[1], hi[2], hi[3]};
}
DEV bf16x8 row_frag(const bf16_t* base, int ld, int idx0, int k0, int lane) {
    return *(const bf16x8*)(base + (idx0 + (lane & 15)) * ld + k0 + (lane >> 4) * 8);
}

DEV void gla1_unit(const Params& p, int h, int dir, int c, float* sm) {
    const int tid = opaque_tid(), lane = tid & 63, wave = tid >> 6;
    const bf16_t* P0 = (const bf16_t*)(p.ws + OFF_P0);
    float* GDS = (float*)(p.ws + OFF_GDS); float* GDEC = (float*)(p.ws + OFF_GDEC);
    const float* wa2 = p.in[dir ? 12 : 10]; const float* ba = p.in[dir ? 13 : 11];
    float* sLR = sm; float* sWA = sm + 1024; float* sBC = sm + 2048; float* sTot = sm + 6208;
    bf16_t* kT = (bf16_t*)(sm + 6272);
    bf16_t* Vs = (bf16_t*)(sm + 8576);
    const int ch = h * 2 + dir;
    __syncthreads();
    gla_decay(P0, c, h, dir, wa2, ba, sLR, sWA, sBC, sTot, tid);
    {
        const int t = tid >> 3, k0 = (tid & 7) * 8;
        float kv[8]; unpack8(*(const uint4*)(P0 + (size_t)(c * 64 + t) * EIN + 256 + h * 64 + k0), kv);
#pragma unroll
        for (int j = 0; j < 8; ++j) kT[(k0 + j) * 72 + t] = __builtin_bit_cast(unsigned short, (__bf16)(kv[j] * fexp(sTot[k0 + j] - sBC[t * 65 + k0 + j])));
#pragma unroll
        for (int u = 0; u < 2; ++u) { const int i = tid + 512 * u, row = i >> 4, c16 = i & 15; *(uint4*)(Vs + row * 136 + c16 * 8) = *(const uint4*)(P0 + (size_t)(c * 64 + row) * EIN + 512 + h * 128 + c16 * 8); }
    }
    __syncthreads();
    {
        f32x4 acc[4];
#pragma unroll
        for (int kt = 0; kt < 4; ++kt) acc[kt] = (f32x4){0.f, 0.f, 0.f, 0.f};
#pragma unroll
        for (int ks = 0; ks < 2; ++ks) {
            const bf16x8 af = tr_frag(Vs, 136, ks * 32, wave * 16, lane);
#pragma unroll
            for (int kt = 0; kt < 4; ++kt) acc[kt] = __builtin_amdgcn_mfma_f32_16x16x32_bf16(af, row_frag(kT, 72, kt * 16, ks * 32, lane), acc[kt], 0, 0, 0);
        }
#pragma unroll
        for (int kt = 0; kt < 4; ++kt) {
            const int k = kt * 16 + (lane & 15), v = wave * 16 + (lane >> 4) * 4;
            st4(GDS + ((size_t)(ch * NCH + c) * 64 + k) * 128 + v, make_float4(acc[kt][0], acc[kt][1], acc[kt][2], acc[kt][3]));
        }
    }
    if (tid < 64) GDEC[(size_t)(ch * NCH + c) * 64 + tid] = fexp(sTot[tid]);
}

DEV void gla2_unit(const Params& p, int unit) {
    const int tid = opaque_tid();
    float* GDS = (float*)(p.ws + OFF_GDS); const float* GDEC = (const float*)(p.ws + OFF_GDEC);
    const int ch = unit >> 4, e = (unit & 15) * 512 + tid, k = e >> 7, dir = ch & 1;
    constexpr int GB = 12;
    float S = 0.f, ninc[GB], nd[GB];
#pragma unroll
    for (int j = 0; j < GB; ++j) { const int c = chunk_at(dir, j); ninc[j] = GDS[(size_t)(ch * NCH + c) * 8192 + e]; nd[j] = GDEC[(size_t)(ch * NCH + c) * 64 + k]; }
#pragma unroll 1
    for (int step0 = 0; step0 < NCH; step0 += GB) {
        float inc[GB], d[GB];
#pragma unroll
        for (int j = 0; j < GB; ++j) { inc[j] = ninc[j]; d[j] = nd[j]; }
#pragma unroll
        for (int j = 0; j < GB; ++j) { const int sn = step0 + GB + j, c = chunk_at(dir, sn < NCH ? sn : NCH - 1); ninc[j] = GDS[(size_t)(ch * NCH + c) * 8192 + e]; nd[j] = GDEC[(size_t)(ch * NCH + c) * 64 + k]; }
        __builtin_amdgcn_sched_barrier(0);
#pragma unroll
        for (int j = 0; j < GB; ++j) { const int c = chunk_at(dir, step0 + j); GDS[(size_t)(ch * NCH + c) * 8192 + e] = S; S = d[j] * S + inc[j]; }
    }
}

DEV void gla3_unit(const Params& p, int h, int c, float* sm) {
    const int tid = opaque_tid(), lane = tid & 63, wave = tid >> 6;
    const bf16_t* P0 = (const bf16_t*)(p.ws + OFF_P0);
    const float* GDS = (const float*)(p.ws + OFF_GDS);
    bf16_t* YC = (bf16_t*)(p.ws + OFF_YC);
    const float* ng = p.in[14];
    float* sLR = sm; float* sWA = sm + 1024; float* sBC = sm + 2048; float* sTot = sm + 6208;
    bf16_t* qt = (bf16_t*)(sm + 6272);
    bf16_t* kt = (bf16_t*)(sm + 8576);
    bf16_t* Sm = (bf16_t*)(sm + 10880);
    bf16_t* S0s = (bf16_t*)(sm + 13184);
    bf16_t* Vs = (bf16_t*)(sm + 17536);
    float* O = sm + 21888;
    const int ti = wave & 3, vt0 = (wave >> 2) * 4;
    f32x4 acc[4];
#pragma unroll
    for (int j = 0; j < 4; ++j) acc[j] = (f32x4){0.f, 0.f, 0.f, 0.f};
    __syncthreads();
#pragma unroll
    for (int u = 0; u < 2; ++u) { const int i = tid + 512 * u, row = i >> 4, c16 = i & 15; *(uint4*)(Vs + row * 136 + c16 * 8) = *(const uint4*)(P0 + (size_t)(c * 64 + row) * EIN + 512 + h * 128 + c16 * 8); }
#pragma unroll 1
    for (int dir = 0; dir < 2; ++dir) {
        const float* wa2 = p.in[dir ? 12 : 10]; const float* ba = p.in[dir ? 13 : 11];
        const int ch = h * 2 + dir;
        __syncthreads();
        gla_decay(P0, c, h, dir, wa2, ba, sLR, sWA, sBC, sTot, tid);
        {
            const int t = tid >> 3, k0 = (tid & 7) * 8;
            float qv[8], kv[8];
            unpack8(*(const uint4*)(P0 + (size_t)(c * 64 + t) * EIN + h * 64 + k0), qv);
            unpack8(*(const uint4*)(P0 + (size_t)(c * 64 + t) * EIN + 256 + h * 64 + k0), kv);
#pragma unroll
            for (int j = 0; j < 8; ++j) { const float bc = sBC[t * 65 + k0 + j]; qv[j] *= 0.125f * fexp(bc); kv[j] *= fexp(-bc); }
            *(uint4*)(qt + t * 72 + k0) = make_uint4(pack2bf(qv[0], qv[1]), pack2bf(qv[2], qv[3]), pack2bf(qv[4], qv[5]), pack2bf(qv[6], qv[7]));
            *(uint4*)(kt + t * 72 + k0) = make_uint4(pack2bf(kv[0], kv[1]), pack2bf(kv[2], kv[3]), pack2bf(kv[4], kv[5]), pack2bf(kv[6], kv[7]));
#pragma unroll
            for (int u = 0; u < 4; ++u) {
                const int i = tid + 512 * u, k = i >> 5, v4 = (i & 31) * 4;
                const float4 s4 = ld4(GDS + (size_t)(ch * NCH + c) * 8192 + k * 128 + v4);
                *(uint2*)(S0s + k * 136 + v4) = make_uint2(pack2bf(s4.x, s4.y), pack2bf(s4.z, s4.w));
            }
        }
        __syncthreads();
        {
            const int si = wave & 3;
#pragma unroll
            for (int jj = 0; jj < 2; ++jj) {
                const int t2 = (wave >> 2) * 2 + jj;
                f32x4 a = (f32x4){0.f, 0.f, 0.f, 0.f};
#pragma unroll
                for (int ks = 0; ks < 2; ++ks) a = __builtin_amdgcn_mfma_f32_16x16x32_bf16(row_frag(kt, 72, si * 16, ks * 32, lane), row_frag(qt, 72, t2 * 16, ks * 32, lane), a, 0, 0, 0);
                const int t = t2 * 16 + (lane & 15), s0 = si * 16 + (lane >> 4) * 4;
                float m[4];
#pragma unroll
                for (int r = 0; r < 4; ++r) { const bool keep = dir ? (s0 + r >= t) : (s0 + r <= t); m[r] = keep ? a[r] : 0.f; }
                *(uint2*)(Sm + t * 72 + s0) = make_uint2(pack2bf(m[0], m[1]), pack2bf(m[2], m[3]));
            }
        }
        __syncthreads();
#pragma unroll
        for (int ks = 0; ks < 2; ++ks) {
            const bf16x8 a1 = row_frag(qt, 72, ti * 16, ks * 32, lane), a2 = row_frag(Sm, 72, ti * 16, ks * 32, lane);
#pragma unroll
            for (int j = 0; j < 4; ++j) {
                acc[j] = __builtin_amdgcn_mfma_f32_16x16x32_bf16(a1, tr_frag(S0s, 136, ks * 32, (vt0 + j) * 16, lane), acc[j], 0, 0, 0);
                acc[j] = __builtin_amdgcn_mfma_f32_16x16x32_bf16(a2, tr_frag(Vs, 136, ks * 32, (vt0 + j) * 16, lane), acc[j], 0, 0, 0);
            }
        }
    }
#pragma unroll
    for (int j = 0; j < 4; ++j)
#pragma unroll
        for (int r = 0; r < 4; ++r) O[(ti * 16 + (lane >> 4) * 4 + r) * 132 + (vt0 + j) * 16 + (lane & 15)] = acc[j][r];
    __syncthreads();
    {
        const int t = tid >> 3, v0 = (tid & 7) * 16;
        float o[16];
        float ss = 0.f;
#pragma unroll
        for (int i = 0; i < 16; ++i) { o[i] = O[t * 132 + v0 + i]; ss += o[i] * o[i]; }
        ss += __shfl_xor(ss, 1, 64); ss += __shfl_xor(ss, 2, 64); ss += __shfl_xor(ss, 4, 64);
        const float rms = rsqrtf(ss * (1.f / 128.f) + 1e-5f);
        float g[16];
        const bf16_t* gp = P0 + (size_t)(c * 64 + t) * EIN + 1024 + h * 128 + v0;
        unpack8(*(const uint4*)gp, g); unpack8(*(const uint4*)(gp + 8), g + 8);
        float y[16];
#pragma unroll
        for (int i = 0; i < 16; ++i) y[i] = o[i] * rms * ng[v0 + i] * silu_f(g[i]);
        bf16_t* yp = YC + (size_t)(c * 64 + t) * 1024 + h * 128 + v0;
        *(uint4*)yp = make_uint4(pack2bf(y[0], y[1]), pack2bf(y[2], y[3]), pack2bf(y[4], y[5]), pack2bf(y[6], y[7]));
        *(uint4*)(yp + 8) = make_uint4(pack2bf(y[8], y[9]), pack2bf(y[10], y[11]), pack2bf(y[12], y[13]), pack2bf(y[14], y[15]));
    }
}

DEV void load8bf(const bf16_t* ptr, float* f) { unpack8(*(const uint4*)ptr, f); }
struct RwNb { int sL, sR, sU, sD; bool vL, vR, vU, vD; };
DEV RwNb rw_nb(int s) {
    RwNb q; q.vU = false; q.vD = false;
    if (s < NCX) { q.vL = s > 0; q.vR = s < NCX - 1; }
    else { const int n = s - NCX, rr = n >> 6, cc = n & 63; q.vL = cc > 0; q.vR = cc < 63; q.vU = rr > 0; q.vD = rr < 127; }
    q.sL = q.vL ? s - 1 : s; q.sR = q.vR ? s + 1 : s; q.sU = q.vU ? s - 64 : s; q.sD = q.vD ? s + 64 : s;
    return q;
}
struct RwRaw { uint4 o, l, r, u, d; };
DEV RwRaw rw_load(const bf16_t* P0, int s, const RwNb& q, int cb) {
    RwRaw w;
    w.o = *(const uint4*)(P0 + (size_t)s * EIN + RW0 + cb); w.l = *(const uint4*)(P0 + (size_t)q.sL * EIN + RW0 + cb); w.r = *(const uint4*)(P0 + (size_t)q.sR * EIN + RW0 + cb);
    w.u = *(const uint4*)(P0 + (size_t)q.sU * EIN + RW0 + cb); w.d = *(const uint4*)(P0 + (size_t)q.sD * EIN + RW0 + cb);
    return w;
}
DEV void rw_comb_l(const RwRaw& w, const RwNb& q, const float* ml, float* out) {
    float own[8]; unpack8(w.o, own);
    const float nb[8] = {q.vL ? bflo(w.l.x) : 0.f, q.vR ? bfhi(w.r.x) : 0.f, q.vU ? bflo(w.u.y) : 0.f, q.vD ? bfhi(w.d.y) : 0.f,
                         q.vL ? bflo(w.l.z) : 0.f, q.vR ? bfhi(w.r.z) : 0.f, q.vU ? bflo(w.u.w) : 0.f, q.vD ? bfhi(w.d.w) : 0.f};
    const float4 m0 = *(const float4*)ml, m1 = *(const float4*)(ml + 4);
    const float m[8] = {m0.x, m0.y, m0.z, m0.w, m1.x, m1.y, m1.z, m1.w};
#pragma unroll
    for (int i = 0; i < 8; ++i) out[i] = own[i] + (nb[i] - own[i]) * m[i];
}
DEV void rw_comb(const RwRaw& w, const RwNb& q, const float* __restrict__ mu, int cb, float* out) {
    float own[8]; unpack8(w.o, own);
    const float nb[8] = {q.vL ? bflo(w.l.x) : 0.f, q.vR ? bfhi(w.r.x) : 0.f, q.vU ? bflo(w.u.y) : 0.f, q.vD ? bfhi(w.d.y) : 0.f,
                         q.vL ? bflo(w.l.z) : 0.f, q.vR ? bfhi(w.r.z) : 0.f, q.vU ? bflo(w.u.w) : 0.f, q.vD ? bfhi(w.d.w) : 0.f};
    const float4 m0 = ld4(mu + cb), m1 = ld4(mu + cb + 4);
    const float m[8] = {m0.x, m0.y, m0.z, m0.w, m1.x, m1.y, m1.z, m1.w};
#pragma unroll
    for (int i = 0; i < 8; ++i) out[i] = own[i] + (nb[i] - own[i]) * m[i];
}
DEV uint4 pack8(const float* f) { return make_uint4(pack2bf(f[0], f[1]), pack2bf(f[2], f[3]), pack2bf(f[4], f[5]), pack2bf(f[6], f[7])); }

template <int XM, int YM, class F>
DEV void mm64(const bf16_t* X, const bf16_t* Y, F f, int lane, int wave) {
#pragma unroll
    for (int q = 0; q < 2; ++q) {
        const int idx = wave * 2 + q, ti = idx >> 2, tj = idx & 3;
        f32x4 acc = (f32x4){0.f, 0.f, 0.f, 0.f};
#pragma unroll
        for (int ks = 0; ks < 2; ++ks) {
            const bf16x8 a = XM == 0 ? row_frag(X, 72, ti * 16, ks * 32, lane) : tr_frag(X, 72, ks * 32, ti * 16, lane);
            const bf16x8 bq = YM == 0 ? row_frag(Y, 72, tj * 16, ks * 32, lane) : tr_frag(Y, 72, ks * 32, tj * 16, lane);
            acc = __builtin_amdgcn_mfma_f32_16x16x32_bf16(a, bq, acc, 0, 0, 0);
        }
        f(ti * 16 + (lane >> 4) * 4, tj * 16 + (lane & 15), acc);
    }
}
template <int XM, int YM, class F>
DEV void mm64x2(const bf16_t* X1, const bf16_t* Y1, const bf16_t* X2, const bf16_t* Y2, F f, int lane, int wave) {
#pragma unroll
    for (int q = 0; q < 2; ++q) {
        const int idx = wave * 2 + q, ti = idx >> 2, tj = idx & 3;
        f32x4 acc = (f32x4){0.f, 0.f, 0.f, 0.f};
#pragma unroll
        for (int ks = 0; ks < 2; ++ks) {
            const bf16x8 a = XM == 0 ? row_frag(X1, 72, ti * 16, ks * 32, lane) : tr_frag(X1, 72, ks * 32, ti * 16, lane);
            const bf16x8 bq = YM == 0 ? row_frag(Y1, 72, tj * 16, ks * 32, lane) : tr_frag(Y1, 72, ks * 32, tj * 16, lane);
            acc = __builtin_amdgcn_mfma_f32_16x16x32_bf16(a, bq, acc, 0, 0, 0);
            const bf16x8 a2 = XM == 0 ? row_frag(X2, 72, ti * 16, ks * 32, lane) : tr_frag(X2, 72, ks * 32, ti * 16, lane);
            const bf16x8 b2 = YM == 0 ? row_frag(Y2, 72, tj * 16, ks * 32, lane) : tr_frag(Y2, 72, ks * 32, tj * 16, lane);
            acc = __builtin_amdgcn_mfma_f32_16x16x32_bf16(a2, b2, acc, 0, 0, 0);
        }
        f(ti * 16 + (lane >> 4) * 4, tj * 16 + (lane & 15), acc);
    }
}
DEV void st_img(bf16_t* P, int i0, int j, float a0, float a1, float a2, float a3) {
    P[(i0 + 0) * 72 + j] = __builtin_bit_cast(unsigned short, (__bf16)a0); P[(i0 + 1) * 72 + j] = __builtin_bit_cast(unsigned short, (__bf16)a1);
    P[(i0 + 2) * 72 + j] = __builtin_bit_cast(unsigned short, (__bf16)a2); P[(i0 + 3) * 72 + j] = __builtin_bit_cast(unsigned short, (__bf16)a3);
}

struct RwRaw3 { uint4 o, u, d; };
DEV RwRaw3 rw_load3(const bf16_t* P0, int s, const RwNb& q, int cb) {
    RwRaw3 w;
    w.o = *(const uint4*)(P0 + (size_t)s * EIN + RW0 + cb); w.u = *(const uint4*)(P0 + (size_t)q.sU * EIN + RW0 + cb); w.d = *(const uint4*)(P0 + (size_t)q.sD * EIN + RW0 + cb);
    return w;
}
DEV void rw_comb3(const RwRaw3& w, const RwNb& q, const bf16_t* tile, const bf16_t* P0, int s, int t, int cb, int j0, const float* ml, float* out) {
    asm volatile("" :: "v"(w.u.x), "v"(w.u.z), "v"(w.d.x), "v"(w.d.z));
    float own[8]; unpack8(w.o, own);
    float l0 = 0.f, l4 = 0.f, r1 = 0.f, r5 = 0.f;
    if (q.vL) { if (t > 0) { l0 = bf2f(tile[(t - 1) * 72 + j0]); l4 = bf2f(tile[(t - 1) * 72 + j0 + 4]); }
                else { const bf16_t* g = P0 + (size_t)(s - 1) * EIN + RW0 + cb; l0 = bf2f(g[0]); l4 = bf2f(g[4]); } }
    if (q.vR) { if (t < 63) { r1 = bf2f(tile[(t + 1) * 72 + j0 + 1]); r5 = bf2f(tile[(t + 1) * 72 + j0 + 5]); }
                else { const bf16_t* g = P0 + (size_t)(s + 1) * EIN + RW0 + cb; r1 = bf2f(g[1]); r5 = bf2f(g[5]); } }
    const float nb[8] = {l0, r1, q.vU ? bflo(w.u.y) : 0.f, q.vD ? bfhi(w.d.y) : 0.f, l4, r5, q.vU ? bflo(w.u.w) : 0.f, q.vD ? bfhi(w.d.w) : 0.f};
    const float4 m0 = *(const float4*)ml, m1 = *(const float4*)(ml + 4);
    const float m[8] = {m0.x, m0.y, m0.z, m0.w, m1.x, m1.y, m1.z, m1.w};
#pragma unroll
    for (int i = 0; i < 8; ++i) out[i] = own[i] + (nb[i] - own[i]) * m[i];
}
struct R1Raw { RwRaw3 r, k, v, w, a; float4 qw0, qw1, qa0, qa1; };
DEV void r1_consts(const Params& p, int h, int dir, float* sm) {
    const int tid = opaque_tid();
    float* sv = (float*)((bf16_t*)sm + 14 * 4608);
    __syncthreads();
    if (tid < 64) { const int hc = h * 64 + tid; sv[64 + tid] = p.in[dir ? 18 : 16][hc]; sv[128 + tid] = p.in[dir ? 22 : 20][hc]; sv[192 + tid] = p.in[24][hc]; sv[256 + tid] = p.in[25][hc]; sv[320 + tid] = p.in[26][hc]; }
    if (tid < 320) { const int tn = tid >> 6, col = tid & 63; const int cb = tn < 3 ? tn * 512 + h * 64 : (tn == 3 ? 2048 + dir * 64 : 2176 + dir * 64); sv[384 + tid] = p.in[15][cb + col]; }
}
DEV void r1_load(const Params& p, int h, int dir, int c, R1Raw& R) {
    const int tid = opaque_tid();
    const bf16_t* P0 = (const bf16_t*)(p.ws + OFF_P0);
    const float* ww2 = p.in[dir ? 19 : 17]; const float* wa2 = p.in[dir ? 23 : 21];
    const int t = tid >> 3, j0 = (tid & 7) * 8, s = c * 64 + t;
    const RwNb nbq = rw_nb(s);
    R.r = rw_load3(P0, s, nbq, h * 64 + j0); R.k = rw_load3(P0, s, nbq, 512 + h * 64 + j0); R.v = rw_load3(P0, s, nbq, 1024 + h * 64 + j0);
    R.w = rw_load3(P0, s, nbq, 2048 + dir * 64 + j0); R.a = rw_load3(P0, s, nbq, 2176 + dir * 64 + j0);
    R.qw0 = ld4(ww2 + (size_t)t * 512 + h * 64 + j0); R.qw1 = ld4(ww2 + (size_t)t * 512 + h * 64 + j0 + 4);
    R.qa0 = ld4(wa2 + (size_t)t * 512 + h * 64 + j0); R.qa1 = ld4(wa2 + (size_t)t * 512 + h * 64 + j0 + 4);
}
DEV void rwkv1_unit(const Params& p, int h, int dir, int c, float* sm, R1Raw& R, int cnext) {
    const int tid = opaque_tid(), lane = tid & 63, wave = tid >> 6;
    bf16_t* RU = (bf16_t*)(p.ws + OFF_RU) + (size_t)((h * 2 + dir) * NCH + c) * 16384;
    float* BONS = (float*)(p.ws + OFF_BONS);
    bf16_t* img = (bf16_t*)sm;
#define SLOT(i_) (img + (i_) * 4608)
    float* fLW = (float*)SLOT(10);
    float* fAS = (float*)SLOT(12);
    float* sv = (float*)SLOT(14);
    const int t = tid >> 3, j0 = (tid & 7) * 8, s = c * 64 + t;
    const bf16_t* P0 = (const bf16_t*)(p.ws + OFF_P0);
    __syncthreads();
    *(uint4*)(SLOT(0) + t * 72 + j0) = R.r.o; *(uint4*)(SLOT(1) + t * 72 + j0) = R.k.o; *(uint4*)(SLOT(2) + t * 72 + j0) = R.v.o;
    *(uint4*)(SLOT(3) + t * 72 + j0) = R.w.o; *(uint4*)(SLOT(4) + t * 72 + j0) = R.a.o;
    __syncthreads();
    float r8[8], k8[8], v8[8];
    {
        float x8[8];
        const RwNb nbq = rw_nb(s);
        rw_comb3(R.r, nbq, SLOT(0), P0, s, t, h * 64 + j0, j0, sv + 384 + j0, r8);
        rw_comb3(R.k, nbq, SLOT(1), P0, s, t, 512 + h * 64 + j0, j0, sv + 448 + j0, k8);
        rw_comb3(R.v, nbq, SLOT(2), P0, s, t, 1024 + h * 64 + j0, j0, sv + 512 + j0, v8);
        rw_comb3(R.w, nbq, SLOT(3), P0, s, t, 2048 + dir * 64 + j0, j0, sv + 576 + j0, x8);
#pragma unroll
        for (int i = 0; i < 8; ++i) x8[i] = tanh_f(x8[i]);
        *(uint4*)(SLOT(6) + t * 72 + j0) = pack8(x8);
        rw_comb3(R.a, nbq, SLOT(4), P0, s, t, 2176 + dir * 64 + j0, j0, sv + 640 + j0, x8);
        *(uint4*)(SLOT(7) + t * 72 + j0) = pack8(x8);
        { const float wq[8] = {R.qw0.x, R.qw0.y, R.qw0.z, R.qw0.w, R.qw1.x, R.qw1.y, R.qw1.z, R.qw1.w}; *(uint4*)(SLOT(8) + t * 72 + j0) = pack8(wq); }
        { const float wq[8] = {R.qa0.x, R.qa0.y, R.qa0.z, R.qa0.w, R.qa1.x, R.qa1.y, R.qa1.z, R.qa1.w}; *(uint4*)(SLOT(9) + t * 72 + j0) = pack8(wq); }
    }
    r1_load(p, h, dir, cnext >= 0 ? cnext : c, R);
    __syncthreads();
    mm64<0, 1>(SLOT(6), SLOT(8), [=](int i0, int j, f32x4 a) {
#pragma unroll
        for (int r = 0; r < 4; ++r) fLW[(i0 + r) * 65 + j] = -0.6065306597f * sigmoid_f(sv[64 + j] + a[r]); }, lane, wave);
    mm64<0, 1>(SLOT(7), SLOT(9), [=](int i0, int j, f32x4 a) {
#pragma unroll
        for (int r = 0; r < 4; ++r) fAS[(i0 + r) * 65 + j] = sigmoid_f(sv[128 + j] + a[r]); }, lane, wave);
    __syncthreads();
#pragma unroll
    for (int j = 0; j < 8; ++j) {
        const int k = wave * 8 + j;
        const float v = wave_scan_add(fLW[lane * 65 + k], lane, dir);
        fLW[lane * 65 + k] = v;
        if (lane == (dir ? 0 : 63)) sv[k] = v;
    }
    __syncthreads();
    {
        float kkv[8], ss = 0.f;
#pragma unroll
        for (int i = 0; i < 8; ++i) { kkv[i] = k8[i] * sv[192 + j0 + i]; ss += kkv[i] * kkv[i]; }
        ss += __shfl_xor(ss, 1, 64); ss += __shfl_xor(ss, 2, 64); ss += __shfl_xor(ss, 4, 64);
        const float rn = rsqrtf(fmaxf(ss, 1e-24f));
        float fa[8], fb[8], fk[8], fr[8], fbp[8], fkp[8], bon = 0.f;
        const int tp = dir ? t + 1 : t - 1;
        const bool hasp = dir ? (t < 63) : (t > 0);
#pragma unroll
        for (int i = 0; i < 8; ++i) {
            const int k = j0 + i;
            const float Bt = fLW[t * 65 + k], Bx = hasp ? fLW[tp * 65 + k] : 0.f, asg = fAS[t * 65 + k];
            const float kk = kkv[i] * rn, kh = k8[i] * (1.f + (asg - 1.f) * sv[256 + k]);
            bon += r8[i] * kh * sv[320 + k];
            const float enB = fexp(-Bt), eLB = fexp(sv[k] - Bt), bv = kk * asg;
            fa[i] = -kk * fexp(Bx); fb[i] = bv * enB; fk[i] = kh * enB; fr[i] = r8[i] * fexp(Bt); fbp[i] = bv * eLB; fkp[i] = kh * eLB;
        }
        bon += __shfl_xor(bon, 1, 64); bon += __shfl_xor(bon, 2, 64); bon += __shfl_xor(bon, 4, 64);
        if ((tid & 7) == 0) BONS[((size_t)dir * TB + s) * 8 + h] = bon;
        *(uint4*)(SLOT(0) + t * 72 + j0) = pack8(fa); *(uint4*)(SLOT(1) + t * 72 + j0) = pack8(fb); *(uint4*)(SLOT(2) + t * 72 + j0) = pack8(fk);
        *(uint4*)(SLOT(3) + t * 72 + j0) = pack8(fr); *(uint4*)(SLOT(4) + t * 72 + j0) = pack8(fbp); *(uint4*)(SLOT(5) + t * 72 + j0) = pack8(fkp);
    }
    __syncthreads();
    *(uint4*)(SLOT(6) + t * 72 + j0) = pack8(v8);
    __syncthreads();
    mm64<0, 0>(SLOT(0), SLOT(1), [=](int i0, int j, f32x4 a) {
        float m[4];
#pragma unroll
        for (int r = 0; r < 4; ++r) { const bool keep = dir ? (j > i0 + r) : (j < i0 + r); m[r] = keep ? a[r] : 0.f; }
        const bool dg = (i0 >> 4) == (j >> 4);
        st_img(SLOT(7), i0, j, dg ? m[0] : 0.f, dg ? m[1] : 0.f, dg ? m[2] : 0.f, dg ? m[3] : 0.f);
        st_img(SLOT(8), i0, j, (dg ? m[0] : 0.f) + (j == i0 ? 1.f : 0.f), (dg ? m[1] : 0.f) + (j == i0 + 1 ? 1.f : 0.f), (dg ? m[2] : 0.f) + (j == i0 + 2 ? 1.f : 0.f), (dg ? m[3] : 0.f) + (j == i0 + 3 ? 1.f : 0.f));
        st_img(SLOT(12), i0, j, dg ? 0.f : m[0], dg ? 0.f : m[1], dg ? 0.f : m[2], dg ? 0.f : m[3]); }, lane, wave);
    mm64<0, 0>(SLOT(0), SLOT(2), [=](int i0, int j, f32x4 a) {
        float m[4];
#pragma unroll
        for (int r = 0; r < 4; ++r) { const bool keep = dir ? (j > i0 + r) : (j < i0 + r); m[r] = keep ? a[r] : 0.f; }
        st_img(SLOT(9), i0, j, m[0], m[1], m[2], m[3]); }, lane, wave);
    mm64<0, 0>(SLOT(3), SLOT(1), [=](int i0, int j, f32x4 a) {
        float m[4];
#pragma unroll
        for (int r = 0; r < 4; ++r) { const bool keep = dir ? (j >= i0 + r) : (j <= i0 + r); m[r] = keep ? a[r] : 0.f; }
        st_img(SLOT(10), i0, j, m[0], m[1], m[2], m[3]); }, lane, wave);
    mm64<0, 0>(SLOT(3), SLOT(2), [=](int i0, int j, f32x4 a) {
        float m[4];
#pragma unroll
        for (int r = 0; r < 4; ++r) { const bool keep = dir ? (j >= i0 + r) : (j <= i0 + r); m[r] = keep ? a[r] : 0.f; }
        st_img(SLOT(11), i0, j, m[0], m[1], m[2], m[3]); }, lane, wave);
    __syncthreads();
    {
        bf16_t* Pc = SLOT(7); bf16_t* Pn = SLOT(1); bf16_t* Tc = SLOT(8); bf16_t* Tn = SLOT(2);
#pragma unroll 1
        for (int it = 0; it < 3; ++it) {
            mm64<0, 1>(Pc, Pc, [=](int i0, int j, f32x4 a) { st_img(Pn, i0, j, a[0], a[1], a[2], a[3]); }, lane, wave);
            __syncthreads();
            mm64<0, 1>(Tc, Pn, [=](int i0, int j, f32x4 a) {
                st_img(Tn, i0, j, a[0] + bf2f(Tc[(i0 + 0) * 72 + j]), a[1] + bf2f(Tc[(i0 + 1) * 72 + j]), a[2] + bf2f(Tc[(i0 + 2) * 72 + j]), a[3] + bf2f(Tc[(i0 + 3) * 72 + j])); }, lane, wave);
            __syncthreads();
            bf16_t* tmp = Pc; Pc = Pn; Pn = tmp; tmp = Tc; Tc = Tn; Tn = tmp;
        }
    }
    mm64<0, 1>(SLOT(2), SLOT(12), [=](int i0, int j, f32x4 a) { st_img(SLOT(7), i0, j, a[0], a[1], a[2], a[3]); }, lane, wave);
    mm64<0, 1>(SLOT(2), SLOT(0), [=](int i0, int j, f32x4 a) { st_img(SLOT(1), i0, j, a[0], a[1], a[2], a[3]); }, lane, wave);
    mm64<0, 1>(SLOT(9), SLOT(6), [=](int i0, int j, f32x4 a) { st_img(SLOT(13), i0, j, a[0], a[1], a[2], a[3]); }, lane, wave);
    __syncthreads();
    mm64<0, 1>(SLOT(2), SLOT(13), [=](int i0, int j, f32x4 a) { st_img(SLOT(8), i0, j, a[0], a[1], a[2], a[3]); }, lane, wave);
    __syncthreads();
    {
        const bf16_t* Zp = (wave < 4) ? SLOT(1) : SLOT(8);
        bf16_t* Xi = (wave < 4) ? SLOT(12) : SLOT(9);
        const int ct = (wave & 3) * 16, g4 = (lane >> 4) * 4, l15 = lane & 15;
#pragma unroll
        for (int bs = 0; bs < 4; ++bs) {
            const int bi = dir ? 3 - bs : bs;
            f32x4 acc;
#pragma unroll
            for (int r = 0; r < 4; ++r) acc[r] = bf2f(Zp[(bi * 16 + g4 + r) * 72 + ct + l15]);
            const bool k0 = dir ? (bi == 0) : (bi >= 1), k1 = dir ? (bi <= 2) : (bi == 3);
            if (k0) acc = __builtin_amdgcn_mfma_f32_16x16x32_bf16(row_frag(SLOT(7), 72, bi * 16, 0, lane), tr_frag(Xi, 72, 0, ct, lane), acc, 0, 0, 0);
            if (k1) acc = __builtin_amdgcn_mfma_f32_16x16x32_bf16(row_frag(SLOT(7), 72, bi * 16, 32, lane), tr_frag(Xi, 72, 32, ct, lane), acc, 0, 0, 0);
            st_img(Xi, bi * 16 + g4, ct + l15, acc[0], acc[1], acc[2], acc[3]);
            __syncthreads();
        }
    }
    mm64<1, 1>(SLOT(12), SLOT(4), [=](int i0, int j, f32x4 a) {
        float m[4];
#pragma unroll
        for (int r = 0; r < 4; ++r) m[r] = a[r] + ((i0 + r) == j ? fexp(sv[j]) : 0.f);
        *(uint2*)(RU + j * 64 + i0) = make_uint2(pack2bf(m[0], m[1]), pack2bf(m[2], m[3])); }, lane, wave);
    mm64x2<1, 1>(SLOT(4), SLOT(9), SLOT(5), SLOT(6), [=](int i0, int j, f32x4 a) {
        *(uint2*)(RU + 4096 + j * 64 + i0) = make_uint2(pack2bf(a[0], a[1]), pack2bf(a[2], a[3])); }, lane, wave);
    mm64<1, 0>(SLOT(12), SLOT(10), [=](int i0, int j, f32x4 a) {
        const uint2 rr = *(const uint2*)(SLOT(3) + j * 72 + i0);
        *(uint2*)(RU + 8192 + j * 64 + i0) = make_uint2(pack2bf(a[0] + bflo(rr.x), a[1] + bfhi(rr.x)), pack2bf(a[2] + bflo(rr.y), a[3] + bfhi(rr.y))); }, lane, wave);
    mm64x2<0, 1>(SLOT(10), SLOT(9), SLOT(11), SLOT(6), [=](int i0, int j, f32x4 a) {
        *(uint2*)(RU + 12288 + j * 64 + i0) = make_uint2(pack2bf(a[0], a[1]), pack2bf(a[2], a[3])); }, lane, wave);
#undef SLOT
}

#define R2_LOAD(M_, C_, rnd_) do { const int r0_ = ((rnd_) < R2_NR ? (rnd_) : R2_NR - 1) * R2_RS; \
    _Pragma("unroll") for (int s_ = 0; s_ < R2_RS; ++s_) M_[s_] = *(const uint4*)(RU + (size_t)(chain * NCH + chunk_at(dir, r0_ + s_)) * 16384 + tid * 8); \
    _Pragma("unroll") for (int j_ = 0; j_ < 3; ++j_) { const int cq_ = tid + 512 * j_; \
        C_[j_] = *(const uint4*)(RU + (size_t)(chain * NCH + chunk_at(dir, r0_ + (cq_ >> 7))) * 16384 + 4096 + (vblk * 16 + ((cq_ >> 3) & 15)) * 64 + (cq_ & 7) * 8); } } while (0)
#define R2_ROUND(M_, C_, rnd_) do { \
    { const int row_ = tid >> 3, c8_ = tid & 7, sw_ = (row_ >> 1) & 7, u0_ = (c8_ >> 2) * 4 + (c8_ & 1) * 2, eh_ = ((c8_ >> 1) & 1) * 8; \
      _Pragma("unroll") for (int s_ = 0; s_ < R2_RS; ++s_) { char* sl_ = ring + s_ * 10240 + row_ * 128 + eh_; \
          *(uint2*)(sl_ + ((u0_ ^ sw_) * 16)) = make_uint2(M_[s_].x, M_[s_].y); *(uint2*)(sl_ + (((u0_ + 1) ^ sw_) * 16)) = make_uint2(M_[s_].z, M_[s_].w); } \
      _Pragma("unroll") for (int j_ = 0; j_ < 3; ++j_) { const int cq_ = tid + 512 * j_, rw_ = (cq_ >> 3) & 15, q8_ = cq_ & 7, i_ = q8_ >> 1, g0_ = (q8_ & 1) * 2, sc_ = (rw_ >> 1) & 7; \
          char* sl_ = ring + (cq_ >> 7) * 10240 + 8192 + rw_ * 128 + (i_ & 1) * 8; \
          *(uint2*)(sl_ + (((g0_ * 2 + (i_ >> 1)) ^ sc_) * 16)) = make_uint2(C_[j_].x, C_[j_].y); *(uint2*)(sl_ + ((((g0_ + 1) * 2 + (i_ >> 1)) ^ sc_) * 16)) = make_uint2(C_[j_].z, C_[j_].w); } } \
    R2_LOAD(M_, C_, (rnd_) + 2); \
    __syncthreads(); \
    if (wave == 0) { \
        _Pragma("unroll 4") for (int s_ = 0; s_ < R2_RS; ++s_) { \
            const int c_ = chunk_at(dir, (rnd_) * R2_RS + s_); const char* sl_ = ring + s_ * 10240; \
            unsigned pk_[4][2]; \
            _Pragma("unroll") for (int i_ = 0; i_ < 4; ++i_) { pk_[i_][0] = pack2bf(st[i_][0], st[i_][1]); pk_[i_][1] = pack2bf(st[i_][2], st[i_][3]); } \
            bf16_t* sp_ = S0G + ((size_t)(chain * NCH + c_) * 64 + vblk * 16 + l15) * 64 + g * 4; \
            _Pragma("unroll") for (int i_ = 0; i_ < 4; ++i_) *(uint2*)(sp_ + i_ * 16) = make_uint2(pk_[i_][0], pk_[i_][1]); \
            bf16x8 bfr_[2]; \
            _Pragma("unroll") for (int ks_ = 0; ks_ < 2; ++ks_) { const uint4 u_ = make_uint4(pk_[2 * ks_][0], pk_[2 * ks_][1], pk_[2 * ks_ + 1][0], pk_[2 * ks_ + 1][1]); bfr_[ks_] = __builtin_bit_cast(bf16x8, u_); } \
            const uint4 c01_ = *(const uint4*)(sl_ + 8192 + l15 * 128 + (((g * 2) ^ ((l15 >> 1) & 7)) * 16)), c23_ = *(const uint4*)(sl_ + 8192 + l15 * 128 + (((g * 2 + 1) ^ ((l15 >> 1) & 7)) * 16)); \
            const unsigned cw_[8] = {c01_.x, c01_.y, c01_.z, c01_.w, c23_.x, c23_.y, c23_.z, c23_.w}; \
            _Pragma("unroll") for (int i_ = 0; i_ < 4; ++i_) { \
                f32x4 acc_ = (f32x4){bflo(cw_[2 * i_]), bfhi(cw_[2 * i_]), bflo(cw_[2 * i_ + 1]), bfhi(cw_[2 * i_ + 1])}; \
                _Pragma("unroll") for (int ks_ = 0; ks_ < 2; ++ks_) { \
                    const int row_ = i_ * 16 + l15; \
                    const bf16x8 af_ = *(const bf16x8*)(sl_ + row_ * 128 + (((ks_ * 4 + g) ^ ((row_ >> 1) & 7)) * 16)); \
                    acc_ = __builtin_amdgcn_mfma_f32_16x16x32_bf16(af_, bfr_[ks_], acc_, 0, 0, 0); } \
                st[i_] = acc_; } } } \
    __syncthreads(); } while (0)
DEV void rwkv2_unit(const Params& p, int chain, int vblk, float* sm) {
    constexpr int R2_RS = 12, R2_NR = NCH / R2_RS;
    static_assert(R2_NR * R2_RS == NCH && R2_RS * 10240 <= LDS_BYTES, "R2 ring");
    const int tid = opaque_tid(), lane = tid & 63, wave = tid >> 6;
    const bf16_t* RU = (const bf16_t*)(p.ws + OFF_RU);
    bf16_t* S0G = (bf16_t*)(p.ws + OFF_RS0);
    char* ring = (char*)sm;
    const int dir = chain & 1, g = lane >> 4, l15 = lane & 15;
    f32x4 st[4];
#pragma unroll
    for (int i = 0; i < 4; ++i) st[i] = (f32x4){0.f, 0.f, 0.f, 0.f};
    uint4 ma[R2_RS], ca[3], mb[R2_RS], cb[3];
    __syncthreads();
    R2_LOAD(ma, ca, 0); R2_LOAD(mb, cb, 1);
#pragma unroll 1
    for (int rnd = 0; rnd < R2_NR; rnd += 2) {
        R2_ROUND(ma, ca, rnd);
        if (rnd + 1 < R2_NR) R2_ROUND(mb, cb, rnd + 1);
    }
}
#undef R2_LOAD
#undef R2_ROUND

DEV void rwkv3_unit(const Params& p, int h, int c, float* sm) {
    const int tid = opaque_tid(), lane = tid & 63, wave = tid >> 6;
    const bf16_t* P0 = (const bf16_t*)(p.ws + OFF_P0);
    const bf16_t* RUb = (const bf16_t*)(p.ws + OFF_RU);
    const bf16_t* S0G = (const bf16_t*)(p.ws + OFF_RS0);
    const float* BONS = (const float*)(p.ws + OFF_BONS);
    bf16_t* YC = (bf16_t*)(p.ws + OFF_YC);
    const float* mu = p.in[15]; const float* gn_g = p.in[27]; const float* gn_b = p.in[28];
    bf16_t* img = (bf16_t*)sm;
    float* O = sm + 4 * 2304;
    const int t = tid >> 3, v0 = (tid & 7) * 8, s = c * 64 + t;
    const size_t u0 = (size_t)((h * 2 + 0) * NCH + c), u1 = (size_t)((h * 2 + 1) * NCH + c);
    const uint4 gr0 = *(const uint4*)(RUb + u0 * 16384 + 8192 + t * 64 + v0), gs0 = *(const uint4*)(S0G + u0 * 4096 + t * 64 + v0);
    const uint4 gr1 = *(const uint4*)(RUb + u1 * 16384 + 8192 + t * 64 + v0), gs1 = *(const uint4*)(S0G + u1 * 4096 + t * 64 + v0);
    uint2 yl[2][2];
#pragma unroll
    for (int q = 0; q < 2; ++q) { const int idx = wave * 2 + q, ti = idx >> 2, tj = idx & 3;
        yl[q][0] = *(const uint2*)(RUb + u0 * 16384 + 12288 + (tj * 16 + (lane & 15)) * 64 + ti * 16 + (lane >> 4) * 4);
        yl[q][1] = *(const uint2*)(RUb + u1 * 16384 + 12288 + (tj * 16 + (lane & 15)) * 64 + ti * 16 + (lane >> 4) * 4); }
    const RwNb nbq = rw_nb(s);
    const RwRaw wv_ = rw_load(P0, s, nbq, 1024 + h * 64 + v0), wg_ = rw_load(P0, s, nbq, 1536 + h * 64 + v0);
    const float bon = BONS[(size_t)s * 8 + h] + BONS[((size_t)TB + s) * 8 + h];
    __syncthreads();
    *(uint4*)(img + 0 * 4608 + t * 72 + v0) = gr0; *(uint4*)(img + 2 * 4608 + t * 72 + v0) = gs0;
    *(uint4*)(img + 1 * 4608 + t * 72 + v0) = gr1; *(uint4*)(img + 3 * 4608 + t * 72 + v0) = gs1;
    __syncthreads();
#pragma unroll
    for (int q = 0; q < 2; ++q) {
        const int idx = wave * 2 + q, ti = idx >> 2, tj = idx & 3;
        f32x4 accd[2];
#pragma unroll
        for (int dir = 0; dir < 2; ++dir) {
            f32x4 acc = (f32x4){bflo(yl[q][dir].x), bfhi(yl[q][dir].x), bflo(yl[q][dir].y), bfhi(yl[q][dir].y)};
#pragma unroll
            for (int ks = 0; ks < 2; ++ks) acc = __builtin_amdgcn_mfma_f32_16x16x32_bf16(row_frag(img + dir * 4608, 72, ti * 16, ks * 32, lane), row_frag(img + (2 + dir) * 4608, 72, tj * 16, ks * 32, lane), acc, 0, 0, 0);
            accd[dir] = acc;
        }
#pragma unroll
        for (int r = 0; r < 4; ++r) {
            const int oi = (ti * 16 + (lane >> 4) * 4 + r) * 68 + tj * 16 + (lane & 15);
            O[oi] = accd[0][r] + accd[1][r];
        }
    }
    __syncthreads();
    {
        float y[8], sum = 0.f;
#pragma unroll
        for (int i = 0; i < 8; ++i) { y[i] = O[t * 68 + v0 + i]; sum += y[i]; }
        sum += __shfl_xor(sum, 1, 64); sum += __shfl_xor(sum, 2, 64); sum += __shfl_xor(sum, 4, 64);
        const float mean = sum * (1.f / 64.f);
        float sq = 0.f;
#pragma unroll
        for (int i = 0; i < 8; ++i) { y[i] -= mean; sq += y[i] * y[i]; }
        sq += __shfl_xor(sq, 1, 64); sq += __shfl_xor(sq, 2, 64); sq += __shfl_xor(sq, 4, 64);
        const float rstd = rsqrtf(sq * (1.f / 64.f) + 64e-5f);
        float vm[8], gm[8];
        rw_comb(wv_, nbq, mu, 1024 + h * 64 + v0, vm);
        rw_comb(wg_, nbq, mu, 1536 + h * 64 + v0, gm);
        float o[8];
#pragma unroll
        for (int i = 0; i < 8; ++i) o[i] = (y[i] * rstd * gn_g[h * 64 + v0 + i] + gn_b[h * 64 + v0 + i] + bon * vm[i]) * silu_f(gm[i]);
        *(uint4*)(YC + (size_t)s * 1024 + 512 + h * 64 + v0) = pack8(o);
    }
}

DEV void ln_rows(const float* src, const float* res_lat, const float* res_cx, int nrows, const float* __restrict__ g, const float* __restrict__ bt, float* dst_lat, float* dst_cx, int ncx,
                 bf16_t* hb = nullptr, const float* mvc = nullptr, const float* mvl = nullptr) {
    const int tid_ = opaque_tid(); const int lane = tid_ & 63, gw = blockIdx.x * NWV + (tid_ >> 6), ngw = gridDim.x * NWV;
    for (int r = gw; r < nrows; r += ngw) {
        const float* x = src + (size_t)r * 1024;
        float4 v[4];
        float sum = 0.f;
        const float* xr = (r < ncx) ? (res_cx + (size_t)r * 1024) : (res_lat + (size_t)(r - ncx) * 1024);
#pragma unroll
        for (int i = 0; i < 4; ++i) { const float4 a = ld4(x + i * 256 + lane * 4), rr = ld4(xr + i * 256 + lane * 4);
            v[i] = make_float4(ALPHA * rr.x + a.x, ALPHA * rr.y + a.y, ALPHA * rr.z + a.z, ALPHA * rr.w + a.w); sum += v[i].x + v[i].y + v[i].z + v[i].w; }
        const float mean = wave_sum(sum) * (1.f / 1024.f);
        float sq = 0.f;
#pragma unroll
        for (int i = 0; i < 4; ++i) {
            v[i].x -= mean; v[i].y -= mean; v[i].z -= mean; v[i].w -= mean;
            sq += v[i].x * v[i].x + v[i].y * v[i].y + v[i].z * v[i].z + v[i].w * v[i].w;
        }
        const float rstd = rsqrtf(wave_sum(sq) * (1.f / 1024.f) + 1e-5f);
        float* d = (r < ncx) ? (dst_cx + (size_t)r * 1024) : (dst_lat + (size_t)(r - ncx) * 1024);
#pragma unroll
        for (int i = 0; i < 4; ++i) {
            const int c = i * 256 + lane * 4;
            const float4 gg = ld4(g + c), bb = ld4(bt + c);
            const float4 y = make_float4(v[i].x * rstd * gg.x + bb.x, v[i].y * rstd * gg.y + bb.y, v[i].z * rstd * gg.z + bb.z, v[i].w * rstd * gg.w + bb.w);
            st4(d + c, y);
            if (hb != nullptr) {
                const float* m = (r < ncx) ? mvc : mvl;
                const float4 sh = ld4(m + c), sc = ld4(m + 1024 + c);
                *(uint2*)(hb + (size_t)r * 1024 + c) = make_uint2(pack2bf(y.x * (1.f + sc.x) + sh.x, y.y * (1.f + sc.y) + sh.y), pack2bf(y.z * (1.f + sc.z) + sh.z, y.w * (1.f + sc.w) + sh.w));
            }
        }
    }
}
DEV void phase_h1l(const Params& p) {
    const float* modv1 = (const float*)(p.ws + OFF_MODV) + 3 * 3072;
    bf16_t* H1 = (bf16_t*)(p.ws + OFF_H1B);
    const size_t gt = (size_t)blockIdx.x * NTHR + opaque_tid(), gn = (size_t)gridDim.x * NTHR;
    for (size_t i = gt; i < (size_t)NB * NL * 128; i += gn) {
        const size_t r = i >> 7; const int k = (int)(i & 127) * 8;
        const float* m = modv1 + (r >= (size_t)NL ? 1 : 0) * 3072;
        const float4 x0 = ld4(p.out + r * DM + k), x1 = ld4(p.out + r * DM + k + 4);
        const float4 s0 = ld4(m + k), s1 = ld4(m + k + 4), c0 = ld4(m + 1024 + k), c1 = ld4(m + 1024 + k + 4);
        *(uint4*)(H1 + r * DM + k) = make_uint4(pack2bf(x0.x * (1.f + c0.x) + s0.x, x0.y * (1.f + c0.y) + s0.y), pack2bf(x0.z * (1.f + c0.z) + s0.z, x0.w * (1.f + c0.w) + s0.w),
                                                pack2bf(x1.x * (1.f + c1.x) + s1.x, x1.y * (1.f + c1.y) + s1.y), pack2bf(x1.z * (1.f + c1.z) + s1.z, x1.w * (1.f + c1.w) + s1.w));
    }
}

DEV void zero_f4(float* ptr, size_t nfloat) {
    const size_t n4 = nfloat / 4;
    for (size_t i = (size_t)blockIdx.x * NTHR + opaque_tid(); i < n4; i += (size_t)gridDim.x * NTHR) ((float4*)ptr)[i] = make_float4(0.f, 0.f, 0.f, 0.f);
}

DEV void chain_ids(int& chain, int& sub) {
    const int bid = blockIdx.x, xcd = bid & 7, idx = bid >> 3;
    chain = xcd * 2 + (idx >> 4); sub = idx & 15;
}

DEV void phase_conv1(const Params& p, float* sm) {
    const bf16_t* XM = (const bf16_t*)(p.ws + OFF_XM);
    bf16_t* XC = (bf16_t*)(p.ws + OFF_XC);
    float* G16P = (float*)(p.ws + OFF_G16P);
    const bf16_t* WFT = (const bf16_t*)(p.ws + OFF_WFT);
    const float* cw = p.in[31]; const float* cbias = p.in[32];
    bf16_t* imgC = (bf16_t*)sm;
    bf16_t* imgM = imgC + 64 * 264;
    float* red = (float*)(imgM + 64 * 264);
    float* cwl = red + 1024;
    const int tid = opaque_tid(), lane = tid & 63, wave = tid >> 6, t = tid >> 3, cg = tid & 7;
    for (int u = blockIdx.x; u < NB * NCH * 4; u += gridDim.x) {
        const int ci = u >> 2, q = u & 3, b = ci / NCH, c = ci % NCH, s = c * 64 + t;
        const size_t rowbase = (size_t)b * TB;
        int nrow[9];
#pragma unroll
        for (int i = 0; i < 3; ++i)
#pragma unroll
            for (int j = 0; j < 3; ++j) {
                int ns = -1;
                if (s < NCX) { const int w2 = s + j - 1; if (i == 1 && w2 >= 0 && w2 < NCX) ns = w2; }
                else { const int n = s - NCX, rr = (n >> 6) + i - 1, w2 = (n & 63) + j - 1; if (rr >= 0 && rr < 128 && w2 >= 0 && w2 < 64) ns = NCX + rr * 64 + w2; }
                nrow[i * 3 + j] = ns;
            }
        const int tt = wave & 3, part = wave >> 2;
        f32x4 acc = (f32x4){0.f, 0.f, 0.f, 0.f};
#pragma unroll 1
        for (int half = 0; half < 2; ++half) {
            __syncthreads();
            for (int i = tid; i < 640; i += NTHR) { const int tp = i >> 6, c4 = (i & 63) * 4; st4(cwl + tp * 256 + c4, ld4((tp < 9 ? cw + tp * 2048 : cbias) + q * 512 + half * 256 + c4)); }
            __syncthreads();
#pragma unroll 2
            for (int it = 0; it < 4; ++it) {
                const int cl = it * 64 + cg * 8, c0 = q * 512 + half * 256 + cl;
                float a8[8];
                { const float4 b0 = ld4(cwl + 9 * 256 + cl), b1 = ld4(cwl + 9 * 256 + cl + 4); a8[0] = b0.x; a8[1] = b0.y; a8[2] = b0.z; a8[3] = b0.w; a8[4] = b1.x; a8[5] = b1.y; a8[6] = b1.z; a8[7] = b1.w; }
                uint4 xmc = make_uint4(0u, 0u, 0u, 0u);
#pragma unroll
                for (int tap = 0; tap < 9; ++tap) {
                    if (nrow[tap] >= 0) {
                        const uint4 xv = *(const uint4*)(XM + (rowbase + nrow[tap]) * 2048 + c0);
                        float x8[8]; unpack8(xv, x8);
                        const float4 w0 = ld4(cwl + tap * 256 + cl), w1 = ld4(cwl + tap * 256 + cl + 4);
                        a8[0] += x8[0] * w0.x; a8[1] += x8[1] * w0.y; a8[2] += x8[2] * w0.z; a8[3] += x8[3] * w0.w;
                        a8[4] += x8[4] * w1.x; a8[5] += x8[5] * w1.y; a8[6] += x8[6] * w1.z; a8[7] += x8[7] * w1.w;
                        if (tap == 4) xmc = xv;
                    }
                }
#pragma unroll
                for (int i = 0; i < 8; ++i) a8[i] = silu_f(a8[i]);
                const uint4 xcv = pack8(a8);
                *(uint4*)(XC + (rowbase + s) * 2048 + c0) = xcv;
                *(uint4*)(imgC + t * 264 + cl) = xcv;
                *(uint4*)(imgM + t * 264 + cl) = xmc;
            }
            __syncthreads();
            {
                const bf16_t* img = part ? imgM : imgC;
                const bf16_t* wrow = WFT + (size_t)(lane & 15) * 4096 + part * 2048 + q * 512 + half * 256 + (lane >> 4) * 8;
#pragma unroll
                for (int ks = 0; ks < 8; ++ks) acc = __builtin_amdgcn_mfma_f32_16x16x32_bf16(row_frag(img, 264, tt * 16, ks * 32, lane), *(const bf16x8*)(wrow + ks * 32), acc, 0, 0, 0);
            }
        }
        if (part == 1) {
#pragma unroll
            for (int r = 0; r < 4; ++r) red[(tt * 16 + (lane >> 4) * 4 + r) * 16 + (lane & 15)] = acc[r];
        }
        __syncthreads();
        if (part == 0) {
#pragma unroll
            for (int r = 0; r < 4; ++r) {
                const int tk = tt * 16 + (lane >> 4) * 4 + r;
                G16P[(((size_t)rowbase + c * 64 + tk) * 16 + (lane & 15)) * 4 + q] = acc[r] + red[tk * 16 + (lane & 15)];
            }
        }
    }
}

struct GateRaw { float4 a, f; };
DEV GateRaw gate_load(const Params& p, size_t row, int dir, int h) {
    const float* G16P = (const float*)(p.ws + OFF_G16P);
    GateRaw g; g.a = ld4(G16P + (row * 16 + dir * 8 + h) * 4); g.f = ld4(G16P + (row * 16 + dir * 8 + 4 + h) * 4);
    return g;
}
DEV void gate_fin(const GateRaw& g, float bi, float bf, float& gi, float& lf) {
    gi = (g.a.x + g.a.y) + (g.a.z + g.a.w) + bi;
    lf = logsig_f((g.f.x + g.f.y) + (g.f.z + g.f.w) + bf);
}
DEV void gate_pair(const Params& p, size_t row, int dir, int h, float& gi, float& lf) {
    const GateRaw g = gate_load(p, row, dir, h);
    gate_fin(g, p.in[dir ? 41 : 37][h], p.in[dir ? 43 : 39][h], gi, lf);
}

DEV void phase_x1(const Params& p, float* sm) {
    int chain, sub; chain_ids(chain, sub);
    const int b = chain >> 3, h = (chain >> 1) & 3, dir = chain & 1;
    const bf16_t* XC = (const bf16_t*)(p.ws + OFF_XC);
    float* GSC = (float*)(p.ws + OFF_GSC); float* CSC = (float*)(p.ws + OFF_CSC); float* NBUF = (float*)(p.ws + OFF_NBUF);
    const float* gtab = (const float*)(p.ws + OFF_GTAB);
    bf16_t* SMAT = (bf16_t*)(p.ws + OFF_SMAT);
    const int tid = opaque_tid(), lane = tid & 63, wave = tid >> 6;
    float* sTot = sm; float* sRef = sm + 132; float* sM0 = sm + 264; float* sBeta = sm + 400;
    const float bias_i = p.in[dir ? 41 : 37][h], bias_f = p.in[dir ? 43 : 39][h];
    {
        GateRaw gn = gate_load(p, (size_t)b * TB + wave * 64 + lane, dir, h);
        for (int c = wave; c < NCH; c += NWV) {
            const GateRaw gc = gn;
            const int cn = (c + NWV < NCH) ? c + NWV : c;
            gn = gate_load(p, (size_t)b * TB + cn * 64 + lane, dir, h);
            float gi, lf; gate_fin(gc, bias_i, bias_f, gi, lf);
            const float bc = wave_scan_add(lf, lane, dir);
            const float ref = wave_max(gi - bc), tot = wave_sum(lf);
            if (lane == 0) { sTot[c] = tot; sRef[c] = ref; }
        }
    }
    __syncthreads();
    if (tid == 0) {
        float m0 = -INFINITY;
        for (int step = 0; step < NCH; ++step) {
            const int c = chunk_at(dir, step);
            sM0[c] = m0;
            const float mx = fmaxf(m0, sRef[c]);
            if (sub == 0) { CSC[(chain * NCH + c) * 2] = fexp(m0 - mx); CSC[(chain * NCH + c) * 2 + 1] = fexp(sRef[c] - mx); }
            m0 = sTot[c] + mx;
        }
    }
    __syncthreads();
    for (int k = wave; sub + 16 * k < NCH; k += NWV) {
        const int c = sub + 16 * k;
        const size_t row = (size_t)b * TB + c * 64 + lane;
        float gi, lf; gate_fin(gate_load(p, row, dir, h), bias_i, bias_f, gi, lf);
        const float bc = wave_scan_add(lf, lane, dir);
        const float a = gi - bc;
        const float amax = wave_scan_max(a, lane, dir);
        const float ref = sRef[c], m0 = sM0[c];
        const float mmax = fmaxf(amax, m0);
        const float mt = bc + mmax;
        const float alpha = fexp(ref - mmax), beta = fexp(a - ref), gg = fexp(m0 - mmax), em = fexp(-mt);
        st4(GSC + ((size_t)chain * TB + c * 64 + lane) * 4, make_float4(alpha, beta, gg, em));
        sBeta[k * 64 + lane] = beta;
    }
    __syncthreads();
    {
        float* part = sm + 1024;
        const int sg = tid >> 6, j8 = (tid & 63) * 8;
        uint4 xn[8];
        { const bf16_t* xp = XC + ((size_t)b * TB + sub * 64 + sg * 8) * 2048 + h * 512 + j8;
#pragma unroll
          for (int s = 0; s < 8; ++s) xn[s] = *(const uint4*)(xp + (size_t)s * 2048); }
        for (int k = 0; sub + 16 * k < NCH; ++k) {
            const int c = sub + 16 * k;
            uint4 xcur[8];
#pragma unroll
            for (int s = 0; s < 8; ++s) xcur[s] = xn[s];
            { const int cn = (c + 16 < NCH) ? c + 16 : c; const bf16_t* xp = XC + ((size_t)b * TB + cn * 64 + sg * 8) * 2048 + h * 512 + j8;
#pragma unroll
              for (int s = 0; s < 8; ++s) xn[s] = *(const uint4*)(xp + (size_t)s * 2048); }
            float acc[8];
#pragma unroll
            for (int i = 0; i < 8; ++i) acc[i] = 0.f;
#pragma unroll
            for (int s = 0; s < 8; ++s) {
                float f[8]; unpack8(xcur[s], f);
                const float be = sBeta[k * 64 + sg * 8 + s];
#pragma unroll
                for (int i = 0; i < 8; ++i) acc[i] += be * f[i];
            }
            __syncthreads();
            st4(part + sg * 512 + j8, make_float4(acc[0], acc[1], acc[2], acc[3])); st4(part + sg * 512 + j8 + 4, make_float4(acc[4], acc[5], acc[6], acc[7]));
            __syncthreads();
            float tot = 0.f;
#pragma unroll
            for (int q = 0; q < 8; ++q) tot += part[q * 512 + tid];
            NBUF[((size_t)chain * NCH + c) * 512 + tid] = tot;
        }
    }
    bf16_t* XCs = (bf16_t*)sm;
    bf16_t* Qs = XCs + 64 * 520;
    for (int u = blockIdx.x; u < NB * 4 * NCH; u += gridDim.x) {
        const int bh = u / NCH, c = u % NCH, ub = bh >> 2, uh = bh & 3;
        __syncthreads();
        float4 gq[2][4];
#pragma unroll
        for (int bb = 0; bb < 2; ++bb) { const float* G = gtab + (size_t)(uh * 128 + (tid & 63) * 2 + bb) * 16; gq[bb][0] = ld4(G); gq[bb][1] = ld4(G + 4); gq[bb][2] = ld4(G + 8); gq[bb][3] = ld4(G + 12); }
        uint4 xr[8];
#pragma unroll
        for (int i = 0; i < 8; ++i) { const int pp = tid + 512 * i, row = pp >> 6, c16 = pp & 63; xr[i] = *(const uint4*)(XC + ((size_t)ub * TB + c * 64 + row) * 2048 + uh * 512 + c16 * 8); }
#pragma unroll
        for (int i = 0; i < 8; ++i) {
            const int pp = tid + 512 * i, row = pp >> 6, c16 = pp & 63;
            const uint4 xv = xr[i];
            float f[8]; unpack8(xv, f);
            float q[8];
#pragma unroll
            for (int bb = 0; bb < 2; ++bb) {
                const float4 g0 = gq[bb][0], g1 = gq[bb][1], g2 = gq[bb][2], g3 = gq[bb][3];
                q[bb * 4 + 0] = f[bb * 4] * g0.x + f[bb * 4 + 1] * g1.x + f[bb * 4 + 2] * g2.x + f[bb * 4 + 3] * g3.x;
                q[bb * 4 + 1] = f[bb * 4] * g0.y + f[bb * 4 + 1] * g1.y + f[bb * 4 + 2] * g2.y + f[bb * 4 + 3] * g3.y;
                q[bb * 4 + 2] = f[bb * 4] * g0.z + f[bb * 4 + 1] * g1.z + f[bb * 4 + 2] * g2.z + f[bb * 4 + 3] * g3.z;
                q[bb * 4 + 3] = f[bb * 4] * g0.w + f[bb * 4 + 1] * g1.w + f[bb * 4 + 2] * g2.w + f[bb * 4 + 3] * g3.w;
            }
            *(uint4*)(XCs + row * 520 + c16 * 8) = xv;
            *(uint4*)(Qs + row * 520 + c16 * 8) = make_uint4(pack2bf(q[0], q[1]), pack2bf(q[2], q[3]), pack2bf(q[4], q[5]), pack2bf(q[6], q[7]));
        }
        __syncthreads();
        const int st = wave & 3, tt0 = (wave >> 2) * 2;
        f32x4 a0 = (f32x4){0.f, 0.f, 0.f, 0.f}, a1 = a0;
        const bf16_t* ap = XCs + (st * 16 + (lane & 15)) * 520 + (lane >> 4) * 8;
        const bf16_t* bp0 = Qs + (tt0 * 16 + (lane & 15)) * 520 + (lane >> 4) * 8;
        const bf16_t* bp1 = bp0 + 16 * 520;
#pragma unroll
        for (int ks = 0; ks < 16; ++ks) {
            const bf16x8 af = *(const bf16x8*)(ap + ks * 32);
            a0 = __builtin_amdgcn_mfma_f32_16x16x32_bf16(af, *(const bf16x8*)(bp0 + ks * 32), a0, 0, 0, 0);
            a1 = __builtin_amdgcn_mfma_f32_16x16x32_bf16(af, *(const bf16x8*)(bp1 + ks * 32), a1, 0, 0, 0);
        }
        bf16_t* sp = SMAT + (size_t)u * 4096 + (size_t)(tt0 * 16 + (lane & 15)) * 64 + st * 16 + (lane >> 4) * 4;
        *(uint2*)sp = make_uint2(pack2bf(a0[0], a0[1]), pack2bf(a0[2], a0[3]));
        *(uint2*)(sp + 16 * 64) = make_uint2(pack2bf(a1[0], a1[1]), pack2bf(a1[2], a1[3]));
    }
}

DEV void phase_x2(const Params& p, float* sm) {
    int chain, sub; chain_ids(chain, sub);
    const int b = chain >> 3, h = (chain >> 1) & 3, dir = chain & 1;
    const bf16_t* XC = (const bf16_t*)(p.ws + OFF_XC);
    float* GSC = (float*)(p.ws + OFF_GSC); const float* CSC = (const float*)(p.ws + OFF_CSC); const float* NBUF = (const float*)(p.ws + OFF_NBUF);
    const float* gtab = (const float*)(p.ws + OFF_GTAB);
    const bf16_t* SMAT = (const bf16_t*)(p.ws + OFF_SMAT);
    const int tid = opaque_tid();
    float* sD0 = sm; float* sCf = sm + 132; float* sN0 = sm + 264; float* sN2 = sN0 + 9 * 512;
    for (int i = tid; i < NCH; i += NTHR) { sD0[i] = CSC[(chain * NCH + i) * 2]; sCf[i] = CSC[(chain * NCH + i) * 2 + 1]; }
    __syncthreads();
    float* sBeta = sN2 + 9 * 512;
    for (int i = tid; i < 9 * 64; i += NTHR) { const int k = i >> 6, c = sub + 16 * k; if (c < NCH) sBeta[i] = GSC[((size_t)chain * TB + c * 64 + (i & 63)) * 4 + 1]; }
    if (tid < 128) {
        constexpr int NBT = 12;
        float4 n = make_float4(0.f, 0.f, 0.f, 0.f), nx[NBT];
        const float* nb = NBUF + (size_t)chain * NCH * 512 + tid * 4;
#pragma unroll
        for (int j = 0; j < NBT; ++j) nx[j] = ld4(nb + (size_t)chunk_at(dir, j) * 512);
#pragma unroll 1
        for (int step0 = 0; step0 < NCH; step0 += NBT) {
            float4 cu[NBT];
#pragma unroll
            for (int j = 0; j < NBT; ++j) cu[j] = nx[j];
#pragma unroll
            for (int j = 0; j < NBT; ++j) { const int sn = step0 + NBT + j; nx[j] = ld4(nb + (size_t)chunk_at(dir, sn < NCH ? sn : NCH - 1) * 512); }
            __builtin_amdgcn_sched_barrier(0);
#pragma unroll
            for (int j = 0; j < NBT; ++j) {
                const int c = chunk_at(dir, step0 + j);
                if ((c & 15) == sub) st4(sN0 + (c >> 4) * 512 + tid * 4, n);
                const float d = sD0[c], cf = sCf[c];
                n = make_float4(d * n.x + cf * cu[j].x, d * n.y + cf * cu[j].y, d * n.z + cf * cu[j].z, d * n.w + cf * cu[j].w);
            }
        }
    }
    __syncthreads();
    {
        const int blk = tid >> 2, cp = tid & 3;
        const float4 g = ld4(gtab + (size_t)(h * 128 + blk) * 16 + cp * 4);
        for (int k = 0; sub + 16 * k < NCH; ++k) {
            const float* n0 = sN0 + k * 512 + blk * 4;
            sN2[k * 512 + tid] = g.x * n0[0] + g.y * n0[1] + g.z * n0[2] + g.w * n0[3];
        }
    }
    __syncthreads();
    const int t = tid >> 3, part = tid & 7;
    for (int k = 0; sub + 16 * k < NCH; ++k) {
        const int c = sub + 16 * k;
        const size_t row = (size_t)b * TB + c * 64 + t;
        float dint = 0.f;
        {
            const bf16_t* xp = XC + row * 2048 + h * 512 + part * 64;
            const float* n2 = sN2 + k * 512 + part * 64;
#pragma unroll
            for (int i = 0; i < 8; ++i) {
                float f[8]; unpack8(*(const uint4*)(xp + i * 8), f);
                const float4 na = ld4(n2 + i * 8), nb2 = ld4(n2 + i * 8 + 4);
                dint += f[0] * na.x + f[1] * na.y + f[2] * na.z + f[3] * na.w + f[4] * nb2.x + f[5] * nb2.y + f[6] * nb2.z + f[7] * nb2.w;
            }
        }
        float di = 0.f;
        {
            float f[8]; unpack8(*(const uint4*)(SMAT + ((size_t)((b * 4 + h) * NCH + c)) * 4096 + t * 64 + part * 8), f);
#pragma unroll
            for (int e = 0; e < 8; ++e) {
                const int s = part * 8 + e;
                const float beta = sBeta[k * 64 + s];
                const bool keep = dir ? (s >= t) : (s <= t);
                di += keep ? f[e] * beta : 0.f;
            }
        }
        dint += __shfl_xor(dint, 1, 64); dint += __shfl_xor(dint, 2, 64); dint += __shfl_xor(dint, 4, 64);
        di += __shfl_xor(di, 1, 64); di += __shfl_xor(di, 2, 64); di += __shfl_xor(di, 4, 64);
        if (part == 0) {
            float* gp = GSC + ((size_t)chain * TB + c * 64 + t) * 4;
            const float4 g4 = ld4(gp);
            const float den = g4.x * di + g4.z * dint;
            gp[3] = 1.f / fmaxf(fabsf(den), g4.w);
        }
    }
}

#define MLSTM_PREFETCH(step_) do { \
    const int c_ = chunk_at(dir, (step_)); const size_t rb_ = (size_t)b * TB + (size_t)c_ * 64; \
    { const bf16_t* xb_ = XC + (rb_ + (tid >> 6)) * 2048 + h * 512 + (tid & 63) * 8; \
      rx0 = *(const uint4*)(xb_); rx1 = *(const uint4*)(xb_ + 8 * 2048); rx2 = *(const uint4*)(xb_ + 16 * 2048); rx3 = *(const uint4*)(xb_ + 24 * 2048); \
      rx4 = *(const uint4*)(xb_ + 32 * 2048); rx5 = *(const uint4*)(xb_ + 40 * 2048); rx6 = *(const uint4*)(xb_ + 48 * 2048); rx7 = *(const uint4*)(xb_ + 56 * 2048); } \
    rxm = *(const uint2*)(XM + (rb_ + ps) * 2048 + ch0 + pvb * 4); \
    rs = *(const uint4*)(SMAT + ((size_t)((b * 4 + h) * NCH + c_)) * 4096 + ps * 64 + pvb * 8); \
    rbeta = GSC[((size_t)chain * TB + c_ * 64 + ps) * 4 + 1]; \
    if (tid < 64) rsc = ld4(GSC + ((size_t)chain * TB + c_ * 64 + tid) * 4); \
    rd0 = CSC[(chain * NCH + c_) * 2]; rcf = CSC[(chain * NCH + c_) * 2 + 1]; } while (0)

DEV void phase_mlstm(const Params& p, float* sm) {
    int chain, sub; chain_ids(chain, sub);
    const int b = chain >> 3, h = (chain >> 1) & 3, dir = chain & 1;
    const bf16_t* XM = (const bf16_t*)(p.ws + OFF_XM);
    const bf16_t* XC = (const bf16_t*)(p.ws + OFF_XC);
    const bf16_t* SMAT = (const bf16_t*)(p.ws + OFF_SMAT);
    const float* GSC = (const float*)(p.ws + OFF_GSC); const float* CSC = (const float*)(p.ws + OFF_CSC);
    const float* gtab = (const float*)(p.ws + OFF_GTAB);
    bf16_t* H = (bf16_t*)(p.ws + OFF_H);
    const float* wv = p.in[35];
    char* smc = (char*)sm;
    bf16_t* XCs = (bf16_t*)smc;
    bf16_t* Cs = (bf16_t*)(smc + 66560);
    bf16_t* Vb = (bf16_t*)(smc + 66560 + 33280);
    bf16_t* Vw = Vb + 32 * 72;
    bf16_t* Sm = Vw + 32 * 72;
    float* Gs = (float*)(smc + 66560 + 33280 + 2 * 4608 + 9216);
    float* sc = Gs + 2048;
    const int tid = opaque_tid(), lane = tid & 63, wave = tid >> 6;
    for (int i = tid; i < 32 * 520 / 2; i += NTHR) ((unsigned*)Cs)[i] = 0u;
    for (int i = tid; i < 2048; i += NTHR) Gs[i] = gtab[h * 2048 + i];
    const int ps = tid >> 3, pvb = tid & 7;
    const int ch0 = h * 512 + sub * 32;
    float wvr[16];
#pragma unroll
    for (int i = 0; i < 16; ++i) wvr[i] = wv[(size_t)((ch0 >> 2) + pvb) * 16 + i];
    f32x4 accS[4][2];
#pragma unroll
    for (int i = 0; i < 4; ++i) { accS[i][0] = (f32x4){0.f, 0.f, 0.f, 0.f}; accS[i][1] = (f32x4){0.f, 0.f, 0.f, 0.f}; }
    uint4 rx0, rx1, rx2, rx3, rx4, rx5, rx6, rx7; uint2 rxm; uint4 rs; float rbeta; float4 rsc = make_float4(0.f, 0.f, 0.f, 0.f); float rd0, rcf;
    MLSTM_PREFETCH(0);
    __syncthreads();
#pragma unroll 1
    for (int step = 0; step < NCH; ++step) {
        const int c = chunk_at(dir, step);
        const float d0 = rd0, cf = rcf;
        {
            bf16_t* xd = XCs + (tid >> 6) * 520 + (tid & 63) * 8;
            *(uint4*)(xd) = rx0; *(uint4*)(xd + 8 * 520) = rx1; *(uint4*)(xd + 16 * 520) = rx2; *(uint4*)(xd + 24 * 520) = rx3;
            *(uint4*)(xd + 32 * 520) = rx4; *(uint4*)(xd + 40 * 520) = rx5; *(uint4*)(xd + 48 * 520) = rx6; *(uint4*)(xd + 56 * 520) = rx7;
        }
        {
            const float x0 = bflo(rxm.x), x1 = bfhi(rxm.x), x2 = bflo(rxm.y), x3 = bfhi(rxm.y);
#pragma unroll
            for (int d = 0; d < 4; ++d) {
                const float v = (x0 * wvr[d] + x1 * wvr[4 + d] + x2 * wvr[8 + d] + x3 * wvr[12 + d]) * rbeta;
                Vb[(pvb * 4 + d) * 72 + ps] = __builtin_bit_cast(unsigned short, (__bf16)v);
                Vw[(pvb * 4 + d) * 72 + ps] = __builtin_bit_cast(unsigned short, (__bf16)(v * cf));
            }
        }
        {
#define SMASK(q_) (((dir ? (pvb * 8 + 2 * (q_) >= ps) : (pvb * 8 + 2 * (q_) <= ps)) ? 0x0000ffffu : 0u) | ((dir ? (pvb * 8 + 2 * (q_) + 1 >= ps) : (pvb * 8 + 2 * (q_) + 1 <= ps)) ? 0xffff0000u : 0u))
            *(uint4*)(Sm + ps * 72 + pvb * 8) = make_uint4(rs.x & SMASK(0), rs.y & SMASK(1), rs.z & SMASK(2), rs.w & SMASK(3));
#undef SMASK
        }
        if (tid < 64) st4(sc + tid * 4, rsc);
        { const int nstep = (step + 1 < NCH) ? step + 1 : step; MLSTM_PREFETCH(nstep); }
        __syncthreads();
        {
            const int vt = wave & 1, tt = wave >> 1;
            f32x4 ao = (f32x4){0.f, 0.f, 0.f, 0.f}, ai = ao, ao1 = ao, ao2 = ao, ao3 = ao;
            const bf16_t* ap = Cs + (vt * 16 + (lane & 15)) * 520 + (lane >> 4) * 8;
            const bf16_t* bp = XCs + (tt * 16 + (lane & 15)) * 520 + (lane >> 4) * 8;
#pragma unroll
            for (int ks = 0; ks < 16; ks += 4) {
                ao = __builtin_amdgcn_mfma_f32_16x16x32_bf16(*(const bf16x8*)(ap + ks * 32), *(const bf16x8*)(bp + ks * 32), ao, 0, 0, 0);
                ao1 = __builtin_amdgcn_mfma_f32_16x16x32_bf16(*(const bf16x8*)(ap + (ks + 1) * 32), *(const bf16x8*)(bp + (ks + 1) * 32), ao1, 0, 0, 0);
                ao2 = __builtin_amdgcn_mfma_f32_16x16x32_bf16(*(const bf16x8*)(ap + (ks + 2) * 32), *(const bf16x8*)(bp + (ks + 2) * 32), ao2, 0, 0, 0);
                ao3 = __builtin_amdgcn_mfma_f32_16x16x32_bf16(*(const bf16x8*)(ap + (ks + 3) * 32), *(const bf16x8*)(bp + (ks + 3) * 32), ao3, 0, 0, 0);
            }
            ao = (ao + ao1) + (ao2 + ao3);
            const bf16_t* ap2 = Vb + (vt * 16 + (lane & 15)) * 72 + (lane >> 4) * 8;
            const bf16_t* bp2 = Sm + (tt * 16 + (lane & 15)) * 72 + (lane >> 4) * 8;
#pragma unroll
            for (int ks = 0; ks < 2; ++ks) ai = __builtin_amdgcn_mfma_f32_16x16x32_bf16(*(const bf16x8*)(ap2 + ks * 32), *(const bf16x8*)(bp2 + ks * 32), ai, 0, 0, 0);
            if (c >= 4) {
                const int t = tt * 16 + (lane & 15);
                const float4 s4 = ld4(sc + t * 4);
                const float h0 = (s4.x * ai[0] + s4.z * ao[0]) * s4.w, h1 = (s4.x * ai[1] + s4.z * ao[1]) * s4.w;
                const float h2 = (s4.x * ai[2] + s4.z * ao[2]) * s4.w, h3 = (s4.x * ai[3] + s4.z * ao[3]) * s4.w;
                bf16_t* hp = H + ((size_t)b * NL + (size_t)c * 64 + t - NCX) * 2048 + ch0 + vt * 16 + (lane >> 4) * 4;
                const unsigned u0 = pack2bf(h0, h1), u1 = pack2bf(h2, h3);
                __builtin_amdgcn_global_atomic_fadd_v2bf16((__attribute__((address_space(1))) s16x2*)hp, __builtin_bit_cast(s16x2, u0));
                __builtin_amdgcn_global_atomic_fadd_v2bf16((__attribute__((address_space(1))) s16x2*)(hp + 2), __builtin_bit_cast(s16x2, u1));
            }
        }
#pragma unroll
        for (int jt = 0; jt < 4; ++jt) { accS[jt][0] *= d0; accS[jt][1] *= d0; }
#pragma unroll
        for (int ks = 0; ks < 2; ++ks) {
            const bf16x8 b0 = *(const bf16x8*)(Vw + (lane & 15) * 72 + ks * 32 + (lane >> 4) * 8);
            const bf16x8 b1 = *(const bf16x8*)(Vw + (16 + (lane & 15)) * 72 + ks * 32 + (lane >> 4) * 8);
            const int row0 = ks * 32 + (lane >> 4) * 8 + ((lane & 15) >> 2);
#pragma unroll
            for (int jt = 0; jt < 4; ++jt) {
                const int col = wave * 64 + jt * 16 + (lane & 3) * 4;
                const s16x4 lo = __builtin_amdgcn_ds_read_tr16_b64_v4i16((__attribute__((address_space(3))) s16x4*)(XCs + row0 * 520 + col));
                const s16x4 hi = __builtin_amdgcn_ds_read_tr16_b64_v4i16((__attribute__((address_space(3))) s16x4*)(XCs + (row0 + 4) * 520 + col));
                const bf16x8 af = (bf16x8){lo[0], lo[1], lo[2], lo[3], hi[0], hi[1], hi[2], hi[3]};
                accS[jt][0] = __builtin_amdgcn_mfma_f32_16x16x32_bf16(af, b0, accS[jt][0], 0, 0, 0);
                accS[jt][1] = __builtin_amdgcn_mfma_f32_16x16x32_bf16(af, b1, accS[jt][1], 0, 0, 0);
            }
        }
        __syncthreads();
#pragma unroll
        for (int jt = 0; jt < 4; ++jt) {
            const int blk = wave * 16 + jt * 4 + (lane >> 4);
            const float4 g0 = ld4(Gs + blk * 16), g1 = ld4(Gs + blk * 16 + 4), g2 = ld4(Gs + blk * 16 + 8), g3 = ld4(Gs + blk * 16 + 12);
#pragma unroll
            for (int v2 = 0; v2 < 2; ++v2) {
                const f32x4 a = accS[jt][v2];
                const float o0 = g0.x * a[0] + g0.y * a[1] + g0.z * a[2] + g0.w * a[3];
                const float o1 = g1.x * a[0] + g1.y * a[1] + g1.z * a[2] + g1.w * a[3];
                const float o2 = g2.x * a[0] + g2.y * a[1] + g2.z * a[2] + g2.w * a[3];
                const float o3 = g3.x * a[0] + g3.y * a[1] + g3.z * a[2] + g3.w * a[3];
                *(uint2*)(Cs + (v2 * 16 + (lane & 15)) * 520 + blk * 4) = make_uint2(pack2bf(o0, o1), pack2bf(o2, o3));
            }
        }
    }
}

DEV void phase_finish1(const Params& p) {
    bf16_t* H = (bf16_t*)(p.ws + OFF_H);
    const bf16_t* XC = (const bf16_t*)(p.ws + OFF_XC);
    const bf16_t* Z = (const bf16_t*)(p.ws + OFF_XM);
    const float* ng = p.in[44]; const float* skip = p.in[45];
    const int tid_ = opaque_tid(); const int lane = tid_ & 63, gw = blockIdx.x * NWV + (tid_ >> 6), ngw = gridDim.x * NWV;
    for (int it = gw; it < NB * NL * 4; it += ngw) {
        const int r = it >> 2, h = it & 3, b = r >= NL ? 1 : 0, nn = r - b * NL;
        const int c0 = h * 512 + lane * 8;
        bf16_t* hp = H + (size_t)r * 2048 + c0;
        float v[8]; unpack8(*(const uint4*)hp, v);
        float sum = 0.f;
#pragma unroll
        for (int j = 0; j < 8; ++j) sum += v[j];
        const float mean = wave_sum(sum) * (1.f / 512.f);
        float sq = 0.f;
#pragma unroll
        for (int j = 0; j < 8; ++j) { v[j] -= mean; sq += v[j] * v[j]; }
        const float rstd = rsqrtf(wave_sum(sq) * (1.f / 512.f) + 1e-5f);
        float xc[8], z[8];
        unpack8(*(const uint4*)(XC + ((size_t)b * TB + NCX + nn) * 2048 + c0), xc);
        unpack8(*(const uint4*)(Z + (size_t)r * 2048 + c0), z);
        float o[8];
#pragma unroll
        for (int j = 0; j < 8; ++j) o[j] = (v[j] * rstd * ng[c0 + j] + skip[c0 + j] * xc[j]) * silu_f(z[j]);
        *(uint4*)hp = make_uint4(pack2bf(o[0], o[1]), pack2bf(o[2], o[3]), pack2bf(o[4], o[5]), pack2bf(o[6], o[7]));
    }
}

__global__ void __launch_bounds__(NTHR) fwd_kernel(Params p) {
    extern __shared__ __attribute__((aligned(16))) float sm[];
    volatile LAS unsigned* xst = (volatile LAS unsigned*)((LAS char*)sm + (LDS_BYTES - 16));
    if (threadIdx.x == 0) { xst[0] = 0u; xst[1] = 0u; }
    __syncthreads();
    const XcdBarrier xbar = xcd_barrier_post((unsigned*)(p.ws + OFF_BAR), xst);
    const int tid = opaque_tid(), lane = tid & 63, wave = tid >> 6;
    float* modv = (float*)(p.ws + OFF_MODV);
    float* X1C = (float*)(p.ws + OFF_X1C);

    phase_mod(p, sm);
    phase_tables(p);
    transpose_convert(p.in[8], 1024, EIN, 4096, (bf16_t*)(p.ws + OFF_WT0), sm);
    transpose_convert(p.in[29], 1024, 4096, 4096, (bf16_t*)(p.ws + OFF_WT1), sm);
    transpose_convert(p.in[9], 1024, 1024, 1024, (bf16_t*)(p.ws + OFF_WT2), sm);
    transpose_convert(p.in[30], 2048, 1024, 1024, (bf16_t*)(p.ws + OFF_WT3), sm);
    xcd_barrier(xbar);

#pragma unroll 1
    for (int b = 0; b < NB; ++b) {
        if (b == 0) { phase_h0(p, 0); xcd_barrier(xbar); }
        run_gemm((const bf16_t*)(p.ws + OFF_YC), (const bf16_t*)(p.ws + OFF_WT0), TB, 4096, DM, EpBf16{(bf16_t*)(p.ws + OFF_P0), EIN, EIN}, sm);
        xcd_barrier(xbar);
        {
            const int x = blockIdx.x & 7, q0 = blockIdx.x >> 3;
            R1Raw R;
            r1_consts(p, x, q0 & 1, sm);
            r1_load(p, x, q0 & 1, q0 >> 1, R);
            for (int q = q0; q < 3 * NCH; q += 32) {
                if (q < 2 * NCH) rwkv1_unit(p, x, q & 1, q >> 1, sm, R, (q + 32 < 2 * NCH) ? ((q + 32) >> 1) : -1);
                else { const int q2 = q - 2 * NCH; gla1_unit(p, x >> 1, q2 & 1, (NCH / 2) * (x & 1) + (q2 >> 1), sm); }
            }
        }
        xcd_barrier(xbar);
        if (blockIdx.x < 128) gla2_unit(p, blockIdx.x);
        else if (blockIdx.x < 192) rwkv2_unit(p, (blockIdx.x - 128) >> 2, (blockIdx.x - 128) & 3, sm);
        xcd_barrier(xbar);
        for (int q = blockIdx.x >> 3; q < NCH + NCH / 2; q += 32) {
            const int x = blockIdx.x & 7;
            if (q < NCH) rwkv3_unit(p, x, q, sm);
            else gla3_unit(p, x >> 1, (NCH / 2) * (x & 1) + (q - NCH), sm);
        }
        xcd_barrier(xbar);
        run_gemm((const bf16_t*)(p.ws + OFF_YC), (const bf16_t*)(p.ws + OFF_WT2), TB, DM, DM, EpRes0{(float*)(p.ws + OFF_P0), modv, b}, sm);
        xcd_barrier(xbar);
        ln_rows((const float*)(p.ws + OFF_P0), p.in[0] + (size_t)b * NL * DM, p.in[2] + (size_t)b * NCX * DM, TB, p.in[6], p.in[7], p.out + (size_t)b * NL * DM, X1C + (size_t)b * NCX * DM, NCX,
                (bf16_t*)(p.ws + OFF_H1B) + (size_t)b * TB * DM, modv + (3 + 2) * 3072, modv + (3 + b) * 3072);
        if (b == 0) phase_h0(p, 1);
        xcd_barrier(xbar);
    }

    run_gemm((const bf16_t*)(p.ws + OFF_H1B), (const bf16_t*)(p.ws + OFF_WT1), RT, 2048, DM, EpBf16{(bf16_t*)(p.ws + OFF_XM), 2048, 2048}, sm);
    zero_f4((float*)(p.ws + OFF_H), (size_t)NB * NL * 1024);
    xcd_barrier(xbar);
    phase_conv1(p, sm);
    xcd_barrier(xbar);
    phase_x1(p, sm);
    xcd_barrier(xbar);
    phase_x2(p, sm);
    xcd_barrier(xbar);
    phase_mlstm(p, sm);
    xcd_barrier(xbar);
    phase_h1l(p);
    xcd_barrier(xbar);
    run_gemm((const bf16_t*)(p.ws + OFF_H1B), (const bf16_t*)(p.ws + OFF_WT1) + (size_t)2048 * 1024, NB * NL, 2048, DM, EpBf16{(bf16_t*)(p.ws + OFF_XM), 2048, 2048}, sm);
    xcd_barrier(xbar);
    phase_finish1(p);
    xcd_barrier(xbar);
    run_gemm((const bf16_t*)(p.ws + OFF_H), (const bf16_t*)(p.ws + OFF_WT3), NB * NL, DM, 2048, EpRes1{(float*)(p.ws + OFF_XC), modv + 3 * 3072}, sm);
    xcd_barrier(xbar);
    ln_rows((const float*)(p.ws + OFF_XC), p.out, p.out, NB * NL, p.in[6] + 1024, p.in[7] + 1024, p.out, p.out, 0);
}

extern "C" void kernel_launch(void* const* d_in, const int* in_sizes, int n_in, void* d_out, int out_size, void* d_ws, size_t ws_size, hipStream_t stream) {
    static int grid_blocks = 0;
    if (grid_blocks == 0) {
        if (ws_size < WS_NEED || n_in != 46) { fprintf(stderr, "kernel_launch: bad ws_size %zu (need %zu) or n_in %d\n", ws_size, (size_t)WS_NEED, n_in); grid_blocks = -1; return; }
        int dev = 0, cus = 0, per_cu = 0;
        (void)hipGetDevice(&dev);
        (void)hipDeviceGetAttribute(&cus, hipDeviceAttributeMultiprocessorCount, dev);
        (void)hipFuncSetAttribute((const void*)fwd_kernel, hipFuncAttributeMaxDynamicSharedMemorySize, LDS_BYTES);
        (void)hipOccupancyMaxActiveBlocksPerMultiprocessor(&per_cu, (const void*)fwd_kernel, NTHR, LDS_BYTES);
        if (per_cu < 1 || cus < 256) { fprintf(stderr, "kernel_launch: occupancy query says %d blocks/CU on %d CUs; this kernel needs 256 resident workgroups\n", per_cu, cus); grid_blocks = -1; return; }
        grid_blocks = 256;
    }
    if (grid_blocks < 0) return;
    (void)hipMemsetAsync((char*)d_ws + OFF_BAR, 0, XCD_BAR_WORDS * 4, stream);
    Params p{};
    for (int i = 0; i < 46; ++i) p.in[i] = (const float*)d_in[i];
    p.out = (float*)d_out; p.ws = (char*)d_ws;
    void* args[] = {&p};
    hipError_t e = hipLaunchCooperativeKernel((const void*)fwd_kernel, dim3(grid_blocks), dim3(NTHR), args, LDS_BYTES, stream);
    if (e != hipSuccess) fprintf(stderr, "cooperative launch failed: %s (grid %d)\n", hipGetErrorString(e), grid_blocks);
}
```

```cpp
#include <hip/hip_runtime.h>
#include <cstdio>
#include <cmath>

#define DEV __device__ __forceinline__

constexpr int NB = 2, NL = 8192, DM = 1024, NCX = 256, TB = NCX + NL;
constexpr int RT = NB * TB;
constexpr int NCH = TB / 64;
constexpr int EIN = 3872, RW0 = 1568;
constexpr int NTHR = 512, NWV = 8;
constexpr float ALPHA = 1.41421356237f;
constexpr float KSCALE = 0.04419417382f;

constexpr size_t OFF_MODV = 0;
constexpr size_t OFF_X1C  = 131072;
constexpr size_t OFF_BAR  = 3145728;
constexpr size_t OFF_BIG  = 4194304;
constexpr size_t OFF_P0   = OFF_BIG;
constexpr size_t OFF_YC   = OFF_BIG + (size_t)TB * EIN * 2;
constexpr size_t OFF_GDS  = OFF_YC + (size_t)TB * 1024 * 2;
constexpr size_t OFF_GDEC = OFF_GDS + (size_t)8 * NCH * 8192 * 4;
constexpr size_t OFF_RU   = OFF_GDEC + (size_t)8 * NCH * 64 * 4;
constexpr size_t OFF_RS0  = OFF_RU + (size_t)16 * NCH * 16384 * 2;
constexpr size_t OFF_BONS = OFF_RS0 + (size_t)16 * NCH * 4096 * 2;
constexpr size_t L0_END   = OFF_BONS + (size_t)2 * TB * 8 * 4;
constexpr size_t OFF_XM   = OFF_BIG;
constexpr size_t OFF_XC   = OFF_XM + (size_t)RT * 2048 * 2;
constexpr size_t OFF_H    = OFF_XC + (size_t)RT * 2048 * 2;
constexpr size_t OFF_WT0  = OFF_H + (size_t)NB * NL * 2048 * 2;
constexpr size_t OFF_WT1  = OFF_WT0 + (size_t)4096 * 1024 * 2;
constexpr size_t OFF_WT2  = OFF_WT1 + (size_t)4096 * 1024 * 2;
constexpr size_t OFF_WT3  = OFF_WT2 + (size_t)1024 * 1024 * 2;
constexpr size_t OFF_G16  = OFF_WT3 + (size_t)1024 * 2048 * 2;
constexpr size_t OFF_SMAT = OFF_G16 + (size_t)RT * 16 * 4;
constexpr size_t OFF_GSC  = OFF_SMAT + (size_t)NB * 4 * NCH * 4096 * 2;
constexpr size_t OFF_CSC  = OFF_GSC + (size_t)16 * TB * 4 * 4;
constexpr size_t OFF_NBUF = OFF_CSC + (size_t)16 * NCH * 2 * 4;
constexpr size_t OFF_GTAB = 3407872;
constexpr size_t OFF_WFT  = OFF_GTAB + (size_t)4 * 128 * 16 * 4;
static_assert(OFF_WFT + (size_t)16 * 4096 * 2 <= OFF_BIG, "low-region tables overflow");
constexpr size_t OFF_G16P = OFF_NBUF + (size_t)16 * NCH * 512 * 4;
constexpr size_t OFF_H1B  = OFF_G16;
constexpr size_t WS_NEED  = (OFF_G16P + (size_t)4 * RT * 16 * 4 > OFF_H1B + (size_t)RT * 1024 * 2) ? OFF_G16P + (size_t)4 * RT * 16 * 4 : OFF_H1B + (size_t)RT * 1024 * 2;
static_assert(WS_NEED <= (size_t)256 * 1024 * 1024, "workspace exceeds the guaranteed 256 MiB");

static_assert(L0_END <= OFF_WT0, "layer-0 buffers overlap the weight copies");
constexpr int LDS_BYTES = 139264;

struct Params { const float* in[46]; float* out; char* ws; };
typedef unsigned short bf16_t;
typedef __attribute__((ext_vector_type(8))) short bf16x8;
typedef __attribute__((ext_vector_type(4))) short s16x4;
typedef __attribute__((ext_vector_type(2))) short s16x2;
typedef __attribute__((ext_vector_type(4))) float f32x4;
typedef __attribute__((ext_vector_type(2))) __bf16 bf2_t;
DEV unsigned pack2bf(float lo, float hi) { bf2_t v; v[0] = (__bf16)lo; v[1] = (__bf16)hi; return __builtin_bit_cast(unsigned, v); }
DEV float bflo(unsigned u) { return __uint_as_float(u << 16); }
DEV float bfhi(unsigned u) { return __uint_as_float(u & 0xffff0000u); }
DEV float bf2f(bf16_t v) { return __uint_as_float(((unsigned)v) << 16); }
DEV void unpack8(uint4 u, float* f) { f[0] = bflo(u.x); f[1] = bfhi(u.x); f[2] = bflo(u.y); f[3] = bfhi(u.y); f[4] = bflo(u.z); f[5] = bfhi(u.z); f[6] = bflo(u.w); f[7] = bfhi(u.w); }

DEV float wave_sum(float v) {
#pragma unroll
    for (int o = 32; o > 0; o >>= 1) v += __shfl_xor(v, o, 64);
    return v;
}
DEV float wave_max(float v) {
#pragma unroll
    for (int o = 32; o > 0; o >>= 1) v = fmaxf(v, __shfl_xor(v, o, 64));
    return v;
}
DEV float fexp(float x) { return __expf(x); }
DEV float frcp(float x) { return __builtin_amdgcn_rcpf(x); }
DEV float sigmoid_f(float x) { return frcp(1.f + fexp(-x)); }
DEV float silu_f(float x) { return x * frcp(1.f + fexp(-x)); }
DEV float logsig_f(float x) { return fminf(x, 0.f) - __logf(1.f + fexp(-fabsf(x))); }
DEV float tanh_f(float x) { const float e = fexp(2.f * x); return 1.f - 2.f * frcp(e + 1.f); }
DEV void lds_fence() { asm volatile("" ::: "memory"); }
DEV int opaque_tid() { int t = threadIdx.x; asm volatile("" : "+v"(t)); return t; }
DEV int scan_s(int dir, int u) { return dir == 0 ? u : (u < NCX ? (NCX - 1 - u) : (TB - 1 + NCX - u)); }
DEV int chunk_at(int dir, int step) { return dir == 0 ? step : (step < 4 ? 3 - step : (NCH + 3 - step)); }
DEV float4 ld4(const float* p) { return *(const float4*)p; }
DEV void st4(float* p, float4 v) { *(float4*)p = v; }


#define XB_TMO      128
#define XB_XCNT(j)  (256  + 64 * (j))
#define XB_XSUB(j)  (1280 + 64 * (j))
#define XB_XGEN(j)  (2304 + 64 * (j))
#define XB_TOP      3328
#define XB_TOPGEN   3392
#define XCD_BAR_WORDS 3456
#define XB_SPIN_CAP (1u << 22)
#define LAS __attribute__((address_space(3)))
DEV unsigned xb_ld(unsigned* p) { return __hip_atomic_load(p, __ATOMIC_RELAXED, __HIP_MEMORY_SCOPE_AGENT); }
DEV unsigned xb_add(unsigned* p, unsigned v) { return __hip_atomic_fetch_add(p, v, __ATOMIC_RELAXED, __HIP_MEMORY_SCOPE_AGENT); }
DEV unsigned xb_xcc_id() { return (unsigned)__builtin_amdgcn_s_getreg((3 << 11) | 20) & 0xFu; }
#define XB_SPIN(cond, bar) do { unsigned _sp = 0; while (cond) { __builtin_amdgcn_s_sleep(1); \
    if ((++_sp & 255u) == 0u) { if (xb_ld(&(bar)[XB_TMO])) break; if (_sp > XB_SPIN_CAP) { atomicAdd(&(bar)[XB_TMO], 1u); break; } } } } while (0)
struct XcdBarrier { unsigned* bar; unsigned x; volatile LAS unsigned* st; };
DEV XcdBarrier xcd_barrier_post(unsigned* bar, volatile LAS unsigned* st) {
    XcdBarrier b; b.bar = bar; b.x = xb_xcc_id(); b.st = st;
    if (threadIdx.x == 0) (void)xb_add(&bar[XB_XCNT(b.x)], 1u);
    return b;
}
DEV void xcd_barrier_complete(unsigned* bar, unsigned x, unsigned& nloc, unsigned& nx) {
    const unsigned G = gridDim.x * gridDim.y * gridDim.z;
    unsigned sum, cnt, mine, sp = 0u;
    for (;;) {
        sum = 0u; cnt = 0u; mine = 0u;
#pragma unroll
        for (unsigned j = 0; j < 16; ++j) { const unsigned c = xb_ld(&bar[XB_XCNT(j)]); sum += c; cnt += (c > 0u) ? 1u : 0u; mine = (j == x) ? c : mine; }
        if (sum == G) break;
        __builtin_amdgcn_s_sleep(1);
        if ((++sp & 255u) == 0u) { if (xb_ld(&bar[XB_TMO])) break; if (sp > XB_SPIN_CAP) { atomicAdd(&bar[XB_TMO], 1u); break; } }
    }
    nloc = mine > 0u ? mine : 1u; nx = cnt > 0u ? cnt : 1u;
}
DEV void xcd_barrier(const XcdBarrier& b) {
    asm volatile("s_waitcnt vmcnt(0)" ::: "memory");
    __syncthreads();
    if (threadIdx.x == 0) {
        unsigned* bar = b.bar;
        __builtin_amdgcn_s_waitcnt(0);
        unsigned nloc = b.st[0], nx = b.st[1];
        if (nloc == 0u) { xcd_barrier_complete(bar, b.x, nloc, nx); b.st[0] = nloc; b.st[1] = nx; }
        const unsigned old = xb_add(&bar[XB_XSUB(b.x)], 1u);
        const unsigned gen = old / nloc;
        if (old + 1u == (gen + 1u) * nloc) {
            __builtin_amdgcn_fence(__ATOMIC_RELEASE, "agent");
            asm volatile("s_waitcnt vmcnt(0)" ::: "memory");
            const unsigned og = xb_add(&bar[XB_TOP], 1u);
            const unsigned tg = og / nx;
            if (og + 1u == (tg + 1u) * nx) xb_add(&bar[XB_TOPGEN], 1u);
            else XB_SPIN(xb_ld(&bar[XB_TOPGEN]) == tg, bar);
            __builtin_amdgcn_fence(__ATOMIC_ACQUIRE, "agent");
            xb_add(&bar[XB_XGEN(b.x)], 1u);
            asm volatile("s_waitcnt vmcnt(0)" ::: "memory");
        } else {
            XB_SPIN(xb_ld(&bar[XB_XGEN(b.x)]) == gen, bar);
            __builtin_amdgcn_fence(__ATOMIC_ACQUIRE, "agent");
            asm volatile("s_waitcnt vmcnt(0)" ::: "memory");
        }
    }
    __syncthreads();
}

namespace pg8 {
#define PG8_LAS __attribute__((address_space(3)))
typedef unsigned short bf16_t;
typedef short bf16x8 __attribute__((ext_vector_type(8)));
typedef float f32x4 __attribute__((ext_vector_type(4)));
typedef unsigned u32x4 __attribute__((ext_vector_type(4)));
constexpr int BM = 256, BK = 64, HALF = 128, HTB = HALF * BK * 2  , STAGE_BYTES = 8 * HTB, NXCD = 8, WGM = 8;

__host__ __device__ __forceinline__ int lds_byte(int r, int c) { const int st = (r >> 4) * 2 + (c >> 5), rr = r & 15, cc = c & 31, ob = rr * 64 + cc * 2; return st * 1024 + (ob ^ (((ob >> 9) & 1) << 5)); }
__host__ __device__ __forceinline__ void stage_rc(int b, int& R, int& C) { const int st = b / 1024, sb = b % 1024, swz = sb ^ (((sb >> 9) & 1) << 5); R = (st >> 1) * 16 + swz / 64; C = (st & 1) * 32 + (swz % 64) / 2; }
__host__ __device__ __forceinline__ int perm32(int rho) { const int n = rho >> 4, i = rho & 15; return 8 * (i >> 2) + 4 * n + (i & 3); }

struct Unit { int pm, pn; };
struct Gemm { const bf16_t* A; const bf16_t* Bt; int M, N, K; };

struct StaticOrder {
    int nM, nN, nwg, G, c;
    __host__ __device__ void init(int M, int N, int G_, int c_) { nM = M / BM; nN = N / BM; nwg = nM * nN; G = G_; c = c_; }
    __host__ __device__ bool next(int i, Unit& u) const {
        const long L = (long)i * G + c; if (L >= nwg) return false;
        int wgid = (int)L; { const int q = nwg / NXCD, r = nwg % NXCD, xcd = wgid % NXCD, off = wgid / NXCD; wgid = (xcd < r ? xcd * (q + 1) : r * (q + 1) + (xcd - r) * q) + off; }
        const int nig = WGM * nN, gid = wgid / nig, fm = gid * WGM, gsz = (nM - fm) < WGM ? (nM - fm) : WGM;
        u.pm = fm + ((wgid % nig) % gsz); u.pn = (wgid % nig) / gsz; return true;
    }
    __device__ __forceinline__ void a_ready(const Unit&) const {}
    __device__ __forceinline__ void done(const Unit&) const {}
};

template <class Epi, class Sched, bool STAMP = false>
__device__ __forceinline__ void gemm_phase(PG8_LAS unsigned char* lds, const Gemm g, const Sched& S, const Epi& E, unsigned long long* stamps) {
    int tid = threadIdx.x; asm volatile("" : "+v"(tid));
    const int wid = __builtin_amdgcn_readfirstlane(tid >> 6), lane = tid & 63, wr = wid >> 2, wc = wid & 3, fr = lane & 15, fq = lane >> 4;
    const int K = g.K, nt = K / BK;
#define PG8_STAMP() do { } while (0)
    PG8_STAMP();
    unsigned voffA[2], voffB[2];
#pragma unroll
    for (int i = 0; i < 2; ++i) { int R, C; stage_rc(tid * 16 + i * 8192, R, C); const int Rb = Epi::PERM ? ((R & ~31) + perm32(R & 31)) : R;
        voffA[i] = (unsigned)(R * K + C) * 2u; voffB[i] = (unsigned)(Rb * K + C) * 2u; }
    const size_t kstep = (size_t)(BK * 2);
    const size_t hstep = (size_t)HALF * K * 2;
    const size_t tstep = 2 * hstep;
    const unsigned ldsw = (unsigned)wid * 1024u;
    const int aoff = lds_byte(wr * 64 + fr, fq * 8), boff = lds_byte(wc * 32 + fr, fq * 8);
#define PG8_SA(b, h) (((b) * 2 + (h)) * HTB)
#define PG8_SB(b, h) ((4 + (b) * 2 + (h)) * HTB)
#define PG8_STAGE(bufoff, gbase, voff) do { _Pragma("unroll") for (int _i = 0; _i < 2; ++_i) \
        __builtin_amdgcn_global_load_lds((const unsigned*)((const char*)(gbase) + (voff)[_i]), (PG8_LAS unsigned*)(lds + (bufoff) + ldsw + _i * 8192), 16, 0, 0); } while (0)
#define PG8_LDA(dst, b, h) do { _Pragma("unroll") for (int m = 0; m < 4; ++m) _Pragma("unroll") for (int k = 0; k < 2; ++k) dst[m][k] = *(const PG8_LAS bf16x8*)(lds + PG8_SA(b, h) + aoff + m * 2048 + k * 1024); } while (0)
#define PG8_LDB(dst, b, h) do { _Pragma("unroll") for (int n = 0; n < 2; ++n) _Pragma("unroll") for (int k = 0; k < 2; ++k) dst[n][k] = *(const PG8_LAS bf16x8*)(lds + PG8_SB(b, h) + boff + n * 2048 + k * 1024); } while (0)
#define PG8_MMA(ai, bj, At, Bt) do { __builtin_amdgcn_s_setprio(1); _Pragma("unroll") for (int m = 0; m < 4; ++m) _Pragma("unroll") for (int n = 0; n < 2; ++n) _Pragma("unroll") for (int k = 0; k < 2; ++k) \
        acc[ai][bj][m][n] = __builtin_amdgcn_mfma_f32_16x16x32_bf16(Bt[n][k], At[m][k], acc[ai][bj][m][n], 0, 0, 0); __builtin_amdgcn_s_setprio(0); } while (0)
#define PG8_WAIT_V(n) asm volatile("s_waitcnt vmcnt(" #n ")" ::: "memory")
#define PG8_WAIT_L(n) asm volatile("s_waitcnt lgkmcnt(" #n ")" ::: "memory")
#define PG8_BAR __builtin_amdgcn_s_barrier()
#define PG8_SCHED __builtin_amdgcn_sched_barrier(0)
    Unit cur, nxt; int ui = 0;
    if (!S.next(0, cur)) return;
    f32x4 acc[2][2][4][2];
#pragma unroll
    for (int a = 0; a < 2; ++a)
#pragma unroll
        for (int b = 0; b < 2; ++b)
#pragma unroll
            for (int m = 0; m < 4; ++m)
#pragma unroll
                for (int n = 0; n < 2; ++n) acc[a][b][m][n] = (f32x4){0.f, 0.f, 0.f, 0.f};
    bf16x8 At[4][2], B0[2][2], B1[2][2];
    const char* cA = (const char*)g.A + (size_t)cur.pm * tstep; const char* cB = (const char*)g.Bt + (size_t)cur.pn * tstep;
    S.a_ready(cur);
    PG8_STAGE(PG8_SB(0, 0), cB, voffB); PG8_STAGE(PG8_SA(0, 0), cA, voffA); PG8_STAGE(PG8_SB(0, 1), cB + hstep, voffB); PG8_STAGE(PG8_SA(0, 1), cA + hstep, voffA);
    if (wr == 1) PG8_BAR;
    PG8_WAIT_V(4); PG8_BAR;
    PG8_STAGE(PG8_SB(1, 0), cB + kstep, voffB); PG8_STAGE(PG8_SA(1, 0), cA + kstep, voffA); PG8_STAGE(PG8_SB(1, 1), cB + hstep + kstep, voffB);
    PG8_WAIT_V(6); PG8_BAR;
    PG8_STAMP();
    for (;;) {
        const bool has_next = S.next(ui + 1, nxt);
        const char* nA = has_next ? (const char*)g.A + (size_t)nxt.pm * tstep : cA; const char* nB = has_next ? (const char*)g.Bt + (size_t)nxt.pn * tstep : cB;
        for (int t = 0; t < nt; t += 2) {
            const bool last = (t == nt - 2);
            const char* a1 = cA + (size_t)(t + 1) * kstep;
            const char* a2 = last ? nA : cA + (size_t)(t + 2) * kstep; const char* b2 = last ? nB : cB + (size_t)(t + 2) * kstep;
            const char* a3 = a2 + kstep; const char* b3 = b2 + kstep;
            if (last && has_next) S.a_ready(nxt);
            PG8_LDB(B0, 0, 0); PG8_SCHED; PG8_LDA(At, 0, 0); PG8_STAGE(PG8_SA(1, 1), a1 + hstep, voffA);
            PG8_WAIT_L(8); PG8_BAR; PG8_WAIT_L(0); PG8_MMA(0, 0, At, B0); PG8_BAR; PG8_SCHED;
            PG8_LDB(B1, 0, 1); PG8_STAGE(PG8_SB(0, 0), b2, voffB);
            PG8_BAR; PG8_WAIT_L(0); PG8_MMA(0, 1, At, B1); PG8_BAR;
            PG8_LDA(At, 0, 1); PG8_STAGE(PG8_SA(0, 0), a2, voffA);
            PG8_BAR; PG8_WAIT_L(0); PG8_MMA(1, 0, At, B0); PG8_BAR; PG8_SCHED;
            PG8_STAGE(PG8_SB(0, 1), b2 + hstep, voffB);
            PG8_WAIT_V(6); PG8_BAR; PG8_MMA(1, 1, At, B1); PG8_BAR;
            PG8_LDB(B0, 1, 0); PG8_SCHED; PG8_LDA(At, 1, 0); PG8_STAGE(PG8_SA(0, 1), a2 + hstep, voffA);
            PG8_WAIT_L(8); PG8_BAR; PG8_WAIT_L(0); PG8_MMA(0, 0, At, B0); PG8_BAR; PG8_SCHED;
            PG8_LDB(B1, 1, 1); PG8_STAGE(PG8_SB(1, 0), b3, voffB);
            PG8_BAR; PG8_WAIT_L(0); PG8_MMA(0, 1, At, B1); PG8_BAR;
            PG8_LDA(At, 1, 1); PG8_STAGE(PG8_SA(1, 0), a3, voffA);
            PG8_BAR; PG8_WAIT_L(0); PG8_MMA(1, 0, At, B0); PG8_BAR; PG8_SCHED;
            PG8_STAGE(PG8_SB(1, 1), b3 + hstep, voffB);
            PG8_WAIT_V(6); PG8_BAR; PG8_MMA(1, 1, At, B1); PG8_BAR;
        }
        PG8_STAMP();
        if constexpr (!Epi::AFTER_DRAIN) { E(acc, cur, wr, wc, fr, fq); S.done(cur); }
        PG8_STAMP();
        if (!has_next) break;
#pragma unroll
        for (int a = 0; a < 2; ++a)
#pragma unroll
            for (int b = 0; b < 2; ++b)
#pragma unroll
                for (int m = 0; m < 4; ++m)
#pragma unroll
                    for (int n = 0; n < 2; ++n) acc[a][b][m][n] = (f32x4){0.f, 0.f, 0.f, 0.f};
        cur = nxt; cA = nA; cB = nB; ++ui;
    }
    PG8_WAIT_V(0);
    if (wr == 0) PG8_BAR;
    PG8_BAR;
    if constexpr (Epi::AFTER_DRAIN) { E.fused(acc, cur, wr, wc, fr, fq, lds, wid, lane); S.done(cur); }
    PG8_STAMP();
#undef PG8_STAMP
#undef PG8_SA
#undef PG8_SB
#undef PG8_STAGE
#undef PG8_LDA
#undef PG8_LDB
#undef PG8_MMA
#undef PG8_WAIT_V
#undef PG8_WAIT_L
#undef PG8_BAR
#undef PG8_SCHED
}
}

DEV void transpose_convert(const float* __restrict__ W, int K, int N, int Npad, bf16_t* Wt, float* sm) {
    float (*T)[65] = (float (*)[65])sm;
    const int tid = opaque_tid();
    const int kt = K / 64, ntl = Npad / 64;
    for (int tile = blockIdx.x; tile < kt * ntl; tile += gridDim.x) {
        const int k0 = (tile / ntl) * 64, n0 = (tile % ntl) * 64;
        __syncthreads();
#pragma unroll
        for (int i = 0; i < 2; ++i) {
            const int k = (tid >> 4) + 32 * i, n4 = (tid & 15) * 4;
            float4 v = make_float4(0.f, 0.f, 0.f, 0.f);
            if (n0 + n4 < N) v = ld4(W + (size_t)(k0 + k) * N + n0 + n4);
            T[k][n4] = v.x; T[k][n4 + 1] = v.y; T[k][n4 + 2] = v.z; T[k][n4 + 3] = v.w;
        }
        __syncthreads();
        const int n = tid >> 3, kq = (tid & 7) * 8;
        unsigned o[4];
#pragma unroll
        for (int j = 0; j < 4; ++j) o[j] = pack2bf(T[kq + 2 * j][n], T[kq + 2 * j + 1][n]);
        bf16_t* dst = Wt + (size_t)(n0 + n) * K + k0 + kq;
        *(uint4*)dst = make_uint4(o[0], o[1], o[2], o[3]);
    }
}

struct EpBf16 {
    static constexpr bool PERM = true, AFTER_DRAIN = false;
    bf16_t* O; int ldc; int ncols;
    DEV void operator()(const pg8::f32x4 (&acc)[2][2][4][2], const pg8::Unit& u, int wr, int wc, int fr, int fq) const {
        const int row0 = u.pm * 256 + wr * 64 + fr, col0 = u.pn * 256 + wc * 32 + 8 * fq;
#pragma unroll
        for (int ai = 0; ai < 2; ++ai)
#pragma unroll
            for (int m = 0; m < 4; ++m) {
                bf16_t* rowp = O + (size_t)(row0 + ai * 128 + m * 16) * ldc + col0;
#pragma unroll
                for (int bj = 0; bj < 2; ++bj) {
                    if (col0 + bj * 128 < ncols) {
                        const pg8::f32x4 v0 = acc[ai][bj][m][0], v1 = acc[ai][bj][m][1];
                        *(uint4*)(rowp + bj * 128) = make_uint4(pack2bf(v0[0], v0[1]), pack2bf(v0[2], v0[3]), pack2bf(v1[0], v1[1]), pack2bf(v1[2], v1[3]));
                    }
                }
            }
    }
};
struct EpRes0 {
    static constexpr bool PERM = false, AFTER_DRAIN = false;
    float* C; const float* mv; int b;
    DEV void operator()(const pg8::f32x4 (&acc)[2][2][4][2], const pg8::Unit& u, int wr, int wc, int fr, int fq) const {
        const bool isc = (u.pm * 256 < NCX);
        const float* gp = mv + (isc ? 2 : b) * 3072 + 2048;
        const int row0 = u.pm * 256 + wr * 64 + fr, col0 = u.pn * 256 + wc * 32 + 4 * fq;
#pragma unroll
        for (int ai = 0; ai < 2; ++ai)
#pragma unroll
            for (int m = 0; m < 4; ++m) {
                const size_t ro = (size_t)(row0 + ai * 128 + m * 16) * DM + col0;
#pragma unroll
                for (int bj = 0; bj < 2; ++bj)
#pragma unroll
                    for (int n = 0; n < 2; ++n) {
                        const int co = bj * 128 + n * 16;
                        const float4 g = ld4(gp + col0 + co); const pg8::f32x4 v = acc[ai][bj][m][n];
                        st4(C + ro + co, make_float4(g.x * v[0], g.y * v[1], g.z * v[2], g.w * v[3]));
                    }
            }
    }
};
struct EpRes1 {
    static constexpr bool PERM = false, AFTER_DRAIN = false;
    float* C; const float* mv;
    DEV void operator()(const pg8::f32x4 (&acc)[2][2][4][2], const pg8::Unit& u, int wr, int wc, int fr, int fq) const {
        const float* gp = mv + (u.pm * 256 >= NL ? 1 : 0) * 3072 + 2048;
        const int row0 = u.pm * 256 + wr * 64 + fr, col0 = u.pn * 256 + wc * 32 + 4 * fq;
#pragma unroll
        for (int ai = 0; ai < 2; ++ai)
#pragma unroll
            for (int m = 0; m < 4; ++m) {
                const size_t ro = (size_t)(row0 + ai * 128 + m * 16) * DM + col0;
#pragma unroll
                for (int bj = 0; bj < 2; ++bj)
#pragma unroll
                    for (int n = 0; n < 2; ++n) {
                        const int co = bj * 128 + n * 16;
                        const float4 g = ld4(gp + col0 + co); const pg8::f32x4 v = acc[ai][bj][m][n];
                        st4(C + ro + co, make_float4(g.x * v[0], g.y * v[1], g.z * v[2], g.w * v[3]));
                    }
            }
    }
};
template <class EP>
DEV void run_gemm(const bf16_t* A, const bf16_t* Bt, int M, int N, int K, const EP& ep, float* sm) {
    pg8::Gemm g{A, Bt, M, N, K}; pg8::StaticOrder S; S.init(M, N, (int)gridDim.x, (int)blockIdx.x);
    pg8::gemm_phase<EP, pg8::StaticOrder, false>((PG8_LAS unsigned char*)sm, g, S, ep, nullptr);
}

DEV void phase_h0(const Params& p, int b) {
    const float* modv = (const float*)(p.ws + OFF_MODV);
    bf16_t* H0 = (bf16_t*)(p.ws + OFF_YC);
    const int gt = blockIdx.x * NTHR + opaque_tid(), gn = gridDim.x * NTHR;
    for (int i = gt; i < TB * 128; i += gn) {
        const int s = i >> 7, k = (i & 127) * 8;
        const float* src; int j;
        if (s < NCX) { src = p.in[2] + ((size_t)(b * NCX + s)) * DM + k; j = 2; }
        else { src = p.in[0] + ((size_t)(b * NL + s - NCX)) * DM + k; j = b; }
        const float4 x0 = ld4(src), x1 = ld4(src + 4);
        const float* m = modv + j * 3072;
        const float4 s0 = ld4(m + k), s1 = ld4(m + k + 4), c0 = ld4(m + 1024 + k), c1 = ld4(m + 1024 + k + 4);
        *(uint4*)(H0 + (size_t)s * DM + k) = make_uint4(pack2bf(x0.x * (1.f + c0.x) + s0.x, x0.y * (1.f + c0.y) + s0.y), pack2bf(x0.z * (1.f + c0.z) + s0.z, x0.w * (1.f + c0.w) + s0.w),
                                                      pack2bf(x1.x * (1.f + c1.x) + s1.x, x1.y * (1.f + c1.y) + s1.y), pack2bf(x1.z * (1.f + c1.z) + s1.z, x1.w * (1.f + c1.w) + s1.w));
    }
}

DEV void phase_mod(const Params& p, float* sm) {
    const float* c = p.in[1]; const float* cctx = p.in[3];
    const float* mod_w = p.in[4]; const float* mod_b = p.in[5];
    float* modv = (float*)(p.ws + OFF_MODV);
    float* sil = sm; float* red = sm + 3072;
    const int tid = opaque_tid();
    for (int i = tid; i < 3072; i += NTHR) {
        const int j = i >> 10, k = i & 1023;
        const float v = (j < 2) ? c[j * 1024 + k] : cctx[k];
        sil[i] = silu_f(v);
    }
    __syncthreads();
    for (int unit = blockIdx.x; unit < 192; unit += gridDim.x) {
        const int l = unit / 96, cb = unit % 96;
        const int kg = tid >> 5, col = tid & 31, n = cb * 32 + col;
        const float* w = mod_w + (size_t)l * 1024 * 3072 + n;
        float a0 = 0.f, a1 = 0.f, a2 = 0.f;
        for (int k = kg * 64; k < kg * 64 + 64; ++k) {
            const float wv = w[(size_t)k * 3072];
            a0 += sil[k] * wv; a1 += sil[1024 + k] * wv; a2 += sil[2048 + k] * wv;
        }
        red[(kg * 3 + 0) * 32 + col] = a0; red[(kg * 3 + 1) * 32 + col] = a1; red[(kg * 3 + 2) * 32 + col] = a2;
        __syncthreads();
        if (tid < 96) {
            const int j = tid >> 5, cc = tid & 31, nn = cb * 32 + cc;
            float s = mod_b[l * 3072 + nn];
            for (int g = 0; g < 16; ++g) s += red[(g * 3 + j) * 32 + cc];
            modv[(l * 3 + j) * 3072 + nn] = s;
        }
        __syncthreads();
    }
}

DEV void phase_tables(const Params& p) {
    const float* wq = p.in[33]; const float* wk = p.in[34]; const float* wv = p.in[35];
    const float* gw0 = p.in[36]; const float* gw1 = p.in[38]; const float* gw2 = p.in[40]; const float* gw3 = p.in[42];
    float* gtab = (float*)(p.ws + OFF_GTAB); bf16_t* wft = (bf16_t*)(p.ws + OFF_WFT);
    const int gt = blockIdx.x * NTHR + opaque_tid(), gn = gridDim.x * NTHR;
    for (int i = gt; i < 512 * 16; i += gn) {
        const int gb = i >> 4, cp = (i >> 2) & 3, c = i & 3;
        float s = 0.f;
#pragma unroll
        for (int d = 0; d < 4; ++d) s += wq[gb * 16 + cp * 4 + d] * wk[gb * 16 + c * 4 + d];
        gtab[i] = s * KSCALE;
    }
    for (int i = gt; i < 4096 * 16; i += gn) {
        const int g = i >> 12, k = i & 4095, gm = g >> 2, hd = g & 3;
        const float* wg = gm == 0 ? gw0 : (gm == 1 ? gw1 : (gm == 2 ? gw2 : gw3));
        float s = 0.f;
        if (k < 2048) {
            const int blk = k >> 2, cc = k & 3;
#pragma unroll
            for (int d = 0; d < 4; ++d) s += wq[blk * 16 + cc * 4 + d] * wg[(size_t)(4 * blk + d) * 4 + hd] + wk[blk * 16 + cc * 4 + d] * wg[(size_t)(2048 + 4 * blk + d) * 4 + hd];
        } else {
            const int kk = k - 2048, blk = kk >> 2, cc = kk & 3;
#pragma unroll
            for (int d = 0; d < 4; ++d) s += wv[blk * 16 + cc * 4 + d] * wg[(size_t)(4096 + 4 * blk + d) * 4 + hd];
        }
        wft[i] = __builtin_bit_cast(unsigned short, (__bf16)s);
    }
}

DEV float wave_scan_add(float v, int lane, int dir) {
#pragma unroll
    for (int o = 1; o < 64; o <<= 1) {
        const float n = dir ? __shfl_down(v, o, 64) : __shfl_up(v, o, 64);
        const bool ok = dir ? (lane + o < 64) : (lane >= o);
        if (ok) v += n;
    }
    return v;
}
DEV float wave_scan_max(float v, int lane, int dir) {
#pragma unroll
    for (int o = 1; o < 64; o <<= 1) {
        const float n = dir ? __shfl_down(v, o, 64) : __shfl_up(v, o, 64);
        const bool ok = dir ? (lane + o < 64) : (lane >= o);
        if (ok) v = fmaxf(v, n);
    }
    return v;
}

DEV void gla_decay(const bf16_t* P0, int c, int h, int dir, const float* __restrict__ wa2, const float* __restrict__ ba,
                   float* sLR, float* sWA, float* sBC, float* sTot, int tid) {
    for (int i = tid; i < 1024; i += NTHR) { const int t = i >> 4, j = i & 15; sLR[i] = bf2f(P0[(size_t)(c * 64 + t) * EIN + 1536 + dir * 16 + j]); }
    for (int i = tid; i < 1024; i += NTHR) { const int ii = i >> 6, k = i & 63; sWA[i] = wa2[ii * 256 + h * 64 + k]; }
    __syncthreads();
    {
        const int t = tid >> 3, k0 = (tid & 7) * 8;
        float acc[8];
#pragma unroll
        for (int j = 0; j < 8; ++j) acc[j] = ba[h * 64 + k0 + j];
#pragma unroll
        for (int ii = 0; ii < 16; ++ii) {
            const float l = sLR[t * 16 + ii];
#pragma unroll
            for (int j = 0; j < 8; ++j) acc[j] += l * sWA[ii * 64 + k0 + j];
        }
#pragma unroll
        for (int j = 0; j < 8; ++j) sBC[t * 65 + k0 + j] = logsig_f(acc[j]) * 0.0625f;
    }
    __syncthreads();
    {
        const int lane = tid & 63, wv = tid >> 6;
#pragma unroll
        for (int j = 0; j < 8; ++j) {
            const int k = wv * 8 + j;
            const float v = wave_scan_add(sBC[lane * 65 + k], lane, dir);
            sBC[lane * 65 + k] = v;
            if (lane == (dir ? 0 : 63)) sTot[k] = v;
        }
    }
    __syncthreads();
}
DEV bf16x8 tr_frag(const bf16_t* base, int ld, int row0, int col0, int lane) {
    const bf16_t* ptr = base + (row0 + (lane >> 4) * 8 + ((lane & 15) >> 2)) * ld + col0 + (lane & 3) * 4;
    const s16x4 lo = __builtin_amdgcn_ds_read_tr16_b64_v4i16((__attribute__((address_space(3))) s16x4*)ptr);
    const s16x4 hi = __builtin_amdgcn_ds_read_tr16_b64_v4i16((__attribute__((address_space(3))) s16x4*)(ptr + 4 * ld));
    return (bf16x8){lo[0], lo[1], lo[2], lo[3], hi[0], hi[1], hi[2], hi[3]};
}
DEV bf16x8 row_frag(const bf16_t* base, int ld, int idx0, int k0, int lane) {
    return *(const bf16x8*)(base + (idx0 + (lane & 15)) * ld + k0 + (lane >> 4) * 8);
}

DEV void gla1_unit(const Params& p, int h, int dir, int c, float* sm) {
    const int tid = opaque_tid(), lane = tid & 63, wave = tid >> 6;
    const bf16_t* P0 = (const bf16_t*)(p.ws + OFF_P0);
    float* GDS = (float*)(p.ws + OFF_GDS); float* GDEC = (float*)(p.ws + OFF_GDEC);
    const float* wa2 = p.in[dir ? 12 : 10]; const float* ba = p.in[dir ? 13 : 11];
    float* sLR = sm; float* sWA = sm + 1024; float* sBC = sm + 2048; float* sTot = sm + 6208;
    bf16_t* kT = (bf16_t*)(sm + 6272);
    bf16_t* Vs = (bf16_t*)(sm + 8576);
    const int ch = h * 2 + dir;
    __syncthreads();
    gla_decay(P0, c, h, dir, wa2, ba, sLR, sWA, sBC, sTot, tid);
    {
        const int t = tid >> 3, k0 = (tid & 7) * 8;
        float kv[8]; unpack8(*(const uint4*)(P0 + (size_t)(c * 64 + t) * EIN + 256 + h * 64 + k0), kv);
#pragma unroll
        for (int j = 0; j < 8; ++j) kT[(k0 + j) * 72 + t] = __builtin_bit_cast(unsigned short, (__bf16)(kv[j] * fexp(sTot[k0 + j] - sBC[t * 65 + k0 + j])));
#pragma unroll
        for (int u = 0; u < 2; ++u) { const int i = tid + 512 * u, row = i >> 4, c16 = i & 15; *(uint4*)(Vs + row * 136 + c16 * 8) = *(const uint4*)(P0 + (size_t)(c * 64 + row) * EIN + 512 + h * 128 + c16 * 8); }
    }
    __syncthreads();
    {
        f32x4 acc[4];
#pragma unroll
        for (int kt = 0; kt < 4; ++kt) acc[kt] = (f32x4){0.f, 0.f, 0.f, 0.f};
#pragma unroll
        for (int ks = 0; ks < 2; ++ks) {
            const bf16x8 af = tr_frag(Vs, 136, ks * 32, wave * 16, lane);
#pragma unroll
            for (int kt = 0; kt < 4; ++kt) acc[kt] = __builtin_amdgcn_mfma_f32_16x16x32_bf16(af, row_frag(kT, 72, kt * 16, ks * 32, lane), acc[kt], 0, 0, 0);
        }
#pragma unroll
        for (int kt = 0; kt < 4; ++kt) {
            const int k = kt * 16 + (lane & 15), v = wave * 16 + (lane >> 4) * 4;
            st4(GDS + ((size_t)(ch * NCH + c) * 64 + k) * 128 + v, make_float4(acc[kt][0], acc[kt][1], acc[kt][2], acc[kt][3]));
        }
    }
    if (tid < 64) GDEC[(size_t)(ch * NCH + c) * 64 + tid] = fexp(sTot[tid]);
}

DEV void gla2_unit(const Params& p, int unit) {
    const int tid = opaque_tid();
    float* GDS = (float*)(p.ws + OFF_GDS); const float* GDEC = (const float*)(p.ws + OFF_GDEC);
    const int ch = unit >> 4, e = (unit & 15) * 512 + tid, k = e >> 7, dir = ch & 1;
    constexpr int GB = 12;
    float S = 0.f, ninc[GB], nd[GB];
#pragma unroll
    for (int j = 0; j < GB; ++j) { const int c = chunk_at(dir, j); ninc[j] = GDS[(size_t)(ch * NCH + c) * 8192 + e]; nd[j] = GDEC[(size_t)(ch * NCH + c) * 64 + k]; }
#pragma unroll 1
    for (int step0 = 0; step0 < NCH; step0 += GB) {
        float inc[GB], d[GB];
#pragma unroll
        for (int j = 0; j < GB; ++j) { inc[j] = ninc[j]; d[j] = nd[j]; }
#pragma unroll
        for (int j = 0; j < GB; ++j) { const int sn = step0 + GB + j, c = chunk_at(dir, sn < NCH ? sn : NCH - 1); ninc[j] = GDS[(size_t)(ch * NCH + c) * 8192 + e]; nd[j] = GDEC[(size_t)(ch * NCH + c) * 64 + k]; }
        __builtin_amdgcn_sched_barrier(0);
#pragma unroll
        for (int j = 0; j < GB; ++j) { const int c = chunk_at(dir, step0 + j); GDS[(size_t)(ch * NCH + c) * 8192 + e] = S; S = d[j] * S + inc[j]; }
    }
}

DEV void gla3_unit(const Params& p, int h, int c, float* sm) {
    const int tid = opaque_tid(), lane = tid & 63, wave = tid >> 6;
    const bf16_t* P0 = (const bf16_t*)(p.ws + OFF_P0);
    const float* GDS = (const float*)(p.ws + OFF_GDS);
    bf16_t* YC = (bf16_t*)(p.ws + OFF_YC);
    const float* ng = p.in[14];
    float* sLR = sm; float* sWA = sm + 1024; float* sBC = sm + 2048; float* sTot = sm + 6208;
    bf16_t* qt = (bf16_t*)(sm + 6272);
    bf16_t* kt = (bf16_t*)(sm + 8576);
    bf16_t* Sm = (bf16_t*)(sm + 10880);
    bf16_t* S0s = (bf16_t*)(sm + 13184);
    bf16_t* Vs = (bf16_t*)(sm + 17536);
    float* O = sm + 21888;
    const int ti = wave & 3, vt0 = (wave >> 2) * 4;
    f32x4 acc[4];
#pragma unroll
    for (int j = 0; j < 4; ++j) acc[j] = (f32x4){0.f, 0.f, 0.f, 0.f};
    __syncthreads();
#pragma unroll
    for (int u = 0; u < 2; ++u) { const int i = tid + 512 * u, row = i >> 4, c16 = i & 15; *(uint4*)(Vs + row * 136 + c16 * 8) = *(const uint4*)(P0 + (size_t)(c * 64 + row) * EIN + 512 + h * 128 + c16 * 8); }
#pragma unroll 1
    for (int dir = 0; dir < 2; ++dir) {
        const float* wa2 = p.in[dir ? 12 : 10]; const float* ba = p.in[dir ? 13 : 11];
        const int ch = h * 2 + dir;
        __syncthreads();
        gla_decay(P0, c, h, dir, wa2, ba, sLR, sWA, sBC, sTot, tid);
        {
            const int t = tid >> 3, k0 = (tid & 7) * 8;
            float qv[8], kv[8];
            unpack8(*(const uint4*)(P0 + (size_t)(c * 64 + t) * EIN + h * 64 + k0), qv);
            unpack8(*(const uint4*)(P0 + (size_t)(c * 64 + t) * EIN + 256 + h * 64 + k0), kv);
#pragma unroll
            for (int j = 0; j < 8; ++j) { const float bc = sBC[t * 65 + k0 + j]; qv[j] *= 0.125f * fexp(bc); kv[j] *= fexp(-bc); }
            *(uint4*)(qt + t * 72 + k0) = make_uint4(pack2bf(qv[0], qv[1]), pack2bf(qv[2], qv[3]), pack2bf(qv[4], qv[5]), pack2bf(qv[6], qv[7]));
            *(uint4*)(kt + t * 72 + k0) = make_uint4(pack2bf(kv[0], kv[1]), pack2bf(kv[2], kv[3]), pack2bf(kv[4], kv[5]), pack2bf(kv[6], kv[7]));
#pragma unroll
            for (int u = 0; u < 4; ++u) {
                const int i = tid + 512 * u, k = i >> 5, v4 = (i & 31) * 4;
                const float4 s4 = ld4(GDS + (size_t)(ch * NCH + c) * 8192 + k * 128 + v4);
                *(uint2*)(S0s + k * 136 + v4) = make_uint2(pack2bf(s4.x, s4.y), pack2bf(s4.z, s4.w));
            }
        }
        __syncthreads();
        {
            const int si = wave & 3;
#pragma unroll
            for (int jj = 0; jj < 2; ++jj) {
                const int t2 = (wave >> 2) * 2 + jj;
                f32x4 a = (f32x4){0.f, 0.f, 0.f, 0.f};
#pragma unroll
                for (int ks = 0; ks < 2; ++ks) a = __builtin_amdgcn_mfma_f32_16x16x32_bf16(row_frag(kt, 72, si * 16, ks * 32, lane), row_frag(qt, 72, t2 * 16, ks * 32, lane), a, 0, 0, 0);
                const int t = t2 * 16 + (lane & 15), s0 = si * 16 + (lane >> 4) * 4;
                float m[4];
#pragma unroll
                for (int r = 0; r < 4; ++r) { const bool keep = dir ? (s0 + r >= t) : (s0 + r <= t); m[r] = keep ? a[r] : 0.f; }
                *(uint2*)(Sm + t * 72 + s0) = make_uint2(pack2bf(m[0], m[1]), pack2bf(m[2], m[3]));
            }
        }
        __syncthreads();
#pragma unroll
        for (int ks = 0; ks < 2; ++ks) {
            const bf16x8 a1 = row_frag(qt, 72, ti * 16, ks * 32, lane), a2 = row_frag(Sm, 72, ti * 16, ks * 32, lane);
#pragma unroll
            for (int j = 0; j < 4; ++j) {
                acc[j] = __builtin_amdgcn_mfma_f32_16x16x32_bf16(a1, tr_frag(S0s, 136, ks * 32, (vt0 + j) * 16, lane), acc[j], 0, 0, 0);
                acc[j] = __builtin_amdgcn_mfma_f32_16x16x32_bf16(a2, tr_frag(Vs, 136, ks * 32, (vt0 + j) * 16, lane), acc[j], 0, 0, 0);
            }
        }
    }
#pragma unroll
    for (int j = 0; j < 4; ++j)
#pragma unroll
        for (int r = 0; r < 4; ++r) O[(ti * 16 + (lane >> 4) * 4 + r) * 132 + (vt0 + j) * 16 + (lane & 15)] = acc[j][r];
    __syncthreads();
    {
        const int t = tid >> 3, v0 = (tid & 7) * 16;
        float o[16];
        float ss = 0.f;
#pragma unroll
        for (int i = 0; i < 16; ++i) { o[i] = O[t * 132 + v0 + i]; ss += o[i] * o[i]; }
        ss += __shfl_xor(ss, 1, 64); ss += __shfl_xor(ss, 2, 64); ss += __shfl_xor(ss, 4, 64);
        const float rms = rsqrtf(ss * (1.f / 128.f) + 1e-5f);
        float g[16];
        const bf16_t* gp = P0 + (size_t)(c * 64 + t) * EIN + 1024 + h * 128 + v0;
        unpack8(*(const uint4*)gp, g); unpack8(*(const uint4*)(gp + 8), g + 8);
        float y[16];
#pragma unroll
        for (int i = 0; i < 16; ++i) y[i] = o[i] * rms * ng[v0 + i] * silu_f(g[i]);
        bf16_t* yp = YC + (size_t)(c * 64 + t) * 1024 + h * 128 + v0;
        *(uint4*)yp = make_uint4(pack2bf(y[0], y[1]), pack2bf(y[2], y[3]), pack2bf(y[4], y[5]), pack2bf(y[6], y[7]));
        *(uint4*)(yp + 8) = make_uint4(pack2bf(y[8], y[9]), pack2bf(y[10], y[11]), pack2bf(y[12], y[13]), pack2bf(y[14], y[15]));
    }
}

DEV void load8bf(const bf16_t* ptr, float* f) { unpack8(*(const uint4*)ptr, f); }
struct RwNb { int sL, sR, sU, sD; bool vL, vR, vU, vD; };
DEV RwNb rw_nb(int s) {
    RwNb q; q.vU = false; q.vD = false;
    if (s < NCX) { q.vL = s > 0; q.vR = s < NCX - 1; }
    else { const int n = s - NCX, rr = n >> 6, cc = n & 63; q.vL = cc > 0; q.vR = cc < 63; q.vU = rr > 0; q.vD = rr < 127; }
    q.sL = q.vL ? s - 1 : s; q.sR = q.vR ? s + 1 : s; q.sU = q.vU ? s - 64 : s; q.sD = q.vD ? s + 64 : s;
    return q;
}
struct RwRaw { uint4 o, l, r, u, d; };
DEV RwRaw rw_load(const bf16_t* P0, int s, const RwNb& q, int cb) {
    RwRaw w;
    w.o = *(const uint4*)(P0 + (size_t)s * EIN + RW0 + cb); w.l = *(const uint4*)(P0 + (size_t)q.sL * EIN + RW0 + cb); w.r = *(const uint4*)(P0 + (size_t)q.sR * EIN + RW0 + cb);
    w.u = *(const uint4*)(P0 + (size_t)q.sU * EIN + RW0 + cb); w.d = *(const uint4*)(P0 + (size_t)q.sD * EIN + RW0 + cb);
    return w;
}
DEV void rw_comb_l(const RwRaw& w, const RwNb& q, const float* ml, float* out) {
    float own[8]; unpack8(w.o, own);
    const float nb[8] = {q.vL ? bflo(w.l.x) : 0.f, q.vR ? bfhi(w.r.x) : 0.f, q.vU ? bflo(w.u.y) : 0.f, q.vD ? bfhi(w.d.y) : 0.f,
                         q.vL ? bflo(w.l.z) : 0.f, q.vR ? bfhi(w.r.z) : 0.f, q.vU ? bflo(w.u.w) : 0.f, q.vD ? bfhi(w.d.w) : 0.f};
    const float4 m0 = *(const float4*)ml, m1 = *(const float4*)(ml + 4);
    const float m[8] = {m0.x, m0.y, m0.z, m0.w, m1.x, m1.y, m1.z, m1.w};
#pragma unroll
    for (int i = 0; i < 8; ++i) out[i] = own[i] + (nb[i] - own[i]) * m[i];
}
DEV void rw_comb(const RwRaw& w, const RwNb& q, const float* __restrict__ mu, int cb, float* out) {
    float own[8]; unpack8(w.o, own);
    const float nb[8] = {q.vL ? bflo(w.l.x) : 0.f, q.vR ? bfhi(w.r.x) : 0.f, q.vU ? bflo(w.u.y) : 0.f, q.vD ? bfhi(w.d.y) : 0.f,
                         q.vL ? bflo(w.l.z) : 0.f, q.vR ? bfhi(w.r.z) : 0.f, q.vU ? bflo(w.u.w) : 0.f, q.vD ? bfhi(w.d.w) : 0.f};
    const float4 m0 = ld4(mu + cb), m1 = ld4(mu + cb + 4);
    const float m[8] = {m0.x, m0.y, m0.z, m0.w, m1.x, m1.y, m1.z, m1.w};
#pragma unroll
    for (int i = 0; i < 8; ++i) out[i] = own[i] + (nb[i] - own[i]) * m[i];
}
DEV uint4 pack8(const float* f) { return make_uint4(pack2bf(f[0], f[1]), pack2bf(f[2], f[3]), pack2bf(f[4], f[5]), pack2bf(f[6], f[7])); }

template <int XM, int YM, class F>
DEV void mm64(const bf16_t* X, const bf16_t* Y, F f, int lane, int wave) {
#pragma unroll
    for (int q = 0; q < 2; ++q) {
        const int idx = wave * 2 + q, ti = idx >> 2, tj = idx & 3;
        f32x4 acc = (f32x4){0.f, 0.f, 0.f, 0.f};
#pragma unroll
        for (int ks = 0; ks < 2; ++ks) {
            const bf16x8 a = XM == 0 ? row_frag(X, 72, ti * 16, ks * 32, lane) : tr_frag(X, 72, ks * 32, ti * 16, lane);
            const bf16x8 bq = YM == 0 ? row_frag(Y, 72, tj * 16, ks * 32, lane) : tr_frag(Y, 72, ks * 32, tj * 16, lane);
            acc = __builtin_amdgcn_mfma_f32_16x16x32_bf16(a, bq, acc, 0, 0, 0);
        }
        f(ti * 16 + (lane >> 4) * 4, tj * 16 + (lane & 15), acc);
    }
}
template <int XM, int YM, class F>
DEV void mm64x2(const bf16_t* X1, const bf16_t* Y1, const bf16_t* X2, const bf16_t* Y2, F f, int lane, int wave) {
#pragma unroll
    for (int q = 0; q < 2; ++q) {
        const int idx = wave * 2 + q, ti = idx >> 2, tj = idx & 3;
        f32x4 acc = (f32x4){0.f, 0.f, 0.f, 0.f};
#pragma unroll
        for (int ks = 0; ks < 2; ++ks) {
            const bf16x8 a = XM == 0 ? row_frag(X1, 72, ti * 16, ks * 32, lane) : tr_frag(X1, 72, ks * 32, ti * 16, lane);
            const bf16x8 bq = YM == 0 ? row_frag(Y1, 72, tj * 16, ks * 32, lane) : tr_frag(Y1, 72, ks * 32, tj * 16, lane);
            acc = __builtin_amdgcn_mfma_f32_16x16x32_bf16(a, bq, acc, 0, 0, 0);
            const bf16x8 a2 = XM == 0 ? row_frag(X2, 72, ti * 16, ks * 32, lane) : tr_frag(X2, 72, ks * 32, ti * 16, lane);
            const bf16x8 b2 = YM == 0 ? row_frag(Y2, 72, tj * 16, ks * 32, lane) : tr_frag(Y2, 72, ks * 32, tj * 16, lane);
            acc = __builtin_amdgcn_mfma_f32_16x16x32_bf16(a2, b2, acc, 0, 0, 0);
        }
        f(ti * 16 + (lane >> 4) * 4, tj * 16 + (lane & 15), acc);
    }
}
DEV void st_img(bf16_t* P, int i0, int j, float a0, float a1, float a2, float a3) {
    P[(i0 + 0) * 72 + j] = __builtin_bit_cast(unsigned short, (__bf16)a0); P[(i0 + 1) * 72 + j] = __builtin_bit_cast(unsigned short, (__bf16)a1);
    P[(i0 + 2) * 72 + j] = __builtin_bit_cast(unsigned short, (__bf16)a2); P[(i0 + 3) * 72 + j] = __builtin_bit_cast(unsigned short, (__bf16)a3);
}

struct RwRaw3 { uint4 o, u, d; };
DEV RwRaw3 rw_load3(const bf16_t* P0, int s, const RwNb& q, int cb) {
    RwRaw3 w;
    w.o = *(const uint4*)(P0 + (size_t)s * EIN + RW0 + cb); w.u = *(const uint4*)(P0 + (size_t)q.sU * EIN + RW0 + cb); w.d = *(const uint4*)(P0 + (size_t)q.sD * EIN + RW0 + cb);
    return w;
}
DEV void rw_comb3(const RwRaw3& w, const RwNb& q, const bf16_t* tile, const bf16_t* P0, int s, int t, int cb, int j0, const float* ml, float* out) {
    asm volatile("" :: "v"(w.u.x), "v"(w.u.z), "v"(w.d.x), "v"(w.d.z));
    float own[8]; unpack8(w.o, own);
    float l0 = 0.f, l4 = 0.f, r1 = 0.f, r5 = 0.f;
    if (q.vL) { if (t > 0) { l0 = bf2f(tile[(t - 1) * 72 + j0]); l4 = bf2f(tile[(t - 1) * 72 + j0 + 4]); }
                else { const bf16_t* g = P0 + (size_t)(s - 1) * EIN + RW0 + cb; l0 = bf2f(g[0]); l4 = bf2f(g[4]); } }
    if (q.vR) { if (t < 63) { r1 = bf2f(tile[(t + 1) * 72 + j0 + 1]); r5 = bf2f(tile[(t + 1) * 72 + j0 + 5]); }
                else { const bf16_t* g = P0 + (size_t)(s + 1) * EIN + RW0 + cb; r1 = bf2f(g[1]); r5 = bf2f(g[5]); } }
    const float nb[8] = {l0, r1, q.vU ? bflo(w.u.y) : 0.f, q.vD ? bfhi(w.d.y) : 0.f, l4, r5, q.vU ? bflo(w.u.w) : 0.f, q.vD ? bfhi(w.d.w) : 0.f};
    const float4 m0 = *(const float4*)ml, m1 = *(const float4*)(ml + 4);
    const float m[8] = {m0.x, m0.y, m0.z, m0.w, m1.x, m1.y, m1.z, m1.w};
#pragma unroll
    for (int i = 0; i < 8; ++i) out[i] = own[i] + (nb[i] - own[i]) * m[i];
}
struct R1Raw { RwRaw3 r, k, v, w, a; float4 qw0, qw1, qa0, qa1; };
DEV void r1_consts(const Params& p, int h, int dir, float* sm) {
    const int tid = opaque_tid();
    float* sv = (float*)((bf16_t*)sm + 14 * 4608);
    __syncthreads();
    if (tid < 64) { const int hc = h * 64 + tid; sv[64 + tid] = p.in[dir ? 18 : 16][hc]; sv[128 + tid] = p.in[dir ? 22 : 20][hc]; sv[192 + tid] = p.in[24][hc]; sv[256 + tid] = p.in[25][hc]; sv[320 + tid] = p.in[26][hc]; }
    if (tid < 320) { const int tn = tid >> 6, col = tid & 63; const int cb = tn < 3 ? tn * 512 + h * 64 : (tn == 3 ? 2048 + dir * 64 : 2176 + dir * 64); sv[384 + tid] = p.in[15][cb + col]; }
}
DEV void r1_load(const Params& p, int h, int dir, int c, R1Raw& R) {
    const int tid = opaque_tid();
    const bf16_t* P0 = (const bf16_t*)(p.ws + OFF_P0);
    const float* ww2 = p.in[dir ? 19 : 17]; const float* wa2 = p.in[dir ? 23 : 21];
    const int t = tid >> 3, j0 = (tid & 7) * 8, s = c * 64 + t;
    const RwNb nbq = rw_nb(s);
    R.r = rw_load3(P0, s, nbq, h * 64 + j0); R.k = rw_load3(P0, s, nbq, 512 + h * 64 + j0); R.v = rw_load3(P0, s, nbq, 1024 + h * 64 + j0);
    R.w = rw_load3(P0, s, nbq, 2048 + dir * 64 + j0); R.a = rw_load3(P0, s, nbq, 2176 + dir * 64 + j0);
    R.qw0 = ld4(ww2 + (size_t)t * 512 + h * 64 + j0); R.qw1 = ld4(ww2 + (size_t)t * 512 + h * 64 + j0 + 4);
    R.qa0 = ld4(wa2 + (size_t)t * 512 + h * 64 + j0); R.qa1 = ld4(wa2 + (size_t)t * 512 + h * 64 + j0 + 4);
}
DEV void rwkv1_unit(const Params& p, int h, int dir, int c, float* sm, R1Raw& R, int cnext) {
    const int tid = opaque_tid(), lane = tid & 63, wave = tid >> 6;
    bf16_t* RU = (bf16_t*)(p.ws + OFF_RU) + (size_t)((h * 2 + dir) * NCH + c) * 16384;
    float* BONS = (float*)(p.ws + OFF_BONS);
    bf16_t* img = (bf16_t*)sm;
#define SLOT(i_) (img + (i_) * 4608)
    float* fLW = (float*)SLOT(10);
    float* fAS = (float*)SLOT(12);
    float* sv = (float*)SLOT(14);
    const int t = tid >> 3, j0 = (tid & 7) * 8, s = c * 64 + t;
    const bf16_t* P0 = (const bf16_t*)(p.ws + OFF_P0);
    __syncthreads();
    *(uint4*)(SLOT(0) + t * 72 + j0) = R.r.o; *(uint4*)(SLOT(1) + t * 72 + j0) = R.k.o; *(uint4*)(SLOT(2) + t * 72 + j0) = R.v.o;
    *(uint4*)(SLOT(3) + t * 72 + j0) = R.w.o; *(uint4*)(SLOT(4) + t * 72 + j0) = R.a.o;
    __syncthreads();
    float r8[8], k8[8], v8[8];
    {
        float x8[8];
        const RwNb nbq = rw_nb(s);
        rw_comb3(R.r, nbq, SLOT(0), P0, s, t, h * 64 + j0, j0, sv + 384 + j0, r8);
        rw_comb3(R.k, nbq, SLOT(1), P0, s, t, 512 + h * 64 + j0, j0, sv + 448 + j0, k8);
        rw_comb3(R.v, nbq, SLOT(2), P0, s, t, 1024 + h * 64 + j0, j0, sv + 512 + j0, v8);
        rw_comb3(R.w, nbq, SLOT(3), P0, s, t, 2048 + dir * 64 + j0, j0, sv + 576 + j0, x8);
#pragma unroll
        for (int i = 0; i < 8; ++i) x8[i] = tanh_f(x8[i]);
        *(uint4*)(SLOT(6) + t * 72 + j0) = pack8(x8);
        rw_comb3(R.a, nbq, SLOT(4), P0, s, t, 2176 + dir * 64 + j0, j0, sv + 640 + j0, x8);
        *(uint4*)(SLOT(7) + t * 72 + j0) = pack8(x8);
        { const float wq[8] = {R.qw0.x, R.qw0.y, R.qw0.z, R.qw0.w, R.qw1.x, R.qw1.y, R.qw1.z, R.qw1.w}; *(uint4*)(SLOT(8) + t * 72 + j0) = pack8(wq); }
        { const float wq[8] = {R.qa0.x, R.qa0.y, R.qa0.z, R.qa0.w, R.qa1.x, R.qa1.y, R.qa1.z, R.qa1.w}; *(uint4*)(SLOT(9) + t * 72 + j0) = pack8(wq); }
    }
    r1_load(p, h, dir, cnext >= 0 ? cnext : c, R);
    __syncthreads();
    mm64<0, 1>(SLOT(6), SLOT(8), [=](int i0, int j, f32x4 a) {
#pragma unroll
        for (int r = 0; r < 4; ++r) fLW[(i0 + r) * 65 + j] = -0.6065306597f * sigmoid_f(sv[64 + j] + a[r]); }, lane, wave);
    mm64<0, 1>(SLOT(7), SLOT(9), [=](int i0, int j, f32x4 a) {
#pragma unroll
        for (int r = 0; r < 4; ++r) fAS[(i0 + r) * 65 + j] = sigmoid_f(sv[128 + j] + a[r]); }, lane, wave);
    __syncthreads();
#pragma unroll
    for (int j = 0; j < 8; ++j) {
        const int k = wave * 8 + j;
        const float v = wave_scan_add(fLW[lane * 65 + k], lane, dir);
        fLW[lane * 65 + k] = v;
        if (lane == (dir ? 0 : 63)) sv[k] = v;
    }
    __syncthreads();
    {
        float kkv[8], ss = 0.f;
#pragma unroll
        for (int i = 0; i < 8; ++i) { kkv[i] = k8[i] * sv[192 + j0 + i]; ss += kkv[i] * kkv[i]; }
        ss += __shfl_xor(ss, 1, 64); ss += __shfl_xor(ss, 2, 64); ss += __shfl_xor(ss, 4, 64);
        const float rn = rsqrtf(fmaxf(ss, 1e-24f));
        float fa[8], fb[8], fk[8], fr[8], fbp[8], fkp[8], bon = 0.f;
        const int tp = dir ? t + 1 : t - 1;
        const bool hasp = dir ? (t < 63) : (t > 0);
#pragma unroll
        for (int i = 0; i < 8; ++i) {
            const int k = j0 + i;
            const float Bt = fLW[t * 65 + k], Bx = hasp ? fLW[tp * 65 + k] : 0.f, asg = fAS[t * 65 + k];
            const float kk = kkv[i] * rn, kh = k8[i] * (1.f + (asg - 1.f) * sv[256 + k]);
            bon += r8[i] * kh * sv[320 + k];
            const float enB = fexp(-Bt), eLB = fexp(sv[k] - Bt), bv = kk * asg;
            fa[i] = -kk * fexp(Bx); fb[i] = bv * enB; fk[i] = kh * enB; fr[i] = r8[i] * fexp(Bt); fbp[i] = bv * eLB; fkp[i] = kh * eLB;
        }
        bon += __shfl_xor(bon, 1, 64); bon += __shfl_xor(bon, 2, 64); bon += __shfl_xor(bon, 4, 64);
        if ((tid & 7) == 0) BONS[((size_t)dir * TB + s) * 8 + h] = bon;
        *(uint4*)(SLOT(0) + t * 72 + j0) = pack8(fa); *(uint4*)(SLOT(1) + t * 72 + j0) = pack8(fb); *(uint4*)(SLOT(2) + t * 72 + j0) = pack8(fk);
        *(uint4*)(SLOT(3) + t * 72 + j0) = pack8(fr); *(uint4*)(SLOT(4) + t * 72 + j0) = pack8(fbp); *(uint4*)(SLOT(5) + t * 72 + j0) = pack8(fkp);
    }
    __syncthreads();
    *(uint4*)(SLOT(6) + t * 72 + j0) = pack8(v8);
    __syncthreads();
    mm64<0, 0>(SLOT(0), SLOT(1), [=](int i0, int j, f32x4 a) {
        float m[4];
#pragma unroll
        for (int r = 0; r < 4; ++r) { const bool keep = dir ? (j > i0 + r) : (j < i0 + r); m[r] = keep ? a[r] : 0.f; }
        const bool dg = (i0 >> 4) == (j >> 4);
        st_img(SLOT(7), i0, j, dg ? m[0] : 0.f, dg ? m[1] : 0.f, dg ? m[2] : 0.f, dg ? m[3] : 0.f);
        st_img(SLOT(8), i0, j, (dg ? m[0] : 0.f) + (j == i0 ? 1.f : 0.f), (dg ? m[1] : 0.f) + (j == i0 + 1 ? 1.f : 0.f), (dg ? m[2] : 0.f) + (j == i0 + 2 ? 1.f : 0.f), (dg ? m[3] : 0.f) + (j == i0 + 3 ? 1.f : 0.f));
        st_img(SLOT(12), i0, j, dg ? 0.f : m[0], dg ? 0.f : m[1], dg ? 0.f : m[2], dg ? 0.f : m[3]); }, lane, wave);
    mm64<0, 0>(SLOT(0), SLOT(2), [=](int i0, int j, f32x4 a) {
        float m[4];
#pragma unroll
        for (int r = 0; r < 4; ++r) { const bool keep = dir ? (j > i0 + r) : (j < i0 + r); m[r] = keep ? a[r] : 0.f; }
        st_img(SLOT(9), i0, j, m[0], m[1], m[2], m[3]); }, lane, wave);
    mm64<0, 0>(SLOT(3), SLOT(1), [=](int i0, int j, f32x4 a) {
        float m[4];
#pragma unroll
        for (int r = 0; r < 4; ++r) { const bool keep = dir ? (j >= i0 + r) : (j <= i0 + r); m[r] = keep ? a[r] : 0.f; }
        st_img(SLOT(10), i0, j, m[0], m[1], m[2], m[3]); }, lane, wave);
    mm64<0, 0>(SLOT(3), SLOT(2), [=](int i0, int j, f32x4 a) {
        float m[4];
#pragma unroll
        for (int r = 0; r < 4; ++r) { const bool keep = dir ? (j >= i0 + r) : (j <= i0 + r); m[r] = keep ? a[r] : 0.f; }
        st_img(SLOT(11), i0, j, m[0], m[1], m[2], m[3]); }, lane, wave);
    __syncthreads();
    {
        bf16_t* Pc = SLOT(7); bf16_t* Pn = SLOT(1); bf16_t* Tc = SLOT(8); bf16_t* Tn = SLOT(2);
#pragma unroll 1
        for (int it = 0; it < 3; ++it) {
            mm64<0, 1>(Pc, Pc, [=](int i0, int j, f32x4 a) { st_img(Pn, i0, j, a[0], a[1], a[2], a[3]); }, lane, wave);
            __syncthreads();
            mm64<0, 1>(Tc, Pn, [=](int i0, int j, f32x4 a) {
                st_img(Tn, i0, j, a[0] + bf2f(Tc[(i0 + 0) * 72 + j]), a[1] + bf2f(Tc[(i0 + 1) * 72 + j]), a[2] + bf2f(Tc[(i0 + 2) * 72 + j]), a[3] + bf2f(Tc[(i0 + 3) * 72 + j])); }, lane, wave);
            __syncthreads();
            bf16_t* tmp = Pc; Pc = Pn; Pn = tmp; tmp = Tc; Tc = Tn; Tn = tmp;
        }
    }
    mm64<0, 1>(SLOT(2), SLOT(12), [=](int i0, int j, f32x4 a) { st_img(SLOT(7), i0, j, a[0], a[1], a[2], a[3]); }, lane, wave);
    mm64<0, 1>(SLOT(2), SLOT(0), [=](int i0, int j, f32x4 a) { st_img(SLOT(1), i0, j, a[0], a[1], a[2], a[3]); }, lane, wave);
    mm64<0, 1>(SLOT(9), SLOT(6), [=](int i0, int j, f32x4 a) { st_img(SLOT(13), i0, j, a[0], a[1], a[2], a[3]); }, lane, wave);
    __syncthreads();
    mm64<0, 1>(SLOT(2), SLOT(13), [=](int i0, int j, f32x4 a) { st_img(SLOT(8), i0, j, a[0], a[1], a[2], a[3]); }, lane, wave);
    __syncthreads();
    {
        const bf16_t* Zp = (wave < 4) ? SLOT(1) : SLOT(8);
        bf16_t* Xi = (wave < 4) ? SLOT(12) : SLOT(9);
        const int ct = (wave & 3) * 16, g4 = (lane >> 4) * 4, l15 = lane & 15;
#pragma unroll
        for (int bs = 0; bs < 4; ++bs) {
            const int bi = dir ? 3 - bs : bs;
            f32x4 acc;
#pragma unroll
            for (int r = 0; r < 4; ++r) acc[r] = bf2f(Zp[(bi * 16 + g4 + r) * 72 + ct + l15]);
            const bool k0 = dir ? (bi == 0) : (bi >= 1), k1 = dir ? (bi <= 2) : (bi == 3);
            if (k0) acc = __builtin_amdgcn_mfma_f32_16x16x32_bf16(row_frag(SLOT(7), 72, bi * 16, 0, lane), tr_frag(Xi, 72, 0, ct, lane), acc, 0, 0, 0);
            if (k1) acc = __builtin_amdgcn_mfma_f32_16x16x32_bf16(row_frag(SLOT(7), 72, bi * 16, 32, lane), tr_frag(Xi, 72, 32, ct, lane), acc, 0, 0, 0);
            st_img(Xi, bi * 16 + g4, ct + l15, acc[0], acc[1], acc[2], acc[3]);
            __syncthreads();
        }
    }
    mm64<1, 1>(SLOT(12), SLOT(4), [=](int i0, int j, f32x4 a) {
        float m[4];
#pragma unroll
        for (int r = 0; r < 4; ++r) m[r] = a[r] + ((i0 + r) == j ? fexp(sv[j]) : 0.f);
        *(uint2*)(RU + j * 64 + i0) = make_uint2(pack2bf(m[0], m[1]), pack2bf(m[2], m[3])); }, lane, wave);
    mm64x2<1, 1>(SLOT(4), SLOT(9), SLOT(5), SLOT(6), [=](int i0, int j, f32x4 a) {
        *(uint2*)(RU + 4096 + j * 64 + i0) = make_uint2(pack2bf(a[0], a[1]), pack2bf(a[2], a[3])); }, lane, wave);
    mm64<1, 0>(SLOT(12), SLOT(10), [=](int i0, int j, f32x4 a) {
        const uint2 rr = *(const uint2*)(SLOT(3) + j * 72 + i0);
        *(uint2*)(RU + 8192 + j * 64 + i0) = make_uint2(pack2bf(a[0] + bflo(rr.x), a[1] + bfhi(rr.x)), pack2bf(a[2] + bflo(rr.y), a[3] + bfhi(rr.y))); }, lane, wave);
    mm64x2<0, 1>(SLOT(10), SLOT(9), SLOT(11), SLOT(6), [=](int i0, int j, f32x4 a) {
        *(uint2*)(RU + 12288 + j * 64 + i0) = make_uint2(pack2bf(a[0], a[1]), pack2bf(a[2], a[3])); }, lane, wave);
#undef SLOT
}

#define R2_LOAD(M_, C_, rnd_) do { const int r0_ = ((rnd_) < R2_NR ? (rnd_) : R2_NR - 1) * R2_RS; \
    _Pragma("unroll") for (int s_ = 0; s_ < R2_RS; ++s_) M_[s_] = *(const uint4*)(RU + (size_t)(chain * NCH + chunk_at(dir, r0_ + s_)) * 16384 + tid * 8); \
    _Pragma("unroll") for (int j_ = 0; j_ < 3; ++j_) { const int cq_ = tid + 512 * j_; \
        C_[j_] = *(const uint4*)(RU + (size_t)(chain * NCH + chunk_at(dir, r0_ + (cq_ >> 7))) * 16384 + 4096 + (vblk * 16 + ((cq_ >> 3) & 15)) * 64 + (cq_ & 7) * 8); } } while (0)
#define R2_ROUND(M_, C_, rnd_) do { \
    { const int row_ = tid >> 3, c8_ = tid & 7, sw_ = (row_ >> 1) & 7, u0_ = (c8_ >> 2) * 4 + (c8_ & 1) * 2, eh_ = ((c8_ >> 1) & 1) * 8; \
      _Pragma("unroll") for (int s_ = 0; s_ < R2_RS; ++s_) { char* sl_ = ring + s_ * 10240 + row_ * 128 + eh_; \
          *(uint2*)(sl_ + ((u0_ ^ sw_) * 16)) = make_uint2(M_[s_].x, M_[s_].y); *(uint2*)(sl_ + (((u0_ + 1) ^ sw_) * 16)) = make_uint2(M_[s_].z, M_[s_].w); } \
      _Pragma("unroll") for (int j_ = 0; j_ < 3; ++j_) { const int cq_ = tid + 512 * j_, rw_ = (cq_ >> 3) & 15, q8_ = cq_ & 7, i_ = q8_ >> 1, g0_ = (q8_ & 1) * 2, sc_ = (rw_ >> 1) & 7; \
          char* sl_ = ring + (cq_ >> 7) * 10240 + 8192 + rw_ * 128 + (i_ & 1) * 8; \
          *(uint2*)(sl_ + (((g0_ * 2 + (i_ >> 1)) ^ sc_) * 16)) = make_uint2(C_[j_].x, C_[j_].y); *(uint2*)(sl_ + ((((g0_ + 1) * 2 + (i_ >> 1)) ^ sc_) * 16)) = make_uint2(C_[j_].z, C_[j_].w); } } \
    R2_LOAD(M_, C_, (rnd_) + 2); \
    __syncthreads(); \
    if (wave == 0) { \
        _Pragma("unroll 4") for (int s_ = 0; s_ < R2_RS; ++s_) { \
            const int c_ = chunk_at(dir, (rnd_) * R2_RS + s_); const char* sl_ = ring + s_ * 10240; \
            unsigned pk_[4][2]; \
            _Pragma("unroll") for (int i_ = 0; i_ < 4; ++i_) { pk_[i_][0] = pack2bf(st[i_][0], st[i_][1]); pk_[i_][1] = pack2bf(st[i_][2], st[i_][3]); } \
            bf16_t* sp_ = S0G + ((size_t)(chain * NCH + c_) * 64 + vblk * 16 + l15) * 64 + g * 4; \
            _Pragma("unroll") for (int i_ = 0; i_ < 4; ++i_) *(uint2*)(sp_ + i_ * 16) = make_uint2(pk_[i_][0], pk_[i_][1]); \
            bf16x8 bfr_[2]; \
            _Pragma("unroll") for (int ks_ = 0; ks_ < 2; ++ks_) { const uint4 u_ = make_uint4(pk_[2 * ks_][0], pk_[2 * ks_][1], pk_[2 * ks_ + 1][0], pk_[2 * ks_ + 1][1]); bfr_[ks_] = __builtin_bit_cast(bf16x8, u_); } \
            const uint4 c01_ = *(const uint4*)(sl_ + 8192 + l15 * 128 + (((g * 2) ^ ((l15 >> 1) & 7)) * 16)), c23_ = *(const uint4*)(sl_ + 8192 + l15 * 128 + (((g * 2 + 1) ^ ((l15 >> 1) & 7)) * 16)); \
            const unsigned cw_[8] = {c01_.x, c01_.y, c01_.z, c01_.w, c23_.x, c23_.y, c23_.z, c23_.w}; \
            _Pragma("unroll") for (int i_ = 0; i_ < 4; ++i_) { \
                f32x4 acc_ = (f32x4){bflo(cw_[2 * i_]), bfhi(cw_[2 * i_]), bflo(cw_[2 * i_ + 1]), bfhi(cw_[2 * i_ + 1])}; \
                _Pragma("unroll") for (int ks_ = 0; ks_ < 2; ++ks_) { \
                    const int row_ = i_ * 16 + l15; \
                    const bf16x8 af_ = *(const bf16x8*)(sl_ + row_ * 128 + (((ks_ * 4 + g) ^ ((row_ >> 1) & 7)) * 16)); \
                    acc_ = __builtin_amdgcn_mfma_f32_16x16x32_bf16(af_, bfr_[ks_], acc_, 0, 0, 0); } \
                st[i_] = acc_; } } } \
    __syncthreads(); } while (0)
DEV void rwkv2_unit(const Params& p, int chain, int vblk, float* sm) {
    constexpr int R2_RS = 12, R2_NR = NCH / R2_RS;
    static_assert(R2_NR * R2_RS == NCH && R2_RS * 10240 <= LDS_BYTES, "R2 ring");
    const int tid = opaque_tid(), lane = tid & 63, wave = tid >> 6;
    const bf16_t* RU = (const bf16_t*)(p.ws + OFF_RU);
    bf16_t* S0G = (bf16_t*)(p.ws + OFF_RS0);
    char* ring = (char*)sm;
    const int dir = chain & 1, g = lane >> 4, l15 = lane & 15;
    f32x4 st[4];
#pragma unroll
    for (int i = 0; i < 4; ++i) st[i] = (f32x4){0.f, 0.f, 0.f, 0.f};
    uint4 ma[R2_RS], ca[3], mb[R2_RS], cb[3];
    __syncthreads();
    R2_LOAD(ma, ca, 0); R2_LOAD(mb, cb, 1);
#pragma unroll 1
    for (int rnd = 0; rnd < R2_NR; rnd += 2) {
        R2_ROUND(ma, ca, rnd);
        if (rnd + 1 < R2_NR) R2_ROUND(mb, cb, rnd + 1);
    }
}
#undef R2_LOAD
#undef R2_ROUND

DEV void rwkv3_unit(const Params& p, int h, int c, float* sm) {
    const int tid = opaque_tid(), lane = tid & 63, wave = tid >> 6;
    const bf16_t* P0 = (const bf16_t*)(p.ws + OFF_P0);
    const bf16_t* RUb = (const bf16_t*)(p.ws + OFF_RU);
    const bf16_t* S0G = (const bf16_t*)(p.ws + OFF_RS0);
    const float* BONS = (const float*)(p.ws + OFF_BONS);
    bf16_t* YC = (bf16_t*)(p.ws + OFF_YC);
    const float* mu = p.in[15]; const float* gn_g = p.in[27]; const float* gn_b = p.in[28];
    bf16_t* img = (bf16_t*)sm;
    float* O = sm + 4 * 2304;
    const int t = tid >> 3, v0 = (tid & 7) * 8, s = c * 64 + t;
    const size_t u0 = (size_t)((h * 2 + 0) * NCH + c), u1 = (size_t)((h * 2 + 1) * NCH + c);
    const uint4 gr0 = *(const uint4*)(RUb + u0 * 16384 + 8192 + t * 64 + v0), gs0 = *(const uint4*)(S0G + u0 * 4096 + t * 64 + v0);
    const uint4 gr1 = *(const uint4*)(RUb + u1 * 16384 + 8192 + t * 64 + v0), gs1 = *(const uint4*)(S0G + u1 * 4096 + t * 64 + v0);
    uint2 yl[2][2];
#pragma unroll
    for (int q = 0; q < 2; ++q) { const int idx = wave * 2 + q, ti = idx >> 2, tj = idx & 3;
        yl[q][0] = *(const uint2*)(RUb + u0 * 16384 + 12288 + (tj * 16 + (lane & 15)) * 64 + ti * 16 + (lane >> 4) * 4);
        yl[q][1] = *(const uint2*)(RUb + u1 * 16384 + 12288 + (tj * 16 + (lane & 15)) * 64 + ti * 16 + (lane >> 4) * 4); }
    const RwNb nbq = rw_nb(s);
    const RwRaw wv_ = rw_load(P0, s, nbq, 1024 + h * 64 + v0), wg_ = rw_load(P0, s, nbq, 1536 + h * 64 + v0);
    const float bon = BONS[(size_t)s * 8 + h] + BONS[((size_t)TB + s) * 8 + h];
    __syncthreads();
    *(uint4*)(img + 0 * 4608 + t * 72 + v0) = gr0; *(uint4*)(img + 2 * 4608 + t * 72 + v0) = gs0;
    *(uint4*)(img + 1 * 4608 + t * 72 + v0) = gr1; *(uint4*)(img + 3 * 4608 + t * 72 + v0) = gs1;
    __syncthreads();
#pragma unroll
    for (int q = 0; q < 2; ++q) {
        const int idx = wave * 2 + q, ti = idx >> 2, tj = idx & 3;
        f32x4 accd[2];
#pragma unroll
        for (int dir = 0; dir < 2; ++dir) {
            f32x4 acc = (f32x4){bflo(yl[q][dir].x), bfhi(yl[q][dir].x), bflo(yl[q][dir].y), bfhi(yl[q][dir].y)};
#pragma unroll
            for (int ks = 0; ks < 2; ++ks) acc = __builtin_amdgcn_mfma_f32_16x16x32_bf16(row_frag(img + dir * 4608, 72, ti * 16, ks * 32, lane), row_frag(img + (2 + dir) * 4608, 72, tj * 16, ks * 32, lane), acc, 0, 0, 0);
            accd[dir] = acc;
        }
#pragma unroll
        for (int r = 0; r < 4; ++r) {
            const int oi = (ti * 16 + (lane >> 4) * 4 + r) * 68 + tj * 16 + (lane & 15);
            O[oi] = accd[0][r] + accd[1][r];
        }
    }
    __syncthreads();
    {
        float y[8], sum = 0.f;
#pragma unroll
        for (int i = 0; i < 8; ++i) { y[i] = O[t * 68 + v0 + i]; sum += y[i]; }
        sum += __shfl_xor(sum, 1, 64); sum += __shfl_xor(sum, 2, 64); sum += __shfl_xor(sum, 4, 64);
        const float mean = sum * (1.f / 64.f);
        float sq = 0.f;
#pragma unroll
        for (int i = 0; i < 8; ++i) { y[i] -= mean; sq += y[i] * y[i]; }
        sq += __shfl_xor(sq, 1, 64); sq += __shfl_xor(sq, 2, 64); sq += __shfl_xor(sq, 4, 64);
        const float rstd = rsqrtf(sq * (1.f / 64.f) + 64e-5f);
        float vm[8], gm[8];
        rw_comb(wv_, nbq, mu, 1024 + h * 64 + v0, vm);
        rw_comb(wg_, nbq, mu, 1536 + h * 64 + v0, gm);
        float o[8];
#pragma unroll
        for (int i = 0; i < 8; ++i) o[i] = (y[i] * rstd * gn_g[h * 64 + v0 + i] + gn_b[h * 64 + v0 + i] + bon * vm[i]) * silu_f(gm[i]);
        *(uint4*)(YC + (size_t)s * 1024 + 512 + h * 64 + v0) = pack8(o);
    }
}

DEV void ln_rows(const float* src, const float* res_lat, const float* res_cx, int nrows, const float* __restrict__ g, const float* __restrict__ bt, float* dst_lat, float* dst_cx, int ncx,
                 bf16_t* hb = nullptr, const float* mvc = nullptr, const float* mvl = nullptr) {
    const int tid_ = opaque_tid(); const int lane = tid_ & 63, gw = blockIdx.x * NWV + (tid_ >> 6), ngw = gridDim.x * NWV;
    for (int r = gw; r < nrows; r += ngw) {
        const float* x = src + (size_t)r * 1024;
        float4 v[4];
        float sum = 0.f;
        const float* xr = (r < ncx) ? (res_cx + (size_t)r * 1024) : (res_lat + (size_t)(r - ncx) * 1024);
#pragma unroll
        for (int i = 0; i < 4; ++i) { const float4 a = ld4(x + i * 256 + lane * 4), rr = ld4(xr + i * 256 + lane * 4);
            v[i] = make_float4(ALPHA * rr.x + a.x, ALPHA * rr.y + a.y, ALPHA * rr.z + a.z, ALPHA * rr.w + a.w); sum += v[i].x + v[i].y + v[i].z + v[i].w; }
        const float mean = wave_sum(sum) * (1.f / 1024.f);
        float sq = 0.f;
#pragma unroll
        for (int i = 0; i < 4; ++i) {
            v[i].x -= mean; v[i].y -= mean; v[i].z -= mean; v[i].w -= mean;
            sq += v[i].x * v[i].x + v[i].y * v[i].y + v[i].z * v[i].z + v[i].w * v[i].w;
        }
        const float rstd = rsqrtf(wave_sum(sq) * (1.f / 1024.f) + 1e-5f);
        float* d = (r < ncx) ? (dst_cx + (size_t)r * 1024) : (dst_lat + (size_t)(r - ncx) * 1024);
#pragma unroll
        for (int i = 0; i < 4; ++i) {
            const int c = i * 256 + lane * 4;
            const float4 gg = ld4(g + c), bb = ld4(bt + c);
            const float4 y = make_float4(v[i].x * rstd * gg.x + bb.x, v[i].y * rstd * gg.y + bb.y, v[i].z * rstd * gg.z + bb.z, v[i].w * rstd * gg.w + bb.w);
            st4(d + c, y);
            if (hb != nullptr) {
                const float* m = (r < ncx) ? mvc : mvl;
                const float4 sh = ld4(m + c), sc = ld4(m + 1024 + c);
                *(uint2*)(hb + (size_t)r * 1024 + c) = make_uint2(pack2bf(y.x * (1.f + sc.x) + sh.x, y.y * (1.f + sc.y) + sh.y), pack2bf(y.z * (1.f + sc.z) + sh.z, y.w * (1.f + sc.w) + sh.w));
            }
        }
    }
}
DEV void phase_h1l(const Params& p) {
    const float* modv1 = (const float*)(p.ws + OFF_MODV) + 3 * 3072;
    bf16_t* H1 = (bf16_t*)(p.ws + OFF_H1B);
    const size_t gt = (size_t)blockIdx.x * NTHR + opaque_tid(), gn = (size_t)gridDim.x * NTHR;
    for (size_t i = gt; i < (size_t)NB * NL * 128; i += gn) {
        const size_t r = i >> 7; const int k = (int)(i & 127) * 8;
        const float* m = modv1 + (r >= (size_t)NL ? 1 : 0) * 3072;
        const float4 x0 = ld4(p.out + r * DM + k), x1 = ld4(p.out + r * DM + k + 4);
        const float4 s0 = ld4(m + k), s1 = ld4(m + k + 4), c0 = ld4(m + 1024 + k), c1 = ld4(m + 1024 + k + 4);
        *(uint4*)(H1 + r * DM + k) = make_uint4(pack2bf(x0.x * (1.f + c0.x) + s0.x, x0.y * (1.f + c0.y) + s0.y), pack2bf(x0.z * (1.f + c0.z) + s0.z, x0.w * (1.f + c0.w) + s0.w),
                                                pack2bf(x1.x * (1.f + c1.x) + s1.x, x1.y * (1.f + c1.y) + s1.y), pack2bf(x1.z * (1.f + c1.z) + s1.z, x1.w * (1.f + c1.w) + s1.w));
    }
}

DEV void zero_f4(float* ptr, size_t nfloat) {
    const size_t n4 = nfloat / 4;
    for (size_t i = (size_t)blockIdx.x * NTHR + opaque_tid(); i < n4; i += (size_t)gridDim.x * NTHR) ((float4*)ptr)[i] = make_float4(0.f, 0.f, 0.f, 0.f);
}

DEV void chain_ids(int& chain, int& sub) {
    const int bid = blockIdx.x, xcd = bid & 7, idx = bid >> 3;
    chain = xcd * 2 + (idx >> 4); sub = idx & 15;
}

DEV void phase_conv1(const Params& p, float* sm) {
    const bf16_t* XM = (const bf16_t*)(p.ws + OFF_XM);
    bf16_t* XC = (bf16_t*)(p.ws + OFF_XC);
    float* G16P = (float*)(p.ws + OFF_G16P);
    const bf16_t* WFT = (const bf16_t*)(p.ws + OFF_WFT);
    const float* cw = p.in[31]; const float* cbias = p.in[32];
    bf16_t* imgC = (bf16_t*)sm;
    bf16_t* imgM = imgC + 64 * 264;
    float* red = (float*)(imgM + 64 * 264);
    float* cwl = red + 1024;
    const int tid = opaque_tid(), lane = tid & 63, wave = tid >> 6, t = tid >> 3, cg = tid & 7;
    for (int u = blockIdx.x; u < NB * NCH * 4; u += gridDim.x) {
        const int ci = u >> 2, q = u & 3, b = ci / NCH, c = ci % NCH, s = c * 64 + t;
        const size_t rowbase = (size_t)b * TB;
        int nrow[9]; unsigned vmask = 0u;
#pragma unroll
        for (int i = 0; i < 3; ++i)
#pragma unroll
            for (int j = 0; j < 3; ++j) {
                int ns = -1;
                if (s < NCX) { const int w2 = s + j - 1; if (i == 1 && w2 >= 0 && w2 < NCX) ns = w2; }
                else { const int n = s - NCX, rr = (n >> 6) + i - 1, w2 = (n & 63) + j - 1; if (rr >= 0 && rr < 128 && w2 >= 0 && w2 < 64) ns = NCX + rr * 64 + w2; }
                nrow[i * 3 + j] = ns >= 0 ? ns : s; vmask |= (ns >= 0 ? 1u : 0u) << (i * 3 + j);
            }
        const int tt = wave & 3, part = wave >> 2;
        f32x4 acc = (f32x4){0.f, 0.f, 0.f, 0.f};
        uint4 xn[9];
#pragma unroll
        for (int tap = 0; tap < 9; ++tap) xn[tap] = *(const uint4*)(XM + (rowbase + nrow[tap]) * 2048 + q * 512 + cg * 8);
#pragma unroll 1
        for (int half = 0; half < 2; ++half) {
            __syncthreads();
            for (int i = tid; i < 640; i += NTHR) { const int tp = i >> 6, c4 = (i & 63) * 4; st4(cwl + tp * 256 + c4, ld4((tp < 9 ? cw + tp * 2048 : cbias) + q * 512 + half * 256 + c4)); }
            __syncthreads();
#pragma unroll 1
            for (int it = 0; it < 4; ++it) {
                const int cl = it * 64 + cg * 8, c0 = q * 512 + half * 256 + cl;
                uint4 xc9[9];
#pragma unroll
                for (int tap = 0; tap < 9; ++tap) xc9[tap] = xn[tap];
                { const int gn = half * 4 + it + 1, c0n = q * 512 + (gn < 8 ? gn : 7) * 64 + cg * 8;
#pragma unroll
                  for (int tap = 0; tap < 9; ++tap) xn[tap] = *(const uint4*)(XM + (rowbase + nrow[tap]) * 2048 + c0n); }
                float a8[8];
                { const float4 b0 = ld4(cwl + 9 * 256 + cl), b1 = ld4(cwl + 9 * 256 + cl + 4); a8[0] = b0.x; a8[1] = b0.y; a8[2] = b0.z; a8[3] = b0.w; a8[4] = b1.x; a8[5] = b1.y; a8[6] = b1.z; a8[7] = b1.w; }
#pragma unroll
                for (int tap = 0; tap < 9; ++tap) {
                    const unsigned mk = ((vmask >> tap) & 1u) ? 0xffffffffu : 0u;
                    const uint4 xv = make_uint4(xc9[tap].x & mk, xc9[tap].y & mk, xc9[tap].z & mk, xc9[tap].w & mk);
                    float x8[8]; unpack8(xv, x8);
                    const float4 w0 = ld4(cwl + tap * 256 + cl), w1 = ld4(cwl + tap * 256 + cl + 4);
                    a8[0] += x8[0] * w0.x; a8[1] += x8[1] * w0.y; a8[2] += x8[2] * w0.z; a8[3] += x8[3] * w0.w;
                    a8[4] += x8[4] * w1.x; a8[5] += x8[5] * w1.y; a8[6] += x8[6] * w1.z; a8[7] += x8[7] * w1.w;
                }
#pragma unroll
                for (int i = 0; i < 8; ++i) a8[i] = silu_f(a8[i]);
                const uint4 xcv = pack8(a8);
                *(uint4*)(XC + (rowbase + s) * 2048 + c0) = xcv;
                *(uint4*)(imgC + t * 264 + cl) = xcv;
                *(uint4*)(imgM + t * 264 + cl) = xc9[4];
            }
            __syncthreads();
            {
                const bf16_t* img = part ? imgM : imgC;
                const bf16_t* wrow = WFT + (size_t)(lane & 15) * 4096 + part * 2048 + q * 512 + half * 256 + (lane >> 4) * 8;
#pragma unroll
                for (int ks = 0; ks < 8; ++ks) acc = __builtin_amdgcn_mfma_f32_16x16x32_bf16(row_frag(img, 264, tt * 16, ks * 32, lane), *(const bf16x8*)(wrow + ks * 32), acc, 0, 0, 0);
            }
        }
        if (part == 1) {
#pragma unroll
            for (int r = 0; r < 4; ++r) red[(tt * 16 + (lane >> 4) * 4 + r) * 16 + (lane & 15)] = acc[r];
        }
        __syncthreads();
        if (part == 0) {
#pragma unroll
            for (int r = 0; r < 4; ++r) {
                const int tk = tt * 16 + (lane >> 4) * 4 + r;
                G16P[(((size_t)rowbase + c * 64 + tk) * 16 + (lane & 15)) * 4 + q] = acc[r] + red[tk * 16 + (lane & 15)];
            }
        }
    }
}

struct GateRaw { float4 a, f; };
DEV GateRaw gate_load(const Params& p, size_t row, int dir, int h) {
    const float* G16P = (const float*)(p.ws + OFF_G16P);
    GateRaw g; g.a = ld4(G16P + (row * 16 + dir * 8 + h) * 4); g.f = ld4(G16P + (row * 16 + dir * 8 + 4 + h) * 4);
    return g;
}
DEV void gate_fin(const GateRaw& g, float bi, float bf, float& gi, float& lf) {
    gi = (g.a.x + g.a.y) + (g.a.z + g.a.w) + bi;
    lf = logsig_f((g.f.x + g.f.y) + (g.f.z + g.f.w) + bf);
}
DEV void gate_pair(const Params& p, size_t row, int dir, int h, float& gi, float& lf) {
    const GateRaw g = gate_load(p, row, dir, h);
    gate_fin(g, p.in[dir ? 41 : 37][h], p.in[dir ? 43 : 39][h], gi, lf);
}

DEV void phase_x1(const Params& p, float* sm) {
    int chain, sub; chain_ids(chain, sub);
    const int b = chain >> 3, h = (chain >> 1) & 3, dir = chain & 1;
    const bf16_t* XC = (const bf16_t*)(p.ws + OFF_XC);
    float* GSC = (float*)(p.ws + OFF_GSC); float* CSC = (float*)(p.ws + OFF_CSC); float* NBUF = (float*)(p.ws + OFF_NBUF);
    const float* gtab = (const float*)(p.ws + OFF_GTAB);
    bf16_t* SMAT = (bf16_t*)(p.ws + OFF_SMAT);
    const int tid = opaque_tid(), lane = tid & 63, wave = tid >> 6;
    float* sTot = sm; float* sRef = sm + 132; float* sM0 = sm + 264; float* sBeta = sm + 400;
    const float bias_i = p.in[dir ? 41 : 37][h], bias_f = p.in[dir ? 43 : 39][h];
    {
        GateRaw gn = gate_load(p, (size_t)b * TB + wave * 64 + lane, dir, h);
        for (int c = wave; c < NCH; c += NWV) {
            const GateRaw gc = gn;
            const int cn = (c + NWV < NCH) ? c + NWV : c;
            gn = gate_load(p, (size_t)b * TB + cn * 64 + lane, dir, h);
            float gi, lf; gate_fin(gc, bias_i, bias_f, gi, lf);
            const float bc = wave_scan_add(lf, lane, dir);
            const float ref = wave_max(gi - bc), tot = wave_sum(lf);
            if (lane == 0) { sTot[c] = tot; sRef[c] = ref; }
        }
    }
    __syncthreads();
    if (tid == 0) {
        float m0 = -INFINITY;
        for (int step = 0; step < NCH; ++step) {
            const int c = chunk_at(dir, step);
            sM0[c] = m0;
            const float mx = fmaxf(m0, sRef[c]);
            if (sub == 0) { CSC[(chain * NCH + c) * 2] = fexp(m0 - mx); CSC[(chain * NCH + c) * 2 + 1] = fexp(sRef[c] - mx); }
            m0 = sTot[c] + mx;
        }
    }
    __syncthreads();
    for (int k = wave; sub + 16 * k < NCH; k += NWV) {
        const int c = sub + 16 * k;
        const size_t row = (size_t)b * TB + c * 64 + lane;
        float gi, lf; gate_fin(gate_load(p, row, dir, h), bias_i, bias_f, gi, lf);
        const float bc = wave_scan_add(lf, lane, dir);
        const float a = gi - bc;
        const float amax = wave_scan_max(a, lane, dir);
        const float ref = sRef[c], m0 = sM0[c];
        const float mmax = fmaxf(amax, m0);
        const float mt = bc + mmax;
        const float alpha = fexp(ref - mmax), beta = fexp(a - ref), gg = fexp(m0 - mmax), em = fexp(-mt);
        st4(GSC + ((size_t)chain * TB + c * 64 + lane) * 4, make_float4(alpha, beta, gg, em));
        sBeta[k * 64 + lane] = beta;
    }
    __syncthreads();
    {
        float* part = sm + 1024;
        const int sg = tid >> 6, j8 = (tid & 63) * 8;
        uint4 xn[8];
        { const bf16_t* xp = XC + ((size_t)b * TB + sub * 64 + sg * 8) * 2048 + h * 512 + j8;
#pragma unroll
          for (int s = 0; s < 8; ++s) xn[s] = *(const uint4*)(xp + (size_t)s * 2048); }
        for (int k = 0; sub + 16 * k < NCH; ++k) {
            const int c = sub + 16 * k;
            uint4 xcur[8];
#pragma unroll
            for (int s = 0; s < 8; ++s) xcur[s] = xn[s];
            { const int cn = (c + 16 < NCH) ? c + 16 : c; const bf16_t* xp = XC + ((size_t)b * TB + cn * 64 + sg * 8) * 2048 + h * 512 + j8;
#pragma unroll
              for (int s = 0; s < 8; ++s) xn[s] = *(const uint4*)(xp + (size_t)s * 2048); }
            float acc[8];
#pragma unroll
            for (int i = 0; i < 8; ++i) acc[i] = 0.f;
#pragma unroll
            for (int s = 0; s < 8; ++s) {
                float f[8]; unpack8(xcur[s], f);
                const float be = sBeta[k * 64 + sg * 8 + s];
#pragma unroll
                for (int i = 0; i < 8; ++i) acc[i] += be * f[i];
            }
            __syncthreads();
            st4(part + sg * 512 + j8, make_float4(acc[0], acc[1], acc[2], acc[3])); st4(part + sg * 512 + j8 + 4, make_float4(acc[4], acc[5], acc[6], acc[7]));
            __syncthreads();
            float tot = 0.f;
#pragma unroll
            for (int q = 0; q < 8; ++q) tot += part[q * 512 + tid];
            NBUF[((size_t)chain * NCH + c) * 512 + tid] = tot;
        }
    }
    bf16_t* XCs = (bf16_t*)sm;
    bf16_t* Qs = XCs + 64 * 520;
    for (int u = blockIdx.x; u < NB * 4 * NCH; u += gridDim.x) {
        const int bh = u / NCH, c = u % NCH, ub = bh >> 2, uh = bh & 3;
        __syncthreads();
        float4 gq[2][4];
#pragma unroll
        for (int bb = 0; bb < 2; ++bb) { const float* G = gtab + (size_t)(uh * 128 + (tid & 63) * 2 + bb) * 16; gq[bb][0] = ld4(G); gq[bb][1] = ld4(G + 4); gq[bb][2] = ld4(G + 8); gq[bb][3] = ld4(G + 12); }
        uint4 xr[8];
#pragma unroll
        for (int i = 0; i < 8; ++i) { const int pp = tid + 512 * i, row = pp >> 6, c16 = pp & 63; xr[i] = *(const uint4*)(XC + ((size_t)ub * TB + c * 64 + row) * 2048 + uh * 512 + c16 * 8); }
#pragma unroll
        for (int i = 0; i < 8; ++i) {
            const int pp = tid + 512 * i, row = pp >> 6, c16 = pp & 63;
            const uint4 xv = xr[i];
            float f[8]; unpack8(xv, f);
            float q[8];
#pragma unroll
            for (int bb = 0; bb < 2; ++bb) {
                const float4 g0 = gq[bb][0], g1 = gq[bb][1], g2 = gq[bb][2], g3 = gq[bb][3];
                q[bb * 4 + 0] = f[bb * 4] * g0.x + f[bb * 4 + 1] * g1.x + f[bb * 4 + 2] * g2.x + f[bb * 4 + 3] * g3.x;
                q[bb * 4 + 1] = f[bb * 4] * g0.y + f[bb * 4 + 1] * g1.y + f[bb * 4 + 2] * g2.y + f[bb * 4 + 3] * g3.y;
                q[bb * 4 + 2] = f[bb * 4] * g0.z + f[bb * 4 + 1] * g1.z + f[bb * 4 + 2] * g2.z + f[bb * 4 + 3] * g3.z;
                q[bb * 4 + 3] = f[bb * 4] * g0.w + f[bb * 4 + 1] * g1.w + f[bb * 4 + 2] * g2.w + f[bb * 4 + 3] * g3.w;
            }
            *(uint4*)(XCs + row * 520 + c16 * 8) = xv;
            *(uint4*)(Qs + row * 520 + c16 * 8) = make_uint4(pack2bf(q[0], q[1]), pack2bf(q[2], q[3]), pack2bf(q[4], q[5]), pack2bf(q[6], q[7]));
        }
        __syncthreads();
        const int st = wave & 3, tt0 = (wave >> 2) * 2;
        f32x4 a0 = (f32x4){0.f, 0.f, 0.f, 0.f}, a1 = a0;
        const bf16_t* ap = XCs + (st * 16 + (lane & 15)) * 520 + (lane >> 4) * 8;
        const bf16_t* bp0 = Qs + (tt0 * 16 + (lane & 15)) * 520 + (lane >> 4) * 8;
        const bf16_t* bp1 = bp0 + 16 * 520;
#pragma unroll
        for (int ks = 0; ks < 16; ++ks) {
            const bf16x8 af = *(const bf16x8*)(ap + ks * 32);
            a0 = __builtin_amdgcn_mfma_f32_16x16x32_bf16(af, *(const bf16x8*)(bp0 + ks * 32), a0, 0, 0, 0);
            a1 = __builtin_amdgcn_mfma_f32_16x16x32_bf16(af, *(const bf16x8*)(bp1 + ks * 32), a1, 0, 0, 0);
        }
        bf16_t* sp = SMAT + (size_t)u * 4096 + (size_t)(tt0 * 16 + (lane & 15)) * 64 + st * 16 + (lane >> 4) * 4;
        *(uint2*)sp = make_uint2(pack2bf(a0[0], a0[1]), pack2bf(a0[2], a0[3]));
        *(uint2*)(sp + 16 * 64) = make_uint2(pack2bf(a1[0], a1[1]), pack2bf(a1[2], a1[3]));
    }
}

DEV void phase_x2(const Params& p, float* sm) {
    int chain, sub; chain_ids(chain, sub);
    const int b = chain >> 3, h = (chain >> 1) & 3, dir = chain & 1;
    const bf16_t* XC = (const bf16_t*)(p.ws + OFF_XC);
    float* GSC = (float*)(p.ws + OFF_GSC); const float* CSC = (const float*)(p.ws + OFF_CSC); const float* NBUF = (const float*)(p.ws + OFF_NBUF);
    const float* gtab = (const float*)(p.ws + OFF_GTAB);
    const bf16_t* SMAT = (const bf16_t*)(p.ws + OFF_SMAT);
    const int tid = opaque_tid();
    float* sD0 = sm; float* sCf = sm + 132; float* sN0 = sm + 264; float* sN2 = sN0 + 9 * 512;
    for (int i = tid; i < NCH; i += NTHR) { sD0[i] = CSC[(chain * NCH + i) * 2]; sCf[i] = CSC[(chain * NCH + i) * 2 + 1]; }
    __syncthreads();
    float* sBeta = sN2 + 9 * 512;
    for (int i = tid; i < 9 * 64; i += NTHR) { const int k = i >> 6, c = sub + 16 * k; if (c < NCH) sBeta[i] = GSC[((size_t)chain * TB + c * 64 + (i & 63)) * 4 + 1]; }
    if (tid < 128) {
        constexpr int NBT = 12;
        float4 n = make_float4(0.f, 0.f, 0.f, 0.f), nx[NBT];
        const float* nb = NBUF + (size_t)chain * NCH * 512 + tid * 4;
#pragma unroll
        for (int j = 0; j < NBT; ++j) nx[j] = ld4(nb + (size_t)chunk_at(dir, j) * 512);
#pragma unroll 1
        for (int step0 = 0; step0 < NCH; step0 += NBT) {
            float4 cu[NBT];
#pragma unroll
            for (int j = 0; j < NBT; ++j) cu[j] = nx[j];
#pragma unroll
            for (int j = 0; j < NBT; ++j) { const int sn = step0 + NBT + j; nx[j] = ld4(nb + (size_t)chunk_at(dir, sn < NCH ? sn : NCH - 1) * 512); }
            __builtin_amdgcn_sched_barrier(0);
#pragma unroll
            for (int j = 0; j < NBT; ++j) {
                const int c = chunk_at(dir, step0 + j);
                if ((c & 15) == sub) st4(sN0 + (c >> 4) * 512 + tid * 4, n);
                const float d = sD0[c], cf = sCf[c];
                n = make_float4(d * n.x + cf * cu[j].x, d * n.y + cf * cu[j].y, d * n.z + cf * cu[j].z, d * n.w + cf * cu[j].w);
            }
        }
    }
    __syncthreads();
    {
        const int blk = tid >> 2, cp = tid & 3;
        const float4 g = ld4(gtab + (size_t)(h * 128 + blk) * 16 + cp * 4);
        for (int k = 0; sub + 16 * k < NCH; ++k) {
            const float* n0 = sN0 + k * 512 + blk * 4;
            sN2[k * 512 + tid] = g.x * n0[0] + g.y * n0[1] + g.z * n0[2] + g.w * n0[3];
        }
    }
    __syncthreads();
    const int t = tid >> 3, part = tid & 7;
    for (int k = 0; sub + 16 * k < NCH; ++k) {
        const int c = sub + 16 * k;
        const size_t row = (size_t)b * TB + c * 64 + t;
        float dint = 0.f;
        {
            const bf16_t* xp = XC + row * 2048 + h * 512 + part * 64;
            const float* n2 = sN2 + k * 512 + part * 64;
#pragma unroll
            for (int i = 0; i < 8; ++i) {
                float f[8]; unpack8(*(const uint4*)(xp + i * 8), f);
                const float4 na = ld4(n2 + i * 8), nb2 = ld4(n2 + i * 8 + 4);
                dint += f[0] * na.x + f[1] * na.y + f[2] * na.z + f[3] * na.w + f[4] * nb2.x + f[5] * nb2.y + f[6] * nb2.z + f[7] * nb2.w;
            }
        }
        float di = 0.f;
        {
            float f[8]; unpack8(*(const uint4*)(SMAT + ((size_t)((b * 4 + h) * NCH + c)) * 4096 + t * 64 + part * 8), f);
#pragma unroll
            for (int e = 0; e < 8; ++e) {
                const int s = part * 8 + e;
                const float beta = sBeta[k * 64 + s];
                const bool keep = dir ? (s >= t) : (s <= t);
                di += keep ? f[e] * beta : 0.f;
            }
        }
        dint += __shfl_xor(dint, 1, 64); dint += __shfl_xor(dint, 2, 64); dint += __shfl_xor(dint, 4, 64);
        di += __shfl_xor(di, 1, 64); di += __shfl_xor(di, 2, 64); di += __shfl_xor(di, 4, 64);
        if (part == 0) {
            float* gp = GSC + ((size_t)chain * TB + c * 64 + t) * 4;
            const float4 g4 = ld4(gp);
            const float den = g4.x * di + g4.z * dint;
            gp[3] = 1.f / fmaxf(fabsf(den), g4.w);
        }
    }
}

#define MLSTM_PREFETCH(step_) do { \
    const int c_ = chunk_at(dir, (step_)); const size_t rb_ = (size_t)b * TB + (size_t)c_ * 64; \
    { const bf16_t* xb_ = XC + (rb_ + (tid >> 6)) * 2048 + h * 512 + (tid & 63) * 8; \
      rx0 = *(const uint4*)(xb_); rx1 = *(const uint4*)(xb_ + 8 * 2048); rx2 = *(const uint4*)(xb_ + 16 * 2048); rx3 = *(const uint4*)(xb_ + 24 * 2048); \
      rx4 = *(const uint4*)(xb_ + 32 * 2048); rx5 = *(const uint4*)(xb_ + 40 * 2048); rx6 = *(const uint4*)(xb_ + 48 * 2048); rx7 = *(const uint4*)(xb_ + 56 * 2048); } \
    rxm = *(const uint2*)(XM + (rb_ + ps) * 2048 + ch0 + pvb * 4); \
    rs = *(const uint4*)(SMAT + ((size_t)((b * 4 + h) * NCH + c_)) * 4096 + ps * 64 + pvb * 8); \
    rbeta = GSC[((size_t)chain * TB + c_ * 64 + ps) * 4 + 1]; \
    if (tid < 64) rsc = ld4(GSC + ((size_t)chain * TB + c_ * 64 + tid) * 4); \
    rd0 = CSC[(chain * NCH + c_) * 2]; rcf = CSC[(chain * NCH + c_) * 2 + 1]; } while (0)

DEV void phase_mlstm(const Params& p, float* sm) {
    int chain, sub; chain_ids(chain, sub);
    const int b = chain >> 3, h = (chain >> 1) & 3, dir = chain & 1;
    const bf16_t* XM = (const bf16_t*)(p.ws + OFF_XM);
    const bf16_t* XC = (const bf16_t*)(p.ws + OFF_XC);
    const bf16_t* SMAT = (const bf16_t*)(p.ws + OFF_SMAT);
    const float* GSC = (const float*)(p.ws + OFF_GSC); const float* CSC = (const float*)(p.ws + OFF_CSC);
    const float* gtab = (const float*)(p.ws + OFF_GTAB);
    bf16_t* H = (bf16_t*)(p.ws + OFF_H);
    const float* wv = p.in[35];
    char* smc = (char*)sm;
    bf16_t* XCs = (bf16_t*)smc;
    bf16_t* Cs = (bf16_t*)(smc + 66560);
    bf16_t* Vb = (bf16_t*)(smc + 66560 + 33280);
    bf16_t* Vw = Vb + 32 * 72;
    bf16_t* Sm = Vw + 32 * 72;
    float* Gs = (float*)(smc + 66560 + 33280 + 2 * 4608 + 9216);
    float* sc = Gs + 2048;
    const int tid = opaque_tid(), lane = tid & 63, wave = tid >> 6;
    for (int i = tid; i < 32 * 520 / 2; i += NTHR) ((unsigned*)Cs)[i] = 0u;
    for (int i = tid; i < 2048; i += NTHR) Gs[i] = gtab[h * 2048 + i];
    const int ps = tid >> 3, pvb = tid & 7;
    const int ch0 = h * 512 + sub * 32;
    float wvr[16];
#pragma unroll
    for (int i = 0; i < 16; ++i) wvr[i] = wv[(size_t)((ch0 >> 2) + pvb) * 16 + i];
    f32x4 accS[4][2];
#pragma unroll
    for (int i = 0; i < 4; ++i) { accS[i][0] = (f32x4){0.f, 0.f, 0.f, 0.f}; accS[i][1] = (f32x4){0.f, 0.f, 0.f, 0.f}; }
    uint4 rx0, rx1, rx2, rx3, rx4, rx5, rx6, rx7; uint2 rxm; uint4 rs; float rbeta; float4 rsc = make_float4(0.f, 0.f, 0.f, 0.f); float rd0, rcf;
    MLSTM_PREFETCH(0);
    __syncthreads();
#pragma unroll 1
    for (int step = 0; step < NCH; ++step) {
        const int c = chunk_at(dir, step);
        const float d0 = rd0, cf = rcf;
        {
            bf16_t* xd = XCs + (tid >> 6) * 520 + (tid & 63) * 8;
            *(uint4*)(xd) = rx0; *(uint4*)(xd + 8 * 520) = rx1; *(uint4*)(xd + 16 * 520) = rx2; *(uint4*)(xd + 24 * 520) = rx3;
            *(uint4*)(xd + 32 * 520) = rx4; *(uint4*)(xd + 40 * 520) = rx5; *(uint4*)(xd + 48 * 520) = rx6; *(uint4*)(xd + 56 * 520) = rx7;
        }
        {
            const float x0 = bflo(rxm.x), x1 = bfhi(rxm.x), x2 = bflo(rxm.y), x3 = bfhi(rxm.y);
#pragma unroll
            for (int d = 0; d < 4; ++d) {
                const float v = (x0 * wvr[d] + x1 * wvr[4 + d] + x2 * wvr[8 + d] + x3 * wvr[12 + d]) * rbeta;
                Vb[(pvb * 4 + d) * 72 + ps] = __builtin_bit_cast(unsigned short, (__bf16)v);
                Vw[(pvb * 4 + d) * 72 + ps] = __builtin_bit_cast(unsigned short, (__bf16)(v * cf));
            }
        }
        {
#define SMASK(q_) (((dir ? (pvb * 8 + 2 * (q_) >= ps) : (pvb * 8 + 2 * (q_) <= ps)) ? 0x0000ffffu : 0u) | ((dir ? (pvb * 8 + 2 * (q_) + 1 >= ps) : (pvb * 8 + 2 * (q_) + 1 <= ps)) ? 0xffff0000u : 0u))
            *(uint4*)(Sm + ps * 72 + pvb * 8) = make_uint4(rs.x & SMASK(0), rs.y & SMASK(1), rs.z & SMASK(2), rs.w & SMASK(3));
#undef SMASK
        }
        if (tid < 64) st4(sc + tid * 4, rsc);
        { const int nstep = (step + 1 < NCH) ? step + 1 : step; MLSTM_PREFETCH(nstep); }
        __syncthreads();
        {
            const int vt = wave & 1, tt = wave >> 1;
            f32x4 ao = (f32x4){0.f, 0.f, 0.f, 0.f}, ai = ao, ao1 = ao, ao2 = ao, ao3 = ao;
            const bf16_t* ap = Cs + (vt * 16 + (lane & 15)) * 520 + (lane >> 4) * 8;
            const bf16_t* bp = XCs + (tt * 16 + (lane & 15)) * 520 + (lane >> 4) * 8;
#pragma unroll
            for (int ks = 0; ks < 16; ks += 4) {
                ao = __builtin_amdgcn_mfma_f32_16x16x32_bf16(*(const bf16x8*)(ap + ks * 32), *(const bf16x8*)(bp + ks * 32), ao, 0, 0, 0);
                ao1 = __builtin_amdgcn_mfma_f32_16x16x32_bf16(*(const bf16x8*)(ap + (ks + 1) * 32), *(const bf16x8*)(bp + (ks + 1) * 32), ao1, 0, 0, 0);
                ao2 = __builtin_amdgcn_mfma_f32_16x16x32_bf16(*(const bf16x8*)(ap + (ks + 2) * 32), *(const bf16x8*)(bp + (ks + 2) * 32), ao2, 0, 0, 0);
                ao3 = __builtin_amdgcn_mfma_f32_16x16x32_bf16(*(const bf16x8*)(ap + (ks + 3) * 32), *(const bf16x8*)(bp + (ks + 3) * 32), ao3, 0, 0, 0);
            }
            ao = (ao + ao1) + (ao2 + ao3);
            const bf16_t* ap2 = Vb + (vt * 16 + (lane & 15)) * 72 + (lane >> 4) * 8;
            const bf16_t* bp2 = Sm + (tt * 16 + (lane & 15)) * 72 + (lane >> 4) * 8;
#pragma unroll
            for (int ks = 0; ks < 2; ++ks) ai = __builtin_amdgcn_mfma_f32_16x16x32_bf16(*(const bf16x8*)(ap2 + ks * 32), *(const bf16x8*)(bp2 + ks * 32), ai, 0, 0, 0);
            if (c >= 4) {
                const int t = tt * 16 + (lane & 15);
                const float4 s4 = ld4(sc + t * 4);
                const float h0 = (s4.x * ai[0] + s4.z * ao[0]) * s4.w, h1 = (s4.x * ai[1] + s4.z * ao[1]) * s4.w;
                const float h2 = (s4.x * ai[2] + s4.z * ao[2]) * s4.w, h3 = (s4.x * ai[3] + s4.z * ao[3]) * s4.w;
                bf16_t* hp = H + ((size_t)b * NL + (size_t)c * 64 + t - NCX) * 2048 + ch0 + vt * 16 + (lane >> 4) * 4;
                const unsigned u0 = pack2bf(h0, h1), u1 = pack2bf(h2, h3);
                __builtin_amdgcn_global_atomic_fadd_v2bf16((__attribute__((address_space(1))) s16x2*)hp, __builtin_bit_cast(s16x2, u0));
                __builtin_amdgcn_global_atomic_fadd_v2bf16((__attribute__((address_space(1))) s16x2*)(hp + 2), __builtin_bit_cast(s16x2, u1));
            }
        }
#pragma unroll
        for (int jt = 0; jt < 4; ++jt) { accS[jt][0] *= d0; accS[jt][1] *= d0; }
#pragma unroll
        for (int ks = 0; ks < 2; ++ks) {
            const bf16x8 b0 = *(const bf16x8*)(Vw + (lane & 15) * 72 + ks * 32 + (lane >> 4) * 8);
            const bf16x8 b1 = *(const bf16x8*)(Vw + (16 + (lane & 15)) * 72 + ks * 32 + (lane >> 4) * 8);
            const int row0 = ks * 32 + (lane >> 4) * 8 + ((lane & 15) >> 2);
#pragma unroll
            for (int jt = 0; jt < 4; ++jt) {
                const int col = wave * 64 + jt * 16 + (lane & 3) * 4;
                const s16x4 lo = __builtin_amdgcn_ds_read_tr16_b64_v4i16((__attribute__((address_space(3))) s16x4*)(XCs + row0 * 520 + col));
                const s16x4 hi = __builtin_amdgcn_ds_read_tr16_b64_v4i16((__attribute__((address_space(3))) s16x4*)(XCs + (row0 + 4) * 520 + col));
                const bf16x8 af = (bf16x8){lo[0], lo[1], lo[2], lo[3], hi[0], hi[1], hi[2], hi[3]};
                accS[jt][0] = __builtin_amdgcn_mfma_f32_16x16x32_bf16(af, b0, accS[jt][0], 0, 0, 0);
                accS[jt][1] = __builtin_amdgcn_mfma_f32_16x16x32_bf16(af, b1, accS[jt][1], 0, 0, 0);
            }
        }
        __syncthreads();
#pragma unroll
        for (int jt = 0; jt < 4; ++jt) {
            const int blk = wave * 16 + jt * 4 + (lane >> 4);
            const float4 g0 = ld4(Gs + blk * 16), g1 = ld4(Gs + blk * 16 + 4), g2 = ld4(Gs + blk * 16 + 8), g3 = ld4(Gs + blk * 16 + 12);
#pragma unroll
            for (int v2 = 0; v2 < 2; ++v2) {
                const f32x4 a = accS[jt][v2];
                const float o0 = g0.x * a[0] + g0.y * a[1] + g0.z * a[2] + g0.w * a[3];
                const float o1 = g1.x * a[0] + g1.y * a[1] + g1.z * a[2] + g1.w * a[3];
                const float o2 = g2.x * a[0] + g2.y * a[1] + g2.z * a[2] + g2.w * a[3];
                const float o3 = g3.x * a[0] + g3.y * a[1] + g3.z * a[2] + g3.w * a[3];
                *(uint2*)(Cs + (v2 * 16 + (lane & 15)) * 520 + blk * 4) = make_uint2(pack2bf(o0, o1), pack2bf(o2, o3));
            }
        }
    }
}

DEV void phase_finish1(const Params& p) {
    bf16_t* H = (bf16_t*)(p.ws + OFF_H);
    const bf16_t* XC = (const bf16_t*)(p.ws + OFF_XC);
    const bf16_t* Z = (const bf16_t*)(p.ws + OFF_XM);
    const float* ng = p.in[44]; const float* skip = p.in[45];
    const int tid_ = opaque_tid(); const int lane = tid_ & 63, gw = blockIdx.x * NWV + (tid_ >> 6), ngw = gridDim.x * NWV;
    for (int it = gw; it < NB * NL * 4; it += ngw) {
        const int r = it >> 2, h = it & 3, b = r >= NL ? 1 : 0, nn = r - b * NL;
        const int c0 = h * 512 + lane * 8;
        bf16_t* hp = H + (size_t)r * 2048 + c0;
        float v[8]; unpack8(*(const uint4*)hp, v);
        float sum = 0.f;
#pragma unroll
        for (int j = 0; j < 8; ++j) sum += v[j];
        const float mean = wave_sum(sum) * (1.f / 512.f);
        float sq = 0.f;
#pragma unroll
        for (int j = 0; j < 8; ++j) { v[j] -= mean; sq += v[j] * v[j]; }
        const float rstd = rsqrtf(wave_sum(sq) * (1.f / 512.f) + 1e-5f);
        float xc[8], z[8];
        unpack8(*(const uint4*)(XC + ((size_t)b * TB + NCX + nn) * 2048 + c0), xc);
        unpack8(*(const uint4*)(Z + (size_t)r * 2048 + c0), z);
        float o[8];
#pragma unroll
        for (int j = 0; j < 8; ++j) o[j] = (v[j] * rstd * ng[c0 + j] + skip[c0 + j] * xc[j]) * silu_f(z[j]);
        *(uint4*)hp = make_uint4(pack2bf(o[0], o[1]), pack2bf(o[2], o[3]), pack2bf(o[4], o[5]), pack2bf(o[6], o[7]));
    }
}

__global__ void __launch_bounds__(NTHR) fwd_kernel(Params p) {
    extern __shared__ __attribute__((aligned(16))) float sm[];
    volatile LAS unsigned* xst = (volatile LAS unsigned*)((LAS char*)sm + (LDS_BYTES - 16));
    if (threadIdx.x == 0) { xst[0] = 0u; xst[1] = 0u; }
    __syncthreads();
    const XcdBarrier xbar = xcd_barrier_post((unsigned*)(p.ws + OFF_BAR), xst);
    const int tid = opaque_tid(), lane = tid & 63, wave = tid >> 6;
    float* modv = (float*)(p.ws + OFF_MODV);
    float* X1C = (float*)(p.ws + OFF_X1C);

    phase_mod(p, sm);
    phase_tables(p);
    transpose_convert(p.in[8], 1024, EIN, 4096, (bf16_t*)(p.ws + OFF_WT0), sm);
    transpose_convert(p.in[29], 1024, 4096, 4096, (bf16_t*)(p.ws + OFF_WT1), sm);
    transpose_convert(p.in[9], 1024, 1024, 1024, (bf16_t*)(p.ws + OFF_WT2), sm);
    transpose_convert(p.in[30], 2048, 1024, 1024, (bf16_t*)(p.ws + OFF_WT3), sm);
    xcd_barrier(xbar);

#pragma unroll 1
    for (int b = 0; b < NB; ++b) {
        if (b == 0) { phase_h0(p, 0); xcd_barrier(xbar); }
        run_gemm((const bf16_t*)(p.ws + OFF_YC), (const bf16_t*)(p.ws + OFF_WT0), TB, 4096, DM, EpBf16{(bf16_t*)(p.ws + OFF_P0), EIN, EIN}, sm);
        xcd_barrier(xbar);
        {
            const int x = blockIdx.x & 7, q0 = blockIdx.x >> 3;
            R1Raw R;
            r1_consts(p, x, q0 & 1, sm);
            r1_load(p, x, q0 & 1, q0 >> 1, R);
            for (int q = q0; q < 3 * NCH; q += 32) {
                if (q < 2 * NCH) rwkv1_unit(p, x, q & 1, q >> 1, sm, R, (q + 32 < 2 * NCH) ? ((q + 32) >> 1) : -1);
                else { const int q2 = q - 2 * NCH; gla1_unit(p, x >> 1, q2 & 1, (NCH / 2) * (x & 1) + (q2 >> 1), sm); }
            }
        }
        xcd_barrier(xbar);
        if (blockIdx.x < 128) gla2_unit(p, blockIdx.x);
        else if (blockIdx.x < 192) rwkv2_unit(p, (blockIdx.x - 128) >> 2, (blockIdx.x - 128) & 3, sm);
        xcd_barrier(xbar);
        for (int q = blockIdx.x >> 3; q < NCH + NCH / 2; q += 32) {
            const int x = blockIdx.x & 7;
            if (q < NCH) rwkv3_unit(p, x, q, sm);
            else gla3_unit(p, x >> 1, (NCH / 2) * (x & 1) + (q - NCH), sm);
        }
        xcd_barrier(xbar);
        run_gemm((const bf16_t*)(p.ws + OFF_YC), (const bf16_t*)(p.ws + OFF_WT2), TB, DM, DM, EpRes0{(float*)(p.ws + OFF_P0), modv, b}, sm);
        xcd_barrier(xbar);
        ln_rows((const float*)(p.ws + OFF_P0), p.in[0] + (size_t)b * NL * DM, p.in[2] + (size_t)b * NCX * DM, TB, p.in[6], p.in[7], p.out + (size_t)b * NL * DM, X1C + (size_t)b * NCX * DM, NCX,
                (bf16_t*)(p.ws + OFF_H1B) + (size_t)b * TB * DM, modv + (3 + 2) * 3072, modv + (3 + b) * 3072);
        if (b == 0) phase_h0(p, 1);
        xcd_barrier(xbar);
    }

    run_gemm((const bf16_t*)(p.ws + OFF_H1B), (const bf16_t*)(p.ws + OFF_WT1), RT, 2048, DM, EpBf16{(bf16_t*)(p.ws + OFF_XM), 2048, 2048}, sm);
    zero_f4((float*)(p.ws + OFF_H), (size_t)NB * NL * 1024);
    xcd_barrier(xbar);
    phase_conv1(p, sm);
    xcd_barrier(xbar);
    phase_x1(p, sm);
    xcd_barrier(xbar);
    phase_x2(p, sm);
    xcd_barrier(xbar);
    phase_mlstm(p, sm);
    xcd_barrier(xbar);
    phase_h1l(p);
    xcd_barrier(xbar);
    run_gemm((const bf16_t*)(p.ws + OFF_H1B), (const bf16_t*)(p.ws + OFF_WT1) + (size_t)2048 * 1024, NB * NL, 2048, DM, EpBf16{(bf16_t*)(p.ws + OFF_XM), 2048, 2048}, sm);
    xcd_barrier(xbar);
    phase_finish1(p);
    xcd_barrier(xbar);
    run_gemm((const bf16_t*)(p.ws + OFF_H), (const bf16_t*)(p.ws + OFF_WT3), NB * NL, DM, 2048, EpRes1{(float*)(p.ws + OFF_XC), modv + 3 * 3072}, sm);
    xcd_barrier(xbar);
    ln_rows((const float*)(p.ws + OFF_XC), p.out, p.out, NB * NL, p.in[6] + 1024, p.in[7] + 1024, p.out, p.out, 0);
}

extern "C" void kernel_launch(void* const* d_in, const int* in_sizes, int n_in, void* d_out, int out_size, void* d_ws, size_t ws_size, hipStream_t stream) {
    static int grid_blocks = 0;
    if (grid_blocks == 0) {
        if (ws_size < WS_NEED || n_in != 46) { fprintf(stderr, "kernel_launch: bad ws_size %zu (need %zu) or n_in %d\n", ws_size, (size_t)WS_NEED, n_in); grid_blocks = -1; return; }
        int dev = 0, cus = 0, per_cu = 0;
        (void)hipGetDevice(&dev);
        (void)hipDeviceGetAttribute(&cus, hipDeviceAttributeMultiprocessorCount, dev);
        (void)hipFuncSetAttribute((const void*)fwd_kernel, hipFuncAttributeMaxDynamicSharedMemorySize, LDS_BYTES);
        (void)hipOccupancyMaxActiveBlocksPerMultiprocessor(&per_cu, (const void*)fwd_kernel, NTHR, LDS_BYTES);
        if (per_cu < 1 || cus < 256) { fprintf(stderr, "kernel_launch: occupancy query says %d blocks/CU on %d CUs; this kernel needs 256 resident workgroups\n", per_cu, cus); grid_blocks = -1; return; }
        grid_blocks = 256;
    }
    if (grid_blocks < 0) return;
    (void)hipMemsetAsync((char*)d_ws + OFF_BAR, 0, XCD_BAR_WORDS * 4, stream);
    Params p{};
    for (int i = 0; i < 46; ++i) p.in[i] = (const float*)d_in[i];
    p.out = (float*)d_out; p.ws = (char*)d_ws;
    void* args[] = {&p};
    hipError_t e = hipLaunchCooperativeKernel((const void*)fwd_kernel, dim3(grid_blocks), dim3(NTHR), args, LDS_BYTES, stream);
    if (e != hipSuccess) fprintf(stderr, "cooperative launch failed: %s (grid %d)\n", hipGetErrorString(e), grid_blocks);
}
```

```cpp
#include <hip/hip_runtime.h>
#include <cstdio>
#include <cmath>

#define DEV __device__ __forceinline__

constexpr int NB = 2, NL = 8192, DM = 1024, NCX = 256, TB = NCX + NL;
constexpr int RT = NB * TB;
constexpr int NCH = TB / 64;
constexpr int EIN = 3872, RW0 = 1568;
constexpr int NTHR = 512, NWV = 8;
constexpr float ALPHA = 1.41421356237f;
constexpr float KSCALE = 0.04419417382f;

constexpr size_t OFF_MODV = 0;
constexpr size_t OFF_X1C  = 131072;
constexpr size_t OFF_BAR  = 3145728;
constexpr size_t OFF_BIG  = 4194304;
constexpr size_t OFF_P0   = OFF_BIG;
constexpr size_t OFF_YC   = OFF_BIG + (size_t)TB * EIN * 2;
constexpr size_t OFF_GDS  = OFF_YC + (size_t)TB * 1024 * 2;
constexpr size_t OFF_GDEC = OFF_GDS + (size_t)8 * NCH * 8192 * 4;
constexpr size_t OFF_RU   = OFF_GDEC + (size_t)8 * NCH * 64 * 4;
constexpr size_t OFF_RS0  = OFF_RU + (size_t)16 * NCH * 16384 * 2;
constexpr size_t OFF_BONS = OFF_RS0 + (size_t)16 * NCH * 4096 * 2;
constexpr size_t L0_END   = OFF_BONS + (size_t)2 * TB * 8 * 4;
constexpr size_t OFF_XM   = OFF_BIG;
constexpr size_t OFF_XC   = OFF_XM + (size_t)RT * 2048 * 2;
constexpr size_t OFF_H    = OFF_XC + (size_t)RT * 2048 * 2;
constexpr size_t OFF_WT0  = OFF_H + (size_t)NB * NL * 2048 * 2;
constexpr size_t OFF_WT1  = OFF_WT0 + (size_t)4096 * 1024 * 2;
constexpr size_t OFF_WT2  = OFF_WT1 + (size_t)4096 * 1024 * 2;
constexpr size_t OFF_WT3  = OFF_WT2 + (size_t)1024 * 1024 * 2;
constexpr size_t OFF_G16  = OFF_WT3 + (size_t)1024 * 2048 * 2;
constexpr size_t OFF_SMAT = OFF_G16 + (size_t)RT * 16 * 4;
constexpr size_t OFF_GSC  = OFF_SMAT + (size_t)NB * 4 * NCH * 4096 * 2;
constexpr size_t OFF_CSC  = OFF_GSC + (size_t)16 * TB * 4 * 4;
constexpr size_t OFF_NBUF = OFF_CSC + (size_t)16 * NCH * 2 * 4;
constexpr size_t OFF_GTAB = 3407872;
constexpr size_t OFF_WFT  = OFF_GTAB + (size_t)4 * 128 * 16 * 4;
static_assert(OFF_WFT + (size_t)16 * 4096 * 2 <= OFF_BIG, "low-region tables overflow");
constexpr size_t OFF_G16P = OFF_NBUF + (size_t)16 * NCH * 512 * 4;
constexpr size_t OFF_H1B  = OFF_G16;
constexpr size_t WS_NEED  = (OFF_G16P + (size_t)4 * RT * 16 * 4 > OFF_H1B + (size_t)RT * 1024 * 2) ? OFF_G16P + (size_t)4 * RT * 16 * 4 : OFF_H1B + (size_t)RT * 1024 * 2;
static_assert(WS_NEED <= (size_t)256 * 1024 * 1024, "workspace exceeds the guaranteed 256 MiB");

static_assert(L0_END <= OFF_WT0, "layer-0 buffers overlap the weight copies");
constexpr int LDS_BYTES = 139264;

struct Params { const float* in[46]; float* out; char* ws; };
typedef unsigned short bf16_t;
typedef __attribute__((ext_vector_type(8))) short bf16x8;
typedef __attribute__((ext_vector_type(4))) short s16x4;
typedef __attribute__((ext_vector_type(2))) short s16x2;
typedef __attribute__((ext_vector_type(4))) float f32x4;
typedef __attribute__((ext_vector_type(2))) __bf16 bf2_t;
DEV unsigned pack2bf(float lo, float hi) { bf2_t v; v[0] = (__bf16)lo; v[1] = (__bf16)hi; return __builtin_bit_cast(unsigned, v); }
DEV float bflo(unsigned u) { return __uint_as_float(u << 16); }
DEV float bfhi(unsigned u) { return __uint_as_float(u & 0xffff0000u); }
DEV float bf2f(bf16_t v) { return __uint_as_float(((unsigned)v) << 16); }
DEV void unpack8(uint4 u, float* f) { f[0] = bflo(u.x); f[1] = bfhi(u.x); f[2] = bflo(u.y); f[3] = bfhi(u.y); f[4] = bflo(u.z); f[5] = bfhi(u.z); f[6] = bflo(u.w); f[7] = bfhi(u.w); }

DEV float wave_sum(float v) {
#pragma unroll
    for (int o = 32; o > 0; o >>= 1) v += __shfl_xor(v, o, 64);
    return v;
}
DEV float wave_max(float v) {
#pragma unroll
    for (int o = 32; o > 0; o >>= 1) v = fmaxf(v, __shfl_xor(v, o, 64));
    return v;
}
DEV float fexp(float x) { return __expf(x); }
DEV float frcp(float x) { return __builtin_amdgcn_rcpf(x); }
DEV float sigmoid_f(float x) { return frcp(1.f + fexp(-x)); }
DEV float silu_f(float x) { return x * frcp(1.f + fexp(-x)); }
DEV float logsig_f(float x) { return fminf(x, 0.f) - __logf(1.f + fexp(-fabsf(x))); }
DEV float tanh_f(float x) { const float e = fexp(2.f * x); return 1.f - 2.f * frcp(e + 1.f); }
DEV void lds_fence() { asm volatile("" ::: "memory"); }
DEV int opaque_tid() { int t = threadIdx.x; asm volatile("" : "+v"(t)); return t; }
DEV int scan_s(int dir, int u) { return dir == 0 ? u : (u < NCX ? (NCX - 1 - u) : (TB - 1 + NCX - u)); }
DEV int chunk_at(int dir, int step) { return dir == 0 ? step : (step < 4 ? 3 - step : (NCH + 3 - step)); }
DEV float4 ld4(const float* p) { return *(const float4*)p; }
DEV void st4(float* p, float4 v) { *(float4*)p = v; }


#define XB_TMO      128
#define XB_XCNT(j)  (256  + 64 * (j))
#define XB_XSUB(j)  (1280 + 64 * (j))
#define XB_XGEN(j)  (2304 + 64 * (j))
#define XB_TOP      3328
#define XB_TOPGEN   3392
#define XCD_BAR_WORDS 3456
#define XB_SPIN_CAP (1u << 22)
#define LAS __attribute__((address_space(3)))
DEV unsigned xb_ld(unsigned* p) { return __hip_atomic_load(p, __ATOMIC_RELAXED, __HIP_MEMORY_SCOPE_AGENT); }
DEV unsigned xb_add(unsigned* p, unsigned v) { return __hip_atomic_fetch_add(p, v, __ATOMIC_RELAXED, __HIP_MEMORY_SCOPE_AGENT); }
DEV unsigned xb_xcc_id() { return (unsigned)__builtin_amdgcn_s_getreg((3 << 11) | 20) & 0xFu; }
#define XB_SPIN(cond, bar) do { unsigned _sp = 0; while (cond) { __builtin_amdgcn_s_sleep(1); \
    if ((++_sp & 255u) == 0u) { if (xb_ld(&(bar)[XB_TMO])) break; if (_sp > XB_SPIN_CAP) { atomicAdd(&(bar)[XB_TMO], 1u); break; } } } } while (0)
struct XcdBarrier { unsigned* bar; unsigned x; volatile LAS unsigned* st; };
DEV XcdBarrier xcd_barrier_post(unsigned* bar, volatile LAS unsigned* st) {
    XcdBarrier b; b.bar = bar; b.x = xb_xcc_id(); b.st = st;
    if (threadIdx.x == 0) (void)xb_add(&bar[XB_XCNT(b.x)], 1u);
    return b;
}
DEV void xcd_barrier_complete(unsigned* bar, unsigned x, unsigned& nloc, unsigned& nx) {
    const unsigned G = gridDim.x * gridDim.y * gridDim.z;
    unsigned sum, cnt, mine, sp = 0u;
    for (;;) {
        sum = 0u; cnt = 0u; mine = 0u;
#pragma unroll
        for (unsigned j = 0; j < 16; ++j) { const unsigned c = xb_ld(&bar[XB_XCNT(j)]); sum += c; cnt += (c > 0u) ? 1u : 0u; mine = (j == x) ? c : mine; }
        if (sum == G) break;
        __builtin_amdgcn_s_sleep(1);
        if ((++sp & 255u) == 0u) { if (xb_ld(&bar[XB_TMO])) break; if (sp > XB_SPIN_CAP) { atomicAdd(&bar[XB_TMO], 1u); break; } }
    }
    nloc = mine > 0u ? mine : 1u; nx = cnt > 0u ? cnt : 1u;
}
DEV void xcd_barrier(const XcdBarrier& b) {
    asm volatile("s_waitcnt vmcnt(0)" ::: "memory");
    __syncthreads();
    if (threadIdx.x == 0) {
        unsigned* bar = b.bar;
        __builtin_amdgcn_s_waitcnt(0);
        unsigned nloc = b.st[0], nx = b.st[1];
        if (nloc == 0u) { xcd_barrier_complete(bar, b.x, nloc, nx); b.st[0] = nloc; b.st[1] = nx; }
        const unsigned old = xb_add(&bar[XB_XSUB(b.x)], 1u);
        const unsigned gen = old / nloc;
        if (old + 1u == (gen + 1u) * nloc) {
            __builtin_amdgcn_fence(__ATOMIC_RELEASE, "agent");
            asm volatile("s_waitcnt vmcnt(0)" ::: "memory");
            const unsigned og = xb_add(&bar[XB_TOP], 1u);
            const unsigned tg = og / nx;
            if (og + 1u == (tg + 1u) * nx) xb_add(&bar[XB_TOPGEN], 1u);
            else XB_SPIN(xb_ld(&bar[XB_TOPGEN]) == tg, bar);
            __builtin_amdgcn_fence(__ATOMIC_ACQUIRE, "agent");
            xb_add(&bar[XB_XGEN(b.x)], 1u);
            asm volatile("s_waitcnt vmcnt(0)" ::: "memory");
        } else {
            XB_SPIN(xb_ld(&bar[XB_XGEN(b.x)]) == gen, bar);
            __builtin_amdgcn_fence(__ATOMIC_ACQUIRE, "agent");
            asm volatile("s_waitcnt vmcnt(0)" ::: "memory");
        }
    }
    __syncthreads();
}

namespace pg8 {
#define PG8_LAS __attribute__((address_space(3)))
typedef unsigned short bf16_t;
typedef short bf16x8 __attribute__((ext_vector_type(8)));
typedef float f32x4 __attribute__((ext_vector_type(4)));
typedef unsigned u32x4 __attribute__((ext_vector_type(4)));
constexpr int BM = 256, BK = 64, HALF = 128, HTB = HALF * BK * 2  , STAGE_BYTES = 8 * HTB, NXCD = 8, WGM = 8;

__host__ __device__ __forceinline__ int lds_byte(int r, int c) { const int st = (r >> 4) * 2 + (c >> 5), rr = r & 15, cc = c & 31, ob = rr * 64 + cc * 2; return st * 1024 + (ob ^ (((ob >> 9) & 1) << 5)); }
__host__ __device__ __forceinline__ void stage_rc(int b, int& R, int& C) { const int st = b / 1024, sb = b % 1024, swz = sb ^ (((sb >> 9) & 1) << 5); R = (st >> 1) * 16 + swz / 64; C = (st & 1) * 32 + (swz % 64) / 2; }
__host__ __device__ __forceinline__ int perm32(int rho) { const int n = rho >> 4, i = rho & 15; return 8 * (i >> 2) + 4 * n + (i & 3); }

struct Unit { int pm, pn; };
struct Gemm { const bf16_t* A; const bf16_t* Bt; int M, N, K; };

struct StaticOrder {
    int nM, nN, nwg, G, c;
    __host__ __device__ void init(int M, int N, int G_, int c_) { nM = M / BM; nN = N / BM; nwg = nM * nN; G = G_; c = c_; }
    __host__ __device__ bool next(int i, Unit& u) const {
        const long L = (long)i * G + c; if (L >= nwg) return false;
        int wgid = (int)L; { const int q = nwg / NXCD, r = nwg % NXCD, xcd = wgid % NXCD, off = wgid / NXCD; wgid = (xcd < r ? xcd * (q + 1) : r * (q + 1) + (xcd - r) * q) + off; }
        const int nig = WGM * nN, gid = wgid / nig, fm = gid * WGM, gsz = (nM - fm) < WGM ? (nM - fm) : WGM;
        u.pm = fm + ((wgid % nig) % gsz); u.pn = (wgid % nig) / gsz; return true;
    }
    __device__ __forceinline__ void a_ready(const Unit&) const {}
    __device__ __forceinline__ void done(const Unit&) const {}
};

template <class Epi, class Sched, bool STAMP = false>
__device__ __forceinline__ void gemm_phase(PG8_LAS unsigned char* lds, const Gemm g, const Sched& S, const Epi& E, unsigned long long* stamps) {
    int tid = threadIdx.x; asm volatile("" : "+v"(tid));
    const int wid = __builtin_amdgcn_readfirstlane(tid >> 6), lane = tid & 63, wr = wid >> 2, wc = wid & 3, fr = lane & 15, fq = lane >> 4;
    const int K = g.K, nt = K / BK;
#define PG8_STAMP() do { } while (0)
    PG8_STAMP();
    unsigned voffA[2], voffB[2];
#pragma unroll
    for (int i = 0; i < 2; ++i) { int R, C; stage_rc(tid * 16 + i * 8192, R, C); const int Rb = Epi::PERM ? ((R & ~31) + perm32(R & 31)) : R;
        voffA[i] = (unsigned)(R * K + C) * 2u; voffB[i] = (unsigned)(Rb * K + C) * 2u; }
    const size_t kstep = (size_t)(BK * 2);
    const size_t hstep = (size_t)HALF * K * 2;
    const size_t tstep = 2 * hstep;
    const unsigned ldsw = (unsigned)wid * 1024u;
    const int aoff = lds_byte(wr * 64 + fr, fq * 8), boff = lds_byte(wc * 32 + fr, fq * 8);
#define PG8_SA(b, h) (((b) * 2 + (h)) * HTB)
#define PG8_SB(b, h) ((4 + (b) * 2 + (h)) * HTB)
#define PG8_STAGE(bufoff, gbase, voff) do { _Pragma("unroll") for (int _i = 0; _i < 2; ++_i) \
        __builtin_amdgcn_global_load_lds((const unsigned*)((const char*)(gbase) + (voff)[_i]), (PG8_LAS unsigned*)(lds + (bufoff) + ldsw + _i * 8192), 16, 0, 0); } while (0)
#define PG8_LDA(dst, b, h) do { _Pragma("unroll") for (int m = 0; m < 4; ++m) _Pragma("unroll") for (int k = 0; k < 2; ++k) dst[m][k] = *(const PG8_LAS bf16x8*)(lds + PG8_SA(b, h) + aoff + m * 2048 + k * 1024); } while (0)
#define PG8_LDB(dst, b, h) do { _Pragma("unroll") for (int n = 0; n < 2; ++n) _Pragma("unroll") for (int k = 0; k < 2; ++k) dst[n][k] = *(const PG8_LAS bf16x8*)(lds + PG8_SB(b, h) + boff + n * 2048 + k * 1024); } while (0)
#define PG8_MMA(ai, bj, At, Bt) do { __builtin_amdgcn_s_setprio(1); _Pragma("unroll") for (int m = 0; m < 4; ++m) _Pragma("unroll") for (int n = 0; n < 2; ++n) _Pragma("unroll") for (int k = 0; k < 2; ++k) \
        acc[ai][bj][m][n] = __builtin_amdgcn_mfma_f32_16x16x32_bf16(Bt[n][k], At[m][k], acc[ai][bj][m][n], 0, 0, 0); __builtin_amdgcn_s_setprio(0); } while (0)
#define PG8_WAIT_V(n) asm volatile("s_waitcnt vmcnt(" #n ")" ::: "memory")
#define PG8_WAIT_L(n) asm volatile("s_waitcnt lgkmcnt(" #n ")" ::: "memory")
#define PG8_BAR __builtin_amdgcn_s_barrier()
#define PG8_SCHED __builtin_amdgcn_sched_barrier(0)
    Unit cur, nxt; int ui = 0;
    if (!S.next(0, cur)) return;
    f32x4 acc[2][2][4][2];
#pragma unroll
    for (int a = 0; a < 2; ++a)
#pragma unroll
        for (int b = 0; b < 2; ++b)
#pragma unroll
            for (int m = 0; m < 4; ++m)
#pragma unroll
                for (int n = 0; n < 2; ++n) acc[a][b][m][n] = (f32x4){0.f, 0.f, 0.f, 0.f};
    bf16x8 At[4][2], B0[2][2], B1[2][2];
    const char* cA = (const char*)g.A + (size_t)cur.pm * tstep; const char* cB = (const char*)g.Bt + (size_t)cur.pn * tstep;
    S.a_ready(cur);
    PG8_STAGE(PG8_SB(0, 0), cB, voffB); PG8_STAGE(PG8_SA(0, 0), cA, voffA); PG8_STAGE(PG8_SB(0, 1), cB + hstep, voffB); PG8_STAGE(PG8_SA(0, 1), cA + hstep, voffA);
    if (wr == 1) PG8_BAR;
    PG8_WAIT_V(4); PG8_BAR;
    PG8_STAGE(PG8_SB(1, 0), cB + kstep, voffB); PG8_STAGE(PG8_SA(1, 0), cA + kstep, voffA); PG8_STAGE(PG8_SB(1, 1), cB + hstep + kstep, voffB);
    PG8_WAIT_V(6); PG8_BAR;
    PG8_STAMP();
    for (;;) {
        const bool has_next = S.next(ui + 1, nxt);
        const char* nA = has_next ? (const char*)g.A + (size_t)nxt.pm * tstep : cA; const char* nB = has_next ? (const char*)g.Bt + (size_t)nxt.pn * tstep : cB;
        for (int t = 0; t < nt; t += 2) {
            const bool last = (t == nt - 2);
            const char* a1 = cA + (size_t)(t + 1) * kstep;
            const char* a2 = last ? nA : cA + (size_t)(t + 2) * kstep; const char* b2 = last ? nB : cB + (size_t)(t + 2) * kstep;
            const char* a3 = a2 + kstep; const char* b3 = b2 + kstep;
            if (last && has_next) S.a_ready(nxt);
            PG8_LDB(B0, 0, 0); PG8_SCHED; PG8_LDA(At, 0, 0); PG8_STAGE(PG8_SA(1, 1), a1 + hstep, voffA);
            PG8_WAIT_L(8); PG8_BAR; PG8_WAIT_L(0); PG8_MMA(0, 0, At, B0); PG8_BAR; PG8_SCHED;
            PG8_LDB(B1, 0, 1); PG8_STAGE(PG8_SB(0, 0), b2, voffB);
            PG8_BAR; PG8_WAIT_L(0); PG8_MMA(0, 1, At, B1); PG8_BAR;
            PG8_LDA(At, 0, 1); PG8_STAGE(PG8_SA(0, 0), a2, voffA);
            PG8_BAR; PG8_WAIT_L(0); PG8_MMA(1, 0, At, B0); PG8_BAR; PG8_SCHED;
            PG8_STAGE(PG8_SB(0, 1), b2 + hstep, voffB);
            PG8_WAIT_V(6); PG8_BAR; PG8_MMA(1, 1, At, B1); PG8_BAR;
            PG8_LDB(B0, 1, 0); PG8_SCHED; PG8_LDA(At, 1, 0); PG8_STAGE(PG8_SA(0, 1), a2 + hstep, voffA);
            PG8_WAIT_L(8); PG8_BAR; PG8_WAIT_L(0); PG8_MMA(0, 0, At, B0); PG8_BAR; PG8_SCHED;
            PG8_LDB(B1, 1, 1); PG8_STAGE(PG8_SB(1, 0), b3, voffB);
            PG8_BAR; PG8_WAIT_L(0); PG8_MMA(0, 1, At, B1); PG8_BAR;
            PG8_LDA(At, 1, 1); PG8_STAGE(PG8_SA(1, 0), a3, voffA);
            PG8_BAR; PG8_WAIT_L(0); PG8_MMA(1, 0, At, B0); PG8_BAR; PG8_SCHED;
            PG8_STAGE(PG8_SB(1, 1), b3 + hstep, voffB);
            PG8_WAIT_V(6); PG8_BAR; PG8_MMA(1, 1, At, B1); PG8_BAR;
        }
        PG8_STAMP();
        if constexpr (!Epi::AFTER_DRAIN) { E(acc, cur, wr, wc, fr, fq); S.done(cur); }
        PG8_STAMP();
        if (!has_next) break;
#pragma unroll
        for (int a = 0; a < 2; ++a)
#pragma unroll
            for (int b = 0; b < 2; ++b)
#pragma unroll
                for (int m = 0; m < 4; ++m)
#pragma unroll
                    for (int n = 0; n < 2; ++n) acc[a][b][m][n] = (f32x4){0.f, 0.f, 0.f, 0.f};
        cur = nxt; cA = nA; cB = nB; ++ui;
    }
    PG8_WAIT_V(0);
    if (wr == 0) PG8_BAR;
    PG8_BAR;
    if constexpr (Epi::AFTER_DRAIN) { E.fused(acc, cur, wr, wc, fr, fq, lds, wid, lane); S.done(cur); }
    PG8_STAMP();
#undef PG8_STAMP
#undef PG8_SA
#undef PG8_SB
#undef PG8_STAGE
#undef PG8_LDA
#undef PG8_LDB
#undef PG8_MMA
#undef PG8_WAIT_V
#undef PG8_WAIT_L
#undef PG8_BAR
#undef PG8_SCHED
}
}

DEV void transpose_convert(const float* __restrict__ W, int K, int N, int Npad, bf16_t* Wt, float* sm) {
    float (*T)[65] = (float (*)[65])sm;
    const int tid = opaque_tid();
    const int kt = K / 64, ntl = Npad / 64;
    for (int tile = blockIdx.x; tile < kt * ntl; tile += gridDim.x) {
        const int k0 = (tile / ntl) * 64, n0 = (tile % ntl) * 64;
        __syncthreads();
#pragma unroll
        for (int i = 0; i < 2; ++i) {
            const int k = (tid >> 4) + 32 * i, n4 = (tid & 15) * 4;
            float4 v = make_float4(0.f, 0.f, 0.f, 0.f);
            if (n0 + n4 < N) v = ld4(W + (size_t)(k0 + k) * N + n0 + n4);
            T[k][n4] = v.x; T[k][n4 + 1] = v.y; T[k][n4 + 2] = v.z; T[k][n4 + 3] = v.w;
        }
        __syncthreads();
        const int n = tid >> 3, kq = (tid & 7) * 8;
        unsigned o[4];
#pragma unroll
        for (int j = 0; j < 4; ++j) o[j] = pack2bf(T[kq + 2 * j][n], T[kq + 2 * j + 1][n]);
        bf16_t* dst = Wt + (size_t)(n0 + n) * K + k0 + kq;
        *(uint4*)dst = make_uint4(o[0], o[1], o[2], o[3]);
    }
}

struct EpBf16 {
    static constexpr bool PERM = true, AFTER_DRAIN = false;
    bf16_t* O; int ldc; int ncols;
    DEV void operator()(const pg8::f32x4 (&acc)[2][2][4][2], const pg8::Unit& u, int wr, int wc, int fr, int fq) const {
        const int row0 = u.pm * 256 + wr * 64 + fr, col0 = u.pn * 256 + wc * 32 + 8 * fq;
#pragma unroll
        for (int ai = 0; ai < 2; ++ai)
#pragma unroll
            for (int m = 0; m < 4; ++m) {
                bf16_t* rowp = O + (size_t)(row0 + ai * 128 + m * 16) * ldc + col0;
#pragma unroll
                for (int bj = 0; bj < 2; ++bj) {
                    if (col0 + bj * 128 < ncols) {
                        const pg8::f32x4 v0 = acc[ai][bj][m][0], v1 = acc[ai][bj][m][1];
                        *(uint4*)(rowp + bj * 128) = make_uint4(pack2bf(v0[0], v0[1]), pack2bf(v0[2], v0[3]), pack2bf(v1[0], v1[1]), pack2bf(v1[2], v1[3]));
                    }
                }
            }
    }
};
struct EpRes0 {
    static constexpr bool PERM = false, AFTER_DRAIN = false;
    float* C; const float* mv; int b;
    DEV void operator()(const pg8::f32x4 (&acc)[2][2][4][2], const pg8::Unit& u, int wr, int wc, int fr, int fq) const {
        const bool isc = (u.pm * 256 < NCX);
        const float* gp = mv + (isc ? 2 : b) * 3072 + 2048;
        const int row0 = u.pm * 256 + wr * 64 + fr, col0 = u.pn * 256 + wc * 32 + 4 * fq;
#pragma unroll
        for (int ai = 0; ai < 2; ++ai)
#pragma unroll
            for (int m = 0; m < 4; ++m) {
                const size_t ro = (size_t)(row0 + ai * 128 + m * 16) * DM + col0;
#pragma unroll
                for (int bj = 0; bj < 2; ++bj)
#pragma unroll
                    for (int n = 0; n < 2; ++n) {
                        const int co = bj * 128 + n * 16;
                        const float4 g = ld4(gp + col0 + co); const pg8::f32x4 v = acc[ai][bj][m][n];
                        st4(C + ro + co, make_float4(g.x * v[0], g.y * v[1], g.z * v[2], g.w * v[3]));
                    }
            }
    }
};
struct EpRes1 {
    static constexpr bool PERM = false, AFTER_DRAIN = false;
    float* C; const float* mv;
    DEV void operator()(const pg8::f32x4 (&acc)[2][2][4][2], const pg8::Unit& u, int wr, int wc, int fr, int fq) const {
        const float* gp = mv + (u.pm * 256 >= NL ? 1 : 0) * 3072 + 2048;
        const int row0 = u.pm * 256 + wr * 64 + fr, col0 = u.pn * 256 + wc * 32 + 4 * fq;
#pragma unroll
        for (int ai = 0; ai < 2; ++ai)
#pragma unroll
            for (int m = 0; m < 4; ++m) {
                const size_t ro = (size_t)(row0 + ai * 128 + m * 16) * DM + col0;
#pragma unroll
                for (int bj = 0; bj < 2; ++bj)
#pragma unroll
                    for (int n = 0; n < 2; ++n) {
                        const int co = bj * 128 + n * 16;
                        const float4 g = ld4(gp + col0 + co); const pg8::f32x4 v = acc[ai][bj][m][n];
                        st4(C + ro + co, make_float4(g.x * v[0], g.y * v[1], g.z * v[2], g.w * v[3]));
                    }
            }
    }
};
template <class EP>
DEV void run_gemm(const bf16_t* A, const bf16_t* Bt, int M, int N, int K, const EP& ep, float* sm) {
    pg8::Gemm g{A, Bt, M, N, K}; pg8::StaticOrder S; S.init(M, N, (int)gridDim.x, (int)blockIdx.x);
    pg8::gemm_phase<EP, pg8::StaticOrder, false>((PG8_LAS unsigned char*)sm, g, S, ep, nullptr);
}

struct Mod8 { float4 s0, s1, c0, c1; };
DEV Mod8 mod8_load(const float* m, int k) { Mod8 q; q.s0 = ld4(m + k); q.s1 = ld4(m + k + 4); q.c0 = ld4(m + 1024 + k); q.c1 = ld4(m + 1024 + k + 4); return q; }
DEV uint4 mod8_apply(const float4 x0, const float4 x1, const Mod8& q) {
    return make_uint4(pack2bf(x0.x * (1.f + q.c0.x) + q.s0.x, x0.y * (1.f + q.c0.y) + q.s0.y), pack2bf(x0.z * (1.f + q.c0.z) + q.s0.z, x0.w * (1.f + q.c0.w) + q.s0.w),
                      pack2bf(x1.x * (1.f + q.c1.x) + q.s1.x, x1.y * (1.f + q.c1.y) + q.s1.y), pack2bf(x1.z * (1.f + q.c1.z) + q.s1.z, x1.w * (1.f + q.c1.w) + q.s1.w));
}
DEV void phase_h0(const Params& p, int b) {
    const float* modv = (const float*)(p.ws + OFF_MODV);
    bf16_t* H0 = (bf16_t*)(p.ws + OFF_YC);
    const int gt = blockIdx.x * NTHR + opaque_tid(), gn = gridDim.x * NTHR;
    const int k = (gt & 127) * 8;
    const Mod8 mc = mod8_load(modv + 2 * 3072, k), ml = mod8_load(modv + b * 3072, k);
    for (int i0 = gt; i0 < TB * 128; i0 += 4 * gn) {
        float4 xa[4], xb[4];
#pragma unroll
        for (int u = 0; u < 4; ++u) {
            const int i = i0 + u * gn, s = (i < TB * 128 ? i : gt) >> 7;
            const float* src = (s < NCX) ? p.in[2] + ((size_t)(b * NCX + s)) * DM + k : p.in[0] + ((size_t)(b * NL + s - NCX)) * DM + k;
            xa[u] = ld4(src); xb[u] = ld4(src + 4);
        }
#pragma unroll
        for (int u = 0; u < 4; ++u) {
            const int i = i0 + u * gn, s = i >> 7;
            if (i < TB * 128) *(uint4*)(H0 + (size_t)s * DM + k) = mod8_apply(xa[u], xb[u], (s < NCX) ? mc : ml);
        }
    }
}

DEV void phase_mod(const Params& p, float* sm) {
    const float* c = p.in[1]; const float* cctx = p.in[3];
    const float* mod_w = p.in[4]; const float* mod_b = p.in[5];
    float* modv = (float*)(p.ws + OFF_MODV);
    float* sil = sm; float* red = sm + 3072;
    const int tid = opaque_tid();
    for (int i = tid; i < 3072; i += NTHR) {
        const int j = i >> 10, k = i & 1023;
        const float v = (j < 2) ? c[j * 1024 + k] : cctx[k];
        sil[i] = silu_f(v);
    }
    __syncthreads();
    for (int unit = blockIdx.x; unit < 192; unit += gridDim.x) {
        const int l = unit / 96, cb = unit % 96;
        const int kg = tid >> 5, col = tid & 31, n = cb * 32 + col;
        const float* w = mod_w + (size_t)l * 1024 * 3072 + n;
        float a0 = 0.f, a1 = 0.f, a2 = 0.f;
        for (int k = kg * 64; k < kg * 64 + 64; ++k) {
            const float wv = w[(size_t)k * 3072];
            a0 += sil[k] * wv; a1 += sil[1024 + k] * wv; a2 += sil[2048 + k] * wv;
        }
        red[(kg * 3 + 0) * 32 + col] = a0; red[(kg * 3 + 1) * 32 + col] = a1; red[(kg * 3 + 2) * 32 + col] = a2;
        __syncthreads();
        if (tid < 96) {
            const int j = tid >> 5, cc = tid & 31, nn = cb * 32 + cc;
            float s = mod_b[l * 3072 + nn];
            for (int g = 0; g < 16; ++g) s += red[(g * 3 + j) * 32 + cc];
            modv[(l * 3 + j) * 3072 + nn] = s;
        }
        __syncthreads();
    }
}

DEV void phase_tables(const Params& p) {
    const float* wq = p.in[33]; const float* wk = p.in[34]; const float* wv = p.in[35];
    const float* gw0 = p.in[36]; const float* gw1 = p.in[38]; const float* gw2 = p.in[40]; const float* gw3 = p.in[42];
    float* gtab = (float*)(p.ws + OFF_GTAB); bf16_t* wft = (bf16_t*)(p.ws + OFF_WFT);
    const int gt = blockIdx.x * NTHR + opaque_tid(), gn = gridDim.x * NTHR;
    for (int i = gt; i < 512 * 16; i += gn) {
        const int gb = i >> 4, cp = (i >> 2) & 3, c = i & 3;
        float s = 0.f;
#pragma unroll
        for (int d = 0; d < 4; ++d) s += wq[gb * 16 + cp * 4 + d] * wk[gb * 16 + c * 4 + d];
        gtab[i] = s * KSCALE;
    }
    for (int i = gt; i < 4096 * 16; i += gn) {
        const int g = i >> 12, k = i & 4095, gm = g >> 2, hd = g & 3;
        const float* wg = gm == 0 ? gw0 : (gm == 1 ? gw1 : (gm == 2 ? gw2 : gw3));
        float s = 0.f;
        if (k < 2048) {
            const int blk = k >> 2, cc = k & 3;
#pragma unroll
            for (int d = 0; d < 4; ++d) s += wq[blk * 16 + cc * 4 + d] * wg[(size_t)(4 * blk + d) * 4 + hd] + wk[blk * 16 + cc * 4 + d] * wg[(size_t)(2048 + 4 * blk + d) * 4 + hd];
        } else {
            const int kk = k - 2048, blk = kk >> 2, cc = kk & 3;
#pragma unroll
            for (int d = 0; d < 4; ++d) s += wv[blk * 16 + cc * 4 + d] * wg[(size_t)(4096 + 4 * blk + d) * 4 + hd];
        }
        wft[i] = __builtin_bit_cast(unsigned short, (__bf16)s);
    }
}

DEV float wave_scan_add(float v, int lane, int dir) {
#pragma unroll
    for (int o = 1; o < 64; o <<= 1) {
        const float n = dir ? __shfl_down(v, o, 64) : __shfl_up(v, o, 64);
        const bool ok = dir ? (lane + o < 64) : (lane >= o);
        if (ok) v += n;
    }
    return v;
}
DEV float wave_scan_max(float v, int lane, int dir) {
#pragma unroll
    for (int o = 1; o < 64; o <<= 1) {
        const float n = dir ? __shfl_down(v, o, 64) : __shfl_up(v, o, 64);
        const bool ok = dir ? (lane + o < 64) : (lane >= o);
        if (ok) v = fmaxf(v, n);
    }
    return v;
}

DEV void gla_decay(const bf16_t* P0, int c, int h, int dir, const float* __restrict__ wa2, const float* __restrict__ ba,
                   float* sLR, float* sWA, float* sBC, float* sTot, int tid) {
    for (int i = tid; i < 1024; i += NTHR) { const int t = i >> 4, j = i & 15; sLR[i] = bf2f(P0[(size_t)(c * 64 + t) * EIN + 1536 + dir * 16 + j]); }
    for (int i = tid; i < 1024; i += NTHR) { const int ii = i >> 6, k = i & 63; sWA[i] = wa2[ii * 256 + h * 64 + k]; }
    __syncthreads();
    {
        const int t = tid >> 3, k0 = (tid & 7) * 8;
        float acc[8];
#pragma unroll
        for (int j = 0; j < 8; ++j) acc[j] = ba[h * 64 + k0 + j];
#pragma unroll
        for (int ii = 0; ii < 16; ++ii) {
            const float l = sLR[t * 16 + ii];
#pragma unroll
            for (int j = 0; j < 8; ++j) acc[j] += l * sWA[ii * 64 + k0 + j];
        }
#pragma unroll
        for (int j = 0; j < 8; ++j) sBC[t * 65 + k0 + j] = logsig_f(acc[j]) * 0.0625f;
    }
    __syncthreads();
    {
        const int lane = tid & 63, wv = tid >> 6;
#pragma unroll
        for (int j = 0; j < 8; ++j) {
            const int k = wv * 8 + j;
            const float v = wave_scan_add(sBC[lane * 65 + k], lane, dir);
            sBC[lane * 65 + k] = v;
            if (lane == (dir ? 0 : 63)) sTot[k] = v;
        }
    }
    __syncthreads();
}
DEV bf16x8 tr_frag(const bf16_t* base, int ld, int row0, int col0, int lane) {
    const bf16_t* ptr = base + (row0 + (lane >> 4) * 8 + ((lane & 15) >> 2)) * ld + col0 + (lane & 3) * 4;
    const s16x4 lo = __builtin_amdgcn_ds_read_tr16_b64_v4i16((__attribute__((address_space(3))) s16x4*)ptr);
    const s16x4 hi = __builtin_amdgcn_ds_read_tr16_b64_v4i16((__attribute__((address_space(3))) s16x4*)(ptr + 4 * ld));
    return (bf16x8){lo[0], lo[1], lo[2], lo[3], hi[0], hi[1], hi[2], hi[3]};
}
DEV bf16x8 row_frag(const bf16_t* base, int ld, int idx0, int k0, int lane) {
    return *(const bf16x8*)(base + (idx0 + (lane & 15)) * ld + k0 + (lane >> 4) * 8);
}

DEV void gla1_unit(const Params& p, int h, int dir, int c, float* sm) {
    const int tid = opaque_tid(), lane = tid & 63, wave = tid >> 6;
    const bf16_t* P0 = (const bf16_t*)(p.ws + OFF_P0);
    float* GDS = (float*)(p.ws + OFF_GDS); float* GDEC = (float*)(p.ws + OFF_GDEC);
    const float* wa2 = p.in[dir ? 12 : 10]; const float* ba = p.in[dir ? 13 : 11];
    float* sLR = sm; float* sWA = sm + 1024; float* sBC = sm + 2048; float* sTot = sm + 6208;
    bf16_t* kT = (bf16_t*)(sm + 6272);
    bf16_t* Vs = (bf16_t*)(sm + 8576);
    const int ch = h * 2 + dir;
    __syncthreads();
    gla_decay(P0, c, h, dir, wa2, ba, sLR, sWA, sBC, sTot, tid);
    {
        const int t = tid >> 3, k0 = (tid & 7) * 8;
        float kv[8]; unpack8(*(const uint4*)(P0 + (size_t)(c * 64 + t) * EIN + 256 + h * 64 + k0), kv);
#pragma unroll
        for (int j = 0; j < 8; ++j) kT[(k0 + j) * 72 + t] = __builtin_bit_cast(unsigned short, (__bf16)(kv[j] * fexp(sTot[k0 + j] - sBC[t * 65 + k0 + j])));
#pragma unroll
        for (int u = 0; u < 2; ++u) { const int i = tid + 512 * u, row = i >> 4, c16 = i & 15; *(uint4*)(Vs + row * 136 + c16 * 8) = *(const uint4*)(P0 + (size_t)(c * 64 + row) * EIN + 512 + h * 128 + c16 * 8); }
    }
    __syncthreads();
    {
        f32x4 acc[4];
#pragma unroll
        for (int kt = 0; kt < 4; ++kt) acc[kt] = (f32x4){0.f, 0.f, 0.f, 0.f};
#pragma unroll
        for (int ks = 0; ks < 2; ++ks) {
            const bf16x8 af = tr_frag(Vs, 136, ks * 32, wave * 16, lane);
#pragma unroll
            for (int kt = 0; kt < 4; ++kt) acc[kt] = __builtin_amdgcn_mfma_f32_16x16x32_bf16(af, row_frag(kT, 72, kt * 16, ks * 32, lane), acc[kt], 0, 0, 0);
        }
#pragma unroll
        for (int kt = 0; kt < 4; ++kt) {
            const int k = kt * 16 + (lane & 15), v = wave * 16 + (lane >> 4) * 4;
            st4(GDS + ((size_t)(ch * NCH + c) * 64 + k) * 128 + v, make_float4(acc[kt][0], acc[kt][1], acc[kt][2], acc[kt][3]));
        }
    }
    if (tid < 64) GDEC[(size_t)(ch * NCH + c) * 64 + tid] = fexp(sTot[tid]);
}

DEV void gla2_unit(const Params& p, int unit) {
    const int tid = opaque_tid();
    float* GDS = (float*)(p.ws + OFF_GDS); const float* GDEC = (const float*)(p.ws + OFF_GDEC);
    const int ch = unit >> 4, e = (unit & 15) * 512 + tid, k = e >> 7, dir = ch & 1;
    constexpr int GB = 12;
    float S = 0.f, ninc[GB], nd[GB];
#pragma unroll
    for (int j = 0; j < GB; ++j) { const int c = chunk_at(dir, j); ninc[j] = GDS[(size_t)(ch * NCH + c) * 8192 + e]; nd[j] = GDEC[(size_t)(ch * NCH + c) * 64 + k]; }
#pragma unroll 1
    for (int step0 = 0; step0 < NCH; step0 += GB) {
        float inc[GB], d[GB];
#pragma unroll
        for (int j = 0; j < GB; ++j) { inc[j] = ninc[j]; d[j] = nd[j]; }
#pragma unroll
        for (int j = 0; j < GB; ++j) { const int sn = step0 + GB + j, c = chunk_at(dir, sn < NCH ? sn : NCH - 1); ninc[j] = GDS[(size_t)(ch * NCH + c) * 8192 + e]; nd[j] = GDEC[(size_t)(ch * NCH + c) * 64 + k]; }
        __builtin_amdgcn_sched_barrier(0);
#pragma unroll
        for (int j = 0; j < GB; ++j) { const int c = chunk_at(dir, step0 + j); GDS[(size_t)(ch * NCH + c) * 8192 + e] = S; S = d[j] * S + inc[j]; }
    }
}

DEV void gla3_unit(const Params& p, int h, int c, float* sm) {
    const int tid = opaque_tid(), lane = tid & 63, wave = tid >> 6;
    const bf16_t* P0 = (const bf16_t*)(p.ws + OFF_P0);
    const float* GDS = (const float*)(p.ws + OFF_GDS);
    bf16_t* YC = (bf16_t*)(p.ws + OFF_YC);
    const float* ng = p.in[14];
    float* sLR = sm; float* sWA = sm + 1024; float* sBC = sm + 2048; float* sTot = sm + 6208;
    bf16_t* qt = (bf16_t*)(sm + 6272);
    bf16_t* kt = (bf16_t*)(sm + 8576);
    bf16_t* Sm = (bf16_t*)(sm + 10880);
    bf16_t* S0s = (bf16_t*)(sm + 13184);
    bf16_t* Vs = (bf16_t*)(sm + 17536);
    float* O = sm + 21888;
    const int ti = wave & 3, vt0 = (wave >> 2) * 4;
    f32x4 acc[4];
#pragma unroll
    for (int j = 0; j < 4; ++j) acc[j] = (f32x4){0.f, 0.f, 0.f, 0.f};
    __syncthreads();
#pragma unroll
    for (int u = 0; u < 2; ++u) { const int i = tid + 512 * u, row = i >> 4, c16 = i & 15; *(uint4*)(Vs + row * 136 + c16 * 8) = *(const uint4*)(P0 + (size_t)(c * 64 + row) * EIN + 512 + h * 128 + c16 * 8); }
#pragma unroll 1
    for (int dir = 0; dir < 2; ++dir) {
        const float* wa2 = p.in[dir ? 12 : 10]; const float* ba = p.in[dir ? 13 : 11];
        const int ch = h * 2 + dir;
        __syncthreads();
        gla_decay(P0, c, h, dir, wa2, ba, sLR, sWA, sBC, sTot, tid);
        {
            const int t = tid >> 3, k0 = (tid & 7) * 8;
            float qv[8], kv[8];
            unpack8(*(const uint4*)(P0 + (size_t)(c * 64 + t) * EIN + h * 64 + k0), qv);
            unpack8(*(const uint4*)(P0 + (size_t)(c * 64 + t) * EIN + 256 + h * 64 + k0), kv);
#pragma unroll
            for (int j = 0; j < 8; ++j) { const float bc = sBC[t * 65 + k0 + j]; qv[j] *= 0.125f * fexp(bc); kv[j] *= fexp(-bc); }
            *(uint4*)(qt + t * 72 + k0) = make_uint4(pack2bf(qv[0], qv[1]), pack2bf(qv[2], qv[3]), pack2bf(qv[4], qv[5]), pack2bf(qv[6], qv[7]));
            *(uint4*)(kt + t * 72 + k0) = make_uint4(pack2bf(kv[0], kv[1]), pack2bf(kv[2], kv[3]), pack2bf(kv[4], kv[5]), pack2bf(kv[6], kv[7]));
#pragma unroll
            for (int u = 0; u < 4; ++u) {
                const int i = tid + 512 * u, k = i >> 5, v4 = (i & 31) * 4;
                const float4 s4 = ld4(GDS + (size_t)(ch * NCH + c) * 8192 + k * 128 + v4);
                *(uint2*)(S0s + k * 136 + v4) = make_uint2(pack2bf(s4.x, s4.y), pack2bf(s4.z, s4.w));
            }
        }
        __syncthreads();
        {
            const int si = wave & 3;
#pragma unroll
            for (int jj = 0; jj < 2; ++jj) {
                const int t2 = (wave >> 2) * 2 + jj;
                f32x4 a = (f32x4){0.f, 0.f, 0.f, 0.f};
#pragma unroll
                for (int ks = 0; ks < 2; ++ks) a = __builtin_amdgcn_mfma_f32_16x16x32_bf16(row_frag(kt, 72, si * 16, ks * 32, lane), row_frag(qt, 72, t2 * 16, ks * 32, lane), a, 0, 0, 0);
                const int t = t2 * 16 + (lane & 15), s0 = si * 16 + (lane >> 4) * 4;
                float m[4];
#pragma unroll
                for (int r = 0; r < 4; ++r) { const bool keep = dir ? (s0 + r >= t) : (s0 + r <= t); m[r] = keep ? a[r] : 0.f; }
                *(uint2*)(Sm + t * 72 + s0) = make_uint2(pack2bf(m[0], m[1]), pack2bf(m[2], m[3]));
            }
        }
        __syncthreads();
#pragma unroll
        for (int ks = 0; ks < 2; ++ks) {
            const bf16x8 a1 = row_frag(qt, 72, ti * 16, ks * 32, lane), a2 = row_frag(Sm, 72, ti * 16, ks * 32, lane);
#pragma unroll
            for (int j = 0; j < 4; ++j) {
                acc[j] = __builtin_amdgcn_mfma_f32_16x16x32_bf16(a1, tr_frag(S0s, 136, ks * 32, (vt0 + j) * 16, lane), acc[j], 0, 0, 0);
                acc[j] = __builtin_amdgcn_mfma_f32_16x16x32_bf16(a2, tr_frag(Vs, 136, ks * 32, (vt0 + j) * 16, lane), acc[j], 0, 0, 0);
            }
        }
    }
#pragma unroll
    for (int j = 0; j < 4; ++j)
#pragma unroll
        for (int r = 0; r < 4; ++r) O[(ti * 16 + (lane >> 4) * 4 + r) * 132 + (vt0 + j) * 16 + (lane & 15)] = acc[j][r];
    __syncthreads();
    {
        const int t = tid >> 3, v0 = (tid & 7) * 16;
        float o[16];
        float ss = 0.f;
#pragma unroll
        for (int i = 0; i < 16; ++i) { o[i] = O[t * 132 + v0 + i]; ss += o[i] * o[i]; }
        ss += __shfl_xor(ss, 1, 64); ss += __shfl_xor(ss, 2, 64); ss += __shfl_xor(ss, 4, 64);
        const float rms = rsqrtf(ss * (1.f / 128.f) + 1e-5f);
        float g[16];
        const bf16_t* gp = P0 + (size_t)(c * 64 + t) * EIN + 1024 + h * 128 + v0;
        unpack8(*(const uint4*)gp, g); unpack8(*(const uint4*)(gp + 8), g + 8);
        float y[16];
#pragma unroll
        for (int i = 0; i < 16; ++i) y[i] = o[i] * rms * ng[v0 + i] * silu_f(g[i]);
        bf16_t* yp = YC + (size_t)(c * 64 + t) * 1024 + h * 128 + v0;
        *(uint4*)yp = make_uint4(pack2bf(y[0], y[1]), pack2bf(y[2], y[3]), pack2bf(y[4], y[5]), pack2bf(y[6], y[7]));
        *(uint4*)(yp + 8) = make_uint4(pack2bf(y[8], y[9]), pack2bf(y[10], y[11]), pack2bf(y[12], y[13]), pack2bf(y[14], y[15]));
    }
}

DEV void load8bf(const bf16_t* ptr, float* f) { unpack8(*(const uint4*)ptr, f); }
struct RwNb { int sL, sR, sU, sD; bool vL, vR, vU, vD; };
DEV RwNb rw_nb(int s) {
    RwNb q; q.vU = false; q.vD = false;
    if (s < NCX) { q.vL = s > 0; q.vR = s < NCX - 1; }
    else { const int n = s - NCX, rr = n >> 6, cc = n & 63; q.vL = cc > 0; q.vR = cc < 63; q.vU = rr > 0; q.vD = rr < 127; }
    q.sL = q.vL ? s - 1 : s; q.sR = q.vR ? s + 1 : s; q.sU = q.vU ? s - 64 : s; q.sD = q.vD ? s + 64 : s;
    return q;
}
struct RwRaw { uint4 o, l, r, u, d; };
DEV RwRaw rw_load(const bf16_t* P0, int s, const RwNb& q, int cb) {
    RwRaw w;
    w.o = *(const uint4*)(P0 + (size_t)s * EIN + RW0 + cb); w.l = *(const uint4*)(P0 + (size_t)q.sL * EIN + RW0 + cb); w.r = *(const uint4*)(P0 + (size_t)q.sR * EIN + RW0 + cb);
    w.u = *(const uint4*)(P0 + (size_t)q.sU * EIN + RW0 + cb); w.d = *(const uint4*)(P0 + (size_t)q.sD * EIN + RW0 + cb);
    return w;
}
DEV void rw_comb_l(const RwRaw& w, const RwNb& q, const float* ml, float* out) {
    float own[8]; unpack8(w.o, own);
    const float nb[8] = {q.vL ? bflo(w.l.x) : 0.f, q.vR ? bfhi(w.r.x) : 0.f, q.vU ? bflo(w.u.y) : 0.f, q.vD ? bfhi(w.d.y) : 0.f,
                         q.vL ? bflo(w.l.z) : 0.f, q.vR ? bfhi(w.r.z) : 0.f, q.vU ? bflo(w.u.w) : 0.f, q.vD ? bfhi(w.d.w) : 0.f};
    const float4 m0 = *(const float4*)ml, m1 = *(const float4*)(ml + 4);
    const float m[8] = {m0.x, m0.y, m0.z, m0.w, m1.x, m1.y, m1.z, m1.w};
#pragma unroll
    for (int i = 0; i < 8; ++i) out[i] = own[i] + (nb[i] - own[i]) * m[i];
}
DEV void rw_comb(const RwRaw& w, const RwNb& q, const float* __restrict__ mu, int cb, float* out) {
    float own[8]; unpack8(w.o, own);
    const float nb[8] = {q.vL ? bflo(w.l.x) : 0.f, q.vR ? bfhi(w.r.x) : 0.f, q.vU ? bflo(w.u.y) : 0.f, q.vD ? bfhi(w.d.y) : 0.f,
                         q.vL ? bflo(w.l.z) : 0.f, q.vR ? bfhi(w.r.z) : 0.f, q.vU ? bflo(w.u.w) : 0.f, q.vD ? bfhi(w.d.w) : 0.f};
    const float4 m0 = ld4(mu + cb), m1 = ld4(mu + cb + 4);
    const float m[8] = {m0.x, m0.y, m0.z, m0.w, m1.x, m1.y, m1.z, m1.w};
#pragma unroll
    for (int i = 0; i < 8; ++i) out[i] = own[i] + (nb[i] - own[i]) * m[i];
}
DEV uint4 pack8(const float* f) { return make_uint4(pack2bf(f[0], f[1]), pack2bf(f[2], f[3]), pack2bf(f[4], f[5]), pack2bf(f[6], f[7])); }

template <int XM, int YM, class F>
DEV void mm64(const bf16_t* X, const bf16_t* Y, F f, int lane, int wave) {
#pragma unroll
    for (int q = 0; q < 2; ++q) {
        const int idx = wave * 2 + q, ti = idx >> 2, tj = idx & 3;
        f32x4 acc = (f32x4){0.f, 0.f, 0.f, 0.f};
#pragma unroll
        for (int ks = 0; ks < 2; ++ks) {
            const bf16x8 a = XM == 0 ? row_frag(X, 72, ti * 16, ks * 32, lane) : tr_frag(X, 72, ks * 32, ti * 16, lane);
            const bf16x8 bq = YM == 0 ? row_frag(Y, 72, tj * 16, ks * 32, lane) : tr_frag(Y, 72, ks * 32, tj * 16, lane);
            acc = __builtin_amdgcn_mfma_f32_16x16x32_bf16(a, bq, acc, 0, 0, 0);
        }
        f(ti * 16 + (lane >> 4) * 4, tj * 16 + (lane & 15), acc);
    }
}
template <int XM, int YM, class F>
DEV void mm64x2(const bf16_t* X1, const bf16_t* Y1, const bf16_t* X2, const bf16_t* Y2, F f, int lane, int wave) {
#pragma unroll
    for (int q = 0; q < 2; ++q) {
        const int idx = wave * 2 + q, ti = idx >> 2, tj = idx & 3;
        f32x4 acc = (f32x4){0.f, 0.f, 0.f, 0.f};
#pragma unroll
        for (int ks = 0; ks < 2; ++ks) {
            const bf16x8 a = XM == 0 ? row_frag(X1, 72, ti * 16, ks * 32, lane) : tr_frag(X1, 72, ks * 32, ti * 16, lane);
            const bf16x8 bq = YM == 0 ? row_frag(Y1, 72, tj * 16, ks * 32, lane) : tr_frag(Y1, 72, ks * 32, tj * 16, lane);
            acc = __builtin_amdgcn_mfma_f32_16x16x32_bf16(a, bq, acc, 0, 0, 0);
            const bf16x8 a2 = XM == 0 ? row_frag(X2, 72, ti * 16, ks * 32, lane) : tr_frag(X2, 72, ks * 32, ti * 16, lane);
            const bf16x8 b2 = YM == 0 ? row_frag(Y2, 72, tj * 16, ks * 32, lane) : tr_frag(Y2, 72, ks * 32, tj * 16, lane);
            acc = __builtin_amdgcn_mfma_f32_16x16x32_bf16(a2, b2, acc, 0, 0, 0);
        }
        f(ti * 16 + (lane >> 4) * 4, tj * 16 + (lane & 15), acc);
    }
}
DEV void st_img(bf16_t* P, int i0, int j, float a0, float a1, float a2, float a3) {
    P[(i0 + 0) * 72 + j] = __builtin_bit_cast(unsigned short, (__bf16)a0); P[(i0 + 1) * 72 + j] = __builtin_bit_cast(unsigned short, (__bf16)a1);
    P[(i0 + 2) * 72 + j] = __builtin_bit_cast(unsigned short, (__bf16)a2); P[(i0 + 3) * 72 + j] = __builtin_bit_cast(unsigned short, (__bf16)a3);
}

struct RwRaw3 { uint4 o, u, d; };
DEV RwRaw3 rw_load3(const bf16_t* P0, int s, const RwNb& q, int cb) {
    RwRaw3 w;
    w.o = *(const uint4*)(P0 + (size_t)s * EIN + RW0 + cb); w.u = *(const uint4*)(P0 + (size_t)q.sU * EIN + RW0 + cb); w.d = *(const uint4*)(P0 + (size_t)q.sD * EIN + RW0 + cb);
    return w;
}
DEV void rw_comb3(const RwRaw3& w, const RwNb& q, const bf16_t* tile, const bf16_t* P0, int s, int t, int cb, int j0, const float* ml, float* out) {
    asm volatile("" :: "v"(w.u.x), "v"(w.u.z), "v"(w.d.x), "v"(w.d.z));
    float own[8]; unpack8(w.o, own);
    float l0 = 0.f, l4 = 0.f, r1 = 0.f, r5 = 0.f;
    if (q.vL) { if (t > 0) { l0 = bf2f(tile[(t - 1) * 72 + j0]); l4 = bf2f(tile[(t - 1) * 72 + j0 + 4]); }
                else { const bf16_t* g = P0 + (size_t)(s - 1) * EIN + RW0 + cb; l0 = bf2f(g[0]); l4 = bf2f(g[4]); } }
    if (q.vR) { if (t < 63) { r1 = bf2f(tile[(t + 1) * 72 + j0 + 1]); r5 = bf2f(tile[(t + 1) * 72 + j0 + 5]); }
                else { const bf16_t* g = P0 + (size_t)(s + 1) * EIN + RW0 + cb; r1 = bf2f(g[1]); r5 = bf2f(g[5]); } }
    const float nb[8] = {l0, r1, q.vU ? bflo(w.u.y) : 0.f, q.vD ? bfhi(w.d.y) : 0.f, l4, r5, q.vU ? bflo(w.u.w) : 0.f, q.vD ? bfhi(w.d.w) : 0.f};
    const float4 m0 = *(const float4*)ml, m1 = *(const float4*)(ml + 4);
    const float m[8] = {m0.x, m0.y, m0.z, m0.w, m1.x, m1.y, m1.z, m1.w};
#pragma unroll
    for (int i = 0; i < 8; ++i) out[i] = own[i] + (nb[i] - own[i]) * m[i];
}
struct R1Raw { RwRaw3 r, k, v, w, a; float4 qw0, qw1, qa0, qa1; };
DEV void r1_consts(const Params& p, int h, int dir, float* sm) {
    const int tid = opaque_tid();
    float* sv = (float*)((bf16_t*)sm + 14 * 4608);
    __syncthreads();
    if (tid < 64) { const int hc = h * 64 + tid; sv[64 + tid] = p.in[dir ? 18 : 16][hc]; sv[128 + tid] = p.in[dir ? 22 : 20][hc]; sv[192 + tid] = p.in[24][hc]; sv[256 + tid] = p.in[25][hc]; sv[320 + tid] = p.in[26][hc]; }
    if (tid < 320) { const int tn = tid >> 6, col = tid & 63; const int cb = tn < 3 ? tn * 512 + h * 64 : (tn == 3 ? 2048 + dir * 64 : 2176 + dir * 64); sv[384 + tid] = p.in[15][cb + col]; }
}
DEV void r1_load(const Params& p, int h, int dir, int c, R1Raw& R) {
    const int tid = opaque_tid();
    const bf16_t* P0 = (const bf16_t*)(p.ws + OFF_P0);
    const float* ww2 = p.in[dir ? 19 : 17]; const float* wa2 = p.in[dir ? 23 : 21];
    const int t = tid >> 3, j0 = (tid & 7) * 8, s = c * 64 + t;
    const RwNb nbq = rw_nb(s);
    R.r = rw_load3(P0, s, nbq, h * 64 + j0); R.k = rw_load3(P0, s, nbq, 512 + h * 64 + j0); R.v = rw_load3(P0, s, nbq, 1024 + h * 64 + j0);
    R.w = rw_load3(P0, s, nbq, 2048 + dir * 64 + j0); R.a = rw_load3(P0, s, nbq, 2176 + dir * 64 + j0);
    R.qw0 = ld4(ww2 + (size_t)t * 512 + h * 64 + j0); R.qw1 = ld4(ww2 + (size_t)t * 512 + h * 64 + j0 + 4);
    R.qa0 = ld4(wa2 + (size_t)t * 512 + h * 64 + j0); R.qa1 = ld4(wa2 + (size_t)t * 512 + h * 64 + j0 + 4);
}
DEV void rwkv1_unit(const Params& p, int h, int dir, int c, float* sm, R1Raw& R, int cnext) {
    const int tid = opaque_tid(), lane = tid & 63, wave = tid >> 6;
    bf16_t* RU = (bf16_t*)(p.ws + OFF_RU) + (size_t)((h * 2 + dir) * NCH + c) * 16384;
    float* BONS = (float*)(p.ws + OFF_BONS);
    bf16_t* img = (bf16_t*)sm;
#define SLOT(i_) (img + (i_) * 4608)
    float* fLW = (float*)SLOT(10);
    float* fAS = (float*)SLOT(12);
    float* sv = (float*)SLOT(14);
    const int t = tid >> 3, j0 = (tid & 7) * 8, s = c * 64 + t;
    const bf16_t* P0 = (const bf16_t*)(p.ws + OFF_P0);
    __syncthreads();
    *(uint4*)(SLOT(0) + t * 72 + j0) = R.r.o; *(uint4*)(SLOT(1) + t * 72 + j0) = R.k.o; *(uint4*)(SLOT(2) + t * 72 + j0) = R.v.o;
    *(uint4*)(SLOT(3) + t * 72 + j0) = R.w.o; *(uint4*)(SLOT(4) + t * 72 + j0) = R.a.o;
    __syncthreads();
    float r8[8], k8[8], v8[8];
    {
        float x8[8];
        const RwNb nbq = rw_nb(s);
        rw_comb3(R.r, nbq, SLOT(0), P0, s, t, h * 64 + j0, j0, sv + 384 + j0, r8);
        rw_comb3(R.k, nbq, SLOT(1), P0, s, t, 512 + h * 64 + j0, j0, sv + 448 + j0, k8);
        rw_comb3(R.v, nbq, SLOT(2), P0, s, t, 1024 + h * 64 + j0, j0, sv + 512 + j0, v8);
        rw_comb3(R.w, nbq, SLOT(3), P0, s, t, 2048 + dir * 64 + j0, j0, sv + 576 + j0, x8);
#pragma unroll
        for (int i = 0; i < 8; ++i) x8[i] = tanh_f(x8[i]);
        *(uint4*)(SLOT(6) + t * 72 + j0) = pack8(x8);
        rw_comb3(R.a, nbq, SLOT(4), P0, s, t, 2176 + dir * 64 + j0, j0, sv + 640 + j0, x8);
        *(uint4*)(SLOT(7) + t * 72 + j0) = pack8(x8);
        { const float wq[8] = {R.qw0.x, R.qw0.y, R.qw0.z, R.qw0.w, R.qw1.x, R.qw1.y, R.qw1.z, R.qw1.w}; *(uint4*)(SLOT(8) + t * 72 + j0) = pack8(wq); }
        { const float wq[8] = {R.qa0.x, R.qa0.y, R.qa0.z, R.qa0.w, R.qa1.x, R.qa1.y, R.qa1.z, R.qa1.w}; *(uint4*)(SLOT(9) + t * 72 + j0) = pack8(wq); }
    }
    r1_load(p, h, dir, cnext >= 0 ? cnext : c, R);
    __syncthreads();
    mm64<0, 1>(SLOT(6), SLOT(8), [=](int i0, int j, f32x4 a) {
#pragma unroll
        for (int r = 0; r < 4; ++r) fLW[(i0 + r) * 65 + j] = -0.6065306597f * sigmoid_f(sv[64 + j] + a[r]); }, lane, wave);
    mm64<0, 1>(SLOT(7), SLOT(9), [=](int i0, int j, f32x4 a) {
#pragma unroll
        for (int r = 0; r < 4; ++r) fAS[(i0 + r) * 65 + j] = sigmoid_f(sv[128 + j] + a[r]); }, lane, wave);
    __syncthreads();
#pragma unroll
    for (int j = 0; j < 8; ++j) {
        const int k = wave * 8 + j;
        const float v = wave_scan_add(fLW[lane * 65 + k], lane, dir);
        fLW[lane * 65 + k] = v;
        if (lane == (dir ? 0 : 63)) sv[k] = v;
    }
    __syncthreads();
    {
        float kkv[8], ss = 0.f;
#pragma unroll
        for (int i = 0; i < 8; ++i) { kkv[i] = k8[i] * sv[192 + j0 + i]; ss += kkv[i] * kkv[i]; }
        ss += __shfl_xor(ss, 1, 64); ss += __shfl_xor(ss, 2, 64); ss += __shfl_xor(ss, 4, 64);
        const float rn = rsqrtf(fmaxf(ss, 1e-24f));
        float fa[8], fb[8], fk[8], fr[8], fbp[8], fkp[8], bon = 0.f;
        const int tp = dir ? t + 1 : t - 1;
        const bool hasp = dir ? (t < 63) : (t > 0);
#pragma unroll
        for (int i = 0; i < 8; ++i) {
            const int k = j0 + i;
            const float Bt = fLW[t * 65 + k], Bx = hasp ? fLW[tp * 65 + k] : 0.f, asg = fAS[t * 65 + k];
            const float kk = kkv[i] * rn, kh = k8[i] * (1.f + (asg - 1.f) * sv[256 + k]);
            bon += r8[i] * kh * sv[320 + k];
            const float enB = fexp(-Bt), eLB = fexp(sv[k] - Bt), bv = kk * asg;
            fa[i] = -kk * fexp(Bx); fb[i] = bv * enB; fk[i] = kh * enB; fr[i] = r8[i] * fexp(Bt); fbp[i] = bv * eLB; fkp[i] = kh * eLB;
        }
        bon += __shfl_xor(bon, 1, 64); bon += __shfl_xor(bon, 2, 64); bon += __shfl_xor(bon, 4, 64);
        if ((tid & 7) == 0) BONS[((size_t)dir * TB + s) * 8 + h] = bon;
        *(uint4*)(SLOT(0) + t * 72 + j0) = pack8(fa); *(uint4*)(SLOT(1) + t * 72 + j0) = pack8(fb); *(uint4*)(SLOT(2) + t * 72 + j0) = pack8(fk);
        *(uint4*)(SLOT(3) + t * 72 + j0) = pack8(fr); *(uint4*)(SLOT(4) + t * 72 + j0) = pack8(fbp); *(uint4*)(SLOT(5) + t * 72 + j0) = pack8(fkp);
    }
    __syncthreads();
    *(uint4*)(SLOT(6) + t * 72 + j0) = pack8(v8);
    __syncthreads();
    mm64<0, 0>(SLOT(0), SLOT(1), [=](int i0, int j, f32x4 a) {
        float m[4];
#pragma unroll
        for (int r = 0; r < 4; ++r) { const bool keep = dir ? (j > i0 + r) : (j < i0 + r); m[r] = keep ? a[r] : 0.f; }
        const bool dg = (i0 >> 4) == (j >> 4);
        st_img(SLOT(7), i0, j, dg ? m[0] : 0.f, dg ? m[1] : 0.f, dg ? m[2] : 0.f, dg ? m[3] : 0.f);
        st_img(SLOT(8), i0, j, (dg ? m[0] : 0.f) + (j == i0 ? 1.f : 0.f), (dg ? m[1] : 0.f) + (j == i0 + 1 ? 1.f : 0.f), (dg ? m[2] : 0.f) + (j == i0 + 2 ? 1.f : 0.f), (dg ? m[3] : 0.f) + (j == i0 + 3 ? 1.f : 0.f));
        st_img(SLOT(12), i0, j, dg ? 0.f : m[0], dg ? 0.f : m[1], dg ? 0.f : m[2], dg ? 0.f : m[3]); }, lane, wave);
    mm64<0, 0>(SLOT(0), SLOT(2), [=](int i0, int j, f32x4 a) {
        float m[4];
#pragma unroll
        for (int r = 0; r < 4; ++r) { const bool keep = dir ? (j > i0 + r) : (j < i0 + r); m[r] = keep ? a[r] : 0.f; }
        st_img(SLOT(9), i0, j, m[0], m[1], m[2], m[3]); }, lane, wave);
    mm64<0, 0>(SLOT(3), SLOT(1), [=](int i0, int j, f32x4 a) {
        float m[4];
#pragma unroll
        for (int r = 0; r < 4; ++r) { const bool keep = dir ? (j >= i0 + r) : (j <= i0 + r); m[r] = keep ? a[r] : 0.f; }
        st_img(SLOT(10), i0, j, m[0], m[1], m[2], m[3]); }, lane, wave);
    mm64<0, 0>(SLOT(3), SLOT(2), [=](int i0, int j, f32x4 a) {
        float m[4];
#pragma unroll
        for (int r = 0; r < 4; ++r) { const bool keep = dir ? (j >= i0 + r) : (j <= i0 + r); m[r] = keep ? a[r] : 0.f; }
        st_img(SLOT(11), i0, j, m[0], m[1], m[2], m[3]); }, lane, wave);
    __syncthreads();
    {
        bf16_t* Pc = SLOT(7); bf16_t* Pn = SLOT(1); bf16_t* Tc = SLOT(8); bf16_t* Tn = SLOT(2);
#pragma unroll 1
        for (int it = 0; it < 3; ++it) {
            mm64<0, 1>(Pc, Pc, [=](int i0, int j, f32x4 a) { st_img(Pn, i0, j, a[0], a[1], a[2], a[3]); }, lane, wave);
            __syncthreads();
            mm64<0, 1>(Tc, Pn, [=](int i0, int j, f32x4 a) {
                st_img(Tn, i0, j, a[0] + bf2f(Tc[(i0 + 0) * 72 + j]), a[1] + bf2f(Tc[(i0 + 1) * 72 + j]), a[2] + bf2f(Tc[(i0 + 2) * 72 + j]), a[3] + bf2f(Tc[(i0 + 3) * 72 + j])); }, lane, wave);
            __syncthreads();
            bf16_t* tmp = Pc; Pc = Pn; Pn = tmp; tmp = Tc; Tc = Tn; Tn = tmp;
        }
    }
    mm64<0, 1>(SLOT(2), SLOT(12), [=](int i0, int j, f32x4 a) { st_img(SLOT(7), i0, j, a[0], a[1], a[2], a[3]); }, lane, wave);
    mm64<0, 1>(SLOT(2), SLOT(0), [=](int i0, int j, f32x4 a) { st_img(SLOT(1), i0, j, a[0], a[1], a[2], a[3]); }, lane, wave);
    mm64<0, 1>(SLOT(9), SLOT(6), [=](int i0, int j, f32x4 a) { st_img(SLOT(13), i0, j, a[0], a[1], a[2], a[3]); }, lane, wave);
    __syncthreads();
    mm64<0, 1>(SLOT(2), SLOT(13), [=](int i0, int j, f32x4 a) { st_img(SLOT(8), i0, j, a[0], a[1], a[2], a[3]); }, lane, wave);
    __syncthreads();
    {
        const bf16_t* Zp = (wave < 4) ? SLOT(1) : SLOT(8);
        bf16_t* Xi = (wave < 4) ? SLOT(12) : SLOT(9);
        const int ct = (wave & 3) * 16, g4 = (lane >> 4) * 4, l15 = lane & 15;
#pragma unroll
        for (int bs = 0; bs < 4; ++bs) {
            const int bi = dir ? 3 - bs : bs;
            f32x4 acc;
#pragma unroll
            for (int r = 0; r < 4; ++r) acc[r] = bf2f(Zp[(bi * 16 + g4 + r) * 72 + ct + l15]);
            const bool k0 = dir ? (bi == 0) : (bi >= 1), k1 = dir ? (bi <= 2) : (bi == 3);
            if (k0) acc = __builtin_amdgcn_mfma_f32_16x16x32_bf16(row_frag(SLOT(7), 72, bi * 16, 0, lane), tr_frag(Xi, 72, 0, ct, lane), acc, 0, 0, 0);
            if (k1) acc = __builtin_amdgcn_mfma_f32_16x16x32_bf16(row_frag(SLOT(7), 72, bi * 16, 32, lane), tr_frag(Xi, 72, 32, ct, lane), acc, 0, 0, 0);
            st_img(Xi, bi * 16 + g4, ct + l15, acc[0], acc[1], acc[2], acc[3]);
            __syncthreads();
        }
    }
    mm64<1, 1>(SLOT(12), SLOT(4), [=](int i0, int j, f32x4 a) {
        float m[4];
#pragma unroll
        for (int r = 0; r < 4; ++r) m[r] = a[r] + ((i0 + r) == j ? fexp(sv[j]) : 0.f);
        *(uint2*)(RU + j * 64 + i0) = make_uint2(pack2bf(m[0], m[1]), pack2bf(m[2], m[3])); }, lane, wave);
    mm64x2<1, 1>(SLOT(4), SLOT(9), SLOT(5), SLOT(6), [=](int i0, int j, f32x4 a) {
        *(uint2*)(RU + 4096 + j * 64 + i0) = make_uint2(pack2bf(a[0], a[1]), pack2bf(a[2], a[3])); }, lane, wave);
    mm64<1, 0>(SLOT(12), SLOT(10), [=](int i0, int j, f32x4 a) {
        const uint2 rr = *(const uint2*)(SLOT(3) + j * 72 + i0);
        *(uint2*)(RU + 8192 + j * 64 + i0) = make_uint2(pack2bf(a[0] + bflo(rr.x), a[1] + bfhi(rr.x)), pack2bf(a[2] + bflo(rr.y), a[3] + bfhi(rr.y))); }, lane, wave);
    mm64x2<0, 1>(SLOT(10), SLOT(9), SLOT(11), SLOT(6), [=](int i0, int j, f32x4 a) {
        *(uint2*)(RU + 12288 + j * 64 + i0) = make_uint2(pack2bf(a[0], a[1]), pack2bf(a[2], a[3])); }, lane, wave);
#undef SLOT
}

#define R2_LOAD(M_, C_, rnd_) do { const int r0_ = ((rnd_) < R2_NR ? (rnd_) : R2_NR - 1) * R2_RS; \
    _Pragma("unroll") for (int s_ = 0; s_ < R2_RS; ++s_) M_[s_] = *(const uint4*)(RU + (size_t)(chain * NCH + chunk_at(dir, r0_ + s_)) * 16384 + tid * 8); \
    _Pragma("unroll") for (int j_ = 0; j_ < 3; ++j_) { const int cq_ = tid + 512 * j_; \
        C_[j_] = *(const uint4*)(RU + (size_t)(chain * NCH + chunk_at(dir, r0_ + (cq_ >> 7))) * 16384 + 4096 + (vblk * 16 + ((cq_ >> 3) & 15)) * 64 + (cq_ & 7) * 8); } } while (0)
#define R2_ROUND(M_, C_, rnd_) do { \
    { const int row_ = tid >> 3, c8_ = tid & 7, sw_ = (row_ >> 1) & 7, u0_ = (c8_ >> 2) * 4 + (c8_ & 1) * 2, eh_ = ((c8_ >> 1) & 1) * 8; \
      _Pragma("unroll") for (int s_ = 0; s_ < R2_RS; ++s_) { char* sl_ = ring + s_ * 10240 + row_ * 128 + eh_; \
          *(uint2*)(sl_ + ((u0_ ^ sw_) * 16)) = make_uint2(M_[s_].x, M_[s_].y); *(uint2*)(sl_ + (((u0_ + 1) ^ sw_) * 16)) = make_uint2(M_[s_].z, M_[s_].w); } \
      _Pragma("unroll") for (int j_ = 0; j_ < 3; ++j_) { const int cq_ = tid + 512 * j_, rw_ = (cq_ >> 3) & 15, q8_ = cq_ & 7, i_ = q8_ >> 1, g0_ = (q8_ & 1) * 2, sc_ = (rw_ >> 1) & 7; \
          char* sl_ = ring + (cq_ >> 7) * 10240 + 8192 + rw_ * 128 + (i_ & 1) * 8; \
          *(uint2*)(sl_ + (((g0_ * 2 + (i_ >> 1)) ^ sc_) * 16)) = make_uint2(C_[j_].x, C_[j_].y); *(uint2*)(sl_ + ((((g0_ + 1) * 2 + (i_ >> 1)) ^ sc_) * 16)) = make_uint2(C_[j_].z, C_[j_].w); } } \
    R2_LOAD(M_, C_, (rnd_) + 2); \
    __syncthreads(); \
    if (wave == 0) { \
        _Pragma("unroll 4") for (int s_ = 0; s_ < R2_RS; ++s_) { \
            const int c_ = chunk_at(dir, (rnd_) * R2_RS + s_); const char* sl_ = ring + s_ * 10240; \
            unsigned pk_[4][2]; \
            _Pragma("unroll") for (int i_ = 0; i_ < 4; ++i_) { pk_[i_][0] = pack2bf(st[i_][0], st[i_][1]); pk_[i_][1] = pack2bf(st[i_][2], st[i_][3]); } \
            bf16_t* sp_ = S0G + ((size_t)(chain * NCH + c_) * 64 + vblk * 16 + l15) * 64 + g * 4; \
            _Pragma("unroll") for (int i_ = 0; i_ < 4; ++i_) *(uint2*)(sp_ + i_ * 16) = make_uint2(pk_[i_][0], pk_[i_][1]); \
            bf16x8 bfr_[2]; \
            _Pragma("unroll") for (int ks_ = 0; ks_ < 2; ++ks_) { const uint4 u_ = make_uint4(pk_[2 * ks_][0], pk_[2 * ks_][1], pk_[2 * ks_ + 1][0], pk_[2 * ks_ + 1][1]); bfr_[ks_] = __builtin_bit_cast(bf16x8, u_); } \
            const uint4 c01_ = *(const uint4*)(sl_ + 8192 + l15 * 128 + (((g * 2) ^ ((l15 >> 1) & 7)) * 16)), c23_ = *(const uint4*)(sl_ + 8192 + l15 * 128 + (((g * 2 + 1) ^ ((l15 >> 1) & 7)) * 16)); \
            const unsigned cw_[8] = {c01_.x, c01_.y, c01_.z, c01_.w, c23_.x, c23_.y, c23_.z, c23_.w}; \
            _Pragma("unroll") for (int i_ = 0; i_ < 4; ++i_) { \
                f32x4 acc_ = (f32x4){bflo(cw_[2 * i_]), bfhi(cw_[2 * i_]), bflo(cw_[2 * i_ + 1]), bfhi(cw_[2 * i_ + 1])}; \
                _Pragma("unroll") for (int ks_ = 0; ks_ < 2; ++ks_) { \
                    const int row_ = i_ * 16 + l15; \
                    const bf16x8 af_ = *(const bf16x8*)(sl_ + row_ * 128 + (((ks_ * 4 + g) ^ ((row_ >> 1) & 7)) * 16)); \
                    acc_ = __builtin_amdgcn_mfma_f32_16x16x32_bf16(af_, bfr_[ks_], acc_, 0, 0, 0); } \
                st[i_] = acc_; } } } \
    __syncthreads(); } while (0)
DEV void rwkv2_unit(const Params& p, int chain, int vblk, float* sm) {
    constexpr int R2_RS = 12, R2_NR = NCH / R2_RS;
    static_assert(R2_NR * R2_RS == NCH && R2_RS * 10240 <= LDS_BYTES, "R2 ring");
    const int tid = opaque_tid(), lane = tid & 63, wave = tid >> 6;
    const bf16_t* RU = (const bf16_t*)(p.ws + OFF_RU);
    bf16_t* S0G = (bf16_t*)(p.ws + OFF_RS0);
    char* ring = (char*)sm;
    const int dir = chain & 1, g = lane >> 4, l15 = lane & 15;
    f32x4 st[4];
#pragma unroll
    for (int i = 0; i < 4; ++i) st[i] = (f32x4){0.f, 0.f, 0.f, 0.f};
    uint4 ma[R2_RS], ca[3], mb[R2_RS], cb[3];
    __syncthreads();
    R2_LOAD(ma, ca, 0); R2_LOAD(mb, cb, 1);
#pragma unroll 1
    for (int rnd = 0; rnd < R2_NR; rnd += 2) {
        R2_ROUND(ma, ca, rnd);
        if (rnd + 1 < R2_NR) R2_ROUND(mb, cb, rnd + 1);
    }
}
#undef R2_LOAD
#undef R2_ROUND

DEV void rwkv3_unit(const Params& p, int h, int c, float* sm) {
    const int tid = opaque_tid(), lane = tid & 63, wave = tid >> 6;
    const bf16_t* P0 = (const bf16_t*)(p.ws + OFF_P0);
    const bf16_t* RUb = (const bf16_t*)(p.ws + OFF_RU);
    const bf16_t* S0G = (const bf16_t*)(p.ws + OFF_RS0);
    const float* BONS = (const float*)(p.ws + OFF_BONS);
    bf16_t* YC = (bf16_t*)(p.ws + OFF_YC);
    const float* mu = p.in[15]; const float* gn_g = p.in[27]; const float* gn_b = p.in[28];
    bf16_t* img = (bf16_t*)sm;
    float* O = sm + 4 * 2304;
    const int t = tid >> 3, v0 = (tid & 7) * 8, s = c * 64 + t;
    const size_t u0 = (size_t)((h * 2 + 0) * NCH + c), u1 = (size_t)((h * 2 + 1) * NCH + c);
    const uint4 gr0 = *(const uint4*)(RUb + u0 * 16384 + 8192 + t * 64 + v0), gs0 = *(const uint4*)(S0G + u0 * 4096 + t * 64 + v0);
    const uint4 gr1 = *(const uint4*)(RUb + u1 * 16384 + 8192 + t * 64 + v0), gs1 = *(const uint4*)(S0G + u1 * 4096 + t * 64 + v0);
    uint2 yl[2][2];
#pragma unroll
    for (int q = 0; q < 2; ++q) { const int idx = wave * 2 + q, ti = idx >> 2, tj = idx & 3;
        yl[q][0] = *(const uint2*)(RUb + u0 * 16384 + 12288 + (tj * 16 + (lane & 15)) * 64 + ti * 16 + (lane >> 4) * 4);
        yl[q][1] = *(const uint2*)(RUb + u1 * 16384 + 12288 + (tj * 16 + (lane & 15)) * 64 + ti * 16 + (lane >> 4) * 4); }
    const RwNb nbq = rw_nb(s);
    const RwRaw wv_ = rw_load(P0, s, nbq, 1024 + h * 64 + v0), wg_ = rw_load(P0, s, nbq, 1536 + h * 64 + v0);
    const float bon = BONS[(size_t)s * 8 + h] + BONS[((size_t)TB + s) * 8 + h];
    __syncthreads();
    *(uint4*)(img + 0 * 4608 + t * 72 + v0) = gr0; *(uint4*)(img + 2 * 4608 + t * 72 + v0) = gs0;
    *(uint4*)(img + 1 * 4608 + t * 72 + v0) = gr1; *(uint4*)(img + 3 * 4608 + t * 72 + v0) = gs1;
    __syncthreads();
#pragma unroll
    for (int q = 0; q < 2; ++q) {
        const int idx = wave * 2 + q, ti = idx >> 2, tj = idx & 3;
        f32x4 accd[2];
#pragma unroll
        for (int dir = 0; dir < 2; ++dir) {
            f32x4 acc = (f32x4){bflo(yl[q][dir].x), bfhi(yl[q][dir].x), bflo(yl[q][dir].y), bfhi(yl[q][dir].y)};
#pragma unroll
            for (int ks = 0; ks < 2; ++ks) acc = __builtin_amdgcn_mfma_f32_16x16x32_bf16(row_frag(img + dir * 4608, 72, ti * 16, ks * 32, lane), row_frag(img + (2 + dir) * 4608, 72, tj * 16, ks * 32, lane), acc, 0, 0, 0);
            accd[dir] = acc;
        }
#pragma unroll
        for (int r = 0; r < 4; ++r) {
            const int oi = (ti * 16 + (lane >> 4) * 4 + r) * 68 + tj * 16 + (lane & 15);
            O[oi] = accd[0][r] + accd[1][r];
        }
    }
    __syncthreads();
    {
        float y[8], sum = 0.f;
#pragma unroll
        for (int i = 0; i < 8; ++i) { y[i] = O[t * 68 + v0 + i]; sum += y[i]; }
        sum += __shfl_xor(sum, 1, 64); sum += __shfl_xor(sum, 2, 64); sum += __shfl_xor(sum, 4, 64);
        const float mean = sum * (1.f / 64.f);
        float sq = 0.f;
#pragma unroll
        for (int i = 0; i < 8; ++i) { y[i] -= mean; sq += y[i] * y[i]; }
        sq += __shfl_xor(sq, 1, 64); sq += __shfl_xor(sq, 2, 64); sq += __shfl_xor(sq, 4, 64);
        const float rstd = rsqrtf(sq * (1.f / 64.f) + 64e-5f);
        float vm[8], gm[8];
        rw_comb(wv_, nbq, mu, 1024 + h * 64 + v0, vm);
        rw_comb(wg_, nbq, mu, 1536 + h * 64 + v0, gm);
        float o[8];
#pragma unroll
        for (int i = 0; i < 8; ++i) o[i] = (y[i] * rstd * gn_g[h * 64 + v0 + i] + gn_b[h * 64 + v0 + i] + bon * vm[i]) * silu_f(gm[i]);
        *(uint4*)(YC + (size_t)s * 1024 + 512 + h * 64 + v0) = pack8(o);
    }
}

DEV void ln_rows(const float* src, const float* res_lat, const float* res_cx, int nrows, const float* __restrict__ g, const float* __restrict__ bt, float* dst_lat, float* dst_cx, int ncx,
                 bf16_t* hb = nullptr, const float* mvc = nullptr, const float* mvl = nullptr) {
    const int tid_ = opaque_tid(); const int lane = tid_ & 63, gw = blockIdx.x * NWV + (tid_ >> 6), ngw = gridDim.x * NWV;
    for (int r = gw; r < nrows; r += ngw) {
        const float* x = src + (size_t)r * 1024;
        float4 v[4];
        float sum = 0.f;
        const float* xr = (r < ncx) ? (res_cx + (size_t)r * 1024) : (res_lat + (size_t)(r - ncx) * 1024);
#pragma unroll
        for (int i = 0; i < 4; ++i) { const float4 a = ld4(x + i * 256 + lane * 4), rr = ld4(xr + i * 256 + lane * 4);
            v[i] = make_float4(ALPHA * rr.x + a.x, ALPHA * rr.y + a.y, ALPHA * rr.z + a.z, ALPHA * rr.w + a.w); sum += v[i].x + v[i].y + v[i].z + v[i].w; }
        const float mean = wave_sum(sum) * (1.f / 1024.f);
        float sq = 0.f;
#pragma unroll
        for (int i = 0; i < 4; ++i) {
            v[i].x -= mean; v[i].y -= mean; v[i].z -= mean; v[i].w -= mean;
            sq += v[i].x * v[i].x + v[i].y * v[i].y + v[i].z * v[i].z + v[i].w * v[i].w;
        }
        const float rstd = rsqrtf(wave_sum(sq) * (1.f / 1024.f) + 1e-5f);
        float* d = (r < ncx) ? (dst_cx + (size_t)r * 1024) : (dst_lat + (size_t)(r - ncx) * 1024);
#pragma unroll
        for (int i = 0; i < 4; ++i) {
            const int c = i * 256 + lane * 4;
            const float4 gg = ld4(g + c), bb = ld4(bt + c);
            const float4 y = make_float4(v[i].x * rstd * gg.x + bb.x, v[i].y * rstd * gg.y + bb.y, v[i].z * rstd * gg.z + bb.z, v[i].w * rstd * gg.w + bb.w);
            st4(d + c, y);
            if (hb != nullptr) {
                const float* m = (r < ncx) ? mvc : mvl;
                const float4 sh = ld4(m + c), sc = ld4(m + 1024 + c);
                *(uint2*)(hb + (size_t)r * 1024 + c) = make_uint2(pack2bf(y.x * (1.f + sc.x) + sh.x, y.y * (1.f + sc.y) + sh.y), pack2bf(y.z * (1.f + sc.z) + sh.z, y.w * (1.f + sc.w) + sh.w));
            }
        }
    }
}
DEV void phase_h1l(const Params& p) {
    const float* modv1 = (const float*)(p.ws + OFF_MODV) + 3 * 3072;
    bf16_t* H1 = (bf16_t*)(p.ws + OFF_H1B);
    const size_t gt = (size_t)blockIdx.x * NTHR + opaque_tid(), gn = (size_t)gridDim.x * NTHR;
    const int k = (int)(gt & 127) * 8;
    const Mod8 m0 = mod8_load(modv1, k), m1 = mod8_load(modv1 + 3072, k);
    constexpr size_t NI = (size_t)NB * NL * 128;
    for (size_t i0 = gt; i0 < NI; i0 += 4 * gn) {
        float4 xa[4], xb[4];
#pragma unroll
        for (int u = 0; u < 4; ++u) { const size_t i = i0 + u * gn, r = (i < NI ? i : gt) >> 7; xa[u] = ld4(p.out + r * DM + k); xb[u] = ld4(p.out + r * DM + k + 4); }
#pragma unroll
        for (int u = 0; u < 4; ++u) { const size_t i = i0 + u * gn, r = i >> 7; if (i < NI) *(uint4*)(H1 + r * DM + k) = mod8_apply(xa[u], xb[u], (r >= (size_t)NL) ? m1 : m0); }
    }
}

DEV void zero_f4(float* ptr, size_t nfloat) {
    const size_t n4 = nfloat / 4;
    for (size_t i = (size_t)blockIdx.x * NTHR + opaque_tid(); i < n4; i += (size_t)gridDim.x * NTHR) ((float4*)ptr)[i] = make_float4(0.f, 0.f, 0.f, 0.f);
}

DEV void chain_ids(int& chain, int& sub) {
    const int bid = blockIdx.x, xcd = bid & 7, idx = bid >> 3;
    chain = xcd * 2 + (idx >> 4); sub = idx & 15;
}

DEV void phase_conv1(const Params& p, float* sm) {
    const bf16_t* XM = (const bf16_t*)(p.ws + OFF_XM);
    bf16_t* XC = (bf16_t*)(p.ws + OFF_XC);
    float* G16P = (float*)(p.ws + OFF_G16P);
    const bf16_t* WFT = (const bf16_t*)(p.ws + OFF_WFT);
    const float* cw = p.in[31]; const float* cbias = p.in[32];
    bf16_t* imgC = (bf16_t*)sm;
    bf16_t* imgM = imgC + 64 * 264;
    float* red = (float*)(imgM + 64 * 264);
    float* cwl = red + 1024;
    const int tid = opaque_tid(), lane = tid & 63, wave = tid >> 6, t = tid >> 3, cg = tid & 7;
    for (int u = blockIdx.x; u < NB * NCH * 4; u += gridDim.x) {
        const int ci = u >> 2, q = u & 3, b = ci / NCH, c = ci % NCH, s = c * 64 + t;
        const size_t rowbase = (size_t)b * TB;
        int nrow[9]; unsigned vmask = 0u;
#pragma unroll
        for (int i = 0; i < 3; ++i)
#pragma unroll
            for (int j = 0; j < 3; ++j) {
                int ns = -1;
                if (s < NCX) { const int w2 = s + j - 1; if (i == 1 && w2 >= 0 && w2 < NCX) ns = w2; }
                else { const int n = s - NCX, rr = (n >> 6) + i - 1, w2 = (n & 63) + j - 1; if (rr >= 0 && rr < 128 && w2 >= 0 && w2 < 64) ns = NCX + rr * 64 + w2; }
                nrow[i * 3 + j] = ns >= 0 ? ns : s; vmask |= (ns >= 0 ? 1u : 0u) << (i * 3 + j);
            }
        const int tt = wave & 3, part = wave >> 2;
        f32x4 acc = (f32x4){0.f, 0.f, 0.f, 0.f};
        uint4 xn[9];
#pragma unroll
        for (int tap = 0; tap < 9; ++tap) xn[tap] = *(const uint4*)(XM + (rowbase + nrow[tap]) * 2048 + q * 512 + cg * 8);
#pragma unroll 1
        for (int half = 0; half < 2; ++half) {
            __syncthreads();
            for (int i = tid; i < 640; i += NTHR) { const int tp = i >> 6, c4 = (i & 63) * 4; st4(cwl + tp * 256 + c4, ld4((tp < 9 ? cw + tp * 2048 : cbias) + q * 512 + half * 256 + c4)); }
            __syncthreads();
#pragma unroll 1
            for (int it = 0; it < 4; ++it) {
                const int cl = it * 64 + cg * 8, c0 = q * 512 + half * 256 + cl;
                uint4 xc9[9];
#pragma unroll
                for (int tap = 0; tap < 9; ++tap) xc9[tap] = xn[tap];
                { const int gn = half * 4 + it + 1, c0n = q * 512 + (gn < 8 ? gn : 7) * 64 + cg * 8;
#pragma unroll
                  for (int tap = 0; tap < 9; ++tap) xn[tap] = *(const uint4*)(XM + (rowbase + nrow[tap]) * 2048 + c0n); }
                float a8[8];
                { const float4 b0 = ld4(cwl + 9 * 256 + cl), b1 = ld4(cwl + 9 * 256 + cl + 4); a8[0] = b0.x; a8[1] = b0.y; a8[2] = b0.z; a8[3] = b0.w; a8[4] = b1.x; a8[5] = b1.y; a8[6] = b1.z; a8[7] = b1.w; }
#pragma unroll
                for (int tap = 0; tap < 9; ++tap) {
                    const unsigned mk = ((vmask >> tap) & 1u) ? 0xffffffffu : 0u;
                    const uint4 xv = make_uint4(xc9[tap].x & mk, xc9[tap].y & mk, xc9[tap].z & mk, xc9[tap].w & mk);
                    float x8[8]; unpack8(xv, x8);
                    const float4 w0 = ld4(cwl + tap * 256 + cl), w1 = ld4(cwl + tap * 256 + cl + 4);
                    a8[0] += x8[0] * w0.x; a8[1] += x8[1] * w0.y; a8[2] += x8[2] * w0.z; a8[3] += x8[3] * w0.w;
                    a8[4] += x8[4] * w1.x; a8[5] += x8[5] * w1.y; a8[6] += x8[6] * w1.z; a8[7] += x8[7] * w1.w;
                }
#pragma unroll
                for (int i = 0; i < 8; ++i) a8[i] = silu_f(a8[i]);
                const uint4 xcv = pack8(a8);
                *(uint4*)(XC + (rowbase + s) * 2048 + c0) = xcv;
                *(uint4*)(imgC + t * 264 + cl) = xcv;
                *(uint4*)(imgM + t * 264 + cl) = xc9[4];
            }
            __syncthreads();
            {
                const bf16_t* img = part ? imgM : imgC;
                const bf16_t* wrow = WFT + (size_t)(lane & 15) * 4096 + part * 2048 + q * 512 + half * 256 + (lane >> 4) * 8;
#pragma unroll
                for (int ks = 0; ks < 8; ++ks) acc = __builtin_amdgcn_mfma_f32_16x16x32_bf16(row_frag(img, 264, tt * 16, ks * 32, lane), *(const bf16x8*)(wrow + ks * 32), acc, 0, 0, 0);
            }
        }
        if (part == 1) {
#pragma unroll
            for (int r = 0; r < 4; ++r) red[(tt * 16 + (lane >> 4) * 4 + r) * 16 + (lane & 15)] = acc[r];
        }
        __syncthreads();
        if (part == 0) {
#pragma unroll
            for (int r = 0; r < 4; ++r) {
                const int tk = tt * 16 + (lane >> 4) * 4 + r;
                G16P[(((size_t)rowbase + c * 64 + tk) * 16 + (lane & 15)) * 4 + q] = acc[r] + red[tk * 16 + (lane & 15)];
            }
        }
    }
}

struct GateRaw { float4 a, f; };
DEV GateRaw gate_load(const Params& p, size_t row, int dir, int h) {
    const float* G16P = (const float*)(p.ws + OFF_G16P);
    GateRaw g; g.a = ld4(G16P + (row * 16 + dir * 8 + h) * 4); g.f = ld4(G16P + (row * 16 + dir * 8 + 4 + h) * 4);
    return g;
}
DEV void gate_fin(const GateRaw& g, float bi, float bf, float& gi, float& lf) {
    gi = (g.a.x + g.a.y) + (g.a.z + g.a.w) + bi;
    lf = logsig_f((g.f.x + g.f.y) + (g.f.z + g.f.w) + bf);
}
DEV void gate_pair(const Params& p, size_t row, int dir, int h, float& gi, float& lf) {
    const GateRaw g = gate_load(p, row, dir, h);
    gate_fin(g, p.in[dir ? 41 : 37][h], p.in[dir ? 43 : 39][h], gi, lf);
}

DEV void phase_x1(const Params& p, float* sm) {
    int chain, sub; chain_ids(chain, sub);
    const int b = chain >> 3, h = (chain >> 1) & 3, dir = chain & 1;
    const bf16_t* XC = (const bf16_t*)(p.ws + OFF_XC);
    float* GSC = (float*)(p.ws + OFF_GSC); float* CSC = (float*)(p.ws + OFF_CSC); float* NBUF = (float*)(p.ws + OFF_NBUF);
    const float* gtab = (const float*)(p.ws + OFF_GTAB);
    bf16_t* SMAT = (bf16_t*)(p.ws + OFF_SMAT);
    const int tid = opaque_tid(), lane = tid & 63, wave = tid >> 6;
    float* sTot = sm; float* sRef = sm + 132; float* sM0 = sm + 264; float* sBeta = sm + 400;
    const float bias_i = p.in[dir ? 41 : 37][h], bias_f = p.in[dir ? 43 : 39][h];
    {
        GateRaw gn = gate_load(p, (size_t)b * TB + wave * 64 + lane, dir, h);
        for (int c = wave; c < NCH; c += NWV) {
            const GateRaw gc = gn;
            const int cn = (c + NWV < NCH) ? c + NWV : c;
            gn = gate_load(p, (size_t)b * TB + cn * 64 + lane, dir, h);
            float gi, lf; gate_fin(gc, bias_i, bias_f, gi, lf);
            const float bc = wave_scan_add(lf, lane, dir);
            const float ref = wave_max(gi - bc), tot = wave_sum(lf);
            if (lane == 0) { sTot[c] = tot; sRef[c] = ref; }
        }
    }
    __syncthreads();
    if (tid == 0) {
        float m0 = -INFINITY;
        for (int step = 0; step < NCH; ++step) {
            const int c = chunk_at(dir, step);
            sM0[c] = m0;
            const float mx = fmaxf(m0, sRef[c]);
            if (sub == 0) { CSC[(chain * NCH + c) * 2] = fexp(m0 - mx); CSC[(chain * NCH + c) * 2 + 1] = fexp(sRef[c] - mx); }
            m0 = sTot[c] + mx;
        }
    }
    __syncthreads();
    for (int k = wave; sub + 16 * k < NCH; k += NWV) {
        const int c = sub + 16 * k;
        const size_t row = (size_t)b * TB + c * 64 + lane;
        float gi, lf; gate_fin(gate_load(p, row, dir, h), bias_i, bias_f, gi, lf);
        const float bc = wave_scan_add(lf, lane, dir);
        const float a = gi - bc;
        const float amax = wave_scan_max(a, lane, dir);
        const float ref = sRef[c], m0 = sM0[c];
        const float mmax = fmaxf(amax, m0);
        const float mt = bc + mmax;
        const float alpha = fexp(ref - mmax), beta = fexp(a - ref), gg = fexp(m0 - mmax), em = fexp(-mt);
        st4(GSC + ((size_t)chain * TB + c * 64 + lane) * 4, make_float4(alpha, beta, gg, em));
        sBeta[k * 64 + lane] = beta;
    }
    __syncthreads();
    {
        float* part = sm + 1024;
        const int sg = tid >> 6, j8 = (tid & 63) * 8;
        uint4 xn[8];
        { const bf16_t* xp = XC + ((size_t)b * TB + sub * 64 + sg * 8) * 2048 + h * 512 + j8;
#pragma unroll
          for (int s = 0; s < 8; ++s) xn[s] = *(const uint4*)(xp + (size_t)s * 2048); }
        for (int k = 0; sub + 16 * k < NCH; ++k) {
            const int c = sub + 16 * k;
            uint4 xcur[8];
#pragma unroll
            for (int s = 0; s < 8; ++s) xcur[s] = xn[s];
            { const int cn = (c + 16 < NCH) ? c + 16 : c; const bf16_t* xp = XC + ((size_t)b * TB + cn * 64 + sg * 8) * 2048 + h * 512 + j8;
#pragma unroll
              for (int s = 0; s < 8; ++s) xn[s] = *(const uint4*)(xp + (size_t)s * 2048); }
            float acc[8];
#pragma unroll
            for (int i = 0; i < 8; ++i) acc[i] = 0.f;
#pragma unroll
            for (int s = 0; s < 8; ++s) {
                float f[8]; unpack8(xcur[s], f);
                const float be = sBeta[k * 64 + sg * 8 + s];
#pragma unroll
                for (int i = 0; i < 8; ++i) acc[i] += be * f[i];
            }
            __syncthreads();
            st4(part + sg * 512 + j8, make_float4(acc[0], acc[1], acc[2], acc[3])); st4(part + sg * 512 + j8 + 4, make_float4(acc[4], acc[5], acc[6], acc[7]));
            __syncthreads();
            float tot = 0.f;
#pragma unroll
            for (int q = 0; q < 8; ++q) tot += part[q * 512 + tid];
            NBUF[((size_t)chain * NCH + c) * 512 + tid] = tot;
        }
    }
    bf16_t* XCs = (bf16_t*)sm;
    bf16_t* Qs = XCs + 64 * 520;
    for (int u = blockIdx.x; u < NB * 4 * NCH; u += gridDim.x) {
        const int bh = u / NCH, c = u % NCH, ub = bh >> 2, uh = bh & 3;
        __syncthreads();
        float4 gq[2][4];
#pragma unroll
        for (int bb = 0; bb < 2; ++bb) { const float* G = gtab + (size_t)(uh * 128 + (tid & 63) * 2 + bb) * 16; gq[bb][0] = ld4(G); gq[bb][1] = ld4(G + 4); gq[bb][2] = ld4(G + 8); gq[bb][3] = ld4(G + 12); }
        uint4 xr[8];
#pragma unroll
        for (int i = 0; i < 8; ++i) { const int pp = tid + 512 * i, row = pp >> 6, c16 = pp & 63; xr[i] = *(const uint4*)(XC + ((size_t)ub * TB + c * 64 + row) * 2048 + uh * 512 + c16 * 8); }
#pragma unroll
        for (int i = 0; i < 8; ++i) {
            const int pp = tid + 512 * i, row = pp >> 6, c16 = pp & 63;
            const uint4 xv = xr[i];
            float f[8]; unpack8(xv, f);
            float q[8];
#pragma unroll
            for (int bb = 0; bb < 2; ++bb) {
                const float4 g0 = gq[bb][0], g1 = gq[bb][1], g2 = gq[bb][2], g3 = gq[bb][3];
                q[bb * 4 + 0] = f[bb * 4] * g0.x + f[bb * 4 + 1] * g1.x + f[bb * 4 + 2] * g2.x + f[bb * 4 + 3] * g3.x;
                q[bb * 4 + 1] = f[bb * 4] * g0.y + f[bb * 4 + 1] * g1.y + f[bb * 4 + 2] * g2.y + f[bb * 4 + 3] * g3.y;
                q[bb * 4 + 2] = f[bb * 4] * g0.z + f[bb * 4 + 1] * g1.z + f[bb * 4 + 2] * g2.z + f[bb * 4 + 3] * g3.z;
                q[bb * 4 + 3] = f[bb * 4] * g0.w + f[bb * 4 + 1] * g1.w + f[bb * 4 + 2] * g2.w + f[bb * 4 + 3] * g3.w;
            }
            *(uint4*)(XCs + row * 520 + c16 * 8) = xv;
            *(uint4*)(Qs + row * 520 + c16 * 8) = make_uint4(pack2bf(q[0], q[1]), pack2bf(q[2], q[3]), pack2bf(q[4], q[5]), pack2bf(q[6], q[7]));
        }
        __syncthreads();
        const int st = wave & 3, tt0 = (wave >> 2) * 2;
        f32x4 a0 = (f32x4){0.f, 0.f, 0.f, 0.f}, a1 = a0;
        const bf16_t* ap = XCs + (st * 16 + (lane & 15)) * 520 + (lane >> 4) * 8;
        const bf16_t* bp0 = Qs + (tt0 * 16 + (lane & 15)) * 520 + (lane >> 4) * 8;
        const bf16_t* bp1 = bp0 + 16 * 520;
#pragma unroll
        for (int ks = 0; ks < 16; ++ks) {
            const bf16x8 af = *(const bf16x8*)(ap + ks * 32);
            a0 = __builtin_amdgcn_mfma_f32_16x16x32_bf16(af, *(const bf16x8*)(bp0 + ks * 32), a0, 0, 0, 0);
            a1 = __builtin_amdgcn_mfma_f32_16x16x32_bf16(af, *(const bf16x8*)(bp1 + ks * 32), a1, 0, 0, 0);
        }
        bf16_t* sp = SMAT + (size_t)u * 4096 + (size_t)(tt0 * 16 + (lane & 15)) * 64 + st * 16 + (lane >> 4) * 4;
        *(uint2*)sp = make_uint2(pack2bf(a0[0], a0[1]), pack2bf(a0[2], a0[3]));
        *(uint2*)(sp + 16 * 64) = make_uint2(pack2bf(a1[0], a1[1]), pack2bf(a1[2], a1[3]));
    }
}

DEV void phase_x2(const Params& p, float* sm) {
    int chain, sub; chain_ids(chain, sub);
    const int b = chain >> 3, h = (chain >> 1) & 3, dir = chain & 1;
    const bf16_t* XC = (const bf16_t*)(p.ws + OFF_XC);
    float* GSC = (float*)(p.ws + OFF_GSC); const float* CSC = (const float*)(p.ws + OFF_CSC); const float* NBUF = (const float*)(p.ws + OFF_NBUF);
    const float* gtab = (const float*)(p.ws + OFF_GTAB);
    const bf16_t* SMAT = (const bf16_t*)(p.ws + OFF_SMAT);
    const int tid = opaque_tid();
    float* sD0 = sm; float* sCf = sm + 132; float* sN0 = sm + 264; float* sN2 = sN0 + 9 * 512;
    for (int i = tid; i < NCH; i += NTHR) { sD0[i] = CSC[(chain * NCH + i) * 2]; sCf[i] = CSC[(chain * NCH + i) * 2 + 1]; }
    __syncthreads();
    float* sBeta = sN2 + 9 * 512;
    for (int i = tid; i < 9 * 64; i += NTHR) { const int k = i >> 6, c = sub + 16 * k; if (c < NCH) sBeta[i] = GSC[((size_t)chain * TB + c * 64 + (i & 63)) * 4 + 1]; }
    if (tid < 128) {
        constexpr int NBT = 12;
        float4 n = make_float4(0.f, 0.f, 0.f, 0.f), nx[NBT];
        const float* nb = NBUF + (size_t)chain * NCH * 512 + tid * 4;
#pragma unroll
        for (int j = 0; j < NBT; ++j) nx[j] = ld4(nb + (size_t)chunk_at(dir, j) * 512);
#pragma unroll 1
        for (int step0 = 0; step0 < NCH; step0 += NBT) {
            float4 cu[NBT];
#pragma unroll
            for (int j = 0; j < NBT; ++j) cu[j] = nx[j];
#pragma unroll
            for (int j = 0; j < NBT; ++j) { const int sn = step0 + NBT + j; nx[j] = ld4(nb + (size_t)chunk_at(dir, sn < NCH ? sn : NCH - 1) * 512); }
            __builtin_amdgcn_sched_barrier(0);
#pragma unroll
            for (int j = 0; j < NBT; ++j) {
                const int c = chunk_at(dir, step0 + j);
                if ((c & 15) == sub) st4(sN0 + (c >> 4) * 512 + tid * 4, n);
                const float d = sD0[c], cf = sCf[c];
                n = make_float4(d * n.x + cf * cu[j].x, d * n.y + cf * cu[j].y, d * n.z + cf * cu[j].z, d * n.w + cf * cu[j].w);
            }
        }
    }
    __syncthreads();
    {
        const int blk = tid >> 2, cp = tid & 3;
        const float4 g = ld4(gtab + (size_t)(h * 128 + blk) * 16 + cp * 4);
        for (int k = 0; sub + 16 * k < NCH; ++k) {
            const float* n0 = sN0 + k * 512 + blk * 4;
            sN2[k * 512 + tid] = g.x * n0[0] + g.y * n0[1] + g.z * n0[2] + g.w * n0[3];
        }
    }
    __syncthreads();
    const int t = tid >> 3, part = tid & 7;
    for (int k = 0; sub + 16 * k < NCH; ++k) {
        const int c = sub + 16 * k;
        const size_t row = (size_t)b * TB + c * 64 + t;
        float dint = 0.f;
        {
            const bf16_t* xp = XC + row * 2048 + h * 512 + part * 64;
            const float* n2 = sN2 + k * 512 + part * 64;
#pragma unroll
            for (int i = 0; i < 8; ++i) {
                float f[8]; unpack8(*(const uint4*)(xp + i * 8), f);
                const float4 na = ld4(n2 + i * 8), nb2 = ld4(n2 + i * 8 + 4);
                dint += f[0] * na.x + f[1] * na.y + f[2] * na.z + f[3] * na.w + f[4] * nb2.x + f[5] * nb2.y + f[6] * nb2.z + f[7] * nb2.w;
            }
        }
        float di = 0.f;
        {
            float f[8]; unpack8(*(const uint4*)(SMAT + ((size_t)((b * 4 + h) * NCH + c)) * 4096 + t * 64 + part * 8), f);
#pragma unroll
            for (int e = 0; e < 8; ++e) {
                const int s = part * 8 + e;
                const float beta = sBeta[k * 64 + s];
                const bool keep = dir ? (s >= t) : (s <= t);
                di += keep ? f[e] * beta : 0.f;
            }
        }
        dint += __shfl_xor(dint, 1, 64); dint += __shfl_xor(dint, 2, 64); dint += __shfl_xor(dint, 4, 64);
        di += __shfl_xor(di, 1, 64); di += __shfl_xor(di, 2, 64); di += __shfl_xor(di, 4, 64);
        if (part == 0) {
            float* gp = GSC + ((size_t)chain * TB + c * 64 + t) * 4;
            const float4 g4 = ld4(gp);
            const float den = g4.x * di + g4.z * dint;
            gp[3] = 1.f / fmaxf(fabsf(den), g4.w);
        }
    }
}

#define MLSTM_PREFETCH(step_) do { \
    const int c_ = chunk_at(dir, (step_)); const size_t rb_ = (size_t)b * TB + (size_t)c_ * 64; \
    { const bf16_t* xb_ = XC + (rb_ + (tid >> 6)) * 2048 + h * 512 + (tid & 63) * 8; \
      rx0 = *(const uint4*)(xb_); rx1 = *(const uint4*)(xb_ + 8 * 2048); rx2 = *(const uint4*)(xb_ + 16 * 2048); rx3 = *(const uint4*)(xb_ + 24 * 2048); \
      rx4 = *(const uint4*)(xb_ + 32 * 2048); rx5 = *(const uint4*)(xb_ + 40 * 2048); rx6 = *(const uint4*)(xb_ + 48 * 2048); rx7 = *(const uint4*)(xb_ + 56 * 2048); } \
    rxm = *(const uint2*)(XM + (rb_ + ps) * 2048 + ch0 + pvb * 4); \
    rs = *(const uint4*)(SMAT + ((size_t)((b * 4 + h) * NCH + c_)) * 4096 + ps * 64 + pvb * 8); \
    rbeta = GSC[((size_t)chain * TB + c_ * 64 + ps) * 4 + 1]; \
    if (tid < 64) rsc = ld4(GSC + ((size_t)chain * TB + c_ * 64 + tid) * 4); \
    rd0 = CSC[(chain * NCH + c_) * 2]; rcf = CSC[(chain * NCH + c_) * 2 + 1]; } while (0)

DEV void phase_mlstm(const Params& p, float* sm) {
    int chain, sub; chain_ids(chain, sub);
    const int b = chain >> 3, h = (chain >> 1) & 3, dir = chain & 1;
    const bf16_t* XM = (const bf16_t*)(p.ws + OFF_XM);
    const bf16_t* XC = (const bf16_t*)(p.ws + OFF_XC);
    const bf16_t* SMAT = (const bf16_t*)(p.ws + OFF_SMAT);
    const float* GSC = (const float*)(p.ws + OFF_GSC); const float* CSC = (const float*)(p.ws + OFF_CSC);
    const float* gtab = (const float*)(p.ws + OFF_GTAB);
    bf16_t* H = (bf16_t*)(p.ws + OFF_H);
    const float* wv = p.in[35];
    char* smc = (char*)sm;
    bf16_t* XCs = (bf16_t*)smc;
    bf16_t* Cs = (bf16_t*)(smc + 66560);
    bf16_t* Vb = (bf16_t*)(smc + 66560 + 33280);
    bf16_t* Vw = Vb + 32 * 72;
    bf16_t* Sm = Vw + 32 * 72;
    float* Gs = (float*)(smc + 66560 + 33280 + 2 * 4608 + 9216);
    float* sc = Gs + 2048;
    const int tid = opaque_tid(), lane = tid & 63, wave = tid >> 6;
    for (int i = tid; i < 32 * 520 / 2; i += NTHR) ((unsigned*)Cs)[i] = 0u;
    for (int i = tid; i < 2048; i += NTHR) Gs[i] = gtab[h * 2048 + i];
    const int ps = tid >> 3, pvb = tid & 7;
    const int ch0 = h * 512 + sub * 32;
    float wvr[16];
#pragma unroll
    for (int i = 0; i < 16; ++i) wvr[i] = wv[(size_t)((ch0 >> 2) + pvb) * 16 + i];
    f32x4 accS[4][2];
#pragma unroll
    for (int i = 0; i < 4; ++i) { accS[i][0] = (f32x4){0.f, 0.f, 0.f, 0.f}; accS[i][1] = (f32x4){0.f, 0.f, 0.f, 0.f}; }
    uint4 rx0, rx1, rx2, rx3, rx4, rx5, rx6, rx7; uint2 rxm; uint4 rs; float rbeta; float4 rsc = make_float4(0.f, 0.f, 0.f, 0.f); float rd0, rcf;
    MLSTM_PREFETCH(0);
    __syncthreads();
#pragma unroll 1
    for (int step = 0; step < NCH; ++step) {
        const int c = chunk_at(dir, step);
        const float d0 = rd0, cf = rcf;
        {
            bf16_t* xd = XCs + (tid >> 6) * 520 + (tid & 63) * 8;
            *(uint4*)(xd) = rx0; *(uint4*)(xd + 8 * 520) = rx1; *(uint4*)(xd + 16 * 520) = rx2; *(uint4*)(xd + 24 * 520) = rx3;
            *(uint4*)(xd + 32 * 520) = rx4; *(uint4*)(xd + 40 * 520) = rx5; *(uint4*)(xd + 48 * 520) = rx6; *(uint4*)(xd + 56 * 520) = rx7;
        }
        {
            const float x0 = bflo(rxm.x), x1 = bfhi(rxm.x), x2 = bflo(rxm.y), x3 = bfhi(rxm.y);
#pragma unroll
            for (int d = 0; d < 4; ++d) {
                const float v = (x0 * wvr[d] + x1 * wvr[4 + d] + x2 * wvr[8 + d] + x3 * wvr[12 + d]) * rbeta;
                Vb[(pvb * 4 + d) * 72 + ps] = __builtin_bit_cast(unsigned short, (__bf16)v);
                Vw[(pvb * 4 + d) * 72 + ps] = __builtin_bit_cast(unsigned short, (__bf16)(v * cf));
            }
        }
        {
#define SMASK(q_) (((dir ? (pvb * 8 + 2 * (q_) >= ps) : (pvb * 8 + 2 * (q_) <= ps)) ? 0x0000ffffu : 0u) | ((dir ? (pvb * 8 + 2 * (q_) + 1 >= ps) : (pvb * 8 + 2 * (q_) + 1 <= ps)) ? 0xffff0000u : 0u))
            *(uint4*)(Sm + ps * 72 + pvb * 8) = make_uint4(rs.x & SMASK(0), rs.y & SMASK(1), rs.z & SMASK(2), rs.w & SMASK(3));
#undef SMASK
        }
        if (tid < 64) st4(sc + tid * 4, rsc);
        { const int nstep = (step + 1 < NCH) ? step + 1 : step; MLSTM_PREFETCH(nstep); }
        __syncthreads();
        {
            const int vt = wave & 1, tt = wave >> 1;
            f32x4 ao = (f32x4){0.f, 0.f, 0.f, 0.f}, ai = ao, ao1 = ao, ao2 = ao, ao3 = ao;
            const bf16_t* ap = Cs + (vt * 16 + (lane & 15)) * 520 + (lane >> 4) * 8;
            const bf16_t* bp = XCs + (tt * 16 + (lane & 15)) * 520 + (lane >> 4) * 8;
#pragma unroll
            for (int ks = 0; ks < 16; ks += 4) {
                ao = __builtin_amdgcn_mfma_f32_16x16x32_bf16(*(const bf16x8*)(ap + ks * 32), *(const bf16x8*)(bp + ks * 32), ao, 0, 0, 0);
                ao1 = __builtin_amdgcn_mfma_f32_16x16x32_bf16(*(const bf16x8*)(ap + (ks + 1) * 32), *(const bf16x8*)(bp + (ks + 1) * 32), ao1, 0, 0, 0);
                ao2 = __builtin_amdgcn_mfma_f32_16x16x32_bf16(*(const bf16x8*)(ap + (ks + 2) * 32), *(const bf16x8*)(bp + (ks + 2) * 32), ao2, 0, 0, 0);
                ao3 = __builtin_amdgcn_mfma_f32_16x16x32_bf16(*(const bf16x8*)(ap + (ks + 3) * 32), *(const bf16x8*)(bp + (ks + 3) * 32), ao3, 0, 0, 0);
            }
            ao = (ao + ao1) + (ao2 + ao3);
            const bf16_t* ap2 = Vb + (vt * 16 + (lane & 15)) * 72 + (lane >> 4) * 8;
            const bf16_t* bp2 = Sm + (tt * 16 + (lane & 15)) * 72 + (lane >> 4) * 8;
#pragma unroll
            for (int ks = 0; ks < 2; ++ks) ai = __builtin_amdgcn_mfma_f32_16x16x32_bf16(*(const bf16x8*)(ap2 + ks * 32), *(const bf16x8*)(bp2 + ks * 32), ai, 0, 0, 0);
            if (c >= 4) {
                const int t = tt * 16 + (lane & 15);
                const float4 s4 = ld4(sc + t * 4);
                const float h0 = (s4.x * ai[0] + s4.z * ao[0]) * s4.w, h1 = (s4.x * ai[1] + s4.z * ao[1]) * s4.w;
                const float h2 = (s4.x * ai[2] + s4.z * ao[2]) * s4.w, h3 = (s4.x * ai[3] + s4.z * ao[3]) * s4.w;
                bf16_t* hp = H + ((size_t)b * NL + (size_t)c * 64 + t - NCX) * 2048 + ch0 + vt * 16 + (lane >> 4) * 4;
                const unsigned u0 = pack2bf(h0, h1), u1 = pack2bf(h2, h3);
                __builtin_amdgcn_global_atomic_fadd_v2bf16((__attribute__((address_space(1))) s16x2*)hp, __builtin_bit_cast(s16x2, u0));
                __builtin_amdgcn_global_atomic_fadd_v2bf16((__attribute__((address_space(1))) s16x2*)(hp + 2), __builtin_bit_cast(s16x2, u1));
            }
        }
#pragma unroll
        for (int jt = 0; jt < 4; ++jt) { accS[jt][0] *= d0; accS[jt][1] *= d0; }
#pragma unroll
        for (int ks = 0; ks < 2; ++ks) {
            const bf16x8 b0 = *(const bf16x8*)(Vw + (lane & 15) * 72 + ks * 32 + (lane >> 4) * 8);
            const bf16x8 b1 = *(const bf16x8*)(Vw + (16 + (lane & 15)) * 72 + ks * 32 + (lane >> 4) * 8);
            const int row0 = ks * 32 + (lane >> 4) * 8 + ((lane & 15) >> 2);
#pragma unroll
            for (int jt = 0; jt < 4; ++jt) {
                const int col = wave * 64 + jt * 16 + (lane & 3) * 4;
                const s16x4 lo = __builtin_amdgcn_ds_read_tr16_b64_v4i16((__attribute__((address_space(3))) s16x4*)(XCs + row0 * 520 + col));
                const s16x4 hi = __builtin_amdgcn_ds_read_tr16_b64_v4i16((__attribute__((address_space(3))) s16x4*)(XCs + (row0 + 4) * 520 + col));
                const bf16x8 af = (bf16x8){lo[0], lo[1], lo[2], lo[3], hi[0], hi[1], hi[2], hi[3]};
                accS[jt][0] = __builtin_amdgcn_mfma_f32_16x16x32_bf16(af, b0, accS[jt][0], 0, 0, 0);
                accS[jt][1] = __builtin_amdgcn_mfma_f32_16x16x32_bf16(af, b1, accS[jt][1], 0, 0, 0);
            }
        }
        __syncthreads();
#pragma unroll
        for (int jt = 0; jt < 4; ++jt) {
            const int blk = wave * 16 + jt * 4 + (lane >> 4);
            const float4 g0 = ld4(Gs + blk * 16), g1 = ld4(Gs + blk * 16 + 4), g2 = ld4(Gs + blk * 16 + 8), g3 = ld4(Gs + blk * 16 + 12);
#pragma unroll
            for (int v2 = 0; v2 < 2; ++v2) {
                const f32x4 a = accS[jt][v2];
                const float o0 = g0.x * a[0] + g0.y * a[1] + g0.z * a[2] + g0.w * a[3];
                const float o1 = g1.x * a[0] + g1.y * a[1] + g1.z * a[2] + g1.w * a[3];
                const float o2 = g2.x * a[0] + g2.y * a[1] + g2.z * a[2] + g2.w * a[3];
                const float o3 = g3.x * a[0] + g3.y * a[1] + g3.z * a[2] + g3.w * a[3];
                *(uint2*)(Cs + (v2 * 16 + (lane & 15)) * 520 + blk * 4) = make_uint2(pack2bf(o0, o1), pack2bf(o2, o3));
            }
        }
    }
}

DEV void phase_finish1(const Params& p) {
    bf16_t* H = (bf16_t*)(p.ws + OFF_H);
    const bf16_t* XC = (const bf16_t*)(p.ws + OFF_XC);
    const bf16_t* Z = (const bf16_t*)(p.ws + OFF_XM);
    const float* ng = p.in[44]; const float* skip = p.in[45];
    const int tid_ = opaque_tid(); const int lane = tid_ & 63, gw = blockIdx.x * NWV + (tid_ >> 6), ngw = gridDim.x * NWV;
    const int h = gw & 3, c0 = h * 512 + lane * 8;
    float gn8[8], sk8[8];
    { const float4 a0 = ld4(ng + c0), a1 = ld4(ng + c0 + 4), b0 = ld4(skip + c0), b1 = ld4(skip + c0 + 4);
      gn8[0] = a0.x; gn8[1] = a0.y; gn8[2] = a0.z; gn8[3] = a0.w; gn8[4] = a1.x; gn8[5] = a1.y; gn8[6] = a1.z; gn8[7] = a1.w;
      sk8[0] = b0.x; sk8[1] = b0.y; sk8[2] = b0.z; sk8[3] = b0.w; sk8[4] = b1.x; sk8[5] = b1.y; sk8[6] = b1.z; sk8[7] = b1.w; }
    constexpr int NIT = NB * NL * 4;
    uint4 nh[2], nx[2], nz[2];
#pragma unroll
    for (int u = 0; u < 2; ++u) { const int it = gw + u * ngw, r = (it < NIT ? it : gw) >> 2, b = r >= NL ? 1 : 0, nn = r - b * NL;
        nh[u] = *(const uint4*)(H + (size_t)r * 2048 + c0); nx[u] = *(const uint4*)(XC + ((size_t)b * TB + NCX + nn) * 2048 + c0); nz[u] = *(const uint4*)(Z + (size_t)r * 2048 + c0); }
    for (int it0 = gw; it0 < NIT; it0 += 2 * ngw) {
        uint4 ch[2], cx[2], cz[2];
#pragma unroll
        for (int u = 0; u < 2; ++u) { ch[u] = nh[u]; cx[u] = nx[u]; cz[u] = nz[u]; }
#pragma unroll
        for (int u = 0; u < 2; ++u) { const int it = it0 + (2 + u) * ngw, r = (it < NIT ? it : gw) >> 2, b = r >= NL ? 1 : 0, nn = r - b * NL;
            nh[u] = *(const uint4*)(H + (size_t)r * 2048 + c0); nx[u] = *(const uint4*)(XC + ((size_t)b * TB + NCX + nn) * 2048 + c0); nz[u] = *(const uint4*)(Z + (size_t)r * 2048 + c0); }
#pragma unroll
        for (int u = 0; u < 2; ++u) {
            const int it = it0 + u * ngw, r = it >> 2;
            float v[8]; unpack8(ch[u], v);
            float sum = 0.f;
#pragma unroll
            for (int j = 0; j < 8; ++j) sum += v[j];
            const float mean = wave_sum(sum) * (1.f / 512.f);
            float sq = 0.f;
#pragma unroll
            for (int j = 0; j < 8; ++j) { v[j] -= mean; sq += v[j] * v[j]; }
            const float rstd = rsqrtf(wave_sum(sq) * (1.f / 512.f) + 1e-5f);
            float xc[8], z[8];
            unpack8(cx[u], xc); unpack8(cz[u], z);
            float o[8];
#pragma unroll
            for (int j = 0; j < 8; ++j) o[j] = (v[j] * rstd * gn8[j] + sk8[j] * xc[j]) * silu_f(z[j]);
            if (it < NIT) *(uint4*)(H + (size_t)r * 2048 + c0) = make_uint4(pack2bf(o[0], o[1]), pack2bf(o[2], o[3]), pack2bf(o[4], o[5]), pack2bf(o[6], o[7]));
        }
    }
}

__global__ void __launch_bounds__(NTHR) fwd_kernel(Params p) {
    extern __shared__ __attribute__((aligned(16))) float sm[];
    volatile LAS unsigned* xst = (volatile LAS unsigned*)((LAS char*)sm + (LDS_BYTES - 16));
    if (threadIdx.x == 0) { xst[0] = 0u; xst[1] = 0u; }
    __syncthreads();
    const XcdBarrier xbar = xcd_barrier_post((unsigned*)(p.ws + OFF_BAR), xst);
    const int tid = opaque_tid(), lane = tid & 63, wave = tid >> 6;
    float* modv = (float*)(p.ws + OFF_MODV);
    float* X1C = (float*)(p.ws + OFF_X1C);

    phase_mod(p, sm);
    phase_tables(p);
    transpose_convert(p.in[8], 1024, EIN, 4096, (bf16_t*)(p.ws + OFF_WT0), sm);
    transpose_convert(p.in[29], 1024, 4096, 4096, (bf16_t*)(p.ws + OFF_WT1), sm);
    transpose_convert(p.in[9], 1024, 1024, 1024, (bf16_t*)(p.ws + OFF_WT2), sm);
    transpose_convert(p.in[30], 2048, 1024, 1024, (bf16_t*)(p.ws + OFF_WT3), sm);
    xcd_barrier(xbar);

#pragma unroll 1
    for (int b = 0; b < NB; ++b) {
        if (b == 0) { phase_h0(p, 0); xcd_barrier(xbar); }
        run_gemm((const bf16_t*)(p.ws + OFF_YC), (const bf16_t*)(p.ws + OFF_WT0), TB, 4096, DM, EpBf16{(bf16_t*)(p.ws + OFF_P0), EIN, EIN}, sm);
        xcd_barrier(xbar);
        {
            const int x = blockIdx.x & 7, q0 = blockIdx.x >> 3;
            R1Raw R;
            r1_consts(p, x, q0 & 1, sm);
            r1_load(p, x, q0 & 1, q0 >> 1, R);
            for (int q = q0; q < 3 * NCH; q += 32) {
                if (q < 2 * NCH) rwkv1_unit(p, x, q & 1, q >> 1, sm, R, (q + 32 < 2 * NCH) ? ((q + 32) >> 1) : -1);
                else { const int q2 = q - 2 * NCH; gla1_unit(p, x >> 1, q2 & 1, (NCH / 2) * (x & 1) + (q2 >> 1), sm); }
            }
        }
        xcd_barrier(xbar);
        if (blockIdx.x < 128) gla2_unit(p, blockIdx.x);
        else if (blockIdx.x < 192) rwkv2_unit(p, (blockIdx.x - 128) >> 2, (blockIdx.x - 128) & 3, sm);
        xcd_barrier(xbar);
        for (int q = blockIdx.x >> 3; q < NCH + NCH / 2; q += 32) {
            const int x = blockIdx.x & 7;
            if (q < NCH) rwkv3_unit(p, x, q, sm);
            else gla3_unit(p, x >> 1, (NCH / 2) * (x & 1) + (q - NCH), sm);
        }
        xcd_barrier(xbar);
        run_gemm((const bf16_t*)(p.ws + OFF_YC), (const bf16_t*)(p.ws + OFF_WT2), TB, DM, DM, EpRes0{(float*)(p.ws + OFF_P0), modv, b}, sm);
        xcd_barrier(xbar);
        ln_rows((const float*)(p.ws + OFF_P0), p.in[0] + (size_t)b * NL * DM, p.in[2] + (size_t)b * NCX * DM, TB, p.in[6], p.in[7], p.out + (size_t)b * NL * DM, X1C + (size_t)b * NCX * DM, NCX,
                (bf16_t*)(p.ws + OFF_H1B) + (size_t)b * TB * DM, modv + (3 + 2) * 3072, modv + (3 + b) * 3072);
        if (b == 0) phase_h0(p, 1);
        xcd_barrier(xbar);
    }

    run_gemm((const bf16_t*)(p.ws + OFF_H1B), (const bf16_t*)(p.ws + OFF_WT1), RT, 2048, DM, EpBf16{(bf16_t*)(p.ws + OFF_XM), 2048, 2048}, sm);
    zero_f4((float*)(p.ws + OFF_H), (size_t)NB * NL * 1024);
    xcd_barrier(xbar);
    phase_conv1(p, sm);
    xcd_barrier(xbar);
    phase_x1(p, sm);
    xcd_barrier(xbar);
    phase_x2(p, sm);
    xcd_barrier(xbar);
    phase_mlstm(p, sm);
    xcd_barrier(xbar);
    phase_h1l(p);
    xcd_barrier(xbar);
    run_gemm((const bf16_t*)(p.ws + OFF_H1B), (const bf16_t*)(p.ws + OFF_WT1) + (size_t)2048 * 1024, NB * NL, 2048, DM, EpBf16{(bf16_t*)(p.ws + OFF_XM), 2048, 2048}, sm);
    xcd_barrier(xbar);
    phase_finish1(p);
    xcd_barrier(xbar);
    run_gemm((const bf16_t*)(p.ws + OFF_H), (const bf16_t*)(p.ws + OFF_WT3), NB * NL, DM, 2048, EpRes1{(float*)(p.ws + OFF_XC), modv + 3 * 3072}, sm);
    xcd_barrier(xbar);
    ln_rows((const float*)(p.ws + OFF_XC), p.out, p.out, NB * NL, p.in[6] + 1024, p.in[7] + 1024, p.out, p.out, 0);
}

extern "C" void kernel_launch(void* const* d_in, const int* in_sizes, int n_in, void* d_out, int out_size, void* d_ws, size_t ws_size, hipStream_t stream) {
    static int grid_blocks = 0;
    if (grid_blocks == 0) {
        if (ws_size < WS_NEED || n_in != 46) { fprintf(stderr, "kernel_launch: bad ws_size %zu (need %zu) or n_in %d\n", ws_size, (size_t)WS_NEED, n_in); grid_blocks = -1; return; }
        int dev = 0, cus = 0, per_cu = 0;
        (void)hipGetDevice(&dev);
        (void)hipDeviceGetAttribute(&cus, hipDeviceAttributeMultiprocessorCount, dev);
        (void)hipFuncSetAttribute((const void*)fwd_kernel, hipFuncAttributeMaxDynamicSharedMemorySize, LDS_BYTES);
        (void)hipOccupancyMaxActiveBlocksPerMultiprocessor(&per_cu, (const void*)fwd_kernel, NTHR, LDS_BYTES);
        if (per_cu < 1 || cus < 256) { fprintf(stderr, "kernel_launch: occupancy query says %d blocks/CU on %d CUs; this kernel needs 256 resident workgroups\n", per_cu, cus); grid_blocks = -1; return; }
        grid_blocks = 256;
    }
    if (grid_blocks < 0) return;
    (void)hipMemsetAsync((char*)d_ws + OFF_BAR, 0, XCD_BAR_WORDS * 4, stream);
    Params p{};
    for (int i = 0; i < 46; ++i) p.in[i] = (const float*)d_in[i];
    p.out = (float*)d_out; p.ws = (char*)d_ws;
    void* args[] = {&p};
    hipError_t e = hipLaunchCooperativeKernel((const void*)fwd_kernel, dim3(grid_blocks), dim3(NTHR), args, LDS_BYTES, stream);
    if (e != hipSuccess) fprintf(stderr, "cooperative launch failed: %s (grid %d)\n", hipGetErrorString(e), grid_blocks);
}
```

```cpp
#include <hip/hip_runtime.h>
#include <cstdio>
#include <cmath>

#define DEV __device__ __forceinline__

constexpr int NB = 2, NL = 8192, DM = 1024, NCX = 256, TB = NCX + NL;
constexpr int RT = NB * TB;
constexpr int NCH = TB / 64;
constexpr int EIN = 3872, RW0 = 1568;
constexpr int NTHR = 512, NWV = 8;
constexpr float ALPHA = 1.41421356237f;
constexpr float KSCALE = 0.04419417382f;

constexpr size_t OFF_MODV = 0;
constexpr size_t OFF_X1C  = 131072;
constexpr size_t OFF_BAR  = 3145728;
constexpr size_t OFF_BIG  = 4194304;
constexpr size_t OFF_P0   = OFF_BIG;
constexpr size_t OFF_YC   = OFF_BIG + (size_t)TB * EIN * 2;
constexpr size_t OFF_GDS  = OFF_YC + (size_t)TB * 1024 * 2;
constexpr size_t OFF_GDEC = OFF_GDS + (size_t)8 * NCH * 8192 * 4;
constexpr size_t OFF_RU   = OFF_GDEC + (size_t)8 * NCH * 64 * 4;
constexpr size_t OFF_RS0  = OFF_RU + (size_t)16 * NCH * 16384 * 2;
constexpr size_t OFF_BONS = OFF_RS0 + (size_t)16 * NCH * 4096 * 2;
constexpr size_t L0_END   = OFF_BONS + (size_t)2 * TB * 8 * 4;
constexpr size_t OFF_XM   = OFF_BIG;
constexpr size_t OFF_XC   = OFF_XM + (size_t)RT * 2048 * 2;
constexpr size_t OFF_H    = OFF_XC + (size_t)RT * 2048 * 2;
constexpr size_t OFF_WT0  = OFF_H + (size_t)NB * NL * 2048 * 2;
constexpr size_t OFF_WT1  = OFF_WT0 + (size_t)4096 * 1024 * 2;
constexpr size_t OFF_WT2  = OFF_WT1 + (size_t)4096 * 1024 * 2;
constexpr size_t OFF_WT3  = OFF_WT2 + (size_t)1024 * 1024 * 2;
constexpr size_t OFF_G16  = OFF_WT3 + (size_t)1024 * 2048 * 2;
constexpr size_t OFF_SMAT = OFF_G16 + (size_t)RT * 16 * 4;
constexpr size_t OFF_GSC  = OFF_SMAT + (size_t)NB * 4 * NCH * 4096 * 2;
constexpr size_t OFF_CSC  = OFF_GSC + (size_t)16 * TB * 4 * 4;
constexpr size_t OFF_NBUF = OFF_CSC + (size_t)16 * NCH * 2 * 4;
constexpr size_t OFF_GTAB = 3407872;
constexpr size_t OFF_WFT  = OFF_GTAB + (size_t)4 * 128 * 16 * 4;
static_assert(OFF_WFT + (size_t)16 * 4096 * 2 <= OFF_BIG, "low-region tables overflow");
constexpr size_t OFF_G16P = OFF_NBUF + (size_t)16 * NCH * 512 * 4;
constexpr size_t OFF_H1B  = OFF_G16;
constexpr size_t WS_NEED  = (OFF_G16P + (size_t)4 * RT * 16 * 4 > OFF_H1B + (size_t)RT * 1024 * 2) ? OFF_G16P + (size_t)4 * RT * 16 * 4 : OFF_H1B + (size_t)RT * 1024 * 2;
static_assert(WS_NEED <= (size_t)256 * 1024 * 1024, "workspace exceeds the guaranteed 256 MiB");

static_assert(L0_END <= OFF_WT0, "layer-0 buffers overlap the weight copies");
constexpr int LDS_BYTES = 139264;

struct Params { const float* in[46]; float* out; char* ws; };
typedef unsigned short bf16_t;
typedef __attribute__((ext_vector_type(8))) short bf16x8;
typedef __attribute__((ext_vector_type(4))) short s16x4;
typedef __attribute__((ext_vector_type(2))) short s16x2;
typedef __attribute__((ext_vector_type(4))) float f32x4;
typedef __attribute__((ext_vector_type(2))) __bf16 bf2_t;
DEV unsigned pack2bf(float lo, float hi) { bf2_t v; v[0] = (__bf16)lo; v[1] = (__bf16)hi; return __builtin_bit_cast(unsigned, v); }
DEV float bflo(unsigned u) { return __uint_as_float(u << 16); }
DEV float bfhi(unsigned u) { return __uint_as_float(u & 0xffff0000u); }
DEV float bf2f(bf16_t v) { return __uint_as_float(((unsigned)v) << 16); }
DEV void unpack8(uint4 u, float* f) { f[0] = bflo(u.x); f[1] = bfhi(u.x); f[2] = bflo(u.y); f[3] = bfhi(u.y); f[4] = bflo(u.z); f[5] = bfhi(u.z); f[6] = bflo(u.w); f[7] = bfhi(u.w); }

DEV float wave_sum(float v) {
#pragma unroll
    for (int o = 32; o > 0; o >>= 1) v += __shfl_xor(v, o, 64);
    return v;
}
DEV float wave_max(float v) {
#pragma unroll
    for (int o = 32; o > 0; o >>= 1) v = fmaxf(v, __shfl_xor(v, o, 64));
    return v;
}
DEV float fexp(float x) { return __expf(x); }
DEV float frcp(float x) { return __builtin_amdgcn_rcpf(x); }
DEV float sigmoid_f(float x) { return frcp(1.f + fexp(-x)); }
DEV float silu_f(float x) { return x * frcp(1.f + fexp(-x)); }
DEV float logsig_f(float x) { return fminf(x, 0.f) - __logf(1.f + fexp(-fabsf(x))); }
DEV float tanh_f(float x) { const float e = fexp(2.f * x); return 1.f - 2.f * frcp(e + 1.f); }
DEV void lds_fence() { asm volatile("" ::: "memory"); }
DEV int opaque_tid() { int t = threadIdx.x; asm volatile("" : "+v"(t)); return t; }
DEV int scan_s(int dir, int u) { return dir == 0 ? u : (u < NCX ? (NCX - 1 - u) : (TB - 1 + NCX - u)); }
DEV int chunk_at(int dir, int step) { return dir == 0 ? step : (step < 4 ? 3 - step : (NCH + 3 - step)); }
DEV float4 ld4(const float* p) { return *(const float4*)p; }
DEV void st4(float* p, float4 v) { *(float4*)p = v; }


#define XB_TMO      128
#define XB_XCNT(j)  (256  + 64 * (j))
#define XB_XSUB(j)  (1280 + 64 * (j))
#define XB_XGEN(j)  (2304 + 64 * (j))
#define XB_TOP      3328
#define XB_TOPGEN   3392
#define XCD_BAR_WORDS 3456
#define XB_SPIN_CAP (1u << 22)
#define LAS __attribute__((address_space(3)))
DEV unsigned xb_ld(unsigned* p) { return __hip_atomic_load(p, __ATOMIC_RELAXED, __HIP_MEMORY_SCOPE_AGENT); }
DEV unsigned xb_add(unsigned* p, unsigned v) { return __hip_atomic_fetch_add(p, v, __ATOMIC_RELAXED, __HIP_MEMORY_SCOPE_AGENT); }
DEV unsigned xb_xcc_id() { return (unsigned)__builtin_amdgcn_s_getreg((3 << 11) | 20) & 0xFu; }
#define XB_SPIN(cond, bar) do { unsigned _sp = 0; while (cond) { __builtin_amdgcn_s_sleep(1); \
    if ((++_sp & 255u) == 0u) { if (xb_ld(&(bar)[XB_TMO])) break; if (_sp > XB_SPIN_CAP) { atomicAdd(&(bar)[XB_TMO], 1u); break; } } } } while (0)
struct XcdBarrier { unsigned* bar; unsigned x; volatile LAS unsigned* st; };
DEV XcdBarrier xcd_barrier_post(unsigned* bar, volatile LAS unsigned* st) {
    XcdBarrier b; b.bar = bar; b.x = xb_xcc_id(); b.st = st;
    if (threadIdx.x == 0) (void)xb_add(&bar[XB_XCNT(b.x)], 1u);
    return b;
}
DEV void xcd_barrier_complete(unsigned* bar, unsigned x, unsigned& nloc, unsigned& nx) {
    const unsigned G = gridDim.x * gridDim.y * gridDim.z;
    unsigned sum, cnt, mine, sp = 0u;
    for (;;) {
        sum = 0u; cnt = 0u; mine = 0u;
#pragma unroll
        for (unsigned j = 0; j < 16; ++j) { const unsigned c = xb_ld(&bar[XB_XCNT(j)]); sum += c; cnt += (c > 0u) ? 1u : 0u; mine = (j == x) ? c : mine; }
        if (sum == G) break;
        __builtin_amdgcn_s_sleep(1);
        if ((++sp & 255u) == 0u) { if (xb_ld(&bar[XB_TMO])) break; if (sp > XB_SPIN_CAP) { atomicAdd(&bar[XB_TMO], 1u); break; } }
    }
    nloc = mine > 0u ? mine : 1u; nx = cnt > 0u ? cnt : 1u;
}
DEV void xcd_barrier(const XcdBarrier& b) {
    asm volatile("s_waitcnt vmcnt(0)" ::: "memory");
    __syncthreads();
    if (threadIdx.x == 0) {
        unsigned* bar = b.bar;
        __builtin_amdgcn_s_waitcnt(0);
        unsigned nloc = b.st[0], nx = b.st[1];
        if (nloc == 0u) { xcd_barrier_complete(bar, b.x, nloc, nx); b.st[0] = nloc; b.st[1] = nx; }
        const unsigned old = xb_add(&bar[XB_XSUB(b.x)], 1u);
        const unsigned gen = old / nloc;
        if (old + 1u == (gen + 1u) * nloc) {
            __builtin_amdgcn_fence(__ATOMIC_RELEASE, "agent");
            asm volatile("s_waitcnt vmcnt(0)" ::: "memory");
            const unsigned og = xb_add(&bar[XB_TOP], 1u);
            const unsigned tg = og / nx;
            if (og + 1u == (tg + 1u) * nx) xb_add(&bar[XB_TOPGEN], 1u);
            else XB_SPIN(xb_ld(&bar[XB_TOPGEN]) == tg, bar);
            __builtin_amdgcn_fence(__ATOMIC_ACQUIRE, "agent");
            xb_add(&bar[XB_XGEN(b.x)], 1u);
            asm volatile("s_waitcnt vmcnt(0)" ::: "memory");
        } else {
            XB_SPIN(xb_ld(&bar[XB_XGEN(b.x)]) == gen, bar);
            __builtin_amdgcn_fence(__ATOMIC_ACQUIRE, "agent");
            asm volatile("s_waitcnt vmcnt(0)" ::: "memory");
        }
    }
    __syncthreads();
}

namespace pg8 {
#define PG8_LAS __attribute__((address_space(3)))
typedef unsigned short bf16_t;
typedef short bf16x8 __attribute__((ext_vector_type(8)));
typedef float f32x4 __attribute__((ext_vector_type(4)));
typedef unsigned u32x4 __attribute__((ext_vector_type(4)));
constexpr int BM = 256, BK = 64, HALF = 128, HTB = HALF * BK * 2  , STAGE_BYTES = 8 * HTB, NXCD = 8, WGM = 8;

__host__ __device__ __forceinline__ int lds_byte(int r, int c) { const int st = (r >> 4) * 2 + (c >> 5), rr = r & 15, cc = c & 31, ob = rr * 64 + cc * 2; return st * 1024 + (ob ^ (((ob >> 9) & 1) << 5)); }
__host__ __device__ __forceinline__ void stage_rc(int b, int& R, int& C) { const int st = b / 1024, sb = b % 1024, swz = sb ^ (((sb >> 9) & 1) << 5); R = (st >> 1) * 16 + swz / 64; C = (st & 1) * 32 + (swz % 64) / 2; }
__host__ __device__ __forceinline__ int perm32(int rho) { const int n = rho >> 4, i = rho & 15; return 8 * (i >> 2) + 4 * n + (i & 3); }

struct Unit { int pm, pn; };
struct Gemm { const bf16_t* A; const bf16_t* Bt; int M, N, K; };

struct StaticOrder {
    int nM, nN, nwg, G, c;
    __host__ __device__ void init(int M, int N, int G_, int c_) { nM = M / BM; nN = N / BM; nwg = nM * nN; G = G_; c = c_; }
    __host__ __device__ bool next(int i, Unit& u) const {
        const long L = (long)i * G + c; if (L >= nwg) return false;
        int wgid = (int)L; { const int q = nwg / NXCD, r = nwg % NXCD, xcd = wgid % NXCD, off = wgid / NXCD; wgid = (xcd < r ? xcd * (q + 1) : r * (q + 1) + (xcd - r) * q) + off; }
        const int nig = WGM * nN, gid = wgid / nig, fm = gid * WGM, gsz = (nM - fm) < WGM ? (nM - fm) : WGM;
        u.pm = fm + ((wgid % nig) % gsz); u.pn = (wgid % nig) / gsz; return true;
    }
    __device__ __forceinline__ void a_ready(const Unit&) const {}
    __device__ __forceinline__ void done(const Unit&) const {}
};

template <class Epi, class Sched, bool STAMP = false>
__device__ __forceinline__ void gemm_phase(PG8_LAS unsigned char* lds, const Gemm g, const Sched& S, const Epi& E, unsigned long long* stamps) {
    int tid = threadIdx.x; asm volatile("" : "+v"(tid));
    const int wid = __builtin_amdgcn_readfirstlane(tid >> 6), lane = tid & 63, wr = wid >> 2, wc = wid & 3, fr = lane & 15, fq = lane >> 4;
    const int K = g.K, nt = K / BK;
#define PG8_STAMP() do { } while (0)
    PG8_STAMP();
    unsigned voffA[2], voffB[2];
#pragma unroll
    for (int i = 0; i < 2; ++i) { int R, C; stage_rc(tid * 16 + i * 8192, R, C); const int Rb = Epi::PERM ? ((R & ~31) + perm32(R & 31)) : R;
        voffA[i] = (unsigned)(R * K + C) * 2u; voffB[i] = (unsigned)(Rb * K + C) * 2u; }
    const size_t kstep = (size_t)(BK * 2);
    const size_t hstep = (size_t)HALF * K * 2;
    const size_t tstep = 2 * hstep;
    const unsigned ldsw = (unsigned)wid * 1024u;
    const int aoff = lds_byte(wr * 64 + fr, fq * 8), boff = lds_byte(wc * 32 + fr, fq * 8);
#define PG8_SA(b, h) (((b) * 2 + (h)) * HTB)
#define PG8_SB(b, h) ((4 + (b) * 2 + (h)) * HTB)
#define PG8_STAGE(bufoff, gbase, voff) do { _Pragma("unroll") for (int _i = 0; _i < 2; ++_i) \
        __builtin_amdgcn_global_load_lds((const unsigned*)((const char*)(gbase) + (voff)[_i]), (PG8_LAS unsigned*)(lds + (bufoff) + ldsw + _i * 8192), 16, 0, 0); } while (0)
#define PG8_LDA(dst, b, h) do { _Pragma("unroll") for (int m = 0; m < 4; ++m) _Pragma("unroll") for (int k = 0; k < 2; ++k) dst[m][k] = *(const PG8_LAS bf16x8*)(lds + PG8_SA(b, h) + aoff + m * 2048 + k * 1024); } while (0)
#define PG8_LDB(dst, b, h) do { _Pragma("unroll") for (int n = 0; n < 2; ++n) _Pragma("unroll") for (int k = 0; k < 2; ++k) dst[n][k] = *(const PG8_LAS bf16x8*)(lds + PG8_SB(b, h) + boff + n * 2048 + k * 1024); } while (0)
#define PG8_MMA(ai, bj, At, Bt) do { __builtin_amdgcn_s_setprio(1); _Pragma("unroll") for (int m = 0; m < 4; ++m) _Pragma("unroll") for (int n = 0; n < 2; ++n) _Pragma("unroll") for (int k = 0; k < 2; ++k) \
        acc[ai][bj][m][n] = __builtin_amdgcn_mfma_f32_16x16x32_bf16(Bt[n][k], At[m][k], acc[ai][bj][m][n], 0, 0, 0); __builtin_amdgcn_s_setprio(0); } while (0)
#define PG8_WAIT_V(n) asm volatile("s_waitcnt vmcnt(" #n ")" ::: "memory")
#define PG8_WAIT_L(n) asm volatile("s_waitcnt lgkmcnt(" #n ")" ::: "memory")
#define PG8_BAR __builtin_amdgcn_s_barrier()
#define PG8_SCHED __builtin_amdgcn_sched_barrier(0)
    Unit cur, nxt; int ui = 0;
    if (!S.next(0, cur)) return;
    f32x4 acc[2][2][4][2];
#pragma unroll
    for (int a = 0; a < 2; ++a)
#pragma unroll
        for (int b = 0; b < 2; ++b)
#pragma unroll
            for (int m = 0; m < 4; ++m)
#pragma unroll
                for (int n = 0; n < 2; ++n) acc[a][b][m][n] = (f32x4){0.f, 0.f, 0.f, 0.f};
    bf16x8 At[4][2], B0[2][2], B1[2][2];
    const char* cA = (const char*)g.A + (size_t)cur.pm * tstep; const char* cB = (const char*)g.Bt + (size_t)cur.pn * tstep;
    S.a_ready(cur);
    PG8_STAGE(PG8_SB(0, 0), cB, voffB); PG8_STAGE(PG8_SA(0, 0), cA, voffA); PG8_STAGE(PG8_SB(0, 1), cB + hstep, voffB); PG8_STAGE(PG8_SA(0, 1), cA + hstep, voffA);
    if (wr == 1) PG8_BAR;
    PG8_WAIT_V(4); PG8_BAR;
    PG8_STAGE(PG8_SB(1, 0), cB + kstep, voffB); PG8_STAGE(PG8_SA(1, 0), cA + kstep, voffA); PG8_STAGE(PG8_SB(1, 1), cB + hstep + kstep, voffB);
    PG8_WAIT_V(6); PG8_BAR;
    PG8_STAMP();
    for (;;) {
        const bool has_next = S.next(ui + 1, nxt);
        const char* nA = has_next ? (const char*)g.A + (size_t)nxt.pm * tstep : cA; const char* nB = has_next ? (const char*)g.Bt + (size_t)nxt.pn * tstep : cB;
        for (int t = 0; t < nt; t += 2) {
            const bool last = (t == nt - 2);
            const char* a1 = cA + (size_t)(t + 1) * kstep;
            const char* a2 = last ? nA : cA + (size_t)(t + 2) * kstep; const char* b2 = last ? nB : cB + (size_t)(t + 2) * kstep;
            const char* a3 = a2 + kstep; const char* b3 = b2 + kstep;
            if (last && has_next) S.a_ready(nxt);
            PG8_LDB(B0, 0, 0); PG8_SCHED; PG8_LDA(At, 0, 0); PG8_STAGE(PG8_SA(1, 1), a1 + hstep, voffA);
            PG8_WAIT_L(8); PG8_BAR; PG8_WAIT_L(0); PG8_MMA(0, 0, At, B0); PG8_BAR; PG8_SCHED;
            PG8_LDB(B1, 0, 1); PG8_STAGE(PG8_SB(0, 0), b2, voffB);
            PG8_BAR; PG8_WAIT_L(0); PG8_MMA(0, 1, At, B1); PG8_BAR;
            PG8_LDA(At, 0, 1); PG8_STAGE(PG8_SA(0, 0), a2, voffA);
            PG8_BAR; PG8_WAIT_L(0); PG8_MMA(1, 0, At, B0); PG8_BAR; PG8_SCHED;
            PG8_STAGE(PG8_SB(0, 1), b2 + hstep, voffB);
            PG8_WAIT_V(6); PG8_BAR; PG8_MMA(1, 1, At, B1); PG8_BAR;
            PG8_LDB(B0, 1, 0); PG8_SCHED; PG8_LDA(At, 1, 0); PG8_STAGE(PG8_SA(0, 1), a2 + hstep, voffA);
            PG8_WAIT_L(8); PG8_BAR; PG8_WAIT_L(0); PG8_MMA(0, 0, At, B0); PG8_BAR; PG8_SCHED;
            PG8_LDB(B1, 1, 1); PG8_STAGE(PG8_SB(1, 0), b3, voffB);
            PG8_BAR; PG8_WAIT_L(0); PG8_MMA(0, 1, At, B1); PG8_BAR;
            PG8_LDA(At, 1, 1); PG8_STAGE(PG8_SA(1, 0), a3, voffA);
            PG8_BAR; PG8_WAIT_L(0); PG8_MMA(1, 0, At, B0); PG8_BAR; PG8_SCHED;
            PG8_STAGE(PG8_SB(1, 1), b3 + hstep, voffB);
            PG8_WAIT_V(6); PG8_BAR; PG8_MMA(1, 1, At, B1); PG8_BAR;
        }
        PG8_STAMP();
        if constexpr (!Epi::AFTER_DRAIN) { E(acc, cur, wr, wc, fr, fq); S.done(cur); }
        PG8_STAMP();
        if (!has_next) break;
#pragma unroll
        for (int a = 0; a < 2; ++a)
#pragma unroll
            for (int b = 0; b < 2; ++b)
#pragma unroll
                for (int m = 0; m < 4; ++m)
#pragma unroll
                    for (int n = 0; n < 2; ++n) acc[a][b][m][n] = (f32x4){0.f, 0.f, 0.f, 0.f};
        cur = nxt; cA = nA; cB = nB; ++ui;
    }
    PG8_WAIT_V(0);
    if (wr == 0) PG8_BAR;
    PG8_BAR;
    if constexpr (Epi::AFTER_DRAIN) { E.fused(acc, cur, wr, wc, fr, fq, lds, wid, lane); S.done(cur); }
    PG8_STAMP();
#undef PG8_STAMP
#undef PG8_SA
#undef PG8_SB
#undef PG8_STAGE
#undef PG8_LDA
#undef PG8_LDB
#undef PG8_MMA
#undef PG8_WAIT_V
#undef PG8_WAIT_L
#undef PG8_BAR
#undef PG8_SCHED
}
}

DEV void transpose_convert(const float* __restrict__ W, int K, int N, int Npad, bf16_t* Wt, float* sm) {
    float (*T)[65] = (float (*)[65])sm;
    const int tid = opaque_tid();
    const int kt = K / 64, ntl = Npad / 64;
    for (int tile = blockIdx.x; tile < kt * ntl; tile += gridDim.x) {
        const int k0 = (tile / ntl) * 64, n0 = (tile % ntl) * 64;
        __syncthreads();
#pragma unroll
        for (int i = 0; i < 2; ++i) {
            const int k = (tid >> 4) + 32 * i, n4 = (tid & 15) * 4;
            float4 v = make_float4(0.f, 0.f, 0.f, 0.f);
            if (n0 + n4 < N) v = ld4(W + (size_t)(k0 + k) * N + n0 + n4);
            T[k][n4] = v.x; T[k][n4 + 1] = v.y; T[k][n4 + 2] = v.z; T[k][n4 + 3] = v.w;
        }
        __syncthreads();
        const int n = tid >> 3, kq = (tid & 7) * 8;
        unsigned o[4];
#pragma unroll
        for (int j = 0; j < 4; ++j) o[j] = pack2bf(T[kq + 2 * j][n], T[kq + 2 * j + 1][n]);
        bf16_t* dst = Wt + (size_t)(n0 + n) * K + k0 + kq;
        *(uint4*)dst = make_uint4(o[0], o[1], o[2], o[3]);
    }
}

struct EpBf16 {
    static constexpr bool PERM = true, AFTER_DRAIN = false;
    bf16_t* O; int ldc; int ncols;
    DEV void operator()(const pg8::f32x4 (&acc)[2][2][4][2], const pg8::Unit& u, int wr, int wc, int fr, int fq) const {
        const int row0 = u.pm * 256 + wr * 64 + fr, col0 = u.pn * 256 + wc * 32 + 8 * fq;
#pragma unroll
        for (int ai = 0; ai < 2; ++ai)
#pragma unroll
            for (int m = 0; m < 4; ++m) {
                bf16_t* rowp = O + (size_t)(row0 + ai * 128 + m * 16) * ldc + col0;
#pragma unroll
                for (int bj = 0; bj < 2; ++bj) {
                    if (col0 + bj * 128 < ncols) {
                        const pg8::f32x4 v0 = acc[ai][bj][m][0], v1 = acc[ai][bj][m][1];
                        *(uint4*)(rowp + bj * 128) = make_uint4(pack2bf(v0[0], v0[1]), pack2bf(v0[2], v0[3]), pack2bf(v1[0], v1[1]), pack2bf(v1[2], v1[3]));
                    }
                }
            }
    }
};
struct EpRes0 {
    static constexpr bool PERM = false, AFTER_DRAIN = false;
    float* C; const float* mv; int b;
    DEV void operator()(const pg8::f32x4 (&acc)[2][2][4][2], const pg8::Unit& u, int wr, int wc, int fr, int fq) const {
        const bool isc = (u.pm * 256 < NCX);
        const float* gp = mv + (isc ? 2 : b) * 3072 + 2048;
        const int row0 = u.pm * 256 + wr * 64 + fr, col0 = u.pn * 256 + wc * 32 + 4 * fq;
#pragma unroll
        for (int ai = 0; ai < 2; ++ai)
#pragma unroll
            for (int m = 0; m < 4; ++m) {
                const size_t ro = (size_t)(row0 + ai * 128 + m * 16) * DM + col0;
#pragma unroll
                for (int bj = 0; bj < 2; ++bj)
#pragma unroll
                    for (int n = 0; n < 2; ++n) {
                        const int co = bj * 128 + n * 16;
                        const float4 g = ld4(gp + col0 + co); const pg8::f32x4 v = acc[ai][bj][m][n];
                        st4(C + ro + co, make_float4(g.x * v[0], g.y * v[1], g.z * v[2], g.w * v[3]));
                    }
            }
    }
};
struct EpRes1 {
    static constexpr bool PERM = false, AFTER_DRAIN = false;
    float* C; const float* mv;
    DEV void operator()(const pg8::f32x4 (&acc)[2][2][4][2], const pg8::Unit& u, int wr, int wc, int fr, int fq) const {
        const float* gp = mv + (u.pm * 256 >= NL ? 1 : 0) * 3072 + 2048;
        const int row0 = u.pm * 256 + wr * 64 + fr, col0 = u.pn * 256 + wc * 32 + 4 * fq;
#pragma unroll
        for (int ai = 0; ai < 2; ++ai)
#pragma unroll
            for (int m = 0; m < 4; ++m) {
                const size_t ro = (size_t)(row0 + ai * 128 + m * 16) * DM + col0;
#pragma unroll
                for (int bj = 0; bj < 2; ++bj)
#pragma unroll
                    for (int n = 0; n < 2; ++n) {
                        const int co = bj * 128 + n * 16;
                        const float4 g = ld4(gp + col0 + co); const pg8::f32x4 v = acc[ai][bj][m][n];
                        st4(C + ro + co, make_float4(g.x * v[0], g.y * v[1], g.z * v[2], g.w * v[3]));
                    }
            }
    }
};
template <class EP>
DEV void run_gemm(const bf16_t* A, const bf16_t* Bt, int M, int N, int K, const EP& ep, float* sm) {
    pg8::Gemm g{A, Bt, M, N, K}; pg8::StaticOrder S; S.init(M, N, (int)gridDim.x, (int)blockIdx.x);
    pg8::gemm_phase<EP, pg8::StaticOrder, false>((PG8_LAS unsigned char*)sm, g, S, ep, nullptr);
}

struct Mod8 { float4 s0, s1, c0, c1; };
DEV Mod8 mod8_load(const float* m, int k) { Mod8 q; q.s0 = ld4(m + k); q.s1 = ld4(m + k + 4); q.c0 = ld4(m + 1024 + k); q.c1 = ld4(m + 1024 + k + 4); return q; }
DEV uint4 mod8_apply(const float4 x0, const float4 x1, const Mod8& q) {
    return make_uint4(pack2bf(x0.x * (1.f + q.c0.x) + q.s0.x, x0.y * (1.f + q.c0.y) + q.s0.y), pack2bf(x0.z * (1.f + q.c0.z) + q.s0.z, x0.w * (1.f + q.c0.w) + q.s0.w),
                      pack2bf(x1.x * (1.f + q.c1.x) + q.s1.x, x1.y * (1.f + q.c1.y) + q.s1.y), pack2bf(x1.z * (1.f + q.c1.z) + q.s1.z, x1.w * (1.f + q.c1.w) + q.s1.w));
}
DEV void phase_h0(const Params& p, int b) {
    const float* modv = (const float*)(p.ws + OFF_MODV);
    bf16_t* H0 = (bf16_t*)(p.ws + OFF_YC);
    const int gt = blockIdx.x * NTHR + opaque_tid(), gn = gridDim.x * NTHR;
    const int k = (gt & 127) * 8;
    const Mod8 mc = mod8_load(modv + 2 * 3072, k), ml = mod8_load(modv + b * 3072, k);
    for (int i0 = gt; i0 < TB * 128; i0 += 4 * gn) {
        float4 xa[4], xb[4];
#pragma unroll
        for (int u = 0; u < 4; ++u) {
            const int i = i0 + u * gn, s = (i < TB * 128 ? i : gt) >> 7;
            const float* src = (s < NCX) ? p.in[2] + ((size_t)(b * NCX + s)) * DM + k : p.in[0] + ((size_t)(b * NL + s - NCX)) * DM + k;
            xa[u] = ld4(src); xb[u] = ld4(src + 4);
        }
#pragma unroll
        for (int u = 0; u < 4; ++u) {
            const int i = i0 + u * gn, s = i >> 7;
            if (i < TB * 128) *(uint4*)(H0 + (size_t)s * DM + k) = mod8_apply(xa[u], xb[u], (s < NCX) ? mc : ml);
        }
    }
}

DEV void phase_mod(const Params& p, float* sm) {
    const float* c = p.in[1]; const float* cctx = p.in[3];
    const float* mod_w = p.in[4]; const float* mod_b = p.in[5];
    float* modv = (float*)(p.ws + OFF_MODV);
    float* sil = sm; float* red = sm + 3072;
    const int tid = opaque_tid();
    for (int i = tid; i < 3072; i += NTHR) {
        const int j = i >> 10, k = i & 1023;
        const float v = (j < 2) ? c[j * 1024 + k] : cctx[k];
        sil[i] = silu_f(v);
    }
    __syncthreads();
    for (int unit = blockIdx.x; unit < 192; unit += gridDim.x) {
        const int l = unit / 96, cb = unit % 96;
        const int kg = tid >> 5, col = tid & 31, n = cb * 32 + col;
        const float* w = mod_w + (size_t)l * 1024 * 3072 + n;
        float a0 = 0.f, a1 = 0.f, a2 = 0.f;
        for (int k = kg * 64; k < kg * 64 + 64; ++k) {
            const float wv = w[(size_t)k * 3072];
            a0 += sil[k] * wv; a1 += sil[1024 + k] * wv; a2 += sil[2048 + k] * wv;
        }
        red[(kg * 3 + 0) * 32 + col] = a0; red[(kg * 3 + 1) * 32 + col] = a1; red[(kg * 3 + 2) * 32 + col] = a2;
        __syncthreads();
        if (tid < 96) {
            const int j = tid >> 5, cc = tid & 31, nn = cb * 32 + cc;
            float s = mod_b[l * 3072 + nn];
            for (int g = 0; g < 16; ++g) s += red[(g * 3 + j) * 32 + cc];
            modv[(l * 3 + j) * 3072 + nn] = s;
        }
        __syncthreads();
    }
}

DEV void phase_tables(const Params& p) {
    const float* wq = p.in[33]; const float* wk = p.in[34]; const float* wv = p.in[35];
    const float* gw0 = p.in[36]; const float* gw1 = p.in[38]; const float* gw2 = p.in[40]; const float* gw3 = p.in[42];
    float* gtab = (float*)(p.ws + OFF_GTAB); bf16_t* wft = (bf16_t*)(p.ws + OFF_WFT);
    const int gt = blockIdx.x * NTHR + opaque_tid(), gn = gridDim.x * NTHR;
    for (int i = gt; i < 512 * 16; i += gn) {
        const int gb = i >> 4, cp = (i >> 2) & 3, c = i & 3;
        float s = 0.f;
#pragma unroll
        for (int d = 0; d < 4; ++d) s += wq[gb * 16 + cp * 4 + d] * wk[gb * 16 + c * 4 + d];
        gtab[i] = s * KSCALE;
    }
    for (int i = gt; i < 4096 * 16; i += gn) {
        const int g = i >> 12, k = i & 4095, gm = g >> 2, hd = g & 3;
        const float* wg = gm == 0 ? gw0 : (gm == 1 ? gw1 : (gm == 2 ? gw2 : gw3));
        float s = 0.f;
        if (k < 2048) {
            const int blk = k >> 2, cc = k & 3;
#pragma unroll
            for (int d = 0; d < 4; ++d) s += wq[blk * 16 + cc * 4 + d] * wg[(size_t)(4 * blk + d) * 4 + hd] + wk[blk * 16 + cc * 4 + d] * wg[(size_t)(2048 + 4 * blk + d) * 4 + hd];
        } else {
            const int kk = k - 2048, blk = kk >> 2, cc = kk & 3;
#pragma unroll
            for (int d = 0; d < 4; ++d) s += wv[blk * 16 + cc * 4 + d] * wg[(size_t)(4096 + 4 * blk + d) * 4 + hd];
        }
        wft[i] = __builtin_bit_cast(unsigned short, (__bf16)s);
    }
}

DEV float wave_scan_add(float v, int lane, int dir) {
#pragma unroll
    for (int o = 1; o < 64; o <<= 1) {
        const float n = dir ? __shfl_down(v, o, 64) : __shfl_up(v, o, 64);
        const bool ok = dir ? (lane + o < 64) : (lane >= o);
        if (ok) v += n;
    }
    return v;
}
DEV float wave_scan_max(float v, int lane, int dir) {
#pragma unroll
    for (int o = 1; o < 64; o <<= 1) {
        const float n = dir ? __shfl_down(v, o, 64) : __shfl_up(v, o, 64);
        const bool ok = dir ? (lane + o < 64) : (lane >= o);
        if (ok) v = fmaxf(v, n);
    }
    return v;
}

constexpr int GLC_OFF = 30336;
static_assert((GLC_OFF + 2176) * 4 <= LDS_BYTES - 16, "GLA constants must fit below the barrier words");
DEV void gla_consts(const Params& p, int h, float* sm) {
    const int tid = opaque_tid();
    float* sWA2 = sm + GLC_OFF; float* sBA2 = sWA2 + 2048;
    __syncthreads();
    for (int i = tid; i < 2048; i += NTHR) { const int d = i >> 10, ii = (i >> 6) & 15, k = i & 63; sWA2[i] = p.in[d ? 12 : 10][ii * 256 + h * 64 + k]; }
    if (tid < 128) sBA2[tid] = p.in[(tid >> 6) ? 13 : 11][h * 64 + (tid & 63)];
}
DEV void gla_decay_core(const float* sLRd, const float* sWAd, const float* sBAd, float* sBC, float* sTot, int dir, int tid) {
    {
        const int t = tid >> 3, k0 = (tid & 7) * 8;
        float acc[8];
#pragma unroll
        for (int j = 0; j < 8; ++j) acc[j] = sBAd[k0 + j];
#pragma unroll
        for (int ii = 0; ii < 16; ++ii) {
            const float l = sLRd[t * 16 + ii];
#pragma unroll
            for (int j = 0; j < 8; ++j) acc[j] += l * sWAd[ii * 64 + k0 + j];
        }
#pragma unroll
        for (int j = 0; j < 8; ++j) sBC[t * 65 + k0 + j] = logsig_f(acc[j]) * 0.0625f;
    }
    __syncthreads();
    {
        const int lane = tid & 63, wv = tid >> 6;
#pragma unroll
        for (int j = 0; j < 8; ++j) {
            const int k = wv * 8 + j;
            const float v = wave_scan_add(sBC[lane * 65 + k], lane, dir);
            sBC[lane * 65 + k] = v;
            if (lane == (dir ? 0 : 63)) sTot[k] = v;
        }
    }
    __syncthreads();
}

DEV bf16x8 tr_frag(const bf16_t* base, int ld, int row0, int col0, int lane) {
    const bf16_t* ptr = base + (row0 + (lane >> 4) * 8 + ((lane & 15) >> 2)) * ld + col0 + (lane & 3) * 4;
    const s16x4 lo = __builtin_amdgcn_ds_read_tr16_b64_v4i16((__attribute__((address_space(3))) s16x4*)ptr);
    const s16x4 hi = __builtin_amdgcn_ds_read_tr16_b64_v4i16((__attribute__((address_space(3))) s16x4*)(ptr + 4 * ld));
    return (bf16x8){lo[0], lo[1], lo[2], lo[3], hi[0], hi[1], hi[2], hi[3]};
}
DEV bf16x8 row_frag(const bf16_t* base, int ld, int idx0, int k0, int lane) {
    return *(const bf16x8*)(base + (idx0 + (lane & 15)) * ld + k0 + (lane >> 4) * 8);
}

DEV void gla1_unit(const Params& p, int h, int dir, int c, float* sm) {
    const int tid = opaque_tid(), lane = tid & 63, wave = tid >> 6;
    const bf16_t* P0 = (const bf16_t*)(p.ws + OFF_P0);
    float* GDS = (float*)(p.ws + OFF_GDS); float* GDEC = (float*)(p.ws + OFF_GDEC);
    float* sLR = sm; float* sBC = sm + 2048; float* sTot = sm + 6208;
    bf16_t* kT = (bf16_t*)(sm + 6272);
    bf16_t* Vs = (bf16_t*)(sm + 8576);
    const int ch = h * 2 + dir;
    const int t = tid >> 3, k0 = (tid & 7) * 8;
    const uint4 lrq = *(const uint4*)(P0 + (size_t)(c * 64 + ((tid & 127) >> 1)) * EIN + 1536 + dir * 16 + (tid & 1) * 8);
    const uint4 kq = *(const uint4*)(P0 + (size_t)(c * 64 + t) * EIN + 256 + h * 64 + k0);
    const uint4 vq0 = *(const uint4*)(P0 + (size_t)(c * 64 + (tid >> 4)) * EIN + 512 + h * 128 + (tid & 15) * 8);
    const uint4 vq1 = *(const uint4*)(P0 + (size_t)(c * 64 + 32 + (tid >> 4)) * EIN + 512 + h * 128 + (tid & 15) * 8);
    __syncthreads();
    if (tid < 128) { float* d = sLR + (tid >> 1) * 16 + (tid & 1) * 8; st4(d, make_float4(bflo(lrq.x), bfhi(lrq.x), bflo(lrq.y), bfhi(lrq.y))); st4(d + 4, make_float4(bflo(lrq.z), bfhi(lrq.z), bflo(lrq.w), bfhi(lrq.w))); }
    *(uint4*)(Vs + (tid >> 4) * 136 + (tid & 15) * 8) = vq0; *(uint4*)(Vs + (32 + (tid >> 4)) * 136 + (tid & 15) * 8) = vq1;
    __syncthreads();
    gla_decay_core(sLR, sm + GLC_OFF + dir * 1024, sm + GLC_OFF + 2048 + dir * 64, sBC, sTot, dir, tid);
    {
        float kv[8]; unpack8(kq, kv);
#pragma unroll
        for (int j = 0; j < 8; ++j) kT[(k0 + j) * 72 + t] = __builtin_bit_cast(unsigned short, (__bf16)(kv[j] * fexp(sTot[k0 + j] - sBC[t * 65 + k0 + j])));
    }
    __syncthreads();
    {
        f32x4 acc[4];
#pragma unroll
        for (int kt = 0; kt < 4; ++kt) acc[kt] = (f32x4){0.f, 0.f, 0.f, 0.f};
#pragma unroll
        for (int ks = 0; ks < 2; ++ks) {
            const bf16x8 af = tr_frag(Vs, 136, ks * 32, wave * 16, lane);
#pragma unroll
            for (int kt = 0; kt < 4; ++kt) acc[kt] = __builtin_amdgcn_mfma_f32_16x16x32_bf16(af, row_frag(kT, 72, kt * 16, ks * 32, lane), acc[kt], 0, 0, 0);
        }
#pragma unroll
        for (int kt = 0; kt < 4; ++kt) {
            const int k = kt * 16 + (lane & 15), v = wave * 16 + (lane >> 4) * 4;
            st4(GDS + ((size_t)(ch * NCH + c) * 64 + k) * 128 + v, make_float4(acc[kt][0], acc[kt][1], acc[kt][2], acc[kt][3]));
        }
    }
    if (tid < 64) GDEC[(size_t)(ch * NCH + c) * 64 + tid] = fexp(sTot[tid]);
}

DEV void gla2_unit(const Params& p, int unit) {
    const int tid = opaque_tid();
    float* GDS = (float*)(p.ws + OFF_GDS); const float* GDEC = (const float*)(p.ws + OFF_GDEC);
    const int ch = unit >> 4, e = (unit & 15) * 512 + tid, k = e >> 7, dir = ch & 1;
    constexpr int GB = 12;
    float S = 0.f, ninc[GB], nd[GB];
#pragma unroll
    for (int j = 0; j < GB; ++j) { const int c = chunk_at(dir, j); ninc[j] = GDS[(size_t)(ch * NCH + c) * 8192 + e]; nd[j] = GDEC[(size_t)(ch * NCH + c) * 64 + k]; }
#pragma unroll 1
    for (int step0 = 0; step0 < NCH; step0 += GB) {
        float inc[GB], d[GB];
#pragma unroll
        for (int j = 0; j < GB; ++j) { inc[j] = ninc[j]; d[j] = nd[j]; }
#pragma unroll
        for (int j = 0; j < GB; ++j) { const int sn = step0 + GB + j, c = chunk_at(dir, sn < NCH ? sn : NCH - 1); ninc[j] = GDS[(size_t)(ch * NCH + c) * 8192 + e]; nd[j] = GDEC[(size_t)(ch * NCH + c) * 64 + k]; }
        __builtin_amdgcn_sched_barrier(0);
#pragma unroll
        for (int j = 0; j < GB; ++j) { const int c = chunk_at(dir, step0 + j); GDS[(size_t)(ch * NCH + c) * 8192 + e] = S; S = d[j] * S + inc[j]; }
    }
}

DEV void gla3_unit(const Params& p, int h, int c, float* sm) {
    const int tid = opaque_tid(), lane = tid & 63, wave = tid >> 6;
    const bf16_t* P0 = (const bf16_t*)(p.ws + OFF_P0);
    const float* GDS = (const float*)(p.ws + OFF_GDS);
    bf16_t* YC = (bf16_t*)(p.ws + OFF_YC);
    const float* ng = p.in[14];
    float* sLR2 = sm;
    float* sBC = sm + 2048; float* sTot = sm + 6208;
    bf16_t* qt = (bf16_t*)(sm + 6272);
    bf16_t* kt = (bf16_t*)(sm + 8576);
    bf16_t* Sm = (bf16_t*)(sm + 10880);
    bf16_t* S0s = (bf16_t*)(sm + 13184);
    bf16_t* Vs = (bf16_t*)(sm + 17536);
    float* O = sm + 21888;
    const int ti = wave & 3, vt0 = (wave >> 2) * 4;
    const int t = tid >> 3, k0 = (tid & 7) * 8;
    f32x4 acc[4];
#pragma unroll
    for (int j = 0; j < 4; ++j) acc[j] = (f32x4){0.f, 0.f, 0.f, 0.f};
    const uint4 vq0 = *(const uint4*)(P0 + (size_t)(c * 64 + (tid >> 4)) * EIN + 512 + h * 128 + (tid & 15) * 8);
    const uint4 vq1 = *(const uint4*)(P0 + (size_t)(c * 64 + 32 + (tid >> 4)) * EIN + 512 + h * 128 + (tid & 15) * 8);
    const uint4 lrq = *(const uint4*)(P0 + (size_t)(c * 64 + ((tid & 255) >> 2)) * EIN + 1536 + (tid & 3) * 8);
    const uint4 qq = *(const uint4*)(P0 + (size_t)(c * 64 + t) * EIN + h * 64 + k0);
    const uint4 kq = *(const uint4*)(P0 + (size_t)(c * 64 + t) * EIN + 256 + h * 64 + k0);
    float4 s0a[4], s0b[4];
#pragma unroll
    for (int u = 0; u < 4; ++u) { const int i = tid + 512 * u, k = i >> 5, v4 = (i & 31) * 4;
        s0a[u] = ld4(GDS + (size_t)((h * 2 + 0) * NCH + c) * 8192 + k * 128 + v4); s0b[u] = ld4(GDS + (size_t)((h * 2 + 1) * NCH + c) * 8192 + k * 128 + v4); }
    const bf16_t* gp = P0 + (size_t)(c * 64 + t) * EIN + 1024 + h * 128 + (tid & 7) * 16;
    const uint4 gq0 = *(const uint4*)gp, gq1 = *(const uint4*)(gp + 8);
    __syncthreads();
    *(uint4*)(Vs + (tid >> 4) * 136 + (tid & 15) * 8) = vq0; *(uint4*)(Vs + (32 + (tid >> 4)) * 136 + (tid & 15) * 8) = vq1;
    if (tid < 256) { float* d = sLR2 + ((tid & 3) >> 1) * 1024 + (tid >> 2) * 16 + (tid & 1) * 8; st4(d, make_float4(bflo(lrq.x), bfhi(lrq.x), bflo(lrq.y), bfhi(lrq.y))); st4(d + 4, make_float4(bflo(lrq.z), bfhi(lrq.z), bflo(lrq.w), bfhi(lrq.w))); }
    __syncthreads();
#pragma unroll
    for (int dir = 0; dir < 2; ++dir) {
        gla_decay_core(sLR2 + dir * 1024, sm + GLC_OFF + dir * 1024, sm + GLC_OFF + 2048 + dir * 64, sBC, sTot, dir, tid);
        {
            float qv[8], kv[8];
            unpack8(qq, qv); unpack8(kq, kv);
#pragma unroll
            for (int j = 0; j < 8; ++j) { const float bc = sBC[t * 65 + k0 + j]; qv[j] *= 0.125f * fexp(bc); kv[j] *= fexp(-bc); }
            *(uint4*)(qt + t * 72 + k0) = make_uint4(pack2bf(qv[0], qv[1]), pack2bf(qv[2], qv[3]), pack2bf(qv[4], qv[5]), pack2bf(qv[6], qv[7]));
            *(uint4*)(kt + t * 72 + k0) = make_uint4(pack2bf(kv[0], kv[1]), pack2bf(kv[2], kv[3]), pack2bf(kv[4], kv[5]), pack2bf(kv[6], kv[7]));
#pragma unroll
            for (int u = 0; u < 4; ++u) {
                const int i = tid + 512 * u, k = i >> 5, v4 = (i & 31) * 4;
                const float4 s4 = dir ? s0b[u] : s0a[u];
                *(uint2*)(S0s + k * 136 + v4) = make_uint2(pack2bf(s4.x, s4.y), pack2bf(s4.z, s4.w));
            }
        }
        __syncthreads();
        {
            const int si = wave & 3;
#pragma unroll
            for (int jj = 0; jj < 2; ++jj) {
                const int t2 = (wave >> 2) * 2 + jj;
                f32x4 a = (f32x4){0.f, 0.f, 0.f, 0.f};
#pragma unroll
                for (int ks = 0; ks < 2; ++ks) a = __builtin_amdgcn_mfma_f32_16x16x32_bf16(row_frag(kt, 72, si * 16, ks * 32, lane), row_frag(qt, 72, t2 * 16, ks * 32, lane), a, 0, 0, 0);
                const int tq = t2 * 16 + (lane & 15), s0 = si * 16 + (lane >> 4) * 4;
                float m[4];
#pragma unroll
                for (int r = 0; r < 4; ++r) { const bool keep = dir ? (s0 + r >= tq) : (s0 + r <= tq); m[r] = keep ? a[r] : 0.f; }
                *(uint2*)(Sm + tq * 72 + s0) = make_uint2(pack2bf(m[0], m[1]), pack2bf(m[2], m[3]));
            }
        }
        __syncthreads();
#pragma unroll
        for (int ks = 0; ks < 2; ++ks) {
            const bf16x8 a1 = row_frag(qt, 72, ti * 16, ks * 32, lane), a2 = row_frag(Sm, 72, ti * 16, ks * 32, lane);
#pragma unroll
            for (int j = 0; j < 4; ++j) {
                acc[j] = __builtin_amdgcn_mfma_f32_16x16x32_bf16(a1, tr_frag(S0s, 136, ks * 32, (vt0 + j) * 16, lane), acc[j], 0, 0, 0);
                acc[j] = __builtin_amdgcn_mfma_f32_16x16x32_bf16(a2, tr_frag(Vs, 136, ks * 32, (vt0 + j) * 16, lane), acc[j], 0, 0, 0);
            }
        }
        if (dir == 0) __syncthreads();
    }
#pragma unroll
    for (int j = 0; j < 4; ++j)
#pragma unroll
        for (int r = 0; r < 4; ++r) O[(ti * 16 + (lane >> 4) * 4 + r) * 132 + (vt0 + j) * 16 + (lane & 15)] = acc[j][r];
    __syncthreads();
    {
        const int v0 = (tid & 7) * 16;
        float o[16];
        float ss = 0.f;
#pragma unroll
        for (int i = 0; i < 16; ++i) { o[i] = O[t * 132 + v0 + i]; ss += o[i] * o[i]; }
        ss += __shfl_xor(ss, 1, 64); ss += __shfl_xor(ss, 2, 64); ss += __shfl_xor(ss, 4, 64);
        const float rms = rsqrtf(ss * (1.f / 128.f) + 1e-5f);
        float g[16];
        unpack8(gq0, g); unpack8(gq1, g + 8);
        float y[16];
#pragma unroll
        for (int i = 0; i < 16; ++i) y[i] = o[i] * rms * ng[v0 + i] * silu_f(g[i]);
        bf16_t* yp = YC + (size_t)(c * 64 + t) * 1024 + h * 128 + v0;
        *(uint4*)yp = make_uint4(pack2bf(y[0], y[1]), pack2bf(y[2], y[3]), pack2bf(y[4], y[5]), pack2bf(y[6], y[7]));
        *(uint4*)(yp + 8) = make_uint4(pack2bf(y[8], y[9]), pack2bf(y[10], y[11]), pack2bf(y[12], y[13]), pack2bf(y[14], y[15]));
    }
}

DEV void load8bf(const bf16_t* ptr, float* f) { unpack8(*(const uint4*)ptr, f); }
struct RwNb { int sL, sR, sU, sD; bool vL, vR, vU, vD; };
DEV RwNb rw_nb(int s) {
    RwNb q; q.vU = false; q.vD = false;
    if (s < NCX) { q.vL = s > 0; q.vR = s < NCX - 1; }
    else { const int n = s - NCX, rr = n >> 6, cc = n & 63; q.vL = cc > 0; q.vR = cc < 63; q.vU = rr > 0; q.vD = rr < 127; }
    q.sL = q.vL ? s - 1 : s; q.sR = q.vR ? s + 1 : s; q.sU = q.vU ? s - 64 : s; q.sD = q.vD ? s + 64 : s;
    return q;
}
struct RwRaw { uint4 o, l, r, u, d; };
DEV RwRaw rw_load(const bf16_t* P0, int s, const RwNb& q, int cb) {
    RwRaw w;
    w.o = *(const uint4*)(P0 + (size_t)s * EIN + RW0 + cb); w.l = *(const uint4*)(P0 + (size_t)q.sL * EIN + RW0 + cb); w.r = *(const uint4*)(P0 + (size_t)q.sR * EIN + RW0 + cb);
    w.u = *(const uint4*)(P0 + (size_t)q.sU * EIN + RW0 + cb); w.d = *(const uint4*)(P0 + (size_t)q.sD * EIN + RW0 + cb);
    return w;
}
DEV void rw_comb_l(const RwRaw& w, const RwNb& q, const float* ml, float* out) {
    float own[8]; unpack8(w.o, own);
    const float nb[8] = {q.vL ? bflo(w.l.x) : 0.f, q.vR ? bfhi(w.r.x) : 0.f, q.vU ? bflo(w.u.y) : 0.f, q.vD ? bfhi(w.d.y) : 0.f,
                         q.vL ? bflo(w.l.z) : 0.f, q.vR ? bfhi(w.r.z) : 0.f, q.vU ? bflo(w.u.w) : 0.f, q.vD ? bfhi(w.d.w) : 0.f};
    const float4 m0 = *(const float4*)ml, m1 = *(const float4*)(ml + 4);
    const float m[8] = {m0.x, m0.y, m0.z, m0.w, m1.x, m1.y, m1.z, m1.w};
#pragma unroll
    for (int i = 0; i < 8; ++i) out[i] = own[i] + (nb[i] - own[i]) * m[i];
}
DEV void rw_comb(const RwRaw& w, const RwNb& q, const float* __restrict__ mu, int cb, float* out) {
    float own[8]; unpack8(w.o, own);
    const float nb[8] = {q.vL ? bflo(w.l.x) : 0.f, q.vR ? bfhi(w.r.x) : 0.f, q.vU ? bflo(w.u.y) : 0.f, q.vD ? bfhi(w.d.y) : 0.f,
                         q.vL ? bflo(w.l.z) : 0.f, q.vR ? bfhi(w.r.z) : 0.f, q.vU ? bflo(w.u.w) : 0.f, q.vD ? bfhi(w.d.w) : 0.f};
    const float4 m0 = ld4(mu + cb), m1 = ld4(mu + cb + 4);
    const float m[8] = {m0.x, m0.y, m0.z, m0.w, m1.x, m1.y, m1.z, m1.w};
#pragma unroll
    for (int i = 0; i < 8; ++i) out[i] = own[i] + (nb[i] - own[i]) * m[i];
}
DEV uint4 pack8(const float* f) { return make_uint4(pack2bf(f[0], f[1]), pack2bf(f[2], f[3]), pack2bf(f[4], f[5]), pack2bf(f[6], f[7])); }

template <int XM, int YM, class F>
DEV void mm64(const bf16_t* X, const bf16_t* Y, F f, int lane, int wave) {
#pragma unroll
    for (int q = 0; q < 2; ++q) {
        const int idx = wave * 2 + q, ti = idx >> 2, tj = idx & 3;
        f32x4 acc = (f32x4){0.f, 0.f, 0.f, 0.f};
#pragma unroll
        for (int ks = 0; ks < 2; ++ks) {
            const bf16x8 a = XM == 0 ? row_frag(X, 72, ti * 16, ks * 32, lane) : tr_frag(X, 72, ks * 32, ti * 16, lane);
            const bf16x8 bq = YM == 0 ? row_frag(Y, 72, tj * 16, ks * 32, lane) : tr_frag(Y, 72, ks * 32, tj * 16, lane);
            acc = __builtin_amdgcn_mfma_f32_16x16x32_bf16(a, bq, acc, 0, 0, 0);
        }
        f(ti * 16 + (lane >> 4) * 4, tj * 16 + (lane & 15), acc);
    }
}
template <int XM, int YM, class F>
DEV void mm64x2(const bf16_t* X1, const bf16_t* Y1, const bf16_t* X2, const bf16_t* Y2, F f, int lane, int wave) {
#pragma unroll
    for (int q = 0; q < 2; ++q) {
        const int idx = wave * 2 + q, ti = idx >> 2, tj = idx & 3;
        f32x4 acc = (f32x4){0.f, 0.f, 0.f, 0.f};
#pragma unroll
        for (int ks = 0; ks < 2; ++ks) {
            const bf16x8 a = XM == 0 ? row_frag(X1, 72, ti * 16, ks * 32, lane) : tr_frag(X1, 72, ks * 32, ti * 16, lane);
            const bf16x8 bq = YM == 0 ? row_frag(Y1, 72, tj * 16, ks * 32, lane) : tr_frag(Y1, 72, ks * 32, tj * 16, lane);
            acc = __builtin_amdgcn_mfma_f32_16x16x32_bf16(a, bq, acc, 0, 0, 0);
            const bf16x8 a2 = XM == 0 ? row_frag(X2, 72, ti * 16, ks * 32, lane) : tr_frag(X2, 72, ks * 32, ti * 16, lane);
            const bf16x8 b2 = YM == 0 ? row_frag(Y2, 72, tj * 16, ks * 32, lane) : tr_frag(Y2, 72, ks * 32, tj * 16, lane);
            acc = __builtin_amdgcn_mfma_f32_16x16x32_bf16(a2, b2, acc, 0, 0, 0);
        }
        f(ti * 16 + (lane >> 4) * 4, tj * 16 + (lane & 15), acc);
    }
}
DEV void st_img(bf16_t* P, int i0, int j, float a0, float a1, float a2, float a3) {
    P[(i0 + 0) * 72 + j] = __builtin_bit_cast(unsigned short, (__bf16)a0); P[(i0 + 1) * 72 + j] = __builtin_bit_cast(unsigned short, (__bf16)a1);
    P[(i0 + 2) * 72 + j] = __builtin_bit_cast(unsigned short, (__bf16)a2); P[(i0 + 3) * 72 + j] = __builtin_bit_cast(unsigned short, (__bf16)a3);
}

struct RwRaw3 { uint4 o, u, d; };
DEV RwRaw3 rw_load3(const bf16_t* P0, int s, const RwNb& q, int cb) {
    RwRaw3 w;
    w.o = *(const uint4*)(P0 + (size_t)s * EIN + RW0 + cb); w.u = *(const uint4*)(P0 + (size_t)q.sU * EIN + RW0 + cb); w.d = *(const uint4*)(P0 + (size_t)q.sD * EIN + RW0 + cb);
    return w;
}
DEV void rw_comb3(const RwRaw3& w, const RwNb& q, const bf16_t* tile, const bf16_t* P0, int s, int t, int cb, int j0, const float* ml, float* out) {
    asm volatile("" :: "v"(w.u.x), "v"(w.u.z), "v"(w.d.x), "v"(w.d.z));
    float own[8]; unpack8(w.o, own);
    float l0 = 0.f, l4 = 0.f, r1 = 0.f, r5 = 0.f;
    if (q.vL) { if (t > 0) { l0 = bf2f(tile[(t - 1) * 72 + j0]); l4 = bf2f(tile[(t - 1) * 72 + j0 + 4]); }
                else { const bf16_t* g = P0 + (size_t)(s - 1) * EIN + RW0 + cb; l0 = bf2f(g[0]); l4 = bf2f(g[4]); } }
    if (q.vR) { if (t < 63) { r1 = bf2f(tile[(t + 1) * 72 + j0 + 1]); r5 = bf2f(tile[(t + 1) * 72 + j0 + 5]); }
                else { const bf16_t* g = P0 + (size_t)(s + 1) * EIN + RW0 + cb; r1 = bf2f(g[1]); r5 = bf2f(g[5]); } }
    const float nb[8] = {l0, r1, q.vU ? bflo(w.u.y) : 0.f, q.vD ? bfhi(w.d.y) : 0.f, l4, r5, q.vU ? bflo(w.u.w) : 0.f, q.vD ? bfhi(w.d.w) : 0.f};
    const float4 m0 = *(const float4*)ml, m1 = *(const float4*)(ml + 4);
    const float m[8] = {m0.x, m0.y, m0.z, m0.w, m1.x, m1.y, m1.z, m1.w};
#pragma unroll
    for (int i = 0; i < 8; ++i) out[i] = own[i] + (nb[i] - own[i]) * m[i];
}
struct R1Raw { RwRaw3 r, k, v, w, a; float4 qw0, qw1, qa0, qa1; };
DEV void r1_consts(const Params& p, int h, int dir, float* sm) {
    const int tid = opaque_tid();
    float* sv = (float*)((bf16_t*)sm + 14 * 4608);
    __syncthreads();
    if (tid < 64) { const int hc = h * 64 + tid; sv[64 + tid] = p.in[dir ? 18 : 16][hc]; sv[128 + tid] = p.in[dir ? 22 : 20][hc]; sv[192 + tid] = p.in[24][hc]; sv[256 + tid] = p.in[25][hc]; sv[320 + tid] = p.in[26][hc]; }
    if (tid < 320) { const int tn = tid >> 6, col = tid & 63; const int cb = tn < 3 ? tn * 512 + h * 64 : (tn == 3 ? 2048 + dir * 64 : 2176 + dir * 64); sv[384 + tid] = p.in[15][cb + col]; }
}
DEV void r1_load(const Params& p, int h, int dir, int c, R1Raw& R) {
    const int tid = opaque_tid();
    const bf16_t* P0 = (const bf16_t*)(p.ws + OFF_P0);
    const float* ww2 = p.in[dir ? 19 : 17]; const float* wa2 = p.in[dir ? 23 : 21];
    const int t = tid >> 3, j0 = (tid & 7) * 8, s = c * 64 + t;
    const RwNb nbq = rw_nb(s);
    R.r = rw_load3(P0, s, nbq, h * 64 + j0); R.k = rw_load3(P0, s, nbq, 512 + h * 64 + j0); R.v = rw_load3(P0, s, nbq, 1024 + h * 64 + j0);
    R.w = rw_load3(P0, s, nbq, 2048 + dir * 64 + j0); R.a = rw_load3(P0, s, nbq, 2176 + dir * 64 + j0);
    R.qw0 = ld4(ww2 + (size_t)t * 512 + h * 64 + j0); R.qw1 = ld4(ww2 + (size_t)t * 512 + h * 64 + j0 + 4);
    R.qa0 = ld4(wa2 + (size_t)t * 512 + h * 64 + j0); R.qa1 = ld4(wa2 + (size_t)t * 512 + h * 64 + j0 + 4);
}
DEV void rwkv1_unit(const Params& p, int h, int dir, int c, float* sm, R1Raw& R, int cnext) {
    const int tid = opaque_tid(), lane = tid & 63, wave = tid >> 6;
    bf16_t* RU = (bf16_t*)(p.ws + OFF_RU) + (size_t)((h * 2 + dir) * NCH + c) * 16384;
    float* BONS = (float*)(p.ws + OFF_BONS);
    bf16_t* img = (bf16_t*)sm;
#define SLOT(i_) (img + (i_) * 4608)
    float* fLW = (float*)SLOT(10);
    float* fAS = (float*)SLOT(12);
    float* sv = (float*)SLOT(14);
    const int t = tid >> 3, j0 = (tid & 7) * 8, s = c * 64 + t;
    const bf16_t* P0 = (const bf16_t*)(p.ws + OFF_P0);
    __syncthreads();
    *(uint4*)(SLOT(0) + t * 72 + j0) = R.r.o; *(uint4*)(SLOT(1) + t * 72 + j0) = R.k.o; *(uint4*)(SLOT(2) + t * 72 + j0) = R.v.o;
    *(uint4*)(SLOT(3) + t * 72 + j0) = R.w.o; *(uint4*)(SLOT(4) + t * 72 + j0) = R.a.o;
    __syncthreads();
    float r8[8], k8[8], v8[8];
    {
        float x8[8];
        const RwNb nbq = rw_nb(s);
        rw_comb3(R.r, nbq, SLOT(0), P0, s, t, h * 64 + j0, j0, sv + 384 + j0, r8);
        rw_comb3(R.k, nbq, SLOT(1), P0, s, t, 512 + h * 64 + j0, j0, sv + 448 + j0, k8);
        rw_comb3(R.v, nbq, SLOT(2), P0, s, t, 1024 + h * 64 + j0, j0, sv + 512 + j0, v8);
        rw_comb3(R.w, nbq, SLOT(3), P0, s, t, 2048 + dir * 64 + j0, j0, sv + 576 + j0, x8);
#pragma unroll
        for (int i = 0; i < 8; ++i) x8[i] = tanh_f(x8[i]);
        *(uint4*)(SLOT(6) + t * 72 + j0) = pack8(x8);
        rw_comb3(R.a, nbq, SLOT(4), P0, s, t, 2176 + dir * 64 + j0, j0, sv + 640 + j0, x8);
        *(uint4*)(SLOT(7) + t * 72 + j0) = pack8(x8);
        { const float wq[8] = {R.qw0.x, R.qw0.y, R.qw0.z, R.qw0.w, R.qw1.x, R.qw1.y, R.qw1.z, R.qw1.w}; *(uint4*)(SLOT(8) + t * 72 + j0) = pack8(wq); }
        { const float wq[8] = {R.qa0.x, R.qa0.y, R.qa0.z, R.qa0.w, R.qa1.x, R.qa1.y, R.qa1.z, R.qa1.w}; *(uint4*)(SLOT(9) + t * 72 + j0) = pack8(wq); }
    }
    r1_load(p, h, dir, cnext >= 0 ? cnext : c, R);
    __syncthreads();
    mm64<0, 1>(SLOT(6), SLOT(8), [=](int i0, int j, f32x4 a) {
#pragma unroll
        for (int r = 0; r < 4; ++r) fLW[(i0 + r) * 65 + j] = -0.6065306597f * sigmoid_f(sv[64 + j] + a[r]); }, lane, wave);
    mm64<0, 1>(SLOT(7), SLOT(9), [=](int i0, int j, f32x4 a) {
#pragma unroll
        for (int r = 0; r < 4; ++r) fAS[(i0 + r) * 65 + j] = sigmoid_f(sv[128 + j] + a[r]); }, lane, wave);
    __syncthreads();
#pragma unroll
    for (int j = 0; j < 8; ++j) {
        const int k = wave * 8 + j;
        const float v = wave_scan_add(fLW[lane * 65 + k], lane, dir);
        fLW[lane * 65 + k] = v;
        if (lane == (dir ? 0 : 63)) sv[k] = v;
    }
    __syncthreads();
    {
        float kkv[8], ss = 0.f;
#pragma unroll
        for (int i = 0; i < 8; ++i) { kkv[i] = k8[i] * sv[192 + j0 + i]; ss += kkv[i] * kkv[i]; }
        ss += __shfl_xor(ss, 1, 64); ss += __shfl_xor(ss, 2, 64); ss += __shfl_xor(ss, 4, 64);
        const float rn = rsqrtf(fmaxf(ss, 1e-24f));
        float fa[8], fb[8], fk[8], fr[8], fbp[8], fkp[8], bon = 0.f;
        const int tp = dir ? t + 1 : t - 1;
        const bool hasp = dir ? (t < 63) : (t > 0);
#pragma unroll
        for (int i = 0; i < 8; ++i) {
            const int k = j0 + i;
            const float Bt = fLW[t * 65 + k], Bx = hasp ? fLW[tp * 65 + k] : 0.f, asg = fAS[t * 65 + k];
            const float kk = kkv[i] * rn, kh = k8[i] * (1.f + (asg - 1.f) * sv[256 + k]);
            bon += r8[i] * kh * sv[320 + k];
            const float enB = fexp(-Bt), eLB = fexp(sv[k] - Bt), bv = kk * asg;
            fa[i] = -kk * fexp(Bx); fb[i] = bv * enB; fk[i] = kh * enB; fr[i] = r8[i] * fexp(Bt); fbp[i] = bv * eLB; fkp[i] = kh * eLB;
        }
        bon += __shfl_xor(bon, 1, 64); bon += __shfl_xor(bon, 2, 64); bon += __shfl_xor(bon, 4, 64);
        if ((tid & 7) == 0) BONS[((size_t)dir * TB + s) * 8 + h] = bon;
        *(uint4*)(SLOT(0) + t * 72 + j0) = pack8(fa); *(uint4*)(SLOT(1) + t * 72 + j0) = pack8(fb); *(uint4*)(SLOT(2) + t * 72 + j0) = pack8(fk);
        *(uint4*)(SLOT(3) + t * 72 + j0) = pack8(fr); *(uint4*)(SLOT(4) + t * 72 + j0) = pack8(fbp); *(uint4*)(SLOT(5) + t * 72 + j0) = pack8(fkp);
    }
    __syncthreads();
    *(uint4*)(SLOT(6) + t * 72 + j0) = pack8(v8);
    __syncthreads();
    mm64<0, 0>(SLOT(0), SLOT(1), [=](int i0, int j, f32x4 a) {
        float m[4];
#pragma unroll
        for (int r = 0; r < 4; ++r) { const bool keep = dir ? (j > i0 + r) : (j < i0 + r); m[r] = keep ? a[r] : 0.f; }
        const bool dg = (i0 >> 4) == (j >> 4);
        st_img(SLOT(7), i0, j, dg ? m[0] : 0.f, dg ? m[1] : 0.f, dg ? m[2] : 0.f, dg ? m[3] : 0.f);
        st_img(SLOT(8), i0, j, (dg ? m[0] : 0.f) + (j == i0 ? 1.f : 0.f), (dg ? m[1] : 0.f) + (j == i0 + 1 ? 1.f : 0.f), (dg ? m[2] : 0.f) + (j == i0 + 2 ? 1.f : 0.f), (dg ? m[3] : 0.f) + (j == i0 + 3 ? 1.f : 0.f));
        st_img(SLOT(12), i0, j, dg ? 0.f : m[0], dg ? 0.f : m[1], dg ? 0.f : m[2], dg ? 0.f : m[3]); }, lane, wave);
    mm64<0, 0>(SLOT(0), SLOT(2), [=](int i0, int j, f32x4 a) {
        float m[4];
#pragma unroll
        for (int r = 0; r < 4; ++r) { const bool keep = dir ? (j > i0 + r) : (j < i0 + r); m[r] = keep ? a[r] : 0.f; }
        st_img(SLOT(9), i0, j, m[0], m[1], m[2], m[3]); }, lane, wave);
    mm64<0, 0>(SLOT(3), SLOT(1), [=](int i0, int j, f32x4 a) {
        float m[4];
#pragma unroll
        for (int r = 0; r < 4; ++r) { const bool keep = dir ? (j >= i0 + r) : (j <= i0 + r); m[r] = keep ? a[r] : 0.f; }
        st_img(SLOT(10), i0, j, m[0], m[1], m[2], m[3]); }, lane, wave);
    mm64<0, 0>(SLOT(3), SLOT(2), [=](int i0, int j, f32x4 a) {
        float m[4];
#pragma unroll
        for (int r = 0; r < 4; ++r) { const bool keep = dir ? (j >= i0 + r) : (j <= i0 + r); m[r] = keep ? a[r] : 0.f; }
        st_img(SLOT(11), i0, j, m[0], m[1], m[2], m[3]); }, lane, wave);
    __syncthreads();
    {
        bf16_t* Pc = SLOT(7); bf16_t* Pn = SLOT(1); bf16_t* Tc = SLOT(8); bf16_t* Tn = SLOT(2);
#pragma unroll 1
        for (int it = 0; it < 3; ++it) {
            mm64<0, 1>(Pc, Pc, [=](int i0, int j, f32x4 a) { st_img(Pn, i0, j, a[0], a[1], a[2], a[3]); }, lane, wave);
            __syncthreads();
            mm64<0, 1>(Tc, Pn, [=](int i0, int j, f32x4 a) {
                st_img(Tn, i0, j, a[0] + bf2f(Tc[(i0 + 0) * 72 + j]), a[1] + bf2f(Tc[(i0 + 1) * 72 + j]), a[2] + bf2f(Tc[(i0 + 2) * 72 + j]), a[3] + bf2f(Tc[(i0 + 3) * 72 + j])); }, lane, wave);
            __syncthreads();
            bf16_t* tmp = Pc; Pc = Pn; Pn = tmp; tmp = Tc; Tc = Tn; Tn = tmp;
        }
    }
    mm64<0, 1>(SLOT(2), SLOT(12), [=](int i0, int j, f32x4 a) { st_img(SLOT(7), i0, j, a[0], a[1], a[2], a[3]); }, lane, wave);
    mm64<0, 1>(SLOT(2), SLOT(0), [=](int i0, int j, f32x4 a) { st_img(SLOT(1), i0, j, a[0], a[1], a[2], a[3]); }, lane, wave);
    mm64<0, 1>(SLOT(9), SLOT(6), [=](int i0, int j, f32x4 a) { st_img(SLOT(13), i0, j, a[0], a[1], a[2], a[3]); }, lane, wave);
    __syncthreads();
    mm64<0, 1>(SLOT(2), SLOT(13), [=](int i0, int j, f32x4 a) { st_img(SLOT(8), i0, j, a[0], a[1], a[2], a[3]); }, lane, wave);
    __syncthreads();
    {
        const bf16_t* Zp = (wave < 4) ? SLOT(1) : SLOT(8);
        bf16_t* Xi = (wave < 4) ? SLOT(12) : SLOT(9);
        const int ct = (wave & 3) * 16, g4 = (lane >> 4) * 4, l15 = lane & 15;
#pragma unroll
        for (int bs = 0; bs < 4; ++bs) {
            const int bi = dir ? 3 - bs : bs;
            f32x4 acc;
#pragma unroll
            for (int r = 0; r < 4; ++r) acc[r] = bf2f(Zp[(bi * 16 + g4 + r) * 72 + ct + l15]);
            const bool k0 = dir ? (bi == 0) : (bi >= 1), k1 = dir ? (bi <= 2) : (bi == 3);
            if (k0) acc = __builtin_amdgcn_mfma_f32_16x16x32_bf16(row_frag(SLOT(7), 72, bi * 16, 0, lane), tr_frag(Xi, 72, 0, ct, lane), acc, 0, 0, 0);
            if (k1) acc = __builtin_amdgcn_mfma_f32_16x16x32_bf16(row_frag(SLOT(7), 72, bi * 16, 32, lane), tr_frag(Xi, 72, 32, ct, lane), acc, 0, 0, 0);
            st_img(Xi, bi * 16 + g4, ct + l15, acc[0], acc[1], acc[2], acc[3]);
            __syncthreads();
        }
    }
    mm64<1, 1>(SLOT(12), SLOT(4), [=](int i0, int j, f32x4 a) {
        float m[4];
#pragma unroll
        for (int r = 0; r < 4; ++r) m[r] = a[r] + ((i0 + r) == j ? fexp(sv[j]) : 0.f);
        *(uint2*)(RU + j * 64 + i0) = make_uint2(pack2bf(m[0], m[1]), pack2bf(m[2], m[3])); }, lane, wave);
    mm64x2<1, 1>(SLOT(4), SLOT(9), SLOT(5), SLOT(6), [=](int i0, int j, f32x4 a) {
        *(uint2*)(RU + 4096 + j * 64 + i0) = make_uint2(pack2bf(a[0], a[1]), pack2bf(a[2], a[3])); }, lane, wave);
    mm64<1, 0>(SLOT(12), SLOT(10), [=](int i0, int j, f32x4 a) {
        const uint2 rr = *(const uint2*)(SLOT(3) + j * 72 + i0);
        *(uint2*)(RU + 8192 + j * 64 + i0) = make_uint2(pack2bf(a[0] + bflo(rr.x), a[1] + bfhi(rr.x)), pack2bf(a[2] + bflo(rr.y), a[3] + bfhi(rr.y))); }, lane, wave);
    mm64x2<0, 1>(SLOT(10), SLOT(9), SLOT(11), SLOT(6), [=](int i0, int j, f32x4 a) {
        *(uint2*)(RU + 12288 + j * 64 + i0) = make_uint2(pack2bf(a[0], a[1]), pack2bf(a[2], a[3])); }, lane, wave);
#undef SLOT
}

#define R2_LOAD(M_, C_, rnd_) do { const int r0_ = ((rnd_) < R2_NR ? (rnd_) : R2_NR - 1) * R2_RS; \
    _Pragma("unroll") for (int s_ = 0; s_ < R2_RS; ++s_) M_[s_] = *(const uint4*)(RU + (size_t)(chain * NCH + chunk_at(dir, r0_ + s_)) * 16384 + tid * 8); \
    _Pragma("unroll") for (int j_ = 0; j_ < 3; ++j_) { const int cq_ = tid + 512 * j_; \
        C_[j_] = *(const uint4*)(RU + (size_t)(chain * NCH + chunk_at(dir, r0_ + (cq_ >> 7))) * 16384 + 4096 + (vblk * 16 + ((cq_ >> 3) & 15)) * 64 + (cq_ & 7) * 8); } } while (0)
#define R2_ROUND(M_, C_, rnd_) do { \
    { const int row_ = tid >> 3, c8_ = tid & 7, sw_ = (row_ >> 1) & 7, u0_ = (c8_ >> 2) * 4 + (c8_ & 1) * 2, eh_ = ((c8_ >> 1) & 1) * 8; \
      _Pragma("unroll") for (int s_ = 0; s_ < R2_RS; ++s_) { char* sl_ = ring + s_ * 10240 + row_ * 128 + eh_; \
          *(uint2*)(sl_ + ((u0_ ^ sw_) * 16)) = make_uint2(M_[s_].x, M_[s_].y); *(uint2*)(sl_ + (((u0_ + 1) ^ sw_) * 16)) = make_uint2(M_[s_].z, M_[s_].w); } \
      _Pragma("unroll") for (int j_ = 0; j_ < 3; ++j_) { const int cq_ = tid + 512 * j_, rw_ = (cq_ >> 3) & 15, q8_ = cq_ & 7, i_ = q8_ >> 1, g0_ = (q8_ & 1) * 2, sc_ = (rw_ >> 1) & 7; \
          char* sl_ = ring + (cq_ >> 7) * 10240 + 8192 + rw_ * 128 + (i_ & 1) * 8; \
          *(uint2*)(sl_ + (((g0_ * 2 + (i_ >> 1)) ^ sc_) * 16)) = make_uint2(C_[j_].x, C_[j_].y); *(uint2*)(sl_ + ((((g0_ + 1) * 2 + (i_ >> 1)) ^ sc_) * 16)) = make_uint2(C_[j_].z, C_[j_].w); } } \
    R2_LOAD(M_, C_, (rnd_) + 2); \
    __syncthreads(); \
    if (wave == 0) { \
        _Pragma("unroll 4") for (int s_ = 0; s_ < R2_RS; ++s_) { \
            const int c_ = chunk_at(dir, (rnd_) * R2_RS + s_); const char* sl_ = ring + s_ * 10240; \
            unsigned pk_[4][2]; \
            _Pragma("unroll") for (int i_ = 0; i_ < 4; ++i_) { pk_[i_][0] = pack2bf(st[i_][0], st[i_][1]); pk_[i_][1] = pack2bf(st[i_][2], st[i_][3]); } \
            bf16_t* sp_ = S0G + ((size_t)(chain * NCH + c_) * 64 + vblk * 16 + l15) * 64 + g * 4; \
            _Pragma("unroll") for (int i_ = 0; i_ < 4; ++i_) *(uint2*)(sp_ + i_ * 16) = make_uint2(pk_[i_][0], pk_[i_][1]); \
            bf16x8 bfr_[2]; \
            _Pragma("unroll") for (int ks_ = 0; ks_ < 2; ++ks_) { const uint4 u_ = make_uint4(pk_[2 * ks_][0], pk_[2 * ks_][1], pk_[2 * ks_ + 1][0], pk_[2 * ks_ + 1][1]); bfr_[ks_] = __builtin_bit_cast(bf16x8, u_); } \
            const uint4 c01_ = *(const uint4*)(sl_ + 8192 + l15 * 128 + (((g * 2) ^ ((l15 >> 1) & 7)) * 16)), c23_ = *(const uint4*)(sl_ + 8192 + l15 * 128 + (((g * 2 + 1) ^ ((l15 >> 1) & 7)) * 16)); \
            const unsigned cw_[8] = {c01_.x, c01_.y, c01_.z, c01_.w, c23_.x, c23_.y, c23_.z, c23_.w}; \
            _Pragma("unroll") for (int i_ = 0; i_ < 4; ++i_) { \
                f32x4 acc_ = (f32x4){bflo(cw_[2 * i_]), bfhi(cw_[2 * i_]), bflo(cw_[2 * i_ + 1]), bfhi(cw_[2 * i_ + 1])}; \
                _Pragma("unroll") for (int ks_ = 0; ks_ < 2; ++ks_) { \
                    const int row_ = i_ * 16 + l15; \
                    const bf16x8 af_ = *(const bf16x8*)(sl_ + row_ * 128 + (((ks_ * 4 + g) ^ ((row_ >> 1) & 7)) * 16)); \
                    acc_ = __builtin_amdgcn_mfma_f32_16x16x32_bf16(af_, bfr_[ks_], acc_, 0, 0, 0); } \
                st[i_] = acc_; } } } \
    __syncthreads(); } while (0)
DEV void rwkv2_unit(const Params& p, int chain, int vblk, float* sm) {
    constexpr int R2_RS = 12, R2_NR = NCH / R2_RS;
    static_assert(R2_NR * R2_RS == NCH && R2_RS * 10240 <= LDS_BYTES, "R2 ring");
    const int tid = opaque_tid(), lane = tid & 63, wave = tid >> 6;
    const bf16_t* RU = (const bf16_t*)(p.ws + OFF_RU);
    bf16_t* S0G = (bf16_t*)(p.ws + OFF_RS0);
    char* ring = (char*)sm;
    const int dir = chain & 1, g = lane >> 4, l15 = lane & 15;
    f32x4 st[4];
#pragma unroll
    for (int i = 0; i < 4; ++i) st[i] = (f32x4){0.f, 0.f, 0.f, 0.f};
    uint4 ma[R2_RS], ca[3], mb[R2_RS], cb[3];
    __syncthreads();
    R2_LOAD(ma, ca, 0); R2_LOAD(mb, cb, 1);
#pragma unroll 1
    for (int rnd = 0; rnd < R2_NR; rnd += 2) {
        R2_ROUND(ma, ca, rnd);
        if (rnd + 1 < R2_NR) R2_ROUND(mb, cb, rnd + 1);
    }
}
#undef R2_LOAD
#undef R2_ROUND

DEV void rwkv3_unit(const Params& p, int h, int c, float* sm) {
    const int tid = opaque_tid(), lane = tid & 63, wave = tid >> 6;
    const bf16_t* P0 = (const bf16_t*)(p.ws + OFF_P0);
    const bf16_t* RUb = (const bf16_t*)(p.ws + OFF_RU);
    const bf16_t* S0G = (const bf16_t*)(p.ws + OFF_RS0);
    const float* BONS = (const float*)(p.ws + OFF_BONS);
    bf16_t* YC = (bf16_t*)(p.ws + OFF_YC);
    const float* mu = p.in[15]; const float* gn_g = p.in[27]; const float* gn_b = p.in[28];
    bf16_t* img = (bf16_t*)sm;
    float* O = sm + 4 * 2304;
    const int t = tid >> 3, v0 = (tid & 7) * 8, s = c * 64 + t;
    const size_t u0 = (size_t)((h * 2 + 0) * NCH + c), u1 = (size_t)((h * 2 + 1) * NCH + c);
    const uint4 gr0 = *(const uint4*)(RUb + u0 * 16384 + 8192 + t * 64 + v0), gs0 = *(const uint4*)(S0G + u0 * 4096 + t * 64 + v0);
    const uint4 gr1 = *(const uint4*)(RUb + u1 * 16384 + 8192 + t * 64 + v0), gs1 = *(const uint4*)(S0G + u1 * 4096 + t * 64 + v0);
    uint2 yl[2][2];
#pragma unroll
    for (int q = 0; q < 2; ++q) { const int idx = wave * 2 + q, ti = idx >> 2, tj = idx & 3;
        yl[q][0] = *(const uint2*)(RUb + u0 * 16384 + 12288 + (tj * 16 + (lane & 15)) * 64 + ti * 16 + (lane >> 4) * 4);
        yl[q][1] = *(const uint2*)(RUb + u1 * 16384 + 12288 + (tj * 16 + (lane & 15)) * 64 + ti * 16 + (lane >> 4) * 4); }
    const RwNb nbq = rw_nb(s);
    const RwRaw wv_ = rw_load(P0, s, nbq, 1024 + h * 64 + v0), wg_ = rw_load(P0, s, nbq, 1536 + h * 64 + v0);
    const float bon = BONS[(size_t)s * 8 + h] + BONS[((size_t)TB + s) * 8 + h];
    __syncthreads();
    *(uint4*)(img + 0 * 4608 + t * 72 + v0) = gr0; *(uint4*)(img + 2 * 4608 + t * 72 + v0) = gs0;
    *(uint4*)(img + 1 * 4608 + t * 72 + v0) = gr1; *(uint4*)(img + 3 * 4608 + t * 72 + v0) = gs1;
    __syncthreads();
#pragma unroll
    for (int q = 0; q < 2; ++q) {
        const int idx = wave * 2 + q, ti = idx >> 2, tj = idx & 3;
        f32x4 accd[2];
#pragma unroll
        for (int dir = 0; dir < 2; ++dir) {
            f32x4 acc = (f32x4){bflo(yl[q][dir].x), bfhi(yl[q][dir].x), bflo(yl[q][dir].y), bfhi(yl[q][dir].y)};
#pragma unroll
            for (int ks = 0; ks < 2; ++ks) acc = __builtin_amdgcn_mfma_f32_16x16x32_bf16(row_frag(img + dir * 4608, 72, ti * 16, ks * 32, lane), row_frag(img + (2 + dir) * 4608, 72, tj * 16, ks * 32, lane), acc, 0, 0, 0);
            accd[dir] = acc;
        }
#pragma unroll
        for (int r = 0; r < 4; ++r) {
            const int oi = (ti * 16 + (lane >> 4) * 4 + r) * 68 + tj * 16 + (lane & 15);
            O[oi] = accd[0][r] + accd[1][r];
        }
    }
    __syncthreads();
    {
        float y[8], sum = 0.f;
#pragma unroll
        for (int i = 0; i < 8; ++i) { y[i] = O[t * 68 + v0 + i]; sum += y[i]; }
        sum += __shfl_xor(sum, 1, 64); sum += __shfl_xor(sum, 2, 64); sum += __shfl_xor(sum, 4, 64);
        const float mean = sum * (1.f / 64.f);
        float sq = 0.f;
#pragma unroll
        for (int i = 0; i < 8; ++i) { y[i] -= mean; sq += y[i] * y[i]; }
        sq += __shfl_xor(sq, 1, 64); sq += __shfl_xor(sq, 2, 64); sq += __shfl_xor(sq, 4, 64);
        const float rstd = rsqrtf(sq * (1.f / 64.f) + 64e-5f);
        float vm[8], gm[8];
        rw_comb(wv_, nbq, mu, 1024 + h * 64 + v0, vm);
        rw_comb(wg_, nbq, mu, 1536 + h * 64 + v0, gm);
        float o[8];
#pragma unroll
        for (int i = 0; i < 8; ++i) o[i] = (y[i] * rstd * gn_g[h * 64 + v0 + i] + gn_b[h * 64 + v0 + i] + bon * vm[i]) * silu_f(gm[i]);
        *(uint4*)(YC + (size_t)s * 1024 + 512 + h * 64 + v0) = pack8(o);
    }
}

DEV void ln_rows(const float* src, const float* res_lat, const float* res_cx, int nrows, const float* __restrict__ g, const float* __restrict__ bt, float* dst_lat, float* dst_cx, int ncx,
                 bf16_t* hb = nullptr, const float* mvc = nullptr, const float* mvl = nullptr) {
    const int tid_ = opaque_tid(); const int lane = tid_ & 63, gw = blockIdx.x * NWV + (tid_ >> 6), ngw = gridDim.x * NWV;
    float4 gg[4], bb[4];
#pragma unroll
    for (int i = 0; i < 4; ++i) { gg[i] = ld4(g + i * 256 + lane * 4); bb[i] = ld4(bt + i * 256 + lane * 4); }
    float4 na[4], nr[4];
    { const int r = gw < nrows ? gw : 0; const float* x = src + (size_t)r * 1024; const float* xr = (r < ncx) ? (res_cx + (size_t)r * 1024) : (res_lat + (size_t)(r - ncx) * 1024);
#pragma unroll
      for (int i = 0; i < 4; ++i) { na[i] = ld4(x + i * 256 + lane * 4); nr[i] = ld4(xr + i * 256 + lane * 4); } }
    for (int r = gw; r < nrows; r += ngw) {
        float4 v[4];
        float sum = 0.f;
#pragma unroll
        for (int i = 0; i < 4; ++i) { const float4 a = na[i], rr = nr[i];
            v[i] = make_float4(ALPHA * rr.x + a.x, ALPHA * rr.y + a.y, ALPHA * rr.z + a.z, ALPHA * rr.w + a.w); sum += v[i].x + v[i].y + v[i].z + v[i].w; }
        { const int rn = (r + ngw < nrows) ? r + ngw : r; const float* x = src + (size_t)rn * 1024; const float* xr = (rn < ncx) ? (res_cx + (size_t)rn * 1024) : (res_lat + (size_t)(rn - ncx) * 1024);
#pragma unroll
          for (int i = 0; i < 4; ++i) { na[i] = ld4(x + i * 256 + lane * 4); nr[i] = ld4(xr + i * 256 + lane * 4); } }
        const float mean = wave_sum(sum) * (1.f / 1024.f);
        float sq = 0.f;
#pragma unroll
        for (int i = 0; i < 4; ++i) {
            v[i].x -= mean; v[i].y -= mean; v[i].z -= mean; v[i].w -= mean;
            sq += v[i].x * v[i].x + v[i].y * v[i].y + v[i].z * v[i].z + v[i].w * v[i].w;
        }
        const float rstd = rsqrtf(wave_sum(sq) * (1.f / 1024.f) + 1e-5f);
        float* d = (r < ncx) ? (dst_cx + (size_t)r * 1024) : (dst_lat + (size_t)(r - ncx) * 1024);
#pragma unroll
        for (int i = 0; i < 4; ++i) {
            const int c = i * 256 + lane * 4;
            const float4 y = make_float4(v[i].x * rstd * gg[i].x + bb[i].x, v[i].y * rstd * gg[i].y + bb[i].y, v[i].z * rstd * gg[i].z + bb[i].z, v[i].w * rstd * gg[i].w + bb[i].w);
            st4(d + c, y);
            if (hb != nullptr) {
                const float* m = (r < ncx) ? mvc : mvl;
                const float4 sh = ld4(m + c), sc = ld4(m + 1024 + c);
                *(uint2*)(hb + (size_t)r * 1024 + c) = make_uint2(pack2bf(y.x * (1.f + sc.x) + sh.x, y.y * (1.f + sc.y) + sh.y), pack2bf(y.z * (1.f + sc.z) + sh.z, y.w * (1.f + sc.w) + sh.w));
            }
        }
    }
}
DEV void phase_h1l(const Params& p) {
    const float* modv1 = (const float*)(p.ws + OFF_MODV) + 3 * 3072;
    bf16_t* H1 = (bf16_t*)(p.ws + OFF_H1B);
    const size_t gt = (size_t)blockIdx.x * NTHR + opaque_tid(), gn = (size_t)gridDim.x * NTHR;
    const int k = (int)(gt & 127) * 8;
    const Mod8 m0 = mod8_load(modv1, k), m1 = mod8_load(modv1 + 3072, k);
    constexpr size_t NI = (size_t)NB * NL * 128;
    for (size_t i0 = gt; i0 < NI; i0 += 4 * gn) {
        float4 xa[4], xb[4];
#pragma unroll
        for (int u = 0; u < 4; ++u) { const size_t i = i0 + u * gn, r = (i < NI ? i : gt) >> 7; xa[u] = ld4(p.out + r * DM + k); xb[u] = ld4(p.out + r * DM + k + 4); }
#pragma unroll
        for (int u = 0; u < 4; ++u) { const size_t i = i0 + u * gn, r = i >> 7; if (i < NI) *(uint4*)(H1 + r * DM + k) = mod8_apply(xa[u], xb[u], (r >= (size_t)NL) ? m1 : m0); }
    }
}

DEV void zero_f4(float* ptr, size_t nfloat) {
    const size_t n4 = nfloat / 4;
    for (size_t i = (size_t)blockIdx.x * NTHR + opaque_tid(); i < n4; i += (size_t)gridDim.x * NTHR) ((float4*)ptr)[i] = make_float4(0.f, 0.f, 0.f, 0.f);
}

DEV void chain_ids(int& chain, int& sub) {
    const int bid = blockIdx.x, xcd = bid & 7, idx = bid >> 3;
    chain = xcd * 2 + (idx >> 4); sub = idx & 15;
}

DEV void phase_conv1(const Params& p, float* sm) {
    const bf16_t* XM = (const bf16_t*)(p.ws + OFF_XM);
    bf16_t* XC = (bf16_t*)(p.ws + OFF_XC);
    float* G16P = (float*)(p.ws + OFF_G16P);
    const bf16_t* WFT = (const bf16_t*)(p.ws + OFF_WFT);
    const float* cw = p.in[31]; const float* cbias = p.in[32];
    bf16_t* imgC = (bf16_t*)sm;
    bf16_t* imgM = imgC + 64 * 264;
    float* red = (float*)(imgM + 64 * 264);
    float* cwl = red + 1024;
    const int tid = opaque_tid(), lane = tid & 63, wave = tid >> 6, t = tid >> 3, cg = tid & 7;
    for (int u = blockIdx.x; u < NB * NCH * 4; u += gridDim.x) {
        const int ci = u >> 2, q = u & 3, b = ci / NCH, c = ci % NCH, s = c * 64 + t;
        const size_t rowbase = (size_t)b * TB;
        int nrow[9]; unsigned vmask = 0u;
#pragma unroll
        for (int i = 0; i < 3; ++i)
#pragma unroll
            for (int j = 0; j < 3; ++j) {
                int ns = -1;
                if (s < NCX) { const int w2 = s + j - 1; if (i == 1 && w2 >= 0 && w2 < NCX) ns = w2; }
                else { const int n = s - NCX, rr = (n >> 6) + i - 1, w2 = (n & 63) + j - 1; if (rr >= 0 && rr < 128 && w2 >= 0 && w2 < 64) ns = NCX + rr * 64 + w2; }
                nrow[i * 3 + j] = ns >= 0 ? ns : s; vmask |= (ns >= 0 ? 1u : 0u) << (i * 3 + j);
            }
        const int tt = wave & 3, part = wave >> 2;
        f32x4 acc = (f32x4){0.f, 0.f, 0.f, 0.f};
        uint4 xn[9];
#pragma unroll
        for (int tap = 0; tap < 9; ++tap) xn[tap] = *(const uint4*)(XM + (rowbase + nrow[tap]) * 2048 + q * 512 + cg * 8);
#pragma unroll 1
        for (int half = 0; half < 2; ++half) {
            __syncthreads();
            for (int i = tid; i < 640; i += NTHR) { const int tp = i >> 6, c4 = (i & 63) * 4; st4(cwl + tp * 256 + c4, ld4((tp < 9 ? cw + tp * 2048 : cbias) + q * 512 + half * 256 + c4)); }
            __syncthreads();
#pragma unroll 1
            for (int it = 0; it < 4; ++it) {
                const int cl = it * 64 + cg * 8, c0 = q * 512 + half * 256 + cl;
                uint4 xc9[9];
#pragma unroll
                for (int tap = 0; tap < 9; ++tap) xc9[tap] = xn[tap];
                { const int gn = half * 4 + it + 1, c0n = q * 512 + (gn < 8 ? gn : 7) * 64 + cg * 8;
#pragma unroll
                  for (int tap = 0; tap < 9; ++tap) xn[tap] = *(const uint4*)(XM + (rowbase + nrow[tap]) * 2048 + c0n); }
                float a8[8];
                { const float4 b0 = ld4(cwl + 9 * 256 + cl), b1 = ld4(cwl + 9 * 256 + cl + 4); a8[0] = b0.x; a8[1] = b0.y; a8[2] = b0.z; a8[3] = b0.w; a8[4] = b1.x; a8[5] = b1.y; a8[6] = b1.z; a8[7] = b1.w; }
#pragma unroll
                for (int tap = 0; tap < 9; ++tap) {
                    const unsigned mk = ((vmask >> tap) & 1u) ? 0xffffffffu : 0u;
                    const uint4 xv = make_uint4(xc9[tap].x & mk, xc9[tap].y & mk, xc9[tap].z & mk, xc9[tap].w & mk);
                    float x8[8]; unpack8(xv, x8);
                    const float4 w0 = ld4(cwl + tap * 256 + cl), w1 = ld4(cwl + tap * 256 + cl + 4);
                    a8[0] += x8[0] * w0.x; a8[1] += x8[1] * w0.y; a8[2] += x8[2] * w0.z; a8[3] += x8[3] * w0.w;
                    a8[4] += x8[4] * w1.x; a8[5] += x8[5] * w1.y; a8[6] += x8[6] * w1.z; a8[7] += x8[7] * w1.w;
                }
#pragma unroll
                for (int i = 0; i < 8; ++i) a8[i] = silu_f(a8[i]);
                const uint4 xcv = pack8(a8);
                *(uint4*)(XC + (rowbase + s) * 2048 + c0) = xcv;
                *(uint4*)(imgC + t * 264 + cl) = xcv;
                *(uint4*)(imgM + t * 264 + cl) = xc9[4];
            }
            __syncthreads();
            {
                const bf16_t* img = part ? imgM : imgC;
                const bf16_t* wrow = WFT + (size_t)(lane & 15) * 4096 + part * 2048 + q * 512 + half * 256 + (lane >> 4) * 8;
#pragma unroll
                for (int ks = 0; ks < 8; ++ks) acc = __builtin_amdgcn_mfma_f32_16x16x32_bf16(row_frag(img, 264, tt * 16, ks * 32, lane), *(const bf16x8*)(wrow + ks * 32), acc, 0, 0, 0);
            }
        }
        if (part == 1) {
#pragma unroll
            for (int r = 0; r < 4; ++r) red[(tt * 16 + (lane >> 4) * 4 + r) * 16 + (lane & 15)] = acc[r];
        }
        __syncthreads();
        if (part == 0) {
#pragma unroll
            for (int r = 0; r < 4; ++r) {
                const int tk = tt * 16 + (lane >> 4) * 4 + r;
                G16P[(((size_t)rowbase + c * 64 + tk) * 16 + (lane & 15)) * 4 + q] = acc[r] + red[tk * 16 + (lane & 15)];
            }
        }
    }
}

struct GateRaw { float4 a, f; };
DEV GateRaw gate_load(const Params& p, size_t row, int dir, int h) {
    const float* G16P = (const float*)(p.ws + OFF_G16P);
    GateRaw g; g.a = ld4(G16P + (row * 16 + dir * 8 + h) * 4); g.f = ld4(G16P + (row * 16 + dir * 8 + 4 + h) * 4);
    return g;
}
DEV void gate_fin(const GateRaw& g, float bi, float bf, float& gi, float& lf) {
    gi = (g.a.x + g.a.y) + (g.a.z + g.a.w) + bi;
    lf = logsig_f((g.f.x + g.f.y) + (g.f.z + g.f.w) + bf);
}
DEV void gate_pair(const Params& p, size_t row, int dir, int h, float& gi, float& lf) {
    const GateRaw g = gate_load(p, row, dir, h);
    gate_fin(g, p.in[dir ? 41 : 37][h], p.in[dir ? 43 : 39][h], gi, lf);
}

DEV void phase_x1(const Params& p, float* sm) {
    int chain, sub; chain_ids(chain, sub);
    const int b = chain >> 3, h = (chain >> 1) & 3, dir = chain & 1;
    const bf16_t* XC = (const bf16_t*)(p.ws + OFF_XC);
    float* GSC = (float*)(p.ws + OFF_GSC); float* CSC = (float*)(p.ws + OFF_CSC); float* NBUF = (float*)(p.ws + OFF_NBUF);
    const float* gtab = (const float*)(p.ws + OFF_GTAB);
    bf16_t* SMAT = (bf16_t*)(p.ws + OFF_SMAT);
    const int tid = opaque_tid(), lane = tid & 63, wave = tid >> 6;
    float* sTot = sm; float* sRef = sm + 132; float* sM0 = sm + 264; float* sBeta = sm + 400;
    const float bias_i = p.in[dir ? 41 : 37][h], bias_f = p.in[dir ? 43 : 39][h];
    {
        GateRaw gn = gate_load(p, (size_t)b * TB + wave * 64 + lane, dir, h);
        for (int c = wave; c < NCH; c += NWV) {
            const GateRaw gc = gn;
            const int cn = (c + NWV < NCH) ? c + NWV : c;
            gn = gate_load(p, (size_t)b * TB + cn * 64 + lane, dir, h);
            float gi, lf; gate_fin(gc, bias_i, bias_f, gi, lf);
            const float bc = wave_scan_add(lf, lane, dir);
            const float ref = wave_max(gi - bc), tot = wave_sum(lf);
            if (lane == 0) { sTot[c] = tot; sRef[c] = ref; }
        }
    }
    __syncthreads();
    if (tid == 0) {
        float m0 = -INFINITY;
        for (int step = 0; step < NCH; ++step) {
            const int c = chunk_at(dir, step);
            sM0[c] = m0;
            const float mx = fmaxf(m0, sRef[c]);
            if (sub == 0) { CSC[(chain * NCH + c) * 2] = fexp(m0 - mx); CSC[(chain * NCH + c) * 2 + 1] = fexp(sRef[c] - mx); }
            m0 = sTot[c] + mx;
        }
    }
    __syncthreads();
    for (int k = wave; sub + 16 * k < NCH; k += NWV) {
        const int c = sub + 16 * k;
        const size_t row = (size_t)b * TB + c * 64 + lane;
        float gi, lf; gate_fin(gate_load(p, row, dir, h), bias_i, bias_f, gi, lf);
        const float bc = wave_scan_add(lf, lane, dir);
        const float a = gi - bc;
        const float amax = wave_scan_max(a, lane, dir);
        const float ref = sRef[c], m0 = sM0[c];
        const float mmax = fmaxf(amax, m0);
        const float mt = bc + mmax;
        const float alpha = fexp(ref - mmax), beta = fexp(a - ref), gg = fexp(m0 - mmax), em = fexp(-mt);
        st4(GSC + ((size_t)chain * TB + c * 64 + lane) * 4, make_float4(alpha, beta, gg, em));
        sBeta[k * 64 + lane] = beta;
    }
    __syncthreads();
    {
        float* part = sm + 1024;
        const int sg = tid >> 6, j8 = (tid & 63) * 8;
        uint4 xn[8];
        { const bf16_t* xp = XC + ((size_t)b * TB + sub * 64 + sg * 8) * 2048 + h * 512 + j8;
#pragma unroll
          for (int s = 0; s < 8; ++s) xn[s] = *(const uint4*)(xp + (size_t)s * 2048); }
        for (int k = 0; sub + 16 * k < NCH; ++k) {
            const int c = sub + 16 * k;
            uint4 xcur[8];
#pragma unroll
            for (int s = 0; s < 8; ++s) xcur[s] = xn[s];
            { const int cn = (c + 16 < NCH) ? c + 16 : c; const bf16_t* xp = XC + ((size_t)b * TB + cn * 64 + sg * 8) * 2048 + h * 512 + j8;
#pragma unroll
              for (int s = 0; s < 8; ++s) xn[s] = *(const uint4*)(xp + (size_t)s * 2048); }
            float acc[8];
#pragma unroll
            for (int i = 0; i < 8; ++i) acc[i] = 0.f;
#pragma unroll
            for (int s = 0; s < 8; ++s) {
                float f[8]; unpack8(xcur[s], f);
                const float be = sBeta[k * 64 + sg * 8 + s];
#pragma unroll
                for (int i = 0; i < 8; ++i) acc[i] += be * f[i];
            }
            __syncthreads();
            st4(part + sg * 512 + j8, make_float4(acc[0], acc[1], acc[2], acc[3])); st4(part + sg * 512 + j8 + 4, make_float4(acc[4], acc[5], acc[6], acc[7]));
            __syncthreads();
            float tot = 0.f;
#pragma unroll
            for (int q = 0; q < 8; ++q) tot += part[q * 512 + tid];
            NBUF[((size_t)chain * NCH + c) * 512 + tid] = tot;
        }
    }
    bf16_t* XCs = (bf16_t*)sm;
    bf16_t* Qs = XCs + 64 * 520;
    for (int u = blockIdx.x; u < NB * 4 * NCH; u += gridDim.x) {
        const int bh = u / NCH, c = u % NCH, ub = bh >> 2, uh = bh & 3;
        __syncthreads();
        float4 gq[2][4];
#pragma unroll
        for (int bb = 0; bb < 2; ++bb) { const float* G = gtab + (size_t)(uh * 128 + (tid & 63) * 2 + bb) * 16; gq[bb][0] = ld4(G); gq[bb][1] = ld4(G + 4); gq[bb][2] = ld4(G + 8); gq[bb][3] = ld4(G + 12); }
        uint4 xr[8];
#pragma unroll
        for (int i = 0; i < 8; ++i) { const int pp = tid + 512 * i, row = pp >> 6, c16 = pp & 63; xr[i] = *(const uint4*)(XC + ((size_t)ub * TB + c * 64 + row) * 2048 + uh * 512 + c16 * 8); }
#pragma unroll
        for (int i = 0; i < 8; ++i) {
            const int pp = tid + 512 * i, row = pp >> 6, c16 = pp & 63;
            const uint4 xv = xr[i];
            float f[8]; unpack8(xv, f);
            float q[8];
#pragma unroll
            for (int bb = 0; bb < 2; ++bb) {
                const float4 g0 = gq[bb][0], g1 = gq[bb][1], g2 = gq[bb][2], g3 = gq[bb][3];
                q[bb * 4 + 0] = f[bb * 4] * g0.x + f[bb * 4 + 1] * g1.x + f[bb * 4 + 2] * g2.x + f[bb * 4 + 3] * g3.x;
                q[bb * 4 + 1] = f[bb * 4] * g0.y + f[bb * 4 + 1] * g1.y + f[bb * 4 + 2] * g2.y + f[bb * 4 + 3] * g3.y;
                q[bb * 4 + 2] = f[bb * 4] * g0.z + f[bb * 4 + 1] * g1.z + f[bb * 4 + 2] * g2.z + f[bb * 4 + 3] * g3.z;
                q[bb * 4 + 3] = f[bb * 4] * g0.w + f[bb * 4 + 1] * g1.w + f[bb * 4 + 2] * g2.w + f[bb * 4 + 3] * g3.w;
            }
            *(uint4*)(XCs + row * 520 + c16 * 8) = xv;
            *(uint4*)(Qs + row * 520 + c16 * 8) = make_uint4(pack2bf(q[0], q[1]), pack2bf(q[2], q[3]), pack2bf(q[4], q[5]), pack2bf(q[6], q[7]));
        }
        __syncthreads();
        const int st = wave & 3, tt0 = (wave >> 2) * 2;
        f32x4 a0 = (f32x4){0.f, 0.f, 0.f, 0.f}, a1 = a0;
        const bf16_t* ap = XCs + (st * 16 + (lane & 15)) * 520 + (lane >> 4) * 8;
        const bf16_t* bp0 = Qs + (tt0 * 16 + (lane & 15)) * 520 + (lane >> 4) * 8;
        const bf16_t* bp1 = bp0 + 16 * 520;
#pragma unroll
        for (int ks = 0; ks < 16; ++ks) {
            const bf16x8 af = *(const bf16x8*)(ap + ks * 32);
            a0 = __builtin_amdgcn_mfma_f32_16x16x32_bf16(af, *(const bf16x8*)(bp0 + ks * 32), a0, 0, 0, 0);
            a1 = __builtin_amdgcn_mfma_f32_16x16x32_bf16(af, *(const bf16x8*)(bp1 + ks * 32), a1, 0, 0, 0);
        }
        bf16_t* sp = SMAT + (size_t)u * 4096 + (size_t)(tt0 * 16 + (lane & 15)) * 64 + st * 16 + (lane >> 4) * 4;
        *(uint2*)sp = make_uint2(pack2bf(a0[0], a0[1]), pack2bf(a0[2], a0[3]));
        *(uint2*)(sp + 16 * 64) = make_uint2(pack2bf(a1[0], a1[1]), pack2bf(a1[2], a1[3]));
    }
}

DEV void phase_x2(const Params& p, float* sm) {
    int chain, sub; chain_ids(chain, sub);
    const int b = chain >> 3, h = (chain >> 1) & 3, dir = chain & 1;
    const bf16_t* XC = (const bf16_t*)(p.ws + OFF_XC);
    float* GSC = (float*)(p.ws + OFF_GSC); const float* CSC = (const float*)(p.ws + OFF_CSC); const float* NBUF = (const float*)(p.ws + OFF_NBUF);
    const float* gtab = (const float*)(p.ws + OFF_GTAB);
    const bf16_t* SMAT = (const bf16_t*)(p.ws + OFF_SMAT);
    const int tid = opaque_tid();
    float* sD0 = sm; float* sCf = sm + 132; float* sN0 = sm + 264; float* sN2 = sN0 + 9 * 512;
    for (int i = tid; i < NCH; i += NTHR) { sD0[i] = CSC[(chain * NCH + i) * 2]; sCf[i] = CSC[(chain * NCH + i) * 2 + 1]; }
    __syncthreads();
    float* sBeta = sN2 + 9 * 512;
    for (int i = tid; i < 9 * 64; i += NTHR) { const int k = i >> 6, c = sub + 16 * k; if (c < NCH) sBeta[i] = GSC[((size_t)chain * TB + c * 64 + (i & 63)) * 4 + 1]; }
    if (tid < 128) {
        constexpr int NBT = 12;
        float4 n = make_float4(0.f, 0.f, 0.f, 0.f), nx[NBT];
        const float* nb = NBUF + (size_t)chain * NCH * 512 + tid * 4;
#pragma unroll
        for (int j = 0; j < NBT; ++j) nx[j] = ld4(nb + (size_t)chunk_at(dir, j) * 512);
#pragma unroll 1
        for (int step0 = 0; step0 < NCH; step0 += NBT) {
            float4 cu[NBT];
#pragma unroll
            for (int j = 0; j < NBT; ++j) cu[j] = nx[j];
#pragma unroll
            for (int j = 0; j < NBT; ++j) { const int sn = step0 + NBT + j; nx[j] = ld4(nb + (size_t)chunk_at(dir, sn < NCH ? sn : NCH - 1) * 512); }
            __builtin_amdgcn_sched_barrier(0);
#pragma unroll
            for (int j = 0; j < NBT; ++j) {
                const int c = chunk_at(dir, step0 + j);
                if ((c & 15) == sub) st4(sN0 + (c >> 4) * 512 + tid * 4, n);
                const float d = sD0[c], cf = sCf[c];
                n = make_float4(d * n.x + cf * cu[j].x, d * n.y + cf * cu[j].y, d * n.z + cf * cu[j].z, d * n.w + cf * cu[j].w);
            }
        }
    }
    __syncthreads();
    {
        const int blk = tid >> 2, cp = tid & 3;
        const float4 g = ld4(gtab + (size_t)(h * 128 + blk) * 16 + cp * 4);
        for (int k = 0; sub + 16 * k < NCH; ++k) {
            const float* n0 = sN0 + k * 512 + blk * 4;
            sN2[k * 512 + tid] = g.x * n0[0] + g.y * n0[1] + g.z * n0[2] + g.w * n0[3];
        }
    }
    __syncthreads();
    const int t = tid >> 3, part = tid & 7;
    for (int k = 0; sub + 16 * k < NCH; ++k) {
        const int c = sub + 16 * k;
        const size_t row = (size_t)b * TB + c * 64 + t;
        float dint = 0.f;
        {
            const bf16_t* xp = XC + row * 2048 + h * 512 + part * 64;
            const float* n2 = sN2 + k * 512 + part * 64;
#pragma unroll
            for (int i = 0; i < 8; ++i) {
                float f[8]; unpack8(*(const uint4*)(xp + i * 8), f);
                const float4 na = ld4(n2 + i * 8), nb2 = ld4(n2 + i * 8 + 4);
                dint += f[0] * na.x + f[1] * na.y + f[2] * na.z + f[3] * na.w + f[4] * nb2.x + f[5] * nb2.y + f[6] * nb2.z + f[7] * nb2.w;
            }
        }
        float di = 0.f;
        {
            float f[8]; unpack8(*(const uint4*)(SMAT + ((size_t)((b * 4 + h) * NCH + c)) * 4096 + t * 64 + part * 8), f);
#pragma unroll
            for (int e = 0; e < 8; ++e) {
                const int s = part * 8 + e;
                const float beta = sBeta[k * 64 + s];
                const bool keep = dir ? (s >= t) : (s <= t);
                di += keep ? f[e] * beta : 0.f;
            }
        }
        dint += __shfl_xor(dint, 1, 64); dint += __shfl_xor(dint, 2, 64); dint += __shfl_xor(dint, 4, 64);
        di += __shfl_xor(di, 1, 64); di += __shfl_xor(di, 2, 64); di += __shfl_xor(di, 4, 64);
        if (part == 0) {
            float* gp = GSC + ((size_t)chain * TB + c * 64 + t) * 4;
            const float4 g4 = ld4(gp);
            const float den = g4.x * di + g4.z * dint;
            gp[3] = 1.f / fmaxf(fabsf(den), g4.w);
        }
    }
}

#define MLSTM_PREFETCH(step_) do { \
    const int c_ = chunk_at(dir, (step_)); const size_t rb_ = (size_t)b * TB + (size_t)c_ * 64; \
    { const bf16_t* xb_ = XC + (rb_ + (tid >> 6)) * 2048 + h * 512 + (tid & 63) * 8; \
      rx0 = *(const uint4*)(xb_); rx1 = *(const uint4*)(xb_ + 8 * 2048); rx2 = *(const uint4*)(xb_ + 16 * 2048); rx3 = *(const uint4*)(xb_ + 24 * 2048); \
      rx4 = *(const uint4*)(xb_ + 32 * 2048); rx5 = *(const uint4*)(xb_ + 40 * 2048); rx6 = *(const uint4*)(xb_ + 48 * 2048); rx7 = *(const uint4*)(xb_ + 56 * 2048); } \
    rxm = *(const uint2*)(XM + (rb_ + ps) * 2048 + ch0 + pvb * 4); \
    rs = *(const uint4*)(SMAT + ((size_t)((b * 4 + h) * NCH + c_)) * 4096 + ps * 64 + pvb * 8); \
    rbeta = GSC[((size_t)chain * TB + c_ * 64 + ps) * 4 + 1]; \
    if (tid < 64) rsc = ld4(GSC + ((size_t)chain * TB + c_ * 64 + tid) * 4); \
    rd0 = CSC[(chain * NCH + c_) * 2]; rcf = CSC[(chain * NCH + c_) * 2 + 1]; } while (0)

DEV void phase_mlstm(const Params& p, float* sm) {
    int chain, sub; chain_ids(chain, sub);
    const int b = chain >> 3, h = (chain >> 1) & 3, dir = chain & 1;
    const bf16_t* XM = (const bf16_t*)(p.ws + OFF_XM);
    const bf16_t* XC = (const bf16_t*)(p.ws + OFF_XC);
    const bf16_t* SMAT = (const bf16_t*)(p.ws + OFF_SMAT);
    const float* GSC = (const float*)(p.ws + OFF_GSC); const float* CSC = (const float*)(p.ws + OFF_CSC);
    const float* gtab = (const float*)(p.ws + OFF_GTAB);
    bf16_t* H = (bf16_t*)(p.ws + OFF_H);
    const float* wv = p.in[35];
    char* smc = (char*)sm;
    bf16_t* XCs = (bf16_t*)smc;
    bf16_t* Cs = (bf16_t*)(smc + 66560);
    bf16_t* Vb = (bf16_t*)(smc + 66560 + 33280);
    bf16_t* Vw = Vb + 32 * 72;
    bf16_t* Sm = Vw + 32 * 72;
    float* Gs = (float*)(smc + 66560 + 33280 + 2 * 4608 + 9216);
    float* sc = Gs + 2048;
    const int tid = opaque_tid(), lane = tid & 63, wave = tid >> 6;
    for (int i = tid; i < 32 * 520 / 2; i += NTHR) ((unsigned*)Cs)[i] = 0u;
    for (int i = tid; i < 2048; i += NTHR) Gs[i] = gtab[h * 2048 + i];
    const int ps = tid >> 3, pvb = tid & 7;
    const int ch0 = h * 512 + sub * 32;
    float wvr[16];
#pragma unroll
    for (int i = 0; i < 16; ++i) wvr[i] = wv[(size_t)((ch0 >> 2) + pvb) * 16 + i];
    f32x4 accS[4][2];
#pragma unroll
    for (int i = 0; i < 4; ++i) { accS[i][0] = (f32x4){0.f, 0.f, 0.f, 0.f}; accS[i][1] = (f32x4){0.f, 0.f, 0.f, 0.f}; }
    uint4 rx0, rx1, rx2, rx3, rx4, rx5, rx6, rx7; uint2 rxm; uint4 rs; float rbeta; float4 rsc = make_float4(0.f, 0.f, 0.f, 0.f); float rd0, rcf;
    MLSTM_PREFETCH(0);
    __syncthreads();
#pragma unroll 1
    for (int step = 0; step < NCH; ++step) {
        const int c = chunk_at(dir, step);
        const float d0 = rd0, cf = rcf;
        {
            bf16_t* xd = XCs + (tid >> 6) * 520 + (tid & 63) * 8;
            *(uint4*)(xd) = rx0; *(uint4*)(xd + 8 * 520) = rx1; *(uint4*)(xd + 16 * 520) = rx2; *(uint4*)(xd + 24 * 520) = rx3;
            *(uint4*)(xd + 32 * 520) = rx4; *(uint4*)(xd + 40 * 520) = rx5; *(uint4*)(xd + 48 * 520) = rx6; *(uint4*)(xd + 56 * 520) = rx7;
        }
        {
            const float x0 = bflo(rxm.x), x1 = bfhi(rxm.x), x2 = bflo(rxm.y), x3 = bfhi(rxm.y);
#pragma unroll
            for (int d = 0; d < 4; ++d) {
                const float v = (x0 * wvr[d] + x1 * wvr[4 + d] + x2 * wvr[8 + d] + x3 * wvr[12 + d]) * rbeta;
                Vb[(pvb * 4 + d) * 72 + ps] = __builtin_bit_cast(unsigned short, (__bf16)v);
                Vw[(pvb * 4 + d) * 72 + ps] = __builtin_bit_cast(unsigned short, (__bf16)(v * cf));
            }
        }
        {
#define SMASK(q_) (((dir ? (pvb * 8 + 2 * (q_) >= ps) : (pvb * 8 + 2 * (q_) <= ps)) ? 0x0000ffffu : 0u) | ((dir ? (pvb * 8 + 2 * (q_) + 1 >= ps) : (pvb * 8 + 2 * (q_) + 1 <= ps)) ? 0xffff0000u : 0u))
            *(uint4*)(Sm + ps * 72 + pvb * 8) = make_uint4(rs.x & SMASK(0), rs.y & SMASK(1), rs.z & SMASK(2), rs.w & SMASK(3));
#undef SMASK
        }
        if (tid < 64) st4(sc + tid * 4, rsc);
        { const int nstep = (step + 1 < NCH) ? step + 1 : step; MLSTM_PREFETCH(nstep); }
        __syncthreads();
        {
            const int vt = wave & 1, tt = wave >> 1;
            f32x4 ao = (f32x4){0.f, 0.f, 0.f, 0.f}, ai = ao, ao1 = ao, ao2 = ao, ao3 = ao;
            const bf16_t* ap = Cs + (vt * 16 + (lane & 15)) * 520 + (lane >> 4) * 8;
            const bf16_t* bp = XCs + (tt * 16 + (lane & 15)) * 520 + (lane >> 4) * 8;
#pragma unroll
            for (int ks = 0; ks < 16; ks += 4) {
                ao = __builtin_amdgcn_mfma_f32_16x16x32_bf16(*(const bf16x8*)(ap + ks * 32), *(const bf16x8*)(bp + ks * 32), ao, 0, 0, 0);
                ao1 = __builtin_amdgcn_mfma_f32_16x16x32_bf16(*(const bf16x8*)(ap + (ks + 1) * 32), *(const bf16x8*)(bp + (ks + 1) * 32), ao1, 0, 0, 0);
                ao2 = __builtin_amdgcn_mfma_f32_16x16x32_bf16(*(const bf16x8*)(ap + (ks + 2) * 32), *(const bf16x8*)(bp + (ks + 2) * 32), ao2, 0, 0, 0);
                ao3 = __builtin_amdgcn_mfma_f32_16x16x32_bf16(*(const bf16x8*)(ap + (ks + 3) * 32), *(const bf16x8*)(bp + (ks + 3) * 32), ao3, 0, 0, 0);
            }
            ao = (ao + ao1) + (ao2 + ao3);
            const bf16_t* ap2 = Vb + (vt * 16 + (lane & 15)) * 72 + (lane >> 4) * 8;
            const bf16_t* bp2 = Sm + (tt * 16 + (lane & 15)) * 72 + (lane >> 4) * 8;
#pragma unroll
            for (int ks = 0; ks < 2; ++ks) ai = __builtin_amdgcn_mfma_f32_16x16x32_bf16(*(const bf16x8*)(ap2 + ks * 32), *(const bf16x8*)(bp2 + ks * 32), ai, 0, 0, 0);
            if (c >= 4) {
                const int t = tt * 16 + (lane & 15);
                const float4 s4 = ld4(sc + t * 4);
                const float h0 = (s4.x * ai[0] + s4.z * ao[0]) * s4.w, h1 = (s4.x * ai[1] + s4.z * ao[1]) * s4.w;
                const float h2 = (s4.x * ai[2] + s4.z * ao[2]) * s4.w, h3 = (s4.x * ai[3] + s4.z * ao[3]) * s4.w;
                bf16_t* hp = H + ((size_t)b * NL + (size_t)c * 64 + t - NCX) * 2048 + ch0 + vt * 16 + (lane >> 4) * 4;
                const unsigned u0 = pack2bf(h0, h1), u1 = pack2bf(h2, h3);
                __builtin_amdgcn_global_atomic_fadd_v2bf16((__attribute__((address_space(1))) s16x2*)hp, __builtin_bit_cast(s16x2, u0));
                __builtin_amdgcn_global_atomic_fadd_v2bf16((__attribute__((address_space(1))) s16x2*)(hp + 2), __builtin_bit_cast(s16x2, u1));
            }
        }
#pragma unroll
        for (int jt = 0; jt < 4; ++jt) { accS[jt][0] *= d0; accS[jt][1] *= d0; }
#pragma unroll
        for (int ks = 0; ks < 2; ++ks) {
            const bf16x8 b0 = *(const bf16x8*)(Vw + (lane & 15) * 72 + ks * 32 + (lane >> 4) * 8);
            const bf16x8 b1 = *(const bf16x8*)(Vw + (16 + (lane & 15)) * 72 + ks * 32 + (lane >> 4) * 8);
            const int row0 = ks * 32 + (lane >> 4) * 8 + ((lane & 15) >> 2);
#pragma unroll
            for (int jt = 0; jt < 4; ++jt) {
                const int col = wave * 64 + jt * 16 + (lane & 3) * 4;
                const s16x4 lo = __builtin_amdgcn_ds_read_tr16_b64_v4i16((__attribute__((address_space(3))) s16x4*)(XCs + row0 * 520 + col));
                const s16x4 hi = __builtin_amdgcn_ds_read_tr16_b64_v4i16((__attribute__((address_space(3))) s16x4*)(XCs + (row0 + 4) * 520 + col));
                const bf16x8 af = (bf16x8){lo[0], lo[1], lo[2], lo[3], hi[0], hi[1], hi[2], hi[3]};
                accS[jt][0] = __builtin_amdgcn_mfma_f32_16x16x32_bf16(af, b0, accS[jt][0], 0, 0, 0);
                accS[jt][1] = __builtin_amdgcn_mfma_f32_16x16x32_bf16(af, b1, accS[jt][1], 0, 0, 0);
            }
        }
        __syncthreads();
#pragma unroll
        for (int jt = 0; jt < 4; ++jt) {
            const int blk = wave * 16 + jt * 4 + (lane >> 4);
            const float4 g0 = ld4(Gs + blk * 16), g1 = ld4(Gs + blk * 16 + 4), g2 = ld4(Gs + blk * 16 + 8), g3 = ld4(Gs + blk * 16 + 12);
#pragma unroll
            for (int v2 = 0; v2 < 2; ++v2) {
                const f32x4 a = accS[jt][v2];
                const float o0 = g0.x * a[0] + g0.y * a[1] + g0.z * a[2] + g0.w * a[3];
                const float o1 = g1.x * a[0] + g1.y * a[1] + g1.z * a[2] + g1.w * a[3];
                const float o2 = g2.x * a[0] + g2.y * a[1] + g2.z * a[2] + g2.w * a[3];
                const float o3 = g3.x * a[0] + g3.y * a[1] + g3.z * a[2] + g3.w * a[3];
                *(uint2*)(Cs + (v2 * 16 + (lane & 15)) * 520 + blk * 4) = make_uint2(pack2bf(o0, o1), pack2bf(o2, o3));
            }
        }
    }
}

DEV void phase_finish1(const Params& p) {
    bf16_t* H = (bf16_t*)(p.ws + OFF_H);
    const bf16_t* XC = (const bf16_t*)(p.ws + OFF_XC);
    const bf16_t* Z = (const bf16_t*)(p.ws + OFF_XM);
    const float* ng = p.in[44]; const float* skip = p.in[45];
    const int tid_ = opaque_tid(); const int lane = tid_ & 63, gw = blockIdx.x * NWV + (tid_ >> 6), ngw = gridDim.x * NWV;
    const int h = gw & 3, c0 = h * 512 + lane * 8;
    float gn8[8], sk8[8];
    { const float4 a0 = ld4(ng + c0), a1 = ld4(ng + c0 + 4), b0 = ld4(skip + c0), b1 = ld4(skip + c0 + 4);
      gn8[0] = a0.x; gn8[1] = a0.y; gn8[2] = a0.z; gn8[3] = a0.w; gn8[4] = a1.x; gn8[5] = a1.y; gn8[6] = a1.z; gn8[7] = a1.w;
      sk8[0] = b0.x; sk8[1] = b0.y; sk8[2] = b0.z; sk8[3] = b0.w; sk8[4] = b1.x; sk8[5] = b1.y; sk8[6] = b1.z; sk8[7] = b1.w; }
    constexpr int NIT = NB * NL * 4;
    uint4 nh[2], nx[2], nz[2];
#pragma unroll
    for (int u = 0; u < 2; ++u) { const int it = gw + u * ngw, r = (it < NIT ? it : gw) >> 2, b = r >= NL ? 1 : 0, nn = r - b * NL;
        nh[u] = *(const uint4*)(H + (size_t)r * 2048 + c0); nx[u] = *(const uint4*)(XC + ((size_t)b * TB + NCX + nn) * 2048 + c0); nz[u] = *(const uint4*)(Z + (size_t)r * 2048 + c0); }
    for (int it0 = gw; it0 < NIT; it0 += 2 * ngw) {
        uint4 ch[2], cx[2], cz[2];
#pragma unroll
        for (int u = 0; u < 2; ++u) { ch[u] = nh[u]; cx[u] = nx[u]; cz[u] = nz[u]; }
#pragma unroll
        for (int u = 0; u < 2; ++u) { const int it = it0 + (2 + u) * ngw, r = (it < NIT ? it : gw) >> 2, b = r >= NL ? 1 : 0, nn = r - b * NL;
            nh[u] = *(const uint4*)(H + (size_t)r * 2048 + c0); nx[u] = *(const uint4*)(XC + ((size_t)b * TB + NCX + nn) * 2048 + c0); nz[u] = *(const uint4*)(Z + (size_t)r * 2048 + c0); }
#pragma unroll
        for (int u = 0; u < 2; ++u) {
            const int it = it0 + u * ngw, r = it >> 2;
            float v[8]; unpack8(ch[u], v);
            float sum = 0.f;
#pragma unroll
            for (int j = 0; j < 8; ++j) sum += v[j];
            const float mean = wave_sum(sum) * (1.f / 512.f);
            float sq = 0.f;
#pragma unroll
            for (int j = 0; j < 8; ++j) { v[j] -= mean; sq += v[j] * v[j]; }
            const float rstd = rsqrtf(wave_sum(sq) * (1.f / 512.f) + 1e-5f);
            float xc[8], z[8];
            unpack8(cx[u], xc); unpack8(cz[u], z);
            float o[8];
#pragma unroll
            for (int j = 0; j < 8; ++j) o[j] = (v[j] * rstd * gn8[j] + sk8[j] * xc[j]) * silu_f(z[j]);
            if (it < NIT) *(uint4*)(H + (size_t)r * 2048 + c0) = make_uint4(pack2bf(o[0], o[1]), pack2bf(o[2], o[3]), pack2bf(o[4], o[5]), pack2bf(o[6], o[7]));
        }
    }
}

__global__ void __launch_bounds__(NTHR) fwd_kernel(Params p) {
    extern __shared__ __attribute__((aligned(16))) float sm[];
    volatile LAS unsigned* xst = (volatile LAS unsigned*)((LAS char*)sm + (LDS_BYTES - 16));
    if (threadIdx.x == 0) { xst[0] = 0u; xst[1] = 0u; }
    __syncthreads();
    const XcdBarrier xbar = xcd_barrier_post((unsigned*)(p.ws + OFF_BAR), xst);
    const int tid = opaque_tid(), lane = tid & 63, wave = tid >> 6;
    float* modv = (float*)(p.ws + OFF_MODV);
    float* X1C = (float*)(p.ws + OFF_X1C);

    phase_mod(p, sm);
    phase_tables(p);
    transpose_convert(p.in[8], 1024, EIN, 4096, (bf16_t*)(p.ws + OFF_WT0), sm);
    transpose_convert(p.in[29], 1024, 4096, 4096, (bf16_t*)(p.ws + OFF_WT1), sm);
    transpose_convert(p.in[9], 1024, 1024, 1024, (bf16_t*)(p.ws + OFF_WT2), sm);
    transpose_convert(p.in[30], 2048, 1024, 1024, (bf16_t*)(p.ws + OFF_WT3), sm);
    xcd_barrier(xbar);

#pragma unroll 1
    for (int b = 0; b < NB; ++b) {
        if (b == 0) { phase_h0(p, 0); xcd_barrier(xbar); }
        run_gemm((const bf16_t*)(p.ws + OFF_YC), (const bf16_t*)(p.ws + OFF_WT0), TB, 4096, DM, EpBf16{(bf16_t*)(p.ws + OFF_P0), EIN, EIN}, sm);
        xcd_barrier(xbar);
        {
            const int x = blockIdx.x & 7, q0 = blockIdx.x >> 3;
            R1Raw R;
            r1_consts(p, x, q0 & 1, sm);
            r1_load(p, x, q0 & 1, q0 >> 1, R);
            for (int q = q0; q < 3 * NCH; q += 32) {
                if (q < 2 * NCH) rwkv1_unit(p, x, q & 1, q >> 1, sm, R, (q + 32 < 2 * NCH) ? ((q + 32) >> 1) : -1);
                else { const int q2 = q - 2 * NCH; if (q2 < 32) gla_consts(p, x >> 1, sm);
                       gla1_unit(p, x >> 1, q2 & 1, (NCH / 2) * (x & 1) + (q2 >> 1), sm); }
            }
        }
        xcd_barrier(xbar);
        if (blockIdx.x < 128) gla2_unit(p, blockIdx.x);
        else if (blockIdx.x < 192) rwkv2_unit(p, (blockIdx.x - 128) >> 2, (blockIdx.x - 128) & 3, sm);
        xcd_barrier(xbar);
        gla_consts(p, (blockIdx.x & 7) >> 1, sm);
        for (int q = blockIdx.x >> 3; q < NCH + NCH / 2; q += 32) {
            const int x = blockIdx.x & 7;
            if (q < NCH) rwkv3_unit(p, x, q, sm);
            else gla3_unit(p, x >> 1, (NCH / 2) * (x & 1) + (q - NCH), sm);
        }
        xcd_barrier(xbar);
        run_gemm((const bf16_t*)(p.ws + OFF_YC), (const bf16_t*)(p.ws + OFF_WT2), TB, DM, DM, EpRes0{(float*)(p.ws + OFF_P0), modv, b}, sm);
        xcd_barrier(xbar);
        ln_rows((const float*)(p.ws + OFF_P0), p.in[0] + (size_t)b * NL * DM, p.in[2] + (size_t)b * NCX * DM, TB, p.in[6], p.in[7], p.out + (size_t)b * NL * DM, X1C + (size_t)b * NCX * DM, NCX,
                (bf16_t*)(p.ws + OFF_H1B) + (size_t)b * TB * DM, modv + (3 + 2) * 3072, modv + (3 + b) * 3072);
        if (b == 0) phase_h0(p, 1);
        xcd_barrier(xbar);
    }

    run_gemm((const bf16_t*)(p.ws + OFF_H1B), (const bf16_t*)(p.ws + OFF_WT1), RT, 2048, DM, EpBf16{(bf16_t*)(p.ws + OFF_XM), 2048, 2048}, sm);
    zero_f4((float*)(p.ws + OFF_H), (size_t)NB * NL * 1024);
    xcd_barrier(xbar);
    phase_conv1(p, sm);
    xcd_barrier(xbar);
    phase_x1(p, sm);
    xcd_barrier(xbar);
    phase_x2(p, sm);
    xcd_barrier(xbar);
    phase_mlstm(p, sm);
    xcd_barrier(xbar);
    phase_h1l(p);
    xcd_barrier(xbar);
    run_gemm((const bf16_t*)(p.ws + OFF_H1B), (const bf16_t*)(p.ws + OFF_WT1) + (size_t)2048 * 1024, NB * NL, 2048, DM, EpBf16{(bf16_t*)(p.ws + OFF_XM), 2048, 2048}, sm);
    xcd_barrier(xbar);
    phase_finish1(p);
    xcd_barrier(xbar);
    run_gemm((const bf16_t*)(p.ws + OFF_H), (const bf16_t*)(p.ws + OFF_WT3), NB * NL, DM, 2048, EpRes1{(float*)(p.ws + OFF_XC), modv + 3 * 3072}, sm);
    xcd_barrier(xbar);
    ln_rows((const float*)(p.ws + OFF_XC), p.out, p.out, NB * NL, p.in[6] + 1024, p.in[7] + 1024, p.out, p.out, 0);
}

extern "C" void kernel_launch(void* const* d_in, const int* in_sizes, int n_in, void* d_out, int out_size, void* d_ws, size_t ws_size, hipStream_t stream) {
    static int grid_blocks = 0;
    if (grid_blocks == 0) {
        if (ws_size < WS_NEED || n_in != 46) { fprintf(stderr, "kernel_launch: bad ws_size %zu (need %zu) or n_in %d\n", ws_size, (size_t)WS_NEED, n_in); grid_blocks = -1; return; }
        int dev = 0, cus = 0, per_cu = 0;
        (void)hipGetDevice(&dev);
        (void)hipDeviceGetAttribute(&cus, hipDeviceAttributeMultiprocessorCount, dev);
        (void)hipFuncSetAttribute((const void*)fwd_kernel, hipFuncAttributeMaxDynamicSharedMemorySize, LDS_BYTES);
        (void)hipOccupancyMaxActiveBlocksPerMultiprocessor(&per_cu, (const void*)fwd_kernel, NTHR, LDS_BYTES);
        if (per_cu < 1 || cus < 256) { fprintf(stderr, "kernel_launch: occupancy query says %d blocks/CU on %d CUs; this kernel needs 256 resident workgroups\n", per_cu, cus); grid_blocks = -1; return; }
        grid_blocks = 256;
    }
    if (grid_blocks < 0) return;
    (void)hipMemsetAsync((char*)d_ws + OFF_BAR, 0, XCD_BAR_WORDS * 4, stream);
    Params p{};
    for (int i = 0; i < 46; ++i) p.in[i] = (const float*)d_in[i];
    p.out = (float*)d_out; p.ws = (char*)d_ws;
    void* args[] = {&p};
    hipError_t e = hipLaunchCooperativeKernel((const void*)fwd_kernel, dim3(grid_blocks), dim3(NTHR), args, LDS_BYTES, stream);
    if (e != hipSuccess) fprintf(stderr, "cooperative launch failed: %s (grid %d)\n", hipGetErrorString(e), grid_blocks);
}
```

```cpp
#include <hip/hip_runtime.h>
#include <cstdio>
#include <cmath>

#define DEV __device__ __forceinline__

constexpr int NB = 2, NL = 8192, DM = 1024, NCX = 256, TB = NCX + NL;
constexpr int RT = NB * TB;
constexpr int NCH = TB / 64;
constexpr int EIN = 3872, RW0 = 1568;
constexpr int NTHR = 512, NWV = 8;
constexpr float ALPHA = 1.41421356237f;
constexpr float KSCALE = 0.04419417382f;

constexpr size_t OFF_MODV = 0;
constexpr size_t OFF_X1C  = 131072;
constexpr size_t OFF_BAR  = 3145728;
constexpr size_t OFF_BIG  = 4194304;
constexpr size_t OFF_P0   = OFF_BIG;
constexpr size_t OFF_YC   = OFF_BIG + (size_t)TB * EIN * 2;
constexpr size_t OFF_GDS  = OFF_YC + (size_t)TB * 1024 * 2;
constexpr size_t OFF_GDEC = OFF_GDS + (size_t)8 * NCH * 8192 * 4;
constexpr size_t OFF_RU   = OFF_GDEC + (size_t)8 * NCH * 64 * 4;
constexpr size_t OFF_RS0  = OFF_RU + (size_t)16 * NCH * 16384 * 2;
constexpr size_t OFF_BONS = OFF_RS0 + (size_t)16 * NCH * 4096 * 2;
constexpr size_t L0_END   = OFF_BONS + (size_t)2 * TB * 8 * 4;
constexpr size_t OFF_XM   = OFF_BIG;
constexpr size_t OFF_XC   = OFF_XM + (size_t)RT * 2048 * 2;
constexpr size_t OFF_H    = OFF_XC + (size_t)RT * 2048 * 2;
constexpr size_t OFF_WT0  = OFF_H + (size_t)NB * NL * 2048 * 2;
constexpr size_t OFF_WT1  = OFF_WT0 + (size_t)4096 * 1024 * 2;
constexpr size_t OFF_WT2  = OFF_WT1 + (size_t)4096 * 1024 * 2;
constexpr size_t OFF_WT3  = OFF_WT2 + (size_t)1024 * 1024 * 2;
constexpr size_t OFF_G16  = OFF_WT3 + (size_t)1024 * 2048 * 2;
constexpr size_t OFF_SMAT = OFF_G16 + (size_t)RT * 16 * 4;
constexpr size_t OFF_GSC  = OFF_SMAT + (size_t)NB * 4 * NCH * 4096 * 2;
constexpr size_t OFF_CSC  = OFF_GSC + (size_t)16 * TB * 4 * 4;
constexpr size_t OFF_NBUF = OFF_CSC + (size_t)16 * NCH * 2 * 4;
constexpr size_t OFF_GTAB = 3407872;
constexpr size_t OFF_WFT  = OFF_GTAB + (size_t)4 * 128 * 16 * 4;
static_assert(OFF_WFT + (size_t)16 * 4096 * 2 <= OFF_BIG, "low-region tables overflow");
constexpr size_t OFF_G16P = OFF_NBUF + (size_t)16 * NCH * 512 * 4;
constexpr size_t OFF_H1B  = OFF_G16;
constexpr size_t WS_NEED  = (OFF_G16P + (size_t)4 * RT * 16 * 4 > OFF_H1B + (size_t)RT * 1024 * 2) ? OFF_G16P + (size_t)4 * RT * 16 * 4 : OFF_H1B + (size_t)RT * 1024 * 2;
static_assert(WS_NEED <= (size_t)256 * 1024 * 1024, "workspace exceeds the guaranteed 256 MiB");

static_assert(L0_END <= OFF_WT0, "layer-0 buffers overlap the weight copies");
constexpr int LDS_BYTES = 139264;

struct Params { const float* in[46]; float* out; char* ws; };
typedef unsigned short bf16_t;
typedef __attribute__((ext_vector_type(8))) short bf16x8;
typedef __attribute__((ext_vector_type(4))) short s16x4;
typedef __attribute__((ext_vector_type(2))) short s16x2;
typedef __attribute__((ext_vector_type(4))) float f32x4;
typedef __attribute__((ext_vector_type(2))) __bf16 bf2_t;
DEV unsigned pack2bf(float lo, float hi) { bf2_t v; v[0] = (__bf16)lo; v[1] = (__bf16)hi; return __builtin_bit_cast(unsigned, v); }
DEV float bflo(unsigned u) { return __uint_as_float(u << 16); }
DEV float bfhi(unsigned u) { return __uint_as_float(u & 0xffff0000u); }
DEV float bf2f(bf16_t v) { return __uint_as_float(((unsigned)v) << 16); }
DEV void unpack8(uint4 u, float* f) { f[0] = bflo(u.x); f[1] = bfhi(u.x); f[2] = bflo(u.y); f[3] = bfhi(u.y); f[4] = bflo(u.z); f[5] = bfhi(u.z); f[6] = bflo(u.w); f[7] = bfhi(u.w); }

DEV float wave_sum(float v) {
#pragma unroll
    for (int o = 32; o > 0; o >>= 1) v += __shfl_xor(v, o, 64);
    return v;
}
DEV float wave_max(float v) {
#pragma unroll
    for (int o = 32; o > 0; o >>= 1) v = fmaxf(v, __shfl_xor(v, o, 64));
    return v;
}
DEV float fexp(float x) { return __expf(x); }
DEV float frcp(float x) { return __builtin_amdgcn_rcpf(x); }
DEV float sigmoid_f(float x) { return frcp(1.f + fexp(-x)); }
DEV float silu_f(float x) { return x * frcp(1.f + fexp(-x)); }
DEV float logsig_f(float x) { return fminf(x, 0.f) - __logf(1.f + fexp(-fabsf(x))); }
DEV float tanh_f(float x) { const float e = fexp(2.f * x); return 1.f - 2.f * frcp(e + 1.f); }
DEV void lds_fence() { asm volatile("" ::: "memory"); }
DEV int opaque_tid() { int t = threadIdx.x; asm volatile("" : "+v"(t)); return t; }
DEV int scan_s(int dir, int u) { return dir == 0 ? u : (u < NCX ? (NCX - 1 - u) : (TB - 1 + NCX - u)); }
DEV int chunk_at(int dir, int step) { return dir == 0 ? step : (step < 4 ? 3 - step : (NCH + 3 - step)); }
DEV float4 ld4(const float* p) { return *(const float4*)p; }
DEV void st4(float* p, float4 v) { *(float4*)p = v; }


#define XB_TMO      128
#define XB_XCNT(j)  (256  + 64 * (j))
#define XB_XSUB(j)  (1280 + 64 * (j))
#define XB_XGEN(j)  (2304 + 64 * (j))
#define XB_TOP      3328
#define XB_TOPGEN   3392
#define XCD_BAR_WORDS 3456
#define XB_SPIN_CAP (1u << 22)
#define LAS __attribute__((address_space(3)))
DEV unsigned xb_ld(unsigned* p) { return __hip_atomic_load(p, __ATOMIC_RELAXED, __HIP_MEMORY_SCOPE_AGENT); }
DEV unsigned xb_add(unsigned* p, unsigned v) { return __hip_atomic_fetch_add(p, v, __ATOMIC_RELAXED, __HIP_MEMORY_SCOPE_AGENT); }
DEV unsigned xb_xcc_id() { return (unsigned)__builtin_amdgcn_s_getreg((3 << 11) | 20) & 0xFu; }
#define XB_SPIN(cond, bar) do { unsigned _sp = 0; while (cond) { __builtin_amdgcn_s_sleep(1); \
    if ((++_sp & 255u) == 0u) { if (xb_ld(&(bar)[XB_TMO])) break; if (_sp > XB_SPIN_CAP) { atomicAdd(&(bar)[XB_TMO], 1u); break; } } } } while (0)
struct XcdBarrier { unsigned* bar; unsigned x; volatile LAS unsigned* st; };
DEV XcdBarrier xcd_barrier_post(unsigned* bar, volatile LAS unsigned* st) {
    XcdBarrier b; b.bar = bar; b.x = xb_xcc_id(); b.st = st;
    if (threadIdx.x == 0) (void)xb_add(&bar[XB_XCNT(b.x)], 1u);
    return b;
}
DEV void xcd_barrier_complete(unsigned* bar, unsigned x, unsigned& nloc, unsigned& nx) {
    const unsigned G = gridDim.x * gridDim.y * gridDim.z;
    unsigned sum, cnt, mine, sp = 0u;
    for (;;) {
        sum = 0u; cnt = 0u; mine = 0u;
#pragma unroll
        for (unsigned j = 0; j < 16; ++j) { const unsigned c = xb_ld(&bar[XB_XCNT(j)]); sum += c; cnt += (c > 0u) ? 1u : 0u; mine = (j == x) ? c : mine; }
        if (sum == G) break;
        __builtin_amdgcn_s_sleep(1);
        if ((++sp & 255u) == 0u) { if (xb_ld(&bar[XB_TMO])) break; if (sp > XB_SPIN_CAP) { atomicAdd(&bar[XB_TMO], 1u); break; } }
    }
    nloc = mine > 0u ? mine : 1u; nx = cnt > 0u ? cnt : 1u;
}
DEV void xcd_barrier(const XcdBarrier& b) {
    asm volatile("s_waitcnt vmcnt(0)" ::: "memory");
    __syncthreads();
    if (threadIdx.x == 0) {
        unsigned* bar = b.bar;
        __builtin_amdgcn_s_waitcnt(0);
        unsigned nloc = b.st[0], nx = b.st[1];
        if (nloc == 0u) { xcd_barrier_complete(bar, b.x, nloc, nx); b.st[0] = nloc; b.st[1] = nx; }
        const unsigned old = xb_add(&bar[XB_XSUB(b.x)], 1u);
        const unsigned gen = old / nloc;
        if (old + 1u == (gen + 1u) * nloc) {
            __builtin_amdgcn_fence(__ATOMIC_RELEASE, "agent");
            asm volatile("s_waitcnt vmcnt(0)" ::: "memory");
            const unsigned og = xb_add(&bar[XB_TOP], 1u);
            const unsigned tg = og / nx;
            if (og + 1u == (tg + 1u) * nx) xb_add(&bar[XB_TOPGEN], 1u);
            else XB_SPIN(xb_ld(&bar[XB_TOPGEN]) == tg, bar);
            __builtin_amdgcn_fence(__ATOMIC_ACQUIRE, "agent");
            xb_add(&bar[XB_XGEN(b.x)], 1u);
            asm volatile("s_waitcnt vmcnt(0)" ::: "memory");
        } else {
            XB_SPIN(xb_ld(&bar[XB_XGEN(b.x)]) == gen, bar);
            __builtin_amdgcn_fence(__ATOMIC_ACQUIRE, "agent");
            asm volatile("s_waitcnt vmcnt(0)" ::: "memory");
        }
    }
    __syncthreads();
}

namespace pg8 {
#define PG8_LAS __attribute__((address_space(3)))
typedef unsigned short bf16_t;
typedef short bf16x8 __attribute__((ext_vector_type(8)));
typedef float f32x4 __attribute__((ext_vector_type(4)));
typedef unsigned u32x4 __attribute__((ext_vector_type(4)));
constexpr int BM = 256, BK = 64, HALF = 128, HTB = HALF * BK * 2  , STAGE_BYTES = 8 * HTB, NXCD = 8, WGM = 8;

__host__ __device__ __forceinline__ int lds_byte(int r, int c) { const int st = (r >> 4) * 2 + (c >> 5), rr = r & 15, cc = c & 31, ob = rr * 64 + cc * 2; return st * 1024 + (ob ^ (((ob >> 9) & 1) << 5)); }
__host__ __device__ __forceinline__ void stage_rc(int b, int& R, int& C) { const int st = b / 1024, sb = b % 1024, swz = sb ^ (((sb >> 9) & 1) << 5); R = (st >> 1) * 16 + swz / 64; C = (st & 1) * 32 + (swz % 64) / 2; }
__host__ __device__ __forceinline__ int perm32(int rho) { const int n = rho >> 4, i = rho & 15; return 8 * (i >> 2) + 4 * n + (i & 3); }

struct Unit { int pm, pn; };
struct Gemm { const bf16_t* A; const bf16_t* Bt; int M, N, K; };

struct StaticOrder {
    int nM, nN, nwg, G, c;
    __host__ __device__ void init(int M, int N, int G_, int c_) { nM = M / BM; nN = N / BM; nwg = nM * nN; G = G_; c = c_; }
    __host__ __device__ bool next(int i, Unit& u) const {
        const long L = (long)i * G + c; if (L >= nwg) return false;
        int wgid = (int)L; { const int q = nwg / NXCD, r = nwg % NXCD, xcd = wgid % NXCD, off = wgid / NXCD; wgid = (xcd < r ? xcd * (q + 1) : r * (q + 1) + (xcd - r) * q) + off; }
        const int nig = WGM * nN, gid = wgid / nig, fm = gid * WGM, gsz = (nM - fm) < WGM ? (nM - fm) : WGM;
        u.pm = fm + ((wgid % nig) % gsz); u.pn = (wgid % nig) / gsz; return true;
    }
    __device__ __forceinline__ void a_ready(const Unit&) const {}
    __device__ __forceinline__ void done(const Unit&) const {}
};

template <class Epi, class Sched, bool STAMP = false>
__device__ __forceinline__ void gemm_phase(PG8_LAS unsigned char* lds, const Gemm g, const Sched& S, const Epi& E, unsigned long long* stamps) {
    int tid = threadIdx.x; asm volatile("" : "+v"(tid));
    const int wid = __builtin_amdgcn_readfirstlane(tid >> 6), lane = tid & 63, wr = wid >> 2, wc = wid & 3, fr = lane & 15, fq = lane >> 4;
    const int K = g.K, nt = K / BK;
#define PG8_STAMP() do { } while (0)
    PG8_STAMP();
    unsigned voffA[2], voffB[2];
#pragma unroll
    for (int i = 0; i < 2; ++i) { int R, C; stage_rc(tid * 16 + i * 8192, R, C); const int Rb = Epi::PERM ? ((R & ~31) + perm32(R & 31)) : R;
        voffA[i] = (unsigned)(R * K + C) * 2u; voffB[i] = (unsigned)(Rb * K + C) * 2u; }
    const size_t kstep = (size_t)(BK * 2);
    const size_t hstep = (size_t)HALF * K * 2;
    const size_t tstep = 2 * hstep;
    const unsigned ldsw = (unsigned)wid * 1024u;
    const int aoff = lds_byte(wr * 64 + fr, fq * 8), boff = lds_byte(wc * 32 + fr, fq * 8);
#define PG8_SA(b, h) (((b) * 2 + (h)) * HTB)
#define PG8_SB(b, h) ((4 + (b) * 2 + (h)) * HTB)
#define PG8_STAGE(bufoff, gbase, voff) do { _Pragma("unroll") for (int _i = 0; _i < 2; ++_i) \
        __builtin_amdgcn_global_load_lds((const unsigned*)((const char*)(gbase) + (voff)[_i]), (PG8_LAS unsigned*)(lds + (bufoff) + ldsw + _i * 8192), 16, 0, 0); } while (0)
#define PG8_LDA(dst, b, h) do { _Pragma("unroll") for (int m = 0; m < 4; ++m) _Pragma("unroll") for (int k = 0; k < 2; ++k) dst[m][k] = *(const PG8_LAS bf16x8*)(lds + PG8_SA(b, h) + aoff + m * 2048 + k * 1024); } while (0)
#define PG8_LDB(dst, b, h) do { _Pragma("unroll") for (int n = 0; n < 2; ++n) _Pragma("unroll") for (int k = 0; k < 2; ++k) dst[n][k] = *(const PG8_LAS bf16x8*)(lds + PG8_SB(b, h) + boff + n * 2048 + k * 1024); } while (0)
#define PG8_MMA(ai, bj, At, Bt) do { __builtin_amdgcn_s_setprio(1); _Pragma("unroll") for (int m = 0; m < 4; ++m) _Pragma("unroll") for (int n = 0; n < 2; ++n) _Pragma("unroll") for (int k = 0; k < 2; ++k) \
        acc[ai][bj][m][n] = __builtin_amdgcn_mfma_f32_16x16x32_bf16(Bt[n][k], At[m][k], acc[ai][bj][m][n], 0, 0, 0); __builtin_amdgcn_s_setprio(0); } while (0)
#define PG8_WAIT_V(n) asm volatile("s_waitcnt vmcnt(" #n ")" ::: "memory")
#define PG8_WAIT_L(n) asm volatile("s_waitcnt lgkmcnt(" #n ")" ::: "memory")
#define PG8_BAR __builtin_amdgcn_s_barrier()
#define PG8_SCHED __builtin_amdgcn_sched_barrier(0)
    Unit cur, nxt; int ui = 0;
    if (!S.next(0, cur)) return;
    f32x4 acc[2][2][4][2];
#pragma unroll
    for (int a = 0; a < 2; ++a)
#pragma unroll
        for (int b = 0; b < 2; ++b)
#pragma unroll
            for (int m = 0; m < 4; ++m)
#pragma unroll
                for (int n = 0; n < 2; ++n) acc[a][b][m][n] = (f32x4){0.f, 0.f, 0.f, 0.f};
    bf16x8 At[4][2], B0[2][2], B1[2][2];
    const char* cA = (const char*)g.A + (size_t)cur.pm * tstep; const char* cB = (const char*)g.Bt + (size_t)cur.pn * tstep;
    S.a_ready(cur);
    PG8_STAGE(PG8_SB(0, 0), cB, voffB); PG8_STAGE(PG8_SA(0, 0), cA, voffA); PG8_STAGE(PG8_SB(0, 1), cB + hstep, voffB); PG8_STAGE(PG8_SA(0, 1), cA + hstep, voffA);
    if (wr == 1) PG8_BAR;
    PG8_WAIT_V(4); PG8_BAR;
    PG8_STAGE(PG8_SB(1, 0), cB + kstep, voffB); PG8_STAGE(PG8_SA(1, 0), cA + kstep, voffA); PG8_STAGE(PG8_SB(1, 1), cB + hstep + kstep, voffB);
    PG8_WAIT_V(6); PG8_BAR;
    PG8_STAMP();
    for (;;) {
        const bool has_next = S.next(ui + 1, nxt);
        const char* nA = has_next ? (const char*)g.A + (size_t)nxt.pm * tstep : cA; const char* nB = has_next ? (const char*)g.Bt + (size_t)nxt.pn * tstep : cB;
        for (int t = 0; t < nt; t += 2) {
            const bool last = (t == nt - 2);
            const char* a1 = cA + (size_t)(t + 1) * kstep;
            const char* a2 = last ? nA : cA + (size_t)(t + 2) * kstep; const char* b2 = last ? nB : cB + (size_t)(t + 2) * kstep;
            const char* a3 = a2 + kstep; const char* b3 = b2 + kstep;
            if (last && has_next) S.a_ready(nxt);
            PG8_LDB(B0, 0, 0); PG8_SCHED; PG8_LDA(At, 0, 0); PG8_STAGE(PG8_SA(1, 1), a1 + hstep, voffA);
            PG8_WAIT_L(8); PG8_BAR; PG8_WAIT_L(0); PG8_MMA(0, 0, At, B0); PG8_BAR; PG8_SCHED;
            PG8_LDB(B1, 0, 1); PG8_STAGE(PG8_SB(0, 0), b2, voffB);
            PG8_BAR; PG8_WAIT_L(0); PG8_MMA(0, 1, At, B1); PG8_BAR;
            PG8_LDA(At, 0, 1); PG8_STAGE(PG8_SA(0, 0), a2, voffA);
            PG8_BAR; PG8_WAIT_L(0); PG8_MMA(1, 0, At, B0); PG8_BAR; PG8_SCHED;
            PG8_STAGE(PG8_SB(0, 1), b2 + hstep, voffB);
            PG8_WAIT_V(6); PG8_BAR; PG8_MMA(1, 1, At, B1); PG8_BAR;
            PG8_LDB(B0, 1, 0); PG8_SCHED; PG8_LDA(At, 1, 0); PG8_STAGE(PG8_SA(0, 1), a2 + hstep, voffA);
            PG8_WAIT_L(8); PG8_BAR; PG8_WAIT_L(0); PG8_MMA(0, 0, At, B0); PG8_BAR; PG8_SCHED;
            PG8_LDB(B1, 1, 1); PG8_STAGE(PG8_SB(1, 0), b3, voffB);
            PG8_BAR; PG8_WAIT_L(0); PG8_MMA(0, 1, At, B1); PG8_BAR;
            PG8_LDA(At, 1, 1); PG8_STAGE(PG8_SA(1, 0), a3, voffA);
            PG8_BAR; PG8_WAIT_L(0); PG8_MMA(1, 0, At, B0); PG8_BAR; PG8_SCHED;
            PG8_STAGE(PG8_SB(1, 1), b3 + hstep, voffB);
            PG8_WAIT_V(6); PG8_BAR; PG8_MMA(1, 1, At, B1); PG8_BAR;
        }
        PG8_STAMP();
        if constexpr (!Epi::AFTER_DRAIN) { E(acc, cur, wr, wc, fr, fq); S.done(cur); }
        PG8_STAMP();
        if (!has_next) break;
#pragma unroll
        for (int a = 0; a < 2; ++a)
#pragma unroll
            for (int b = 0; b < 2; ++b)
#pragma unroll
                for (int m = 0; m < 4; ++m)
#pragma unroll
                    for (int n = 0; n < 2; ++n) acc[a][b][m][n] = (f32x4){0.f, 0.f, 0.f, 0.f};
        cur = nxt; cA = nA; cB = nB; ++ui;
    }
    PG8_WAIT_V(0);
    if (wr == 0) PG8_BAR;
    PG8_BAR;
    if constexpr (Epi::AFTER_DRAIN) { E.fused(acc, cur, wr, wc, fr, fq, lds, wid, lane); S.done(cur); }
    PG8_STAMP();
#undef PG8_STAMP
#undef PG8_SA
#undef PG8_SB
#undef PG8_STAGE
#undef PG8_LDA
#undef PG8_LDB
#undef PG8_MMA
#undef PG8_WAIT_V
#undef PG8_WAIT_L
#undef PG8_BAR
#undef PG8_SCHED
}
}

DEV void transpose_convert(const float* __restrict__ W, int K, int N, int Npad, bf16_t* Wt, float* sm) {
    float (*T)[65] = (float (*)[65])sm;
    const int tid = opaque_tid();
    const int kt = K / 64, ntl = Npad / 64;
    for (int tile = blockIdx.x; tile < kt * ntl; tile += gridDim.x) {
        const int k0 = (tile / ntl) * 64, n0 = (tile % ntl) * 64;
        __syncthreads();
#pragma unroll
        for (int i = 0; i < 2; ++i) {
            const int k = (tid >> 4) + 32 * i, n4 = (tid & 15) * 4;
            float4 v = make_float4(0.f, 0.f, 0.f, 0.f);
            if (n0 + n4 < N) v = ld4(W + (size_t)(k0 + k) * N + n0 + n4);
            T[k][n4] = v.x; T[k][n4 + 1] = v.y; T[k][n4 + 2] = v.z; T[k][n4 + 3] = v.w;
        }
        __syncthreads();
        const int n = tid >> 3, kq = (tid & 7) * 8;
        unsigned o[4];
#pragma unroll
        for (int j = 0; j < 4; ++j) o[j] = pack2bf(T[kq + 2 * j][n], T[kq + 2 * j + 1][n]);
        bf16_t* dst = Wt + (size_t)(n0 + n) * K + k0 + kq;
        *(uint4*)dst = make_uint4(o[0], o[1], o[2], o[3]);
    }
}

struct EpBf16 {
    static constexpr bool PERM = true, AFTER_DRAIN = false;
    bf16_t* O; int ldc; int ncols;
    DEV void operator()(const pg8::f32x4 (&acc)[2][2][4][2], const pg8::Unit& u, int wr, int wc, int fr, int fq) const {
        const int row0 = u.pm * 256 + wr * 64 + fr, col0 = u.pn * 256 + wc * 32 + 8 * fq;
#pragma unroll
        for (int ai = 0; ai < 2; ++ai)
#pragma unroll
            for (int m = 0; m < 4; ++m) {
                bf16_t* rowp = O + (size_t)(row0 + ai * 128 + m * 16) * ldc + col0;
#pragma unroll
                for (int bj = 0; bj < 2; ++bj) {
                    if (col0 + bj * 128 < ncols) {
                        const pg8::f32x4 v0 = acc[ai][bj][m][0], v1 = acc[ai][bj][m][1];
                        *(uint4*)(rowp + bj * 128) = make_uint4(pack2bf(v0[0], v0[1]), pack2bf(v0[2], v0[3]), pack2bf(v1[0], v1[1]), pack2bf(v1[2], v1[3]));
                    }
                }
            }
    }
};
struct EpRes0 {
    static constexpr bool PERM = false, AFTER_DRAIN = false;
    float* C; const float* mv; int b;
    DEV void operator()(const pg8::f32x4 (&acc)[2][2][4][2], const pg8::Unit& u, int wr, int wc, int fr, int fq) const {
        const bool isc = (u.pm * 256 < NCX);
        const float* gp = mv + (isc ? 2 : b) * 3072 + 2048;
        const int row0 = u.pm * 256 + wr * 64 + fr, col0 = u.pn * 256 + wc * 32 + 4 * fq;
#pragma unroll
        for (int ai = 0; ai < 2; ++ai)
#pragma unroll
            for (int m = 0; m < 4; ++m) {
                const size_t ro = (size_t)(row0 + ai * 128 + m * 16) * DM + col0;
#pragma unroll
                for (int bj = 0; bj < 2; ++bj)
#pragma unroll
                    for (int n = 0; n < 2; ++n) {
                        const int co = bj * 128 + n * 16;
                        const float4 g = ld4(gp + col0 + co); const pg8::f32x4 v = acc[ai][bj][m][n];
                        st4(C + ro + co, make_float4(g.x * v[0], g.y * v[1], g.z * v[2], g.w * v[3]));
                    }
            }
    }
};
struct EpRes1 {
    static constexpr bool PERM = false, AFTER_DRAIN = false;
    float* C; const float* mv;
    DEV void operator()(const pg8::f32x4 (&acc)[2][2][4][2], const pg8::Unit& u, int wr, int wc, int fr, int fq) const {
        const float* gp = mv + (u.pm * 256 >= NL ? 1 : 0) * 3072 + 2048;
        const int row0 = u.pm * 256 + wr * 64 + fr, col0 = u.pn * 256 + wc * 32 + 4 * fq;
#pragma unroll
        for (int ai = 0; ai < 2; ++ai)
#pragma unroll
            for (int m = 0; m < 4; ++m) {
                const size_t ro = (size_t)(row0 + ai * 128 + m * 16) * DM + col0;
#pragma unroll
                for (int bj = 0; bj < 2; ++bj)
#pragma unroll
                    for (int n = 0; n < 2; ++n) {
                        const int co = bj * 128 + n * 16;
                        const float4 g = ld4(gp + col0 + co); const pg8::f32x4 v = acc[ai][bj][m][n];
                        st4(C + ro + co, make_float4(g.x * v[0], g.y * v[1], g.z * v[2], g.w * v[3]));
                    }
            }
    }
};
template <class EP>
DEV void run_gemm(const bf16_t* A, const bf16_t* Bt, int M, int N, int K, const EP& ep, float* sm) {
    pg8::Gemm g{A, Bt, M, N, K}; pg8::StaticOrder S; S.init(M, N, (int)gridDim.x, (int)blockIdx.x);
    pg8::gemm_phase<EP, pg8::StaticOrder, false>((PG8_LAS unsigned char*)sm, g, S, ep, nullptr);
}

struct Mod8 { float4 s0, s1, c0, c1; };
DEV Mod8 mod8_load(const float* m, int k) { Mod8 q; q.s0 = ld4(m + k); q.s1 = ld4(m + k + 4); q.c0 = ld4(m + 1024 + k); q.c1 = ld4(m + 1024 + k + 4); return q; }
DEV uint4 mod8_apply(const float4 x0, const float4 x1, const Mod8& q) {
    return make_uint4(pack2bf(x0.x * (1.f + q.c0.x) + q.s0.x, x0.y * (1.f + q.c0.y) + q.s0.y), pack2bf(x0.z * (1.f + q.c0.z) + q.s0.z, x0.w * (1.f + q.c0.w) + q.s0.w),
                      pack2bf(x1.x * (1.f + q.c1.x) + q.s1.x, x1.y * (1.f + q.c1.y) + q.s1.y), pack2bf(x1.z * (1.f + q.c1.z) + q.s1.z, x1.w * (1.f + q.c1.w) + q.s1.w));
}
DEV void phase_h0(const Params& p, int b) {
    const float* modv = (const float*)(p.ws + OFF_MODV);
    bf16_t* H0 = (bf16_t*)(p.ws + OFF_YC);
    const int gt = blockIdx.x * NTHR + opaque_tid(), gn = gridDim.x * NTHR;
    const int k = (gt & 127) * 8;
    const Mod8 mc = mod8_load(modv + 2 * 3072, k), ml = mod8_load(modv + b * 3072, k);
    for (int i0 = gt; i0 < TB * 128; i0 += 4 * gn) {
        float4 xa[4], xb[4];
#pragma unroll
        for (int u = 0; u < 4; ++u) {
            const int i = i0 + u * gn, s = (i < TB * 128 ? i : gt) >> 7;
            const float* src = (s < NCX) ? p.in[2] + ((size_t)(b * NCX + s)) * DM + k : p.in[0] + ((size_t)(b * NL + s - NCX)) * DM + k;
            xa[u] = ld4(src); xb[u] = ld4(src + 4);
        }
#pragma unroll
        for (int u = 0; u < 4; ++u) {
            const int i = i0 + u * gn, s = i >> 7;
            if (i < TB * 128) *(uint4*)(H0 + (size_t)s * DM + k) = mod8_apply(xa[u], xb[u], (s < NCX) ? mc : ml);
        }
    }
}

DEV void phase_mod(const Params& p, float* sm) {
    const float* c = p.in[1]; const float* cctx = p.in[3];
    const float* mod_w = p.in[4]; const float* mod_b = p.in[5];
    float* modv = (float*)(p.ws + OFF_MODV);
    float* sil = sm; float* red = sm + 3072;
    const int tid = opaque_tid();
    for (int i = tid; i < 3072; i += NTHR) {
        const int j = i >> 10, k = i & 1023;
        const float v = (j < 2) ? c[j * 1024 + k] : cctx[k];
        sil[i] = silu_f(v);
    }
    __syncthreads();
    for (int unit = blockIdx.x; unit < 192; unit += gridDim.x) {
        const int l = unit / 96, cb = unit % 96;
        const int kg = tid >> 5, col = tid & 31, n = cb * 32 + col;
        const float* w = mod_w + (size_t)l * 1024 * 3072 + n;
        float a0 = 0.f, a1 = 0.f, a2 = 0.f;
        for (int k = kg * 64; k < kg * 64 + 64; ++k) {
            const float wv = w[(size_t)k * 3072];
            a0 += sil[k] * wv; a1 += sil[1024 + k] * wv; a2 += sil[2048 + k] * wv;
        }
        red[(kg * 3 + 0) * 32 + col] = a0; red[(kg * 3 + 1) * 32 + col] = a1; red[(kg * 3 + 2) * 32 + col] = a2;
        __syncthreads();
        if (tid < 96) {
            const int j = tid >> 5, cc = tid & 31, nn = cb * 32 + cc;
            float s = mod_b[l * 3072 + nn];
            for (int g = 0; g < 16; ++g) s += red[(g * 3 + j) * 32 + cc];
            modv[(l * 3 + j) * 3072 + nn] = s;
        }
        __syncthreads();
    }
}

DEV void phase_tables(const Params& p) {
    const float* wq = p.in[33]; const float* wk = p.in[34]; const float* wv = p.in[35];
    const float* gw0 = p.in[36]; const float* gw1 = p.in[38]; const float* gw2 = p.in[40]; const float* gw3 = p.in[42];
    float* gtab = (float*)(p.ws + OFF_GTAB); bf16_t* wft = (bf16_t*)(p.ws + OFF_WFT);
    const int gt = blockIdx.x * NTHR + opaque_tid(), gn = gridDim.x * NTHR;
    for (int i = gt; i < 512 * 16; i += gn) {
        const int gb = i >> 4, cp = (i >> 2) & 3, c = i & 3;
        float s = 0.f;
#pragma unroll
        for (int d = 0; d < 4; ++d) s += wq[gb * 16 + cp * 4 + d] * wk[gb * 16 + c * 4 + d];
        gtab[i] = s * KSCALE;
    }
    for (int i = gt; i < 4096 * 16; i += gn) {
        const int g = i >> 12, k = i & 4095, gm = g >> 2, hd = g & 3;
        const float* wg = gm == 0 ? gw0 : (gm == 1 ? gw1 : (gm == 2 ? gw2 : gw3));
        float s = 0.f;
        if (k < 2048) {
            const int blk = k >> 2, cc = k & 3;
#pragma unroll
            for (int d = 0; d < 4; ++d) s += wq[blk * 16 + cc * 4 + d] * wg[(size_t)(4 * blk + d) * 4 + hd] + wk[blk * 16 + cc * 4 + d] * wg[(size_t)(2048 + 4 * blk + d) * 4 + hd];
        } else {
            const int kk = k - 2048, blk = kk >> 2, cc = kk & 3;
#pragma unroll
            for (int d = 0; d < 4; ++d) s += wv[blk * 16 + cc * 4 + d] * wg[(size_t)(4096 + 4 * blk + d) * 4 + hd];
        }
        wft[i] = __builtin_bit_cast(unsigned short, (__bf16)s);
    }
}

DEV float wave_scan_add(float v, int lane, int dir) {
#pragma unroll
    for (int o = 1; o < 64; o <<= 1) {
        const float n = dir ? __shfl_down(v, o, 64) : __shfl_up(v, o, 64);
        const bool ok = dir ? (lane + o < 64) : (lane >= o);
        if (ok) v += n;
    }
    return v;
}
DEV float wave_scan_max(float v, int lane, int dir) {
#pragma unroll
    for (int o = 1; o < 64; o <<= 1) {
        const float n = dir ? __shfl_down(v, o, 64) : __shfl_up(v, o, 64);
        const bool ok = dir ? (lane + o < 64) : (lane >= o);
        if (ok) v = fmaxf(v, n);
    }
    return v;
}

constexpr int GLC_OFF = 30336;
static_assert((GLC_OFF + 2176) * 4 <= LDS_BYTES - 16, "GLA constants must fit below the barrier words");
DEV void gla_consts(const Params& p, int h, float* sm) {
    const int tid = opaque_tid();
    float* sWA2 = sm + GLC_OFF; float* sBA2 = sWA2 + 2048;
    __syncthreads();
    for (int i = tid; i < 2048; i += NTHR) { const int d = i >> 10, ii = (i >> 6) & 15, k = i & 63; sWA2[i] = p.in[d ? 12 : 10][ii * 256 + h * 64 + k]; }
    if (tid < 128) sBA2[tid] = p.in[(tid >> 6) ? 13 : 11][h * 64 + (tid & 63)];
}
DEV void gla_decay_core(const float* sLRd, const float* sWAd, const float* sBAd, float* sBC, float* sTot, int dir, int tid) {
    {
        const int t = tid >> 3, k0 = (tid & 7) * 8;
        float acc[8];
#pragma unroll
        for (int j = 0; j < 8; ++j) acc[j] = sBAd[k0 + j];
#pragma unroll
        for (int ii = 0; ii < 16; ++ii) {
            const float l = sLRd[t * 16 + ii];
#pragma unroll
            for (int j = 0; j < 8; ++j) acc[j] += l * sWAd[ii * 64 + k0 + j];
        }
#pragma unroll
        for (int j = 0; j < 8; ++j) sBC[t * 65 + k0 + j] = logsig_f(acc[j]) * 0.0625f;
    }
    __syncthreads();
    {
        const int lane = tid & 63, wv = tid >> 6;
#pragma unroll
        for (int j = 0; j < 8; ++j) {
            const int k = wv * 8 + j;
            const float v = wave_scan_add(sBC[lane * 65 + k], lane, dir);
            sBC[lane * 65 + k] = v;
            if (lane == (dir ? 0 : 63)) sTot[k] = v;
        }
    }
    __syncthreads();
}

DEV bf16x8 tr_frag(const bf16_t* base, int ld, int row0, int col0, int lane) {
    const bf16_t* ptr = base + (row0 + (lane >> 4) * 8 + ((lane & 15) >> 2)) * ld + col0 + (lane & 3) * 4;
    const s16x4 lo = __builtin_amdgcn_ds_read_tr16_b64_v4i16((__attribute__((address_space(3))) s16x4*)ptr);
    const s16x4 hi = __builtin_amdgcn_ds_read_tr16_b64_v4i16((__attribute__((address_space(3))) s16x4*)(ptr + 4 * ld));
    return (bf16x8){lo[0], lo[1], lo[2], lo[3], hi[0], hi[1], hi[2], hi[3]};
}
DEV bf16x8 row_frag(const bf16_t* base, int ld, int idx0, int k0, int lane) {
    return *(const bf16x8*)(base + (idx0 + (lane & 15)) * ld + k0 + (lane >> 4) * 8);
}

DEV void gla1_unit(const Params& p, int h, int dir, int c, float* sm) {
    const int tid = opaque_tid(), lane = tid & 63, wave = tid >> 6;
    const bf16_t* P0 = (const bf16_t*)(p.ws + OFF_P0);
    float* GDS = (float*)(p.ws + OFF_GDS); float* GDEC = (float*)(p.ws + OFF_GDEC);
    float* sLR = sm; float* sBC = sm + 2048; float* sTot = sm + 6208;
    bf16_t* kT = (bf16_t*)(sm + 6272);
    bf16_t* Vs = (bf16_t*)(sm + 8576);
    const int ch = h * 2 + dir;
    const int t = tid >> 3, k0 = (tid & 7) * 8;
    const uint4 lrq = *(const uint4*)(P0 + (size_t)(c * 64 + ((tid & 127) >> 1)) * EIN + 1536 + dir * 16 + (tid & 1) * 8);
    const uint4 kq = *(const uint4*)(P0 + (size_t)(c * 64 + t) * EIN + 256 + h * 64 + k0);
    const uint4 vq0 = *(const uint4*)(P0 + (size_t)(c * 64 + (tid >> 4)) * EIN + 512 + h * 128 + (tid & 15) * 8);
    const uint4 vq1 = *(const uint4*)(P0 + (size_t)(c * 64 + 32 + (tid >> 4)) * EIN + 512 + h * 128 + (tid & 15) * 8);
    __syncthreads();
    if (tid < 128) { float* d = sLR + (tid >> 1) * 16 + (tid & 1) * 8; st4(d, make_float4(bflo(lrq.x), bfhi(lrq.x), bflo(lrq.y), bfhi(lrq.y))); st4(d + 4, make_float4(bflo(lrq.z), bfhi(lrq.z), bflo(lrq.w), bfhi(lrq.w))); }
    *(uint4*)(Vs + (tid >> 4) * 136 + (tid & 15) * 8) = vq0; *(uint4*)(Vs + (32 + (tid >> 4)) * 136 + (tid & 15) * 8) = vq1;
    __syncthreads();
    gla_decay_core(sLR, sm + GLC_OFF + dir * 1024, sm + GLC_OFF + 2048 + dir * 64, sBC, sTot, dir, tid);
    {
        float kv[8]; unpack8(kq, kv);
#pragma unroll
        for (int j = 0; j < 8; ++j) kT[(k0 + j) * 72 + t] = __builtin_bit_cast(unsigned short, (__bf16)(kv[j] * fexp(sTot[k0 + j] - sBC[t * 65 + k0 + j])));
    }
    __syncthreads();
    {
        f32x4 acc[4];
#pragma unroll
        for (int kt = 0; kt < 4; ++kt) acc[kt] = (f32x4){0.f, 0.f, 0.f, 0.f};
#pragma unroll
        for (int ks = 0; ks < 2; ++ks) {
            const bf16x8 af = tr_frag(Vs, 136, ks * 32, wave * 16, lane);
#pragma unroll
            for (int kt = 0; kt < 4; ++kt) acc[kt] = __builtin_amdgcn_mfma_f32_16x16x32_bf16(af, row_frag(kT, 72, kt * 16, ks * 32, lane), acc[kt], 0, 0, 0);
        }
#pragma unroll
        for (int kt = 0; kt < 4; ++kt) {
            const int k = kt * 16 + (lane & 15), v = wave * 16 + (lane >> 4) * 4;
            st4(GDS + ((size_t)(ch * NCH + c) * 64 + k) * 128 + v, make_float4(acc[kt][0], acc[kt][1], acc[kt][2], acc[kt][3]));
        }
    }
    if (tid < 64) GDEC[(size_t)(ch * NCH + c) * 64 + tid] = fexp(sTot[tid]);
}

DEV void gla2_unit(const Params& p, int unit) {
    const int tid = opaque_tid();
    float* GDS = (float*)(p.ws + OFF_GDS); const float* GDEC = (const float*)(p.ws + OFF_GDEC);
    const int ch = unit >> 4, e = (unit & 15) * 512 + tid, k = e >> 7, dir = ch & 1;
    constexpr int GB = 12;
    float S = 0.f, ninc[GB], nd[GB];
#pragma unroll
    for (int j = 0; j < GB; ++j) { const int c = chunk_at(dir, j); ninc[j] = GDS[(size_t)(ch * NCH + c) * 8192 + e]; nd[j] = GDEC[(size_t)(ch * NCH + c) * 64 + k]; }
#pragma unroll 1
    for (int step0 = 0; step0 < NCH; step0 += GB) {
        float inc[GB], d[GB];
#pragma unroll
        for (int j = 0; j < GB; ++j) { inc[j] = ninc[j]; d[j] = nd[j]; }
#pragma unroll
        for (int j = 0; j < GB; ++j) { const int sn = step0 + GB + j, c = chunk_at(dir, sn < NCH ? sn : NCH - 1); ninc[j] = GDS[(size_t)(ch * NCH + c) * 8192 + e]; nd[j] = GDEC[(size_t)(ch * NCH + c) * 64 + k]; }
        __builtin_amdgcn_sched_barrier(0);
#pragma unroll
        for (int j = 0; j < GB; ++j) { const int c = chunk_at(dir, step0 + j); GDS[(size_t)(ch * NCH + c) * 8192 + e] = S; S = d[j] * S + inc[j]; }
    }
}

DEV void gla3_unit(const Params& p, int h, int c, float* sm) {
    const int tid = opaque_tid(), lane = tid & 63, wave = tid >> 6;
    const bf16_t* P0 = (const bf16_t*)(p.ws + OFF_P0);
    const float* GDS = (const float*)(p.ws + OFF_GDS);
    bf16_t* YC = (bf16_t*)(p.ws + OFF_YC);
    const float* ng = p.in[14];
    float* sLR2 = sm;
    float* sBC = sm + 2048; float* sTot = sm + 6208;
    bf16_t* qt = (bf16_t*)(sm + 6272);
    bf16_t* kt = (bf16_t*)(sm + 8576);
    bf16_t* Sm = (bf16_t*)(sm + 10880);
    bf16_t* S0s = (bf16_t*)(sm + 13184);
    bf16_t* Vs = (bf16_t*)(sm + 17536);
    float* O = sm + 21888;
    const int ti = wave & 3, vt0 = (wave >> 2) * 4;
    const int t = tid >> 3, k0 = (tid & 7) * 8;
    f32x4 acc[4];
#pragma unroll
    for (int j = 0; j < 4; ++j) acc[j] = (f32x4){0.f, 0.f, 0.f, 0.f};
    const uint4 vq0 = *(const uint4*)(P0 + (size_t)(c * 64 + (tid >> 4)) * EIN + 512 + h * 128 + (tid & 15) * 8);
    const uint4 vq1 = *(const uint4*)(P0 + (size_t)(c * 64 + 32 + (tid >> 4)) * EIN + 512 + h * 128 + (tid & 15) * 8);
    const uint4 lrq = *(const uint4*)(P0 + (size_t)(c * 64 + ((tid & 255) >> 2)) * EIN + 1536 + (tid & 3) * 8);
    const uint4 qq = *(const uint4*)(P0 + (size_t)(c * 64 + t) * EIN + h * 64 + k0);
    const uint4 kq = *(const uint4*)(P0 + (size_t)(c * 64 + t) * EIN + 256 + h * 64 + k0);
    float4 s0a[4], s0b[4];
#pragma unroll
    for (int u = 0; u < 4; ++u) { const int i = tid + 512 * u, k = i >> 5, v4 = (i & 31) * 4;
        s0a[u] = ld4(GDS + (size_t)((h * 2 + 0) * NCH + c) * 8192 + k * 128 + v4); s0b[u] = ld4(GDS + (size_t)((h * 2 + 1) * NCH + c) * 8192 + k * 128 + v4); }
    const bf16_t* gp = P0 + (size_t)(c * 64 + t) * EIN + 1024 + h * 128 + (tid & 7) * 16;
    const uint4 gq0 = *(const uint4*)gp, gq1 = *(const uint4*)(gp + 8);
    __syncthreads();
    *(uint4*)(Vs + (tid >> 4) * 136 + (tid & 15) * 8) = vq0; *(uint4*)(Vs + (32 + (tid >> 4)) * 136 + (tid & 15) * 8) = vq1;
    if (tid < 256) { float* d = sLR2 + ((tid & 3) >> 1) * 1024 + (tid >> 2) * 16 + (tid & 1) * 8; st4(d, make_float4(bflo(lrq.x), bfhi(lrq.x), bflo(lrq.y), bfhi(lrq.y))); st4(d + 4, make_float4(bflo(lrq.z), bfhi(lrq.z), bflo(lrq.w), bfhi(lrq.w))); }
    __syncthreads();
#pragma unroll
    for (int dir = 0; dir < 2; ++dir) {
        gla_decay_core(sLR2 + dir * 1024, sm + GLC_OFF + dir * 1024, sm + GLC_OFF + 2048 + dir * 64, sBC, sTot, dir, tid);
        {
            float qv[8], kv[8];
            unpack8(qq, qv); unpack8(kq, kv);
#pragma unroll
            for (int j = 0; j < 8; ++j) { const float bc = sBC[t * 65 + k0 + j]; qv[j] *= 0.125f * fexp(bc); kv[j] *= fexp(-bc); }
            *(uint4*)(qt + t * 72 + k0) = make_uint4(pack2bf(qv[0], qv[1]), pack2bf(qv[2], qv[3]), pack2bf(qv[4], qv[5]), pack2bf(qv[6], qv[7]));
            *(uint4*)(kt + t * 72 + k0) = make_uint4(pack2bf(kv[0], kv[1]), pack2bf(kv[2], kv[3]), pack2bf(kv[4], kv[5]), pack2bf(kv[6], kv[7]));
#pragma unroll
            for (int u = 0; u < 4; ++u) {
                const int i = tid + 512 * u, k = i >> 5, v4 = (i & 31) * 4;
                const float4 s4 = dir ? s0b[u] : s0a[u];
                *(uint2*)(S0s + k * 136 + v4) = make_uint2(pack2bf(s4.x, s4.y), pack2bf(s4.z, s4.w));
            }
        }
        __syncthreads();
        {
            const int si = wave & 3;
#pragma unroll
            for (int jj = 0; jj < 2; ++jj) {
                const int t2 = (wave >> 2) * 2 + jj;
                f32x4 a = (f32x4){0.f, 0.f, 0.f, 0.f};
#pragma unroll
                for (int ks = 0; ks < 2; ++ks) a = __builtin_amdgcn_mfma_f32_16x16x32_bf16(row_frag(kt, 72, si * 16, ks * 32, lane), row_frag(qt, 72, t2 * 16, ks * 32, lane), a, 0, 0, 0);
                const int tq = t2 * 16 + (lane & 15), s0 = si * 16 + (lane >> 4) * 4;
                float m[4];
#pragma unroll
                for (int r = 0; r < 4; ++r) { const bool keep = dir ? (s0 + r >= tq) : (s0 + r <= tq); m[r] = keep ? a[r] : 0.f; }
                *(uint2*)(Sm + tq * 72 + s0) = make_uint2(pack2bf(m[0], m[1]), pack2bf(m[2], m[3]));
            }
        }
        __syncthreads();
#pragma unroll
        for (int ks = 0; ks < 2; ++ks) {
            const bf16x8 a1 = row_frag(qt, 72, ti * 16, ks * 32, lane), a2 = row_frag(Sm, 72, ti * 16, ks * 32, lane);
#pragma unroll
            for (int j = 0; j < 4; ++j) {
                acc[j] = __builtin_amdgcn_mfma_f32_16x16x32_bf16(a1, tr_frag(S0s, 136, ks * 32, (vt0 + j) * 16, lane), acc[j], 0, 0, 0);
                acc[j] = __builtin_amdgcn_mfma_f32_16x16x32_bf16(a2, tr_frag(Vs, 136, ks * 32, (vt0 + j) * 16, lane), acc[j], 0, 0, 0);
            }
        }
        if (dir == 0) __syncthreads();
    }
#pragma unroll
    for (int j = 0; j < 4; ++j)
#pragma unroll
        for (int r = 0; r < 4; ++r) O[(ti * 16 + (lane >> 4) * 4 + r) * 132 + (vt0 + j) * 16 + (lane & 15)] = acc[j][r];
    __syncthreads();
    {
        const int v0 = (tid & 7) * 16;
        float o[16];
        float ss = 0.f;
#pragma unroll
        for (int i = 0; i < 16; ++i) { o[i] = O[t * 132 + v0 + i]; ss += o[i] * o[i]; }
        ss += __shfl_xor(ss, 1, 64); ss += __shfl_xor(ss, 2, 64); ss += __shfl_xor(ss, 4, 64);
        const float rms = rsqrtf(ss * (1.f / 128.f) + 1e-5f);
        float g[16];
        unpack8(gq0, g); unpack8(gq1, g + 8);
        float y[16];
#pragma unroll
        for (int i = 0; i < 16; ++i) y[i] = o[i] * rms * ng[v0 + i] * silu_f(g[i]);
        bf16_t* yp = YC + (size_t)(c * 64 + t) * 1024 + h * 128 + v0;
        *(uint4*)yp = make_uint4(pack2bf(y[0], y[1]), pack2bf(y[2], y[3]), pack2bf(y[4], y[5]), pack2bf(y[6], y[7]));
        *(uint4*)(yp + 8) = make_uint4(pack2bf(y[8], y[9]), pack2bf(y[10], y[11]), pack2bf(y[12], y[13]), pack2bf(y[14], y[15]));
    }
}

DEV void load8bf(const bf16_t* ptr, float* f) { unpack8(*(const uint4*)ptr, f); }
struct RwNb { int sL, sR, sU, sD; bool vL, vR, vU, vD; };
DEV RwNb rw_nb(int s) {
    RwNb q; q.vU = false; q.vD = false;
    if (s < NCX) { q.vL = s > 0; q.vR = s < NCX - 1; }
    else { const int n = s - NCX, rr = n >> 6, cc = n & 63; q.vL = cc > 0; q.vR = cc < 63; q.vU = rr > 0; q.vD = rr < 127; }
    q.sL = q.vL ? s - 1 : s; q.sR = q.vR ? s + 1 : s; q.sU = q.vU ? s - 64 : s; q.sD = q.vD ? s + 64 : s;
    return q;
}
struct RwRaw { uint4 o, l, r, u, d; };
DEV RwRaw rw_load(const bf16_t* P0, int s, const RwNb& q, int cb) {
    RwRaw w;
    w.o = *(const uint4*)(P0 + (size_t)s * EIN + RW0 + cb); w.l = *(const uint4*)(P0 + (size_t)q.sL * EIN + RW0 + cb); w.r = *(const uint4*)(P0 + (size_t)q.sR * EIN + RW0 + cb);
    w.u = *(const uint4*)(P0 + (size_t)q.sU * EIN + RW0 + cb); w.d = *(const uint4*)(P0 + (size_t)q.sD * EIN + RW0 + cb);
    return w;
}
DEV void rw_comb_l(const RwRaw& w, const RwNb& q, const float* ml, float* out) {
    float own[8]; unpack8(w.o, own);
    const float nb[8] = {q.vL ? bflo(w.l.x) : 0.f, q.vR ? bfhi(w.r.x) : 0.f, q.vU ? bflo(w.u.y) : 0.f, q.vD ? bfhi(w.d.y) : 0.f,
                         q.vL ? bflo(w.l.z) : 0.f, q.vR ? bfhi(w.r.z) : 0.f, q.vU ? bflo(w.u.w) : 0.f, q.vD ? bfhi(w.d.w) : 0.f};
    const float4 m0 = *(const float4*)ml, m1 = *(const float4*)(ml + 4);
    const float m[8] = {m0.x, m0.y, m0.z, m0.w, m1.x, m1.y, m1.z, m1.w};
#pragma unroll
    for (int i = 0; i < 8; ++i) out[i] = own[i] + (nb[i] - own[i]) * m[i];
}
DEV void rw_comb(const RwRaw& w, const RwNb& q, const float* __restrict__ mu, int cb, float* out) {
    float own[8]; unpack8(w.o, own);
    const float nb[8] = {q.vL ? bflo(w.l.x) : 0.f, q.vR ? bfhi(w.r.x) : 0.f, q.vU ? bflo(w.u.y) : 0.f, q.vD ? bfhi(w.d.y) : 0.f,
                         q.vL ? bflo(w.l.z) : 0.f, q.vR ? bfhi(w.r.z) : 0.f, q.vU ? bflo(w.u.w) : 0.f, q.vD ? bfhi(w.d.w) : 0.f};
    const float4 m0 = ld4(mu + cb), m1 = ld4(mu + cb + 4);
    const float m[8] = {m0.x, m0.y, m0.z, m0.w, m1.x, m1.y, m1.z, m1.w};
#pragma unroll
    for (int i = 0; i < 8; ++i) out[i] = own[i] + (nb[i] - own[i]) * m[i];
}
DEV uint4 pack8(const float* f) { return make_uint4(pack2bf(f[0], f[1]), pack2bf(f[2], f[3]), pack2bf(f[4], f[5]), pack2bf(f[6], f[7])); }

template <int XM, int YM, class F>
DEV void mm64(const bf16_t* X, const bf16_t* Y, F f, int lane, int wave) {
#pragma unroll
    for (int q = 0; q < 2; ++q) {
        const int idx = wave * 2 + q, ti = idx >> 2, tj = idx & 3;
        f32x4 acc = (f32x4){0.f, 0.f, 0.f, 0.f};
#pragma unroll
        for (int ks = 0; ks < 2; ++ks) {
            const bf16x8 a = XM == 0 ? row_frag(X, 72, ti * 16, ks * 32, lane) : tr_frag(X, 72, ks * 32, ti * 16, lane);
            const bf16x8 bq = YM == 0 ? row_frag(Y, 72, tj * 16, ks * 32, lane) : tr_frag(Y, 72, ks * 32, tj * 16, lane);
            acc = __builtin_amdgcn_mfma_f32_16x16x32_bf16(a, bq, acc, 0, 0, 0);
        }
        f(ti * 16 + (lane >> 4) * 4, tj * 16 + (lane & 15), acc);
    }
}
template <int XM, int YM, class F>
DEV void mm64x2(const bf16_t* X1, const bf16_t* Y1, const bf16_t* X2, const bf16_t* Y2, F f, int lane, int wave) {
#pragma unroll
    for (int q = 0; q < 2; ++q) {
        const int idx = wave * 2 + q, ti = idx >> 2, tj = idx & 3;
        f32x4 acc = (f32x4){0.f, 0.f, 0.f, 0.f};
#pragma unroll
        for (int ks = 0; ks < 2; ++ks) {
            const bf16x8 a = XM == 0 ? row_frag(X1, 72, ti * 16, ks * 32, lane) : tr_frag(X1, 72, ks * 32, ti * 16, lane);
            const bf16x8 bq = YM == 0 ? row_frag(Y1, 72, tj * 16, ks * 32, lane) : tr_frag(Y1, 72, ks * 32, tj * 16, lane);
            acc = __builtin_amdgcn_mfma_f32_16x16x32_bf16(a, bq, acc, 0, 0, 0);
            const bf16x8 a2 = XM == 0 ? row_frag(X2, 72, ti * 16, ks * 32, lane) : tr_frag(X2, 72, ks * 32, ti * 16, lane);
            const bf16x8 b2 = YM == 0 ? row_frag(Y2, 72, tj * 16, ks * 32, lane) : tr_frag(Y2, 72, ks * 32, tj * 16, lane);
            acc = __builtin_amdgcn_mfma_f32_16x16x32_bf16(a2, b2, acc, 0, 0, 0);
        }
        f(ti * 16 + (lane >> 4) * 4, tj * 16 + (lane & 15), acc);
    }
}
DEV void st_img(bf16_t* P, int i0, int j, float a0, float a1, float a2, float a3) {
    P[(i0 + 0) * 72 + j] = __builtin_bit_cast(unsigned short, (__bf16)a0); P[(i0 + 1) * 72 + j] = __builtin_bit_cast(unsigned short, (__bf16)a1);
    P[(i0 + 2) * 72 + j] = __builtin_bit_cast(unsigned short, (__bf16)a2); P[(i0 + 3) * 72 + j] = __builtin_bit_cast(unsigned short, (__bf16)a3);
}

struct RwRaw3 { uint4 o, u, d; };
DEV RwRaw3 rw_load3(const bf16_t* P0, int s, const RwNb& q, int cb) {
    RwRaw3 w;
    w.o = *(const uint4*)(P0 + (size_t)s * EIN + RW0 + cb); w.u = *(const uint4*)(P0 + (size_t)q.sU * EIN + RW0 + cb); w.d = *(const uint4*)(P0 + (size_t)q.sD * EIN + RW0 + cb);
    return w;
}
DEV void rw_comb3(const RwRaw3& w, const RwNb& q, const bf16_t* tile, const bf16_t* P0, int s, int t, int cb, int j0, const float* ml, float* out) {
    asm volatile("" :: "v"(w.u.x), "v"(w.u.z), "v"(w.d.x), "v"(w.d.z));
    float own[8]; unpack8(w.o, own);
    float l0 = 0.f, l4 = 0.f, r1 = 0.f, r5 = 0.f;
    if (q.vL) { if (t > 0) { l0 = bf2f(tile[(t - 1) * 72 + j0]); l4 = bf2f(tile[(t - 1) * 72 + j0 + 4]); }
                else { const bf16_t* g = P0 + (size_t)(s - 1) * EIN + RW0 + cb; l0 = bf2f(g[0]); l4 = bf2f(g[4]); } }
    if (q.vR) { if (t < 63) { r1 = bf2f(tile[(t + 1) * 72 + j0 + 1]); r5 = bf2f(tile[(t + 1) * 72 + j0 + 5]); }
                else { const bf16_t* g = P0 + (size_t)(s + 1) * EIN + RW0 + cb; r1 = bf2f(g[1]); r5 = bf2f(g[5]); } }
    const float nb[8] = {l0, r1, q.vU ? bflo(w.u.y) : 0.f, q.vD ? bfhi(w.d.y) : 0.f, l4, r5, q.vU ? bflo(w.u.w) : 0.f, q.vD ? bfhi(w.d.w) : 0.f};
    const float4 m0 = *(const float4*)ml, m1 = *(const float4*)(ml + 4);
    const float m[8] = {m0.x, m0.y, m0.z, m0.w, m1.x, m1.y, m1.z, m1.w};
#pragma unroll
    for (int i = 0; i < 8; ++i) out[i] = own[i] + (nb[i] - own[i]) * m[i];
}
struct R1Raw { RwRaw3 r, k, v, w, a; float4 qw0, qw1, qa0, qa1; };
DEV void r1_consts(const Params& p, int h, int dir, float* sm) {
    const int tid = opaque_tid();
    float* sv = (float*)((bf16_t*)sm + 14 * 4608);
    __syncthreads();
    if (tid < 64) { const int hc = h * 64 + tid; sv[64 + tid] = p.in[dir ? 18 : 16][hc]; sv[128 + tid] = p.in[dir ? 22 : 20][hc]; sv[192 + tid] = p.in[24][hc]; sv[256 + tid] = p.in[25][hc]; sv[320 + tid] = p.in[26][hc]; }
    if (tid < 320) { const int tn = tid >> 6, col = tid & 63; const int cb = tn < 3 ? tn * 512 + h * 64 : (tn == 3 ? 2048 + dir * 64 : 2176 + dir * 64); sv[384 + tid] = p.in[15][cb + col]; }
}
DEV void r1_load(const Params& p, int h, int dir, int c, R1Raw& R) {
    const int tid = opaque_tid();
    const bf16_t* P0 = (const bf16_t*)(p.ws + OFF_P0);
    const float* ww2 = p.in[dir ? 19 : 17]; const float* wa2 = p.in[dir ? 23 : 21];
    const int t = tid >> 3, j0 = (tid & 7) * 8, s = c * 64 + t;
    const RwNb nbq = rw_nb(s);
    R.r = rw_load3(P0, s, nbq, h * 64 + j0); R.k = rw_load3(P0, s, nbq, 512 + h * 64 + j0); R.v = rw_load3(P0, s, nbq, 1024 + h * 64 + j0);
    R.w = rw_load3(P0, s, nbq, 2048 + dir * 64 + j0); R.a = rw_load3(P0, s, nbq, 2176 + dir * 64 + j0);
    R.qw0 = ld4(ww2 + (size_t)t * 512 + h * 64 + j0); R.qw1 = ld4(ww2 + (size_t)t * 512 + h * 64 + j0 + 4);
    R.qa0 = ld4(wa2 + (size_t)t * 512 + h * 64 + j0); R.qa1 = ld4(wa2 + (size_t)t * 512 + h * 64 + j0 + 4);
}
DEV void rwkv1_unit(const Params& p, int h, int dir, int c, float* sm, R1Raw& R, int cnext) {
    const int tid = opaque_tid(), lane = tid & 63, wave = tid >> 6;
    bf16_t* RU = (bf16_t*)(p.ws + OFF_RU) + (size_t)((h * 2 + dir) * NCH + c) * 16384;
    float* BONS = (float*)(p.ws + OFF_BONS);
    bf16_t* img = (bf16_t*)sm;
#define SLOT(i_) (img + (i_) * 4608)
    float* fLW = (float*)SLOT(10);
    float* fAS = (float*)SLOT(12);
    float* sv = (float*)SLOT(14);
    const int t = tid >> 3, j0 = (tid & 7) * 8, s = c * 64 + t;
    const bf16_t* P0 = (const bf16_t*)(p.ws + OFF_P0);
    __syncthreads();
    *(uint4*)(SLOT(0) + t * 72 + j0) = R.r.o; *(uint4*)(SLOT(1) + t * 72 + j0) = R.k.o; *(uint4*)(SLOT(2) + t * 72 + j0) = R.v.o;
    *(uint4*)(SLOT(3) + t * 72 + j0) = R.w.o; *(uint4*)(SLOT(4) + t * 72 + j0) = R.a.o;
    __syncthreads();
    float r8[8], k8[8], v8[8];
    {
        float x8[8];
        const RwNb nbq = rw_nb(s);
        rw_comb3(R.r, nbq, SLOT(0), P0, s, t, h * 64 + j0, j0, sv + 384 + j0, r8);
        rw_comb3(R.k, nbq, SLOT(1), P0, s, t, 512 + h * 64 + j0, j0, sv + 448 + j0, k8);
        rw_comb3(R.v, nbq, SLOT(2), P0, s, t, 1024 + h * 64 + j0, j0, sv + 512 + j0, v8);
        rw_comb3(R.w, nbq, SLOT(3), P0, s, t, 2048 + dir * 64 + j0, j0, sv + 576 + j0, x8);
#pragma unroll
        for (int i = 0; i < 8; ++i) x8[i] = tanh_f(x8[i]);
        *(uint4*)(SLOT(6) + t * 72 + j0) = pack8(x8);
        rw_comb3(R.a, nbq, SLOT(4), P0, s, t, 2176 + dir * 64 + j0, j0, sv + 640 + j0, x8);
        *(uint4*)(SLOT(7) + t * 72 + j0) = pack8(x8);
        { const float wq[8] = {R.qw0.x, R.qw0.y, R.qw0.z, R.qw0.w, R.qw1.x, R.qw1.y, R.qw1.z, R.qw1.w}; *(uint4*)(SLOT(8) + t * 72 + j0) = pack8(wq); }
        { const float wq[8] = {R.qa0.x, R.qa0.y, R.qa0.z, R.qa0.w, R.qa1.x, R.qa1.y, R.qa1.z, R.qa1.w}; *(uint4*)(SLOT(9) + t * 72 + j0) = pack8(wq); }
    }
    r1_load(p, h, dir, cnext >= 0 ? cnext : c, R);
    __syncthreads();
    mm64<0, 1>(SLOT(6), SLOT(8), [=](int i0, int j, f32x4 a) {
#pragma unroll
        for (int r = 0; r < 4; ++r) fLW[(i0 + r) * 65 + j] = -0.6065306597f * sigmoid_f(sv[64 + j] + a[r]); }, lane, wave);
    mm64<0, 1>(SLOT(7), SLOT(9), [=](int i0, int j, f32x4 a) {
#pragma unroll
        for (int r = 0; r < 4; ++r) fAS[(i0 + r) * 65 + j] = sigmoid_f(sv[128 + j] + a[r]); }, lane, wave);
    __syncthreads();
#pragma unroll
    for (int j = 0; j < 8; ++j) {
        const int k = wave * 8 + j;
        const float v = wave_scan_add(fLW[lane * 65 + k], lane, dir);
        fLW[lane * 65 + k] = v;
        if (lane == (dir ? 0 : 63)) sv[k] = v;
    }
    __syncthreads();
    {
        float kkv[8], ss = 0.f;
#pragma unroll
        for (int i = 0; i < 8; ++i) { kkv[i] = k8[i] * sv[192 + j0 + i]; ss += kkv[i] * kkv[i]; }
        ss += __shfl_xor(ss, 1, 64); ss += __shfl_xor(ss, 2, 64); ss += __shfl_xor(ss, 4, 64);
        const float rn = rsqrtf(fmaxf(ss, 1e-24f));
        float fa[8], fb[8], fk[8], fr[8], fbp[8], fkp[8], bon = 0.f;
        const int tp = dir ? t + 1 : t - 1;
        const bool hasp = dir ? (t < 63) : (t > 0);
#pragma unroll
        for (int i = 0; i < 8; ++i) {
            const int k = j0 + i;
            const float Bt = fLW[t * 65 + k], Bx = hasp ? fLW[tp * 65 + k] : 0.f, asg = fAS[t * 65 + k];
            const float kk = kkv[i] * rn, kh = k8[i] * (1.f + (asg - 1.f) * sv[256 + k]);
            bon += r8[i] * kh * sv[320 + k];
            const float enB = fexp(-Bt), eLB = fexp(sv[k] - Bt), bv = kk * asg;
            fa[i] = -kk * fexp(Bx); fb[i] = bv * enB; fk[i] = kh * enB; fr[i] = r8[i] * fexp(Bt); fbp[i] = bv * eLB; fkp[i] = kh * eLB;
        }
        bon += __shfl_xor(bon, 1, 64); bon += __shfl_xor(bon, 2, 64); bon += __shfl_xor(bon, 4, 64);
        if ((tid & 7) == 0) BONS[((size_t)dir * TB + s) * 8 + h] = bon;
        *(uint4*)(SLOT(0) + t * 72 + j0) = pack8(fa); *(uint4*)(SLOT(1) + t * 72 + j0) = pack8(fb); *(uint4*)(SLOT(2) + t * 72 + j0) = pack8(fk);
        *(uint4*)(SLOT(3) + t * 72 + j0) = pack8(fr); *(uint4*)(SLOT(4) + t * 72 + j0) = pack8(fbp); *(uint4*)(SLOT(5) + t * 72 + j0) = pack8(fkp);
    }
    __syncthreads();
    *(uint4*)(SLOT(6) + t * 72 + j0) = pack8(v8);
    __syncthreads();
    mm64<0, 0>(SLOT(0), SLOT(1), [=](int i0, int j, f32x4 a) {
        float m[4];
#pragma unroll
        for (int r = 0; r < 4; ++r) { const bool keep = dir ? (j > i0 + r) : (j < i0 + r); m[r] = keep ? a[r] : 0.f; }
        const bool dg = (i0 >> 4) == (j >> 4);
        st_img(SLOT(7), i0, j, dg ? m[0] : 0.f, dg ? m[1] : 0.f, dg ? m[2] : 0.f, dg ? m[3] : 0.f);
        st_img(SLOT(8), i0, j, (dg ? m[0] : 0.f) + (j == i0 ? 1.f : 0.f), (dg ? m[1] : 0.f) + (j == i0 + 1 ? 1.f : 0.f), (dg ? m[2] : 0.f) + (j == i0 + 2 ? 1.f : 0.f), (dg ? m[3] : 0.f) + (j == i0 + 3 ? 1.f : 0.f));
        st_img(SLOT(12), i0, j, dg ? 0.f : m[0], dg ? 0.f : m[1], dg ? 0.f : m[2], dg ? 0.f : m[3]); }, lane, wave);
    mm64<0, 0>(SLOT(0), SLOT(2), [=](int i0, int j, f32x4 a) {
        float m[4];
#pragma unroll
        for (int r = 0; r < 4; ++r) { const bool keep = dir ? (j > i0 + r) : (j < i0 + r); m[r] = keep ? a[r] : 0.f; }
        st_img(SLOT(9), i0, j, m[0], m[1], m[2], m[3]); }, lane, wave);
    mm64<0, 0>(SLOT(3), SLOT(1), [=](int i0, int j, f32x4 a) {
        float m[4];
#pragma unroll
        for (int r = 0; r < 4; ++r) { const bool keep = dir ? (j >= i0 + r) : (j <= i0 + r); m[r] = keep ? a[r] : 0.f; }
        st_img(SLOT(10), i0, j, m[0], m[1], m[2], m[3]); }, lane, wave);
    mm64<0, 0>(SLOT(3), SLOT(2), [=](int i0, int j, f32x4 a) {
        float m[4];
#pragma unroll
        for (int r = 0; r < 4; ++r) { const bool keep = dir ? (j >= i0 + r) : (j <= i0 + r); m[r] = keep ? a[r] : 0.f; }
        st_img(SLOT(11), i0, j, m[0], m[1], m[2], m[3]); }, lane, wave);
    __syncthreads();
    {
        bf16_t* Pc = SLOT(7); bf16_t* Pn = SLOT(1); bf16_t* Tc = SLOT(8); bf16_t* Tn = SLOT(2);
#pragma unroll 1
        for (int it = 0; it < 3; ++it) {
            mm64<0, 1>(Pc, Pc, [=](int i0, int j, f32x4 a) { st_img(Pn, i0, j, a[0], a[1], a[2], a[3]); }, lane, wave);
            __syncthreads();
            mm64<0, 1>(Tc, Pn, [=](int i0, int j, f32x4 a) {
                st_img(Tn, i0, j, a[0] + bf2f(Tc[(i0 + 0) * 72 + j]), a[1] + bf2f(Tc[(i0 + 1) * 72 + j]), a[2] + bf2f(Tc[(i0 + 2) * 72 + j]), a[3] + bf2f(Tc[(i0 + 3) * 72 + j])); }, lane, wave);
            __syncthreads();
            bf16_t* tmp = Pc; Pc = Pn; Pn = tmp; tmp = Tc; Tc = Tn; Tn = tmp;
        }
    }
    mm64<0, 1>(SLOT(2), SLOT(12), [=](int i0, int j, f32x4 a) { st_img(SLOT(7), i0, j, a[0], a[1], a[2], a[3]); }, lane, wave);
    mm64<0, 1>(SLOT(2), SLOT(0), [=](int i0, int j, f32x4 a) { st_img(SLOT(1), i0, j, a[0], a[1], a[2], a[3]); }, lane, wave);
    mm64<0, 1>(SLOT(9), SLOT(6), [=](int i0, int j, f32x4 a) { st_img(SLOT(13), i0, j, a[0], a[1], a[2], a[3]); }, lane, wave);
    __syncthreads();
    mm64<0, 1>(SLOT(2), SLOT(13), [=](int i0, int j, f32x4 a) { st_img(SLOT(8), i0, j, a[0], a[1], a[2], a[3]); }, lane, wave);
    __syncthreads();
    {
        const bf16_t* Zp = (wave < 4) ? SLOT(1) : SLOT(8);
        bf16_t* Xi = (wave < 4) ? SLOT(12) : SLOT(9);
        const int ct = (wave & 3) * 16, g4 = (lane >> 4) * 4, l15 = lane & 15;
#pragma unroll
        for (int bs = 0; bs < 4; ++bs) {
            const int bi = dir ? 3 - bs : bs;
            f32x4 acc;
#pragma unroll
            for (int r = 0; r < 4; ++r) acc[r] = bf2f(Zp[(bi * 16 + g4 + r) * 72 + ct + l15]);
            const bool k0 = dir ? (bi == 0) : (bi >= 1), k1 = dir ? (bi <= 2) : (bi == 3);
            if (k0) acc = __builtin_amdgcn_mfma_f32_16x16x32_bf16(row_frag(SLOT(7), 72, bi * 16, 0, lane), tr_frag(Xi, 72, 0, ct, lane), acc, 0, 0, 0);
            if (k1) acc = __builtin_amdgcn_mfma_f32_16x16x32_bf16(row_frag(SLOT(7), 72, bi * 16, 32, lane), tr_frag(Xi, 72, 32, ct, lane), acc, 0, 0, 0);
            st_img(Xi, bi * 16 + g4, ct + l15, acc[0], acc[1], acc[2], acc[3]);
            __syncthreads();
        }
    }
    mm64<1, 1>(SLOT(12), SLOT(4), [=](int i0, int j, f32x4 a) {
        float m[4];
#pragma unroll
        for (int r = 0; r < 4; ++r) m[r] = a[r] + ((i0 + r) == j ? fexp(sv[j]) : 0.f);
        *(uint2*)(RU + j * 64 + i0) = make_uint2(pack2bf(m[0], m[1]), pack2bf(m[2], m[3])); }, lane, wave);
    mm64x2<1, 1>(SLOT(4), SLOT(9), SLOT(5), SLOT(6), [=](int i0, int j, f32x4 a) {
        *(uint2*)(RU + 4096 + j * 64 + i0) = make_uint2(pack2bf(a[0], a[1]), pack2bf(a[2], a[3])); }, lane, wave);
    mm64<1, 0>(SLOT(12), SLOT(10), [=](int i0, int j, f32x4 a) {
        const uint2 rr = *(const uint2*)(SLOT(3) + j * 72 + i0);
        *(uint2*)(RU + 8192 + j * 64 + i0) = make_uint2(pack2bf(a[0] + bflo(rr.x), a[1] + bfhi(rr.x)), pack2bf(a[2] + bflo(rr.y), a[3] + bfhi(rr.y))); }, lane, wave);
    mm64x2<0, 1>(SLOT(10), SLOT(9), SLOT(11), SLOT(6), [=](int i0, int j, f32x4 a) {
        *(uint2*)(RU + 12288 + j * 64 + i0) = make_uint2(pack2bf(a[0], a[1]), pack2bf(a[2], a[3])); }, lane, wave);
#undef SLOT
}

#define R2_LOAD(M_, C_, rnd_) do { const int r0_ = ((rnd_) < R2_NR ? (rnd_) : R2_NR - 1) * R2_RS; \
    _Pragma("unroll") for (int s_ = 0; s_ < R2_RS; ++s_) M_[s_] = *(const uint4*)(RU + (size_t)(chain * NCH + chunk_at(dir, r0_ + s_)) * 16384 + tid * 8); \
    _Pragma("unroll") for (int j_ = 0; j_ < 3; ++j_) { const int cq_ = tid + 512 * j_; \
        C_[j_] = *(const uint4*)(RU + (size_t)(chain * NCH + chunk_at(dir, r0_ + (cq_ >> 7))) * 16384 + 4096 + (vblk * 16 + ((cq_ >> 3) & 15)) * 64 + (cq_ & 7) * 8); } } while (0)
#define R2_ROUND(M_, C_, rnd_) do { \
    { const int row_ = tid >> 3, c8_ = tid & 7, sw_ = (row_ >> 1) & 7, u0_ = (c8_ >> 2) * 4 + (c8_ & 1) * 2, eh_ = ((c8_ >> 1) & 1) * 8; \
      _Pragma("unroll") for (int s_ = 0; s_ < R2_RS; ++s_) { char* sl_ = ring + s_ * 10240 + row_ * 128 + eh_; \
          *(uint2*)(sl_ + ((u0_ ^ sw_) * 16)) = make_uint2(M_[s_].x, M_[s_].y); *(uint2*)(sl_ + (((u0_ + 1) ^ sw_) * 16)) = make_uint2(M_[s_].z, M_[s_].w); } \
      _Pragma("unroll") for (int j_ = 0; j_ < 3; ++j_) { const int cq_ = tid + 512 * j_, rw_ = (cq_ >> 3) & 15, q8_ = cq_ & 7, i_ = q8_ >> 1, g0_ = (q8_ & 1) * 2, sc_ = (rw_ >> 1) & 7; \
          char* sl_ = ring + (cq_ >> 7) * 10240 + 8192 + rw_ * 128 + (i_ & 1) * 8; \
          *(uint2*)(sl_ + (((g0_ * 2 + (i_ >> 1)) ^ sc_) * 16)) = make_uint2(C_[j_].x, C_[j_].y); *(uint2*)(sl_ + ((((g0_ + 1) * 2 + (i_ >> 1)) ^ sc_) * 16)) = make_uint2(C_[j_].z, C_[j_].w); } } \
    R2_LOAD(M_, C_, (rnd_) + 2); \
    __syncthreads(); \
    if (wave == 0) { \
        _Pragma("unroll 4") for (int s_ = 0; s_ < R2_RS; ++s_) { \
            const int c_ = chunk_at(dir, (rnd_) * R2_RS + s_); const char* sl_ = ring + s_ * 10240; \
            unsigned pk_[4][2]; \
            _Pragma("unroll") for (int i_ = 0; i_ < 4; ++i_) { pk_[i_][0] = pack2bf(st[i_][0], st[i_][1]); pk_[i_][1] = pack2bf(st[i_][2], st[i_][3]); } \
            bf16_t* sp_ = S0G + ((size_t)(chain * NCH + c_) * 64 + vblk * 16 + l15) * 64 + g * 4; \
            _Pragma("unroll") for (int i_ = 0; i_ < 4; ++i_) *(uint2*)(sp_ + i_ * 16) = make_uint2(pk_[i_][0], pk_[i_][1]); \
            bf16x8 bfr_[2]; \
            _Pragma("unroll") for (int ks_ = 0; ks_ < 2; ++ks_) { const uint4 u_ = make_uint4(pk_[2 * ks_][0], pk_[2 * ks_][1], pk_[2 * ks_ + 1][0], pk_[2 * ks_ + 1][1]); bfr_[ks_] = __builtin_bit_cast(bf16x8, u_); } \
            const uint4 c01_ = *(const uint4*)(sl_ + 8192 + l15 * 128 + (((g * 2) ^ ((l15 >> 1) & 7)) * 16)), c23_ = *(const uint4*)(sl_ + 8192 + l15 * 128 + (((g * 2 + 1) ^ ((l15 >> 1) & 7)) * 16)); \
            const unsigned cw_[8] = {c01_.x, c01_.y, c01_.z, c01_.w, c23_.x, c23_.y, c23_.z, c23_.w}; \
            _Pragma("unroll") for (int i_ = 0; i_ < 4; ++i_) { \
                f32x4 acc_ = (f32x4){bflo(cw_[2 * i_]), bfhi(cw_[2 * i_]), bflo(cw_[2 * i_ + 1]), bfhi(cw_[2 * i_ + 1])}; \
                _Pragma("unroll") for (int ks_ = 0; ks_ < 2; ++ks_) { \
                    const int row_ = i_ * 16 + l15; \
                    const bf16x8 af_ = *(const bf16x8*)(sl_ + row_ * 128 + (((ks_ * 4 + g) ^ ((row_ >> 1) & 7)) * 16)); \
                    acc_ = __builtin_amdgcn_mfma_f32_16x16x32_bf16(af_, bfr_[ks_], acc_, 0, 0, 0); } \
                st[i_] = acc_; } } } \
    __syncthreads(); } while (0)
DEV void rwkv2_unit(const Params& p, int chain, int vblk, float* sm) {
    constexpr int R2_RS = 12, R2_NR = NCH / R2_RS;
    static_assert(R2_NR * R2_RS == NCH && R2_RS * 10240 <= LDS_BYTES, "R2 ring");
    const int tid = opaque_tid(), lane = tid & 63, wave = tid >> 6;
    const bf16_t* RU = (const bf16_t*)(p.ws + OFF_RU);
    bf16_t* S0G = (bf16_t*)(p.ws + OFF_RS0);
    char* ring = (char*)sm;
    const int dir = chain & 1, g = lane >> 4, l15 = lane & 15;
    f32x4 st[4];
#pragma unroll
    for (int i = 0; i < 4; ++i) st[i] = (f32x4){0.f, 0.f, 0.f, 0.f};
    uint4 ma[R2_RS], ca[3], mb[R2_RS], cb[3];
    __syncthreads();
    R2_LOAD(ma, ca, 0); R2_LOAD(mb, cb, 1);
#pragma unroll 1
    for (int rnd = 0; rnd < R2_NR; rnd += 2) {
        R2_ROUND(ma, ca, rnd);
        if (rnd + 1 < R2_NR) R2_ROUND(mb, cb, rnd + 1);
    }
}
#undef R2_LOAD
#undef R2_ROUND

DEV void rwkv3_unit(const Params& p, int h, int c, float* sm) {
    const int tid = opaque_tid(), lane = tid & 63, wave = tid >> 6;
    const bf16_t* P0 = (const bf16_t*)(p.ws + OFF_P0);
    const bf16_t* RUb = (const bf16_t*)(p.ws + OFF_RU);
    const bf16_t* S0G = (const bf16_t*)(p.ws + OFF_RS0);
    const float* BONS = (const float*)(p.ws + OFF_BONS);
    bf16_t* YC = (bf16_t*)(p.ws + OFF_YC);
    const float* mu = p.in[15]; const float* gn_g = p.in[27]; const float* gn_b = p.in[28];
    bf16_t* img = (bf16_t*)sm;
    float* O = sm + 4 * 2304;
    const int t = tid >> 3, v0 = (tid & 7) * 8, s = c * 64 + t;
    const size_t u0 = (size_t)((h * 2 + 0) * NCH + c), u1 = (size_t)((h * 2 + 1) * NCH + c);
    const uint4 gr0 = *(const uint4*)(RUb + u0 * 16384 + 8192 + t * 64 + v0), gs0 = *(const uint4*)(S0G + u0 * 4096 + t * 64 + v0);
    const uint4 gr1 = *(const uint4*)(RUb + u1 * 16384 + 8192 + t * 64 + v0), gs1 = *(const uint4*)(S0G + u1 * 4096 + t * 64 + v0);
    uint2 yl[2][2];
#pragma unroll
    for (int q = 0; q < 2; ++q) { const int idx = wave * 2 + q, ti = idx >> 2, tj = idx & 3;
        yl[q][0] = *(const uint2*)(RUb + u0 * 16384 + 12288 + (tj * 16 + (lane & 15)) * 64 + ti * 16 + (lane >> 4) * 4);
        yl[q][1] = *(const uint2*)(RUb + u1 * 16384 + 12288 + (tj * 16 + (lane & 15)) * 64 + ti * 16 + (lane >> 4) * 4); }
    const RwNb nbq = rw_nb(s);
    const RwRaw wv_ = rw_load(P0, s, nbq, 1024 + h * 64 + v0), wg_ = rw_load(P0, s, nbq, 1536 + h * 64 + v0);
    const float bon = BONS[(size_t)s * 8 + h] + BONS[((size_t)TB + s) * 8 + h];
    __syncthreads();
    *(uint4*)(img + 0 * 4608 + t * 72 + v0) = gr0; *(uint4*)(img + 2 * 4608 + t * 72 + v0) = gs0;
    *(uint4*)(img + 1 * 4608 + t * 72 + v0) = gr1; *(uint4*)(img + 3 * 4608 + t * 72 + v0) = gs1;
    __syncthreads();
#pragma unroll
    for (int q = 0; q < 2; ++q) {
        const int idx = wave * 2 + q, ti = idx >> 2, tj = idx & 3;
        f32x4 accd[2];
#pragma unroll
        for (int dir = 0; dir < 2; ++dir) {
            f32x4 acc = (f32x4){bflo(yl[q][dir].x), bfhi(yl[q][dir].x), bflo(yl[q][dir].y), bfhi(yl[q][dir].y)};
#pragma unroll
            for (int ks = 0; ks < 2; ++ks) acc = __builtin_amdgcn_mfma_f32_16x16x32_bf16(row_frag(img + dir * 4608, 72, ti * 16, ks * 32, lane), row_frag(img + (2 + dir) * 4608, 72, tj * 16, ks * 32, lane), acc, 0, 0, 0);
            accd[dir] = acc;
        }
#pragma unroll
        for (int r = 0; r < 4; ++r) {
            const int oi = (ti * 16 + (lane >> 4) * 4 + r) * 68 + tj * 16 + (lane & 15);
            O[oi] = accd[0][r] + accd[1][r];
        }
    }
    __syncthreads();
    {
        float y[8], sum = 0.f;
#pragma unroll
        for (int i = 0; i < 8; ++i) { y[i] = O[t * 68 + v0 + i]; sum += y[i]; }
        sum += __shfl_xor(sum, 1, 64); sum += __shfl_xor(sum, 2, 64); sum += __shfl_xor(sum, 4, 64);
        const float mean = sum * (1.f / 64.f);
        float sq = 0.f;
#pragma unroll
        for (int i = 0; i < 8; ++i) { y[i] -= mean; sq += y[i] * y[i]; }
        sq += __shfl_xor(sq, 1, 64); sq += __shfl_xor(sq, 2, 64); sq += __shfl_xor(sq, 4, 64);
        const float rstd = rsqrtf(sq * (1.f / 64.f) + 64e-5f);
        float vm[8], gm[8];
        rw_comb(wv_, nbq, mu, 1024 + h * 64 + v0, vm);
        rw_comb(wg_, nbq, mu, 1536 + h * 64 + v0, gm);
        float o[8];
#pragma unroll
        for (int i = 0; i < 8; ++i) o[i] = (y[i] * rstd * gn_g[h * 64 + v0 + i] + gn_b[h * 64 + v0 + i] + bon * vm[i]) * silu_f(gm[i]);
        *(uint4*)(YC + (size_t)s * 1024 + 512 + h * 64 + v0) = pack8(o);
    }
}

DEV void ln_rows(const float* src, const float* res_lat, const float* res_cx, int nrows, const float* __restrict__ g, const float* __restrict__ bt, float* dst_lat, float* dst_cx, int ncx,
                 bf16_t* hb = nullptr, const float* mvc = nullptr, const float* mvl = nullptr) {
    const int tid_ = opaque_tid(); const int lane = tid_ & 63, gw = blockIdx.x * NWV + (tid_ >> 6), ngw = gridDim.x * NWV;
    float4 gg[4], bb[4];
#pragma unroll
    for (int i = 0; i < 4; ++i) { gg[i] = ld4(g + i * 256 + lane * 4); bb[i] = ld4(bt + i * 256 + lane * 4); }
    float4 na[4], nr[4];
    { const int r = gw < nrows ? gw : 0; const float* x = src + (size_t)r * 1024; const float* xr = (r < ncx) ? (res_cx + (size_t)r * 1024) : (res_lat + (size_t)(r - ncx) * 1024);
#pragma unroll
      for (int i = 0; i < 4; ++i) { na[i] = ld4(x + i * 256 + lane * 4); nr[i] = ld4(xr + i * 256 + lane * 4); } }
    for (int r = gw; r < nrows; r += ngw) {
        float4 v[4];
        float sum = 0.f;
#pragma unroll
        for (int i = 0; i < 4; ++i) { const float4 a = na[i], rr = nr[i];
            v[i] = make_float4(ALPHA * rr.x + a.x, ALPHA * rr.y + a.y, ALPHA * rr.z + a.z, ALPHA * rr.w + a.w); sum += v[i].x + v[i].y + v[i].z + v[i].w; }
        { const int rn = (r + ngw < nrows) ? r + ngw : r; const float* x = src + (size_t)rn * 1024; const float* xr = (rn < ncx) ? (res_cx + (size_t)rn * 1024) : (res_lat + (size_t)(rn - ncx) * 1024);
#pragma unroll
          for (int i = 0; i < 4; ++i) { na[i] = ld4(x + i * 256 + lane * 4); nr[i] = ld4(xr + i * 256 + lane * 4); } }
        const float mean = wave_sum(sum) * (1.f / 1024.f);
        float sq = 0.f;
#pragma unroll
        for (int i = 0; i < 4; ++i) {
            v[i].x -= mean; v[i].y -= mean; v[i].z -= mean; v[i].w -= mean;
            sq += v[i].x * v[i].x + v[i].y * v[i].y + v[i].z * v[i].z + v[i].w * v[i].w;
        }
        const float rstd = rsqrtf(wave_sum(sq) * (1.f / 1024.f) + 1e-5f);
        float* d = (r < ncx) ? (dst_cx + (size_t)r * 1024) : (dst_lat + (size_t)(r - ncx) * 1024);
#pragma unroll
        for (int i = 0; i < 4; ++i) {
            const int c = i * 256 + lane * 4;
            const float4 y = make_float4(v[i].x * rstd * gg[i].x + bb[i].x, v[i].y * rstd * gg[i].y + bb[i].y, v[i].z * rstd * gg[i].z + bb[i].z, v[i].w * rstd * gg[i].w + bb[i].w);
            st4(d + c, y);
            if (hb != nullptr) {
                const float* m = (r < ncx) ? mvc : mvl;
                const float4 sh = ld4(m + c), sc = ld4(m + 1024 + c);
                *(uint2*)(hb + (size_t)r * 1024 + c) = make_uint2(pack2bf(y.x * (1.f + sc.x) + sh.x, y.y * (1.f + sc.y) + sh.y), pack2bf(y.z * (1.f + sc.z) + sh.z, y.w * (1.f + sc.w) + sh.w));
            }
        }
    }
}
DEV void phase_h1l(const Params& p) {
    const float* modv1 = (const float*)(p.ws + OFF_MODV) + 3 * 3072;
    bf16_t* H1 = (bf16_t*)(p.ws + OFF_H1B);
    const size_t gt = (size_t)blockIdx.x * NTHR + opaque_tid(), gn = (size_t)gridDim.x * NTHR;
    const int k = (int)(gt & 127) * 8;
    const Mod8 m0 = mod8_load(modv1, k), m1 = mod8_load(modv1 + 3072, k);
    constexpr size_t NI = (size_t)NB * NL * 128;
    for (size_t i0 = gt; i0 < NI; i0 += 4 * gn) {
        float4 xa[4], xb[4];
#pragma unroll
        for (int u = 0; u < 4; ++u) { const size_t i = i0 + u * gn, r = (i < NI ? i : gt) >> 7; xa[u] = ld4(p.out + r * DM + k); xb[u] = ld4(p.out + r * DM + k + 4); }
#pragma unroll
        for (int u = 0; u < 4; ++u) { const size_t i = i0 + u * gn, r = i >> 7; if (i < NI) *(uint4*)(H1 + r * DM + k) = mod8_apply(xa[u], xb[u], (r >= (size_t)NL) ? m1 : m0); }
    }
}

DEV void zero_f4(float* ptr, size_t nfloat) {
    const size_t n4 = nfloat / 4;
    for (size_t i = (size_t)blockIdx.x * NTHR + opaque_tid(); i < n4; i += (size_t)gridDim.x * NTHR) ((float4*)ptr)[i] = make_float4(0.f, 0.f, 0.f, 0.f);
}

DEV void chain_ids(int& chain, int& sub) {
    const int bid = blockIdx.x, xcd = bid & 7, idx = bid >> 3;
    chain = xcd * 2 + (idx >> 4); sub = idx & 15;
}

DEV void phase_conv1(const Params& p, float* sm) {
    const bf16_t* XM = (const bf16_t*)(p.ws + OFF_XM);
    bf16_t* XC = (bf16_t*)(p.ws + OFF_XC);
    float* G16P = (float*)(p.ws + OFF_G16P);
    const bf16_t* WFT = (const bf16_t*)(p.ws + OFF_WFT);
    const float* cw = p.in[31]; const float* cbias = p.in[32];
    bf16_t* imgC = (bf16_t*)sm;
    bf16_t* imgM = imgC + 64 * 264;
    float* red = (float*)(imgM + 64 * 264);
    float* cwl = red + 1024;
    const int tid = opaque_tid(), lane = tid & 63, wave = tid >> 6, t = tid >> 3, cg = tid & 7;
    for (int u = blockIdx.x; u < NB * NCH * 4; u += gridDim.x) {
        const int ci = u >> 2, q = u & 3, b = ci / NCH, c = ci % NCH, s = c * 64 + t;
        const size_t rowbase = (size_t)b * TB;
        int nrow[9]; unsigned vmask = 0u;
#pragma unroll
        for (int i = 0; i < 3; ++i)
#pragma unroll
            for (int j = 0; j < 3; ++j) {
                int ns = -1;
                if (s < NCX) { const int w2 = s + j - 1; if (i == 1 && w2 >= 0 && w2 < NCX) ns = w2; }
                else { const int n = s - NCX, rr = (n >> 6) + i - 1, w2 = (n & 63) + j - 1; if (rr >= 0 && rr < 128 && w2 >= 0 && w2 < 64) ns = NCX + rr * 64 + w2; }
                nrow[i * 3 + j] = ns >= 0 ? ns : s; vmask |= (ns >= 0 ? 1u : 0u) << (i * 3 + j);
            }
        const int tt = wave & 3, part = wave >> 2;
        f32x4 acc = (f32x4){0.f, 0.f, 0.f, 0.f};
        uint4 xn[9];
#pragma unroll
        for (int tap = 0; tap < 9; ++tap) xn[tap] = *(const uint4*)(XM + (rowbase + nrow[tap]) * 2048 + q * 512 + cg * 8);
#pragma unroll 1
        for (int half = 0; half < 2; ++half) {
            __syncthreads();
            for (int i = tid; i < 640; i += NTHR) { const int tp = i >> 6, c4 = (i & 63) * 4; st4(cwl + tp * 256 + c4, ld4((tp < 9 ? cw + tp * 2048 : cbias) + q * 512 + half * 256 + c4)); }
            __syncthreads();
#pragma unroll 1
            for (int it = 0; it < 4; ++it) {
                const int cl = it * 64 + cg * 8, c0 = q * 512 + half * 256 + cl;
                uint4 xc9[9];
#pragma unroll
                for (int tap = 0; tap < 9; ++tap) xc9[tap] = xn[tap];
                { const int gn = half * 4 + it + 1, c0n = q * 512 + (gn < 8 ? gn : 7) * 64 + cg * 8;
#pragma unroll
                  for (int tap = 0; tap < 9; ++tap) xn[tap] = *(const uint4*)(XM + (rowbase + nrow[tap]) * 2048 + c0n); }
                float a8[8];
                { const float4 b0 = ld4(cwl + 9 * 256 + cl), b1 = ld4(cwl + 9 * 256 + cl + 4); a8[0] = b0.x; a8[1] = b0.y; a8[2] = b0.z; a8[3] = b0.w; a8[4] = b1.x; a8[5] = b1.y; a8[6] = b1.z; a8[7] = b1.w; }
#pragma unroll
                for (int tap = 0; tap < 9; ++tap) {
                    const unsigned mk = ((vmask >> tap) & 1u) ? 0xffffffffu : 0u;
                    const uint4 xv = make_uint4(xc9[tap].x & mk, xc9[tap].y & mk, xc9[tap].z & mk, xc9[tap].w & mk);
                    float x8[8]; unpack8(xv, x8);
                    const float4 w0 = ld4(cwl + tap * 256 + cl), w1 = ld4(cwl + tap * 256 + cl + 4);
                    a8[0] += x8[0] * w0.x; a8[1] += x8[1] * w0.y; a8[2] += x8[2] * w0.z; a8[3] += x8[3] * w0.w;
                    a8[4] += x8[4] * w1.x; a8[5] += x8[5] * w1.y; a8[6] += x8[6] * w1.z; a8[7] += x8[7] * w1.w;
                }
#pragma unroll
                for (int i = 0; i < 8; ++i) a8[i] = silu_f(a8[i]);
                const uint4 xcv = pack8(a8);
                *(uint4*)(XC + (rowbase + s) * 2048 + c0) = xcv;
                *(uint4*)(imgC + t * 264 + cl) = xcv;
                *(uint4*)(imgM + t * 264 + cl) = xc9[4];
            }
            __syncthreads();
            {
                const bf16_t* img = part ? imgM : imgC;
                const bf16_t* wrow = WFT + (size_t)(lane & 15) * 4096 + part * 2048 + q * 512 + half * 256 + (lane >> 4) * 8;
#pragma unroll
                for (int ks = 0; ks < 8; ++ks) acc = __builtin_amdgcn_mfma_f32_16x16x32_bf16(row_frag(img, 264, tt * 16, ks * 32, lane), *(const bf16x8*)(wrow + ks * 32), acc, 0, 0, 0);
            }
        }
        if (part == 1) {
#pragma unroll
            for (int r = 0; r < 4; ++r) red[(tt * 16 + (lane >> 4) * 4 + r) * 16 + (lane & 15)] = acc[r];
        }
        __syncthreads();
        if (part == 0) {
#pragma unroll
            for (int r = 0; r < 4; ++r) {
                const int tk = tt * 16 + (lane >> 4) * 4 + r;
                G16P[(((size_t)rowbase + c * 64 + tk) * 16 + (lane & 15)) * 4 + q] = acc[r] + red[tk * 16 + (lane & 15)];
            }
        }
    }
}

struct GateRaw { float4 a, f; };
DEV GateRaw gate_load(const Params& p, size_t row, int dir, int h) {
    const float* G16P = (const float*)(p.ws + OFF_G16P);
    GateRaw g; g.a = ld4(G16P + (row * 16 + dir * 8 + h) * 4); g.f = ld4(G16P + (row * 16 + dir * 8 + 4 + h) * 4);
    return g;
}
DEV void gate_fin(const GateRaw& g, float bi, float bf, float& gi, float& lf) {
    gi = (g.a.x + g.a.y) + (g.a.z + g.a.w) + bi;
    lf = logsig_f((g.f.x + g.f.y) + (g.f.z + g.f.w) + bf);
}
DEV void gate_pair(const Params& p, size_t row, int dir, int h, float& gi, float& lf) {
    const GateRaw g = gate_load(p, row, dir, h);
    gate_fin(g, p.in[dir ? 41 : 37][h], p.in[dir ? 43 : 39][h], gi, lf);
}

DEV void phase_x1(const Params& p, float* sm) {
    int chain, sub; chain_ids(chain, sub);
    const int b = chain >> 3, h = (chain >> 1) & 3, dir = chain & 1;
    const bf16_t* XC = (const bf16_t*)(p.ws + OFF_XC);
    float* GSC = (float*)(p.ws + OFF_GSC); float* CSC = (float*)(p.ws + OFF_CSC); float* NBUF = (float*)(p.ws + OFF_NBUF);
    const float* gtab = (const float*)(p.ws + OFF_GTAB);
    bf16_t* SMAT = (bf16_t*)(p.ws + OFF_SMAT);
    const int tid = opaque_tid(), lane = tid & 63, wave = tid >> 6;
    float* sTot = sm; float* sRef = sm + 132; float* sM0 = sm + 264; float* sBeta = sm + 400;
    const float bias_i = p.in[dir ? 41 : 37][h], bias_f = p.in[dir ? 43 : 39][h];
    {
        GateRaw gn = gate_load(p, (size_t)b * TB + wave * 64 + lane, dir, h);
        for (int c = wave; c < NCH; c += NWV) {
            const GateRaw gc = gn;
            const int cn = (c + NWV < NCH) ? c + NWV : c;
            gn = gate_load(p, (size_t)b * TB + cn * 64 + lane, dir, h);
            float gi, lf; gate_fin(gc, bias_i, bias_f, gi, lf);
            const float bc = wave_scan_add(lf, lane, dir);
            const float ref = wave_max(gi - bc), tot = wave_sum(lf);
            if (lane == 0) { sTot[c] = tot; sRef[c] = ref; }
        }
    }
    __syncthreads();
    if (tid == 0) {
        float m0 = -INFINITY;
        for (int step = 0; step < NCH; ++step) {
            const int c = chunk_at(dir, step);
            sM0[c] = m0;
            const float mx = fmaxf(m0, sRef[c]);
            if (sub == 0) { CSC[(chain * NCH + c) * 2] = fexp(m0 - mx); CSC[(chain * NCH + c) * 2 + 1] = fexp(sRef[c] - mx); }
            m0 = sTot[c] + mx;
        }
    }
    __syncthreads();
    for (int k = wave; sub + 16 * k < NCH; k += NWV) {
        const int c = sub + 16 * k;
        const size_t row = (size_t)b * TB + c * 64 + lane;
        float gi, lf; gate_fin(gate_load(p, row, dir, h), bias_i, bias_f, gi, lf);
        const float bc = wave_scan_add(lf, lane, dir);
        const float a = gi - bc;
        const float amax = wave_scan_max(a, lane, dir);
        const float ref = sRef[c], m0 = sM0[c];
        const float mmax = fmaxf(amax, m0);
        const float mt = bc + mmax;
        const float alpha = fexp(ref - mmax), beta = fexp(a - ref), gg = fexp(m0 - mmax), em = fexp(-mt);
        st4(GSC + ((size_t)chain * TB + c * 64 + lane) * 4, make_float4(alpha, beta, gg, em));
        sBeta[k * 64 + lane] = beta;
    }
    __syncthreads();
    {
        float* part = sm + 1024;
        const int sg = tid >> 6, j8 = (tid & 63) * 8;
        uint4 xn[8];
        { const bf16_t* xp = XC + ((size_t)b * TB + sub * 64 + sg * 8) * 2048 + h * 512 + j8;
#pragma unroll
          for (int s = 0; s < 8; ++s) xn[s] = *(const uint4*)(xp + (size_t)s * 2048); }
        for (int k = 0; sub + 16 * k < NCH; ++k) {
            const int c = sub + 16 * k;
            uint4 xcur[8];
#pragma unroll
            for (int s = 0; s < 8; ++s) xcur[s] = xn[s];
            { const int cn = (c + 16 < NCH) ? c + 16 : c; const bf16_t* xp = XC + ((size_t)b * TB + cn * 64 + sg * 8) * 2048 + h * 512 + j8;
#pragma unroll
              for (int s = 0; s < 8; ++s) xn[s] = *(const uint4*)(xp + (size_t)s * 2048); }
            float acc[8];
#pragma unroll
            for (int i = 0; i < 8; ++i) acc[i] = 0.f;
#pragma unroll
            for (int s = 0; s < 8; ++s) {
                float f[8]; unpack8(xcur[s], f);
                const float be = sBeta[k * 64 + sg * 8 + s];
#pragma unroll
                for (int i = 0; i < 8; ++i) acc[i] += be * f[i];
            }
            __syncthreads();
            st4(part + sg * 512 + j8, make_float4(acc[0], acc[1], acc[2], acc[3])); st4(part + sg * 512 + j8 + 4, make_float4(acc[4], acc[5], acc[6], acc[7]));
            __syncthreads();
            float tot = 0.f;
#pragma unroll
            for (int q = 0; q < 8; ++q) tot += part[q * 512 + tid];
            NBUF[((size_t)chain * NCH + c) * 512 + tid] = tot;
        }
    }
    bf16_t* XCs = (bf16_t*)sm;
    bf16_t* Qs = XCs + 64 * 520;
    for (int u = blockIdx.x; u < NB * 4 * NCH; u += gridDim.x) {
        const int bh = u / NCH, c = u % NCH, ub = bh >> 2, uh = bh & 3;
        __syncthreads();
        float4 gq[2][4];
#pragma unroll
        for (int bb = 0; bb < 2; ++bb) { const float* G = gtab + (size_t)(uh * 128 + (tid & 63) * 2 + bb) * 16; gq[bb][0] = ld4(G); gq[bb][1] = ld4(G + 4); gq[bb][2] = ld4(G + 8); gq[bb][3] = ld4(G + 12); }
        uint4 xr[8];
#pragma unroll
        for (int i = 0; i < 8; ++i) { const int pp = tid + 512 * i, row = pp >> 6, c16 = pp & 63; xr[i] = *(const uint4*)(XC + ((size_t)ub * TB + c * 64 + row) * 2048 + uh * 512 + c16 * 8); }
#pragma unroll
        for (int i = 0; i < 8; ++i) {
            const int pp = tid + 512 * i, row = pp >> 6, c16 = pp & 63;
            const uint4 xv = xr[i];
            float f[8]; unpack8(xv, f);
            float q[8];
#pragma unroll
            for (int bb = 0; bb < 2; ++bb) {
                const float4 g0 = gq[bb][0], g1 = gq[bb][1], g2 = gq[bb][2], g3 = gq[bb][3];
                q[bb * 4 + 0] = f[bb * 4] * g0.x + f[bb * 4 + 1] * g1.x + f[bb * 4 + 2] * g2.x + f[bb * 4 + 3] * g3.x;
                q[bb * 4 + 1] = f[bb * 4] * g0.y + f[bb * 4 + 1] * g1.y + f[bb * 4 + 2] * g2.y + f[bb * 4 + 3] * g3.y;
                q[bb * 4 + 2] = f[bb * 4] * g0.z + f[bb * 4 + 1] * g1.z + f[bb * 4 + 2] * g2.z + f[bb * 4 + 3] * g3.z;
                q[bb * 4 + 3] = f[bb * 4] * g0.w + f[bb * 4 + 1] * g1.w + f[bb * 4 + 2] * g2.w + f[bb * 4 + 3] * g3.w;
            }
            *(uint4*)(XCs + row * 520 + c16 * 8) = xv;
            *(uint4*)(Qs + row * 520 + c16 * 8) = make_uint4(pack2bf(q[0], q[1]), pack2bf(q[2], q[3]), pack2bf(q[4], q[5]), pack2bf(q[6], q[7]));
        }
        __syncthreads();
        const int st = wave & 3, tt0 = (wave >> 2) * 2;
        f32x4 a0 = (f32x4){0.f, 0.f, 0.f, 0.f}, a1 = a0;
        const bf16_t* ap = XCs + (st * 16 + (lane & 15)) * 520 + (lane >> 4) * 8;
        const bf16_t* bp0 = Qs + (tt0 * 16 + (lane & 15)) * 520 + (lane >> 4) * 8;
        const bf16_t* bp1 = bp0 + 16 * 520;
#pragma unroll
        for (int ks = 0; ks < 16; ++ks) {
            const bf16x8 af = *(const bf16x8*)(ap + ks * 32);
            a0 = __builtin_amdgcn_mfma_f32_16x16x32_bf16(af, *(const bf16x8*)(bp0 + ks * 32), a0, 0, 0, 0);
            a1 = __builtin_amdgcn_mfma_f32_16x16x32_bf16(af, *(const bf16x8*)(bp1 + ks * 32), a1, 0, 0, 0);
        }
        bf16_t* sp = SMAT + (size_t)u * 4096 + (size_t)(tt0 * 16 + (lane & 15)) * 64 + st * 16 + (lane >> 4) * 4;
        *(uint2*)sp = make_uint2(pack2bf(a0[0], a0[1]), pack2bf(a0[2], a0[3]));
        *(uint2*)(sp + 16 * 64) = make_uint2(pack2bf(a1[0], a1[1]), pack2bf(a1[2], a1[3]));
    }
}

DEV void phase_x2(const Params& p, float* sm) {
    int chain, sub; chain_ids(chain, sub);
    const int b = chain >> 3, h = (chain >> 1) & 3, dir = chain & 1;
    const bf16_t* XC = (const bf16_t*)(p.ws + OFF_XC);
    float* GSC = (float*)(p.ws + OFF_GSC); const float* CSC = (const float*)(p.ws + OFF_CSC); const float* NBUF = (const float*)(p.ws + OFF_NBUF);
    const float* gtab = (const float*)(p.ws + OFF_GTAB);
    const bf16_t* SMAT = (const bf16_t*)(p.ws + OFF_SMAT);
    const int tid = opaque_tid();
    float* sD0 = sm; float* sCf = sm + 132; float* sN0 = sm + 264; float* sN2 = sN0 + 9 * 512;
    for (int i = tid; i < NCH; i += NTHR) { sD0[i] = CSC[(chain * NCH + i) * 2]; sCf[i] = CSC[(chain * NCH + i) * 2 + 1]; }
    __syncthreads();
    float* sBeta = sN2 + 9 * 512;
    for (int i = tid; i < 9 * 64; i += NTHR) { const int k = i >> 6, c = sub + 16 * k; if (c < NCH) sBeta[i] = GSC[((size_t)chain * TB + c * 64 + (i & 63)) * 4 + 1]; }
    if (tid < 128) {
        constexpr int NBT = 12;
        float4 n = make_float4(0.f, 0.f, 0.f, 0.f), nx[NBT];
        const float* nb = NBUF + (size_t)chain * NCH * 512 + tid * 4;
#pragma unroll
        for (int j = 0; j < NBT; ++j) nx[j] = ld4(nb + (size_t)chunk_at(dir, j) * 512);
#pragma unroll 1
        for (int step0 = 0; step0 < NCH; step0 += NBT) {
            float4 cu[NBT];
#pragma unroll
            for (int j = 0; j < NBT; ++j) cu[j] = nx[j];
#pragma unroll
            for (int j = 0; j < NBT; ++j) { const int sn = step0 + NBT + j; nx[j] = ld4(nb + (size_t)chunk_at(dir, sn < NCH ? sn : NCH - 1) * 512); }
            __builtin_amdgcn_sched_barrier(0);
#pragma unroll
            for (int j = 0; j < NBT; ++j) {
                const int c = chunk_at(dir, step0 + j);
                if ((c & 15) == sub) st4(sN0 + (c >> 4) * 512 + tid * 4, n);
                const float d = sD0[c], cf = sCf[c];
                n = make_float4(d * n.x + cf * cu[j].x, d * n.y + cf * cu[j].y, d * n.z + cf * cu[j].z, d * n.w + cf * cu[j].w);
            }
        }
    }
    __syncthreads();
    {
        const int blk = tid >> 2, cp = tid & 3;
        const float4 g = ld4(gtab + (size_t)(h * 128 + blk) * 16 + cp * 4);
        for (int k = 0; sub + 16 * k < NCH; ++k) {
            const float* n0 = sN0 + k * 512 + blk * 4;
            sN2[k * 512 + tid] = g.x * n0[0] + g.y * n0[1] + g.z * n0[2] + g.w * n0[3];
        }
    }
    __syncthreads();
    const int t = tid >> 3, part = tid & 7;
    for (int k = 0; sub + 16 * k < NCH; ++k) {
        const int c = sub + 16 * k;
        const size_t row = (size_t)b * TB + c * 64 + t;
        float dint = 0.f;
        {
            const bf16_t* xp = XC + row * 2048 + h * 512 + part * 64;
            const float* n2 = sN2 + k * 512 + part * 64;
#pragma unroll
            for (int i = 0; i < 8; ++i) {
                float f[8]; unpack8(*(const uint4*)(xp + i * 8), f);
                const float4 na = ld4(n2 + i * 8), nb2 = ld4(n2 + i * 8 + 4);
                dint += f[0] * na.x + f[1] * na.y + f[2] * na.z + f[3] * na.w + f[4] * nb2.x + f[5] * nb2.y + f[6] * nb2.z + f[7] * nb2.w;
            }
        }
        float di = 0.f;
        {
            float f[8]; unpack8(*(const uint4*)(SMAT + ((size_t)((b * 4 + h) * NCH + c)) * 4096 + t * 64 + part * 8), f);
#pragma unroll
            for (int e = 0; e < 8; ++e) {
                const int s = part * 8 + e;
                const float beta = sBeta[k * 64 + s];
                const bool keep = dir ? (s >= t) : (s <= t);
                di += keep ? f[e] * beta : 0.f;
            }
        }
        dint += __shfl_xor(dint, 1, 64); dint += __shfl_xor(dint, 2, 64); dint += __shfl_xor(dint, 4, 64);
        di += __shfl_xor(di, 1, 64); di += __shfl_xor(di, 2, 64); di += __shfl_xor(di, 4, 64);
        if (part == 0) {
            float* gp = GSC + ((size_t)chain * TB + c * 64 + t) * 4;
            const float4 g4 = ld4(gp);
            const float den = g4.x * di + g4.z * dint;
            gp[3] = 1.f / fmaxf(fabsf(den), g4.w);
        }
    }
}

#define MLSTM_PREFETCH(step_) do { \
    const int c_ = chunk_at(dir, (step_)); const size_t rb_ = (size_t)b * TB + (size_t)c_ * 64; \
    { const bf16_t* xb_ = XC + (rb_ + (tid >> 6)) * 2048 + h * 512 + (tid & 63) * 8; \
      rx0 = *(const uint4*)(xb_); rx1 = *(const uint4*)(xb_ + 8 * 2048); rx2 = *(const uint4*)(xb_ + 16 * 2048); rx3 = *(const uint4*)(xb_ + 24 * 2048); \
      rx4 = *(const uint4*)(xb_ + 32 * 2048); rx5 = *(const uint4*)(xb_ + 40 * 2048); rx6 = *(const uint4*)(xb_ + 48 * 2048); rx7 = *(const uint4*)(xb_ + 56 * 2048); } \
    rxm = *(const uint2*)(XM + (rb_ + ps) * 2048 + ch0 + pvb * 4); \
    rs = *(const uint4*)(SMAT + ((size_t)((b * 4 + h) * NCH + c_)) * 4096 + ps * 64 + pvb * 8); \
    rbeta = GSC[((size_t)chain * TB + c_ * 64 + ps) * 4 + 1]; \
    if (tid < 64) rsc = ld4(GSC + ((size_t)chain * TB + c_ * 64 + tid) * 4); \
    rd0 = CSC[(chain * NCH + c_) * 2]; rcf = CSC[(chain * NCH + c_) * 2 + 1]; } while (0)

DEV void phase_mlstm(const Params& p, float* sm) {
    int chain, sub; chain_ids(chain, sub);
    const int b = chain >> 3, h = (chain >> 1) & 3, dir = chain & 1;
    const bf16_t* XM = (const bf16_t*)(p.ws + OFF_XM);
    const bf16_t* XC = (const bf16_t*)(p.ws + OFF_XC);
    const bf16_t* SMAT = (const bf16_t*)(p.ws + OFF_SMAT);
    const float* GSC = (const float*)(p.ws + OFF_GSC); const float* CSC = (const float*)(p.ws + OFF_CSC);
    const float* gtab = (const float*)(p.ws + OFF_GTAB);
    bf16_t* H = (bf16_t*)(p.ws + OFF_H);
    const float* wv = p.in[35];
    char* smc = (char*)sm;
    bf16_t* XCs = (bf16_t*)smc;
    bf16_t* Cs = (bf16_t*)(smc + 66560);
    bf16_t* Vb = (bf16_t*)(smc + 66560 + 33280);
    bf16_t* Vw = Vb + 32 * 72;
    bf16_t* Sm = Vw + 32 * 72;
    float* Gs = (float*)(smc + 66560 + 33280 + 2 * 4608 + 9216);
    float* sc = Gs + 2048;
    const int tid = opaque_tid(), lane = tid & 63, wave = tid >> 6;
    for (int i = tid; i < 32 * 520 / 2; i += NTHR) ((unsigned*)Cs)[i] = 0u;
    for (int i = tid; i < 2048; i += NTHR) Gs[i] = gtab[h * 2048 + i];
    const int ps = tid >> 3, pvb = tid & 7;
    const int ch0 = h * 512 + sub * 32;
    float wvr[16];
#pragma unroll
    for (int i = 0; i < 16; ++i) wvr[i] = wv[(size_t)((ch0 >> 2) + pvb) * 16 + i];
    f32x4 accS[4][2];
#pragma unroll
    for (int i = 0; i < 4; ++i) { accS[i][0] = (f32x4){0.f, 0.f, 0.f, 0.f}; accS[i][1] = (f32x4){0.f, 0.f, 0.f, 0.f}; }
    uint4 rx0, rx1, rx2, rx3, rx4, rx5, rx6, rx7; uint2 rxm; uint4 rs; float rbeta; float4 rsc = make_float4(0.f, 0.f, 0.f, 0.f); float rd0, rcf;
    MLSTM_PREFETCH(0);
    __syncthreads();
#pragma unroll 1
    for (int step = 0; step < NCH; ++step) {
        const int c = chunk_at(dir, step);
        const float d0 = rd0, cf = rcf;
        {
            bf16_t* xd = XCs + (tid >> 6) * 520 + (tid & 63) * 8;
            *(uint4*)(xd) = rx0; *(uint4*)(xd + 8 * 520) = rx1; *(uint4*)(xd + 16 * 520) = rx2; *(uint4*)(xd + 24 * 520) = rx3;
            *(uint4*)(xd + 32 * 520) = rx4; *(uint4*)(xd + 40 * 520) = rx5; *(uint4*)(xd + 48 * 520) = rx6; *(uint4*)(xd + 56 * 520) = rx7;
        }
        {
            const float x0 = bflo(rxm.x), x1 = bfhi(rxm.x), x2 = bflo(rxm.y), x3 = bfhi(rxm.y);
#pragma unroll
            for (int d = 0; d < 4; ++d) {
                const float v = (x0 * wvr[d] + x1 * wvr[4 + d] + x2 * wvr[8 + d] + x3 * wvr[12 + d]) * rbeta;
                Vb[(pvb * 4 + d) * 72 + ps] = __builtin_bit_cast(unsigned short, (__bf16)v);
                Vw[(pvb * 4 + d) * 72 + ps] = __builtin_bit_cast(unsigned short, (__bf16)(v * cf));
            }
        }
        {
#define SMASK(q_) (((dir ? (pvb * 8 + 2 * (q_) >= ps) : (pvb * 8 + 2 * (q_) <= ps)) ? 0x0000ffffu : 0u) | ((dir ? (pvb * 8 + 2 * (q_) + 1 >= ps) : (pvb * 8 + 2 * (q_) + 1 <= ps)) ? 0xffff0000u : 0u))
            *(uint4*)(Sm + ps * 72 + pvb * 8) = make_uint4(rs.x & SMASK(0), rs.y & SMASK(1), rs.z & SMASK(2), rs.w & SMASK(3));
#undef SMASK
        }
        if (tid < 64) st4(sc + tid * 4, rsc);
        { const int nstep = (step + 1 < NCH) ? step + 1 : step; MLSTM_PREFETCH(nstep); }
        __syncthreads();
        {
            const int vt = wave & 1, tt = wave >> 1;
            f32x4 ao = (f32x4){0.f, 0.f, 0.f, 0.f}, ai = ao, ao1 = ao, ao2 = ao, ao3 = ao;
            const bf16_t* ap = Cs + (vt * 16 + (lane & 15)) * 520 + (lane >> 4) * 8;
            const bf16_t* bp = XCs + (tt * 16 + (lane & 15)) * 520 + (lane >> 4) * 8;
#pragma unroll
            for (int ks = 0; ks < 16; ks += 4) {
                ao = __builtin_amdgcn_mfma_f32_16x16x32_bf16(*(const bf16x8*)(ap + ks * 32), *(const bf16x8*)(bp + ks * 32), ao, 0, 0, 0);
                ao1 = __builtin_amdgcn_mfma_f32_16x16x32_bf16(*(const bf16x8*)(ap + (ks + 1) * 32), *(const bf16x8*)(bp + (ks + 1) * 32), ao1, 0, 0, 0);
                ao2 = __builtin_amdgcn_mfma_f32_16x16x32_bf16(*(const bf16x8*)(ap + (ks + 2) * 32), *(const bf16x8*)(bp + (ks + 2) * 32), ao2, 0, 0, 0);
                ao3 = __builtin_amdgcn_mfma_f32_16x16x32_bf16(*(const bf16x8*)(ap + (ks + 3) * 32), *(const bf16x8*)(bp + (ks + 3) * 32), ao3, 0, 0, 0);
            }
            ao = (ao + ao1) + (ao2 + ao3);
            const bf16_t* ap2 = Vb + (vt * 16 + (lane & 15)) * 72 + (lane >> 4) * 8;
            const bf16_t* bp2 = Sm + (tt * 16 + (lane & 15)) * 72 + (lane >> 4) * 8;
#pragma unroll
            for (int ks = 0; ks < 2; ++ks) ai = __builtin_amdgcn_mfma_f32_16x16x32_bf16(*(const bf16x8*)(ap2 + ks * 32), *(const bf16x8*)(bp2 + ks * 32), ai, 0, 0, 0);
            if (c >= 4) {
                const int t = tt * 16 + (lane & 15);
                const float4 s4 = ld4(sc + t * 4);
                const float h0 = (s4.x * ai[0] + s4.z * ao[0]) * s4.w, h1 = (s4.x * ai[1] + s4.z * ao[1]) * s4.w;
                const float h2 = (s4.x * ai[2] + s4.z * ao[2]) * s4.w, h3 = (s4.x * ai[3] + s4.z * ao[3]) * s4.w;
                bf16_t* hp = H + ((size_t)b * NL + (size_t)c * 64 + t - NCX) * 2048 + ch0 + vt * 16 + (lane >> 4) * 4;
                const unsigned u0 = pack2bf(h0, h1), u1 = pack2bf(h2, h3);
                __builtin_amdgcn_global_atomic_fadd_v2bf16((__attribute__((address_space(1))) s16x2*)hp, __builtin_bit_cast(s16x2, u0));
                __builtin_amdgcn_global_atomic_fadd_v2bf16((__attribute__((address_space(1))) s16x2*)(hp + 2), __builtin_bit_cast(s16x2, u1));
            }
        }
#pragma unroll
        for (int jt = 0; jt < 4; ++jt) { accS[jt][0] *= d0; accS[jt][1] *= d0; }
#pragma unroll
        for (int ks = 0; ks < 2; ++ks) {
            const bf16x8 b0 = *(const bf16x8*)(Vw + (lane & 15) * 72 + ks * 32 + (lane >> 4) * 8);
            const bf16x8 b1 = *(const bf16x8*)(Vw + (16 + (lane & 15)) * 72 + ks * 32 + (lane >> 4) * 8);
            const int row0 = ks * 32 + (lane >> 4) * 8 + ((lane & 15) >> 2);
#pragma unroll
            for (int jt = 0; jt < 4; ++jt) {
                const int col = wave * 64 + jt * 16 + (lane & 3) * 4;
                const s16x4 lo = __builtin_amdgcn_ds_read_tr16_b64_v4i16((__attribute__((address_space(3))) s16x4*)(XCs + row0 * 520 + col));
                const s16x4 hi = __builtin_amdgcn_ds_read_tr16_b64_v4i16((__attribute__((address_space(3))) s16x4*)(XCs + (row0 + 4) * 520 + col));
                const bf16x8 af = (bf16x8){lo[0], lo[1], lo[2], lo[3], hi[0], hi[1], hi[2], hi[3]};
                accS[jt][0] = __builtin_amdgcn_mfma_f32_16x16x32_bf16(af, b0, accS[jt][0], 0, 0, 0);
                accS[jt][1] = __builtin_amdgcn_mfma_f32_16x16x32_bf16(af, b1, accS[jt][1], 0, 0, 0);
            }
        }
        __syncthreads();
#pragma unroll
        for (int jt = 0; jt < 4; ++jt) {
            const int blk = wave * 16 + jt * 4 + (lane >> 4);
            const float4 g0 = ld4(Gs + blk * 16), g1 = ld4(Gs + blk * 16 + 4), g2 = ld4(Gs + blk * 16 + 8), g3 = ld4(Gs + blk * 16 + 12);
#pragma unroll
            for (int v2 = 0; v2 < 2; ++v2) {
                const f32x4 a = accS[jt][v2];
                const float o0 = g0.x * a[0] + g0.y * a[1] + g0.z * a[2] + g0.w * a[3];
                const float o1 = g1.x * a[0] + g1.y * a[1] + g1.z * a[2] + g1.w * a[3];
                const float o2 = g2.x * a[0] + g2.y * a[1] + g2.z * a[2] + g2.w * a[3];
                const float o3 = g3.x * a[0] + g3.y * a[1] + g3.z * a[2] + g3.w * a[3];
                *(uint2*)(Cs + (v2 * 16 + (lane & 15)) * 520 + blk * 4) = make_uint2(pack2bf(o0, o1), pack2bf(o2, o3));
            }
        }
    }
}

DEV void phase_finish1(const Params& p) {
    bf16_t* H = (bf16_t*)(p.ws + OFF_H);
    const bf16_t* XC = (const bf16_t*)(p.ws + OFF_XC);
    const bf16_t* Z = (const bf16_t*)(p.ws + OFF_XM);
    const float* ng = p.in[44]; const float* skip = p.in[45];
    const int tid_ = opaque_tid(); const int lane = tid_ & 63, gw = blockIdx.x * NWV + (tid_ >> 6), ngw = gridDim.x * NWV;
    const int h = gw & 3, c0 = h * 512 + lane * 8;
    float gn8[8], sk8[8];
    { const float4 a0 = ld4(ng + c0), a1 = ld4(ng + c0 + 4), b0 = ld4(skip + c0), b1 = ld4(skip + c0 + 4);
      gn8[0] = a0.x; gn8[1] = a0.y; gn8[2] = a0.z; gn8[3] = a0.w; gn8[4] = a1.x; gn8[5] = a1.y; gn8[6] = a1.z; gn8[7] = a1.w;
      sk8[0] = b0.x; sk8[1] = b0.y; sk8[2] = b0.z; sk8[3] = b0.w; sk8[4] = b1.x; sk8[5] = b1.y; sk8[6] = b1.z; sk8[7] = b1.w; }
    constexpr int NIT = NB * NL * 4;
    uint4 nh[2], nx[2], nz[2];
#pragma unroll
    for (int u = 0; u < 2; ++u) { const int it = gw + u * ngw, r = (it < NIT ? it : gw) >> 2, b = r >= NL ? 1 : 0, nn = r - b * NL;
        nh[u] = *(const uint4*)(H + (size_t)r * 2048 + c0); nx[u] = *(const uint4*)(XC + ((size_t)b * TB + NCX + nn) * 2048 + c0); nz[u] = *(const uint4*)(Z + (size_t)r * 2048 + c0); }
    for (int it0 = gw; it0 < NIT; it0 += 2 * ngw) {
        uint4 ch[2], cx[2], cz[2];
#pragma unroll
        for (int u = 0; u < 2; ++u) { ch[u] = nh[u]; cx[u] = nx[u]; cz[u] = nz[u]; }
#pragma unroll
        for (int u = 0; u < 2; ++u) { const int it = it0 + (2 + u) * ngw, r = (it < NIT ? it : gw) >> 2, b = r >= NL ? 1 : 0, nn = r - b * NL;
            nh[u] = *(const uint4*)(H + (size_t)r * 2048 + c0); nx[u] = *(const uint4*)(XC + ((size_t)b * TB + NCX + nn) * 2048 + c0); nz[u] = *(const uint4*)(Z + (size_t)r * 2048 + c0); }
#pragma unroll
        for (int u = 0; u < 2; ++u) {
            const int it = it0 + u * ngw, r = it >> 2;
            float v[8]; unpack8(ch[u], v);
            float sum = 0.f;
#pragma unroll
            for (int j = 0; j < 8; ++j) sum += v[j];
            const float mean = wave_sum(sum) * (1.f / 512.f);
            float sq = 0.f;
#pragma unroll
            for (int j = 0; j < 8; ++j) { v[j] -= mean; sq += v[j] * v[j]; }
            const float rstd = rsqrtf(wave_sum(sq) * (1.f / 512.f) + 1e-5f);
            float xc[8], z[8];
            unpack8(cx[u], xc); unpack8(cz[u], z);
            float o[8];
#pragma unroll
            for (int j = 0; j < 8; ++j) o[j] = (v[j] * rstd * gn8[j] + sk8[j] * xc[j]) * silu_f(z[j]);
            if (it < NIT) *(uint4*)(H + (size_t)r * 2048 + c0) = make_uint4(pack2bf(o[0], o[1]), pack2bf(o[2], o[3]), pack2bf(o[4], o[5]), pack2bf(o[6], o[7]));
        }
    }
}

__global__ void __launch_bounds__(NTHR) fwd_kernel(Params p) {
    extern __shared__ __attribute__((aligned(16))) float sm[];
    volatile LAS unsigned* xst = (volatile LAS unsigned*)((LAS char*)sm + (LDS_BYTES - 16));
    if (threadIdx.x == 0) { xst[0] = 0u; xst[1] = 0u; }
    __syncthreads();
    const XcdBarrier xbar = xcd_barrier_post((unsigned*)(p.ws + OFF_BAR), xst);
    const int tid = opaque_tid(), lane = tid & 63, wave = tid >> 6;
    float* modv = (float*)(p.ws + OFF_MODV);
    float* X1C = (float*)(p.ws + OFF_X1C);

    phase_mod(p, sm);
    phase_tables(p);
    transpose_convert(p.in[8], 1024, EIN, 4096, (bf16_t*)(p.ws + OFF_WT0), sm);
    transpose_convert(p.in[29], 1024, 4096, 4096, (bf16_t*)(p.ws + OFF_WT1), sm);
    transpose_convert(p.in[9], 1024, 1024, 1024, (bf16_t*)(p.ws + OFF_WT2), sm);
    transpose_convert(p.in[30], 2048, 1024, 1024, (bf16_t*)(p.ws + OFF_WT3), sm);
    xcd_barrier(xbar);

#pragma unroll 1
    for (int b = 0; b < NB; ++b) {
        if (b == 0) { phase_h0(p, 0); xcd_barrier(xbar); }
        run_gemm((const bf16_t*)(p.ws + OFF_YC), (const bf16_t*)(p.ws + OFF_WT0), TB, 4096, DM, EpBf16{(bf16_t*)(p.ws + OFF_P0), EIN, EIN}, sm);
        xcd_barrier(xbar);
        {
            const int x = blockIdx.x & 7, q0 = blockIdx.x >> 3;
            R1Raw R;
            r1_consts(p, x, q0 & 1, sm);
            r1_load(p, x, q0 & 1, q0 >> 1, R);
            for (int q = q0; q < 2 * NCH; q += 32) rwkv1_unit(p, x, q & 1, q >> 1, sm, R, (q + 32 < 2 * NCH) ? ((q + 32) >> 1) : -1);
            gla_consts(p, x >> 1, sm);
            if (q0 < 8) { for (int g = 2 * q0; g < 2 * q0 + 2; ++g) gla1_unit(p, x >> 1, g & 1, (NCH / 2) * (x & 1) + (g >> 1), sm); }
            else { for (int g = 16 + (q0 - 8); g < NCH; g += 24) gla1_unit(p, x >> 1, g & 1, (NCH / 2) * (x & 1) + (g >> 1), sm); }
        }
        xcd_barrier(xbar);
        if (blockIdx.x < 128) gla2_unit(p, blockIdx.x);
        else if (blockIdx.x < 192) rwkv2_unit(p, (blockIdx.x - 128) >> 2, (blockIdx.x - 128) & 3, sm);
        xcd_barrier(xbar);
        {
            const int x = blockIdx.x & 7, j = blockIdx.x >> 3;
            gla_consts(p, x >> 1, sm);
            const int r0 = j < 2 ? 2 * j : (j < 10 ? 4 + (j - 2) * 5 : 44 + (j - 10) * 4), nr = j < 2 ? 2 : (j < 10 ? 5 : 4);
            for (int r = r0; r < r0 + nr; ++r) rwkv3_unit(p, x, r, sm);
            for (int g = j; g < NCH / 2; g += 32) gla3_unit(p, x >> 1, (NCH / 2) * (x & 1) + g, sm);
        }
        xcd_barrier(xbar);
        run_gemm((const bf16_t*)(p.ws + OFF_YC), (const bf16_t*)(p.ws + OFF_WT2), TB, DM, DM, EpRes0{(float*)(p.ws + OFF_P0), modv, b}, sm);
        xcd_barrier(xbar);
        ln_rows((const float*)(p.ws + OFF_P0), p.in[0] + (size_t)b * NL * DM, p.in[2] + (size_t)b * NCX * DM, TB, p.in[6], p.in[7], p.out + (size_t)b * NL * DM, X1C + (size_t)b * NCX * DM, NCX,
                (bf16_t*)(p.ws + OFF_H1B) + (size_t)b * TB * DM, modv + (3 + 2) * 3072, modv + (3 + b) * 3072);
        if (b == 0) phase_h0(p, 1);
        xcd_barrier(xbar);
    }

    run_gemm((const bf16_t*)(p.ws + OFF_H1B), (const bf16_t*)(p.ws + OFF_WT1), RT, 2048, DM, EpBf16{(bf16_t*)(p.ws + OFF_XM), 2048, 2048}, sm);
    zero_f4((float*)(p.ws + OFF_H), (size_t)NB * NL * 1024);
    xcd_barrier(xbar);
    phase_conv1(p, sm);
    xcd_barrier(xbar);
    phase_x1(p, sm);
    xcd_barrier(xbar);
    phase_x2(p, sm);
    xcd_barrier(xbar);
    phase_mlstm(p, sm);
    xcd_barrier(xbar);
    phase_h1l(p);
    xcd_barrier(xbar);
    run_gemm((const bf16_t*)(p.ws + OFF_H1B), (const bf16_t*)(p.ws + OFF_WT1) + (size_t)2048 * 1024, NB * NL, 2048, DM, EpBf16{(bf16_t*)(p.ws + OFF_XM), 2048, 2048}, sm);
    xcd_barrier(xbar);
    phase_finish1(p);
    xcd_barrier(xbar);
    run_gemm((const bf16_t*)(p.ws + OFF_H), (const bf16_t*)(p.ws + OFF_WT3), NB * NL, DM, 2048, EpRes1{(float*)(p.ws + OFF_XC), modv + 3 * 3072}, sm);
    xcd_barrier(xbar);
    ln_rows((const float*)(p.ws + OFF_XC), p.out, p.out, NB * NL, p.in[6] + 1024, p.in[7] + 1024, p.out, p.out, 0);
}

extern "C" void kernel_launch(void* const* d_in, const int* in_sizes, int n_in, void* d_out, int out_size, void* d_ws, size_t ws_size, hipStream_t stream) {
    static int grid_blocks = 0;
    if (grid_blocks == 0) {
        if (ws_size < WS_NEED || n_in != 46) { fprintf(stderr, "kernel_launch: bad ws_size %zu (need %zu) or n_in %d\n", ws_size, (size_t)WS_NEED, n_in); grid_blocks = -1; return; }
        int dev = 0, cus = 0, per_cu = 0;
        (void)hipGetDevice(&dev);
        (void)hipDeviceGetAttribute(&cus, hipDeviceAttributeMultiprocessorCount, dev);
        (void)hipFuncSetAttribute((const void*)fwd_kernel, hipFuncAttributeMaxDynamicSharedMemorySize, LDS_BYTES);
        (void)hipOccupancyMaxActiveBlocksPerMultiprocessor(&per_cu, (const void*)fwd_kernel, NTHR, LDS_BYTES);
        if (per_cu < 1 || cus < 256) { fprintf(stderr, "kernel_launch: occupancy query says %d blocks/CU on %d CUs; this kernel needs 256 resident workgroups\n", per_cu, cus); grid_blocks = -1; return; }
        grid_blocks = 256;
    }
    if (grid_blocks < 0) return;
    (void)hipMemsetAsync((char*)d_ws + OFF_BAR, 0, XCD_BAR_WORDS * 4, stream);
    Params p{};
    for (int i = 0; i < 46; ++i) p.in[i] = (const float*)d_in[i];
    p.out = (float*)d_out; p.ws = (char*)d_ws;
    void* args[] = {&p};
    hipError_t e = hipLaunchCooperativeKernel((const void*)fwd_kernel, dim3(grid_blocks), dim3(NTHR), args, LDS_BYTES, stream);
    if (e != hipSuccess) fprintf(stderr, "cooperative launch failed: %s (grid %d)\n", hipGetErrorString(e), grid_blocks);
}
```

```cpp
#include <hip/hip_runtime.h>
#include <cstdio>
#include <cmath>

#define DEV __device__ __forceinline__

constexpr int NB = 2, NL = 8192, DM = 1024, NCX = 256, TB = NCX + NL;
constexpr int RT = NB * TB;
constexpr int NCH = TB / 64;
constexpr int EIN = 3872, RW0 = 1568;
constexpr int NTHR = 512, NWV = 8;
constexpr float ALPHA = 1.41421356237f;
constexpr float KSCALE = 0.04419417382f;

constexpr size_t OFF_MODV = 0;
constexpr size_t OFF_X1C  = 131072;
constexpr size_t OFF_BAR  = 3145728;
constexpr size_t OFF_BIG  = 4194304;
constexpr size_t OFF_P0   = OFF_BIG;
constexpr size_t OFF_YC   = OFF_BIG + (size_t)TB * EIN * 2;
constexpr size_t OFF_GDS  = OFF_YC + (size_t)TB * 1024 * 2;
constexpr size_t OFF_GDEC = OFF_GDS + (size_t)8 * NCH * 8192 * 4;
constexpr size_t OFF_RU   = OFF_GDEC + (size_t)8 * NCH * 64 * 4;
constexpr size_t OFF_RS0  = OFF_RU + (size_t)16 * NCH * 16384 * 2;
constexpr size_t OFF_BONS = OFF_RS0 + (size_t)16 * NCH * 4096 * 2;
constexpr size_t L0_END   = OFF_BONS + (size_t)2 * TB * 8 * 4;
constexpr size_t OFF_XM   = OFF_BIG;
constexpr size_t OFF_XC   = OFF_XM + (size_t)RT * 2048 * 2;
constexpr size_t OFF_H    = OFF_XC + (size_t)RT * 2048 * 2;
constexpr size_t OFF_WT0  = OFF_H + (size_t)NB * NL * 2048 * 2;
constexpr size_t OFF_WT1  = OFF_WT0 + (size_t)4096 * 1024 * 2;
constexpr size_t OFF_WT2  = OFF_WT1 + (size_t)4096 * 1024 * 2;
constexpr size_t OFF_WT3  = OFF_WT2 + (size_t)1024 * 1024 * 2;
constexpr size_t OFF_G16  = OFF_WT3 + (size_t)1024 * 2048 * 2;
constexpr size_t OFF_SMAT = OFF_G16 + (size_t)RT * 16 * 4;
constexpr size_t OFF_GSC  = OFF_SMAT + (size_t)NB * 4 * NCH * 4096 * 2;
constexpr size_t OFF_CSC  = OFF_GSC + (size_t)16 * TB * 4 * 4;
constexpr size_t OFF_NBUF = OFF_CSC + (size_t)16 * NCH * 2 * 4;
constexpr size_t OFF_GTAB = 3407872;
constexpr size_t OFF_WFT  = OFF_GTAB + (size_t)4 * 128 * 16 * 4;
static_assert(OFF_WFT + (size_t)16 * 4096 * 2 <= OFF_BIG, "low-region tables overflow");
constexpr size_t OFF_G16P = OFF_NBUF + (size_t)16 * NCH * 512 * 4;
constexpr size_t OFF_H1B  = OFF_G16;
constexpr size_t WS_NEED  = (OFF_G16P + (size_t)4 * RT * 16 * 4 > OFF_H1B + (size_t)RT * 1024 * 2) ? OFF_G16P + (size_t)4 * RT * 16 * 4 : OFF_H1B + (size_t)RT * 1024 * 2;
static_assert(WS_NEED <= (size_t)256 * 1024 * 1024, "workspace exceeds the guaranteed 256 MiB");

static_assert(L0_END <= OFF_WT0, "layer-0 buffers overlap the weight copies");
constexpr int LDS_BYTES = 139264;

struct Params { const float* in[46]; float* out; char* ws; };
typedef unsigned short bf16_t;
typedef __attribute__((ext_vector_type(8))) short bf16x8;
typedef __attribute__((ext_vector_type(4))) short s16x4;
typedef __attribute__((ext_vector_type(2))) short s16x2;
typedef __attribute__((ext_vector_type(4))) float f32x4;
typedef __attribute__((ext_vector_type(2))) __bf16 bf2_t;
DEV unsigned pack2bf(float lo, float hi) { bf2_t v; v[0] = (__bf16)lo; v[1] = (__bf16)hi; return __builtin_bit_cast(unsigned, v); }
DEV float bflo(unsigned u) { return __uint_as_float(u << 16); }
DEV float bfhi(unsigned u) { return __uint_as_float(u & 0xffff0000u); }
DEV float bf2f(bf16_t v) { return __uint_as_float(((unsigned)v) << 16); }
DEV void unpack8(uint4 u, float* f) { f[0] = bflo(u.x); f[1] = bfhi(u.x); f[2] = bflo(u.y); f[3] = bfhi(u.y); f[4] = bflo(u.z); f[5] = bfhi(u.z); f[6] = bflo(u.w); f[7] = bfhi(u.w); }

DEV float wave_sum(float v) {
#pragma unroll
    for (int o = 32; o > 0; o >>= 1) v += __shfl_xor(v, o, 64);
    return v;
}
DEV float wave_max(float v) {
#pragma unroll
    for (int o = 32; o > 0; o >>= 1) v = fmaxf(v, __shfl_xor(v, o, 64));
    return v;
}
DEV float fexp(float x) { return __expf(x); }
DEV float frcp(float x) { return __builtin_amdgcn_rcpf(x); }
DEV float sigmoid_f(float x) { return frcp(1.f + fexp(-x)); }
DEV float silu_f(float x) { return x * frcp(1.f + fexp(-x)); }
DEV float logsig_f(float x) { return fminf(x, 0.f) - __logf(1.f + fexp(-fabsf(x))); }
DEV float tanh_f(float x) { const float e = fexp(2.f * x); return 1.f - 2.f * frcp(e + 1.f); }
DEV void lds_fence() { asm volatile("" ::: "memory"); }
DEV int opaque_tid() { int t = threadIdx.x; asm volatile("" : "+v"(t)); return t; }
DEV int scan_s(int dir, int u) { return dir == 0 ? u : (u < NCX ? (NCX - 1 - u) : (TB - 1 + NCX - u)); }
DEV int chunk_at(int dir, int step) { return dir == 0 ? step : (step < 4 ? 3 - step : (NCH + 3 - step)); }
DEV float4 ld4(const float* p) { return *(const float4*)p; }
DEV void st4(float* p, float4 v) { *(float4*)p = v; }


#define XB_TMO      128
#define XB_XCNT(j)  (256  + 64 * (j))
#define XB_XSUB(j)  (1280 + 64 * (j))
#define XB_XGEN(j)  (2304 + 64 * (j))
#define XB_TOP      3328
#define XB_TOPGEN   3392
#define XCD_BAR_WORDS 3456
#define XB_SPIN_CAP (1u << 22)
#define LAS __attribute__((address_space(3)))
DEV unsigned xb_ld(unsigned* p) { return __hip_atomic_load(p, __ATOMIC_RELAXED, __HIP_MEMORY_SCOPE_AGENT); }
DEV unsigned xb_add(unsigned* p, unsigned v) { return __hip_atomic_fetch_add(p, v, __ATOMIC_RELAXED, __HIP_MEMORY_SCOPE_AGENT); }
DEV unsigned xb_xcc_id() { return (unsigned)__builtin_amdgcn_s_getreg((3 << 11) | 20) & 0xFu; }
#define XB_SPIN(cond, bar) do { unsigned _sp = 0; while (cond) { __builtin_amdgcn_s_sleep(1); \
    if ((++_sp & 255u) == 0u) { if (xb_ld(&(bar)[XB_TMO])) break; if (_sp > XB_SPIN_CAP) { atomicAdd(&(bar)[XB_TMO], 1u); break; } } } } while (0)
struct XcdBarrier { unsigned* bar; unsigned x; volatile LAS unsigned* st; };
DEV XcdBarrier xcd_barrier_post(unsigned* bar, volatile LAS unsigned* st) {
    XcdBarrier b; b.bar = bar; b.x = xb_xcc_id(); b.st = st;
    if (threadIdx.x == 0) (void)xb_add(&bar[XB_XCNT(b.x)], 1u);
    return b;
}
DEV void xcd_barrier_complete(unsigned* bar, unsigned x, unsigned& nloc, unsigned& nx) {
    const unsigned G = gridDim.x * gridDim.y * gridDim.z;
    unsigned sum, cnt, mine, sp = 0u;
    for (;;) {
        sum = 0u; cnt = 0u; mine = 0u;
#pragma unroll
        for (unsigned j = 0; j < 16; ++j) { const unsigned c = xb_ld(&bar[XB_XCNT(j)]); sum += c; cnt += (c > 0u) ? 1u : 0u; mine = (j == x) ? c : mine; }
        if (sum == G) break;
        __builtin_amdgcn_s_sleep(1);
        if ((++sp & 255u) == 0u) { if (xb_ld(&bar[XB_TMO])) break; if (sp > XB_SPIN_CAP) { atomicAdd(&bar[XB_TMO], 1u); break; } }
    }
    nloc = mine > 0u ? mine : 1u; nx = cnt > 0u ? cnt : 1u;
}
DEV void xcd_barrier(const XcdBarrier& b) {
    asm volatile("s_waitcnt vmcnt(0)" ::: "memory");
    __syncthreads();
    if (threadIdx.x == 0) {
        unsigned* bar = b.bar;
        __builtin_amdgcn_s_waitcnt(0);
        unsigned nloc = b.st[0], nx = b.st[1];
        if (nloc == 0u) { xcd_barrier_complete(bar, b.x, nloc, nx); b.st[0] = nloc; b.st[1] = nx; }
        const unsigned old = xb_add(&bar[XB_XSUB(b.x)], 1u);
        const unsigned gen = old / nloc;
        if (old + 1u == (gen + 1u) * nloc) {
            __builtin_amdgcn_fence(__ATOMIC_RELEASE, "agent");
            asm volatile("s_waitcnt vmcnt(0)" ::: "memory");
            const unsigned og = xb_add(&bar[XB_TOP], 1u);
            const unsigned tg = og / nx;
            if (og + 1u == (tg + 1u) * nx) xb_add(&bar[XB_TOPGEN], 1u);
            else XB_SPIN(xb_ld(&bar[XB_TOPGEN]) == tg, bar);
            __builtin_amdgcn_fence(__ATOMIC_ACQUIRE, "agent");
            xb_add(&bar[XB_XGEN(b.x)], 1u);
            asm volatile("s_waitcnt vmcnt(0)" ::: "memory");
        } else {
            XB_SPIN(xb_ld(&bar[XB_XGEN(b.x)]) == gen, bar);
            __builtin_amdgcn_fence(__ATOMIC_ACQUIRE, "agent");
            asm volatile("s_waitcnt vmcnt(0)" ::: "memory");
        }
    }
    __syncthreads();
}

namespace pg8 {
#define PG8_LAS __attribute__((address_space(3)))
typedef unsigned short bf16_t;
typedef short bf16x8 __attribute__((ext_vector_type(8)));
typedef float f32x4 __attribute__((ext_vector_type(4)));
typedef unsigned u32x4 __attribute__((ext_vector_type(4)));
constexpr int BM = 256, BK = 64, HALF = 128, HTB = HALF * BK * 2  , STAGE_BYTES = 8 * HTB, NXCD = 8, WGM = 8;

__host__ __device__ __forceinline__ int lds_byte(int r, int c) { const int st = (r >> 4) * 2 + (c >> 5), rr = r & 15, cc = c & 31, ob = rr * 64 + cc * 2; return st * 1024 + (ob ^ (((ob >> 9) & 1) << 5)); }
__host__ __device__ __forceinline__ void stage_rc(int b, int& R, int& C) { const int st = b / 1024, sb = b % 1024, swz = sb ^ (((sb >> 9) & 1) << 5); R = (st >> 1) * 16 + swz / 64; C = (st & 1) * 32 + (swz % 64) / 2; }
__host__ __device__ __forceinline__ int perm32(int rho) { const int n = rho >> 4, i = rho & 15; return 8 * (i >> 2) + 4 * n + (i & 3); }

struct Unit { int pm, pn; };
struct Gemm { const bf16_t* A; const bf16_t* Bt; int M, N, K; };

struct StaticOrder {
    int nM, nN, nwg, G, c;
    __host__ __device__ void init(int M, int N, int G_, int c_) { nM = M / BM; nN = N / BM; nwg = nM * nN; G = G_; c = c_; }
    __host__ __device__ bool next(int i, Unit& u) const {
        const long L = (long)i * G + c; if (L >= nwg) return false;
        int wgid = (int)L; { const int q = nwg / NXCD, r = nwg % NXCD, xcd = wgid % NXCD, off = wgid / NXCD; wgid = (xcd < r ? xcd * (q + 1) : r * (q + 1) + (xcd - r) * q) + off; }
        const int nig = WGM * nN, gid = wgid / nig, fm = gid * WGM, gsz = (nM - fm) < WGM ? (nM - fm) : WGM;
        u.pm = fm + ((wgid % nig) % gsz); u.pn = (wgid % nig) / gsz; return true;
    }
    __device__ __forceinline__ void a_ready(const Unit&) const {}
    __device__ __forceinline__ void done(const Unit&) const {}
};

template <class Epi, class Sched, bool STAMP = false>
__device__ __forceinline__ void gemm_phase(PG8_LAS unsigned char* lds, const Gemm g, const Sched& S, const Epi& E, unsigned long long* stamps) {
    int tid = threadIdx.x; asm volatile("" : "+v"(tid));
    const int wid = __builtin_amdgcn_readfirstlane(tid >> 6), lane = tid & 63, wr = wid >> 2, wc = wid & 3, fr = lane & 15, fq = lane >> 4;
    const int K = g.K, nt = K / BK;
#define PG8_STAMP() do { } while (0)
    PG8_STAMP();
    unsigned voffA[2], voffB[2];
#pragma unroll
    for (int i = 0; i < 2; ++i) { int R, C; stage_rc(tid * 16 + i * 8192, R, C); const int Rb = Epi::PERM ? ((R & ~31) + perm32(R & 31)) : R;
        voffA[i] = (unsigned)(R * K + C) * 2u; voffB[i] = (unsigned)(Rb * K + C) * 2u; }
    const size_t kstep = (size_t)(BK * 2);
    const size_t hstep = (size_t)HALF * K * 2;
    const size_t tstep = 2 * hstep;
    const unsigned ldsw = (unsigned)wid * 1024u;
    const int aoff = lds_byte(wr * 64 + fr, fq * 8), boff = lds_byte(wc * 32 + fr, fq * 8);
#define PG8_SA(b, h) (((b) * 2 + (h)) * HTB)
#define PG8_SB(b, h) ((4 + (b) * 2 + (h)) * HTB)
#define PG8_STAGE(bufoff, gbase, voff) do { _Pragma("unroll") for (int _i = 0; _i < 2; ++_i) \
        __builtin_amdgcn_global_load_lds((const unsigned*)((const char*)(gbase) + (voff)[_i]), (PG8_LAS unsigned*)(lds + (bufoff) + ldsw + _i * 8192), 16, 0, 0); } while (0)
#define PG8_LDA(dst, b, h) do { _Pragma("unroll") for (int m = 0; m < 4; ++m) _Pragma("unroll") for (int k = 0; k < 2; ++k) dst[m][k] = *(const PG8_LAS bf16x8*)(lds + PG8_SA(b, h) + aoff + m * 2048 + k * 1024); } while (0)
#define PG8_LDB(dst, b, h) do { _Pragma("unroll") for (int n = 0; n < 2; ++n) _Pragma("unroll") for (int k = 0; k < 2; ++k) dst[n][k] = *(const PG8_LAS bf16x8*)(lds + PG8_SB(b, h) + boff + n * 2048 + k * 1024); } while (0)
#define PG8_MMA(ai, bj, At, Bt) do { __builtin_amdgcn_s_setprio(1); _Pragma("unroll") for (int m = 0; m < 4; ++m) _Pragma("unroll") for (int n = 0; n < 2; ++n) _Pragma("unroll") for (int k = 0; k < 2; ++k) \
        acc[ai][bj][m][n] = __builtin_amdgcn_mfma_f32_16x16x32_bf16(Bt[n][k], At[m][k], acc[ai][bj][m][n], 0, 0, 0); __builtin_amdgcn_s_setprio(0); } while (0)
#define PG8_WAIT_V(n) asm volatile("s_waitcnt vmcnt(" #n ")" ::: "memory")
#define PG8_WAIT_L(n) asm volatile("s_waitcnt lgkmcnt(" #n ")" ::: "memory")
#define PG8_BAR __builtin_amdgcn_s_barrier()
#define PG8_SCHED __builtin_amdgcn_sched_barrier(0)
    Unit cur, nxt; int ui = 0;
    if (!S.next(0, cur)) return;
    f32x4 acc[2][2][4][2];
#pragma unroll
    for (int a = 0; a < 2; ++a)
#pragma unroll
        for (int b = 0; b < 2; ++b)
#pragma unroll
            for (int m = 0; m < 4; ++m)
#pragma unroll
                for (int n = 0; n < 2; ++n) acc[a][b][m][n] = (f32x4){0.f, 0.f, 0.f, 0.f};
    bf16x8 At[4][2], B0[2][2], B1[2][2];
    const char* cA = (const char*)g.A + (size_t)cur.pm * tstep; const char* cB = (const char*)g.Bt + (size_t)cur.pn * tstep;
    S.a_ready(cur);
    PG8_STAGE(PG8_SB(0, 0), cB, voffB); PG8_STAGE(PG8_SA(0, 0), cA, voffA); PG8_STAGE(PG8_SB(0, 1), cB + hstep, voffB); PG8_STAGE(PG8_SA(0, 1), cA + hstep, voffA);
    if (wr == 1) PG8_BAR;
    PG8_WAIT_V(4); PG8_BAR;
    PG8_STAGE(PG8_SB(1, 0), cB + kstep, voffB); PG8_STAGE(PG8_SA(1, 0), cA + kstep, voffA); PG8_STAGE(PG8_SB(1, 1), cB + hstep + kstep, voffB);
    PG8_WAIT_V(6); PG8_BAR;
    PG8_STAMP();
    for (;;) {
        const bool has_next = S.next(ui + 1, nxt);
        const char* nA = has_next ? (const char*)g.A + (size_t)nxt.pm * tstep : cA; const char* nB = has_next ? (const char*)g.Bt + (size_t)nxt.pn * tstep : cB;
        for (int t = 0; t < nt; t += 2) {
            const bool last = (t == nt - 2);
            const char* a1 = cA + (size_t)(t + 1) * kstep;
            const char* a2 = last ? nA : cA + (size_t)(t + 2) * kstep; const char* b2 = last ? nB : cB + (size_t)(t + 2) * kstep;
            const char* a3 = a2 + kstep; const char* b3 = b2 + kstep;
            if (last && has_next) S.a_ready(nxt);
            PG8_LDB(B0, 0, 0); PG8_SCHED; PG8_LDA(At, 0, 0); PG8_STAGE(PG8_SA(1, 1), a1 + hstep, voffA);
            PG8_WAIT_L(8); PG8_BAR; PG8_WAIT_L(0); PG8_MMA(0, 0, At, B0); PG8_BAR; PG8_SCHED;
            PG8_LDB(B1, 0, 1); PG8_STAGE(PG8_SB(0, 0), b2, voffB);
            PG8_BAR; PG8_WAIT_L(0); PG8_MMA(0, 1, At, B1); PG8_BAR;
            PG8_LDA(At, 0, 1); PG8_STAGE(PG8_SA(0, 0), a2, voffA);
            PG8_BAR; PG8_WAIT_L(0); PG8_MMA(1, 0, At, B0); PG8_BAR; PG8_SCHED;
            PG8_STAGE(PG8_SB(0, 1), b2 + hstep, voffB);
            PG8_WAIT_V(6); PG8_BAR; PG8_MMA(1, 1, At, B1); PG8_BAR;
            PG8_LDB(B0, 1, 0); PG8_SCHED; PG8_LDA(At, 1, 0); PG8_STAGE(PG8_SA(0, 1), a2 + hstep, voffA);
            PG8_WAIT_L(8); PG8_BAR; PG8_WAIT_L(0); PG8_MMA(0, 0, At, B0); PG8_BAR; PG8_SCHED;
            PG8_LDB(B1, 1, 1); PG8_STAGE(PG8_SB(1, 0), b3, voffB);
            PG8_BAR; PG8_WAIT_L(0); PG8_MMA(0, 1, At, B1); PG8_BAR;
            PG8_LDA(At, 1, 1); PG8_STAGE(PG8_SA(1, 0), a3, voffA);
            PG8_BAR; PG8_WAIT_L(0); PG8_MMA(1, 0, At, B0); PG8_BAR; PG8_SCHED;
            PG8_STAGE(PG8_SB(1, 1), b3 + hstep, voffB);
            PG8_WAIT_V(6); PG8_BAR; PG8_MMA(1, 1, At, B1); PG8_BAR;
        }
        PG8_STAMP();
        if constexpr (!Epi::AFTER_DRAIN) { E(acc, cur, wr, wc, fr, fq); S.done(cur); }
        PG8_STAMP();
        if (!has_next) break;
#pragma unroll
        for (int a = 0; a < 2; ++a)
#pragma unroll
            for (int b = 0; b < 2; ++b)
#pragma unroll
                for (int m = 0; m < 4; ++m)
#pragma unroll
                    for (int n = 0; n < 2; ++n) acc[a][b][m][n] = (f32x4){0.f, 0.f, 0.f, 0.f};
        cur = nxt; cA = nA; cB = nB; ++ui;
    }
    PG8_WAIT_V(0);
    if (wr == 0) PG8_BAR;
    PG8_BAR;
    if constexpr (Epi::AFTER_DRAIN) { E.fused(acc, cur, wr, wc, fr, fq, lds, wid, lane); S.done(cur); }
    PG8_STAMP();
#undef PG8_STAMP
#undef PG8_SA
#undef PG8_SB
#undef PG8_STAGE
#undef PG8_LDA
#undef PG8_LDB
#undef PG8_MMA
#undef PG8_WAIT_V
#undef PG8_WAIT_L
#undef PG8_BAR
#undef PG8_SCHED
}
}

DEV void transpose_convert(const float* __restrict__ W, int K, int N, int Npad, bf16_t* Wt, float* sm) {
    float (*T)[65] = (float (*)[65])sm;
    const int tid = opaque_tid();
    const int kt = K / 64, ntl = Npad / 64;
    for (int tile = blockIdx.x; tile < kt * ntl; tile += gridDim.x) {
        const int k0 = (tile / ntl) * 64, n0 = (tile % ntl) * 64;
        __syncthreads();
#pragma unroll
        for (int i = 0; i < 2; ++i) {
            const int k = (tid >> 4) + 32 * i, n4 = (tid & 15) * 4;
            float4 v = make_float4(0.f, 0.f, 0.f, 0.f);
            if (n0 + n4 < N) v = ld4(W + (size_t)(k0 + k) * N + n0 + n4);
            T[k][n4] = v.x; T[k][n4 + 1] = v.y; T[k][n4 + 2] = v.z; T[k][n4 + 3] = v.w;
        }
        __syncthreads();
        const int n = tid >> 3, kq = (tid & 7) * 8;
        unsigned o[4];
#pragma unroll
        for (int j = 0; j < 4; ++j) o[j] = pack2bf(T[kq + 2 * j][n], T[kq + 2 * j + 1][n]);
        bf16_t* dst = Wt + (size_t)(n0 + n) * K + k0 + kq;
        *(uint4*)dst = make_uint4(o[0], o[1], o[2], o[3]);
    }
}

struct EpBf16 {
    static constexpr bool PERM = true, AFTER_DRAIN = false;
    bf16_t* O; int ldc; int ncols;
    DEV void operator()(const pg8::f32x4 (&acc)[2][2][4][2], const pg8::Unit& u, int wr, int wc, int fr, int fq) const {
        const int row0 = u.pm * 256 + wr * 64 + fr, col0 = u.pn * 256 + wc * 32 + 8 * fq;
#pragma unroll
        for (int ai = 0; ai < 2; ++ai)
#pragma unroll
            for (int m = 0; m < 4; ++m) {
                bf16_t* rowp = O + (size_t)(row0 + ai * 128 + m * 16) * ldc + col0;
#pragma unroll
                for (int bj = 0; bj < 2; ++bj) {
                    if (col0 + bj * 128 < ncols) {
                        const pg8::f32x4 v0 = acc[ai][bj][m][0], v1 = acc[ai][bj][m][1];
                        *(uint4*)(rowp + bj * 128) = make_uint4(pack2bf(v0[0], v0[1]), pack2bf(v0[2], v0[3]), pack2bf(v1[0], v1[1]), pack2bf(v1[2], v1[3]));
                    }
                }
            }
    }
};
struct EpRes0 {
    static constexpr bool PERM = false, AFTER_DRAIN = false;
    float* C; const float* mv; int b;
    DEV void operator()(const pg8::f32x4 (&acc)[2][2][4][2], const pg8::Unit& u, int wr, int wc, int fr, int fq) const {
        const bool isc = (u.pm * 256 < NCX);
        const float* gp = mv + (isc ? 2 : b) * 3072 + 2048;
        const int row0 = u.pm * 256 + wr * 64 + fr, col0 = u.pn * 256 + wc * 32 + 4 * fq;
#pragma unroll
        for (int ai = 0; ai < 2; ++ai)
#pragma unroll
            for (int m = 0; m < 4; ++m) {
                const size_t ro = (size_t)(row0 + ai * 128 + m * 16) * DM + col0;
#pragma unroll
                for (int bj = 0; bj < 2; ++bj)
#pragma unroll
                    for (int n = 0; n < 2; ++n) {
                        const int co = bj * 128 + n * 16;
                        const float4 g = ld4(gp + col0 + co); const pg8::f32x4 v = acc[ai][bj][m][n];
                        st4(C + ro + co, make_float4(g.x * v[0], g.y * v[1], g.z * v[2], g.w * v[3]));
                    }
            }
    }
};
struct EpRes1 {
    static constexpr bool PERM = false, AFTER_DRAIN = false;
    float* C; const float* mv;
    DEV void operator()(const pg8::f32x4 (&acc)[2][2][4][2], const pg8::Unit& u, int wr, int wc, int fr, int fq) const {
        const float* gp = mv + (u.pm * 256 >= NL ? 1 : 0) * 3072 + 2048;
        const int row0 = u.pm * 256 + wr * 64 + fr, col0 = u.pn * 256 + wc * 32 + 4 * fq;
#pragma unroll
        for (int ai = 0; ai < 2; ++ai)
#pragma unroll
            for (int m = 0; m < 4; ++m) {
                const size_t ro = (size_t)(row0 + ai * 128 + m * 16) * DM + col0;
#pragma unroll
                for (int bj = 0; bj < 2; ++bj)
#pragma unroll
                    for (int n = 0; n < 2; ++n) {
                        const int co = bj * 128 + n * 16;
                        const float4 g = ld4(gp + col0 + co); const pg8::f32x4 v = acc[ai][bj][m][n];
                        st4(C + ro + co, make_float4(g.x * v[0], g.y * v[1], g.z * v[2], g.w * v[3]));
                    }
            }
    }
};
template <class EP>
DEV void run_gemm(const bf16_t* A, const bf16_t* Bt, int M, int N, int K, const EP& ep, float* sm) {
    pg8::Gemm g{A, Bt, M, N, K}; pg8::StaticOrder S; S.init(M, N, (int)gridDim.x, (int)blockIdx.x);
    pg8::gemm_phase<EP, pg8::StaticOrder, false>((PG8_LAS unsigned char*)sm, g, S, ep, nullptr);
}

template <int MT, int NT>
DEV void mini_gemm(const bf16_t* A, int lda, int row0, int row_clamp, const bf16_t* Bt, int ldb, int brow0, bf16_t* C, int ldc, int ccol0, int nvalid, float* sm) {
    const int tid = opaque_tid(), lane = tid & 63, wave = tid >> 6, l15 = lane & 15, g = lane >> 4;
    f32x4 acc[MT][NT];
#pragma unroll
    for (int m = 0; m < MT; ++m)
#pragma unroll
        for (int n = 0; n < NT; ++n) acc[m][n] = (f32x4){0.f, 0.f, 0.f, 0.f};
    const bf16_t* ap[MT]; const bf16_t* bp[NT];
#pragma unroll
    for (int m = 0; m < MT; ++m) { const int r = row0 + m * 16 + l15; ap[m] = A + (size_t)(r < row_clamp ? r : row_clamp) * lda + wave * 128 + g * 8; }
#pragma unroll
    for (int n = 0; n < NT; ++n) bp[n] = Bt + (size_t)(brow0 + n * 16 + l15) * ldb + wave * 128 + g * 8;
#pragma unroll
    for (int kh = 0; kh < 2; ++kh) {
        bf16x8 af[2][MT], bq[2][NT];
#pragma unroll
        for (int ks = 0; ks < 2; ++ks) {
#pragma unroll
            for (int m = 0; m < MT; ++m) af[ks][m] = *(const bf16x8*)(ap[m] + (kh * 2 + ks) * 32);
#pragma unroll
            for (int n = 0; n < NT; ++n) bq[ks][n] = *(const bf16x8*)(bp[n] + (kh * 2 + ks) * 32);
        }
#pragma unroll
        for (int ks = 0; ks < 2; ++ks)
#pragma unroll
            for (int m = 0; m < MT; ++m)
#pragma unroll
                for (int n = 0; n < NT; ++n) acc[m][n] = __builtin_amdgcn_mfma_f32_16x16x32_bf16(af[ks][m], bq[ks][n], acc[m][n], 0, 0, 0);
    }
    __syncthreads();
#pragma unroll
    for (int m = 0; m < MT; ++m)
#pragma unroll
        for (int n = 0; n < NT; ++n) st4(sm + ((wave * MT + m) * NT + n) * 256 + lane * 4, make_float4(acc[m][n][0], acc[m][n][1], acc[m][n][2], acc[m][n][3]));
    __syncthreads();
    for (int e = tid; e < MT * NT * 256; e += NTHR) {
        const int tile = e >> 8, idx = e & 255, ln = idx >> 2, r = idx & 3;
        float s = 0.f;
#pragma unroll
        for (int w = 0; w < NWV; ++w) s += sm[(w * MT * NT + tile) * 256 + idx];
        const int i = (tile / NT) * 16 + (ln >> 4) * 4 + r, j = (tile % NT) * 16 + (ln & 15);
        if (i < nvalid) C[(size_t)(row0 + i) * ldc + ccol0 + j] = __builtin_bit_cast(unsigned short, (__bf16)s);
    }
}

struct Mod8 { float4 s0, s1, c0, c1; };
DEV Mod8 mod8_load(const float* m, int k) { Mod8 q; q.s0 = ld4(m + k); q.s1 = ld4(m + k + 4); q.c0 = ld4(m + 1024 + k); q.c1 = ld4(m + 1024 + k + 4); return q; }
DEV uint4 mod8_apply(const float4 x0, const float4 x1, const Mod8& q) {
    return make_uint4(pack2bf(x0.x * (1.f + q.c0.x) + q.s0.x, x0.y * (1.f + q.c0.y) + q.s0.y), pack2bf(x0.z * (1.f + q.c0.z) + q.s0.z, x0.w * (1.f + q.c0.w) + q.s0.w),
                      pack2bf(x1.x * (1.f + q.c1.x) + q.s1.x, x1.y * (1.f + q.c1.y) + q.s1.y), pack2bf(x1.z * (1.f + q.c1.z) + q.s1.z, x1.w * (1.f + q.c1.w) + q.s1.w));
}
DEV void phase_h0(const Params& p, int b) {
    const float* modv = (const float*)(p.ws + OFF_MODV);
    bf16_t* H0 = (bf16_t*)(p.ws + OFF_YC);
    const int gt = blockIdx.x * NTHR + opaque_tid(), gn = gridDim.x * NTHR;
    const int k = (gt & 127) * 8;
    const Mod8 mc = mod8_load(modv + 2 * 3072, k), ml = mod8_load(modv + b * 3072, k);
    for (int i0 = gt; i0 < TB * 128; i0 += 4 * gn) {
        float4 xa[4], xb[4];
#pragma unroll
        for (int u = 0; u < 4; ++u) {
            const int i = i0 + u * gn, s = (i < TB * 128 ? i : gt) >> 7;
            const float* src = (s < NCX) ? p.in[2] + ((size_t)(b * NCX + s)) * DM + k : p.in[0] + ((size_t)(b * NL + s - NCX)) * DM + k;
            xa[u] = ld4(src); xb[u] = ld4(src + 4);
        }
#pragma unroll
        for (int u = 0; u < 4; ++u) {
            const int i = i0 + u * gn, s = i >> 7;
            if (i < TB * 128) *(uint4*)(H0 + (size_t)s * DM + k) = mod8_apply(xa[u], xb[u], (s < NCX) ? mc : ml);
        }
    }
}

DEV void phase_mod(const Params& p, float* sm) {
    const float* c = p.in[1]; const float* cctx = p.in[3];
    const float* mod_w = p.in[4]; const float* mod_b = p.in[5];
    float* modv = (float*)(p.ws + OFF_MODV);
    float* sil = sm; float* red = sm + 3072;
    const int tid = opaque_tid();
    for (int i = tid; i < 3072; i += NTHR) {
        const int j = i >> 10, k = i & 1023;
        const float v = (j < 2) ? c[j * 1024 + k] : cctx[k];
        sil[i] = silu_f(v);
    }
    __syncthreads();
    for (int unit = blockIdx.x; unit < 192; unit += gridDim.x) {
        const int l = unit / 96, cb = unit % 96;
        const int kg = tid >> 5, col = tid & 31, n = cb * 32 + col;
        const float* w = mod_w + (size_t)l * 1024 * 3072 + n;
        float a0 = 0.f, a1 = 0.f, a2 = 0.f;
        for (int k = kg * 64; k < kg * 64 + 64; ++k) {
            const float wv = w[(size_t)k * 3072];
            a0 += sil[k] * wv; a1 += sil[1024 + k] * wv; a2 += sil[2048 + k] * wv;
        }
        red[(kg * 3 + 0) * 32 + col] = a0; red[(kg * 3 + 1) * 32 + col] = a1; red[(kg * 3 + 2) * 32 + col] = a2;
        __syncthreads();
        if (tid < 96) {
            const int j = tid >> 5, cc = tid & 31, nn = cb * 32 + cc;
            float s = mod_b[l * 3072 + nn];
            for (int g = 0; g < 16; ++g) s += red[(g * 3 + j) * 32 + cc];
            modv[(l * 3 + j) * 3072 + nn] = s;
        }
        __syncthreads();
    }
}

DEV void phase_tables(const Params& p) {
    const float* wq = p.in[33]; const float* wk = p.in[34]; const float* wv = p.in[35];
    const float* gw0 = p.in[36]; const float* gw1 = p.in[38]; const float* gw2 = p.in[40]; const float* gw3 = p.in[42];
    float* gtab = (float*)(p.ws + OFF_GTAB); bf16_t* wft = (bf16_t*)(p.ws + OFF_WFT);
    const int gt = blockIdx.x * NTHR + opaque_tid(), gn = gridDim.x * NTHR;
    for (int i = gt; i < 512 * 16; i += gn) {
        const int gb = i >> 4, cp = (i >> 2) & 3, c = i & 3;
        float s = 0.f;
#pragma unroll
        for (int d = 0; d < 4; ++d) s += wq[gb * 16 + cp * 4 + d] * wk[gb * 16 + c * 4 + d];
        gtab[i] = s * KSCALE;
    }
    for (int i = gt; i < 4096 * 16; i += gn) {
        const int g = i >> 12, k = i & 4095, gm = g >> 2, hd = g & 3;
        const float* wg = gm == 0 ? gw0 : (gm == 1 ? gw1 : (gm == 2 ? gw2 : gw3));
        float s = 0.f;
        if (k < 2048) {
            const int blk = k >> 2, cc = k & 3;
#pragma unroll
            for (int d = 0; d < 4; ++d) s += wq[blk * 16 + cc * 4 + d] * wg[(size_t)(4 * blk + d) * 4 + hd] + wk[blk * 16 + cc * 4 + d] * wg[(size_t)(2048 + 4 * blk + d) * 4 + hd];
        } else {
            const int kk = k - 2048, blk = kk >> 2, cc = kk & 3;
#pragma unroll
            for (int d = 0; d < 4; ++d) s += wv[blk * 16 + cc * 4 + d] * wg[(size_t)(4096 + 4 * blk + d) * 4 + hd];
        }
        wft[i] = __builtin_bit_cast(unsigned short, (__bf16)s);
    }
}

DEV float wave_scan_add(float v, int lane, int dir) {
#pragma unroll
    for (int o = 1; o < 64; o <<= 1) {
        const float n = dir ? __shfl_down(v, o, 64) : __shfl_up(v, o, 64);
        const bool ok = dir ? (lane + o < 64) : (lane >= o);
        if (ok) v += n;
    }
    return v;
}
DEV float wave_scan_max(float v, int lane, int dir) {
#pragma unroll
    for (int o = 1; o < 64; o <<= 1) {
        const float n = dir ? __shfl_down(v, o, 64) : __shfl_up(v, o, 64);
        const bool ok = dir ? (lane + o < 64) : (lane >= o);
        if (ok) v = fmaxf(v, n);
    }
    return v;
}

constexpr int GLC_OFF = 30336;
static_assert((GLC_OFF + 2176) * 4 <= LDS_BYTES - 16, "GLA constants must fit below the barrier words");
DEV void gla_consts(const Params& p, int h, float* sm) {
    const int tid = opaque_tid();
    float* sWA2 = sm + GLC_OFF; float* sBA2 = sWA2 + 2048;
    __syncthreads();
    for (int i = tid; i < 2048; i += NTHR) { const int d = i >> 10, ii = (i >> 6) & 15, k = i & 63; sWA2[i] = p.in[d ? 12 : 10][ii * 256 + h * 64 + k]; }
    if (tid < 128) sBA2[tid] = p.in[(tid >> 6) ? 13 : 11][h * 64 + (tid & 63)];
}
DEV void gla_decay_core(const float* sLRd, const float* sWAd, const float* sBAd, float* sBC, float* sTot, int dir, int tid) {
    {
        const int t = tid >> 3, k0 = (tid & 7) * 8;
        float acc[8];
#pragma unroll
        for (int j = 0; j < 8; ++j) acc[j] = sBAd[k0 + j];
#pragma unroll
        for (int ii = 0; ii < 16; ++ii) {
            const float l = sLRd[t * 16 + ii];
#pragma unroll
            for (int j = 0; j < 8; ++j) acc[j] += l * sWAd[ii * 64 + k0 + j];
        }
#pragma unroll
        for (int j = 0; j < 8; ++j) sBC[t * 65 + k0 + j] = logsig_f(acc[j]) * 0.0625f;
    }
    __syncthreads();
    {
        const int lane = tid & 63, wv = tid >> 6;
#pragma unroll
        for (int j = 0; j < 8; ++j) {
            const int k = wv * 8 + j;
            const float v = wave_scan_add(sBC[lane * 65 + k], lane, dir);
            sBC[lane * 65 + k] = v;
            if (lane == (dir ? 0 : 63)) sTot[k] = v;
        }
    }
    __syncthreads();
}

DEV bf16x8 tr_frag(const bf16_t* base, int ld, int row0, int col0, int lane) {
    const bf16_t* ptr = base + (row0 + (lane >> 4) * 8 + ((lane & 15) >> 2)) * ld + col0 + (lane & 3) * 4;
    const s16x4 lo = __builtin_amdgcn_ds_read_tr16_b64_v4i16((__attribute__((address_space(3))) s16x4*)ptr);
    const s16x4 hi = __builtin_amdgcn_ds_read_tr16_b64_v4i16((__attribute__((address_space(3))) s16x4*)(ptr + 4 * ld));
    return (bf16x8){lo[0], lo[1], lo[2], lo[3], hi[0], hi[1], hi[2], hi[3]};
}
DEV bf16x8 row_frag(const bf16_t* base, int ld, int idx0, int k0, int lane) {
    return *(const bf16x8*)(base + (idx0 + (lane & 15)) * ld + k0 + (lane >> 4) * 8);
}

DEV void gla1_unit(const Params& p, int h, int dir, int c, float* sm) {
    const int tid = opaque_tid(), lane = tid & 63, wave = tid >> 6;
    const bf16_t* P0 = (const bf16_t*)(p.ws + OFF_P0);
    float* GDS = (float*)(p.ws + OFF_GDS); float* GDEC = (float*)(p.ws + OFF_GDEC);
    float* sLR = sm; float* sBC = sm + 2048; float* sTot = sm + 6208;
    bf16_t* kT = (bf16_t*)(sm + 6272);
    bf16_t* Vs = (bf16_t*)(sm + 8576);
    const int ch = h * 2 + dir;
    const int t = tid >> 3, k0 = (tid & 7) * 8;
    const uint4 lrq = *(const uint4*)(P0 + (size_t)(c * 64 + ((tid & 127) >> 1)) * EIN + 1536 + dir * 16 + (tid & 1) * 8);
    const uint4 kq = *(const uint4*)(P0 + (size_t)(c * 64 + t) * EIN + 256 + h * 64 + k0);
    const uint4 vq0 = *(const uint4*)(P0 + (size_t)(c * 64 + (tid >> 4)) * EIN + 512 + h * 128 + (tid & 15) * 8);
    const uint4 vq1 = *(const uint4*)(P0 + (size_t)(c * 64 + 32 + (tid >> 4)) * EIN + 512 + h * 128 + (tid & 15) * 8);
    __syncthreads();
    if (tid < 128) { float* d = sLR + (tid >> 1) * 16 + (tid & 1) * 8; st4(d, make_float4(bflo(lrq.x), bfhi(lrq.x), bflo(lrq.y), bfhi(lrq.y))); st4(d + 4, make_float4(bflo(lrq.z), bfhi(lrq.z), bflo(lrq.w), bfhi(lrq.w))); }
    *(uint4*)(Vs + (tid >> 4) * 136 + (tid & 15) * 8) = vq0; *(uint4*)(Vs + (32 + (tid >> 4)) * 136 + (tid & 15) * 8) = vq1;
    __syncthreads();
    gla_decay_core(sLR, sm + GLC_OFF + dir * 1024, sm + GLC_OFF + 2048 + dir * 64, sBC, sTot, dir, tid);
    {
        float kv[8]; unpack8(kq, kv);
#pragma unroll
        for (int j = 0; j < 8; ++j) kT[(k0 + j) * 72 + t] = __builtin_bit_cast(unsigned short, (__bf16)(kv[j] * fexp(sTot[k0 + j] - sBC[t * 65 + k0 + j])));
    }
    __syncthreads();
    {
        f32x4 acc[4];
#pragma unroll
        for (int kt = 0; kt < 4; ++kt) acc[kt] = (f32x4){0.f, 0.f, 0.f, 0.f};
#pragma unroll
        for (int ks = 0; ks < 2; ++ks) {
            const bf16x8 af = tr_frag(Vs, 136, ks * 32, wave * 16, lane);
#pragma unroll
            for (int kt = 0; kt < 4; ++kt) acc[kt] = __builtin_amdgcn_mfma_f32_16x16x32_bf16(af, row_frag(kT, 72, kt * 16, ks * 32, lane), acc[kt], 0, 0, 0);
        }
#pragma unroll
        for (int kt = 0; kt < 4; ++kt) {
            const int k = kt * 16 + (lane & 15), v = wave * 16 + (lane >> 4) * 4;
            st4(GDS + ((size_t)(ch * NCH + c) * 64 + k) * 128 + v, make_float4(acc[kt][0], acc[kt][1], acc[kt][2], acc[kt][3]));
        }
    }
    if (tid < 64) GDEC[(size_t)(ch * NCH + c) * 64 + tid] = fexp(sTot[tid]);
}

DEV void gla2_unit(const Params& p, int unit) {
    const int tid = opaque_tid();
    float* GDS = (float*)(p.ws + OFF_GDS); const float* GDEC = (const float*)(p.ws + OFF_GDEC);
    const int ch = unit >> 4, e = (unit & 15) * 512 + tid, k = e >> 7, dir = ch & 1;
    constexpr int GB = 12;
    float S = 0.f, ninc[GB], nd[GB];
#pragma unroll
    for (int j = 0; j < GB; ++j) { const int c = chunk_at(dir, j); ninc[j] = GDS[(size_t)(ch * NCH + c) * 8192 + e]; nd[j] = GDEC[(size_t)(ch * NCH + c) * 64 + k]; }
#pragma unroll 1
    for (int step0 = 0; step0 < NCH; step0 += GB) {
        float inc[GB], d[GB];
#pragma unroll
        for (int j = 0; j < GB; ++j) { inc[j] = ninc[j]; d[j] = nd[j]; }
#pragma unroll
        for (int j = 0; j < GB; ++j) { const int sn = step0 + GB + j, c = chunk_at(dir, sn < NCH ? sn : NCH - 1); ninc[j] = GDS[(size_t)(ch * NCH + c) * 8192 + e]; nd[j] = GDEC[(size_t)(ch * NCH + c) * 64 + k]; }
        __builtin_amdgcn_sched_barrier(0);
#pragma unroll
        for (int j = 0; j < GB; ++j) { const int c = chunk_at(dir, step0 + j); GDS[(size_t)(ch * NCH + c) * 8192 + e] = S; S = d[j] * S + inc[j]; }
    }
}

DEV void gla3_unit(const Params& p, int h, int c, float* sm) {
    const int tid = opaque_tid(), lane = tid & 63, wave = tid >> 6;
    const bf16_t* P0 = (const bf16_t*)(p.ws + OFF_P0);
    const float* GDS = (const float*)(p.ws + OFF_GDS);
    bf16_t* YC = (bf16_t*)(p.ws + OFF_YC);
    const float* ng = p.in[14];
    float* sLR2 = sm;
    float* sBC = sm + 2048; float* sTot = sm + 6208;
    bf16_t* qt = (bf16_t*)(sm + 6272);
    bf16_t* kt = (bf16_t*)(sm + 8576);
    bf16_t* Sm = (bf16_t*)(sm + 10880);
    bf16_t* S0s = (bf16_t*)(sm + 13184);
    bf16_t* Vs = (bf16_t*)(sm + 17536);
    float* O = sm + 21888;
    const int ti = wave & 3, vt0 = (wave >> 2) * 4;
    const int t = tid >> 3, k0 = (tid & 7) * 8;
    f32x4 acc[4];
#pragma unroll
    for (int j = 0; j < 4; ++j) acc[j] = (f32x4){0.f, 0.f, 0.f, 0.f};
    const uint4 vq0 = *(const uint4*)(P0 + (size_t)(c * 64 + (tid >> 4)) * EIN + 512 + h * 128 + (tid & 15) * 8);
    const uint4 vq1 = *(const uint4*)(P0 + (size_t)(c * 64 + 32 + (tid >> 4)) * EIN + 512 + h * 128 + (tid & 15) * 8);
    const uint4 lrq = *(const uint4*)(P0 + (size_t)(c * 64 + ((tid & 255) >> 2)) * EIN + 1536 + (tid & 3) * 8);
    const uint4 qq = *(const uint4*)(P0 + (size_t)(c * 64 + t) * EIN + h * 64 + k0);
    const uint4 kq = *(const uint4*)(P0 + (size_t)(c * 64 + t) * EIN + 256 + h * 64 + k0);
    float4 s0a[4], s0b[4];
#pragma unroll
    for (int u = 0; u < 4; ++u) { const int i = tid + 512 * u, k = i >> 5, v4 = (i & 31) * 4;
        s0a[u] = ld4(GDS + (size_t)((h * 2 + 0) * NCH + c) * 8192 + k * 128 + v4); s0b[u] = ld4(GDS + (size_t)((h * 2 + 1) * NCH + c) * 8192 + k * 128 + v4); }
    const bf16_t* gp = P0 + (size_t)(c * 64 + t) * EIN + 1024 + h * 128 + (tid & 7) * 16;
    const uint4 gq0 = *(const uint4*)gp, gq1 = *(const uint4*)(gp + 8);
    __syncthreads();
    *(uint4*)(Vs + (tid >> 4) * 136 + (tid & 15) * 8) = vq0; *(uint4*)(Vs + (32 + (tid >> 4)) * 136 + (tid & 15) * 8) = vq1;
    if (tid < 256) { float* d = sLR2 + ((tid & 3) >> 1) * 1024 + (tid >> 2) * 16 + (tid & 1) * 8; st4(d, make_float4(bflo(lrq.x), bfhi(lrq.x), bflo(lrq.y), bfhi(lrq.y))); st4(d + 4, make_float4(bflo(lrq.z), bfhi(lrq.z), bflo(lrq.w), bfhi(lrq.w))); }
    __syncthreads();
#pragma unroll
    for (int dir = 0; dir < 2; ++dir) {
        gla_decay_core(sLR2 + dir * 1024, sm + GLC_OFF + dir * 1024, sm + GLC_OFF + 2048 + dir * 64, sBC, sTot, dir, tid);
        {
            float qv[8], kv[8];
            unpack8(qq, qv); unpack8(kq, kv);
#pragma unroll
            for (int j = 0; j < 8; ++j) { const float bc = sBC[t * 65 + k0 + j]; qv[j] *= 0.125f * fexp(bc); kv[j] *= fexp(-bc); }
            *(uint4*)(qt + t * 72 + k0) = make_uint4(pack2bf(qv[0], qv[1]), pack2bf(qv[2], qv[3]), pack2bf(qv[4], qv[5]), pack2bf(qv[6], qv[7]));
            *(uint4*)(kt + t * 72 + k0) = make_uint4(pack2bf(kv[0], kv[1]), pack2bf(kv[2], kv[3]), pack2bf(kv[4], kv[5]), pack2bf(kv[6], kv[7]));
#pragma unroll
            for (int u = 0; u < 4; ++u) {
                const int i = tid + 512 * u, k = i >> 5, v4 = (i & 31) * 4;
                const float4 s4 = dir ? s0b[u] : s0a[u];
                *(uint2*)(S0s + k * 136 + v4) = make_uint2(pack2bf(s4.x, s4.y), pack2bf(s4.z, s4.w));
            }
        }
        __syncthreads();
        {
            const int si = wave & 3;
#pragma unroll
            for (int jj = 0; jj < 2; ++jj) {
                const int t2 = (wave >> 2) * 2 + jj;
                f32x4 a = (f32x4){0.f, 0.f, 0.f, 0.f};
#pragma unroll
                for (int ks = 0; ks < 2; ++ks) a = __builtin_amdgcn_mfma_f32_16x16x32_bf16(row_frag(kt, 72, si * 16, ks * 32, lane), row_frag(qt, 72, t2 * 16, ks * 32, lane), a, 0, 0, 0);
                const int tq = t2 * 16 + (lane & 15), s0 = si * 16 + (lane >> 4) * 4;
                float m[4];
#pragma unroll
                for (int r = 0; r < 4; ++r) { const bool keep = dir ? (s0 + r >= tq) : (s0 + r <= tq); m[r] = keep ? a[r] : 0.f; }
                *(uint2*)(Sm + tq * 72 + s0) = make_uint2(pack2bf(m[0], m[1]), pack2bf(m[2], m[3]));
            }
        }
        __syncthreads();
#pragma unroll
        for (int ks = 0; ks < 2; ++ks) {
            const bf16x8 a1 = row_frag(qt, 72, ti * 16, ks * 32, lane), a2 = row_frag(Sm, 72, ti * 16, ks * 32, lane);
#pragma unroll
            for (int j = 0; j < 4; ++j) {
                acc[j] = __builtin_amdgcn_mfma_f32_16x16x32_bf16(a1, tr_frag(S0s, 136, ks * 32, (vt0 + j) * 16, lane), acc[j], 0, 0, 0);
                acc[j] = __builtin_amdgcn_mfma_f32_16x16x32_bf16(a2, tr_frag(Vs, 136, ks * 32, (vt0 + j) * 16, lane), acc[j], 0, 0, 0);
            }
        }
        if (dir == 0) __syncthreads();
    }
#pragma unroll
    for (int j = 0; j < 4; ++j)
#pragma unroll
        for (int r = 0; r < 4; ++r) O[(ti * 16 + (lane >> 4) * 4 + r) * 132 + (vt0 + j) * 16 + (lane & 15)] = acc[j][r];
    __syncthreads();
    {
        const int v0 = (tid & 7) * 16;
        float o[16];
        float ss = 0.f;
#pragma unroll
        for (int i = 0; i < 16; ++i) { o[i] = O[t * 132 + v0 + i]; ss += o[i] * o[i]; }
        ss += __shfl_xor(ss, 1, 64); ss += __shfl_xor(ss, 2, 64); ss += __shfl_xor(ss, 4, 64);
        const float rms = rsqrtf(ss * (1.f / 128.f) + 1e-5f);
        float g[16];
        unpack8(gq0, g); unpack8(gq1, g + 8);
        float y[16];
#pragma unroll
        for (int i = 0; i < 16; ++i) y[i] = o[i] * rms * ng[v0 + i] * silu_f(g[i]);
        bf16_t* yp = YC + (size_t)(c * 64 + t) * 1024 + h * 128 + v0;
        *(uint4*)yp = make_uint4(pack2bf(y[0], y[1]), pack2bf(y[2], y[3]), pack2bf(y[4], y[5]), pack2bf(y[6], y[7]));
        *(uint4*)(yp + 8) = make_uint4(pack2bf(y[8], y[9]), pack2bf(y[10], y[11]), pack2bf(y[12], y[13]), pack2bf(y[14], y[15]));
    }
}

DEV void load8bf(const bf16_t* ptr, float* f) { unpack8(*(const uint4*)ptr, f); }
struct RwNb { int sL, sR, sU, sD; bool vL, vR, vU, vD; };
DEV RwNb rw_nb(int s) {
    RwNb q; q.vU = false; q.vD = false;
    if (s < NCX) { q.vL = s > 0; q.vR = s < NCX - 1; }
    else { const int n = s - NCX, rr = n >> 6, cc = n & 63; q.vL = cc > 0; q.vR = cc < 63; q.vU = rr > 0; q.vD = rr < 127; }
    q.sL = q.vL ? s - 1 : s; q.sR = q.vR ? s + 1 : s; q.sU = q.vU ? s - 64 : s; q.sD = q.vD ? s + 64 : s;
    return q;
}
struct RwRaw { uint4 o, l, r, u, d; };
DEV RwRaw rw_load(const bf16_t* P0, int s, const RwNb& q, int cb) {
    RwRaw w;
    w.o = *(const uint4*)(P0 + (size_t)s * EIN + RW0 + cb); w.l = *(const uint4*)(P0 + (size_t)q.sL * EIN + RW0 + cb); w.r = *(const uint4*)(P0 + (size_t)q.sR * EIN + RW0 + cb);
    w.u = *(const uint4*)(P0 + (size_t)q.sU * EIN + RW0 + cb); w.d = *(const uint4*)(P0 + (size_t)q.sD * EIN + RW0 + cb);
    return w;
}
DEV void rw_comb_l(const RwRaw& w, const RwNb& q, const float* ml, float* out) {
    float own[8]; unpack8(w.o, own);
    const float nb[8] = {q.vL ? bflo(w.l.x) : 0.f, q.vR ? bfhi(w.r.x) : 0.f, q.vU ? bflo(w.u.y) : 0.f, q.vD ? bfhi(w.d.y) : 0.f,
                         q.vL ? bflo(w.l.z) : 0.f, q.vR ? bfhi(w.r.z) : 0.f, q.vU ? bflo(w.u.w) : 0.f, q.vD ? bfhi(w.d.w) : 0.f};
    const float4 m0 = *(const float4*)ml, m1 = *(const float4*)(ml + 4);
    const float m[8] = {m0.x, m0.y, m0.z, m0.w, m1.x, m1.y, m1.z, m1.w};
#pragma unroll
    for (int i = 0; i < 8; ++i) out[i] = own[i] + (nb[i] - own[i]) * m[i];
}
DEV void rw_comb(const RwRaw& w, const RwNb& q, const float* __restrict__ mu, int cb, float* out) {
    float own[8]; unpack8(w.o, own);
    const float nb[8] = {q.vL ? bflo(w.l.x) : 0.f, q.vR ? bfhi(w.r.x) : 0.f, q.vU ? bflo(w.u.y) : 0.f, q.vD ? bfhi(w.d.y) : 0.f,
                         q.vL ? bflo(w.l.z) : 0.f, q.vR ? bfhi(w.r.z) : 0.f, q.vU ? bflo(w.u.w) : 0.f, q.vD ? bfhi(w.d.w) : 0.f};
    const float4 m0 = ld4(mu + cb), m1 = ld4(mu + cb + 4);
    const float m[8] = {m0.x, m0.y, m0.z, m0.w, m1.x, m1.y, m1.z, m1.w};
#pragma unroll
    for (int i = 0; i < 8; ++i) out[i] = own[i] + (nb[i] - own[i]) * m[i];
}
DEV uint4 pack8(const float* f) { return make_uint4(pack2bf(f[0], f[1]), pack2bf(f[2], f[3]), pack2bf(f[4], f[5]), pack2bf(f[6], f[7])); }

template <int XM, int YM, class F>
DEV void mm64(const bf16_t* X, const bf16_t* Y, F f, int lane, int wave) {
#pragma unroll
    for (int q = 0; q < 2; ++q) {
        const int idx = wave * 2 + q, ti = idx >> 2, tj = idx & 3;
        f32x4 acc = (f32x4){0.f, 0.f, 0.f, 0.f};
#pragma unroll
        for (int ks = 0; ks < 2; ++ks) {
            const bf16x8 a = XM == 0 ? row_frag(X, 72, ti * 16, ks * 32, lane) : tr_frag(X, 72, ks * 32, ti * 16, lane);
            const bf16x8 bq = YM == 0 ? row_frag(Y, 72, tj * 16, ks * 32, lane) : tr_frag(Y, 72, ks * 32, tj * 16, lane);
            acc = __builtin_amdgcn_mfma_f32_16x16x32_bf16(a, bq, acc, 0, 0, 0);
        }
        f(ti * 16 + (lane >> 4) * 4, tj * 16 + (lane & 15), acc);
    }
}
template <int XM, int YM, class F>
DEV void mm64x2(const bf16_t* X1, const bf16_t* Y1, const bf16_t* X2, const bf16_t* Y2, F f, int lane, int wave) {
#pragma unroll
    for (int q = 0; q < 2; ++q) {
        const int idx = wave * 2 + q, ti = idx >> 2, tj = idx & 3;
        f32x4 acc = (f32x4){0.f, 0.f, 0.f, 0.f};
#pragma unroll
        for (int ks = 0; ks < 2; ++ks) {
            const bf16x8 a = XM == 0 ? row_frag(X1, 72, ti * 16, ks * 32, lane) : tr_frag(X1, 72, ks * 32, ti * 16, lane);
            const bf16x8 bq = YM == 0 ? row_frag(Y1, 72, tj * 16, ks * 32, lane) : tr_frag(Y1, 72, ks * 32, tj * 16, lane);
            acc = __builtin_amdgcn_mfma_f32_16x16x32_bf16(a, bq, acc, 0, 0, 0);
            const bf16x8 a2 = XM == 0 ? row_frag(X2, 72, ti * 16, ks * 32, lane) : tr_frag(X2, 72, ks * 32, ti * 16, lane);
            const bf16x8 b2 = YM == 0 ? row_frag(Y2, 72, tj * 16, ks * 32, lane) : tr_frag(Y2, 72, ks * 32, tj * 16, lane);
            acc = __builtin_amdgcn_mfma_f32_16x16x32_bf16(a2, b2, acc, 0, 0, 0);
        }
        f(ti * 16 + (lane >> 4) * 4, tj * 16 + (lane & 15), acc);
    }
}
DEV void st_img(bf16_t* P, int i0, int j, float a0, float a1, float a2, float a3) {
    P[(i0 + 0) * 72 + j] = __builtin_bit_cast(unsigned short, (__bf16)a0); P[(i0 + 1) * 72 + j] = __builtin_bit_cast(unsigned short, (__bf16)a1);
    P[(i0 + 2) * 72 + j] = __builtin_bit_cast(unsigned short, (__bf16)a2); P[(i0 + 3) * 72 + j] = __builtin_bit_cast(unsigned short, (__bf16)a3);
}

struct RwRaw3 { uint4 o, u, d; };
DEV RwRaw3 rw_load3(const bf16_t* P0, int s, const RwNb& q, int cb) {
    RwRaw3 w;
    w.o = *(const uint4*)(P0 + (size_t)s * EIN + RW0 + cb); w.u = *(const uint4*)(P0 + (size_t)q.sU * EIN + RW0 + cb); w.d = *(const uint4*)(P0 + (size_t)q.sD * EIN + RW0 + cb);
    return w;
}
DEV void rw_comb3(const RwRaw3& w, const RwNb& q, const bf16_t* tile, const bf16_t* P0, int s, int t, int cb, int j0, const float* ml, float* out) {
    asm volatile("" :: "v"(w.u.x), "v"(w.u.z), "v"(w.d.x), "v"(w.d.z));
    float own[8]; unpack8(w.o, own);
    float l0 = 0.f, l4 = 0.f, r1 = 0.f, r5 = 0.f;
    if (q.vL) { if (t > 0) { l0 = bf2f(tile[(t - 1) * 72 + j0]); l4 = bf2f(tile[(t - 1) * 72 + j0 + 4]); }
                else { const bf16_t* g = P0 + (size_t)(s - 1) * EIN + RW0 + cb; l0 = bf2f(g[0]); l4 = bf2f(g[4]); } }
    if (q.vR) { if (t < 63) { r1 = bf2f(tile[(t + 1) * 72 + j0 + 1]); r5 = bf2f(tile[(t + 1) * 72 + j0 + 5]); }
                else { const bf16_t* g = P0 + (size_t)(s + 1) * EIN + RW0 + cb; r1 = bf2f(g[1]); r5 = bf2f(g[5]); } }
    const float nb[8] = {l0, r1, q.vU ? bflo(w.u.y) : 0.f, q.vD ? bfhi(w.d.y) : 0.f, l4, r5, q.vU ? bflo(w.u.w) : 0.f, q.vD ? bfhi(w.d.w) : 0.f};
    const float4 m0 = *(const float4*)ml, m1 = *(const float4*)(ml + 4);
    const float m[8] = {m0.x, m0.y, m0.z, m0.w, m1.x, m1.y, m1.z, m1.w};
#pragma unroll
    for (int i = 0; i < 8; ++i) out[i] = own[i] + (nb[i] - own[i]) * m[i];
}
struct R1Raw { RwRaw3 r, k, v, w, a; float4 qw0, qw1, qa0, qa1; };
DEV void r1_consts(const Params& p, int h, int dir, float* sm) {
    const int tid = opaque_tid();
    float* sv = (float*)((bf16_t*)sm + 14 * 4608);
    __syncthreads();
    if (tid < 64) { const int hc = h * 64 + tid; sv[64 + tid] = p.in[dir ? 18 : 16][hc]; sv[128 + tid] = p.in[dir ? 22 : 20][hc]; sv[192 + tid] = p.in[24][hc]; sv[256 + tid] = p.in[25][hc]; sv[320 + tid] = p.in[26][hc]; }
    if (tid < 320) { const int tn = tid >> 6, col = tid & 63; const int cb = tn < 3 ? tn * 512 + h * 64 : (tn == 3 ? 2048 + dir * 64 : 2176 + dir * 64); sv[384 + tid] = p.in[15][cb + col]; }
}
DEV void r1_load(const Params& p, int h, int dir, int c, R1Raw& R) {
    const int tid = opaque_tid();
    const bf16_t* P0 = (const bf16_t*)(p.ws + OFF_P0);
    const float* ww2 = p.in[dir ? 19 : 17]; const float* wa2 = p.in[dir ? 23 : 21];
    const int t = tid >> 3, j0 = (tid & 7) * 8, s = c * 64 + t;
    const RwNb nbq = rw_nb(s);
    R.r = rw_load3(P0, s, nbq, h * 64 + j0); R.k = rw_load3(P0, s, nbq, 512 + h * 64 + j0); R.v = rw_load3(P0, s, nbq, 1024 + h * 64 + j0);
    R.w = rw_load3(P0, s, nbq, 2048 + dir * 64 + j0); R.a = rw_load3(P0, s, nbq, 2176 + dir * 64 + j0);
    R.qw0 = ld4(ww2 + (size_t)t * 512 + h * 64 + j0); R.qw1 = ld4(ww2 + (size_t)t * 512 + h * 64 + j0 + 4);
    R.qa0 = ld4(wa2 + (size_t)t * 512 + h * 64 + j0); R.qa1 = ld4(wa2 + (size_t)t * 512 + h * 64 + j0 + 4);
}
DEV void rwkv1_unit(const Params& p, int h, int dir, int c, float* sm, R1Raw& R, int cnext) {
    const int tid = opaque_tid(), lane = tid & 63, wave = tid >> 6;
    bf16_t* RU = (bf16_t*)(p.ws + OFF_RU) + (size_t)((h * 2 + dir) * NCH + c) * 16384;
    float* BONS = (float*)(p.ws + OFF_BONS);
    bf16_t* img = (bf16_t*)sm;
#define SLOT(i_) (img + (i_) * 4608)
    float* fLW = (float*)SLOT(10);
    float* fAS = (float*)SLOT(12);
    float* sv = (float*)SLOT(14);
    const int t = tid >> 3, j0 = (tid & 7) * 8, s = c * 64 + t;
    const bf16_t* P0 = (const bf16_t*)(p.ws + OFF_P0);
    __syncthreads();
    *(uint4*)(SLOT(0) + t * 72 + j0) = R.r.o; *(uint4*)(SLOT(1) + t * 72 + j0) = R.k.o; *(uint4*)(SLOT(2) + t * 72 + j0) = R.v.o;
    *(uint4*)(SLOT(3) + t * 72 + j0) = R.w.o; *(uint4*)(SLOT(4) + t * 72 + j0) = R.a.o;
    __syncthreads();
    float r8[8], k8[8], v8[8];
    {
        float x8[8];
        const RwNb nbq = rw_nb(s);
        rw_comb3(R.r, nbq, SLOT(0), P0, s, t, h * 64 + j0, j0, sv + 384 + j0, r8);
        rw_comb3(R.k, nbq, SLOT(1), P0, s, t, 512 + h * 64 + j0, j0, sv + 448 + j0, k8);
        rw_comb3(R.v, nbq, SLOT(2), P0, s, t, 1024 + h * 64 + j0, j0, sv + 512 + j0, v8);
        rw_comb3(R.w, nbq, SLOT(3), P0, s, t, 2048 + dir * 64 + j0, j0, sv + 576 + j0, x8);
#pragma unroll
        for (int i = 0; i < 8; ++i) x8[i] = tanh_f(x8[i]);
        *(uint4*)(SLOT(6) + t * 72 + j0) = pack8(x8);
        rw_comb3(R.a, nbq, SLOT(4), P0, s, t, 2176 + dir * 64 + j0, j0, sv + 640 + j0, x8);
        *(uint4*)(SLOT(7) + t * 72 + j0) = pack8(x8);
        { const float wq[8] = {R.qw0.x, R.qw0.y, R.qw0.z, R.qw0.w, R.qw1.x, R.qw1.y, R.qw1.z, R.qw1.w}; *(uint4*)(SLOT(8) + t * 72 + j0) = pack8(wq); }
        { const float wq[8] = {R.qa0.x, R.qa0.y, R.qa0.z, R.qa0.w, R.qa1.x, R.qa1.y, R.qa1.z, R.qa1.w}; *(uint4*)(SLOT(9) + t * 72 + j0) = pack8(wq); }
    }
    r1_load(p, h, dir, cnext >= 0 ? cnext : c, R);
    __syncthreads();
    mm64<0, 1>(SLOT(6), SLOT(8), [=](int i0, int j, f32x4 a) {
#pragma unroll
        for (int r = 0; r < 4; ++r) fLW[(i0 + r) * 65 + j] = -0.6065306597f * sigmoid_f(sv[64 + j] + a[r]); }, lane, wave);
    mm64<0, 1>(SLOT(7), SLOT(9), [=](int i0, int j, f32x4 a) {
#pragma unroll
        for (int r = 0; r < 4; ++r) fAS[(i0 + r) * 65 + j] = sigmoid_f(sv[128 + j] + a[r]); }, lane, wave);
    __syncthreads();
#pragma unroll
    for (int j = 0; j < 8; ++j) {
        const int k = wave * 8 + j;
        const float v = wave_scan_add(fLW[lane * 65 + k], lane, dir);
        fLW[lane * 65 + k] = v;
        if (lane == (dir ? 0 : 63)) sv[k] = v;
    }
    __syncthreads();
    {
        float kkv[8], ss = 0.f;
#pragma unroll
        for (int i = 0; i < 8; ++i) { kkv[i] = k8[i] * sv[192 + j0 + i]; ss += kkv[i] * kkv[i]; }
        ss += __shfl_xor(ss, 1, 64); ss += __shfl_xor(ss, 2, 64); ss += __shfl_xor(ss, 4, 64);
        const float rn = rsqrtf(fmaxf(ss, 1e-24f));
        float fa[8], fb[8], fk[8], fr[8], fbp[8], fkp[8], bon = 0.f;
        const int tp = dir ? t + 1 : t - 1;
        const bool hasp = dir ? (t < 63) : (t > 0);
#pragma unroll
        for (int i = 0; i < 8; ++i) {
            const int k = j0 + i;
            const float Bt = fLW[t * 65 + k], Bx = hasp ? fLW[tp * 65 + k] : 0.f, asg = fAS[t * 65 + k];
            const float kk = kkv[i] * rn, kh = k8[i] * (1.f + (asg - 1.f) * sv[256 + k]);
            bon += r8[i] * kh * sv[320 + k];
            const float enB = fexp(-Bt), eLB = fexp(sv[k] - Bt), bv = kk * asg;
            fa[i] = -kk * fexp(Bx); fb[i] = bv * enB; fk[i] = kh * enB; fr[i] = r8[i] * fexp(Bt); fbp[i] = bv * eLB; fkp[i] = kh * eLB;
        }
        bon += __shfl_xor(bon, 1, 64); bon += __shfl_xor(bon, 2, 64); bon += __shfl_xor(bon, 4, 64);
        if ((tid & 7) == 0) BONS[((size_t)dir * TB + s) * 8 + h] = bon;
        *(uint4*)(SLOT(0) + t * 72 + j0) = pack8(fa); *(uint4*)(SLOT(1) + t * 72 + j0) = pack8(fb); *(uint4*)(SLOT(2) + t * 72 + j0) = pack8(fk);
        *(uint4*)(SLOT(3) + t * 72 + j0) = pack8(fr); *(uint4*)(SLOT(4) + t * 72 + j0) = pack8(fbp); *(uint4*)(SLOT(5) + t * 72 + j0) = pack8(fkp);
    }
    __syncthreads();
    *(uint4*)(SLOT(6) + t * 72 + j0) = pack8(v8);
    __syncthreads();
    mm64<0, 0>(SLOT(0), SLOT(1), [=](int i0, int j, f32x4 a) {
        float m[4];
#pragma unroll
        for (int r = 0; r < 4; ++r) { const bool keep = dir ? (j > i0 + r) : (j < i0 + r); m[r] = keep ? a[r] : 0.f; }
        const bool dg = (i0 >> 4) == (j >> 4);
        st_img(SLOT(7), i0, j, dg ? m[0] : 0.f, dg ? m[1] : 0.f, dg ? m[2] : 0.f, dg ? m[3] : 0.f);
        st_img(SLOT(8), i0, j, (dg ? m[0] : 0.f) + (j == i0 ? 1.f : 0.f), (dg ? m[1] : 0.f) + (j == i0 + 1 ? 1.f : 0.f), (dg ? m[2] : 0.f) + (j == i0 + 2 ? 1.f : 0.f), (dg ? m[3] : 0.f) + (j == i0 + 3 ? 1.f : 0.f));
        st_img(SLOT(12), i0, j, dg ? 0.f : m[0], dg ? 0.f : m[1], dg ? 0.f : m[2], dg ? 0.f : m[3]); }, lane, wave);
    mm64<0, 0>(SLOT(0), SLOT(2), [=](int i0, int j, f32x4 a) {
        float m[4];
#pragma unroll
        for (int r = 0; r < 4; ++r) { const bool keep = dir ? (j > i0 + r) : (j < i0 + r); m[r] = keep ? a[r] : 0.f; }
        st_img(SLOT(9), i0, j, m[0], m[1], m[2], m[3]); }, lane, wave);
    mm64<0, 0>(SLOT(3), SLOT(1), [=](int i0, int j, f32x4 a) {
        float m[4];
#pragma unroll
        for (int r = 0; r < 4; ++r) { const bool keep = dir ? (j >= i0 + r) : (j <= i0 + r); m[r] = keep ? a[r] : 0.f; }
        st_img(SLOT(10), i0, j, m[0], m[1], m[2], m[3]); }, lane, wave);
    mm64<0, 0>(SLOT(3), SLOT(2), [=](int i0, int j, f32x4 a) {
        float m[4];
#pragma unroll
        for (int r = 0; r < 4; ++r) { const bool keep = dir ? (j >= i0 + r) : (j <= i0 + r); m[r] = keep ? a[r] : 0.f; }
        st_img(SLOT(11), i0, j, m[0], m[1], m[2], m[3]); }, lane, wave);
    __syncthreads();
    {
        bf16_t* Pc = SLOT(7); bf16_t* Pn = SLOT(1); bf16_t* Tc = SLOT(8); bf16_t* Tn = SLOT(2);
#pragma unroll 1
        for (int it = 0; it < 3; ++it) {
            mm64<0, 1>(Pc, Pc, [=](int i0, int j, f32x4 a) { st_img(Pn, i0, j, a[0], a[1], a[2], a[3]); }, lane, wave);
            __syncthreads();
            mm64<0, 1>(Tc, Pn, [=](int i0, int j, f32x4 a) {
                st_img(Tn, i0, j, a[0] + bf2f(Tc[(i0 + 0) * 72 + j]), a[1] + bf2f(Tc[(i0 + 1) * 72 + j]), a[2] + bf2f(Tc[(i0 + 2) * 72 + j]), a[3] + bf2f(Tc[(i0 + 3) * 72 + j])); }, lane, wave);
            __syncthreads();
            bf16_t* tmp = Pc; Pc = Pn; Pn = tmp; tmp = Tc; Tc = Tn; Tn = tmp;
        }
    }
    mm64<0, 1>(SLOT(2), SLOT(12), [=](int i0, int j, f32x4 a) { st_img(SLOT(7), i0, j, a[0], a[1], a[2], a[3]); }, lane, wave);
    mm64<0, 1>(SLOT(2), SLOT(0), [=](int i0, int j, f32x4 a) { st_img(SLOT(1), i0, j, a[0], a[1], a[2], a[3]); }, lane, wave);
    mm64<0, 1>(SLOT(9), SLOT(6), [=](int i0, int j, f32x4 a) { st_img(SLOT(13), i0, j, a[0], a[1], a[2], a[3]); }, lane, wave);
    __syncthreads();
    mm64<0, 1>(SLOT(2), SLOT(13), [=](int i0, int j, f32x4 a) { st_img(SLOT(8), i0, j, a[0], a[1], a[2], a[3]); }, lane, wave);
    __syncthreads();
    {
        const bf16_t* Zp = (wave < 4) ? SLOT(1) : SLOT(8);
        bf16_t* Xi = (wave < 4) ? SLOT(12) : SLOT(9);
        const int ct = (wave & 3) * 16, g4 = (lane >> 4) * 4, l15 = lane & 15;
#pragma unroll
        for (int bs = 0; bs < 4; ++bs) {
            const int bi = dir ? 3 - bs : bs;
            f32x4 acc;
#pragma unroll
            for (int r = 0; r < 4; ++r) acc[r] = bf2f(Zp[(bi * 16 + g4 + r) * 72 + ct + l15]);
            const bool k0 = dir ? (bi == 0) : (bi >= 1), k1 = dir ? (bi <= 2) : (bi == 3);
            if (k0) acc = __builtin_amdgcn_mfma_f32_16x16x32_bf16(row_frag(SLOT(7), 72, bi * 16, 0, lane), tr_frag(Xi, 72, 0, ct, lane), acc, 0, 0, 0);
            if (k1) acc = __builtin_amdgcn_mfma_f32_16x16x32_bf16(row_frag(SLOT(7), 72, bi * 16, 32, lane), tr_frag(Xi, 72, 32, ct, lane), acc, 0, 0, 0);
            st_img(Xi, bi * 16 + g4, ct + l15, acc[0], acc[1], acc[2], acc[3]);
            __syncthreads();
        }
    }
    mm64<1, 1>(SLOT(12), SLOT(4), [=](int i0, int j, f32x4 a) {
        float m[4];
#pragma unroll
        for (int r = 0; r < 4; ++r) m[r] = a[r] + ((i0 + r) == j ? fexp(sv[j]) : 0.f);
        *(uint2*)(RU + j * 64 + i0) = make_uint2(pack2bf(m[0], m[1]), pack2bf(m[2], m[3])); }, lane, wave);
    mm64x2<1, 1>(SLOT(4), SLOT(9), SLOT(5), SLOT(6), [=](int i0, int j, f32x4 a) {
        *(uint2*)(RU + 4096 + j * 64 + i0) = make_uint2(pack2bf(a[0], a[1]), pack2bf(a[2], a[3])); }, lane, wave);
    mm64<1, 0>(SLOT(12), SLOT(10), [=](int i0, int j, f32x4 a) {
        const uint2 rr = *(const uint2*)(SLOT(3) + j * 72 + i0);
        *(uint2*)(RU + 8192 + j * 64 + i0) = make_uint2(pack2bf(a[0] + bflo(rr.x), a[1] + bfhi(rr.x)), pack2bf(a[2] + bflo(rr.y), a[3] + bfhi(rr.y))); }, lane, wave);
    mm64x2<0, 1>(SLOT(10), SLOT(9), SLOT(11), SLOT(6), [=](int i0, int j, f32x4 a) {
        *(uint2*)(RU + 12288 + j * 64 + i0) = make_uint2(pack2bf(a[0], a[1]), pack2bf(a[2], a[3])); }, lane, wave);
#undef SLOT
}

#define R2_LOAD(M_, C_, rnd_) do { const int r0_ = ((rnd_) < R2_NR ? (rnd_) : R2_NR - 1) * R2_RS; \
    _Pragma("unroll") for (int s_ = 0; s_ < R2_RS; ++s_) M_[s_] = *(const uint4*)(RU + (size_t)(chain * NCH + chunk_at(dir, r0_ + s_)) * 16384 + tid * 8); \
    _Pragma("unroll") for (int j_ = 0; j_ < 3; ++j_) { const int cq_ = tid + 512 * j_; \
        C_[j_] = *(const uint4*)(RU + (size_t)(chain * NCH + chunk_at(dir, r0_ + (cq_ >> 7))) * 16384 + 4096 + (vblk * 16 + ((cq_ >> 3) & 15)) * 64 + (cq_ & 7) * 8); } } while (0)
#define R2_ROUND(M_, C_, rnd_) do { \
    { const int row_ = tid >> 3, c8_ = tid & 7, sw_ = (row_ >> 1) & 7, u0_ = (c8_ >> 2) * 4 + (c8_ & 1) * 2, eh_ = ((c8_ >> 1) & 1) * 8; \
      _Pragma("unroll") for (int s_ = 0; s_ < R2_RS; ++s_) { char* sl_ = ring + s_ * 10240 + row_ * 128 + eh_; \
          *(uint2*)(sl_ + ((u0_ ^ sw_) * 16)) = make_uint2(M_[s_].x, M_[s_].y); *(uint2*)(sl_ + (((u0_ + 1) ^ sw_) * 16)) = make_uint2(M_[s_].z, M_[s_].w); } \
      _Pragma("unroll") for (int j_ = 0; j_ < 3; ++j_) { const int cq_ = tid + 512 * j_, rw_ = (cq_ >> 3) & 15, q8_ = cq_ & 7, i_ = q8_ >> 1, g0_ = (q8_ & 1) * 2, sc_ = (rw_ >> 1) & 7; \
          char* sl_ = ring + (cq_ >> 7) * 10240 + 8192 + rw_ * 128 + (i_ & 1) * 8; \
          *(uint2*)(sl_ + (((g0_ * 2 + (i_ >> 1)) ^ sc_) * 16)) = make_uint2(C_[j_].x, C_[j_].y); *(uint2*)(sl_ + ((((g0_ + 1) * 2 + (i_ >> 1)) ^ sc_) * 16)) = make_uint2(C_[j_].z, C_[j_].w); } } \
    R2_LOAD(M_, C_, (rnd_) + 2); \
    __syncthreads(); \
    if (wave == 0) { \
        _Pragma("unroll 4") for (int s_ = 0; s_ < R2_RS; ++s_) { \
            const int c_ = chunk_at(dir, (rnd_) * R2_RS + s_); const char* sl_ = ring + s_ * 10240; \
            unsigned pk_[4][2]; \
            _Pragma("unroll") for (int i_ = 0; i_ < 4; ++i_) { pk_[i_][0] = pack2bf(st[i_][0], st[i_][1]); pk_[i_][1] = pack2bf(st[i_][2], st[i_][3]); } \
            bf16_t* sp_ = S0G + ((size_t)(chain * NCH + c_) * 64 + vblk * 16 + l15) * 64 + g * 4; \
            _Pragma("unroll") for (int i_ = 0; i_ < 4; ++i_) *(uint2*)(sp_ + i_ * 16) = make_uint2(pk_[i_][0], pk_[i_][1]); \
            bf16x8 bfr_[2]; \
            _Pragma("unroll") for (int ks_ = 0; ks_ < 2; ++ks_) { const uint4 u_ = make_uint4(pk_[2 * ks_][0], pk_[2 * ks_][1], pk_[2 * ks_ + 1][0], pk_[2 * ks_ + 1][1]); bfr_[ks_] = __builtin_bit_cast(bf16x8, u_); } \
            const uint4 c01_ = *(const uint4*)(sl_ + 8192 + l15 * 128 + (((g * 2) ^ ((l15 >> 1) & 7)) * 16)), c23_ = *(const uint4*)(sl_ + 8192 + l15 * 128 + (((g * 2 + 1) ^ ((l15 >> 1) & 7)) * 16)); \
            const unsigned cw_[8] = {c01_.x, c01_.y, c01_.z, c01_.w, c23_.x, c23_.y, c23_.z, c23_.w}; \
            _Pragma("unroll") for (int i_ = 0; i_ < 4; ++i_) { \
                f32x4 acc_ = (f32x4){bflo(cw_[2 * i_]), bfhi(cw_[2 * i_]), bflo(cw_[2 * i_ + 1]), bfhi(cw_[2 * i_ + 1])}; \
                _Pragma("unroll") for (int ks_ = 0; ks_ < 2; ++ks_) { \
                    const int row_ = i_ * 16 + l15; \
                    const bf16x8 af_ = *(const bf16x8*)(sl_ + row_ * 128 + (((ks_ * 4 + g) ^ ((row_ >> 1) & 7)) * 16)); \
                    acc_ = __builtin_amdgcn_mfma_f32_16x16x32_bf16(af_, bfr_[ks_], acc_, 0, 0, 0); } \
                st[i_] = acc_; } } } \
    __syncthreads(); } while (0)
DEV void rwkv2_unit(const Params& p, int chain, int vblk, float* sm) {
    constexpr int R2_RS = 12, R2_NR = NCH / R2_RS;
    static_assert(R2_NR * R2_RS == NCH && R2_RS * 10240 <= LDS_BYTES, "R2 ring");
    const int tid = opaque_tid(), lane = tid & 63, wave = tid >> 6;
    const bf16_t* RU = (const bf16_t*)(p.ws + OFF_RU);
    bf16_t* S0G = (bf16_t*)(p.ws + OFF_RS0);
    char* ring = (char*)sm;
    const int dir = chain & 1, g = lane >> 4, l15 = lane & 15;
    f32x4 st[4];
#pragma unroll
    for (int i = 0; i < 4; ++i) st[i] = (f32x4){0.f, 0.f, 0.f, 0.f};
    uint4 ma[R2_RS], ca[3], mb[R2_RS], cb[3];
    __syncthreads();
    R2_LOAD(ma, ca, 0); R2_LOAD(mb, cb, 1);
#pragma unroll 1
    for (int rnd = 0; rnd < R2_NR; rnd += 2) {
        R2_ROUND(ma, ca, rnd);
        if (rnd + 1 < R2_NR) R2_ROUND(mb, cb, rnd + 1);
    }
}
#undef R2_LOAD
#undef R2_ROUND

DEV void rwkv3_unit(const Params& p, int h, int c, float* sm) {
    const int tid = opaque_tid(), lane = tid & 63, wave = tid >> 6;
    const bf16_t* P0 = (const bf16_t*)(p.ws + OFF_P0);
    const bf16_t* RUb = (const bf16_t*)(p.ws + OFF_RU);
    const bf16_t* S0G = (const bf16_t*)(p.ws + OFF_RS0);
    const float* BONS = (const float*)(p.ws + OFF_BONS);
    bf16_t* YC = (bf16_t*)(p.ws + OFF_YC);
    const float* mu = p.in[15]; const float* gn_g = p.in[27]; const float* gn_b = p.in[28];
    bf16_t* img = (bf16_t*)sm;
    float* O = sm + 4 * 2304;
    const int t = tid >> 3, v0 = (tid & 7) * 8, s = c * 64 + t;
    const size_t u0 = (size_t)((h * 2 + 0) * NCH + c), u1 = (size_t)((h * 2 + 1) * NCH + c);
    const uint4 gr0 = *(const uint4*)(RUb + u0 * 16384 + 8192 + t * 64 + v0), gs0 = *(const uint4*)(S0G + u0 * 4096 + t * 64 + v0);
    const uint4 gr1 = *(const uint4*)(RUb + u1 * 16384 + 8192 + t * 64 + v0), gs1 = *(const uint4*)(S0G + u1 * 4096 + t * 64 + v0);
    uint2 yl[2][2];
#pragma unroll
    for (int q = 0; q < 2; ++q) { const int idx = wave * 2 + q, ti = idx >> 2, tj = idx & 3;
        yl[q][0] = *(const uint2*)(RUb + u0 * 16384 + 12288 + (tj * 16 + (lane & 15)) * 64 + ti * 16 + (lane >> 4) * 4);
        yl[q][1] = *(const uint2*)(RUb + u1 * 16384 + 12288 + (tj * 16 + (lane & 15)) * 64 + ti * 16 + (lane >> 4) * 4); }
    const RwNb nbq = rw_nb(s);
    const RwRaw wv_ = rw_load(P0, s, nbq, 1024 + h * 64 + v0), wg_ = rw_load(P0, s, nbq, 1536 + h * 64 + v0);
    const float bon = BONS[(size_t)s * 8 + h] + BONS[((size_t)TB + s) * 8 + h];
    __syncthreads();
    *(uint4*)(img + 0 * 4608 + t * 72 + v0) = gr0; *(uint4*)(img + 2 * 4608 + t * 72 + v0) = gs0;
    *(uint4*)(img + 1 * 4608 + t * 72 + v0) = gr1; *(uint4*)(img + 3 * 4608 + t * 72 + v0) = gs1;
    __syncthreads();
#pragma unroll
    for (int q = 0; q < 2; ++q) {
        const int idx = wave * 2 + q, ti = idx >> 2, tj = idx & 3;
        f32x4 accd[2];
#pragma unroll
        for (int dir = 0; dir < 2; ++dir) {
            f32x4 acc = (f32x4){bflo(yl[q][dir].x), bfhi(yl[q][dir].x), bflo(yl[q][dir].y), bfhi(yl[q][dir].y)};
#pragma unroll
            for (int ks = 0; ks < 2; ++ks) acc = __builtin_amdgcn_mfma_f32_16x16x32_bf16(row_frag(img + dir * 4608, 72, ti * 16, ks * 32, lane), row_frag(img + (2 + dir) * 4608, 72, tj * 16, ks * 32, lane), acc, 0, 0, 0);
            accd[dir] = acc;
        }
#pragma unroll
        for (int r = 0; r < 4; ++r) {
            const int oi = (ti * 16 + (lane >> 4) * 4 + r) * 68 + tj * 16 + (lane & 15);
            O[oi] = accd[0][r] + accd[1][r];
        }
    }
    __syncthreads();
    {
        float y[8], sum = 0.f;
#pragma unroll
        for (int i = 0; i < 8; ++i) { y[i] = O[t * 68 + v0 + i]; sum += y[i]; }
        sum += __shfl_xor(sum, 1, 64); sum += __shfl_xor(sum, 2, 64); sum += __shfl_xor(sum, 4, 64);
        const float mean = sum * (1.f / 64.f);
        float sq = 0.f;
#pragma unroll
        for (int i = 0; i < 8; ++i) { y[i] -= mean; sq += y[i] * y[i]; }
        sq += __shfl_xor(sq, 1, 64); sq += __shfl_xor(sq, 2, 64); sq += __shfl_xor(sq, 4, 64);
        const float rstd = rsqrtf(sq * (1.f / 64.f) + 64e-5f);
        float vm[8], gm[8];
        rw_comb(wv_, nbq, mu, 1024 + h * 64 + v0, vm);
        rw_comb(wg_, nbq, mu, 1536 + h * 64 + v0, gm);
        float o[8];
#pragma unroll
        for (int i = 0; i < 8; ++i) o[i] = (y[i] * rstd * gn_g[h * 64 + v0 + i] + gn_b[h * 64 + v0 + i] + bon * vm[i]) * silu_f(gm[i]);
        *(uint4*)(YC + (size_t)s * 1024 + 512 + h * 64 + v0) = pack8(o);
    }
}

DEV void ln_rows(const float* src, const float* res_lat, const float* res_cx, int nrows, const float* __restrict__ g, const float* __restrict__ bt, float* dst_lat, float* dst_cx, int ncx,
                 bf16_t* hb = nullptr, const float* mvc = nullptr, const float* mvl = nullptr) {
    const int tid_ = opaque_tid(); const int lane = tid_ & 63, gw = blockIdx.x * NWV + (tid_ >> 6), ngw = gridDim.x * NWV;
    float4 gg[4], bb[4];
#pragma unroll
    for (int i = 0; i < 4; ++i) { gg[i] = ld4(g + i * 256 + lane * 4); bb[i] = ld4(bt + i * 256 + lane * 4); }
    float4 na[4], nr[4];
    { const int r = gw < nrows ? gw : 0; const float* x = src + (size_t)r * 1024; const float* xr = (r < ncx) ? (res_cx + (size_t)r * 1024) : (res_lat + (size_t)(r - ncx) * 1024);
#pragma unroll
      for (int i = 0; i < 4; ++i) { na[i] = ld4(x + i * 256 + lane * 4); nr[i] = ld4(xr + i * 256 + lane * 4); } }
    for (int r = gw; r < nrows; r += ngw) {
        float4 v[4];
        float sum = 0.f;
#pragma unroll
        for (int i = 0; i < 4; ++i) { const float4 a = na[i], rr = nr[i];
            v[i] = make_float4(ALPHA * rr.x + a.x, ALPHA * rr.y + a.y, ALPHA * rr.z + a.z, ALPHA * rr.w + a.w); sum += v[i].x + v[i].y + v[i].z + v[i].w; }
        { const int rn = (r + ngw < nrows) ? r + ngw : r; const float* x = src + (size_t)rn * 1024; const float* xr = (rn < ncx) ? (res_cx + (size_t)rn * 1024) : (res_lat + (size_t)(rn - ncx) * 1024);
#pragma unroll
          for (int i = 0; i < 4; ++i) { na[i] = ld4(x + i * 256 + lane * 4); nr[i] = ld4(xr + i * 256 + lane * 4); } }
        const float mean = wave_sum(sum) * (1.f / 1024.f);
        float sq = 0.f;
#pragma unroll
        for (int i = 0; i < 4; ++i) {
            v[i].x -= mean; v[i].y -= mean; v[i].z -= mean; v[i].w -= mean;
            sq += v[i].x * v[i].x + v[i].y * v[i].y + v[i].z * v[i].z + v[i].w * v[i].w;
        }
        const float rstd = rsqrtf(wave_sum(sq) * (1.f / 1024.f) + 1e-5f);
        float* d = (r < ncx) ? (dst_cx + (size_t)r * 1024) : (dst_lat + (size_t)(r - ncx) * 1024);
#pragma unroll
        for (int i = 0; i < 4; ++i) {
            const int c = i * 256 + lane * 4;
            const float4 y = make_float4(v[i].x * rstd * gg[i].x + bb[i].x, v[i].y * rstd * gg[i].y + bb[i].y, v[i].z * rstd * gg[i].z + bb[i].z, v[i].w * rstd * gg[i].w + bb[i].w);
            st4(d + c, y);
            if (hb != nullptr) {
                const float* m = (r < ncx) ? mvc : mvl;
                const float4 sh = ld4(m + c), sc = ld4(m + 1024 + c);
                *(uint2*)(hb + (size_t)r * 1024 + c) = make_uint2(pack2bf(y.x * (1.f + sc.x) + sh.x, y.y * (1.f + sc.y) + sh.y), pack2bf(y.z * (1.f + sc.z) + sh.z, y.w * (1.f + sc.w) + sh.w));
            }
        }
    }
}
DEV void phase_h1l(const Params& p) {
    const float* modv1 = (const float*)(p.ws + OFF_MODV) + 3 * 3072;
    bf16_t* H1 = (bf16_t*)(p.ws + OFF_H1B);
    const size_t gt = (size_t)blockIdx.x * NTHR + opaque_tid(), gn = (size_t)gridDim.x * NTHR;
    const int k = (int)(gt & 127) * 8;
    const Mod8 m0 = mod8_load(modv1, k), m1 = mod8_load(modv1 + 3072, k);
    constexpr size_t NI = (size_t)NB * NL * 128;
    for (size_t i0 = gt; i0 < NI; i0 += 4 * gn) {
        float4 xa[4], xb[4];
#pragma unroll
        for (int u = 0; u < 4; ++u) { const size_t i = i0 + u * gn, r = (i < NI ? i : gt) >> 7; xa[u] = ld4(p.out + r * DM + k); xb[u] = ld4(p.out + r * DM + k + 4); }
#pragma unroll
        for (int u = 0; u < 4; ++u) { const size_t i = i0 + u * gn, r = i >> 7; if (i < NI) *(uint4*)(H1 + r * DM + k) = mod8_apply(xa[u], xb[u], (r >= (size_t)NL) ? m1 : m0); }
    }
}

DEV void zero_f4(float* ptr, size_t nfloat) {
    const size_t n4 = nfloat / 4;
    for (size_t i = (size_t)blockIdx.x * NTHR + opaque_tid(); i < n4; i += (size_t)gridDim.x * NTHR) ((float4*)ptr)[i] = make_float4(0.f, 0.f, 0.f, 0.f);
}

DEV void chain_ids(int& chain, int& sub) {
    const int bid = blockIdx.x, xcd = bid & 7, idx = bid >> 3;
    chain = xcd * 2 + (idx >> 4); sub = idx & 15;
}

DEV void phase_conv1(const Params& p, float* sm) {
    const bf16_t* XM = (const bf16_t*)(p.ws + OFF_XM);
    bf16_t* XC = (bf16_t*)(p.ws + OFF_XC);
    float* G16P = (float*)(p.ws + OFF_G16P);
    const bf16_t* WFT = (const bf16_t*)(p.ws + OFF_WFT);
    const float* cw = p.in[31]; const float* cbias = p.in[32];
    bf16_t* imgC = (bf16_t*)sm;
    bf16_t* imgM = imgC + 64 * 264;
    float* red = (float*)(imgM + 64 * 264);
    float* cwl = red + 1024;
    const int tid = opaque_tid(), lane = tid & 63, wave = tid >> 6, t = tid >> 3, cg = tid & 7;
    for (int u = blockIdx.x; u < NB * NCH * 4; u += gridDim.x) {
        const int ci = u >> 2, q = u & 3, b = ci / NCH, c = ci % NCH, s = c * 64 + t;
        const size_t rowbase = (size_t)b * TB;
        int nrow[9]; unsigned vmask = 0u;
#pragma unroll
        for (int i = 0; i < 3; ++i)
#pragma unroll
            for (int j = 0; j < 3; ++j) {
                int ns = -1;
                if (s < NCX) { const int w2 = s + j - 1; if (i == 1 && w2 >= 0 && w2 < NCX) ns = w2; }
                else { const int n = s - NCX, rr = (n >> 6) + i - 1, w2 = (n & 63) + j - 1; if (rr >= 0 && rr < 128 && w2 >= 0 && w2 < 64) ns = NCX + rr * 64 + w2; }
                nrow[i * 3 + j] = ns >= 0 ? ns : s; vmask |= (ns >= 0 ? 1u : 0u) << (i * 3 + j);
            }
        const int tt = wave & 3, part = wave >> 2;
        f32x4 acc = (f32x4){0.f, 0.f, 0.f, 0.f};
        uint4 xn[9];
#pragma unroll
        for (int tap = 0; tap < 9; ++tap) xn[tap] = *(const uint4*)(XM + (rowbase + nrow[tap]) * 2048 + q * 512 + cg * 8);
#pragma unroll 1
        for (int half = 0; half < 2; ++half) {
            __syncthreads();
            for (int i = tid; i < 640; i += NTHR) { const int tp = i >> 6, c4 = (i & 63) * 4; st4(cwl + tp * 256 + c4, ld4((tp < 9 ? cw + tp * 2048 : cbias) + q * 512 + half * 256 + c4)); }
            __syncthreads();
#pragma unroll 1
            for (int it = 0; it < 4; ++it) {
                const int cl = it * 64 + cg * 8, c0 = q * 512 + half * 256 + cl;
                uint4 xc9[9];
#pragma unroll
                for (int tap = 0; tap < 9; ++tap) xc9[tap] = xn[tap];
                { const int gn = half * 4 + it + 1, c0n = q * 512 + (gn < 8 ? gn : 7) * 64 + cg * 8;
#pragma unroll
                  for (int tap = 0; tap < 9; ++tap) xn[tap] = *(const uint4*)(XM + (rowbase + nrow[tap]) * 2048 + c0n); }
                float a8[8];
                { const float4 b0 = ld4(cwl + 9 * 256 + cl), b1 = ld4(cwl + 9 * 256 + cl + 4); a8[0] = b0.x; a8[1] = b0.y; a8[2] = b0.z; a8[3] = b0.w; a8[4] = b1.x; a8[5] = b1.y; a8[6] = b1.z; a8[7] = b1.w; }
#pragma unroll
                for (int tap = 0; tap < 9; ++tap) {
                    const unsigned mk = ((vmask >> tap) & 1u) ? 0xffffffffu : 0u;
                    const uint4 xv = make_uint4(xc9[tap].x & mk, xc9[tap].y & mk, xc9[tap].z & mk, xc9[tap].w & mk);
                    float x8[8]; unpack8(xv, x8);
                    const float4 w0 = ld4(cwl + tap * 256 + cl), w1 = ld4(cwl + tap * 256 + cl + 4);
                    a8[0] += x8[0] * w0.x; a8[1] += x8[1] * w0.y; a8[2] += x8[2] * w0.z; a8[3] += x8[3] * w0.w;
                    a8[4] += x8[4] * w1.x; a8[5] += x8[5] * w1.y; a8[6] += x8[6] * w1.z; a8[7] += x8[7] * w1.w;
                }
#pragma unroll
                for (int i = 0; i < 8; ++i) a8[i] = silu_f(a8[i]);
                const uint4 xcv = pack8(a8);
                *(uint4*)(XC + (rowbase + s) * 2048 + c0) = xcv;
                *(uint4*)(imgC + t * 264 + cl) = xcv;
                *(uint4*)(imgM + t * 264 + cl) = xc9[4];
            }
            __syncthreads();
            {
                const bf16_t* img = part ? imgM : imgC;
                const bf16_t* wrow = WFT + (size_t)(lane & 15) * 4096 + part * 2048 + q * 512 + half * 256 + (lane >> 4) * 8;
#pragma unroll
                for (int ks = 0; ks < 8; ++ks) acc = __builtin_amdgcn_mfma_f32_16x16x32_bf16(row_frag(img, 264, tt * 16, ks * 32, lane), *(const bf16x8*)(wrow + ks * 32), acc, 0, 0, 0);
            }
        }
        if (part == 1) {
#pragma unroll
            for (int r = 0; r < 4; ++r) red[(tt * 16 + (lane >> 4) * 4 + r) * 16 + (lane & 15)] = acc[r];
        }
        __syncthreads();
        if (part == 0) {
#pragma unroll
            for (int r = 0; r < 4; ++r) {
                const int tk = tt * 16 + (lane >> 4) * 4 + r;
                G16P[(((size_t)rowbase + c * 64 + tk) * 16 + (lane & 15)) * 4 + q] = acc[r] + red[tk * 16 + (lane & 15)];
            }
        }
    }
}

struct GateRaw { float4 a, f; };
DEV GateRaw gate_load(const Params& p, size_t row, int dir, int h) {
    const float* G16P = (const float*)(p.ws + OFF_G16P);
    GateRaw g; g.a = ld4(G16P + (row * 16 + dir * 8 + h) * 4); g.f = ld4(G16P + (row * 16 + dir * 8 + 4 + h) * 4);
    return g;
}
DEV void gate_fin(const GateRaw& g, float bi, float bf, float& gi, float& lf) {
    gi = (g.a.x + g.a.y) + (g.a.z + g.a.w) + bi;
    lf = logsig_f((g.f.x + g.f.y) + (g.f.z + g.f.w) + bf);
}
DEV void gate_pair(const Params& p, size_t row, int dir, int h, float& gi, float& lf) {
    const GateRaw g = gate_load(p, row, dir, h);
    gate_fin(g, p.in[dir ? 41 : 37][h], p.in[dir ? 43 : 39][h], gi, lf);
}

DEV void phase_x1(const Params& p, float* sm) {
    int chain, sub; chain_ids(chain, sub);
    const int b = chain >> 3, h = (chain >> 1) & 3, dir = chain & 1;
    const bf16_t* XC = (const bf16_t*)(p.ws + OFF_XC);
    float* GSC = (float*)(p.ws + OFF_GSC); float* CSC = (float*)(p.ws + OFF_CSC); float* NBUF = (float*)(p.ws + OFF_NBUF);
    const float* gtab = (const float*)(p.ws + OFF_GTAB);
    bf16_t* SMAT = (bf16_t*)(p.ws + OFF_SMAT);
    const int tid = opaque_tid(), lane = tid & 63, wave = tid >> 6;
    float* sTot = sm; float* sRef = sm + 132; float* sM0 = sm + 264; float* sBeta = sm + 400;
    const float bias_i = p.in[dir ? 41 : 37][h], bias_f = p.in[dir ? 43 : 39][h];
    {
        GateRaw gn = gate_load(p, (size_t)b * TB + wave * 64 + lane, dir, h);
        for (int c = wave; c < NCH; c += NWV) {
            const GateRaw gc = gn;
            const int cn = (c + NWV < NCH) ? c + NWV : c;
            gn = gate_load(p, (size_t)b * TB + cn * 64 + lane, dir, h);
            float gi, lf; gate_fin(gc, bias_i, bias_f, gi, lf);
            const float bc = wave_scan_add(lf, lane, dir);
            const float ref = wave_max(gi - bc), tot = wave_sum(lf);
            if (lane == 0) { sTot[c] = tot; sRef[c] = ref; }
        }
    }
    __syncthreads();
    if (tid == 0) {
        float m0 = -INFINITY;
        for (int step = 0; step < NCH; ++step) {
            const int c = chunk_at(dir, step);
            sM0[c] = m0;
            const float mx = fmaxf(m0, sRef[c]);
            if (sub == 0) { CSC[(chain * NCH + c) * 2] = fexp(m0 - mx); CSC[(chain * NCH + c) * 2 + 1] = fexp(sRef[c] - mx); }
            m0 = sTot[c] + mx;
        }
    }
    __syncthreads();
    for (int k = wave; sub + 16 * k < NCH; k += NWV) {
        const int c = sub + 16 * k;
        const size_t row = (size_t)b * TB + c * 64 + lane;
        float gi, lf; gate_fin(gate_load(p, row, dir, h), bias_i, bias_f, gi, lf);
        const float bc = wave_scan_add(lf, lane, dir);
        const float a = gi - bc;
        const float amax = wave_scan_max(a, lane, dir);
        const float ref = sRef[c], m0 = sM0[c];
        const float mmax = fmaxf(amax, m0);
        const float mt = bc + mmax;
        const float alpha = fexp(ref - mmax), beta = fexp(a - ref), gg = fexp(m0 - mmax), em = fexp(-mt);
        st4(GSC + ((size_t)chain * TB + c * 64 + lane) * 4, make_float4(alpha, beta, gg, em));
        sBeta[k * 64 + lane] = beta;
    }
    __syncthreads();
    {
        float* part = sm + 1024;
        const int sg = tid >> 6, j8 = (tid & 63) * 8;
        uint4 xn[8];
        { const bf16_t* xp = XC + ((size_t)b * TB + sub * 64 + sg * 8) * 2048 + h * 512 + j8;
#pragma unroll
          for (int s = 0; s < 8; ++s) xn[s] = *(const uint4*)(xp + (size_t)s * 2048); }
        for (int k = 0; sub + 16 * k < NCH; ++k) {
            const int c = sub + 16 * k;
            uint4 xcur[8];
#pragma unroll
            for (int s = 0; s < 8; ++s) xcur[s] = xn[s];
            { const int cn = (c + 16 < NCH) ? c + 16 : c; const bf16_t* xp = XC + ((size_t)b * TB + cn * 64 + sg * 8) * 2048 + h * 512 + j8;
#pragma unroll
              for (int s = 0; s < 8; ++s) xn[s] = *(const uint4*)(xp + (size_t)s * 2048); }
            float acc[8];
#pragma unroll
            for (int i = 0; i < 8; ++i) acc[i] = 0.f;
#pragma unroll
            for (int s = 0; s < 8; ++s) {
                float f[8]; unpack8(xcur[s], f);
                const float be = sBeta[k * 64 + sg * 8 + s];
#pragma unroll
                for (int i = 0; i < 8; ++i) acc[i] += be * f[i];
            }
            __syncthreads();
            st4(part + sg * 512 + j8, make_float4(acc[0], acc[1], acc[2], acc[3])); st4(part + sg * 512 + j8 + 4, make_float4(acc[4], acc[5], acc[6], acc[7]));
            __syncthreads();
            float tot = 0.f;
#pragma unroll
            for (int q = 0; q < 8; ++q) tot += part[q * 512 + tid];
            NBUF[((size_t)chain * NCH + c) * 512 + tid] = tot;
        }
    }
    bf16_t* XCs = (bf16_t*)sm;
    bf16_t* Qs = XCs + 64 * 520;
    for (int u = blockIdx.x; u < NB * 4 * NCH; u += gridDim.x) {
        const int bh = u / NCH, c = u % NCH, ub = bh >> 2, uh = bh & 3;
        __syncthreads();
        float4 gq[2][4];
#pragma unroll
        for (int bb = 0; bb < 2; ++bb) { const float* G = gtab + (size_t)(uh * 128 + (tid & 63) * 2 + bb) * 16; gq[bb][0] = ld4(G); gq[bb][1] = ld4(G + 4); gq[bb][2] = ld4(G + 8); gq[bb][3] = ld4(G + 12); }
        uint4 xr[8];
#pragma unroll
        for (int i = 0; i < 8; ++i) { const int pp = tid + 512 * i, row = pp >> 6, c16 = pp & 63; xr[i] = *(const uint4*)(XC + ((size_t)ub * TB + c * 64 + row) * 2048 + uh * 512 + c16 * 8); }
#pragma unroll
        for (int i = 0; i < 8; ++i) {
            const int pp = tid + 512 * i, row = pp >> 6, c16 = pp & 63;
            const uint4 xv = xr[i];
            float f[8]; unpack8(xv, f);
            float q[8];
#pragma unroll
            for (int bb = 0; bb < 2; ++bb) {
                const float4 g0 = gq[bb][0], g1 = gq[bb][1], g2 = gq[bb][2], g3 = gq[bb][3];
                q[bb * 4 + 0] = f[bb * 4] * g0.x + f[bb * 4 + 1] * g1.x + f[bb * 4 + 2] * g2.x + f[bb * 4 + 3] * g3.x;
                q[bb * 4 + 1] = f[bb * 4] * g0.y + f[bb * 4 + 1] * g1.y + f[bb * 4 + 2] * g2.y + f[bb * 4 + 3] * g3.y;
                q[bb * 4 + 2] = f[bb * 4] * g0.z + f[bb * 4 + 1] * g1.z + f[bb * 4 + 2] * g2.z + f[bb * 4 + 3] * g3.z;
                q[bb * 4 + 3] = f[bb * 4] * g0.w + f[bb * 4 + 1] * g1.w + f[bb * 4 + 2] * g2.w + f[bb * 4 + 3] * g3.w;
            }
            *(uint4*)(XCs + row * 520 + c16 * 8) = xv;
            *(uint4*)(Qs + row * 520 + c16 * 8) = make_uint4(pack2bf(q[0], q[1]), pack2bf(q[2], q[3]), pack2bf(q[4], q[5]), pack2bf(q[6], q[7]));
        }
        __syncthreads();
        const int st = wave & 3, tt0 = (wave >> 2) * 2;
        f32x4 a0 = (f32x4){0.f, 0.f, 0.f, 0.f}, a1 = a0;
        const bf16_t* ap = XCs + (st * 16 + (lane & 15)) * 520 + (lane >> 4) * 8;
        const bf16_t* bp0 = Qs + (tt0 * 16 + (lane & 15)) * 520 + (lane >> 4) * 8;
        const bf16_t* bp1 = bp0 + 16 * 520;
#pragma unroll
        for (int ks = 0; ks < 16; ++ks) {
            const bf16x8 af = *(const bf16x8*)(ap + ks * 32);
            a0 = __builtin_amdgcn_mfma_f32_16x16x32_bf16(af, *(const bf16x8*)(bp0 + ks * 32), a0, 0, 0, 0);
            a1 = __builtin_amdgcn_mfma_f32_16x16x32_bf16(af, *(const bf16x8*)(bp1 + ks * 32), a1, 0, 0, 0);
        }
        bf16_t* sp = SMAT + (size_t)u * 4096 + (size_t)(tt0 * 16 + (lane & 15)) * 64 + st * 16 + (lane >> 4) * 4;
        *(uint2*)sp = make_uint2(pack2bf(a0[0], a0[1]), pack2bf(a0[2], a0[3]));
        *(uint2*)(sp + 16 * 64) = make_uint2(pack2bf(a1[0], a1[1]), pack2bf(a1[2], a1[3]));
    }
}

DEV void phase_x2(const Params& p, float* sm) {
    int chain, sub; chain_ids(chain, sub);
    const int b = chain >> 3, h = (chain >> 1) & 3, dir = chain & 1;
    const bf16_t* XC = (const bf16_t*)(p.ws + OFF_XC);
    float* GSC = (float*)(p.ws + OFF_GSC); const float* CSC = (const float*)(p.ws + OFF_CSC); const float* NBUF = (const float*)(p.ws + OFF_NBUF);
    const float* gtab = (const float*)(p.ws + OFF_GTAB);
    const bf16_t* SMAT = (const bf16_t*)(p.ws + OFF_SMAT);
    const int tid = opaque_tid();
    float* sD0 = sm; float* sCf = sm + 132; float* sN0 = sm + 264; float* sN2 = sN0 + 9 * 512;
    for (int i = tid; i < NCH; i += NTHR) { sD0[i] = CSC[(chain * NCH + i) * 2]; sCf[i] = CSC[(chain * NCH + i) * 2 + 1]; }
    __syncthreads();
    float* sBeta = sN2 + 9 * 512;
    for (int i = tid; i < 9 * 64; i += NTHR) { const int k = i >> 6, c = sub + 16 * k; if (c < NCH) sBeta[i] = GSC[((size_t)chain * TB + c * 64 + (i & 63)) * 4 + 1]; }
    if (tid < 128) {
        constexpr int NBT = 12;
        float4 n = make_float4(0.f, 0.f, 0.f, 0.f), nx[NBT];
        const float* nb = NBUF + (size_t)chain * NCH * 512 + tid * 4;
#pragma unroll
        for (int j = 0; j < NBT; ++j) nx[j] = ld4(nb + (size_t)chunk_at(dir, j) * 512);
#pragma unroll 1
        for (int step0 = 0; step0 < NCH; step0 += NBT) {
            float4 cu[NBT];
#pragma unroll
            for (int j = 0; j < NBT; ++j) cu[j] = nx[j];
#pragma unroll
            for (int j = 0; j < NBT; ++j) { const int sn = step0 + NBT + j; nx[j] = ld4(nb + (size_t)chunk_at(dir, sn < NCH ? sn : NCH - 1) * 512); }
            __builtin_amdgcn_sched_barrier(0);
#pragma unroll
            for (int j = 0; j < NBT; ++j) {
                const int c = chunk_at(dir, step0 + j);
                if ((c & 15) == sub) st4(sN0 + (c >> 4) * 512 + tid * 4, n);
                const float d = sD0[c], cf = sCf[c];
                n = make_float4(d * n.x + cf * cu[j].x, d * n.y + cf * cu[j].y, d * n.z + cf * cu[j].z, d * n.w + cf * cu[j].w);
            }
        }
    }
    __syncthreads();
    {
        const int blk = tid >> 2, cp = tid & 3;
        const float4 g = ld4(gtab + (size_t)(h * 128 + blk) * 16 + cp * 4);
        for (int k = 0; sub + 16 * k < NCH; ++k) {
            const float* n0 = sN0 + k * 512 + blk * 4;
            sN2[k * 512 + tid] = g.x * n0[0] + g.y * n0[1] + g.z * n0[2] + g.w * n0[3];
        }
    }
    __syncthreads();
    const int t = tid >> 3, part = tid & 7;
    for (int k = 0; sub + 16 * k < NCH; ++k) {
        const int c = sub + 16 * k;
        const size_t row = (size_t)b * TB + c * 64 + t;
        float dint = 0.f;
        {
            const bf16_t* xp = XC + row * 2048 + h * 512 + part * 64;
            const float* n2 = sN2 + k * 512 + part * 64;
#pragma unroll
            for (int i = 0; i < 8; ++i) {
                float f[8]; unpack8(*(const uint4*)(xp + i * 8), f);
                const float4 na = ld4(n2 + i * 8), nb2 = ld4(n2 + i * 8 + 4);
                dint += f[0] * na.x + f[1] * na.y + f[2] * na.z + f[3] * na.w + f[4] * nb2.x + f[5] * nb2.y + f[6] * nb2.z + f[7] * nb2.w;
            }
        }
        float di = 0.f;
        {
            float f[8]; unpack8(*(const uint4*)(SMAT + ((size_t)((b * 4 + h) * NCH + c)) * 4096 + t * 64 + part * 8), f);
#pragma unroll
            for (int e = 0; e < 8; ++e) {
                const int s = part * 8 + e;
                const float beta = sBeta[k * 64 + s];
                const bool keep = dir ? (s >= t) : (s <= t);
                di += keep ? f[e] * beta : 0.f;
            }
        }
        dint += __shfl_xor(dint, 1, 64); dint += __shfl_xor(dint, 2, 64); dint += __shfl_xor(dint, 4, 64);
        di += __shfl_xor(di, 1, 64); di += __shfl_xor(di, 2, 64); di += __shfl_xor(di, 4, 64);
        if (part == 0) {
            float* gp = GSC + ((size_t)chain * TB + c * 64 + t) * 4;
            const float4 g4 = ld4(gp);
            const float den = g4.x * di + g4.z * dint;
            gp[3] = 1.f / fmaxf(fabsf(den), g4.w);
        }
    }
}

#define MLSTM_PREFETCH(step_) do { \
    const int c_ = chunk_at(dir, (step_)); const size_t rb_ = (size_t)b * TB + (size_t)c_ * 64; \
    { const bf16_t* xb_ = XC + (rb_ + (tid >> 6)) * 2048 + h * 512 + (tid & 63) * 8; \
      rx0 = *(const uint4*)(xb_); rx1 = *(const uint4*)(xb_ + 8 * 2048); rx2 = *(const uint4*)(xb_ + 16 * 2048); rx3 = *(const uint4*)(xb_ + 24 * 2048); \
      rx4 = *(const uint4*)(xb_ + 32 * 2048); rx5 = *(const uint4*)(xb_ + 40 * 2048); rx6 = *(const uint4*)(xb_ + 48 * 2048); rx7 = *(const uint4*)(xb_ + 56 * 2048); } \
    rxm = *(const uint2*)(XM + (rb_ + ps) * 2048 + ch0 + pvb * 4); \
    rs = *(const uint4*)(SMAT + ((size_t)((b * 4 + h) * NCH + c_)) * 4096 + ps * 64 + pvb * 8); \
    rbeta = GSC[((size_t)chain * TB + c_ * 64 + ps) * 4 + 1]; \
    if (tid < 64) rsc = ld4(GSC + ((size_t)chain * TB + c_ * 64 + tid) * 4); \
    rd0 = CSC[(chain * NCH + c_) * 2]; rcf = CSC[(chain * NCH + c_) * 2 + 1]; } while (0)

DEV void phase_mlstm(const Params& p, float* sm) {
    int chain, sub; chain_ids(chain, sub);
    const int b = chain >> 3, h = (chain >> 1) & 3, dir = chain & 1;
    const bf16_t* XM = (const bf16_t*)(p.ws + OFF_XM);
    const bf16_t* XC = (const bf16_t*)(p.ws + OFF_XC);
    const bf16_t* SMAT = (const bf16_t*)(p.ws + OFF_SMAT);
    const float* GSC = (const float*)(p.ws + OFF_GSC); const float* CSC = (const float*)(p.ws + OFF_CSC);
    const float* gtab = (const float*)(p.ws + OFF_GTAB);
    bf16_t* H = (bf16_t*)(p.ws + OFF_H);
    const float* wv = p.in[35];
    char* smc = (char*)sm;
    bf16_t* XCs = (bf16_t*)smc;
    bf16_t* Cs = (bf16_t*)(smc + 66560);
    bf16_t* Vb = (bf16_t*)(smc + 66560 + 33280);
    bf16_t* Vw = Vb + 32 * 72;
    bf16_t* Sm = Vw + 32 * 72;
    float* Gs = (float*)(smc + 66560 + 33280 + 2 * 4608 + 9216);
    float* sc = Gs + 2048;
    const int tid = opaque_tid(), lane = tid & 63, wave = tid >> 6;
    for (int i = tid; i < 32 * 520 / 2; i += NTHR) ((unsigned*)Cs)[i] = 0u;
    for (int i = tid; i < 2048; i += NTHR) Gs[i] = gtab[h * 2048 + i];
    const int ps = tid >> 3, pvb = tid & 7;
    const int ch0 = h * 512 + sub * 32;
    float wvr[16];
#pragma unroll
    for (int i = 0; i < 16; ++i) wvr[i] = wv[(size_t)((ch0 >> 2) + pvb) * 16 + i];
    f32x4 accS[4][2];
#pragma unroll
    for (int i = 0; i < 4; ++i) { accS[i][0] = (f32x4){0.f, 0.f, 0.f, 0.f}; accS[i][1] = (f32x4){0.f, 0.f, 0.f, 0.f}; }
    uint4 rx0, rx1, rx2, rx3, rx4, rx5, rx6, rx7; uint2 rxm; uint4 rs; float rbeta; float4 rsc = make_float4(0.f, 0.f, 0.f, 0.f); float rd0, rcf;
    MLSTM_PREFETCH(0);
    __syncthreads();
#pragma unroll 1
    for (int step = 0; step < NCH; ++step) {
        const int c = chunk_at(dir, step);
        const float d0 = rd0, cf = rcf;
        {
            bf16_t* xd = XCs + (tid >> 6) * 520 + (tid & 63) * 8;
            *(uint4*)(xd) = rx0; *(uint4*)(xd + 8 * 520) = rx1; *(uint4*)(xd + 16 * 520) = rx2; *(uint4*)(xd + 24 * 520) = rx3;
            *(uint4*)(xd + 32 * 520) = rx4; *(uint4*)(xd + 40 * 520) = rx5; *(uint4*)(xd + 48 * 520) = rx6; *(uint4*)(xd + 56 * 520) = rx7;
        }
        {
            const float x0 = bflo(rxm.x), x1 = bfhi(rxm.x), x2 = bflo(rxm.y), x3 = bfhi(rxm.y);
#pragma unroll
            for (int d = 0; d < 4; ++d) {
                const float v = (x0 * wvr[d] + x1 * wvr[4 + d] + x2 * wvr[8 + d] + x3 * wvr[12 + d]) * rbeta;
                Vb[(pvb * 4 + d) * 72 + ps] = __builtin_bit_cast(unsigned short, (__bf16)v);
                Vw[(pvb * 4 + d) * 72 + ps] = __builtin_bit_cast(unsigned short, (__bf16)(v * cf));
            }
        }
        {
#define SMASK(q_) (((dir ? (pvb * 8 + 2 * (q_) >= ps) : (pvb * 8 + 2 * (q_) <= ps)) ? 0x0000ffffu : 0u) | ((dir ? (pvb * 8 + 2 * (q_) + 1 >= ps) : (pvb * 8 + 2 * (q_) + 1 <= ps)) ? 0xffff0000u : 0u))
            *(uint4*)(Sm + ps * 72 + pvb * 8) = make_uint4(rs.x & SMASK(0), rs.y & SMASK(1), rs.z & SMASK(2), rs.w & SMASK(3));
#undef SMASK
        }
        if (tid < 64) st4(sc + tid * 4, rsc);
        { const int nstep = (step + 1 < NCH) ? step + 1 : step; MLSTM_PREFETCH(nstep); }
        __syncthreads();
        {
            const int vt = wave & 1, tt = wave >> 1;
            f32x4 ao = (f32x4){0.f, 0.f, 0.f, 0.f}, ai = ao, ao1 = ao, ao2 = ao, ao3 = ao;
            const bf16_t* ap = Cs + (vt * 16 + (lane & 15)) * 520 + (lane >> 4) * 8;
            const bf16_t* bp = XCs + (tt * 16 + (lane & 15)) * 520 + (lane >> 4) * 8;
#pragma unroll
            for (int ks = 0; ks < 16; ks += 4) {
                ao = __builtin_amdgcn_mfma_f32_16x16x32_bf16(*(const bf16x8*)(ap + ks * 32), *(const bf16x8*)(bp + ks * 32), ao, 0, 0, 0);
                ao1 = __builtin_amdgcn_mfma_f32_16x16x32_bf16(*(const bf16x8*)(ap + (ks + 1) * 32), *(const bf16x8*)(bp + (ks + 1) * 32), ao1, 0, 0, 0);
                ao2 = __builtin_amdgcn_mfma_f32_16x16x32_bf16(*(const bf16x8*)(ap + (ks + 2) * 32), *(const bf16x8*)(bp + (ks + 2) * 32), ao2, 0, 0, 0);
                ao3 = __builtin_amdgcn_mfma_f32_16x16x32_bf16(*(const bf16x8*)(ap + (ks + 3) * 32), *(const bf16x8*)(bp + (ks + 3) * 32), ao3, 0, 0, 0);
            }
            ao = (ao + ao1) + (ao2 + ao3);
            const bf16_t* ap2 = Vb + (vt * 16 + (lane & 15)) * 72 + (lane >> 4) * 8;
            const bf16_t* bp2 = Sm + (tt * 16 + (lane & 15)) * 72 + (lane >> 4) * 8;
#pragma unroll
            for (int ks = 0; ks < 2; ++ks) ai = __builtin_amdgcn_mfma_f32_16x16x32_bf16(*(const bf16x8*)(ap2 + ks * 32), *(const bf16x8*)(bp2 + ks * 32), ai, 0, 0, 0);
            if (c >= 4) {
                const int t = tt * 16 + (lane & 15);
                const float4 s4 = ld4(sc + t * 4);
                const float h0 = (s4.x * ai[0] + s4.z * ao[0]) * s4.w, h1 = (s4.x * ai[1] + s4.z * ao[1]) * s4.w;
                const float h2 = (s4.x * ai[2] + s4.z * ao[2]) * s4.w, h3 = (s4.x * ai[3] + s4.z * ao[3]) * s4.w;
                bf16_t* hp = H + ((size_t)b * NL + (size_t)c * 64 + t - NCX) * 2048 + ch0 + vt * 16 + (lane >> 4) * 4;
                const unsigned u0 = pack2bf(h0, h1), u1 = pack2bf(h2, h3);
                __builtin_amdgcn_global_atomic_fadd_v2bf16((__attribute__((address_space(1))) s16x2*)hp, __builtin_bit_cast(s16x2, u0));
                __builtin_amdgcn_global_atomic_fadd_v2bf16((__attribute__((address_space(1))) s16x2*)(hp + 2), __builtin_bit_cast(s16x2, u1));
            }
        }
#pragma unroll
        for (int jt = 0; jt < 4; ++jt) { accS[jt][0] *= d0; accS[jt][1] *= d0; }
#pragma unroll
        for (int ks = 0; ks < 2; ++ks) {
            const bf16x8 b0 = *(const bf16x8*)(Vw + (lane & 15) * 72 + ks * 32 + (lane >> 4) * 8);
            const bf16x8 b1 = *(const bf16x8*)(Vw + (16 + (lane & 15)) * 72 + ks * 32 + (lane >> 4) * 8);
            const int row0 = ks * 32 + (lane >> 4) * 8 + ((lane & 15) >> 2);
#pragma unroll
            for (int jt = 0; jt < 4; ++jt) {
                const int col = wave * 64 + jt * 16 + (lane & 3) * 4;
                const s16x4 lo = __builtin_amdgcn_ds_read_tr16_b64_v4i16((__attribute__((address_space(3))) s16x4*)(XCs + row0 * 520 + col));
                const s16x4 hi = __builtin_amdgcn_ds_read_tr16_b64_v4i16((__attribute__((address_space(3))) s16x4*)(XCs + (row0 + 4) * 520 + col));
                const bf16x8 af = (bf16x8){lo[0], lo[1], lo[2], lo[3], hi[0], hi[1], hi[2], hi[3]};
                accS[jt][0] = __builtin_amdgcn_mfma_f32_16x16x32_bf16(af, b0, accS[jt][0], 0, 0, 0);
                accS[jt][1] = __builtin_amdgcn_mfma_f32_16x16x32_bf16(af, b1, accS[jt][1], 0, 0, 0);
            }
        }
        __syncthreads();
#pragma unroll
        for (int jt = 0; jt < 4; ++jt) {
            const int blk = wave * 16 + jt * 4 + (lane >> 4);
            const float4 g0 = ld4(Gs + blk * 16), g1 = ld4(Gs + blk * 16 + 4), g2 = ld4(Gs + blk * 16 + 8), g3 = ld4(Gs + blk * 16 + 12);
#pragma unroll
            for (int v2 = 0; v2 < 2; ++v2) {
                const f32x4 a = accS[jt][v2];
                const float o0 = g0.x * a[0] + g0.y * a[1] + g0.z * a[2] + g0.w * a[3];
                const float o1 = g1.x * a[0] + g1.y * a[1] + g1.z * a[2] + g1.w * a[3];
                const float o2 = g2.x * a[0] + g2.y * a[1] + g2.z * a[2] + g2.w * a[3];
                const float o3 = g3.x * a[0] + g3.y * a[1] + g3.z * a[2] + g3.w * a[3];
                *(uint2*)(Cs + (v2 * 16 + (lane & 15)) * 520 + blk * 4) = make_uint2(pack2bf(o0, o1), pack2bf(o2, o3));
            }
        }
    }
}

DEV void phase_finish1(const Params& p) {
    bf16_t* H = (bf16_t*)(p.ws + OFF_H);
    const bf16_t* XC = (const bf16_t*)(p.ws + OFF_XC);
    const bf16_t* Z = (const bf16_t*)(p.ws + OFF_XM);
    const float* ng = p.in[44]; const float* skip = p.in[45];
    const int tid_ = opaque_tid(); const int lane = tid_ & 63, gw = blockIdx.x * NWV + (tid_ >> 6), ngw = gridDim.x * NWV;
    const int h = gw & 3, c0 = h * 512 + lane * 8;
    float gn8[8], sk8[8];
    { const float4 a0 = ld4(ng + c0), a1 = ld4(ng + c0 + 4), b0 = ld4(skip + c0), b1 = ld4(skip + c0 + 4);
      gn8[0] = a0.x; gn8[1] = a0.y; gn8[2] = a0.z; gn8[3] = a0.w; gn8[4] = a1.x; gn8[5] = a1.y; gn8[6] = a1.z; gn8[7] = a1.w;
      sk8[0] = b0.x; sk8[1] = b0.y; sk8[2] = b0.z; sk8[3] = b0.w; sk8[4] = b1.x; sk8[5] = b1.y; sk8[6] = b1.z; sk8[7] = b1.w; }
    constexpr int NIT = NB * NL * 4;
    uint4 nh[2], nx[2], nz[2];
#pragma unroll
    for (int u = 0; u < 2; ++u) { const int it = gw + u * ngw, r = (it < NIT ? it : gw) >> 2, b = r >= NL ? 1 : 0, nn = r - b * NL;
        nh[u] = *(const uint4*)(H + (size_t)r * 2048 + c0); nx[u] = *(const uint4*)(XC + ((size_t)b * TB + NCX + nn) * 2048 + c0); nz[u] = *(const uint4*)(Z + (size_t)r * 2048 + c0); }
    for (int it0 = gw; it0 < NIT; it0 += 2 * ngw) {
        uint4 ch[2], cx[2], cz[2];
#pragma unroll
        for (int u = 0; u < 2; ++u) { ch[u] = nh[u]; cx[u] = nx[u]; cz[u] = nz[u]; }
#pragma unroll
        for (int u = 0; u < 2; ++u) { const int it = it0 + (2 + u) * ngw, r = (it < NIT ? it : gw) >> 2, b = r >= NL ? 1 : 0, nn = r - b * NL;
            nh[u] = *(const uint4*)(H + (size_t)r * 2048 + c0); nx[u] = *(const uint4*)(XC + ((size_t)b * TB + NCX + nn) * 2048 + c0); nz[u] = *(const uint4*)(Z + (size_t)r * 2048 + c0); }
#pragma unroll
        for (int u = 0; u < 2; ++u) {
            const int it = it0 + u * ngw, r = it >> 2;
            float v[8]; unpack8(ch[u], v);
            float sum = 0.f;
#pragma unroll
            for (int j = 0; j < 8; ++j) sum += v[j];
            const float mean = wave_sum(sum) * (1.f / 512.f);
            float sq = 0.f;
#pragma unroll
            for (int j = 0; j < 8; ++j) { v[j] -= mean; sq += v[j] * v[j]; }
            const float rstd = rsqrtf(wave_sum(sq) * (1.f / 512.f) + 1e-5f);
            float xc[8], z[8];
            unpack8(cx[u], xc); unpack8(cz[u], z);
            float o[8];
#pragma unroll
            for (int j = 0; j < 8; ++j) o[j] = (v[j] * rstd * gn8[j] + sk8[j] * xc[j]) * silu_f(z[j]);
            if (it < NIT) *(uint4*)(H + (size_t)r * 2048 + c0) = make_uint4(pack2bf(o[0], o[1]), pack2bf(o[2], o[3]), pack2bf(o[4], o[5]), pack2bf(o[6], o[7]));
        }
    }
}

__global__ void __launch_bounds__(NTHR) fwd_kernel(Params p) {
    extern __shared__ __attribute__((aligned(16))) float sm[];
    volatile LAS unsigned* xst = (volatile LAS unsigned*)((LAS char*)sm + (LDS_BYTES - 16));
    if (threadIdx.x == 0) { xst[0] = 0u; xst[1] = 0u; }
    __syncthreads();
    const XcdBarrier xbar = xcd_barrier_post((unsigned*)(p.ws + OFF_BAR), xst);
    const int tid = opaque_tid(), lane = tid & 63, wave = tid >> 6;
    float* modv = (float*)(p.ws + OFF_MODV);
    float* X1C = (float*)(p.ws + OFF_X1C);

    phase_mod(p, sm);
    phase_tables(p);
    transpose_convert(p.in[8], 1024, EIN, 4096, (bf16_t*)(p.ws + OFF_WT0), sm);
    transpose_convert(p.in[29], 1024, 4096, 4096, (bf16_t*)(p.ws + OFF_WT1), sm);
    transpose_convert(p.in[9], 1024, 1024, 1024, (bf16_t*)(p.ws + OFF_WT2), sm);
    transpose_convert(p.in[30], 2048, 1024, 1024, (bf16_t*)(p.ws + OFF_WT3), sm);
    xcd_barrier(xbar);

#pragma unroll 1
    for (int b = 0; b < NB; ++b) {
        if (b == 0) { phase_h0(p, 0); xcd_barrier(xbar); }
        run_gemm((const bf16_t*)(p.ws + OFF_YC), (const bf16_t*)(p.ws + OFF_WT0), TB, 3840, DM, EpBf16{(bf16_t*)(p.ws + OFF_P0), EIN, EIN}, sm);
        mini_gemm<3, 2>((const bf16_t*)(p.ws + OFF_YC), DM, 33 * (int)blockIdx.x, TB - 1, (const bf16_t*)(p.ws + OFF_WT0), DM, 3840, (bf16_t*)(p.ws + OFF_P0), EIN, 3840, 33, sm);
        xcd_barrier(xbar);
        {
            const int x = blockIdx.x & 7, q0 = blockIdx.x >> 3;
            R1Raw R;
            r1_consts(p, x, q0 & 1, sm);
            r1_load(p, x, q0 & 1, q0 >> 1, R);
            for (int q = q0; q < 2 * NCH; q += 32) rwkv1_unit(p, x, q & 1, q >> 1, sm, R, (q + 32 < 2 * NCH) ? ((q + 32) >> 1) : -1);
            gla_consts(p, x >> 1, sm);
            if (q0 < 8) { for (int g = 2 * q0; g < 2 * q0 + 2; ++g) gla1_unit(p, x >> 1, g & 1, (NCH / 2) * (x & 1) + (g >> 1), sm); }
            else { for (int g = 16 + (q0 - 8); g < NCH; g += 24) gla1_unit(p, x >> 1, g & 1, (NCH / 2) * (x & 1) + (g >> 1), sm); }
        }
        xcd_barrier(xbar);
        if (blockIdx.x < 128) gla2_unit(p, blockIdx.x);
        else if (blockIdx.x < 192) { const int i = (blockIdx.x - 128) >> 3; rwkv2_unit(p, (blockIdx.x & 7) * 2 + (i >> 2), i & 3, sm); }
        xcd_barrier(xbar);
        {
            const int x = blockIdx.x & 7, j = blockIdx.x >> 3;
            gla_consts(p, x >> 1, sm);
            const int r0 = j < 2 ? 2 * j : (j < 10 ? 4 + (j - 2) * 5 : 44 + (j - 10) * 4), nr = j < 2 ? 2 : (j < 10 ? 5 : 4);
            for (int r = r0; r < r0 + nr; ++r) rwkv3_unit(p, x, r, sm);
            for (int g = j; g < NCH / 2; g += 32) gla3_unit(p, x >> 1, (NCH / 2) * (x & 1) + g, sm);
        }
        xcd_barrier(xbar);
        run_gemm((const bf16_t*)(p.ws + OFF_YC), (const bf16_t*)(p.ws + OFF_WT2), TB, DM, DM, EpRes0{(float*)(p.ws + OFF_P0), modv, b}, sm);
        xcd_barrier(xbar);
        ln_rows((const float*)(p.ws + OFF_P0), p.in[0] + (size_t)b * NL * DM, p.in[2] + (size_t)b * NCX * DM, TB, p.in[6], p.in[7], p.out + (size_t)b * NL * DM, X1C + (size_t)b * NCX * DM, NCX,
                (bf16_t*)(p.ws + OFF_H1B) + (size_t)b * TB * DM, modv + (3 + 2) * 3072, modv + (3 + b) * 3072);
        if (b == 0) phase_h0(p, 1);
        xcd_barrier(xbar);
    }

    run_gemm((const bf16_t*)(p.ws + OFF_H1B), (const bf16_t*)(p.ws + OFF_WT1), RT, 2048, DM, EpBf16{(bf16_t*)(p.ws + OFF_XM), 2048, 2048}, sm);
    zero_f4((float*)(p.ws + OFF_H), (size_t)NB * NL * 1024);
    xcd_barrier(xbar);
    phase_conv1(p, sm);
    xcd_barrier(xbar);
    phase_x1(p, sm);
    xcd_barrier(xbar);
    phase_x2(p, sm);
    xcd_barrier(xbar);
    phase_mlstm(p, sm);
    xcd_barrier(xbar);
    phase_h1l(p);
    xcd_barrier(xbar);
    run_gemm((const bf16_t*)(p.ws + OFF_H1B), (const bf16_t*)(p.ws + OFF_WT1) + (size_t)2048 * 1024, NB * NL, 2048, DM, EpBf16{(bf16_t*)(p.ws + OFF_XM), 2048, 2048}, sm);
    xcd_barrier(xbar);
    phase_finish1(p);
    xcd_barrier(xbar);
    run_gemm((const bf16_t*)(p.ws + OFF_H), (const bf16_t*)(p.ws + OFF_WT3), NB * NL, DM, 2048, EpRes1{(float*)(p.ws + OFF_XC), modv + 3 * 3072}, sm);
    xcd_barrier(xbar);
    ln_rows((const float*)(p.ws + OFF_XC), p.out, p.out, NB * NL, p.in[6] + 1024, p.in[7] + 1024, p.out, p.out, 0);
}

extern "C" void kernel_launch(void* const* d_in, const int* in_sizes, int n_in, void* d_out, int out_size, void* d_ws, size_t ws_size, hipStream_t stream) {
    static int grid_blocks = 0;
    if (grid_blocks == 0) {
        if (ws_size < WS_NEED || n_in != 46) { fprintf(stderr, "kernel_launch: bad ws_size %zu (need %zu) or n_in %d\n", ws_size, (size_t)WS_NEED, n_in); grid_blocks = -1; return; }
        int dev = 0, cus = 0, per_cu = 0;
        (void)hipGetDevice(&dev);
        (void)hipDeviceGetAttribute(&cus, hipDeviceAttributeMultiprocessorCount, dev);
        (void)hipFuncSetAttribute((const void*)fwd_kernel, hipFuncAttributeMaxDynamicSharedMemorySize, LDS_BYTES);
        (void)hipOccupancyMaxActiveBlocksPerMultiprocessor(&per_cu, (const void*)fwd_kernel, NTHR, LDS_BYTES);
        if (per_cu < 1 || cus < 256) { fprintf(stderr, "kernel_launch: occupancy query says %d blocks/CU on %d CUs; this kernel needs 256 resident workgroups\n", per_cu, cus); grid_blocks = -1; return; }
        grid_blocks = 256;
    }
    if (grid_blocks < 0) return;
    (void)hipMemsetAsync((char*)d_ws + OFF_BAR, 0, XCD_BAR_WORDS * 4, stream);
    Params p{};
    for (int i = 0; i < 46; ++i) p.in[i] = (const float*)d_in[i];
    p.out = (float*)d_out; p.ws = (char*)d_ws;
    void* args[] = {&p};
    hipError_t e = hipLaunchCooperativeKernel((const void*)fwd_kernel, dim3(grid_blocks), dim3(NTHR), args, LDS_BYTES, stream);
    if (e != hipSuccess) fprintf(stderr, "cooperative launch failed: %s (grid %d)\n", hipGetErrorString(e), grid_blocks);
}
```

```cpp
#include <hip/hip_runtime.h>
#include <cstdio>
#include <cmath>

#define DEV __device__ __forceinline__

constexpr int NB = 2, NL = 8192, DM = 1024, NCX = 256, TB = NCX + NL;
constexpr int RT = NB * TB;
constexpr int NCH = TB / 64;
constexpr int EIN = 3872, RW0 = 1568;
constexpr int NTHR = 512, NWV = 8;
constexpr float ALPHA = 1.41421356237f;
constexpr float KSCALE = 0.04419417382f;

constexpr size_t OFF_MODV = 0;
constexpr size_t OFF_X1C  = 131072;
constexpr size_t OFF_BAR  = 3145728;
constexpr size_t OFF_BIG  = 4194304;
constexpr size_t OFF_P0   = OFF_BIG;
constexpr size_t OFF_YC   = OFF_BIG + (size_t)TB * EIN * 2;
constexpr size_t OFF_GDS  = OFF_YC + (size_t)TB * 1024 * 2;
constexpr size_t OFF_GDEC = OFF_GDS + (size_t)8 * NCH * 8192 * 4;
constexpr size_t OFF_RU   = OFF_GDEC + (size_t)8 * NCH * 64 * 4;
constexpr size_t OFF_RS0  = OFF_RU + (size_t)16 * NCH * 16384 * 2;
constexpr size_t OFF_BONS = OFF_RS0 + (size_t)16 * NCH * 4096 * 2;
constexpr size_t L0_END   = OFF_BONS + (size_t)2 * TB * 8 * 4;
constexpr size_t OFF_XM   = OFF_BIG;
constexpr size_t OFF_XC   = OFF_XM + (size_t)RT * 2048 * 2;
constexpr size_t OFF_H    = OFF_XC + (size_t)RT * 2048 * 2;
constexpr size_t OFF_WT0  = OFF_H + (size_t)NB * NL * 2048 * 2;
constexpr size_t OFF_WT1  = OFF_WT0 + (size_t)4096 * 1024 * 2;
constexpr size_t OFF_WT2  = OFF_WT1 + (size_t)4096 * 1024 * 2;
constexpr size_t OFF_WT3  = OFF_WT2 + (size_t)1024 * 1024 * 2;
constexpr size_t OFF_G16  = OFF_WT3 + (size_t)1024 * 2048 * 2;
constexpr size_t OFF_SMAT = OFF_G16 + (size_t)RT * 16 * 4;
constexpr size_t OFF_GSC  = OFF_SMAT + (size_t)NB * 4 * NCH * 4096 * 2;
constexpr size_t OFF_CSC  = OFF_GSC + (size_t)16 * TB * 4 * 4;
constexpr size_t OFF_NBUF = OFF_CSC + (size_t)16 * NCH * 2 * 4;
constexpr size_t OFF_GTAB = 3407872;
constexpr size_t OFF_WFT  = OFF_GTAB + (size_t)4 * 128 * 16 * 4;
static_assert(OFF_WFT + (size_t)16 * 4096 * 2 <= OFF_BIG, "low-region tables overflow");
constexpr size_t OFF_G16P = OFF_NBUF + (size_t)16 * NCH * 512 * 4;
constexpr size_t OFF_H1B  = OFF_G16;
constexpr size_t WS_NEED  = (OFF_G16P + (size_t)4 * RT * 16 * 4 > OFF_H1B + (size_t)RT * 1024 * 2) ? OFF_G16P + (size_t)4 * RT * 16 * 4 : OFF_H1B + (size_t)RT * 1024 * 2;
static_assert(WS_NEED <= (size_t)256 * 1024 * 1024, "workspace exceeds the guaranteed 256 MiB");

static_assert(L0_END <= OFF_WT0, "layer-0 buffers overlap the weight copies");
constexpr int LDS_BYTES = 139264;

struct Params { const float* in[46]; float* out; char* ws; };
typedef unsigned short bf16_t;
typedef __attribute__((ext_vector_type(8))) short bf16x8;
typedef __attribute__((ext_vector_type(4))) short s16x4;
typedef __attribute__((ext_vector_type(2))) short s16x2;
typedef __attribute__((ext_vector_type(4))) float f32x4;
typedef __attribute__((ext_vector_type(2))) __bf16 bf2_t;
DEV unsigned pack2bf(float lo, float hi) { bf2_t v; v[0] = (__bf16)lo; v[1] = (__bf16)hi; return __builtin_bit_cast(unsigned, v); }
DEV float bflo(unsigned u) { return __uint_as_float(u << 16); }
DEV float bfhi(unsigned u) { return __uint_as_float(u & 0xffff0000u); }
DEV float bf2f(bf16_t v) { return __uint_as_float(((unsigned)v) << 16); }
DEV void unpack8(uint4 u, float* f) { f[0] = bflo(u.x); f[1] = bfhi(u.x); f[2] = bflo(u.y); f[3] = bfhi(u.y); f[4] = bflo(u.z); f[5] = bfhi(u.z); f[6] = bflo(u.w); f[7] = bfhi(u.w); }

DEV float wave_sum(float v) {
#pragma unroll
    for (int o = 32; o > 0; o >>= 1) v += __shfl_xor(v, o, 64);
    return v;
}
DEV float wave_max(float v) {
#pragma unroll
    for (int o = 32; o > 0; o >>= 1) v = fmaxf(v, __shfl_xor(v, o, 64));
    return v;
}
DEV float fexp(float x) { return __expf(x); }
DEV float frcp(float x) { return __builtin_amdgcn_rcpf(x); }
DEV float sigmoid_f(float x) { return frcp(1.f + fexp(-x)); }
DEV float silu_f(float x) { return x * frcp(1.f + fexp(-x)); }
DEV float logsig_f(float x) { return fminf(x, 0.f) - __logf(1.f + fexp(-fabsf(x))); }
DEV float tanh_f(float x) { const float e = fexp(2.f * x); return 1.f - 2.f * frcp(e + 1.f); }
DEV void lds_fence() { asm volatile("" ::: "memory"); }
DEV int opaque_tid() { int t = threadIdx.x; asm volatile("" : "+v"(t)); return t; }
DEV int scan_s(int dir, int u) { return dir == 0 ? u : (u < NCX ? (NCX - 1 - u) : (TB - 1 + NCX - u)); }
DEV int chunk_at(int dir, int step) { return dir == 0 ? step : (step < 4 ? 3 - step : (NCH + 3 - step)); }
DEV float4 ld4(const float* p) { return *(const float4*)p; }
DEV void st4(float* p, float4 v) { *(float4*)p = v; }


#define XB_TMO      128
#define XB_XCNT(j)  (256  + 64 * (j))
#define XB_XSUB(j)  (1280 + 64 * (j))
#define XB_XGEN(j)  (2304 + 64 * (j))
#define XB_TOP      3328
#define XB_TOPGEN   3392
#define XCD_BAR_WORDS 3456
#define XB_SPIN_CAP (1u << 22)
#define LAS __attribute__((address_space(3)))
DEV unsigned xb_ld(unsigned* p) { return __hip_atomic_load(p, __ATOMIC_RELAXED, __HIP_MEMORY_SCOPE_AGENT); }
DEV unsigned xb_add(unsigned* p, unsigned v) { return __hip_atomic_fetch_add(p, v, __ATOMIC_RELAXED, __HIP_MEMORY_SCOPE_AGENT); }
DEV unsigned xb_xcc_id() { return (unsigned)__builtin_amdgcn_s_getreg((3 << 11) | 20) & 0xFu; }
#define XB_SPIN(cond, bar) do { unsigned _sp = 0; while (cond) { __builtin_amdgcn_s_sleep(1); \
    if ((++_sp & 255u) == 0u) { if (xb_ld(&(bar)[XB_TMO])) break; if (_sp > XB_SPIN_CAP) { atomicAdd(&(bar)[XB_TMO], 1u); break; } } } } while (0)
struct XcdBarrier { unsigned* bar; unsigned x; volatile LAS unsigned* st; };
DEV XcdBarrier xcd_barrier_post(unsigned* bar, volatile LAS unsigned* st) {
    XcdBarrier b; b.bar = bar; b.x = xb_xcc_id(); b.st = st;
    if (threadIdx.x == 0) (void)xb_add(&bar[XB_XCNT(b.x)], 1u);
    return b;
}
DEV void xcd_barrier_complete(unsigned* bar, unsigned x, unsigned& nloc, unsigned& nx) {
    const unsigned G = gridDim.x * gridDim.y * gridDim.z;
    unsigned sum, cnt, mine, sp = 0u;
    for (;;) {
        sum = 0u; cnt = 0u; mine = 0u;
#pragma unroll
        for (unsigned j = 0; j < 16; ++j) { const unsigned c = xb_ld(&bar[XB_XCNT(j)]); sum += c; cnt += (c > 0u) ? 1u : 0u; mine = (j == x) ? c : mine; }
        if (sum == G) break;
        __builtin_amdgcn_s_sleep(1);
        if ((++sp & 255u) == 0u) { if (xb_ld(&bar[XB_TMO])) break; if (sp > XB_SPIN_CAP) { atomicAdd(&bar[XB_TMO], 1u); break; } }
    }
    nloc = mine > 0u ? mine : 1u; nx = cnt > 0u ? cnt : 1u;
}
DEV void xcd_barrier(const XcdBarrier& b) {
    asm volatile("s_waitcnt vmcnt(0)" ::: "memory");
    __syncthreads();
    if (threadIdx.x == 0) {
        unsigned* bar = b.bar;
        __builtin_amdgcn_s_waitcnt(0);
        unsigned nloc = b.st[0], nx = b.st[1];
        if (nloc == 0u) { xcd_barrier_complete(bar, b.x, nloc, nx); b.st[0] = nloc; b.st[1] = nx; }
        const unsigned old = xb_add(&bar[XB_XSUB(b.x)], 1u);
        const unsigned gen = old / nloc;
        if (old + 1u == (gen + 1u) * nloc) {
            __builtin_amdgcn_fence(__ATOMIC_RELEASE, "agent");
            asm volatile("s_waitcnt vmcnt(0)" ::: "memory");
            const unsigned og = xb_add(&bar[XB_TOP], 1u);
            const unsigned tg = og / nx;
            if (og + 1u == (tg + 1u) * nx) xb_add(&bar[XB_TOPGEN], 1u);
            else XB_SPIN(xb_ld(&bar[XB_TOPGEN]) == tg, bar);
            __builtin_amdgcn_fence(__ATOMIC_ACQUIRE, "agent");
            xb_add(&bar[XB_XGEN(b.x)], 1u);
            asm volatile("s_waitcnt vmcnt(0)" ::: "memory");
        } else {
            XB_SPIN(xb_ld(&bar[XB_XGEN(b.x)]) == gen, bar);
            __builtin_amdgcn_fence(__ATOMIC_ACQUIRE, "agent");
            asm volatile("s_waitcnt vmcnt(0)" ::: "memory");
        }
    }
    __syncthreads();
}

namespace pg8 {
#define PG8_LAS __attribute__((address_space(3)))
typedef unsigned short bf16_t;
typedef short bf16x8 __attribute__((ext_vector_type(8)));
typedef float f32x4 __attribute__((ext_vector_type(4)));
typedef unsigned u32x4 __attribute__((ext_vector_type(4)));
constexpr int BM = 256, BK = 64, HALF = 128, HTB = HALF * BK * 2  , STAGE_BYTES = 8 * HTB, NXCD = 8, WGM = 8;

__host__ __device__ __forceinline__ int lds_byte(int r, int c) { const int st = (r >> 4) * 2 + (c >> 5), rr = r & 15, cc = c & 31, ob = rr * 64 + cc * 2; return st * 1024 + (ob ^ (((ob >> 9) & 1) << 5)); }
__host__ __device__ __forceinline__ void stage_rc(int b, int& R, int& C) { const int st = b / 1024, sb = b % 1024, swz = sb ^ (((sb >> 9) & 1) << 5); R = (st >> 1) * 16 + swz / 64; C = (st & 1) * 32 + (swz % 64) / 2; }
__host__ __device__ __forceinline__ int perm32(int rho) { const int n = rho >> 4, i = rho & 15; return 8 * (i >> 2) + 4 * n + (i & 3); }

struct Unit { int pm, pn; };
struct Gemm { const bf16_t* A; const bf16_t* Bt; int M, N, K; };

struct StaticOrder {
    int nM, nN, nwg, G, c;
    __host__ __device__ void init(int M, int N, int G_, int c_) { nM = M / BM; nN = N / BM; nwg = nM * nN; G = G_; c = c_; }
    __host__ __device__ bool next(int i, Unit& u) const {
        const long L = (long)i * G + c; if (L >= nwg) return false;
        int wgid = (int)L; { const int q = nwg / NXCD, r = nwg % NXCD, xcd = wgid % NXCD, off = wgid / NXCD; wgid = (xcd < r ? xcd * (q + 1) : r * (q + 1) + (xcd - r) * q) + off; }
        const int nig = WGM * nN, gid = wgid / nig, fm = gid * WGM, gsz = (nM - fm) < WGM ? (nM - fm) : WGM;
        u.pm = fm + ((wgid % nig) % gsz); u.pn = (wgid % nig) / gsz; return true;
    }
    __device__ __forceinline__ void a_ready(const Unit&) const {}
    __device__ __forceinline__ void done(const Unit&) const {}
};

template <class Epi, class Sched, bool STAMP = false>
__device__ __forceinline__ void gemm_phase(PG8_LAS unsigned char* lds, const Gemm g, const Sched& S, const Epi& E, unsigned long long* stamps) {
    int tid = threadIdx.x; asm volatile("" : "+v"(tid));
    const int wid = __builtin_amdgcn_readfirstlane(tid >> 6), lane = tid & 63, wr = wid >> 2, wc = wid & 3, fr = lane & 15, fq = lane >> 4;
    const int K = g.K, nt = K / BK;
#define PG8_STAMP() do { } while (0)
    PG8_STAMP();
    unsigned voffA[2], voffB[2];
#pragma unroll
    for (int i = 0; i < 2; ++i) { int R, C; stage_rc(tid * 16 + i * 8192, R, C); const int Rb = Epi::PERM ? ((R & ~31) + perm32(R & 31)) : R;
        voffA[i] = (unsigned)(R * K + C) * 2u; voffB[i] = (unsigned)(Rb * K + C) * 2u; }
    const size_t kstep = (size_t)(BK * 2);
    const size_t hstep = (size_t)HALF * K * 2;
    const size_t tstep = 2 * hstep;
    const unsigned ldsw = (unsigned)wid * 1024u;
    const int aoff = lds_byte(wr * 64 + fr, fq * 8), boff = lds_byte(wc * 32 + fr, fq * 8);
#define PG8_SA(b, h) (((b) * 2 + (h)) * HTB)
#define PG8_SB(b, h) ((4 + (b) * 2 + (h)) * HTB)
#define PG8_STAGE(bufoff, gbase, voff) do { _Pragma("unroll") for (int _i = 0; _i < 2; ++_i) \
        __builtin_amdgcn_global_load_lds((const unsigned*)((const char*)(gbase) + (voff)[_i]), (PG8_LAS unsigned*)(lds + (bufoff) + ldsw + _i * 8192), 16, 0, 0); } while (0)
#define PG8_LDA(dst, b, h) do { _Pragma("unroll") for (int m = 0; m < 4; ++m) _Pragma("unroll") for (int k = 0; k < 2; ++k) dst[m][k] = *(const PG8_LAS bf16x8*)(lds + PG8_SA(b, h) + aoff + m * 2048 + k * 1024); } while (0)
#define PG8_LDB(dst, b, h) do { _Pragma("unroll") for (int n = 0; n < 2; ++n) _Pragma("unroll") for (int k = 0; k < 2; ++k) dst[n][k] = *(const PG8_LAS bf16x8*)(lds + PG8_SB(b, h) + boff + n * 2048 + k * 1024); } while (0)
#define PG8_MMA(ai, bj, At, Bt) do { __builtin_amdgcn_s_setprio(1); _Pragma("unroll") for (int m = 0; m < 4; ++m) _Pragma("unroll") for (int n = 0; n < 2; ++n) _Pragma("unroll") for (int k = 0; k < 2; ++k) \
        acc[ai][bj][m][n] = __builtin_amdgcn_mfma_f32_16x16x32_bf16(Bt[n][k], At[m][k], acc[ai][bj][m][n], 0, 0, 0); __builtin_amdgcn_s_setprio(0); } while (0)
#define PG8_WAIT_V(n) asm volatile("s_waitcnt vmcnt(" #n ")" ::: "memory")
#define PG8_WAIT_L(n) asm volatile("s_waitcnt lgkmcnt(" #n ")" ::: "memory")
#define PG8_BAR __builtin_amdgcn_s_barrier()
#define PG8_SCHED __builtin_amdgcn_sched_barrier(0)
    Unit cur, nxt; int ui = 0;
    if (!S.next(0, cur)) return;
    f32x4 acc[2][2][4][2];
#pragma unroll
    for (int a = 0; a < 2; ++a)
#pragma unroll
        for (int b = 0; b < 2; ++b)
#pragma unroll
            for (int m = 0; m < 4; ++m)
#pragma unroll
                for (int n = 0; n < 2; ++n) acc[a][b][m][n] = (f32x4){0.f, 0.f, 0.f, 0.f};
    bf16x8 At[4][2], B0[2][2], B1[2][2];
    const char* cA = (const char*)g.A + (size_t)cur.pm * tstep; const char* cB = (const char*)g.Bt + (size_t)cur.pn * tstep;
    S.a_ready(cur);
    PG8_STAGE(PG8_SB(0, 0), cB, voffB); PG8_STAGE(PG8_SA(0, 0), cA, voffA); PG8_STAGE(PG8_SB(0, 1), cB + hstep, voffB); PG8_STAGE(PG8_SA(0, 1), cA + hstep, voffA);
    if (wr == 1) PG8_BAR;
    PG8_WAIT_V(4); PG8_BAR;
    PG8_STAGE(PG8_SB(1, 0), cB + kstep, voffB); PG8_STAGE(PG8_SA(1, 0), cA + kstep, voffA); PG8_STAGE(PG8_SB(1, 1), cB + hstep + kstep, voffB);
    PG8_WAIT_V(6); PG8_BAR;
    PG8_STAMP();
    for (;;) {
        const bool has_next = S.next(ui + 1, nxt);
        const char* nA = has_next ? (const char*)g.A + (size_t)nxt.pm * tstep : cA; const char* nB = has_next ? (const char*)g.Bt + (size_t)nxt.pn * tstep : cB;
        for (int t = 0; t < nt; t += 2) {
            const bool last = (t == nt - 2);
            const char* a1 = cA + (size_t)(t + 1) * kstep;
            const char* a2 = last ? nA : cA + (size_t)(t + 2) * kstep; const char* b2 = last ? nB : cB + (size_t)(t + 2) * kstep;
            const char* a3 = a2 + kstep; const char* b3 = b2 + kstep;
            if (last && has_next) S.a_ready(nxt);
            PG8_LDB(B0, 0, 0); PG8_SCHED; PG8_LDA(At, 0, 0); PG8_STAGE(PG8_SA(1, 1), a1 + hstep, voffA);
            PG8_WAIT_L(8); PG8_BAR; PG8_WAIT_L(0); PG8_MMA(0, 0, At, B0); PG8_BAR; PG8_SCHED;
            PG8_LDB(B1, 0, 1); PG8_STAGE(PG8_SB(0, 0), b2, voffB);
            PG8_BAR; PG8_WAIT_L(0); PG8_MMA(0, 1, At, B1); PG8_BAR;
            PG8_LDA(At, 0, 1); PG8_STAGE(PG8_SA(0, 0), a2, voffA);
            PG8_BAR; PG8_WAIT_L(0); PG8_MMA(1, 0, At, B0); PG8_BAR; PG8_SCHED;
            PG8_STAGE(PG8_SB(0, 1), b2 + hstep, voffB);
            PG8_WAIT_V(6); PG8_BAR; PG8_MMA(1, 1, At, B1); PG8_BAR;
            PG8_LDB(B0, 1, 0); PG8_SCHED; PG8_LDA(At, 1, 0); PG8_STAGE(PG8_SA(0, 1), a2 + hstep, voffA);
            PG8_WAIT_L(8); PG8_BAR; PG8_WAIT_L(0); PG8_MMA(0, 0, At, B0); PG8_BAR; PG8_SCHED;
            PG8_LDB(B1, 1, 1); PG8_STAGE(PG8_SB(1, 0), b3, voffB);
            PG8_BAR; PG8_WAIT_L(0); PG8_MMA(0, 1, At, B1); PG8_BAR;
            PG8_LDA(At, 1, 1); PG8_STAGE(PG8_SA(1, 0), a3, voffA);
            PG8_BAR; PG8_WAIT_L(0); PG8_MMA(1, 0, At, B0); PG8_BAR; PG8_SCHED;
            PG8_STAGE(PG8_SB(1, 1), b3 + hstep, voffB);
            PG8_WAIT_V(6); PG8_BAR; PG8_MMA(1, 1, At, B1); PG8_BAR;
        }
        PG8_STAMP();
        if constexpr (!Epi::AFTER_DRAIN) { E(acc, cur, wr, wc, fr, fq); S.done(cur); }
        PG8_STAMP();
        if (!has_next) break;
#pragma unroll
        for (int a = 0; a < 2; ++a)
#pragma unroll
            for (int b = 0; b < 2; ++b)
#pragma unroll
                for (int m = 0; m < 4; ++m)
#pragma unroll
                    for (int n = 0; n < 2; ++n) acc[a][b][m][n] = (f32x4){0.f, 0.f, 0.f, 0.f};
        cur = nxt; cA = nA; cB = nB; ++ui;
    }
    PG8_WAIT_V(0);
    if (wr == 0) PG8_BAR;
    PG8_BAR;
    if constexpr (Epi::AFTER_DRAIN) { E.fused(acc, cur, wr, wc, fr, fq, lds, wid, lane); S.done(cur); }
    PG8_STAMP();
#undef PG8_STAMP
#undef PG8_SA
#undef PG8_SB
#undef PG8_STAGE
#undef PG8_LDA
#undef PG8_LDB
#undef PG8_MMA
#undef PG8_WAIT_V
#undef PG8_WAIT_L
#undef PG8_BAR
#undef PG8_SCHED
}
}

DEV void transpose_convert(const float* __restrict__ W, int K, int N, int Npad, bf16_t* Wt, float* sm) {
    float (*T)[65] = (float (*)[65])sm;
    const int tid = opaque_tid();
    const int kt = K / 64, ntl = Npad / 64;
    for (int tile = blockIdx.x; tile < kt * ntl; tile += gridDim.x) {
        const int k0 = (tile / ntl) * 64, n0 = (tile % ntl) * 64;
        __syncthreads();
#pragma unroll
        for (int i = 0; i < 2; ++i) {
            const int k = (tid >> 4) + 32 * i, n4 = (tid & 15) * 4;
            float4 v = make_float4(0.f, 0.f, 0.f, 0.f);
            if (n0 + n4 < N) v = ld4(W + (size_t)(k0 + k) * N + n0 + n4);
            T[k][n4] = v.x; T[k][n4 + 1] = v.y; T[k][n4 + 2] = v.z; T[k][n4 + 3] = v.w;
        }
        __syncthreads();
        const int n = tid >> 3, kq = (tid & 7) * 8;
        unsigned o[4];
#pragma unroll
        for (int j = 0; j < 4; ++j) o[j] = pack2bf(T[kq + 2 * j][n], T[kq + 2 * j + 1][n]);
        bf16_t* dst = Wt + (size_t)(n0 + n) * K + k0 + kq;
        *(uint4*)dst = make_uint4(o[0], o[1], o[2], o[3]);
    }
}

struct EpBf16 {
    static constexpr bool PERM = true, AFTER_DRAIN = false;
    bf16_t* O; int ldc; int ncols;
    DEV void operator()(const pg8::f32x4 (&acc)[2][2][4][2], const pg8::Unit& u, int wr, int wc, int fr, int fq) const {
        const int row0 = u.pm * 256 + wr * 64 + fr, col0 = u.pn * 256 + wc * 32 + 8 * fq;
#pragma unroll
        for (int ai = 0; ai < 2; ++ai)
#pragma unroll
            for (int m = 0; m < 4; ++m) {
                bf16_t* rowp = O + (size_t)(row0 + ai * 128 + m * 16) * ldc + col0;
#pragma unroll
                for (int bj = 0; bj < 2; ++bj) {
                    if (col0 + bj * 128 < ncols) {
                        const pg8::f32x4 v0 = acc[ai][bj][m][0], v1 = acc[ai][bj][m][1];
                        *(uint4*)(rowp + bj * 128) = make_uint4(pack2bf(v0[0], v0[1]), pack2bf(v0[2], v0[3]), pack2bf(v1[0], v1[1]), pack2bf(v1[2], v1[3]));
                    }
                }
            }
    }
};
struct EpRes0 {
    static constexpr bool PERM = false, AFTER_DRAIN = false;
    float* C; const float* mv; int b;
    DEV void operator()(const pg8::f32x4 (&acc)[2][2][4][2], const pg8::Unit& u, int wr, int wc, int fr, int fq) const {
        const bool isc = (u.pm * 256 < NCX);
        const float* gp = mv + (isc ? 2 : b) * 3072 + 2048;
        const int row0 = u.pm * 256 + wr * 64 + fr, col0 = u.pn * 256 + wc * 32 + 4 * fq;
#pragma unroll
        for (int ai = 0; ai < 2; ++ai)
#pragma unroll
            for (int m = 0; m < 4; ++m) {
                const size_t ro = (size_t)(row0 + ai * 128 + m * 16) * DM + col0;
#pragma unroll
                for (int bj = 0; bj < 2; ++bj)
#pragma unroll
                    for (int n = 0; n < 2; ++n) {
                        const int co = bj * 128 + n * 16;
                        const float4 g = ld4(gp + col0 + co); const pg8::f32x4 v = acc[ai][bj][m][n];
                        st4(C + ro + co, make_float4(g.x * v[0], g.y * v[1], g.z * v[2], g.w * v[3]));
                    }
            }
    }
};
struct EpRes1 {
    static constexpr bool PERM = false, AFTER_DRAIN = false;
    float* C; const float* mv;
    DEV void operator()(const pg8::f32x4 (&acc)[2][2][4][2], const pg8::Unit& u, int wr, int wc, int fr, int fq) const {
        const float* gp = mv + (u.pm * 256 >= NL ? 1 : 0) * 3072 + 2048;
        const int row0 = u.pm * 256 + wr * 64 + fr, col0 = u.pn * 256 + wc * 32 + 4 * fq;
#pragma unroll
        for (int ai = 0; ai < 2; ++ai)
#pragma unroll
            for (int m = 0; m < 4; ++m) {
                const size_t ro = (size_t)(row0 + ai * 128 + m * 16) * DM + col0;
#pragma unroll
                for (int bj = 0; bj < 2; ++bj)
#pragma unroll
                    for (int n = 0; n < 2; ++n) {
                        const int co = bj * 128 + n * 16;
                        const float4 g = ld4(gp + col0 + co); const pg8::f32x4 v = acc[ai][bj][m][n];
                        st4(C + ro + co, make_float4(g.x * v[0], g.y * v[1], g.z * v[2], g.w * v[3]));
                    }
            }
    }
};
template <class EP>
DEV void run_gemm(const bf16_t* A, const bf16_t* Bt, int M, int N, int K, const EP& ep, float* sm) {
    pg8::Gemm g{A, Bt, M, N, K}; pg8::StaticOrder S; S.init(M, N, (int)gridDim.x, (int)blockIdx.x);
    pg8::gemm_phase<EP, pg8::StaticOrder, false>((PG8_LAS unsigned char*)sm, g, S, ep, nullptr);
}

template <int MT, int NT>
DEV void mini_gemm(const bf16_t* A, int lda, int row0, int row_clamp, const bf16_t* Bt, int ldb, int brow0, bf16_t* C, int ldc, int ccol0, int nvalid, float* sm) {
    const int tid = opaque_tid(), lane = tid & 63, wave = tid >> 6, l15 = lane & 15, g = lane >> 4;
    f32x4 acc[MT][NT];
#pragma unroll
    for (int m = 0; m < MT; ++m)
#pragma unroll
        for (int n = 0; n < NT; ++n) acc[m][n] = (f32x4){0.f, 0.f, 0.f, 0.f};
    const bf16_t* ap[MT]; const bf16_t* bp[NT];
#pragma unroll
    for (int m = 0; m < MT; ++m) { const int r = row0 + m * 16 + l15; ap[m] = A + (size_t)(r < row_clamp ? r : row_clamp) * lda + wave * 128 + g * 8; }
#pragma unroll
    for (int n = 0; n < NT; ++n) bp[n] = Bt + (size_t)(brow0 + n * 16 + l15) * ldb + wave * 128 + g * 8;
#pragma unroll
    for (int kh = 0; kh < 2; ++kh) {
        bf16x8 af[2][MT], bq[2][NT];
#pragma unroll
        for (int ks = 0; ks < 2; ++ks) {
#pragma unroll
            for (int m = 0; m < MT; ++m) af[ks][m] = *(const bf16x8*)(ap[m] + (kh * 2 + ks) * 32);
#pragma unroll
            for (int n = 0; n < NT; ++n) bq[ks][n] = *(const bf16x8*)(bp[n] + (kh * 2 + ks) * 32);
        }
#pragma unroll
        for (int ks = 0; ks < 2; ++ks)
#pragma unroll
            for (int m = 0; m < MT; ++m)
#pragma unroll
                for (int n = 0; n < NT; ++n) acc[m][n] = __builtin_amdgcn_mfma_f32_16x16x32_bf16(af[ks][m], bq[ks][n], acc[m][n], 0, 0, 0);
    }
    __syncthreads();
#pragma unroll
    for (int m = 0; m < MT; ++m)
#pragma unroll
        for (int n = 0; n < NT; ++n) st4(sm + ((wave * MT + m) * NT + n) * 256 + lane * 4, make_float4(acc[m][n][0], acc[m][n][1], acc[m][n][2], acc[m][n][3]));
    __syncthreads();
    for (int e = tid; e < MT * NT * 256; e += NTHR) {
        const int tile = e >> 8, idx = e & 255, ln = idx >> 2, r = idx & 3;
        float s = 0.f;
#pragma unroll
        for (int w = 0; w < NWV; ++w) s += sm[(w * MT * NT + tile) * 256 + idx];
        const int i = (tile / NT) * 16 + (ln >> 4) * 4 + r, j = (tile % NT) * 16 + (ln & 15);
        if (i < nvalid) C[(size_t)(row0 + i) * ldc + ccol0 + j] = __builtin_bit_cast(unsigned short, (__bf16)s);
    }
}

struct Mod8 { float4 s0, s1, c0, c1; };
DEV Mod8 mod8_load(const float* m, int k) { Mod8 q; q.s0 = ld4(m + k); q.s1 = ld4(m + k + 4); q.c0 = ld4(m + 1024 + k); q.c1 = ld4(m + 1024 + k + 4); return q; }
DEV uint4 mod8_apply(const float4 x0, const float4 x1, const Mod8& q) {
    return make_uint4(pack2bf(x0.x * (1.f + q.c0.x) + q.s0.x, x0.y * (1.f + q.c0.y) + q.s0.y), pack2bf(x0.z * (1.f + q.c0.z) + q.s0.z, x0.w * (1.f + q.c0.w) + q.s0.w),
                      pack2bf(x1.x * (1.f + q.c1.x) + q.s1.x, x1.y * (1.f + q.c1.y) + q.s1.y), pack2bf(x1.z * (1.f + q.c1.z) + q.s1.z, x1.w * (1.f + q.c1.w) + q.s1.w));
}
DEV void phase_h0(const Params& p, int b) {
    const float* modv = (const float*)(p.ws + OFF_MODV);
    bf16_t* H0 = (bf16_t*)(p.ws + OFF_YC);
    const int gt = blockIdx.x * NTHR + opaque_tid(), gn = gridDim.x * NTHR;
    const int k = (gt & 127) * 8;
    const Mod8 mc = mod8_load(modv + 2 * 3072, k), ml = mod8_load(modv + b * 3072, k);
    for (int i0 = gt; i0 < TB * 128; i0 += 4 * gn) {
        float4 xa[4], xb[4];
#pragma unroll
        for (int u = 0; u < 4; ++u) {
            const int i = i0 + u * gn, s = (i < TB * 128 ? i : gt) >> 7;
            const float* src = (s < NCX) ? p.in[2] + ((size_t)(b * NCX + s)) * DM + k : p.in[0] + ((size_t)(b * NL + s - NCX)) * DM + k;
            xa[u] = ld4(src); xb[u] = ld4(src + 4);
        }
#pragma unroll
        for (int u = 0; u < 4; ++u) {
            const int i = i0 + u * gn, s = i >> 7;
            if (i < TB * 128) *(uint4*)(H0 + (size_t)s * DM + k) = mod8_apply(xa[u], xb[u], (s < NCX) ? mc : ml);
        }
    }
}

DEV void phase_mod(const Params& p, float* sm) {
    const float* c = p.in[1]; const float* cctx = p.in[3];
    const float* mod_w = p.in[4]; const float* mod_b = p.in[5];
    float* modv = (float*)(p.ws + OFF_MODV);
    float* sil = sm; float* red = sm + 3072;
    const int tid = opaque_tid();
    for (int i = tid; i < 3072; i += NTHR) {
        const int j = i >> 10, k = i & 1023;
        const float v = (j < 2) ? c[j * 1024 + k] : cctx[k];
        sil[i] = silu_f(v);
    }
    __syncthreads();
    for (int unit = blockIdx.x; unit < 192; unit += gridDim.x) {
        const int l = unit / 96, cb = unit % 96;
        const int kg = tid >> 5, col = tid & 31, n = cb * 32 + col;
        const float* w = mod_w + (size_t)l * 1024 * 3072 + n;
        float a0 = 0.f, a1 = 0.f, a2 = 0.f;
        for (int k = kg * 64; k < kg * 64 + 64; ++k) {
            const float wv = w[(size_t)k * 3072];
            a0 += sil[k] * wv; a1 += sil[1024 + k] * wv; a2 += sil[2048 + k] * wv;
        }
        red[(kg * 3 + 0) * 32 + col] = a0; red[(kg * 3 + 1) * 32 + col] = a1; red[(kg * 3 + 2) * 32 + col] = a2;
        __syncthreads();
        if (tid < 96) {
            const int j = tid >> 5, cc = tid & 31, nn = cb * 32 + cc;
            float s = mod_b[l * 3072 + nn];
            for (int g = 0; g < 16; ++g) s += red[(g * 3 + j) * 32 + cc];
            modv[(l * 3 + j) * 3072 + nn] = s;
        }
        __syncthreads();
    }
}

DEV void phase_tables(const Params& p) {
    const float* wq = p.in[33]; const float* wk = p.in[34]; const float* wv = p.in[35];
    const float* gw0 = p.in[36]; const float* gw1 = p.in[38]; const float* gw2 = p.in[40]; const float* gw3 = p.in[42];
    float* gtab = (float*)(p.ws + OFF_GTAB); bf16_t* wft = (bf16_t*)(p.ws + OFF_WFT);
    const int gt = blockIdx.x * NTHR + opaque_tid(), gn = gridDim.x * NTHR;
    for (int i = gt; i < 512 * 16; i += gn) {
        const int gb = i >> 4, cp = (i >> 2) & 3, c = i & 3;
        float s = 0.f;
#pragma unroll
        for (int d = 0; d < 4; ++d) s += wq[gb * 16 + cp * 4 + d] * wk[gb * 16 + c * 4 + d];
        gtab[i] = s * KSCALE;
    }
    for (int i = gt; i < 4096 * 16; i += gn) {
        const int g = i >> 12, k = i & 4095, gm = g >> 2, hd = g & 3;
        const float* wg = gm == 0 ? gw0 : (gm == 1 ? gw1 : (gm == 2 ? gw2 : gw3));
        float s = 0.f;
        if (k < 2048) {
            const int blk = k >> 2, cc = k & 3;
#pragma unroll
            for (int d = 0; d < 4; ++d) s += wq[blk * 16 + cc * 4 + d] * wg[(size_t)(4 * blk + d) * 4 + hd] + wk[blk * 16 + cc * 4 + d] * wg[(size_t)(2048 + 4 * blk + d) * 4 + hd];
        } else {
            const int kk = k - 2048, blk = kk >> 2, cc = kk & 3;
#pragma unroll
            for (int d = 0; d < 4; ++d) s += wv[blk * 16 + cc * 4 + d] * wg[(size_t)(4096 + 4 * blk + d) * 4 + hd];
        }
        wft[i] = __builtin_bit_cast(unsigned short, (__bf16)s);
    }
}

DEV float wave_scan_add(float v, int lane, int dir) {
#pragma unroll
    for (int o = 1; o < 64; o <<= 1) {
        const float n = dir ? __shfl_down(v, o, 64) : __shfl_up(v, o, 64);
        const bool ok = dir ? (lane + o < 64) : (lane >= o);
        if (ok) v += n;
    }
    return v;
}
DEV float wave_scan_max(float v, int lane, int dir) {
#pragma unroll
    for (int o = 1; o < 64; o <<= 1) {
        const float n = dir ? __shfl_down(v, o, 64) : __shfl_up(v, o, 64);
        const bool ok = dir ? (lane + o < 64) : (lane >= o);
        if (ok) v = fmaxf(v, n);
    }
    return v;
}

constexpr int GLC_OFF = 30336;
static_assert((GLC_OFF + 2176) * 4 <= LDS_BYTES - 16, "GLA constants must fit below the barrier words");
DEV void gla_consts(const Params& p, int h, float* sm) {
    const int tid = opaque_tid();
    float* sWA2 = sm + GLC_OFF; float* sBA2 = sWA2 + 2048;
    __syncthreads();
    for (int i = tid; i < 2048; i += NTHR) { const int d = i >> 10, ii = (i >> 6) & 15, k = i & 63; sWA2[i] = p.in[d ? 12 : 10][ii * 256 + h * 64 + k]; }
    if (tid < 128) sBA2[tid] = p.in[(tid >> 6) ? 13 : 11][h * 64 + (tid & 63)];
}
DEV void gla_decay_core(const float* sLRd, const float* sWAd, const float* sBAd, float* sBC, float* sTot, int dir, int tid) {
    {
        const int t = tid >> 3, k0 = (tid & 7) * 8;
        float acc[8];
#pragma unroll
        for (int j = 0; j < 8; ++j) acc[j] = sBAd[k0 + j];
#pragma unroll
        for (int ii = 0; ii < 16; ++ii) {
            const float l = sLRd[t * 16 + ii];
#pragma unroll
            for (int j = 0; j < 8; ++j) acc[j] += l * sWAd[ii * 64 + k0 + j];
        }
#pragma unroll
        for (int j = 0; j < 8; ++j) sBC[t * 65 + k0 + j] = logsig_f(acc[j]) * 0.0625f;
    }
    __syncthreads();
    {
        const int lane = tid & 63, wv = tid >> 6;
#pragma unroll
        for (int j = 0; j < 8; ++j) {
            const int k = wv * 8 + j;
            const float v = wave_scan_add(sBC[lane * 65 + k], lane, dir);
            sBC[lane * 65 + k] = v;
            if (lane == (dir ? 0 : 63)) sTot[k] = v;
        }
    }
    __syncthreads();
}

DEV bf16x8 tr_frag(const bf16_t* base, int ld, int row0, int col0, int lane) {
    const bf16_t* ptr = base + (row0 + (lane >> 4) * 8 + ((lane & 15) >> 2)) * ld + col0 + (lane & 3) * 4;
    const s16x4 lo = __builtin_amdgcn_ds_read_tr16_b64_v4i16((__attribute__((address_space(3))) s16x4*)ptr);
    const s16x4 hi = __builtin_amdgcn_ds_read_tr16_b64_v4i16((__attribute__((address_space(3))) s16x4*)(ptr + 4 * ld));
    return (bf16x8){lo[0], lo[1], lo[2], lo[3], hi[0], hi[1], hi[2], hi[3]};
}
DEV bf16x8 row_frag(const bf16_t* base, int ld, int idx0, int k0, int lane) {
    return *(const bf16x8*)(base + (idx0 + (lane & 15)) * ld + k0 + (lane >> 4) * 8);
}

DEV void gla1_unit(const Params& p, int h, int dir, int c, float* sm) {
    const int tid = opaque_tid(), lane = tid & 63, wave = tid >> 6;
    const bf16_t* P0 = (const bf16_t*)(p.ws + OFF_P0);
    float* GDS = (float*)(p.ws + OFF_GDS); float* GDEC = (float*)(p.ws + OFF_GDEC);
    float* sLR = sm; float* sBC = sm + 2048; float* sTot = sm + 6208;
    bf16_t* kT = (bf16_t*)(sm + 6272);
    bf16_t* Vs = (bf16_t*)(sm + 8576);
    const int ch = h * 2 + dir;
    const int t = tid >> 3, k0 = (tid & 7) * 8;
    const uint4 lrq = *(const uint4*)(P0 + (size_t)(c * 64 + ((tid & 127) >> 1)) * EIN + 1536 + dir * 16 + (tid & 1) * 8);
    const uint4 kq = *(const uint4*)(P0 + (size_t)(c * 64 + t) * EIN + 256 + h * 64 + k0);
    const uint4 vq0 = *(const uint4*)(P0 + (size_t)(c * 64 + (tid >> 4)) * EIN + 512 + h * 128 + (tid & 15) * 8);
    const uint4 vq1 = *(const uint4*)(P0 + (size_t)(c * 64 + 32 + (tid >> 4)) * EIN + 512 + h * 128 + (tid & 15) * 8);
    __syncthreads();
    if (tid < 128) { float* d = sLR + (tid >> 1) * 16 + (tid & 1) * 8; st4(d, make_float4(bflo(lrq.x), bfhi(lrq.x), bflo(lrq.y), bfhi(lrq.y))); st4(d + 4, make_float4(bflo(lrq.z), bfhi(lrq.z), bflo(lrq.w), bfhi(lrq.w))); }
    *(uint4*)(Vs + (tid >> 4) * 136 + (tid & 15) * 8) = vq0; *(uint4*)(Vs + (32 + (tid >> 4)) * 136 + (tid & 15) * 8) = vq1;
    __syncthreads();
    gla_decay_core(sLR, sm + GLC_OFF + dir * 1024, sm + GLC_OFF + 2048 + dir * 64, sBC, sTot, dir, tid);
    {
        float kv[8]; unpack8(kq, kv);
#pragma unroll
        for (int j = 0; j < 8; ++j) kT[(k0 + j) * 72 + t] = __builtin_bit_cast(unsigned short, (__bf16)(kv[j] * fexp(sTot[k0 + j] - sBC[t * 65 + k0 + j])));
    }
    __syncthreads();
    {
        f32x4 acc[4];
#pragma unroll
        for (int kt = 0; kt < 4; ++kt) acc[kt] = (f32x4){0.f, 0.f, 0.f, 0.f};
#pragma unroll
        for (int ks = 0; ks < 2; ++ks) {
            const bf16x8 af = tr_frag(Vs, 136, ks * 32, wave * 16, lane);
#pragma unroll
            for (int kt = 0; kt < 4; ++kt) acc[kt] = __builtin_amdgcn_mfma_f32_16x16x32_bf16(af, row_frag(kT, 72, kt * 16, ks * 32, lane), acc[kt], 0, 0, 0);
        }
#pragma unroll
        for (int kt = 0; kt < 4; ++kt) {
            const int k = kt * 16 + (lane & 15), v = wave * 16 + (lane >> 4) * 4;
            st4(GDS + ((size_t)(ch * NCH + c) * 64 + k) * 128 + v, make_float4(acc[kt][0], acc[kt][1], acc[kt][2], acc[kt][3]));
        }
    }
    if (tid < 64) GDEC[(size_t)(ch * NCH + c) * 64 + tid] = fexp(sTot[tid]);
}

DEV void gla2_unit(const Params& p, int unit) {
    const int tid = opaque_tid();
    float* GDS = (float*)(p.ws + OFF_GDS); const float* GDEC = (const float*)(p.ws + OFF_GDEC);
    const int ch = unit >> 4, e = (unit & 15) * 512 + tid, k = e >> 7, dir = ch & 1;
    constexpr int GB = 12;
    float S = 0.f, ninc[GB], nd[GB];
#pragma unroll
    for (int j = 0; j < GB; ++j) { const int c = chunk_at(dir, j); ninc[j] = GDS[(size_t)(ch * NCH + c) * 8192 + e]; nd[j] = GDEC[(size_t)(ch * NCH + c) * 64 + k]; }
#pragma unroll 1
    for (int step0 = 0; step0 < NCH; step0 += GB) {
        float inc[GB], d[GB];
#pragma unroll
        for (int j = 0; j < GB; ++j) { inc[j] = ninc[j]; d[j] = nd[j]; }
#pragma unroll
        for (int j = 0; j < GB; ++j) { const int sn = step0 + GB + j, c = chunk_at(dir, sn < NCH ? sn : NCH - 1); ninc[j] = GDS[(size_t)(ch * NCH + c) * 8192 + e]; nd[j] = GDEC[(size_t)(ch * NCH + c) * 64 + k]; }
        __builtin_amdgcn_sched_barrier(0);
#pragma unroll
        for (int j = 0; j < GB; ++j) { const int c = chunk_at(dir, step0 + j); GDS[(size_t)(ch * NCH + c) * 8192 + e] = S; S = d[j] * S + inc[j]; }
    }
}

DEV void gla3_unit(const Params& p, int h, int c, float* sm) {
    const int tid = opaque_tid(), lane = tid & 63, wave = tid >> 6;
    const bf16_t* P0 = (const bf16_t*)(p.ws + OFF_P0);
    const float* GDS = (const float*)(p.ws + OFF_GDS);
    bf16_t* YC = (bf16_t*)(p.ws + OFF_YC);
    const float* ng = p.in[14];
    float* sLR2 = sm;
    float* sBC = sm + 2048; float* sTot = sm + 6208;
    bf16_t* qt = (bf16_t*)(sm + 6272);
    bf16_t* kt = (bf16_t*)(sm + 8576);
    bf16_t* Sm = (bf16_t*)(sm + 10880);
    bf16_t* S0s = (bf16_t*)(sm + 13184);
    bf16_t* Vs = (bf16_t*)(sm + 17536);
    float* O = sm + 21888;
    const int ti = wave & 3, vt0 = (wave >> 2) * 4;
    const int t = tid >> 3, k0 = (tid & 7) * 8;
    f32x4 acc[4];
#pragma unroll
    for (int j = 0; j < 4; ++j) acc[j] = (f32x4){0.f, 0.f, 0.f, 0.f};
    const uint4 vq0 = *(const uint4*)(P0 + (size_t)(c * 64 + (tid >> 4)) * EIN + 512 + h * 128 + (tid & 15) * 8);
    const uint4 vq1 = *(const uint4*)(P0 + (size_t)(c * 64 + 32 + (tid >> 4)) * EIN + 512 + h * 128 + (tid & 15) * 8);
    const uint4 lrq = *(const uint4*)(P0 + (size_t)(c * 64 + ((tid & 255) >> 2)) * EIN + 1536 + (tid & 3) * 8);
    const uint4 qq = *(const uint4*)(P0 + (size_t)(c * 64 + t) * EIN + h * 64 + k0);
    const uint4 kq = *(const uint4*)(P0 + (size_t)(c * 64 + t) * EIN + 256 + h * 64 + k0);
    float4 s0a[4], s0b[4];
#pragma unroll
    for (int u = 0; u < 4; ++u) { const int i = tid + 512 * u, k = i >> 5, v4 = (i & 31) * 4;
        s0a[u] = ld4(GDS + (size_t)((h * 2 + 0) * NCH + c) * 8192 + k * 128 + v4); s0b[u] = ld4(GDS + (size_t)((h * 2 + 1) * NCH + c) * 8192 + k * 128 + v4); }
    const bf16_t* gp = P0 + (size_t)(c * 64 + t) * EIN + 1024 + h * 128 + (tid & 7) * 16;
    const uint4 gq0 = *(const uint4*)gp, gq1 = *(const uint4*)(gp + 8);
    __syncthreads();
    *(uint4*)(Vs + (tid >> 4) * 136 + (tid & 15) * 8) = vq0; *(uint4*)(Vs + (32 + (tid >> 4)) * 136 + (tid & 15) * 8) = vq1;
    if (tid < 256) { float* d = sLR2 + ((tid & 3) >> 1) * 1024 + (tid >> 2) * 16 + (tid & 1) * 8; st4(d, make_float4(bflo(lrq.x), bfhi(lrq.x), bflo(lrq.y), bfhi(lrq.y))); st4(d + 4, make_float4(bflo(lrq.z), bfhi(lrq.z), bflo(lrq.w), bfhi(lrq.w))); }
    __syncthreads();
#pragma unroll
    for (int dir = 0; dir < 2; ++dir) {
        gla_decay_core(sLR2 + dir * 1024, sm + GLC_OFF + dir * 1024, sm + GLC_OFF + 2048 + dir * 64, sBC, sTot, dir, tid);
        {
            float qv[8], kv[8];
            unpack8(qq, qv); unpack8(kq, kv);
#pragma unroll
            for (int j = 0; j < 8; ++j) { const float bc = sBC[t * 65 + k0 + j]; qv[j] *= 0.125f * fexp(bc); kv[j] *= fexp(-bc); }
            *(uint4*)(qt + t * 72 + k0) = make_uint4(pack2bf(qv[0], qv[1]), pack2bf(qv[2], qv[3]), pack2bf(qv[4], qv[5]), pack2bf(qv[6], qv[7]));
            *(uint4*)(kt + t * 72 + k0) = make_uint4(pack2bf(kv[0], kv[1]), pack2bf(kv[2], kv[3]), pack2bf(kv[4], kv[5]), pack2bf(kv[6], kv[7]));
#pragma unroll
            for (int u = 0; u < 4; ++u) {
                const int i = tid + 512 * u, k = i >> 5, v4 = (i & 31) * 4;
                const float4 s4 = dir ? s0b[u] : s0a[u];
                *(uint2*)(S0s + k * 136 + v4) = make_uint2(pack2bf(s4.x, s4.y), pack2bf(s4.z, s4.w));
            }
        }
        __syncthreads();
        {
            const int si = wave & 3;
#pragma unroll
            for (int jj = 0; jj < 2; ++jj) {
                const int t2 = (wave >> 2) * 2 + jj;
                f32x4 a = (f32x4){0.f, 0.f, 0.f, 0.f};
#pragma unroll
                for (int ks = 0; ks < 2; ++ks) a = __builtin_amdgcn_mfma_f32_16x16x32_bf16(row_frag(kt, 72, si * 16, ks * 32, lane), row_frag(qt, 72, t2 * 16, ks * 32, lane), a, 0, 0, 0);
                const int tq = t2 * 16 + (lane & 15), s0 = si * 16 + (lane >> 4) * 4;
                float m[4];
#pragma unroll
                for (int r = 0; r < 4; ++r) { const bool keep = dir ? (s0 + r >= tq) : (s0 + r <= tq); m[r] = keep ? a[r] : 0.f; }
                *(uint2*)(Sm + tq * 72 + s0) = make_uint2(pack2bf(m[0], m[1]), pack2bf(m[2], m[3]));
            }
        }
        __syncthreads();
#pragma unroll
        for (int ks = 0; ks < 2; ++ks) {
            const bf16x8 a1 = row_frag(qt, 72, ti * 16, ks * 32, lane), a2 = row_frag(Sm, 72, ti * 16, ks * 32, lane);
#pragma unroll
            for (int j = 0; j < 4; ++j) {
                acc[j] = __builtin_amdgcn_mfma_f32_16x16x32_bf16(a1, tr_frag(S0s, 136, ks * 32, (vt0 + j) * 16, lane), acc[j], 0, 0, 0);
                acc[j] = __builtin_amdgcn_mfma_f32_16x16x32_bf16(a2, tr_frag(Vs, 136, ks * 32, (vt0 + j) * 16, lane), acc[j], 0, 0, 0);
            }
        }
        if (dir == 0) __syncthreads();
    }
#pragma unroll
    for (int j = 0; j < 4; ++j)
#pragma unroll
        for (int r = 0; r < 4; ++r) O[(ti * 16 + (lane >> 4) * 4 + r) * 132 + (vt0 + j) * 16 + (lane & 15)] = acc[j][r];
    __syncthreads();
    {
        const int v0 = (tid & 7) * 16;
        float o[16];
        float ss = 0.f;
#pragma unroll
        for (int i = 0; i < 16; ++i) { o[i] = O[t * 132 + v0 + i]; ss += o[i] * o[i]; }
        ss += __shfl_xor(ss, 1, 64); ss += __shfl_xor(ss, 2, 64); ss += __shfl_xor(ss, 4, 64);
        const float rms = rsqrtf(ss * (1.f / 128.f) + 1e-5f);
        float g[16];
        unpack8(gq0, g); unpack8(gq1, g + 8);
        float y[16];
#pragma unroll
        for (int i = 0; i < 16; ++i) y[i] = o[i] * rms * ng[v0 + i] * silu_f(g[i]);
        bf16_t* yp = YC + (size_t)(c * 64 + t) * 1024 + h * 128 + v0;
        *(uint4*)yp = make_uint4(pack2bf(y[0], y[1]), pack2bf(y[2], y[3]), pack2bf(y[4], y[5]), pack2bf(y[6], y[7]));
        *(uint4*)(yp + 8) = make_uint4(pack2bf(y[8], y[9]), pack2bf(y[10], y[11]), pack2bf(y[12], y[13]), pack2bf(y[14], y[15]));
    }
}

DEV void load8bf(const bf16_t* ptr, float* f) { unpack8(*(const uint4*)ptr, f); }
struct RwNb { int sL, sR, sU, sD; bool vL, vR, vU, vD; };
DEV RwNb rw_nb(int s) {
    RwNb q; q.vU = false; q.vD = false;
    if (s < NCX) { q.vL = s > 0; q.vR = s < NCX - 1; }
    else { const int n = s - NCX, rr = n >> 6, cc = n & 63; q.vL = cc > 0; q.vR = cc < 63; q.vU = rr > 0; q.vD = rr < 127; }
    q.sL = q.vL ? s - 1 : s; q.sR = q.vR ? s + 1 : s; q.sU = q.vU ? s - 64 : s; q.sD = q.vD ? s + 64 : s;
    return q;
}
struct RwRaw { uint4 o, l, r, u, d; };
DEV RwRaw rw_load(const bf16_t* P0, int s, const RwNb& q, int cb) {
    RwRaw w;
    w.o = *(const uint4*)(P0 + (size_t)s * EIN + RW0 + cb); w.l = *(const uint4*)(P0 + (size_t)q.sL * EIN + RW0 + cb); w.r = *(const uint4*)(P0 + (size_t)q.sR * EIN + RW0 + cb);
    w.u = *(const uint4*)(P0 + (size_t)q.sU * EIN + RW0 + cb); w.d = *(const uint4*)(P0 + (size_t)q.sD * EIN + RW0 + cb);
    return w;
}
DEV void rw_comb_l(const RwRaw& w, const RwNb& q, const float* ml, float* out) {
    float own[8]; unpack8(w.o, own);
    const float nb[8] = {q.vL ? bflo(w.l.x) : 0.f, q.vR ? bfhi(w.r.x) : 0.f, q.vU ? bflo(w.u.y) : 0.f, q.vD ? bfhi(w.d.y) : 0.f,
                         q.vL ? bflo(w.l.z) : 0.f, q.vR ? bfhi(w.r.z) : 0.f, q.vU ? bflo(w.u.w) : 0.f, q.vD ? bfhi(w.d.w) : 0.f};
    const float4 m0 = *(const float4*)ml, m1 = *(const float4*)(ml + 4);
    const float m[8] = {m0.x, m0.y, m0.z, m0.w, m1.x, m1.y, m1.z, m1.w};
#pragma unroll
    for (int i = 0; i < 8; ++i) out[i] = own[i] + (nb[i] - own[i]) * m[i];
}
DEV void rw_comb(const RwRaw& w, const RwNb& q, const float* __restrict__ mu, int cb, float* out) {
    float own[8]; unpack8(w.o, own);
    const float nb[8] = {q.vL ? bflo(w.l.x) : 0.f, q.vR ? bfhi(w.r.x) : 0.f, q.vU ? bflo(w.u.y) : 0.f, q.vD ? bfhi(w.d.y) : 0.f,
                         q.vL ? bflo(w.l.z) : 0.f, q.vR ? bfhi(w.r.z) : 0.f, q.vU ? bflo(w.u.w) : 0.f, q.vD ? bfhi(w.d.w) : 0.f};
    const float4 m0 = ld4(mu + cb), m1 = ld4(mu + cb + 4);
    const float m[8] = {m0.x, m0.y, m0.z, m0.w, m1.x, m1.y, m1.z, m1.w};
#pragma unroll
    for (int i = 0; i < 8; ++i) out[i] = own[i] + (nb[i] - own[i]) * m[i];
}
DEV uint4 pack8(const float* f) { return make_uint4(pack2bf(f[0], f[1]), pack2bf(f[2], f[3]), pack2bf(f[4], f[5]), pack2bf(f[6], f[7])); }

template <int XM, int YM, class F>
DEV void mm64(const bf16_t* X, const bf16_t* Y, F f, int lane, int wave) {
#pragma unroll
    for (int q = 0; q < 2; ++q) {
        const int idx = wave * 2 + q, ti = idx >> 2, tj = idx & 3;
        f32x4 acc = (f32x4){0.f, 0.f, 0.f, 0.f};
#pragma unroll
        for (int ks = 0; ks < 2; ++ks) {
            const bf16x8 a = XM == 0 ? row_frag(X, 72, ti * 16, ks * 32, lane) : tr_frag(X, 72, ks * 32, ti * 16, lane);
            const bf16x8 bq = YM == 0 ? row_frag(Y, 72, tj * 16, ks * 32, lane) : tr_frag(Y, 72, ks * 32, tj * 16, lane);
            acc = __builtin_amdgcn_mfma_f32_16x16x32_bf16(a, bq, acc, 0, 0, 0);
        }
        f(ti * 16 + (lane >> 4) * 4, tj * 16 + (lane & 15), acc);
    }
}
template <int XM, int YM, class F>
DEV void mm64x2(const bf16_t* X1, const bf16_t* Y1, const bf16_t* X2, const bf16_t* Y2, F f, int lane, int wave) {
#pragma unroll
    for (int q = 0; q < 2; ++q) {
        const int idx = wave * 2 + q, ti = idx >> 2, tj = idx & 3;
        f32x4 acc = (f32x4){0.f, 0.f, 0.f, 0.f};
#pragma unroll
        for (int ks = 0; ks < 2; ++ks) {
            const bf16x8 a = XM == 0 ? row_frag(X1, 72, ti * 16, ks * 32, lane) : tr_frag(X1, 72, ks * 32, ti * 16, lane);
            const bf16x8 bq = YM == 0 ? row_frag(Y1, 72, tj * 16, ks * 32, lane) : tr_frag(Y1, 72, ks * 32, tj * 16, lane);
            acc = __builtin_amdgcn_mfma_f32_16x16x32_bf16(a, bq, acc, 0, 0, 0);
            const bf16x8 a2 = XM == 0 ? row_frag(X2, 72, ti * 16, ks * 32, lane) : tr_frag(X2, 72, ks * 32, ti * 16, lane);
            const bf16x8 b2 = YM == 0 ? row_frag(Y2, 72, tj * 16, ks * 32, lane) : tr_frag(Y2, 72, ks * 32, tj * 16, lane);
            acc = __builtin_amdgcn_mfma_f32_16x16x32_bf16(a2, b2, acc, 0, 0, 0);
        }
        f(ti * 16 + (lane >> 4) * 4, tj * 16 + (lane & 15), acc);
    }
}
DEV void st_img(bf16_t* P, int i0, int j, float a0, float a1, float a2, float a3) {
    P[(i0 + 0) * 72 + j] = __builtin_bit_cast(unsigned short, (__bf16)a0); P[(i0 + 1) * 72 + j] = __builtin_bit_cast(unsigned short, (__bf16)a1);
    P[(i0 + 2) * 72 + j] = __builtin_bit_cast(unsigned short, (__bf16)a2); P[(i0 + 3) * 72 + j] = __builtin_bit_cast(unsigned short, (__bf16)a3);
}

struct RwRaw3 { uint4 o, u, d; };
DEV RwRaw3 rw_load3(const bf16_t* P0, int s, const RwNb& q, int cb) {
    RwRaw3 w;
    w.o = *(const uint4*)(P0 + (size_t)s * EIN + RW0 + cb); w.u = *(const uint4*)(P0 + (size_t)q.sU * EIN + RW0 + cb); w.d = *(const uint4*)(P0 + (size_t)q.sD * EIN + RW0 + cb);
    return w;
}
DEV void rw_comb3(const RwRaw3& w, const RwNb& q, const bf16_t* tile, const bf16_t* P0, int s, int t, int cb, int j0, const float* ml, float* out) {
    asm volatile("" :: "v"(w.u.x), "v"(w.u.z), "v"(w.d.x), "v"(w.d.z));
    float own[8]; unpack8(w.o, own);
    float l0 = 0.f, l4 = 0.f, r1 = 0.f, r5 = 0.f;
    if (q.vL) { if (t > 0) { l0 = bf2f(tile[(t - 1) * 72 + j0]); l4 = bf2f(tile[(t - 1) * 72 + j0 + 4]); }
                else { const bf16_t* g = P0 + (size_t)(s - 1) * EIN + RW0 + cb; l0 = bf2f(g[0]); l4 = bf2f(g[4]); } }
    if (q.vR) { if (t < 63) { r1 = bf2f(tile[(t + 1) * 72 + j0 + 1]); r5 = bf2f(tile[(t + 1) * 72 + j0 + 5]); }
                else { const bf16_t* g = P0 + (size_t)(s + 1) * EIN + RW0 + cb; r1 = bf2f(g[1]); r5 = bf2f(g[5]); } }
    const float nb[8] = {l0, r1, q.vU ? bflo(w.u.y) : 0.f, q.vD ? bfhi(w.d.y) : 0.f, l4, r5, q.vU ? bflo(w.u.w) : 0.f, q.vD ? bfhi(w.d.w) : 0.f};
    const float4 m0 = *(const float4*)ml, m1 = *(const float4*)(ml + 4);
    const float m[8] = {m0.x, m0.y, m0.z, m0.w, m1.x, m1.y, m1.z, m1.w};
#pragma unroll
    for (int i = 0; i < 8; ++i) out[i] = own[i] + (nb[i] - own[i]) * m[i];
}
struct R1Raw { RwRaw3 r, k, v, w, a; float4 qw0, qw1, qa0, qa1; };
DEV void r1_consts(const Params& p, int h, int dir, float* sm) {
    const int tid = opaque_tid();
    float* sv = (float*)((bf16_t*)sm + 14 * 4608);
    __syncthreads();
    if (tid < 64) { const int hc = h * 64 + tid; sv[64 + tid] = p.in[dir ? 18 : 16][hc]; sv[128 + tid] = p.in[dir ? 22 : 20][hc]; sv[192 + tid] = p.in[24][hc]; sv[256 + tid] = p.in[25][hc]; sv[320 + tid] = p.in[26][hc]; }
    if (tid < 320) { const int tn = tid >> 6, col = tid & 63; const int cb = tn < 3 ? tn * 512 + h * 64 : (tn == 3 ? 2048 + dir * 64 : 2176 + dir * 64); sv[384 + tid] = p.in[15][cb + col]; }
}
DEV void r1_load(const Params& p, int h, int dir, int c, R1Raw& R) {
    const int tid = opaque_tid();
    const bf16_t* P0 = (const bf16_t*)(p.ws + OFF_P0);
    const float* ww2 = p.in[dir ? 19 : 17]; const float* wa2 = p.in[dir ? 23 : 21];
    const int t = tid >> 3, j0 = (tid & 7) * 8, s = c * 64 + t;
    const RwNb nbq = rw_nb(s);
    R.r = rw_load3(P0, s, nbq, h * 64 + j0); R.k = rw_load3(P0, s, nbq, 512 + h * 64 + j0); R.v = rw_load3(P0, s, nbq, 1024 + h * 64 + j0);
    R.w = rw_load3(P0, s, nbq, 2048 + dir * 64 + j0); R.a = rw_load3(P0, s, nbq, 2176 + dir * 64 + j0);
    R.qw0 = ld4(ww2 + (size_t)t * 512 + h * 64 + j0); R.qw1 = ld4(ww2 + (size_t)t * 512 + h * 64 + j0 + 4);
    R.qa0 = ld4(wa2 + (size_t)t * 512 + h * 64 + j0); R.qa1 = ld4(wa2 + (size_t)t * 512 + h * 64 + j0 + 4);
}
DEV void rwkv1_unit(const Params& p, int h, int dir, int c, float* sm, R1Raw& R, int cnext) {
    const int tid = opaque_tid(), lane = tid & 63, wave = tid >> 6;
    bf16_t* RU = (bf16_t*)(p.ws + OFF_RU) + (size_t)((h * 2 + dir) * NCH + c) * 16384;
    float* BONS = (float*)(p.ws + OFF_BONS);
    bf16_t* img = (bf16_t*)sm;
#define SLOT(i_) (img + (i_) * 4608)
    float* fLW = (float*)SLOT(10);
    float* fAS = (float*)SLOT(12);
    float* sv = (float*)SLOT(14);
    const int t = tid >> 3, j0 = (tid & 7) * 8, s = c * 64 + t;
    const bf16_t* P0 = (const bf16_t*)(p.ws + OFF_P0);
    __syncthreads();
    *(uint4*)(SLOT(0) + t * 72 + j0) = R.r.o; *(uint4*)(SLOT(1) + t * 72 + j0) = R.k.o; *(uint4*)(SLOT(2) + t * 72 + j0) = R.v.o;
    *(uint4*)(SLOT(3) + t * 72 + j0) = R.w.o; *(uint4*)(SLOT(4) + t * 72 + j0) = R.a.o;
    __syncthreads();
    float r8[8], k8[8], v8[8];
    {
        float x8[8];
        const RwNb nbq = rw_nb(s);
        rw_comb3(R.r, nbq, SLOT(0), P0, s, t, h * 64 + j0, j0, sv + 384 + j0, r8);
        rw_comb3(R.k, nbq, SLOT(1), P0, s, t, 512 + h * 64 + j0, j0, sv + 448 + j0, k8);
        rw_comb3(R.v, nbq, SLOT(2), P0, s, t, 1024 + h * 64 + j0, j0, sv + 512 + j0, v8);
        rw_comb3(R.w, nbq, SLOT(3), P0, s, t, 2048 + dir * 64 + j0, j0, sv + 576 + j0, x8);
#pragma unroll
        for (int i = 0; i < 8; ++i) x8[i] = tanh_f(x8[i]);
        *(uint4*)(SLOT(6) + t * 72 + j0) = pack8(x8);
        rw_comb3(R.a, nbq, SLOT(4), P0, s, t, 2176 + dir * 64 + j0, j0, sv + 640 + j0, x8);
        *(uint4*)(SLOT(7) + t * 72 + j0) = pack8(x8);
        { const float wq[8] = {R.qw0.x, R.qw0.y, R.qw0.z, R.qw0.w, R.qw1.x, R.qw1.y, R.qw1.z, R.qw1.w}; *(uint4*)(SLOT(8) + t * 72 + j0) = pack8(wq); }
        { const float wq[8] = {R.qa0.x, R.qa0.y, R.qa0.z, R.qa0.w, R.qa1.x, R.qa1.y, R.qa1.z, R.qa1.w}; *(uint4*)(SLOT(9) + t * 72 + j0) = pack8(wq); }
    }
    r1_load(p, h, dir, cnext >= 0 ? cnext : c, R);
    __syncthreads();
    mm64<0, 1>(SLOT(6), SLOT(8), [=](int i0, int j, f32x4 a) {
#pragma unroll
        for (int r = 0; r < 4; ++r) fLW[(i0 + r) * 65 + j] = -0.6065306597f * sigmoid_f(sv[64 + j] + a[r]); }, lane, wave);
    mm64<0, 1>(SLOT(7), SLOT(9), [=](int i0, int j, f32x4 a) {
#pragma unroll
        for (int r = 0; r < 4; ++r) fAS[(i0 + r) * 65 + j] = sigmoid_f(sv[128 + j] + a[r]); }, lane, wave);
    __syncthreads();
#pragma unroll
    for (int j = 0; j < 8; ++j) {
        const int k = wave * 8 + j;
        const float v = wave_scan_add(fLW[lane * 65 + k], lane, dir);
        fLW[lane * 65 + k] = v;
        if (lane == (dir ? 0 : 63)) sv[k] = v;
    }
    __syncthreads();
    {
        float kkv[8], ss = 0.f;
#pragma unroll
        for (int i = 0; i < 8; ++i) { kkv[i] = k8[i] * sv[192 + j0 + i]; ss += kkv[i] * kkv[i]; }
        ss += __shfl_xor(ss, 1, 64); ss += __shfl_xor(ss, 2, 64); ss += __shfl_xor(ss, 4, 64);
        const float rn = rsqrtf(fmaxf(ss, 1e-24f));
        float fa[8], fb[8], fk[8], fr[8], fbp[8], fkp[8], bon = 0.f;
        const int tp = dir ? t + 1 : t - 1;
        const bool hasp = dir ? (t < 63) : (t > 0);
#pragma unroll
        for (int i = 0; i < 8; ++i) {
            const int k = j0 + i;
            const float Bt = fLW[t * 65 + k], Bx = hasp ? fLW[tp * 65 + k] : 0.f, asg = fAS[t * 65 + k];
            const float kk = kkv[i] * rn, kh = k8[i] * (1.f + (asg - 1.f) * sv[256 + k]);
            bon += r8[i] * kh * sv[320 + k];
            const float enB = fexp(-Bt), eLB = fexp(sv[k] - Bt), bv = kk * asg;
            fa[i] = -kk * fexp(Bx); fb[i] = bv * enB; fk[i] = kh * enB; fr[i] = r8[i] * fexp(Bt); fbp[i] = bv * eLB; fkp[i] = kh * eLB;
        }
        bon += __shfl_xor(bon, 1, 64); bon += __shfl_xor(bon, 2, 64); bon += __shfl_xor(bon, 4, 64);
        if ((tid & 7) == 0) BONS[((size_t)dir * TB + s) * 8 + h] = bon;
        *(uint4*)(SLOT(0) + t * 72 + j0) = pack8(fa); *(uint4*)(SLOT(1) + t * 72 + j0) = pack8(fb); *(uint4*)(SLOT(2) + t * 72 + j0) = pack8(fk);
        *(uint4*)(SLOT(3) + t * 72 + j0) = pack8(fr); *(uint4*)(SLOT(4) + t * 72 + j0) = pack8(fbp); *(uint4*)(SLOT(5) + t * 72 + j0) = pack8(fkp);
    }
    __syncthreads();
    *(uint4*)(SLOT(6) + t * 72 + j0) = pack8(v8);
    __syncthreads();
    mm64<0, 0>(SLOT(0), SLOT(1), [=](int i0, int j, f32x4 a) {
        float m[4];
#pragma unroll
        for (int r = 0; r < 4; ++r) { const bool keep = dir ? (j > i0 + r) : (j < i0 + r); m[r] = keep ? a[r] : 0.f; }
        const bool dg = (i0 >> 4) == (j >> 4);
        st_img(SLOT(7), i0, j, dg ? m[0] : 0.f, dg ? m[1] : 0.f, dg ? m[2] : 0.f, dg ? m[3] : 0.f);
        st_img(SLOT(8), i0, j, (dg ? m[0] : 0.f) + (j == i0 ? 1.f : 0.f), (dg ? m[1] : 0.f) + (j == i0 + 1 ? 1.f : 0.f), (dg ? m[2] : 0.f) + (j == i0 + 2 ? 1.f : 0.f), (dg ? m[3] : 0.f) + (j == i0 + 3 ? 1.f : 0.f));
        st_img(SLOT(12), i0, j, dg ? 0.f : m[0], dg ? 0.f : m[1], dg ? 0.f : m[2], dg ? 0.f : m[3]); }, lane, wave);
    mm64<0, 0>(SLOT(0), SLOT(2), [=](int i0, int j, f32x4 a) {
        float m[4];
#pragma unroll
        for (int r = 0; r < 4; ++r) { const bool keep = dir ? (j > i0 + r) : (j < i0 + r); m[r] = keep ? a[r] : 0.f; }
        st_img(SLOT(9), i0, j, m[0], m[1], m[2], m[3]); }, lane, wave);
    mm64<0, 0>(SLOT(3), SLOT(1), [=](int i0, int j, f32x4 a) {
        float m[4];
#pragma unroll
        for (int r = 0; r < 4; ++r) { const bool keep = dir ? (j >= i0 + r) : (j <= i0 + r); m[r] = keep ? a[r] : 0.f; }
        st_img(SLOT(10), i0, j, m[0], m[1], m[2], m[3]); }, lane, wave);
    mm64<0, 0>(SLOT(3), SLOT(2), [=](int i0, int j, f32x4 a) {
        float m[4];
#pragma unroll
        for (int r = 0; r < 4; ++r) { const bool keep = dir ? (j >= i0 + r) : (j <= i0 + r); m[r] = keep ? a[r] : 0.f; }
        st_img(SLOT(11), i0, j, m[0], m[1], m[2], m[3]); }, lane, wave);
    __syncthreads();
    {
        bf16_t* Pc = SLOT(7); bf16_t* Pn = SLOT(1); bf16_t* Tc = SLOT(8); bf16_t* Tn = SLOT(2);
#pragma unroll 1
        for (int it = 0; it < 3; ++it) {
            mm64<0, 1>(Pc, Pc, [=](int i0, int j, f32x4 a) { st_img(Pn, i0, j, a[0], a[1], a[2], a[3]); }, lane, wave);
            __syncthreads();
            mm64<0, 1>(Tc, Pn, [=](int i0, int j, f32x4 a) {
                st_img(Tn, i0, j, a[0] + bf2f(Tc[(i0 + 0) * 72 + j]), a[1] + bf2f(Tc[(i0 + 1) * 72 + j]), a[2] + bf2f(Tc[(i0 + 2) * 72 + j]), a[3] + bf2f(Tc[(i0 + 3) * 72 + j])); }, lane, wave);
            __syncthreads();
            bf16_t* tmp = Pc; Pc = Pn; Pn = tmp; tmp = Tc; Tc = Tn; Tn = tmp;
        }
    }
    mm64<0, 1>(SLOT(2), SLOT(12), [=](int i0, int j, f32x4 a) { st_img(SLOT(7), i0, j, a[0], a[1], a[2], a[3]); }, lane, wave);
    mm64<0, 1>(SLOT(2), SLOT(0), [=](int i0, int j, f32x4 a) { st_img(SLOT(1), i0, j, a[0], a[1], a[2], a[3]); }, lane, wave);
    mm64<0, 1>(SLOT(9), SLOT(6), [=](int i0, int j, f32x4 a) { st_img(SLOT(13), i0, j, a[0], a[1], a[2], a[3]); }, lane, wave);
    __syncthreads();
    mm64<0, 1>(SLOT(2), SLOT(13), [=](int i0, int j, f32x4 a) { st_img(SLOT(8), i0, j, a[0], a[1], a[2], a[3]); }, lane, wave);
    __syncthreads();
    {
        const bf16_t* Zp = (wave < 4) ? SLOT(1) : SLOT(8);
        bf16_t* Xi = (wave < 4) ? SLOT(12) : SLOT(9);
        const int ct = (wave & 3) * 16, g4 = (lane >> 4) * 4, l15 = lane & 15;
#pragma unroll
        for (int bs = 0; bs < 4; ++bs) {
            const int bi = dir ? 3 - bs : bs;
            f32x4 acc;
#pragma unroll
            for (int r = 0; r < 4; ++r) acc[r] = bf2f(Zp[(bi * 16 + g4 + r) * 72 + ct + l15]);
            const bool k0 = dir ? (bi == 0) : (bi >= 1), k1 = dir ? (bi <= 2) : (bi == 3);
            if (k0) acc = __builtin_amdgcn_mfma_f32_16x16x32_bf16(row_frag(SLOT(7), 72, bi * 16, 0, lane), tr_frag(Xi, 72, 0, ct, lane), acc, 0, 0, 0);
            if (k1) acc = __builtin_amdgcn_mfma_f32_16x16x32_bf16(row_frag(SLOT(7), 72, bi * 16, 32, lane), tr_frag(Xi, 72, 32, ct, lane), acc, 0, 0, 0);
            st_img(Xi, bi * 16 + g4, ct + l15, acc[0], acc[1], acc[2], acc[3]);
            __syncthreads();
        }
    }
    mm64<1, 1>(SLOT(12), SLOT(4), [=](int i0, int j, f32x4 a) {
        float m[4];
#pragma unroll
        for (int r = 0; r < 4; ++r) m[r] = a[r] + ((i0 + r) == j ? fexp(sv[j]) : 0.f);
        *(uint2*)(RU + j * 64 + i0) = make_uint2(pack2bf(m[0], m[1]), pack2bf(m[2], m[3])); }, lane, wave);
    mm64x2<1, 1>(SLOT(4), SLOT(9), SLOT(5), SLOT(6), [=](int i0, int j, f32x4 a) {
        *(uint2*)(RU + 4096 + j * 64 + i0) = make_uint2(pack2bf(a[0], a[1]), pack2bf(a[2], a[3])); }, lane, wave);
    mm64<1, 0>(SLOT(12), SLOT(10), [=](int i0, int j, f32x4 a) {
        const uint2 rr = *(const uint2*)(SLOT(3) + j * 72 + i0);
        *(uint2*)(RU + 8192 + j * 64 + i0) = make_uint2(pack2bf(a[0] + bflo(rr.x), a[1] + bfhi(rr.x)), pack2bf(a[2] + bflo(rr.y), a[3] + bfhi(rr.y))); }, lane, wave);
    mm64x2<0, 1>(SLOT(10), SLOT(9), SLOT(11), SLOT(6), [=](int i0, int j, f32x4 a) {
        *(uint2*)(RU + 12288 + j * 64 + i0) = make_uint2(pack2bf(a[0], a[1]), pack2bf(a[2], a[3])); }, lane, wave);
#undef SLOT
}

#define R2_LOAD(M_, C_, rnd_) do { const int r0_ = ((rnd_) < R2_NR ? (rnd_) : R2_NR - 1) * R2_RS; \
    _Pragma("unroll") for (int s_ = 0; s_ < R2_RS; ++s_) M_[s_] = *(const uint4*)(RU + (size_t)(chain * NCH + chunk_at(dir, r0_ + s_)) * 16384 + tid * 8); \
    _Pragma("unroll") for (int j_ = 0; j_ < 3; ++j_) { const int cq_ = tid + 512 * j_; \
        C_[j_] = *(const uint4*)(RU + (size_t)(chain * NCH + chunk_at(dir, r0_ + (cq_ >> 7))) * 16384 + 4096 + (vblk * 16 + ((cq_ >> 3) & 15)) * 64 + (cq_ & 7) * 8); } } while (0)
#define R2_ROUND(M_, C_, rnd_) do { \
    { const int row_ = tid >> 3, c8_ = tid & 7, sw_ = (row_ >> 1) & 7, u0_ = (c8_ >> 2) * 4 + (c8_ & 1) * 2, eh_ = ((c8_ >> 1) & 1) * 8; \
      _Pragma("unroll") for (int s_ = 0; s_ < R2_RS; ++s_) { char* sl_ = ring + s_ * 10240 + row_ * 128 + eh_; \
          *(uint2*)(sl_ + ((u0_ ^ sw_) * 16)) = make_uint2(M_[s_].x, M_[s_].y); *(uint2*)(sl_ + (((u0_ + 1) ^ sw_) * 16)) = make_uint2(M_[s_].z, M_[s_].w); } \
      _Pragma("unroll") for (int j_ = 0; j_ < 3; ++j_) { const int cq_ = tid + 512 * j_, rw_ = (cq_ >> 3) & 15, q8_ = cq_ & 7, i_ = q8_ >> 1, g0_ = (q8_ & 1) * 2, sc_ = (rw_ >> 1) & 7; \
          char* sl_ = ring + (cq_ >> 7) * 10240 + 8192 + rw_ * 128 + (i_ & 1) * 8; \
          *(uint2*)(sl_ + (((g0_ * 2 + (i_ >> 1)) ^ sc_) * 16)) = make_uint2(C_[j_].x, C_[j_].y); *(uint2*)(sl_ + ((((g0_ + 1) * 2 + (i_ >> 1)) ^ sc_) * 16)) = make_uint2(C_[j_].z, C_[j_].w); } } \
    R2_LOAD(M_, C_, (rnd_) + 2); \
    __syncthreads(); \
    if (wave == 0) { \
        _Pragma("unroll 4") for (int s_ = 0; s_ < R2_RS; ++s_) { \
            const int c_ = chunk_at(dir, (rnd_) * R2_RS + s_); const char* sl_ = ring + s_ * 10240; \
            unsigned pk_[4][2]; \
            _Pragma("unroll") for (int i_ = 0; i_ < 4; ++i_) { pk_[i_][0] = pack2bf(st[i_][0], st[i_][1]); pk_[i_][1] = pack2bf(st[i_][2], st[i_][3]); } \
            bf16_t* sp_ = S0G + ((size_t)(chain * NCH + c_) * 64 + vblk * 16 + l15) * 64 + g * 4; \
            _Pragma("unroll") for (int i_ = 0; i_ < 4; ++i_) *(uint2*)(sp_ + i_ * 16) = make_uint2(pk_[i_][0], pk_[i_][1]); \
            bf16x8 bfr_[2]; \
            _Pragma("unroll") for (int ks_ = 0; ks_ < 2; ++ks_) { const uint4 u_ = make_uint4(pk_[2 * ks_][0], pk_[2 * ks_][1], pk_[2 * ks_ + 1][0], pk_[2 * ks_ + 1][1]); bfr_[ks_] = __builtin_bit_cast(bf16x8, u_); } \
            const uint4 c01_ = *(const uint4*)(sl_ + 8192 + l15 * 128 + (((g * 2) ^ ((l15 >> 1) & 7)) * 16)), c23_ = *(const uint4*)(sl_ + 8192 + l15 * 128 + (((g * 2 + 1) ^ ((l15 >> 1) & 7)) * 16)); \
            const unsigned cw_[8] = {c01_.x, c01_.y, c01_.z, c01_.w, c23_.x, c23_.y, c23_.z, c23_.w}; \
            _Pragma("unroll") for (int i_ = 0; i_ < 4; ++i_) { \
                f32x4 acc_ = (f32x4){bflo(cw_[2 * i_]), bfhi(cw_[2 * i_]), bflo(cw_[2 * i_ + 1]), bfhi(cw_[2 * i_ + 1])}; \
                _Pragma("unroll") for (int ks_ = 0; ks_ < 2; ++ks_) { \
                    const int row_ = i_ * 16 + l15; \
                    const bf16x8 af_ = *(const bf16x8*)(sl_ + row_ * 128 + (((ks_ * 4 + g) ^ ((row_ >> 1) & 7)) * 16)); \
                    acc_ = __builtin_amdgcn_mfma_f32_16x16x32_bf16(af_, bfr_[ks_], acc_, 0, 0, 0); } \
                st[i_] = acc_; } } } \
    __syncthreads(); } while (0)
DEV void rwkv2_unit(const Params& p, int chain, int vblk, float* sm) {
    constexpr int R2_RS = 12, R2_NR = NCH / R2_RS;
    static_assert(R2_NR * R2_RS == NCH && R2_RS * 10240 <= LDS_BYTES, "R2 ring");
    const int tid = opaque_tid(), lane = tid & 63, wave = tid >> 6;
    const bf16_t* RU = (const bf16_t*)(p.ws + OFF_RU);
    bf16_t* S0G = (bf16_t*)(p.ws + OFF_RS0);
    char* ring = (char*)sm;
    const int dir = chain & 1, g = lane >> 4, l15 = lane & 15;
    f32x4 st[4];
#pragma unroll
    for (int i = 0; i < 4; ++i) st[i] = (f32x4){0.f, 0.f, 0.f, 0.f};
    uint4 ma[R2_RS], ca[3], mb[R2_RS], cb[3];
    __syncthreads();
    R2_LOAD(ma, ca, 0); R2_LOAD(mb, cb, 1);
#pragma unroll 1
    for (int rnd = 0; rnd < R2_NR; rnd += 2) {
        R2_ROUND(ma, ca, rnd);
        if (rnd + 1 < R2_NR) R2_ROUND(mb, cb, rnd + 1);
    }
}
#undef R2_LOAD
#undef R2_ROUND

DEV void rwkv3_unit(const Params& p, int h, int c, float* sm) {
    const int tid = opaque_tid(), lane = tid & 63, wave = tid >> 6;
    const bf16_t* P0 = (const bf16_t*)(p.ws + OFF_P0);
    const bf16_t* RUb = (const bf16_t*)(p.ws + OFF_RU);
    const bf16_t* S0G = (const bf16_t*)(p.ws + OFF_RS0);
    const float* BONS = (const float*)(p.ws + OFF_BONS);
    bf16_t* YC = (bf16_t*)(p.ws + OFF_YC);
    const float* mu = p.in[15]; const float* gn_g = p.in[27]; const float* gn_b = p.in[28];
    bf16_t* img = (bf16_t*)sm;
    float* O = sm + 4 * 2304;
    const int t = tid >> 3, v0 = (tid & 7) * 8, s = c * 64 + t;
    const size_t u0 = (size_t)((h * 2 + 0) * NCH + c), u1 = (size_t)((h * 2 + 1) * NCH + c);
    const uint4 gr0 = *(const uint4*)(RUb + u0 * 16384 + 8192 + t * 64 + v0), gs0 = *(const uint4*)(S0G + u0 * 4096 + t * 64 + v0);
    const uint4 gr1 = *(const uint4*)(RUb + u1 * 16384 + 8192 + t * 64 + v0), gs1 = *(const uint4*)(S0G + u1 * 4096 + t * 64 + v0);
    uint2 yl[2][2];
#pragma unroll
    for (int q = 0; q < 2; ++q) { const int idx = wave * 2 + q, ti = idx >> 2, tj = idx & 3;
        yl[q][0] = *(const uint2*)(RUb + u0 * 16384 + 12288 + (tj * 16 + (lane & 15)) * 64 + ti * 16 + (lane >> 4) * 4);
        yl[q][1] = *(const uint2*)(RUb + u1 * 16384 + 12288 + (tj * 16 + (lane & 15)) * 64 + ti * 16 + (lane >> 4) * 4); }
    const RwNb nbq = rw_nb(s);
    const RwRaw wv_ = rw_load(P0, s, nbq, 1024 + h * 64 + v0), wg_ = rw_load(P0, s, nbq, 1536 + h * 64 + v0);
    const float bon = BONS[(size_t)s * 8 + h] + BONS[((size_t)TB + s) * 8 + h];
    __syncthreads();
    *(uint4*)(img + 0 * 4608 + t * 72 + v0) = gr0; *(uint4*)(img + 2 * 4608 + t * 72 + v0) = gs0;
    *(uint4*)(img + 1 * 4608 + t * 72 + v0) = gr1; *(uint4*)(img + 3 * 4608 + t * 72 + v0) = gs1;
    __syncthreads();
#pragma unroll
    for (int q = 0; q < 2; ++q) {
        const int idx = wave * 2 + q, ti = idx >> 2, tj = idx & 3;
        f32x4 accd[2];
#pragma unroll
        for (int dir = 0; dir < 2; ++dir) {
            f32x4 acc = (f32x4){bflo(yl[q][dir].x), bfhi(yl[q][dir].x), bflo(yl[q][dir].y), bfhi(yl[q][dir].y)};
#pragma unroll
            for (int ks = 0; ks < 2; ++ks) acc = __builtin_amdgcn_mfma_f32_16x16x32_bf16(row_frag(img + dir * 4608, 72, ti * 16, ks * 32, lane), row_frag(img + (2 + dir) * 4608, 72, tj * 16, ks * 32, lane), acc, 0, 0, 0);
            accd[dir] = acc;
        }
#pragma unroll
        for (int r = 0; r < 4; ++r) {
            const int oi = (ti * 16 + (lane >> 4) * 4 + r) * 68 + tj * 16 + (lane & 15);
            O[oi] = accd[0][r] + accd[1][r];
        }
    }
    __syncthreads();
    {
        float y[8], sum = 0.f;
#pragma unroll
        for (int i = 0; i < 8; ++i) { y[i] = O[t * 68 + v0 + i]; sum += y[i]; }
        sum += __shfl_xor(sum, 1, 64); sum += __shfl_xor(sum, 2, 64); sum += __shfl_xor(sum, 4, 64);
        const float mean = sum * (1.f / 64.f);
        float sq = 0.f;
#pragma unroll
        for (int i = 0; i < 8; ++i) { y[i] -= mean; sq += y[i] * y[i]; }
        sq += __shfl_xor(sq, 1, 64); sq += __shfl_xor(sq, 2, 64); sq += __shfl_xor(sq, 4, 64);
        const float rstd = rsqrtf(sq * (1.f / 64.f) + 64e-5f);
        float vm[8], gm[8];
        rw_comb(wv_, nbq, mu, 1024 + h * 64 + v0, vm);
        rw_comb(wg_, nbq, mu, 1536 + h * 64 + v0, gm);
        float o[8];
#pragma unroll
        for (int i = 0; i < 8; ++i) o[i] = (y[i] * rstd * gn_g[h * 64 + v0 + i] + gn_b[h * 64 + v0 + i] + bon * vm[i]) * silu_f(gm[i]);
        *(uint4*)(YC + (size_t)s * 1024 + 512 + h * 64 + v0) = pack8(o);
    }
}

DEV void ln_rows(const float* src, const float* res_lat, const float* res_cx, int nrows, const float* __restrict__ g, const float* __restrict__ bt, float* dst_lat, float* dst_cx, int ncx,
                 bf16_t* hb = nullptr, const float* mvc = nullptr, const float* mvl = nullptr) {
    const int tid_ = opaque_tid(); const int lane = tid_ & 63, gw = blockIdx.x * NWV + (tid_ >> 6), ngw = gridDim.x * NWV;
    float4 gg[4], bb[4];
#pragma unroll
    for (int i = 0; i < 4; ++i) { gg[i] = ld4(g + i * 256 + lane * 4); bb[i] = ld4(bt + i * 256 + lane * 4); }
    float4 na[4], nr[4];
    { const int r = gw < nrows ? gw : 0; const float* x = src + (size_t)r * 1024; const float* xr = (r < ncx) ? (res_cx + (size_t)r * 1024) : (res_lat + (size_t)(r - ncx) * 1024);
#pragma unroll
      for (int i = 0; i < 4; ++i) { na[i] = ld4(x + i * 256 + lane * 4); nr[i] = ld4(xr + i * 256 + lane * 4); } }
    for (int r = gw; r < nrows; r += ngw) {
        float4 v[4];
        float sum = 0.f;
#pragma unroll
        for (int i = 0; i < 4; ++i) { const float4 a = na[i], rr = nr[i];
            v[i] = make_float4(ALPHA * rr.x + a.x, ALPHA * rr.y + a.y, ALPHA * rr.z + a.z, ALPHA * rr.w + a.w); sum += v[i].x + v[i].y + v[i].z + v[i].w; }
        { const int rn = (r + ngw < nrows) ? r + ngw : r; const float* x = src + (size_t)rn * 1024; const float* xr = (rn < ncx) ? (res_cx + (size_t)rn * 1024) : (res_lat + (size_t)(rn - ncx) * 1024);
#pragma unroll
          for (int i = 0; i < 4; ++i) { na[i] = ld4(x + i * 256 + lane * 4); nr[i] = ld4(xr + i * 256 + lane * 4); } }
        const float mean = wave_sum(sum) * (1.f / 1024.f);
        float sq = 0.f;
#pragma unroll
        for (int i = 0; i < 4; ++i) {
            v[i].x -= mean; v[i].y -= mean; v[i].z -= mean; v[i].w -= mean;
            sq += v[i].x * v[i].x + v[i].y * v[i].y + v[i].z * v[i].z + v[i].w * v[i].w;
        }
        const float rstd = rsqrtf(wave_sum(sq) * (1.f / 1024.f) + 1e-5f);
        float* d = (r < ncx) ? (dst_cx + (size_t)r * 1024) : (dst_lat + (size_t)(r - ncx) * 1024);
#pragma unroll
        for (int i = 0; i < 4; ++i) {
            const int c = i * 256 + lane * 4;
            const float4 y = make_float4(v[i].x * rstd * gg[i].x + bb[i].x, v[i].y * rstd * gg[i].y + bb[i].y, v[i].z * rstd * gg[i].z + bb[i].z, v[i].w * rstd * gg[i].w + bb[i].w);
            st4(d + c, y);
            if (hb != nullptr) {
                const float* m = (r < ncx) ? mvc : mvl;
                const float4 sh = ld4(m + c), sc = ld4(m + 1024 + c);
                *(uint2*)(hb + (size_t)r * 1024 + c) = make_uint2(pack2bf(y.x * (1.f + sc.x) + sh.x, y.y * (1.f + sc.y) + sh.y), pack2bf(y.z * (1.f + sc.z) + sh.z, y.w * (1.f + sc.w) + sh.w));
            }
        }
    }
}
DEV void phase_h1l(const Params& p) {
    const float* modv1 = (const float*)(p.ws + OFF_MODV) + 3 * 3072;
    bf16_t* H1 = (bf16_t*)(p.ws + OFF_H1B);
    const size_t gt = (size_t)blockIdx.x * NTHR + opaque_tid(), gn = (size_t)gridDim.x * NTHR;
    const int k = (int)(gt & 127) * 8;
    const Mod8 m0 = mod8_load(modv1, k), m1 = mod8_load(modv1 + 3072, k);
    constexpr size_t NI = (size_t)NB * NL * 128;
    for (size_t i0 = gt; i0 < NI; i0 += 4 * gn) {
        float4 xa[4], xb[4];
#pragma unroll
        for (int u = 0; u < 4; ++u) { const size_t i = i0 + u * gn, r = (i < NI ? i : gt) >> 7; xa[u] = ld4(p.out + r * DM + k); xb[u] = ld4(p.out + r * DM + k + 4); }
#pragma unroll
        for (int u = 0; u < 4; ++u) { const size_t i = i0 + u * gn, r = i >> 7; if (i < NI) *(uint4*)(H1 + r * DM + k) = mod8_apply(xa[u], xb[u], (r >= (size_t)NL) ? m1 : m0); }
    }
}

DEV void zero_f4(float* ptr, size_t nfloat) {
    const size_t n4 = nfloat / 4;
    for (size_t i = (size_t)blockIdx.x * NTHR + opaque_tid(); i < n4; i += (size_t)gridDim.x * NTHR) ((float4*)ptr)[i] = make_float4(0.f, 0.f, 0.f, 0.f);
}

DEV void chain_ids(int& chain, int& sub) {
    const int bid = blockIdx.x, xcd = bid & 7, idx = bid >> 3;
    chain = xcd * 2 + (idx >> 4); sub = idx & 15;
}

DEV void phase_conv1(const Params& p, float* sm) {
    const bf16_t* XM = (const bf16_t*)(p.ws + OFF_XM);
    bf16_t* XC = (bf16_t*)(p.ws + OFF_XC);
    float* G16P = (float*)(p.ws + OFF_G16P);
    const bf16_t* WFT = (const bf16_t*)(p.ws + OFF_WFT);
    const float* cw = p.in[31]; const float* cbias = p.in[32];
    bf16_t* imgC = (bf16_t*)sm;
    bf16_t* imgM = imgC + 64 * 264;
    float* red = (float*)(imgM + 64 * 264);
    float* cwl = red + 1024;
    const int tid = opaque_tid(), lane = tid & 63, wave = tid >> 6, t = tid >> 3, cg = tid & 7;
    for (int u = blockIdx.x; u < NB * NCH * 4; u += gridDim.x) {
        const int ci = u >> 2, q = u & 3, b = ci / NCH, c = ci % NCH, s = c * 64 + t;
        const size_t rowbase = (size_t)b * TB;
        int nrow[9]; unsigned vmask = 0u;
#pragma unroll
        for (int i = 0; i < 3; ++i)
#pragma unroll
            for (int j = 0; j < 3; ++j) {
                int ns = -1;
                if (s < NCX) { const int w2 = s + j - 1; if (i == 1 && w2 >= 0 && w2 < NCX) ns = w2; }
                else { const int n = s - NCX, rr = (n >> 6) + i - 1, w2 = (n & 63) + j - 1; if (rr >= 0 && rr < 128 && w2 >= 0 && w2 < 64) ns = NCX + rr * 64 + w2; }
                nrow[i * 3 + j] = ns >= 0 ? ns : s; vmask |= (ns >= 0 ? 1u : 0u) << (i * 3 + j);
            }
        const int tt = wave & 3, part = wave >> 2;
        f32x4 acc = (f32x4){0.f, 0.f, 0.f, 0.f};
        uint4 xn[9];
#pragma unroll
        for (int tap = 0; tap < 9; ++tap) xn[tap] = *(const uint4*)(XM + (rowbase + nrow[tap]) * 2048 + q * 512 + cg * 8);
#pragma unroll 1
        for (int half = 0; half < 2; ++half) {
            __syncthreads();
            for (int i = tid; i < 640; i += NTHR) { const int tp = i >> 6, c4 = (i & 63) * 4; st4(cwl + tp * 256 + c4, ld4((tp < 9 ? cw + tp * 2048 : cbias) + q * 512 + half * 256 + c4)); }
            __syncthreads();
#pragma unroll 1
            for (int it = 0; it < 4; ++it) {
                const int cl = it * 64 + cg * 8, c0 = q * 512 + half * 256 + cl;
                uint4 xc9[9];
#pragma unroll
                for (int tap = 0; tap < 9; ++tap) xc9[tap] = xn[tap];
                { const int gn = half * 4 + it + 1, c0n = q * 512 + (gn < 8 ? gn : 7) * 64 + cg * 8;
#pragma unroll
                  for (int tap = 0; tap < 9; ++tap) xn[tap] = *(const uint4*)(XM + (rowbase + nrow[tap]) * 2048 + c0n); }
                float a8[8];
                { const float4 b0 = ld4(cwl + 9 * 256 + cl), b1 = ld4(cwl + 9 * 256 + cl + 4); a8[0] = b0.x; a8[1] = b0.y; a8[2] = b0.z; a8[3] = b0.w; a8[4] = b1.x; a8[5] = b1.y; a8[6] = b1.z; a8[7] = b1.w; }
#pragma unroll
                for (int tap = 0; tap < 9; ++tap) {
                    const unsigned mk = ((vmask >> tap) & 1u) ? 0xffffffffu : 0u;
                    const uint4 xv = make_uint4(xc9[tap].x & mk, xc9[tap].y & mk, xc9[tap].z & mk, xc9[tap].w & mk);
                    float x8[8]; unpack8(xv, x8);
                    const float4 w0 = ld4(cwl + tap * 256 + cl), w1 = ld4(cwl + tap * 256 + cl + 4);
                    a8[0] += x8[0] * w0.x; a8[1] += x8[1] * w0.y; a8[2] += x8[2] * w0.z; a8[3] += x8[3] * w0.w;
                    a8[4] += x8[4] * w1.x; a8[5] += x8[5] * w1.y; a8[6] += x8[6] * w1.z; a8[7] += x8[7] * w1.w;
                }
#pragma unroll
                for (int i = 0; i < 8; ++i) a8[i] = silu_f(a8[i]);
                const uint4 xcv = pack8(a8);
                *(uint4*)(XC + (rowbase + s) * 2048 + c0) = xcv;
                *(uint4*)(imgC + t * 264 + cl) = xcv;
                *(uint4*)(imgM + t * 264 + cl) = xc9[4];
            }
            __syncthreads();
            {
                const bf16_t* img = part ? imgM : imgC;
                const bf16_t* wrow = WFT + (size_t)(lane & 15) * 4096 + part * 2048 + q * 512 + half * 256 + (lane >> 4) * 8;
#pragma unroll
                for (int ks = 0; ks < 8; ++ks) acc = __builtin_amdgcn_mfma_f32_16x16x32_bf16(row_frag(img, 264, tt * 16, ks * 32, lane), *(const bf16x8*)(wrow + ks * 32), acc, 0, 0, 0);
            }
        }
        if (part == 1) {
#pragma unroll
            for (int r = 0; r < 4; ++r) red[(tt * 16 + (lane >> 4) * 4 + r) * 16 + (lane & 15)] = acc[r];
        }
        __syncthreads();
        if (part == 0) {
#pragma unroll
            for (int r = 0; r < 4; ++r) {
                const int tk = tt * 16 + (lane >> 4) * 4 + r;
                G16P[(((size_t)rowbase + c * 64 + tk) * 16 + (lane & 15)) * 4 + q] = acc[r] + red[tk * 16 + (lane & 15)];
            }
        }
    }
}

struct GateRaw { float4 a, f; };
DEV GateRaw gate_load(const Params& p, size_t row, int dir, int h) {
    const float* G16P = (const float*)(p.ws + OFF_G16P);
    GateRaw g; g.a = ld4(G16P + (row * 16 + dir * 8 + h) * 4); g.f = ld4(G16P + (row * 16 + dir * 8 + 4 + h) * 4);
    return g;
}
DEV void gate_fin(const GateRaw& g, float bi, float bf, float& gi, float& lf) {
    gi = (g.a.x + g.a.y) + (g.a.z + g.a.w) + bi;
    lf = logsig_f((g.f.x + g.f.y) + (g.f.z + g.f.w) + bf);
}
DEV void gate_pair(const Params& p, size_t row, int dir, int h, float& gi, float& lf) {
    const GateRaw g = gate_load(p, row, dir, h);
    gate_fin(g, p.in[dir ? 41 : 37][h], p.in[dir ? 43 : 39][h], gi, lf);
}

DEV void phase_x1(const Params& p, float* sm) {
    int chain, sub; chain_ids(chain, sub);
    const int b = chain >> 3, h = (chain >> 1) & 3, dir = chain & 1;
    const bf16_t* XC = (const bf16_t*)(p.ws + OFF_XC);
    float* GSC = (float*)(p.ws + OFF_GSC); float* CSC = (float*)(p.ws + OFF_CSC); float* NBUF = (float*)(p.ws + OFF_NBUF);
    const float* gtab = (const float*)(p.ws + OFF_GTAB);
    bf16_t* SMAT = (bf16_t*)(p.ws + OFF_SMAT);
    const int tid = opaque_tid(), lane = tid & 63, wave = tid >> 6;
    float* sTot = sm; float* sRef = sm + 132; float* sM0 = sm + 264; float* sBeta = sm + 400;
    const float bias_i = p.in[dir ? 41 : 37][h], bias_f = p.in[dir ? 43 : 39][h];
    {
        GateRaw gn = gate_load(p, (size_t)b * TB + wave * 64 + lane, dir, h);
        for (int c = wave; c < NCH; c += NWV) {
            const GateRaw gc = gn;
            const int cn = (c + NWV < NCH) ? c + NWV : c;
            gn = gate_load(p, (size_t)b * TB + cn * 64 + lane, dir, h);
            float gi, lf; gate_fin(gc, bias_i, bias_f, gi, lf);
            const float bc = wave_scan_add(lf, lane, dir);
            const float ref = wave_max(gi - bc), tot = wave_sum(lf);
            if (lane == 0) { sTot[c] = tot; sRef[c] = ref; }
        }
    }
    __syncthreads();
    if (tid == 0) {
        float m0 = -INFINITY;
        for (int step = 0; step < NCH; ++step) {
            const int c = chunk_at(dir, step);
            sM0[c] = m0;
            const float mx = fmaxf(m0, sRef[c]);
            if (sub == 0) { CSC[(chain * NCH + c) * 2] = fexp(m0 - mx); CSC[(chain * NCH + c) * 2 + 1] = fexp(sRef[c] - mx); }
            m0 = sTot[c] + mx;
        }
    }
    __syncthreads();
    for (int k = wave; sub + 16 * k < NCH; k += NWV) {
        const int c = sub + 16 * k;
        const size_t row = (size_t)b * TB + c * 64 + lane;
        float gi, lf; gate_fin(gate_load(p, row, dir, h), bias_i, bias_f, gi, lf);
        const float bc = wave_scan_add(lf, lane, dir);
        const float a = gi - bc;
        const float amax = wave_scan_max(a, lane, dir);
        const float ref = sRef[c], m0 = sM0[c];
        const float mmax = fmaxf(amax, m0);
        const float mt = bc + mmax;
        const float alpha = fexp(ref - mmax), beta = fexp(a - ref), gg = fexp(m0 - mmax), em = fexp(-mt);
        st4(GSC + ((size_t)chain * TB + c * 64 + lane) * 4, make_float4(alpha, beta, gg, em));
        sBeta[k * 64 + lane] = beta;
    }
    __syncthreads();
    {
        float* part = sm + 1024;
        const int sg = tid >> 6, j8 = (tid & 63) * 8;
        uint4 xn[8];
        { const bf16_t* xp = XC + ((size_t)b * TB + sub * 64 + sg * 8) * 2048 + h * 512 + j8;
#pragma unroll
          for (int s = 0; s < 8; ++s) xn[s] = *(const uint4*)(xp + (size_t)s * 2048); }
        for (int k = 0; sub + 16 * k < NCH; ++k) {
            const int c = sub + 16 * k;
            uint4 xcur[8];
#pragma unroll
            for (int s = 0; s < 8; ++s) xcur[s] = xn[s];
            { const int cn = (c + 16 < NCH) ? c + 16 : c; const bf16_t* xp = XC + ((size_t)b * TB + cn * 64 + sg * 8) * 2048 + h * 512 + j8;
#pragma unroll
              for (int s = 0; s < 8; ++s) xn[s] = *(const uint4*)(xp + (size_t)s * 2048); }
            float acc[8];
#pragma unroll
            for (int i = 0; i < 8; ++i) acc[i] = 0.f;
#pragma unroll
            for (int s = 0; s < 8; ++s) {
                float f[8]; unpack8(xcur[s], f);
                const float be = sBeta[k * 64 + sg * 8 + s];
#pragma unroll
                for (int i = 0; i < 8; ++i) acc[i] += be * f[i];
            }
            __syncthreads();
            st4(part + sg * 512 + j8, make_float4(acc[0], acc[1], acc[2], acc[3])); st4(part + sg * 512 + j8 + 4, make_float4(acc[4], acc[5], acc[6], acc[7]));
            __syncthreads();
            float tot = 0.f;
#pragma unroll
            for (int q = 0; q < 8; ++q) tot += part[q * 512 + tid];
            NBUF[((size_t)chain * NCH + c) * 512 + tid] = tot;
        }
    }
    bf16_t* XCs = (bf16_t*)sm;
    bf16_t* Qs = XCs + 64 * 520;
    for (int u = blockIdx.x; u < NB * 4 * NCH; u += gridDim.x) {
        const int bh = u / NCH, c = u % NCH, ub = bh >> 2, uh = bh & 3;
        __syncthreads();
        float4 gq[2][4];
#pragma unroll
        for (int bb = 0; bb < 2; ++bb) { const float* G = gtab + (size_t)(uh * 128 + (tid & 63) * 2 + bb) * 16; gq[bb][0] = ld4(G); gq[bb][1] = ld4(G + 4); gq[bb][2] = ld4(G + 8); gq[bb][3] = ld4(G + 12); }
        uint4 xr[8];
#pragma unroll
        for (int i = 0; i < 8; ++i) { const int pp = tid + 512 * i, row = pp >> 6, c16 = pp & 63; xr[i] = *(const uint4*)(XC + ((size_t)ub * TB + c * 64 + row) * 2048 + uh * 512 + c16 * 8); }
#pragma unroll
        for (int i = 0; i < 8; ++i) {
            const int pp = tid + 512 * i, row = pp >> 6, c16 = pp & 63;
            const uint4 xv = xr[i];
            float f[8]; unpack8(xv, f);
            float q[8];
#pragma unroll
            for (int bb = 0; bb < 2; ++bb) {
                const float4 g0 = gq[bb][0], g1 = gq[bb][1], g2 = gq[bb][2], g3 = gq[bb][3];
                q[bb * 4 + 0] = f[bb * 4] * g0.x + f[bb * 4 + 1] * g1.x + f[bb * 4 + 2] * g2.x + f[bb * 4 + 3] * g3.x;
                q[bb * 4 + 1] = f[bb * 4] * g0.y + f[bb * 4 + 1] * g1.y + f[bb * 4 + 2] * g2.y + f[bb * 4 + 3] * g3.y;
                q[bb * 4 + 2] = f[bb * 4] * g0.z + f[bb * 4 + 1] * g1.z + f[bb * 4 + 2] * g2.z + f[bb * 4 + 3] * g3.z;
                q[bb * 4 + 3] = f[bb * 4] * g0.w + f[bb * 4 + 1] * g1.w + f[bb * 4 + 2] * g2.w + f[bb * 4 + 3] * g3.w;
            }
            *(uint4*)(XCs + row * 520 + c16 * 8) = xv;
            *(uint4*)(Qs + row * 520 + c16 * 8) = make_uint4(pack2bf(q[0], q[1]), pack2bf(q[2], q[3]), pack2bf(q[4], q[5]), pack2bf(q[6], q[7]));
        }
        __syncthreads();
        const int st = wave & 3, tt0 = (wave >> 2) * 2;
        f32x4 a0 = (f32x4){0.f, 0.f, 0.f, 0.f}, a1 = a0;
        const bf16_t* ap = XCs + (st * 16 + (lane & 15)) * 520 + (lane >> 4) * 8;
        const bf16_t* bp0 = Qs + (tt0 * 16 + (lane & 15)) * 520 + (lane >> 4) * 8;
        const bf16_t* bp1 = bp0 + 16 * 520;
#pragma unroll
        for (int ks = 0; ks < 16; ++ks) {
            const bf16x8 af = *(const bf16x8*)(ap + ks * 32);
            a0 = __builtin_amdgcn_mfma_f32_16x16x32_bf16(af, *(const bf16x8*)(bp0 + ks * 32), a0, 0, 0, 0);
            a1 = __builtin_amdgcn_mfma_f32_16x16x32_bf16(af, *(const bf16x8*)(bp1 + ks * 32), a1, 0, 0, 0);
        }
        bf16_t* sp = SMAT + (size_t)u * 4096 + (size_t)(tt0 * 16 + (lane & 15)) * 64 + st * 16 + (lane >> 4) * 4;
        *(uint2*)sp = make_uint2(pack2bf(a0[0], a0[1]), pack2bf(a0[2], a0[3]));
        *(uint2*)(sp + 16 * 64) = make_uint2(pack2bf(a1[0], a1[1]), pack2bf(a1[2], a1[3]));
    }
}

DEV void phase_x2(const Params& p, float* sm) {
    int chain, sub; chain_ids(chain, sub);
    const int b = chain >> 3, h = (chain >> 1) & 3, dir = chain & 1;
    const bf16_t* XC = (const bf16_t*)(p.ws + OFF_XC);
    float* GSC = (float*)(p.ws + OFF_GSC); const float* CSC = (const float*)(p.ws + OFF_CSC); const float* NBUF = (const float*)(p.ws + OFF_NBUF);
    const float* gtab = (const float*)(p.ws + OFF_GTAB);
    const bf16_t* SMAT = (const bf16_t*)(p.ws + OFF_SMAT);
    const int tid = opaque_tid();
    float* sD0 = sm; float* sCf = sm + 132; float* sN0 = sm + 264; float* sN2 = sN0 + 9 * 512;
    for (int i = tid; i < NCH; i += NTHR) { sD0[i] = CSC[(chain * NCH + i) * 2]; sCf[i] = CSC[(chain * NCH + i) * 2 + 1]; }
    __syncthreads();
    float* sBeta = sN2 + 9 * 512;
    for (int i = tid; i < 9 * 64; i += NTHR) { const int k = i >> 6, c = sub + 16 * k; if (c < NCH) sBeta[i] = GSC[((size_t)chain * TB + c * 64 + (i & 63)) * 4 + 1]; }
    if (tid < 128) {
        constexpr int NBT = 12;
        float4 n = make_float4(0.f, 0.f, 0.f, 0.f), nx[NBT];
        const float* nb = NBUF + (size_t)chain * NCH * 512 + tid * 4;
#pragma unroll
        for (int j = 0; j < NBT; ++j) nx[j] = ld4(nb + (size_t)chunk_at(dir, j) * 512);
#pragma unroll 1
        for (int step0 = 0; step0 < NCH; step0 += NBT) {
            float4 cu[NBT];
#pragma unroll
            for (int j = 0; j < NBT; ++j) cu[j] = nx[j];
#pragma unroll
            for (int j = 0; j < NBT; ++j) { const int sn = step0 + NBT + j; nx[j] = ld4(nb + (size_t)chunk_at(dir, sn < NCH ? sn : NCH - 1) * 512); }
            __builtin_amdgcn_sched_barrier(0);
#pragma unroll
            for (int j = 0; j < NBT; ++j) {
                const int c = chunk_at(dir, step0 + j);
                if ((c & 15) == sub) st4(sN0 + (c >> 4) * 512 + tid * 4, n);
                const float d = sD0[c], cf = sCf[c];
                n = make_float4(d * n.x + cf * cu[j].x, d * n.y + cf * cu[j].y, d * n.z + cf * cu[j].z, d * n.w + cf * cu[j].w);
            }
        }
    }
    __syncthreads();
    {
        const int blk = tid >> 2, cp = tid & 3;
        const float4 g = ld4(gtab + (size_t)(h * 128 + blk) * 16 + cp * 4);
        for (int k = 0; sub + 16 * k < NCH; ++k) {
            const float* n0 = sN0 + k * 512 + blk * 4;
            sN2[k * 512 + tid] = g.x * n0[0] + g.y * n0[1] + g.z * n0[2] + g.w * n0[3];
        }
    }
    __syncthreads();
    const int t = tid >> 3, part = tid & 7;
    for (int k = 0; sub + 16 * k < NCH; ++k) {
        const int c = sub + 16 * k;
        const size_t row = (size_t)b * TB + c * 64 + t;
        float dint = 0.f;
        {
            const bf16_t* xp = XC + row * 2048 + h * 512 + part * 64;
            const float* n2 = sN2 + k * 512 + part * 64;
#pragma unroll
            for (int i = 0; i < 8; ++i) {
                float f[8]; unpack8(*(const uint4*)(xp + i * 8), f);
                const float4 na = ld4(n2 + i * 8), nb2 = ld4(n2 + i * 8 + 4);
                dint += f[0] * na.x + f[1] * na.y + f[2] * na.z + f[3] * na.w + f[4] * nb2.x + f[5] * nb2.y + f[6] * nb2.z + f[7] * nb2.w;
            }
        }
        float di = 0.f;
        {
            float f[8]; unpack8(*(const uint4*)(SMAT + ((size_t)((b * 4 + h) * NCH + c)) * 4096 + t * 64 + part * 8), f);
#pragma unroll
            for (int e = 0; e < 8; ++e) {
                const int s = part * 8 + e;
                const float beta = sBeta[k * 64 + s];
                const bool keep = dir ? (s >= t) : (s <= t);
                di += keep ? f[e] * beta : 0.f;
            }
        }
        dint += __shfl_xor(dint, 1, 64); dint += __shfl_xor(dint, 2, 64); dint += __shfl_xor(dint, 4, 64);
        di += __shfl_xor(di, 1, 64); di += __shfl_xor(di, 2, 64); di += __shfl_xor(di, 4, 64);
        if (part == 0) {
            float* gp = GSC + ((size_t)chain * TB + c * 64 + t) * 4;
            const float4 g4 = ld4(gp);
            const float den = g4.x * di + g4.z * dint;
            gp[3] = 1.f / fmaxf(fabsf(den), g4.w);
        }
    }
}

#define MLSTM_PREFETCH(step_) do { \
    const int c_ = chunk_at(dir, (step_)); const size_t rb_ = (size_t)b * TB + (size_t)c_ * 64; \
    { const bf16_t* xb_ = XC + (rb_ + (tid >> 6)) * 2048 + h * 512 + (tid & 63) * 8; \
      rx0 = *(const uint4*)(xb_); rx1 = *(const uint4*)(xb_ + 8 * 2048); rx2 = *(const uint4*)(xb_ + 16 * 2048); rx3 = *(const uint4*)(xb_ + 24 * 2048); \
      rx4 = *(const uint4*)(xb_ + 32 * 2048); rx5 = *(const uint4*)(xb_ + 40 * 2048); rx6 = *(const uint4*)(xb_ + 48 * 2048); rx7 = *(const uint4*)(xb_ + 56 * 2048); } \
    rxm = *(const uint2*)(XM + (rb_ + ps) * 2048 + ch0 + pvb * 4); \
    rs = *(const uint4*)(SMAT + ((size_t)((b * 4 + h) * NCH + c_)) * 4096 + ps * 64 + pvb * 8); \
    rbeta = GSC[((size_t)chain * TB + c_ * 64 + ps) * 4 + 1]; \
    if (tid < 64) rsc = ld4(GSC + ((size_t)chain * TB + c_ * 64 + tid) * 4); \
    rd0 = CSC[(chain * NCH + c_) * 2]; rcf = CSC[(chain * NCH + c_) * 2 + 1]; } while (0)

DEV void phase_mlstm(const Params& p, float* sm) {
    int chain, sub; chain_ids(chain, sub);
    const int b = chain >> 3, h = (chain >> 1) & 3, dir = chain & 1;
    const bf16_t* XM = (const bf16_t*)(p.ws + OFF_XM);
    const bf16_t* XC = (const bf16_t*)(p.ws + OFF_XC);
    const bf16_t* SMAT = (const bf16_t*)(p.ws + OFF_SMAT);
    const float* GSC = (const float*)(p.ws + OFF_GSC); const float* CSC = (const float*)(p.ws + OFF_CSC);
    const float* gtab = (const float*)(p.ws + OFF_GTAB);
    bf16_t* H = (bf16_t*)(p.ws + OFF_H);
    const float* wv = p.in[35];
    char* smc = (char*)sm;
    bf16_t* XCs = (bf16_t*)smc;
    bf16_t* Cs = (bf16_t*)(smc + 66560);
    bf16_t* Vb = (bf16_t*)(smc + 66560 + 33280);
    bf16_t* Vw = Vb + 32 * 72;
    bf16_t* Sm = Vw + 32 * 72;
    float* Gs = (float*)(smc + 66560 + 33280 + 2 * 4608 + 9216);
    float* sc = Gs + 2048;
    const int tid = opaque_tid(), lane = tid & 63, wave = tid >> 6;
    for (int i = tid; i < 32 * 520 / 2; i += NTHR) ((unsigned*)Cs)[i] = 0u;
    for (int i = tid; i < 2048; i += NTHR) Gs[i] = gtab[h * 2048 + i];
    const int ps = tid >> 3, pvb = tid & 7;
    const int ch0 = h * 512 + sub * 32;
    float wvr[16];
#pragma unroll
    for (int i = 0; i < 16; ++i) wvr[i] = wv[(size_t)((ch0 >> 2) + pvb) * 16 + i];
    f32x4 accS[4][2];
#pragma unroll
    for (int i = 0; i < 4; ++i) { accS[i][0] = (f32x4){0.f, 0.f, 0.f, 0.f}; accS[i][1] = (f32x4){0.f, 0.f, 0.f, 0.f}; }
    uint4 rx0, rx1, rx2, rx3, rx4, rx5, rx6, rx7; uint2 rxm; uint4 rs; float rbeta; float4 rsc = make_float4(0.f, 0.f, 0.f, 0.f); float rd0, rcf;
    MLSTM_PREFETCH(0);
    __syncthreads();
#pragma unroll 1
    for (int step = 0; step < NCH; ++step) {
        const int c = chunk_at(dir, step);
        const float d0 = rd0, cf = rcf;
        {
            bf16_t* xd = XCs + (tid >> 6) * 520 + (tid & 63) * 8;
            *(uint4*)(xd) = rx0; *(uint4*)(xd + 8 * 520) = rx1; *(uint4*)(xd + 16 * 520) = rx2; *(uint4*)(xd + 24 * 520) = rx3;
            *(uint4*)(xd + 32 * 520) = rx4; *(uint4*)(xd + 40 * 520) = rx5; *(uint4*)(xd + 48 * 520) = rx6; *(uint4*)(xd + 56 * 520) = rx7;
        }
        {
            const float x0 = bflo(rxm.x), x1 = bfhi(rxm.x), x2 = bflo(rxm.y), x3 = bfhi(rxm.y);
#pragma unroll
            for (int d = 0; d < 4; ++d) {
                const float v = (x0 * wvr[d] + x1 * wvr[4 + d] + x2 * wvr[8 + d] + x3 * wvr[12 + d]) * rbeta;
                Vb[(pvb * 4 + d) * 72 + ps] = __builtin_bit_cast(unsigned short, (__bf16)v);
                Vw[(pvb * 4 + d) * 72 + ps] = __builtin_bit_cast(unsigned short, (__bf16)(v * cf));
            }
        }
        {
#define SMASK(q_) (((dir ? (pvb * 8 + 2 * (q_) >= ps) : (pvb * 8 + 2 * (q_) <= ps)) ? 0x0000ffffu : 0u) | ((dir ? (pvb * 8 + 2 * (q_) + 1 >= ps) : (pvb * 8 + 2 * (q_) + 1 <= ps)) ? 0xffff0000u : 0u))
            *(uint4*)(Sm + ps * 72 + pvb * 8) = make_uint4(rs.x & SMASK(0), rs.y & SMASK(1), rs.z & SMASK(2), rs.w & SMASK(3));
#undef SMASK
        }
        if (tid < 64) st4(sc + tid * 4, rsc);
        { const int nstep = (step + 1 < NCH) ? step + 1 : step; MLSTM_PREFETCH(nstep); }
        __syncthreads();
        {
            const int vt = wave & 1, tt = wave >> 1;
            f32x4 ao = (f32x4){0.f, 0.f, 0.f, 0.f}, ai = ao, ao1 = ao, ao2 = ao, ao3 = ao;
            const bf16_t* ap = Cs + (vt * 16 + (lane & 15)) * 520 + (lane >> 4) * 8;
            const bf16_t* bp = XCs + (tt * 16 + (lane & 15)) * 520 + (lane >> 4) * 8;
#pragma unroll
            for (int ks = 0; ks < 16; ks += 4) {
                ao = __builtin_amdgcn_mfma_f32_16x16x32_bf16(*(const bf16x8*)(ap + ks * 32), *(const bf16x8*)(bp + ks * 32), ao, 0, 0, 0);
                ao1 = __builtin_amdgcn_mfma_f32_16x16x32_bf16(*(const bf16x8*)(ap + (ks + 1) * 32), *(const bf16x8*)(bp + (ks + 1) * 32), ao1, 0, 0, 0);
                ao2 = __builtin_amdgcn_mfma_f32_16x16x32_bf16(*(const bf16x8*)(ap + (ks + 2) * 32), *(const bf16x8*)(bp + (ks + 2) * 32), ao2, 0, 0, 0);
                ao3 = __builtin_amdgcn_mfma_f32_16x16x32_bf16(*(const bf16x8*)(ap + (ks + 3) * 32), *(const bf16x8*)(bp + (ks + 3) * 32), ao3, 0, 0, 0);
            }
            ao = (ao + ao1) + (ao2 + ao3);
            const bf16_t* ap2 = Vb + (vt * 16 + (lane & 15)) * 72 + (lane >> 4) * 8;
            const bf16_t* bp2 = Sm + (tt * 16 + (lane & 15)) * 72 + (lane >> 4) * 8;
#pragma unroll
            for (int ks = 0; ks < 2; ++ks) ai = __builtin_amdgcn_mfma_f32_16x16x32_bf16(*(const bf16x8*)(ap2 + ks * 32), *(const bf16x8*)(bp2 + ks * 32), ai, 0, 0, 0);
            if (c >= 4) {
                const int t = tt * 16 + (lane & 15);
                const float4 s4 = ld4(sc + t * 4);
                const float h0 = (s4.x * ai[0] + s4.z * ao[0]) * s4.w, h1 = (s4.x * ai[1] + s4.z * ao[1]) * s4.w;
                const float h2 = (s4.x * ai[2] + s4.z * ao[2]) * s4.w, h3 = (s4.x * ai[3] + s4.z * ao[3]) * s4.w;
                bf16_t* hp = H + ((size_t)b * NL + (size_t)c * 64 + t - NCX) * 2048 + ch0 + vt * 16 + (lane >> 4) * 4;
                const unsigned u0 = pack2bf(h0, h1), u1 = pack2bf(h2, h3);
                asm volatile("global_atomic_pk_add_bf16 %0, %1, off sc1\n\tglobal_atomic_pk_add_bf16 %0, %2, off offset:4 sc1" :: "v"(hp), "v"(u0), "v"(u1) : "memory");
            }
        }
#pragma unroll
        for (int jt = 0; jt < 4; ++jt) { accS[jt][0] *= d0; accS[jt][1] *= d0; }
#pragma unroll
        for (int ks = 0; ks < 2; ++ks) {
            const bf16x8 b0 = *(const bf16x8*)(Vw + (lane & 15) * 72 + ks * 32 + (lane >> 4) * 8);
            const bf16x8 b1 = *(const bf16x8*)(Vw + (16 + (lane & 15)) * 72 + ks * 32 + (lane >> 4) * 8);
            const int row0 = ks * 32 + (lane >> 4) * 8 + ((lane & 15) >> 2);
#pragma unroll
            for (int jt = 0; jt < 4; ++jt) {
                const int col = wave * 64 + jt * 16 + (lane & 3) * 4;
                const s16x4 lo = __builtin_amdgcn_ds_read_tr16_b64_v4i16((__attribute__((address_space(3))) s16x4*)(XCs + row0 * 520 + col));
                const s16x4 hi = __builtin_amdgcn_ds_read_tr16_b64_v4i16((__attribute__((address_space(3))) s16x4*)(XCs + (row0 + 4) * 520 + col));
                const bf16x8 af = (bf16x8){lo[0], lo[1], lo[2], lo[3], hi[0], hi[1], hi[2], hi[3]};
                accS[jt][0] = __builtin_amdgcn_mfma_f32_16x16x32_bf16(af, b0, accS[jt][0], 0, 0, 0);
                accS[jt][1] = __builtin_amdgcn_mfma_f32_16x16x32_bf16(af, b1, accS[jt][1], 0, 0, 0);
            }
        }
        __syncthreads();
#pragma unroll
        for (int jt = 0; jt < 4; ++jt) {
            const int blk = wave * 16 + jt * 4 + (lane >> 4);
            const float4 g0 = ld4(Gs + blk * 16), g1 = ld4(Gs + blk * 16 + 4), g2 = ld4(Gs + blk * 16 + 8), g3 = ld4(Gs + blk * 16 + 12);
#pragma unroll
            for (int v2 = 0; v2 < 2; ++v2) {
                const f32x4 a = accS[jt][v2];
                const float o0 = g0.x * a[0] + g0.y * a[1] + g0.z * a[2] + g0.w * a[3];
                const float o1 = g1.x * a[0] + g1.y * a[1] + g1.z * a[2] + g1.w * a[3];
                const float o2 = g2.x * a[0] + g2.y * a[1] + g2.z * a[2] + g2.w * a[3];
                const float o3 = g3.x * a[0] + g3.y * a[1] + g3.z * a[2] + g3.w * a[3];
                *(uint2*)(Cs + (v2 * 16 + (lane & 15)) * 520 + blk * 4) = make_uint2(pack2bf(o0, o1), pack2bf(o2, o3));
            }
        }
    }
}

DEV void phase_finish1(const Params& p) {
    bf16_t* H = (bf16_t*)(p.ws + OFF_H);
    const bf16_t* XC = (const bf16_t*)(p.ws + OFF_XC);
    const bf16_t* Z = (const bf16_t*)(p.ws + OFF_XM);
    const float* ng = p.in[44]; const float* skip = p.in[45];
    const int tid_ = opaque_tid(); const int lane = tid_ & 63, gw = blockIdx.x * NWV + (tid_ >> 6), ngw = gridDim.x * NWV;
    const int h = gw & 3, c0 = h * 512 + lane * 8;
    float gn8[8], sk8[8];
    { const float4 a0 = ld4(ng + c0), a1 = ld4(ng + c0 + 4), b0 = ld4(skip + c0), b1 = ld4(skip + c0 + 4);
      gn8[0] = a0.x; gn8[1] = a0.y; gn8[2] = a0.z; gn8[3] = a0.w; gn8[4] = a1.x; gn8[5] = a1.y; gn8[6] = a1.z; gn8[7] = a1.w;
      sk8[0] = b0.x; sk8[1] = b0.y; sk8[2] = b0.z; sk8[3] = b0.w; sk8[4] = b1.x; sk8[5] = b1.y; sk8[6] = b1.z; sk8[7] = b1.w; }
    constexpr int NIT = NB * NL * 4;
    uint4 nh[2], nx[2], nz[2];
#pragma unroll
    for (int u = 0; u < 2; ++u) { const int it = gw + u * ngw, r = (it < NIT ? it : gw) >> 2, b = r >= NL ? 1 : 0, nn = r - b * NL;
        nh[u] = *(const uint4*)(H + (size_t)r * 2048 + c0); nx[u] = *(const uint4*)(XC + ((size_t)b * TB + NCX + nn) * 2048 + c0); nz[u] = *(const uint4*)(Z + (size_t)r * 2048 + c0); }
    for (int it0 = gw; it0 < NIT; it0 += 2 * ngw) {
        uint4 ch[2], cx[2], cz[2];
#pragma unroll
        for (int u = 0; u < 2; ++u) { ch[u] = nh[u]; cx[u] = nx[u]; cz[u] = nz[u]; }
#pragma unroll
        for (int u = 0; u < 2; ++u) { const int it = it0 + (2 + u) * ngw, r = (it < NIT ? it : gw) >> 2, b = r >= NL ? 1 : 0, nn = r - b * NL;
            nh[u] = *(const uint4*)(H + (size_t)r * 2048 + c0); nx[u] = *(const uint4*)(XC + ((size_t)b * TB + NCX + nn) * 2048 + c0); nz[u] = *(const uint4*)(Z + (size_t)r * 2048 + c0); }
#pragma unroll
        for (int u = 0; u < 2; ++u) {
            const int it = it0 + u * ngw, r = it >> 2;
            float v[8]; unpack8(ch[u], v);
            float sum = 0.f;
#pragma unroll
            for (int j = 0; j < 8; ++j) sum += v[j];
            const float mean = wave_sum(sum) * (1.f / 512.f);
            float sq = 0.f;
#pragma unroll
            for (int j = 0; j < 8; ++j) { v[j] -= mean; sq += v[j] * v[j]; }
            const float rstd = rsqrtf(wave_sum(sq) * (1.f / 512.f) + 1e-5f);
            float xc[8], z[8];
            unpack8(cx[u], xc); unpack8(cz[u], z);
            float o[8];
#pragma unroll
            for (int j = 0; j < 8; ++j) o[j] = (v[j] * rstd * gn8[j] + sk8[j] * xc[j]) * silu_f(z[j]);
            if (it < NIT) *(uint4*)(H + (size_t)r * 2048 + c0) = make_uint4(pack2bf(o[0], o[1]), pack2bf(o[2], o[3]), pack2bf(o[4], o[5]), pack2bf(o[6], o[7]));
        }
    }
}

__global__ void __launch_bounds__(NTHR) fwd_kernel(Params p) {
    extern __shared__ __attribute__((aligned(16))) float sm[];
    volatile LAS unsigned* xst = (volatile LAS unsigned*)((LAS char*)sm + (LDS_BYTES - 16));
    if (threadIdx.x == 0) { xst[0] = 0u; xst[1] = 0u; }
    __syncthreads();
    const XcdBarrier xbar = xcd_barrier_post((unsigned*)(p.ws + OFF_BAR), xst);
    const int tid = opaque_tid(), lane = tid & 63, wave = tid >> 6;
    float* modv = (float*)(p.ws + OFF_MODV);
    float* X1C = (float*)(p.ws + OFF_X1C);

    phase_mod(p, sm);
    phase_tables(p);
    transpose_convert(p.in[8], 1024, EIN, 4096, (bf16_t*)(p.ws + OFF_WT0), sm);
    transpose_convert(p.in[29], 1024, 4096, 4096, (bf16_t*)(p.ws + OFF_WT1), sm);
    transpose_convert(p.in[9], 1024, 1024, 1024, (bf16_t*)(p.ws + OFF_WT2), sm);
    transpose_convert(p.in[30], 2048, 1024, 1024, (bf16_t*)(p.ws + OFF_WT3), sm);
    xcd_barrier(xbar);

#pragma unroll 1
    for (int b = 0; b < NB; ++b) {
        if (b == 0) { phase_h0(p, 0); xcd_barrier(xbar); }
        run_gemm((const bf16_t*)(p.ws + OFF_YC), (const bf16_t*)(p.ws + OFF_WT0), TB, 3840, DM, EpBf16{(bf16_t*)(p.ws + OFF_P0), EIN, EIN}, sm);
        mini_gemm<3, 2>((const bf16_t*)(p.ws + OFF_YC), DM, 33 * (int)blockIdx.x, TB - 1, (const bf16_t*)(p.ws + OFF_WT0), DM, 3840, (bf16_t*)(p.ws + OFF_P0), EIN, 3840, 33, sm);
        xcd_barrier(xbar);
        {
            const int x = blockIdx.x & 7, q0 = blockIdx.x >> 3;
            R1Raw R;
            r1_consts(p, x, q0 & 1, sm);
            r1_load(p, x, q0 & 1, q0 >> 1, R);
            for (int q = q0; q < 2 * NCH; q += 32) rwkv1_unit(p, x, q & 1, q >> 1, sm, R, (q + 32 < 2 * NCH) ? ((q + 32) >> 1) : -1);
            gla_consts(p, x >> 1, sm);
            if (q0 < 8) { for (int g = 2 * q0; g < 2 * q0 + 2; ++g) gla1_unit(p, x >> 1, g & 1, (NCH / 2) * (x & 1) + (g >> 1), sm); }
            else { for (int g = 16 + (q0 - 8); g < NCH; g += 24) gla1_unit(p, x >> 1, g & 1, (NCH / 2) * (x & 1) + (g >> 1), sm); }
        }
        xcd_barrier(xbar);
        if (blockIdx.x < 128) gla2_unit(p, blockIdx.x);
        else if (blockIdx.x < 192) { const int i = (blockIdx.x - 128) >> 3; rwkv2_unit(p, (blockIdx.x & 7) * 2 + (i >> 2), i & 3, sm); }
        xcd_barrier(xbar);
        {
            const int x = blockIdx.x & 7, j = blockIdx.x >> 3;
            gla_consts(p, x >> 1, sm);
            const int r0 = j < 2 ? 2 * j : (j < 10 ? 4 + (j - 2) * 5 : 44 + (j - 10) * 4), nr = j < 2 ? 2 : (j < 10 ? 5 : 4);
            for (int r = r0; r < r0 + nr; ++r) rwkv3_unit(p, x, r, sm);
            for (int g = j; g < NCH / 2; g += 32) gla3_unit(p, x >> 1, (NCH / 2) * (x & 1) + g, sm);
        }
        xcd_barrier(xbar);
        run_gemm((const bf16_t*)(p.ws + OFF_YC), (const bf16_t*)(p.ws + OFF_WT2), TB, DM, DM, EpRes0{(float*)(p.ws + OFF_P0), modv, b}, sm);
        xcd_barrier(xbar);
        ln_rows((const float*)(p.ws + OFF_P0), p.in[0] + (size_t)b * NL * DM, p.in[2] + (size_t)b * NCX * DM, TB, p.in[6], p.in[7], p.out + (size_t)b * NL * DM, X1C + (size_t)b * NCX * DM, NCX,
                (bf16_t*)(p.ws + OFF_H1B) + (size_t)b * TB * DM, modv + (3 + 2) * 3072, modv + (3 + b) * 3072);
        if (b == 0) phase_h0(p, 1);
        xcd_barrier(xbar);
    }

    run_gemm((const bf16_t*)(p.ws + OFF_H1B), (const bf16_t*)(p.ws + OFF_WT1), RT, 2048, DM, EpBf16{(bf16_t*)(p.ws + OFF_XM), 2048, 2048}, sm);
    zero_f4((float*)(p.ws + OFF_H), (size_t)NB * NL * 1024);
    xcd_barrier(xbar);
    phase_conv1(p, sm);
    xcd_barrier(xbar);
    phase_x1(p, sm);
    xcd_barrier(xbar);
    phase_x2(p, sm);
    xcd_barrier(xbar);
    phase_mlstm(p, sm);
    xcd_barrier(xbar);
    phase_h1l(p);
    xcd_barrier(xbar);
    run_gemm((const bf16_t*)(p.ws + OFF_H1B), (const bf16_t*)(p.ws + OFF_WT1) + (size_t)2048 * 1024, NB * NL, 2048, DM, EpBf16{(bf16_t*)(p.ws + OFF_XM), 2048, 2048}, sm);
    xcd_barrier(xbar);
    phase_finish1(p);
    xcd_barrier(xbar);
    run_gemm((const bf16_t*)(p.ws + OFF_H), (const bf16_t*)(p.ws + OFF_WT3), NB * NL, DM, 2048, EpRes1{(float*)(p.ws + OFF_XC), modv + 3 * 3072}, sm);
    xcd_barrier(xbar);
    ln_rows((const float*)(p.ws + OFF_XC), p.out, p.out, NB * NL, p.in[6] + 1024, p.in[7] + 1024, p.out, p.out, 0);
}

extern "C" void kernel_launch(void* const* d_in, const int* in_sizes, int n_in, void* d_out, int out_size, void* d_ws, size_t ws_size, hipStream_t stream) {
    static int grid_blocks = 0;
    if (grid_blocks == 0) {
        if (ws_size < WS_NEED || n_in != 46) { fprintf(stderr, "kernel_launch: bad ws_size %zu (need %zu) or n_in %d\n", ws_size, (size_t)WS_NEED, n_in); grid_blocks = -1; return; }
        int dev = 0, cus = 0, per_cu = 0;
        (void)hipGetDevice(&dev);
        (void)hipDeviceGetAttribute(&cus, hipDeviceAttributeMultiprocessorCount, dev);
        (void)hipFuncSetAttribute((const void*)fwd_kernel, hipFuncAttributeMaxDynamicSharedMemorySize, LDS_BYTES);
        (void)hipOccupancyMaxActiveBlocksPerMultiprocessor(&per_cu, (const void*)fwd_kernel, NTHR, LDS_BYTES);
        if (per_cu < 1 || cus < 256) { fprintf(stderr, "kernel_launch: occupancy query says %d blocks/CU on %d CUs; this kernel needs 256 resident workgroups\n", per_cu, cus); grid_blocks = -1; return; }
        grid_blocks = 256;
    }
    if (grid_blocks < 0) return;
    (void)hipMemsetAsync((char*)d_ws + OFF_BAR, 0, XCD_BAR_WORDS * 4, stream);
    Params p{};
    for (int i = 0; i < 46; ++i) p.in[i] = (const float*)d_in[i];
    p.out = (float*)d_out; p.ws = (char*)d_ws;
    void* args[] = {&p};
    hipError_t e = hipLaunchCooperativeKernel((const void*)fwd_kernel, dim3(grid_blocks), dim3(NTHR), args, LDS_BYTES, stream);
    if (e != hipSuccess) fprintf(stderr, "cooperative launch failed: %s (grid %d)\n", hipGetErrorString(e), grid_blocks);
}
```

```cpp
#include <hip/hip_runtime.h>
#include <cstdio>
#include <cmath>

#define DEV __device__ __forceinline__

constexpr int NB = 2, NL = 8192, DM = 1024, NCX = 256, TB = NCX + NL;
constexpr int RT = NB * TB;
constexpr int NCH = TB / 64;
constexpr int EIN = 3872, RW0 = 1568;
constexpr int NTHR = 512, NWV = 8;
constexpr float ALPHA = 1.41421356237f;
constexpr float KSCALE = 0.04419417382f;

constexpr size_t OFF_MODV = 0;
constexpr size_t OFF_X1C  = 131072;
constexpr size_t OFF_BAR  = 3145728;
constexpr size_t OFF_BIG  = 4194304;
constexpr size_t OFF_P0   = OFF_BIG;
constexpr size_t OFF_YC   = OFF_BIG + (size_t)TB * EIN * 2;
constexpr size_t OFF_GDS  = OFF_YC + (size_t)TB * 1024 * 2;
constexpr size_t OFF_GDEC = OFF_GDS + (size_t)8 * NCH * 8192 * 4;
constexpr size_t OFF_RU   = OFF_GDEC + (size_t)8 * NCH * 64 * 4;
constexpr size_t OFF_RS0  = OFF_RU + (size_t)16 * NCH * 16384 * 2;
constexpr size_t OFF_BONS = OFF_RS0 + (size_t)16 * NCH * 4096 * 2;
constexpr size_t L0_END   = OFF_BONS + (size_t)2 * TB * 8 * 4;
constexpr size_t OFF_XM   = OFF_BIG;
constexpr size_t OFF_XC   = OFF_XM + (size_t)RT * 2048 * 2;
constexpr size_t OFF_H    = OFF_XC + (size_t)RT * 2048 * 2;
constexpr size_t OFF_WT0  = OFF_H + (size_t)NB * NL * 2048 * 2;
constexpr size_t OFF_WT1  = OFF_WT0 + (size_t)4096 * 1024 * 2;
constexpr size_t OFF_WT2  = OFF_WT1 + (size_t)4096 * 1024 * 2;
constexpr size_t OFF_WT3  = OFF_WT2 + (size_t)1024 * 1024 * 2;
constexpr size_t OFF_G16  = OFF_WT3 + (size_t)1024 * 2048 * 2;
constexpr size_t OFF_SMAT = OFF_G16 + (size_t)RT * 16 * 4;
constexpr size_t OFF_GSC  = OFF_SMAT + (size_t)NB * 4 * NCH * 4096 * 2;
constexpr size_t OFF_CSC  = OFF_GSC + (size_t)16 * TB * 4 * 4;
constexpr size_t OFF_NBUF = OFF_CSC + (size_t)16 * NCH * 2 * 4;
constexpr size_t OFF_GTAB = 3407872;
constexpr size_t OFF_WFT  = OFF_GTAB + (size_t)4 * 128 * 16 * 4;
static_assert(OFF_WFT + (size_t)16 * 4096 * 2 <= OFF_BIG, "low-region tables overflow");
constexpr size_t OFF_G16P = OFF_NBUF + (size_t)16 * NCH * 512 * 4;
constexpr size_t OFF_H1B  = OFF_G16;
constexpr size_t WS_NEED  = (OFF_G16P + (size_t)4 * RT * 16 * 4 > OFF_H1B + (size_t)RT * 1024 * 2) ? OFF_G16P + (size_t)4 * RT * 16 * 4 : OFF_H1B + (size_t)RT * 1024 * 2;
static_assert(WS_NEED <= (size_t)256 * 1024 * 1024, "workspace exceeds the guaranteed 256 MiB");

static_assert(L0_END <= OFF_WT0, "layer-0 buffers overlap the weight copies");
constexpr int LDS_BYTES = 139264;

struct Params { const float* in[46]; float* out; char* ws; };
typedef unsigned short bf16_t;
typedef __attribute__((ext_vector_type(8))) short bf16x8;
typedef __attribute__((ext_vector_type(4))) short s16x4;
typedef __attribute__((ext_vector_type(2))) short s16x2;
typedef __attribute__((ext_vector_type(4))) float f32x4;
typedef __attribute__((ext_vector_type(2))) __bf16 bf2_t;
DEV unsigned pack2bf(float lo, float hi) { bf2_t v; v[0] = (__bf16)lo; v[1] = (__bf16)hi; return __builtin_bit_cast(unsigned, v); }
DEV float bflo(unsigned u) { return __uint_as_float(u << 16); }
DEV float bfhi(unsigned u) { return __uint_as_float(u & 0xffff0000u); }
DEV float bf2f(bf16_t v) { return __uint_as_float(((unsigned)v) << 16); }
DEV void unpack8(uint4 u, float* f) { f[0] = bflo(u.x); f[1] = bfhi(u.x); f[2] = bflo(u.y); f[3] = bfhi(u.y); f[4] = bflo(u.z); f[5] = bfhi(u.z); f[6] = bflo(u.w); f[7] = bfhi(u.w); }

DEV float wave_sum(float v) {
#pragma unroll
    for (int o = 32; o > 0; o >>= 1) v += __shfl_xor(v, o, 64);
    return v;
}
DEV float wave_max(float v) {
#pragma unroll
    for (int o = 32; o > 0; o >>= 1) v = fmaxf(v, __shfl_xor(v, o, 64));
    return v;
}
DEV float fexp(float x) { return __expf(x); }
DEV float frcp(float x) { return __builtin_amdgcn_rcpf(x); }
DEV float sigmoid_f(float x) { return frcp(1.f + fexp(-x)); }
DEV float silu_f(float x) { return x * frcp(1.f + fexp(-x)); }
DEV float logsig_f(float x) { return fminf(x, 0.f) - __logf(1.f + fexp(-fabsf(x))); }
DEV float tanh_f(float x) { const float e = fexp(2.f * x); return 1.f - 2.f * frcp(e + 1.f); }
DEV void lds_fence() { asm volatile("" ::: "memory"); }
DEV int opaque_tid() { int t = threadIdx.x; asm volatile("" : "+v"(t)); return t; }
DEV int scan_s(int dir, int u) { return dir == 0 ? u : (u < NCX ? (NCX - 1 - u) : (TB - 1 + NCX - u)); }
DEV int chunk_at(int dir, int step) { return dir == 0 ? step : (step < 4 ? 3 - step : (NCH + 3 - step)); }
DEV float4 ld4(const float* p) { return *(const float4*)p; }
DEV void st4(float* p, float4 v) { *(float4*)p = v; }


#define XB_TMO      128
#define XB_XCNT(j)  (256  + 64 * (j))
#define XB_XSUB(j)  (1280 + 64 * (j))
#define XB_XGEN(j)  (2304 + 64 * (j))
#define XB_TOP      3328
#define XB_TOPGEN   3392
#define XCD_BAR_WORDS 3456
#define XB_SPIN_CAP (1u << 22)
#define LAS __attribute__((address_space(3)))
DEV unsigned xb_ld(unsigned* p) { return __hip_atomic_load(p, __ATOMIC_RELAXED, __HIP_MEMORY_SCOPE_AGENT); }
DEV unsigned xb_add(unsigned* p, unsigned v) { return __hip_atomic_fetch_add(p, v, __ATOMIC_RELAXED, __HIP_MEMORY_SCOPE_AGENT); }
DEV unsigned xb_xcc_id() { return (unsigned)__builtin_amdgcn_s_getreg((3 << 11) | 20) & 0xFu; }
#define XB_SPIN(cond, bar) do { unsigned _sp = 0; while (cond) { __builtin_amdgcn_s_sleep(1); \
    if ((++_sp & 255u) == 0u) { if (xb_ld(&(bar)[XB_TMO])) break; if (_sp > XB_SPIN_CAP) { atomicAdd(&(bar)[XB_TMO], 1u); break; } } } } while (0)
struct XcdBarrier { unsigned* bar; unsigned x; volatile LAS unsigned* st; };
DEV XcdBarrier xcd_barrier_post(unsigned* bar, volatile LAS unsigned* st) {
    XcdBarrier b; b.bar = bar; b.x = xb_xcc_id(); b.st = st;
    if (threadIdx.x == 0) (void)xb_add(&bar[XB_XCNT(b.x)], 1u);
    return b;
}
DEV void xcd_barrier_complete(unsigned* bar, unsigned x, unsigned& nloc, unsigned& nx) {
    const unsigned G = gridDim.x * gridDim.y * gridDim.z;
    unsigned sum, cnt, mine, sp = 0u;
    for (;;) {
        sum = 0u; cnt = 0u; mine = 0u;
#pragma unroll
        for (unsigned j = 0; j < 16; ++j) { const unsigned c = xb_ld(&bar[XB_XCNT(j)]); sum += c; cnt += (c > 0u) ? 1u : 0u; mine = (j == x) ? c : mine; }
        if (sum == G) break;
        __builtin_amdgcn_s_sleep(1);
        if ((++sp & 255u) == 0u) { if (xb_ld(&bar[XB_TMO])) break; if (sp > XB_SPIN_CAP) { atomicAdd(&bar[XB_TMO], 1u); break; } }
    }
    nloc = mine > 0u ? mine : 1u; nx = cnt > 0u ? cnt : 1u;
}
DEV void xcd_barrier(const XcdBarrier& b) {
    asm volatile("s_waitcnt vmcnt(0)" ::: "memory");
    __syncthreads();
    if (threadIdx.x == 0) {
        unsigned* bar = b.bar;
        __builtin_amdgcn_s_waitcnt(0);
        unsigned nloc = b.st[0], nx = b.st[1];
        if (nloc == 0u) { xcd_barrier_complete(bar, b.x, nloc, nx); b.st[0] = nloc; b.st[1] = nx; }
        const unsigned old = xb_add(&bar[XB_XSUB(b.x)], 1u);
        const unsigned gen = old / nloc;
        if (old + 1u == (gen + 1u) * nloc) {
            __builtin_amdgcn_fence(__ATOMIC_RELEASE, "agent");
            asm volatile("s_waitcnt vmcnt(0)" ::: "memory");
            const unsigned og = xb_add(&bar[XB_TOP], 1u);
            const unsigned tg = og / nx;
            if (og + 1u == (tg + 1u) * nx) xb_add(&bar[XB_TOPGEN], 1u);
            else XB_SPIN(xb_ld(&bar[XB_TOPGEN]) == tg, bar);
            __builtin_amdgcn_fence(__ATOMIC_ACQUIRE, "agent");
            xb_add(&bar[XB_XGEN(b.x)], 1u);
            asm volatile("s_waitcnt vmcnt(0)" ::: "memory");
        } else {
            XB_SPIN(xb_ld(&bar[XB_XGEN(b.x)]) == gen, bar);
            __builtin_amdgcn_fence(__ATOMIC_ACQUIRE, "agent");
            asm volatile("s_waitcnt vmcnt(0)" ::: "memory");
        }
    }
    __syncthreads();
}

namespace pg8 {
#define PG8_LAS __attribute__((address_space(3)))
typedef unsigned short bf16_t;
typedef short bf16x8 __attribute__((ext_vector_type(8)));
typedef float f32x4 __attribute__((ext_vector_type(4)));
typedef unsigned u32x4 __attribute__((ext_vector_type(4)));
constexpr int BM = 256, BK = 64, HALF = 128, HTB = HALF * BK * 2  , STAGE_BYTES = 8 * HTB, NXCD = 8, WGM = 8;

__host__ __device__ __forceinline__ int lds_byte(int r, int c) { const int st = (r >> 4) * 2 + (c >> 5), rr = r & 15, cc = c & 31, ob = rr * 64 + cc * 2; return st * 1024 + (ob ^ (((ob >> 9) & 1) << 5)); }
__host__ __device__ __forceinline__ void stage_rc(int b, int& R, int& C) { const int st = b / 1024, sb = b % 1024, swz = sb ^ (((sb >> 9) & 1) << 5); R = (st >> 1) * 16 + swz / 64; C = (st & 1) * 32 + (swz % 64) / 2; }
__host__ __device__ __forceinline__ int perm32(int rho) { const int n = rho >> 4, i = rho & 15; return 8 * (i >> 2) + 4 * n + (i & 3); }

struct Unit { int pm, pn; };
struct Gemm { const bf16_t* A; const bf16_t* Bt; int M, N, K; };

struct StaticOrder {
    int nM, nN, nwg, G, c;
    __host__ __device__ void init(int M, int N, int G_, int c_) { nM = M / BM; nN = N / BM; nwg = nM * nN; G = G_; c = c_; }
    __host__ __device__ bool next(int i, Unit& u) const {
        const long L = (long)i * G + c; if (L >= nwg) return false;
        int wgid = (int)L; { const int q = nwg / NXCD, r = nwg % NXCD, xcd = wgid % NXCD, off = wgid / NXCD; wgid = (xcd < r ? xcd * (q + 1) : r * (q + 1) + (xcd - r) * q) + off; }
        const int nig = WGM * nN, gid = wgid / nig, fm = gid * WGM, gsz = (nM - fm) < WGM ? (nM - fm) : WGM;
        u.pm = fm + ((wgid % nig) % gsz); u.pn = (wgid % nig) / gsz; return true;
    }
    __device__ __forceinline__ void a_ready(const Unit&) const {}
    __device__ __forceinline__ void done(const Unit&) const {}
};

template <class Epi, class Sched, bool STAMP = false>
__device__ __forceinline__ void gemm_phase(PG8_LAS unsigned char* lds, const Gemm g, const Sched& S, const Epi& E, unsigned long long* stamps) {
    int tid = threadIdx.x; asm volatile("" : "+v"(tid));
    const int wid = __builtin_amdgcn_readfirstlane(tid >> 6), lane = tid & 63, wr = wid >> 2, wc = wid & 3, fr = lane & 15, fq = lane >> 4;
    const int K = g.K, nt = K / BK;
#define PG8_STAMP() do { } while (0)
    PG8_STAMP();
    unsigned voffA[2], voffB[2];
#pragma unroll
    for (int i = 0; i < 2; ++i) { int R, C; stage_rc(tid * 16 + i * 8192, R, C); const int Rb = Epi::PERM ? ((R & ~31) + perm32(R & 31)) : R;
        voffA[i] = (unsigned)(R * K + C) * 2u; voffB[i] = (unsigned)(Rb * K + C) * 2u; }
    const size_t kstep = (size_t)(BK * 2);
    const size_t hstep = (size_t)HALF * K * 2;
    const size_t tstep = 2 * hstep;
    const unsigned ldsw = (unsigned)wid * 1024u;
    const int aoff = lds_byte(wr * 64 + fr, fq * 8), boff = lds_byte(wc * 32 + fr, fq * 8);
#define PG8_SA(b, h) (((b) * 2 + (h)) * HTB)
#define PG8_SB(b, h) ((4 + (b) * 2 + (h)) * HTB)
#define PG8_STAGE(bufoff, gbase, voff) do { _Pragma("unroll") for (int _i = 0; _i < 2; ++_i) \
        __builtin_amdgcn_global_load_lds((const unsigned*)((const char*)(gbase) + (voff)[_i]), (PG8_LAS unsigned*)(lds + (bufoff) + ldsw + _i * 8192), 16, 0, 0); } while (0)
#define PG8_LDA(dst, b, h) do { _Pragma("unroll") for (int m = 0; m < 4; ++m) _Pragma("unroll") for (int k = 0; k < 2; ++k) dst[m][k] = *(const PG8_LAS bf16x8*)(lds + PG8_SA(b, h) + aoff + m * 2048 + k * 1024); } while (0)
#define PG8_LDB(dst, b, h) do { _Pragma("unroll") for (int n = 0; n < 2; ++n) _Pragma("unroll") for (int k = 0; k < 2; ++k) dst[n][k] = *(const PG8_LAS bf16x8*)(lds + PG8_SB(b, h) + boff + n * 2048 + k * 1024); } while (0)
#define PG8_MMA(ai, bj, At, Bt) do { __builtin_amdgcn_s_setprio(1); _Pragma("unroll") for (int m = 0; m < 4; ++m) _Pragma("unroll") for (int n = 0; n < 2; ++n) _Pragma("unroll") for (int k = 0; k < 2; ++k) \
        acc[ai][bj][m][n] = __builtin_amdgcn_mfma_f32_16x16x32_bf16(Bt[n][k], At[m][k], acc[ai][bj][m][n], 0, 0, 0); __builtin_amdgcn_s_setprio(0); } while (0)
#define PG8_WAIT_V(n) asm volatile("s_waitcnt vmcnt(" #n ")" ::: "memory")
#define PG8_WAIT_L(n) asm volatile("s_waitcnt lgkmcnt(" #n ")" ::: "memory")
#define PG8_BAR __builtin_amdgcn_s_barrier()
#define PG8_SCHED __builtin_amdgcn_sched_barrier(0)
    Unit cur, nxt; int ui = 0;
    if (!S.next(0, cur)) return;
    f32x4 acc[2][2][4][2];
#pragma unroll
    for (int a = 0; a < 2; ++a)
#pragma unroll
        for (int b = 0; b < 2; ++b)
#pragma unroll
            for (int m = 0; m < 4; ++m)
#pragma unroll
                for (int n = 0; n < 2; ++n) acc[a][b][m][n] = (f32x4){0.f, 0.f, 0.f, 0.f};
    bf16x8 At[4][2], B0[2][2], B1[2][2];
    const char* cA = (const char*)g.A + (size_t)cur.pm * tstep; const char* cB = (const char*)g.Bt + (size_t)cur.pn * tstep;
    S.a_ready(cur);
    PG8_STAGE(PG8_SB(0, 0), cB, voffB); PG8_STAGE(PG8_SA(0, 0), cA, voffA); PG8_STAGE(PG8_SB(0, 1), cB + hstep, voffB); PG8_STAGE(PG8_SA(0, 1), cA + hstep, voffA);
    if (wr == 1) PG8_BAR;
    PG8_WAIT_V(4); PG8_BAR;
    PG8_STAGE(PG8_SB(1, 0), cB + kstep, voffB); PG8_STAGE(PG8_SA(1, 0), cA + kstep, voffA); PG8_STAGE(PG8_SB(1, 1), cB + hstep + kstep, voffB);
    PG8_WAIT_V(6); PG8_BAR;
    PG8_STAMP();
    for (;;) {
        const bool has_next = S.next(ui + 1, nxt);
        const char* nA = has_next ? (const char*)g.A + (size_t)nxt.pm * tstep : cA; const char* nB = has_next ? (const char*)g.Bt + (size_t)nxt.pn * tstep : cB;
        for (int t = 0; t < nt; t += 2) {
            const bool last = (t == nt - 2);
            const char* a1 = cA + (size_t)(t + 1) * kstep;
            const char* a2 = last ? nA : cA + (size_t)(t + 2) * kstep; const char* b2 = last ? nB : cB + (size_t)(t + 2) * kstep;
            const char* a3 = a2 + kstep; const char* b3 = b2 + kstep;
            if (last && has_next) S.a_ready(nxt);
            PG8_LDB(B0, 0, 0); PG8_SCHED; PG8_LDA(At, 0, 0); PG8_STAGE(PG8_SA(1, 1), a1 + hstep, voffA);
            PG8_WAIT_L(8); PG8_BAR; PG8_WAIT_L(0); PG8_MMA(0, 0, At, B0); PG8_BAR; PG8_SCHED;
            PG8_LDB(B1, 0, 1); PG8_STAGE(PG8_SB(0, 0), b2, voffB);
            PG8_BAR; PG8_WAIT_L(0); PG8_MMA(0, 1, At, B1); PG8_BAR;
            PG8_LDA(At, 0, 1); PG8_STAGE(PG8_SA(0, 0), a2, voffA);
            PG8_BAR; PG8_WAIT_L(0); PG8_MMA(1, 0, At, B0); PG8_BAR; PG8_SCHED;
            PG8_STAGE(PG8_SB(0, 1), b2 + hstep, voffB);
            PG8_WAIT_V(6); PG8_BAR; PG8_MMA(1, 1, At, B1); PG8_BAR;
            PG8_LDB(B0, 1, 0); PG8_SCHED; PG8_LDA(At, 1, 0); PG8_STAGE(PG8_SA(0, 1), a2 + hstep, voffA);
            PG8_WAIT_L(8); PG8_BAR; PG8_WAIT_L(0); PG8_MMA(0, 0, At, B0); PG8_BAR; PG8_SCHED;
            PG8_LDB(B1, 1, 1); PG8_STAGE(PG8_SB(1, 0), b3, voffB);
            PG8_BAR; PG8_WAIT_L(0); PG8_MMA(0, 1, At, B1); PG8_BAR;
            PG8_LDA(At, 1, 1); PG8_STAGE(PG8_SA(1, 0), a3, voffA);
            PG8_BAR; PG8_WAIT_L(0); PG8_MMA(1, 0, At, B0); PG8_BAR; PG8_SCHED;
            PG8_STAGE(PG8_SB(1, 1), b3 + hstep, voffB);
            PG8_WAIT_V(6); PG8_BAR; PG8_MMA(1, 1, At, B1); PG8_BAR;
        }
        PG8_STAMP();
        if constexpr (!Epi::AFTER_DRAIN) { E(acc, cur, wr, wc, fr, fq); S.done(cur); }
        PG8_STAMP();
        if (!has_next) break;
#pragma unroll
        for (int a = 0; a < 2; ++a)
#pragma unroll
            for (int b = 0; b < 2; ++b)
#pragma unroll
                for (int m = 0; m < 4; ++m)
#pragma unroll
                    for (int n = 0; n < 2; ++n) acc[a][b][m][n] = (f32x4){0.f, 0.f, 0.f, 0.f};
        cur = nxt; cA = nA; cB = nB; ++ui;
    }
    PG8_WAIT_V(0);
    if (wr == 0) PG8_BAR;
    PG8_BAR;
    if constexpr (Epi::AFTER_DRAIN) { E.fused(acc, cur, wr, wc, fr, fq, lds, wid, lane); S.done(cur); }
    PG8_STAMP();
#undef PG8_STAMP
#undef PG8_SA
#undef PG8_SB
#undef PG8_STAGE
#undef PG8_LDA
#undef PG8_LDB
#undef PG8_MMA
#undef PG8_WAIT_V
#undef PG8_WAIT_L
#undef PG8_BAR
#undef PG8_SCHED
}
}

DEV void transpose_convert(const float* __restrict__ W, int K, int N, int Npad, bf16_t* Wt, float* sm) {
    float (*T)[65] = (float (*)[65])sm;
    const int tid = opaque_tid();
    const int kt = K / 64, ntl = Npad / 64;
    for (int tile = blockIdx.x; tile < kt * ntl; tile += gridDim.x) {
        const int k0 = (tile / ntl) * 64, n0 = (tile % ntl) * 64;
        __syncthreads();
#pragma unroll
        for (int i = 0; i < 2; ++i) {
            const int k = (tid >> 4) + 32 * i, n4 = (tid & 15) * 4;
            float4 v = make_float4(0.f, 0.f, 0.f, 0.f);
            if (n0 + n4 < N) v = ld4(W + (size_t)(k0 + k) * N + n0 + n4);
            T[k][n4] = v.x; T[k][n4 + 1] = v.y; T[k][n4 + 2] = v.z; T[k][n4 + 3] = v.w;
        }
        __syncthreads();
        const int n = tid >> 3, kq = (tid & 7) * 8;
        unsigned o[4];
#pragma unroll
        for (int j = 0; j < 4; ++j) o[j] = pack2bf(T[kq + 2 * j][n], T[kq + 2 * j + 1][n]);
        bf16_t* dst = Wt + (size_t)(n0 + n) * K + k0 + kq;
        *(uint4*)dst = make_uint4(o[0], o[1], o[2], o[3]);
    }
}

struct EpBf16 {
    static constexpr bool PERM = true, AFTER_DRAIN = false;
    bf16_t* O; int ldc; int ncols;
    DEV void operator()(const pg8::f32x4 (&acc)[2][2][4][2], const pg8::Unit& u, int wr, int wc, int fr, int fq) const {
        const int row0 = u.pm * 256 + wr * 64 + fr, col0 = u.pn * 256 + wc * 32 + 8 * fq;
#pragma unroll
        for (int ai = 0; ai < 2; ++ai)
#pragma unroll
            for (int m = 0; m < 4; ++m) {
                bf16_t* rowp = O + (size_t)(row0 + ai * 128 + m * 16) * ldc + col0;
#pragma unroll
                for (int bj = 0; bj < 2; ++bj) {
                    if (col0 + bj * 128 < ncols) {
                        const pg8::f32x4 v0 = acc[ai][bj][m][0], v1 = acc[ai][bj][m][1];
                        *(uint4*)(rowp + bj * 128) = make_uint4(pack2bf(v0[0], v0[1]), pack2bf(v0[2], v0[3]), pack2bf(v1[0], v1[1]), pack2bf(v1[2], v1[3]));
                    }
                }
            }
    }
};
struct EpRes0 {
    static constexpr bool PERM = false, AFTER_DRAIN = false;
    float* C; const float* mv; int b;
    DEV void operator()(const pg8::f32x4 (&acc)[2][2][4][2], const pg8::Unit& u, int wr, int wc, int fr, int fq) const {
        const bool isc = (u.pm * 256 < NCX);
        const float* gp = mv + (isc ? 2 : b) * 3072 + 2048;
        const int row0 = u.pm * 256 + wr * 64 + fr, col0 = u.pn * 256 + wc * 32 + 4 * fq;
#pragma unroll
        for (int ai = 0; ai < 2; ++ai)
#pragma unroll
            for (int m = 0; m < 4; ++m) {
                const size_t ro = (size_t)(row0 + ai * 128 + m * 16) * DM + col0;
#pragma unroll
                for (int bj = 0; bj < 2; ++bj)
#pragma unroll
                    for (int n = 0; n < 2; ++n) {
                        const int co = bj * 128 + n * 16;
                        const float4 g = ld4(gp + col0 + co); const pg8::f32x4 v = acc[ai][bj][m][n];
                        st4(C + ro + co, make_float4(g.x * v[0], g.y * v[1], g.z * v[2], g.w * v[3]));
                    }
            }
    }
};
struct EpRes1 {
    static constexpr bool PERM = false, AFTER_DRAIN = false;
    float* C; const float* mv;
    DEV void operator()(const pg8::f32x4 (&acc)[2][2][4][2], const pg8::Unit& u, int wr, int wc, int fr, int fq) const {
        const float* gp = mv + (u.pm * 256 >= NL ? 1 : 0) * 3072 + 2048;
        const int row0 = u.pm * 256 + wr * 64 + fr, col0 = u.pn * 256 + wc * 32 + 4 * fq;
#pragma unroll
        for (int ai = 0; ai < 2; ++ai)
#pragma unroll
            for (int m = 0; m < 4; ++m) {
                const size_t ro = (size_t)(row0 + ai * 128 + m * 16) * DM + col0;
#pragma unroll
                for (int bj = 0; bj < 2; ++bj)
#pragma unroll
                    for (int n = 0; n < 2; ++n) {
                        const int co = bj * 128 + n * 16;
                        const float4 g = ld4(gp + col0 + co); const pg8::f32x4 v = acc[ai][bj][m][n];
                        st4(C + ro + co, make_float4(g.x * v[0], g.y * v[1], g.z * v[2], g.w * v[3]));
                    }
            }
    }
};
template <class EP>
DEV void run_gemm(const bf16_t* A, const bf16_t* Bt, int M, int N, int K, const EP& ep, float* sm) {
    pg8::Gemm g{A, Bt, M, N, K}; pg8::StaticOrder S; S.init(M, N, (int)gridDim.x, (int)blockIdx.x);
    pg8::gemm_phase<EP, pg8::StaticOrder, false>((PG8_LAS unsigned char*)sm, g, S, ep, nullptr);
}

template <int MT, int NT>
DEV void mini_gemm(const bf16_t* A, int lda, int row0, int row_clamp, const bf16_t* Bt, int ldb, int brow0, bf16_t* C, int ldc, int ccol0, int nvalid, float* sm) {
    const int tid = opaque_tid(), lane = tid & 63, wave = tid >> 6, l15 = lane & 15, g = lane >> 4;
    f32x4 acc[MT][NT];
#pragma unroll
    for (int m = 0; m < MT; ++m)
#pragma unroll
        for (int n = 0; n < NT; ++n) acc[m][n] = (f32x4){0.f, 0.f, 0.f, 0.f};
    const bf16_t* ap[MT]; const bf16_t* bp[NT];
#pragma unroll
    for (int m = 0; m < MT; ++m) { const int r = row0 + m * 16 + l15; ap[m] = A + (size_t)(r < row_clamp ? r : row_clamp) * lda + wave * 128 + g * 8; }
#pragma unroll
    for (int n = 0; n < NT; ++n) bp[n] = Bt + (size_t)(brow0 + n * 16 + l15) * ldb + wave * 128 + g * 8;
#pragma unroll
    for (int kh = 0; kh < 2; ++kh) {
        bf16x8 af[2][MT], bq[2][NT];
#pragma unroll
        for (int ks = 0; ks < 2; ++ks) {
#pragma unroll
            for (int m = 0; m < MT; ++m) af[ks][m] = *(const bf16x8*)(ap[m] + (kh * 2 + ks) * 32);
#pragma unroll
            for (int n = 0; n < NT; ++n) bq[ks][n] = *(const bf16x8*)(bp[n] + (kh * 2 + ks) * 32);
        }
#pragma unroll
        for (int ks = 0; ks < 2; ++ks)
#pragma unroll
            for (int m = 0; m < MT; ++m)
#pragma unroll
                for (int n = 0; n < NT; ++n) acc[m][n] = __builtin_amdgcn_mfma_f32_16x16x32_bf16(af[ks][m], bq[ks][n], acc[m][n], 0, 0, 0);
    }
    __syncthreads();
#pragma unroll
    for (int m = 0; m < MT; ++m)
#pragma unroll
        for (int n = 0; n < NT; ++n) st4(sm + ((wave * MT + m) * NT + n) * 256 + lane * 4, make_float4(acc[m][n][0], acc[m][n][1], acc[m][n][2], acc[m][n][3]));
    __syncthreads();
    for (int e = tid; e < MT * NT * 256; e += NTHR) {
        const int tile = e >> 8, idx = e & 255, ln = idx >> 2, r = idx & 3;
        float s = 0.f;
#pragma unroll
        for (int w = 0; w < NWV; ++w) s += sm[(w * MT * NT + tile) * 256 + idx];
        const int i = (tile / NT) * 16 + (ln >> 4) * 4 + r, j = (tile % NT) * 16 + (ln & 15);
        if (i < nvalid) C[(size_t)(row0 + i) * ldc + ccol0 + j] = __builtin_bit_cast(unsigned short, (__bf16)s);
    }
}

struct Mod8 { float4 s0, s1, c0, c1; };
DEV Mod8 mod8_load(const float* m, int k) { Mod8 q; q.s0 = ld4(m + k); q.s1 = ld4(m + k + 4); q.c0 = ld4(m + 1024 + k); q.c1 = ld4(m + 1024 + k + 4); return q; }
DEV uint4 mod8_apply(const float4 x0, const float4 x1, const Mod8& q) {
    return make_uint4(pack2bf(x0.x * (1.f + q.c0.x) + q.s0.x, x0.y * (1.f + q.c0.y) + q.s0.y), pack2bf(x0.z * (1.f + q.c0.z) + q.s0.z, x0.w * (1.f + q.c0.w) + q.s0.w),
                      pack2bf(x1.x * (1.f + q.c1.x) + q.s1.x, x1.y * (1.f + q.c1.y) + q.s1.y), pack2bf(x1.z * (1.f + q.c1.z) + q.s1.z, x1.w * (1.f + q.c1.w) + q.s1.w));
}
DEV void phase_h0(const Params& p, int b) {
    const float* modv = (const float*)(p.ws + OFF_MODV);
    bf16_t* H0 = (bf16_t*)(p.ws + OFF_YC);
    const int gt = blockIdx.x * NTHR + opaque_tid(), gn = gridDim.x * NTHR;
    const int k = (gt & 127) * 8;
    const Mod8 mc = mod8_load(modv + 2 * 3072, k), ml = mod8_load(modv + b * 3072, k);
    for (int i0 = gt; i0 < TB * 128; i0 += 4 * gn) {
        float4 xa[4], xb[4];
#pragma unroll
        for (int u = 0; u < 4; ++u) {
            const int i = i0 + u * gn, s = (i < TB * 128 ? i : gt) >> 7;
            const float* src = (s < NCX) ? p.in[2] + ((size_t)(b * NCX + s)) * DM + k : p.in[0] + ((size_t)(b * NL + s - NCX)) * DM + k;
            xa[u] = ld4(src); xb[u] = ld4(src + 4);
        }
#pragma unroll
        for (int u = 0; u < 4; ++u) {
            const int i = i0 + u * gn, s = i >> 7;
            if (i < TB * 128) *(uint4*)(H0 + (size_t)s * DM + k) = mod8_apply(xa[u], xb[u], (s < NCX) ? mc : ml);
        }
    }
}

DEV void phase_mod(const Params& p, float* sm) {
    const float* c = p.in[1]; const float* cctx = p.in[3];
    const float* mod_w = p.in[4]; const float* mod_b = p.in[5];
    float* modv = (float*)(p.ws + OFF_MODV);
    float* sil = sm; float* red = sm + 3072;
    const int tid = opaque_tid();
    for (int i = tid; i < 3072; i += NTHR) {
        const int j = i >> 10, k = i & 1023;
        const float v = (j < 2) ? c[j * 1024 + k] : cctx[k];
        sil[i] = silu_f(v);
    }
    __syncthreads();
    for (int unit = blockIdx.x; unit < 192; unit += gridDim.x) {
        const int l = unit / 96, cb = unit % 96;
        const int kg = tid >> 5, col = tid & 31, n = cb * 32 + col;
        const float* w = mod_w + (size_t)l * 1024 * 3072 + n;
        float a0 = 0.f, a1 = 0.f, a2 = 0.f;
        for (int k = kg * 64; k < kg * 64 + 64; ++k) {
            const float wv = w[(size_t)k * 3072];
            a0 += sil[k] * wv; a1 += sil[1024 + k] * wv; a2 += sil[2048 + k] * wv;
        }
        red[(kg * 3 + 0) * 32 + col] = a0; red[(kg * 3 + 1) * 32 + col] = a1; red[(kg * 3 + 2) * 32 + col] = a2;
        __syncthreads();
        if (tid < 96) {
            const int j = tid >> 5, cc = tid & 31, nn = cb * 32 + cc;
            float s = mod_b[l * 3072 + nn];
            for (int g = 0; g < 16; ++g) s += red[(g * 3 + j) * 32 + cc];
            modv[(l * 3 + j) * 3072 + nn] = s;
        }
        __syncthreads();
    }
}

DEV void phase_tables(const Params& p) {
    const float* wq = p.in[33]; const float* wk = p.in[34]; const float* wv = p.in[35];
    const float* gw0 = p.in[36]; const float* gw1 = p.in[38]; const float* gw2 = p.in[40]; const float* gw3 = p.in[42];
    float* gtab = (float*)(p.ws + OFF_GTAB); bf16_t* wft = (bf16_t*)(p.ws + OFF_WFT);
    const int gt = blockIdx.x * NTHR + opaque_tid(), gn = gridDim.x * NTHR;
    for (int i = gt; i < 512 * 16; i += gn) {
        const int gb = i >> 4, cp = (i >> 2) & 3, c = i & 3;
        float s = 0.f;
#pragma unroll
        for (int d = 0; d < 4; ++d) s += wq[gb * 16 + cp * 4 + d] * wk[gb * 16 + c * 4 + d];
        gtab[i] = s * KSCALE;
    }
    for (int i = gt; i < 4096 * 16; i += gn) {
        const int g = i >> 12, k = i & 4095, gm = g >> 2, hd = g & 3;
        const float* wg = gm == 0 ? gw0 : (gm == 1 ? gw1 : (gm == 2 ? gw2 : gw3));
        float s = 0.f;
        if (k < 2048) {
            const int blk = k >> 2, cc = k & 3;
#pragma unroll
            for (int d = 0; d < 4; ++d) s += wq[blk * 16 + cc * 4 + d] * wg[(size_t)(4 * blk + d) * 4 + hd] + wk[blk * 16 + cc * 4 + d] * wg[(size_t)(2048 + 4 * blk + d) * 4 + hd];
        } else {
            const int kk = k - 2048, blk = kk >> 2, cc = kk & 3;
#pragma unroll
            for (int d = 0; d < 4; ++d) s += wv[blk * 16 + cc * 4 + d] * wg[(size_t)(4096 + 4 * blk + d) * 4 + hd];
        }
        wft[i] = __builtin_bit_cast(unsigned short, (__bf16)s);
    }
}

DEV float dpp_add(float v, float acc_src, int) { return v + acc_src; }
#define DPP_F(src_, ctrl_, rmask_) __int_as_float(__builtin_amdgcn_update_dpp(0, __float_as_int(src_), (ctrl_), (rmask_), 0xf, false))
DEV float wave_scan_add(float v, int lane, int dir) {
    float p = v;
    p += DPP_F(p, 0x111, 0xf);
    p += DPP_F(p, 0x112, 0xf);
    p += DPP_F(p, 0x114, 0xf);
    p += DPP_F(p, 0x118, 0xf);
    p += DPP_F(p, 0x142, 0xa);
    p += DPP_F(p, 0x143, 0xc);
    if (dir) { const float tot = __int_as_float(__builtin_amdgcn_readlane(__float_as_int(p), 63)); p = tot - p + v; }
    return p;
}
DEV float wave_scan_max(float v, int lane, int dir) {
#pragma unroll
    for (int o = 1; o < 64; o <<= 1) {
        const float n = dir ? __shfl_down(v, o, 64) : __shfl_up(v, o, 64);
        const bool ok = dir ? (lane + o < 64) : (lane >= o);
        if (ok) v = fmaxf(v, n);
    }
    return v;
}

constexpr int GLC_OFF = 30336;
static_assert((GLC_OFF + 2176) * 4 <= LDS_BYTES - 16, "GLA constants must fit below the barrier words");
DEV void gla_consts(const Params& p, int h, float* sm) {
    const int tid = opaque_tid();
    float* sWA2 = sm + GLC_OFF; float* sBA2 = sWA2 + 2048;
    __syncthreads();
    for (int i = tid; i < 2048; i += NTHR) { const int d = i >> 10, ii = (i >> 6) & 15, k = i & 63; sWA2[i] = p.in[d ? 12 : 10][ii * 256 + h * 64 + k]; }
    if (tid < 128) sBA2[tid] = p.in[(tid >> 6) ? 13 : 11][h * 64 + (tid & 63)];
}
DEV void gla_decay_core(const float* sLRd, const float* sWAd, const float* sBAd, float* sBC, float* sTot, int dir, int tid) {
    {
        const int t = tid >> 3, k0 = (tid & 7) * 8;
        float acc[8];
#pragma unroll
        for (int j = 0; j < 8; ++j) acc[j] = sBAd[k0 + j];
#pragma unroll
        for (int ii = 0; ii < 16; ++ii) {
            const float l = sLRd[t * 16 + ii];
#pragma unroll
            for (int j = 0; j < 8; ++j) acc[j] += l * sWAd[ii * 64 + k0 + j];
        }
#pragma unroll
        for (int j = 0; j < 8; ++j) sBC[t * 65 + k0 + j] = logsig_f(acc[j]) * 0.0625f;
    }
    __syncthreads();
    {
        const int lane = tid & 63, wv = tid >> 6;
#pragma unroll
        for (int j = 0; j < 8; ++j) {
            const int k = wv * 8 + j;
            const float v = wave_scan_add(sBC[lane * 65 + k], lane, dir);
            sBC[lane * 65 + k] = v;
            if (lane == (dir ? 0 : 63)) sTot[k] = v;
        }
    }
    __syncthreads();
}

DEV bf16x8 tr_frag(const bf16_t* base, int ld, int row0, int col0, int lane) {
    const bf16_t* ptr = base + (row0 + (lane >> 4) * 8 + ((lane & 15) >> 2)) * ld + col0 + (lane & 3) * 4;
    const s16x4 lo = __builtin_amdgcn_ds_read_tr16_b64_v4i16((__attribute__((address_space(3))) s16x4*)ptr);
    const s16x4 hi = __builtin_amdgcn_ds_read_tr16_b64_v4i16((__attribute__((address_space(3))) s16x4*)(ptr + 4 * ld));
    return (bf16x8){lo[0], lo[1], lo[2], lo[3], hi[0], hi[1], hi[2], hi[3]};
}
DEV bf16x8 row_frag(const bf16_t* base, int ld, int idx0, int k0, int lane) {
    return *(const bf16x8*)(base + (idx0 + (lane & 15)) * ld + k0 + (lane >> 4) * 8);
}

DEV void gla1_unit(const Params& p, int h, int dir, int c, float* sm) {
    const int tid = opaque_tid(), lane = tid & 63, wave = tid >> 6;
    const bf16_t* P0 = (const bf16_t*)(p.ws + OFF_P0);
    float* GDS = (float*)(p.ws + OFF_GDS); float* GDEC = (float*)(p.ws + OFF_GDEC);
    float* sLR = sm; float* sBC = sm + 2048; float* sTot = sm + 6208;
    bf16_t* kT = (bf16_t*)(sm + 6272);
    bf16_t* Vs = (bf16_t*)(sm + 8576);
    const int ch = h * 2 + dir;
    const int t = tid >> 3, k0 = (tid & 7) * 8;
    const uint4 lrq = *(const uint4*)(P0 + (size_t)(c * 64 + ((tid & 127) >> 1)) * EIN + 1536 + dir * 16 + (tid & 1) * 8);
    const uint4 kq = *(const uint4*)(P0 + (size_t)(c * 64 + t) * EIN + 256 + h * 64 + k0);
    const uint4 vq0 = *(const uint4*)(P0 + (size_t)(c * 64 + (tid >> 4)) * EIN + 512 + h * 128 + (tid & 15) * 8);
    const uint4 vq1 = *(const uint4*)(P0 + (size_t)(c * 64 + 32 + (tid >> 4)) * EIN + 512 + h * 128 + (tid & 15) * 8);
    __syncthreads();
    if (tid < 128) { float* d = sLR + (tid >> 1) * 16 + (tid & 1) * 8; st4(d, make_float4(bflo(lrq.x), bfhi(lrq.x), bflo(lrq.y), bfhi(lrq.y))); st4(d + 4, make_float4(bflo(lrq.z), bfhi(lrq.z), bflo(lrq.w), bfhi(lrq.w))); }
    *(uint4*)(Vs + (tid >> 4) * 136 + (tid & 15) * 8) = vq0; *(uint4*)(Vs + (32 + (tid >> 4)) * 136 + (tid & 15) * 8) = vq1;
    __syncthreads();
    gla_decay_core(sLR, sm + GLC_OFF + dir * 1024, sm + GLC_OFF + 2048 + dir * 64, sBC, sTot, dir, tid);
    {
        float kv[8]; unpack8(kq, kv);
#pragma unroll
        for (int j = 0; j < 8; ++j) kT[(k0 + j) * 72 + t] = __builtin_bit_cast(unsigned short, (__bf16)(kv[j] * fexp(sTot[k0 + j] - sBC[t * 65 + k0 + j])));
    }
    __syncthreads();
    {
        f32x4 acc[4];
#pragma unroll
        for (int kt = 0; kt < 4; ++kt) acc[kt] = (f32x4){0.f, 0.f, 0.f, 0.f};
#pragma unroll
        for (int ks = 0; ks < 2; ++ks) {
            const bf16x8 af = tr_frag(Vs, 136, ks * 32, wave * 16, lane);
#pragma unroll
            for (int kt = 0; kt < 4; ++kt) acc[kt] = __builtin_amdgcn_mfma_f32_16x16x32_bf16(af, row_frag(kT, 72, kt * 16, ks * 32, lane), acc[kt], 0, 0, 0);
        }
#pragma unroll
        for (int kt = 0; kt < 4; ++kt) {
            const int k = kt * 16 + (lane & 15), v = wave * 16 + (lane >> 4) * 4;
            st4(GDS + ((size_t)(ch * NCH + c) * 64 + k) * 128 + v, make_float4(acc[kt][0], acc[kt][1], acc[kt][2], acc[kt][3]));
        }
    }
    if (tid < 64) GDEC[(size_t)(ch * NCH + c) * 64 + tid] = fexp(sTot[tid]);
}

DEV void gla2_unit(const Params& p, int unit) {
    const int tid = opaque_tid();
    float* GDS = (float*)(p.ws + OFF_GDS); const float* GDEC = (const float*)(p.ws + OFF_GDEC);
    const int ch = unit >> 4, e = (unit & 15) * 512 + tid, k = e >> 7, dir = ch & 1;
    constexpr int GB = 12;
    float S = 0.f, ninc[GB], nd[GB];
#pragma unroll
    for (int j = 0; j < GB; ++j) { const int c = chunk_at(dir, j); ninc[j] = GDS[(size_t)(ch * NCH + c) * 8192 + e]; nd[j] = GDEC[(size_t)(ch * NCH + c) * 64 + k]; }
#pragma unroll 1
    for (int step0 = 0; step0 < NCH; step0 += GB) {
        float inc[GB], d[GB];
#pragma unroll
        for (int j = 0; j < GB; ++j) { inc[j] = ninc[j]; d[j] = nd[j]; }
#pragma unroll
        for (int j = 0; j < GB; ++j) { const int sn = step0 + GB + j, c = chunk_at(dir, sn < NCH ? sn : NCH - 1); ninc[j] = GDS[(size_t)(ch * NCH + c) * 8192 + e]; nd[j] = GDEC[(size_t)(ch * NCH + c) * 64 + k]; }
        __builtin_amdgcn_sched_barrier(0);
#pragma unroll
        for (int j = 0; j < GB; ++j) { const int c = chunk_at(dir, step0 + j); GDS[(size_t)(ch * NCH + c) * 8192 + e] = S; S = d[j] * S + inc[j]; }
    }
}

DEV void gla3_unit(const Params& p, int h, int c, float* sm) {
    const int tid = opaque_tid(), lane = tid & 63, wave = tid >> 6;
    const bf16_t* P0 = (const bf16_t*)(p.ws + OFF_P0);
    const float* GDS = (const float*)(p.ws + OFF_GDS);
    bf16_t* YC = (bf16_t*)(p.ws + OFF_YC);
    const float* ng = p.in[14];
    float* sLR2 = sm;
    float* sBC = sm + 2048; float* sTot = sm + 6208;
    bf16_t* qt = (bf16_t*)(sm + 6272);
    bf16_t* kt = (bf16_t*)(sm + 8576);
    bf16_t* Sm = (bf16_t*)(sm + 10880);
    bf16_t* S0s = (bf16_t*)(sm + 13184);
    bf16_t* Vs = (bf16_t*)(sm + 17536);
    float* O = sm + 21888;
    const int ti = wave & 3, vt0 = (wave >> 2) * 4;
    const int t = tid >> 3, k0 = (tid & 7) * 8;
    f32x4 acc[4];
#pragma unroll
    for (int j = 0; j < 4; ++j) acc[j] = (f32x4){0.f, 0.f, 0.f, 0.f};
    const uint4 vq0 = *(const uint4*)(P0 + (size_t)(c * 64 + (tid >> 4)) * EIN + 512 + h * 128 + (tid & 15) * 8);
    const uint4 vq1 = *(const uint4*)(P0 + (size_t)(c * 64 + 32 + (tid >> 4)) * EIN + 512 + h * 128 + (tid & 15) * 8);
    const uint4 lrq = *(const uint4*)(P0 + (size_t)(c * 64 + ((tid & 255) >> 2)) * EIN + 1536 + (tid & 3) * 8);
    const uint4 qq = *(const uint4*)(P0 + (size_t)(c * 64 + t) * EIN + h * 64 + k0);
    const uint4 kq = *(const uint4*)(P0 + (size_t)(c * 64 + t) * EIN + 256 + h * 64 + k0);
    float4 s0a[4], s0b[4];
#pragma unroll
    for (int u = 0; u < 4; ++u) { const int i = tid + 512 * u, k = i >> 5, v4 = (i & 31) * 4;
        s0a[u] = ld4(GDS + (size_t)((h * 2 + 0) * NCH + c) * 8192 + k * 128 + v4); s0b[u] = ld4(GDS + (size_t)((h * 2 + 1) * NCH + c) * 8192 + k * 128 + v4); }
    const bf16_t* gp = P0 + (size_t)(c * 64 + t) * EIN + 1024 + h * 128 + (tid & 7) * 16;
    const uint4 gq0 = *(const uint4*)gp, gq1 = *(const uint4*)(gp + 8);
    __syncthreads();
    *(uint4*)(Vs + (tid >> 4) * 136 + (tid & 15) * 8) = vq0; *(uint4*)(Vs + (32 + (tid >> 4)) * 136 + (tid & 15) * 8) = vq1;
    if (tid < 256) { float* d = sLR2 + ((tid & 3) >> 1) * 1024 + (tid >> 2) * 16 + (tid & 1) * 8; st4(d, make_float4(bflo(lrq.x), bfhi(lrq.x), bflo(lrq.y), bfhi(lrq.y))); st4(d + 4, make_float4(bflo(lrq.z), bfhi(lrq.z), bflo(lrq.w), bfhi(lrq.w))); }
    __syncthreads();
#pragma unroll
    for (int dir = 0; dir < 2; ++dir) {
        gla_decay_core(sLR2 + dir * 1024, sm + GLC_OFF + dir * 1024, sm + GLC_OFF + 2048 + dir * 64, sBC, sTot, dir, tid);
        {
            float qv[8], kv[8];
            unpack8(qq, qv); unpack8(kq, kv);
#pragma unroll
            for (int j = 0; j < 8; ++j) { const float bc = sBC[t * 65 + k0 + j]; qv[j] *= 0.125f * fexp(bc); kv[j] *= fexp(-bc); }
            *(uint4*)(qt + t * 72 + k0) = make_uint4(pack2bf(qv[0], qv[1]), pack2bf(qv[2], qv[3]), pack2bf(qv[4], qv[5]), pack2bf(qv[6], qv[7]));
            *(uint4*)(kt + t * 72 + k0) = make_uint4(pack2bf(kv[0], kv[1]), pack2bf(kv[2], kv[3]), pack2bf(kv[4], kv[5]), pack2bf(kv[6], kv[7]));
#pragma unroll
            for (int u = 0; u < 4; ++u) {
                const int i = tid + 512 * u, k = i >> 5, v4 = (i & 31) * 4;
                const float4 s4 = dir ? s0b[u] : s0a[u];
                *(uint2*)(S0s + k * 136 + v4) = make_uint2(pack2bf(s4.x, s4.y), pack2bf(s4.z, s4.w));
            }
        }
        __syncthreads();
        {
            const int si = wave & 3;
#pragma unroll
            for (int jj = 0; jj < 2; ++jj) {
                const int t2 = (wave >> 2) * 2 + jj;
                f32x4 a = (f32x4){0.f, 0.f, 0.f, 0.f};
#pragma unroll
                for (int ks = 0; ks < 2; ++ks) a = __builtin_amdgcn_mfma_f32_16x16x32_bf16(row_frag(kt, 72, si * 16, ks * 32, lane), row_frag(qt, 72, t2 * 16, ks * 32, lane), a, 0, 0, 0);
                const int tq = t2 * 16 + (lane & 15), s0 = si * 16 + (lane >> 4) * 4;
                float m[4];
#pragma unroll
                for (int r = 0; r < 4; ++r) { const bool keep = dir ? (s0 + r >= tq) : (s0 + r <= tq); m[r] = keep ? a[r] : 0.f; }
                *(uint2*)(Sm + tq * 72 + s0) = make_uint2(pack2bf(m[0], m[1]), pack2bf(m[2], m[3]));
            }
        }
        __syncthreads();
#pragma unroll
        for (int ks = 0; ks < 2; ++ks) {
            const bf16x8 a1 = row_frag(qt, 72, ti * 16, ks * 32, lane), a2 = row_frag(Sm, 72, ti * 16, ks * 32, lane);
#pragma unroll
            for (int j = 0; j < 4; ++j) {
                acc[j] = __builtin_amdgcn_mfma_f32_16x16x32_bf16(a1, tr_frag(S0s, 136, ks * 32, (vt0 + j) * 16, lane), acc[j], 0, 0, 0);
                acc[j] = __builtin_amdgcn_mfma_f32_16x16x32_bf16(a2, tr_frag(Vs, 136, ks * 32, (vt0 + j) * 16, lane), acc[j], 0, 0, 0);
            }
        }
        if (dir == 0) __syncthreads();
    }
#pragma unroll
    for (int j = 0; j < 4; ++j)
#pragma unroll
        for (int r = 0; r < 4; ++r) O[(ti * 16 + (lane >> 4) * 4 + r) * 132 + (vt0 + j) * 16 + (lane & 15)] = acc[j][r];
    __syncthreads();
    {
        const int v0 = (tid & 7) * 16;
        float o[16];
        float ss = 0.f;
#pragma unroll
        for (int i = 0; i < 16; ++i) { o[i] = O[t * 132 + v0 + i]; ss += o[i] * o[i]; }
        ss += __shfl_xor(ss, 1, 64); ss += __shfl_xor(ss, 2, 64); ss += __shfl_xor(ss, 4, 64);
        const float rms = rsqrtf(ss * (1.f / 128.f) + 1e-5f);
        float g[16];
        unpack8(gq0, g); unpack8(gq1, g + 8);
        float y[16];
#pragma unroll
        for (int i = 0; i < 16; ++i) y[i] = o[i] * rms * ng[v0 + i] * silu_f(g[i]);
        bf16_t* yp = YC + (size_t)(c * 64 + t) * 1024 + h * 128 + v0;
        *(uint4*)yp = make_uint4(pack2bf(y[0], y[1]), pack2bf(y[2], y[3]), pack2bf(y[4], y[5]), pack2bf(y[6], y[7]));
        *(uint4*)(yp + 8) = make_uint4(pack2bf(y[8], y[9]), pack2bf(y[10], y[11]), pack2bf(y[12], y[13]), pack2bf(y[14], y[15]));
    }
}

DEV void load8bf(const bf16_t* ptr, float* f) { unpack8(*(const uint4*)ptr, f); }
struct RwNb { int sL, sR, sU, sD; bool vL, vR, vU, vD; };
DEV RwNb rw_nb(int s) {
    RwNb q; q.vU = false; q.vD = false;
    if (s < NCX) { q.vL = s > 0; q.vR = s < NCX - 1; }
    else { const int n = s - NCX, rr = n >> 6, cc = n & 63; q.vL = cc > 0; q.vR = cc < 63; q.vU = rr > 0; q.vD = rr < 127; }
    q.sL = q.vL ? s - 1 : s; q.sR = q.vR ? s + 1 : s; q.sU = q.vU ? s - 64 : s; q.sD = q.vD ? s + 64 : s;
    return q;
}
struct RwRaw { uint4 o, l, r, u, d; };
DEV RwRaw rw_load(const bf16_t* P0, int s, const RwNb& q, int cb) {
    RwRaw w;
    w.o = *(const uint4*)(P0 + (size_t)s * EIN + RW0 + cb); w.l = *(const uint4*)(P0 + (size_t)q.sL * EIN + RW0 + cb); w.r = *(const uint4*)(P0 + (size_t)q.sR * EIN + RW0 + cb);
    w.u = *(const uint4*)(P0 + (size_t)q.sU * EIN + RW0 + cb); w.d = *(const uint4*)(P0 + (size_t)q.sD * EIN + RW0 + cb);
    return w;
}
DEV void rw_comb_l(const RwRaw& w, const RwNb& q, const float* ml, float* out) {
    float own[8]; unpack8(w.o, own);
    const float nb[8] = {q.vL ? bflo(w.l.x) : 0.f, q.vR ? bfhi(w.r.x) : 0.f, q.vU ? bflo(w.u.y) : 0.f, q.vD ? bfhi(w.d.y) : 0.f,
                         q.vL ? bflo(w.l.z) : 0.f, q.vR ? bfhi(w.r.z) : 0.f, q.vU ? bflo(w.u.w) : 0.f, q.vD ? bfhi(w.d.w) : 0.f};
    const float4 m0 = *(const float4*)ml, m1 = *(const float4*)(ml + 4);
    const float m[8] = {m0.x, m0.y, m0.z, m0.w, m1.x, m1.y, m1.z, m1.w};
#pragma unroll
    for (int i = 0; i < 8; ++i) out[i] = own[i] + (nb[i] - own[i]) * m[i];
}
DEV void rw_comb(const RwRaw& w, const RwNb& q, const float* __restrict__ mu, int cb, float* out) {
    float own[8]; unpack8(w.o, own);
    const float nb[8] = {q.vL ? bflo(w.l.x) : 0.f, q.vR ? bfhi(w.r.x) : 0.f, q.vU ? bflo(w.u.y) : 0.f, q.vD ? bfhi(w.d.y) : 0.f,
                         q.vL ? bflo(w.l.z) : 0.f, q.vR ? bfhi(w.r.z) : 0.f, q.vU ? bflo(w.u.w) : 0.f, q.vD ? bfhi(w.d.w) : 0.f};
    const float4 m0 = ld4(mu + cb), m1 = ld4(mu + cb + 4);
    const float m[8] = {m0.x, m0.y, m0.z, m0.w, m1.x, m1.y, m1.z, m1.w};
#pragma unroll
    for (int i = 0; i < 8; ++i) out[i] = own[i] + (nb[i] - own[i]) * m[i];
}
DEV uint4 pack8(const float* f) { return make_uint4(pack2bf(f[0], f[1]), pack2bf(f[2], f[3]), pack2bf(f[4], f[5]), pack2bf(f[6], f[7])); }

template <int XM, int YM, class F>
DEV void mm64(const bf16_t* X, const bf16_t* Y, F f, int lane, int wave) {
#pragma unroll
    for (int q = 0; q < 2; ++q) {
        const int idx = wave * 2 + q, ti = idx >> 2, tj = idx & 3;
        f32x4 acc = (f32x4){0.f, 0.f, 0.f, 0.f};
#pragma unroll
        for (int ks = 0; ks < 2; ++ks) {
            const bf16x8 a = XM == 0 ? row_frag(X, 72, ti * 16, ks * 32, lane) : tr_frag(X, 72, ks * 32, ti * 16, lane);
            const bf16x8 bq = YM == 0 ? row_frag(Y, 72, tj * 16, ks * 32, lane) : tr_frag(Y, 72, ks * 32, tj * 16, lane);
            acc = __builtin_amdgcn_mfma_f32_16x16x32_bf16(a, bq, acc, 0, 0, 0);
        }
        f(ti * 16 + (lane >> 4) * 4, tj * 16 + (lane & 15), acc);
    }
}
template <int XM, int YM, class F>
DEV void mm64x2(const bf16_t* X1, const bf16_t* Y1, const bf16_t* X2, const bf16_t* Y2, F f, int lane, int wave) {
#pragma unroll
    for (int q = 0; q < 2; ++q) {
        const int idx = wave * 2 + q, ti = idx >> 2, tj = idx & 3;
        f32x4 acc = (f32x4){0.f, 0.f, 0.f, 0.f};
#pragma unroll
        for (int ks = 0; ks < 2; ++ks) {
            const bf16x8 a = XM == 0 ? row_frag(X1, 72, ti * 16, ks * 32, lane) : tr_frag(X1, 72, ks * 32, ti * 16, lane);
            const bf16x8 bq = YM == 0 ? row_frag(Y1, 72, tj * 16, ks * 32, lane) : tr_frag(Y1, 72, ks * 32, tj * 16, lane);
            acc = __builtin_amdgcn_mfma_f32_16x16x32_bf16(a, bq, acc, 0, 0, 0);
            const bf16x8 a2 = XM == 0 ? row_frag(X2, 72, ti * 16, ks * 32, lane) : tr_frag(X2, 72, ks * 32, ti * 16, lane);
            const bf16x8 b2 = YM == 0 ? row_frag(Y2, 72, tj * 16, ks * 32, lane) : tr_frag(Y2, 72, ks * 32, tj * 16, lane);
            acc = __builtin_amdgcn_mfma_f32_16x16x32_bf16(a2, b2, acc, 0, 0, 0);
        }
        f(ti * 16 + (lane >> 4) * 4, tj * 16 + (lane & 15), acc);
    }
}
DEV void st_img(bf16_t* P, int i0, int j, float a0, float a1, float a2, float a3) {
    P[(i0 + 0) * 72 + j] = __builtin_bit_cast(unsigned short, (__bf16)a0); P[(i0 + 1) * 72 + j] = __builtin_bit_cast(unsigned short, (__bf16)a1);
    P[(i0 + 2) * 72 + j] = __builtin_bit_cast(unsigned short, (__bf16)a2); P[(i0 + 3) * 72 + j] = __builtin_bit_cast(unsigned short, (__bf16)a3);
}

struct RwRaw3 { uint4 o, u, d; };
DEV RwRaw3 rw_load3(const bf16_t* P0, int s, const RwNb& q, int cb) {
    RwRaw3 w;
    w.o = *(const uint4*)(P0 + (size_t)s * EIN + RW0 + cb); w.u = *(const uint4*)(P0 + (size_t)q.sU * EIN + RW0 + cb); w.d = *(const uint4*)(P0 + (size_t)q.sD * EIN + RW0 + cb);
    return w;
}
DEV void rw_comb3(const RwRaw3& w, const RwNb& q, const bf16_t* tile, const bf16_t* P0, int s, int t, int cb, int j0, const float* ml, float* out) {
    asm volatile("" :: "v"(w.u.x), "v"(w.u.z), "v"(w.d.x), "v"(w.d.z));
    float own[8]; unpack8(w.o, own);
    float l0 = 0.f, l4 = 0.f, r1 = 0.f, r5 = 0.f;
    if (q.vL) { if (t > 0) { l0 = bf2f(tile[(t - 1) * 72 + j0]); l4 = bf2f(tile[(t - 1) * 72 + j0 + 4]); }
                else { const bf16_t* g = P0 + (size_t)(s - 1) * EIN + RW0 + cb; l0 = bf2f(g[0]); l4 = bf2f(g[4]); } }
    if (q.vR) { if (t < 63) { r1 = bf2f(tile[(t + 1) * 72 + j0 + 1]); r5 = bf2f(tile[(t + 1) * 72 + j0 + 5]); }
                else { const bf16_t* g = P0 + (size_t)(s + 1) * EIN + RW0 + cb; r1 = bf2f(g[1]); r5 = bf2f(g[5]); } }
    const float nb[8] = {l0, r1, q.vU ? bflo(w.u.y) : 0.f, q.vD ? bfhi(w.d.y) : 0.f, l4, r5, q.vU ? bflo(w.u.w) : 0.f, q.vD ? bfhi(w.d.w) : 0.f};
    const float4 m0 = *(const float4*)ml, m1 = *(const float4*)(ml + 4);
    const float m[8] = {m0.x, m0.y, m0.z, m0.w, m1.x, m1.y, m1.z, m1.w};
#pragma unroll
    for (int i = 0; i < 8; ++i) out[i] = own[i] + (nb[i] - own[i]) * m[i];
}
struct R1Raw { RwRaw3 r, k, v, w, a; float4 qw0, qw1, qa0, qa1; };
DEV void r1_consts(const Params& p, int h, int dir, float* sm) {
    const int tid = opaque_tid();
    float* sv = (float*)((bf16_t*)sm + 14 * 4608);
    __syncthreads();
    if (tid < 64) { const int hc = h * 64 + tid; sv[64 + tid] = p.in[dir ? 18 : 16][hc]; sv[128 + tid] = p.in[dir ? 22 : 20][hc]; sv[192 + tid] = p.in[24][hc]; sv[256 + tid] = p.in[25][hc]; sv[320 + tid] = p.in[26][hc]; }
    if (tid < 320) { const int tn = tid >> 6, col = tid & 63; const int cb = tn < 3 ? tn * 512 + h * 64 : (tn == 3 ? 2048 + dir * 64 : 2176 + dir * 64); sv[384 + tid] = p.in[15][cb + col]; }
}
DEV void r1_load(const Params& p, int h, int dir, int c, R1Raw& R) {
    const int tid = opaque_tid();
    const bf16_t* P0 = (const bf16_t*)(p.ws + OFF_P0);
    const float* ww2 = p.in[dir ? 19 : 17]; const float* wa2 = p.in[dir ? 23 : 21];
    const int t = tid >> 3, j0 = (tid & 7) * 8, s = c * 64 + t;
    const RwNb nbq = rw_nb(s);
    R.r = rw_load3(P0, s, nbq, h * 64 + j0); R.k = rw_load3(P0, s, nbq, 512 + h * 64 + j0); R.v = rw_load3(P0, s, nbq, 1024 + h * 64 + j0);
    R.w = rw_load3(P0, s, nbq, 2048 + dir * 64 + j0); R.a = rw_load3(P0, s, nbq, 2176 + dir * 64 + j0);
    R.qw0 = ld4(ww2 + (size_t)t * 512 + h * 64 + j0); R.qw1 = ld4(ww2 + (size_t)t * 512 + h * 64 + j0 + 4);
    R.qa0 = ld4(wa2 + (size_t)t * 512 + h * 64 + j0); R.qa1 = ld4(wa2 + (size_t)t * 512 + h * 64 + j0 + 4);
}
DEV void rwkv1_unit(const Params& p, int h, int dir, int c, float* sm, R1Raw& R, int cnext) {
    const int tid = opaque_tid(), lane = tid & 63, wave = tid >> 6;
    bf16_t* RU = (bf16_t*)(p.ws + OFF_RU) + (size_t)((h * 2 + dir) * NCH + c) * 16384;
    float* BONS = (float*)(p.ws + OFF_BONS);
    bf16_t* img = (bf16_t*)sm;
#define SLOT(i_) (img + (i_) * 4608)
    float* fLW = (float*)SLOT(10);
    float* fAS = (float*)SLOT(12);
    float* sv = (float*)SLOT(14);
    const int t = tid >> 3, j0 = (tid & 7) * 8, s = c * 64 + t;
    const bf16_t* P0 = (const bf16_t*)(p.ws + OFF_P0);
    __syncthreads();
    *(uint4*)(SLOT(0) + t * 72 + j0) = R.r.o; *(uint4*)(SLOT(1) + t * 72 + j0) = R.k.o; *(uint4*)(SLOT(2) + t * 72 + j0) = R.v.o;
    *(uint4*)(SLOT(3) + t * 72 + j0) = R.w.o; *(uint4*)(SLOT(4) + t * 72 + j0) = R.a.o;
    __syncthreads();
    float r8[8], k8[8], v8[8];
    {
        float x8[8];
        const RwNb nbq = rw_nb(s);
        rw_comb3(R.r, nbq, SLOT(0), P0, s, t, h * 64 + j0, j0, sv + 384 + j0, r8);
        rw_comb3(R.k, nbq, SLOT(1), P0, s, t, 512 + h * 64 + j0, j0, sv + 448 + j0, k8);
        rw_comb3(R.v, nbq, SLOT(2), P0, s, t, 1024 + h * 64 + j0, j0, sv + 512 + j0, v8);
        rw_comb3(R.w, nbq, SLOT(3), P0, s, t, 2048 + dir * 64 + j0, j0, sv + 576 + j0, x8);
#pragma unroll
        for (int i = 0; i < 8; ++i) x8[i] = tanh_f(x8[i]);
        *(uint4*)(SLOT(6) + t * 72 + j0) = pack8(x8);
        rw_comb3(R.a, nbq, SLOT(4), P0, s, t, 2176 + dir * 64 + j0, j0, sv + 640 + j0, x8);
        *(uint4*)(SLOT(7) + t * 72 + j0) = pack8(x8);
        { const float wq[8] = {R.qw0.x, R.qw0.y, R.qw0.z, R.qw0.w, R.qw1.x, R.qw1.y, R.qw1.z, R.qw1.w}; *(uint4*)(SLOT(8) + t * 72 + j0) = pack8(wq); }
        { const float wq[8] = {R.qa0.x, R.qa0.y, R.qa0.z, R.qa0.w, R.qa1.x, R.qa1.y, R.qa1.z, R.qa1.w}; *(uint4*)(SLOT(9) + t * 72 + j0) = pack8(wq); }
    }
    r1_load(p, h, dir, cnext >= 0 ? cnext : c, R);
    __syncthreads();
    mm64<0, 1>(SLOT(6), SLOT(8), [=](int i0, int j, f32x4 a) {
#pragma unroll
        for (int r = 0; r < 4; ++r) fLW[(i0 + r) * 65 + j] = -0.6065306597f * sigmoid_f(sv[64 + j] + a[r]); }, lane, wave);
    mm64<0, 1>(SLOT(7), SLOT(9), [=](int i0, int j, f32x4 a) {
#pragma unroll
        for (int r = 0; r < 4; ++r) fAS[(i0 + r) * 65 + j] = sigmoid_f(sv[128 + j] + a[r]); }, lane, wave);
    __syncthreads();
#pragma unroll
    for (int j = 0; j < 8; ++j) {
        const int k = wave * 8 + j;
        const float v = wave_scan_add(fLW[lane * 65 + k], lane, dir);
        fLW[lane * 65 + k] = v;
        if (lane == (dir ? 0 : 63)) sv[k] = v;
    }
    __syncthreads();
    {
        float kkv[8], ss = 0.f;
#pragma unroll
        for (int i = 0; i < 8; ++i) { kkv[i] = k8[i] * sv[192 + j0 + i]; ss += kkv[i] * kkv[i]; }
        ss += __shfl_xor(ss, 1, 64); ss += __shfl_xor(ss, 2, 64); ss += __shfl_xor(ss, 4, 64);
        const float rn = rsqrtf(fmaxf(ss, 1e-24f));
        float fa[8], fb[8], fk[8], fr[8], fbp[8], fkp[8], bon = 0.f;
        const int tp = dir ? t + 1 : t - 1;
        const bool hasp = dir ? (t < 63) : (t > 0);
#pragma unroll
        for (int i = 0; i < 8; ++i) {
            const int k = j0 + i;
            const float Bt = fLW[t * 65 + k], Bx = hasp ? fLW[tp * 65 + k] : 0.f, asg = fAS[t * 65 + k];
            const float kk = kkv[i] * rn, kh = k8[i] * (1.f + (asg - 1.f) * sv[256 + k]);
            bon += r8[i] * kh * sv[320 + k];
            const float enB = fexp(-Bt), eLB = fexp(sv[k] - Bt), bv = kk * asg;
            fa[i] = -kk * fexp(Bx); fb[i] = bv * enB; fk[i] = kh * enB; fr[i] = r8[i] * fexp(Bt); fbp[i] = bv * eLB; fkp[i] = kh * eLB;
        }
        bon += __shfl_xor(bon, 1, 64); bon += __shfl_xor(bon, 2, 64); bon += __shfl_xor(bon, 4, 64);
        if ((tid & 7) == 0) BONS[((size_t)dir * TB + s) * 8 + h] = bon;
        *(uint4*)(SLOT(0) + t * 72 + j0) = pack8(fa); *(uint4*)(SLOT(1) + t * 72 + j0) = pack8(fb); *(uint4*)(SLOT(2) + t * 72 + j0) = pack8(fk);
        *(uint4*)(SLOT(3) + t * 72 + j0) = pack8(fr); *(uint4*)(SLOT(4) + t * 72 + j0) = pack8(fbp); *(uint4*)(SLOT(5) + t * 72 + j0) = pack8(fkp);
    }
    __syncthreads();
    *(uint4*)(SLOT(6) + t * 72 + j0) = pack8(v8);
    __syncthreads();
    mm64<0, 0>(SLOT(0), SLOT(1), [=](int i0, int j, f32x4 a) {
        float m[4];
#pragma unroll
        for (int r = 0; r < 4; ++r) { const bool keep = dir ? (j > i0 + r) : (j < i0 + r); m[r] = keep ? a[r] : 0.f; }
        const bool dg = (i0 >> 4) == (j >> 4);
        st_img(SLOT(7), i0, j, dg ? m[0] : 0.f, dg ? m[1] : 0.f, dg ? m[2] : 0.f, dg ? m[3] : 0.f);
        st_img(SLOT(8), i0, j, (dg ? m[0] : 0.f) + (j == i0 ? 1.f : 0.f), (dg ? m[1] : 0.f) + (j == i0 + 1 ? 1.f : 0.f), (dg ? m[2] : 0.f) + (j == i0 + 2 ? 1.f : 0.f), (dg ? m[3] : 0.f) + (j == i0 + 3 ? 1.f : 0.f));
        st_img(SLOT(12), i0, j, dg ? 0.f : m[0], dg ? 0.f : m[1], dg ? 0.f : m[2], dg ? 0.f : m[3]); }, lane, wave);
    mm64<0, 0>(SLOT(0), SLOT(2), [=](int i0, int j, f32x4 a) {
        float m[4];
#pragma unroll
        for (int r = 0; r < 4; ++r) { const bool keep = dir ? (j > i0 + r) : (j < i0 + r); m[r] = keep ? a[r] : 0.f; }
        st_img(SLOT(9), i0, j, m[0], m[1], m[2], m[3]); }, lane, wave);
    mm64<0, 0>(SLOT(3), SLOT(1), [=](int i0, int j, f32x4 a) {
        float m[4];
#pragma unroll
        for (int r = 0; r < 4; ++r) { const bool keep = dir ? (j >= i0 + r) : (j <= i0 + r); m[r] = keep ? a[r] : 0.f; }
        st_img(SLOT(10), i0, j, m[0], m[1], m[2], m[3]); }, lane, wave);
    mm64<0, 0>(SLOT(3), SLOT(2), [=](int i0, int j, f32x4 a) {
        float m[4];
#pragma unroll
        for (int r = 0; r < 4; ++r) { const bool keep = dir ? (j >= i0 + r) : (j <= i0 + r); m[r] = keep ? a[r] : 0.f; }
        st_img(SLOT(11), i0, j, m[0], m[1], m[2], m[3]); }, lane, wave);
    __syncthreads();
    mm64<0, 1>(SLOT(7), SLOT(7), [=](int i0, int j, f32x4 a) { st_img(SLOT(1), i0, j, a[0], a[1], a[2], a[3]); }, lane, wave);
    mm64<0, 1>(SLOT(9), SLOT(6), [=](int i0, int j, f32x4 a) { st_img(SLOT(13), i0, j, a[0], a[1], a[2], a[3]); }, lane, wave);
    __syncthreads();
    mm64<0, 1>(SLOT(1), SLOT(1), [=](int i0, int j, f32x4 a) { st_img(SLOT(7), i0, j, a[0], a[1], a[2], a[3]); }, lane, wave);
    mm64<0, 1>(SLOT(8), SLOT(1), [=](int i0, int j, f32x4 a) {
        st_img(SLOT(2), i0, j, a[0] + bf2f(SLOT(8)[(i0 + 0) * 72 + j]), a[1] + bf2f(SLOT(8)[(i0 + 1) * 72 + j]), a[2] + bf2f(SLOT(8)[(i0 + 2) * 72 + j]), a[3] + bf2f(SLOT(8)[(i0 + 3) * 72 + j])); }, lane, wave);
    __syncthreads();
    mm64<0, 1>(SLOT(7), SLOT(7), [=](int i0, int j, f32x4 a) { st_img(SLOT(1), i0, j, a[0], a[1], a[2], a[3]); }, lane, wave);
    {
        mm64<0, 1>(SLOT(2), SLOT(7), [=](int i0, int j, f32x4 a) {
            st_img(SLOT(8), i0, j, a[0] + bf2f(SLOT(2)[(i0 + 0) * 72 + j]), a[1] + bf2f(SLOT(2)[(i0 + 1) * 72 + j]), a[2] + bf2f(SLOT(2)[(i0 + 2) * 72 + j]), a[3] + bf2f(SLOT(2)[(i0 + 3) * 72 + j])); }, lane, wave);
    }
    __syncthreads();
    mm64<0, 1>(SLOT(8), SLOT(1), [=](int i0, int j, f32x4 a) {
        st_img(SLOT(2), i0, j, a[0] + bf2f(SLOT(8)[(i0 + 0) * 72 + j]), a[1] + bf2f(SLOT(8)[(i0 + 1) * 72 + j]), a[2] + bf2f(SLOT(8)[(i0 + 2) * 72 + j]), a[3] + bf2f(SLOT(8)[(i0 + 3) * 72 + j])); }, lane, wave);
    __syncthreads();
    mm64<0, 1>(SLOT(2), SLOT(12), [=](int i0, int j, f32x4 a) { st_img(SLOT(7), i0, j, a[0], a[1], a[2], a[3]); }, lane, wave);
    mm64<0, 1>(SLOT(2), SLOT(0), [=](int i0, int j, f32x4 a) { st_img(SLOT(1), i0, j, a[0], a[1], a[2], a[3]); }, lane, wave);
    mm64<0, 1>(SLOT(2), SLOT(13), [=](int i0, int j, f32x4 a) { st_img(SLOT(8), i0, j, a[0], a[1], a[2], a[3]); }, lane, wave);
    __syncthreads();
    {
        const bf16_t* Zp = (wave < 4) ? SLOT(1) : SLOT(8);
        bf16_t* Xi = (wave < 4) ? SLOT(12) : SLOT(9);
        const int ct = (wave & 3) * 16, g4 = (lane >> 4) * 4, l15 = lane & 15;
#pragma unroll
        for (int bs = 0; bs < 4; ++bs) {
            const int bi = dir ? 3 - bs : bs;
            f32x4 acc;
#pragma unroll
            for (int r = 0; r < 4; ++r) acc[r] = bf2f(Zp[(bi * 16 + g4 + r) * 72 + ct + l15]);
            const bool k0 = dir ? (bi == 0) : (bi >= 1), k1 = dir ? (bi <= 2) : (bi == 3);
            if (k0) acc = __builtin_amdgcn_mfma_f32_16x16x32_bf16(row_frag(SLOT(7), 72, bi * 16, 0, lane), tr_frag(Xi, 72, 0, ct, lane), acc, 0, 0, 0);
            if (k1) acc = __builtin_amdgcn_mfma_f32_16x16x32_bf16(row_frag(SLOT(7), 72, bi * 16, 32, lane), tr_frag(Xi, 72, 32, ct, lane), acc, 0, 0, 0);
            st_img(Xi, bi * 16 + g4, ct + l15, acc[0], acc[1], acc[2], acc[3]);
            __syncthreads();
        }
    }
    mm64<1, 1>(SLOT(12), SLOT(4), [=](int i0, int j, f32x4 a) {
        float m[4];
#pragma unroll
        for (int r = 0; r < 4; ++r) m[r] = a[r] + ((i0 + r) == j ? fexp(sv[j]) : 0.f);
        *(uint2*)(RU + j * 64 + i0) = make_uint2(pack2bf(m[0], m[1]), pack2bf(m[2], m[3])); }, lane, wave);
    mm64x2<1, 1>(SLOT(4), SLOT(9), SLOT(5), SLOT(6), [=](int i0, int j, f32x4 a) {
        *(uint2*)(RU + 4096 + j * 64 + i0) = make_uint2(pack2bf(a[0], a[1]), pack2bf(a[2], a[3])); }, lane, wave);
    mm64<1, 0>(SLOT(12), SLOT(10), [=](int i0, int j, f32x4 a) {
        const uint2 rr = *(const uint2*)(SLOT(3) + j * 72 + i0);
        *(uint2*)(RU + 8192 + j * 64 + i0) = make_uint2(pack2bf(a[0] + bflo(rr.x), a[1] + bfhi(rr.x)), pack2bf(a[2] + bflo(rr.y), a[3] + bfhi(rr.y))); }, lane, wave);
    mm64x2<0, 1>(SLOT(10), SLOT(9), SLOT(11), SLOT(6), [=](int i0, int j, f32x4 a) {
        *(uint2*)(RU + 12288 + j * 64 + i0) = make_uint2(pack2bf(a[0], a[1]), pack2bf(a[2], a[3])); }, lane, wave);
#undef SLOT
}

#define R2_LOAD(M_, C_, rnd_) do { const int r0_ = ((rnd_) < R2_NR ? (rnd_) : R2_NR - 1) * R2_RS; \
    _Pragma("unroll") for (int s_ = 0; s_ < R2_RS; ++s_) M_[s_] = *(const uint4*)(RU + (size_t)(chain * NCH + chunk_at(dir, r0_ + s_)) * 16384 + tid * 8); \
    _Pragma("unroll") for (int j_ = 0; j_ < 3; ++j_) { const int cq_ = tid + 512 * j_; \
        C_[j_] = *(const uint4*)(RU + (size_t)(chain * NCH + chunk_at(dir, r0_ + (cq_ >> 7))) * 16384 + 4096 + (vblk * 16 + ((cq_ >> 3) & 15)) * 64 + (cq_ & 7) * 8); } } while (0)
#define R2_ROUND(M_, C_, rnd_) do { \
    { const int row_ = tid >> 3, c8_ = tid & 7, sw_ = (row_ >> 1) & 7, u0_ = (c8_ >> 2) * 4 + (c8_ & 1) * 2, eh_ = ((c8_ >> 1) & 1) * 8; \
      _Pragma("unroll") for (int s_ = 0; s_ < R2_RS; ++s_) { char* sl_ = ring + s_ * 10240 + row_ * 128 + eh_; \
          *(uint2*)(sl_ + ((u0_ ^ sw_) * 16)) = make_uint2(M_[s_].x, M_[s_].y); *(uint2*)(sl_ + (((u0_ + 1) ^ sw_) * 16)) = make_uint2(M_[s_].z, M_[s_].w); } \
      _Pragma("unroll") for (int j_ = 0; j_ < 3; ++j_) { const int cq_ = tid + 512 * j_, rw_ = (cq_ >> 3) & 15, q8_ = cq_ & 7, i_ = q8_ >> 1, g0_ = (q8_ & 1) * 2, sc_ = (rw_ >> 1) & 7; \
          char* sl_ = ring + (cq_ >> 7) * 10240 + 8192 + rw_ * 128 + (i_ & 1) * 8; \
          *(uint2*)(sl_ + (((g0_ * 2 + (i_ >> 1)) ^ sc_) * 16)) = make_uint2(C_[j_].x, C_[j_].y); *(uint2*)(sl_ + ((((g0_ + 1) * 2 + (i_ >> 1)) ^ sc_) * 16)) = make_uint2(C_[j_].z, C_[j_].w); } } \
    R2_LOAD(M_, C_, (rnd_) + 2); \
    __syncthreads(); \
    if (wave == 0) { \
        _Pragma("unroll 4") for (int s_ = 0; s_ < R2_RS; ++s_) { \
            const int c_ = chunk_at(dir, (rnd_) * R2_RS + s_); const char* sl_ = ring + s_ * 10240; \
            unsigned pk_[4][2]; \
            _Pragma("unroll") for (int i_ = 0; i_ < 4; ++i_) { pk_[i_][0] = pack2bf(st[i_][0], st[i_][1]); pk_[i_][1] = pack2bf(st[i_][2], st[i_][3]); } \
            bf16_t* sp_ = S0G + ((size_t)(chain * NCH + c_) * 64 + vblk * 16 + l15) * 64 + g * 4; \
            _Pragma("unroll") for (int i_ = 0; i_ < 4; ++i_) *(uint2*)(sp_ + i_ * 16) = make_uint2(pk_[i_][0], pk_[i_][1]); \
            bf16x8 bfr_[2]; \
            _Pragma("unroll") for (int ks_ = 0; ks_ < 2; ++ks_) { const uint4 u_ = make_uint4(pk_[2 * ks_][0], pk_[2 * ks_][1], pk_[2 * ks_ + 1][0], pk_[2 * ks_ + 1][1]); bfr_[ks_] = __builtin_bit_cast(bf16x8, u_); } \
            const uint4 c01_ = *(const uint4*)(sl_ + 8192 + l15 * 128 + (((g * 2) ^ ((l15 >> 1) & 7)) * 16)), c23_ = *(const uint4*)(sl_ + 8192 + l15 * 128 + (((g * 2 + 1) ^ ((l15 >> 1) & 7)) * 16)); \
            const unsigned cw_[8] = {c01_.x, c01_.y, c01_.z, c01_.w, c23_.x, c23_.y, c23_.z, c23_.w}; \
            _Pragma("unroll") for (int i_ = 0; i_ < 4; ++i_) { \
                f32x4 acc_ = (f32x4){bflo(cw_[2 * i_]), bfhi(cw_[2 * i_]), bflo(cw_[2 * i_ + 1]), bfhi(cw_[2 * i_ + 1])}; \
                _Pragma("unroll") for (int ks_ = 0; ks_ < 2; ++ks_) { \
                    const int row_ = i_ * 16 + l15; \
                    const bf16x8 af_ = *(const bf16x8*)(sl_ + row_ * 128 + (((ks_ * 4 + g) ^ ((row_ >> 1) & 7)) * 16)); \
                    acc_ = __builtin_amdgcn_mfma_f32_16x16x32_bf16(af_, bfr_[ks_], acc_, 0, 0, 0); } \
                st[i_] = acc_; } } } \
    __syncthreads(); } while (0)
DEV void rwkv2_unit(const Params& p, int chain, int vblk, float* sm) {
    constexpr int R2_RS = 12, R2_NR = NCH / R2_RS;
    static_assert(R2_NR * R2_RS == NCH && R2_RS * 10240 <= LDS_BYTES, "R2 ring");
    const int tid = opaque_tid(), lane = tid & 63, wave = tid >> 6;
    const bf16_t* RU = (const bf16_t*)(p.ws + OFF_RU);
    bf16_t* S0G = (bf16_t*)(p.ws + OFF_RS0);
    char* ring = (char*)sm;
    const int dir = chain & 1, g = lane >> 4, l15 = lane & 15;
    f32x4 st[4];
#pragma unroll
    for (int i = 0; i < 4; ++i) st[i] = (f32x4){0.f, 0.f, 0.f, 0.f};
    uint4 ma[R2_RS], ca[3], mb[R2_RS], cb[3];
    __syncthreads();
    R2_LOAD(ma, ca, 0); R2_LOAD(mb, cb, 1);
#pragma unroll 1
    for (int rnd = 0; rnd < R2_NR; rnd += 2) {
        R2_ROUND(ma, ca, rnd);
        if (rnd + 1 < R2_NR) R2_ROUND(mb, cb, rnd + 1);
    }
}
#undef R2_LOAD
#undef R2_ROUND

DEV void rwkv3_unit(const Params& p, int h, int c, float* sm) {
    const int tid = opaque_tid(), lane = tid & 63, wave = tid >> 6;
    const bf16_t* P0 = (const bf16_t*)(p.ws + OFF_P0);
    const bf16_t* RUb = (const bf16_t*)(p.ws + OFF_RU);
    const bf16_t* S0G = (const bf16_t*)(p.ws + OFF_RS0);
    const float* BONS = (const float*)(p.ws + OFF_BONS);
    bf16_t* YC = (bf16_t*)(p.ws + OFF_YC);
    const float* mu = p.in[15]; const float* gn_g = p.in[27]; const float* gn_b = p.in[28];
    bf16_t* img = (bf16_t*)sm;
    float* O = sm + 4 * 2304;
    const int t = tid >> 3, v0 = (tid & 7) * 8, s = c * 64 + t;
    const size_t u0 = (size_t)((h * 2 + 0) * NCH + c), u1 = (size_t)((h * 2 + 1) * NCH + c);
    const uint4 gr0 = *(const uint4*)(RUb + u0 * 16384 + 8192 + t * 64 + v0), gs0 = *(const uint4*)(S0G + u0 * 4096 + t * 64 + v0);
    const uint4 gr1 = *(const uint4*)(RUb + u1 * 16384 + 8192 + t * 64 + v0), gs1 = *(const uint4*)(S0G + u1 * 4096 + t * 64 + v0);
    uint2 yl[2][2];
#pragma unroll
    for (int q = 0; q < 2; ++q) { const int idx = wave * 2 + q, ti = idx >> 2, tj = idx & 3;
        yl[q][0] = *(const uint2*)(RUb + u0 * 16384 + 12288 + (tj * 16 + (lane & 15)) * 64 + ti * 16 + (lane >> 4) * 4);
        yl[q][1] = *(const uint2*)(RUb + u1 * 16384 + 12288 + (tj * 16 + (lane & 15)) * 64 + ti * 16 + (lane >> 4) * 4); }
    const RwNb nbq = rw_nb(s);
    const RwRaw wv_ = rw_load(P0, s, nbq, 1024 + h * 64 + v0), wg_ = rw_load(P0, s, nbq, 1536 + h * 64 + v0);
    const float bon = BONS[(size_t)s * 8 + h] + BONS[((size_t)TB + s) * 8 + h];
    __syncthreads();
    *(uint4*)(img + 0 * 4608 + t * 72 + v0) = gr0; *(uint4*)(img + 2 * 4608 + t * 72 + v0) = gs0;
    *(uint4*)(img + 1 * 4608 + t * 72 + v0) = gr1; *(uint4*)(img + 3 * 4608 + t * 72 + v0) = gs1;
    __syncthreads();
#pragma unroll
    for (int q = 0; q < 2; ++q) {
        const int idx = wave * 2 + q, ti = idx >> 2, tj = idx & 3;
        f32x4 accd[2];
#pragma unroll
        for (int dir = 0; dir < 2; ++dir) {
            f32x4 acc = (f32x4){bflo(yl[q][dir].x), bfhi(yl[q][dir].x), bflo(yl[q][dir].y), bfhi(yl[q][dir].y)};
#pragma unroll
            for (int ks = 0; ks < 2; ++ks) acc = __builtin_amdgcn_mfma_f32_16x16x32_bf16(row_frag(img + dir * 4608, 72, ti * 16, ks * 32, lane), row_frag(img + (2 + dir) * 4608, 72, tj * 16, ks * 32, lane), acc, 0, 0, 0);
            accd[dir] = acc;
        }
#pragma unroll
        for (int r = 0; r < 4; ++r) {
            const int oi = (ti * 16 + (lane >> 4) * 4 + r) * 68 + tj * 16 + (lane & 15);
            O[oi] = accd[0][r] + accd[1][r];
        }
    }
    __syncthreads();
    {
        float y[8], sum = 0.f;
#pragma unroll
        for (int i = 0; i < 8; ++i) { y[i] = O[t * 68 + v0 + i]; sum += y[i]; }
        sum += __shfl_xor(sum, 1, 64); sum += __shfl_xor(sum, 2, 64); sum += __shfl_xor(sum, 4, 64);
        const float mean = sum * (1.f / 64.f);
        float sq = 0.f;
#pragma unroll
        for (int i = 0; i < 8; ++i) { y[i] -= mean; sq += y[i] * y[i]; }
        sq += __shfl_xor(sq, 1, 64); sq += __shfl_xor(sq, 2, 64); sq += __shfl_xor(sq, 4, 64);
        const float rstd = rsqrtf(sq * (1.f / 64.f) + 64e-5f);
        float vm[8], gm[8];
        rw_comb(wv_, nbq, mu, 1024 + h * 64 + v0, vm);
        rw_comb(wg_, nbq, mu, 1536 + h * 64 + v0, gm);
        float o[8];
#pragma unroll
        for (int i = 0; i < 8; ++i) o[i] = (y[i] * rstd * gn_g[h * 64 + v0 + i] + gn_b[h * 64 + v0 + i] + bon * vm[i]) * silu_f(gm[i]);
        *(uint4*)(YC + (size_t)s * 1024 + 512 + h * 64 + v0) = pack8(o);
    }
}

DEV void ln_rows(const float* src, const float* res_lat, const float* res_cx, int nrows, const float* __restrict__ g, const float* __restrict__ bt, float* dst_lat, float* dst_cx, int ncx,
                 bf16_t* hb = nullptr, const float* mvc = nullptr, const float* mvl = nullptr) {
    const int tid_ = opaque_tid(); const int lane = tid_ & 63, gw = blockIdx.x * NWV + (tid_ >> 6), ngw = gridDim.x * NWV;
    float4 gg[4], bb[4];
#pragma unroll
    for (int i = 0; i < 4; ++i) { gg[i] = ld4(g + i * 256 + lane * 4); bb[i] = ld4(bt + i * 256 + lane * 4); }
    float4 na[4], nr[4];
    { const int r = gw < nrows ? gw : 0; const float* x = src + (size_t)r * 1024; const float* xr = (r < ncx) ? (res_cx + (size_t)r * 1024) : (res_lat + (size_t)(r - ncx) * 1024);
#pragma unroll
      for (int i = 0; i < 4; ++i) { na[i] = ld4(x + i * 256 + lane * 4); nr[i] = ld4(xr + i * 256 + lane * 4); } }
    for (int r = gw; r < nrows; r += ngw) {
        float4 v[4];
        float sum = 0.f;
#pragma unroll
        for (int i = 0; i < 4; ++i) { const float4 a = na[i], rr = nr[i];
            v[i] = make_float4(ALPHA * rr.x + a.x, ALPHA * rr.y + a.y, ALPHA * rr.z + a.z, ALPHA * rr.w + a.w); sum += v[i].x + v[i].y + v[i].z + v[i].w; }
        { const int rn = (r + ngw < nrows) ? r + ngw : r; const float* x = src + (size_t)rn * 1024; const float* xr = (rn < ncx) ? (res_cx + (size_t)rn * 1024) : (res_lat + (size_t)(rn - ncx) * 1024);
#pragma unroll
          for (int i = 0; i < 4; ++i) { na[i] = ld4(x + i * 256 + lane * 4); nr[i] = ld4(xr + i * 256 + lane * 4); } }
        const float mean = wave_sum(sum) * (1.f / 1024.f);
        float sq = 0.f;
#pragma unroll
        for (int i = 0; i < 4; ++i) {
            v[i].x -= mean; v[i].y -= mean; v[i].z -= mean; v[i].w -= mean;
            sq += v[i].x * v[i].x + v[i].y * v[i].y + v[i].z * v[i].z + v[i].w * v[i].w;
        }
        const float rstd = rsqrtf(wave_sum(sq) * (1.f / 1024.f) + 1e-5f);
        float* d = (r < ncx) ? (dst_cx + (size_t)r * 1024) : (dst_lat + (size_t)(r - ncx) * 1024);
#pragma unroll
        for (int i = 0; i < 4; ++i) {
            const int c = i * 256 + lane * 4;
            const float4 y = make_float4(v[i].x * rstd * gg[i].x + bb[i].x, v[i].y * rstd * gg[i].y + bb[i].y, v[i].z * rstd * gg[i].z + bb[i].z, v[i].w * rstd * gg[i].w + bb[i].w);
            st4(d + c, y);
            if (hb != nullptr) {
                const float* m = (r < ncx) ? mvc : mvl;
                const float4 sh = ld4(m + c), sc = ld4(m + 1024 + c);
                *(uint2*)(hb + (size_t)r * 1024 + c) = make_uint2(pack2bf(y.x * (1.f + sc.x) + sh.x, y.y * (1.f + sc.y) + sh.y), pack2bf(y.z * (1.f + sc.z) + sh.z, y.w * (1.f + sc.w) + sh.w));
            }
        }
    }
}
DEV void phase_h1l(const Params& p) {
    const float* modv1 = (const float*)(p.ws + OFF_MODV) + 3 * 3072;
    bf16_t* H1 = (bf16_t*)(p.ws + OFF_H1B);
    const size_t gt = (size_t)blockIdx.x * NTHR + opaque_tid(), gn = (size_t)gridDim.x * NTHR;
    const int k = (int)(gt & 127) * 8;
    const Mod8 m0 = mod8_load(modv1, k), m1 = mod8_load(modv1 + 3072, k);
    constexpr size_t NI = (size_t)NB * NL * 128;
    for (size_t i0 = gt; i0 < NI; i0 += 4 * gn) {
        float4 xa[4], xb[4];
#pragma unroll
        for (int u = 0; u < 4; ++u) { const size_t i = i0 + u * gn, r = (i < NI ? i : gt) >> 7; xa[u] = ld4(p.out + r * DM + k); xb[u] = ld4(p.out + r * DM + k + 4); }
#pragma unroll
        for (int u = 0; u < 4; ++u) { const size_t i = i0 + u * gn, r = i >> 7; if (i < NI) *(uint4*)(H1 + r * DM + k) = mod8_apply(xa[u], xb[u], (r >= (size_t)NL) ? m1 : m0); }
    }
}

DEV void zero_f4(float* ptr, size_t nfloat) {
    const size_t n4 = nfloat / 4;
    for (size_t i = (size_t)blockIdx.x * NTHR + opaque_tid(); i < n4; i += (size_t)gridDim.x * NTHR) ((float4*)ptr)[i] = make_float4(0.f, 0.f, 0.f, 0.f);
}

DEV void chain_ids(int& chain, int& sub) {
    const int bid = blockIdx.x, xcd = bid & 7, idx = bid >> 3;
    chain = xcd * 2 + (idx >> 4); sub = idx & 15;
}

DEV void phase_conv1(const Params& p, float* sm) {
    const bf16_t* XM = (const bf16_t*)(p.ws + OFF_XM);
    bf16_t* XC = (bf16_t*)(p.ws + OFF_XC);
    float* G16P = (float*)(p.ws + OFF_G16P);
    const bf16_t* WFT = (const bf16_t*)(p.ws + OFF_WFT);
    const float* cw = p.in[31]; const float* cbias = p.in[32];
    bf16_t* imgC = (bf16_t*)sm;
    bf16_t* imgM = imgC + 64 * 264;
    float* red = (float*)(imgM + 64 * 264);
    float* cwl = red + 1024;
    const int tid = opaque_tid(), lane = tid & 63, wave = tid >> 6, t = tid >> 3, cg = tid & 7;
    for (int u = blockIdx.x; u < NB * NCH * 4; u += gridDim.x) {
        const int ci = u >> 2, q = u & 3, b = ci / NCH, c = ci % NCH, s = c * 64 + t;
        const size_t rowbase = (size_t)b * TB;
        int nrow[9]; unsigned vmask = 0u;
#pragma unroll
        for (int i = 0; i < 3; ++i)
#pragma unroll
            for (int j = 0; j < 3; ++j) {
                int ns = -1;
                if (s < NCX) { const int w2 = s + j - 1; if (i == 1 && w2 >= 0 && w2 < NCX) ns = w2; }
                else { const int n = s - NCX, rr = (n >> 6) + i - 1, w2 = (n & 63) + j - 1; if (rr >= 0 && rr < 128 && w2 >= 0 && w2 < 64) ns = NCX + rr * 64 + w2; }
                nrow[i * 3 + j] = ns >= 0 ? ns : s; vmask |= (ns >= 0 ? 1u : 0u) << (i * 3 + j);
            }
        const int tt = wave & 3, part = wave >> 2;
        f32x4 acc = (f32x4){0.f, 0.f, 0.f, 0.f};
        uint4 xn[9];
#pragma unroll
        for (int tap = 0; tap < 9; ++tap) xn[tap] = *(const uint4*)(XM + (rowbase + nrow[tap]) * 2048 + q * 512 + cg * 8);
#pragma unroll 1
        for (int half = 0; half < 2; ++half) {
            __syncthreads();
            for (int i = tid; i < 640; i += NTHR) { const int tp = i >> 6, c4 = (i & 63) * 4; st4(cwl + tp * 256 + c4, ld4((tp < 9 ? cw + tp * 2048 : cbias) + q * 512 + half * 256 + c4)); }
            __syncthreads();
#pragma unroll 1
            for (int it = 0; it < 4; ++it) {
                const int cl = it * 64 + cg * 8, c0 = q * 512 + half * 256 + cl;
                uint4 xc9[9];
#pragma unroll
                for (int tap = 0; tap < 9; ++tap) xc9[tap] = xn[tap];
                { const int gn = half * 4 + it + 1, c0n = q * 512 + (gn < 8 ? gn : 7) * 64 + cg * 8;
#pragma unroll
                  for (int tap = 0; tap < 9; ++tap) xn[tap] = *(const uint4*)(XM + (rowbase + nrow[tap]) * 2048 + c0n); }
                float a8[8];
                { const float4 b0 = ld4(cwl + 9 * 256 + cl), b1 = ld4(cwl + 9 * 256 + cl + 4); a8[0] = b0.x; a8[1] = b0.y; a8[2] = b0.z; a8[3] = b0.w; a8[4] = b1.x; a8[5] = b1.y; a8[6] = b1.z; a8[7] = b1.w; }
#pragma unroll
                for (int tap = 0; tap < 9; ++tap) {
                    const unsigned mk = ((vmask >> tap) & 1u) ? 0xffffffffu : 0u;
                    const uint4 xv = make_uint4(xc9[tap].x & mk, xc9[tap].y & mk, xc9[tap].z & mk, xc9[tap].w & mk);
                    float x8[8]; unpack8(xv, x8);
                    const float4 w0 = ld4(cwl + tap * 256 + cl), w1 = ld4(cwl + tap * 256 + cl + 4);
                    a8[0] += x8[0] * w0.x; a8[1] += x8[1] * w0.y; a8[2] += x8[2] * w0.z; a8[3] += x8[3] * w0.w;
                    a8[4] += x8[4] * w1.x; a8[5] += x8[5] * w1.y; a8[6] += x8[6] * w1.z; a8[7] += x8[7] * w1.w;
                }
#pragma unroll
                for (int i = 0; i < 8; ++i) a8[i] = silu_f(a8[i]);
                const uint4 xcv = pack8(a8);
                *(uint4*)(XC + (rowbase + s) * 2048 + c0) = xcv;
                *(uint4*)(imgC + t * 264 + cl) = xcv;
                *(uint4*)(imgM + t * 264 + cl) = xc9[4];
            }
            __syncthreads();
            {
                const bf16_t* img = part ? imgM : imgC;
                const bf16_t* wrow = WFT + (size_t)(lane & 15) * 4096 + part * 2048 + q * 512 + half * 256 + (lane >> 4) * 8;
#pragma unroll
                for (int ks = 0; ks < 8; ++ks) acc = __builtin_amdgcn_mfma_f32_16x16x32_bf16(row_frag(img, 264, tt * 16, ks * 32, lane), *(const bf16x8*)(wrow + ks * 32), acc, 0, 0, 0);
            }
        }
        if (part == 1) {
#pragma unroll
            for (int r = 0; r < 4; ++r) red[(tt * 16 + (lane >> 4) * 4 + r) * 16 + (lane & 15)] = acc[r];
        }
        __syncthreads();
        if (part == 0) {
#pragma unroll
            for (int r = 0; r < 4; ++r) {
                const int tk = tt * 16 + (lane >> 4) * 4 + r;
                G16P[(((size_t)rowbase + c * 64 + tk) * 16 + (lane & 15)) * 4 + q] = acc[r] + red[tk * 16 + (lane & 15)];
            }
        }
    }
}

struct GateRaw { float4 a, f; };
DEV GateRaw gate_load(const Params& p, size_t row, int dir, int h) {
    const float* G16P = (const float*)(p.ws + OFF_G16P);
    GateRaw g; g.a = ld4(G16P + (row * 16 + dir * 8 + h) * 4); g.f = ld4(G16P + (row * 16 + dir * 8 + 4 + h) * 4);
    return g;
}
DEV void gate_fin(const GateRaw& g, float bi, float bf, float& gi, float& lf) {
    gi = (g.a.x + g.a.y) + (g.a.z + g.a.w) + bi;
    lf = logsig_f((g.f.x + g.f.y) + (g.f.z + g.f.w) + bf);
}
DEV void gate_pair(const Params& p, size_t row, int dir, int h, float& gi, float& lf) {
    const GateRaw g = gate_load(p, row, dir, h);
    gate_fin(g, p.in[dir ? 41 : 37][h], p.in[dir ? 43 : 39][h], gi, lf);
}

DEV void phase_x1(const Params& p, float* sm) {
    int chain, sub; chain_ids(chain, sub);
    const int b = chain >> 3, h = (chain >> 1) & 3, dir = chain & 1;
    const bf16_t* XC = (const bf16_t*)(p.ws + OFF_XC);
    float* GSC = (float*)(p.ws + OFF_GSC); float* CSC = (float*)(p.ws + OFF_CSC); float* NBUF = (float*)(p.ws + OFF_NBUF);
    const float* gtab = (const float*)(p.ws + OFF_GTAB);
    bf16_t* SMAT = (bf16_t*)(p.ws + OFF_SMAT);
    const int tid = opaque_tid(), lane = tid & 63, wave = tid >> 6;
    float* sTot = sm; float* sRef = sm + 132; float* sM0 = sm + 264; float* sBeta = sm + 400;
    const float bias_i = p.in[dir ? 41 : 37][h], bias_f = p.in[dir ? 43 : 39][h];
    {
        GateRaw gn = gate_load(p, (size_t)b * TB + wave * 64 + lane, dir, h);
        for (int c = wave; c < NCH; c += NWV) {
            const GateRaw gc = gn;
            const int cn = (c + NWV < NCH) ? c + NWV : c;
            gn = gate_load(p, (size_t)b * TB + cn * 64 + lane, dir, h);
            float gi, lf; gate_fin(gc, bias_i, bias_f, gi, lf);
            const float bc = wave_scan_add(lf, lane, dir);
            const float ref = wave_max(gi - bc), tot = wave_sum(lf);
            if (lane == 0) { sTot[c] = tot; sRef[c] = ref; }
        }
    }
    __syncthreads();
    if (tid == 0) {
        float m0 = -INFINITY;
        for (int step = 0; step < NCH; ++step) {
            const int c = chunk_at(dir, step);
            sM0[c] = m0;
            const float mx = fmaxf(m0, sRef[c]);
            if (sub == 0) { CSC[(chain * NCH + c) * 2] = fexp(m0 - mx); CSC[(chain * NCH + c) * 2 + 1] = fexp(sRef[c] - mx); }
            m0 = sTot[c] + mx;
        }
    }
    __syncthreads();
    for (int k = wave; sub + 16 * k < NCH; k += NWV) {
        const int c = sub + 16 * k;
        const size_t row = (size_t)b * TB + c * 64 + lane;
        float gi, lf; gate_fin(gate_load(p, row, dir, h), bias_i, bias_f, gi, lf);
        const float bc = wave_scan_add(lf, lane, dir);
        const float a = gi - bc;
        const float amax = wave_scan_max(a, lane, dir);
        const float ref = sRef[c], m0 = sM0[c];
        const float mmax = fmaxf(amax, m0);
        const float mt = bc + mmax;
        const float alpha = fexp(ref - mmax), beta = fexp(a - ref), gg = fexp(m0 - mmax), em = fexp(-mt);
        st4(GSC + ((size_t)chain * TB + c * 64 + lane) * 4, make_float4(alpha, beta, gg, em));
        sBeta[k * 64 + lane] = beta;
    }
    __syncthreads();
    {
        float* part = sm + 1024;
        const int sg = tid >> 6, j8 = (tid & 63) * 8;
        uint4 xn[8];
        { const bf16_t* xp = XC + ((size_t)b * TB + sub * 64 + sg * 8) * 2048 + h * 512 + j8;
#pragma unroll
          for (int s = 0; s < 8; ++s) xn[s] = *(const uint4*)(xp + (size_t)s * 2048); }
        for (int k = 0; sub + 16 * k < NCH; ++k) {
            const int c = sub + 16 * k;
            uint4 xcur[8];
#pragma unroll
            for (int s = 0; s < 8; ++s) xcur[s] = xn[s];
            { const int cn = (c + 16 < NCH) ? c + 16 : c; const bf16_t* xp = XC + ((size_t)b * TB + cn * 64 + sg * 8) * 2048 + h * 512 + j8;
#pragma unroll
              for (int s = 0; s < 8; ++s) xn[s] = *(const uint4*)(xp + (size_t)s * 2048); }
            float acc[8];
#pragma unroll
            for (int i = 0; i < 8; ++i) acc[i] = 0.f;
#pragma unroll
            for (int s = 0; s < 8; ++s) {
                float f[8]; unpack8(xcur[s], f);
                const float be = sBeta[k * 64 + sg * 8 + s];
#pragma unroll
                for (int i = 0; i < 8; ++i) acc[i] += be * f[i];
            }
            __syncthreads();
            st4(part + sg * 512 + j8, make_float4(acc[0], acc[1], acc[2], acc[3])); st4(part + sg * 512 + j8 + 4, make_float4(acc[4], acc[5], acc[6], acc[7]));
            __syncthreads();
            float tot = 0.f;
#pragma unroll
            for (int q = 0; q < 8; ++q) tot += part[q * 512 + tid];
            NBUF[((size_t)chain * NCH + c) * 512 + tid] = tot;
        }
    }
    bf16_t* XCs = (bf16_t*)sm;
    bf16_t* Qs = XCs + 64 * 520;
    for (int u = blockIdx.x; u < NB * 4 * NCH; u += gridDim.x) {
        const int bh = u / NCH, c = u % NCH, ub = bh >> 2, uh = bh & 3;
        __syncthreads();
        float4 gq[2][4];
#pragma unroll
        for (int bb = 0; bb < 2; ++bb) { const float* G = gtab + (size_t)(uh * 128 + (tid & 63) * 2 + bb) * 16; gq[bb][0] = ld4(G); gq[bb][1] = ld4(G + 4); gq[bb][2] = ld4(G + 8); gq[bb][3] = ld4(G + 12); }
        uint4 xr[8];
#pragma unroll
        for (int i = 0; i < 8; ++i) { const int pp = tid + 512 * i, row = pp >> 6, c16 = pp & 63; xr[i] = *(const uint4*)(XC + ((size_t)ub * TB + c * 64 + row) * 2048 + uh * 512 + c16 * 8); }
#pragma unroll
        for (int i = 0; i < 8; ++i) {
            const int pp = tid + 512 * i, row = pp >> 6, c16 = pp & 63;
            const uint4 xv = xr[i];
            float f[8]; unpack8(xv, f);
            float q[8];
#pragma unroll
            for (int bb = 0; bb < 2; ++bb) {
                const float4 g0 = gq[bb][0], g1 = gq[bb][1], g2 = gq[bb][2], g3 = gq[bb][3];
                q[bb * 4 + 0] = f[bb * 4] * g0.x + f[bb * 4 + 1] * g1.x + f[bb * 4 + 2] * g2.x + f[bb * 4 + 3] * g3.x;
                q[bb * 4 + 1] = f[bb * 4] * g0.y + f[bb * 4 + 1] * g1.y + f[bb * 4 + 2] * g2.y + f[bb * 4 + 3] * g3.y;
                q[bb * 4 + 2] = f[bb * 4] * g0.z + f[bb * 4 + 1] * g1.z + f[bb * 4 + 2] * g2.z + f[bb * 4 + 3] * g3.z;
                q[bb * 4 + 3] = f[bb * 4] * g0.w + f[bb * 4 + 1] * g1.w + f[bb * 4 + 2] * g2.w + f[bb * 4 + 3] * g3.w;
            }
            *(uint4*)(XCs + row * 520 + c16 * 8) = xv;
            *(uint4*)(Qs + row * 520 + c16 * 8) = make_uint4(pack2bf(q[0], q[1]), pack2bf(q[2], q[3]), pack2bf(q[4], q[5]), pack2bf(q[6], q[7]));
        }
        __syncthreads();
        const int st = wave & 3, tt0 = (wave >> 2) * 2;
        f32x4 a0 = (f32x4){0.f, 0.f, 0.f, 0.f}, a1 = a0;
        const bf16_t* ap = XCs + (st * 16 + (lane & 15)) * 520 + (lane >> 4) * 8;
        const bf16_t* bp0 = Qs + (tt0 * 16 + (lane & 15)) * 520 + (lane >> 4) * 8;
        const bf16_t* bp1 = bp0 + 16 * 520;
#pragma unroll
        for (int ks = 0; ks < 16; ++ks) {
            const bf16x8 af = *(const bf16x8*)(ap + ks * 32);
            a0 = __builtin_amdgcn_mfma_f32_16x16x32_bf16(af, *(const bf16x8*)(bp0 + ks * 32), a0, 0, 0, 0);
            a1 = __builtin_amdgcn_mfma_f32_16x16x32_bf16(af, *(const bf16x8*)(bp1 + ks * 32), a1, 0, 0, 0);
        }
        bf16_t* sp = SMAT + (size_t)u * 4096 + (size_t)(tt0 * 16 + (lane & 15)) * 64 + st * 16 + (lane >> 4) * 4;
        *(uint2*)sp = make_uint2(pack2bf(a0[0], a0[1]), pack2bf(a0[2], a0[3]));
        *(uint2*)(sp + 16 * 64) = make_uint2(pack2bf(a1[0], a1[1]), pack2bf(a1[2], a1[3]));
    }
}

DEV void phase_x2(const Params& p, float* sm) {
    int chain, sub; chain_ids(chain, sub);
    const int b = chain >> 3, h = (chain >> 1) & 3, dir = chain & 1;
    const bf16_t* XC = (const bf16_t*)(p.ws + OFF_XC);
    float* GSC = (float*)(p.ws + OFF_GSC); const float* CSC = (const float*)(p.ws + OFF_CSC); const float* NBUF = (const float*)(p.ws + OFF_NBUF);
    const float* gtab = (const float*)(p.ws + OFF_GTAB);
    const bf16_t* SMAT = (const bf16_t*)(p.ws + OFF_SMAT);
    const int tid = opaque_tid();
    float* sD0 = sm; float* sCf = sm + 132; float* sN0 = sm + 264; float* sN2 = sN0 + 9 * 512;
    for (int i = tid; i < NCH; i += NTHR) { sD0[i] = CSC[(chain * NCH + i) * 2]; sCf[i] = CSC[(chain * NCH + i) * 2 + 1]; }
    __syncthreads();
    float* sBeta = sN2 + 9 * 512;
    for (int i = tid; i < 9 * 64; i += NTHR) { const int k = i >> 6, c = sub + 16 * k; if (c < NCH) sBeta[i] = GSC[((size_t)chain * TB + c * 64 + (i & 63)) * 4 + 1]; }
    if (tid < 128) {
        constexpr int NBT = 12;
        float4 n = make_float4(0.f, 0.f, 0.f, 0.f), nx[NBT];
        const float* nb = NBUF + (size_t)chain * NCH * 512 + tid * 4;
#pragma unroll
        for (int j = 0; j < NBT; ++j) nx[j] = ld4(nb + (size_t)chunk_at(dir, j) * 512);
#pragma unroll 1
        for (int step0 = 0; step0 < NCH; step0 += NBT) {
            float4 cu[NBT];
#pragma unroll
            for (int j = 0; j < NBT; ++j) cu[j] = nx[j];
#pragma unroll
            for (int j = 0; j < NBT; ++j) { const int sn = step0 + NBT + j; nx[j] = ld4(nb + (size_t)chunk_at(dir, sn < NCH ? sn : NCH - 1) * 512); }
            __builtin_amdgcn_sched_barrier(0);
#pragma unroll
            for (int j = 0; j < NBT; ++j) {
                const int c = chunk_at(dir, step0 + j);
                if ((c & 15) == sub) st4(sN0 + (c >> 4) * 512 + tid * 4, n);
                const float d = sD0[c], cf = sCf[c];
                n = make_float4(d * n.x + cf * cu[j].x, d * n.y + cf * cu[j].y, d * n.z + cf * cu[j].z, d * n.w + cf * cu[j].w);
            }
        }
    }
    __syncthreads();
    {
        const int blk = tid >> 2, cp = tid & 3;
        const float4 g = ld4(gtab + (size_t)(h * 128 + blk) * 16 + cp * 4);
        for (int k = 0; sub + 16 * k < NCH; ++k) {
            const float* n0 = sN0 + k * 512 + blk * 4;
            sN2[k * 512 + tid] = g.x * n0[0] + g.y * n0[1] + g.z * n0[2] + g.w * n0[3];
        }
    }
    __syncthreads();
    const int t = tid >> 3, part = tid & 7;
    for (int k = 0; sub + 16 * k < NCH; ++k) {
        const int c = sub + 16 * k;
        const size_t row = (size_t)b * TB + c * 64 + t;
        float dint = 0.f;
        {
            const bf16_t* xp = XC + row * 2048 + h * 512 + part * 64;
            const float* n2 = sN2 + k * 512 + part * 64;
#pragma unroll
            for (int i = 0; i < 8; ++i) {
                float f[8]; unpack8(*(const uint4*)(xp + i * 8), f);
                const float4 na = ld4(n2 + i * 8), nb2 = ld4(n2 + i * 8 + 4);
                dint += f[0] * na.x + f[1] * na.y + f[2] * na.z + f[3] * na.w + f[4] * nb2.x + f[5] * nb2.y + f[6] * nb2.z + f[7] * nb2.w;
            }
        }
        float di = 0.f;
        {
            float f[8]; unpack8(*(const uint4*)(SMAT + ((size_t)((b * 4 + h) * NCH + c)) * 4096 + t * 64 + part * 8), f);
#pragma unroll
            for (int e = 0; e < 8; ++e) {
                const int s = part * 8 + e;
                const float beta = sBeta[k * 64 + s];
                const bool keep = dir ? (s >= t) : (s <= t);
                di += keep ? f[e] * beta : 0.f;
            }
        }
        dint += __shfl_xor(dint, 1, 64); dint += __shfl_xor(dint, 2, 64); dint += __shfl_xor(dint, 4, 64);
        di += __shfl_xor(di, 1, 64); di += __shfl_xor(di, 2, 64); di += __shfl_xor(di, 4, 64);
        if (part == 0) {
            float* gp = GSC + ((size_t)chain * TB + c * 64 + t) * 4;
            const float4 g4 = ld4(gp);
            const float den = g4.x * di + g4.z * dint;
            gp[3] = 1.f / fmaxf(fabsf(den), g4.w);
        }
    }
}

#define MLSTM_PREFETCH(step_) do { \
    const int c_ = chunk_at(dir, (step_)); const size_t rb_ = (size_t)b * TB + (size_t)c_ * 64; \
    { const bf16_t* xb_ = XC + (rb_ + (tid >> 6)) * 2048 + h * 512 + (tid & 63) * 8; \
      rx0 = *(const uint4*)(xb_); rx1 = *(const uint4*)(xb_ + 8 * 2048); rx2 = *(const uint4*)(xb_ + 16 * 2048); rx3 = *(const uint4*)(xb_ + 24 * 2048); \
      rx4 = *(const uint4*)(xb_ + 32 * 2048); rx5 = *(const uint4*)(xb_ + 40 * 2048); rx6 = *(const uint4*)(xb_ + 48 * 2048); rx7 = *(const uint4*)(xb_ + 56 * 2048); } \
    rxm = *(const uint2*)(XM + (rb_ + ps) * 2048 + ch0 + pvb * 4); \
    rs = *(const uint4*)(SMAT + ((size_t)((b * 4 + h) * NCH + c_)) * 4096 + ps * 64 + pvb * 8); \
    rbeta = GSC[((size_t)chain * TB + c_ * 64 + ps) * 4 + 1]; \
    if (tid < 64) rsc = ld4(GSC + ((size_t)chain * TB + c_ * 64 + tid) * 4); \
    rd0 = CSC[(chain * NCH + c_) * 2]; rcf = CSC[(chain * NCH + c_) * 2 + 1]; } while (0)

DEV void phase_mlstm(const Params& p, float* sm) {
    int chain, sub; chain_ids(chain, sub);
    const int b = chain >> 3, h = (chain >> 1) & 3, dir = chain & 1;
    const bf16_t* XM = (const bf16_t*)(p.ws + OFF_XM);
    const bf16_t* XC = (const bf16_t*)(p.ws + OFF_XC);
    const bf16_t* SMAT = (const bf16_t*)(p.ws + OFF_SMAT);
    const float* GSC = (const float*)(p.ws + OFF_GSC); const float* CSC = (const float*)(p.ws + OFF_CSC);
    const float* gtab = (const float*)(p.ws + OFF_GTAB);
    bf16_t* H = (bf16_t*)(p.ws + OFF_H);
    const float* wv = p.in[35];
    char* smc = (char*)sm;
    bf16_t* XCs = (bf16_t*)smc;
    bf16_t* Cs = (bf16_t*)(smc + 66560);
    bf16_t* Vb = (bf16_t*)(smc + 66560 + 33280);
    bf16_t* Vw = Vb + 32 * 72;
    bf16_t* Sm = Vw + 32 * 72;
    float* Gs = (float*)(smc + 66560 + 33280 + 2 * 4608 + 9216);
    float* sc = Gs + 2048;
    const int tid = opaque_tid(), lane = tid & 63, wave = tid >> 6;
    for (int i = tid; i < 32 * 520 / 2; i += NTHR) ((unsigned*)Cs)[i] = 0u;
    for (int i = tid; i < 2048; i += NTHR) Gs[i] = gtab[h * 2048 + i];
    const int ps = tid >> 3, pvb = tid & 7;
    const int ch0 = h * 512 + sub * 32;
    float wvr[16];
#pragma unroll
    for (int i = 0; i < 16; ++i) wvr[i] = wv[(size_t)((ch0 >> 2) + pvb) * 16 + i];
    f32x4 accS[4][2];
#pragma unroll
    for (int i = 0; i < 4; ++i) { accS[i][0] = (f32x4){0.f, 0.f, 0.f, 0.f}; accS[i][1] = (f32x4){0.f, 0.f, 0.f, 0.f}; }
    uint4 rx0, rx1, rx2, rx3, rx4, rx5, rx6, rx7; uint2 rxm; uint4 rs; float rbeta; float4 rsc = make_float4(0.f, 0.f, 0.f, 0.f); float rd0, rcf;
    MLSTM_PREFETCH(0);
    __syncthreads();
#pragma unroll 1
    for (int step = 0; step < NCH; ++step) {
        const int c = chunk_at(dir, step);
        const float d0 = rd0, cf = rcf;
        {
            bf16_t* xd = XCs + (tid >> 6) * 520 + (tid & 63) * 8;
            *(uint4*)(xd) = rx0; *(uint4*)(xd + 8 * 520) = rx1; *(uint4*)(xd + 16 * 520) = rx2; *(uint4*)(xd + 24 * 520) = rx3;
            *(uint4*)(xd + 32 * 520) = rx4; *(uint4*)(xd + 40 * 520) = rx5; *(uint4*)(xd + 48 * 520) = rx6; *(uint4*)(xd + 56 * 520) = rx7;
        }
        {
            const float x0 = bflo(rxm.x), x1 = bfhi(rxm.x), x2 = bflo(rxm.y), x3 = bfhi(rxm.y);
#pragma unroll
            for (int d = 0; d < 4; ++d) {
                const float v = (x0 * wvr[d] + x1 * wvr[4 + d] + x2 * wvr[8 + d] + x3 * wvr[12 + d]) * rbeta;
                Vb[(pvb * 4 + d) * 72 + ps] = __builtin_bit_cast(unsigned short, (__bf16)v);
                Vw[(pvb * 4 + d) * 72 + ps] = __builtin_bit_cast(unsigned short, (__bf16)(v * cf));
            }
        }
        {
#define SMASK(q_) (((dir ? (pvb * 8 + 2 * (q_) >= ps) : (pvb * 8 + 2 * (q_) <= ps)) ? 0x0000ffffu : 0u) | ((dir ? (pvb * 8 + 2 * (q_) + 1 >= ps) : (pvb * 8 + 2 * (q_) + 1 <= ps)) ? 0xffff0000u : 0u))
            *(uint4*)(Sm + ps * 72 + pvb * 8) = make_uint4(rs.x & SMASK(0), rs.y & SMASK(1), rs.z & SMASK(2), rs.w & SMASK(3));
#undef SMASK
        }
        if (tid < 64) st4(sc + tid * 4, rsc);
        { const int nstep = (step + 1 < NCH) ? step + 1 : step; MLSTM_PREFETCH(nstep); }
        __syncthreads();
        {
            const int vt = wave & 1, tt = wave >> 1;
            f32x4 ao = (f32x4){0.f, 0.f, 0.f, 0.f}, ai = ao, ao1 = ao, ao2 = ao, ao3 = ao;
            const bf16_t* ap = Cs + (vt * 16 + (lane & 15)) * 520 + (lane >> 4) * 8;
            const bf16_t* bp = XCs + (tt * 16 + (lane & 15)) * 520 + (lane >> 4) * 8;
#pragma unroll
            for (int ks = 0; ks < 16; ks += 4) {
                ao = __builtin_amdgcn_mfma_f32_16x16x32_bf16(*(const bf16x8*)(ap + ks * 32), *(const bf16x8*)(bp + ks * 32), ao, 0, 0, 0);
                ao1 = __builtin_amdgcn_mfma_f32_16x16x32_bf16(*(const bf16x8*)(ap + (ks + 1) * 32), *(const bf16x8*)(bp + (ks + 1) * 32), ao1, 0, 0, 0);
                ao2 = __builtin_amdgcn_mfma_f32_16x16x32_bf16(*(const bf16x8*)(ap + (ks + 2) * 32), *(const bf16x8*)(bp + (ks + 2) * 32), ao2, 0, 0, 0);
                ao3 = __builtin_amdgcn_mfma_f32_16x16x32_bf16(*(const bf16x8*)(ap + (ks + 3) * 32), *(const bf16x8*)(bp + (ks + 3) * 32), ao3, 0, 0, 0);
            }
            ao = (ao + ao1) + (ao2 + ao3);
            const bf16_t* ap2 = Vb + (vt * 16 + (lane & 15)) * 72 + (lane >> 4) * 8;
            const bf16_t* bp2 = Sm + (tt * 16 + (lane & 15)) * 72 + (lane >> 4) * 8;
#pragma unroll
            for (int ks = 0; ks < 2; ++ks) ai = __builtin_amdgcn_mfma_f32_16x16x32_bf16(*(const bf16x8*)(ap2 + ks * 32), *(const bf16x8*)(bp2 + ks * 32), ai, 0, 0, 0);
            if (c >= 4) {
                const int t = tt * 16 + (lane & 15);
                const float4 s4 = ld4(sc + t * 4);
                const float h0 = (s4.x * ai[0] + s4.z * ao[0]) * s4.w, h1 = (s4.x * ai[1] + s4.z * ao[1]) * s4.w;
                const float h2 = (s4.x * ai[2] + s4.z * ao[2]) * s4.w, h3 = (s4.x * ai[3] + s4.z * ao[3]) * s4.w;
                bf16_t* hp = H + ((size_t)b * NL + (size_t)c * 64 + t - NCX) * 2048 + ch0 + vt * 16 + (lane >> 4) * 4;
                const unsigned u0 = pack2bf(h0, h1), u1 = pack2bf(h2, h3);
                asm volatile("global_atomic_pk_add_bf16 %0, %1, off sc1\n\tglobal_atomic_pk_add_bf16 %0, %2, off offset:4 sc1" :: "v"(hp), "v"(u0), "v"(u1) : "memory");
            }
        }
#pragma unroll
        for (int jt = 0; jt < 4; ++jt) { accS[jt][0] *= d0; accS[jt][1] *= d0; }
#pragma unroll
        for (int ks = 0; ks < 2; ++ks) {
            const bf16x8 b0 = *(const bf16x8*)(Vw + (lane & 15) * 72 + ks * 32 + (lane >> 4) * 8);
            const bf16x8 b1 = *(const bf16x8*)(Vw + (16 + (lane & 15)) * 72 + ks * 32 + (lane >> 4) * 8);
            const int row0 = ks * 32 + (lane >> 4) * 8 + ((lane & 15) >> 2);
#pragma unroll
            for (int jt = 0; jt < 4; ++jt) {
                const int col = wave * 64 + jt * 16 + (lane & 3) * 4;
                const s16x4 lo = __builtin_amdgcn_ds_read_tr16_b64_v4i16((__attribute__((address_space(3))) s16x4*)(XCs + row0 * 520 + col));
                const s16x4 hi = __builtin_amdgcn_ds_read_tr16_b64_v4i16((__attribute__((address_space(3))) s16x4*)(XCs + (row0 + 4) * 520 + col));
                const bf16x8 af = (bf16x8){lo[0], lo[1], lo[2], lo[3], hi[0], hi[1], hi[2], hi[3]};
                accS[jt][0] = __builtin_amdgcn_mfma_f32_16x16x32_bf16(af, b0, accS[jt][0], 0, 0, 0);
                accS[jt][1] = __builtin_amdgcn_mfma_f32_16x16x32_bf16(af, b1, accS[jt][1], 0, 0, 0);
            }
        }
        __syncthreads();
#pragma unroll
        for (int jt = 0; jt < 4; ++jt) {
            const int blk = wave * 16 + jt * 4 + (lane >> 4);
            const float4 g0 = ld4(Gs + blk * 16), g1 = ld4(Gs + blk * 16 + 4), g2 = ld4(Gs + blk * 16 + 8), g3 = ld4(Gs + blk * 16 + 12);
#pragma unroll
            for (int v2 = 0; v2 < 2; ++v2) {
                const f32x4 a = accS[jt][v2];
                const float o0 = g0.x * a[0] + g0.y * a[1] + g0.z * a[2] + g0.w * a[3];
                const float o1 = g1.x * a[0] + g1.y * a[1] + g1.z * a[2] + g1.w * a[3];
                const float o2 = g2.x * a[0] + g2.y * a[1] + g2.z * a[2] + g2.w * a[3];
                const float o3 = g3.x * a[0] + g3.y * a[1] + g3.z * a[2] + g3.w * a[3];
                *(uint2*)(Cs + (v2 * 16 + (lane & 15)) * 520 + blk * 4) = make_uint2(pack2bf(o0, o1), pack2bf(o2, o3));
            }
        }
    }
}

DEV void phase_finish1(const Params& p) {
    bf16_t* H = (bf16_t*)(p.ws + OFF_H);
    const bf16_t* XC = (const bf16_t*)(p.ws + OFF_XC);
    const bf16_t* Z = (const bf16_t*)(p.ws + OFF_XM);
    const float* ng = p.in[44]; const float* skip = p.in[45];
    const int tid_ = opaque_tid(); const int lane = tid_ & 63, gw = blockIdx.x * NWV + (tid_ >> 6), ngw = gridDim.x * NWV;
    const int h = gw & 3, c0 = h * 512 + lane * 8;
    float gn8[8], sk8[8];
    { const float4 a0 = ld4(ng + c0), a1 = ld4(ng + c0 + 4), b0 = ld4(skip + c0), b1 = ld4(skip + c0 + 4);
      gn8[0] = a0.x; gn8[1] = a0.y; gn8[2] = a0.z; gn8[3] = a0.w; gn8[4] = a1.x; gn8[5] = a1.y; gn8[6] = a1.z; gn8[7] = a1.w;
      sk8[0] = b0.x; sk8[1] = b0.y; sk8[2] = b0.z; sk8[3] = b0.w; sk8[4] = b1.x; sk8[5] = b1.y; sk8[6] = b1.z; sk8[7] = b1.w; }
    constexpr int NIT = NB * NL * 4;
    uint4 nh[2], nx[2], nz[2];
#pragma unroll
    for (int u = 0; u < 2; ++u) { const int it = gw + u * ngw, r = (it < NIT ? it : gw) >> 2, b = r >= NL ? 1 : 0, nn = r - b * NL;
        nh[u] = *(const uint4*)(H + (size_t)r * 2048 + c0); nx[u] = *(const uint4*)(XC + ((size_t)b * TB + NCX + nn) * 2048 + c0); nz[u] = *(const uint4*)(Z + (size_t)r * 2048 + c0); }
    for (int it0 = gw; it0 < NIT; it0 += 2 * ngw) {
        uint4 ch[2], cx[2], cz[2];
#pragma unroll
        for (int u = 0; u < 2; ++u) { ch[u] = nh[u]; cx[u] = nx[u]; cz[u] = nz[u]; }
#pragma unroll
        for (int u = 0; u < 2; ++u) { const int it = it0 + (2 + u) * ngw, r = (it < NIT ? it : gw) >> 2, b = r >= NL ? 1 : 0, nn = r - b * NL;
            nh[u] = *(const uint4*)(H + (size_t)r * 2048 + c0); nx[u] = *(const uint4*)(XC + ((size_t)b * TB + NCX + nn) * 2048 + c0); nz[u] = *(const uint4*)(Z + (size_t)r * 2048 + c0); }
#pragma unroll
        for (int u = 0; u < 2; ++u) {
            const int it = it0 + u * ngw, r = it >> 2;
            float v[8]; unpack8(ch[u], v);
            float sum = 0.f;
#pragma unroll
            for (int j = 0; j < 8; ++j) sum += v[j];
            const float mean = wave_sum(sum) * (1.f / 512.f);
            float sq = 0.f;
#pragma unroll
            for (int j = 0; j < 8; ++j) { v[j] -= mean; sq += v[j] * v[j]; }
            const float rstd = rsqrtf(wave_sum(sq) * (1.f / 512.f) + 1e-5f);
            float xc[8], z[8];
            unpack8(cx[u], xc); unpack8(cz[u], z);
            float o[8];
#pragma unroll
            for (int j = 0; j < 8; ++j) o[j] = (v[j] * rstd * gn8[j] + sk8[j] * xc[j]) * silu_f(z[j]);
            if (it < NIT) *(uint4*)(H + (size_t)r * 2048 + c0) = make_uint4(pack2bf(o[0], o[1]), pack2bf(o[2], o[3]), pack2bf(o[4], o[5]), pack2bf(o[6], o[7]));
        }
    }
}

__global__ void __launch_bounds__(NTHR) fwd_kernel(Params p) {
    extern __shared__ __attribute__((aligned(16))) float sm[];
    volatile LAS unsigned* xst = (volatile LAS unsigned*)((LAS char*)sm + (LDS_BYTES - 16));
    if (threadIdx.x == 0) { xst[0] = 0u; xst[1] = 0u; }
    __syncthreads();
    const XcdBarrier xbar = xcd_barrier_post((unsigned*)(p.ws + OFF_BAR), xst);
    const int tid = opaque_tid(), lane = tid & 63, wave = tid >> 6;
    float* modv = (float*)(p.ws + OFF_MODV);
    float* X1C = (float*)(p.ws + OFF_X1C);

    phase_mod(p, sm);
    phase_tables(p);
    transpose_convert(p.in[8], 1024, EIN, 4096, (bf16_t*)(p.ws + OFF_WT0), sm);
    transpose_convert(p.in[29], 1024, 4096, 4096, (bf16_t*)(p.ws + OFF_WT1), sm);
    transpose_convert(p.in[9], 1024, 1024, 1024, (bf16_t*)(p.ws + OFF_WT2), sm);
    transpose_convert(p.in[30], 2048, 1024, 1024, (bf16_t*)(p.ws + OFF_WT3), sm);
    xcd_barrier(xbar);

#pragma unroll 1
    for (int b = 0; b < NB; ++b) {
        if (b == 0) { phase_h0(p, 0); xcd_barrier(xbar); }
        run_gemm((const bf16_t*)(p.ws + OFF_YC), (const bf16_t*)(p.ws + OFF_WT0), TB, 3840, DM, EpBf16{(bf16_t*)(p.ws + OFF_P0), EIN, EIN}, sm);
        mini_gemm<3, 2>((const bf16_t*)(p.ws + OFF_YC), DM, 33 * (int)blockIdx.x, TB - 1, (const bf16_t*)(p.ws + OFF_WT0), DM, 3840, (bf16_t*)(p.ws + OFF_P0), EIN, 3840, 33, sm);
        xcd_barrier(xbar);
        {
            const int x = blockIdx.x & 7, q0 = blockIdx.x >> 3;
            R1Raw R;
            r1_consts(p, x, q0 & 1, sm);
            r1_load(p, x, q0 & 1, q0 >> 1, R);
            for (int q = q0; q < 2 * NCH; q += 32) rwkv1_unit(p, x, q & 1, q >> 1, sm, R, (q + 32 < 2 * NCH) ? ((q + 32) >> 1) : -1);
            gla_consts(p, x >> 1, sm);
            if (q0 < 8) { for (int g = 2 * q0; g < 2 * q0 + 2; ++g) gla1_unit(p, x >> 1, g & 1, (NCH / 2) * (x & 1) + (g >> 1), sm); }
            else { for (int g = 16 + (q0 - 8); g < NCH; g += 24) gla1_unit(p, x >> 1, g & 1, (NCH / 2) * (x & 1) + (g >> 1), sm); }
        }
        xcd_barrier(xbar);
        if (blockIdx.x < 128) gla2_unit(p, blockIdx.x);
        else if (blockIdx.x < 192) { const int i = (blockIdx.x - 128) >> 3; rwkv2_unit(p, (blockIdx.x & 7) * 2 + (i >> 2), i & 3, sm); }
        xcd_barrier(xbar);
        {
            const int x = blockIdx.x & 7, j = blockIdx.x >> 3;
            gla_consts(p, x >> 1, sm);
            const int r0 = j < 2 ? 2 * j : (j < 10 ? 4 + (j - 2) * 5 : 44 + (j - 10) * 4), nr = j < 2 ? 2 : (j < 10 ? 5 : 4);
            for (int r = r0; r < r0 + nr; ++r) rwkv3_unit(p, x, r, sm);
            for (int g = j; g < NCH / 2; g += 32) gla3_unit(p, x >> 1, (NCH / 2) * (x & 1) + g, sm);
        }
        xcd_barrier(xbar);
        run_gemm((const bf16_t*)(p.ws + OFF_YC), (const bf16_t*)(p.ws + OFF_WT2), TB, DM, DM, EpRes0{(float*)(p.ws + OFF_P0), modv, b}, sm);
        xcd_barrier(xbar);
        ln_rows((const float*)(p.ws + OFF_P0), p.in[0] + (size_t)b * NL * DM, p.in[2] + (size_t)b * NCX * DM, TB, p.in[6], p.in[7], p.out + (size_t)b * NL * DM, X1C + (size_t)b * NCX * DM, NCX,
                (bf16_t*)(p.ws + OFF_H1B) + (size_t)b * TB * DM, modv + (3 + 2) * 3072, modv + (3 + b) * 3072);
        if (b == 0) phase_h0(p, 1);
        xcd_barrier(xbar);
    }

    run_gemm((const bf16_t*)(p.ws + OFF_H1B), (const bf16_t*)(p.ws + OFF_WT1), RT, 2048, DM, EpBf16{(bf16_t*)(p.ws + OFF_XM), 2048, 2048}, sm);
    zero_f4((float*)(p.ws + OFF_H), (size_t)NB * NL * 1024);
    xcd_barrier(xbar);
    phase_conv1(p, sm);
    xcd_barrier(xbar);
    phase_x1(p, sm);
    xcd_barrier(xbar);
    phase_x2(p, sm);
    xcd_barrier(xbar);
    phase_mlstm(p, sm);
    xcd_barrier(xbar);
    phase_h1l(p);
    xcd_barrier(xbar);
    run_gemm((const bf16_t*)(p.ws + OFF_H1B), (const bf16_t*)(p.ws + OFF_WT1) + (size_t)2048 * 1024, NB * NL, 2048, DM, EpBf16{(bf16_t*)(p.ws + OFF_XM), 2048, 2048}, sm);
    xcd_barrier(xbar);
    phase_finish1(p);
    xcd_barrier(xbar);
    run_gemm((const bf16_t*)(p.ws + OFF_H), (const bf16_t*)(p.ws + OFF_WT3), NB * NL, DM, 2048, EpRes1{(float*)(p.ws + OFF_XC), modv + 3 * 3072}, sm);
    xcd_barrier(xbar);
    ln_rows((const float*)(p.ws + OFF_XC), p.out, p.out, NB * NL, p.in[6] + 1024, p.in[7] + 1024, p.out, p.out, 0);
}

extern "C" void kernel_launch(void* const* d_in, const int* in_sizes, int n_in, void* d_out, int out_size, void* d_ws, size_t ws_size, hipStream_t stream) {
    static int grid_blocks = 0;
    if (grid_blocks == 0) {
        if (ws_size < WS_NEED || n_in != 46) { fprintf(stderr, "kernel_launch: bad ws_size %zu (need %zu) or n_in %d\n", ws_size, (size_t)WS_NEED, n_in); grid_blocks = -1; return; }
        int dev = 0, cus = 0, per_cu = 0;
        (void)hipGetDevice(&dev);
        (void)hipDeviceGetAttribute(&cus, hipDeviceAttributeMultiprocessorCount, dev);
        (void)hipFuncSetAttribute((const void*)fwd_kernel, hipFuncAttributeMaxDynamicSharedMemorySize, LDS_BYTES);
        (void)hipOccupancyMaxActiveBlocksPerMultiprocessor(&per_cu, (const void*)fwd_kernel, NTHR, LDS_BYTES);
        if (per_cu < 1 || cus < 256) { fprintf(stderr, "kernel_launch: occupancy query says %d blocks/CU on %d CUs; this kernel needs 256 resident workgroups\n", per_cu, cus); grid_blocks = -1; return; }
        grid_blocks = 256;
    }
    if (grid_blocks < 0) return;
    (void)hipMemsetAsync((char*)d_ws + OFF_BAR, 0, XCD_BAR_WORDS * 4, stream);
    Params p{};
    for (int i = 0; i < 46; ++i) p.in[i] = (const float*)d_in[i];
    p.out = (float*)d_out; p.ws = (char*)d_ws;
    void* args[] = {&p};
    hipError_t e = hipLaunchCooperativeKernel((const void*)fwd_kernel, dim3(grid_blocks), dim3(NTHR), args, LDS_BYTES, stream);
    if (e != hipSuccess) fprintf(stderr, "cooperative launch failed: %s (grid %d)\n", hipGetErrorString(e), grid_blocks);
}
```

```cpp
#include <hip/hip_runtime.h>
#include <cstdio>
#include <cmath>

#define DEV __device__ __forceinline__

constexpr int NB = 2, NL = 8192, DM = 1024, NCX = 256, TB = NCX + NL;
constexpr int RT = NB * TB;
constexpr int NCH = TB / 64;
constexpr int EIN = 3872, RW0 = 1568;
constexpr int NTHR = 512, NWV = 8;
constexpr float ALPHA = 1.41421356237f;
constexpr float KSCALE = 0.04419417382f;

constexpr size_t OFF_MODV = 0;
constexpr size_t OFF_X1C  = 131072;
constexpr size_t OFF_BAR  = 3145728;
constexpr size_t OFF_BIG  = 4194304;
constexpr size_t OFF_P0   = OFF_BIG;
constexpr size_t OFF_YC   = OFF_BIG + (size_t)TB * EIN * 2;
constexpr size_t OFF_GDS  = OFF_YC + (size_t)TB * 1024 * 2;
constexpr size_t OFF_GDEC = OFF_GDS + (size_t)8 * NCH * 8192 * 4;
constexpr size_t OFF_RU   = OFF_GDEC + (size_t)8 * NCH * 64 * 4;
constexpr size_t OFF_RS0  = OFF_RU + (size_t)16 * NCH * 16384 * 2;
constexpr size_t OFF_BONS = OFF_RS0 + (size_t)16 * NCH * 4096 * 2;
constexpr size_t L0_END   = OFF_BONS + (size_t)2 * TB * 8 * 4;
constexpr size_t OFF_XM   = OFF_BIG;
constexpr size_t OFF_XC   = OFF_XM + (size_t)RT * 2048 * 2;
constexpr size_t OFF_H    = OFF_XC + (size_t)RT * 2048 * 2;
constexpr size_t OFF_WT0  = OFF_H + (size_t)NB * NL * 2048 * 2;
constexpr size_t OFF_WT1  = OFF_WT0 + (size_t)4096 * 1024 * 2;
constexpr size_t OFF_WT2  = OFF_WT1 + (size_t)4096 * 1024 * 2;
constexpr size_t OFF_WT3  = OFF_WT2 + (size_t)1024 * 1024 * 2;
constexpr size_t OFF_G16  = OFF_WT3 + (size_t)1024 * 2048 * 2;
constexpr size_t OFF_SMAT = OFF_G16 + (size_t)RT * 16 * 4;
constexpr size_t OFF_GSC  = OFF_SMAT + (size_t)NB * 4 * NCH * 4096 * 2;
constexpr size_t OFF_CSC  = OFF_GSC + (size_t)16 * TB * 4 * 4;
constexpr size_t OFF_NBUF = OFF_CSC + (size_t)16 * NCH * 2 * 4;
constexpr size_t OFF_GTAB = 3407872;
constexpr size_t OFF_WFT  = OFF_GTAB + (size_t)4 * 128 * 16 * 4;
static_assert(OFF_WFT + (size_t)16 * 4096 * 2 <= OFF_BIG, "low-region tables overflow");
constexpr size_t OFF_G16P = OFF_NBUF + (size_t)16 * NCH * 512 * 4;
constexpr size_t OFF_H1B  = OFF_G16;
constexpr size_t WS_NEED  = (OFF_G16P + (size_t)4 * RT * 16 * 4 > OFF_H1B + (size_t)RT * 1024 * 2) ? OFF_G16P + (size_t)4 * RT * 16 * 4 : OFF_H1B + (size_t)RT * 1024 * 2;
static_assert(WS_NEED <= (size_t)256 * 1024 * 1024, "workspace exceeds the guaranteed 256 MiB");

static_assert(L0_END <= OFF_WT0, "layer-0 buffers overlap the weight copies");
constexpr int LDS_BYTES = 139264;

struct Params { const float* in[46]; float* out; char* ws; };
typedef unsigned short bf16_t;
typedef __attribute__((ext_vector_type(8))) short bf16x8;
typedef __attribute__((ext_vector_type(4))) short s16x4;
typedef __attribute__((ext_vector_type(2))) short s16x2;
typedef __attribute__((ext_vector_type(4))) float f32x4;
typedef __attribute__((ext_vector_type(2))) __bf16 bf2_t;
DEV unsigned pack2bf(float lo, float hi) { bf2_t v; v[0] = (__bf16)lo; v[1] = (__bf16)hi; return __builtin_bit_cast(unsigned, v); }
DEV float bflo(unsigned u) { return __uint_as_float(u << 16); }
DEV float bfhi(unsigned u) { return __uint_as_float(u & 0xffff0000u); }
DEV float bf2f(bf16_t v) { return __uint_as_float(((unsigned)v) << 16); }
DEV void unpack8(uint4 u, float* f) { f[0] = bflo(u.x); f[1] = bfhi(u.x); f[2] = bflo(u.y); f[3] = bfhi(u.y); f[4] = bflo(u.z); f[5] = bfhi(u.z); f[6] = bflo(u.w); f[7] = bfhi(u.w); }

#define DPPX_F(src_, ctrl_) __int_as_float(__builtin_amdgcn_update_dpp(0, __float_as_int(src_), (ctrl_), 0xf, 0xf, false))
DEV float red8_sum(float v) { v += DPPX_F(v, 0xB1); v += DPPX_F(v, 0x4E); v += DPPX_F(v, 0x141); return v; }
DEV float wave_sum(float v) {
    v += DPPX_F(v, 0xB1); v += DPPX_F(v, 0x4E); v += DPPX_F(v, 0x141); v += DPPX_F(v, 0x140);
    const int b = __float_as_int(v);
    return (__int_as_float(__builtin_amdgcn_readlane(b, 0)) + __int_as_float(__builtin_amdgcn_readlane(b, 16))) + (__int_as_float(__builtin_amdgcn_readlane(b, 32)) + __int_as_float(__builtin_amdgcn_readlane(b, 48)));
}
DEV float wave_max(float v) {
    v = fmaxf(v, DPPX_F(v, 0xB1)); v = fmaxf(v, DPPX_F(v, 0x4E)); v = fmaxf(v, DPPX_F(v, 0x141)); v = fmaxf(v, DPPX_F(v, 0x140));
    const int b = __float_as_int(v);
    return fmaxf(fmaxf(__int_as_float(__builtin_amdgcn_readlane(b, 0)), __int_as_float(__builtin_amdgcn_readlane(b, 16))), fmaxf(__int_as_float(__builtin_amdgcn_readlane(b, 32)), __int_as_float(__builtin_amdgcn_readlane(b, 48))));
}
DEV float fexp(float x) { return __expf(x); }
DEV float frcp(float x) { return __builtin_amdgcn_rcpf(x); }
DEV float sigmoid_f(float x) { return frcp(1.f + fexp(-x)); }
DEV float silu_f(float x) { return x * frcp(1.f + fexp(-x)); }
DEV float logsig_f(float x) { return fminf(x, 0.f) - __logf(1.f + fexp(-fabsf(x))); }
DEV float tanh_f(float x) { const float e = fexp(2.f * x); return 1.f - 2.f * frcp(e + 1.f); }
DEV void lds_fence() { asm volatile("" ::: "memory"); }
DEV int opaque_tid() { int t = threadIdx.x; asm volatile("" : "+v"(t)); return t; }
DEV int scan_s(int dir, int u) { return dir == 0 ? u : (u < NCX ? (NCX - 1 - u) : (TB - 1 + NCX - u)); }
DEV int chunk_at(int dir, int step) { return dir == 0 ? step : (step < 4 ? 3 - step : (NCH + 3 - step)); }
DEV float4 ld4(const float* p) { return *(const float4*)p; }
DEV void st4(float* p, float4 v) { *(float4*)p = v; }


#define XB_TMO      128
#define XB_XCNT(j)  (256  + 64 * (j))
#define XB_XSUB(j)  (1280 + 64 * (j))
#define XB_XGEN(j)  (2304 + 64 * (j))
#define XB_TOP      3328
#define XB_TOPGEN   3392
#define XCD_BAR_WORDS 3456
#define XB_SPIN_CAP (1u << 22)
#define LAS __attribute__((address_space(3)))
DEV unsigned xb_ld(unsigned* p) { return __hip_atomic_load(p, __ATOMIC_RELAXED, __HIP_MEMORY_SCOPE_AGENT); }
DEV unsigned xb_add(unsigned* p, unsigned v) { return __hip_atomic_fetch_add(p, v, __ATOMIC_RELAXED, __HIP_MEMORY_SCOPE_AGENT); }
DEV unsigned xb_xcc_id() { return (unsigned)__builtin_amdgcn_s_getreg((3 << 11) | 20) & 0xFu; }
#define XB_SPIN(cond, bar) do { unsigned _sp = 0; while (cond) { __builtin_amdgcn_s_sleep(1); \
    if ((++_sp & 255u) == 0u) { if (xb_ld(&(bar)[XB_TMO])) break; if (_sp > XB_SPIN_CAP) { atomicAdd(&(bar)[XB_TMO], 1u); break; } } } } while (0)
struct XcdBarrier { unsigned* bar; unsigned x; volatile LAS unsigned* st; };
DEV XcdBarrier xcd_barrier_post(unsigned* bar, volatile LAS unsigned* st) {
    XcdBarrier b; b.bar = bar; b.x = xb_xcc_id(); b.st = st;
    if (threadIdx.x == 0) (void)xb_add(&bar[XB_XCNT(b.x)], 1u);
    return b;
}
DEV void xcd_barrier_complete(unsigned* bar, unsigned x, unsigned& nloc, unsigned& nx) {
    const unsigned G = gridDim.x * gridDim.y * gridDim.z;
    unsigned sum, cnt, mine, sp = 0u;
    for (;;) {
        sum = 0u; cnt = 0u; mine = 0u;
#pragma unroll
        for (unsigned j = 0; j < 16; ++j) { const unsigned c = xb_ld(&bar[XB_XCNT(j)]); sum += c; cnt += (c > 0u) ? 1u : 0u; mine = (j == x) ? c : mine; }
        if (sum == G) break;
        __builtin_amdgcn_s_sleep(1);
        if ((++sp & 255u) == 0u) { if (xb_ld(&bar[XB_TMO])) break; if (sp > XB_SPIN_CAP) { atomicAdd(&bar[XB_TMO], 1u); break; } }
    }
    nloc = mine > 0u ? mine : 1u; nx = cnt > 0u ? cnt : 1u;
}
DEV void xcd_barrier(const XcdBarrier& b) {
    asm volatile("s_waitcnt vmcnt(0)" ::: "memory");
    __syncthreads();
    if (threadIdx.x == 0) {
        unsigned* bar = b.bar;
        __builtin_amdgcn_s_waitcnt(0);
        unsigned nloc = b.st[0], nx = b.st[1];
        if (nloc == 0u) { xcd_barrier_complete(bar, b.x, nloc, nx); b.st[0] = nloc; b.st[1] = nx; }
        const unsigned old = xb_add(&bar[XB_XSUB(b.x)], 1u);
        const unsigned gen = old / nloc;
        if (old + 1u == (gen + 1u) * nloc) {
            __builtin_amdgcn_fence(__ATOMIC_RELEASE, "agent");
            asm volatile("s_waitcnt vmcnt(0)" ::: "memory");
            const unsigned og = xb_add(&bar[XB_TOP], 1u);
            const unsigned tg = og / nx;
            if (og + 1u == (tg + 1u) * nx) xb_add(&bar[XB_TOPGEN], 1u);
            else XB_SPIN(xb_ld(&bar[XB_TOPGEN]) == tg, bar);
            __builtin_amdgcn_fence(__ATOMIC_ACQUIRE, "agent");
            xb_add(&bar[XB_XGEN(b.x)], 1u);
            asm volatile("s_waitcnt vmcnt(0)" ::: "memory");
        } else {
            XB_SPIN(xb_ld(&bar[XB_XGEN(b.x)]) == gen, bar);
            __builtin_amdgcn_fence(__ATOMIC_ACQUIRE, "agent");
            asm volatile("s_waitcnt vmcnt(0)" ::: "memory");
        }
    }
    __syncthreads();
}

namespace pg8 {
#define PG8_LAS __attribute__((address_space(3)))
typedef unsigned short bf16_t;
typedef short bf16x8 __attribute__((ext_vector_type(8)));
typedef float f32x4 __attribute__((ext_vector_type(4)));
typedef unsigned u32x4 __attribute__((ext_vector_type(4)));
constexpr int BM = 256, BK = 64, HALF = 128, HTB = HALF * BK * 2  , STAGE_BYTES = 8 * HTB, NXCD = 8, WGM = 8;

__host__ __device__ __forceinline__ int lds_byte(int r, int c) { const int st = (r >> 4) * 2 + (c >> 5), rr = r & 15, cc = c & 31, ob = rr * 64 + cc * 2; return st * 1024 + (ob ^ (((ob >> 9) & 1) << 5)); }
__host__ __device__ __forceinline__ void stage_rc(int b, int& R, int& C) { const int st = b / 1024, sb = b % 1024, swz = sb ^ (((sb >> 9) & 1) << 5); R = (st >> 1) * 16 + swz / 64; C = (st & 1) * 32 + (swz % 64) / 2; }
__host__ __device__ __forceinline__ int perm32(int rho) { const int n = rho >> 4, i = rho & 15; return 8 * (i >> 2) + 4 * n + (i & 3); }

struct Unit { int pm, pn; };
struct Gemm { const bf16_t* A; const bf16_t* Bt; int M, N, K; };

struct StaticOrder {
    int nM, nN, nwg, G, c;
    __host__ __device__ void init(int M, int N, int G_, int c_) { nM = M / BM; nN = N / BM; nwg = nM * nN; G = G_; c = c_; }
    __host__ __device__ bool next(int i, Unit& u) const {
        const long L = (long)i * G + c; if (L >= nwg) return false;
        int wgid = (int)L; { const int q = nwg / NXCD, r = nwg % NXCD, xcd = wgid % NXCD, off = wgid / NXCD; wgid = (xcd < r ? xcd * (q + 1) : r * (q + 1) + (xcd - r) * q) + off; }
        const int nig = WGM * nN, gid = wgid / nig, fm = gid * WGM, gsz = (nM - fm) < WGM ? (nM - fm) : WGM;
        u.pm = fm + ((wgid % nig) % gsz); u.pn = (wgid % nig) / gsz; return true;
    }
    __device__ __forceinline__ void a_ready(const Unit&) const {}
    __device__ __forceinline__ void done(const Unit&) const {}
};

template <class Epi, class Sched, bool STAMP = false>
__device__ __forceinline__ void gemm_phase(PG8_LAS unsigned char* lds, const Gemm g, const Sched& S, const Epi& E, unsigned long long* stamps) {
    int tid = threadIdx.x; asm volatile("" : "+v"(tid));
    const int wid = __builtin_amdgcn_readfirstlane(tid >> 6), lane = tid & 63, wr = wid >> 2, wc = wid & 3, fr = lane & 15, fq = lane >> 4;
    const int K = g.K, nt = K / BK;
#define PG8_STAMP() do { } while (0)
    PG8_STAMP();
    unsigned voffA[2], voffB[2];
#pragma unroll
    for (int i = 0; i < 2; ++i) { int R, C; stage_rc(tid * 16 + i * 8192, R, C); const int Rb = Epi::PERM ? ((R & ~31) + perm32(R & 31)) : R;
        voffA[i] = (unsigned)(R * K + C) * 2u; voffB[i] = (unsigned)(Rb * K + C) * 2u; }
    const size_t kstep = (size_t)(BK * 2);
    const size_t hstep = (size_t)HALF * K * 2;
    const size_t tstep = 2 * hstep;
    const unsigned ldsw = (unsigned)wid * 1024u;
    const int aoff = lds_byte(wr * 64 + fr, fq * 8), boff = lds_byte(wc * 32 + fr, fq * 8);
#define PG8_SA(b, h) (((b) * 2 + (h)) * HTB)
#define PG8_SB(b, h) ((4 + (b) * 2 + (h)) * HTB)
#define PG8_STAGE(bufoff, gbase, voff) do { _Pragma("unroll") for (int _i = 0; _i < 2; ++_i) \
        __builtin_amdgcn_global_load_lds((const unsigned*)((const char*)(gbase) + (voff)[_i]), (PG8_LAS unsigned*)(lds + (bufoff) + ldsw + _i * 8192), 16, 0, 0); } while (0)
#define PG8_LDA(dst, b, h) do { _Pragma("unroll") for (int m = 0; m < 4; ++m) _Pragma("unroll") for (int k = 0; k < 2; ++k) dst[m][k] = *(const PG8_LAS bf16x8*)(lds + PG8_SA(b, h) + aoff + m * 2048 + k * 1024); } while (0)
#define PG8_LDB(dst, b, h) do { _Pragma("unroll") for (int n = 0; n < 2; ++n) _Pragma("unroll") for (int k = 0; k < 2; ++k) dst[n][k] = *(const PG8_LAS bf16x8*)(lds + PG8_SB(b, h) + boff + n * 2048 + k * 1024); } while (0)
#define PG8_MMA(ai, bj, At, Bt) do { __builtin_amdgcn_s_setprio(1); _Pragma("unroll") for (int m = 0; m < 4; ++m) _Pragma("unroll") for (int n = 0; n < 2; ++n) _Pragma("unroll") for (int k = 0; k < 2; ++k) \
        acc[ai][bj][m][n] = __builtin_amdgcn_mfma_f32_16x16x32_bf16(Bt[n][k], At[m][k], acc[ai][bj][m][n], 0, 0, 0); __builtin_amdgcn_s_setprio(0); } while (0)
#define PG8_WAIT_V(n) asm volatile("s_waitcnt vmcnt(" #n ")" ::: "memory")
#define PG8_WAIT_L(n) asm volatile("s_waitcnt lgkmcnt(" #n ")" ::: "memory")
#define PG8_BAR __builtin_amdgcn_s_barrier()
#define PG8_SCHED __builtin_amdgcn_sched_barrier(0)
    Unit cur, nxt; int ui = 0;
    if (!S.next(0, cur)) return;
    f32x4 acc[2][2][4][2];
#pragma unroll
    for (int a = 0; a < 2; ++a)
#pragma unroll
        for (int b = 0; b < 2; ++b)
#pragma unroll
            for (int m = 0; m < 4; ++m)
#pragma unroll
                for (int n = 0; n < 2; ++n) acc[a][b][m][n] = (f32x4){0.f, 0.f, 0.f, 0.f};
    bf16x8 At[4][2], B0[2][2], B1[2][2];
    const char* cA = (const char*)g.A + (size_t)cur.pm * tstep; const char* cB = (const char*)g.Bt + (size_t)cur.pn * tstep;
    S.a_ready(cur);
    PG8_STAGE(PG8_SB(0, 0), cB, voffB); PG8_STAGE(PG8_SA(0, 0), cA, voffA); PG8_STAGE(PG8_SB(0, 1), cB + hstep, voffB); PG8_STAGE(PG8_SA(0, 1), cA + hstep, voffA);
    if (wr == 1) PG8_BAR;
    PG8_WAIT_V(4); PG8_BAR;
    PG8_STAGE(PG8_SB(1, 0), cB + kstep, voffB); PG8_STAGE(PG8_SA(1, 0), cA + kstep, voffA); PG8_STAGE(PG8_SB(1, 1), cB + hstep + kstep, voffB);
    PG8_WAIT_V(6); PG8_BAR;
    PG8_STAMP();
    for (;;) {
        const bool has_next = S.next(ui + 1, nxt);
        const char* nA = has_next ? (const char*)g.A + (size_t)nxt.pm * tstep : cA; const char* nB = has_next ? (const char*)g.Bt + (size_t)nxt.pn * tstep : cB;
        for (int t = 0; t < nt; t += 2) {
            const bool last = (t == nt - 2);
            const char* a1 = cA + (size_t)(t + 1) * kstep;
            const char* a2 = last ? nA : cA + (size_t)(t + 2) * kstep; const char* b2 = last ? nB : cB + (size_t)(t + 2) * kstep;
            const char* a3 = a2 + kstep; const char* b3 = b2 + kstep;
            if (last && has_next) S.a_ready(nxt);
            PG8_LDB(B0, 0, 0); PG8_SCHED; PG8_LDA(At, 0, 0); PG8_STAGE(PG8_SA(1, 1), a1 + hstep, voffA);
            PG8_WAIT_L(8); PG8_BAR; PG8_WAIT_L(0); PG8_MMA(0, 0, At, B0); PG8_BAR; PG8_SCHED;
            PG8_LDB(B1, 0, 1); PG8_STAGE(PG8_SB(0, 0), b2, voffB);
            PG8_BAR; PG8_WAIT_L(0); PG8_MMA(0, 1, At, B1); PG8_BAR;
            PG8_LDA(At, 0, 1); PG8_STAGE(PG8_SA(0, 0), a2, voffA);
            PG8_BAR; PG8_WAIT_L(0); PG8_MMA(1, 0, At, B0); PG8_BAR; PG8_SCHED;
            PG8_STAGE(PG8_SB(0, 1), b2 + hstep, voffB);
            PG8_WAIT_V(6); PG8_BAR; PG8_MMA(1, 1, At, B1); PG8_BAR;
            PG8_LDB(B0, 1, 0); PG8_SCHED; PG8_LDA(At, 1, 0); PG8_STAGE(PG8_SA(0, 1), a2 + hstep, voffA);
            PG8_WAIT_L(8); PG8_BAR; PG8_WAIT_L(0); PG8_MMA(0, 0, At, B0); PG8_BAR; PG8_SCHED;
            PG8_LDB(B1, 1, 1); PG8_STAGE(PG8_SB(1, 0), b3, voffB);
            PG8_BAR; PG8_WAIT_L(0); PG8_MMA(0, 1, At, B1); PG8_BAR;
            PG8_LDA(At, 1, 1); PG8_STAGE(PG8_SA(1, 0), a3, voffA);
            PG8_BAR; PG8_WAIT_L(0); PG8_MMA(1, 0, At, B0); PG8_BAR; PG8_SCHED;
            PG8_STAGE(PG8_SB(1, 1), b3 + hstep, voffB);
            PG8_WAIT_V(6); PG8_BAR; PG8_MMA(1, 1, At, B1); PG8_BAR;
        }
        PG8_STAMP();
        if constexpr (!Epi::AFTER_DRAIN) { E(acc, cur, wr, wc, fr, fq); S.done(cur); }
        PG8_STAMP();
        if (!has_next) break;
#pragma unroll
        for (int a = 0; a < 2; ++a)
#pragma unroll
            for (int b = 0; b < 2; ++b)
#pragma unroll
                for (int m = 0; m < 4; ++m)
#pragma unroll
                    for (int n = 0; n < 2; ++n) acc[a][b][m][n] = (f32x4){0.f, 0.f, 0.f, 0.f};
        cur = nxt; cA = nA; cB = nB; ++ui;
    }
    PG8_WAIT_V(0);
    if (wr == 0) PG8_BAR;
    PG8_BAR;
    if constexpr (Epi::AFTER_DRAIN) { E.fused(acc, cur, wr, wc, fr, fq, lds, wid, lane); S.done(cur); }
    PG8_STAMP();
#undef PG8_STAMP
#undef PG8_SA
#undef PG8_SB
#undef PG8_STAGE
#undef PG8_LDA
#undef PG8_LDB
#undef PG8_MMA
#undef PG8_WAIT_V
#undef PG8_WAIT_L
#undef PG8_BAR
#undef PG8_SCHED
}
}

DEV void transpose_convert(const float* __restrict__ W, int K, int N, int Npad, bf16_t* Wt, float* sm) {
    float (*T)[65] = (float (*)[65])sm;
    const int tid = opaque_tid();
    const int kt = K / 64, ntl = Npad / 64;
    for (int tile = blockIdx.x; tile < kt * ntl; tile += gridDim.x) {
        const int k0 = (tile / ntl) * 64, n0 = (tile % ntl) * 64;
        __syncthreads();
#pragma unroll
        for (int i = 0; i < 2; ++i) {
            const int k = (tid >> 4) + 32 * i, n4 = (tid & 15) * 4;
            float4 v = make_float4(0.f, 0.f, 0.f, 0.f);
            if (n0 + n4 < N) v = ld4(W + (size_t)(k0 + k) * N + n0 + n4);
            T[k][n4] = v.x; T[k][n4 + 1] = v.y; T[k][n4 + 2] = v.z; T[k][n4 + 3] = v.w;
        }
        __syncthreads();
        const int n = tid >> 3, kq = (tid & 7) * 8;
        unsigned o[4];
#pragma unroll
        for (int j = 0; j < 4; ++j) o[j] = pack2bf(T[kq + 2 * j][n], T[kq + 2 * j + 1][n]);
        bf16_t* dst = Wt + (size_t)(n0 + n) * K + k0 + kq;
        *(uint4*)dst = make_uint4(o[0], o[1], o[2], o[3]);
    }
}

struct EpBf16 {
    static constexpr bool PERM = true, AFTER_DRAIN = false;
    bf16_t* O; int ldc; int ncols;
    DEV void operator()(const pg8::f32x4 (&acc)[2][2][4][2], const pg8::Unit& u, int wr, int wc, int fr, int fq) const {
        const int row0 = u.pm * 256 + wr * 64 + fr, col0 = u.pn * 256 + wc * 32 + 8 * fq;
#pragma unroll
        for (int ai = 0; ai < 2; ++ai)
#pragma unroll
            for (int m = 0; m < 4; ++m) {
                bf16_t* rowp = O + (size_t)(row0 + ai * 128 + m * 16) * ldc + col0;
#pragma unroll
                for (int bj = 0; bj < 2; ++bj) {
                    if (col0 + bj * 128 < ncols) {
                        const pg8::f32x4 v0 = acc[ai][bj][m][0], v1 = acc[ai][bj][m][1];
                        *(uint4*)(rowp + bj * 128) = make_uint4(pack2bf(v0[0], v0[1]), pack2bf(v0[2], v0[3]), pack2bf(v1[0], v1[1]), pack2bf(v1[2], v1[3]));
                    }
                }
            }
    }
};
struct EpRes0 {
    static constexpr bool PERM = false, AFTER_DRAIN = false;
    float* C; const float* mv; int b;
    DEV void operator()(const pg8::f32x4 (&acc)[2][2][4][2], const pg8::Unit& u, int wr, int wc, int fr, int fq) const {
        const bool isc = (u.pm * 256 < NCX);
        const float* gp = mv + (isc ? 2 : b) * 3072 + 2048;
        const int row0 = u.pm * 256 + wr * 64 + fr, col0 = u.pn * 256 + wc * 32 + 4 * fq;
#pragma unroll
        for (int ai = 0; ai < 2; ++ai)
#pragma unroll
            for (int m = 0; m < 4; ++m) {
                const size_t ro = (size_t)(row0 + ai * 128 + m * 16) * DM + col0;
#pragma unroll
                for (int bj = 0; bj < 2; ++bj)
#pragma unroll
                    for (int n = 0; n < 2; ++n) {
                        const int co = bj * 128 + n * 16;
                        const float4 g = ld4(gp + col0 + co); const pg8::f32x4 v = acc[ai][bj][m][n];
                        st4(C + ro + co, make_float4(g.x * v[0], g.y * v[1], g.z * v[2], g.w * v[3]));
                    }
            }
    }
};
struct EpRes1 {
    static constexpr bool PERM = false, AFTER_DRAIN = false;
    float* C; const float* mv;
    DEV void operator()(const pg8::f32x4 (&acc)[2][2][4][2], const pg8::Unit& u, int wr, int wc, int fr, int fq) const {
        const float* gp = mv + (u.pm * 256 >= NL ? 1 : 0) * 3072 + 2048;
        const int row0 = u.pm * 256 + wr * 64 + fr, col0 = u.pn * 256 + wc * 32 + 4 * fq;
#pragma unroll
        for (int ai = 0; ai < 2; ++ai)
#pragma unroll
            for (int m = 0; m < 4; ++m) {
                const size_t ro = (size_t)(row0 + ai * 128 + m * 16) * DM + col0;
#pragma unroll
                for (int bj = 0; bj < 2; ++bj)
#pragma unroll
                    for (int n = 0; n < 2; ++n) {
                        const int co = bj * 128 + n * 16;
                        const float4 g = ld4(gp + col0 + co); const pg8::f32x4 v = acc[ai][bj][m][n];
                        st4(C + ro + co, make_float4(g.x * v[0], g.y * v[1], g.z * v[2], g.w * v[3]));
                    }
            }
    }
};
template <class EP>
DEV void run_gemm(const bf16_t* A, const bf16_t* Bt, int M, int N, int K, const EP& ep, float* sm) {
    pg8::Gemm g{A, Bt, M, N, K}; pg8::StaticOrder S; S.init(M, N, (int)gridDim.x, (int)blockIdx.x);
    pg8::gemm_phase<EP, pg8::StaticOrder, false>((PG8_LAS unsigned char*)sm, g, S, ep, nullptr);
}

template <int MT, int NT>
DEV void mini_gemm(const bf16_t* A, int lda, int row0, int row_clamp, const bf16_t* Bt, int ldb, int brow0, bf16_t* C, int ldc, int ccol0, int nvalid, float* sm) {
    const int tid = opaque_tid(), lane = tid & 63, wave = tid >> 6, l15 = lane & 15, g = lane >> 4;
    f32x4 acc[MT][NT];
#pragma unroll
    for (int m = 0; m < MT; ++m)
#pragma unroll
        for (int n = 0; n < NT; ++n) acc[m][n] = (f32x4){0.f, 0.f, 0.f, 0.f};
    const bf16_t* ap[MT]; const bf16_t* bp[NT];
#pragma unroll
    for (int m = 0; m < MT; ++m) { const int r = row0 + m * 16 + l15; ap[m] = A + (size_t)(r < row_clamp ? r : row_clamp) * lda + wave * 128 + g * 8; }
#pragma unroll
    for (int n = 0; n < NT; ++n) bp[n] = Bt + (size_t)(brow0 + n * 16 + l15) * ldb + wave * 128 + g * 8;
#pragma unroll
    for (int kh = 0; kh < 2; ++kh) {
        bf16x8 af[2][MT], bq[2][NT];
#pragma unroll
        for (int ks = 0; ks < 2; ++ks) {
#pragma unroll
            for (int m = 0; m < MT; ++m) af[ks][m] = *(const bf16x8*)(ap[m] + (kh * 2 + ks) * 32);
#pragma unroll
            for (int n = 0; n < NT; ++n) bq[ks][n] = *(const bf16x8*)(bp[n] + (kh * 2 + ks) * 32);
        }
#pragma unroll
        for (int ks = 0; ks < 2; ++ks)
#pragma unroll
            for (int m = 0; m < MT; ++m)
#pragma unroll
                for (int n = 0; n < NT; ++n) acc[m][n] = __builtin_amdgcn_mfma_f32_16x16x32_bf16(af[ks][m], bq[ks][n], acc[m][n], 0, 0, 0);
    }
    __syncthreads();
#pragma unroll
    for (int m = 0; m < MT; ++m)
#pragma unroll
        for (int n = 0; n < NT; ++n) st4(sm + ((wave * MT + m) * NT + n) * 256 + lane * 4, make_float4(acc[m][n][0], acc[m][n][1], acc[m][n][2], acc[m][n][3]));
    __syncthreads();
    for (int e = tid; e < MT * NT * 256; e += NTHR) {
        const int tile = e >> 8, idx = e & 255, ln = idx >> 2, r = idx & 3;
        float s = 0.f;
#pragma unroll
        for (int w = 0; w < NWV; ++w) s += sm[(w * MT * NT + tile) * 256 + idx];
        const int i = (tile / NT) * 16 + (ln >> 4) * 4 + r, j = (tile % NT) * 16 + (ln & 15);
        if (i < nvalid) C[(size_t)(row0 + i) * ldc + ccol0 + j] = __builtin_bit_cast(unsigned short, (__bf16)s);
    }
}

struct Mod8 { float4 s0, s1, c0, c1; };
DEV Mod8 mod8_load(const float* m, int k) { Mod8 q; q.s0 = ld4(m + k); q.s1 = ld4(m + k + 4); q.c0 = ld4(m + 1024 + k); q.c1 = ld4(m + 1024 + k + 4); return q; }
DEV uint4 mod8_apply(const float4 x0, const float4 x1, const Mod8& q) {
    return make_uint4(pack2bf(x0.x * (1.f + q.c0.x) + q.s0.x, x0.y * (1.f + q.c0.y) + q.s0.y), pack2bf(x0.z * (1.f + q.c0.z) + q.s0.z, x0.w * (1.f + q.c0.w) + q.s0.w),
                      pack2bf(x1.x * (1.f + q.c1.x) + q.s1.x, x1.y * (1.f + q.c1.y) + q.s1.y), pack2bf(x1.z * (1.f + q.c1.z) + q.s1.z, x1.w * (1.f + q.c1.w) + q.s1.w));
}
DEV void phase_h0(const Params& p, int b) {
    const float* modv = (const float*)(p.ws + OFF_MODV);
    bf16_t* H0 = (bf16_t*)(p.ws + OFF_YC);
    const int gt = blockIdx.x * NTHR + opaque_tid(), gn = gridDim.x * NTHR;
    const int k = (gt & 127) * 8;
    const Mod8 mc = mod8_load(modv + 2 * 3072, k), ml = mod8_load(modv + b * 3072, k);
    for (int i0 = gt; i0 < TB * 128; i0 += 4 * gn) {
        float4 xa[4], xb[4];
#pragma unroll
        for (int u = 0; u < 4; ++u) {
            const int i = i0 + u * gn, s = (i < TB * 128 ? i : gt) >> 7;
            const float* src = (s < NCX) ? p.in[2] + ((size_t)(b * NCX + s)) * DM + k : p.in[0] + ((size_t)(b * NL + s - NCX)) * DM + k;
            xa[u] = ld4(src); xb[u] = ld4(src + 4);
        }
#pragma unroll
        for (int u = 0; u < 4; ++u) {
            const int i = i0 + u * gn, s = i >> 7;
            if (i < TB * 128) *(uint4*)(H0 + (size_t)s * DM + k) = mod8_apply(xa[u], xb[u], (s < NCX) ? mc : ml);
        }
    }
}

DEV void phase_mod(const Params& p, float* sm) {
    const float* c = p.in[1]; const float* cctx = p.in[3];
    const float* mod_w = p.in[4]; const float* mod_b = p.in[5];
    float* modv = (float*)(p.ws + OFF_MODV);
    float* sil = sm; float* red = sm + 3072;
    const int tid = opaque_tid();
    for (int i = tid; i < 3072; i += NTHR) {
        const int j = i >> 10, k = i & 1023;
        const float v = (j < 2) ? c[j * 1024 + k] : cctx[k];
        sil[i] = silu_f(v);
    }
    __syncthreads();
    for (int unit = blockIdx.x; unit < 192; unit += gridDim.x) {
        const int l = unit / 96, cb = unit % 96;
        const int kg = tid >> 5, col = tid & 31, n = cb * 32 + col;
        const float* w = mod_w + (size_t)l * 1024 * 3072 + n;
        float a0 = 0.f, a1 = 0.f, a2 = 0.f;
        for (int k = kg * 64; k < kg * 64 + 64; ++k) {
            const float wv = w[(size_t)k * 3072];
            a0 += sil[k] * wv; a1 += sil[1024 + k] * wv; a2 += sil[2048 + k] * wv;
        }
        red[(kg * 3 + 0) * 32 + col] = a0; red[(kg * 3 + 1) * 32 + col] = a1; red[(kg * 3 + 2) * 32 + col] = a2;
        __syncthreads();
        if (tid < 96) {
            const int j = tid >> 5, cc = tid & 31, nn = cb * 32 + cc;
            float s = mod_b[l * 3072 + nn];
            for (int g = 0; g < 16; ++g) s += red[(g * 3 + j) * 32 + cc];
            modv[(l * 3 + j) * 3072 + nn] = s;
        }
        __syncthreads();
    }
}

DEV void phase_tables(const Params& p) {
    const float* wq = p.in[33]; const float* wk = p.in[34]; const float* wv = p.in[35];
    const float* gw0 = p.in[36]; const float* gw1 = p.in[38]; const float* gw2 = p.in[40]; const float* gw3 = p.in[42];
    float* gtab = (float*)(p.ws + OFF_GTAB); bf16_t* wft = (bf16_t*)(p.ws + OFF_WFT);
    const int gt = blockIdx.x * NTHR + opaque_tid(), gn = gridDim.x * NTHR;
    for (int i = gt; i < 512 * 16; i += gn) {
        const int gb = i >> 4, cp = (i >> 2) & 3, c = i & 3;
        float s = 0.f;
#pragma unroll
        for (int d = 0; d < 4; ++d) s += wq[gb * 16 + cp * 4 + d] * wk[gb * 16 + c * 4 + d];
        gtab[i] = s * KSCALE;
    }
    for (int i = gt; i < 4096 * 16; i += gn) {
        const int g = i >> 12, k = i & 4095, gm = g >> 2, hd = g & 3;
        const float* wg = gm == 0 ? gw0 : (gm == 1 ? gw1 : (gm == 2 ? gw2 : gw3));
        float s = 0.f;
        if (k < 2048) {
            const int blk = k >> 2, cc = k & 3;
#pragma unroll
            for (int d = 0; d < 4; ++d) s += wq[blk * 16 + cc * 4 + d] * wg[(size_t)(4 * blk + d) * 4 + hd] + wk[blk * 16 + cc * 4 + d] * wg[(size_t)(2048 + 4 * blk + d) * 4 + hd];
        } else {
            const int kk = k - 2048, blk = kk >> 2, cc = kk & 3;
#pragma unroll
            for (int d = 0; d < 4; ++d) s += wv[blk * 16 + cc * 4 + d] * wg[(size_t)(4096 + 4 * blk + d) * 4 + hd];
        }
        wft[i] = __builtin_bit_cast(unsigned short, (__bf16)s);
    }
}

DEV float dpp_add(float v, float acc_src, int) { return v + acc_src; }
#define DPP_F(src_, ctrl_, rmask_) __int_as_float(__builtin_amdgcn_update_dpp(0, __float_as_int(src_), (ctrl_), (rmask_), 0xf, false))
DEV float wave_scan_add(float v, int lane, int dir) {
    float p = v;
    p += DPP_F(p, 0x111, 0xf);
    p += DPP_F(p, 0x112, 0xf);
    p += DPP_F(p, 0x114, 0xf);
    p += DPP_F(p, 0x118, 0xf);
    p += DPP_F(p, 0x142, 0xa);
    p += DPP_F(p, 0x143, 0xc);
    if (dir) { const float tot = __int_as_float(__builtin_amdgcn_readlane(__float_as_int(p), 63)); p = tot - p + v; }
    return p;
}
DEV float wave_scan_max(float v, int lane, int dir) {
#pragma unroll
    for (int o = 1; o < 64; o <<= 1) {
        const float n = dir ? __shfl_down(v, o, 64) : __shfl_up(v, o, 64);
        const bool ok = dir ? (lane + o < 64) : (lane >= o);
        if (ok) v = fmaxf(v, n);
    }
    return v;
}

constexpr int GLC_OFF = 30336;
static_assert((GLC_OFF + 2176) * 4 <= LDS_BYTES - 16, "GLA constants must fit below the barrier words");
DEV void gla_consts(const Params& p, int h, float* sm) {
    const int tid = opaque_tid();
    float* sWA2 = sm + GLC_OFF; float* sBA2 = sWA2 + 2048;
    __syncthreads();
    for (int i = tid; i < 2048; i += NTHR) { const int d = i >> 10, ii = (i >> 6) & 15, k = i & 63; sWA2[i] = p.in[d ? 12 : 10][ii * 256 + h * 64 + k]; }
    if (tid < 128) sBA2[tid] = p.in[(tid >> 6) ? 13 : 11][h * 64 + (tid & 63)];
}
DEV void gla_decay_core(const float* sLRd, const float* sWAd, const float* sBAd, float* sBC, float* sTot, int dir, int tid) {
    {
        const int t = tid >> 3, k0 = (tid & 7) * 8;
        float acc[8];
#pragma unroll
        for (int j = 0; j < 8; ++j) acc[j] = sBAd[k0 + j];
#pragma unroll
        for (int ii = 0; ii < 16; ++ii) {
            const float l = sLRd[t * 16 + ii];
#pragma unroll
            for (int j = 0; j < 8; ++j) acc[j] += l * sWAd[ii * 64 + k0 + j];
        }
#pragma unroll
        for (int j = 0; j < 8; ++j) sBC[t * 65 + k0 + j] = logsig_f(acc[j]) * 0.0625f;
    }
    __syncthreads();
    {
        const int lane = tid & 63, wv = tid >> 6;
#pragma unroll
        for (int j = 0; j < 8; ++j) {
            const int k = wv * 8 + j;
            const float v = wave_scan_add(sBC[lane * 65 + k], lane, dir);
            sBC[lane * 65 + k] = v;
            if (lane == (dir ? 0 : 63)) sTot[k] = v;
        }
    }
    __syncthreads();
}

DEV bf16x8 tr_frag(const bf16_t* base, int ld, int row0, int col0, int lane) {
    const bf16_t* ptr = base + (row0 + (lane >> 4) * 8 + ((lane & 15) >> 2)) * ld + col0 + (lane & 3) * 4;
    const s16x4 lo = __builtin_amdgcn_ds_read_tr16_b64_v4i16((__attribute__((address_space(3))) s16x4*)ptr);
    const s16x4 hi = __builtin_amdgcn_ds_read_tr16_b64_v4i16((__attribute__((address_space(3))) s16x4*)(ptr + 4 * ld));
    return (bf16x8){lo[0], lo[1], lo[2], lo[3], hi[0], hi[1], hi[2], hi[3]};
}
DEV bf16x8 row_frag(const bf16_t* base, int ld, int idx0, int k0, int lane) {
    return *(const bf16x8*)(base + (idx0 + (lane & 15)) * ld + k0 + (lane >> 4) * 8);
}

DEV void gla1_unit(const Params& p, int h, int dir, int c, float* sm) {
    const int tid = opaque_tid(), lane = tid & 63, wave = tid >> 6;
    const bf16_t* P0 = (const bf16_t*)(p.ws + OFF_P0);
    float* GDS = (float*)(p.ws + OFF_GDS); float* GDEC = (float*)(p.ws + OFF_GDEC);
    float* sLR = sm; float* sBC = sm + 2048; float* sTot = sm + 6208;
    bf16_t* kT = (bf16_t*)(sm + 6272);
    bf16_t* Vs = (bf16_t*)(sm + 8576);
    const int ch = h * 2 + dir;
    const int t = tid >> 3, k0 = (tid & 7) * 8;
    const uint4 lrq = *(const uint4*)(P0 + (size_t)(c * 64 + ((tid & 127) >> 1)) * EIN + 1536 + dir * 16 + (tid & 1) * 8);
    const uint4 kq = *(const uint4*)(P0 + (size_t)(c * 64 + t) * EIN + 256 + h * 64 + k0);
    const uint4 vq0 = *(const uint4*)(P0 + (size_t)(c * 64 + (tid >> 4)) * EIN + 512 + h * 128 + (tid & 15) * 8);
    const uint4 vq1 = *(const uint4*)(P0 + (size_t)(c * 64 + 32 + (tid >> 4)) * EIN + 512 + h * 128 + (tid & 15) * 8);
    __syncthreads();
    if (tid < 128) { float* d = sLR + (tid >> 1) * 16 + (tid & 1) * 8; st4(d, make_float4(bflo(lrq.x), bfhi(lrq.x), bflo(lrq.y), bfhi(lrq.y))); st4(d + 4, make_float4(bflo(lrq.z), bfhi(lrq.z), bflo(lrq.w), bfhi(lrq.w))); }
    *(uint4*)(Vs + (tid >> 4) * 136 + (tid & 15) * 8) = vq0; *(uint4*)(Vs + (32 + (tid >> 4)) * 136 + (tid & 15) * 8) = vq1;
    __syncthreads();
    gla_decay_core(sLR, sm + GLC_OFF + dir * 1024, sm + GLC_OFF + 2048 + dir * 64, sBC, sTot, dir, tid);
    {
        float kv[8]; unpack8(kq, kv);
#pragma unroll
        for (int j = 0; j < 8; ++j) kT[(k0 + j) * 72 + t] = __builtin_bit_cast(unsigned short, (__bf16)(kv[j] * fexp(sTot[k0 + j] - sBC[t * 65 + k0 + j])));
    }
    __syncthreads();
    {
        f32x4 acc[4];
#pragma unroll
        for (int kt = 0; kt < 4; ++kt) acc[kt] = (f32x4){0.f, 0.f, 0.f, 0.f};
#pragma unroll
        for (int ks = 0; ks < 2; ++ks) {
            const bf16x8 af = tr_frag(Vs, 136, ks * 32, wave * 16, lane);
#pragma unroll
            for (int kt = 0; kt < 4; ++kt) acc[kt] = __builtin_amdgcn_mfma_f32_16x16x32_bf16(af, row_frag(kT, 72, kt * 16, ks * 32, lane), acc[kt], 0, 0, 0);
        }
#pragma unroll
        for (int kt = 0; kt < 4; ++kt) {
            const int k = kt * 16 + (lane & 15), v = wave * 16 + (lane >> 4) * 4;
            st4(GDS + ((size_t)(ch * NCH + c) * 64 + k) * 128 + v, make_float4(acc[kt][0], acc[kt][1], acc[kt][2], acc[kt][3]));
        }
    }
    if (tid < 64) GDEC[(size_t)(ch * NCH + c) * 64 + tid] = fexp(sTot[tid]);
}

DEV void gla2_unit(const Params& p, int unit) {
    const int tid = opaque_tid();
    float* GDS = (float*)(p.ws + OFF_GDS); const float* GDEC = (const float*)(p.ws + OFF_GDEC);
    const int ch = unit >> 4, e = (unit & 15) * 512 + tid, k = e >> 7, dir = ch & 1;
    constexpr int GB = 12;
    float S = 0.f, ninc[GB], nd[GB];
#pragma unroll
    for (int j = 0; j < GB; ++j) { const int c = chunk_at(dir, j); ninc[j] = GDS[(size_t)(ch * NCH + c) * 8192 + e]; nd[j] = GDEC[(size_t)(ch * NCH + c) * 64 + k]; }
#pragma unroll 1
    for (int step0 = 0; step0 < NCH; step0 += GB) {
        float inc[GB], d[GB];
#pragma unroll
        for (int j = 0; j < GB; ++j) { inc[j] = ninc[j]; d[j] = nd[j]; }
#pragma unroll
        for (int j = 0; j < GB; ++j) { const int sn = step0 + GB + j, c = chunk_at(dir, sn < NCH ? sn : NCH - 1); ninc[j] = GDS[(size_t)(ch * NCH + c) * 8192 + e]; nd[j] = GDEC[(size_t)(ch * NCH + c) * 64 + k]; }
        __builtin_amdgcn_sched_barrier(0);
#pragma unroll
        for (int j = 0; j < GB; ++j) { const int c = chunk_at(dir, step0 + j); GDS[(size_t)(ch * NCH + c) * 8192 + e] = S; S = d[j] * S + inc[j]; }
    }
}

DEV void gla3_unit(const Params& p, int h, int c, float* sm) {
    const int tid = opaque_tid(), lane = tid & 63, wave = tid >> 6;
    const bf16_t* P0 = (const bf16_t*)(p.ws + OFF_P0);
    const float* GDS = (const float*)(p.ws + OFF_GDS);
    bf16_t* YC = (bf16_t*)(p.ws + OFF_YC);
    const float* ng = p.in[14];
    float* sLR2 = sm;
    float* sBC = sm + 2048; float* sTot = sm + 6208;
    bf16_t* qt = (bf16_t*)(sm + 6272);
    bf16_t* kt = (bf16_t*)(sm + 8576);
    bf16_t* Sm = (bf16_t*)(sm + 10880);
    bf16_t* S0s = (bf16_t*)(sm + 13184);
    bf16_t* Vs = (bf16_t*)(sm + 17536);
    float* O = sm + 21888;
    const int ti = wave & 3, vt0 = (wave >> 2) * 4;
    const int t = tid >> 3, k0 = (tid & 7) * 8;
    f32x4 acc[4];
#pragma unroll
    for (int j = 0; j < 4; ++j) acc[j] = (f32x4){0.f, 0.f, 0.f, 0.f};
    const uint4 vq0 = *(const uint4*)(P0 + (size_t)(c * 64 + (tid >> 4)) * EIN + 512 + h * 128 + (tid & 15) * 8);
    const uint4 vq1 = *(const uint4*)(P0 + (size_t)(c * 64 + 32 + (tid >> 4)) * EIN + 512 + h * 128 + (tid & 15) * 8);
    const uint4 lrq = *(const uint4*)(P0 + (size_t)(c * 64 + ((tid & 255) >> 2)) * EIN + 1536 + (tid & 3) * 8);
    const uint4 qq = *(const uint4*)(P0 + (size_t)(c * 64 + t) * EIN + h * 64 + k0);
    const uint4 kq = *(const uint4*)(P0 + (size_t)(c * 64 + t) * EIN + 256 + h * 64 + k0);
    float4 s0a[4], s0b[4];
#pragma unroll
    for (int u = 0; u < 4; ++u) { const int i = tid + 512 * u, k = i >> 5, v4 = (i & 31) * 4;
        s0a[u] = ld4(GDS + (size_t)((h * 2 + 0) * NCH + c) * 8192 + k * 128 + v4); s0b[u] = ld4(GDS + (size_t)((h * 2 + 1) * NCH + c) * 8192 + k * 128 + v4); }
    const bf16_t* gp = P0 + (size_t)(c * 64 + t) * EIN + 1024 + h * 128 + (tid & 7) * 16;
    const uint4 gq0 = *(const uint4*)gp, gq1 = *(const uint4*)(gp + 8);
    __syncthreads();
    *(uint4*)(Vs + (tid >> 4) * 136 + (tid & 15) * 8) = vq0; *(uint4*)(Vs + (32 + (tid >> 4)) * 136 + (tid & 15) * 8) = vq1;
    if (tid < 256) { float* d = sLR2 + ((tid & 3) >> 1) * 1024 + (tid >> 2) * 16 + (tid & 1) * 8; st4(d, make_float4(bflo(lrq.x), bfhi(lrq.x), bflo(lrq.y), bfhi(lrq.y))); st4(d + 4, make_float4(bflo(lrq.z), bfhi(lrq.z), bflo(lrq.w), bfhi(lrq.w))); }
    __syncthreads();
#pragma unroll
    for (int dir = 0; dir < 2; ++dir) {
        gla_decay_core(sLR2 + dir * 1024, sm + GLC_OFF + dir * 1024, sm + GLC_OFF + 2048 + dir * 64, sBC, sTot, dir, tid);
        {
            float qv[8], kv[8];
            unpack8(qq, qv); unpack8(kq, kv);
#pragma unroll
            for (int j = 0; j < 8; ++j) { const float bc = sBC[t * 65 + k0 + j]; qv[j] *= 0.125f * fexp(bc); kv[j] *= fexp(-bc); }
            *(uint4*)(qt + t * 72 + k0) = make_uint4(pack2bf(qv[0], qv[1]), pack2bf(qv[2], qv[3]), pack2bf(qv[4], qv[5]), pack2bf(qv[6], qv[7]));
            *(uint4*)(kt + t * 72 + k0) = make_uint4(pack2bf(kv[0], kv[1]), pack2bf(kv[2], kv[3]), pack2bf(kv[4], kv[5]), pack2bf(kv[6], kv[7]));
#pragma unroll
            for (int u = 0; u < 4; ++u) {
                const int i = tid + 512 * u, k = i >> 5, v4 = (i & 31) * 4;
                const float4 s4 = dir ? s0b[u] : s0a[u];
                *(uint2*)(S0s + k * 136 + v4) = make_uint2(pack2bf(s4.x, s4.y), pack2bf(s4.z, s4.w));
            }
        }
        __syncthreads();
        {
            const int si = wave & 3;
#pragma unroll
            for (int jj = 0; jj < 2; ++jj) {
                const int t2 = (wave >> 2) * 2 + jj;
                f32x4 a = (f32x4){0.f, 0.f, 0.f, 0.f};
#pragma unroll
                for (int ks = 0; ks < 2; ++ks) a = __builtin_amdgcn_mfma_f32_16x16x32_bf16(row_frag(kt, 72, si * 16, ks * 32, lane), row_frag(qt, 72, t2 * 16, ks * 32, lane), a, 0, 0, 0);
                const int tq = t2 * 16 + (lane & 15), s0 = si * 16 + (lane >> 4) * 4;
                float m[4];
#pragma unroll
                for (int r = 0; r < 4; ++r) { const bool keep = dir ? (s0 + r >= tq) : (s0 + r <= tq); m[r] = keep ? a[r] : 0.f; }
                *(uint2*)(Sm + tq * 72 + s0) = make_uint2(pack2bf(m[0], m[1]), pack2bf(m[2], m[3]));
            }
        }
        __syncthreads();
#pragma unroll
        for (int ks = 0; ks < 2; ++ks) {
            const bf16x8 a1 = row_frag(qt, 72, ti * 16, ks * 32, lane), a2 = row_frag(Sm, 72, ti * 16, ks * 32, lane);
#pragma unroll
            for (int j = 0; j < 4; ++j) {
                acc[j] = __builtin_amdgcn_mfma_f32_16x16x32_bf16(a1, tr_frag(S0s, 136, ks * 32, (vt0 + j) * 16, lane), acc[j], 0, 0, 0);
                acc[j] = __builtin_amdgcn_mfma_f32_16x16x32_bf16(a2, tr_frag(Vs, 136, ks * 32, (vt0 + j) * 16, lane), acc[j], 0, 0, 0);
            }
        }
        if (dir == 0) __syncthreads();
    }
#pragma unroll
    for (int j = 0; j < 4; ++j)
#pragma unroll
        for (int r = 0; r < 4; ++r) O[(ti * 16 + (lane >> 4) * 4 + r) * 132 + (vt0 + j) * 16 + (lane & 15)] = acc[j][r];
    __syncthreads();
    {
        const int v0 = (tid & 7) * 16;
        float o[16];
        float ss = 0.f;
#pragma unroll
        for (int i = 0; i < 16; ++i) { o[i] = O[t * 132 + v0 + i]; ss += o[i] * o[i]; }
        ss = red8_sum(ss);
        const float rms = rsqrtf(ss * (1.f / 128.f) + 1e-5f);
        float g[16];
        unpack8(gq0, g); unpack8(gq1, g + 8);
        float y[16];
#pragma unroll
        for (int i = 0; i < 16; ++i) y[i] = o[i] * rms * ng[v0 + i] * silu_f(g[i]);
        bf16_t* yp = YC + (size_t)(c * 64 + t) * 1024 + h * 128 + v0;
        *(uint4*)yp = make_uint4(pack2bf(y[0], y[1]), pack2bf(y[2], y[3]), pack2bf(y[4], y[5]), pack2bf(y[6], y[7]));
        *(uint4*)(yp + 8) = make_uint4(pack2bf(y[8], y[9]), pack2bf(y[10], y[11]), pack2bf(y[12], y[13]), pack2bf(y[14], y[15]));
    }
}

DEV void load8bf(const bf16_t* ptr, float* f) { unpack8(*(const uint4*)ptr, f); }
struct RwNb { int sL, sR, sU, sD; bool vL, vR, vU, vD; };
DEV RwNb rw_nb(int s) {
    RwNb q; q.vU = false; q.vD = false;
    if (s < NCX) { q.vL = s > 0; q.vR = s < NCX - 1; }
    else { const int n = s - NCX, rr = n >> 6, cc = n & 63; q.vL = cc > 0; q.vR = cc < 63; q.vU = rr > 0; q.vD = rr < 127; }
    q.sL = q.vL ? s - 1 : s; q.sR = q.vR ? s + 1 : s; q.sU = q.vU ? s - 64 : s; q.sD = q.vD ? s + 64 : s;
    return q;
}
struct RwRaw { uint4 o, l, r, u, d; };
DEV RwRaw rw_load(const bf16_t* P0, int s, const RwNb& q, int cb) {
    RwRaw w;
    w.o = *(const uint4*)(P0 + (size_t)s * EIN + RW0 + cb); w.l = *(const uint4*)(P0 + (size_t)q.sL * EIN + RW0 + cb); w.r = *(const uint4*)(P0 + (size_t)q.sR * EIN + RW0 + cb);
    w.u = *(const uint4*)(P0 + (size_t)q.sU * EIN + RW0 + cb); w.d = *(const uint4*)(P0 + (size_t)q.sD * EIN + RW0 + cb);
    return w;
}
DEV void rw_comb_l(const RwRaw& w, const RwNb& q, const float* ml, float* out) {
    float own[8]; unpack8(w.o, own);
    const float nb[8] = {q.vL ? bflo(w.l.x) : 0.f, q.vR ? bfhi(w.r.x) : 0.f, q.vU ? bflo(w.u.y) : 0.f, q.vD ? bfhi(w.d.y) : 0.f,
                         q.vL ? bflo(w.l.z) : 0.f, q.vR ? bfhi(w.r.z) : 0.f, q.vU ? bflo(w.u.w) : 0.f, q.vD ? bfhi(w.d.w) : 0.f};
    const float4 m0 = *(const float4*)ml, m1 = *(const float4*)(ml + 4);
    const float m[8] = {m0.x, m0.y, m0.z, m0.w, m1.x, m1.y, m1.z, m1.w};
#pragma unroll
    for (int i = 0; i < 8; ++i) out[i] = own[i] + (nb[i] - own[i]) * m[i];
}
DEV void rw_comb(const RwRaw& w, const RwNb& q, const float* __restrict__ mu, int cb, float* out) {
    float own[8]; unpack8(w.o, own);
    const float nb[8] = {q.vL ? bflo(w.l.x) : 0.f, q.vR ? bfhi(w.r.x) : 0.f, q.vU ? bflo(w.u.y) : 0.f, q.vD ? bfhi(w.d.y) : 0.f,
                         q.vL ? bflo(w.l.z) : 0.f, q.vR ? bfhi(w.r.z) : 0.f, q.vU ? bflo(w.u.w) : 0.f, q.vD ? bfhi(w.d.w) : 0.f};
    const float4 m0 = ld4(mu + cb), m1 = ld4(mu + cb + 4);
    const float m[8] = {m0.x, m0.y, m0.z, m0.w, m1.x, m1.y, m1.z, m1.w};
#pragma unroll
    for (int i = 0; i < 8; ++i) out[i] = own[i] + (nb[i] - own[i]) * m[i];
}
DEV uint4 pack8(const float* f) { return make_uint4(pack2bf(f[0], f[1]), pack2bf(f[2], f[3]), pack2bf(f[4], f[5]), pack2bf(f[6], f[7])); }

template <int XM, int YM, class F>
DEV void mm64(const bf16_t* X, const bf16_t* Y, F f, int lane, int wave) {
#pragma unroll
    for (int q = 0; q < 2; ++q) {
        const int idx = wave * 2 + q, ti = idx >> 2, tj = idx & 3;
        f32x4 acc = (f32x4){0.f, 0.f, 0.f, 0.f};
#pragma unroll
        for (int ks = 0; ks < 2; ++ks) {
            const bf16x8 a = XM == 0 ? row_frag(X, 72, ti * 16, ks * 32, lane) : tr_frag(X, 72, ks * 32, ti * 16, lane);
            const bf16x8 bq = YM == 0 ? row_frag(Y, 72, tj * 16, ks * 32, lane) : tr_frag(Y, 72, ks * 32, tj * 16, lane);
            acc = __builtin_amdgcn_mfma_f32_16x16x32_bf16(a, bq, acc, 0, 0, 0);
        }
        f(ti * 16 + (lane >> 4) * 4, tj * 16 + (lane & 15), acc);
    }
}
template <int XM, int YM, class F>
DEV void mm64x2(const bf16_t* X1, const bf16_t* Y1, const bf16_t* X2, const bf16_t* Y2, F f, int lane, int wave) {
#pragma unroll
    for (int q = 0; q < 2; ++q) {
        const int idx = wave * 2 + q, ti = idx >> 2, tj = idx & 3;
        f32x4 acc = (f32x4){0.f, 0.f, 0.f, 0.f};
#pragma unroll
        for (int ks = 0; ks < 2; ++ks) {
            const bf16x8 a = XM == 0 ? row_frag(X1, 72, ti * 16, ks * 32, lane) : tr_frag(X1, 72, ks * 32, ti * 16, lane);
            const bf16x8 bq = YM == 0 ? row_frag(Y1, 72, tj * 16, ks * 32, lane) : tr_frag(Y1, 72, ks * 32, tj * 16, lane);
            acc = __builtin_amdgcn_mfma_f32_16x16x32_bf16(a, bq, acc, 0, 0, 0);
            const bf16x8 a2 = XM == 0 ? row_frag(X2, 72, ti * 16, ks * 32, lane) : tr_frag(X2, 72, ks * 32, ti * 16, lane);
            const bf16x8 b2 = YM == 0 ? row_frag(Y2, 72, tj * 16, ks * 32, lane) : tr_frag(Y2, 72, ks * 32, tj * 16, lane);
            acc = __builtin_amdgcn_mfma_f32_16x16x32_bf16(a2, b2, acc, 0, 0, 0);
        }
        f(ti * 16 + (lane >> 4) * 4, tj * 16 + (lane & 15), acc);
    }
}
DEV void st_img(bf16_t* P, int i0, int j, float a0, float a1, float a2, float a3) {
    P[(i0 + 0) * 72 + j] = __builtin_bit_cast(unsigned short, (__bf16)a0); P[(i0 + 1) * 72 + j] = __builtin_bit_cast(unsigned short, (__bf16)a1);
    P[(i0 + 2) * 72 + j] = __builtin_bit_cast(unsigned short, (__bf16)a2); P[(i0 + 3) * 72 + j] = __builtin_bit_cast(unsigned short, (__bf16)a3);
}

struct RwRaw3 { uint4 o, u, d; };
DEV RwRaw3 rw_load3(const bf16_t* P0, int s, const RwNb& q, int cb) {
    RwRaw3 w;
    w.o = *(const uint4*)(P0 + (size_t)s * EIN + RW0 + cb); w.u = *(const uint4*)(P0 + (size_t)q.sU * EIN + RW0 + cb); w.d = *(const uint4*)(P0 + (size_t)q.sD * EIN + RW0 + cb);
    return w;
}
DEV void rw_comb3(const RwRaw3& w, const RwNb& q, const bf16_t* tile, const bf16_t* P0, int s, int t, int cb, int j0, const float* ml, float* out) {
    asm volatile("" :: "v"(w.u.x), "v"(w.u.z), "v"(w.d.x), "v"(w.d.z));
    float own[8]; unpack8(w.o, own);
    float l0 = 0.f, l4 = 0.f, r1 = 0.f, r5 = 0.f;
    if (q.vL) { if (t > 0) { l0 = bf2f(tile[(t - 1) * 72 + j0]); l4 = bf2f(tile[(t - 1) * 72 + j0 + 4]); }
                else { const bf16_t* g = P0 + (size_t)(s - 1) * EIN + RW0 + cb; l0 = bf2f(g[0]); l4 = bf2f(g[4]); } }
    if (q.vR) { if (t < 63) { r1 = bf2f(tile[(t + 1) * 72 + j0 + 1]); r5 = bf2f(tile[(t + 1) * 72 + j0 + 5]); }
                else { const bf16_t* g = P0 + (size_t)(s + 1) * EIN + RW0 + cb; r1 = bf2f(g[1]); r5 = bf2f(g[5]); } }
    const float nb[8] = {l0, r1, q.vU ? bflo(w.u.y) : 0.f, q.vD ? bfhi(w.d.y) : 0.f, l4, r5, q.vU ? bflo(w.u.w) : 0.f, q.vD ? bfhi(w.d.w) : 0.f};
    const float4 m0 = *(const float4*)ml, m1 = *(const float4*)(ml + 4);
    const float m[8] = {m0.x, m0.y, m0.z, m0.w, m1.x, m1.y, m1.z, m1.w};
#pragma unroll
    for (int i = 0; i < 8; ++i) out[i] = own[i] + (nb[i] - own[i]) * m[i];
}
template <int XM, int YM, class F>
DEV void mm64t(const bf16_t* X, const bf16_t* Y, F f, int lane, int wave) {
#pragma unroll
    for (int q = 0; q < 2; ++q) {
        const int idx = wave * 2 + q, ti = idx >> 2, tj = idx & 3;
        f32x4 acc = (f32x4){0.f, 0.f, 0.f, 0.f};
#pragma unroll
        for (int ks = 0; ks < 2; ++ks) {
            const bf16x8 a = XM == 0 ? row_frag(X, 72, ti * 16, ks * 32, lane) : tr_frag(X, 72, ks * 32, ti * 16, lane);
            const bf16x8 bq = YM == 0 ? row_frag(Y, 72, tj * 16, ks * 32, lane) : tr_frag(Y, 72, ks * 32, tj * 16, lane);
            acc = __builtin_amdgcn_mfma_f32_16x16x32_bf16(bq, a, acc, 0, 0, 0);
        }
        f(ti * 16 + (lane & 15), tj * 16 + (lane >> 4) * 4, acc);
    }
}
DEV void st_row(bf16_t* P, int i, int j0, float a0, float a1, float a2, float a3) { *(uint2*)(P + i * 72 + j0) = make_uint2(pack2bf(a0, a1), pack2bf(a2, a3)); }
struct R1Raw { RwRaw3 r, k, v, w, a; float4 qw0, qw1, qa0, qa1; };
DEV void r1_consts(const Params& p, int h, int dir, float* sm) {
    const int tid = opaque_tid();
    float* sv = (float*)((bf16_t*)sm + 14 * 4608);
    __syncthreads();
    if (tid < 64) { const int hc = h * 64 + tid; sv[64 + tid] = p.in[dir ? 18 : 16][hc]; sv[128 + tid] = p.in[dir ? 22 : 20][hc]; sv[192 + tid] = p.in[24][hc]; sv[256 + tid] = p.in[25][hc]; sv[320 + tid] = p.in[26][hc]; }
    if (tid < 320) { const int tn = tid >> 6, col = tid & 63; const int cb = tn < 3 ? tn * 512 + h * 64 : (tn == 3 ? 2048 + dir * 64 : 2176 + dir * 64); sv[384 + tid] = p.in[15][cb + col]; }
}
DEV void r1_load(const Params& p, int h, int dir, int c, R1Raw& R) {
    const int tid = opaque_tid();
    const bf16_t* P0 = (const bf16_t*)(p.ws + OFF_P0);
    const float* ww2 = p.in[dir ? 19 : 17]; const float* wa2 = p.in[dir ? 23 : 21];
    const int t = tid >> 3, j0 = (tid & 7) * 8, s = c * 64 + t;
    const RwNb nbq = rw_nb(s);
    R.r = rw_load3(P0, s, nbq, h * 64 + j0); R.k = rw_load3(P0, s, nbq, 512 + h * 64 + j0); R.v = rw_load3(P0, s, nbq, 1024 + h * 64 + j0);
    R.w = rw_load3(P0, s, nbq, 2048 + dir * 64 + j0); R.a = rw_load3(P0, s, nbq, 2176 + dir * 64 + j0);
    R.qw0 = ld4(ww2 + (size_t)t * 512 + h * 64 + j0); R.qw1 = ld4(ww2 + (size_t)t * 512 + h * 64 + j0 + 4);
    R.qa0 = ld4(wa2 + (size_t)t * 512 + h * 64 + j0); R.qa1 = ld4(wa2 + (size_t)t * 512 + h * 64 + j0 + 4);
}
DEV void rwkv1_unit(const Params& p, int h, int dir, int c, float* sm, R1Raw& R, int cnext) {
    const int tid = opaque_tid(), lane = tid & 63, wave = tid >> 6;
    bf16_t* RU = (bf16_t*)(p.ws + OFF_RU) + (size_t)((h * 2 + dir) * NCH + c) * 16384;
    float* BONS = (float*)(p.ws + OFF_BONS);
    bf16_t* img = (bf16_t*)sm;
#define SLOT(i_) (img + (i_) * 4608)
    float* fLW = (float*)SLOT(10);
    float* fAS = (float*)SLOT(12);
    float* sv = (float*)SLOT(14);
    const int t = tid >> 3, j0 = (tid & 7) * 8, s = c * 64 + t;
    const bf16_t* P0 = (const bf16_t*)(p.ws + OFF_P0);
    __syncthreads();
    *(uint4*)(SLOT(0) + t * 72 + j0) = R.r.o; *(uint4*)(SLOT(1) + t * 72 + j0) = R.k.o; *(uint4*)(SLOT(2) + t * 72 + j0) = R.v.o;
    *(uint4*)(SLOT(3) + t * 72 + j0) = R.w.o; *(uint4*)(SLOT(4) + t * 72 + j0) = R.a.o;
    __syncthreads();
    float r8[8], k8[8], v8[8];
    {
        float x8[8];
        const RwNb nbq = rw_nb(s);
        rw_comb3(R.r, nbq, SLOT(0), P0, s, t, h * 64 + j0, j0, sv + 384 + j0, r8);
        rw_comb3(R.k, nbq, SLOT(1), P0, s, t, 512 + h * 64 + j0, j0, sv + 448 + j0, k8);
        rw_comb3(R.v, nbq, SLOT(2), P0, s, t, 1024 + h * 64 + j0, j0, sv + 512 + j0, v8);
        rw_comb3(R.w, nbq, SLOT(3), P0, s, t, 2048 + dir * 64 + j0, j0, sv + 576 + j0, x8);
#pragma unroll
        for (int i = 0; i < 8; ++i) x8[i] = tanh_f(x8[i]);
        *(uint4*)(SLOT(6) + t * 72 + j0) = pack8(x8);
        rw_comb3(R.a, nbq, SLOT(4), P0, s, t, 2176 + dir * 64 + j0, j0, sv + 640 + j0, x8);
        *(uint4*)(SLOT(7) + t * 72 + j0) = pack8(x8);
        { const float wq[8] = {R.qw0.x, R.qw0.y, R.qw0.z, R.qw0.w, R.qw1.x, R.qw1.y, R.qw1.z, R.qw1.w}; *(uint4*)(SLOT(8) + t * 72 + j0) = pack8(wq); }
        { const float wq[8] = {R.qa0.x, R.qa0.y, R.qa0.z, R.qa0.w, R.qa1.x, R.qa1.y, R.qa1.z, R.qa1.w}; *(uint4*)(SLOT(9) + t * 72 + j0) = pack8(wq); }
    }
    r1_load(p, h, dir, cnext >= 0 ? cnext : c, R);
    __syncthreads();
    mm64<0, 1>(SLOT(6), SLOT(8), [=](int i0, int j, f32x4 a) {
#pragma unroll
        for (int r = 0; r < 4; ++r) fLW[(i0 + r) * 65 + j] = -0.6065306597f * sigmoid_f(sv[64 + j] + a[r]); }, lane, wave);
    mm64<0, 1>(SLOT(7), SLOT(9), [=](int i0, int j, f32x4 a) {
#pragma unroll
        for (int r = 0; r < 4; ++r) fAS[(i0 + r) * 65 + j] = sigmoid_f(sv[128 + j] + a[r]); }, lane, wave);
    __syncthreads();
#pragma unroll
    for (int j = 0; j < 8; ++j) {
        const int k = wave * 8 + j;
        const float v = wave_scan_add(fLW[lane * 65 + k], lane, dir);
        fLW[lane * 65 + k] = v;
        if (lane == (dir ? 0 : 63)) sv[k] = v;
    }
    __syncthreads();
    {
        float kkv[8], ss = 0.f;
#pragma unroll
        for (int i = 0; i < 8; ++i) { kkv[i] = k8[i] * sv[192 + j0 + i]; ss += kkv[i] * kkv[i]; }
        ss = red8_sum(ss);
        const float rn = rsqrtf(fmaxf(ss, 1e-24f));
        float fa[8], fb[8], fk[8], fr[8], fbp[8], fkp[8], bon = 0.f;
        const int tp = dir ? t + 1 : t - 1;
        const bool hasp = dir ? (t < 63) : (t > 0);
#pragma unroll
        for (int i = 0; i < 8; ++i) {
            const int k = j0 + i;
            const float Bt = fLW[t * 65 + k], Bx = hasp ? fLW[tp * 65 + k] : 0.f, asg = fAS[t * 65 + k];
            const float kk = kkv[i] * rn, kh = k8[i] * (1.f + (asg - 1.f) * sv[256 + k]);
            bon += r8[i] * kh * sv[320 + k];
            const float enB = fexp(-Bt), eLB = fexp(sv[k] - Bt), bv = kk * asg;
            fa[i] = -kk * fexp(Bx); fb[i] = bv * enB; fk[i] = kh * enB; fr[i] = r8[i] * fexp(Bt); fbp[i] = bv * eLB; fkp[i] = kh * eLB;
        }
        bon = red8_sum(bon);
        if ((tid & 7) == 0) BONS[((size_t)dir * TB + s) * 8 + h] = bon;
        *(uint4*)(SLOT(0) + t * 72 + j0) = pack8(fa); *(uint4*)(SLOT(1) + t * 72 + j0) = pack8(fb); *(uint4*)(SLOT(2) + t * 72 + j0) = pack8(fk);
        *(uint4*)(SLOT(3) + t * 72 + j0) = pack8(fr); *(uint4*)(SLOT(4) + t * 72 + j0) = pack8(fbp); *(uint4*)(SLOT(5) + t * 72 + j0) = pack8(fkp);
    }
    __syncthreads();
    *(uint4*)(SLOT(6) + t * 72 + j0) = pack8(v8);
    __syncthreads();
    mm64t<0, 0>(SLOT(0), SLOT(1), [=](int i, int j0, f32x4 a) {
        float m[4];
#pragma unroll
        for (int r = 0; r < 4; ++r) { const bool keep = dir ? (j0 + r > i) : (j0 + r < i); m[r] = keep ? a[r] : 0.f; }
        const bool dg = (i >> 4) == (j0 >> 4);
        st_row(SLOT(7), i, j0, dg ? m[0] : 0.f, dg ? m[1] : 0.f, dg ? m[2] : 0.f, dg ? m[3] : 0.f);
        st_row(SLOT(8), i, j0, (dg ? m[0] : 0.f) + (j0 == i ? 1.f : 0.f), (dg ? m[1] : 0.f) + (j0 + 1 == i ? 1.f : 0.f), (dg ? m[2] : 0.f) + (j0 + 2 == i ? 1.f : 0.f), (dg ? m[3] : 0.f) + (j0 + 3 == i ? 1.f : 0.f));
        st_row(SLOT(12), i, j0, dg ? 0.f : m[0], dg ? 0.f : m[1], dg ? 0.f : m[2], dg ? 0.f : m[3]); }, lane, wave);
    mm64t<0, 0>(SLOT(0), SLOT(2), [=](int i, int j0, f32x4 a) {
        float m[4];
#pragma unroll
        for (int r = 0; r < 4; ++r) { const bool keep = dir ? (j0 + r > i) : (j0 + r < i); m[r] = keep ? a[r] : 0.f; }
        st_row(SLOT(9), i, j0, m[0], m[1], m[2], m[3]); }, lane, wave);
    mm64t<0, 0>(SLOT(3), SLOT(1), [=](int i, int j0, f32x4 a) {
        float m[4];
#pragma unroll
        for (int r = 0; r < 4; ++r) { const bool keep = dir ? (j0 + r >= i) : (j0 + r <= i); m[r] = keep ? a[r] : 0.f; }
        st_row(SLOT(10), i, j0, m[0], m[1], m[2], m[3]); }, lane, wave);
    mm64t<0, 0>(SLOT(3), SLOT(2), [=](int i, int j0, f32x4 a) {
        float m[4];
#pragma unroll
        for (int r = 0; r < 4; ++r) { const bool keep = dir ? (j0 + r >= i) : (j0 + r <= i); m[r] = keep ? a[r] : 0.f; }
        st_row(SLOT(11), i, j0, m[0], m[1], m[2], m[3]); }, lane, wave);
    __syncthreads();
#define R1_TADD(dst_, told_) [=](int i, int j0, f32x4 a) { const uint2 tt = *(const uint2*)((told_) + i * 72 + j0); \
        st_row((dst_), i, j0, a[0] + bflo(tt.x), a[1] + bfhi(tt.x), a[2] + bflo(tt.y), a[3] + bfhi(tt.y)); }
    mm64t<0, 1>(SLOT(7), SLOT(7), [=](int i, int j0, f32x4 a) { st_row(SLOT(1), i, j0, a[0], a[1], a[2], a[3]); }, lane, wave);
    mm64t<0, 1>(SLOT(9), SLOT(6), [=](int i, int j0, f32x4 a) { st_row(SLOT(13), i, j0, a[0], a[1], a[2], a[3]); }, lane, wave);
    __syncthreads();
    mm64t<0, 1>(SLOT(1), SLOT(1), [=](int i, int j0, f32x4 a) { st_row(SLOT(7), i, j0, a[0], a[1], a[2], a[3]); }, lane, wave);
    mm64t<0, 1>(SLOT(8), SLOT(1), R1_TADD(SLOT(2), SLOT(8)), lane, wave);
    __syncthreads();
    mm64t<0, 1>(SLOT(7), SLOT(7), [=](int i, int j0, f32x4 a) { st_row(SLOT(1), i, j0, a[0], a[1], a[2], a[3]); }, lane, wave);
    mm64t<0, 1>(SLOT(2), SLOT(7), R1_TADD(SLOT(8), SLOT(2)), lane, wave);
    __syncthreads();
    mm64t<0, 1>(SLOT(8), SLOT(1), R1_TADD(SLOT(2), SLOT(8)), lane, wave);
    __syncthreads();
#undef R1_TADD
    mm64t<0, 1>(SLOT(2), SLOT(12), [=](int i, int j0, f32x4 a) { st_row(SLOT(7), i, j0, a[0], a[1], a[2], a[3]); }, lane, wave);
    mm64t<0, 1>(SLOT(2), SLOT(0), [=](int i, int j0, f32x4 a) { st_row(SLOT(1), i, j0, a[0], a[1], a[2], a[3]); }, lane, wave);
    mm64t<0, 1>(SLOT(2), SLOT(13), [=](int i, int j0, f32x4 a) { st_row(SLOT(8), i, j0, a[0], a[1], a[2], a[3]); }, lane, wave);
    __syncthreads();
    {
        const bf16_t* Zp = (wave < 4) ? SLOT(1) : SLOT(8);
        bf16_t* Xi = (wave < 4) ? SLOT(12) : SLOT(9);
        const int ct = (wave & 3) * 16, g4 = (lane >> 4) * 4, l15 = lane & 15;
#pragma unroll
        for (int bs = 0; bs < 4; ++bs) {
            const int bi = dir ? 3 - bs : bs;
            const uint2 zz = *(const uint2*)(Zp + (bi * 16 + l15) * 72 + ct + g4);
            f32x4 acc = (f32x4){bflo(zz.x), bfhi(zz.x), bflo(zz.y), bfhi(zz.y)};
            const bool k0 = dir ? (bi == 0) : (bi >= 1), k1 = dir ? (bi <= 2) : (bi == 3);
            if (k0) acc = __builtin_amdgcn_mfma_f32_16x16x32_bf16(tr_frag(Xi, 72, 0, ct, lane), row_frag(SLOT(7), 72, bi * 16, 0, lane), acc, 0, 0, 0);
            if (k1) acc = __builtin_amdgcn_mfma_f32_16x16x32_bf16(tr_frag(Xi, 72, 32, ct, lane), row_frag(SLOT(7), 72, bi * 16, 32, lane), acc, 0, 0, 0);
            st_row(Xi, bi * 16 + l15, ct + g4, acc[0], acc[1], acc[2], acc[3]);
            __syncthreads();
        }
    }
    mm64<1, 1>(SLOT(12), SLOT(4), [=](int i0, int j, f32x4 a) {
        float m[4];
#pragma unroll
        for (int r = 0; r < 4; ++r) m[r] = a[r] + ((i0 + r) == j ? fexp(sv[j]) : 0.f);
        *(uint2*)(RU + j * 64 + i0) = make_uint2(pack2bf(m[0], m[1]), pack2bf(m[2], m[3])); }, lane, wave);
    mm64x2<1, 1>(SLOT(4), SLOT(9), SLOT(5), SLOT(6), [=](int i0, int j, f32x4 a) {
        *(uint2*)(RU + 4096 + j * 64 + i0) = make_uint2(pack2bf(a[0], a[1]), pack2bf(a[2], a[3])); }, lane, wave);
    mm64<1, 0>(SLOT(12), SLOT(10), [=](int i0, int j, f32x4 a) {
        const uint2 rr = *(const uint2*)(SLOT(3) + j * 72 + i0);
        *(uint2*)(RU + 8192 + j * 64 + i0) = make_uint2(pack2bf(a[0] + bflo(rr.x), a[1] + bfhi(rr.x)), pack2bf(a[2] + bflo(rr.y), a[3] + bfhi(rr.y))); }, lane, wave);
    mm64x2<0, 1>(SLOT(10), SLOT(9), SLOT(11), SLOT(6), [=](int i0, int j, f32x4 a) {
        *(uint2*)(RU + 12288 + j * 64 + i0) = make_uint2(pack2bf(a[0], a[1]), pack2bf(a[2], a[3])); }, lane, wave);
#undef SLOT
}

#define R2_LOAD(M_, C_, rnd_) do { const int r0_ = ((rnd_) < R2_NR ? (rnd_) : R2_NR - 1) * R2_RS; \
    _Pragma("unroll") for (int s_ = 0; s_ < R2_RS; ++s_) M_[s_] = *(const uint4*)(RU + (size_t)(chain * NCH + chunk_at(dir, r0_ + s_)) * 16384 + tid * 8); \
    _Pragma("unroll") for (int j_ = 0; j_ < 3; ++j_) { const int cq_ = tid + 512 * j_; \
        C_[j_] = *(const uint4*)(RU + (size_t)(chain * NCH + chunk_at(dir, r0_ + (cq_ >> 7))) * 16384 + 4096 + (vblk * 16 + ((cq_ >> 3) & 15)) * 64 + (cq_ & 7) * 8); } } while (0)
#define R2_ROUND(M_, C_, rnd_) do { \
    { const int row_ = tid >> 3, c8_ = tid & 7, sw_ = (row_ >> 1) & 7, u0_ = (c8_ >> 2) * 4 + (c8_ & 1) * 2, eh_ = ((c8_ >> 1) & 1) * 8; \
      _Pragma("unroll") for (int s_ = 0; s_ < R2_RS; ++s_) { char* sl_ = ring + s_ * 10240 + row_ * 128 + eh_; \
          *(uint2*)(sl_ + ((u0_ ^ sw_) * 16)) = make_uint2(M_[s_].x, M_[s_].y); *(uint2*)(sl_ + (((u0_ + 1) ^ sw_) * 16)) = make_uint2(M_[s_].z, M_[s_].w); } \
      _Pragma("unroll") for (int j_ = 0; j_ < 3; ++j_) { const int cq_ = tid + 512 * j_, rw_ = (cq_ >> 3) & 15, q8_ = cq_ & 7, i_ = q8_ >> 1, g0_ = (q8_ & 1) * 2, sc_ = (rw_ >> 1) & 7; \
          char* sl_ = ring + (cq_ >> 7) * 10240 + 8192 + rw_ * 128 + (i_ & 1) * 8; \
          *(uint2*)(sl_ + (((g0_ * 2 + (i_ >> 1)) ^ sc_) * 16)) = make_uint2(C_[j_].x, C_[j_].y); *(uint2*)(sl_ + ((((g0_ + 1) * 2 + (i_ >> 1)) ^ sc_) * 16)) = make_uint2(C_[j_].z, C_[j_].w); } } \
    R2_LOAD(M_, C_, (rnd_) + 2); \
    __syncthreads(); \
    if (wave == 0) { \
        _Pragma("unroll 4") for (int s_ = 0; s_ < R2_RS; ++s_) { \
            const int c_ = chunk_at(dir, (rnd_) * R2_RS + s_); const char* sl_ = ring + s_ * 10240; \
            unsigned pk_[4][2]; \
            _Pragma("unroll") for (int i_ = 0; i_ < 4; ++i_) { pk_[i_][0] = pack2bf(st[i_][0], st[i_][1]); pk_[i_][1] = pack2bf(st[i_][2], st[i_][3]); } \
            bf16_t* sp_ = S0G + ((size_t)(chain * NCH + c_) * 64 + vblk * 16 + l15) * 64 + g * 4; \
            _Pragma("unroll") for (int i_ = 0; i_ < 4; ++i_) *(uint2*)(sp_ + i_ * 16) = make_uint2(pk_[i_][0], pk_[i_][1]); \
            bf16x8 bfr_[2]; \
            _Pragma("unroll") for (int ks_ = 0; ks_ < 2; ++ks_) { const uint4 u_ = make_uint4(pk_[2 * ks_][0], pk_[2 * ks_][1], pk_[2 * ks_ + 1][0], pk_[2 * ks_ + 1][1]); bfr_[ks_] = __builtin_bit_cast(bf16x8, u_); } \
            const uint4 c01_ = *(const uint4*)(sl_ + 8192 + l15 * 128 + (((g * 2) ^ ((l15 >> 1) & 7)) * 16)), c23_ = *(const uint4*)(sl_ + 8192 + l15 * 128 + (((g * 2 + 1) ^ ((l15 >> 1) & 7)) * 16)); \
            const unsigned cw_[8] = {c01_.x, c01_.y, c01_.z, c01_.w, c23_.x, c23_.y, c23_.z, c23_.w}; \
            _Pragma("unroll") for (int i_ = 0; i_ < 4; ++i_) { \
                f32x4 acc_ = (f32x4){bflo(cw_[2 * i_]), bfhi(cw_[2 * i_]), bflo(cw_[2 * i_ + 1]), bfhi(cw_[2 * i_ + 1])}; \
                _Pragma("unroll") for (int ks_ = 0; ks_ < 2; ++ks_) { \
                    const int row_ = i_ * 16 + l15; \
                    const bf16x8 af_ = *(const bf16x8*)(sl_ + row_ * 128 + (((ks_ * 4 + g) ^ ((row_ >> 1) & 7)) * 16)); \
                    acc_ = __builtin_amdgcn_mfma_f32_16x16x32_bf16(af_, bfr_[ks_], acc_, 0, 0, 0); } \
                st[i_] = acc_; } } } \
    __syncthreads(); } while (0)
DEV void rwkv2_unit(const Params& p, int chain, int vblk, float* sm) {
    constexpr int R2_RS = 12, R2_NR = NCH / R2_RS;
    static_assert(R2_NR * R2_RS == NCH && R2_RS * 10240 <= LDS_BYTES, "R2 ring");
    const int tid = opaque_tid(), lane = tid & 63, wave = tid >> 6;
    const bf16_t* RU = (const bf16_t*)(p.ws + OFF_RU);
    bf16_t* S0G = (bf16_t*)(p.ws + OFF_RS0);
    char* ring = (char*)sm;
    const int dir = chain & 1, g = lane >> 4, l15 = lane & 15;
    f32x4 st[4];
#pragma unroll
    for (int i = 0; i < 4; ++i) st[i] = (f32x4){0.f, 0.f, 0.f, 0.f};
    uint4 ma[R2_RS], ca[3], mb[R2_RS], cb[3];
    __syncthreads();
    R2_LOAD(ma, ca, 0); R2_LOAD(mb, cb, 1);
#pragma unroll 1
    for (int rnd = 0; rnd < R2_NR; rnd += 2) {
        R2_ROUND(ma, ca, rnd);
        if (rnd + 1 < R2_NR) R2_ROUND(mb, cb, rnd + 1);
    }
}
#undef R2_LOAD
#undef R2_ROUND

DEV void rwkv3_unit(const Params& p, int h, int c, float* sm) {
    const int tid = opaque_tid(), lane = tid & 63, wave = tid >> 6;
    const bf16_t* P0 = (const bf16_t*)(p.ws + OFF_P0);
    const bf16_t* RUb = (const bf16_t*)(p.ws + OFF_RU);
    const bf16_t* S0G = (const bf16_t*)(p.ws + OFF_RS0);
    const float* BONS = (const float*)(p.ws + OFF_BONS);
    bf16_t* YC = (bf16_t*)(p.ws + OFF_YC);
    const float* mu = p.in[15]; const float* gn_g = p.in[27]; const float* gn_b = p.in[28];
    bf16_t* img = (bf16_t*)sm;
    float* O = sm + 4 * 2304;
    const int t = tid >> 3, v0 = (tid & 7) * 8, s = c * 64 + t;
    const size_t u0 = (size_t)((h * 2 + 0) * NCH + c), u1 = (size_t)((h * 2 + 1) * NCH + c);
    const uint4 gr0 = *(const uint4*)(RUb + u0 * 16384 + 8192 + t * 64 + v0), gs0 = *(const uint4*)(S0G + u0 * 4096 + t * 64 + v0);
    const uint4 gr1 = *(const uint4*)(RUb + u1 * 16384 + 8192 + t * 64 + v0), gs1 = *(const uint4*)(S0G + u1 * 4096 + t * 64 + v0);
    uint2 yl[2][2];
#pragma unroll
    for (int q = 0; q < 2; ++q) { const int idx = wave * 2 + q, ti = idx >> 2, tj = idx & 3;
        yl[q][0] = *(const uint2*)(RUb + u0 * 16384 + 12288 + (tj * 16 + (lane & 15)) * 64 + ti * 16 + (lane >> 4) * 4);
        yl[q][1] = *(const uint2*)(RUb + u1 * 16384 + 12288 + (tj * 16 + (lane & 15)) * 64 + ti * 16 + (lane >> 4) * 4); }
    const RwNb nbq = rw_nb(s);
    const RwRaw wv_ = rw_load(P0, s, nbq, 1024 + h * 64 + v0), wg_ = rw_load(P0, s, nbq, 1536 + h * 64 + v0);
    const float bon = BONS[(size_t)s * 8 + h] + BONS[((size_t)TB + s) * 8 + h];
    __syncthreads();
    *(uint4*)(img + 0 * 4608 + t * 72 + v0) = gr0; *(uint4*)(img + 2 * 4608 + t * 72 + v0) = gs0;
    *(uint4*)(img + 1 * 4608 + t * 72 + v0) = gr1; *(uint4*)(img + 3 * 4608 + t * 72 + v0) = gs1;
    __syncthreads();
#pragma unroll
    for (int q = 0; q < 2; ++q) {
        const int idx = wave * 2 + q, ti = idx >> 2, tj = idx & 3;
        f32x4 accd[2];
#pragma unroll
        for (int dir = 0; dir < 2; ++dir) {
            f32x4 acc = (f32x4){bflo(yl[q][dir].x), bfhi(yl[q][dir].x), bflo(yl[q][dir].y), bfhi(yl[q][dir].y)};
#pragma unroll
            for (int ks = 0; ks < 2; ++ks) acc = __builtin_amdgcn_mfma_f32_16x16x32_bf16(row_frag(img + dir * 4608, 72, ti * 16, ks * 32, lane), row_frag(img + (2 + dir) * 4608, 72, tj * 16, ks * 32, lane), acc, 0, 0, 0);
            accd[dir] = acc;
        }
#pragma unroll
        for (int r = 0; r < 4; ++r) {
            const int oi = (ti * 16 + (lane >> 4) * 4 + r) * 68 + tj * 16 + (lane & 15);
            O[oi] = accd[0][r] + accd[1][r];
        }
    }
    __syncthreads();
    {
        float y[8], sum = 0.f;
#pragma unroll
        for (int i = 0; i < 8; ++i) { y[i] = O[t * 68 + v0 + i]; sum += y[i]; }
        sum = red8_sum(sum);
        const float mean = sum * (1.f / 64.f);
        float sq = 0.f;
#pragma unroll
        for (int i = 0; i < 8; ++i) { y[i] -= mean; sq += y[i] * y[i]; }
        sq = red8_sum(sq);
        const float rstd = rsqrtf(sq * (1.f / 64.f) + 64e-5f);
        float vm[8], gm[8];
        rw_comb(wv_, nbq, mu, 1024 + h * 64 + v0, vm);
        rw_comb(wg_, nbq, mu, 1536 + h * 64 + v0, gm);
        float o[8];
#pragma unroll
        for (int i = 0; i < 8; ++i) o[i] = (y[i] * rstd * gn_g[h * 64 + v0 + i] + gn_b[h * 64 + v0 + i] + bon * vm[i]) * silu_f(gm[i]);
        *(uint4*)(YC + (size_t)s * 1024 + 512 + h * 64 + v0) = pack8(o);
    }
}

DEV void ln_rows(const float* src, const float* res_lat, const float* res_cx, int nrows, const float* __restrict__ g, const float* __restrict__ bt, float* dst_lat, float* dst_cx, int ncx,
                 bf16_t* hb = nullptr, const float* mvc = nullptr, const float* mvl = nullptr) {
    const int tid_ = opaque_tid(); const int lane = tid_ & 63, gw = blockIdx.x * NWV + (tid_ >> 6), ngw = gridDim.x * NWV;
    float4 gg[4], bb[4];
#pragma unroll
    for (int i = 0; i < 4; ++i) { gg[i] = ld4(g + i * 256 + lane * 4); bb[i] = ld4(bt + i * 256 + lane * 4); }
    float4 na[4], nr[4];
    { const int r = gw < nrows ? gw : 0; const float* x = src + (size_t)r * 1024; const float* xr = (r < ncx) ? (res_cx + (size_t)r * 1024) : (res_lat + (size_t)(r - ncx) * 1024);
#pragma unroll
      for (int i = 0; i < 4; ++i) { na[i] = ld4(x + i * 256 + lane * 4); nr[i] = ld4(xr + i * 256 + lane * 4); } }
    for (int r = gw; r < nrows; r += ngw) {
        float4 v[4];
        float sum = 0.f;
#pragma unroll
        for (int i = 0; i < 4; ++i) { const float4 a = na[i], rr = nr[i];
            v[i] = make_float4(ALPHA * rr.x + a.x, ALPHA * rr.y + a.y, ALPHA * rr.z + a.z, ALPHA * rr.w + a.w); sum += v[i].x + v[i].y + v[i].z + v[i].w; }
        { const int rn = (r + ngw < nrows) ? r + ngw : r; const float* x = src + (size_t)rn * 1024; const float* xr = (rn < ncx) ? (res_cx + (size_t)rn * 1024) : (res_lat + (size_t)(rn - ncx) * 1024);
#pragma unroll
          for (int i = 0; i < 4; ++i) { na[i] = ld4(x + i * 256 + lane * 4); nr[i] = ld4(xr + i * 256 + lane * 4); } }
        const float mean = wave_sum(sum) * (1.f / 1024.f);
        float sq = 0.f;
#pragma unroll
        for (int i = 0; i < 4; ++i) {
            v[i].x -= mean; v[i].y -= mean; v[i].z -= mean; v[i].w -= mean;
            sq += v[i].x * v[i].x + v[i].y * v[i].y + v[i].z * v[i].z + v[i].w * v[i].w;
        }
        const float rstd = rsqrtf(wave_sum(sq) * (1.f / 1024.f) + 1e-5f);
        float* d = (r < ncx) ? (dst_cx + (size_t)r * 1024) : (dst_lat + (size_t)(r - ncx) * 1024);
#pragma unroll
        for (int i = 0; i < 4; ++i) {
            const int c = i * 256 + lane * 4;
            const float4 y = make_float4(v[i].x * rstd * gg[i].x + bb[i].x, v[i].y * rstd * gg[i].y + bb[i].y, v[i].z * rstd * gg[i].z + bb[i].z, v[i].w * rstd * gg[i].w + bb[i].w);
            st4(d + c, y);
            if (hb != nullptr) {
                const float* m = (r < ncx) ? mvc : mvl;
                const float4 sh = ld4(m + c), sc = ld4(m + 1024 + c);
                *(uint2*)(hb + (size_t)r * 1024 + c) = make_uint2(pack2bf(y.x * (1.f + sc.x) + sh.x, y.y * (1.f + sc.y) + sh.y), pack2bf(y.z * (1.f + sc.z) + sh.z, y.w * (1.f + sc.w) + sh.w));
            }
        }
    }
}
DEV void phase_h1l(const Params& p) {
    const float* modv1 = (const float*)(p.ws + OFF_MODV) + 3 * 3072;
    bf16_t* H1 = (bf16_t*)(p.ws + OFF_H1B);
    const size_t gt = (size_t)blockIdx.x * NTHR + opaque_tid(), gn = (size_t)gridDim.x * NTHR;
    const int k = (int)(gt & 127) * 8;
    const Mod8 m0 = mod8_load(modv1, k), m1 = mod8_load(modv1 + 3072, k);
    constexpr size_t NI = (size_t)NB * NL * 128;
    for (size_t i0 = gt; i0 < NI; i0 += 4 * gn) {
        float4 xa[4], xb[4];
#pragma unroll
        for (int u = 0; u < 4; ++u) { const size_t i = i0 + u * gn, r = (i < NI ? i : gt) >> 7; xa[u] = ld4(p.out + r * DM + k); xb[u] = ld4(p.out + r * DM + k + 4); }
#pragma unroll
        for (int u = 0; u < 4; ++u) { const size_t i = i0 + u * gn, r = i >> 7; if (i < NI) *(uint4*)(H1 + r * DM + k) = mod8_apply(xa[u], xb[u], (r >= (size_t)NL) ? m1 : m0); }
    }
}

DEV void zero_f4(float* ptr, size_t nfloat) {
    const size_t n4 = nfloat / 4;
    for (size_t i = (size_t)blockIdx.x * NTHR + opaque_tid(); i < n4; i += (size_t)gridDim.x * NTHR) ((float4*)ptr)[i] = make_float4(0.f, 0.f, 0.f, 0.f);
}

DEV void chain_ids(int& chain, int& sub) {
    const int bid = blockIdx.x, xcd = bid & 7, idx = bid >> 3;
    chain = xcd * 2 + (idx >> 4); sub = idx & 15;
}

DEV void phase_conv1(const Params& p, float* sm) {
    const bf16_t* XM = (const bf16_t*)(p.ws + OFF_XM);
    bf16_t* XC = (bf16_t*)(p.ws + OFF_XC);
    float* G16P = (float*)(p.ws + OFF_G16P);
    const bf16_t* WFT = (const bf16_t*)(p.ws + OFF_WFT);
    const float* cw = p.in[31]; const float* cbias = p.in[32];
    bf16_t* imgC = (bf16_t*)sm;
    bf16_t* imgM = imgC + 64 * 264;
    float* red = (float*)(imgM + 64 * 264);
    float* cwl = red + 1024;
    const int tid = opaque_tid(), lane = tid & 63, wave = tid >> 6, t = tid >> 3, cg = tid & 7;
    for (int u = blockIdx.x; u < NB * NCH * 4; u += gridDim.x) {
        const int ci = u >> 2, q = u & 3, b = ci / NCH, c = ci % NCH, s = c * 64 + t;
        const size_t rowbase = (size_t)b * TB;
        int nrow[9]; unsigned vmask = 0u;
#pragma unroll
        for (int i = 0; i < 3; ++i)
#pragma unroll
            for (int j = 0; j < 3; ++j) {
                int ns = -1;
                if (s < NCX) { const int w2 = s + j - 1; if (i == 1 && w2 >= 0 && w2 < NCX) ns = w2; }
                else { const int n = s - NCX, rr = (n >> 6) + i - 1, w2 = (n & 63) + j - 1; if (rr >= 0 && rr < 128 && w2 >= 0 && w2 < 64) ns = NCX + rr * 64 + w2; }
                nrow[i * 3 + j] = ns >= 0 ? ns : s; vmask |= (ns >= 0 ? 1u : 0u) << (i * 3 + j);
            }
        const int tt = wave & 3, part = wave >> 2;
        f32x4 acc = (f32x4){0.f, 0.f, 0.f, 0.f};
        uint4 xn[9];
#pragma unroll
        for (int tap = 0; tap < 9; ++tap) xn[tap] = *(const uint4*)(XM + (rowbase + nrow[tap]) * 2048 + q * 512 + cg * 8);
#pragma unroll 1
        for (int half = 0; half < 2; ++half) {
            __syncthreads();
            for (int i = tid; i < 640; i += NTHR) { const int tp = i >> 6, c4 = (i & 63) * 4; st4(cwl + tp * 256 + c4, ld4((tp < 9 ? cw + tp * 2048 : cbias) + q * 512 + half * 256 + c4)); }
            __syncthreads();
#pragma unroll 1
            for (int it = 0; it < 4; ++it) {
                const int cl = it * 64 + cg * 8, c0 = q * 512 + half * 256 + cl;
                uint4 xc9[9];
#pragma unroll
                for (int tap = 0; tap < 9; ++tap) xc9[tap] = xn[tap];
                { const int gn = half * 4 + it + 1, c0n = q * 512 + (gn < 8 ? gn : 7) * 64 + cg * 8;
#pragma unroll
                  for (int tap = 0; tap < 9; ++tap) xn[tap] = *(const uint4*)(XM + (rowbase + nrow[tap]) * 2048 + c0n); }
                float a8[8];
                { const float4 b0 = ld4(cwl + 9 * 256 + cl), b1 = ld4(cwl + 9 * 256 + cl + 4); a8[0] = b0.x; a8[1] = b0.y; a8[2] = b0.z; a8[3] = b0.w; a8[4] = b1.x; a8[5] = b1.y; a8[6] = b1.z; a8[7] = b1.w; }
#pragma unroll
                for (int tap = 0; tap < 9; ++tap) {
                    const unsigned mk = ((vmask >> tap) & 1u) ? 0xffffffffu : 0u;
                    const uint4 xv = make_uint4(xc9[tap].x & mk, xc9[tap].y & mk, xc9[tap].z & mk, xc9[tap].w & mk);
                    float x8[8]; unpack8(xv, x8);
                    const float4 w0 = ld4(cwl + tap * 256 + cl), w1 = ld4(cwl + tap * 256 + cl + 4);
                    a8[0] += x8[0] * w0.x; a8[1] += x8[1] * w0.y; a8[2] += x8[2] * w0.z; a8[3] += x8[3] * w0.w;
                    a8[4] += x8[4] * w1.x; a8[5] += x8[5] * w1.y; a8[6] += x8[6] * w1.z; a8[7] += x8[7] * w1.w;
                }
#pragma unroll
                for (int i = 0; i < 8; ++i) a8[i] = silu_f(a8[i]);
                const uint4 xcv = pack8(a8);
                *(uint4*)(XC + (rowbase + s) * 2048 + c0) = xcv;
                *(uint4*)(imgC + t * 264 + cl) = xcv;
                *(uint4*)(imgM + t * 264 + cl) = xc9[4];
            }
            __syncthreads();
            {
                const bf16_t* img = part ? imgM : imgC;
                const bf16_t* wrow = WFT + (size_t)(lane & 15) * 4096 + part * 2048 + q * 512 + half * 256 + (lane >> 4) * 8;
#pragma unroll
                for (int ks = 0; ks < 8; ++ks) acc = __builtin_amdgcn_mfma_f32_16x16x32_bf16(row_frag(img, 264, tt * 16, ks * 32, lane), *(const bf16x8*)(wrow + ks * 32), acc, 0, 0, 0);
            }
        }
        if (part == 1) {
#pragma unroll
            for (int r = 0; r < 4; ++r) red[(tt * 16 + (lane >> 4) * 4 + r) * 16 + (lane & 15)] = acc[r];
        }
        __syncthreads();
        if (part == 0) {
#pragma unroll
            for (int r = 0; r < 4; ++r) {
                const int tk = tt * 16 + (lane >> 4) * 4 + r;
                G16P[(((size_t)rowbase + c * 64 + tk) * 16 + (lane & 15)) * 4 + q] = acc[r] + red[tk * 16 + (lane & 15)];
            }
        }
    }
}

struct GateRaw { float4 a, f; };
DEV GateRaw gate_load(const Params& p, size_t row, int dir, int h) {
    const float* G16P = (const float*)(p.ws + OFF_G16P);
    GateRaw g; g.a = ld4(G16P + (row * 16 + dir * 8 + h) * 4); g.f = ld4(G16P + (row * 16 + dir * 8 + 4 + h) * 4);
    return g;
}
DEV void gate_fin(const GateRaw& g, float bi, float bf, float& gi, float& lf) {
    gi = (g.a.x + g.a.y) + (g.a.z + g.a.w) + bi;
    lf = logsig_f((g.f.x + g.f.y) + (g.f.z + g.f.w) + bf);
}
DEV void gate_pair(const Params& p, size_t row, int dir, int h, float& gi, float& lf) {
    const GateRaw g = gate_load(p, row, dir, h);
    gate_fin(g, p.in[dir ? 41 : 37][h], p.in[dir ? 43 : 39][h], gi, lf);
}

DEV void phase_x1(const Params& p, float* sm) {
    int chain, sub; chain_ids(chain, sub);
    const int b = chain >> 3, h = (chain >> 1) & 3, dir = chain & 1;
    const bf16_t* XC = (const bf16_t*)(p.ws + OFF_XC);
    float* GSC = (float*)(p.ws + OFF_GSC); float* CSC = (float*)(p.ws + OFF_CSC); float* NBUF = (float*)(p.ws + OFF_NBUF);
    const float* gtab = (const float*)(p.ws + OFF_GTAB);
    bf16_t* SMAT = (bf16_t*)(p.ws + OFF_SMAT);
    const int tid = opaque_tid(), lane = tid & 63, wave = tid >> 6;
    float* sTot = sm; float* sRef = sm + 132; float* sM0 = sm + 264; float* sBeta = sm + 400;
    const float bias_i = p.in[dir ? 41 : 37][h], bias_f = p.in[dir ? 43 : 39][h];
    {
        GateRaw gn = gate_load(p, (size_t)b * TB + wave * 64 + lane, dir, h);
        for (int c = wave; c < NCH; c += NWV) {
            const GateRaw gc = gn;
            const int cn = (c + NWV < NCH) ? c + NWV : c;
            gn = gate_load(p, (size_t)b * TB + cn * 64 + lane, dir, h);
            float gi, lf; gate_fin(gc, bias_i, bias_f, gi, lf);
            const float bc = wave_scan_add(lf, lane, dir);
            const float ref = wave_max(gi - bc), tot = wave_sum(lf);
            if (lane == 0) { sTot[c] = tot; sRef[c] = ref; }
        }
    }
    __syncthreads();
    if (tid == 0) {
        float m0 = -INFINITY;
        for (int step = 0; step < NCH; ++step) {
            const int c = chunk_at(dir, step);
            sM0[c] = m0;
            const float mx = fmaxf(m0, sRef[c]);
            if (sub == 0) { CSC[(chain * NCH + c) * 2] = fexp(m0 - mx); CSC[(chain * NCH + c) * 2 + 1] = fexp(sRef[c] - mx); }
            m0 = sTot[c] + mx;
        }
    }
    __syncthreads();
    for (int k = wave; sub + 16 * k < NCH; k += NWV) {
        const int c = sub + 16 * k;
        const size_t row = (size_t)b * TB + c * 64 + lane;
        float gi, lf; gate_fin(gate_load(p, row, dir, h), bias_i, bias_f, gi, lf);
        const float bc = wave_scan_add(lf, lane, dir);
        const float a = gi - bc;
        const float amax = wave_scan_max(a, lane, dir);
        const float ref = sRef[c], m0 = sM0[c];
        const float mmax = fmaxf(amax, m0);
        const float mt = bc + mmax;
        const float alpha = fexp(ref - mmax), beta = fexp(a - ref), gg = fexp(m0 - mmax), em = fexp(-mt);
        st4(GSC + ((size_t)chain * TB + c * 64 + lane) * 4, make_float4(alpha, beta, gg, em));
        sBeta[k * 64 + lane] = beta;
    }
    __syncthreads();
    {
        float* part = sm + 1024;
        const int sg = tid >> 6, j8 = (tid & 63) * 8;
        uint4 xn[8];
        { const bf16_t* xp = XC + ((size_t)b * TB + sub * 64 + sg * 8) * 2048 + h * 512 + j8;
#pragma unroll
          for (int s = 0; s < 8; ++s) xn[s] = *(const uint4*)(xp + (size_t)s * 2048); }
        for (int k = 0; sub + 16 * k < NCH; ++k) {
            const int c = sub + 16 * k;
            uint4 xcur[8];
#pragma unroll
            for (int s = 0; s < 8; ++s) xcur[s] = xn[s];
            { const int cn = (c + 16 < NCH) ? c + 16 : c; const bf16_t* xp = XC + ((size_t)b * TB + cn * 64 + sg * 8) * 2048 + h * 512 + j8;
#pragma unroll
              for (int s = 0; s < 8; ++s) xn[s] = *(const uint4*)(xp + (size_t)s * 2048); }
            float acc[8];
#pragma unroll
            for (int i = 0; i < 8; ++i) acc[i] = 0.f;
#pragma unroll
            for (int s = 0; s < 8; ++s) {
                float f[8]; unpack8(xcur[s], f);
                const float be = sBeta[k * 64 + sg * 8 + s];
#pragma unroll
                for (int i = 0; i < 8; ++i) acc[i] += be * f[i];
            }
            __syncthreads();
            st4(part + sg * 512 + j8, make_float4(acc[0], acc[1], acc[2], acc[3])); st4(part + sg * 512 + j8 + 4, make_float4(acc[4], acc[5], acc[6], acc[7]));
            __syncthreads();
            float tot = 0.f;
#pragma unroll
            for (int q = 0; q < 8; ++q) tot += part[q * 512 + tid];
            NBUF[((size_t)chain * NCH + c) * 512 + tid] = tot;
        }
    }
    bf16_t* XCs = (bf16_t*)sm;
    bf16_t* Qs = XCs + 64 * 520;
    for (int u = blockIdx.x; u < NB * 4 * NCH; u += gridDim.x) {
        const int bh = u / NCH, c = u % NCH, ub = bh >> 2, uh = bh & 3;
        __syncthreads();
        float4 gq[2][4];
#pragma unroll
        for (int bb = 0; bb < 2; ++bb) { const float* G = gtab + (size_t)(uh * 128 + (tid & 63) * 2 + bb) * 16; gq[bb][0] = ld4(G); gq[bb][1] = ld4(G + 4); gq[bb][2] = ld4(G + 8); gq[bb][3] = ld4(G + 12); }
        uint4 xr[8];
#pragma unroll
        for (int i = 0; i < 8; ++i) { const int pp = tid + 512 * i, row = pp >> 6, c16 = pp & 63; xr[i] = *(const uint4*)(XC + ((size_t)ub * TB + c * 64 + row) * 2048 + uh * 512 + c16 * 8); }
#pragma unroll
        for (int i = 0; i < 8; ++i) {
            const int pp = tid + 512 * i, row = pp >> 6, c16 = pp & 63;
            const uint4 xv = xr[i];
            float f[8]; unpack8(xv, f);
            float q[8];
#pragma unroll
            for (int bb = 0; bb < 2; ++bb) {
                const float4 g0 = gq[bb][0], g1 = gq[bb][1], g2 = gq[bb][2], g3 = gq[bb][3];
                q[bb * 4 + 0] = f[bb * 4] * g0.x + f[bb * 4 + 1] * g1.x + f[bb * 4 + 2] * g2.x + f[bb * 4 + 3] * g3.x;
                q[bb * 4 + 1] = f[bb * 4] * g0.y + f[bb * 4 + 1] * g1.y + f[bb * 4 + 2] * g2.y + f[bb * 4 + 3] * g3.y;
                q[bb * 4 + 2] = f[bb * 4] * g0.z + f[bb * 4 + 1] * g1.z + f[bb * 4 + 2] * g2.z + f[bb * 4 + 3] * g3.z;
                q[bb * 4 + 3] = f[bb * 4] * g0.w + f[bb * 4 + 1] * g1.w + f[bb * 4 + 2] * g2.w + f[bb * 4 + 3] * g3.w;
            }
            *(uint4*)(XCs + row * 520 + c16 * 8) = xv;
            *(uint4*)(Qs + row * 520 + c16 * 8) = make_uint4(pack2bf(q[0], q[1]), pack2bf(q[2], q[3]), pack2bf(q[4], q[5]), pack2bf(q[6], q[7]));
        }
        __syncthreads();
        const int st = wave & 3, tt0 = (wave >> 2) * 2;
        f32x4 a0 = (f32x4){0.f, 0.f, 0.f, 0.f}, a1 = a0;
        const bf16_t* ap = XCs + (st * 16 + (lane & 15)) * 520 + (lane >> 4) * 8;
        const bf16_t* bp0 = Qs + (tt0 * 16 + (lane & 15)) * 520 + (lane >> 4) * 8;
        const bf16_t* bp1 = bp0 + 16 * 520;
#pragma unroll
        for (int ks = 0; ks < 16; ++ks) {
            const bf16x8 af = *(const bf16x8*)(ap + ks * 32);
            a0 = __builtin_amdgcn_mfma_f32_16x16x32_bf16(af, *(const bf16x8*)(bp0 + ks * 32), a0, 0, 0, 0);
            a1 = __builtin_amdgcn_mfma_f32_16x16x32_bf16(af, *(const bf16x8*)(bp1 + ks * 32), a1, 0, 0, 0);
        }
        bf16_t* sp = SMAT + (size_t)u * 4096 + (size_t)(tt0 * 16 + (lane & 15)) * 64 + st * 16 + (lane >> 4) * 4;
        *(uint2*)sp = make_uint2(pack2bf(a0[0], a0[1]), pack2bf(a0[2], a0[3]));
        *(uint2*)(sp + 16 * 64) = make_uint2(pack2bf(a1[0], a1[1]), pack2bf(a1[2], a1[3]));
    }
}

DEV void phase_x2(const Params& p, float* sm) {
    int chain, sub; chain_ids(chain, sub);
    const int b = chain >> 3, h = (chain >> 1) & 3, dir = chain & 1;
    const bf16_t* XC = (const bf16_t*)(p.ws + OFF_XC);
    float* GSC = (float*)(p.ws + OFF_GSC); const float* CSC = (const float*)(p.ws + OFF_CSC); const float* NBUF = (const float*)(p.ws + OFF_NBUF);
    const float* gtab = (const float*)(p.ws + OFF_GTAB);
    const bf16_t* SMAT = (const bf16_t*)(p.ws + OFF_SMAT);
    const int tid = opaque_tid();
    float* sD0 = sm; float* sCf = sm + 132; float* sN0 = sm + 264; float* sN2 = sN0 + 9 * 512;
    for (int i = tid; i < NCH; i += NTHR) { sD0[i] = CSC[(chain * NCH + i) * 2]; sCf[i] = CSC[(chain * NCH + i) * 2 + 1]; }
    __syncthreads();
    float* sBeta = sN2 + 9 * 512;
    for (int i = tid; i < 9 * 64; i += NTHR) { const int k = i >> 6, c = sub + 16 * k; if (c < NCH) sBeta[i] = GSC[((size_t)chain * TB + c * 64 + (i & 63)) * 4 + 1]; }
    if (tid < 128) {
        constexpr int NBT = 12;
        float4 n = make_float4(0.f, 0.f, 0.f, 0.f), nx[NBT];
        const float* nb = NBUF + (size_t)chain * NCH * 512 + tid * 4;
#pragma unroll
        for (int j = 0; j < NBT; ++j) nx[j] = ld4(nb + (size_t)chunk_at(dir, j) * 512);
#pragma unroll 1
        for (int step0 = 0; step0 < NCH; step0 += NBT) {
            float4 cu[NBT];
#pragma unroll
            for (int j = 0; j < NBT; ++j) cu[j] = nx[j];
#pragma unroll
            for (int j = 0; j < NBT; ++j) { const int sn = step0 + NBT + j; nx[j] = ld4(nb + (size_t)chunk_at(dir, sn < NCH ? sn : NCH - 1) * 512); }
            __builtin_amdgcn_sched_barrier(0);
#pragma unroll
            for (int j = 0; j < NBT; ++j) {
                const int c = chunk_at(dir, step0 + j);
                if ((c & 15) == sub) st4(sN0 + (c >> 4) * 512 + tid * 4, n);
                const float d = sD0[c], cf = sCf[c];
                n = make_float4(d * n.x + cf * cu[j].x, d * n.y + cf * cu[j].y, d * n.z + cf * cu[j].z, d * n.w + cf * cu[j].w);
            }
        }
    }
    __syncthreads();
    {
        const int blk = tid >> 2, cp = tid & 3;
        const float4 g = ld4(gtab + (size_t)(h * 128 + blk) * 16 + cp * 4);
        for (int k = 0; sub + 16 * k < NCH; ++k) {
            const float* n0 = sN0 + k * 512 + blk * 4;
            sN2[k * 512 + tid] = g.x * n0[0] + g.y * n0[1] + g.z * n0[2] + g.w * n0[3];
        }
    }
    __syncthreads();
    const int t = tid >> 3, part = tid & 7;
    for (int k = 0; sub + 16 * k < NCH; ++k) {
        const int c = sub + 16 * k;
        const size_t row = (size_t)b * TB + c * 64 + t;
        float dint = 0.f;
        {
            const bf16_t* xp = XC + row * 2048 + h * 512 + part * 64;
            const float* n2 = sN2 + k * 512 + part * 64;
#pragma unroll
            for (int i = 0; i < 8; ++i) {
                float f[8]; unpack8(*(const uint4*)(xp + i * 8), f);
                const float4 na = ld4(n2 + i * 8), nb2 = ld4(n2 + i * 8 + 4);
                dint += f[0] * na.x + f[1] * na.y + f[2] * na.z + f[3] * na.w + f[4] * nb2.x + f[5] * nb2.y + f[6] * nb2.z + f[7] * nb2.w;
            }
        }
        float di = 0.f;
        {
            float f[8]; unpack8(*(const uint4*)(SMAT + ((size_t)((b * 4 + h) * NCH + c)) * 4096 + t * 64 + part * 8), f);
#pragma unroll
            for (int e = 0; e < 8; ++e) {
                const int s = part * 8 + e;
                const float beta = sBeta[k * 64 + s];
                const bool keep = dir ? (s >= t) : (s <= t);
                di += keep ? f[e] * beta : 0.f;
            }
        }
        dint = red8_sum(dint);
        di = red8_sum(di);
        if (part == 0) {
            float* gp = GSC + ((size_t)chain * TB + c * 64 + t) * 4;
            const float4 g4 = ld4(gp);
            const float den = g4.x * di + g4.z * dint;
            gp[3] = 1.f / fmaxf(fabsf(den), g4.w);
        }
    }
}

#define MLSTM_PREFETCH(step_) do { \
    const int c_ = chunk_at(dir, (step_)); const size_t rb_ = (size_t)b * TB + (size_t)c_ * 64; \
    { const bf16_t* xb_ = XC + (rb_ + (tid >> 6)) * 2048 + h * 512 + (tid & 63) * 8; \
      rx0 = *(const uint4*)(xb_); rx1 = *(const uint4*)(xb_ + 8 * 2048); rx2 = *(const uint4*)(xb_ + 16 * 2048); rx3 = *(const uint4*)(xb_ + 24 * 2048); \
      rx4 = *(const uint4*)(xb_ + 32 * 2048); rx5 = *(const uint4*)(xb_ + 40 * 2048); rx6 = *(const uint4*)(xb_ + 48 * 2048); rx7 = *(const uint4*)(xb_ + 56 * 2048); } \
    rxm = *(const uint2*)(XM + (rb_ + ps) * 2048 + ch0 + pvb * 4); \
    rs = *(const uint4*)(SMAT + ((size_t)((b * 4 + h) * NCH + c_)) * 4096 + ps * 64 + pvb * 8); \
    rbeta = GSC[((size_t)chain * TB + c_ * 64 + ps) * 4 + 1]; \
    if (tid < 64) rsc = ld4(GSC + ((size_t)chain * TB + c_ * 64 + tid) * 4); \
    rd0 = CSC[(chain * NCH + c_) * 2]; rcf = CSC[(chain * NCH + c_) * 2 + 1]; } while (0)

DEV void phase_mlstm(const Params& p, float* sm) {
    int chain, sub; chain_ids(chain, sub);
    const int b = chain >> 3, h = (chain >> 1) & 3, dir = chain & 1;
    const bf16_t* XM = (const bf16_t*)(p.ws + OFF_XM);
    const bf16_t* XC = (const bf16_t*)(p.ws + OFF_XC);
    const bf16_t* SMAT = (const bf16_t*)(p.ws + OFF_SMAT);
    const float* GSC = (const float*)(p.ws + OFF_GSC); const float* CSC = (const float*)(p.ws + OFF_CSC);
    const float* gtab = (const float*)(p.ws + OFF_GTAB);
    bf16_t* H = (bf16_t*)(p.ws + OFF_H);
    const float* wv = p.in[35];
    char* smc = (char*)sm;
    bf16_t* XCs = (bf16_t*)smc;
    bf16_t* Cs = (bf16_t*)(smc + 66560);
    bf16_t* Vb = (bf16_t*)(smc + 66560 + 33280);
    bf16_t* Vw = Vb + 32 * 72;
    bf16_t* Sm = Vw + 32 * 72;
    float* Gs = (float*)(smc + 66560 + 33280 + 2 * 4608 + 9216);
    float* sc = Gs + 2048;
    const int tid = opaque_tid(), lane = tid & 63, wave = tid >> 6;
    for (int i = tid; i < 32 * 520 / 2; i += NTHR) ((unsigned*)Cs)[i] = 0u;
    for (int i = tid; i < 2048; i += NTHR) Gs[i] = gtab[h * 2048 + i];
    const int ps = tid >> 3, pvb = tid & 7;
    const int ch0 = h * 512 + sub * 32;
    float wvr[16];
#pragma unroll
    for (int i = 0; i < 16; ++i) wvr[i] = wv[(size_t)((ch0 >> 2) + pvb) * 16 + i];
    f32x4 accS[4][2];
#pragma unroll
    for (int i = 0; i < 4; ++i) { accS[i][0] = (f32x4){0.f, 0.f, 0.f, 0.f}; accS[i][1] = (f32x4){0.f, 0.f, 0.f, 0.f}; }
    uint4 rx0, rx1, rx2, rx3, rx4, rx5, rx6, rx7; uint2 rxm; uint4 rs; float rbeta; float4 rsc = make_float4(0.f, 0.f, 0.f, 0.f); float rd0, rcf;
    MLSTM_PREFETCH(0);
    __syncthreads();
#pragma unroll 1
    for (int step = 0; step < NCH; ++step) {
        const int c = chunk_at(dir, step);
        const float d0 = rd0, cf = rcf;
        {
            bf16_t* xd = XCs + (tid >> 6) * 520 + (tid & 63) * 8;
            *(uint4*)(xd) = rx0; *(uint4*)(xd + 8 * 520) = rx1; *(uint4*)(xd + 16 * 520) = rx2; *(uint4*)(xd + 24 * 520) = rx3;
            *(uint4*)(xd + 32 * 520) = rx4; *(uint4*)(xd + 40 * 520) = rx5; *(uint4*)(xd + 48 * 520) = rx6; *(uint4*)(xd + 56 * 520) = rx7;
        }
        {
            const float x0 = bflo(rxm.x), x1 = bfhi(rxm.x), x2 = bflo(rxm.y), x3 = bfhi(rxm.y);
#pragma unroll
            for (int d = 0; d < 4; ++d) {
                const float v = (x0 * wvr[d] + x1 * wvr[4 + d] + x2 * wvr[8 + d] + x3 * wvr[12 + d]) * rbeta;
                Vb[(pvb * 4 + d) * 72 + ps] = __builtin_bit_cast(unsigned short, (__bf16)v);
                Vw[(pvb * 4 + d) * 72 + ps] = __builtin_bit_cast(unsigned short, (__bf16)(v * cf));
            }
        }
        {
#define SMASK(q_) (((dir ? (pvb * 8 + 2 * (q_) >= ps) : (pvb * 8 + 2 * (q_) <= ps)) ? 0x0000ffffu : 0u) | ((dir ? (pvb * 8 + 2 * (q_) + 1 >= ps) : (pvb * 8 + 2 * (q_) + 1 <= ps)) ? 0xffff0000u : 0u))
            *(uint4*)(Sm + ps * 72 + pvb * 8) = make_uint4(rs.x & SMASK(0), rs.y & SMASK(1), rs.z & SMASK(2), rs.w & SMASK(3));
#undef SMASK
        }
        if (tid < 64) st4(sc + tid * 4, rsc);
        { const int nstep = (step + 1 < NCH) ? step + 1 : step; MLSTM_PREFETCH(nstep); }
        __syncthreads();
        {
            const int vt = wave & 1, tt = wave >> 1;
            f32x4 ao = (f32x4){0.f, 0.f, 0.f, 0.f}, ai = ao, ao1 = ao, ao2 = ao, ao3 = ao;
            const bf16_t* ap = Cs + (vt * 16 + (lane & 15)) * 520 + (lane >> 4) * 8;
            const bf16_t* bp = XCs + (tt * 16 + (lane & 15)) * 520 + (lane >> 4) * 8;
#pragma unroll
            for (int ks = 0; ks < 16; ks += 4) {
                ao = __builtin_amdgcn_mfma_f32_16x16x32_bf16(*(const bf16x8*)(ap + ks * 32), *(const bf16x8*)(bp + ks * 32), ao, 0, 0, 0);
                ao1 = __builtin_amdgcn_mfma_f32_16x16x32_bf16(*(const bf16x8*)(ap + (ks + 1) * 32), *(const bf16x8*)(bp + (ks + 1) * 32), ao1, 0, 0, 0);
                ao2 = __builtin_amdgcn_mfma_f32_16x16x32_bf16(*(const bf16x8*)(ap + (ks + 2) * 32), *(const bf16x8*)(bp + (ks + 2) * 32), ao2, 0, 0, 0);
                ao3 = __builtin_amdgcn_mfma_f32_16x16x32_bf16(*(const bf16x8*)(ap + (ks + 3) * 32), *(const bf16x8*)(bp + (ks + 3) * 32), ao3, 0, 0, 0);
            }
            ao = (ao + ao1) + (ao2 + ao3);
            const bf16_t* ap2 = Vb + (vt * 16 + (lane & 15)) * 72 + (lane >> 4) * 8;
            const bf16_t* bp2 = Sm + (tt * 16 + (lane & 15)) * 72 + (lane >> 4) * 8;
#pragma unroll
            for (int ks = 0; ks < 2; ++ks) ai = __builtin_amdgcn_mfma_f32_16x16x32_bf16(*(const bf16x8*)(ap2 + ks * 32), *(const bf16x8*)(bp2 + ks * 32), ai, 0, 0, 0);
            if (c >= 4) {
                const int t = tt * 16 + (lane & 15);
                const float4 s4 = ld4(sc + t * 4);
                const float h0 = (s4.x * ai[0] + s4.z * ao[0]) * s4.w, h1 = (s4.x * ai[1] + s4.z * ao[1]) * s4.w;
                const float h2 = (s4.x * ai[2] + s4.z * ao[2]) * s4.w, h3 = (s4.x * ai[3] + s4.z * ao[3]) * s4.w;
                bf16_t* hp = H + ((size_t)b * NL + (size_t)c * 64 + t - NCX) * 2048 + ch0 + vt * 16 + (lane >> 4) * 4;
                const unsigned u0 = pack2bf(h0, h1), u1 = pack2bf(h2, h3);
                asm volatile("global_atomic_pk_add_bf16 %0, %1, off sc1\n\tglobal_atomic_pk_add_bf16 %0, %2, off offset:4 sc1" :: "v"(hp), "v"(u0), "v"(u1) : "memory");
            }
        }
#pragma unroll
        for (int jt = 0; jt < 4; ++jt) { accS[jt][0] *= d0; accS[jt][1] *= d0; }
#pragma unroll
        for (int ks = 0; ks < 2; ++ks) {
            const bf16x8 b0 = *(const bf16x8*)(Vw + (lane & 15) * 72 + ks * 32 + (lane >> 4) * 8);
            const bf16x8 b1 = *(const bf16x8*)(Vw + (16 + (lane & 15)) * 72 + ks * 32 + (lane >> 4) * 8);
            const int row0 = ks * 32 + (lane >> 4) * 8 + ((lane & 15) >> 2);
#pragma unroll
            for (int jt = 0; jt < 4; ++jt) {
                const int col = wave * 64 + jt * 16 + (lane & 3) * 4;
                const s16x4 lo = __builtin_amdgcn_ds_read_tr16_b64_v4i16((__attribute__((address_space(3))) s16x4*)(XCs + row0 * 520 + col));
                const s16x4 hi = __builtin_amdgcn_ds_read_tr16_b64_v4i16((__attribute__((address_space(3))) s16x4*)(XCs + (row0 + 4) * 520 + col));
                const bf16x8 af = (bf16x8){lo[0], lo[1], lo[2], lo[3], hi[0], hi[1], hi[2], hi[3]};
                accS[jt][0] = __builtin_amdgcn_mfma_f32_16x16x32_bf16(af, b0, accS[jt][0], 0, 0, 0);
                accS[jt][1] = __builtin_amdgcn_mfma_f32_16x16x32_bf16(af, b1, accS[jt][1], 0, 0, 0);
            }
        }
        __syncthreads();
#pragma unroll
        for (int jt = 0; jt < 4; ++jt) {
            const int blk = wave * 16 + jt * 4 + (lane >> 4);
            const float4 g0 = ld4(Gs + blk * 16), g1 = ld4(Gs + blk * 16 + 4), g2 = ld4(Gs + blk * 16 + 8), g3 = ld4(Gs + blk * 16 + 12);
#pragma unroll
            for (int v2 = 0; v2 < 2; ++v2) {
                const f32x4 a = accS[jt][v2];
                const float o0 = g0.x * a[0] + g0.y * a[1] + g0.z * a[2] + g0.w * a[3];
                const float o1 = g1.x * a[0] + g1.y * a[1] + g1.z * a[2] + g1.w * a[3];
                const float o2 = g2.x * a[0] + g2.y * a[1] + g2.z * a[2] + g2.w * a[3];
                const float o3 = g3.x * a[0] + g3.y * a[1] + g3.z * a[2] + g3.w * a[3];
                *(uint2*)(Cs + (v2 * 16 + (lane & 15)) * 520 + blk * 4) = make_uint2(pack2bf(o0, o1), pack2bf(o2, o3));
            }
        }
    }
}

DEV void phase_finish1(const Params& p) {
    bf16_t* H = (bf16_t*)(p.ws + OFF_H);
    const bf16_t* XC = (const bf16_t*)(p.ws + OFF_XC);
    const bf16_t* Z = (const bf16_t*)(p.ws + OFF_XM);
    const float* ng = p.in[44]; const float* skip = p.in[45];
    const int tid_ = opaque_tid(); const int lane = tid_ & 63, gw = blockIdx.x * NWV + (tid_ >> 6), ngw = gridDim.x * NWV;
    const int h = gw & 3, c0 = h * 512 + lane * 8;
    float gn8[8], sk8[8];
    { const float4 a0 = ld4(ng + c0), a1 = ld4(ng + c0 + 4), b0 = ld4(skip + c0), b1 = ld4(skip + c0 + 4);
      gn8[0] = a0.x; gn8[1] = a0.y; gn8[2] = a0.z; gn8[3] = a0.w; gn8[4] = a1.x; gn8[5] = a1.y; gn8[6] = a1.z; gn8[7] = a1.w;
      sk8[0] = b0.x; sk8[1] = b0.y; sk8[2] = b0.z; sk8[3] = b0.w; sk8[4] = b1.x; sk8[5] = b1.y; sk8[6] = b1.z; sk8[7] = b1.w; }
    constexpr int NIT = NB * NL * 4;
    uint4 nh[2], nx[2], nz[2];
#pragma unroll
    for (int u = 0; u < 2; ++u) { const int it = gw + u * ngw, r = (it < NIT ? it : gw) >> 2, b = r >= NL ? 1 : 0, nn = r - b * NL;
        nh[u] = *(const uint4*)(H + (size_t)r * 2048 + c0); nx[u] = *(const uint4*)(XC + ((size_t)b * TB + NCX + nn) * 2048 + c0); nz[u] = *(const uint4*)(Z + (size_t)r * 2048 + c0); }
    for (int it0 = gw; it0 < NIT; it0 += 2 * ngw) {
        uint4 ch[2], cx[2], cz[2];
#pragma unroll
        for (int u = 0; u < 2; ++u) { ch[u] = nh[u]; cx[u] = nx[u]; cz[u] = nz[u]; }
#pragma unroll
        for (int u = 0; u < 2; ++u) { const int it = it0 + (2 + u) * ngw, r = (it < NIT ? it : gw) >> 2, b = r >= NL ? 1 : 0, nn = r - b * NL;
            nh[u] = *(const uint4*)(H + (size_t)r * 2048 + c0); nx[u] = *(const uint4*)(XC + ((size_t)b * TB + NCX + nn) * 2048 + c0); nz[u] = *(const uint4*)(Z + (size_t)r * 2048 + c0); }
#pragma unroll
        for (int u = 0; u < 2; ++u) {
            const int it = it0 + u * ngw, r = it >> 2;
            float v[8]; unpack8(ch[u], v);
            float sum = 0.f;
#pragma unroll
            for (int j = 0; j < 8; ++j) sum += v[j];
            const float mean = wave_sum(sum) * (1.f / 512.f);
            float sq = 0.f;
#pragma unroll
            for (int j = 0; j < 8; ++j) { v[j] -= mean; sq += v[j] * v[j]; }
            const float rstd = rsqrtf(wave_sum(sq) * (1.f / 512.f) + 1e-5f);
            float xc[8], z[8];
            unpack8(cx[u], xc); unpack8(cz[u], z);
            float o[8];
#pragma unroll
            for (int j = 0; j < 8; ++j) o[j] = (v[j] * rstd * gn8[j] + sk8[j] * xc[j]) * silu_f(z[j]);
            if (it < NIT) *(uint4*)(H + (size_t)r * 2048 + c0) = make_uint4(pack2bf(o[0], o[1]), pack2bf(o[2], o[3]), pack2bf(o[4], o[5]), pack2bf(o[6], o[7]));
        }
    }
}

__global__ void __launch_bounds__(NTHR) fwd_kernel(Params p) {
    extern __shared__ __attribute__((aligned(16))) float sm[];
    volatile LAS unsigned* xst = (volatile LAS unsigned*)((LAS char*)sm + (LDS_BYTES - 16));
    if (threadIdx.x == 0) { xst[0] = 0u; xst[1] = 0u; }
    __syncthreads();
    const XcdBarrier xbar = xcd_barrier_post((unsigned*)(p.ws + OFF_BAR), xst);
    const int tid = opaque_tid(), lane = tid & 63, wave = tid >> 6;
    float* modv = (float*)(p.ws + OFF_MODV);
    float* X1C = (float*)(p.ws + OFF_X1C);

    phase_mod(p, sm);
    phase_tables(p);
    transpose_convert(p.in[8], 1024, EIN, 4096, (bf16_t*)(p.ws + OFF_WT0), sm);
    transpose_convert(p.in[29], 1024, 4096, 4096, (bf16_t*)(p.ws + OFF_WT1), sm);
    transpose_convert(p.in[9], 1024, 1024, 1024, (bf16_t*)(p.ws + OFF_WT2), sm);
    transpose_convert(p.in[30], 2048, 1024, 1024, (bf16_t*)(p.ws + OFF_WT3), sm);
    xcd_barrier(xbar);

#pragma unroll 1
    for (int b = 0; b < NB; ++b) {
        if (b == 0) { phase_h0(p, 0); xcd_barrier(xbar); }
        run_gemm((const bf16_t*)(p.ws + OFF_YC), (const bf16_t*)(p.ws + OFF_WT0), TB, 3840, DM, EpBf16{(bf16_t*)(p.ws + OFF_P0), EIN, EIN}, sm);
        mini_gemm<3, 2>((const bf16_t*)(p.ws + OFF_YC), DM, 33 * (int)blockIdx.x, TB - 1, (const bf16_t*)(p.ws + OFF_WT0), DM, 3840, (bf16_t*)(p.ws + OFF_P0), EIN, 3840, 33, sm);
        xcd_barrier(xbar);
        {
            const int x = blockIdx.x & 7, q0 = blockIdx.x >> 3;
            R1Raw R;
            r1_consts(p, x, q0 & 1, sm);
            r1_load(p, x, q0 & 1, q0 >> 1, R);
            for (int q = q0; q < 2 * NCH; q += 32) rwkv1_unit(p, x, q & 1, q >> 1, sm, R, (q + 32 < 2 * NCH) ? ((q + 32) >> 1) : -1);
            gla_consts(p, x >> 1, sm);
            if (q0 < 8) { for (int g = 2 * q0; g < 2 * q0 + 2; ++g) gla1_unit(p, x >> 1, g & 1, (NCH / 2) * (x & 1) + (g >> 1), sm); }
            else { for (int g = 16 + (q0 - 8); g < NCH; g += 24) gla1_unit(p, x >> 1, g & 1, (NCH / 2) * (x & 1) + (g >> 1), sm); }
        }
        xcd_barrier(xbar);
        if (blockIdx.x < 128) gla2_unit(p, blockIdx.x);
        else if (blockIdx.x < 192) { const int i = (blockIdx.x - 128) >> 3; rwkv2_unit(p, (blockIdx.x & 7) * 2 + (i >> 2), i & 3, sm); }
        xcd_barrier(xbar);
        {
            const int x = blockIdx.x & 7, j = blockIdx.x >> 3;
            gla_consts(p, x >> 1, sm);
            const int r0 = j < 2 ? 2 * j : (j < 10 ? 4 + (j - 2) * 5 : 44 + (j - 10) * 4), nr = j < 2 ? 2 : (j < 10 ? 5 : 4);
            for (int r = r0; r < r0 + nr; ++r) rwkv3_unit(p, x, r, sm);
            for (int g = j; g < NCH / 2; g += 32) gla3_unit(p, x >> 1, (NCH / 2) * (x & 1) + g, sm);
        }
        xcd_barrier(xbar);
        run_gemm((const bf16_t*)(p.ws + OFF_YC), (const bf16_t*)(p.ws + OFF_WT2), TB, DM, DM, EpRes0{(float*)(p.ws + OFF_P0), modv, b}, sm);
        xcd_barrier(xbar);
        ln_rows((const float*)(p.ws + OFF_P0), p.in[0] + (size_t)b * NL * DM, p.in[2] + (size_t)b * NCX * DM, TB, p.in[6], p.in[7], p.out + (size_t)b * NL * DM, X1C + (size_t)b * NCX * DM, NCX,
                (bf16_t*)(p.ws + OFF_H1B) + (size_t)b * TB * DM, modv + (3 + 2) * 3072, modv + (3 + b) * 3072);
        if (b == 0) phase_h0(p, 1);
        xcd_barrier(xbar);
    }

    run_gemm((const bf16_t*)(p.ws + OFF_H1B), (const bf16_t*)(p.ws + OFF_WT1), RT, 2048, DM, EpBf16{(bf16_t*)(p.ws + OFF_XM), 2048, 2048}, sm);
    zero_f4((float*)(p.ws + OFF_H), (size_t)NB * NL * 1024);
    xcd_barrier(xbar);
    phase_conv1(p, sm);
    xcd_barrier(xbar);
    phase_x1(p, sm);
    xcd_barrier(xbar);
    phase_x2(p, sm);
    xcd_barrier(xbar);
    phase_mlstm(p, sm);
    xcd_barrier(xbar);
    phase_h1l(p);
    xcd_barrier(xbar);
    run_gemm((const bf16_t*)(p.ws + OFF_H1B), (const bf16_t*)(p.ws + OFF_WT1) + (size_t)2048 * 1024, NB * NL, 2048, DM, EpBf16{(bf16_t*)(p.ws + OFF_XM), 2048, 2048}, sm);
    xcd_barrier(xbar);
    phase_finish1(p);
    xcd_barrier(xbar);
    run_gemm((const bf16_t*)(p.ws + OFF_H), (const bf16_t*)(p.ws + OFF_WT3), NB * NL, DM, 2048, EpRes1{(float*)(p.ws + OFF_XC), modv + 3 * 3072}, sm);
    xcd_barrier(xbar);
    ln_rows((const float*)(p.ws + OFF_XC), p.out, p.out, NB * NL, p.in[6] + 1024, p.in[7] + 1024, p.out, p.out, 0);
}

extern "C" void kernel_launch(void* const* d_in, const int* in_sizes, int n_in, void* d_out, int out_size, void* d_ws, size_t ws_size, hipStream_t stream) {
    static int grid_blocks = 0;
    if (grid_blocks == 0) {
        if (ws_size < WS_NEED || n_in != 46) { fprintf(stderr, "kernel_launch: bad ws_size %zu (need %zu) or n_in %d\n", ws_size, (size_t)WS_NEED, n_in); grid_blocks = -1; return; }
        int dev = 0, cus = 0, per_cu = 0;
        (void)hipGetDevice(&dev);
        (void)hipDeviceGetAttribute(&cus, hipDeviceAttributeMultiprocessorCount, dev);
        (void)hipFuncSetAttribute((const void*)fwd_kernel, hipFuncAttributeMaxDynamicSharedMemorySize, LDS_BYTES);
        (void)hipOccupancyMaxActiveBlocksPerMultiprocessor(&per_cu, (const void*)fwd_kernel, NTHR, LDS_BYTES);
        if (per_cu < 1 || cus < 256) { fprintf(stderr, "kernel_launch: occupancy query says %d blocks/CU on %d CUs; this kernel needs 256 resident workgroups\n", per_cu, cus); grid_blocks = -1; return; }
        grid_blocks = 256;
    }
    if (grid_blocks < 0) return;
    (void)hipMemsetAsync((char*)d_ws + OFF_BAR, 0, XCD_BAR_WORDS * 4, stream);
    Params p{};
    for (int i = 0; i < 46; ++i) p.in[i] = (const float*)d_in[i];
    p.out = (float*)d_out; p.ws = (char*)d_ws;
    void* args[] = {&p};
    hipError_t e = hipLaunchCooperativeKernel((const void*)fwd_kernel, dim3(grid_blocks), dim3(NTHR), args, LDS_BYTES, stream);
    if (e != hipSuccess) fprintf(stderr, "cooperative launch failed: %s (grid %d)\n", hipGetErrorString(e), grid_blocks);
}
```

```cpp
#include <hip/hip_runtime.h>
#include <cstdio>
#include <cmath>

#define DEV __device__ __forceinline__

constexpr int NB = 2, NL = 8192, DM = 1024, NCX = 256, TB = NCX + NL;
constexpr int RT = NB * TB;
constexpr int NCH = TB / 64;
constexpr int EIN = 3872, RW0 = 1568;
constexpr int NTHR = 512, NWV = 8;
constexpr float ALPHA = 1.41421356237f;
constexpr float KSCALE = 0.04419417382f;

constexpr size_t OFF_MODV = 0;
constexpr size_t OFF_X1C  = 131072;
constexpr size_t OFF_BAR  = 3145728;
constexpr size_t OFF_BIG  = 4194304;
constexpr size_t OFF_P0   = OFF_BIG;
constexpr size_t OFF_YC   = OFF_BIG + (size_t)TB * EIN * 2;
constexpr size_t OFF_GDS  = OFF_YC + (size_t)TB * 1024 * 2;
constexpr size_t OFF_GDEC = OFF_GDS + (size_t)8 * NCH * 8192 * 4;
constexpr size_t OFF_RU   = OFF_GDEC + (size_t)8 * NCH * 64 * 4;
constexpr size_t OFF_RS0  = OFF_RU + (size_t)16 * NCH * 16384 * 2;
constexpr size_t OFF_BONS = OFF_RS0 + (size_t)16 * NCH * 4096 * 2;
constexpr size_t L0_END   = OFF_BONS + (size_t)2 * TB * 8 * 4;
constexpr size_t OFF_XM   = OFF_BIG;
constexpr size_t OFF_XC   = OFF_XM + (size_t)RT * 2048 * 2;
constexpr size_t OFF_H    = OFF_XC + (size_t)RT * 2048 * 2;
constexpr size_t OFF_WT0  = OFF_H + (size_t)NB * NL * 2048 * 2;
constexpr size_t OFF_WT1  = OFF_WT0 + (size_t)4096 * 1024 * 2;
constexpr size_t OFF_WT2  = OFF_WT1 + (size_t)4096 * 1024 * 2;
constexpr size_t OFF_WT3  = OFF_WT2 + (size_t)1024 * 1024 * 2;
constexpr size_t OFF_G16  = OFF_WT3 + (size_t)1024 * 2048 * 2;
constexpr size_t OFF_SMAT = OFF_G16 + (size_t)RT * 16 * 4;
constexpr size_t OFF_GSC  = OFF_SMAT + (size_t)NB * 4 * NCH * 4096 * 2;
constexpr size_t OFF_CSC  = OFF_GSC + (size_t)16 * TB * 4 * 4;
constexpr size_t OFF_NBUF = OFF_CSC + (size_t)16 * NCH * 2 * 4;
constexpr size_t OFF_GTAB = 3407872;
constexpr size_t OFF_WFT  = OFF_GTAB + (size_t)4 * 128 * 16 * 4;
static_assert(OFF_WFT + (size_t)16 * 4096 * 2 <= OFF_BIG, "low-region tables overflow");
constexpr size_t OFF_G16P = OFF_NBUF + (size_t)16 * NCH * 512 * 4;
constexpr size_t OFF_H1B  = OFF_G16;
constexpr size_t WS_NEED  = (OFF_G16P + (size_t)4 * RT * 16 * 4 > OFF_H1B + (size_t)RT * 1024 * 2) ? OFF_G16P + (size_t)4 * RT * 16 * 4 : OFF_H1B + (size_t)RT * 1024 * 2;
static_assert(WS_NEED <= (size_t)256 * 1024 * 1024, "workspace exceeds the guaranteed 256 MiB");

static_assert(L0_END <= OFF_WT0, "layer-0 buffers overlap the weight copies");
constexpr int LDS_BYTES = 139264;

struct Params { const float* in[46]; float* out; char* ws; };
typedef unsigned short bf16_t;
typedef __attribute__((ext_vector_type(8))) short bf16x8;
typedef __attribute__((ext_vector_type(4))) short s16x4;
typedef __attribute__((ext_vector_type(2))) short s16x2;
typedef __attribute__((ext_vector_type(4))) float f32x4;
typedef __attribute__((ext_vector_type(2))) __bf16 bf2_t;
DEV unsigned pack2bf(float lo, float hi) { bf2_t v; v[0] = (__bf16)lo; v[1] = (__bf16)hi; return __builtin_bit_cast(unsigned, v); }
DEV float bflo(unsigned u) { return __uint_as_float(u << 16); }
DEV float bfhi(unsigned u) { return __uint_as_float(u & 0xffff0000u); }
DEV float bf2f(bf16_t v) { return __uint_as_float(((unsigned)v) << 16); }
DEV void unpack8(uint4 u, float* f) { f[0] = bflo(u.x); f[1] = bfhi(u.x); f[2] = bflo(u.y); f[3] = bfhi(u.y); f[4] = bflo(u.z); f[5] = bfhi(u.z); f[6] = bflo(u.w); f[7] = bfhi(u.w); }

#define DPPX_F(src_, ctrl_) __int_as_float(__builtin_amdgcn_update_dpp(0, __float_as_int(src_), (ctrl_), 0xf, 0xf, false))
DEV float red8_sum(float v) { v += DPPX_F(v, 0xB1); v += DPPX_F(v, 0x4E); v += DPPX_F(v, 0x141); return v; }
DEV float wave_sum(float v) {
    v += DPPX_F(v, 0xB1); v += DPPX_F(v, 0x4E); v += DPPX_F(v, 0x141); v += DPPX_F(v, 0x140);
    const int b = __float_as_int(v);
    return (__int_as_float(__builtin_amdgcn_readlane(b, 0)) + __int_as_float(__builtin_amdgcn_readlane(b, 16))) + (__int_as_float(__builtin_amdgcn_readlane(b, 32)) + __int_as_float(__builtin_amdgcn_readlane(b, 48)));
}
DEV float wave_max(float v) {
    v = fmaxf(v, DPPX_F(v, 0xB1)); v = fmaxf(v, DPPX_F(v, 0x4E)); v = fmaxf(v, DPPX_F(v, 0x141)); v = fmaxf(v, DPPX_F(v, 0x140));
    const int b = __float_as_int(v);
    return fmaxf(fmaxf(__int_as_float(__builtin_amdgcn_readlane(b, 0)), __int_as_float(__builtin_amdgcn_readlane(b, 16))), fmaxf(__int_as_float(__builtin_amdgcn_readlane(b, 32)), __int_as_float(__builtin_amdgcn_readlane(b, 48))));
}
DEV float fexp(float x) { return __expf(x); }
DEV float frcp(float x) { return __builtin_amdgcn_rcpf(x); }
DEV float sigmoid_f(float x) { return frcp(1.f + fexp(-x)); }
DEV float silu_f(float x) { return x * frcp(1.f + fexp(-x)); }
DEV float logsig_f(float x) { return fminf(x, 0.f) - __logf(1.f + fexp(-fabsf(x))); }
DEV float tanh_f(float x) { const float e = fexp(2.f * x); return 1.f - 2.f * frcp(e + 1.f); }
DEV void lds_fence() { asm volatile("" ::: "memory"); }
DEV int opaque_tid() { int t = threadIdx.x; asm volatile("" : "+v"(t)); return t; }
DEV int scan_s(int dir, int u) { return dir == 0 ? u : (u < NCX ? (NCX - 1 - u) : (TB - 1 + NCX - u)); }
DEV int chunk_at(int dir, int step) { return dir == 0 ? step : (step < 4 ? 3 - step : (NCH + 3 - step)); }
DEV float4 ld4(const float* p) { return *(const float4*)p; }
DEV void st4(float* p, float4 v) { *(float4*)p = v; }


#define XB_TMO      128
#define XB_XCNT(j)  (256  + 64 * (j))
#define XB_XSUB(j)  (1280 + 64 * (j))
#define XB_XGEN(j)  (2304 + 64 * (j))
#define XB_TOP      3328
#define XB_TOPGEN   3392
#define XCD_BAR_WORDS 3456
#define XB_SPIN_CAP (1u << 22)
#define LAS __attribute__((address_space(3)))
DEV unsigned xb_ld(unsigned* p) { return __hip_atomic_load(p, __ATOMIC_RELAXED, __HIP_MEMORY_SCOPE_AGENT); }
DEV unsigned xb_add(unsigned* p, unsigned v) { return __hip_atomic_fetch_add(p, v, __ATOMIC_RELAXED, __HIP_MEMORY_SCOPE_AGENT); }
DEV unsigned xb_xcc_id() { return (unsigned)__builtin_amdgcn_s_getreg((3 << 11) | 20) & 0xFu; }
#define XB_SPIN(cond, bar) do { unsigned _sp = 0; while (cond) { __builtin_amdgcn_s_sleep(1); \
    if ((++_sp & 255u) == 0u) { if (xb_ld(&(bar)[XB_TMO])) break; if (_sp > XB_SPIN_CAP) { atomicAdd(&(bar)[XB_TMO], 1u); break; } } } } while (0)
struct XcdBarrier { unsigned* bar; unsigned x; volatile LAS unsigned* st; };
DEV XcdBarrier xcd_barrier_post(unsigned* bar, volatile LAS unsigned* st) {
    XcdBarrier b; b.bar = bar; b.x = xb_xcc_id(); b.st = st;
    if (threadIdx.x == 0) (void)xb_add(&bar[XB_XCNT(b.x)], 1u);
    return b;
}
DEV void xcd_barrier_complete(unsigned* bar, unsigned x, unsigned& nloc, unsigned& nx) {
    const unsigned G = gridDim.x * gridDim.y * gridDim.z;
    unsigned sum, cnt, mine, sp = 0u;
    for (;;) {
        sum = 0u; cnt = 0u; mine = 0u;
#pragma unroll
        for (unsigned j = 0; j < 16; ++j) { const unsigned c = xb_ld(&bar[XB_XCNT(j)]); sum += c; cnt += (c > 0u) ? 1u : 0u; mine = (j == x) ? c : mine; }
        if (sum == G) break;
        __builtin_amdgcn_s_sleep(1);
        if ((++sp & 255u) == 0u) { if (xb_ld(&bar[XB_TMO])) break; if (sp > XB_SPIN_CAP) { atomicAdd(&bar[XB_TMO], 1u); break; } }
    }
    nloc = mine > 0u ? mine : 1u; nx = cnt > 0u ? cnt : 1u;
}
DEV void xcd_barrier(const XcdBarrier& b) {
    asm volatile("s_waitcnt vmcnt(0)" ::: "memory");
    __syncthreads();
    if (threadIdx.x == 0) {
        unsigned* bar = b.bar;
        __builtin_amdgcn_s_waitcnt(0);
        unsigned nloc = b.st[0], nx = b.st[1];
        if (nloc == 0u) { xcd_barrier_complete(bar, b.x, nloc, nx); b.st[0] = nloc; b.st[1] = nx; }
        const unsigned old = xb_add(&bar[XB_XSUB(b.x)], 1u);
        const unsigned gen = old / nloc;
        if (old + 1u == (gen + 1u) * nloc) {
            __builtin_amdgcn_fence(__ATOMIC_RELEASE, "agent");
            asm volatile("s_waitcnt vmcnt(0)" ::: "memory");
            const unsigned og = xb_add(&bar[XB_TOP], 1u);
            const unsigned tg = og / nx;
            if (og + 1u == (tg + 1u) * nx) xb_add(&bar[XB_TOPGEN], 1u);
            else XB_SPIN(xb_ld(&bar[XB_TOPGEN]) == tg, bar);
            __builtin_amdgcn_fence(__ATOMIC_ACQUIRE, "agent");
            xb_add(&bar[XB_XGEN(b.x)], 1u);
            asm volatile("s_waitcnt vmcnt(0)" ::: "memory");
        } else {
            XB_SPIN(xb_ld(&bar[XB_XGEN(b.x)]) == gen, bar);
            __builtin_amdgcn_fence(__ATOMIC_ACQUIRE, "agent");
            asm volatile("s_waitcnt vmcnt(0)" ::: "memory");
        }
    }
    __syncthreads();
}

namespace pg8 {
#define PG8_LAS __attribute__((address_space(3)))
typedef unsigned short bf16_t;
typedef short bf16x8 __attribute__((ext_vector_type(8)));
typedef float f32x4 __attribute__((ext_vector_type(4)));
typedef unsigned u32x4 __attribute__((ext_vector_type(4)));
constexpr int BM = 256, BK = 64, HALF = 128, HTB = HALF * BK * 2  , STAGE_BYTES = 8 * HTB, NXCD = 8, WGM = 8;

__host__ __device__ __forceinline__ int lds_byte(int r, int c) { const int st = (r >> 4) * 2 + (c >> 5), rr = r & 15, cc = c & 31, ob = rr * 64 + cc * 2; return st * 1024 + (ob ^ (((ob >> 9) & 1) << 5)); }
__host__ __device__ __forceinline__ void stage_rc(int b, int& R, int& C) { const int st = b / 1024, sb = b % 1024, swz = sb ^ (((sb >> 9) & 1) << 5); R = (st >> 1) * 16 + swz / 64; C = (st & 1) * 32 + (swz % 64) / 2; }
__host__ __device__ __forceinline__ int perm32(int rho) { const int n = rho >> 4, i = rho & 15; return 8 * (i >> 2) + 4 * n + (i & 3); }

struct Unit { int pm, pn; };
struct Gemm { const bf16_t* A; const bf16_t* Bt; int M, N, K; };

struct StaticOrder {
    int nM, nN, nwg, G, c;
    __host__ __device__ void init(int M, int N, int G_, int c_) { nM = M / BM; nN = N / BM; nwg = nM * nN; G = G_; c = c_; }
    __host__ __device__ bool next(int i, Unit& u) const {
        const long L = (long)i * G + c; if (L >= nwg) return false;
        int wgid = (int)L; { const int q = nwg / NXCD, r = nwg % NXCD, xcd = wgid % NXCD, off = wgid / NXCD; wgid = (xcd < r ? xcd * (q + 1) : r * (q + 1) + (xcd - r) * q) + off; }
        const int nig = WGM * nN, gid = wgid / nig, fm = gid * WGM, gsz = (nM - fm) < WGM ? (nM - fm) : WGM;
        u.pm = fm + ((wgid % nig) % gsz); u.pn = (wgid % nig) / gsz; return true;
    }
    __device__ __forceinline__ void a_ready(const Unit&) const {}
    __device__ __forceinline__ void done(const Unit&) const {}
};

template <class Epi, class Sched, bool STAMP = false>
__device__ __forceinline__ void gemm_phase(PG8_LAS unsigned char* lds, const Gemm g, const Sched& S, const Epi& E, unsigned long long* stamps) {
    int tid = threadIdx.x; asm volatile("" : "+v"(tid));
    const int wid = __builtin_amdgcn_readfirstlane(tid >> 6), lane = tid & 63, wr = wid >> 2, wc = wid & 3, fr = lane & 15, fq = lane >> 4;
    const int K = g.K, nt = K / BK;
#define PG8_STAMP() do { } while (0)
    PG8_STAMP();
    unsigned voffA[2], voffB[2];
#pragma unroll
    for (int i = 0; i < 2; ++i) { int R, C; stage_rc(tid * 16 + i * 8192, R, C); const int Rb = Epi::PERM ? ((R & ~31) + perm32(R & 31)) : R;
        voffA[i] = (unsigned)(R * K + C) * 2u; voffB[i] = (unsigned)(Rb * K + C) * 2u; }
    const size_t kstep = (size_t)(BK * 2);
    const size_t hstep = (size_t)HALF * K * 2;
    const size_t tstep = 2 * hstep;
    const unsigned ldsw = (unsigned)wid * 1024u;
    const int aoff = lds_byte(wr * 64 + fr, fq * 8), boff = lds_byte(wc * 32 + fr, fq * 8);
#define PG8_SA(b, h) (((b) * 2 + (h)) * HTB)
#define PG8_SB(b, h) ((4 + (b) * 2 + (h)) * HTB)
#define PG8_STAGE(bufoff, gbase, voff) do { _Pragma("unroll") for (int _i = 0; _i < 2; ++_i) \
        __builtin_amdgcn_global_load_lds((const unsigned*)((const char*)(gbase) + (voff)[_i]), (PG8_LAS unsigned*)(lds + (bufoff) + ldsw + _i * 8192), 16, 0, 0); } while (0)
#define PG8_LDA(dst, b, h) do { _Pragma("unroll") for (int m = 0; m < 4; ++m) _Pragma("unroll") for (int k = 0; k < 2; ++k) dst[m][k] = *(const PG8_LAS bf16x8*)(lds + PG8_SA(b, h) + aoff + m * 2048 + k * 1024); } while (0)
#define PG8_LDB(dst, b, h) do { _Pragma("unroll") for (int n = 0; n < 2; ++n) _Pragma("unroll") for (int k = 0; k < 2; ++k) dst[n][k] = *(const PG8_LAS bf16x8*)(lds + PG8_SB(b, h) + boff + n * 2048 + k * 1024); } while (0)
#define PG8_MMA(ai, bj, At, Bt) do { __builtin_amdgcn_s_setprio(1); _Pragma("unroll") for (int m = 0; m < 4; ++m) _Pragma("unroll") for (int n = 0; n < 2; ++n) _Pragma("unroll") for (int k = 0; k < 2; ++k) \
        acc[ai][bj][m][n] = __builtin_amdgcn_mfma_f32_16x16x32_bf16(Bt[n][k], At[m][k], acc[ai][bj][m][n], 0, 0, 0); __builtin_amdgcn_s_setprio(0); } while (0)
#define PG8_WAIT_V(n) asm volatile("s_waitcnt vmcnt(" #n ")" ::: "memory")
#define PG8_WAIT_L(n) asm volatile("s_waitcnt lgkmcnt(" #n ")" ::: "memory")
#define PG8_BAR __builtin_amdgcn_s_barrier()
#define PG8_SCHED __builtin_amdgcn_sched_barrier(0)
    Unit cur, nxt; int ui = 0;
    if (!S.next(0, cur)) return;
    f32x4 acc[2][2][4][2];
#pragma unroll
    for (int a = 0; a < 2; ++a)
#pragma unroll
        for (int b = 0; b < 2; ++b)
#pragma unroll
            for (int m = 0; m < 4; ++m)
#pragma unroll
                for (int n = 0; n < 2; ++n) acc[a][b][m][n] = (f32x4){0.f, 0.f, 0.f, 0.f};
    bf16x8 At[4][2], B0[2][2], B1[2][2];
    const char* cA = (const char*)g.A + (size_t)cur.pm * tstep; const char* cB = (const char*)g.Bt + (size_t)cur.pn * tstep;
    S.a_ready(cur);
    PG8_STAGE(PG8_SB(0, 0), cB, voffB); PG8_STAGE(PG8_SA(0, 0), cA, voffA); PG8_STAGE(PG8_SB(0, 1), cB + hstep, voffB); PG8_STAGE(PG8_SA(0, 1), cA + hstep, voffA);
    if (wr == 1) PG8_BAR;
    PG8_WAIT_V(4); PG8_BAR;
    PG8_STAGE(PG8_SB(1, 0), cB + kstep, voffB); PG8_STAGE(PG8_SA(1, 0), cA + kstep, voffA); PG8_STAGE(PG8_SB(1, 1), cB + hstep + kstep, voffB);
    PG8_WAIT_V(6); PG8_BAR;
    PG8_STAMP();
    for (;;) {
        const bool has_next = S.next(ui + 1, nxt);
        const char* nA = has_next ? (const char*)g.A + (size_t)nxt.pm * tstep : cA; const char* nB = has_next ? (const char*)g.Bt + (size_t)nxt.pn * tstep : cB;
        for (int t = 0; t < nt; t += 2) {
            const bool last = (t == nt - 2);
            const char* a1 = cA + (size_t)(t + 1) * kstep;
            const char* a2 = last ? nA : cA + (size_t)(t + 2) * kstep; const char* b2 = last ? nB : cB + (size_t)(t + 2) * kstep;
            const char* a3 = a2 + kstep; const char* b3 = b2 + kstep;
            if (last && has_next) S.a_ready(nxt);
            PG8_LDB(B0, 0, 0); PG8_SCHED; PG8_LDA(At, 0, 0); PG8_STAGE(PG8_SA(1, 1), a1 + hstep, voffA);
            PG8_WAIT_L(8); PG8_BAR; PG8_WAIT_L(0); PG8_MMA(0, 0, At, B0); PG8_BAR; PG8_SCHED;
            PG8_LDB(B1, 0, 1); PG8_STAGE(PG8_SB(0, 0), b2, voffB);
            PG8_BAR; PG8_WAIT_L(0); PG8_MMA(0, 1, At, B1); PG8_BAR;
            PG8_LDA(At, 0, 1); PG8_STAGE(PG8_SA(0, 0), a2, voffA);
            PG8_BAR; PG8_WAIT_L(0); PG8_MMA(1, 0, At, B0); PG8_BAR; PG8_SCHED;
            PG8_STAGE(PG8_SB(0, 1), b2 + hstep, voffB);
            PG8_WAIT_V(6); PG8_BAR; PG8_MMA(1, 1, At, B1); PG8_BAR;
            PG8_LDB(B0, 1, 0); PG8_SCHED; PG8_LDA(At, 1, 0); PG8_STAGE(PG8_SA(0, 1), a2 + hstep, voffA);
            PG8_WAIT_L(8); PG8_BAR; PG8_WAIT_L(0); PG8_MMA(0, 0, At, B0); PG8_BAR; PG8_SCHED;
            PG8_LDB(B1, 1, 1); PG8_STAGE(PG8_SB(1, 0), b3, voffB);
            PG8_BAR; PG8_WAIT_L(0); PG8_MMA(0, 1, At, B1); PG8_BAR;
            PG8_LDA(At, 1, 1); PG8_STAGE(PG8_SA(1, 0), a3, voffA);
            PG8_BAR; PG8_WAIT_L(0); PG8_MMA(1, 0, At, B0); PG8_BAR; PG8_SCHED;
            PG8_STAGE(PG8_SB(1, 1), b3 + hstep, voffB);
            PG8_WAIT_V(6); PG8_BAR; PG8_MMA(1, 1, At, B1); PG8_BAR;
        }
        PG8_STAMP();
        if constexpr (!Epi::AFTER_DRAIN) { E(acc, cur, wr, wc, fr, fq); S.done(cur); }
        PG8_STAMP();
        if (!has_next) break;
#pragma unroll
        for (int a = 0; a < 2; ++a)
#pragma unroll
            for (int b = 0; b < 2; ++b)
#pragma unroll
                for (int m = 0; m < 4; ++m)
#pragma unroll
                    for (int n = 0; n < 2; ++n) acc[a][b][m][n] = (f32x4){0.f, 0.f, 0.f, 0.f};
        cur = nxt; cA = nA; cB = nB; ++ui;
    }
    PG8_WAIT_V(0);
    if (wr == 0) PG8_BAR;
    PG8_BAR;
    if constexpr (Epi::AFTER_DRAIN) { E.fused(acc, cur, wr, wc, fr, fq, lds, wid, lane); S.done(cur); }
    PG8_STAMP();
#undef PG8_STAMP
#undef PG8_SA
#undef PG8_SB
#undef PG8_STAGE
#undef PG8_LDA
#undef PG8_LDB
#undef PG8_MMA
#undef PG8_WAIT_V
#undef PG8_WAIT_L
#undef PG8_BAR
#undef PG8_SCHED
}
}

DEV void transpose_convert(const float* __restrict__ W, int K, int N, int Npad, bf16_t* Wt, float* sm) {
    float (*T)[65] = (float (*)[65])sm;
    const int tid = opaque_tid();
    const int kt = K / 64, ntl = Npad / 64;
    for (int tile = blockIdx.x; tile < kt * ntl; tile += gridDim.x) {
        const int k0 = (tile / ntl) * 64, n0 = (tile % ntl) * 64;
        __syncthreads();
#pragma unroll
        for (int i = 0; i < 2; ++i) {
            const int k = (tid >> 4) + 32 * i, n4 = (tid & 15) * 4;
            float4 v = make_float4(0.f, 0.f, 0.f, 0.f);
            if (n0 + n4 < N) v = ld4(W + (size_t)(k0 + k) * N + n0 + n4);
            T[k][n4] = v.x; T[k][n4 + 1] = v.y; T[k][n4 + 2] = v.z; T[k][n4 + 3] = v.w;
        }
        __syncthreads();
        const int n = tid >> 3, kq = (tid & 7) * 8;
        unsigned o[4];
#pragma unroll
        for (int j = 0; j < 4; ++j) o[j] = pack2bf(T[kq + 2 * j][n], T[kq + 2 * j + 1][n]);
        bf16_t* dst = Wt + (size_t)(n0 + n) * K + k0 + kq;
        *(uint4*)dst = make_uint4(o[0], o[1], o[2], o[3]);
    }
}

struct EpBf16 {
    static constexpr bool PERM = true, AFTER_DRAIN = false;
    bf16_t* O; int ldc; int ncols;
    DEV void operator()(const pg8::f32x4 (&acc)[2][2][4][2], const pg8::Unit& u, int wr, int wc, int fr, int fq) const {
        const int row0 = u.pm * 256 + wr * 64 + fr, col0 = u.pn * 256 + wc * 32 + 8 * fq;
#pragma unroll
        for (int ai = 0; ai < 2; ++ai)
#pragma unroll
            for (int m = 0; m < 4; ++m) {
                bf16_t* rowp = O + (size_t)(row0 + ai * 128 + m * 16) * ldc + col0;
#pragma unroll
                for (int bj = 0; bj < 2; ++bj) {
                    if (col0 + bj * 128 < ncols) {
                        const pg8::f32x4 v0 = acc[ai][bj][m][0], v1 = acc[ai][bj][m][1];
                        *(uint4*)(rowp + bj * 128) = make_uint4(pack2bf(v0[0], v0[1]), pack2bf(v0[2], v0[3]), pack2bf(v1[0], v1[1]), pack2bf(v1[2], v1[3]));
                    }
                }
            }
    }
};
struct EpRes0 {
    static constexpr bool PERM = false, AFTER_DRAIN = false;
    float* C; const float* mv; int b;
    DEV void operator()(const pg8::f32x4 (&acc)[2][2][4][2], const pg8::Unit& u, int wr, int wc, int fr, int fq) const {
        const bool isc = (u.pm * 256 < NCX);
        const float* gp = mv + (isc ? 2 : b) * 3072 + 2048;
        const int row0 = u.pm * 256 + wr * 64 + fr, col0 = u.pn * 256 + wc * 32 + 4 * fq;
#pragma unroll
        for (int ai = 0; ai < 2; ++ai)
#pragma unroll
            for (int m = 0; m < 4; ++m) {
                const size_t ro = (size_t)(row0 + ai * 128 + m * 16) * DM + col0;
#pragma unroll
                for (int bj = 0; bj < 2; ++bj)
#pragma unroll
                    for (int n = 0; n < 2; ++n) {
                        const int co = bj * 128 + n * 16;
                        const float4 g = ld4(gp + col0 + co); const pg8::f32x4 v = acc[ai][bj][m][n];
                        st4(C + ro + co, make_float4(g.x * v[0], g.y * v[1], g.z * v[2], g.w * v[3]));
                    }
            }
    }
};
struct EpRes1 {
    static constexpr bool PERM = false, AFTER_DRAIN = false;
    float* C; const float* mv;
    DEV void operator()(const pg8::f32x4 (&acc)[2][2][4][2], const pg8::Unit& u, int wr, int wc, int fr, int fq) const {
        const float* gp = mv + (u.pm * 256 >= NL ? 1 : 0) * 3072 + 2048;
        const int row0 = u.pm * 256 + wr * 64 + fr, col0 = u.pn * 256 + wc * 32 + 4 * fq;
#pragma unroll
        for (int ai = 0; ai < 2; ++ai)
#pragma unroll
            for (int m = 0; m < 4; ++m) {
                const size_t ro = (size_t)(row0 + ai * 128 + m * 16) * DM + col0;
#pragma unroll
                for (int bj = 0; bj < 2; ++bj)
#pragma unroll
                    for (int n = 0; n < 2; ++n) {
                        const int co = bj * 128 + n * 16;
                        const float4 g = ld4(gp + col0 + co); const pg8::f32x4 v = acc[ai][bj][m][n];
                        st4(C + ro + co, make_float4(g.x * v[0], g.y * v[1], g.z * v[2], g.w * v[3]));
                    }
            }
    }
};
template <class EP>
DEV void run_gemm(const bf16_t* A, const bf16_t* Bt, int M, int N, int K, const EP& ep, float* sm) {
    pg8::Gemm g{A, Bt, M, N, K}; pg8::StaticOrder S; S.init(M, N, (int)gridDim.x, (int)blockIdx.x);
    pg8::gemm_phase<EP, pg8::StaticOrder, false>((PG8_LAS unsigned char*)sm, g, S, ep, nullptr);
}

template <int MT, int NT>
DEV void mini_gemm(const bf16_t* A, int lda, int row0, int row_clamp, const bf16_t* Bt, int ldb, int brow0, bf16_t* C, int ldc, int ccol0, int nvalid, float* sm) {
    const int tid = opaque_tid(), lane = tid & 63, wave = tid >> 6, l15 = lane & 15, g = lane >> 4;
    f32x4 acc[MT][NT];
#pragma unroll
    for (int m = 0; m < MT; ++m)
#pragma unroll
        for (int n = 0; n < NT; ++n) acc[m][n] = (f32x4){0.f, 0.f, 0.f, 0.f};
    const bf16_t* ap[MT]; const bf16_t* bp[NT];
#pragma unroll
    for (int m = 0; m < MT; ++m) { const int r = row0 + m * 16 + l15; ap[m] = A + (size_t)(r < row_clamp ? r : row_clamp) * lda + wave * 128 + g * 8; }
#pragma unroll
    for (int n = 0; n < NT; ++n) bp[n] = Bt + (size_t)(brow0 + n * 16 + l15) * ldb + wave * 128 + g * 8;
#pragma unroll
    for (int kh = 0; kh < 2; ++kh) {
        bf16x8 af[2][MT], bq[2][NT];
#pragma unroll
        for (int ks = 0; ks < 2; ++ks) {
#pragma unroll
            for (int m = 0; m < MT; ++m) af[ks][m] = *(const bf16x8*)(ap[m] + (kh * 2 + ks) * 32);
#pragma unroll
            for (int n = 0; n < NT; ++n) bq[ks][n] = *(const bf16x8*)(bp[n] + (kh * 2 + ks) * 32);
        }
#pragma unroll
        for (int ks = 0; ks < 2; ++ks)
#pragma unroll
            for (int m = 0; m < MT; ++m)
#pragma unroll
                for (int n = 0; n < NT; ++n) acc[m][n] = __builtin_amdgcn_mfma_f32_16x16x32_bf16(af[ks][m], bq[ks][n], acc[m][n], 0, 0, 0);
    }
    __syncthreads();
#pragma unroll
    for (int m = 0; m < MT; ++m)
#pragma unroll
        for (int n = 0; n < NT; ++n) st4(sm + ((wave * MT + m) * NT + n) * 256 + lane * 4, make_float4(acc[m][n][0], acc[m][n][1], acc[m][n][2], acc[m][n][3]));
    __syncthreads();
    for (int e = tid; e < MT * NT * 256; e += NTHR) {
        const int tile = e >> 8, idx = e & 255, ln = idx >> 2, r = idx & 3;
        float s = 0.f;
#pragma unroll
        for (int w = 0; w < NWV; ++w) s += sm[(w * MT * NT + tile) * 256 + idx];
        const int i = (tile / NT) * 16 + (ln >> 4) * 4 + r, j = (tile % NT) * 16 + (ln & 15);
        if (i < nvalid) C[(size_t)(row0 + i) * ldc + ccol0 + j] = __builtin_bit_cast(unsigned short, (__bf16)s);
    }
}

struct Mod8 { float4 s0, s1, c0, c1; };
DEV Mod8 mod8_load(const float* m, int k) { Mod8 q; q.s0 = ld4(m + k); q.s1 = ld4(m + k + 4); q.c0 = ld4(m + 1024 + k); q.c1 = ld4(m + 1024 + k + 4); return q; }
DEV uint4 mod8_apply(const float4 x0, const float4 x1, const Mod8& q) {
    return make_uint4(pack2bf(x0.x * (1.f + q.c0.x) + q.s0.x, x0.y * (1.f + q.c0.y) + q.s0.y), pack2bf(x0.z * (1.f + q.c0.z) + q.s0.z, x0.w * (1.f + q.c0.w) + q.s0.w),
                      pack2bf(x1.x * (1.f + q.c1.x) + q.s1.x, x1.y * (1.f + q.c1.y) + q.s1.y), pack2bf(x1.z * (1.f + q.c1.z) + q.s1.z, x1.w * (1.f + q.c1.w) + q.s1.w));
}
DEV void phase_h0(const Params& p, int b) {
    const float* modv = (const float*)(p.ws + OFF_MODV);
    bf16_t* H0 = (bf16_t*)(p.ws + OFF_YC);
    const int gt = blockIdx.x * NTHR + opaque_tid(), gn = gridDim.x * NTHR;
    const int k = (gt & 127) * 8;
    const Mod8 mc = mod8_load(modv + 2 * 3072, k), ml = mod8_load(modv + b * 3072, k);
    for (int i0 = gt; i0 < TB * 128; i0 += 4 * gn) {
        float4 xa[4], xb[4];
#pragma unroll
        for (int u = 0; u < 4; ++u) {
            const int i = i0 + u * gn, s = (i < TB * 128 ? i : gt) >> 7;
            const float* src = (s < NCX) ? p.in[2] + ((size_t)(b * NCX + s)) * DM + k : p.in[0] + ((size_t)(b * NL + s - NCX)) * DM + k;
            xa[u] = ld4(src); xb[u] = ld4(src + 4);
        }
#pragma unroll
        for (int u = 0; u < 4; ++u) {
            const int i = i0 + u * gn, s = i >> 7;
            if (i < TB * 128) *(uint4*)(H0 + (size_t)s * DM + k) = mod8_apply(xa[u], xb[u], (s < NCX) ? mc : ml);
        }
    }
}

DEV void phase_mod(const Params& p, float* sm) {
    const float* c = p.in[1]; const float* cctx = p.in[3];
    const float* mod_w = p.in[4]; const float* mod_b = p.in[5];
    float* modv = (float*)(p.ws + OFF_MODV);
    float* sil = sm; float* red = sm + 3072;
    const int tid = opaque_tid();
    for (int i = tid; i < 3072; i += NTHR) {
        const int j = i >> 10, k = i & 1023;
        const float v = (j < 2) ? c[j * 1024 + k] : cctx[k];
        sil[i] = silu_f(v);
    }
    __syncthreads();
    for (int unit = blockIdx.x; unit < 192; unit += gridDim.x) {
        const int l = unit / 96, cb = unit % 96;
        const int kg = tid >> 5, col = tid & 31, n = cb * 32 + col;
        const float* w = mod_w + (size_t)l * 1024 * 3072 + n;
        float a0 = 0.f, a1 = 0.f, a2 = 0.f;
        for (int k = kg * 64; k < kg * 64 + 64; ++k) {
            const float wv = w[(size_t)k * 3072];
            a0 += sil[k] * wv; a1 += sil[1024 + k] * wv; a2 += sil[2048 + k] * wv;
        }
        red[(kg * 3 + 0) * 32 + col] = a0; red[(kg * 3 + 1) * 32 + col] = a1; red[(kg * 3 + 2) * 32 + col] = a2;
        __syncthreads();
        if (tid < 96) {
            const int j = tid >> 5, cc = tid & 31, nn = cb * 32 + cc;
            float s = mod_b[l * 3072 + nn];
            for (int g = 0; g < 16; ++g) s += red[(g * 3 + j) * 32 + cc];
            modv[(l * 3 + j) * 3072 + nn] = s;
        }
        __syncthreads();
    }
}

DEV void phase_tables(const Params& p) {
    const float* wq = p.in[33]; const float* wk = p.in[34]; const float* wv = p.in[35];
    const float* gw0 = p.in[36]; const float* gw1 = p.in[38]; const float* gw2 = p.in[40]; const float* gw3 = p.in[42];
    float* gtab = (float*)(p.ws + OFF_GTAB); bf16_t* wft = (bf16_t*)(p.ws + OFF_WFT);
    const int gt = blockIdx.x * NTHR + opaque_tid(), gn = gridDim.x * NTHR;
    for (int i = gt; i < 512 * 16; i += gn) {
        const int gb = i >> 4, cp = (i >> 2) & 3, c = i & 3;
        float s = 0.f;
#pragma unroll
        for (int d = 0; d < 4; ++d) s += wq[gb * 16 + cp * 4 + d] * wk[gb * 16 + c * 4 + d];
        gtab[i] = s * KSCALE;
    }
    for (int i = gt; i < 4096 * 16; i += gn) {
        const int g = i >> 12, k = i & 4095, gm = g >> 2, hd = g & 3;
        const float* wg = gm == 0 ? gw0 : (gm == 1 ? gw1 : (gm == 2 ? gw2 : gw3));
        float s = 0.f;
        if (k < 2048) {
            const int blk = k >> 2, cc = k & 3;
#pragma unroll
            for (int d = 0; d < 4; ++d) s += wq[blk * 16 + cc * 4 + d] * wg[(size_t)(4 * blk + d) * 4 + hd] + wk[blk * 16 + cc * 4 + d] * wg[(size_t)(2048 + 4 * blk + d) * 4 + hd];
        } else {
            const int kk = k - 2048, blk = kk >> 2, cc = kk & 3;
#pragma unroll
            for (int d = 0; d < 4; ++d) s += wv[blk * 16 + cc * 4 + d] * wg[(size_t)(4096 + 4 * blk + d) * 4 + hd];
        }
        wft[i] = __builtin_bit_cast(unsigned short, (__bf16)s);
    }
}

DEV float dpp_add(float v, float acc_src, int) { return v + acc_src; }
#define DPP_F(src_, ctrl_, rmask_) __int_as_float(__builtin_amdgcn_update_dpp(0, __float_as_int(src_), (ctrl_), (rmask_), 0xf, false))
DEV float wave_scan_add(float v, int lane, int dir) {
    float p = v;
    p += DPP_F(p, 0x111, 0xf);
    p += DPP_F(p, 0x112, 0xf);
    p += DPP_F(p, 0x114, 0xf);
    p += DPP_F(p, 0x118, 0xf);
    p += DPP_F(p, 0x142, 0xa);
    p += DPP_F(p, 0x143, 0xc);
    if (dir) { const float tot = __int_as_float(__builtin_amdgcn_readlane(__float_as_int(p), 63)); p = tot - p + v; }
    return p;
}
DEV float wave_scan_max(float v, int lane, int dir) {
#pragma unroll
    for (int o = 1; o < 64; o <<= 1) {
        const float n = dir ? __shfl_down(v, o, 64) : __shfl_up(v, o, 64);
        const bool ok = dir ? (lane + o < 64) : (lane >= o);
        if (ok) v = fmaxf(v, n);
    }
    return v;
}

constexpr int GLC_OFF = 30336;
static_assert((GLC_OFF + 2176) * 4 <= LDS_BYTES - 16, "GLA constants must fit below the barrier words");
DEV void gla_consts(const Params& p, int h, float* sm) {
    const int tid = opaque_tid();
    float* sWA2 = sm + GLC_OFF; float* sBA2 = sWA2 + 2048;
    __syncthreads();
    for (int i = tid; i < 2048; i += NTHR) { const int d = i >> 10, ii = (i >> 6) & 15, k = i & 63; sWA2[i] = p.in[d ? 12 : 10][ii * 256 + h * 64 + k]; }
    if (tid < 128) sBA2[tid] = p.in[(tid >> 6) ? 13 : 11][h * 64 + (tid & 63)];
}
DEV void gla_decay_core(const float* sLRd, const float* sWAd, const float* sBAd, float* sBC, float* sTot, int dir, int tid) {
    {
        const int t = tid >> 3, k0 = (tid & 7) * 8;
        float acc[8];
#pragma unroll
        for (int j = 0; j < 8; ++j) acc[j] = sBAd[k0 + j];
#pragma unroll
        for (int ii = 0; ii < 16; ++ii) {
            const float l = sLRd[t * 16 + ii];
#pragma unroll
            for (int j = 0; j < 8; ++j) acc[j] += l * sWAd[ii * 64 + k0 + j];
        }
#pragma unroll
        for (int j = 0; j < 8; ++j) sBC[t * 65 + k0 + j] = logsig_f(acc[j]) * 0.0625f;
    }
    __syncthreads();
    {
        const int lane = tid & 63, wv = tid >> 6;
#pragma unroll
        for (int j = 0; j < 8; ++j) {
            const int k = wv * 8 + j;
            const float v = wave_scan_add(sBC[lane * 65 + k], lane, dir);
            sBC[lane * 65 + k] = v;
            if (lane == (dir ? 0 : 63)) sTot[k] = v;
        }
    }
    __syncthreads();
}

DEV bf16x8 tr_frag(const bf16_t* base, int ld, int row0, int col0, int lane) {
    const bf16_t* ptr = base + (row0 + (lane >> 4) * 8 + ((lane & 15) >> 2)) * ld + col0 + (lane & 3) * 4;
    const s16x4 lo = __builtin_amdgcn_ds_read_tr16_b64_v4i16((__attribute__((address_space(3))) s16x4*)ptr);
    const s16x4 hi = __builtin_amdgcn_ds_read_tr16_b64_v4i16((__attribute__((address_space(3))) s16x4*)(ptr + 4 * ld));
    return (bf16x8){lo[0], lo[1], lo[2], lo[3], hi[0], hi[1], hi[2], hi[3]};
}
DEV bf16x8 row_frag(const bf16_t* base, int ld, int idx0, int k0, int lane) {
    return *(const bf16x8*)(base + (idx0 + (lane & 15)) * ld + k0 + (lane >> 4) * 8);
}

DEV void gla1_unit(const Params& p, int h, int dir, int c, float* sm) {
    const int tid = opaque_tid(), lane = tid & 63, wave = tid >> 6;
    const bf16_t* P0 = (const bf16_t*)(p.ws + OFF_P0);
    float* GDS = (float*)(p.ws + OFF_GDS); float* GDEC = (float*)(p.ws + OFF_GDEC);
    float* sLR = sm; float* sBC = sm + 2048; float* sTot = sm + 6208;
    bf16_t* kT = (bf16_t*)(sm + 6272);
    bf16_t* Vs = (bf16_t*)(sm + 8576);
    const int ch = h * 2 + dir;
    const int t = tid >> 3, k0 = (tid & 7) * 8;
    const uint4 lrq = *(const uint4*)(P0 + (size_t)(c * 64 + ((tid & 127) >> 1)) * EIN + 1536 + dir * 16 + (tid & 1) * 8);
    const uint4 kq = *(const uint4*)(P0 + (size_t)(c * 64 + t) * EIN + 256 + h * 64 + k0);
    const uint4 vq0 = *(const uint4*)(P0 + (size_t)(c * 64 + (tid >> 4)) * EIN + 512 + h * 128 + (tid & 15) * 8);
    const uint4 vq1 = *(const uint4*)(P0 + (size_t)(c * 64 + 32 + (tid >> 4)) * EIN + 512 + h * 128 + (tid & 15) * 8);
    __syncthreads();
    if (tid < 128) { float* d = sLR + (tid >> 1) * 16 + (tid & 1) * 8; st4(d, make_float4(bflo(lrq.x), bfhi(lrq.x), bflo(lrq.y), bfhi(lrq.y))); st4(d + 4, make_float4(bflo(lrq.z), bfhi(lrq.z), bflo(lrq.w), bfhi(lrq.w))); }
    *(uint4*)(Vs + (tid >> 4) * 136 + (tid & 15) * 8) = vq0; *(uint4*)(Vs + (32 + (tid >> 4)) * 136 + (tid & 15) * 8) = vq1;
    __syncthreads();
    gla_decay_core(sLR, sm + GLC_OFF + dir * 1024, sm + GLC_OFF + 2048 + dir * 64, sBC, sTot, dir, tid);
    {
        float kv[8]; unpack8(kq, kv);
#pragma unroll
        for (int j = 0; j < 8; ++j) kT[(k0 + j) * 72 + t] = __builtin_bit_cast(unsigned short, (__bf16)(kv[j] * fexp(sTot[k0 + j] - sBC[t * 65 + k0 + j])));
    }
    __syncthreads();
    {
        f32x4 acc[4];
#pragma unroll
        for (int kt = 0; kt < 4; ++kt) acc[kt] = (f32x4){0.f, 0.f, 0.f, 0.f};
#pragma unroll
        for (int ks = 0; ks < 2; ++ks) {
            const bf16x8 af = tr_frag(Vs, 136, ks * 32, wave * 16, lane);
#pragma unroll
            for (int kt = 0; kt < 4; ++kt) acc[kt] = __builtin_amdgcn_mfma_f32_16x16x32_bf16(af, row_frag(kT, 72, kt * 16, ks * 32, lane), acc[kt], 0, 0, 0);
        }
#pragma unroll
        for (int kt = 0; kt < 4; ++kt) {
            const int k = kt * 16 + (lane & 15), v = wave * 16 + (lane >> 4) * 4;
            st4(GDS + ((size_t)(ch * NCH + c) * 64 + k) * 128 + v, make_float4(acc[kt][0], acc[kt][1], acc[kt][2], acc[kt][3]));
        }
    }
    if (tid < 64) GDEC[(size_t)(ch * NCH + c) * 64 + tid] = fexp(sTot[tid]);
}

DEV void gla2_unit(const Params& p, int unit) {
    const int tid = opaque_tid();
    float* GDS = (float*)(p.ws + OFF_GDS); const float* GDEC = (const float*)(p.ws + OFF_GDEC);
    const int ch = unit >> 4, e = (unit & 15) * 512 + tid, k = e >> 7, dir = ch & 1;
    constexpr int GB = 12;
    float S = 0.f, ninc[GB], nd[GB];
#pragma unroll
    for (int j = 0; j < GB; ++j) { const int c = chunk_at(dir, j); ninc[j] = GDS[(size_t)(ch * NCH + c) * 8192 + e]; nd[j] = GDEC[(size_t)(ch * NCH + c) * 64 + k]; }
#pragma unroll 1
    for (int step0 = 0; step0 < NCH; step0 += GB) {
        float inc[GB], d[GB];
#pragma unroll
        for (int j = 0; j < GB; ++j) { inc[j] = ninc[j]; d[j] = nd[j]; }
#pragma unroll
        for (int j = 0; j < GB; ++j) { const int sn = step0 + GB + j, c = chunk_at(dir, sn < NCH ? sn : NCH - 1); ninc[j] = GDS[(size_t)(ch * NCH + c) * 8192 + e]; nd[j] = GDEC[(size_t)(ch * NCH + c) * 64 + k]; }
        __builtin_amdgcn_sched_barrier(0);
#pragma unroll
        for (int j = 0; j < GB; ++j) { const int c = chunk_at(dir, step0 + j); GDS[(size_t)(ch * NCH + c) * 8192 + e] = S; S = d[j] * S + inc[j]; }
    }
}

DEV void gla3_unit(const Params& p, int h, int c, float* sm) {
    const int tid = opaque_tid(), lane = tid & 63, wave = tid >> 6;
    const bf16_t* P0 = (const bf16_t*)(p.ws + OFF_P0);
    const float* GDS = (const float*)(p.ws + OFF_GDS);
    bf16_t* YC = (bf16_t*)(p.ws + OFF_YC);
    const float* ng = p.in[14];
    float* sLR2 = sm;
    float* sBC = sm + 2048; float* sTot = sm + 6208;
    bf16_t* qt = (bf16_t*)(sm + 6272);
    bf16_t* kt = (bf16_t*)(sm + 8576);
    bf16_t* Sm = (bf16_t*)(sm + 10880);
    bf16_t* S0s = (bf16_t*)(sm + 13184);
    bf16_t* Vs = (bf16_t*)(sm + 17536);
    float* O = sm + 21888;
    const int ti = wave & 3, vt0 = (wave >> 2) * 4;
    const int t = tid >> 3, k0 = (tid & 7) * 8;
    f32x4 acc[4];
#pragma unroll
    for (int j = 0; j < 4; ++j) acc[j] = (f32x4){0.f, 0.f, 0.f, 0.f};
    const uint4 vq0 = *(const uint4*)(P0 + (size_t)(c * 64 + (tid >> 4)) * EIN + 512 + h * 128 + (tid & 15) * 8);
    const uint4 vq1 = *(const uint4*)(P0 + (size_t)(c * 64 + 32 + (tid >> 4)) * EIN + 512 + h * 128 + (tid & 15) * 8);
    const uint4 lrq = *(const uint4*)(P0 + (size_t)(c * 64 + ((tid & 255) >> 2)) * EIN + 1536 + (tid & 3) * 8);
    const uint4 qq = *(const uint4*)(P0 + (size_t)(c * 64 + t) * EIN + h * 64 + k0);
    const uint4 kq = *(const uint4*)(P0 + (size_t)(c * 64 + t) * EIN + 256 + h * 64 + k0);
    float4 s0a[4], s0b[4];
#pragma unroll
    for (int u = 0; u < 4; ++u) { const int i = tid + 512 * u, k = i >> 5, v4 = (i & 31) * 4;
        s0a[u] = ld4(GDS + (size_t)((h * 2 + 0) * NCH + c) * 8192 + k * 128 + v4); s0b[u] = ld4(GDS + (size_t)((h * 2 + 1) * NCH + c) * 8192 + k * 128 + v4); }
    const bf16_t* gp = P0 + (size_t)(c * 64 + t) * EIN + 1024 + h * 128 + (tid & 7) * 16;
    const uint4 gq0 = *(const uint4*)gp, gq1 = *(const uint4*)(gp + 8);
    __syncthreads();
    *(uint4*)(Vs + (tid >> 4) * 136 + (tid & 15) * 8) = vq0; *(uint4*)(Vs + (32 + (tid >> 4)) * 136 + (tid & 15) * 8) = vq1;
    if (tid < 256) { float* d = sLR2 + ((tid & 3) >> 1) * 1024 + (tid >> 2) * 16 + (tid & 1) * 8; st4(d, make_float4(bflo(lrq.x), bfhi(lrq.x), bflo(lrq.y), bfhi(lrq.y))); st4(d + 4, make_float4(bflo(lrq.z), bfhi(lrq.z), bflo(lrq.w), bfhi(lrq.w))); }
    __syncthreads();
#pragma unroll
    for (int dir = 0; dir < 2; ++dir) {
        gla_decay_core(sLR2 + dir * 1024, sm + GLC_OFF + dir * 1024, sm + GLC_OFF + 2048 + dir * 64, sBC, sTot, dir, tid);
        {
            float qv[8], kv[8];
            unpack8(qq, qv); unpack8(kq, kv);
#pragma unroll
            for (int j = 0; j < 8; ++j) { const float bc = sBC[t * 65 + k0 + j]; qv[j] *= 0.125f * fexp(bc); kv[j] *= fexp(-bc); }
            *(uint4*)(qt + t * 72 + k0) = make_uint4(pack2bf(qv[0], qv[1]), pack2bf(qv[2], qv[3]), pack2bf(qv[4], qv[5]), pack2bf(qv[6], qv[7]));
            *(uint4*)(kt + t * 72 + k0) = make_uint4(pack2bf(kv[0], kv[1]), pack2bf(kv[2], kv[3]), pack2bf(kv[4], kv[5]), pack2bf(kv[6], kv[7]));
#pragma unroll
            for (int u = 0; u < 4; ++u) {
                const int i = tid + 512 * u, k = i >> 5, v4 = (i & 31) * 4;
                const float4 s4 = dir ? s0b[u] : s0a[u];
                *(uint2*)(S0s + k * 136 + v4) = make_uint2(pack2bf(s4.x, s4.y), pack2bf(s4.z, s4.w));
            }
        }
        __syncthreads();
        {
            const int si = wave & 3;
#pragma unroll
            for (int jj = 0; jj < 2; ++jj) {
                const int t2 = (wave >> 2) * 2 + jj;
                f32x4 a = (f32x4){0.f, 0.f, 0.f, 0.f};
#pragma unroll
                for (int ks = 0; ks < 2; ++ks) a = __builtin_amdgcn_mfma_f32_16x16x32_bf16(row_frag(kt, 72, si * 16, ks * 32, lane), row_frag(qt, 72, t2 * 16, ks * 32, lane), a, 0, 0, 0);
                const int tq = t2 * 16 + (lane & 15), s0 = si * 16 + (lane >> 4) * 4;
                float m[4];
#pragma unroll
                for (int r = 0; r < 4; ++r) { const bool keep = dir ? (s0 + r >= tq) : (s0 + r <= tq); m[r] = keep ? a[r] : 0.f; }
                *(uint2*)(Sm + tq * 72 + s0) = make_uint2(pack2bf(m[0], m[1]), pack2bf(m[2], m[3]));
            }
        }
        __syncthreads();
#pragma unroll
        for (int ks = 0; ks < 2; ++ks) {
            const bf16x8 a1 = row_frag(qt, 72, ti * 16, ks * 32, lane), a2 = row_frag(Sm, 72, ti * 16, ks * 32, lane);
#pragma unroll
            for (int j = 0; j < 4; ++j) {
                acc[j] = __builtin_amdgcn_mfma_f32_16x16x32_bf16(a1, tr_frag(S0s, 136, ks * 32, (vt0 + j) * 16, lane), acc[j], 0, 0, 0);
                acc[j] = __builtin_amdgcn_mfma_f32_16x16x32_bf16(a2, tr_frag(Vs, 136, ks * 32, (vt0 + j) * 16, lane), acc[j], 0, 0, 0);
            }
        }
        if (dir == 0) __syncthreads();
    }
#pragma unroll
    for (int j = 0; j < 4; ++j)
#pragma unroll
        for (int r = 0; r < 4; ++r) O[(ti * 16 + (lane >> 4) * 4 + r) * 132 + (vt0 + j) * 16 + (lane & 15)] = acc[j][r];
    __syncthreads();
    {
        const int v0 = (tid & 7) * 16;
        float o[16];
        float ss = 0.f;
#pragma unroll
        for (int i = 0; i < 16; ++i) { o[i] = O[t * 132 + v0 + i]; ss += o[i] * o[i]; }
        ss = red8_sum(ss);
        const float rms = rsqrtf(ss * (1.f / 128.f) + 1e-5f);
        float g[16];
        unpack8(gq0, g); unpack8(gq1, g + 8);
        float y[16];
#pragma unroll
        for (int i = 0; i < 16; ++i) y[i] = o[i] * rms * ng[v0 + i] * silu_f(g[i]);
        bf16_t* yp = YC + (size_t)(c * 64 + t) * 1024 + h * 128 + v0;
        *(uint4*)yp = make_uint4(pack2bf(y[0], y[1]), pack2bf(y[2], y[3]), pack2bf(y[4], y[5]), pack2bf(y[6], y[7]));
        *(uint4*)(yp + 8) = make_uint4(pack2bf(y[8], y[9]), pack2bf(y[10], y[11]), pack2bf(y[12], y[13]), pack2bf(y[14], y[15]));
    }
}

DEV void load8bf(const bf16_t* ptr, float* f) { unpack8(*(const uint4*)ptr, f); }
struct RwNb { int sL, sR, sU, sD; bool vL, vR, vU, vD; };
DEV RwNb rw_nb(int s) {
    RwNb q; q.vU = false; q.vD = false;
    if (s < NCX) { q.vL = s > 0; q.vR = s < NCX - 1; }
    else { const int n = s - NCX, rr = n >> 6, cc = n & 63; q.vL = cc > 0; q.vR = cc < 63; q.vU = rr > 0; q.vD = rr < 127; }
    q.sL = q.vL ? s - 1 : s; q.sR = q.vR ? s + 1 : s; q.sU = q.vU ? s - 64 : s; q.sD = q.vD ? s + 64 : s;
    return q;
}
struct RwRaw { uint4 o, l, r, u, d; };
DEV RwRaw rw_load(const bf16_t* P0, int s, const RwNb& q, int cb) {
    RwRaw w;
    w.o = *(const uint4*)(P0 + (size_t)s * EIN + RW0 + cb); w.l = *(const uint4*)(P0 + (size_t)q.sL * EIN + RW0 + cb); w.r = *(const uint4*)(P0 + (size_t)q.sR * EIN + RW0 + cb);
    w.u = *(const uint4*)(P0 + (size_t)q.sU * EIN + RW0 + cb); w.d = *(const uint4*)(P0 + (size_t)q.sD * EIN + RW0 + cb);
    return w;
}
DEV void rw_comb_l(const RwRaw& w, const RwNb& q, const float* ml, float* out) {
    float own[8]; unpack8(w.o, own);
    const float nb[8] = {q.vL ? bflo(w.l.x) : 0.f, q.vR ? bfhi(w.r.x) : 0.f, q.vU ? bflo(w.u.y) : 0.f, q.vD ? bfhi(w.d.y) : 0.f,
                         q.vL ? bflo(w.l.z) : 0.f, q.vR ? bfhi(w.r.z) : 0.f, q.vU ? bflo(w.u.w) : 0.f, q.vD ? bfhi(w.d.w) : 0.f};
    const float4 m0 = *(const float4*)ml, m1 = *(const float4*)(ml + 4);
    const float m[8] = {m0.x, m0.y, m0.z, m0.w, m1.x, m1.y, m1.z, m1.w};
#pragma unroll
    for (int i = 0; i < 8; ++i) out[i] = own[i] + (nb[i] - own[i]) * m[i];
}
DEV void rw_comb(const RwRaw& w, const RwNb& q, const float* __restrict__ mu, int cb, float* out) {
    float own[8]; unpack8(w.o, own);
    const float nb[8] = {q.vL ? bflo(w.l.x) : 0.f, q.vR ? bfhi(w.r.x) : 0.f, q.vU ? bflo(w.u.y) : 0.f, q.vD ? bfhi(w.d.y) : 0.f,
                         q.vL ? bflo(w.l.z) : 0.f, q.vR ? bfhi(w.r.z) : 0.f, q.vU ? bflo(w.u.w) : 0.f, q.vD ? bfhi(w.d.w) : 0.f};
    const float4 m0 = ld4(mu + cb), m1 = ld4(mu + cb + 4);
    const float m[8] = {m0.x, m0.y, m0.z, m0.w, m1.x, m1.y, m1.z, m1.w};
#pragma unroll
    for (int i = 0; i < 8; ++i) out[i] = own[i] + (nb[i] - own[i]) * m[i];
}
DEV uint4 pack8(const float* f) { return make_uint4(pack2bf(f[0], f[1]), pack2bf(f[2], f[3]), pack2bf(f[4], f[5]), pack2bf(f[6], f[7])); }

template <int XM, int YM, class F>
DEV void mm64(const bf16_t* X, const bf16_t* Y, F f, int lane, int wave) {
#pragma unroll
    for (int q = 0; q < 2; ++q) {
        const int idx = wave * 2 + q, ti = idx >> 2, tj = idx & 3;
        f32x4 acc = (f32x4){0.f, 0.f, 0.f, 0.f};
#pragma unroll
        for (int ks = 0; ks < 2; ++ks) {
            const bf16x8 a = XM == 0 ? row_frag(X, 72, ti * 16, ks * 32, lane) : tr_frag(X, 72, ks * 32, ti * 16, lane);
            const bf16x8 bq = YM == 0 ? row_frag(Y, 72, tj * 16, ks * 32, lane) : tr_frag(Y, 72, ks * 32, tj * 16, lane);
            acc = __builtin_amdgcn_mfma_f32_16x16x32_bf16(a, bq, acc, 0, 0, 0);
        }
        f(ti * 16 + (lane >> 4) * 4, tj * 16 + (lane & 15), acc);
    }
}
template <int XM, int YM, class F>
DEV void mm64x2(const bf16_t* X1, const bf16_t* Y1, const bf16_t* X2, const bf16_t* Y2, F f, int lane, int wave) {
#pragma unroll
    for (int q = 0; q < 2; ++q) {
        const int idx = wave * 2 + q, ti = idx >> 2, tj = idx & 3;
        f32x4 acc = (f32x4){0.f, 0.f, 0.f, 0.f};
#pragma unroll
        for (int ks = 0; ks < 2; ++ks) {
            const bf16x8 a = XM == 0 ? row_frag(X1, 72, ti * 16, ks * 32, lane) : tr_frag(X1, 72, ks * 32, ti * 16, lane);
            const bf16x8 bq = YM == 0 ? row_frag(Y1, 72, tj * 16, ks * 32, lane) : tr_frag(Y1, 72, ks * 32, tj * 16, lane);
            acc = __builtin_amdgcn_mfma_f32_16x16x32_bf16(a, bq, acc, 0, 0, 0);
            const bf16x8 a2 = XM == 0 ? row_frag(X2, 72, ti * 16, ks * 32, lane) : tr_frag(X2, 72, ks * 32, ti * 16, lane);
            const bf16x8 b2 = YM == 0 ? row_frag(Y2, 72, tj * 16, ks * 32, lane) : tr_frag(Y2, 72, ks * 32, tj * 16, lane);
            acc = __builtin_amdgcn_mfma_f32_16x16x32_bf16(a2, b2, acc, 0, 0, 0);
        }
        f(ti * 16 + (lane >> 4) * 4, tj * 16 + (lane & 15), acc);
    }
}
DEV void st_img(bf16_t* P, int i0, int j, float a0, float a1, float a2, float a3) {
    P[(i0 + 0) * 72 + j] = __builtin_bit_cast(unsigned short, (__bf16)a0); P[(i0 + 1) * 72 + j] = __builtin_bit_cast(unsigned short, (__bf16)a1);
    P[(i0 + 2) * 72 + j] = __builtin_bit_cast(unsigned short, (__bf16)a2); P[(i0 + 3) * 72 + j] = __builtin_bit_cast(unsigned short, (__bf16)a3);
}

struct RwRaw3 { uint4 o, u, d; };
DEV RwRaw3 rw_load3(const bf16_t* P0, int s, const RwNb& q, int cb) {
    RwRaw3 w;
    w.o = *(const uint4*)(P0 + (size_t)s * EIN + RW0 + cb); w.u = *(const uint4*)(P0 + (size_t)q.sU * EIN + RW0 + cb); w.d = *(const uint4*)(P0 + (size_t)q.sD * EIN + RW0 + cb);
    return w;
}
DEV void rw_comb3(const RwRaw3& w, const RwNb& q, const bf16_t* tile, const bf16_t* P0, int s, int t, int cb, int j0, const float* ml, float* out) {
    asm volatile("" :: "v"(w.u.x), "v"(w.u.z), "v"(w.d.x), "v"(w.d.z));
    float own[8]; unpack8(w.o, own);
    float l0 = 0.f, l4 = 0.f, r1 = 0.f, r5 = 0.f;
    if (q.vL) { if (t > 0) { l0 = bf2f(tile[(t - 1) * 72 + j0]); l4 = bf2f(tile[(t - 1) * 72 + j0 + 4]); }
                else { const bf16_t* g = P0 + (size_t)(s - 1) * EIN + RW0 + cb; l0 = bf2f(g[0]); l4 = bf2f(g[4]); } }
    if (q.vR) { if (t < 63) { r1 = bf2f(tile[(t + 1) * 72 + j0 + 1]); r5 = bf2f(tile[(t + 1) * 72 + j0 + 5]); }
                else { const bf16_t* g = P0 + (size_t)(s + 1) * EIN + RW0 + cb; r1 = bf2f(g[1]); r5 = bf2f(g[5]); } }
    const float nb[8] = {l0, r1, q.vU ? bflo(w.u.y) : 0.f, q.vD ? bfhi(w.d.y) : 0.f, l4, r5, q.vU ? bflo(w.u.w) : 0.f, q.vD ? bfhi(w.d.w) : 0.f};
    const float4 m0 = *(const float4*)ml, m1 = *(const float4*)(ml + 4);
    const float m[8] = {m0.x, m0.y, m0.z, m0.w, m1.x, m1.y, m1.z, m1.w};
#pragma unroll
    for (int i = 0; i < 8; ++i) out[i] = own[i] + (nb[i] - own[i]) * m[i];
}
template <int XM, int YM, class F>
DEV void mm64t(const bf16_t* X, const bf16_t* Y, F f, int lane, int wave) {
#pragma unroll
    for (int q = 0; q < 2; ++q) {
        const int idx = wave * 2 + q, ti = idx >> 2, tj = idx & 3;
        f32x4 acc = (f32x4){0.f, 0.f, 0.f, 0.f};
#pragma unroll
        for (int ks = 0; ks < 2; ++ks) {
            const bf16x8 a = XM == 0 ? row_frag(X, 72, ti * 16, ks * 32, lane) : tr_frag(X, 72, ks * 32, ti * 16, lane);
            const bf16x8 bq = YM == 0 ? row_frag(Y, 72, tj * 16, ks * 32, lane) : tr_frag(Y, 72, ks * 32, tj * 16, lane);
            acc = __builtin_amdgcn_mfma_f32_16x16x32_bf16(bq, a, acc, 0, 0, 0);
        }
        f(ti * 16 + (lane & 15), tj * 16 + (lane >> 4) * 4, acc);
    }
}
DEV void st_row(bf16_t* P, int i, int j0, float a0, float a1, float a2, float a3) { *(uint2*)(P + i * 72 + j0) = make_uint2(pack2bf(a0, a1), pack2bf(a2, a3)); }
struct R1Raw { RwRaw3 r, k, v, w, a; float4 qw0, qw1, qa0, qa1; };
DEV void r1_consts(const Params& p, int h, int dir, float* sm) {
    const int tid = opaque_tid();
    float* sv = (float*)((bf16_t*)sm + 14 * 4608);
    __syncthreads();
    if (tid < 64) { const int hc = h * 64 + tid; sv[64 + tid] = p.in[dir ? 18 : 16][hc]; sv[128 + tid] = p.in[dir ? 22 : 20][hc]; sv[192 + tid] = p.in[24][hc]; sv[256 + tid] = p.in[25][hc]; sv[320 + tid] = p.in[26][hc]; }
    if (tid < 320) { const int tn = tid >> 6, col = tid & 63; const int cb = tn < 3 ? tn * 512 + h * 64 : (tn == 3 ? 2048 + dir * 64 : 2176 + dir * 64); sv[384 + tid] = p.in[15][cb + col]; }
}
DEV void r1_load(const Params& p, int h, int dir, int c, R1Raw& R) {
    const int tid = opaque_tid();
    const bf16_t* P0 = (const bf16_t*)(p.ws + OFF_P0);
    const float* ww2 = p.in[dir ? 19 : 17]; const float* wa2 = p.in[dir ? 23 : 21];
    const int t = tid >> 3, j0 = (tid & 7) * 8, s = c * 64 + t;
    const RwNb nbq = rw_nb(s);
    R.r = rw_load3(P0, s, nbq, h * 64 + j0); R.k = rw_load3(P0, s, nbq, 512 + h * 64 + j0); R.v = rw_load3(P0, s, nbq, 1024 + h * 64 + j0);
    R.w = rw_load3(P0, s, nbq, 2048 + dir * 64 + j0); R.a = rw_load3(P0, s, nbq, 2176 + dir * 64 + j0);
    R.qw0 = ld4(ww2 + (size_t)t * 512 + h * 64 + j0); R.qw1 = ld4(ww2 + (size_t)t * 512 + h * 64 + j0 + 4);
    R.qa0 = ld4(wa2 + (size_t)t * 512 + h * 64 + j0); R.qa1 = ld4(wa2 + (size_t)t * 512 + h * 64 + j0 + 4);
}
DEV void rwkv1_unit(const Params& p, int h, int dir, int c, float* sm, R1Raw& R, int cnext) {
    const int tid = opaque_tid(), lane = tid & 63, wave = tid >> 6;
    bf16_t* RU = (bf16_t*)(p.ws + OFF_RU) + (size_t)((h * 2 + dir) * NCH + c) * 16384;
    float* BONS = (float*)(p.ws + OFF_BONS);
    bf16_t* img = (bf16_t*)sm;
#define SLOT(i_) (img + (i_) * 4608)
    float* fLW = (float*)SLOT(10);
    float* fAS = (float*)SLOT(12);
    float* sv = (float*)SLOT(14);
    const int t = tid >> 3, j0 = (tid & 7) * 8, s = c * 64 + t;
    const bf16_t* P0 = (const bf16_t*)(p.ws + OFF_P0);
    __syncthreads();
    *(uint4*)(SLOT(0) + t * 72 + j0) = R.r.o; *(uint4*)(SLOT(1) + t * 72 + j0) = R.k.o; *(uint4*)(SLOT(2) + t * 72 + j0) = R.v.o;
    *(uint4*)(SLOT(3) + t * 72 + j0) = R.w.o; *(uint4*)(SLOT(4) + t * 72 + j0) = R.a.o;
    __syncthreads();
    float r8[8], k8[8], v8[8];
    {
        float x8[8];
        const RwNb nbq = rw_nb(s);
        rw_comb3(R.r, nbq, SLOT(0), P0, s, t, h * 64 + j0, j0, sv + 384 + j0, r8);
        rw_comb3(R.k, nbq, SLOT(1), P0, s, t, 512 + h * 64 + j0, j0, sv + 448 + j0, k8);
        rw_comb3(R.v, nbq, SLOT(2), P0, s, t, 1024 + h * 64 + j0, j0, sv + 512 + j0, v8);
        rw_comb3(R.w, nbq, SLOT(3), P0, s, t, 2048 + dir * 64 + j0, j0, sv + 576 + j0, x8);
#pragma unroll
        for (int i = 0; i < 8; ++i) x8[i] = tanh_f(x8[i]);
        *(uint4*)(SLOT(6) + t * 72 + j0) = pack8(x8);
        rw_comb3(R.a, nbq, SLOT(4), P0, s, t, 2176 + dir * 64 + j0, j0, sv + 640 + j0, x8);
        *(uint4*)(SLOT(7) + t * 72 + j0) = pack8(x8);
        { const float wq[8] = {R.qw0.x, R.qw0.y, R.qw0.z, R.qw0.w, R.qw1.x, R.qw1.y, R.qw1.z, R.qw1.w}; *(uint4*)(SLOT(8) + t * 72 + j0) = pack8(wq); }
        { const float wq[8] = {R.qa0.x, R.qa0.y, R.qa0.z, R.qa0.w, R.qa1.x, R.qa1.y, R.qa1.z, R.qa1.w}; *(uint4*)(SLOT(9) + t * 72 + j0) = pack8(wq); }
    }
    r1_load(p, h, dir, cnext >= 0 ? cnext : c, R);
    __syncthreads();
    mm64t<0, 1>(SLOT(6), SLOT(8), [=](int i, int jq, f32x4 a) {
        const float4 b4 = ld4(sv + 64 + jq);
        st4(fLW + i * 68 + jq, make_float4(-0.6065306597f * sigmoid_f(b4.x + a[0]), -0.6065306597f * sigmoid_f(b4.y + a[1]), -0.6065306597f * sigmoid_f(b4.z + a[2]), -0.6065306597f * sigmoid_f(b4.w + a[3]))); }, lane, wave);
    mm64t<0, 1>(SLOT(7), SLOT(9), [=](int i, int jq, f32x4 a) {
        const float4 b4 = ld4(sv + 128 + jq);
        st4(fAS + i * 68 + jq, make_float4(sigmoid_f(b4.x + a[0]), sigmoid_f(b4.y + a[1]), sigmoid_f(b4.z + a[2]), sigmoid_f(b4.w + a[3]))); }, lane, wave);
    __syncthreads();
#pragma unroll
    for (int j = 0; j < 8; ++j) {
        const int k = wave * 8 + j;
        const float v = wave_scan_add(fLW[lane * 68 + k], lane, dir);
        fLW[lane * 68 + k] = v;
        if (lane == (dir ? 0 : 63)) sv[k] = v;
    }
    __syncthreads();
    {
        float kkv[8], ss = 0.f;
#pragma unroll
        for (int i = 0; i < 8; ++i) { kkv[i] = k8[i] * sv[192 + j0 + i]; ss += kkv[i] * kkv[i]; }
        ss = red8_sum(ss);
        const float rn = rsqrtf(fmaxf(ss, 1e-24f));
        float fa[8], fb[8], fk[8], fr[8], fbp[8], fkp[8], bon = 0.f;
        const int tp = dir ? t + 1 : t - 1;
        const bool hasp = dir ? (t < 63) : (t > 0);
        const int tpc = hasp ? tp : t;
        float Bt8[8], Bx8[8], as8[8];
        { const float4 q0 = ld4(fLW + t * 68 + j0), q1 = ld4(fLW + t * 68 + j0 + 4), x0 = ld4(fLW + tpc * 68 + j0), x1 = ld4(fLW + tpc * 68 + j0 + 4), s0 = ld4(fAS + t * 68 + j0), s1 = ld4(fAS + t * 68 + j0 + 4);
          Bt8[0] = q0.x; Bt8[1] = q0.y; Bt8[2] = q0.z; Bt8[3] = q0.w; Bt8[4] = q1.x; Bt8[5] = q1.y; Bt8[6] = q1.z; Bt8[7] = q1.w;
          Bx8[0] = x0.x; Bx8[1] = x0.y; Bx8[2] = x0.z; Bx8[3] = x0.w; Bx8[4] = x1.x; Bx8[5] = x1.y; Bx8[6] = x1.z; Bx8[7] = x1.w;
          as8[0] = s0.x; as8[1] = s0.y; as8[2] = s0.z; as8[3] = s0.w; as8[4] = s1.x; as8[5] = s1.y; as8[6] = s1.z; as8[7] = s1.w; }
#pragma unroll
        for (int i = 0; i < 8; ++i) {
            const int k = j0 + i;
            const float Bt = Bt8[i], Bx = hasp ? Bx8[i] : 0.f, asg = as8[i];
            const float kk = kkv[i] * rn, kh = k8[i] * (1.f + (asg - 1.f) * sv[256 + k]);
            bon += r8[i] * kh * sv[320 + k];
            const float enB = fexp(-Bt), eLB = fexp(sv[k] - Bt), bv = kk * asg;
            fa[i] = -kk * fexp(Bx); fb[i] = bv * enB; fk[i] = kh * enB; fr[i] = r8[i] * fexp(Bt); fbp[i] = bv * eLB; fkp[i] = kh * eLB;
        }
        bon = red8_sum(bon);
        if ((tid & 7) == 0) BONS[((size_t)dir * TB + s) * 8 + h] = bon;
        *(uint4*)(SLOT(0) + t * 72 + j0) = pack8(fa); *(uint4*)(SLOT(1) + t * 72 + j0) = pack8(fb); *(uint4*)(SLOT(2) + t * 72 + j0) = pack8(fk);
        *(uint4*)(SLOT(3) + t * 72 + j0) = pack8(fr); *(uint4*)(SLOT(4) + t * 72 + j0) = pack8(fbp); *(uint4*)(SLOT(5) + t * 72 + j0) = pack8(fkp);
    }
    __syncthreads();
    *(uint4*)(SLOT(6) + t * 72 + j0) = pack8(v8);
    __syncthreads();
    mm64t<0, 0>(SLOT(0), SLOT(1), [=](int i, int j0, f32x4 a) {
        float m[4];
#pragma unroll
        for (int r = 0; r < 4; ++r) { const bool keep = dir ? (j0 + r > i) : (j0 + r < i); m[r] = keep ? a[r] : 0.f; }
        const bool dg = (i >> 4) == (j0 >> 4);
        st_row(SLOT(7), i, j0, dg ? m[0] : 0.f, dg ? m[1] : 0.f, dg ? m[2] : 0.f, dg ? m[3] : 0.f);
        st_row(SLOT(8), i, j0, (dg ? m[0] : 0.f) + (j0 == i ? 1.f : 0.f), (dg ? m[1] : 0.f) + (j0 + 1 == i ? 1.f : 0.f), (dg ? m[2] : 0.f) + (j0 + 2 == i ? 1.f : 0.f), (dg ? m[3] : 0.f) + (j0 + 3 == i ? 1.f : 0.f));
        st_row(SLOT(12), i, j0, dg ? 0.f : m[0], dg ? 0.f : m[1], dg ? 0.f : m[2], dg ? 0.f : m[3]); }, lane, wave);
    mm64t<0, 0>(SLOT(0), SLOT(2), [=](int i, int j0, f32x4 a) {
        float m[4];
#pragma unroll
        for (int r = 0; r < 4; ++r) { const bool keep = dir ? (j0 + r > i) : (j0 + r < i); m[r] = keep ? a[r] : 0.f; }
        st_row(SLOT(9), i, j0, m[0], m[1], m[2], m[3]); }, lane, wave);
    mm64t<0, 0>(SLOT(3), SLOT(1), [=](int i, int j0, f32x4 a) {
        float m[4];
#pragma unroll
        for (int r = 0; r < 4; ++r) { const bool keep = dir ? (j0 + r >= i) : (j0 + r <= i); m[r] = keep ? a[r] : 0.f; }
        st_row(SLOT(10), i, j0, m[0], m[1], m[2], m[3]); }, lane, wave);
    mm64t<0, 0>(SLOT(3), SLOT(2), [=](int i, int j0, f32x4 a) {
        float m[4];
#pragma unroll
        for (int r = 0; r < 4; ++r) { const bool keep = dir ? (j0 + r >= i) : (j0 + r <= i); m[r] = keep ? a[r] : 0.f; }
        st_row(SLOT(11), i, j0, m[0], m[1], m[2], m[3]); }, lane, wave);
    __syncthreads();
#define R1_TADD(dst_, told_) [=](int i, int j0, f32x4 a) { const uint2 tt = *(const uint2*)((told_) + i * 72 + j0); \
        st_row((dst_), i, j0, a[0] + bflo(tt.x), a[1] + bfhi(tt.x), a[2] + bflo(tt.y), a[3] + bfhi(tt.y)); }
    mm64t<0, 1>(SLOT(7), SLOT(7), [=](int i, int j0, f32x4 a) { st_row(SLOT(1), i, j0, a[0], a[1], a[2], a[3]); }, lane, wave);
    mm64t<0, 1>(SLOT(9), SLOT(6), [=](int i, int j0, f32x4 a) { st_row(SLOT(13), i, j0, a[0], a[1], a[2], a[3]); }, lane, wave);
    __syncthreads();
    mm64t<0, 1>(SLOT(1), SLOT(1), [=](int i, int j0, f32x4 a) { st_row(SLOT(7), i, j0, a[0], a[1], a[2], a[3]); }, lane, wave);
    mm64t<0, 1>(SLOT(8), SLOT(1), R1_TADD(SLOT(2), SLOT(8)), lane, wave);
    __syncthreads();
    mm64t<0, 1>(SLOT(7), SLOT(7), [=](int i, int j0, f32x4 a) { st_row(SLOT(1), i, j0, a[0], a[1], a[2], a[3]); }, lane, wave);
    mm64t<0, 1>(SLOT(2), SLOT(7), R1_TADD(SLOT(8), SLOT(2)), lane, wave);
    __syncthreads();
    mm64t<0, 1>(SLOT(8), SLOT(1), R1_TADD(SLOT(2), SLOT(8)), lane, wave);
    __syncthreads();
#undef R1_TADD
    mm64t<0, 1>(SLOT(2), SLOT(12), [=](int i, int j0, f32x4 a) { st_row(SLOT(7), i, j0, a[0], a[1], a[2], a[3]); }, lane, wave);
    mm64t<0, 1>(SLOT(2), SLOT(0), [=](int i, int j0, f32x4 a) { st_row(SLOT(1), i, j0, a[0], a[1], a[2], a[3]); }, lane, wave);
    mm64t<0, 1>(SLOT(2), SLOT(13), [=](int i, int j0, f32x4 a) { st_row(SLOT(8), i, j0, a[0], a[1], a[2], a[3]); }, lane, wave);
    __syncthreads();
    {
        const bf16_t* Zp = (wave < 4) ? SLOT(1) : SLOT(8);
        bf16_t* Xi = (wave < 4) ? SLOT(12) : SLOT(9);
        const int ct = (wave & 3) * 16, g4 = (lane >> 4) * 4, l15 = lane & 15;
#pragma unroll
        for (int bs = 0; bs < 4; ++bs) {
            const int bi = dir ? 3 - bs : bs;
            const uint2 zz = *(const uint2*)(Zp + (bi * 16 + l15) * 72 + ct + g4);
            f32x4 acc = (f32x4){bflo(zz.x), bfhi(zz.x), bflo(zz.y), bfhi(zz.y)};
            const bool k0 = dir ? (bi == 0) : (bi >= 1), k1 = dir ? (bi <= 2) : (bi == 3);
            if (k0) acc = __builtin_amdgcn_mfma_f32_16x16x32_bf16(tr_frag(Xi, 72, 0, ct, lane), row_frag(SLOT(7), 72, bi * 16, 0, lane), acc, 0, 0, 0);
            if (k1) acc = __builtin_amdgcn_mfma_f32_16x16x32_bf16(tr_frag(Xi, 72, 32, ct, lane), row_frag(SLOT(7), 72, bi * 16, 32, lane), acc, 0, 0, 0);
            st_row(Xi, bi * 16 + l15, ct + g4, acc[0], acc[1], acc[2], acc[3]);
            __syncthreads();
        }
    }
    mm64<1, 1>(SLOT(12), SLOT(4), [=](int i0, int j, f32x4 a) {
        float m[4];
#pragma unroll
        for (int r = 0; r < 4; ++r) m[r] = a[r] + ((i0 + r) == j ? fexp(sv[j]) : 0.f);
        *(uint2*)(RU + j * 64 + i0) = make_uint2(pack2bf(m[0], m[1]), pack2bf(m[2], m[3])); }, lane, wave);
    mm64x2<1, 1>(SLOT(4), SLOT(9), SLOT(5), SLOT(6), [=](int i0, int j, f32x4 a) {
        *(uint2*)(RU + 4096 + j * 64 + i0) = make_uint2(pack2bf(a[0], a[1]), pack2bf(a[2], a[3])); }, lane, wave);
    mm64<1, 0>(SLOT(12), SLOT(10), [=](int i0, int j, f32x4 a) {
        const uint2 rr = *(const uint2*)(SLOT(3) + j * 72 + i0);
        *(uint2*)(RU + 8192 + j * 64 + i0) = make_uint2(pack2bf(a[0] + bflo(rr.x), a[1] + bfhi(rr.x)), pack2bf(a[2] + bflo(rr.y), a[3] + bfhi(rr.y))); }, lane, wave);
    mm64x2<0, 1>(SLOT(10), SLOT(9), SLOT(11), SLOT(6), [=](int i0, int j, f32x4 a) {
        *(uint2*)(RU + 12288 + j * 64 + i0) = make_uint2(pack2bf(a[0], a[1]), pack2bf(a[2], a[3])); }, lane, wave);
#undef SLOT
}

#define R2_LOAD(M_, C_, rnd_) do { const int r0_ = ((rnd_) < R2_NR ? (rnd_) : R2_NR - 1) * R2_RS; \
    _Pragma("unroll") for (int s_ = 0; s_ < R2_RS; ++s_) M_[s_] = *(const uint4*)(RU + (size_t)(chain * NCH + chunk_at(dir, r0_ + s_)) * 16384 + tid * 8); \
    _Pragma("unroll") for (int j_ = 0; j_ < 3; ++j_) { const int cq_ = tid + 512 * j_; \
        C_[j_] = *(const uint4*)(RU + (size_t)(chain * NCH + chunk_at(dir, r0_ + (cq_ >> 7))) * 16384 + 4096 + (vblk * 16 + ((cq_ >> 3) & 15)) * 64 + (cq_ & 7) * 8); } } while (0)
#define R2_ROUND(M_, C_, rnd_) do { \
    { const int row_ = tid >> 3, c8_ = tid & 7, sw_ = (row_ >> 1) & 7, u0_ = (c8_ >> 2) * 4 + (c8_ & 1) * 2, eh_ = ((c8_ >> 1) & 1) * 8; \
      _Pragma("unroll") for (int s_ = 0; s_ < R2_RS; ++s_) { char* sl_ = ring + s_ * 10240 + row_ * 128 + eh_; \
          *(uint2*)(sl_ + ((u0_ ^ sw_) * 16)) = make_uint2(M_[s_].x, M_[s_].y); *(uint2*)(sl_ + (((u0_ + 1) ^ sw_) * 16)) = make_uint2(M_[s_].z, M_[s_].w); } \
      _Pragma("unroll") for (int j_ = 0; j_ < 3; ++j_) { const int cq_ = tid + 512 * j_, rw_ = (cq_ >> 3) & 15, q8_ = cq_ & 7, i_ = q8_ >> 1, g0_ = (q8_ & 1) * 2, sc_ = (rw_ >> 1) & 7; \
          char* sl_ = ring + (cq_ >> 7) * 10240 + 8192 + rw_ * 128 + (i_ & 1) * 8; \
          *(uint2*)(sl_ + (((g0_ * 2 + (i_ >> 1)) ^ sc_) * 16)) = make_uint2(C_[j_].x, C_[j_].y); *(uint2*)(sl_ + ((((g0_ + 1) * 2 + (i_ >> 1)) ^ sc_) * 16)) = make_uint2(C_[j_].z, C_[j_].w); } } \
    R2_LOAD(M_, C_, (rnd_) + 2); \
    __syncthreads(); \
    if (wave == 0) { \
        _Pragma("unroll 4") for (int s_ = 0; s_ < R2_RS; ++s_) { \
            const int c_ = chunk_at(dir, (rnd_) * R2_RS + s_); const char* sl_ = ring + s_ * 10240; \
            unsigned pk_[4][2]; \
            _Pragma("unroll") for (int i_ = 0; i_ < 4; ++i_) { pk_[i_][0] = pack2bf(st[i_][0], st[i_][1]); pk_[i_][1] = pack2bf(st[i_][2], st[i_][3]); } \
            bf16_t* sp_ = S0G + ((size_t)(chain * NCH + c_) * 64 + vblk * 16 + l15) * 64 + g * 4; \
            _Pragma("unroll") for (int i_ = 0; i_ < 4; ++i_) *(uint2*)(sp_ + i_ * 16) = make_uint2(pk_[i_][0], pk_[i_][1]); \
            bf16x8 bfr_[2]; \
            _Pragma("unroll") for (int ks_ = 0; ks_ < 2; ++ks_) { const uint4 u_ = make_uint4(pk_[2 * ks_][0], pk_[2 * ks_][1], pk_[2 * ks_ + 1][0], pk_[2 * ks_ + 1][1]); bfr_[ks_] = __builtin_bit_cast(bf16x8, u_); } \
            const uint4 c01_ = *(const uint4*)(sl_ + 8192 + l15 * 128 + (((g * 2) ^ ((l15 >> 1) & 7)) * 16)), c23_ = *(const uint4*)(sl_ + 8192 + l15 * 128 + (((g * 2 + 1) ^ ((l15 >> 1) & 7)) * 16)); \
            const unsigned cw_[8] = {c01_.x, c01_.y, c01_.z, c01_.w, c23_.x, c23_.y, c23_.z, c23_.w}; \
            _Pragma("unroll") for (int i_ = 0; i_ < 4; ++i_) { \
                f32x4 acc_ = (f32x4){bflo(cw_[2 * i_]), bfhi(cw_[2 * i_]), bflo(cw_[2 * i_ + 1]), bfhi(cw_[2 * i_ + 1])}; \
                _Pragma("unroll") for (int ks_ = 0; ks_ < 2; ++ks_) { \
                    const int row_ = i_ * 16 + l15; \
                    const bf16x8 af_ = *(const bf16x8*)(sl_ + row_ * 128 + (((ks_ * 4 + g) ^ ((row_ >> 1) & 7)) * 16)); \
                    acc_ = __builtin_amdgcn_mfma_f32_16x16x32_bf16(af_, bfr_[ks_], acc_, 0, 0, 0); } \
                st[i_] = acc_; } } } \
    __syncthreads(); } while (0)
DEV void rwkv2_unit(const Params& p, int chain, int vblk, float* sm) {
    constexpr int R2_RS = 12, R2_NR = NCH / R2_RS;
    static_assert(R2_NR * R2_RS == NCH && R2_RS * 10240 <= LDS_BYTES, "R2 ring");
    const int tid = opaque_tid(), lane = tid & 63, wave = tid >> 6;
    const bf16_t* RU = (const bf16_t*)(p.ws + OFF_RU);
    bf16_t* S0G = (bf16_t*)(p.ws + OFF_RS0);
    char* ring = (char*)sm;
    const int dir = chain & 1, g = lane >> 4, l15 = lane & 15;
    f32x4 st[4];
#pragma unroll
    for (int i = 0; i < 4; ++i) st[i] = (f32x4){0.f, 0.f, 0.f, 0.f};
    uint4 ma[R2_RS], ca[3], mb[R2_RS], cb[3];
    __syncthreads();
    R2_LOAD(ma, ca, 0); R2_LOAD(mb, cb, 1);
#pragma unroll 1
    for (int rnd = 0; rnd < R2_NR; rnd += 2) {
        R2_ROUND(ma, ca, rnd);
        if (rnd + 1 < R2_NR) R2_ROUND(mb, cb, rnd + 1);
    }
}
#undef R2_LOAD
#undef R2_ROUND

DEV void rwkv3_unit(const Params& p, int h, int c, float* sm) {
    const int tid = opaque_tid(), lane = tid & 63, wave = tid >> 6;
    const bf16_t* P0 = (const bf16_t*)(p.ws + OFF_P0);
    const bf16_t* RUb = (const bf16_t*)(p.ws + OFF_RU);
    const bf16_t* S0G = (const bf16_t*)(p.ws + OFF_RS0);
    const float* BONS = (const float*)(p.ws + OFF_BONS);
    bf16_t* YC = (bf16_t*)(p.ws + OFF_YC);
    const float* mu = p.in[15]; const float* gn_g = p.in[27]; const float* gn_b = p.in[28];
    bf16_t* img = (bf16_t*)sm;
    float* O = sm + 4 * 2304;
    const int t = tid >> 3, v0 = (tid & 7) * 8, s = c * 64 + t;
    const size_t u0 = (size_t)((h * 2 + 0) * NCH + c), u1 = (size_t)((h * 2 + 1) * NCH + c);
    const uint4 gr0 = *(const uint4*)(RUb + u0 * 16384 + 8192 + t * 64 + v0), gs0 = *(const uint4*)(S0G + u0 * 4096 + t * 64 + v0);
    const uint4 gr1 = *(const uint4*)(RUb + u1 * 16384 + 8192 + t * 64 + v0), gs1 = *(const uint4*)(S0G + u1 * 4096 + t * 64 + v0);
    uint2 yl[2][2];
#pragma unroll
    for (int q = 0; q < 2; ++q) { const int idx = wave * 2 + q, ti = idx >> 2, tj = idx & 3;
        yl[q][0] = *(const uint2*)(RUb + u0 * 16384 + 12288 + (tj * 16 + (lane & 15)) * 64 + ti * 16 + (lane >> 4) * 4);
        yl[q][1] = *(const uint2*)(RUb + u1 * 16384 + 12288 + (tj * 16 + (lane & 15)) * 64 + ti * 16 + (lane >> 4) * 4); }
    const RwNb nbq = rw_nb(s);
    const RwRaw wv_ = rw_load(P0, s, nbq, 1024 + h * 64 + v0), wg_ = rw_load(P0, s, nbq, 1536 + h * 64 + v0);
    const float bon = BONS[(size_t)s * 8 + h] + BONS[((size_t)TB + s) * 8 + h];
    __syncthreads();
    *(uint4*)(img + 0 * 4608 + t * 72 + v0) = gr0; *(uint4*)(img + 2 * 4608 + t * 72 + v0) = gs0;
    *(uint4*)(img + 1 * 4608 + t * 72 + v0) = gr1; *(uint4*)(img + 3 * 4608 + t * 72 + v0) = gs1;
    __syncthreads();
#pragma unroll
    for (int q = 0; q < 2; ++q) {
        const int idx = wave * 2 + q, ti = idx >> 2, tj = idx & 3;
        f32x4 accd[2];
#pragma unroll
        for (int dir = 0; dir < 2; ++dir) {
            f32x4 acc = (f32x4){bflo(yl[q][dir].x), bfhi(yl[q][dir].x), bflo(yl[q][dir].y), bfhi(yl[q][dir].y)};
#pragma unroll
            for (int ks = 0; ks < 2; ++ks) acc = __builtin_amdgcn_mfma_f32_16x16x32_bf16(row_frag(img + dir * 4608, 72, ti * 16, ks * 32, lane), row_frag(img + (2 + dir) * 4608, 72, tj * 16, ks * 32, lane), acc, 0, 0, 0);
            accd[dir] = acc;
        }
#pragma unroll
        for (int r = 0; r < 4; ++r) {
            const int oi = (ti * 16 + (lane >> 4) * 4 + r) * 68 + tj * 16 + (lane & 15);
            O[oi] = accd[0][r] + accd[1][r];
        }
    }
    __syncthreads();
    {
        float y[8], sum = 0.f;
#pragma unroll
        for (int i = 0; i < 8; ++i) { y[i] = O[t * 68 + v0 + i]; sum += y[i]; }
        sum = red8_sum(sum);
        const float mean = sum * (1.f / 64.f);
        float sq = 0.f;
#pragma unroll
        for (int i = 0; i < 8; ++i) { y[i] -= mean; sq += y[i] * y[i]; }
        sq = red8_sum(sq);
        const float rstd = rsqrtf(sq * (1.f / 64.f) + 64e-5f);
        float vm[8], gm[8];
        rw_comb(wv_, nbq, mu, 1024 + h * 64 + v0, vm);
        rw_comb(wg_, nbq, mu, 1536 + h * 64 + v0, gm);
        float o[8];
#pragma unroll
        for (int i = 0; i < 8; ++i) o[i] = (y[i] * rstd * gn_g[h * 64 + v0 + i] + gn_b[h * 64 + v0 + i] + bon * vm[i]) * silu_f(gm[i]);
        *(uint4*)(YC + (size_t)s * 1024 + 512 + h * 64 + v0) = pack8(o);
    }
}

DEV void ln_rows(const float* src, const float* res_lat, const float* res_cx, int nrows, const float* __restrict__ g, const float* __restrict__ bt, float* dst_lat, float* dst_cx, int ncx,
                 bf16_t* hb = nullptr, const float* mvc = nullptr, const float* mvl = nullptr) {
    const int tid_ = opaque_tid(); const int lane = tid_ & 63, gw = blockIdx.x * NWV + (tid_ >> 6), ngw = gridDim.x * NWV;
    float4 gg[4], bb[4];
#pragma unroll
    for (int i = 0; i < 4; ++i) { gg[i] = ld4(g + i * 256 + lane * 4); bb[i] = ld4(bt + i * 256 + lane * 4); }
    float4 na[4], nr[4];
    { const int r = gw < nrows ? gw : 0; const float* x = src + (size_t)r * 1024; const float* xr = (r < ncx) ? (res_cx + (size_t)r * 1024) : (res_lat + (size_t)(r - ncx) * 1024);
#pragma unroll
      for (int i = 0; i < 4; ++i) { na[i] = ld4(x + i * 256 + lane * 4); nr[i] = ld4(xr + i * 256 + lane * 4); } }
    for (int r = gw; r < nrows; r += ngw) {
        float4 v[4];
        float sum = 0.f;
#pragma unroll
        for (int i = 0; i < 4; ++i) { const float4 a = na[i], rr = nr[i];
            v[i] = make_float4(ALPHA * rr.x + a.x, ALPHA * rr.y + a.y, ALPHA * rr.z + a.z, ALPHA * rr.w + a.w); sum += v[i].x + v[i].y + v[i].z + v[i].w; }
        { const int rn = (r + ngw < nrows) ? r + ngw : r; const float* x = src + (size_t)rn * 1024; const float* xr = (rn < ncx) ? (res_cx + (size_t)rn * 1024) : (res_lat + (size_t)(rn - ncx) * 1024);
#pragma unroll
          for (int i = 0; i < 4; ++i) { na[i] = ld4(x + i * 256 + lane * 4); nr[i] = ld4(xr + i * 256 + lane * 4); } }
        const float mean = wave_sum(sum) * (1.f / 1024.f);
        float sq = 0.f;
#pragma unroll
        for (int i = 0; i < 4; ++i) {
            v[i].x -= mean; v[i].y -= mean; v[i].z -= mean; v[i].w -= mean;
            sq += v[i].x * v[i].x + v[i].y * v[i].y + v[i].z * v[i].z + v[i].w * v[i].w;
        }
        const float rstd = rsqrtf(wave_sum(sq) * (1.f / 1024.f) + 1e-5f);
        float* d = (r < ncx) ? (dst_cx + (size_t)r * 1024) : (dst_lat + (size_t)(r - ncx) * 1024);
#pragma unroll
        for (int i = 0; i < 4; ++i) {
            const int c = i * 256 + lane * 4;
            const float4 y = make_float4(v[i].x * rstd * gg[i].x + bb[i].x, v[i].y * rstd * gg[i].y + bb[i].y, v[i].z * rstd * gg[i].z + bb[i].z, v[i].w * rstd * gg[i].w + bb[i].w);
            st4(d + c, y);
            if (hb != nullptr) {
                const float* m = (r < ncx) ? mvc : mvl;
                const float4 sh = ld4(m + c), sc = ld4(m + 1024 + c);
                *(uint2*)(hb + (size_t)r * 1024 + c) = make_uint2(pack2bf(y.x * (1.f + sc.x) + sh.x, y.y * (1.f + sc.y) + sh.y), pack2bf(y.z * (1.f + sc.z) + sh.z, y.w * (1.f + sc.w) + sh.w));
            }
        }
    }
}
DEV void phase_h1l(const Params& p) {
    const float* modv1 = (const float*)(p.ws + OFF_MODV) + 3 * 3072;
    bf16_t* H1 = (bf16_t*)(p.ws + OFF_H1B);
    const size_t gt = (size_t)blockIdx.x * NTHR + opaque_tid(), gn = (size_t)gridDim.x * NTHR;
    const int k = (int)(gt & 127) * 8;
    const Mod8 m0 = mod8_load(modv1, k), m1 = mod8_load(modv1 + 3072, k);
    constexpr size_t NI = (size_t)NB * NL * 128;
    for (size_t i0 = gt; i0 < NI; i0 += 4 * gn) {
        float4 xa[4], xb[4];
#pragma unroll
        for (int u = 0; u < 4; ++u) { const size_t i = i0 + u * gn, r = (i < NI ? i : gt) >> 7; xa[u] = ld4(p.out + r * DM + k); xb[u] = ld4(p.out + r * DM + k + 4); }
#pragma unroll
        for (int u = 0; u < 4; ++u) { const size_t i = i0 + u * gn, r = i >> 7; if (i < NI) *(uint4*)(H1 + r * DM + k) = mod8_apply(xa[u], xb[u], (r >= (size_t)NL) ? m1 : m0); }
    }
}

DEV void zero_f4(float* ptr, size_t nfloat) {
    const size_t n4 = nfloat / 4;
    for (size_t i = (size_t)blockIdx.x * NTHR + opaque_tid(); i < n4; i += (size_t)gridDim.x * NTHR) ((float4*)ptr)[i] = make_float4(0.f, 0.f, 0.f, 0.f);
}

DEV void chain_ids(int& chain, int& sub) {
    const int bid = blockIdx.x, xcd = bid & 7, idx = bid >> 3;
    chain = xcd * 2 + (idx >> 4); sub = idx & 15;
}

DEV void phase_conv1(const Params& p, float* sm) {
    const bf16_t* XM = (const bf16_t*)(p.ws + OFF_XM);
    bf16_t* XC = (bf16_t*)(p.ws + OFF_XC);
    float* G16P = (float*)(p.ws + OFF_G16P);
    const bf16_t* WFT = (const bf16_t*)(p.ws + OFF_WFT);
    const float* cw = p.in[31]; const float* cbias = p.in[32];
    bf16_t* imgC = (bf16_t*)sm;
    bf16_t* imgM = imgC + 64 * 264;
    float* red = (float*)(imgM + 64 * 264);
    float* cwl = red + 1024;
    const int tid = opaque_tid(), lane = tid & 63, wave = tid >> 6, t = tid >> 3, cg = tid & 7;
    for (int u = blockIdx.x; u < NB * NCH * 4; u += gridDim.x) {
        const int ci = u >> 2, q = u & 3, b = ci / NCH, c = ci % NCH, s = c * 64 + t;
        const size_t rowbase = (size_t)b * TB;
        int nrow[9]; unsigned vmask = 0u;
#pragma unroll
        for (int i = 0; i < 3; ++i)
#pragma unroll
            for (int j = 0; j < 3; ++j) {
                int ns = -1;
                if (s < NCX) { const int w2 = s + j - 1; if (i == 1 && w2 >= 0 && w2 < NCX) ns = w2; }
                else { const int n = s - NCX, rr = (n >> 6) + i - 1, w2 = (n & 63) + j - 1; if (rr >= 0 && rr < 128 && w2 >= 0 && w2 < 64) ns = NCX + rr * 64 + w2; }
                nrow[i * 3 + j] = ns >= 0 ? ns : s; vmask |= (ns >= 0 ? 1u : 0u) << (i * 3 + j);
            }
        const int tt = wave & 3, part = wave >> 2;
        f32x4 acc = (f32x4){0.f, 0.f, 0.f, 0.f};
        uint4 xn[9];
#pragma unroll
        for (int tap = 0; tap < 9; ++tap) xn[tap] = *(const uint4*)(XM + (rowbase + nrow[tap]) * 2048 + q * 512 + cg * 8);
#pragma unroll 1
        for (int half = 0; half < 2; ++half) {
            __syncthreads();
            for (int i = tid; i < 640; i += NTHR) { const int tp = i >> 6, c4 = (i & 63) * 4; st4(cwl + tp * 256 + c4, ld4((tp < 9 ? cw + tp * 2048 : cbias) + q * 512 + half * 256 + c4)); }
            __syncthreads();
#pragma unroll 1
            for (int it = 0; it < 4; ++it) {
                const int cl = it * 64 + cg * 8, c0 = q * 512 + half * 256 + cl;
                uint4 xc9[9];
#pragma unroll
                for (int tap = 0; tap < 9; ++tap) xc9[tap] = xn[tap];
                { const int gn = half * 4 + it + 1, c0n = q * 512 + (gn < 8 ? gn : 7) * 64 + cg * 8;
#pragma unroll
                  for (int tap = 0; tap < 9; ++tap) xn[tap] = *(const uint4*)(XM + (rowbase + nrow[tap]) * 2048 + c0n); }
                float a8[8];
                { const float4 b0 = ld4(cwl + 9 * 256 + cl), b1 = ld4(cwl + 9 * 256 + cl + 4); a8[0] = b0.x; a8[1] = b0.y; a8[2] = b0.z; a8[3] = b0.w; a8[4] = b1.x; a8[5] = b1.y; a8[6] = b1.z; a8[7] = b1.w; }
#pragma unroll
                for (int tap = 0; tap < 9; ++tap) {
                    const unsigned mk = ((vmask >> tap) & 1u) ? 0xffffffffu : 0u;
                    const uint4 xv = make_uint4(xc9[tap].x & mk, xc9[tap].y & mk, xc9[tap].z & mk, xc9[tap].w & mk);
                    float x8[8]; unpack8(xv, x8);
                    const float4 w0 = ld4(cwl + tap * 256 + cl), w1 = ld4(cwl + tap * 256 + cl + 4);
                    a8[0] += x8[0] * w0.x; a8[1] += x8[1] * w0.y; a8[2] += x8[2] * w0.z; a8[3] += x8[3] * w0.w;
                    a8[4] += x8[4] * w1.x; a8[5] += x8[5] * w1.y; a8[6] += x8[6] * w1.z; a8[7] += x8[7] * w1.w;
                }
#pragma unroll
                for (int i = 0; i < 8; ++i) a8[i] = silu_f(a8[i]);
                const uint4 xcv = pack8(a8);
                *(uint4*)(XC + (rowbase + s) * 2048 + c0) = xcv;
                *(uint4*)(imgC + t * 264 + cl) = xcv;
                *(uint4*)(imgM + t * 264 + cl) = xc9[4];
            }
            __syncthreads();
            {
                const bf16_t* img = part ? imgM : imgC;
                const bf16_t* wrow = WFT + (size_t)(lane & 15) * 4096 + part * 2048 + q * 512 + half * 256 + (lane >> 4) * 8;
#pragma unroll
                for (int ks = 0; ks < 8; ++ks) acc = __builtin_amdgcn_mfma_f32_16x16x32_bf16(row_frag(img, 264, tt * 16, ks * 32, lane), *(const bf16x8*)(wrow + ks * 32), acc, 0, 0, 0);
            }
        }
        if (part == 1) {
#pragma unroll
            for (int r = 0; r < 4; ++r) red[(tt * 16 + (lane >> 4) * 4 + r) * 16 + (lane & 15)] = acc[r];
        }
        __syncthreads();
        if (part == 0) {
#pragma unroll
            for (int r = 0; r < 4; ++r) {
                const int tk = tt * 16 + (lane >> 4) * 4 + r;
                G16P[(((size_t)rowbase + c * 64 + tk) * 16 + (lane & 15)) * 4 + q] = acc[r] + red[tk * 16 + (lane & 15)];
            }
        }
    }
}

struct GateRaw { float4 a, f; };
DEV GateRaw gate_load(const Params& p, size_t row, int dir, int h) {
    const float* G16P = (const float*)(p.ws + OFF_G16P);
    GateRaw g; g.a = ld4(G16P + (row * 16 + dir * 8 + h) * 4); g.f = ld4(G16P + (row * 16 + dir * 8 + 4 + h) * 4);
    return g;
}
DEV void gate_fin(const GateRaw& g, float bi, float bf, float& gi, float& lf) {
    gi = (g.a.x + g.a.y) + (g.a.z + g.a.w) + bi;
    lf = logsig_f((g.f.x + g.f.y) + (g.f.z + g.f.w) + bf);
}
DEV void gate_pair(const Params& p, size_t row, int dir, int h, float& gi, float& lf) {
    const GateRaw g = gate_load(p, row, dir, h);
    gate_fin(g, p.in[dir ? 41 : 37][h], p.in[dir ? 43 : 39][h], gi, lf);
}

DEV void phase_x1(const Params& p, float* sm) {
    int chain, sub; chain_ids(chain, sub);
    const int b = chain >> 3, h = (chain >> 1) & 3, dir = chain & 1;
    const bf16_t* XC = (const bf16_t*)(p.ws + OFF_XC);
    float* GSC = (float*)(p.ws + OFF_GSC); float* CSC = (float*)(p.ws + OFF_CSC); float* NBUF = (float*)(p.ws + OFF_NBUF);
    const float* gtab = (const float*)(p.ws + OFF_GTAB);
    bf16_t* SMAT = (bf16_t*)(p.ws + OFF_SMAT);
    const int tid = opaque_tid(), lane = tid & 63, wave = tid >> 6;
    float* sTot = sm; float* sRef = sm + 132; float* sM0 = sm + 264; float* sBeta = sm + 400;
    const float bias_i = p.in[dir ? 41 : 37][h], bias_f = p.in[dir ? 43 : 39][h];
    {
        GateRaw gn = gate_load(p, (size_t)b * TB + wave * 64 + lane, dir, h);
        for (int c = wave; c < NCH; c += NWV) {
            const GateRaw gc = gn;
            const int cn = (c + NWV < NCH) ? c + NWV : c;
            gn = gate_load(p, (size_t)b * TB + cn * 64 + lane, dir, h);
            float gi, lf; gate_fin(gc, bias_i, bias_f, gi, lf);
            const float bc = wave_scan_add(lf, lane, dir);
            const float ref = wave_max(gi - bc), tot = wave_sum(lf);
            if (lane == 0) { sTot[c] = tot; sRef[c] = ref; }
        }
    }
    __syncthreads();
    if (tid == 0) {
        float m0 = -INFINITY;
        for (int step = 0; step < NCH; ++step) {
            const int c = chunk_at(dir, step);
            sM0[c] = m0;
            const float mx = fmaxf(m0, sRef[c]);
            if (sub == 0) { CSC[(chain * NCH + c) * 2] = fexp(m0 - mx); CSC[(chain * NCH + c) * 2 + 1] = fexp(sRef[c] - mx); }
            m0 = sTot[c] + mx;
        }
    }
    __syncthreads();
    for (int k = wave; sub + 16 * k < NCH; k += NWV) {
        const int c = sub + 16 * k;
        const size_t row = (size_t)b * TB + c * 64 + lane;
        float gi, lf; gate_fin(gate_load(p, row, dir, h), bias_i, bias_f, gi, lf);
        const float bc = wave_scan_add(lf, lane, dir);
        const float a = gi - bc;
        const float amax = wave_scan_max(a, lane, dir);
        const float ref = sRef[c], m0 = sM0[c];
        const float mmax = fmaxf(amax, m0);
        const float mt = bc + mmax;
        const float alpha = fexp(ref - mmax), beta = fexp(a - ref), gg = fexp(m0 - mmax), em = fexp(-mt);
        st4(GSC + ((size_t)chain * TB + c * 64 + lane) * 4, make_float4(alpha, beta, gg, em));
        sBeta[k * 64 + lane] = beta;
    }
    __syncthreads();
    {
        float* part = sm + 1024;
        const int sg = tid >> 6, j8 = (tid & 63) * 8;
        uint4 xn[8];
        { const bf16_t* xp = XC + ((size_t)b * TB + sub * 64 + sg * 8) * 2048 + h * 512 + j8;
#pragma unroll
          for (int s = 0; s < 8; ++s) xn[s] = *(const uint4*)(xp + (size_t)s * 2048); }
        for (int k = 0; sub + 16 * k < NCH; ++k) {
            const int c = sub + 16 * k;
            uint4 xcur[8];
#pragma unroll
            for (int s = 0; s < 8; ++s) xcur[s] = xn[s];
            { const int cn = (c + 16 < NCH) ? c + 16 : c; const bf16_t* xp = XC + ((size_t)b * TB + cn * 64 + sg * 8) * 2048 + h * 512 + j8;
#pragma unroll
              for (int s = 0; s < 8; ++s) xn[s] = *(const uint4*)(xp + (size_t)s * 2048); }
            float acc[8];
#pragma unroll
            for (int i = 0; i < 8; ++i) acc[i] = 0.f;
#pragma unroll
            for (int s = 0; s < 8; ++s) {
                float f[8]; unpack8(xcur[s], f);
                const float be = sBeta[k * 64 + sg * 8 + s];
#pragma unroll
                for (int i = 0; i < 8; ++i) acc[i] += be * f[i];
            }
            __syncthreads();
            st4(part + sg * 512 + j8, make_float4(acc[0], acc[1], acc[2], acc[3])); st4(part + sg * 512 + j8 + 4, make_float4(acc[4], acc[5], acc[6], acc[7]));
            __syncthreads();
            float tot = 0.f;
#pragma unroll
            for (int q = 0; q < 8; ++q) tot += part[q * 512 + tid];
            NBUF[((size_t)chain * NCH + c) * 512 + tid] = tot;
        }
    }
    bf16_t* XCs = (bf16_t*)sm;
    bf16_t* Qs = XCs + 64 * 520;
    for (int u = blockIdx.x; u < NB * 4 * NCH; u += gridDim.x) {
        const int bh = u / NCH, c = u % NCH, ub = bh >> 2, uh = bh & 3;
        __syncthreads();
        float4 gq[2][4];
#pragma unroll
        for (int bb = 0; bb < 2; ++bb) { const float* G = gtab + (size_t)(uh * 128 + (tid & 63) * 2 + bb) * 16; gq[bb][0] = ld4(G); gq[bb][1] = ld4(G + 4); gq[bb][2] = ld4(G + 8); gq[bb][3] = ld4(G + 12); }
        uint4 xr[8];
#pragma unroll
        for (int i = 0; i < 8; ++i) { const int pp = tid + 512 * i, row = pp >> 6, c16 = pp & 63; xr[i] = *(const uint4*)(XC + ((size_t)ub * TB + c * 64 + row) * 2048 + uh * 512 + c16 * 8); }
#pragma unroll
        for (int i = 0; i < 8; ++i) {
            const int pp = tid + 512 * i, row = pp >> 6, c16 = pp & 63;
            const uint4 xv = xr[i];
            float f[8]; unpack8(xv, f);
            float q[8];
#pragma unroll
            for (int bb = 0; bb < 2; ++bb) {
                const float4 g0 = gq[bb][0], g1 = gq[bb][1], g2 = gq[bb][2], g3 = gq[bb][3];
                q[bb * 4 + 0] = f[bb * 4] * g0.x + f[bb * 4 + 1] * g1.x + f[bb * 4 + 2] * g2.x + f[bb * 4 + 3] * g3.x;
                q[bb * 4 + 1] = f[bb * 4] * g0.y + f[bb * 4 + 1] * g1.y + f[bb * 4 + 2] * g2.y + f[bb * 4 + 3] * g3.y;
                q[bb * 4 + 2] = f[bb * 4] * g0.z + f[bb * 4 + 1] * g1.z + f[bb * 4 + 2] * g2.z + f[bb * 4 + 3] * g3.z;
                q[bb * 4 + 3] = f[bb * 4] * g0.w + f[bb * 4 + 1] * g1.w + f[bb * 4 + 2] * g2.w + f[bb * 4 + 3] * g3.w;
            }
            *(uint4*)(XCs + row * 520 + c16 * 8) = xv;
            *(uint4*)(Qs + row * 520 + c16 * 8) = make_uint4(pack2bf(q[0], q[1]), pack2bf(q[2], q[3]), pack2bf(q[4], q[5]), pack2bf(q[6], q[7]));
        }
        __syncthreads();
        const int st = wave & 3, tt0 = (wave >> 2) * 2;
        f32x4 a0 = (f32x4){0.f, 0.f, 0.f, 0.f}, a1 = a0;
        const bf16_t* ap = XCs + (st * 16 + (lane & 15)) * 520 + (lane >> 4) * 8;
        const bf16_t* bp0 = Qs + (tt0 * 16 + (lane & 15)) * 520 + (lane >> 4) * 8;
        const bf16_t* bp1 = bp0 + 16 * 520;
#pragma unroll
        for (int ks = 0; ks < 16; ++ks) {
            const bf16x8 af = *(const bf16x8*)(ap + ks * 32);
            a0 = __builtin_amdgcn_mfma_f32_16x16x32_bf16(af, *(const bf16x8*)(bp0 + ks * 32), a0, 0, 0, 0);
            a1 = __builtin_amdgcn_mfma_f32_16x16x32_bf16(af, *(const bf16x8*)(bp1 + ks * 32), a1, 0, 0, 0);
        }
        bf16_t* sp = SMAT + (size_t)u * 4096 + (size_t)(tt0 * 16 + (lane & 15)) * 64 + st * 16 + (lane >> 4) * 4;
        *(uint2*)sp = make_uint2(pack2bf(a0[0], a0[1]), pack2bf(a0[2], a0[3]));
        *(uint2*)(sp + 16 * 64) = make_uint2(pack2bf(a1[0], a1[1]), pack2bf(a1[2], a1[3]));
    }
}

DEV void phase_x2(const Params& p, float* sm) {
    int chain, sub; chain_ids(chain, sub);
    const int b = chain >> 3, h = (chain >> 1) & 3, dir = chain & 1;
    const bf16_t* XC = (const bf16_t*)(p.ws + OFF_XC);
    float* GSC = (float*)(p.ws + OFF_GSC); const float* CSC = (const float*)(p.ws + OFF_CSC); const float* NBUF = (const float*)(p.ws + OFF_NBUF);
    const float* gtab = (const float*)(p.ws + OFF_GTAB);
    const bf16_t* SMAT = (const bf16_t*)(p.ws + OFF_SMAT);
    const int tid = opaque_tid();
    float* sD0 = sm; float* sCf = sm + 132; float* sN0 = sm + 264; float* sN2 = sN0 + 9 * 512;
    for (int i = tid; i < NCH; i += NTHR) { sD0[i] = CSC[(chain * NCH + i) * 2]; sCf[i] = CSC[(chain * NCH + i) * 2 + 1]; }
    __syncthreads();
    float* sBeta = sN2 + 9 * 512;
    for (int i = tid; i < 9 * 64; i += NTHR) { const int k = i >> 6, c = sub + 16 * k; if (c < NCH) sBeta[i] = GSC[((size_t)chain * TB + c * 64 + (i & 63)) * 4 + 1]; }
    if (tid < 128) {
        constexpr int NBT = 12;
        float4 n = make_float4(0.f, 0.f, 0.f, 0.f), nx[NBT];
        const float* nb = NBUF + (size_t)chain * NCH * 512 + tid * 4;
#pragma unroll
        for (int j = 0; j < NBT; ++j) nx[j] = ld4(nb + (size_t)chunk_at(dir, j) * 512);
#pragma unroll 1
        for (int step0 = 0; step0 < NCH; step0 += NBT) {
            float4 cu[NBT];
#pragma unroll
            for (int j = 0; j < NBT; ++j) cu[j] = nx[j];
#pragma unroll
            for (int j = 0; j < NBT; ++j) { const int sn = step0 + NBT + j; nx[j] = ld4(nb + (size_t)chunk_at(dir, sn < NCH ? sn : NCH - 1) * 512); }
            __builtin_amdgcn_sched_barrier(0);
#pragma unroll
            for (int j = 0; j < NBT; ++j) {
                const int c = chunk_at(dir, step0 + j);
                if ((c & 15) == sub) st4(sN0 + (c >> 4) * 512 + tid * 4, n);
                const float d = sD0[c], cf = sCf[c];
                n = make_float4(d * n.x + cf * cu[j].x, d * n.y + cf * cu[j].y, d * n.z + cf * cu[j].z, d * n.w + cf * cu[j].w);
            }
        }
    }
    __syncthreads();
    {
        const int blk = tid >> 2, cp = tid & 3;
        const float4 g = ld4(gtab + (size_t)(h * 128 + blk) * 16 + cp * 4);
        for (int k = 0; sub + 16 * k < NCH; ++k) {
            const float* n0 = sN0 + k * 512 + blk * 4;
            sN2[k * 512 + tid] = g.x * n0[0] + g.y * n0[1] + g.z * n0[2] + g.w * n0[3];
        }
    }
    __syncthreads();
    const int t = tid >> 3, part = tid & 7;
    for (int k = 0; sub + 16 * k < NCH; ++k) {
        const int c = sub + 16 * k;
        const size_t row = (size_t)b * TB + c * 64 + t;
        float dint = 0.f;
        {
            const bf16_t* xp = XC + row * 2048 + h * 512 + part * 64;
            const float* n2 = sN2 + k * 512 + part * 64;
#pragma unroll
            for (int i = 0; i < 8; ++i) {
                float f[8]; unpack8(*(const uint4*)(xp + i * 8), f);
                const float4 na = ld4(n2 + i * 8), nb2 = ld4(n2 + i * 8 + 4);
                dint += f[0] * na.x + f[1] * na.y + f[2] * na.z + f[3] * na.w + f[4] * nb2.x + f[5] * nb2.y + f[6] * nb2.z + f[7] * nb2.w;
            }
        }
        float di = 0.f;
        {
            float f[8]; unpack8(*(const uint4*)(SMAT + ((size_t)((b * 4 + h) * NCH + c)) * 4096 + t * 64 + part * 8), f);
#pragma unroll
            for (int e = 0; e < 8; ++e) {
                const int s = part * 8 + e;
                const float beta = sBeta[k * 64 + s];
                const bool keep = dir ? (s >= t) : (s <= t);
                di += keep ? f[e] * beta : 0.f;
            }
        }
        dint = red8_sum(dint);
        di = red8_sum(di);
        if (part == 0) {
            float* gp = GSC + ((size_t)chain * TB + c * 64 + t) * 4;
            const float4 g4 = ld4(gp);
            const float den = g4.x * di + g4.z * dint;
            gp[3] = 1.f / fmaxf(fabsf(den), g4.w);
        }
    }
}

#define MLSTM_PREFETCH(step_) do { \
    const int c_ = chunk_at(dir, (step_)); const size_t rb_ = (size_t)b * TB + (size_t)c_ * 64; \
    { const bf16_t* xb_ = XC + (rb_ + (tid >> 6)) * 2048 + h * 512 + (tid & 63) * 8; \
      rx0 = *(const uint4*)(xb_); rx1 = *(const uint4*)(xb_ + 8 * 2048); rx2 = *(const uint4*)(xb_ + 16 * 2048); rx3 = *(const uint4*)(xb_ + 24 * 2048); \
      rx4 = *(const uint4*)(xb_ + 32 * 2048); rx5 = *(const uint4*)(xb_ + 40 * 2048); rx6 = *(const uint4*)(xb_ + 48 * 2048); rx7 = *(const uint4*)(xb_ + 56 * 2048); } \
    rxm = *(const uint2*)(XM + (rb_ + ps) * 2048 + ch0 + pvb * 4); \
    rs = *(const uint4*)(SMAT + ((size_t)((b * 4 + h) * NCH + c_)) * 4096 + ps * 64 + pvb * 8); \
    rbeta = GSC[((size_t)chain * TB + c_ * 64 + ps) * 4 + 1]; \
    if (tid < 64) rsc = ld4(GSC + ((size_t)chain * TB + c_ * 64 + tid) * 4); \
    rd0 = CSC[(chain * NCH + c_) * 2]; rcf = CSC[(chain * NCH + c_) * 2 + 1]; } while (0)

DEV void phase_mlstm(const Params& p, float* sm) {
    int chain, sub; chain_ids(chain, sub);
    const int b = chain >> 3, h = (chain >> 1) & 3, dir = chain & 1;
    const bf16_t* XM = (const bf16_t*)(p.ws + OFF_XM);
    const bf16_t* XC = (const bf16_t*)(p.ws + OFF_XC);
    const bf16_t* SMAT = (const bf16_t*)(p.ws + OFF_SMAT);
    const float* GSC = (const float*)(p.ws + OFF_GSC); const float* CSC = (const float*)(p.ws + OFF_CSC);
    const float* gtab = (const float*)(p.ws + OFF_GTAB);
    bf16_t* H = (bf16_t*)(p.ws + OFF_H);
    const float* wv = p.in[35];
    char* smc = (char*)sm;
    bf16_t* XCs = (bf16_t*)smc;
    bf16_t* Cs = (bf16_t*)(smc + 66560);
    bf16_t* Vb = (bf16_t*)(smc + 66560 + 33280);
    bf16_t* Vw = Vb + 32 * 72;
    bf16_t* Sm = Vw + 32 * 72;
    float* Gs = (float*)(smc + 66560 + 33280 + 2 * 4608 + 9216);
    float* sc = Gs + 2048;
    const int tid = opaque_tid(), lane = tid & 63, wave = tid >> 6;
    for (int i = tid; i < 32 * 520 / 2; i += NTHR) ((unsigned*)Cs)[i] = 0u;
    for (int i = tid; i < 2048; i += NTHR) Gs[i] = gtab[h * 2048 + i];
    const int ps = tid >> 3, pvb = tid & 7;
    const int ch0 = h * 512 + sub * 32;
    float wvr[16];
#pragma unroll
    for (int i = 0; i < 16; ++i) wvr[i] = wv[(size_t)((ch0 >> 2) + pvb) * 16 + i];
    f32x4 accS[4][2];
#pragma unroll
    for (int i = 0; i < 4; ++i) { accS[i][0] = (f32x4){0.f, 0.f, 0.f, 0.f}; accS[i][1] = (f32x4){0.f, 0.f, 0.f, 0.f}; }
    bf16x8 gA[2][2];
#pragma unroll
    for (int pr = 0; pr < 2; ++pr)
#pragma unroll
        for (int tg = 0; tg < 2; ++tg) {
            const int gq = lane >> 4, l15 = lane & 15, blk = wave * 16 + (pr * 2 + tg) * 4 + gq;
            const float4 gr = ld4(gtab + (size_t)h * 2048 + blk * 16 + (l15 & 3) * 4);
            const bool on = (gq == (l15 >> 2));
            const unsigned p0 = on ? pack2bf(gr.x, gr.y) : 0u, p1 = on ? pack2bf(gr.z, gr.w) : 0u;
            const uint4 u = tg == 0 ? make_uint4(p0, p1, 0u, 0u) : make_uint4(0u, 0u, p0, p1);
            gA[pr][tg] = __builtin_bit_cast(bf16x8, u);
        }
    uint4 rx0, rx1, rx2, rx3, rx4, rx5, rx6, rx7; uint2 rxm; uint4 rs; float rbeta; float4 rsc = make_float4(0.f, 0.f, 0.f, 0.f); float rd0, rcf;
    MLSTM_PREFETCH(0);
    __syncthreads();
#pragma unroll 1
    for (int step = 0; step < NCH; ++step) {
        const int c = chunk_at(dir, step);
        const float d0 = rd0, cf = rcf;
        {
            bf16_t* xd = XCs + (tid >> 6) * 520 + (tid & 63) * 8;
            *(uint4*)(xd) = rx0; *(uint4*)(xd + 8 * 520) = rx1; *(uint4*)(xd + 16 * 520) = rx2; *(uint4*)(xd + 24 * 520) = rx3;
            *(uint4*)(xd + 32 * 520) = rx4; *(uint4*)(xd + 40 * 520) = rx5; *(uint4*)(xd + 48 * 520) = rx6; *(uint4*)(xd + 56 * 520) = rx7;
        }
        {
            const float x0 = bflo(rxm.x), x1 = bfhi(rxm.x), x2 = bflo(rxm.y), x3 = bfhi(rxm.y);
#pragma unroll
            for (int d = 0; d < 4; ++d) {
                const float v = (x0 * wvr[d] + x1 * wvr[4 + d] + x2 * wvr[8 + d] + x3 * wvr[12 + d]) * rbeta;
                Vb[(pvb * 4 + d) * 72 + ps] = __builtin_bit_cast(unsigned short, (__bf16)v);
                Vw[(pvb * 4 + d) * 72 + ps] = __builtin_bit_cast(unsigned short, (__bf16)(v * cf));
            }
        }
        {
#define SMASK(q_) (((dir ? (pvb * 8 + 2 * (q_) >= ps) : (pvb * 8 + 2 * (q_) <= ps)) ? 0x0000ffffu : 0u) | ((dir ? (pvb * 8 + 2 * (q_) + 1 >= ps) : (pvb * 8 + 2 * (q_) + 1 <= ps)) ? 0xffff0000u : 0u))
            *(uint4*)(Sm + ps * 72 + pvb * 8) = make_uint4(rs.x & SMASK(0), rs.y & SMASK(1), rs.z & SMASK(2), rs.w & SMASK(3));
#undef SMASK
        }
        if (tid < 64) st4(sc + tid * 4, rsc);
        { const int nstep = (step + 1 < NCH) ? step + 1 : step; MLSTM_PREFETCH(nstep); }
        __syncthreads();
        {
            const int vt = wave & 1, tt = wave >> 1;
            f32x4 ao = (f32x4){0.f, 0.f, 0.f, 0.f}, ai = ao, ao1 = ao, ao2 = ao, ao3 = ao;
            const bf16_t* ap = Cs + (vt * 16 + (lane & 15)) * 520 + (lane >> 4) * 8;
            const bf16_t* bp = XCs + (tt * 16 + (lane & 15)) * 520 + (lane >> 4) * 8;
#pragma unroll
            for (int ks = 0; ks < 16; ks += 4) {
                ao = __builtin_amdgcn_mfma_f32_16x16x32_bf16(*(const bf16x8*)(ap + ks * 32), *(const bf16x8*)(bp + ks * 32), ao, 0, 0, 0);
                ao1 = __builtin_amdgcn_mfma_f32_16x16x32_bf16(*(const bf16x8*)(ap + (ks + 1) * 32), *(const bf16x8*)(bp + (ks + 1) * 32), ao1, 0, 0, 0);
                ao2 = __builtin_amdgcn_mfma_f32_16x16x32_bf16(*(const bf16x8*)(ap + (ks + 2) * 32), *(const bf16x8*)(bp + (ks + 2) * 32), ao2, 0, 0, 0);
                ao3 = __builtin_amdgcn_mfma_f32_16x16x32_bf16(*(const bf16x8*)(ap + (ks + 3) * 32), *(const bf16x8*)(bp + (ks + 3) * 32), ao3, 0, 0, 0);
            }
            ao = (ao + ao1) + (ao2 + ao3);
            const bf16_t* ap2 = Vb + (vt * 16 + (lane & 15)) * 72 + (lane >> 4) * 8;
            const bf16_t* bp2 = Sm + (tt * 16 + (lane & 15)) * 72 + (lane >> 4) * 8;
#pragma unroll
            for (int ks = 0; ks < 2; ++ks) ai = __builtin_amdgcn_mfma_f32_16x16x32_bf16(*(const bf16x8*)(ap2 + ks * 32), *(const bf16x8*)(bp2 + ks * 32), ai, 0, 0, 0);
            if (c >= 4) {
                const int t = tt * 16 + (lane & 15);
                const float4 s4 = ld4(sc + t * 4);
                const float h0 = (s4.x * ai[0] + s4.z * ao[0]) * s4.w, h1 = (s4.x * ai[1] + s4.z * ao[1]) * s4.w;
                const float h2 = (s4.x * ai[2] + s4.z * ao[2]) * s4.w, h3 = (s4.x * ai[3] + s4.z * ao[3]) * s4.w;
                bf16_t* hp = H + ((size_t)b * NL + (size_t)c * 64 + t - NCX) * 2048 + ch0 + vt * 16 + (lane >> 4) * 4;
                const unsigned u0 = pack2bf(h0, h1), u1 = pack2bf(h2, h3);
                asm volatile("global_atomic_pk_add_bf16 %0, %1, off sc1\n\tglobal_atomic_pk_add_bf16 %0, %2, off offset:4 sc1" :: "v"(hp), "v"(u0), "v"(u1) : "memory");
            }
        }
#pragma unroll
        for (int jt = 0; jt < 4; ++jt) { accS[jt][0] *= d0; accS[jt][1] *= d0; }
#pragma unroll
        for (int ks = 0; ks < 2; ++ks) {
            const bf16x8 b0 = *(const bf16x8*)(Vw + (lane & 15) * 72 + ks * 32 + (lane >> 4) * 8);
            const bf16x8 b1 = *(const bf16x8*)(Vw + (16 + (lane & 15)) * 72 + ks * 32 + (lane >> 4) * 8);
            const int row0 = ks * 32 + (lane >> 4) * 8 + ((lane & 15) >> 2);
#pragma unroll
            for (int jt = 0; jt < 4; ++jt) {
                const int col = wave * 64 + jt * 16 + (lane & 3) * 4;
                const s16x4 lo = __builtin_amdgcn_ds_read_tr16_b64_v4i16((__attribute__((address_space(3))) s16x4*)(XCs + row0 * 520 + col));
                const s16x4 hi = __builtin_amdgcn_ds_read_tr16_b64_v4i16((__attribute__((address_space(3))) s16x4*)(XCs + (row0 + 4) * 520 + col));
                const bf16x8 af = (bf16x8){lo[0], lo[1], lo[2], lo[3], hi[0], hi[1], hi[2], hi[3]};
                accS[jt][0] = __builtin_amdgcn_mfma_f32_16x16x32_bf16(af, b0, accS[jt][0], 0, 0, 0);
                accS[jt][1] = __builtin_amdgcn_mfma_f32_16x16x32_bf16(af, b1, accS[jt][1], 0, 0, 0);
            }
        }
        __builtin_amdgcn_sched_barrier(0);
        __syncthreads();
        __builtin_amdgcn_sched_barrier(0);
#pragma unroll
        for (int pr = 0; pr < 2; ++pr)
#pragma unroll
            for (int v2 = 0; v2 < 2; ++v2) {
                const f32x4 a0 = accS[2 * pr][v2], a1 = accS[2 * pr + 1][v2];
                const uint4 bu = make_uint4(pack2bf(a0[0], a0[1]), pack2bf(a0[2], a0[3]), pack2bf(a1[0], a1[1]), pack2bf(a1[2], a1[3]));
                const bf16x8 bq = __builtin_bit_cast(bf16x8, bu);
#pragma unroll
                for (int tg = 0; tg < 2; ++tg) {
                    const f32x4 o = __builtin_amdgcn_mfma_f32_16x16x32_bf16(gA[pr][tg], bq, (f32x4){0.f, 0.f, 0.f, 0.f}, 0, 0, 0);
                    const int blk = wave * 16 + (2 * pr + tg) * 4 + (lane >> 4);
                    *(uint2*)(Cs + (v2 * 16 + (lane & 15)) * 520 + blk * 4) = make_uint2(pack2bf(o[0], o[1]), pack2bf(o[2], o[3]));
                }
            }
    }
}

DEV void phase_finish1(const Params& p) {
    bf16_t* H = (bf16_t*)(p.ws + OFF_H);
    const bf16_t* XC = (const bf16_t*)(p.ws + OFF_XC);
    const bf16_t* Z = (const bf16_t*)(p.ws + OFF_XM);
    const float* ng = p.in[44]; const float* skip = p.in[45];
    const int tid_ = opaque_tid(); const int lane = tid_ & 63, gw = blockIdx.x * NWV + (tid_ >> 6), ngw = gridDim.x * NWV;
    const int h = gw & 3, c0 = h * 512 + lane * 8;
    float gn8[8], sk8[8];
    { const float4 a0 = ld4(ng + c0), a1 = ld4(ng + c0 + 4), b0 = ld4(skip + c0), b1 = ld4(skip + c0 + 4);
      gn8[0] = a0.x; gn8[1] = a0.y; gn8[2] = a0.z; gn8[3] = a0.w; gn8[4] = a1.x; gn8[5] = a1.y; gn8[6] = a1.z; gn8[7] = a1.w;
      sk8[0] = b0.x; sk8[1] = b0.y; sk8[2] = b0.z; sk8[3] = b0.w; sk8[4] = b1.x; sk8[5] = b1.y; sk8[6] = b1.z; sk8[7] = b1.w; }
    constexpr int NIT = NB * NL * 4;
    uint4 nh[2], nx[2], nz[2];
#pragma unroll
    for (int u = 0; u < 2; ++u) { const int it = gw + u * ngw, r = (it < NIT ? it : gw) >> 2, b = r >= NL ? 1 : 0, nn = r - b * NL;
        nh[u] = *(const uint4*)(H + (size_t)r * 2048 + c0); nx[u] = *(const uint4*)(XC + ((size_t)b * TB + NCX + nn) * 2048 + c0); nz[u] = *(const uint4*)(Z + (size_t)r * 2048 + c0); }
    for (int it0 = gw; it0 < NIT; it0 += 2 * ngw) {
        uint4 ch[2], cx[2], cz[2];
#pragma unroll
        for (int u = 0; u < 2; ++u) { ch[u] = nh[u]; cx[u] = nx[u]; cz[u] = nz[u]; }
#pragma unroll
        for (int u = 0; u < 2; ++u) { const int it = it0 + (2 + u) * ngw, r = (it < NIT ? it : gw) >> 2, b = r >= NL ? 1 : 0, nn = r - b * NL;
            nh[u] = *(const uint4*)(H + (size_t)r * 2048 + c0); nx[u] = *(const uint4*)(XC + ((size_t)b * TB + NCX + nn) * 2048 + c0); nz[u] = *(const uint4*)(Z + (size_t)r * 2048 + c0); }
#pragma unroll
        for (int u = 0; u < 2; ++u) {
            const int it = it0 + u * ngw, r = it >> 2;
            float v[8]; unpack8(ch[u], v);
            float sum = 0.f;
#pragma unroll
            for (int j = 0; j < 8; ++j) sum += v[j];
            const float mean = wave_sum(sum) * (1.f / 512.f);
            float sq = 0.f;
#pragma unroll
            for (int j = 0; j < 8; ++j) { v[j] -= mean; sq += v[j] * v[j]; }
            const float rstd = rsqrtf(wave_sum(sq) * (1.f / 512.f) + 1e-5f);
            float xc[8], z[8];
            unpack8(cx[u], xc); unpack8(cz[u], z);
            float o[8];
#pragma unroll
            for (int j = 0; j < 8; ++j) o[j] = (v[j] * rstd * gn8[j] + sk8[j] * xc[j]) * silu_f(z[j]);
            if (it < NIT) *(uint4*)(H + (size_t)r * 2048 + c0) = make_uint4(pack2bf(o[0], o[1]), pack2bf(o[2], o[3]), pack2bf(o[4], o[5]), pack2bf(o[6], o[7]));
        }
    }
}

__global__ void __launch_bounds__(NTHR) fwd_kernel(Params p) {
    extern __shared__ __attribute__((aligned(16))) float sm[];
    volatile LAS unsigned* xst = (volatile LAS unsigned*)((LAS char*)sm + (LDS_BYTES - 16));
    if (threadIdx.x == 0) { xst[0] = 0u; xst[1] = 0u; }
    __syncthreads();
    const XcdBarrier xbar = xcd_barrier_post((unsigned*)(p.ws + OFF_BAR), xst);
    const int tid = opaque_tid(), lane = tid & 63, wave = tid >> 6;
    float* modv = (float*)(p.ws + OFF_MODV);
    float* X1C = (float*)(p.ws + OFF_X1C);

    phase_mod(p, sm);
    phase_tables(p);
    transpose_convert(p.in[8], 1024, EIN, 4096, (bf16_t*)(p.ws + OFF_WT0), sm);
    transpose_convert(p.in[29], 1024, 4096, 4096, (bf16_t*)(p.ws + OFF_WT1), sm);
    transpose_convert(p.in[9], 1024, 1024, 1024, (bf16_t*)(p.ws + OFF_WT2), sm);
    transpose_convert(p.in[30], 2048, 1024, 1024, (bf16_t*)(p.ws + OFF_WT3), sm);
    xcd_barrier(xbar);

#pragma unroll 1
    for (int b = 0; b < NB; ++b) {
        if (b == 0) { phase_h0(p, 0); xcd_barrier(xbar); }
        run_gemm((const bf16_t*)(p.ws + OFF_YC), (const bf16_t*)(p.ws + OFF_WT0), TB, 3840, DM, EpBf16{(bf16_t*)(p.ws + OFF_P0), EIN, EIN}, sm);
        mini_gemm<3, 2>((const bf16_t*)(p.ws + OFF_YC), DM, 33 * (int)blockIdx.x, TB - 1, (const bf16_t*)(p.ws + OFF_WT0), DM, 3840, (bf16_t*)(p.ws + OFF_P0), EIN, 3840, 33, sm);
        xcd_barrier(xbar);
        {
            const int x = blockIdx.x & 7, q0 = blockIdx.x >> 3;
            R1Raw R;
            r1_consts(p, x, q0 & 1, sm);
            r1_load(p, x, q0 & 1, q0 >> 1, R);
            for (int q = q0; q < 2 * NCH; q += 32) rwkv1_unit(p, x, q & 1, q >> 1, sm, R, (q + 32 < 2 * NCH) ? ((q + 32) >> 1) : -1);
            gla_consts(p, x >> 1, sm);
            if (q0 < 8) { for (int g = 2 * q0; g < 2 * q0 + 2; ++g) gla1_unit(p, x >> 1, g & 1, (NCH / 2) * (x & 1) + (g >> 1), sm); }
            else { for (int g = 16 + (q0 - 8); g < NCH; g += 24) gla1_unit(p, x >> 1, g & 1, (NCH / 2) * (x & 1) + (g >> 1), sm); }
        }
        xcd_barrier(xbar);
        if (blockIdx.x < 128) gla2_unit(p, blockIdx.x);
        else if (blockIdx.x < 192) { const int i = (blockIdx.x - 128) >> 3; rwkv2_unit(p, (blockIdx.x & 7) * 2 + (i >> 2), i & 3, sm); }
        xcd_barrier(xbar);
        {
            const int x = blockIdx.x & 7, j = blockIdx.x >> 3;
            gla_consts(p, x >> 1, sm);
            const int r0 = j < 2 ? 2 * j : (j < 10 ? 4 + (j - 2) * 5 : 44 + (j - 10) * 4), nr = j < 2 ? 2 : (j < 10 ? 5 : 4);
            for (int r = r0; r < r0 + nr; ++r) rwkv3_unit(p, x, r, sm);
            for (int g = j; g < NCH / 2; g += 32) gla3_unit(p, x >> 1, (NCH / 2) * (x & 1) + g, sm);
        }
        xcd_barrier(xbar);
        run_gemm((const bf16_t*)(p.ws + OFF_YC), (const bf16_t*)(p.ws + OFF_WT2), TB, DM, DM, EpRes0{(float*)(p.ws + OFF_P0), modv, b}, sm);
        xcd_barrier(xbar);
        ln_rows((const float*)(p.ws + OFF_P0), p.in[0] + (size_t)b * NL * DM, p.in[2] + (size_t)b * NCX * DM, TB, p.in[6], p.in[7], p.out + (size_t)b * NL * DM, X1C + (size_t)b * NCX * DM, NCX,
                (bf16_t*)(p.ws + OFF_H1B) + (size_t)b * TB * DM, modv + (3 + 2) * 3072, modv + (3 + b) * 3072);
        if (b == 0) phase_h0(p, 1);
        xcd_barrier(xbar);
    }

    run_gemm((const bf16_t*)(p.ws + OFF_H1B), (const bf16_t*)(p.ws + OFF_WT1), RT, 2048, DM, EpBf16{(bf16_t*)(p.ws + OFF_XM), 2048, 2048}, sm);
    zero_f4((float*)(p.ws + OFF_H), (size_t)NB * NL * 1024);
    xcd_barrier(xbar);
    phase_conv1(p, sm);
    xcd_barrier(xbar);
    phase_x1(p, sm);
    xcd_barrier(xbar);
    phase_x2(p, sm);
    xcd_barrier(xbar);
    phase_mlstm(p, sm);
    xcd_barrier(xbar);
    phase_h1l(p);
    xcd_barrier(xbar);
    run_gemm((const bf16_t*)(p.ws + OFF_H1B), (const bf16_t*)(p.ws + OFF_WT1) + (size_t)2048 * 1024, NB * NL, 2048, DM, EpBf16{(bf16_t*)(p.ws + OFF_XM), 2048, 2048}, sm);
    xcd_barrier(xbar);
    phase_finish1(p);
    xcd_barrier(xbar);
    run_gemm((const bf16_t*)(p.ws + OFF_H), (const bf16_t*)(p.ws + OFF_WT3), NB * NL, DM, 2048, EpRes1{(float*)(p.ws + OFF_XC), modv + 3 * 3072}, sm);
    xcd_barrier(xbar);
    ln_rows((const float*)(p.ws + OFF_XC), p.out, p.out, NB * NL, p.in[6] + 1024, p.in[7] + 1024, p.out, p.out, 0);
}

extern "C" void kernel_launch(void* const* d_in, const int* in_sizes, int n_in, void* d_out, int out_size, void* d_ws, size_t ws_size, hipStream_t stream) {
    static int grid_blocks = 0;
    if (grid_blocks == 0) {
        if (ws_size < WS_NEED || n_in != 46) { fprintf(stderr, "kernel_launch: bad ws_size %zu (need %zu) or n_in %d\n", ws_size, (size_t)WS_NEED, n_in); grid_blocks = -1; return; }
        int dev = 0, cus = 0, per_cu = 0;
        (void)hipGetDevice(&dev);
        (void)hipDeviceGetAttribute(&cus, hipDeviceAttributeMultiprocessorCount, dev);
        (void)hipFuncSetAttribute((const void*)fwd_kernel, hipFuncAttributeMaxDynamicSharedMemorySize, LDS_BYTES);
        (void)hipOccupancyMaxActiveBlocksPerMultiprocessor(&per_cu, (const void*)fwd_kernel, NTHR, LDS_BYTES);
        if (per_cu < 1 || cus < 256) { fprintf(stderr, "kernel_launch: occupancy query says %d blocks/CU on %d CUs; this kernel needs 256 resident workgroups\n", per_cu, cus); grid_blocks = -1; return; }
        grid_blocks = 256;
    }
    if (grid_blocks < 0) return;
    (void)hipMemsetAsync((char*)d_ws + OFF_BAR, 0, XCD_BAR_WORDS * 4, stream);
    Params p{};
    for (int i = 0; i < 46; ++i) p.in[i] = (const float*)d_in[i];
    p.out = (float*)d_out; p.ws = (char*)d_ws;
    void* args[] = {&p};
    hipError_t e = hipLaunchCooperativeKernel((const void*)fwd_kernel, dim3(grid_blocks), dim3(NTHR), args, LDS_BYTES, stream);
    if (e != hipSuccess) fprintf(stderr, "cooperative launch failed: %s (grid %d)\n", hipGetErrorString(e), grid_blocks);
}
```

```cpp
#include <hip/hip_runtime.h>
#include <cstdio>
#include <cmath>

#define DEV __device__ __forceinline__

constexpr int NB = 2, NL = 8192, DM = 1024, NCX = 256, TB = NCX + NL;
constexpr int RT = NB * TB;
constexpr int NCH = TB / 64;
constexpr int EIN = 3872, RW0 = 1568;
constexpr int NTHR = 512, NWV = 8;
constexpr float ALPHA = 1.41421356237f;
constexpr float KSCALE = 0.04419417382f;

constexpr size_t OFF_MODV = 0;
constexpr size_t OFF_X1C  = 131072;
constexpr size_t OFF_BAR  = 3145728;
constexpr size_t OFF_BIG  = 4194304;
constexpr size_t OFF_P0   = OFF_BIG;
constexpr size_t OFF_YC   = OFF_BIG + (size_t)TB * EIN * 2;
constexpr size_t OFF_GDS  = OFF_YC + (size_t)TB * 1024 * 2;
constexpr size_t OFF_GDEC = OFF_GDS + (size_t)8 * NCH * 8192 * 4;
constexpr size_t OFF_RU   = OFF_GDEC + (size_t)8 * NCH * 64 * 4;
constexpr size_t OFF_RS0  = OFF_RU + (size_t)16 * NCH * 16384 * 2;
constexpr size_t OFF_BONS = OFF_RS0 + (size_t)16 * NCH * 4096 * 2;
constexpr size_t L0_END   = OFF_BONS + (size_t)2 * TB * 8 * 4;
constexpr size_t OFF_XM   = OFF_BIG;
constexpr size_t OFF_XC   = OFF_XM + (size_t)RT * 2048 * 2;
constexpr size_t OFF_H    = OFF_XC + (size_t)RT * 2048 * 2;
constexpr size_t OFF_WT0  = OFF_H + (size_t)NB * NL * 2048 * 2;
constexpr size_t OFF_WT1  = OFF_WT0 + (size_t)4096 * 1024 * 2;
constexpr size_t OFF_WT2  = OFF_WT1 + (size_t)4096 * 1024 * 2;
constexpr size_t OFF_WT3  = OFF_WT2 + (size_t)1024 * 1024 * 2;
constexpr size_t OFF_G16  = OFF_WT3 + (size_t)1024 * 2048 * 2;
constexpr size_t OFF_SMAT = OFF_G16 + (size_t)RT * 16 * 4;
constexpr size_t OFF_GSC  = OFF_SMAT + (size_t)NB * 4 * NCH * 4096 * 2;
constexpr size_t OFF_CSC  = OFF_GSC + (size_t)16 * TB * 4 * 4;
constexpr size_t OFF_NBUF = OFF_CSC + (size_t)16 * NCH * 2 * 4;
constexpr size_t OFF_GTAB = 3407872;
constexpr size_t OFF_WFT  = OFF_GTAB + (size_t)4 * 128 * 16 * 4;
static_assert(OFF_WFT + (size_t)16 * 4096 * 2 <= OFF_BIG, "low-region tables overflow");
constexpr size_t OFF_G16P = OFF_NBUF + (size_t)16 * NCH * 512 * 4;
constexpr size_t OFF_H1B  = OFF_G16;
constexpr size_t WS_NEED  = (OFF_G16P + (size_t)4 * RT * 16 * 4 > OFF_H1B + (size_t)RT * 1024 * 2) ? OFF_G16P + (size_t)4 * RT * 16 * 4 : OFF_H1B + (size_t)RT * 1024 * 2;
static_assert(WS_NEED <= (size_t)256 * 1024 * 1024, "workspace exceeds the guaranteed 256 MiB");

static_assert(L0_END <= OFF_WT0, "layer-0 buffers overlap the weight copies");
constexpr int LDS_BYTES = 139264;

struct Params { const float* in[46]; float* out; char* ws; };
typedef unsigned short bf16_t;
typedef __attribute__((ext_vector_type(8))) short bf16x8;
typedef __attribute__((ext_vector_type(4))) short s16x4;
typedef __attribute__((ext_vector_type(2))) short s16x2;
typedef __attribute__((ext_vector_type(4))) float f32x4;
typedef __attribute__((ext_vector_type(2))) __bf16 bf2_t;
DEV unsigned pack2bf(float lo, float hi) { bf2_t v; v[0] = (__bf16)lo; v[1] = (__bf16)hi; return __builtin_bit_cast(unsigned, v); }
DEV float bflo(unsigned u) { return __uint_as_float(u << 16); }
DEV float bfhi(unsigned u) { return __uint_as_float(u & 0xffff0000u); }
DEV float bf2f(bf16_t v) { return __uint_as_float(((unsigned)v) << 16); }
DEV void unpack8(uint4 u, float* f) { f[0] = bflo(u.x); f[1] = bfhi(u.x); f[2] = bflo(u.y); f[3] = bfhi(u.y); f[4] = bflo(u.z); f[5] = bfhi(u.z); f[6] = bflo(u.w); f[7] = bfhi(u.w); }

#define DPPX_F(src_, ctrl_) __int_as_float(__builtin_amdgcn_update_dpp(0, __float_as_int(src_), (ctrl_), 0xf, 0xf, false))
DEV float red8_sum(float v) { v += DPPX_F(v, 0xB1); v += DPPX_F(v, 0x4E); v += DPPX_F(v, 0x141); return v; }
DEV float wave_sum(float v) {
    v += DPPX_F(v, 0xB1); v += DPPX_F(v, 0x4E); v += DPPX_F(v, 0x141); v += DPPX_F(v, 0x140);
    const int b = __float_as_int(v);
    return (__int_as_float(__builtin_amdgcn_readlane(b, 0)) + __int_as_float(__builtin_amdgcn_readlane(b, 16))) + (__int_as_float(__builtin_amdgcn_readlane(b, 32)) + __int_as_float(__builtin_amdgcn_readlane(b, 48)));
}
DEV float wave_max(float v) {
    v = fmaxf(v, DPPX_F(v, 0xB1)); v = fmaxf(v, DPPX_F(v, 0x4E)); v = fmaxf(v, DPPX_F(v, 0x141)); v = fmaxf(v, DPPX_F(v, 0x140));
    const int b = __float_as_int(v);
    return fmaxf(fmaxf(__int_as_float(__builtin_amdgcn_readlane(b, 0)), __int_as_float(__builtin_amdgcn_readlane(b, 16))), fmaxf(__int_as_float(__builtin_amdgcn_readlane(b, 32)), __int_as_float(__builtin_amdgcn_readlane(b, 48))));
}
DEV float fexp(float x) { return __expf(x); }
DEV float frcp(float x) { return __builtin_amdgcn_rcpf(x); }
DEV float sigmoid_f(float x) { return frcp(1.f + fexp(-x)); }
DEV float silu_f(float x) { return x * frcp(1.f + fexp(-x)); }
DEV float logsig_f(float x) { return fminf(x, 0.f) - __logf(1.f + fexp(-fabsf(x))); }
DEV float tanh_f(float x) { const float e = fexp(2.f * x); return 1.f - 2.f * frcp(e + 1.f); }
DEV void lds_fence() { asm volatile("" ::: "memory"); }
DEV int opaque_tid() { int t = threadIdx.x; asm volatile("" : "+v"(t)); return t; }
DEV int scan_s(int dir, int u) { return dir == 0 ? u : (u < NCX ? (NCX - 1 - u) : (TB - 1 + NCX - u)); }
DEV int chunk_at(int dir, int step) { return dir == 0 ? step : (step < 4 ? 3 - step : (NCH + 3 - step)); }
DEV float4 ld4(const float* p) { return *(const float4*)p; }
DEV void st4(float* p, float4 v) { *(float4*)p = v; }


#define XB_TMO      128
#define XB_XCNT(j)  (256  + 64 * (j))
#define XB_XSUB(j)  (1280 + 64 * (j))
#define XB_XGEN(j)  (2304 + 64 * (j))
#define XB_TOP      3328
#define XB_TOPGEN   3392
#define XCD_BAR_WORDS 3456
#define XB_SPIN_CAP (1u << 22)
#define LAS __attribute__((address_space(3)))
DEV unsigned xb_ld(unsigned* p) { return __hip_atomic_load(p, __ATOMIC_RELAXED, __HIP_MEMORY_SCOPE_AGENT); }
DEV unsigned xb_add(unsigned* p, unsigned v) { return __hip_atomic_fetch_add(p, v, __ATOMIC_RELAXED, __HIP_MEMORY_SCOPE_AGENT); }
DEV unsigned xb_xcc_id() { return (unsigned)__builtin_amdgcn_s_getreg((3 << 11) | 20) & 0xFu; }
#define XB_SPIN(cond, bar) do { unsigned _sp = 0; while (cond) { __builtin_amdgcn_s_sleep(1); \
    if ((++_sp & 255u) == 0u) { if (xb_ld(&(bar)[XB_TMO])) break; if (_sp > XB_SPIN_CAP) { atomicAdd(&(bar)[XB_TMO], 1u); break; } } } } while (0)
struct XcdBarrier { unsigned* bar; unsigned x; volatile LAS unsigned* st; };
DEV XcdBarrier xcd_barrier_post(unsigned* bar, volatile LAS unsigned* st) {
    XcdBarrier b; b.bar = bar; b.x = xb_xcc_id(); b.st = st;
    if (threadIdx.x == 0) (void)xb_add(&bar[XB_XCNT(b.x)], 1u);
    return b;
}
DEV void xcd_barrier_complete(unsigned* bar, unsigned x, unsigned& nloc, unsigned& nx) {
    const unsigned G = gridDim.x * gridDim.y * gridDim.z;
    unsigned sum, cnt, mine, sp = 0u;
    for (;;) {
        sum = 0u; cnt = 0u; mine = 0u;
#pragma unroll
        for (unsigned j = 0; j < 16; ++j) { const unsigned c = xb_ld(&bar[XB_XCNT(j)]); sum += c; cnt += (c > 0u) ? 1u : 0u; mine = (j == x) ? c : mine; }
        if (sum == G) break;
        __builtin_amdgcn_s_sleep(1);
        if ((++sp & 255u) == 0u) { if (xb_ld(&bar[XB_TMO])) break; if (sp > XB_SPIN_CAP) { atomicAdd(&bar[XB_TMO], 1u); break; } }
    }
    nloc = mine > 0u ? mine : 1u; nx = cnt > 0u ? cnt : 1u;
}
DEV void xcd_barrier(const XcdBarrier& b) {
    asm volatile("s_waitcnt vmcnt(0)" ::: "memory");
    __syncthreads();
    if (threadIdx.x == 0) {
        unsigned* bar = b.bar;
        __builtin_amdgcn_s_waitcnt(0);
        unsigned nloc = b.st[0], nx = b.st[1];
        if (nloc == 0u) { xcd_barrier_complete(bar, b.x, nloc, nx); b.st[0] = nloc; b.st[1] = nx; }
        const unsigned old = xb_add(&bar[XB_XSUB(b.x)], 1u);
        const unsigned gen = old / nloc;
        if (old + 1u == (gen + 1u) * nloc) {
            __builtin_amdgcn_fence(__ATOMIC_RELEASE, "agent");
            asm volatile("s_waitcnt vmcnt(0)" ::: "memory");
            const unsigned og = xb_add(&bar[XB_TOP], 1u);
            const unsigned tg = og / nx;
            if (og + 1u == (tg + 1u) * nx) xb_add(&bar[XB_TOPGEN], 1u);
            else XB_SPIN(xb_ld(&bar[XB_TOPGEN]) == tg, bar);
            __builtin_amdgcn_fence(__ATOMIC_ACQUIRE, "agent");
            xb_add(&bar[XB_XGEN(b.x)], 1u);
            asm volatile("s_waitcnt vmcnt(0)" ::: "memory");
        } else {
            XB_SPIN(xb_ld(&bar[XB_XGEN(b.x)]) == gen, bar);
            __builtin_amdgcn_fence(__ATOMIC_ACQUIRE, "agent");
            asm volatile("s_waitcnt vmcnt(0)" ::: "memory");
        }
    }
    __syncthreads();
}

namespace pg8 {
#define PG8_LAS __attribute__((address_space(3)))
typedef unsigned short bf16_t;
typedef short bf16x8 __attribute__((ext_vector_type(8)));
typedef float f32x4 __attribute__((ext_vector_type(4)));
typedef unsigned u32x4 __attribute__((ext_vector_type(4)));
constexpr int BM = 256, BK = 64, HALF = 128, HTB = HALF * BK * 2  , STAGE_BYTES = 8 * HTB, NXCD = 8, WGM = 8;

__host__ __device__ __forceinline__ int lds_byte(int r, int c) { const int st = (r >> 4) * 2 + (c >> 5), rr = r & 15, cc = c & 31, ob = rr * 64 + cc * 2; return st * 1024 + (ob ^ (((ob >> 9) & 1) << 5)); }
__host__ __device__ __forceinline__ void stage_rc(int b, int& R, int& C) { const int st = b / 1024, sb = b % 1024, swz = sb ^ (((sb >> 9) & 1) << 5); R = (st >> 1) * 16 + swz / 64; C = (st & 1) * 32 + (swz % 64) / 2; }
__host__ __device__ __forceinline__ int perm32(int rho) { const int n = rho >> 4, i = rho & 15; return 8 * (i >> 2) + 4 * n + (i & 3); }

struct Unit { int pm, pn; };
struct Gemm { const bf16_t* A; const bf16_t* Bt; int M, N, K; };

struct StaticOrder {
    int nM, nN, nwg, G, c;
    __host__ __device__ void init(int M, int N, int G_, int c_) { nM = M / BM; nN = N / BM; nwg = nM * nN; G = G_; c = c_; }
    __host__ __device__ bool next(int i, Unit& u) const {
        const long L = (long)i * G + c; if (L >= nwg) return false;
        int wgid = (int)L; { const int q = nwg / NXCD, r = nwg % NXCD, xcd = wgid % NXCD, off = wgid / NXCD; wgid = (xcd < r ? xcd * (q + 1) : r * (q + 1) + (xcd - r) * q) + off; }
        const int nig = WGM * nN, gid = wgid / nig, fm = gid * WGM, gsz = (nM - fm) < WGM ? (nM - fm) : WGM;
        u.pm = fm + ((wgid % nig) % gsz); u.pn = (wgid % nig) / gsz; return true;
    }
    __device__ __forceinline__ void a_ready(const Unit&) const {}
    __device__ __forceinline__ void done(const Unit&) const {}
};

template <class Epi, class Sched, bool STAMP = false>
__device__ __forceinline__ void gemm_phase(PG8_LAS unsigned char* lds, const Gemm g, const Sched& S, const Epi& E, unsigned long long* stamps) {
    int tid = threadIdx.x; asm volatile("" : "+v"(tid));
    const int wid = __builtin_amdgcn_readfirstlane(tid >> 6), lane = tid & 63, wr = wid >> 2, wc = wid & 3, fr = lane & 15, fq = lane >> 4;
    const int K = g.K, nt = K / BK;
#define PG8_STAMP() do { } while (0)
    PG8_STAMP();
    unsigned voffA[2], voffB[2];
#pragma unroll
    for (int i = 0; i < 2; ++i) { int R, C; stage_rc(tid * 16 + i * 8192, R, C); const int Rb = Epi::PERM ? ((R & ~31) + perm32(R & 31)) : R;
        voffA[i] = (unsigned)(R * K + C) * 2u; voffB[i] = (unsigned)(Rb * K + C) * 2u; }
    const size_t kstep = (size_t)(BK * 2);
    const size_t hstep = (size_t)HALF * K * 2;
    const size_t tstep = 2 * hstep;
    const unsigned ldsw = (unsigned)wid * 1024u;
    const int aoff = lds_byte(wr * 64 + fr, fq * 8), boff = lds_byte(wc * 32 + fr, fq * 8);
#define PG8_SA(b, h) (((b) * 2 + (h)) * HTB)
#define PG8_SB(b, h) ((4 + (b) * 2 + (h)) * HTB)
#define PG8_STAGE(bufoff, gbase, voff) do { _Pragma("unroll") for (int _i = 0; _i < 2; ++_i) \
        __builtin_amdgcn_global_load_lds((const unsigned*)((const char*)(gbase) + (voff)[_i]), (PG8_LAS unsigned*)(lds + (bufoff) + ldsw + _i * 8192), 16, 0, 0); } while (0)
#define PG8_LDA(dst, b, h) do { _Pragma("unroll") for (int m = 0; m < 4; ++m) _Pragma("unroll") for (int k = 0; k < 2; ++k) dst[m][k] = *(const PG8_LAS bf16x8*)(lds + PG8_SA(b, h) + aoff + m * 2048 + k * 1024); } while (0)
#define PG8_LDB(dst, b, h) do { _Pragma("unroll") for (int n = 0; n < 2; ++n) _Pragma("unroll") for (int k = 0; k < 2; ++k) dst[n][k] = *(const PG8_LAS bf16x8*)(lds + PG8_SB(b, h) + boff + n * 2048 + k * 1024); } while (0)
#define PG8_MMA(ai, bj, At, Bt) do { __builtin_amdgcn_s_setprio(1); _Pragma("unroll") for (int m = 0; m < 4; ++m) _Pragma("unroll") for (int n = 0; n < 2; ++n) _Pragma("unroll") for (int k = 0; k < 2; ++k) \
        acc[ai][bj][m][n] = __builtin_amdgcn_mfma_f32_16x16x32_bf16(Bt[n][k], At[m][k], acc[ai][bj][m][n], 0, 0, 0); __builtin_amdgcn_s_setprio(0); } while (0)
#define PG8_WAIT_V(n) asm volatile("s_waitcnt vmcnt(" #n ")" ::: "memory")
#define PG8_WAIT_L(n) asm volatile("s_waitcnt lgkmcnt(" #n ")" ::: "memory")
#define PG8_BAR __builtin_amdgcn_s_barrier()
#define PG8_SCHED __builtin_amdgcn_sched_barrier(0)
    Unit cur, nxt; int ui = 0;
    if (!S.next(0, cur)) return;
    f32x4 acc[2][2][4][2];
#pragma unroll
    for (int a = 0; a < 2; ++a)
#pragma unroll
        for (int b = 0; b < 2; ++b)
#pragma unroll
            for (int m = 0; m < 4; ++m)
#pragma unroll
                for (int n = 0; n < 2; ++n) acc[a][b][m][n] = (f32x4){0.f, 0.f, 0.f, 0.f};
    bf16x8 At[4][2], B0[2][2], B1[2][2];
    const char* cA = (const char*)g.A + (size_t)cur.pm * tstep; const char* cB = (const char*)g.Bt + (size_t)cur.pn * tstep;
    S.a_ready(cur);
    PG8_STAGE(PG8_SB(0, 0), cB, voffB); PG8_STAGE(PG8_SA(0, 0), cA, voffA); PG8_STAGE(PG8_SB(0, 1), cB + hstep, voffB); PG8_STAGE(PG8_SA(0, 1), cA + hstep, voffA);
    if (wr == 1) PG8_BAR;
    PG8_WAIT_V(4); PG8_BAR;
    PG8_STAGE(PG8_SB(1, 0), cB + kstep, voffB); PG8_STAGE(PG8_SA(1, 0), cA + kstep, voffA); PG8_STAGE(PG8_SB(1, 1), cB + hstep + kstep, voffB);
    PG8_WAIT_V(6); PG8_BAR;
    PG8_STAMP();
    for (;;) {
        const bool has_next = S.next(ui + 1, nxt);
        const char* nA = has_next ? (const char*)g.A + (size_t)nxt.pm * tstep : cA; const char* nB = has_next ? (const char*)g.Bt + (size_t)nxt.pn * tstep : cB;
        for (int t = 0; t < nt; t += 2) {
            const bool last = (t == nt - 2);
            const char* a1 = cA + (size_t)(t + 1) * kstep;
            const char* a2 = last ? nA : cA + (size_t)(t + 2) * kstep; const char* b2 = last ? nB : cB + (size_t)(t + 2) * kstep;
            const char* a3 = a2 + kstep; const char* b3 = b2 + kstep;
            if (last && has_next) S.a_ready(nxt);
            PG8_LDB(B0, 0, 0); PG8_SCHED; PG8_LDA(At, 0, 0); PG8_STAGE(PG8_SA(1, 1), a1 + hstep, voffA);
            PG8_WAIT_L(8); PG8_BAR; PG8_WAIT_L(0); PG8_MMA(0, 0, At, B0); PG8_BAR; PG8_SCHED;
            PG8_LDB(B1, 0, 1); PG8_STAGE(PG8_SB(0, 0), b2, voffB);
            PG8_BAR; PG8_WAIT_L(0); PG8_MMA(0, 1, At, B1); PG8_BAR;
            PG8_LDA(At, 0, 1); PG8_STAGE(PG8_SA(0, 0), a2, voffA);
            PG8_BAR; PG8_WAIT_L(0); PG8_MMA(1, 0, At, B0); PG8_BAR; PG8_SCHED;
            PG8_STAGE(PG8_SB(0, 1), b2 + hstep, voffB);
            PG8_WAIT_V(6); PG8_BAR; PG8_MMA(1, 1, At, B1); PG8_BAR;
            PG8_LDB(B0, 1, 0); PG8_SCHED; PG8_LDA(At, 1, 0); PG8_STAGE(PG8_SA(0, 1), a2 + hstep, voffA);
            PG8_WAIT_L(8); PG8_BAR; PG8_WAIT_L(0); PG8_MMA(0, 0, At, B0); PG8_BAR; PG8_SCHED;
            PG8_LDB(B1, 1, 1); PG8_STAGE(PG8_SB(1, 0), b3, voffB);
            PG8_BAR; PG8_WAIT_L(0); PG8_MMA(0, 1, At, B1); PG8_BAR;
            PG8_LDA(At, 1, 1); PG8_STAGE(PG8_SA(1, 0), a3, voffA);
            PG8_BAR; PG8_WAIT_L(0); PG8_MMA(1, 0, At, B0); PG8_BAR; PG8_SCHED;
            PG8_STAGE(PG8_SB(1, 1), b3 + hstep, voffB);
            PG8_WAIT_V(6); PG8_BAR; PG8_MMA(1, 1, At, B1); PG8_BAR;
        }
        PG8_STAMP();
        if constexpr (!Epi::AFTER_DRAIN) { E(acc, cur, wr, wc, fr, fq); S.done(cur); }
        PG8_STAMP();
        if (!has_next) break;
#pragma unroll
        for (int a = 0; a < 2; ++a)
#pragma unroll
            for (int b = 0; b < 2; ++b)
#pragma unroll
                for (int m = 0; m < 4; ++m)
#pragma unroll
                    for (int n = 0; n < 2; ++n) acc[a][b][m][n] = (f32x4){0.f, 0.f, 0.f, 0.f};
        cur = nxt; cA = nA; cB = nB; ++ui;
    }
    PG8_WAIT_V(0);
    if (wr == 0) PG8_BAR;
    PG8_BAR;
    if constexpr (Epi::AFTER_DRAIN) { E.fused(acc, cur, wr, wc, fr, fq, lds, wid, lane); S.done(cur); }
    PG8_STAMP();
#undef PG8_STAMP
#undef PG8_SA
#undef PG8_SB
#undef PG8_STAGE
#undef PG8_LDA
#undef PG8_LDB
#undef PG8_MMA
#undef PG8_WAIT_V
#undef PG8_WAIT_L
#undef PG8_BAR
#undef PG8_SCHED
}
}

DEV void transpose_convert(const float* __restrict__ W, int K, int N, int Npad, bf16_t* Wt, float* sm) {
    float (*T)[65] = (float (*)[65])sm;
    const int tid = opaque_tid();
    const int kt = K / 64, ntl = Npad / 64;
    for (int tile = blockIdx.x; tile < kt * ntl; tile += gridDim.x) {
        const int k0 = (tile / ntl) * 64, n0 = (tile % ntl) * 64;
        __syncthreads();
#pragma unroll
        for (int i = 0; i < 2; ++i) {
            const int k = (tid >> 4) + 32 * i, n4 = (tid & 15) * 4;
            float4 v = make_float4(0.f, 0.f, 0.f, 0.f);
            if (n0 + n4 < N) v = ld4(W + (size_t)(k0 + k) * N + n0 + n4);
            T[k][n4] = v.x; T[k][n4 + 1] = v.y; T[k][n4 + 2] = v.z; T[k][n4 + 3] = v.w;
        }
        __syncthreads();
        const int n = tid >> 3, kq = (tid & 7) * 8;
        unsigned o[4];
#pragma unroll
        for (int j = 0; j < 4; ++j) o[j] = pack2bf(T[kq + 2 * j][n], T[kq + 2 * j + 1][n]);
        bf16_t* dst = Wt + (size_t)(n0 + n) * K + k0 + kq;
        *(uint4*)dst = make_uint4(o[0], o[1], o[2], o[3]);
    }
}

struct EpBf16 {
    static constexpr bool PERM = true, AFTER_DRAIN = false;
    bf16_t* O; int ldc; int ncols;
    DEV void operator()(const pg8::f32x4 (&acc)[2][2][4][2], const pg8::Unit& u, int wr, int wc, int fr, int fq) const {
        const int row0 = u.pm * 256 + wr * 64 + fr, col0 = u.pn * 256 + wc * 32 + 8 * fq;
#pragma unroll
        for (int ai = 0; ai < 2; ++ai)
#pragma unroll
            for (int m = 0; m < 4; ++m) {
                bf16_t* rowp = O + (size_t)(row0 + ai * 128 + m * 16) * ldc + col0;
#pragma unroll
                for (int bj = 0; bj < 2; ++bj) {
                    if (col0 + bj * 128 < ncols) {
                        const pg8::f32x4 v0 = acc[ai][bj][m][0], v1 = acc[ai][bj][m][1];
                        *(uint4*)(rowp + bj * 128) = make_uint4(pack2bf(v0[0], v0[1]), pack2bf(v0[2], v0[3]), pack2bf(v1[0], v1[1]), pack2bf(v1[2], v1[3]));
                    }
                }
            }
    }
};
struct EpRes0 {
    static constexpr bool PERM = false, AFTER_DRAIN = false;
    float* C; const float* mv; int b;
    DEV void operator()(const pg8::f32x4 (&acc)[2][2][4][2], const pg8::Unit& u, int wr, int wc, int fr, int fq) const {
        const bool isc = (u.pm * 256 < NCX);
        const float* gp = mv + (isc ? 2 : b) * 3072 + 2048;
        const int row0 = u.pm * 256 + wr * 64 + fr, col0 = u.pn * 256 + wc * 32 + 4 * fq;
#pragma unroll
        for (int ai = 0; ai < 2; ++ai)
#pragma unroll
            for (int m = 0; m < 4; ++m) {
                const size_t ro = (size_t)(row0 + ai * 128 + m * 16) * DM + col0;
#pragma unroll
                for (int bj = 0; bj < 2; ++bj)
#pragma unroll
                    for (int n = 0; n < 2; ++n) {
                        const int co = bj * 128 + n * 16;
                        const float4 g = ld4(gp + col0 + co); const pg8::f32x4 v = acc[ai][bj][m][n];
                        st4(C + ro + co, make_float4(g.x * v[0], g.y * v[1], g.z * v[2], g.w * v[3]));
                    }
            }
    }
};
struct EpRes1 {
    static constexpr bool PERM = false, AFTER_DRAIN = false;
    float* C; const float* mv;
    DEV void operator()(const pg8::f32x4 (&acc)[2][2][4][2], const pg8::Unit& u, int wr, int wc, int fr, int fq) const {
        const float* gp = mv + (u.pm * 256 >= NL ? 1 : 0) * 3072 + 2048;
        const int row0 = u.pm * 256 + wr * 64 + fr, col0 = u.pn * 256 + wc * 32 + 4 * fq;
#pragma unroll
        for (int ai = 0; ai < 2; ++ai)
#pragma unroll
            for (int m = 0; m < 4; ++m) {
                const size_t ro = (size_t)(row0 + ai * 128 + m * 16) * DM + col0;
#pragma unroll
                for (int bj = 0; bj < 2; ++bj)
#pragma unroll
                    for (int n = 0; n < 2; ++n) {
                        const int co = bj * 128 + n * 16;
                        const float4 g = ld4(gp + col0 + co); const pg8::f32x4 v = acc[ai][bj][m][n];
                        st4(C + ro + co, make_float4(g.x * v[0], g.y * v[1], g.z * v[2], g.w * v[3]));
                    }
            }
    }
};
template <class EP>
DEV void run_gemm(const bf16_t* A, const bf16_t* Bt, int M, int N, int K, const EP& ep, float* sm) {
    pg8::Gemm g{A, Bt, M, N, K}; pg8::StaticOrder S; S.init(M, N, (int)gridDim.x, (int)blockIdx.x);
    pg8::gemm_phase<EP, pg8::StaticOrder, false>((PG8_LAS unsigned char*)sm, g, S, ep, nullptr);
}

template <int MT, int NT>
DEV void mini_gemm(const bf16_t* A, int lda, int row0, int row_clamp, const bf16_t* Bt, int ldb, int brow0, bf16_t* C, int ldc, int ccol0, int nvalid, float* sm) {
    const int tid = opaque_tid(), lane = tid & 63, wave = tid >> 6, l15 = lane & 15, g = lane >> 4;
    f32x4 acc[MT][NT];
#pragma unroll
    for (int m = 0; m < MT; ++m)
#pragma unroll
        for (int n = 0; n < NT; ++n) acc[m][n] = (f32x4){0.f, 0.f, 0.f, 0.f};
    const bf16_t* ap[MT]; const bf16_t* bp[NT];
#pragma unroll
    for (int m = 0; m < MT; ++m) { const int r = row0 + m * 16 + l15; ap[m] = A + (size_t)(r < row_clamp ? r : row_clamp) * lda + wave * 128 + g * 8; }
#pragma unroll
    for (int n = 0; n < NT; ++n) bp[n] = Bt + (size_t)(brow0 + n * 16 + l15) * ldb + wave * 128 + g * 8;
#pragma unroll
    for (int kh = 0; kh < 2; ++kh) {
        bf16x8 af[2][MT], bq[2][NT];
#pragma unroll
        for (int ks = 0; ks < 2; ++ks) {
#pragma unroll
            for (int m = 0; m < MT; ++m) af[ks][m] = *(const bf16x8*)(ap[m] + (kh * 2 + ks) * 32);
#pragma unroll
            for (int n = 0; n < NT; ++n) bq[ks][n] = *(const bf16x8*)(bp[n] + (kh * 2 + ks) * 32);
        }
#pragma unroll
        for (int ks = 0; ks < 2; ++ks)
#pragma unroll
            for (int m = 0; m < MT; ++m)
#pragma unroll
                for (int n = 0; n < NT; ++n) acc[m][n] = __builtin_amdgcn_mfma_f32_16x16x32_bf16(af[ks][m], bq[ks][n], acc[m][n], 0, 0, 0);
    }
    __syncthreads();
#pragma unroll
    for (int m = 0; m < MT; ++m)
#pragma unroll
        for (int n = 0; n < NT; ++n) st4(sm + ((wave * MT + m) * NT + n) * 256 + lane * 4, make_float4(acc[m][n][0], acc[m][n][1], acc[m][n][2], acc[m][n][3]));
    __syncthreads();
    for (int e = tid; e < MT * NT * 256; e += NTHR) {
        const int tile = e >> 8, idx = e & 255, ln = idx >> 2, r = idx & 3;
        float s = 0.f;
#pragma unroll
        for (int w = 0; w < NWV; ++w) s += sm[(w * MT * NT + tile) * 256 + idx];
        const int i = (tile / NT) * 16 + (ln >> 4) * 4 + r, j = (tile % NT) * 16 + (ln & 15);
        if (i < nvalid) C[(size_t)(row0 + i) * ldc + ccol0 + j] = __builtin_bit_cast(unsigned short, (__bf16)s);
    }
}

struct Mod8 { float4 s0, s1, c0, c1; };
DEV Mod8 mod8_load(const float* m, int k) { Mod8 q; q.s0 = ld4(m + k); q.s1 = ld4(m + k + 4); q.c0 = ld4(m + 1024 + k); q.c1 = ld4(m + 1024 + k + 4); return q; }
DEV uint4 mod8_apply(const float4 x0, const float4 x1, const Mod8& q) {
    return make_uint4(pack2bf(x0.x * (1.f + q.c0.x) + q.s0.x, x0.y * (1.f + q.c0.y) + q.s0.y), pack2bf(x0.z * (1.f + q.c0.z) + q.s0.z, x0.w * (1.f + q.c0.w) + q.s0.w),
                      pack2bf(x1.x * (1.f + q.c1.x) + q.s1.x, x1.y * (1.f + q.c1.y) + q.s1.y), pack2bf(x1.z * (1.f + q.c1.z) + q.s1.z, x1.w * (1.f + q.c1.w) + q.s1.w));
}
DEV void phase_h0(const Params& p, int b) {
    const float* modv = (const float*)(p.ws + OFF_MODV);
    bf16_t* H0 = (bf16_t*)(p.ws + OFF_YC);
    const int gt = blockIdx.x * NTHR + opaque_tid(), gn = gridDim.x * NTHR;
    const int k = (gt & 127) * 8;
    const Mod8 mc = mod8_load(modv + 2 * 3072, k), ml = mod8_load(modv + b * 3072, k);
    for (int i0 = gt; i0 < TB * 128; i0 += 4 * gn) {
        float4 xa[4], xb[4];
#pragma unroll
        for (int u = 0; u < 4; ++u) {
            const int i = i0 + u * gn, s = (i < TB * 128 ? i : gt) >> 7;
            const float* src = (s < NCX) ? p.in[2] + ((size_t)(b * NCX + s)) * DM + k : p.in[0] + ((size_t)(b * NL + s - NCX)) * DM + k;
            xa[u] = ld4(src); xb[u] = ld4(src + 4);
        }
#pragma unroll
        for (int u = 0; u < 4; ++u) {
            const int i = i0 + u * gn, s = i >> 7;
            if (i < TB * 128) *(uint4*)(H0 + (size_t)s * DM + k) = mod8_apply(xa[u], xb[u], (s < NCX) ? mc : ml);
        }
    }
}

DEV void phase_mod(const Params& p, float* sm) {
    const float* c = p.in[1]; const float* cctx = p.in[3];
    const float* mod_w = p.in[4]; const float* mod_b = p.in[5];
    float* modv = (float*)(p.ws + OFF_MODV);
    float* sil = sm; float* red = sm + 3072;
    const int tid = opaque_tid();
    for (int i = tid; i < 3072; i += NTHR) {
        const int j = i >> 10, k = i & 1023;
        const float v = (j < 2) ? c[j * 1024 + k] : cctx[k];
        sil[i] = silu_f(v);
    }
    __syncthreads();
    for (int unit = blockIdx.x; unit < 192; unit += gridDim.x) {
        const int l = unit / 96, cb = unit % 96;
        const int kg = tid >> 5, col = tid & 31, n = cb * 32 + col;
        const float* w = mod_w + (size_t)l * 1024 * 3072 + n;
        float a0 = 0.f, a1 = 0.f, a2 = 0.f;
        for (int k = kg * 64; k < kg * 64 + 64; ++k) {
            const float wv = w[(size_t)k * 3072];
            a0 += sil[k] * wv; a1 += sil[1024 + k] * wv; a2 += sil[2048 + k] * wv;
        }
        red[(kg * 3 + 0) * 32 + col] = a0; red[(kg * 3 + 1) * 32 + col] = a1; red[(kg * 3 + 2) * 32 + col] = a2;
        __syncthreads();
        if (tid < 96) {
            const int j = tid >> 5, cc = tid & 31, nn = cb * 32 + cc;
            float s = mod_b[l * 3072 + nn];
            for (int g = 0; g < 16; ++g) s += red[(g * 3 + j) * 32 + cc];
            modv[(l * 3 + j) * 3072 + nn] = s;
        }
        __syncthreads();
    }
}

DEV void phase_tables(const Params& p) {
    const float* wq = p.in[33]; const float* wk = p.in[34]; const float* wv = p.in[35];
    const float* gw0 = p.in[36]; const float* gw1 = p.in[38]; const float* gw2 = p.in[40]; const float* gw3 = p.in[42];
    float* gtab = (float*)(p.ws + OFF_GTAB); bf16_t* wft = (bf16_t*)(p.ws + OFF_WFT);
    const int gt = blockIdx.x * NTHR + opaque_tid(), gn = gridDim.x * NTHR;
    for (int i = gt; i < 512 * 16; i += gn) {
        const int gb = i >> 4, cp = (i >> 2) & 3, c = i & 3;
        float s = 0.f;
#pragma unroll
        for (int d = 0; d < 4; ++d) s += wq[gb * 16 + cp * 4 + d] * wk[gb * 16 + c * 4 + d];
        gtab[i] = s * KSCALE;
    }
    for (int i = gt; i < 4096 * 16; i += gn) {
        const int g = i >> 12, k = i & 4095, gm = g >> 2, hd = g & 3;
        const float* wg = gm == 0 ? gw0 : (gm == 1 ? gw1 : (gm == 2 ? gw2 : gw3));
        float s = 0.f;
        if (k < 2048) {
            const int blk = k >> 2, cc = k & 3;
#pragma unroll
            for (int d = 0; d < 4; ++d) s += wq[blk * 16 + cc * 4 + d] * wg[(size_t)(4 * blk + d) * 4 + hd] + wk[blk * 16 + cc * 4 + d] * wg[(size_t)(2048 + 4 * blk + d) * 4 + hd];
        } else {
            const int kk = k - 2048, blk = kk >> 2, cc = kk & 3;
#pragma unroll
            for (int d = 0; d < 4; ++d) s += wv[blk * 16 + cc * 4 + d] * wg[(size_t)(4096 + 4 * blk + d) * 4 + hd];
        }
        wft[i] = __builtin_bit_cast(unsigned short, (__bf16)s);
    }
}

DEV float dpp_add(float v, float acc_src, int) { return v + acc_src; }
#define DPP_F(src_, ctrl_, rmask_) __int_as_float(__builtin_amdgcn_update_dpp(0, __float_as_int(src_), (ctrl_), (rmask_), 0xf, false))
DEV float wave_scan_add(float v, int lane, int dir) {
    float p = v;
    p += DPP_F(p, 0x111, 0xf);
    p += DPP_F(p, 0x112, 0xf);
    p += DPP_F(p, 0x114, 0xf);
    p += DPP_F(p, 0x118, 0xf);
    p += DPP_F(p, 0x142, 0xa);
    p += DPP_F(p, 0x143, 0xc);
    if (dir) { const float tot = __int_as_float(__builtin_amdgcn_readlane(__float_as_int(p), 63)); p = tot - p + v; }
    return p;
}
DEV float wave_scan_max(float v, int lane, int dir) {
#pragma unroll
    for (int o = 1; o < 64; o <<= 1) {
        const float n = dir ? __shfl_down(v, o, 64) : __shfl_up(v, o, 64);
        const bool ok = dir ? (lane + o < 64) : (lane >= o);
        if (ok) v = fmaxf(v, n);
    }
    return v;
}

constexpr int GLC_OFF = 30336;
static_assert((GLC_OFF + 2176) * 4 <= LDS_BYTES - 16, "GLA constants must fit below the barrier words");
DEV void gla_consts(const Params& p, int h, float* sm) {
    const int tid = opaque_tid();
    float* sWA2 = sm + GLC_OFF; float* sBA2 = sWA2 + 2048;
    __syncthreads();
    for (int i = tid; i < 2048; i += NTHR) { const int d = i >> 10, ii = (i >> 6) & 15, k = i & 63; sWA2[i] = p.in[d ? 12 : 10][ii * 256 + h * 64 + k]; }
    if (tid < 128) sBA2[tid] = p.in[(tid >> 6) ? 13 : 11][h * 64 + (tid & 63)];
}
DEV void gla_decay_core(const float* sLRd, const float* sWAd, const float* sBAd, float* sBC, float* sTot, int dir, int tid) {
    {
        const int t = tid >> 3, k0 = (tid & 7) * 8;
        float acc[8];
#pragma unroll
        for (int j = 0; j < 8; ++j) acc[j] = sBAd[k0 + j];
#pragma unroll
        for (int ii = 0; ii < 16; ++ii) {
            const float l = sLRd[t * 16 + ii];
#pragma unroll
            for (int j = 0; j < 8; ++j) acc[j] += l * sWAd[ii * 64 + k0 + j];
        }
#pragma unroll
        for (int j = 0; j < 8; ++j) sBC[t * 65 + k0 + j] = logsig_f(acc[j]) * 0.0625f;
    }
    __syncthreads();
    {
        const int lane = tid & 63, wv = tid >> 6;
#pragma unroll
        for (int j = 0; j < 8; ++j) {
            const int k = wv * 8 + j;
            const float v = wave_scan_add(sBC[lane * 65 + k], lane, dir);
            sBC[lane * 65 + k] = v;
            if (lane == (dir ? 0 : 63)) sTot[k] = v;
        }
    }
    __syncthreads();
}

DEV bf16x8 tr_frag(const bf16_t* base, int ld, int row0, int col0, int lane) {
    const bf16_t* ptr = base + (row0 + (lane >> 4) * 8 + ((lane & 15) >> 2)) * ld + col0 + (lane & 3) * 4;
    const s16x4 lo = __builtin_amdgcn_ds_read_tr16_b64_v4i16((__attribute__((address_space(3))) s16x4*)ptr);
    const s16x4 hi = __builtin_amdgcn_ds_read_tr16_b64_v4i16((__attribute__((address_space(3))) s16x4*)(ptr + 4 * ld));
    return (bf16x8){lo[0], lo[1], lo[2], lo[3], hi[0], hi[1], hi[2], hi[3]};
}
DEV bf16x8 row_frag(const bf16_t* base, int ld, int idx0, int k0, int lane) {
    return *(const bf16x8*)(base + (idx0 + (lane & 15)) * ld + k0 + (lane >> 4) * 8);
}

DEV void gla1_unit(const Params& p, int h, int dir, int c, float* sm) {
    const int tid = opaque_tid(), lane = tid & 63, wave = tid >> 6;
    const bf16_t* P0 = (const bf16_t*)(p.ws + OFF_P0);
    float* GDS = (float*)(p.ws + OFF_GDS); float* GDEC = (float*)(p.ws + OFF_GDEC);
    float* sLR = sm; float* sBC = sm + 2048; float* sTot = sm + 6208;
    bf16_t* kT = (bf16_t*)(sm + 6272);
    bf16_t* Vs = (bf16_t*)(sm + 8576);
    const int ch = h * 2 + dir;
    const int t = tid >> 3, k0 = (tid & 7) * 8;
    const uint4 lrq = *(const uint4*)(P0 + (size_t)(c * 64 + ((tid & 127) >> 1)) * EIN + 1536 + dir * 16 + (tid & 1) * 8);
    const uint4 kq = *(const uint4*)(P0 + (size_t)(c * 64 + t) * EIN + 256 + h * 64 + k0);
    const uint4 vq0 = *(const uint4*)(P0 + (size_t)(c * 64 + (tid >> 4)) * EIN + 512 + h * 128 + (tid & 15) * 8);
    const uint4 vq1 = *(const uint4*)(P0 + (size_t)(c * 64 + 32 + (tid >> 4)) * EIN + 512 + h * 128 + (tid & 15) * 8);
    __syncthreads();
    if (tid < 128) { float* d = sLR + (tid >> 1) * 16 + (tid & 1) * 8; st4(d, make_float4(bflo(lrq.x), bfhi(lrq.x), bflo(lrq.y), bfhi(lrq.y))); st4(d + 4, make_float4(bflo(lrq.z), bfhi(lrq.z), bflo(lrq.w), bfhi(lrq.w))); }
    *(uint4*)(Vs + (tid >> 4) * 136 + (tid & 15) * 8) = vq0; *(uint4*)(Vs + (32 + (tid >> 4)) * 136 + (tid & 15) * 8) = vq1;
    __syncthreads();
    gla_decay_core(sLR, sm + GLC_OFF + dir * 1024, sm + GLC_OFF + 2048 + dir * 64, sBC, sTot, dir, tid);
    {
        float kv[8]; unpack8(kq, kv);
#pragma unroll
        for (int j = 0; j < 8; ++j) kT[(k0 + j) * 72 + t] = __builtin_bit_cast(unsigned short, (__bf16)(kv[j] * fexp(sTot[k0 + j] - sBC[t * 65 + k0 + j])));
    }
    __syncthreads();
    {
        f32x4 acc[4];
#pragma unroll
        for (int kt = 0; kt < 4; ++kt) acc[kt] = (f32x4){0.f, 0.f, 0.f, 0.f};
#pragma unroll
        for (int ks = 0; ks < 2; ++ks) {
            const bf16x8 af = tr_frag(Vs, 136, ks * 32, wave * 16, lane);
#pragma unroll
            for (int kt = 0; kt < 4; ++kt) acc[kt] = __builtin_amdgcn_mfma_f32_16x16x32_bf16(af, row_frag(kT, 72, kt * 16, ks * 32, lane), acc[kt], 0, 0, 0);
        }
#pragma unroll
        for (int kt = 0; kt < 4; ++kt) {
            const int k = kt * 16 + (lane & 15), v = wave * 16 + (lane >> 4) * 4;
            st4(GDS + ((size_t)(ch * NCH + c) * 64 + k) * 128 + v, make_float4(acc[kt][0], acc[kt][1], acc[kt][2], acc[kt][3]));
        }
    }
    if (tid < 64) GDEC[(size_t)(ch * NCH + c) * 64 + tid] = fexp(sTot[tid]);
}

DEV void gla2_unit(const Params& p, int unit) {
    const int tid = opaque_tid();
    float* GDS = (float*)(p.ws + OFF_GDS); const float* GDEC = (const float*)(p.ws + OFF_GDEC);
    const int ch = unit >> 4, e = (unit & 15) * 512 + tid, k = e >> 7, dir = ch & 1;
    constexpr int GB = 12;
    float S = 0.f, ninc[GB], nd[GB];
#pragma unroll
    for (int j = 0; j < GB; ++j) { const int c = chunk_at(dir, j); ninc[j] = GDS[(size_t)(ch * NCH + c) * 8192 + e]; nd[j] = GDEC[(size_t)(ch * NCH + c) * 64 + k]; }
#pragma unroll 1
    for (int step0 = 0; step0 < NCH; step0 += GB) {
        float inc[GB], d[GB];
#pragma unroll
        for (int j = 0; j < GB; ++j) { inc[j] = ninc[j]; d[j] = nd[j]; }
#pragma unroll
        for (int j = 0; j < GB; ++j) { const int sn = step0 + GB + j, c = chunk_at(dir, sn < NCH ? sn : NCH - 1); ninc[j] = GDS[(size_t)(ch * NCH + c) * 8192 + e]; nd[j] = GDEC[(size_t)(ch * NCH + c) * 64 + k]; }
        __builtin_amdgcn_sched_barrier(0);
#pragma unroll
        for (int j = 0; j < GB; ++j) { const int c = chunk_at(dir, step0 + j); GDS[(size_t)(ch * NCH + c) * 8192 + e] = S; S = d[j] * S + inc[j]; }
    }
}

DEV void gla3_unit(const Params& p, int h, int c, float* sm) {
    const int tid = opaque_tid(), lane = tid & 63, wave = tid >> 6;
    const bf16_t* P0 = (const bf16_t*)(p.ws + OFF_P0);
    const float* GDS = (const float*)(p.ws + OFF_GDS);
    bf16_t* YC = (bf16_t*)(p.ws + OFF_YC);
    const float* ng = p.in[14];
    float* sLR2 = sm;
    float* sBC = sm + 2048; float* sTot = sm + 6208;
    bf16_t* qt = (bf16_t*)(sm + 6272);
    bf16_t* kt = (bf16_t*)(sm + 8576);
    bf16_t* Sm = (bf16_t*)(sm + 10880);
    bf16_t* S0s = (bf16_t*)(sm + 13184);
    bf16_t* Vs = (bf16_t*)(sm + 17536);
    float* O = sm + 21888;
    const int ti = wave & 3, vt0 = (wave >> 2) * 4;
    const int t = tid >> 3, k0 = (tid & 7) * 8;
    f32x4 acc[4];
#pragma unroll
    for (int j = 0; j < 4; ++j) acc[j] = (f32x4){0.f, 0.f, 0.f, 0.f};
    const uint4 vq0 = *(const uint4*)(P0 + (size_t)(c * 64 + (tid >> 4)) * EIN + 512 + h * 128 + (tid & 15) * 8);
    const uint4 vq1 = *(const uint4*)(P0 + (size_t)(c * 64 + 32 + (tid >> 4)) * EIN + 512 + h * 128 + (tid & 15) * 8);
    const uint4 lrq = *(const uint4*)(P0 + (size_t)(c * 64 + ((tid & 255) >> 2)) * EIN + 1536 + (tid & 3) * 8);
    const uint4 qq = *(const uint4*)(P0 + (size_t)(c * 64 + t) * EIN + h * 64 + k0);
    const uint4 kq = *(const uint4*)(P0 + (size_t)(c * 64 + t) * EIN + 256 + h * 64 + k0);
    float4 s0a[4], s0b[4];
#pragma unroll
    for (int u = 0; u < 4; ++u) { const int i = tid + 512 * u, k = i >> 5, v4 = (i & 31) * 4;
        s0a[u] = ld4(GDS + (size_t)((h * 2 + 0) * NCH + c) * 8192 + k * 128 + v4); s0b[u] = ld4(GDS + (size_t)((h * 2 + 1) * NCH + c) * 8192 + k * 128 + v4); }
    const bf16_t* gp = P0 + (size_t)(c * 64 + t) * EIN + 1024 + h * 128 + (tid & 7) * 16;
    const uint4 gq0 = *(const uint4*)gp, gq1 = *(const uint4*)(gp + 8);
    __syncthreads();
    *(uint4*)(Vs + (tid >> 4) * 136 + (tid & 15) * 8) = vq0; *(uint4*)(Vs + (32 + (tid >> 4)) * 136 + (tid & 15) * 8) = vq1;
    if (tid < 256) { float* d = sLR2 + ((tid & 3) >> 1) * 1024 + (tid >> 2) * 16 + (tid & 1) * 8; st4(d, make_float4(bflo(lrq.x), bfhi(lrq.x), bflo(lrq.y), bfhi(lrq.y))); st4(d + 4, make_float4(bflo(lrq.z), bfhi(lrq.z), bflo(lrq.w), bfhi(lrq.w))); }
    __syncthreads();
#pragma unroll
    for (int dir = 0; dir < 2; ++dir) {
        gla_decay_core(sLR2 + dir * 1024, sm + GLC_OFF + dir * 1024, sm + GLC_OFF + 2048 + dir * 64, sBC, sTot, dir, tid);
        {
            float qv[8], kv[8];
            unpack8(qq, qv); unpack8(kq, kv);
#pragma unroll
            for (int j = 0; j < 8; ++j) { const float bc = sBC[t * 65 + k0 + j]; qv[j] *= 0.125f * fexp(bc); kv[j] *= fexp(-bc); }
            *(uint4*)(qt + t * 72 + k0) = make_uint4(pack2bf(qv[0], qv[1]), pack2bf(qv[2], qv[3]), pack2bf(qv[4], qv[5]), pack2bf(qv[6], qv[7]));
            *(uint4*)(kt + t * 72 + k0) = make_uint4(pack2bf(kv[0], kv[1]), pack2bf(kv[2], kv[3]), pack2bf(kv[4], kv[5]), pack2bf(kv[6], kv[7]));
#pragma unroll
            for (int u = 0; u < 4; ++u) {
                const int i = tid + 512 * u, k = i >> 5, v4 = (i & 31) * 4;
                const float4 s4 = dir ? s0b[u] : s0a[u];
                *(uint2*)(S0s + k * 136 + v4) = make_uint2(pack2bf(s4.x, s4.y), pack2bf(s4.z, s4.w));
            }
        }
        __syncthreads();
        {
            const int si = wave & 3;
#pragma unroll
            for (int jj = 0; jj < 2; ++jj) {
                const int t2 = (wave >> 2) * 2 + jj;
                f32x4 a = (f32x4){0.f, 0.f, 0.f, 0.f};
#pragma unroll
                for (int ks = 0; ks < 2; ++ks) a = __builtin_amdgcn_mfma_f32_16x16x32_bf16(row_frag(kt, 72, si * 16, ks * 32, lane), row_frag(qt, 72, t2 * 16, ks * 32, lane), a, 0, 0, 0);
                const int tq = t2 * 16 + (lane & 15), s0 = si * 16 + (lane >> 4) * 4;
                float m[4];
#pragma unroll
                for (int r = 0; r < 4; ++r) { const bool keep = dir ? (s0 + r >= tq) : (s0 + r <= tq); m[r] = keep ? a[r] : 0.f; }
                *(uint2*)(Sm + tq * 72 + s0) = make_uint2(pack2bf(m[0], m[1]), pack2bf(m[2], m[3]));
            }
        }
        __syncthreads();
#pragma unroll
        for (int ks = 0; ks < 2; ++ks) {
            const bf16x8 a1 = row_frag(qt, 72, ti * 16, ks * 32, lane), a2 = row_frag(Sm, 72, ti * 16, ks * 32, lane);
#pragma unroll
            for (int j = 0; j < 4; ++j) {
                acc[j] = __builtin_amdgcn_mfma_f32_16x16x32_bf16(a1, tr_frag(S0s, 136, ks * 32, (vt0 + j) * 16, lane), acc[j], 0, 0, 0);
                acc[j] = __builtin_amdgcn_mfma_f32_16x16x32_bf16(a2, tr_frag(Vs, 136, ks * 32, (vt0 + j) * 16, lane), acc[j], 0, 0, 0);
            }
        }
        if (dir == 0) __syncthreads();
    }
#pragma unroll
    for (int j = 0; j < 4; ++j)
#pragma unroll
        for (int r = 0; r < 4; ++r) O[(ti * 16 + (lane >> 4) * 4 + r) * 132 + (vt0 + j) * 16 + (lane & 15)] = acc[j][r];
    __syncthreads();
    {
        const int v0 = (tid & 7) * 16;
        float o[16];
        float ss = 0.f;
#pragma unroll
        for (int i = 0; i < 16; ++i) { o[i] = O[t * 132 + v0 + i]; ss += o[i] * o[i]; }
        ss = red8_sum(ss);
        const float rms = rsqrtf(ss * (1.f / 128.f) + 1e-5f);
        float g[16];
        unpack8(gq0, g); unpack8(gq1, g + 8);
        float y[16];
#pragma unroll
        for (int i = 0; i < 16; ++i) y[i] = o[i] * rms * ng[v0 + i] * silu_f(g[i]);
        bf16_t* yp = YC + (size_t)(c * 64 + t) * 1024 + h * 128 + v0;
        *(uint4*)yp = make_uint4(pack2bf(y[0], y[1]), pack2bf(y[2], y[3]), pack2bf(y[4], y[5]), pack2bf(y[6], y[7]));
        *(uint4*)(yp + 8) = make_uint4(pack2bf(y[8], y[9]), pack2bf(y[10], y[11]), pack2bf(y[12], y[13]), pack2bf(y[14], y[15]));
    }
}

DEV void load8bf(const bf16_t* ptr, float* f) { unpack8(*(const uint4*)ptr, f); }
struct RwNb { int sL, sR, sU, sD; bool vL, vR, vU, vD; };
DEV RwNb rw_nb(int s) {
    RwNb q; q.vU = false; q.vD = false;
    if (s < NCX) { q.vL = s > 0; q.vR = s < NCX - 1; }
    else { const int n = s - NCX, rr = n >> 6, cc = n & 63; q.vL = cc > 0; q.vR = cc < 63; q.vU = rr > 0; q.vD = rr < 127; }
    q.sL = q.vL ? s - 1 : s; q.sR = q.vR ? s + 1 : s; q.sU = q.vU ? s - 64 : s; q.sD = q.vD ? s + 64 : s;
    return q;
}
struct RwRaw { uint4 o, l, r, u, d; };
DEV RwRaw rw_load(const bf16_t* P0, int s, const RwNb& q, int cb) {
    RwRaw w;
    w.o = *(const uint4*)(P0 + (size_t)s * EIN + RW0 + cb); w.l = *(const uint4*)(P0 + (size_t)q.sL * EIN + RW0 + cb); w.r = *(const uint4*)(P0 + (size_t)q.sR * EIN + RW0 + cb);
    w.u = *(const uint4*)(P0 + (size_t)q.sU * EIN + RW0 + cb); w.d = *(const uint4*)(P0 + (size_t)q.sD * EIN + RW0 + cb);
    return w;
}
DEV void rw_comb_l(const RwRaw& w, const RwNb& q, const float* ml, float* out) {
    float own[8]; unpack8(w.o, own);
    const float nb[8] = {q.vL ? bflo(w.l.x) : 0.f, q.vR ? bfhi(w.r.x) : 0.f, q.vU ? bflo(w.u.y) : 0.f, q.vD ? bfhi(w.d.y) : 0.f,
                         q.vL ? bflo(w.l.z) : 0.f, q.vR ? bfhi(w.r.z) : 0.f, q.vU ? bflo(w.u.w) : 0.f, q.vD ? bfhi(w.d.w) : 0.f};
    const float4 m0 = *(const float4*)ml, m1 = *(const float4*)(ml + 4);
    const float m[8] = {m0.x, m0.y, m0.z, m0.w, m1.x, m1.y, m1.z, m1.w};
#pragma unroll
    for (int i = 0; i < 8; ++i) out[i] = own[i] + (nb[i] - own[i]) * m[i];
}
DEV void rw_comb(const RwRaw& w, const RwNb& q, const float* __restrict__ mu, int cb, float* out) {
    float own[8]; unpack8(w.o, own);
    const float nb[8] = {q.vL ? bflo(w.l.x) : 0.f, q.vR ? bfhi(w.r.x) : 0.f, q.vU ? bflo(w.u.y) : 0.f, q.vD ? bfhi(w.d.y) : 0.f,
                         q.vL ? bflo(w.l.z) : 0.f, q.vR ? bfhi(w.r.z) : 0.f, q.vU ? bflo(w.u.w) : 0.f, q.vD ? bfhi(w.d.w) : 0.f};
    const float4 m0 = ld4(mu + cb), m1 = ld4(mu + cb + 4);
    const float m[8] = {m0.x, m0.y, m0.z, m0.w, m1.x, m1.y, m1.z, m1.w};
#pragma unroll
    for (int i = 0; i < 8; ++i) out[i] = own[i] + (nb[i] - own[i]) * m[i];
}
DEV uint4 pack8(const float* f) { return make_uint4(pack2bf(f[0], f[1]), pack2bf(f[2], f[3]), pack2bf(f[4], f[5]), pack2bf(f[6], f[7])); }

template <int XM, int YM, class F>
DEV void mm64(const bf16_t* X, const bf16_t* Y, F f, int lane, int wave) {
#pragma unroll
    for (int q = 0; q < 2; ++q) {
        const int idx = wave * 2 + q, ti = idx >> 2, tj = idx & 3;
        f32x4 acc = (f32x4){0.f, 0.f, 0.f, 0.f};
#pragma unroll
        for (int ks = 0; ks < 2; ++ks) {
            const bf16x8 a = XM == 0 ? row_frag(X, 72, ti * 16, ks * 32, lane) : tr_frag(X, 72, ks * 32, ti * 16, lane);
            const bf16x8 bq = YM == 0 ? row_frag(Y, 72, tj * 16, ks * 32, lane) : tr_frag(Y, 72, ks * 32, tj * 16, lane);
            acc = __builtin_amdgcn_mfma_f32_16x16x32_bf16(a, bq, acc, 0, 0, 0);
        }
        f(ti * 16 + (lane >> 4) * 4, tj * 16 + (lane & 15), acc);
    }
}
template <int XM, int YM, class F>
DEV void mm64x2(const bf16_t* X1, const bf16_t* Y1, const bf16_t* X2, const bf16_t* Y2, F f, int lane, int wave) {
#pragma unroll
    for (int q = 0; q < 2; ++q) {
        const int idx = wave * 2 + q, ti = idx >> 2, tj = idx & 3;
        f32x4 acc = (f32x4){0.f, 0.f, 0.f, 0.f};
#pragma unroll
        for (int ks = 0; ks < 2; ++ks) {
            const bf16x8 a = XM == 0 ? row_frag(X1, 72, ti * 16, ks * 32, lane) : tr_frag(X1, 72, ks * 32, ti * 16, lane);
            const bf16x8 bq = YM == 0 ? row_frag(Y1, 72, tj * 16, ks * 32, lane) : tr_frag(Y1, 72, ks * 32, tj * 16, lane);
            acc = __builtin_amdgcn_mfma_f32_16x16x32_bf16(a, bq, acc, 0, 0, 0);
            const bf16x8 a2 = XM == 0 ? row_frag(X2, 72, ti * 16, ks * 32, lane) : tr_frag(X2, 72, ks * 32, ti * 16, lane);
            const bf16x8 b2 = YM == 0 ? row_frag(Y2, 72, tj * 16, ks * 32, lane) : tr_frag(Y2, 72, ks * 32, tj * 16, lane);
            acc = __builtin_amdgcn_mfma_f32_16x16x32_bf16(a2, b2, acc, 0, 0, 0);
        }
        f(ti * 16 + (lane >> 4) * 4, tj * 16 + (lane & 15), acc);
    }
}
DEV void st_img(bf16_t* P, int i0, int j, float a0, float a1, float a2, float a3) {
    P[(i0 + 0) * 72 + j] = __builtin_bit_cast(unsigned short, (__bf16)a0); P[(i0 + 1) * 72 + j] = __builtin_bit_cast(unsigned short, (__bf16)a1);
    P[(i0 + 2) * 72 + j] = __builtin_bit_cast(unsigned short, (__bf16)a2); P[(i0 + 3) * 72 + j] = __builtin_bit_cast(unsigned short, (__bf16)a3);
}

struct RwRaw3 { uint4 o, u, d; };
DEV RwRaw3 rw_load3(const bf16_t* P0, int s, const RwNb& q, int cb) {
    RwRaw3 w;
    w.o = *(const uint4*)(P0 + (size_t)s * EIN + RW0 + cb); w.u = *(const uint4*)(P0 + (size_t)q.sU * EIN + RW0 + cb); w.d = *(const uint4*)(P0 + (size_t)q.sD * EIN + RW0 + cb);
    return w;
}
DEV void rw_comb3(const RwRaw3& w, const RwNb& q, const bf16_t* tile, const bf16_t* P0, int s, int t, int cb, int j0, const float* ml, float* out) {
    asm volatile("" :: "v"(w.u.x), "v"(w.u.z), "v"(w.d.x), "v"(w.d.z));
    float own[8]; unpack8(w.o, own);
    float l0 = 0.f, l4 = 0.f, r1 = 0.f, r5 = 0.f;
    if (q.vL) { if (t > 0) { l0 = bf2f(tile[(t - 1) * 72 + j0]); l4 = bf2f(tile[(t - 1) * 72 + j0 + 4]); }
                else { const bf16_t* g = P0 + (size_t)(s - 1) * EIN + RW0 + cb; l0 = bf2f(g[0]); l4 = bf2f(g[4]); } }
    if (q.vR) { if (t < 63) { r1 = bf2f(tile[(t + 1) * 72 + j0 + 1]); r5 = bf2f(tile[(t + 1) * 72 + j0 + 5]); }
                else { const bf16_t* g = P0 + (size_t)(s + 1) * EIN + RW0 + cb; r1 = bf2f(g[1]); r5 = bf2f(g[5]); } }
    const float nb[8] = {l0, r1, q.vU ? bflo(w.u.y) : 0.f, q.vD ? bfhi(w.d.y) : 0.f, l4, r5, q.vU ? bflo(w.u.w) : 0.f, q.vD ? bfhi(w.d.w) : 0.f};
    const float4 m0 = *(const float4*)ml, m1 = *(const float4*)(ml + 4);
    const float m[8] = {m0.x, m0.y, m0.z, m0.w, m1.x, m1.y, m1.z, m1.w};
#pragma unroll
    for (int i = 0; i < 8; ++i) out[i] = own[i] + (nb[i] - own[i]) * m[i];
}
template <int XM, int YM, class F>
DEV void mm64t(const bf16_t* X, const bf16_t* Y, F f, int lane, int wave) {
#pragma unroll
    for (int q = 0; q < 2; ++q) {
        const int idx = wave * 2 + q, ti = idx >> 2, tj = idx & 3;
        f32x4 acc = (f32x4){0.f, 0.f, 0.f, 0.f};
#pragma unroll
        for (int ks = 0; ks < 2; ++ks) {
            const bf16x8 a = XM == 0 ? row_frag(X, 72, ti * 16, ks * 32, lane) : tr_frag(X, 72, ks * 32, ti * 16, lane);
            const bf16x8 bq = YM == 0 ? row_frag(Y, 72, tj * 16, ks * 32, lane) : tr_frag(Y, 72, ks * 32, tj * 16, lane);
            acc = __builtin_amdgcn_mfma_f32_16x16x32_bf16(bq, a, acc, 0, 0, 0);
        }
        f(ti * 16 + (lane & 15), tj * 16 + (lane >> 4) * 4, acc);
    }
}
DEV void st_row(bf16_t* P, int i, int j0, float a0, float a1, float a2, float a3) { *(uint2*)(P + i * 72 + j0) = make_uint2(pack2bf(a0, a1), pack2bf(a2, a3)); }
struct R1Raw { RwRaw3 r, k, v, w, a; float4 qw0, qw1, qa0, qa1; };
DEV void r1_consts(const Params& p, int h, int dir, float* sm) {
    const int tid = opaque_tid();
    float* sv = (float*)((bf16_t*)sm + 14 * 4608);
    __syncthreads();
    if (tid < 64) { const int hc = h * 64 + tid; sv[64 + tid] = p.in[dir ? 18 : 16][hc]; sv[128 + tid] = p.in[dir ? 22 : 20][hc]; sv[192 + tid] = p.in[24][hc]; sv[256 + tid] = p.in[25][hc]; sv[320 + tid] = p.in[26][hc]; }
    if (tid < 320) { const int tn = tid >> 6, col = tid & 63; const int cb = tn < 3 ? tn * 512 + h * 64 : (tn == 3 ? 2048 + dir * 64 : 2176 + dir * 64); sv[384 + tid] = p.in[15][cb + col]; }
}
DEV void r1_load(const Params& p, int h, int dir, int c, R1Raw& R) {
    const int tid = opaque_tid();
    const bf16_t* P0 = (const bf16_t*)(p.ws + OFF_P0);
    const float* ww2 = p.in[dir ? 19 : 17]; const float* wa2 = p.in[dir ? 23 : 21];
    const int t = tid >> 3, j0 = (tid & 7) * 8, s = c * 64 + t;
    const RwNb nbq = rw_nb(s);
    R.r = rw_load3(P0, s, nbq, h * 64 + j0); R.k = rw_load3(P0, s, nbq, 512 + h * 64 + j0); R.v = rw_load3(P0, s, nbq, 1024 + h * 64 + j0);
    R.w = rw_load3(P0, s, nbq, 2048 + dir * 64 + j0); R.a = rw_load3(P0, s, nbq, 2176 + dir * 64 + j0);
    R.qw0 = ld4(ww2 + (size_t)t * 512 + h * 64 + j0); R.qw1 = ld4(ww2 + (size_t)t * 512 + h * 64 + j0 + 4);
    R.qa0 = ld4(wa2 + (size_t)t * 512 + h * 64 + j0); R.qa1 = ld4(wa2 + (size_t)t * 512 + h * 64 + j0 + 4);
}
DEV void rwkv1_unit(const Params& p, int h, int dir, int c, float* sm, R1Raw& R, int cnext) {
    const int tid = opaque_tid(), lane = tid & 63, wave = tid >> 6;
    bf16_t* RU = (bf16_t*)(p.ws + OFF_RU) + (size_t)((h * 2 + dir) * NCH + c) * 16384;
    float* BONS = (float*)(p.ws + OFF_BONS);
    bf16_t* img = (bf16_t*)sm;
#define SLOT(i_) (img + (i_) * 4608)
    float* fLW = (float*)SLOT(10);
    float* fAS = (float*)SLOT(12);
    float* sv = (float*)SLOT(14);
    const int t = tid >> 3, j0 = (tid & 7) * 8, s = c * 64 + t;
    const bf16_t* P0 = (const bf16_t*)(p.ws + OFF_P0);
    __syncthreads();
    *(uint4*)(SLOT(0) + t * 72 + j0) = R.r.o; *(uint4*)(SLOT(1) + t * 72 + j0) = R.k.o; *(uint4*)(SLOT(2) + t * 72 + j0) = R.v.o;
    *(uint4*)(SLOT(3) + t * 72 + j0) = R.w.o; *(uint4*)(SLOT(4) + t * 72 + j0) = R.a.o;
    __syncthreads();
    float r8[8], k8[8], v8[8];
    {
        float x8[8];
        const RwNb nbq = rw_nb(s);
        rw_comb3(R.r, nbq, SLOT(0), P0, s, t, h * 64 + j0, j0, sv + 384 + j0, r8);
        rw_comb3(R.k, nbq, SLOT(1), P0, s, t, 512 + h * 64 + j0, j0, sv + 448 + j0, k8);
        rw_comb3(R.v, nbq, SLOT(2), P0, s, t, 1024 + h * 64 + j0, j0, sv + 512 + j0, v8);
        rw_comb3(R.w, nbq, SLOT(3), P0, s, t, 2048 + dir * 64 + j0, j0, sv + 576 + j0, x8);
#pragma unroll
        for (int i = 0; i < 8; ++i) x8[i] = tanh_f(x8[i]);
        *(uint4*)(SLOT(6) + t * 72 + j0) = pack8(x8);
        rw_comb3(R.a, nbq, SLOT(4), P0, s, t, 2176 + dir * 64 + j0, j0, sv + 640 + j0, x8);
        *(uint4*)(SLOT(7) + t * 72 + j0) = pack8(x8);
        { const float wq[8] = {R.qw0.x, R.qw0.y, R.qw0.z, R.qw0.w, R.qw1.x, R.qw1.y, R.qw1.z, R.qw1.w}; *(uint4*)(SLOT(8) + t * 72 + j0) = pack8(wq); }
        { const float wq[8] = {R.qa0.x, R.qa0.y, R.qa0.z, R.qa0.w, R.qa1.x, R.qa1.y, R.qa1.z, R.qa1.w}; *(uint4*)(SLOT(9) + t * 72 + j0) = pack8(wq); }
    }
    r1_load(p, h, dir, cnext >= 0 ? cnext : c, R);
    __syncthreads();
    mm64t<0, 1>(SLOT(6), SLOT(8), [=](int i, int jq, f32x4 a) {
        const float4 b4 = ld4(sv + 64 + jq);
        st4(fLW + i * 68 + jq, make_float4(-0.6065306597f * sigmoid_f(b4.x + a[0]), -0.6065306597f * sigmoid_f(b4.y + a[1]), -0.6065306597f * sigmoid_f(b4.z + a[2]), -0.6065306597f * sigmoid_f(b4.w + a[3]))); }, lane, wave);
    mm64t<0, 1>(SLOT(7), SLOT(9), [=](int i, int jq, f32x4 a) {
        const float4 b4 = ld4(sv + 128 + jq);
        st4(fAS + i * 68 + jq, make_float4(sigmoid_f(b4.x + a[0]), sigmoid_f(b4.y + a[1]), sigmoid_f(b4.z + a[2]), sigmoid_f(b4.w + a[3]))); }, lane, wave);
    __syncthreads();
#pragma unroll
    for (int j = 0; j < 8; ++j) {
        const int k = wave * 8 + j;
        const float v = wave_scan_add(fLW[lane * 68 + k], lane, dir);
        fLW[lane * 68 + k] = v;
        if (lane == (dir ? 0 : 63)) sv[k] = v;
    }
    __syncthreads();
    {
        float kkv[8], ss = 0.f;
#pragma unroll
        for (int i = 0; i < 8; ++i) { kkv[i] = k8[i] * sv[192 + j0 + i]; ss += kkv[i] * kkv[i]; }
        ss = red8_sum(ss);
        const float rn = rsqrtf(fmaxf(ss, 1e-24f));
        float fa[8], fb[8], fk[8], fr[8], fbp[8], fkp[8], bon = 0.f;
        const int tp = dir ? t + 1 : t - 1;
        const bool hasp = dir ? (t < 63) : (t > 0);
        const int tpc = hasp ? tp : t;
        float Bt8[8], Bx8[8], as8[8];
        { const float4 q0 = ld4(fLW + t * 68 + j0), q1 = ld4(fLW + t * 68 + j0 + 4), x0 = ld4(fLW + tpc * 68 + j0), x1 = ld4(fLW + tpc * 68 + j0 + 4), s0 = ld4(fAS + t * 68 + j0), s1 = ld4(fAS + t * 68 + j0 + 4);
          Bt8[0] = q0.x; Bt8[1] = q0.y; Bt8[2] = q0.z; Bt8[3] = q0.w; Bt8[4] = q1.x; Bt8[5] = q1.y; Bt8[6] = q1.z; Bt8[7] = q1.w;
          Bx8[0] = x0.x; Bx8[1] = x0.y; Bx8[2] = x0.z; Bx8[3] = x0.w; Bx8[4] = x1.x; Bx8[5] = x1.y; Bx8[6] = x1.z; Bx8[7] = x1.w;
          as8[0] = s0.x; as8[1] = s0.y; as8[2] = s0.z; as8[3] = s0.w; as8[4] = s1.x; as8[5] = s1.y; as8[6] = s1.z; as8[7] = s1.w; }
#pragma unroll
        for (int i = 0; i < 8; ++i) {
            const int k = j0 + i;
            const float Bt = Bt8[i], Bx = hasp ? Bx8[i] : 0.f, asg = as8[i];
            const float kk = kkv[i] * rn, kh = k8[i] * (1.f + (asg - 1.f) * sv[256 + k]);
            bon += r8[i] * kh * sv[320 + k];
            const float enB = fexp(-Bt), eLB = fexp(sv[k] - Bt), bv = kk * asg;
            fa[i] = -kk * fexp(Bx); fb[i] = bv * enB; fk[i] = kh * enB; fr[i] = r8[i] * fexp(Bt); fbp[i] = bv * eLB; fkp[i] = kh * eLB;
        }
        bon = red8_sum(bon);
        if ((tid & 7) == 0) BONS[((size_t)dir * TB + s) * 8 + h] = bon;
        *(uint4*)(SLOT(0) + t * 72 + j0) = pack8(fa); *(uint4*)(SLOT(1) + t * 72 + j0) = pack8(fb); *(uint4*)(SLOT(2) + t * 72 + j0) = pack8(fk);
        *(uint4*)(SLOT(3) + t * 72 + j0) = pack8(fr); *(uint4*)(SLOT(4) + t * 72 + j0) = pack8(fbp); *(uint4*)(SLOT(5) + t * 72 + j0) = pack8(fkp);
    }
    __syncthreads();
    *(uint4*)(SLOT(6) + t * 72 + j0) = pack8(v8);
    __syncthreads();
    mm64t<0, 0>(SLOT(0), SLOT(1), [=](int i, int j0, f32x4 a) {
        float m[4];
#pragma unroll
        for (int r = 0; r < 4; ++r) { const bool keep = dir ? (j0 + r > i) : (j0 + r < i); m[r] = keep ? a[r] : 0.f; }
        const bool dg = (i >> 4) == (j0 >> 4);
        st_row(SLOT(7), i, j0, dg ? m[0] : 0.f, dg ? m[1] : 0.f, dg ? m[2] : 0.f, dg ? m[3] : 0.f);
        st_row(SLOT(8), i, j0, (dg ? m[0] : 0.f) + (j0 == i ? 1.f : 0.f), (dg ? m[1] : 0.f) + (j0 + 1 == i ? 1.f : 0.f), (dg ? m[2] : 0.f) + (j0 + 2 == i ? 1.f : 0.f), (dg ? m[3] : 0.f) + (j0 + 3 == i ? 1.f : 0.f));
        st_row(SLOT(12), i, j0, dg ? 0.f : m[0], dg ? 0.f : m[1], dg ? 0.f : m[2], dg ? 0.f : m[3]); }, lane, wave);
    mm64t<0, 0>(SLOT(0), SLOT(2), [=](int i, int j0, f32x4 a) {
        float m[4];
#pragma unroll
        for (int r = 0; r < 4; ++r) { const bool keep = dir ? (j0 + r > i) : (j0 + r < i); m[r] = keep ? a[r] : 0.f; }
        st_row(SLOT(9), i, j0, m[0], m[1], m[2], m[3]); }, lane, wave);
    mm64t<0, 0>(SLOT(3), SLOT(1), [=](int i, int j0, f32x4 a) {
        float m[4];
#pragma unroll
        for (int r = 0; r < 4; ++r) { const bool keep = dir ? (j0 + r >= i) : (j0 + r <= i); m[r] = keep ? a[r] : 0.f; }
        st_row(SLOT(10), i, j0, m[0], m[1], m[2], m[3]); }, lane, wave);
    mm64t<0, 0>(SLOT(3), SLOT(2), [=](int i, int j0, f32x4 a) {
        float m[4];
#pragma unroll
        for (int r = 0; r < 4; ++r) { const bool keep = dir ? (j0 + r >= i) : (j0 + r <= i); m[r] = keep ? a[r] : 0.f; }
        st_row(SLOT(11), i, j0, m[0], m[1], m[2], m[3]); }, lane, wave);
    __syncthreads();
#define R1_TADD(dst_, told_) [=](int i, int j0, f32x4 a) { const uint2 tt = *(const uint2*)((told_) + i * 72 + j0); \
        st_row((dst_), i, j0, a[0] + bflo(tt.x), a[1] + bfhi(tt.x), a[2] + bflo(tt.y), a[3] + bfhi(tt.y)); }
    mm64t<0, 1>(SLOT(7), SLOT(7), [=](int i, int j0, f32x4 a) { st_row(SLOT(1), i, j0, a[0], a[1], a[2], a[3]); }, lane, wave);
    mm64t<0, 1>(SLOT(9), SLOT(6), [=](int i, int j0, f32x4 a) { st_row(SLOT(13), i, j0, a[0], a[1], a[2], a[3]); }, lane, wave);
    __syncthreads();
    mm64t<0, 1>(SLOT(1), SLOT(1), [=](int i, int j0, f32x4 a) { st_row(SLOT(7), i, j0, a[0], a[1], a[2], a[3]); }, lane, wave);
    mm64t<0, 1>(SLOT(8), SLOT(1), R1_TADD(SLOT(2), SLOT(8)), lane, wave);
    __syncthreads();
    mm64t<0, 1>(SLOT(7), SLOT(7), [=](int i, int j0, f32x4 a) { st_row(SLOT(1), i, j0, a[0], a[1], a[2], a[3]); }, lane, wave);
    mm64t<0, 1>(SLOT(2), SLOT(7), R1_TADD(SLOT(8), SLOT(2)), lane, wave);
    __syncthreads();
    mm64t<0, 1>(SLOT(8), SLOT(1), R1_TADD(SLOT(2), SLOT(8)), lane, wave);
    __syncthreads();
#undef R1_TADD
    mm64t<0, 1>(SLOT(2), SLOT(12), [=](int i, int j0, f32x4 a) { st_row(SLOT(7), i, j0, a[0], a[1], a[2], a[3]); }, lane, wave);
    mm64t<0, 1>(SLOT(2), SLOT(0), [=](int i, int j0, f32x4 a) { st_row(SLOT(1), i, j0, a[0], a[1], a[2], a[3]); }, lane, wave);
    mm64t<0, 1>(SLOT(2), SLOT(13), [=](int i, int j0, f32x4 a) { st_row(SLOT(8), i, j0, a[0], a[1], a[2], a[3]); }, lane, wave);
    __syncthreads();
    {
        const bf16_t* Zp = (wave < 4) ? SLOT(1) : SLOT(8);
        bf16_t* Xi = (wave < 4) ? SLOT(12) : SLOT(9);
        const int ct = (wave & 3) * 16, g4 = (lane >> 4) * 4, l15 = lane & 15;
#pragma unroll
        for (int bs = 0; bs < 4; ++bs) {
            const int bi = dir ? 3 - bs : bs;
            const uint2 zz = *(const uint2*)(Zp + (bi * 16 + l15) * 72 + ct + g4);
            f32x4 acc = (f32x4){bflo(zz.x), bfhi(zz.x), bflo(zz.y), bfhi(zz.y)};
            const bool k0 = dir ? (bi == 0) : (bi >= 1), k1 = dir ? (bi <= 2) : (bi == 3);
            if (k0) acc = __builtin_amdgcn_mfma_f32_16x16x32_bf16(tr_frag(Xi, 72, 0, ct, lane), row_frag(SLOT(7), 72, bi * 16, 0, lane), acc, 0, 0, 0);
            if (k1) acc = __builtin_amdgcn_mfma_f32_16x16x32_bf16(tr_frag(Xi, 72, 32, ct, lane), row_frag(SLOT(7), 72, bi * 16, 32, lane), acc, 0, 0, 0);
            st_row(Xi, bi * 16 + l15, ct + g4, acc[0], acc[1], acc[2], acc[3]);
            __syncthreads();
        }
    }
    mm64<1, 1>(SLOT(12), SLOT(4), [=](int i0, int j, f32x4 a) {
        float m[4];
#pragma unroll
        for (int r = 0; r < 4; ++r) m[r] = a[r] + ((i0 + r) == j ? fexp(sv[j]) : 0.f);
        *(uint2*)(RU + j * 64 + i0) = make_uint2(pack2bf(m[0], m[1]), pack2bf(m[2], m[3])); }, lane, wave);
    mm64x2<1, 1>(SLOT(4), SLOT(9), SLOT(5), SLOT(6), [=](int i0, int j, f32x4 a) {
        *(uint2*)(RU + 4096 + j * 64 + i0) = make_uint2(pack2bf(a[0], a[1]), pack2bf(a[2], a[3])); }, lane, wave);
    mm64<1, 0>(SLOT(12), SLOT(10), [=](int i0, int j, f32x4 a) {
        const uint2 rr = *(const uint2*)(SLOT(3) + j * 72 + i0);
        *(uint2*)(RU + 8192 + j * 64 + i0) = make_uint2(pack2bf(a[0] + bflo(rr.x), a[1] + bfhi(rr.x)), pack2bf(a[2] + bflo(rr.y), a[3] + bfhi(rr.y))); }, lane, wave);
    mm64x2<0, 1>(SLOT(10), SLOT(9), SLOT(11), SLOT(6), [=](int i0, int j, f32x4 a) {
        *(uint2*)(RU + 12288 + j * 64 + i0) = make_uint2(pack2bf(a[0], a[1]), pack2bf(a[2], a[3])); }, lane, wave);
#undef SLOT
}

#define R2_LOAD(M_, C_, rnd_) do { const int r0_ = ((rnd_) < R2_NR ? (rnd_) : R2_NR - 1) * R2_RS; \
    _Pragma("unroll") for (int s_ = 0; s_ < R2_RS; ++s_) M_[s_] = *(const uint4*)(RU + (size_t)(chain * NCH + chunk_at(dir, r0_ + s_)) * 16384 + tid * 8); \
    _Pragma("unroll") for (int j_ = 0; j_ < 3; ++j_) { const int cq_ = tid + 512 * j_; \
        C_[j_] = *(const uint4*)(RU + (size_t)(chain * NCH + chunk_at(dir, r0_ + (cq_ >> 7))) * 16384 + 4096 + (vblk * 16 + ((cq_ >> 3) & 15)) * 64 + (cq_ & 7) * 8); } } while (0)
#define R2_ROUND(M_, C_, rnd_) do { \
    { const int row_ = tid >> 3, c8_ = tid & 7, sw_ = (row_ >> 1) & 7, u0_ = (c8_ >> 2) * 4 + (c8_ & 1) * 2, eh_ = ((c8_ >> 1) & 1) * 8; \
      _Pragma("unroll") for (int s_ = 0; s_ < R2_RS; ++s_) { char* sl_ = ring + s_ * 10240 + row_ * 128 + eh_; \
          *(uint2*)(sl_ + ((u0_ ^ sw_) * 16)) = make_uint2(M_[s_].x, M_[s_].y); *(uint2*)(sl_ + (((u0_ + 1) ^ sw_) * 16)) = make_uint2(M_[s_].z, M_[s_].w); } \
      _Pragma("unroll") for (int j_ = 0; j_ < 3; ++j_) { const int cq_ = tid + 512 * j_, rw_ = (cq_ >> 3) & 15, q8_ = cq_ & 7, i_ = q8_ >> 1, g0_ = (q8_ & 1) * 2, sc_ = (rw_ >> 1) & 7; \
          char* sl_ = ring + (cq_ >> 7) * 10240 + 8192 + rw_ * 128 + (i_ & 1) * 8; \
          *(uint2*)(sl_ + (((g0_ * 2 + (i_ >> 1)) ^ sc_) * 16)) = make_uint2(C_[j_].x, C_[j_].y); *(uint2*)(sl_ + ((((g0_ + 1) * 2 + (i_ >> 1)) ^ sc_) * 16)) = make_uint2(C_[j_].z, C_[j_].w); } } \
    R2_LOAD(M_, C_, (rnd_) + 2); \
    __syncthreads(); \
    if (wave == 0) { \
        _Pragma("unroll 4") for (int s_ = 0; s_ < R2_RS; ++s_) { \
            const int c_ = chunk_at(dir, (rnd_) * R2_RS + s_); const char* sl_ = ring + s_ * 10240; \
            unsigned pk_[4][2]; \
            _Pragma("unroll") for (int i_ = 0; i_ < 4; ++i_) { pk_[i_][0] = pack2bf(st[i_][0], st[i_][1]); pk_[i_][1] = pack2bf(st[i_][2], st[i_][3]); } \
            bf16_t* sp_ = S0G + ((size_t)(chain * NCH + c_) * 64 + vblk * 16 + l15) * 64 + g * 4; \
            _Pragma("unroll") for (int i_ = 0; i_ < 4; ++i_) *(uint2*)(sp_ + i_ * 16) = make_uint2(pk_[i_][0], pk_[i_][1]); \
            bf16x8 bfr_[2]; \
            _Pragma("unroll") for (int ks_ = 0; ks_ < 2; ++ks_) { const uint4 u_ = make_uint4(pk_[2 * ks_][0], pk_[2 * ks_][1], pk_[2 * ks_ + 1][0], pk_[2 * ks_ + 1][1]); bfr_[ks_] = __builtin_bit_cast(bf16x8, u_); } \
            const uint4 c01_ = *(const uint4*)(sl_ + 8192 + l15 * 128 + (((g * 2) ^ ((l15 >> 1) & 7)) * 16)), c23_ = *(const uint4*)(sl_ + 8192 + l15 * 128 + (((g * 2 + 1) ^ ((l15 >> 1) & 7)) * 16)); \
            const unsigned cw_[8] = {c01_.x, c01_.y, c01_.z, c01_.w, c23_.x, c23_.y, c23_.z, c23_.w}; \
            _Pragma("unroll") for (int i_ = 0; i_ < 4; ++i_) { \
                f32x4 acc_ = (f32x4){bflo(cw_[2 * i_]), bfhi(cw_[2 * i_]), bflo(cw_[2 * i_ + 1]), bfhi(cw_[2 * i_ + 1])}; \
                _Pragma("unroll") for (int ks_ = 0; ks_ < 2; ++ks_) { \
                    const int row_ = i_ * 16 + l15; \
                    const bf16x8 af_ = *(const bf16x8*)(sl_ + row_ * 128 + (((ks_ * 4 + g) ^ ((row_ >> 1) & 7)) * 16)); \
                    acc_ = __builtin_amdgcn_mfma_f32_16x16x32_bf16(af_, bfr_[ks_], acc_, 0, 0, 0); } \
                st[i_] = acc_; } } } \
    __syncthreads(); } while (0)
DEV void rwkv2_unit(const Params& p, int chain, int vblk, float* sm) {
    constexpr int R2_RS = 12, R2_NR = NCH / R2_RS;
    static_assert(R2_NR * R2_RS == NCH && R2_RS * 10240 <= LDS_BYTES, "R2 ring");
    const int tid = opaque_tid(), lane = tid & 63, wave = tid >> 6;
    const bf16_t* RU = (const bf16_t*)(p.ws + OFF_RU);
    bf16_t* S0G = (bf16_t*)(p.ws + OFF_RS0);
    char* ring = (char*)sm;
    const int dir = chain & 1, g = lane >> 4, l15 = lane & 15;
    f32x4 st[4];
#pragma unroll
    for (int i = 0; i < 4; ++i) st[i] = (f32x4){0.f, 0.f, 0.f, 0.f};
    uint4 ma[R2_RS], ca[3], mb[R2_RS], cb[3];
    __syncthreads();
    R2_LOAD(ma, ca, 0); R2_LOAD(mb, cb, 1);
#pragma unroll 1
    for (int rnd = 0; rnd < R2_NR; rnd += 2) {
        R2_ROUND(ma, ca, rnd);
        if (rnd + 1 < R2_NR) R2_ROUND(mb, cb, rnd + 1);
    }
}
#undef R2_LOAD
#undef R2_ROUND

DEV void rwkv3_unit(const Params& p, int h, int c, float* sm) {
    const int tid = opaque_tid(), lane = tid & 63, wave = tid >> 6;
    const bf16_t* P0 = (const bf16_t*)(p.ws + OFF_P0);
    const bf16_t* RUb = (const bf16_t*)(p.ws + OFF_RU);
    const bf16_t* S0G = (const bf16_t*)(p.ws + OFF_RS0);
    const float* BONS = (const float*)(p.ws + OFF_BONS);
    bf16_t* YC = (bf16_t*)(p.ws + OFF_YC);
    const float* mu = p.in[15]; const float* gn_g = p.in[27]; const float* gn_b = p.in[28];
    bf16_t* img = (bf16_t*)sm;
    float* O = sm + 4 * 2304;
    const int t = tid >> 3, v0 = (tid & 7) * 8, s = c * 64 + t;
    const size_t u0 = (size_t)((h * 2 + 0) * NCH + c), u1 = (size_t)((h * 2 + 1) * NCH + c);
    const uint4 gr0 = *(const uint4*)(RUb + u0 * 16384 + 8192 + t * 64 + v0), gs0 = *(const uint4*)(S0G + u0 * 4096 + t * 64 + v0);
    const uint4 gr1 = *(const uint4*)(RUb + u1 * 16384 + 8192 + t * 64 + v0), gs1 = *(const uint4*)(S0G + u1 * 4096 + t * 64 + v0);
    uint2 yl[2][2];
#pragma unroll
    for (int q = 0; q < 2; ++q) { const int idx = wave * 2 + q, ti = idx >> 2, tj = idx & 3;
        yl[q][0] = *(const uint2*)(RUb + u0 * 16384 + 12288 + (tj * 16 + (lane & 15)) * 64 + ti * 16 + (lane >> 4) * 4);
        yl[q][1] = *(const uint2*)(RUb + u1 * 16384 + 12288 + (tj * 16 + (lane & 15)) * 64 + ti * 16 + (lane >> 4) * 4); }
    const RwNb nbq = rw_nb(s);
    const RwRaw wv_ = rw_load(P0, s, nbq, 1024 + h * 64 + v0), wg_ = rw_load(P0, s, nbq, 1536 + h * 64 + v0);
    const float bon = BONS[(size_t)s * 8 + h] + BONS[((size_t)TB + s) * 8 + h];
    __syncthreads();
    *(uint4*)(img + 0 * 4608 + t * 72 + v0) = gr0; *(uint4*)(img + 2 * 4608 + t * 72 + v0) = gs0;
    *(uint4*)(img + 1 * 4608 + t * 72 + v0) = gr1; *(uint4*)(img + 3 * 4608 + t * 72 + v0) = gs1;
    __syncthreads();
#pragma unroll
    for (int q = 0; q < 2; ++q) {
        const int idx = wave * 2 + q, ti = idx >> 2, tj = idx & 3;
        f32x4 accd[2];
#pragma unroll
        for (int dir = 0; dir < 2; ++dir) {
            f32x4 acc = (f32x4){bflo(yl[q][dir].x), bfhi(yl[q][dir].x), bflo(yl[q][dir].y), bfhi(yl[q][dir].y)};
#pragma unroll
            for (int ks = 0; ks < 2; ++ks) acc = __builtin_amdgcn_mfma_f32_16x16x32_bf16(row_frag(img + dir * 4608, 72, ti * 16, ks * 32, lane), row_frag(img + (2 + dir) * 4608, 72, tj * 16, ks * 32, lane), acc, 0, 0, 0);
            accd[dir] = acc;
        }
#pragma unroll
        for (int r = 0; r < 4; ++r) {
            const int oi = (ti * 16 + (lane >> 4) * 4 + r) * 68 + tj * 16 + (lane & 15);
            O[oi] = accd[0][r] + accd[1][r];
        }
    }
    __syncthreads();
    {
        float y[8], sum = 0.f;
#pragma unroll
        for (int i = 0; i < 8; ++i) { y[i] = O[t * 68 + v0 + i]; sum += y[i]; }
        sum = red8_sum(sum);
        const float mean = sum * (1.f / 64.f);
        float sq = 0.f;
#pragma unroll
        for (int i = 0; i < 8; ++i) { y[i] -= mean; sq += y[i] * y[i]; }
        sq = red8_sum(sq);
        const float rstd = rsqrtf(sq * (1.f / 64.f) + 64e-5f);
        float vm[8], gm[8];
        rw_comb(wv_, nbq, mu, 1024 + h * 64 + v0, vm);
        rw_comb(wg_, nbq, mu, 1536 + h * 64 + v0, gm);
        float o[8];
#pragma unroll
        for (int i = 0; i < 8; ++i) o[i] = (y[i] * rstd * gn_g[h * 64 + v0 + i] + gn_b[h * 64 + v0 + i] + bon * vm[i]) * silu_f(gm[i]);
        *(uint4*)(YC + (size_t)s * 1024 + 512 + h * 64 + v0) = pack8(o);
    }
}

DEV void ln_rows(const float* src, const float* res_lat, const float* res_cx, int nrows, const float* __restrict__ g, const float* __restrict__ bt, float* dst_lat, float* dst_cx, int ncx,
                 bf16_t* hb = nullptr, const float* mvc = nullptr, const float* mvl = nullptr) {
    const int tid_ = opaque_tid(); const int lane = tid_ & 63, gw = blockIdx.x * NWV + (tid_ >> 6), ngw = gridDim.x * NWV;
    float4 gg[4], bb[4];
#pragma unroll
    for (int i = 0; i < 4; ++i) { gg[i] = ld4(g + i * 256 + lane * 4); bb[i] = ld4(bt + i * 256 + lane * 4); }
    float4 na[4], nr[4];
    { const int r = gw < nrows ? gw : 0; const float* x = src + (size_t)r * 1024; const float* xr = (r < ncx) ? (res_cx + (size_t)r * 1024) : (res_lat + (size_t)(r - ncx) * 1024);
#pragma unroll
      for (int i = 0; i < 4; ++i) { na[i] = ld4(x + i * 256 + lane * 4); nr[i] = ld4(xr + i * 256 + lane * 4); } }
    for (int r = gw; r < nrows; r += ngw) {
        float4 v[4];
        float sum = 0.f;
#pragma unroll
        for (int i = 0; i < 4; ++i) { const float4 a = na[i], rr = nr[i];
            v[i] = make_float4(ALPHA * rr.x + a.x, ALPHA * rr.y + a.y, ALPHA * rr.z + a.z, ALPHA * rr.w + a.w); sum += v[i].x + v[i].y + v[i].z + v[i].w; }
        { const int rn = (r + ngw < nrows) ? r + ngw : r; const float* x = src + (size_t)rn * 1024; const float* xr = (rn < ncx) ? (res_cx + (size_t)rn * 1024) : (res_lat + (size_t)(rn - ncx) * 1024);
#pragma unroll
          for (int i = 0; i < 4; ++i) { na[i] = ld4(x + i * 256 + lane * 4); nr[i] = ld4(xr + i * 256 + lane * 4); } }
        const float mean = wave_sum(sum) * (1.f / 1024.f);
        float sq = 0.f;
#pragma unroll
        for (int i = 0; i < 4; ++i) {
            v[i].x -= mean; v[i].y -= mean; v[i].z -= mean; v[i].w -= mean;
            sq += v[i].x * v[i].x + v[i].y * v[i].y + v[i].z * v[i].z + v[i].w * v[i].w;
        }
        const float rstd = rsqrtf(wave_sum(sq) * (1.f / 1024.f) + 1e-5f);
        float* d = (r < ncx) ? (dst_cx + (size_t)r * 1024) : (dst_lat + (size_t)(r - ncx) * 1024);
#pragma unroll
        for (int i = 0; i < 4; ++i) {
            const int c = i * 256 + lane * 4;
            const float4 y = make_float4(v[i].x * rstd * gg[i].x + bb[i].x, v[i].y * rstd * gg[i].y + bb[i].y, v[i].z * rstd * gg[i].z + bb[i].z, v[i].w * rstd * gg[i].w + bb[i].w);
            st4(d + c, y);
            if (hb != nullptr) {
                const float* m = (r < ncx) ? mvc : mvl;
                const float4 sh = ld4(m + c), sc = ld4(m + 1024 + c);
                *(uint2*)(hb + (size_t)r * 1024 + c) = make_uint2(pack2bf(y.x * (1.f + sc.x) + sh.x, y.y * (1.f + sc.y) + sh.y), pack2bf(y.z * (1.f + sc.z) + sh.z, y.w * (1.f + sc.w) + sh.w));
            }
        }
    }
}
DEV void phase_h1l(const Params& p) {
    const float* modv1 = (const float*)(p.ws + OFF_MODV) + 3 * 3072;
    bf16_t* H1 = (bf16_t*)(p.ws + OFF_H1B);
    const size_t gt = (size_t)blockIdx.x * NTHR + opaque_tid(), gn = (size_t)gridDim.x * NTHR;
    const int k = (int)(gt & 127) * 8;
    const Mod8 m0 = mod8_load(modv1, k), m1 = mod8_load(modv1 + 3072, k);
    constexpr size_t NI = (size_t)NB * NL * 128;
    for (size_t i0 = gt; i0 < NI; i0 += 4 * gn) {
        float4 xa[4], xb[4];
#pragma unroll
        for (int u = 0; u < 4; ++u) { const size_t i = i0 + u * gn, r = (i < NI ? i : gt) >> 7; xa[u] = ld4(p.out + r * DM + k); xb[u] = ld4(p.out + r * DM + k + 4); }
#pragma unroll
        for (int u = 0; u < 4; ++u) { const size_t i = i0 + u * gn, r = i >> 7; if (i < NI) *(uint4*)(H1 + r * DM + k) = mod8_apply(xa[u], xb[u], (r >= (size_t)NL) ? m1 : m0); }
    }
}

DEV void zero_f4(float* ptr, size_t nfloat) {
    const size_t n4 = nfloat / 4;
    for (size_t i = (size_t)blockIdx.x * NTHR + opaque_tid(); i < n4; i += (size_t)gridDim.x * NTHR) ((float4*)ptr)[i] = make_float4(0.f, 0.f, 0.f, 0.f);
}

DEV void chain_ids(int& chain, int& sub) {
    const int bid = blockIdx.x, xcd = bid & 7, idx = bid >> 3;
    chain = xcd * 2 + (idx >> 4); sub = idx & 15;
}

DEV void phase_conv1(const Params& p, float* sm) {
    const bf16_t* XM = (const bf16_t*)(p.ws + OFF_XM);
    bf16_t* XC = (bf16_t*)(p.ws + OFF_XC);
    float* G16P = (float*)(p.ws + OFF_G16P);
    const bf16_t* WFT = (const bf16_t*)(p.ws + OFF_WFT);
    const float* cw = p.in[31]; const float* cbias = p.in[32];
    bf16_t* imgC = (bf16_t*)sm;
    bf16_t* imgM = imgC + 64 * 264;
    float* red = (float*)(imgM + 64 * 264);
    float* cwl = red + 1024;
    const int tid = opaque_tid(), lane = tid & 63, wave = tid >> 6, t = tid >> 3, cg = tid & 7;
    for (int u = blockIdx.x; u < NB * NCH * 4; u += gridDim.x) {
        const int ci = u >> 2, q = u & 3, b = ci / NCH, c = ci % NCH, s = c * 64 + t;
        const size_t rowbase = (size_t)b * TB;
        int nrow[9]; unsigned vmask = 0u;
#pragma unroll
        for (int i = 0; i < 3; ++i)
#pragma unroll
            for (int j = 0; j < 3; ++j) {
                int ns = -1;
                if (s < NCX) { const int w2 = s + j - 1; if (i == 1 && w2 >= 0 && w2 < NCX) ns = w2; }
                else { const int n = s - NCX, rr = (n >> 6) + i - 1, w2 = (n & 63) + j - 1; if (rr >= 0 && rr < 128 && w2 >= 0 && w2 < 64) ns = NCX + rr * 64 + w2; }
                nrow[i * 3 + j] = ns >= 0 ? ns : s; vmask |= (ns >= 0 ? 1u : 0u) << (i * 3 + j);
            }
        const int tt = wave & 3, part = wave >> 2;
        f32x4 acc = (f32x4){0.f, 0.f, 0.f, 0.f};
        uint4 xn[9];
#pragma unroll
        for (int tap = 0; tap < 9; ++tap) xn[tap] = *(const uint4*)(XM + (rowbase + nrow[tap]) * 2048 + q * 512 + cg * 8);
#pragma unroll 1
        for (int half = 0; half < 2; ++half) {
            __syncthreads();
            for (int i = tid; i < 640; i += NTHR) { const int tp = i >> 6, c4 = (i & 63) * 4; st4(cwl + tp * 256 + c4, ld4((tp < 9 ? cw + tp * 2048 : cbias) + q * 512 + half * 256 + c4)); }
            __syncthreads();
#pragma unroll 1
            for (int it = 0; it < 4; ++it) {
                const int cl = it * 64 + cg * 8, c0 = q * 512 + half * 256 + cl;
                uint4 xc9[9];
#pragma unroll
                for (int tap = 0; tap < 9; ++tap) xc9[tap] = xn[tap];
                { const int gn = half * 4 + it + 1, c0n = q * 512 + (gn < 8 ? gn : 7) * 64 + cg * 8;
#pragma unroll
                  for (int tap = 0; tap < 9; ++tap) xn[tap] = *(const uint4*)(XM + (rowbase + nrow[tap]) * 2048 + c0n); }
                float a8[8];
                { const float4 b0 = ld4(cwl + 9 * 256 + cl), b1 = ld4(cwl + 9 * 256 + cl + 4); a8[0] = b0.x; a8[1] = b0.y; a8[2] = b0.z; a8[3] = b0.w; a8[4] = b1.x; a8[5] = b1.y; a8[6] = b1.z; a8[7] = b1.w; }
#pragma unroll
                for (int tap = 0; tap < 9; ++tap) {
                    const unsigned mk = ((vmask >> tap) & 1u) ? 0xffffffffu : 0u;
                    const uint4 xv = make_uint4(xc9[tap].x & mk, xc9[tap].y & mk, xc9[tap].z & mk, xc9[tap].w & mk);
                    float x8[8]; unpack8(xv, x8);
                    const float4 w0 = ld4(cwl + tap * 256 + cl), w1 = ld4(cwl + tap * 256 + cl + 4);
                    a8[0] += x8[0] * w0.x; a8[1] += x8[1] * w0.y; a8[2] += x8[2] * w0.z; a8[3] += x8[3] * w0.w;
                    a8[4] += x8[4] * w1.x; a8[5] += x8[5] * w1.y; a8[6] += x8[6] * w1.z; a8[7] += x8[7] * w1.w;
                }
#pragma unroll
                for (int i = 0; i < 8; ++i) a8[i] = silu_f(a8[i]);
                const uint4 xcv = pack8(a8);
                *(uint4*)(XC + (rowbase + s) * 2048 + c0) = xcv;
                *(uint4*)(imgC + t * 264 + cl) = xcv;
                *(uint4*)(imgM + t * 264 + cl) = xc9[4];
            }
            __syncthreads();
            {
                const bf16_t* img = part ? imgM : imgC;
                const bf16_t* wrow = WFT + (size_t)(lane & 15) * 4096 + part * 2048 + q * 512 + half * 256 + (lane >> 4) * 8;
#pragma unroll
                for (int ks = 0; ks < 8; ++ks) acc = __builtin_amdgcn_mfma_f32_16x16x32_bf16(row_frag(img, 264, tt * 16, ks * 32, lane), *(const bf16x8*)(wrow + ks * 32), acc, 0, 0, 0);
            }
        }
        if (part == 1) {
#pragma unroll
            for (int r = 0; r < 4; ++r) red[(tt * 16 + (lane >> 4) * 4 + r) * 16 + (lane & 15)] = acc[r];
        }
        __syncthreads();
        if (part == 0) {
#pragma unroll
            for (int r = 0; r < 4; ++r) {
                const int tk = tt * 16 + (lane >> 4) * 4 + r;
                G16P[(((size_t)rowbase + c * 64 + tk) * 16 + (lane & 15)) * 4 + q] = acc[r] + red[tk * 16 + (lane & 15)];
            }
        }
    }
}

struct GateRaw { float4 a, f; };
DEV GateRaw gate_load(const Params& p, size_t row, int dir, int h) {
    const float* G16P = (const float*)(p.ws + OFF_G16P);
    GateRaw g; g.a = ld4(G16P + (row * 16 + dir * 8 + h) * 4); g.f = ld4(G16P + (row * 16 + dir * 8 + 4 + h) * 4);
    return g;
}
DEV void gate_fin(const GateRaw& g, float bi, float bf, float& gi, float& lf) {
    gi = (g.a.x + g.a.y) + (g.a.z + g.a.w) + bi;
    lf = logsig_f((g.f.x + g.f.y) + (g.f.z + g.f.w) + bf);
}
DEV void gate_pair(const Params& p, size_t row, int dir, int h, float& gi, float& lf) {
    const GateRaw g = gate_load(p, row, dir, h);
    gate_fin(g, p.in[dir ? 41 : 37][h], p.in[dir ? 43 : 39][h], gi, lf);
}

DEV void phase_x1(const Params& p, float* sm) {
    int chain, sub; chain_ids(chain, sub);
    const int b = chain >> 3, h = (chain >> 1) & 3, dir = chain & 1;
    const bf16_t* XC = (const bf16_t*)(p.ws + OFF_XC);
    float* GSC = (float*)(p.ws + OFF_GSC); float* CSC = (float*)(p.ws + OFF_CSC); float* NBUF = (float*)(p.ws + OFF_NBUF);
    const float* gtab = (const float*)(p.ws + OFF_GTAB);
    bf16_t* SMAT = (bf16_t*)(p.ws + OFF_SMAT);
    const int tid = opaque_tid(), lane = tid & 63, wave = tid >> 6;
    float* sTot = sm; float* sRef = sm + 132; float* sM0 = sm + 264; float* sBeta = sm + 400;
    const float bias_i = p.in[dir ? 41 : 37][h], bias_f = p.in[dir ? 43 : 39][h];
    {
        GateRaw gn = gate_load(p, (size_t)b * TB + wave * 64 + lane, dir, h);
        for (int c = wave; c < NCH; c += NWV) {
            const GateRaw gc = gn;
            const int cn = (c + NWV < NCH) ? c + NWV : c;
            gn = gate_load(p, (size_t)b * TB + cn * 64 + lane, dir, h);
            float gi, lf; gate_fin(gc, bias_i, bias_f, gi, lf);
            const float bc = wave_scan_add(lf, lane, dir);
            const float ref = wave_max(gi - bc), tot = wave_sum(lf);
            if (lane == 0) { sTot[c] = tot; sRef[c] = ref; }
        }
    }
    __syncthreads();
    if (tid == 0) {
        float m0 = -INFINITY;
        for (int step = 0; step < NCH; ++step) {
            const int c = chunk_at(dir, step);
            sM0[c] = m0;
            const float mx = fmaxf(m0, sRef[c]);
            if (sub == 0) { CSC[(chain * NCH + c) * 2] = fexp(m0 - mx); CSC[(chain * NCH + c) * 2 + 1] = fexp(sRef[c] - mx); }
            m0 = sTot[c] + mx;
        }
    }
    __syncthreads();
    for (int k = wave; sub + 16 * k < NCH; k += NWV) {
        const int c = sub + 16 * k;
        const size_t row = (size_t)b * TB + c * 64 + lane;
        float gi, lf; gate_fin(gate_load(p, row, dir, h), bias_i, bias_f, gi, lf);
        const float bc = wave_scan_add(lf, lane, dir);
        const float a = gi - bc;
        const float amax = wave_scan_max(a, lane, dir);
        const float ref = sRef[c], m0 = sM0[c];
        const float mmax = fmaxf(amax, m0);
        const float mt = bc + mmax;
        const float alpha = fexp(ref - mmax), beta = fexp(a - ref), gg = fexp(m0 - mmax), em = fexp(-mt);
        st4(GSC + ((size_t)chain * TB + c * 64 + lane) * 4, make_float4(alpha, beta, gg, em));
        sBeta[k * 64 + lane] = beta;
    }
    __syncthreads();
    {
        float* part = sm + 1024;
        const int sg = tid >> 6, j8 = (tid & 63) * 8;
        uint4 xn[8];
        { const bf16_t* xp = XC + ((size_t)b * TB + sub * 64 + sg * 8) * 2048 + h * 512 + j8;
#pragma unroll
          for (int s = 0; s < 8; ++s) xn[s] = *(const uint4*)(xp + (size_t)s * 2048); }
        for (int k = 0; sub + 16 * k < NCH; ++k) {
            const int c = sub + 16 * k;
            uint4 xcur[8];
#pragma unroll
            for (int s = 0; s < 8; ++s) xcur[s] = xn[s];
            { const int cn = (c + 16 < NCH) ? c + 16 : c; const bf16_t* xp = XC + ((size_t)b * TB + cn * 64 + sg * 8) * 2048 + h * 512 + j8;
#pragma unroll
              for (int s = 0; s < 8; ++s) xn[s] = *(const uint4*)(xp + (size_t)s * 2048); }
            float acc[8];
#pragma unroll
            for (int i = 0; i < 8; ++i) acc[i] = 0.f;
#pragma unroll
            for (int s = 0; s < 8; ++s) {
                float f[8]; unpack8(xcur[s], f);
                const float be = sBeta[k * 64 + sg * 8 + s];
#pragma unroll
                for (int i = 0; i < 8; ++i) acc[i] += be * f[i];
            }
            __syncthreads();
            st4(part + sg * 512 + j8, make_float4(acc[0], acc[1], acc[2], acc[3])); st4(part + sg * 512 + j8 + 4, make_float4(acc[4], acc[5], acc[6], acc[7]));
            __syncthreads();
            float tot = 0.f;
#pragma unroll
            for (int q = 0; q < 8; ++q) tot += part[q * 512 + tid];
            NBUF[((size_t)chain * NCH + c) * 512 + tid] = tot;
        }
    }
    bf16_t* XCs = (bf16_t*)sm;
    bf16_t* Qs = XCs + 64 * 520;
    for (int u = blockIdx.x; u < NB * 4 * NCH; u += gridDim.x) {
        const int bh = u / NCH, c = u % NCH, ub = bh >> 2, uh = bh & 3;
        __syncthreads();
        float4 gq[2][4];
#pragma unroll
        for (int bb = 0; bb < 2; ++bb) { const float* G = gtab + (size_t)(uh * 128 + (tid & 63) * 2 + bb) * 16; gq[bb][0] = ld4(G); gq[bb][1] = ld4(G + 4); gq[bb][2] = ld4(G + 8); gq[bb][3] = ld4(G + 12); }
        uint4 xr[8];
#pragma unroll
        for (int i = 0; i < 8; ++i) { const int pp = tid + 512 * i, row = pp >> 6, c16 = pp & 63; xr[i] = *(const uint4*)(XC + ((size_t)ub * TB + c * 64 + row) * 2048 + uh * 512 + c16 * 8); }
#pragma unroll
        for (int i = 0; i < 8; ++i) {
            const int pp = tid + 512 * i, row = pp >> 6, c16 = pp & 63;
            const uint4 xv = xr[i];
            float f[8]; unpack8(xv, f);
            float q[8];
#pragma unroll
            for (int bb = 0; bb < 2; ++bb) {
                const float4 g0 = gq[bb][0], g1 = gq[bb][1], g2 = gq[bb][2], g3 = gq[bb][3];
                q[bb * 4 + 0] = f[bb * 4] * g0.x + f[bb * 4 + 1] * g1.x + f[bb * 4 + 2] * g2.x + f[bb * 4 + 3] * g3.x;
                q[bb * 4 + 1] = f[bb * 4] * g0.y + f[bb * 4 + 1] * g1.y + f[bb * 4 + 2] * g2.y + f[bb * 4 + 3] * g3.y;
                q[bb * 4 + 2] = f[bb * 4] * g0.z + f[bb * 4 + 1] * g1.z + f[bb * 4 + 2] * g2.z + f[bb * 4 + 3] * g3.z;
                q[bb * 4 + 3] = f[bb * 4] * g0.w + f[bb * 4 + 1] * g1.w + f[bb * 4 + 2] * g2.w + f[bb * 4 + 3] * g3.w;
            }
            *(uint4*)(XCs + row * 520 + c16 * 8) = xv;
            *(uint4*)(Qs + row * 520 + c16 * 8) = make_uint4(pack2bf(q[0], q[1]), pack2bf(q[2], q[3]), pack2bf(q[4], q[5]), pack2bf(q[6], q[7]));
        }
        __syncthreads();
        const int st = wave & 3, tt0 = (wave >> 2) * 2;
        f32x4 a0 = (f32x4){0.f, 0.f, 0.f, 0.f}, a1 = a0;
        const bf16_t* ap = XCs + (st * 16 + (lane & 15)) * 520 + (lane >> 4) * 8;
        const bf16_t* bp0 = Qs + (tt0 * 16 + (lane & 15)) * 520 + (lane >> 4) * 8;
        const bf16_t* bp1 = bp0 + 16 * 520;
#pragma unroll
        for (int ks = 0; ks < 16; ++ks) {
            const bf16x8 af = *(const bf16x8*)(ap + ks * 32);
            a0 = __builtin_amdgcn_mfma_f32_16x16x32_bf16(af, *(const bf16x8*)(bp0 + ks * 32), a0, 0, 0, 0);
            a1 = __builtin_amdgcn_mfma_f32_16x16x32_bf16(af, *(const bf16x8*)(bp1 + ks * 32), a1, 0, 0, 0);
        }
        bf16_t* sp = SMAT + (size_t)u * 4096 + (size_t)(tt0 * 16 + (lane & 15)) * 64 + st * 16 + (lane >> 4) * 4;
        *(uint2*)sp = make_uint2(pack2bf(a0[0], a0[1]), pack2bf(a0[2], a0[3]));
        *(uint2*)(sp + 16 * 64) = make_uint2(pack2bf(a1[0], a1[1]), pack2bf(a1[2], a1[3]));
    }
}

DEV void phase_x2(const Params& p, float* sm) {
    int chain, sub; chain_ids(chain, sub);
    const int b = chain >> 3, h = (chain >> 1) & 3, dir = chain & 1;
    const bf16_t* XC = (const bf16_t*)(p.ws + OFF_XC);
    float* GSC = (float*)(p.ws + OFF_GSC); const float* CSC = (const float*)(p.ws + OFF_CSC); const float* NBUF = (const float*)(p.ws + OFF_NBUF);
    const float* gtab = (const float*)(p.ws + OFF_GTAB);
    const bf16_t* SMAT = (const bf16_t*)(p.ws + OFF_SMAT);
    const int tid = opaque_tid();
    float* sD0 = sm; float* sCf = sm + 132; float* sN0 = sm + 264; float* sN2 = sN0 + 9 * 512;
    for (int i = tid; i < NCH; i += NTHR) { sD0[i] = CSC[(chain * NCH + i) * 2]; sCf[i] = CSC[(chain * NCH + i) * 2 + 1]; }
    __syncthreads();
    float* sBeta = sN2 + 9 * 512;
    for (int i = tid; i < 9 * 64; i += NTHR) { const int k = i >> 6, c = sub + 16 * k; if (c < NCH) sBeta[i] = GSC[((size_t)chain * TB + c * 64 + (i & 63)) * 4 + 1]; }
    if (tid < 128) {
        constexpr int NBT = 12;
        float4 n = make_float4(0.f, 0.f, 0.f, 0.f), nx[NBT];
        const float* nb = NBUF + (size_t)chain * NCH * 512 + tid * 4;
#pragma unroll
        for (int j = 0; j < NBT; ++j) nx[j] = ld4(nb + (size_t)chunk_at(dir, j) * 512);
#pragma unroll 1
        for (int step0 = 0; step0 < NCH; step0 += NBT) {
            float4 cu[NBT];
#pragma unroll
            for (int j = 0; j < NBT; ++j) cu[j] = nx[j];
#pragma unroll
            for (int j = 0; j < NBT; ++j) { const int sn = step0 + NBT + j; nx[j] = ld4(nb + (size_t)chunk_at(dir, sn < NCH ? sn : NCH - 1) * 512); }
            __builtin_amdgcn_sched_barrier(0);
#pragma unroll
            for (int j = 0; j < NBT; ++j) {
                const int c = chunk_at(dir, step0 + j);
                if ((c & 15) == sub) st4(sN0 + (c >> 4) * 512 + tid * 4, n);
                const float d = sD0[c], cf = sCf[c];
                n = make_float4(d * n.x + cf * cu[j].x, d * n.y + cf * cu[j].y, d * n.z + cf * cu[j].z, d * n.w + cf * cu[j].w);
            }
        }
    }
    __syncthreads();
    {
        const int blk = tid >> 2, cp = tid & 3;
        const float4 g = ld4(gtab + (size_t)(h * 128 + blk) * 16 + cp * 4);
        for (int k = 0; sub + 16 * k < NCH; ++k) {
            const float* n0 = sN0 + k * 512 + blk * 4;
            sN2[k * 512 + tid] = g.x * n0[0] + g.y * n0[1] + g.z * n0[2] + g.w * n0[3];
        }
    }
    __syncthreads();
    const int t = tid >> 3, part = tid & 7;
    for (int k = 0; sub + 16 * k < NCH; ++k) {
        const int c = sub + 16 * k;
        const size_t row = (size_t)b * TB + c * 64 + t;
        float dint = 0.f;
        {
            const bf16_t* xp = XC + row * 2048 + h * 512 + part * 64;
            const float* n2 = sN2 + k * 512 + part * 64;
#pragma unroll
            for (int i = 0; i < 8; ++i) {
                float f[8]; unpack8(*(const uint4*)(xp + i * 8), f);
                const float4 na = ld4(n2 + i * 8), nb2 = ld4(n2 + i * 8 + 4);
                dint += f[0] * na.x + f[1] * na.y + f[2] * na.z + f[3] * na.w + f[4] * nb2.x + f[5] * nb2.y + f[6] * nb2.z + f[7] * nb2.w;
            }
        }
        float di = 0.f;
        {
            float f[8]; unpack8(*(const uint4*)(SMAT + ((size_t)((b * 4 + h) * NCH + c)) * 4096 + t * 64 + part * 8), f);
#pragma unroll
            for (int e = 0; e < 8; ++e) {
                const int s = part * 8 + e;
                const float beta = sBeta[k * 64 + s];
                const bool keep = dir ? (s >= t) : (s <= t);
                di += keep ? f[e] * beta : 0.f;
            }
        }
        dint = red8_sum(dint);
        di = red8_sum(di);
        if (part == 0) {
            float* gp = GSC + ((size_t)chain * TB + c * 64 + t) * 4;
            const float4 g4 = ld4(gp);
            const float den = g4.x * di + g4.z * dint;
            gp[3] = 1.f / fmaxf(fabsf(den), g4.w);
        }
    }
}

#define MLSTM_PREFETCH(step_) do { \
    const int c_ = chunk_at(dir, (step_)); const size_t rb_ = (size_t)b * TB + (size_t)c_ * 64; \
    { const bf16_t* xb_ = XC + (rb_ + (tid >> 6)) * 2048 + h * 512 + (tid & 63) * 8; \
      rx0 = *(const uint4*)(xb_); rx1 = *(const uint4*)(xb_ + 8 * 2048); rx2 = *(const uint4*)(xb_ + 16 * 2048); rx3 = *(const uint4*)(xb_ + 24 * 2048); \
      rx4 = *(const uint4*)(xb_ + 32 * 2048); rx5 = *(const uint4*)(xb_ + 40 * 2048); rx6 = *(const uint4*)(xb_ + 48 * 2048); rx7 = *(const uint4*)(xb_ + 56 * 2048); } \
    rxm = *(const uint2*)(XM + (rb_ + ps) * 2048 + ch0 + pvb * 4); \
    rs = *(const uint4*)(SMAT + ((size_t)((b * 4 + h) * NCH + c_)) * 4096 + ps * 64 + pvb * 8); \
    rbeta = GSC[((size_t)chain * TB + c_ * 64 + ps) * 4 + 1]; \
    if (tid < 64) rsc = ld4(GSC + ((size_t)chain * TB + c_ * 64 + tid) * 4); \
    rd0 = CSC[(chain * NCH + c_) * 2]; rcf = CSC[(chain * NCH + c_) * 2 + 1]; } while (0)

DEV void phase_mlstm(const Params& p, float* sm) {
    int chain, sub; chain_ids(chain, sub);
    const int b = chain >> 3, h = (chain >> 1) & 3, dir = chain & 1;
    const bf16_t* XM = (const bf16_t*)(p.ws + OFF_XM);
    const bf16_t* XC = (const bf16_t*)(p.ws + OFF_XC);
    const bf16_t* SMAT = (const bf16_t*)(p.ws + OFF_SMAT);
    const float* GSC = (const float*)(p.ws + OFF_GSC); const float* CSC = (const float*)(p.ws + OFF_CSC);
    const float* gtab = (const float*)(p.ws + OFF_GTAB);
    bf16_t* H = (bf16_t*)(p.ws + OFF_H);
    const float* wv = p.in[35];
    char* smc = (char*)sm;
    bf16_t* XCs = (bf16_t*)smc;
    bf16_t* Cs = (bf16_t*)(smc + 66560);
    bf16_t* Vb = (bf16_t*)(smc + 66560 + 33280);
    bf16_t* Vw = Vb + 64 * 40;
    bf16_t* Sm = Vw + 64 * 40;
    float* sc = (float*)(smc + 66560 + 33280 + 2 * 5120 + 9216);
    const int tid = opaque_tid(), lane = tid & 63, wave = tid >> 6;
    for (int i = tid; i < 32 * 520 / 2; i += NTHR) ((unsigned*)Cs)[i] = 0u;
    const int ps = tid >> 3, pvb = tid & 7;
    const int ch0 = h * 512 + sub * 32;
    float wvr[16];
#pragma unroll
    for (int i = 0; i < 16; ++i) wvr[i] = wv[(size_t)((ch0 >> 2) + pvb) * 16 + i];
    f32x4 accS[4][2];
#pragma unroll
    for (int i = 0; i < 4; ++i) { accS[i][0] = (f32x4){0.f, 0.f, 0.f, 0.f}; accS[i][1] = (f32x4){0.f, 0.f, 0.f, 0.f}; }
    bf16x8 gA[2][2];
#pragma unroll
    for (int pr = 0; pr < 2; ++pr)
#pragma unroll
        for (int tg = 0; tg < 2; ++tg) {
            const int gq = lane >> 4, l15 = lane & 15, blk = wave * 16 + (pr * 2 + tg) * 4 + gq;
            const float4 gr = ld4(gtab + (size_t)h * 2048 + blk * 16 + (l15 & 3) * 4);
            const bool on = (gq == (l15 >> 2));
            const unsigned p0 = on ? pack2bf(gr.x, gr.y) : 0u, p1 = on ? pack2bf(gr.z, gr.w) : 0u;
            const uint4 u = tg == 0 ? make_uint4(p0, p1, 0u, 0u) : make_uint4(0u, 0u, p0, p1);
            gA[pr][tg] = __builtin_bit_cast(bf16x8, u);
        }
    uint4 rx0, rx1, rx2, rx3, rx4, rx5, rx6, rx7; uint2 rxm; uint4 rs; float rbeta; float4 rsc = make_float4(0.f, 0.f, 0.f, 0.f); float rd0, rcf;
    MLSTM_PREFETCH(0);
    __syncthreads();
#pragma unroll 1
    for (int step = 0; step < NCH; ++step) {
        const int c = chunk_at(dir, step);
        const float d0 = rd0, cf = rcf;
        {
            bf16_t* xd = XCs + (tid >> 6) * 520 + (tid & 63) * 8;
            *(uint4*)(xd) = rx0; *(uint4*)(xd + 8 * 520) = rx1; *(uint4*)(xd + 16 * 520) = rx2; *(uint4*)(xd + 24 * 520) = rx3;
            *(uint4*)(xd + 32 * 520) = rx4; *(uint4*)(xd + 40 * 520) = rx5; *(uint4*)(xd + 48 * 520) = rx6; *(uint4*)(xd + 56 * 520) = rx7;
        }
        {
            const float x0 = bflo(rxm.x), x1 = bfhi(rxm.x), x2 = bflo(rxm.y), x3 = bfhi(rxm.y);
            float vv[4];
#pragma unroll
            for (int d = 0; d < 4; ++d) vv[d] = (x0 * wvr[d] + x1 * wvr[4 + d] + x2 * wvr[8 + d] + x3 * wvr[12 + d]) * rbeta;
            *(uint2*)(Vb + ps * 40 + pvb * 4) = make_uint2(pack2bf(vv[0], vv[1]), pack2bf(vv[2], vv[3]));
            *(uint2*)(Vw + ps * 40 + pvb * 4) = make_uint2(pack2bf(vv[0] * cf, vv[1] * cf), pack2bf(vv[2] * cf, vv[3] * cf));
        }
        {
#define SMASK(q_) (((dir ? (pvb * 8 + 2 * (q_) >= ps) : (pvb * 8 + 2 * (q_) <= ps)) ? 0x0000ffffu : 0u) | ((dir ? (pvb * 8 + 2 * (q_) + 1 >= ps) : (pvb * 8 + 2 * (q_) + 1 <= ps)) ? 0xffff0000u : 0u))
            *(uint4*)(Sm + ps * 72 + pvb * 8) = make_uint4(rs.x & SMASK(0), rs.y & SMASK(1), rs.z & SMASK(2), rs.w & SMASK(3));
#undef SMASK
        }
        if (tid < 64) st4(sc + tid * 4, rsc);
        { const int nstep = (step + 1 < NCH) ? step + 1 : step; MLSTM_PREFETCH(nstep); }
        __syncthreads();
        {
            const int vt = wave & 1, tt = wave >> 1;
            f32x4 ao = (f32x4){0.f, 0.f, 0.f, 0.f}, ai = ao, ao1 = ao, ao2 = ao, ao3 = ao;
            const bf16_t* ap = Cs + (vt * 16 + (lane & 15)) * 520 + (lane >> 4) * 8;
            const bf16_t* bp = XCs + (tt * 16 + (lane & 15)) * 520 + (lane >> 4) * 8;
#pragma unroll
            for (int ks = 0; ks < 16; ks += 4) {
                ao = __builtin_amdgcn_mfma_f32_16x16x32_bf16(*(const bf16x8*)(ap + ks * 32), *(const bf16x8*)(bp + ks * 32), ao, 0, 0, 0);
                ao1 = __builtin_amdgcn_mfma_f32_16x16x32_bf16(*(const bf16x8*)(ap + (ks + 1) * 32), *(const bf16x8*)(bp + (ks + 1) * 32), ao1, 0, 0, 0);
                ao2 = __builtin_amdgcn_mfma_f32_16x16x32_bf16(*(const bf16x8*)(ap + (ks + 2) * 32), *(const bf16x8*)(bp + (ks + 2) * 32), ao2, 0, 0, 0);
                ao3 = __builtin_amdgcn_mfma_f32_16x16x32_bf16(*(const bf16x8*)(ap + (ks + 3) * 32), *(const bf16x8*)(bp + (ks + 3) * 32), ao3, 0, 0, 0);
            }
            ao = (ao + ao1) + (ao2 + ao3);
            const bf16_t* bp2 = Sm + (tt * 16 + (lane & 15)) * 72 + (lane >> 4) * 8;
#pragma unroll
            for (int ks = 0; ks < 2; ++ks) ai = __builtin_amdgcn_mfma_f32_16x16x32_bf16(tr_frag(Vb, 40, ks * 32, vt * 16, lane), *(const bf16x8*)(bp2 + ks * 32), ai, 0, 0, 0);
            if (c >= 4) {
                const int t = tt * 16 + (lane & 15);
                const float4 s4 = ld4(sc + t * 4);
                const float h0 = (s4.x * ai[0] + s4.z * ao[0]) * s4.w, h1 = (s4.x * ai[1] + s4.z * ao[1]) * s4.w;
                const float h2 = (s4.x * ai[2] + s4.z * ao[2]) * s4.w, h3 = (s4.x * ai[3] + s4.z * ao[3]) * s4.w;
                bf16_t* hp = H + ((size_t)b * NL + (size_t)c * 64 + t - NCX) * 2048 + ch0 + vt * 16 + (lane >> 4) * 4;
                const unsigned u0 = pack2bf(h0, h1), u1 = pack2bf(h2, h3);
                asm volatile("global_atomic_pk_add_bf16 %0, %1, off sc1\n\tglobal_atomic_pk_add_bf16 %0, %2, off offset:4 sc1" :: "v"(hp), "v"(u0), "v"(u1) : "memory");
            }
        }
#pragma unroll
        for (int jt = 0; jt < 4; ++jt) { accS[jt][0] *= d0; accS[jt][1] *= d0; }
#pragma unroll
        for (int ks = 0; ks < 2; ++ks) {
            const bf16x8 b0 = tr_frag(Vw, 40, ks * 32, 0, lane), b1 = tr_frag(Vw, 40, ks * 32, 16, lane);
            const int row0 = ks * 32 + (lane >> 4) * 8 + ((lane & 15) >> 2);
#pragma unroll
            for (int jt = 0; jt < 4; ++jt) {
                const int col = wave * 64 + jt * 16 + (lane & 3) * 4;
                const s16x4 lo = __builtin_amdgcn_ds_read_tr16_b64_v4i16((__attribute__((address_space(3))) s16x4*)(XCs + row0 * 520 + col));
                const s16x4 hi = __builtin_amdgcn_ds_read_tr16_b64_v4i16((__attribute__((address_space(3))) s16x4*)(XCs + (row0 + 4) * 520 + col));
                const bf16x8 af = (bf16x8){lo[0], lo[1], lo[2], lo[3], hi[0], hi[1], hi[2], hi[3]};
                accS[jt][0] = __builtin_amdgcn_mfma_f32_16x16x32_bf16(af, b0, accS[jt][0], 0, 0, 0);
                accS[jt][1] = __builtin_amdgcn_mfma_f32_16x16x32_bf16(af, b1, accS[jt][1], 0, 0, 0);
            }
        }
        __builtin_amdgcn_sched_barrier(0);
        __syncthreads();
        __builtin_amdgcn_sched_barrier(0);
#pragma unroll
        for (int pr = 0; pr < 2; ++pr)
#pragma unroll
            for (int v2 = 0; v2 < 2; ++v2) {
                const f32x4 a0 = accS[2 * pr][v2], a1 = accS[2 * pr + 1][v2];
                const uint4 bu = make_uint4(pack2bf(a0[0], a0[1]), pack2bf(a0[2], a0[3]), pack2bf(a1[0], a1[1]), pack2bf(a1[2], a1[3]));
                const bf16x8 bq = __builtin_bit_cast(bf16x8, bu);
#pragma unroll
                for (int tg = 0; tg < 2; ++tg) {
                    const f32x4 o = __builtin_amdgcn_mfma_f32_16x16x32_bf16(gA[pr][tg], bq, (f32x4){0.f, 0.f, 0.f, 0.f}, 0, 0, 0);
                    const int blk = wave * 16 + (2 * pr + tg) * 4 + (lane >> 4);
                    *(uint2*)(Cs + (v2 * 16 + (lane & 15)) * 520 + blk * 4) = make_uint2(pack2bf(o[0], o[1]), pack2bf(o[2], o[3]));
                }
            }
    }
}

DEV void phase_finish1(const Params& p) {
    bf16_t* H = (bf16_t*)(p.ws + OFF_H);
    const bf16_t* XC = (const bf16_t*)(p.ws + OFF_XC);
    const bf16_t* Z = (const bf16_t*)(p.ws + OFF_XM);
    const float* ng = p.in[44]; const float* skip = p.in[45];
    const int tid_ = opaque_tid(); const int lane = tid_ & 63, gw = blockIdx.x * NWV + (tid_ >> 6), ngw = gridDim.x * NWV;
    const int h = gw & 3, c0 = h * 512 + lane * 8;
    float gn8[8], sk8[8];
    { const float4 a0 = ld4(ng + c0), a1 = ld4(ng + c0 + 4), b0 = ld4(skip + c0), b1 = ld4(skip + c0 + 4);
      gn8[0] = a0.x; gn8[1] = a0.y; gn8[2] = a0.z; gn8[3] = a0.w; gn8[4] = a1.x; gn8[5] = a1.y; gn8[6] = a1.z; gn8[7] = a1.w;
      sk8[0] = b0.x; sk8[1] = b0.y; sk8[2] = b0.z; sk8[3] = b0.w; sk8[4] = b1.x; sk8[5] = b1.y; sk8[6] = b1.z; sk8[7] = b1.w; }
    constexpr int NIT = NB * NL * 4;
    uint4 nh[2], nx[2], nz[2];
#pragma unroll
    for (int u = 0; u < 2; ++u) { const int it = gw + u * ngw, r = (it < NIT ? it : gw) >> 2, b = r >= NL ? 1 : 0, nn = r - b * NL;
        nh[u] = *(const uint4*)(H + (size_t)r * 2048 + c0); nx[u] = *(const uint4*)(XC + ((size_t)b * TB + NCX + nn) * 2048 + c0); nz[u] = *(const uint4*)(Z + (size_t)r * 2048 + c0); }
    for (int it0 = gw; it0 < NIT; it0 += 2 * ngw) {
        uint4 ch[2], cx[2], cz[2];
#pragma unroll
        for (int u = 0; u < 2; ++u) { ch[u] = nh[u]; cx[u] = nx[u]; cz[u] = nz[u]; }
#pragma unroll
        for (int u = 0; u < 2; ++u) { const int it = it0 + (2 + u) * ngw, r = (it < NIT ? it : gw) >> 2, b = r >= NL ? 1 : 0, nn = r - b * NL;
            nh[u] = *(const uint4*)(H + (size_t)r * 2048 + c0); nx[u] = *(const uint4*)(XC + ((size_t)b * TB + NCX + nn) * 2048 + c0); nz[u] = *(const uint4*)(Z + (size_t)r * 2048 + c0); }
#pragma unroll
        for (int u = 0; u < 2; ++u) {
            const int it = it0 + u * ngw, r = it >> 2;
            float v[8]; unpack8(ch[u], v);
            float sum = 0.f;
#pragma unroll
            for (int j = 0; j < 8; ++j) sum += v[j];
            const float mean = wave_sum(sum) * (1.f / 512.f);
            float sq = 0.f;
#pragma unroll
            for (int j = 0; j < 8; ++j) { v[j] -= mean; sq += v[j] * v[j]; }
            const float rstd = rsqrtf(wave_sum(sq) * (1.f / 512.f) + 1e-5f);
            float xc[8], z[8];
            unpack8(cx[u], xc); unpack8(cz[u], z);
            float o[8];
#pragma unroll
            for (int j = 0; j < 8; ++j) o[j] = (v[j] * rstd * gn8[j] + sk8[j] * xc[j]) * silu_f(z[j]);
            if (it < NIT) *(uint4*)(H + (size_t)r * 2048 + c0) = make_uint4(pack2bf(o[0], o[1]), pack2bf(o[2], o[3]), pack2bf(o[4], o[5]), pack2bf(o[6], o[7]));
        }
    }
}

__global__ void __launch_bounds__(NTHR) fwd_kernel(Params p) {
    extern __shared__ __attribute__((aligned(16))) float sm[];
    volatile LAS unsigned* xst = (volatile LAS unsigned*)((LAS char*)sm + (LDS_BYTES - 16));
    if (threadIdx.x == 0) { xst[0] = 0u; xst[1] = 0u; }
    __syncthreads();
    const XcdBarrier xbar = xcd_barrier_post((unsigned*)(p.ws + OFF_BAR), xst);
    const int tid = opaque_tid(), lane = tid & 63, wave = tid >> 6;
    float* modv = (float*)(p.ws + OFF_MODV);
    float* X1C = (float*)(p.ws + OFF_X1C);

    phase_mod(p, sm);
    phase_tables(p);
    transpose_convert(p.in[8], 1024, EIN, 4096, (bf16_t*)(p.ws + OFF_WT0), sm);
    transpose_convert(p.in[29], 1024, 4096, 4096, (bf16_t*)(p.ws + OFF_WT1), sm);
    transpose_convert(p.in[9], 1024, 1024, 1024, (bf16_t*)(p.ws + OFF_WT2), sm);
    transpose_convert(p.in[30], 2048, 1024, 1024, (bf16_t*)(p.ws + OFF_WT3), sm);
    xcd_barrier(xbar);

#pragma unroll 1
    for (int b = 0; b < NB; ++b) {
        if (b == 0) { phase_h0(p, 0); xcd_barrier(xbar); }
        run_gemm((const bf16_t*)(p.ws + OFF_YC), (const bf16_t*)(p.ws + OFF_WT0), TB, 3840, DM, EpBf16{(bf16_t*)(p.ws + OFF_P0), EIN, EIN}, sm);
        mini_gemm<3, 2>((const bf16_t*)(p.ws + OFF_YC), DM, 33 * (int)blockIdx.x, TB - 1, (const bf16_t*)(p.ws + OFF_WT0), DM, 3840, (bf16_t*)(p.ws + OFF_P0), EIN, 3840, 33, sm);
        xcd_barrier(xbar);
        {
            const int x = blockIdx.x & 7, q0 = blockIdx.x >> 3;
            R1Raw R;
            r1_consts(p, x, q0 & 1, sm);
            r1_load(p, x, q0 & 1, q0 >> 1, R);
            for (int q = q0; q < 2 * NCH; q += 32) rwkv1_unit(p, x, q & 1, q >> 1, sm, R, (q + 32 < 2 * NCH) ? ((q + 32) >> 1) : -1);
            gla_consts(p, x >> 1, sm);
            if (q0 < 8) { for (int g = 2 * q0; g < 2 * q0 + 2; ++g) gla1_unit(p, x >> 1, g & 1, (NCH / 2) * (x & 1) + (g >> 1), sm); }
            else { for (int g = 16 + (q0 - 8); g < NCH; g += 24) gla1_unit(p, x >> 1, g & 1, (NCH / 2) * (x & 1) + (g >> 1), sm); }
        }
        xcd_barrier(xbar);
        if (blockIdx.x < 128) gla2_unit(p, blockIdx.x);
        else if (blockIdx.x < 192) { const int i = (blockIdx.x - 128) >> 3; rwkv2_unit(p, (blockIdx.x & 7) * 2 + (i >> 2), i & 3, sm); }
        xcd_barrier(xbar);
        {
            const int x = blockIdx.x & 7, j = blockIdx.x >> 3;
            gla_consts(p, x >> 1, sm);
            const int r0 = j < 2 ? 2 * j : (j < 10 ? 4 + (j - 2) * 5 : 44 + (j - 10) * 4), nr = j < 2 ? 2 : (j < 10 ? 5 : 4);
            for (int r = r0; r < r0 + nr; ++r) rwkv3_unit(p, x, r, sm);
            for (int g = j; g < NCH / 2; g += 32) gla3_unit(p, x >> 1, (NCH / 2) * (x & 1) + g, sm);
        }
        xcd_barrier(xbar);
        run_gemm((const bf16_t*)(p.ws + OFF_YC), (const bf16_t*)(p.ws + OFF_WT2), TB, DM, DM, EpRes0{(float*)(p.ws + OFF_P0), modv, b}, sm);
        xcd_barrier(xbar);
        ln_rows((const float*)(p.ws + OFF_P0), p.in[0] + (size_t)b * NL * DM, p.in[2] + (size_t)b * NCX * DM, TB, p.in[6], p.in[7], p.out + (size_t)b * NL * DM, X1C + (size_t)b * NCX * DM, NCX,
                (bf16_t*)(p.ws + OFF_H1B) + (size_t)b * TB * DM, modv + (3 + 2) * 3072, modv + (3 + b) * 3072);
        if (b == 0) phase_h0(p, 1);
        xcd_barrier(xbar);
    }

    run_gemm((const bf16_t*)(p.ws + OFF_H1B), (const bf16_t*)(p.ws + OFF_WT1), RT, 2048, DM, EpBf16{(bf16_t*)(p.ws + OFF_XM), 2048, 2048}, sm);
    zero_f4((float*)(p.ws + OFF_H), (size_t)NB * NL * 1024);
    xcd_barrier(xbar);
    phase_conv1(p, sm);
    xcd_barrier(xbar);
    phase_x1(p, sm);
    xcd_barrier(xbar);
    phase_x2(p, sm);
    xcd_barrier(xbar);
    phase_mlstm(p, sm);
    xcd_barrier(xbar);
    phase_h1l(p);
    xcd_barrier(xbar);
    run_gemm((const bf16_t*)(p.ws + OFF_H1B), (const bf16_t*)(p.ws + OFF_WT1) + (size_t)2048 * 1024, NB * NL, 2048, DM, EpBf16{(bf16_t*)(p.ws + OFF_XM), 2048, 2048}, sm);
    xcd_barrier(xbar);
    phase_finish1(p);
    xcd_barrier(xbar);
    run_gemm((const bf16_t*)(p.ws + OFF_H), (const bf16_t*)(p.ws + OFF_WT3), NB * NL, DM, 2048, EpRes1{(float*)(p.ws + OFF_XC), modv + 3 * 3072}, sm);
    xcd_barrier(xbar);
    ln_rows((const float*)(p.ws + OFF_XC), p.out, p.out, NB * NL, p.in[6] + 1024, p.in[7] + 1024, p.out, p.out, 0);
}

extern "C" void kernel_launch(void* const* d_in, const int* in_sizes, int n_in, void* d_out, int out_size, void* d_ws, size_t ws_size, hipStream_t stream) {
    static int grid_blocks = 0;
    if (grid_blocks == 0) {
        if (ws_size < WS_NEED || n_in != 46) { fprintf(stderr, "kernel_launch: bad ws_size %zu (need %zu) or n_in %d\n", ws_size, (size_t)WS_NEED, n_in); grid_blocks = -1; return; }
        int dev = 0, cus = 0, per_cu = 0;
        (void)hipGetDevice(&dev);
        (void)hipDeviceGetAttribute(&cus, hipDeviceAttributeMultiprocessorCount, dev);
        (void)hipFuncSetAttribute((const void*)fwd_kernel, hipFuncAttributeMaxDynamicSharedMemorySize, LDS_BYTES);
        (void)hipOccupancyMaxActiveBlocksPerMultiprocessor(&per_cu, (const void*)fwd_kernel, NTHR, LDS_BYTES);
        if (per_cu < 1 || cus < 256) { fprintf(stderr, "kernel_launch: occupancy query says %d blocks/CU on %d CUs; this kernel needs 256 resident workgroups\n", per_cu, cus); grid_blocks = -1; return; }
        grid_blocks = 256;
    }
    if (grid_blocks < 0) return;
    (void)hipMemsetAsync((char*)d_ws + OFF_BAR, 0, XCD_BAR_WORDS * 4, stream);
    Params p{};
    for (int i = 0; i < 46; ++i) p.in[i] = (const float*)d_in[i];
    p.out = (float*)d_out; p.ws = (char*)d_ws;
    void* args[] = {&p};
    hipError_t e = hipLaunchCooperativeKernel((const void*)fwd_kernel, dim3(grid_blocks), dim3(NTHR), args, LDS_BYTES, stream);
    if (e != hipSuccess) fprintf(stderr, "cooperative launch failed: %s (grid %d)\n", hipGetErrorString(e), grid_blocks);
}
```

```cpp
#include <hip/hip_runtime.h>
#include <cstdio>
#include <cmath>

#define DEV __device__ __forceinline__

constexpr int NB = 2, NL = 8192, DM = 1024, NCX = 256, TB = NCX + NL;
constexpr int RT = NB * TB;
constexpr int NCH = TB / 64;
constexpr int EIN = 3872, RW0 = 1568;
constexpr int NTHR = 512, NWV = 8;
constexpr float ALPHA = 1.41421356237f;
constexpr float KSCALE = 0.04419417382f;

constexpr size_t OFF_MODV = 0;
constexpr size_t OFF_X1C  = 131072;
constexpr size_t OFF_BAR  = 3145728;
constexpr size_t OFF_BIG  = 4194304;
constexpr size_t OFF_ZROW = OFF_BAR + 16384;
constexpr size_t OFF_P0   = OFF_BIG;
constexpr size_t OFF_YC   = OFF_BIG + (size_t)TB * EIN * 2;
constexpr size_t OFF_GDS  = OFF_YC + (size_t)TB * 1024 * 2;
constexpr size_t OFF_GDEC = OFF_GDS + (size_t)8 * NCH * 8192 * 4;
constexpr size_t OFF_RU   = OFF_GDEC + (size_t)8 * NCH * 64 * 4;
constexpr size_t OFF_RS0  = OFF_RU + (size_t)16 * NCH * 16384 * 2;
constexpr size_t OFF_BONS = OFF_RS0 + (size_t)16 * NCH * 4096 * 2;
constexpr size_t L0_END   = OFF_BONS + (size_t)2 * TB * 8 * 4;
constexpr size_t OFF_XM   = OFF_BIG;
constexpr size_t OFF_XC   = OFF_XM + (size_t)RT * 2048 * 2;
constexpr size_t OFF_H    = OFF_XC + (size_t)RT * 2048 * 2;
constexpr size_t OFF_WT1  = OFF_H + (size_t)NB * NL * 2048 * 2;
constexpr size_t OFF_WT3  = OFF_WT1 + (size_t)4096 * 1024 * 2;
constexpr size_t OFF_WT0  = OFF_WT3 + (size_t)1024 * 2048 * 2;
constexpr size_t OFF_WT2  = OFF_WT0 + (size_t)4096 * 1024 * 2;
constexpr size_t OFF_H1B  = OFF_WT2 + (size_t)1024 * 1024 * 2;
constexpr size_t OFF_SMAT = OFF_WT0;
constexpr size_t OFF_CSC  = OFF_SMAT + (size_t)NB * 4 * NCH * 4096 * 2;
static_assert(OFF_CSC + (size_t)16 * NCH * 2 * 4 <= OFF_H1B, "S matrices + chunk scalars must fit in the dead layer-0 weight copies");
constexpr size_t OFF_GSC  = OFF_X1C;
static_assert(OFF_GSC + (size_t)16 * TB * 4 * 4 <= OFF_BAR, "gate scalars overflow the low region");
constexpr size_t OFF_NBUF = OFF_H1B;
constexpr size_t OFF_G16P = OFF_NBUF + (size_t)16 * NCH * 512 * 4;
constexpr int H1B_NBUF_ROWS = (int)((size_t)16 * NCH * 512 * 4 / 2048);
static_assert((size_t)H1B_NBUF_ROWS * 2048 == (size_t)16 * NCH * 512 * 4, "NBUF must cover whole H1B rows");
constexpr int H1B_CLOB = (int)((OFF_G16P + (size_t)4 * RT * 16 * 4 - OFF_H1B + 2047) / 2048);
static_assert(H1B_CLOB > NCX && H1B_CLOB <= TB, "clobbered H1B rows must stay inside batch 0");
constexpr size_t OFF_GTAB = 3407872;
constexpr size_t OFF_WFT  = OFF_GTAB + (size_t)4 * 128 * 16 * 4;
static_assert(OFF_WFT + (size_t)16 * 4096 * 2 <= OFF_BIG, "low-region tables overflow");
constexpr size_t WS_NEED  = OFF_H1B + (size_t)RT * 1024 * 2;
static_assert(WS_NEED <= (size_t)256 * 1024 * 1024, "workspace exceeds the guaranteed 256 MiB");

static_assert(L0_END <= OFF_WT1, "layer-0 buffers overlap the weight copies");
constexpr int LDS_BYTES = 139264;

struct Params { const float* in[46]; float* out; char* ws; };
typedef unsigned short bf16_t;
typedef __attribute__((ext_vector_type(8))) short bf16x8;
typedef __attribute__((ext_vector_type(4))) short s16x4;
typedef __attribute__((ext_vector_type(2))) short s16x2;
typedef __attribute__((ext_vector_type(4))) float f32x4;
typedef __attribute__((ext_vector_type(2))) __bf16 bf2_t;
DEV unsigned pack2bf(float lo, float hi) { bf2_t v; v[0] = (__bf16)lo; v[1] = (__bf16)hi; return __builtin_bit_cast(unsigned, v); }
DEV float bflo(unsigned u) { return __uint_as_float(u << 16); }
DEV float bfhi(unsigned u) { return __uint_as_float(u & 0xffff0000u); }
DEV float bf2f(bf16_t v) { return __uint_as_float(((unsigned)v) << 16); }
DEV void unpack8(uint4 u, float* f) { f[0] = bflo(u.x); f[1] = bfhi(u.x); f[2] = bflo(u.y); f[3] = bfhi(u.y); f[4] = bflo(u.z); f[5] = bfhi(u.z); f[6] = bflo(u.w); f[7] = bfhi(u.w); }

#define DPPX_F(src_, ctrl_) __int_as_float(__builtin_amdgcn_update_dpp(0, __float_as_int(src_), (ctrl_), 0xf, 0xf, false))
DEV float red8_sum(float v) { v += DPPX_F(v, 0xB1); v += DPPX_F(v, 0x4E); v += DPPX_F(v, 0x141); return v; }
DEV float wave_sum(float v) {
    v += DPPX_F(v, 0xB1); v += DPPX_F(v, 0x4E); v += DPPX_F(v, 0x141); v += DPPX_F(v, 0x140);
    const int b = __float_as_int(v);
    return (__int_as_float(__builtin_amdgcn_readlane(b, 0)) + __int_as_float(__builtin_amdgcn_readlane(b, 16))) + (__int_as_float(__builtin_amdgcn_readlane(b, 32)) + __int_as_float(__builtin_amdgcn_readlane(b, 48)));
}
DEV float wave_max(float v) {
    v = fmaxf(v, DPPX_F(v, 0xB1)); v = fmaxf(v, DPPX_F(v, 0x4E)); v = fmaxf(v, DPPX_F(v, 0x141)); v = fmaxf(v, DPPX_F(v, 0x140));
    const int b = __float_as_int(v);
    return fmaxf(fmaxf(__int_as_float(__builtin_amdgcn_readlane(b, 0)), __int_as_float(__builtin_amdgcn_readlane(b, 16))), fmaxf(__int_as_float(__builtin_amdgcn_readlane(b, 32)), __int_as_float(__builtin_amdgcn_readlane(b, 48))));
}
DEV float fexp(float x) { return __expf(x); }
DEV float frcp(float x) { return __builtin_amdgcn_rcpf(x); }
DEV float sigmoid_f(float x) { return frcp(1.f + fexp(-x)); }
DEV float silu_f(float x) { return x * frcp(1.f + fexp(-x)); }
DEV float logsig_f(float x) { return fminf(x, 0.f) - __logf(1.f + fexp(-fabsf(x))); }
DEV float tanh_f(float x) { const float e = fexp(2.f * x); return 1.f - 2.f * frcp(e + 1.f); }
DEV void lds_fence() { asm volatile("" ::: "memory"); }
DEV int opaque_tid() { int t = threadIdx.x; asm volatile("" : "+v"(t)); return t; }
DEV int scan_s(int dir, int u) { return dir == 0 ? u : (u < NCX ? (NCX - 1 - u) : (TB - 1 + NCX - u)); }
DEV int chunk_at(int dir, int step) { return dir == 0 ? step : (step < 4 ? 3 - step : (NCH + 3 - step)); }
DEV float4 ld4(const float* p) { return *(const float4*)p; }
DEV void st4(float* p, float4 v) { *(float4*)p = v; }


#define XB_TMO      128
#define XB_XCNT(j)  (256  + 64 * (j))
#define XB_XSUB(j)  (1280 + 64 * (j))
#define XB_XGEN(j)  (2304 + 64 * (j))
#define XB_TOP      3328
#define XB_TOPGEN   3392
#define XCD_BAR_WORDS 3456
#define XB_GRP(i)   (3456 + 64 * (i))
#define BAR_WORDS_ALL (3456 + 64 * 8)
static_assert(BAR_WORDS_ALL * 4 <= 16384, "barrier words must end below the zero row");
#define XB_SPIN_CAP (1u << 22)
#define LAS __attribute__((address_space(3)))
DEV unsigned xb_ld(unsigned* p) { return __hip_atomic_load(p, __ATOMIC_RELAXED, __HIP_MEMORY_SCOPE_AGENT); }
DEV unsigned xb_add(unsigned* p, unsigned v) { return __hip_atomic_fetch_add(p, v, __ATOMIC_RELAXED, __HIP_MEMORY_SCOPE_AGENT); }
DEV unsigned xb_xcc_id() { return (unsigned)__builtin_amdgcn_s_getreg((3 << 11) | 20) & 0xFu; }
#define XB_SPIN(cond, bar) do { unsigned _sp = 0; while (cond) { __builtin_amdgcn_s_sleep(1); \
    if ((++_sp & 255u) == 0u) { if (xb_ld(&(bar)[XB_TMO])) break; if (_sp > XB_SPIN_CAP) { atomicAdd(&(bar)[XB_TMO], 1u); break; } } } } while (0)
struct XcdBarrier { unsigned* bar; unsigned x; volatile LAS unsigned* st; };
DEV XcdBarrier xcd_barrier_post(unsigned* bar, volatile LAS unsigned* st) {
    XcdBarrier b; b.bar = bar; b.x = xb_xcc_id(); b.st = st;
    if (threadIdx.x == 0) (void)xb_add(&bar[XB_XCNT(b.x)], 1u);
    return b;
}
DEV void xcd_barrier_complete(unsigned* bar, unsigned x, unsigned& nloc, unsigned& nx) {
    const unsigned G = gridDim.x * gridDim.y * gridDim.z;
    unsigned sum, cnt, mine, sp = 0u;
    for (;;) {
        sum = 0u; cnt = 0u; mine = 0u;
#pragma unroll
        for (unsigned j = 0; j < 16; ++j) { const unsigned c = xb_ld(&bar[XB_XCNT(j)]); sum += c; cnt += (c > 0u) ? 1u : 0u; mine = (j == x) ? c : mine; }
        if (sum == G) break;
        __builtin_amdgcn_s_sleep(1);
        if ((++sp & 255u) == 0u) { if (xb_ld(&bar[XB_TMO])) break; if (sp > XB_SPIN_CAP) { atomicAdd(&bar[XB_TMO], 1u); break; } }
    }
    nloc = mine > 0u ? mine : 1u; nx = cnt > 0u ? cnt : 1u;
}
DEV void xcd_barrier(const XcdBarrier& b) {
    asm volatile("s_waitcnt vmcnt(0)" ::: "memory");
    __syncthreads();
    if (threadIdx.x == 0) {
        unsigned* bar = b.bar;
        __builtin_amdgcn_s_waitcnt(0);
        unsigned nloc = b.st[0], nx = b.st[1];
        if (nloc == 0u) { xcd_barrier_complete(bar, b.x, nloc, nx); b.st[0] = nloc; b.st[1] = nx; }
        const unsigned old = xb_add(&bar[XB_XSUB(b.x)], 1u);
        const unsigned gen = old / nloc;
        if (old + 1u == (gen + 1u) * nloc) {
            __builtin_amdgcn_fence(__ATOMIC_RELEASE, "agent");
            asm volatile("s_waitcnt vmcnt(0)" ::: "memory");
            const unsigned og = xb_add(&bar[XB_TOP], 1u);
            const unsigned tg = og / nx;
            if (og + 1u == (tg + 1u) * nx) xb_add(&bar[XB_TOPGEN], 1u);
            else XB_SPIN(xb_ld(&bar[XB_TOPGEN]) == tg, bar);
            __builtin_amdgcn_fence(__ATOMIC_ACQUIRE, "agent");
            xb_add(&bar[XB_XGEN(b.x)], 1u);
            asm volatile("s_waitcnt vmcnt(0)" ::: "memory");
        } else {
            XB_SPIN(xb_ld(&bar[XB_XGEN(b.x)]) == gen, bar);
            __builtin_amdgcn_fence(__ATOMIC_ACQUIRE, "agent");
            asm volatile("s_waitcnt vmcnt(0)" ::: "memory");
        }
    }
    __syncthreads();
}

DEV void group_barrier(unsigned* bar, unsigned* cnt, unsigned n) {
    asm volatile("s_waitcnt vmcnt(0)" ::: "memory");
    __syncthreads();
    if (threadIdx.x == 0) {
        __builtin_amdgcn_fence(__ATOMIC_RELEASE, "agent");
        asm volatile("s_waitcnt vmcnt(0)" ::: "memory");
        (void)xb_add(cnt, 1u);
        XB_SPIN(xb_ld(cnt) < n, bar);
        __builtin_amdgcn_fence(__ATOMIC_ACQUIRE, "agent");
        asm volatile("s_waitcnt vmcnt(0)" ::: "memory");
    }
    __syncthreads();
}

namespace pg8 {
#define PG8_LAS __attribute__((address_space(3)))
typedef unsigned short bf16_t;
typedef short bf16x8 __attribute__((ext_vector_type(8)));
typedef float f32x4 __attribute__((ext_vector_type(4)));
typedef unsigned u32x4 __attribute__((ext_vector_type(4)));
constexpr int BM = 256, BK = 64, HALF = 128, HTB = HALF * BK * 2  , STAGE_BYTES = 8 * HTB, NXCD = 8, WGM = 8;

__host__ __device__ __forceinline__ int lds_byte(int r, int c) { const int st = (r >> 4) * 2 + (c >> 5), rr = r & 15, cc = c & 31, ob = rr * 64 + cc * 2; return st * 1024 + (ob ^ (((ob >> 9) & 1) << 5)); }
__host__ __device__ __forceinline__ void stage_rc(int b, int& R, int& C) { const int st = b / 1024, sb = b % 1024, swz = sb ^ (((sb >> 9) & 1) << 5); R = (st >> 1) * 16 + swz / 64; C = (st & 1) * 32 + (swz % 64) / 2; }
__host__ __device__ __forceinline__ int perm32(int rho) { const int n = rho >> 4, i = rho & 15; return 8 * (i >> 2) + 4 * n + (i & 3); }

struct Unit { int pm, pn; };
struct Gemm { const bf16_t* A; const bf16_t* Bt; int M, N, K; int skip_pm = 1 << 30; size_t skip_bytes = 0; };

struct StaticOrder {
    int nM, nN, nwg, G, c;
    __host__ __device__ void init(int M, int N, int G_, int c_) { nM = M / BM; nN = N / BM; nwg = nM * nN; G = G_; c = c_; }
    __host__ __device__ bool next(int i, Unit& u) const {
        const long L = (long)i * G + c; if (L >= nwg) return false;
        int wgid = (int)L; { const int q = nwg / NXCD, r = nwg % NXCD, xcd = wgid % NXCD, off = wgid / NXCD; wgid = (xcd < r ? xcd * (q + 1) : r * (q + 1) + (xcd - r) * q) + off; }
        const int nig = WGM * nN, gid = wgid / nig, fm = gid * WGM, gsz = (nM - fm) < WGM ? (nM - fm) : WGM;
        u.pm = fm + ((wgid % nig) % gsz); u.pn = (wgid % nig) / gsz; return true;
    }
    __device__ __forceinline__ void a_ready(const Unit&) const {}
    __device__ __forceinline__ void done(const Unit&) const {}
};

template <class Epi, class Sched, bool STAMP = false>
__device__ __forceinline__ void gemm_phase(PG8_LAS unsigned char* lds, const Gemm g, const Sched& S, const Epi& E, unsigned long long* stamps) {
    int tid = threadIdx.x; asm volatile("" : "+v"(tid));
    const int wid = __builtin_amdgcn_readfirstlane(tid >> 6), lane = tid & 63, wr = wid >> 2, wc = wid & 3, fr = lane & 15, fq = lane >> 4;
    const int K = g.K, nt = K / BK;
#define PG8_STAMP() do { } while (0)
    PG8_STAMP();
    unsigned voffA[2], voffB[2];
#pragma unroll
    for (int i = 0; i < 2; ++i) { int R, C; stage_rc(tid * 16 + i * 8192, R, C); const int Rb = Epi::PERM ? ((R & ~31) + perm32(R & 31)) : R;
        voffA[i] = (unsigned)(R * K + C) * 2u; voffB[i] = (unsigned)(Rb * K + C) * 2u; }
    const size_t kstep = (size_t)(BK * 2);
    const size_t hstep = (size_t)HALF * K * 2;
    const size_t tstep = 2 * hstep;
    const unsigned ldsw = (unsigned)wid * 1024u;
    const int aoff = lds_byte(wr * 64 + fr, fq * 8), boff = lds_byte(wc * 32 + fr, fq * 8);
#define PG8_SA(b, h) (((b) * 2 + (h)) * HTB)
#define PG8_SB(b, h) ((4 + (b) * 2 + (h)) * HTB)
#define PG8_STAGE(bufoff, gbase, voff) do { _Pragma("unroll") for (int _i = 0; _i < 2; ++_i) \
        __builtin_amdgcn_global_load_lds((const unsigned*)((const char*)(gbase) + (voff)[_i]), (PG8_LAS unsigned*)(lds + (bufoff) + ldsw + _i * 8192), 16, 0, 0); } while (0)
#define PG8_LDA(dst, b, h) do { _Pragma("unroll") for (int m = 0; m < 4; ++m) _Pragma("unroll") for (int k = 0; k < 2; ++k) dst[m][k] = *(const PG8_LAS bf16x8*)(lds + PG8_SA(b, h) + aoff + m * 2048 + k * 1024); } while (0)
#define PG8_LDB(dst, b, h) do { _Pragma("unroll") for (int n = 0; n < 2; ++n) _Pragma("unroll") for (int k = 0; k < 2; ++k) dst[n][k] = *(const PG8_LAS bf16x8*)(lds + PG8_SB(b, h) + boff + n * 2048 + k * 1024); } while (0)
#define PG8_MMA(ai, bj, At, Bt) do { __builtin_amdgcn_s_setprio(1); _Pragma("unroll") for (int m = 0; m < 4; ++m) _Pragma("unroll") for (int n = 0; n < 2; ++n) _Pragma("unroll") for (int k = 0; k < 2; ++k) \
        acc[ai][bj][m][n] = __builtin_amdgcn_mfma_f32_16x16x32_bf16(Bt[n][k], At[m][k], acc[ai][bj][m][n], 0, 0, 0); __builtin_amdgcn_s_setprio(0); } while (0)
#define PG8_WAIT_V(n) asm volatile("s_waitcnt vmcnt(" #n ")" ::: "memory")
#define PG8_WAIT_L(n) asm volatile("s_waitcnt lgkmcnt(" #n ")" ::: "memory")
#define PG8_BAR __builtin_amdgcn_s_barrier()
#define PG8_SCHED __builtin_amdgcn_sched_barrier(0)
    Unit cur, nxt; int ui = 0;
    if (!S.next(0, cur)) return;
    f32x4 acc[2][2][4][2];
#pragma unroll
    for (int a = 0; a < 2; ++a)
#pragma unroll
        for (int b = 0; b < 2; ++b)
#pragma unroll
            for (int m = 0; m < 4; ++m)
#pragma unroll
                for (int n = 0; n < 2; ++n) acc[a][b][m][n] = (f32x4){0.f, 0.f, 0.f, 0.f};
    bf16x8 At[4][2], B0[2][2], B1[2][2];
    const char* cA = (const char*)g.A + (size_t)cur.pm * tstep + (cur.pm >= g.skip_pm ? g.skip_bytes : (size_t)0); const char* cB = (const char*)g.Bt + (size_t)cur.pn * tstep;
    S.a_ready(cur);
    PG8_STAGE(PG8_SB(0, 0), cB, voffB); PG8_STAGE(PG8_SA(0, 0), cA, voffA); PG8_STAGE(PG8_SB(0, 1), cB + hstep, voffB); PG8_STAGE(PG8_SA(0, 1), cA + hstep, voffA);
    if (wr == 1) PG8_BAR;
    PG8_WAIT_V(4); PG8_BAR;
    PG8_STAGE(PG8_SB(1, 0), cB + kstep, voffB); PG8_STAGE(PG8_SA(1, 0), cA + kstep, voffA); PG8_STAGE(PG8_SB(1, 1), cB + hstep + kstep, voffB);
    PG8_WAIT_V(6); PG8_BAR;
    PG8_STAMP();
    for (;;) {
        const bool has_next = S.next(ui + 1, nxt);
        const char* nA = has_next ? (const char*)g.A + (size_t)nxt.pm * tstep + (nxt.pm >= g.skip_pm ? g.skip_bytes : (size_t)0) : cA; const char* nB = has_next ? (const char*)g.Bt + (size_t)nxt.pn * tstep : cB;
        for (int t = 0; t < nt; t += 2) {
            const bool last = (t == nt - 2);
            const char* a1 = cA + (size_t)(t + 1) * kstep;
            const char* a2 = last ? nA : cA + (size_t)(t + 2) * kstep; const char* b2 = last ? nB : cB + (size_t)(t + 2) * kstep;
            const char* a3 = a2 + kstep; const char* b3 = b2 + kstep;
            if (last && has_next) S.a_ready(nxt);
            PG8_LDB(B0, 0, 0); PG8_SCHED; PG8_LDA(At, 0, 0); PG8_STAGE(PG8_SA(1, 1), a1 + hstep, voffA);
            PG8_WAIT_L(8); PG8_BAR; PG8_WAIT_L(0); PG8_MMA(0, 0, At, B0); PG8_BAR; PG8_SCHED;
            PG8_LDB(B1, 0, 1); PG8_STAGE(PG8_SB(0, 0), b2, voffB);
            PG8_BAR; PG8_WAIT_L(0); PG8_MMA(0, 1, At, B1); PG8_BAR;
            PG8_LDA(At, 0, 1); PG8_STAGE(PG8_SA(0, 0), a2, voffA);
            PG8_BAR; PG8_WAIT_L(0); PG8_MMA(1, 0, At, B0); PG8_BAR; PG8_SCHED;
            PG8_STAGE(PG8_SB(0, 1), b2 + hstep, voffB);
            PG8_WAIT_V(6); PG8_BAR; PG8_MMA(1, 1, At, B1); PG8_BAR;
            PG8_LDB(B0, 1, 0); PG8_SCHED; PG8_LDA(At, 1, 0); PG8_STAGE(PG8_SA(0, 1), a2 + hstep, voffA);
            PG8_WAIT_L(8); PG8_BAR; PG8_WAIT_L(0); PG8_MMA(0, 0, At, B0); PG8_BAR; PG8_SCHED;
            PG8_LDB(B1, 1, 1); PG8_STAGE(PG8_SB(1, 0), b3, voffB);
            PG8_BAR; PG8_WAIT_L(0); PG8_MMA(0, 1, At, B1); PG8_BAR;
            PG8_LDA(At, 1, 1); PG8_STAGE(PG8_SA(1, 0), a3, voffA);
            PG8_BAR; PG8_WAIT_L(0); PG8_MMA(1, 0, At, B0); PG8_BAR; PG8_SCHED;
            PG8_STAGE(PG8_SB(1, 1), b3 + hstep, voffB);
            PG8_WAIT_V(6); PG8_BAR; PG8_MMA(1, 1, At, B1); PG8_BAR;
        }
        PG8_STAMP();
        if constexpr (!Epi::AFTER_DRAIN) { E(acc, cur, wr, wc, fr, fq); S.done(cur); }
        PG8_STAMP();
        if (!has_next) break;
#pragma unroll
        for (int a = 0; a < 2; ++a)
#pragma unroll
            for (int b = 0; b < 2; ++b)
#pragma unroll
                for (int m = 0; m < 4; ++m)
#pragma unroll
                    for (int n = 0; n < 2; ++n) acc[a][b][m][n] = (f32x4){0.f, 0.f, 0.f, 0.f};
        cur = nxt; cA = nA; cB = nB; ++ui;
    }
    PG8_WAIT_V(0);
    if (wr == 0) PG8_BAR;
    PG8_BAR;
    if constexpr (Epi::AFTER_DRAIN) { E.fused(acc, cur, wr, wc, fr, fq, lds, wid, lane); S.done(cur); }
    PG8_STAMP();
#undef PG8_STAMP
#undef PG8_SA
#undef PG8_SB
#undef PG8_STAGE
#undef PG8_LDA
#undef PG8_LDB
#undef PG8_MMA
#undef PG8_WAIT_V
#undef PG8_WAIT_L
#undef PG8_BAR
#undef PG8_SCHED
}
}

DEV void transpose_tiles(const float* __restrict__ W, int K, int N, int Npad, bf16_t* Wt, float* sm, int tile0, int stride, int tend);
DEV void transpose_convert(const float* __restrict__ W, int K, int N, int Npad, bf16_t* Wt, float* sm, int wg0 = 0, int nwg = 256) {
    if ((int)blockIdx.x < wg0 || (int)blockIdx.x >= wg0 + nwg) return;
    transpose_tiles(W, K, N, Npad, Wt, sm, (int)blockIdx.x - wg0, nwg, (K / 64) * (Npad / 64));
}
DEV void transpose_tiles(const float* __restrict__ W, int K, int N, int Npad, bf16_t* Wt, float* sm, int tile0, int stride, int tend) {
    float (*T)[65] = (float (*)[65])sm;
    const int tid = opaque_tid();
    const int ntl = Npad / 64;
    for (int tile = tile0; tile < tend; tile += stride) {
        const int k0 = (tile / ntl) * 64, n0 = (tile % ntl) * 64;
        __syncthreads();
#pragma unroll
        for (int i = 0; i < 2; ++i) {
            const int k = (tid >> 4) + 32 * i, n4 = (tid & 15) * 4;
            float4 v = make_float4(0.f, 0.f, 0.f, 0.f);
            if (n0 + n4 < N) v = ld4(W + (size_t)(k0 + k) * N + n0 + n4);
            T[k][n4] = v.x; T[k][n4 + 1] = v.y; T[k][n4 + 2] = v.z; T[k][n4 + 3] = v.w;
        }
        __syncthreads();
        const int n = tid >> 3, kq = (tid & 7) * 8;
        unsigned o[4];
#pragma unroll
        for (int j = 0; j < 4; ++j) o[j] = pack2bf(T[kq + 2 * j][n], T[kq + 2 * j + 1][n]);
        bf16_t* dst = Wt + (size_t)(n0 + n) * K + k0 + kq;
        *(uint4*)dst = make_uint4(o[0], o[1], o[2], o[3]);
    }
}

struct EpBf16 {
    static constexpr bool PERM = true, AFTER_DRAIN = false;
    bf16_t* O; int ldc; int ncols; int skip_pm = 1 << 30, skip_rows = 0;
    DEV void operator()(const pg8::f32x4 (&acc)[2][2][4][2], const pg8::Unit& u, int wr, int wc, int fr, int fq) const {
        const int row0 = u.pm * 256 + wr * 64 + fr + (u.pm >= skip_pm ? skip_rows : 0), col0 = u.pn * 256 + wc * 32 + 8 * fq;
#pragma unroll
        for (int ai = 0; ai < 2; ++ai)
#pragma unroll
            for (int m = 0; m < 4; ++m) {
                bf16_t* rowp = O + (size_t)(row0 + ai * 128 + m * 16) * ldc + col0;
#pragma unroll
                for (int bj = 0; bj < 2; ++bj) {
                    if (col0 + bj * 128 < ncols) {
                        const pg8::f32x4 v0 = acc[ai][bj][m][0], v1 = acc[ai][bj][m][1];
                        *(uint4*)(rowp + bj * 128) = make_uint4(pack2bf(v0[0], v0[1]), pack2bf(v0[2], v0[3]), pack2bf(v1[0], v1[1]), pack2bf(v1[2], v1[3]));
                    }
                }
            }
    }
};
template <int L>
struct EpGate {
    static constexpr bool PERM = true, AFTER_DRAIN = false;
    bf16_t* C; const float* mv; int b;
    DEV void operator()(const pg8::f32x4 (&acc)[2][2][4][2], const pg8::Unit& u, int wr, int wc, int fr, int fq) const {
        const float* gp = mv + (L == 0 ? ((u.pm * 256 < NCX) ? 2 : b) : ((u.pm * 256 >= NL) ? 1 : 0)) * 3072 + 2048;
        const int row0 = u.pm * 256 + wr * 64 + fr, col0 = u.pn * 256 + wc * 32 + 8 * fq;
        const float4 g00 = ld4(gp + col0), g01 = ld4(gp + col0 + 4), g10 = ld4(gp + col0 + 128), g11 = ld4(gp + col0 + 132);
#pragma unroll
        for (int ai = 0; ai < 2; ++ai)
#pragma unroll
            for (int m = 0; m < 4; ++m) {
                bf16_t* rowp = C + (size_t)(row0 + ai * 128 + m * 16) * DM + col0;
#pragma unroll
                for (int bj = 0; bj < 2; ++bj) {
                    const pg8::f32x4 v0 = acc[ai][bj][m][0], v1 = acc[ai][bj][m][1];
                    const float4 ga = bj ? g10 : g00, gb = bj ? g11 : g01;
                    *(uint4*)(rowp + bj * 128) = make_uint4(pack2bf(ga.x * v0[0], ga.y * v0[1]), pack2bf(ga.z * v0[2], ga.w * v0[3]), pack2bf(gb.x * v1[0], gb.y * v1[1]), pack2bf(gb.z * v1[2], gb.w * v1[3]));
                }
            }
    }
};
template <class EP>
DEV void run_gemm(const bf16_t* A, const bf16_t* Bt, int M, int N, int K, const EP& ep, float* sm, int skip_pm = 1 << 30, size_t skip_bytes = 0) {
    pg8::Gemm g{A, Bt, M, N, K, skip_pm, skip_bytes}; pg8::StaticOrder S; S.init(M, N, (int)gridDim.x, (int)blockIdx.x);
    pg8::gemm_phase<EP, pg8::StaticOrder, false>((PG8_LAS unsigned char*)sm, g, S, ep, nullptr);
}

template <int MT, int NT>
DEV void mini_gemm(const bf16_t* A, int lda, int row0, int row_clamp, const bf16_t* Bt, int ldb, int brow0, bf16_t* C, int ldc, int ccol0, int nvalid, float* sm) {
    const int tid = opaque_tid(), lane = tid & 63, wave = tid >> 6, l15 = lane & 15, g = lane >> 4;
    f32x4 acc[MT][NT];
#pragma unroll
    for (int m = 0; m < MT; ++m)
#pragma unroll
        for (int n = 0; n < NT; ++n) acc[m][n] = (f32x4){0.f, 0.f, 0.f, 0.f};
    const bf16_t* ap[MT]; const bf16_t* bp[NT];
#pragma unroll
    for (int m = 0; m < MT; ++m) { const int r = row0 + m * 16 + l15; ap[m] = A + (size_t)(r < row_clamp ? r : row_clamp) * lda + wave * 128 + g * 8; }
#pragma unroll
    for (int n = 0; n < NT; ++n) bp[n] = Bt + (size_t)(brow0 + n * 16 + l15) * ldb + wave * 128 + g * 8;
#pragma unroll
    for (int kh = 0; kh < 2; ++kh) {
        bf16x8 af[2][MT], bq[2][NT];
#pragma unroll
        for (int ks = 0; ks < 2; ++ks) {
#pragma unroll
            for (int m = 0; m < MT; ++m) af[ks][m] = *(const bf16x8*)(ap[m] + (kh * 2 + ks) * 32);
#pragma unroll
            for (int n = 0; n < NT; ++n) bq[ks][n] = *(const bf16x8*)(bp[n] + (kh * 2 + ks) * 32);
        }
#pragma unroll
        for (int ks = 0; ks < 2; ++ks)
#pragma unroll
            for (int m = 0; m < MT; ++m)
#pragma unroll
                for (int n = 0; n < NT; ++n) acc[m][n] = __builtin_amdgcn_mfma_f32_16x16x32_bf16(af[ks][m], bq[ks][n], acc[m][n], 0, 0, 0);
    }
    __syncthreads();
#pragma unroll
    for (int m = 0; m < MT; ++m)
#pragma unroll
        for (int n = 0; n < NT; ++n) st4(sm + ((wave * MT + m) * NT + n) * 256 + lane * 4, make_float4(acc[m][n][0], acc[m][n][1], acc[m][n][2], acc[m][n][3]));
    __syncthreads();
    for (int e = tid; e < MT * NT * 256; e += NTHR) {
        const int tile = e >> 8, idx = e & 255, ln = idx >> 2, r = idx & 3;
        float s = 0.f;
#pragma unroll
        for (int w = 0; w < NWV; ++w) s += sm[(w * MT * NT + tile) * 256 + idx];
        const int i = (tile / NT) * 16 + (ln >> 4) * 4 + r, j = (tile % NT) * 16 + (ln & 15);
        if (i < nvalid) C[(size_t)(row0 + i) * ldc + ccol0 + j] = __builtin_bit_cast(unsigned short, (__bf16)s);
    }
}

struct Mod8 { float4 s0, s1, c0, c1; };
DEV Mod8 mod8_load(const float* m, int k) { Mod8 q; q.s0 = ld4(m + k); q.s1 = ld4(m + k + 4); q.c0 = ld4(m + 1024 + k); q.c1 = ld4(m + 1024 + k + 4); return q; }
DEV uint4 mod8_apply(const float4 x0, const float4 x1, const Mod8& q) {
    return make_uint4(pack2bf(x0.x * (1.f + q.c0.x) + q.s0.x, x0.y * (1.f + q.c0.y) + q.s0.y), pack2bf(x0.z * (1.f + q.c0.z) + q.s0.z, x0.w * (1.f + q.c0.w) + q.s0.w),
                      pack2bf(x1.x * (1.f + q.c1.x) + q.s1.x, x1.y * (1.f + q.c1.y) + q.s1.y), pack2bf(x1.z * (1.f + q.c1.z) + q.s1.z, x1.w * (1.f + q.c1.w) + q.s1.w));
}
DEV void phase_h0(const Params& p, int b, bf16_t* H0, int wg0, int nwg) {
    const float* modv = (const float*)(p.ws + OFF_MODV);
    if ((int)blockIdx.x < wg0 || (int)blockIdx.x >= wg0 + nwg) return;
    const int gt = ((int)blockIdx.x - wg0) * NTHR + opaque_tid(), gn = nwg * NTHR;
    const int k = (gt & 127) * 8;
    const Mod8 mc = mod8_load(modv + 2 * 3072, k), ml = mod8_load(modv + b * 3072, k);
    for (int i0 = gt; i0 < TB * 128; i0 += 4 * gn) {
        float4 xa[4], xb[4];
#pragma unroll
        for (int u = 0; u < 4; ++u) {
            const int i = i0 + u * gn, s = (i < TB * 128 ? i : gt) >> 7;
            const float* src = (s < NCX) ? p.in[2] + ((size_t)(b * NCX + s)) * DM + k : p.in[0] + ((size_t)(b * NL + s - NCX)) * DM + k;
            xa[u] = ld4(src); xb[u] = ld4(src + 4);
        }
#pragma unroll
        for (int u = 0; u < 4; ++u) {
            const int i = i0 + u * gn, s = i >> 7;
            if (i < TB * 128) *(uint4*)(H0 + (size_t)s * DM + k) = mod8_apply(xa[u], xb[u], (s < NCX) ? mc : ml);
        }
    }
}

DEV void phase_mod(const Params& p, float* sm) {
    const float* c = p.in[1]; const float* cctx = p.in[3];
    const float* mod_w = p.in[4]; const float* mod_b = p.in[5];
    float* modv = (float*)(p.ws + OFF_MODV);
    float* sil = sm; float* red = sm + 3072;
    const int tid = opaque_tid();
    for (int i = tid; i < 3072; i += NTHR) {
        const int j = i >> 10, k = i & 1023;
        const float v = (j < 2) ? c[j * 1024 + k] : cctx[k];
        sil[i] = silu_f(v);
    }
    __syncthreads();
    for (int unit = blockIdx.x; unit < 192; unit += gridDim.x) {
        const int l = unit / 96, cb = unit % 96;
        const int kg = tid >> 3, cg = tid & 7, n = cb * 32 + cg * 4;
        const float* w = mod_w + (size_t)l * 1024 * 3072 + (size_t)(kg * 16) * 3072 + n;
        float4 wv[16];
#pragma unroll
        for (int i = 0; i < 16; ++i) wv[i] = ld4(w + (size_t)i * 3072);
        float4 a0 = make_float4(0.f, 0.f, 0.f, 0.f), a1 = a0, a2 = a0;
#pragma unroll
        for (int i = 0; i < 16; ++i) {
            const float s0 = sil[kg * 16 + i], s1 = sil[1024 + kg * 16 + i], s2 = sil[2048 + kg * 16 + i];
            a0.x += s0 * wv[i].x; a0.y += s0 * wv[i].y; a0.z += s0 * wv[i].z; a0.w += s0 * wv[i].w;
            a1.x += s1 * wv[i].x; a1.y += s1 * wv[i].y; a1.z += s1 * wv[i].z; a1.w += s1 * wv[i].w;
            a2.x += s2 * wv[i].x; a2.y += s2 * wv[i].y; a2.z += s2 * wv[i].z; a2.w += s2 * wv[i].w;
        }
        st4(red + (kg * 3 + 0) * 32 + cg * 4, a0); st4(red + (kg * 3 + 1) * 32 + cg * 4, a1); st4(red + (kg * 3 + 2) * 32 + cg * 4, a2);
        __syncthreads();
        if (tid < 96) {
            const int j = tid >> 5, cc = tid & 31, nn = cb * 32 + cc;
            float s = mod_b[l * 3072 + nn];
#pragma unroll 8
            for (int g = 0; g < 64; ++g) s += red[(g * 3 + j) * 32 + cc];
            modv[(l * 3 + j) * 3072 + nn] = s;
        }
        __syncthreads();
    }
}

DEV void phase_tables(const Params& p, int wg0, int nwg) {
    const float* wq = p.in[33]; const float* wk = p.in[34]; const float* wv = p.in[35];
    const float* gw0 = p.in[36]; const float* gw1 = p.in[38]; const float* gw2 = p.in[40]; const float* gw3 = p.in[42];
    float* gtab = (float*)(p.ws + OFF_GTAB); bf16_t* wft = (bf16_t*)(p.ws + OFF_WFT);
    if ((int)blockIdx.x < wg0 || (int)blockIdx.x >= wg0 + nwg) return;
    const int gt = ((int)blockIdx.x - wg0) * NTHR + opaque_tid(), gn = nwg * NTHR;
    for (int i = gt; i < 512 * 16; i += gn) {
        const int gb = i >> 4, cp = (i >> 2) & 3, c = i & 3;
        float s = 0.f;
#pragma unroll
        for (int d = 0; d < 4; ++d) s += wq[gb * 16 + cp * 4 + d] * wk[gb * 16 + c * 4 + d];
        gtab[i] = s * KSCALE;
    }
    for (int i = gt; i < 4096 * 16; i += gn) {
        const int g = i >> 12, k = i & 4095, gm = g >> 2, hd = g & 3;
        const float* wg = gm == 0 ? gw0 : (gm == 1 ? gw1 : (gm == 2 ? gw2 : gw3));
        float s = 0.f;
        if (k < 2048) {
            const int blk = k >> 2, cc = k & 3;
#pragma unroll
            for (int d = 0; d < 4; ++d) s += wq[blk * 16 + cc * 4 + d] * wg[(size_t)(4 * blk + d) * 4 + hd] + wk[blk * 16 + cc * 4 + d] * wg[(size_t)(2048 + 4 * blk + d) * 4 + hd];
        } else {
            const int kk = k - 2048, blk = kk >> 2, cc = kk & 3;
#pragma unroll
            for (int d = 0; d < 4; ++d) s += wv[blk * 16 + cc * 4 + d] * wg[(size_t)(4096 + 4 * blk + d) * 4 + hd];
        }
        wft[i] = __builtin_bit_cast(unsigned short, (__bf16)s);
    }
}

DEV float dpp_add(float v, float acc_src, int) { return v + acc_src; }
#define DPP_F(src_, ctrl_, rmask_) __int_as_float(__builtin_amdgcn_update_dpp(0, __float_as_int(src_), (ctrl_), (rmask_), 0xf, false))
DEV float wave_scan_add(float v, int lane, int dir) {
    float p = v;
    p += DPP_F(p, 0x111, 0xf);
    p += DPP_F(p, 0x112, 0xf);
    p += DPP_F(p, 0x114, 0xf);
    p += DPP_F(p, 0x118, 0xf);
    p += DPP_F(p, 0x142, 0xa);
    p += DPP_F(p, 0x143, 0xc);
    if (dir) { const float tot = __int_as_float(__builtin_amdgcn_readlane(__float_as_int(p), 63)); p = tot - p + v; }
    return p;
}
DEV float wave_scan_max(float v, int lane, int dir) {
#pragma unroll
    for (int o = 1; o < 64; o <<= 1) {
        const float n = dir ? __shfl_down(v, o, 64) : __shfl_up(v, o, 64);
        const bool ok = dir ? (lane + o < 64) : (lane >= o);
        if (ok) v = fmaxf(v, n);
    }
    return v;
}

constexpr int GLC_OFF = 30336;
static_assert((GLC_OFF + 2176) * 4 <= LDS_BYTES - 16, "GLA constants must fit below the barrier words");
DEV void gla_consts(const Params& p, int h, float* sm) {
    const int tid = opaque_tid();
    float* sWA2 = sm + GLC_OFF; float* sBA2 = sWA2 + 2048;
    __syncthreads();
    for (int i = tid; i < 2048; i += NTHR) { const int d = i >> 10, ii = (i >> 6) & 15, k = i & 63; sWA2[i] = p.in[d ? 12 : 10][ii * 256 + h * 64 + k]; }
    if (tid < 128) sBA2[tid] = p.in[(tid >> 6) ? 13 : 11][h * 64 + (tid & 63)];
}
DEV void gla_decay_core(const float* sLRd, const float* sWAd, const float* sBAd, float* sBC, float* sTot, int dir, int tid) {
    {
        const int t = tid >> 3, k0 = (tid & 7) * 8;
        float acc[8];
#pragma unroll
        for (int j = 0; j < 8; ++j) acc[j] = sBAd[k0 + j];
#pragma unroll
        for (int ii = 0; ii < 16; ++ii) {
            const float l = sLRd[t * 16 + ii];
#pragma unroll
            for (int j = 0; j < 8; ++j) acc[j] += l * sWAd[ii * 64 + k0 + j];
        }
#pragma unroll
        for (int j = 0; j < 8; ++j) sBC[t * 65 + k0 + j] = logsig_f(acc[j]) * 0.0625f;
    }
    __syncthreads();
    {
        const int lane = tid & 63, wv = tid >> 6;
#pragma unroll
        for (int j = 0; j < 8; ++j) {
            const int k = wv * 8 + j;
            const float v = wave_scan_add(sBC[lane * 65 + k], lane, dir);
            sBC[lane * 65 + k] = v;
            if (lane == (dir ? 0 : 63)) sTot[k] = v;
        }
    }
    __syncthreads();
}

DEV bf16x8 tr_frag(const bf16_t* base, int ld, int row0, int col0, int lane) {
    const bf16_t* ptr = base + (row0 + (lane >> 4) * 8 + ((lane & 15) >> 2)) * ld + col0 + (lane & 3) * 4;
    const s16x4 lo = __builtin_amdgcn_ds_read_tr16_b64_v4i16((__attribute__((address_space(3))) s16x4*)ptr);
    const s16x4 hi = __builtin_amdgcn_ds_read_tr16_b64_v4i16((__attribute__((address_space(3))) s16x4*)(ptr + 4 * ld));
    return (bf16x8){lo[0], lo[1], lo[2], lo[3], hi[0], hi[1], hi[2], hi[3]};
}
DEV bf16x8 row_frag(const bf16_t* base, int ld, int idx0, int k0, int lane) {
    return *(const bf16x8*)(base + (idx0 + (lane & 15)) * ld + k0 + (lane >> 4) * 8);
}

DEV void gla1_unit(const Params& p, int h, int dir, int c, float* sm) {
    const int tid = opaque_tid(), lane = tid & 63, wave = tid >> 6;
    const bf16_t* P0 = (const bf16_t*)(p.ws + OFF_P0);
    bf16_t* GDS = (bf16_t*)(p.ws + OFF_GDS); float* GDEC = (float*)(p.ws + OFF_GDEC);
    float* sLR = sm; float* sBC = sm + 2048; float* sTot = sm + 6208;
    bf16_t* kT = (bf16_t*)(sm + 6272);
    bf16_t* Vs = (bf16_t*)(sm + 8576);
    const int ch = h * 2 + dir;
    const int t = tid >> 3, k0 = (tid & 7) * 8;
    const uint4 lrq = *(const uint4*)(P0 + (size_t)(c * 64 + ((tid & 127) >> 1)) * EIN + 1536 + dir * 16 + (tid & 1) * 8);
    const uint4 kq = *(const uint4*)(P0 + (size_t)(c * 64 + t) * EIN + 256 + h * 64 + k0);
    const uint4 vq0 = *(const uint4*)(P0 + (size_t)(c * 64 + (tid >> 4)) * EIN + 512 + h * 128 + (tid & 15) * 8);
    const uint4 vq1 = *(const uint4*)(P0 + (size_t)(c * 64 + 32 + (tid >> 4)) * EIN + 512 + h * 128 + (tid & 15) * 8);
    __syncthreads();
    if (tid < 128) { float* d = sLR + (tid >> 1) * 16 + (tid & 1) * 8; st4(d, make_float4(bflo(lrq.x), bfhi(lrq.x), bflo(lrq.y), bfhi(lrq.y))); st4(d + 4, make_float4(bflo(lrq.z), bfhi(lrq.z), bflo(lrq.w), bfhi(lrq.w))); }
    *(uint4*)(Vs + (tid >> 4) * 136 + (tid & 15) * 8) = vq0; *(uint4*)(Vs + (32 + (tid >> 4)) * 136 + (tid & 15) * 8) = vq1;
    __syncthreads();
    gla_decay_core(sLR, sm + GLC_OFF + dir * 1024, sm + GLC_OFF + 2048 + dir * 64, sBC, sTot, dir, tid);
    {
        float kv[8]; unpack8(kq, kv);
#pragma unroll
        for (int j = 0; j < 8; ++j) kT[(k0 + j) * 72 + t] = __builtin_bit_cast(unsigned short, (__bf16)(kv[j] * fexp(sTot[k0 + j] - sBC[t * 65 + k0 + j])));
    }
    __syncthreads();
    {
        f32x4 acc[4];
#pragma unroll
        for (int kt = 0; kt < 4; ++kt) acc[kt] = (f32x4){0.f, 0.f, 0.f, 0.f};
#pragma unroll
        for (int ks = 0; ks < 2; ++ks) {
            const bf16x8 af = tr_frag(Vs, 136, ks * 32, wave * 16, lane);
#pragma unroll
            for (int kt = 0; kt < 4; ++kt) acc[kt] = __builtin_amdgcn_mfma_f32_16x16x32_bf16(af, row_frag(kT, 72, kt * 16, ks * 32, lane), acc[kt], 0, 0, 0);
        }
        bf16_t* Ot = (bf16_t*)(sm + 13056);
#pragma unroll
        for (int kt = 0; kt < 4; ++kt) {
            const int k = kt * 16 + (lane & 15), v = wave * 16 + (lane >> 4) * 4;
            *(uint2*)(Ot + k * 136 + v) = make_uint2(pack2bf(acc[kt][0], acc[kt][1]), pack2bf(acc[kt][2], acc[kt][3]));
        }
        __syncthreads();
#pragma unroll
        for (int u = 0; u < 2; ++u) { const int i = tid + 512 * u; *(uint4*)(GDS + (size_t)(ch * NCH + c) * 8192 + i * 8) = *(const uint4*)(Ot + (i >> 4) * 136 + (i & 15) * 8); }
    }
    if (tid < 64) GDEC[(size_t)(ch * NCH + c) * 64 + tid] = fexp(sTot[tid]);
}

DEV void gla2_head(const Params& p, int hg, int f) {
    const int tid = opaque_tid();
    bf16_t* GDS = (bf16_t*)(p.ws + OFF_GDS); const float* GDEC = (const float*)(p.ws + OFF_GDEC);
    const int E = f * 384 + tid * 4;
    if (tid >= 96 || E >= 16384) return;
    const int dir = E >> 13, e = E & 8191, k = e >> 7, ch = hg * 2 + dir;
    constexpr int GB = 12;
    float4 S = make_float4(0.f, 0.f, 0.f, 0.f); uint2 ninc[GB]; float nd[GB];
#pragma unroll
    for (int j = 0; j < GB; ++j) { const int c = chunk_at(dir, j); ninc[j] = *(const uint2*)(GDS + (size_t)(ch * NCH + c) * 8192 + e); nd[j] = GDEC[(size_t)(ch * NCH + c) * 64 + k]; }
#pragma unroll 1
    for (int step0 = 0; step0 < NCH; step0 += GB) {
        uint2 inc[GB]; float d[GB];
#pragma unroll
        for (int j = 0; j < GB; ++j) { inc[j] = ninc[j]; d[j] = nd[j]; }
#pragma unroll
        for (int j = 0; j < GB; ++j) { const int sn = step0 + GB + j, c = chunk_at(dir, sn < NCH ? sn : NCH - 1); ninc[j] = *(const uint2*)(GDS + (size_t)(ch * NCH + c) * 8192 + e); nd[j] = GDEC[(size_t)(ch * NCH + c) * 64 + k]; }
        __builtin_amdgcn_sched_barrier(0);
#pragma unroll
        for (int j = 0; j < GB; ++j) { const int c = chunk_at(dir, step0 + j);
            *(uint2*)(GDS + (size_t)(ch * NCH + c) * 8192 + e) = make_uint2(pack2bf(S.x, S.y), pack2bf(S.z, S.w));
            S = make_float4(d[j] * S.x + bflo(inc[j].x), d[j] * S.y + bfhi(inc[j].x), d[j] * S.z + bflo(inc[j].y), d[j] * S.w + bfhi(inc[j].y)); }
    }
}

DEV void gla3_unit(const Params& p, int h, int c, float* sm) {
    const int tid = opaque_tid(), lane = tid & 63, wave = tid >> 6;
    const bf16_t* P0 = (const bf16_t*)(p.ws + OFF_P0);
    const bf16_t* GDS = (const bf16_t*)(p.ws + OFF_GDS);
    bf16_t* YC = (bf16_t*)(p.ws + OFF_YC);
    const float* ng = p.in[14];
    float* sLR2 = sm;
    float* sBC = sm + 2048; float* sTot = sm + 6208;
    bf16_t* qt = (bf16_t*)(sm + 6272);
    bf16_t* kt = (bf16_t*)(sm + 8576);
    bf16_t* Sm = (bf16_t*)(sm + 10880);
    bf16_t* S0s = (bf16_t*)(sm + 13184);
    bf16_t* Vs = (bf16_t*)(sm + 17536);
    float* O = sm + 21888;
    const int ti = wave & 3, vt0 = (wave >> 2) * 4;
    const int t = tid >> 3, k0 = (tid & 7) * 8;
    f32x4 acc[4];
#pragma unroll
    for (int j = 0; j < 4; ++j) acc[j] = (f32x4){0.f, 0.f, 0.f, 0.f};
    const uint4 vq0 = *(const uint4*)(P0 + (size_t)(c * 64 + (tid >> 4)) * EIN + 512 + h * 128 + (tid & 15) * 8);
    const uint4 vq1 = *(const uint4*)(P0 + (size_t)(c * 64 + 32 + (tid >> 4)) * EIN + 512 + h * 128 + (tid & 15) * 8);
    const uint4 lrq = *(const uint4*)(P0 + (size_t)(c * 64 + ((tid & 255) >> 2)) * EIN + 1536 + (tid & 3) * 8);
    const uint4 qq = *(const uint4*)(P0 + (size_t)(c * 64 + t) * EIN + h * 64 + k0);
    const uint4 kq = *(const uint4*)(P0 + (size_t)(c * 64 + t) * EIN + 256 + h * 64 + k0);
    const uint4 s0a0 = *(const uint4*)(GDS + (size_t)((h * 2 + 0) * NCH + c) * 8192 + tid * 8), s0a1 = *(const uint4*)(GDS + (size_t)((h * 2 + 0) * NCH + c) * 8192 + (tid + 512) * 8);
    const uint4 s0b0 = *(const uint4*)(GDS + (size_t)((h * 2 + 1) * NCH + c) * 8192 + tid * 8), s0b1 = *(const uint4*)(GDS + (size_t)((h * 2 + 1) * NCH + c) * 8192 + (tid + 512) * 8);
    const bf16_t* gp = P0 + (size_t)(c * 64 + t) * EIN + 1024 + h * 128 + (tid & 7) * 16;
    const uint4 gq0 = *(const uint4*)gp, gq1 = *(const uint4*)(gp + 8);
    __syncthreads();
    *(uint4*)(Vs + (tid >> 4) * 136 + (tid & 15) * 8) = vq0; *(uint4*)(Vs + (32 + (tid >> 4)) * 136 + (tid & 15) * 8) = vq1;
    if (tid < 256) { float* d = sLR2 + ((tid & 3) >> 1) * 1024 + (tid >> 2) * 16 + (tid & 1) * 8; st4(d, make_float4(bflo(lrq.x), bfhi(lrq.x), bflo(lrq.y), bfhi(lrq.y))); st4(d + 4, make_float4(bflo(lrq.z), bfhi(lrq.z), bflo(lrq.w), bfhi(lrq.w))); }
    __syncthreads();
#pragma unroll
    for (int dir = 0; dir < 2; ++dir) {
        gla_decay_core(sLR2 + dir * 1024, sm + GLC_OFF + dir * 1024, sm + GLC_OFF + 2048 + dir * 64, sBC, sTot, dir, tid);
        {
            float qv[8], kv[8];
            unpack8(qq, qv); unpack8(kq, kv);
#pragma unroll
            for (int j = 0; j < 8; ++j) { const float bc = sBC[t * 65 + k0 + j]; qv[j] *= 0.125f * fexp(bc); kv[j] *= fexp(-bc); }
            *(uint4*)(qt + t * 72 + k0) = make_uint4(pack2bf(qv[0], qv[1]), pack2bf(qv[2], qv[3]), pack2bf(qv[4], qv[5]), pack2bf(qv[6], qv[7]));
            *(uint4*)(kt + t * 72 + k0) = make_uint4(pack2bf(kv[0], kv[1]), pack2bf(kv[2], kv[3]), pack2bf(kv[4], kv[5]), pack2bf(kv[6], kv[7]));
            *(uint4*)(S0s + (tid >> 4) * 136 + (tid & 15) * 8) = dir ? s0b0 : s0a0;
            *(uint4*)(S0s + ((tid + 512) >> 4) * 136 + (tid & 15) * 8) = dir ? s0b1 : s0a1;
        }
        __syncthreads();
        {
            const int si = wave & 3;
#pragma unroll
            for (int jj = 0; jj < 2; ++jj) {
                const int t2 = (wave >> 2) * 2 + jj;
                f32x4 a = (f32x4){0.f, 0.f, 0.f, 0.f};
#pragma unroll
                for (int ks = 0; ks < 2; ++ks) a = __builtin_amdgcn_mfma_f32_16x16x32_bf16(row_frag(kt, 72, si * 16, ks * 32, lane), row_frag(qt, 72, t2 * 16, ks * 32, lane), a, 0, 0, 0);
                const int tq = t2 * 16 + (lane & 15), s0 = si * 16 + (lane >> 4) * 4;
                float m[4];
#pragma unroll
                for (int r = 0; r < 4; ++r) { const bool keep = dir ? (s0 + r >= tq) : (s0 + r <= tq); m[r] = keep ? a[r] : 0.f; }
                *(uint2*)(Sm + tq * 72 + s0) = make_uint2(pack2bf(m[0], m[1]), pack2bf(m[2], m[3]));
            }
        }
        __syncthreads();
#pragma unroll
        for (int ks = 0; ks < 2; ++ks) {
            const bf16x8 a1 = row_frag(qt, 72, ti * 16, ks * 32, lane), a2 = row_frag(Sm, 72, ti * 16, ks * 32, lane);
#pragma unroll
            for (int j = 0; j < 4; ++j) {
                acc[j] = __builtin_amdgcn_mfma_f32_16x16x32_bf16(a1, tr_frag(S0s, 136, ks * 32, (vt0 + j) * 16, lane), acc[j], 0, 0, 0);
                acc[j] = __builtin_amdgcn_mfma_f32_16x16x32_bf16(a2, tr_frag(Vs, 136, ks * 32, (vt0 + j) * 16, lane), acc[j], 0, 0, 0);
            }
        }
        if (dir == 0) __syncthreads();
    }
#pragma unroll
    for (int j = 0; j < 4; ++j)
#pragma unroll
        for (int r = 0; r < 4; ++r) O[(ti * 16 + (lane >> 4) * 4 + r) * 132 + (vt0 + j) * 16 + (lane & 15)] = acc[j][r];
    __syncthreads();
    {
        const int v0 = (tid & 7) * 16;
        float o[16];
        float ss = 0.f;
#pragma unroll
        for (int i = 0; i < 16; ++i) { o[i] = O[t * 132 + v0 + i]; ss += o[i] * o[i]; }
        ss = red8_sum(ss);
        const float rms = rsqrtf(ss * (1.f / 128.f) + 1e-5f);
        float g[16];
        unpack8(gq0, g); unpack8(gq1, g + 8);
        float y[16];
#pragma unroll
        for (int i = 0; i < 16; ++i) y[i] = o[i] * rms * ng[v0 + i] * silu_f(g[i]);
        bf16_t* yp = YC + (size_t)(c * 64 + t) * 1024 + h * 128 + v0;
        *(uint4*)yp = make_uint4(pack2bf(y[0], y[1]), pack2bf(y[2], y[3]), pack2bf(y[4], y[5]), pack2bf(y[6], y[7]));
        *(uint4*)(yp + 8) = make_uint4(pack2bf(y[8], y[9]), pack2bf(y[10], y[11]), pack2bf(y[12], y[13]), pack2bf(y[14], y[15]));
    }
}

DEV void load8bf(const bf16_t* ptr, float* f) { unpack8(*(const uint4*)ptr, f); }
struct RwNb { int sL, sR, sU, sD; bool vL, vR, vU, vD; };
DEV RwNb rw_nb(int s) {
    RwNb q; q.vU = false; q.vD = false;
    if (s < NCX) { q.vL = s > 0; q.vR = s < NCX - 1; }
    else { const int n = s - NCX, rr = n >> 6, cc = n & 63; q.vL = cc > 0; q.vR = cc < 63; q.vU = rr > 0; q.vD = rr < 127; }
    q.sL = q.vL ? s - 1 : s; q.sR = q.vR ? s + 1 : s; q.sU = q.vU ? s - 64 : s; q.sD = q.vD ? s + 64 : s;
    return q;
}
struct RwRaw { uint4 o, l, r, u, d; };
DEV RwRaw rw_load(const bf16_t* P0, int s, const RwNb& q, int cb) {
    RwRaw w;
    w.o = *(const uint4*)(P0 + (size_t)s * EIN + RW0 + cb); w.l = *(const uint4*)(P0 + (size_t)q.sL * EIN + RW0 + cb); w.r = *(const uint4*)(P0 + (size_t)q.sR * EIN + RW0 + cb);
    w.u = *(const uint4*)(P0 + (size_t)q.sU * EIN + RW0 + cb); w.d = *(const uint4*)(P0 + (size_t)q.sD * EIN + RW0 + cb);
    return w;
}
DEV void rw_comb_l(const RwRaw& w, const RwNb& q, const float* ml, float* out) {
    float own[8]; unpack8(w.o, own);
    const float nb[8] = {q.vL ? bflo(w.l.x) : 0.f, q.vR ? bfhi(w.r.x) : 0.f, q.vU ? bflo(w.u.y) : 0.f, q.vD ? bfhi(w.d.y) : 0.f,
                         q.vL ? bflo(w.l.z) : 0.f, q.vR ? bfhi(w.r.z) : 0.f, q.vU ? bflo(w.u.w) : 0.f, q.vD ? bfhi(w.d.w) : 0.f};
    const float4 m0 = *(const float4*)ml, m1 = *(const float4*)(ml + 4);
    const float m[8] = {m0.x, m0.y, m0.z, m0.w, m1.x, m1.y, m1.z, m1.w};
#pragma unroll
    for (int i = 0; i < 8; ++i) out[i] = own[i] + (nb[i] - own[i]) * m[i];
}
DEV void rw_comb(const RwRaw& w, const RwNb& q, const float* __restrict__ mu, int cb, float* out) {
    float own[8]; unpack8(w.o, own);
    const float nb[8] = {q.vL ? bflo(w.l.x) : 0.f, q.vR ? bfhi(w.r.x) : 0.f, q.vU ? bflo(w.u.y) : 0.f, q.vD ? bfhi(w.d.y) : 0.f,
                         q.vL ? bflo(w.l.z) : 0.f, q.vR ? bfhi(w.r.z) : 0.f, q.vU ? bflo(w.u.w) : 0.f, q.vD ? bfhi(w.d.w) : 0.f};
    const float4 m0 = ld4(mu + cb), m1 = ld4(mu + cb + 4);
    const float m[8] = {m0.x, m0.y, m0.z, m0.w, m1.x, m1.y, m1.z, m1.w};
#pragma unroll
    for (int i = 0; i < 8; ++i) out[i] = own[i] + (nb[i] - own[i]) * m[i];
}
DEV uint4 pack8(const float* f) { return make_uint4(pack2bf(f[0], f[1]), pack2bf(f[2], f[3]), pack2bf(f[4], f[5]), pack2bf(f[6], f[7])); }

template <int XM, int YM, class F>
DEV void mm64(const bf16_t* X, const bf16_t* Y, F f, int lane, int wave) {
#pragma unroll
    for (int q = 0; q < 2; ++q) {
        const int idx = wave * 2 + q, ti = idx >> 2, tj = idx & 3;
        f32x4 acc = (f32x4){0.f, 0.f, 0.f, 0.f};
#pragma unroll
        for (int ks = 0; ks < 2; ++ks) {
            const bf16x8 a = XM == 0 ? row_frag(X, 72, ti * 16, ks * 32, lane) : tr_frag(X, 72, ks * 32, ti * 16, lane);
            const bf16x8 bq = YM == 0 ? row_frag(Y, 72, tj * 16, ks * 32, lane) : tr_frag(Y, 72, ks * 32, tj * 16, lane);
            acc = __builtin_amdgcn_mfma_f32_16x16x32_bf16(a, bq, acc, 0, 0, 0);
        }
        f(ti * 16 + (lane >> 4) * 4, tj * 16 + (lane & 15), acc);
    }
}
template <int XM, int YM, class F>
DEV void mm64x2(const bf16_t* X1, const bf16_t* Y1, const bf16_t* X2, const bf16_t* Y2, F f, int lane, int wave) {
#pragma unroll
    for (int q = 0; q < 2; ++q) {
        const int idx = wave * 2 + q, ti = idx >> 2, tj = idx & 3;
        f32x4 acc = (f32x4){0.f, 0.f, 0.f, 0.f};
#pragma unroll
        for (int ks = 0; ks < 2; ++ks) {
            const bf16x8 a = XM == 0 ? row_frag(X1, 72, ti * 16, ks * 32, lane) : tr_frag(X1, 72, ks * 32, ti * 16, lane);
            const bf16x8 bq = YM == 0 ? row_frag(Y1, 72, tj * 16, ks * 32, lane) : tr_frag(Y1, 72, ks * 32, tj * 16, lane);
            acc = __builtin_amdgcn_mfma_f32_16x16x32_bf16(a, bq, acc, 0, 0, 0);
            const bf16x8 a2 = XM == 0 ? row_frag(X2, 72, ti * 16, ks * 32, lane) : tr_frag(X2, 72, ks * 32, ti * 16, lane);
            const bf16x8 b2 = YM == 0 ? row_frag(Y2, 72, tj * 16, ks * 32, lane) : tr_frag(Y2, 72, ks * 32, tj * 16, lane);
            acc = __builtin_amdgcn_mfma_f32_16x16x32_bf16(a2, b2, acc, 0, 0, 0);
        }
        f(ti * 16 + (lane >> 4) * 4, tj * 16 + (lane & 15), acc);
    }
}
DEV void st_img(bf16_t* P, int i0, int j, float a0, float a1, float a2, float a3) {
    P[(i0 + 0) * 72 + j] = __builtin_bit_cast(unsigned short, (__bf16)a0); P[(i0 + 1) * 72 + j] = __builtin_bit_cast(unsigned short, (__bf16)a1);
    P[(i0 + 2) * 72 + j] = __builtin_bit_cast(unsigned short, (__bf16)a2); P[(i0 + 3) * 72 + j] = __builtin_bit_cast(unsigned short, (__bf16)a3);
}

struct RwRaw3 { uint4 o, u, d; };
DEV RwRaw3 rw_load3(const bf16_t* P0, int s, const RwNb& q, int cb) {
    RwRaw3 w;
    w.o = *(const uint4*)(P0 + (size_t)s * EIN + RW0 + cb); w.u = *(const uint4*)(P0 + (size_t)q.sU * EIN + RW0 + cb); w.d = *(const uint4*)(P0 + (size_t)q.sD * EIN + RW0 + cb);
    return w;
}
DEV void rw_comb3(const RwRaw3& w, const RwNb& q, const bf16_t* tile, const bf16_t* P0, int s, int t, int cb, int j0, const float* ml, float* out) {
    float own[8]; unpack8(w.o, own);
    const int tl = t > 0 ? t - 1 : 0, tr = t < 63 ? t + 1 : 63;
    float l0 = bf2f(tile[tl * 72 + j0]), l4 = bf2f(tile[tl * 72 + j0 + 4]), r1 = bf2f(tile[tr * 72 + j0 + 1]), r5 = bf2f(tile[tr * 72 + j0 + 5]);
    const bool inL = q.vL && t > 0, inR = q.vR && t < 63;
    l0 = inL ? l0 : 0.f; l4 = inL ? l4 : 0.f; r1 = inR ? r1 : 0.f; r5 = inR ? r5 : 0.f;
    if (s - t < NCX) {
        if (q.vL && t == 0) { const bf16_t* g = P0 + (size_t)(s - 1) * EIN + RW0 + cb; l0 = bf2f(g[0]); l4 = bf2f(g[4]); }
        if (q.vR && t == 63) { const bf16_t* g = P0 + (size_t)(s + 1) * EIN + RW0 + cb; r1 = bf2f(g[1]); r5 = bf2f(g[5]); }
    }
    const float nb[8] = {l0, r1, q.vU ? bflo(w.u.y) : 0.f, q.vD ? bfhi(w.d.y) : 0.f, l4, r5, q.vU ? bflo(w.u.w) : 0.f, q.vD ? bfhi(w.d.w) : 0.f};
    const float4 m0 = *(const float4*)ml, m1 = *(const float4*)(ml + 4);
    const float m[8] = {m0.x, m0.y, m0.z, m0.w, m1.x, m1.y, m1.z, m1.w};
#pragma unroll
    for (int i = 0; i < 8; ++i) out[i] = own[i] + (nb[i] - own[i]) * m[i];
}
template <int XM, int YM, class F>
DEV void mm64t(const bf16_t* X, const bf16_t* Y, F f, int lane, int wave) {
#pragma unroll
    for (int q = 0; q < 2; ++q) {
        const int idx = wave * 2 + q, ti = idx >> 2, tj = idx & 3;
        f32x4 acc = (f32x4){0.f, 0.f, 0.f, 0.f};
#pragma unroll
        for (int ks = 0; ks < 2; ++ks) {
            const bf16x8 a = XM == 0 ? row_frag(X, 72, ti * 16, ks * 32, lane) : tr_frag(X, 72, ks * 32, ti * 16, lane);
            const bf16x8 bq = YM == 0 ? row_frag(Y, 72, tj * 16, ks * 32, lane) : tr_frag(Y, 72, ks * 32, tj * 16, lane);
            acc = __builtin_amdgcn_mfma_f32_16x16x32_bf16(bq, a, acc, 0, 0, 0);
        }
        f(ti * 16 + (lane & 15), tj * 16 + (lane >> 4) * 4, acc);
    }
}
DEV void st_row(bf16_t* P, int i, int j0, float a0, float a1, float a2, float a3) { *(uint2*)(P + i * 72 + j0) = make_uint2(pack2bf(a0, a1), pack2bf(a2, a3)); }
struct R1Tile { uint4 r, k, v, w, a; };
struct R1Raw { R1Tile pr, cu, nx; float4 qw0, qw1, qa0, qa1; };
DEV R1Tile r1_tile(const Params& p, int h, int dir, int c) {
    const int tid = opaque_tid();
    const bf16_t* P0 = (const bf16_t*)(p.ws + OFF_P0);
    const int cc = c < 0 ? 0 : (c > NCH - 1 ? NCH - 1 : c), t = tid >> 3, j0 = (tid & 7) * 8;
    const bf16_t* row = P0 + (size_t)(cc * 64 + t) * EIN + RW0 + j0;
    R1Tile T;
    T.r = *(const uint4*)(row + h * 64); T.k = *(const uint4*)(row + 512 + h * 64); T.v = *(const uint4*)(row + 1024 + h * 64);
    T.w = *(const uint4*)(row + 2048 + dir * 64); T.a = *(const uint4*)(row + 2176 + dir * 64);
    return T;
}
DEV void r1_consts(const Params& p, int h, int dir, float* sm) {
    const int tid = opaque_tid();
    float* sv = (float*)((bf16_t*)sm + 14 * 4608);
    __syncthreads();
    if (tid < 64) { const int hc = h * 64 + tid; sv[64 + tid] = p.in[dir ? 18 : 16][hc]; sv[128 + tid] = p.in[dir ? 22 : 20][hc]; sv[192 + tid] = p.in[24][hc]; sv[256 + tid] = p.in[25][hc]; sv[320 + tid] = p.in[26][hc]; }
    if (tid < 320) { const int tn = tid >> 6, col = tid & 63; const int cb = tn < 3 ? tn * 512 + h * 64 : (tn == 3 ? 2048 + dir * 64 : 2176 + dir * 64); sv[384 + tid] = p.in[15][cb + col]; }
}
DEV void r1_load(const Params& p, int h, int dir, int c, R1Raw& R) {
    const int tid = opaque_tid();
    const float* ww2 = p.in[dir ? 19 : 17]; const float* wa2 = p.in[dir ? 23 : 21];
    const int t = tid >> 3, j0 = (tid & 7) * 8;
    R.pr = r1_tile(p, h, dir, c - 1); R.cu = r1_tile(p, h, dir, c); R.nx = r1_tile(p, h, dir, c + 1);
    R.qw0 = ld4(ww2 + (size_t)t * 512 + h * 64 + j0); R.qw1 = ld4(ww2 + (size_t)t * 512 + h * 64 + j0 + 4);
    R.qa0 = ld4(wa2 + (size_t)t * 512 + h * 64 + j0); R.qa1 = ld4(wa2 + (size_t)t * 512 + h * 64 + j0 + 4);
}
DEV void rwkv1_unit(const Params& p, int h, int dir, int c, float* sm, R1Raw& R, int cnext) {
    const int tid = opaque_tid(), lane = tid & 63, wave = tid >> 6;
    bf16_t* RU = (bf16_t*)(p.ws + OFF_RU) + (size_t)((h * 2 + dir) * NCH + c) * 16384;
    float* BONS = (float*)(p.ws + OFF_BONS);
    bf16_t* img = (bf16_t*)sm;
#define SLOT(i_) (img + (i_) * 4608)
    float* fLW = (float*)SLOT(10);
    float* fAS = (float*)SLOT(12);
    float* sv = (float*)SLOT(14);
    const int t = tid >> 3, j0 = (tid & 7) * 8, s = c * 64 + t;
    const bf16_t* P0 = (const bf16_t*)(p.ws + OFF_P0);
    __syncthreads();
    *(uint4*)(SLOT(0) + t * 72 + j0) = R.cu.r; *(uint4*)(SLOT(1) + t * 72 + j0) = R.cu.k; *(uint4*)(SLOT(2) + t * 72 + j0) = R.cu.v;
    *(uint4*)(SLOT(3) + t * 72 + j0) = R.cu.w; *(uint4*)(SLOT(4) + t * 72 + j0) = R.cu.a;
    __syncthreads();
    float r8[8], k8[8], v8[8];
    {
        float x8[8];
        const RwNb nbq = rw_nb(s);
        rw_comb3(RwRaw3{R.cu.r, R.pr.r, R.nx.r}, nbq, SLOT(0), P0, s, t, h * 64 + j0, j0, sv + 384 + j0, r8);
        rw_comb3(RwRaw3{R.cu.k, R.pr.k, R.nx.k}, nbq, SLOT(1), P0, s, t, 512 + h * 64 + j0, j0, sv + 448 + j0, k8);
        rw_comb3(RwRaw3{R.cu.v, R.pr.v, R.nx.v}, nbq, SLOT(2), P0, s, t, 1024 + h * 64 + j0, j0, sv + 512 + j0, v8);
        rw_comb3(RwRaw3{R.cu.w, R.pr.w, R.nx.w}, nbq, SLOT(3), P0, s, t, 2048 + dir * 64 + j0, j0, sv + 576 + j0, x8);
#pragma unroll
        for (int i = 0; i < 8; ++i) x8[i] = tanh_f(x8[i]);
        *(uint4*)(SLOT(6) + t * 72 + j0) = pack8(x8);
        rw_comb3(RwRaw3{R.cu.a, R.pr.a, R.nx.a}, nbq, SLOT(4), P0, s, t, 2176 + dir * 64 + j0, j0, sv + 640 + j0, x8);
        *(uint4*)(SLOT(7) + t * 72 + j0) = pack8(x8);
        { const float wq[8] = {R.qw0.x, R.qw0.y, R.qw0.z, R.qw0.w, R.qw1.x, R.qw1.y, R.qw1.z, R.qw1.w}; *(uint4*)(SLOT(8) + t * 72 + j0) = pack8(wq); }
        { const float wq[8] = {R.qa0.x, R.qa0.y, R.qa0.z, R.qa0.w, R.qa1.x, R.qa1.y, R.qa1.z, R.qa1.w}; *(uint4*)(SLOT(9) + t * 72 + j0) = pack8(wq); }
    }
    R.pr = R.cu; R.cu = R.nx; R.nx = r1_tile(p, h, dir, cnext);
    __syncthreads();
    mm64t<0, 1>(SLOT(6), SLOT(8), [=](int i, int jq, f32x4 a) {
        const float4 b4 = ld4(sv + 64 + jq);
        st4(fLW + i * 68 + jq, make_float4(-0.6065306597f * sigmoid_f(b4.x + a[0]), -0.6065306597f * sigmoid_f(b4.y + a[1]), -0.6065306597f * sigmoid_f(b4.z + a[2]), -0.6065306597f * sigmoid_f(b4.w + a[3]))); }, lane, wave);
    mm64t<0, 1>(SLOT(7), SLOT(9), [=](int i, int jq, f32x4 a) {
        const float4 b4 = ld4(sv + 128 + jq);
        st4(fAS + i * 68 + jq, make_float4(sigmoid_f(b4.x + a[0]), sigmoid_f(b4.y + a[1]), sigmoid_f(b4.z + a[2]), sigmoid_f(b4.w + a[3]))); }, lane, wave);
    __syncthreads();
#pragma unroll
    for (int j = 0; j < 8; ++j) {
        const int k = wave * 8 + j;
        const float v = wave_scan_add(fLW[lane * 68 + k], lane, dir);
        fLW[lane * 68 + k] = v;
        if (lane == (dir ? 0 : 63)) sv[k] = v;
    }
    __syncthreads();
    {
        float kkv[8], ss = 0.f;
#pragma unroll
        for (int i = 0; i < 8; ++i) { kkv[i] = k8[i] * sv[192 + j0 + i]; ss += kkv[i] * kkv[i]; }
        ss = red8_sum(ss);
        const float rn = rsqrtf(fmaxf(ss, 1e-24f));
        float fa[8], fb[8], fk[8], fr[8], fbp[8], fkp[8], bon = 0.f;
        const int tp = dir ? t + 1 : t - 1;
        const bool hasp = dir ? (t < 63) : (t > 0);
        const int tpc = hasp ? tp : t;
        float Bt8[8], Bx8[8], as8[8];
        { const float4 q0 = ld4(fLW + t * 68 + j0), q1 = ld4(fLW + t * 68 + j0 + 4), x0 = ld4(fLW + tpc * 68 + j0), x1 = ld4(fLW + tpc * 68 + j0 + 4), s0 = ld4(fAS + t * 68 + j0), s1 = ld4(fAS + t * 68 + j0 + 4);
          Bt8[0] = q0.x; Bt8[1] = q0.y; Bt8[2] = q0.z; Bt8[3] = q0.w; Bt8[4] = q1.x; Bt8[5] = q1.y; Bt8[6] = q1.z; Bt8[7] = q1.w;
          Bx8[0] = x0.x; Bx8[1] = x0.y; Bx8[2] = x0.z; Bx8[3] = x0.w; Bx8[4] = x1.x; Bx8[5] = x1.y; Bx8[6] = x1.z; Bx8[7] = x1.w;
          as8[0] = s0.x; as8[1] = s0.y; as8[2] = s0.z; as8[3] = s0.w; as8[4] = s1.x; as8[5] = s1.y; as8[6] = s1.z; as8[7] = s1.w; }
#pragma unroll
        for (int i = 0; i < 8; ++i) {
            const int k = j0 + i;
            const float Bt = Bt8[i], Bx = hasp ? Bx8[i] : 0.f, asg = as8[i];
            const float kk = kkv[i] * rn, kh = k8[i] * (1.f + (asg - 1.f) * sv[256 + k]);
            bon += r8[i] * kh * sv[320 + k];
            const float enB = fexp(-Bt), eLB = fexp(sv[k] - Bt), bv = kk * asg;
            fa[i] = -kk * fexp(Bx); fb[i] = bv * enB; fk[i] = kh * enB; fr[i] = r8[i] * fexp(Bt); fbp[i] = bv * eLB; fkp[i] = kh * eLB;
        }
        bon = red8_sum(bon);
        if ((tid & 7) == 0) BONS[((size_t)dir * TB + s) * 8 + h] = bon;
        *(uint4*)(SLOT(0) + t * 72 + j0) = pack8(fa); *(uint4*)(SLOT(1) + t * 72 + j0) = pack8(fb); *(uint4*)(SLOT(2) + t * 72 + j0) = pack8(fk);
        *(uint4*)(SLOT(3) + t * 72 + j0) = pack8(fr); *(uint4*)(SLOT(4) + t * 72 + j0) = pack8(fbp); *(uint4*)(SLOT(5) + t * 72 + j0) = pack8(fkp);
    }
    __syncthreads();
    *(uint4*)(SLOT(6) + t * 72 + j0) = pack8(v8);
    __syncthreads();
    mm64t<0, 0>(SLOT(0), SLOT(1), [=](int i, int j0, f32x4 a) {
        float m[4];
#pragma unroll
        for (int r = 0; r < 4; ++r) { const bool keep = dir ? (j0 + r > i) : (j0 + r < i); m[r] = keep ? a[r] : 0.f; }
        const bool dg = (i >> 4) == (j0 >> 4);
        st_row(SLOT(7), i, j0, dg ? m[0] : 0.f, dg ? m[1] : 0.f, dg ? m[2] : 0.f, dg ? m[3] : 0.f);
        st_row(SLOT(8), i, j0, (dg ? m[0] : 0.f) + (j0 == i ? 1.f : 0.f), (dg ? m[1] : 0.f) + (j0 + 1 == i ? 1.f : 0.f), (dg ? m[2] : 0.f) + (j0 + 2 == i ? 1.f : 0.f), (dg ? m[3] : 0.f) + (j0 + 3 == i ? 1.f : 0.f));
        st_row(SLOT(12), i, j0, dg ? 0.f : m[0], dg ? 0.f : m[1], dg ? 0.f : m[2], dg ? 0.f : m[3]); }, lane, wave);
    mm64t<0, 0>(SLOT(0), SLOT(2), [=](int i, int j0, f32x4 a) {
        float m[4];
#pragma unroll
        for (int r = 0; r < 4; ++r) { const bool keep = dir ? (j0 + r > i) : (j0 + r < i); m[r] = keep ? a[r] : 0.f; }
        st_row(SLOT(9), i, j0, m[0], m[1], m[2], m[3]); }, lane, wave);
    mm64t<0, 0>(SLOT(3), SLOT(1), [=](int i, int j0, f32x4 a) {
        float m[4];
#pragma unroll
        for (int r = 0; r < 4; ++r) { const bool keep = dir ? (j0 + r >= i) : (j0 + r <= i); m[r] = keep ? a[r] : 0.f; }
        st_row(SLOT(10), i, j0, m[0], m[1], m[2], m[3]); }, lane, wave);
    mm64t<0, 0>(SLOT(3), SLOT(2), [=](int i, int j0, f32x4 a) {
        float m[4];
#pragma unroll
        for (int r = 0; r < 4; ++r) { const bool keep = dir ? (j0 + r >= i) : (j0 + r <= i); m[r] = keep ? a[r] : 0.f; }
        st_row(SLOT(11), i, j0, m[0], m[1], m[2], m[3]); }, lane, wave);
    __syncthreads();
#define R1_TADD(dst_, told_) [=](int i, int j0, f32x4 a) { const uint2 tt = *(const uint2*)((told_) + i * 72 + j0); \
        st_row((dst_), i, j0, a[0] + bflo(tt.x), a[1] + bfhi(tt.x), a[2] + bflo(tt.y), a[3] + bfhi(tt.y)); }
    mm64t<0, 1>(SLOT(7), SLOT(7), [=](int i, int j0, f32x4 a) { st_row(SLOT(1), i, j0, a[0], a[1], a[2], a[3]); }, lane, wave);
    mm64t<0, 1>(SLOT(9), SLOT(6), [=](int i, int j0, f32x4 a) { st_row(SLOT(13), i, j0, a[0], a[1], a[2], a[3]); }, lane, wave);
    __syncthreads();
    mm64t<0, 1>(SLOT(1), SLOT(1), [=](int i, int j0, f32x4 a) { st_row(SLOT(7), i, j0, a[0], a[1], a[2], a[3]); }, lane, wave);
    mm64t<0, 1>(SLOT(8), SLOT(1), R1_TADD(SLOT(2), SLOT(8)), lane, wave);
    __syncthreads();
    mm64t<0, 1>(SLOT(7), SLOT(7), [=](int i, int j0, f32x4 a) { st_row(SLOT(1), i, j0, a[0], a[1], a[2], a[3]); }, lane, wave);
    mm64t<0, 1>(SLOT(2), SLOT(7), R1_TADD(SLOT(8), SLOT(2)), lane, wave);
    __syncthreads();
    mm64t<0, 1>(SLOT(8), SLOT(1), R1_TADD(SLOT(2), SLOT(8)), lane, wave);
    __syncthreads();
#undef R1_TADD
    mm64t<0, 1>(SLOT(2), SLOT(12), [=](int i, int j0, f32x4 a) { st_row(SLOT(7), i, j0, a[0], a[1], a[2], a[3]); }, lane, wave);
    mm64t<0, 1>(SLOT(2), SLOT(0), [=](int i, int j0, f32x4 a) { st_row(SLOT(1), i, j0, a[0], a[1], a[2], a[3]); }, lane, wave);
    mm64t<0, 1>(SLOT(2), SLOT(13), [=](int i, int j0, f32x4 a) { st_row(SLOT(8), i, j0, a[0], a[1], a[2], a[3]); }, lane, wave);
    __syncthreads();
    {
        const bf16_t* Zp = (wave < 4) ? SLOT(1) : SLOT(8);
        bf16_t* Xi = (wave < 4) ? SLOT(12) : SLOT(9);
        const int ct = (wave & 3) * 16, g4 = (lane >> 4) * 4, l15 = lane & 15;
#pragma unroll
        for (int bs = 0; bs < 4; ++bs) {
            const int bi = dir ? 3 - bs : bs;
            const uint2 zz = *(const uint2*)(Zp + (bi * 16 + l15) * 72 + ct + g4);
            f32x4 acc = (f32x4){bflo(zz.x), bfhi(zz.x), bflo(zz.y), bfhi(zz.y)};
            const bool k0 = dir ? (bi == 0) : (bi >= 1), k1 = dir ? (bi <= 2) : (bi == 3);
            if (k0) acc = __builtin_amdgcn_mfma_f32_16x16x32_bf16(tr_frag(Xi, 72, 0, ct, lane), row_frag(SLOT(7), 72, bi * 16, 0, lane), acc, 0, 0, 0);
            if (k1) acc = __builtin_amdgcn_mfma_f32_16x16x32_bf16(tr_frag(Xi, 72, 32, ct, lane), row_frag(SLOT(7), 72, bi * 16, 32, lane), acc, 0, 0, 0);
            st_row(Xi, bi * 16 + l15, ct + g4, acc[0], acc[1], acc[2], acc[3]);
            __syncthreads();
        }
    }
    mm64<1, 1>(SLOT(12), SLOT(4), [=](int i0, int j, f32x4 a) {
        float m[4];
#pragma unroll
        for (int r = 0; r < 4; ++r) m[r] = a[r] + ((i0 + r) == j ? fexp(sv[j]) : 0.f);
        *(uint2*)(RU + j * 64 + i0) = make_uint2(pack2bf(m[0], m[1]), pack2bf(m[2], m[3])); }, lane, wave);
    mm64x2<1, 1>(SLOT(4), SLOT(9), SLOT(5), SLOT(6), [=](int i0, int j, f32x4 a) {
        *(uint2*)(RU + 4096 + j * 64 + i0) = make_uint2(pack2bf(a[0], a[1]), pack2bf(a[2], a[3])); }, lane, wave);
    mm64<1, 0>(SLOT(12), SLOT(10), [=](int i0, int j, f32x4 a) {
        const uint2 rr = *(const uint2*)(SLOT(3) + j * 72 + i0);
        *(uint2*)(RU + 8192 + j * 64 + i0) = make_uint2(pack2bf(a[0] + bflo(rr.x), a[1] + bfhi(rr.x)), pack2bf(a[2] + bflo(rr.y), a[3] + bfhi(rr.y))); }, lane, wave);
    mm64x2<0, 1>(SLOT(10), SLOT(9), SLOT(11), SLOT(6), [=](int i0, int j, f32x4 a) {
        *(uint2*)(RU + 12288 + j * 64 + i0) = make_uint2(pack2bf(a[0], a[1]), pack2bf(a[2], a[3])); }, lane, wave);
#undef SLOT
}

struct R2Ops { bf16x8 a[2][2]; uint4 c01, c23; };
DEV bf16x8 r2_afrag(const char* sl, int i, int ks, int g, int l15) { const int row = i * 16 + l15; return *(const bf16x8*)(sl + row * 128 + (((ks * 4 + g) ^ ((row >> 1) & 7)) * 16)); }
DEV R2Ops r2_ops(const char* sl, int g, int l15) {
    R2Ops o;
#pragma unroll
    for (int i = 0; i < 2; ++i)
#pragma unroll
        for (int ks = 0; ks < 2; ++ks) o.a[i][ks] = r2_afrag(sl, i, ks, g, l15);
    o.c01 = *(const uint4*)(sl + 8192 + l15 * 128 + (((g * 2) ^ ((l15 >> 1) & 7)) * 16)); o.c23 = *(const uint4*)(sl + 8192 + l15 * 128 + (((g * 2 + 1) ^ ((l15 >> 1) & 7)) * 16));
    return o;
}
DEV void r2_compute(const char* buf, int rnd, int dir, int chain, int vblk, int g, int l15, f32x4 (&st)[4], bf16_t* S0G) {
    R2Ops nx = r2_ops(buf, g, l15);
#pragma unroll
    for (int s = 0; s < 6; ++s) {
        const char* sl = buf + s * 10240;
        const R2Ops cu = nx;
        bf16x8 a23[2][2];
#pragma unroll
        for (int i = 0; i < 2; ++i)
#pragma unroll
            for (int ks = 0; ks < 2; ++ks) a23[i][ks] = r2_afrag(sl, 2 + i, ks, g, l15);
        if (s + 1 < 6) nx = r2_ops(sl + 10240, g, l15);
        __builtin_amdgcn_sched_barrier(0);
        const int c = chunk_at(dir, rnd * 6 + s);
        unsigned pk[4][2];
#pragma unroll
        for (int i = 0; i < 4; ++i) { pk[i][0] = pack2bf(st[i][0], st[i][1]); pk[i][1] = pack2bf(st[i][2], st[i][3]);
            asm volatile("" : "+v"(pk[i][0]), "+v"(pk[i][1])); }
        bf16_t* sp = S0G + ((size_t)(chain * NCH + c) * 64 + vblk * 16 + l15) * 64 + g * 4;
#pragma unroll
        for (int i = 0; i < 4; ++i) *(uint2*)(sp + i * 16) = make_uint2(pk[i][0], pk[i][1]);
        bf16x8 bfr[2];
#pragma unroll
        for (int ks = 0; ks < 2; ++ks) { const uint4 u = make_uint4(pk[2 * ks][0], pk[2 * ks][1], pk[2 * ks + 1][0], pk[2 * ks + 1][1]); bfr[ks] = __builtin_bit_cast(bf16x8, u); }
        const unsigned cw[8] = {cu.c01.x, cu.c01.y, cu.c01.z, cu.c01.w, cu.c23.x, cu.c23.y, cu.c23.z, cu.c23.w};
#pragma unroll
        for (int i = 0; i < 4; ++i) {
            f32x4 acc = (f32x4){bflo(cw[2 * i]), bfhi(cw[2 * i]), bflo(cw[2 * i + 1]), bfhi(cw[2 * i + 1])};
#pragma unroll
            for (int ks = 0; ks < 2; ++ks) acc = __builtin_amdgcn_mfma_f32_16x16x32_bf16(i < 2 ? cu.a[i][ks] : a23[i - 2][ks], bfr[ks], acc, 0, 0, 0);
            st[i] = acc;
        }
        __builtin_amdgcn_sched_barrier(0);
    }
}
#define R2_RS 6
#define R2_NR (NCH / R2_RS)
#define R2_LOADX(X_, rnd_) do { const int r0_ = ((rnd_) < R2_NR ? (rnd_) : R2_NR - 1) * R2_RS; \
    _Pragma("unroll") for (int k_ = 0; k_ < 8; ++k_) { const int pm_ = lt + 384 * k_; \
        X_[k_] = *(const uint4*)(RU + (size_t)(chain * NCH + chunk_at(dir, r0_ + (pm_ >> 9))) * 16384 + (pm_ & 511) * 8); } \
    _Pragma("unroll") for (int j_ = 0; j_ < 2; ++j_) { const int pc_ = lt + 384 * j_; \
        X_[8 + j_] = *(const uint4*)(RU + (size_t)(chain * NCH + chunk_at(dir, r0_ + (pc_ >> 7))) * 16384 + 4096 + (vblk * 16 + ((pc_ >> 3) & 15)) * 64 + (pc_ & 7) * 8); } } while (0)
#define R2_STAGEX(X_, buf_) do { \
    _Pragma("unroll") for (int k_ = 0; k_ < 8; ++k_) { const int pm_ = lt + 384 * k_, row_ = (pm_ >> 3) & 63, c8_ = pm_ & 7, sw_ = (row_ >> 1) & 7, u0_ = (c8_ >> 2) * 4 + (c8_ & 1) * 2, eh_ = ((c8_ >> 1) & 1) * 8; \
        char* sl_ = (buf_) + (pm_ >> 9) * 10240 + row_ * 128 + eh_; const uint4 m_ = X_[k_]; \
        *(uint2*)(sl_ + ((u0_ ^ sw_) * 16)) = make_uint2(m_.x, m_.y); *(uint2*)(sl_ + (((u0_ + 1) ^ sw_) * 16)) = make_uint2(m_.z, m_.w); } \
    _Pragma("unroll") for (int j_ = 0; j_ < 2; ++j_) { const int pc_ = lt + 384 * j_, rw_ = (pc_ >> 3) & 15, q8_ = pc_ & 7, i_ = q8_ >> 1, g0_ = (q8_ & 1) * 2, sc_ = (rw_ >> 1) & 7; \
        char* sl_ = (buf_) + (pc_ >> 7) * 10240 + 8192 + rw_ * 128 + (i_ & 1) * 8; const uint4 m_ = X_[8 + j_]; \
        *(uint2*)(sl_ + (((g0_ * 2 + (i_ >> 1)) ^ sc_) * 16)) = make_uint2(m_.x, m_.y); *(uint2*)(sl_ + ((((g0_ + 1) * 2 + (i_ >> 1)) ^ sc_) * 16)) = make_uint2(m_.z, m_.w); } } while (0)
DEV void rwkv2_unit(const Params& p, int chain, int vblk, float* sm) {
    static_assert(R2_NR * R2_RS == NCH && (R2_NR & 1) == 0 && 2 * R2_RS * 10240 <= LDS_BYTES - 16 && R2_RS * 512 == 8 * 384 && R2_RS * 128 == 2 * 384, "R2 ring");
    const int tid = opaque_tid(), lane = tid & 63, wave = tid >> 6;
    const bf16_t* RU = (const bf16_t*)(p.ws + OFF_RU);
    bf16_t* S0G = (bf16_t*)(p.ws + OFF_RS0);
    char* ring = (char*)sm;
    char* ring1 = ring + R2_RS * 10240;
    const int dir = chain & 1, g = lane >> 4, l15 = lane & 15;
    const bool loader = wave >= 1 && wave <= 6;
    int lt = loader ? tid - 64 : 0;
    f32x4 st[4];
#pragma unroll
    for (int i = 0; i < 4; ++i) st[i] = (f32x4){0.f, 0.f, 0.f, 0.f};
    uint4 xa[10], xb[10];
    __syncthreads();
    if (loader) { R2_LOADX(xa, 0); R2_STAGEX(xa, ring); R2_LOADX(xa, 2); R2_LOADX(xb, 1); }
    __syncthreads();
#pragma unroll 1
    for (int rnd = 0; rnd < R2_NR; rnd += 2) {
        asm volatile("" : "+v"(lt));
        if (loader) { R2_STAGEX(xb, ring1); R2_LOADX(xb, rnd + 3); }
        else if (wave == 0) r2_compute(ring, rnd, dir, chain, vblk, g, l15, st, S0G);
        __syncthreads();
        asm volatile("" : "+v"(lt));
        if (loader) { R2_STAGEX(xa, ring); R2_LOADX(xa, rnd + 4); }
        else if (wave == 0) r2_compute(ring1, rnd + 1, dir, chain, vblk, g, l15, st, S0G);
        __syncthreads();
    }
}
#undef R2_LOADX
#undef R2_STAGEX
#undef R2_RS
#undef R2_NR

struct R3Tile { uint4 v, g; };
struct R3Raw { R3Tile pr, cu, nx; };
DEV R3Tile r3_tile(const Params& p, int h, int c) {
    const int tid = opaque_tid();
    const bf16_t* P0 = (const bf16_t*)(p.ws + OFF_P0);
    const int cc = c < 0 ? 0 : (c > NCH - 1 ? NCH - 1 : c);
    const bf16_t* row = P0 + (size_t)(cc * 64 + (tid >> 3)) * EIN + RW0 + h * 64 + (tid & 7) * 8;
    R3Tile T; T.v = *(const uint4*)(row + 1024); T.g = *(const uint4*)(row + 1536);
    return T;
}
DEV void rwkv3_unit(const Params& p, int h, int c, float* sm, R3Raw& R) {
    const int tid = opaque_tid(), lane = tid & 63, wave = tid >> 6;
    const bf16_t* P0 = (const bf16_t*)(p.ws + OFF_P0);
    const bf16_t* RUb = (const bf16_t*)(p.ws + OFF_RU);
    const bf16_t* S0G = (const bf16_t*)(p.ws + OFF_RS0);
    const float* BONS = (const float*)(p.ws + OFF_BONS);
    bf16_t* YC = (bf16_t*)(p.ws + OFF_YC);
    const float* mu = p.in[15]; const float* gn_g = p.in[27]; const float* gn_b = p.in[28];
    bf16_t* img = (bf16_t*)sm;
    float* O = sm + 4 * 2304;
    const int t = tid >> 3, v0 = (tid & 7) * 8, s = c * 64 + t;
    const size_t u0 = (size_t)((h * 2 + 0) * NCH + c), u1 = (size_t)((h * 2 + 1) * NCH + c);
    const uint4 gr0 = *(const uint4*)(RUb + u0 * 16384 + 8192 + t * 64 + v0), gs0 = *(const uint4*)(S0G + u0 * 4096 + t * 64 + v0);
    const uint4 gr1 = *(const uint4*)(RUb + u1 * 16384 + 8192 + t * 64 + v0), gs1 = *(const uint4*)(S0G + u1 * 4096 + t * 64 + v0);
    uint2 yl[2][2];
#pragma unroll
    for (int q = 0; q < 2; ++q) { const int idx = wave * 2 + q, ti = idx >> 2, tj = idx & 3;
        yl[q][0] = *(const uint2*)(RUb + u0 * 16384 + 12288 + (tj * 16 + (lane & 15)) * 64 + ti * 16 + (lane >> 4) * 4);
        yl[q][1] = *(const uint2*)(RUb + u1 * 16384 + 12288 + (tj * 16 + (lane & 15)) * 64 + ti * 16 + (lane >> 4) * 4); }
    const RwNb nbq = rw_nb(s);
    const float bon = BONS[(size_t)s * 8 + h] + BONS[((size_t)TB + s) * 8 + h];
    bf16_t* tileV = img + 4 * 4608 + 64 * 68 * 2;
    bf16_t* tileG = tileV + 4608;
    __syncthreads();
    *(uint4*)(img + 0 * 4608 + t * 72 + v0) = gr0; *(uint4*)(img + 2 * 4608 + t * 72 + v0) = gs0;
    *(uint4*)(img + 1 * 4608 + t * 72 + v0) = gr1; *(uint4*)(img + 3 * 4608 + t * 72 + v0) = gs1;
    *(uint4*)(tileV + t * 72 + v0) = R.cu.v; *(uint4*)(tileG + t * 72 + v0) = R.cu.g;
    __syncthreads();
#pragma unroll
    for (int q = 0; q < 2; ++q) {
        const int idx = wave * 2 + q, ti = idx >> 2, tj = idx & 3;
        f32x4 accd[2];
#pragma unroll
        for (int dir = 0; dir < 2; ++dir) {
            f32x4 acc = (f32x4){bflo(yl[q][dir].x), bfhi(yl[q][dir].x), bflo(yl[q][dir].y), bfhi(yl[q][dir].y)};
#pragma unroll
            for (int ks = 0; ks < 2; ++ks) acc = __builtin_amdgcn_mfma_f32_16x16x32_bf16(row_frag(img + dir * 4608, 72, ti * 16, ks * 32, lane), row_frag(img + (2 + dir) * 4608, 72, tj * 16, ks * 32, lane), acc, 0, 0, 0);
            accd[dir] = acc;
        }
#pragma unroll
        for (int r = 0; r < 4; ++r) {
            const int oi = (ti * 16 + (lane >> 4) * 4 + r) * 68 + tj * 16 + (lane & 15);
            O[oi] = accd[0][r] + accd[1][r];
        }
    }
    __syncthreads();
    {
        float y[8], sum = 0.f;
#pragma unroll
        for (int i = 0; i < 8; ++i) { y[i] = O[t * 68 + v0 + i]; sum += y[i]; }
        sum = red8_sum(sum);
        const float mean = sum * (1.f / 64.f);
        float sq = 0.f;
#pragma unroll
        for (int i = 0; i < 8; ++i) { y[i] -= mean; sq += y[i] * y[i]; }
        sq = red8_sum(sq);
        const float rstd = rsqrtf(sq * (1.f / 64.f) + 64e-5f);
        float vm[8], gm[8];
        rw_comb3(RwRaw3{R.cu.v, R.pr.v, R.nx.v}, nbq, tileV, P0, s, t, 1024 + h * 64 + v0, v0, mu + 1024 + h * 64 + v0, vm);
        rw_comb3(RwRaw3{R.cu.g, R.pr.g, R.nx.g}, nbq, tileG, P0, s, t, 1536 + h * 64 + v0, v0, mu + 1536 + h * 64 + v0, gm);
        R.pr = R.cu; R.cu = R.nx; R.nx = r3_tile(p, h, c + 2);
        float o[8];
#pragma unroll
        for (int i = 0; i < 8; ++i) o[i] = (y[i] * rstd * gn_g[h * 64 + v0 + i] + gn_b[h * 64 + v0 + i] + bon * vm[i]) * silu_f(gm[i]);
        *(uint4*)(YC + (size_t)s * 1024 + 512 + h * 64 + v0) = pack8(o);
    }
}

DEV void ln_rows(const bf16_t* src, const float* res_lat, const float* res_cx, int nrows, const float* __restrict__ g, const float* __restrict__ bt, float* dst_lat, float* dst_cx, int ncx,
                 bf16_t* hb = nullptr, const float* mvc = nullptr, const float* mvl = nullptr, int row0 = 0, int wg0 = 0, int nwg = 256) {
    if ((int)blockIdx.x < wg0 || (int)blockIdx.x >= wg0 + nwg) return;
    const int tid_ = opaque_tid(); const int lane = tid_ & 63, gw = row0 + ((int)blockIdx.x - wg0) * NWV + (tid_ >> 6), ngw = nwg * NWV;
    float4 gg[4], bb[4];
#pragma unroll
    for (int i = 0; i < 4; ++i) { gg[i] = ld4(g + i * 256 + lane * 4); bb[i] = ld4(bt + i * 256 + lane * 4); }
    uint2 na[4]; float4 nr[4];
    { const int r = gw < nrows ? gw : row0; const bf16_t* x = src + (size_t)r * 1024; const float* xr = (r < ncx) ? (res_cx + (size_t)r * 1024) : (res_lat + (size_t)(r - ncx) * 1024);
#pragma unroll
      for (int i = 0; i < 4; ++i) { na[i] = *(const uint2*)(x + i * 256 + lane * 4); nr[i] = ld4(xr + i * 256 + lane * 4); } }
    for (int r = gw; r < nrows; r += ngw) {
        float4 v[4];
        float sum = 0.f;
#pragma unroll
        for (int i = 0; i < 4; ++i) { const float4 a = make_float4(bflo(na[i].x), bfhi(na[i].x), bflo(na[i].y), bfhi(na[i].y)), rr = nr[i];
            v[i] = make_float4(ALPHA * rr.x + a.x, ALPHA * rr.y + a.y, ALPHA * rr.z + a.z, ALPHA * rr.w + a.w); sum += v[i].x + v[i].y + v[i].z + v[i].w; }
        { const int rn = (r + ngw < nrows) ? r + ngw : r; const bf16_t* x = src + (size_t)rn * 1024; const float* xr = (rn < ncx) ? (res_cx + (size_t)rn * 1024) : (res_lat + (size_t)(rn - ncx) * 1024);
#pragma unroll
          for (int i = 0; i < 4; ++i) { na[i] = *(const uint2*)(x + i * 256 + lane * 4); nr[i] = ld4(xr + i * 256 + lane * 4); } }
        const float mean = wave_sum(sum) * (1.f / 1024.f);
        float sq = 0.f;
#pragma unroll
        for (int i = 0; i < 4; ++i) {
            v[i].x -= mean; v[i].y -= mean; v[i].z -= mean; v[i].w -= mean;
            sq += v[i].x * v[i].x + v[i].y * v[i].y + v[i].z * v[i].z + v[i].w * v[i].w;
        }
        const float rstd = rsqrtf(wave_sum(sq) * (1.f / 1024.f) + 1e-5f);
        float* d = (r < ncx) ? (dst_cx + (size_t)r * 1024) : (dst_lat + (size_t)(r - ncx) * 1024);
#pragma unroll
        for (int i = 0; i < 4; ++i) {
            const int c = i * 256 + lane * 4;
            const float4 y = make_float4(v[i].x * rstd * gg[i].x + bb[i].x, v[i].y * rstd * gg[i].y + bb[i].y, v[i].z * rstd * gg[i].z + bb[i].z, v[i].w * rstd * gg[i].w + bb[i].w);
            st4(d + c, y);
            if (hb != nullptr) {
                const float* m = (r < ncx) ? mvc : mvl;
                const float4 sh = ld4(m + c), sc = ld4(m + 1024 + c);
                *(uint2*)(hb + (size_t)r * 1024 + c) = make_uint2(pack2bf(y.x * (1.f + sc.x) + sh.x, y.y * (1.f + sc.y) + sh.y), pack2bf(y.z * (1.f + sc.z) + sh.z, y.w * (1.f + sc.w) + sh.w));
            }
        }
    }
}
DEV void h1_regen(const Params& p, int row0, int row1, int gt, int gn) {
    const float* modv1 = (const float*)(p.ws + OFF_MODV) + 3 * 3072;
    bf16_t* H1 = (bf16_t*)(p.ws + OFF_H1B);
    const int k = (gt & 127) * 8;
    const Mod8 m0 = mod8_load(modv1, k);
    const int NI = (row1 - row0) * 128;
    for (int i0 = gt; i0 < NI; i0 += 4 * gn) {
        float4 xa[4], xb[4];
#pragma unroll
        for (int u = 0; u < 4; ++u) { const int i = i0 + u * gn; const size_t n = (size_t)(row0 - NCX + ((i < NI ? i : gt) >> 7)); xa[u] = ld4(p.out + n * DM + k); xb[u] = ld4(p.out + n * DM + k + 4); }
#pragma unroll
        for (int u = 0; u < 4; ++u) { const int i = i0 + u * gn; const size_t n = (size_t)(row0 - NCX + (i >> 7)); if (i < NI) *(uint4*)(H1 + (n + NCX) * DM + k) = mod8_apply(xa[u], xb[u], m0); }
    }
}

DEV void zero_f4_sub(float* ptr, size_t nfloat, int wg0, int nwg) {
    if ((int)blockIdx.x < wg0 || (int)blockIdx.x >= wg0 + nwg) return;
    const size_t n4 = nfloat / 4;
    for (size_t i = (size_t)((int)blockIdx.x - wg0) * NTHR + opaque_tid(); i < n4; i += (size_t)nwg * NTHR) ((float4*)ptr)[i] = make_float4(0.f, 0.f, 0.f, 0.f);
}
DEV void zero_f4(float* ptr, size_t nfloat) {
    const size_t n4 = nfloat / 4;
    for (size_t i = (size_t)blockIdx.x * NTHR + opaque_tid(); i < n4; i += (size_t)gridDim.x * NTHR) ((float4*)ptr)[i] = make_float4(0.f, 0.f, 0.f, 0.f);
}

DEV void chain_ids(int& chain, int& sub) {
    const int bid = blockIdx.x, xcd = bid & 7, idx = bid >> 3;
    chain = xcd * 2 + (idx >> 4); sub = idx & 15;
}

__device__ __forceinline__ void conv1_small(const Params& p, float* sm, int q, int b, int s0);
DEV void phase_conv1(const Params& p, float* sm) {
    const bf16_t* XM = (const bf16_t*)(p.ws + OFF_XM);
    bf16_t* XC = (bf16_t*)(p.ws + OFF_XC);
    float* G16P = (float*)(p.ws + OFF_G16P);
    const bf16_t* WFT = (const bf16_t*)(p.ws + OFF_WFT);
    const float* cw = p.in[31]; const float* cbias = p.in[32];
    bf16_t* imgC = (bf16_t*)sm;
    bf16_t* imgM = imgC + 64 * 264;
    float* red = (float*)(imgM + 64 * 264);
    float* cwl = red + 1024;
    const int tid = opaque_tid(), lane = tid & 63, wave = tid >> 6, t = tid >> 3, cg = tid & 7;
    static_assert(TB % 264 == 0 && RT / 264 * 4 == 256, "conv token ranges assume 256 workgroups");
    static_assert((size_t)32 * 256 * NTHR * 16 == (size_t)NB * NL * 2048 * 2, "the conv loop's side stores cover H exactly");
    { const int q = (int)blockIdx.x & 3;
      for (int i = tid; i < 1280; i += NTHR) { const int tp = i >> 7, c4 = (i & 127) * 4; st4(cwl + tp * 512 + c4, ld4((tp < 9 ? cw + tp * 2048 : cbias) + q * 512 + c4)); } }
    __syncthreads();
    for (int k4 = 0; k4 < 4; ++k4) {
        const int q = (int)blockIdx.x & 3, ri = (int)blockIdx.x >> 2, b = ri >> 5, s0 = (ri & 31) * 264 + k4 * 64, s = s0 + t;
        const size_t rowbase = (size_t)b * TB;
        int nrow[9];
        static_assert(OFF_ZROW < OFF_XM && (OFF_XM - OFF_ZROW) % 4096 == 0 && OFF_ZROW + 4096 <= OFF_GTAB, "zero row must sit a whole number of XM rows below XM");
        constexpr int ZROW = -(int)((OFF_XM - OFF_ZROW) / 4096);
#pragma unroll
        for (int i = 0; i < 3; ++i)
#pragma unroll
            for (int j = 0; j < 3; ++j) {
                int ns = -1;
                if (s < NCX) { const int w2 = s + j - 1; if (i == 1 && w2 >= 0 && w2 < NCX) ns = w2; }
                else { const int n = s - NCX, rr = (n >> 6) + i - 1, w2 = (n & 63) + j - 1; if (rr >= 0 && rr < 128 && w2 >= 0 && w2 < 64) ns = NCX + rr * 64 + w2; }
                nrow[i * 3 + j] = ns >= 0 ? (int)rowbase + ns : ZROW;
            }
        const int tt = wave & 3, part = wave >> 2;
        f32x4 acc = (f32x4){0.f, 0.f, 0.f, 0.f};
        uint4 xn[9];
#pragma unroll
        for (int tap = 0; tap < 9; ++tap) xn[tap] = *(const uint4*)(XM + (long)nrow[tap] * 2048 + q * 512 + cg * 8);
#pragma unroll 1
        for (int half = 0; half < 2; ++half) {
            __syncthreads();
#pragma unroll 1
            for (int it = 0; it < 4; ++it) {
                const int cl = it * 64 + cg * 8, c0 = q * 512 + half * 256 + cl;
                uint4 xc9[9];
#pragma unroll
                for (int tap = 0; tap < 9; ++tap) xc9[tap] = xn[tap];
                { const int gn = half * 4 + it + 1, c0n = q * 512 + (gn < 8 ? gn : 7) * 64 + cg * 8;
#pragma unroll
                  for (int tap = 0; tap < 9; ++tap) xn[tap] = *(const uint4*)(XM + (long)nrow[tap] * 2048 + c0n); }
                float a8[8];
                { const float4 b0 = ld4(cwl + 9 * 512 + half * 256 + cl), b1 = ld4(cwl + 9 * 512 + half * 256 + cl + 4); a8[0] = b0.x; a8[1] = b0.y; a8[2] = b0.z; a8[3] = b0.w; a8[4] = b1.x; a8[5] = b1.y; a8[6] = b1.z; a8[7] = b1.w; }
#pragma unroll
                for (int tap = 0; tap < 9; ++tap) {
                    float x8[8]; unpack8(xc9[tap], x8);
                    const float4 w0 = ld4(cwl + tap * 512 + half * 256 + cl), w1 = ld4(cwl + tap * 512 + half * 256 + cl + 4);
                    a8[0] += x8[0] * w0.x; a8[1] += x8[1] * w0.y; a8[2] += x8[2] * w0.z; a8[3] += x8[3] * w0.w;
                    a8[4] += x8[4] * w1.x; a8[5] += x8[5] * w1.y; a8[6] += x8[6] * w1.z; a8[7] += x8[7] * w1.w;
                }
#pragma unroll
                for (int i = 0; i < 8; ++i) a8[i] = silu_f(a8[i]);
                const uint4 xcv = pack8(a8);
                *(uint4*)(XC + (rowbase + s) * 2048 + c0) = xcv;
                *(uint4*)(imgC + t * 264 + cl) = xcv;
                *(uint4*)(imgM + t * 264 + cl) = xc9[4];
                ((float4*)(p.ws + OFF_H))[(size_t)((k4 * 2 + half) * 4 + it) * (256 * NTHR) + (size_t)blockIdx.x * NTHR + tid] = make_float4(0.f, 0.f, 0.f, 0.f);
            }
            __syncthreads();
            {
                const bf16_t* img = part ? imgM : imgC;
                const bf16_t* wrow = WFT + (size_t)(lane & 15) * 4096 + part * 2048 + q * 512 + half * 256 + (lane >> 4) * 8;
#pragma unroll
                for (int ks = 0; ks < 8; ++ks) acc = __builtin_amdgcn_mfma_f32_16x16x32_bf16(row_frag(img, 264, tt * 16, ks * 32, lane), *(const bf16x8*)(wrow + ks * 32), acc, 0, 0, 0);
            }
        }
        if (part == 1) {
#pragma unroll
            for (int r = 0; r < 4; ++r) red[(tt * 16 + (lane >> 4) * 4 + r) * 16 + (lane & 15)] = acc[r];
        }
        __syncthreads();
        if (part == 0) {
#pragma unroll
            for (int r = 0; r < 4; ++r) {
                const int tk = tt * 16 + (lane >> 4) * 4 + r;
                G16P[(((size_t)rowbase + s0 + tk) * 16 + (lane & 15)) * 4 + q] = acc[r] + red[tk * 16 + (lane & 15)];
            }
        }
    }
    conv1_small(p, sm, (int)blockIdx.x & 3, (int)blockIdx.x >> 7, (((int)blockIdx.x >> 2) & 31) * 264 + 256);
}
DEV void conv1_small(const Params& p, float* sm, int q, int b, int s0) {
    const bf16_t* XM = (const bf16_t*)(p.ws + OFF_XM);
    bf16_t* XC = (bf16_t*)(p.ws + OFF_XC);
    float* G16P = (float*)(p.ws + OFF_G16P);
    const bf16_t* WFT = (const bf16_t*)(p.ws + OFF_WFT);
    const float* cw = p.in[31]; const float* cbias = p.in[32];
    bf16_t* imgC = (bf16_t*)sm;
    bf16_t* imgM = imgC + 16 * 520;
    float* red = (float*)(imgM + 16 * 520);
    const float* cwl = (const float*)((const char*)sm + 71680);
    const int tid = opaque_tid(), lane = tid & 63, wave = tid >> 6, t8 = tid >> 6, g = (tid >> 3) & 7, cg = tid & 7, s = s0 + t8;
    const size_t rowbase = (size_t)b * TB;
    int nrow[9]; unsigned vmask = 0u;
#pragma unroll
    for (int i = 0; i < 3; ++i)
#pragma unroll
        for (int j = 0; j < 3; ++j) {
            int ns = -1;
            if (s < NCX) { const int w2 = s + j - 1; if (i == 1 && w2 >= 0 && w2 < NCX) ns = w2; }
            else { const int n = s - NCX, rr = (n >> 6) + i - 1, w2 = (n & 63) + j - 1; if (rr >= 0 && rr < 128 && w2 >= 0 && w2 < 64) ns = NCX + rr * 64 + w2; }
            nrow[i * 3 + j] = ns >= 0 ? ns : s; vmask |= (ns >= 0 ? 1u : 0u) << (i * 3 + j);
        }
    const int cl = g * 64 + cg * 8, c0 = q * 512 + cl;
    uint4 x9[9];
#pragma unroll
    for (int tap = 0; tap < 9; ++tap) x9[tap] = *(const uint4*)(XM + (rowbase + nrow[tap]) * 2048 + c0);
    __syncthreads();
    float a8[8];
    { const float4 b0 = ld4(cwl + 9 * 512 + cl), b1 = ld4(cwl + 9 * 512 + cl + 4); a8[0] = b0.x; a8[1] = b0.y; a8[2] = b0.z; a8[3] = b0.w; a8[4] = b1.x; a8[5] = b1.y; a8[6] = b1.z; a8[7] = b1.w; }
#pragma unroll
    for (int tap = 0; tap < 9; ++tap) {
        const unsigned mk = ((vmask >> tap) & 1u) ? 0xffffffffu : 0u;
        const uint4 xv = make_uint4(x9[tap].x & mk, x9[tap].y & mk, x9[tap].z & mk, x9[tap].w & mk);
        float x8[8]; unpack8(xv, x8);
        const float4 w0 = ld4(cwl + tap * 512 + cl), w1 = ld4(cwl + tap * 512 + cl + 4);
        a8[0] += x8[0] * w0.x; a8[1] += x8[1] * w0.y; a8[2] += x8[2] * w0.z; a8[3] += x8[3] * w0.w;
        a8[4] += x8[4] * w1.x; a8[5] += x8[5] * w1.y; a8[6] += x8[6] * w1.z; a8[7] += x8[7] * w1.w;
    }
#pragma unroll
    for (int i = 0; i < 8; ++i) a8[i] = silu_f(a8[i]);
    const uint4 xcv = pack8(a8);
    *(uint4*)(XC + (rowbase + s) * 2048 + c0) = xcv;
    *(uint4*)(imgC + t8 * 520 + cl) = xcv;
    *(uint4*)(imgM + t8 * 520 + cl) = x9[4];
    __syncthreads();
    {
        const int part = wave >> 2, kq = wave & 3;
        const bf16_t* img = part ? imgM : imgC;
        const bf16_t* wrow = WFT + (size_t)(lane & 15) * 4096 + part * 2048 + q * 512 + kq * 128 + (lane >> 4) * 8;
        f32x4 acc = (f32x4){0.f, 0.f, 0.f, 0.f};
#pragma unroll
        for (int ks = 0; ks < 4; ++ks) acc = __builtin_amdgcn_mfma_f32_16x16x32_bf16(row_frag(img, 520, 0, kq * 128 + ks * 32, lane), *(const bf16x8*)(wrow + ks * 32), acc, 0, 0, 0);
        st4(red + wave * 256 + lane * 4, make_float4(acc[0], acc[1], acc[2], acc[3]));
    }
    __syncthreads();
    if (tid < 128) {
        const int tok = tid >> 4, gate = tid & 15, idx = ((tok >> 2) * 16 + gate) * 4 + (tok & 3);
        float sum = 0.f;
#pragma unroll
        for (int w = 0; w < NWV; ++w) sum += red[w * 256 + idx];
        G16P[(((size_t)rowbase + s0 + tok) * 16 + gate) * 4 + q] = sum;
    }
}

struct GateRaw { float4 a, f; };
DEV GateRaw gate_load(const Params& p, size_t row, int dir, int h) {
    const float* G16P = (const float*)(p.ws + OFF_G16P);
    GateRaw g; g.a = ld4(G16P + (row * 16 + dir * 8 + h) * 4); g.f = ld4(G16P + (row * 16 + dir * 8 + 4 + h) * 4);
    return g;
}
DEV void gate_fin(const GateRaw& g, float bi, float bf, float& gi, float& lf) {
    gi = (g.a.x + g.a.y) + (g.a.z + g.a.w) + bi;
    lf = logsig_f((g.f.x + g.f.y) + (g.f.z + g.f.w) + bf);
}
DEV void gate_pair(const Params& p, size_t row, int dir, int h, float& gi, float& lf) {
    const GateRaw g = gate_load(p, row, dir, h);
    gate_fin(g, p.in[dir ? 41 : 37][h], p.in[dir ? 43 : 39][h], gi, lf);
}

DEV void phase_x1(const Params& p, float* sm) {
    int chain, sub; chain_ids(chain, sub);
    const int b = chain >> 3, h = (chain >> 1) & 3, dir = chain & 1;
    const bf16_t* XC = (const bf16_t*)(p.ws + OFF_XC);
    float* GSC = (float*)(p.ws + OFF_GSC); float* CSC = (float*)(p.ws + OFF_CSC); float* NBUF = (float*)(p.ws + OFF_NBUF);
    const float* gtab = (const float*)(p.ws + OFF_GTAB);
    bf16_t* SMAT = (bf16_t*)(p.ws + OFF_SMAT);
    const int tid = opaque_tid(), lane = tid & 63, wave = tid >> 6;
    float* sTot = sm; float* sRef = sm + 132; float* sM0 = sm + 264; float* sBeta = sm + 400;
    const float bias_i = p.in[dir ? 41 : 37][h], bias_f = p.in[dir ? 43 : 39][h];
    {
        constexpr int GB = 6;
#pragma unroll 1
        for (int c0 = wave; c0 < NCH; c0 += NWV * GB) {
            GateRaw gr0, gr1, gr2, gr3, gr4, gr5;
#define X1_GL(j_, dst_) { const int c_ = c0 + (j_) * NWV; dst_ = gate_load(p, (size_t)b * TB + (c_ < NCH ? c_ : NCH - 1) * 64 + lane, dir, h); }
            X1_GL(0, gr0) X1_GL(1, gr1) X1_GL(2, gr2) X1_GL(3, gr3) X1_GL(4, gr4) X1_GL(5, gr5)
#undef X1_GL
#define X1_GC(j_, src_) { const int c_ = c0 + (j_) * NWV; float gi, lf; gate_fin(src_, bias_i, bias_f, gi, lf); const float bc = wave_scan_add(lf, lane, dir); \
                          const float ref = wave_max(gi - bc), tot = wave_sum(lf); if (lane == 0 && c_ < NCH) { sTot[c_] = tot; sRef[c_] = ref; } }
            X1_GC(0, gr0) X1_GC(1, gr1) X1_GC(2, gr2) X1_GC(3, gr3) X1_GC(4, gr4) X1_GC(5, gr5)
#undef X1_GC
        }
    }
    __syncthreads();
    if (wave == 0) {
        float ta0, ta1, ta2, rb0, rb1, rb2; int cc0, cc1, cc2;
#define X1_ST(j_, ta_, rb_, cc_) { const int st_ = 3 * lane + (j_); const bool v_ = st_ < NCH; cc_ = chunk_at(dir, v_ ? st_ : NCH - 1); ta_ = v_ ? sTot[cc_] : 0.f; rb_ = v_ ? sRef[cc_] : -INFINITY; }
        X1_ST(0, ta0, rb0, cc0) X1_ST(1, ta1, rb1, cc1) X1_ST(2, ta2, rb2, cc2)
#undef X1_ST
        float A = ta0, Bv = rb0 + ta0;
        Bv = fmaxf(Bv + ta1, rb1 + ta1); A += ta1;
        Bv = fmaxf(Bv + ta2, rb2 + ta2); A += ta2;
#pragma unroll
        for (int off = 1; off < 64; off <<= 1) {
            const float pa = __shfl_up(A, off), pb = __shfl_up(Bv, off);
            if (lane >= off) { Bv = fmaxf(pb + A, Bv); A = pa + A; }
        }
        float m0 = __shfl_up(Bv, 1);
        if (lane == 0) m0 = -INFINITY;
#define X1_AP(j_, ta_, rb_, cc_) if (3 * lane + (j_) < NCH) { sM0[cc_] = m0; const float mx = fmaxf(m0, rb_); \
            if (sub == 0) { CSC[(chain * NCH + cc_) * 2] = fexp(m0 - mx); CSC[(chain * NCH + cc_) * 2 + 1] = fexp(rb_ - mx); } m0 = ta_ + mx; }
        X1_AP(0, ta0, rb0, cc0) X1_AP(1, ta1, rb1, cc1) X1_AP(2, ta2, rb2, cc2)
#undef X1_AP
    }
    __syncthreads();
    for (int k = wave; sub + 16 * k < NCH; k += NWV) {
        const int c = sub + 16 * k;
        const size_t row = (size_t)b * TB + c * 64 + lane;
        float gi, lf; gate_fin(gate_load(p, row, dir, h), bias_i, bias_f, gi, lf);
        const float bc = wave_scan_add(lf, lane, dir);
        const float a = gi - bc;
        const float amax = wave_scan_max(a, lane, dir);
        const float ref = sRef[c], m0 = sM0[c];
        const float mmax = fmaxf(amax, m0);
        const float mt = bc + mmax;
        const float alpha = fexp(ref - mmax), beta = fexp(a - ref), gg = fexp(m0 - mmax), em = fexp(-mt);
        st4(GSC + ((size_t)chain * TB + c * 64 + lane) * 4, make_float4(alpha, beta, gg, em));
        sBeta[k * 64 + lane] = beta;
    }
    __syncthreads();
    {
        bf16_t* XCs = (bf16_t*)((char*)sm + 4096);
        bf16_t* Qs = XCs + 64 * 520;
        float* part = (float*)Qs;
        static_assert(4096 + 2 * 64 * 520 * 2 <= LDS_BYTES - 16, "x1 LDS map");
        const int sg = tid >> 6, j8 = (tid & 63) * 8;
        const int nk = (NCH - 1 - sub) / 16 + 1;
        float4 gq[2][4];
#pragma unroll
        for (int bb = 0; bb < 2; ++bb) { const float* G = gtab + (size_t)(h * 128 + (tid & 63) * 2 + bb) * 16; gq[bb][0] = ld4(G); gq[bb][1] = ld4(G + 4); gq[bb][2] = ld4(G + 8); gq[bb][3] = ld4(G + 12); }
        uint4 xn[8], xn2[8];
        { const bf16_t* xp = XC + ((size_t)b * TB + sub * 64 + sg) * 2048 + h * 512 + j8;
#pragma unroll
          for (int s = 0; s < 8; ++s) xn[s] = *(const uint4*)(xp + (size_t)s * 8 * 2048);
          const bf16_t* xq = XC + ((size_t)b * TB + (sub + 16) * 64 + sg) * 2048 + h * 512 + j8;
#pragma unroll
          for (int s = 0; s < 8; ++s) xn2[s] = *(const uint4*)(xq + (size_t)s * 8 * 2048); }
        for (int k = 0; k < nk; ++k) {
            const int c = sub + 16 * k;
            uint4 xcur[8];
#pragma unroll
            for (int s = 0; s < 8; ++s) { xcur[s] = xn[s]; xn[s] = xn2[s]; }
            { const int kn = (k + 2 < nk) ? k + 2 : nk - 1; const bf16_t* xp = XC + ((size_t)b * TB + (sub + 16 * kn) * 64 + sg) * 2048 + h * 512 + j8;
#pragma unroll
              for (int s = 0; s < 8; ++s) xn2[s] = *(const uint4*)(xp + (size_t)s * 8 * 2048); }
            float acc[8];
#pragma unroll
            for (int i = 0; i < 8; ++i) acc[i] = 0.f;
#pragma unroll
            for (int s = 0; s < 8; ++s) {
                float f[8]; unpack8(xcur[s], f);
                const float be = sBeta[k * 64 + sg + 8 * s];
#pragma unroll
                for (int i = 0; i < 8; ++i) acc[i] += be * f[i];
            }
            __syncthreads();
            st4(part + sg * 512 + j8, make_float4(acc[0], acc[1], acc[2], acc[3])); st4(part + sg * 512 + j8 + 4, make_float4(acc[4], acc[5], acc[6], acc[7]));
            __syncthreads();
            float tot = 0.f;
#pragma unroll
            for (int q = 0; q < 8; ++q) tot += part[q * 512 + tid];
            NBUF[((size_t)chain * NCH + c) * 512 + tid] = tot;
            if ((k & 1) == dir) {
                __syncthreads();
#pragma unroll
                for (int i = 0; i < 8; ++i) {
                    const int row = sg + 8 * i;
                    const uint4 xv = xcur[i];
                    float f[8]; unpack8(xv, f);
                    float q[8];
#pragma unroll
                    for (int bb = 0; bb < 2; ++bb) {
                        const float4 g0 = gq[bb][0], g1 = gq[bb][1], g2 = gq[bb][2], g3 = gq[bb][3];
                        q[bb * 4 + 0] = f[bb * 4] * g0.x + f[bb * 4 + 1] * g1.x + f[bb * 4 + 2] * g2.x + f[bb * 4 + 3] * g3.x;
                        q[bb * 4 + 1] = f[bb * 4] * g0.y + f[bb * 4 + 1] * g1.y + f[bb * 4 + 2] * g2.y + f[bb * 4 + 3] * g3.y;
                        q[bb * 4 + 2] = f[bb * 4] * g0.z + f[bb * 4 + 1] * g1.z + f[bb * 4 + 2] * g2.z + f[bb * 4 + 3] * g3.z;
                        q[bb * 4 + 3] = f[bb * 4] * g0.w + f[bb * 4 + 1] * g1.w + f[bb * 4 + 2] * g2.w + f[bb * 4 + 3] * g3.w;
                    }
                    *(uint4*)(XCs + row * 520 + j8) = xv;
                    *(uint4*)(Qs + row * 520 + j8) = make_uint4(pack2bf(q[0], q[1]), pack2bf(q[2], q[3]), pack2bf(q[4], q[5]), pack2bf(q[6], q[7]));
                }
                __syncthreads();
                const int st = wave & 3, tt0 = (wave >> 2) * 2;
                f32x4 a0 = (f32x4){0.f, 0.f, 0.f, 0.f}, a1 = a0;
                const bf16_t* ap = XCs + (st * 16 + (lane & 15)) * 520 + (lane >> 4) * 8;
                const bf16_t* bp0 = Qs + (tt0 * 16 + (lane & 15)) * 520 + (lane >> 4) * 8;
                const bf16_t* bp1 = bp0 + 16 * 520;
#pragma unroll
                for (int ks = 0; ks < 16; ++ks) {
                    const bf16x8 af = *(const bf16x8*)(ap + ks * 32);
                    a0 = __builtin_amdgcn_mfma_f32_16x16x32_bf16(af, *(const bf16x8*)(bp0 + ks * 32), a0, 0, 0, 0);
                    a1 = __builtin_amdgcn_mfma_f32_16x16x32_bf16(af, *(const bf16x8*)(bp1 + ks * 32), a1, 0, 0, 0);
                }
                bf16_t* sp = SMAT + (size_t)((b * 4 + h) * NCH + c) * 4096 + (size_t)(tt0 * 16 + (lane & 15)) * 64 + st * 16 + (lane >> 4) * 4;
                *(uint2*)sp = make_uint2(pack2bf(a0[0], a0[1]), pack2bf(a0[2], a0[3]));
                *(uint2*)(sp + 16 * 64) = make_uint2(pack2bf(a1[0], a1[1]), pack2bf(a1[2], a1[3]));
            }
        }
    }
}

DEV void phase_x2(const Params& p, float* sm) {
    int chain, sub; chain_ids(chain, sub);
    const int b = chain >> 3, h = (chain >> 1) & 3, dir = chain & 1;
    const bf16_t* XC = (const bf16_t*)(p.ws + OFF_XC);
    float* GSC = (float*)(p.ws + OFF_GSC); const float* CSC = (const float*)(p.ws + OFF_CSC); const float* NBUF = (const float*)(p.ws + OFF_NBUF);
    const float* gtab = (const float*)(p.ws + OFF_GTAB);
    const bf16_t* SMAT = (const bf16_t*)(p.ws + OFF_SMAT);
    const int tid = opaque_tid();
    float* sD0 = sm; float* sCf = sm + 132; float* sN0 = sm + 264; float* sN2 = sN0 + 9 * 512;
    for (int i = tid; i < NCH; i += NTHR) { sD0[i] = CSC[(chain * NCH + i) * 2]; sCf[i] = CSC[(chain * NCH + i) * 2 + 1]; }
    __syncthreads();
    float* sBeta = sN2 + 9 * 512;
    for (int i = tid; i < 9 * 64; i += NTHR) { const int k = i >> 6, c = sub + 16 * k; if (c < NCH) sBeta[i] = GSC[((size_t)chain * TB + c * 64 + (i & 63)) * 4 + 1]; }
    if (tid < 128) {
        constexpr int NBT = 12;
        float4 n = make_float4(0.f, 0.f, 0.f, 0.f), nx[NBT];
        const float* nb = NBUF + (size_t)chain * NCH * 512 + tid * 4;
#pragma unroll
        for (int j = 0; j < NBT; ++j) nx[j] = ld4(nb + (size_t)chunk_at(dir, j) * 512);
#pragma unroll 1
        for (int step0 = 0; step0 < NCH; step0 += NBT) {
            float4 cu[NBT];
#pragma unroll
            for (int j = 0; j < NBT; ++j) cu[j] = nx[j];
#pragma unroll
            for (int j = 0; j < NBT; ++j) { const int sn = step0 + NBT + j; nx[j] = ld4(nb + (size_t)chunk_at(dir, sn < NCH ? sn : NCH - 1) * 512); }
            __builtin_amdgcn_sched_barrier(0);
#pragma unroll
            for (int j = 0; j < NBT; ++j) {
                const int c = chunk_at(dir, step0 + j);
                if ((c & 15) == sub) st4(sN0 + (c >> 4) * 512 + tid * 4, n);
                const float d = sD0[c], cf = sCf[c];
                n = make_float4(d * n.x + cf * cu[j].x, d * n.y + cf * cu[j].y, d * n.z + cf * cu[j].z, d * n.w + cf * cu[j].w);
            }
        }
    } else {
        h1_regen(p, H1B_NBUF_ROWS, H1B_CLOB, (int)blockIdx.x * (NTHR - 128) + (tid - 128), (int)gridDim.x * (NTHR - 128));
    }
    __syncthreads();
    bf16_t* sNh = (bf16_t*)sN2; bf16_t* sNl = sNh + 9 * 512;
    float* dpart = sBeta + 9 * 64;
    {
        const int blk = tid >> 2, cp = tid & 3;
        const float4 g = ld4(gtab + (size_t)(h * 128 + blk) * 16 + cp * 4);
        for (int k = 0; sub + 16 * k < NCH; ++k) {
            const float* n0 = sN0 + k * 512 + blk * 4;
            const float v = g.x * n0[0] + g.y * n0[1] + g.z * n0[2] + g.w * n0[3];
            const __bf16 hi = (__bf16)v; const __bf16 lo = (__bf16)(v - (float)hi);
            sNh[k * 512 + tid] = __builtin_bit_cast(unsigned short, hi); sNl[k * 512 + tid] = __builtin_bit_cast(unsigned short, lo);
        }
    }
    __syncthreads();
    const int t = tid >> 3, part = tid & 7;
    const int lane = tid & 63, wave = tid >> 6;
    const int tt = wave & 3, kh = wave >> 2, l15 = lane & 15, g4i = lane >> 4;
    const int nk = (NCH - 1 - sub) / 16 + 1;
    uint4 xq0, xq1, xq2, xq3, xq4, xq5, xq6, xq7, sq; float4 gq4;
#define X2_LOAD(k_) do { const int c_ = sub + 16 * ((k_) < nk ? (k_) : nk - 1); const bf16_t* xp_ = XC + ((size_t)b * TB + c_ * 64 + tt * 16 + l15) * 2048 + h * 512 + kh * 256 + g4i * 8; \
        xq0 = *(const uint4*)(xp_); xq1 = *(const uint4*)(xp_ + 32); xq2 = *(const uint4*)(xp_ + 64); xq3 = *(const uint4*)(xp_ + 96); \
        xq4 = *(const uint4*)(xp_ + 128); xq5 = *(const uint4*)(xp_ + 160); xq6 = *(const uint4*)(xp_ + 192); xq7 = *(const uint4*)(xp_ + 224); \
        sq = *(const uint4*)(SMAT + ((size_t)((b * 4 + h) * NCH + c_)) * 4096 + t * 64 + part * 8); gq4 = ld4(GSC + ((size_t)chain * TB + c_ * 64 + t) * 4); } while (0)
    X2_LOAD(0);
    for (int k = 0; k < nk; ++k) {
        const int c = sub + 16 * k;
        const uint4 x0 = xq0, x1 = xq1, x2 = xq2, x3 = xq3, x4 = xq4, x5 = xq5, x6 = xq6, x7 = xq7, sv = sq; const float4 g4 = gq4;
        X2_LOAD(k + 1);
        {
            const bf16_t* bsrc = (l15 == 1 ? sNl : sNh) + k * 512 + kh * 256 + g4i * 8;
            f32x4 acc = (f32x4){0.f, 0.f, 0.f, 0.f};
#define X2_MM(i_, xv_) acc = __builtin_amdgcn_mfma_f32_16x16x32_bf16(__builtin_bit_cast(bf16x8, xv_), *(const bf16x8*)(bsrc + (i_) * 32), acc, 0, 0, 0);
            X2_MM(0, x0) X2_MM(1, x1) X2_MM(2, x2) X2_MM(3, x3) X2_MM(4, x4) X2_MM(5, x5) X2_MM(6, x6) X2_MM(7, x7)
#undef X2_MM
            const float d0 = acc[0] + DPPX_F(acc[0], 0xB1), d1 = acc[1] + DPPX_F(acc[1], 0xB1), d2 = acc[2] + DPPX_F(acc[2], 0xB1), d3 = acc[3] + DPPX_F(acc[3], 0xB1);
            if (l15 == 0) st4(dpart + ((k & 1) * 2 + kh) * 64 + tt * 16 + g4i * 4, make_float4(d0, d1, d2, d3));
        }
        float di = 0.f;
        {
            float f[8]; unpack8(sv, f);
#pragma unroll
            for (int e = 0; e < 8; ++e) {
                const int s_ = part * 8 + e;
                const float beta = sBeta[k * 64 + s_];
                const bool keep = dir ? (s_ >= t) : (s_ <= t);
                di += keep ? f[e] * beta : 0.f;
            }
        }
        di = red8_sum(di);
        __syncthreads();
        if (part == 0) {
            const float dint = dpart[((k & 1) * 2) * 64 + t] + dpart[((k & 1) * 2 + 1) * 64 + t];
            const float den = g4.x * di + g4.z * dint;
            GSC[((size_t)chain * TB + c * 64 + t) * 4 + 3] = 1.f / fmaxf(fabsf(den), g4.w);
        }
    }
#undef X2_LOAD
}

#define MLSTM_PREFETCH(step_) do { \
    const int c_ = chunk_at(dir, (step_)); const size_t rb_ = (size_t)b * TB + (size_t)c_ * 64; \
    { const bf16_t* xb_ = XC + (rb_ + (tid >> 6)) * 2048 + h * 512 + (tid & 63) * 8; \
      rx0 = *(const uint4*)(xb_); rx1 = *(const uint4*)(xb_ + 8 * 2048); rx2 = *(const uint4*)(xb_ + 16 * 2048); rx3 = *(const uint4*)(xb_ + 24 * 2048); \
      rx4 = *(const uint4*)(xb_ + 32 * 2048); rx5 = *(const uint4*)(xb_ + 40 * 2048); rx6 = *(const uint4*)(xb_ + 48 * 2048); rx7 = *(const uint4*)(xb_ + 56 * 2048); } \
    rxm = *(const uint2*)(XM + (rb_ + ps) * 2048 + ch0 + pvb * 4); \
    rs = *(const uint4*)(SMAT + ((size_t)((b * 4 + h) * NCH + c_)) * 4096 + ps * 64 + pvb * 8); \
    rbeta = GSC[((size_t)chain * TB + c_ * 64 + ps) * 4 + 1]; \
    if (tid < 64) rsc = ld4(GSC + ((size_t)chain * TB + c_ * 64 + tid) * 4); \
    rd0 = CSC[(chain * NCH + c_) * 2]; rcf = CSC[(chain * NCH + c_) * 2 + 1]; } while (0)

DEV void phase_mlstm(const Params& p, float* sm) {
    int chain, sub; chain_ids(chain, sub);
    const int b = chain >> 3, h = (chain >> 1) & 3, dir = chain & 1;
    const bf16_t* XM = (const bf16_t*)(p.ws + OFF_XM);
    const bf16_t* XC = (const bf16_t*)(p.ws + OFF_XC);
    const bf16_t* SMAT = (const bf16_t*)(p.ws + OFF_SMAT);
    const float* GSC = (const float*)(p.ws + OFF_GSC); const float* CSC = (const float*)(p.ws + OFF_CSC);
    const float* gtab = (const float*)(p.ws + OFF_GTAB);
    bf16_t* H = (bf16_t*)(p.ws + OFF_H);
    const float* wv = p.in[35];
    char* smc = (char*)sm;
    bf16_t* XCs = (bf16_t*)smc;
    bf16_t* Cs = (bf16_t*)(smc + 66560);
    bf16_t* Vb = (bf16_t*)(smc + 66560 + 33280);
    bf16_t* Vw = Vb + 64 * 40;
    bf16_t* Sm = Vw + 64 * 40;
    float* sc = (float*)(smc + 66560 + 33280 + 2 * 5120 + 9216);
    float* Xp = sc + 256;
    const int tid = opaque_tid(), lane = tid & 63, wave = tid >> 6;
    for (int i = tid; i < 32 * 520 / 2; i += NTHR) ((unsigned*)Cs)[i] = 0u;
    const int ps = tid >> 3, pvb = tid & 7;
    const int ch0 = h * 512 + sub * 32;
    float wvr[16];
#pragma unroll
    for (int i = 0; i < 16; ++i) wvr[i] = wv[(size_t)((ch0 >> 2) + pvb) * 16 + i];
    f32x4 accS[4][2];
#pragma unroll
    for (int i = 0; i < 4; ++i) { accS[i][0] = (f32x4){0.f, 0.f, 0.f, 0.f}; accS[i][1] = (f32x4){0.f, 0.f, 0.f, 0.f}; }
    bf16x8 gA[2][2];
#pragma unroll
    for (int pr = 0; pr < 2; ++pr)
#pragma unroll
        for (int tg = 0; tg < 2; ++tg) {
            const int gq = lane >> 4, l15 = lane & 15, blk = wave * 16 + (pr * 2 + tg) * 4 + gq;
            const float4 gr = ld4(gtab + (size_t)h * 2048 + blk * 16 + (l15 & 3) * 4);
            const bool on = (gq == (l15 >> 2));
            const unsigned p0 = on ? pack2bf(gr.x, gr.y) : 0u, p1 = on ? pack2bf(gr.z, gr.w) : 0u;
            const uint4 u = tg == 0 ? make_uint4(p0, p1, 0u, 0u) : make_uint4(0u, 0u, p0, p1);
            gA[pr][tg] = __builtin_bit_cast(bf16x8, u);
        }
    uint4 rx0, rx1, rx2, rx3, rx4, rx5, rx6, rx7; uint2 rxm; uint4 rs; float rbeta; float4 rsc = make_float4(0.f, 0.f, 0.f, 0.f); float rd0, rcf;
    MLSTM_PREFETCH(0);
    __syncthreads();
#pragma unroll 1
    for (int step = 0; step < NCH; ++step) {
        const int c = chunk_at(dir, step);
        const float d0 = rd0, cf = rcf;
        {
            bf16_t* xd = XCs + (tid >> 6) * 520 + (tid & 63) * 8;
            *(uint4*)(xd) = rx0; *(uint4*)(xd + 8 * 520) = rx1; *(uint4*)(xd + 16 * 520) = rx2; *(uint4*)(xd + 24 * 520) = rx3;
            *(uint4*)(xd + 32 * 520) = rx4; *(uint4*)(xd + 40 * 520) = rx5; *(uint4*)(xd + 48 * 520) = rx6; *(uint4*)(xd + 56 * 520) = rx7;
        }
        {
            const float x0 = bflo(rxm.x), x1 = bfhi(rxm.x), x2 = bflo(rxm.y), x3 = bfhi(rxm.y);
            float vv[4];
#pragma unroll
            for (int d = 0; d < 4; ++d) vv[d] = (x0 * wvr[d] + x1 * wvr[4 + d] + x2 * wvr[8 + d] + x3 * wvr[12 + d]) * rbeta;
            *(uint2*)(Vb + ps * 40 + pvb * 4) = make_uint2(pack2bf(vv[0], vv[1]), pack2bf(vv[2], vv[3]));
            *(uint2*)(Vw + ps * 40 + pvb * 4) = make_uint2(pack2bf(vv[0] * cf, vv[1] * cf), pack2bf(vv[2] * cf, vv[3] * cf));
        }
        {
#define SMASK(q_) (((dir ? (pvb * 8 + 2 * (q_) >= ps) : (pvb * 8 + 2 * (q_) <= ps)) ? 0x0000ffffu : 0u) | ((dir ? (pvb * 8 + 2 * (q_) + 1 >= ps) : (pvb * 8 + 2 * (q_) + 1 <= ps)) ? 0xffff0000u : 0u))
            *(uint4*)(Sm + ps * 72 + pvb * 8) = make_uint4(rs.x & SMASK(0), rs.y & SMASK(1), rs.z & SMASK(2), rs.w & SMASK(3));
#undef SMASK
        }
        if (tid < 64) st4(sc + tid * 4, rsc);
        { const int nstep = (step + 1 < NCH) ? step + 1 : step; MLSTM_PREFETCH(nstep); }
        __syncthreads();
        const int tt = wave & 3, kh = wave >> 2;
        f32x4 ao_own, ai = (f32x4){0.f, 0.f, 0.f, 0.f};
        float4 s4;
        {
            f32x4 a00 = ai, a01 = ai, a10 = ai, a11 = ai;
            const bf16_t* ap0 = Cs + (lane & 15) * 520 + (lane >> 4) * 8 + kh * 256;
            const bf16_t* ap1 = ap0 + 16 * 520;
            const bf16_t* bp = XCs + (tt * 16 + (lane & 15)) * 520 + (lane >> 4) * 8 + kh * 256;
#pragma unroll
            for (int ks = 0; ks < 8; ks += 2) {
                const bf16x8 b0 = *(const bf16x8*)(bp + ks * 32), b1 = *(const bf16x8*)(bp + (ks + 1) * 32);
                a00 = __builtin_amdgcn_mfma_f32_16x16x32_bf16(*(const bf16x8*)(ap0 + ks * 32), b0, a00, 0, 0, 0);
                a10 = __builtin_amdgcn_mfma_f32_16x16x32_bf16(*(const bf16x8*)(ap1 + ks * 32), b0, a10, 0, 0, 0);
                a01 = __builtin_amdgcn_mfma_f32_16x16x32_bf16(*(const bf16x8*)(ap0 + (ks + 1) * 32), b1, a01, 0, 0, 0);
                a11 = __builtin_amdgcn_mfma_f32_16x16x32_bf16(*(const bf16x8*)(ap1 + (ks + 1) * 32), b1, a11, 0, 0, 0);
            }
            const f32x4 av0 = a00 + a01, av1 = a10 + a11;
            ao_own = kh ? av1 : av0;
            const f32x4 oth = kh ? av0 : av1;
            st4(Xp + wave * 256 + lane * 4, make_float4(oth[0], oth[1], oth[2], oth[3]));
            const bf16_t* bp2 = Sm + (tt * 16 + (lane & 15)) * 72 + (lane >> 4) * 8;
#pragma unroll
            for (int ks = 0; ks < 2; ++ks) ai = __builtin_amdgcn_mfma_f32_16x16x32_bf16(tr_frag(Vb, 40, ks * 32, kh * 16, lane), *(const bf16x8*)(bp2 + ks * 32), ai, 0, 0, 0);
            s4 = ld4(sc + (tt * 16 + (lane & 15)) * 4);
        }
#pragma unroll
        for (int jt = 0; jt < 4; ++jt) { accS[jt][0] *= d0; accS[jt][1] *= d0; }
#pragma unroll
        for (int ks = 0; ks < 2; ++ks) {
            const bf16x8 b0 = tr_frag(Vw, 40, ks * 32, 0, lane), b1 = tr_frag(Vw, 40, ks * 32, 16, lane);
            const int row0 = ks * 32 + (lane >> 4) * 8 + ((lane & 15) >> 2);
#pragma unroll
            for (int jt = 0; jt < 4; ++jt) {
                const int col = wave * 64 + jt * 16 + (lane & 3) * 4;
                const s16x4 lo = __builtin_amdgcn_ds_read_tr16_b64_v4i16((__attribute__((address_space(3))) s16x4*)(XCs + row0 * 520 + col));
                const s16x4 hi = __builtin_amdgcn_ds_read_tr16_b64_v4i16((__attribute__((address_space(3))) s16x4*)(XCs + (row0 + 4) * 520 + col));
                const bf16x8 af = (bf16x8){lo[0], lo[1], lo[2], lo[3], hi[0], hi[1], hi[2], hi[3]};
                accS[jt][0] = __builtin_amdgcn_mfma_f32_16x16x32_bf16(af, b0, accS[jt][0], 0, 0, 0);
                accS[jt][1] = __builtin_amdgcn_mfma_f32_16x16x32_bf16(af, b1, accS[jt][1], 0, 0, 0);
            }
        }
        __builtin_amdgcn_sched_barrier(0);
        __syncthreads();
        __builtin_amdgcn_sched_barrier(0);
        if (c >= 4) {
            const float4 pt = ld4(Xp + (tt + 4 * (1 - kh)) * 256 + lane * 4);
            const int t = tt * 16 + (lane & 15);
            const float o0 = ao_own[0] + pt.x, o1 = ao_own[1] + pt.y, o2 = ao_own[2] + pt.z, o3 = ao_own[3] + pt.w;
            const float h0 = (s4.x * ai[0] + s4.z * o0) * s4.w, h1 = (s4.x * ai[1] + s4.z * o1) * s4.w;
            const float h2 = (s4.x * ai[2] + s4.z * o2) * s4.w, h3 = (s4.x * ai[3] + s4.z * o3) * s4.w;
            bf16_t* hp = H + ((size_t)b * NL + (size_t)c * 64 + t - NCX) * 2048 + ch0 + kh * 16 + (lane >> 4) * 4;
            const unsigned u0 = pack2bf(h0, h1), u1 = pack2bf(h2, h3);
            asm volatile("global_atomic_pk_add_bf16 %0, %1, off sc1\n\tglobal_atomic_pk_add_bf16 %0, %2, off offset:4 sc1" :: "v"(hp), "v"(u0), "v"(u1) : "memory");
        }
#pragma unroll
        for (int pr = 0; pr < 2; ++pr)
#pragma unroll
            for (int v2 = 0; v2 < 2; ++v2) {
                const f32x4 a0 = accS[2 * pr][v2], a1 = accS[2 * pr + 1][v2];
                const uint4 bu = make_uint4(pack2bf(a0[0], a0[1]), pack2bf(a0[2], a0[3]), pack2bf(a1[0], a1[1]), pack2bf(a1[2], a1[3]));
                const bf16x8 bq = __builtin_bit_cast(bf16x8, bu);
#pragma unroll
                for (int tg = 0; tg < 2; ++tg) {
                    const f32x4 o = __builtin_amdgcn_mfma_f32_16x16x32_bf16(gA[pr][tg], bq, (f32x4){0.f, 0.f, 0.f, 0.f}, 0, 0, 0);
                    const int blk = wave * 16 + (2 * pr + tg) * 4 + (lane >> 4);
                    *(uint2*)(Cs + (v2 * 16 + (lane & 15)) * 520 + blk * 4) = make_uint2(pack2bf(o[0], o[1]), pack2bf(o[2], o[3]));
                }
            }
    }
}

DEV void phase_finish1(const Params& p) {
    bf16_t* H = (bf16_t*)(p.ws + OFF_H);
    const bf16_t* XC = (const bf16_t*)(p.ws + OFF_XC);
    const bf16_t* Z = (const bf16_t*)(p.ws + OFF_XM);
    const float* ng = p.in[44]; const float* skip = p.in[45];
    const int tid_ = opaque_tid(); const int lane = tid_ & 63, gw = blockIdx.x * NWV + (tid_ >> 6), ngw = gridDim.x * NWV;
    const int h = gw & 3, c0 = h * 512 + lane * 8;
    float gn8[8], sk8[8];
    { const float4 a0 = ld4(ng + c0), a1 = ld4(ng + c0 + 4), b0 = ld4(skip + c0), b1 = ld4(skip + c0 + 4);
      gn8[0] = a0.x; gn8[1] = a0.y; gn8[2] = a0.z; gn8[3] = a0.w; gn8[4] = a1.x; gn8[5] = a1.y; gn8[6] = a1.z; gn8[7] = a1.w;
      sk8[0] = b0.x; sk8[1] = b0.y; sk8[2] = b0.z; sk8[3] = b0.w; sk8[4] = b1.x; sk8[5] = b1.y; sk8[6] = b1.z; sk8[7] = b1.w; }
    constexpr int NIT = NB * NL * 4;
    uint4 nh[2], nx[2], nz[2];
#pragma unroll
    for (int u = 0; u < 2; ++u) { const int it = gw + u * ngw, r = (it < NIT ? it : gw) >> 2, b = r >= NL ? 1 : 0, nn = r - b * NL;
        nh[u] = *(const uint4*)(H + (size_t)r * 2048 + c0); nx[u] = *(const uint4*)(XC + ((size_t)b * TB + NCX + nn) * 2048 + c0); nz[u] = *(const uint4*)(Z + (size_t)r * 2048 + c0); }
    for (int it0 = gw; it0 < NIT; it0 += 2 * ngw) {
        uint4 ch[2], cx[2], cz[2];
#pragma unroll
        for (int u = 0; u < 2; ++u) { ch[u] = nh[u]; cx[u] = nx[u]; cz[u] = nz[u]; }
#pragma unroll
        for (int u = 0; u < 2; ++u) { const int it = it0 + (2 + u) * ngw, r = (it < NIT ? it : gw) >> 2, b = r >= NL ? 1 : 0, nn = r - b * NL;
            nh[u] = *(const uint4*)(H + (size_t)r * 2048 + c0); nx[u] = *(const uint4*)(XC + ((size_t)b * TB + NCX + nn) * 2048 + c0); nz[u] = *(const uint4*)(Z + (size_t)r * 2048 + c0); }
#pragma unroll
        for (int u = 0; u < 2; ++u) {
            const int it = it0 + u * ngw, r = it >> 2;
            float v[8]; unpack8(ch[u], v);
            float sum = 0.f;
#pragma unroll
            for (int j = 0; j < 8; ++j) sum += v[j];
            const float mean = wave_sum(sum) * (1.f / 512.f);
            float sq = 0.f;
#pragma unroll
            for (int j = 0; j < 8; ++j) { v[j] -= mean; sq += v[j] * v[j]; }
            const float rstd = rsqrtf(wave_sum(sq) * (1.f / 512.f) + 1e-5f);
            float xc[8], z[8];
            unpack8(cx[u], xc); unpack8(cz[u], z);
            float o[8];
#pragma unroll
            for (int j = 0; j < 8; ++j) o[j] = (v[j] * rstd * gn8[j] + sk8[j] * xc[j]) * silu_f(z[j]);
            if (it < NIT) *(uint4*)(H + (size_t)r * 2048 + c0) = make_uint4(pack2bf(o[0], o[1]), pack2bf(o[2], o[3]), pack2bf(o[4], o[5]), pack2bf(o[6], o[7]));
        }
    }
}

DEV void phase_gemm0(const Params& p, int b, float* sm) {
    const bf16_t* H0b = (const bf16_t*)(p.ws + (b == 0 ? OFF_YC : OFF_RS0));
    run_gemm(H0b, (const bf16_t*)(p.ws + OFF_WT0), TB, 3840, DM, EpBf16{(bf16_t*)(p.ws + OFF_P0), EIN, EIN}, sm);
    mini_gemm<3, 2>(H0b, DM, 33 * (int)blockIdx.x, TB - 1, (const bf16_t*)(p.ws + OFF_WT0), DM, 3840, (bf16_t*)(p.ws + OFF_P0), EIN, 3840, 33, sm);
    if (b == 0) transpose_convert(p.in[9], 1024, 1024, 1024, (bf16_t*)(p.ws + OFF_WT2), sm, 239, (int)gridDim.x - 239);
}

__global__ void __launch_bounds__(NTHR) fwd_kernel(Params p) {
    extern __shared__ __attribute__((aligned(16))) float sm[];
    volatile LAS unsigned* xst = (volatile LAS unsigned*)((LAS char*)sm + (LDS_BYTES - 16));
    if (threadIdx.x == 0) { xst[0] = 0u; xst[1] = 0u; }
    __syncthreads();
    const XcdBarrier xbar = xcd_barrier_post((unsigned*)(p.ws + OFF_BAR), xst);
    const int tid = opaque_tid(), lane = tid & 63, wave = tid >> 6;
    float* modv = (float*)(p.ws + OFF_MODV);
    float* X1C = (float*)(p.ws + OFF_X1C);

    phase_mod(p, sm);
    if (blockIdx.x >= 192) transpose_tiles(p.in[8], 1024, EIN, 4096, (bf16_t*)(p.ws + OFF_WT0), sm, (int)blockIdx.x - 192, 64, 256);
    xcd_barrier(xbar);
    phase_h0(p, 0, (bf16_t*)(p.ws + OFF_YC), 0, (int)gridDim.x);
    transpose_tiles(p.in[8], 1024, EIN, 4096, (bf16_t*)(p.ws + OFF_WT0), sm, 256 + (int)blockIdx.x, 256, 1024);
    xcd_barrier(xbar);

#pragma unroll 1
    for (int b = 0; b < NB; ++b) {
        if (b == 0) { phase_gemm0(p, 0, sm); xcd_barrier(xbar); }
        {
            const int x = blockIdx.x & 7, q0 = blockIdx.x >> 3;
            const int rdir = q0 & 1, wi = q0 >> 1, rc0 = wi < 4 ? 9 * wi : 36 + 8 * (wi - 4), rn = wi < 4 ? 9 : 8;
            R1Raw R;
            r1_consts(p, x, rdir, sm);
            r1_load(p, x, rdir, rc0, R);
            for (int c = rc0; c < rc0 + rn; ++c) rwkv1_unit(p, x, rdir, c, sm, R, c + 2);
            gla_consts(p, x >> 1, sm);
            if (q0 < 8) { for (int g = 2 * q0; g < 2 * q0 + 2; ++g) gla1_unit(p, x >> 1, g & 1, (NCH / 2) * (x & 1) + (g >> 1), sm); }
            else { for (int g = 16 + (q0 - 8); g < NCH; g += 24) gla1_unit(p, x >> 1, g & 1, (NCH / 2) * (x & 1) + (g >> 1), sm); }
        }
        xcd_barrier(xbar);
        {
            const int x = blockIdx.x & 7, j = blockIdx.x >> 3;
            if (j >= 16 && j < 24) { const int i = j - 16; rwkv2_unit(p, x * 2 + (i >> 2), i & 3, sm); }
            else {
                const int hg = x >> 1, f = (x & 1) * 24 + (j < 16 ? j : j - 8);
                gla2_head(p, hg, f);
                group_barrier((unsigned*)(p.ws + OFF_BAR), (unsigned*)(p.ws + OFF_BAR) + XB_GRP(b * 4 + hg), 48u);
                gla_consts(p, hg, sm);
                gla3_unit(p, hg, f, sm);
                gla3_unit(p, hg, f + 48, sm);
            }
        }
        xcd_barrier(xbar);
        {
            const int x = blockIdx.x & 7, j = blockIdx.x >> 3;
            if (j < 18) gla_consts(p, x >> 1, sm);
            const int r0 = j < 18 ? 3 * j : (j < 26 ? 54 + (j - 18) * 6 : 102 + (j - 26) * 5), nr = j < 18 ? 3 : (j < 26 ? 6 : 5);
            R3Raw R3; R3.pr = r3_tile(p, x, r0 - 1); R3.cu = r3_tile(p, x, r0); R3.nx = r3_tile(p, x, r0 + 1);
            for (int r = r0; r < r0 + nr; ++r) rwkv3_unit(p, x, r, sm, R3);
            if (j < 18) gla3_unit(p, x >> 1, 96 + (x & 1) * 18 + j, sm);
        }
        xcd_barrier(xbar);
        run_gemm((const bf16_t*)(p.ws + OFF_YC), (const bf16_t*)(p.ws + OFF_WT2), TB, DM, DM, EpGate<0>{(bf16_t*)(p.ws + OFF_GDS), modv, b}, sm);
        if (b == 0) phase_h0(p, 1, (bf16_t*)(p.ws + OFF_RS0), 132, (int)gridDim.x - 132);
        else {
            transpose_convert(p.in[29], 1024, 4096, 4096, (bf16_t*)(p.ws + OFF_WT1), sm, 132, (int)gridDim.x - 132);
            transpose_convert(p.in[30], 2048, 1024, 1024, (bf16_t*)(p.ws + OFF_WT3), sm, 132, (int)gridDim.x - 132);
            phase_tables(p, 132, (int)gridDim.x - 132);
        }
        xcd_barrier(xbar);
        constexpr int LN_SPLIT = TB - 17 * 33;
        ln_rows((const bf16_t*)(p.ws + OFF_GDS), p.in[0] + (size_t)b * NL * DM, p.in[2] + (size_t)b * NCX * DM, b == 0 ? LN_SPLIT : TB, p.in[6], p.in[7], p.out + (size_t)b * NL * DM, X1C + (size_t)b * NCX * DM, NCX,
                (bf16_t*)(p.ws + OFF_H1B) + (size_t)b * TB * DM, modv + (3 + 2) * 3072, modv + (3 + b) * 3072);
        if (b == 0) {
            phase_gemm0(p, 1, sm);
            ln_rows((const bf16_t*)(p.ws + OFF_GDS), p.in[0], p.in[2], TB, p.in[6], p.in[7], p.out, X1C, NCX, (bf16_t*)(p.ws + OFF_H1B), modv + (3 + 2) * 3072, modv + 3 * 3072, LN_SPLIT, 239, 17);
        }
        xcd_barrier(xbar);
    }

    run_gemm((const bf16_t*)(p.ws + OFF_H1B) + (size_t)NCX * DM, (const bf16_t*)(p.ws + OFF_WT1), NB * NL, 2048, DM, EpBf16{(bf16_t*)(p.ws + OFF_XM) + (size_t)NCX * 2048, 2048, 2048, NL / 256, NCX}, sm, NL / 256, (size_t)NCX * DM * 2);
    { const int rb = (int)blockIdx.x & 7, cb = (int)blockIdx.x >> 3;
      mini_gemm<4, 4>((const bf16_t*)(p.ws + OFF_H1B), DM, rb < 4 ? rb * 64 : TB + (rb - 4) * 64, RT - 1, (const bf16_t*)(p.ws + OFF_WT1), DM, cb * 64, (bf16_t*)(p.ws + OFF_XM), 2048, cb * 64, 64, sm); }
    xcd_barrier(xbar);
    phase_conv1(p, sm);
    xcd_barrier(xbar);
    phase_x1(p, sm);
    xcd_barrier(xbar);
    phase_x2(p, sm);
    xcd_barrier(xbar);
    h1_regen(p, NCX, H1B_NBUF_ROWS, (int)blockIdx.x * NTHR + opaque_tid(), (int)gridDim.x * NTHR);
    phase_mlstm(p, sm);
    xcd_barrier(xbar);
    run_gemm((const bf16_t*)(p.ws + OFF_H1B) + (size_t)NCX * DM, (const bf16_t*)(p.ws + OFF_WT1) + (size_t)2048 * 1024, NB * NL, 2048, DM, EpBf16{(bf16_t*)(p.ws + OFF_XM), 2048, 2048}, sm, NL / 256, (size_t)NCX * DM * 2);
    xcd_barrier(xbar);
    phase_finish1(p);
    xcd_barrier(xbar);
    run_gemm((const bf16_t*)(p.ws + OFF_H), (const bf16_t*)(p.ws + OFF_WT3), NB * NL, DM, 2048, EpGate<1>{(bf16_t*)(p.ws + OFF_XC), modv + 3 * 3072, 0}, sm);
    xcd_barrier(xbar);
    ln_rows((const bf16_t*)(p.ws + OFF_XC), p.out, p.out, NB * NL, p.in[6] + 1024, p.in[7] + 1024, p.out, p.out, 0);
}

extern "C" void kernel_launch(void* const* d_in, const int* in_sizes, int n_in, void* d_out, int out_size, void* d_ws, size_t ws_size, hipStream_t stream) {
    static int grid_blocks = 0;
    if (grid_blocks == 0) {
        if (ws_size < WS_NEED || n_in != 46) { fprintf(stderr, "kernel_launch: bad ws_size %zu (need %zu) or n_in %d\n", ws_size, (size_t)WS_NEED, n_in); grid_blocks = -1; return; }
        int dev = 0, cus = 0, per_cu = 0;
        (void)hipGetDevice(&dev);
        (void)hipDeviceGetAttribute(&cus, hipDeviceAttributeMultiprocessorCount, dev);
        (void)hipFuncSetAttribute((const void*)fwd_kernel, hipFuncAttributeMaxDynamicSharedMemorySize, LDS_BYTES);
        (void)hipOccupancyMaxActiveBlocksPerMultiprocessor(&per_cu, (const void*)fwd_kernel, NTHR, LDS_BYTES);
        if (per_cu < 1 || cus < 256) { fprintf(stderr, "kernel_launch: occupancy query says %d blocks/CU on %d CUs; this kernel needs 256 resident workgroups\n", per_cu, cus); grid_blocks = -1; return; }
        grid_blocks = 256;
    }
    if (grid_blocks < 0) return;
    (void)hipMemsetAsync((char*)d_ws + OFF_BAR, 0, 16384 + 4096, stream);
    Params p{};
    for (int i = 0; i < 46; ++i) p.in[i] = (const float*)d_in[i];
    p.out = (float*)d_out; p.ws = (char*)d_ws;
    void* args[] = {&p};
    hipError_t e = hipLaunchCooperativeKernel((const void*)fwd_kernel, dim3(grid_blocks), dim3(NTHR), args, LDS_BYTES, stream);
    if (e != hipSuccess) fprintf(stderr, "cooperative launch failed: %s (grid %d)\n", hipGetErrorString(e), grid_blocks);
}
```
